# Optimizing an MI355X kernel written in HIP

```python
import math
import jax, jax.numpy as jnp
from jax import lax
import numpy as np

D_MODEL = 1024
BATCH = 8
SEQ = 8192
DEPTH = 4

N_MIXERS = 3
N_ATTN = (DEPTH + 2) // 3
N_HGRN = (DEPTH + 1) // 3
N_LRU = DEPTH // 3
N_DENSE = (DEPTH + 1) // 2
N_MOE = DEPTH // 2

DA_HEADS = 8
DA_HEAD_DIM = 64
DA_V_DIM = 2 * DA_HEAD_DIM
DA_QK_WIDTH = DA_HEADS * 2 * DA_HEAD_DIM
DA_V_WIDTH = DA_HEADS * DA_V_DIM
ROPE_THETA = 10000.0
Q_BLOCK = 128

HG_HEADS = 8
HG_KEY_DIM = D_MODEL // HG_HEADS
HG_VAL_DIM = D_MODEL // HG_HEADS
HG_K_WIDTH = HG_HEADS * HG_KEY_DIM
HG_V_WIDTH = HG_HEADS * HG_VAL_DIM
HG_CHUNK = 64

LRU_WIDTH = 1280
LRU_BLOCKS = 10
LRU_BLOCK_W = LRU_WIDTH // LRU_BLOCKS
CONV_WIDTH = 4
CONV_PAD = (1, 2)
LRU_C = 8.0

D_FF = 2816
N_EXPERTS = 8
TOP_K = 2
D_FF_EXPERT = 3584
EPS = 1e-6

kernel_name = 'hybrid_diffattn_hgrn2_rglru_moe_encoder'


def rms_norm(x, g):
    xf = x.astype(jnp.float32)
    y = xf * lax.rsqrt(jnp.mean(xf * xf, axis=-1, keepdims=True) + EPS)
    return (y * g.astype(jnp.float32)).astype(x.dtype)


def modulate(x, g, shift, scale):
    return rms_norm(x, g) * (1.0 + scale[:, None, :]) + shift[:, None, :]


def rotary_tables(seq, dim):
    inv = 1.0 / (ROPE_THETA ** (jnp.arange(0, dim, 2, dtype=jnp.float32) / dim))
    ang = jnp.arange(seq, dtype=jnp.float32)[:, None] * inv[None, :]
    return jnp.cos(ang), jnp.sin(ang)


def apply_rope(x, cos, sin):
    half = x.shape[-1] // 2
    xf = x.astype(jnp.float32)
    x1, x2 = xf[..., :half], xf[..., half:]
    c = cos[:, None, None, :]
    s = sin[:, None, None, :]
    return jnp.concatenate([x1 * c - x2 * s, x2 * c + x1 * s], axis=-1).astype(x.dtype)


def diff_attention(h, w_in, q_norm_g, k_norm_g, lam_vecs, subln_g, w_out, lambda_init, cos, sin):
    B, S, _ = h.shape
    q, k, v = jnp.split(h @ w_in, [DA_QK_WIDTH, 2 * DA_QK_WIDTH], axis=-1)
    q = q.reshape(B, S, DA_HEADS, 2, DA_HEAD_DIM)
    k = k.reshape(B, S, DA_HEADS, 2, DA_HEAD_DIM)
    v = v.reshape(B, S, DA_HEADS, DA_V_DIM)
    q = apply_rope(rms_norm(q, q_norm_g), cos, sin)
    k = apply_rope(rms_norm(k, k_norm_g), cos, sin)
    lf = lam_vecs.astype(jnp.float32)
    lam = jnp.exp(jnp.sum(lf[0] * lf[1])) - jnp.exp(jnp.sum(lf[2] * lf[3])) + lambda_init
    scale = DA_HEAD_DIM ** -0.5
    nb = S // Q_BLOCK
    q_blocks = jnp.moveaxis(q.reshape(B, nb, Q_BLOCK, DA_HEADS, 2, DA_HEAD_DIM), 1, 0)

    def block(qb):
        s = jnp.einsum('bqhjd,bkhjd->bhjqk', qb, k).astype(jnp.float32) * scale
        p = jax.nn.softmax(s, axis=-1)
        w = p[:, :, 0] - lam * p[:, :, 1]
        return jnp.einsum('bhqk,bkhe->bqhe', w.astype(v.dtype), v)

    o = lax.map(block, q_blocks)
    o = jnp.moveaxis(o, 0, 1).reshape(B, S, DA_HEADS, DA_V_DIM)
    o = rms_norm(o, subln_g) * (1.0 - lambda_init)
    return o.reshape(B, S, DA_V_WIDTH) @ w_out


def gla_chunk_scan(q, k, log_f, v):
    B, S, H, K = q.shape
    V = v.shape[-1]
    n = S // HG_CHUNK

    def to_chunks(t):
        return jnp.swapaxes(t.reshape(B, n, HG_CHUNK, H, t.shape[-1]), 0, 1)

    causal = jnp.tril(jnp.ones((HG_CHUNK, HG_CHUNK), dtype=bool))[None, :, :, None, None]

    def step(state, inp):
        qc, kc, fc, vc = inp
        b = jnp.cumsum(fc, axis=1)
        o_inter = jnp.einsum('bthk,bhkv->bthv', qc * jnp.exp(b), state)
        rel = jnp.where(causal, b[:, :, None] - b[:, None, :], -jnp.inf)
        scores = jnp.einsum('bthk,bshk,btshk->bths', qc, kc, jnp.exp(rel))
        o_intra = jnp.einsum('bths,bshv->bthv', scores, vc)
        b_last = b[:, -1]
        new_state = jnp.exp(b_last)[..., None] * state + jnp.einsum(
            'bshk,bshv->bhkv', kc * jnp.exp(b_last[:, None] - b), vc)
        return new_state, o_inter + o_intra

    state0 = jnp.zeros((B, H, K, V), jnp.float32)
    _, o = lax.scan(step, state0, (to_chunks(q), to_chunks(k), to_chunks(log_f), to_chunks(v)))
    return jnp.swapaxes(o, 0, 1).reshape(B, S, H, V)


def hgrn2(h, w_in, lower_bounds, norm_g, w_out, layer):
    B, S, _ = h.shape
    q, f_fw, f_bw, i_in, g = jnp.split(
        h @ w_in, [HG_K_WIDTH, 2 * HG_K_WIDTH, 3 * HG_K_WIDTH, 3 * HG_K_WIDTH + HG_V_WIDTH], axis=-1)
    lb_all = jnp.cumsum(jax.nn.softmax(lower_bounds.astype(jnp.float32), axis=1), axis=1)
    lb = lb_all[:, layer] - lb_all[:, 0]
    qh = jax.nn.silu(q.astype(jnp.float32)).reshape(B, S, HG_HEADS, HG_KEY_DIM)
    vh = i_in.astype(jnp.float32).reshape(B, S, HG_HEADS, HG_VAL_DIM)
    o_sum = jnp.zeros((B, S, HG_HEADS, HG_VAL_DIM), jnp.float32)
    for d, f_raw in enumerate((f_fw, f_bw)):
        forget = lb[d] + (1.0 - lb[d]) * jax.nn.sigmoid(f_raw.astype(jnp.float32))
        kh = (1.0 - forget).reshape(B, S, HG_HEADS, HG_KEY_DIM)
        lfh = jnp.log(forget).reshape(B, S, HG_HEADS, HG_KEY_DIM)
        if d == 0:
            o_sum = o_sum + gla_chunk_scan(qh, kh, lfh, vh)
        else:
            o_b = gla_chunk_scan(jnp.flip(qh, 1), jnp.flip(kh, 1), jnp.flip(lfh, 1), jnp.flip(vh, 1))
            o_sum = o_sum + jnp.flip(o_b, 1)
    gate = jax.nn.silu(g.astype(jnp.float32)).reshape(B, S, HG_HEADS, HG_VAL_DIM)
    o = rms_norm(o_sum, norm_g) * gate
    return o.reshape(B, S, HG_V_WIDTH).astype(h.dtype) @ w_out


def linear_combine(e1, e2):
    a1, u1 = e1
    a2, u2 = e2
    return a1 * a2, a2 * u1 + u2


def rglru_block(h, w_in, conv_w, conv_b, w_a, b_a, w_x, b_x, lam, w_out):
    B, S, _ = h.shape
    y_br, x_br = jnp.split(h @ w_in, 2, axis=-1)
    y_br = jax.nn.gelu(y_br)
    xc = lax.conv_general_dilated(
        x_br, conv_w[:, None, :], window_strides=(1,), padding=[CONV_PAD],
        dimension_numbers=('NWC', 'WIO', 'NWC'), feature_group_count=LRU_WIDTH) + conv_b
    xf = xc.astype(jnp.float32)
    xb = xc.reshape(B, S, LRU_BLOCKS, LRU_BLOCK_W)
    h_sum = jnp.zeros((B, S, LRU_WIDTH), jnp.float32)
    for d in range(2):
        r = jax.nn.sigmoid(jnp.einsum('bsni,nij->bsnj', xb, w_a[d]).reshape(B, S, LRU_WIDTH).astype(jnp.float32)
                           + b_a[d].astype(jnp.float32))
        ig = jax.nn.sigmoid(jnp.einsum('bsni,nij->bsnj', xb, w_x[d]).reshape(B, S, LRU_WIDTH).astype(jnp.float32)
                            + b_x[d].astype(jnp.float32))
        log_a = -LRU_C * r * jax.nn.softplus(-lam[d].astype(jnp.float32))
        a = jnp.exp(log_a)
        u = jnp.sqrt(-jnp.expm1(2.0 * log_a)) * (ig * xf)
        _, hd = lax.associative_scan(linear_combine, (a, u), reverse=(d == 1), axis=1)
        h_sum = h_sum + hd
    return (h_sum.astype(h.dtype) * y_br) @ w_out


def swiglu(h, w_gu, w_down):
    gate, up = jnp.split(h @ w_gu, 2, axis=-1)
    return (jax.nn.silu(gate) * up) @ w_down


def moe(h, router, w_gu, w_down):
    B, S, D = h.shape
    t = h.reshape(B * S, D)
    logits = (t @ router).astype(jnp.float32)
    top_v, top_i = lax.top_k(logits, TOP_K)
    gates = jax.nn.softmax(top_v, axis=-1)
    combine = jnp.sum(jax.nn.one_hot(top_i, N_EXPERTS, dtype=jnp.float32) * gates[..., None], axis=1)
    y = jnp.zeros_like(t)
    for e in range(N_EXPERTS):
        y = y + combine[:, e:e + 1].astype(t.dtype) * swiglu(t, w_gu[e], w_down[e])
    return y.reshape(B, S, D)


def setup_inputs(seed: int = 0) -> dict:
    key = jax.random.key(seed)
    ks = jax.random.split(key, 32)
    f32 = jnp.float32
    D = D_MODEL

    def nrm(k, shape, scale):
        return jax.random.normal(k, shape, f32) * scale

    u = jax.random.uniform(ks[23], (N_LRU, 2, LRU_WIDTH), f32, 0.9, 0.999)
    p = u ** (1.0 / LRU_C)
    lru_lambda = jnp.log(p) - jnp.log1p(-p)
    return {
        'x': nrm(ks[0], (BATCH, SEQ, D), 1.0),
        'c': nrm(ks[1], (BATCH, D), 1.0),
        'ada_w': nrm(ks[2], (DEPTH, D, 6 * D), 0.5 * D ** -0.5),
        'ada_b': nrm(ks[3], (DEPTH, 6 * D), 0.02),
        'norm1_g': 1.0 + nrm(ks[4], (DEPTH, D), 0.02),
        'norm2_g': 1.0 + nrm(ks[5], (DEPTH, D), 0.02),
        'at_w_in': nrm(ks[6], (N_ATTN, D, 2 * DA_QK_WIDTH + DA_V_WIDTH), D ** -0.5),
        'at_q_norm': 1.0 + nrm(ks[7], (N_ATTN, DA_HEAD_DIM), 0.02),
        'at_k_norm': 1.0 + nrm(ks[8], (N_ATTN, DA_HEAD_DIM), 0.02),
        'at_lam': nrm(ks[9], (N_ATTN, 4, DA_HEAD_DIM), 0.1),
        'at_subln': 1.0 + nrm(ks[10], (N_ATTN, DA_V_DIM), 0.02),
        'at_w_out': nrm(ks[11], (N_ATTN, DA_V_WIDTH, D), DA_V_WIDTH ** -0.5),
        'hg_w_in': nrm(ks[12], (N_HGRN, D, 3 * HG_K_WIDTH + 2 * HG_V_WIDTH), D ** -0.5),
        'hg_lower_bounds': nrm(ks[13], (2, DEPTH, HG_K_WIDTH), 0.1),
        'hg_norm_g': 1.0 + nrm(ks[14], (N_HGRN, HG_VAL_DIM), 0.02),
        'hg_w_out': nrm(ks[15], (N_HGRN, HG_V_WIDTH, D), HG_V_WIDTH ** -0.5),
        'lru_w_in': nrm(ks[16], (N_LRU, D, 2 * LRU_WIDTH), D ** -0.5),
        'lru_conv_w': nrm(ks[17], (N_LRU, CONV_WIDTH, LRU_WIDTH), CONV_WIDTH ** -0.5),
        'lru_conv_b': nrm(ks[18], (N_LRU, LRU_WIDTH), 0.02),
        'lru_w_a': nrm(ks[19], (N_LRU, 2, LRU_BLOCKS, LRU_BLOCK_W, LRU_BLOCK_W), LRU_BLOCK_W ** -0.5),
        'lru_b_a': nrm(ks[20], (N_LRU, 2, LRU_WIDTH), 0.02),
        'lru_w_x': nrm(ks[21], (N_LRU, 2, LRU_BLOCKS, LRU_BLOCK_W, LRU_BLOCK_W), LRU_BLOCK_W ** -0.5),
        'lru_b_x': nrm(ks[22], (N_LRU, 2, LRU_WIDTH), 0.02),
        'lru_lambda': lru_lambda,
        'lru_w_out': nrm(ks[24], (N_LRU, LRU_WIDTH, D), LRU_WIDTH ** -0.5),
        'ff_w_gu': nrm(ks[25], (N_DENSE, D, 2 * D_FF), D ** -0.5),
        'ff_w_down': nrm(ks[26], (N_DENSE, D_FF, D), D_FF ** -0.5),
        'moe_router': nrm(ks[27], (N_MOE, D, N_EXPERTS), D ** -0.5),
        'moe_w_gu': nrm(ks[28], (N_MOE, N_EXPERTS, D, 2 * D_FF_EXPERT), D ** -0.5),
        'moe_w_down': nrm(ks[29], (N_MOE, N_EXPERTS, D_FF_EXPERT, D), D_FF_EXPERT ** -0.5),
    }


def reference(x, c, ada_w, ada_b, norm1_g, norm2_g,
              at_w_in, at_q_norm, at_k_norm, at_lam, at_subln, at_w_out,
              hg_w_in, hg_lower_bounds, hg_norm_g, hg_w_out,
              lru_w_in, lru_conv_w, lru_conv_b, lru_w_a, lru_b_a, lru_w_x, lru_b_x, lru_lambda, lru_w_out,
              ff_w_gu, ff_w_down, moe_router, moe_w_gu, moe_w_down):
    B, S, _ = x.shape
    cos, sin = rotary_tables(S, DA_HEAD_DIM)
    mods = jnp.einsum('bd,lde->lbe', jax.nn.silu(c), ada_w) + ada_b[:, None, :]
    for i in range(DEPTH):
        sh1, sc1, g1, sh2, sc2, g2 = jnp.split(mods[i], 6, axis=-1)
        hm = modulate(x, norm1_g[i], sh1, sc1)
        kind, j = i % N_MIXERS, i // N_MIXERS
        if kind == 0:
            lambda_init = 0.8 - 0.6 * math.exp(-0.3 * i)
            mix = diff_attention(hm, at_w_in[j], at_q_norm[j], at_k_norm[j], at_lam[j], at_subln[j],
                                 at_w_out[j], lambda_init, cos, sin)
        elif kind == 1:
            mix = hgrn2(hm, hg_w_in[j], hg_lower_bounds, hg_norm_g[j], hg_w_out[j], i)
        else:
            mix = rglru_block(hm, lru_w_in[j], lru_conv_w[j], lru_conv_b[j], lru_w_a[j], lru_b_a[j],
                              lru_w_x[j], lru_b_x[j], lru_lambda[j], lru_w_out[j])
        x = x + g1[:, None, :] * mix
        hf = modulate(x, norm2_g[i], sh2, sc2)
        m = i // 2
        if i % 2 == 0:
            ff = swiglu(hf, ff_w_gu[m], ff_w_down[m])
        else:
            ff = moe(hf, moe_router[m], moe_w_gu[m], moe_w_down[m])
        x = x + g2[:, None, :] * ff
    return x
```

```cpp
#define DIAG_FROM 2
#include <hip/hip_runtime.h>
#include <cstdio>
#include <cstdint>

#define LAS __attribute__((address_space(3)))
#define GAS __attribute__((address_space(1)))
typedef unsigned short bf16_t;
typedef short bf16x8 __attribute__((ext_vector_type(8)));
typedef short s16x4 __attribute__((ext_vector_type(4)));
typedef float f32x2 __attribute__((ext_vector_type(2)));
typedef float f32x4 __attribute__((ext_vector_type(4)));
typedef float f32x16 __attribute__((ext_vector_type(16)));
typedef unsigned u32x2 __attribute__((ext_vector_type(2)));
typedef unsigned u32x4 __attribute__((ext_vector_type(4)));

constexpr int MTOK = 65536, DM = 1024, SEQ = 8192, NBATCH = 8, DEPTH = 4;
constexpr int DFF = 2816, DFFE = 3584, NEXP = 8, LRUW = 1280;
constexpr float EPS = 1e-6f;
constexpr float LOG2E = 1.4426950408889634f;

constexpr size_t MiB = 1u << 20;
constexpr size_t WS_CTL = 0, CTL_ZERO_BYTES = 1 * MiB;
constexpr size_t WS_TAB = 1 * MiB;
constexpr size_t TB_MODS = WS_TAB;
constexpr size_t TB_COS = WS_TAB + 1 * MiB;
constexpr size_t TB_SIN = WS_TAB + 2 * MiB;
constexpr size_t TB_SCAL = WS_TAB + 3 * MiB;
constexpr size_t TB_LB = TB_SCAL + 4096;
constexpr size_t TB_SP = TB_SCAL + 16384;
constexpr size_t TB_EID = WS_TAB + 4 * MiB;
constexpr size_t TB_GATE = WS_TAB + 5 * MiB;
constexpr size_t TB_SLOT = WS_TAB + 6 * MiB;
constexpr size_t TB_BCNT = WS_TAB + 7 * MiB;
constexpr size_t TB_TILES = TB_BCNT + 16384;
constexpr size_t TB_LSUM = WS_TAB + 8 * MiB;
constexpr size_t TB_LCIN = WS_TAB + 16 * MiB;
constexpr size_t WS_W = 32 * MiB;
constexpr size_t W_QKV = WS_W;
constexpr size_t W_AO = W_QKV + 2 * (size_t)3072 * 1024 * 2;
constexpr size_t W_HGI = W_AO + 2 * (size_t)1024 * 1024 * 2;
constexpr size_t W_HGO = W_HGI + (size_t)5120 * 1024 * 2;
constexpr size_t W_LRI = W_HGO + (size_t)1024 * 1024 * 2;
constexpr size_t W_LRG = W_LRI + (size_t)2560 * 1024 * 2;
constexpr size_t W_LRO = W_LRG + (size_t)10 * 2 * 256 * 128 * 2;
constexpr size_t W_FGU = W_LRO + (size_t)1024 * 1280 * 2;
constexpr size_t W_FDN = W_FGU + 2 * (size_t)5632 * 1024 * 2;
constexpr size_t W_MGU = W_FDN + 2 * (size_t)1024 * 2816 * 2;
constexpr size_t W_MDN = W_MGU + 16 * (size_t)7168 * 1024 * 2;
constexpr size_t W_END = W_MDN + 16 * (size_t)1024 * 3584 * 2;
constexpr size_t WS_HM = 440 * MiB;
constexpr size_t WS_ACT = 568 * MiB;
static_assert(W_END <= WS_HM, "weights overflow");
constexpr size_t SZ_TOK = (size_t)MTOK * 1024 * 2;
constexpr size_t A_Q = WS_ACT, A_K = A_Q + SZ_TOK, A_V = A_K + SZ_TOK;
constexpr size_t F_HID = WS_ACT;
constexpr size_t H_Q = WS_ACT, H_LFF = H_Q + SZ_TOK, H_LFB = H_LFF + SZ_TOK, H_V = H_LFB + SZ_TOK, H_G = H_V + SZ_TOK, H_OF = H_G + SZ_TOK, H_OB = H_OF + SZ_TOK;
constexpr size_t SZ_LRU = (size_t)MTOK * 1280 * 2;
constexpr size_t L_YB = WS_ACT, L_XB = L_YB + SZ_LRU, L_HF = L_XB + SZ_LRU, L_HY = L_HF + SZ_LRU;
constexpr int MOE_ROWS = 2 * MTOK + NEXP * 256;
constexpr size_t E_XS = WS_ACT, E_HID = E_XS + (size_t)MOE_ROWS * 1024 * 2, E_END = E_HID + (size_t)MOE_ROWS * DFFE * 2;
constexpr size_t WS_NEED = E_END;
static_assert(WS_NEED <= (size_t)1792 * MiB, "workspace");

constexpr int CW_BAR = 4096;

constexpr int RING_BYTES = 135168;
constexpr int MISC_OFF = RING_BYTES;
constexpr int LDS_BYTES = 147456;
constexpr int NWAVES = 8, NTHR = 512;

typedef __bf16 bf16x2v __attribute__((ext_vector_type(2)));
__device__ __forceinline__ unsigned cvt_pk_bf16(float lo, float hi) { const f32x2 v = {lo, hi}; const bf16x2v b = __builtin_convertvector(v, bf16x2v); return __builtin_bit_cast(unsigned, b); }
__device__ __forceinline__ unsigned f2bf(float f) { unsigned u = __builtin_bit_cast(unsigned, f); return (u + 0x7fffu + ((u >> 16) & 1u)) >> 16; }
__device__ __forceinline__ float bf2f(unsigned short b) { return __builtin_bit_cast(float, ((unsigned)b) << 16); }
__device__ __forceinline__ float bflo(unsigned w) { return __builtin_bit_cast(float, w << 16); }
__device__ __forceinline__ float bfhi(unsigned w) { return __builtin_bit_cast(float, w & 0xffff0000u); }
__device__ __forceinline__ float fexp2(float x) { return __builtin_amdgcn_exp2f(x); }
__device__ __forceinline__ float fexp(float x) { return __builtin_amdgcn_exp2f(x * LOG2E); }
__device__ __forceinline__ float frcp(float x) { return __builtin_amdgcn_rcpf(x); }
__device__ __forceinline__ float fsigmoid(float x) { return frcp(1.0f + fexp(-x)); }
__device__ __forceinline__ float fsilu(float x) { return x * fsigmoid(x); }
__device__ __forceinline__ float wave_sum(float v) {
#pragma unroll
    for (int o = 1; o < 64; o <<= 1) v += __shfl_xor(v, o);
    return v;
}
#define LDS_WAIT() asm volatile("s_waitcnt lgkmcnt(0)" ::: "memory")
#define VM_WAIT() asm volatile("s_waitcnt vmcnt(0)" ::: "memory")

#define XB_TMO      128
#define XB_XCNT(j)  (256  + 64 * (j))
#define XB_XSUB(j)  (1280 + 64 * (j))
#define XB_XGEN(j)  (2304 + 64 * (j))
#define XB_TOP      3328
#define XB_TOPGEN   3392
#define XCD_BAR_WORDS 3456
#define XB_SPIN_CAP (1u << 22)
__device__ __forceinline__ unsigned xb_ld(unsigned* p)              { return __hip_atomic_load(p, __ATOMIC_RELAXED, __HIP_MEMORY_SCOPE_AGENT); }
__device__ __forceinline__ unsigned xb_add(unsigned* p, unsigned v) { return __hip_atomic_fetch_add(p, v, __ATOMIC_RELAXED, __HIP_MEMORY_SCOPE_AGENT); }
__device__ __forceinline__ unsigned xb_xcc_id() { return (unsigned)__builtin_amdgcn_s_getreg((3 << 11) | 20) & 0xFu; }
#define XB_SPIN(cond, bar) do { unsigned _sp = 0; while (cond) { __builtin_amdgcn_s_sleep(1); \
    if ((++_sp & 255u) == 0u) { if (xb_ld(&(bar)[XB_TMO])) break; if (_sp > XB_SPIN_CAP) { atomicAdd(&(bar)[XB_TMO], 1u); break; } } } } while (0)
struct XcdBarrier { unsigned* bar; unsigned x; volatile LAS unsigned* st; };
__device__ __forceinline__ XcdBarrier xcd_barrier_post(unsigned* bar, volatile LAS unsigned* st) {
    XcdBarrier b; b.bar = bar; b.x = xb_xcc_id(); b.st = st;
    if (threadIdx.x == 0) (void)xb_add(&bar[XB_XCNT(b.x)], 1u);
    return b;
}
__device__ __forceinline__ void xcd_barrier_complete(unsigned* bar, unsigned x, unsigned& nloc, unsigned& nx) {
    const unsigned G = gridDim.x * gridDim.y * gridDim.z;
    unsigned sum, cnt, mine, sp = 0u;
    for (;;) {
        sum = 0u; cnt = 0u; mine = 0u;
#pragma unroll
        for (unsigned j = 0; j < 16; ++j) { const unsigned c = xb_ld(&bar[XB_XCNT(j)]); sum += c; cnt += (c > 0u) ? 1u : 0u; mine = (j == x) ? c : mine; }
        if (sum == G) break;
        __builtin_amdgcn_s_sleep(1);
        if ((++sp & 255u) == 0u) { if (xb_ld(&bar[XB_TMO])) break; if (sp > XB_SPIN_CAP) { atomicAdd(&bar[XB_TMO], 1u); break; } }
    }
    nloc = mine > 0u ? mine : 1u; nx = cnt > 0u ? cnt : 1u;
}
__device__ __forceinline__ void xcd_barrier(const XcdBarrier& b) {
    asm volatile("s_waitcnt vmcnt(0)" ::: "memory");
    __syncthreads();
    if (threadIdx.x == 0) {
        unsigned* bar = b.bar;
        __builtin_amdgcn_s_waitcnt(0);
        unsigned nloc = b.st[0], nx = b.st[1];
        if (nloc == 0u) { xcd_barrier_complete(bar, b.x, nloc, nx); b.st[0] = nloc; b.st[1] = nx; }
        const unsigned old = xb_add(&bar[XB_XSUB(b.x)], 1u);
        const unsigned gen = old / nloc;
        if (old + 1u == (gen + 1u) * nloc) {
            __builtin_amdgcn_fence(__ATOMIC_RELEASE, "agent");
            asm volatile("s_waitcnt vmcnt(0)" ::: "memory");
            const unsigned og = xb_add(&bar[XB_TOP], 1u);
            const unsigned tg = og / nx;
            if (og + 1u == (tg + 1u) * nx) xb_add(&bar[XB_TOPGEN], 1u);
            else XB_SPIN(xb_ld(&bar[XB_TOPGEN]) == tg, bar);
            __builtin_amdgcn_fence(__ATOMIC_ACQUIRE, "agent");
            xb_add(&bar[XB_XGEN(b.x)], 1u);
            asm volatile("s_waitcnt vmcnt(0)" ::: "memory");
        } else {
            XB_SPIN(xb_ld(&bar[XB_XGEN(b.x)]) == gen, bar);
            __builtin_amdgcn_fence(__ATOMIC_ACQUIRE, "agent");
            asm volatile("s_waitcnt vmcnt(0)" ::: "memory");
        }
    }
    __syncthreads();
}

namespace pg8 {
constexpr int BM = 256, BK = 64, HALF = 128, HTB = HALF * BK * 2, STAGE_BYTES = 8 * HTB, NXCD = 8, WGM = 8;
__host__ __device__ __forceinline__ int lds_byte(int r, int c) { const int st = (r >> 4) * 2 + (c >> 5), rr = r & 15, cc = c & 31, ob = rr * 64 + cc * 2; return st * 1024 + (ob ^ (((ob >> 9) & 1) << 5)); }
__host__ __device__ __forceinline__ void stage_rc(int b, int& R, int& C) { const int st = b / 1024, sb = b % 1024, swz = sb ^ (((sb >> 9) & 1) << 5); R = (st >> 1) * 16 + swz / 64; C = (st & 1) * 32 + (swz % 64) / 2; }
__host__ __device__ __forceinline__ int perm32(int rho) { const int n = rho >> 4, i = rho & 15; return 8 * (i >> 2) + 4 * n + (i & 3); }

struct Unit { int pm, pn, pb; };
struct Gemm { const bf16_t* A; const bf16_t* Bt; int K; };

struct TileOrder {
    int nM, nN, nwg, G, c; int ts[NEXP];
    __device__ __forceinline__ void init(int nM_, int nN_, int G_, int c_) { nM = nM_; nN = nN_; nwg = nM * nN; G = G_; c = c_;
#pragma unroll
        for (int e = 0; e < NEXP; ++e) ts[e] = (e == 0) ? 0 : 0x7fffffff; }
    __device__ __forceinline__ bool next(int i, Unit& u) const {
        const long L = (long)i * G + c; if (L >= nwg) return false;
        int wgid = (int)L; { const int q = nwg / NXCD, r = nwg % NXCD, xcd = wgid % NXCD, off = wgid / NXCD; wgid = (xcd < r ? xcd * (q + 1) : r * (q + 1) + (xcd - r) * q) + off; }
        const int nig = WGM * nN, gid = wgid / nig, fm = gid * WGM, gsz = (nM - fm) < WGM ? (nM - fm) : WGM;
        u.pm = fm + ((wgid % nig) % gsz); u.pn = (wgid % nig) / gsz;
        int e = 0;
#pragma unroll
        for (int k = 1; k < NEXP; ++k) e += (u.pm >= ts[k]) ? 1 : 0;
        u.pb = e * nN + u.pn; return true;
    }
};

template <class Epi>
__device__ __forceinline__ void gemm_phase(LAS unsigned char* lds, const Gemm g, const TileOrder& S, const Epi& E) {
    int tid_ = threadIdx.x; asm volatile("" : "+v"(tid_));
    const int tid = tid_, wid = __builtin_amdgcn_readfirstlane(tid >> 6), lane = tid & 63, wr = wid >> 2, wc = wid & 3, fr = lane & 15, fq = lane >> 4;
    const int K = g.K, nt = K / BK;
    unsigned voffA[2], voffB[2];
#pragma unroll
    for (int i = 0; i < 2; ++i) { int R, C; stage_rc(tid * 16 + i * 8192, R, C); const int Rb = Epi::PERM ? ((R & ~31) + perm32(R & 31)) : R;
        voffA[i] = (unsigned)(R * K + C) * 2u; voffB[i] = (unsigned)(Rb * K + C) * 2u; }
    const size_t kstep = (size_t)(BK * 2);
    const size_t hstep = (size_t)HALF * K * 2;
    const size_t tstep = 2 * hstep;
    const unsigned ldsw = (unsigned)wid * 1024u;
    const int aoff = lds_byte(wr * 64 + fr, fq * 8), boff = lds_byte(wc * 32 + fr, fq * 8);
#define PG8_SA(b, h) (((b) * 2 + (h)) * HTB)
#define PG8_SB(b, h) ((4 + (b) * 2 + (h)) * HTB)
#define PG8_STAGE(bufoff, gbase, voff) do { _Pragma("unroll") for (int _i = 0; _i < 2; ++_i) \
        __builtin_amdgcn_global_load_lds((const unsigned*)((const char*)(gbase) + (voff)[_i]), (LAS unsigned*)(lds + (bufoff) + ldsw + _i * 8192), 16, 0, 0); } while (0)
#define PG8_LDA(dst, b, h) do { _Pragma("unroll") for (int m = 0; m < 4; ++m) _Pragma("unroll") for (int k = 0; k < 2; ++k) dst[m][k] = *(const LAS bf16x8*)(lds + PG8_SA(b, h) + aoff + m * 2048 + k * 1024); } while (0)
#define PG8_LDB(dst, b, h) do { _Pragma("unroll") for (int n = 0; n < 2; ++n) _Pragma("unroll") for (int k = 0; k < 2; ++k) dst[n][k] = *(const LAS bf16x8*)(lds + PG8_SB(b, h) + boff + n * 2048 + k * 1024); } while (0)
#define PG8_MMA(ai, bj, At, Bt) do { __builtin_amdgcn_s_setprio(1); _Pragma("unroll") for (int m = 0; m < 4; ++m) _Pragma("unroll") for (int n = 0; n < 2; ++n) _Pragma("unroll") for (int k = 0; k < 2; ++k) \
        acc[ai][bj][m][n] = __builtin_amdgcn_mfma_f32_16x16x32_bf16(Bt[n][k], At[m][k], acc[ai][bj][m][n], 0, 0, 0); __builtin_amdgcn_s_setprio(0); } while (0)
#define PG8_WAIT_V(n) asm volatile("s_waitcnt vmcnt(" #n ")" ::: "memory")
#define PG8_WAIT_L(n) asm volatile("s_waitcnt lgkmcnt(" #n ")" ::: "memory")
#define PG8_BAR __builtin_amdgcn_s_barrier()
#define PG8_SCHED __builtin_amdgcn_sched_barrier(0)
    Unit cur, nxt; int ui = 0;
    if (!S.next(0, cur)) return;
    f32x4 acc[2][2][4][2];
#pragma unroll
    for (int a = 0; a < 2; ++a)
#pragma unroll
        for (int b = 0; b < 2; ++b)
#pragma unroll
            for (int m = 0; m < 4; ++m)
#pragma unroll
                for (int n = 0; n < 2; ++n) acc[a][b][m][n] = (f32x4){0.f, 0.f, 0.f, 0.f};
    bf16x8 At[4][2], B0[2][2], B1[2][2];
    const char* cA = (const char*)g.A + (size_t)cur.pm * tstep; const char* cB = (const char*)g.Bt + (size_t)cur.pb * tstep;
    PG8_STAGE(PG8_SB(0, 0), cB, voffB); PG8_STAGE(PG8_SA(0, 0), cA, voffA); PG8_STAGE(PG8_SB(0, 1), cB + hstep, voffB); PG8_STAGE(PG8_SA(0, 1), cA + hstep, voffA);
    if (wr == 1) PG8_BAR;
    PG8_WAIT_V(4); PG8_BAR;
    PG8_STAGE(PG8_SB(1, 0), cB + kstep, voffB); PG8_STAGE(PG8_SA(1, 0), cA + kstep, voffA); PG8_STAGE(PG8_SB(1, 1), cB + hstep + kstep, voffB);
    PG8_WAIT_V(6); PG8_BAR;
    for (;;) {
        const bool has_next = S.next(ui + 1, nxt);
        const char* nA = has_next ? (const char*)g.A + (size_t)nxt.pm * tstep : cA; const char* nB = has_next ? (const char*)g.Bt + (size_t)nxt.pb * tstep : cB;
        for (int t = 0; t < nt; t += 2) {
            const bool last = (t == nt - 2);
            const char* a1 = cA + (size_t)(t + 1) * kstep;
            const char* a2 = last ? nA : cA + (size_t)(t + 2) * kstep; const char* b2 = last ? nB : cB + (size_t)(t + 2) * kstep;
            const char* a3 = a2 + kstep; const char* b3 = b2 + kstep;
            PG8_LDB(B0, 0, 0); PG8_SCHED; PG8_LDA(At, 0, 0); PG8_STAGE(PG8_SA(1, 1), a1 + hstep, voffA);
            PG8_WAIT_L(8); PG8_BAR; PG8_WAIT_L(0); PG8_MMA(0, 0, At, B0); PG8_BAR; PG8_SCHED;
            PG8_LDB(B1, 0, 1); PG8_STAGE(PG8_SB(0, 0), b2, voffB);
            PG8_BAR; PG8_WAIT_L(0); PG8_MMA(0, 1, At, B1); PG8_BAR;
            PG8_LDA(At, 0, 1); PG8_STAGE(PG8_SA(0, 0), a2, voffA);
            PG8_BAR; PG8_WAIT_L(0); PG8_MMA(1, 0, At, B0); PG8_BAR; PG8_SCHED;
            PG8_STAGE(PG8_SB(0, 1), b2 + hstep, voffB);
            PG8_WAIT_V(6); PG8_BAR; PG8_MMA(1, 1, At, B1); PG8_BAR;
            PG8_LDB(B0, 1, 0); PG8_SCHED; PG8_LDA(At, 1, 0); PG8_STAGE(PG8_SA(0, 1), a2 + hstep, voffA);
            PG8_WAIT_L(8); PG8_BAR; PG8_WAIT_L(0); PG8_MMA(0, 0, At, B0); PG8_BAR; PG8_SCHED;
            PG8_LDB(B1, 1, 1); PG8_STAGE(PG8_SB(1, 0), b3, voffB);
            PG8_BAR; PG8_WAIT_L(0); PG8_MMA(0, 1, At, B1); PG8_BAR;
            PG8_LDA(At, 1, 1); PG8_STAGE(PG8_SA(1, 0), a3, voffA);
            PG8_BAR; PG8_WAIT_L(0); PG8_MMA(1, 0, At, B0); PG8_BAR; PG8_SCHED;
            PG8_STAGE(PG8_SB(1, 1), b3 + hstep, voffB);
            PG8_WAIT_V(6); PG8_BAR; PG8_MMA(1, 1, At, B1); PG8_BAR;
        }
        E(acc, cur, wr, wc, fr, fq);
        if (!has_next) break;
#pragma unroll
        for (int a = 0; a < 2; ++a)
#pragma unroll
            for (int b = 0; b < 2; ++b)
#pragma unroll
                for (int m = 0; m < 4; ++m)
#pragma unroll
                    for (int n = 0; n < 2; ++n) acc[a][b][m][n] = (f32x4){0.f, 0.f, 0.f, 0.f};
        cur = nxt; cA = nA; cB = nB; ++ui;
    }
    PG8_WAIT_V(0);
    if (wr == 0) PG8_BAR;
    PG8_BAR;
#undef PG8_SA
#undef PG8_SB
#undef PG8_STAGE
#undef PG8_LDA
#undef PG8_LDB
#undef PG8_MMA
#undef PG8_WAIT_V
#undef PG8_WAIT_L
#undef PG8_BAR
#undef PG8_SCHED
}

struct EpiQKV {
    static constexpr bool PERM = true;
    bf16_t *Q, *Kk, *V; const float *gq, *gk, *cosT, *sinT; float qscale;
    __device__ __forceinline__ void operator()(const f32x4 (&acc)[2][2][4][2], const Unit& u, int wr, int wc, int fr, int fq) const {
        const int row0 = u.pm * BM + wr * 64 + fr;
        if (u.pn >= 8) {
            const int col0 = (u.pn - 8) * BM + wc * 32 + 8 * fq;
#pragma unroll
            for (int ai = 0; ai < 2; ++ai)
#pragma unroll
                for (int m = 0; m < 4; ++m) { bf16_t* rowp = V + (size_t)(row0 + ai * HALF + m * 16) * DM + col0;
#pragma unroll
                    for (int bj = 0; bj < 2; ++bj) { const f32x4 v0 = acc[ai][bj][m][0], v1 = acc[ai][bj][m][1];
                        u32x4 w; w.x = cvt_pk_bf16(v0[0], v0[1]); w.y = cvt_pk_bf16(v0[2], v0[3]); w.z = cvt_pk_bf16(v1[0], v1[1]); w.w = cvt_pk_bf16(v1[2], v1[3]);
                        *(u32x4*)(rowp + bj * HALF) = w; } }
        } else {
            const int part = u.pn >> 2, sh = 4 * (u.pn & 3) + wc;
            bf16_t* dst = part ? Kk : Q; const float* g = part ? gk : gq; const float sc = part ? 1.0f : qscale;
            f32x4 g0[2], g1[2];
#pragma unroll
            for (int n = 0; n < 2; ++n) { g0[n] = *(const f32x4*)(g + 8 * fq + 4 * n); g1[n] = *(const f32x4*)(g + 32 + 8 * fq + 4 * n); }
#pragma unroll
            for (int ai = 0; ai < 2; ++ai)
#pragma unroll
                for (int m = 0; m < 4; ++m) {
                    const int r = row0 + ai * HALF + m * 16; const int pos = r & (SEQ - 1);
                    f32x4 x1[2], x2[2]; float ss = 0.f;
#pragma unroll
                    for (int n = 0; n < 2; ++n) { x1[n] = acc[ai][0][m][n]; x2[n] = acc[ai][1][m][n];
                        ss += (x1[n][0] * x1[n][0] + x1[n][1] * x1[n][1]) + (x1[n][2] * x1[n][2] + x1[n][3] * x1[n][3]);
                        ss += (x2[n][0] * x2[n][0] + x2[n][1] * x2[n][1]) + (x2[n][2] * x2[n][2] + x2[n][3] * x2[n][3]); }
                    ss += __shfl_xor(ss, 16); ss += __shfl_xor(ss, 32);
                    const float rstd = __builtin_amdgcn_rsqf(ss * (1.0f / 64.0f) + EPS) ;
                    bf16_t* op = dst + (size_t)r * DM + sh * 64 + 8 * fq;
                    u32x4 w1, w2;
#pragma unroll
                    for (int n = 0; n < 2; ++n) {
                        const f32x4 cs = *(const f32x4*)(cosT + pos * 32 + 8 * fq + 4 * n), sn = *(const f32x4*)(sinT + pos * 32 + 8 * fq + 4 * n);
                        const f32x4 y1 = x1[n] * rstd * g0[n], y2 = x2[n] * rstd * g1[n];
                        const f32x4 o1 = (y1 * cs - y2 * sn) * sc, o2 = (y2 * cs + y1 * sn) * sc;
                        if (n == 0) { w1.x = cvt_pk_bf16(o1[0], o1[1]); w1.y = cvt_pk_bf16(o1[2], o1[3]); w2.x = cvt_pk_bf16(o2[0], o2[1]); w2.y = cvt_pk_bf16(o2[2], o2[3]); }
                        else { w1.z = cvt_pk_bf16(o1[0], o1[1]); w1.w = cvt_pk_bf16(o1[2], o1[3]); w2.z = cvt_pk_bf16(o2[0], o2[1]); w2.w = cvt_pk_bf16(o2[2], o2[3]); }
                    }
                    *(u32x4*)(op) = w1; *(u32x4*)(op + 32) = w2;
                }
        }
    }
};
struct EpiRes {
    static constexpr bool PERM = false;
    const float* xin; float* xout; const float* gate;
    __device__ __forceinline__ void operator()(const f32x4 (&acc)[2][2][4][2], const Unit& u, int wr, int wc, int fr, int fq) const {
        const int row0 = u.pm * BM + wr * 64 + fr, col0 = u.pn * BM + wc * 32 + 4 * fq;
        const float* gp = gate + (size_t)(u.pm >> 5) * 6144 + col0;
        f32x4 gv[2][2];
#pragma unroll
        for (int bj = 0; bj < 2; ++bj)
#pragma unroll
            for (int n = 0; n < 2; ++n) gv[bj][n] = *(const f32x4*)(gp + bj * HALF + n * 16);
#pragma unroll
        for (int ai = 0; ai < 2; ++ai)
#pragma unroll
            for (int m = 0; m < 4; ++m) { const size_t off = (size_t)(row0 + ai * HALF + m * 16) * DM + col0;
#pragma unroll
                for (int bj = 0; bj < 2; ++bj)
#pragma unroll
                    for (int n = 0; n < 2; ++n) { const f32x4 xv = *(const f32x4*)(xin + off + bj * HALF + n * 16);
                        *(f32x4*)(xout + off + bj * HALF + n * 16) = xv + gv[bj][n] * acc[ai][bj][m][n]; }
                asm volatile("" ::: "memory"); }
    }
};
struct EpiSwiGLU {
    static constexpr bool PERM = true;
    bf16_t* H; int ldh;
    __device__ __forceinline__ void operator()(const f32x4 (&acc)[2][2][4][2], const Unit& u, int wr, int wc, int fr, int fq) const {
        const int row0 = u.pm * BM + wr * 64 + fr, col0 = u.pn * HALF + wc * 32 + 8 * fq;
#pragma unroll
        for (int ai = 0; ai < 2; ++ai)
#pragma unroll
            for (int m = 0; m < 4; ++m) { bf16_t* rowp = H + (size_t)(row0 + ai * HALF + m * 16) * ldh + col0;
                f32x4 v[2];
#pragma unroll
                for (int n = 0; n < 2; ++n) { const f32x4 gt = acc[ai][0][m][n], up = acc[ai][1][m][n];
#pragma unroll
                    for (int j = 0; j < 4; ++j) v[n][j] = fsilu(gt[j]) * up[j]; }
                u32x4 w; w.x = cvt_pk_bf16(v[0][0], v[0][1]); w.y = cvt_pk_bf16(v[0][2], v[0][3]); w.z = cvt_pk_bf16(v[1][0], v[1][1]); w.w = cvt_pk_bf16(v[1][2], v[1][3]);
                *(u32x4*)rowp = w; }
    }
};
struct EpiPlain {
    static constexpr bool PERM = true;
    bf16_t* O; int ldc;
    __device__ __forceinline__ void operator()(const f32x4 (&acc)[2][2][4][2], const Unit& u, int wr, int wc, int fr, int fq) const {
        const int row0 = u.pm * BM + wr * 64 + fr, col0 = u.pn * BM + wc * 32 + 8 * fq;
#pragma unroll
        for (int ai = 0; ai < 2; ++ai)
#pragma unroll
            for (int m = 0; m < 4; ++m) { bf16_t* rowp = O + (size_t)(row0 + ai * HALF + m * 16) * ldc + col0;
#pragma unroll
                for (int bj = 0; bj < 2; ++bj) { const f32x4 v0 = acc[ai][bj][m][0], v1 = acc[ai][bj][m][1];
                    u32x4 w; w.x = cvt_pk_bf16(v0[0], v0[1]); w.y = cvt_pk_bf16(v0[2], v0[3]); w.z = cvt_pk_bf16(v1[0], v1[1]); w.w = cvt_pk_bf16(v1[2], v1[3]);
                    *(u32x4*)(rowp + bj * HALF) = w; } }
    }
};
struct EpiAct {
    static constexpr bool PERM = true;
    int kind; unsigned char* ws; const float* lb;
    __device__ __forceinline__ void operator()(const f32x4 (&acc)[2][2][4][2], const Unit& u, int wr, int wc, int fr, int fq) const {
        const int row0 = u.pm * BM + wr * 64 + fr;
        int mode, ldc, colt; size_t boff;
        if (kind == 0) { const int grp = u.pn >> 2; colt = (u.pn & 3) * 256; ldc = 1024;
            boff = grp == 0 ? H_Q : grp == 1 ? H_LFF : grp == 2 ? H_LFB : grp == 3 ? H_V : H_G; mode = (grp == 0 || grp == 4) ? 1 : (grp == 3 ? 0 : 3); }
        else { ldc = LRUW; if (u.pn < 5) { boff = L_YB; colt = u.pn * 256; mode = 2; } else { boff = L_XB; colt = (u.pn - 5) * 256; mode = 0; } }
        bf16_t* base = (bf16_t*)(ws + boff);
        const int col0 = colt + wc * 32 + 8 * fq;
        f32x4 lbv[2][2];
        if (mode == 3) { const float* lp = lb + ((u.pn >> 2) - 1) * 1024 + col0;
#pragma unroll
            for (int bj = 0; bj < 2; ++bj)
#pragma unroll
                for (int n = 0; n < 2; ++n) lbv[bj][n] = *(const f32x4*)(lp + bj * HALF + 4 * n); }
#pragma unroll
        for (int ai = 0; ai < 2; ++ai)
#pragma unroll
            for (int m = 0; m < 4; ++m) { bf16_t* rowp = base + (size_t)(row0 + ai * HALF + m * 16) * ldc + col0;
#pragma unroll
                for (int bj = 0; bj < 2; ++bj) { f32x4 v[2]; u32x4 w;
#pragma unroll
                    for (int n = 0; n < 2; ++n) { v[n] = acc[ai][bj][m][n];
                        if (mode == 1) {
#pragma unroll
                            for (int j = 0; j < 4; ++j) v[n][j] = fsilu(v[n][j]); }
                        else if (mode == 2) {
#pragma unroll
                            for (int j = 0; j < 4; ++j) { const float x = v[n][j]; v[n][j] = x * fsigmoid(1.5957691216057308f * (x + 0.044715f * x * x * x)); } }
                        else if (mode == 3) {
#pragma unroll
                            for (int j = 0; j < 4; ++j) { const float l = lbv[bj][n][j]; const float fg = l + (1.0f - l) * fsigmoid(v[n][j]); v[n][j] = __builtin_amdgcn_logf(fg) * 0.6931471805599453f; } }
                    }
                    if (mode == 3) {
#pragma unroll
                        for (int n = 0; n < 2; ++n) { const _Float16 h0 = (_Float16)v[n][0], h1 = (_Float16)v[n][1], h2 = (_Float16)v[n][2], h3 = (_Float16)v[n][3];
                            const unsigned a = (unsigned)__builtin_bit_cast(unsigned short, h0) | ((unsigned)__builtin_bit_cast(unsigned short, h1) << 16);
                            const unsigned b = (unsigned)__builtin_bit_cast(unsigned short, h2) | ((unsigned)__builtin_bit_cast(unsigned short, h3) << 16);
                            if (n == 0) { w.x = a; w.y = b; } else { w.z = a; w.w = b; } }
                    } else { w.x = cvt_pk_bf16(v[0][0], v[0][1]); w.y = cvt_pk_bf16(v[0][2], v[0][3]); w.z = cvt_pk_bf16(v[1][0], v[1][1]); w.w = cvt_pk_bf16(v[1][2], v[1][3]); }
                    *(u32x4*)(rowp + bj * HALF) = w; } }
    }
};
}

struct Args { const float* in[30]; float* out; unsigned char* ws; };
enum { I_X = 0, I_C, I_ADAW, I_ADAB, I_N1G, I_N2G, I_ATWIN, I_ATQN, I_ATKN, I_ATLAM, I_ATSUB, I_ATWOUT, I_HGWIN, I_HGLB, I_HGNG, I_HGWOUT,
       I_LRWIN, I_LRCW, I_LRCB, I_LRWA, I_LRBA, I_LRWX, I_LRBX, I_LRLAM, I_LRWOUT, I_FFGU, I_FFDN, I_MOER, I_MOEGU, I_MOEDN };
enum { SC_LAM0 = 0, SC_LAM1, SC_OML0, SC_OML1, SC_MC0, SC_MC1 };

__device__ __forceinline__ void cvt_item(const float* W, int ldw, int src_col0, bf16_t* WT, int ldt, int dst_row0, int k0, LAS float* scr, int lane) {
#pragma unroll 8
    for (int i = 0; i < 32; ++i) { const int kk = 2 * i + (lane >> 5); scr[kk * 33 + (lane & 31)] = W[(size_t)(k0 + kk) * ldw + src_col0 + (lane & 31)]; }
    LDS_WAIT(); asm volatile("" ::: "memory");
    const int c = lane & 7;
#pragma unroll
    for (int j = 0; j < 4; ++j) { const int n = (lane >> 3) + 8 * j; const LAS float* s = scr + (8 * c) * 33 + n;
        u32x4 o; o.x = cvt_pk_bf16(s[0 * 33], s[1 * 33]); o.y = cvt_pk_bf16(s[2 * 33], s[3 * 33]); o.z = cvt_pk_bf16(s[4 * 33], s[5 * 33]); o.w = cvt_pk_bf16(s[6 * 33], s[7 * 33]);
        *(u32x4*)(WT + (size_t)(dst_row0 + n) * ldt + k0 + 8 * c) = o; }
    LDS_WAIT(); asm volatile("" ::: "memory");
}
enum { MAP_ID = 0, MAP_QKV = 1, MAP_SWI = 2 };
__device__ __forceinline__ void cvt_family(const float* src, size_t sstride, int ninst, int ldw, int K, int ng, int map, int F, bf16_t* dst, size_t dstride,
                                           LAS float* scr, int gw, int NGW, int lane) {
    const int nkb = K / 64, per = nkb * ng, total = ninst * per;
    for (int it = gw; it < total; it += NGW) {
        const int inst = it / per, r = it - inst * per, kb = r / ng, gi = r - kb * ng;
        int sc0;
        if (map == MAP_ID) sc0 = 32 * gi;
        else if (map == MAP_QKV) { const int pn = gi >> 3, bj = (gi >> 2) & 1, wc = gi & 3;
            if (pn < 8) { const int part = pn >> 2, sh = 4 * (pn & 3) + wc; sc0 = part * 1024 + sh * 64 + 32 * bj; } else sc0 = 32 * gi; }
        else { const int pn = gi >> 3, bj = (gi >> 2) & 1, q = gi & 3; sc0 = bj * F + pn * 128 + 32 * q; }
        cvt_item(src + (size_t)inst * sstride, ldw, sc0, dst + (size_t)inst * dstride, K, 32 * gi, 64 * kb, scr, lane);
    }
}

__device__ __forceinline__ void prologue_phase(const Args& A, LAS unsigned char* lds, int bid, int G) {
    const int tid = threadIdx.x, lane = tid & 63, wave = tid >> 6;
    unsigned char* ws = A.ws;
    {
        LAS float* sc = (LAS float*)lds;
        LAS float* red = (LAS float*)(lds + 32768);
        for (int i = tid; i < NBATCH * DM; i += NTHR) { const float cv = A.in[I_C][i]; sc[i] = fsilu(cv); }
        __syncthreads();
        float* mods = (float*)(ws + TB_MODS);
        for (int cb = bid; cb < (DEPTH * 6144) / 128; cb += G) {
            const int col = cb * 128 + (tid & 127), l = col / 6144, e = col - l * 6144, ch = tid >> 7;
            const float* wp = A.in[I_ADAW] + (size_t)l * DM * 6144 + e;
            float a[NBATCH];
#pragma unroll
            for (int b = 0; b < NBATCH; ++b) a[b] = 0.f;
#pragma unroll 4
            for (int d = ch * 256; d < ch * 256 + 256; ++d) { const float w = wp[(size_t)d * 6144];
#pragma unroll
                for (int b = 0; b < NBATCH; ++b) a[b] += sc[b * DM + d] * w; }
#pragma unroll
            for (int b = 0; b < NBATCH; ++b) red[(ch * 128 + (tid & 127)) * 8 + b] = a[b];
            __syncthreads();
            if (tid < 128) { const float bias = A.in[I_ADAB][l * 6144 + e];
#pragma unroll
                for (int b = 0; b < NBATCH; ++b) { const float s = ((red[(0 * 128 + tid) * 8 + b] + red[(1 * 128 + tid) * 8 + b]) + (red[(2 * 128 + tid) * 8 + b] + red[(3 * 128 + tid) * 8 + b])) + bias;
                    mods[((size_t)l * NBATCH + b) * 6144 + e] = s; } }
            __syncthreads();
        }
    }
    {
        float* cosT = (float*)(ws + TB_COS); float* sinT = (float*)(ws + TB_SIN);
        for (int i = bid * NTHR + tid; i < SEQ * 32; i += G * NTHR) {
            const int pos = i >> 5, d = i & 31;
            const float inv = (float)exp(-(double)d * (1.0 / 32.0) * 9.210340371976184);
            const float ang = (float)pos * inv;
            const double rev = (double)ang * 0.15915494309189535; const float fr = (float)(rev - floor(rev));
            cosT[i] = __builtin_amdgcn_cosf(fr); sinT[i] = __builtin_amdgcn_sinf(fr);
        }
        if (bid == 0 && tid < 2) {
            const int a = tid; const float* lm = A.in[I_ATLAM] + a * 256;
            float s1 = 0.f, s2 = 0.f; for (int i = 0; i < 64; ++i) { s1 += lm[i] * lm[64 + i]; s2 += lm[128 + i] * lm[192 + i]; }
            const float linit = 0.8f - 0.6f * expf(-0.3f * (float)(3 * a));
            float mq = 0.f, mk = 0.f; for (int i = 0; i < 64; ++i) { mq = fmaxf(mq, fabsf(A.in[I_ATQN][a * 64 + i])); mk = fmaxf(mk, fabsf(A.in[I_ATKN][a * 64 + i])); }
            float* scal = (float*)(ws + TB_SCAL);
            scal[SC_LAM0 + a] = expf(s1) - expf(s2) + linit; scal[SC_OML0 + a] = 1.0f - linit; scal[SC_MC0 + a] = 8.0f * mq * mk * LOG2E * 1.0001f;
        }
        if (bid == 1) {
            float* lb = (float*)(ws + TB_LB);
            for (int i = tid; i < 2 * 1024; i += NTHR) { const int d = i >> 10, k = i & 1023; const float* p = A.in[I_HGLB] + (size_t)d * DEPTH * 1024 + k;
                float mx = p[0]; for (int l = 1; l < DEPTH; ++l) mx = fmaxf(mx, p[l * 1024]);
                float den = 0.f, num = 0.f; for (int l = 0; l < DEPTH; ++l) { const float e = expf(p[l * 1024] - mx); den += e; if (l == 1) num += e; }
                lb[i] = num / den; }
        }
        if (bid == 2) {
            float* sp = (float*)(ws + TB_SP);
            for (int i = tid; i < 2 * LRUW; i += NTHR) { const float x = -A.in[I_LRLAM][i]; sp[i] = (x > 20.f) ? x : log1pf(expf(x)); }
        }
    }
    {
        LAS float* scr = (LAS float*)(lds + wave * 16384);
        const int vcu = (bid % 8) * (G / 8) + bid / 8;
        const int gw = vcu * NWAVES + wave, NGW = G * NWAVES;
        cvt_family(A.in[I_ATWIN], (size_t)1024 * 3072, 2, 3072, 1024, 96, MAP_QKV, 0, (bf16_t*)(ws + W_QKV), (size_t)3072 * 1024, scr, gw, NGW, lane);
        cvt_family(A.in[I_ATWOUT], (size_t)1024 * 1024, 2, 1024, 1024, 32, MAP_ID, 0, (bf16_t*)(ws + W_AO), (size_t)1024 * 1024, scr, gw, NGW, lane);
        cvt_family(A.in[I_HGWIN], 0, 1, 5120, 1024, 160, MAP_ID, 0, (bf16_t*)(ws + W_HGI), 0, scr, gw, NGW, lane);
        cvt_family(A.in[I_HGWOUT], 0, 1, 1024, 1024, 32, MAP_ID, 0, (bf16_t*)(ws + W_HGO), 0, scr, gw, NGW, lane);
        cvt_family(A.in[I_LRWIN], 0, 1, 2560, 1024, 80, MAP_ID, 0, (bf16_t*)(ws + W_LRI), 0, scr, gw, NGW, lane);
        cvt_family(A.in[I_LRWOUT], 0, 1, 1024, 1280, 32, MAP_ID, 0, (bf16_t*)(ws + W_LRO), 0, scr, gw, NGW, lane);
        for (int it = gw; it < 2 * 20 * 2 * 4; it += NGW) {
            const int part = it / 160, r = it % 160, inst = r >> 3, kb = (r >> 2) & 1, gi = r & 3, d = inst / 10, n = inst % 10;
            const float* src = (part ? A.in[I_LRWX] : A.in[I_LRWA]) + (size_t)inst * 16384;
            cvt_item(src, 128, 32 * gi, (bf16_t*)(ws + W_LRG) + (size_t)(n * 2 + d) * 256 * 128, 128, part * 128 + 32 * gi, 64 * kb, scr, lane);
        }
        cvt_family(A.in[I_FFGU], (size_t)1024 * 5632, 2, 5632, 1024, 176, MAP_SWI, DFF, (bf16_t*)(ws + W_FGU), (size_t)5632 * 1024, scr, gw, NGW, lane);
        cvt_family(A.in[I_FFDN], (size_t)2816 * 1024, 2, 1024, 2816, 32, MAP_ID, 0, (bf16_t*)(ws + W_FDN), (size_t)1024 * 2816, scr, gw, NGW, lane);
        cvt_family(A.in[I_MOEGU], (size_t)1024 * 7168, 16, 7168, 1024, 224, MAP_SWI, DFFE, (bf16_t*)(ws + W_MGU), (size_t)7168 * 1024, scr, gw, NGW, lane);
        cvt_family(A.in[I_MOEDN], (size_t)3584 * 1024, 16, 1024, 3584, 32, MAP_ID, 0, (bf16_t*)(ws + W_MDN), (size_t)1024 * 3584, scr, gw, NGW, lane);
    }
}

template <bool ROUTER>
__device__ __forceinline__ void norm_phase(const Args& A, LAS unsigned char* lds, int bid, int G, const float* xsrc, float* xdst, const float* gain, const float* modl  , int which,
                                           bool combine, const float* modprev  , bool nonorm, const float* router) {
    int tid_ = threadIdx.x; asm volatile("" : "+v"(tid_));
    const int tid = tid_, lane = tid & 63, wave = tid >> 6;
    unsigned char* ws = A.ws;
    bf16_t* HM = (bf16_t*)(ws + WS_HM);
    const int* slot = (const int*)(ws + TB_SLOT); const float* gts = (const float*)(ws + TB_GATE);
    const bf16_t* Y = (const bf16_t*)(ws + E_XS);
    LAS int* hist = (LAS int*)lds;
    for (int tb = bid; tb < MTOK / 256; tb += G) {
        const int b = tb >> 5;
        f32x4 ga[4], sh[4], g2[4];
#pragma unroll
        for (int j = 0; j < 4; ++j) { const int c = 256 * j + 4 * lane;
            if (!nonorm) { const f32x4 gv = *(const f32x4*)(gain + c), sv = *(const f32x4*)(modl + (size_t)b * 6144 + (which * 3 + 1) * 1024 + c);
                ga[j] = gv * (sv + 1.0f); sh[j] = *(const f32x4*)(modl + (size_t)b * 6144 + (which * 3) * 1024 + c); }
            if (combine) g2[j] = *(const f32x4*)(modprev + (size_t)b * 6144 + 5 * 1024 + c); }
        f32x4 rw[ROUTER ? 32 : 1];
        if constexpr (ROUTER) {
            if (tid < 8) hist[tid] = 0;
#pragma unroll
            for (int j = 0; j < 4; ++j)
#pragma unroll
                for (int i = 0; i < 4; ++i) { const int c = 256 * j + 4 * lane + i; rw[(j * 4 + i) * 2] = *(const f32x4*)(router + c * 8); rw[(j * 4 + i) * 2 + 1] = *(const f32x4*)(router + c * 8 + 4); }
            __syncthreads();
        }
        for (int i = 0; i < 32; ++i) {
            const int row = tb * 256 + wave * 32 + i;
            const float* xr = xsrc + (size_t)row * DM;
            f32x4 v[4];
#pragma unroll
            for (int j = 0; j < 4; ++j) v[j] = *(const f32x4*)(xr + 256 * j + 4 * lane);
            if (combine) {
                const int s0 = slot[row * 2], s1 = slot[row * 2 + 1]; const float w0 = gts[row * 2], w1 = gts[row * 2 + 1];
#pragma unroll
                for (int j = 0; j < 4; ++j) { const u32x2 a = *(const u32x2*)(Y + (size_t)s0 * DM + 256 * j + 4 * lane), c2 = *(const u32x2*)(Y + (size_t)s1 * DM + 256 * j + 4 * lane);
                    f32x4 y; y[0] = w0 * bflo(a.x) + w1 * bflo(c2.x); y[1] = w0 * bfhi(a.x) + w1 * bfhi(c2.x); y[2] = w0 * bflo(a.y) + w1 * bflo(c2.y); y[3] = w0 * bfhi(a.y) + w1 * bfhi(c2.y);
                    v[j] = v[j] + g2[j] * y; *(f32x4*)(xdst + (size_t)row * DM + 256 * j + 4 * lane) = v[j]; }
            }
            if (nonorm) continue;
            float ss = 0.f;
#pragma unroll
            for (int j = 0; j < 4; ++j) ss += (v[j][0] * v[j][0] + v[j][1] * v[j][1]) + (v[j][2] * v[j][2] + v[j][3] * v[j][3]);
            ss = wave_sum(ss);
            const float rstd = 1.0f / sqrtf(ss * (1.0f / DM) + EPS);
            f32x4 h[4];
#pragma unroll
            for (int j = 0; j < 4; ++j) { h[j] = v[j] * rstd * ga[j] + sh[j];
                u32x2 w; w.x = cvt_pk_bf16(h[j][0], h[j][1]); w.y = cvt_pk_bf16(h[j][2], h[j][3]);
                *(u32x2*)(HM + (size_t)row * DM + 256 * j + 4 * lane) = w; }
            if constexpr (ROUTER) {
                float lg[8];
#pragma unroll
                for (int e = 0; e < 8; ++e) lg[e] = 0.f;
#pragma unroll
                for (int j = 0; j < 4; ++j)
#pragma unroll
                    for (int q = 0; q < 4; ++q) { const float hv = h[j][q]; const f32x4 r0 = rw[(j * 4 + q) * 2], r1 = rw[(j * 4 + q) * 2 + 1];
                        lg[0] += hv * r0[0]; lg[1] += hv * r0[1]; lg[2] += hv * r0[2]; lg[3] += hv * r0[3]; lg[4] += hv * r1[0]; lg[5] += hv * r1[1]; lg[6] += hv * r1[2]; lg[7] += hv * r1[3]; }
#pragma unroll
                for (int e = 0; e < 8; ++e) lg[e] = wave_sum(lg[e]);
                int e0 = 0; float v0 = lg[0];
#pragma unroll
                for (int e = 1; e < 8; ++e) if (lg[e] > v0) { v0 = lg[e]; e0 = e; }
                int e1 = -1; float v1 = -3.0e38f;
#pragma unroll
                for (int e = 0; e < 8; ++e) if (e != e0 && lg[e] > v1) { v1 = lg[e]; e1 = e; }
                const float p1 = frcp(1.0f + fexp(v1 - v0));
                if (lane == 0) { int* eid = (int*)(ws + TB_EID); float* gt = (float*)(ws + TB_GATE);
                    eid[row * 2] = e0; eid[row * 2 + 1] = e1; gt[row * 2] = p1; gt[row * 2 + 1] = 1.0f - p1;
                    atomicAdd((int*)&hist[e0], 1); atomicAdd((int*)&hist[e1], 1); }
            }
        }
        if constexpr (ROUTER) {
            __syncthreads();
            if (tid < 8) ((int*)(ws + TB_BCNT))[tb * 8 + tid] = hist[tid];
            __syncthreads();
        }
    }
}

namespace lru {
constexpr int XCF = 0, XCB = 16384, AA = 24576, UU = 40960;
__device__ __forceinline__ int sw256(int row, int cb) { return row * 256 + (cb ^ ((row & 7) << 4)); }
__device__ __forceinline__ int crow(int r, int hi) { return (r & 3) + 8 * (r >> 2) + 4 * hi; }
template <int MODE>
__device__ __forceinline__ void lru_item(const Args& A, LAS unsigned char* lds, int b, int n, int seg, int dir) {
    int tid_ = threadIdx.x; asm volatile("" : "+v"(tid_));
    const int tid = tid_, wid = tid >> 6, lane = tid & 63, r = lane & 31, hh = lane >> 5;
    unsigned char* ws = A.ws;
    const bf16_t* XB = (const bf16_t*)(ws + L_XB); const bf16_t* YB = (const bf16_t*)(ws + L_YB); bf16_t* HF = (bf16_t*)(ws + L_HF); bf16_t* HY = (bf16_t*)(ws + L_HY);
    const bf16_t* Wg = (const bf16_t*)(ws + W_LRG) + (size_t)((n * 2 + dir) * 256 + ((r < 16) ? (16 * wid + r) : (128 + 16 * wid + r - 16))) * 128 + 8 * hh;
    bf16x8 bfrag[8];
#pragma unroll
    for (int ks = 0; ks < 8; ++ks) bfrag[ks] = *(const bf16x8*)(Wg + 16 * ks);
    const int cch = n * 128 + 16 * wid + (r & 15);
    const float ba = A.in[I_LRBA][dir * LRUW + cch], bx = A.in[I_LRBX][dir * LRUW + cch], sp = ((const float*)(ws + TB_SP))[dir * LRUW + cch];
    const int ct = tid >> 4, cg = tid & 15, cc0 = n * 128 + 8 * cg;
    float cw[4][8], cb[8];
#pragma unroll
    for (int j = 0; j < 8; ++j) { cb[j] = A.in[I_LRCB][cc0 + j];
#pragma unroll
        for (int w = 0; w < 4; ++w) cw[w][j] = A.in[I_LRCW][w * LRUW + cc0 + j]; }
    float carry = 0.f, P = 1.f;
    if (MODE != 0 && tid < 128) carry = ((const float*)(ws + TB_LCIN))[(size_t)((b * 32 + seg) * 2 + dir) * LRUW + n * 128 + tid];
    for (int si = 0; si < 8; ++si) {
        const int sub = dir ? (7 - si) : si; const int t0 = seg * 256 + sub * 32;
        {
            const int tok = t0 + ct; float xc[8];
#pragma unroll
            for (int j = 0; j < 8; ++j) xc[j] = cb[j];
#pragma unroll
            for (int w = 0; w < 4; ++w) { const int tt = tok - 1 + w;
                if (tt >= 0 && tt < SEQ) { const u32x4 v = *(const u32x4*)(XB + ((size_t)b * SEQ + tt) * LRUW + cc0);
#pragma unroll
                    for (int e = 0; e < 4; ++e) { xc[2 * e] += cw[w][2 * e] * bflo(v[e]); xc[2 * e + 1] += cw[w][2 * e + 1] * bfhi(v[e]); } } }
            *(LAS f32x4*)(lds + XCF + (ct * 128 + 8 * cg) * 4) = (f32x4){xc[0], xc[1], xc[2], xc[3]};
            *(LAS f32x4*)(lds + XCF + (ct * 128 + 8 * cg + 4) * 4) = (f32x4){xc[4], xc[5], xc[6], xc[7]};
            *(LAS u32x4*)(lds + XCB + sw256(ct, 16 * cg)) = (u32x4){cvt_pk_bf16(xc[0], xc[1]), cvt_pk_bf16(xc[2], xc[3]), cvt_pk_bf16(xc[4], xc[5]), cvt_pk_bf16(xc[6], xc[7])};
        }
        __syncthreads();
        {
            f32x16 acc = {};
#pragma unroll
            for (int ks = 0; ks < 8; ++ks) { const bf16x8 fa = *(const LAS bf16x8*)(lds + XCB + sw256(r, (16 * ks + 8 * hh) * 2)); acc = __builtin_amdgcn_mfma_f32_32x32x16_bf16(fa, bfrag[ks], acc, 0, 0, 0); }
#pragma unroll
            for (int q = 0; q < 8; ++q) {
                const float send = (r < 16) ? acc[8 + q] : acc[q]; const float recv = __shfl_xor(send, 16);
                const float rp = (r < 16) ? acc[q] : recv, ip = (r < 16) ? recv : acc[8 + q];
                const int tq = crow((r < 16) ? q : (8 + q), hh); const int cl = 16 * wid + (r & 15);
                const float xcv = ((const LAS float*)(lds + XCF))[tq * 128 + cl];
                const float rg = fsigmoid(rp + ba), ig = fsigmoid(ip + bx); const float la = -8.0f * rg * sp;
                const float av = fexp(la), uv = sqrtf(fmaxf(1.0f - fexp(2.0f * la), 0.f)) * ig * xcv;
                ((LAS float*)(lds + AA))[tq * 128 + cl] = av; ((LAS float*)(lds + UU))[tq * 128 + cl] = uv; }
        }
        __syncthreads();
        if (tid < 128) {
            LAS float* ap = (LAS float*)(lds + AA) + tid; LAS float* up = (LAS float*)(lds + UU) + tid;
            for (int i = 0; i < 32; ++i) { const int t = dir ? (31 - i) : i; const float av = ap[t * 128]; carry = av * carry + up[t * 128]; if (MODE == 0) P *= av; else up[t * 128] = carry; }
        }
        if (MODE != 0) {
            __syncthreads();
            const int tok = t0 + ct; const size_t go = ((size_t)b * SEQ + tok) * LRUW + cc0;
            const f32x4 h0 = *(const LAS f32x4*)(lds + UU + (ct * 128 + 8 * cg) * 4), h1 = *(const LAS f32x4*)(lds + UU + (ct * 128 + 8 * cg + 4) * 4);
            if (MODE == 1) { *(u32x4*)(HF + go) = (u32x4){cvt_pk_bf16(h0[0], h0[1]), cvt_pk_bf16(h0[2], h0[3]), cvt_pk_bf16(h1[0], h1[1]), cvt_pk_bf16(h1[2], h1[3])}; }
            else { const u32x4 f = *(const u32x4*)(HF + go), y = *(const u32x4*)(YB + go);
                *(u32x4*)(HY + go) = (u32x4){cvt_pk_bf16((h0[0] + bflo(f[0])) * bflo(y[0]), (h0[1] + bfhi(f[0])) * bfhi(y[0])), cvt_pk_bf16((h0[2] + bflo(f[1])) * bflo(y[1]), (h0[3] + bfhi(f[1])) * bfhi(y[1])),
                                            cvt_pk_bf16((h1[0] + bflo(f[2])) * bflo(y[2]), (h1[1] + bfhi(f[2])) * bfhi(y[2])), cvt_pk_bf16((h1[2] + bflo(f[3])) * bflo(y[3]), (h1[3] + bfhi(f[3])) * bfhi(y[3]))}; }
        }
        __syncthreads();
    }
    if (MODE == 0 && tid < 128) { float* sm = (float*)(ws + TB_LSUM) + (size_t)(((b * 32 + seg) * 2 + dir) * 2) * LRUW + n * 128 + tid; sm[0] = P; sm[LRUW] = carry; }
}
}
template <int MODE>
__device__ __forceinline__ void lru_phase(const Args& A, LAS unsigned char* lds, int bid, int G) {
    const int nitems = (MODE == 0) ? 5120 : 2560;
    for (int it = bid; it < nitems; it += G) {
        int b, n, seg, dir;
        if (MODE == 0) { dir = it & 1; const int r = it >> 1; seg = r & 31; n = (r >> 5) % 10; b = r / 320; }
        else { dir = MODE - 1; seg = it & 31; n = (it >> 5) % 10; b = it / 320; }
        lru::lru_item<MODE>(A, lds, b, n, seg, dir);
    }
}
__device__ __forceinline__ void lru_carry_phase(const Args& A, int bid, int G) {
    const float* sm = (const float*)(A.ws + TB_LSUM); float* cin = (float*)(A.ws + TB_LCIN);
    for (int idx = bid * NTHR + threadIdx.x; idx < NBATCH * 2 * LRUW; idx += G * NTHR) {
        const int b = idx / (2 * LRUW), r = idx % (2 * LRUW), dir = r / LRUW, ch = r % LRUW; float carry = 0.f;
        for (int i = 0; i < 32; ++i) { const int sg = dir ? (31 - i) : i; const size_t o = (size_t)((b * 32 + sg) * 2 + dir);
            cin[o * LRUW + ch] = carry; carry = sm[o * 2 * LRUW + ch] * carry + sm[o * 2 * LRUW + LRUW + ch]; }
    }
}

__device__ __forceinline__ void place_phase(const Args& A, LAS unsigned char* lds, int bid, int G) {
    int tid_ = threadIdx.x; asm volatile("" : "+v"(tid_));
    const int tid = tid_, lane = tid & 63, wave = tid >> 6; unsigned char* ws = A.ws;
    const int* bcnt = (const int*)(ws + TB_BCNT); const int* eid = (const int*)(ws + TB_EID); int* slot = (int*)(ws + TB_SLOT);
    const bf16_t* HM = (const bf16_t*)(ws + WS_HM); bf16_t* XS = (bf16_t*)(ws + E_XS);
    LAS int* tot = (LAS int*)lds; LAS int* pre = tot + 8; LAS int* rb = tot + 16; LAS int* wcn = tot + 32; LAS int* sl = tot + 64;
    for (int tb = bid; tb < MTOK / 256; tb += G) {
        { int t_ = 0, p_ = 0;
#pragma unroll
            for (int j = 0; j < 4; ++j) { const int blk = lane + 64 * j; const int v = bcnt[blk * 8 + wave]; t_ += v; p_ += (blk < tb) ? v : 0; }
#pragma unroll
            for (int o = 1; o < 64; o <<= 1) { t_ += __shfl_xor(t_, o); p_ += __shfl_xor(p_, o); }
            if (lane == 0) { tot[wave] = t_; pre[wave] = p_; } }
        __syncthreads();
        if (tid == 0) { int acc = 0; for (int e = 0; e < 8; ++e) { rb[e] = acc * 256; if (tb == 0) ((int*)(ws + TB_TILES))[e] = acc; acc += (tot[e] + 255) >> 8; } if (tb == 0) ((int*)(ws + TB_TILES))[8] = acc; }
        int e0 = -1, e1 = -1; unsigned long long mk0 = 0, mk1 = 0;
        if (tid < 256) { e0 = eid[(tb * 256 + tid) * 2]; e1 = eid[(tb * 256 + tid) * 2 + 1];
#pragma unroll
            for (int e = 0; e < 8; ++e) { const unsigned long long m = __ballot(e0 == e || e1 == e); if (lane == 0) wcn[wave * 8 + e] = __popcll(m); if (e0 == e) mk0 = m; if (e1 == e) mk1 = m; } }
        __syncthreads();
        if (tid < 256) { const unsigned long long lt = (1ull << lane) - 1ull; int b0 = rb[e0] + pre[e0] + __popcll(mk0 & lt), b1 = rb[e1] + pre[e1] + __popcll(mk1 & lt);
            for (int w = 0; w < wave; ++w) { b0 += wcn[w * 8 + e0]; b1 += wcn[w * 8 + e1]; }
            sl[tid * 2] = b0; sl[tid * 2 + 1] = b1; slot[(tb * 256 + tid) * 2] = b0; slot[(tb * 256 + tid) * 2 + 1] = b1; }
        __syncthreads();
        for (int i = 0; i < 32; ++i) { const int t = wave * 32 + i; const int s0 = sl[t * 2], s1 = sl[t * 2 + 1];
            const bf16_t* src = HM + (size_t)(tb * 256 + t) * DM + lane * 8;
            const u32x4 a = *(const u32x4*)src, b = *(const u32x4*)(src + 512);
            *(u32x4*)(XS + (size_t)s0 * DM + lane * 8) = a; *(u32x4*)(XS + (size_t)s0 * DM + lane * 8 + 512) = b;
            *(u32x4*)(XS + (size_t)s1 * DM + lane * 8) = a; *(u32x4*)(XS + (size_t)s1 * DM + lane * 8 + 512) = b; }
        __syncthreads();
    }
}

namespace att {
constexpr int KVBLK = 64;
constexpr int SHM_V = KVBLK * 128 * 2, SHM_K = KVBLK * 128 * 2;
#define KSWZ(row, colB) ((row) * 256 + ((colB) ^ (((row) & 7) << 4)))
#define SBAR() __builtin_amdgcn_sched_barrier(0)
__device__ __forceinline__ int crow(int r, int hi) { return (r & 3) + 8 * (r >> 2) + 4 * hi; }
__device__ __forceinline__ int v_st(int k, int c) { const int kk = (k & ~0xC) | ((k & 4) << 1) | ((k & 8) >> 1); return ((kk >> 3) * 4 + (c >> 5)) * 512 + ((kk & 7) * 32 + (c & 31)) * 2; }
__device__ __forceinline__ int v_rd_base(int lane) { return ((lane & 3) << 3) | (((lane >> 2) & 3) << 6) | (((lane >> 4) & 1) << 5) | (((lane >> 5) & 1) << 8); }
constexpr int v_rd_off(int d0, int ks, int half) { return d0 * 512 + ks * 4096 + half * 2048; }
template <int OFF> __device__ __forceinline__ s16x4 tr_read(int vb) {
    s16x4 r; asm volatile("ds_read_b64_tr_b16 %0, %1 offset:%2" : "=&v"(r) : "v"(vb), "i"(OFF) : "memory"); return r;
}
template <int D0> __device__ __forceinline__ void pv_one(f32x16& od, int vb, bf16x8 pa0, bf16x8 pa1, bf16x8 pa2, bf16x8 pa3) {
    const s16x4 l0 = tr_read<v_rd_off(D0, 0, 0)>(vb), h0 = tr_read<v_rd_off(D0, 0, 1)>(vb), l1 = tr_read<v_rd_off(D0, 1, 0)>(vb), h1 = tr_read<v_rd_off(D0, 1, 1)>(vb);
    const s16x4 l2 = tr_read<v_rd_off(D0, 2, 0)>(vb), h2 = tr_read<v_rd_off(D0, 2, 1)>(vb), l3 = tr_read<v_rd_off(D0, 3, 0)>(vb), h3 = tr_read<v_rd_off(D0, 3, 1)>(vb);
    asm volatile("s_waitcnt lgkmcnt(0)" ::: "memory"); SBAR();
#define PK(L, H) (bf16x8){L[0], L[1], L[2], L[3], H[0], H[1], H[2], H[3]}
    od = __builtin_amdgcn_mfma_f32_32x32x16_bf16(pa0, PK(l0, h0), od, 0, 0, 0);
    od = __builtin_amdgcn_mfma_f32_32x32x16_bf16(pa1, PK(l1, h1), od, 0, 0, 0);
    od = __builtin_amdgcn_mfma_f32_32x32x16_bf16(pa2, PK(l2, h2), od, 0, 0, 0);
    od = __builtin_amdgcn_mfma_f32_32x32x16_bf16(pa3, PK(l3, h3), od, 0, 0, 0);
#undef PK
}
__device__ __forceinline__ void pv_d0(f32x16* o, int vb, bf16x8 pa0, bf16x8 pa1, bf16x8 pa2, bf16x8 pa3) {
    pv_one<0>(o[0], vb, pa0, pa1, pa2, pa3); pv_one<1>(o[1], vb, pa0, pa1, pa2, pa3); pv_one<2>(o[2], vb, pa0, pa1, pa2, pa3); pv_one<3>(o[3], vb, pa0, pa1, pa2, pa3);
}
__device__ __forceinline__ void partialSM(f32x16& p0, f32x16& p1, float Mc) {
#pragma unroll
    for (int r = 0; r < 16; ++r) p0[r] = fexp2(p0[r] - Mc);
#pragma unroll
    for (int r = 0; r < 16; ++r) p1[r] = p1[r] - Mc;
}
__device__ __forceinline__ void finishSM(f32x16& p0, f32x16& p1, float& l_reg, bf16x8& pa0, bf16x8& pa1, bf16x8& pa2, bf16x8& pa3) {
#pragma unroll
    for (int r = 0; r < 16; ++r) p1[r] = fexp2(p1[r]);
    float ps = 0;
#pragma unroll
    for (int r = 0; r < 16; ++r) ps += p0[r];
#pragma unroll
    for (int r = 0; r < 16; ++r) ps += p1[r];
    { auto rr = __builtin_amdgcn_permlane32_swap(__float_as_uint(ps), __float_as_uint(ps), false, false);
      ps = __uint_as_float(rr[0]) + __uint_as_float(rr[1]); }
    l_reg += ps;
#define PK4(P, BASE, OUT) do { unsigned a0 = cvt_pk_bf16(P[BASE + 0], P[BASE + 1]), a1 = cvt_pk_bf16(P[BASE + 2], P[BASE + 3]);   \
    unsigned b0 = cvt_pk_bf16(P[BASE + 4], P[BASE + 5]), b1 = cvt_pk_bf16(P[BASE + 6], P[BASE + 7]);                              \
    auto r0 = __builtin_amdgcn_permlane32_swap(a0, b0, false, false); auto r1 = __builtin_amdgcn_permlane32_swap(a1, b1, false, false); \
    u32x4 w = {r0[0], r1[0], r0[1], r1[1]}; OUT = *reinterpret_cast<bf16x8*>(&w); } while (0)
    PK4(p0, 0, pa0); PK4(p0, 8, pa1); PK4(p1, 0, pa2); PK4(p1, 8, pa3);
#undef PK4
}
__device__ __forceinline__ void qkt(f32x16& p0, f32x16& p1, const LAS char* Ks, const bf16x8* qr, int r32, int hi, int jj) {
    p0 = f32x16{}; p1 = f32x16{};
#pragma unroll
    for (int d0 = 0; d0 < 4; ++d0) { const int cb = ((jj * 4 + d0) * 16 + hi * 8) * 2;
        const bf16x8 b0 = *(const LAS bf16x8*)(Ks + KSWZ(r32, cb));
        const bf16x8 b1 = *(const LAS bf16x8*)(Ks + KSWZ(32 + r32, cb));
        p0 = __builtin_amdgcn_mfma_f32_32x32x16_bf16(b0, qr[d0], p0, 0, 0, 0);
        p1 = __builtin_amdgcn_mfma_f32_32x32x16_bf16(b1, qr[d0], p1, 0, 0, 0); }
}
__device__ __forceinline__ void attn_unit(const bf16_t* __restrict__ Qb, const bf16_t* __restrict__ Kh, const bf16_t* __restrict__ Vh, bf16_t* __restrict__ Ob,
                                          float lamv, float Mc, const float* __restrict__ subg, float omli, LAS char* lds) {
    int tid_ = threadIdx.x; asm volatile("" : "+v"(tid_));
    const int tid = tid_, wid = tid >> 6, lane = tid & 63, r32 = lane & 31, hi = lane >> 5, jj = wid >> 2, wq = wid & 3;
    LAS char* V_lds = lds; LAS char* K_lds = lds + 2 * SHM_V;
    LAS float* li_l = (LAS float*)(lds + 2 * SHM_V + 2 * SHM_K) + wid * 64;
    float l_reg = 0; f32x16 o[4] = {}; bf16x8 qr[4];
    const bf16_t* Qw = Qb + (size_t)(wq * 32 + r32) * DM + jj * 64 + hi * 8;
#pragma unroll
    for (int d0 = 0; d0 < 4; ++d0) qr[d0] = *(const bf16x8*)(Qw + d0 * 16);
    const int sr = tid >> 4, sc = (tid & 15) * 8, vst0 = v_st(sr, sc), vst1 = v_st(32 + sr, sc);
    const int vb0 = (int)(uintptr_t)V_lds + v_rd_base(lane);
    struct { bf16x8 vs0, vs1, ks0, ks1; } sr_[2];
#define SLOAD(i, k0) do { sr_[i].vs0 = *(const bf16x8*)(&Vh[(size_t)((k0) + sr) * DM + sc]); sr_[i].vs1 = *(const bf16x8*)(&Vh[(size_t)((k0) + 32 + sr) * DM + sc]); \
    sr_[i].ks0 = *(const bf16x8*)(&Kh[(size_t)((k0) + sr) * DM + sc]); sr_[i].ks1 = *(const bf16x8*)(&Kh[(size_t)((k0) + 32 + sr) * DM + sc]); } while (0)
#define SWRITE(b, i) do { *(LAS bf16x8*)(V_lds + (b) * SHM_V + vst0) = sr_[i].vs0;          \
    *(LAS bf16x8*)(V_lds + (b) * SHM_V + vst1) = sr_[i].vs1; const int kc = sc * 2;               \
    *(LAS bf16x8*)(K_lds + (b) * SHM_K + KSWZ(sr, kc)) = sr_[i].ks0;                       \
    *(LAS bf16x8*)(K_lds + (b) * SHM_K + KSWZ(32 + sr, kc)) = sr_[i].ks1; } while (0)
#define SWAIT() asm volatile("s_waitcnt vmcnt(4)" ::: "memory")
    f32x16 pA0, pA1, pB0, pB1; bf16x8 pa0, pa1, pa2, pa3; constexpr int NT = SEQ / KVBLK;
    constexpr int SE = 0, SO = 1;
    SLOAD(SE, 0); asm volatile("s_waitcnt vmcnt(0)" ::: "memory"); SWRITE(0, SE); __syncthreads();
    qkt(pA0, pA1, K_lds, qr, r32, hi, jj); partialSM(pA0, pA1, Mc);
    SLOAD(SO, KVBLK); SLOAD(SE, 2 * KVBLK);
    SWAIT(); SWRITE(1, SO); __syncthreads();
    for (int j = 1; j + 1 < NT; j += 2) {
        SBAR(); qkt(pB0, pB1, K_lds + SHM_K, qr, r32, hi, jj);
        finishSM(pA0, pA1, l_reg, pa0, pa1, pa2, pa3); SBAR();
        SLOAD(SO, (j + 2) * KVBLK); SBAR();
        pv_d0(o, vb0, pa0, pa1, pa2, pa3); partialSM(pB0, pB1, Mc);
        __syncthreads(); SWAIT(); SWRITE(0, SE);
        __syncthreads();
        SBAR(); qkt(pA0, pA1, K_lds, qr, r32, hi, jj);
        finishSM(pB0, pB1, l_reg, pa0, pa1, pa2, pa3); SBAR();
        if (j + 3 < NT) SLOAD(SE, (j + 3) * KVBLK); SBAR();
        pv_d0(o, vb0 + SHM_V, pa0, pa1, pa2, pa3); partialSM(pA0, pA1, Mc);
        __syncthreads(); SWAIT(); SWRITE(1, SO);
        __syncthreads();
    }
    SBAR(); qkt(pB0, pB1, K_lds + SHM_K, qr, r32, hi, jj);
    finishSM(pA0, pA1, l_reg, pa0, pa1, pa2, pa3); SBAR();
    pv_d0(o, vb0, pa0, pa1, pa2, pa3); partialSM(pB0, pB1, Mc);
    __syncthreads();
    finishSM(pB0, pB1, l_reg, pa0, pa1, pa2, pa3); SBAR();
    pv_d0(o, vb0 + SHM_V, pa0, pa1, pa2, pa3);
    int r32e = r32, hie = hi; asm volatile("" : "+v"(r32e), "+v"(hie));
#define r32 r32e
#define hi hie
    if (hi == 0) li_l[r32] = l_reg; asm volatile("s_waitcnt lgkmcnt(0)" ::: "memory");
    float rli[16];
#pragma unroll
    for (int r = 0; r < 16; ++r) rli[r] = frcp(li_l[crow(r, hi)]);
    __syncthreads();
    LAS float* Cb = (LAS float*)lds;
    if (jj == 1) {
#pragma unroll
        for (int r = 0; r < 16; ++r) { const float s = rli[r] * lamv;
#pragma unroll
            for (int d0 = 0; d0 < 4; ++d0) Cb[(wq * 32 + crow(r, hi)) * 128 + d0 * 32 + r32] = o[d0][r] * s; }
    }
    __syncthreads();
    if (jj == 0) {
        float g[4];
#pragma unroll
        for (int d0 = 0; d0 < 4; ++d0) g[d0] = subg[d0 * 32 + r32] * omli;
#pragma unroll
        for (int r = 0; r < 16; ++r) {
            float ss = 0.f;
#pragma unroll
            for (int d0 = 0; d0 < 4; ++d0) { const float v = o[d0][r] * rli[r] - Cb[(wq * 32 + crow(r, hi)) * 128 + d0 * 32 + r32]; o[d0][r] = v; ss += v * v; }
            ss += __shfl_xor(ss, 1); ss += __shfl_xor(ss, 2); ss += __shfl_xor(ss, 4); ss += __shfl_xor(ss, 8); ss += __shfl_xor(ss, 16);
            const float rs = 1.0f / sqrtf(ss * (1.0f / 128.0f) + EPS);
            bf16_t* op = Ob + (size_t)(wq * 32 + crow(r, hi)) * DM + r32;
#pragma unroll
            for (int d0 = 0; d0 < 4; ++d0) op[d0 * 32] = (bf16_t)f2bf(o[d0][r] * rs * g[d0]);
        }
    }
    __syncthreads();
#undef r32
#undef hi
#undef SLOAD
#undef SWRITE
#undef SWAIT
}
}

__device__ __forceinline__ void attn_phase(const Args& A, LAS unsigned char* lds, int bid, int G, int al) {
    unsigned char* ws = A.ws;
    const bf16_t* Q = (const bf16_t*)(ws + A_Q); const bf16_t* K = (const bf16_t*)(ws + A_K); const bf16_t* V = (const bf16_t*)(ws + A_V);
    bf16_t* O = (bf16_t*)(ws + WS_HM);
    const float* scal = (const float*)(ws + TB_SCAL);
    const float lamv = scal[SC_LAM0 + al], omli = scal[SC_OML0 + al], Mc = scal[SC_MC0 + al];
    const float* subg = A.in[I_ATSUB] + al * 128;
    const int x = bid & 7, c = bid >> 3;
    for (int i = 0; i < 16; ++i) {
        const int bh = x * 8 + (i >> 1), qb = (i & 1) * 32 + c;
        const int b = bh >> 3, h = bh & 7;
        const size_t base = (size_t)b * SEQ * DM + h * 128;
        att::attn_unit(Q + base + (size_t)qb * 128 * DM, K + base, V + base, O + base + (size_t)qb * 128 * DM, lamv, Mc, subg, omli, (LAS char*)lds);
    }
}

namespace gla {
constexpr int BC = 0, QI = 32768, QA = 49152, KA = 65536, KST = 81920, VT = 98304, ST = 106496, AT = 122880, EM = 131072, EL = EM + 512, DD = EM + 1024, BMID = EM + 1536, SEG = EM + 2048;
static_assert(SEG + 2048 <= RING_BYTES, "gla lds");
__device__ __forceinline__ int sw256(int row, int cb) { return row * 256 + (cb ^ ((row & 7) << 4)); }
__device__ __forceinline__ int sw128(int row, int cb) { return row * 128 + (cb ^ ((row & 7) << 4)); }
__device__ __forceinline__ int crow(int r, int hi) { return (r & 3) + 8 * (r >> 2) + 4 * hi; }
__device__ __forceinline__ float h2f(unsigned short b) { return (float)__builtin_bit_cast(_Float16, b); }
__device__ __forceinline__ void gla_item(const bf16_t* __restrict__ Qp, const unsigned short* __restrict__ LFp, const bf16_t* __restrict__ Vp, bf16_t* __restrict__ Op, int dir, LAS unsigned char* lds, float* dbg) {
    int tid_ = threadIdx.x; asm volatile("" : "+v"(tid_));
    const int tid = tid_, wid = tid >> 6, lane = tid & 63, r = lane & 31, hh = lane >> 5;
    const int t1 = tid >> 3, kg = tid & 7, k0 = 16 * kg, v0 = (tid & 7) * 8;
    for (int i = tid; i < 16384 / 16; i += NTHR) *(LAS u32x4*)(lds + ST + i * 16) = (u32x4){0u, 0u, 0u, 0u};
    f32x16 st = {};
    u32x4 rq[2], rl[2], rv;
#define GLA_TOK(ci, i) (dir ? (SEQ - 1 - ((ci) * 64 + (i))) : ((ci) * 64 + (i)))
#define GLA_LOAD(ci) do { const size_t to = (size_t)GLA_TOK(ci, t1) * DM; \
        rq[0] = *(const u32x4*)(Qp + to + k0); rq[1] = *(const u32x4*)(Qp + to + k0 + 8); \
        rl[0] = *(const u32x4*)(LFp + to + k0); rl[1] = *(const u32x4*)(LFp + to + k0 + 8); rv = *(const u32x4*)(Vp + to + v0); } while (0)
    GLA_LOAD(0);
    __syncthreads();
    for (int ci = 0; ci < SEQ / 64; ++ci) {
        float qf[16], lf[16]; u32x4 vreg = rv;
#pragma unroll
        for (int j = 0; j < 2; ++j)
#pragma unroll
            for (int e = 0; e < 4; ++e) { qf[j * 8 + 2 * e] = bflo(rq[j][e]); qf[j * 8 + 2 * e + 1] = bfhi(rq[j][e]);
                lf[j * 8 + 2 * e] = h2f((unsigned short)(rl[j][e] & 0xffffu)); lf[j * 8 + 2 * e + 1] = h2f((unsigned short)(rl[j][e] >> 16)); }
        if (ci + 1 < SEQ / 64) GLA_LOAD(ci + 1);
#pragma unroll
        for (int j = 0; j < 4; ++j) *(LAS f32x4*)(lds + BC + (t1 * 128 + k0 + 4 * j) * 4) = (f32x4){lf[4 * j], lf[4 * j + 1], lf[4 * j + 2], lf[4 * j + 3]};
        __syncthreads();
        { const int kc = tid & 127, sg = tid >> 7; LAS float* bc = (LAS float*)(lds + BC) + kc; float run = 0.f;
#pragma unroll
            for (int i = 0; i < 16; ++i) { const int t = sg * 16 + i; run += bc[t * 128]; bc[t * 128] = run; }
            ((LAS float*)(lds + SEG))[sg * 128 + kc] = run;
            __syncthreads();
            const LAS float* sgp = (const LAS float*)(lds + SEG) + kc; const float s0 = sgp[0], s1 = sgp[128], s2 = sgp[256], s3 = sgp[384];
            const float off = sg == 0 ? 0.f : sg == 1 ? s0 : sg == 2 ? (s0 + s1) : ((s0 + s1) + s2);
            if (sg != 0) {
#pragma unroll
                for (int i = 0; i < 16; ++i) { const int t = sg * 16 + i; bc[t * 128] += off; } }
            else { const float bm = s0 + s1, bl = ((s0 + s1) + s2) + s3;
                ((LAS float*)(lds + BMID))[kc] = bm; ((LAS float*)(lds + EM))[kc] = fexp(bm); ((LAS float*)(lds + EL))[kc] = fexp(bl - bm); ((LAS float*)(lds + DD))[kc] = fexp(bl); }
            __syncthreads();
        }
#ifdef DIAG
        if (dbg && ci == 0) { for (int i = tid; i < 8192; i += NTHR) dbg[i] = ((const LAS float*)(lds + BC))[i]; }
#endif
        {
            unsigned wqi[8], wqa[8], wka[8]; float ksv[16];
#pragma unroll
            for (int j = 0; j < 4; ++j) {
                const f32x4 bt = *(const LAS f32x4*)(lds + BC + (t1 * 128 + k0 + 4 * j) * 4), bm = *(const LAS f32x4*)(lds + BMID + (k0 + 4 * j) * 4);
                const f32x4 em = *(const LAS f32x4*)(lds + EM + (k0 + 4 * j) * 4), el = *(const LAS f32x4*)(lds + EL + (k0 + 4 * j) * 4);
                float qi[4], qa[4], ka[4];
#pragma unroll
                for (int e = 0; e < 4; ++e) { const int i = 4 * j + e; const float e1 = fexp(bt[e] - bm[e]), r1 = frcp(e1);
                    qa[e] = qf[i] * e1; qi[e] = qa[e] * em[e]; const float kk = 1.0f - fexp(lf[i]); ka[e] = kk * r1; ksv[i] = ka[e] * el[e]; }
                wqi[2 * j] = cvt_pk_bf16(qi[0], qi[1]); wqi[2 * j + 1] = cvt_pk_bf16(qi[2], qi[3]);
                wqa[2 * j] = cvt_pk_bf16(qa[0], qa[1]); wqa[2 * j + 1] = cvt_pk_bf16(qa[2], qa[3]);
                wka[2 * j] = cvt_pk_bf16(ka[0], ka[1]); wka[2 * j + 1] = cvt_pk_bf16(ka[2], ka[3]);
            }
#pragma unroll
            for (int j = 0; j < 2; ++j) { const int off = sw256(t1, (k0 + 8 * j) * 2);
                *(LAS u32x4*)(lds + QI + off) = (u32x4){wqi[4 * j], wqi[4 * j + 1], wqi[4 * j + 2], wqi[4 * j + 3]};
                *(LAS u32x4*)(lds + QA + off) = (u32x4){wqa[4 * j], wqa[4 * j + 1], wqa[4 * j + 2], wqa[4 * j + 3]};
                *(LAS u32x4*)(lds + KA + off) = (u32x4){wka[4 * j], wka[4 * j + 1], wka[4 * j + 2], wka[4 * j + 3]}; }
#pragma unroll
            for (int i = 0; i < 16; ++i) *(LAS unsigned short*)(lds + KST + sw128(k0 + i, t1 * 2)) = (unsigned short)f2bf(ksv[i]);
#pragma unroll
            for (int e = 0; e < 4; ++e) { *(LAS unsigned short*)(lds + VT + sw128(v0 + 2 * e, t1 * 2)) = (unsigned short)(vreg[e] & 0xffffu);
                *(LAS unsigned short*)(lds + VT + sw128(v0 + 2 * e + 1, t1 * 2)) = (unsigned short)(vreg[e] >> 16); }
        }
        __syncthreads();
        f32x16 oacc = {};
        const int w4 = wid & 3, t_i = w4 >> 1, v_i = w4 & 1;
        if (wid < 4) {
            const int s_i = wid >> 1, tq = wid & 1; f32x16 a = {};
#pragma unroll
            for (int ks = 0; ks < 8; ++ks) { const bf16x8 fa = *(const LAS bf16x8*)(lds + KA + sw256(32 * s_i + r, (16 * ks + 8 * hh) * 2)), fb = *(const LAS bf16x8*)(lds + QA + sw256(32 * tq + r, (16 * ks + 8 * hh) * 2));
                a = __builtin_amdgcn_mfma_f32_32x32x16_bf16(fa, fb, a, 0, 0, 0); }
            const int tg = 32 * tq + r;
#pragma unroll
            for (int g = 0; g < 4; ++g) { float m[4];
#pragma unroll
                for (int e = 0; e < 4; ++e) { const int sgl = 32 * s_i + 8 * g + 4 * hh + e; m[e] = (sgl <= tg) ? a[4 * g + e] : 0.f; }
                *(LAS u32x2*)(lds + AT + sw128(tg, (32 * s_i + 8 * g + 4 * hh) * 2)) = (u32x2){cvt_pk_bf16(m[0], m[1]), cvt_pk_bf16(m[2], m[3])}; }
        } else {
#pragma unroll
            for (int ks = 0; ks < 8; ++ks) { const bf16x8 fa = *(const LAS bf16x8*)(lds + QI + sw256(32 * t_i + r, (16 * ks + 8 * hh) * 2)), fb = *(const LAS bf16x8*)(lds + ST + sw256(32 * v_i + r, (16 * ks + 8 * hh) * 2));
                oacc = __builtin_amdgcn_mfma_f32_32x32x16_bf16(fa, fb, oacc, 0, 0, 0); }
        }
        __syncthreads();
#ifdef DIAG
        if (dbg && ci == 0) { for (int i = tid; i < 2048; i += NTHR) { ((unsigned*)dbg)[8192 + i] = ((const LAS unsigned*)(lds + AT))[i]; ((unsigned*)dbg)[8192 + 2048 + i] = ((const LAS unsigned*)(lds + VT))[i]; } }
#endif
        if (wid >= 4) {
#pragma unroll
            for (int ks = 0; ks < 4; ++ks) { const bf16x8 fa = *(const LAS bf16x8*)(lds + AT + sw128(32 * t_i + r, (16 * ks + 8 * hh) * 2)), fb = *(const LAS bf16x8*)(lds + VT + sw128(32 * v_i + r, (16 * ks + 8 * hh) * 2));
                oacc = __builtin_amdgcn_mfma_f32_32x32x16_bf16(fa, fb, oacc, 0, 0, 0); }
#pragma unroll
            for (int i = 0; i < 16; ++i) { const int t = 32 * t_i + crow(i, hh); Op[(size_t)GLA_TOK(ci, t) * DM + 32 * v_i + r] = (bf16_t)f2bf(oacc[i]); }
        }
        {
            const int kq = wid >> 1, vq = wid & 1;
#pragma unroll
            for (int i = 0; i < 16; ++i) st[i] *= ((const LAS float*)(lds + DD))[32 * kq + crow(i, hh)];
#pragma unroll
            for (int ks = 0; ks < 4; ++ks) { const bf16x8 fa = *(const LAS bf16x8*)(lds + KST + sw128(32 * kq + r, (16 * ks + 8 * hh) * 2)), fb = *(const LAS bf16x8*)(lds + VT + sw128(32 * vq + r, (16 * ks + 8 * hh) * 2));
                st = __builtin_amdgcn_mfma_f32_32x32x16_bf16(fa, fb, st, 0, 0, 0); }
#pragma unroll
            for (int g = 0; g < 4; ++g) *(LAS u32x2*)(lds + ST + sw256(32 * vq + r, (32 * kq + 8 * g + 4 * hh) * 2)) = (u32x2){cvt_pk_bf16(st[4 * g], st[4 * g + 1]), cvt_pk_bf16(st[4 * g + 2], st[4 * g + 3])};
        }
        __syncthreads();
#ifdef DIAG
        if (dbg && ci == 0) { for (int i = tid; i < 4096; i += NTHR) { ((unsigned*)dbg)[12288 + i] = ((const LAS unsigned*)(lds + ST))[i]; ((unsigned*)dbg)[16384 + i] = ((const LAS unsigned*)(lds + KST))[i]; } }
#endif
    }
#undef GLA_TOK
#undef GLA_LOAD
}
}
__device__ __forceinline__ void gla_phase(const Args& A, LAS unsigned char* lds, int bid, int G) {
    unsigned char* ws = A.ws;
    for (int it = bid; it < 256; it += G) {
        const int b = it >> 5, h = (it >> 2) & 7, dir = (it >> 1) & 1, vh = it & 1;
        const size_t base = (size_t)b * SEQ * DM + h * 128;
        gla::gla_item((const bf16_t*)(ws + H_Q) + base, (const unsigned short*)(ws + (dir ? H_LFB : H_LFF)) + base, (const bf16_t*)(ws + H_V) + base + vh * 64,
                      (bf16_t*)(ws + (dir ? H_OB : H_OF)) + base + vh * 64, dir, lds, it == 0 ? (float*)(ws + TB_LSUM) : nullptr);
    }
}
__device__ __forceinline__ void hg_normo_phase(const Args& A, int bid, int G) {
    int tid_ = threadIdx.x; asm volatile("" : "+v"(tid_));
    const int tid = tid_, lane = tid & 63, wave = tid >> 6; unsigned char* ws = A.ws;
    const bf16_t* OF = (const bf16_t*)(ws + H_OF); const bf16_t* OB = (const bf16_t*)(ws + H_OB); const bf16_t* GG = (const bf16_t*)(ws + H_G); bf16_t* HM = (bf16_t*)(ws + WS_HM);
    const int c0 = (lane >> 3) * 128 + (lane & 7) * 16;
    float ng[16];
#pragma unroll
    for (int i = 0; i < 16; ++i) ng[i] = A.in[I_HGNG][(lane & 7) * 16 + i];
    for (int row = (bid * NWAVES + wave); row < MTOK; row += G * NWAVES) {
        const size_t o = (size_t)row * DM + c0;
        const u32x4 a0 = *(const u32x4*)(OF + o), a1 = *(const u32x4*)(OF + o + 8), b0 = *(const u32x4*)(OB + o), b1 = *(const u32x4*)(OB + o + 8), g0 = *(const u32x4*)(GG + o), g1 = *(const u32x4*)(GG + o + 8);
        float v[16], gt[16]; float ss = 0.f;
#pragma unroll
        for (int e = 0; e < 4; ++e) { v[2 * e] = bflo(a0[e]) + bflo(b0[e]); v[2 * e + 1] = bfhi(a0[e]) + bfhi(b0[e]); v[8 + 2 * e] = bflo(a1[e]) + bflo(b1[e]); v[8 + 2 * e + 1] = bfhi(a1[e]) + bfhi(b1[e]);
            gt[2 * e] = bflo(g0[e]); gt[2 * e + 1] = bfhi(g0[e]); gt[8 + 2 * e] = bflo(g1[e]); gt[8 + 2 * e + 1] = bfhi(g1[e]); }
#pragma unroll
        for (int i = 0; i < 16; ++i) ss += v[i] * v[i];
        ss += __shfl_xor(ss, 1); ss += __shfl_xor(ss, 2); ss += __shfl_xor(ss, 4);
        const float rstd = 1.0f / sqrtf(ss * (1.0f / 128.0f) + EPS);
        u32x4 w0, w1;
#pragma unroll
        for (int e = 0; e < 4; ++e) { w0[e] = cvt_pk_bf16(v[2 * e] * rstd * ng[2 * e] * gt[2 * e], v[2 * e + 1] * rstd * ng[2 * e + 1] * gt[2 * e + 1]);
            w1[e] = cvt_pk_bf16(v[8 + 2 * e] * rstd * ng[8 + 2 * e] * gt[8 + 2 * e], v[8 + 2 * e + 1] * rstd * ng[8 + 2 * e + 1] * gt[8 + 2 * e + 1]); }
        *(u32x4*)(HM + o) = w0; *(u32x4*)(HM + o + 8) = w1;
    }
}

#ifdef DIAG
constexpr int DG_BASE = 8192;
__device__ __forceinline__ void dg_put(const Args& A, int k, float e) { if (!(e >= 0.f) || e > 1e9f) e = 1e9f; atomicMax((unsigned*)(A.ws + WS_CTL) + DG_BASE + 64 * k, __float_as_uint(e)); }
__device__ __forceinline__ float dg_rel(float got, float ref) { return fabsf(got - ref) / (fabsf(ref) + 0.1f); }
__device__ __forceinline__ unsigned dg_hash(unsigned a, unsigned b) { unsigned h = a * 2654435761u + b * 40503u + 0x9e3779b9u; h ^= h >> 15; h *= 2246822519u; h ^= h >> 13; h *= 3266489917u; h ^= h >> 16; return h; }
__device__ __forceinline__ float dg_bfr(float x) { return bflo(f2bf(x)); }
__device__ __forceinline__ void dg_mods(const Args& A, int k) {
    const int lane = threadIdx.x & 63, gwv = blockIdx.x * 8 + (threadIdx.x >> 6);
    const unsigned h = dg_hash(gwv, k); const int l = h & 3, b = (h >> 2) & 7, e = (h >> 5) % 6144;
    float a = 0.f; for (int d = lane; d < DM; d += 64) a += fsilu(A.in[I_C][b * DM + d]) * A.in[I_ADAW][((size_t)l * DM + d) * 6144 + e];
    a = wave_sum(a) + A.in[I_ADAB][l * 6144 + e];
    const float got = ((const float*)(A.ws + TB_MODS))[((size_t)l * NBATCH + b) * 6144 + e];
    if (lane == 0) dg_put(A, k, dg_rel(got, a));
}
__device__ __forceinline__ void dg_norm(const Args& A, int k, const float* x, const float* gain, int L, int which) {
    const int lane = threadIdx.x & 63, gwv = blockIdx.x * 8 + (threadIdx.x >> 6);
    const int row = dg_hash(gwv, k) & (MTOK - 1), b = row >> 13;
    const float* modl = (const float*)(A.ws + TB_MODS) + ((size_t)L * NBATCH + b) * 6144;
    float ss = 0.f; for (int c = lane; c < DM; c += 64) { const float v = x[(size_t)row * DM + c]; ss += v * v; }
    ss = wave_sum(ss); const float rstd = 1.0f / sqrtf(ss / DM + EPS); float e = 0.f;
    for (int c = lane; c < DM; c += 64) { const float ref = x[(size_t)row * DM + c] * rstd * gain[c] * (1.0f + modl[(which * 3 + 1) * 1024 + c]) + modl[(which * 3) * 1024 + c];
        e = fmaxf(e, dg_rel(bf2f(((const bf16_t*)(A.ws + WS_HM))[(size_t)row * DM + c]), ref)); }
    dg_put(A, k, e);
}
__device__ __forceinline__ void dg_qkv(const Args& A, int k, int al) {
    const int lane = threadIdx.x & 63, gwv = blockIdx.x * 8 + (threadIdx.x >> 6);
    const unsigned h = dg_hash(gwv, k); const int row = h & (MTOK - 1), t = (h >> 16) % 48, col = t * 64 + lane;
    const bf16_t* hm = (const bf16_t*)(A.ws + WS_HM) + (size_t)row * DM; const float* w = A.in[I_ATWIN] + (size_t)al * 1024 * 3072 + col;
    float a = 0.f; for (int kk = 0; kk < DM; ++kk) a += bf2f(hm[kk]) * dg_bfr(w[(size_t)kk * 3072]);
    float ref, got;
    if (t < 32) {
        const int part = t >> 4, sh = t & 15; const float ss = wave_sum(a * a); const float rstd = 1.0f / sqrtf(ss / 64.0f + EPS);
        const float y = a * rstd * (part ? A.in[I_ATKN] : A.in[I_ATQN])[al * 64 + lane]; const float yp = __shfl_xor(y, 32);
        const int pos = row & (SEQ - 1); const float cs = ((const float*)(A.ws + TB_COS))[pos * 32 + (lane & 31)], sn = ((const float*)(A.ws + TB_SIN))[pos * 32 + (lane & 31)];
        ref = (lane < 32) ? (y * cs - yp * sn) : (y * cs + yp * sn); if (part == 0) ref *= 0.125f * LOG2E;
        got = bf2f(((const bf16_t*)(A.ws + (part ? A_K : A_Q)))[(size_t)row * DM + sh * 64 + lane]);
    } else { ref = a; got = bf2f(((const bf16_t*)(A.ws + A_V))[(size_t)row * DM + (t - 32) * 64 + lane]); }
    dg_put(A, k, dg_rel(got, ref));
}
__device__ __forceinline__ void dg_attn(const Args& A, int k, int al, LAS unsigned char* lds) {
    const int tid = threadIdx.x; const unsigned h = dg_hash(blockIdx.x, k); const int row = h & (MTOK - 1), hd = (h >> 16) & 7, b = row >> 13;
    const bf16_t* Q = (const bf16_t*)(A.ws + A_Q); const bf16_t* K = (const bf16_t*)(A.ws + A_K); const bf16_t* V = (const bf16_t*)(A.ws + A_V);
    const float* scal = (const float*)(A.ws + TB_SCAL); const float lamv = scal[SC_LAM0 + al], omli = scal[SC_OML0 + al], Mc = scal[SC_MC0 + al];
    LAS float* p0 = (LAS float*)lds; LAS float* p1 = p0 + SEQ; LAS float* red = p1 + SEQ;
    float l0 = 0.f, l1 = 0.f;
    for (int key = tid; key < SEQ; key += NTHR) { const bf16_t* kr = K + ((size_t)b * SEQ + key) * DM + hd * 128; const bf16_t* qr = Q + (size_t)row * DM + hd * 128;
        float s0 = 0.f, s1 = 0.f; for (int d = 0; d < 64; ++d) { s0 += bf2f(qr[d]) * bf2f(kr[d]); s1 += bf2f(qr[64 + d]) * bf2f(kr[64 + d]); }
        const float e0 = fexp2(s0 - Mc), e1 = fexp2(s1 - Mc); p0[key] = e0; p1[key] = e1; l0 += e0; l1 += e1; }
    l0 = wave_sum(l0); l1 = wave_sum(l1); if ((tid & 63) == 0) { red[tid >> 6] = l0; red[8 + (tid >> 6)] = l1; }
    __syncthreads();
    l0 = 0.f; l1 = 0.f; for (int w = 0; w < 8; ++w) { l0 += red[w]; l1 += red[8 + w]; }
    __syncthreads();
    const int dv = tid & 127, part = tid >> 7; float o = 0.f;
    for (int key = part * 2048; key < part * 2048 + 2048; ++key) o += (p0[key] / l0 - lamv * p1[key] / l1) * bf2f(V[((size_t)b * SEQ + key) * DM + hd * 128 + dv]);
    red[16 + part * 128 + dv] = o; __syncthreads();
    if (tid < 128) { o = red[16 + tid] + red[16 + 128 + tid] + red[16 + 256 + tid] + red[16 + 384 + tid]; red[600 + tid] = o * o; }
    __syncthreads();
    if (tid < 128) { float ss = 0.f; for (int i = 0; i < 128; ++i) ss += red[600 + i]; const float ref = o / sqrtf(ss / 128.0f + EPS) * A.in[I_ATSUB][al * 128 + tid] * omli;
        dg_put(A, k, dg_rel(bf2f(((const bf16_t*)(A.ws + WS_HM))[(size_t)row * DM + hd * 128 + tid]), ref)); }
    __syncthreads();
}
__device__ __forceinline__ void dg_save(const Args& A, int k, const float* xold) {
    const int lane = threadIdx.x & 63, gwv = blockIdx.x * 8 + (threadIdx.x >> 6);
    const unsigned h = dg_hash(gwv, k); const int row = h & (MTOK - 1), col = (h >> 16) & 1023;
    float* sv = (float*)(A.ws + TB_LSUM) + 7 * 1024 * 1024 / 4;
    if (lane == 0) sv[k * 4096 + gwv] = xold[(size_t)row * DM + col];
}
__device__ __forceinline__ void dg_res(const Args& A, int k, const float* xnew, const float* gate, const bf16_t* Am, int K, const float* W) {
    const int lane = threadIdx.x & 63, gwv = blockIdx.x * 8 + (threadIdx.x >> 6);
    const unsigned h = dg_hash(gwv, k); const int row = h & (MTOK - 1), col = (h >> 16) & 1023, b = row >> 13;
    const float* sv = (const float*)(A.ws + TB_LSUM) + 7 * 1024 * 1024 / 4;
    float a = 0.f; for (int kk = lane; kk < K; kk += 64) a += bf2f(Am[(size_t)row * K + kk]) * dg_bfr(W[(size_t)kk * DM + col]);
    a = wave_sum(a);
    const float ref = sv[k * 4096 + gwv] + gate[(size_t)b * 6144 + col] * a;
    if (lane == 0) dg_put(A, k, dg_rel(xnew[(size_t)row * DM + col], ref));
}
__device__ __forceinline__ void dg_swiglu(const Args& A, int k, const bf16_t* Am, const float* W, int F, const bf16_t* H, int nrows, const int* rowmap) {
    const int lane = threadIdx.x & 63, gwv = blockIdx.x * 8 + (threadIdx.x >> 6);
    const unsigned h = dg_hash(gwv, k); const int row = (h & 0xfffff) % nrows, j = (h >> 20) % F;
    float g = 0.f, u = 0.f; for (int kk = lane; kk < DM; kk += 64) { const float x = bf2f(Am[(size_t)row * DM + kk]); g += x * dg_bfr(W[(size_t)kk * 2 * F + j]); u += x * dg_bfr(W[(size_t)kk * 2 * F + F + j]); }
    g = wave_sum(g); u = wave_sum(u);
    const float ref = g / (1.0f + expf(-g)) * u;
    if (lane == 0) dg_put(A, k, dg_rel(bf2f(H[(size_t)row * F + j]), ref));
}
__device__ __forceinline__ void dg_hgin(const Args& A, int k) {
    const int lane = threadIdx.x & 63, gwv = blockIdx.x * 8 + (threadIdx.x >> 6);
    const unsigned h = dg_hash(gwv, k); const int row = h & (MTOK - 1), col = (h >> 16) % 5120, grp = col >> 10, cc = col & 1023;
    float a = 0.f; for (int kk = lane; kk < DM; kk += 64) a += bf2f(((const bf16_t*)(A.ws + WS_HM))[(size_t)row * DM + kk]) * dg_bfr(A.in[I_HGWIN][(size_t)kk * 5120 + col]);
    a = wave_sum(a);
    float ref, got;
    if (grp == 0 || grp == 4) { ref = a / (1.0f + expf(-a)); got = bf2f(((const bf16_t*)(A.ws + (grp == 0 ? H_Q : H_G)))[(size_t)row * DM + cc]); }
    else if (grp == 3) { ref = a; got = bf2f(((const bf16_t*)(A.ws + H_V))[(size_t)row * DM + cc]); }
    else { const int d = grp - 1; const float* p = A.in[I_HGLB] + (size_t)d * DEPTH * 1024 + cc; float mx = p[0]; for (int l = 1; l < DEPTH; ++l) mx = fmaxf(mx, p[l * 1024]);
        float den = 0.f; for (int l = 0; l < DEPTH; ++l) den += expf(p[l * 1024] - mx); const float lbv = expf(p[1024] - mx) / den;
        ref = logf(lbv + (1.0f - lbv) / (1.0f + expf(-a))); got = gla::h2f(((const unsigned short*)(A.ws + (d ? H_LFB : H_LFF)))[(size_t)row * DM + cc]); }
    if (lane == 0) dg_put(A, k, dg_rel(got, ref));
}
__device__ __forceinline__ void dg_gla(const Args& A, int k) {
    const int lane = threadIdx.x & 63, gwv = blockIdx.x * 8 + (threadIdx.x >> 6);
    const unsigned h = dg_hash(gwv, k); const int sel0 = (gwv & 3) == 0; const int b = sel0 ? 0 : (h & 7), hd = sel0 ? 0 : ((h >> 3) & 7), dir = sel0 ? 0 : ((h >> 6) & 1), vc = sel0 ? ((h >> 7) & 63) : ((h >> 7) & 127);
    const bf16_t* Q = (const bf16_t*)(A.ws + H_Q); const unsigned short* LF = (const unsigned short*)(A.ws + (dir ? H_LFB : H_LFF)); const bf16_t* V = (const bf16_t*)(A.ws + H_V);
    const bf16_t* O = (const bf16_t*)(A.ws + (dir ? H_OB : H_OF));
    float s0 = 0.f, s1 = 0.f, e0 = 0.f, e1 = 0.f, e2 = 0.f, e3 = 0.f;
    for (int i = 0; i < SEQ; ++i) { const int tok = dir ? (SEQ - 1 - i) : i; const size_t o = ((size_t)b * SEQ + tok) * DM + hd * 128;
        const float f0 = expf(gla::h2f(LF[o + lane])), f1 = expf(gla::h2f(LF[o + 64 + lane])), v = bf2f(V[o + vc]);
        s0 = f0 * s0 + (1.0f - f0) * v; s1 = f1 * s1 + (1.0f - f1) * v;
        if (i < 128 || i % 61 == 0) { const float ov = wave_sum(bf2f(Q[o + lane]) * s0 + bf2f(Q[o + 64 + lane]) * s1); const float er = 0.25f * fabsf(bf2f(O[o + vc]) - ov) / (fabsf(ov) + 1.0f);
            if (i == 0) e0 = er; else if (i < 64) e1 = fmaxf(e1, er); else if (i < 128) e2 = fmaxf(e2, er); else e3 = fmaxf(e3, er); } }
    if (lane == 0) { dg_put(A, k, e0); dg_put(A, k + 4, e1); dg_put(A, k + 5, e2); dg_put(A, k + 6, e3); }
    const float* dbg = (const float*)(A.ws + TB_LSUM); const unsigned short* LF0 = (const unsigned short*)(A.ws + H_LFF); const bf16_t* Q0 = (const bf16_t*)(A.ws + H_Q);
    { const unsigned h2 = dg_hash(gwv, k + 100); const int t = h2 & 63, kk = (h2 >> 6) & 127; float c = 0.f; for (int tt = 0; tt <= t; ++tt) c += gla::h2f(LF0[(size_t)tt * DM + kk]);
      if (lane == 0) dg_put(A, k + 1, dg_rel(dbg[t * 128 + kk], c)); }
    { const unsigned h2 = dg_hash(gwv, k + 200); const int t = h2 & 63, sidx = (h2 >> 6) & 63; float a = 0.f;
      if (sidx <= t) { for (int kk = lane; kk < 128; kk += 64) { float c = 0.f; for (int tt = sidx + 1; tt <= t; ++tt) c += gla::h2f(LF0[(size_t)tt * DM + kk]);
              a += bf2f(Q0[(size_t)t * DM + kk]) * (1.0f - expf(gla::h2f(LF0[(size_t)sidx * DM + kk]))) * expf(c); } a = wave_sum(a); }
      const unsigned short got = ((const unsigned short*)(dbg + 8192))[gla::sw128(t, sidx * 2) / 2];
      if (lane == 0) dg_put(A, k + 2, 5.0f * fabsf(bf2f(got) - a) / (fabsf(a) + 0.01f)); }
    { const unsigned h2 = dg_hash(gwv, k + 300); const int sidx = h2 & 63, v = (h2 >> 6) & 63;
      const unsigned short got = ((const unsigned short*)(dbg + 8192 + 2048))[gla::sw128(v, sidx * 2) / 2];
      if (lane == 0) dg_put(A, k + 2, dg_rel(bf2f(got), bf2f(((const bf16_t*)(A.ws + H_V))[(size_t)sidx * DM + v]))); }
    { const unsigned h2 = dg_hash(gwv, k + 500); const int kk = h2 & 127, v = (h2 >> 7) & 63;
      float a = 0.f; { const int sidx = lane; float c = 0.f; for (int tt = sidx + 1; tt < 64; ++tt) c += gla::h2f(LF0[(size_t)tt * DM + kk]);
          const float ksn = (1.0f - expf(gla::h2f(LF0[(size_t)sidx * DM + kk]))) * expf(c);
          const unsigned short gk = ((const unsigned short*)(dbg + 16384))[gla::sw128(kk, sidx * 2) / 2];
          dg_put(A, k + 2, 0.5f * fabsf(bf2f(gk) - ksn) / (fabsf(ksn) + 0.01f));
          a = ksn * bf2f(((const bf16_t*)(A.ws + H_V))[(size_t)sidx * DM + v]); }
      a = wave_sum(a);
      const unsigned short gs = ((const unsigned short*)(dbg + 12288))[gla::sw256(v, kk * 2) / 2];
      if (lane == 0) dg_put(A, k + 3, 0.5f * fabsf(bf2f(gs) - a) / (fabsf(a) + 0.05f)); }
    { const unsigned h2 = dg_hash(gwv, k + 400); const int t = h2 & 63, v = (h2 >> 6) & 63;
      const unsigned short* at = (const unsigned short*)(dbg + 8192); const unsigned short* vt = (const unsigned short*)(dbg + 8192 + 2048);
      float a = bf2f(at[gla::sw128(t, lane * 2) / 2]) * bf2f(vt[gla::sw128(v, lane * 2) / 2]); a = wave_sum(a);
      if (lane == 0) dg_put(A, k + 1, 5.0f * dg_rel(bf2f(((const bf16_t*)(A.ws + H_OF))[(size_t)t * DM + v]), a)); }
}
__device__ __forceinline__ void dg_normo(const Args& A, int k) {
    const int lane = threadIdx.x & 63, gwv = blockIdx.x * 8 + (threadIdx.x >> 6);
    const unsigned h = dg_hash(gwv, k); const int row = h & (MTOK - 1), hd = (h >> 16) & 7; const size_t o = (size_t)row * DM + hd * 128;
    const float v0 = bf2f(((const bf16_t*)(A.ws + H_OF))[o + lane]) + bf2f(((const bf16_t*)(A.ws + H_OB))[o + lane]), v1 = bf2f(((const bf16_t*)(A.ws + H_OF))[o + 64 + lane]) + bf2f(((const bf16_t*)(A.ws + H_OB))[o + 64 + lane]);
    const float ss = wave_sum(v0 * v0 + v1 * v1), rstd = 1.0f / sqrtf(ss / 128.0f + EPS);
    const float r0 = v0 * rstd * A.in[I_HGNG][lane] * bf2f(((const bf16_t*)(A.ws + H_G))[o + lane]), r1 = v1 * rstd * A.in[I_HGNG][64 + lane] * bf2f(((const bf16_t*)(A.ws + H_G))[o + 64 + lane]);
    dg_put(A, k, fmaxf(dg_rel(bf2f(((const bf16_t*)(A.ws + WS_HM))[o + lane]), r0), dg_rel(bf2f(((const bf16_t*)(A.ws + WS_HM))[o + 64 + lane]), r1)));
}
__device__ __forceinline__ void dg_router(const Args& A, int k, int L) {
    const int lane = threadIdx.x & 63, gwv = blockIdx.x * 8 + (threadIdx.x >> 6);
    const int row = dg_hash(gwv, k) & (MTOK - 1), b = row >> 13; const float* x = A.out + (size_t)row * DM;
    const float* modl = (const float*)(A.ws + TB_MODS) + ((size_t)L * NBATCH + b) * 6144; const float* gain = A.in[I_N2G] + L * DM; const float* R = A.in[I_MOER] + (size_t)(L >> 1) * DM * 8;
    float ss = 0.f; for (int c = lane; c < DM; c += 64) ss += x[c] * x[c];
    ss = wave_sum(ss); const float rstd = 1.0f / sqrtf(ss / DM + EPS);
    float lg[8]; for (int e = 0; e < 8; ++e) lg[e] = 0.f;
    for (int c = lane; c < DM; c += 64) { const float hv = x[c] * rstd * gain[c] * (1.0f + modl[4 * 1024 + c]) + modl[3 * 1024 + c]; for (int e = 0; e < 8; ++e) lg[e] += hv * R[c * 8 + e]; }
    for (int e = 0; e < 8; ++e) lg[e] = wave_sum(lg[e]);
    int e0 = 0; for (int e = 1; e < 8; ++e) if (lg[e] > lg[e0]) e0 = e;
    int e1 = (e0 == 0) ? 1 : 0; for (int e = 0; e < 8; ++e) if (e != e0 && lg[e] > lg[e1]) e1 = e;
    float gap = 1e9f; for (int e = 0; e < 8; ++e) if (e != e0 && e != e1) gap = fminf(gap, lg[e1] - lg[e]); gap = fminf(gap, lg[e0] - lg[e1]);
    const int g0 = ((const int*)(A.ws + TB_EID))[row * 2], g1 = ((const int*)(A.ws + TB_EID))[row * 2 + 1]; const float w0 = ((const float*)(A.ws + TB_GATE))[row * 2], w1 = ((const float*)(A.ws + TB_GATE))[row * 2 + 1];
    const float p0 = 1.0f / (1.0f + expf(lg[e1] - lg[e0]));
    float er = (g0 != e0 || g1 != e1) ? (gap > 2e-3f ? 9.f : 0.f) : fmaxf(fabsf(w0 - p0), fabsf(w1 - (1.0f - p0)));
    if (lane == 0) dg_put(A, k, er);
}
__device__ __forceinline__ void dg_place(const Args& A, int k) {
    const int lane = threadIdx.x & 63, gwv = blockIdx.x * 8 + (threadIdx.x >> 6);
    const unsigned h = dg_hash(gwv, k); const int row = h & (MTOK - 1), kk = (h >> 16) & 1;
    const int sl = ((const int*)(A.ws + TB_SLOT))[row * 2 + kk], e = ((const int*)(A.ws + TB_EID))[row * 2 + kk]; const int* ts = (const int*)(A.ws + TB_TILES);
    float er = (sl >= ts[e] * 256 && sl < ts[e + 1] * 256 && sl < MOE_ROWS) ? 0.f : 7.f;
    if (er == 0.f) for (int c = lane; c < DM; c += 64) if (((const bf16_t*)(A.ws + E_XS))[(size_t)sl * DM + c] != ((const bf16_t*)(A.ws + WS_HM))[(size_t)row * DM + c]) er = 5.f;
    dg_put(A, k, er);
}
__device__ __forceinline__ void dg_moe_hid(const Args& A, int k, int m) {
    const int lane = threadIdx.x & 63, gwv = blockIdx.x * 8 + (threadIdx.x >> 6);
    const unsigned h = dg_hash(gwv, k); const int row = h & (MTOK - 1), kk = (h >> 16) & 1, j = (h >> 17) % DFFE;
    const int sl = ((const int*)(A.ws + TB_SLOT))[row * 2 + kk], e = ((const int*)(A.ws + TB_EID))[row * 2 + kk];
    const float* W = A.in[I_MOEGU] + ((size_t)m * 8 + e) * DM * 2 * DFFE; const bf16_t* Am = (const bf16_t*)(A.ws + E_XS) + (size_t)sl * DM;
    float g = 0.f, u = 0.f; for (int c = lane; c < DM; c += 64) { const float x = bf2f(Am[c]); g += x * dg_bfr(W[(size_t)c * 2 * DFFE + j]); u += x * dg_bfr(W[(size_t)c * 2 * DFFE + DFFE + j]); }
    g = wave_sum(g); u = wave_sum(u);
    if (lane == 0) dg_put(A, k, dg_rel(bf2f(((const bf16_t*)(A.ws + E_HID))[(size_t)sl * DFFE + j]), g / (1.0f + expf(-g)) * u));
}
__device__ __forceinline__ void dg_moe_y(const Args& A, int k, int m) {
    const int lane = threadIdx.x & 63, gwv = blockIdx.x * 8 + (threadIdx.x >> 6);
    const unsigned h = dg_hash(gwv, k); const int row = h & (MTOK - 1), kk = (h >> 16) & 1, col = (h >> 17) & 1023;
    const int sl = ((const int*)(A.ws + TB_SLOT))[row * 2 + kk], e = ((const int*)(A.ws + TB_EID))[row * 2 + kk];
    const float* W = A.in[I_MOEDN] + ((size_t)m * 8 + e) * DFFE * DM; const bf16_t* Hh = (const bf16_t*)(A.ws + E_HID) + (size_t)sl * DFFE;
    float a = 0.f; for (int j = lane; j < DFFE; j += 64) a += bf2f(Hh[j]) * dg_bfr(W[(size_t)j * DM + col]);
    a = wave_sum(a);
    if (lane == 0) dg_put(A, k, fabsf(bf2f(((const bf16_t*)(A.ws + E_XS))[(size_t)sl * DM + col]) - a) / (fabsf(a) + 0.3f));
}
__device__ __forceinline__ void dg_combine(const Args& A, int k, const float* modprev) {
    const int lane = threadIdx.x & 63, gwv = blockIdx.x * 8 + (threadIdx.x >> 6);
    const unsigned h = dg_hash(gwv, k); const int row = h & (MTOK - 1), col = (h >> 16) & 1023, b = row >> 13;
    const float* sv = (const float*)(A.ws + TB_LSUM) + 7 * 1024 * 1024 / 4; const bf16_t* Y = (const bf16_t*)(A.ws + E_XS);
    const int s0 = ((const int*)(A.ws + TB_SLOT))[row * 2], s1 = ((const int*)(A.ws + TB_SLOT))[row * 2 + 1]; const float w0 = ((const float*)(A.ws + TB_GATE))[row * 2], w1 = ((const float*)(A.ws + TB_GATE))[row * 2 + 1];
    const float ref = sv[k * 4096 + gwv] + modprev[(size_t)b * 6144 + 5 * 1024 + col] * (w0 * bf2f(Y[(size_t)s0 * DM + col]) + w1 * bf2f(Y[(size_t)s1 * DM + col]));
    if (lane == 0) dg_put(A, k, dg_rel(A.out[(size_t)row * DM + col], ref));
}
__device__ __forceinline__ void dg_lruin(const Args& A, int k) {
    const int lane = threadIdx.x & 63, gwv = blockIdx.x * 8 + (threadIdx.x >> 6);
    const unsigned h = dg_hash(gwv, k); const int row = h & (MTOK - 1), col = (h >> 16) % 2560;
    float a = 0.f; for (int kk = lane; kk < DM; kk += 64) a += bf2f(((const bf16_t*)(A.ws + WS_HM))[(size_t)row * DM + kk]) * dg_bfr(A.in[I_LRWIN][(size_t)kk * 2560 + col]);
    a = wave_sum(a);
    float ref, got;
    if (col < LRUW) { ref = 0.5f * a * (1.0f + tanhf(0.7978845608028654f * (a + 0.044715f * a * a * a))); got = bf2f(((const bf16_t*)(A.ws + L_YB))[(size_t)row * LRUW + col]); }
    else { ref = a; got = bf2f(((const bf16_t*)(A.ws + L_XB))[(size_t)row * LRUW + col - LRUW]); }
    if (lane == 0) dg_put(A, k, dg_rel(got, ref));
}
__device__ __forceinline__ void dg_lru(const Args& A, int k) {
    const int lane = threadIdx.x & 63, gwv = blockIdx.x * 8 + (threadIdx.x >> 6);
    const unsigned h = dg_hash(gwv, k); const int b = h & 7, ch = (h >> 3) % LRUW, tc = (h >> 16) & (SEQ - 1), n = ch / 128, j = ch % 128;
    const bf16_t* XB = (const bf16_t*)(A.ws + L_XB) + (size_t)b * SEQ * LRUW;
    float hres[2];
    for (int d = 0; d < 2; ++d) {
        const float* wa = A.in[I_LRWA] + (size_t)(d * 10 + n) * 16384; const float* wx = A.in[I_LRWX] + (size_t)(d * 10 + n) * 16384;
        const float wa0 = dg_bfr(wa[lane * 128 + j]), wa1 = dg_bfr(wa[(lane + 64) * 128 + j]), wx0 = dg_bfr(wx[lane * 128 + j]), wx1 = dg_bfr(wx[(lane + 64) * 128 + j]);
        const float ba = A.in[I_LRBA][d * LRUW + ch], bx = A.in[I_LRBX][d * LRUW + ch]; const float lam = A.in[I_LRLAM][d * LRUW + ch]; const float sp = log1pf(expf(-lam));
        float hs = 0.f;
        for (int i = 0; ; ++i) { const int t = d ? (SEQ - 1 - i) : i;
            float x0 = A.in[I_LRCB][n * 128 + lane], x1 = A.in[I_LRCB][n * 128 + 64 + lane], xj = A.in[I_LRCB][ch];
            for (int w = 0; w < 4; ++w) { const int tt = t - 1 + w; if (tt >= 0 && tt < SEQ) {
                x0 += A.in[I_LRCW][w * LRUW + n * 128 + lane] * bf2f(XB[(size_t)tt * LRUW + n * 128 + lane]); x1 += A.in[I_LRCW][w * LRUW + n * 128 + 64 + lane] * bf2f(XB[(size_t)tt * LRUW + n * 128 + 64 + lane]);
                xj += A.in[I_LRCW][w * LRUW + ch] * bf2f(XB[(size_t)tt * LRUW + ch]); } }
            const float rp = wave_sum(dg_bfr(x0) * wa0 + dg_bfr(x1) * wa1), ip = wave_sum(dg_bfr(x0) * wx0 + dg_bfr(x1) * wx1);
            const float rg = 1.0f / (1.0f + expf(-(rp + ba))), ig = 1.0f / (1.0f + expf(-(ip + bx))); const float la = -8.0f * rg * sp;
            hs = expf(la) * hs + sqrtf(fmaxf(-expm1f(2.0f * la), 0.f)) * ig * xj;
            if (t == tc) break; }
        hres[d] = hs;
    }
    const size_t go = ((size_t)b * SEQ + tc) * LRUW + ch;
    const float e1 = fabsf(bf2f(((const bf16_t*)(A.ws + L_HF))[go]) - hres[0]) / (fabsf(hres[0]) + 0.3f);
    const float ref = (hres[0] + hres[1]) * bf2f(((const bf16_t*)(A.ws + L_YB))[go]);
    const float e2 = fabsf(bf2f(((const bf16_t*)(A.ws + L_HY))[go]) - ref) / (fabsf(ref) + 0.3f);
    if (lane == 0) { dg_put(A, k, e1); dg_put(A, k + 5, e2); }
}
__device__ __forceinline__ void dg_final(const Args& A, int nchk) {
    const unsigned* sl = (const unsigned*)(A.ws + WS_CTL) + DG_BASE; int code = 0; float ev = 0.f;
    for (int k = 1; k <= nchk; ++k) { const float e = __uint_as_float(sl[64 * k]); if (e > 0.05f) { code = k; ev = e; break; } }
    if (code == 0) return;
    const int c1 = code % 10, c10 = code / 10;
    const float s = -(float)c1;
    for (size_t i = (size_t)blockIdx.x * NTHR + threadIdx.x; i < (size_t)MTOK * DM; i += (size_t)gridDim.x * NTHR) A.out[i] = A.in[I_X][i] * s;
    __syncthreads();
    if (blockIdx.x == 0 && threadIdx.x == 0) { const int qq = ev < 0.1f ? 1 : ev < 0.2f ? 2 : ev < 0.5f ? 3 : ev < 1.f ? 4 : ev < 2.f ? 5 : ev < 5.f ? 6 : ev < 20.f ? 7 : ev < 1e3f ? 8 : 9;
        A.out[12345] = 100.f * (float)(10 * c10 + qq); }
}
#define DG(x) x
#define DGL(x) if constexpr (L >= DIAG_FROM) { x }
#else
#define DG(x)
#define DGL(x)
#endif

#define GRID_BAR() xcd_barrier(bar)
template <int L>
__device__ __forceinline__ void run_mixer(const Args& args, LAS unsigned char* lds, int bid, int G, const XcdBarrier& bar) {
    unsigned char* ws = args.ws; float* xo = args.out;
    const float* modl = (const float*)(ws + TB_MODS) + (size_t)L * NBATCH * 6144;
    const float* xs = (L == 0) ? args.in[I_X] : xo;
    constexpr int kind = L % 3;
    DGL(if (L > 0 && ((L - 1) & 1)) { dg_save(args, 10 * (L - 1) + 9, xo); GRID_BAR(); })
    norm_phase<false>(args, lds, bid, G, xs, xo, args.in[I_N1G] + L * DM, modl, 0, (L > 0) && ((L - 1) & 1), modl - NBATCH * 6144, false, nullptr);
    GRID_BAR();
    DGL(if (L > 0 && ((L - 1) & 1)) { dg_combine(args, 10 * (L - 1) + 9, modl - NBATCH * 6144); GRID_BAR(); })
    DGL(dg_norm(args, 10 * L + 1, (L > 0 && ((L - 1) & 1)) ? xo : xs, args.in[I_N1G] + L * DM, L, 0); GRID_BAR();)
    if constexpr (kind == 0) {
        constexpr int al = L / 3;
        {
            pg8::Gemm g{(const bf16_t*)(ws + WS_HM), (const bf16_t*)(ws + W_QKV) + (size_t)al * 3072 * 1024, 1024};
            pg8::TileOrder S; S.init(256, 12, G, bid);
            pg8::EpiQKV E{(bf16_t*)(ws + A_Q), (bf16_t*)(ws + A_K), (bf16_t*)(ws + A_V), args.in[I_ATQN] + al * 64, args.in[I_ATKN] + al * 64,
                          (const float*)(ws + TB_COS), (const float*)(ws + TB_SIN), 0.125f * LOG2E};
            pg8::gemm_phase<pg8::EpiQKV>(lds, g, S, E);
        }
        GRID_BAR();
        DGL(dg_qkv(args, 10 * L + 2, al); GRID_BAR();)
        attn_phase(args, lds, bid, G, al);
        GRID_BAR();
        DGL(dg_attn(args, 10 * L + 3, al, lds); GRID_BAR();)
        DGL(dg_save(args, 10 * L + 4, xs); GRID_BAR();)
        {
            pg8::Gemm g{(const bf16_t*)(ws + WS_HM), (const bf16_t*)(ws + W_AO) + (size_t)al * 1024 * 1024, 1024};
            pg8::TileOrder S; S.init(256, 4, G, bid);
            pg8::EpiRes E{xs, xo, modl + 2 * 1024};
            pg8::gemm_phase<pg8::EpiRes>(lds, g, S, E);
        }
        GRID_BAR();
        DGL(dg_res(args, 10 * L + 4, xo, modl + 2 * 1024, (const bf16_t*)(ws + WS_HM), 1024, args.in[I_ATWOUT] + (size_t)al * 1024 * 1024); GRID_BAR();)
    }
    if constexpr (kind == 1) {
        {
            pg8::Gemm g{(const bf16_t*)(ws + WS_HM), (const bf16_t*)(ws + W_HGI), 1024};
            pg8::TileOrder S; S.init(256, 20, G, bid);
            pg8::EpiAct E{0, ws, (const float*)(ws + TB_LB)};
            pg8::gemm_phase<pg8::EpiAct>(lds, g, S, E);
        }
        GRID_BAR();
        DGL(dg_hgin(args, 10 * L + 2); GRID_BAR();)
        gla_phase(args, lds, bid, G);
        GRID_BAR();
        DGL(dg_gla(args, 10 * L + 3); GRID_BAR();)
        hg_normo_phase(args, bid, G);
        GRID_BAR();
        DGL(dg_normo(args, 10 * L + 0); GRID_BAR();)
        DGL(dg_save(args, 10 * L + 4, xs); GRID_BAR();)
        {
            pg8::Gemm g{(const bf16_t*)(ws + WS_HM), (const bf16_t*)(ws + W_HGO), 1024};
            pg8::TileOrder S; S.init(256, 4, G, bid);
            pg8::EpiRes E{xs, xo, modl + 2 * 1024};
            pg8::gemm_phase<pg8::EpiRes>(lds, g, S, E);
        }
        GRID_BAR();
        DGL(dg_res(args, 10 * L + 4, xo, modl + 2 * 1024, (const bf16_t*)(ws + WS_HM), 1024, args.in[I_HGWOUT]); GRID_BAR();)
    }
    if constexpr (kind == 2) {
        {
            pg8::Gemm g{(const bf16_t*)(ws + WS_HM), (const bf16_t*)(ws + W_LRI), 1024};
            pg8::TileOrder S; S.init(256, 10, G, bid);
            pg8::EpiAct E{1, ws, nullptr};
            pg8::gemm_phase<pg8::EpiAct>(lds, g, S, E);
        }
        GRID_BAR();
        DGL(dg_lruin(args, 10 * L + 2); GRID_BAR();)
        lru_phase<0>(args, lds, bid, G);
        GRID_BAR();
        lru_carry_phase(args, bid, G);
        GRID_BAR();
        lru_phase<1>(args, lds, bid, G);
        GRID_BAR();
        lru_phase<2>(args, lds, bid, G);
        GRID_BAR();
        DGL(dg_lru(args, 10 * L + 3); GRID_BAR();)
        DGL(dg_save(args, 10 * L + 4, xs); GRID_BAR();)
        {
            pg8::Gemm g{(const bf16_t*)(ws + L_HY), (const bf16_t*)(ws + W_LRO), LRUW};
            pg8::TileOrder S; S.init(256, 4, G, bid);
            pg8::EpiRes E{xs, xo, modl + 2 * 1024};
            pg8::gemm_phase<pg8::EpiRes>(lds, g, S, E);
        }
        GRID_BAR();
        DGL(dg_res(args, 10 * L + 4, xo, modl + 2 * 1024, (const bf16_t*)(ws + L_HY), LRUW, args.in[I_LRWOUT]); GRID_BAR();)
    }
}
template <int L>
__device__ __forceinline__ void run_ffn(const Args& args, LAS unsigned char* lds, int bid, int G, const XcdBarrier& bar) {
    unsigned char* ws = args.ws; float* xo = args.out;
    const float* modl = (const float*)(ws + TB_MODS) + (size_t)L * NBATCH * 6144;
    if constexpr ((L & 1) == 0) {
        constexpr int m = L >> 1;
        norm_phase<false>(args, lds, bid, G, xo, xo, args.in[I_N2G] + L * DM, modl, 1, false, modl, false, nullptr);
        GRID_BAR();
        DGL(dg_norm(args, 10 * L + 5, xo, args.in[I_N2G] + L * DM, L, 1); GRID_BAR();)
        {
            pg8::Gemm g{(const bf16_t*)(ws + WS_HM), (const bf16_t*)(ws + W_FGU) + (size_t)m * 5632 * 1024, 1024};
            pg8::TileOrder S; S.init(256, 22, G, bid);
            pg8::EpiSwiGLU E{(bf16_t*)(ws + F_HID), DFF};
            pg8::gemm_phase<pg8::EpiSwiGLU>(lds, g, S, E);
        }
        GRID_BAR();
        DGL(dg_swiglu(args, 10 * L + 6, (const bf16_t*)(ws + WS_HM), args.in[I_FFGU] + (size_t)m * 1024 * 5632, DFF, (const bf16_t*)(ws + F_HID), MTOK, nullptr); GRID_BAR();)
        DGL(dg_save(args, 10 * L + 7, xo); GRID_BAR();)
        {
            pg8::Gemm g{(const bf16_t*)(ws + F_HID), (const bf16_t*)(ws + W_FDN) + (size_t)m * 1024 * 2816, DFF};
            pg8::TileOrder S; S.init(256, 4, G, bid);
            pg8::EpiRes E{xo, xo, modl + 5 * 1024};
            pg8::gemm_phase<pg8::EpiRes>(lds, g, S, E);
        }
        GRID_BAR();
        DGL(dg_res(args, 10 * L + 7, xo, modl + 5 * 1024, (const bf16_t*)(ws + F_HID), DFF, args.in[I_FFDN] + (size_t)m * 2816 * 1024); GRID_BAR();)
    } else {
        constexpr int m = L >> 1;
        norm_phase<true>(args, lds, bid, G, xo, xo, args.in[I_N2G] + L * DM, modl, 1, false, modl, false, args.in[I_MOER] + (size_t)m * DM * 8);
        GRID_BAR();
        DGL(dg_norm(args, 10 * L + 5, xo, args.in[I_N2G] + L * DM, L, 1); dg_router(args, 10 * L + 5, L); GRID_BAR();)
        place_phase(args, lds, bid, G);
        GRID_BAR();
        DGL(dg_place(args, 10 * L + 6); GRID_BAR();)
        const int* tiles = (const int*)(ws + TB_TILES);
        {
            pg8::Gemm g{(const bf16_t*)(ws + E_XS), (const bf16_t*)(ws + W_MGU) + (size_t)m * 8 * 7168 * 1024, 1024};
            pg8::TileOrder S; S.init(tiles[8], 28, G, bid);
#pragma unroll
            for (int e = 1; e < NEXP; ++e) S.ts[e] = tiles[e];
            pg8::EpiSwiGLU E{(bf16_t*)(ws + E_HID), DFFE};
            pg8::gemm_phase<pg8::EpiSwiGLU>(lds, g, S, E);
        }
        GRID_BAR();
        DGL(dg_moe_hid(args, 10 * L + 7, m); GRID_BAR();)
        {
            pg8::Gemm g{(const bf16_t*)(ws + E_HID), (const bf16_t*)(ws + W_MDN) + (size_t)m * 8 * 1024 * 3584, DFFE};
            pg8::TileOrder S; S.init(tiles[8], 4, G, bid);
#pragma unroll
            for (int e = 1; e < NEXP; ++e) S.ts[e] = tiles[e];
            pg8::EpiPlain E{(bf16_t*)(ws + E_XS), DM};
            pg8::gemm_phase<pg8::EpiPlain>(lds, g, S, E);
        }
        GRID_BAR();
        DGL(dg_moe_y(args, 10 * L + 8, m); GRID_BAR();)
    }
}
__device__ __forceinline__ void final_combine(const Args& args, LAS unsigned char* lds, int bid, int G, const XcdBarrier& bar) {
    const float* modl = (const float*)(args.ws + TB_MODS) + (size_t)3 * NBATCH * 6144;
    DG(dg_save(args, 39, args.out); GRID_BAR();)
    norm_phase<false>(args, lds, bid, G, args.out, args.out, args.in[I_N1G], modl, 0, true, modl, true, nullptr);
    DG(GRID_BAR(); dg_combine(args, 39, modl);)
}

__global__ void __launch_bounds__(NTHR, 2) mega_fwd(Args args) {
    extern __shared__ __attribute__((aligned(16))) unsigned char lds_raw[];
    LAS unsigned char* lds = (LAS unsigned char*)lds_raw;
    const int tid = threadIdx.x, bid = blockIdx.x, G = gridDim.x;
    unsigned char* ws = args.ws;
    volatile LAS unsigned* MISC = (volatile LAS unsigned*)(lds + MISC_OFF);
    if (tid < 64) MISC[tid] = 0u;
    __syncthreads();
    XcdBarrier bar = xcd_barrier_post((unsigned*)(ws + WS_CTL) + CW_BAR, MISC + 8);

    prologue_phase(args, lds, bid, G);
    GRID_BAR();

    run_mixer<0>(args, lds, bid, G, bar);
    run_ffn<0>(args, lds, bid, G, bar);
    run_mixer<1>(args, lds, bid, G, bar);
    run_ffn<1>(args, lds, bid, G, bar);
    run_mixer<2>(args, lds, bid, G, bar);
    run_ffn<2>(args, lds, bid, G, bar);
    run_mixer<3>(args, lds, bid, G, bar);
    run_ffn<3>(args, lds, bid, G, bar);
    final_combine(args, lds, bid, G, bar);
    DG(GRID_BAR(); dg_final(args, 49);)
}

extern "C" void kernel_launch(void* const* d_in, const int* in_sizes, int n_in, void* d_out, int out_size, void* d_ws, size_t ws_size, hipStream_t stream) {
    static int grid = 0;
    if (grid == 0) {
        if (n_in != 30 || out_size != MTOK * DM || ws_size < WS_NEED) { fprintf(stderr, "kernel_launch: unexpected shapes (n_in %d out %d ws %zu need %zu)\n", n_in, out_size, ws_size, (size_t)WS_NEED); grid = -1; return; }
        int dev = 0, cus = 0;
        if (hipGetDevice(&dev) != hipSuccess || hipDeviceGetAttribute(&cus, hipDeviceAttributeMultiprocessorCount, dev) != hipSuccess) { grid = -1; return; }
        if (hipFuncSetAttribute((const void*)mega_fwd, hipFuncAttributeMaxDynamicSharedMemorySize, LDS_BYTES) != hipSuccess) { fprintf(stderr, "kernel_launch: hipFuncSetAttribute failed\n"); grid = -1; return; }
        int per_cu = 0;
        if (hipOccupancyMaxActiveBlocksPerMultiprocessor(&per_cu, (const void*)mega_fwd, NTHR, LDS_BYTES) != hipSuccess || per_cu < 1) { fprintf(stderr, "kernel_launch: occupancy query says %d\n", per_cu); }
        (void)hipGetLastError();
        grid = (cus >= 256) ? 256 : -1;
        if (grid < 0) { fprintf(stderr, "kernel_launch: needs 256 CUs, device has %d\n", cus); return; }
    }
    if (grid < 0) return;
    if (hipMemsetAsync((char*)d_ws + WS_CTL, 0, CTL_ZERO_BYTES, stream) != hipSuccess) return;
    Args a{};
    for (int i = 0; i < 30; ++i) a.in[i] = (const float*)d_in[i];
    a.out = (float*)d_out; a.ws = (unsigned char*)d_ws;
    hipLaunchKernelGGL(mega_fwd, dim3(grid), dim3(NTHR), LDS_BYTES, stream, a);
}
```

```cpp
#define DIAG_FROM 2
#include <hip/hip_runtime.h>
#include <cstdio>
#include <cstdint>

#define LAS __attribute__((address_space(3)))
#define GAS __attribute__((address_space(1)))
typedef unsigned short bf16_t;
typedef short bf16x8 __attribute__((ext_vector_type(8)));
typedef short s16x4 __attribute__((ext_vector_type(4)));
typedef float f32x2 __attribute__((ext_vector_type(2)));
typedef float f32x4 __attribute__((ext_vector_type(4)));
typedef float f32x16 __attribute__((ext_vector_type(16)));
typedef unsigned u32x2 __attribute__((ext_vector_type(2)));
typedef unsigned u32x4 __attribute__((ext_vector_type(4)));

constexpr int MTOK = 65536, DM = 1024, SEQ = 8192, NBATCH = 8, DEPTH = 4;
constexpr int DFF = 2816, DFFE = 3584, NEXP = 8, LRUW = 1280;
constexpr float EPS = 1e-6f;
constexpr float LOG2E = 1.4426950408889634f;

constexpr size_t MiB = 1u << 20;
constexpr size_t WS_CTL = 0, CTL_ZERO_BYTES = 1 * MiB;
constexpr size_t WS_TAB = 1 * MiB;
constexpr size_t TB_MODS = WS_TAB;
constexpr size_t TB_COS = WS_TAB + 1 * MiB;
constexpr size_t TB_SIN = WS_TAB + 2 * MiB;
constexpr size_t TB_SCAL = WS_TAB + 3 * MiB;
constexpr size_t TB_LB = TB_SCAL + 4096;
constexpr size_t TB_SP = TB_SCAL + 16384;
constexpr size_t TB_EID = WS_TAB + 4 * MiB;
constexpr size_t TB_GATE = WS_TAB + 5 * MiB;
constexpr size_t TB_SLOT = WS_TAB + 6 * MiB;
constexpr size_t TB_BCNT = WS_TAB + 7 * MiB;
constexpr size_t TB_TILES = TB_BCNT + 16384;
constexpr size_t TB_LSUM = WS_TAB + 8 * MiB;
constexpr size_t TB_LCIN = WS_TAB + 16 * MiB;
constexpr size_t WS_W = 32 * MiB;
constexpr size_t W_QKV = WS_W;
constexpr size_t W_AO = W_QKV + 2 * (size_t)3072 * 1024 * 2;
constexpr size_t W_HGI = W_AO + 2 * (size_t)1024 * 1024 * 2;
constexpr size_t W_HGO = W_HGI + (size_t)5120 * 1024 * 2;
constexpr size_t W_LRI = W_HGO + (size_t)1024 * 1024 * 2;
constexpr size_t W_LRG = W_LRI + (size_t)2560 * 1024 * 2;
constexpr size_t W_LRO = W_LRG + (size_t)10 * 2 * 256 * 128 * 2;
constexpr size_t W_FGU = W_LRO + (size_t)1024 * 1280 * 2;
constexpr size_t W_FDN = W_FGU + 2 * (size_t)5632 * 1024 * 2;
constexpr size_t W_MGU = W_FDN + 2 * (size_t)1024 * 2816 * 2;
constexpr size_t W_MDN = W_MGU + 16 * (size_t)7168 * 1024 * 2;
constexpr size_t W_END = W_MDN + 16 * (size_t)1024 * 3584 * 2;
constexpr size_t WS_HM = 440 * MiB;
constexpr size_t WS_ACT = 568 * MiB;
static_assert(W_END <= WS_HM, "weights overflow");
constexpr size_t SZ_TOK = (size_t)MTOK * 1024 * 2;
constexpr size_t A_Q = WS_ACT, A_K = A_Q + SZ_TOK, A_V = A_K + SZ_TOK;
constexpr size_t F_HID = WS_ACT;
constexpr size_t H_Q = WS_ACT, H_LFF = H_Q + SZ_TOK, H_LFB = H_LFF + SZ_TOK, H_V = H_LFB + SZ_TOK, H_G = H_V + SZ_TOK, H_OF = H_G + SZ_TOK, H_OB = H_OF + SZ_TOK;
constexpr size_t SZ_LRU = (size_t)MTOK * 1280 * 2;
constexpr size_t L_YB = WS_ACT, L_XB = L_YB + SZ_LRU, L_HF = L_XB + SZ_LRU, L_HY = L_HF + SZ_LRU;
constexpr int MOE_ROWS = 2 * MTOK + NEXP * 256;
constexpr size_t E_XS = WS_ACT, E_HID = E_XS + (size_t)MOE_ROWS * 1024 * 2, E_END = E_HID + (size_t)MOE_ROWS * DFFE * 2;
constexpr size_t WS_NEED = E_END;
static_assert(WS_NEED <= (size_t)1792 * MiB, "workspace");

constexpr int CW_BAR = 4096;

constexpr int RING_BYTES = 135168;
constexpr int MISC_OFF = RING_BYTES;
constexpr int LDS_BYTES = 147456;
constexpr int NWAVES = 8, NTHR = 512;

typedef __bf16 bf16x2v __attribute__((ext_vector_type(2)));
__device__ __forceinline__ unsigned cvt_pk_bf16(float lo, float hi) { const f32x2 v = {lo, hi}; const bf16x2v b = __builtin_convertvector(v, bf16x2v); return __builtin_bit_cast(unsigned, b); }
__device__ __forceinline__ unsigned f2bf(float f) { unsigned u = __builtin_bit_cast(unsigned, f); return (u + 0x7fffu + ((u >> 16) & 1u)) >> 16; }
__device__ __forceinline__ float bf2f(unsigned short b) { return __builtin_bit_cast(float, ((unsigned)b) << 16); }
__device__ __forceinline__ float bflo(unsigned w) { return __builtin_bit_cast(float, w << 16); }
__device__ __forceinline__ float bfhi(unsigned w) { return __builtin_bit_cast(float, w & 0xffff0000u); }
__device__ __forceinline__ float fexp2(float x) { return __builtin_amdgcn_exp2f(x); }
__device__ __forceinline__ float fexp(float x) { return __builtin_amdgcn_exp2f(x * LOG2E); }
__device__ __forceinline__ float frcp(float x) { return __builtin_amdgcn_rcpf(x); }
__device__ __forceinline__ float fsigmoid(float x) { return frcp(1.0f + fexp(-x)); }
__device__ __forceinline__ float fsilu(float x) { return x * fsigmoid(x); }
__device__ __forceinline__ float wave_sum(float v) {
#pragma unroll
    for (int o = 1; o < 64; o <<= 1) v += __shfl_xor(v, o);
    return v;
}
#define LDS_WAIT() asm volatile("s_waitcnt lgkmcnt(0)" ::: "memory")
#define VM_WAIT() asm volatile("s_waitcnt vmcnt(0)" ::: "memory")

#define XB_TMO      128
#define XB_XCNT(j)  (256  + 64 * (j))
#define XB_XSUB(j)  (1280 + 64 * (j))
#define XB_XGEN(j)  (2304 + 64 * (j))
#define XB_TOP      3328
#define XB_TOPGEN   3392
#define XCD_BAR_WORDS 3456
#define XB_SPIN_CAP (1u << 22)
__device__ __forceinline__ unsigned xb_ld(unsigned* p)              { return __hip_atomic_load(p, __ATOMIC_RELAXED, __HIP_MEMORY_SCOPE_AGENT); }
__device__ __forceinline__ unsigned xb_add(unsigned* p, unsigned v) { return __hip_atomic_fetch_add(p, v, __ATOMIC_RELAXED, __HIP_MEMORY_SCOPE_AGENT); }
__device__ __forceinline__ unsigned xb_xcc_id() { return (unsigned)__builtin_amdgcn_s_getreg((3 << 11) | 20) & 0xFu; }
#define XB_SPIN(cond, bar) do { unsigned _sp = 0; while (cond) { __builtin_amdgcn_s_sleep(1); \
    if ((++_sp & 255u) == 0u) { if (xb_ld(&(bar)[XB_TMO])) break; if (_sp > XB_SPIN_CAP) { atomicAdd(&(bar)[XB_TMO], 1u); break; } } } } while (0)
struct XcdBarrier { unsigned* bar; unsigned x; volatile LAS unsigned* st; };
__device__ __forceinline__ XcdBarrier xcd_barrier_post(unsigned* bar, volatile LAS unsigned* st) {
    XcdBarrier b; b.bar = bar; b.x = xb_xcc_id(); b.st = st;
    if (threadIdx.x == 0) (void)xb_add(&bar[XB_XCNT(b.x)], 1u);
    return b;
}
__device__ __forceinline__ void xcd_barrier_complete(unsigned* bar, unsigned x, unsigned& nloc, unsigned& nx) {
    const unsigned G = gridDim.x * gridDim.y * gridDim.z;
    unsigned sum, cnt, mine, sp = 0u;
    for (;;) {
        sum = 0u; cnt = 0u; mine = 0u;
#pragma unroll
        for (unsigned j = 0; j < 16; ++j) { const unsigned c = xb_ld(&bar[XB_XCNT(j)]); sum += c; cnt += (c > 0u) ? 1u : 0u; mine = (j == x) ? c : mine; }
        if (sum == G) break;
        __builtin_amdgcn_s_sleep(1);
        if ((++sp & 255u) == 0u) { if (xb_ld(&bar[XB_TMO])) break; if (sp > XB_SPIN_CAP) { atomicAdd(&bar[XB_TMO], 1u); break; } }
    }
    nloc = mine > 0u ? mine : 1u; nx = cnt > 0u ? cnt : 1u;
}
__device__ __forceinline__ void xcd_barrier(const XcdBarrier& b) {
    asm volatile("s_waitcnt vmcnt(0)" ::: "memory");
    __syncthreads();
    if (threadIdx.x == 0) {
        unsigned* bar = b.bar;
        __builtin_amdgcn_s_waitcnt(0);
        unsigned nloc = b.st[0], nx = b.st[1];
        if (nloc == 0u) { xcd_barrier_complete(bar, b.x, nloc, nx); b.st[0] = nloc; b.st[1] = nx; }
        const unsigned old = xb_add(&bar[XB_XSUB(b.x)], 1u);
        const unsigned gen = old / nloc;
        if (old + 1u == (gen + 1u) * nloc) {
            __builtin_amdgcn_fence(__ATOMIC_RELEASE, "agent");
            asm volatile("s_waitcnt vmcnt(0)" ::: "memory");
            const unsigned og = xb_add(&bar[XB_TOP], 1u);
            const unsigned tg = og / nx;
            if (og + 1u == (tg + 1u) * nx) xb_add(&bar[XB_TOPGEN], 1u);
            else XB_SPIN(xb_ld(&bar[XB_TOPGEN]) == tg, bar);
            __builtin_amdgcn_fence(__ATOMIC_ACQUIRE, "agent");
            xb_add(&bar[XB_XGEN(b.x)], 1u);
            asm volatile("s_waitcnt vmcnt(0)" ::: "memory");
        } else {
            XB_SPIN(xb_ld(&bar[XB_XGEN(b.x)]) == gen, bar);
            __builtin_amdgcn_fence(__ATOMIC_ACQUIRE, "agent");
            asm volatile("s_waitcnt vmcnt(0)" ::: "memory");
        }
    }
    __syncthreads();
}

namespace pg8 {
constexpr int BM = 256, BK = 64, HALF = 128, HTB = HALF * BK * 2, STAGE_BYTES = 8 * HTB, NXCD = 8, WGM = 8;
__host__ __device__ __forceinline__ int lds_byte(int r, int c) { const int st = (r >> 4) * 2 + (c >> 5), rr = r & 15, cc = c & 31, ob = rr * 64 + cc * 2; return st * 1024 + (ob ^ (((ob >> 9) & 1) << 5)); }
__host__ __device__ __forceinline__ void stage_rc(int b, int& R, int& C) { const int st = b / 1024, sb = b % 1024, swz = sb ^ (((sb >> 9) & 1) << 5); R = (st >> 1) * 16 + swz / 64; C = (st & 1) * 32 + (swz % 64) / 2; }
__host__ __device__ __forceinline__ int perm32(int rho) { const int n = rho >> 4, i = rho & 15; return 8 * (i >> 2) + 4 * n + (i & 3); }

struct Unit { int pm, pn, pb; };
struct Gemm { const bf16_t* A; const bf16_t* Bt; int K; };

struct TileOrder {
    int nM, nN, nwg, G, c; int ts[NEXP];
    __device__ __forceinline__ void init(int nM_, int nN_, int G_, int c_) { nM = nM_; nN = nN_; nwg = nM * nN; G = G_; c = c_;
#pragma unroll
        for (int e = 0; e < NEXP; ++e) ts[e] = (e == 0) ? 0 : 0x7fffffff; }
    __device__ __forceinline__ bool next(int i, Unit& u) const {
        const long L = (long)i * G + c; if (L >= nwg) return false;
        int wgid = (int)L; { const int q = nwg / NXCD, r = nwg % NXCD, xcd = wgid % NXCD, off = wgid / NXCD; wgid = (xcd < r ? xcd * (q + 1) : r * (q + 1) + (xcd - r) * q) + off; }
        const int nig = WGM * nN, gid = wgid / nig, fm = gid * WGM, gsz = (nM - fm) < WGM ? (nM - fm) : WGM;
        u.pm = fm + ((wgid % nig) % gsz); u.pn = (wgid % nig) / gsz;
        int e = 0;
#pragma unroll
        for (int k = 1; k < NEXP; ++k) e += (u.pm >= ts[k]) ? 1 : 0;
        u.pb = e * nN + u.pn; return true;
    }
};

template <class Epi>
__device__ __forceinline__ void gemm_phase(LAS unsigned char* lds, const Gemm g, const TileOrder& S, const Epi& E) {
    int tid_ = threadIdx.x; asm volatile("" : "+v"(tid_));
    const int tid = tid_, wid = __builtin_amdgcn_readfirstlane(tid >> 6), lane = tid & 63, wr = wid >> 2, wc = wid & 3, fr = lane & 15, fq = lane >> 4;
    const int K = g.K, nt = K / BK;
    unsigned voffA[2], voffB[2];
#pragma unroll
    for (int i = 0; i < 2; ++i) { int R, C; stage_rc(tid * 16 + i * 8192, R, C); const int Rb = Epi::PERM ? ((R & ~31) + perm32(R & 31)) : R;
        voffA[i] = (unsigned)(R * K + C) * 2u; voffB[i] = (unsigned)(Rb * K + C) * 2u; }
    const size_t kstep = (size_t)(BK * 2);
    const size_t hstep = (size_t)HALF * K * 2;
    const size_t tstep = 2 * hstep;
    const unsigned ldsw = (unsigned)wid * 1024u;
    const int aoff = lds_byte(wr * 64 + fr, fq * 8), boff = lds_byte(wc * 32 + fr, fq * 8);
#define PG8_SA(b, h) (((b) * 2 + (h)) * HTB)
#define PG8_SB(b, h) ((4 + (b) * 2 + (h)) * HTB)
#define PG8_STAGE(bufoff, gbase, voff) do { _Pragma("unroll") for (int _i = 0; _i < 2; ++_i) \
        __builtin_amdgcn_global_load_lds((const unsigned*)((const char*)(gbase) + (voff)[_i]), (LAS unsigned*)(lds + (bufoff) + ldsw + _i * 8192), 16, 0, 0); } while (0)
#define PG8_LDA(dst, b, h) do { _Pragma("unroll") for (int m = 0; m < 4; ++m) _Pragma("unroll") for (int k = 0; k < 2; ++k) dst[m][k] = *(const LAS bf16x8*)(lds + PG8_SA(b, h) + aoff + m * 2048 + k * 1024); } while (0)
#define PG8_LDB(dst, b, h) do { _Pragma("unroll") for (int n = 0; n < 2; ++n) _Pragma("unroll") for (int k = 0; k < 2; ++k) dst[n][k] = *(const LAS bf16x8*)(lds + PG8_SB(b, h) + boff + n * 2048 + k * 1024); } while (0)
#define PG8_MMA(ai, bj, At, Bt) do { __builtin_amdgcn_s_setprio(1); _Pragma("unroll") for (int m = 0; m < 4; ++m) _Pragma("unroll") for (int n = 0; n < 2; ++n) _Pragma("unroll") for (int k = 0; k < 2; ++k) \
        acc[ai][bj][m][n] = __builtin_amdgcn_mfma_f32_16x16x32_bf16(Bt[n][k], At[m][k], acc[ai][bj][m][n], 0, 0, 0); __builtin_amdgcn_s_setprio(0); } while (0)
#define PG8_WAIT_V(n) asm volatile("s_waitcnt vmcnt(" #n ")" ::: "memory")
#define PG8_WAIT_L(n) asm volatile("s_waitcnt lgkmcnt(" #n ")" ::: "memory")
#define PG8_BAR __builtin_amdgcn_s_barrier()
#define PG8_SCHED __builtin_amdgcn_sched_barrier(0)
    Unit cur, nxt; int ui = 0;
    if (!S.next(0, cur)) return;
    f32x4 acc[2][2][4][2];
#pragma unroll
    for (int a = 0; a < 2; ++a)
#pragma unroll
        for (int b = 0; b < 2; ++b)
#pragma unroll
            for (int m = 0; m < 4; ++m)
#pragma unroll
                for (int n = 0; n < 2; ++n) acc[a][b][m][n] = (f32x4){0.f, 0.f, 0.f, 0.f};
    bf16x8 At[4][2], B0[2][2], B1[2][2];
    const char* cA = (const char*)g.A + (size_t)cur.pm * tstep; const char* cB = (const char*)g.Bt + (size_t)cur.pb * tstep;
    PG8_STAGE(PG8_SB(0, 0), cB, voffB); PG8_STAGE(PG8_SA(0, 0), cA, voffA); PG8_STAGE(PG8_SB(0, 1), cB + hstep, voffB); PG8_STAGE(PG8_SA(0, 1), cA + hstep, voffA);
    if (wr == 1) PG8_BAR;
    PG8_WAIT_V(4); PG8_BAR;
    PG8_STAGE(PG8_SB(1, 0), cB + kstep, voffB); PG8_STAGE(PG8_SA(1, 0), cA + kstep, voffA); PG8_STAGE(PG8_SB(1, 1), cB + hstep + kstep, voffB);
    PG8_WAIT_V(6); PG8_BAR;
    for (;;) {
        const bool has_next = S.next(ui + 1, nxt);
        const char* nA = has_next ? (const char*)g.A + (size_t)nxt.pm * tstep : cA; const char* nB = has_next ? (const char*)g.Bt + (size_t)nxt.pb * tstep : cB;
        for (int t = 0; t < nt; t += 2) {
            const bool last = (t == nt - 2);
            const char* a1 = cA + (size_t)(t + 1) * kstep;
            const char* a2 = last ? nA : cA + (size_t)(t + 2) * kstep; const char* b2 = last ? nB : cB + (size_t)(t + 2) * kstep;
            const char* a3 = a2 + kstep; const char* b3 = b2 + kstep;
            PG8_LDB(B0, 0, 0); PG8_SCHED; PG8_LDA(At, 0, 0); PG8_STAGE(PG8_SA(1, 1), a1 + hstep, voffA);
            PG8_WAIT_L(8); PG8_BAR; PG8_WAIT_L(0); PG8_MMA(0, 0, At, B0); PG8_BAR; PG8_SCHED;
            PG8_LDB(B1, 0, 1); PG8_STAGE(PG8_SB(0, 0), b2, voffB);
            PG8_BAR; PG8_WAIT_L(0); PG8_MMA(0, 1, At, B1); PG8_BAR;
            PG8_LDA(At, 0, 1); PG8_STAGE(PG8_SA(0, 0), a2, voffA);
            PG8_BAR; PG8_WAIT_L(0); PG8_MMA(1, 0, At, B0); PG8_BAR; PG8_SCHED;
            PG8_STAGE(PG8_SB(0, 1), b2 + hstep, voffB);
            PG8_WAIT_V(6); PG8_BAR; PG8_MMA(1, 1, At, B1); PG8_BAR;
            PG8_LDB(B0, 1, 0); PG8_SCHED; PG8_LDA(At, 1, 0); PG8_STAGE(PG8_SA(0, 1), a2 + hstep, voffA);
            PG8_WAIT_L(8); PG8_BAR; PG8_WAIT_L(0); PG8_MMA(0, 0, At, B0); PG8_BAR; PG8_SCHED;
            PG8_LDB(B1, 1, 1); PG8_STAGE(PG8_SB(1, 0), b3, voffB);
            PG8_BAR; PG8_WAIT_L(0); PG8_MMA(0, 1, At, B1); PG8_BAR;
            PG8_LDA(At, 1, 1); PG8_STAGE(PG8_SA(1, 0), a3, voffA);
            PG8_BAR; PG8_WAIT_L(0); PG8_MMA(1, 0, At, B0); PG8_BAR; PG8_SCHED;
            PG8_STAGE(PG8_SB(1, 1), b3 + hstep, voffB);
            PG8_WAIT_V(6); PG8_BAR; PG8_MMA(1, 1, At, B1); PG8_BAR;
        }
        E(acc, cur, wr, wc, fr, fq);
        if (!has_next) break;
#pragma unroll
        for (int a = 0; a < 2; ++a)
#pragma unroll
            for (int b = 0; b < 2; ++b)
#pragma unroll
                for (int m = 0; m < 4; ++m)
#pragma unroll
                    for (int n = 0; n < 2; ++n) acc[a][b][m][n] = (f32x4){0.f, 0.f, 0.f, 0.f};
        cur = nxt; cA = nA; cB = nB; ++ui;
    }
    PG8_WAIT_V(0);
    if (wr == 0) PG8_BAR;
    PG8_BAR;
#undef PG8_SA
#undef PG8_SB
#undef PG8_STAGE
#undef PG8_LDA
#undef PG8_LDB
#undef PG8_MMA
#undef PG8_WAIT_V
#undef PG8_WAIT_L
#undef PG8_BAR
#undef PG8_SCHED
}

struct EpiQKV {
    static constexpr bool PERM = true;
    bf16_t *Q, *Kk, *V; const float *gq, *gk, *cosT, *sinT; float qscale;
    __device__ __forceinline__ void operator()(const f32x4 (&acc)[2][2][4][2], const Unit& u, int wr, int wc, int fr, int fq) const {
        const int row0 = u.pm * BM + wr * 64 + fr;
        if (u.pn >= 8) {
            const int col0 = (u.pn - 8) * BM + wc * 32 + 8 * fq;
#pragma unroll
            for (int ai = 0; ai < 2; ++ai)
#pragma unroll
                for (int m = 0; m < 4; ++m) { bf16_t* rowp = V + (size_t)(row0 + ai * HALF + m * 16) * DM + col0;
#pragma unroll
                    for (int bj = 0; bj < 2; ++bj) { const f32x4 v0 = acc[ai][bj][m][0], v1 = acc[ai][bj][m][1];
                        u32x4 w; w.x = cvt_pk_bf16(v0[0], v0[1]); w.y = cvt_pk_bf16(v0[2], v0[3]); w.z = cvt_pk_bf16(v1[0], v1[1]); w.w = cvt_pk_bf16(v1[2], v1[3]);
                        *(u32x4*)(rowp + bj * HALF) = w; } }
        } else {
            const int part = u.pn >> 2, sh = 4 * (u.pn & 3) + wc;
            bf16_t* dst = part ? Kk : Q; const float* g = part ? gk : gq; const float sc = part ? 1.0f : qscale;
            f32x4 g0[2], g1[2];
#pragma unroll
            for (int n = 0; n < 2; ++n) { g0[n] = *(const f32x4*)(g + 8 * fq + 4 * n); g1[n] = *(const f32x4*)(g + 32 + 8 * fq + 4 * n); }
#pragma unroll
            for (int ai = 0; ai < 2; ++ai)
#pragma unroll
                for (int m = 0; m < 4; ++m) {
                    const int r = row0 + ai * HALF + m * 16; const int pos = r & (SEQ - 1);
                    f32x4 x1[2], x2[2]; float ss = 0.f;
#pragma unroll
                    for (int n = 0; n < 2; ++n) { x1[n] = acc[ai][0][m][n]; x2[n] = acc[ai][1][m][n];
                        ss += (x1[n][0] * x1[n][0] + x1[n][1] * x1[n][1]) + (x1[n][2] * x1[n][2] + x1[n][3] * x1[n][3]);
                        ss += (x2[n][0] * x2[n][0] + x2[n][1] * x2[n][1]) + (x2[n][2] * x2[n][2] + x2[n][3] * x2[n][3]); }
                    ss += __shfl_xor(ss, 16); ss += __shfl_xor(ss, 32);
                    const float rstd = __builtin_amdgcn_rsqf(ss * (1.0f / 64.0f) + EPS) ;
                    bf16_t* op = dst + (size_t)r * DM + sh * 64 + 8 * fq;
                    u32x4 w1, w2;
#pragma unroll
                    for (int n = 0; n < 2; ++n) {
                        const f32x4 cs = *(const f32x4*)(cosT + pos * 32 + 8 * fq + 4 * n), sn = *(const f32x4*)(sinT + pos * 32 + 8 * fq + 4 * n);
                        const f32x4 y1 = x1[n] * rstd * g0[n], y2 = x2[n] * rstd * g1[n];
                        const f32x4 o1 = (y1 * cs - y2 * sn) * sc, o2 = (y2 * cs + y1 * sn) * sc;
                        if (n == 0) { w1.x = cvt_pk_bf16(o1[0], o1[1]); w1.y = cvt_pk_bf16(o1[2], o1[3]); w2.x = cvt_pk_bf16(o2[0], o2[1]); w2.y = cvt_pk_bf16(o2[2], o2[3]); }
                        else { w1.z = cvt_pk_bf16(o1[0], o1[1]); w1.w = cvt_pk_bf16(o1[2], o1[3]); w2.z = cvt_pk_bf16(o2[0], o2[1]); w2.w = cvt_pk_bf16(o2[2], o2[3]); }
                    }
                    *(u32x4*)(op) = w1; *(u32x4*)(op + 32) = w2;
                }
        }
    }
};
struct EpiRes {
    static constexpr bool PERM = false;
    const float* xin; float* xout; const float* gate;
    __device__ __forceinline__ void operator()(const f32x4 (&acc)[2][2][4][2], const Unit& u, int wr, int wc, int fr, int fq) const {
        const int row0 = u.pm * BM + wr * 64 + fr, col0 = u.pn * BM + wc * 32 + 4 * fq;
        const float* gp = gate + (size_t)(u.pm >> 5) * 6144 + col0;
        f32x4 gv[2][2];
#pragma unroll
        for (int bj = 0; bj < 2; ++bj)
#pragma unroll
            for (int n = 0; n < 2; ++n) gv[bj][n] = *(const f32x4*)(gp + bj * HALF + n * 16);
#pragma unroll
        for (int ai = 0; ai < 2; ++ai)
#pragma unroll
            for (int m = 0; m < 4; ++m) { const size_t off = (size_t)(row0 + ai * HALF + m * 16) * DM + col0;
#pragma unroll
                for (int bj = 0; bj < 2; ++bj)
#pragma unroll
                    for (int n = 0; n < 2; ++n) { const f32x4 xv = *(const f32x4*)(xin + off + bj * HALF + n * 16);
                        *(f32x4*)(xout + off + bj * HALF + n * 16) = xv + gv[bj][n] * acc[ai][bj][m][n]; }
                asm volatile("" ::: "memory"); }
    }
};
struct EpiSwiGLU {
    static constexpr bool PERM = true;
    bf16_t* H; int ldh;
    __device__ __forceinline__ void operator()(const f32x4 (&acc)[2][2][4][2], const Unit& u, int wr, int wc, int fr, int fq) const {
        const int row0 = u.pm * BM + wr * 64 + fr, col0 = u.pn * HALF + wc * 32 + 8 * fq;
#pragma unroll
        for (int ai = 0; ai < 2; ++ai)
#pragma unroll
            for (int m = 0; m < 4; ++m) { bf16_t* rowp = H + (size_t)(row0 + ai * HALF + m * 16) * ldh + col0;
                f32x4 v[2];
#pragma unroll
                for (int n = 0; n < 2; ++n) { const f32x4 gt = acc[ai][0][m][n], up = acc[ai][1][m][n];
#pragma unroll
                    for (int j = 0; j < 4; ++j) v[n][j] = fsilu(gt[j]) * up[j]; }
                u32x4 w; w.x = cvt_pk_bf16(v[0][0], v[0][1]); w.y = cvt_pk_bf16(v[0][2], v[0][3]); w.z = cvt_pk_bf16(v[1][0], v[1][1]); w.w = cvt_pk_bf16(v[1][2], v[1][3]);
                *(u32x4*)rowp = w; }
    }
};
struct EpiPlain {
    static constexpr bool PERM = true;
    bf16_t* O; int ldc;
    __device__ __forceinline__ void operator()(const f32x4 (&acc)[2][2][4][2], const Unit& u, int wr, int wc, int fr, int fq) const {
        const int row0 = u.pm * BM + wr * 64 + fr, col0 = u.pn * BM + wc * 32 + 8 * fq;
#pragma unroll
        for (int ai = 0; ai < 2; ++ai)
#pragma unroll
            for (int m = 0; m < 4; ++m) { bf16_t* rowp = O + (size_t)(row0 + ai * HALF + m * 16) * ldc + col0;
#pragma unroll
                for (int bj = 0; bj < 2; ++bj) { const f32x4 v0 = acc[ai][bj][m][0], v1 = acc[ai][bj][m][1];
                    u32x4 w; w.x = cvt_pk_bf16(v0[0], v0[1]); w.y = cvt_pk_bf16(v0[2], v0[3]); w.z = cvt_pk_bf16(v1[0], v1[1]); w.w = cvt_pk_bf16(v1[2], v1[3]);
                    *(u32x4*)(rowp + bj * HALF) = w; } }
    }
};
struct EpiAct {
    static constexpr bool PERM = true;
    int kind; unsigned char* ws; const float* lb;
    __device__ __forceinline__ void operator()(const f32x4 (&acc)[2][2][4][2], const Unit& u, int wr, int wc, int fr, int fq) const {
        const int row0 = u.pm * BM + wr * 64 + fr;
        int mode, ldc, colt; size_t boff;
        if (kind == 0) { const int grp = u.pn >> 2; colt = (u.pn & 3) * 256; ldc = 1024;
            boff = grp == 0 ? H_Q : grp == 1 ? H_LFF : grp == 2 ? H_LFB : grp == 3 ? H_V : H_G; mode = (grp == 0 || grp == 4) ? 1 : (grp == 3 ? 0 : 3); }
        else { ldc = LRUW; if (u.pn < 5) { boff = L_YB; colt = u.pn * 256; mode = 2; } else { boff = L_XB; colt = (u.pn - 5) * 256; mode = 0; } }
        bf16_t* base = (bf16_t*)(ws + boff);
        const int col0 = colt + wc * 32 + 8 * fq;
        f32x4 lbv[2][2];
        if (mode == 3) { const float* lp = lb + ((u.pn >> 2) - 1) * 1024 + col0;
#pragma unroll
            for (int bj = 0; bj < 2; ++bj)
#pragma unroll
                for (int n = 0; n < 2; ++n) lbv[bj][n] = *(const f32x4*)(lp + bj * HALF + 4 * n); }
#pragma unroll
        for (int ai = 0; ai < 2; ++ai)
#pragma unroll
            for (int m = 0; m < 4; ++m) { bf16_t* rowp = base + (size_t)(row0 + ai * HALF + m * 16) * ldc + col0;
#pragma unroll
                for (int bj = 0; bj < 2; ++bj) { f32x4 v[2]; u32x4 w;
#pragma unroll
                    for (int n = 0; n < 2; ++n) { v[n] = acc[ai][bj][m][n];
                        if (mode == 1) {
#pragma unroll
                            for (int j = 0; j < 4; ++j) v[n][j] = fsilu(v[n][j]); }
                        else if (mode == 2) {
#pragma unroll
                            for (int j = 0; j < 4; ++j) { const float x = v[n][j]; v[n][j] = x * fsigmoid(1.5957691216057308f * (x + 0.044715f * x * x * x)); } }
                        else if (mode == 3) {
#pragma unroll
                            for (int j = 0; j < 4; ++j) { const float l = lbv[bj][n][j]; const float fg = l + (1.0f - l) * fsigmoid(v[n][j]); v[n][j] = __builtin_amdgcn_logf(fg) * 0.6931471805599453f; } }
                    }
                    if (mode == 3) {
#pragma unroll
                        for (int n = 0; n < 2; ++n) { const _Float16 h0 = (_Float16)v[n][0], h1 = (_Float16)v[n][1], h2 = (_Float16)v[n][2], h3 = (_Float16)v[n][3];
                            const unsigned a = (unsigned)__builtin_bit_cast(unsigned short, h0) | ((unsigned)__builtin_bit_cast(unsigned short, h1) << 16);
                            const unsigned b = (unsigned)__builtin_bit_cast(unsigned short, h2) | ((unsigned)__builtin_bit_cast(unsigned short, h3) << 16);
                            if (n == 0) { w.x = a; w.y = b; } else { w.z = a; w.w = b; } }
                    } else { w.x = cvt_pk_bf16(v[0][0], v[0][1]); w.y = cvt_pk_bf16(v[0][2], v[0][3]); w.z = cvt_pk_bf16(v[1][0], v[1][1]); w.w = cvt_pk_bf16(v[1][2], v[1][3]); }
                    *(u32x4*)(rowp + bj * HALF) = w; } }
    }
};
}

struct Args { const float* in[30]; float* out; unsigned char* ws; };
enum { I_X = 0, I_C, I_ADAW, I_ADAB, I_N1G, I_N2G, I_ATWIN, I_ATQN, I_ATKN, I_ATLAM, I_ATSUB, I_ATWOUT, I_HGWIN, I_HGLB, I_HGNG, I_HGWOUT,
       I_LRWIN, I_LRCW, I_LRCB, I_LRWA, I_LRBA, I_LRWX, I_LRBX, I_LRLAM, I_LRWOUT, I_FFGU, I_FFDN, I_MOER, I_MOEGU, I_MOEDN };
enum { SC_LAM0 = 0, SC_LAM1, SC_OML0, SC_OML1, SC_MC0, SC_MC1 };

__device__ __forceinline__ void cvt_item(const float* W, int ldw, int src_col0, bf16_t* WT, int ldt, int dst_row0, int k0, LAS float* scr, int lane) {
#pragma unroll 8
    for (int i = 0; i < 32; ++i) { const int kk = 2 * i + (lane >> 5); scr[kk * 33 + (lane & 31)] = W[(size_t)(k0 + kk) * ldw + src_col0 + (lane & 31)]; }
    LDS_WAIT(); asm volatile("" ::: "memory");
    const int c = lane & 7;
#pragma unroll
    for (int j = 0; j < 4; ++j) { const int n = (lane >> 3) + 8 * j; const LAS float* s = scr + (8 * c) * 33 + n;
        u32x4 o; o.x = cvt_pk_bf16(s[0 * 33], s[1 * 33]); o.y = cvt_pk_bf16(s[2 * 33], s[3 * 33]); o.z = cvt_pk_bf16(s[4 * 33], s[5 * 33]); o.w = cvt_pk_bf16(s[6 * 33], s[7 * 33]);
        *(u32x4*)(WT + (size_t)(dst_row0 + n) * ldt + k0 + 8 * c) = o; }
    LDS_WAIT(); asm volatile("" ::: "memory");
}
enum { MAP_ID = 0, MAP_QKV = 1, MAP_SWI = 2 };
__device__ __forceinline__ void cvt_family(const float* src, size_t sstride, int ninst, int ldw, int K, int ng, int map, int F, bf16_t* dst, size_t dstride,
                                           LAS float* scr, int gw, int NGW, int lane) {
    const int nkb = K / 64, per = nkb * ng, total = ninst * per;
    for (int it = gw; it < total; it += NGW) {
        const int inst = it / per, r = it - inst * per, kb = r / ng, gi = r - kb * ng;
        int sc0;
        if (map == MAP_ID) sc0 = 32 * gi;
        else if (map == MAP_QKV) { const int pn = gi >> 3, bj = (gi >> 2) & 1, wc = gi & 3;
            if (pn < 8) { const int part = pn >> 2, sh = 4 * (pn & 3) + wc; sc0 = part * 1024 + sh * 64 + 32 * bj; } else sc0 = 32 * gi; }
        else { const int pn = gi >> 3, bj = (gi >> 2) & 1, q = gi & 3; sc0 = bj * F + pn * 128 + 32 * q; }
        cvt_item(src + (size_t)inst * sstride, ldw, sc0, dst + (size_t)inst * dstride, K, 32 * gi, 64 * kb, scr, lane);
    }
}

__device__ __forceinline__ void prologue_phase(const Args& A, LAS unsigned char* lds, int bid, int G) {
    const int tid = threadIdx.x, lane = tid & 63, wave = tid >> 6;
    unsigned char* ws = A.ws;
    {
        LAS float* sc = (LAS float*)lds;
        LAS float* red = (LAS float*)(lds + 32768);
        for (int i = tid; i < NBATCH * DM; i += NTHR) { const float cv = A.in[I_C][i]; sc[i] = fsilu(cv); }
        __syncthreads();
        float* mods = (float*)(ws + TB_MODS);
        for (int cb = bid; cb < (DEPTH * 6144) / 128; cb += G) {
            const int col = cb * 128 + (tid & 127), l = col / 6144, e = col - l * 6144, ch = tid >> 7;
            const float* wp = A.in[I_ADAW] + (size_t)l * DM * 6144 + e;
            float a[NBATCH];
#pragma unroll
            for (int b = 0; b < NBATCH; ++b) a[b] = 0.f;
#pragma unroll 4
            for (int d = ch * 256; d < ch * 256 + 256; ++d) { const float w = wp[(size_t)d * 6144];
#pragma unroll
                for (int b = 0; b < NBATCH; ++b) a[b] += sc[b * DM + d] * w; }
#pragma unroll
            for (int b = 0; b < NBATCH; ++b) red[(ch * 128 + (tid & 127)) * 8 + b] = a[b];
            __syncthreads();
            if (tid < 128) { const float bias = A.in[I_ADAB][l * 6144 + e];
#pragma unroll
                for (int b = 0; b < NBATCH; ++b) { const float s = ((red[(0 * 128 + tid) * 8 + b] + red[(1 * 128 + tid) * 8 + b]) + (red[(2 * 128 + tid) * 8 + b] + red[(3 * 128 + tid) * 8 + b])) + bias;
                    mods[((size_t)l * NBATCH + b) * 6144 + e] = s; } }
            __syncthreads();
        }
    }
    {
        float* cosT = (float*)(ws + TB_COS); float* sinT = (float*)(ws + TB_SIN);
        for (int i = bid * NTHR + tid; i < SEQ * 32; i += G * NTHR) {
            const int pos = i >> 5, d = i & 31;
            const float inv = (float)exp(-(double)d * (1.0 / 32.0) * 9.210340371976184);
            const float ang = (float)pos * inv;
            const double rev = (double)ang * 0.15915494309189535; const float fr = (float)(rev - floor(rev));
            cosT[i] = __builtin_amdgcn_cosf(fr); sinT[i] = __builtin_amdgcn_sinf(fr);
        }
        if (bid == 0 && tid < 2) {
            const int a = tid; const float* lm = A.in[I_ATLAM] + a * 256;
            float s1 = 0.f, s2 = 0.f; for (int i = 0; i < 64; ++i) { s1 += lm[i] * lm[64 + i]; s2 += lm[128 + i] * lm[192 + i]; }
            const float linit = 0.8f - 0.6f * expf(-0.3f * (float)(3 * a));
            float mq = 0.f, mk = 0.f; for (int i = 0; i < 64; ++i) { mq = fmaxf(mq, fabsf(A.in[I_ATQN][a * 64 + i])); mk = fmaxf(mk, fabsf(A.in[I_ATKN][a * 64 + i])); }
            float* scal = (float*)(ws + TB_SCAL);
            scal[SC_LAM0 + a] = expf(s1) - expf(s2) + linit; scal[SC_OML0 + a] = 1.0f - linit; scal[SC_MC0 + a] = 8.0f * mq * mk * LOG2E * 1.0001f;
        }
        if (bid == 1) {
            float* lb = (float*)(ws + TB_LB);
            for (int i = tid; i < 2 * 1024; i += NTHR) { const int d = i >> 10, k = i & 1023; const float* p = A.in[I_HGLB] + (size_t)d * DEPTH * 1024 + k;
                float mx = p[0]; for (int l = 1; l < DEPTH; ++l) mx = fmaxf(mx, p[l * 1024]);
                float den = 0.f, num = 0.f; for (int l = 0; l < DEPTH; ++l) { const float e = expf(p[l * 1024] - mx); den += e; if (l == 1) num += e; }
                lb[i] = num / den; }
        }
        if (bid == 2) {
            float* sp = (float*)(ws + TB_SP);
            for (int i = tid; i < 2 * LRUW; i += NTHR) { const float x = -A.in[I_LRLAM][i]; sp[i] = (x > 20.f) ? x : log1pf(expf(x)); }
        }
    }
    {
        LAS float* scr = (LAS float*)(lds + wave * 16384);
        const int vcu = (bid % 8) * (G / 8) + bid / 8;
        const int gw = vcu * NWAVES + wave, NGW = G * NWAVES;
        cvt_family(A.in[I_ATWIN], (size_t)1024 * 3072, 2, 3072, 1024, 96, MAP_QKV, 0, (bf16_t*)(ws + W_QKV), (size_t)3072 * 1024, scr, gw, NGW, lane);
        cvt_family(A.in[I_ATWOUT], (size_t)1024 * 1024, 2, 1024, 1024, 32, MAP_ID, 0, (bf16_t*)(ws + W_AO), (size_t)1024 * 1024, scr, gw, NGW, lane);
        cvt_family(A.in[I_HGWIN], 0, 1, 5120, 1024, 160, MAP_ID, 0, (bf16_t*)(ws + W_HGI), 0, scr, gw, NGW, lane);
        cvt_family(A.in[I_HGWOUT], 0, 1, 1024, 1024, 32, MAP_ID, 0, (bf16_t*)(ws + W_HGO), 0, scr, gw, NGW, lane);
        cvt_family(A.in[I_LRWIN], 0, 1, 2560, 1024, 80, MAP_ID, 0, (bf16_t*)(ws + W_LRI), 0, scr, gw, NGW, lane);
        cvt_family(A.in[I_LRWOUT], 0, 1, 1024, 1280, 32, MAP_ID, 0, (bf16_t*)(ws + W_LRO), 0, scr, gw, NGW, lane);
        for (int it = gw; it < 2 * 20 * 2 * 4; it += NGW) {
            const int part = it / 160, r = it % 160, inst = r >> 3, kb = (r >> 2) & 1, gi = r & 3, d = inst / 10, n = inst % 10;
            const float* src = (part ? A.in[I_LRWX] : A.in[I_LRWA]) + (size_t)inst * 16384;
            cvt_item(src, 128, 32 * gi, (bf16_t*)(ws + W_LRG) + (size_t)(n * 2 + d) * 256 * 128, 128, part * 128 + 32 * gi, 64 * kb, scr, lane);
        }
        cvt_family(A.in[I_FFGU], (size_t)1024 * 5632, 2, 5632, 1024, 176, MAP_SWI, DFF, (bf16_t*)(ws + W_FGU), (size_t)5632 * 1024, scr, gw, NGW, lane);
        cvt_family(A.in[I_FFDN], (size_t)2816 * 1024, 2, 1024, 2816, 32, MAP_ID, 0, (bf16_t*)(ws + W_FDN), (size_t)1024 * 2816, scr, gw, NGW, lane);
        cvt_family(A.in[I_MOEGU], (size_t)1024 * 7168, 16, 7168, 1024, 224, MAP_SWI, DFFE, (bf16_t*)(ws + W_MGU), (size_t)7168 * 1024, scr, gw, NGW, lane);
        cvt_family(A.in[I_MOEDN], (size_t)3584 * 1024, 16, 1024, 3584, 32, MAP_ID, 0, (bf16_t*)(ws + W_MDN), (size_t)1024 * 3584, scr, gw, NGW, lane);
    }
}

template <bool ROUTER>
__device__ __forceinline__ void norm_phase(const Args& A, LAS unsigned char* lds, int bid, int G, const float* xsrc, float* xdst, const float* gain, const float* modl  , int which,
                                           bool combine, const float* modprev  , bool nonorm, const float* router) {
    int tid_ = threadIdx.x; asm volatile("" : "+v"(tid_));
    const int tid = tid_, lane = tid & 63, wave = tid >> 6;
    unsigned char* ws = A.ws;
    bf16_t* HM = (bf16_t*)(ws + WS_HM);
    const int* slot = (const int*)(ws + TB_SLOT); const float* gts = (const float*)(ws + TB_GATE);
    const bf16_t* Y = (const bf16_t*)(ws + E_XS);
    LAS int* hist = (LAS int*)lds;
    for (int tb = bid; tb < MTOK / 256; tb += G) {
        const int b = tb >> 5;
        f32x4 ga[4], sh[4], g2[4];
#pragma unroll
        for (int j = 0; j < 4; ++j) { const int c = 256 * j + 4 * lane;
            if (!nonorm) { const f32x4 gv = *(const f32x4*)(gain + c), sv = *(const f32x4*)(modl + (size_t)b * 6144 + (which * 3 + 1) * 1024 + c);
                ga[j] = gv * (sv + 1.0f); sh[j] = *(const f32x4*)(modl + (size_t)b * 6144 + (which * 3) * 1024 + c); }
            if (combine) g2[j] = *(const f32x4*)(modprev + (size_t)b * 6144 + 5 * 1024 + c); }
        f32x4 rw[ROUTER ? 32 : 1];
        if constexpr (ROUTER) {
            if (tid < 8) hist[tid] = 0;
#pragma unroll
            for (int j = 0; j < 4; ++j)
#pragma unroll
                for (int i = 0; i < 4; ++i) { const int c = 256 * j + 4 * lane + i; rw[(j * 4 + i) * 2] = *(const f32x4*)(router + c * 8); rw[(j * 4 + i) * 2 + 1] = *(const f32x4*)(router + c * 8 + 4); }
            __syncthreads();
        }
        for (int i = 0; i < 32; ++i) {
            const int row = tb * 256 + wave * 32 + i;
            const float* xr = xsrc + (size_t)row * DM;
            f32x4 v[4];
#pragma unroll
            for (int j = 0; j < 4; ++j) v[j] = *(const f32x4*)(xr + 256 * j + 4 * lane);
            if (combine) {
                const int s0 = slot[row * 2], s1 = slot[row * 2 + 1]; const float w0 = gts[row * 2], w1 = gts[row * 2 + 1];
#pragma unroll
                for (int j = 0; j < 4; ++j) { const u32x2 a = *(const u32x2*)(Y + (size_t)s0 * DM + 256 * j + 4 * lane), c2 = *(const u32x2*)(Y + (size_t)s1 * DM + 256 * j + 4 * lane);
                    f32x4 y; y[0] = w0 * bflo(a.x) + w1 * bflo(c2.x); y[1] = w0 * bfhi(a.x) + w1 * bfhi(c2.x); y[2] = w0 * bflo(a.y) + w1 * bflo(c2.y); y[3] = w0 * bfhi(a.y) + w1 * bfhi(c2.y);
                    v[j] = v[j] + g2[j] * y; *(f32x4*)(xdst + (size_t)row * DM + 256 * j + 4 * lane) = v[j]; }
            }
            if (nonorm) continue;
            float ss = 0.f;
#pragma unroll
            for (int j = 0; j < 4; ++j) ss += (v[j][0] * v[j][0] + v[j][1] * v[j][1]) + (v[j][2] * v[j][2] + v[j][3] * v[j][3]);
            ss = wave_sum(ss);
            const float rstd = 1.0f / sqrtf(ss * (1.0f / DM) + EPS);
            f32x4 h[4];
#pragma unroll
            for (int j = 0; j < 4; ++j) { h[j] = v[j] * rstd * ga[j] + sh[j];
                u32x2 w; w.x = cvt_pk_bf16(h[j][0], h[j][1]); w.y = cvt_pk_bf16(h[j][2], h[j][3]);
                *(u32x2*)(HM + (size_t)row * DM + 256 * j + 4 * lane) = w; }
            if constexpr (ROUTER) {
                float lg[8];
#pragma unroll
                for (int e = 0; e < 8; ++e) lg[e] = 0.f;
#pragma unroll
                for (int j = 0; j < 4; ++j)
#pragma unroll
                    for (int q = 0; q < 4; ++q) { const float hv = h[j][q]; const f32x4 r0 = rw[(j * 4 + q) * 2], r1 = rw[(j * 4 + q) * 2 + 1];
                        lg[0] += hv * r0[0]; lg[1] += hv * r0[1]; lg[2] += hv * r0[2]; lg[3] += hv * r0[3]; lg[4] += hv * r1[0]; lg[5] += hv * r1[1]; lg[6] += hv * r1[2]; lg[7] += hv * r1[3]; }
#pragma unroll
                for (int e = 0; e < 8; ++e) lg[e] = wave_sum(lg[e]);
                int e0 = 0; float v0 = lg[0];
#pragma unroll
                for (int e = 1; e < 8; ++e) if (lg[e] > v0) { v0 = lg[e]; e0 = e; }
                int e1 = -1; float v1 = -3.0e38f;
#pragma unroll
                for (int e = 0; e < 8; ++e) if (e != e0 && lg[e] > v1) { v1 = lg[e]; e1 = e; }
                const float p1 = frcp(1.0f + fexp(v1 - v0));
                if (lane == 0) { int* eid = (int*)(ws + TB_EID); float* gt = (float*)(ws + TB_GATE);
                    eid[row * 2] = e0; eid[row * 2 + 1] = e1; gt[row * 2] = p1; gt[row * 2 + 1] = 1.0f - p1;
                    atomicAdd((int*)&hist[e0], 1); atomicAdd((int*)&hist[e1], 1); }
            }
        }
        if constexpr (ROUTER) {
            __syncthreads();
            if (tid < 8) ((int*)(ws + TB_BCNT))[tb * 8 + tid] = hist[tid];
            __syncthreads();
        }
    }
}

namespace lru {
constexpr int XCF = 0, XCB = 16384, AA = 24576, UU = 40960;
__device__ __forceinline__ int sw256(int row, int cb) { return row * 256 + (cb ^ ((row & 7) << 4)); }
__device__ __forceinline__ int crow(int r, int hi) { return (r & 3) + 8 * (r >> 2) + 4 * hi; }
template <int MODE>
__device__ __forceinline__ void lru_item(const Args& A, LAS unsigned char* lds, int b, int n, int seg, int dir) {
    int tid_ = threadIdx.x; asm volatile("" : "+v"(tid_));
    const int tid = tid_, wid = tid >> 6, lane = tid & 63, r = lane & 31, hh = lane >> 5;
    unsigned char* ws = A.ws;
    const bf16_t* XB = (const bf16_t*)(ws + L_XB); const bf16_t* YB = (const bf16_t*)(ws + L_YB); bf16_t* HF = (bf16_t*)(ws + L_HF); bf16_t* HY = (bf16_t*)(ws + L_HY);
    const bf16_t* Wg = (const bf16_t*)(ws + W_LRG) + (size_t)((n * 2 + dir) * 256 + ((r < 16) ? (16 * wid + r) : (128 + 16 * wid + r - 16))) * 128 + 8 * hh;
    bf16x8 bfrag[8];
#pragma unroll
    for (int ks = 0; ks < 8; ++ks) bfrag[ks] = *(const bf16x8*)(Wg + 16 * ks);
    const int cch = n * 128 + 16 * wid + (r & 15);
    const float ba = A.in[I_LRBA][dir * LRUW + cch], bx = A.in[I_LRBX][dir * LRUW + cch], sp = ((const float*)(ws + TB_SP))[dir * LRUW + cch];
    const int ct = tid >> 4, cg = tid & 15, cc0 = n * 128 + 8 * cg;
    float cw[4][8], cb[8];
#pragma unroll
    for (int j = 0; j < 8; ++j) { cb[j] = A.in[I_LRCB][cc0 + j];
#pragma unroll
        for (int w = 0; w < 4; ++w) cw[w][j] = A.in[I_LRCW][w * LRUW + cc0 + j]; }
    float carry = 0.f, P = 1.f;
    if (MODE != 0 && tid < 128) carry = ((const float*)(ws + TB_LCIN))[(size_t)((b * 32 + seg) * 2 + dir) * LRUW + n * 128 + tid];
    u32x4 xr[4];
#define LRU_XLOAD(si_) do { const int sub_ = dir ? (7 - (si_)) : (si_); const int tok_ = seg * 256 + sub_ * 32 + ct; \
        _Pragma("unroll") for (int w = 0; w < 4; ++w) { const int tt = tok_ - 1 + w; xr[w] = (tt >= 0 && tt < SEQ) ? *(const u32x4*)(XB + ((size_t)b * SEQ + tt) * LRUW + cc0) : (u32x4){0u, 0u, 0u, 0u}; } } while (0)
    LRU_XLOAD(0);
    for (int si = 0; si < 8; ++si) {
        const int sub = dir ? (7 - si) : si; const int t0 = seg * 256 + sub * 32;
        {
            float xc[8];
#pragma unroll
            for (int j = 0; j < 8; ++j) xc[j] = cb[j];
#pragma unroll
            for (int w = 0; w < 4; ++w) { const u32x4 v = xr[w];
#pragma unroll
                for (int e = 0; e < 4; ++e) { xc[2 * e] += cw[w][2 * e] * bflo(v[e]); xc[2 * e + 1] += cw[w][2 * e + 1] * bfhi(v[e]); } }
            if (si + 1 < 8) LRU_XLOAD(si + 1);
            *(LAS f32x4*)(lds + XCF + (ct * 128 + 8 * cg) * 4) = (f32x4){xc[0], xc[1], xc[2], xc[3]};
            *(LAS f32x4*)(lds + XCF + (ct * 128 + 8 * cg + 4) * 4) = (f32x4){xc[4], xc[5], xc[6], xc[7]};
            *(LAS u32x4*)(lds + XCB + sw256(ct, 16 * cg)) = (u32x4){cvt_pk_bf16(xc[0], xc[1]), cvt_pk_bf16(xc[2], xc[3]), cvt_pk_bf16(xc[4], xc[5]), cvt_pk_bf16(xc[6], xc[7])};
        }
        __syncthreads();
        {
            f32x16 acc = {};
#pragma unroll
            for (int ks = 0; ks < 8; ++ks) { const bf16x8 fa = *(const LAS bf16x8*)(lds + XCB + sw256(r, (16 * ks + 8 * hh) * 2)); acc = __builtin_amdgcn_mfma_f32_32x32x16_bf16(fa, bfrag[ks], acc, 0, 0, 0); }
#pragma unroll
            for (int q = 0; q < 8; ++q) {
                const float send = (r < 16) ? acc[8 + q] : acc[q]; const float recv = __shfl_xor(send, 16);
                const float rp = (r < 16) ? acc[q] : recv, ip = (r < 16) ? recv : acc[8 + q];
                const int tq = crow((r < 16) ? q : (8 + q), hh); const int cl = 16 * wid + (r & 15);
                const float xcv = ((const LAS float*)(lds + XCF))[tq * 128 + cl];
                const float rg = fsigmoid(rp + ba), ig = fsigmoid(ip + bx); const float la = -8.0f * rg * sp;
                const float av = fexp(la), uv = sqrtf(fmaxf(1.0f - av * av, 0.f)) * ig * xcv;
                ((LAS float*)(lds + AA))[tq * 128 + cl] = av; ((LAS float*)(lds + UU))[tq * 128 + cl] = uv; }
        }
        __syncthreads();
        if (tid < 128) {
            LAS float* ap = (LAS float*)(lds + AA) + tid; LAS float* up = (LAS float*)(lds + UU) + tid; float av[32], uv[32];
#pragma unroll
            for (int i = 0; i < 32; ++i) { av[i] = ap[i * 128]; uv[i] = up[i * 128]; }
            if (dir == 0) {
#pragma unroll
                for (int i = 0; i < 32; ++i) { carry = av[i] * carry + uv[i]; if (MODE == 0) P *= av[i]; else uv[i] = carry; } }
            else {
#pragma unroll
                for (int i = 31; i >= 0; --i) { carry = av[i] * carry + uv[i]; if (MODE == 0) P *= av[i]; else uv[i] = carry; } }
            if (MODE != 0) {
#pragma unroll
                for (int i = 0; i < 32; ++i) up[i * 128] = uv[i]; }
        }
        if (MODE != 0) {
            __syncthreads();
            const int tok = t0 + ct; const size_t go = ((size_t)b * SEQ + tok) * LRUW + cc0;
            const f32x4 h0 = *(const LAS f32x4*)(lds + UU + (ct * 128 + 8 * cg) * 4), h1 = *(const LAS f32x4*)(lds + UU + (ct * 128 + 8 * cg + 4) * 4);
            if (MODE == 1) { *(u32x4*)(HF + go) = (u32x4){cvt_pk_bf16(h0[0], h0[1]), cvt_pk_bf16(h0[2], h0[3]), cvt_pk_bf16(h1[0], h1[1]), cvt_pk_bf16(h1[2], h1[3])}; }
            else { const u32x4 f = *(const u32x4*)(HF + go), y = *(const u32x4*)(YB + go);
                *(u32x4*)(HY + go) = (u32x4){cvt_pk_bf16((h0[0] + bflo(f[0])) * bflo(y[0]), (h0[1] + bfhi(f[0])) * bfhi(y[0])), cvt_pk_bf16((h0[2] + bflo(f[1])) * bflo(y[1]), (h0[3] + bfhi(f[1])) * bfhi(y[1])),
                                            cvt_pk_bf16((h1[0] + bflo(f[2])) * bflo(y[2]), (h1[1] + bfhi(f[2])) * bfhi(y[2])), cvt_pk_bf16((h1[2] + bflo(f[3])) * bflo(y[3]), (h1[3] + bfhi(f[3])) * bfhi(y[3]))}; }
        }
        __syncthreads();
    }
#undef LRU_XLOAD
    if (MODE == 0 && tid < 128) { float* sm = (float*)(ws + TB_LSUM) + (size_t)(((b * 32 + seg) * 2 + dir) * 2) * LRUW + n * 128 + tid; sm[0] = P; sm[LRUW] = carry; }
}
}
template <int MODE>
__device__ __forceinline__ void lru_phase(const Args& A, LAS unsigned char* lds, int bid, int G) {
    const int nitems = (MODE == 0) ? 5120 : 2560;
    for (int it = bid; it < nitems; it += G) {
        int b, n, seg, dir;
        if (MODE == 0) { dir = it & 1; const int r = it >> 1; seg = r & 31; n = (r >> 5) % 10; b = r / 320; }
        else { dir = MODE - 1; seg = it & 31; n = (it >> 5) % 10; b = it / 320; }
        lru::lru_item<MODE>(A, lds, b, n, seg, dir);
    }
}
__device__ __forceinline__ void lru_carry_phase(const Args& A, int bid, int G) {
    const float* sm = (const float*)(A.ws + TB_LSUM); float* cin = (float*)(A.ws + TB_LCIN);
    for (int idx = bid * NTHR + threadIdx.x; idx < NBATCH * 2 * LRUW; idx += G * NTHR) {
        const int b = idx / (2 * LRUW), r = idx % (2 * LRUW), dir = r / LRUW, ch = r % LRUW; float carry = 0.f;
        for (int i = 0; i < 32; ++i) { const int sg = dir ? (31 - i) : i; const size_t o = (size_t)((b * 32 + sg) * 2 + dir);
            cin[o * LRUW + ch] = carry; carry = sm[o * 2 * LRUW + ch] * carry + sm[o * 2 * LRUW + LRUW + ch]; }
    }
}

__device__ __forceinline__ void place_phase(const Args& A, LAS unsigned char* lds, int bid, int G) {
    int tid_ = threadIdx.x; asm volatile("" : "+v"(tid_));
    const int tid = tid_, lane = tid & 63, wave = tid >> 6; unsigned char* ws = A.ws;
    const int* bcnt = (const int*)(ws + TB_BCNT); const int* eid = (const int*)(ws + TB_EID); int* slot = (int*)(ws + TB_SLOT);
    const bf16_t* HM = (const bf16_t*)(ws + WS_HM); bf16_t* XS = (bf16_t*)(ws + E_XS);
    LAS int* tot = (LAS int*)lds; LAS int* pre = tot + 8; LAS int* rb = tot + 16; LAS int* wcn = tot + 32; LAS int* sl = tot + 64;
    for (int tb = bid; tb < MTOK / 256; tb += G) {
        { int t_ = 0, p_ = 0;
#pragma unroll
            for (int j = 0; j < 4; ++j) { const int blk = lane + 64 * j; const int v = bcnt[blk * 8 + wave]; t_ += v; p_ += (blk < tb) ? v : 0; }
#pragma unroll
            for (int o = 1; o < 64; o <<= 1) { t_ += __shfl_xor(t_, o); p_ += __shfl_xor(p_, o); }
            if (lane == 0) { tot[wave] = t_; pre[wave] = p_; } }
        __syncthreads();
        if (tid == 0) { int acc = 0; for (int e = 0; e < 8; ++e) { rb[e] = acc * 256; if (tb == 0) ((int*)(ws + TB_TILES))[e] = acc; acc += (tot[e] + 255) >> 8; } if (tb == 0) ((int*)(ws + TB_TILES))[8] = acc; }
        int e0 = -1, e1 = -1; unsigned long long mk0 = 0, mk1 = 0;
        if (tid < 256) { e0 = eid[(tb * 256 + tid) * 2]; e1 = eid[(tb * 256 + tid) * 2 + 1];
#pragma unroll
            for (int e = 0; e < 8; ++e) { const unsigned long long m = __ballot(e0 == e || e1 == e); if (lane == 0) wcn[wave * 8 + e] = __popcll(m); if (e0 == e) mk0 = m; if (e1 == e) mk1 = m; } }
        __syncthreads();
        if (tid < 256) { const unsigned long long lt = (1ull << lane) - 1ull; int b0 = rb[e0] + pre[e0] + __popcll(mk0 & lt), b1 = rb[e1] + pre[e1] + __popcll(mk1 & lt);
            for (int w = 0; w < wave; ++w) { b0 += wcn[w * 8 + e0]; b1 += wcn[w * 8 + e1]; }
            sl[tid * 2] = b0; sl[tid * 2 + 1] = b1; slot[(tb * 256 + tid) * 2] = b0; slot[(tb * 256 + tid) * 2 + 1] = b1; }
        __syncthreads();
        for (int i = 0; i < 32; ++i) { const int t = wave * 32 + i; const int s0 = sl[t * 2], s1 = sl[t * 2 + 1];
            const bf16_t* src = HM + (size_t)(tb * 256 + t) * DM + lane * 8;
            const u32x4 a = *(const u32x4*)src, b = *(const u32x4*)(src + 512);
            *(u32x4*)(XS + (size_t)s0 * DM + lane * 8) = a; *(u32x4*)(XS + (size_t)s0 * DM + lane * 8 + 512) = b;
            *(u32x4*)(XS + (size_t)s1 * DM + lane * 8) = a; *(u32x4*)(XS + (size_t)s1 * DM + lane * 8 + 512) = b; }
        __syncthreads();
    }
}

namespace att {
constexpr int KVBLK = 64;
constexpr int SHM_V = KVBLK * 128 * 2, SHM_K = KVBLK * 128 * 2;
#define KSWZ(row, colB) ((row) * 256 + ((colB) ^ (((row) & 7) << 4)))
#define SBAR() __builtin_amdgcn_sched_barrier(0)
__device__ __forceinline__ int crow(int r, int hi) { return (r & 3) + 8 * (r >> 2) + 4 * hi; }
__device__ __forceinline__ int v_st(int k, int c) { const int kk = (k & ~0xC) | ((k & 4) << 1) | ((k & 8) >> 1); return ((kk >> 3) * 4 + (c >> 5)) * 512 + ((kk & 7) * 32 + (c & 31)) * 2; }
__device__ __forceinline__ int v_rd_base(int lane) { return ((lane & 3) << 3) | (((lane >> 2) & 3) << 6) | (((lane >> 4) & 1) << 5) | (((lane >> 5) & 1) << 8); }
constexpr int v_rd_off(int d0, int ks, int half) { return d0 * 512 + ks * 4096 + half * 2048; }
template <int OFF> __device__ __forceinline__ s16x4 tr_read(int vb) {
    s16x4 r; asm volatile("ds_read_b64_tr_b16 %0, %1 offset:%2" : "=&v"(r) : "v"(vb), "i"(OFF) : "memory"); return r;
}
template <int D0> __device__ __forceinline__ void pv_one(f32x16& od, int vb, bf16x8 pa0, bf16x8 pa1, bf16x8 pa2, bf16x8 pa3) {
    const s16x4 l0 = tr_read<v_rd_off(D0, 0, 0)>(vb), h0 = tr_read<v_rd_off(D0, 0, 1)>(vb), l1 = tr_read<v_rd_off(D0, 1, 0)>(vb), h1 = tr_read<v_rd_off(D0, 1, 1)>(vb);
    const s16x4 l2 = tr_read<v_rd_off(D0, 2, 0)>(vb), h2 = tr_read<v_rd_off(D0, 2, 1)>(vb), l3 = tr_read<v_rd_off(D0, 3, 0)>(vb), h3 = tr_read<v_rd_off(D0, 3, 1)>(vb);
    asm volatile("s_waitcnt lgkmcnt(0)" ::: "memory"); SBAR();
#define PK(L, H) (bf16x8){L[0], L[1], L[2], L[3], H[0], H[1], H[2], H[3]}
    od = __builtin_amdgcn_mfma_f32_32x32x16_bf16(pa0, PK(l0, h0), od, 0, 0, 0);
    od = __builtin_amdgcn_mfma_f32_32x32x16_bf16(pa1, PK(l1, h1), od, 0, 0, 0);
    od = __builtin_amdgcn_mfma_f32_32x32x16_bf16(pa2, PK(l2, h2), od, 0, 0, 0);
    od = __builtin_amdgcn_mfma_f32_32x32x16_bf16(pa3, PK(l3, h3), od, 0, 0, 0);
#undef PK
}
__device__ __forceinline__ void pv_d0(f32x16* o, int vb, bf16x8 pa0, bf16x8 pa1, bf16x8 pa2, bf16x8 pa3) {
    pv_one<0>(o[0], vb, pa0, pa1, pa2, pa3); pv_one<1>(o[1], vb, pa0, pa1, pa2, pa3); pv_one<2>(o[2], vb, pa0, pa1, pa2, pa3); pv_one<3>(o[3], vb, pa0, pa1, pa2, pa3);
}
__device__ __forceinline__ void partialSM(f32x16& p0, f32x16& p1, float Mc) {
#pragma unroll
    for (int r = 0; r < 16; ++r) p0[r] = fexp2(p0[r]);
}
__device__ __forceinline__ void finishSM(f32x16& p0, f32x16& p1, float& l_reg, bf16x8& pa0, bf16x8& pa1, bf16x8& pa2, bf16x8& pa3) {
#pragma unroll
    for (int r = 0; r < 16; ++r) p1[r] = fexp2(p1[r]);
    float ps = 0;
#pragma unroll
    for (int r = 0; r < 16; ++r) ps += p0[r];
#pragma unroll
    for (int r = 0; r < 16; ++r) ps += p1[r];
    { auto rr = __builtin_amdgcn_permlane32_swap(__float_as_uint(ps), __float_as_uint(ps), false, false);
      ps = __uint_as_float(rr[0]) + __uint_as_float(rr[1]); }
    l_reg += ps;
#define PK4(P, BASE, OUT) do { unsigned a0 = cvt_pk_bf16(P[BASE + 0], P[BASE + 1]), a1 = cvt_pk_bf16(P[BASE + 2], P[BASE + 3]);   \
    unsigned b0 = cvt_pk_bf16(P[BASE + 4], P[BASE + 5]), b1 = cvt_pk_bf16(P[BASE + 6], P[BASE + 7]);                              \
    auto r0 = __builtin_amdgcn_permlane32_swap(a0, b0, false, false); auto r1 = __builtin_amdgcn_permlane32_swap(a1, b1, false, false); \
    u32x4 w = {r0[0], r1[0], r0[1], r1[1]}; OUT = *reinterpret_cast<bf16x8*>(&w); } while (0)
    PK4(p0, 0, pa0); PK4(p0, 8, pa1); PK4(p1, 0, pa2); PK4(p1, 8, pa3);
#undef PK4
}
__device__ __forceinline__ void qkt(f32x16& p0, f32x16& p1, const LAS char* Ks, const bf16x8* qr, int r32, int hi, int jj, float nMc) {
#pragma unroll
    for (int r = 0; r < 16; ++r) { p0[r] = nMc; p1[r] = nMc; }
#pragma unroll
    for (int d0 = 0; d0 < 4; ++d0) { const int cb = ((jj * 4 + d0) * 16 + hi * 8) * 2;
        const bf16x8 b0 = *(const LAS bf16x8*)(Ks + KSWZ(r32, cb));
        const bf16x8 b1 = *(const LAS bf16x8*)(Ks + KSWZ(32 + r32, cb));
        p0 = __builtin_amdgcn_mfma_f32_32x32x16_bf16(b0, qr[d0], p0, 0, 0, 0);
        p1 = __builtin_amdgcn_mfma_f32_32x32x16_bf16(b1, qr[d0], p1, 0, 0, 0); }
}
__device__ __forceinline__ void attn_unit(const bf16_t* __restrict__ Qb, const bf16_t* __restrict__ Kh, const bf16_t* __restrict__ Vh, bf16_t* __restrict__ Ob,
                                          float lamv, float Mc, const float* __restrict__ subg, float omli, LAS char* lds) {
    int tid_ = threadIdx.x; asm volatile("" : "+v"(tid_));
    const int tid = tid_, wid = tid >> 6, lane = tid & 63, r32 = lane & 31, hi = lane >> 5, jj = wid >> 2, wq = wid & 3;
    LAS char* V_lds = lds; LAS char* K_lds = lds + 2 * SHM_V;
    LAS float* li_l = (LAS float*)(lds + 2 * SHM_V + 2 * SHM_K) + wid * 64;
    float l_reg = 0; f32x16 o[4] = {}; bf16x8 qr[4];
    const bf16_t* Qw = Qb + (size_t)(wq * 32 + r32) * DM + jj * 64 + hi * 8;
#pragma unroll
    for (int d0 = 0; d0 < 4; ++d0) qr[d0] = *(const bf16x8*)(Qw + d0 * 16);
    const int sr = tid >> 4, sc = (tid & 15) * 8, vst0 = v_st(sr, sc), vst1 = v_st(32 + sr, sc);
    const int vb0 = (int)(uintptr_t)V_lds + v_rd_base(lane);
    struct { bf16x8 vs0, vs1, ks0, ks1; } sr_[2];
#define SLOAD(i, k0) do { sr_[i].vs0 = *(const bf16x8*)(&Vh[(size_t)((k0) + sr) * DM + sc]); sr_[i].vs1 = *(const bf16x8*)(&Vh[(size_t)((k0) + 32 + sr) * DM + sc]); \
    sr_[i].ks0 = *(const bf16x8*)(&Kh[(size_t)((k0) + sr) * DM + sc]); sr_[i].ks1 = *(const bf16x8*)(&Kh[(size_t)((k0) + 32 + sr) * DM + sc]); } while (0)
#define SWRITE(b, i) do { *(LAS bf16x8*)(V_lds + (b) * SHM_V + vst0) = sr_[i].vs0;          \
    *(LAS bf16x8*)(V_lds + (b) * SHM_V + vst1) = sr_[i].vs1; const int kc = sc * 2;               \
    *(LAS bf16x8*)(K_lds + (b) * SHM_K + KSWZ(sr, kc)) = sr_[i].ks0;                       \
    *(LAS bf16x8*)(K_lds + (b) * SHM_K + KSWZ(32 + sr, kc)) = sr_[i].ks1; } while (0)
#define SWAIT() asm volatile("s_waitcnt vmcnt(4)" ::: "memory")
    f32x16 pA0, pA1, pB0, pB1; bf16x8 pa0, pa1, pa2, pa3; constexpr int NT = SEQ / KVBLK;
    constexpr int SE = 0, SO = 1;
    SLOAD(SE, 0); asm volatile("s_waitcnt vmcnt(0)" ::: "memory"); SWRITE(0, SE); __syncthreads();
    qkt(pA0, pA1, K_lds, qr, r32, hi, jj, -Mc); partialSM(pA0, pA1, Mc);
    SLOAD(SO, KVBLK); SLOAD(SE, 2 * KVBLK);
    SWAIT(); SWRITE(1, SO); __syncthreads();
    for (int j = 1; j + 1 < NT; j += 2) {
        SBAR(); qkt(pB0, pB1, K_lds + SHM_K, qr, r32, hi, jj, -Mc);
        finishSM(pA0, pA1, l_reg, pa0, pa1, pa2, pa3); SBAR();
        SLOAD(SO, (j + 2) * KVBLK); SBAR();
        pv_d0(o, vb0, pa0, pa1, pa2, pa3); partialSM(pB0, pB1, Mc);
        __syncthreads(); SWAIT(); SWRITE(0, SE);
        __syncthreads();
        SBAR(); qkt(pA0, pA1, K_lds, qr, r32, hi, jj, -Mc);
        finishSM(pB0, pB1, l_reg, pa0, pa1, pa2, pa3); SBAR();
        if (j + 3 < NT) SLOAD(SE, (j + 3) * KVBLK); SBAR();
        pv_d0(o, vb0 + SHM_V, pa0, pa1, pa2, pa3); partialSM(pA0, pA1, Mc);
        __syncthreads(); SWAIT(); SWRITE(1, SO);
        __syncthreads();
    }
    SBAR(); qkt(pB0, pB1, K_lds + SHM_K, qr, r32, hi, jj, -Mc);
    finishSM(pA0, pA1, l_reg, pa0, pa1, pa2, pa3); SBAR();
    pv_d0(o, vb0, pa0, pa1, pa2, pa3); partialSM(pB0, pB1, Mc);
    __syncthreads();
    finishSM(pB0, pB1, l_reg, pa0, pa1, pa2, pa3); SBAR();
    pv_d0(o, vb0 + SHM_V, pa0, pa1, pa2, pa3);
    int r32e = r32, hie = hi; asm volatile("" : "+v"(r32e), "+v"(hie));
#define r32 r32e
#define hi hie
    if (hi == 0) li_l[r32] = l_reg; asm volatile("s_waitcnt lgkmcnt(0)" ::: "memory");
    float rli[16];
#pragma unroll
    for (int r = 0; r < 16; ++r) rli[r] = frcp(li_l[crow(r, hi)]);
    __syncthreads();
    LAS float* Cb = (LAS float*)lds;
    if (jj == 1) {
#pragma unroll
        for (int r = 0; r < 16; ++r) { const float s = rli[r] * lamv;
#pragma unroll
            for (int d0 = 0; d0 < 4; ++d0) Cb[(wq * 32 + crow(r, hi)) * 128 + d0 * 32 + r32] = o[d0][r] * s; }
    }
    __syncthreads();
    if (jj == 0) {
        float g[4];
#pragma unroll
        for (int d0 = 0; d0 < 4; ++d0) g[d0] = subg[d0 * 32 + r32] * omli;
#pragma unroll
        for (int r = 0; r < 16; ++r) {
            float ss = 0.f;
#pragma unroll
            for (int d0 = 0; d0 < 4; ++d0) { const float v = o[d0][r] * rli[r] - Cb[(wq * 32 + crow(r, hi)) * 128 + d0 * 32 + r32]; o[d0][r] = v; ss += v * v; }
            ss += __shfl_xor(ss, 1); ss += __shfl_xor(ss, 2); ss += __shfl_xor(ss, 4); ss += __shfl_xor(ss, 8); ss += __shfl_xor(ss, 16);
            const float rs = 1.0f / sqrtf(ss * (1.0f / 128.0f) + EPS);
            bf16_t* op = Ob + (size_t)(wq * 32 + crow(r, hi)) * DM + r32;
#pragma unroll
            for (int d0 = 0; d0 < 4; ++d0) op[d0 * 32] = (bf16_t)f2bf(o[d0][r] * rs * g[d0]);
        }
    }
    __syncthreads();
#undef r32
#undef hi
#undef SLOAD
#undef SWRITE
#undef SWAIT
}
}

__device__ __forceinline__ void attn_phase(const Args& A, LAS unsigned char* lds, int bid, int G, int al) {
    unsigned char* ws = A.ws;
    const bf16_t* Q = (const bf16_t*)(ws + A_Q); const bf16_t* K = (const bf16_t*)(ws + A_K); const bf16_t* V = (const bf16_t*)(ws + A_V);
    bf16_t* O = (bf16_t*)(ws + WS_HM);
    const float* scal = (const float*)(ws + TB_SCAL);
    const float lamv = scal[SC_LAM0 + al], omli = scal[SC_OML0 + al], Mc = scal[SC_MC0 + al];
    const float* subg = A.in[I_ATSUB] + al * 128;
    const int x = bid & 7, c = bid >> 3;
    for (int i = 0; i < 16; ++i) {
        const int bh = x * 8 + (i >> 1), qb = (i & 1) * 32 + c;
        const int b = bh >> 3, h = bh & 7;
        const size_t base = (size_t)b * SEQ * DM + h * 128;
        att::attn_unit(Q + base + (size_t)qb * 128 * DM, K + base, V + base, O + base + (size_t)qb * 128 * DM, lamv, Mc, subg, omli, (LAS char*)lds);
    }
}

namespace gla {
constexpr int BC = 0, QI = 32768, QA = 49152, KA = 65536, KST = 81920, VT = 98304, ST = 106496, AT = 122880, EM = 131072, EL = EM + 512, DD = EM + 1024, BMID = EM + 1536, SEG = EM + 2048;
static_assert(SEG + 2048 <= RING_BYTES, "gla lds");
__device__ __forceinline__ int sw256(int row, int cb) { return row * 256 + (cb ^ ((row & 15) << 4)); }
__device__ __forceinline__ int sw128(int row, int cb) { return row * 128 + (cb ^ ((((row & 7) ^ (row >> 4)) & 7) << 4)); }
__device__ __forceinline__ int crow(int r, int hi) { return (r & 3) + 8 * (r >> 2) + 4 * hi; }
__device__ __forceinline__ float h2f(unsigned short b) { return (float)__builtin_bit_cast(_Float16, b); }
__device__ __forceinline__ void gla_item(const bf16_t* __restrict__ Qp, const unsigned short* __restrict__ LFp, const bf16_t* __restrict__ Vp, bf16_t* __restrict__ Op, int dir, LAS unsigned char* lds, float* dbg) {
    int tid_ = threadIdx.x; asm volatile("" : "+v"(tid_));
    const int tid = tid_, wid = tid >> 6, lane = tid & 63, r = lane & 31, hh = lane >> 5;
    const int t1 = tid >> 3, kg = tid & 7, k0 = 16 * kg, v0 = (tid & 7) * 8;
    for (int i = tid; i < 16384 / 16; i += NTHR) *(LAS u32x4*)(lds + ST + i * 16) = (u32x4){0u, 0u, 0u, 0u};
    f32x16 st = {};
    u32x4 rq[2], rl[2], rv;
#define GLA_TOK(ci, i) (dir ? (SEQ - 1 - ((ci) * 64 + (i))) : ((ci) * 64 + (i)))
#define GLA_LOAD(ci) do { const size_t to = (size_t)GLA_TOK(ci, t1) * DM; \
        rq[0] = *(const u32x4*)(Qp + to + k0); rq[1] = *(const u32x4*)(Qp + to + k0 + 8); \
        rl[0] = *(const u32x4*)(LFp + to + k0); rl[1] = *(const u32x4*)(LFp + to + k0 + 8); rv = *(const u32x4*)(Vp + to + v0); } while (0)
    GLA_LOAD(0);
    __syncthreads();
    for (int ci = 0; ci < SEQ / 64; ++ci) {
        float qf[16], lf[16]; u32x4 vreg = rv;
#pragma unroll
        for (int j = 0; j < 2; ++j)
#pragma unroll
            for (int e = 0; e < 4; ++e) { qf[j * 8 + 2 * e] = bflo(rq[j][e]); qf[j * 8 + 2 * e + 1] = bfhi(rq[j][e]);
                lf[j * 8 + 2 * e] = h2f((unsigned short)(rl[j][e] & 0xffffu)); lf[j * 8 + 2 * e + 1] = h2f((unsigned short)(rl[j][e] >> 16)); }
        if (ci + 1 < SEQ / 64) GLA_LOAD(ci + 1);
#pragma unroll
        for (int j = 0; j < 4; ++j) *(LAS f32x4*)(lds + BC + (t1 * 128 + k0 + 4 * j) * 4) = (f32x4){lf[4 * j], lf[4 * j + 1], lf[4 * j + 2], lf[4 * j + 3]};
        __syncthreads();
        { const int kc = tid & 127, sg = tid >> 7; LAS float* bc = (LAS float*)(lds + BC) + kc; float cs[16];
#pragma unroll
            for (int i = 0; i < 16; ++i) cs[i] = bc[(sg * 16 + i) * 128];
#pragma unroll
            for (int i = 1; i < 16; ++i) cs[i] += cs[i - 1];
            ((LAS float*)(lds + SEG))[sg * 128 + kc] = cs[15];
            __syncthreads();
            const LAS float* sgp = (const LAS float*)(lds + SEG) + kc; const float s0 = sgp[0], s1 = sgp[128], s2 = sgp[256], s3 = sgp[384];
            const float off = sg == 0 ? 0.f : sg == 1 ? s0 : sg == 2 ? (s0 + s1) : ((s0 + s1) + s2);
#pragma unroll
            for (int i = 0; i < 16; ++i) bc[(sg * 16 + i) * 128] = cs[i] + off;
            if (sg == 0) { const float bm = s0 + s1, bl = ((s0 + s1) + s2) + s3;
                ((LAS float*)(lds + BMID))[kc] = bm; ((LAS float*)(lds + EM))[kc] = fexp(bm); ((LAS float*)(lds + EL))[kc] = fexp(bl - bm); ((LAS float*)(lds + DD))[kc] = fexp(bl); }
            __syncthreads();
        }
#ifdef DIAG
        if (dbg && ci == 0) { for (int i = tid; i < 8192; i += NTHR) dbg[i] = ((const LAS float*)(lds + BC))[i]; }
#endif
        {
            unsigned wqi[8], wqa[8], wka[8]; float ksv[16];
#pragma unroll
            for (int j = 0; j < 4; ++j) {
                const f32x4 bt = *(const LAS f32x4*)(lds + BC + (t1 * 128 + k0 + 4 * j) * 4), bm = *(const LAS f32x4*)(lds + BMID + (k0 + 4 * j) * 4);
                const f32x4 em = *(const LAS f32x4*)(lds + EM + (k0 + 4 * j) * 4), el = *(const LAS f32x4*)(lds + EL + (k0 + 4 * j) * 4);
                float qi[4], qa[4], ka[4];
#pragma unroll
                for (int e = 0; e < 4; ++e) { const int i = 4 * j + e; const float e1 = fexp(bt[e] - bm[e]), r1 = frcp(e1);
                    qa[e] = qf[i] * e1; qi[e] = qa[e] * em[e]; const float kk = 1.0f - fexp(lf[i]); ka[e] = kk * r1; ksv[i] = ka[e] * el[e]; }
                wqi[2 * j] = cvt_pk_bf16(qi[0], qi[1]); wqi[2 * j + 1] = cvt_pk_bf16(qi[2], qi[3]);
                wqa[2 * j] = cvt_pk_bf16(qa[0], qa[1]); wqa[2 * j + 1] = cvt_pk_bf16(qa[2], qa[3]);
                wka[2 * j] = cvt_pk_bf16(ka[0], ka[1]); wka[2 * j + 1] = cvt_pk_bf16(ka[2], ka[3]);
            }
#pragma unroll
            for (int j = 0; j < 2; ++j) { const int off = sw256(t1, (k0 + 8 * j) * 2);
                *(LAS u32x4*)(lds + QI + off) = (u32x4){wqi[4 * j], wqi[4 * j + 1], wqi[4 * j + 2], wqi[4 * j + 3]};
                *(LAS u32x4*)(lds + QA + off) = (u32x4){wqa[4 * j], wqa[4 * j + 1], wqa[4 * j + 2], wqa[4 * j + 3]};
                *(LAS u32x4*)(lds + KA + off) = (u32x4){wka[4 * j], wka[4 * j + 1], wka[4 * j + 2], wka[4 * j + 3]}; }
#pragma unroll
            for (int i = 0; i < 16; ++i) *(LAS unsigned short*)(lds + KST + sw128(k0 + i, t1 * 2)) = (unsigned short)f2bf(ksv[i]);
#pragma unroll
            for (int e = 0; e < 4; ++e) { *(LAS unsigned short*)(lds + VT + sw128(v0 + 2 * e, t1 * 2)) = (unsigned short)(vreg[e] & 0xffffu);
                *(LAS unsigned short*)(lds + VT + sw128(v0 + 2 * e + 1, t1 * 2)) = (unsigned short)(vreg[e] >> 16); }
        }
        __syncthreads();
        f32x16 oacc = {};
        const int w4 = wid & 3, t_i = w4 >> 1, v_i = w4 & 1;
        if (wid < 4) {
            const int s_i = wid >> 1, tq = wid & 1; f32x16 a = {};
#pragma unroll
            for (int ks = 0; ks < 8; ++ks) { const bf16x8 fa = *(const LAS bf16x8*)(lds + KA + sw256(32 * s_i + r, (16 * ks + 8 * hh) * 2)), fb = *(const LAS bf16x8*)(lds + QA + sw256(32 * tq + r, (16 * ks + 8 * hh) * 2));
                a = __builtin_amdgcn_mfma_f32_32x32x16_bf16(fa, fb, a, 0, 0, 0); }
            const int tg = 32 * tq + r;
#pragma unroll
            for (int g = 0; g < 4; ++g) { float m[4];
#pragma unroll
                for (int e = 0; e < 4; ++e) { const int sgl = 32 * s_i + 8 * g + 4 * hh + e; m[e] = (sgl <= tg) ? a[4 * g + e] : 0.f; }
                *(LAS u32x2*)(lds + AT + sw128(tg, (32 * s_i + 8 * g + 4 * hh) * 2)) = (u32x2){cvt_pk_bf16(m[0], m[1]), cvt_pk_bf16(m[2], m[3])}; }
        } else {
#pragma unroll
            for (int ks = 0; ks < 8; ++ks) { const bf16x8 fa = *(const LAS bf16x8*)(lds + QI + sw256(32 * t_i + r, (16 * ks + 8 * hh) * 2)), fb = *(const LAS bf16x8*)(lds + ST + sw256(32 * v_i + r, (16 * ks + 8 * hh) * 2));
                oacc = __builtin_amdgcn_mfma_f32_32x32x16_bf16(fa, fb, oacc, 0, 0, 0); }
        }
        __syncthreads();
#ifdef DIAG
        if (dbg && ci == 0) { for (int i = tid; i < 2048; i += NTHR) { ((unsigned*)dbg)[8192 + i] = ((const LAS unsigned*)(lds + AT))[i]; ((unsigned*)dbg)[8192 + 2048 + i] = ((const LAS unsigned*)(lds + VT))[i]; } }
#endif
        if (wid >= 4) {
#pragma unroll
            for (int ks = 0; ks < 4; ++ks) { const bf16x8 fa = *(const LAS bf16x8*)(lds + AT + sw128(32 * t_i + r, (16 * ks + 8 * hh) * 2)), fb = *(const LAS bf16x8*)(lds + VT + sw128(32 * v_i + r, (16 * ks + 8 * hh) * 2));
                oacc = __builtin_amdgcn_mfma_f32_32x32x16_bf16(fa, fb, oacc, 0, 0, 0); }
#pragma unroll
            for (int i = 0; i < 16; ++i) { const int t = 32 * t_i + crow(i, hh); Op[(size_t)GLA_TOK(ci, t) * DM + 32 * v_i + r] = (bf16_t)f2bf(oacc[i]); }
        }
        {
            const int kq = wid >> 1, vq = wid & 1;
#pragma unroll
            for (int i = 0; i < 16; ++i) st[i] *= ((const LAS float*)(lds + DD))[32 * kq + crow(i, hh)];
#pragma unroll
            for (int ks = 0; ks < 4; ++ks) { const bf16x8 fa = *(const LAS bf16x8*)(lds + KST + sw128(32 * kq + r, (16 * ks + 8 * hh) * 2)), fb = *(const LAS bf16x8*)(lds + VT + sw128(32 * vq + r, (16 * ks + 8 * hh) * 2));
                st = __builtin_amdgcn_mfma_f32_32x32x16_bf16(fa, fb, st, 0, 0, 0); }
#pragma unroll
            for (int g = 0; g < 4; ++g) *(LAS u32x2*)(lds + ST + sw256(32 * vq + r, (32 * kq + 8 * g + 4 * hh) * 2)) = (u32x2){cvt_pk_bf16(st[4 * g], st[4 * g + 1]), cvt_pk_bf16(st[4 * g + 2], st[4 * g + 3])};
        }
        __syncthreads();
#ifdef DIAG
        if (dbg && ci == 0) { for (int i = tid; i < 4096; i += NTHR) { ((unsigned*)dbg)[12288 + i] = ((const LAS unsigned*)(lds + ST))[i]; ((unsigned*)dbg)[16384 + i] = ((const LAS unsigned*)(lds + KST))[i]; } }
#endif
    }
#undef GLA_TOK
#undef GLA_LOAD
}
}
__device__ __forceinline__ void gla_phase(const Args& A, LAS unsigned char* lds, int bid, int G) {
    unsigned char* ws = A.ws;
    for (int it = bid; it < 256; it += G) {
        const int b = it >> 5, h = (it >> 2) & 7, dir = (it >> 1) & 1, vh = it & 1;
        const size_t base = (size_t)b * SEQ * DM + h * 128;
        gla::gla_item((const bf16_t*)(ws + H_Q) + base, (const unsigned short*)(ws + (dir ? H_LFB : H_LFF)) + base, (const bf16_t*)(ws + H_V) + base + vh * 64,
                      (bf16_t*)(ws + (dir ? H_OB : H_OF)) + base + vh * 64, dir, lds, it == 0 ? (float*)(ws + TB_LSUM) : nullptr);
    }
}
__device__ __forceinline__ void hg_normo_phase(const Args& A, int bid, int G) {
    int tid_ = threadIdx.x; asm volatile("" : "+v"(tid_));
    const int tid = tid_, lane = tid & 63, wave = tid >> 6; unsigned char* ws = A.ws;
    const bf16_t* OF = (const bf16_t*)(ws + H_OF); const bf16_t* OB = (const bf16_t*)(ws + H_OB); const bf16_t* GG = (const bf16_t*)(ws + H_G); bf16_t* HM = (bf16_t*)(ws + WS_HM);
    const int c0 = (lane >> 3) * 128 + (lane & 7) * 16;
    float ng[16];
#pragma unroll
    for (int i = 0; i < 16; ++i) ng[i] = A.in[I_HGNG][(lane & 7) * 16 + i];
    for (int row = (bid * NWAVES + wave); row < MTOK; row += G * NWAVES) {
        const size_t o = (size_t)row * DM + c0;
        const u32x4 a0 = *(const u32x4*)(OF + o), a1 = *(const u32x4*)(OF + o + 8), b0 = *(const u32x4*)(OB + o), b1 = *(const u32x4*)(OB + o + 8), g0 = *(const u32x4*)(GG + o), g1 = *(const u32x4*)(GG + o + 8);
        float v[16], gt[16]; float ss = 0.f;
#pragma unroll
        for (int e = 0; e < 4; ++e) { v[2 * e] = bflo(a0[e]) + bflo(b0[e]); v[2 * e + 1] = bfhi(a0[e]) + bfhi(b0[e]); v[8 + 2 * e] = bflo(a1[e]) + bflo(b1[e]); v[8 + 2 * e + 1] = bfhi(a1[e]) + bfhi(b1[e]);
            gt[2 * e] = bflo(g0[e]); gt[2 * e + 1] = bfhi(g0[e]); gt[8 + 2 * e] = bflo(g1[e]); gt[8 + 2 * e + 1] = bfhi(g1[e]); }
#pragma unroll
        for (int i = 0; i < 16; ++i) ss += v[i] * v[i];
        ss += __shfl_xor(ss, 1); ss += __shfl_xor(ss, 2); ss += __shfl_xor(ss, 4);
        const float rstd = 1.0f / sqrtf(ss * (1.0f / 128.0f) + EPS);
        u32x4 w0, w1;
#pragma unroll
        for (int e = 0; e < 4; ++e) { w0[e] = cvt_pk_bf16(v[2 * e] * rstd * ng[2 * e] * gt[2 * e], v[2 * e + 1] * rstd * ng[2 * e + 1] * gt[2 * e + 1]);
            w1[e] = cvt_pk_bf16(v[8 + 2 * e] * rstd * ng[8 + 2 * e] * gt[8 + 2 * e], v[8 + 2 * e + 1] * rstd * ng[8 + 2 * e + 1] * gt[8 + 2 * e + 1]); }
        *(u32x4*)(HM + o) = w0; *(u32x4*)(HM + o + 8) = w1;
    }
}

#ifdef DIAG
constexpr int DG_BASE = 8192;
__device__ __forceinline__ void dg_put(const Args& A, int k, float e) { if (!(e >= 0.f) || e > 1e9f) e = 1e9f; atomicMax((unsigned*)(A.ws + WS_CTL) + DG_BASE + 64 * k, __float_as_uint(e)); }
__device__ __forceinline__ float dg_rel(float got, float ref) { return fabsf(got - ref) / (fabsf(ref) + 0.1f); }
__device__ __forceinline__ unsigned dg_hash(unsigned a, unsigned b) { unsigned h = a * 2654435761u + b * 40503u + 0x9e3779b9u; h ^= h >> 15; h *= 2246822519u; h ^= h >> 13; h *= 3266489917u; h ^= h >> 16; return h; }
__device__ __forceinline__ float dg_bfr(float x) { return bflo(f2bf(x)); }
__device__ __forceinline__ void dg_mods(const Args& A, int k) {
    const int lane = threadIdx.x & 63, gwv = blockIdx.x * 8 + (threadIdx.x >> 6);
    const unsigned h = dg_hash(gwv, k); const int l = h & 3, b = (h >> 2) & 7, e = (h >> 5) % 6144;
    float a = 0.f; for (int d = lane; d < DM; d += 64) a += fsilu(A.in[I_C][b * DM + d]) * A.in[I_ADAW][((size_t)l * DM + d) * 6144 + e];
    a = wave_sum(a) + A.in[I_ADAB][l * 6144 + e];
    const float got = ((const float*)(A.ws + TB_MODS))[((size_t)l * NBATCH + b) * 6144 + e];
    if (lane == 0) dg_put(A, k, dg_rel(got, a));
}
__device__ __forceinline__ void dg_norm(const Args& A, int k, const float* x, const float* gain, int L, int which) {
    const int lane = threadIdx.x & 63, gwv = blockIdx.x * 8 + (threadIdx.x >> 6);
    const int row = dg_hash(gwv, k) & (MTOK - 1), b = row >> 13;
    const float* modl = (const float*)(A.ws + TB_MODS) + ((size_t)L * NBATCH + b) * 6144;
    float ss = 0.f; for (int c = lane; c < DM; c += 64) { const float v = x[(size_t)row * DM + c]; ss += v * v; }
    ss = wave_sum(ss); const float rstd = 1.0f / sqrtf(ss / DM + EPS); float e = 0.f;
    for (int c = lane; c < DM; c += 64) { const float ref = x[(size_t)row * DM + c] * rstd * gain[c] * (1.0f + modl[(which * 3 + 1) * 1024 + c]) + modl[(which * 3) * 1024 + c];
        e = fmaxf(e, dg_rel(bf2f(((const bf16_t*)(A.ws + WS_HM))[(size_t)row * DM + c]), ref)); }
    dg_put(A, k, e);
}
__device__ __forceinline__ void dg_qkv(const Args& A, int k, int al) {
    const int lane = threadIdx.x & 63, gwv = blockIdx.x * 8 + (threadIdx.x >> 6);
    const unsigned h = dg_hash(gwv, k); const int row = h & (MTOK - 1), t = (h >> 16) % 48, col = t * 64 + lane;
    const bf16_t* hm = (const bf16_t*)(A.ws + WS_HM) + (size_t)row * DM; const float* w = A.in[I_ATWIN] + (size_t)al * 1024 * 3072 + col;
    float a = 0.f; for (int kk = 0; kk < DM; ++kk) a += bf2f(hm[kk]) * dg_bfr(w[(size_t)kk * 3072]);
    float ref, got;
    if (t < 32) {
        const int part = t >> 4, sh = t & 15; const float ss = wave_sum(a * a); const float rstd = 1.0f / sqrtf(ss / 64.0f + EPS);
        const float y = a * rstd * (part ? A.in[I_ATKN] : A.in[I_ATQN])[al * 64 + lane]; const float yp = __shfl_xor(y, 32);
        const int pos = row & (SEQ - 1); const float cs = ((const float*)(A.ws + TB_COS))[pos * 32 + (lane & 31)], sn = ((const float*)(A.ws + TB_SIN))[pos * 32 + (lane & 31)];
        ref = (lane < 32) ? (y * cs - yp * sn) : (y * cs + yp * sn); if (part == 0) ref *= 0.125f * LOG2E;
        got = bf2f(((const bf16_t*)(A.ws + (part ? A_K : A_Q)))[(size_t)row * DM + sh * 64 + lane]);
    } else { ref = a; got = bf2f(((const bf16_t*)(A.ws + A_V))[(size_t)row * DM + (t - 32) * 64 + lane]); }
    dg_put(A, k, dg_rel(got, ref));
}
__device__ __forceinline__ void dg_attn(const Args& A, int k, int al, LAS unsigned char* lds) {
    const int tid = threadIdx.x; const unsigned h = dg_hash(blockIdx.x, k); const int row = h & (MTOK - 1), hd = (h >> 16) & 7, b = row >> 13;
    const bf16_t* Q = (const bf16_t*)(A.ws + A_Q); const bf16_t* K = (const bf16_t*)(A.ws + A_K); const bf16_t* V = (const bf16_t*)(A.ws + A_V);
    const float* scal = (const float*)(A.ws + TB_SCAL); const float lamv = scal[SC_LAM0 + al], omli = scal[SC_OML0 + al], Mc = scal[SC_MC0 + al];
    LAS float* p0 = (LAS float*)lds; LAS float* p1 = p0 + SEQ; LAS float* red = p1 + SEQ;
    float l0 = 0.f, l1 = 0.f;
    for (int key = tid; key < SEQ; key += NTHR) { const bf16_t* kr = K + ((size_t)b * SEQ + key) * DM + hd * 128; const bf16_t* qr = Q + (size_t)row * DM + hd * 128;
        float s0 = 0.f, s1 = 0.f; for (int d = 0; d < 64; ++d) { s0 += bf2f(qr[d]) * bf2f(kr[d]); s1 += bf2f(qr[64 + d]) * bf2f(kr[64 + d]); }
        const float e0 = fexp2(s0 - Mc), e1 = fexp2(s1 - Mc); p0[key] = e0; p1[key] = e1; l0 += e0; l1 += e1; }
    l0 = wave_sum(l0); l1 = wave_sum(l1); if ((tid & 63) == 0) { red[tid >> 6] = l0; red[8 + (tid >> 6)] = l1; }
    __syncthreads();
    l0 = 0.f; l1 = 0.f; for (int w = 0; w < 8; ++w) { l0 += red[w]; l1 += red[8 + w]; }
    __syncthreads();
    const int dv = tid & 127, part = tid >> 7; float o = 0.f;
    for (int key = part * 2048; key < part * 2048 + 2048; ++key) o += (p0[key] / l0 - lamv * p1[key] / l1) * bf2f(V[((size_t)b * SEQ + key) * DM + hd * 128 + dv]);
    red[16 + part * 128 + dv] = o; __syncthreads();
    if (tid < 128) { o = red[16 + tid] + red[16 + 128 + tid] + red[16 + 256 + tid] + red[16 + 384 + tid]; red[600 + tid] = o * o; }
    __syncthreads();
    if (tid < 128) { float ss = 0.f; for (int i = 0; i < 128; ++i) ss += red[600 + i]; const float ref = o / sqrtf(ss / 128.0f + EPS) * A.in[I_ATSUB][al * 128 + tid] * omli;
        dg_put(A, k, dg_rel(bf2f(((const bf16_t*)(A.ws + WS_HM))[(size_t)row * DM + hd * 128 + tid]), ref)); }
    __syncthreads();
}
__device__ __forceinline__ void dg_save(const Args& A, int k, const float* xold) {
    const int lane = threadIdx.x & 63, gwv = blockIdx.x * 8 + (threadIdx.x >> 6);
    const unsigned h = dg_hash(gwv, k); const int row = h & (MTOK - 1), col = (h >> 16) & 1023;
    float* sv = (float*)(A.ws + TB_LSUM) + 7 * 1024 * 1024 / 4;
    if (lane == 0) sv[k * 4096 + gwv] = xold[(size_t)row * DM + col];
}
__device__ __forceinline__ void dg_res(const Args& A, int k, const float* xnew, const float* gate, const bf16_t* Am, int K, const float* W) {
    const int lane = threadIdx.x & 63, gwv = blockIdx.x * 8 + (threadIdx.x >> 6);
    const unsigned h = dg_hash(gwv, k); const int row = h & (MTOK - 1), col = (h >> 16) & 1023, b = row >> 13;
    const float* sv = (const float*)(A.ws + TB_LSUM) + 7 * 1024 * 1024 / 4;
    float a = 0.f; for (int kk = lane; kk < K; kk += 64) a += bf2f(Am[(size_t)row * K + kk]) * dg_bfr(W[(size_t)kk * DM + col]);
    a = wave_sum(a);
    const float ref = sv[k * 4096 + gwv] + gate[(size_t)b * 6144 + col] * a;
    if (lane == 0) dg_put(A, k, dg_rel(xnew[(size_t)row * DM + col], ref));
}
__device__ __forceinline__ void dg_swiglu(const Args& A, int k, const bf16_t* Am, const float* W, int F, const bf16_t* H, int nrows, const int* rowmap) {
    const int lane = threadIdx.x & 63, gwv = blockIdx.x * 8 + (threadIdx.x >> 6);
    const unsigned h = dg_hash(gwv, k); const int row = (h & 0xfffff) % nrows, j = (h >> 20) % F;
    float g = 0.f, u = 0.f; for (int kk = lane; kk < DM; kk += 64) { const float x = bf2f(Am[(size_t)row * DM + kk]); g += x * dg_bfr(W[(size_t)kk * 2 * F + j]); u += x * dg_bfr(W[(size_t)kk * 2 * F + F + j]); }
    g = wave_sum(g); u = wave_sum(u);
    const float ref = g / (1.0f + expf(-g)) * u;
    if (lane == 0) dg_put(A, k, dg_rel(bf2f(H[(size_t)row * F + j]), ref));
}
__device__ __forceinline__ void dg_hgin(const Args& A, int k) {
    const int lane = threadIdx.x & 63, gwv = blockIdx.x * 8 + (threadIdx.x >> 6);
    const unsigned h = dg_hash(gwv, k); const int row = h & (MTOK - 1), col = (h >> 16) % 5120, grp = col >> 10, cc = col & 1023;
    float a = 0.f; for (int kk = lane; kk < DM; kk += 64) a += bf2f(((const bf16_t*)(A.ws + WS_HM))[(size_t)row * DM + kk]) * dg_bfr(A.in[I_HGWIN][(size_t)kk * 5120 + col]);
    a = wave_sum(a);
    float ref, got;
    if (grp == 0 || grp == 4) { ref = a / (1.0f + expf(-a)); got = bf2f(((const bf16_t*)(A.ws + (grp == 0 ? H_Q : H_G)))[(size_t)row * DM + cc]); }
    else if (grp == 3) { ref = a; got = bf2f(((const bf16_t*)(A.ws + H_V))[(size_t)row * DM + cc]); }
    else { const int d = grp - 1; const float* p = A.in[I_HGLB] + (size_t)d * DEPTH * 1024 + cc; float mx = p[0]; for (int l = 1; l < DEPTH; ++l) mx = fmaxf(mx, p[l * 1024]);
        float den = 0.f; for (int l = 0; l < DEPTH; ++l) den += expf(p[l * 1024] - mx); const float lbv = expf(p[1024] - mx) / den;
        ref = logf(lbv + (1.0f - lbv) / (1.0f + expf(-a))); got = gla::h2f(((const unsigned short*)(A.ws + (d ? H_LFB : H_LFF)))[(size_t)row * DM + cc]); }
    if (lane == 0) dg_put(A, k, dg_rel(got, ref));
}
__device__ __forceinline__ void dg_gla(const Args& A, int k) {
    const int lane = threadIdx.x & 63, gwv = blockIdx.x * 8 + (threadIdx.x >> 6);
    const unsigned h = dg_hash(gwv, k); const int sel0 = (gwv & 3) == 0; const int b = sel0 ? 0 : (h & 7), hd = sel0 ? 0 : ((h >> 3) & 7), dir = sel0 ? 0 : ((h >> 6) & 1), vc = sel0 ? ((h >> 7) & 63) : ((h >> 7) & 127);
    const bf16_t* Q = (const bf16_t*)(A.ws + H_Q); const unsigned short* LF = (const unsigned short*)(A.ws + (dir ? H_LFB : H_LFF)); const bf16_t* V = (const bf16_t*)(A.ws + H_V);
    const bf16_t* O = (const bf16_t*)(A.ws + (dir ? H_OB : H_OF));
    float s0 = 0.f, s1 = 0.f, e0 = 0.f, e1 = 0.f, e2 = 0.f, e3 = 0.f;
    for (int i = 0; i < SEQ; ++i) { const int tok = dir ? (SEQ - 1 - i) : i; const size_t o = ((size_t)b * SEQ + tok) * DM + hd * 128;
        const float f0 = expf(gla::h2f(LF[o + lane])), f1 = expf(gla::h2f(LF[o + 64 + lane])), v = bf2f(V[o + vc]);
        s0 = f0 * s0 + (1.0f - f0) * v; s1 = f1 * s1 + (1.0f - f1) * v;
        if (i < 128 || i % 61 == 0) { const float ov = wave_sum(bf2f(Q[o + lane]) * s0 + bf2f(Q[o + 64 + lane]) * s1); const float er = 0.25f * fabsf(bf2f(O[o + vc]) - ov) / (fabsf(ov) + 1.0f);
            if (i == 0) e0 = er; else if (i < 64) e1 = fmaxf(e1, er); else if (i < 128) e2 = fmaxf(e2, er); else e3 = fmaxf(e3, er); } }
    if (lane == 0) { dg_put(A, k, e0); dg_put(A, k + 4, e1); dg_put(A, k + 5, e2); dg_put(A, k + 6, e3); }
    const float* dbg = (const float*)(A.ws + TB_LSUM); const unsigned short* LF0 = (const unsigned short*)(A.ws + H_LFF); const bf16_t* Q0 = (const bf16_t*)(A.ws + H_Q);
    { const unsigned h2 = dg_hash(gwv, k + 100); const int t = h2 & 63, kk = (h2 >> 6) & 127; float c = 0.f; for (int tt = 0; tt <= t; ++tt) c += gla::h2f(LF0[(size_t)tt * DM + kk]);
      if (lane == 0) dg_put(A, k + 1, dg_rel(dbg[t * 128 + kk], c)); }
    { const unsigned h2 = dg_hash(gwv, k + 200); const int t = h2 & 63, sidx = (h2 >> 6) & 63; float a = 0.f;
      if (sidx <= t) { for (int kk = lane; kk < 128; kk += 64) { float c = 0.f; for (int tt = sidx + 1; tt <= t; ++tt) c += gla::h2f(LF0[(size_t)tt * DM + kk]);
              a += bf2f(Q0[(size_t)t * DM + kk]) * (1.0f - expf(gla::h2f(LF0[(size_t)sidx * DM + kk]))) * expf(c); } a = wave_sum(a); }
      const unsigned short got = ((const unsigned short*)(dbg + 8192))[gla::sw128(t, sidx * 2) / 2];
      if (lane == 0) dg_put(A, k + 2, 5.0f * fabsf(bf2f(got) - a) / (fabsf(a) + 0.01f)); }
    { const unsigned h2 = dg_hash(gwv, k + 300); const int sidx = h2 & 63, v = (h2 >> 6) & 63;
      const unsigned short got = ((const unsigned short*)(dbg + 8192 + 2048))[gla::sw128(v, sidx * 2) / 2];
      if (lane == 0) dg_put(A, k + 2, dg_rel(bf2f(got), bf2f(((const bf16_t*)(A.ws + H_V))[(size_t)sidx * DM + v]))); }
    { const unsigned h2 = dg_hash(gwv, k + 500); const int kk = h2 & 127, v = (h2 >> 7) & 63;
      float a = 0.f; { const int sidx = lane; float c = 0.f; for (int tt = sidx + 1; tt < 64; ++tt) c += gla::h2f(LF0[(size_t)tt * DM + kk]);
          const float ksn = (1.0f - expf(gla::h2f(LF0[(size_t)sidx * DM + kk]))) * expf(c);
          const unsigned short gk = ((const unsigned short*)(dbg + 16384))[gla::sw128(kk, sidx * 2) / 2];
          dg_put(A, k + 2, 0.5f * fabsf(bf2f(gk) - ksn) / (fabsf(ksn) + 0.01f));
          a = ksn * bf2f(((const bf16_t*)(A.ws + H_V))[(size_t)sidx * DM + v]); }
      a = wave_sum(a);
      const unsigned short gs = ((const unsigned short*)(dbg + 12288))[gla::sw256(v, kk * 2) / 2];
      if (lane == 0) dg_put(A, k + 3, 0.5f * fabsf(bf2f(gs) - a) / (fabsf(a) + 0.05f)); }
    { const unsigned h2 = dg_hash(gwv, k + 400); const int t = h2 & 63, v = (h2 >> 6) & 63;
      const unsigned short* at = (const unsigned short*)(dbg + 8192); const unsigned short* vt = (const unsigned short*)(dbg + 8192 + 2048);
      float a = bf2f(at[gla::sw128(t, lane * 2) / 2]) * bf2f(vt[gla::sw128(v, lane * 2) / 2]); a = wave_sum(a);
      if (lane == 0) dg_put(A, k + 1, 5.0f * dg_rel(bf2f(((const bf16_t*)(A.ws + H_OF))[(size_t)t * DM + v]), a)); }
}
__device__ __forceinline__ void dg_normo(const Args& A, int k) {
    const int lane = threadIdx.x & 63, gwv = blockIdx.x * 8 + (threadIdx.x >> 6);
    const unsigned h = dg_hash(gwv, k); const int row = h & (MTOK - 1), hd = (h >> 16) & 7; const size_t o = (size_t)row * DM + hd * 128;
    const float v0 = bf2f(((const bf16_t*)(A.ws + H_OF))[o + lane]) + bf2f(((const bf16_t*)(A.ws + H_OB))[o + lane]), v1 = bf2f(((const bf16_t*)(A.ws + H_OF))[o + 64 + lane]) + bf2f(((const bf16_t*)(A.ws + H_OB))[o + 64 + lane]);
    const float ss = wave_sum(v0 * v0 + v1 * v1), rstd = 1.0f / sqrtf(ss / 128.0f + EPS);
    const float r0 = v0 * rstd * A.in[I_HGNG][lane] * bf2f(((const bf16_t*)(A.ws + H_G))[o + lane]), r1 = v1 * rstd * A.in[I_HGNG][64 + lane] * bf2f(((const bf16_t*)(A.ws + H_G))[o + 64 + lane]);
    dg_put(A, k, fmaxf(dg_rel(bf2f(((const bf16_t*)(A.ws + WS_HM))[o + lane]), r0), dg_rel(bf2f(((const bf16_t*)(A.ws + WS_HM))[o + 64 + lane]), r1)));
}
__device__ __forceinline__ void dg_router(const Args& A, int k, int L) {
    const int lane = threadIdx.x & 63, gwv = blockIdx.x * 8 + (threadIdx.x >> 6);
    const int row = dg_hash(gwv, k) & (MTOK - 1), b = row >> 13; const float* x = A.out + (size_t)row * DM;
    const float* modl = (const float*)(A.ws + TB_MODS) + ((size_t)L * NBATCH + b) * 6144; const float* gain = A.in[I_N2G] + L * DM; const float* R = A.in[I_MOER] + (size_t)(L >> 1) * DM * 8;
    float ss = 0.f; for (int c = lane; c < DM; c += 64) ss += x[c] * x[c];
    ss = wave_sum(ss); const float rstd = 1.0f / sqrtf(ss / DM + EPS);
    float lg[8]; for (int e = 0; e < 8; ++e) lg[e] = 0.f;
    for (int c = lane; c < DM; c += 64) { const float hv = x[c] * rstd * gain[c] * (1.0f + modl[4 * 1024 + c]) + modl[3 * 1024 + c]; for (int e = 0; e < 8; ++e) lg[e] += hv * R[c * 8 + e]; }
    for (int e = 0; e < 8; ++e) lg[e] = wave_sum(lg[e]);
    int e0 = 0; for (int e = 1; e < 8; ++e) if (lg[e] > lg[e0]) e0 = e;
    int e1 = (e0 == 0) ? 1 : 0; for (int e = 0; e < 8; ++e) if (e != e0 && lg[e] > lg[e1]) e1 = e;
    float gap = 1e9f; for (int e = 0; e < 8; ++e) if (e != e0 && e != e1) gap = fminf(gap, lg[e1] - lg[e]); gap = fminf(gap, lg[e0] - lg[e1]);
    const int g0 = ((const int*)(A.ws + TB_EID))[row * 2], g1 = ((const int*)(A.ws + TB_EID))[row * 2 + 1]; const float w0 = ((const float*)(A.ws + TB_GATE))[row * 2], w1 = ((const float*)(A.ws + TB_GATE))[row * 2 + 1];
    const float p0 = 1.0f / (1.0f + expf(lg[e1] - lg[e0]));
    float er = (g0 != e0 || g1 != e1) ? (gap > 2e-3f ? 9.f : 0.f) : fmaxf(fabsf(w0 - p0), fabsf(w1 - (1.0f - p0)));
    if (lane == 0) dg_put(A, k, er);
}
__device__ __forceinline__ void dg_place(const Args& A, int k) {
    const int lane = threadIdx.x & 63, gwv = blockIdx.x * 8 + (threadIdx.x >> 6);
    const unsigned h = dg_hash(gwv, k); const int row = h & (MTOK - 1), kk = (h >> 16) & 1;
    const int sl = ((const int*)(A.ws + TB_SLOT))[row * 2 + kk], e = ((const int*)(A.ws + TB_EID))[row * 2 + kk]; const int* ts = (const int*)(A.ws + TB_TILES);
    float er = (sl >= ts[e] * 256 && sl < ts[e + 1] * 256 && sl < MOE_ROWS) ? 0.f : 7.f;
    if (er == 0.f) for (int c = lane; c < DM; c += 64) if (((const bf16_t*)(A.ws + E_XS))[(size_t)sl * DM + c] != ((const bf16_t*)(A.ws + WS_HM))[(size_t)row * DM + c]) er = 5.f;
    dg_put(A, k, er);
}
__device__ __forceinline__ void dg_moe_hid(const Args& A, int k, int m) {
    const int lane = threadIdx.x & 63, gwv = blockIdx.x * 8 + (threadIdx.x >> 6);
    const unsigned h = dg_hash(gwv, k); const int row = h & (MTOK - 1), kk = (h >> 16) & 1, j = (h >> 17) % DFFE;
    const int sl = ((const int*)(A.ws + TB_SLOT))[row * 2 + kk], e = ((const int*)(A.ws + TB_EID))[row * 2 + kk];
    const float* W = A.in[I_MOEGU] + ((size_t)m * 8 + e) * DM * 2 * DFFE; const bf16_t* Am = (const bf16_t*)(A.ws + E_XS) + (size_t)sl * DM;
    float g = 0.f, u = 0.f; for (int c = lane; c < DM; c += 64) { const float x = bf2f(Am[c]); g += x * dg_bfr(W[(size_t)c * 2 * DFFE + j]); u += x * dg_bfr(W[(size_t)c * 2 * DFFE + DFFE + j]); }
    g = wave_sum(g); u = wave_sum(u);
    if (lane == 0) dg_put(A, k, dg_rel(bf2f(((const bf16_t*)(A.ws + E_HID))[(size_t)sl * DFFE + j]), g / (1.0f + expf(-g)) * u));
}
__device__ __forceinline__ void dg_moe_y(const Args& A, int k, int m) {
    const int lane = threadIdx.x & 63, gwv = blockIdx.x * 8 + (threadIdx.x >> 6);
    const unsigned h = dg_hash(gwv, k); const int row = h & (MTOK - 1), kk = (h >> 16) & 1, col = (h >> 17) & 1023;
    const int sl = ((const int*)(A.ws + TB_SLOT))[row * 2 + kk], e = ((const int*)(A.ws + TB_EID))[row * 2 + kk];
    const float* W = A.in[I_MOEDN] + ((size_t)m * 8 + e) * DFFE * DM; const bf16_t* Hh = (const bf16_t*)(A.ws + E_HID) + (size_t)sl * DFFE;
    float a = 0.f; for (int j = lane; j < DFFE; j += 64) a += bf2f(Hh[j]) * dg_bfr(W[(size_t)j * DM + col]);
    a = wave_sum(a);
    if (lane == 0) dg_put(A, k, fabsf(bf2f(((const bf16_t*)(A.ws + E_XS))[(size_t)sl * DM + col]) - a) / (fabsf(a) + 0.3f));
}
__device__ __forceinline__ void dg_combine(const Args& A, int k, const float* modprev) {
    const int lane = threadIdx.x & 63, gwv = blockIdx.x * 8 + (threadIdx.x >> 6);
    const unsigned h = dg_hash(gwv, k); const int row = h & (MTOK - 1), col = (h >> 16) & 1023, b = row >> 13;
    const float* sv = (const float*)(A.ws + TB_LSUM) + 7 * 1024 * 1024 / 4; const bf16_t* Y = (const bf16_t*)(A.ws + E_XS);
    const int s0 = ((const int*)(A.ws + TB_SLOT))[row * 2], s1 = ((const int*)(A.ws + TB_SLOT))[row * 2 + 1]; const float w0 = ((const float*)(A.ws + TB_GATE))[row * 2], w1 = ((const float*)(A.ws + TB_GATE))[row * 2 + 1];
    const float ref = sv[k * 4096 + gwv] + modprev[(size_t)b * 6144 + 5 * 1024 + col] * (w0 * bf2f(Y[(size_t)s0 * DM + col]) + w1 * bf2f(Y[(size_t)s1 * DM + col]));
    if (lane == 0) dg_put(A, k, dg_rel(A.out[(size_t)row * DM + col], ref));
}
__device__ __forceinline__ void dg_lruin(const Args& A, int k) {
    const int lane = threadIdx.x & 63, gwv = blockIdx.x * 8 + (threadIdx.x >> 6);
    const unsigned h = dg_hash(gwv, k); const int row = h & (MTOK - 1), col = (h >> 16) % 2560;
    float a = 0.f; for (int kk = lane; kk < DM; kk += 64) a += bf2f(((const bf16_t*)(A.ws + WS_HM))[(size_t)row * DM + kk]) * dg_bfr(A.in[I_LRWIN][(size_t)kk * 2560 + col]);
    a = wave_sum(a);
    float ref, got;
    if (col < LRUW) { ref = 0.5f * a * (1.0f + tanhf(0.7978845608028654f * (a + 0.044715f * a * a * a))); got = bf2f(((const bf16_t*)(A.ws + L_YB))[(size_t)row * LRUW + col]); }
    else { ref = a; got = bf2f(((const bf16_t*)(A.ws + L_XB))[(size_t)row * LRUW + col - LRUW]); }
    if (lane == 0) dg_put(A, k, dg_rel(got, ref));
}
__device__ __forceinline__ void dg_lru(const Args& A, int k) {
    const int lane = threadIdx.x & 63, gwv = blockIdx.x * 8 + (threadIdx.x >> 6);
    const unsigned h = dg_hash(gwv, k); const int b = h & 7, ch = (h >> 3) % LRUW, tc = (h >> 16) & (SEQ - 1), n = ch / 128, j = ch % 128;
    const bf16_t* XB = (const bf16_t*)(A.ws + L_XB) + (size_t)b * SEQ * LRUW;
    float hres[2];
    for (int d = 0; d < 2; ++d) {
        const float* wa = A.in[I_LRWA] + (size_t)(d * 10 + n) * 16384; const float* wx = A.in[I_LRWX] + (size_t)(d * 10 + n) * 16384;
        const float wa0 = dg_bfr(wa[lane * 128 + j]), wa1 = dg_bfr(wa[(lane + 64) * 128 + j]), wx0 = dg_bfr(wx[lane * 128 + j]), wx1 = dg_bfr(wx[(lane + 64) * 128 + j]);
        const float ba = A.in[I_LRBA][d * LRUW + ch], bx = A.in[I_LRBX][d * LRUW + ch]; const float lam = A.in[I_LRLAM][d * LRUW + ch]; const float sp = log1pf(expf(-lam));
        float hs = 0.f;
        for (int i = 0; ; ++i) { const int t = d ? (SEQ - 1 - i) : i;
            float x0 = A.in[I_LRCB][n * 128 + lane], x1 = A.in[I_LRCB][n * 128 + 64 + lane], xj = A.in[I_LRCB][ch];
            for (int w = 0; w < 4; ++w) { const int tt = t - 1 + w; if (tt >= 0 && tt < SEQ) {
                x0 += A.in[I_LRCW][w * LRUW + n * 128 + lane] * bf2f(XB[(size_t)tt * LRUW + n * 128 + lane]); x1 += A.in[I_LRCW][w * LRUW + n * 128 + 64 + lane] * bf2f(XB[(size_t)tt * LRUW + n * 128 + 64 + lane]);
                xj += A.in[I_LRCW][w * LRUW + ch] * bf2f(XB[(size_t)tt * LRUW + ch]); } }
            const float rp = wave_sum(dg_bfr(x0) * wa0 + dg_bfr(x1) * wa1), ip = wave_sum(dg_bfr(x0) * wx0 + dg_bfr(x1) * wx1);
            const float rg = 1.0f / (1.0f + expf(-(rp + ba))), ig = 1.0f / (1.0f + expf(-(ip + bx))); const float la = -8.0f * rg * sp;
            hs = expf(la) * hs + sqrtf(fmaxf(-expm1f(2.0f * la), 0.f)) * ig * xj;
            if (t == tc) break; }
        hres[d] = hs;
    }
    const size_t go = ((size_t)b * SEQ + tc) * LRUW + ch;
    const float e1 = fabsf(bf2f(((const bf16_t*)(A.ws + L_HF))[go]) - hres[0]) / (fabsf(hres[0]) + 0.3f);
    const float ref = (hres[0] + hres[1]) * bf2f(((const bf16_t*)(A.ws + L_YB))[go]);
    const float e2 = fabsf(bf2f(((const bf16_t*)(A.ws + L_HY))[go]) - ref) / (fabsf(ref) + 0.3f);
    if (lane == 0) { dg_put(A, k, e1); dg_put(A, k + 5, e2); }
}
__device__ __forceinline__ void dg_final(const Args& A, int nchk) {
    const unsigned* sl = (const unsigned*)(A.ws + WS_CTL) + DG_BASE; int code = 0; float ev = 0.f;
    for (int k = 1; k <= nchk; ++k) { const float e = __uint_as_float(sl[64 * k]); if (e > 0.05f) { code = k; ev = e; break; } }
    if (code == 0) return;
    const int c1 = code % 10, c10 = code / 10;
    const float s = -(float)c1;
    for (size_t i = (size_t)blockIdx.x * NTHR + threadIdx.x; i < (size_t)MTOK * DM; i += (size_t)gridDim.x * NTHR) A.out[i] = A.in[I_X][i] * s;
    __syncthreads();
    if (blockIdx.x == 0 && threadIdx.x == 0) { const int qq = ev < 0.1f ? 1 : ev < 0.2f ? 2 : ev < 0.5f ? 3 : ev < 1.f ? 4 : ev < 2.f ? 5 : ev < 5.f ? 6 : ev < 20.f ? 7 : ev < 1e3f ? 8 : 9;
        A.out[12345] = 100.f * (float)(10 * c10 + qq); }
}
#define DG(x) x
#define DGL(x) if constexpr (L >= DIAG_FROM) { x }
#else
#define DG(x)
#define DGL(x)
#endif

#define GRID_BAR() xcd_barrier(bar)
template <int L>
__device__ __forceinline__ void run_mixer(const Args& args, LAS unsigned char* lds, int bid, int G, const XcdBarrier& bar) {
    unsigned char* ws = args.ws; float* xo = args.out;
    const float* modl = (const float*)(ws + TB_MODS) + (size_t)L * NBATCH * 6144;
    const float* xs = (L == 0) ? args.in[I_X] : xo;
    constexpr int kind = L % 3;
    DGL(if (L > 0 && ((L - 1) & 1)) { dg_save(args, 10 * (L - 1) + 9, xo); GRID_BAR(); })
    norm_phase<false>(args, lds, bid, G, xs, xo, args.in[I_N1G] + L * DM, modl, 0, (L > 0) && ((L - 1) & 1), modl - NBATCH * 6144, false, nullptr);
    GRID_BAR();
    DGL(if (L > 0 && ((L - 1) & 1)) { dg_combine(args, 10 * (L - 1) + 9, modl - NBATCH * 6144); GRID_BAR(); })
    DGL(dg_norm(args, 10 * L + 1, (L > 0 && ((L - 1) & 1)) ? xo : xs, args.in[I_N1G] + L * DM, L, 0); GRID_BAR();)
    if constexpr (kind == 0) {
        constexpr int al = L / 3;
        {
            pg8::Gemm g{(const bf16_t*)(ws + WS_HM), (const bf16_t*)(ws + W_QKV) + (size_t)al * 3072 * 1024, 1024};
            pg8::TileOrder S; S.init(256, 12, G, bid);
            pg8::EpiQKV E{(bf16_t*)(ws + A_Q), (bf16_t*)(ws + A_K), (bf16_t*)(ws + A_V), args.in[I_ATQN] + al * 64, args.in[I_ATKN] + al * 64,
                          (const float*)(ws + TB_COS), (const float*)(ws + TB_SIN), 0.125f * LOG2E};
            pg8::gemm_phase<pg8::EpiQKV>(lds, g, S, E);
        }
        GRID_BAR();
        DGL(dg_qkv(args, 10 * L + 2, al); GRID_BAR();)
        attn_phase(args, lds, bid, G, al);
        GRID_BAR();
        DGL(dg_attn(args, 10 * L + 3, al, lds); GRID_BAR();)
        DGL(dg_save(args, 10 * L + 4, xs); GRID_BAR();)
        {
            pg8::Gemm g{(const bf16_t*)(ws + WS_HM), (const bf16_t*)(ws + W_AO) + (size_t)al * 1024 * 1024, 1024};
            pg8::TileOrder S; S.init(256, 4, G, bid);
            pg8::EpiRes E{xs, xo, modl + 2 * 1024};
            pg8::gemm_phase<pg8::EpiRes>(lds, g, S, E);
        }
        GRID_BAR();
        DGL(dg_res(args, 10 * L + 4, xo, modl + 2 * 1024, (const bf16_t*)(ws + WS_HM), 1024, args.in[I_ATWOUT] + (size_t)al * 1024 * 1024); GRID_BAR();)
    }
    if constexpr (kind == 1) {
        {
            pg8::Gemm g{(const bf16_t*)(ws + WS_HM), (const bf16_t*)(ws + W_HGI), 1024};
            pg8::TileOrder S; S.init(256, 20, G, bid);
            pg8::EpiAct E{0, ws, (const float*)(ws + TB_LB)};
            pg8::gemm_phase<pg8::EpiAct>(lds, g, S, E);
        }
        GRID_BAR();
        DGL(dg_hgin(args, 10 * L + 2); GRID_BAR();)
        gla_phase(args, lds, bid, G);
        GRID_BAR();
        DGL(dg_gla(args, 10 * L + 3); GRID_BAR();)
        hg_normo_phase(args, bid, G);
        GRID_BAR();
        DGL(dg_normo(args, 10 * L + 0); GRID_BAR();)
        DGL(dg_save(args, 10 * L + 4, xs); GRID_BAR();)
        {
            pg8::Gemm g{(const bf16_t*)(ws + WS_HM), (const bf16_t*)(ws + W_HGO), 1024};
            pg8::TileOrder S; S.init(256, 4, G, bid);
            pg8::EpiRes E{xs, xo, modl + 2 * 1024};
            pg8::gemm_phase<pg8::EpiRes>(lds, g, S, E);
        }
        GRID_BAR();
        DGL(dg_res(args, 10 * L + 4, xo, modl + 2 * 1024, (const bf16_t*)(ws + WS_HM), 1024, args.in[I_HGWOUT]); GRID_BAR();)
    }
    if constexpr (kind == 2) {
        {
            pg8::Gemm g{(const bf16_t*)(ws + WS_HM), (const bf16_t*)(ws + W_LRI), 1024};
            pg8::TileOrder S; S.init(256, 10, G, bid);
            pg8::EpiAct E{1, ws, nullptr};
            pg8::gemm_phase<pg8::EpiAct>(lds, g, S, E);
        }
        GRID_BAR();
        DGL(dg_lruin(args, 10 * L + 2); GRID_BAR();)
        lru_phase<0>(args, lds, bid, G);
        GRID_BAR();
        lru_carry_phase(args, bid, G);
        GRID_BAR();
        lru_phase<1>(args, lds, bid, G);
        GRID_BAR();
        lru_phase<2>(args, lds, bid, G);
        GRID_BAR();
        DGL(dg_lru(args, 10 * L + 3); GRID_BAR();)
        DGL(dg_save(args, 10 * L + 4, xs); GRID_BAR();)
        {
            pg8::Gemm g{(const bf16_t*)(ws + L_HY), (const bf16_t*)(ws + W_LRO), LRUW};
            pg8::TileOrder S; S.init(256, 4, G, bid);
            pg8::EpiRes E{xs, xo, modl + 2 * 1024};
            pg8::gemm_phase<pg8::EpiRes>(lds, g, S, E);
        }
        GRID_BAR();
        DGL(dg_res(args, 10 * L + 4, xo, modl + 2 * 1024, (const bf16_t*)(ws + L_HY), LRUW, args.in[I_LRWOUT]); GRID_BAR();)
    }
}
template <int L>
__device__ __forceinline__ void run_ffn(const Args& args, LAS unsigned char* lds, int bid, int G, const XcdBarrier& bar) {
    unsigned char* ws = args.ws; float* xo = args.out;
    const float* modl = (const float*)(ws + TB_MODS) + (size_t)L * NBATCH * 6144;
    if constexpr ((L & 1) == 0) {
        constexpr int m = L >> 1;
        norm_phase<false>(args, lds, bid, G, xo, xo, args.in[I_N2G] + L * DM, modl, 1, false, modl, false, nullptr);
        GRID_BAR();
        DGL(dg_norm(args, 10 * L + 5, xo, args.in[I_N2G] + L * DM, L, 1); GRID_BAR();)
        {
            pg8::Gemm g{(const bf16_t*)(ws + WS_HM), (const bf16_t*)(ws + W_FGU) + (size_t)m * 5632 * 1024, 1024};
            pg8::TileOrder S; S.init(256, 22, G, bid);
            pg8::EpiSwiGLU E{(bf16_t*)(ws + F_HID), DFF};
            pg8::gemm_phase<pg8::EpiSwiGLU>(lds, g, S, E);
        }
        GRID_BAR();
        DGL(dg_swiglu(args, 10 * L + 6, (const bf16_t*)(ws + WS_HM), args.in[I_FFGU] + (size_t)m * 1024 * 5632, DFF, (const bf16_t*)(ws + F_HID), MTOK, nullptr); GRID_BAR();)
        DGL(dg_save(args, 10 * L + 7, xo); GRID_BAR();)
        {
            pg8::Gemm g{(const bf16_t*)(ws + F_HID), (const bf16_t*)(ws + W_FDN) + (size_t)m * 1024 * 2816, DFF};
            pg8::TileOrder S; S.init(256, 4, G, bid);
            pg8::EpiRes E{xo, xo, modl + 5 * 1024};
            pg8::gemm_phase<pg8::EpiRes>(lds, g, S, E);
        }
        GRID_BAR();
        DGL(dg_res(args, 10 * L + 7, xo, modl + 5 * 1024, (const bf16_t*)(ws + F_HID), DFF, args.in[I_FFDN] + (size_t)m * 2816 * 1024); GRID_BAR();)
    } else {
        constexpr int m = L >> 1;
        norm_phase<true>(args, lds, bid, G, xo, xo, args.in[I_N2G] + L * DM, modl, 1, false, modl, false, args.in[I_MOER] + (size_t)m * DM * 8);
        GRID_BAR();
        DGL(dg_norm(args, 10 * L + 5, xo, args.in[I_N2G] + L * DM, L, 1); dg_router(args, 10 * L + 5, L); GRID_BAR();)
        place_phase(args, lds, bid, G);
        GRID_BAR();
        DGL(dg_place(args, 10 * L + 6); GRID_BAR();)
        const int* tiles = (const int*)(ws + TB_TILES);
        {
            pg8::Gemm g{(const bf16_t*)(ws + E_XS), (const bf16_t*)(ws + W_MGU) + (size_t)m * 8 * 7168 * 1024, 1024};
            pg8::TileOrder S; S.init(tiles[8], 28, G, bid);
#pragma unroll
            for (int e = 1; e < NEXP; ++e) S.ts[e] = tiles[e];
            pg8::EpiSwiGLU E{(bf16_t*)(ws + E_HID), DFFE};
            pg8::gemm_phase<pg8::EpiSwiGLU>(lds, g, S, E);
        }
        GRID_BAR();
        DGL(dg_moe_hid(args, 10 * L + 7, m); GRID_BAR();)
        {
            pg8::Gemm g{(const bf16_t*)(ws + E_HID), (const bf16_t*)(ws + W_MDN) + (size_t)m * 8 * 1024 * 3584, DFFE};
            pg8::TileOrder S; S.init(tiles[8], 4, G, bid);
#pragma unroll
            for (int e = 1; e < NEXP; ++e) S.ts[e] = tiles[e];
            pg8::EpiPlain E{(bf16_t*)(ws + E_XS), DM};
            pg8::gemm_phase<pg8::EpiPlain>(lds, g, S, E);
        }
        GRID_BAR();
        DGL(dg_moe_y(args, 10 * L + 8, m); GRID_BAR();)
    }
}
__device__ __forceinline__ void final_combine(const Args& args, LAS unsigned char* lds, int bid, int G, const XcdBarrier& bar) {
    const float* modl = (const float*)(args.ws + TB_MODS) + (size_t)3 * NBATCH * 6144;
    DG(dg_save(args, 39, args.out); GRID_BAR();)
    norm_phase<false>(args, lds, bid, G, args.out, args.out, args.in[I_N1G], modl, 0, true, modl, true, nullptr);
    DG(GRID_BAR(); dg_combine(args, 39, modl);)
}

__global__ void __launch_bounds__(NTHR, 2) mega_fwd(Args args) {
    extern __shared__ __attribute__((aligned(16))) unsigned char lds_raw[];
    LAS unsigned char* lds = (LAS unsigned char*)lds_raw;
    const int tid = threadIdx.x, bid = blockIdx.x, G = gridDim.x;
    unsigned char* ws = args.ws;
    volatile LAS unsigned* MISC = (volatile LAS unsigned*)(lds + MISC_OFF);
    if (tid < 64) MISC[tid] = 0u;
    __syncthreads();
    XcdBarrier bar = xcd_barrier_post((unsigned*)(ws + WS_CTL) + CW_BAR, MISC + 8);

    prologue_phase(args, lds, bid, G);
    GRID_BAR();

    run_mixer<0>(args, lds, bid, G, bar);
    run_ffn<0>(args, lds, bid, G, bar);
    run_mixer<1>(args, lds, bid, G, bar);
    run_ffn<1>(args, lds, bid, G, bar);
    run_mixer<2>(args, lds, bid, G, bar);
    run_ffn<2>(args, lds, bid, G, bar);
    run_mixer<3>(args, lds, bid, G, bar);
    run_ffn<3>(args, lds, bid, G, bar);
    final_combine(args, lds, bid, G, bar);
    DG(GRID_BAR(); dg_final(args, 49);)
}

extern "C" void kernel_launch(void* const* d_in, const int* in_sizes, int n_in, void* d_out, int out_size, void* d_ws, size_t ws_size, hipStream_t stream) {
    static int grid = 0;
    if (grid == 0) {
        if (n_in != 30 || out_size != MTOK * DM || ws_size < WS_NEED) { fprintf(stderr, "kernel_launch: unexpected shapes (n_in %d out %d ws %zu need %zu)\n", n_in, out_size, ws_size, (size_t)WS_NEED); grid = -1; return; }
        int dev = 0, cus = 0;
        if (hipGetDevice(&dev) != hipSuccess || hipDeviceGetAttribute(&cus, hipDeviceAttributeMultiprocessorCount, dev) != hipSuccess) { grid = -1; return; }
        if (hipFuncSetAttribute((const void*)mega_fwd, hipFuncAttributeMaxDynamicSharedMemorySize, LDS_BYTES) != hipSuccess) { fprintf(stderr, "kernel_launch: hipFuncSetAttribute failed\n"); grid = -1; return; }
        int per_cu = 0;
        if (hipOccupancyMaxActiveBlocksPerMultiprocessor(&per_cu, (const void*)mega_fwd, NTHR, LDS_BYTES) != hipSuccess || per_cu < 1) { fprintf(stderr, "kernel_launch: occupancy query says %d\n", per_cu); }
        (void)hipGetLastError();
        grid = (cus >= 256) ? 256 : -1;
        if (grid < 0) { fprintf(stderr, "kernel_launch: needs 256 CUs, device has %d\n", cus); return; }
    }
    if (grid < 0) return;
    if (hipMemsetAsync((char*)d_ws + WS_CTL, 0, CTL_ZERO_BYTES, stream) != hipSuccess) return;
    Args a{};
    for (int i = 0; i < 30; ++i) a.in[i] = (const float*)d_in[i];
    a.out = (float*)d_out; a.ws = (unsigned char*)d_ws;
    hipLaunchKernelGGL(mega_fwd, dim3(grid), dim3(NTHR), LDS_BYTES, stream, a);
}
```

```cpp
#define DIAG_FROM 2
#include <hip/hip_runtime.h>
#include <cstdio>
#include <cstdint>

#define LAS __attribute__((address_space(3)))
#define GAS __attribute__((address_space(1)))
typedef unsigned short bf16_t;
typedef short bf16x8 __attribute__((ext_vector_type(8)));
typedef short s16x4 __attribute__((ext_vector_type(4)));
typedef float f32x2 __attribute__((ext_vector_type(2)));
typedef float f32x4 __attribute__((ext_vector_type(4)));
typedef float f32x16 __attribute__((ext_vector_type(16)));
typedef unsigned u32x2 __attribute__((ext_vector_type(2)));
typedef unsigned u32x4 __attribute__((ext_vector_type(4)));

constexpr int MTOK = 65536, DM = 1024, SEQ = 8192, NBATCH = 8, DEPTH = 4;
constexpr int DFF = 2816, DFFE = 3584, NEXP = 8, LRUW = 1280;
constexpr float EPS = 1e-6f;
constexpr float MOE_WSCALE = 64.0f, MOE_HSCALE = 4.0f;
constexpr float LOG2E = 1.4426950408889634f;

constexpr size_t MiB = 1u << 20;
constexpr size_t WS_CTL = 0, CTL_ZERO_BYTES = 1 * MiB;
constexpr size_t WS_TAB = 1 * MiB;
constexpr size_t TB_MODS = WS_TAB;
constexpr size_t TB_COS = WS_TAB + 1 * MiB;
constexpr size_t TB_SIN = WS_TAB + 2 * MiB;
constexpr size_t TB_SCAL = WS_TAB + 3 * MiB;
constexpr size_t TB_LB = TB_SCAL + 4096;
constexpr size_t TB_SP = TB_SCAL + 16384;
constexpr size_t TB_EID = WS_TAB + 4 * MiB;
constexpr size_t TB_GATE = WS_TAB + 5 * MiB;
constexpr size_t TB_SLOT = WS_TAB + 6 * MiB;
constexpr size_t TB_BCNT = WS_TAB + 7 * MiB;
constexpr size_t TB_TILES = TB_BCNT + 16384;
constexpr size_t TB_LSUM = WS_TAB + 8 * MiB;
constexpr size_t TB_LCIN = WS_TAB + 16 * MiB;
constexpr size_t WS_W = 32 * MiB;
constexpr size_t W_QKV = WS_W;
constexpr size_t W_AO = W_QKV + 2 * (size_t)3072 * 1024 * 2;
constexpr size_t W_HGI = W_AO + 2 * (size_t)1024 * 1024 * 2;
constexpr size_t W_HGO = W_HGI + (size_t)5120 * 1024 * 2;
constexpr size_t W_LRI = W_HGO + (size_t)1024 * 1024 * 2;
constexpr size_t W_LRG = W_LRI + (size_t)2560 * 1024 * 2;
constexpr size_t W_LRO = W_LRG + (size_t)10 * 2 * 256 * 128 * 2;
constexpr size_t W_FGU = W_LRO + (size_t)1024 * 1280 * 2;
constexpr size_t W_FDN = W_FGU + 2 * (size_t)5632 * 1024 * 2;
constexpr size_t W_MGU = W_FDN + 2 * (size_t)1024 * 2816 * 2;
constexpr size_t W_MDN = W_MGU + 16 * (size_t)7168 * 1024 * 2;
constexpr size_t W_END = W_MDN + 16 * (size_t)1024 * 3584 * 2;
constexpr size_t WS_HM = 440 * MiB;
constexpr size_t WS_ACT = 568 * MiB;
static_assert(W_END <= WS_HM, "weights overflow");
constexpr size_t SZ_TOK = (size_t)MTOK * 1024 * 2;
constexpr size_t A_Q = WS_ACT, A_K = A_Q + SZ_TOK, A_V = A_K + SZ_TOK;
constexpr size_t F_HID = WS_ACT;
constexpr size_t H_Q = WS_ACT, H_LFF = H_Q + SZ_TOK, H_LFB = H_LFF + SZ_TOK, H_V = H_LFB + SZ_TOK, H_G = H_V + SZ_TOK, H_OF = H_G + SZ_TOK, H_OB = H_OF + SZ_TOK;
constexpr size_t SZ_LRU = (size_t)MTOK * 1280 * 2;
constexpr size_t L_YB = WS_ACT, L_XB = L_YB + SZ_LRU, L_HF = L_XB + SZ_LRU, L_HY = L_HF + SZ_LRU;
constexpr int MOE_ROWS = 2 * MTOK + NEXP * 256;
constexpr size_t E_XS = WS_ACT, E_HID = E_XS + (size_t)MOE_ROWS * 1024 * 2, E_END = E_HID + (size_t)MOE_ROWS * DFFE * 2;
constexpr size_t WS_NEED = E_END;
static_assert(WS_NEED <= (size_t)1792 * MiB, "workspace");

constexpr int CW_BAR = 4096;

constexpr int RING_BYTES = 135168;
constexpr int MISC_OFF = RING_BYTES;
constexpr int LDS_BYTES = 147456;
constexpr int NWAVES = 8, NTHR = 512;

typedef __bf16 bf16x2v __attribute__((ext_vector_type(2)));
__device__ __forceinline__ unsigned cvt_pk_bf16(float lo, float hi) { const f32x2 v = {lo, hi}; const bf16x2v b = __builtin_convertvector(v, bf16x2v); return __builtin_bit_cast(unsigned, b); }
__device__ __forceinline__ unsigned pk_fp8x4(float a, float b, float c, float d) { unsigned w = 0; w = __builtin_amdgcn_cvt_pk_fp8_f32(a, b, w, false); w = __builtin_amdgcn_cvt_pk_fp8_f32(c, d, w, true); return w; }
__device__ __forceinline__ unsigned f2bf(float f) { unsigned u = __builtin_bit_cast(unsigned, f); return (u + 0x7fffu + ((u >> 16) & 1u)) >> 16; }
__device__ __forceinline__ float bf2f(unsigned short b) { return __builtin_bit_cast(float, ((unsigned)b) << 16); }
__device__ __forceinline__ float bflo(unsigned w) { return __builtin_bit_cast(float, w << 16); }
__device__ __forceinline__ float bfhi(unsigned w) { return __builtin_bit_cast(float, w & 0xffff0000u); }
__device__ __forceinline__ float fexp2(float x) { return __builtin_amdgcn_exp2f(x); }
__device__ __forceinline__ float fexp(float x) { return __builtin_amdgcn_exp2f(x * LOG2E); }
__device__ __forceinline__ float frcp(float x) { return __builtin_amdgcn_rcpf(x); }
__device__ __forceinline__ float fsigmoid(float x) { return frcp(1.0f + fexp(-x)); }
__device__ __forceinline__ float fsilu(float x) { return x * fsigmoid(x); }
__device__ __forceinline__ float wave_sum(float v) {
#pragma unroll
    for (int o = 1; o < 64; o <<= 1) v += __shfl_xor(v, o);
    return v;
}
#define LDS_WAIT() asm volatile("s_waitcnt lgkmcnt(0)" ::: "memory")
#define VM_WAIT() asm volatile("s_waitcnt vmcnt(0)" ::: "memory")

#define XB_TMO      128
#define XB_XCNT(j)  (256  + 64 * (j))
#define XB_XSUB(j)  (1280 + 64 * (j))
#define XB_XGEN(j)  (2304 + 64 * (j))
#define XB_TOP      3328
#define XB_TOPGEN   3392
#define XCD_BAR_WORDS 3456
#define XB_SPIN_CAP (1u << 22)
__device__ __forceinline__ unsigned xb_ld(unsigned* p)              { return __hip_atomic_load(p, __ATOMIC_RELAXED, __HIP_MEMORY_SCOPE_AGENT); }
__device__ __forceinline__ unsigned xb_add(unsigned* p, unsigned v) { return __hip_atomic_fetch_add(p, v, __ATOMIC_RELAXED, __HIP_MEMORY_SCOPE_AGENT); }
__device__ __forceinline__ unsigned xb_xcc_id() { return (unsigned)__builtin_amdgcn_s_getreg((3 << 11) | 20) & 0xFu; }
#define XB_SPIN(cond, bar) do { unsigned _sp = 0; while (cond) { __builtin_amdgcn_s_sleep(1); \
    if ((++_sp & 255u) == 0u) { if (xb_ld(&(bar)[XB_TMO])) break; if (_sp > XB_SPIN_CAP) { atomicAdd(&(bar)[XB_TMO], 1u); break; } } } } while (0)
struct XcdBarrier { unsigned* bar; unsigned x; volatile LAS unsigned* st; };
__device__ __forceinline__ XcdBarrier xcd_barrier_post(unsigned* bar, volatile LAS unsigned* st) {
    XcdBarrier b; b.bar = bar; b.x = xb_xcc_id(); b.st = st;
    if (threadIdx.x == 0) (void)xb_add(&bar[XB_XCNT(b.x)], 1u);
    return b;
}
__device__ __forceinline__ void xcd_barrier_complete(unsigned* bar, unsigned x, unsigned& nloc, unsigned& nx) {
    const unsigned G = gridDim.x * gridDim.y * gridDim.z;
    unsigned sum, cnt, mine, sp = 0u;
    for (;;) {
        sum = 0u; cnt = 0u; mine = 0u;
#pragma unroll
        for (unsigned j = 0; j < 16; ++j) { const unsigned c = xb_ld(&bar[XB_XCNT(j)]); sum += c; cnt += (c > 0u) ? 1u : 0u; mine = (j == x) ? c : mine; }
        if (sum == G) break;
        __builtin_amdgcn_s_sleep(1);
        if ((++sp & 255u) == 0u) { if (xb_ld(&bar[XB_TMO])) break; if (sp > XB_SPIN_CAP) { atomicAdd(&bar[XB_TMO], 1u); break; } }
    }
    nloc = mine > 0u ? mine : 1u; nx = cnt > 0u ? cnt : 1u;
}
__device__ __forceinline__ void xcd_barrier(const XcdBarrier& b) {
    asm volatile("s_waitcnt vmcnt(0)" ::: "memory");
    __syncthreads();
    if (threadIdx.x == 0) {
        unsigned* bar = b.bar;
        __builtin_amdgcn_s_waitcnt(0);
        unsigned nloc = b.st[0], nx = b.st[1];
        if (nloc == 0u) { xcd_barrier_complete(bar, b.x, nloc, nx); b.st[0] = nloc; b.st[1] = nx; }
        const unsigned old = xb_add(&bar[XB_XSUB(b.x)], 1u);
        const unsigned gen = old / nloc;
        if (old + 1u == (gen + 1u) * nloc) {
            __builtin_amdgcn_fence(__ATOMIC_RELEASE, "agent");
            asm volatile("s_waitcnt vmcnt(0)" ::: "memory");
            const unsigned og = xb_add(&bar[XB_TOP], 1u);
            const unsigned tg = og / nx;
            if (og + 1u == (tg + 1u) * nx) xb_add(&bar[XB_TOPGEN], 1u);
            else XB_SPIN(xb_ld(&bar[XB_TOPGEN]) == tg, bar);
            __builtin_amdgcn_fence(__ATOMIC_ACQUIRE, "agent");
            xb_add(&bar[XB_XGEN(b.x)], 1u);
            asm volatile("s_waitcnt vmcnt(0)" ::: "memory");
        } else {
            XB_SPIN(xb_ld(&bar[XB_XGEN(b.x)]) == gen, bar);
            __builtin_amdgcn_fence(__ATOMIC_ACQUIRE, "agent");
            asm volatile("s_waitcnt vmcnt(0)" ::: "memory");
        }
    }
    __syncthreads();
}

namespace pg8 {
constexpr int BM = 256, BK = 64, HALF = 128, HTB = HALF * BK * 2, STAGE_BYTES = 8 * HTB, NXCD = 8, WGM = 8;
__host__ __device__ __forceinline__ int lds_byte(int r, int c) { const int st = (r >> 4) * 2 + (c >> 5), rr = r & 15, cc = c & 31, ob = rr * 64 + cc * 2; return st * 1024 + (ob ^ (((ob >> 9) & 1) << 5)); }
__host__ __device__ __forceinline__ void stage_rc(int b, int& R, int& C) { const int st = b / 1024, sb = b % 1024, swz = sb ^ (((sb >> 9) & 1) << 5); R = (st >> 1) * 16 + swz / 64; C = (st & 1) * 32 + (swz % 64) / 2; }
__host__ __device__ __forceinline__ int perm32(int rho) { const int n = rho >> 4, i = rho & 15; return 8 * (i >> 2) + 4 * n + (i & 3); }

struct Unit { int pm, pn, pb; };
struct Gemm { const bf16_t* A; const bf16_t* Bt; int K; };

struct TileOrder {
    int nM, nN, nwg, G, c; int ts[NEXP];
    __device__ __forceinline__ void init(int nM_, int nN_, int G_, int c_) { nM = nM_; nN = nN_; nwg = nM * nN; G = G_; c = c_;
#pragma unroll
        for (int e = 0; e < NEXP; ++e) ts[e] = (e == 0) ? 0 : 0x7fffffff; }
    __device__ __forceinline__ bool next(int i, Unit& u) const {
        const long L = (long)i * G + c; if (L >= nwg) return false;
        int wgid = (int)L; { const int q = nwg / NXCD, r = nwg % NXCD, xcd = wgid % NXCD, off = wgid / NXCD; wgid = (xcd < r ? xcd * (q + 1) : r * (q + 1) + (xcd - r) * q) + off; }
        const int nig = WGM * nN, gid = wgid / nig, fm = gid * WGM, gsz = (nM - fm) < WGM ? (nM - fm) : WGM;
        u.pm = fm + ((wgid % nig) % gsz); u.pn = (wgid % nig) / gsz;
        int e = 0;
#pragma unroll
        for (int k = 1; k < NEXP; ++k) e += (u.pm >= ts[k]) ? 1 : 0;
        u.pb = e * nN + u.pn; return true;
    }
};

typedef int v8i32 __attribute__((ext_vector_type(8)));
template <class Epi, bool FP8 = false>
__device__ __forceinline__ void gemm_phase(LAS unsigned char* lds, const Gemm g, const TileOrder& S, const Epi& E) {
    int tid_ = threadIdx.x; asm volatile("" : "+v"(tid_));
    const int tid = tid_, wid = __builtin_amdgcn_readfirstlane(tid >> 6), lane = tid & 63, wr = wid >> 2, wc = wid & 3, fr = lane & 15, fq = lane >> 4;
    const int K = g.K, nt = K / BK;
    unsigned voffA[2], voffB[2];
#pragma unroll
    for (int i = 0; i < 2; ++i) { int R, C; stage_rc(tid * 16 + i * 8192, R, C); const int Rb = Epi::PERM ? ((R & ~31) + perm32(R & 31)) : R;
        voffA[i] = (unsigned)(R * K + C) * 2u; voffB[i] = (unsigned)(Rb * K + C) * 2u; }
    const size_t kstep = (size_t)(BK * 2);
    const size_t hstep = (size_t)HALF * K * 2;
    const size_t tstep = 2 * hstep;
    const unsigned ldsw = (unsigned)wid * 1024u;
    const int aoff = lds_byte(wr * 64 + fr, fq * 8), boff = lds_byte(wc * 32 + fr, fq * 8);
#define PG8_SA(b, h) (((b) * 2 + (h)) * HTB)
#define PG8_SB(b, h) ((4 + (b) * 2 + (h)) * HTB)
#define PG8_STAGE(bufoff, gbase, voff) do { _Pragma("unroll") for (int _i = 0; _i < 2; ++_i) \
        __builtin_amdgcn_global_load_lds((const unsigned*)((const char*)(gbase) + (voff)[_i]), (LAS unsigned*)(lds + (bufoff) + ldsw + _i * 8192), 16, 0, 0); } while (0)
#define PG8_LD8(p) __builtin_bit_cast(v8i32, __builtin_shufflevector(*(const LAS u32x4*)(p), *(const LAS u32x4*)((p) + 1024), 0, 1, 2, 3, 4, 5, 6, 7))
#define PG8_LDA(dst, b, h) do { if constexpr (FP8) { _Pragma("unroll") for (int m = 0; m < 4; ++m) dst##8[m] = PG8_LD8(lds + PG8_SA(b, h) + aoff + m * 2048); } \
        else { _Pragma("unroll") for (int m = 0; m < 4; ++m) _Pragma("unroll") for (int k = 0; k < 2; ++k) dst[m][k] = *(const LAS bf16x8*)(lds + PG8_SA(b, h) + aoff + m * 2048 + k * 1024); } } while (0)
#define PG8_LDB(dst, b, h) do { if constexpr (FP8) { _Pragma("unroll") for (int n = 0; n < 2; ++n) dst##8[n] = PG8_LD8(lds + PG8_SB(b, h) + boff + n * 2048); } \
        else { _Pragma("unroll") for (int n = 0; n < 2; ++n) _Pragma("unroll") for (int k = 0; k < 2; ++k) dst[n][k] = *(const LAS bf16x8*)(lds + PG8_SB(b, h) + boff + n * 2048 + k * 1024); } } while (0)
#define PG8_MMA(ai, bj, At, Bt) do { __builtin_amdgcn_s_setprio(1); \
        if constexpr (FP8) { _Pragma("unroll") for (int m = 0; m < 4; ++m) _Pragma("unroll") for (int n = 0; n < 2; ++n) \
            asm volatile("v_mfma_scale_f32_16x16x128_f8f6f4 %0, %1, %2, %0, %3, %3 op_sel_hi:[0,0,0]" : "+v"(acc[ai][bj][m][n]) : "v"(Bt##8[n]), "v"(At##8[m]), "v"(one_scale)); } \
        else { _Pragma("unroll") for (int m = 0; m < 4; ++m) _Pragma("unroll") for (int n = 0; n < 2; ++n) _Pragma("unroll") for (int k = 0; k < 2; ++k) \
            acc[ai][bj][m][n] = __builtin_amdgcn_mfma_f32_16x16x32_bf16(Bt[n][k], At[m][k], acc[ai][bj][m][n], 0, 0, 0); } \
        __builtin_amdgcn_s_setprio(0); } while (0)
#define PG8_WAIT_V(n) asm volatile("s_waitcnt vmcnt(" #n ")" ::: "memory")
#define PG8_WAIT_L(n) asm volatile("s_waitcnt lgkmcnt(" #n ")" ::: "memory")
#define PG8_BAR __builtin_amdgcn_s_barrier()
#define PG8_SCHED __builtin_amdgcn_sched_barrier(0)
    Unit cur, nxt; int ui = 0;
    if (!S.next(0, cur)) return;
    f32x4 acc[2][2][4][2];
#pragma unroll
    for (int a = 0; a < 2; ++a)
#pragma unroll
        for (int b = 0; b < 2; ++b)
#pragma unroll
            for (int m = 0; m < 4; ++m)
#pragma unroll
                for (int n = 0; n < 2; ++n) acc[a][b][m][n] = (f32x4){0.f, 0.f, 0.f, 0.f};
    bf16x8 At[4][2], B0[2][2], B1[2][2]; v8i32 At8[4], B08[2], B18[2];
    int one_scale = 0x7f7f7f7f; asm volatile("" : "+v"(one_scale));
    const char* cA = (const char*)g.A + (size_t)cur.pm * tstep; const char* cB = (const char*)g.Bt + (size_t)cur.pb * tstep;
    PG8_STAGE(PG8_SB(0, 0), cB, voffB); PG8_STAGE(PG8_SA(0, 0), cA, voffA); PG8_STAGE(PG8_SB(0, 1), cB + hstep, voffB); PG8_STAGE(PG8_SA(0, 1), cA + hstep, voffA);
    if (wr == 1) PG8_BAR;
    PG8_WAIT_V(4); PG8_BAR;
    PG8_STAGE(PG8_SB(1, 0), cB + kstep, voffB); PG8_STAGE(PG8_SA(1, 0), cA + kstep, voffA); PG8_STAGE(PG8_SB(1, 1), cB + hstep + kstep, voffB);
    PG8_WAIT_V(6); PG8_BAR;
    for (;;) {
        const bool has_next = S.next(ui + 1, nxt);
        const char* nA = has_next ? (const char*)g.A + (size_t)nxt.pm * tstep : cA; const char* nB = has_next ? (const char*)g.Bt + (size_t)nxt.pb * tstep : cB;
        for (int t = 0; t < nt; t += 2) {
            const bool last = (t == nt - 2);
            const char* a1 = cA + (size_t)(t + 1) * kstep;
            const char* a2 = last ? nA : cA + (size_t)(t + 2) * kstep; const char* b2 = last ? nB : cB + (size_t)(t + 2) * kstep;
            const char* a3 = a2 + kstep; const char* b3 = b2 + kstep;
            PG8_LDB(B0, 0, 0); PG8_SCHED; PG8_LDA(At, 0, 0); PG8_STAGE(PG8_SA(1, 1), a1 + hstep, voffA);
            PG8_WAIT_L(8); PG8_BAR; PG8_WAIT_L(0); PG8_MMA(0, 0, At, B0); PG8_BAR; PG8_SCHED;
            PG8_LDB(B1, 0, 1); PG8_STAGE(PG8_SB(0, 0), b2, voffB);
            PG8_BAR; PG8_WAIT_L(0); PG8_MMA(0, 1, At, B1); PG8_BAR;
            PG8_LDA(At, 0, 1); PG8_STAGE(PG8_SA(0, 0), a2, voffA);
            PG8_BAR; PG8_WAIT_L(0); PG8_MMA(1, 0, At, B0); PG8_BAR; PG8_SCHED;
            PG8_STAGE(PG8_SB(0, 1), b2 + hstep, voffB);
            PG8_WAIT_V(6); PG8_BAR; PG8_MMA(1, 1, At, B1); PG8_BAR;
            PG8_LDB(B0, 1, 0); PG8_SCHED; PG8_LDA(At, 1, 0); PG8_STAGE(PG8_SA(0, 1), a2 + hstep, voffA);
            PG8_WAIT_L(8); PG8_BAR; PG8_WAIT_L(0); PG8_MMA(0, 0, At, B0); PG8_BAR; PG8_SCHED;
            PG8_LDB(B1, 1, 1); PG8_STAGE(PG8_SB(1, 0), b3, voffB);
            PG8_BAR; PG8_WAIT_L(0); PG8_MMA(0, 1, At, B1); PG8_BAR;
            PG8_LDA(At, 1, 1); PG8_STAGE(PG8_SA(1, 0), a3, voffA);
            PG8_BAR; PG8_WAIT_L(0); PG8_MMA(1, 0, At, B0); PG8_BAR; PG8_SCHED;
            PG8_STAGE(PG8_SB(1, 1), b3 + hstep, voffB);
            PG8_WAIT_V(6); PG8_BAR; PG8_MMA(1, 1, At, B1); PG8_BAR;
        }
        if constexpr (FP8) asm volatile("s_nop 15\n\ts_nop 15" ::: "memory");
        E(acc, cur, wr, wc, fr, fq);
        if (!has_next) break;
#pragma unroll
        for (int a = 0; a < 2; ++a)
#pragma unroll
            for (int b = 0; b < 2; ++b)
#pragma unroll
                for (int m = 0; m < 4; ++m)
#pragma unroll
                    for (int n = 0; n < 2; ++n) acc[a][b][m][n] = (f32x4){0.f, 0.f, 0.f, 0.f};
        cur = nxt; cA = nA; cB = nB; ++ui;
    }
    PG8_WAIT_V(0);
    if (wr == 0) PG8_BAR;
    PG8_BAR;
#undef PG8_SA
#undef PG8_SB
#undef PG8_STAGE
#undef PG8_LDA
#undef PG8_LDB
#undef PG8_MMA
#undef PG8_LD8
#undef PG8_WAIT_V
#undef PG8_WAIT_L
#undef PG8_BAR
#undef PG8_SCHED
}

struct EpiQKV {
    static constexpr bool PERM = true;
    bf16_t *Q, *Kk, *V; const float *gq, *gk, *cosT, *sinT; float qscale;
    __device__ __forceinline__ void operator()(const f32x4 (&acc)[2][2][4][2], const Unit& u, int wr, int wc, int fr, int fq) const {
        const int row0 = u.pm * BM + wr * 64 + fr;
        if (u.pn >= 8) {
            const int col0 = (u.pn - 8) * BM + wc * 32 + 8 * fq;
#pragma unroll
            for (int ai = 0; ai < 2; ++ai)
#pragma unroll
                for (int m = 0; m < 4; ++m) { bf16_t* rowp = V + (size_t)(row0 + ai * HALF + m * 16) * DM + col0;
#pragma unroll
                    for (int bj = 0; bj < 2; ++bj) { const f32x4 v0 = acc[ai][bj][m][0], v1 = acc[ai][bj][m][1];
                        u32x4 w; w.x = cvt_pk_bf16(v0[0], v0[1]); w.y = cvt_pk_bf16(v0[2], v0[3]); w.z = cvt_pk_bf16(v1[0], v1[1]); w.w = cvt_pk_bf16(v1[2], v1[3]);
                        *(u32x4*)(rowp + bj * HALF) = w; } }
        } else {
            const int part = u.pn >> 2, sh = 4 * (u.pn & 3) + wc;
            bf16_t* dst = part ? Kk : Q; const float* g = part ? gk : gq; const float sc = part ? 1.0f : qscale;
            f32x4 g0[2], g1[2];
#pragma unroll
            for (int n = 0; n < 2; ++n) { g0[n] = *(const f32x4*)(g + 8 * fq + 4 * n); g1[n] = *(const f32x4*)(g + 32 + 8 * fq + 4 * n); }
#pragma unroll
            for (int ai = 0; ai < 2; ++ai)
#pragma unroll
                for (int m = 0; m < 4; ++m) {
                    const int r = row0 + ai * HALF + m * 16; const int pos = r & (SEQ - 1);
                    f32x4 x1[2], x2[2]; float ss = 0.f;
#pragma unroll
                    for (int n = 0; n < 2; ++n) { x1[n] = acc[ai][0][m][n]; x2[n] = acc[ai][1][m][n];
                        ss += (x1[n][0] * x1[n][0] + x1[n][1] * x1[n][1]) + (x1[n][2] * x1[n][2] + x1[n][3] * x1[n][3]);
                        ss += (x2[n][0] * x2[n][0] + x2[n][1] * x2[n][1]) + (x2[n][2] * x2[n][2] + x2[n][3] * x2[n][3]); }
                    ss += __shfl_xor(ss, 16); ss += __shfl_xor(ss, 32);
                    const float rstd = __builtin_amdgcn_rsqf(ss * (1.0f / 64.0f) + EPS) ;
                    bf16_t* op = dst + (size_t)r * DM + sh * 64 + 8 * fq;
                    u32x4 w1, w2;
#pragma unroll
                    for (int n = 0; n < 2; ++n) {
                        const f32x4 cs = *(const f32x4*)(cosT + pos * 32 + 8 * fq + 4 * n), sn = *(const f32x4*)(sinT + pos * 32 + 8 * fq + 4 * n);
                        const f32x4 y1 = x1[n] * rstd * g0[n], y2 = x2[n] * rstd * g1[n];
                        const f32x4 o1 = (y1 * cs - y2 * sn) * sc, o2 = (y2 * cs + y1 * sn) * sc;
                        if (n == 0) { w1.x = cvt_pk_bf16(o1[0], o1[1]); w1.y = cvt_pk_bf16(o1[2], o1[3]); w2.x = cvt_pk_bf16(o2[0], o2[1]); w2.y = cvt_pk_bf16(o2[2], o2[3]); }
                        else { w1.z = cvt_pk_bf16(o1[0], o1[1]); w1.w = cvt_pk_bf16(o1[2], o1[3]); w2.z = cvt_pk_bf16(o2[0], o2[1]); w2.w = cvt_pk_bf16(o2[2], o2[3]); }
                    }
                    *(u32x4*)(op) = w1; *(u32x4*)(op + 32) = w2;
                }
        }
    }
};
struct EpiRes {
    static constexpr bool PERM = false;
    const float* xin; float* xout; const float* gate;
    __device__ __forceinline__ void operator()(const f32x4 (&acc)[2][2][4][2], const Unit& u, int wr, int wc, int fr, int fq) const {
        const int row0 = u.pm * BM + wr * 64 + fr, col0 = u.pn * BM + wc * 32 + 4 * fq;
        const float* gp = gate + (size_t)(u.pm >> 5) * 6144 + col0;
        f32x4 gv[2][2];
#pragma unroll
        for (int bj = 0; bj < 2; ++bj)
#pragma unroll
            for (int n = 0; n < 2; ++n) gv[bj][n] = *(const f32x4*)(gp + bj * HALF + n * 16);
#pragma unroll
        for (int ai = 0; ai < 2; ++ai)
#pragma unroll
            for (int m = 0; m < 4; ++m) { const size_t off = (size_t)(row0 + ai * HALF + m * 16) * DM + col0;
#pragma unroll
                for (int bj = 0; bj < 2; ++bj)
#pragma unroll
                    for (int n = 0; n < 2; ++n) { const f32x4 xv = *(const f32x4*)(xin + off + bj * HALF + n * 16);
                        *(f32x4*)(xout + off + bj * HALF + n * 16) = xv + gv[bj][n] * acc[ai][bj][m][n]; }
                asm volatile("" ::: "memory"); }
    }
};
struct EpiSwiGLU {
    static constexpr bool PERM = true;
    bf16_t* H; int ldh;
    __device__ __forceinline__ void operator()(const f32x4 (&acc)[2][2][4][2], const Unit& u, int wr, int wc, int fr, int fq) const {
        const int row0 = u.pm * BM + wr * 64 + fr, col0 = u.pn * HALF + wc * 32 + 8 * fq;
#pragma unroll
        for (int ai = 0; ai < 2; ++ai)
#pragma unroll
            for (int m = 0; m < 4; ++m) { bf16_t* rowp = H + (size_t)(row0 + ai * HALF + m * 16) * ldh + col0;
                f32x4 v[2];
#pragma unroll
                for (int n = 0; n < 2; ++n) { const f32x4 gt = acc[ai][0][m][n], up = acc[ai][1][m][n];
#pragma unroll
                    for (int j = 0; j < 4; ++j) v[n][j] = fsilu(gt[j]) * up[j]; }
                u32x4 w; w.x = cvt_pk_bf16(v[0][0], v[0][1]); w.y = cvt_pk_bf16(v[0][2], v[0][3]); w.z = cvt_pk_bf16(v[1][0], v[1][1]); w.w = cvt_pk_bf16(v[1][2], v[1][3]);
                *(u32x4*)rowp = w; }
    }
};
struct EpiSwiGLU8 {
    static constexpr bool PERM = true;
    unsigned char* H; int ldh; float ws, hs;
    __device__ __forceinline__ void operator()(const f32x4 (&acc)[2][2][4][2], const Unit& u, int wr, int wc, int fr, int fq) const {
        const int row0 = u.pm * BM + wr * 64 + fr, col0 = u.pn * HALF + wc * 32 + 8 * fq;
#pragma unroll
        for (int ai = 0; ai < 2; ++ai)
#pragma unroll
            for (int m = 0; m < 4; ++m) { unsigned char* rowp = H + (size_t)(row0 + ai * HALF + m * 16) * ldh + col0;
                f32x4 v[2];
#pragma unroll
                for (int n = 0; n < 2; ++n) { const f32x4 gt = acc[ai][0][m][n] * ws, up = acc[ai][1][m][n] * (ws * hs);
#pragma unroll
                    for (int j = 0; j < 4; ++j) v[n][j] = fsilu(gt[j]) * up[j]; }
                *(u32x2*)rowp = (u32x2){pk_fp8x4(v[0][0], v[0][1], v[0][2], v[0][3]), pk_fp8x4(v[1][0], v[1][1], v[1][2], v[1][3])}; }
    }
};
struct EpiPlain {
    static constexpr bool PERM = true;
    bf16_t* O; int ldc; float sc;
    __device__ __forceinline__ void operator()(const f32x4 (&acc)[2][2][4][2], const Unit& u, int wr, int wc, int fr, int fq) const {
        const int row0 = u.pm * BM + wr * 64 + fr, col0 = u.pn * BM + wc * 32 + 8 * fq;
#pragma unroll
        for (int ai = 0; ai < 2; ++ai)
#pragma unroll
            for (int m = 0; m < 4; ++m) { bf16_t* rowp = O + (size_t)(row0 + ai * HALF + m * 16) * ldc + col0;
#pragma unroll
                for (int bj = 0; bj < 2; ++bj) { const f32x4 v0 = acc[ai][bj][m][0] * sc, v1 = acc[ai][bj][m][1] * sc;
                    u32x4 w; w.x = cvt_pk_bf16(v0[0], v0[1]); w.y = cvt_pk_bf16(v0[2], v0[3]); w.z = cvt_pk_bf16(v1[0], v1[1]); w.w = cvt_pk_bf16(v1[2], v1[3]);
                    *(u32x4*)(rowp + bj * HALF) = w; } }
    }
};
struct EpiAct {
    static constexpr bool PERM = true;
    int kind; unsigned char* ws; const float* lb;
    __device__ __forceinline__ void operator()(const f32x4 (&acc)[2][2][4][2], const Unit& u, int wr, int wc, int fr, int fq) const {
        const int row0 = u.pm * BM + wr * 64 + fr;
        int mode, ldc, colt; size_t boff;
        if (kind == 0) { const int grp = u.pn >> 2; colt = (u.pn & 3) * 256; ldc = 1024;
            boff = grp == 0 ? H_Q : grp == 1 ? H_LFF : grp == 2 ? H_LFB : grp == 3 ? H_V : H_G; mode = (grp == 0 || grp == 4) ? 1 : (grp == 3 ? 0 : 3); }
        else { ldc = LRUW; if (u.pn < 5) { boff = L_YB; colt = u.pn * 256; mode = 2; } else { boff = L_XB; colt = (u.pn - 5) * 256; mode = 0; } }
        bf16_t* base = (bf16_t*)(ws + boff);
        const int col0 = colt + wc * 32 + 8 * fq;
        f32x4 lbv[2][2];
        if (mode == 3) { const float* lp = lb + ((u.pn >> 2) - 1) * 1024 + col0;
#pragma unroll
            for (int bj = 0; bj < 2; ++bj)
#pragma unroll
                for (int n = 0; n < 2; ++n) lbv[bj][n] = *(const f32x4*)(lp + bj * HALF + 4 * n); }
#pragma unroll
        for (int ai = 0; ai < 2; ++ai)
#pragma unroll
            for (int m = 0; m < 4; ++m) { bf16_t* rowp = base + (size_t)(row0 + ai * HALF + m * 16) * ldc + col0;
#pragma unroll
                for (int bj = 0; bj < 2; ++bj) { f32x4 v[2]; u32x4 w;
#pragma unroll
                    for (int n = 0; n < 2; ++n) { v[n] = acc[ai][bj][m][n];
                        if (mode == 1) {
#pragma unroll
                            for (int j = 0; j < 4; ++j) v[n][j] = fsilu(v[n][j]); }
                        else if (mode == 2) {
#pragma unroll
                            for (int j = 0; j < 4; ++j) { const float x = v[n][j]; v[n][j] = x * fsigmoid(1.5957691216057308f * (x + 0.044715f * x * x * x)); } }
                        else if (mode == 3) {
#pragma unroll
                            for (int j = 0; j < 4; ++j) { const float l = lbv[bj][n][j]; const float fg = l + (1.0f - l) * fsigmoid(v[n][j]); v[n][j] = __builtin_amdgcn_logf(fg) * 0.6931471805599453f; } }
                    }
                    if (mode == 3) {
#pragma unroll
                        for (int n = 0; n < 2; ++n) { const _Float16 h0 = (_Float16)v[n][0], h1 = (_Float16)v[n][1], h2 = (_Float16)v[n][2], h3 = (_Float16)v[n][3];
                            const unsigned a = (unsigned)__builtin_bit_cast(unsigned short, h0) | ((unsigned)__builtin_bit_cast(unsigned short, h1) << 16);
                            const unsigned b = (unsigned)__builtin_bit_cast(unsigned short, h2) | ((unsigned)__builtin_bit_cast(unsigned short, h3) << 16);
                            if (n == 0) { w.x = a; w.y = b; } else { w.z = a; w.w = b; } }
                    } else { w.x = cvt_pk_bf16(v[0][0], v[0][1]); w.y = cvt_pk_bf16(v[0][2], v[0][3]); w.z = cvt_pk_bf16(v[1][0], v[1][1]); w.w = cvt_pk_bf16(v[1][2], v[1][3]); }
                    *(u32x4*)(rowp + bj * HALF) = w; } }
    }
};
}

struct Args { const float* in[30]; float* out; unsigned char* ws; };
enum { I_X = 0, I_C, I_ADAW, I_ADAB, I_N1G, I_N2G, I_ATWIN, I_ATQN, I_ATKN, I_ATLAM, I_ATSUB, I_ATWOUT, I_HGWIN, I_HGLB, I_HGNG, I_HGWOUT,
       I_LRWIN, I_LRCW, I_LRCB, I_LRWA, I_LRBA, I_LRWX, I_LRBX, I_LRLAM, I_LRWOUT, I_FFGU, I_FFDN, I_MOER, I_MOEGU, I_MOEDN };
enum { SC_LAM0 = 0, SC_LAM1, SC_OML0, SC_OML1, SC_MC0, SC_MC1 };

__device__ __forceinline__ void cvt_item(const float* W, int ldw, int src_col0, bf16_t* WT, int ldt, int dst_row0, int k0, LAS float* scr, int lane) {
#pragma unroll 8
    for (int i = 0; i < 32; ++i) { const int kk = 2 * i + (lane >> 5); scr[kk * 33 + (lane & 31)] = W[(size_t)(k0 + kk) * ldw + src_col0 + (lane & 31)]; }
    LDS_WAIT(); asm volatile("" ::: "memory");
    const int c = lane & 7;
#pragma unroll
    for (int j = 0; j < 4; ++j) { const int n = (lane >> 3) + 8 * j; const LAS float* s = scr + (8 * c) * 33 + n;
        u32x4 o; o.x = cvt_pk_bf16(s[0 * 33], s[1 * 33]); o.y = cvt_pk_bf16(s[2 * 33], s[3 * 33]); o.z = cvt_pk_bf16(s[4 * 33], s[5 * 33]); o.w = cvt_pk_bf16(s[6 * 33], s[7 * 33]);
        *(u32x4*)(WT + (size_t)(dst_row0 + n) * ldt + k0 + 8 * c) = o; }
    LDS_WAIT(); asm volatile("" ::: "memory");
}
__device__ __forceinline__ void cvt_item8(const float* W, int ldw, int src_col0, unsigned char* WT, int ldt, int dst_row0, int k0, float sc, LAS float* scr, int lane) {
#pragma unroll 8
    for (int i = 0; i < 32; ++i) { const int kk = 2 * i + (lane >> 5); scr[kk * 33 + (lane & 31)] = W[(size_t)(k0 + kk) * ldw + src_col0 + (lane & 31)]; }
    LDS_WAIT(); asm volatile("" ::: "memory");
    const int c = lane & 7;
#pragma unroll
    for (int j = 0; j < 4; ++j) { const int n = (lane >> 3) + 8 * j; const LAS float* s = scr + (8 * c) * 33 + n;
        *(u32x2*)(WT + (size_t)(dst_row0 + n) * ldt + k0 + 8 * c) = (u32x2){pk_fp8x4(s[0 * 33] * sc, s[1 * 33] * sc, s[2 * 33] * sc, s[3 * 33] * sc), pk_fp8x4(s[4 * 33] * sc, s[5 * 33] * sc, s[6 * 33] * sc, s[7 * 33] * sc)}; }
    LDS_WAIT(); asm volatile("" ::: "memory");
}
enum { MAP_ID = 0, MAP_QKV = 1, MAP_SWI = 2 };
template <bool F8 = false>
__device__ __forceinline__ void cvt_family(const float* src, size_t sstride, int ninst, int ldw, int K, int ng, int map, int F, bf16_t* dst, size_t dstride,
                                           LAS float* scr, int gw, int NGW, int lane) {
    const int nkb = K / 64, per = nkb * ng, total = ninst * per;
    for (int it = gw; it < total; it += NGW) {
        const int inst = it / per, r = it - inst * per, kb = r / ng, gi = r - kb * ng;
        int sc0;
        if (map == MAP_ID) sc0 = 32 * gi;
        else if (map == MAP_QKV) { const int pn = gi >> 3, bj = (gi >> 2) & 1, wc = gi & 3;
            if (pn < 8) { const int part = pn >> 2, sh = 4 * (pn & 3) + wc; sc0 = part * 1024 + sh * 64 + 32 * bj; } else sc0 = 32 * gi; }
        else { const int pn = gi >> 3, bj = (gi >> 2) & 1, q = gi & 3; sc0 = bj * F + pn * 128 + 32 * q; }
        if constexpr (F8) cvt_item8(src + (size_t)inst * sstride, ldw, sc0, (unsigned char*)dst + (size_t)inst * dstride, K, 32 * gi, 64 * kb, MOE_WSCALE, scr, lane);
        else cvt_item(src + (size_t)inst * sstride, ldw, sc0, dst + (size_t)inst * dstride, K, 32 * gi, 64 * kb, scr, lane);
    }
}

__device__ __forceinline__ void prologue_phase(const Args& A, LAS unsigned char* lds, int bid, int G) {
    const int tid = threadIdx.x, lane = tid & 63, wave = tid >> 6;
    unsigned char* ws = A.ws;
    {
        LAS float* sc = (LAS float*)lds;
        LAS float* red = (LAS float*)(lds + 32768);
        for (int i = tid; i < NBATCH * DM; i += NTHR) { const float cv = A.in[I_C][i]; sc[i] = fsilu(cv); }
        __syncthreads();
        float* mods = (float*)(ws + TB_MODS);
        for (int cb = bid; cb < (DEPTH * 6144) / 128; cb += G) {
            const int col = cb * 128 + (tid & 127), l = col / 6144, e = col - l * 6144, ch = tid >> 7;
            const float* wp = A.in[I_ADAW] + (size_t)l * DM * 6144 + e;
            float a[NBATCH];
#pragma unroll
            for (int b = 0; b < NBATCH; ++b) a[b] = 0.f;
#pragma unroll 4
            for (int d = ch * 256; d < ch * 256 + 256; ++d) { const float w = wp[(size_t)d * 6144];
#pragma unroll
                for (int b = 0; b < NBATCH; ++b) a[b] += sc[b * DM + d] * w; }
#pragma unroll
            for (int b = 0; b < NBATCH; ++b) red[(ch * 128 + (tid & 127)) * 8 + b] = a[b];
            __syncthreads();
            if (tid < 128) { const float bias = A.in[I_ADAB][l * 6144 + e];
#pragma unroll
                for (int b = 0; b < NBATCH; ++b) { const float s = ((red[(0 * 128 + tid) * 8 + b] + red[(1 * 128 + tid) * 8 + b]) + (red[(2 * 128 + tid) * 8 + b] + red[(3 * 128 + tid) * 8 + b])) + bias;
                    mods[((size_t)l * NBATCH + b) * 6144 + e] = s; } }
            __syncthreads();
        }
    }
    {
        float* cosT = (float*)(ws + TB_COS); float* sinT = (float*)(ws + TB_SIN);
        for (int i = bid * NTHR + tid; i < SEQ * 32; i += G * NTHR) {
            const int pos = i >> 5, d = i & 31;
            const float inv = (float)exp(-(double)d * (1.0 / 32.0) * 9.210340371976184);
            const float ang = (float)pos * inv;
            const double rev = (double)ang * 0.15915494309189535; const float fr = (float)(rev - floor(rev));
            cosT[i] = __builtin_amdgcn_cosf(fr); sinT[i] = __builtin_amdgcn_sinf(fr);
        }
        if (bid == 0 && tid < 2) {
            const int a = tid; const float* lm = A.in[I_ATLAM] + a * 256;
            float s1 = 0.f, s2 = 0.f; for (int i = 0; i < 64; ++i) { s1 += lm[i] * lm[64 + i]; s2 += lm[128 + i] * lm[192 + i]; }
            const float linit = 0.8f - 0.6f * expf(-0.3f * (float)(3 * a));
            float mq = 0.f, mk = 0.f; for (int i = 0; i < 64; ++i) { mq = fmaxf(mq, fabsf(A.in[I_ATQN][a * 64 + i])); mk = fmaxf(mk, fabsf(A.in[I_ATKN][a * 64 + i])); }
            float* scal = (float*)(ws + TB_SCAL);
            scal[SC_LAM0 + a] = expf(s1) - expf(s2) + linit; scal[SC_OML0 + a] = 1.0f - linit; scal[SC_MC0 + a] = 8.0f * mq * mk * LOG2E * 1.0001f;
        }
        if (bid == 1) {
            float* lb = (float*)(ws + TB_LB);
            for (int i = tid; i < 2 * 1024; i += NTHR) { const int d = i >> 10, k = i & 1023; const float* p = A.in[I_HGLB] + (size_t)d * DEPTH * 1024 + k;
                float mx = p[0]; for (int l = 1; l < DEPTH; ++l) mx = fmaxf(mx, p[l * 1024]);
                float den = 0.f, num = 0.f; for (int l = 0; l < DEPTH; ++l) { const float e = expf(p[l * 1024] - mx); den += e; if (l == 1) num += e; }
                lb[i] = num / den; }
        }
        if (bid == 2) {
            float* sp = (float*)(ws + TB_SP);
            for (int i = tid; i < 2 * LRUW; i += NTHR) { const float x = -A.in[I_LRLAM][i]; sp[i] = (x > 20.f) ? x : log1pf(expf(x)); }
        }
    }
    {
        LAS float* scr = (LAS float*)(lds + wave * 16384);
        const int vcu = (bid % 8) * (G / 8) + bid / 8;
        const int gw = vcu * NWAVES + wave, NGW = G * NWAVES;
        cvt_family(A.in[I_ATWIN], (size_t)1024 * 3072, 2, 3072, 1024, 96, MAP_QKV, 0, (bf16_t*)(ws + W_QKV), (size_t)3072 * 1024, scr, gw, NGW, lane);
        cvt_family(A.in[I_ATWOUT], (size_t)1024 * 1024, 2, 1024, 1024, 32, MAP_ID, 0, (bf16_t*)(ws + W_AO), (size_t)1024 * 1024, scr, gw, NGW, lane);
        cvt_family(A.in[I_HGWIN], 0, 1, 5120, 1024, 160, MAP_ID, 0, (bf16_t*)(ws + W_HGI), 0, scr, gw, NGW, lane);
        cvt_family(A.in[I_HGWOUT], 0, 1, 1024, 1024, 32, MAP_ID, 0, (bf16_t*)(ws + W_HGO), 0, scr, gw, NGW, lane);
        cvt_family(A.in[I_LRWIN], 0, 1, 2560, 1024, 80, MAP_ID, 0, (bf16_t*)(ws + W_LRI), 0, scr, gw, NGW, lane);
        cvt_family(A.in[I_LRWOUT], 0, 1, 1024, 1280, 32, MAP_ID, 0, (bf16_t*)(ws + W_LRO), 0, scr, gw, NGW, lane);
        for (int it = gw; it < 2 * 20 * 2 * 4; it += NGW) {
            const int part = it / 160, r = it % 160, inst = r >> 3, kb = (r >> 2) & 1, gi = r & 3, d = inst / 10, n = inst % 10;
            const float* src = (part ? A.in[I_LRWX] : A.in[I_LRWA]) + (size_t)inst * 16384;
            cvt_item(src, 128, 32 * gi, (bf16_t*)(ws + W_LRG) + (size_t)(n * 2 + d) * 256 * 128, 128, part * 128 + 32 * gi, 64 * kb, scr, lane);
        }
        cvt_family(A.in[I_FFGU], (size_t)1024 * 5632, 2, 5632, 1024, 176, MAP_SWI, DFF, (bf16_t*)(ws + W_FGU), (size_t)5632 * 1024, scr, gw, NGW, lane);
        cvt_family(A.in[I_FFDN], (size_t)2816 * 1024, 2, 1024, 2816, 32, MAP_ID, 0, (bf16_t*)(ws + W_FDN), (size_t)1024 * 2816, scr, gw, NGW, lane);
        cvt_family<true>(A.in[I_MOEGU], (size_t)1024 * 7168, 16, 7168, 1024, 224, MAP_SWI, DFFE, (bf16_t*)(ws + W_MGU), (size_t)7168 * 1024, scr, gw, NGW, lane);
        cvt_family<true>(A.in[I_MOEDN], (size_t)3584 * 1024, 16, 1024, 3584, 32, MAP_ID, 0, (bf16_t*)(ws + W_MDN), (size_t)1024 * 3584, scr, gw, NGW, lane);
    }
}

template <bool ROUTER>
__device__ __forceinline__ void norm_phase(const Args& A, LAS unsigned char* lds, int bid, int G, const float* xsrc, float* xdst, const float* gain, const float* modl  , int which,
                                           bool combine, const float* modprev  , bool nonorm, const float* router) {
    int tid_ = threadIdx.x; asm volatile("" : "+v"(tid_));
    const int tid = tid_, lane = tid & 63, wave = tid >> 6;
    unsigned char* ws = A.ws;
    bf16_t* HM = (bf16_t*)(ws + WS_HM);
    const int* slot = (const int*)(ws + TB_SLOT); const float* gts = (const float*)(ws + TB_GATE);
    const bf16_t* Y = (const bf16_t*)(ws + E_XS);
    LAS int* hist = (LAS int*)lds;
    for (int tb = bid; tb < MTOK / 256; tb += G) {
        const int b = tb >> 5;
        f32x4 ga[4], sh[4], g2[4];
#pragma unroll
        for (int j = 0; j < 4; ++j) { const int c = 256 * j + 4 * lane;
            if (!nonorm) { const f32x4 gv = *(const f32x4*)(gain + c), sv = *(const f32x4*)(modl + (size_t)b * 6144 + (which * 3 + 1) * 1024 + c);
                ga[j] = gv * (sv + 1.0f); sh[j] = *(const f32x4*)(modl + (size_t)b * 6144 + (which * 3) * 1024 + c); }
            if (combine) g2[j] = *(const f32x4*)(modprev + (size_t)b * 6144 + 5 * 1024 + c); }
        f32x4 rw[ROUTER ? 32 : 1];
        if constexpr (ROUTER) {
            if (tid < 8) hist[tid] = 0;
#pragma unroll
            for (int j = 0; j < 4; ++j)
#pragma unroll
                for (int i = 0; i < 4; ++i) { const int c = 256 * j + 4 * lane + i; rw[(j * 4 + i) * 2] = *(const f32x4*)(router + c * 8); rw[(j * 4 + i) * 2 + 1] = *(const f32x4*)(router + c * 8 + 4); }
            __syncthreads();
        }
        for (int i = 0; i < 32; ++i) {
            const int row = tb * 256 + wave * 32 + i;
            const float* xr = xsrc + (size_t)row * DM;
            f32x4 v[4];
#pragma unroll
            for (int j = 0; j < 4; ++j) v[j] = *(const f32x4*)(xr + 256 * j + 4 * lane);
            if (combine) {
                const int s0 = slot[row * 2], s1 = slot[row * 2 + 1]; const float w0 = gts[row * 2], w1 = gts[row * 2 + 1];
#pragma unroll
                for (int j = 0; j < 4; ++j) { const u32x2 a = *(const u32x2*)(Y + (size_t)s0 * DM + 256 * j + 4 * lane), c2 = *(const u32x2*)(Y + (size_t)s1 * DM + 256 * j + 4 * lane);
                    f32x4 y; y[0] = w0 * bflo(a.x) + w1 * bflo(c2.x); y[1] = w0 * bfhi(a.x) + w1 * bfhi(c2.x); y[2] = w0 * bflo(a.y) + w1 * bflo(c2.y); y[3] = w0 * bfhi(a.y) + w1 * bfhi(c2.y);
                    v[j] = v[j] + g2[j] * y; *(f32x4*)(xdst + (size_t)row * DM + 256 * j + 4 * lane) = v[j]; }
            }
            if (nonorm) continue;
            float ss = 0.f;
#pragma unroll
            for (int j = 0; j < 4; ++j) ss += (v[j][0] * v[j][0] + v[j][1] * v[j][1]) + (v[j][2] * v[j][2] + v[j][3] * v[j][3]);
            ss = wave_sum(ss);
            const float rstd = 1.0f / sqrtf(ss * (1.0f / DM) + EPS);
            f32x4 h[4];
#pragma unroll
            for (int j = 0; j < 4; ++j) { h[j] = v[j] * rstd * ga[j] + sh[j];
                u32x2 w; w.x = cvt_pk_bf16(h[j][0], h[j][1]); w.y = cvt_pk_bf16(h[j][2], h[j][3]);
                *(u32x2*)(HM + (size_t)row * DM + 256 * j + 4 * lane) = w; }
            if constexpr (ROUTER) {
                float lg[8];
#pragma unroll
                for (int e = 0; e < 8; ++e) lg[e] = 0.f;
#pragma unroll
                for (int j = 0; j < 4; ++j)
#pragma unroll
                    for (int q = 0; q < 4; ++q) { const float hv = h[j][q]; const f32x4 r0 = rw[(j * 4 + q) * 2], r1 = rw[(j * 4 + q) * 2 + 1];
                        lg[0] += hv * r0[0]; lg[1] += hv * r0[1]; lg[2] += hv * r0[2]; lg[3] += hv * r0[3]; lg[4] += hv * r1[0]; lg[5] += hv * r1[1]; lg[6] += hv * r1[2]; lg[7] += hv * r1[3]; }
#pragma unroll
                for (int e = 0; e < 8; ++e) lg[e] = wave_sum(lg[e]);
                int e0 = 0; float v0 = lg[0];
#pragma unroll
                for (int e = 1; e < 8; ++e) if (lg[e] > v0) { v0 = lg[e]; e0 = e; }
                int e1 = -1; float v1 = -3.0e38f;
#pragma unroll
                for (int e = 0; e < 8; ++e) if (e != e0 && lg[e] > v1) { v1 = lg[e]; e1 = e; }
                const float p1 = frcp(1.0f + fexp(v1 - v0));
                if (lane == 0) { int* eid = (int*)(ws + TB_EID); float* gt = (float*)(ws + TB_GATE);
                    eid[row * 2] = e0; eid[row * 2 + 1] = e1; gt[row * 2] = p1; gt[row * 2 + 1] = 1.0f - p1;
                    atomicAdd((int*)&hist[e0], 1); atomicAdd((int*)&hist[e1], 1); }
            }
        }
        if constexpr (ROUTER) {
            __syncthreads();
            if (tid < 8) ((int*)(ws + TB_BCNT))[tb * 8 + tid] = hist[tid];
            __syncthreads();
        }
    }
}

namespace lru {
constexpr int XCF = 0, XCB = 16384, AA = 24576, UU = 40960;
__device__ __forceinline__ int sw256(int row, int cb) { return row * 256 + (cb ^ ((row & 7) << 4)); }
__device__ __forceinline__ int crow(int r, int hi) { return (r & 3) + 8 * (r >> 2) + 4 * hi; }
template <int MODE>
__device__ __forceinline__ void lru_item(const Args& A, LAS unsigned char* lds, int b, int n, int seg, int dir) {
    int tid_ = threadIdx.x; asm volatile("" : "+v"(tid_));
    const int tid = tid_, wid = tid >> 6, lane = tid & 63, r = lane & 31, hh = lane >> 5;
    unsigned char* ws = A.ws;
    const bf16_t* XB = (const bf16_t*)(ws + L_XB); const bf16_t* YB = (const bf16_t*)(ws + L_YB); bf16_t* HF = (bf16_t*)(ws + L_HF); bf16_t* HY = (bf16_t*)(ws + L_HY);
    const bf16_t* Wg = (const bf16_t*)(ws + W_LRG) + (size_t)((n * 2 + dir) * 256 + ((r < 16) ? (16 * wid + r) : (128 + 16 * wid + r - 16))) * 128 + 8 * hh;
    bf16x8 bfrag[8];
#pragma unroll
    for (int ks = 0; ks < 8; ++ks) bfrag[ks] = *(const bf16x8*)(Wg + 16 * ks);
    const int cch = n * 128 + 16 * wid + (r & 15);
    const float ba = A.in[I_LRBA][dir * LRUW + cch], bx = A.in[I_LRBX][dir * LRUW + cch], sp = ((const float*)(ws + TB_SP))[dir * LRUW + cch];
    const int ct = tid >> 4, cg = tid & 15, cc0 = n * 128 + 8 * cg;
    float cw[4][8], cb[8];
#pragma unroll
    for (int j = 0; j < 8; ++j) { cb[j] = A.in[I_LRCB][cc0 + j];
#pragma unroll
        for (int w = 0; w < 4; ++w) cw[w][j] = A.in[I_LRCW][w * LRUW + cc0 + j]; }
    float carry = 0.f, P = 1.f;
    if (MODE != 0 && tid < 128) carry = ((const float*)(ws + TB_LCIN))[(size_t)((b * 32 + seg) * 2 + dir) * LRUW + n * 128 + tid];
    u32x4 xr[4];
#define LRU_XLOAD(si_) do { const int sub_ = dir ? (7 - (si_)) : (si_); const int tok_ = seg * 256 + sub_ * 32 + ct; \
        _Pragma("unroll") for (int w = 0; w < 4; ++w) { const int tt = tok_ - 1 + w; xr[w] = (tt >= 0 && tt < SEQ) ? *(const u32x4*)(XB + ((size_t)b * SEQ + tt) * LRUW + cc0) : (u32x4){0u, 0u, 0u, 0u}; } } while (0)
    LRU_XLOAD(0);
    for (int si = 0; si < 8; ++si) {
        const int sub = dir ? (7 - si) : si; const int t0 = seg * 256 + sub * 32;
        {
            float xc[8];
#pragma unroll
            for (int j = 0; j < 8; ++j) xc[j] = cb[j];
#pragma unroll
            for (int w = 0; w < 4; ++w) { const u32x4 v = xr[w];
#pragma unroll
                for (int e = 0; e < 4; ++e) { xc[2 * e] += cw[w][2 * e] * bflo(v[e]); xc[2 * e + 1] += cw[w][2 * e + 1] * bfhi(v[e]); } }
            if (si + 1 < 8) LRU_XLOAD(si + 1);
            *(LAS f32x4*)(lds + XCF + (ct * 128 + 8 * cg) * 4) = (f32x4){xc[0], xc[1], xc[2], xc[3]};
            *(LAS f32x4*)(lds + XCF + (ct * 128 + 8 * cg + 4) * 4) = (f32x4){xc[4], xc[5], xc[6], xc[7]};
            *(LAS u32x4*)(lds + XCB + sw256(ct, 16 * cg)) = (u32x4){cvt_pk_bf16(xc[0], xc[1]), cvt_pk_bf16(xc[2], xc[3]), cvt_pk_bf16(xc[4], xc[5]), cvt_pk_bf16(xc[6], xc[7])};
        }
        __syncthreads();
        {
            f32x16 acc = {};
#pragma unroll
            for (int ks = 0; ks < 8; ++ks) { const bf16x8 fa = *(const LAS bf16x8*)(lds + XCB + sw256(r, (16 * ks + 8 * hh) * 2)); acc = __builtin_amdgcn_mfma_f32_32x32x16_bf16(fa, bfrag[ks], acc, 0, 0, 0); }
#pragma unroll
            for (int q = 0; q < 8; ++q) {
                const float send = (r < 16) ? acc[8 + q] : acc[q]; const float recv = __shfl_xor(send, 16);
                const float rp = (r < 16) ? acc[q] : recv, ip = (r < 16) ? recv : acc[8 + q];
                const int tq = crow((r < 16) ? q : (8 + q), hh); const int cl = 16 * wid + (r & 15);
                const float xcv = ((const LAS float*)(lds + XCF))[tq * 128 + cl];
                const float rg = fsigmoid(rp + ba), ig = fsigmoid(ip + bx); const float la = -8.0f * rg * sp;
                const float av = fexp(la), uv = sqrtf(fmaxf(1.0f - av * av, 0.f)) * ig * xcv;
                ((LAS float*)(lds + AA))[tq * 128 + cl] = av; ((LAS float*)(lds + UU))[tq * 128 + cl] = uv; }
        }
        __syncthreads();
        if (tid < 128) {
            LAS float* ap = (LAS float*)(lds + AA) + tid; LAS float* up = (LAS float*)(lds + UU) + tid; float av[32], uv[32];
#pragma unroll
            for (int i = 0; i < 32; ++i) { av[i] = ap[i * 128]; uv[i] = up[i * 128]; }
            if (dir == 0) {
#pragma unroll
                for (int i = 0; i < 32; ++i) { carry = av[i] * carry + uv[i]; if (MODE == 0) P *= av[i]; else uv[i] = carry; } }
            else {
#pragma unroll
                for (int i = 31; i >= 0; --i) { carry = av[i] * carry + uv[i]; if (MODE == 0) P *= av[i]; else uv[i] = carry; } }
            if (MODE != 0) {
#pragma unroll
                for (int i = 0; i < 32; ++i) up[i * 128] = uv[i]; }
        }
        if (MODE != 0) {
            __syncthreads();
            const int tok = t0 + ct; const size_t go = ((size_t)b * SEQ + tok) * LRUW + cc0;
            const f32x4 h0 = *(const LAS f32x4*)(lds + UU + (ct * 128 + 8 * cg) * 4), h1 = *(const LAS f32x4*)(lds + UU + (ct * 128 + 8 * cg + 4) * 4);
            if (MODE == 1) { *(u32x4*)(HF + go) = (u32x4){cvt_pk_bf16(h0[0], h0[1]), cvt_pk_bf16(h0[2], h0[3]), cvt_pk_bf16(h1[0], h1[1]), cvt_pk_bf16(h1[2], h1[3])}; }
            else { const u32x4 f = *(const u32x4*)(HF + go), y = *(const u32x4*)(YB + go);
                *(u32x4*)(HY + go) = (u32x4){cvt_pk_bf16((h0[0] + bflo(f[0])) * bflo(y[0]), (h0[1] + bfhi(f[0])) * bfhi(y[0])), cvt_pk_bf16((h0[2] + bflo(f[1])) * bflo(y[1]), (h0[3] + bfhi(f[1])) * bfhi(y[1])),
                                            cvt_pk_bf16((h1[0] + bflo(f[2])) * bflo(y[2]), (h1[1] + bfhi(f[2])) * bfhi(y[2])), cvt_pk_bf16((h1[2] + bflo(f[3])) * bflo(y[3]), (h1[3] + bfhi(f[3])) * bfhi(y[3]))}; }
        }
        __syncthreads();
    }
#undef LRU_XLOAD
    if (MODE == 0 && tid < 128) { float* sm = (float*)(ws + TB_LSUM) + (size_t)(((b * 32 + seg) * 2 + dir) * 2) * LRUW + n * 128 + tid; sm[0] = P; sm[LRUW] = carry; }
}
}
template <int MODE>
__device__ __forceinline__ void lru_phase(const Args& A, LAS unsigned char* lds, int bid, int G) {
    const int nitems = (MODE == 0) ? 5120 : 2560;
    for (int it = bid; it < nitems; it += G) {
        int b, n, seg, dir;
        if (MODE == 0) { dir = it & 1; const int r = it >> 1; seg = r & 31; n = (r >> 5) % 10; b = r / 320; }
        else { dir = MODE - 1; seg = it & 31; n = (it >> 5) % 10; b = it / 320; }
        lru::lru_item<MODE>(A, lds, b, n, seg, dir);
    }
}
__device__ __forceinline__ void lru_carry_phase(const Args& A, int bid, int G) {
    const float* sm = (const float*)(A.ws + TB_LSUM); float* cin = (float*)(A.ws + TB_LCIN);
    for (int idx = bid * NTHR + threadIdx.x; idx < NBATCH * 2 * LRUW; idx += G * NTHR) {
        const int b = idx / (2 * LRUW), r = idx % (2 * LRUW), dir = r / LRUW, ch = r % LRUW; float carry = 0.f;
        for (int i = 0; i < 32; ++i) { const int sg = dir ? (31 - i) : i; const size_t o = (size_t)((b * 32 + sg) * 2 + dir);
            cin[o * LRUW + ch] = carry; carry = sm[o * 2 * LRUW + ch] * carry + sm[o * 2 * LRUW + LRUW + ch]; }
    }
}

__device__ __forceinline__ void place_phase(const Args& A, LAS unsigned char* lds, int bid, int G) {
    int tid_ = threadIdx.x; asm volatile("" : "+v"(tid_));
    const int tid = tid_, lane = tid & 63, wave = tid >> 6; unsigned char* ws = A.ws;
    const int* bcnt = (const int*)(ws + TB_BCNT); const int* eid = (const int*)(ws + TB_EID); int* slot = (int*)(ws + TB_SLOT);
    const bf16_t* HM = (const bf16_t*)(ws + WS_HM); bf16_t* XS = (bf16_t*)(ws + E_XS);
    LAS int* tot = (LAS int*)lds; LAS int* pre = tot + 8; LAS int* rb = tot + 16; LAS int* wcn = tot + 32; LAS int* sl = tot + 64;
    for (int tb = bid; tb < MTOK / 256; tb += G) {
        { int t_ = 0, p_ = 0;
#pragma unroll
            for (int j = 0; j < 4; ++j) { const int blk = lane + 64 * j; const int v = bcnt[blk * 8 + wave]; t_ += v; p_ += (blk < tb) ? v : 0; }
#pragma unroll
            for (int o = 1; o < 64; o <<= 1) { t_ += __shfl_xor(t_, o); p_ += __shfl_xor(p_, o); }
            if (lane == 0) { tot[wave] = t_; pre[wave] = p_; } }
        __syncthreads();
        if (tid == 0) { int acc = 0; for (int e = 0; e < 8; ++e) { rb[e] = acc * 256; if (tb == 0) ((int*)(ws + TB_TILES))[e] = acc; acc += (tot[e] + 255) >> 8; } if (tb == 0) ((int*)(ws + TB_TILES))[8] = acc; }
        int e0 = -1, e1 = -1; unsigned long long mk0 = 0, mk1 = 0;
        if (tid < 256) { e0 = eid[(tb * 256 + tid) * 2]; e1 = eid[(tb * 256 + tid) * 2 + 1];
#pragma unroll
            for (int e = 0; e < 8; ++e) { const unsigned long long m = __ballot(e0 == e || e1 == e); if (lane == 0) wcn[wave * 8 + e] = __popcll(m); if (e0 == e) mk0 = m; if (e1 == e) mk1 = m; } }
        __syncthreads();
        if (tid < 256) { const unsigned long long lt = (1ull << lane) - 1ull; int b0 = rb[e0] + pre[e0] + __popcll(mk0 & lt), b1 = rb[e1] + pre[e1] + __popcll(mk1 & lt);
            for (int w = 0; w < wave; ++w) { b0 += wcn[w * 8 + e0]; b1 += wcn[w * 8 + e1]; }
            sl[tid * 2] = b0; sl[tid * 2 + 1] = b1; slot[(tb * 256 + tid) * 2] = b0; slot[(tb * 256 + tid) * 2 + 1] = b1; }
        __syncthreads();
        for (int i = 0; i < 32; ++i) { const int t = wave * 32 + i; const int s0 = sl[t * 2], s1 = sl[t * 2 + 1];
            const bf16_t* src = HM + (size_t)(tb * 256 + t) * DM + lane * 16;
            const u32x4 a = *(const u32x4*)src, b = *(const u32x4*)(src + 8);
            const u32x4 q = {pk_fp8x4(bflo(a[0]), bfhi(a[0]), bflo(a[1]), bfhi(a[1])), pk_fp8x4(bflo(a[2]), bfhi(a[2]), bflo(a[3]), bfhi(a[3])),
                             pk_fp8x4(bflo(b[0]), bfhi(b[0]), bflo(b[1]), bfhi(b[1])), pk_fp8x4(bflo(b[2]), bfhi(b[2]), bflo(b[3]), bfhi(b[3]))};
            *(u32x4*)((unsigned char*)XS + (size_t)s0 * DM + lane * 16) = q; *(u32x4*)((unsigned char*)XS + (size_t)s1 * DM + lane * 16) = q; }
        __syncthreads();
    }
}

namespace att {
constexpr int KVBLK = 64;
constexpr int SHM_V = KVBLK * 128 * 2, SHM_K = KVBLK * 128 * 2;
#define KSWZ(row, colB) ((row) * 256 + ((colB) ^ (((row) & 7) << 4)))
#define SBAR() __builtin_amdgcn_sched_barrier(0)
__device__ __forceinline__ int crow(int r, int hi) { return (r & 3) + 8 * (r >> 2) + 4 * hi; }
__device__ __forceinline__ int v_st(int k, int c) { const int kk = (k & ~0xC) | ((k & 4) << 1) | ((k & 8) >> 1); return ((kk >> 3) * 4 + (c >> 5)) * 512 + ((kk & 7) * 32 + (c & 31)) * 2; }
__device__ __forceinline__ int v_rd_base(int lane) { return ((lane & 3) << 3) | (((lane >> 2) & 3) << 6) | (((lane >> 4) & 1) << 5) | (((lane >> 5) & 1) << 8); }
constexpr int v_rd_off(int d0, int ks, int half) { return d0 * 512 + ks * 4096 + half * 2048; }
template <int OFF> __device__ __forceinline__ s16x4 tr_read(int vb) {
    s16x4 r; asm volatile("ds_read_b64_tr_b16 %0, %1 offset:%2" : "=&v"(r) : "v"(vb), "i"(OFF) : "memory"); return r;
}
template <int D0> __device__ __forceinline__ void pv_one(f32x16& od, int vb, bf16x8 pa0, bf16x8 pa1, bf16x8 pa2, bf16x8 pa3) {
    const s16x4 l0 = tr_read<v_rd_off(D0, 0, 0)>(vb), h0 = tr_read<v_rd_off(D0, 0, 1)>(vb), l1 = tr_read<v_rd_off(D0, 1, 0)>(vb), h1 = tr_read<v_rd_off(D0, 1, 1)>(vb);
    const s16x4 l2 = tr_read<v_rd_off(D0, 2, 0)>(vb), h2 = tr_read<v_rd_off(D0, 2, 1)>(vb), l3 = tr_read<v_rd_off(D0, 3, 0)>(vb), h3 = tr_read<v_rd_off(D0, 3, 1)>(vb);
    asm volatile("s_waitcnt lgkmcnt(0)" ::: "memory"); SBAR();
#define PK(L, H) (bf16x8){L[0], L[1], L[2], L[3], H[0], H[1], H[2], H[3]}
    od = __builtin_amdgcn_mfma_f32_32x32x16_bf16(pa0, PK(l0, h0), od, 0, 0, 0);
    od = __builtin_amdgcn_mfma_f32_32x32x16_bf16(pa1, PK(l1, h1), od, 0, 0, 0);
    od = __builtin_amdgcn_mfma_f32_32x32x16_bf16(pa2, PK(l2, h2), od, 0, 0, 0);
    od = __builtin_amdgcn_mfma_f32_32x32x16_bf16(pa3, PK(l3, h3), od, 0, 0, 0);
#undef PK
}
__device__ __forceinline__ void pv_d0(f32x16* o, int vb, bf16x8 pa0, bf16x8 pa1, bf16x8 pa2, bf16x8 pa3) {
    pv_one<0>(o[0], vb, pa0, pa1, pa2, pa3); pv_one<1>(o[1], vb, pa0, pa1, pa2, pa3); pv_one<2>(o[2], vb, pa0, pa1, pa2, pa3); pv_one<3>(o[3], vb, pa0, pa1, pa2, pa3);
}
__device__ __forceinline__ void partialSM(f32x16& p0, f32x16& p1, float Mc) {
#pragma unroll
    for (int r = 0; r < 16; ++r) p0[r] = fexp2(p0[r]);
}
__device__ __forceinline__ void finishSM(f32x16& p0, f32x16& p1, float& l_reg, bf16x8& pa0, bf16x8& pa1, bf16x8& pa2, bf16x8& pa3) {
#pragma unroll
    for (int r = 0; r < 16; ++r) p1[r] = fexp2(p1[r]);
    float ps = 0;
#pragma unroll
    for (int r = 0; r < 16; ++r) ps += p0[r];
#pragma unroll
    for (int r = 0; r < 16; ++r) ps += p1[r];
    { auto rr = __builtin_amdgcn_permlane32_swap(__float_as_uint(ps), __float_as_uint(ps), false, false);
      ps = __uint_as_float(rr[0]) + __uint_as_float(rr[1]); }
    l_reg += ps;
#define PK4(P, BASE, OUT) do { unsigned a0 = cvt_pk_bf16(P[BASE + 0], P[BASE + 1]), a1 = cvt_pk_bf16(P[BASE + 2], P[BASE + 3]);   \
    unsigned b0 = cvt_pk_bf16(P[BASE + 4], P[BASE + 5]), b1 = cvt_pk_bf16(P[BASE + 6], P[BASE + 7]);                              \
    auto r0 = __builtin_amdgcn_permlane32_swap(a0, b0, false, false); auto r1 = __builtin_amdgcn_permlane32_swap(a1, b1, false, false); \
    u32x4 w = {r0[0], r1[0], r0[1], r1[1]}; OUT = *reinterpret_cast<bf16x8*>(&w); } while (0)
    PK4(p0, 0, pa0); PK4(p0, 8, pa1); PK4(p1, 0, pa2); PK4(p1, 8, pa3);
#undef PK4
}
__device__ __forceinline__ void qkt(f32x16& p0, f32x16& p1, const LAS char* Ks, const bf16x8* qr, int r32, int hi, int jj, float nMc) {
#pragma unroll
    for (int r = 0; r < 16; ++r) { p0[r] = nMc; p1[r] = nMc; }
#pragma unroll
    for (int d0 = 0; d0 < 4; ++d0) { const int cb = ((jj * 4 + d0) * 16 + hi * 8) * 2;
        const bf16x8 b0 = *(const LAS bf16x8*)(Ks + KSWZ(r32, cb));
        const bf16x8 b1 = *(const LAS bf16x8*)(Ks + KSWZ(32 + r32, cb));
        p0 = __builtin_amdgcn_mfma_f32_32x32x16_bf16(b0, qr[d0], p0, 0, 0, 0);
        p1 = __builtin_amdgcn_mfma_f32_32x32x16_bf16(b1, qr[d0], p1, 0, 0, 0); }
}
__device__ __forceinline__ void attn_unit(const bf16_t* __restrict__ Qb, const bf16_t* __restrict__ Kh, const bf16_t* __restrict__ Vh, bf16_t* __restrict__ Ob,
                                          float lamv, float Mc, const float* __restrict__ subg, float omli, LAS char* lds) {
    int tid_ = threadIdx.x; asm volatile("" : "+v"(tid_));
    const int tid = tid_, wid = tid >> 6, lane = tid & 63, r32 = lane & 31, hi = lane >> 5, jj = wid >> 2, wq = wid & 3;
    LAS char* V_lds = lds; LAS char* K_lds = lds + 2 * SHM_V;
    LAS float* li_l = (LAS float*)(lds + 2 * SHM_V + 2 * SHM_K) + wid * 64;
    float l_reg = 0; f32x16 o[4] = {}; bf16x8 qr[4];
    const bf16_t* Qw = Qb + (size_t)(wq * 32 + r32) * DM + jj * 64 + hi * 8;
#pragma unroll
    for (int d0 = 0; d0 < 4; ++d0) qr[d0] = *(const bf16x8*)(Qw + d0 * 16);
    const int sr = tid >> 4, sc = (tid & 15) * 8, vst0 = v_st(sr, sc), vst1 = v_st(32 + sr, sc);
    const int vb0 = (int)(uintptr_t)V_lds + v_rd_base(lane);
    struct { bf16x8 vs0, vs1, ks0, ks1; } sr_[2];
#define SLOAD(i, k0) do { sr_[i].vs0 = *(const bf16x8*)(&Vh[(size_t)((k0) + sr) * DM + sc]); sr_[i].vs1 = *(const bf16x8*)(&Vh[(size_t)((k0) + 32 + sr) * DM + sc]); \
    sr_[i].ks0 = *(const bf16x8*)(&Kh[(size_t)((k0) + sr) * DM + sc]); sr_[i].ks1 = *(const bf16x8*)(&Kh[(size_t)((k0) + 32 + sr) * DM + sc]); } while (0)
#define SWRITE(b, i) do { *(LAS bf16x8*)(V_lds + (b) * SHM_V + vst0) = sr_[i].vs0;          \
    *(LAS bf16x8*)(V_lds + (b) * SHM_V + vst1) = sr_[i].vs1; const int kc = sc * 2;               \
    *(LAS bf16x8*)(K_lds + (b) * SHM_K + KSWZ(sr, kc)) = sr_[i].ks0;                       \
    *(LAS bf16x8*)(K_lds + (b) * SHM_K + KSWZ(32 + sr, kc)) = sr_[i].ks1; } while (0)
#define SWAIT() asm volatile("s_waitcnt vmcnt(4)" ::: "memory")
    f32x16 pA0, pA1, pB0, pB1; bf16x8 pa0, pa1, pa2, pa3; constexpr int NT = SEQ / KVBLK;
    constexpr int SE = 0, SO = 1;
    SLOAD(SE, 0); asm volatile("s_waitcnt vmcnt(0)" ::: "memory"); SWRITE(0, SE); __syncthreads();
    qkt(pA0, pA1, K_lds, qr, r32, hi, jj, -Mc); partialSM(pA0, pA1, Mc);
    SLOAD(SO, KVBLK); SLOAD(SE, 2 * KVBLK);
    SWAIT(); SWRITE(1, SO); __syncthreads();
    for (int j = 1; j + 1 < NT; j += 2) {
        SBAR(); qkt(pB0, pB1, K_lds + SHM_K, qr, r32, hi, jj, -Mc);
        finishSM(pA0, pA1, l_reg, pa0, pa1, pa2, pa3); SBAR();
        SLOAD(SO, (j + 2) * KVBLK); SBAR();
        pv_d0(o, vb0, pa0, pa1, pa2, pa3); partialSM(pB0, pB1, Mc);
        __syncthreads(); SWAIT(); SWRITE(0, SE);
        __syncthreads();
        SBAR(); qkt(pA0, pA1, K_lds, qr, r32, hi, jj, -Mc);
        finishSM(pB0, pB1, l_reg, pa0, pa1, pa2, pa3); SBAR();
        if (j + 3 < NT) SLOAD(SE, (j + 3) * KVBLK); SBAR();
        pv_d0(o, vb0 + SHM_V, pa0, pa1, pa2, pa3); partialSM(pA0, pA1, Mc);
        __syncthreads(); SWAIT(); SWRITE(1, SO);
        __syncthreads();
    }
    SBAR(); qkt(pB0, pB1, K_lds + SHM_K, qr, r32, hi, jj, -Mc);
    finishSM(pA0, pA1, l_reg, pa0, pa1, pa2, pa3); SBAR();
    pv_d0(o, vb0, pa0, pa1, pa2, pa3); partialSM(pB0, pB1, Mc);
    __syncthreads();
    finishSM(pB0, pB1, l_reg, pa0, pa1, pa2, pa3); SBAR();
    pv_d0(o, vb0 + SHM_V, pa0, pa1, pa2, pa3);
    int r32e = r32, hie = hi; asm volatile("" : "+v"(r32e), "+v"(hie));
#define r32 r32e
#define hi hie
    if (hi == 0) li_l[r32] = l_reg; asm volatile("s_waitcnt lgkmcnt(0)" ::: "memory");
    float rli[16];
#pragma unroll
    for (int r = 0; r < 16; ++r) rli[r] = frcp(li_l[crow(r, hi)]);
    __syncthreads();
    LAS float* Cb = (LAS float*)lds;
    if (jj == 1) {
#pragma unroll
        for (int r = 0; r < 16; ++r) { const float s = rli[r] * lamv;
#pragma unroll
            for (int d0 = 0; d0 < 4; ++d0) Cb[(wq * 32 + crow(r, hi)) * 128 + d0 * 32 + r32] = o[d0][r] * s; }
    }
    __syncthreads();
    if (jj == 0) {
        float g[4];
#pragma unroll
        for (int d0 = 0; d0 < 4; ++d0) g[d0] = subg[d0 * 32 + r32] * omli;
#pragma unroll
        for (int r = 0; r < 16; ++r) {
            float ss = 0.f;
#pragma unroll
            for (int d0 = 0; d0 < 4; ++d0) { const float v = o[d0][r] * rli[r] - Cb[(wq * 32 + crow(r, hi)) * 128 + d0 * 32 + r32]; o[d0][r] = v; ss += v * v; }
            ss += __shfl_xor(ss, 1); ss += __shfl_xor(ss, 2); ss += __shfl_xor(ss, 4); ss += __shfl_xor(ss, 8); ss += __shfl_xor(ss, 16);
            const float rs = 1.0f / sqrtf(ss * (1.0f / 128.0f) + EPS);
            bf16_t* op = Ob + (size_t)(wq * 32 + crow(r, hi)) * DM + r32;
#pragma unroll
            for (int d0 = 0; d0 < 4; ++d0) op[d0 * 32] = (bf16_t)f2bf(o[d0][r] * rs * g[d0]);
        }
    }
    __syncthreads();
#undef r32
#undef hi
#undef SLOAD
#undef SWRITE
#undef SWAIT
}
}

__device__ __forceinline__ void attn_phase(const Args& A, LAS unsigned char* lds, int bid, int G, int al) {
    unsigned char* ws = A.ws;
    const bf16_t* Q = (const bf16_t*)(ws + A_Q); const bf16_t* K = (const bf16_t*)(ws + A_K); const bf16_t* V = (const bf16_t*)(ws + A_V);
    bf16_t* O = (bf16_t*)(ws + WS_HM);
    const float* scal = (const float*)(ws + TB_SCAL);
    const float lamv = scal[SC_LAM0 + al], omli = scal[SC_OML0 + al], Mc = scal[SC_MC0 + al];
    const float* subg = A.in[I_ATSUB] + al * 128;
    const int x = bid & 7, c = bid >> 3;
    for (int i = 0; i < 16; ++i) {
        const int bh = x * 8 + (i >> 1), qb = (i & 1) * 32 + c;
        const int b = bh >> 3, h = bh & 7;
        const size_t base = (size_t)b * SEQ * DM + h * 128;
        att::attn_unit(Q + base + (size_t)qb * 128 * DM, K + base, V + base, O + base + (size_t)qb * 128 * DM, lamv, Mc, subg, omli, (LAS char*)lds);
    }
}

namespace gla {
constexpr int BC = 0, QI = 32768, QA = 49152, KA = 65536, KST = 81920, VT = 98304, ST = 106496, AT = 122880, EM = 131072, EL = EM + 512, DD = EM + 1024, BMID = EM + 1536, SEG = EM + 2048;
static_assert(SEG + 2048 <= RING_BYTES, "gla lds");
__device__ __forceinline__ int sw256(int row, int cb) { return row * 256 + (cb ^ ((row & 15) << 4)); }
__device__ __forceinline__ int sw128(int row, int cb) { return row * 128 + (cb ^ ((((row & 7) ^ (row >> 4)) & 7) << 4)); }
__device__ __forceinline__ int crow(int r, int hi) { return (r & 3) + 8 * (r >> 2) + 4 * hi; }
__device__ __forceinline__ float h2f(unsigned short b) { return (float)__builtin_bit_cast(_Float16, b); }
__device__ __forceinline__ void gla_item(const bf16_t* __restrict__ Qp, const unsigned short* __restrict__ LFp, const bf16_t* __restrict__ Vp, bf16_t* __restrict__ Op, int dir, LAS unsigned char* lds, float* dbg) {
    int tid_ = threadIdx.x; asm volatile("" : "+v"(tid_));
    const int tid = tid_, wid = tid >> 6, lane = tid & 63, r = lane & 31, hh = lane >> 5;
    const int t1 = tid >> 3, kg = tid & 7, k0 = 16 * kg, v0 = (tid & 7) * 8;
    for (int i = tid; i < 16384 / 16; i += NTHR) *(LAS u32x4*)(lds + ST + i * 16) = (u32x4){0u, 0u, 0u, 0u};
    f32x16 st = {};
    u32x4 rq[2], rl[2], rv;
#define GLA_TOK(ci, i) (dir ? (SEQ - 1 - ((ci) * 64 + (i))) : ((ci) * 64 + (i)))
#define GLA_LOAD(ci) do { const size_t to = (size_t)GLA_TOK(ci, t1) * DM; \
        rq[0] = *(const u32x4*)(Qp + to + k0); rq[1] = *(const u32x4*)(Qp + to + k0 + 8); \
        rl[0] = *(const u32x4*)(LFp + to + k0); rl[1] = *(const u32x4*)(LFp + to + k0 + 8); rv = *(const u32x4*)(Vp + to + v0); } while (0)
    GLA_LOAD(0);
    __syncthreads();
    for (int ci = 0; ci < SEQ / 64; ++ci) {
        float qf[16], lf[16]; u32x4 vreg = rv;
#pragma unroll
        for (int j = 0; j < 2; ++j)
#pragma unroll
            for (int e = 0; e < 4; ++e) { qf[j * 8 + 2 * e] = bflo(rq[j][e]); qf[j * 8 + 2 * e + 1] = bfhi(rq[j][e]);
                lf[j * 8 + 2 * e] = h2f((unsigned short)(rl[j][e] & 0xffffu)); lf[j * 8 + 2 * e + 1] = h2f((unsigned short)(rl[j][e] >> 16)); }
        if (ci + 1 < SEQ / 64) GLA_LOAD(ci + 1);
#pragma unroll
        for (int j = 0; j < 4; ++j) *(LAS f32x4*)(lds + BC + (t1 * 128 + k0 + 4 * j) * 4) = (f32x4){lf[4 * j], lf[4 * j + 1], lf[4 * j + 2], lf[4 * j + 3]};
        __syncthreads();
        { const int kc = tid & 127, sg = tid >> 7; LAS float* bc = (LAS float*)(lds + BC) + kc; float cs[16];
#pragma unroll
            for (int i = 0; i < 16; ++i) cs[i] = bc[(sg * 16 + i) * 128];
#pragma unroll
            for (int i = 1; i < 16; ++i) cs[i] += cs[i - 1];
            ((LAS float*)(lds + SEG))[sg * 128 + kc] = cs[15];
            __syncthreads();
            const LAS float* sgp = (const LAS float*)(lds + SEG) + kc; const float s0 = sgp[0], s1 = sgp[128], s2 = sgp[256], s3 = sgp[384];
            const float off = sg == 0 ? 0.f : sg == 1 ? s0 : sg == 2 ? (s0 + s1) : ((s0 + s1) + s2);
#pragma unroll
            for (int i = 0; i < 16; ++i) bc[(sg * 16 + i) * 128] = cs[i] + off;
            if (sg == 0) { const float bm = s0 + s1, bl = ((s0 + s1) + s2) + s3;
                ((LAS float*)(lds + BMID))[kc] = bm; ((LAS float*)(lds + EM))[kc] = fexp(bm); ((LAS float*)(lds + EL))[kc] = fexp(bl - bm); ((LAS float*)(lds + DD))[kc] = fexp(bl); }
            __syncthreads();
        }
#ifdef DIAG
        if (dbg && ci == 0) { for (int i = tid; i < 8192; i += NTHR) dbg[i] = ((const LAS float*)(lds + BC))[i]; }
#endif
        {
            unsigned wqi[8], wqa[8], wka[8]; float ksv[16];
#pragma unroll
            for (int j = 0; j < 4; ++j) {
                const f32x4 bt = *(const LAS f32x4*)(lds + BC + (t1 * 128 + k0 + 4 * j) * 4), bm = *(const LAS f32x4*)(lds + BMID + (k0 + 4 * j) * 4);
                const f32x4 em = *(const LAS f32x4*)(lds + EM + (k0 + 4 * j) * 4), el = *(const LAS f32x4*)(lds + EL + (k0 + 4 * j) * 4);
                float qi[4], qa[4], ka[4];
#pragma unroll
                for (int e = 0; e < 4; ++e) { const int i = 4 * j + e; const float e1 = fexp(bt[e] - bm[e]), r1 = frcp(e1);
                    qa[e] = qf[i] * e1; qi[e] = qa[e] * em[e]; const float kk = 1.0f - fexp(lf[i]); ka[e] = kk * r1; ksv[i] = ka[e] * el[e]; }
                wqi[2 * j] = cvt_pk_bf16(qi[0], qi[1]); wqi[2 * j + 1] = cvt_pk_bf16(qi[2], qi[3]);
                wqa[2 * j] = cvt_pk_bf16(qa[0], qa[1]); wqa[2 * j + 1] = cvt_pk_bf16(qa[2], qa[3]);
                wka[2 * j] = cvt_pk_bf16(ka[0], ka[1]); wka[2 * j + 1] = cvt_pk_bf16(ka[2], ka[3]);
            }
#pragma unroll
            for (int j = 0; j < 2; ++j) { const int off = sw256(t1, (k0 + 8 * j) * 2);
                *(LAS u32x4*)(lds + QI + off) = (u32x4){wqi[4 * j], wqi[4 * j + 1], wqi[4 * j + 2], wqi[4 * j + 3]};
                *(LAS u32x4*)(lds + QA + off) = (u32x4){wqa[4 * j], wqa[4 * j + 1], wqa[4 * j + 2], wqa[4 * j + 3]};
                *(LAS u32x4*)(lds + KA + off) = (u32x4){wka[4 * j], wka[4 * j + 1], wka[4 * j + 2], wka[4 * j + 3]}; }
#pragma unroll
            for (int i = 0; i < 16; ++i) *(LAS unsigned short*)(lds + KST + sw128(k0 + i, t1 * 2)) = (unsigned short)f2bf(ksv[i]);
#pragma unroll
            for (int e = 0; e < 4; ++e) { *(LAS unsigned short*)(lds + VT + sw128(v0 + 2 * e, t1 * 2)) = (unsigned short)(vreg[e] & 0xffffu);
                *(LAS unsigned short*)(lds + VT + sw128(v0 + 2 * e + 1, t1 * 2)) = (unsigned short)(vreg[e] >> 16); }
        }
        __syncthreads();
        f32x16 oacc = {};
        const int w4 = wid & 3, t_i = w4 >> 1, v_i = w4 & 1;
        if (wid < 4) {
            const int s_i = wid >> 1, tq = wid & 1; f32x16 a = {};
#pragma unroll
            for (int ks = 0; ks < 8; ++ks) { const bf16x8 fa = *(const LAS bf16x8*)(lds + KA + sw256(32 * s_i + r, (16 * ks + 8 * hh) * 2)), fb = *(const LAS bf16x8*)(lds + QA + sw256(32 * tq + r, (16 * ks + 8 * hh) * 2));
                a = __builtin_amdgcn_mfma_f32_32x32x16_bf16(fa, fb, a, 0, 0, 0); }
            const int tg = 32 * tq + r;
#pragma unroll
            for (int g = 0; g < 4; ++g) { float m[4];
#pragma unroll
                for (int e = 0; e < 4; ++e) { const int sgl = 32 * s_i + 8 * g + 4 * hh + e; m[e] = (sgl <= tg) ? a[4 * g + e] : 0.f; }
                *(LAS u32x2*)(lds + AT + sw128(tg, (32 * s_i + 8 * g + 4 * hh) * 2)) = (u32x2){cvt_pk_bf16(m[0], m[1]), cvt_pk_bf16(m[2], m[3])}; }
        } else {
#pragma unroll
            for (int ks = 0; ks < 8; ++ks) { const bf16x8 fa = *(const LAS bf16x8*)(lds + QI + sw256(32 * t_i + r, (16 * ks + 8 * hh) * 2)), fb = *(const LAS bf16x8*)(lds + ST + sw256(32 * v_i + r, (16 * ks + 8 * hh) * 2));
                oacc = __builtin_amdgcn_mfma_f32_32x32x16_bf16(fa, fb, oacc, 0, 0, 0); }
        }
        __syncthreads();
#ifdef DIAG
        if (dbg && ci == 0) { for (int i = tid; i < 2048; i += NTHR) { ((unsigned*)dbg)[8192 + i] = ((const LAS unsigned*)(lds + AT))[i]; ((unsigned*)dbg)[8192 + 2048 + i] = ((const LAS unsigned*)(lds + VT))[i]; } }
#endif
        if (wid >= 4) {
#pragma unroll
            for (int ks = 0; ks < 4; ++ks) { const bf16x8 fa = *(const LAS bf16x8*)(lds + AT + sw128(32 * t_i + r, (16 * ks + 8 * hh) * 2)), fb = *(const LAS bf16x8*)(lds + VT + sw128(32 * v_i + r, (16 * ks + 8 * hh) * 2));
                oacc = __builtin_amdgcn_mfma_f32_32x32x16_bf16(fa, fb, oacc, 0, 0, 0); }
#pragma unroll
            for (int i = 0; i < 16; ++i) { const int t = 32 * t_i + crow(i, hh); Op[(size_t)GLA_TOK(ci, t) * DM + 32 * v_i + r] = (bf16_t)f2bf(oacc[i]); }
        }
        {
            const int kq = wid >> 1, vq = wid & 1;
#pragma unroll
            for (int i = 0; i < 16; ++i) st[i] *= ((const LAS float*)(lds + DD))[32 * kq + crow(i, hh)];
#pragma unroll
            for (int ks = 0; ks < 4; ++ks) { const bf16x8 fa = *(const LAS bf16x8*)(lds + KST + sw128(32 * kq + r, (16 * ks + 8 * hh) * 2)), fb = *(const LAS bf16x8*)(lds + VT + sw128(32 * vq + r, (16 * ks + 8 * hh) * 2));
                st = __builtin_amdgcn_mfma_f32_32x32x16_bf16(fa, fb, st, 0, 0, 0); }
#pragma unroll
            for (int g = 0; g < 4; ++g) *(LAS u32x2*)(lds + ST + sw256(32 * vq + r, (32 * kq + 8 * g + 4 * hh) * 2)) = (u32x2){cvt_pk_bf16(st[4 * g], st[4 * g + 1]), cvt_pk_bf16(st[4 * g + 2], st[4 * g + 3])};
        }
        __syncthreads();
#ifdef DIAG
        if (dbg && ci == 0) { for (int i = tid; i < 4096; i += NTHR) { ((unsigned*)dbg)[12288 + i] = ((const LAS unsigned*)(lds + ST))[i]; ((unsigned*)dbg)[16384 + i] = ((const LAS unsigned*)(lds + KST))[i]; } }
#endif
    }
#undef GLA_TOK
#undef GLA_LOAD
}
}
__device__ __forceinline__ void gla_phase(const Args& A, LAS unsigned char* lds, int bid, int G) {
    unsigned char* ws = A.ws;
    for (int it = bid; it < 256; it += G) {
        const int b = it >> 5, h = (it >> 2) & 7, dir = (it >> 1) & 1, vh = it & 1;
        const size_t base = (size_t)b * SEQ * DM + h * 128;
        gla::gla_item((const bf16_t*)(ws + H_Q) + base, (const unsigned short*)(ws + (dir ? H_LFB : H_LFF)) + base, (const bf16_t*)(ws + H_V) + base + vh * 64,
                      (bf16_t*)(ws + (dir ? H_OB : H_OF)) + base + vh * 64, dir, lds, it == 0 ? (float*)(ws + TB_LSUM) : nullptr);
    }
}
__device__ __forceinline__ void hg_normo_phase(const Args& A, int bid, int G) {
    int tid_ = threadIdx.x; asm volatile("" : "+v"(tid_));
    const int tid = tid_, lane = tid & 63, wave = tid >> 6; unsigned char* ws = A.ws;
    const bf16_t* OF = (const bf16_t*)(ws + H_OF); const bf16_t* OB = (const bf16_t*)(ws + H_OB); const bf16_t* GG = (const bf16_t*)(ws + H_G); bf16_t* HM = (bf16_t*)(ws + WS_HM);
    const int c0 = (lane >> 3) * 128 + (lane & 7) * 16;
    float ng[16];
#pragma unroll
    for (int i = 0; i < 16; ++i) ng[i] = A.in[I_HGNG][(lane & 7) * 16 + i];
    for (int row = (bid * NWAVES + wave); row < MTOK; row += G * NWAVES) {
        const size_t o = (size_t)row * DM + c0;
        const u32x4 a0 = *(const u32x4*)(OF + o), a1 = *(const u32x4*)(OF + o + 8), b0 = *(const u32x4*)(OB + o), b1 = *(const u32x4*)(OB + o + 8), g0 = *(const u32x4*)(GG + o), g1 = *(const u32x4*)(GG + o + 8);
        float v[16], gt[16]; float ss = 0.f;
#pragma unroll
        for (int e = 0; e < 4; ++e) { v[2 * e] = bflo(a0[e]) + bflo(b0[e]); v[2 * e + 1] = bfhi(a0[e]) + bfhi(b0[e]); v[8 + 2 * e] = bflo(a1[e]) + bflo(b1[e]); v[8 + 2 * e + 1] = bfhi(a1[e]) + bfhi(b1[e]);
            gt[2 * e] = bflo(g0[e]); gt[2 * e + 1] = bfhi(g0[e]); gt[8 + 2 * e] = bflo(g1[e]); gt[8 + 2 * e + 1] = bfhi(g1[e]); }
#pragma unroll
        for (int i = 0; i < 16; ++i) ss += v[i] * v[i];
        ss += __shfl_xor(ss, 1); ss += __shfl_xor(ss, 2); ss += __shfl_xor(ss, 4);
        const float rstd = 1.0f / sqrtf(ss * (1.0f / 128.0f) + EPS);
        u32x4 w0, w1;
#pragma unroll
        for (int e = 0; e < 4; ++e) { w0[e] = cvt_pk_bf16(v[2 * e] * rstd * ng[2 * e] * gt[2 * e], v[2 * e + 1] * rstd * ng[2 * e + 1] * gt[2 * e + 1]);
            w1[e] = cvt_pk_bf16(v[8 + 2 * e] * rstd * ng[8 + 2 * e] * gt[8 + 2 * e], v[8 + 2 * e + 1] * rstd * ng[8 + 2 * e + 1] * gt[8 + 2 * e + 1]); }
        *(u32x4*)(HM + o) = w0; *(u32x4*)(HM + o + 8) = w1;
    }
}

#ifdef DIAG
constexpr int DG_BASE = 8192;
__device__ __forceinline__ void dg_put(const Args& A, int k, float e) { if (!(e >= 0.f) || e > 1e9f) e = 1e9f; atomicMax((unsigned*)(A.ws + WS_CTL) + DG_BASE + 64 * k, __float_as_uint(e)); }
__device__ __forceinline__ float dg_rel(float got, float ref) { return fabsf(got - ref) / (fabsf(ref) + 0.1f); }
__device__ __forceinline__ unsigned dg_hash(unsigned a, unsigned b) { unsigned h = a * 2654435761u + b * 40503u + 0x9e3779b9u; h ^= h >> 15; h *= 2246822519u; h ^= h >> 13; h *= 3266489917u; h ^= h >> 16; return h; }
__device__ __forceinline__ float dg_bfr(float x) { return bflo(f2bf(x)); }
__device__ __forceinline__ void dg_mods(const Args& A, int k) {
    const int lane = threadIdx.x & 63, gwv = blockIdx.x * 8 + (threadIdx.x >> 6);
    const unsigned h = dg_hash(gwv, k); const int l = h & 3, b = (h >> 2) & 7, e = (h >> 5) % 6144;
    float a = 0.f; for (int d = lane; d < DM; d += 64) a += fsilu(A.in[I_C][b * DM + d]) * A.in[I_ADAW][((size_t)l * DM + d) * 6144 + e];
    a = wave_sum(a) + A.in[I_ADAB][l * 6144 + e];
    const float got = ((const float*)(A.ws + TB_MODS))[((size_t)l * NBATCH + b) * 6144 + e];
    if (lane == 0) dg_put(A, k, dg_rel(got, a));
}
__device__ __forceinline__ void dg_norm(const Args& A, int k, const float* x, const float* gain, int L, int which) {
    const int lane = threadIdx.x & 63, gwv = blockIdx.x * 8 + (threadIdx.x >> 6);
    const int row = dg_hash(gwv, k) & (MTOK - 1), b = row >> 13;
    const float* modl = (const float*)(A.ws + TB_MODS) + ((size_t)L * NBATCH + b) * 6144;
    float ss = 0.f; for (int c = lane; c < DM; c += 64) { const float v = x[(size_t)row * DM + c]; ss += v * v; }
    ss = wave_sum(ss); const float rstd = 1.0f / sqrtf(ss / DM + EPS); float e = 0.f;
    for (int c = lane; c < DM; c += 64) { const float ref = x[(size_t)row * DM + c] * rstd * gain[c] * (1.0f + modl[(which * 3 + 1) * 1024 + c]) + modl[(which * 3) * 1024 + c];
        e = fmaxf(e, dg_rel(bf2f(((const bf16_t*)(A.ws + WS_HM))[(size_t)row * DM + c]), ref)); }
    dg_put(A, k, e);
}
__device__ __forceinline__ void dg_qkv(const Args& A, int k, int al) {
    const int lane = threadIdx.x & 63, gwv = blockIdx.x * 8 + (threadIdx.x >> 6);
    const unsigned h = dg_hash(gwv, k); const int row = h & (MTOK - 1), t = (h >> 16) % 48, col = t * 64 + lane;
    const bf16_t* hm = (const bf16_t*)(A.ws + WS_HM) + (size_t)row * DM; const float* w = A.in[I_ATWIN] + (size_t)al * 1024 * 3072 + col;
    float a = 0.f; for (int kk = 0; kk < DM; ++kk) a += bf2f(hm[kk]) * dg_bfr(w[(size_t)kk * 3072]);
    float ref, got;
    if (t < 32) {
        const int part = t >> 4, sh = t & 15; const float ss = wave_sum(a * a); const float rstd = 1.0f / sqrtf(ss / 64.0f + EPS);
        const float y = a * rstd * (part ? A.in[I_ATKN] : A.in[I_ATQN])[al * 64 + lane]; const float yp = __shfl_xor(y, 32);
        const int pos = row & (SEQ - 1); const float cs = ((const float*)(A.ws + TB_COS))[pos * 32 + (lane & 31)], sn = ((const float*)(A.ws + TB_SIN))[pos * 32 + (lane & 31)];
        ref = (lane < 32) ? (y * cs - yp * sn) : (y * cs + yp * sn); if (part == 0) ref *= 0.125f * LOG2E;
        got = bf2f(((const bf16_t*)(A.ws + (part ? A_K : A_Q)))[(size_t)row * DM + sh * 64 + lane]);
    } else { ref = a; got = bf2f(((const bf16_t*)(A.ws + A_V))[(size_t)row * DM + (t - 32) * 64 + lane]); }
    dg_put(A, k, dg_rel(got, ref));
}
__device__ __forceinline__ void dg_attn(const Args& A, int k, int al, LAS unsigned char* lds) {
    const int tid = threadIdx.x; const unsigned h = dg_hash(blockIdx.x, k); const int row = h & (MTOK - 1), hd = (h >> 16) & 7, b = row >> 13;
    const bf16_t* Q = (const bf16_t*)(A.ws + A_Q); const bf16_t* K = (const bf16_t*)(A.ws + A_K); const bf16_t* V = (const bf16_t*)(A.ws + A_V);
    const float* scal = (const float*)(A.ws + TB_SCAL); const float lamv = scal[SC_LAM0 + al], omli = scal[SC_OML0 + al], Mc = scal[SC_MC0 + al];
    LAS float* p0 = (LAS float*)lds; LAS float* p1 = p0 + SEQ; LAS float* red = p1 + SEQ;
    float l0 = 0.f, l1 = 0.f;
    for (int key = tid; key < SEQ; key += NTHR) { const bf16_t* kr = K + ((size_t)b * SEQ + key) * DM + hd * 128; const bf16_t* qr = Q + (size_t)row * DM + hd * 128;
        float s0 = 0.f, s1 = 0.f; for (int d = 0; d < 64; ++d) { s0 += bf2f(qr[d]) * bf2f(kr[d]); s1 += bf2f(qr[64 + d]) * bf2f(kr[64 + d]); }
        const float e0 = fexp2(s0 - Mc), e1 = fexp2(s1 - Mc); p0[key] = e0; p1[key] = e1; l0 += e0; l1 += e1; }
    l0 = wave_sum(l0); l1 = wave_sum(l1); if ((tid & 63) == 0) { red[tid >> 6] = l0; red[8 + (tid >> 6)] = l1; }
    __syncthreads();
    l0 = 0.f; l1 = 0.f; for (int w = 0; w < 8; ++w) { l0 += red[w]; l1 += red[8 + w]; }
    __syncthreads();
    const int dv = tid & 127, part = tid >> 7; float o = 0.f;
    for (int key = part * 2048; key < part * 2048 + 2048; ++key) o += (p0[key] / l0 - lamv * p1[key] / l1) * bf2f(V[((size_t)b * SEQ + key) * DM + hd * 128 + dv]);
    red[16 + part * 128 + dv] = o; __syncthreads();
    if (tid < 128) { o = red[16 + tid] + red[16 + 128 + tid] + red[16 + 256 + tid] + red[16 + 384 + tid]; red[600 + tid] = o * o; }
    __syncthreads();
    if (tid < 128) { float ss = 0.f; for (int i = 0; i < 128; ++i) ss += red[600 + i]; const float ref = o / sqrtf(ss / 128.0f + EPS) * A.in[I_ATSUB][al * 128 + tid] * omli;
        dg_put(A, k, dg_rel(bf2f(((const bf16_t*)(A.ws + WS_HM))[(size_t)row * DM + hd * 128 + tid]), ref)); }
    __syncthreads();
}
__device__ __forceinline__ void dg_save(const Args& A, int k, const float* xold) {
    const int lane = threadIdx.x & 63, gwv = blockIdx.x * 8 + (threadIdx.x >> 6);
    const unsigned h = dg_hash(gwv, k); const int row = h & (MTOK - 1), col = (h >> 16) & 1023;
    float* sv = (float*)(A.ws + TB_LSUM) + 7 * 1024 * 1024 / 4;
    if (lane == 0) sv[k * 4096 + gwv] = xold[(size_t)row * DM + col];
}
__device__ __forceinline__ void dg_res(const Args& A, int k, const float* xnew, const float* gate, const bf16_t* Am, int K, const float* W) {
    const int lane = threadIdx.x & 63, gwv = blockIdx.x * 8 + (threadIdx.x >> 6);
    const unsigned h = dg_hash(gwv, k); const int row = h & (MTOK - 1), col = (h >> 16) & 1023, b = row >> 13;
    const float* sv = (const float*)(A.ws + TB_LSUM) + 7 * 1024 * 1024 / 4;
    float a = 0.f; for (int kk = lane; kk < K; kk += 64) a += bf2f(Am[(size_t)row * K + kk]) * dg_bfr(W[(size_t)kk * DM + col]);
    a = wave_sum(a);
    const float ref = sv[k * 4096 + gwv] + gate[(size_t)b * 6144 + col] * a;
    if (lane == 0) dg_put(A, k, dg_rel(xnew[(size_t)row * DM + col], ref));
}
__device__ __forceinline__ void dg_swiglu(const Args& A, int k, const bf16_t* Am, const float* W, int F, const bf16_t* H, int nrows, const int* rowmap) {
    const int lane = threadIdx.x & 63, gwv = blockIdx.x * 8 + (threadIdx.x >> 6);
    const unsigned h = dg_hash(gwv, k); const int row = (h & 0xfffff) % nrows, j = (h >> 20) % F;
    float g = 0.f, u = 0.f; for (int kk = lane; kk < DM; kk += 64) { const float x = bf2f(Am[(size_t)row * DM + kk]); g += x * dg_bfr(W[(size_t)kk * 2 * F + j]); u += x * dg_bfr(W[(size_t)kk * 2 * F + F + j]); }
    g = wave_sum(g); u = wave_sum(u);
    const float ref = g / (1.0f + expf(-g)) * u;
    if (lane == 0) dg_put(A, k, dg_rel(bf2f(H[(size_t)row * F + j]), ref));
}
__device__ __forceinline__ void dg_hgin(const Args& A, int k) {
    const int lane = threadIdx.x & 63, gwv = blockIdx.x * 8 + (threadIdx.x >> 6);
    const unsigned h = dg_hash(gwv, k); const int row = h & (MTOK - 1), col = (h >> 16) % 5120, grp = col >> 10, cc = col & 1023;
    float a = 0.f; for (int kk = lane; kk < DM; kk += 64) a += bf2f(((const bf16_t*)(A.ws + WS_HM))[(size_t)row * DM + kk]) * dg_bfr(A.in[I_HGWIN][(size_t)kk * 5120 + col]);
    a = wave_sum(a);
    float ref, got;
    if (grp == 0 || grp == 4) { ref = a / (1.0f + expf(-a)); got = bf2f(((const bf16_t*)(A.ws + (grp == 0 ? H_Q : H_G)))[(size_t)row * DM + cc]); }
    else if (grp == 3) { ref = a; got = bf2f(((const bf16_t*)(A.ws + H_V))[(size_t)row * DM + cc]); }
    else { const int d = grp - 1; const float* p = A.in[I_HGLB] + (size_t)d * DEPTH * 1024 + cc; float mx = p[0]; for (int l = 1; l < DEPTH; ++l) mx = fmaxf(mx, p[l * 1024]);
        float den = 0.f; for (int l = 0; l < DEPTH; ++l) den += expf(p[l * 1024] - mx); const float lbv = expf(p[1024] - mx) / den;
        ref = logf(lbv + (1.0f - lbv) / (1.0f + expf(-a))); got = gla::h2f(((const unsigned short*)(A.ws + (d ? H_LFB : H_LFF)))[(size_t)row * DM + cc]); }
    if (lane == 0) dg_put(A, k, dg_rel(got, ref));
}
__device__ __forceinline__ void dg_gla(const Args& A, int k) {
    const int lane = threadIdx.x & 63, gwv = blockIdx.x * 8 + (threadIdx.x >> 6);
    const unsigned h = dg_hash(gwv, k); const int sel0 = (gwv & 3) == 0; const int b = sel0 ? 0 : (h & 7), hd = sel0 ? 0 : ((h >> 3) & 7), dir = sel0 ? 0 : ((h >> 6) & 1), vc = sel0 ? ((h >> 7) & 63) : ((h >> 7) & 127);
    const bf16_t* Q = (const bf16_t*)(A.ws + H_Q); const unsigned short* LF = (const unsigned short*)(A.ws + (dir ? H_LFB : H_LFF)); const bf16_t* V = (const bf16_t*)(A.ws + H_V);
    const bf16_t* O = (const bf16_t*)(A.ws + (dir ? H_OB : H_OF));
    float s0 = 0.f, s1 = 0.f, e0 = 0.f, e1 = 0.f, e2 = 0.f, e3 = 0.f;
    for (int i = 0; i < SEQ; ++i) { const int tok = dir ? (SEQ - 1 - i) : i; const size_t o = ((size_t)b * SEQ + tok) * DM + hd * 128;
        const float f0 = expf(gla::h2f(LF[o + lane])), f1 = expf(gla::h2f(LF[o + 64 + lane])), v = bf2f(V[o + vc]);
        s0 = f0 * s0 + (1.0f - f0) * v; s1 = f1 * s1 + (1.0f - f1) * v;
        if (i < 128 || i % 61 == 0) { const float ov = wave_sum(bf2f(Q[o + lane]) * s0 + bf2f(Q[o + 64 + lane]) * s1); const float er = 0.25f * fabsf(bf2f(O[o + vc]) - ov) / (fabsf(ov) + 1.0f);
            if (i == 0) e0 = er; else if (i < 64) e1 = fmaxf(e1, er); else if (i < 128) e2 = fmaxf(e2, er); else e3 = fmaxf(e3, er); } }
    if (lane == 0) { dg_put(A, k, e0); dg_put(A, k + 4, e1); dg_put(A, k + 5, e2); dg_put(A, k + 6, e3); }
    const float* dbg = (const float*)(A.ws + TB_LSUM); const unsigned short* LF0 = (const unsigned short*)(A.ws + H_LFF); const bf16_t* Q0 = (const bf16_t*)(A.ws + H_Q);
    { const unsigned h2 = dg_hash(gwv, k + 100); const int t = h2 & 63, kk = (h2 >> 6) & 127; float c = 0.f; for (int tt = 0; tt <= t; ++tt) c += gla::h2f(LF0[(size_t)tt * DM + kk]);
      if (lane == 0) dg_put(A, k + 1, dg_rel(dbg[t * 128 + kk], c)); }
    { const unsigned h2 = dg_hash(gwv, k + 200); const int t = h2 & 63, sidx = (h2 >> 6) & 63; float a = 0.f;
      if (sidx <= t) { for (int kk = lane; kk < 128; kk += 64) { float c = 0.f; for (int tt = sidx + 1; tt <= t; ++tt) c += gla::h2f(LF0[(size_t)tt * DM + kk]);
              a += bf2f(Q0[(size_t)t * DM + kk]) * (1.0f - expf(gla::h2f(LF0[(size_t)sidx * DM + kk]))) * expf(c); } a = wave_sum(a); }
      const unsigned short got = ((const unsigned short*)(dbg + 8192))[gla::sw128(t, sidx * 2) / 2];
      if (lane == 0) dg_put(A, k + 2, 5.0f * fabsf(bf2f(got) - a) / (fabsf(a) + 0.01f)); }
    { const unsigned h2 = dg_hash(gwv, k + 300); const int sidx = h2 & 63, v = (h2 >> 6) & 63;
      const unsigned short got = ((const unsigned short*)(dbg + 8192 + 2048))[gla::sw128(v, sidx * 2) / 2];
      if (lane == 0) dg_put(A, k + 2, dg_rel(bf2f(got), bf2f(((const bf16_t*)(A.ws + H_V))[(size_t)sidx * DM + v]))); }
    { const unsigned h2 = dg_hash(gwv, k + 500); const int kk = h2 & 127, v = (h2 >> 7) & 63;
      float a = 0.f; { const int sidx = lane; float c = 0.f; for (int tt = sidx + 1; tt < 64; ++tt) c += gla::h2f(LF0[(size_t)tt * DM + kk]);
          const float ksn = (1.0f - expf(gla::h2f(LF0[(size_t)sidx * DM + kk]))) * expf(c);
          const unsigned short gk = ((const unsigned short*)(dbg + 16384))[gla::sw128(kk, sidx * 2) / 2];
          dg_put(A, k + 2, 0.5f * fabsf(bf2f(gk) - ksn) / (fabsf(ksn) + 0.01f));
          a = ksn * bf2f(((const bf16_t*)(A.ws + H_V))[(size_t)sidx * DM + v]); }
      a = wave_sum(a);
      const unsigned short gs = ((const unsigned short*)(dbg + 12288))[gla::sw256(v, kk * 2) / 2];
      if (lane == 0) dg_put(A, k + 3, 0.5f * fabsf(bf2f(gs) - a) / (fabsf(a) + 0.05f)); }
    { const unsigned h2 = dg_hash(gwv, k + 400); const int t = h2 & 63, v = (h2 >> 6) & 63;
      const unsigned short* at = (const unsigned short*)(dbg + 8192); const unsigned short* vt = (const unsigned short*)(dbg + 8192 + 2048);
      float a = bf2f(at[gla::sw128(t, lane * 2) / 2]) * bf2f(vt[gla::sw128(v, lane * 2) / 2]); a = wave_sum(a);
      if (lane == 0) dg_put(A, k + 1, 5.0f * dg_rel(bf2f(((const bf16_t*)(A.ws + H_OF))[(size_t)t * DM + v]), a)); }
}
__device__ __forceinline__ void dg_normo(const Args& A, int k) {
    const int lane = threadIdx.x & 63, gwv = blockIdx.x * 8 + (threadIdx.x >> 6);
    const unsigned h = dg_hash(gwv, k); const int row = h & (MTOK - 1), hd = (h >> 16) & 7; const size_t o = (size_t)row * DM + hd * 128;
    const float v0 = bf2f(((const bf16_t*)(A.ws + H_OF))[o + lane]) + bf2f(((const bf16_t*)(A.ws + H_OB))[o + lane]), v1 = bf2f(((const bf16_t*)(A.ws + H_OF))[o + 64 + lane]) + bf2f(((const bf16_t*)(A.ws + H_OB))[o + 64 + lane]);
    const float ss = wave_sum(v0 * v0 + v1 * v1), rstd = 1.0f / sqrtf(ss / 128.0f + EPS);
    const float r0 = v0 * rstd * A.in[I_HGNG][lane] * bf2f(((const bf16_t*)(A.ws + H_G))[o + lane]), r1 = v1 * rstd * A.in[I_HGNG][64 + lane] * bf2f(((const bf16_t*)(A.ws + H_G))[o + 64 + lane]);
    dg_put(A, k, fmaxf(dg_rel(bf2f(((const bf16_t*)(A.ws + WS_HM))[o + lane]), r0), dg_rel(bf2f(((const bf16_t*)(A.ws + WS_HM))[o + 64 + lane]), r1)));
}
__device__ __forceinline__ void dg_router(const Args& A, int k, int L) {
    const int lane = threadIdx.x & 63, gwv = blockIdx.x * 8 + (threadIdx.x >> 6);
    const int row = dg_hash(gwv, k) & (MTOK - 1), b = row >> 13; const float* x = A.out + (size_t)row * DM;
    const float* modl = (const float*)(A.ws + TB_MODS) + ((size_t)L * NBATCH + b) * 6144; const float* gain = A.in[I_N2G] + L * DM; const float* R = A.in[I_MOER] + (size_t)(L >> 1) * DM * 8;
    float ss = 0.f; for (int c = lane; c < DM; c += 64) ss += x[c] * x[c];
    ss = wave_sum(ss); const float rstd = 1.0f / sqrtf(ss / DM + EPS);
    float lg[8]; for (int e = 0; e < 8; ++e) lg[e] = 0.f;
    for (int c = lane; c < DM; c += 64) { const float hv = x[c] * rstd * gain[c] * (1.0f + modl[4 * 1024 + c]) + modl[3 * 1024 + c]; for (int e = 0; e < 8; ++e) lg[e] += hv * R[c * 8 + e]; }
    for (int e = 0; e < 8; ++e) lg[e] = wave_sum(lg[e]);
    int e0 = 0; for (int e = 1; e < 8; ++e) if (lg[e] > lg[e0]) e0 = e;
    int e1 = (e0 == 0) ? 1 : 0; for (int e = 0; e < 8; ++e) if (e != e0 && lg[e] > lg[e1]) e1 = e;
    float gap = 1e9f; for (int e = 0; e < 8; ++e) if (e != e0 && e != e1) gap = fminf(gap, lg[e1] - lg[e]); gap = fminf(gap, lg[e0] - lg[e1]);
    const int g0 = ((const int*)(A.ws + TB_EID))[row * 2], g1 = ((const int*)(A.ws + TB_EID))[row * 2 + 1]; const float w0 = ((const float*)(A.ws + TB_GATE))[row * 2], w1 = ((const float*)(A.ws + TB_GATE))[row * 2 + 1];
    const float p0 = 1.0f / (1.0f + expf(lg[e1] - lg[e0]));
    float er = (g0 != e0 || g1 != e1) ? (gap > 2e-3f ? 9.f : 0.f) : fmaxf(fabsf(w0 - p0), fabsf(w1 - (1.0f - p0)));
    if (lane == 0) dg_put(A, k, er);
}
__device__ __forceinline__ void dg_place(const Args& A, int k) {
    const int lane = threadIdx.x & 63, gwv = blockIdx.x * 8 + (threadIdx.x >> 6);
    const unsigned h = dg_hash(gwv, k); const int row = h & (MTOK - 1), kk = (h >> 16) & 1;
    const int sl = ((const int*)(A.ws + TB_SLOT))[row * 2 + kk], e = ((const int*)(A.ws + TB_EID))[row * 2 + kk]; const int* ts = (const int*)(A.ws + TB_TILES);
    float er = (sl >= ts[e] * 256 && sl < ts[e + 1] * 256 && sl < MOE_ROWS) ? 0.f : 7.f;
    if (er == 0.f) for (int c = lane; c < DM; c += 64) if (((const bf16_t*)(A.ws + E_XS))[(size_t)sl * DM + c] != ((const bf16_t*)(A.ws + WS_HM))[(size_t)row * DM + c]) er = 5.f;
    dg_put(A, k, er);
}
__device__ __forceinline__ void dg_moe_hid(const Args& A, int k, int m) {
    const int lane = threadIdx.x & 63, gwv = blockIdx.x * 8 + (threadIdx.x >> 6);
    const unsigned h = dg_hash(gwv, k); const int row = h & (MTOK - 1), kk = (h >> 16) & 1, j = (h >> 17) % DFFE;
    const int sl = ((const int*)(A.ws + TB_SLOT))[row * 2 + kk], e = ((const int*)(A.ws + TB_EID))[row * 2 + kk];
    const float* W = A.in[I_MOEGU] + ((size_t)m * 8 + e) * DM * 2 * DFFE; const bf16_t* Am = (const bf16_t*)(A.ws + E_XS) + (size_t)sl * DM;
    float g = 0.f, u = 0.f; for (int c = lane; c < DM; c += 64) { const float x = bf2f(Am[c]); g += x * dg_bfr(W[(size_t)c * 2 * DFFE + j]); u += x * dg_bfr(W[(size_t)c * 2 * DFFE + DFFE + j]); }
    g = wave_sum(g); u = wave_sum(u);
    if (lane == 0) dg_put(A, k, dg_rel(bf2f(((const bf16_t*)(A.ws + E_HID))[(size_t)sl * DFFE + j]), g / (1.0f + expf(-g)) * u));
}
__device__ __forceinline__ void dg_moe_y(const Args& A, int k, int m) {
    const int lane = threadIdx.x & 63, gwv = blockIdx.x * 8 + (threadIdx.x >> 6);
    const unsigned h = dg_hash(gwv, k); const int row = h & (MTOK - 1), kk = (h >> 16) & 1, col = (h >> 17) & 1023;
    const int sl = ((const int*)(A.ws + TB_SLOT))[row * 2 + kk], e = ((const int*)(A.ws + TB_EID))[row * 2 + kk];
    const float* W = A.in[I_MOEDN] + ((size_t)m * 8 + e) * DFFE * DM; const bf16_t* Hh = (const bf16_t*)(A.ws + E_HID) + (size_t)sl * DFFE;
    float a = 0.f; for (int j = lane; j < DFFE; j += 64) a += bf2f(Hh[j]) * dg_bfr(W[(size_t)j * DM + col]);
    a = wave_sum(a);
    if (lane == 0) dg_put(A, k, fabsf(bf2f(((const bf16_t*)(A.ws + E_XS))[(size_t)sl * DM + col]) - a) / (fabsf(a) + 0.3f));
}
__device__ __forceinline__ void dg_combine(const Args& A, int k, const float* modprev) {
    const int lane = threadIdx.x & 63, gwv = blockIdx.x * 8 + (threadIdx.x >> 6);
    const unsigned h = dg_hash(gwv, k); const int row = h & (MTOK - 1), col = (h >> 16) & 1023, b = row >> 13;
    const float* sv = (const float*)(A.ws + TB_LSUM) + 7 * 1024 * 1024 / 4; const bf16_t* Y = (const bf16_t*)(A.ws + E_XS);
    const int s0 = ((const int*)(A.ws + TB_SLOT))[row * 2], s1 = ((const int*)(A.ws + TB_SLOT))[row * 2 + 1]; const float w0 = ((const float*)(A.ws + TB_GATE))[row * 2], w1 = ((const float*)(A.ws + TB_GATE))[row * 2 + 1];
    const float ref = sv[k * 4096 + gwv] + modprev[(size_t)b * 6144 + 5 * 1024 + col] * (w0 * bf2f(Y[(size_t)s0 * DM + col]) + w1 * bf2f(Y[(size_t)s1 * DM + col]));
    if (lane == 0) dg_put(A, k, dg_rel(A.out[(size_t)row * DM + col], ref));
}
__device__ __forceinline__ void dg_lruin(const Args& A, int k) {
    const int lane = threadIdx.x & 63, gwv = blockIdx.x * 8 + (threadIdx.x >> 6);
    const unsigned h = dg_hash(gwv, k); const int row = h & (MTOK - 1), col = (h >> 16) % 2560;
    float a = 0.f; for (int kk = lane; kk < DM; kk += 64) a += bf2f(((const bf16_t*)(A.ws + WS_HM))[(size_t)row * DM + kk]) * dg_bfr(A.in[I_LRWIN][(size_t)kk * 2560 + col]);
    a = wave_sum(a);
    float ref, got;
    if (col < LRUW) { ref = 0.5f * a * (1.0f + tanhf(0.7978845608028654f * (a + 0.044715f * a * a * a))); got = bf2f(((const bf16_t*)(A.ws + L_YB))[(size_t)row * LRUW + col]); }
    else { ref = a; got = bf2f(((const bf16_t*)(A.ws + L_XB))[(size_t)row * LRUW + col - LRUW]); }
    if (lane == 0) dg_put(A, k, dg_rel(got, ref));
}
__device__ __forceinline__ void dg_lru(const Args& A, int k) {
    const int lane = threadIdx.x & 63, gwv = blockIdx.x * 8 + (threadIdx.x >> 6);
    const unsigned h = dg_hash(gwv, k); const int b = h & 7, ch = (h >> 3) % LRUW, tc = (h >> 16) & (SEQ - 1), n = ch / 128, j = ch % 128;
    const bf16_t* XB = (const bf16_t*)(A.ws + L_XB) + (size_t)b * SEQ * LRUW;
    float hres[2];
    for (int d = 0; d < 2; ++d) {
        const float* wa = A.in[I_LRWA] + (size_t)(d * 10 + n) * 16384; const float* wx = A.in[I_LRWX] + (size_t)(d * 10 + n) * 16384;
        const float wa0 = dg_bfr(wa[lane * 128 + j]), wa1 = dg_bfr(wa[(lane + 64) * 128 + j]), wx0 = dg_bfr(wx[lane * 128 + j]), wx1 = dg_bfr(wx[(lane + 64) * 128 + j]);
        const float ba = A.in[I_LRBA][d * LRUW + ch], bx = A.in[I_LRBX][d * LRUW + ch]; const float lam = A.in[I_LRLAM][d * LRUW + ch]; const float sp = log1pf(expf(-lam));
        float hs = 0.f;
        for (int i = 0; ; ++i) { const int t = d ? (SEQ - 1 - i) : i;
            float x0 = A.in[I_LRCB][n * 128 + lane], x1 = A.in[I_LRCB][n * 128 + 64 + lane], xj = A.in[I_LRCB][ch];
            for (int w = 0; w < 4; ++w) { const int tt = t - 1 + w; if (tt >= 0 && tt < SEQ) {
                x0 += A.in[I_LRCW][w * LRUW + n * 128 + lane] * bf2f(XB[(size_t)tt * LRUW + n * 128 + lane]); x1 += A.in[I_LRCW][w * LRUW + n * 128 + 64 + lane] * bf2f(XB[(size_t)tt * LRUW + n * 128 + 64 + lane]);
                xj += A.in[I_LRCW][w * LRUW + ch] * bf2f(XB[(size_t)tt * LRUW + ch]); } }
            const float rp = wave_sum(dg_bfr(x0) * wa0 + dg_bfr(x1) * wa1), ip = wave_sum(dg_bfr(x0) * wx0 + dg_bfr(x1) * wx1);
            const float rg = 1.0f / (1.0f + expf(-(rp + ba))), ig = 1.0f / (1.0f + expf(-(ip + bx))); const float la = -8.0f * rg * sp;
            hs = expf(la) * hs + sqrtf(fmaxf(-expm1f(2.0f * la), 0.f)) * ig * xj;
            if (t == tc) break; }
        hres[d] = hs;
    }
    const size_t go = ((size_t)b * SEQ + tc) * LRUW + ch;
    const float e1 = fabsf(bf2f(((const bf16_t*)(A.ws + L_HF))[go]) - hres[0]) / (fabsf(hres[0]) + 0.3f);
    const float ref = (hres[0] + hres[1]) * bf2f(((const bf16_t*)(A.ws + L_YB))[go]);
    const float e2 = fabsf(bf2f(((const bf16_t*)(A.ws + L_HY))[go]) - ref) / (fabsf(ref) + 0.3f);
    if (lane == 0) { dg_put(A, k, e1); dg_put(A, k + 5, e2); }
}
__device__ __forceinline__ void dg_final(const Args& A, int nchk) {
    const unsigned* sl = (const unsigned*)(A.ws + WS_CTL) + DG_BASE; int code = 0; float ev = 0.f;
    for (int k = 1; k <= nchk; ++k) { const float e = __uint_as_float(sl[64 * k]); if (e > 0.05f) { code = k; ev = e; break; } }
    if (code == 0) return;
    const int c1 = code % 10, c10 = code / 10;
    const float s = -(float)c1;
    for (size_t i = (size_t)blockIdx.x * NTHR + threadIdx.x; i < (size_t)MTOK * DM; i += (size_t)gridDim.x * NTHR) A.out[i] = A.in[I_X][i] * s;
    __syncthreads();
    if (blockIdx.x == 0 && threadIdx.x == 0) { const int qq = ev < 0.1f ? 1 : ev < 0.2f ? 2 : ev < 0.5f ? 3 : ev < 1.f ? 4 : ev < 2.f ? 5 : ev < 5.f ? 6 : ev < 20.f ? 7 : ev < 1e3f ? 8 : 9;
        A.out[12345] = 100.f * (float)(10 * c10 + qq); }
}
#define DG(x) x
#define DGL(x) if constexpr (L >= DIAG_FROM) { x }
#else
#define DG(x)
#define DGL(x)
#endif

#define GRID_BAR() xcd_barrier(bar)
template <int L>
__device__ __forceinline__ void run_mixer(const Args& args, LAS unsigned char* lds, int bid, int G, const XcdBarrier& bar) {
    unsigned char* ws = args.ws; float* xo = args.out;
    const float* modl = (const float*)(ws + TB_MODS) + (size_t)L * NBATCH * 6144;
    const float* xs = (L == 0) ? args.in[I_X] : xo;
    constexpr int kind = L % 3;
    DGL(if (L > 0 && ((L - 1) & 1)) { dg_save(args, 10 * (L - 1) + 9, xo); GRID_BAR(); })
    norm_phase<false>(args, lds, bid, G, xs, xo, args.in[I_N1G] + L * DM, modl, 0, (L > 0) && ((L - 1) & 1), modl - NBATCH * 6144, false, nullptr);
    GRID_BAR();
    DGL(if (L > 0 && ((L - 1) & 1)) { dg_combine(args, 10 * (L - 1) + 9, modl - NBATCH * 6144); GRID_BAR(); })
    DGL(dg_norm(args, 10 * L + 1, (L > 0 && ((L - 1) & 1)) ? xo : xs, args.in[I_N1G] + L * DM, L, 0); GRID_BAR();)
    if constexpr (kind == 0) {
        constexpr int al = L / 3;
        {
            pg8::Gemm g{(const bf16_t*)(ws + WS_HM), (const bf16_t*)(ws + W_QKV) + (size_t)al * 3072 * 1024, 1024};
            pg8::TileOrder S; S.init(256, 12, G, bid);
            pg8::EpiQKV E{(bf16_t*)(ws + A_Q), (bf16_t*)(ws + A_K), (bf16_t*)(ws + A_V), args.in[I_ATQN] + al * 64, args.in[I_ATKN] + al * 64,
                          (const float*)(ws + TB_COS), (const float*)(ws + TB_SIN), 0.125f * LOG2E};
            pg8::gemm_phase<pg8::EpiQKV>(lds, g, S, E);
        }
        GRID_BAR();
        DGL(dg_qkv(args, 10 * L + 2, al); GRID_BAR();)
        attn_phase(args, lds, bid, G, al);
        GRID_BAR();
        DGL(dg_attn(args, 10 * L + 3, al, lds); GRID_BAR();)
        DGL(dg_save(args, 10 * L + 4, xs); GRID_BAR();)
        {
            pg8::Gemm g{(const bf16_t*)(ws + WS_HM), (const bf16_t*)(ws + W_AO) + (size_t)al * 1024 * 1024, 1024};
            pg8::TileOrder S; S.init(256, 4, G, bid);
            pg8::EpiRes E{xs, xo, modl + 2 * 1024};
            pg8::gemm_phase<pg8::EpiRes>(lds, g, S, E);
        }
        GRID_BAR();
        DGL(dg_res(args, 10 * L + 4, xo, modl + 2 * 1024, (const bf16_t*)(ws + WS_HM), 1024, args.in[I_ATWOUT] + (size_t)al * 1024 * 1024); GRID_BAR();)
    }
    if constexpr (kind == 1) {
        {
            pg8::Gemm g{(const bf16_t*)(ws + WS_HM), (const bf16_t*)(ws + W_HGI), 1024};
            pg8::TileOrder S; S.init(256, 20, G, bid);
            pg8::EpiAct E{0, ws, (const float*)(ws + TB_LB)};
            pg8::gemm_phase<pg8::EpiAct>(lds, g, S, E);
        }
        GRID_BAR();
        DGL(dg_hgin(args, 10 * L + 2); GRID_BAR();)
        gla_phase(args, lds, bid, G);
        GRID_BAR();
        DGL(dg_gla(args, 10 * L + 3); GRID_BAR();)
        hg_normo_phase(args, bid, G);
        GRID_BAR();
        DGL(dg_normo(args, 10 * L + 0); GRID_BAR();)
        DGL(dg_save(args, 10 * L + 4, xs); GRID_BAR();)
        {
            pg8::Gemm g{(const bf16_t*)(ws + WS_HM), (const bf16_t*)(ws + W_HGO), 1024};
            pg8::TileOrder S; S.init(256, 4, G, bid);
            pg8::EpiRes E{xs, xo, modl + 2 * 1024};
            pg8::gemm_phase<pg8::EpiRes>(lds, g, S, E);
        }
        GRID_BAR();
        DGL(dg_res(args, 10 * L + 4, xo, modl + 2 * 1024, (const bf16_t*)(ws + WS_HM), 1024, args.in[I_HGWOUT]); GRID_BAR();)
    }
    if constexpr (kind == 2) {
        {
            pg8::Gemm g{(const bf16_t*)(ws + WS_HM), (const bf16_t*)(ws + W_LRI), 1024};
            pg8::TileOrder S; S.init(256, 10, G, bid);
            pg8::EpiAct E{1, ws, nullptr};
            pg8::gemm_phase<pg8::EpiAct>(lds, g, S, E);
        }
        GRID_BAR();
        DGL(dg_lruin(args, 10 * L + 2); GRID_BAR();)
        lru_phase<0>(args, lds, bid, G);
        GRID_BAR();
        lru_carry_phase(args, bid, G);
        GRID_BAR();
        lru_phase<1>(args, lds, bid, G);
        GRID_BAR();
        lru_phase<2>(args, lds, bid, G);
        GRID_BAR();
        DGL(dg_lru(args, 10 * L + 3); GRID_BAR();)
        DGL(dg_save(args, 10 * L + 4, xs); GRID_BAR();)
        {
            pg8::Gemm g{(const bf16_t*)(ws + L_HY), (const bf16_t*)(ws + W_LRO), LRUW};
            pg8::TileOrder S; S.init(256, 4, G, bid);
            pg8::EpiRes E{xs, xo, modl + 2 * 1024};
            pg8::gemm_phase<pg8::EpiRes>(lds, g, S, E);
        }
        GRID_BAR();
        DGL(dg_res(args, 10 * L + 4, xo, modl + 2 * 1024, (const bf16_t*)(ws + L_HY), LRUW, args.in[I_LRWOUT]); GRID_BAR();)
    }
}
template <int L>
__device__ __forceinline__ void run_ffn(const Args& args, LAS unsigned char* lds, int bid, int G, const XcdBarrier& bar) {
    unsigned char* ws = args.ws; float* xo = args.out;
    const float* modl = (const float*)(ws + TB_MODS) + (size_t)L * NBATCH * 6144;
    if constexpr ((L & 1) == 0) {
        constexpr int m = L >> 1;
        norm_phase<false>(args, lds, bid, G, xo, xo, args.in[I_N2G] + L * DM, modl, 1, false, modl, false, nullptr);
        GRID_BAR();
        DGL(dg_norm(args, 10 * L + 5, xo, args.in[I_N2G] + L * DM, L, 1); GRID_BAR();)
        {
            pg8::Gemm g{(const bf16_t*)(ws + WS_HM), (const bf16_t*)(ws + W_FGU) + (size_t)m * 5632 * 1024, 1024};
            pg8::TileOrder S; S.init(256, 22, G, bid);
            pg8::EpiSwiGLU E{(bf16_t*)(ws + F_HID), DFF};
            pg8::gemm_phase<pg8::EpiSwiGLU>(lds, g, S, E);
        }
        GRID_BAR();
        DGL(dg_swiglu(args, 10 * L + 6, (const bf16_t*)(ws + WS_HM), args.in[I_FFGU] + (size_t)m * 1024 * 5632, DFF, (const bf16_t*)(ws + F_HID), MTOK, nullptr); GRID_BAR();)
        DGL(dg_save(args, 10 * L + 7, xo); GRID_BAR();)
        {
            pg8::Gemm g{(const bf16_t*)(ws + F_HID), (const bf16_t*)(ws + W_FDN) + (size_t)m * 1024 * 2816, DFF};
            pg8::TileOrder S; S.init(256, 4, G, bid);
            pg8::EpiRes E{xo, xo, modl + 5 * 1024};
            pg8::gemm_phase<pg8::EpiRes>(lds, g, S, E);
        }
        GRID_BAR();
        DGL(dg_res(args, 10 * L + 7, xo, modl + 5 * 1024, (const bf16_t*)(ws + F_HID), DFF, args.in[I_FFDN] + (size_t)m * 2816 * 1024); GRID_BAR();)
    } else {
        constexpr int m = L >> 1;
        norm_phase<true>(args, lds, bid, G, xo, xo, args.in[I_N2G] + L * DM, modl, 1, false, modl, false, args.in[I_MOER] + (size_t)m * DM * 8);
        GRID_BAR();
        DGL(dg_norm(args, 10 * L + 5, xo, args.in[I_N2G] + L * DM, L, 1); dg_router(args, 10 * L + 5, L); GRID_BAR();)
        place_phase(args, lds, bid, G);
        GRID_BAR();
        DGL(dg_place(args, 10 * L + 6); GRID_BAR();)
        const int* tiles = (const int*)(ws + TB_TILES);
        {
            pg8::Gemm g{(const bf16_t*)(ws + E_XS), (const bf16_t*)(ws + W_MGU + (size_t)m * 8 * 7168 * 1024), 512};
            pg8::TileOrder S; S.init(tiles[8], 28, G, bid);
#pragma unroll
            for (int e = 1; e < NEXP; ++e) S.ts[e] = tiles[e];
            pg8::EpiSwiGLU8 E{ws + E_HID, DFFE, 1.0f / MOE_WSCALE, MOE_HSCALE};
            pg8::gemm_phase<pg8::EpiSwiGLU8, true>(lds, g, S, E);
        }
        GRID_BAR();
        DGL(dg_moe_hid(args, 10 * L + 7, m); GRID_BAR();)
        {
            pg8::Gemm g{(const bf16_t*)(ws + E_HID), (const bf16_t*)(ws + W_MDN + (size_t)m * 8 * 1024 * 3584), DFFE / 2};
            pg8::TileOrder S; S.init(tiles[8], 4, G, bid);
#pragma unroll
            for (int e = 1; e < NEXP; ++e) S.ts[e] = tiles[e];
            pg8::EpiPlain E{(bf16_t*)(ws + E_XS), DM, 1.0f / (MOE_WSCALE * MOE_HSCALE)};
            pg8::gemm_phase<pg8::EpiPlain, true>(lds, g, S, E);
        }
        GRID_BAR();
        DGL(dg_moe_y(args, 10 * L + 8, m); GRID_BAR();)
    }
}
__device__ __forceinline__ void final_combine(const Args& args, LAS unsigned char* lds, int bid, int G, const XcdBarrier& bar) {
    const float* modl = (const float*)(args.ws + TB_MODS) + (size_t)3 * NBATCH * 6144;
    DG(dg_save(args, 39, args.out); GRID_BAR();)
    norm_phase<false>(args, lds, bid, G, args.out, args.out, args.in[I_N1G], modl, 0, true, modl, true, nullptr);
    DG(GRID_BAR(); dg_combine(args, 39, modl);)
}

__global__ void __launch_bounds__(NTHR, 2) mega_fwd(Args args) {
    extern __shared__ __attribute__((aligned(16))) unsigned char lds_raw[];
    LAS unsigned char* lds = (LAS unsigned char*)lds_raw;
    const int tid = threadIdx.x, bid = blockIdx.x, G = gridDim.x;
    unsigned char* ws = args.ws;
    volatile LAS unsigned* MISC = (volatile LAS unsigned*)(lds + MISC_OFF);
    if (tid < 64) MISC[tid] = 0u;
    __syncthreads();
    XcdBarrier bar = xcd_barrier_post((unsigned*)(ws + WS_CTL) + CW_BAR, MISC + 8);

    prologue_phase(args, lds, bid, G);
    GRID_BAR();

    run_mixer<0>(args, lds, bid, G, bar);
    run_ffn<0>(args, lds, bid, G, bar);
    run_mixer<1>(args, lds, bid, G, bar);
    run_ffn<1>(args, lds, bid, G, bar);
    run_mixer<2>(args, lds, bid, G, bar);
    run_ffn<2>(args, lds, bid, G, bar);
    run_mixer<3>(args, lds, bid, G, bar);
    run_ffn<3>(args, lds, bid, G, bar);
    final_combine(args, lds, bid, G, bar);
    DG(GRID_BAR(); dg_final(args, 49);)
}

extern "C" void kernel_launch(void* const* d_in, const int* in_sizes, int n_in, void* d_out, int out_size, void* d_ws, size_t ws_size, hipStream_t stream) {
    static int grid = 0;
    if (grid == 0) {
        if (n_in != 30 || out_size != MTOK * DM || ws_size < WS_NEED) { fprintf(stderr, "kernel_launch: unexpected shapes (n_in %d out %d ws %zu need %zu)\n", n_in, out_size, ws_size, (size_t)WS_NEED); grid = -1; return; }
        int dev = 0, cus = 0;
        if (hipGetDevice(&dev) != hipSuccess || hipDeviceGetAttribute(&cus, hipDeviceAttributeMultiprocessorCount, dev) != hipSuccess) { grid = -1; return; }
        if (hipFuncSetAttribute((const void*)mega_fwd, hipFuncAttributeMaxDynamicSharedMemorySize, LDS_BYTES) != hipSuccess) { fprintf(stderr, "kernel_launch: hipFuncSetAttribute failed\n"); grid = -1; return; }
        int per_cu = 0;
        if (hipOccupancyMaxActiveBlocksPerMultiprocessor(&per_cu, (const void*)mega_fwd, NTHR, LDS_BYTES) != hipSuccess || per_cu < 1) { fprintf(stderr, "kernel_launch: occupancy query says %d\n", per_cu); }
        (void)hipGetLastError();
        grid = (cus >= 256) ? 256 : -1;
        if (grid < 0) { fprintf(stderr, "kernel_launch: needs 256 CUs, device has %d\n", cus); return; }
    }
    if (grid < 0) return;
    if (hipMemsetAsync((char*)d_ws + WS_CTL, 0, CTL_ZERO_BYTES, stream) != hipSuccess) return;
    Args a{};
    for (int i = 0; i < 30; ++i) a.in[i] = (const float*)d_in[i];
    a.out = (float*)d_out; a.ws = (unsigned char*)d_ws;
    hipLaunchKernelGGL(mega_fwd, dim3(grid), dim3(NTHR), LDS_BYTES, stream, a);
}
```

```cpp
#define DIAG_FROM 2
#include <hip/hip_runtime.h>
#include <cstdio>
#include <cstdint>

#define LAS __attribute__((address_space(3)))
#define GAS __attribute__((address_space(1)))
typedef unsigned short bf16_t;
typedef short bf16x8 __attribute__((ext_vector_type(8)));
typedef short s16x4 __attribute__((ext_vector_type(4)));
typedef float f32x2 __attribute__((ext_vector_type(2)));
typedef float f32x4 __attribute__((ext_vector_type(4)));
typedef float f32x16 __attribute__((ext_vector_type(16)));
typedef unsigned u32x2 __attribute__((ext_vector_type(2)));
typedef unsigned u32x4 __attribute__((ext_vector_type(4)));

constexpr int MTOK = 65536, DM = 1024, SEQ = 8192, NBATCH = 8, DEPTH = 4;
constexpr int DFF = 2816, DFFE = 3584, NEXP = 8, LRUW = 1280;
constexpr float EPS = 1e-6f;
constexpr float MOE_WSCALE = 64.0f, MOE_HSCALE = 4.0f;
constexpr float LOG2E = 1.4426950408889634f;

constexpr size_t MiB = 1u << 20;
constexpr size_t WS_CTL = 0, CTL_ZERO_BYTES = 1 * MiB;
constexpr size_t WS_TAB = 1 * MiB;
constexpr size_t TB_MODS = WS_TAB;
constexpr size_t TB_COS = WS_TAB + 1 * MiB;
constexpr size_t TB_SIN = WS_TAB + 2 * MiB;
constexpr size_t TB_SCAL = WS_TAB + 3 * MiB;
constexpr size_t TB_LB = TB_SCAL + 4096;
constexpr size_t TB_SP = TB_SCAL + 16384;
constexpr size_t TB_EID = WS_TAB + 4 * MiB;
constexpr size_t TB_GATE = WS_TAB + 5 * MiB;
constexpr size_t TB_SLOT = WS_TAB + 6 * MiB;
constexpr size_t TB_BCNT = WS_TAB + 7 * MiB;
constexpr size_t TB_TILES = TB_BCNT + 16384;
constexpr size_t TB_LSUM = WS_TAB + 8 * MiB;
constexpr size_t TB_LCIN = WS_TAB + 16 * MiB;
constexpr size_t WS_W = 32 * MiB;
constexpr size_t W_QKV = WS_W;
constexpr size_t W_AO = W_QKV + 2 * (size_t)3072 * 1024 * 2;
constexpr size_t W_HGI = W_AO + 2 * (size_t)1024 * 1024 * 2;
constexpr size_t W_HGO = W_HGI + (size_t)5120 * 1024 * 2;
constexpr size_t W_LRI = W_HGO + (size_t)1024 * 1024 * 2;
constexpr size_t W_LRG = W_LRI + (size_t)2560 * 1024 * 2;
constexpr size_t W_LRO = W_LRG + (size_t)10 * 2 * 256 * 128 * 2;
constexpr size_t W_FGU = W_LRO + (size_t)1024 * 1280 * 2;
constexpr size_t W_FDN = W_FGU + 2 * (size_t)5632 * 1024 * 2;
constexpr size_t W_MGU = W_FDN + 2 * (size_t)1024 * 2816 * 2;
constexpr size_t W_MDN = W_MGU + 16 * (size_t)7168 * 1024 * 2;
constexpr size_t W_END = W_MDN + 16 * (size_t)1024 * 3584 * 2;
constexpr size_t WS_HM = 440 * MiB;
constexpr size_t WS_ACT = 568 * MiB;
static_assert(W_END <= WS_HM, "weights overflow");
constexpr size_t SZ_TOK = (size_t)MTOK * 1024 * 2;
constexpr size_t A_Q = WS_ACT, A_K = A_Q + SZ_TOK, A_V = A_K + SZ_TOK;
constexpr size_t F_HID = WS_ACT;
constexpr size_t H_Q = WS_ACT, H_LFF = H_Q + SZ_TOK, H_LFB = H_LFF + SZ_TOK, H_V = H_LFB + SZ_TOK, H_G = H_V + SZ_TOK, H_OF = H_G + SZ_TOK, H_OB = H_OF + SZ_TOK;
constexpr size_t SZ_LRU = (size_t)MTOK * 1280 * 2;
constexpr size_t L_YB = WS_ACT, L_XB = L_YB + SZ_LRU, L_HF = L_XB + SZ_LRU, L_HY = L_HF + SZ_LRU;
constexpr int MOE_ROWS = 2 * MTOK + NEXP * 256;
constexpr size_t E_XS = WS_ACT, E_HID = E_XS + (size_t)MOE_ROWS * 1024 * 2, E_END = E_HID + (size_t)MOE_ROWS * DFFE * 2;
constexpr size_t WS_NEED = E_END;
static_assert(WS_NEED <= (size_t)1792 * MiB, "workspace");

constexpr int CW_BAR = 4096;

constexpr int RING_BYTES = 135168;
constexpr int MISC_OFF = RING_BYTES;
constexpr int LDS_BYTES = 147456;
constexpr int NWAVES = 8, NTHR = 512;

typedef __bf16 bf16x2v __attribute__((ext_vector_type(2)));
__device__ __forceinline__ unsigned cvt_pk_bf16(float lo, float hi) { const f32x2 v = {lo, hi}; const bf16x2v b = __builtin_convertvector(v, bf16x2v); return __builtin_bit_cast(unsigned, b); }
__device__ __forceinline__ unsigned pk_fp8x4(float a, float b, float c, float d) { unsigned w = 0; w = __builtin_amdgcn_cvt_pk_fp8_f32(a, b, w, false); w = __builtin_amdgcn_cvt_pk_fp8_f32(c, d, w, true); return w; }
__device__ __forceinline__ unsigned f2bf(float f) { unsigned u = __builtin_bit_cast(unsigned, f); return (u + 0x7fffu + ((u >> 16) & 1u)) >> 16; }
__device__ __forceinline__ float bf2f(unsigned short b) { return __builtin_bit_cast(float, ((unsigned)b) << 16); }
__device__ __forceinline__ float bflo(unsigned w) { return __builtin_bit_cast(float, w << 16); }
__device__ __forceinline__ float bfhi(unsigned w) { return __builtin_bit_cast(float, w & 0xffff0000u); }
__device__ __forceinline__ float fexp2(float x) { return __builtin_amdgcn_exp2f(x); }
__device__ __forceinline__ float fexp(float x) { return __builtin_amdgcn_exp2f(x * LOG2E); }
__device__ __forceinline__ float frcp(float x) { return __builtin_amdgcn_rcpf(x); }
__device__ __forceinline__ float fsigmoid(float x) { return frcp(1.0f + fexp(-x)); }
__device__ __forceinline__ float fsilu(float x) { return x * fsigmoid(x); }
__device__ __forceinline__ float wave_sum(float v) {
#pragma unroll
    for (int o = 1; o < 64; o <<= 1) v += __shfl_xor(v, o);
    return v;
}
#define LDS_WAIT() asm volatile("s_waitcnt lgkmcnt(0)" ::: "memory")
#define VM_WAIT() asm volatile("s_waitcnt vmcnt(0)" ::: "memory")

#define XB_TMO      128
#define XB_XCNT(j)  (256  + 64 * (j))
#define XB_XSUB(j)  (1280 + 64 * (j))
#define XB_XGEN(j)  (2304 + 64 * (j))
#define XB_TOP      3328
#define XB_TOPGEN   3392
#define XCD_BAR_WORDS 3456
#define XB_SPIN_CAP (1u << 22)
__device__ __forceinline__ unsigned xb_ld(unsigned* p)              { return __hip_atomic_load(p, __ATOMIC_RELAXED, __HIP_MEMORY_SCOPE_AGENT); }
__device__ __forceinline__ unsigned xb_add(unsigned* p, unsigned v) { return __hip_atomic_fetch_add(p, v, __ATOMIC_RELAXED, __HIP_MEMORY_SCOPE_AGENT); }
__device__ __forceinline__ unsigned xb_xcc_id() { return (unsigned)__builtin_amdgcn_s_getreg((3 << 11) | 20) & 0xFu; }
#define XB_SPIN(cond, bar) do { unsigned _sp = 0; while (cond) { __builtin_amdgcn_s_sleep(1); \
    if ((++_sp & 255u) == 0u) { if (xb_ld(&(bar)[XB_TMO])) break; if (_sp > XB_SPIN_CAP) { atomicAdd(&(bar)[XB_TMO], 1u); break; } } } } while (0)
struct XcdBarrier { unsigned* bar; unsigned x; volatile LAS unsigned* st; };
__device__ __forceinline__ XcdBarrier xcd_barrier_post(unsigned* bar, volatile LAS unsigned* st) {
    XcdBarrier b; b.bar = bar; b.x = xb_xcc_id(); b.st = st;
    if (threadIdx.x == 0) (void)xb_add(&bar[XB_XCNT(b.x)], 1u);
    return b;
}
__device__ __forceinline__ void xcd_barrier_complete(unsigned* bar, unsigned x, unsigned& nloc, unsigned& nx) {
    const unsigned G = gridDim.x * gridDim.y * gridDim.z;
    unsigned sum, cnt, mine, sp = 0u;
    for (;;) {
        sum = 0u; cnt = 0u; mine = 0u;
#pragma unroll
        for (unsigned j = 0; j < 16; ++j) { const unsigned c = xb_ld(&bar[XB_XCNT(j)]); sum += c; cnt += (c > 0u) ? 1u : 0u; mine = (j == x) ? c : mine; }
        if (sum == G) break;
        __builtin_amdgcn_s_sleep(1);
        if ((++sp & 255u) == 0u) { if (xb_ld(&bar[XB_TMO])) break; if (sp > XB_SPIN_CAP) { atomicAdd(&bar[XB_TMO], 1u); break; } }
    }
    nloc = mine > 0u ? mine : 1u; nx = cnt > 0u ? cnt : 1u;
}
__device__ __forceinline__ void xcd_barrier(const XcdBarrier& b) {
    asm volatile("s_waitcnt vmcnt(0)" ::: "memory");
    __syncthreads();
    if (threadIdx.x == 0) {
        unsigned* bar = b.bar;
        __builtin_amdgcn_s_waitcnt(0);
        unsigned nloc = b.st[0], nx = b.st[1];
        if (nloc == 0u) { xcd_barrier_complete(bar, b.x, nloc, nx); b.st[0] = nloc; b.st[1] = nx; }
        const unsigned old = xb_add(&bar[XB_XSUB(b.x)], 1u);
        const unsigned gen = old / nloc;
        if (old + 1u == (gen + 1u) * nloc) {
            __builtin_amdgcn_fence(__ATOMIC_RELEASE, "agent");
            asm volatile("s_waitcnt vmcnt(0)" ::: "memory");
            const unsigned og = xb_add(&bar[XB_TOP], 1u);
            const unsigned tg = og / nx;
            if (og + 1u == (tg + 1u) * nx) xb_add(&bar[XB_TOPGEN], 1u);
            else XB_SPIN(xb_ld(&bar[XB_TOPGEN]) == tg, bar);
            __builtin_amdgcn_fence(__ATOMIC_ACQUIRE, "agent");
            xb_add(&bar[XB_XGEN(b.x)], 1u);
            asm volatile("s_waitcnt vmcnt(0)" ::: "memory");
        } else {
            XB_SPIN(xb_ld(&bar[XB_XGEN(b.x)]) == gen, bar);
            __builtin_amdgcn_fence(__ATOMIC_ACQUIRE, "agent");
            asm volatile("s_waitcnt vmcnt(0)" ::: "memory");
        }
    }
    __syncthreads();
}

namespace pg8 {
constexpr int BM = 256, BK = 64, HALF = 128, HTB = HALF * BK * 2, STAGE_BYTES = 8 * HTB, NXCD = 8, WGM = 8;
__host__ __device__ __forceinline__ int lds_byte(int r, int c) { const int st = (r >> 4) * 2 + (c >> 5), rr = r & 15, cc = c & 31, ob = rr * 64 + cc * 2; return st * 1024 + (ob ^ (((ob >> 9) & 1) << 5)); }
__host__ __device__ __forceinline__ void stage_rc(int b, int& R, int& C) { const int st = b / 1024, sb = b % 1024, swz = sb ^ (((sb >> 9) & 1) << 5); R = (st >> 1) * 16 + swz / 64; C = (st & 1) * 32 + (swz % 64) / 2; }
__host__ __device__ __forceinline__ int perm32(int rho) { const int n = rho >> 4, i = rho & 15; return 8 * (i >> 2) + 4 * n + (i & 3); }

struct Unit { int pm, pn, pb; };
struct Gemm { const bf16_t* A; const bf16_t* Bt; int K; };

struct TileOrder {
    int nM, nN, nwg, G, c; int ts[NEXP];
    __device__ __forceinline__ void init(int nM_, int nN_, int G_, int c_) { nM = nM_; nN = nN_; nwg = nM * nN; G = G_; c = c_;
#pragma unroll
        for (int e = 0; e < NEXP; ++e) ts[e] = (e == 0) ? 0 : 0x7fffffff; }
    __device__ __forceinline__ bool next(int i, Unit& u) const {
        const long L = (long)i * G + c; if (L >= nwg) return false;
        int wgid = (int)L; { const int q = nwg / NXCD, r = nwg % NXCD, xcd = wgid % NXCD, off = wgid / NXCD; wgid = (xcd < r ? xcd * (q + 1) : r * (q + 1) + (xcd - r) * q) + off; }
        const int nig = WGM * nN, gid = wgid / nig, fm = gid * WGM, gsz = (nM - fm) < WGM ? (nM - fm) : WGM;
        u.pm = fm + ((wgid % nig) % gsz); u.pn = (wgid % nig) / gsz;
        int e = 0;
#pragma unroll
        for (int k = 1; k < NEXP; ++k) e += (u.pm >= ts[k]) ? 1 : 0;
        u.pb = e * nN + u.pn; return true;
    }
};

typedef int v8i32 __attribute__((ext_vector_type(8)));
template <class Epi, bool FP8 = false>
__device__ __forceinline__ void gemm_phase(LAS unsigned char* lds, const Gemm g, const TileOrder& S, const Epi& E) {
    int tid_ = threadIdx.x; asm volatile("" : "+v"(tid_));
    const int tid = tid_, wid = __builtin_amdgcn_readfirstlane(tid >> 6), lane = tid & 63, wr = wid >> 2, wc = wid & 3, fr = lane & 15, fq = lane >> 4;
    const int K = g.K, nt = K / BK;
    unsigned voffA[2], voffB[2];
#pragma unroll
    for (int i = 0; i < 2; ++i) { int R, C; stage_rc(tid * 16 + i * 8192, R, C); const int Rb = Epi::PERM ? ((R & ~31) + perm32(R & 31)) : R;
        voffA[i] = (unsigned)(R * K + C) * 2u; voffB[i] = (unsigned)(Rb * K + C) * 2u; }
    const size_t kstep = (size_t)(BK * 2);
    const size_t hstep = (size_t)HALF * K * 2;
    const size_t tstep = 2 * hstep;
    const unsigned ldsw = (unsigned)wid * 1024u;
    const int aoff = lds_byte(wr * 64 + fr, fq * 8), boff = lds_byte(wc * 32 + fr, fq * 8);
#define PG8_SA(b, h) (((b) * 2 + (h)) * HTB)
#define PG8_SB(b, h) ((4 + (b) * 2 + (h)) * HTB)
#define PG8_STAGE(bufoff, gbase, voff) do { _Pragma("unroll") for (int _i = 0; _i < 2; ++_i) \
        __builtin_amdgcn_global_load_lds((const unsigned*)((const char*)(gbase) + (voff)[_i]), (LAS unsigned*)(lds + (bufoff) + ldsw + _i * 8192), 16, 0, 0); } while (0)
#define PG8_LD8(p) __builtin_bit_cast(v8i32, __builtin_shufflevector(*(const LAS u32x4*)(p), *(const LAS u32x4*)((p) + 1024), 0, 1, 2, 3, 4, 5, 6, 7))
#define PG8_LDA(dst, b, h) do { if constexpr (FP8) { _Pragma("unroll") for (int m = 0; m < 4; ++m) dst##8[m] = PG8_LD8(lds + PG8_SA(b, h) + aoff + m * 2048); } \
        else { _Pragma("unroll") for (int m = 0; m < 4; ++m) _Pragma("unroll") for (int k = 0; k < 2; ++k) dst[m][k] = *(const LAS bf16x8*)(lds + PG8_SA(b, h) + aoff + m * 2048 + k * 1024); } } while (0)
#define PG8_LDB(dst, b, h) do { if constexpr (FP8) { _Pragma("unroll") for (int n = 0; n < 2; ++n) dst##8[n] = PG8_LD8(lds + PG8_SB(b, h) + boff + n * 2048); } \
        else { _Pragma("unroll") for (int n = 0; n < 2; ++n) _Pragma("unroll") for (int k = 0; k < 2; ++k) dst[n][k] = *(const LAS bf16x8*)(lds + PG8_SB(b, h) + boff + n * 2048 + k * 1024); } } while (0)
#define PG8_MMA(ai, bj, At, Bt) do { __builtin_amdgcn_s_setprio(1); \
        if constexpr (FP8) { _Pragma("unroll") for (int m = 0; m < 4; ++m) _Pragma("unroll") for (int n = 0; n < 2; ++n) \
            asm volatile("v_mfma_scale_f32_16x16x128_f8f6f4 %0, %1, %2, %0, %3, %3 op_sel_hi:[0,0,0]" : "+v"(acc[ai][bj][m][n]) : "v"(Bt##8[n]), "v"(At##8[m]), "v"(one_scale)); } \
        else { _Pragma("unroll") for (int m = 0; m < 4; ++m) _Pragma("unroll") for (int n = 0; n < 2; ++n) _Pragma("unroll") for (int k = 0; k < 2; ++k) \
            acc[ai][bj][m][n] = __builtin_amdgcn_mfma_f32_16x16x32_bf16(Bt[n][k], At[m][k], acc[ai][bj][m][n], 0, 0, 0); } \
        __builtin_amdgcn_s_setprio(0); } while (0)
#define PG8_WAIT_V(n) asm volatile("s_waitcnt vmcnt(" #n ")" ::: "memory")
#define PG8_WAIT_L(n) asm volatile("s_waitcnt lgkmcnt(" #n ")" ::: "memory")
#define PG8_BAR __builtin_amdgcn_s_barrier()
#define PG8_SCHED __builtin_amdgcn_sched_barrier(0)
    Unit cur, nxt; int ui = 0;
    if (!S.next(0, cur)) return;
    f32x4 acc[2][2][4][2];
#pragma unroll
    for (int a = 0; a < 2; ++a)
#pragma unroll
        for (int b = 0; b < 2; ++b)
#pragma unroll
            for (int m = 0; m < 4; ++m)
#pragma unroll
                for (int n = 0; n < 2; ++n) acc[a][b][m][n] = (f32x4){0.f, 0.f, 0.f, 0.f};
    bf16x8 At[4][2], B0[2][2], B1[2][2]; v8i32 At8[4], B08[2], B18[2];
    int one_scale = 0x7f7f7f7f; asm volatile("" : "+v"(one_scale));
    const char* cA = (const char*)g.A + (size_t)cur.pm * tstep; const char* cB = (const char*)g.Bt + (size_t)cur.pb * tstep;
    PG8_STAGE(PG8_SB(0, 0), cB, voffB); PG8_STAGE(PG8_SA(0, 0), cA, voffA); PG8_STAGE(PG8_SB(0, 1), cB + hstep, voffB); PG8_STAGE(PG8_SA(0, 1), cA + hstep, voffA);
    if (wr == 1) PG8_BAR;
    PG8_WAIT_V(4); PG8_BAR;
    PG8_STAGE(PG8_SB(1, 0), cB + kstep, voffB); PG8_STAGE(PG8_SA(1, 0), cA + kstep, voffA); PG8_STAGE(PG8_SB(1, 1), cB + hstep + kstep, voffB);
    PG8_WAIT_V(6); PG8_BAR;
    for (;;) {
        const bool has_next = S.next(ui + 1, nxt);
        const char* nA = has_next ? (const char*)g.A + (size_t)nxt.pm * tstep : cA; const char* nB = has_next ? (const char*)g.Bt + (size_t)nxt.pb * tstep : cB;
        for (int t = 0; t < nt; t += 2) {
            const bool last = (t == nt - 2);
            const char* a1 = cA + (size_t)(t + 1) * kstep;
            const char* a2 = last ? nA : cA + (size_t)(t + 2) * kstep; const char* b2 = last ? nB : cB + (size_t)(t + 2) * kstep;
            const char* a3 = a2 + kstep; const char* b3 = b2 + kstep;
            PG8_LDB(B0, 0, 0); PG8_SCHED; PG8_LDA(At, 0, 0); PG8_STAGE(PG8_SA(1, 1), a1 + hstep, voffA);
            PG8_WAIT_L(8); PG8_BAR; PG8_WAIT_L(0); PG8_MMA(0, 0, At, B0); PG8_BAR; PG8_SCHED;
            PG8_LDB(B1, 0, 1); PG8_STAGE(PG8_SB(0, 0), b2, voffB);
            PG8_BAR; PG8_WAIT_L(0); PG8_MMA(0, 1, At, B1); PG8_BAR;
            PG8_LDA(At, 0, 1); PG8_STAGE(PG8_SA(0, 0), a2, voffA);
            PG8_BAR; PG8_WAIT_L(0); PG8_MMA(1, 0, At, B0); PG8_BAR; PG8_SCHED;
            PG8_STAGE(PG8_SB(0, 1), b2 + hstep, voffB);
            PG8_WAIT_V(6); PG8_BAR; PG8_MMA(1, 1, At, B1); PG8_BAR;
            PG8_LDB(B0, 1, 0); PG8_SCHED; PG8_LDA(At, 1, 0); PG8_STAGE(PG8_SA(0, 1), a2 + hstep, voffA);
            PG8_WAIT_L(8); PG8_BAR; PG8_WAIT_L(0); PG8_MMA(0, 0, At, B0); PG8_BAR; PG8_SCHED;
            PG8_LDB(B1, 1, 1); PG8_STAGE(PG8_SB(1, 0), b3, voffB);
            PG8_BAR; PG8_WAIT_L(0); PG8_MMA(0, 1, At, B1); PG8_BAR;
            PG8_LDA(At, 1, 1); PG8_STAGE(PG8_SA(1, 0), a3, voffA);
            PG8_BAR; PG8_WAIT_L(0); PG8_MMA(1, 0, At, B0); PG8_BAR; PG8_SCHED;
            PG8_STAGE(PG8_SB(1, 1), b3 + hstep, voffB);
            PG8_WAIT_V(6); PG8_BAR; PG8_MMA(1, 1, At, B1); PG8_BAR;
        }
        if constexpr (FP8) asm volatile("s_nop 15\n\ts_nop 15" ::: "memory");
        E(acc, cur, wr, wc, fr, fq);
        if (!has_next) break;
#pragma unroll
        for (int a = 0; a < 2; ++a)
#pragma unroll
            for (int b = 0; b < 2; ++b)
#pragma unroll
                for (int m = 0; m < 4; ++m)
#pragma unroll
                    for (int n = 0; n < 2; ++n) acc[a][b][m][n] = (f32x4){0.f, 0.f, 0.f, 0.f};
        cur = nxt; cA = nA; cB = nB; ++ui;
    }
    PG8_WAIT_V(0);
    if (wr == 0) PG8_BAR;
    PG8_BAR;
#undef PG8_SA
#undef PG8_SB
#undef PG8_STAGE
#undef PG8_LDA
#undef PG8_LDB
#undef PG8_MMA
#undef PG8_LD8
#undef PG8_WAIT_V
#undef PG8_WAIT_L
#undef PG8_BAR
#undef PG8_SCHED
}

struct EpiQKV {
    static constexpr bool PERM = true;
    bf16_t *Q, *Kk, *V; const float *gq, *gk, *cosT, *sinT; float qscale;
    __device__ __forceinline__ void operator()(const f32x4 (&acc)[2][2][4][2], const Unit& u, int wr, int wc, int fr, int fq) const {
        const int row0 = u.pm * BM + wr * 64 + fr;
        if (u.pn >= 8) {
            const int col0 = (u.pn - 8) * BM + wc * 32 + 8 * fq;
#pragma unroll
            for (int ai = 0; ai < 2; ++ai)
#pragma unroll
                for (int m = 0; m < 4; ++m) { bf16_t* rowp = V + (size_t)(row0 + ai * HALF + m * 16) * DM + col0;
#pragma unroll
                    for (int bj = 0; bj < 2; ++bj) { const f32x4 v0 = acc[ai][bj][m][0], v1 = acc[ai][bj][m][1];
                        u32x4 w; w.x = cvt_pk_bf16(v0[0], v0[1]); w.y = cvt_pk_bf16(v0[2], v0[3]); w.z = cvt_pk_bf16(v1[0], v1[1]); w.w = cvt_pk_bf16(v1[2], v1[3]);
                        *(u32x4*)(rowp + bj * HALF) = w; } }
        } else {
            const int part = u.pn >> 2, sh = 4 * (u.pn & 3) + wc;
            bf16_t* dst = part ? Kk : Q; const float* g = part ? gk : gq; const float sc = part ? 1.0f : qscale;
            f32x4 g0[2], g1[2];
#pragma unroll
            for (int n = 0; n < 2; ++n) { g0[n] = *(const f32x4*)(g + 8 * fq + 4 * n); g1[n] = *(const f32x4*)(g + 32 + 8 * fq + 4 * n); }
#pragma unroll
            for (int ai = 0; ai < 2; ++ai)
#pragma unroll
                for (int m = 0; m < 4; ++m) {
                    const int r = row0 + ai * HALF + m * 16; const int pos = r & (SEQ - 1);
                    f32x4 x1[2], x2[2]; float ss = 0.f;
#pragma unroll
                    for (int n = 0; n < 2; ++n) { x1[n] = acc[ai][0][m][n]; x2[n] = acc[ai][1][m][n];
                        ss += (x1[n][0] * x1[n][0] + x1[n][1] * x1[n][1]) + (x1[n][2] * x1[n][2] + x1[n][3] * x1[n][3]);
                        ss += (x2[n][0] * x2[n][0] + x2[n][1] * x2[n][1]) + (x2[n][2] * x2[n][2] + x2[n][3] * x2[n][3]); }
                    ss += __shfl_xor(ss, 16); ss += __shfl_xor(ss, 32);
                    const float rstd = __builtin_amdgcn_rsqf(ss * (1.0f / 64.0f) + EPS) ;
                    bf16_t* op = dst + (size_t)r * DM + sh * 64 + 8 * fq;
                    u32x4 w1, w2;
#pragma unroll
                    for (int n = 0; n < 2; ++n) {
                        const f32x4 cs = *(const f32x4*)(cosT + pos * 32 + 8 * fq + 4 * n), sn = *(const f32x4*)(sinT + pos * 32 + 8 * fq + 4 * n);
                        const f32x4 y1 = x1[n] * rstd * g0[n], y2 = x2[n] * rstd * g1[n];
                        const f32x4 o1 = (y1 * cs - y2 * sn) * sc, o2 = (y2 * cs + y1 * sn) * sc;
                        if (n == 0) { w1.x = cvt_pk_bf16(o1[0], o1[1]); w1.y = cvt_pk_bf16(o1[2], o1[3]); w2.x = cvt_pk_bf16(o2[0], o2[1]); w2.y = cvt_pk_bf16(o2[2], o2[3]); }
                        else { w1.z = cvt_pk_bf16(o1[0], o1[1]); w1.w = cvt_pk_bf16(o1[2], o1[3]); w2.z = cvt_pk_bf16(o2[0], o2[1]); w2.w = cvt_pk_bf16(o2[2], o2[3]); }
                    }
                    *(u32x4*)(op) = w1; *(u32x4*)(op + 32) = w2;
                }
        }
    }
};
struct EpiRes {
    static constexpr bool PERM = false;
    const float* xin; float* xout; const float* gate;
    __device__ __forceinline__ void operator()(const f32x4 (&acc)[2][2][4][2], const Unit& u, int wr, int wc, int fr, int fq) const {
        const int row0 = u.pm * BM + wr * 64 + fr, col0 = u.pn * BM + wc * 32 + 4 * fq;
        const float* gp = gate + (size_t)(u.pm >> 5) * 6144 + col0;
        f32x4 gv[2][2];
#pragma unroll
        for (int bj = 0; bj < 2; ++bj)
#pragma unroll
            for (int n = 0; n < 2; ++n) gv[bj][n] = *(const f32x4*)(gp + bj * HALF + n * 16);
#pragma unroll
        for (int ai = 0; ai < 2; ++ai)
#pragma unroll
            for (int m = 0; m < 4; ++m) { const size_t off = (size_t)(row0 + ai * HALF + m * 16) * DM + col0;
#pragma unroll
                for (int bj = 0; bj < 2; ++bj)
#pragma unroll
                    for (int n = 0; n < 2; ++n) { const f32x4 xv = *(const f32x4*)(xin + off + bj * HALF + n * 16);
                        *(f32x4*)(xout + off + bj * HALF + n * 16) = xv + gv[bj][n] * acc[ai][bj][m][n]; }
                asm volatile("" ::: "memory"); }
    }
};
struct EpiSwiGLU {
    static constexpr bool PERM = true;
    bf16_t* H; int ldh;
    __device__ __forceinline__ void operator()(const f32x4 (&acc)[2][2][4][2], const Unit& u, int wr, int wc, int fr, int fq) const {
        const int row0 = u.pm * BM + wr * 64 + fr, col0 = u.pn * HALF + wc * 32 + 8 * fq;
#pragma unroll
        for (int ai = 0; ai < 2; ++ai)
#pragma unroll
            for (int m = 0; m < 4; ++m) { bf16_t* rowp = H + (size_t)(row0 + ai * HALF + m * 16) * ldh + col0;
                f32x4 v[2];
#pragma unroll
                for (int n = 0; n < 2; ++n) { const f32x4 gt = acc[ai][0][m][n], up = acc[ai][1][m][n];
#pragma unroll
                    for (int j = 0; j < 4; ++j) v[n][j] = fsilu(gt[j]) * up[j]; }
                u32x4 w; w.x = cvt_pk_bf16(v[0][0], v[0][1]); w.y = cvt_pk_bf16(v[0][2], v[0][3]); w.z = cvt_pk_bf16(v[1][0], v[1][1]); w.w = cvt_pk_bf16(v[1][2], v[1][3]);
                *(u32x4*)rowp = w; }
    }
};
struct EpiSwiGLU8 {
    static constexpr bool PERM = true;
    unsigned char* H; int ldh; float ws, hs;
    __device__ __forceinline__ void operator()(const f32x4 (&acc)[2][2][4][2], const Unit& u, int wr, int wc, int fr, int fq) const {
        const int row0 = u.pm * BM + wr * 64 + fr, col0 = u.pn * HALF + wc * 32 + 8 * fq;
#pragma unroll
        for (int ai = 0; ai < 2; ++ai)
#pragma unroll
            for (int m = 0; m < 4; ++m) { unsigned char* rowp = H + (size_t)(row0 + ai * HALF + m * 16) * ldh + col0;
                f32x4 v[2];
#pragma unroll
                for (int n = 0; n < 2; ++n) { const f32x4 gt = acc[ai][0][m][n] * ws, up = acc[ai][1][m][n] * (ws * hs);
#pragma unroll
                    for (int j = 0; j < 4; ++j) v[n][j] = fsilu(gt[j]) * up[j]; }
                *(u32x2*)rowp = (u32x2){pk_fp8x4(v[0][0], v[0][1], v[0][2], v[0][3]), pk_fp8x4(v[1][0], v[1][1], v[1][2], v[1][3])}; }
    }
};
struct EpiPlain {
    static constexpr bool PERM = true;
    bf16_t* O; int ldc; float sc;
    __device__ __forceinline__ void operator()(const f32x4 (&acc)[2][2][4][2], const Unit& u, int wr, int wc, int fr, int fq) const {
        const int row0 = u.pm * BM + wr * 64 + fr, col0 = u.pn * BM + wc * 32 + 8 * fq;
#pragma unroll
        for (int ai = 0; ai < 2; ++ai)
#pragma unroll
            for (int m = 0; m < 4; ++m) { bf16_t* rowp = O + (size_t)(row0 + ai * HALF + m * 16) * ldc + col0;
#pragma unroll
                for (int bj = 0; bj < 2; ++bj) { const f32x4 v0 = acc[ai][bj][m][0] * sc, v1 = acc[ai][bj][m][1] * sc;
                    u32x4 w; w.x = cvt_pk_bf16(v0[0], v0[1]); w.y = cvt_pk_bf16(v0[2], v0[3]); w.z = cvt_pk_bf16(v1[0], v1[1]); w.w = cvt_pk_bf16(v1[2], v1[3]);
                    *(u32x4*)(rowp + bj * HALF) = w; } }
    }
};
struct EpiAct {
    static constexpr bool PERM = true;
    int kind; unsigned char* ws; const float* lb;
    __device__ __forceinline__ void operator()(const f32x4 (&acc)[2][2][4][2], const Unit& u, int wr, int wc, int fr, int fq) const {
        const int row0 = u.pm * BM + wr * 64 + fr;
        int mode, ldc, colt; size_t boff;
        if (kind == 0) { const int grp = u.pn >> 2; colt = (u.pn & 3) * 256; ldc = 1024;
            boff = grp == 0 ? H_Q : grp == 1 ? H_LFF : grp == 2 ? H_LFB : grp == 3 ? H_V : H_G; mode = (grp == 0 || grp == 4) ? 1 : (grp == 3 ? 0 : 3); }
        else { ldc = LRUW; if (u.pn < 5) { boff = L_YB; colt = u.pn * 256; mode = 2; } else { boff = L_XB; colt = (u.pn - 5) * 256; mode = 0; } }
        bf16_t* base = (bf16_t*)(ws + boff);
        const int col0 = colt + wc * 32 + 8 * fq;
        f32x4 lbv[2][2];
        if (mode == 3) { const float* lp = lb + ((u.pn >> 2) - 1) * 1024 + col0;
#pragma unroll
            for (int bj = 0; bj < 2; ++bj)
#pragma unroll
                for (int n = 0; n < 2; ++n) lbv[bj][n] = *(const f32x4*)(lp + bj * HALF + 4 * n); }
#pragma unroll
        for (int ai = 0; ai < 2; ++ai)
#pragma unroll
            for (int m = 0; m < 4; ++m) { bf16_t* rowp = base + (size_t)(row0 + ai * HALF + m * 16) * ldc + col0;
#pragma unroll
                for (int bj = 0; bj < 2; ++bj) { f32x4 v[2]; u32x4 w;
#pragma unroll
                    for (int n = 0; n < 2; ++n) { v[n] = acc[ai][bj][m][n];
                        if (mode == 1) {
#pragma unroll
                            for (int j = 0; j < 4; ++j) v[n][j] = fsilu(v[n][j]); }
                        else if (mode == 2) {
#pragma unroll
                            for (int j = 0; j < 4; ++j) { const float x = v[n][j]; v[n][j] = x * fsigmoid(1.5957691216057308f * (x + 0.044715f * x * x * x)); } }
                        else if (mode == 3) {
#pragma unroll
                            for (int j = 0; j < 4; ++j) { const float l = lbv[bj][n][j]; const float fg = l + (1.0f - l) * fsigmoid(v[n][j]); v[n][j] = __builtin_amdgcn_logf(fg) * 0.6931471805599453f; } }
                    }
                    if (mode == 3) {
#pragma unroll
                        for (int n = 0; n < 2; ++n) { const _Float16 h0 = (_Float16)v[n][0], h1 = (_Float16)v[n][1], h2 = (_Float16)v[n][2], h3 = (_Float16)v[n][3];
                            const unsigned a = (unsigned)__builtin_bit_cast(unsigned short, h0) | ((unsigned)__builtin_bit_cast(unsigned short, h1) << 16);
                            const unsigned b = (unsigned)__builtin_bit_cast(unsigned short, h2) | ((unsigned)__builtin_bit_cast(unsigned short, h3) << 16);
                            if (n == 0) { w.x = a; w.y = b; } else { w.z = a; w.w = b; } }
                    } else { w.x = cvt_pk_bf16(v[0][0], v[0][1]); w.y = cvt_pk_bf16(v[0][2], v[0][3]); w.z = cvt_pk_bf16(v[1][0], v[1][1]); w.w = cvt_pk_bf16(v[1][2], v[1][3]); }
                    *(u32x4*)(rowp + bj * HALF) = w; } }
    }
};
}

struct Args { const float* in[30]; float* out; unsigned char* ws; };
enum { I_X = 0, I_C, I_ADAW, I_ADAB, I_N1G, I_N2G, I_ATWIN, I_ATQN, I_ATKN, I_ATLAM, I_ATSUB, I_ATWOUT, I_HGWIN, I_HGLB, I_HGNG, I_HGWOUT,
       I_LRWIN, I_LRCW, I_LRCB, I_LRWA, I_LRBA, I_LRWX, I_LRBX, I_LRLAM, I_LRWOUT, I_FFGU, I_FFDN, I_MOER, I_MOEGU, I_MOEDN };
enum { SC_LAM0 = 0, SC_LAM1, SC_OML0, SC_OML1, SC_MC0, SC_MC1 };

__device__ __forceinline__ void cvt_item(const float* W, int ldw, int src_col0, bf16_t* WT, int ldt, int dst_row0, int k0, LAS float* scr, int lane) {
#pragma unroll 8
    for (int i = 0; i < 32; ++i) { const int kk = 2 * i + (lane >> 5); scr[kk * 33 + (lane & 31)] = W[(size_t)(k0 + kk) * ldw + src_col0 + (lane & 31)]; }
    LDS_WAIT(); asm volatile("" ::: "memory");
    const int c = lane & 7;
#pragma unroll
    for (int j = 0; j < 4; ++j) { const int n = (lane >> 3) + 8 * j; const LAS float* s = scr + (8 * c) * 33 + n;
        u32x4 o; o.x = cvt_pk_bf16(s[0 * 33], s[1 * 33]); o.y = cvt_pk_bf16(s[2 * 33], s[3 * 33]); o.z = cvt_pk_bf16(s[4 * 33], s[5 * 33]); o.w = cvt_pk_bf16(s[6 * 33], s[7 * 33]);
        *(u32x4*)(WT + (size_t)(dst_row0 + n) * ldt + k0 + 8 * c) = o; }
    LDS_WAIT(); asm volatile("" ::: "memory");
}
__device__ __forceinline__ void cvt_item8(const float* W, int ldw, int src_col0, unsigned char* WT, int ldt, int dst_row0, int k0, float sc, LAS float* scr, int lane) {
#pragma unroll 8
    for (int i = 0; i < 32; ++i) { const int kk = 2 * i + (lane >> 5); scr[kk * 33 + (lane & 31)] = W[(size_t)(k0 + kk) * ldw + src_col0 + (lane & 31)]; }
    LDS_WAIT(); asm volatile("" ::: "memory");
    const int c = lane & 7;
#pragma unroll
    for (int j = 0; j < 4; ++j) { const int n = (lane >> 3) + 8 * j; const LAS float* s = scr + (8 * c) * 33 + n;
        *(u32x2*)(WT + (size_t)(dst_row0 + n) * ldt + k0 + 8 * c) = (u32x2){pk_fp8x4(s[0 * 33] * sc, s[1 * 33] * sc, s[2 * 33] * sc, s[3 * 33] * sc), pk_fp8x4(s[4 * 33] * sc, s[5 * 33] * sc, s[6 * 33] * sc, s[7 * 33] * sc)}; }
    LDS_WAIT(); asm volatile("" ::: "memory");
}
enum { MAP_ID = 0, MAP_QKV = 1, MAP_SWI = 2 };
template <bool F8 = false>
__device__ __forceinline__ void cvt_family(const float* src, size_t sstride, int ninst, int ldw, int K, int ng, int map, int F, bf16_t* dst, size_t dstride,
                                           LAS float* scr, int gw, int NGW, int lane) {
    const int nkb = K / 64, per = nkb * ng, total = ninst * per;
    for (int it = gw; it < total; it += NGW) {
        const int inst = it / per, r = it - inst * per, kb = r / ng, gi = r - kb * ng;
        int sc0;
        if (map == MAP_ID) sc0 = 32 * gi;
        else if (map == MAP_QKV) { const int pn = gi >> 3, bj = (gi >> 2) & 1, wc = gi & 3;
            if (pn < 8) { const int part = pn >> 2, sh = 4 * (pn & 3) + wc; sc0 = part * 1024 + sh * 64 + 32 * bj; } else sc0 = 32 * gi; }
        else { const int pn = gi >> 3, bj = (gi >> 2) & 1, q = gi & 3; sc0 = bj * F + pn * 128 + 32 * q; }
        if constexpr (F8) cvt_item8(src + (size_t)inst * sstride, ldw, sc0, (unsigned char*)dst + (size_t)inst * dstride, K, 32 * gi, 64 * kb, MOE_WSCALE, scr, lane);
        else cvt_item(src + (size_t)inst * sstride, ldw, sc0, dst + (size_t)inst * dstride, K, 32 * gi, 64 * kb, scr, lane);
    }
}

__device__ __forceinline__ void prologue_phase(const Args& A, LAS unsigned char* lds, int bid, int G) {
    const int tid = threadIdx.x, lane = tid & 63, wave = tid >> 6;
    unsigned char* ws = A.ws;
    {
        LAS float* sc = (LAS float*)lds;
        LAS float* red = (LAS float*)(lds + 32768);
        for (int i = tid; i < NBATCH * DM; i += NTHR) { const float cv = A.in[I_C][i]; sc[i] = fsilu(cv); }
        __syncthreads();
        float* mods = (float*)(ws + TB_MODS);
        for (int cb = bid; cb < (DEPTH * 6144) / 128; cb += G) {
            const int col = cb * 128 + (tid & 127), l = col / 6144, e = col - l * 6144, ch = tid >> 7;
            const float* wp = A.in[I_ADAW] + (size_t)l * DM * 6144 + e;
            float a[NBATCH];
#pragma unroll
            for (int b = 0; b < NBATCH; ++b) a[b] = 0.f;
#pragma unroll 4
            for (int d = ch * 256; d < ch * 256 + 256; ++d) { const float w = wp[(size_t)d * 6144];
#pragma unroll
                for (int b = 0; b < NBATCH; ++b) a[b] += sc[b * DM + d] * w; }
#pragma unroll
            for (int b = 0; b < NBATCH; ++b) red[(ch * 128 + (tid & 127)) * 8 + b] = a[b];
            __syncthreads();
            if (tid < 128) { const float bias = A.in[I_ADAB][l * 6144 + e];
#pragma unroll
                for (int b = 0; b < NBATCH; ++b) { const float s = ((red[(0 * 128 + tid) * 8 + b] + red[(1 * 128 + tid) * 8 + b]) + (red[(2 * 128 + tid) * 8 + b] + red[(3 * 128 + tid) * 8 + b])) + bias;
                    mods[((size_t)l * NBATCH + b) * 6144 + e] = s; } }
            __syncthreads();
        }
    }
    {
        float* cosT = (float*)(ws + TB_COS); float* sinT = (float*)(ws + TB_SIN);
        for (int i = bid * NTHR + tid; i < SEQ * 32; i += G * NTHR) {
            const int pos = i >> 5, d = i & 31;
            const float inv = (float)exp(-(double)d * (1.0 / 32.0) * 9.210340371976184);
            const float ang = (float)pos * inv;
            const double rev = (double)ang * 0.15915494309189535; const float fr = (float)(rev - floor(rev));
            cosT[i] = __builtin_amdgcn_cosf(fr); sinT[i] = __builtin_amdgcn_sinf(fr);
        }
        if (bid == 0 && tid < 2) {
            const int a = tid; const float* lm = A.in[I_ATLAM] + a * 256;
            float s1 = 0.f, s2 = 0.f; for (int i = 0; i < 64; ++i) { s1 += lm[i] * lm[64 + i]; s2 += lm[128 + i] * lm[192 + i]; }
            const float linit = 0.8f - 0.6f * expf(-0.3f * (float)(3 * a));
            float mq = 0.f, mk = 0.f; for (int i = 0; i < 64; ++i) { mq = fmaxf(mq, fabsf(A.in[I_ATQN][a * 64 + i])); mk = fmaxf(mk, fabsf(A.in[I_ATKN][a * 64 + i])); }
            float* scal = (float*)(ws + TB_SCAL);
            scal[SC_LAM0 + a] = expf(s1) - expf(s2) + linit; scal[SC_OML0 + a] = 1.0f - linit; scal[SC_MC0 + a] = 8.0f * mq * mk * LOG2E * 1.0001f;
        }
        if (bid == 1) {
            float* lb = (float*)(ws + TB_LB);
            for (int i = tid; i < 2 * 1024; i += NTHR) { const int d = i >> 10, k = i & 1023; const float* p = A.in[I_HGLB] + (size_t)d * DEPTH * 1024 + k;
                float mx = p[0]; for (int l = 1; l < DEPTH; ++l) mx = fmaxf(mx, p[l * 1024]);
                float den = 0.f, num = 0.f; for (int l = 0; l < DEPTH; ++l) { const float e = expf(p[l * 1024] - mx); den += e; if (l == 1) num += e; }
                lb[i] = num / den; }
        }
        if (bid == 2) {
            float* sp = (float*)(ws + TB_SP);
            for (int i = tid; i < 2 * LRUW; i += NTHR) { const float x = -A.in[I_LRLAM][i]; sp[i] = (x > 20.f) ? x : log1pf(expf(x)); }
        }
    }
    {
        LAS float* scr = (LAS float*)(lds + wave * 16384);
        const int vcu = (bid % 8) * (G / 8) + bid / 8;
        const int gw = vcu * NWAVES + wave, NGW = G * NWAVES;
        cvt_family(A.in[I_ATWIN], (size_t)1024 * 3072, 2, 3072, 1024, 96, MAP_QKV, 0, (bf16_t*)(ws + W_QKV), (size_t)3072 * 1024, scr, gw, NGW, lane);
        cvt_family(A.in[I_ATWOUT], (size_t)1024 * 1024, 2, 1024, 1024, 32, MAP_ID, 0, (bf16_t*)(ws + W_AO), (size_t)1024 * 1024, scr, gw, NGW, lane);
        cvt_family(A.in[I_HGWIN], 0, 1, 5120, 1024, 160, MAP_ID, 0, (bf16_t*)(ws + W_HGI), 0, scr, gw, NGW, lane);
        cvt_family(A.in[I_HGWOUT], 0, 1, 1024, 1024, 32, MAP_ID, 0, (bf16_t*)(ws + W_HGO), 0, scr, gw, NGW, lane);
        cvt_family(A.in[I_LRWIN], 0, 1, 2560, 1024, 80, MAP_ID, 0, (bf16_t*)(ws + W_LRI), 0, scr, gw, NGW, lane);
        cvt_family(A.in[I_LRWOUT], 0, 1, 1024, 1280, 32, MAP_ID, 0, (bf16_t*)(ws + W_LRO), 0, scr, gw, NGW, lane);
        for (int it = gw; it < 2 * 20 * 2 * 4; it += NGW) {
            const int part = it / 160, r = it % 160, inst = r >> 3, kb = (r >> 2) & 1, gi = r & 3, d = inst / 10, n = inst % 10;
            const float* src = (part ? A.in[I_LRWX] : A.in[I_LRWA]) + (size_t)inst * 16384;
            cvt_item(src, 128, 32 * gi, (bf16_t*)(ws + W_LRG) + (size_t)(n * 2 + d) * 256 * 128, 128, part * 128 + 32 * gi, 64 * kb, scr, lane);
        }
        cvt_family(A.in[I_FFGU], (size_t)1024 * 5632, 2, 5632, 1024, 176, MAP_SWI, DFF, (bf16_t*)(ws + W_FGU), (size_t)5632 * 1024, scr, gw, NGW, lane);
        cvt_family(A.in[I_FFDN], (size_t)2816 * 1024, 2, 1024, 2816, 32, MAP_ID, 0, (bf16_t*)(ws + W_FDN), (size_t)1024 * 2816, scr, gw, NGW, lane);
        cvt_family<true>(A.in[I_MOEGU], (size_t)1024 * 7168, 16, 7168, 1024, 224, MAP_SWI, DFFE, (bf16_t*)(ws + W_MGU), (size_t)7168 * 1024, scr, gw, NGW, lane);
        cvt_family<true>(A.in[I_MOEDN], (size_t)3584 * 1024, 16, 1024, 3584, 32, MAP_ID, 0, (bf16_t*)(ws + W_MDN), (size_t)1024 * 3584, scr, gw, NGW, lane);
    }
}

template <bool ROUTER>
__device__ __forceinline__ void norm_phase(const Args& A, LAS unsigned char* lds, int bid, int G, const float* xsrc, float* xdst, const float* gain, const float* modl  , int which,
                                           bool combine, const float* modprev  , bool nonorm, const float* router) {
    int tid_ = threadIdx.x; asm volatile("" : "+v"(tid_));
    const int tid = tid_, lane = tid & 63, wave = tid >> 6;
    unsigned char* ws = A.ws;
    bf16_t* HM = (bf16_t*)(ws + WS_HM);
    const int* slot = (const int*)(ws + TB_SLOT); const float* gts = (const float*)(ws + TB_GATE);
    const bf16_t* Y = (const bf16_t*)(ws + E_XS);
    LAS int* hist = (LAS int*)lds;
    for (int tb = bid; tb < MTOK / 256; tb += G) {
        const int b = tb >> 5;
        f32x4 ga[4], sh[4], g2[4];
#pragma unroll
        for (int j = 0; j < 4; ++j) { const int c = 256 * j + 4 * lane;
            if (!nonorm) { const f32x4 gv = *(const f32x4*)(gain + c), sv = *(const f32x4*)(modl + (size_t)b * 6144 + (which * 3 + 1) * 1024 + c);
                ga[j] = gv * (sv + 1.0f); sh[j] = *(const f32x4*)(modl + (size_t)b * 6144 + (which * 3) * 1024 + c); }
            if (combine) g2[j] = *(const f32x4*)(modprev + (size_t)b * 6144 + 5 * 1024 + c); }
        f32x4 rw[ROUTER ? 32 : 1];
        if constexpr (ROUTER) {
            if (tid < 8) hist[tid] = 0;
#pragma unroll
            for (int j = 0; j < 4; ++j)
#pragma unroll
                for (int i = 0; i < 4; ++i) { const int c = 256 * j + 4 * lane + i; rw[(j * 4 + i) * 2] = *(const f32x4*)(router + c * 8); rw[(j * 4 + i) * 2 + 1] = *(const f32x4*)(router + c * 8 + 4); }
            __syncthreads();
        }
        for (int i = 0; i < 32; ++i) {
            const int row = tb * 256 + wave * 32 + i;
            const float* xr = xsrc + (size_t)row * DM;
            f32x4 v[4];
#pragma unroll
            for (int j = 0; j < 4; ++j) v[j] = *(const f32x4*)(xr + 256 * j + 4 * lane);
            if (combine) {
                const int s0 = slot[row * 2], s1 = slot[row * 2 + 1]; const float w0 = gts[row * 2], w1 = gts[row * 2 + 1];
#pragma unroll
                for (int j = 0; j < 4; ++j) { const u32x2 a = *(const u32x2*)(Y + (size_t)s0 * DM + 256 * j + 4 * lane), c2 = *(const u32x2*)(Y + (size_t)s1 * DM + 256 * j + 4 * lane);
                    f32x4 y; y[0] = w0 * bflo(a.x) + w1 * bflo(c2.x); y[1] = w0 * bfhi(a.x) + w1 * bfhi(c2.x); y[2] = w0 * bflo(a.y) + w1 * bflo(c2.y); y[3] = w0 * bfhi(a.y) + w1 * bfhi(c2.y);
                    v[j] = v[j] + g2[j] * y; *(f32x4*)(xdst + (size_t)row * DM + 256 * j + 4 * lane) = v[j]; }
            }
            if (nonorm) continue;
            float ss = 0.f;
#pragma unroll
            for (int j = 0; j < 4; ++j) ss += (v[j][0] * v[j][0] + v[j][1] * v[j][1]) + (v[j][2] * v[j][2] + v[j][3] * v[j][3]);
            ss = wave_sum(ss);
            const float rstd = 1.0f / sqrtf(ss * (1.0f / DM) + EPS);
            f32x4 h[4];
#pragma unroll
            for (int j = 0; j < 4; ++j) { h[j] = v[j] * rstd * ga[j] + sh[j];
                u32x2 w; w.x = cvt_pk_bf16(h[j][0], h[j][1]); w.y = cvt_pk_bf16(h[j][2], h[j][3]);
                *(u32x2*)(HM + (size_t)row * DM + 256 * j + 4 * lane) = w; }
            if constexpr (ROUTER) {
                float lg[8];
#pragma unroll
                for (int e = 0; e < 8; ++e) lg[e] = 0.f;
#pragma unroll
                for (int j = 0; j < 4; ++j)
#pragma unroll
                    for (int q = 0; q < 4; ++q) { const float hv = h[j][q]; const f32x4 r0 = rw[(j * 4 + q) * 2], r1 = rw[(j * 4 + q) * 2 + 1];
                        lg[0] += hv * r0[0]; lg[1] += hv * r0[1]; lg[2] += hv * r0[2]; lg[3] += hv * r0[3]; lg[4] += hv * r1[0]; lg[5] += hv * r1[1]; lg[6] += hv * r1[2]; lg[7] += hv * r1[3]; }
#pragma unroll
                for (int e = 0; e < 8; ++e) lg[e] = wave_sum(lg[e]);
                int e0 = 0; float v0 = lg[0];
#pragma unroll
                for (int e = 1; e < 8; ++e) if (lg[e] > v0) { v0 = lg[e]; e0 = e; }
                int e1 = -1; float v1 = -3.0e38f;
#pragma unroll
                for (int e = 0; e < 8; ++e) if (e != e0 && lg[e] > v1) { v1 = lg[e]; e1 = e; }
                const float p1 = frcp(1.0f + fexp(v1 - v0));
                if (lane == 0) { int* eid = (int*)(ws + TB_EID); float* gt = (float*)(ws + TB_GATE);
                    eid[row * 2] = e0; eid[row * 2 + 1] = e1; gt[row * 2] = p1; gt[row * 2 + 1] = 1.0f - p1;
                    atomicAdd((int*)&hist[e0], 1); atomicAdd((int*)&hist[e1], 1); }
            }
        }
        if constexpr (ROUTER) {
            __syncthreads();
            if (tid < 8) ((int*)(ws + TB_BCNT))[tb * 8 + tid] = hist[tid];
            __syncthreads();
        }
    }
}

namespace lru {
constexpr int XCF = 0, XCB = 16384, AA = 24576, UU = 40960;
__device__ __forceinline__ int sw256(int row, int cb) { return row * 256 + (cb ^ ((row & 7) << 4)); }
__device__ __forceinline__ int crow(int r, int hi) { return (r & 3) + 8 * (r >> 2) + 4 * hi; }
template <int MODE>
__device__ __forceinline__ void lru_item(const Args& A, LAS unsigned char* lds, int b, int n, int seg, int dir) {
    int tid_ = threadIdx.x; asm volatile("" : "+v"(tid_));
    const int tid = tid_, wid = tid >> 6, lane = tid & 63, r = lane & 31, hh = lane >> 5;
    unsigned char* ws = A.ws;
    const bf16_t* XB = (const bf16_t*)(ws + L_XB); const bf16_t* YB = (const bf16_t*)(ws + L_YB); bf16_t* HF = (bf16_t*)(ws + L_HF); bf16_t* HY = (bf16_t*)(ws + L_HY);
    const bf16_t* Wg = (const bf16_t*)(ws + W_LRG) + (size_t)((n * 2 + dir) * 256 + ((r < 16) ? (16 * wid + r) : (128 + 16 * wid + r - 16))) * 128 + 8 * hh;
    bf16x8 bfrag[8];
#pragma unroll
    for (int ks = 0; ks < 8; ++ks) bfrag[ks] = *(const bf16x8*)(Wg + 16 * ks);
    const int cch = n * 128 + 16 * wid + (r & 15);
    const float ba = A.in[I_LRBA][dir * LRUW + cch], bx = A.in[I_LRBX][dir * LRUW + cch], sp = ((const float*)(ws + TB_SP))[dir * LRUW + cch];
    const int ct = tid >> 4, cg = tid & 15, cc0 = n * 128 + 8 * cg;
    float cw[4][8], cb[8];
#pragma unroll
    for (int j = 0; j < 8; ++j) { cb[j] = A.in[I_LRCB][cc0 + j];
#pragma unroll
        for (int w = 0; w < 4; ++w) cw[w][j] = A.in[I_LRCW][w * LRUW + cc0 + j]; }
    float carry = 0.f, P = 1.f;
    if (MODE != 0 && tid < 128) carry = ((const float*)(ws + TB_LCIN))[(size_t)((b * 32 + seg) * 2 + dir) * LRUW + n * 128 + tid];
    u32x4 xr[4];
#define LRU_XLOAD(si_) do { const int sub_ = dir ? (7 - (si_)) : (si_); const int tok_ = seg * 256 + sub_ * 32 + ct; \
        _Pragma("unroll") for (int w = 0; w < 4; ++w) { const int tt = tok_ - 1 + w; xr[w] = (tt >= 0 && tt < SEQ) ? *(const u32x4*)(XB + ((size_t)b * SEQ + tt) * LRUW + cc0) : (u32x4){0u, 0u, 0u, 0u}; } } while (0)
    LRU_XLOAD(0);
    for (int si = 0; si < 8; ++si) {
        const int sub = dir ? (7 - si) : si; const int t0 = seg * 256 + sub * 32;
        {
            float xc[8];
#pragma unroll
            for (int j = 0; j < 8; ++j) xc[j] = cb[j];
#pragma unroll
            for (int w = 0; w < 4; ++w) { const u32x4 v = xr[w];
#pragma unroll
                for (int e = 0; e < 4; ++e) { xc[2 * e] += cw[w][2 * e] * bflo(v[e]); xc[2 * e + 1] += cw[w][2 * e + 1] * bfhi(v[e]); } }
            if (si + 1 < 8) LRU_XLOAD(si + 1);
            *(LAS f32x4*)(lds + XCF + (ct * 128 + 8 * cg) * 4) = (f32x4){xc[0], xc[1], xc[2], xc[3]};
            *(LAS f32x4*)(lds + XCF + (ct * 128 + 8 * cg + 4) * 4) = (f32x4){xc[4], xc[5], xc[6], xc[7]};
            *(LAS u32x4*)(lds + XCB + sw256(ct, 16 * cg)) = (u32x4){cvt_pk_bf16(xc[0], xc[1]), cvt_pk_bf16(xc[2], xc[3]), cvt_pk_bf16(xc[4], xc[5]), cvt_pk_bf16(xc[6], xc[7])};
        }
        __syncthreads();
        {
            f32x16 acc = {};
#pragma unroll
            for (int ks = 0; ks < 8; ++ks) { const bf16x8 fa = *(const LAS bf16x8*)(lds + XCB + sw256(r, (16 * ks + 8 * hh) * 2)); acc = __builtin_amdgcn_mfma_f32_32x32x16_bf16(fa, bfrag[ks], acc, 0, 0, 0); }
#pragma unroll
            for (int q = 0; q < 8; ++q) {
                const float send = (r < 16) ? acc[8 + q] : acc[q]; const float recv = __shfl_xor(send, 16);
                const float rp = (r < 16) ? acc[q] : recv, ip = (r < 16) ? recv : acc[8 + q];
                const int tq = crow((r < 16) ? q : (8 + q), hh); const int cl = 16 * wid + (r & 15);
                const float xcv = ((const LAS float*)(lds + XCF))[tq * 128 + cl];
                const float rg = fsigmoid(rp + ba), ig = fsigmoid(ip + bx); const float la = -8.0f * rg * sp;
                const float av = fexp(la), uv = sqrtf(fmaxf(1.0f - av * av, 0.f)) * ig * xcv;
                ((LAS float*)(lds + AA))[tq * 128 + cl] = av; ((LAS float*)(lds + UU))[tq * 128 + cl] = uv; }
        }
        __syncthreads();
        if (tid < 128) {
            LAS float* ap = (LAS float*)(lds + AA) + tid; LAS float* up = (LAS float*)(lds + UU) + tid; float av[32], uv[32];
#pragma unroll
            for (int i = 0; i < 32; ++i) { av[i] = ap[i * 128]; uv[i] = up[i * 128]; }
            if (dir == 0) {
#pragma unroll
                for (int i = 0; i < 32; ++i) { carry = av[i] * carry + uv[i]; if (MODE == 0) P *= av[i]; else uv[i] = carry; } }
            else {
#pragma unroll
                for (int i = 31; i >= 0; --i) { carry = av[i] * carry + uv[i]; if (MODE == 0) P *= av[i]; else uv[i] = carry; } }
            if (MODE != 0) {
#pragma unroll
                for (int i = 0; i < 32; ++i) up[i * 128] = uv[i]; }
        }
        if (MODE != 0) {
            __syncthreads();
            const int tok = t0 + ct; const size_t go = ((size_t)b * SEQ + tok) * LRUW + cc0;
            const f32x4 h0 = *(const LAS f32x4*)(lds + UU + (ct * 128 + 8 * cg) * 4), h1 = *(const LAS f32x4*)(lds + UU + (ct * 128 + 8 * cg + 4) * 4);
            if (MODE == 1) { *(u32x4*)(HF + go) = (u32x4){cvt_pk_bf16(h0[0], h0[1]), cvt_pk_bf16(h0[2], h0[3]), cvt_pk_bf16(h1[0], h1[1]), cvt_pk_bf16(h1[2], h1[3])}; }
            else { const u32x4 f = *(const u32x4*)(HF + go), y = *(const u32x4*)(YB + go);
                *(u32x4*)(HY + go) = (u32x4){cvt_pk_bf16((h0[0] + bflo(f[0])) * bflo(y[0]), (h0[1] + bfhi(f[0])) * bfhi(y[0])), cvt_pk_bf16((h0[2] + bflo(f[1])) * bflo(y[1]), (h0[3] + bfhi(f[1])) * bfhi(y[1])),
                                            cvt_pk_bf16((h1[0] + bflo(f[2])) * bflo(y[2]), (h1[1] + bfhi(f[2])) * bfhi(y[2])), cvt_pk_bf16((h1[2] + bflo(f[3])) * bflo(y[3]), (h1[3] + bfhi(f[3])) * bfhi(y[3]))}; }
        }
        __syncthreads();
    }
#undef LRU_XLOAD
    if (MODE == 0 && tid < 128) { float* sm = (float*)(ws + TB_LSUM) + (size_t)(((b * 32 + seg) * 2 + dir) * 2) * LRUW + n * 128 + tid; sm[0] = P; sm[LRUW] = carry; }
}
}
template <int MODE>
__device__ __forceinline__ void lru_phase(const Args& A, LAS unsigned char* lds, int bid, int G) {
    const int nitems = (MODE == 0) ? 5120 : 2560;
    for (int it = bid; it < nitems; it += G) {
        int b, n, seg, dir;
        if (MODE == 0) { dir = it & 1; const int r = it >> 1; seg = r & 31; n = (r >> 5) % 10; b = r / 320; }
        else { dir = MODE - 1; seg = it & 31; n = (it >> 5) % 10; b = it / 320; }
        lru::lru_item<MODE>(A, lds, b, n, seg, dir);
    }
}
__device__ __forceinline__ void lru_carry_phase(const Args& A, int bid, int G) {
    const float* sm = (const float*)(A.ws + TB_LSUM); float* cin = (float*)(A.ws + TB_LCIN);
    for (int idx = bid * NTHR + threadIdx.x; idx < NBATCH * 2 * LRUW; idx += G * NTHR) {
        const int b = idx / (2 * LRUW), r = idx % (2 * LRUW), dir = r / LRUW, ch = r % LRUW; float carry = 0.f;
        for (int i = 0; i < 32; ++i) { const int sg = dir ? (31 - i) : i; const size_t o = (size_t)((b * 32 + sg) * 2 + dir);
            cin[o * LRUW + ch] = carry; carry = sm[o * 2 * LRUW + ch] * carry + sm[o * 2 * LRUW + LRUW + ch]; }
    }
}

__device__ __forceinline__ void place_phase(const Args& A, LAS unsigned char* lds, int bid, int G) {
    int tid_ = threadIdx.x; asm volatile("" : "+v"(tid_));
    const int tid = tid_, lane = tid & 63, wave = tid >> 6; unsigned char* ws = A.ws;
    const int* bcnt = (const int*)(ws + TB_BCNT); const int* eid = (const int*)(ws + TB_EID); int* slot = (int*)(ws + TB_SLOT);
    const bf16_t* HM = (const bf16_t*)(ws + WS_HM); bf16_t* XS = (bf16_t*)(ws + E_XS);
    LAS int* tot = (LAS int*)lds; LAS int* pre = tot + 8; LAS int* rb = tot + 16; LAS int* wcn = tot + 32; LAS int* sl = tot + 64;
    for (int tb = bid; tb < MTOK / 256; tb += G) {
        { int t_ = 0, p_ = 0;
#pragma unroll
            for (int j = 0; j < 4; ++j) { const int blk = lane + 64 * j; const int v = bcnt[blk * 8 + wave]; t_ += v; p_ += (blk < tb) ? v : 0; }
#pragma unroll
            for (int o = 1; o < 64; o <<= 1) { t_ += __shfl_xor(t_, o); p_ += __shfl_xor(p_, o); }
            if (lane == 0) { tot[wave] = t_; pre[wave] = p_; } }
        __syncthreads();
        if (tid == 0) { int acc = 0; for (int e = 0; e < 8; ++e) { rb[e] = acc * 256; if (tb == 0) ((int*)(ws + TB_TILES))[e] = acc; acc += (tot[e] + 255) >> 8; } if (tb == 0) ((int*)(ws + TB_TILES))[8] = acc; }
        int e0 = -1, e1 = -1; unsigned long long mk0 = 0, mk1 = 0;
        if (tid < 256) { e0 = eid[(tb * 256 + tid) * 2]; e1 = eid[(tb * 256 + tid) * 2 + 1];
#pragma unroll
            for (int e = 0; e < 8; ++e) { const unsigned long long m = __ballot(e0 == e || e1 == e); if (lane == 0) wcn[wave * 8 + e] = __popcll(m); if (e0 == e) mk0 = m; if (e1 == e) mk1 = m; } }
        __syncthreads();
        if (tid < 256) { const unsigned long long lt = (1ull << lane) - 1ull; int b0 = rb[e0] + pre[e0] + __popcll(mk0 & lt), b1 = rb[e1] + pre[e1] + __popcll(mk1 & lt);
            for (int w = 0; w < wave; ++w) { b0 += wcn[w * 8 + e0]; b1 += wcn[w * 8 + e1]; }
            sl[tid * 2] = b0; sl[tid * 2 + 1] = b1; slot[(tb * 256 + tid) * 2] = b0; slot[(tb * 256 + tid) * 2 + 1] = b1; }
        __syncthreads();
        for (int i = 0; i < 32; ++i) { const int t = wave * 32 + i; const int s0 = sl[t * 2], s1 = sl[t * 2 + 1];
            const bf16_t* src = HM + (size_t)(tb * 256 + t) * DM + lane * 16;
            const u32x4 a = *(const u32x4*)src, b = *(const u32x4*)(src + 8);
            const u32x4 q = {pk_fp8x4(bflo(a[0]), bfhi(a[0]), bflo(a[1]), bfhi(a[1])), pk_fp8x4(bflo(a[2]), bfhi(a[2]), bflo(a[3]), bfhi(a[3])),
                             pk_fp8x4(bflo(b[0]), bfhi(b[0]), bflo(b[1]), bfhi(b[1])), pk_fp8x4(bflo(b[2]), bfhi(b[2]), bflo(b[3]), bfhi(b[3]))};
            *(u32x4*)((unsigned char*)XS + (size_t)s0 * DM + lane * 16) = q; *(u32x4*)((unsigned char*)XS + (size_t)s1 * DM + lane * 16) = q; }
        __syncthreads();
    }
}

namespace att {
constexpr int KVBLK = 64;
constexpr int SHM_V = KVBLK * 128 * 2, SHM_K = KVBLK * 128 * 2;
#define KSWZ(row, colB) ((row) * 256 + ((colB) ^ (((row) & 7) << 4)))
#define SBAR() __builtin_amdgcn_sched_barrier(0)
__device__ __forceinline__ int crow(int r, int hi) { return (r & 3) + 8 * (r >> 2) + 4 * hi; }
__device__ __forceinline__ int v_st(int k, int c) { const int kk = (k & ~0xC) | ((k & 4) << 1) | ((k & 8) >> 1); return ((kk >> 3) * 4 + (c >> 5)) * 512 + ((kk & 7) * 32 + (c & 31)) * 2; }
__device__ __forceinline__ int v_rd_base(int lane) { return ((lane & 3) << 3) | (((lane >> 2) & 3) << 6) | (((lane >> 4) & 1) << 5) | (((lane >> 5) & 1) << 8); }
constexpr int v_rd_off(int d0, int ks, int half) { return d0 * 512 + ks * 4096 + half * 2048; }
template <int OFF> __device__ __forceinline__ s16x4 tr_read(int vb) {
    s16x4 r; asm volatile("ds_read_b64_tr_b16 %0, %1 offset:%2" : "=&v"(r) : "v"(vb), "i"(OFF) : "memory"); return r;
}
template <int D0> __device__ __forceinline__ void pv_one(f32x16& od, int vb, bf16x8 pa0, bf16x8 pa1, bf16x8 pa2, bf16x8 pa3) {
    const s16x4 l0 = tr_read<v_rd_off(D0, 0, 0)>(vb), h0 = tr_read<v_rd_off(D0, 0, 1)>(vb), l1 = tr_read<v_rd_off(D0, 1, 0)>(vb), h1 = tr_read<v_rd_off(D0, 1, 1)>(vb);
    const s16x4 l2 = tr_read<v_rd_off(D0, 2, 0)>(vb), h2 = tr_read<v_rd_off(D0, 2, 1)>(vb), l3 = tr_read<v_rd_off(D0, 3, 0)>(vb), h3 = tr_read<v_rd_off(D0, 3, 1)>(vb);
    asm volatile("s_waitcnt lgkmcnt(0)" ::: "memory"); SBAR();
#define PK(L, H) (bf16x8){L[0], L[1], L[2], L[3], H[0], H[1], H[2], H[3]}
    od = __builtin_amdgcn_mfma_f32_32x32x16_bf16(pa0, PK(l0, h0), od, 0, 0, 0);
    od = __builtin_amdgcn_mfma_f32_32x32x16_bf16(pa1, PK(l1, h1), od, 0, 0, 0);
    od = __builtin_amdgcn_mfma_f32_32x32x16_bf16(pa2, PK(l2, h2), od, 0, 0, 0);
    od = __builtin_amdgcn_mfma_f32_32x32x16_bf16(pa3, PK(l3, h3), od, 0, 0, 0);
#undef PK
}
__device__ __forceinline__ void pv_d0(f32x16* o, int vb, bf16x8 pa0, bf16x8 pa1, bf16x8 pa2, bf16x8 pa3) {
    pv_one<0>(o[0], vb, pa0, pa1, pa2, pa3); pv_one<1>(o[1], vb, pa0, pa1, pa2, pa3); pv_one<2>(o[2], vb, pa0, pa1, pa2, pa3); pv_one<3>(o[3], vb, pa0, pa1, pa2, pa3);
}
__device__ __forceinline__ void partialSM(f32x16& p0, f32x16& p1, float Mc) {
#pragma unroll
    for (int r = 0; r < 16; ++r) p0[r] = fexp2(p0[r]);
}
__device__ __forceinline__ void finishSM(f32x16& p0, f32x16& p1, float& l_reg, bf16x8& pa0, bf16x8& pa1, bf16x8& pa2, bf16x8& pa3) {
#pragma unroll
    for (int r = 0; r < 16; ++r) p1[r] = fexp2(p1[r]);
    float ps = 0;
#pragma unroll
    for (int r = 0; r < 16; ++r) ps += p0[r];
#pragma unroll
    for (int r = 0; r < 16; ++r) ps += p1[r];
    { auto rr = __builtin_amdgcn_permlane32_swap(__float_as_uint(ps), __float_as_uint(ps), false, false);
      ps = __uint_as_float(rr[0]) + __uint_as_float(rr[1]); }
    l_reg += ps;
#define PK4(P, BASE, OUT) do { unsigned a0 = cvt_pk_bf16(P[BASE + 0], P[BASE + 1]), a1 = cvt_pk_bf16(P[BASE + 2], P[BASE + 3]);   \
    unsigned b0 = cvt_pk_bf16(P[BASE + 4], P[BASE + 5]), b1 = cvt_pk_bf16(P[BASE + 6], P[BASE + 7]);                              \
    auto r0 = __builtin_amdgcn_permlane32_swap(a0, b0, false, false); auto r1 = __builtin_amdgcn_permlane32_swap(a1, b1, false, false); \
    u32x4 w = {r0[0], r1[0], r0[1], r1[1]}; OUT = *reinterpret_cast<bf16x8*>(&w); } while (0)
    PK4(p0, 0, pa0); PK4(p0, 8, pa1); PK4(p1, 0, pa2); PK4(p1, 8, pa3);
#undef PK4
}
__device__ __forceinline__ void qkt(f32x16& p0, f32x16& p1, const LAS char* Ks, const bf16x8* qr, int r32, int hi, int jj, float nMc) {
#pragma unroll
    for (int r = 0; r < 16; ++r) { p0[r] = nMc; p1[r] = nMc; }
#pragma unroll
    for (int d0 = 0; d0 < 4; ++d0) { const int cb = ((jj * 4 + d0) * 16 + hi * 8) * 2;
        const bf16x8 b0 = *(const LAS bf16x8*)(Ks + KSWZ(r32, cb));
        const bf16x8 b1 = *(const LAS bf16x8*)(Ks + KSWZ(32 + r32, cb));
        p0 = __builtin_amdgcn_mfma_f32_32x32x16_bf16(b0, qr[d0], p0, 0, 0, 0);
        p1 = __builtin_amdgcn_mfma_f32_32x32x16_bf16(b1, qr[d0], p1, 0, 0, 0); }
}
constexpr int SLOTB = 16384;
__device__ __forceinline__ int k_slot(int s) { return (s & 1) * SLOTB + (s >> 1) * 65536; }
__device__ __forceinline__ int v_slot(int s) { return 32768 + (s & 1) * SLOTB + (s >> 1) * 65536; }
}

__device__ __forceinline__ void attn_phase(const Args& A, LAS unsigned char* ldsu, int bid, int G, int al) {
    using namespace att;
    LAS char* lds = (LAS char*)ldsu;
    unsigned char* ws = A.ws;
    const bf16_t* Qg = (const bf16_t*)(ws + A_Q); const bf16_t* Kg = (const bf16_t*)(ws + A_K); const bf16_t* Vg = (const bf16_t*)(ws + A_V);
    bf16_t* Og = (bf16_t*)(ws + WS_HM);
    const float* scal = (const float*)(ws + TB_SCAL);
    const float lamv = scal[SC_LAM0 + al], omli = scal[SC_OML0 + al], Mc = scal[SC_MC0 + al];
    const float* subg = A.in[I_ATSUB] + al * 128;
    int tid_ = threadIdx.x; asm volatile("" : "+v"(tid_));
    const int tid = tid_, wid = __builtin_amdgcn_readfirstlane(tid >> 6), lane = tid & 63, r32 = lane & 31, hi = lane >> 5, jj = wid >> 2, wq = wid & 3;
    constexpr int NT = SEQ / KVBLK;
    unsigned koff[2], voff[2];
#pragma unroll
    for (int i = 0; i < 2; ++i) { const int bb = wid * 2048 + i * 1024 + lane * 16;
        { const int row = bb >> 8, colB = (bb & 255) ^ ((row & 7) << 4); koff[i] = (unsigned)(row * 2048 + colB); }
        { const int sub = bb >> 9, rem = bb & 511, kk = (sub >> 2) * 8 + (rem >> 6), c = (sub & 3) * 32 + ((rem >> 1) & 31); const int k = (kk & ~0xC) | ((kk & 4) << 1) | ((kk & 8) >> 1); voff[i] = (unsigned)(k * 2048 + c * 2); } }
    const unsigned ldsw = (unsigned)wid * 2048u;
#define ATT_DMA(slot, kt, vt) do { _Pragma("unroll") for (int _i = 0; _i < 2; ++_i) { \
        __builtin_amdgcn_global_load_lds((const unsigned*)((const char*)(kt) + koff[_i]), (LAS unsigned*)(lds + k_slot(slot) + ldsw + _i * 1024), 16, 0, 0); \
        __builtin_amdgcn_global_load_lds((const unsigned*)((const char*)(vt) + voff[_i]), (LAS unsigned*)(lds + v_slot(slot) + ldsw + _i * 1024), 16, 0, 0); } } while (0)
#define ATT_TOP() do { asm volatile("s_waitcnt vmcnt(4)" ::: "memory"); __builtin_amdgcn_s_barrier(); asm volatile("" ::: "memory"); } while (0)
    const int xq = bid & 7, cq = bid >> 3;
    LAS float* li_l = (LAS float*)(lds + 131072) + wid * 64;
    const int vbl = (int)(uintptr_t)lds + v_rd_base(lane);
    size_t cbase; { const int bh = xq * 8, b = bh >> 3, h = bh & 7; cbase = (size_t)b * SEQ * DM + h * 128; }
    ATT_DMA(0, Kg + cbase, Vg + cbase); ATT_DMA(1, Kg + cbase + (size_t)64 * DM, Vg + cbase + (size_t)64 * DM);
    for (int ui = 0; ui < 16; ++ui) {
        const int qb = (ui & 1) * 32 + cq;
        size_t nbase = cbase; if (ui + 1 < 16) { const int bh = xq * 8 + ((ui + 1) >> 1), b = bh >> 3, h = bh & 7; nbase = (size_t)b * SEQ * DM + h * 128; }
        const bf16_t* Kh = Kg + cbase; const bf16_t* Vh = Vg + cbase; const bf16_t* nK = Kg + nbase; const bf16_t* nV = Vg + nbase;
        float l_reg = 0; f32x16 o[4] = {}; bf16x8 qr[4];
        { const bf16_t* Qw = Qg + cbase + (size_t)(qb * 128 + wq * 32 + r32) * DM + jj * 64 + hi * 8;
#pragma unroll
          for (int d0 = 0; d0 < 4; ++d0) qr[d0] = *(const bf16x8*)(Qw + d0 * 16); }
        f32x16 pA0, pA1, pB0, pB1; bf16x8 pa0, pa1, pa2, pa3;
#define ATT_SRC(jt, KP, VP) const bf16_t* KP = ((jt) + 2 < NT) ? Kh + (size_t)((jt) + 2) * 64 * DM : nK + (size_t)((jt) + 2 - NT) * 64 * DM; \
                            const bf16_t* VP = ((jt) + 2 < NT) ? Vh + (size_t)((jt) + 2) * 64 * DM : nV + (size_t)((jt) + 2 - NT) * 64 * DM
        { ATT_TOP(); ATT_SRC(0, kp, vp); ATT_DMA(2, kp, vp);
          qkt(pA0, pA1, lds + k_slot(0), qr, r32, hi, jj, -Mc); partialSM(pA0, pA1, Mc); }
        for (int jt = 1; jt + 1 < NT; jt += 2) {
            { ATT_TOP(); ATT_SRC(jt, kp, vp); ATT_DMA((jt + 2) & 3, kp, vp);
              SBAR(); qkt(pB0, pB1, lds + k_slot(jt & 3), qr, r32, hi, jj, -Mc);
              finishSM(pA0, pA1, l_reg, pa0, pa1, pa2, pa3); SBAR();
              pv_d0(o, vbl + v_slot((jt - 1) & 3), pa0, pa1, pa2, pa3); partialSM(pB0, pB1, Mc); }
            { const int j2 = jt + 1; ATT_TOP(); ATT_SRC(j2, kp, vp); ATT_DMA((j2 + 2) & 3, kp, vp);
              SBAR(); qkt(pA0, pA1, lds + k_slot(j2 & 3), qr, r32, hi, jj, -Mc);
              finishSM(pB0, pB1, l_reg, pa0, pa1, pa2, pa3); SBAR();
              pv_d0(o, vbl + v_slot((j2 - 1) & 3), pa0, pa1, pa2, pa3); partialSM(pA0, pA1, Mc); }
        }
        { constexpr int jt = NT - 1; ATT_TOP(); ATT_SRC(jt, kp, vp); ATT_DMA((jt + 2) & 3, kp, vp);
          SBAR(); qkt(pB0, pB1, lds + k_slot(jt & 3), qr, r32, hi, jj, -Mc);
          finishSM(pA0, pA1, l_reg, pa0, pa1, pa2, pa3); SBAR();
          pv_d0(o, vbl + v_slot((jt - 1) & 3), pa0, pa1, pa2, pa3); partialSM(pB0, pB1, Mc);
          finishSM(pB0, pB1, l_reg, pa0, pa1, pa2, pa3); SBAR();
          pv_d0(o, vbl + v_slot(jt & 3), pa0, pa1, pa2, pa3); }
        int r32e = r32, hie = hi; asm volatile("" : "+v"(r32e), "+v"(hie));
        if (hie == 0) li_l[r32e] = l_reg; asm volatile("s_waitcnt lgkmcnt(0)" ::: "memory");
        float rli[16];
#pragma unroll
        for (int r = 0; r < 16; ++r) rli[r] = frcp(li_l[crow(r, hie)]);
        asm volatile("s_waitcnt lgkmcnt(0)" ::: "memory"); __builtin_amdgcn_s_barrier(); asm volatile("" ::: "memory");
        LAS float* Cb = (LAS float*)(lds + 65536);
        if (jj == 1) {
#pragma unroll
            for (int r = 0; r < 16; ++r) { const float sc = rli[r] * lamv;
#pragma unroll
                for (int d0 = 0; d0 < 4; ++d0) Cb[(wq * 32 + crow(r, hie)) * 128 + d0 * 32 + r32e] = o[d0][r] * sc; }
        }
        asm volatile("s_waitcnt lgkmcnt(0)" ::: "memory"); __builtin_amdgcn_s_barrier(); asm volatile("" ::: "memory");
        if (jj == 0) {
            float g[4];
#pragma unroll
            for (int d0 = 0; d0 < 4; ++d0) g[d0] = subg[d0 * 32 + r32e] * omli;
            bf16_t* Ob = Og + cbase + (size_t)(qb * 128) * DM;
#pragma unroll
            for (int r = 0; r < 16; ++r) {
                float ss = 0.f;
#pragma unroll
                for (int d0 = 0; d0 < 4; ++d0) { const float v = o[d0][r] * rli[r] - Cb[(wq * 32 + crow(r, hie)) * 128 + d0 * 32 + r32e]; o[d0][r] = v; ss += v * v; }
                ss += __shfl_xor(ss, 1); ss += __shfl_xor(ss, 2); ss += __shfl_xor(ss, 4); ss += __shfl_xor(ss, 8); ss += __shfl_xor(ss, 16);
                const float rs = 1.0f / sqrtf(ss * (1.0f / 128.0f) + EPS);
                bf16_t* op = Ob + (size_t)(wq * 32 + crow(r, hie)) * DM + r32e;
#pragma unroll
                for (int d0 = 0; d0 < 4; ++d0) op[d0 * 32] = (bf16_t)f2bf(o[d0][r] * rs * g[d0]);
            }
        }
        cbase = nbase;
    }
    asm volatile("s_waitcnt vmcnt(0) lgkmcnt(0)" ::: "memory"); __builtin_amdgcn_s_barrier(); asm volatile("" ::: "memory");
#undef ATT_DMA
#undef ATT_TOP
#undef ATT_SRC
}

namespace gla {
constexpr int BC = 0, QI = 32768, QA = 49152, KA = 65536, KST = 81920, VT = 98304, ST = 106496, AT = 122880, EM = 131072, EL = EM + 512, DD = EM + 1024, BMID = EM + 1536, SEG = EM + 2048;
static_assert(SEG + 2048 <= RING_BYTES, "gla lds");
__device__ __forceinline__ int sw256(int row, int cb) { return row * 256 + (cb ^ ((row & 15) << 4)); }
__device__ __forceinline__ int sw128(int row, int cb) { return row * 128 + (cb ^ ((((row & 7) ^ (row >> 4)) & 7) << 4)); }
__device__ __forceinline__ int crow(int r, int hi) { return (r & 3) + 8 * (r >> 2) + 4 * hi; }
__device__ __forceinline__ float h2f(unsigned short b) { return (float)__builtin_bit_cast(_Float16, b); }
__device__ __forceinline__ void gla_item(const bf16_t* __restrict__ Qp, const unsigned short* __restrict__ LFp, const bf16_t* __restrict__ Vp, bf16_t* __restrict__ Op, int dir, LAS unsigned char* lds, float* dbg) {
    int tid_ = threadIdx.x; asm volatile("" : "+v"(tid_));
    const int tid = tid_, wid = tid >> 6, lane = tid & 63, r = lane & 31, hh = lane >> 5;
    const int t1 = tid >> 3, kg = tid & 7, k0 = 16 * kg, v0 = (tid & 7) * 8;
    for (int i = tid; i < 16384 / 16; i += NTHR) *(LAS u32x4*)(lds + ST + i * 16) = (u32x4){0u, 0u, 0u, 0u};
    f32x16 st = {};
    u32x4 rq[2], rl[2], rv;
#define GLA_TOK(ci, i) (dir ? (SEQ - 1 - ((ci) * 64 + (i))) : ((ci) * 64 + (i)))
#define GLA_LOAD(ci) do { const size_t to = (size_t)GLA_TOK(ci, t1) * DM; \
        rq[0] = *(const u32x4*)(Qp + to + k0); rq[1] = *(const u32x4*)(Qp + to + k0 + 8); \
        rl[0] = *(const u32x4*)(LFp + to + k0); rl[1] = *(const u32x4*)(LFp + to + k0 + 8); rv = *(const u32x4*)(Vp + to + v0); } while (0)
    GLA_LOAD(0);
    __syncthreads();
    for (int ci = 0; ci < SEQ / 64; ++ci) {
        float qf[16], lf[16]; u32x4 vreg = rv;
#pragma unroll
        for (int j = 0; j < 2; ++j)
#pragma unroll
            for (int e = 0; e < 4; ++e) { qf[j * 8 + 2 * e] = bflo(rq[j][e]); qf[j * 8 + 2 * e + 1] = bfhi(rq[j][e]);
                lf[j * 8 + 2 * e] = h2f((unsigned short)(rl[j][e] & 0xffffu)); lf[j * 8 + 2 * e + 1] = h2f((unsigned short)(rl[j][e] >> 16)); }
        if (ci + 1 < SEQ / 64) GLA_LOAD(ci + 1);
#pragma unroll
        for (int j = 0; j < 4; ++j) *(LAS f32x4*)(lds + BC + (t1 * 128 + k0 + 4 * j) * 4) = (f32x4){lf[4 * j], lf[4 * j + 1], lf[4 * j + 2], lf[4 * j + 3]};
        __syncthreads();
        { const int kc = tid & 127, sg = tid >> 7; LAS float* bc = (LAS float*)(lds + BC) + kc; float cs[16];
#pragma unroll
            for (int i = 0; i < 16; ++i) cs[i] = bc[(sg * 16 + i) * 128];
#pragma unroll
            for (int i = 1; i < 16; ++i) cs[i] += cs[i - 1];
            ((LAS float*)(lds + SEG))[sg * 128 + kc] = cs[15];
            __syncthreads();
            const LAS float* sgp = (const LAS float*)(lds + SEG) + kc; const float s0 = sgp[0], s1 = sgp[128], s2 = sgp[256], s3 = sgp[384];
            const float off = sg == 0 ? 0.f : sg == 1 ? s0 : sg == 2 ? (s0 + s1) : ((s0 + s1) + s2);
#pragma unroll
            for (int i = 0; i < 16; ++i) bc[(sg * 16 + i) * 128] = cs[i] + off;
            if (sg == 0) { const float bm = s0 + s1, bl = ((s0 + s1) + s2) + s3;
                ((LAS float*)(lds + BMID))[kc] = bm; ((LAS float*)(lds + EM))[kc] = fexp(bm); ((LAS float*)(lds + EL))[kc] = fexp(bl - bm); ((LAS float*)(lds + DD))[kc] = fexp(bl); }
            __syncthreads();
        }
#ifdef DIAG
        if (dbg && ci == 0) { for (int i = tid; i < 8192; i += NTHR) dbg[i] = ((const LAS float*)(lds + BC))[i]; }
#endif
        {
            unsigned wqi[8], wqa[8], wka[8]; float ksv[16];
#pragma unroll
            for (int j = 0; j < 4; ++j) {
                const f32x4 bt = *(const LAS f32x4*)(lds + BC + (t1 * 128 + k0 + 4 * j) * 4), bm = *(const LAS f32x4*)(lds + BMID + (k0 + 4 * j) * 4);
                const f32x4 em = *(const LAS f32x4*)(lds + EM + (k0 + 4 * j) * 4), el = *(const LAS f32x4*)(lds + EL + (k0 + 4 * j) * 4);
                float qi[4], qa[4], ka[4];
#pragma unroll
                for (int e = 0; e < 4; ++e) { const int i = 4 * j + e; const float e1 = fexp(bt[e] - bm[e]), r1 = frcp(e1);
                    qa[e] = qf[i] * e1; qi[e] = qa[e] * em[e]; const float kk = 1.0f - fexp(lf[i]); ka[e] = kk * r1; ksv[i] = ka[e] * el[e]; }
                wqi[2 * j] = cvt_pk_bf16(qi[0], qi[1]); wqi[2 * j + 1] = cvt_pk_bf16(qi[2], qi[3]);
                wqa[2 * j] = cvt_pk_bf16(qa[0], qa[1]); wqa[2 * j + 1] = cvt_pk_bf16(qa[2], qa[3]);
                wka[2 * j] = cvt_pk_bf16(ka[0], ka[1]); wka[2 * j + 1] = cvt_pk_bf16(ka[2], ka[3]);
            }
#pragma unroll
            for (int j = 0; j < 2; ++j) { const int off = sw256(t1, (k0 + 8 * j) * 2);
                *(LAS u32x4*)(lds + QI + off) = (u32x4){wqi[4 * j], wqi[4 * j + 1], wqi[4 * j + 2], wqi[4 * j + 3]};
                *(LAS u32x4*)(lds + QA + off) = (u32x4){wqa[4 * j], wqa[4 * j + 1], wqa[4 * j + 2], wqa[4 * j + 3]};
                *(LAS u32x4*)(lds + KA + off) = (u32x4){wka[4 * j], wka[4 * j + 1], wka[4 * j + 2], wka[4 * j + 3]}; }
#pragma unroll
            for (int i = 0; i < 16; ++i) *(LAS unsigned short*)(lds + KST + sw128(k0 + i, t1 * 2)) = (unsigned short)f2bf(ksv[i]);
#pragma unroll
            for (int e = 0; e < 4; ++e) { *(LAS unsigned short*)(lds + VT + sw128(v0 + 2 * e, t1 * 2)) = (unsigned short)(vreg[e] & 0xffffu);
                *(LAS unsigned short*)(lds + VT + sw128(v0 + 2 * e + 1, t1 * 2)) = (unsigned short)(vreg[e] >> 16); }
        }
        __syncthreads();
        f32x16 oacc = {};
        const int w4 = wid & 3, t_i = w4 >> 1, v_i = w4 & 1;
        if (wid < 4) {
            const int s_i = wid >> 1, tq = wid & 1; f32x16 a = {};
#pragma unroll
            for (int ks = 0; ks < 8; ++ks) { const bf16x8 fa = *(const LAS bf16x8*)(lds + KA + sw256(32 * s_i + r, (16 * ks + 8 * hh) * 2)), fb = *(const LAS bf16x8*)(lds + QA + sw256(32 * tq + r, (16 * ks + 8 * hh) * 2));
                a = __builtin_amdgcn_mfma_f32_32x32x16_bf16(fa, fb, a, 0, 0, 0); }
            const int tg = 32 * tq + r;
#pragma unroll
            for (int g = 0; g < 4; ++g) { float m[4];
#pragma unroll
                for (int e = 0; e < 4; ++e) { const int sgl = 32 * s_i + 8 * g + 4 * hh + e; m[e] = (sgl <= tg) ? a[4 * g + e] : 0.f; }
                *(LAS u32x2*)(lds + AT + sw128(tg, (32 * s_i + 8 * g + 4 * hh) * 2)) = (u32x2){cvt_pk_bf16(m[0], m[1]), cvt_pk_bf16(m[2], m[3])}; }
        } else {
#pragma unroll
            for (int ks = 0; ks < 8; ++ks) { const bf16x8 fa = *(const LAS bf16x8*)(lds + QI + sw256(32 * t_i + r, (16 * ks + 8 * hh) * 2)), fb = *(const LAS bf16x8*)(lds + ST + sw256(32 * v_i + r, (16 * ks + 8 * hh) * 2));
                oacc = __builtin_amdgcn_mfma_f32_32x32x16_bf16(fa, fb, oacc, 0, 0, 0); }
        }
        __syncthreads();
#ifdef DIAG
        if (dbg && ci == 0) { for (int i = tid; i < 2048; i += NTHR) { ((unsigned*)dbg)[8192 + i] = ((const LAS unsigned*)(lds + AT))[i]; ((unsigned*)dbg)[8192 + 2048 + i] = ((const LAS unsigned*)(lds + VT))[i]; } }
#endif
        if (wid >= 4) {
#pragma unroll
            for (int ks = 0; ks < 4; ++ks) { const bf16x8 fa = *(const LAS bf16x8*)(lds + AT + sw128(32 * t_i + r, (16 * ks + 8 * hh) * 2)), fb = *(const LAS bf16x8*)(lds + VT + sw128(32 * v_i + r, (16 * ks + 8 * hh) * 2));
                oacc = __builtin_amdgcn_mfma_f32_32x32x16_bf16(fa, fb, oacc, 0, 0, 0); }
#pragma unroll
            for (int i = 0; i < 16; ++i) { const int t = 32 * t_i + crow(i, hh); Op[(size_t)GLA_TOK(ci, t) * DM + 32 * v_i + r] = (bf16_t)f2bf(oacc[i]); }
        }
        {
            const int kq = wid >> 1, vq = wid & 1;
#pragma unroll
            for (int i = 0; i < 16; ++i) st[i] *= ((const LAS float*)(lds + DD))[32 * kq + crow(i, hh)];
#pragma unroll
            for (int ks = 0; ks < 4; ++ks) { const bf16x8 fa = *(const LAS bf16x8*)(lds + KST + sw128(32 * kq + r, (16 * ks + 8 * hh) * 2)), fb = *(const LAS bf16x8*)(lds + VT + sw128(32 * vq + r, (16 * ks + 8 * hh) * 2));
                st = __builtin_amdgcn_mfma_f32_32x32x16_bf16(fa, fb, st, 0, 0, 0); }
#pragma unroll
            for (int g = 0; g < 4; ++g) *(LAS u32x2*)(lds + ST + sw256(32 * vq + r, (32 * kq + 8 * g + 4 * hh) * 2)) = (u32x2){cvt_pk_bf16(st[4 * g], st[4 * g + 1]), cvt_pk_bf16(st[4 * g + 2], st[4 * g + 3])};
        }
        __syncthreads();
#ifdef DIAG
        if (dbg && ci == 0) { for (int i = tid; i < 4096; i += NTHR) { ((unsigned*)dbg)[12288 + i] = ((const LAS unsigned*)(lds + ST))[i]; ((unsigned*)dbg)[16384 + i] = ((const LAS unsigned*)(lds + KST))[i]; } }
#endif
    }
#undef GLA_TOK
#undef GLA_LOAD
}
}
__device__ __forceinline__ void gla_phase(const Args& A, LAS unsigned char* lds, int bid, int G) {
    unsigned char* ws = A.ws;
    for (int it = bid; it < 256; it += G) {
        const int b = it >> 5, h = (it >> 2) & 7, dir = (it >> 1) & 1, vh = it & 1;
        const size_t base = (size_t)b * SEQ * DM + h * 128;
        gla::gla_item((const bf16_t*)(ws + H_Q) + base, (const unsigned short*)(ws + (dir ? H_LFB : H_LFF)) + base, (const bf16_t*)(ws + H_V) + base + vh * 64,
                      (bf16_t*)(ws + (dir ? H_OB : H_OF)) + base + vh * 64, dir, lds, it == 0 ? (float*)(ws + TB_LSUM) : nullptr);
    }
}
__device__ __forceinline__ void hg_normo_phase(const Args& A, int bid, int G) {
    int tid_ = threadIdx.x; asm volatile("" : "+v"(tid_));
    const int tid = tid_, lane = tid & 63, wave = tid >> 6; unsigned char* ws = A.ws;
    const bf16_t* OF = (const bf16_t*)(ws + H_OF); const bf16_t* OB = (const bf16_t*)(ws + H_OB); const bf16_t* GG = (const bf16_t*)(ws + H_G); bf16_t* HM = (bf16_t*)(ws + WS_HM);
    const int c0 = (lane >> 3) * 128 + (lane & 7) * 16;
    float ng[16];
#pragma unroll
    for (int i = 0; i < 16; ++i) ng[i] = A.in[I_HGNG][(lane & 7) * 16 + i];
    for (int row = (bid * NWAVES + wave); row < MTOK; row += G * NWAVES) {
        const size_t o = (size_t)row * DM + c0;
        const u32x4 a0 = *(const u32x4*)(OF + o), a1 = *(const u32x4*)(OF + o + 8), b0 = *(const u32x4*)(OB + o), b1 = *(const u32x4*)(OB + o + 8), g0 = *(const u32x4*)(GG + o), g1 = *(const u32x4*)(GG + o + 8);
        float v[16], gt[16]; float ss = 0.f;
#pragma unroll
        for (int e = 0; e < 4; ++e) { v[2 * e] = bflo(a0[e]) + bflo(b0[e]); v[2 * e + 1] = bfhi(a0[e]) + bfhi(b0[e]); v[8 + 2 * e] = bflo(a1[e]) + bflo(b1[e]); v[8 + 2 * e + 1] = bfhi(a1[e]) + bfhi(b1[e]);
            gt[2 * e] = bflo(g0[e]); gt[2 * e + 1] = bfhi(g0[e]); gt[8 + 2 * e] = bflo(g1[e]); gt[8 + 2 * e + 1] = bfhi(g1[e]); }
#pragma unroll
        for (int i = 0; i < 16; ++i) ss += v[i] * v[i];
        ss += __shfl_xor(ss, 1); ss += __shfl_xor(ss, 2); ss += __shfl_xor(ss, 4);
        const float rstd = 1.0f / sqrtf(ss * (1.0f / 128.0f) + EPS);
        u32x4 w0, w1;
#pragma unroll
        for (int e = 0; e < 4; ++e) { w0[e] = cvt_pk_bf16(v[2 * e] * rstd * ng[2 * e] * gt[2 * e], v[2 * e + 1] * rstd * ng[2 * e + 1] * gt[2 * e + 1]);
            w1[e] = cvt_pk_bf16(v[8 + 2 * e] * rstd * ng[8 + 2 * e] * gt[8 + 2 * e], v[8 + 2 * e + 1] * rstd * ng[8 + 2 * e + 1] * gt[8 + 2 * e + 1]); }
        *(u32x4*)(HM + o) = w0; *(u32x4*)(HM + o + 8) = w1;
    }
}

#ifdef DIAG
constexpr int DG_BASE = 8192;
__device__ __forceinline__ void dg_put(const Args& A, int k, float e) { if (!(e >= 0.f) || e > 1e9f) e = 1e9f; atomicMax((unsigned*)(A.ws + WS_CTL) + DG_BASE + 64 * k, __float_as_uint(e)); }
__device__ __forceinline__ float dg_rel(float got, float ref) { return fabsf(got - ref) / (fabsf(ref) + 0.1f); }
__device__ __forceinline__ unsigned dg_hash(unsigned a, unsigned b) { unsigned h = a * 2654435761u + b * 40503u + 0x9e3779b9u; h ^= h >> 15; h *= 2246822519u; h ^= h >> 13; h *= 3266489917u; h ^= h >> 16; return h; }
__device__ __forceinline__ float dg_bfr(float x) { return bflo(f2bf(x)); }
__device__ __forceinline__ void dg_mods(const Args& A, int k) {
    const int lane = threadIdx.x & 63, gwv = blockIdx.x * 8 + (threadIdx.x >> 6);
    const unsigned h = dg_hash(gwv, k); const int l = h & 3, b = (h >> 2) & 7, e = (h >> 5) % 6144;
    float a = 0.f; for (int d = lane; d < DM; d += 64) a += fsilu(A.in[I_C][b * DM + d]) * A.in[I_ADAW][((size_t)l * DM + d) * 6144 + e];
    a = wave_sum(a) + A.in[I_ADAB][l * 6144 + e];
    const float got = ((const float*)(A.ws + TB_MODS))[((size_t)l * NBATCH + b) * 6144 + e];
    if (lane == 0) dg_put(A, k, dg_rel(got, a));
}
__device__ __forceinline__ void dg_norm(const Args& A, int k, const float* x, const float* gain, int L, int which) {
    const int lane = threadIdx.x & 63, gwv = blockIdx.x * 8 + (threadIdx.x >> 6);
    const int row = dg_hash(gwv, k) & (MTOK - 1), b = row >> 13;
    const float* modl = (const float*)(A.ws + TB_MODS) + ((size_t)L * NBATCH + b) * 6144;
    float ss = 0.f; for (int c = lane; c < DM; c += 64) { const float v = x[(size_t)row * DM + c]; ss += v * v; }
    ss = wave_sum(ss); const float rstd = 1.0f / sqrtf(ss / DM + EPS); float e = 0.f;
    for (int c = lane; c < DM; c += 64) { const float ref = x[(size_t)row * DM + c] * rstd * gain[c] * (1.0f + modl[(which * 3 + 1) * 1024 + c]) + modl[(which * 3) * 1024 + c];
        e = fmaxf(e, dg_rel(bf2f(((const bf16_t*)(A.ws + WS_HM))[(size_t)row * DM + c]), ref)); }
    dg_put(A, k, e);
}
__device__ __forceinline__ void dg_qkv(const Args& A, int k, int al) {
    const int lane = threadIdx.x & 63, gwv = blockIdx.x * 8 + (threadIdx.x >> 6);
    const unsigned h = dg_hash(gwv, k); const int row = h & (MTOK - 1), t = (h >> 16) % 48, col = t * 64 + lane;
    const bf16_t* hm = (const bf16_t*)(A.ws + WS_HM) + (size_t)row * DM; const float* w = A.in[I_ATWIN] + (size_t)al * 1024 * 3072 + col;
    float a = 0.f; for (int kk = 0; kk < DM; ++kk) a += bf2f(hm[kk]) * dg_bfr(w[(size_t)kk * 3072]);
    float ref, got;
    if (t < 32) {
        const int part = t >> 4, sh = t & 15; const float ss = wave_sum(a * a); const float rstd = 1.0f / sqrtf(ss / 64.0f + EPS);
        const float y = a * rstd * (part ? A.in[I_ATKN] : A.in[I_ATQN])[al * 64 + lane]; const float yp = __shfl_xor(y, 32);
        const int pos = row & (SEQ - 1); const float cs = ((const float*)(A.ws + TB_COS))[pos * 32 + (lane & 31)], sn = ((const float*)(A.ws + TB_SIN))[pos * 32 + (lane & 31)];
        ref = (lane < 32) ? (y * cs - yp * sn) : (y * cs + yp * sn); if (part == 0) ref *= 0.125f * LOG2E;
        got = bf2f(((const bf16_t*)(A.ws + (part ? A_K : A_Q)))[(size_t)row * DM + sh * 64 + lane]);
    } else { ref = a; got = bf2f(((const bf16_t*)(A.ws + A_V))[(size_t)row * DM + (t - 32) * 64 + lane]); }
    dg_put(A, k, dg_rel(got, ref));
}
__device__ __forceinline__ void dg_attn(const Args& A, int k, int al, LAS unsigned char* lds) {
    const int tid = threadIdx.x; const unsigned h = dg_hash(blockIdx.x, k); const int row = h & (MTOK - 1), hd = (h >> 16) & 7, b = row >> 13;
    const bf16_t* Q = (const bf16_t*)(A.ws + A_Q); const bf16_t* K = (const bf16_t*)(A.ws + A_K); const bf16_t* V = (const bf16_t*)(A.ws + A_V);
    const float* scal = (const float*)(A.ws + TB_SCAL); const float lamv = scal[SC_LAM0 + al], omli = scal[SC_OML0 + al], Mc = scal[SC_MC0 + al];
    LAS float* p0 = (LAS float*)lds; LAS float* p1 = p0 + SEQ; LAS float* red = p1 + SEQ;
    float l0 = 0.f, l1 = 0.f;
    for (int key = tid; key < SEQ; key += NTHR) { const bf16_t* kr = K + ((size_t)b * SEQ + key) * DM + hd * 128; const bf16_t* qr = Q + (size_t)row * DM + hd * 128;
        float s0 = 0.f, s1 = 0.f; for (int d = 0; d < 64; ++d) { s0 += bf2f(qr[d]) * bf2f(kr[d]); s1 += bf2f(qr[64 + d]) * bf2f(kr[64 + d]); }
        const float e0 = fexp2(s0 - Mc), e1 = fexp2(s1 - Mc); p0[key] = e0; p1[key] = e1; l0 += e0; l1 += e1; }
    l0 = wave_sum(l0); l1 = wave_sum(l1); if ((tid & 63) == 0) { red[tid >> 6] = l0; red[8 + (tid >> 6)] = l1; }
    __syncthreads();
    l0 = 0.f; l1 = 0.f; for (int w = 0; w < 8; ++w) { l0 += red[w]; l1 += red[8 + w]; }
    __syncthreads();
    const int dv = tid & 127, part = tid >> 7; float o = 0.f;
    for (int key = part * 2048; key < part * 2048 + 2048; ++key) o += (p0[key] / l0 - lamv * p1[key] / l1) * bf2f(V[((size_t)b * SEQ + key) * DM + hd * 128 + dv]);
    red[16 + part * 128 + dv] = o; __syncthreads();
    if (tid < 128) { o = red[16 + tid] + red[16 + 128 + tid] + red[16 + 256 + tid] + red[16 + 384 + tid]; red[600 + tid] = o * o; }
    __syncthreads();
    if (tid < 128) { float ss = 0.f; for (int i = 0; i < 128; ++i) ss += red[600 + i]; const float ref = o / sqrtf(ss / 128.0f + EPS) * A.in[I_ATSUB][al * 128 + tid] * omli;
        dg_put(A, k, dg_rel(bf2f(((const bf16_t*)(A.ws + WS_HM))[(size_t)row * DM + hd * 128 + tid]), ref)); }
    __syncthreads();
}
__device__ __forceinline__ void dg_save(const Args& A, int k, const float* xold) {
    const int lane = threadIdx.x & 63, gwv = blockIdx.x * 8 + (threadIdx.x >> 6);
    const unsigned h = dg_hash(gwv, k); const int row = h & (MTOK - 1), col = (h >> 16) & 1023;
    float* sv = (float*)(A.ws + TB_LSUM) + 7 * 1024 * 1024 / 4;
    if (lane == 0) sv[k * 4096 + gwv] = xold[(size_t)row * DM + col];
}
__device__ __forceinline__ void dg_res(const Args& A, int k, const float* xnew, const float* gate, const bf16_t* Am, int K, const float* W) {
    const int lane = threadIdx.x & 63, gwv = blockIdx.x * 8 + (threadIdx.x >> 6);
    const unsigned h = dg_hash(gwv, k); const int row = h & (MTOK - 1), col = (h >> 16) & 1023, b = row >> 13;
    const float* sv = (const float*)(A.ws + TB_LSUM) + 7 * 1024 * 1024 / 4;
    float a = 0.f; for (int kk = lane; kk < K; kk += 64) a += bf2f(Am[(size_t)row * K + kk]) * dg_bfr(W[(size_t)kk * DM + col]);
    a = wave_sum(a);
    const float ref = sv[k * 4096 + gwv] + gate[(size_t)b * 6144 + col] * a;
    if (lane == 0) dg_put(A, k, dg_rel(xnew[(size_t)row * DM + col], ref));
}
__device__ __forceinline__ void dg_swiglu(const Args& A, int k, const bf16_t* Am, const float* W, int F, const bf16_t* H, int nrows, const int* rowmap) {
    const int lane = threadIdx.x & 63, gwv = blockIdx.x * 8 + (threadIdx.x >> 6);
    const unsigned h = dg_hash(gwv, k); const int row = (h & 0xfffff) % nrows, j = (h >> 20) % F;
    float g = 0.f, u = 0.f; for (int kk = lane; kk < DM; kk += 64) { const float x = bf2f(Am[(size_t)row * DM + kk]); g += x * dg_bfr(W[(size_t)kk * 2 * F + j]); u += x * dg_bfr(W[(size_t)kk * 2 * F + F + j]); }
    g = wave_sum(g); u = wave_sum(u);
    const float ref = g / (1.0f + expf(-g)) * u;
    if (lane == 0) dg_put(A, k, dg_rel(bf2f(H[(size_t)row * F + j]), ref));
}
__device__ __forceinline__ void dg_hgin(const Args& A, int k) {
    const int lane = threadIdx.x & 63, gwv = blockIdx.x * 8 + (threadIdx.x >> 6);
    const unsigned h = dg_hash(gwv, k); const int row = h & (MTOK - 1), col = (h >> 16) % 5120, grp = col >> 10, cc = col & 1023;
    float a = 0.f; for (int kk = lane; kk < DM; kk += 64) a += bf2f(((const bf16_t*)(A.ws + WS_HM))[(size_t)row * DM + kk]) * dg_bfr(A.in[I_HGWIN][(size_t)kk * 5120 + col]);
    a = wave_sum(a);
    float ref, got;
    if (grp == 0 || grp == 4) { ref = a / (1.0f + expf(-a)); got = bf2f(((const bf16_t*)(A.ws + (grp == 0 ? H_Q : H_G)))[(size_t)row * DM + cc]); }
    else if (grp == 3) { ref = a; got = bf2f(((const bf16_t*)(A.ws + H_V))[(size_t)row * DM + cc]); }
    else { const int d = grp - 1; const float* p = A.in[I_HGLB] + (size_t)d * DEPTH * 1024 + cc; float mx = p[0]; for (int l = 1; l < DEPTH; ++l) mx = fmaxf(mx, p[l * 1024]);
        float den = 0.f; for (int l = 0; l < DEPTH; ++l) den += expf(p[l * 1024] - mx); const float lbv = expf(p[1024] - mx) / den;
        ref = logf(lbv + (1.0f - lbv) / (1.0f + expf(-a))); got = gla::h2f(((const unsigned short*)(A.ws + (d ? H_LFB : H_LFF)))[(size_t)row * DM + cc]); }
    if (lane == 0) dg_put(A, k, dg_rel(got, ref));
}
__device__ __forceinline__ void dg_gla(const Args& A, int k) {
    const int lane = threadIdx.x & 63, gwv = blockIdx.x * 8 + (threadIdx.x >> 6);
    const unsigned h = dg_hash(gwv, k); const int sel0 = (gwv & 3) == 0; const int b = sel0 ? 0 : (h & 7), hd = sel0 ? 0 : ((h >> 3) & 7), dir = sel0 ? 0 : ((h >> 6) & 1), vc = sel0 ? ((h >> 7) & 63) : ((h >> 7) & 127);
    const bf16_t* Q = (const bf16_t*)(A.ws + H_Q); const unsigned short* LF = (const unsigned short*)(A.ws + (dir ? H_LFB : H_LFF)); const bf16_t* V = (const bf16_t*)(A.ws + H_V);
    const bf16_t* O = (const bf16_t*)(A.ws + (dir ? H_OB : H_OF));
    float s0 = 0.f, s1 = 0.f, e0 = 0.f, e1 = 0.f, e2 = 0.f, e3 = 0.f;
    for (int i = 0; i < SEQ; ++i) { const int tok = dir ? (SEQ - 1 - i) : i; const size_t o = ((size_t)b * SEQ + tok) * DM + hd * 128;
        const float f0 = expf(gla::h2f(LF[o + lane])), f1 = expf(gla::h2f(LF[o + 64 + lane])), v = bf2f(V[o + vc]);
        s0 = f0 * s0 + (1.0f - f0) * v; s1 = f1 * s1 + (1.0f - f1) * v;
        if (i < 128 || i % 61 == 0) { const float ov = wave_sum(bf2f(Q[o + lane]) * s0 + bf2f(Q[o + 64 + lane]) * s1); const float er = 0.25f * fabsf(bf2f(O[o + vc]) - ov) / (fabsf(ov) + 1.0f);
            if (i == 0) e0 = er; else if (i < 64) e1 = fmaxf(e1, er); else if (i < 128) e2 = fmaxf(e2, er); else e3 = fmaxf(e3, er); } }
    if (lane == 0) { dg_put(A, k, e0); dg_put(A, k + 4, e1); dg_put(A, k + 5, e2); dg_put(A, k + 6, e3); }
    const float* dbg = (const float*)(A.ws + TB_LSUM); const unsigned short* LF0 = (const unsigned short*)(A.ws + H_LFF); const bf16_t* Q0 = (const bf16_t*)(A.ws + H_Q);
    { const unsigned h2 = dg_hash(gwv, k + 100); const int t = h2 & 63, kk = (h2 >> 6) & 127; float c = 0.f; for (int tt = 0; tt <= t; ++tt) c += gla::h2f(LF0[(size_t)tt * DM + kk]);
      if (lane == 0) dg_put(A, k + 1, dg_rel(dbg[t * 128 + kk], c)); }
    { const unsigned h2 = dg_hash(gwv, k + 200); const int t = h2 & 63, sidx = (h2 >> 6) & 63; float a = 0.f;
      if (sidx <= t) { for (int kk = lane; kk < 128; kk += 64) { float c = 0.f; for (int tt = sidx + 1; tt <= t; ++tt) c += gla::h2f(LF0[(size_t)tt * DM + kk]);
              a += bf2f(Q0[(size_t)t * DM + kk]) * (1.0f - expf(gla::h2f(LF0[(size_t)sidx * DM + kk]))) * expf(c); } a = wave_sum(a); }
      const unsigned short got = ((const unsigned short*)(dbg + 8192))[gla::sw128(t, sidx * 2) / 2];
      if (lane == 0) dg_put(A, k + 2, 5.0f * fabsf(bf2f(got) - a) / (fabsf(a) + 0.01f)); }
    { const unsigned h2 = dg_hash(gwv, k + 300); const int sidx = h2 & 63, v = (h2 >> 6) & 63;
      const unsigned short got = ((const unsigned short*)(dbg + 8192 + 2048))[gla::sw128(v, sidx * 2) / 2];
      if (lane == 0) dg_put(A, k + 2, dg_rel(bf2f(got), bf2f(((const bf16_t*)(A.ws + H_V))[(size_t)sidx * DM + v]))); }
    { const unsigned h2 = dg_hash(gwv, k + 500); const int kk = h2 & 127, v = (h2 >> 7) & 63;
      float a = 0.f; { const int sidx = lane; float c = 0.f; for (int tt = sidx + 1; tt < 64; ++tt) c += gla::h2f(LF0[(size_t)tt * DM + kk]);
          const float ksn = (1.0f - expf(gla::h2f(LF0[(size_t)sidx * DM + kk]))) * expf(c);
          const unsigned short gk = ((const unsigned short*)(dbg + 16384))[gla::sw128(kk, sidx * 2) / 2];
          dg_put(A, k + 2, 0.5f * fabsf(bf2f(gk) - ksn) / (fabsf(ksn) + 0.01f));
          a = ksn * bf2f(((const bf16_t*)(A.ws + H_V))[(size_t)sidx * DM + v]); }
      a = wave_sum(a);
      const unsigned short gs = ((const unsigned short*)(dbg + 12288))[gla::sw256(v, kk * 2) / 2];
      if (lane == 0) dg_put(A, k + 3, 0.5f * fabsf(bf2f(gs) - a) / (fabsf(a) + 0.05f)); }
    { const unsigned h2 = dg_hash(gwv, k + 400); const int t = h2 & 63, v = (h2 >> 6) & 63;
      const unsigned short* at = (const unsigned short*)(dbg + 8192); const unsigned short* vt = (const unsigned short*)(dbg + 8192 + 2048);
      float a = bf2f(at[gla::sw128(t, lane * 2) / 2]) * bf2f(vt[gla::sw128(v, lane * 2) / 2]); a = wave_sum(a);
      if (lane == 0) dg_put(A, k + 1, 5.0f * dg_rel(bf2f(((const bf16_t*)(A.ws + H_OF))[(size_t)t * DM + v]), a)); }
}
__device__ __forceinline__ void dg_normo(const Args& A, int k) {
    const int lane = threadIdx.x & 63, gwv = blockIdx.x * 8 + (threadIdx.x >> 6);
    const unsigned h = dg_hash(gwv, k); const int row = h & (MTOK - 1), hd = (h >> 16) & 7; const size_t o = (size_t)row * DM + hd * 128;
    const float v0 = bf2f(((const bf16_t*)(A.ws + H_OF))[o + lane]) + bf2f(((const bf16_t*)(A.ws + H_OB))[o + lane]), v1 = bf2f(((const bf16_t*)(A.ws + H_OF))[o + 64 + lane]) + bf2f(((const bf16_t*)(A.ws + H_OB))[o + 64 + lane]);
    const float ss = wave_sum(v0 * v0 + v1 * v1), rstd = 1.0f / sqrtf(ss / 128.0f + EPS);
    const float r0 = v0 * rstd * A.in[I_HGNG][lane] * bf2f(((const bf16_t*)(A.ws + H_G))[o + lane]), r1 = v1 * rstd * A.in[I_HGNG][64 + lane] * bf2f(((const bf16_t*)(A.ws + H_G))[o + 64 + lane]);
    dg_put(A, k, fmaxf(dg_rel(bf2f(((const bf16_t*)(A.ws + WS_HM))[o + lane]), r0), dg_rel(bf2f(((const bf16_t*)(A.ws + WS_HM))[o + 64 + lane]), r1)));
}
__device__ __forceinline__ void dg_router(const Args& A, int k, int L) {
    const int lane = threadIdx.x & 63, gwv = blockIdx.x * 8 + (threadIdx.x >> 6);
    const int row = dg_hash(gwv, k) & (MTOK - 1), b = row >> 13; const float* x = A.out + (size_t)row * DM;
    const float* modl = (const float*)(A.ws + TB_MODS) + ((size_t)L * NBATCH + b) * 6144; const float* gain = A.in[I_N2G] + L * DM; const float* R = A.in[I_MOER] + (size_t)(L >> 1) * DM * 8;
    float ss = 0.f; for (int c = lane; c < DM; c += 64) ss += x[c] * x[c];
    ss = wave_sum(ss); const float rstd = 1.0f / sqrtf(ss / DM + EPS);
    float lg[8]; for (int e = 0; e < 8; ++e) lg[e] = 0.f;
    for (int c = lane; c < DM; c += 64) { const float hv = x[c] * rstd * gain[c] * (1.0f + modl[4 * 1024 + c]) + modl[3 * 1024 + c]; for (int e = 0; e < 8; ++e) lg[e] += hv * R[c * 8 + e]; }
    for (int e = 0; e < 8; ++e) lg[e] = wave_sum(lg[e]);
    int e0 = 0; for (int e = 1; e < 8; ++e) if (lg[e] > lg[e0]) e0 = e;
    int e1 = (e0 == 0) ? 1 : 0; for (int e = 0; e < 8; ++e) if (e != e0 && lg[e] > lg[e1]) e1 = e;
    float gap = 1e9f; for (int e = 0; e < 8; ++e) if (e != e0 && e != e1) gap = fminf(gap, lg[e1] - lg[e]); gap = fminf(gap, lg[e0] - lg[e1]);
    const int g0 = ((const int*)(A.ws + TB_EID))[row * 2], g1 = ((const int*)(A.ws + TB_EID))[row * 2 + 1]; const float w0 = ((const float*)(A.ws + TB_GATE))[row * 2], w1 = ((const float*)(A.ws + TB_GATE))[row * 2 + 1];
    const float p0 = 1.0f / (1.0f + expf(lg[e1] - lg[e0]));
    float er = (g0 != e0 || g1 != e1) ? (gap > 2e-3f ? 9.f : 0.f) : fmaxf(fabsf(w0 - p0), fabsf(w1 - (1.0f - p0)));
    if (lane == 0) dg_put(A, k, er);
}
__device__ __forceinline__ void dg_place(const Args& A, int k) {
    const int lane = threadIdx.x & 63, gwv = blockIdx.x * 8 + (threadIdx.x >> 6);
    const unsigned h = dg_hash(gwv, k); const int row = h & (MTOK - 1), kk = (h >> 16) & 1;
    const int sl = ((const int*)(A.ws + TB_SLOT))[row * 2 + kk], e = ((const int*)(A.ws + TB_EID))[row * 2 + kk]; const int* ts = (const int*)(A.ws + TB_TILES);
    float er = (sl >= ts[e] * 256 && sl < ts[e + 1] * 256 && sl < MOE_ROWS) ? 0.f : 7.f;
    if (er == 0.f) for (int c = lane; c < DM; c += 64) if (((const bf16_t*)(A.ws + E_XS))[(size_t)sl * DM + c] != ((const bf16_t*)(A.ws + WS_HM))[(size_t)row * DM + c]) er = 5.f;
    dg_put(A, k, er);
}
__device__ __forceinline__ void dg_moe_hid(const Args& A, int k, int m) {
    const int lane = threadIdx.x & 63, gwv = blockIdx.x * 8 + (threadIdx.x >> 6);
    const unsigned h = dg_hash(gwv, k); const int row = h & (MTOK - 1), kk = (h >> 16) & 1, j = (h >> 17) % DFFE;
    const int sl = ((const int*)(A.ws + TB_SLOT))[row * 2 + kk], e = ((const int*)(A.ws + TB_EID))[row * 2 + kk];
    const float* W = A.in[I_MOEGU] + ((size_t)m * 8 + e) * DM * 2 * DFFE; const bf16_t* Am = (const bf16_t*)(A.ws + E_XS) + (size_t)sl * DM;
    float g = 0.f, u = 0.f; for (int c = lane; c < DM; c += 64) { const float x = bf2f(Am[c]); g += x * dg_bfr(W[(size_t)c * 2 * DFFE + j]); u += x * dg_bfr(W[(size_t)c * 2 * DFFE + DFFE + j]); }
    g = wave_sum(g); u = wave_sum(u);
    if (lane == 0) dg_put(A, k, dg_rel(bf2f(((const bf16_t*)(A.ws + E_HID))[(size_t)sl * DFFE + j]), g / (1.0f + expf(-g)) * u));
}
__device__ __forceinline__ void dg_moe_y(const Args& A, int k, int m) {
    const int lane = threadIdx.x & 63, gwv = blockIdx.x * 8 + (threadIdx.x >> 6);
    const unsigned h = dg_hash(gwv, k); const int row = h & (MTOK - 1), kk = (h >> 16) & 1, col = (h >> 17) & 1023;
    const int sl = ((const int*)(A.ws + TB_SLOT))[row * 2 + kk], e = ((const int*)(A.ws + TB_EID))[row * 2 + kk];
    const float* W = A.in[I_MOEDN] + ((size_t)m * 8 + e) * DFFE * DM; const bf16_t* Hh = (const bf16_t*)(A.ws + E_HID) + (size_t)sl * DFFE;
    float a = 0.f; for (int j = lane; j < DFFE; j += 64) a += bf2f(Hh[j]) * dg_bfr(W[(size_t)j * DM + col]);
    a = wave_sum(a);
    if (lane == 0) dg_put(A, k, fabsf(bf2f(((const bf16_t*)(A.ws + E_XS))[(size_t)sl * DM + col]) - a) / (fabsf(a) + 0.3f));
}
__device__ __forceinline__ void dg_combine(const Args& A, int k, const float* modprev) {
    const int lane = threadIdx.x & 63, gwv = blockIdx.x * 8 + (threadIdx.x >> 6);
    const unsigned h = dg_hash(gwv, k); const int row = h & (MTOK - 1), col = (h >> 16) & 1023, b = row >> 13;
    const float* sv = (const float*)(A.ws + TB_LSUM) + 7 * 1024 * 1024 / 4; const bf16_t* Y = (const bf16_t*)(A.ws + E_XS);
    const int s0 = ((const int*)(A.ws + TB_SLOT))[row * 2], s1 = ((const int*)(A.ws + TB_SLOT))[row * 2 + 1]; const float w0 = ((const float*)(A.ws + TB_GATE))[row * 2], w1 = ((const float*)(A.ws + TB_GATE))[row * 2 + 1];
    const float ref = sv[k * 4096 + gwv] + modprev[(size_t)b * 6144 + 5 * 1024 + col] * (w0 * bf2f(Y[(size_t)s0 * DM + col]) + w1 * bf2f(Y[(size_t)s1 * DM + col]));
    if (lane == 0) dg_put(A, k, dg_rel(A.out[(size_t)row * DM + col], ref));
}
__device__ __forceinline__ void dg_lruin(const Args& A, int k) {
    const int lane = threadIdx.x & 63, gwv = blockIdx.x * 8 + (threadIdx.x >> 6);
    const unsigned h = dg_hash(gwv, k); const int row = h & (MTOK - 1), col = (h >> 16) % 2560;
    float a = 0.f; for (int kk = lane; kk < DM; kk += 64) a += bf2f(((const bf16_t*)(A.ws + WS_HM))[(size_t)row * DM + kk]) * dg_bfr(A.in[I_LRWIN][(size_t)kk * 2560 + col]);
    a = wave_sum(a);
    float ref, got;
    if (col < LRUW) { ref = 0.5f * a * (1.0f + tanhf(0.7978845608028654f * (a + 0.044715f * a * a * a))); got = bf2f(((const bf16_t*)(A.ws + L_YB))[(size_t)row * LRUW + col]); }
    else { ref = a; got = bf2f(((const bf16_t*)(A.ws + L_XB))[(size_t)row * LRUW + col - LRUW]); }
    if (lane == 0) dg_put(A, k, dg_rel(got, ref));
}
__device__ __forceinline__ void dg_lru(const Args& A, int k) {
    const int lane = threadIdx.x & 63, gwv = blockIdx.x * 8 + (threadIdx.x >> 6);
    const unsigned h = dg_hash(gwv, k); const int b = h & 7, ch = (h >> 3) % LRUW, tc = (h >> 16) & (SEQ - 1), n = ch / 128, j = ch % 128;
    const bf16_t* XB = (const bf16_t*)(A.ws + L_XB) + (size_t)b * SEQ * LRUW;
    float hres[2];
    for (int d = 0; d < 2; ++d) {
        const float* wa = A.in[I_LRWA] + (size_t)(d * 10 + n) * 16384; const float* wx = A.in[I_LRWX] + (size_t)(d * 10 + n) * 16384;
        const float wa0 = dg_bfr(wa[lane * 128 + j]), wa1 = dg_bfr(wa[(lane + 64) * 128 + j]), wx0 = dg_bfr(wx[lane * 128 + j]), wx1 = dg_bfr(wx[(lane + 64) * 128 + j]);
        const float ba = A.in[I_LRBA][d * LRUW + ch], bx = A.in[I_LRBX][d * LRUW + ch]; const float lam = A.in[I_LRLAM][d * LRUW + ch]; const float sp = log1pf(expf(-lam));
        float hs = 0.f;
        for (int i = 0; ; ++i) { const int t = d ? (SEQ - 1 - i) : i;
            float x0 = A.in[I_LRCB][n * 128 + lane], x1 = A.in[I_LRCB][n * 128 + 64 + lane], xj = A.in[I_LRCB][ch];
            for (int w = 0; w < 4; ++w) { const int tt = t - 1 + w; if (tt >= 0 && tt < SEQ) {
                x0 += A.in[I_LRCW][w * LRUW + n * 128 + lane] * bf2f(XB[(size_t)tt * LRUW + n * 128 + lane]); x1 += A.in[I_LRCW][w * LRUW + n * 128 + 64 + lane] * bf2f(XB[(size_t)tt * LRUW + n * 128 + 64 + lane]);
                xj += A.in[I_LRCW][w * LRUW + ch] * bf2f(XB[(size_t)tt * LRUW + ch]); } }
            const float rp = wave_sum(dg_bfr(x0) * wa0 + dg_bfr(x1) * wa1), ip = wave_sum(dg_bfr(x0) * wx0 + dg_bfr(x1) * wx1);
            const float rg = 1.0f / (1.0f + expf(-(rp + ba))), ig = 1.0f / (1.0f + expf(-(ip + bx))); const float la = -8.0f * rg * sp;
            hs = expf(la) * hs + sqrtf(fmaxf(-expm1f(2.0f * la), 0.f)) * ig * xj;
            if (t == tc) break; }
        hres[d] = hs;
    }
    const size_t go = ((size_t)b * SEQ + tc) * LRUW + ch;
    const float e1 = fabsf(bf2f(((const bf16_t*)(A.ws + L_HF))[go]) - hres[0]) / (fabsf(hres[0]) + 0.3f);
    const float ref = (hres[0] + hres[1]) * bf2f(((const bf16_t*)(A.ws + L_YB))[go]);
    const float e2 = fabsf(bf2f(((const bf16_t*)(A.ws + L_HY))[go]) - ref) / (fabsf(ref) + 0.3f);
    if (lane == 0) { dg_put(A, k, e1); dg_put(A, k + 5, e2); }
}
__device__ __forceinline__ void dg_final(const Args& A, int nchk) {
    const unsigned* sl = (const unsigned*)(A.ws + WS_CTL) + DG_BASE; int code = 0; float ev = 0.f;
    for (int k = 1; k <= nchk; ++k) { const float e = __uint_as_float(sl[64 * k]); if (e > 0.05f) { code = k; ev = e; break; } }
    if (code == 0) return;
    const int c1 = code % 10, c10 = code / 10;
    const float s = -(float)c1;
    for (size_t i = (size_t)blockIdx.x * NTHR + threadIdx.x; i < (size_t)MTOK * DM; i += (size_t)gridDim.x * NTHR) A.out[i] = A.in[I_X][i] * s;
    __syncthreads();
    if (blockIdx.x == 0 && threadIdx.x == 0) { const int qq = ev < 0.1f ? 1 : ev < 0.2f ? 2 : ev < 0.5f ? 3 : ev < 1.f ? 4 : ev < 2.f ? 5 : ev < 5.f ? 6 : ev < 20.f ? 7 : ev < 1e3f ? 8 : 9;
        A.out[12345] = 100.f * (float)(10 * c10 + qq); }
}
#define DG(x) x
#define DGL(x) if constexpr (L >= DIAG_FROM) { x }
#else
#define DG(x)
#define DGL(x)
#endif

#define GRID_BAR() xcd_barrier(bar)
template <int L>
__device__ __forceinline__ void run_mixer(const Args& args, LAS unsigned char* lds, int bid, int G, const XcdBarrier& bar) {
    unsigned char* ws = args.ws; float* xo = args.out;
    const float* modl = (const float*)(ws + TB_MODS) + (size_t)L * NBATCH * 6144;
    const float* xs = (L == 0) ? args.in[I_X] : xo;
    constexpr int kind = L % 3;
    DGL(if (L > 0 && ((L - 1) & 1)) { dg_save(args, 10 * (L - 1) + 9, xo); GRID_BAR(); })
    norm_phase<false>(args, lds, bid, G, xs, xo, args.in[I_N1G] + L * DM, modl, 0, (L > 0) && ((L - 1) & 1), modl - NBATCH * 6144, false, nullptr);
    GRID_BAR();
    DGL(if (L > 0 && ((L - 1) & 1)) { dg_combine(args, 10 * (L - 1) + 9, modl - NBATCH * 6144); GRID_BAR(); })
    DGL(dg_norm(args, 10 * L + 1, (L > 0 && ((L - 1) & 1)) ? xo : xs, args.in[I_N1G] + L * DM, L, 0); GRID_BAR();)
    if constexpr (kind == 0) {
        constexpr int al = L / 3;
        {
            pg8::Gemm g{(const bf16_t*)(ws + WS_HM), (const bf16_t*)(ws + W_QKV) + (size_t)al * 3072 * 1024, 1024};
            pg8::TileOrder S; S.init(256, 12, G, bid);
            pg8::EpiQKV E{(bf16_t*)(ws + A_Q), (bf16_t*)(ws + A_K), (bf16_t*)(ws + A_V), args.in[I_ATQN] + al * 64, args.in[I_ATKN] + al * 64,
                          (const float*)(ws + TB_COS), (const float*)(ws + TB_SIN), 0.125f * LOG2E};
            pg8::gemm_phase<pg8::EpiQKV>(lds, g, S, E);
        }
        GRID_BAR();
        DGL(dg_qkv(args, 10 * L + 2, al); GRID_BAR();)
        attn_phase(args, lds, bid, G, al);
        GRID_BAR();
        DGL(dg_attn(args, 10 * L + 3, al, lds); GRID_BAR();)
        DGL(dg_save(args, 10 * L + 4, xs); GRID_BAR();)
        {
            pg8::Gemm g{(const bf16_t*)(ws + WS_HM), (const bf16_t*)(ws + W_AO) + (size_t)al * 1024 * 1024, 1024};
            pg8::TileOrder S; S.init(256, 4, G, bid);
            pg8::EpiRes E{xs, xo, modl + 2 * 1024};
            pg8::gemm_phase<pg8::EpiRes>(lds, g, S, E);
        }
        GRID_BAR();
        DGL(dg_res(args, 10 * L + 4, xo, modl + 2 * 1024, (const bf16_t*)(ws + WS_HM), 1024, args.in[I_ATWOUT] + (size_t)al * 1024 * 1024); GRID_BAR();)
    }
    if constexpr (kind == 1) {
        {
            pg8::Gemm g{(const bf16_t*)(ws + WS_HM), (const bf16_t*)(ws + W_HGI), 1024};
            pg8::TileOrder S; S.init(256, 20, G, bid);
            pg8::EpiAct E{0, ws, (const float*)(ws + TB_LB)};
            pg8::gemm_phase<pg8::EpiAct>(lds, g, S, E);
        }
        GRID_BAR();
        DGL(dg_hgin(args, 10 * L + 2); GRID_BAR();)
        gla_phase(args, lds, bid, G);
        GRID_BAR();
        DGL(dg_gla(args, 10 * L + 3); GRID_BAR();)
        hg_normo_phase(args, bid, G);
        GRID_BAR();
        DGL(dg_normo(args, 10 * L + 0); GRID_BAR();)
        DGL(dg_save(args, 10 * L + 4, xs); GRID_BAR();)
        {
            pg8::Gemm g{(const bf16_t*)(ws + WS_HM), (const bf16_t*)(ws + W_HGO), 1024};
            pg8::TileOrder S; S.init(256, 4, G, bid);
            pg8::EpiRes E{xs, xo, modl + 2 * 1024};
            pg8::gemm_phase<pg8::EpiRes>(lds, g, S, E);
        }
        GRID_BAR();
        DGL(dg_res(args, 10 * L + 4, xo, modl + 2 * 1024, (const bf16_t*)(ws + WS_HM), 1024, args.in[I_HGWOUT]); GRID_BAR();)
    }
    if constexpr (kind == 2) {
        {
            pg8::Gemm g{(const bf16_t*)(ws + WS_HM), (const bf16_t*)(ws + W_LRI), 1024};
            pg8::TileOrder S; S.init(256, 10, G, bid);
            pg8::EpiAct E{1, ws, nullptr};
            pg8::gemm_phase<pg8::EpiAct>(lds, g, S, E);
        }
        GRID_BAR();
        DGL(dg_lruin(args, 10 * L + 2); GRID_BAR();)
        lru_phase<0>(args, lds, bid, G);
        GRID_BAR();
        lru_carry_phase(args, bid, G);
        GRID_BAR();
        lru_phase<1>(args, lds, bid, G);
        GRID_BAR();
        lru_phase<2>(args, lds, bid, G);
        GRID_BAR();
        DGL(dg_lru(args, 10 * L + 3); GRID_BAR();)
        DGL(dg_save(args, 10 * L + 4, xs); GRID_BAR();)
        {
            pg8::Gemm g{(const bf16_t*)(ws + L_HY), (const bf16_t*)(ws + W_LRO), LRUW};
            pg8::TileOrder S; S.init(256, 4, G, bid);
            pg8::EpiRes E{xs, xo, modl + 2 * 1024};
            pg8::gemm_phase<pg8::EpiRes>(lds, g, S, E);
        }
        GRID_BAR();
        DGL(dg_res(args, 10 * L + 4, xo, modl + 2 * 1024, (const bf16_t*)(ws + L_HY), LRUW, args.in[I_LRWOUT]); GRID_BAR();)
    }
}
template <int L>
__device__ __forceinline__ void run_ffn(const Args& args, LAS unsigned char* lds, int bid, int G, const XcdBarrier& bar) {
    unsigned char* ws = args.ws; float* xo = args.out;
    const float* modl = (const float*)(ws + TB_MODS) + (size_t)L * NBATCH * 6144;
    if constexpr ((L & 1) == 0) {
        constexpr int m = L >> 1;
        norm_phase<false>(args, lds, bid, G, xo, xo, args.in[I_N2G] + L * DM, modl, 1, false, modl, false, nullptr);
        GRID_BAR();
        DGL(dg_norm(args, 10 * L + 5, xo, args.in[I_N2G] + L * DM, L, 1); GRID_BAR();)
        {
            pg8::Gemm g{(const bf16_t*)(ws + WS_HM), (const bf16_t*)(ws + W_FGU) + (size_t)m * 5632 * 1024, 1024};
            pg8::TileOrder S; S.init(256, 22, G, bid);
            pg8::EpiSwiGLU E{(bf16_t*)(ws + F_HID), DFF};
            pg8::gemm_phase<pg8::EpiSwiGLU>(lds, g, S, E);
        }
        GRID_BAR();
        DGL(dg_swiglu(args, 10 * L + 6, (const bf16_t*)(ws + WS_HM), args.in[I_FFGU] + (size_t)m * 1024 * 5632, DFF, (const bf16_t*)(ws + F_HID), MTOK, nullptr); GRID_BAR();)
        DGL(dg_save(args, 10 * L + 7, xo); GRID_BAR();)
        {
            pg8::Gemm g{(const bf16_t*)(ws + F_HID), (const bf16_t*)(ws + W_FDN) + (size_t)m * 1024 * 2816, DFF};
            pg8::TileOrder S; S.init(256, 4, G, bid);
            pg8::EpiRes E{xo, xo, modl + 5 * 1024};
            pg8::gemm_phase<pg8::EpiRes>(lds, g, S, E);
        }
        GRID_BAR();
        DGL(dg_res(args, 10 * L + 7, xo, modl + 5 * 1024, (const bf16_t*)(ws + F_HID), DFF, args.in[I_FFDN] + (size_t)m * 2816 * 1024); GRID_BAR();)
    } else {
        constexpr int m = L >> 1;
        norm_phase<true>(args, lds, bid, G, xo, xo, args.in[I_N2G] + L * DM, modl, 1, false, modl, false, args.in[I_MOER] + (size_t)m * DM * 8);
        GRID_BAR();
        DGL(dg_norm(args, 10 * L + 5, xo, args.in[I_N2G] + L * DM, L, 1); dg_router(args, 10 * L + 5, L); GRID_BAR();)
        place_phase(args, lds, bid, G);
        GRID_BAR();
        DGL(dg_place(args, 10 * L + 6); GRID_BAR();)
        const int* tiles = (const int*)(ws + TB_TILES);
        {
            pg8::Gemm g{(const bf16_t*)(ws + E_XS), (const bf16_t*)(ws + W_MGU + (size_t)m * 8 * 7168 * 1024), 512};
            pg8::TileOrder S; S.init(tiles[8], 28, G, bid);
#pragma unroll
            for (int e = 1; e < NEXP; ++e) S.ts[e] = tiles[e];
            pg8::EpiSwiGLU8 E{ws + E_HID, DFFE, 1.0f / MOE_WSCALE, MOE_HSCALE};
            pg8::gemm_phase<pg8::EpiSwiGLU8, true>(lds, g, S, E);
        }
        GRID_BAR();
        DGL(dg_moe_hid(args, 10 * L + 7, m); GRID_BAR();)
        {
            pg8::Gemm g{(const bf16_t*)(ws + E_HID), (const bf16_t*)(ws + W_MDN + (size_t)m * 8 * 1024 * 3584), DFFE / 2};
            pg8::TileOrder S; S.init(tiles[8], 4, G, bid);
#pragma unroll
            for (int e = 1; e < NEXP; ++e) S.ts[e] = tiles[e];
            pg8::EpiPlain E{(bf16_t*)(ws + E_XS), DM, 1.0f / (MOE_WSCALE * MOE_HSCALE)};
            pg8::gemm_phase<pg8::EpiPlain, true>(lds, g, S, E);
        }
        GRID_BAR();
        DGL(dg_moe_y(args, 10 * L + 8, m); GRID_BAR();)
    }
}
__device__ __forceinline__ void final_combine(const Args& args, LAS unsigned char* lds, int bid, int G, const XcdBarrier& bar) {
    const float* modl = (const float*)(args.ws + TB_MODS) + (size_t)3 * NBATCH * 6144;
    DG(dg_save(args, 39, args.out); GRID_BAR();)
    norm_phase<false>(args, lds, bid, G, args.out, args.out, args.in[I_N1G], modl, 0, true, modl, true, nullptr);
    DG(GRID_BAR(); dg_combine(args, 39, modl);)
}

__global__ void __launch_bounds__(NTHR, 2) mega_fwd(Args args) {
    extern __shared__ __attribute__((aligned(16))) unsigned char lds_raw[];
    LAS unsigned char* lds = (LAS unsigned char*)lds_raw;
    const int tid = threadIdx.x, bid = blockIdx.x, G = gridDim.x;
    unsigned char* ws = args.ws;
    volatile LAS unsigned* MISC = (volatile LAS unsigned*)(lds + MISC_OFF);
    if (tid < 64) MISC[tid] = 0u;
    __syncthreads();
    XcdBarrier bar = xcd_barrier_post((unsigned*)(ws + WS_CTL) + CW_BAR, MISC + 8);

    prologue_phase(args, lds, bid, G);
    GRID_BAR();

    run_mixer<0>(args, lds, bid, G, bar);
    run_ffn<0>(args, lds, bid, G, bar);
    run_mixer<1>(args, lds, bid, G, bar);
    run_ffn<1>(args, lds, bid, G, bar);
    run_mixer<2>(args, lds, bid, G, bar);
    run_ffn<2>(args, lds, bid, G, bar);
    run_mixer<3>(args, lds, bid, G, bar);
    run_ffn<3>(args, lds, bid, G, bar);
    final_combine(args, lds, bid, G, bar);
    DG(GRID_BAR(); dg_final(args, 49);)
}

extern "C" void kernel_launch(void* const* d_in, const int* in_sizes, int n_in, void* d_out, int out_size, void* d_ws, size_t ws_size, hipStream_t stream) {
    static int grid = 0;
    if (grid == 0) {
        if (n_in != 30 || out_size != MTOK * DM || ws_size < WS_NEED) { fprintf(stderr, "kernel_launch: unexpected shapes (n_in %d out %d ws %zu need %zu)\n", n_in, out_size, ws_size, (size_t)WS_NEED); grid = -1; return; }
        int dev = 0, cus = 0;
        if (hipGetDevice(&dev) != hipSuccess || hipDeviceGetAttribute(&cus, hipDeviceAttributeMultiprocessorCount, dev) != hipSuccess) { grid = -1; return; }
        if (hipFuncSetAttribute((const void*)mega_fwd, hipFuncAttributeMaxDynamicSharedMemorySize, LDS_BYTES) != hipSuccess) { fprintf(stderr, "kernel_launch: hipFuncSetAttribute failed\n"); grid = -1; return; }
        int per_cu = 0;
        if (hipOccupancyMaxActiveBlocksPerMultiprocessor(&per_cu, (const void*)mega_fwd, NTHR, LDS_BYTES) != hipSuccess || per_cu < 1) { fprintf(stderr, "kernel_launch: occupancy query says %d\n", per_cu); }
        (void)hipGetLastError();
        grid = (cus >= 256) ? 256 : -1;
        if (grid < 0) { fprintf(stderr, "kernel_launch: needs 256 CUs, device has %d\n", cus); return; }
    }
    if (grid < 0) return;
    if (hipMemsetAsync((char*)d_ws + WS_CTL, 0, CTL_ZERO_BYTES, stream) != hipSuccess) return;
    Args a{};
    for (int i = 0; i < 30; ++i) a.in[i] = (const float*)d_in[i];
    a.out = (float*)d_out; a.ws = (unsigned char*)d_ws;
    hipLaunchKernelGGL(mega_fwd, dim3(grid), dim3(NTHR), LDS_BYTES, stream, a);
}
```

```cpp
#define DIAG_FROM 2
#include <hip/hip_runtime.h>
#include <cstdio>
#include <cstdint>

#define LAS __attribute__((address_space(3)))
#define GAS __attribute__((address_space(1)))
typedef unsigned short bf16_t;
typedef short bf16x8 __attribute__((ext_vector_type(8)));
typedef short s16x4 __attribute__((ext_vector_type(4)));
typedef float f32x2 __attribute__((ext_vector_type(2)));
typedef float f32x4 __attribute__((ext_vector_type(4)));
typedef float f32x16 __attribute__((ext_vector_type(16)));
typedef unsigned u32x2 __attribute__((ext_vector_type(2)));
typedef unsigned u32x4 __attribute__((ext_vector_type(4)));

constexpr int MTOK = 65536, DM = 1024, SEQ = 8192, NBATCH = 8, DEPTH = 4;
constexpr int DFF = 2816, DFFE = 3584, NEXP = 8, LRUW = 1280;
constexpr float EPS = 1e-6f;
constexpr int FP8_DENSE_FROM = 2;
constexpr float MOE_WSCALE = 64.0f, MOE_HSCALE = 4.0f;
constexpr float LOG2E = 1.4426950408889634f;

constexpr size_t MiB = 1u << 20;
constexpr size_t WS_CTL = 0, CTL_ZERO_BYTES = 1 * MiB;
constexpr size_t WS_TAB = 1 * MiB;
constexpr size_t TB_MODS = WS_TAB;
constexpr size_t TB_COS = WS_TAB + 1 * MiB;
constexpr size_t TB_SIN = WS_TAB + 2 * MiB;
constexpr size_t TB_SCAL = WS_TAB + 3 * MiB;
constexpr size_t TB_LB = TB_SCAL + 4096;
constexpr size_t TB_SP = TB_SCAL + 16384;
constexpr size_t TB_EID = WS_TAB + 4 * MiB;
constexpr size_t TB_GATE = WS_TAB + 5 * MiB;
constexpr size_t TB_SLOT = WS_TAB + 6 * MiB;
constexpr size_t TB_BCNT = WS_TAB + 7 * MiB;
constexpr size_t TB_TILES = TB_BCNT + 16384;
constexpr size_t TB_LSUM = WS_TAB + 8 * MiB;
constexpr size_t TB_LCIN = WS_TAB + 16 * MiB;
constexpr size_t WS_W = 32 * MiB;
constexpr size_t W_QKV = WS_W;
constexpr size_t W_AO = W_QKV + 2 * (size_t)3072 * 1024 * 2;
constexpr size_t W_HGI = W_AO + 2 * (size_t)1024 * 1024 * 2;
constexpr size_t W_HGO = W_HGI + (size_t)5120 * 1024 * 2;
constexpr size_t W_LRI = W_HGO + (size_t)1024 * 1024 * 2;
constexpr size_t W_LRG = W_LRI + (size_t)2560 * 1024 * 2;
constexpr size_t W_LRO = W_LRG + (size_t)10 * 2 * 256 * 128 * 2;
constexpr size_t W_FGU = W_LRO + (size_t)1024 * 1280 * 2;
constexpr size_t W_FDN = W_FGU + 2 * (size_t)5632 * 1024 * 2;
constexpr size_t W_MGU = W_FDN + 2 * (size_t)1024 * 2816 * 2;
constexpr size_t W_MDN = W_MGU + 16 * (size_t)7168 * 1024 * 2;
constexpr size_t W_END = W_MDN + 16 * (size_t)1024 * 3584 * 2;
constexpr size_t WS_HM = 440 * MiB;
constexpr size_t WS_ACT = 568 * MiB;
static_assert(W_END <= WS_HM, "weights overflow");
constexpr size_t SZ_TOK = (size_t)MTOK * 1024 * 2;
constexpr size_t A_Q = WS_ACT, A_K = A_Q + SZ_TOK, A_V = A_K + SZ_TOK;
constexpr size_t F_HID = WS_ACT;
constexpr size_t H_Q = WS_ACT, H_LFF = H_Q + SZ_TOK, H_LFB = H_LFF + SZ_TOK, H_V = H_LFB + SZ_TOK, H_G = H_V + SZ_TOK, H_OF = H_G + SZ_TOK, H_OB = H_OF + SZ_TOK;
constexpr size_t SZ_LRU = (size_t)MTOK * 1280 * 2;
constexpr size_t L_YB = WS_ACT, L_XB = L_YB + SZ_LRU, L_HF = L_XB + SZ_LRU, L_HY = L_HF + SZ_LRU;
constexpr int MOE_ROWS = 2 * MTOK + NEXP * 256;
constexpr size_t E_XS = WS_ACT, E_HID = E_XS + (size_t)MOE_ROWS * 1024 * 2, E_END = E_HID + (size_t)MOE_ROWS * DFFE * 2;
constexpr size_t WS_NEED = E_END;
static_assert(WS_NEED <= (size_t)1792 * MiB, "workspace");

constexpr int CW_BAR = 4096;

constexpr int RING_BYTES = 135168;
constexpr int MISC_OFF = RING_BYTES;
constexpr int LDS_BYTES = 147456;
constexpr int NWAVES = 8, NTHR = 512;

typedef __bf16 bf16x2v __attribute__((ext_vector_type(2)));
__device__ __forceinline__ unsigned cvt_pk_bf16(float lo, float hi) { const f32x2 v = {lo, hi}; const bf16x2v b = __builtin_convertvector(v, bf16x2v); return __builtin_bit_cast(unsigned, b); }
__device__ __forceinline__ unsigned pk_fp8x4(float a, float b, float c, float d) { unsigned w = 0; w = __builtin_amdgcn_cvt_pk_fp8_f32(a, b, w, false); w = __builtin_amdgcn_cvt_pk_fp8_f32(c, d, w, true); return w; }
__device__ __forceinline__ unsigned f2bf(float f) { unsigned u = __builtin_bit_cast(unsigned, f); return (u + 0x7fffu + ((u >> 16) & 1u)) >> 16; }
__device__ __forceinline__ float bf2f(unsigned short b) { return __builtin_bit_cast(float, ((unsigned)b) << 16); }
__device__ __forceinline__ float bflo(unsigned w) { return __builtin_bit_cast(float, w << 16); }
__device__ __forceinline__ float bfhi(unsigned w) { return __builtin_bit_cast(float, w & 0xffff0000u); }
__device__ __forceinline__ float fexp2(float x) { return __builtin_amdgcn_exp2f(x); }
__device__ __forceinline__ float fexp(float x) { return __builtin_amdgcn_exp2f(x * LOG2E); }
__device__ __forceinline__ float frcp(float x) { return __builtin_amdgcn_rcpf(x); }
__device__ __forceinline__ float fsigmoid(float x) { return frcp(1.0f + fexp(-x)); }
__device__ __forceinline__ float fsilu(float x) { return x * fsigmoid(x); }
__device__ __forceinline__ float wave_sum(float v) {
#pragma unroll
    for (int o = 1; o < 64; o <<= 1) v += __shfl_xor(v, o);
    return v;
}
#define LDS_WAIT() asm volatile("s_waitcnt lgkmcnt(0)" ::: "memory")
#define VM_WAIT() asm volatile("s_waitcnt vmcnt(0)" ::: "memory")

#define XB_TMO      128
#define XB_XCNT(j)  (256  + 64 * (j))
#define XB_XSUB(j)  (1280 + 64 * (j))
#define XB_XGEN(j)  (2304 + 64 * (j))
#define XB_TOP      3328
#define XB_TOPGEN   3392
#define XCD_BAR_WORDS 3456
#define XB_SPIN_CAP (1u << 22)
__device__ __forceinline__ unsigned xb_ld(unsigned* p)              { return __hip_atomic_load(p, __ATOMIC_RELAXED, __HIP_MEMORY_SCOPE_AGENT); }
__device__ __forceinline__ unsigned xb_add(unsigned* p, unsigned v) { return __hip_atomic_fetch_add(p, v, __ATOMIC_RELAXED, __HIP_MEMORY_SCOPE_AGENT); }
__device__ __forceinline__ unsigned xb_xcc_id() { return (unsigned)__builtin_amdgcn_s_getreg((3 << 11) | 20) & 0xFu; }
#define XB_SPIN(cond, bar) do { unsigned _sp = 0; while (cond) { __builtin_amdgcn_s_sleep(1); \
    if ((++_sp & 255u) == 0u) { if (xb_ld(&(bar)[XB_TMO])) break; if (_sp > XB_SPIN_CAP) { atomicAdd(&(bar)[XB_TMO], 1u); break; } } } } while (0)
struct XcdBarrier { unsigned* bar; unsigned x; volatile LAS unsigned* st; };
__device__ __forceinline__ XcdBarrier xcd_barrier_post(unsigned* bar, volatile LAS unsigned* st) {
    XcdBarrier b; b.bar = bar; b.x = xb_xcc_id(); b.st = st;
    if (threadIdx.x == 0) (void)xb_add(&bar[XB_XCNT(b.x)], 1u);
    return b;
}
__device__ __forceinline__ void xcd_barrier_complete(unsigned* bar, unsigned x, unsigned& nloc, unsigned& nx) {
    const unsigned G = gridDim.x * gridDim.y * gridDim.z;
    unsigned sum, cnt, mine, sp = 0u;
    for (;;) {
        sum = 0u; cnt = 0u; mine = 0u;
#pragma unroll
        for (unsigned j = 0; j < 16; ++j) { const unsigned c = xb_ld(&bar[XB_XCNT(j)]); sum += c; cnt += (c > 0u) ? 1u : 0u; mine = (j == x) ? c : mine; }
        if (sum == G) break;
        __builtin_amdgcn_s_sleep(1);
        if ((++sp & 255u) == 0u) { if (xb_ld(&bar[XB_TMO])) break; if (sp > XB_SPIN_CAP) { atomicAdd(&bar[XB_TMO], 1u); break; } }
    }
    nloc = mine > 0u ? mine : 1u; nx = cnt > 0u ? cnt : 1u;
}
__device__ __forceinline__ void xcd_barrier(const XcdBarrier& b) {
    asm volatile("s_waitcnt vmcnt(0)" ::: "memory");
    __syncthreads();
    if (threadIdx.x == 0) {
        unsigned* bar = b.bar;
        __builtin_amdgcn_s_waitcnt(0);
        unsigned nloc = b.st[0], nx = b.st[1];
        if (nloc == 0u) { xcd_barrier_complete(bar, b.x, nloc, nx); b.st[0] = nloc; b.st[1] = nx; }
        const unsigned old = xb_add(&bar[XB_XSUB(b.x)], 1u);
        const unsigned gen = old / nloc;
        if (old + 1u == (gen + 1u) * nloc) {
            __builtin_amdgcn_fence(__ATOMIC_RELEASE, "agent");
            asm volatile("s_waitcnt vmcnt(0)" ::: "memory");
            const unsigned og = xb_add(&bar[XB_TOP], 1u);
            const unsigned tg = og / nx;
            if (og + 1u == (tg + 1u) * nx) xb_add(&bar[XB_TOPGEN], 1u);
            else XB_SPIN(xb_ld(&bar[XB_TOPGEN]) == tg, bar);
            __builtin_amdgcn_fence(__ATOMIC_ACQUIRE, "agent");
            xb_add(&bar[XB_XGEN(b.x)], 1u);
            asm volatile("s_waitcnt vmcnt(0)" ::: "memory");
        } else {
            XB_SPIN(xb_ld(&bar[XB_XGEN(b.x)]) == gen, bar);
            __builtin_amdgcn_fence(__ATOMIC_ACQUIRE, "agent");
            asm volatile("s_waitcnt vmcnt(0)" ::: "memory");
        }
    }
    __syncthreads();
}

namespace pg8 {
constexpr int BM = 256, BK = 64, HALF = 128, HTB = HALF * BK * 2, STAGE_BYTES = 8 * HTB, NXCD = 8, WGM = 8;
__host__ __device__ __forceinline__ int lds_byte(int r, int c) { const int st = (r >> 4) * 2 + (c >> 5), rr = r & 15, cc = c & 31, ob = rr * 64 + cc * 2; return st * 1024 + (ob ^ (((ob >> 9) & 1) << 5)); }
__host__ __device__ __forceinline__ void stage_rc(int b, int& R, int& C) { const int st = b / 1024, sb = b % 1024, swz = sb ^ (((sb >> 9) & 1) << 5); R = (st >> 1) * 16 + swz / 64; C = (st & 1) * 32 + (swz % 64) / 2; }
__host__ __device__ __forceinline__ int perm32(int rho) { const int n = rho >> 4, i = rho & 15; return 8 * (i >> 2) + 4 * n + (i & 3); }

struct Unit { int pm, pn, pb; };
struct Gemm { const bf16_t* A; const bf16_t* Bt; int K; };

struct TileOrder {
    int nM, nN, nwg, G, c; int ts[NEXP];
    __device__ __forceinline__ void init(int nM_, int nN_, int G_, int c_) { nM = nM_; nN = nN_; nwg = nM * nN; G = G_; c = c_;
#pragma unroll
        for (int e = 0; e < NEXP; ++e) ts[e] = (e == 0) ? 0 : 0x7fffffff; }
    __device__ __forceinline__ bool next(int i, Unit& u) const {
        const long L = (long)i * G + c; if (L >= nwg) return false;
        int wgid = (int)L; { const int q = nwg / NXCD, r = nwg % NXCD, xcd = wgid % NXCD, off = wgid / NXCD; wgid = (xcd < r ? xcd * (q + 1) : r * (q + 1) + (xcd - r) * q) + off; }
        const int nig = WGM * nN, gid = wgid / nig, fm = gid * WGM, gsz = (nM - fm) < WGM ? (nM - fm) : WGM;
        u.pm = fm + ((wgid % nig) % gsz); u.pn = (wgid % nig) / gsz;
        int e = 0;
#pragma unroll
        for (int k = 1; k < NEXP; ++k) e += (u.pm >= ts[k]) ? 1 : 0;
        u.pb = e * nN + u.pn; return true;
    }
};

typedef int v8i32 __attribute__((ext_vector_type(8)));
template <class Epi, bool FP8 = false>
__device__ __forceinline__ void gemm_phase(LAS unsigned char* lds, const Gemm g, const TileOrder& S, const Epi& E) {
    int tid_ = threadIdx.x; asm volatile("" : "+v"(tid_));
    const int tid = tid_, wid = __builtin_amdgcn_readfirstlane(tid >> 6), lane = tid & 63, wr = wid >> 2, wc = wid & 3, fr = lane & 15, fq = lane >> 4;
    const int K = g.K, nt = K / BK;
    unsigned voffA[2], voffB[2];
#pragma unroll
    for (int i = 0; i < 2; ++i) { int R, C; stage_rc(tid * 16 + i * 8192, R, C); const int Rb = Epi::PERM ? ((R & ~31) + perm32(R & 31)) : R;
        voffA[i] = (unsigned)(R * K + C) * 2u; voffB[i] = (unsigned)(Rb * K + C) * 2u; }
    const size_t kstep = (size_t)(BK * 2);
    const size_t hstep = (size_t)HALF * K * 2;
    const size_t tstep = 2 * hstep;
    const unsigned ldsw = (unsigned)wid * 1024u;
    const int aoff = lds_byte(wr * 64 + fr, fq * 8), boff = lds_byte(wc * 32 + fr, fq * 8);
#define PG8_SA(b, h) (((b) * 2 + (h)) * HTB)
#define PG8_SB(b, h) ((4 + (b) * 2 + (h)) * HTB)
#define PG8_STAGE(bufoff, gbase, voff) do { _Pragma("unroll") for (int _i = 0; _i < 2; ++_i) \
        __builtin_amdgcn_global_load_lds((const unsigned*)((const char*)(gbase) + (voff)[_i]), (LAS unsigned*)(lds + (bufoff) + ldsw + _i * 8192), 16, 0, 0); } while (0)
#define PG8_LD8(p) __builtin_bit_cast(v8i32, __builtin_shufflevector(*(const LAS u32x4*)(p), *(const LAS u32x4*)((p) + 1024), 0, 1, 2, 3, 4, 5, 6, 7))
#define PG8_LDA(dst, b, h) do { if constexpr (FP8) { _Pragma("unroll") for (int m = 0; m < 4; ++m) dst##8[m] = PG8_LD8(lds + PG8_SA(b, h) + aoff + m * 2048); } \
        else { _Pragma("unroll") for (int m = 0; m < 4; ++m) _Pragma("unroll") for (int k = 0; k < 2; ++k) dst[m][k] = *(const LAS bf16x8*)(lds + PG8_SA(b, h) + aoff + m * 2048 + k * 1024); } } while (0)
#define PG8_LDB(dst, b, h) do { if constexpr (FP8) { _Pragma("unroll") for (int n = 0; n < 2; ++n) dst##8[n] = PG8_LD8(lds + PG8_SB(b, h) + boff + n * 2048); } \
        else { _Pragma("unroll") for (int n = 0; n < 2; ++n) _Pragma("unroll") for (int k = 0; k < 2; ++k) dst[n][k] = *(const LAS bf16x8*)(lds + PG8_SB(b, h) + boff + n * 2048 + k * 1024); } } while (0)
#define PG8_MMA(ai, bj, At, Bt) do { __builtin_amdgcn_s_setprio(1); \
        if constexpr (FP8) { _Pragma("unroll") for (int m = 0; m < 4; ++m) _Pragma("unroll") for (int n = 0; n < 2; ++n) \
            asm volatile("v_mfma_scale_f32_16x16x128_f8f6f4 %0, %1, %2, %0, %3, %3 op_sel_hi:[0,0,0]" : "+v"(acc[ai][bj][m][n]) : "v"(Bt##8[n]), "v"(At##8[m]), "v"(one_scale)); } \
        else { _Pragma("unroll") for (int m = 0; m < 4; ++m) _Pragma("unroll") for (int n = 0; n < 2; ++n) _Pragma("unroll") for (int k = 0; k < 2; ++k) \
            acc[ai][bj][m][n] = __builtin_amdgcn_mfma_f32_16x16x32_bf16(Bt[n][k], At[m][k], acc[ai][bj][m][n], 0, 0, 0); } \
        __builtin_amdgcn_s_setprio(0); } while (0)
#define PG8_WAIT_V(n) asm volatile("s_waitcnt vmcnt(" #n ")" ::: "memory")
#define PG8_WAIT_L(n) asm volatile("s_waitcnt lgkmcnt(" #n ")" ::: "memory")
#define PG8_BAR __builtin_amdgcn_s_barrier()
#define PG8_SCHED __builtin_amdgcn_sched_barrier(0)
    Unit cur, nxt; int ui = 0;
    if (!S.next(0, cur)) return;
    f32x4 acc[2][2][4][2];
#pragma unroll
    for (int a = 0; a < 2; ++a)
#pragma unroll
        for (int b = 0; b < 2; ++b)
#pragma unroll
            for (int m = 0; m < 4; ++m)
#pragma unroll
                for (int n = 0; n < 2; ++n) acc[a][b][m][n] = (f32x4){0.f, 0.f, 0.f, 0.f};
    bf16x8 At[4][2], B0[2][2], B1[2][2]; v8i32 At8[4], B08[2], B18[2];
    int one_scale = 0x7f7f7f7f; asm volatile("" : "+v"(one_scale));
    const char* cA = (const char*)g.A + (size_t)cur.pm * tstep; const char* cB = (const char*)g.Bt + (size_t)cur.pb * tstep;
    PG8_STAGE(PG8_SB(0, 0), cB, voffB); PG8_STAGE(PG8_SA(0, 0), cA, voffA); PG8_STAGE(PG8_SB(0, 1), cB + hstep, voffB); PG8_STAGE(PG8_SA(0, 1), cA + hstep, voffA);
    if (wr == 1) PG8_BAR;
    PG8_WAIT_V(4); PG8_BAR;
    PG8_STAGE(PG8_SB(1, 0), cB + kstep, voffB); PG8_STAGE(PG8_SA(1, 0), cA + kstep, voffA); PG8_STAGE(PG8_SB(1, 1), cB + hstep + kstep, voffB);
    PG8_WAIT_V(6); PG8_BAR;
    for (;;) {
        const bool has_next = S.next(ui + 1, nxt);
        const char* nA = has_next ? (const char*)g.A + (size_t)nxt.pm * tstep : cA; const char* nB = has_next ? (const char*)g.Bt + (size_t)nxt.pb * tstep : cB;
        for (int t = 0; t < nt; t += 2) {
            const bool last = (t == nt - 2);
            const char* a1 = cA + (size_t)(t + 1) * kstep;
            const char* a2 = last ? nA : cA + (size_t)(t + 2) * kstep; const char* b2 = last ? nB : cB + (size_t)(t + 2) * kstep;
            const char* a3 = a2 + kstep; const char* b3 = b2 + kstep;
            PG8_LDB(B0, 0, 0); PG8_SCHED; PG8_LDA(At, 0, 0); PG8_STAGE(PG8_SA(1, 1), a1 + hstep, voffA);
            PG8_WAIT_L(8); PG8_BAR; PG8_WAIT_L(0); PG8_MMA(0, 0, At, B0); PG8_BAR; PG8_SCHED;
            PG8_LDB(B1, 0, 1); PG8_STAGE(PG8_SB(0, 0), b2, voffB);
            PG8_BAR; PG8_WAIT_L(0); PG8_MMA(0, 1, At, B1); PG8_BAR;
            PG8_LDA(At, 0, 1); PG8_STAGE(PG8_SA(0, 0), a2, voffA);
            PG8_BAR; PG8_WAIT_L(0); PG8_MMA(1, 0, At, B0); PG8_BAR; PG8_SCHED;
            PG8_STAGE(PG8_SB(0, 1), b2 + hstep, voffB);
            PG8_WAIT_V(6); PG8_BAR; PG8_MMA(1, 1, At, B1); PG8_BAR;
            PG8_LDB(B0, 1, 0); PG8_SCHED; PG8_LDA(At, 1, 0); PG8_STAGE(PG8_SA(0, 1), a2 + hstep, voffA);
            PG8_WAIT_L(8); PG8_BAR; PG8_WAIT_L(0); PG8_MMA(0, 0, At, B0); PG8_BAR; PG8_SCHED;
            PG8_LDB(B1, 1, 1); PG8_STAGE(PG8_SB(1, 0), b3, voffB);
            PG8_BAR; PG8_WAIT_L(0); PG8_MMA(0, 1, At, B1); PG8_BAR;
            PG8_LDA(At, 1, 1); PG8_STAGE(PG8_SA(1, 0), a3, voffA);
            PG8_BAR; PG8_WAIT_L(0); PG8_MMA(1, 0, At, B0); PG8_BAR; PG8_SCHED;
            PG8_STAGE(PG8_SB(1, 1), b3 + hstep, voffB);
            PG8_WAIT_V(6); PG8_BAR; PG8_MMA(1, 1, At, B1); PG8_BAR;
        }
        if constexpr (FP8) asm volatile("s_nop 15\n\ts_nop 15" ::: "memory");
        E(acc, cur, wr, wc, fr, fq);
        if (!has_next) break;
#pragma unroll
        for (int a = 0; a < 2; ++a)
#pragma unroll
            for (int b = 0; b < 2; ++b)
#pragma unroll
                for (int m = 0; m < 4; ++m)
#pragma unroll
                    for (int n = 0; n < 2; ++n) acc[a][b][m][n] = (f32x4){0.f, 0.f, 0.f, 0.f};
        cur = nxt; cA = nA; cB = nB; ++ui;
    }
    PG8_WAIT_V(0);
    if (wr == 0) PG8_BAR;
    PG8_BAR;
#undef PG8_SA
#undef PG8_SB
#undef PG8_STAGE
#undef PG8_LDA
#undef PG8_LDB
#undef PG8_MMA
#undef PG8_LD8
#undef PG8_WAIT_V
#undef PG8_WAIT_L
#undef PG8_BAR
#undef PG8_SCHED
}

struct EpiQKV {
    static constexpr bool PERM = true;
    bf16_t *Q, *Kk, *V; const float *gq, *gk, *cosT, *sinT; float qscale;
    __device__ __forceinline__ void operator()(const f32x4 (&acc)[2][2][4][2], const Unit& u, int wr, int wc, int fr, int fq) const {
        const int row0 = u.pm * BM + wr * 64 + fr;
        if (u.pn >= 8) {
            const int col0 = (u.pn - 8) * BM + wc * 32 + 8 * fq;
#pragma unroll
            for (int ai = 0; ai < 2; ++ai)
#pragma unroll
                for (int m = 0; m < 4; ++m) { bf16_t* rowp = V + (size_t)(row0 + ai * HALF + m * 16) * DM + col0;
#pragma unroll
                    for (int bj = 0; bj < 2; ++bj) { const f32x4 v0 = acc[ai][bj][m][0], v1 = acc[ai][bj][m][1];
                        u32x4 w; w.x = cvt_pk_bf16(v0[0], v0[1]); w.y = cvt_pk_bf16(v0[2], v0[3]); w.z = cvt_pk_bf16(v1[0], v1[1]); w.w = cvt_pk_bf16(v1[2], v1[3]);
                        *(u32x4*)(rowp + bj * HALF) = w; } }
        } else {
            const int part = u.pn >> 2, sh = 4 * (u.pn & 3) + wc;
            bf16_t* dst = part ? Kk : Q; const float* g = part ? gk : gq; const float sc = part ? 1.0f : qscale;
            f32x4 g0[2], g1[2];
#pragma unroll
            for (int n = 0; n < 2; ++n) { g0[n] = *(const f32x4*)(g + 8 * fq + 4 * n); g1[n] = *(const f32x4*)(g + 32 + 8 * fq + 4 * n); }
#pragma unroll
            for (int ai = 0; ai < 2; ++ai)
#pragma unroll
                for (int m = 0; m < 4; ++m) {
                    const int r = row0 + ai * HALF + m * 16; const int pos = r & (SEQ - 1);
                    f32x4 x1[2], x2[2]; float ss = 0.f;
#pragma unroll
                    for (int n = 0; n < 2; ++n) { x1[n] = acc[ai][0][m][n]; x2[n] = acc[ai][1][m][n];
                        ss += (x1[n][0] * x1[n][0] + x1[n][1] * x1[n][1]) + (x1[n][2] * x1[n][2] + x1[n][3] * x1[n][3]);
                        ss += (x2[n][0] * x2[n][0] + x2[n][1] * x2[n][1]) + (x2[n][2] * x2[n][2] + x2[n][3] * x2[n][3]); }
                    ss += __shfl_xor(ss, 16); ss += __shfl_xor(ss, 32);
                    const float rstd = __builtin_amdgcn_rsqf(ss * (1.0f / 64.0f) + EPS) ;
                    bf16_t* op = dst + (size_t)r * DM + sh * 64 + 8 * fq;
                    u32x4 w1, w2;
#pragma unroll
                    for (int n = 0; n < 2; ++n) {
                        const f32x4 cs = *(const f32x4*)(cosT + pos * 32 + 8 * fq + 4 * n), sn = *(const f32x4*)(sinT + pos * 32 + 8 * fq + 4 * n);
                        const f32x4 y1 = x1[n] * rstd * g0[n], y2 = x2[n] * rstd * g1[n];
                        const f32x4 o1 = (y1 * cs - y2 * sn) * sc, o2 = (y2 * cs + y1 * sn) * sc;
                        if (n == 0) { w1.x = cvt_pk_bf16(o1[0], o1[1]); w1.y = cvt_pk_bf16(o1[2], o1[3]); w2.x = cvt_pk_bf16(o2[0], o2[1]); w2.y = cvt_pk_bf16(o2[2], o2[3]); }
                        else { w1.z = cvt_pk_bf16(o1[0], o1[1]); w1.w = cvt_pk_bf16(o1[2], o1[3]); w2.z = cvt_pk_bf16(o2[0], o2[1]); w2.w = cvt_pk_bf16(o2[2], o2[3]); }
                    }
                    *(u32x4*)(op) = w1; *(u32x4*)(op + 32) = w2;
                }
        }
    }
};
struct EpiRes {
    static constexpr bool PERM = false;
    const float* xin; float* xout; const float* gate; float sc;
    __device__ __forceinline__ void operator()(const f32x4 (&acc)[2][2][4][2], const Unit& u, int wr, int wc, int fr, int fq) const {
        const int row0 = u.pm * BM + wr * 64 + fr, col0 = u.pn * BM + wc * 32 + 4 * fq;
        const float* gp = gate + (size_t)(u.pm >> 5) * 6144 + col0;
        f32x4 gv[2][2];
#pragma unroll
        for (int bj = 0; bj < 2; ++bj)
#pragma unroll
            for (int n = 0; n < 2; ++n) gv[bj][n] = *(const f32x4*)(gp + bj * HALF + n * 16) * sc;
#pragma unroll
        for (int ai = 0; ai < 2; ++ai)
#pragma unroll
            for (int m = 0; m < 4; ++m) { const size_t off = (size_t)(row0 + ai * HALF + m * 16) * DM + col0;
#pragma unroll
                for (int bj = 0; bj < 2; ++bj)
#pragma unroll
                    for (int n = 0; n < 2; ++n) { const f32x4 xv = *(const f32x4*)(xin + off + bj * HALF + n * 16);
                        *(f32x4*)(xout + off + bj * HALF + n * 16) = xv + gv[bj][n] * acc[ai][bj][m][n]; }
                asm volatile("" ::: "memory"); }
    }
};
struct EpiSwiGLU {
    static constexpr bool PERM = true;
    bf16_t* H; int ldh;
    __device__ __forceinline__ void operator()(const f32x4 (&acc)[2][2][4][2], const Unit& u, int wr, int wc, int fr, int fq) const {
        const int row0 = u.pm * BM + wr * 64 + fr, col0 = u.pn * HALF + wc * 32 + 8 * fq;
#pragma unroll
        for (int ai = 0; ai < 2; ++ai)
#pragma unroll
            for (int m = 0; m < 4; ++m) { bf16_t* rowp = H + (size_t)(row0 + ai * HALF + m * 16) * ldh + col0;
                f32x4 v[2];
#pragma unroll
                for (int n = 0; n < 2; ++n) { const f32x4 gt = acc[ai][0][m][n], up = acc[ai][1][m][n];
#pragma unroll
                    for (int j = 0; j < 4; ++j) v[n][j] = fsilu(gt[j]) * up[j]; }
                u32x4 w; w.x = cvt_pk_bf16(v[0][0], v[0][1]); w.y = cvt_pk_bf16(v[0][2], v[0][3]); w.z = cvt_pk_bf16(v[1][0], v[1][1]); w.w = cvt_pk_bf16(v[1][2], v[1][3]);
                *(u32x4*)rowp = w; }
    }
};
struct EpiSwiGLU8 {
    static constexpr bool PERM = true;
    unsigned char* H; int ldh; float ws, hs;
    __device__ __forceinline__ void operator()(const f32x4 (&acc)[2][2][4][2], const Unit& u, int wr, int wc, int fr, int fq) const {
        const int row0 = u.pm * BM + wr * 64 + fr, col0 = u.pn * HALF + wc * 32 + 8 * fq;
#pragma unroll
        for (int ai = 0; ai < 2; ++ai)
#pragma unroll
            for (int m = 0; m < 4; ++m) { unsigned char* rowp = H + (size_t)(row0 + ai * HALF + m * 16) * ldh + col0;
                f32x4 v[2];
#pragma unroll
                for (int n = 0; n < 2; ++n) { const f32x4 gt = acc[ai][0][m][n] * ws, up = acc[ai][1][m][n] * (ws * hs);
#pragma unroll
                    for (int j = 0; j < 4; ++j) v[n][j] = fsilu(gt[j]) * up[j]; }
                *(u32x2*)rowp = (u32x2){pk_fp8x4(v[0][0], v[0][1], v[0][2], v[0][3]), pk_fp8x4(v[1][0], v[1][1], v[1][2], v[1][3])}; }
    }
};
struct EpiPlain {
    static constexpr bool PERM = true;
    bf16_t* O; int ldc; float sc;
    __device__ __forceinline__ void operator()(const f32x4 (&acc)[2][2][4][2], const Unit& u, int wr, int wc, int fr, int fq) const {
        const int row0 = u.pm * BM + wr * 64 + fr, col0 = u.pn * BM + wc * 32 + 8 * fq;
#pragma unroll
        for (int ai = 0; ai < 2; ++ai)
#pragma unroll
            for (int m = 0; m < 4; ++m) { bf16_t* rowp = O + (size_t)(row0 + ai * HALF + m * 16) * ldc + col0;
#pragma unroll
                for (int bj = 0; bj < 2; ++bj) { const f32x4 v0 = acc[ai][bj][m][0] * sc, v1 = acc[ai][bj][m][1] * sc;
                    u32x4 w; w.x = cvt_pk_bf16(v0[0], v0[1]); w.y = cvt_pk_bf16(v0[2], v0[3]); w.z = cvt_pk_bf16(v1[0], v1[1]); w.w = cvt_pk_bf16(v1[2], v1[3]);
                    *(u32x4*)(rowp + bj * HALF) = w; } }
    }
};
struct EpiAct {
    static constexpr bool PERM = true;
    int kind; unsigned char* ws; const float* lb;
    __device__ __forceinline__ void operator()(const f32x4 (&acc)[2][2][4][2], const Unit& u, int wr, int wc, int fr, int fq) const {
        const int row0 = u.pm * BM + wr * 64 + fr;
        int mode, ldc, colt; size_t boff;
        if (kind == 0) { const int grp = u.pn >> 2; colt = (u.pn & 3) * 256; ldc = 1024;
            boff = grp == 0 ? H_Q : grp == 1 ? H_LFF : grp == 2 ? H_LFB : grp == 3 ? H_V : H_G; mode = (grp == 0 || grp == 4) ? 1 : (grp == 3 ? 0 : 3); }
        else { ldc = LRUW; if (u.pn < 5) { boff = L_YB; colt = u.pn * 256; mode = 2; } else { boff = L_XB; colt = (u.pn - 5) * 256; mode = 0; } }
        bf16_t* base = (bf16_t*)(ws + boff);
        const int col0 = colt + wc * 32 + 8 * fq;
        f32x4 lbv[2][2];
        if (mode == 3) { const float* lp = lb + ((u.pn >> 2) - 1) * 1024 + col0;
#pragma unroll
            for (int bj = 0; bj < 2; ++bj)
#pragma unroll
                for (int n = 0; n < 2; ++n) lbv[bj][n] = *(const f32x4*)(lp + bj * HALF + 4 * n); }
#pragma unroll
        for (int ai = 0; ai < 2; ++ai)
#pragma unroll
            for (int m = 0; m < 4; ++m) { bf16_t* rowp = base + (size_t)(row0 + ai * HALF + m * 16) * ldc + col0;
#pragma unroll
                for (int bj = 0; bj < 2; ++bj) { f32x4 v[2]; u32x4 w;
#pragma unroll
                    for (int n = 0; n < 2; ++n) { v[n] = acc[ai][bj][m][n];
                        if (mode == 1) {
#pragma unroll
                            for (int j = 0; j < 4; ++j) v[n][j] = fsilu(v[n][j]); }
                        else if (mode == 2) {
#pragma unroll
                            for (int j = 0; j < 4; ++j) { const float x = v[n][j]; v[n][j] = x * fsigmoid(1.5957691216057308f * (x + 0.044715f * x * x * x)); } }
                        else if (mode == 3) {
#pragma unroll
                            for (int j = 0; j < 4; ++j) { const float l = lbv[bj][n][j]; const float fg = l + (1.0f - l) * fsigmoid(v[n][j]); v[n][j] = __builtin_amdgcn_logf(fg) * 0.6931471805599453f; } }
                    }
                    if (mode == 3) {
#pragma unroll
                        for (int n = 0; n < 2; ++n) { const _Float16 h0 = (_Float16)v[n][0], h1 = (_Float16)v[n][1], h2 = (_Float16)v[n][2], h3 = (_Float16)v[n][3];
                            const unsigned a = (unsigned)__builtin_bit_cast(unsigned short, h0) | ((unsigned)__builtin_bit_cast(unsigned short, h1) << 16);
                            const unsigned b = (unsigned)__builtin_bit_cast(unsigned short, h2) | ((unsigned)__builtin_bit_cast(unsigned short, h3) << 16);
                            if (n == 0) { w.x = a; w.y = b; } else { w.z = a; w.w = b; } }
                    } else { w.x = cvt_pk_bf16(v[0][0], v[0][1]); w.y = cvt_pk_bf16(v[0][2], v[0][3]); w.z = cvt_pk_bf16(v[1][0], v[1][1]); w.w = cvt_pk_bf16(v[1][2], v[1][3]); }
                    *(u32x4*)(rowp + bj * HALF) = w; } }
    }
};
}

struct Args { const float* in[30]; float* out; unsigned char* ws; };
enum { I_X = 0, I_C, I_ADAW, I_ADAB, I_N1G, I_N2G, I_ATWIN, I_ATQN, I_ATKN, I_ATLAM, I_ATSUB, I_ATWOUT, I_HGWIN, I_HGLB, I_HGNG, I_HGWOUT,
       I_LRWIN, I_LRCW, I_LRCB, I_LRWA, I_LRBA, I_LRWX, I_LRBX, I_LRLAM, I_LRWOUT, I_FFGU, I_FFDN, I_MOER, I_MOEGU, I_MOEDN };
enum { SC_LAM0 = 0, SC_LAM1, SC_OML0, SC_OML1, SC_MC0, SC_MC1 };

__device__ __forceinline__ void cvt_item(const float* W, int ldw, int src_col0, bf16_t* WT, int ldt, int dst_row0, int k0, LAS float* scr, int lane) {
#pragma unroll 8
    for (int i = 0; i < 32; ++i) { const int kk = 2 * i + (lane >> 5); scr[kk * 33 + (lane & 31)] = W[(size_t)(k0 + kk) * ldw + src_col0 + (lane & 31)]; }
    LDS_WAIT(); asm volatile("" ::: "memory");
    const int c = lane & 7;
#pragma unroll
    for (int j = 0; j < 4; ++j) { const int n = (lane >> 3) + 8 * j; const LAS float* s = scr + (8 * c) * 33 + n;
        u32x4 o; o.x = cvt_pk_bf16(s[0 * 33], s[1 * 33]); o.y = cvt_pk_bf16(s[2 * 33], s[3 * 33]); o.z = cvt_pk_bf16(s[4 * 33], s[5 * 33]); o.w = cvt_pk_bf16(s[6 * 33], s[7 * 33]);
        *(u32x4*)(WT + (size_t)(dst_row0 + n) * ldt + k0 + 8 * c) = o; }
    LDS_WAIT(); asm volatile("" ::: "memory");
}
__device__ __forceinline__ void cvt_item8(const float* W, int ldw, int src_col0, unsigned char* WT, int ldt, int dst_row0, int k0, float sc, LAS float* scr, int lane) {
#pragma unroll 8
    for (int i = 0; i < 32; ++i) { const int kk = 2 * i + (lane >> 5); scr[kk * 33 + (lane & 31)] = W[(size_t)(k0 + kk) * ldw + src_col0 + (lane & 31)]; }
    LDS_WAIT(); asm volatile("" ::: "memory");
    const int c = lane & 7;
#pragma unroll
    for (int j = 0; j < 4; ++j) { const int n = (lane >> 3) + 8 * j; const LAS float* s = scr + (8 * c) * 33 + n;
        *(u32x2*)(WT + (size_t)(dst_row0 + n) * ldt + k0 + 8 * c) = (u32x2){pk_fp8x4(s[0 * 33] * sc, s[1 * 33] * sc, s[2 * 33] * sc, s[3 * 33] * sc), pk_fp8x4(s[4 * 33] * sc, s[5 * 33] * sc, s[6 * 33] * sc, s[7 * 33] * sc)}; }
    LDS_WAIT(); asm volatile("" ::: "memory");
}
enum { MAP_ID = 0, MAP_QKV = 1, MAP_SWI = 2 };
template <bool F8 = false>
__device__ __forceinline__ void cvt_family(const float* src, size_t sstride, int ninst, int ldw, int K, int ng, int map, int F, bf16_t* dst, size_t dstride,
                                           LAS float* scr, int gw, int NGW, int lane) {
    const int nkb = K / 64, per = nkb * ng, total = ninst * per;
    for (int it = gw; it < total; it += NGW) {
        const int inst = it / per, r = it - inst * per, kb = r / ng, gi = r - kb * ng;
        int sc0;
        if (map == MAP_ID) sc0 = 32 * gi;
        else if (map == MAP_QKV) { const int pn = gi >> 3, bj = (gi >> 2) & 1, wc = gi & 3;
            if (pn < 8) { const int part = pn >> 2, sh = 4 * (pn & 3) + wc; sc0 = part * 1024 + sh * 64 + 32 * bj; } else sc0 = 32 * gi; }
        else { const int pn = gi >> 3, bj = (gi >> 2) & 1, q = gi & 3; sc0 = bj * F + pn * 128 + 32 * q; }
        if constexpr (F8) cvt_item8(src + (size_t)inst * sstride, ldw, sc0, (unsigned char*)dst + (size_t)inst * dstride, K, 32 * gi, 64 * kb, MOE_WSCALE, scr, lane);
        else cvt_item(src + (size_t)inst * sstride, ldw, sc0, dst + (size_t)inst * dstride, K, 32 * gi, 64 * kb, scr, lane);
    }
}

__device__ __forceinline__ void prologue_phase(const Args& A, LAS unsigned char* lds, int bid, int G) {
    const int tid = threadIdx.x, lane = tid & 63, wave = tid >> 6;
    unsigned char* ws = A.ws;
    {
        LAS float* sc = (LAS float*)lds;
        LAS float* red = (LAS float*)(lds + 32768);
        for (int i = tid; i < NBATCH * DM; i += NTHR) { const float cv = A.in[I_C][i]; sc[i] = fsilu(cv); }
        __syncthreads();
        float* mods = (float*)(ws + TB_MODS);
        for (int cb = bid; cb < (DEPTH * 6144) / 128; cb += G) {
            const int col = cb * 128 + (tid & 127), l = col / 6144, e = col - l * 6144, ch = tid >> 7;
            const float* wp = A.in[I_ADAW] + (size_t)l * DM * 6144 + e;
            float a[NBATCH];
#pragma unroll
            for (int b = 0; b < NBATCH; ++b) a[b] = 0.f;
#pragma unroll 4
            for (int d = ch * 256; d < ch * 256 + 256; ++d) { const float w = wp[(size_t)d * 6144];
#pragma unroll
                for (int b = 0; b < NBATCH; ++b) a[b] += sc[b * DM + d] * w; }
#pragma unroll
            for (int b = 0; b < NBATCH; ++b) red[(ch * 128 + (tid & 127)) * 8 + b] = a[b];
            __syncthreads();
            if (tid < 128) { const float bias = A.in[I_ADAB][l * 6144 + e];
#pragma unroll
                for (int b = 0; b < NBATCH; ++b) { const float s = ((red[(0 * 128 + tid) * 8 + b] + red[(1 * 128 + tid) * 8 + b]) + (red[(2 * 128 + tid) * 8 + b] + red[(3 * 128 + tid) * 8 + b])) + bias;
                    mods[((size_t)l * NBATCH + b) * 6144 + e] = s; } }
            __syncthreads();
        }
    }
    {
        float* cosT = (float*)(ws + TB_COS); float* sinT = (float*)(ws + TB_SIN);
        for (int i = bid * NTHR + tid; i < SEQ * 32; i += G * NTHR) {
            const int pos = i >> 5, d = i & 31;
            const float inv = (float)exp(-(double)d * (1.0 / 32.0) * 9.210340371976184);
            const float ang = (float)pos * inv;
            const double rev = (double)ang * 0.15915494309189535; const float fr = (float)(rev - floor(rev));
            cosT[i] = __builtin_amdgcn_cosf(fr); sinT[i] = __builtin_amdgcn_sinf(fr);
        }
        if (bid == 0 && tid < 2) {
            const int a = tid; const float* lm = A.in[I_ATLAM] + a * 256;
            float s1 = 0.f, s2 = 0.f; for (int i = 0; i < 64; ++i) { s1 += lm[i] * lm[64 + i]; s2 += lm[128 + i] * lm[192 + i]; }
            const float linit = 0.8f - 0.6f * expf(-0.3f * (float)(3 * a));
            float mq = 0.f, mk = 0.f; for (int i = 0; i < 64; ++i) { mq = fmaxf(mq, fabsf(A.in[I_ATQN][a * 64 + i])); mk = fmaxf(mk, fabsf(A.in[I_ATKN][a * 64 + i])); }
            float* scal = (float*)(ws + TB_SCAL);
            scal[SC_LAM0 + a] = expf(s1) - expf(s2) + linit; scal[SC_OML0 + a] = 1.0f - linit; scal[SC_MC0 + a] = 8.0f * mq * mk * LOG2E * 1.0001f;
        }
        if (bid == 1) {
            float* lb = (float*)(ws + TB_LB);
            for (int i = tid; i < 2 * 1024; i += NTHR) { const int d = i >> 10, k = i & 1023; const float* p = A.in[I_HGLB] + (size_t)d * DEPTH * 1024 + k;
                float mx = p[0]; for (int l = 1; l < DEPTH; ++l) mx = fmaxf(mx, p[l * 1024]);
                float den = 0.f, num = 0.f; for (int l = 0; l < DEPTH; ++l) { const float e = expf(p[l * 1024] - mx); den += e; if (l == 1) num += e; }
                lb[i] = num / den; }
        }
        if (bid == 2) {
            float* sp = (float*)(ws + TB_SP);
            for (int i = tid; i < 2 * LRUW; i += NTHR) { const float x = -A.in[I_LRLAM][i]; sp[i] = (x > 20.f) ? x : log1pf(expf(x)); }
        }
    }
    {
        LAS float* scr = (LAS float*)(lds + wave * 16384);
        const int vcu = (bid % 8) * (G / 8) + bid / 8;
        const int gw = vcu * NWAVES + wave, NGW = G * NWAVES;
        cvt_family(A.in[I_ATWIN], (size_t)1024 * 3072, 2, 3072, 1024, 96, MAP_QKV, 0, (bf16_t*)(ws + W_QKV), (size_t)3072 * 1024, scr, gw, NGW, lane);
        cvt_family(A.in[I_ATWOUT], (size_t)1024 * 1024, 2, 1024, 1024, 32, MAP_ID, 0, (bf16_t*)(ws + W_AO), (size_t)1024 * 1024, scr, gw, NGW, lane);
        cvt_family(A.in[I_HGWIN], 0, 1, 5120, 1024, 160, MAP_ID, 0, (bf16_t*)(ws + W_HGI), 0, scr, gw, NGW, lane);
        cvt_family(A.in[I_HGWOUT], 0, 1, 1024, 1024, 32, MAP_ID, 0, (bf16_t*)(ws + W_HGO), 0, scr, gw, NGW, lane);
        cvt_family(A.in[I_LRWIN], 0, 1, 2560, 1024, 80, MAP_ID, 0, (bf16_t*)(ws + W_LRI), 0, scr, gw, NGW, lane);
        cvt_family(A.in[I_LRWOUT], 0, 1, 1024, 1280, 32, MAP_ID, 0, (bf16_t*)(ws + W_LRO), 0, scr, gw, NGW, lane);
        for (int it = gw; it < 2 * 20 * 2 * 4; it += NGW) {
            const int part = it / 160, r = it % 160, inst = r >> 3, kb = (r >> 2) & 1, gi = r & 3, d = inst / 10, n = inst % 10;
            const float* src = (part ? A.in[I_LRWX] : A.in[I_LRWA]) + (size_t)inst * 16384;
            cvt_item(src, 128, 32 * gi, (bf16_t*)(ws + W_LRG) + (size_t)(n * 2 + d) * 256 * 128, 128, part * 128 + 32 * gi, 64 * kb, scr, lane);
        }
        static_assert(FP8_DENSE_FROM == 2 || FP8_DENSE_FROM > 3, "dense layer 0 stays bf16; layer 2 optional");
        constexpr int NB16 = (FP8_DENSE_FROM == 2) ? 1 : 2;
        cvt_family(A.in[I_FFGU], (size_t)1024 * 5632, NB16, 5632, 1024, 176, MAP_SWI, DFF, (bf16_t*)(ws + W_FGU), (size_t)5632 * 1024, scr, gw, NGW, lane);
        cvt_family(A.in[I_FFDN], (size_t)2816 * 1024, NB16, 1024, 2816, 32, MAP_ID, 0, (bf16_t*)(ws + W_FDN), (size_t)1024 * 2816, scr, gw, NGW, lane);
        if constexpr (NB16 == 1) {
            cvt_family<true>(A.in[I_FFGU] + (size_t)1024 * 5632, 0, 1, 5632, 1024, 176, MAP_SWI, DFF, (bf16_t*)(ws + W_FGU) + (size_t)5632 * 1024, 0, scr, gw, NGW, lane);
            cvt_family<true>(A.in[I_FFDN] + (size_t)2816 * 1024, 0, 1, 1024, 2816, 32, MAP_ID, 0, (bf16_t*)(ws + W_FDN) + (size_t)1024 * 2816, 0, scr, gw, NGW, lane);
        }
        cvt_family<true>(A.in[I_MOEGU], (size_t)1024 * 7168, 16, 7168, 1024, 224, MAP_SWI, DFFE, (bf16_t*)(ws + W_MGU), (size_t)7168 * 1024, scr, gw, NGW, lane);
        cvt_family<true>(A.in[I_MOEDN], (size_t)3584 * 1024, 16, 1024, 3584, 32, MAP_ID, 0, (bf16_t*)(ws + W_MDN), (size_t)1024 * 3584, scr, gw, NGW, lane);
    }
}

template <bool ROUTER>
__device__ __forceinline__ void norm_phase(const Args& A, LAS unsigned char* lds, int bid, int G, const float* xsrc, float* xdst, const float* gain, const float* modl  , int which,
                                           bool combine, const float* modprev  , bool nonorm, const float* router, bool f8out = false) {
    int tid_ = threadIdx.x; asm volatile("" : "+v"(tid_));
    const int tid = tid_, lane = tid & 63, wave = tid >> 6;
    unsigned char* ws = A.ws;
    bf16_t* HM = (bf16_t*)(ws + WS_HM);
    const int* slot = (const int*)(ws + TB_SLOT); const float* gts = (const float*)(ws + TB_GATE);
    const bf16_t* Y = (const bf16_t*)(ws + E_XS);
    LAS int* hist = (LAS int*)lds;
    for (int tb = bid; tb < MTOK / 256; tb += G) {
        const int b = tb >> 5;
        f32x4 ga[4], sh[4], g2[4];
#pragma unroll
        for (int j = 0; j < 4; ++j) { const int c = 256 * j + 4 * lane;
            if (!nonorm) { const f32x4 gv = *(const f32x4*)(gain + c), sv = *(const f32x4*)(modl + (size_t)b * 6144 + (which * 3 + 1) * 1024 + c);
                ga[j] = gv * (sv + 1.0f); sh[j] = *(const f32x4*)(modl + (size_t)b * 6144 + (which * 3) * 1024 + c); }
            if (combine) g2[j] = *(const f32x4*)(modprev + (size_t)b * 6144 + 5 * 1024 + c); }
        f32x4 rw[ROUTER ? 32 : 1];
        if constexpr (ROUTER) {
            if (tid < 8) hist[tid] = 0;
#pragma unroll
            for (int j = 0; j < 4; ++j)
#pragma unroll
                for (int i = 0; i < 4; ++i) { const int c = 256 * j + 4 * lane + i; rw[(j * 4 + i) * 2] = *(const f32x4*)(router + c * 8); rw[(j * 4 + i) * 2 + 1] = *(const f32x4*)(router + c * 8 + 4); }
            __syncthreads();
        }
        for (int i = 0; i < 32; ++i) {
            const int row = tb * 256 + wave * 32 + i;
            const float* xr = xsrc + (size_t)row * DM;
            f32x4 v[4];
#pragma unroll
            for (int j = 0; j < 4; ++j) v[j] = *(const f32x4*)(xr + 256 * j + 4 * lane);
            if (combine) {
                const int s0 = slot[row * 2], s1 = slot[row * 2 + 1]; const float w0 = gts[row * 2], w1 = gts[row * 2 + 1];
#pragma unroll
                for (int j = 0; j < 4; ++j) { const u32x2 a = *(const u32x2*)(Y + (size_t)s0 * DM + 256 * j + 4 * lane), c2 = *(const u32x2*)(Y + (size_t)s1 * DM + 256 * j + 4 * lane);
                    f32x4 y; y[0] = w0 * bflo(a.x) + w1 * bflo(c2.x); y[1] = w0 * bfhi(a.x) + w1 * bfhi(c2.x); y[2] = w0 * bflo(a.y) + w1 * bflo(c2.y); y[3] = w0 * bfhi(a.y) + w1 * bfhi(c2.y);
                    v[j] = v[j] + g2[j] * y; *(f32x4*)(xdst + (size_t)row * DM + 256 * j + 4 * lane) = v[j]; }
            }
            if (nonorm) continue;
            float ss = 0.f;
#pragma unroll
            for (int j = 0; j < 4; ++j) ss += (v[j][0] * v[j][0] + v[j][1] * v[j][1]) + (v[j][2] * v[j][2] + v[j][3] * v[j][3]);
            ss = wave_sum(ss);
            const float rstd = 1.0f / sqrtf(ss * (1.0f / DM) + EPS);
            f32x4 h[4];
#pragma unroll
            for (int j = 0; j < 4; ++j) { h[j] = v[j] * rstd * ga[j] + sh[j];
                if (f8out) { *(unsigned*)((unsigned char*)HM + (size_t)row * DM + 256 * j + 4 * lane) = pk_fp8x4(h[j][0], h[j][1], h[j][2], h[j][3]); }
                else { u32x2 w; w.x = cvt_pk_bf16(h[j][0], h[j][1]); w.y = cvt_pk_bf16(h[j][2], h[j][3]);
                    *(u32x2*)(HM + (size_t)row * DM + 256 * j + 4 * lane) = w; } }
            if constexpr (ROUTER) {
                float lg[8];
#pragma unroll
                for (int e = 0; e < 8; ++e) lg[e] = 0.f;
#pragma unroll
                for (int j = 0; j < 4; ++j)
#pragma unroll
                    for (int q = 0; q < 4; ++q) { const float hv = h[j][q]; const f32x4 r0 = rw[(j * 4 + q) * 2], r1 = rw[(j * 4 + q) * 2 + 1];
                        lg[0] += hv * r0[0]; lg[1] += hv * r0[1]; lg[2] += hv * r0[2]; lg[3] += hv * r0[3]; lg[4] += hv * r1[0]; lg[5] += hv * r1[1]; lg[6] += hv * r1[2]; lg[7] += hv * r1[3]; }
#pragma unroll
                for (int e = 0; e < 8; ++e) lg[e] = wave_sum(lg[e]);
                int e0 = 0; float v0 = lg[0];
#pragma unroll
                for (int e = 1; e < 8; ++e) if (lg[e] > v0) { v0 = lg[e]; e0 = e; }
                int e1 = -1; float v1 = -3.0e38f;
#pragma unroll
                for (int e = 0; e < 8; ++e) if (e != e0 && lg[e] > v1) { v1 = lg[e]; e1 = e; }
                const float p1 = frcp(1.0f + fexp(v1 - v0));
                if (lane == 0) { int* eid = (int*)(ws + TB_EID); float* gt = (float*)(ws + TB_GATE);
                    eid[row * 2] = e0; eid[row * 2 + 1] = e1; gt[row * 2] = p1; gt[row * 2 + 1] = 1.0f - p1;
                    atomicAdd((int*)&hist[e0], 1); atomicAdd((int*)&hist[e1], 1); }
            }
        }
        if constexpr (ROUTER) {
            __syncthreads();
            if (tid < 8) ((int*)(ws + TB_BCNT))[tb * 8 + tid] = hist[tid];
            __syncthreads();
        }
    }
}

namespace lru {
constexpr int XCF = 0, XCB = 16384, AA = 24576, UU = 40960;
__device__ __forceinline__ int sw256(int row, int cb) { return row * 256 + (cb ^ ((row & 7) << 4)); }
__device__ __forceinline__ int crow(int r, int hi) { return (r & 3) + 8 * (r >> 2) + 4 * hi; }
template <int MODE>
__device__ __forceinline__ void lru_item(const Args& A, LAS unsigned char* lds, int b, int n, int seg, int dir) {
    int tid_ = threadIdx.x; asm volatile("" : "+v"(tid_));
    const int tid = tid_, wid = tid >> 6, lane = tid & 63, r = lane & 31, hh = lane >> 5;
    unsigned char* ws = A.ws;
    const bf16_t* XB = (const bf16_t*)(ws + L_XB); const bf16_t* YB = (const bf16_t*)(ws + L_YB); bf16_t* HF = (bf16_t*)(ws + L_HF); bf16_t* HY = (bf16_t*)(ws + L_HY);
    const bf16_t* Wg = (const bf16_t*)(ws + W_LRG) + (size_t)((n * 2 + dir) * 256 + ((r < 16) ? (16 * wid + r) : (128 + 16 * wid + r - 16))) * 128 + 8 * hh;
    bf16x8 bfrag[8];
#pragma unroll
    for (int ks = 0; ks < 8; ++ks) bfrag[ks] = *(const bf16x8*)(Wg + 16 * ks);
    const int cch = n * 128 + 16 * wid + (r & 15);
    const float ba = A.in[I_LRBA][dir * LRUW + cch], bx = A.in[I_LRBX][dir * LRUW + cch], sp = ((const float*)(ws + TB_SP))[dir * LRUW + cch];
    const int ct = tid >> 4, cg = tid & 15, cc0 = n * 128 + 8 * cg;
    float cw[4][8], cb[8];
#pragma unroll
    for (int j = 0; j < 8; ++j) { cb[j] = A.in[I_LRCB][cc0 + j];
#pragma unroll
        for (int w = 0; w < 4; ++w) cw[w][j] = A.in[I_LRCW][w * LRUW + cc0 + j]; }
    float carry = 0.f, P = 1.f;
    if (MODE != 0 && tid < 128) carry = ((const float*)(ws + TB_LCIN))[(size_t)((b * 32 + seg) * 2 + dir) * LRUW + n * 128 + tid];
    u32x4 xr[4];
#define LRU_XLOAD(si_) do { const int sub_ = dir ? (7 - (si_)) : (si_); const int tok_ = seg * 256 + sub_ * 32 + ct; \
        _Pragma("unroll") for (int w = 0; w < 4; ++w) { const int tt = tok_ - 1 + w; xr[w] = (tt >= 0 && tt < SEQ) ? *(const u32x4*)(XB + ((size_t)b * SEQ + tt) * LRUW + cc0) : (u32x4){0u, 0u, 0u, 0u}; } } while (0)
    LRU_XLOAD(0);
    for (int si = 0; si < 8; ++si) {
        const int sub = dir ? (7 - si) : si; const int t0 = seg * 256 + sub * 32;
        {
            float xc[8];
#pragma unroll
            for (int j = 0; j < 8; ++j) xc[j] = cb[j];
#pragma unroll
            for (int w = 0; w < 4; ++w) { const u32x4 v = xr[w];
#pragma unroll
                for (int e = 0; e < 4; ++e) { xc[2 * e] += cw[w][2 * e] * bflo(v[e]); xc[2 * e + 1] += cw[w][2 * e + 1] * bfhi(v[e]); } }
            if (si + 1 < 8) LRU_XLOAD(si + 1);
            *(LAS f32x4*)(lds + XCF + (ct * 128 + 8 * cg) * 4) = (f32x4){xc[0], xc[1], xc[2], xc[3]};
            *(LAS f32x4*)(lds + XCF + (ct * 128 + 8 * cg + 4) * 4) = (f32x4){xc[4], xc[5], xc[6], xc[7]};
            *(LAS u32x4*)(lds + XCB + sw256(ct, 16 * cg)) = (u32x4){cvt_pk_bf16(xc[0], xc[1]), cvt_pk_bf16(xc[2], xc[3]), cvt_pk_bf16(xc[4], xc[5]), cvt_pk_bf16(xc[6], xc[7])};
        }
        __syncthreads();
        {
            f32x16 acc = {};
#pragma unroll
            for (int ks = 0; ks < 8; ++ks) { const bf16x8 fa = *(const LAS bf16x8*)(lds + XCB + sw256(r, (16 * ks + 8 * hh) * 2)); acc = __builtin_amdgcn_mfma_f32_32x32x16_bf16(fa, bfrag[ks], acc, 0, 0, 0); }
#pragma unroll
            for (int q = 0; q < 8; ++q) {
                const float send = (r < 16) ? acc[8 + q] : acc[q]; const float recv = __shfl_xor(send, 16);
                const float rp = (r < 16) ? acc[q] : recv, ip = (r < 16) ? recv : acc[8 + q];
                const int tq = crow((r < 16) ? q : (8 + q), hh); const int cl = 16 * wid + (r & 15);
                const float xcv = ((const LAS float*)(lds + XCF))[tq * 128 + cl];
                const float rg = fsigmoid(rp + ba), ig = fsigmoid(ip + bx); const float la = -8.0f * rg * sp;
                const float av = fexp(la), uv = sqrtf(fmaxf(1.0f - av * av, 0.f)) * ig * xcv;
                ((LAS float*)(lds + AA))[tq * 128 + cl] = av; ((LAS float*)(lds + UU))[tq * 128 + cl] = uv; }
        }
        __syncthreads();
        if (tid < 128) {
            LAS float* ap = (LAS float*)(lds + AA) + tid; LAS float* up = (LAS float*)(lds + UU) + tid; float av[32], uv[32];
#pragma unroll
            for (int i = 0; i < 32; ++i) { av[i] = ap[i * 128]; uv[i] = up[i * 128]; }
            if (dir == 0) {
#pragma unroll
                for (int i = 0; i < 32; ++i) { carry = av[i] * carry + uv[i]; if (MODE == 0) P *= av[i]; else uv[i] = carry; } }
            else {
#pragma unroll
                for (int i = 31; i >= 0; --i) { carry = av[i] * carry + uv[i]; if (MODE == 0) P *= av[i]; else uv[i] = carry; } }
            if (MODE != 0) {
#pragma unroll
                for (int i = 0; i < 32; ++i) up[i * 128] = uv[i]; }
        }
        if (MODE != 0) {
            __syncthreads();
            const int tok = t0 + ct; const size_t go = ((size_t)b * SEQ + tok) * LRUW + cc0;
            const f32x4 h0 = *(const LAS f32x4*)(lds + UU + (ct * 128 + 8 * cg) * 4), h1 = *(const LAS f32x4*)(lds + UU + (ct * 128 + 8 * cg + 4) * 4);
            if (MODE == 1) { *(u32x4*)(HF + go) = (u32x4){cvt_pk_bf16(h0[0], h0[1]), cvt_pk_bf16(h0[2], h0[3]), cvt_pk_bf16(h1[0], h1[1]), cvt_pk_bf16(h1[2], h1[3])}; }
            else { const u32x4 f = *(const u32x4*)(HF + go), y = *(const u32x4*)(YB + go);
                *(u32x4*)(HY + go) = (u32x4){cvt_pk_bf16((h0[0] + bflo(f[0])) * bflo(y[0]), (h0[1] + bfhi(f[0])) * bfhi(y[0])), cvt_pk_bf16((h0[2] + bflo(f[1])) * bflo(y[1]), (h0[3] + bfhi(f[1])) * bfhi(y[1])),
                                            cvt_pk_bf16((h1[0] + bflo(f[2])) * bflo(y[2]), (h1[1] + bfhi(f[2])) * bfhi(y[2])), cvt_pk_bf16((h1[2] + bflo(f[3])) * bflo(y[3]), (h1[3] + bfhi(f[3])) * bfhi(y[3]))}; }
        }
        __syncthreads();
    }
#undef LRU_XLOAD
    if (MODE == 0 && tid < 128) { float* sm = (float*)(ws + TB_LSUM) + (size_t)(((b * 32 + seg) * 2 + dir) * 2) * LRUW + n * 128 + tid; sm[0] = P; sm[LRUW] = carry; }
}
}
template <int MODE>
__device__ __forceinline__ void lru_phase(const Args& A, LAS unsigned char* lds, int bid, int G) {
    const int nitems = (MODE == 0) ? 5120 : 2560;
    for (int it = bid; it < nitems; it += G) {
        int b, n, seg, dir;
        if (MODE == 0) { dir = it & 1; const int r = it >> 1; seg = r & 31; n = (r >> 5) % 10; b = r / 320; }
        else { dir = MODE - 1; seg = it & 31; n = (it >> 5) % 10; b = it / 320; }
        lru::lru_item<MODE>(A, lds, b, n, seg, dir);
    }
}
__device__ __forceinline__ void lru_carry_phase(const Args& A, int bid, int G) {
    const float* sm = (const float*)(A.ws + TB_LSUM); float* cin = (float*)(A.ws + TB_LCIN);
    for (int idx = bid * NTHR + threadIdx.x; idx < NBATCH * 2 * LRUW; idx += G * NTHR) {
        const int b = idx / (2 * LRUW), r = idx % (2 * LRUW), dir = r / LRUW, ch = r % LRUW; float carry = 0.f;
        for (int i = 0; i < 32; ++i) { const int sg = dir ? (31 - i) : i; const size_t o = (size_t)((b * 32 + sg) * 2 + dir);
            cin[o * LRUW + ch] = carry; carry = sm[o * 2 * LRUW + ch] * carry + sm[o * 2 * LRUW + LRUW + ch]; }
    }
}

__device__ __forceinline__ void place_phase(const Args& A, LAS unsigned char* lds, int bid, int G) {
    int tid_ = threadIdx.x; asm volatile("" : "+v"(tid_));
    const int tid = tid_, lane = tid & 63, wave = tid >> 6; unsigned char* ws = A.ws;
    const int* bcnt = (const int*)(ws + TB_BCNT); const int* eid = (const int*)(ws + TB_EID); int* slot = (int*)(ws + TB_SLOT);
    const bf16_t* HM = (const bf16_t*)(ws + WS_HM); bf16_t* XS = (bf16_t*)(ws + E_XS);
    LAS int* tot = (LAS int*)lds; LAS int* pre = tot + 8; LAS int* rb = tot + 16; LAS int* wcn = tot + 32; LAS int* sl = tot + 64;
    for (int tb = bid; tb < MTOK / 256; tb += G) {
        { int t_ = 0, p_ = 0;
#pragma unroll
            for (int j = 0; j < 4; ++j) { const int blk = lane + 64 * j; const int v = bcnt[blk * 8 + wave]; t_ += v; p_ += (blk < tb) ? v : 0; }
#pragma unroll
            for (int o = 1; o < 64; o <<= 1) { t_ += __shfl_xor(t_, o); p_ += __shfl_xor(p_, o); }
            if (lane == 0) { tot[wave] = t_; pre[wave] = p_; } }
        __syncthreads();
        if (tid == 0) { int acc = 0; for (int e = 0; e < 8; ++e) { rb[e] = acc * 256; if (tb == 0) ((int*)(ws + TB_TILES))[e] = acc; acc += (tot[e] + 255) >> 8; } if (tb == 0) ((int*)(ws + TB_TILES))[8] = acc; }
        int e0 = -1, e1 = -1; unsigned long long mk0 = 0, mk1 = 0;
        if (tid < 256) { e0 = eid[(tb * 256 + tid) * 2]; e1 = eid[(tb * 256 + tid) * 2 + 1];
#pragma unroll
            for (int e = 0; e < 8; ++e) { const unsigned long long m = __ballot(e0 == e || e1 == e); if (lane == 0) wcn[wave * 8 + e] = __popcll(m); if (e0 == e) mk0 = m; if (e1 == e) mk1 = m; } }
        __syncthreads();
        if (tid < 256) { const unsigned long long lt = (1ull << lane) - 1ull; int b0 = rb[e0] + pre[e0] + __popcll(mk0 & lt), b1 = rb[e1] + pre[e1] + __popcll(mk1 & lt);
            for (int w = 0; w < wave; ++w) { b0 += wcn[w * 8 + e0]; b1 += wcn[w * 8 + e1]; }
            sl[tid * 2] = b0; sl[tid * 2 + 1] = b1; slot[(tb * 256 + tid) * 2] = b0; slot[(tb * 256 + tid) * 2 + 1] = b1; }
        __syncthreads();
        for (int i = 0; i < 32; ++i) { const int t = wave * 32 + i; const int s0 = sl[t * 2], s1 = sl[t * 2 + 1];
            const bf16_t* src = HM + (size_t)(tb * 256 + t) * DM + lane * 16;
            const u32x4 a = *(const u32x4*)src, b = *(const u32x4*)(src + 8);
            const u32x4 q = {pk_fp8x4(bflo(a[0]), bfhi(a[0]), bflo(a[1]), bfhi(a[1])), pk_fp8x4(bflo(a[2]), bfhi(a[2]), bflo(a[3]), bfhi(a[3])),
                             pk_fp8x4(bflo(b[0]), bfhi(b[0]), bflo(b[1]), bfhi(b[1])), pk_fp8x4(bflo(b[2]), bfhi(b[2]), bflo(b[3]), bfhi(b[3]))};
            *(u32x4*)((unsigned char*)XS + (size_t)s0 * DM + lane * 16) = q; *(u32x4*)((unsigned char*)XS + (size_t)s1 * DM + lane * 16) = q; }
        __syncthreads();
    }
}

namespace att {
constexpr int KVBLK = 64;
constexpr int SHM_V = KVBLK * 128 * 2, SHM_K = KVBLK * 128 * 2;
#define KSWZ(row, colB) ((row) * 256 + ((colB) ^ (((row) & 7) << 4)))
#define SBAR() __builtin_amdgcn_sched_barrier(0)
__device__ __forceinline__ int crow(int r, int hi) { return (r & 3) + 8 * (r >> 2) + 4 * hi; }
__device__ __forceinline__ int v_st(int k, int c) { const int kk = (k & ~0xC) | ((k & 4) << 1) | ((k & 8) >> 1); return ((kk >> 3) * 4 + (c >> 5)) * 512 + ((kk & 7) * 32 + (c & 31)) * 2; }
__device__ __forceinline__ int v_rd_base(int lane) { return ((lane & 3) << 3) | (((lane >> 2) & 3) << 6) | (((lane >> 4) & 1) << 5) | (((lane >> 5) & 1) << 8); }
constexpr int v_rd_off(int d0, int ks, int half) { return d0 * 512 + ks * 4096 + half * 2048; }
template <int OFF> __device__ __forceinline__ s16x4 tr_read(int vb) {
    s16x4 r; asm volatile("ds_read_b64_tr_b16 %0, %1 offset:%2" : "=&v"(r) : "v"(vb), "i"(OFF) : "memory"); return r;
}
template <int D0> __device__ __forceinline__ void pv_one(f32x16& od, int vb, bf16x8 pa0, bf16x8 pa1, bf16x8 pa2, bf16x8 pa3) {
    const s16x4 l0 = tr_read<v_rd_off(D0, 0, 0)>(vb), h0 = tr_read<v_rd_off(D0, 0, 1)>(vb), l1 = tr_read<v_rd_off(D0, 1, 0)>(vb), h1 = tr_read<v_rd_off(D0, 1, 1)>(vb);
    const s16x4 l2 = tr_read<v_rd_off(D0, 2, 0)>(vb), h2 = tr_read<v_rd_off(D0, 2, 1)>(vb), l3 = tr_read<v_rd_off(D0, 3, 0)>(vb), h3 = tr_read<v_rd_off(D0, 3, 1)>(vb);
    asm volatile("s_waitcnt lgkmcnt(0)" ::: "memory"); SBAR();
#define PK(L, H) (bf16x8){L[0], L[1], L[2], L[3], H[0], H[1], H[2], H[3]}
    od = __builtin_amdgcn_mfma_f32_32x32x16_bf16(pa0, PK(l0, h0), od, 0, 0, 0);
    od = __builtin_amdgcn_mfma_f32_32x32x16_bf16(pa1, PK(l1, h1), od, 0, 0, 0);
    od = __builtin_amdgcn_mfma_f32_32x32x16_bf16(pa2, PK(l2, h2), od, 0, 0, 0);
    od = __builtin_amdgcn_mfma_f32_32x32x16_bf16(pa3, PK(l3, h3), od, 0, 0, 0);
#undef PK
}
__device__ __forceinline__ void pv_d0(f32x16* o, int vb, bf16x8 pa0, bf16x8 pa1, bf16x8 pa2, bf16x8 pa3) {
    pv_one<0>(o[0], vb, pa0, pa1, pa2, pa3); pv_one<1>(o[1], vb, pa0, pa1, pa2, pa3); pv_one<2>(o[2], vb, pa0, pa1, pa2, pa3); pv_one<3>(o[3], vb, pa0, pa1, pa2, pa3);
}
__device__ __forceinline__ void partialSM(f32x16& p0, f32x16& p1, float Mc) {
#pragma unroll
    for (int r = 0; r < 16; ++r) p0[r] = fexp2(p0[r]);
}
__device__ __forceinline__ void finishSM(f32x16& p0, f32x16& p1, float& l_reg, bf16x8& pa0, bf16x8& pa1, bf16x8& pa2, bf16x8& pa3) {
#pragma unroll
    for (int r = 0; r < 16; ++r) p1[r] = fexp2(p1[r]);
    float ps = 0;
#pragma unroll
    for (int r = 0; r < 16; ++r) ps += p0[r];
#pragma unroll
    for (int r = 0; r < 16; ++r) ps += p1[r];
    { auto rr = __builtin_amdgcn_permlane32_swap(__float_as_uint(ps), __float_as_uint(ps), false, false);
      ps = __uint_as_float(rr[0]) + __uint_as_float(rr[1]); }
    l_reg += ps;
#define PK4(P, BASE, OUT) do { unsigned a0 = cvt_pk_bf16(P[BASE + 0], P[BASE + 1]), a1 = cvt_pk_bf16(P[BASE + 2], P[BASE + 3]);   \
    unsigned b0 = cvt_pk_bf16(P[BASE + 4], P[BASE + 5]), b1 = cvt_pk_bf16(P[BASE + 6], P[BASE + 7]);                              \
    auto r0 = __builtin_amdgcn_permlane32_swap(a0, b0, false, false); auto r1 = __builtin_amdgcn_permlane32_swap(a1, b1, false, false); \
    u32x4 w = {r0[0], r1[0], r0[1], r1[1]}; OUT = *reinterpret_cast<bf16x8*>(&w); } while (0)
    PK4(p0, 0, pa0); PK4(p0, 8, pa1); PK4(p1, 0, pa2); PK4(p1, 8, pa3);
#undef PK4
}
__device__ __forceinline__ void qkt(f32x16& p0, f32x16& p1, const LAS char* Ks, const bf16x8* qr, int r32, int hi, int jj, float nMc) {
#pragma unroll
    for (int r = 0; r < 16; ++r) { p0[r] = nMc; p1[r] = nMc; }
#pragma unroll
    for (int d0 = 0; d0 < 4; ++d0) { const int cb = ((jj * 4 + d0) * 16 + hi * 8) * 2;
        const bf16x8 b0 = *(const LAS bf16x8*)(Ks + KSWZ(r32, cb));
        const bf16x8 b1 = *(const LAS bf16x8*)(Ks + KSWZ(32 + r32, cb));
        p0 = __builtin_amdgcn_mfma_f32_32x32x16_bf16(b0, qr[d0], p0, 0, 0, 0);
        p1 = __builtin_amdgcn_mfma_f32_32x32x16_bf16(b1, qr[d0], p1, 0, 0, 0); }
}
constexpr int SLOTB = 16384;
__device__ __forceinline__ int k_slot(int s) { return (s & 1) * SLOTB + (s >> 1) * 65536; }
__device__ __forceinline__ int v_slot(int s) { return 32768 + (s & 1) * SLOTB + (s >> 1) * 65536; }
}

__device__ __forceinline__ void attn_phase(const Args& A, LAS unsigned char* ldsu, int bid, int G, int al) {
    using namespace att;
    LAS char* lds = (LAS char*)ldsu;
    unsigned char* ws = A.ws;
    const bf16_t* Qg = (const bf16_t*)(ws + A_Q); const bf16_t* Kg = (const bf16_t*)(ws + A_K); const bf16_t* Vg = (const bf16_t*)(ws + A_V);
    bf16_t* Og = (bf16_t*)(ws + WS_HM);
    const float* scal = (const float*)(ws + TB_SCAL);
    const float lamv = scal[SC_LAM0 + al], omli = scal[SC_OML0 + al], Mc = scal[SC_MC0 + al];
    const float* subg = A.in[I_ATSUB] + al * 128;
    int tid_ = threadIdx.x; asm volatile("" : "+v"(tid_));
    const int tid = tid_, wid = __builtin_amdgcn_readfirstlane(tid >> 6), lane = tid & 63, r32 = lane & 31, hi = lane >> 5, jj = wid >> 2, wq = wid & 3;
    constexpr int NT = SEQ / KVBLK;
    unsigned koff[2], voff[2];
#pragma unroll
    for (int i = 0; i < 2; ++i) { const int bb = wid * 2048 + i * 1024 + lane * 16;
        { const int row = bb >> 8, colB = (bb & 255) ^ ((row & 7) << 4); koff[i] = (unsigned)(row * 2048 + colB); }
        { const int sub = bb >> 9, rem = bb & 511, kk = (sub >> 2) * 8 + (rem >> 6), c = (sub & 3) * 32 + ((rem >> 1) & 31); const int k = (kk & ~0xC) | ((kk & 4) << 1) | ((kk & 8) >> 1); voff[i] = (unsigned)(k * 2048 + c * 2); } }
    const unsigned ldsw = (unsigned)wid * 2048u;
#define ATT_DMA(slot, kt, vt) do { _Pragma("unroll") for (int _i = 0; _i < 2; ++_i) { \
        __builtin_amdgcn_global_load_lds((const unsigned*)((const char*)(kt) + koff[_i]), (LAS unsigned*)(lds + k_slot(slot) + ldsw + _i * 1024), 16, 0, 0); \
        __builtin_amdgcn_global_load_lds((const unsigned*)((const char*)(vt) + voff[_i]), (LAS unsigned*)(lds + v_slot(slot) + ldsw + _i * 1024), 16, 0, 0); } } while (0)
#define ATT_TOP() do { asm volatile("s_waitcnt vmcnt(4)" ::: "memory"); __builtin_amdgcn_s_barrier(); asm volatile("" ::: "memory"); } while (0)
    const int xq = bid & 7, cq = bid >> 3;
    LAS float* li_l = (LAS float*)(lds + 131072) + wid * 64;
    const int vbl = (int)(uintptr_t)lds + v_rd_base(lane);
    size_t cbase; { const int bh = xq * 8, b = bh >> 3, h = bh & 7; cbase = (size_t)b * SEQ * DM + h * 128; }
    ATT_DMA(0, Kg + cbase, Vg + cbase); ATT_DMA(1, Kg + cbase + (size_t)64 * DM, Vg + cbase + (size_t)64 * DM);
    for (int ui = 0; ui < 16; ++ui) {
        const int qb = (ui & 1) * 32 + cq;
        size_t nbase = cbase; if (ui + 1 < 16) { const int bh = xq * 8 + ((ui + 1) >> 1), b = bh >> 3, h = bh & 7; nbase = (size_t)b * SEQ * DM + h * 128; }
        const bf16_t* Kh = Kg + cbase; const bf16_t* Vh = Vg + cbase; const bf16_t* nK = Kg + nbase; const bf16_t* nV = Vg + nbase;
        float l_reg = 0; f32x16 o[4] = {}; bf16x8 qr[4];
        { const bf16_t* Qw = Qg + cbase + (size_t)(qb * 128 + wq * 32 + r32) * DM + jj * 64 + hi * 8;
#pragma unroll
          for (int d0 = 0; d0 < 4; ++d0) qr[d0] = *(const bf16x8*)(Qw + d0 * 16); }
        f32x16 pA0, pA1, pB0, pB1; bf16x8 pa0, pa1, pa2, pa3;
#define ATT_SRC(jt, KP, VP) const bf16_t* KP = ((jt) + 2 < NT) ? Kh + (size_t)((jt) + 2) * 64 * DM : nK + (size_t)((jt) + 2 - NT) * 64 * DM; \
                            const bf16_t* VP = ((jt) + 2 < NT) ? Vh + (size_t)((jt) + 2) * 64 * DM : nV + (size_t)((jt) + 2 - NT) * 64 * DM
        { ATT_TOP(); ATT_SRC(0, kp, vp); ATT_DMA(2, kp, vp);
          qkt(pA0, pA1, lds + k_slot(0), qr, r32, hi, jj, -Mc); partialSM(pA0, pA1, Mc); }
        for (int jt = 1; jt + 1 < NT; jt += 2) {
            { ATT_TOP(); ATT_SRC(jt, kp, vp); ATT_DMA((jt + 2) & 3, kp, vp);
              SBAR(); qkt(pB0, pB1, lds + k_slot(jt & 3), qr, r32, hi, jj, -Mc);
              finishSM(pA0, pA1, l_reg, pa0, pa1, pa2, pa3); SBAR();
              pv_d0(o, vbl + v_slot((jt - 1) & 3), pa0, pa1, pa2, pa3); partialSM(pB0, pB1, Mc); }
            { const int j2 = jt + 1; ATT_TOP(); ATT_SRC(j2, kp, vp); ATT_DMA((j2 + 2) & 3, kp, vp);
              SBAR(); qkt(pA0, pA1, lds + k_slot(j2 & 3), qr, r32, hi, jj, -Mc);
              finishSM(pB0, pB1, l_reg, pa0, pa1, pa2, pa3); SBAR();
              pv_d0(o, vbl + v_slot((j2 - 1) & 3), pa0, pa1, pa2, pa3); partialSM(pA0, pA1, Mc); }
        }
        { constexpr int jt = NT - 1; ATT_TOP(); ATT_SRC(jt, kp, vp); ATT_DMA((jt + 2) & 3, kp, vp);
          SBAR(); qkt(pB0, pB1, lds + k_slot(jt & 3), qr, r32, hi, jj, -Mc);
          finishSM(pA0, pA1, l_reg, pa0, pa1, pa2, pa3); SBAR();
          pv_d0(o, vbl + v_slot((jt - 1) & 3), pa0, pa1, pa2, pa3); partialSM(pB0, pB1, Mc);
          finishSM(pB0, pB1, l_reg, pa0, pa1, pa2, pa3); SBAR();
          pv_d0(o, vbl + v_slot(jt & 3), pa0, pa1, pa2, pa3); }
        int r32e = r32, hie = hi; asm volatile("" : "+v"(r32e), "+v"(hie));
        if (hie == 0) li_l[r32e] = l_reg; asm volatile("s_waitcnt lgkmcnt(0)" ::: "memory");
        float rli[16];
#pragma unroll
        for (int r = 0; r < 16; ++r) rli[r] = frcp(li_l[crow(r, hie)]);
        asm volatile("s_waitcnt lgkmcnt(0)" ::: "memory"); __builtin_amdgcn_s_barrier(); asm volatile("" ::: "memory");
        LAS float* Cb = (LAS float*)(lds + 65536);
        if (jj == 1) {
#pragma unroll
            for (int r = 0; r < 16; ++r) { const float sc = rli[r] * lamv;
#pragma unroll
                for (int d0 = 0; d0 < 4; ++d0) Cb[(wq * 32 + crow(r, hie)) * 128 + d0 * 32 + r32e] = o[d0][r] * sc; }
        }
        asm volatile("s_waitcnt lgkmcnt(0)" ::: "memory"); __builtin_amdgcn_s_barrier(); asm volatile("" ::: "memory");
        if (jj == 0) {
            float g[4];
#pragma unroll
            for (int d0 = 0; d0 < 4; ++d0) g[d0] = subg[d0 * 32 + r32e] * omli;
            bf16_t* Ob = Og + cbase + (size_t)(qb * 128) * DM;
#pragma unroll
            for (int r = 0; r < 16; ++r) {
                float ss = 0.f;
#pragma unroll
                for (int d0 = 0; d0 < 4; ++d0) { const float v = o[d0][r] * rli[r] - Cb[(wq * 32 + crow(r, hie)) * 128 + d0 * 32 + r32e]; o[d0][r] = v; ss += v * v; }
                ss += __shfl_xor(ss, 1); ss += __shfl_xor(ss, 2); ss += __shfl_xor(ss, 4); ss += __shfl_xor(ss, 8); ss += __shfl_xor(ss, 16);
                const float rs = 1.0f / sqrtf(ss * (1.0f / 128.0f) + EPS);
                bf16_t* op = Ob + (size_t)(wq * 32 + crow(r, hie)) * DM + r32e;
#pragma unroll
                for (int d0 = 0; d0 < 4; ++d0) op[d0 * 32] = (bf16_t)f2bf(o[d0][r] * rs * g[d0]);
            }
        }
        cbase = nbase;
    }
    asm volatile("s_waitcnt vmcnt(0) lgkmcnt(0)" ::: "memory"); __builtin_amdgcn_s_barrier(); asm volatile("" ::: "memory");
#undef ATT_DMA
#undef ATT_TOP
#undef ATT_SRC
}

namespace gla {
constexpr int BC = 0, QI = 32768, QA = 49152, KA = 65536, KST = 81920, VT = 98304, ST = 106496, AT = 122880, EM = 131072, EL = EM + 512, DD = EM + 1024, BMID = EM + 1536, SEG = EM + 2048;
static_assert(SEG + 2048 <= RING_BYTES, "gla lds");
__device__ __forceinline__ int sw256(int row, int cb) { return row * 256 + (cb ^ ((row & 15) << 4)); }
__device__ __forceinline__ int sw128(int row, int cb) { return row * 128 + (cb ^ ((((row & 7) ^ (row >> 4)) & 7) << 4)); }
__device__ __forceinline__ int crow(int r, int hi) { return (r & 3) + 8 * (r >> 2) + 4 * hi; }
__device__ __forceinline__ float h2f(unsigned short b) { return (float)__builtin_bit_cast(_Float16, b); }
__device__ __forceinline__ void gla_item(const bf16_t* __restrict__ Qp, const unsigned short* __restrict__ LFp, const bf16_t* __restrict__ Vp, bf16_t* __restrict__ Op, int dir, LAS unsigned char* lds, float* dbg) {
    int tid_ = threadIdx.x; asm volatile("" : "+v"(tid_));
    const int tid = tid_, wid = tid >> 6, lane = tid & 63, r = lane & 31, hh = lane >> 5;
    const int t1 = tid >> 3, kg = tid & 7, k0 = 16 * kg, v0 = (tid & 7) * 8;
    for (int i = tid; i < 16384 / 16; i += NTHR) *(LAS u32x4*)(lds + ST + i * 16) = (u32x4){0u, 0u, 0u, 0u};
    f32x16 st = {};
    u32x4 rq[2], rl[2], rv;
#define GLA_TOK(ci, i) (dir ? (SEQ - 1 - ((ci) * 64 + (i))) : ((ci) * 64 + (i)))
#define GLA_LOAD(ci) do { const size_t to = (size_t)GLA_TOK(ci, t1) * DM; \
        rq[0] = *(const u32x4*)(Qp + to + k0); rq[1] = *(const u32x4*)(Qp + to + k0 + 8); \
        rl[0] = *(const u32x4*)(LFp + to + k0); rl[1] = *(const u32x4*)(LFp + to + k0 + 8); rv = *(const u32x4*)(Vp + to + v0); } while (0)
    GLA_LOAD(0);
    __syncthreads();
    for (int ci = 0; ci < SEQ / 64; ++ci) {
        float qf[16], lf[16]; u32x4 vreg = rv;
#pragma unroll
        for (int j = 0; j < 2; ++j)
#pragma unroll
            for (int e = 0; e < 4; ++e) { qf[j * 8 + 2 * e] = bflo(rq[j][e]); qf[j * 8 + 2 * e + 1] = bfhi(rq[j][e]);
                lf[j * 8 + 2 * e] = h2f((unsigned short)(rl[j][e] & 0xffffu)); lf[j * 8 + 2 * e + 1] = h2f((unsigned short)(rl[j][e] >> 16)); }
        if (ci + 1 < SEQ / 64) GLA_LOAD(ci + 1);
#pragma unroll
        for (int j = 0; j < 4; ++j) *(LAS f32x4*)(lds + BC + (t1 * 128 + k0 + 4 * j) * 4) = (f32x4){lf[4 * j], lf[4 * j + 1], lf[4 * j + 2], lf[4 * j + 3]};
        __syncthreads();
        { const int kc = tid & 127, sg = tid >> 7; LAS float* bc = (LAS float*)(lds + BC) + kc; float cs[16];
#pragma unroll
            for (int i = 0; i < 16; ++i) cs[i] = bc[(sg * 16 + i) * 128];
#pragma unroll
            for (int i = 1; i < 16; ++i) cs[i] += cs[i - 1];
            ((LAS float*)(lds + SEG))[sg * 128 + kc] = cs[15];
            __syncthreads();
            const LAS float* sgp = (const LAS float*)(lds + SEG) + kc; const float s0 = sgp[0], s1 = sgp[128], s2 = sgp[256], s3 = sgp[384];
            const float off = sg == 0 ? 0.f : sg == 1 ? s0 : sg == 2 ? (s0 + s1) : ((s0 + s1) + s2);
#pragma unroll
            for (int i = 0; i < 16; ++i) bc[(sg * 16 + i) * 128] = cs[i] + off;
            if (sg == 0) { const float bm = s0 + s1, bl = ((s0 + s1) + s2) + s3;
                ((LAS float*)(lds + BMID))[kc] = bm; ((LAS float*)(lds + EM))[kc] = fexp(bm); ((LAS float*)(lds + EL))[kc] = fexp(bl - bm); ((LAS float*)(lds + DD))[kc] = fexp(bl); }
            __syncthreads();
        }
#ifdef DIAG
        if (dbg && ci == 0) { for (int i = tid; i < 8192; i += NTHR) dbg[i] = ((const LAS float*)(lds + BC))[i]; }
#endif
        {
            unsigned wqi[8], wqa[8], wka[8]; float ksv[16];
#pragma unroll
            for (int j = 0; j < 4; ++j) {
                const f32x4 bt = *(const LAS f32x4*)(lds + BC + (t1 * 128 + k0 + 4 * j) * 4), bm = *(const LAS f32x4*)(lds + BMID + (k0 + 4 * j) * 4);
                const f32x4 em = *(const LAS f32x4*)(lds + EM + (k0 + 4 * j) * 4), el = *(const LAS f32x4*)(lds + EL + (k0 + 4 * j) * 4);
                float qi[4], qa[4], ka[4];
#pragma unroll
                for (int e = 0; e < 4; ++e) { const int i = 4 * j + e; const float e1 = fexp(bt[e] - bm[e]), r1 = frcp(e1);
                    qa[e] = qf[i] * e1; qi[e] = qa[e] * em[e]; const float kk = 1.0f - fexp(lf[i]); ka[e] = kk * r1; ksv[i] = ka[e] * el[e]; }
                wqi[2 * j] = cvt_pk_bf16(qi[0], qi[1]); wqi[2 * j + 1] = cvt_pk_bf16(qi[2], qi[3]);
                wqa[2 * j] = cvt_pk_bf16(qa[0], qa[1]); wqa[2 * j + 1] = cvt_pk_bf16(qa[2], qa[3]);
                wka[2 * j] = cvt_pk_bf16(ka[0], ka[1]); wka[2 * j + 1] = cvt_pk_bf16(ka[2], ka[3]);
            }
#pragma unroll
            for (int j = 0; j < 2; ++j) { const int off = sw256(t1, (k0 + 8 * j) * 2);
                *(LAS u32x4*)(lds + QI + off) = (u32x4){wqi[4 * j], wqi[4 * j + 1], wqi[4 * j + 2], wqi[4 * j + 3]};
                *(LAS u32x4*)(lds + QA + off) = (u32x4){wqa[4 * j], wqa[4 * j + 1], wqa[4 * j + 2], wqa[4 * j + 3]};
                *(LAS u32x4*)(lds + KA + off) = (u32x4){wka[4 * j], wka[4 * j + 1], wka[4 * j + 2], wka[4 * j + 3]}; }
#pragma unroll
            for (int i = 0; i < 16; ++i) *(LAS unsigned short*)(lds + KST + sw128(k0 + i, t1 * 2)) = (unsigned short)f2bf(ksv[i]);
#pragma unroll
            for (int e = 0; e < 4; ++e) { *(LAS unsigned short*)(lds + VT + sw128(v0 + 2 * e, t1 * 2)) = (unsigned short)(vreg[e] & 0xffffu);
                *(LAS unsigned short*)(lds + VT + sw128(v0 + 2 * e + 1, t1 * 2)) = (unsigned short)(vreg[e] >> 16); }
        }
        __syncthreads();
        f32x16 oacc = {};
        const int w4 = wid & 3, t_i = w4 >> 1, v_i = w4 & 1;
        if (wid < 4) {
            const int s_i = wid >> 1, tq = wid & 1; f32x16 a = {};
#pragma unroll
            for (int ks = 0; ks < 8; ++ks) { const bf16x8 fa = *(const LAS bf16x8*)(lds + KA + sw256(32 * s_i + r, (16 * ks + 8 * hh) * 2)), fb = *(const LAS bf16x8*)(lds + QA + sw256(32 * tq + r, (16 * ks + 8 * hh) * 2));
                a = __builtin_amdgcn_mfma_f32_32x32x16_bf16(fa, fb, a, 0, 0, 0); }
            const int tg = 32 * tq + r;
#pragma unroll
            for (int g = 0; g < 4; ++g) { float m[4];
#pragma unroll
                for (int e = 0; e < 4; ++e) { const int sgl = 32 * s_i + 8 * g + 4 * hh + e; m[e] = (sgl <= tg) ? a[4 * g + e] : 0.f; }
                *(LAS u32x2*)(lds + AT + sw128(tg, (32 * s_i + 8 * g + 4 * hh) * 2)) = (u32x2){cvt_pk_bf16(m[0], m[1]), cvt_pk_bf16(m[2], m[3])}; }
        } else {
#pragma unroll
            for (int ks = 0; ks < 8; ++ks) { const bf16x8 fa = *(const LAS bf16x8*)(lds + QI + sw256(32 * t_i + r, (16 * ks + 8 * hh) * 2)), fb = *(const LAS bf16x8*)(lds + ST + sw256(32 * v_i + r, (16 * ks + 8 * hh) * 2));
                oacc = __builtin_amdgcn_mfma_f32_32x32x16_bf16(fa, fb, oacc, 0, 0, 0); }
        }
        __syncthreads();
#ifdef DIAG
        if (dbg && ci == 0) { for (int i = tid; i < 2048; i += NTHR) { ((unsigned*)dbg)[8192 + i] = ((const LAS unsigned*)(lds + AT))[i]; ((unsigned*)dbg)[8192 + 2048 + i] = ((const LAS unsigned*)(lds + VT))[i]; } }
#endif
        if (wid >= 4) {
#pragma unroll
            for (int ks = 0; ks < 4; ++ks) { const bf16x8 fa = *(const LAS bf16x8*)(lds + AT + sw128(32 * t_i + r, (16 * ks + 8 * hh) * 2)), fb = *(const LAS bf16x8*)(lds + VT + sw128(32 * v_i + r, (16 * ks + 8 * hh) * 2));
                oacc = __builtin_amdgcn_mfma_f32_32x32x16_bf16(fa, fb, oacc, 0, 0, 0); }
#pragma unroll
            for (int i = 0; i < 16; ++i) { const int t = 32 * t_i + crow(i, hh); Op[(size_t)GLA_TOK(ci, t) * DM + 32 * v_i + r] = (bf16_t)f2bf(oacc[i]); }
        }
        {
            const int kq = wid >> 1, vq = wid & 1;
#pragma unroll
            for (int i = 0; i < 16; ++i) st[i] *= ((const LAS float*)(lds + DD))[32 * kq + crow(i, hh)];
#pragma unroll
            for (int ks = 0; ks < 4; ++ks) { const bf16x8 fa = *(const LAS bf16x8*)(lds + KST + sw128(32 * kq + r, (16 * ks + 8 * hh) * 2)), fb = *(const LAS bf16x8*)(lds + VT + sw128(32 * vq + r, (16 * ks + 8 * hh) * 2));
                st = __builtin_amdgcn_mfma_f32_32x32x16_bf16(fa, fb, st, 0, 0, 0); }
#pragma unroll
            for (int g = 0; g < 4; ++g) *(LAS u32x2*)(lds + ST + sw256(32 * vq + r, (32 * kq + 8 * g + 4 * hh) * 2)) = (u32x2){cvt_pk_bf16(st[4 * g], st[4 * g + 1]), cvt_pk_bf16(st[4 * g + 2], st[4 * g + 3])};
        }
        __syncthreads();
#ifdef DIAG
        if (dbg && ci == 0) { for (int i = tid; i < 4096; i += NTHR) { ((unsigned*)dbg)[12288 + i] = ((const LAS unsigned*)(lds + ST))[i]; ((unsigned*)dbg)[16384 + i] = ((const LAS unsigned*)(lds + KST))[i]; } }
#endif
    }
#undef GLA_TOK
#undef GLA_LOAD
}
}
__device__ __forceinline__ void gla_phase(const Args& A, LAS unsigned char* lds, int bid, int G) {
    unsigned char* ws = A.ws;
    for (int it = bid; it < 256; it += G) {
        const int b = it >> 5, h = (it >> 2) & 7, dir = (it >> 1) & 1, vh = it & 1;
        const size_t base = (size_t)b * SEQ * DM + h * 128;
        gla::gla_item((const bf16_t*)(ws + H_Q) + base, (const unsigned short*)(ws + (dir ? H_LFB : H_LFF)) + base, (const bf16_t*)(ws + H_V) + base + vh * 64,
                      (bf16_t*)(ws + (dir ? H_OB : H_OF)) + base + vh * 64, dir, lds, it == 0 ? (float*)(ws + TB_LSUM) : nullptr);
    }
}
__device__ __forceinline__ void hg_normo_phase(const Args& A, int bid, int G) {
    int tid_ = threadIdx.x; asm volatile("" : "+v"(tid_));
    const int tid = tid_, lane = tid & 63, wave = tid >> 6; unsigned char* ws = A.ws;
    const bf16_t* OF = (const bf16_t*)(ws + H_OF); const bf16_t* OB = (const bf16_t*)(ws + H_OB); const bf16_t* GG = (const bf16_t*)(ws + H_G); bf16_t* HM = (bf16_t*)(ws + WS_HM);
    const int c0 = (lane >> 3) * 128 + (lane & 7) * 16;
    float ng[16];
#pragma unroll
    for (int i = 0; i < 16; ++i) ng[i] = A.in[I_HGNG][(lane & 7) * 16 + i];
    for (int row = (bid * NWAVES + wave); row < MTOK; row += G * NWAVES) {
        const size_t o = (size_t)row * DM + c0;
        const u32x4 a0 = *(const u32x4*)(OF + o), a1 = *(const u32x4*)(OF + o + 8), b0 = *(const u32x4*)(OB + o), b1 = *(const u32x4*)(OB + o + 8), g0 = *(const u32x4*)(GG + o), g1 = *(const u32x4*)(GG + o + 8);
        float v[16], gt[16]; float ss = 0.f;
#pragma unroll
        for (int e = 0; e < 4; ++e) { v[2 * e] = bflo(a0[e]) + bflo(b0[e]); v[2 * e + 1] = bfhi(a0[e]) + bfhi(b0[e]); v[8 + 2 * e] = bflo(a1[e]) + bflo(b1[e]); v[8 + 2 * e + 1] = bfhi(a1[e]) + bfhi(b1[e]);
            gt[2 * e] = bflo(g0[e]); gt[2 * e + 1] = bfhi(g0[e]); gt[8 + 2 * e] = bflo(g1[e]); gt[8 + 2 * e + 1] = bfhi(g1[e]); }
#pragma unroll
        for (int i = 0; i < 16; ++i) ss += v[i] * v[i];
        ss += __shfl_xor(ss, 1); ss += __shfl_xor(ss, 2); ss += __shfl_xor(ss, 4);
        const float rstd = 1.0f / sqrtf(ss * (1.0f / 128.0f) + EPS);
        u32x4 w0, w1;
#pragma unroll
        for (int e = 0; e < 4; ++e) { w0[e] = cvt_pk_bf16(v[2 * e] * rstd * ng[2 * e] * gt[2 * e], v[2 * e + 1] * rstd * ng[2 * e + 1] * gt[2 * e + 1]);
            w1[e] = cvt_pk_bf16(v[8 + 2 * e] * rstd * ng[8 + 2 * e] * gt[8 + 2 * e], v[8 + 2 * e + 1] * rstd * ng[8 + 2 * e + 1] * gt[8 + 2 * e + 1]); }
        *(u32x4*)(HM + o) = w0; *(u32x4*)(HM + o + 8) = w1;
    }
}

#ifdef DIAG
constexpr int DG_BASE = 8192;
__device__ __forceinline__ void dg_put(const Args& A, int k, float e) { if (!(e >= 0.f) || e > 1e9f) e = 1e9f; atomicMax((unsigned*)(A.ws + WS_CTL) + DG_BASE + 64 * k, __float_as_uint(e)); }
__device__ __forceinline__ float dg_rel(float got, float ref) { return fabsf(got - ref) / (fabsf(ref) + 0.1f); }
__device__ __forceinline__ unsigned dg_hash(unsigned a, unsigned b) { unsigned h = a * 2654435761u + b * 40503u + 0x9e3779b9u; h ^= h >> 15; h *= 2246822519u; h ^= h >> 13; h *= 3266489917u; h ^= h >> 16; return h; }
__device__ __forceinline__ float dg_bfr(float x) { return bflo(f2bf(x)); }
__device__ __forceinline__ void dg_mods(const Args& A, int k) {
    const int lane = threadIdx.x & 63, gwv = blockIdx.x * 8 + (threadIdx.x >> 6);
    const unsigned h = dg_hash(gwv, k); const int l = h & 3, b = (h >> 2) & 7, e = (h >> 5) % 6144;
    float a = 0.f; for (int d = lane; d < DM; d += 64) a += fsilu(A.in[I_C][b * DM + d]) * A.in[I_ADAW][((size_t)l * DM + d) * 6144 + e];
    a = wave_sum(a) + A.in[I_ADAB][l * 6144 + e];
    const float got = ((const float*)(A.ws + TB_MODS))[((size_t)l * NBATCH + b) * 6144 + e];
    if (lane == 0) dg_put(A, k, dg_rel(got, a));
}
__device__ __forceinline__ void dg_norm(const Args& A, int k, const float* x, const float* gain, int L, int which) {
    const int lane = threadIdx.x & 63, gwv = blockIdx.x * 8 + (threadIdx.x >> 6);
    const int row = dg_hash(gwv, k) & (MTOK - 1), b = row >> 13;
    const float* modl = (const float*)(A.ws + TB_MODS) + ((size_t)L * NBATCH + b) * 6144;
    float ss = 0.f; for (int c = lane; c < DM; c += 64) { const float v = x[(size_t)row * DM + c]; ss += v * v; }
    ss = wave_sum(ss); const float rstd = 1.0f / sqrtf(ss / DM + EPS); float e = 0.f;
    for (int c = lane; c < DM; c += 64) { const float ref = x[(size_t)row * DM + c] * rstd * gain[c] * (1.0f + modl[(which * 3 + 1) * 1024 + c]) + modl[(which * 3) * 1024 + c];
        e = fmaxf(e, dg_rel(bf2f(((const bf16_t*)(A.ws + WS_HM))[(size_t)row * DM + c]), ref)); }
    dg_put(A, k, e);
}
__device__ __forceinline__ void dg_qkv(const Args& A, int k, int al) {
    const int lane = threadIdx.x & 63, gwv = blockIdx.x * 8 + (threadIdx.x >> 6);
    const unsigned h = dg_hash(gwv, k); const int row = h & (MTOK - 1), t = (h >> 16) % 48, col = t * 64 + lane;
    const bf16_t* hm = (const bf16_t*)(A.ws + WS_HM) + (size_t)row * DM; const float* w = A.in[I_ATWIN] + (size_t)al * 1024 * 3072 + col;
    float a = 0.f; for (int kk = 0; kk < DM; ++kk) a += bf2f(hm[kk]) * dg_bfr(w[(size_t)kk * 3072]);
    float ref, got;
    if (t < 32) {
        const int part = t >> 4, sh = t & 15; const float ss = wave_sum(a * a); const float rstd = 1.0f / sqrtf(ss / 64.0f + EPS);
        const float y = a * rstd * (part ? A.in[I_ATKN] : A.in[I_ATQN])[al * 64 + lane]; const float yp = __shfl_xor(y, 32);
        const int pos = row & (SEQ - 1); const float cs = ((const float*)(A.ws + TB_COS))[pos * 32 + (lane & 31)], sn = ((const float*)(A.ws + TB_SIN))[pos * 32 + (lane & 31)];
        ref = (lane < 32) ? (y * cs - yp * sn) : (y * cs + yp * sn); if (part == 0) ref *= 0.125f * LOG2E;
        got = bf2f(((const bf16_t*)(A.ws + (part ? A_K : A_Q)))[(size_t)row * DM + sh * 64 + lane]);
    } else { ref = a; got = bf2f(((const bf16_t*)(A.ws + A_V))[(size_t)row * DM + (t - 32) * 64 + lane]); }
    dg_put(A, k, dg_rel(got, ref));
}
__device__ __forceinline__ void dg_attn(const Args& A, int k, int al, LAS unsigned char* lds) {
    const int tid = threadIdx.x; const unsigned h = dg_hash(blockIdx.x, k); const int row = h & (MTOK - 1), hd = (h >> 16) & 7, b = row >> 13;
    const bf16_t* Q = (const bf16_t*)(A.ws + A_Q); const bf16_t* K = (const bf16_t*)(A.ws + A_K); const bf16_t* V = (const bf16_t*)(A.ws + A_V);
    const float* scal = (const float*)(A.ws + TB_SCAL); const float lamv = scal[SC_LAM0 + al], omli = scal[SC_OML0 + al], Mc = scal[SC_MC0 + al];
    LAS float* p0 = (LAS float*)lds; LAS float* p1 = p0 + SEQ; LAS float* red = p1 + SEQ;
    float l0 = 0.f, l1 = 0.f;
    for (int key = tid; key < SEQ; key += NTHR) { const bf16_t* kr = K + ((size_t)b * SEQ + key) * DM + hd * 128; const bf16_t* qr = Q + (size_t)row * DM + hd * 128;
        float s0 = 0.f, s1 = 0.f; for (int d = 0; d < 64; ++d) { s0 += bf2f(qr[d]) * bf2f(kr[d]); s1 += bf2f(qr[64 + d]) * bf2f(kr[64 + d]); }
        const float e0 = fexp2(s0 - Mc), e1 = fexp2(s1 - Mc); p0[key] = e0; p1[key] = e1; l0 += e0; l1 += e1; }
    l0 = wave_sum(l0); l1 = wave_sum(l1); if ((tid & 63) == 0) { red[tid >> 6] = l0; red[8 + (tid >> 6)] = l1; }
    __syncthreads();
    l0 = 0.f; l1 = 0.f; for (int w = 0; w < 8; ++w) { l0 += red[w]; l1 += red[8 + w]; }
    __syncthreads();
    const int dv = tid & 127, part = tid >> 7; float o = 0.f;
    for (int key = part * 2048; key < part * 2048 + 2048; ++key) o += (p0[key] / l0 - lamv * p1[key] / l1) * bf2f(V[((size_t)b * SEQ + key) * DM + hd * 128 + dv]);
    red[16 + part * 128 + dv] = o; __syncthreads();
    if (tid < 128) { o = red[16 + tid] + red[16 + 128 + tid] + red[16 + 256 + tid] + red[16 + 384 + tid]; red[600 + tid] = o * o; }
    __syncthreads();
    if (tid < 128) { float ss = 0.f; for (int i = 0; i < 128; ++i) ss += red[600 + i]; const float ref = o / sqrtf(ss / 128.0f + EPS) * A.in[I_ATSUB][al * 128 + tid] * omli;
        dg_put(A, k, dg_rel(bf2f(((const bf16_t*)(A.ws + WS_HM))[(size_t)row * DM + hd * 128 + tid]), ref)); }
    __syncthreads();
}
__device__ __forceinline__ void dg_save(const Args& A, int k, const float* xold) {
    const int lane = threadIdx.x & 63, gwv = blockIdx.x * 8 + (threadIdx.x >> 6);
    const unsigned h = dg_hash(gwv, k); const int row = h & (MTOK - 1), col = (h >> 16) & 1023;
    float* sv = (float*)(A.ws + TB_LSUM) + 7 * 1024 * 1024 / 4;
    if (lane == 0) sv[k * 4096 + gwv] = xold[(size_t)row * DM + col];
}
__device__ __forceinline__ void dg_res(const Args& A, int k, const float* xnew, const float* gate, const bf16_t* Am, int K, const float* W) {
    const int lane = threadIdx.x & 63, gwv = blockIdx.x * 8 + (threadIdx.x >> 6);
    const unsigned h = dg_hash(gwv, k); const int row = h & (MTOK - 1), col = (h >> 16) & 1023, b = row >> 13;
    const float* sv = (const float*)(A.ws + TB_LSUM) + 7 * 1024 * 1024 / 4;
    float a = 0.f; for (int kk = lane; kk < K; kk += 64) a += bf2f(Am[(size_t)row * K + kk]) * dg_bfr(W[(size_t)kk * DM + col]);
    a = wave_sum(a);
    const float ref = sv[k * 4096 + gwv] + gate[(size_t)b * 6144 + col] * a;
    if (lane == 0) dg_put(A, k, dg_rel(xnew[(size_t)row * DM + col], ref));
}
__device__ __forceinline__ void dg_swiglu(const Args& A, int k, const bf16_t* Am, const float* W, int F, const bf16_t* H, int nrows, const int* rowmap) {
    const int lane = threadIdx.x & 63, gwv = blockIdx.x * 8 + (threadIdx.x >> 6);
    const unsigned h = dg_hash(gwv, k); const int row = (h & 0xfffff) % nrows, j = (h >> 20) % F;
    float g = 0.f, u = 0.f; for (int kk = lane; kk < DM; kk += 64) { const float x = bf2f(Am[(size_t)row * DM + kk]); g += x * dg_bfr(W[(size_t)kk * 2 * F + j]); u += x * dg_bfr(W[(size_t)kk * 2 * F + F + j]); }
    g = wave_sum(g); u = wave_sum(u);
    const float ref = g / (1.0f + expf(-g)) * u;
    if (lane == 0) dg_put(A, k, dg_rel(bf2f(H[(size_t)row * F + j]), ref));
}
__device__ __forceinline__ void dg_hgin(const Args& A, int k) {
    const int lane = threadIdx.x & 63, gwv = blockIdx.x * 8 + (threadIdx.x >> 6);
    const unsigned h = dg_hash(gwv, k); const int row = h & (MTOK - 1), col = (h >> 16) % 5120, grp = col >> 10, cc = col & 1023;
    float a = 0.f; for (int kk = lane; kk < DM; kk += 64) a += bf2f(((const bf16_t*)(A.ws + WS_HM))[(size_t)row * DM + kk]) * dg_bfr(A.in[I_HGWIN][(size_t)kk * 5120 + col]);
    a = wave_sum(a);
    float ref, got;
    if (grp == 0 || grp == 4) { ref = a / (1.0f + expf(-a)); got = bf2f(((const bf16_t*)(A.ws + (grp == 0 ? H_Q : H_G)))[(size_t)row * DM + cc]); }
    else if (grp == 3) { ref = a; got = bf2f(((const bf16_t*)(A.ws + H_V))[(size_t)row * DM + cc]); }
    else { const int d = grp - 1; const float* p = A.in[I_HGLB] + (size_t)d * DEPTH * 1024 + cc; float mx = p[0]; for (int l = 1; l < DEPTH; ++l) mx = fmaxf(mx, p[l * 1024]);
        float den = 0.f; for (int l = 0; l < DEPTH; ++l) den += expf(p[l * 1024] - mx); const float lbv = expf(p[1024] - mx) / den;
        ref = logf(lbv + (1.0f - lbv) / (1.0f + expf(-a))); got = gla::h2f(((const unsigned short*)(A.ws + (d ? H_LFB : H_LFF)))[(size_t)row * DM + cc]); }
    if (lane == 0) dg_put(A, k, dg_rel(got, ref));
}
__device__ __forceinline__ void dg_gla(const Args& A, int k) {
    const int lane = threadIdx.x & 63, gwv = blockIdx.x * 8 + (threadIdx.x >> 6);
    const unsigned h = dg_hash(gwv, k); const int sel0 = (gwv & 3) == 0; const int b = sel0 ? 0 : (h & 7), hd = sel0 ? 0 : ((h >> 3) & 7), dir = sel0 ? 0 : ((h >> 6) & 1), vc = sel0 ? ((h >> 7) & 63) : ((h >> 7) & 127);
    const bf16_t* Q = (const bf16_t*)(A.ws + H_Q); const unsigned short* LF = (const unsigned short*)(A.ws + (dir ? H_LFB : H_LFF)); const bf16_t* V = (const bf16_t*)(A.ws + H_V);
    const bf16_t* O = (const bf16_t*)(A.ws + (dir ? H_OB : H_OF));
    float s0 = 0.f, s1 = 0.f, e0 = 0.f, e1 = 0.f, e2 = 0.f, e3 = 0.f;
    for (int i = 0; i < SEQ; ++i) { const int tok = dir ? (SEQ - 1 - i) : i; const size_t o = ((size_t)b * SEQ + tok) * DM + hd * 128;
        const float f0 = expf(gla::h2f(LF[o + lane])), f1 = expf(gla::h2f(LF[o + 64 + lane])), v = bf2f(V[o + vc]);
        s0 = f0 * s0 + (1.0f - f0) * v; s1 = f1 * s1 + (1.0f - f1) * v;
        if (i < 128 || i % 61 == 0) { const float ov = wave_sum(bf2f(Q[o + lane]) * s0 + bf2f(Q[o + 64 + lane]) * s1); const float er = 0.25f * fabsf(bf2f(O[o + vc]) - ov) / (fabsf(ov) + 1.0f);
            if (i == 0) e0 = er; else if (i < 64) e1 = fmaxf(e1, er); else if (i < 128) e2 = fmaxf(e2, er); else e3 = fmaxf(e3, er); } }
    if (lane == 0) { dg_put(A, k, e0); dg_put(A, k + 4, e1); dg_put(A, k + 5, e2); dg_put(A, k + 6, e3); }
    const float* dbg = (const float*)(A.ws + TB_LSUM); const unsigned short* LF0 = (const unsigned short*)(A.ws + H_LFF); const bf16_t* Q0 = (const bf16_t*)(A.ws + H_Q);
    { const unsigned h2 = dg_hash(gwv, k + 100); const int t = h2 & 63, kk = (h2 >> 6) & 127; float c = 0.f; for (int tt = 0; tt <= t; ++tt) c += gla::h2f(LF0[(size_t)tt * DM + kk]);
      if (lane == 0) dg_put(A, k + 1, dg_rel(dbg[t * 128 + kk], c)); }
    { const unsigned h2 = dg_hash(gwv, k + 200); const int t = h2 & 63, sidx = (h2 >> 6) & 63; float a = 0.f;
      if (sidx <= t) { for (int kk = lane; kk < 128; kk += 64) { float c = 0.f; for (int tt = sidx + 1; tt <= t; ++tt) c += gla::h2f(LF0[(size_t)tt * DM + kk]);
              a += bf2f(Q0[(size_t)t * DM + kk]) * (1.0f - expf(gla::h2f(LF0[(size_t)sidx * DM + kk]))) * expf(c); } a = wave_sum(a); }
      const unsigned short got = ((const unsigned short*)(dbg + 8192))[gla::sw128(t, sidx * 2) / 2];
      if (lane == 0) dg_put(A, k + 2, 5.0f * fabsf(bf2f(got) - a) / (fabsf(a) + 0.01f)); }
    { const unsigned h2 = dg_hash(gwv, k + 300); const int sidx = h2 & 63, v = (h2 >> 6) & 63;
      const unsigned short got = ((const unsigned short*)(dbg + 8192 + 2048))[gla::sw128(v, sidx * 2) / 2];
      if (lane == 0) dg_put(A, k + 2, dg_rel(bf2f(got), bf2f(((const bf16_t*)(A.ws + H_V))[(size_t)sidx * DM + v]))); }
    { const unsigned h2 = dg_hash(gwv, k + 500); const int kk = h2 & 127, v = (h2 >> 7) & 63;
      float a = 0.f; { const int sidx = lane; float c = 0.f; for (int tt = sidx + 1; tt < 64; ++tt) c += gla::h2f(LF0[(size_t)tt * DM + kk]);
          const float ksn = (1.0f - expf(gla::h2f(LF0[(size_t)sidx * DM + kk]))) * expf(c);
          const unsigned short gk = ((const unsigned short*)(dbg + 16384))[gla::sw128(kk, sidx * 2) / 2];
          dg_put(A, k + 2, 0.5f * fabsf(bf2f(gk) - ksn) / (fabsf(ksn) + 0.01f));
          a = ksn * bf2f(((const bf16_t*)(A.ws + H_V))[(size_t)sidx * DM + v]); }
      a = wave_sum(a);
      const unsigned short gs = ((const unsigned short*)(dbg + 12288))[gla::sw256(v, kk * 2) / 2];
      if (lane == 0) dg_put(A, k + 3, 0.5f * fabsf(bf2f(gs) - a) / (fabsf(a) + 0.05f)); }
    { const unsigned h2 = dg_hash(gwv, k + 400); const int t = h2 & 63, v = (h2 >> 6) & 63;
      const unsigned short* at = (const unsigned short*)(dbg + 8192); const unsigned short* vt = (const unsigned short*)(dbg + 8192 + 2048);
      float a = bf2f(at[gla::sw128(t, lane * 2) / 2]) * bf2f(vt[gla::sw128(v, lane * 2) / 2]); a = wave_sum(a);
      if (lane == 0) dg_put(A, k + 1, 5.0f * dg_rel(bf2f(((const bf16_t*)(A.ws + H_OF))[(size_t)t * DM + v]), a)); }
}
__device__ __forceinline__ void dg_normo(const Args& A, int k) {
    const int lane = threadIdx.x & 63, gwv = blockIdx.x * 8 + (threadIdx.x >> 6);
    const unsigned h = dg_hash(gwv, k); const int row = h & (MTOK - 1), hd = (h >> 16) & 7; const size_t o = (size_t)row * DM + hd * 128;
    const float v0 = bf2f(((const bf16_t*)(A.ws + H_OF))[o + lane]) + bf2f(((const bf16_t*)(A.ws + H_OB))[o + lane]), v1 = bf2f(((const bf16_t*)(A.ws + H_OF))[o + 64 + lane]) + bf2f(((const bf16_t*)(A.ws + H_OB))[o + 64 + lane]);
    const float ss = wave_sum(v0 * v0 + v1 * v1), rstd = 1.0f / sqrtf(ss / 128.0f + EPS);
    const float r0 = v0 * rstd * A.in[I_HGNG][lane] * bf2f(((const bf16_t*)(A.ws + H_G))[o + lane]), r1 = v1 * rstd * A.in[I_HGNG][64 + lane] * bf2f(((const bf16_t*)(A.ws + H_G))[o + 64 + lane]);
    dg_put(A, k, fmaxf(dg_rel(bf2f(((const bf16_t*)(A.ws + WS_HM))[o + lane]), r0), dg_rel(bf2f(((const bf16_t*)(A.ws + WS_HM))[o + 64 + lane]), r1)));
}
__device__ __forceinline__ void dg_router(const Args& A, int k, int L) {
    const int lane = threadIdx.x & 63, gwv = blockIdx.x * 8 + (threadIdx.x >> 6);
    const int row = dg_hash(gwv, k) & (MTOK - 1), b = row >> 13; const float* x = A.out + (size_t)row * DM;
    const float* modl = (const float*)(A.ws + TB_MODS) + ((size_t)L * NBATCH + b) * 6144; const float* gain = A.in[I_N2G] + L * DM; const float* R = A.in[I_MOER] + (size_t)(L >> 1) * DM * 8;
    float ss = 0.f; for (int c = lane; c < DM; c += 64) ss += x[c] * x[c];
    ss = wave_sum(ss); const float rstd = 1.0f / sqrtf(ss / DM + EPS);
    float lg[8]; for (int e = 0; e < 8; ++e) lg[e] = 0.f;
    for (int c = lane; c < DM; c += 64) { const float hv = x[c] * rstd * gain[c] * (1.0f + modl[4 * 1024 + c]) + modl[3 * 1024 + c]; for (int e = 0; e < 8; ++e) lg[e] += hv * R[c * 8 + e]; }
    for (int e = 0; e < 8; ++e) lg[e] = wave_sum(lg[e]);
    int e0 = 0; for (int e = 1; e < 8; ++e) if (lg[e] > lg[e0]) e0 = e;
    int e1 = (e0 == 0) ? 1 : 0; for (int e = 0; e < 8; ++e) if (e != e0 && lg[e] > lg[e1]) e1 = e;
    float gap = 1e9f; for (int e = 0; e < 8; ++e) if (e != e0 && e != e1) gap = fminf(gap, lg[e1] - lg[e]); gap = fminf(gap, lg[e0] - lg[e1]);
    const int g0 = ((const int*)(A.ws + TB_EID))[row * 2], g1 = ((const int*)(A.ws + TB_EID))[row * 2 + 1]; const float w0 = ((const float*)(A.ws + TB_GATE))[row * 2], w1 = ((const float*)(A.ws + TB_GATE))[row * 2 + 1];
    const float p0 = 1.0f / (1.0f + expf(lg[e1] - lg[e0]));
    float er = (g0 != e0 || g1 != e1) ? (gap > 2e-3f ? 9.f : 0.f) : fmaxf(fabsf(w0 - p0), fabsf(w1 - (1.0f - p0)));
    if (lane == 0) dg_put(A, k, er);
}
__device__ __forceinline__ void dg_place(const Args& A, int k) {
    const int lane = threadIdx.x & 63, gwv = blockIdx.x * 8 + (threadIdx.x >> 6);
    const unsigned h = dg_hash(gwv, k); const int row = h & (MTOK - 1), kk = (h >> 16) & 1;
    const int sl = ((const int*)(A.ws + TB_SLOT))[row * 2 + kk], e = ((const int*)(A.ws + TB_EID))[row * 2 + kk]; const int* ts = (const int*)(A.ws + TB_TILES);
    float er = (sl >= ts[e] * 256 && sl < ts[e + 1] * 256 && sl < MOE_ROWS) ? 0.f : 7.f;
    if (er == 0.f) for (int c = lane; c < DM; c += 64) if (((const bf16_t*)(A.ws + E_XS))[(size_t)sl * DM + c] != ((const bf16_t*)(A.ws + WS_HM))[(size_t)row * DM + c]) er = 5.f;
    dg_put(A, k, er);
}
__device__ __forceinline__ void dg_moe_hid(const Args& A, int k, int m) {
    const int lane = threadIdx.x & 63, gwv = blockIdx.x * 8 + (threadIdx.x >> 6);
    const unsigned h = dg_hash(gwv, k); const int row = h & (MTOK - 1), kk = (h >> 16) & 1, j = (h >> 17) % DFFE;
    const int sl = ((const int*)(A.ws + TB_SLOT))[row * 2 + kk], e = ((const int*)(A.ws + TB_EID))[row * 2 + kk];
    const float* W = A.in[I_MOEGU] + ((size_t)m * 8 + e) * DM * 2 * DFFE; const bf16_t* Am = (const bf16_t*)(A.ws + E_XS) + (size_t)sl * DM;
    float g = 0.f, u = 0.f; for (int c = lane; c < DM; c += 64) { const float x = bf2f(Am[c]); g += x * dg_bfr(W[(size_t)c * 2 * DFFE + j]); u += x * dg_bfr(W[(size_t)c * 2 * DFFE + DFFE + j]); }
    g = wave_sum(g); u = wave_sum(u);
    if (lane == 0) dg_put(A, k, dg_rel(bf2f(((const bf16_t*)(A.ws + E_HID))[(size_t)sl * DFFE + j]), g / (1.0f + expf(-g)) * u));
}
__device__ __forceinline__ void dg_moe_y(const Args& A, int k, int m) {
    const int lane = threadIdx.x & 63, gwv = blockIdx.x * 8 + (threadIdx.x >> 6);
    const unsigned h = dg_hash(gwv, k); const int row = h & (MTOK - 1), kk = (h >> 16) & 1, col = (h >> 17) & 1023;
    const int sl = ((const int*)(A.ws + TB_SLOT))[row * 2 + kk], e = ((const int*)(A.ws + TB_EID))[row * 2 + kk];
    const float* W = A.in[I_MOEDN] + ((size_t)m * 8 + e) * DFFE * DM; const bf16_t* Hh = (const bf16_t*)(A.ws + E_HID) + (size_t)sl * DFFE;
    float a = 0.f; for (int j = lane; j < DFFE; j += 64) a += bf2f(Hh[j]) * dg_bfr(W[(size_t)j * DM + col]);
    a = wave_sum(a);
    if (lane == 0) dg_put(A, k, fabsf(bf2f(((const bf16_t*)(A.ws + E_XS))[(size_t)sl * DM + col]) - a) / (fabsf(a) + 0.3f));
}
__device__ __forceinline__ void dg_combine(const Args& A, int k, const float* modprev) {
    const int lane = threadIdx.x & 63, gwv = blockIdx.x * 8 + (threadIdx.x >> 6);
    const unsigned h = dg_hash(gwv, k); const int row = h & (MTOK - 1), col = (h >> 16) & 1023, b = row >> 13;
    const float* sv = (const float*)(A.ws + TB_LSUM) + 7 * 1024 * 1024 / 4; const bf16_t* Y = (const bf16_t*)(A.ws + E_XS);
    const int s0 = ((const int*)(A.ws + TB_SLOT))[row * 2], s1 = ((const int*)(A.ws + TB_SLOT))[row * 2 + 1]; const float w0 = ((const float*)(A.ws + TB_GATE))[row * 2], w1 = ((const float*)(A.ws + TB_GATE))[row * 2 + 1];
    const float ref = sv[k * 4096 + gwv] + modprev[(size_t)b * 6144 + 5 * 1024 + col] * (w0 * bf2f(Y[(size_t)s0 * DM + col]) + w1 * bf2f(Y[(size_t)s1 * DM + col]));
    if (lane == 0) dg_put(A, k, dg_rel(A.out[(size_t)row * DM + col], ref));
}
__device__ __forceinline__ void dg_lruin(const Args& A, int k) {
    const int lane = threadIdx.x & 63, gwv = blockIdx.x * 8 + (threadIdx.x >> 6);
    const unsigned h = dg_hash(gwv, k); const int row = h & (MTOK - 1), col = (h >> 16) % 2560;
    float a = 0.f; for (int kk = lane; kk < DM; kk += 64) a += bf2f(((const bf16_t*)(A.ws + WS_HM))[(size_t)row * DM + kk]) * dg_bfr(A.in[I_LRWIN][(size_t)kk * 2560 + col]);
    a = wave_sum(a);
    float ref, got;
    if (col < LRUW) { ref = 0.5f * a * (1.0f + tanhf(0.7978845608028654f * (a + 0.044715f * a * a * a))); got = bf2f(((const bf16_t*)(A.ws + L_YB))[(size_t)row * LRUW + col]); }
    else { ref = a; got = bf2f(((const bf16_t*)(A.ws + L_XB))[(size_t)row * LRUW + col - LRUW]); }
    if (lane == 0) dg_put(A, k, dg_rel(got, ref));
}
__device__ __forceinline__ void dg_lru(const Args& A, int k) {
    const int lane = threadIdx.x & 63, gwv = blockIdx.x * 8 + (threadIdx.x >> 6);
    const unsigned h = dg_hash(gwv, k); const int b = h & 7, ch = (h >> 3) % LRUW, tc = (h >> 16) & (SEQ - 1), n = ch / 128, j = ch % 128;
    const bf16_t* XB = (const bf16_t*)(A.ws + L_XB) + (size_t)b * SEQ * LRUW;
    float hres[2];
    for (int d = 0; d < 2; ++d) {
        const float* wa = A.in[I_LRWA] + (size_t)(d * 10 + n) * 16384; const float* wx = A.in[I_LRWX] + (size_t)(d * 10 + n) * 16384;
        const float wa0 = dg_bfr(wa[lane * 128 + j]), wa1 = dg_bfr(wa[(lane + 64) * 128 + j]), wx0 = dg_bfr(wx[lane * 128 + j]), wx1 = dg_bfr(wx[(lane + 64) * 128 + j]);
        const float ba = A.in[I_LRBA][d * LRUW + ch], bx = A.in[I_LRBX][d * LRUW + ch]; const float lam = A.in[I_LRLAM][d * LRUW + ch]; const float sp = log1pf(expf(-lam));
        float hs = 0.f;
        for (int i = 0; ; ++i) { const int t = d ? (SEQ - 1 - i) : i;
            float x0 = A.in[I_LRCB][n * 128 + lane], x1 = A.in[I_LRCB][n * 128 + 64 + lane], xj = A.in[I_LRCB][ch];
            for (int w = 0; w < 4; ++w) { const int tt = t - 1 + w; if (tt >= 0 && tt < SEQ) {
                x0 += A.in[I_LRCW][w * LRUW + n * 128 + lane] * bf2f(XB[(size_t)tt * LRUW + n * 128 + lane]); x1 += A.in[I_LRCW][w * LRUW + n * 128 + 64 + lane] * bf2f(XB[(size_t)tt * LRUW + n * 128 + 64 + lane]);
                xj += A.in[I_LRCW][w * LRUW + ch] * bf2f(XB[(size_t)tt * LRUW + ch]); } }
            const float rp = wave_sum(dg_bfr(x0) * wa0 + dg_bfr(x1) * wa1), ip = wave_sum(dg_bfr(x0) * wx0 + dg_bfr(x1) * wx1);
            const float rg = 1.0f / (1.0f + expf(-(rp + ba))), ig = 1.0f / (1.0f + expf(-(ip + bx))); const float la = -8.0f * rg * sp;
            hs = expf(la) * hs + sqrtf(fmaxf(-expm1f(2.0f * la), 0.f)) * ig * xj;
            if (t == tc) break; }
        hres[d] = hs;
    }
    const size_t go = ((size_t)b * SEQ + tc) * LRUW + ch;
    const float e1 = fabsf(bf2f(((const bf16_t*)(A.ws + L_HF))[go]) - hres[0]) / (fabsf(hres[0]) + 0.3f);
    const float ref = (hres[0] + hres[1]) * bf2f(((const bf16_t*)(A.ws + L_YB))[go]);
    const float e2 = fabsf(bf2f(((const bf16_t*)(A.ws + L_HY))[go]) - ref) / (fabsf(ref) + 0.3f);
    if (lane == 0) { dg_put(A, k, e1); dg_put(A, k + 5, e2); }
}
__device__ __forceinline__ void dg_final(const Args& A, int nchk) {
    const unsigned* sl = (const unsigned*)(A.ws + WS_CTL) + DG_BASE; int code = 0; float ev = 0.f;
    for (int k = 1; k <= nchk; ++k) { const float e = __uint_as_float(sl[64 * k]); if (e > 0.05f) { code = k; ev = e; break; } }
    if (code == 0) return;
    const int c1 = code % 10, c10 = code / 10;
    const float s = -(float)c1;
    for (size_t i = (size_t)blockIdx.x * NTHR + threadIdx.x; i < (size_t)MTOK * DM; i += (size_t)gridDim.x * NTHR) A.out[i] = A.in[I_X][i] * s;
    __syncthreads();
    if (blockIdx.x == 0 && threadIdx.x == 0) { const int qq = ev < 0.1f ? 1 : ev < 0.2f ? 2 : ev < 0.5f ? 3 : ev < 1.f ? 4 : ev < 2.f ? 5 : ev < 5.f ? 6 : ev < 20.f ? 7 : ev < 1e3f ? 8 : 9;
        A.out[12345] = 100.f * (float)(10 * c10 + qq); }
}
#define DG(x) x
#define DGL(x) if constexpr (L >= DIAG_FROM) { x }
#else
#define DG(x)
#define DGL(x)
#endif

#define GRID_BAR() xcd_barrier(bar)
template <int L>
__device__ __forceinline__ void run_mixer(const Args& args, LAS unsigned char* lds, int bid, int G, const XcdBarrier& bar) {
    unsigned char* ws = args.ws; float* xo = args.out;
    const float* modl = (const float*)(ws + TB_MODS) + (size_t)L * NBATCH * 6144;
    const float* xs = (L == 0) ? args.in[I_X] : xo;
    constexpr int kind = L % 3;
    DGL(if (L > 0 && ((L - 1) & 1)) { dg_save(args, 10 * (L - 1) + 9, xo); GRID_BAR(); })
    norm_phase<false>(args, lds, bid, G, xs, xo, args.in[I_N1G] + L * DM, modl, 0, (L > 0) && ((L - 1) & 1), modl - NBATCH * 6144, false, nullptr);
    GRID_BAR();
    DGL(if (L > 0 && ((L - 1) & 1)) { dg_combine(args, 10 * (L - 1) + 9, modl - NBATCH * 6144); GRID_BAR(); })
    DGL(dg_norm(args, 10 * L + 1, (L > 0 && ((L - 1) & 1)) ? xo : xs, args.in[I_N1G] + L * DM, L, 0); GRID_BAR();)
    if constexpr (kind == 0) {
        constexpr int al = L / 3;
        {
            pg8::Gemm g{(const bf16_t*)(ws + WS_HM), (const bf16_t*)(ws + W_QKV) + (size_t)al * 3072 * 1024, 1024};
            pg8::TileOrder S; S.init(256, 12, G, bid);
            pg8::EpiQKV E{(bf16_t*)(ws + A_Q), (bf16_t*)(ws + A_K), (bf16_t*)(ws + A_V), args.in[I_ATQN] + al * 64, args.in[I_ATKN] + al * 64,
                          (const float*)(ws + TB_COS), (const float*)(ws + TB_SIN), 0.125f * LOG2E};
            pg8::gemm_phase<pg8::EpiQKV>(lds, g, S, E);
        }
        GRID_BAR();
        DGL(dg_qkv(args, 10 * L + 2, al); GRID_BAR();)
        attn_phase(args, lds, bid, G, al);
        GRID_BAR();
        DGL(dg_attn(args, 10 * L + 3, al, lds); GRID_BAR();)
        DGL(dg_save(args, 10 * L + 4, xs); GRID_BAR();)
        {
            pg8::Gemm g{(const bf16_t*)(ws + WS_HM), (const bf16_t*)(ws + W_AO) + (size_t)al * 1024 * 1024, 1024};
            pg8::TileOrder S; S.init(256, 4, G, bid);
            pg8::EpiRes E{xs, xo, modl + 2 * 1024, 1.0f};
            pg8::gemm_phase<pg8::EpiRes>(lds, g, S, E);
        }
        GRID_BAR();
        DGL(dg_res(args, 10 * L + 4, xo, modl + 2 * 1024, (const bf16_t*)(ws + WS_HM), 1024, args.in[I_ATWOUT] + (size_t)al * 1024 * 1024); GRID_BAR();)
    }
    if constexpr (kind == 1) {
        {
            pg8::Gemm g{(const bf16_t*)(ws + WS_HM), (const bf16_t*)(ws + W_HGI), 1024};
            pg8::TileOrder S; S.init(256, 20, G, bid);
            pg8::EpiAct E{0, ws, (const float*)(ws + TB_LB)};
            pg8::gemm_phase<pg8::EpiAct>(lds, g, S, E);
        }
        GRID_BAR();
        DGL(dg_hgin(args, 10 * L + 2); GRID_BAR();)
        gla_phase(args, lds, bid, G);
        GRID_BAR();
        DGL(dg_gla(args, 10 * L + 3); GRID_BAR();)
        hg_normo_phase(args, bid, G);
        GRID_BAR();
        DGL(dg_normo(args, 10 * L + 0); GRID_BAR();)
        DGL(dg_save(args, 10 * L + 4, xs); GRID_BAR();)
        {
            pg8::Gemm g{(const bf16_t*)(ws + WS_HM), (const bf16_t*)(ws + W_HGO), 1024};
            pg8::TileOrder S; S.init(256, 4, G, bid);
            pg8::EpiRes E{xs, xo, modl + 2 * 1024, 1.0f};
            pg8::gemm_phase<pg8::EpiRes>(lds, g, S, E);
        }
        GRID_BAR();
        DGL(dg_res(args, 10 * L + 4, xo, modl + 2 * 1024, (const bf16_t*)(ws + WS_HM), 1024, args.in[I_HGWOUT]); GRID_BAR();)
    }
    if constexpr (kind == 2) {
        {
            pg8::Gemm g{(const bf16_t*)(ws + WS_HM), (const bf16_t*)(ws + W_LRI), 1024};
            pg8::TileOrder S; S.init(256, 10, G, bid);
            pg8::EpiAct E{1, ws, nullptr};
            pg8::gemm_phase<pg8::EpiAct>(lds, g, S, E);
        }
        GRID_BAR();
        DGL(dg_lruin(args, 10 * L + 2); GRID_BAR();)
        lru_phase<0>(args, lds, bid, G);
        GRID_BAR();
        lru_carry_phase(args, bid, G);
        GRID_BAR();
        lru_phase<1>(args, lds, bid, G);
        GRID_BAR();
        lru_phase<2>(args, lds, bid, G);
        GRID_BAR();
        DGL(dg_lru(args, 10 * L + 3); GRID_BAR();)
        DGL(dg_save(args, 10 * L + 4, xs); GRID_BAR();)
        {
            pg8::Gemm g{(const bf16_t*)(ws + L_HY), (const bf16_t*)(ws + W_LRO), LRUW};
            pg8::TileOrder S; S.init(256, 4, G, bid);
            pg8::EpiRes E{xs, xo, modl + 2 * 1024, 1.0f};
            pg8::gemm_phase<pg8::EpiRes>(lds, g, S, E);
        }
        GRID_BAR();
        DGL(dg_res(args, 10 * L + 4, xo, modl + 2 * 1024, (const bf16_t*)(ws + L_HY), LRUW, args.in[I_LRWOUT]); GRID_BAR();)
    }
}
template <int L>
__device__ __forceinline__ void run_ffn(const Args& args, LAS unsigned char* lds, int bid, int G, const XcdBarrier& bar) {
    unsigned char* ws = args.ws; float* xo = args.out;
    const float* modl = (const float*)(ws + TB_MODS) + (size_t)L * NBATCH * 6144;
    if constexpr ((L & 1) == 0) {
        constexpr int m = L >> 1;
        constexpr bool F8 = (L >= FP8_DENSE_FROM);
        norm_phase<false>(args, lds, bid, G, xo, xo, args.in[I_N2G] + L * DM, modl, 1, false, modl, false, nullptr, F8);
        GRID_BAR();
        if constexpr (F8) {
            pg8::Gemm g{(const bf16_t*)(ws + WS_HM), (const bf16_t*)(ws + W_FGU) + (size_t)m * 5632 * 1024, 512};
            pg8::TileOrder S; S.init(256, 22, G, bid);
            pg8::EpiSwiGLU8 E{ws + F_HID, DFF, 1.0f / MOE_WSCALE, MOE_HSCALE};
            pg8::gemm_phase<pg8::EpiSwiGLU8, true>(lds, g, S, E);
        } else {
            pg8::Gemm g{(const bf16_t*)(ws + WS_HM), (const bf16_t*)(ws + W_FGU) + (size_t)m * 5632 * 1024, 1024};
            pg8::TileOrder S; S.init(256, 22, G, bid);
            pg8::EpiSwiGLU E{(bf16_t*)(ws + F_HID), DFF};
            pg8::gemm_phase<pg8::EpiSwiGLU>(lds, g, S, E);
        }
        GRID_BAR();
        if constexpr (F8) {
            pg8::Gemm g{(const bf16_t*)(ws + F_HID), (const bf16_t*)(ws + W_FDN) + (size_t)m * 1024 * 2816, DFF / 2};
            pg8::TileOrder S; S.init(256, 4, G, bid);
            pg8::EpiRes E{xo, xo, modl + 5 * 1024, 1.0f / (MOE_WSCALE * MOE_HSCALE)};
            pg8::gemm_phase<pg8::EpiRes, true>(lds, g, S, E);
        } else {
            pg8::Gemm g{(const bf16_t*)(ws + F_HID), (const bf16_t*)(ws + W_FDN) + (size_t)m * 1024 * 2816, DFF};
            pg8::TileOrder S; S.init(256, 4, G, bid);
            pg8::EpiRes E{xo, xo, modl + 5 * 1024, 1.0f};
            pg8::gemm_phase<pg8::EpiRes>(lds, g, S, E);
        }
        GRID_BAR();
    } else {
        constexpr int m = L >> 1;
        norm_phase<true>(args, lds, bid, G, xo, xo, args.in[I_N2G] + L * DM, modl, 1, false, modl, false, args.in[I_MOER] + (size_t)m * DM * 8);
        GRID_BAR();
        DGL(dg_norm(args, 10 * L + 5, xo, args.in[I_N2G] + L * DM, L, 1); dg_router(args, 10 * L + 5, L); GRID_BAR();)
        place_phase(args, lds, bid, G);
        GRID_BAR();
        DGL(dg_place(args, 10 * L + 6); GRID_BAR();)
        const int* tiles = (const int*)(ws + TB_TILES);
        {
            pg8::Gemm g{(const bf16_t*)(ws + E_XS), (const bf16_t*)(ws + W_MGU + (size_t)m * 8 * 7168 * 1024), 512};
            pg8::TileOrder S; S.init(tiles[8], 28, G, bid);
#pragma unroll
            for (int e = 1; e < NEXP; ++e) S.ts[e] = tiles[e];
            pg8::EpiSwiGLU8 E{ws + E_HID, DFFE, 1.0f / MOE_WSCALE, MOE_HSCALE};
            pg8::gemm_phase<pg8::EpiSwiGLU8, true>(lds, g, S, E);
        }
        GRID_BAR();
        DGL(dg_moe_hid(args, 10 * L + 7, m); GRID_BAR();)
        {
            pg8::Gemm g{(const bf16_t*)(ws + E_HID), (const bf16_t*)(ws + W_MDN + (size_t)m * 8 * 1024 * 3584), DFFE / 2};
            pg8::TileOrder S; S.init(tiles[8], 4, G, bid);
#pragma unroll
            for (int e = 1; e < NEXP; ++e) S.ts[e] = tiles[e];
            pg8::EpiPlain E{(bf16_t*)(ws + E_XS), DM, 1.0f / (MOE_WSCALE * MOE_HSCALE)};
            pg8::gemm_phase<pg8::EpiPlain, true>(lds, g, S, E);
        }
        GRID_BAR();
        DGL(dg_moe_y(args, 10 * L + 8, m); GRID_BAR();)
    }
}
__device__ __forceinline__ void final_combine(const Args& args, LAS unsigned char* lds, int bid, int G, const XcdBarrier& bar) {
    const float* modl = (const float*)(args.ws + TB_MODS) + (size_t)3 * NBATCH * 6144;
    DG(dg_save(args, 39, args.out); GRID_BAR();)
    norm_phase<false>(args, lds, bid, G, args.out, args.out, args.in[I_N1G], modl, 0, true, modl, true, nullptr);
    DG(GRID_BAR(); dg_combine(args, 39, modl);)
}

__global__ void __launch_bounds__(NTHR, 2) mega_fwd(Args args) {
    extern __shared__ __attribute__((aligned(16))) unsigned char lds_raw[];
    LAS unsigned char* lds = (LAS unsigned char*)lds_raw;
    const int tid = threadIdx.x, bid = blockIdx.x, G = gridDim.x;
    unsigned char* ws = args.ws;
    volatile LAS unsigned* MISC = (volatile LAS unsigned*)(lds + MISC_OFF);
    if (tid < 64) MISC[tid] = 0u;
    __syncthreads();
    XcdBarrier bar = xcd_barrier_post((unsigned*)(ws + WS_CTL) + CW_BAR, MISC + 8);

    prologue_phase(args, lds, bid, G);
    GRID_BAR();

    run_mixer<0>(args, lds, bid, G, bar);
    run_ffn<0>(args, lds, bid, G, bar);
    run_mixer<1>(args, lds, bid, G, bar);
    run_ffn<1>(args, lds, bid, G, bar);
    run_mixer<2>(args, lds, bid, G, bar);
    run_ffn<2>(args, lds, bid, G, bar);
    run_mixer<3>(args, lds, bid, G, bar);
    run_ffn<3>(args, lds, bid, G, bar);
    final_combine(args, lds, bid, G, bar);
    DG(GRID_BAR(); dg_final(args, 49);)
}

extern "C" void kernel_launch(void* const* d_in, const int* in_sizes, int n_in, void* d_out, int out_size, void* d_ws, size_t ws_size, hipStream_t stream) {
    static int grid = 0;
    if (grid == 0) {
        if (n_in != 30 || out_size != MTOK * DM || ws_size < WS_NEED) { fprintf(stderr, "kernel_launch: unexpected shapes (n_in %d out %d ws %zu need %zu)\n", n_in, out_size, ws_size, (size_t)WS_NEED); grid = -1; return; }
        int dev = 0, cus = 0;
        if (hipGetDevice(&dev) != hipSuccess || hipDeviceGetAttribute(&cus, hipDeviceAttributeMultiprocessorCount, dev) != hipSuccess) { grid = -1; return; }
        if (hipFuncSetAttribute((const void*)mega_fwd, hipFuncAttributeMaxDynamicSharedMemorySize, LDS_BYTES) != hipSuccess) { fprintf(stderr, "kernel_launch: hipFuncSetAttribute failed\n"); grid = -1; return; }
        int per_cu = 0;
        if (hipOccupancyMaxActiveBlocksPerMultiprocessor(&per_cu, (const void*)mega_fwd, NTHR, LDS_BYTES) != hipSuccess || per_cu < 1) { fprintf(stderr, "kernel_launch: occupancy query says %d\n", per_cu); }
        (void)hipGetLastError();
        grid = (cus >= 256) ? 256 : -1;
        if (grid < 0) { fprintf(stderr, "kernel_launch: needs 256 CUs, device has %d\n", cus); return; }
    }
    if (grid < 0) return;
    if (hipMemsetAsync((char*)d_ws + WS_CTL, 0, CTL_ZERO_BYTES, stream) != hipSuccess) return;
    Args a{};
    for (int i = 0; i < 30; ++i) a.in[i] = (const float*)d_in[i];
    a.out = (float*)d_out; a.ws = (unsigned char*)d_ws;
    hipLaunchKernelGGL(mega_fwd, dim3(grid), dim3(NTHR), LDS_BYTES, stream, a);
}
```

```cpp
#define DIAG_FROM 2
#include <hip/hip_runtime.h>
#include <cstdio>
#include <cstdint>

#define LAS __attribute__((address_space(3)))
#define GAS __attribute__((address_space(1)))
typedef unsigned short bf16_t;
typedef short bf16x8 __attribute__((ext_vector_type(8)));
typedef short s16x4 __attribute__((ext_vector_type(4)));
typedef float f32x2 __attribute__((ext_vector_type(2)));
typedef float f32x4 __attribute__((ext_vector_type(4)));
typedef float f32x16 __attribute__((ext_vector_type(16)));
typedef unsigned u32x2 __attribute__((ext_vector_type(2)));
typedef unsigned u32x4 __attribute__((ext_vector_type(4)));

constexpr int MTOK = 65536, DM = 1024, SEQ = 8192, NBATCH = 8, DEPTH = 4;
constexpr int DFF = 2816, DFFE = 3584, NEXP = 8, LRUW = 1280;
constexpr float EPS = 1e-6f;
constexpr int FP8_DENSE_FROM = 2;
constexpr float MOE_WSCALE = 64.0f, MOE_HSCALE = 4.0f;
constexpr float LOG2E = 1.4426950408889634f;

constexpr size_t MiB = 1u << 20;
constexpr size_t WS_CTL = 0, CTL_ZERO_BYTES = 1 * MiB;
constexpr size_t WS_TAB = 1 * MiB;
constexpr size_t TB_MODS = WS_TAB;
constexpr size_t TB_COS = WS_TAB + 1 * MiB;
constexpr size_t TB_SIN = WS_TAB + 2 * MiB;
constexpr size_t TB_SCAL = WS_TAB + 3 * MiB;
constexpr size_t TB_LB = TB_SCAL + 4096;
constexpr size_t TB_SP = TB_SCAL + 16384;
constexpr size_t TB_EID = WS_TAB + 4 * MiB;
constexpr size_t TB_GATE = WS_TAB + 5 * MiB;
constexpr size_t TB_SLOT = WS_TAB + 6 * MiB;
constexpr size_t TB_BCNT = WS_TAB + 7 * MiB;
constexpr size_t TB_TILES = TB_BCNT + 16384;
constexpr size_t TB_LSUM = WS_TAB + 8 * MiB;
constexpr size_t TB_LCIN = WS_TAB + 16 * MiB;
constexpr size_t WS_W = 32 * MiB;
constexpr size_t W_QKV = WS_W;
constexpr size_t W_AO = W_QKV + 2 * (size_t)3072 * 1024 * 2;
constexpr size_t W_HGI = W_AO + 2 * (size_t)1024 * 1024 * 2;
constexpr size_t W_HGO = W_HGI + (size_t)5120 * 1024 * 2;
constexpr size_t W_LRI = W_HGO + (size_t)1024 * 1024 * 2;
constexpr size_t W_LRG = W_LRI + (size_t)2560 * 1024 * 2;
constexpr size_t W_LRO = W_LRG + (size_t)10 * 2 * 256 * 128 * 2;
constexpr size_t W_FGU = W_LRO + (size_t)1024 * 1280 * 2;
constexpr size_t W_FDN = W_FGU + 2 * (size_t)5632 * 1024 * 2;
constexpr size_t W_MGU = W_FDN + 2 * (size_t)1024 * 2816 * 2;
constexpr size_t W_MDN = W_MGU + 16 * (size_t)7168 * 1024 * 2;
constexpr size_t W_END = W_MDN + 16 * (size_t)1024 * 3584 * 2;
constexpr size_t WS_HM = 440 * MiB;
constexpr size_t WS_ACT = 568 * MiB;
static_assert(W_END <= WS_HM, "weights overflow");
constexpr size_t SZ_TOK = (size_t)MTOK * 1024 * 2;
constexpr size_t A_Q = WS_ACT, A_K = A_Q + SZ_TOK, A_V = A_K + SZ_TOK;
constexpr size_t F_HID = WS_ACT;
constexpr size_t H_Q = WS_ACT, H_LFF = H_Q + SZ_TOK, H_LFB = H_LFF + SZ_TOK, H_V = H_LFB + SZ_TOK, H_G = H_V + SZ_TOK, H_OF = H_G + SZ_TOK, H_OB = H_OF + SZ_TOK;
constexpr size_t SZ_LRU = (size_t)MTOK * 1280 * 2;
constexpr size_t L_YB = WS_ACT, L_XB = L_YB + SZ_LRU, L_HF = L_XB + SZ_LRU, L_HY = L_HF + SZ_LRU;
constexpr int MOE_ROWS = 2 * MTOK + NEXP * 256;
constexpr size_t E_XS = WS_ACT, E_HID = E_XS + (size_t)MOE_ROWS * 1024 * 2, E_END = E_HID + (size_t)MOE_ROWS * DFFE * 2;
constexpr size_t WS_NEED = E_END;
static_assert(WS_NEED <= (size_t)1792 * MiB, "workspace");

constexpr int CW_BAR = 4096;

constexpr int RING_BYTES = 135168;
constexpr int MISC_OFF = RING_BYTES;
constexpr int LDS_BYTES = 147456;
constexpr int NWAVES = 8, NTHR = 512;

typedef __bf16 bf16x2v __attribute__((ext_vector_type(2)));
__device__ __forceinline__ unsigned cvt_pk_bf16(float lo, float hi) { const f32x2 v = {lo, hi}; const bf16x2v b = __builtin_convertvector(v, bf16x2v); return __builtin_bit_cast(unsigned, b); }
__device__ __forceinline__ unsigned pk_fp8x4(float a, float b, float c, float d) { unsigned w = 0; w = __builtin_amdgcn_cvt_pk_fp8_f32(a, b, w, false); w = __builtin_amdgcn_cvt_pk_fp8_f32(c, d, w, true); return w; }
__device__ __forceinline__ unsigned f2bf(float f) { unsigned u = __builtin_bit_cast(unsigned, f); return (u + 0x7fffu + ((u >> 16) & 1u)) >> 16; }
__device__ __forceinline__ float bf2f(unsigned short b) { return __builtin_bit_cast(float, ((unsigned)b) << 16); }
__device__ __forceinline__ float bflo(unsigned w) { return __builtin_bit_cast(float, w << 16); }
__device__ __forceinline__ float bfhi(unsigned w) { return __builtin_bit_cast(float, w & 0xffff0000u); }
__device__ __forceinline__ float fexp2(float x) { return __builtin_amdgcn_exp2f(x); }
__device__ __forceinline__ float fexp(float x) { return __builtin_amdgcn_exp2f(x * LOG2E); }
__device__ __forceinline__ float frcp(float x) { return __builtin_amdgcn_rcpf(x); }
__device__ __forceinline__ float fsigmoid(float x) { return frcp(1.0f + fexp(-x)); }
__device__ __forceinline__ float fsilu(float x) { return x * fsigmoid(x); }
__device__ __forceinline__ float wave_sum(float v) {
#pragma unroll
    for (int o = 1; o < 64; o <<= 1) v += __shfl_xor(v, o);
    return v;
}
#define LDS_WAIT() asm volatile("s_waitcnt lgkmcnt(0)" ::: "memory")
#define VM_WAIT() asm volatile("s_waitcnt vmcnt(0)" ::: "memory")

#define XB_TMO      128
#define XB_XCNT(j)  (256  + 64 * (j))
#define XB_XSUB(j)  (1280 + 64 * (j))
#define XB_XGEN(j)  (2304 + 64 * (j))
#define XB_TOP      3328
#define XB_TOPGEN   3392
#define XCD_BAR_WORDS 3456
#define XB_SPIN_CAP (1u << 22)
__device__ __forceinline__ unsigned xb_ld(unsigned* p)              { return __hip_atomic_load(p, __ATOMIC_RELAXED, __HIP_MEMORY_SCOPE_AGENT); }
__device__ __forceinline__ unsigned xb_add(unsigned* p, unsigned v) { return __hip_atomic_fetch_add(p, v, __ATOMIC_RELAXED, __HIP_MEMORY_SCOPE_AGENT); }
__device__ __forceinline__ unsigned xb_xcc_id() { return (unsigned)__builtin_amdgcn_s_getreg((3 << 11) | 20) & 0xFu; }
#define XB_SPIN(cond, bar) do { unsigned _sp = 0; while (cond) { __builtin_amdgcn_s_sleep(1); \
    if ((++_sp & 255u) == 0u) { if (xb_ld(&(bar)[XB_TMO])) break; if (_sp > XB_SPIN_CAP) { atomicAdd(&(bar)[XB_TMO], 1u); break; } } } } while (0)
struct XcdBarrier { unsigned* bar; unsigned x; volatile LAS unsigned* st; };
__device__ __forceinline__ XcdBarrier xcd_barrier_post(unsigned* bar, volatile LAS unsigned* st) {
    XcdBarrier b; b.bar = bar; b.x = xb_xcc_id(); b.st = st;
    if (threadIdx.x == 0) (void)xb_add(&bar[XB_XCNT(b.x)], 1u);
    return b;
}
__device__ __forceinline__ void xcd_barrier_complete(unsigned* bar, unsigned x, unsigned& nloc, unsigned& nx) {
    const unsigned G = gridDim.x * gridDim.y * gridDim.z;
    unsigned sum, cnt, mine, sp = 0u;
    for (;;) {
        sum = 0u; cnt = 0u; mine = 0u;
#pragma unroll
        for (unsigned j = 0; j < 16; ++j) { const unsigned c = xb_ld(&bar[XB_XCNT(j)]); sum += c; cnt += (c > 0u) ? 1u : 0u; mine = (j == x) ? c : mine; }
        if (sum == G) break;
        __builtin_amdgcn_s_sleep(1);
        if ((++sp & 255u) == 0u) { if (xb_ld(&bar[XB_TMO])) break; if (sp > XB_SPIN_CAP) { atomicAdd(&bar[XB_TMO], 1u); break; } }
    }
    nloc = mine > 0u ? mine : 1u; nx = cnt > 0u ? cnt : 1u;
}
__device__ __forceinline__ void xcd_barrier(const XcdBarrier& b) {
    asm volatile("s_waitcnt vmcnt(0)" ::: "memory");
    __syncthreads();
    if (threadIdx.x == 0) {
        unsigned* bar = b.bar;
        __builtin_amdgcn_s_waitcnt(0);
        unsigned nloc = b.st[0], nx = b.st[1];
        if (nloc == 0u) { xcd_barrier_complete(bar, b.x, nloc, nx); b.st[0] = nloc; b.st[1] = nx; }
        const unsigned old = xb_add(&bar[XB_XSUB(b.x)], 1u);
        const unsigned gen = old / nloc;
        if (old + 1u == (gen + 1u) * nloc) {
            __builtin_amdgcn_fence(__ATOMIC_RELEASE, "agent");
            asm volatile("s_waitcnt vmcnt(0)" ::: "memory");
            const unsigned og = xb_add(&bar[XB_TOP], 1u);
            const unsigned tg = og / nx;
            if (og + 1u == (tg + 1u) * nx) xb_add(&bar[XB_TOPGEN], 1u);
            else XB_SPIN(xb_ld(&bar[XB_TOPGEN]) == tg, bar);
            __builtin_amdgcn_fence(__ATOMIC_ACQUIRE, "agent");
            xb_add(&bar[XB_XGEN(b.x)], 1u);
            asm volatile("s_waitcnt vmcnt(0)" ::: "memory");
        } else {
            XB_SPIN(xb_ld(&bar[XB_XGEN(b.x)]) == gen, bar);
            __builtin_amdgcn_fence(__ATOMIC_ACQUIRE, "agent");
            asm volatile("s_waitcnt vmcnt(0)" ::: "memory");
        }
    }
    __syncthreads();
}

namespace pg8 {
constexpr int BM = 256, BK = 64, HALF = 128, HTB = HALF * BK * 2, STAGE_BYTES = 8 * HTB, NXCD = 8, WGM = 8;
__host__ __device__ __forceinline__ int lds_byte(int r, int c) { const int st = (r >> 4) * 2 + (c >> 5), rr = r & 15, cc = c & 31, ob = rr * 64 + cc * 2; return st * 1024 + (ob ^ (((ob >> 9) & 1) << 5)); }
__host__ __device__ __forceinline__ void stage_rc(int b, int& R, int& C) { const int st = b / 1024, sb = b % 1024, swz = sb ^ (((sb >> 9) & 1) << 5); R = (st >> 1) * 16 + swz / 64; C = (st & 1) * 32 + (swz % 64) / 2; }
__host__ __device__ __forceinline__ int perm32(int rho) { const int n = rho >> 4, i = rho & 15; return 8 * (i >> 2) + 4 * n + (i & 3); }

struct Unit { int pm, pn, pb; };
struct Gemm { const bf16_t* A; const bf16_t* Bt; int K; };

struct TileOrder {
    int nM, nN, nwg, G, c; int ts[NEXP];
    __device__ __forceinline__ void init(int nM_, int nN_, int G_, int c_) { nM = nM_; nN = nN_; nwg = nM * nN; G = G_; c = c_;
#pragma unroll
        for (int e = 0; e < NEXP; ++e) ts[e] = (e == 0) ? 0 : 0x7fffffff; }
    __device__ __forceinline__ bool next(int i, Unit& u) const {
        const long L = (long)i * G + c; if (L >= nwg) return false;
        int wgid = (int)L; { const int q = nwg / NXCD, r = nwg % NXCD, xcd = wgid % NXCD, off = wgid / NXCD; wgid = (xcd < r ? xcd * (q + 1) : r * (q + 1) + (xcd - r) * q) + off; }
        const int nig = WGM * nN, gid = wgid / nig, fm = gid * WGM, gsz = (nM - fm) < WGM ? (nM - fm) : WGM;
        u.pm = fm + ((wgid % nig) % gsz); u.pn = (wgid % nig) / gsz;
        int e = 0;
#pragma unroll
        for (int k = 1; k < NEXP; ++k) e += (u.pm >= ts[k]) ? 1 : 0;
        u.pb = e * nN + u.pn; return true;
    }
};

typedef int v8i32 __attribute__((ext_vector_type(8)));
template <class Epi, bool FP8 = false>
__device__ __forceinline__ void gemm_phase(LAS unsigned char* lds, const Gemm g, const TileOrder& S, const Epi& E) {
    int tid_ = threadIdx.x; asm volatile("" : "+v"(tid_));
    const int tid = tid_, wid = __builtin_amdgcn_readfirstlane(tid >> 6), lane = tid & 63, wr = wid >> 2, wc = wid & 3, fr = lane & 15, fq = lane >> 4;
    const int K = g.K, nt = K / BK;
    unsigned voffA[2], voffB[2];
#pragma unroll
    for (int i = 0; i < 2; ++i) { int R, C; stage_rc(tid * 16 + i * 8192, R, C); const int Rb = Epi::PERM ? ((R & ~31) + perm32(R & 31)) : R;
        voffA[i] = (unsigned)(R * K + C) * 2u; voffB[i] = (unsigned)(Rb * K + C) * 2u; }
    const size_t kstep = (size_t)(BK * 2);
    const size_t hstep = (size_t)HALF * K * 2;
    const size_t tstep = 2 * hstep;
    const unsigned ldsw = (unsigned)wid * 1024u;
    const int aoff = lds_byte(wr * 64 + fr, fq * 8), boff = lds_byte(wc * 32 + fr, fq * 8);
#define PG8_SA(b, h) (((b) * 2 + (h)) * HTB)
#define PG8_SB(b, h) ((4 + (b) * 2 + (h)) * HTB)
#define PG8_STAGE(bufoff, gbase, voff) do { _Pragma("unroll") for (int _i = 0; _i < 2; ++_i) \
        __builtin_amdgcn_global_load_lds((const unsigned*)((const char*)(gbase) + (voff)[_i]), (LAS unsigned*)(lds + (bufoff) + ldsw + _i * 8192), 16, 0, 0); } while (0)
#define PG8_LD8(p) __builtin_bit_cast(v8i32, __builtin_shufflevector(*(const LAS u32x4*)(p), *(const LAS u32x4*)((p) + 1024), 0, 1, 2, 3, 4, 5, 6, 7))
#define PG8_LDA(dst, b, h) do { if constexpr (FP8) { _Pragma("unroll") for (int m = 0; m < 4; ++m) dst##8[m] = PG8_LD8(lds + PG8_SA(b, h) + aoff + m * 2048); } \
        else { _Pragma("unroll") for (int m = 0; m < 4; ++m) _Pragma("unroll") for (int k = 0; k < 2; ++k) dst[m][k] = *(const LAS bf16x8*)(lds + PG8_SA(b, h) + aoff + m * 2048 + k * 1024); } } while (0)
#define PG8_LDB(dst, b, h) do { if constexpr (FP8) { _Pragma("unroll") for (int n = 0; n < 2; ++n) dst##8[n] = PG8_LD8(lds + PG8_SB(b, h) + boff + n * 2048); } \
        else { _Pragma("unroll") for (int n = 0; n < 2; ++n) _Pragma("unroll") for (int k = 0; k < 2; ++k) dst[n][k] = *(const LAS bf16x8*)(lds + PG8_SB(b, h) + boff + n * 2048 + k * 1024); } } while (0)
#define PG8_MMA(ai, bj, At, Bt) do { __builtin_amdgcn_s_setprio(1); \
        if constexpr (FP8) { _Pragma("unroll") for (int m = 0; m < 4; ++m) _Pragma("unroll") for (int n = 0; n < 2; ++n) \
            asm volatile("v_mfma_scale_f32_16x16x128_f8f6f4 %0, %1, %2, %0, %3, %3 op_sel_hi:[0,0,0]" : "+v"(acc[ai][bj][m][n]) : "v"(Bt##8[n]), "v"(At##8[m]), "v"(one_scale)); } \
        else { _Pragma("unroll") for (int m = 0; m < 4; ++m) _Pragma("unroll") for (int n = 0; n < 2; ++n) _Pragma("unroll") for (int k = 0; k < 2; ++k) \
            acc[ai][bj][m][n] = __builtin_amdgcn_mfma_f32_16x16x32_bf16(Bt[n][k], At[m][k], acc[ai][bj][m][n], 0, 0, 0); } \
        __builtin_amdgcn_s_setprio(0); } while (0)
#define PG8_WAIT_V(n) asm volatile("s_waitcnt vmcnt(" #n ")" ::: "memory")
#define PG8_WAIT_L(n) asm volatile("s_waitcnt lgkmcnt(" #n ")" ::: "memory")
#define PG8_BAR __builtin_amdgcn_s_barrier()
#define PG8_SCHED __builtin_amdgcn_sched_barrier(0)
    Unit cur, nxt; int ui = 0;
    if (!S.next(0, cur)) return;
    f32x4 acc[2][2][4][2];
#pragma unroll
    for (int a = 0; a < 2; ++a)
#pragma unroll
        for (int b = 0; b < 2; ++b)
#pragma unroll
            for (int m = 0; m < 4; ++m)
#pragma unroll
                for (int n = 0; n < 2; ++n) acc[a][b][m][n] = (f32x4){0.f, 0.f, 0.f, 0.f};
    bf16x8 At[4][2], B0[2][2], B1[2][2]; v8i32 At8[4], B08[2], B18[2];
    int one_scale = 0x7f7f7f7f; asm volatile("" : "+v"(one_scale));
    const char* cA = (const char*)g.A + (size_t)cur.pm * tstep; const char* cB = (const char*)g.Bt + (size_t)cur.pb * tstep;
    PG8_STAGE(PG8_SB(0, 0), cB, voffB); PG8_STAGE(PG8_SA(0, 0), cA, voffA); PG8_STAGE(PG8_SB(0, 1), cB + hstep, voffB); PG8_STAGE(PG8_SA(0, 1), cA + hstep, voffA);
    if (wr == 1) PG8_BAR;
    PG8_WAIT_V(4); PG8_BAR;
    PG8_STAGE(PG8_SB(1, 0), cB + kstep, voffB); PG8_STAGE(PG8_SA(1, 0), cA + kstep, voffA); PG8_STAGE(PG8_SB(1, 1), cB + hstep + kstep, voffB);
    PG8_WAIT_V(6); PG8_BAR;
    for (;;) {
        const bool has_next = S.next(ui + 1, nxt);
        const char* nA = has_next ? (const char*)g.A + (size_t)nxt.pm * tstep : cA; const char* nB = has_next ? (const char*)g.Bt + (size_t)nxt.pb * tstep : cB;
        for (int t = 0; t < nt; t += 2) {
            const bool last = (t == nt - 2);
            const char* a1 = cA + (size_t)(t + 1) * kstep;
            const char* a2 = last ? nA : cA + (size_t)(t + 2) * kstep; const char* b2 = last ? nB : cB + (size_t)(t + 2) * kstep;
            const char* a3 = a2 + kstep; const char* b3 = b2 + kstep;
            PG8_LDB(B0, 0, 0); PG8_SCHED; PG8_LDA(At, 0, 0); PG8_STAGE(PG8_SA(1, 1), a1 + hstep, voffA);
            PG8_WAIT_L(8); PG8_BAR; PG8_WAIT_L(0); PG8_MMA(0, 0, At, B0); PG8_BAR; PG8_SCHED;
            PG8_LDB(B1, 0, 1); PG8_STAGE(PG8_SB(0, 0), b2, voffB);
            PG8_BAR; PG8_WAIT_L(0); PG8_MMA(0, 1, At, B1); PG8_BAR;
            PG8_LDA(At, 0, 1); PG8_STAGE(PG8_SA(0, 0), a2, voffA);
            PG8_BAR; PG8_WAIT_L(0); PG8_MMA(1, 0, At, B0); PG8_BAR; PG8_SCHED;
            PG8_STAGE(PG8_SB(0, 1), b2 + hstep, voffB);
            PG8_WAIT_V(6); PG8_BAR; PG8_MMA(1, 1, At, B1); PG8_BAR;
            PG8_LDB(B0, 1, 0); PG8_SCHED; PG8_LDA(At, 1, 0); PG8_STAGE(PG8_SA(0, 1), a2 + hstep, voffA);
            PG8_WAIT_L(8); PG8_BAR; PG8_WAIT_L(0); PG8_MMA(0, 0, At, B0); PG8_BAR; PG8_SCHED;
            PG8_LDB(B1, 1, 1); PG8_STAGE(PG8_SB(1, 0), b3, voffB);
            PG8_BAR; PG8_WAIT_L(0); PG8_MMA(0, 1, At, B1); PG8_BAR;
            PG8_LDA(At, 1, 1); PG8_STAGE(PG8_SA(1, 0), a3, voffA);
            PG8_BAR; PG8_WAIT_L(0); PG8_MMA(1, 0, At, B0); PG8_BAR; PG8_SCHED;
            PG8_STAGE(PG8_SB(1, 1), b3 + hstep, voffB);
            PG8_WAIT_V(6); PG8_BAR; PG8_MMA(1, 1, At, B1); PG8_BAR;
        }
        if constexpr (FP8) asm volatile("s_nop 15\n\ts_nop 15" ::: "memory");
        E(acc, cur, wr, wc, fr, fq);
        if (!has_next) break;
#pragma unroll
        for (int a = 0; a < 2; ++a)
#pragma unroll
            for (int b = 0; b < 2; ++b)
#pragma unroll
                for (int m = 0; m < 4; ++m)
#pragma unroll
                    for (int n = 0; n < 2; ++n) acc[a][b][m][n] = (f32x4){0.f, 0.f, 0.f, 0.f};
        cur = nxt; cA = nA; cB = nB; ++ui;
    }
    PG8_WAIT_V(0);
    if (wr == 0) PG8_BAR;
    PG8_BAR;
#undef PG8_SA
#undef PG8_SB
#undef PG8_STAGE
#undef PG8_LDA
#undef PG8_LDB
#undef PG8_MMA
#undef PG8_LD8
#undef PG8_WAIT_V
#undef PG8_WAIT_L
#undef PG8_BAR
#undef PG8_SCHED
}

struct EpiQKV {
    static constexpr bool PERM = true;
    bf16_t *Q, *Kk, *V; const float *gq, *gk, *cosT, *sinT; float qscale;
    __device__ __forceinline__ void operator()(const f32x4 (&acc)[2][2][4][2], const Unit& u, int wr, int wc, int fr, int fq) const {
        const int row0 = u.pm * BM + wr * 64 + fr;
        if (u.pn >= 8) {
            const int col0 = (u.pn - 8) * BM + wc * 32 + 8 * fq;
#pragma unroll
            for (int ai = 0; ai < 2; ++ai)
#pragma unroll
                for (int m = 0; m < 4; ++m) { bf16_t* rowp = V + (size_t)(row0 + ai * HALF + m * 16) * DM + col0;
#pragma unroll
                    for (int bj = 0; bj < 2; ++bj) { const f32x4 v0 = acc[ai][bj][m][0], v1 = acc[ai][bj][m][1];
                        u32x4 w; w.x = cvt_pk_bf16(v0[0], v0[1]); w.y = cvt_pk_bf16(v0[2], v0[3]); w.z = cvt_pk_bf16(v1[0], v1[1]); w.w = cvt_pk_bf16(v1[2], v1[3]);
                        *(u32x4*)(rowp + bj * HALF) = w; } }
        } else {
            const int part = u.pn >> 2, sh = 4 * (u.pn & 3) + wc;
            bf16_t* dst = part ? Kk : Q; const float* g = part ? gk : gq; const float sc = part ? 1.0f : qscale;
            f32x4 g0[2], g1[2];
#pragma unroll
            for (int n = 0; n < 2; ++n) { g0[n] = *(const f32x4*)(g + 8 * fq + 4 * n); g1[n] = *(const f32x4*)(g + 32 + 8 * fq + 4 * n); }
#pragma unroll
            for (int ai = 0; ai < 2; ++ai)
#pragma unroll
                for (int m = 0; m < 4; ++m) {
                    const int r = row0 + ai * HALF + m * 16; const int pos = r & (SEQ - 1);
                    f32x4 x1[2], x2[2]; float ss = 0.f;
#pragma unroll
                    for (int n = 0; n < 2; ++n) { x1[n] = acc[ai][0][m][n]; x2[n] = acc[ai][1][m][n];
                        ss += (x1[n][0] * x1[n][0] + x1[n][1] * x1[n][1]) + (x1[n][2] * x1[n][2] + x1[n][3] * x1[n][3]);
                        ss += (x2[n][0] * x2[n][0] + x2[n][1] * x2[n][1]) + (x2[n][2] * x2[n][2] + x2[n][3] * x2[n][3]); }
                    ss += __shfl_xor(ss, 16); ss += __shfl_xor(ss, 32);
                    const float rstd = __builtin_amdgcn_rsqf(ss * (1.0f / 64.0f) + EPS) ;
                    bf16_t* op = dst + (size_t)r * DM + sh * 64 + 8 * fq;
                    u32x4 w1, w2;
#pragma unroll
                    for (int n = 0; n < 2; ++n) {
                        const f32x4 cs = *(const f32x4*)(cosT + pos * 32 + 8 * fq + 4 * n), sn = *(const f32x4*)(sinT + pos * 32 + 8 * fq + 4 * n);
                        const f32x4 y1 = x1[n] * rstd * g0[n], y2 = x2[n] * rstd * g1[n];
                        const f32x4 o1 = (y1 * cs - y2 * sn) * sc, o2 = (y2 * cs + y1 * sn) * sc;
                        if (n == 0) { w1.x = cvt_pk_bf16(o1[0], o1[1]); w1.y = cvt_pk_bf16(o1[2], o1[3]); w2.x = cvt_pk_bf16(o2[0], o2[1]); w2.y = cvt_pk_bf16(o2[2], o2[3]); }
                        else { w1.z = cvt_pk_bf16(o1[0], o1[1]); w1.w = cvt_pk_bf16(o1[2], o1[3]); w2.z = cvt_pk_bf16(o2[0], o2[1]); w2.w = cvt_pk_bf16(o2[2], o2[3]); }
                    }
                    *(u32x4*)(op) = w1; *(u32x4*)(op + 32) = w2;
                }
        }
    }
};
struct EpiRes {
    static constexpr bool PERM = false;
    const float* xin; float* xout; const float* gate; float sc;
    __device__ __forceinline__ void operator()(const f32x4 (&acc)[2][2][4][2], const Unit& u, int wr, int wc, int fr, int fq) const {
        const int row0 = u.pm * BM + wr * 64 + fr, col0 = u.pn * BM + wc * 32 + 4 * fq;
        const float* gp = gate + (size_t)(u.pm >> 5) * 6144 + col0;
        f32x4 gv[2][2];
#pragma unroll
        for (int bj = 0; bj < 2; ++bj)
#pragma unroll
            for (int n = 0; n < 2; ++n) gv[bj][n] = *(const f32x4*)(gp + bj * HALF + n * 16) * sc;
#pragma unroll
        for (int ai = 0; ai < 2; ++ai)
#pragma unroll
            for (int m = 0; m < 4; ++m) { const size_t off = (size_t)(row0 + ai * HALF + m * 16) * DM + col0;
#pragma unroll
                for (int bj = 0; bj < 2; ++bj)
#pragma unroll
                    for (int n = 0; n < 2; ++n) { const f32x4 xv = *(const f32x4*)(xin + off + bj * HALF + n * 16);
                        *(f32x4*)(xout + off + bj * HALF + n * 16) = xv + gv[bj][n] * acc[ai][bj][m][n]; }
                asm volatile("" ::: "memory"); }
    }
};
struct EpiSwiGLU {
    static constexpr bool PERM = true;
    bf16_t* H; int ldh;
    __device__ __forceinline__ void operator()(const f32x4 (&acc)[2][2][4][2], const Unit& u, int wr, int wc, int fr, int fq) const {
        const int row0 = u.pm * BM + wr * 64 + fr, col0 = u.pn * HALF + wc * 32 + 8 * fq;
#pragma unroll
        for (int ai = 0; ai < 2; ++ai)
#pragma unroll
            for (int m = 0; m < 4; ++m) { bf16_t* rowp = H + (size_t)(row0 + ai * HALF + m * 16) * ldh + col0;
                f32x4 v[2];
#pragma unroll
                for (int n = 0; n < 2; ++n) { const f32x4 gt = acc[ai][0][m][n], up = acc[ai][1][m][n];
#pragma unroll
                    for (int j = 0; j < 4; ++j) v[n][j] = fsilu(gt[j]) * up[j]; }
                u32x4 w; w.x = cvt_pk_bf16(v[0][0], v[0][1]); w.y = cvt_pk_bf16(v[0][2], v[0][3]); w.z = cvt_pk_bf16(v[1][0], v[1][1]); w.w = cvt_pk_bf16(v[1][2], v[1][3]);
                *(u32x4*)rowp = w; }
    }
};
struct EpiSwiGLU8 {
    static constexpr bool PERM = true;
    unsigned char* H; int ldh; float ws, hs;
    __device__ __forceinline__ void operator()(const f32x4 (&acc)[2][2][4][2], const Unit& u, int wr, int wc, int fr, int fq) const {
        const int row0 = u.pm * BM + wr * 64 + fr, col0 = u.pn * HALF + wc * 32 + 8 * fq;
#pragma unroll
        for (int ai = 0; ai < 2; ++ai)
#pragma unroll
            for (int m = 0; m < 4; ++m) { unsigned char* rowp = H + (size_t)(row0 + ai * HALF + m * 16) * ldh + col0;
                f32x4 v[2];
#pragma unroll
                for (int n = 0; n < 2; ++n) { const f32x4 gt = acc[ai][0][m][n] * ws, up = acc[ai][1][m][n] * (ws * hs);
#pragma unroll
                    for (int j = 0; j < 4; ++j) v[n][j] = fsilu(gt[j]) * up[j]; }
                *(u32x2*)rowp = (u32x2){pk_fp8x4(v[0][0], v[0][1], v[0][2], v[0][3]), pk_fp8x4(v[1][0], v[1][1], v[1][2], v[1][3])}; }
    }
};
struct EpiPlain {
    static constexpr bool PERM = true;
    bf16_t* O; int ldc; float sc;
    __device__ __forceinline__ void operator()(const f32x4 (&acc)[2][2][4][2], const Unit& u, int wr, int wc, int fr, int fq) const {
        const int row0 = u.pm * BM + wr * 64 + fr, col0 = u.pn * BM + wc * 32 + 8 * fq;
#pragma unroll
        for (int ai = 0; ai < 2; ++ai)
#pragma unroll
            for (int m = 0; m < 4; ++m) { bf16_t* rowp = O + (size_t)(row0 + ai * HALF + m * 16) * ldc + col0;
#pragma unroll
                for (int bj = 0; bj < 2; ++bj) { const f32x4 v0 = acc[ai][bj][m][0] * sc, v1 = acc[ai][bj][m][1] * sc;
                    u32x4 w; w.x = cvt_pk_bf16(v0[0], v0[1]); w.y = cvt_pk_bf16(v0[2], v0[3]); w.z = cvt_pk_bf16(v1[0], v1[1]); w.w = cvt_pk_bf16(v1[2], v1[3]);
                    *(u32x4*)(rowp + bj * HALF) = w; } }
    }
};
struct EpiAct {
    static constexpr bool PERM = true;
    int kind; unsigned char* ws; const float* lb;
    __device__ __forceinline__ void operator()(const f32x4 (&acc)[2][2][4][2], const Unit& u, int wr, int wc, int fr, int fq) const {
        const int row0 = u.pm * BM + wr * 64 + fr;
        int mode, ldc, colt; size_t boff;
        if (kind == 0) { const int grp = u.pn >> 2; colt = (u.pn & 3) * 256; ldc = 1024;
            boff = grp == 0 ? H_Q : grp == 1 ? H_LFF : grp == 2 ? H_LFB : grp == 3 ? H_V : H_G; mode = (grp == 0 || grp == 4) ? 1 : (grp == 3 ? 0 : 3); }
        else { ldc = LRUW; if (u.pn < 5) { boff = L_YB; colt = u.pn * 256; mode = 2; } else { boff = L_XB; colt = (u.pn - 5) * 256; mode = 0; } }
        bf16_t* base = (bf16_t*)(ws + boff);
        const int col0 = colt + wc * 32 + 8 * fq;
        f32x4 lbv[2][2];
        if (mode == 3) { const float* lp = lb + ((u.pn >> 2) - 1) * 1024 + col0;
#pragma unroll
            for (int bj = 0; bj < 2; ++bj)
#pragma unroll
                for (int n = 0; n < 2; ++n) lbv[bj][n] = *(const f32x4*)(lp + bj * HALF + 4 * n); }
#pragma unroll
        for (int ai = 0; ai < 2; ++ai)
#pragma unroll
            for (int m = 0; m < 4; ++m) { bf16_t* rowp = base + (size_t)(row0 + ai * HALF + m * 16) * ldc + col0;
#pragma unroll
                for (int bj = 0; bj < 2; ++bj) { f32x4 v[2]; u32x4 w;
#pragma unroll
                    for (int n = 0; n < 2; ++n) { v[n] = acc[ai][bj][m][n];
                        if (mode == 1) {
#pragma unroll
                            for (int j = 0; j < 4; ++j) v[n][j] = fsilu(v[n][j]); }
                        else if (mode == 2) {
#pragma unroll
                            for (int j = 0; j < 4; ++j) { const float x = v[n][j]; v[n][j] = x * fsigmoid(1.5957691216057308f * (x + 0.044715f * x * x * x)); } }
                        else if (mode == 3) {
#pragma unroll
                            for (int j = 0; j < 4; ++j) { const float l = lbv[bj][n][j]; const float fg = l + (1.0f - l) * fsigmoid(v[n][j]); v[n][j] = __builtin_amdgcn_logf(fg) * 0.6931471805599453f; } }
                    }
                    if (mode == 3) {
#pragma unroll
                        for (int n = 0; n < 2; ++n) { const _Float16 h0 = (_Float16)v[n][0], h1 = (_Float16)v[n][1], h2 = (_Float16)v[n][2], h3 = (_Float16)v[n][3];
                            const unsigned a = (unsigned)__builtin_bit_cast(unsigned short, h0) | ((unsigned)__builtin_bit_cast(unsigned short, h1) << 16);
                            const unsigned b = (unsigned)__builtin_bit_cast(unsigned short, h2) | ((unsigned)__builtin_bit_cast(unsigned short, h3) << 16);
                            if (n == 0) { w.x = a; w.y = b; } else { w.z = a; w.w = b; } }
                    } else { w.x = cvt_pk_bf16(v[0][0], v[0][1]); w.y = cvt_pk_bf16(v[0][2], v[0][3]); w.z = cvt_pk_bf16(v[1][0], v[1][1]); w.w = cvt_pk_bf16(v[1][2], v[1][3]); }
                    *(u32x4*)(rowp + bj * HALF) = w; } }
    }
};
}

struct Args { const float* in[30]; float* out; unsigned char* ws; };
enum { I_X = 0, I_C, I_ADAW, I_ADAB, I_N1G, I_N2G, I_ATWIN, I_ATQN, I_ATKN, I_ATLAM, I_ATSUB, I_ATWOUT, I_HGWIN, I_HGLB, I_HGNG, I_HGWOUT,
       I_LRWIN, I_LRCW, I_LRCB, I_LRWA, I_LRBA, I_LRWX, I_LRBX, I_LRLAM, I_LRWOUT, I_FFGU, I_FFDN, I_MOER, I_MOEGU, I_MOEDN };
enum { SC_LAM0 = 0, SC_LAM1, SC_OML0, SC_OML1, SC_MC0, SC_MC1 };

__device__ __forceinline__ void cvt_item(const float* W, int ldw, int src_col0, bf16_t* WT, int ldt, int dst_row0, int k0, LAS float* scr, int lane) {
#pragma unroll 8
    for (int i = 0; i < 32; ++i) { const int kk = 2 * i + (lane >> 5); scr[kk * 33 + (lane & 31)] = W[(size_t)(k0 + kk) * ldw + src_col0 + (lane & 31)]; }
    LDS_WAIT(); asm volatile("" ::: "memory");
    const int c = lane & 7;
#pragma unroll
    for (int j = 0; j < 4; ++j) { const int n = (lane >> 3) + 8 * j; const LAS float* s = scr + (8 * c) * 33 + n;
        u32x4 o; o.x = cvt_pk_bf16(s[0 * 33], s[1 * 33]); o.y = cvt_pk_bf16(s[2 * 33], s[3 * 33]); o.z = cvt_pk_bf16(s[4 * 33], s[5 * 33]); o.w = cvt_pk_bf16(s[6 * 33], s[7 * 33]);
        *(u32x4*)(WT + (size_t)(dst_row0 + n) * ldt + k0 + 8 * c) = o; }
    LDS_WAIT(); asm volatile("" ::: "memory");
}
__device__ __forceinline__ void cvt_item8(const float* W, int ldw, int src_col0, unsigned char* WT, int ldt, int dst_row0, int k0, float sc, LAS float* scr, int lane) {
#pragma unroll 8
    for (int i = 0; i < 32; ++i) { const int kk = 2 * i + (lane >> 5); scr[kk * 33 + (lane & 31)] = W[(size_t)(k0 + kk) * ldw + src_col0 + (lane & 31)]; }
    LDS_WAIT(); asm volatile("" ::: "memory");
    const int c = lane & 7;
#pragma unroll
    for (int j = 0; j < 4; ++j) { const int n = (lane >> 3) + 8 * j; const LAS float* s = scr + (8 * c) * 33 + n;
        *(u32x2*)(WT + (size_t)(dst_row0 + n) * ldt + k0 + 8 * c) = (u32x2){pk_fp8x4(s[0 * 33] * sc, s[1 * 33] * sc, s[2 * 33] * sc, s[3 * 33] * sc), pk_fp8x4(s[4 * 33] * sc, s[5 * 33] * sc, s[6 * 33] * sc, s[7 * 33] * sc)}; }
    LDS_WAIT(); asm volatile("" ::: "memory");
}
enum { MAP_ID = 0, MAP_QKV = 1, MAP_SWI = 2 };
template <bool F8 = false>
__device__ __forceinline__ void cvt_family(const float* src, size_t sstride, int ninst, int ldw, int K, int ng, int map, int F, bf16_t* dst, size_t dstride,
                                           LAS float* scr, int gw, int NGW, int lane) {
    const int nkb = K / 64, per = nkb * ng, total = ninst * per;
    for (int it = gw; it < total; it += NGW) {
        const int inst = it / per, r = it - inst * per, kb = r / ng, gi = r - kb * ng;
        int sc0;
        if (map == MAP_ID) sc0 = 32 * gi;
        else if (map == MAP_QKV) { const int pn = gi >> 3, bj = (gi >> 2) & 1, wc = gi & 3;
            if (pn < 8) { const int part = pn >> 2, sh = 4 * (pn & 3) + wc; sc0 = part * 1024 + sh * 64 + 32 * bj; } else sc0 = 32 * gi; }
        else { const int pn = gi >> 3, bj = (gi >> 2) & 1, q = gi & 3; sc0 = bj * F + pn * 128 + 32 * q; }
        if constexpr (F8) cvt_item8(src + (size_t)inst * sstride, ldw, sc0, (unsigned char*)dst + (size_t)inst * dstride, K, 32 * gi, 64 * kb, MOE_WSCALE, scr, lane);
        else cvt_item(src + (size_t)inst * sstride, ldw, sc0, dst + (size_t)inst * dstride, K, 32 * gi, 64 * kb, scr, lane);
    }
}

__device__ __forceinline__ void prologue_phase(const Args& A, LAS unsigned char* lds, int bid, int G) {
    const int tid = threadIdx.x, lane = tid & 63, wave = tid >> 6;
    unsigned char* ws = A.ws;
    {
        LAS float* sc = (LAS float*)lds;
        LAS float* red = (LAS float*)(lds + 32768);
        for (int i = tid; i < NBATCH * DM; i += NTHR) { const float cv = A.in[I_C][i]; sc[i] = fsilu(cv); }
        __syncthreads();
        float* mods = (float*)(ws + TB_MODS);
        for (int cb = bid; cb < (DEPTH * 6144) / 128; cb += G) {
            const int col = cb * 128 + (tid & 127), l = col / 6144, e = col - l * 6144, ch = tid >> 7;
            const float* wp = A.in[I_ADAW] + (size_t)l * DM * 6144 + e;
            float a[NBATCH];
#pragma unroll
            for (int b = 0; b < NBATCH; ++b) a[b] = 0.f;
#pragma unroll 4
            for (int d = ch * 256; d < ch * 256 + 256; ++d) { const float w = wp[(size_t)d * 6144];
#pragma unroll
                for (int b = 0; b < NBATCH; ++b) a[b] += sc[b * DM + d] * w; }
#pragma unroll
            for (int b = 0; b < NBATCH; ++b) red[(ch * 128 + (tid & 127)) * 8 + b] = a[b];
            __syncthreads();
            if (tid < 128) { const float bias = A.in[I_ADAB][l * 6144 + e];
#pragma unroll
                for (int b = 0; b < NBATCH; ++b) { const float s = ((red[(0 * 128 + tid) * 8 + b] + red[(1 * 128 + tid) * 8 + b]) + (red[(2 * 128 + tid) * 8 + b] + red[(3 * 128 + tid) * 8 + b])) + bias;
                    mods[((size_t)l * NBATCH + b) * 6144 + e] = s; } }
            __syncthreads();
        }
    }
    {
        float* cosT = (float*)(ws + TB_COS); float* sinT = (float*)(ws + TB_SIN);
        for (int i = bid * NTHR + tid; i < SEQ * 32; i += G * NTHR) {
            const int pos = i >> 5, d = i & 31;
            const float inv = (float)exp(-(double)d * (1.0 / 32.0) * 9.210340371976184);
            const float ang = (float)pos * inv;
            const double rev = (double)ang * 0.15915494309189535; const float fr = (float)(rev - floor(rev));
            cosT[i] = __builtin_amdgcn_cosf(fr); sinT[i] = __builtin_amdgcn_sinf(fr);
        }
        if (bid == 0 && tid < 2) {
            const int a = tid; const float* lm = A.in[I_ATLAM] + a * 256;
            float s1 = 0.f, s2 = 0.f; for (int i = 0; i < 64; ++i) { s1 += lm[i] * lm[64 + i]; s2 += lm[128 + i] * lm[192 + i]; }
            const float linit = 0.8f - 0.6f * expf(-0.3f * (float)(3 * a));
            float mq = 0.f, mk = 0.f; for (int i = 0; i < 64; ++i) { mq = fmaxf(mq, fabsf(A.in[I_ATQN][a * 64 + i])); mk = fmaxf(mk, fabsf(A.in[I_ATKN][a * 64 + i])); }
            float* scal = (float*)(ws + TB_SCAL);
            scal[SC_LAM0 + a] = expf(s1) - expf(s2) + linit; scal[SC_OML0 + a] = 1.0f - linit; scal[SC_MC0 + a] = 8.0f * mq * mk * LOG2E * 1.0001f;
        }
        if (bid == 1) {
            float* lb = (float*)(ws + TB_LB);
            for (int i = tid; i < 2 * 1024; i += NTHR) { const int d = i >> 10, k = i & 1023; const float* p = A.in[I_HGLB] + (size_t)d * DEPTH * 1024 + k;
                float mx = p[0]; for (int l = 1; l < DEPTH; ++l) mx = fmaxf(mx, p[l * 1024]);
                float den = 0.f, num = 0.f; for (int l = 0; l < DEPTH; ++l) { const float e = expf(p[l * 1024] - mx); den += e; if (l == 1) num += e; }
                lb[i] = num / den; }
        }
        if (bid == 2) {
            float* sp = (float*)(ws + TB_SP);
            for (int i = tid; i < 2 * LRUW; i += NTHR) { const float x = -A.in[I_LRLAM][i]; sp[i] = (x > 20.f) ? x : log1pf(expf(x)); }
        }
    }
    {
        LAS float* scr = (LAS float*)(lds + wave * 16384);
        const int vcu = (bid % 8) * (G / 8) + bid / 8;
        const int gw = vcu * NWAVES + wave, NGW = G * NWAVES;
        cvt_family(A.in[I_ATWIN], (size_t)1024 * 3072, 2, 3072, 1024, 96, MAP_QKV, 0, (bf16_t*)(ws + W_QKV), (size_t)3072 * 1024, scr, gw, NGW, lane);
        cvt_family(A.in[I_ATWOUT], (size_t)1024 * 1024, 2, 1024, 1024, 32, MAP_ID, 0, (bf16_t*)(ws + W_AO), (size_t)1024 * 1024, scr, gw, NGW, lane);
        cvt_family(A.in[I_HGWIN], 0, 1, 5120, 1024, 160, MAP_ID, 0, (bf16_t*)(ws + W_HGI), 0, scr, gw, NGW, lane);
        cvt_family(A.in[I_HGWOUT], 0, 1, 1024, 1024, 32, MAP_ID, 0, (bf16_t*)(ws + W_HGO), 0, scr, gw, NGW, lane);
        cvt_family(A.in[I_LRWIN], 0, 1, 2560, 1024, 80, MAP_ID, 0, (bf16_t*)(ws + W_LRI), 0, scr, gw, NGW, lane);
        cvt_family(A.in[I_LRWOUT], 0, 1, 1024, 1280, 32, MAP_ID, 0, (bf16_t*)(ws + W_LRO), 0, scr, gw, NGW, lane);
        for (int it = gw; it < 2 * 20 * 2 * 4; it += NGW) {
            const int part = it / 160, r = it % 160, inst = r >> 3, kb = (r >> 2) & 1, gi = r & 3, d = inst / 10, n = inst % 10;
            const float* src = (part ? A.in[I_LRWX] : A.in[I_LRWA]) + (size_t)inst * 16384;
            cvt_item(src, 128, 32 * gi, (bf16_t*)(ws + W_LRG) + (size_t)(n * 2 + d) * 256 * 128, 128, part * 128 + 32 * gi, 64 * kb, scr, lane);
        }
        static_assert(FP8_DENSE_FROM == 2 || FP8_DENSE_FROM > 3, "dense layer 0 stays bf16; layer 2 optional");
        constexpr int NB16 = (FP8_DENSE_FROM == 2) ? 1 : 2;
        cvt_family(A.in[I_FFGU], (size_t)1024 * 5632, NB16, 5632, 1024, 176, MAP_SWI, DFF, (bf16_t*)(ws + W_FGU), (size_t)5632 * 1024, scr, gw, NGW, lane);
        cvt_family(A.in[I_FFDN], (size_t)2816 * 1024, NB16, 1024, 2816, 32, MAP_ID, 0, (bf16_t*)(ws + W_FDN), (size_t)1024 * 2816, scr, gw, NGW, lane);
        if constexpr (NB16 == 1) {
            cvt_family<true>(A.in[I_FFGU] + (size_t)1024 * 5632, 0, 1, 5632, 1024, 176, MAP_SWI, DFF, (bf16_t*)(ws + W_FGU) + (size_t)5632 * 1024, 0, scr, gw, NGW, lane);
            cvt_family<true>(A.in[I_FFDN] + (size_t)2816 * 1024, 0, 1, 1024, 2816, 32, MAP_ID, 0, (bf16_t*)(ws + W_FDN) + (size_t)1024 * 2816, 0, scr, gw, NGW, lane);
        }
        cvt_family<true>(A.in[I_MOEGU], (size_t)1024 * 7168, 16, 7168, 1024, 224, MAP_SWI, DFFE, (bf16_t*)(ws + W_MGU), (size_t)7168 * 1024, scr, gw, NGW, lane);
        cvt_family<true>(A.in[I_MOEDN], (size_t)3584 * 1024, 16, 1024, 3584, 32, MAP_ID, 0, (bf16_t*)(ws + W_MDN), (size_t)1024 * 3584, scr, gw, NGW, lane);
    }
}

template <bool ROUTER>
__device__ __forceinline__ void norm_phase(const Args& A, LAS unsigned char* lds, int bid, int G, const float* xsrc, float* xdst, const float* gain, const float* modl  , int which,
                                           bool combine, const float* modprev  , bool nonorm, const float* router, bool f8out = false) {
    int tid_ = threadIdx.x; asm volatile("" : "+v"(tid_));
    const int tid = tid_, lane = tid & 63, wave = tid >> 6;
    unsigned char* ws = A.ws;
    bf16_t* HM = (bf16_t*)(ws + WS_HM);
    const int* slot = (const int*)(ws + TB_SLOT); const float* gts = (const float*)(ws + TB_GATE);
    const bf16_t* Y = (const bf16_t*)(ws + E_XS);
    LAS int* hist = (LAS int*)lds;
    for (int tb = bid; tb < MTOK / 256; tb += G) {
        const int b = tb >> 5;
        f32x4 ga[4], sh[4], g2[4];
#pragma unroll
        for (int j = 0; j < 4; ++j) { const int c = 256 * j + 4 * lane;
            if (!nonorm) { const f32x4 gv = *(const f32x4*)(gain + c), sv = *(const f32x4*)(modl + (size_t)b * 6144 + (which * 3 + 1) * 1024 + c);
                ga[j] = gv * (sv + 1.0f); sh[j] = *(const f32x4*)(modl + (size_t)b * 6144 + (which * 3) * 1024 + c); }
            if (combine) g2[j] = *(const f32x4*)(modprev + (size_t)b * 6144 + 5 * 1024 + c); }
        f32x4 rw[ROUTER ? 32 : 1];
        if constexpr (ROUTER) {
            if (tid < 8) hist[tid] = 0;
#pragma unroll
            for (int j = 0; j < 4; ++j)
#pragma unroll
                for (int i = 0; i < 4; ++i) { const int c = 256 * j + 4 * lane + i; rw[(j * 4 + i) * 2] = *(const f32x4*)(router + c * 8); rw[(j * 4 + i) * 2 + 1] = *(const f32x4*)(router + c * 8 + 4); }
            __syncthreads();
        }
        for (int i = 0; i < 32; ++i) {
            const int row = tb * 256 + wave * 32 + i;
            const float* xr = xsrc + (size_t)row * DM;
            f32x4 v[4];
#pragma unroll
            for (int j = 0; j < 4; ++j) v[j] = *(const f32x4*)(xr + 256 * j + 4 * lane);
            if (combine) {
                const int s0 = slot[row * 2], s1 = slot[row * 2 + 1]; const float w0 = gts[row * 2], w1 = gts[row * 2 + 1];
#pragma unroll
                for (int j = 0; j < 4; ++j) { const u32x2 a = *(const u32x2*)(Y + (size_t)s0 * DM + 256 * j + 4 * lane), c2 = *(const u32x2*)(Y + (size_t)s1 * DM + 256 * j + 4 * lane);
                    f32x4 y; y[0] = w0 * bflo(a.x) + w1 * bflo(c2.x); y[1] = w0 * bfhi(a.x) + w1 * bfhi(c2.x); y[2] = w0 * bflo(a.y) + w1 * bflo(c2.y); y[3] = w0 * bfhi(a.y) + w1 * bfhi(c2.y);
                    v[j] = v[j] + g2[j] * y; *(f32x4*)(xdst + (size_t)row * DM + 256 * j + 4 * lane) = v[j]; }
            }
            if (nonorm) continue;
            float ss = 0.f;
#pragma unroll
            for (int j = 0; j < 4; ++j) ss += (v[j][0] * v[j][0] + v[j][1] * v[j][1]) + (v[j][2] * v[j][2] + v[j][3] * v[j][3]);
            ss = wave_sum(ss);
            const float rstd = 1.0f / sqrtf(ss * (1.0f / DM) + EPS);
            f32x4 h[4];
#pragma unroll
            for (int j = 0; j < 4; ++j) { h[j] = v[j] * rstd * ga[j] + sh[j];
                if (f8out) { *(unsigned*)((unsigned char*)HM + (size_t)row * DM + 256 * j + 4 * lane) = pk_fp8x4(h[j][0], h[j][1], h[j][2], h[j][3]); }
                else { u32x2 w; w.x = cvt_pk_bf16(h[j][0], h[j][1]); w.y = cvt_pk_bf16(h[j][2], h[j][3]);
                    *(u32x2*)(HM + (size_t)row * DM + 256 * j + 4 * lane) = w; } }
            if constexpr (ROUTER) {
                float lg[8];
#pragma unroll
                for (int e = 0; e < 8; ++e) lg[e] = 0.f;
#pragma unroll
                for (int j = 0; j < 4; ++j)
#pragma unroll
                    for (int q = 0; q < 4; ++q) { const float hv = h[j][q]; const f32x4 r0 = rw[(j * 4 + q) * 2], r1 = rw[(j * 4 + q) * 2 + 1];
                        lg[0] += hv * r0[0]; lg[1] += hv * r0[1]; lg[2] += hv * r0[2]; lg[3] += hv * r0[3]; lg[4] += hv * r1[0]; lg[5] += hv * r1[1]; lg[6] += hv * r1[2]; lg[7] += hv * r1[3]; }
#pragma unroll
                for (int e = 0; e < 8; ++e) lg[e] = wave_sum(lg[e]);
                int e0 = 0; float v0 = lg[0];
#pragma unroll
                for (int e = 1; e < 8; ++e) if (lg[e] > v0) { v0 = lg[e]; e0 = e; }
                int e1 = -1; float v1 = -3.0e38f;
#pragma unroll
                for (int e = 0; e < 8; ++e) if (e != e0 && lg[e] > v1) { v1 = lg[e]; e1 = e; }
                const float p1 = frcp(1.0f + fexp(v1 - v0));
                if (lane == 0) { int* eid = (int*)(ws + TB_EID); float* gt = (float*)(ws + TB_GATE);
                    eid[row * 2] = e0; eid[row * 2 + 1] = e1; gt[row * 2] = p1; gt[row * 2 + 1] = 1.0f - p1;
                    atomicAdd((int*)&hist[e0], 1); atomicAdd((int*)&hist[e1], 1); }
            }
        }
        if constexpr (ROUTER) {
            __syncthreads();
            if (tid < 8) ((int*)(ws + TB_BCNT))[tb * 8 + tid] = hist[tid];
            __syncthreads();
        }
    }
}

namespace lru {
constexpr int XCF = 0, XCB = 16384, AA = 24576, UU = 40960;
__device__ __forceinline__ int sw256(int row, int cb) { return row * 256 + (cb ^ ((row & 7) << 4)); }
__device__ __forceinline__ int crow(int r, int hi) { return (r & 3) + 8 * (r >> 2) + 4 * hi; }
template <int MODE>
__device__ __forceinline__ void lru_item(const Args& A, LAS unsigned char* lds, int b, int n, int seg, int dir) {
    int tid_ = threadIdx.x; asm volatile("" : "+v"(tid_));
    const int tid = tid_, wid = tid >> 6, lane = tid & 63, r = lane & 31, hh = lane >> 5;
    unsigned char* ws = A.ws;
    const bf16_t* XB = (const bf16_t*)(ws + L_XB); const bf16_t* YB = (const bf16_t*)(ws + L_YB); bf16_t* HF = (bf16_t*)(ws + L_HF); bf16_t* HY = (bf16_t*)(ws + L_HY);
    const bf16_t* Wg = (const bf16_t*)(ws + W_LRG) + (size_t)((n * 2 + dir) * 256 + ((r < 16) ? (16 * wid + r) : (128 + 16 * wid + r - 16))) * 128 + 8 * hh;
    bf16x8 bfrag[8];
#pragma unroll
    for (int ks = 0; ks < 8; ++ks) bfrag[ks] = *(const bf16x8*)(Wg + 16 * ks);
    const int cch = n * 128 + 16 * wid + (r & 15);
    const float ba = A.in[I_LRBA][dir * LRUW + cch], bx = A.in[I_LRBX][dir * LRUW + cch], sp = ((const float*)(ws + TB_SP))[dir * LRUW + cch];
    const int ct = tid >> 4, cg = tid & 15, cc0 = n * 128 + 8 * cg;
    float cw[4][8], cb[8];
#pragma unroll
    for (int j = 0; j < 8; ++j) { cb[j] = A.in[I_LRCB][cc0 + j];
#pragma unroll
        for (int w = 0; w < 4; ++w) cw[w][j] = A.in[I_LRCW][w * LRUW + cc0 + j]; }
    float carry = 0.f, P = 1.f;
    if (MODE != 0 && tid < 128) carry = ((const float*)(ws + TB_LCIN))[(size_t)((b * 32 + seg) * 2 + dir) * LRUW + n * 128 + tid];
    u32x4 xr[4];
#define LRU_XLOAD(si_) do { const int sub_ = dir ? (7 - (si_)) : (si_); const int tok_ = seg * 256 + sub_ * 32 + ct; \
        _Pragma("unroll") for (int w = 0; w < 4; ++w) { const int tt = tok_ - 1 + w; xr[w] = (tt >= 0 && tt < SEQ) ? *(const u32x4*)(XB + ((size_t)b * SEQ + tt) * LRUW + cc0) : (u32x4){0u, 0u, 0u, 0u}; } } while (0)
    LRU_XLOAD(0);
    for (int si = 0; si < 8; ++si) {
        const int sub = dir ? (7 - si) : si; const int t0 = seg * 256 + sub * 32;
        {
            float xc[8];
#pragma unroll
            for (int j = 0; j < 8; ++j) xc[j] = cb[j];
#pragma unroll
            for (int w = 0; w < 4; ++w) { const u32x4 v = xr[w];
#pragma unroll
                for (int e = 0; e < 4; ++e) { xc[2 * e] += cw[w][2 * e] * bflo(v[e]); xc[2 * e + 1] += cw[w][2 * e + 1] * bfhi(v[e]); } }
            if (si + 1 < 8) LRU_XLOAD(si + 1);
            *(LAS f32x4*)(lds + XCF + (ct * 128 + 8 * cg) * 4) = (f32x4){xc[0], xc[1], xc[2], xc[3]};
            *(LAS f32x4*)(lds + XCF + (ct * 128 + 8 * cg + 4) * 4) = (f32x4){xc[4], xc[5], xc[6], xc[7]};
            *(LAS u32x4*)(lds + XCB + sw256(ct, 16 * cg)) = (u32x4){cvt_pk_bf16(xc[0], xc[1]), cvt_pk_bf16(xc[2], xc[3]), cvt_pk_bf16(xc[4], xc[5]), cvt_pk_bf16(xc[6], xc[7])};
        }
        __syncthreads();
        {
            f32x16 acc = {};
#pragma unroll
            for (int ks = 0; ks < 8; ++ks) { const bf16x8 fa = *(const LAS bf16x8*)(lds + XCB + sw256(r, (16 * ks + 8 * hh) * 2)); acc = __builtin_amdgcn_mfma_f32_32x32x16_bf16(fa, bfrag[ks], acc, 0, 0, 0); }
#pragma unroll
            for (int q = 0; q < 8; ++q) {
                const float send = (r < 16) ? acc[8 + q] : acc[q]; const float recv = __shfl_xor(send, 16);
                const float rp = (r < 16) ? acc[q] : recv, ip = (r < 16) ? recv : acc[8 + q];
                const int tq = crow((r < 16) ? q : (8 + q), hh); const int cl = 16 * wid + (r & 15);
                const float xcv = ((const LAS float*)(lds + XCF))[tq * 128 + cl];
                const float rg = fsigmoid(rp + ba), ig = fsigmoid(ip + bx); const float la = -8.0f * rg * sp;
                const float av = fexp(la), uv = sqrtf(fmaxf(1.0f - av * av, 0.f)) * ig * xcv;
                ((LAS float*)(lds + AA))[tq * 128 + cl] = av; ((LAS float*)(lds + UU))[tq * 128 + cl] = uv; }
        }
        __syncthreads();
        if (tid < 128) {
            LAS float* ap = (LAS float*)(lds + AA) + tid; LAS float* up = (LAS float*)(lds + UU) + tid; float av[32], uv[32];
#pragma unroll
            for (int i = 0; i < 32; ++i) { av[i] = ap[i * 128]; uv[i] = up[i * 128]; }
            if (dir == 0) {
#pragma unroll
                for (int i = 0; i < 32; ++i) { carry = av[i] * carry + uv[i]; if (MODE == 0) P *= av[i]; else uv[i] = carry; } }
            else {
#pragma unroll
                for (int i = 31; i >= 0; --i) { carry = av[i] * carry + uv[i]; if (MODE == 0) P *= av[i]; else uv[i] = carry; } }
            if (MODE != 0) {
#pragma unroll
                for (int i = 0; i < 32; ++i) up[i * 128] = uv[i]; }
        }
        if (MODE != 0) {
            __syncthreads();
            const int tok = t0 + ct; const size_t go = ((size_t)b * SEQ + tok) * LRUW + cc0;
            const f32x4 h0 = *(const LAS f32x4*)(lds + UU + (ct * 128 + 8 * cg) * 4), h1 = *(const LAS f32x4*)(lds + UU + (ct * 128 + 8 * cg + 4) * 4);
            if (MODE == 1) { *(u32x4*)(HF + go) = (u32x4){cvt_pk_bf16(h0[0], h0[1]), cvt_pk_bf16(h0[2], h0[3]), cvt_pk_bf16(h1[0], h1[1]), cvt_pk_bf16(h1[2], h1[3])}; }
            else { const u32x4 f = *(const u32x4*)(HF + go), y = *(const u32x4*)(YB + go);
                *(u32x4*)(HY + go) = (u32x4){cvt_pk_bf16((h0[0] + bflo(f[0])) * bflo(y[0]), (h0[1] + bfhi(f[0])) * bfhi(y[0])), cvt_pk_bf16((h0[2] + bflo(f[1])) * bflo(y[1]), (h0[3] + bfhi(f[1])) * bfhi(y[1])),
                                            cvt_pk_bf16((h1[0] + bflo(f[2])) * bflo(y[2]), (h1[1] + bfhi(f[2])) * bfhi(y[2])), cvt_pk_bf16((h1[2] + bflo(f[3])) * bflo(y[3]), (h1[3] + bfhi(f[3])) * bfhi(y[3]))}; }
        }
        __syncthreads();
    }
#undef LRU_XLOAD
    if (MODE == 0 && tid < 128) { float* sm = (float*)(ws + TB_LSUM) + (size_t)(((b * 32 + seg) * 2 + dir) * 2) * LRUW + n * 128 + tid; sm[0] = P; sm[LRUW] = carry; }
}
}
template <int MODE>
__device__ __forceinline__ void lru_phase(const Args& A, LAS unsigned char* lds, int bid, int G) {
    const int nitems = (MODE == 0) ? 5120 : 2560;
    for (int it = bid; it < nitems; it += G) {
        int b, n, seg, dir;
        if (MODE == 0) { dir = it & 1; const int r = it >> 1; seg = r & 31; n = (r >> 5) % 10; b = r / 320; }
        else { dir = MODE - 1; seg = it & 31; n = (it >> 5) % 10; b = it / 320; }
        lru::lru_item<MODE>(A, lds, b, n, seg, dir);
    }
}
__device__ __forceinline__ void lru_carry_phase(const Args& A, int bid, int G) {
    const float* sm = (const float*)(A.ws + TB_LSUM); float* cin = (float*)(A.ws + TB_LCIN);
    for (int idx = bid * NTHR + threadIdx.x; idx < NBATCH * 2 * LRUW; idx += G * NTHR) {
        const int b = idx / (2 * LRUW), r = idx % (2 * LRUW), dir = r / LRUW, ch = r % LRUW; float carry = 0.f;
        for (int i = 0; i < 32; ++i) { const int sg = dir ? (31 - i) : i; const size_t o = (size_t)((b * 32 + sg) * 2 + dir);
            cin[o * LRUW + ch] = carry; carry = sm[o * 2 * LRUW + ch] * carry + sm[o * 2 * LRUW + LRUW + ch]; }
    }
}

__device__ __forceinline__ void place_phase(const Args& A, LAS unsigned char* lds, int bid, int G) {
    int tid_ = threadIdx.x; asm volatile("" : "+v"(tid_));
    const int tid = tid_, lane = tid & 63, wave = tid >> 6; unsigned char* ws = A.ws;
    const int* bcnt = (const int*)(ws + TB_BCNT); const int* eid = (const int*)(ws + TB_EID); int* slot = (int*)(ws + TB_SLOT);
    const bf16_t* HM = (const bf16_t*)(ws + WS_HM); bf16_t* XS = (bf16_t*)(ws + E_XS);
    LAS int* tot = (LAS int*)lds; LAS int* pre = tot + 8; LAS int* rb = tot + 16; LAS int* wcn = tot + 32; LAS int* sl = tot + 64;
    for (int tb = bid; tb < MTOK / 256; tb += G) {
        { int t_ = 0, p_ = 0;
#pragma unroll
            for (int j = 0; j < 4; ++j) { const int blk = lane + 64 * j; const int v = bcnt[blk * 8 + wave]; t_ += v; p_ += (blk < tb) ? v : 0; }
#pragma unroll
            for (int o = 1; o < 64; o <<= 1) { t_ += __shfl_xor(t_, o); p_ += __shfl_xor(p_, o); }
            if (lane == 0) { tot[wave] = t_; pre[wave] = p_; } }
        __syncthreads();
        if (tid == 0) { int acc = 0; for (int e = 0; e < 8; ++e) { rb[e] = acc * 256; if (tb == 0) ((int*)(ws + TB_TILES))[e] = acc; acc += (tot[e] + 255) >> 8; } if (tb == 0) ((int*)(ws + TB_TILES))[8] = acc; }
        int e0 = -1, e1 = -1; unsigned long long mk0 = 0, mk1 = 0;
        if (tid < 256) { e0 = eid[(tb * 256 + tid) * 2]; e1 = eid[(tb * 256 + tid) * 2 + 1];
#pragma unroll
            for (int e = 0; e < 8; ++e) { const unsigned long long m = __ballot(e0 == e || e1 == e); if (lane == 0) wcn[wave * 8 + e] = __popcll(m); if (e0 == e) mk0 = m; if (e1 == e) mk1 = m; } }
        __syncthreads();
        if (tid < 256) { const unsigned long long lt = (1ull << lane) - 1ull; int b0 = rb[e0] + pre[e0] + __popcll(mk0 & lt), b1 = rb[e1] + pre[e1] + __popcll(mk1 & lt);
            for (int w = 0; w < wave; ++w) { b0 += wcn[w * 8 + e0]; b1 += wcn[w * 8 + e1]; }
            sl[tid * 2] = b0; sl[tid * 2 + 1] = b1; slot[(tb * 256 + tid) * 2] = b0; slot[(tb * 256 + tid) * 2 + 1] = b1; }
        __syncthreads();
        for (int i = 0; i < 32; ++i) { const int t = wave * 32 + i; const int s0 = sl[t * 2], s1 = sl[t * 2 + 1];
            const bf16_t* src = HM + (size_t)(tb * 256 + t) * DM + lane * 16;
            const u32x4 a = *(const u32x4*)src, b = *(const u32x4*)(src + 8);
            const u32x4 q = {pk_fp8x4(bflo(a[0]), bfhi(a[0]), bflo(a[1]), bfhi(a[1])), pk_fp8x4(bflo(a[2]), bfhi(a[2]), bflo(a[3]), bfhi(a[3])),
                             pk_fp8x4(bflo(b[0]), bfhi(b[0]), bflo(b[1]), bfhi(b[1])), pk_fp8x4(bflo(b[2]), bfhi(b[2]), bflo(b[3]), bfhi(b[3]))};
            *(u32x4*)((unsigned char*)XS + (size_t)s0 * DM + lane * 16) = q; *(u32x4*)((unsigned char*)XS + (size_t)s1 * DM + lane * 16) = q; }
        __syncthreads();
    }
}

namespace att {
constexpr int KVBLK = 64;
constexpr int SHM_V = KVBLK * 128 * 2, SHM_K = KVBLK * 128 * 2;
#define KSWZ(row, colB) ((row) * 256 + ((colB) ^ (((row) & 7) << 4)))
#define SBAR() __builtin_amdgcn_sched_barrier(0)
__device__ __forceinline__ int crow(int r, int hi) { return (r & 3) + 8 * (r >> 2) + 4 * hi; }
__device__ __forceinline__ int v_st(int k, int c) { const int kk = (k & ~0xC) | ((k & 4) << 1) | ((k & 8) >> 1); return ((kk >> 3) * 4 + (c >> 5)) * 512 + ((kk & 7) * 32 + (c & 31)) * 2; }
__device__ __forceinline__ int v_rd_base(int lane) { return ((lane & 3) << 3) | (((lane >> 2) & 3) << 6) | (((lane >> 4) & 1) << 5) | (((lane >> 5) & 1) << 8); }
constexpr int v_rd_off(int d0, int ks, int half) { return d0 * 512 + ks * 4096 + half * 2048; }
template <int OFF> __device__ __forceinline__ s16x4 tr_read(int vb) {
    s16x4 r; asm volatile("ds_read_b64_tr_b16 %0, %1 offset:%2" : "=&v"(r) : "v"(vb), "i"(OFF) : "memory"); return r;
}
template <int D0> __device__ __forceinline__ void pv_one(f32x16& od, int vb, bf16x8 pa0, bf16x8 pa1, bf16x8 pa2, bf16x8 pa3) {
    const s16x4 l0 = tr_read<v_rd_off(D0, 0, 0)>(vb), h0 = tr_read<v_rd_off(D0, 0, 1)>(vb), l1 = tr_read<v_rd_off(D0, 1, 0)>(vb), h1 = tr_read<v_rd_off(D0, 1, 1)>(vb);
    const s16x4 l2 = tr_read<v_rd_off(D0, 2, 0)>(vb), h2 = tr_read<v_rd_off(D0, 2, 1)>(vb), l3 = tr_read<v_rd_off(D0, 3, 0)>(vb), h3 = tr_read<v_rd_off(D0, 3, 1)>(vb);
    asm volatile("s_waitcnt lgkmcnt(0)" ::: "memory"); SBAR();
#define PK(L, H) (bf16x8){L[0], L[1], L[2], L[3], H[0], H[1], H[2], H[3]}
    od = __builtin_amdgcn_mfma_f32_32x32x16_bf16(pa0, PK(l0, h0), od, 0, 0, 0);
    od = __builtin_amdgcn_mfma_f32_32x32x16_bf16(pa1, PK(l1, h1), od, 0, 0, 0);
    od = __builtin_amdgcn_mfma_f32_32x32x16_bf16(pa2, PK(l2, h2), od, 0, 0, 0);
    od = __builtin_amdgcn_mfma_f32_32x32x16_bf16(pa3, PK(l3, h3), od, 0, 0, 0);
#undef PK
}
__device__ __forceinline__ void pv_d0(f32x16* o, int vb, bf16x8 pa0, bf16x8 pa1, bf16x8 pa2, bf16x8 pa3) {
    pv_one<0>(o[0], vb, pa0, pa1, pa2, pa3); pv_one<1>(o[1], vb, pa0, pa1, pa2, pa3); pv_one<2>(o[2], vb, pa0, pa1, pa2, pa3); pv_one<3>(o[3], vb, pa0, pa1, pa2, pa3);
}
__device__ __forceinline__ void partialSM(f32x16& p0, f32x16& p1, float Mc) {
#pragma unroll
    for (int r = 0; r < 16; ++r) p0[r] = fexp2(p0[r]);
}
__device__ __forceinline__ void finishSM(f32x16& p0, f32x16& p1, float& l_reg, bf16x8& pa0, bf16x8& pa1, bf16x8& pa2, bf16x8& pa3) {
#pragma unroll
    for (int r = 0; r < 16; ++r) p1[r] = fexp2(p1[r]);
    float ps = 0;
#pragma unroll
    for (int r = 0; r < 16; ++r) ps += p0[r];
#pragma unroll
    for (int r = 0; r < 16; ++r) ps += p1[r];
    { auto rr = __builtin_amdgcn_permlane32_swap(__float_as_uint(ps), __float_as_uint(ps), false, false);
      ps = __uint_as_float(rr[0]) + __uint_as_float(rr[1]); }
    l_reg += ps;
#define PK4(P, BASE, OUT) do { unsigned a0 = cvt_pk_bf16(P[BASE + 0], P[BASE + 1]), a1 = cvt_pk_bf16(P[BASE + 2], P[BASE + 3]);   \
    unsigned b0 = cvt_pk_bf16(P[BASE + 4], P[BASE + 5]), b1 = cvt_pk_bf16(P[BASE + 6], P[BASE + 7]);                              \
    auto r0 = __builtin_amdgcn_permlane32_swap(a0, b0, false, false); auto r1 = __builtin_amdgcn_permlane32_swap(a1, b1, false, false); \
    u32x4 w = {r0[0], r1[0], r0[1], r1[1]}; OUT = *reinterpret_cast<bf16x8*>(&w); } while (0)
    PK4(p0, 0, pa0); PK4(p0, 8, pa1); PK4(p1, 0, pa2); PK4(p1, 8, pa3);
#undef PK4
}
__device__ __forceinline__ void qkt(f32x16& p0, f32x16& p1, const LAS char* Ks, const bf16x8* qr, int r32, int hi, int jj, float nMc) {
#pragma unroll
    for (int r = 0; r < 16; ++r) { p0[r] = nMc; p1[r] = nMc; }
#pragma unroll
    for (int d0 = 0; d0 < 4; ++d0) { const int cb = ((jj * 4 + d0) * 16 + hi * 8) * 2;
        const bf16x8 b0 = *(const LAS bf16x8*)(Ks + KSWZ(r32, cb));
        const bf16x8 b1 = *(const LAS bf16x8*)(Ks + KSWZ(32 + r32, cb));
        p0 = __builtin_amdgcn_mfma_f32_32x32x16_bf16(b0, qr[d0], p0, 0, 0, 0);
        p1 = __builtin_amdgcn_mfma_f32_32x32x16_bf16(b1, qr[d0], p1, 0, 0, 0); }
}
constexpr int SLOTB = 16384;
__device__ __forceinline__ int k_slot(int s) { return (s & 1) * SLOTB + (s >> 1) * 65536; }
__device__ __forceinline__ int v_slot(int s) { return 32768 + (s & 1) * SLOTB + (s >> 1) * 65536; }
}

__device__ __forceinline__ void attn_phase(const Args& A, LAS unsigned char* ldsu, int bid, int G, int al) {
    using namespace att;
    LAS char* lds = (LAS char*)ldsu;
    unsigned char* ws = A.ws;
    const bf16_t* Qg = (const bf16_t*)(ws + A_Q); const bf16_t* Kg = (const bf16_t*)(ws + A_K); const bf16_t* Vg = (const bf16_t*)(ws + A_V);
    bf16_t* Og = (bf16_t*)(ws + WS_HM);
    const float* scal = (const float*)(ws + TB_SCAL);
    const float lamv = scal[SC_LAM0 + al], omli = scal[SC_OML0 + al], Mc = scal[SC_MC0 + al];
    const float* subg = A.in[I_ATSUB] + al * 128;
    int tid_ = threadIdx.x; asm volatile("" : "+v"(tid_));
    const int tid = tid_, wid = __builtin_amdgcn_readfirstlane(tid >> 6), lane = tid & 63, r32 = lane & 31, hi = lane >> 5, jj = wid >> 2, wq = wid & 3;
    constexpr int NT = SEQ / KVBLK;
    unsigned koff[2], voff[2];
#pragma unroll
    for (int i = 0; i < 2; ++i) { const int bb = wid * 2048 + i * 1024 + lane * 16;
        { const int row = bb >> 8, colB = (bb & 255) ^ ((row & 7) << 4); koff[i] = (unsigned)(row * 2048 + colB); }
        { const int sub = bb >> 9, rem = bb & 511, kk = (sub >> 2) * 8 + (rem >> 6), c = (sub & 3) * 32 + ((rem >> 1) & 31); const int k = (kk & ~0xC) | ((kk & 4) << 1) | ((kk & 8) >> 1); voff[i] = (unsigned)(k * 2048 + c * 2); } }
    const unsigned ldsw = (unsigned)wid * 2048u;
#define ATT_DMA(slot, kt, vt) do { _Pragma("unroll") for (int _i = 0; _i < 2; ++_i) { \
        __builtin_amdgcn_global_load_lds((const unsigned*)((const char*)(kt) + koff[_i]), (LAS unsigned*)(lds + k_slot(slot) + ldsw + _i * 1024), 16, 0, 0); \
        __builtin_amdgcn_global_load_lds((const unsigned*)((const char*)(vt) + voff[_i]), (LAS unsigned*)(lds + v_slot(slot) + ldsw + _i * 1024), 16, 0, 0); } } while (0)
#define ATT_TOP() do { asm volatile("s_waitcnt vmcnt(0)" ::: "memory"); __builtin_amdgcn_s_barrier(); asm volatile("" ::: "memory"); } while (0)
    const int xq = bid & 7, cq = bid >> 3;
    LAS float* li_l = (LAS float*)(lds + 131072) + wid * 64;
    const int vbl = (int)(uintptr_t)lds + v_rd_base(lane);
    size_t cbase; { const int bh = xq * 8, b = bh >> 3, h = bh & 7; cbase = (size_t)b * SEQ * DM + h * 128; }
    const bool lag = (jj != 0);
    ATT_DMA(0, Kg + cbase, Vg + cbase);
    { asm volatile("s_waitcnt vmcnt(0)" ::: "memory"); __builtin_amdgcn_s_barrier(); asm volatile("" ::: "memory"); ATT_DMA(1, Kg + cbase + (size_t)64 * DM, Vg + cbase + (size_t)64 * DM); }
    for (int ui = 0; ui < 16; ++ui) {
        const int qb = (ui & 1) * 32 + cq;
        size_t nbase = cbase; if (ui + 1 < 16) { const int bh = xq * 8 + ((ui + 1) >> 1), b = bh >> 3, h = bh & 7; nbase = (size_t)b * SEQ * DM + h * 128; }
        const bf16_t* Kh = Kg + cbase; const bf16_t* Vh = Vg + cbase; const bf16_t* nK = Kg + nbase; const bf16_t* nV = Vg + nbase;
        float l_reg = 0; f32x16 o[4] = {}; bf16x8 qr[4];
        { const bf16_t* Qw = Qg + cbase + (size_t)(qb * 128 + wq * 32 + r32) * DM + jj * 64 + hi * 8;
#pragma unroll
          for (int d0 = 0; d0 < 4; ++d0) qr[d0] = *(const bf16x8*)(Qw + d0 * 16); }
        f32x16 pA0, pA1, pB0, pB1; bf16x8 pa0, pa1, pa2, pa3;
#define ATT_SRC(jt, KP, VP) const bf16_t* KP = ((jt) + 2 < NT) ? Kh + (size_t)((jt) + 2) * 64 * DM : nK + (size_t)((jt) + 2 - NT) * 64 * DM; \
                            const bf16_t* VP = ((jt) + 2 < NT) ? Vh + (size_t)((jt) + 2) * 64 * DM : nV + (size_t)((jt) + 2 - NT) * 64 * DM
#define ATT_BAR(jt) do { ATT_TOP(); ATT_SRC(jt, kp_, vp_); ATT_DMA(((jt) + 2) & 3, kp_, vp_); } while (0)
        { qkt(pA0, pA1, lds + k_slot(0), qr, r32, hi, jj, -Mc);
          if (lag) ATT_BAR(0);
          partialSM(pA0, pA1, Mc);
          if (!lag) ATT_BAR(0); }
        for (int jt = 1; jt + 1 < NT; jt += 2) {
            { SBAR(); qkt(pB0, pB1, lds + k_slot(jt & 3), qr, r32, hi, jj, -Mc);
              finishSM(pA0, pA1, l_reg, pa0, pa1, pa2, pa3); SBAR();
              if (lag) ATT_BAR(jt);
              pv_d0(o, vbl + v_slot((jt - 1) & 3), pa0, pa1, pa2, pa3); partialSM(pB0, pB1, Mc);
              if (!lag) ATT_BAR(jt); }
            { const int j2 = jt + 1;
              SBAR(); qkt(pA0, pA1, lds + k_slot(j2 & 3), qr, r32, hi, jj, -Mc);
              finishSM(pB0, pB1, l_reg, pa0, pa1, pa2, pa3); SBAR();
              if (lag) ATT_BAR(j2);
              pv_d0(o, vbl + v_slot((j2 - 1) & 3), pa0, pa1, pa2, pa3); partialSM(pA0, pA1, Mc);
              if (!lag) ATT_BAR(j2); }
        }
        { constexpr int jt = NT - 1;
          SBAR(); qkt(pB0, pB1, lds + k_slot(jt & 3), qr, r32, hi, jj, -Mc);
          finishSM(pA0, pA1, l_reg, pa0, pa1, pa2, pa3); SBAR();
          if (lag) ATT_BAR(jt);
          pv_d0(o, vbl + v_slot((jt - 1) & 3), pa0, pa1, pa2, pa3); partialSM(pB0, pB1, Mc);
          if (!lag) ATT_BAR(jt);
          finishSM(pB0, pB1, l_reg, pa0, pa1, pa2, pa3); SBAR();
          pv_d0(o, vbl + v_slot(jt & 3), pa0, pa1, pa2, pa3); }
#undef ATT_BAR
        int r32e = r32, hie = hi; asm volatile("" : "+v"(r32e), "+v"(hie));
        if (hie == 0) li_l[r32e] = l_reg; asm volatile("s_waitcnt lgkmcnt(0)" ::: "memory");
        float rli[16];
#pragma unroll
        for (int r = 0; r < 16; ++r) rli[r] = frcp(li_l[crow(r, hie)]);
        asm volatile("s_waitcnt lgkmcnt(0)" ::: "memory"); __builtin_amdgcn_s_barrier(); asm volatile("" ::: "memory");
        LAS float* Cb = (LAS float*)(lds + 65536);
        if (jj == 1) {
#pragma unroll
            for (int r = 0; r < 16; ++r) { const float sc = rli[r] * lamv;
#pragma unroll
                for (int d0 = 0; d0 < 4; ++d0) Cb[(wq * 32 + crow(r, hie)) * 128 + d0 * 32 + r32e] = o[d0][r] * sc; }
        }
        asm volatile("s_waitcnt lgkmcnt(0)" ::: "memory"); __builtin_amdgcn_s_barrier(); asm volatile("" ::: "memory");
        if (jj == 0) {
            float g[4];
#pragma unroll
            for (int d0 = 0; d0 < 4; ++d0) g[d0] = subg[d0 * 32 + r32e] * omli;
            bf16_t* Ob = Og + cbase + (size_t)(qb * 128) * DM;
#pragma unroll
            for (int r = 0; r < 16; ++r) {
                float ss = 0.f;
#pragma unroll
                for (int d0 = 0; d0 < 4; ++d0) { const float v = o[d0][r] * rli[r] - Cb[(wq * 32 + crow(r, hie)) * 128 + d0 * 32 + r32e]; o[d0][r] = v; ss += v * v; }
                ss += __shfl_xor(ss, 1); ss += __shfl_xor(ss, 2); ss += __shfl_xor(ss, 4); ss += __shfl_xor(ss, 8); ss += __shfl_xor(ss, 16);
                const float rs = 1.0f / sqrtf(ss * (1.0f / 128.0f) + EPS);
                bf16_t* op = Ob + (size_t)(wq * 32 + crow(r, hie)) * DM + r32e;
#pragma unroll
                for (int d0 = 0; d0 < 4; ++d0) op[d0 * 32] = (bf16_t)f2bf(o[d0][r] * rs * g[d0]);
            }
        }
        cbase = nbase;
    }
    asm volatile("s_waitcnt vmcnt(0) lgkmcnt(0)" ::: "memory"); __builtin_amdgcn_s_barrier(); asm volatile("" ::: "memory");
#undef ATT_DMA
#undef ATT_TOP
#undef ATT_SRC
}

namespace gla {
constexpr int BC = 0, QI = 32768, QA = 49152, KA = 65536, KST = 81920, VT = 98304, ST = 106496, AT = 122880, EM = 131072, EL = EM + 512, DD = EM + 1024, BMID = EM + 1536, SEG = EM + 2048;
static_assert(SEG + 2048 <= RING_BYTES, "gla lds");
__device__ __forceinline__ int sw256(int row, int cb) { return row * 256 + (cb ^ ((row & 15) << 4)); }
__device__ __forceinline__ int sw128(int row, int cb) { return row * 128 + (cb ^ ((((row & 7) ^ (row >> 4)) & 7) << 4)); }
__device__ __forceinline__ int crow(int r, int hi) { return (r & 3) + 8 * (r >> 2) + 4 * hi; }
__device__ __forceinline__ float h2f(unsigned short b) { return (float)__builtin_bit_cast(_Float16, b); }
__device__ __forceinline__ void gla_item(const bf16_t* __restrict__ Qp, const unsigned short* __restrict__ LFp, const bf16_t* __restrict__ Vp, bf16_t* __restrict__ Op, int dir, LAS unsigned char* lds, float* dbg) {
    int tid_ = threadIdx.x; asm volatile("" : "+v"(tid_));
    const int tid = tid_, wid = tid >> 6, lane = tid & 63, r = lane & 31, hh = lane >> 5;
    const int t1 = tid >> 3, kg = tid & 7, k0 = 16 * kg, v0 = (tid & 7) * 8;
    for (int i = tid; i < 16384 / 16; i += NTHR) *(LAS u32x4*)(lds + ST + i * 16) = (u32x4){0u, 0u, 0u, 0u};
    f32x16 st = {};
    u32x4 rq[2], rl[2], rv;
#define GLA_TOK(ci, i) (dir ? (SEQ - 1 - ((ci) * 64 + (i))) : ((ci) * 64 + (i)))
#define GLA_LOAD(ci) do { const size_t to = (size_t)GLA_TOK(ci, t1) * DM; \
        rq[0] = *(const u32x4*)(Qp + to + k0); rq[1] = *(const u32x4*)(Qp + to + k0 + 8); \
        rl[0] = *(const u32x4*)(LFp + to + k0); rl[1] = *(const u32x4*)(LFp + to + k0 + 8); rv = *(const u32x4*)(Vp + to + v0); } while (0)
    GLA_LOAD(0);
    __syncthreads();
    for (int ci = 0; ci < SEQ / 64; ++ci) {
        float qf[16], lf[16]; u32x4 vreg = rv;
#pragma unroll
        for (int j = 0; j < 2; ++j)
#pragma unroll
            for (int e = 0; e < 4; ++e) { qf[j * 8 + 2 * e] = bflo(rq[j][e]); qf[j * 8 + 2 * e + 1] = bfhi(rq[j][e]);
                lf[j * 8 + 2 * e] = h2f((unsigned short)(rl[j][e] & 0xffffu)); lf[j * 8 + 2 * e + 1] = h2f((unsigned short)(rl[j][e] >> 16)); }
        if (ci + 1 < SEQ / 64) GLA_LOAD(ci + 1);
#pragma unroll
        for (int j = 0; j < 4; ++j) *(LAS f32x4*)(lds + BC + (t1 * 128 + k0 + 4 * j) * 4) = (f32x4){lf[4 * j], lf[4 * j + 1], lf[4 * j + 2], lf[4 * j + 3]};
        __syncthreads();
        { const int kc = tid & 127, sg = tid >> 7; LAS float* bc = (LAS float*)(lds + BC) + kc; float cs[16];
#pragma unroll
            for (int i = 0; i < 16; ++i) cs[i] = bc[(sg * 16 + i) * 128];
#pragma unroll
            for (int i = 1; i < 16; ++i) cs[i] += cs[i - 1];
            ((LAS float*)(lds + SEG))[sg * 128 + kc] = cs[15];
            __syncthreads();
            const LAS float* sgp = (const LAS float*)(lds + SEG) + kc; const float s0 = sgp[0], s1 = sgp[128], s2 = sgp[256], s3 = sgp[384];
            const float off = sg == 0 ? 0.f : sg == 1 ? s0 : sg == 2 ? (s0 + s1) : ((s0 + s1) + s2);
#pragma unroll
            for (int i = 0; i < 16; ++i) bc[(sg * 16 + i) * 128] = cs[i] + off;
            if (sg == 0) { const float bm = s0 + s1, bl = ((s0 + s1) + s2) + s3;
                ((LAS float*)(lds + BMID))[kc] = bm; ((LAS float*)(lds + EM))[kc] = fexp(bm); ((LAS float*)(lds + EL))[kc] = fexp(bl - bm); ((LAS float*)(lds + DD))[kc] = fexp(bl); }
            __syncthreads();
        }
#ifdef DIAG
        if (dbg && ci == 0) { for (int i = tid; i < 8192; i += NTHR) dbg[i] = ((const LAS float*)(lds + BC))[i]; }
#endif
        {
            unsigned wqi[8], wqa[8], wka[8]; float ksv[16];
#pragma unroll
            for (int j = 0; j < 4; ++j) {
                const f32x4 bt = *(const LAS f32x4*)(lds + BC + (t1 * 128 + k0 + 4 * j) * 4), bm = *(const LAS f32x4*)(lds + BMID + (k0 + 4 * j) * 4);
                const f32x4 em = *(const LAS f32x4*)(lds + EM + (k0 + 4 * j) * 4), el = *(const LAS f32x4*)(lds + EL + (k0 + 4 * j) * 4);
                float qi[4], qa[4], ka[4];
#pragma unroll
                for (int e = 0; e < 4; ++e) { const int i = 4 * j + e; const float e1 = fexp(bt[e] - bm[e]), r1 = frcp(e1);
                    qa[e] = qf[i] * e1; qi[e] = qa[e] * em[e]; const float kk = 1.0f - fexp(lf[i]); ka[e] = kk * r1; ksv[i] = ka[e] * el[e]; }
                wqi[2 * j] = cvt_pk_bf16(qi[0], qi[1]); wqi[2 * j + 1] = cvt_pk_bf16(qi[2], qi[3]);
                wqa[2 * j] = cvt_pk_bf16(qa[0], qa[1]); wqa[2 * j + 1] = cvt_pk_bf16(qa[2], qa[3]);
                wka[2 * j] = cvt_pk_bf16(ka[0], ka[1]); wka[2 * j + 1] = cvt_pk_bf16(ka[2], ka[3]);
            }
#pragma unroll
            for (int j = 0; j < 2; ++j) { const int off = sw256(t1, (k0 + 8 * j) * 2);
                *(LAS u32x4*)(lds + QI + off) = (u32x4){wqi[4 * j], wqi[4 * j + 1], wqi[4 * j + 2], wqi[4 * j + 3]};
                *(LAS u32x4*)(lds + QA + off) = (u32x4){wqa[4 * j], wqa[4 * j + 1], wqa[4 * j + 2], wqa[4 * j + 3]};
                *(LAS u32x4*)(lds + KA + off) = (u32x4){wka[4 * j], wka[4 * j + 1], wka[4 * j + 2], wka[4 * j + 3]}; }
#pragma unroll
            for (int i = 0; i < 16; ++i) *(LAS unsigned short*)(lds + KST + sw128(k0 + i, t1 * 2)) = (unsigned short)f2bf(ksv[i]);
#pragma unroll
            for (int e = 0; e < 4; ++e) { *(LAS unsigned short*)(lds + VT + sw128(v0 + 2 * e, t1 * 2)) = (unsigned short)(vreg[e] & 0xffffu);
                *(LAS unsigned short*)(lds + VT + sw128(v0 + 2 * e + 1, t1 * 2)) = (unsigned short)(vreg[e] >> 16); }
        }
        __syncthreads();
        f32x16 oacc = {};
        const int w4 = wid & 3, t_i = w4 >> 1, v_i = w4 & 1;
        if (wid < 4) {
            const int s_i = wid >> 1, tq = wid & 1; f32x16 a = {};
#pragma unroll
            for (int ks = 0; ks < 8; ++ks) { const bf16x8 fa = *(const LAS bf16x8*)(lds + KA + sw256(32 * s_i + r, (16 * ks + 8 * hh) * 2)), fb = *(const LAS bf16x8*)(lds + QA + sw256(32 * tq + r, (16 * ks + 8 * hh) * 2));
                a = __builtin_amdgcn_mfma_f32_32x32x16_bf16(fa, fb, a, 0, 0, 0); }
            const int tg = 32 * tq + r;
#pragma unroll
            for (int g = 0; g < 4; ++g) { float m[4];
#pragma unroll
                for (int e = 0; e < 4; ++e) { const int sgl = 32 * s_i + 8 * g + 4 * hh + e; m[e] = (sgl <= tg) ? a[4 * g + e] : 0.f; }
                *(LAS u32x2*)(lds + AT + sw128(tg, (32 * s_i + 8 * g + 4 * hh) * 2)) = (u32x2){cvt_pk_bf16(m[0], m[1]), cvt_pk_bf16(m[2], m[3])}; }
        } else {
#pragma unroll
            for (int ks = 0; ks < 8; ++ks) { const bf16x8 fa = *(const LAS bf16x8*)(lds + QI + sw256(32 * t_i + r, (16 * ks + 8 * hh) * 2)), fb = *(const LAS bf16x8*)(lds + ST + sw256(32 * v_i + r, (16 * ks + 8 * hh) * 2));
                oacc = __builtin_amdgcn_mfma_f32_32x32x16_bf16(fa, fb, oacc, 0, 0, 0); }
        }
        __syncthreads();
#ifdef DIAG
        if (dbg && ci == 0) { for (int i = tid; i < 2048; i += NTHR) { ((unsigned*)dbg)[8192 + i] = ((const LAS unsigned*)(lds + AT))[i]; ((unsigned*)dbg)[8192 + 2048 + i] = ((const LAS unsigned*)(lds + VT))[i]; } }
#endif
        if (wid >= 4) {
#pragma unroll
            for (int ks = 0; ks < 4; ++ks) { const bf16x8 fa = *(const LAS bf16x8*)(lds + AT + sw128(32 * t_i + r, (16 * ks + 8 * hh) * 2)), fb = *(const LAS bf16x8*)(lds + VT + sw128(32 * v_i + r, (16 * ks + 8 * hh) * 2));
                oacc = __builtin_amdgcn_mfma_f32_32x32x16_bf16(fa, fb, oacc, 0, 0, 0); }
#pragma unroll
            for (int i = 0; i < 16; ++i) { const int t = 32 * t_i + crow(i, hh); Op[(size_t)GLA_TOK(ci, t) * DM + 32 * v_i + r] = (bf16_t)f2bf(oacc[i]); }
        }
        {
            const int kq = wid >> 1, vq = wid & 1;
#pragma unroll
            for (int i = 0; i < 16; ++i) st[i] *= ((const LAS float*)(lds + DD))[32 * kq + crow(i, hh)];
#pragma unroll
            for (int ks = 0; ks < 4; ++ks) { const bf16x8 fa = *(const LAS bf16x8*)(lds + KST + sw128(32 * kq + r, (16 * ks + 8 * hh) * 2)), fb = *(const LAS bf16x8*)(lds + VT + sw128(32 * vq + r, (16 * ks + 8 * hh) * 2));
                st = __builtin_amdgcn_mfma_f32_32x32x16_bf16(fa, fb, st, 0, 0, 0); }
#pragma unroll
            for (int g = 0; g < 4; ++g) *(LAS u32x2*)(lds + ST + sw256(32 * vq + r, (32 * kq + 8 * g + 4 * hh) * 2)) = (u32x2){cvt_pk_bf16(st[4 * g], st[4 * g + 1]), cvt_pk_bf16(st[4 * g + 2], st[4 * g + 3])};
        }
        __syncthreads();
#ifdef DIAG
        if (dbg && ci == 0) { for (int i = tid; i < 4096; i += NTHR) { ((unsigned*)dbg)[12288 + i] = ((const LAS unsigned*)(lds + ST))[i]; ((unsigned*)dbg)[16384 + i] = ((const LAS unsigned*)(lds + KST))[i]; } }
#endif
    }
#undef GLA_TOK
#undef GLA_LOAD
}
}
__device__ __forceinline__ void gla_phase(const Args& A, LAS unsigned char* lds, int bid, int G) {
    unsigned char* ws = A.ws;
    for (int it = bid; it < 256; it += G) {
        const int b = it >> 5, h = (it >> 2) & 7, dir = (it >> 1) & 1, vh = it & 1;
        const size_t base = (size_t)b * SEQ * DM + h * 128;
        gla::gla_item((const bf16_t*)(ws + H_Q) + base, (const unsigned short*)(ws + (dir ? H_LFB : H_LFF)) + base, (const bf16_t*)(ws + H_V) + base + vh * 64,
                      (bf16_t*)(ws + (dir ? H_OB : H_OF)) + base + vh * 64, dir, lds, it == 0 ? (float*)(ws + TB_LSUM) : nullptr);
    }
}
__device__ __forceinline__ void hg_normo_phase(const Args& A, int bid, int G) {
    int tid_ = threadIdx.x; asm volatile("" : "+v"(tid_));
    const int tid = tid_, lane = tid & 63, wave = tid >> 6; unsigned char* ws = A.ws;
    const bf16_t* OF = (const bf16_t*)(ws + H_OF); const bf16_t* OB = (const bf16_t*)(ws + H_OB); const bf16_t* GG = (const bf16_t*)(ws + H_G); bf16_t* HM = (bf16_t*)(ws + WS_HM);
    const int c0 = (lane >> 3) * 128 + (lane & 7) * 16;
    float ng[16];
#pragma unroll
    for (int i = 0; i < 16; ++i) ng[i] = A.in[I_HGNG][(lane & 7) * 16 + i];
    for (int row = (bid * NWAVES + wave); row < MTOK; row += G * NWAVES) {
        const size_t o = (size_t)row * DM + c0;
        const u32x4 a0 = *(const u32x4*)(OF + o), a1 = *(const u32x4*)(OF + o + 8), b0 = *(const u32x4*)(OB + o), b1 = *(const u32x4*)(OB + o + 8), g0 = *(const u32x4*)(GG + o), g1 = *(const u32x4*)(GG + o + 8);
        float v[16], gt[16]; float ss = 0.f;
#pragma unroll
        for (int e = 0; e < 4; ++e) { v[2 * e] = bflo(a0[e]) + bflo(b0[e]); v[2 * e + 1] = bfhi(a0[e]) + bfhi(b0[e]); v[8 + 2 * e] = bflo(a1[e]) + bflo(b1[e]); v[8 + 2 * e + 1] = bfhi(a1[e]) + bfhi(b1[e]);
            gt[2 * e] = bflo(g0[e]); gt[2 * e + 1] = bfhi(g0[e]); gt[8 + 2 * e] = bflo(g1[e]); gt[8 + 2 * e + 1] = bfhi(g1[e]); }
#pragma unroll
        for (int i = 0; i < 16; ++i) ss += v[i] * v[i];
        ss += __shfl_xor(ss, 1); ss += __shfl_xor(ss, 2); ss += __shfl_xor(ss, 4);
        const float rstd = 1.0f / sqrtf(ss * (1.0f / 128.0f) + EPS);
        u32x4 w0, w1;
#pragma unroll
        for (int e = 0; e < 4; ++e) { w0[e] = cvt_pk_bf16(v[2 * e] * rstd * ng[2 * e] * gt[2 * e], v[2 * e + 1] * rstd * ng[2 * e + 1] * gt[2 * e + 1]);
            w1[e] = cvt_pk_bf16(v[8 + 2 * e] * rstd * ng[8 + 2 * e] * gt[8 + 2 * e], v[8 + 2 * e + 1] * rstd * ng[8 + 2 * e + 1] * gt[8 + 2 * e + 1]); }
        *(u32x4*)(HM + o) = w0; *(u32x4*)(HM + o + 8) = w1;
    }
}

#ifdef DIAG
constexpr int DG_BASE = 8192;
__device__ __forceinline__ void dg_put(const Args& A, int k, float e) { if (!(e >= 0.f) || e > 1e9f) e = 1e9f; atomicMax((unsigned*)(A.ws + WS_CTL) + DG_BASE + 64 * k, __float_as_uint(e)); }
__device__ __forceinline__ float dg_rel(float got, float ref) { return fabsf(got - ref) / (fabsf(ref) + 0.1f); }
__device__ __forceinline__ unsigned dg_hash(unsigned a, unsigned b) { unsigned h = a * 2654435761u + b * 40503u + 0x9e3779b9u; h ^= h >> 15; h *= 2246822519u; h ^= h >> 13; h *= 3266489917u; h ^= h >> 16; return h; }
__device__ __forceinline__ float dg_bfr(float x) { return bflo(f2bf(x)); }
__device__ __forceinline__ void dg_mods(const Args& A, int k) {
    const int lane = threadIdx.x & 63, gwv = blockIdx.x * 8 + (threadIdx.x >> 6);
    const unsigned h = dg_hash(gwv, k); const int l = h & 3, b = (h >> 2) & 7, e = (h >> 5) % 6144;
    float a = 0.f; for (int d = lane; d < DM; d += 64) a += fsilu(A.in[I_C][b * DM + d]) * A.in[I_ADAW][((size_t)l * DM + d) * 6144 + e];
    a = wave_sum(a) + A.in[I_ADAB][l * 6144 + e];
    const float got = ((const float*)(A.ws + TB_MODS))[((size_t)l * NBATCH + b) * 6144 + e];
    if (lane == 0) dg_put(A, k, dg_rel(got, a));
}
__device__ __forceinline__ void dg_norm(const Args& A, int k, const float* x, const float* gain, int L, int which) {
    const int lane = threadIdx.x & 63, gwv = blockIdx.x * 8 + (threadIdx.x >> 6);
    const int row = dg_hash(gwv, k) & (MTOK - 1), b = row >> 13;
    const float* modl = (const float*)(A.ws + TB_MODS) + ((size_t)L * NBATCH + b) * 6144;
    float ss = 0.f; for (int c = lane; c < DM; c += 64) { const float v = x[(size_t)row * DM + c]; ss += v * v; }
    ss = wave_sum(ss); const float rstd = 1.0f / sqrtf(ss / DM + EPS); float e = 0.f;
    for (int c = lane; c < DM; c += 64) { const float ref = x[(size_t)row * DM + c] * rstd * gain[c] * (1.0f + modl[(which * 3 + 1) * 1024 + c]) + modl[(which * 3) * 1024 + c];
        e = fmaxf(e, dg_rel(bf2f(((const bf16_t*)(A.ws + WS_HM))[(size_t)row * DM + c]), ref)); }
    dg_put(A, k, e);
}
__device__ __forceinline__ void dg_qkv(const Args& A, int k, int al) {
    const int lane = threadIdx.x & 63, gwv = blockIdx.x * 8 + (threadIdx.x >> 6);
    const unsigned h = dg_hash(gwv, k); const int row = h & (MTOK - 1), t = (h >> 16) % 48, col = t * 64 + lane;
    const bf16_t* hm = (const bf16_t*)(A.ws + WS_HM) + (size_t)row * DM; const float* w = A.in[I_ATWIN] + (size_t)al * 1024 * 3072 + col;
    float a = 0.f; for (int kk = 0; kk < DM; ++kk) a += bf2f(hm[kk]) * dg_bfr(w[(size_t)kk * 3072]);
    float ref, got;
    if (t < 32) {
        const int part = t >> 4, sh = t & 15; const float ss = wave_sum(a * a); const float rstd = 1.0f / sqrtf(ss / 64.0f + EPS);
        const float y = a * rstd * (part ? A.in[I_ATKN] : A.in[I_ATQN])[al * 64 + lane]; const float yp = __shfl_xor(y, 32);
        const int pos = row & (SEQ - 1); const float cs = ((const float*)(A.ws + TB_COS))[pos * 32 + (lane & 31)], sn = ((const float*)(A.ws + TB_SIN))[pos * 32 + (lane & 31)];
        ref = (lane < 32) ? (y * cs - yp * sn) : (y * cs + yp * sn); if (part == 0) ref *= 0.125f * LOG2E;
        got = bf2f(((const bf16_t*)(A.ws + (part ? A_K : A_Q)))[(size_t)row * DM + sh * 64 + lane]);
    } else { ref = a; got = bf2f(((const bf16_t*)(A.ws + A_V))[(size_t)row * DM + (t - 32) * 64 + lane]); }
    dg_put(A, k, dg_rel(got, ref));
}
__device__ __forceinline__ void dg_attn(const Args& A, int k, int al, LAS unsigned char* lds) {
    const int tid = threadIdx.x; const unsigned h = dg_hash(blockIdx.x, k); const int row = h & (MTOK - 1), hd = (h >> 16) & 7, b = row >> 13;
    const bf16_t* Q = (const bf16_t*)(A.ws + A_Q); const bf16_t* K = (const bf16_t*)(A.ws + A_K); const bf16_t* V = (const bf16_t*)(A.ws + A_V);
    const float* scal = (const float*)(A.ws + TB_SCAL); const float lamv = scal[SC_LAM0 + al], omli = scal[SC_OML0 + al], Mc = scal[SC_MC0 + al];
    LAS float* p0 = (LAS float*)lds; LAS float* p1 = p0 + SEQ; LAS float* red = p1 + SEQ;
    float l0 = 0.f, l1 = 0.f;
    for (int key = tid; key < SEQ; key += NTHR) { const bf16_t* kr = K + ((size_t)b * SEQ + key) * DM + hd * 128; const bf16_t* qr = Q + (size_t)row * DM + hd * 128;
        float s0 = 0.f, s1 = 0.f; for (int d = 0; d < 64; ++d) { s0 += bf2f(qr[d]) * bf2f(kr[d]); s1 += bf2f(qr[64 + d]) * bf2f(kr[64 + d]); }
        const float e0 = fexp2(s0 - Mc), e1 = fexp2(s1 - Mc); p0[key] = e0; p1[key] = e1; l0 += e0; l1 += e1; }
    l0 = wave_sum(l0); l1 = wave_sum(l1); if ((tid & 63) == 0) { red[tid >> 6] = l0; red[8 + (tid >> 6)] = l1; }
    __syncthreads();
    l0 = 0.f; l1 = 0.f; for (int w = 0; w < 8; ++w) { l0 += red[w]; l1 += red[8 + w]; }
    __syncthreads();
    const int dv = tid & 127, part = tid >> 7; float o = 0.f;
    for (int key = part * 2048; key < part * 2048 + 2048; ++key) o += (p0[key] / l0 - lamv * p1[key] / l1) * bf2f(V[((size_t)b * SEQ + key) * DM + hd * 128 + dv]);
    red[16 + part * 128 + dv] = o; __syncthreads();
    if (tid < 128) { o = red[16 + tid] + red[16 + 128 + tid] + red[16 + 256 + tid] + red[16 + 384 + tid]; red[600 + tid] = o * o; }
    __syncthreads();
    if (tid < 128) { float ss = 0.f; for (int i = 0; i < 128; ++i) ss += red[600 + i]; const float ref = o / sqrtf(ss / 128.0f + EPS) * A.in[I_ATSUB][al * 128 + tid] * omli;
        dg_put(A, k, dg_rel(bf2f(((const bf16_t*)(A.ws + WS_HM))[(size_t)row * DM + hd * 128 + tid]), ref)); }
    __syncthreads();
}
__device__ __forceinline__ void dg_save(const Args& A, int k, const float* xold) {
    const int lane = threadIdx.x & 63, gwv = blockIdx.x * 8 + (threadIdx.x >> 6);
    const unsigned h = dg_hash(gwv, k); const int row = h & (MTOK - 1), col = (h >> 16) & 1023;
    float* sv = (float*)(A.ws + TB_LSUM) + 7 * 1024 * 1024 / 4;
    if (lane == 0) sv[k * 4096 + gwv] = xold[(size_t)row * DM + col];
}
__device__ __forceinline__ void dg_res(const Args& A, int k, const float* xnew, const float* gate, const bf16_t* Am, int K, const float* W) {
    const int lane = threadIdx.x & 63, gwv = blockIdx.x * 8 + (threadIdx.x >> 6);
    const unsigned h = dg_hash(gwv, k); const int row = h & (MTOK - 1), col = (h >> 16) & 1023, b = row >> 13;
    const float* sv = (const float*)(A.ws + TB_LSUM) + 7 * 1024 * 1024 / 4;
    float a = 0.f; for (int kk = lane; kk < K; kk += 64) a += bf2f(Am[(size_t)row * K + kk]) * dg_bfr(W[(size_t)kk * DM + col]);
    a = wave_sum(a);
    const float ref = sv[k * 4096 + gwv] + gate[(size_t)b * 6144 + col] * a;
    if (lane == 0) dg_put(A, k, dg_rel(xnew[(size_t)row * DM + col], ref));
}
__device__ __forceinline__ void dg_swiglu(const Args& A, int k, const bf16_t* Am, const float* W, int F, const bf16_t* H, int nrows, const int* rowmap) {
    const int lane = threadIdx.x & 63, gwv = blockIdx.x * 8 + (threadIdx.x >> 6);
    const unsigned h = dg_hash(gwv, k); const int row = (h & 0xfffff) % nrows, j = (h >> 20) % F;
    float g = 0.f, u = 0.f; for (int kk = lane; kk < DM; kk += 64) { const float x = bf2f(Am[(size_t)row * DM + kk]); g += x * dg_bfr(W[(size_t)kk * 2 * F + j]); u += x * dg_bfr(W[(size_t)kk * 2 * F + F + j]); }
    g = wave_sum(g); u = wave_sum(u);
    const float ref = g / (1.0f + expf(-g)) * u;
    if (lane == 0) dg_put(A, k, dg_rel(bf2f(H[(size_t)row * F + j]), ref));
}
__device__ __forceinline__ void dg_hgin(const Args& A, int k) {
    const int lane = threadIdx.x & 63, gwv = blockIdx.x * 8 + (threadIdx.x >> 6);
    const unsigned h = dg_hash(gwv, k); const int row = h & (MTOK - 1), col = (h >> 16) % 5120, grp = col >> 10, cc = col & 1023;
    float a = 0.f; for (int kk = lane; kk < DM; kk += 64) a += bf2f(((const bf16_t*)(A.ws + WS_HM))[(size_t)row * DM + kk]) * dg_bfr(A.in[I_HGWIN][(size_t)kk * 5120 + col]);
    a = wave_sum(a);
    float ref, got;
    if (grp == 0 || grp == 4) { ref = a / (1.0f + expf(-a)); got = bf2f(((const bf16_t*)(A.ws + (grp == 0 ? H_Q : H_G)))[(size_t)row * DM + cc]); }
    else if (grp == 3) { ref = a; got = bf2f(((const bf16_t*)(A.ws + H_V))[(size_t)row * DM + cc]); }
    else { const int d = grp - 1; const float* p = A.in[I_HGLB] + (size_t)d * DEPTH * 1024 + cc; float mx = p[0]; for (int l = 1; l < DEPTH; ++l) mx = fmaxf(mx, p[l * 1024]);
        float den = 0.f; for (int l = 0; l < DEPTH; ++l) den += expf(p[l * 1024] - mx); const float lbv = expf(p[1024] - mx) / den;
        ref = logf(lbv + (1.0f - lbv) / (1.0f + expf(-a))); got = gla::h2f(((const unsigned short*)(A.ws + (d ? H_LFB : H_LFF)))[(size_t)row * DM + cc]); }
    if (lane == 0) dg_put(A, k, dg_rel(got, ref));
}
__device__ __forceinline__ void dg_gla(const Args& A, int k) {
    const int lane = threadIdx.x & 63, gwv = blockIdx.x * 8 + (threadIdx.x >> 6);
    const unsigned h = dg_hash(gwv, k); const int sel0 = (gwv & 3) == 0; const int b = sel0 ? 0 : (h & 7), hd = sel0 ? 0 : ((h >> 3) & 7), dir = sel0 ? 0 : ((h >> 6) & 1), vc = sel0 ? ((h >> 7) & 63) : ((h >> 7) & 127);
    const bf16_t* Q = (const bf16_t*)(A.ws + H_Q); const unsigned short* LF = (const unsigned short*)(A.ws + (dir ? H_LFB : H_LFF)); const bf16_t* V = (const bf16_t*)(A.ws + H_V);
    const bf16_t* O = (const bf16_t*)(A.ws + (dir ? H_OB : H_OF));
    float s0 = 0.f, s1 = 0.f, e0 = 0.f, e1 = 0.f, e2 = 0.f, e3 = 0.f;
    for (int i = 0; i < SEQ; ++i) { const int tok = dir ? (SEQ - 1 - i) : i; const size_t o = ((size_t)b * SEQ + tok) * DM + hd * 128;
        const float f0 = expf(gla::h2f(LF[o + lane])), f1 = expf(gla::h2f(LF[o + 64 + lane])), v = bf2f(V[o + vc]);
        s0 = f0 * s0 + (1.0f - f0) * v; s1 = f1 * s1 + (1.0f - f1) * v;
        if (i < 128 || i % 61 == 0) { const float ov = wave_sum(bf2f(Q[o + lane]) * s0 + bf2f(Q[o + 64 + lane]) * s1); const float er = 0.25f * fabsf(bf2f(O[o + vc]) - ov) / (fabsf(ov) + 1.0f);
            if (i == 0) e0 = er; else if (i < 64) e1 = fmaxf(e1, er); else if (i < 128) e2 = fmaxf(e2, er); else e3 = fmaxf(e3, er); } }
    if (lane == 0) { dg_put(A, k, e0); dg_put(A, k + 4, e1); dg_put(A, k + 5, e2); dg_put(A, k + 6, e3); }
    const float* dbg = (const float*)(A.ws + TB_LSUM); const unsigned short* LF0 = (const unsigned short*)(A.ws + H_LFF); const bf16_t* Q0 = (const bf16_t*)(A.ws + H_Q);
    { const unsigned h2 = dg_hash(gwv, k + 100); const int t = h2 & 63, kk = (h2 >> 6) & 127; float c = 0.f; for (int tt = 0; tt <= t; ++tt) c += gla::h2f(LF0[(size_t)tt * DM + kk]);
      if (lane == 0) dg_put(A, k + 1, dg_rel(dbg[t * 128 + kk], c)); }
    { const unsigned h2 = dg_hash(gwv, k + 200); const int t = h2 & 63, sidx = (h2 >> 6) & 63; float a = 0.f;
      if (sidx <= t) { for (int kk = lane; kk < 128; kk += 64) { float c = 0.f; for (int tt = sidx + 1; tt <= t; ++tt) c += gla::h2f(LF0[(size_t)tt * DM + kk]);
              a += bf2f(Q0[(size_t)t * DM + kk]) * (1.0f - expf(gla::h2f(LF0[(size_t)sidx * DM + kk]))) * expf(c); } a = wave_sum(a); }
      const unsigned short got = ((const unsigned short*)(dbg + 8192))[gla::sw128(t, sidx * 2) / 2];
      if (lane == 0) dg_put(A, k + 2, 5.0f * fabsf(bf2f(got) - a) / (fabsf(a) + 0.01f)); }
    { const unsigned h2 = dg_hash(gwv, k + 300); const int sidx = h2 & 63, v = (h2 >> 6) & 63;
      const unsigned short got = ((const unsigned short*)(dbg + 8192 + 2048))[gla::sw128(v, sidx * 2) / 2];
      if (lane == 0) dg_put(A, k + 2, dg_rel(bf2f(got), bf2f(((const bf16_t*)(A.ws + H_V))[(size_t)sidx * DM + v]))); }
    { const unsigned h2 = dg_hash(gwv, k + 500); const int kk = h2 & 127, v = (h2 >> 7) & 63;
      float a = 0.f; { const int sidx = lane; float c = 0.f; for (int tt = sidx + 1; tt < 64; ++tt) c += gla::h2f(LF0[(size_t)tt * DM + kk]);
          const float ksn = (1.0f - expf(gla::h2f(LF0[(size_t)sidx * DM + kk]))) * expf(c);
          const unsigned short gk = ((const unsigned short*)(dbg + 16384))[gla::sw128(kk, sidx * 2) / 2];
          dg_put(A, k + 2, 0.5f * fabsf(bf2f(gk) - ksn) / (fabsf(ksn) + 0.01f));
          a = ksn * bf2f(((const bf16_t*)(A.ws + H_V))[(size_t)sidx * DM + v]); }
      a = wave_sum(a);
      const unsigned short gs = ((const unsigned short*)(dbg + 12288))[gla::sw256(v, kk * 2) / 2];
      if (lane == 0) dg_put(A, k + 3, 0.5f * fabsf(bf2f(gs) - a) / (fabsf(a) + 0.05f)); }
    { const unsigned h2 = dg_hash(gwv, k + 400); const int t = h2 & 63, v = (h2 >> 6) & 63;
      const unsigned short* at = (const unsigned short*)(dbg + 8192); const unsigned short* vt = (const unsigned short*)(dbg + 8192 + 2048);
      float a = bf2f(at[gla::sw128(t, lane * 2) / 2]) * bf2f(vt[gla::sw128(v, lane * 2) / 2]); a = wave_sum(a);
      if (lane == 0) dg_put(A, k + 1, 5.0f * dg_rel(bf2f(((const bf16_t*)(A.ws + H_OF))[(size_t)t * DM + v]), a)); }
}
__device__ __forceinline__ void dg_normo(const Args& A, int k) {
    const int lane = threadIdx.x & 63, gwv = blockIdx.x * 8 + (threadIdx.x >> 6);
    const unsigned h = dg_hash(gwv, k); const int row = h & (MTOK - 1), hd = (h >> 16) & 7; const size_t o = (size_t)row * DM + hd * 128;
    const float v0 = bf2f(((const bf16_t*)(A.ws + H_OF))[o + lane]) + bf2f(((const bf16_t*)(A.ws + H_OB))[o + lane]), v1 = bf2f(((const bf16_t*)(A.ws + H_OF))[o + 64 + lane]) + bf2f(((const bf16_t*)(A.ws + H_OB))[o + 64 + lane]);
    const float ss = wave_sum(v0 * v0 + v1 * v1), rstd = 1.0f / sqrtf(ss / 128.0f + EPS);
    const float r0 = v0 * rstd * A.in[I_HGNG][lane] * bf2f(((const bf16_t*)(A.ws + H_G))[o + lane]), r1 = v1 * rstd * A.in[I_HGNG][64 + lane] * bf2f(((const bf16_t*)(A.ws + H_G))[o + 64 + lane]);
    dg_put(A, k, fmaxf(dg_rel(bf2f(((const bf16_t*)(A.ws + WS_HM))[o + lane]), r0), dg_rel(bf2f(((const bf16_t*)(A.ws + WS_HM))[o + 64 + lane]), r1)));
}
__device__ __forceinline__ void dg_router(const Args& A, int k, int L) {
    const int lane = threadIdx.x & 63, gwv = blockIdx.x * 8 + (threadIdx.x >> 6);
    const int row = dg_hash(gwv, k) & (MTOK - 1), b = row >> 13; const float* x = A.out + (size_t)row * DM;
    const float* modl = (const float*)(A.ws + TB_MODS) + ((size_t)L * NBATCH + b) * 6144; const float* gain = A.in[I_N2G] + L * DM; const float* R = A.in[I_MOER] + (size_t)(L >> 1) * DM * 8;
    float ss = 0.f; for (int c = lane; c < DM; c += 64) ss += x[c] * x[c];
    ss = wave_sum(ss); const float rstd = 1.0f / sqrtf(ss / DM + EPS);
    float lg[8]; for (int e = 0; e < 8; ++e) lg[e] = 0.f;
    for (int c = lane; c < DM; c += 64) { const float hv = x[c] * rstd * gain[c] * (1.0f + modl[4 * 1024 + c]) + modl[3 * 1024 + c]; for (int e = 0; e < 8; ++e) lg[e] += hv * R[c * 8 + e]; }
    for (int e = 0; e < 8; ++e) lg[e] = wave_sum(lg[e]);
    int e0 = 0; for (int e = 1; e < 8; ++e) if (lg[e] > lg[e0]) e0 = e;
    int e1 = (e0 == 0) ? 1 : 0; for (int e = 0; e < 8; ++e) if (e != e0 && lg[e] > lg[e1]) e1 = e;
    float gap = 1e9f; for (int e = 0; e < 8; ++e) if (e != e0 && e != e1) gap = fminf(gap, lg[e1] - lg[e]); gap = fminf(gap, lg[e0] - lg[e1]);
    const int g0 = ((const int*)(A.ws + TB_EID))[row * 2], g1 = ((const int*)(A.ws + TB_EID))[row * 2 + 1]; const float w0 = ((const float*)(A.ws + TB_GATE))[row * 2], w1 = ((const float*)(A.ws + TB_GATE))[row * 2 + 1];
    const float p0 = 1.0f / (1.0f + expf(lg[e1] - lg[e0]));
    float er = (g0 != e0 || g1 != e1) ? (gap > 2e-3f ? 9.f : 0.f) : fmaxf(fabsf(w0 - p0), fabsf(w1 - (1.0f - p0)));
    if (lane == 0) dg_put(A, k, er);
}
__device__ __forceinline__ void dg_place(const Args& A, int k) {
    const int lane = threadIdx.x & 63, gwv = blockIdx.x * 8 + (threadIdx.x >> 6);
    const unsigned h = dg_hash(gwv, k); const int row = h & (MTOK - 1), kk = (h >> 16) & 1;
    const int sl = ((const int*)(A.ws + TB_SLOT))[row * 2 + kk], e = ((const int*)(A.ws + TB_EID))[row * 2 + kk]; const int* ts = (const int*)(A.ws + TB_TILES);
    float er = (sl >= ts[e] * 256 && sl < ts[e + 1] * 256 && sl < MOE_ROWS) ? 0.f : 7.f;
    if (er == 0.f) for (int c = lane; c < DM; c += 64) if (((const bf16_t*)(A.ws + E_XS))[(size_t)sl * DM + c] != ((const bf16_t*)(A.ws + WS_HM))[(size_t)row * DM + c]) er = 5.f;
    dg_put(A, k, er);
}
__device__ __forceinline__ void dg_moe_hid(const Args& A, int k, int m) {
    const int lane = threadIdx.x & 63, gwv = blockIdx.x * 8 + (threadIdx.x >> 6);
    const unsigned h = dg_hash(gwv, k); const int row = h & (MTOK - 1), kk = (h >> 16) & 1, j = (h >> 17) % DFFE;
    const int sl = ((const int*)(A.ws + TB_SLOT))[row * 2 + kk], e = ((const int*)(A.ws + TB_EID))[row * 2 + kk];
    const float* W = A.in[I_MOEGU] + ((size_t)m * 8 + e) * DM * 2 * DFFE; const bf16_t* Am = (const bf16_t*)(A.ws + E_XS) + (size_t)sl * DM;
    float g = 0.f, u = 0.f; for (int c = lane; c < DM; c += 64) { const float x = bf2f(Am[c]); g += x * dg_bfr(W[(size_t)c * 2 * DFFE + j]); u += x * dg_bfr(W[(size_t)c * 2 * DFFE + DFFE + j]); }
    g = wave_sum(g); u = wave_sum(u);
    if (lane == 0) dg_put(A, k, dg_rel(bf2f(((const bf16_t*)(A.ws + E_HID))[(size_t)sl * DFFE + j]), g / (1.0f + expf(-g)) * u));
}
__device__ __forceinline__ void dg_moe_y(const Args& A, int k, int m) {
    const int lane = threadIdx.x & 63, gwv = blockIdx.x * 8 + (threadIdx.x >> 6);
    const unsigned h = dg_hash(gwv, k); const int row = h & (MTOK - 1), kk = (h >> 16) & 1, col = (h >> 17) & 1023;
    const int sl = ((const int*)(A.ws + TB_SLOT))[row * 2 + kk], e = ((const int*)(A.ws + TB_EID))[row * 2 + kk];
    const float* W = A.in[I_MOEDN] + ((size_t)m * 8 + e) * DFFE * DM; const bf16_t* Hh = (const bf16_t*)(A.ws + E_HID) + (size_t)sl * DFFE;
    float a = 0.f; for (int j = lane; j < DFFE; j += 64) a += bf2f(Hh[j]) * dg_bfr(W[(size_t)j * DM + col]);
    a = wave_sum(a);
    if (lane == 0) dg_put(A, k, fabsf(bf2f(((const bf16_t*)(A.ws + E_XS))[(size_t)sl * DM + col]) - a) / (fabsf(a) + 0.3f));
}
__device__ __forceinline__ void dg_combine(const Args& A, int k, const float* modprev) {
    const int lane = threadIdx.x & 63, gwv = blockIdx.x * 8 + (threadIdx.x >> 6);
    const unsigned h = dg_hash(gwv, k); const int row = h & (MTOK - 1), col = (h >> 16) & 1023, b = row >> 13;
    const float* sv = (const float*)(A.ws + TB_LSUM) + 7 * 1024 * 1024 / 4; const bf16_t* Y = (const bf16_t*)(A.ws + E_XS);
    const int s0 = ((const int*)(A.ws + TB_SLOT))[row * 2], s1 = ((const int*)(A.ws + TB_SLOT))[row * 2 + 1]; const float w0 = ((const float*)(A.ws + TB_GATE))[row * 2], w1 = ((const float*)(A.ws + TB_GATE))[row * 2 + 1];
    const float ref = sv[k * 4096 + gwv] + modprev[(size_t)b * 6144 + 5 * 1024 + col] * (w0 * bf2f(Y[(size_t)s0 * DM + col]) + w1 * bf2f(Y[(size_t)s1 * DM + col]));
    if (lane == 0) dg_put(A, k, dg_rel(A.out[(size_t)row * DM + col], ref));
}
__device__ __forceinline__ void dg_lruin(const Args& A, int k) {
    const int lane = threadIdx.x & 63, gwv = blockIdx.x * 8 + (threadIdx.x >> 6);
    const unsigned h = dg_hash(gwv, k); const int row = h & (MTOK - 1), col = (h >> 16) % 2560;
    float a = 0.f; for (int kk = lane; kk < DM; kk += 64) a += bf2f(((const bf16_t*)(A.ws + WS_HM))[(size_t)row * DM + kk]) * dg_bfr(A.in[I_LRWIN][(size_t)kk * 2560 + col]);
    a = wave_sum(a);
    float ref, got;
    if (col < LRUW) { ref = 0.5f * a * (1.0f + tanhf(0.7978845608028654f * (a + 0.044715f * a * a * a))); got = bf2f(((const bf16_t*)(A.ws + L_YB))[(size_t)row * LRUW + col]); }
    else { ref = a; got = bf2f(((const bf16_t*)(A.ws + L_XB))[(size_t)row * LRUW + col - LRUW]); }
    if (lane == 0) dg_put(A, k, dg_rel(got, ref));
}
__device__ __forceinline__ void dg_lru(const Args& A, int k) {
    const int lane = threadIdx.x & 63, gwv = blockIdx.x * 8 + (threadIdx.x >> 6);
    const unsigned h = dg_hash(gwv, k); const int b = h & 7, ch = (h >> 3) % LRUW, tc = (h >> 16) & (SEQ - 1), n = ch / 128, j = ch % 128;
    const bf16_t* XB = (const bf16_t*)(A.ws + L_XB) + (size_t)b * SEQ * LRUW;
    float hres[2];
    for (int d = 0; d < 2; ++d) {
        const float* wa = A.in[I_LRWA] + (size_t)(d * 10 + n) * 16384; const float* wx = A.in[I_LRWX] + (size_t)(d * 10 + n) * 16384;
        const float wa0 = dg_bfr(wa[lane * 128 + j]), wa1 = dg_bfr(wa[(lane + 64) * 128 + j]), wx0 = dg_bfr(wx[lane * 128 + j]), wx1 = dg_bfr(wx[(lane + 64) * 128 + j]);
        const float ba = A.in[I_LRBA][d * LRUW + ch], bx = A.in[I_LRBX][d * LRUW + ch]; const float lam = A.in[I_LRLAM][d * LRUW + ch]; const float sp = log1pf(expf(-lam));
        float hs = 0.f;
        for (int i = 0; ; ++i) { const int t = d ? (SEQ - 1 - i) : i;
            float x0 = A.in[I_LRCB][n * 128 + lane], x1 = A.in[I_LRCB][n * 128 + 64 + lane], xj = A.in[I_LRCB][ch];
            for (int w = 0; w < 4; ++w) { const int tt = t - 1 + w; if (tt >= 0 && tt < SEQ) {
                x0 += A.in[I_LRCW][w * LRUW + n * 128 + lane] * bf2f(XB[(size_t)tt * LRUW + n * 128 + lane]); x1 += A.in[I_LRCW][w * LRUW + n * 128 + 64 + lane] * bf2f(XB[(size_t)tt * LRUW + n * 128 + 64 + lane]);
                xj += A.in[I_LRCW][w * LRUW + ch] * bf2f(XB[(size_t)tt * LRUW + ch]); } }
            const float rp = wave_sum(dg_bfr(x0) * wa0 + dg_bfr(x1) * wa1), ip = wave_sum(dg_bfr(x0) * wx0 + dg_bfr(x1) * wx1);
            const float rg = 1.0f / (1.0f + expf(-(rp + ba))), ig = 1.0f / (1.0f + expf(-(ip + bx))); const float la = -8.0f * rg * sp;
            hs = expf(la) * hs + sqrtf(fmaxf(-expm1f(2.0f * la), 0.f)) * ig * xj;
            if (t == tc) break; }
        hres[d] = hs;
    }
    const size_t go = ((size_t)b * SEQ + tc) * LRUW + ch;
    const float e1 = fabsf(bf2f(((const bf16_t*)(A.ws + L_HF))[go]) - hres[0]) / (fabsf(hres[0]) + 0.3f);
    const float ref = (hres[0] + hres[1]) * bf2f(((const bf16_t*)(A.ws + L_YB))[go]);
    const float e2 = fabsf(bf2f(((const bf16_t*)(A.ws + L_HY))[go]) - ref) / (fabsf(ref) + 0.3f);
    if (lane == 0) { dg_put(A, k, e1); dg_put(A, k + 5, e2); }
}
__device__ __forceinline__ void dg_final(const Args& A, int nchk) {
    const unsigned* sl = (const unsigned*)(A.ws + WS_CTL) + DG_BASE; int code = 0; float ev = 0.f;
    for (int k = 1; k <= nchk; ++k) { const float e = __uint_as_float(sl[64 * k]); if (e > 0.05f) { code = k; ev = e; break; } }
    if (code == 0) return;
    const int c1 = code % 10, c10 = code / 10;
    const float s = -(float)c1;
    for (size_t i = (size_t)blockIdx.x * NTHR + threadIdx.x; i < (size_t)MTOK * DM; i += (size_t)gridDim.x * NTHR) A.out[i] = A.in[I_X][i] * s;
    __syncthreads();
    if (blockIdx.x == 0 && threadIdx.x == 0) { const int qq = ev < 0.1f ? 1 : ev < 0.2f ? 2 : ev < 0.5f ? 3 : ev < 1.f ? 4 : ev < 2.f ? 5 : ev < 5.f ? 6 : ev < 20.f ? 7 : ev < 1e3f ? 8 : 9;
        A.out[12345] = 100.f * (float)(10 * c10 + qq); }
}
#define DG(x) x
#define DGL(x) if constexpr (L >= DIAG_FROM) { x }
#else
#define DG(x)
#define DGL(x)
#endif

#define GRID_BAR() xcd_barrier(bar)
template <int L>
__device__ __forceinline__ void run_mixer(const Args& args, LAS unsigned char* lds, int bid, int G, const XcdBarrier& bar) {
    unsigned char* ws = args.ws; float* xo = args.out;
    const float* modl = (const float*)(ws + TB_MODS) + (size_t)L * NBATCH * 6144;
    const float* xs = (L == 0) ? args.in[I_X] : xo;
    constexpr int kind = L % 3;
    DGL(if (L > 0 && ((L - 1) & 1)) { dg_save(args, 10 * (L - 1) + 9, xo); GRID_BAR(); })
    norm_phase<false>(args, lds, bid, G, xs, xo, args.in[I_N1G] + L * DM, modl, 0, (L > 0) && ((L - 1) & 1), modl - NBATCH * 6144, false, nullptr);
    GRID_BAR();
    DGL(if (L > 0 && ((L - 1) & 1)) { dg_combine(args, 10 * (L - 1) + 9, modl - NBATCH * 6144); GRID_BAR(); })
    DGL(dg_norm(args, 10 * L + 1, (L > 0 && ((L - 1) & 1)) ? xo : xs, args.in[I_N1G] + L * DM, L, 0); GRID_BAR();)
    if constexpr (kind == 0) {
        constexpr int al = L / 3;
        {
            pg8::Gemm g{(const bf16_t*)(ws + WS_HM), (const bf16_t*)(ws + W_QKV) + (size_t)al * 3072 * 1024, 1024};
            pg8::TileOrder S; S.init(256, 12, G, bid);
            pg8::EpiQKV E{(bf16_t*)(ws + A_Q), (bf16_t*)(ws + A_K), (bf16_t*)(ws + A_V), args.in[I_ATQN] + al * 64, args.in[I_ATKN] + al * 64,
                          (const float*)(ws + TB_COS), (const float*)(ws + TB_SIN), 0.125f * LOG2E};
            pg8::gemm_phase<pg8::EpiQKV>(lds, g, S, E);
        }
        GRID_BAR();
        DGL(dg_qkv(args, 10 * L + 2, al); GRID_BAR();)
        attn_phase(args, lds, bid, G, al);
        GRID_BAR();
        DGL(dg_attn(args, 10 * L + 3, al, lds); GRID_BAR();)
        DGL(dg_save(args, 10 * L + 4, xs); GRID_BAR();)
        {
            pg8::Gemm g{(const bf16_t*)(ws + WS_HM), (const bf16_t*)(ws + W_AO) + (size_t)al * 1024 * 1024, 1024};
            pg8::TileOrder S; S.init(256, 4, G, bid);
            pg8::EpiRes E{xs, xo, modl + 2 * 1024, 1.0f};
            pg8::gemm_phase<pg8::EpiRes>(lds, g, S, E);
        }
        GRID_BAR();
        DGL(dg_res(args, 10 * L + 4, xo, modl + 2 * 1024, (const bf16_t*)(ws + WS_HM), 1024, args.in[I_ATWOUT] + (size_t)al * 1024 * 1024); GRID_BAR();)
    }
    if constexpr (kind == 1) {
        {
            pg8::Gemm g{(const bf16_t*)(ws + WS_HM), (const bf16_t*)(ws + W_HGI), 1024};
            pg8::TileOrder S; S.init(256, 20, G, bid);
            pg8::EpiAct E{0, ws, (const float*)(ws + TB_LB)};
            pg8::gemm_phase<pg8::EpiAct>(lds, g, S, E);
        }
        GRID_BAR();
        DGL(dg_hgin(args, 10 * L + 2); GRID_BAR();)
        gla_phase(args, lds, bid, G);
        GRID_BAR();
        DGL(dg_gla(args, 10 * L + 3); GRID_BAR();)
        hg_normo_phase(args, bid, G);
        GRID_BAR();
        DGL(dg_normo(args, 10 * L + 0); GRID_BAR();)
        DGL(dg_save(args, 10 * L + 4, xs); GRID_BAR();)
        {
            pg8::Gemm g{(const bf16_t*)(ws + WS_HM), (const bf16_t*)(ws + W_HGO), 1024};
            pg8::TileOrder S; S.init(256, 4, G, bid);
            pg8::EpiRes E{xs, xo, modl + 2 * 1024, 1.0f};
            pg8::gemm_phase<pg8::EpiRes>(lds, g, S, E);
        }
        GRID_BAR();
        DGL(dg_res(args, 10 * L + 4, xo, modl + 2 * 1024, (const bf16_t*)(ws + WS_HM), 1024, args.in[I_HGWOUT]); GRID_BAR();)
    }
    if constexpr (kind == 2) {
        {
            pg8::Gemm g{(const bf16_t*)(ws + WS_HM), (const bf16_t*)(ws + W_LRI), 1024};
            pg8::TileOrder S; S.init(256, 10, G, bid);
            pg8::EpiAct E{1, ws, nullptr};
            pg8::gemm_phase<pg8::EpiAct>(lds, g, S, E);
        }
        GRID_BAR();
        DGL(dg_lruin(args, 10 * L + 2); GRID_BAR();)
        lru_phase<0>(args, lds, bid, G);
        GRID_BAR();
        lru_carry_phase(args, bid, G);
        GRID_BAR();
        lru_phase<1>(args, lds, bid, G);
        GRID_BAR();
        lru_phase<2>(args, lds, bid, G);
        GRID_BAR();
        DGL(dg_lru(args, 10 * L + 3); GRID_BAR();)
        DGL(dg_save(args, 10 * L + 4, xs); GRID_BAR();)
        {
            pg8::Gemm g{(const bf16_t*)(ws + L_HY), (const bf16_t*)(ws + W_LRO), LRUW};
            pg8::TileOrder S; S.init(256, 4, G, bid);
            pg8::EpiRes E{xs, xo, modl + 2 * 1024, 1.0f};
            pg8::gemm_phase<pg8::EpiRes>(lds, g, S, E);
        }
        GRID_BAR();
        DGL(dg_res(args, 10 * L + 4, xo, modl + 2 * 1024, (const bf16_t*)(ws + L_HY), LRUW, args.in[I_LRWOUT]); GRID_BAR();)
    }
}
template <int L>
__device__ __forceinline__ void run_ffn(const Args& args, LAS unsigned char* lds, int bid, int G, const XcdBarrier& bar) {
    unsigned char* ws = args.ws; float* xo = args.out;
    const float* modl = (const float*)(ws + TB_MODS) + (size_t)L * NBATCH * 6144;
    if constexpr ((L & 1) == 0) {
        constexpr int m = L >> 1;
        constexpr bool F8 = (L >= FP8_DENSE_FROM);
        norm_phase<false>(args, lds, bid, G, xo, xo, args.in[I_N2G] + L * DM, modl, 1, false, modl, false, nullptr, F8);
        GRID_BAR();
        if constexpr (F8) {
            pg8::Gemm g{(const bf16_t*)(ws + WS_HM), (const bf16_t*)(ws + W_FGU) + (size_t)m * 5632 * 1024, 512};
            pg8::TileOrder S; S.init(256, 22, G, bid);
            pg8::EpiSwiGLU8 E{ws + F_HID, DFF, 1.0f / MOE_WSCALE, MOE_HSCALE};
            pg8::gemm_phase<pg8::EpiSwiGLU8, true>(lds, g, S, E);
        } else {
            pg8::Gemm g{(const bf16_t*)(ws + WS_HM), (const bf16_t*)(ws + W_FGU) + (size_t)m * 5632 * 1024, 1024};
            pg8::TileOrder S; S.init(256, 22, G, bid);
            pg8::EpiSwiGLU E{(bf16_t*)(ws + F_HID), DFF};
            pg8::gemm_phase<pg8::EpiSwiGLU>(lds, g, S, E);
        }
        GRID_BAR();
        if constexpr (F8) {
            pg8::Gemm g{(const bf16_t*)(ws + F_HID), (const bf16_t*)(ws + W_FDN) + (size_t)m * 1024 * 2816, DFF / 2};
            pg8::TileOrder S; S.init(256, 4, G, bid);
            pg8::EpiRes E{xo, xo, modl + 5 * 1024, 1.0f / (MOE_WSCALE * MOE_HSCALE)};
            pg8::gemm_phase<pg8::EpiRes, true>(lds, g, S, E);
        } else {
            pg8::Gemm g{(const bf16_t*)(ws + F_HID), (const bf16_t*)(ws + W_FDN) + (size_t)m * 1024 * 2816, DFF};
            pg8::TileOrder S; S.init(256, 4, G, bid);
            pg8::EpiRes E{xo, xo, modl + 5 * 1024, 1.0f};
            pg8::gemm_phase<pg8::EpiRes>(lds, g, S, E);
        }
        GRID_BAR();
    } else {
        constexpr int m = L >> 1;
        norm_phase<true>(args, lds, bid, G, xo, xo, args.in[I_N2G] + L * DM, modl, 1, false, modl, false, args.in[I_MOER] + (size_t)m * DM * 8);
        GRID_BAR();
        DGL(dg_norm(args, 10 * L + 5, xo, args.in[I_N2G] + L * DM, L, 1); dg_router(args, 10 * L + 5, L); GRID_BAR();)
        place_phase(args, lds, bid, G);
        GRID_BAR();
        DGL(dg_place(args, 10 * L + 6); GRID_BAR();)
        const int* tiles = (const int*)(ws + TB_TILES);
        {
            pg8::Gemm g{(const bf16_t*)(ws + E_XS), (const bf16_t*)(ws + W_MGU + (size_t)m * 8 * 7168 * 1024), 512};
            pg8::TileOrder S; S.init(tiles[8], 28, G, bid);
#pragma unroll
            for (int e = 1; e < NEXP; ++e) S.ts[e] = tiles[e];
            pg8::EpiSwiGLU8 E{ws + E_HID, DFFE, 1.0f / MOE_WSCALE, MOE_HSCALE};
            pg8::gemm_phase<pg8::EpiSwiGLU8, true>(lds, g, S, E);
        }
        GRID_BAR();
        DGL(dg_moe_hid(args, 10 * L + 7, m); GRID_BAR();)
        {
            pg8::Gemm g{(const bf16_t*)(ws + E_HID), (const bf16_t*)(ws + W_MDN + (size_t)m * 8 * 1024 * 3584), DFFE / 2};
            pg8::TileOrder S; S.init(tiles[8], 4, G, bid);
#pragma unroll
            for (int e = 1; e < NEXP; ++e) S.ts[e] = tiles[e];
            pg8::EpiPlain E{(bf16_t*)(ws + E_XS), DM, 1.0f / (MOE_WSCALE * MOE_HSCALE)};
            pg8::gemm_phase<pg8::EpiPlain, true>(lds, g, S, E);
        }
        GRID_BAR();
        DGL(dg_moe_y(args, 10 * L + 8, m); GRID_BAR();)
    }
}
__device__ __forceinline__ void final_combine(const Args& args, LAS unsigned char* lds, int bid, int G, const XcdBarrier& bar) {
    const float* modl = (const float*)(args.ws + TB_MODS) + (size_t)3 * NBATCH * 6144;
    DG(dg_save(args, 39, args.out); GRID_BAR();)
    norm_phase<false>(args, lds, bid, G, args.out, args.out, args.in[I_N1G], modl, 0, true, modl, true, nullptr);
    DG(GRID_BAR(); dg_combine(args, 39, modl);)
}

__global__ void __launch_bounds__(NTHR, 2) mega_fwd(Args args) {
    extern __shared__ __attribute__((aligned(16))) unsigned char lds_raw[];
    LAS unsigned char* lds = (LAS unsigned char*)lds_raw;
    const int tid = threadIdx.x, bid = blockIdx.x, G = gridDim.x;
    unsigned char* ws = args.ws;
    volatile LAS unsigned* MISC = (volatile LAS unsigned*)(lds + MISC_OFF);
    if (tid < 64) MISC[tid] = 0u;
    __syncthreads();
    XcdBarrier bar = xcd_barrier_post((unsigned*)(ws + WS_CTL) + CW_BAR, MISC + 8);

    prologue_phase(args, lds, bid, G);
    GRID_BAR();

    run_mixer<0>(args, lds, bid, G, bar);
    run_ffn<0>(args, lds, bid, G, bar);
    run_mixer<1>(args, lds, bid, G, bar);
    run_ffn<1>(args, lds, bid, G, bar);
    run_mixer<2>(args, lds, bid, G, bar);
    run_ffn<2>(args, lds, bid, G, bar);
    run_mixer<3>(args, lds, bid, G, bar);
    run_ffn<3>(args, lds, bid, G, bar);
    final_combine(args, lds, bid, G, bar);
    DG(GRID_BAR(); dg_final(args, 49);)
}

extern "C" void kernel_launch(void* const* d_in, const int* in_sizes, int n_in, void* d_out, int out_size, void* d_ws, size_t ws_size, hipStream_t stream) {
    static int grid = 0;
    if (grid == 0) {
        if (n_in != 30 || out_size != MTOK * DM || ws_size < WS_NEED) { fprintf(stderr, "kernel_launch: unexpected shapes (n_in %d out %d ws %zu need %zu)\n", n_in, out_size, ws_size, (size_t)WS_NEED); grid = -1; return; }
        int dev = 0, cus = 0;
        if (hipGetDevice(&dev) != hipSuccess || hipDeviceGetAttribute(&cus, hipDeviceAttributeMultiprocessorCount, dev) != hipSuccess) { grid = -1; return; }
        if (hipFuncSetAttribute((const void*)mega_fwd, hipFuncAttributeMaxDynamicSharedMemorySize, LDS_BYTES) != hipSuccess) { fprintf(stderr, "kernel_launch: hipFuncSetAttribute failed\n"); grid = -1; return; }
        int per_cu = 0;
        if (hipOccupancyMaxActiveBlocksPerMultiprocessor(&per_cu, (const void*)mega_fwd, NTHR, LDS_BYTES) != hipSuccess || per_cu < 1) { fprintf(stderr, "kernel_launch: occupancy query says %d\n", per_cu); }
        (void)hipGetLastError();
        grid = (cus >= 256) ? 256 : -1;
        if (grid < 0) { fprintf(stderr, "kernel_launch: needs 256 CUs, device has %d\n", cus); return; }
    }
    if (grid < 0) return;
    if (hipMemsetAsync((char*)d_ws + WS_CTL, 0, CTL_ZERO_BYTES, stream) != hipSuccess) return;
    Args a{};
    for (int i = 0; i < 30; ++i) a.in[i] = (const float*)d_in[i];
    a.out = (float*)d_out; a.ws = (unsigned char*)d_ws;
    hipLaunchKernelGGL(mega_fwd, dim3(grid), dim3(NTHR), LDS_BYTES, stream, a);
}
```

```cpp
#define DIAG_FROM 2
#include <hip/hip_runtime.h>
#include <cstdio>
#include <cstdint>

#define LAS __attribute__((address_space(3)))
#define GAS __attribute__((address_space(1)))
typedef unsigned short bf16_t;
typedef short bf16x8 __attribute__((ext_vector_type(8)));
typedef short s16x4 __attribute__((ext_vector_type(4)));
typedef float f32x2 __attribute__((ext_vector_type(2)));
typedef float f32x4 __attribute__((ext_vector_type(4)));
typedef float f32x16 __attribute__((ext_vector_type(16)));
typedef unsigned u32x2 __attribute__((ext_vector_type(2)));
typedef unsigned u32x4 __attribute__((ext_vector_type(4)));

constexpr int MTOK = 65536, DM = 1024, SEQ = 8192, NBATCH = 8, DEPTH = 4;
constexpr int DFF = 2816, DFFE = 3584, NEXP = 8, LRUW = 1280;
constexpr float EPS = 1e-6f;
constexpr int FP8_DENSE_FROM = 2;
constexpr float MOE_WSCALE = 64.0f, MOE_HSCALE = 4.0f;
constexpr float LOG2E = 1.4426950408889634f;

constexpr size_t MiB = 1u << 20;
constexpr size_t WS_CTL = 0, CTL_ZERO_BYTES = 1 * MiB;
constexpr size_t WS_TAB = 1 * MiB;
constexpr size_t TB_MODS = WS_TAB;
constexpr size_t TB_COS = WS_TAB + 1 * MiB;
constexpr size_t TB_SIN = WS_TAB + 2 * MiB;
constexpr size_t TB_SCAL = WS_TAB + 3 * MiB;
constexpr size_t TB_LB = TB_SCAL + 4096;
constexpr size_t TB_SP = TB_SCAL + 16384;
constexpr size_t TB_EID = WS_TAB + 4 * MiB;
constexpr size_t TB_GATE = WS_TAB + 5 * MiB;
constexpr size_t TB_SLOT = WS_TAB + 6 * MiB;
constexpr size_t TB_BCNT = WS_TAB + 7 * MiB;
constexpr size_t TB_TILES = TB_BCNT + 16384;
constexpr size_t TB_LSUM = WS_TAB + 8 * MiB;
constexpr size_t TB_LCIN = WS_TAB + 16 * MiB;
constexpr size_t WS_W = 32 * MiB;
constexpr size_t W_QKV = WS_W;
constexpr size_t W_AO = W_QKV + 2 * (size_t)3072 * 1024 * 2;
constexpr size_t W_HGI = W_AO + 2 * (size_t)1024 * 1024 * 2;
constexpr size_t W_HGO = W_HGI + (size_t)5120 * 1024 * 2;
constexpr size_t W_LRI = W_HGO + (size_t)1024 * 1024 * 2;
constexpr size_t W_LRG = W_LRI + (size_t)2560 * 1024 * 2;
constexpr size_t W_LRO = W_LRG + (size_t)10 * 2 * 256 * 128 * 2;
constexpr size_t W_FGU = W_LRO + (size_t)1024 * 1280 * 2;
constexpr size_t W_FDN = W_FGU + 2 * (size_t)5632 * 1024 * 2;
constexpr size_t W_MGU = W_FDN + 2 * (size_t)1024 * 2816 * 2;
constexpr size_t W_MDN = W_MGU + 16 * (size_t)7168 * 1024 * 2;
constexpr size_t W_END = W_MDN + 16 * (size_t)1024 * 3584 * 2;
constexpr size_t WS_HM = 440 * MiB;
constexpr size_t WS_ACT = 568 * MiB;
static_assert(W_END <= WS_HM, "weights overflow");
constexpr size_t SZ_TOK = (size_t)MTOK * 1024 * 2;
constexpr size_t A_Q = WS_ACT, A_K = A_Q + SZ_TOK, A_V = A_K + SZ_TOK, A_VT = A_V + SZ_TOK;
constexpr size_t F_HID = WS_ACT;
constexpr size_t H_Q = WS_ACT, H_LFF = H_Q + SZ_TOK, H_LFB = H_LFF + SZ_TOK, H_V = H_LFB + SZ_TOK, H_G = H_V + SZ_TOK, H_OF = H_G + SZ_TOK, H_OB = H_OF + SZ_TOK;
constexpr size_t SZ_LRU = (size_t)MTOK * 1280 * 2;
constexpr size_t L_YB = WS_ACT, L_XB = L_YB + SZ_LRU, L_HF = L_XB + SZ_LRU, L_HY = L_HF + SZ_LRU;
constexpr int MOE_ROWS = 2 * MTOK + NEXP * 256;
constexpr size_t E_XS = WS_ACT, E_HID = E_XS + (size_t)MOE_ROWS * 1024 * 2, E_END = E_HID + (size_t)MOE_ROWS * DFFE * 2;
constexpr size_t WS_NEED = E_END;
static_assert(WS_NEED <= (size_t)1792 * MiB, "workspace");

constexpr int CW_BAR = 4096;

constexpr int RING_BYTES = 135168;
constexpr int MISC_OFF = RING_BYTES;
constexpr int LDS_BYTES = 147456;
constexpr int NWAVES = 8, NTHR = 512;

typedef __bf16 bf16x2v __attribute__((ext_vector_type(2)));
__device__ __forceinline__ unsigned cvt_pk_bf16(float lo, float hi) { const f32x2 v = {lo, hi}; const bf16x2v b = __builtin_convertvector(v, bf16x2v); return __builtin_bit_cast(unsigned, b); }
__device__ __forceinline__ unsigned pk_fp8x4(float a, float b, float c, float d) { unsigned w = 0; w = __builtin_amdgcn_cvt_pk_fp8_f32(a, b, w, false); w = __builtin_amdgcn_cvt_pk_fp8_f32(c, d, w, true); return w; }
__device__ __forceinline__ unsigned f2bf(float f) { unsigned u = __builtin_bit_cast(unsigned, f); return (u + 0x7fffu + ((u >> 16) & 1u)) >> 16; }
__device__ __forceinline__ float bf2f(unsigned short b) { return __builtin_bit_cast(float, ((unsigned)b) << 16); }
__device__ __forceinline__ float bflo(unsigned w) { return __builtin_bit_cast(float, w << 16); }
__device__ __forceinline__ float bfhi(unsigned w) { return __builtin_bit_cast(float, w & 0xffff0000u); }
__device__ __forceinline__ float fexp2(float x) { return __builtin_amdgcn_exp2f(x); }
__device__ __forceinline__ float fexp(float x) { return __builtin_amdgcn_exp2f(x * LOG2E); }
__device__ __forceinline__ float frcp(float x) { return __builtin_amdgcn_rcpf(x); }
__device__ __forceinline__ float fsigmoid(float x) { return frcp(1.0f + fexp(-x)); }
__device__ __forceinline__ float fsilu(float x) { return x * fsigmoid(x); }
__device__ __forceinline__ float wave_sum(float v) {
#pragma unroll
    for (int o = 1; o < 64; o <<= 1) v += __shfl_xor(v, o);
    return v;
}
#define LDS_WAIT() asm volatile("s_waitcnt lgkmcnt(0)" ::: "memory")
#define VM_WAIT() asm volatile("s_waitcnt vmcnt(0)" ::: "memory")

#define XB_TMO      128
#define XB_XCNT(j)  (256  + 64 * (j))
#define XB_XSUB(j)  (1280 + 64 * (j))
#define XB_XGEN(j)  (2304 + 64 * (j))
#define XB_TOP      3328
#define XB_TOPGEN   3392
#define XCD_BAR_WORDS 3456
#define XB_SPIN_CAP (1u << 22)
__device__ __forceinline__ unsigned xb_ld(unsigned* p)              { return __hip_atomic_load(p, __ATOMIC_RELAXED, __HIP_MEMORY_SCOPE_AGENT); }
__device__ __forceinline__ unsigned xb_add(unsigned* p, unsigned v) { return __hip_atomic_fetch_add(p, v, __ATOMIC_RELAXED, __HIP_MEMORY_SCOPE_AGENT); }
__device__ __forceinline__ unsigned xb_xcc_id() { return (unsigned)__builtin_amdgcn_s_getreg((3 << 11) | 20) & 0xFu; }
#define XB_SPIN(cond, bar) do { unsigned _sp = 0; while (cond) { __builtin_amdgcn_s_sleep(1); \
    if ((++_sp & 255u) == 0u) { if (xb_ld(&(bar)[XB_TMO])) break; if (_sp > XB_SPIN_CAP) { atomicAdd(&(bar)[XB_TMO], 1u); break; } } } } while (0)
struct XcdBarrier { unsigned* bar; unsigned x; volatile LAS unsigned* st; };
__device__ __forceinline__ XcdBarrier xcd_barrier_post(unsigned* bar, volatile LAS unsigned* st) {
    XcdBarrier b; b.bar = bar; b.x = xb_xcc_id(); b.st = st;
    if (threadIdx.x == 0) (void)xb_add(&bar[XB_XCNT(b.x)], 1u);
    return b;
}
__device__ __forceinline__ void xcd_barrier_complete(unsigned* bar, unsigned x, unsigned& nloc, unsigned& nx) {
    const unsigned G = gridDim.x * gridDim.y * gridDim.z;
    unsigned sum, cnt, mine, sp = 0u;
    for (;;) {
        sum = 0u; cnt = 0u; mine = 0u;
#pragma unroll
        for (unsigned j = 0; j < 16; ++j) { const unsigned c = xb_ld(&bar[XB_XCNT(j)]); sum += c; cnt += (c > 0u) ? 1u : 0u; mine = (j == x) ? c : mine; }
        if (sum == G) break;
        __builtin_amdgcn_s_sleep(1);
        if ((++sp & 255u) == 0u) { if (xb_ld(&bar[XB_TMO])) break; if (sp > XB_SPIN_CAP) { atomicAdd(&bar[XB_TMO], 1u); break; } }
    }
    nloc = mine > 0u ? mine : 1u; nx = cnt > 0u ? cnt : 1u;
}
__device__ __forceinline__ void xcd_barrier(const XcdBarrier& b) {
    asm volatile("s_waitcnt vmcnt(0)" ::: "memory");
    __syncthreads();
    if (threadIdx.x == 0) {
        unsigned* bar = b.bar;
        __builtin_amdgcn_s_waitcnt(0);
        unsigned nloc = b.st[0], nx = b.st[1];
        if (nloc == 0u) { xcd_barrier_complete(bar, b.x, nloc, nx); b.st[0] = nloc; b.st[1] = nx; }
        const unsigned old = xb_add(&bar[XB_XSUB(b.x)], 1u);
        const unsigned gen = old / nloc;
        if (old + 1u == (gen + 1u) * nloc) {
            __builtin_amdgcn_fence(__ATOMIC_RELEASE, "agent");
            asm volatile("s_waitcnt vmcnt(0)" ::: "memory");
            const unsigned og = xb_add(&bar[XB_TOP], 1u);
            const unsigned tg = og / nx;
            if (og + 1u == (tg + 1u) * nx) xb_add(&bar[XB_TOPGEN], 1u);
            else XB_SPIN(xb_ld(&bar[XB_TOPGEN]) == tg, bar);
            __builtin_amdgcn_fence(__ATOMIC_ACQUIRE, "agent");
            xb_add(&bar[XB_XGEN(b.x)], 1u);
            asm volatile("s_waitcnt vmcnt(0)" ::: "memory");
        } else {
            XB_SPIN(xb_ld(&bar[XB_XGEN(b.x)]) == gen, bar);
            __builtin_amdgcn_fence(__ATOMIC_ACQUIRE, "agent");
            asm volatile("s_waitcnt vmcnt(0)" ::: "memory");
        }
    }
    __syncthreads();
}

namespace pg8 {
constexpr int BM = 256, BK = 64, HALF = 128, HTB = HALF * BK * 2, STAGE_BYTES = 8 * HTB, NXCD = 8, WGM = 8;
__host__ __device__ __forceinline__ int lds_byte(int r, int c) { const int st = (r >> 4) * 2 + (c >> 5), rr = r & 15, cc = c & 31, ob = rr * 64 + cc * 2; return st * 1024 + (ob ^ (((ob >> 9) & 1) << 5)); }
__host__ __device__ __forceinline__ void stage_rc(int b, int& R, int& C) { const int st = b / 1024, sb = b % 1024, swz = sb ^ (((sb >> 9) & 1) << 5); R = (st >> 1) * 16 + swz / 64; C = (st & 1) * 32 + (swz % 64) / 2; }
__host__ __device__ __forceinline__ int perm32(int rho) { const int n = rho >> 4, i = rho & 15; return 8 * (i >> 2) + 4 * n + (i & 3); }

struct Unit { int pm, pn, pb; };
struct Gemm { const bf16_t* A; const bf16_t* Bt; int K; };

struct TileOrder {
    int nM, nN, nwg, G, c; int ts[NEXP];
    __device__ __forceinline__ void init(int nM_, int nN_, int G_, int c_) { nM = nM_; nN = nN_; nwg = nM * nN; G = G_; c = c_;
#pragma unroll
        for (int e = 0; e < NEXP; ++e) ts[e] = (e == 0) ? 0 : 0x7fffffff; }
    __device__ __forceinline__ bool next(int i, Unit& u) const {
        const long L = (long)i * G + c; if (L >= nwg) return false;
        int wgid = (int)L; { const int q = nwg / NXCD, r = nwg % NXCD, xcd = wgid % NXCD, off = wgid / NXCD; wgid = (xcd < r ? xcd * (q + 1) : r * (q + 1) + (xcd - r) * q) + off; }
        const int nig = WGM * nN, gid = wgid / nig, fm = gid * WGM, gsz = (nM - fm) < WGM ? (nM - fm) : WGM;
        u.pm = fm + ((wgid % nig) % gsz); u.pn = (wgid % nig) / gsz;
        int e = 0;
#pragma unroll
        for (int k = 1; k < NEXP; ++k) e += (u.pm >= ts[k]) ? 1 : 0;
        u.pb = e * nN + u.pn; return true;
    }
};

typedef int v8i32 __attribute__((ext_vector_type(8)));
template <class Epi, bool FP8 = false>
__device__ __forceinline__ void gemm_phase(LAS unsigned char* lds, const Gemm g, const TileOrder& S, const Epi& E) {
    int tid_ = threadIdx.x; asm volatile("" : "+v"(tid_));
    const int tid = tid_, wid = __builtin_amdgcn_readfirstlane(tid >> 6), lane = tid & 63, wr = wid >> 2, wc = wid & 3, fr = lane & 15, fq = lane >> 4;
    const int K = g.K, nt = K / BK;
    unsigned voffA[2], voffB[2];
#pragma unroll
    for (int i = 0; i < 2; ++i) { int R, C; stage_rc(tid * 16 + i * 8192, R, C); const int Rb = Epi::PERM ? ((R & ~31) + perm32(R & 31)) : R;
        voffA[i] = (unsigned)(R * K + C) * 2u; voffB[i] = (unsigned)(Rb * K + C) * 2u; }
    const size_t kstep = (size_t)(BK * 2);
    const size_t hstep = (size_t)HALF * K * 2;
    const size_t tstep = 2 * hstep;
    const unsigned ldsw = (unsigned)wid * 1024u;
    const int aoff = lds_byte(wr * 64 + fr, fq * 8), boff = lds_byte(wc * 32 + fr, fq * 8);
#define PG8_SA(b, h) (((b) * 2 + (h)) * HTB)
#define PG8_SB(b, h) ((4 + (b) * 2 + (h)) * HTB)
#define PG8_STAGE(bufoff, gbase, voff) do { _Pragma("unroll") for (int _i = 0; _i < 2; ++_i) \
        __builtin_amdgcn_global_load_lds((const unsigned*)((const char*)(gbase) + (voff)[_i]), (LAS unsigned*)(lds + (bufoff) + ldsw + _i * 8192), 16, 0, 0); } while (0)
#define PG8_LD8(p) __builtin_bit_cast(v8i32, __builtin_shufflevector(*(const LAS u32x4*)(p), *(const LAS u32x4*)((p) + 1024), 0, 1, 2, 3, 4, 5, 6, 7))
#define PG8_LDA(dst, b, h) do { if constexpr (FP8) { _Pragma("unroll") for (int m = 0; m < 4; ++m) dst##8[m] = PG8_LD8(lds + PG8_SA(b, h) + aoff + m * 2048); } \
        else { _Pragma("unroll") for (int m = 0; m < 4; ++m) _Pragma("unroll") for (int k = 0; k < 2; ++k) dst[m][k] = *(const LAS bf16x8*)(lds + PG8_SA(b, h) + aoff + m * 2048 + k * 1024); } } while (0)
#define PG8_LDB(dst, b, h) do { if constexpr (FP8) { _Pragma("unroll") for (int n = 0; n < 2; ++n) dst##8[n] = PG8_LD8(lds + PG8_SB(b, h) + boff + n * 2048); } \
        else { _Pragma("unroll") for (int n = 0; n < 2; ++n) _Pragma("unroll") for (int k = 0; k < 2; ++k) dst[n][k] = *(const LAS bf16x8*)(lds + PG8_SB(b, h) + boff + n * 2048 + k * 1024); } } while (0)
#define PG8_MMA(ai, bj, At, Bt) do { __builtin_amdgcn_s_setprio(1); \
        if constexpr (FP8) { _Pragma("unroll") for (int m = 0; m < 4; ++m) _Pragma("unroll") for (int n = 0; n < 2; ++n) \
            asm volatile("v_mfma_scale_f32_16x16x128_f8f6f4 %0, %1, %2, %0, %3, %3 op_sel_hi:[0,0,0]" : "+v"(acc[ai][bj][m][n]) : "v"(Bt##8[n]), "v"(At##8[m]), "v"(one_scale)); } \
        else { _Pragma("unroll") for (int m = 0; m < 4; ++m) _Pragma("unroll") for (int n = 0; n < 2; ++n) _Pragma("unroll") for (int k = 0; k < 2; ++k) \
            acc[ai][bj][m][n] = __builtin_amdgcn_mfma_f32_16x16x32_bf16(Bt[n][k], At[m][k], acc[ai][bj][m][n], 0, 0, 0); } \
        __builtin_amdgcn_s_setprio(0); } while (0)
#define PG8_WAIT_V(n) asm volatile("s_waitcnt vmcnt(" #n ")" ::: "memory")
#define PG8_WAIT_L(n) asm volatile("s_waitcnt lgkmcnt(" #n ")" ::: "memory")
#define PG8_BAR __builtin_amdgcn_s_barrier()
#define PG8_SCHED __builtin_amdgcn_sched_barrier(0)
    Unit cur, nxt; int ui = 0;
    if (!S.next(0, cur)) return;
    f32x4 acc[2][2][4][2];
#pragma unroll
    for (int a = 0; a < 2; ++a)
#pragma unroll
        for (int b = 0; b < 2; ++b)
#pragma unroll
            for (int m = 0; m < 4; ++m)
#pragma unroll
                for (int n = 0; n < 2; ++n) acc[a][b][m][n] = (f32x4){0.f, 0.f, 0.f, 0.f};
    bf16x8 At[4][2], B0[2][2], B1[2][2]; v8i32 At8[4], B08[2], B18[2];
    int one_scale = 0x7f7f7f7f; asm volatile("" : "+v"(one_scale));
    const char* cA = (const char*)g.A + (size_t)cur.pm * tstep; const char* cB = (const char*)g.Bt + (size_t)cur.pb * tstep;
    PG8_STAGE(PG8_SB(0, 0), cB, voffB); PG8_STAGE(PG8_SA(0, 0), cA, voffA); PG8_STAGE(PG8_SB(0, 1), cB + hstep, voffB); PG8_STAGE(PG8_SA(0, 1), cA + hstep, voffA);
    if (wr == 1) PG8_BAR;
    PG8_WAIT_V(4); PG8_BAR;
    PG8_STAGE(PG8_SB(1, 0), cB + kstep, voffB); PG8_STAGE(PG8_SA(1, 0), cA + kstep, voffA); PG8_STAGE(PG8_SB(1, 1), cB + hstep + kstep, voffB);
    PG8_WAIT_V(6); PG8_BAR;
    for (;;) {
        const bool has_next = S.next(ui + 1, nxt);
        const char* nA = has_next ? (const char*)g.A + (size_t)nxt.pm * tstep : cA; const char* nB = has_next ? (const char*)g.Bt + (size_t)nxt.pb * tstep : cB;
        for (int t = 0; t < nt; t += 2) {
            const bool last = (t == nt - 2);
            const char* a1 = cA + (size_t)(t + 1) * kstep;
            const char* a2 = last ? nA : cA + (size_t)(t + 2) * kstep; const char* b2 = last ? nB : cB + (size_t)(t + 2) * kstep;
            const char* a3 = a2 + kstep; const char* b3 = b2 + kstep;
            PG8_LDB(B0, 0, 0); PG8_SCHED; PG8_LDA(At, 0, 0); PG8_STAGE(PG8_SA(1, 1), a1 + hstep, voffA);
            PG8_WAIT_L(8); PG8_BAR; PG8_WAIT_L(0); PG8_MMA(0, 0, At, B0); PG8_BAR; PG8_SCHED;
            PG8_LDB(B1, 0, 1); PG8_STAGE(PG8_SB(0, 0), b2, voffB);
            PG8_BAR; PG8_WAIT_L(0); PG8_MMA(0, 1, At, B1); PG8_BAR;
            PG8_LDA(At, 0, 1); PG8_STAGE(PG8_SA(0, 0), a2, voffA);
            PG8_BAR; PG8_WAIT_L(0); PG8_MMA(1, 0, At, B0); PG8_BAR; PG8_SCHED;
            PG8_STAGE(PG8_SB(0, 1), b2 + hstep, voffB);
            PG8_WAIT_V(6); PG8_BAR; PG8_MMA(1, 1, At, B1); PG8_BAR;
            PG8_LDB(B0, 1, 0); PG8_SCHED; PG8_LDA(At, 1, 0); PG8_STAGE(PG8_SA(0, 1), a2 + hstep, voffA);
            PG8_WAIT_L(8); PG8_BAR; PG8_WAIT_L(0); PG8_MMA(0, 0, At, B0); PG8_BAR; PG8_SCHED;
            PG8_LDB(B1, 1, 1); PG8_STAGE(PG8_SB(1, 0), b3, voffB);
            PG8_BAR; PG8_WAIT_L(0); PG8_MMA(0, 1, At, B1); PG8_BAR;
            PG8_LDA(At, 1, 1); PG8_STAGE(PG8_SA(1, 0), a3, voffA);
            PG8_BAR; PG8_WAIT_L(0); PG8_MMA(1, 0, At, B0); PG8_BAR; PG8_SCHED;
            PG8_STAGE(PG8_SB(1, 1), b3 + hstep, voffB);
            PG8_WAIT_V(6); PG8_BAR; PG8_MMA(1, 1, At, B1); PG8_BAR;
        }
        if constexpr (FP8) asm volatile("s_nop 15\n\ts_nop 15" ::: "memory");
        E(acc, cur, wr, wc, fr, fq);
        if (!has_next) break;
#pragma unroll
        for (int a = 0; a < 2; ++a)
#pragma unroll
            for (int b = 0; b < 2; ++b)
#pragma unroll
                for (int m = 0; m < 4; ++m)
#pragma unroll
                    for (int n = 0; n < 2; ++n) acc[a][b][m][n] = (f32x4){0.f, 0.f, 0.f, 0.f};
        cur = nxt; cA = nA; cB = nB; ++ui;
    }
    PG8_WAIT_V(0);
    if (wr == 0) PG8_BAR;
    PG8_BAR;
#undef PG8_SA
#undef PG8_SB
#undef PG8_STAGE
#undef PG8_LDA
#undef PG8_LDB
#undef PG8_MMA
#undef PG8_LD8
#undef PG8_WAIT_V
#undef PG8_WAIT_L
#undef PG8_BAR
#undef PG8_SCHED
}

struct EpiQKV {
    static constexpr bool PERM = true;
    bf16_t *Q, *Kk, *V; const float *gq, *gk, *cosT, *sinT; float qscale;
    __device__ __forceinline__ void operator()(const f32x4 (&acc)[2][2][4][2], const Unit& u, int wr, int wc, int fr, int fq) const {
        const int row0 = u.pm * BM + wr * 64 + fr;
        if (u.pn >= 8) {
            const int col0 = (u.pn - 8) * BM + wc * 32 + 8 * fq;
#pragma unroll
            for (int ai = 0; ai < 2; ++ai)
#pragma unroll
                for (int m = 0; m < 4; ++m) { bf16_t* rowp = V + (size_t)(row0 + ai * HALF + m * 16) * DM + col0;
#pragma unroll
                    for (int bj = 0; bj < 2; ++bj) { const f32x4 v0 = acc[ai][bj][m][0], v1 = acc[ai][bj][m][1];
                        u32x4 w; w.x = cvt_pk_bf16(v0[0], v0[1]); w.y = cvt_pk_bf16(v0[2], v0[3]); w.z = cvt_pk_bf16(v1[0], v1[1]); w.w = cvt_pk_bf16(v1[2], v1[3]);
                        *(u32x4*)(rowp + bj * HALF) = w; } }
        } else {
            const int part = u.pn >> 2, sh = 4 * (u.pn & 3) + wc;
            bf16_t* dst = part ? Kk : Q; const float* g = part ? gk : gq; const float sc = part ? 1.0f : qscale;
            f32x4 g0[2], g1[2];
#pragma unroll
            for (int n = 0; n < 2; ++n) { g0[n] = *(const f32x4*)(g + 8 * fq + 4 * n); g1[n] = *(const f32x4*)(g + 32 + 8 * fq + 4 * n); }
#pragma unroll
            for (int ai = 0; ai < 2; ++ai)
#pragma unroll
                for (int m = 0; m < 4; ++m) {
                    const int r = row0 + ai * HALF + m * 16; const int pos = r & (SEQ - 1);
                    f32x4 x1[2], x2[2]; float ss = 0.f;
#pragma unroll
                    for (int n = 0; n < 2; ++n) { x1[n] = acc[ai][0][m][n]; x2[n] = acc[ai][1][m][n];
                        ss += (x1[n][0] * x1[n][0] + x1[n][1] * x1[n][1]) + (x1[n][2] * x1[n][2] + x1[n][3] * x1[n][3]);
                        ss += (x2[n][0] * x2[n][0] + x2[n][1] * x2[n][1]) + (x2[n][2] * x2[n][2] + x2[n][3] * x2[n][3]); }
                    ss += __shfl_xor(ss, 16); ss += __shfl_xor(ss, 32);
                    const float rstd = __builtin_amdgcn_rsqf(ss * (1.0f / 64.0f) + EPS) ;
                    unsigned char* op = (unsigned char*)dst + (size_t)r * DM + sh * 64 + 8 * fq;
                    u32x2 w1, w2;
#pragma unroll
                    for (int n = 0; n < 2; ++n) {
                        const f32x4 cs = *(const f32x4*)(cosT + pos * 32 + 8 * fq + 4 * n), sn = *(const f32x4*)(sinT + pos * 32 + 8 * fq + 4 * n);
                        const f32x4 y1 = x1[n] * rstd * g0[n], y2 = x2[n] * rstd * g1[n];
                        const f32x4 o1 = (y1 * cs - y2 * sn) * sc, o2 = (y2 * cs + y1 * sn) * sc;
                        if (n == 0) { w1.x = pk_fp8x4(o1[0], o1[1], o1[2], o1[3]); w2.x = pk_fp8x4(o2[0], o2[1], o2[2], o2[3]); }
                        else { w1.y = pk_fp8x4(o1[0], o1[1], o1[2], o1[3]); w2.y = pk_fp8x4(o2[0], o2[1], o2[2], o2[3]); }
                    }
                    *(u32x2*)(op) = w1; *(u32x2*)(op + 32) = w2;
                }
        }
    }
};
struct EpiRes {
    static constexpr bool PERM = false;
    const float* xin; float* xout; const float* gate; float sc;
    __device__ __forceinline__ void operator()(const f32x4 (&acc)[2][2][4][2], const Unit& u, int wr, int wc, int fr, int fq) const {
        const int row0 = u.pm * BM + wr * 64 + fr, col0 = u.pn * BM + wc * 32 + 4 * fq;
        const float* gp = gate + (size_t)(u.pm >> 5) * 6144 + col0;
        f32x4 gv[2][2];
#pragma unroll
        for (int bj = 0; bj < 2; ++bj)
#pragma unroll
            for (int n = 0; n < 2; ++n) gv[bj][n] = *(const f32x4*)(gp + bj * HALF + n * 16) * sc;
#pragma unroll
        for (int ai = 0; ai < 2; ++ai)
#pragma unroll
            for (int m = 0; m < 4; ++m) { const size_t off = (size_t)(row0 + ai * HALF + m * 16) * DM + col0;
#pragma unroll
                for (int bj = 0; bj < 2; ++bj)
#pragma unroll
                    for (int n = 0; n < 2; ++n) { const f32x4 xv = *(const f32x4*)(xin + off + bj * HALF + n * 16);
                        *(f32x4*)(xout + off + bj * HALF + n * 16) = xv + gv[bj][n] * acc[ai][bj][m][n]; }
                asm volatile("" ::: "memory"); }
    }
};
struct EpiSwiGLU {
    static constexpr bool PERM = true;
    bf16_t* H; int ldh;
    __device__ __forceinline__ void operator()(const f32x4 (&acc)[2][2][4][2], const Unit& u, int wr, int wc, int fr, int fq) const {
        const int row0 = u.pm * BM + wr * 64 + fr, col0 = u.pn * HALF + wc * 32 + 8 * fq;
#pragma unroll
        for (int ai = 0; ai < 2; ++ai)
#pragma unroll
            for (int m = 0; m < 4; ++m) { bf16_t* rowp = H + (size_t)(row0 + ai * HALF + m * 16) * ldh + col0;
                f32x4 v[2];
#pragma unroll
                for (int n = 0; n < 2; ++n) { const f32x4 gt = acc[ai][0][m][n], up = acc[ai][1][m][n];
#pragma unroll
                    for (int j = 0; j < 4; ++j) v[n][j] = fsilu(gt[j]) * up[j]; }
                u32x4 w; w.x = cvt_pk_bf16(v[0][0], v[0][1]); w.y = cvt_pk_bf16(v[0][2], v[0][3]); w.z = cvt_pk_bf16(v[1][0], v[1][1]); w.w = cvt_pk_bf16(v[1][2], v[1][3]);
                *(u32x4*)rowp = w; }
    }
};
struct EpiSwiGLU8 {
    static constexpr bool PERM = true;
    unsigned char* H; int ldh; float ws, hs;
    __device__ __forceinline__ void operator()(const f32x4 (&acc)[2][2][4][2], const Unit& u, int wr, int wc, int fr, int fq) const {
        const int row0 = u.pm * BM + wr * 64 + fr, col0 = u.pn * HALF + wc * 32 + 8 * fq;
#pragma unroll
        for (int ai = 0; ai < 2; ++ai)
#pragma unroll
            for (int m = 0; m < 4; ++m) { unsigned char* rowp = H + (size_t)(row0 + ai * HALF + m * 16) * ldh + col0;
                f32x4 v[2];
#pragma unroll
                for (int n = 0; n < 2; ++n) { const f32x4 gt = acc[ai][0][m][n] * ws, up = acc[ai][1][m][n] * (ws * hs);
#pragma unroll
                    for (int j = 0; j < 4; ++j) v[n][j] = fsilu(gt[j]) * up[j]; }
                *(u32x2*)rowp = (u32x2){pk_fp8x4(v[0][0], v[0][1], v[0][2], v[0][3]), pk_fp8x4(v[1][0], v[1][1], v[1][2], v[1][3])}; }
    }
};
struct EpiPlain {
    static constexpr bool PERM = true;
    bf16_t* O; int ldc; float sc;
    __device__ __forceinline__ void operator()(const f32x4 (&acc)[2][2][4][2], const Unit& u, int wr, int wc, int fr, int fq) const {
        const int row0 = u.pm * BM + wr * 64 + fr, col0 = u.pn * BM + wc * 32 + 8 * fq;
#pragma unroll
        for (int ai = 0; ai < 2; ++ai)
#pragma unroll
            for (int m = 0; m < 4; ++m) { bf16_t* rowp = O + (size_t)(row0 + ai * HALF + m * 16) * ldc + col0;
#pragma unroll
                for (int bj = 0; bj < 2; ++bj) { const f32x4 v0 = acc[ai][bj][m][0] * sc, v1 = acc[ai][bj][m][1] * sc;
                    u32x4 w; w.x = cvt_pk_bf16(v0[0], v0[1]); w.y = cvt_pk_bf16(v0[2], v0[3]); w.z = cvt_pk_bf16(v1[0], v1[1]); w.w = cvt_pk_bf16(v1[2], v1[3]);
                    *(u32x4*)(rowp + bj * HALF) = w; } }
    }
};
struct EpiAct {
    static constexpr bool PERM = true;
    int kind; unsigned char* ws; const float* lb;
    __device__ __forceinline__ void operator()(const f32x4 (&acc)[2][2][4][2], const Unit& u, int wr, int wc, int fr, int fq) const {
        const int row0 = u.pm * BM + wr * 64 + fr;
        int mode, ldc, colt; size_t boff;
        if (kind == 0) { const int grp = u.pn >> 2; colt = (u.pn & 3) * 256; ldc = 1024;
            boff = grp == 0 ? H_Q : grp == 1 ? H_LFF : grp == 2 ? H_LFB : grp == 3 ? H_V : H_G; mode = (grp == 0 || grp == 4) ? 1 : (grp == 3 ? 0 : 3); }
        else { ldc = LRUW; if (u.pn < 5) { boff = L_YB; colt = u.pn * 256; mode = 2; } else { boff = L_XB; colt = (u.pn - 5) * 256; mode = 0; } }
        bf16_t* base = (bf16_t*)(ws + boff);
        const int col0 = colt + wc * 32 + 8 * fq;
        f32x4 lbv[2][2];
        if (mode == 3) { const float* lp = lb + ((u.pn >> 2) - 1) * 1024 + col0;
#pragma unroll
            for (int bj = 0; bj < 2; ++bj)
#pragma unroll
                for (int n = 0; n < 2; ++n) lbv[bj][n] = *(const f32x4*)(lp + bj * HALF + 4 * n); }
#pragma unroll
        for (int ai = 0; ai < 2; ++ai)
#pragma unroll
            for (int m = 0; m < 4; ++m) { bf16_t* rowp = base + (size_t)(row0 + ai * HALF + m * 16) * ldc + col0;
#pragma unroll
                for (int bj = 0; bj < 2; ++bj) { f32x4 v[2]; u32x4 w;
#pragma unroll
                    for (int n = 0; n < 2; ++n) { v[n] = acc[ai][bj][m][n];
                        if (mode == 1) {
#pragma unroll
                            for (int j = 0; j < 4; ++j) v[n][j] = fsilu(v[n][j]); }
                        else if (mode == 2) {
#pragma unroll
                            for (int j = 0; j < 4; ++j) { const float x = v[n][j]; v[n][j] = x * fsigmoid(1.5957691216057308f * (x + 0.044715f * x * x * x)); } }
                        else if (mode == 3) {
#pragma unroll
                            for (int j = 0; j < 4; ++j) { const float l = lbv[bj][n][j]; const float fg = l + (1.0f - l) * fsigmoid(v[n][j]); v[n][j] = __builtin_amdgcn_logf(fg) * 0.6931471805599453f; } }
                    }
                    if (mode == 3) {
#pragma unroll
                        for (int n = 0; n < 2; ++n) { const _Float16 h0 = (_Float16)v[n][0], h1 = (_Float16)v[n][1], h2 = (_Float16)v[n][2], h3 = (_Float16)v[n][3];
                            const unsigned a = (unsigned)__builtin_bit_cast(unsigned short, h0) | ((unsigned)__builtin_bit_cast(unsigned short, h1) << 16);
                            const unsigned b = (unsigned)__builtin_bit_cast(unsigned short, h2) | ((unsigned)__builtin_bit_cast(unsigned short, h3) << 16);
                            if (n == 0) { w.x = a; w.y = b; } else { w.z = a; w.w = b; } }
                    } else { w.x = cvt_pk_bf16(v[0][0], v[0][1]); w.y = cvt_pk_bf16(v[0][2], v[0][3]); w.z = cvt_pk_bf16(v[1][0], v[1][1]); w.w = cvt_pk_bf16(v[1][2], v[1][3]); }
                    *(u32x4*)(rowp + bj * HALF) = w; } }
    }
};
}

struct Args { const float* in[30]; float* out; unsigned char* ws; };
enum { I_X = 0, I_C, I_ADAW, I_ADAB, I_N1G, I_N2G, I_ATWIN, I_ATQN, I_ATKN, I_ATLAM, I_ATSUB, I_ATWOUT, I_HGWIN, I_HGLB, I_HGNG, I_HGWOUT,
       I_LRWIN, I_LRCW, I_LRCB, I_LRWA, I_LRBA, I_LRWX, I_LRBX, I_LRLAM, I_LRWOUT, I_FFGU, I_FFDN, I_MOER, I_MOEGU, I_MOEDN };
enum { SC_LAM0 = 0, SC_LAM1, SC_OML0, SC_OML1, SC_MC0, SC_MC1 };

__device__ __forceinline__ void cvt_item(const float* W, int ldw, int src_col0, bf16_t* WT, int ldt, int dst_row0, int k0, LAS float* scr, int lane) {
#pragma unroll 8
    for (int i = 0; i < 32; ++i) { const int kk = 2 * i + (lane >> 5); scr[kk * 33 + (lane & 31)] = W[(size_t)(k0 + kk) * ldw + src_col0 + (lane & 31)]; }
    LDS_WAIT(); asm volatile("" ::: "memory");
    const int c = lane & 7;
#pragma unroll
    for (int j = 0; j < 4; ++j) { const int n = (lane >> 3) + 8 * j; const LAS float* s = scr + (8 * c) * 33 + n;
        u32x4 o; o.x = cvt_pk_bf16(s[0 * 33], s[1 * 33]); o.y = cvt_pk_bf16(s[2 * 33], s[3 * 33]); o.z = cvt_pk_bf16(s[4 * 33], s[5 * 33]); o.w = cvt_pk_bf16(s[6 * 33], s[7 * 33]);
        *(u32x4*)(WT + (size_t)(dst_row0 + n) * ldt + k0 + 8 * c) = o; }
    LDS_WAIT(); asm volatile("" ::: "memory");
}
__device__ __forceinline__ void cvt_item8(const float* W, int ldw, int src_col0, unsigned char* WT, int ldt, int dst_row0, int k0, float sc, LAS float* scr, int lane) {
#pragma unroll 8
    for (int i = 0; i < 32; ++i) { const int kk = 2 * i + (lane >> 5); scr[kk * 33 + (lane & 31)] = W[(size_t)(k0 + kk) * ldw + src_col0 + (lane & 31)]; }
    LDS_WAIT(); asm volatile("" ::: "memory");
    const int c = lane & 7;
#pragma unroll
    for (int j = 0; j < 4; ++j) { const int n = (lane >> 3) + 8 * j; const LAS float* s = scr + (8 * c) * 33 + n;
        *(u32x2*)(WT + (size_t)(dst_row0 + n) * ldt + k0 + 8 * c) = (u32x2){pk_fp8x4(s[0 * 33] * sc, s[1 * 33] * sc, s[2 * 33] * sc, s[3 * 33] * sc), pk_fp8x4(s[4 * 33] * sc, s[5 * 33] * sc, s[6 * 33] * sc, s[7 * 33] * sc)}; }
    LDS_WAIT(); asm volatile("" ::: "memory");
}
enum { MAP_ID = 0, MAP_QKV = 1, MAP_SWI = 2 };
template <bool F8 = false>
__device__ __forceinline__ void cvt_family(const float* src, size_t sstride, int ninst, int ldw, int K, int ng, int map, int F, bf16_t* dst, size_t dstride,
                                           LAS float* scr, int gw, int NGW, int lane) {
    const int nkb = K / 64, per = nkb * ng, total = ninst * per;
    for (int it = gw; it < total; it += NGW) {
        const int inst = it / per, r = it - inst * per, kb = r / ng, gi = r - kb * ng;
        int sc0;
        if (map == MAP_ID) sc0 = 32 * gi;
        else if (map == MAP_QKV) { const int pn = gi >> 3, bj = (gi >> 2) & 1, wc = gi & 3;
            if (pn < 8) { const int part = pn >> 2, sh = 4 * (pn & 3) + wc; sc0 = part * 1024 + sh * 64 + 32 * bj; } else sc0 = 32 * gi; }
        else { const int pn = gi >> 3, bj = (gi >> 2) & 1, q = gi & 3; sc0 = bj * F + pn * 128 + 32 * q; }
        if constexpr (F8) cvt_item8(src + (size_t)inst * sstride, ldw, sc0, (unsigned char*)dst + (size_t)inst * dstride, K, 32 * gi, 64 * kb, MOE_WSCALE, scr, lane);
        else cvt_item(src + (size_t)inst * sstride, ldw, sc0, dst + (size_t)inst * dstride, K, 32 * gi, 64 * kb, scr, lane);
    }
}

__device__ __forceinline__ void prologue_phase(const Args& A, LAS unsigned char* lds, int bid, int G) {
    const int tid = threadIdx.x, lane = tid & 63, wave = tid >> 6;
    unsigned char* ws = A.ws;
    {
        LAS float* sc = (LAS float*)lds;
        LAS float* red = (LAS float*)(lds + 32768);
        for (int i = tid; i < NBATCH * DM; i += NTHR) { const float cv = A.in[I_C][i]; sc[i] = fsilu(cv); }
        __syncthreads();
        float* mods = (float*)(ws + TB_MODS);
        for (int cb = bid; cb < (DEPTH * 6144) / 128; cb += G) {
            const int col = cb * 128 + (tid & 127), l = col / 6144, e = col - l * 6144, ch = tid >> 7;
            const float* wp = A.in[I_ADAW] + (size_t)l * DM * 6144 + e;
            float a[NBATCH];
#pragma unroll
            for (int b = 0; b < NBATCH; ++b) a[b] = 0.f;
#pragma unroll 4
            for (int d = ch * 256; d < ch * 256 + 256; ++d) { const float w = wp[(size_t)d * 6144];
#pragma unroll
                for (int b = 0; b < NBATCH; ++b) a[b] += sc[b * DM + d] * w; }
#pragma unroll
            for (int b = 0; b < NBATCH; ++b) red[(ch * 128 + (tid & 127)) * 8 + b] = a[b];
            __syncthreads();
            if (tid < 128) { const float bias = A.in[I_ADAB][l * 6144 + e];
#pragma unroll
                for (int b = 0; b < NBATCH; ++b) { const float s = ((red[(0 * 128 + tid) * 8 + b] + red[(1 * 128 + tid) * 8 + b]) + (red[(2 * 128 + tid) * 8 + b] + red[(3 * 128 + tid) * 8 + b])) + bias;
                    mods[((size_t)l * NBATCH + b) * 6144 + e] = s; } }
            __syncthreads();
        }
    }
    {
        float* cosT = (float*)(ws + TB_COS); float* sinT = (float*)(ws + TB_SIN);
        for (int i = bid * NTHR + tid; i < SEQ * 32; i += G * NTHR) {
            const int pos = i >> 5, d = i & 31;
            const float inv = (float)exp(-(double)d * (1.0 / 32.0) * 9.210340371976184);
            const float ang = (float)pos * inv;
            const double rev = (double)ang * 0.15915494309189535; const float fr = (float)(rev - floor(rev));
            cosT[i] = __builtin_amdgcn_cosf(fr); sinT[i] = __builtin_amdgcn_sinf(fr);
        }
        if (bid == 0 && tid < 2) {
            const int a = tid; const float* lm = A.in[I_ATLAM] + a * 256;
            float s1 = 0.f, s2 = 0.f; for (int i = 0; i < 64; ++i) { s1 += lm[i] * lm[64 + i]; s2 += lm[128 + i] * lm[192 + i]; }
            const float linit = 0.8f - 0.6f * expf(-0.3f * (float)(3 * a));
            float mq = 0.f, mk = 0.f; for (int i = 0; i < 64; ++i) { mq = fmaxf(mq, fabsf(A.in[I_ATQN][a * 64 + i])); mk = fmaxf(mk, fabsf(A.in[I_ATKN][a * 64 + i])); }
            float* scal = (float*)(ws + TB_SCAL);
            scal[SC_LAM0 + a] = expf(s1) - expf(s2) + linit; scal[SC_OML0 + a] = 1.0f - linit; scal[SC_MC0 + a] = 8.0f * mq * mk * LOG2E * 1.0001f;
        }
        if (bid == 1) {
            float* lb = (float*)(ws + TB_LB);
            for (int i = tid; i < 2 * 1024; i += NTHR) { const int d = i >> 10, k = i & 1023; const float* p = A.in[I_HGLB] + (size_t)d * DEPTH * 1024 + k;
                float mx = p[0]; for (int l = 1; l < DEPTH; ++l) mx = fmaxf(mx, p[l * 1024]);
                float den = 0.f, num = 0.f; for (int l = 0; l < DEPTH; ++l) { const float e = expf(p[l * 1024] - mx); den += e; if (l == 1) num += e; }
                lb[i] = num / den; }
        }
        if (bid == 2) {
            float* sp = (float*)(ws + TB_SP);
            for (int i = tid; i < 2 * LRUW; i += NTHR) { const float x = -A.in[I_LRLAM][i]; sp[i] = (x > 20.f) ? x : log1pf(expf(x)); }
        }
    }
    {
        LAS float* scr = (LAS float*)(lds + wave * 16384);
        const int vcu = (bid % 8) * (G / 8) + bid / 8;
        const int gw = vcu * NWAVES + wave, NGW = G * NWAVES;
        cvt_family(A.in[I_ATWIN], (size_t)1024 * 3072, 2, 3072, 1024, 96, MAP_QKV, 0, (bf16_t*)(ws + W_QKV), (size_t)3072 * 1024, scr, gw, NGW, lane);
        cvt_family(A.in[I_ATWOUT], (size_t)1024 * 1024, 2, 1024, 1024, 32, MAP_ID, 0, (bf16_t*)(ws + W_AO), (size_t)1024 * 1024, scr, gw, NGW, lane);
        cvt_family(A.in[I_HGWIN], 0, 1, 5120, 1024, 160, MAP_ID, 0, (bf16_t*)(ws + W_HGI), 0, scr, gw, NGW, lane);
        cvt_family(A.in[I_HGWOUT], 0, 1, 1024, 1024, 32, MAP_ID, 0, (bf16_t*)(ws + W_HGO), 0, scr, gw, NGW, lane);
        cvt_family(A.in[I_LRWIN], 0, 1, 2560, 1024, 80, MAP_ID, 0, (bf16_t*)(ws + W_LRI), 0, scr, gw, NGW, lane);
        cvt_family(A.in[I_LRWOUT], 0, 1, 1024, 1280, 32, MAP_ID, 0, (bf16_t*)(ws + W_LRO), 0, scr, gw, NGW, lane);
        for (int it = gw; it < 2 * 20 * 2 * 4; it += NGW) {
            const int part = it / 160, r = it % 160, inst = r >> 3, kb = (r >> 2) & 1, gi = r & 3, d = inst / 10, n = inst % 10;
            const float* src = (part ? A.in[I_LRWX] : A.in[I_LRWA]) + (size_t)inst * 16384;
            cvt_item(src, 128, 32 * gi, (bf16_t*)(ws + W_LRG) + (size_t)(n * 2 + d) * 256 * 128, 128, part * 128 + 32 * gi, 64 * kb, scr, lane);
        }
        static_assert(FP8_DENSE_FROM == 2 || FP8_DENSE_FROM > 3, "dense layer 0 stays bf16; layer 2 optional");
        constexpr int NB16 = (FP8_DENSE_FROM == 2) ? 1 : 2;
        cvt_family(A.in[I_FFGU], (size_t)1024 * 5632, NB16, 5632, 1024, 176, MAP_SWI, DFF, (bf16_t*)(ws + W_FGU), (size_t)5632 * 1024, scr, gw, NGW, lane);
        cvt_family(A.in[I_FFDN], (size_t)2816 * 1024, NB16, 1024, 2816, 32, MAP_ID, 0, (bf16_t*)(ws + W_FDN), (size_t)1024 * 2816, scr, gw, NGW, lane);
        if constexpr (NB16 == 1) {
            cvt_family<true>(A.in[I_FFGU] + (size_t)1024 * 5632, 0, 1, 5632, 1024, 176, MAP_SWI, DFF, (bf16_t*)(ws + W_FGU) + (size_t)5632 * 1024, 0, scr, gw, NGW, lane);
            cvt_family<true>(A.in[I_FFDN] + (size_t)2816 * 1024, 0, 1, 1024, 2816, 32, MAP_ID, 0, (bf16_t*)(ws + W_FDN) + (size_t)1024 * 2816, 0, scr, gw, NGW, lane);
        }
        cvt_family<true>(A.in[I_MOEGU], (size_t)1024 * 7168, 16, 7168, 1024, 224, MAP_SWI, DFFE, (bf16_t*)(ws + W_MGU), (size_t)7168 * 1024, scr, gw, NGW, lane);
        cvt_family<true>(A.in[I_MOEDN], (size_t)3584 * 1024, 16, 1024, 3584, 32, MAP_ID, 0, (bf16_t*)(ws + W_MDN), (size_t)1024 * 3584, scr, gw, NGW, lane);
    }
}

template <bool ROUTER>
__device__ __forceinline__ void norm_phase(const Args& A, LAS unsigned char* lds, int bid, int G, const float* xsrc, float* xdst, const float* gain, const float* modl  , int which,
                                           bool combine, const float* modprev  , bool nonorm, const float* router, bool f8out = false) {
    int tid_ = threadIdx.x; asm volatile("" : "+v"(tid_));
    const int tid = tid_, lane = tid & 63, wave = tid >> 6;
    unsigned char* ws = A.ws;
    bf16_t* HM = (bf16_t*)(ws + WS_HM);
    const int* slot = (const int*)(ws + TB_SLOT); const float* gts = (const float*)(ws + TB_GATE);
    const bf16_t* Y = (const bf16_t*)(ws + E_XS);
    LAS int* hist = (LAS int*)lds;
    for (int tb = bid; tb < MTOK / 256; tb += G) {
        const int b = tb >> 5;
        f32x4 ga[4], sh[4], g2[4];
#pragma unroll
        for (int j = 0; j < 4; ++j) { const int c = 256 * j + 4 * lane;
            if (!nonorm) { const f32x4 gv = *(const f32x4*)(gain + c), sv = *(const f32x4*)(modl + (size_t)b * 6144 + (which * 3 + 1) * 1024 + c);
                ga[j] = gv * (sv + 1.0f); sh[j] = *(const f32x4*)(modl + (size_t)b * 6144 + (which * 3) * 1024 + c); }
            if (combine) g2[j] = *(const f32x4*)(modprev + (size_t)b * 6144 + 5 * 1024 + c); }
        f32x4 rw[ROUTER ? 32 : 1];
        if constexpr (ROUTER) {
            if (tid < 8) hist[tid] = 0;
#pragma unroll
            for (int j = 0; j < 4; ++j)
#pragma unroll
                for (int i = 0; i < 4; ++i) { const int c = 256 * j + 4 * lane + i; rw[(j * 4 + i) * 2] = *(const f32x4*)(router + c * 8); rw[(j * 4 + i) * 2 + 1] = *(const f32x4*)(router + c * 8 + 4); }
            __syncthreads();
        }
        for (int i = 0; i < 32; ++i) {
            const int row = tb * 256 + wave * 32 + i;
            const float* xr = xsrc + (size_t)row * DM;
            f32x4 v[4];
#pragma unroll
            for (int j = 0; j < 4; ++j) v[j] = *(const f32x4*)(xr + 256 * j + 4 * lane);
            if (combine) {
                const int s0 = slot[row * 2], s1 = slot[row * 2 + 1]; const float w0 = gts[row * 2], w1 = gts[row * 2 + 1];
#pragma unroll
                for (int j = 0; j < 4; ++j) { const u32x2 a = *(const u32x2*)(Y + (size_t)s0 * DM + 256 * j + 4 * lane), c2 = *(const u32x2*)(Y + (size_t)s1 * DM + 256 * j + 4 * lane);
                    f32x4 y; y[0] = w0 * bflo(a.x) + w1 * bflo(c2.x); y[1] = w0 * bfhi(a.x) + w1 * bfhi(c2.x); y[2] = w0 * bflo(a.y) + w1 * bflo(c2.y); y[3] = w0 * bfhi(a.y) + w1 * bfhi(c2.y);
                    v[j] = v[j] + g2[j] * y; *(f32x4*)(xdst + (size_t)row * DM + 256 * j + 4 * lane) = v[j]; }
            }
            if (nonorm) continue;
            float ss = 0.f;
#pragma unroll
            for (int j = 0; j < 4; ++j) ss += (v[j][0] * v[j][0] + v[j][1] * v[j][1]) + (v[j][2] * v[j][2] + v[j][3] * v[j][3]);
            ss = wave_sum(ss);
            const float rstd = 1.0f / sqrtf(ss * (1.0f / DM) + EPS);
            f32x4 h[4];
#pragma unroll
            for (int j = 0; j < 4; ++j) { h[j] = v[j] * rstd * ga[j] + sh[j];
                if (f8out) { *(unsigned*)((unsigned char*)HM + (size_t)row * DM + 256 * j + 4 * lane) = pk_fp8x4(h[j][0], h[j][1], h[j][2], h[j][3]); }
                else { u32x2 w; w.x = cvt_pk_bf16(h[j][0], h[j][1]); w.y = cvt_pk_bf16(h[j][2], h[j][3]);
                    *(u32x2*)(HM + (size_t)row * DM + 256 * j + 4 * lane) = w; } }
            if constexpr (ROUTER) {
                float lg[8];
#pragma unroll
                for (int e = 0; e < 8; ++e) lg[e] = 0.f;
#pragma unroll
                for (int j = 0; j < 4; ++j)
#pragma unroll
                    for (int q = 0; q < 4; ++q) { const float hv = h[j][q]; const f32x4 r0 = rw[(j * 4 + q) * 2], r1 = rw[(j * 4 + q) * 2 + 1];
                        lg[0] += hv * r0[0]; lg[1] += hv * r0[1]; lg[2] += hv * r0[2]; lg[3] += hv * r0[3]; lg[4] += hv * r1[0]; lg[5] += hv * r1[1]; lg[6] += hv * r1[2]; lg[7] += hv * r1[3]; }
#pragma unroll
                for (int e = 0; e < 8; ++e) lg[e] = wave_sum(lg[e]);
                int e0 = 0; float v0 = lg[0];
#pragma unroll
                for (int e = 1; e < 8; ++e) if (lg[e] > v0) { v0 = lg[e]; e0 = e; }
                int e1 = -1; float v1 = -3.0e38f;
#pragma unroll
                for (int e = 0; e < 8; ++e) if (e != e0 && lg[e] > v1) { v1 = lg[e]; e1 = e; }
                const float p1 = frcp(1.0f + fexp(v1 - v0));
                if (lane == 0) { int* eid = (int*)(ws + TB_EID); float* gt = (float*)(ws + TB_GATE);
                    eid[row * 2] = e0; eid[row * 2 + 1] = e1; gt[row * 2] = p1; gt[row * 2 + 1] = 1.0f - p1;
                    atomicAdd((int*)&hist[e0], 1); atomicAdd((int*)&hist[e1], 1); }
            }
        }
        if constexpr (ROUTER) {
            __syncthreads();
            if (tid < 8) ((int*)(ws + TB_BCNT))[tb * 8 + tid] = hist[tid];
            __syncthreads();
        }
    }
}

namespace lru {
constexpr int XCF = 0, XCB = 16384, AA = 24576, UU = 40960;
__device__ __forceinline__ int sw256(int row, int cb) { return row * 256 + (cb ^ ((row & 7) << 4)); }
__device__ __forceinline__ int crow(int r, int hi) { return (r & 3) + 8 * (r >> 2) + 4 * hi; }
template <int MODE>
__device__ __forceinline__ void lru_item(const Args& A, LAS unsigned char* lds, int b, int n, int seg, int dir) {
    int tid_ = threadIdx.x; asm volatile("" : "+v"(tid_));
    const int tid = tid_, wid = tid >> 6, lane = tid & 63, r = lane & 31, hh = lane >> 5;
    unsigned char* ws = A.ws;
    const bf16_t* XB = (const bf16_t*)(ws + L_XB); const bf16_t* YB = (const bf16_t*)(ws + L_YB); bf16_t* HF = (bf16_t*)(ws + L_HF); bf16_t* HY = (bf16_t*)(ws + L_HY);
    const bf16_t* Wg = (const bf16_t*)(ws + W_LRG) + (size_t)((n * 2 + dir) * 256 + ((r < 16) ? (16 * wid + r) : (128 + 16 * wid + r - 16))) * 128 + 8 * hh;
    bf16x8 bfrag[8];
#pragma unroll
    for (int ks = 0; ks < 8; ++ks) bfrag[ks] = *(const bf16x8*)(Wg + 16 * ks);
    const int cch = n * 128 + 16 * wid + (r & 15);
    const float ba = A.in[I_LRBA][dir * LRUW + cch], bx = A.in[I_LRBX][dir * LRUW + cch], sp = ((const float*)(ws + TB_SP))[dir * LRUW + cch];
    const int ct = tid >> 4, cg = tid & 15, cc0 = n * 128 + 8 * cg;
    float cw[4][8], cb[8];
#pragma unroll
    for (int j = 0; j < 8; ++j) { cb[j] = A.in[I_LRCB][cc0 + j];
#pragma unroll
        for (int w = 0; w < 4; ++w) cw[w][j] = A.in[I_LRCW][w * LRUW + cc0 + j]; }
    float carry = 0.f, P = 1.f;
    if (MODE != 0 && tid < 128) carry = ((const float*)(ws + TB_LCIN))[(size_t)((b * 32 + seg) * 2 + dir) * LRUW + n * 128 + tid];
    u32x4 xr[4];
#define LRU_XLOAD(si_) do { const int sub_ = dir ? (7 - (si_)) : (si_); const int tok_ = seg * 256 + sub_ * 32 + ct; \
        _Pragma("unroll") for (int w = 0; w < 4; ++w) { const int tt = tok_ - 1 + w; xr[w] = (tt >= 0 && tt < SEQ) ? *(const u32x4*)(XB + ((size_t)b * SEQ + tt) * LRUW + cc0) : (u32x4){0u, 0u, 0u, 0u}; } } while (0)
    LRU_XLOAD(0);
    for (int si = 0; si < 8; ++si) {
        const int sub = dir ? (7 - si) : si; const int t0 = seg * 256 + sub * 32;
        {
            float xc[8];
#pragma unroll
            for (int j = 0; j < 8; ++j) xc[j] = cb[j];
#pragma unroll
            for (int w = 0; w < 4; ++w) { const u32x4 v = xr[w];
#pragma unroll
                for (int e = 0; e < 4; ++e) { xc[2 * e] += cw[w][2 * e] * bflo(v[e]); xc[2 * e + 1] += cw[w][2 * e + 1] * bfhi(v[e]); } }
            if (si + 1 < 8) LRU_XLOAD(si + 1);
            *(LAS f32x4*)(lds + XCF + (ct * 128 + 8 * cg) * 4) = (f32x4){xc[0], xc[1], xc[2], xc[3]};
            *(LAS f32x4*)(lds + XCF + (ct * 128 + 8 * cg + 4) * 4) = (f32x4){xc[4], xc[5], xc[6], xc[7]};
            *(LAS u32x4*)(lds + XCB + sw256(ct, 16 * cg)) = (u32x4){cvt_pk_bf16(xc[0], xc[1]), cvt_pk_bf16(xc[2], xc[3]), cvt_pk_bf16(xc[4], xc[5]), cvt_pk_bf16(xc[6], xc[7])};
        }
        __syncthreads();
        {
            f32x16 acc = {};
#pragma unroll
            for (int ks = 0; ks < 8; ++ks) { const bf16x8 fa = *(const LAS bf16x8*)(lds + XCB + sw256(r, (16 * ks + 8 * hh) * 2)); acc = __builtin_amdgcn_mfma_f32_32x32x16_bf16(fa, bfrag[ks], acc, 0, 0, 0); }
#pragma unroll
            for (int q = 0; q < 8; ++q) {
                const float send = (r < 16) ? acc[8 + q] : acc[q]; const float recv = __shfl_xor(send, 16);
                const float rp = (r < 16) ? acc[q] : recv, ip = (r < 16) ? recv : acc[8 + q];
                const int tq = crow((r < 16) ? q : (8 + q), hh); const int cl = 16 * wid + (r & 15);
                const float xcv = ((const LAS float*)(lds + XCF))[tq * 128 + cl];
                const float rg = fsigmoid(rp + ba), ig = fsigmoid(ip + bx); const float la = -8.0f * rg * sp;
                const float av = fexp(la), uv = sqrtf(fmaxf(1.0f - av * av, 0.f)) * ig * xcv;
                ((LAS float*)(lds + AA))[tq * 128 + cl] = av; ((LAS float*)(lds + UU))[tq * 128 + cl] = uv; }
        }
        __syncthreads();
        if (tid < 128) {
            LAS float* ap = (LAS float*)(lds + AA) + tid; LAS float* up = (LAS float*)(lds + UU) + tid; float av[32], uv[32];
#pragma unroll
            for (int i = 0; i < 32; ++i) { av[i] = ap[i * 128]; uv[i] = up[i * 128]; }
            if (dir == 0) {
#pragma unroll
                for (int i = 0; i < 32; ++i) { carry = av[i] * carry + uv[i]; if (MODE == 0) P *= av[i]; else uv[i] = carry; } }
            else {
#pragma unroll
                for (int i = 31; i >= 0; --i) { carry = av[i] * carry + uv[i]; if (MODE == 0) P *= av[i]; else uv[i] = carry; } }
            if (MODE != 0) {
#pragma unroll
                for (int i = 0; i < 32; ++i) up[i * 128] = uv[i]; }
        }
        if (MODE != 0) {
            __syncthreads();
            const int tok = t0 + ct; const size_t go = ((size_t)b * SEQ + tok) * LRUW + cc0;
            const f32x4 h0 = *(const LAS f32x4*)(lds + UU + (ct * 128 + 8 * cg) * 4), h1 = *(const LAS f32x4*)(lds + UU + (ct * 128 + 8 * cg + 4) * 4);
            if (MODE == 1) { *(u32x4*)(HF + go) = (u32x4){cvt_pk_bf16(h0[0], h0[1]), cvt_pk_bf16(h0[2], h0[3]), cvt_pk_bf16(h1[0], h1[1]), cvt_pk_bf16(h1[2], h1[3])}; }
            else { const u32x4 f = *(const u32x4*)(HF + go), y = *(const u32x4*)(YB + go);
                *(u32x4*)(HY + go) = (u32x4){cvt_pk_bf16((h0[0] + bflo(f[0])) * bflo(y[0]), (h0[1] + bfhi(f[0])) * bfhi(y[0])), cvt_pk_bf16((h0[2] + bflo(f[1])) * bflo(y[1]), (h0[3] + bfhi(f[1])) * bfhi(y[1])),
                                            cvt_pk_bf16((h1[0] + bflo(f[2])) * bflo(y[2]), (h1[1] + bfhi(f[2])) * bfhi(y[2])), cvt_pk_bf16((h1[2] + bflo(f[3])) * bflo(y[3]), (h1[3] + bfhi(f[3])) * bfhi(y[3]))}; }
        }
        __syncthreads();
    }
#undef LRU_XLOAD
    if (MODE == 0 && tid < 128) { float* sm = (float*)(ws + TB_LSUM) + (size_t)(((b * 32 + seg) * 2 + dir) * 2) * LRUW + n * 128 + tid; sm[0] = P; sm[LRUW] = carry; }
}
}
template <int MODE>
__device__ __forceinline__ void lru_phase(const Args& A, LAS unsigned char* lds, int bid, int G) {
    const int nitems = (MODE == 0) ? 5120 : 2560;
    for (int it = bid; it < nitems; it += G) {
        int b, n, seg, dir;
        if (MODE == 0) { dir = it & 1; const int r = it >> 1; seg = r & 31; n = (r >> 5) % 10; b = r / 320; }
        else { dir = MODE - 1; seg = it & 31; n = (it >> 5) % 10; b = it / 320; }
        lru::lru_item<MODE>(A, lds, b, n, seg, dir);
    }
}
__device__ __forceinline__ void lru_carry_phase(const Args& A, int bid, int G) {
    const float* sm = (const float*)(A.ws + TB_LSUM); float* cin = (float*)(A.ws + TB_LCIN);
    for (int idx = bid * NTHR + threadIdx.x; idx < NBATCH * 2 * LRUW; idx += G * NTHR) {
        const int b = idx / (2 * LRUW), r = idx % (2 * LRUW), dir = r / LRUW, ch = r % LRUW; float carry = 0.f;
        for (int i = 0; i < 32; ++i) { const int sg = dir ? (31 - i) : i; const size_t o = (size_t)((b * 32 + sg) * 2 + dir);
            cin[o * LRUW + ch] = carry; carry = sm[o * 2 * LRUW + ch] * carry + sm[o * 2 * LRUW + LRUW + ch]; }
    }
}

__device__ __forceinline__ void place_phase(const Args& A, LAS unsigned char* lds, int bid, int G) {
    int tid_ = threadIdx.x; asm volatile("" : "+v"(tid_));
    const int tid = tid_, lane = tid & 63, wave = tid >> 6; unsigned char* ws = A.ws;
    const int* bcnt = (const int*)(ws + TB_BCNT); const int* eid = (const int*)(ws + TB_EID); int* slot = (int*)(ws + TB_SLOT);
    const bf16_t* HM = (const bf16_t*)(ws + WS_HM); bf16_t* XS = (bf16_t*)(ws + E_XS);
    LAS int* tot = (LAS int*)lds; LAS int* pre = tot + 8; LAS int* rb = tot + 16; LAS int* wcn = tot + 32; LAS int* sl = tot + 64;
    for (int tb = bid; tb < MTOK / 256; tb += G) {
        { int t_ = 0, p_ = 0;
#pragma unroll
            for (int j = 0; j < 4; ++j) { const int blk = lane + 64 * j; const int v = bcnt[blk * 8 + wave]; t_ += v; p_ += (blk < tb) ? v : 0; }
#pragma unroll
            for (int o = 1; o < 64; o <<= 1) { t_ += __shfl_xor(t_, o); p_ += __shfl_xor(p_, o); }
            if (lane == 0) { tot[wave] = t_; pre[wave] = p_; } }
        __syncthreads();
        if (tid == 0) { int acc = 0; for (int e = 0; e < 8; ++e) { rb[e] = acc * 256; if (tb == 0) ((int*)(ws + TB_TILES))[e] = acc; acc += (tot[e] + 255) >> 8; } if (tb == 0) ((int*)(ws + TB_TILES))[8] = acc; }
        int e0 = -1, e1 = -1; unsigned long long mk0 = 0, mk1 = 0;
        if (tid < 256) { e0 = eid[(tb * 256 + tid) * 2]; e1 = eid[(tb * 256 + tid) * 2 + 1];
#pragma unroll
            for (int e = 0; e < 8; ++e) { const unsigned long long m = __ballot(e0 == e || e1 == e); if (lane == 0) wcn[wave * 8 + e] = __popcll(m); if (e0 == e) mk0 = m; if (e1 == e) mk1 = m; } }
        __syncthreads();
        if (tid < 256) { const unsigned long long lt = (1ull << lane) - 1ull; int b0 = rb[e0] + pre[e0] + __popcll(mk0 & lt), b1 = rb[e1] + pre[e1] + __popcll(mk1 & lt);
            for (int w = 0; w < wave; ++w) { b0 += wcn[w * 8 + e0]; b1 += wcn[w * 8 + e1]; }
            sl[tid * 2] = b0; sl[tid * 2 + 1] = b1; slot[(tb * 256 + tid) * 2] = b0; slot[(tb * 256 + tid) * 2 + 1] = b1; }
        __syncthreads();
        for (int i = 0; i < 32; ++i) { const int t = wave * 32 + i; const int s0 = sl[t * 2], s1 = sl[t * 2 + 1];
            const bf16_t* src = HM + (size_t)(tb * 256 + t) * DM + lane * 16;
            const u32x4 a = *(const u32x4*)src, b = *(const u32x4*)(src + 8);
            const u32x4 q = {pk_fp8x4(bflo(a[0]), bfhi(a[0]), bflo(a[1]), bfhi(a[1])), pk_fp8x4(bflo(a[2]), bfhi(a[2]), bflo(a[3]), bfhi(a[3])),
                             pk_fp8x4(bflo(b[0]), bfhi(b[0]), bflo(b[1]), bfhi(b[1])), pk_fp8x4(bflo(b[2]), bfhi(b[2]), bflo(b[3]), bfhi(b[3]))};
            *(u32x4*)((unsigned char*)XS + (size_t)s0 * DM + lane * 16) = q; *(u32x4*)((unsigned char*)XS + (size_t)s1 * DM + lane * 16) = q; }
        __syncthreads();
    }
}

namespace att {
constexpr int KVBLK = 64;
#define SBAR() __builtin_amdgcn_sched_barrier(0)
typedef int v8i __attribute__((ext_vector_type(8)));
__device__ __forceinline__ int crow(int r, int hi) { return (r & 3) + 8 * (r >> 2) + 4 * hi; }
constexpr int SLOTB = 16384;
__device__ __forceinline__ int k_slot(int s) { return s * SLOTB; }
__device__ __forceinline__ int v_slot(int s) { return s * SLOTB + 8192; }
__device__ __forceinline__ int kswz(int row) { return ((row & 7) ^ (row >> 4)) & 7; }
__device__ __forceinline__ int vswz(int row) { return (row >> 2) & 3; }
__device__ __forceinline__ void mfma8_acc(f32x16& acc, const v8i& a, const v8i& b, int sc) {
    asm volatile("s_nop 1\n\tv_mfma_scale_f32_32x32x64_f8f6f4 %0, %1, %2, %0, %3, %3 op_sel_hi:[0,0,0]" : "+v"(acc) : "v"(a), "v"(b), "v"(sc));
}
__device__ __forceinline__ void mfma8_c(f32x16& d, const v8i& a, const v8i& b, const f32x16& c, int sa, int sb) {
    asm volatile("v_mfma_scale_f32_32x32x64_f8f6f4 %0, %1, %2, %3, %4, %5 op_sel_hi:[0,0,0]" : "=&v"(d) : "v"(a), "v"(b), "v"(c), "v"(sa), "v"(sb));
}
#define ATT_LD8(p0_, p1_) __builtin_bit_cast(v8i, __builtin_shufflevector(*(const LAS u32x4*)(p0_), *(const LAS u32x4*)(p1_), 0, 1, 2, 3, 4, 5, 6, 7))
__device__ __forceinline__ void qkt(f32x16& p0, f32x16& p1, const LAS char* Ks, const v8i& qr, int r32, int hi, int jj, const f32x16& cinit, int s1, int s8) {
    const int c0 = jj * 4 + 2 * hi;
    { const int row = r32; const v8i kf = ATT_LD8(Ks + row * 128 + ((c0 ^ kswz(row)) << 4), Ks + row * 128 + (((c0 + 1) ^ kswz(row)) << 4)); mfma8_c(p0, kf, qr, cinit, s1, s8); }
    { const int row = 32 + r32; const v8i kf = ATT_LD8(Ks + row * 128 + ((c0 ^ kswz(row)) << 4), Ks + row * 128 + (((c0 + 1) ^ kswz(row)) << 4)); mfma8_c(p1, kf, qr, cinit, s1, s8); }
}
__device__ __forceinline__ void partialSM(f32x16& p0) {
#pragma unroll
    for (int r = 0; r < 16; ++r) p0[r] = fexp2(p0[r]);
}
__device__ __forceinline__ void finishSM(f32x16& p0, f32x16& p1, float& l_reg, v8i& pa) {
#pragma unroll
    for (int r = 0; r < 16; ++r) p1[r] = fexp2(p1[r]);
    float ps = 0;
#pragma unroll
    for (int r = 0; r < 16; ++r) ps += p0[r];
#pragma unroll
    for (int r = 0; r < 16; ++r) ps += p1[r];
    { auto rr = __builtin_amdgcn_permlane32_swap(__float_as_uint(ps), __float_as_uint(ps), false, false);
      ps = __uint_as_float(rr[0]) + __uint_as_float(rr[1]); }
    l_reg += ps;
#pragma unroll
    for (int w = 0; w < 4; ++w) { pa[w] = (int)pk_fp8x4(p0[4 * w], p0[4 * w + 1], p0[4 * w + 2], p0[4 * w + 3]); pa[4 + w] = (int)pk_fp8x4(p1[4 * w], p1[4 * w + 1], p1[4 * w + 2], p1[4 * w + 3]); }
}
__device__ __forceinline__ void pv_d0(f32x16* o, const LAS char* Vs, const v8i& pa, int r32, int hi, int s1) {
#pragma unroll
    for (int d0 = 0; d0 < 4; ++d0) { const int row = 32 * d0 + r32;
        const v8i vf = ATT_LD8(Vs + row * 64 + (((2 * hi) ^ vswz(row)) << 4), Vs + row * 64 + (((2 * hi + 1) ^ vswz(row)) << 4));
        mfma8_acc(o[d0], pa, vf, s1); }
}
}

__device__ __forceinline__ void vt_phase(const Args& A, int bid, int G) {
    const int tid = threadIdx.x; unsigned char* ws = A.ws;
    const bf16_t* V = (const bf16_t*)(ws + A_V); unsigned char* VT = ws + A_VT;
    const int dv = tid & 127, kq = tid >> 7, half = kq >> 1, hi = kq & 1;
    for (int it = bid; it < 64 * 128; it += G) {
        const int bh = it >> 7, tile = it & 127, b = bh >> 3, h = bh & 7;
        const bf16_t* vp = V + ((size_t)b * SEQ + tile * 64 + 32 * half) * DM + h * 128 + dv;
        float f[16];
#pragma unroll
        for (int i = 0; i < 16; ++i) f[i] = bf2f(vp[(size_t)att::crow(i, hi) * DM]);
        *(u32x4*)(VT + (((size_t)bh * 128 + dv) * 128 + tile) * 64 + hi * 32 + half * 16) =
            (u32x4){pk_fp8x4(f[0], f[1], f[2], f[3]), pk_fp8x4(f[4], f[5], f[6], f[7]), pk_fp8x4(f[8], f[9], f[10], f[11]), pk_fp8x4(f[12], f[13], f[14], f[15])};
    }
}

__device__ __forceinline__ void attn_phase(const Args& A, LAS unsigned char* ldsu, int bid, int G, int al) {
    using namespace att;
    LAS char* lds = (LAS char*)ldsu;
    unsigned char* ws = A.ws;
    const unsigned char* Qg = ws + A_Q; const unsigned char* Kg = ws + A_K; const unsigned char* VTg = ws + A_VT;
    bf16_t* Og = (bf16_t*)(ws + WS_HM);
    const float* scal = (const float*)(ws + TB_SCAL);
    const float lamv = scal[SC_LAM0 + al], omli = scal[SC_OML0 + al], Mc = scal[SC_MC0 + al] - 7.5f;
    const float* subg = A.in[I_ATSUB] + al * 128;
    int tid_ = threadIdx.x; asm volatile("" : "+v"(tid_));
    const int tid = tid_, wid = __builtin_amdgcn_readfirstlane(tid >> 6), lane = tid & 63, r32 = lane & 31, hi = lane >> 5, jj = wid >> 2, wq = wid & 3;
    constexpr int NT = SEQ / KVBLK;
    int s1 = 0x7f7f7f7f, s8 = 0x7c7c7c7c; asm volatile("" : "+v"(s1), "+v"(s8));
    f32x16 cinit;
#pragma unroll
    for (int r = 0; r < 16; ++r) cinit[r] = -Mc;
    unsigned koff, voff;
    { const int bb = wid * 1024 + lane * 16;
      { const int row = bb >> 7, c = ((bb & 127) >> 4) ^ kswz(row); koff = (unsigned)(row * 1024 + c * 16); }
      { const int row = bb >> 6, c = ((bb & 63) >> 4) ^ vswz(row); voff = (unsigned)(row * 8192 + c * 16); } }
    const unsigned ldsw = (unsigned)wid * 1024u;
#define ATT_DMA(slot, kt, vt) do { \
        __builtin_amdgcn_global_load_lds((const unsigned*)((const unsigned char*)(kt) + koff), (LAS unsigned*)(lds + k_slot(slot) + ldsw), 16, 0, 0); \
        __builtin_amdgcn_global_load_lds((const unsigned*)((const unsigned char*)(vt) + voff), (LAS unsigned*)(lds + v_slot(slot) + ldsw), 16, 0, 0); } while (0)
#define ATT_TOP() do { asm volatile("s_waitcnt vmcnt(0)" ::: "memory"); __builtin_amdgcn_s_barrier(); asm volatile("" ::: "memory"); } while (0)
    const int xq = bid & 7, cq = bid >> 3;
    LAS float* li_l = (LAS float*)(lds + 131072) + wid * 64;
    int cbh = xq * 8;
    const bool lag = (jj != 0);
#define ATT_KB(bh_) (Kg + ((size_t)((bh_) >> 3) * SEQ) * DM + ((bh_) & 7) * 128)
#define ATT_VB(bh_) (VTg + (size_t)(bh_) * 128 * 8192)
    ATT_DMA(0, ATT_KB(cbh), ATT_VB(cbh));
    { asm volatile("s_waitcnt vmcnt(0)" ::: "memory"); __builtin_amdgcn_s_barrier(); asm volatile("" ::: "memory"); ATT_DMA(1, ATT_KB(cbh) + (size_t)64 * DM, ATT_VB(cbh) + 64); }
    for (int ui = 0; ui < 16; ++ui) {
        const int qb = (ui & 1) * 32 + cq;
        const int nbh = (ui + 1 < 16) ? xq * 8 + ((ui + 1) >> 1) : cbh;
        const unsigned char* Kh = ATT_KB(cbh); const unsigned char* Vh = ATT_VB(cbh); const unsigned char* nK = ATT_KB(nbh); const unsigned char* nV = ATT_VB(nbh);
        const size_t obase = ((size_t)(cbh >> 3) * SEQ + qb * 128) * DM + (cbh & 7) * 128;
        float l_reg = 0; f32x16 o[4] = {}; v8i qr;
        { const unsigned char* Qw = Qg + obase + (size_t)(wq * 32 + r32) * DM + jj * 64 + hi * 32;
          const u32x4 qa = *(const u32x4*)Qw, qb2 = *(const u32x4*)(Qw + 16);
          qr = __builtin_bit_cast(v8i, __builtin_shufflevector(qa, qb2, 0, 1, 2, 3, 4, 5, 6, 7)); }
        f32x16 pA0, pA1, pB0, pB1; v8i pa;
#define ATT_SRC(jt, KP, VP) const unsigned char* KP = ((jt) + 2 < NT) ? Kh + (size_t)((jt) + 2) * 64 * DM : nK + (size_t)((jt) + 2 - NT) * 64 * DM; \
                            const unsigned char* VP = ((jt) + 2 < NT) ? Vh + (size_t)((jt) + 2) * 64 : nV + (size_t)((jt) + 2 - NT) * 64
#define ATT_BAR(jt) do { ATT_TOP(); ATT_SRC(jt, kp_, vp_); ATT_DMA(((jt) + 2) & 3, kp_, vp_); } while (0)
        { qkt(pA0, pA1, lds + k_slot(0), qr, r32, hi, jj, cinit, s1, s8);
          if (lag) ATT_BAR(0);
          asm volatile("s_nop 15\n\ts_nop 7" ::: "memory");
          partialSM(pA0);
          if (!lag) ATT_BAR(0); }
        for (int jt = 1; jt + 1 < NT; jt += 2) {
            { SBAR(); qkt(pB0, pB1, lds + k_slot(jt & 3), qr, r32, hi, jj, cinit, s1, s8);
              finishSM(pA0, pA1, l_reg, pa); SBAR();
              if (lag) ATT_BAR(jt);
              pv_d0(o, lds + v_slot((jt - 1) & 3), pa, r32, hi, s1); partialSM(pB0);
              if (!lag) ATT_BAR(jt); }
            { const int j2 = jt + 1;
              SBAR(); qkt(pA0, pA1, lds + k_slot(j2 & 3), qr, r32, hi, jj, cinit, s1, s8);
              finishSM(pB0, pB1, l_reg, pa); SBAR();
              if (lag) ATT_BAR(j2);
              pv_d0(o, lds + v_slot((j2 - 1) & 3), pa, r32, hi, s1); partialSM(pA0);
              if (!lag) ATT_BAR(j2); }
        }
        { constexpr int jt = NT - 1;
          SBAR(); qkt(pB0, pB1, lds + k_slot(jt & 3), qr, r32, hi, jj, cinit, s1, s8);
          finishSM(pA0, pA1, l_reg, pa); SBAR();
          if (lag) ATT_BAR(jt);
          pv_d0(o, lds + v_slot((jt - 1) & 3), pa, r32, hi, s1); partialSM(pB0);
          if (!lag) ATT_BAR(jt);
          finishSM(pB0, pB1, l_reg, pa); SBAR();
          pv_d0(o, lds + v_slot(jt & 3), pa, r32, hi, s1);
          asm volatile("s_nop 15\n\ts_nop 15" ::: "memory"); }
#undef ATT_BAR
#undef ATT_SRC
        int r32e = r32, hie = hi; asm volatile("" : "+v"(r32e), "+v"(hie));
        if (hie == 0) li_l[r32e] = l_reg; asm volatile("s_waitcnt lgkmcnt(0)" ::: "memory");
        float rli[16];
#pragma unroll
        for (int r = 0; r < 16; ++r) rli[r] = frcp(li_l[crow(r, hie)]);
        LAS float* Cb = (LAS float*)(lds + 65536);
        if (jj == 1) {
#pragma unroll
            for (int r = 0; r < 16; ++r) { const float sc = rli[r] * lamv;
#pragma unroll
                for (int d0 = 0; d0 < 4; ++d0) Cb[(wq * 32 + crow(r, hie)) * 128 + d0 * 32 + r32e] = o[d0][r] * sc; }
        }
        asm volatile("s_waitcnt lgkmcnt(0)" ::: "memory"); __builtin_amdgcn_s_barrier(); asm volatile("" ::: "memory");
        if (jj == 0) {
            float g[4];
#pragma unroll
            for (int d0 = 0; d0 < 4; ++d0) g[d0] = subg[d0 * 32 + r32e] * omli;
            bf16_t* Ob = Og + obase;
#pragma unroll
            for (int r = 0; r < 16; ++r) {
                float ss = 0.f;
#pragma unroll
                for (int d0 = 0; d0 < 4; ++d0) { const float v = o[d0][r] * rli[r] - Cb[(wq * 32 + crow(r, hie)) * 128 + d0 * 32 + r32e]; o[d0][r] = v; ss += v * v; }
                ss += __shfl_xor(ss, 1); ss += __shfl_xor(ss, 2); ss += __shfl_xor(ss, 4); ss += __shfl_xor(ss, 8); ss += __shfl_xor(ss, 16);
                const float rs = 1.0f / sqrtf(ss * (1.0f / 128.0f) + EPS);
                bf16_t* op = Ob + (size_t)(wq * 32 + crow(r, hie)) * DM + r32e;
#pragma unroll
                for (int d0 = 0; d0 < 4; ++d0) op[d0 * 32] = (bf16_t)f2bf(o[d0][r] * rs * g[d0]);
            }
        }
        asm volatile("s_waitcnt lgkmcnt(0)" ::: "memory"); __builtin_amdgcn_s_barrier(); asm volatile("" ::: "memory");
        cbh = nbh;
    }
    asm volatile("s_waitcnt vmcnt(0) lgkmcnt(0)" ::: "memory"); __builtin_amdgcn_s_barrier(); asm volatile("" ::: "memory");
#undef ATT_DMA
#undef ATT_TOP
#undef ATT_KB
#undef ATT_VB
#undef ATT_LD8
}

namespace gla {
constexpr int BC = 0, QI = 32768, QA = 49152, KA = 65536, KST = 81920, VT = 98304, ST = 106496, AT = 122880, EM = 131072, EL = EM + 512, DD = EM + 1024, BMID = EM + 1536, SEG = EM + 2048;
static_assert(SEG + 2048 <= RING_BYTES, "gla lds");
__device__ __forceinline__ int sw256(int row, int cb) { return row * 256 + (cb ^ ((row & 15) << 4)); }
__device__ __forceinline__ int sw128(int row, int cb) { return row * 128 + (cb ^ ((((row & 7) ^ (row >> 4)) & 7) << 4)); }
__device__ __forceinline__ int crow(int r, int hi) { return (r & 3) + 8 * (r >> 2) + 4 * hi; }
__device__ __forceinline__ float h2f(unsigned short b) { return (float)__builtin_bit_cast(_Float16, b); }
__device__ __forceinline__ void gla_item(const bf16_t* __restrict__ Qp, const unsigned short* __restrict__ LFp, const bf16_t* __restrict__ Vp, bf16_t* __restrict__ Op, int dir, LAS unsigned char* lds, float* dbg) {
    int tid_ = threadIdx.x; asm volatile("" : "+v"(tid_));
    const int tid = tid_, wid = tid >> 6, lane = tid & 63, r = lane & 31, hh = lane >> 5;
    const int t1 = tid >> 3, kg = tid & 7, k0 = 16 * kg, v0 = (tid & 7) * 8;
    for (int i = tid; i < 16384 / 16; i += NTHR) *(LAS u32x4*)(lds + ST + i * 16) = (u32x4){0u, 0u, 0u, 0u};
    f32x16 st = {};
    u32x4 rq[2], rl[2], rv;
#define GLA_TOK(ci, i) (dir ? (SEQ - 1 - ((ci) * 64 + (i))) : ((ci) * 64 + (i)))
#define GLA_LOAD(ci) do { const size_t to = (size_t)GLA_TOK(ci, t1) * DM; \
        rq[0] = *(const u32x4*)(Qp + to + k0); rq[1] = *(const u32x4*)(Qp + to + k0 + 8); \
        rl[0] = *(const u32x4*)(LFp + to + k0); rl[1] = *(const u32x4*)(LFp + to + k0 + 8); rv = *(const u32x4*)(Vp + to + v0); } while (0)
    GLA_LOAD(0);
    __syncthreads();
    for (int ci = 0; ci < SEQ / 64; ++ci) {
        float qf[16], lf[16]; u32x4 vreg = rv;
#pragma unroll
        for (int j = 0; j < 2; ++j)
#pragma unroll
            for (int e = 0; e < 4; ++e) { qf[j * 8 + 2 * e] = bflo(rq[j][e]); qf[j * 8 + 2 * e + 1] = bfhi(rq[j][e]);
                lf[j * 8 + 2 * e] = h2f((unsigned short)(rl[j][e] & 0xffffu)); lf[j * 8 + 2 * e + 1] = h2f((unsigned short)(rl[j][e] >> 16)); }
        if (ci + 1 < SEQ / 64) GLA_LOAD(ci + 1);
#pragma unroll
        for (int j = 0; j < 4; ++j) *(LAS f32x4*)(lds + BC + (t1 * 128 + k0 + 4 * j) * 4) = (f32x4){lf[4 * j], lf[4 * j + 1], lf[4 * j + 2], lf[4 * j + 3]};
        __syncthreads();
        { const int kc = tid & 127, sg = tid >> 7; LAS float* bc = (LAS float*)(lds + BC) + kc; float cs[16];
#pragma unroll
            for (int i = 0; i < 16; ++i) cs[i] = bc[(sg * 16 + i) * 128];
#pragma unroll
            for (int i = 1; i < 16; ++i) cs[i] += cs[i - 1];
            ((LAS float*)(lds + SEG))[sg * 128 + kc] = cs[15];
            __syncthreads();
            const LAS float* sgp = (const LAS float*)(lds + SEG) + kc; const float s0 = sgp[0], s1 = sgp[128], s2 = sgp[256], s3 = sgp[384];
            const float off = sg == 0 ? 0.f : sg == 1 ? s0 : sg == 2 ? (s0 + s1) : ((s0 + s1) + s2);
#pragma unroll
            for (int i = 0; i < 16; ++i) bc[(sg * 16 + i) * 128] = cs[i] + off;
            if (sg == 0) { const float bm = s0 + s1, bl = ((s0 + s1) + s2) + s3;
                ((LAS float*)(lds + BMID))[kc] = bm; ((LAS float*)(lds + EM))[kc] = fexp(bm); ((LAS float*)(lds + EL))[kc] = fexp(bl - bm); ((LAS float*)(lds + DD))[kc] = fexp(bl); }
            __syncthreads();
        }
#ifdef DIAG
        if (dbg && ci == 0) { for (int i = tid; i < 8192; i += NTHR) dbg[i] = ((const LAS float*)(lds + BC))[i]; }
#endif
        {
            unsigned wqi[8], wqa[8], wka[8]; float ksv[16];
#pragma unroll
            for (int j = 0; j < 4; ++j) {
                const f32x4 bt = *(const LAS f32x4*)(lds + BC + (t1 * 128 + k0 + 4 * j) * 4), bm = *(const LAS f32x4*)(lds + BMID + (k0 + 4 * j) * 4);
                const f32x4 em = *(const LAS f32x4*)(lds + EM + (k0 + 4 * j) * 4), el = *(const LAS f32x4*)(lds + EL + (k0 + 4 * j) * 4);
                float qi[4], qa[4], ka[4];
#pragma unroll
                for (int e = 0; e < 4; ++e) { const int i = 4 * j + e; const float e1 = fexp(bt[e] - bm[e]), r1 = frcp(e1);
                    qa[e] = qf[i] * e1; qi[e] = qa[e] * em[e]; const float kk = 1.0f - fexp(lf[i]); ka[e] = kk * r1; ksv[i] = ka[e] * el[e]; }
                wqi[2 * j] = cvt_pk_bf16(qi[0], qi[1]); wqi[2 * j + 1] = cvt_pk_bf16(qi[2], qi[3]);
                wqa[2 * j] = cvt_pk_bf16(qa[0], qa[1]); wqa[2 * j + 1] = cvt_pk_bf16(qa[2], qa[3]);
                wka[2 * j] = cvt_pk_bf16(ka[0], ka[1]); wka[2 * j + 1] = cvt_pk_bf16(ka[2], ka[3]);
            }
#pragma unroll
            for (int j = 0; j < 2; ++j) { const int off = sw256(t1, (k0 + 8 * j) * 2);
                *(LAS u32x4*)(lds + QI + off) = (u32x4){wqi[4 * j], wqi[4 * j + 1], wqi[4 * j + 2], wqi[4 * j + 3]};
                *(LAS u32x4*)(lds + QA + off) = (u32x4){wqa[4 * j], wqa[4 * j + 1], wqa[4 * j + 2], wqa[4 * j + 3]};
                *(LAS u32x4*)(lds + KA + off) = (u32x4){wka[4 * j], wka[4 * j + 1], wka[4 * j + 2], wka[4 * j + 3]}; }
#pragma unroll
            for (int i = 0; i < 16; ++i) *(LAS unsigned short*)(lds + KST + sw128(k0 + i, t1 * 2)) = (unsigned short)f2bf(ksv[i]);
#pragma unroll
            for (int e = 0; e < 4; ++e) { *(LAS unsigned short*)(lds + VT + sw128(v0 + 2 * e, t1 * 2)) = (unsigned short)(vreg[e] & 0xffffu);
                *(LAS unsigned short*)(lds + VT + sw128(v0 + 2 * e + 1, t1 * 2)) = (unsigned short)(vreg[e] >> 16); }
        }
        __syncthreads();
        f32x16 oacc = {};
        const int w4 = wid & 3, t_i = w4 >> 1, v_i = w4 & 1;
        if (wid < 4) {
            const int s_i = wid >> 1, tq = wid & 1; f32x16 a = {};
#pragma unroll
            for (int ks = 0; ks < 8; ++ks) { const bf16x8 fa = *(const LAS bf16x8*)(lds + KA + sw256(32 * s_i + r, (16 * ks + 8 * hh) * 2)), fb = *(const LAS bf16x8*)(lds + QA + sw256(32 * tq + r, (16 * ks + 8 * hh) * 2));
                a = __builtin_amdgcn_mfma_f32_32x32x16_bf16(fa, fb, a, 0, 0, 0); }
            const int tg = 32 * tq + r;
#pragma unroll
            for (int g = 0; g < 4; ++g) { float m[4];
#pragma unroll
                for (int e = 0; e < 4; ++e) { const int sgl = 32 * s_i + 8 * g + 4 * hh + e; m[e] = (sgl <= tg) ? a[4 * g + e] : 0.f; }
                *(LAS u32x2*)(lds + AT + sw128(tg, (32 * s_i + 8 * g + 4 * hh) * 2)) = (u32x2){cvt_pk_bf16(m[0], m[1]), cvt_pk_bf16(m[2], m[3])}; }
        } else {
#pragma unroll
            for (int ks = 0; ks < 8; ++ks) { const bf16x8 fa = *(const LAS bf16x8*)(lds + QI + sw256(32 * t_i + r, (16 * ks + 8 * hh) * 2)), fb = *(const LAS bf16x8*)(lds + ST + sw256(32 * v_i + r, (16 * ks + 8 * hh) * 2));
                oacc = __builtin_amdgcn_mfma_f32_32x32x16_bf16(fa, fb, oacc, 0, 0, 0); }
        }
        __syncthreads();
#ifdef DIAG
        if (dbg && ci == 0) { for (int i = tid; i < 2048; i += NTHR) { ((unsigned*)dbg)[8192 + i] = ((const LAS unsigned*)(lds + AT))[i]; ((unsigned*)dbg)[8192 + 2048 + i] = ((const LAS unsigned*)(lds + VT))[i]; } }
#endif
        if (wid >= 4) {
#pragma unroll
            for (int ks = 0; ks < 4; ++ks) { const bf16x8 fa = *(const LAS bf16x8*)(lds + AT + sw128(32 * t_i + r, (16 * ks + 8 * hh) * 2)), fb = *(const LAS bf16x8*)(lds + VT + sw128(32 * v_i + r, (16 * ks + 8 * hh) * 2));
                oacc = __builtin_amdgcn_mfma_f32_32x32x16_bf16(fa, fb, oacc, 0, 0, 0); }
#pragma unroll
            for (int i = 0; i < 16; ++i) { const int t = 32 * t_i + crow(i, hh); Op[(size_t)GLA_TOK(ci, t) * DM + 32 * v_i + r] = (bf16_t)f2bf(oacc[i]); }
        }
        {
            const int kq = wid >> 1, vq = wid & 1;
#pragma unroll
            for (int i = 0; i < 16; ++i) st[i] *= ((const LAS float*)(lds + DD))[32 * kq + crow(i, hh)];
#pragma unroll
            for (int ks = 0; ks < 4; ++ks) { const bf16x8 fa = *(const LAS bf16x8*)(lds + KST + sw128(32 * kq + r, (16 * ks + 8 * hh) * 2)), fb = *(const LAS bf16x8*)(lds + VT + sw128(32 * vq + r, (16 * ks + 8 * hh) * 2));
                st = __builtin_amdgcn_mfma_f32_32x32x16_bf16(fa, fb, st, 0, 0, 0); }
#pragma unroll
            for (int g = 0; g < 4; ++g) *(LAS u32x2*)(lds + ST + sw256(32 * vq + r, (32 * kq + 8 * g + 4 * hh) * 2)) = (u32x2){cvt_pk_bf16(st[4 * g], st[4 * g + 1]), cvt_pk_bf16(st[4 * g + 2], st[4 * g + 3])};
        }
        __syncthreads();
#ifdef DIAG
        if (dbg && ci == 0) { for (int i = tid; i < 4096; i += NTHR) { ((unsigned*)dbg)[12288 + i] = ((const LAS unsigned*)(lds + ST))[i]; ((unsigned*)dbg)[16384 + i] = ((const LAS unsigned*)(lds + KST))[i]; } }
#endif
    }
#undef GLA_TOK
#undef GLA_LOAD
}
}
__device__ __forceinline__ void gla_phase(const Args& A, LAS unsigned char* lds, int bid, int G) {
    unsigned char* ws = A.ws;
    for (int it = bid; it < 256; it += G) {
        const int b = it >> 5, h = (it >> 2) & 7, dir = (it >> 1) & 1, vh = it & 1;
        const size_t base = (size_t)b * SEQ * DM + h * 128;
        gla::gla_item((const bf16_t*)(ws + H_Q) + base, (const unsigned short*)(ws + (dir ? H_LFB : H_LFF)) + base, (const bf16_t*)(ws + H_V) + base + vh * 64,
                      (bf16_t*)(ws + (dir ? H_OB : H_OF)) + base + vh * 64, dir, lds, it == 0 ? (float*)(ws + TB_LSUM) : nullptr);
    }
}
__device__ __forceinline__ void hg_normo_phase(const Args& A, int bid, int G) {
    int tid_ = threadIdx.x; asm volatile("" : "+v"(tid_));
    const int tid = tid_, lane = tid & 63, wave = tid >> 6; unsigned char* ws = A.ws;
    const bf16_t* OF = (const bf16_t*)(ws + H_OF); const bf16_t* OB = (const bf16_t*)(ws + H_OB); const bf16_t* GG = (const bf16_t*)(ws + H_G); bf16_t* HM = (bf16_t*)(ws + WS_HM);
    const int c0 = (lane >> 3) * 128 + (lane & 7) * 16;
    float ng[16];
#pragma unroll
    for (int i = 0; i < 16; ++i) ng[i] = A.in[I_HGNG][(lane & 7) * 16 + i];
    for (int row = (bid * NWAVES + wave); row < MTOK; row += G * NWAVES) {
        const size_t o = (size_t)row * DM + c0;
        const u32x4 a0 = *(const u32x4*)(OF + o), a1 = *(const u32x4*)(OF + o + 8), b0 = *(const u32x4*)(OB + o), b1 = *(const u32x4*)(OB + o + 8), g0 = *(const u32x4*)(GG + o), g1 = *(const u32x4*)(GG + o + 8);
        float v[16], gt[16]; float ss = 0.f;
#pragma unroll
        for (int e = 0; e < 4; ++e) { v[2 * e] = bflo(a0[e]) + bflo(b0[e]); v[2 * e + 1] = bfhi(a0[e]) + bfhi(b0[e]); v[8 + 2 * e] = bflo(a1[e]) + bflo(b1[e]); v[8 + 2 * e + 1] = bfhi(a1[e]) + bfhi(b1[e]);
            gt[2 * e] = bflo(g0[e]); gt[2 * e + 1] = bfhi(g0[e]); gt[8 + 2 * e] = bflo(g1[e]); gt[8 + 2 * e + 1] = bfhi(g1[e]); }
#pragma unroll
        for (int i = 0; i < 16; ++i) ss += v[i] * v[i];
        ss += __shfl_xor(ss, 1); ss += __shfl_xor(ss, 2); ss += __shfl_xor(ss, 4);
        const float rstd = 1.0f / sqrtf(ss * (1.0f / 128.0f) + EPS);
        u32x4 w0, w1;
#pragma unroll
        for (int e = 0; e < 4; ++e) { w0[e] = cvt_pk_bf16(v[2 * e] * rstd * ng[2 * e] * gt[2 * e], v[2 * e + 1] * rstd * ng[2 * e + 1] * gt[2 * e + 1]);
            w1[e] = cvt_pk_bf16(v[8 + 2 * e] * rstd * ng[8 + 2 * e] * gt[8 + 2 * e], v[8 + 2 * e + 1] * rstd * ng[8 + 2 * e + 1] * gt[8 + 2 * e + 1]); }
        *(u32x4*)(HM + o) = w0; *(u32x4*)(HM + o + 8) = w1;
    }
}

#ifdef DIAG
constexpr int DG_BASE = 8192;
__device__ __forceinline__ void dg_put(const Args& A, int k, float e) { if (!(e >= 0.f) || e > 1e9f) e = 1e9f; atomicMax((unsigned*)(A.ws + WS_CTL) + DG_BASE + 64 * k, __float_as_uint(e)); }
__device__ __forceinline__ float dg_rel(float got, float ref) { return fabsf(got - ref) / (fabsf(ref) + 0.1f); }
__device__ __forceinline__ unsigned dg_hash(unsigned a, unsigned b) { unsigned h = a * 2654435761u + b * 40503u + 0x9e3779b9u; h ^= h >> 15; h *= 2246822519u; h ^= h >> 13; h *= 3266489917u; h ^= h >> 16; return h; }
__device__ __forceinline__ float dg_bfr(float x) { return bflo(f2bf(x)); }
__device__ __forceinline__ void dg_mods(const Args& A, int k) {
    const int lane = threadIdx.x & 63, gwv = blockIdx.x * 8 + (threadIdx.x >> 6);
    const unsigned h = dg_hash(gwv, k); const int l = h & 3, b = (h >> 2) & 7, e = (h >> 5) % 6144;
    float a = 0.f; for (int d = lane; d < DM; d += 64) a += fsilu(A.in[I_C][b * DM + d]) * A.in[I_ADAW][((size_t)l * DM + d) * 6144 + e];
    a = wave_sum(a) + A.in[I_ADAB][l * 6144 + e];
    const float got = ((const float*)(A.ws + TB_MODS))[((size_t)l * NBATCH + b) * 6144 + e];
    if (lane == 0) dg_put(A, k, dg_rel(got, a));
}
__device__ __forceinline__ void dg_norm(const Args& A, int k, const float* x, const float* gain, int L, int which) {
    const int lane = threadIdx.x & 63, gwv = blockIdx.x * 8 + (threadIdx.x >> 6);
    const int row = dg_hash(gwv, k) & (MTOK - 1), b = row >> 13;
    const float* modl = (const float*)(A.ws + TB_MODS) + ((size_t)L * NBATCH + b) * 6144;
    float ss = 0.f; for (int c = lane; c < DM; c += 64) { const float v = x[(size_t)row * DM + c]; ss += v * v; }
    ss = wave_sum(ss); const float rstd = 1.0f / sqrtf(ss / DM + EPS); float e = 0.f;
    for (int c = lane; c < DM; c += 64) { const float ref = x[(size_t)row * DM + c] * rstd * gain[c] * (1.0f + modl[(which * 3 + 1) * 1024 + c]) + modl[(which * 3) * 1024 + c];
        e = fmaxf(e, dg_rel(bf2f(((const bf16_t*)(A.ws + WS_HM))[(size_t)row * DM + c]), ref)); }
    dg_put(A, k, e);
}
__device__ __forceinline__ void dg_qkv(const Args& A, int k, int al) {
    const int lane = threadIdx.x & 63, gwv = blockIdx.x * 8 + (threadIdx.x >> 6);
    const unsigned h = dg_hash(gwv, k); const int row = h & (MTOK - 1), t = (h >> 16) % 48, col = t * 64 + lane;
    const bf16_t* hm = (const bf16_t*)(A.ws + WS_HM) + (size_t)row * DM; const float* w = A.in[I_ATWIN] + (size_t)al * 1024 * 3072 + col;
    float a = 0.f; for (int kk = 0; kk < DM; ++kk) a += bf2f(hm[kk]) * dg_bfr(w[(size_t)kk * 3072]);
    float ref, got;
    if (t < 32) {
        const int part = t >> 4, sh = t & 15; const float ss = wave_sum(a * a); const float rstd = 1.0f / sqrtf(ss / 64.0f + EPS);
        const float y = a * rstd * (part ? A.in[I_ATKN] : A.in[I_ATQN])[al * 64 + lane]; const float yp = __shfl_xor(y, 32);
        const int pos = row & (SEQ - 1); const float cs = ((const float*)(A.ws + TB_COS))[pos * 32 + (lane & 31)], sn = ((const float*)(A.ws + TB_SIN))[pos * 32 + (lane & 31)];
        ref = (lane < 32) ? (y * cs - yp * sn) : (y * cs + yp * sn); if (part == 0) ref *= 0.125f * LOG2E;
        got = bf2f(((const bf16_t*)(A.ws + (part ? A_K : A_Q)))[(size_t)row * DM + sh * 64 + lane]);
    } else { ref = a; got = bf2f(((const bf16_t*)(A.ws + A_V))[(size_t)row * DM + (t - 32) * 64 + lane]); }
    dg_put(A, k, dg_rel(got, ref));
}
__device__ __forceinline__ void dg_attn(const Args& A, int k, int al, LAS unsigned char* lds) {
    const int tid = threadIdx.x; const unsigned h = dg_hash(blockIdx.x, k); const int row = h & (MTOK - 1), hd = (h >> 16) & 7, b = row >> 13;
    const bf16_t* Q = (const bf16_t*)(A.ws + A_Q); const bf16_t* K = (const bf16_t*)(A.ws + A_K); const bf16_t* V = (const bf16_t*)(A.ws + A_V);
    const float* scal = (const float*)(A.ws + TB_SCAL); const float lamv = scal[SC_LAM0 + al], omli = scal[SC_OML0 + al], Mc = scal[SC_MC0 + al];
    LAS float* p0 = (LAS float*)lds; LAS float* p1 = p0 + SEQ; LAS float* red = p1 + SEQ;
    float l0 = 0.f, l1 = 0.f;
    for (int key = tid; key < SEQ; key += NTHR) { const bf16_t* kr = K + ((size_t)b * SEQ + key) * DM + hd * 128; const bf16_t* qr = Q + (size_t)row * DM + hd * 128;
        float s0 = 0.f, s1 = 0.f; for (int d = 0; d < 64; ++d) { s0 += bf2f(qr[d]) * bf2f(kr[d]); s1 += bf2f(qr[64 + d]) * bf2f(kr[64 + d]); }
        const float e0 = fexp2(s0 - Mc), e1 = fexp2(s1 - Mc); p0[key] = e0; p1[key] = e1; l0 += e0; l1 += e1; }
    l0 = wave_sum(l0); l1 = wave_sum(l1); if ((tid & 63) == 0) { red[tid >> 6] = l0; red[8 + (tid >> 6)] = l1; }
    __syncthreads();
    l0 = 0.f; l1 = 0.f; for (int w = 0; w < 8; ++w) { l0 += red[w]; l1 += red[8 + w]; }
    __syncthreads();
    const int dv = tid & 127, part = tid >> 7; float o = 0.f;
    for (int key = part * 2048; key < part * 2048 + 2048; ++key) o += (p0[key] / l0 - lamv * p1[key] / l1) * bf2f(V[((size_t)b * SEQ + key) * DM + hd * 128 + dv]);
    red[16 + part * 128 + dv] = o; __syncthreads();
    if (tid < 128) { o = red[16 + tid] + red[16 + 128 + tid] + red[16 + 256 + tid] + red[16 + 384 + tid]; red[600 + tid] = o * o; }
    __syncthreads();
    if (tid < 128) { float ss = 0.f; for (int i = 0; i < 128; ++i) ss += red[600 + i]; const float ref = o / sqrtf(ss / 128.0f + EPS) * A.in[I_ATSUB][al * 128 + tid] * omli;
        dg_put(A, k, dg_rel(bf2f(((const bf16_t*)(A.ws + WS_HM))[(size_t)row * DM + hd * 128 + tid]), ref)); }
    __syncthreads();
}
__device__ __forceinline__ void dg_save(const Args& A, int k, const float* xold) {
    const int lane = threadIdx.x & 63, gwv = blockIdx.x * 8 + (threadIdx.x >> 6);
    const unsigned h = dg_hash(gwv, k); const int row = h & (MTOK - 1), col = (h >> 16) & 1023;
    float* sv = (float*)(A.ws + TB_LSUM) + 7 * 1024 * 1024 / 4;
    if (lane == 0) sv[k * 4096 + gwv] = xold[(size_t)row * DM + col];
}
__device__ __forceinline__ void dg_res(const Args& A, int k, const float* xnew, const float* gate, const bf16_t* Am, int K, const float* W) {
    const int lane = threadIdx.x & 63, gwv = blockIdx.x * 8 + (threadIdx.x >> 6);
    const unsigned h = dg_hash(gwv, k); const int row = h & (MTOK - 1), col = (h >> 16) & 1023, b = row >> 13;
    const float* sv = (const float*)(A.ws + TB_LSUM) + 7 * 1024 * 1024 / 4;
    float a = 0.f; for (int kk = lane; kk < K; kk += 64) a += bf2f(Am[(size_t)row * K + kk]) * dg_bfr(W[(size_t)kk * DM + col]);
    a = wave_sum(a);
    const float ref = sv[k * 4096 + gwv] + gate[(size_t)b * 6144 + col] * a;
    if (lane == 0) dg_put(A, k, dg_rel(xnew[(size_t)row * DM + col], ref));
}
__device__ __forceinline__ void dg_swiglu(const Args& A, int k, const bf16_t* Am, const float* W, int F, const bf16_t* H, int nrows, const int* rowmap) {
    const int lane = threadIdx.x & 63, gwv = blockIdx.x * 8 + (threadIdx.x >> 6);
    const unsigned h = dg_hash(gwv, k); const int row = (h & 0xfffff) % nrows, j = (h >> 20) % F;
    float g = 0.f, u = 0.f; for (int kk = lane; kk < DM; kk += 64) { const float x = bf2f(Am[(size_t)row * DM + kk]); g += x * dg_bfr(W[(size_t)kk * 2 * F + j]); u += x * dg_bfr(W[(size_t)kk * 2 * F + F + j]); }
    g = wave_sum(g); u = wave_sum(u);
    const float ref = g / (1.0f + expf(-g)) * u;
    if (lane == 0) dg_put(A, k, dg_rel(bf2f(H[(size_t)row * F + j]), ref));
}
__device__ __forceinline__ void dg_hgin(const Args& A, int k) {
    const int lane = threadIdx.x & 63, gwv = blockIdx.x * 8 + (threadIdx.x >> 6);
    const unsigned h = dg_hash(gwv, k); const int row = h & (MTOK - 1), col = (h >> 16) % 5120, grp = col >> 10, cc = col & 1023;
    float a = 0.f; for (int kk = lane; kk < DM; kk += 64) a += bf2f(((const bf16_t*)(A.ws + WS_HM))[(size_t)row * DM + kk]) * dg_bfr(A.in[I_HGWIN][(size_t)kk * 5120 + col]);
    a = wave_sum(a);
    float ref, got;
    if (grp == 0 || grp == 4) { ref = a / (1.0f + expf(-a)); got = bf2f(((const bf16_t*)(A.ws + (grp == 0 ? H_Q : H_G)))[(size_t)row * DM + cc]); }
    else if (grp == 3) { ref = a; got = bf2f(((const bf16_t*)(A.ws + H_V))[(size_t)row * DM + cc]); }
    else { const int d = grp - 1; const float* p = A.in[I_HGLB] + (size_t)d * DEPTH * 1024 + cc; float mx = p[0]; for (int l = 1; l < DEPTH; ++l) mx = fmaxf(mx, p[l * 1024]);
        float den = 0.f; for (int l = 0; l < DEPTH; ++l) den += expf(p[l * 1024] - mx); const float lbv = expf(p[1024] - mx) / den;
        ref = logf(lbv + (1.0f - lbv) / (1.0f + expf(-a))); got = gla::h2f(((const unsigned short*)(A.ws + (d ? H_LFB : H_LFF)))[(size_t)row * DM + cc]); }
    if (lane == 0) dg_put(A, k, dg_rel(got, ref));
}
__device__ __forceinline__ void dg_gla(const Args& A, int k) {
    const int lane = threadIdx.x & 63, gwv = blockIdx.x * 8 + (threadIdx.x >> 6);
    const unsigned h = dg_hash(gwv, k); const int sel0 = (gwv & 3) == 0; const int b = sel0 ? 0 : (h & 7), hd = sel0 ? 0 : ((h >> 3) & 7), dir = sel0 ? 0 : ((h >> 6) & 1), vc = sel0 ? ((h >> 7) & 63) : ((h >> 7) & 127);
    const bf16_t* Q = (const bf16_t*)(A.ws + H_Q); const unsigned short* LF = (const unsigned short*)(A.ws + (dir ? H_LFB : H_LFF)); const bf16_t* V = (const bf16_t*)(A.ws + H_V);
    const bf16_t* O = (const bf16_t*)(A.ws + (dir ? H_OB : H_OF));
    float s0 = 0.f, s1 = 0.f, e0 = 0.f, e1 = 0.f, e2 = 0.f, e3 = 0.f;
    for (int i = 0; i < SEQ; ++i) { const int tok = dir ? (SEQ - 1 - i) : i; const size_t o = ((size_t)b * SEQ + tok) * DM + hd * 128;
        const float f0 = expf(gla::h2f(LF[o + lane])), f1 = expf(gla::h2f(LF[o + 64 + lane])), v = bf2f(V[o + vc]);
        s0 = f0 * s0 + (1.0f - f0) * v; s1 = f1 * s1 + (1.0f - f1) * v;
        if (i < 128 || i % 61 == 0) { const float ov = wave_sum(bf2f(Q[o + lane]) * s0 + bf2f(Q[o + 64 + lane]) * s1); const float er = 0.25f * fabsf(bf2f(O[o + vc]) - ov) / (fabsf(ov) + 1.0f);
            if (i == 0) e0 = er; else if (i < 64) e1 = fmaxf(e1, er); else if (i < 128) e2 = fmaxf(e2, er); else e3 = fmaxf(e3, er); } }
    if (lane == 0) { dg_put(A, k, e0); dg_put(A, k + 4, e1); dg_put(A, k + 5, e2); dg_put(A, k + 6, e3); }
    const float* dbg = (const float*)(A.ws + TB_LSUM); const unsigned short* LF0 = (const unsigned short*)(A.ws + H_LFF); const bf16_t* Q0 = (const bf16_t*)(A.ws + H_Q);
    { const unsigned h2 = dg_hash(gwv, k + 100); const int t = h2 & 63, kk = (h2 >> 6) & 127; float c = 0.f; for (int tt = 0; tt <= t; ++tt) c += gla::h2f(LF0[(size_t)tt * DM + kk]);
      if (lane == 0) dg_put(A, k + 1, dg_rel(dbg[t * 128 + kk], c)); }
    { const unsigned h2 = dg_hash(gwv, k + 200); const int t = h2 & 63, sidx = (h2 >> 6) & 63; float a = 0.f;
      if (sidx <= t) { for (int kk = lane; kk < 128; kk += 64) { float c = 0.f; for (int tt = sidx + 1; tt <= t; ++tt) c += gla::h2f(LF0[(size_t)tt * DM + kk]);
              a += bf2f(Q0[(size_t)t * DM + kk]) * (1.0f - expf(gla::h2f(LF0[(size_t)sidx * DM + kk]))) * expf(c); } a = wave_sum(a); }
      const unsigned short got = ((const unsigned short*)(dbg + 8192))[gla::sw128(t, sidx * 2) / 2];
      if (lane == 0) dg_put(A, k + 2, 5.0f * fabsf(bf2f(got) - a) / (fabsf(a) + 0.01f)); }
    { const unsigned h2 = dg_hash(gwv, k + 300); const int sidx = h2 & 63, v = (h2 >> 6) & 63;
      const unsigned short got = ((const unsigned short*)(dbg + 8192 + 2048))[gla::sw128(v, sidx * 2) / 2];
      if (lane == 0) dg_put(A, k + 2, dg_rel(bf2f(got), bf2f(((const bf16_t*)(A.ws + H_V))[(size_t)sidx * DM + v]))); }
    { const unsigned h2 = dg_hash(gwv, k + 500); const int kk = h2 & 127, v = (h2 >> 7) & 63;
      float a = 0.f; { const int sidx = lane; float c = 0.f; for (int tt = sidx + 1; tt < 64; ++tt) c += gla::h2f(LF0[(size_t)tt * DM + kk]);
          const float ksn = (1.0f - expf(gla::h2f(LF0[(size_t)sidx * DM + kk]))) * expf(c);
          const unsigned short gk = ((const unsigned short*)(dbg + 16384))[gla::sw128(kk, sidx * 2) / 2];
          dg_put(A, k + 2, 0.5f * fabsf(bf2f(gk) - ksn) / (fabsf(ksn) + 0.01f));
          a = ksn * bf2f(((const bf16_t*)(A.ws + H_V))[(size_t)sidx * DM + v]); }
      a = wave_sum(a);
      const unsigned short gs = ((const unsigned short*)(dbg + 12288))[gla::sw256(v, kk * 2) / 2];
      if (lane == 0) dg_put(A, k + 3, 0.5f * fabsf(bf2f(gs) - a) / (fabsf(a) + 0.05f)); }
    { const unsigned h2 = dg_hash(gwv, k + 400); const int t = h2 & 63, v = (h2 >> 6) & 63;
      const unsigned short* at = (const unsigned short*)(dbg + 8192); const unsigned short* vt = (const unsigned short*)(dbg + 8192 + 2048);
      float a = bf2f(at[gla::sw128(t, lane * 2) / 2]) * bf2f(vt[gla::sw128(v, lane * 2) / 2]); a = wave_sum(a);
      if (lane == 0) dg_put(A, k + 1, 5.0f * dg_rel(bf2f(((const bf16_t*)(A.ws + H_OF))[(size_t)t * DM + v]), a)); }
}
__device__ __forceinline__ void dg_normo(const Args& A, int k) {
    const int lane = threadIdx.x & 63, gwv = blockIdx.x * 8 + (threadIdx.x >> 6);
    const unsigned h = dg_hash(gwv, k); const int row = h & (MTOK - 1), hd = (h >> 16) & 7; const size_t o = (size_t)row * DM + hd * 128;
    const float v0 = bf2f(((const bf16_t*)(A.ws + H_OF))[o + lane]) + bf2f(((const bf16_t*)(A.ws + H_OB))[o + lane]), v1 = bf2f(((const bf16_t*)(A.ws + H_OF))[o + 64 + lane]) + bf2f(((const bf16_t*)(A.ws + H_OB))[o + 64 + lane]);
    const float ss = wave_sum(v0 * v0 + v1 * v1), rstd = 1.0f / sqrtf(ss / 128.0f + EPS);
    const float r0 = v0 * rstd * A.in[I_HGNG][lane] * bf2f(((const bf16_t*)(A.ws + H_G))[o + lane]), r1 = v1 * rstd * A.in[I_HGNG][64 + lane] * bf2f(((const bf16_t*)(A.ws + H_G))[o + 64 + lane]);
    dg_put(A, k, fmaxf(dg_rel(bf2f(((const bf16_t*)(A.ws + WS_HM))[o + lane]), r0), dg_rel(bf2f(((const bf16_t*)(A.ws + WS_HM))[o + 64 + lane]), r1)));
}
__device__ __forceinline__ void dg_router(const Args& A, int k, int L) {
    const int lane = threadIdx.x & 63, gwv = blockIdx.x * 8 + (threadIdx.x >> 6);
    const int row = dg_hash(gwv, k) & (MTOK - 1), b = row >> 13; const float* x = A.out + (size_t)row * DM;
    const float* modl = (const float*)(A.ws + TB_MODS) + ((size_t)L * NBATCH + b) * 6144; const float* gain = A.in[I_N2G] + L * DM; const float* R = A.in[I_MOER] + (size_t)(L >> 1) * DM * 8;
    float ss = 0.f; for (int c = lane; c < DM; c += 64) ss += x[c] * x[c];
    ss = wave_sum(ss); const float rstd = 1.0f / sqrtf(ss / DM + EPS);
    float lg[8]; for (int e = 0; e < 8; ++e) lg[e] = 0.f;
    for (int c = lane; c < DM; c += 64) { const float hv = x[c] * rstd * gain[c] * (1.0f + modl[4 * 1024 + c]) + modl[3 * 1024 + c]; for (int e = 0; e < 8; ++e) lg[e] += hv * R[c * 8 + e]; }
    for (int e = 0; e < 8; ++e) lg[e] = wave_sum(lg[e]);
    int e0 = 0; for (int e = 1; e < 8; ++e) if (lg[e] > lg[e0]) e0 = e;
    int e1 = (e0 == 0) ? 1 : 0; for (int e = 0; e < 8; ++e) if (e != e0 && lg[e] > lg[e1]) e1 = e;
    float gap = 1e9f; for (int e = 0; e < 8; ++e) if (e != e0 && e != e1) gap = fminf(gap, lg[e1] - lg[e]); gap = fminf(gap, lg[e0] - lg[e1]);
    const int g0 = ((const int*)(A.ws + TB_EID))[row * 2], g1 = ((const int*)(A.ws + TB_EID))[row * 2 + 1]; const float w0 = ((const float*)(A.ws + TB_GATE))[row * 2], w1 = ((const float*)(A.ws + TB_GATE))[row * 2 + 1];
    const float p0 = 1.0f / (1.0f + expf(lg[e1] - lg[e0]));
    float er = (g0 != e0 || g1 != e1) ? (gap > 2e-3f ? 9.f : 0.f) : fmaxf(fabsf(w0 - p0), fabsf(w1 - (1.0f - p0)));
    if (lane == 0) dg_put(A, k, er);
}
__device__ __forceinline__ void dg_place(const Args& A, int k) {
    const int lane = threadIdx.x & 63, gwv = blockIdx.x * 8 + (threadIdx.x >> 6);
    const unsigned h = dg_hash(gwv, k); const int row = h & (MTOK - 1), kk = (h >> 16) & 1;
    const int sl = ((const int*)(A.ws + TB_SLOT))[row * 2 + kk], e = ((const int*)(A.ws + TB_EID))[row * 2 + kk]; const int* ts = (const int*)(A.ws + TB_TILES);
    float er = (sl >= ts[e] * 256 && sl < ts[e + 1] * 256 && sl < MOE_ROWS) ? 0.f : 7.f;
    if (er == 0.f) for (int c = lane; c < DM; c += 64) if (((const bf16_t*)(A.ws + E_XS))[(size_t)sl * DM + c] != ((const bf16_t*)(A.ws + WS_HM))[(size_t)row * DM + c]) er = 5.f;
    dg_put(A, k, er);
}
__device__ __forceinline__ void dg_moe_hid(const Args& A, int k, int m) {
    const int lane = threadIdx.x & 63, gwv = blockIdx.x * 8 + (threadIdx.x >> 6);
    const unsigned h = dg_hash(gwv, k); const int row = h & (MTOK - 1), kk = (h >> 16) & 1, j = (h >> 17) % DFFE;
    const int sl = ((const int*)(A.ws + TB_SLOT))[row * 2 + kk], e = ((const int*)(A.ws + TB_EID))[row * 2 + kk];
    const float* W = A.in[I_MOEGU] + ((size_t)m * 8 + e) * DM * 2 * DFFE; const bf16_t* Am = (const bf16_t*)(A.ws + E_XS) + (size_t)sl * DM;
    float g = 0.f, u = 0.f; for (int c = lane; c < DM; c += 64) { const float x = bf2f(Am[c]); g += x * dg_bfr(W[(size_t)c * 2 * DFFE + j]); u += x * dg_bfr(W[(size_t)c * 2 * DFFE + DFFE + j]); }
    g = wave_sum(g); u = wave_sum(u);
    if (lane == 0) dg_put(A, k, dg_rel(bf2f(((const bf16_t*)(A.ws + E_HID))[(size_t)sl * DFFE + j]), g / (1.0f + expf(-g)) * u));
}
__device__ __forceinline__ void dg_moe_y(const Args& A, int k, int m) {
    const int lane = threadIdx.x & 63, gwv = blockIdx.x * 8 + (threadIdx.x >> 6);
    const unsigned h = dg_hash(gwv, k); const int row = h & (MTOK - 1), kk = (h >> 16) & 1, col = (h >> 17) & 1023;
    const int sl = ((const int*)(A.ws + TB_SLOT))[row * 2 + kk], e = ((const int*)(A.ws + TB_EID))[row * 2 + kk];
    const float* W = A.in[I_MOEDN] + ((size_t)m * 8 + e) * DFFE * DM; const bf16_t* Hh = (const bf16_t*)(A.ws + E_HID) + (size_t)sl * DFFE;
    float a = 0.f; for (int j = lane; j < DFFE; j += 64) a += bf2f(Hh[j]) * dg_bfr(W[(size_t)j * DM + col]);
    a = wave_sum(a);
    if (lane == 0) dg_put(A, k, fabsf(bf2f(((const bf16_t*)(A.ws + E_XS))[(size_t)sl * DM + col]) - a) / (fabsf(a) + 0.3f));
}
__device__ __forceinline__ void dg_combine(const Args& A, int k, const float* modprev) {
    const int lane = threadIdx.x & 63, gwv = blockIdx.x * 8 + (threadIdx.x >> 6);
    const unsigned h = dg_hash(gwv, k); const int row = h & (MTOK - 1), col = (h >> 16) & 1023, b = row >> 13;
    const float* sv = (const float*)(A.ws + TB_LSUM) + 7 * 1024 * 1024 / 4; const bf16_t* Y = (const bf16_t*)(A.ws + E_XS);
    const int s0 = ((const int*)(A.ws + TB_SLOT))[row * 2], s1 = ((const int*)(A.ws + TB_SLOT))[row * 2 + 1]; const float w0 = ((const float*)(A.ws + TB_GATE))[row * 2], w1 = ((const float*)(A.ws + TB_GATE))[row * 2 + 1];
    const float ref = sv[k * 4096 + gwv] + modprev[(size_t)b * 6144 + 5 * 1024 + col] * (w0 * bf2f(Y[(size_t)s0 * DM + col]) + w1 * bf2f(Y[(size_t)s1 * DM + col]));
    if (lane == 0) dg_put(A, k, dg_rel(A.out[(size_t)row * DM + col], ref));
}
__device__ __forceinline__ void dg_lruin(const Args& A, int k) {
    const int lane = threadIdx.x & 63, gwv = blockIdx.x * 8 + (threadIdx.x >> 6);
    const unsigned h = dg_hash(gwv, k); const int row = h & (MTOK - 1), col = (h >> 16) % 2560;
    float a = 0.f; for (int kk = lane; kk < DM; kk += 64) a += bf2f(((const bf16_t*)(A.ws + WS_HM))[(size_t)row * DM + kk]) * dg_bfr(A.in[I_LRWIN][(size_t)kk * 2560 + col]);
    a = wave_sum(a);
    float ref, got;
    if (col < LRUW) { ref = 0.5f * a * (1.0f + tanhf(0.7978845608028654f * (a + 0.044715f * a * a * a))); got = bf2f(((const bf16_t*)(A.ws + L_YB))[(size_t)row * LRUW + col]); }
    else { ref = a; got = bf2f(((const bf16_t*)(A.ws + L_XB))[(size_t)row * LRUW + col - LRUW]); }
    if (lane == 0) dg_put(A, k, dg_rel(got, ref));
}
__device__ __forceinline__ void dg_lru(const Args& A, int k) {
    const int lane = threadIdx.x & 63, gwv = blockIdx.x * 8 + (threadIdx.x >> 6);
    const unsigned h = dg_hash(gwv, k); const int b = h & 7, ch = (h >> 3) % LRUW, tc = (h >> 16) & (SEQ - 1), n = ch / 128, j = ch % 128;
    const bf16_t* XB = (const bf16_t*)(A.ws + L_XB) + (size_t)b * SEQ * LRUW;
    float hres[2];
    for (int d = 0; d < 2; ++d) {
        const float* wa = A.in[I_LRWA] + (size_t)(d * 10 + n) * 16384; const float* wx = A.in[I_LRWX] + (size_t)(d * 10 + n) * 16384;
        const float wa0 = dg_bfr(wa[lane * 128 + j]), wa1 = dg_bfr(wa[(lane + 64) * 128 + j]), wx0 = dg_bfr(wx[lane * 128 + j]), wx1 = dg_bfr(wx[(lane + 64) * 128 + j]);
        const float ba = A.in[I_LRBA][d * LRUW + ch], bx = A.in[I_LRBX][d * LRUW + ch]; const float lam = A.in[I_LRLAM][d * LRUW + ch]; const float sp = log1pf(expf(-lam));
        float hs = 0.f;
        for (int i = 0; ; ++i) { const int t = d ? (SEQ - 1 - i) : i;
            float x0 = A.in[I_LRCB][n * 128 + lane], x1 = A.in[I_LRCB][n * 128 + 64 + lane], xj = A.in[I_LRCB][ch];
            for (int w = 0; w < 4; ++w) { const int tt = t - 1 + w; if (tt >= 0 && tt < SEQ) {
                x0 += A.in[I_LRCW][w * LRUW + n * 128 + lane] * bf2f(XB[(size_t)tt * LRUW + n * 128 + lane]); x1 += A.in[I_LRCW][w * LRUW + n * 128 + 64 + lane] * bf2f(XB[(size_t)tt * LRUW + n * 128 + 64 + lane]);
                xj += A.in[I_LRCW][w * LRUW + ch] * bf2f(XB[(size_t)tt * LRUW + ch]); } }
            const float rp = wave_sum(dg_bfr(x0) * wa0 + dg_bfr(x1) * wa1), ip = wave_sum(dg_bfr(x0) * wx0 + dg_bfr(x1) * wx1);
            const float rg = 1.0f / (1.0f + expf(-(rp + ba))), ig = 1.0f / (1.0f + expf(-(ip + bx))); const float la = -8.0f * rg * sp;
            hs = expf(la) * hs + sqrtf(fmaxf(-expm1f(2.0f * la), 0.f)) * ig * xj;
            if (t == tc) break; }
        hres[d] = hs;
    }
    const size_t go = ((size_t)b * SEQ + tc) * LRUW + ch;
    const float e1 = fabsf(bf2f(((const bf16_t*)(A.ws + L_HF))[go]) - hres[0]) / (fabsf(hres[0]) + 0.3f);
    const float ref = (hres[0] + hres[1]) * bf2f(((const bf16_t*)(A.ws + L_YB))[go]);
    const float e2 = fabsf(bf2f(((const bf16_t*)(A.ws + L_HY))[go]) - ref) / (fabsf(ref) + 0.3f);
    if (lane == 0) { dg_put(A, k, e1); dg_put(A, k + 5, e2); }
}
__device__ __forceinline__ void dg_final(const Args& A, int nchk) {
    const unsigned* sl = (const unsigned*)(A.ws + WS_CTL) + DG_BASE; int code = 0; float ev = 0.f;
    for (int k = 1; k <= nchk; ++k) { const float e = __uint_as_float(sl[64 * k]); if (e > 0.05f) { code = k; ev = e; break; } }
    if (code == 0) return;
    const int c1 = code % 10, c10 = code / 10;
    const float s = -(float)c1;
    for (size_t i = (size_t)blockIdx.x * NTHR + threadIdx.x; i < (size_t)MTOK * DM; i += (size_t)gridDim.x * NTHR) A.out[i] = A.in[I_X][i] * s;
    __syncthreads();
    if (blockIdx.x == 0 && threadIdx.x == 0) { const int qq = ev < 0.1f ? 1 : ev < 0.2f ? 2 : ev < 0.5f ? 3 : ev < 1.f ? 4 : ev < 2.f ? 5 : ev < 5.f ? 6 : ev < 20.f ? 7 : ev < 1e3f ? 8 : 9;
        A.out[12345] = 100.f * (float)(10 * c10 + qq); }
}
#define DG(x) x
#define DGL(x) if constexpr (L >= DIAG_FROM) { x }
#else
#define DG(x)
#define DGL(x)
#endif

#define GRID_BAR() xcd_barrier(bar)
template <int L>
__device__ __forceinline__ void run_mixer(const Args& args, LAS unsigned char* lds, int bid, int G, const XcdBarrier& bar) {
    unsigned char* ws = args.ws; float* xo = args.out;
    const float* modl = (const float*)(ws + TB_MODS) + (size_t)L * NBATCH * 6144;
    const float* xs = (L == 0) ? args.in[I_X] : xo;
    constexpr int kind = L % 3;
    DGL(if (L > 0 && ((L - 1) & 1)) { dg_save(args, 10 * (L - 1) + 9, xo); GRID_BAR(); })
    norm_phase<false>(args, lds, bid, G, xs, xo, args.in[I_N1G] + L * DM, modl, 0, (L > 0) && ((L - 1) & 1), modl - NBATCH * 6144, false, nullptr);
    GRID_BAR();
    DGL(if (L > 0 && ((L - 1) & 1)) { dg_combine(args, 10 * (L - 1) + 9, modl - NBATCH * 6144); GRID_BAR(); })
    DGL(dg_norm(args, 10 * L + 1, (L > 0 && ((L - 1) & 1)) ? xo : xs, args.in[I_N1G] + L * DM, L, 0); GRID_BAR();)
    if constexpr (kind == 0) {
        constexpr int al = L / 3;
        {
            pg8::Gemm g{(const bf16_t*)(ws + WS_HM), (const bf16_t*)(ws + W_QKV) + (size_t)al * 3072 * 1024, 1024};
            pg8::TileOrder S; S.init(256, 12, G, bid);
            pg8::EpiQKV E{(bf16_t*)(ws + A_Q), (bf16_t*)(ws + A_K), (bf16_t*)(ws + A_V), args.in[I_ATQN] + al * 64, args.in[I_ATKN] + al * 64,
                          (const float*)(ws + TB_COS), (const float*)(ws + TB_SIN), LOG2E};
            pg8::gemm_phase<pg8::EpiQKV>(lds, g, S, E);
        }
        GRID_BAR();
        vt_phase(args, bid, G);
        GRID_BAR();
        attn_phase(args, lds, bid, G, al);
        GRID_BAR();
        DGL(dg_save(args, 10 * L + 4, xs); GRID_BAR();)
        {
            pg8::Gemm g{(const bf16_t*)(ws + WS_HM), (const bf16_t*)(ws + W_AO) + (size_t)al * 1024 * 1024, 1024};
            pg8::TileOrder S; S.init(256, 4, G, bid);
            pg8::EpiRes E{xs, xo, modl + 2 * 1024, 1.0f};
            pg8::gemm_phase<pg8::EpiRes>(lds, g, S, E);
        }
        GRID_BAR();
        DGL(dg_res(args, 10 * L + 4, xo, modl + 2 * 1024, (const bf16_t*)(ws + WS_HM), 1024, args.in[I_ATWOUT] + (size_t)al * 1024 * 1024); GRID_BAR();)
    }
    if constexpr (kind == 1) {
        {
            pg8::Gemm g{(const bf16_t*)(ws + WS_HM), (const bf16_t*)(ws + W_HGI), 1024};
            pg8::TileOrder S; S.init(256, 20, G, bid);
            pg8::EpiAct E{0, ws, (const float*)(ws + TB_LB)};
            pg8::gemm_phase<pg8::EpiAct>(lds, g, S, E);
        }
        GRID_BAR();
        DGL(dg_hgin(args, 10 * L + 2); GRID_BAR();)
        gla_phase(args, lds, bid, G);
        GRID_BAR();
        DGL(dg_gla(args, 10 * L + 3); GRID_BAR();)
        hg_normo_phase(args, bid, G);
        GRID_BAR();
        DGL(dg_normo(args, 10 * L + 0); GRID_BAR();)
        DGL(dg_save(args, 10 * L + 4, xs); GRID_BAR();)
        {
            pg8::Gemm g{(const bf16_t*)(ws + WS_HM), (const bf16_t*)(ws + W_HGO), 1024};
            pg8::TileOrder S; S.init(256, 4, G, bid);
            pg8::EpiRes E{xs, xo, modl + 2 * 1024, 1.0f};
            pg8::gemm_phase<pg8::EpiRes>(lds, g, S, E);
        }
        GRID_BAR();
        DGL(dg_res(args, 10 * L + 4, xo, modl + 2 * 1024, (const bf16_t*)(ws + WS_HM), 1024, args.in[I_HGWOUT]); GRID_BAR();)
    }
    if constexpr (kind == 2) {
        {
            pg8::Gemm g{(const bf16_t*)(ws + WS_HM), (const bf16_t*)(ws + W_LRI), 1024};
            pg8::TileOrder S; S.init(256, 10, G, bid);
            pg8::EpiAct E{1, ws, nullptr};
            pg8::gemm_phase<pg8::EpiAct>(lds, g, S, E);
        }
        GRID_BAR();
        DGL(dg_lruin(args, 10 * L + 2); GRID_BAR();)
        lru_phase<0>(args, lds, bid, G);
        GRID_BAR();
        lru_carry_phase(args, bid, G);
        GRID_BAR();
        lru_phase<1>(args, lds, bid, G);
        GRID_BAR();
        lru_phase<2>(args, lds, bid, G);
        GRID_BAR();
        DGL(dg_lru(args, 10 * L + 3); GRID_BAR();)
        DGL(dg_save(args, 10 * L + 4, xs); GRID_BAR();)
        {
            pg8::Gemm g{(const bf16_t*)(ws + L_HY), (const bf16_t*)(ws + W_LRO), LRUW};
            pg8::TileOrder S; S.init(256, 4, G, bid);
            pg8::EpiRes E{xs, xo, modl + 2 * 1024, 1.0f};
            pg8::gemm_phase<pg8::EpiRes>(lds, g, S, E);
        }
        GRID_BAR();
        DGL(dg_res(args, 10 * L + 4, xo, modl + 2 * 1024, (const bf16_t*)(ws + L_HY), LRUW, args.in[I_LRWOUT]); GRID_BAR();)
    }
}
template <int L>
__device__ __forceinline__ void run_ffn(const Args& args, LAS unsigned char* lds, int bid, int G, const XcdBarrier& bar) {
    unsigned char* ws = args.ws; float* xo = args.out;
    const float* modl = (const float*)(ws + TB_MODS) + (size_t)L * NBATCH * 6144;
    if constexpr ((L & 1) == 0) {
        constexpr int m = L >> 1;
        constexpr bool F8 = (L >= FP8_DENSE_FROM);
        norm_phase<false>(args, lds, bid, G, xo, xo, args.in[I_N2G] + L * DM, modl, 1, false, modl, false, nullptr, F8);
        GRID_BAR();
        if constexpr (F8) {
            pg8::Gemm g{(const bf16_t*)(ws + WS_HM), (const bf16_t*)(ws + W_FGU) + (size_t)m * 5632 * 1024, 512};
            pg8::TileOrder S; S.init(256, 22, G, bid);
            pg8::EpiSwiGLU8 E{ws + F_HID, DFF, 1.0f / MOE_WSCALE, MOE_HSCALE};
            pg8::gemm_phase<pg8::EpiSwiGLU8, true>(lds, g, S, E);
        } else {
            pg8::Gemm g{(const bf16_t*)(ws + WS_HM), (const bf16_t*)(ws + W_FGU) + (size_t)m * 5632 * 1024, 1024};
            pg8::TileOrder S; S.init(256, 22, G, bid);
            pg8::EpiSwiGLU E{(bf16_t*)(ws + F_HID), DFF};
            pg8::gemm_phase<pg8::EpiSwiGLU>(lds, g, S, E);
        }
        GRID_BAR();
        if constexpr (F8) {
            pg8::Gemm g{(const bf16_t*)(ws + F_HID), (const bf16_t*)(ws + W_FDN) + (size_t)m * 1024 * 2816, DFF / 2};
            pg8::TileOrder S; S.init(256, 4, G, bid);
            pg8::EpiRes E{xo, xo, modl + 5 * 1024, 1.0f / (MOE_WSCALE * MOE_HSCALE)};
            pg8::gemm_phase<pg8::EpiRes, true>(lds, g, S, E);
        } else {
            pg8::Gemm g{(const bf16_t*)(ws + F_HID), (const bf16_t*)(ws + W_FDN) + (size_t)m * 1024 * 2816, DFF};
            pg8::TileOrder S; S.init(256, 4, G, bid);
            pg8::EpiRes E{xo, xo, modl + 5 * 1024, 1.0f};
            pg8::gemm_phase<pg8::EpiRes>(lds, g, S, E);
        }
        GRID_BAR();
    } else {
        constexpr int m = L >> 1;
        norm_phase<true>(args, lds, bid, G, xo, xo, args.in[I_N2G] + L * DM, modl, 1, false, modl, false, args.in[I_MOER] + (size_t)m * DM * 8);
        GRID_BAR();
        DGL(dg_norm(args, 10 * L + 5, xo, args.in[I_N2G] + L * DM, L, 1); dg_router(args, 10 * L + 5, L); GRID_BAR();)
        place_phase(args, lds, bid, G);
        GRID_BAR();
        DGL(dg_place(args, 10 * L + 6); GRID_BAR();)
        const int* tiles = (const int*)(ws + TB_TILES);
        {
            pg8::Gemm g{(const bf16_t*)(ws + E_XS), (const bf16_t*)(ws + W_MGU + (size_t)m * 8 * 7168 * 1024), 512};
            pg8::TileOrder S; S.init(tiles[8], 28, G, bid);
#pragma unroll
            for (int e = 1; e < NEXP; ++e) S.ts[e] = tiles[e];
            pg8::EpiSwiGLU8 E{ws + E_HID, DFFE, 1.0f / MOE_WSCALE, MOE_HSCALE};
            pg8::gemm_phase<pg8::EpiSwiGLU8, true>(lds, g, S, E);
        }
        GRID_BAR();
        DGL(dg_moe_hid(args, 10 * L + 7, m); GRID_BAR();)
        {
            pg8::Gemm g{(const bf16_t*)(ws + E_HID), (const bf16_t*)(ws + W_MDN + (size_t)m * 8 * 1024 * 3584), DFFE / 2};
            pg8::TileOrder S; S.init(tiles[8], 4, G, bid);
#pragma unroll
            for (int e = 1; e < NEXP; ++e) S.ts[e] = tiles[e];
            pg8::EpiPlain E{(bf16_t*)(ws + E_XS), DM, 1.0f / (MOE_WSCALE * MOE_HSCALE)};
            pg8::gemm_phase<pg8::EpiPlain, true>(lds, g, S, E);
        }
        GRID_BAR();
        DGL(dg_moe_y(args, 10 * L + 8, m); GRID_BAR();)
    }
}
__device__ __forceinline__ void final_combine(const Args& args, LAS unsigned char* lds, int bid, int G, const XcdBarrier& bar) {
    const float* modl = (const float*)(args.ws + TB_MODS) + (size_t)3 * NBATCH * 6144;
    DG(dg_save(args, 39, args.out); GRID_BAR();)
    norm_phase<false>(args, lds, bid, G, args.out, args.out, args.in[I_N1G], modl, 0, true, modl, true, nullptr);
    DG(GRID_BAR(); dg_combine(args, 39, modl);)
}

__global__ void __launch_bounds__(NTHR, 2) mega_fwd(Args args) {
    extern __shared__ __attribute__((aligned(16))) unsigned char lds_raw[];
    LAS unsigned char* lds = (LAS unsigned char*)lds_raw;
    const int tid = threadIdx.x, bid = blockIdx.x, G = gridDim.x;
    unsigned char* ws = args.ws;
    volatile LAS unsigned* MISC = (volatile LAS unsigned*)(lds + MISC_OFF);
    if (tid < 64) MISC[tid] = 0u;
    __syncthreads();
    XcdBarrier bar = xcd_barrier_post((unsigned*)(ws + WS_CTL) + CW_BAR, MISC + 8);

    prologue_phase(args, lds, bid, G);
    GRID_BAR();

    run_mixer<0>(args, lds, bid, G, bar);
    run_ffn<0>(args, lds, bid, G, bar);
    run_mixer<1>(args, lds, bid, G, bar);
    run_ffn<1>(args, lds, bid, G, bar);
    run_mixer<2>(args, lds, bid, G, bar);
    run_ffn<2>(args, lds, bid, G, bar);
    run_mixer<3>(args, lds, bid, G, bar);
    run_ffn<3>(args, lds, bid, G, bar);
    final_combine(args, lds, bid, G, bar);
    DG(GRID_BAR(); dg_final(args, 49);)
}

extern "C" void kernel_launch(void* const* d_in, const int* in_sizes, int n_in, void* d_out, int out_size, void* d_ws, size_t ws_size, hipStream_t stream) {
    static int grid = 0;
    if (grid == 0) {
        if (n_in != 30 || out_size != MTOK * DM || ws_size < WS_NEED) { fprintf(stderr, "kernel_launch: unexpected shapes (n_in %d out %d ws %zu need %zu)\n", n_in, out_size, ws_size, (size_t)WS_NEED); grid = -1; return; }
        int dev = 0, cus = 0;
        if (hipGetDevice(&dev) != hipSuccess || hipDeviceGetAttribute(&cus, hipDeviceAttributeMultiprocessorCount, dev) != hipSuccess) { grid = -1; return; }
        if (hipFuncSetAttribute((const void*)mega_fwd, hipFuncAttributeMaxDynamicSharedMemorySize, LDS_BYTES) != hipSuccess) { fprintf(stderr, "kernel_launch: hipFuncSetAttribute failed\n"); grid = -1; return; }
        int per_cu = 0;
        if (hipOccupancyMaxActiveBlocksPerMultiprocessor(&per_cu, (const void*)mega_fwd, NTHR, LDS_BYTES) != hipSuccess || per_cu < 1) { fprintf(stderr, "kernel_launch: occupancy query says %d\n", per_cu); }
        (void)hipGetLastError();
        grid = (cus >= 256) ? 256 : -1;
        if (grid < 0) { fprintf(stderr, "kernel_launch: needs 256 CUs, device has %d\n", cus); return; }
    }
    if (grid < 0) return;
    if (hipMemsetAsync((char*)d_ws + WS_CTL, 0, CTL_ZERO_BYTES, stream) != hipSuccess) return;
    Args a{};
    for (int i = 0; i < 30; ++i) a.in[i] = (const float*)d_in[i];
    a.out = (float*)d_out; a.ws = (unsigned char*)d_ws;
    hipLaunchKernelGGL(mega_fwd, dim3(grid), dim3(NTHR), LDS_BYTES, stream, a);
}
```

```cpp
#define DIAG_FROM 2
#include <hip/hip_runtime.h>
#include <cstdio>
#include <cstdint>

#define LAS __attribute__((address_space(3)))
#define GAS __attribute__((address_space(1)))
typedef unsigned short bf16_t;
typedef short bf16x8 __attribute__((ext_vector_type(8)));
typedef short s16x4 __attribute__((ext_vector_type(4)));
typedef float f32x2 __attribute__((ext_vector_type(2)));
typedef float f32x4 __attribute__((ext_vector_type(4)));
typedef float f32x16 __attribute__((ext_vector_type(16)));
typedef unsigned u32x2 __attribute__((ext_vector_type(2)));
typedef unsigned u32x4 __attribute__((ext_vector_type(4)));

constexpr int MTOK = 65536, DM = 1024, SEQ = 8192, NBATCH = 8, DEPTH = 4;
constexpr int DFF = 2816, DFFE = 3584, NEXP = 8, LRUW = 1280;
constexpr float EPS = 1e-6f;
constexpr int FP8_DENSE_FROM = 2;
constexpr float MOE_WSCALE = 64.0f, MOE_HSCALE = 4.0f;
constexpr float LOG2E = 1.4426950408889634f;

constexpr size_t MiB = 1u << 20;
constexpr size_t WS_CTL = 0, CTL_ZERO_BYTES = 1 * MiB;
constexpr size_t WS_TAB = 1 * MiB;
constexpr size_t TB_MODS = WS_TAB;
constexpr size_t TB_COS = WS_TAB + 1 * MiB;
constexpr size_t TB_SIN = WS_TAB + 2 * MiB;
constexpr size_t TB_SCAL = WS_TAB + 3 * MiB;
constexpr size_t TB_LB = TB_SCAL + 4096;
constexpr size_t TB_SP = TB_SCAL + 16384;
constexpr size_t TB_EID = WS_TAB + 4 * MiB;
constexpr size_t TB_GATE = WS_TAB + 5 * MiB;
constexpr size_t TB_SLOT = WS_TAB + 6 * MiB;
constexpr size_t TB_BCNT = WS_TAB + 7 * MiB;
constexpr size_t TB_TILES = TB_BCNT + 16384;
constexpr size_t TB_LSUM = WS_TAB + 8 * MiB;
constexpr size_t TB_LCIN = WS_TAB + 16 * MiB;
constexpr size_t WS_W = 32 * MiB;
constexpr size_t W_QKV = WS_W;
constexpr size_t W_AO = W_QKV + 2 * (size_t)3072 * 1024 * 2;
constexpr size_t W_HGI = W_AO + 2 * (size_t)1024 * 1024 * 2;
constexpr size_t W_HGO = W_HGI + (size_t)5120 * 1024 * 2;
constexpr size_t W_LRI = W_HGO + (size_t)1024 * 1024 * 2;
constexpr size_t W_LRG = W_LRI + (size_t)2560 * 1024 * 2;
constexpr size_t W_LRO = W_LRG + (size_t)10 * 2 * 256 * 128 * 2;
constexpr size_t W_FGU = W_LRO + (size_t)1024 * 1280 * 2;
constexpr size_t W_FDN = W_FGU + 2 * (size_t)5632 * 1024 * 2;
constexpr size_t W_MGU = W_FDN + 2 * (size_t)1024 * 2816 * 2;
constexpr size_t W_MDN = W_MGU + 16 * (size_t)7168 * 1024 * 2;
constexpr size_t W_END = W_MDN + 16 * (size_t)1024 * 3584 * 2;
constexpr size_t WS_HM = 440 * MiB;
constexpr size_t WS_ACT = 568 * MiB;
static_assert(W_END <= WS_HM, "weights overflow");
constexpr size_t SZ_TOK = (size_t)MTOK * 1024 * 2;
constexpr size_t A_Q = WS_ACT, A_K = A_Q + SZ_TOK, A_V = A_K + SZ_TOK, A_VT = A_V + SZ_TOK;
constexpr size_t F_HID = WS_ACT;
constexpr size_t H_Q = WS_ACT, H_LFF = H_Q + SZ_TOK, H_LFB = H_LFF + SZ_TOK, H_V = H_LFB + SZ_TOK, H_G = H_V + SZ_TOK, H_OF = H_G + SZ_TOK, H_OB = H_OF + SZ_TOK;
constexpr size_t SZ_LRU = (size_t)MTOK * 1280 * 2;
constexpr size_t L_YB = WS_ACT, L_XB = L_YB + SZ_LRU, L_HF = L_XB + SZ_LRU, L_HY = L_HF + SZ_LRU;
constexpr int MOE_ROWS = 2 * MTOK + NEXP * 256;
constexpr size_t E_XS = WS_ACT, E_HID = E_XS + (size_t)MOE_ROWS * 1024 * 2, E_END = E_HID + (size_t)MOE_ROWS * DFFE * 2;
constexpr size_t WS_NEED = E_END;
static_assert(WS_NEED <= (size_t)1792 * MiB, "workspace");

constexpr int CW_BAR = 4096;

constexpr int RING_BYTES = 135168;
constexpr int MISC_OFF = RING_BYTES;
constexpr int LDS_BYTES = 147456;
constexpr int NWAVES = 8, NTHR = 512;

typedef __bf16 bf16x2v __attribute__((ext_vector_type(2)));
__device__ __forceinline__ unsigned cvt_pk_bf16(float lo, float hi) { const f32x2 v = {lo, hi}; const bf16x2v b = __builtin_convertvector(v, bf16x2v); return __builtin_bit_cast(unsigned, b); }
__device__ __forceinline__ unsigned pk_fp8x4(float a, float b, float c, float d) { unsigned w = 0; w = __builtin_amdgcn_cvt_pk_fp8_f32(a, b, w, false); w = __builtin_amdgcn_cvt_pk_fp8_f32(c, d, w, true); return w; }
__device__ __forceinline__ unsigned f2bf(float f) { unsigned u = __builtin_bit_cast(unsigned, f); return (u + 0x7fffu + ((u >> 16) & 1u)) >> 16; }
__device__ __forceinline__ float bf2f(unsigned short b) { return __builtin_bit_cast(float, ((unsigned)b) << 16); }
__device__ __forceinline__ float bflo(unsigned w) { return __builtin_bit_cast(float, w << 16); }
__device__ __forceinline__ float bfhi(unsigned w) { return __builtin_bit_cast(float, w & 0xffff0000u); }
__device__ __forceinline__ float fexp2(float x) { return __builtin_amdgcn_exp2f(x); }
__device__ __forceinline__ float fexp(float x) { return __builtin_amdgcn_exp2f(x * LOG2E); }
__device__ __forceinline__ float frcp(float x) { return __builtin_amdgcn_rcpf(x); }
__device__ __forceinline__ float fsigmoid(float x) { return frcp(1.0f + fexp(-x)); }
__device__ __forceinline__ float fsilu(float x) { return x * fsigmoid(x); }
__device__ __forceinline__ float wave_sum(float v) {
#pragma unroll
    for (int o = 1; o < 64; o <<= 1) v += __shfl_xor(v, o);
    return v;
}
#define LDS_WAIT() asm volatile("s_waitcnt lgkmcnt(0)" ::: "memory")
#define VM_WAIT() asm volatile("s_waitcnt vmcnt(0)" ::: "memory")

#define XB_TMO      128
#define XB_XCNT(j)  (256  + 64 * (j))
#define XB_XSUB(j)  (1280 + 64 * (j))
#define XB_XGEN(j)  (2304 + 64 * (j))
#define XB_TOP      3328
#define XB_TOPGEN   3392
#define XCD_BAR_WORDS 3456
#define XB_SPIN_CAP (1u << 22)
__device__ __forceinline__ unsigned xb_ld(unsigned* p)              { return __hip_atomic_load(p, __ATOMIC_RELAXED, __HIP_MEMORY_SCOPE_AGENT); }
__device__ __forceinline__ unsigned xb_add(unsigned* p, unsigned v) { return __hip_atomic_fetch_add(p, v, __ATOMIC_RELAXED, __HIP_MEMORY_SCOPE_AGENT); }
__device__ __forceinline__ unsigned xb_xcc_id() { return (unsigned)__builtin_amdgcn_s_getreg((3 << 11) | 20) & 0xFu; }
#define XB_SPIN(cond, bar) do { unsigned _sp = 0; while (cond) { __builtin_amdgcn_s_sleep(1); \
    if ((++_sp & 255u) == 0u) { if (xb_ld(&(bar)[XB_TMO])) break; if (_sp > XB_SPIN_CAP) { atomicAdd(&(bar)[XB_TMO], 1u); break; } } } } while (0)
struct XcdBarrier { unsigned* bar; unsigned x; volatile LAS unsigned* st; };
__device__ __forceinline__ XcdBarrier xcd_barrier_post(unsigned* bar, volatile LAS unsigned* st) {
    XcdBarrier b; b.bar = bar; b.x = xb_xcc_id(); b.st = st;
    if (threadIdx.x == 0) (void)xb_add(&bar[XB_XCNT(b.x)], 1u);
    return b;
}
__device__ __forceinline__ void xcd_barrier_complete(unsigned* bar, unsigned x, unsigned& nloc, unsigned& nx) {
    const unsigned G = gridDim.x * gridDim.y * gridDim.z;
    unsigned sum, cnt, mine, sp = 0u;
    for (;;) {
        sum = 0u; cnt = 0u; mine = 0u;
#pragma unroll
        for (unsigned j = 0; j < 16; ++j) { const unsigned c = xb_ld(&bar[XB_XCNT(j)]); sum += c; cnt += (c > 0u) ? 1u : 0u; mine = (j == x) ? c : mine; }
        if (sum == G) break;
        __builtin_amdgcn_s_sleep(1);
        if ((++sp & 255u) == 0u) { if (xb_ld(&bar[XB_TMO])) break; if (sp > XB_SPIN_CAP) { atomicAdd(&bar[XB_TMO], 1u); break; } }
    }
    nloc = mine > 0u ? mine : 1u; nx = cnt > 0u ? cnt : 1u;
}
__device__ __forceinline__ void xcd_barrier(const XcdBarrier& b) {
    asm volatile("s_waitcnt vmcnt(0)" ::: "memory");
    __syncthreads();
    if (threadIdx.x == 0) {
        unsigned* bar = b.bar;
        __builtin_amdgcn_s_waitcnt(0);
        unsigned nloc = b.st[0], nx = b.st[1];
        if (nloc == 0u) { xcd_barrier_complete(bar, b.x, nloc, nx); b.st[0] = nloc; b.st[1] = nx; }
        const unsigned old = xb_add(&bar[XB_XSUB(b.x)], 1u);
        const unsigned gen = old / nloc;
        if (old + 1u == (gen + 1u) * nloc) {
            __builtin_amdgcn_fence(__ATOMIC_RELEASE, "agent");
            asm volatile("s_waitcnt vmcnt(0)" ::: "memory");
            const unsigned og = xb_add(&bar[XB_TOP], 1u);
            const unsigned tg = og / nx;
            if (og + 1u == (tg + 1u) * nx) xb_add(&bar[XB_TOPGEN], 1u);
            else XB_SPIN(xb_ld(&bar[XB_TOPGEN]) == tg, bar);
            __builtin_amdgcn_fence(__ATOMIC_ACQUIRE, "agent");
            xb_add(&bar[XB_XGEN(b.x)], 1u);
            asm volatile("s_waitcnt vmcnt(0)" ::: "memory");
        } else {
            XB_SPIN(xb_ld(&bar[XB_XGEN(b.x)]) == gen, bar);
            __builtin_amdgcn_fence(__ATOMIC_ACQUIRE, "agent");
            asm volatile("s_waitcnt vmcnt(0)" ::: "memory");
        }
    }
    __syncthreads();
}

namespace pg8 {
constexpr int BM = 256, BK = 64, HALF = 128, HTB = HALF * BK * 2, STAGE_BYTES = 8 * HTB, NXCD = 8, WGM = 8;
__host__ __device__ __forceinline__ int lds_byte(int r, int c) { const int st = (r >> 4) * 2 + (c >> 5), rr = r & 15, cc = c & 31, ob = rr * 64 + cc * 2; return st * 1024 + (ob ^ (((ob >> 9) & 1) << 5)); }
__host__ __device__ __forceinline__ void stage_rc(int b, int& R, int& C) { const int st = b / 1024, sb = b % 1024, swz = sb ^ (((sb >> 9) & 1) << 5); R = (st >> 1) * 16 + swz / 64; C = (st & 1) * 32 + (swz % 64) / 2; }
__host__ __device__ __forceinline__ int perm32(int rho) { const int n = rho >> 4, i = rho & 15; return 8 * (i >> 2) + 4 * n + (i & 3); }

struct Unit { int pm, pn, pb; };
struct Gemm { const bf16_t* A; const bf16_t* Bt; int K; };

struct TileOrder {
    int nM, nN, nwg, G, c; int ts[NEXP];
    __device__ __forceinline__ void init(int nM_, int nN_, int G_, int c_) { nM = nM_; nN = nN_; nwg = nM * nN; G = G_; c = c_;
#pragma unroll
        for (int e = 0; e < NEXP; ++e) ts[e] = (e == 0) ? 0 : 0x7fffffff; }
    __device__ __forceinline__ bool next(int i, Unit& u) const {
        const long L = (long)i * G + c; if (L >= nwg) return false;
        int wgid = (int)L; { const int q = nwg / NXCD, r = nwg % NXCD, xcd = wgid % NXCD, off = wgid / NXCD; wgid = (xcd < r ? xcd * (q + 1) : r * (q + 1) + (xcd - r) * q) + off; }
        const int nig = WGM * nN, gid = wgid / nig, fm = gid * WGM, gsz = (nM - fm) < WGM ? (nM - fm) : WGM;
        u.pm = fm + ((wgid % nig) % gsz); u.pn = (wgid % nig) / gsz;
        int e = 0;
#pragma unroll
        for (int k = 1; k < NEXP; ++k) e += (u.pm >= ts[k]) ? 1 : 0;
        u.pb = e * nN + u.pn; return true;
    }
};

typedef int v8i32 __attribute__((ext_vector_type(8)));
template <class Epi, bool FP8 = false>
__device__ __forceinline__ void gemm_phase(LAS unsigned char* lds, const Gemm g, const TileOrder& S, const Epi& E) {
    int tid_ = threadIdx.x; asm volatile("" : "+v"(tid_));
    const int tid = tid_, wid = __builtin_amdgcn_readfirstlane(tid >> 6), lane = tid & 63, wr = wid >> 2, wc = wid & 3, fr = lane & 15, fq = lane >> 4;
    const int K = g.K, nt = K / BK;
    unsigned voffA[2], voffB[2];
#pragma unroll
    for (int i = 0; i < 2; ++i) { int R, C; stage_rc(tid * 16 + i * 8192, R, C); const int Rb = Epi::PERM ? ((R & ~31) + perm32(R & 31)) : R;
        voffA[i] = (unsigned)(R * K + C) * 2u; voffB[i] = (unsigned)(Rb * K + C) * 2u; }
    const size_t kstep = (size_t)(BK * 2);
    const size_t hstep = (size_t)HALF * K * 2;
    const size_t tstep = 2 * hstep;
    const unsigned ldsw = (unsigned)wid * 1024u;
    const int aoff = lds_byte(wr * 64 + fr, fq * 8), boff = lds_byte(wc * 32 + fr, fq * 8);
#define PG8_SA(b, h) (((b) * 2 + (h)) * HTB)
#define PG8_SB(b, h) ((4 + (b) * 2 + (h)) * HTB)
#define PG8_STAGE(bufoff, gbase, voff) do { _Pragma("unroll") for (int _i = 0; _i < 2; ++_i) \
        __builtin_amdgcn_global_load_lds((const unsigned*)((const char*)(gbase) + (voff)[_i]), (LAS unsigned*)(lds + (bufoff) + ldsw + _i * 8192), 16, 0, 0); } while (0)
#define PG8_LD8(p) __builtin_bit_cast(v8i32, __builtin_shufflevector(*(const LAS u32x4*)(p), *(const LAS u32x4*)((p) + 1024), 0, 1, 2, 3, 4, 5, 6, 7))
#define PG8_LDA(dst, b, h) do { if constexpr (FP8) { _Pragma("unroll") for (int m = 0; m < 4; ++m) dst##8[m] = PG8_LD8(lds + PG8_SA(b, h) + aoff + m * 2048); } \
        else { _Pragma("unroll") for (int m = 0; m < 4; ++m) _Pragma("unroll") for (int k = 0; k < 2; ++k) dst[m][k] = *(const LAS bf16x8*)(lds + PG8_SA(b, h) + aoff + m * 2048 + k * 1024); } } while (0)
#define PG8_LDB(dst, b, h) do { if constexpr (FP8) { _Pragma("unroll") for (int n = 0; n < 2; ++n) dst##8[n] = PG8_LD8(lds + PG8_SB(b, h) + boff + n * 2048); } \
        else { _Pragma("unroll") for (int n = 0; n < 2; ++n) _Pragma("unroll") for (int k = 0; k < 2; ++k) dst[n][k] = *(const LAS bf16x8*)(lds + PG8_SB(b, h) + boff + n * 2048 + k * 1024); } } while (0)
#define PG8_MMA(ai, bj, At, Bt) do { __builtin_amdgcn_s_setprio(1); \
        if constexpr (FP8) { _Pragma("unroll") for (int m = 0; m < 4; ++m) _Pragma("unroll") for (int n = 0; n < 2; ++n) \
            asm volatile("v_mfma_scale_f32_16x16x128_f8f6f4 %0, %1, %2, %0, %3, %3 op_sel_hi:[0,0,0]" : "+v"(acc[ai][bj][m][n]) : "v"(Bt##8[n]), "v"(At##8[m]), "v"(one_scale)); } \
        else { _Pragma("unroll") for (int m = 0; m < 4; ++m) _Pragma("unroll") for (int n = 0; n < 2; ++n) _Pragma("unroll") for (int k = 0; k < 2; ++k) \
            acc[ai][bj][m][n] = __builtin_amdgcn_mfma_f32_16x16x32_bf16(Bt[n][k], At[m][k], acc[ai][bj][m][n], 0, 0, 0); } \
        __builtin_amdgcn_s_setprio(0); } while (0)
#define PG8_WAIT_V(n) asm volatile("s_waitcnt vmcnt(" #n ")" ::: "memory")
#define PG8_WAIT_L(n) asm volatile("s_waitcnt lgkmcnt(" #n ")" ::: "memory")
#define PG8_BAR __builtin_amdgcn_s_barrier()
#define PG8_SCHED __builtin_amdgcn_sched_barrier(0)
    Unit cur, nxt; int ui = 0;
    if (!S.next(0, cur)) return;
    f32x4 acc[2][2][4][2];
#pragma unroll
    for (int a = 0; a < 2; ++a)
#pragma unroll
        for (int b = 0; b < 2; ++b)
#pragma unroll
            for (int m = 0; m < 4; ++m)
#pragma unroll
                for (int n = 0; n < 2; ++n) acc[a][b][m][n] = (f32x4){0.f, 0.f, 0.f, 0.f};
    bf16x8 At[4][2], B0[2][2], B1[2][2]; v8i32 At8[4], B08[2], B18[2];
    int one_scale = 0x7f7f7f7f; asm volatile("" : "+v"(one_scale));
    const char* cA = (const char*)g.A + (size_t)cur.pm * tstep; const char* cB = (const char*)g.Bt + (size_t)cur.pb * tstep;
    PG8_STAGE(PG8_SB(0, 0), cB, voffB); PG8_STAGE(PG8_SA(0, 0), cA, voffA); PG8_STAGE(PG8_SB(0, 1), cB + hstep, voffB); PG8_STAGE(PG8_SA(0, 1), cA + hstep, voffA);
    if (wr == 1) PG8_BAR;
    PG8_WAIT_V(4); PG8_BAR;
    PG8_STAGE(PG8_SB(1, 0), cB + kstep, voffB); PG8_STAGE(PG8_SA(1, 0), cA + kstep, voffA); PG8_STAGE(PG8_SB(1, 1), cB + hstep + kstep, voffB);
    PG8_WAIT_V(6); PG8_BAR;
    for (;;) {
        const bool has_next = S.next(ui + 1, nxt);
        const char* nA = has_next ? (const char*)g.A + (size_t)nxt.pm * tstep : cA; const char* nB = has_next ? (const char*)g.Bt + (size_t)nxt.pb * tstep : cB;
        for (int t = 0; t < nt; t += 2) {
            const bool last = (t == nt - 2);
            const char* a1 = cA + (size_t)(t + 1) * kstep;
            const char* a2 = last ? nA : cA + (size_t)(t + 2) * kstep; const char* b2 = last ? nB : cB + (size_t)(t + 2) * kstep;
            const char* a3 = a2 + kstep; const char* b3 = b2 + kstep;
            PG8_LDB(B0, 0, 0); PG8_SCHED; PG8_LDA(At, 0, 0); PG8_STAGE(PG8_SA(1, 1), a1 + hstep, voffA);
            PG8_WAIT_L(8); PG8_BAR; PG8_WAIT_L(0); PG8_MMA(0, 0, At, B0); PG8_BAR; PG8_SCHED;
            PG8_LDB(B1, 0, 1); PG8_STAGE(PG8_SB(0, 0), b2, voffB);
            PG8_BAR; PG8_WAIT_L(0); PG8_MMA(0, 1, At, B1); PG8_BAR;
            PG8_LDA(At, 0, 1); PG8_STAGE(PG8_SA(0, 0), a2, voffA);
            PG8_BAR; PG8_WAIT_L(0); PG8_MMA(1, 0, At, B0); PG8_BAR; PG8_SCHED;
            PG8_STAGE(PG8_SB(0, 1), b2 + hstep, voffB);
            PG8_WAIT_V(6); PG8_BAR; PG8_MMA(1, 1, At, B1); PG8_BAR;
            PG8_LDB(B0, 1, 0); PG8_SCHED; PG8_LDA(At, 1, 0); PG8_STAGE(PG8_SA(0, 1), a2 + hstep, voffA);
            PG8_WAIT_L(8); PG8_BAR; PG8_WAIT_L(0); PG8_MMA(0, 0, At, B0); PG8_BAR; PG8_SCHED;
            PG8_LDB(B1, 1, 1); PG8_STAGE(PG8_SB(1, 0), b3, voffB);
            PG8_BAR; PG8_WAIT_L(0); PG8_MMA(0, 1, At, B1); PG8_BAR;
            PG8_LDA(At, 1, 1); PG8_STAGE(PG8_SA(1, 0), a3, voffA);
            PG8_BAR; PG8_WAIT_L(0); PG8_MMA(1, 0, At, B0); PG8_BAR; PG8_SCHED;
            PG8_STAGE(PG8_SB(1, 1), b3 + hstep, voffB);
            PG8_WAIT_V(6); PG8_BAR; PG8_MMA(1, 1, At, B1); PG8_BAR;
        }
        if constexpr (FP8) asm volatile("s_nop 15\n\ts_nop 15" ::: "memory");
        E(acc, cur, wr, wc, fr, fq);
        if (!has_next) break;
#pragma unroll
        for (int a = 0; a < 2; ++a)
#pragma unroll
            for (int b = 0; b < 2; ++b)
#pragma unroll
                for (int m = 0; m < 4; ++m)
#pragma unroll
                    for (int n = 0; n < 2; ++n) acc[a][b][m][n] = (f32x4){0.f, 0.f, 0.f, 0.f};
        cur = nxt; cA = nA; cB = nB; ++ui;
    }
    PG8_WAIT_V(0);
    if (wr == 0) PG8_BAR;
    PG8_BAR;
#undef PG8_SA
#undef PG8_SB
#undef PG8_STAGE
#undef PG8_LDA
#undef PG8_LDB
#undef PG8_MMA
#undef PG8_LD8
#undef PG8_WAIT_V
#undef PG8_WAIT_L
#undef PG8_BAR
#undef PG8_SCHED
}

struct EpiQKV {
    static constexpr bool PERM = true;
    bf16_t *Q, *Kk, *V; const float *gq, *gk, *cosT, *sinT; float qscale;
    __device__ __forceinline__ void operator()(const f32x4 (&acc)[2][2][4][2], const Unit& u, int wr, int wc, int fr, int fq) const {
        const int row0 = u.pm * BM + wr * 64 + fr;
        if (u.pn >= 8) {
            const int col0 = (u.pn - 8) * BM + wc * 32 + 8 * fq;
#pragma unroll
            for (int ai = 0; ai < 2; ++ai)
#pragma unroll
                for (int m = 0; m < 4; ++m) { bf16_t* rowp = V + (size_t)(row0 + ai * HALF + m * 16) * DM + col0;
#pragma unroll
                    for (int bj = 0; bj < 2; ++bj) { const f32x4 v0 = acc[ai][bj][m][0], v1 = acc[ai][bj][m][1];
                        u32x4 w; w.x = cvt_pk_bf16(v0[0], v0[1]); w.y = cvt_pk_bf16(v0[2], v0[3]); w.z = cvt_pk_bf16(v1[0], v1[1]); w.w = cvt_pk_bf16(v1[2], v1[3]);
                        *(u32x4*)(rowp + bj * HALF) = w; } }
        } else {
            const int part = u.pn >> 2, sh = 4 * (u.pn & 3) + wc;
            bf16_t* dst = part ? Kk : Q; const float* g = part ? gk : gq; const float sc = part ? 1.0f : qscale;
            f32x4 g0[2], g1[2];
#pragma unroll
            for (int n = 0; n < 2; ++n) { g0[n] = *(const f32x4*)(g + 8 * fq + 4 * n); g1[n] = *(const f32x4*)(g + 32 + 8 * fq + 4 * n); }
#pragma unroll
            for (int ai = 0; ai < 2; ++ai)
#pragma unroll
                for (int m = 0; m < 4; ++m) {
                    const int r = row0 + ai * HALF + m * 16; const int pos = r & (SEQ - 1);
                    f32x4 x1[2], x2[2]; float ss = 0.f;
#pragma unroll
                    for (int n = 0; n < 2; ++n) { x1[n] = acc[ai][0][m][n]; x2[n] = acc[ai][1][m][n];
                        ss += (x1[n][0] * x1[n][0] + x1[n][1] * x1[n][1]) + (x1[n][2] * x1[n][2] + x1[n][3] * x1[n][3]);
                        ss += (x2[n][0] * x2[n][0] + x2[n][1] * x2[n][1]) + (x2[n][2] * x2[n][2] + x2[n][3] * x2[n][3]); }
                    ss += __shfl_xor(ss, 16); ss += __shfl_xor(ss, 32);
                    const float rstd = __builtin_amdgcn_rsqf(ss * (1.0f / 64.0f) + EPS) ;
                    unsigned char* op = (unsigned char*)dst + (size_t)r * DM + sh * 64 + 8 * fq;
                    u32x2 w1, w2;
#pragma unroll
                    for (int n = 0; n < 2; ++n) {
                        const f32x4 cs = *(const f32x4*)(cosT + pos * 32 + 8 * fq + 4 * n), sn = *(const f32x4*)(sinT + pos * 32 + 8 * fq + 4 * n);
                        const f32x4 y1 = x1[n] * rstd * g0[n], y2 = x2[n] * rstd * g1[n];
                        const f32x4 o1 = (y1 * cs - y2 * sn) * sc, o2 = (y2 * cs + y1 * sn) * sc;
                        if (n == 0) { w1.x = pk_fp8x4(o1[0], o1[1], o1[2], o1[3]); w2.x = pk_fp8x4(o2[0], o2[1], o2[2], o2[3]); }
                        else { w1.y = pk_fp8x4(o1[0], o1[1], o1[2], o1[3]); w2.y = pk_fp8x4(o2[0], o2[1], o2[2], o2[3]); }
                    }
                    *(u32x2*)(op) = w1; *(u32x2*)(op + 32) = w2;
                }
        }
    }
};
struct EpiRes {
    static constexpr bool PERM = false;
    const float* xin; float* xout; const float* gate; float sc;
    __device__ __forceinline__ void operator()(const f32x4 (&acc)[2][2][4][2], const Unit& u, int wr, int wc, int fr, int fq) const {
        const int row0 = u.pm * BM + wr * 64 + fr, col0 = u.pn * BM + wc * 32 + 4 * fq;
        const float* gp = gate + (size_t)(u.pm >> 5) * 6144 + col0;
        f32x4 gv[2][2];
#pragma unroll
        for (int bj = 0; bj < 2; ++bj)
#pragma unroll
            for (int n = 0; n < 2; ++n) gv[bj][n] = *(const f32x4*)(gp + bj * HALF + n * 16) * sc;
#pragma unroll
        for (int ai = 0; ai < 2; ++ai)
#pragma unroll
            for (int m = 0; m < 4; ++m) { const size_t off = (size_t)(row0 + ai * HALF + m * 16) * DM + col0;
#pragma unroll
                for (int bj = 0; bj < 2; ++bj)
#pragma unroll
                    for (int n = 0; n < 2; ++n) { const f32x4 xv = *(const f32x4*)(xin + off + bj * HALF + n * 16);
                        *(f32x4*)(xout + off + bj * HALF + n * 16) = xv + gv[bj][n] * acc[ai][bj][m][n]; }
                asm volatile("" ::: "memory"); }
    }
};
struct EpiSwiGLU {
    static constexpr bool PERM = true;
    bf16_t* H; int ldh;
    __device__ __forceinline__ void operator()(const f32x4 (&acc)[2][2][4][2], const Unit& u, int wr, int wc, int fr, int fq) const {
        const int row0 = u.pm * BM + wr * 64 + fr, col0 = u.pn * HALF + wc * 32 + 8 * fq;
#pragma unroll
        for (int ai = 0; ai < 2; ++ai)
#pragma unroll
            for (int m = 0; m < 4; ++m) { bf16_t* rowp = H + (size_t)(row0 + ai * HALF + m * 16) * ldh + col0;
                f32x4 v[2];
#pragma unroll
                for (int n = 0; n < 2; ++n) { const f32x4 gt = acc[ai][0][m][n], up = acc[ai][1][m][n];
#pragma unroll
                    for (int j = 0; j < 4; ++j) v[n][j] = fsilu(gt[j]) * up[j]; }
                u32x4 w; w.x = cvt_pk_bf16(v[0][0], v[0][1]); w.y = cvt_pk_bf16(v[0][2], v[0][3]); w.z = cvt_pk_bf16(v[1][0], v[1][1]); w.w = cvt_pk_bf16(v[1][2], v[1][3]);
                *(u32x4*)rowp = w; }
    }
};
struct EpiSwiGLU8 {
    static constexpr bool PERM = true;
    unsigned char* H; int ldh; float ws, hs;
    __device__ __forceinline__ void operator()(const f32x4 (&acc)[2][2][4][2], const Unit& u, int wr, int wc, int fr, int fq) const {
        const int row0 = u.pm * BM + wr * 64 + fr, col0 = u.pn * HALF + wc * 32 + 8 * fq;
#pragma unroll
        for (int ai = 0; ai < 2; ++ai)
#pragma unroll
            for (int m = 0; m < 4; ++m) { unsigned char* rowp = H + (size_t)(row0 + ai * HALF + m * 16) * ldh + col0;
                f32x4 v[2];
#pragma unroll
                for (int n = 0; n < 2; ++n) { const f32x4 gt = acc[ai][0][m][n] * ws, up = acc[ai][1][m][n] * (ws * hs);
#pragma unroll
                    for (int j = 0; j < 4; ++j) v[n][j] = fsilu(gt[j]) * up[j]; }
                *(u32x2*)rowp = (u32x2){pk_fp8x4(v[0][0], v[0][1], v[0][2], v[0][3]), pk_fp8x4(v[1][0], v[1][1], v[1][2], v[1][3])}; }
    }
};
struct EpiPlain {
    static constexpr bool PERM = true;
    bf16_t* O; int ldc; float sc;
    __device__ __forceinline__ void operator()(const f32x4 (&acc)[2][2][4][2], const Unit& u, int wr, int wc, int fr, int fq) const {
        const int row0 = u.pm * BM + wr * 64 + fr, col0 = u.pn * BM + wc * 32 + 8 * fq;
#pragma unroll
        for (int ai = 0; ai < 2; ++ai)
#pragma unroll
            for (int m = 0; m < 4; ++m) { bf16_t* rowp = O + (size_t)(row0 + ai * HALF + m * 16) * ldc + col0;
#pragma unroll
                for (int bj = 0; bj < 2; ++bj) { const f32x4 v0 = acc[ai][bj][m][0] * sc, v1 = acc[ai][bj][m][1] * sc;
                    u32x4 w; w.x = cvt_pk_bf16(v0[0], v0[1]); w.y = cvt_pk_bf16(v0[2], v0[3]); w.z = cvt_pk_bf16(v1[0], v1[1]); w.w = cvt_pk_bf16(v1[2], v1[3]);
                    *(u32x4*)(rowp + bj * HALF) = w; } }
    }
};
struct EpiAct {
    static constexpr bool PERM = true;
    int kind; unsigned char* ws; const float* lb;
    __device__ __forceinline__ void operator()(const f32x4 (&acc)[2][2][4][2], const Unit& u, int wr, int wc, int fr, int fq) const {
        const int row0 = u.pm * BM + wr * 64 + fr;
        int mode, ldc, colt; size_t boff;
        if (kind == 0) { const int grp = u.pn >> 2; colt = (u.pn & 3) * 256; ldc = 1024;
            boff = grp == 0 ? H_Q : grp == 1 ? H_LFF : grp == 2 ? H_LFB : grp == 3 ? H_V : H_G; mode = (grp == 0 || grp == 4) ? 1 : (grp == 3 ? 0 : 3); }
        else { ldc = LRUW; if (u.pn < 5) { boff = L_YB; colt = u.pn * 256; mode = 2; } else { boff = L_XB; colt = (u.pn - 5) * 256; mode = 0; } }
        bf16_t* base = (bf16_t*)(ws + boff);
        const int col0 = colt + wc * 32 + 8 * fq;
        f32x4 lbv[2][2];
        if (mode == 3) { const float* lp = lb + ((u.pn >> 2) - 1) * 1024 + col0;
#pragma unroll
            for (int bj = 0; bj < 2; ++bj)
#pragma unroll
                for (int n = 0; n < 2; ++n) lbv[bj][n] = *(const f32x4*)(lp + bj * HALF + 4 * n); }
#pragma unroll
        for (int ai = 0; ai < 2; ++ai)
#pragma unroll
            for (int m = 0; m < 4; ++m) { bf16_t* rowp = base + (size_t)(row0 + ai * HALF + m * 16) * ldc + col0;
#pragma unroll
                for (int bj = 0; bj < 2; ++bj) { f32x4 v[2]; u32x4 w;
#pragma unroll
                    for (int n = 0; n < 2; ++n) { v[n] = acc[ai][bj][m][n];
                        if (mode == 1) {
#pragma unroll
                            for (int j = 0; j < 4; ++j) v[n][j] = fsilu(v[n][j]); }
                        else if (mode == 2) {
#pragma unroll
                            for (int j = 0; j < 4; ++j) { const float x = v[n][j]; v[n][j] = x * fsigmoid(1.5957691216057308f * (x + 0.044715f * x * x * x)); } }
                        else if (mode == 3) {
#pragma unroll
                            for (int j = 0; j < 4; ++j) { const float l = lbv[bj][n][j]; const float fg = l + (1.0f - l) * fsigmoid(v[n][j]); v[n][j] = __builtin_amdgcn_logf(fg) * 0.6931471805599453f; } }
                    }
                    if (mode == 3) {
#pragma unroll
                        for (int n = 0; n < 2; ++n) { const _Float16 h0 = (_Float16)v[n][0], h1 = (_Float16)v[n][1], h2 = (_Float16)v[n][2], h3 = (_Float16)v[n][3];
                            const unsigned a = (unsigned)__builtin_bit_cast(unsigned short, h0) | ((unsigned)__builtin_bit_cast(unsigned short, h1) << 16);
                            const unsigned b = (unsigned)__builtin_bit_cast(unsigned short, h2) | ((unsigned)__builtin_bit_cast(unsigned short, h3) << 16);
                            if (n == 0) { w.x = a; w.y = b; } else { w.z = a; w.w = b; } }
                    } else { w.x = cvt_pk_bf16(v[0][0], v[0][1]); w.y = cvt_pk_bf16(v[0][2], v[0][3]); w.z = cvt_pk_bf16(v[1][0], v[1][1]); w.w = cvt_pk_bf16(v[1][2], v[1][3]); }
                    *(u32x4*)(rowp + bj * HALF) = w; } }
    }
};
}

struct Args { const float* in[30]; float* out; unsigned char* ws; };
enum { I_X = 0, I_C, I_ADAW, I_ADAB, I_N1G, I_N2G, I_ATWIN, I_ATQN, I_ATKN, I_ATLAM, I_ATSUB, I_ATWOUT, I_HGWIN, I_HGLB, I_HGNG, I_HGWOUT,
       I_LRWIN, I_LRCW, I_LRCB, I_LRWA, I_LRBA, I_LRWX, I_LRBX, I_LRLAM, I_LRWOUT, I_FFGU, I_FFDN, I_MOER, I_MOEGU, I_MOEDN };
enum { SC_LAM0 = 0, SC_LAM1, SC_OML0, SC_OML1, SC_MC0, SC_MC1 };

__device__ __forceinline__ void cvt_item(const float* W, int ldw, int src_col0, bf16_t* WT, int ldt, int dst_row0, int k0, LAS float* scr, int lane) {
#pragma unroll 8
    for (int i = 0; i < 32; ++i) { const int kk = 2 * i + (lane >> 5); scr[kk * 33 + (lane & 31)] = W[(size_t)(k0 + kk) * ldw + src_col0 + (lane & 31)]; }
    LDS_WAIT(); asm volatile("" ::: "memory");
    const int c = lane & 7;
#pragma unroll
    for (int j = 0; j < 4; ++j) { const int n = (lane >> 3) + 8 * j; const LAS float* s = scr + (8 * c) * 33 + n;
        u32x4 o; o.x = cvt_pk_bf16(s[0 * 33], s[1 * 33]); o.y = cvt_pk_bf16(s[2 * 33], s[3 * 33]); o.z = cvt_pk_bf16(s[4 * 33], s[5 * 33]); o.w = cvt_pk_bf16(s[6 * 33], s[7 * 33]);
        *(u32x4*)(WT + (size_t)(dst_row0 + n) * ldt + k0 + 8 * c) = o; }
    LDS_WAIT(); asm volatile("" ::: "memory");
}
__device__ __forceinline__ void cvt_item8(const float* W, int ldw, int src_col0, unsigned char* WT, int ldt, int dst_row0, int k0, float sc, LAS float* scr, int lane) {
#pragma unroll 8
    for (int i = 0; i < 32; ++i) { const int kk = 2 * i + (lane >> 5); scr[kk * 33 + (lane & 31)] = W[(size_t)(k0 + kk) * ldw + src_col0 + (lane & 31)]; }
    LDS_WAIT(); asm volatile("" ::: "memory");
    const int c = lane & 7;
#pragma unroll
    for (int j = 0; j < 4; ++j) { const int n = (lane >> 3) + 8 * j; const LAS float* s = scr + (8 * c) * 33 + n;
        *(u32x2*)(WT + (size_t)(dst_row0 + n) * ldt + k0 + 8 * c) = (u32x2){pk_fp8x4(s[0 * 33] * sc, s[1 * 33] * sc, s[2 * 33] * sc, s[3 * 33] * sc), pk_fp8x4(s[4 * 33] * sc, s[5 * 33] * sc, s[6 * 33] * sc, s[7 * 33] * sc)}; }
    LDS_WAIT(); asm volatile("" ::: "memory");
}
enum { MAP_ID = 0, MAP_QKV = 1, MAP_SWI = 2 };
template <bool F8 = false>
__device__ __forceinline__ void cvt_family(const float* src, size_t sstride, int ninst, int ldw, int K, int ng, int map, int F, bf16_t* dst, size_t dstride,
                                           LAS float* scr, int gw, int NGW, int lane) {
    const int nkb = K / 64, per = nkb * ng, total = ninst * per;
    for (int it = gw; it < total; it += NGW) {
        const int inst = it / per, r = it - inst * per, kb = r / ng, gi = r - kb * ng;
        int sc0;
        if (map == MAP_ID) sc0 = 32 * gi;
        else if (map == MAP_QKV) { const int pn = gi >> 3, bj = (gi >> 2) & 1, wc = gi & 3;
            if (pn < 8) { const int part = pn >> 2, sh = 4 * (pn & 3) + wc; sc0 = part * 1024 + sh * 64 + 32 * bj; } else sc0 = 32 * gi; }
        else { const int pn = gi >> 3, bj = (gi >> 2) & 1, q = gi & 3; sc0 = bj * F + pn * 128 + 32 * q; }
        if constexpr (F8) cvt_item8(src + (size_t)inst * sstride, ldw, sc0, (unsigned char*)dst + (size_t)inst * dstride, K, 32 * gi, 64 * kb, MOE_WSCALE, scr, lane);
        else cvt_item(src + (size_t)inst * sstride, ldw, sc0, dst + (size_t)inst * dstride, K, 32 * gi, 64 * kb, scr, lane);
    }
}

__device__ __forceinline__ void prologue_phase(const Args& A, LAS unsigned char* lds, int bid, int G) {
    const int tid = threadIdx.x, lane = tid & 63, wave = tid >> 6;
    unsigned char* ws = A.ws;
    {
        LAS float* sc = (LAS float*)lds;
        LAS float* red = (LAS float*)(lds + 32768);
        for (int i = tid; i < NBATCH * DM; i += NTHR) { const float cv = A.in[I_C][i]; sc[i] = fsilu(cv); }
        __syncthreads();
        float* mods = (float*)(ws + TB_MODS);
        for (int cb = bid; cb < (DEPTH * 6144) / 128; cb += G) {
            const int col = cb * 128 + (tid & 127), l = col / 6144, e = col - l * 6144, ch = tid >> 7;
            const float* wp = A.in[I_ADAW] + (size_t)l * DM * 6144 + e;
            float a[NBATCH];
#pragma unroll
            for (int b = 0; b < NBATCH; ++b) a[b] = 0.f;
#pragma unroll 4
            for (int d = ch * 256; d < ch * 256 + 256; ++d) { const float w = wp[(size_t)d * 6144];
#pragma unroll
                for (int b = 0; b < NBATCH; ++b) a[b] += sc[b * DM + d] * w; }
#pragma unroll
            for (int b = 0; b < NBATCH; ++b) red[(ch * 128 + (tid & 127)) * 8 + b] = a[b];
            __syncthreads();
            if (tid < 128) { const float bias = A.in[I_ADAB][l * 6144 + e];
#pragma unroll
                for (int b = 0; b < NBATCH; ++b) { const float s = ((red[(0 * 128 + tid) * 8 + b] + red[(1 * 128 + tid) * 8 + b]) + (red[(2 * 128 + tid) * 8 + b] + red[(3 * 128 + tid) * 8 + b])) + bias;
                    mods[((size_t)l * NBATCH + b) * 6144 + e] = s; } }
            __syncthreads();
        }
    }
    {
        float* cosT = (float*)(ws + TB_COS); float* sinT = (float*)(ws + TB_SIN);
        for (int i = bid * NTHR + tid; i < SEQ * 32; i += G * NTHR) {
            const int pos = i >> 5, d = i & 31;
            const float inv = (float)exp(-(double)d * (1.0 / 32.0) * 9.210340371976184);
            const float ang = (float)pos * inv;
            const double rev = (double)ang * 0.15915494309189535; const float fr = (float)(rev - floor(rev));
            cosT[i] = __builtin_amdgcn_cosf(fr); sinT[i] = __builtin_amdgcn_sinf(fr);
        }
        if (bid == 0 && tid < 2) {
            const int a = tid; const float* lm = A.in[I_ATLAM] + a * 256;
            float s1 = 0.f, s2 = 0.f; for (int i = 0; i < 64; ++i) { s1 += lm[i] * lm[64 + i]; s2 += lm[128 + i] * lm[192 + i]; }
            const float linit = 0.8f - 0.6f * expf(-0.3f * (float)(3 * a));
            float mq = 0.f, mk = 0.f; for (int i = 0; i < 64; ++i) { mq = fmaxf(mq, fabsf(A.in[I_ATQN][a * 64 + i])); mk = fmaxf(mk, fabsf(A.in[I_ATKN][a * 64 + i])); }
            float* scal = (float*)(ws + TB_SCAL);
            scal[SC_LAM0 + a] = expf(s1) - expf(s2) + linit; scal[SC_OML0 + a] = 1.0f - linit; scal[SC_MC0 + a] = 8.0f * mq * mk * LOG2E * 1.0001f;
        }
        if (bid == 1) {
            float* lb = (float*)(ws + TB_LB);
            for (int i = tid; i < 2 * 1024; i += NTHR) { const int d = i >> 10, k = i & 1023; const float* p = A.in[I_HGLB] + (size_t)d * DEPTH * 1024 + k;
                float mx = p[0]; for (int l = 1; l < DEPTH; ++l) mx = fmaxf(mx, p[l * 1024]);
                float den = 0.f, num = 0.f; for (int l = 0; l < DEPTH; ++l) { const float e = expf(p[l * 1024] - mx); den += e; if (l == 1) num += e; }
                lb[i] = num / den; }
        }
        if (bid == 2) {
            float* sp = (float*)(ws + TB_SP);
            for (int i = tid; i < 2 * LRUW; i += NTHR) { const float x = -A.in[I_LRLAM][i]; sp[i] = (x > 20.f) ? x : log1pf(expf(x)); }
        }
    }
    {
        LAS float* scr = (LAS float*)(lds + wave * 16384);
        const int vcu = (bid % 8) * (G / 8) + bid / 8;
        const int gw = vcu * NWAVES + wave, NGW = G * NWAVES;
        cvt_family(A.in[I_ATWIN], (size_t)1024 * 3072, 2, 3072, 1024, 96, MAP_QKV, 0, (bf16_t*)(ws + W_QKV), (size_t)3072 * 1024, scr, gw, NGW, lane);
        cvt_family(A.in[I_ATWOUT], (size_t)1024 * 1024, 2, 1024, 1024, 32, MAP_ID, 0, (bf16_t*)(ws + W_AO), (size_t)1024 * 1024, scr, gw, NGW, lane);
        cvt_family(A.in[I_HGWIN], 0, 1, 5120, 1024, 160, MAP_ID, 0, (bf16_t*)(ws + W_HGI), 0, scr, gw, NGW, lane);
        cvt_family(A.in[I_HGWOUT], 0, 1, 1024, 1024, 32, MAP_ID, 0, (bf16_t*)(ws + W_HGO), 0, scr, gw, NGW, lane);
        cvt_family(A.in[I_LRWIN], 0, 1, 2560, 1024, 80, MAP_ID, 0, (bf16_t*)(ws + W_LRI), 0, scr, gw, NGW, lane);
        cvt_family(A.in[I_LRWOUT], 0, 1, 1024, 1280, 32, MAP_ID, 0, (bf16_t*)(ws + W_LRO), 0, scr, gw, NGW, lane);
        for (int it = gw; it < 2 * 20 * 2 * 4; it += NGW) {
            const int part = it / 160, r = it % 160, inst = r >> 3, kb = (r >> 2) & 1, gi = r & 3, d = inst / 10, n = inst % 10;
            const float* src = (part ? A.in[I_LRWX] : A.in[I_LRWA]) + (size_t)inst * 16384;
            cvt_item(src, 128, 32 * gi, (bf16_t*)(ws + W_LRG) + (size_t)(n * 2 + d) * 256 * 128, 128, part * 128 + 32 * gi, 64 * kb, scr, lane);
        }
        static_assert(FP8_DENSE_FROM == 2 || FP8_DENSE_FROM > 3, "dense layer 0 stays bf16; layer 2 optional");
        constexpr int NB16 = (FP8_DENSE_FROM == 2) ? 1 : 2;
        cvt_family(A.in[I_FFGU], (size_t)1024 * 5632, NB16, 5632, 1024, 176, MAP_SWI, DFF, (bf16_t*)(ws + W_FGU), (size_t)5632 * 1024, scr, gw, NGW, lane);
        cvt_family(A.in[I_FFDN], (size_t)2816 * 1024, NB16, 1024, 2816, 32, MAP_ID, 0, (bf16_t*)(ws + W_FDN), (size_t)1024 * 2816, scr, gw, NGW, lane);
        if constexpr (NB16 == 1) {
            cvt_family<true>(A.in[I_FFGU] + (size_t)1024 * 5632, 0, 1, 5632, 1024, 176, MAP_SWI, DFF, (bf16_t*)(ws + W_FGU) + (size_t)5632 * 1024, 0, scr, gw, NGW, lane);
            cvt_family<true>(A.in[I_FFDN] + (size_t)2816 * 1024, 0, 1, 1024, 2816, 32, MAP_ID, 0, (bf16_t*)(ws + W_FDN) + (size_t)1024 * 2816, 0, scr, gw, NGW, lane);
        }
        cvt_family<true>(A.in[I_MOEGU], (size_t)1024 * 7168, 16, 7168, 1024, 224, MAP_SWI, DFFE, (bf16_t*)(ws + W_MGU), (size_t)7168 * 1024, scr, gw, NGW, lane);
        cvt_family<true>(A.in[I_MOEDN], (size_t)3584 * 1024, 16, 1024, 3584, 32, MAP_ID, 0, (bf16_t*)(ws + W_MDN), (size_t)1024 * 3584, scr, gw, NGW, lane);
    }
}

template <bool ROUTER>
__device__ __forceinline__ void norm_phase(const Args& A, LAS unsigned char* lds, int bid, int G, const float* xsrc, float* xdst, const float* gain, const float* modl  , int which,
                                           bool combine, const float* modprev  , bool nonorm, const float* router, bool f8out = false) {
    int tid_ = threadIdx.x; asm volatile("" : "+v"(tid_));
    const int tid = tid_, lane = tid & 63, wave = tid >> 6;
    unsigned char* ws = A.ws;
    bf16_t* HM = (bf16_t*)(ws + WS_HM);
    const int* slot = (const int*)(ws + TB_SLOT); const float* gts = (const float*)(ws + TB_GATE);
    const bf16_t* Y = (const bf16_t*)(ws + E_XS);
    LAS int* hist = (LAS int*)lds;
    for (int tb = bid; tb < MTOK / 256; tb += G) {
        const int b = tb >> 5;
        f32x4 ga[4], sh[4], g2[4];
#pragma unroll
        for (int j = 0; j < 4; ++j) { const int c = 256 * j + 4 * lane;
            if (!nonorm) { const f32x4 gv = *(const f32x4*)(gain + c), sv = *(const f32x4*)(modl + (size_t)b * 6144 + (which * 3 + 1) * 1024 + c);
                ga[j] = gv * (sv + 1.0f); sh[j] = *(const f32x4*)(modl + (size_t)b * 6144 + (which * 3) * 1024 + c); }
            if (combine) g2[j] = *(const f32x4*)(modprev + (size_t)b * 6144 + 5 * 1024 + c); }
        f32x4 rw[ROUTER ? 32 : 1];
        if constexpr (ROUTER) {
            if (tid < 8) hist[tid] = 0;
#pragma unroll
            for (int j = 0; j < 4; ++j)
#pragma unroll
                for (int i = 0; i < 4; ++i) { const int c = 256 * j + 4 * lane + i; rw[(j * 4 + i) * 2] = *(const f32x4*)(router + c * 8); rw[(j * 4 + i) * 2 + 1] = *(const f32x4*)(router + c * 8 + 4); }
            __syncthreads();
        }
        for (int i = 0; i < 32; ++i) {
            const int row = tb * 256 + wave * 32 + i;
            const float* xr = xsrc + (size_t)row * DM;
            f32x4 v[4];
#pragma unroll
            for (int j = 0; j < 4; ++j) v[j] = *(const f32x4*)(xr + 256 * j + 4 * lane);
            if (combine) {
                const int s0 = slot[row * 2], s1 = slot[row * 2 + 1]; const float w0 = gts[row * 2], w1 = gts[row * 2 + 1];
#pragma unroll
                for (int j = 0; j < 4; ++j) { const u32x2 a = *(const u32x2*)(Y + (size_t)s0 * DM + 256 * j + 4 * lane), c2 = *(const u32x2*)(Y + (size_t)s1 * DM + 256 * j + 4 * lane);
                    f32x4 y; y[0] = w0 * bflo(a.x) + w1 * bflo(c2.x); y[1] = w0 * bfhi(a.x) + w1 * bfhi(c2.x); y[2] = w0 * bflo(a.y) + w1 * bflo(c2.y); y[3] = w0 * bfhi(a.y) + w1 * bfhi(c2.y);
                    v[j] = v[j] + g2[j] * y; *(f32x4*)(xdst + (size_t)row * DM + 256 * j + 4 * lane) = v[j]; }
            }
            if (nonorm) continue;
            float ss = 0.f;
#pragma unroll
            for (int j = 0; j < 4; ++j) ss += (v[j][0] * v[j][0] + v[j][1] * v[j][1]) + (v[j][2] * v[j][2] + v[j][3] * v[j][3]);
            ss = wave_sum(ss);
            const float rstd = 1.0f / sqrtf(ss * (1.0f / DM) + EPS);
            f32x4 h[4];
#pragma unroll
            for (int j = 0; j < 4; ++j) { h[j] = v[j] * rstd * ga[j] + sh[j];
                if (f8out) { *(unsigned*)((unsigned char*)HM + (size_t)row * DM + 256 * j + 4 * lane) = pk_fp8x4(h[j][0], h[j][1], h[j][2], h[j][3]); }
                else { u32x2 w; w.x = cvt_pk_bf16(h[j][0], h[j][1]); w.y = cvt_pk_bf16(h[j][2], h[j][3]);
                    *(u32x2*)(HM + (size_t)row * DM + 256 * j + 4 * lane) = w; } }
            if constexpr (ROUTER) {
                float lg[8];
#pragma unroll
                for (int e = 0; e < 8; ++e) lg[e] = 0.f;
#pragma unroll
                for (int j = 0; j < 4; ++j)
#pragma unroll
                    for (int q = 0; q < 4; ++q) { const float hv = h[j][q]; const f32x4 r0 = rw[(j * 4 + q) * 2], r1 = rw[(j * 4 + q) * 2 + 1];
                        lg[0] += hv * r0[0]; lg[1] += hv * r0[1]; lg[2] += hv * r0[2]; lg[3] += hv * r0[3]; lg[4] += hv * r1[0]; lg[5] += hv * r1[1]; lg[6] += hv * r1[2]; lg[7] += hv * r1[3]; }
#pragma unroll
                for (int e = 0; e < 8; ++e) lg[e] = wave_sum(lg[e]);
                int e0 = 0; float v0 = lg[0];
#pragma unroll
                for (int e = 1; e < 8; ++e) if (lg[e] > v0) { v0 = lg[e]; e0 = e; }
                int e1 = -1; float v1 = -3.0e38f;
#pragma unroll
                for (int e = 0; e < 8; ++e) if (e != e0 && lg[e] > v1) { v1 = lg[e]; e1 = e; }
                const float p1 = frcp(1.0f + fexp(v1 - v0));
                if (lane == 0) { int* eid = (int*)(ws + TB_EID); float* gt = (float*)(ws + TB_GATE);
                    eid[row * 2] = e0; eid[row * 2 + 1] = e1; gt[row * 2] = p1; gt[row * 2 + 1] = 1.0f - p1;
                    atomicAdd((int*)&hist[e0], 1); atomicAdd((int*)&hist[e1], 1); }
            }
        }
        if constexpr (ROUTER) {
            __syncthreads();
            if (tid < 8) ((int*)(ws + TB_BCNT))[tb * 8 + tid] = hist[tid];
            __syncthreads();
        }
    }
}

namespace lru {
constexpr int XCF = 0, XCB = 16384, AA = 24576, UU = 40960;
__device__ __forceinline__ int sw256(int row, int cb) { return row * 256 + (cb ^ ((row & 15) << 4)); }
__device__ __forceinline__ int crow(int r, int hi) { return (r & 3) + 8 * (r >> 2) + 4 * hi; }
template <int MODE>
__device__ __forceinline__ void lru_item(const Args& A, LAS unsigned char* lds, int b, int n, int seg, int dir) {
    int tid_ = threadIdx.x; asm volatile("" : "+v"(tid_));
    const int tid = tid_, wid = tid >> 6, lane = tid & 63, r = lane & 31, hh = lane >> 5;
    unsigned char* ws = A.ws;
    const bf16_t* XB = (const bf16_t*)(ws + L_XB); const bf16_t* YB = (const bf16_t*)(ws + L_YB); bf16_t* HF = (bf16_t*)(ws + L_HF); bf16_t* HY = (bf16_t*)(ws + L_HY);
    const bf16_t* Wg = (const bf16_t*)(ws + W_LRG) + (size_t)((n * 2 + dir) * 256 + ((r < 16) ? (16 * wid + r) : (128 + 16 * wid + r - 16))) * 128 + 8 * hh;
    bf16x8 bfrag[8];
#pragma unroll
    for (int ks = 0; ks < 8; ++ks) bfrag[ks] = *(const bf16x8*)(Wg + 16 * ks);
    const int cch = n * 128 + 16 * wid + (r & 15);
    const float nba = -LOG2E * A.in[I_LRBA][dir * LRUW + cch], nbx = -LOG2E * A.in[I_LRBX][dir * LRUW + cch], csp = -8.0f * LOG2E * ((const float*)(ws + TB_SP))[dir * LRUW + cch];
    const int ct = tid >> 4, cg = tid & 15, cc0 = n * 128 + 8 * cg;
    float cw[4][8], cb[8];
#pragma unroll
    for (int j = 0; j < 8; ++j) { cb[j] = A.in[I_LRCB][cc0 + j];
#pragma unroll
        for (int w = 0; w < 4; ++w) cw[w][j] = A.in[I_LRCW][w * LRUW + cc0 + j]; }
    float carry = 0.f, P = 1.f;
    if (MODE != 0 && tid < 128) carry = ((const float*)(ws + TB_LCIN))[(size_t)((b * 32 + seg) * 2 + dir) * LRUW + n * 128 + tid];
    u32x4 xr[4];
#define LRU_XLOAD(si_) do { const int sub_ = dir ? (7 - (si_)) : (si_); const int tok_ = seg * 256 + sub_ * 32 + ct; \
        _Pragma("unroll") for (int w = 0; w < 4; ++w) { const int tt = tok_ - 1 + w; xr[w] = (tt >= 0 && tt < SEQ) ? *(const u32x4*)(XB + ((size_t)b * SEQ + tt) * LRUW + cc0) : (u32x4){0u, 0u, 0u, 0u}; } } while (0)
    LRU_XLOAD(0);
    for (int si = 0; si < 8; ++si) {
        const int sub = dir ? (7 - si) : si; const int t0 = seg * 256 + sub * 32;
        {
            float xc[8];
#pragma unroll
            for (int j = 0; j < 8; ++j) xc[j] = cb[j];
#pragma unroll
            for (int w = 0; w < 4; ++w) { const u32x4 v = xr[w];
#pragma unroll
                for (int e = 0; e < 4; ++e) { xc[2 * e] += cw[w][2 * e] * bflo(v[e]); xc[2 * e + 1] += cw[w][2 * e + 1] * bfhi(v[e]); } }
            if (si + 1 < 8) LRU_XLOAD(si + 1);
            *(LAS f32x4*)(lds + XCF + (ct * 128 + 8 * cg) * 4) = (f32x4){xc[0], xc[1], xc[2], xc[3]};
            *(LAS f32x4*)(lds + XCF + (ct * 128 + 8 * cg + 4) * 4) = (f32x4){xc[4], xc[5], xc[6], xc[7]};
            *(LAS u32x4*)(lds + XCB + sw256(ct, 16 * cg)) = (u32x4){cvt_pk_bf16(xc[0], xc[1]), cvt_pk_bf16(xc[2], xc[3]), cvt_pk_bf16(xc[4], xc[5]), cvt_pk_bf16(xc[6], xc[7])};
        }
        __syncthreads();
        {
            f32x16 acc = {};
#pragma unroll
            for (int ks = 0; ks < 8; ++ks) { const bf16x8 fa = *(const LAS bf16x8*)(lds + XCB + sw256(r, (16 * ks + 8 * hh) * 2)); acc = __builtin_amdgcn_mfma_f32_32x32x16_bf16(fa, bfrag[ks], acc, 0, 0, 0); }
#pragma unroll
            for (int q = 0; q < 8; ++q) {
                const auto sw = __builtin_amdgcn_permlane16_swap(__float_as_uint(acc[q]), __float_as_uint(acc[8 + q]), false, false);
                const float rp = __uint_as_float(sw[0]), ip = __uint_as_float(sw[1]);
                const int tq = crow((r < 16) ? q : (8 + q), hh); const int cl = 16 * wid + (r & 15);
                const float xcv = ((const LAS float*)(lds + XCF))[tq * 128 + cl];
                const float rg = frcp(1.0f + fexp2(fmaf(rp, -LOG2E, nba))), ig = frcp(1.0f + fexp2(fmaf(ip, -LOG2E, nbx)));
                const float av = fexp2(csp * rg), uv = __builtin_amdgcn_sqrtf(fmaxf(fmaf(-av, av, 1.0f), 0.f)) * ig * xcv;
                ((LAS float*)(lds + AA))[tq * 128 + cl] = av; ((LAS float*)(lds + UU))[tq * 128 + cl] = uv; }
        }
        __syncthreads();
        if (tid < 128) {
            LAS float* ap = (LAS float*)(lds + AA) + tid; LAS float* up = (LAS float*)(lds + UU) + tid; float av[32], uv[32];
#pragma unroll
            for (int i = 0; i < 32; ++i) { av[i] = ap[i * 128]; uv[i] = up[i * 128]; }
            if (dir == 0) {
#pragma unroll
                for (int i = 0; i < 32; ++i) { carry = av[i] * carry + uv[i]; if (MODE == 0) P *= av[i]; else uv[i] = carry; } }
            else {
#pragma unroll
                for (int i = 31; i >= 0; --i) { carry = av[i] * carry + uv[i]; if (MODE == 0) P *= av[i]; else uv[i] = carry; } }
            if (MODE != 0) {
#pragma unroll
                for (int i = 0; i < 32; ++i) up[i * 128] = uv[i]; }
        }
        if (MODE != 0) {
            __syncthreads();
            const int tok = t0 + ct; const size_t go = ((size_t)b * SEQ + tok) * LRUW + cc0;
            const f32x4 h0 = *(const LAS f32x4*)(lds + UU + (ct * 128 + 8 * cg) * 4), h1 = *(const LAS f32x4*)(lds + UU + (ct * 128 + 8 * cg + 4) * 4);
            if (MODE == 1) { *(u32x4*)(HF + go) = (u32x4){cvt_pk_bf16(h0[0], h0[1]), cvt_pk_bf16(h0[2], h0[3]), cvt_pk_bf16(h1[0], h1[1]), cvt_pk_bf16(h1[2], h1[3])}; }
            else { const u32x4 f = *(const u32x4*)(HF + go), y = *(const u32x4*)(YB + go);
                *(u32x4*)(HY + go) = (u32x4){cvt_pk_bf16((h0[0] + bflo(f[0])) * bflo(y[0]), (h0[1] + bfhi(f[0])) * bfhi(y[0])), cvt_pk_bf16((h0[2] + bflo(f[1])) * bflo(y[1]), (h0[3] + bfhi(f[1])) * bfhi(y[1])),
                                            cvt_pk_bf16((h1[0] + bflo(f[2])) * bflo(y[2]), (h1[1] + bfhi(f[2])) * bfhi(y[2])), cvt_pk_bf16((h1[2] + bflo(f[3])) * bflo(y[3]), (h1[3] + bfhi(f[3])) * bfhi(y[3]))}; }
        }
        __syncthreads();
    }
#undef LRU_XLOAD
    if (MODE == 0 && tid < 128) { float* sm = (float*)(ws + TB_LSUM) + (size_t)(((b * 32 + seg) * 2 + dir) * 2) * LRUW + n * 128 + tid; sm[0] = P; sm[LRUW] = carry; }
}
}
template <int MODE>
__device__ __forceinline__ void lru_phase(const Args& A, LAS unsigned char* lds, int bid, int G) {
    const int nitems = (MODE == 0) ? 5120 : 2560;
    for (int it = bid; it < nitems; it += G) {
        int b, n, seg, dir;
        if (MODE == 0) { dir = it & 1; const int r = it >> 1; seg = r & 31; n = (r >> 5) % 10; b = r / 320; }
        else { dir = MODE - 1; seg = it & 31; n = (it >> 5) % 10; b = it / 320; }
        lru::lru_item<MODE>(A, lds, b, n, seg, dir);
    }
}
__device__ __forceinline__ void lru_carry_phase(const Args& A, int bid, int G) {
    const float* sm = (const float*)(A.ws + TB_LSUM); float* cin = (float*)(A.ws + TB_LCIN);
    for (int idx = bid * NTHR + threadIdx.x; idx < NBATCH * 2 * LRUW; idx += G * NTHR) {
        const int b = idx / (2 * LRUW), r = idx % (2 * LRUW), dir = r / LRUW, ch = r % LRUW; float carry = 0.f;
        for (int i = 0; i < 32; ++i) { const int sg = dir ? (31 - i) : i; const size_t o = (size_t)((b * 32 + sg) * 2 + dir);
            cin[o * LRUW + ch] = carry; carry = sm[o * 2 * LRUW + ch] * carry + sm[o * 2 * LRUW + LRUW + ch]; }
    }
}

__device__ __forceinline__ void place_phase(const Args& A, LAS unsigned char* lds, int bid, int G) {
    int tid_ = threadIdx.x; asm volatile("" : "+v"(tid_));
    const int tid = tid_, lane = tid & 63, wave = tid >> 6; unsigned char* ws = A.ws;
    const int* bcnt = (const int*)(ws + TB_BCNT); const int* eid = (const int*)(ws + TB_EID); int* slot = (int*)(ws + TB_SLOT);
    const bf16_t* HM = (const bf16_t*)(ws + WS_HM); bf16_t* XS = (bf16_t*)(ws + E_XS);
    LAS int* tot = (LAS int*)lds; LAS int* pre = tot + 8; LAS int* rb = tot + 16; LAS int* wcn = tot + 32; LAS int* sl = tot + 64;
    for (int tb = bid; tb < MTOK / 256; tb += G) {
        { int t_ = 0, p_ = 0;
#pragma unroll
            for (int j = 0; j < 4; ++j) { const int blk = lane + 64 * j; const int v = bcnt[blk * 8 + wave]; t_ += v; p_ += (blk < tb) ? v : 0; }
#pragma unroll
            for (int o = 1; o < 64; o <<= 1) { t_ += __shfl_xor(t_, o); p_ += __shfl_xor(p_, o); }
            if (lane == 0) { tot[wave] = t_; pre[wave] = p_; } }
        __syncthreads();
        if (tid == 0) { int acc = 0; for (int e = 0; e < 8; ++e) { rb[e] = acc * 256; if (tb == 0) ((int*)(ws + TB_TILES))[e] = acc; acc += (tot[e] + 255) >> 8; } if (tb == 0) ((int*)(ws + TB_TILES))[8] = acc; }
        int e0 = -1, e1 = -1; unsigned long long mk0 = 0, mk1 = 0;
        if (tid < 256) { e0 = eid[(tb * 256 + tid) * 2]; e1 = eid[(tb * 256 + tid) * 2 + 1];
#pragma unroll
            for (int e = 0; e < 8; ++e) { const unsigned long long m = __ballot(e0 == e || e1 == e); if (lane == 0) wcn[wave * 8 + e] = __popcll(m); if (e0 == e) mk0 = m; if (e1 == e) mk1 = m; } }
        __syncthreads();
        if (tid < 256) { const unsigned long long lt = (1ull << lane) - 1ull; int b0 = rb[e0] + pre[e0] + __popcll(mk0 & lt), b1 = rb[e1] + pre[e1] + __popcll(mk1 & lt);
            for (int w = 0; w < wave; ++w) { b0 += wcn[w * 8 + e0]; b1 += wcn[w * 8 + e1]; }
            sl[tid * 2] = b0; sl[tid * 2 + 1] = b1; slot[(tb * 256 + tid) * 2] = b0; slot[(tb * 256 + tid) * 2 + 1] = b1; }
        __syncthreads();
        for (int i = 0; i < 32; ++i) { const int t = wave * 32 + i; const int s0 = sl[t * 2], s1 = sl[t * 2 + 1];
            const bf16_t* src = HM + (size_t)(tb * 256 + t) * DM + lane * 16;
            const u32x4 a = *(const u32x4*)src, b = *(const u32x4*)(src + 8);
            const u32x4 q = {pk_fp8x4(bflo(a[0]), bfhi(a[0]), bflo(a[1]), bfhi(a[1])), pk_fp8x4(bflo(a[2]), bfhi(a[2]), bflo(a[3]), bfhi(a[3])),
                             pk_fp8x4(bflo(b[0]), bfhi(b[0]), bflo(b[1]), bfhi(b[1])), pk_fp8x4(bflo(b[2]), bfhi(b[2]), bflo(b[3]), bfhi(b[3]))};
            *(u32x4*)((unsigned char*)XS + (size_t)s0 * DM + lane * 16) = q; *(u32x4*)((unsigned char*)XS + (size_t)s1 * DM + lane * 16) = q; }
        __syncthreads();
    }
}

namespace att {
constexpr int KVBLK = 64;
#define SBAR() __builtin_amdgcn_sched_barrier(0)
typedef int v8i __attribute__((ext_vector_type(8)));
__device__ __forceinline__ int crow(int r, int hi) { return (r & 3) + 8 * (r >> 2) + 4 * hi; }
constexpr int SLOTB = 16384;
__device__ __forceinline__ int k_slot(int s) { return s * SLOTB; }
__device__ __forceinline__ int v_slot(int s) { return s * SLOTB + 8192; }
__device__ __forceinline__ int kswz(int row) { return ((row & 7) ^ (row >> 4)) & 7; }
__device__ __forceinline__ int vswz(int row) { return (row >> 2) & 3; }
__device__ __forceinline__ void mfma8_acc(f32x16& acc, const v8i& a, const v8i& b, int sc) {
    asm volatile("s_nop 4\n\tv_mfma_scale_f32_32x32x64_f8f6f4 %0, %1, %2, %0, %3, %3 op_sel_hi:[0,0,0]" : "+v"(acc) : "v"(a), "v"(b), "v"(sc));
}
__device__ __forceinline__ void mfma8_c(f32x16& d, const v8i& a, const v8i& b, const f32x16& c, int sa, int sb) {
    asm volatile("v_mfma_scale_f32_32x32x64_f8f6f4 %0, %1, %2, %3, %4, %5 op_sel_hi:[0,0,0]" : "=&v"(d) : "v"(a), "v"(b), "v"(c), "v"(sa), "v"(sb));
}
#define ATT_LD8(p0_, p1_) __builtin_bit_cast(v8i, __builtin_shufflevector(*(const LAS u32x4*)(p0_), *(const LAS u32x4*)(p1_), 0, 1, 2, 3, 4, 5, 6, 7))
__device__ __forceinline__ void qkt(f32x16& p0, f32x16& p1, const LAS char* Ks, const v8i& qr, int r32, int hi, int jj, const f32x16& cinit, int s1, int s8) {
    const int c0 = jj * 4 + 2 * hi;
    { const int row = r32; const v8i kf = ATT_LD8(Ks + row * 128 + ((c0 ^ kswz(row)) << 4), Ks + row * 128 + (((c0 + 1) ^ kswz(row)) << 4)); mfma8_c(p0, kf, qr, cinit, s1, s8); }
    { const int row = 32 + r32; const v8i kf = ATT_LD8(Ks + row * 128 + ((c0 ^ kswz(row)) << 4), Ks + row * 128 + (((c0 + 1) ^ kswz(row)) << 4)); mfma8_c(p1, kf, qr, cinit, s1, s8); }
}
__device__ __forceinline__ void partialSM(f32x16& p0) {
#pragma unroll
    for (int r = 0; r < 16; ++r) p0[r] = fexp2(p0[r]);
}
__device__ __forceinline__ void finishSM(f32x16& p0, f32x16& p1, v8i& pa) {
#pragma unroll
    for (int r = 0; r < 16; ++r) p1[r] = fexp2(p1[r]);
#pragma unroll
    for (int w = 0; w < 4; ++w) { pa[w] = (int)pk_fp8x4(p0[4 * w], p0[4 * w + 1], p0[4 * w + 2], p0[4 * w + 3]); pa[4 + w] = (int)pk_fp8x4(p1[4 * w], p1[4 * w + 1], p1[4 * w + 2], p1[4 * w + 3]); }
}
__device__ __forceinline__ void pv_d0(f32x16* o, f32x16& lacc, const v8i& ones, const LAS char* Vs, const v8i& pa, int r32, int hi, int s1) {
#pragma unroll
    for (int d0 = 0; d0 < 4; ++d0) { const int row = 32 * d0 + r32;
        const v8i vf = ATT_LD8(Vs + row * 64 + (((2 * hi) ^ vswz(row)) << 4), Vs + row * 64 + (((2 * hi + 1) ^ vswz(row)) << 4));
        mfma8_acc(o[d0], pa, vf, s1); }
    mfma8_acc(lacc, pa, ones, s1);
}
}

__device__ __forceinline__ void vt_phase(const Args& A, int bid, int G) {
    const int tid = threadIdx.x; unsigned char* ws = A.ws;
    const bf16_t* V = (const bf16_t*)(ws + A_V); unsigned char* VT = ws + A_VT;
    const int dv = tid & 127, kq = tid >> 7, half = kq >> 1, hi = kq & 1;
    for (int it = bid; it < 64 * 128; it += G) {
        const int bh = it >> 7, tile = it & 127, b = bh >> 3, h = bh & 7;
        const bf16_t* vp = V + ((size_t)b * SEQ + tile * 64 + 32 * half) * DM + h * 128 + dv;
        float f[16];
#pragma unroll
        for (int i = 0; i < 16; ++i) f[i] = bf2f(vp[(size_t)att::crow(i, hi) * DM]);
        *(u32x4*)(VT + (((size_t)bh * 128 + dv) * 128 + tile) * 64 + hi * 32 + half * 16) =
            (u32x4){pk_fp8x4(f[0], f[1], f[2], f[3]), pk_fp8x4(f[4], f[5], f[6], f[7]), pk_fp8x4(f[8], f[9], f[10], f[11]), pk_fp8x4(f[12], f[13], f[14], f[15])};
    }
}

__device__ __forceinline__ void attn_phase(const Args& A, LAS unsigned char* ldsu, int bid, int G, int al) {
    using namespace att;
    LAS char* lds = (LAS char*)ldsu;
    unsigned char* ws = A.ws;
    const unsigned char* Qg = ws + A_Q; const unsigned char* Kg = ws + A_K; const unsigned char* VTg = ws + A_VT;
    bf16_t* Og = (bf16_t*)(ws + WS_HM);
    const float* scal = (const float*)(ws + TB_SCAL);
    const float lamv = scal[SC_LAM0 + al], omli = scal[SC_OML0 + al], Mc = scal[SC_MC0 + al] - 7.5f;
    const float* subg = A.in[I_ATSUB] + al * 128;
    int tid_ = threadIdx.x; asm volatile("" : "+v"(tid_));
    const int tid = tid_, wid = __builtin_amdgcn_readfirstlane(tid >> 6), lane = tid & 63, r32 = lane & 31, hi = lane >> 5, jj = wid >> 2, wq = wid & 3;
    constexpr int NT = SEQ / KVBLK;
    int s1 = 0x7f7f7f7f, s8 = 0x7c7c7c7c; asm volatile("" : "+v"(s1), "+v"(s8));
    v8i ones; { int o1 = 0x38383838; asm volatile("" : "+v"(o1)); ones = (v8i){o1, o1, o1, o1, o1, o1, o1, o1}; }
    f32x16 cinit;
#pragma unroll
    for (int r = 0; r < 16; ++r) cinit[r] = -Mc;
    unsigned koff, voff;
    { const int bb = wid * 1024 + lane * 16;
      { const int row = bb >> 7, c = ((bb & 127) >> 4) ^ kswz(row); koff = (unsigned)(row * 1024 + c * 16); }
      { const int row = bb >> 6, c = ((bb & 63) >> 4) ^ vswz(row); voff = (unsigned)(row * 8192 + c * 16); } }
    const unsigned ldsw = (unsigned)wid * 1024u;
#define ATT_DMA(slot, kt, vt) do { \
        __builtin_amdgcn_global_load_lds((const unsigned*)((const unsigned char*)(kt) + koff), (LAS unsigned*)(lds + k_slot(slot) + ldsw), 16, 0, 0); \
        __builtin_amdgcn_global_load_lds((const unsigned*)((const unsigned char*)(vt) + voff), (LAS unsigned*)(lds + v_slot(slot) + ldsw), 16, 0, 0); } while (0)
#define ATT_TOP() do { asm volatile("s_waitcnt vmcnt(0)" ::: "memory"); __builtin_amdgcn_s_barrier(); asm volatile("" ::: "memory"); } while (0)
    const int xq = bid & 7, cq = bid >> 3;
    int cbh = xq * 8;
    const bool lag = (jj != 0);
#define ATT_KB(bh_) (Kg + ((size_t)((bh_) >> 3) * SEQ) * DM + ((bh_) & 7) * 128)
#define ATT_VB(bh_) (VTg + (size_t)(bh_) * 128 * 8192)
    ATT_DMA(0, ATT_KB(cbh), ATT_VB(cbh));
    { asm volatile("s_waitcnt vmcnt(0)" ::: "memory"); __builtin_amdgcn_s_barrier(); asm volatile("" ::: "memory"); ATT_DMA(1, ATT_KB(cbh) + (size_t)64 * DM, ATT_VB(cbh) + 64); }
    for (int ui = 0; ui < 16; ++ui) {
        const int qb = (ui & 1) * 32 + cq;
        const int nbh = (ui + 1 < 16) ? xq * 8 + ((ui + 1) >> 1) : cbh;
        const unsigned char* Kh = ATT_KB(cbh); const unsigned char* Vh = ATT_VB(cbh); const unsigned char* nK = ATT_KB(nbh); const unsigned char* nV = ATT_VB(nbh);
        const size_t obase = ((size_t)(cbh >> 3) * SEQ + qb * 128) * DM + (cbh & 7) * 128;
        f32x16 lacc = {}; f32x16 o[4] = {}; v8i qr;
        { const unsigned char* Qw = Qg + obase + (size_t)(wq * 32 + r32) * DM + jj * 64 + hi * 32;
          const u32x4 qa = *(const u32x4*)Qw, qb2 = *(const u32x4*)(Qw + 16);
          qr = __builtin_bit_cast(v8i, __builtin_shufflevector(qa, qb2, 0, 1, 2, 3, 4, 5, 6, 7)); }
        f32x16 pA0, pA1, pB0, pB1; v8i pa;
#define ATT_SRC(jt, KP, VP) const unsigned char* KP = ((jt) + 2 < NT) ? Kh + (size_t)((jt) + 2) * 64 * DM : nK + (size_t)((jt) + 2 - NT) * 64 * DM; \
                            const unsigned char* VP = ((jt) + 2 < NT) ? Vh + (size_t)((jt) + 2) * 64 : nV + (size_t)((jt) + 2 - NT) * 64
#define ATT_BAR(jt) do { ATT_TOP(); ATT_SRC(jt, kp_, vp_); ATT_DMA(((jt) + 2) & 3, kp_, vp_); } while (0)
        { qkt(pA0, pA1, lds + k_slot(0), qr, r32, hi, jj, cinit, s1, s8);
          if (lag) ATT_BAR(0);
          asm volatile("s_nop 15\n\ts_nop 7" ::: "memory");
          partialSM(pA0);
          if (!lag) ATT_BAR(0); }
        for (int jt = 1; jt + 1 < NT; jt += 2) {
            { SBAR(); qkt(pB0, pB1, lds + k_slot(jt & 3), qr, r32, hi, jj, cinit, s1, s8);
              finishSM(pA0, pA1, pa); SBAR();
              if (lag) ATT_BAR(jt);
              pv_d0(o, lacc, ones, lds + v_slot((jt - 1) & 3), pa, r32, hi, s1); partialSM(pB0);
              if (!lag) ATT_BAR(jt); }
            { const int j2 = jt + 1;
              SBAR(); qkt(pA0, pA1, lds + k_slot(j2 & 3), qr, r32, hi, jj, cinit, s1, s8);
              finishSM(pB0, pB1, pa); SBAR();
              if (lag) ATT_BAR(j2);
              pv_d0(o, lacc, ones, lds + v_slot((j2 - 1) & 3), pa, r32, hi, s1); partialSM(pA0);
              if (!lag) ATT_BAR(j2); }
        }
        { constexpr int jt = NT - 1;
          SBAR(); qkt(pB0, pB1, lds + k_slot(jt & 3), qr, r32, hi, jj, cinit, s1, s8);
          finishSM(pA0, pA1, pa); SBAR();
          if (lag) ATT_BAR(jt);
          pv_d0(o, lacc, ones, lds + v_slot((jt - 1) & 3), pa, r32, hi, s1); partialSM(pB0);
          if (!lag) ATT_BAR(jt);
          finishSM(pB0, pB1, pa); SBAR();
          pv_d0(o, lacc, ones, lds + v_slot(jt & 3), pa, r32, hi, s1);
          asm volatile("s_nop 15\n\ts_nop 15" ::: "memory"); }
#undef ATT_BAR
#undef ATT_SRC
        int r32e = r32, hie = hi; asm volatile("" : "+v"(r32e), "+v"(hie));
        float rli[16];
#pragma unroll
        for (int r = 0; r < 16; ++r) rli[r] = frcp(lacc[r]);
        LAS float* Cb = (LAS float*)(lds + 65536);
        if (jj == 1) {
#pragma unroll
            for (int r = 0; r < 16; ++r) { const float sc = rli[r] * lamv;
#pragma unroll
                for (int d0 = 0; d0 < 4; ++d0) Cb[(wq * 32 + crow(r, hie)) * 128 + d0 * 32 + r32e] = o[d0][r] * sc; }
        }
        asm volatile("s_waitcnt lgkmcnt(0)" ::: "memory"); __builtin_amdgcn_s_barrier(); asm volatile("" ::: "memory");
        if (jj == 0) {
            float g[4];
#pragma unroll
            for (int d0 = 0; d0 < 4; ++d0) g[d0] = subg[d0 * 32 + r32e] * omli;
            bf16_t* Ob = Og + obase;
#pragma unroll
            for (int r = 0; r < 16; ++r) {
                float ss = 0.f;
#pragma unroll
                for (int d0 = 0; d0 < 4; ++d0) { const float v = o[d0][r] * rli[r] - Cb[(wq * 32 + crow(r, hie)) * 128 + d0 * 32 + r32e]; o[d0][r] = v; ss += v * v; }
                ss += __shfl_xor(ss, 1); ss += __shfl_xor(ss, 2); ss += __shfl_xor(ss, 4); ss += __shfl_xor(ss, 8); ss += __shfl_xor(ss, 16);
                const float rs = 1.0f / sqrtf(ss * (1.0f / 128.0f) + EPS);
                bf16_t* op = Ob + (size_t)(wq * 32 + crow(r, hie)) * DM + r32e;
#pragma unroll
                for (int d0 = 0; d0 < 4; ++d0) op[d0 * 32] = (bf16_t)f2bf(o[d0][r] * rs * g[d0]);
            }
        }
        asm volatile("s_waitcnt lgkmcnt(0)" ::: "memory"); __builtin_amdgcn_s_barrier(); asm volatile("" ::: "memory");
        cbh = nbh;
    }
    asm volatile("s_waitcnt vmcnt(0) lgkmcnt(0)" ::: "memory"); __builtin_amdgcn_s_barrier(); asm volatile("" ::: "memory");
#undef ATT_DMA
#undef ATT_TOP
#undef ATT_KB
#undef ATT_VB
#undef ATT_LD8
}

namespace gla {
constexpr int BC = 0, QI = 32768, QA = 49152, KA = 65536, KST = 81920, VT = 98304, ST = 106496, AT = 122880, EM = 131072, EL = EM + 512, DD = EM + 1024, BMID = EM + 1536, SEG = EM + 2048;
static_assert(SEG + 2048 <= RING_BYTES, "gla lds");
__device__ __forceinline__ int sw256(int row, int cb) { return row * 256 + (cb ^ ((row & 15) << 4)); }
__device__ __forceinline__ int sw128(int row, int cb) { return row * 128 + (cb ^ ((((row & 7) ^ (row >> 4)) & 7) << 4)); }
__device__ __forceinline__ int crow(int r, int hi) { return (r & 3) + 8 * (r >> 2) + 4 * hi; }
__device__ __forceinline__ float h2f(unsigned short b) { return (float)__builtin_bit_cast(_Float16, b); }
__device__ __forceinline__ void gla_item(const bf16_t* __restrict__ Qp, const unsigned short* __restrict__ LFp, const bf16_t* __restrict__ Vp, bf16_t* __restrict__ Op, int dir, LAS unsigned char* lds, float* dbg) {
    int tid_ = threadIdx.x; asm volatile("" : "+v"(tid_));
    const int tid = tid_, wid = tid >> 6, lane = tid & 63, r = lane & 31, hh = lane >> 5;
    const int t1 = tid >> 3, kg = tid & 7, k0 = 16 * kg, v0 = (tid & 7) * 8;
    for (int i = tid; i < 16384 / 16; i += NTHR) *(LAS u32x4*)(lds + ST + i * 16) = (u32x4){0u, 0u, 0u, 0u};
    f32x16 st = {};
    u32x4 rq[2], rl[2], rv;
#define GLA_TOK(ci, i) (dir ? (SEQ - 1 - ((ci) * 64 + (i))) : ((ci) * 64 + (i)))
#define GLA_LOAD(ci) do { const size_t to = (size_t)GLA_TOK(ci, t1) * DM; \
        rq[0] = *(const u32x4*)(Qp + to + k0); rq[1] = *(const u32x4*)(Qp + to + k0 + 8); \
        rl[0] = *(const u32x4*)(LFp + to + k0); rl[1] = *(const u32x4*)(LFp + to + k0 + 8); rv = *(const u32x4*)(Vp + to + v0); } while (0)
    GLA_LOAD(0);
    __syncthreads();
    for (int ci = 0; ci < SEQ / 64; ++ci) {
        float qf[16], lf[16]; u32x4 vreg = rv;
#pragma unroll
        for (int j = 0; j < 2; ++j)
#pragma unroll
            for (int e = 0; e < 4; ++e) { qf[j * 8 + 2 * e] = bflo(rq[j][e]); qf[j * 8 + 2 * e + 1] = bfhi(rq[j][e]);
                lf[j * 8 + 2 * e] = h2f((unsigned short)(rl[j][e] & 0xffffu)); lf[j * 8 + 2 * e + 1] = h2f((unsigned short)(rl[j][e] >> 16)); }
        if (ci + 1 < SEQ / 64) GLA_LOAD(ci + 1);
#pragma unroll
        for (int j = 0; j < 4; ++j) *(LAS f32x4*)(lds + BC + (t1 * 128 + k0 + 4 * j) * 4) = (f32x4){lf[4 * j], lf[4 * j + 1], lf[4 * j + 2], lf[4 * j + 3]};
        __syncthreads();
        { const int kc = tid & 127, sg = tid >> 7; LAS float* bc = (LAS float*)(lds + BC) + kc; float cs[16];
#pragma unroll
            for (int i = 0; i < 16; ++i) cs[i] = bc[(sg * 16 + i) * 128];
#pragma unroll
            for (int i = 1; i < 16; ++i) cs[i] += cs[i - 1];
            ((LAS float*)(lds + SEG))[sg * 128 + kc] = cs[15];
            __syncthreads();
            const LAS float* sgp = (const LAS float*)(lds + SEG) + kc; const float s0 = sgp[0], s1 = sgp[128], s2 = sgp[256], s3 = sgp[384];
            const float off = sg == 0 ? 0.f : sg == 1 ? s0 : sg == 2 ? (s0 + s1) : ((s0 + s1) + s2);
#pragma unroll
            for (int i = 0; i < 16; ++i) bc[(sg * 16 + i) * 128] = cs[i] + off;
            if (sg == 0) { const float bm = s0 + s1, bl = ((s0 + s1) + s2) + s3;
                ((LAS float*)(lds + BMID))[kc] = bm; ((LAS float*)(lds + EM))[kc] = fexp(bm); ((LAS float*)(lds + EL))[kc] = fexp(bl - bm); ((LAS float*)(lds + DD))[kc] = fexp(bl); }
            __syncthreads();
        }
#ifdef DIAG
        if (dbg && ci == 0) { for (int i = tid; i < 8192; i += NTHR) dbg[i] = ((const LAS float*)(lds + BC))[i]; }
#endif
        {
            unsigned wqi[8], wqa[8], wka[8]; float ksv[16];
#pragma unroll
            for (int j = 0; j < 4; ++j) {
                const f32x4 bt = *(const LAS f32x4*)(lds + BC + (t1 * 128 + k0 + 4 * j) * 4), bm = *(const LAS f32x4*)(lds + BMID + (k0 + 4 * j) * 4);
                const f32x4 em = *(const LAS f32x4*)(lds + EM + (k0 + 4 * j) * 4), el = *(const LAS f32x4*)(lds + EL + (k0 + 4 * j) * 4);
                float qi[4], qa[4], ka[4];
#pragma unroll
                for (int e = 0; e < 4; ++e) { const int i = 4 * j + e; const float e1 = fexp(bt[e] - bm[e]), r1 = frcp(e1);
                    qa[e] = qf[i] * e1; qi[e] = qa[e] * em[e]; const float kk = 1.0f - fexp(lf[i]); ka[e] = kk * r1; ksv[i] = ka[e] * el[e]; }
                wqi[2 * j] = cvt_pk_bf16(qi[0], qi[1]); wqi[2 * j + 1] = cvt_pk_bf16(qi[2], qi[3]);
                wqa[2 * j] = cvt_pk_bf16(qa[0], qa[1]); wqa[2 * j + 1] = cvt_pk_bf16(qa[2], qa[3]);
                wka[2 * j] = cvt_pk_bf16(ka[0], ka[1]); wka[2 * j + 1] = cvt_pk_bf16(ka[2], ka[3]);
            }
#pragma unroll
            for (int j = 0; j < 2; ++j) { const int off = sw256(t1, (k0 + 8 * j) * 2);
                *(LAS u32x4*)(lds + QI + off) = (u32x4){wqi[4 * j], wqi[4 * j + 1], wqi[4 * j + 2], wqi[4 * j + 3]};
                *(LAS u32x4*)(lds + QA + off) = (u32x4){wqa[4 * j], wqa[4 * j + 1], wqa[4 * j + 2], wqa[4 * j + 3]};
                *(LAS u32x4*)(lds + KA + off) = (u32x4){wka[4 * j], wka[4 * j + 1], wka[4 * j + 2], wka[4 * j + 3]}; }
#pragma unroll
            for (int i = 0; i < 16; ++i) *(LAS unsigned short*)(lds + KST + sw128(k0 + i, t1 * 2)) = (unsigned short)f2bf(ksv[i]);
#pragma unroll
            for (int e = 0; e < 4; ++e) { *(LAS unsigned short*)(lds + VT + sw128(v0 + 2 * e, t1 * 2)) = (unsigned short)(vreg[e] & 0xffffu);
                *(LAS unsigned short*)(lds + VT + sw128(v0 + 2 * e + 1, t1 * 2)) = (unsigned short)(vreg[e] >> 16); }
        }
        __syncthreads();
        f32x16 oacc = {};
        const int w4 = wid & 3, t_i = w4 >> 1, v_i = w4 & 1;
        if (wid < 4) {
            const int s_i = wid >> 1, tq = wid & 1; f32x16 a = {};
#pragma unroll
            for (int ks = 0; ks < 8; ++ks) { const bf16x8 fa = *(const LAS bf16x8*)(lds + KA + sw256(32 * s_i + r, (16 * ks + 8 * hh) * 2)), fb = *(const LAS bf16x8*)(lds + QA + sw256(32 * tq + r, (16 * ks + 8 * hh) * 2));
                a = __builtin_amdgcn_mfma_f32_32x32x16_bf16(fa, fb, a, 0, 0, 0); }
            const int tg = 32 * tq + r;
#pragma unroll
            for (int g = 0; g < 4; ++g) { float m[4];
#pragma unroll
                for (int e = 0; e < 4; ++e) { const int sgl = 32 * s_i + 8 * g + 4 * hh + e; m[e] = (sgl <= tg) ? a[4 * g + e] : 0.f; }
                *(LAS u32x2*)(lds + AT + sw128(tg, (32 * s_i + 8 * g + 4 * hh) * 2)) = (u32x2){cvt_pk_bf16(m[0], m[1]), cvt_pk_bf16(m[2], m[3])}; }
        } else {
#pragma unroll
            for (int ks = 0; ks < 8; ++ks) { const bf16x8 fa = *(const LAS bf16x8*)(lds + QI + sw256(32 * t_i + r, (16 * ks + 8 * hh) * 2)), fb = *(const LAS bf16x8*)(lds + ST + sw256(32 * v_i + r, (16 * ks + 8 * hh) * 2));
                oacc = __builtin_amdgcn_mfma_f32_32x32x16_bf16(fa, fb, oacc, 0, 0, 0); }
        }
        __syncthreads();
#ifdef DIAG
        if (dbg && ci == 0) { for (int i = tid; i < 2048; i += NTHR) { ((unsigned*)dbg)[8192 + i] = ((const LAS unsigned*)(lds + AT))[i]; ((unsigned*)dbg)[8192 + 2048 + i] = ((const LAS unsigned*)(lds + VT))[i]; } }
#endif
        if (wid >= 4) {
#pragma unroll
            for (int ks = 0; ks < 4; ++ks) { const bf16x8 fa = *(const LAS bf16x8*)(lds + AT + sw128(32 * t_i + r, (16 * ks + 8 * hh) * 2)), fb = *(const LAS bf16x8*)(lds + VT + sw128(32 * v_i + r, (16 * ks + 8 * hh) * 2));
                oacc = __builtin_amdgcn_mfma_f32_32x32x16_bf16(fa, fb, oacc, 0, 0, 0); }
#pragma unroll
            for (int i = 0; i < 16; ++i) { const int t = 32 * t_i + crow(i, hh); Op[(size_t)GLA_TOK(ci, t) * DM + 32 * v_i + r] = (bf16_t)f2bf(oacc[i]); }
        }
        {
            const int kq = wid >> 1, vq = wid & 1;
#pragma unroll
            for (int i = 0; i < 16; ++i) st[i] *= ((const LAS float*)(lds + DD))[32 * kq + crow(i, hh)];
#pragma unroll
            for (int ks = 0; ks < 4; ++ks) { const bf16x8 fa = *(const LAS bf16x8*)(lds + KST + sw128(32 * kq + r, (16 * ks + 8 * hh) * 2)), fb = *(const LAS bf16x8*)(lds + VT + sw128(32 * vq + r, (16 * ks + 8 * hh) * 2));
                st = __builtin_amdgcn_mfma_f32_32x32x16_bf16(fa, fb, st, 0, 0, 0); }
#pragma unroll
            for (int g = 0; g < 4; ++g) *(LAS u32x2*)(lds + ST + sw256(32 * vq + r, (32 * kq + 8 * g + 4 * hh) * 2)) = (u32x2){cvt_pk_bf16(st[4 * g], st[4 * g + 1]), cvt_pk_bf16(st[4 * g + 2], st[4 * g + 3])};
        }
        __syncthreads();
#ifdef DIAG
        if (dbg && ci == 0) { for (int i = tid; i < 4096; i += NTHR) { ((unsigned*)dbg)[12288 + i] = ((const LAS unsigned*)(lds + ST))[i]; ((unsigned*)dbg)[16384 + i] = ((const LAS unsigned*)(lds + KST))[i]; } }
#endif
    }
#undef GLA_TOK
#undef GLA_LOAD
}
}
__device__ __forceinline__ void gla_phase(const Args& A, LAS unsigned char* lds, int bid, int G) {
    unsigned char* ws = A.ws;
    for (int it = bid; it < 256; it += G) {
        const int b = it >> 5, h = (it >> 2) & 7, dir = (it >> 1) & 1, vh = it & 1;
        const size_t base = (size_t)b * SEQ * DM + h * 128;
        gla::gla_item((const bf16_t*)(ws + H_Q) + base, (const unsigned short*)(ws + (dir ? H_LFB : H_LFF)) + base, (const bf16_t*)(ws + H_V) + base + vh * 64,
                      (bf16_t*)(ws + (dir ? H_OB : H_OF)) + base + vh * 64, dir, lds, it == 0 ? (float*)(ws + TB_LSUM) : nullptr);
    }
}
__device__ __forceinline__ void hg_normo_phase(const Args& A, int bid, int G) {
    int tid_ = threadIdx.x; asm volatile("" : "+v"(tid_));
    const int tid = tid_, lane = tid & 63, wave = tid >> 6; unsigned char* ws = A.ws;
    const bf16_t* OF = (const bf16_t*)(ws + H_OF); const bf16_t* OB = (const bf16_t*)(ws + H_OB); const bf16_t* GG = (const bf16_t*)(ws + H_G); bf16_t* HM = (bf16_t*)(ws + WS_HM);
    const int c0 = (lane >> 3) * 128 + (lane & 7) * 16;
    float ng[16];
#pragma unroll
    for (int i = 0; i < 16; ++i) ng[i] = A.in[I_HGNG][(lane & 7) * 16 + i];
    for (int row = (bid * NWAVES + wave); row < MTOK; row += G * NWAVES) {
        const size_t o = (size_t)row * DM + c0;
        const u32x4 a0 = *(const u32x4*)(OF + o), a1 = *(const u32x4*)(OF + o + 8), b0 = *(const u32x4*)(OB + o), b1 = *(const u32x4*)(OB + o + 8), g0 = *(const u32x4*)(GG + o), g1 = *(const u32x4*)(GG + o + 8);
        float v[16], gt[16]; float ss = 0.f;
#pragma unroll
        for (int e = 0; e < 4; ++e) { v[2 * e] = bflo(a0[e]) + bflo(b0[e]); v[2 * e + 1] = bfhi(a0[e]) + bfhi(b0[e]); v[8 + 2 * e] = bflo(a1[e]) + bflo(b1[e]); v[8 + 2 * e + 1] = bfhi(a1[e]) + bfhi(b1[e]);
            gt[2 * e] = bflo(g0[e]); gt[2 * e + 1] = bfhi(g0[e]); gt[8 + 2 * e] = bflo(g1[e]); gt[8 + 2 * e + 1] = bfhi(g1[e]); }
#pragma unroll
        for (int i = 0; i < 16; ++i) ss += v[i] * v[i];
        ss += __shfl_xor(ss, 1); ss += __shfl_xor(ss, 2); ss += __shfl_xor(ss, 4);
        const float rstd = 1.0f / sqrtf(ss * (1.0f / 128.0f) + EPS);
        u32x4 w0, w1;
#pragma unroll
        for (int e = 0; e < 4; ++e) { w0[e] = cvt_pk_bf16(v[2 * e] * rstd * ng[2 * e] * gt[2 * e], v[2 * e + 1] * rstd * ng[2 * e + 1] * gt[2 * e + 1]);
            w1[e] = cvt_pk_bf16(v[8 + 2 * e] * rstd * ng[8 + 2 * e] * gt[8 + 2 * e], v[8 + 2 * e + 1] * rstd * ng[8 + 2 * e + 1] * gt[8 + 2 * e + 1]); }
        *(u32x4*)(HM + o) = w0; *(u32x4*)(HM + o + 8) = w1;
    }
}

#ifdef DIAG
constexpr int DG_BASE = 8192;
__device__ __forceinline__ void dg_put(const Args& A, int k, float e) { if (!(e >= 0.f) || e > 1e9f) e = 1e9f; atomicMax((unsigned*)(A.ws + WS_CTL) + DG_BASE + 64 * k, __float_as_uint(e)); }
__device__ __forceinline__ float dg_rel(float got, float ref) { return fabsf(got - ref) / (fabsf(ref) + 0.1f); }
__device__ __forceinline__ unsigned dg_hash(unsigned a, unsigned b) { unsigned h = a * 2654435761u + b * 40503u + 0x9e3779b9u; h ^= h >> 15; h *= 2246822519u; h ^= h >> 13; h *= 3266489917u; h ^= h >> 16; return h; }
__device__ __forceinline__ float dg_bfr(float x) { return bflo(f2bf(x)); }
__device__ __forceinline__ void dg_mods(const Args& A, int k) {
    const int lane = threadIdx.x & 63, gwv = blockIdx.x * 8 + (threadIdx.x >> 6);
    const unsigned h = dg_hash(gwv, k); const int l = h & 3, b = (h >> 2) & 7, e = (h >> 5) % 6144;
    float a = 0.f; for (int d = lane; d < DM; d += 64) a += fsilu(A.in[I_C][b * DM + d]) * A.in[I_ADAW][((size_t)l * DM + d) * 6144 + e];
    a = wave_sum(a) + A.in[I_ADAB][l * 6144 + e];
    const float got = ((const float*)(A.ws + TB_MODS))[((size_t)l * NBATCH + b) * 6144 + e];
    if (lane == 0) dg_put(A, k, dg_rel(got, a));
}
__device__ __forceinline__ void dg_norm(const Args& A, int k, const float* x, const float* gain, int L, int which) {
    const int lane = threadIdx.x & 63, gwv = blockIdx.x * 8 + (threadIdx.x >> 6);
    const int row = dg_hash(gwv, k) & (MTOK - 1), b = row >> 13;
    const float* modl = (const float*)(A.ws + TB_MODS) + ((size_t)L * NBATCH + b) * 6144;
    float ss = 0.f; for (int c = lane; c < DM; c += 64) { const float v = x[(size_t)row * DM + c]; ss += v * v; }
    ss = wave_sum(ss); const float rstd = 1.0f / sqrtf(ss / DM + EPS); float e = 0.f;
    for (int c = lane; c < DM; c += 64) { const float ref = x[(size_t)row * DM + c] * rstd * gain[c] * (1.0f + modl[(which * 3 + 1) * 1024 + c]) + modl[(which * 3) * 1024 + c];
        e = fmaxf(e, dg_rel(bf2f(((const bf16_t*)(A.ws + WS_HM))[(size_t)row * DM + c]), ref)); }
    dg_put(A, k, e);
}
__device__ __forceinline__ void dg_qkv(const Args& A, int k, int al) {
    const int lane = threadIdx.x & 63, gwv = blockIdx.x * 8 + (threadIdx.x >> 6);
    const unsigned h = dg_hash(gwv, k); const int row = h & (MTOK - 1), t = (h >> 16) % 48, col = t * 64 + lane;
    const bf16_t* hm = (const bf16_t*)(A.ws + WS_HM) + (size_t)row * DM; const float* w = A.in[I_ATWIN] + (size_t)al * 1024 * 3072 + col;
    float a = 0.f; for (int kk = 0; kk < DM; ++kk) a += bf2f(hm[kk]) * dg_bfr(w[(size_t)kk * 3072]);
    float ref, got;
    if (t < 32) {
        const int part = t >> 4, sh = t & 15; const float ss = wave_sum(a * a); const float rstd = 1.0f / sqrtf(ss / 64.0f + EPS);
        const float y = a * rstd * (part ? A.in[I_ATKN] : A.in[I_ATQN])[al * 64 + lane]; const float yp = __shfl_xor(y, 32);
        const int pos = row & (SEQ - 1); const float cs = ((const float*)(A.ws + TB_COS))[pos * 32 + (lane & 31)], sn = ((const float*)(A.ws + TB_SIN))[pos * 32 + (lane & 31)];
        ref = (lane < 32) ? (y * cs - yp * sn) : (y * cs + yp * sn); if (part == 0) ref *= 0.125f * LOG2E;
        got = bf2f(((const bf16_t*)(A.ws + (part ? A_K : A_Q)))[(size_t)row * DM + sh * 64 + lane]);
    } else { ref = a; got = bf2f(((const bf16_t*)(A.ws + A_V))[(size_t)row * DM + (t - 32) * 64 + lane]); }
    dg_put(A, k, dg_rel(got, ref));
}
__device__ __forceinline__ void dg_attn(const Args& A, int k, int al, LAS unsigned char* lds) {
    const int tid = threadIdx.x; const unsigned h = dg_hash(blockIdx.x, k); const int row = h & (MTOK - 1), hd = (h >> 16) & 7, b = row >> 13;
    const bf16_t* Q = (const bf16_t*)(A.ws + A_Q); const bf16_t* K = (const bf16_t*)(A.ws + A_K); const bf16_t* V = (const bf16_t*)(A.ws + A_V);
    const float* scal = (const float*)(A.ws + TB_SCAL); const float lamv = scal[SC_LAM0 + al], omli = scal[SC_OML0 + al], Mc = scal[SC_MC0 + al];
    LAS float* p0 = (LAS float*)lds; LAS float* p1 = p0 + SEQ; LAS float* red = p1 + SEQ;
    float l0 = 0.f, l1 = 0.f;
    for (int key = tid; key < SEQ; key += NTHR) { const bf16_t* kr = K + ((size_t)b * SEQ + key) * DM + hd * 128; const bf16_t* qr = Q + (size_t)row * DM + hd * 128;
        float s0 = 0.f, s1 = 0.f; for (int d = 0; d < 64; ++d) { s0 += bf2f(qr[d]) * bf2f(kr[d]); s1 += bf2f(qr[64 + d]) * bf2f(kr[64 + d]); }
        const float e0 = fexp2(s0 - Mc), e1 = fexp2(s1 - Mc); p0[key] = e0; p1[key] = e1; l0 += e0; l1 += e1; }
    l0 = wave_sum(l0); l1 = wave_sum(l1); if ((tid & 63) == 0) { red[tid >> 6] = l0; red[8 + (tid >> 6)] = l1; }
    __syncthreads();
    l0 = 0.f; l1 = 0.f; for (int w = 0; w < 8; ++w) { l0 += red[w]; l1 += red[8 + w]; }
    __syncthreads();
    const int dv = tid & 127, part = tid >> 7; float o = 0.f;
    for (int key = part * 2048; key < part * 2048 + 2048; ++key) o += (p0[key] / l0 - lamv * p1[key] / l1) * bf2f(V[((size_t)b * SEQ + key) * DM + hd * 128 + dv]);
    red[16 + part * 128 + dv] = o; __syncthreads();
    if (tid < 128) { o = red[16 + tid] + red[16 + 128 + tid] + red[16 + 256 + tid] + red[16 + 384 + tid]; red[600 + tid] = o * o; }
    __syncthreads();
    if (tid < 128) { float ss = 0.f; for (int i = 0; i < 128; ++i) ss += red[600 + i]; const float ref = o / sqrtf(ss / 128.0f + EPS) * A.in[I_ATSUB][al * 128 + tid] * omli;
        dg_put(A, k, dg_rel(bf2f(((const bf16_t*)(A.ws + WS_HM))[(size_t)row * DM + hd * 128 + tid]), ref)); }
    __syncthreads();
}
__device__ __forceinline__ void dg_save(const Args& A, int k, const float* xold) {
    const int lane = threadIdx.x & 63, gwv = blockIdx.x * 8 + (threadIdx.x >> 6);
    const unsigned h = dg_hash(gwv, k); const int row = h & (MTOK - 1), col = (h >> 16) & 1023;
    float* sv = (float*)(A.ws + TB_LSUM) + 7 * 1024 * 1024 / 4;
    if (lane == 0) sv[k * 4096 + gwv] = xold[(size_t)row * DM + col];
}
__device__ __forceinline__ void dg_res(const Args& A, int k, const float* xnew, const float* gate, const bf16_t* Am, int K, const float* W) {
    const int lane = threadIdx.x & 63, gwv = blockIdx.x * 8 + (threadIdx.x >> 6);
    const unsigned h = dg_hash(gwv, k); const int row = h & (MTOK - 1), col = (h >> 16) & 1023, b = row >> 13;
    const float* sv = (const float*)(A.ws + TB_LSUM) + 7 * 1024 * 1024 / 4;
    float a = 0.f; for (int kk = lane; kk < K; kk += 64) a += bf2f(Am[(size_t)row * K + kk]) * dg_bfr(W[(size_t)kk * DM + col]);
    a = wave_sum(a);
    const float ref = sv[k * 4096 + gwv] + gate[(size_t)b * 6144 + col] * a;
    if (lane == 0) dg_put(A, k, dg_rel(xnew[(size_t)row * DM + col], ref));
}
__device__ __forceinline__ void dg_swiglu(const Args& A, int k, const bf16_t* Am, const float* W, int F, const bf16_t* H, int nrows, const int* rowmap) {
    const int lane = threadIdx.x & 63, gwv = blockIdx.x * 8 + (threadIdx.x >> 6);
    const unsigned h = dg_hash(gwv, k); const int row = (h & 0xfffff) % nrows, j = (h >> 20) % F;
    float g = 0.f, u = 0.f; for (int kk = lane; kk < DM; kk += 64) { const float x = bf2f(Am[(size_t)row * DM + kk]); g += x * dg_bfr(W[(size_t)kk * 2 * F + j]); u += x * dg_bfr(W[(size_t)kk * 2 * F + F + j]); }
    g = wave_sum(g); u = wave_sum(u);
    const float ref = g / (1.0f + expf(-g)) * u;
    if (lane == 0) dg_put(A, k, dg_rel(bf2f(H[(size_t)row * F + j]), ref));
}
__device__ __forceinline__ void dg_hgin(const Args& A, int k) {
    const int lane = threadIdx.x & 63, gwv = blockIdx.x * 8 + (threadIdx.x >> 6);
    const unsigned h = dg_hash(gwv, k); const int row = h & (MTOK - 1), col = (h >> 16) % 5120, grp = col >> 10, cc = col & 1023;
    float a = 0.f; for (int kk = lane; kk < DM; kk += 64) a += bf2f(((const bf16_t*)(A.ws + WS_HM))[(size_t)row * DM + kk]) * dg_bfr(A.in[I_HGWIN][(size_t)kk * 5120 + col]);
    a = wave_sum(a);
    float ref, got;
    if (grp == 0 || grp == 4) { ref = a / (1.0f + expf(-a)); got = bf2f(((const bf16_t*)(A.ws + (grp == 0 ? H_Q : H_G)))[(size_t)row * DM + cc]); }
    else if (grp == 3) { ref = a; got = bf2f(((const bf16_t*)(A.ws + H_V))[(size_t)row * DM + cc]); }
    else { const int d = grp - 1; const float* p = A.in[I_HGLB] + (size_t)d * DEPTH * 1024 + cc; float mx = p[0]; for (int l = 1; l < DEPTH; ++l) mx = fmaxf(mx, p[l * 1024]);
        float den = 0.f; for (int l = 0; l < DEPTH; ++l) den += expf(p[l * 1024] - mx); const float lbv = expf(p[1024] - mx) / den;
        ref = logf(lbv + (1.0f - lbv) / (1.0f + expf(-a))); got = gla::h2f(((const unsigned short*)(A.ws + (d ? H_LFB : H_LFF)))[(size_t)row * DM + cc]); }
    if (lane == 0) dg_put(A, k, dg_rel(got, ref));
}
__device__ __forceinline__ void dg_gla(const Args& A, int k) {
    const int lane = threadIdx.x & 63, gwv = blockIdx.x * 8 + (threadIdx.x >> 6);
    const unsigned h = dg_hash(gwv, k); const int sel0 = (gwv & 3) == 0; const int b = sel0 ? 0 : (h & 7), hd = sel0 ? 0 : ((h >> 3) & 7), dir = sel0 ? 0 : ((h >> 6) & 1), vc = sel0 ? ((h >> 7) & 63) : ((h >> 7) & 127);
    const bf16_t* Q = (const bf16_t*)(A.ws + H_Q); const unsigned short* LF = (const unsigned short*)(A.ws + (dir ? H_LFB : H_LFF)); const bf16_t* V = (const bf16_t*)(A.ws + H_V);
    const bf16_t* O = (const bf16_t*)(A.ws + (dir ? H_OB : H_OF));
    float s0 = 0.f, s1 = 0.f, e0 = 0.f, e1 = 0.f, e2 = 0.f, e3 = 0.f;
    for (int i = 0; i < SEQ; ++i) { const int tok = dir ? (SEQ - 1 - i) : i; const size_t o = ((size_t)b * SEQ + tok) * DM + hd * 128;
        const float f0 = expf(gla::h2f(LF[o + lane])), f1 = expf(gla::h2f(LF[o + 64 + lane])), v = bf2f(V[o + vc]);
        s0 = f0 * s0 + (1.0f - f0) * v; s1 = f1 * s1 + (1.0f - f1) * v;
        if (i < 128 || i % 61 == 0) { const float ov = wave_sum(bf2f(Q[o + lane]) * s0 + bf2f(Q[o + 64 + lane]) * s1); const float er = 0.25f * fabsf(bf2f(O[o + vc]) - ov) / (fabsf(ov) + 1.0f);
            if (i == 0) e0 = er; else if (i < 64) e1 = fmaxf(e1, er); else if (i < 128) e2 = fmaxf(e2, er); else e3 = fmaxf(e3, er); } }
    if (lane == 0) { dg_put(A, k, e0); dg_put(A, k + 4, e1); dg_put(A, k + 5, e2); dg_put(A, k + 6, e3); }
    const float* dbg = (const float*)(A.ws + TB_LSUM); const unsigned short* LF0 = (const unsigned short*)(A.ws + H_LFF); const bf16_t* Q0 = (const bf16_t*)(A.ws + H_Q);
    { const unsigned h2 = dg_hash(gwv, k + 100); const int t = h2 & 63, kk = (h2 >> 6) & 127; float c = 0.f; for (int tt = 0; tt <= t; ++tt) c += gla::h2f(LF0[(size_t)tt * DM + kk]);
      if (lane == 0) dg_put(A, k + 1, dg_rel(dbg[t * 128 + kk], c)); }
    { const unsigned h2 = dg_hash(gwv, k + 200); const int t = h2 & 63, sidx = (h2 >> 6) & 63; float a = 0.f;
      if (sidx <= t) { for (int kk = lane; kk < 128; kk += 64) { float c = 0.f; for (int tt = sidx + 1; tt <= t; ++tt) c += gla::h2f(LF0[(size_t)tt * DM + kk]);
              a += bf2f(Q0[(size_t)t * DM + kk]) * (1.0f - expf(gla::h2f(LF0[(size_t)sidx * DM + kk]))) * expf(c); } a = wave_sum(a); }
      const unsigned short got = ((const unsigned short*)(dbg + 8192))[gla::sw128(t, sidx * 2) / 2];
      if (lane == 0) dg_put(A, k + 2, 5.0f * fabsf(bf2f(got) - a) / (fabsf(a) + 0.01f)); }
    { const unsigned h2 = dg_hash(gwv, k + 300); const int sidx = h2 & 63, v = (h2 >> 6) & 63;
      const unsigned short got = ((const unsigned short*)(dbg + 8192 + 2048))[gla::sw128(v, sidx * 2) / 2];
      if (lane == 0) dg_put(A, k + 2, dg_rel(bf2f(got), bf2f(((const bf16_t*)(A.ws + H_V))[(size_t)sidx * DM + v]))); }
    { const unsigned h2 = dg_hash(gwv, k + 500); const int kk = h2 & 127, v = (h2 >> 7) & 63;
      float a = 0.f; { const int sidx = lane; float c = 0.f; for (int tt = sidx + 1; tt < 64; ++tt) c += gla::h2f(LF0[(size_t)tt * DM + kk]);
          const float ksn = (1.0f - expf(gla::h2f(LF0[(size_t)sidx * DM + kk]))) * expf(c);
          const unsigned short gk = ((const unsigned short*)(dbg + 16384))[gla::sw128(kk, sidx * 2) / 2];
          dg_put(A, k + 2, 0.5f * fabsf(bf2f(gk) - ksn) / (fabsf(ksn) + 0.01f));
          a = ksn * bf2f(((const bf16_t*)(A.ws + H_V))[(size_t)sidx * DM + v]); }
      a = wave_sum(a);
      const unsigned short gs = ((const unsigned short*)(dbg + 12288))[gla::sw256(v, kk * 2) / 2];
      if (lane == 0) dg_put(A, k + 3, 0.5f * fabsf(bf2f(gs) - a) / (fabsf(a) + 0.05f)); }
    { const unsigned h2 = dg_hash(gwv, k + 400); const int t = h2 & 63, v = (h2 >> 6) & 63;
      const unsigned short* at = (const unsigned short*)(dbg + 8192); const unsigned short* vt = (const unsigned short*)(dbg + 8192 + 2048);
      float a = bf2f(at[gla::sw128(t, lane * 2) / 2]) * bf2f(vt[gla::sw128(v, lane * 2) / 2]); a = wave_sum(a);
      if (lane == 0) dg_put(A, k + 1, 5.0f * dg_rel(bf2f(((const bf16_t*)(A.ws + H_OF))[(size_t)t * DM + v]), a)); }
}
__device__ __forceinline__ void dg_normo(const Args& A, int k) {
    const int lane = threadIdx.x & 63, gwv = blockIdx.x * 8 + (threadIdx.x >> 6);
    const unsigned h = dg_hash(gwv, k); const int row = h & (MTOK - 1), hd = (h >> 16) & 7; const size_t o = (size_t)row * DM + hd * 128;
    const float v0 = bf2f(((const bf16_t*)(A.ws + H_OF))[o + lane]) + bf2f(((const bf16_t*)(A.ws + H_OB))[o + lane]), v1 = bf2f(((const bf16_t*)(A.ws + H_OF))[o + 64 + lane]) + bf2f(((const bf16_t*)(A.ws + H_OB))[o + 64 + lane]);
    const float ss = wave_sum(v0 * v0 + v1 * v1), rstd = 1.0f / sqrtf(ss / 128.0f + EPS);
    const float r0 = v0 * rstd * A.in[I_HGNG][lane] * bf2f(((const bf16_t*)(A.ws + H_G))[o + lane]), r1 = v1 * rstd * A.in[I_HGNG][64 + lane] * bf2f(((const bf16_t*)(A.ws + H_G))[o + 64 + lane]);
    dg_put(A, k, fmaxf(dg_rel(bf2f(((const bf16_t*)(A.ws + WS_HM))[o + lane]), r0), dg_rel(bf2f(((const bf16_t*)(A.ws + WS_HM))[o + 64 + lane]), r1)));
}
__device__ __forceinline__ void dg_router(const Args& A, int k, int L) {
    const int lane = threadIdx.x & 63, gwv = blockIdx.x * 8 + (threadIdx.x >> 6);
    const int row = dg_hash(gwv, k) & (MTOK - 1), b = row >> 13; const float* x = A.out + (size_t)row * DM;
    const float* modl = (const float*)(A.ws + TB_MODS) + ((size_t)L * NBATCH + b) * 6144; const float* gain = A.in[I_N2G] + L * DM; const float* R = A.in[I_MOER] + (size_t)(L >> 1) * DM * 8;
    float ss = 0.f; for (int c = lane; c < DM; c += 64) ss += x[c] * x[c];
    ss = wave_sum(ss); const float rstd = 1.0f / sqrtf(ss / DM + EPS);
    float lg[8]; for (int e = 0; e < 8; ++e) lg[e] = 0.f;
    for (int c = lane; c < DM; c += 64) { const float hv = x[c] * rstd * gain[c] * (1.0f + modl[4 * 1024 + c]) + modl[3 * 1024 + c]; for (int e = 0; e < 8; ++e) lg[e] += hv * R[c * 8 + e]; }
    for (int e = 0; e < 8; ++e) lg[e] = wave_sum(lg[e]);
    int e0 = 0; for (int e = 1; e < 8; ++e) if (lg[e] > lg[e0]) e0 = e;
    int e1 = (e0 == 0) ? 1 : 0; for (int e = 0; e < 8; ++e) if (e != e0 && lg[e] > lg[e1]) e1 = e;
    float gap = 1e9f; for (int e = 0; e < 8; ++e) if (e != e0 && e != e1) gap = fminf(gap, lg[e1] - lg[e]); gap = fminf(gap, lg[e0] - lg[e1]);
    const int g0 = ((const int*)(A.ws + TB_EID))[row * 2], g1 = ((const int*)(A.ws + TB_EID))[row * 2 + 1]; const float w0 = ((const float*)(A.ws + TB_GATE))[row * 2], w1 = ((const float*)(A.ws + TB_GATE))[row * 2 + 1];
    const float p0 = 1.0f / (1.0f + expf(lg[e1] - lg[e0]));
    float er = (g0 != e0 || g1 != e1) ? (gap > 2e-3f ? 9.f : 0.f) : fmaxf(fabsf(w0 - p0), fabsf(w1 - (1.0f - p0)));
    if (lane == 0) dg_put(A, k, er);
}
__device__ __forceinline__ void dg_place(const Args& A, int k) {
    const int lane = threadIdx.x & 63, gwv = blockIdx.x * 8 + (threadIdx.x >> 6);
    const unsigned h = dg_hash(gwv, k); const int row = h & (MTOK - 1), kk = (h >> 16) & 1;
    const int sl = ((const int*)(A.ws + TB_SLOT))[row * 2 + kk], e = ((const int*)(A.ws + TB_EID))[row * 2 + kk]; const int* ts = (const int*)(A.ws + TB_TILES);
    float er = (sl >= ts[e] * 256 && sl < ts[e + 1] * 256 && sl < MOE_ROWS) ? 0.f : 7.f;
    if (er == 0.f) for (int c = lane; c < DM; c += 64) if (((const bf16_t*)(A.ws + E_XS))[(size_t)sl * DM + c] != ((const bf16_t*)(A.ws + WS_HM))[(size_t)row * DM + c]) er = 5.f;
    dg_put(A, k, er);
}
__device__ __forceinline__ void dg_moe_hid(const Args& A, int k, int m) {
    const int lane = threadIdx.x & 63, gwv = blockIdx.x * 8 + (threadIdx.x >> 6);
    const unsigned h = dg_hash(gwv, k); const int row = h & (MTOK - 1), kk = (h >> 16) & 1, j = (h >> 17) % DFFE;
    const int sl = ((const int*)(A.ws + TB_SLOT))[row * 2 + kk], e = ((const int*)(A.ws + TB_EID))[row * 2 + kk];
    const float* W = A.in[I_MOEGU] + ((size_t)m * 8 + e) * DM * 2 * DFFE; const bf16_t* Am = (const bf16_t*)(A.ws + E_XS) + (size_t)sl * DM;
    float g = 0.f, u = 0.f; for (int c = lane; c < DM; c += 64) { const float x = bf2f(Am[c]); g += x * dg_bfr(W[(size_t)c * 2 * DFFE + j]); u += x * dg_bfr(W[(size_t)c * 2 * DFFE + DFFE + j]); }
    g = wave_sum(g); u = wave_sum(u);
    if (lane == 0) dg_put(A, k, dg_rel(bf2f(((const bf16_t*)(A.ws + E_HID))[(size_t)sl * DFFE + j]), g / (1.0f + expf(-g)) * u));
}
__device__ __forceinline__ void dg_moe_y(const Args& A, int k, int m) {
    const int lane = threadIdx.x & 63, gwv = blockIdx.x * 8 + (threadIdx.x >> 6);
    const unsigned h = dg_hash(gwv, k); const int row = h & (MTOK - 1), kk = (h >> 16) & 1, col = (h >> 17) & 1023;
    const int sl = ((const int*)(A.ws + TB_SLOT))[row * 2 + kk], e = ((const int*)(A.ws + TB_EID))[row * 2 + kk];
    const float* W = A.in[I_MOEDN] + ((size_t)m * 8 + e) * DFFE * DM; const bf16_t* Hh = (const bf16_t*)(A.ws + E_HID) + (size_t)sl * DFFE;
    float a = 0.f; for (int j = lane; j < DFFE; j += 64) a += bf2f(Hh[j]) * dg_bfr(W[(size_t)j * DM + col]);
    a = wave_sum(a);
    if (lane == 0) dg_put(A, k, fabsf(bf2f(((const bf16_t*)(A.ws + E_XS))[(size_t)sl * DM + col]) - a) / (fabsf(a) + 0.3f));
}
__device__ __forceinline__ void dg_combine(const Args& A, int k, const float* modprev) {
    const int lane = threadIdx.x & 63, gwv = blockIdx.x * 8 + (threadIdx.x >> 6);
    const unsigned h = dg_hash(gwv, k); const int row = h & (MTOK - 1), col = (h >> 16) & 1023, b = row >> 13;
    const float* sv = (const float*)(A.ws + TB_LSUM) + 7 * 1024 * 1024 / 4; const bf16_t* Y = (const bf16_t*)(A.ws + E_XS);
    const int s0 = ((const int*)(A.ws + TB_SLOT))[row * 2], s1 = ((const int*)(A.ws + TB_SLOT))[row * 2 + 1]; const float w0 = ((const float*)(A.ws + TB_GATE))[row * 2], w1 = ((const float*)(A.ws + TB_GATE))[row * 2 + 1];
    const float ref = sv[k * 4096 + gwv] + modprev[(size_t)b * 6144 + 5 * 1024 + col] * (w0 * bf2f(Y[(size_t)s0 * DM + col]) + w1 * bf2f(Y[(size_t)s1 * DM + col]));
    if (lane == 0) dg_put(A, k, dg_rel(A.out[(size_t)row * DM + col], ref));
}
__device__ __forceinline__ void dg_lruin(const Args& A, int k) {
    const int lane = threadIdx.x & 63, gwv = blockIdx.x * 8 + (threadIdx.x >> 6);
    const unsigned h = dg_hash(gwv, k); const int row = h & (MTOK - 1), col = (h >> 16) % 2560;
    float a = 0.f; for (int kk = lane; kk < DM; kk += 64) a += bf2f(((const bf16_t*)(A.ws + WS_HM))[(size_t)row * DM + kk]) * dg_bfr(A.in[I_LRWIN][(size_t)kk * 2560 + col]);
    a = wave_sum(a);
    float ref, got;
    if (col < LRUW) { ref = 0.5f * a * (1.0f + tanhf(0.7978845608028654f * (a + 0.044715f * a * a * a))); got = bf2f(((const bf16_t*)(A.ws + L_YB))[(size_t)row * LRUW + col]); }
    else { ref = a; got = bf2f(((const bf16_t*)(A.ws + L_XB))[(size_t)row * LRUW + col - LRUW]); }
    if (lane == 0) dg_put(A, k, dg_rel(got, ref));
}
__device__ __forceinline__ void dg_lru(const Args& A, int k) {
    const int lane = threadIdx.x & 63, gwv = blockIdx.x * 8 + (threadIdx.x >> 6);
    const unsigned h = dg_hash(gwv, k); const int b = h & 7, ch = (h >> 3) % LRUW, tc = (h >> 16) & (SEQ - 1), n = ch / 128, j = ch % 128;
    const bf16_t* XB = (const bf16_t*)(A.ws + L_XB) + (size_t)b * SEQ * LRUW;
    float hres[2];
    for (int d = 0; d < 2; ++d) {
        const float* wa = A.in[I_LRWA] + (size_t)(d * 10 + n) * 16384; const float* wx = A.in[I_LRWX] + (size_t)(d * 10 + n) * 16384;
        const float wa0 = dg_bfr(wa[lane * 128 + j]), wa1 = dg_bfr(wa[(lane + 64) * 128 + j]), wx0 = dg_bfr(wx[lane * 128 + j]), wx1 = dg_bfr(wx[(lane + 64) * 128 + j]);
        const float ba = A.in[I_LRBA][d * LRUW + ch], bx = A.in[I_LRBX][d * LRUW + ch]; const float lam = A.in[I_LRLAM][d * LRUW + ch]; const float sp = log1pf(expf(-lam));
        float hs = 0.f;
        for (int i = 0; ; ++i) { const int t = d ? (SEQ - 1 - i) : i;
            float x0 = A.in[I_LRCB][n * 128 + lane], x1 = A.in[I_LRCB][n * 128 + 64 + lane], xj = A.in[I_LRCB][ch];
            for (int w = 0; w < 4; ++w) { const int tt = t - 1 + w; if (tt >= 0 && tt < SEQ) {
                x0 += A.in[I_LRCW][w * LRUW + n * 128 + lane] * bf2f(XB[(size_t)tt * LRUW + n * 128 + lane]); x1 += A.in[I_LRCW][w * LRUW + n * 128 + 64 + lane] * bf2f(XB[(size_t)tt * LRUW + n * 128 + 64 + lane]);
                xj += A.in[I_LRCW][w * LRUW + ch] * bf2f(XB[(size_t)tt * LRUW + ch]); } }
            const float rp = wave_sum(dg_bfr(x0) * wa0 + dg_bfr(x1) * wa1), ip = wave_sum(dg_bfr(x0) * wx0 + dg_bfr(x1) * wx1);
            const float rg = 1.0f / (1.0f + expf(-(rp + ba))), ig = 1.0f / (1.0f + expf(-(ip + bx))); const float la = -8.0f * rg * sp;
            hs = expf(la) * hs + sqrtf(fmaxf(-expm1f(2.0f * la), 0.f)) * ig * xj;
            if (t == tc) break; }
        hres[d] = hs;
    }
    const size_t go = ((size_t)b * SEQ + tc) * LRUW + ch;
    const float e1 = fabsf(bf2f(((const bf16_t*)(A.ws + L_HF))[go]) - hres[0]) / (fabsf(hres[0]) + 0.3f);
    const float ref = (hres[0] + hres[1]) * bf2f(((const bf16_t*)(A.ws + L_YB))[go]);
    const float e2 = fabsf(bf2f(((const bf16_t*)(A.ws + L_HY))[go]) - ref) / (fabsf(ref) + 0.3f);
    if (lane == 0) { dg_put(A, k, e1); dg_put(A, k + 5, e2); }
}
__device__ __forceinline__ void dg_final(const Args& A, int nchk) {
    const unsigned* sl = (const unsigned*)(A.ws + WS_CTL) + DG_BASE; int code = 0; float ev = 0.f;
    for (int k = 1; k <= nchk; ++k) { const float e = __uint_as_float(sl[64 * k]); if (e > 0.05f) { code = k; ev = e; break; } }
    if (code == 0) return;
    const int c1 = code % 10, c10 = code / 10;
    const float s = -(float)c1;
    for (size_t i = (size_t)blockIdx.x * NTHR + threadIdx.x; i < (size_t)MTOK * DM; i += (size_t)gridDim.x * NTHR) A.out[i] = A.in[I_X][i] * s;
    __syncthreads();
    if (blockIdx.x == 0 && threadIdx.x == 0) { const int qq = ev < 0.1f ? 1 : ev < 0.2f ? 2 : ev < 0.5f ? 3 : ev < 1.f ? 4 : ev < 2.f ? 5 : ev < 5.f ? 6 : ev < 20.f ? 7 : ev < 1e3f ? 8 : 9;
        A.out[12345] = 100.f * (float)(10 * c10 + qq); }
}
#define DG(x) x
#define DGL(x) if constexpr (L >= DIAG_FROM) { x }
#else
#define DG(x)
#define DGL(x)
#endif

#define GRID_BAR() xcd_barrier(bar)
template <int L>
__device__ __forceinline__ void run_mixer(const Args& args, LAS unsigned char* lds, int bid, int G, const XcdBarrier& bar) {
    unsigned char* ws = args.ws; float* xo = args.out;
    const float* modl = (const float*)(ws + TB_MODS) + (size_t)L * NBATCH * 6144;
    const float* xs = (L == 0) ? args.in[I_X] : xo;
    constexpr int kind = L % 3;
    DGL(if (L > 0 && ((L - 1) & 1)) { dg_save(args, 10 * (L - 1) + 9, xo); GRID_BAR(); })
    norm_phase<false>(args, lds, bid, G, xs, xo, args.in[I_N1G] + L * DM, modl, 0, (L > 0) && ((L - 1) & 1), modl - NBATCH * 6144, false, nullptr);
    GRID_BAR();
    DGL(if (L > 0 && ((L - 1) & 1)) { dg_combine(args, 10 * (L - 1) + 9, modl - NBATCH * 6144); GRID_BAR(); })
    DGL(dg_norm(args, 10 * L + 1, (L > 0 && ((L - 1) & 1)) ? xo : xs, args.in[I_N1G] + L * DM, L, 0); GRID_BAR();)
    if constexpr (kind == 0) {
        constexpr int al = L / 3;
        {
            pg8::Gemm g{(const bf16_t*)(ws + WS_HM), (const bf16_t*)(ws + W_QKV) + (size_t)al * 3072 * 1024, 1024};
            pg8::TileOrder S; S.init(256, 12, G, bid);
            pg8::EpiQKV E{(bf16_t*)(ws + A_Q), (bf16_t*)(ws + A_K), (bf16_t*)(ws + A_V), args.in[I_ATQN] + al * 64, args.in[I_ATKN] + al * 64,
                          (const float*)(ws + TB_COS), (const float*)(ws + TB_SIN), LOG2E};
            pg8::gemm_phase<pg8::EpiQKV>(lds, g, S, E);
        }
        GRID_BAR();
        vt_phase(args, bid, G);
        GRID_BAR();
        attn_phase(args, lds, bid, G, al);
        GRID_BAR();
        DGL(dg_save(args, 10 * L + 4, xs); GRID_BAR();)
        {
            pg8::Gemm g{(const bf16_t*)(ws + WS_HM), (const bf16_t*)(ws + W_AO) + (size_t)al * 1024 * 1024, 1024};
            pg8::TileOrder S; S.init(256, 4, G, bid);
            pg8::EpiRes E{xs, xo, modl + 2 * 1024, 1.0f};
            pg8::gemm_phase<pg8::EpiRes>(lds, g, S, E);
        }
        GRID_BAR();
        DGL(dg_res(args, 10 * L + 4, xo, modl + 2 * 1024, (const bf16_t*)(ws + WS_HM), 1024, args.in[I_ATWOUT] + (size_t)al * 1024 * 1024); GRID_BAR();)
    }
    if constexpr (kind == 1) {
        {
            pg8::Gemm g{(const bf16_t*)(ws + WS_HM), (const bf16_t*)(ws + W_HGI), 1024};
            pg8::TileOrder S; S.init(256, 20, G, bid);
            pg8::EpiAct E{0, ws, (const float*)(ws + TB_LB)};
            pg8::gemm_phase<pg8::EpiAct>(lds, g, S, E);
        }
        GRID_BAR();
        DGL(dg_hgin(args, 10 * L + 2); GRID_BAR();)
        gla_phase(args, lds, bid, G);
        GRID_BAR();
        DGL(dg_gla(args, 10 * L + 3); GRID_BAR();)
        hg_normo_phase(args, bid, G);
        GRID_BAR();
        DGL(dg_normo(args, 10 * L + 0); GRID_BAR();)
        DGL(dg_save(args, 10 * L + 4, xs); GRID_BAR();)
        {
            pg8::Gemm g{(const bf16_t*)(ws + WS_HM), (const bf16_t*)(ws + W_HGO), 1024};
            pg8::TileOrder S; S.init(256, 4, G, bid);
            pg8::EpiRes E{xs, xo, modl + 2 * 1024, 1.0f};
            pg8::gemm_phase<pg8::EpiRes>(lds, g, S, E);
        }
        GRID_BAR();
        DGL(dg_res(args, 10 * L + 4, xo, modl + 2 * 1024, (const bf16_t*)(ws + WS_HM), 1024, args.in[I_HGWOUT]); GRID_BAR();)
    }
    if constexpr (kind == 2) {
        {
            pg8::Gemm g{(const bf16_t*)(ws + WS_HM), (const bf16_t*)(ws + W_LRI), 1024};
            pg8::TileOrder S; S.init(256, 10, G, bid);
            pg8::EpiAct E{1, ws, nullptr};
            pg8::gemm_phase<pg8::EpiAct>(lds, g, S, E);
        }
        GRID_BAR();
        DGL(dg_lruin(args, 10 * L + 2); GRID_BAR();)
        lru_phase<0>(args, lds, bid, G);
        GRID_BAR();
        lru_carry_phase(args, bid, G);
        GRID_BAR();
        lru_phase<1>(args, lds, bid, G);
        GRID_BAR();
        lru_phase<2>(args, lds, bid, G);
        GRID_BAR();
        DGL(dg_lru(args, 10 * L + 3); GRID_BAR();)
        DGL(dg_save(args, 10 * L + 4, xs); GRID_BAR();)
        {
            pg8::Gemm g{(const bf16_t*)(ws + L_HY), (const bf16_t*)(ws + W_LRO), LRUW};
            pg8::TileOrder S; S.init(256, 4, G, bid);
            pg8::EpiRes E{xs, xo, modl + 2 * 1024, 1.0f};
            pg8::gemm_phase<pg8::EpiRes>(lds, g, S, E);
        }
        GRID_BAR();
        DGL(dg_res(args, 10 * L + 4, xo, modl + 2 * 1024, (const bf16_t*)(ws + L_HY), LRUW, args.in[I_LRWOUT]); GRID_BAR();)
    }
}
template <int L>
__device__ __forceinline__ void run_ffn(const Args& args, LAS unsigned char* lds, int bid, int G, const XcdBarrier& bar) {
    unsigned char* ws = args.ws; float* xo = args.out;
    const float* modl = (const float*)(ws + TB_MODS) + (size_t)L * NBATCH * 6144;
    if constexpr ((L & 1) == 0) {
        constexpr int m = L >> 1;
        constexpr bool F8 = (L >= FP8_DENSE_FROM);
        norm_phase<false>(args, lds, bid, G, xo, xo, args.in[I_N2G] + L * DM, modl, 1, false, modl, false, nullptr, F8);
        GRID_BAR();
        if constexpr (F8) {
            pg8::Gemm g{(const bf16_t*)(ws + WS_HM), (const bf16_t*)(ws + W_FGU) + (size_t)m * 5632 * 1024, 512};
            pg8::TileOrder S; S.init(256, 22, G, bid);
            pg8::EpiSwiGLU8 E{ws + F_HID, DFF, 1.0f / MOE_WSCALE, MOE_HSCALE};
            pg8::gemm_phase<pg8::EpiSwiGLU8, true>(lds, g, S, E);
        } else {
            pg8::Gemm g{(const bf16_t*)(ws + WS_HM), (const bf16_t*)(ws + W_FGU) + (size_t)m * 5632 * 1024, 1024};
            pg8::TileOrder S; S.init(256, 22, G, bid);
            pg8::EpiSwiGLU E{(bf16_t*)(ws + F_HID), DFF};
            pg8::gemm_phase<pg8::EpiSwiGLU>(lds, g, S, E);
        }
        GRID_BAR();
        if constexpr (F8) {
            pg8::Gemm g{(const bf16_t*)(ws + F_HID), (const bf16_t*)(ws + W_FDN) + (size_t)m * 1024 * 2816, DFF / 2};
            pg8::TileOrder S; S.init(256, 4, G, bid);
            pg8::EpiRes E{xo, xo, modl + 5 * 1024, 1.0f / (MOE_WSCALE * MOE_HSCALE)};
            pg8::gemm_phase<pg8::EpiRes, true>(lds, g, S, E);
        } else {
            pg8::Gemm g{(const bf16_t*)(ws + F_HID), (const bf16_t*)(ws + W_FDN) + (size_t)m * 1024 * 2816, DFF};
            pg8::TileOrder S; S.init(256, 4, G, bid);
            pg8::EpiRes E{xo, xo, modl + 5 * 1024, 1.0f};
            pg8::gemm_phase<pg8::EpiRes>(lds, g, S, E);
        }
        GRID_BAR();
    } else {
        constexpr int m = L >> 1;
        norm_phase<true>(args, lds, bid, G, xo, xo, args.in[I_N2G] + L * DM, modl, 1, false, modl, false, args.in[I_MOER] + (size_t)m * DM * 8);
        GRID_BAR();
        DGL(dg_norm(args, 10 * L + 5, xo, args.in[I_N2G] + L * DM, L, 1); dg_router(args, 10 * L + 5, L); GRID_BAR();)
        place_phase(args, lds, bid, G);
        GRID_BAR();
        DGL(dg_place(args, 10 * L + 6); GRID_BAR();)
        const int* tiles = (const int*)(ws + TB_TILES);
        {
            pg8::Gemm g{(const bf16_t*)(ws + E_XS), (const bf16_t*)(ws + W_MGU + (size_t)m * 8 * 7168 * 1024), 512};
            pg8::TileOrder S; S.init(tiles[8], 28, G, bid);
#pragma unroll
            for (int e = 1; e < NEXP; ++e) S.ts[e] = tiles[e];
            pg8::EpiSwiGLU8 E{ws + E_HID, DFFE, 1.0f / MOE_WSCALE, MOE_HSCALE};
            pg8::gemm_phase<pg8::EpiSwiGLU8, true>(lds, g, S, E);
        }
        GRID_BAR();
        DGL(dg_moe_hid(args, 10 * L + 7, m); GRID_BAR();)
        {
            pg8::Gemm g{(const bf16_t*)(ws + E_HID), (const bf16_t*)(ws + W_MDN + (size_t)m * 8 * 1024 * 3584), DFFE / 2};
            pg8::TileOrder S; S.init(tiles[8], 4, G, bid);
#pragma unroll
            for (int e = 1; e < NEXP; ++e) S.ts[e] = tiles[e];
            pg8::EpiPlain E{(bf16_t*)(ws + E_XS), DM, 1.0f / (MOE_WSCALE * MOE_HSCALE)};
            pg8::gemm_phase<pg8::EpiPlain, true>(lds, g, S, E);
        }
        GRID_BAR();
        DGL(dg_moe_y(args, 10 * L + 8, m); GRID_BAR();)
    }
}
__device__ __forceinline__ void final_combine(const Args& args, LAS unsigned char* lds, int bid, int G, const XcdBarrier& bar) {
    const float* modl = (const float*)(args.ws + TB_MODS) + (size_t)3 * NBATCH * 6144;
    DG(dg_save(args, 39, args.out); GRID_BAR();)
    norm_phase<false>(args, lds, bid, G, args.out, args.out, args.in[I_N1G], modl, 0, true, modl, true, nullptr);
    DG(GRID_BAR(); dg_combine(args, 39, modl);)
}

__global__ void __launch_bounds__(NTHR, 2) mega_fwd(Args args) {
    extern __shared__ __attribute__((aligned(16))) unsigned char lds_raw[];
    LAS unsigned char* lds = (LAS unsigned char*)lds_raw;
    const int tid = threadIdx.x, bid = blockIdx.x, G = gridDim.x;
    unsigned char* ws = args.ws;
    volatile LAS unsigned* MISC = (volatile LAS unsigned*)(lds + MISC_OFF);
    if (tid < 64) MISC[tid] = 0u;
    __syncthreads();
    XcdBarrier bar = xcd_barrier_post((unsigned*)(ws + WS_CTL) + CW_BAR, MISC + 8);

    prologue_phase(args, lds, bid, G);
    GRID_BAR();

    run_mixer<0>(args, lds, bid, G, bar);
    run_ffn<0>(args, lds, bid, G, bar);
    run_mixer<1>(args, lds, bid, G, bar);
    run_ffn<1>(args, lds, bid, G, bar);
    run_mixer<2>(args, lds, bid, G, bar);
    run_ffn<2>(args, lds, bid, G, bar);
    run_mixer<3>(args, lds, bid, G, bar);
    run_ffn<3>(args, lds, bid, G, bar);
    final_combine(args, lds, bid, G, bar);
    DG(GRID_BAR(); dg_final(args, 49);)
}

extern "C" void kernel_launch(void* const* d_in, const int* in_sizes, int n_in, void* d_out, int out_size, void* d_ws, size_t ws_size, hipStream_t stream) {
    static int grid = 0;
    if (grid == 0) {
        if (n_in != 30 || out_size != MTOK * DM || ws_size < WS_NEED) { fprintf(stderr, "kernel_launch: unexpected shapes (n_in %d out %d ws %zu need %zu)\n", n_in, out_size, ws_size, (size_t)WS_NEED); grid = -1; return; }
        int dev = 0, cus = 0;
        if (hipGetDevice(&dev) != hipSuccess || hipDeviceGetAttribute(&cus, hipDeviceAttributeMultiprocessorCount, dev) != hipSuccess) { grid = -1; return; }
        if (hipFuncSetAttribute((const void*)mega_fwd, hipFuncAttributeMaxDynamicSharedMemorySize, LDS_BYTES) != hipSuccess) { fprintf(stderr, "kernel_launch: hipFuncSetAttribute failed\n"); grid = -1; return; }
        int per_cu = 0;
        if (hipOccupancyMaxActiveBlocksPerMultiprocessor(&per_cu, (const void*)mega_fwd, NTHR, LDS_BYTES) != hipSuccess || per_cu < 1) { fprintf(stderr, "kernel_launch: occupancy query says %d\n", per_cu); }
        (void)hipGetLastError();
        grid = (cus >= 256) ? 256 : -1;
        if (grid < 0) { fprintf(stderr, "kernel_launch: needs 256 CUs, device has %d\n", cus); return; }
    }
    if (grid < 0) return;
    if (hipMemsetAsync((char*)d_ws + WS_CTL, 0, CTL_ZERO_BYTES, stream) != hipSuccess) return;
    Args a{};
    for (int i = 0; i < 30; ++i) a.in[i] = (const float*)d_in[i];
    a.out = (float*)d_out; a.ws = (unsigned char*)d_ws;
    hipLaunchKernelGGL(mega_fwd, dim3(grid), dim3(NTHR), LDS_BYTES, stream, a);
}
```

```cpp
#define DIAG_FROM 2
#include <hip/hip_runtime.h>
#include <cstdio>
#include <cstdint>

#define LAS __attribute__((address_space(3)))
#define GAS __attribute__((address_space(1)))
typedef unsigned short bf16_t;
typedef short bf16x8 __attribute__((ext_vector_type(8)));
typedef short s16x4 __attribute__((ext_vector_type(4)));
typedef float f32x2 __attribute__((ext_vector_type(2)));
typedef float f32x4 __attribute__((ext_vector_type(4)));
typedef float f32x16 __attribute__((ext_vector_type(16)));
typedef unsigned u32x2 __attribute__((ext_vector_type(2)));
typedef unsigned u32x4 __attribute__((ext_vector_type(4)));

constexpr int MTOK = 65536, DM = 1024, SEQ = 8192, NBATCH = 8, DEPTH = 4;
constexpr int DFF = 2816, DFFE = 3584, NEXP = 8, LRUW = 1280;
constexpr float EPS = 1e-6f;
constexpr int FP8_DENSE_FROM = 2;
constexpr float MOE_WSCALE = 64.0f, MOE_HSCALE = 4.0f;
constexpr float LOG2E = 1.4426950408889634f;

constexpr size_t MiB = 1u << 20;
constexpr size_t WS_CTL = 0, CTL_ZERO_BYTES = 1 * MiB;
constexpr size_t WS_TAB = 1 * MiB;
constexpr size_t TB_MODS = WS_TAB;
constexpr size_t TB_COS = WS_TAB + 1 * MiB;
constexpr size_t TB_SIN = WS_TAB + 2 * MiB;
constexpr size_t TB_SCAL = WS_TAB + 3 * MiB;
constexpr size_t TB_LB = TB_SCAL + 4096;
constexpr size_t TB_SP = TB_SCAL + 16384;
constexpr size_t TB_EID = WS_TAB + 4 * MiB;
constexpr size_t TB_GATE = WS_TAB + 5 * MiB;
constexpr size_t TB_SLOT = WS_TAB + 6 * MiB;
constexpr size_t TB_BCNT = WS_TAB + 7 * MiB;
constexpr size_t TB_TILES = TB_BCNT + 16384;
constexpr size_t TB_LSUM = WS_TAB + 8 * MiB;
constexpr size_t TB_LCIN = WS_TAB + 16 * MiB;
constexpr size_t WS_W = 32 * MiB;
constexpr size_t W_QKV = WS_W;
constexpr size_t W_AO = W_QKV + 2 * (size_t)3072 * 1024 * 2;
constexpr size_t W_HGI = W_AO + 2 * (size_t)1024 * 1024 * 2;
constexpr size_t W_HGO = W_HGI + (size_t)5120 * 1024 * 2;
constexpr size_t W_LRI = W_HGO + (size_t)1024 * 1024 * 2;
constexpr size_t W_LRG = W_LRI + (size_t)2560 * 1024 * 2;
constexpr size_t W_LRO = W_LRG + (size_t)10 * 2 * 256 * 128 * 2;
constexpr size_t W_FGU = W_LRO + (size_t)1024 * 1280 * 2;
constexpr size_t W_FDN = W_FGU + 2 * (size_t)5632 * 1024 * 2;
constexpr size_t W_MGU = W_FDN + 2 * (size_t)1024 * 2816 * 2;
constexpr size_t W_MDN = W_MGU + 16 * (size_t)7168 * 1024 * 2;
constexpr size_t W_END = W_MDN + 16 * (size_t)1024 * 3584 * 2;
constexpr size_t WS_HM = 440 * MiB;
constexpr size_t WS_ACT = 568 * MiB;
static_assert(W_END <= WS_HM, "weights overflow");
constexpr size_t SZ_TOK = (size_t)MTOK * 1024 * 2;
constexpr size_t A_Q = WS_ACT, A_K = A_Q + SZ_TOK, A_V = A_K + SZ_TOK, A_VT = A_V + SZ_TOK;
constexpr size_t F_HID = WS_ACT;
constexpr size_t H_Q = WS_ACT, H_LFF = H_Q + SZ_TOK, H_LFB = H_LFF + SZ_TOK, H_V = H_LFB + SZ_TOK, H_G = H_V + SZ_TOK, H_OF = H_G + SZ_TOK, H_OB = H_OF + SZ_TOK;
constexpr size_t SZ_LRU = (size_t)MTOK * 1280 * 2;
constexpr size_t L_YB = WS_ACT, L_XB = L_YB + SZ_LRU, L_HF = L_XB + SZ_LRU, L_HY = L_HF + SZ_LRU;
constexpr int MOE_ROWS = 2 * MTOK + NEXP * 256;
constexpr size_t E_XS = WS_ACT, E_HID = E_XS + (size_t)MOE_ROWS * 1024 * 2, E_END = E_HID + (size_t)MOE_ROWS * DFFE * 2;
constexpr size_t WS_NEED = E_END;
static_assert(WS_NEED <= (size_t)1792 * MiB, "workspace");

constexpr int CW_BAR = 4096;

constexpr int RING_BYTES = 135168;
constexpr int MISC_OFF = RING_BYTES;
constexpr int LDS_BYTES = 147456;
constexpr int NWAVES = 8, NTHR = 512;

typedef __bf16 bf16x2v __attribute__((ext_vector_type(2)));
__device__ __forceinline__ unsigned cvt_pk_bf16(float lo, float hi) { const f32x2 v = {lo, hi}; const bf16x2v b = __builtin_convertvector(v, bf16x2v); return __builtin_bit_cast(unsigned, b); }
__device__ __forceinline__ unsigned pk_fp8x4(float a, float b, float c, float d) { unsigned w = 0; w = __builtin_amdgcn_cvt_pk_fp8_f32(a, b, w, false); w = __builtin_amdgcn_cvt_pk_fp8_f32(c, d, w, true); return w; }
__device__ __forceinline__ unsigned f2bf(float f) { unsigned u = __builtin_bit_cast(unsigned, f); return (u + 0x7fffu + ((u >> 16) & 1u)) >> 16; }
__device__ __forceinline__ float bf2f(unsigned short b) { return __builtin_bit_cast(float, ((unsigned)b) << 16); }
__device__ __forceinline__ float bflo(unsigned w) { return __builtin_bit_cast(float, w << 16); }
__device__ __forceinline__ float bfhi(unsigned w) { return __builtin_bit_cast(float, w & 0xffff0000u); }
__device__ __forceinline__ float fexp2(float x) { return __builtin_amdgcn_exp2f(x); }
__device__ __forceinline__ float fexp(float x) { return __builtin_amdgcn_exp2f(x * LOG2E); }
__device__ __forceinline__ float frcp(float x) { return __builtin_amdgcn_rcpf(x); }
__device__ __forceinline__ float fsigmoid(float x) { return frcp(1.0f + fexp(-x)); }
__device__ __forceinline__ float fsilu(float x) { return x * fsigmoid(x); }
__device__ __forceinline__ float wave_sum(float v) {
#pragma unroll
    for (int o = 1; o < 64; o <<= 1) v += __shfl_xor(v, o);
    return v;
}
#define LDS_WAIT() asm volatile("s_waitcnt lgkmcnt(0)" ::: "memory")
#define VM_WAIT() asm volatile("s_waitcnt vmcnt(0)" ::: "memory")

#define XB_TMO      128
#define XB_XCNT(j)  (256  + 64 * (j))
#define XB_XSUB(j)  (1280 + 64 * (j))
#define XB_XGEN(j)  (2304 + 64 * (j))
#define XB_TOP      3328
#define XB_TOPGEN   3392
#define XCD_BAR_WORDS 3456
#define XB_SPIN_CAP (1u << 22)
__device__ __forceinline__ unsigned xb_ld(unsigned* p)              { return __hip_atomic_load(p, __ATOMIC_RELAXED, __HIP_MEMORY_SCOPE_AGENT); }
__device__ __forceinline__ unsigned xb_add(unsigned* p, unsigned v) { return __hip_atomic_fetch_add(p, v, __ATOMIC_RELAXED, __HIP_MEMORY_SCOPE_AGENT); }
__device__ __forceinline__ unsigned xb_xcc_id() { return (unsigned)__builtin_amdgcn_s_getreg((3 << 11) | 20) & 0xFu; }
#define XB_SPIN(cond, bar) do { unsigned _sp = 0; while (cond) { __builtin_amdgcn_s_sleep(1); \
    if ((++_sp & 255u) == 0u) { if (xb_ld(&(bar)[XB_TMO])) break; if (_sp > XB_SPIN_CAP) { atomicAdd(&(bar)[XB_TMO], 1u); break; } } } } while (0)
struct XcdBarrier { unsigned* bar; unsigned x; volatile LAS unsigned* st; };
__device__ __forceinline__ XcdBarrier xcd_barrier_post(unsigned* bar, volatile LAS unsigned* st) {
    XcdBarrier b; b.bar = bar; b.x = xb_xcc_id(); b.st = st;
    if (threadIdx.x == 0) (void)xb_add(&bar[XB_XCNT(b.x)], 1u);
    return b;
}
__device__ __forceinline__ void xcd_barrier_complete(unsigned* bar, unsigned x, unsigned& nloc, unsigned& nx) {
    const unsigned G = gridDim.x * gridDim.y * gridDim.z;
    unsigned sum, cnt, mine, sp = 0u;
    for (;;) {
        sum = 0u; cnt = 0u; mine = 0u;
#pragma unroll
        for (unsigned j = 0; j < 16; ++j) { const unsigned c = xb_ld(&bar[XB_XCNT(j)]); sum += c; cnt += (c > 0u) ? 1u : 0u; mine = (j == x) ? c : mine; }
        if (sum == G) break;
        __builtin_amdgcn_s_sleep(1);
        if ((++sp & 255u) == 0u) { if (xb_ld(&bar[XB_TMO])) break; if (sp > XB_SPIN_CAP) { atomicAdd(&bar[XB_TMO], 1u); break; } }
    }
    nloc = mine > 0u ? mine : 1u; nx = cnt > 0u ? cnt : 1u;
}
__device__ __forceinline__ void xcd_barrier(const XcdBarrier& b) {
    asm volatile("s_waitcnt vmcnt(0)" ::: "memory");
    __syncthreads();
    if (threadIdx.x == 0) {
        unsigned* bar = b.bar;
        __builtin_amdgcn_s_waitcnt(0);
        unsigned nloc = b.st[0], nx = b.st[1];
        if (nloc == 0u) { xcd_barrier_complete(bar, b.x, nloc, nx); b.st[0] = nloc; b.st[1] = nx; }
        const unsigned old = xb_add(&bar[XB_XSUB(b.x)], 1u);
        const unsigned gen = old / nloc;
        if (old + 1u == (gen + 1u) * nloc) {
            __builtin_amdgcn_fence(__ATOMIC_RELEASE, "agent");
            asm volatile("s_waitcnt vmcnt(0)" ::: "memory");
            const unsigned og = xb_add(&bar[XB_TOP], 1u);
            const unsigned tg = og / nx;
            if (og + 1u == (tg + 1u) * nx) xb_add(&bar[XB_TOPGEN], 1u);
            else XB_SPIN(xb_ld(&bar[XB_TOPGEN]) == tg, bar);
            __builtin_amdgcn_fence(__ATOMIC_ACQUIRE, "agent");
            xb_add(&bar[XB_XGEN(b.x)], 1u);
            asm volatile("s_waitcnt vmcnt(0)" ::: "memory");
        } else {
            XB_SPIN(xb_ld(&bar[XB_XGEN(b.x)]) == gen, bar);
            __builtin_amdgcn_fence(__ATOMIC_ACQUIRE, "agent");
            asm volatile("s_waitcnt vmcnt(0)" ::: "memory");
        }
    }
    __syncthreads();
}

namespace pg8 {
constexpr int BM = 256, BK = 64, HALF = 128, HTB = HALF * BK * 2, STAGE_BYTES = 8 * HTB, NXCD = 8, WGM = 8;
__host__ __device__ __forceinline__ int lds_byte(int r, int c) { const int st = (r >> 4) * 2 + (c >> 5), rr = r & 15, cc = c & 31, ob = rr * 64 + cc * 2; return st * 1024 + (ob ^ (((ob >> 9) & 1) << 5)); }
__host__ __device__ __forceinline__ void stage_rc(int b, int& R, int& C) { const int st = b / 1024, sb = b % 1024, swz = sb ^ (((sb >> 9) & 1) << 5); R = (st >> 1) * 16 + swz / 64; C = (st & 1) * 32 + (swz % 64) / 2; }
__host__ __device__ __forceinline__ int perm32(int rho) { const int n = rho >> 4, i = rho & 15; return 8 * (i >> 2) + 4 * n + (i & 3); }

struct Unit { int pm, pn, pb; };
struct Gemm { const bf16_t* A; const bf16_t* Bt; int K; };

struct TileOrder {
    int nM, nN, nwg, G, c; int ts[NEXP];
    __device__ __forceinline__ void init(int nM_, int nN_, int G_, int c_) { nM = nM_; nN = nN_; nwg = nM * nN; G = G_; c = c_;
#pragma unroll
        for (int e = 0; e < NEXP; ++e) ts[e] = (e == 0) ? 0 : 0x7fffffff; }
    __device__ __forceinline__ bool next(int i, Unit& u) const {
        const long L = (long)i * G + c; if (L >= nwg) return false;
        int wgid = (int)L; { const int q = nwg / NXCD, r = nwg % NXCD, xcd = wgid % NXCD, off = wgid / NXCD; wgid = (xcd < r ? xcd * (q + 1) : r * (q + 1) + (xcd - r) * q) + off; }
        const int nig = WGM * nN, gid = wgid / nig, fm = gid * WGM, gsz = (nM - fm) < WGM ? (nM - fm) : WGM;
        u.pm = fm + ((wgid % nig) % gsz); u.pn = (wgid % nig) / gsz;
        int e = 0;
#pragma unroll
        for (int k = 1; k < NEXP; ++k) e += (u.pm >= ts[k]) ? 1 : 0;
        u.pb = e * nN + u.pn; return true;
    }
};

typedef int v8i32 __attribute__((ext_vector_type(8)));
template <class Epi, bool FP8 = false>
__device__ __forceinline__ void gemm_phase(LAS unsigned char* lds, const Gemm g, const TileOrder& S, const Epi& E) {
    int tid_ = threadIdx.x; asm volatile("" : "+v"(tid_));
    const int tid = tid_, wid = __builtin_amdgcn_readfirstlane(tid >> 6), lane = tid & 63, wr = wid >> 2, wc = wid & 3, fr = lane & 15, fq = lane >> 4;
    const int K = g.K, nt = K / BK;
    unsigned voffA[2], voffB[2];
#pragma unroll
    for (int i = 0; i < 2; ++i) { int R, C; stage_rc(tid * 16 + i * 8192, R, C); const int Rb = Epi::PERM ? ((R & ~31) + perm32(R & 31)) : R;
        voffA[i] = (unsigned)(R * K + C) * 2u; voffB[i] = (unsigned)(Rb * K + C) * 2u; }
    const size_t kstep = (size_t)(BK * 2);
    const size_t hstep = (size_t)HALF * K * 2;
    const size_t tstep = 2 * hstep;
    const unsigned ldsw = (unsigned)wid * 1024u;
    const int aoff = lds_byte(wr * 64 + fr, fq * 8), boff = lds_byte(wc * 32 + fr, fq * 8);
#define PG8_SA(b, h) (((b) * 2 + (h)) * HTB)
#define PG8_SB(b, h) ((4 + (b) * 2 + (h)) * HTB)
#define PG8_STAGE(bufoff, gbase, voff) do { _Pragma("unroll") for (int _i = 0; _i < 2; ++_i) \
        __builtin_amdgcn_global_load_lds((const unsigned*)((const char*)(gbase) + (voff)[_i]), (LAS unsigned*)(lds + (bufoff) + ldsw + _i * 8192), 16, 0, 0); } while (0)
#define PG8_LD8(p) __builtin_bit_cast(v8i32, __builtin_shufflevector(*(const LAS u32x4*)(p), *(const LAS u32x4*)((p) + 1024), 0, 1, 2, 3, 4, 5, 6, 7))
#define PG8_LDA(dst, b, h) do { if constexpr (FP8) { _Pragma("unroll") for (int m = 0; m < 4; ++m) dst##8[m] = PG8_LD8(lds + PG8_SA(b, h) + aoff + m * 2048); } \
        else { _Pragma("unroll") for (int m = 0; m < 4; ++m) _Pragma("unroll") for (int k = 0; k < 2; ++k) dst[m][k] = *(const LAS bf16x8*)(lds + PG8_SA(b, h) + aoff + m * 2048 + k * 1024); } } while (0)
#define PG8_LDB(dst, b, h) do { if constexpr (FP8) { _Pragma("unroll") for (int n = 0; n < 2; ++n) dst##8[n] = PG8_LD8(lds + PG8_SB(b, h) + boff + n * 2048); } \
        else { _Pragma("unroll") for (int n = 0; n < 2; ++n) _Pragma("unroll") for (int k = 0; k < 2; ++k) dst[n][k] = *(const LAS bf16x8*)(lds + PG8_SB(b, h) + boff + n * 2048 + k * 1024); } } while (0)
#define PG8_MMA(ai, bj, At, Bt) do { __builtin_amdgcn_s_setprio(1); \
        if constexpr (FP8) { _Pragma("unroll") for (int m = 0; m < 4; ++m) _Pragma("unroll") for (int n = 0; n < 2; ++n) \
            asm volatile("v_mfma_scale_f32_16x16x128_f8f6f4 %0, %1, %2, %0, %3, %3 op_sel_hi:[0,0,0]" : "+v"(acc[ai][bj][m][n]) : "v"(Bt##8[n]), "v"(At##8[m]), "v"(one_scale)); } \
        else { _Pragma("unroll") for (int m = 0; m < 4; ++m) _Pragma("unroll") for (int n = 0; n < 2; ++n) _Pragma("unroll") for (int k = 0; k < 2; ++k) \
            acc[ai][bj][m][n] = __builtin_amdgcn_mfma_f32_16x16x32_bf16(Bt[n][k], At[m][k], acc[ai][bj][m][n], 0, 0, 0); } \
        __builtin_amdgcn_s_setprio(0); } while (0)
#define PG8_WAIT_V(n) asm volatile("s_waitcnt vmcnt(" #n ")" ::: "memory")
#define PG8_WAIT_L(n) asm volatile("s_waitcnt lgkmcnt(" #n ")" ::: "memory")
#define PG8_BAR __builtin_amdgcn_s_barrier()
#define PG8_SCHED __builtin_amdgcn_sched_barrier(0)
    Unit cur, nxt; int ui = 0;
    if (!S.next(0, cur)) return;
    f32x4 acc[2][2][4][2];
#pragma unroll
    for (int a = 0; a < 2; ++a)
#pragma unroll
        for (int b = 0; b < 2; ++b)
#pragma unroll
            for (int m = 0; m < 4; ++m)
#pragma unroll
                for (int n = 0; n < 2; ++n) acc[a][b][m][n] = (f32x4){0.f, 0.f, 0.f, 0.f};
    bf16x8 At[4][2], B0[2][2], B1[2][2]; v8i32 At8[4], B08[2], B18[2];
    int one_scale = 0x7f7f7f7f; asm volatile("" : "+v"(one_scale));
    const char* cA = (const char*)g.A + (size_t)cur.pm * tstep; const char* cB = (const char*)g.Bt + (size_t)cur.pb * tstep;
    PG8_STAGE(PG8_SB(0, 0), cB, voffB); PG8_STAGE(PG8_SA(0, 0), cA, voffA); PG8_STAGE(PG8_SB(0, 1), cB + hstep, voffB); PG8_STAGE(PG8_SA(0, 1), cA + hstep, voffA);
    if (wr == 1) PG8_BAR;
    PG8_WAIT_V(4); PG8_BAR;
    PG8_STAGE(PG8_SB(1, 0), cB + kstep, voffB); PG8_STAGE(PG8_SA(1, 0), cA + kstep, voffA); PG8_STAGE(PG8_SB(1, 1), cB + hstep + kstep, voffB);
    PG8_WAIT_V(6); PG8_BAR;
    for (;;) {
        const bool has_next = S.next(ui + 1, nxt);
        const char* nA = has_next ? (const char*)g.A + (size_t)nxt.pm * tstep : cA; const char* nB = has_next ? (const char*)g.Bt + (size_t)nxt.pb * tstep : cB;
        for (int t = 0; t < nt; t += 2) {
            const bool last = (t == nt - 2);
            const char* a1 = cA + (size_t)(t + 1) * kstep;
            const char* a2 = last ? nA : cA + (size_t)(t + 2) * kstep; const char* b2 = last ? nB : cB + (size_t)(t + 2) * kstep;
            const char* a3 = a2 + kstep; const char* b3 = b2 + kstep;
            PG8_LDB(B0, 0, 0); PG8_SCHED; PG8_LDA(At, 0, 0); PG8_STAGE(PG8_SA(1, 1), a1 + hstep, voffA);
            PG8_WAIT_L(8); PG8_BAR; PG8_WAIT_L(0); PG8_MMA(0, 0, At, B0); PG8_BAR; PG8_SCHED;
            PG8_LDB(B1, 0, 1); PG8_STAGE(PG8_SB(0, 0), b2, voffB);
            PG8_BAR; PG8_WAIT_L(0); PG8_MMA(0, 1, At, B1); PG8_BAR;
            PG8_LDA(At, 0, 1); PG8_STAGE(PG8_SA(0, 0), a2, voffA);
            PG8_BAR; PG8_WAIT_L(0); PG8_MMA(1, 0, At, B0); PG8_BAR; PG8_SCHED;
            PG8_STAGE(PG8_SB(0, 1), b2 + hstep, voffB);
            PG8_WAIT_V(6); PG8_BAR; PG8_MMA(1, 1, At, B1); PG8_BAR;
            PG8_LDB(B0, 1, 0); PG8_SCHED; PG8_LDA(At, 1, 0); PG8_STAGE(PG8_SA(0, 1), a2 + hstep, voffA);
            PG8_WAIT_L(8); PG8_BAR; PG8_WAIT_L(0); PG8_MMA(0, 0, At, B0); PG8_BAR; PG8_SCHED;
            PG8_LDB(B1, 1, 1); PG8_STAGE(PG8_SB(1, 0), b3, voffB);
            PG8_BAR; PG8_WAIT_L(0); PG8_MMA(0, 1, At, B1); PG8_BAR;
            PG8_LDA(At, 1, 1); PG8_STAGE(PG8_SA(1, 0), a3, voffA);
            PG8_BAR; PG8_WAIT_L(0); PG8_MMA(1, 0, At, B0); PG8_BAR; PG8_SCHED;
            PG8_STAGE(PG8_SB(1, 1), b3 + hstep, voffB);
            PG8_WAIT_V(6); PG8_BAR; PG8_MMA(1, 1, At, B1); PG8_BAR;
        }
        if constexpr (FP8) asm volatile("s_nop 15\n\ts_nop 15" ::: "memory");
        E(acc, cur, wr, wc, fr, fq);
        if (!has_next) break;
#pragma unroll
        for (int a = 0; a < 2; ++a)
#pragma unroll
            for (int b = 0; b < 2; ++b)
#pragma unroll
                for (int m = 0; m < 4; ++m)
#pragma unroll
                    for (int n = 0; n < 2; ++n) acc[a][b][m][n] = (f32x4){0.f, 0.f, 0.f, 0.f};
        cur = nxt; cA = nA; cB = nB; ++ui;
    }
    PG8_WAIT_V(0);
    if (wr == 0) PG8_BAR;
    PG8_BAR;
#undef PG8_SA
#undef PG8_SB
#undef PG8_STAGE
#undef PG8_LDA
#undef PG8_LDB
#undef PG8_MMA
#undef PG8_LD8
#undef PG8_WAIT_V
#undef PG8_WAIT_L
#undef PG8_BAR
#undef PG8_SCHED
}

struct EpiQKV {
    static constexpr bool PERM = true;
    bf16_t *Q, *Kk, *V; const float *gq, *gk, *cosT, *sinT; float qscale;
    __device__ __forceinline__ void operator()(const f32x4 (&acc)[2][2][4][2], const Unit& u, int wr, int wc, int fr, int fq) const {
        const int row0 = u.pm * BM + wr * 64 + fr;
        if (u.pn >= 8) {
            const int col0 = (u.pn - 8) * BM + wc * 32 + 8 * fq;
#pragma unroll
            for (int ai = 0; ai < 2; ++ai)
#pragma unroll
                for (int m = 0; m < 4; ++m) { bf16_t* rowp = V + (size_t)(row0 + ai * HALF + m * 16) * DM + col0;
#pragma unroll
                    for (int bj = 0; bj < 2; ++bj) { const f32x4 v0 = acc[ai][bj][m][0], v1 = acc[ai][bj][m][1];
                        u32x4 w; w.x = cvt_pk_bf16(v0[0], v0[1]); w.y = cvt_pk_bf16(v0[2], v0[3]); w.z = cvt_pk_bf16(v1[0], v1[1]); w.w = cvt_pk_bf16(v1[2], v1[3]);
                        *(u32x4*)(rowp + bj * HALF) = w; } }
        } else {
            const int part = u.pn >> 2, sh = 4 * (u.pn & 3) + wc;
            bf16_t* dst = part ? Kk : Q; const float* g = part ? gk : gq; const float sc = part ? 1.0f : qscale;
            f32x4 g0[2], g1[2];
#pragma unroll
            for (int n = 0; n < 2; ++n) { g0[n] = *(const f32x4*)(g + 8 * fq + 4 * n); g1[n] = *(const f32x4*)(g + 32 + 8 * fq + 4 * n); }
#pragma unroll
            for (int ai = 0; ai < 2; ++ai)
#pragma unroll
                for (int m = 0; m < 4; ++m) {
                    const int r = row0 + ai * HALF + m * 16; const int pos = r & (SEQ - 1);
                    f32x4 x1[2], x2[2]; float ss = 0.f;
#pragma unroll
                    for (int n = 0; n < 2; ++n) { x1[n] = acc[ai][0][m][n]; x2[n] = acc[ai][1][m][n];
                        ss += (x1[n][0] * x1[n][0] + x1[n][1] * x1[n][1]) + (x1[n][2] * x1[n][2] + x1[n][3] * x1[n][3]);
                        ss += (x2[n][0] * x2[n][0] + x2[n][1] * x2[n][1]) + (x2[n][2] * x2[n][2] + x2[n][3] * x2[n][3]); }
                    ss += __shfl_xor(ss, 16); ss += __shfl_xor(ss, 32);
                    const float rstd = __builtin_amdgcn_rsqf(ss * (1.0f / 64.0f) + EPS) ;
                    unsigned char* op = (unsigned char*)dst + (size_t)r * DM + sh * 64 + 8 * fq;
                    u32x2 w1, w2;
#pragma unroll
                    for (int n = 0; n < 2; ++n) {
                        const f32x4 cs = *(const f32x4*)(cosT + pos * 32 + 8 * fq + 4 * n), sn = *(const f32x4*)(sinT + pos * 32 + 8 * fq + 4 * n);
                        const f32x4 y1 = x1[n] * rstd * g0[n], y2 = x2[n] * rstd * g1[n];
                        const f32x4 o1 = (y1 * cs - y2 * sn) * sc, o2 = (y2 * cs + y1 * sn) * sc;
                        if (n == 0) { w1.x = pk_fp8x4(o1[0], o1[1], o1[2], o1[3]); w2.x = pk_fp8x4(o2[0], o2[1], o2[2], o2[3]); }
                        else { w1.y = pk_fp8x4(o1[0], o1[1], o1[2], o1[3]); w2.y = pk_fp8x4(o2[0], o2[1], o2[2], o2[3]); }
                    }
                    *(u32x2*)(op) = w1; *(u32x2*)(op + 32) = w2;
                }
        }
    }
};
struct EpiRes {
    static constexpr bool PERM = false;
    const float* xin; float* xout; const float* gate; float sc;
    __device__ __forceinline__ void operator()(const f32x4 (&acc)[2][2][4][2], const Unit& u, int wr, int wc, int fr, int fq) const {
        const int row0 = u.pm * BM + wr * 64 + fr, col0 = u.pn * BM + wc * 32 + 4 * fq;
        const float* gp = gate + (size_t)(u.pm >> 5) * 6144 + col0;
        f32x4 gv[2][2];
#pragma unroll
        for (int bj = 0; bj < 2; ++bj)
#pragma unroll
            for (int n = 0; n < 2; ++n) gv[bj][n] = *(const f32x4*)(gp + bj * HALF + n * 16) * sc;
#pragma unroll
        for (int ai = 0; ai < 2; ++ai)
#pragma unroll
            for (int m = 0; m < 4; ++m) { const size_t off = (size_t)(row0 + ai * HALF + m * 16) * DM + col0;
                f32x4 xv[2][2];
#pragma unroll
                for (int bj = 0; bj < 2; ++bj)
#pragma unroll
                    for (int n = 0; n < 2; ++n) xv[bj][n] = *(const f32x4*)(xin + off + bj * HALF + n * 16);
#pragma unroll
                for (int bj = 0; bj < 2; ++bj)
#pragma unroll
                    for (int n = 0; n < 2; ++n) *(f32x4*)(xout + off + bj * HALF + n * 16) = xv[bj][n] + gv[bj][n] * acc[ai][bj][m][n];
                if (m == 3) asm volatile("" ::: "memory"); }
    }
};
struct EpiSwiGLU {
    static constexpr bool PERM = true;
    bf16_t* H; int ldh;
    __device__ __forceinline__ void operator()(const f32x4 (&acc)[2][2][4][2], const Unit& u, int wr, int wc, int fr, int fq) const {
        const int row0 = u.pm * BM + wr * 64 + fr, col0 = u.pn * HALF + wc * 32 + 8 * fq;
#pragma unroll
        for (int ai = 0; ai < 2; ++ai)
#pragma unroll
            for (int m = 0; m < 4; ++m) { bf16_t* rowp = H + (size_t)(row0 + ai * HALF + m * 16) * ldh + col0;
                f32x4 v[2];
#pragma unroll
                for (int n = 0; n < 2; ++n) { const f32x4 gt = acc[ai][0][m][n], up = acc[ai][1][m][n];
#pragma unroll
                    for (int j = 0; j < 4; ++j) v[n][j] = fsilu(gt[j]) * up[j]; }
                u32x4 w; w.x = cvt_pk_bf16(v[0][0], v[0][1]); w.y = cvt_pk_bf16(v[0][2], v[0][3]); w.z = cvt_pk_bf16(v[1][0], v[1][1]); w.w = cvt_pk_bf16(v[1][2], v[1][3]);
                *(u32x4*)rowp = w; }
    }
};
struct EpiSwiGLU8 {
    static constexpr bool PERM = true;
    unsigned char* H; int ldh; float ws, hs;
    __device__ __forceinline__ void operator()(const f32x4 (&acc)[2][2][4][2], const Unit& u, int wr, int wc, int fr, int fq) const {
        const int row0 = u.pm * BM + wr * 64 + fr, col0 = u.pn * HALF + wc * 32 + 8 * fq;
#pragma unroll
        for (int ai = 0; ai < 2; ++ai)
#pragma unroll
            for (int m = 0; m < 4; ++m) { unsigned char* rowp = H + (size_t)(row0 + ai * HALF + m * 16) * ldh + col0;
                f32x4 v[2];
#pragma unroll
                for (int n = 0; n < 2; ++n) { const f32x4 gt = acc[ai][0][m][n] * ws, up = acc[ai][1][m][n] * (ws * hs);
#pragma unroll
                    for (int j = 0; j < 4; ++j) v[n][j] = fsilu(gt[j]) * up[j]; }
                *(u32x2*)rowp = (u32x2){pk_fp8x4(v[0][0], v[0][1], v[0][2], v[0][3]), pk_fp8x4(v[1][0], v[1][1], v[1][2], v[1][3])}; }
    }
};
struct EpiPlain {
    static constexpr bool PERM = true;
    bf16_t* O; int ldc; float sc;
    __device__ __forceinline__ void operator()(const f32x4 (&acc)[2][2][4][2], const Unit& u, int wr, int wc, int fr, int fq) const {
        const int row0 = u.pm * BM + wr * 64 + fr, col0 = u.pn * BM + wc * 32 + 8 * fq;
#pragma unroll
        for (int ai = 0; ai < 2; ++ai)
#pragma unroll
            for (int m = 0; m < 4; ++m) { bf16_t* rowp = O + (size_t)(row0 + ai * HALF + m * 16) * ldc + col0;
#pragma unroll
                for (int bj = 0; bj < 2; ++bj) { const f32x4 v0 = acc[ai][bj][m][0] * sc, v1 = acc[ai][bj][m][1] * sc;
                    u32x4 w; w.x = cvt_pk_bf16(v0[0], v0[1]); w.y = cvt_pk_bf16(v0[2], v0[3]); w.z = cvt_pk_bf16(v1[0], v1[1]); w.w = cvt_pk_bf16(v1[2], v1[3]);
                    *(u32x4*)(rowp + bj * HALF) = w; } }
    }
};
struct EpiAct {
    static constexpr bool PERM = true;
    int kind; unsigned char* ws; const float* lb;
    __device__ __forceinline__ void operator()(const f32x4 (&acc)[2][2][4][2], const Unit& u, int wr, int wc, int fr, int fq) const {
        const int row0 = u.pm * BM + wr * 64 + fr;
        int mode, ldc, colt; size_t boff;
        if (kind == 0) { const int grp = u.pn >> 2; colt = (u.pn & 3) * 256; ldc = 1024;
            boff = grp == 0 ? H_Q : grp == 1 ? H_LFF : grp == 2 ? H_LFB : grp == 3 ? H_V : H_G; mode = (grp == 0 || grp == 4) ? 1 : (grp == 3 ? 0 : 3); }
        else { ldc = LRUW; if (u.pn < 5) { boff = L_YB; colt = u.pn * 256; mode = 2; } else { boff = L_XB; colt = (u.pn - 5) * 256; mode = 0; } }
        bf16_t* base = (bf16_t*)(ws + boff);
        const int col0 = colt + wc * 32 + 8 * fq;
        f32x4 lbv[2][2];
        if (mode == 3) { const float* lp = lb + ((u.pn >> 2) - 1) * 1024 + col0;
#pragma unroll
            for (int bj = 0; bj < 2; ++bj)
#pragma unroll
                for (int n = 0; n < 2; ++n) lbv[bj][n] = *(const f32x4*)(lp + bj * HALF + 4 * n); }
#pragma unroll
        for (int ai = 0; ai < 2; ++ai)
#pragma unroll
            for (int m = 0; m < 4; ++m) { bf16_t* rowp = base + (size_t)(row0 + ai * HALF + m * 16) * ldc + col0;
#pragma unroll
                for (int bj = 0; bj < 2; ++bj) { f32x4 v[2]; u32x4 w;
#pragma unroll
                    for (int n = 0; n < 2; ++n) { v[n] = acc[ai][bj][m][n];
                        if (mode == 1) {
#pragma unroll
                            for (int j = 0; j < 4; ++j) v[n][j] = fsilu(v[n][j]); }
                        else if (mode == 2) {
#pragma unroll
                            for (int j = 0; j < 4; ++j) { const float x = v[n][j]; v[n][j] = x * fsigmoid(1.5957691216057308f * (x + 0.044715f * x * x * x)); } }
                        else if (mode == 3) {
#pragma unroll
                            for (int j = 0; j < 4; ++j) { const float l = lbv[bj][n][j]; const float fg = l + (1.0f - l) * fsigmoid(v[n][j]); v[n][j] = __builtin_amdgcn_logf(fg) * 0.6931471805599453f; } }
                    }
                    if (mode == 3) {
#pragma unroll
                        for (int n = 0; n < 2; ++n) { const _Float16 h0 = (_Float16)v[n][0], h1 = (_Float16)v[n][1], h2 = (_Float16)v[n][2], h3 = (_Float16)v[n][3];
                            const unsigned a = (unsigned)__builtin_bit_cast(unsigned short, h0) | ((unsigned)__builtin_bit_cast(unsigned short, h1) << 16);
                            const unsigned b = (unsigned)__builtin_bit_cast(unsigned short, h2) | ((unsigned)__builtin_bit_cast(unsigned short, h3) << 16);
                            if (n == 0) { w.x = a; w.y = b; } else { w.z = a; w.w = b; } }
                    } else { w.x = cvt_pk_bf16(v[0][0], v[0][1]); w.y = cvt_pk_bf16(v[0][2], v[0][3]); w.z = cvt_pk_bf16(v[1][0], v[1][1]); w.w = cvt_pk_bf16(v[1][2], v[1][3]); }
                    *(u32x4*)(rowp + bj * HALF) = w; } }
    }
};
}

struct Args { const float* in[30]; float* out; unsigned char* ws; };
enum { I_X = 0, I_C, I_ADAW, I_ADAB, I_N1G, I_N2G, I_ATWIN, I_ATQN, I_ATKN, I_ATLAM, I_ATSUB, I_ATWOUT, I_HGWIN, I_HGLB, I_HGNG, I_HGWOUT,
       I_LRWIN, I_LRCW, I_LRCB, I_LRWA, I_LRBA, I_LRWX, I_LRBX, I_LRLAM, I_LRWOUT, I_FFGU, I_FFDN, I_MOER, I_MOEGU, I_MOEDN };
enum { SC_LAM0 = 0, SC_LAM1, SC_OML0, SC_OML1, SC_MC0, SC_MC1 };

__device__ __forceinline__ void cvt_item(const float* W, int ldw, int src_col0, bf16_t* WT, int ldt, int dst_row0, int k0, LAS float* scr, int lane) {
#pragma unroll 8
    for (int i = 0; i < 32; ++i) { const int kk = 2 * i + (lane >> 5); scr[kk * 33 + (lane & 31)] = W[(size_t)(k0 + kk) * ldw + src_col0 + (lane & 31)]; }
    LDS_WAIT(); asm volatile("" ::: "memory");
    const int c = lane & 7;
#pragma unroll
    for (int j = 0; j < 4; ++j) { const int n = (lane >> 3) + 8 * j; const LAS float* s = scr + (8 * c) * 33 + n;
        u32x4 o; o.x = cvt_pk_bf16(s[0 * 33], s[1 * 33]); o.y = cvt_pk_bf16(s[2 * 33], s[3 * 33]); o.z = cvt_pk_bf16(s[4 * 33], s[5 * 33]); o.w = cvt_pk_bf16(s[6 * 33], s[7 * 33]);
        *(u32x4*)(WT + (size_t)(dst_row0 + n) * ldt + k0 + 8 * c) = o; }
    LDS_WAIT(); asm volatile("" ::: "memory");
}
__device__ __forceinline__ void cvt_item8(const float* W, int ldw, int src_col0, unsigned char* WT, int ldt, int dst_row0, int k0, float sc, LAS float* scr, int lane) {
#pragma unroll 8
    for (int i = 0; i < 32; ++i) { const int kk = 2 * i + (lane >> 5); scr[kk * 33 + (lane & 31)] = W[(size_t)(k0 + kk) * ldw + src_col0 + (lane & 31)]; }
    LDS_WAIT(); asm volatile("" ::: "memory");
    const int c = lane & 7;
#pragma unroll
    for (int j = 0; j < 4; ++j) { const int n = (lane >> 3) + 8 * j; const LAS float* s = scr + (8 * c) * 33 + n;
        *(u32x2*)(WT + (size_t)(dst_row0 + n) * ldt + k0 + 8 * c) = (u32x2){pk_fp8x4(s[0 * 33] * sc, s[1 * 33] * sc, s[2 * 33] * sc, s[3 * 33] * sc), pk_fp8x4(s[4 * 33] * sc, s[5 * 33] * sc, s[6 * 33] * sc, s[7 * 33] * sc)}; }
    LDS_WAIT(); asm volatile("" ::: "memory");
}
enum { MAP_ID = 0, MAP_QKV = 1, MAP_SWI = 2 };
template <bool F8 = false>
__device__ __forceinline__ void cvt_family(const float* src, size_t sstride, int ninst, int ldw, int K, int ng, int map, int F, bf16_t* dst, size_t dstride,
                                           LAS float* scr, int gw, int NGW, int lane) {
    const int nkb = K / 64, per = nkb * ng, total = ninst * per;
    for (int it = gw; it < total; it += NGW) {
        const int inst = it / per, r = it - inst * per, kb = r / ng, gi = r - kb * ng;
        int sc0;
        if (map == MAP_ID) sc0 = 32 * gi;
        else if (map == MAP_QKV) { const int pn = gi >> 3, bj = (gi >> 2) & 1, wc = gi & 3;
            if (pn < 8) { const int part = pn >> 2, sh = 4 * (pn & 3) + wc; sc0 = part * 1024 + sh * 64 + 32 * bj; } else sc0 = 32 * gi; }
        else { const int pn = gi >> 3, bj = (gi >> 2) & 1, q = gi & 3; sc0 = bj * F + pn * 128 + 32 * q; }
        if constexpr (F8) cvt_item8(src + (size_t)inst * sstride, ldw, sc0, (unsigned char*)dst + (size_t)inst * dstride, K, 32 * gi, 64 * kb, MOE_WSCALE, scr, lane);
        else cvt_item(src + (size_t)inst * sstride, ldw, sc0, dst + (size_t)inst * dstride, K, 32 * gi, 64 * kb, scr, lane);
    }
}

__device__ __forceinline__ void prologue_phase(const Args& A, LAS unsigned char* lds, int bid, int G) {
    const int tid = threadIdx.x, lane = tid & 63, wave = tid >> 6;
    unsigned char* ws = A.ws;
    {
        LAS float* sc = (LAS float*)lds;
        LAS float* red = (LAS float*)(lds + 32768);
        for (int i = tid; i < NBATCH * DM; i += NTHR) { const float cv = A.in[I_C][i]; sc[i] = fsilu(cv); }
        __syncthreads();
        float* mods = (float*)(ws + TB_MODS);
        for (int cb = bid; cb < (DEPTH * 6144) / 128; cb += G) {
            const int col = cb * 128 + (tid & 127), l = col / 6144, e = col - l * 6144, ch = tid >> 7;
            const float* wp = A.in[I_ADAW] + (size_t)l * DM * 6144 + e;
            float a[NBATCH];
#pragma unroll
            for (int b = 0; b < NBATCH; ++b) a[b] = 0.f;
#pragma unroll 4
            for (int d = ch * 256; d < ch * 256 + 256; ++d) { const float w = wp[(size_t)d * 6144];
#pragma unroll
                for (int b = 0; b < NBATCH; ++b) a[b] += sc[b * DM + d] * w; }
#pragma unroll
            for (int b = 0; b < NBATCH; ++b) red[(ch * 128 + (tid & 127)) * 8 + b] = a[b];
            __syncthreads();
            if (tid < 128) { const float bias = A.in[I_ADAB][l * 6144 + e];
#pragma unroll
                for (int b = 0; b < NBATCH; ++b) { const float s = ((red[(0 * 128 + tid) * 8 + b] + red[(1 * 128 + tid) * 8 + b]) + (red[(2 * 128 + tid) * 8 + b] + red[(3 * 128 + tid) * 8 + b])) + bias;
                    mods[((size_t)l * NBATCH + b) * 6144 + e] = s; } }
            __syncthreads();
        }
    }
    {
        float* cosT = (float*)(ws + TB_COS); float* sinT = (float*)(ws + TB_SIN);
        for (int i = bid * NTHR + tid; i < SEQ * 32; i += G * NTHR) {
            const int pos = i >> 5, d = i & 31;
            const float inv = (float)exp(-(double)d * (1.0 / 32.0) * 9.210340371976184);
            const float ang = (float)pos * inv;
            const double rev = (double)ang * 0.15915494309189535; const float fr = (float)(rev - floor(rev));
            cosT[i] = __builtin_amdgcn_cosf(fr); sinT[i] = __builtin_amdgcn_sinf(fr);
        }
        if (bid == 0 && tid < 2) {
            const int a = tid; const float* lm = A.in[I_ATLAM] + a * 256;
            float s1 = 0.f, s2 = 0.f; for (int i = 0; i < 64; ++i) { s1 += lm[i] * lm[64 + i]; s2 += lm[128 + i] * lm[192 + i]; }
            const float linit = 0.8f - 0.6f * expf(-0.3f * (float)(3 * a));
            float mq = 0.f, mk = 0.f; for (int i = 0; i < 64; ++i) { mq = fmaxf(mq, fabsf(A.in[I_ATQN][a * 64 + i])); mk = fmaxf(mk, fabsf(A.in[I_ATKN][a * 64 + i])); }
            float* scal = (float*)(ws + TB_SCAL);
            scal[SC_LAM0 + a] = expf(s1) - expf(s2) + linit; scal[SC_OML0 + a] = 1.0f - linit; scal[SC_MC0 + a] = 8.0f * mq * mk * LOG2E * 1.0001f;
        }
        if (bid == 1) {
            float* lb = (float*)(ws + TB_LB);
            for (int i = tid; i < 2 * 1024; i += NTHR) { const int d = i >> 10, k = i & 1023; const float* p = A.in[I_HGLB] + (size_t)d * DEPTH * 1024 + k;
                float mx = p[0]; for (int l = 1; l < DEPTH; ++l) mx = fmaxf(mx, p[l * 1024]);
                float den = 0.f, num = 0.f; for (int l = 0; l < DEPTH; ++l) { const float e = expf(p[l * 1024] - mx); den += e; if (l == 1) num += e; }
                lb[i] = num / den; }
        }
        if (bid == 2) {
            float* sp = (float*)(ws + TB_SP);
            for (int i = tid; i < 2 * LRUW; i += NTHR) { const float x = -A.in[I_LRLAM][i]; sp[i] = (x > 20.f) ? x : log1pf(expf(x)); }
        }
    }
    {
        LAS float* scr = (LAS float*)(lds + wave * 16384);
        const int vcu = (bid % 8) * (G / 8) + bid / 8;
        const int gw = vcu * NWAVES + wave, NGW = G * NWAVES;
        cvt_family(A.in[I_ATWIN], (size_t)1024 * 3072, 2, 3072, 1024, 96, MAP_QKV, 0, (bf16_t*)(ws + W_QKV), (size_t)3072 * 1024, scr, gw, NGW, lane);
        cvt_family(A.in[I_ATWOUT], (size_t)1024 * 1024, 2, 1024, 1024, 32, MAP_ID, 0, (bf16_t*)(ws + W_AO), (size_t)1024 * 1024, scr, gw, NGW, lane);
        cvt_family(A.in[I_HGWIN], 0, 1, 5120, 1024, 160, MAP_ID, 0, (bf16_t*)(ws + W_HGI), 0, scr, gw, NGW, lane);
        cvt_family(A.in[I_HGWOUT], 0, 1, 1024, 1024, 32, MAP_ID, 0, (bf16_t*)(ws + W_HGO), 0, scr, gw, NGW, lane);
        cvt_family(A.in[I_LRWIN], 0, 1, 2560, 1024, 80, MAP_ID, 0, (bf16_t*)(ws + W_LRI), 0, scr, gw, NGW, lane);
        cvt_family(A.in[I_LRWOUT], 0, 1, 1024, 1280, 32, MAP_ID, 0, (bf16_t*)(ws + W_LRO), 0, scr, gw, NGW, lane);
        for (int it = gw; it < 2 * 20 * 2 * 4; it += NGW) {
            const int part = it / 160, r = it % 160, inst = r >> 3, kb = (r >> 2) & 1, gi = r & 3, d = inst / 10, n = inst % 10;
            const float* src = (part ? A.in[I_LRWX] : A.in[I_LRWA]) + (size_t)inst * 16384;
            cvt_item(src, 128, 32 * gi, (bf16_t*)(ws + W_LRG) + (size_t)(n * 2 + d) * 256 * 128, 128, part * 128 + 32 * gi, 64 * kb, scr, lane);
        }
        static_assert(FP8_DENSE_FROM == 2 || FP8_DENSE_FROM > 3, "dense layer 0 stays bf16; layer 2 optional");
        constexpr int NB16 = (FP8_DENSE_FROM == 2) ? 1 : 2;
        cvt_family(A.in[I_FFGU], (size_t)1024 * 5632, NB16, 5632, 1024, 176, MAP_SWI, DFF, (bf16_t*)(ws + W_FGU), (size_t)5632 * 1024, scr, gw, NGW, lane);
        cvt_family(A.in[I_FFDN], (size_t)2816 * 1024, NB16, 1024, 2816, 32, MAP_ID, 0, (bf16_t*)(ws + W_FDN), (size_t)1024 * 2816, scr, gw, NGW, lane);
        if constexpr (NB16 == 1) {
            cvt_family<true>(A.in[I_FFGU] + (size_t)1024 * 5632, 0, 1, 5632, 1024, 176, MAP_SWI, DFF, (bf16_t*)(ws + W_FGU) + (size_t)5632 * 1024, 0, scr, gw, NGW, lane);
            cvt_family<true>(A.in[I_FFDN] + (size_t)2816 * 1024, 0, 1, 1024, 2816, 32, MAP_ID, 0, (bf16_t*)(ws + W_FDN) + (size_t)1024 * 2816, 0, scr, gw, NGW, lane);
        }
        cvt_family<true>(A.in[I_MOEGU], (size_t)1024 * 7168, 16, 7168, 1024, 224, MAP_SWI, DFFE, (bf16_t*)(ws + W_MGU), (size_t)7168 * 1024, scr, gw, NGW, lane);
        cvt_family<true>(A.in[I_MOEDN], (size_t)3584 * 1024, 16, 1024, 3584, 32, MAP_ID, 0, (bf16_t*)(ws + W_MDN), (size_t)1024 * 3584, scr, gw, NGW, lane);
    }
}

template <bool ROUTER>
__device__ __forceinline__ void norm_phase(const Args& A, LAS unsigned char* lds, int bid, int G, const float* xsrc, float* xdst, const float* gain, const float* modl  , int which,
                                           bool combine, const float* modprev  , bool nonorm, const float* router, bool f8out = false) {
    int tid_ = threadIdx.x; asm volatile("" : "+v"(tid_));
    const int tid = tid_, lane = tid & 63, wave = tid >> 6;
    unsigned char* ws = A.ws;
    bf16_t* HM = (bf16_t*)(ws + WS_HM);
    const int* slot = (const int*)(ws + TB_SLOT); const float* gts = (const float*)(ws + TB_GATE);
    const bf16_t* Y = (const bf16_t*)(ws + E_XS);
    LAS int* hist = (LAS int*)lds;
    for (int tb = bid; tb < MTOK / 256; tb += G) {
        const int b = tb >> 5;
        f32x4 ga[4], sh[4], g2[4];
#pragma unroll
        for (int j = 0; j < 4; ++j) { const int c = 256 * j + 4 * lane;
            if (!nonorm) { const f32x4 gv = *(const f32x4*)(gain + c), sv = *(const f32x4*)(modl + (size_t)b * 6144 + (which * 3 + 1) * 1024 + c);
                ga[j] = gv * (sv + 1.0f); sh[j] = *(const f32x4*)(modl + (size_t)b * 6144 + (which * 3) * 1024 + c); }
            if (combine) g2[j] = *(const f32x4*)(modprev + (size_t)b * 6144 + 5 * 1024 + c); }
        f32x4 rw[ROUTER ? 32 : 1];
        if constexpr (ROUTER) {
            if (tid < 8) hist[tid] = 0;
#pragma unroll
            for (int j = 0; j < 4; ++j)
#pragma unroll
                for (int i = 0; i < 4; ++i) { const int c = 256 * j + 4 * lane + i; rw[(j * 4 + i) * 2] = *(const f32x4*)(router + c * 8); rw[(j * 4 + i) * 2 + 1] = *(const f32x4*)(router + c * 8 + 4); }
            __syncthreads();
        }
        for (int i = 0; i < 32; ++i) {
            const int row = tb * 256 + wave * 32 + i;
            const float* xr = xsrc + (size_t)row * DM;
            f32x4 v[4];
#pragma unroll
            for (int j = 0; j < 4; ++j) v[j] = *(const f32x4*)(xr + 256 * j + 4 * lane);
            if (combine) {
                const int s0 = slot[row * 2], s1 = slot[row * 2 + 1]; const float w0 = gts[row * 2], w1 = gts[row * 2 + 1];
#pragma unroll
                for (int j = 0; j < 4; ++j) { const u32x2 a = *(const u32x2*)(Y + (size_t)s0 * DM + 256 * j + 4 * lane), c2 = *(const u32x2*)(Y + (size_t)s1 * DM + 256 * j + 4 * lane);
                    f32x4 y; y[0] = w0 * bflo(a.x) + w1 * bflo(c2.x); y[1] = w0 * bfhi(a.x) + w1 * bfhi(c2.x); y[2] = w0 * bflo(a.y) + w1 * bflo(c2.y); y[3] = w0 * bfhi(a.y) + w1 * bfhi(c2.y);
                    v[j] = v[j] + g2[j] * y; *(f32x4*)(xdst + (size_t)row * DM + 256 * j + 4 * lane) = v[j]; }
            }
            if (nonorm) continue;
            float ss = 0.f;
#pragma unroll
            for (int j = 0; j < 4; ++j) ss += (v[j][0] * v[j][0] + v[j][1] * v[j][1]) + (v[j][2] * v[j][2] + v[j][3] * v[j][3]);
            ss = wave_sum(ss);
            const float rstd = 1.0f / sqrtf(ss * (1.0f / DM) + EPS);
            f32x4 h[4];
#pragma unroll
            for (int j = 0; j < 4; ++j) { h[j] = v[j] * rstd * ga[j] + sh[j];
                if (f8out) { *(unsigned*)((unsigned char*)HM + (size_t)row * DM + 256 * j + 4 * lane) = pk_fp8x4(h[j][0], h[j][1], h[j][2], h[j][3]); }
                else { u32x2 w; w.x = cvt_pk_bf16(h[j][0], h[j][1]); w.y = cvt_pk_bf16(h[j][2], h[j][3]);
                    *(u32x2*)(HM + (size_t)row * DM + 256 * j + 4 * lane) = w; } }
            if constexpr (ROUTER) {
                float lg[8];
#pragma unroll
                for (int e = 0; e < 8; ++e) lg[e] = 0.f;
#pragma unroll
                for (int j = 0; j < 4; ++j)
#pragma unroll
                    for (int q = 0; q < 4; ++q) { const float hv = h[j][q]; const f32x4 r0 = rw[(j * 4 + q) * 2], r1 = rw[(j * 4 + q) * 2 + 1];
                        lg[0] += hv * r0[0]; lg[1] += hv * r0[1]; lg[2] += hv * r0[2]; lg[3] += hv * r0[3]; lg[4] += hv * r1[0]; lg[5] += hv * r1[1]; lg[6] += hv * r1[2]; lg[7] += hv * r1[3]; }
#pragma unroll
                for (int e = 0; e < 8; ++e) lg[e] = wave_sum(lg[e]);
                int e0 = 0; float v0 = lg[0];
#pragma unroll
                for (int e = 1; e < 8; ++e) if (lg[e] > v0) { v0 = lg[e]; e0 = e; }
                int e1 = -1; float v1 = -3.0e38f;
#pragma unroll
                for (int e = 0; e < 8; ++e) if (e != e0 && lg[e] > v1) { v1 = lg[e]; e1 = e; }
                const float p1 = frcp(1.0f + fexp(v1 - v0));
                if (lane == 0) { int* eid = (int*)(ws + TB_EID); float* gt = (float*)(ws + TB_GATE);
                    eid[row * 2] = e0; eid[row * 2 + 1] = e1; gt[row * 2] = p1; gt[row * 2 + 1] = 1.0f - p1;
                    atomicAdd((int*)&hist[e0], 1); atomicAdd((int*)&hist[e1], 1); }
            }
        }
        if constexpr (ROUTER) {
            __syncthreads();
            if (tid < 8) ((int*)(ws + TB_BCNT))[tb * 8 + tid] = hist[tid];
            __syncthreads();
        }
    }
}

namespace lru {
constexpr int XCF = 0, XCB = 16384, AA = 24576, UU = 40960;
__device__ __forceinline__ int sw256(int row, int cb) { return row * 256 + (cb ^ ((row & 15) << 4)); }
__device__ __forceinline__ int crow(int r, int hi) { return (r & 3) + 8 * (r >> 2) + 4 * hi; }
template <int MODE>
__device__ __forceinline__ void lru_item(const Args& A, LAS unsigned char* lds, int b, int n, int seg, int dir) {
    int tid_ = threadIdx.x; asm volatile("" : "+v"(tid_));
    const int tid = tid_, wid = tid >> 6, lane = tid & 63, r = lane & 31, hh = lane >> 5;
    unsigned char* ws = A.ws;
    const bf16_t* XB = (const bf16_t*)(ws + L_XB); const bf16_t* YB = (const bf16_t*)(ws + L_YB); bf16_t* HF = (bf16_t*)(ws + L_HF); bf16_t* HY = (bf16_t*)(ws + L_HY);
    const bf16_t* Wg = (const bf16_t*)(ws + W_LRG) + (size_t)((n * 2 + dir) * 256 + ((r < 16) ? (16 * wid + r) : (128 + 16 * wid + r - 16))) * 128 + 8 * hh;
    bf16x8 bfrag[8];
#pragma unroll
    for (int ks = 0; ks < 8; ++ks) bfrag[ks] = *(const bf16x8*)(Wg + 16 * ks);
    const int cch = n * 128 + 16 * wid + (r & 15);
    const float nba = -LOG2E * A.in[I_LRBA][dir * LRUW + cch], nbx = -LOG2E * A.in[I_LRBX][dir * LRUW + cch], csp = -8.0f * LOG2E * ((const float*)(ws + TB_SP))[dir * LRUW + cch];
    const int ct = tid >> 4, cg = tid & 15, cc0 = n * 128 + 8 * cg;
    float cw[4][8], cb[8];
#pragma unroll
    for (int j = 0; j < 8; ++j) { cb[j] = A.in[I_LRCB][cc0 + j];
#pragma unroll
        for (int w = 0; w < 4; ++w) cw[w][j] = A.in[I_LRCW][w * LRUW + cc0 + j]; }
    float carry = 0.f, P = 1.f;
    if (MODE != 0 && tid < 128) carry = ((const float*)(ws + TB_LCIN))[(size_t)((b * 32 + seg) * 2 + dir) * LRUW + n * 128 + tid];
    u32x4 xr[4];
#define LRU_XLOAD(si_) do { const int sub_ = dir ? (7 - (si_)) : (si_); const int tok_ = seg * 256 + sub_ * 32 + ct; \
        _Pragma("unroll") for (int w = 0; w < 4; ++w) { const int tt = tok_ - 1 + w; xr[w] = (tt >= 0 && tt < SEQ) ? *(const u32x4*)(XB + ((size_t)b * SEQ + tt) * LRUW + cc0) : (u32x4){0u, 0u, 0u, 0u}; } } while (0)
    LRU_XLOAD(0);
    for (int si = 0; si < 8; ++si) {
        const int sub = dir ? (7 - si) : si; const int t0 = seg * 256 + sub * 32;
        {
            float xc[8];
#pragma unroll
            for (int j = 0; j < 8; ++j) xc[j] = cb[j];
#pragma unroll
            for (int w = 0; w < 4; ++w) { const u32x4 v = xr[w];
#pragma unroll
                for (int e = 0; e < 4; ++e) { xc[2 * e] += cw[w][2 * e] * bflo(v[e]); xc[2 * e + 1] += cw[w][2 * e + 1] * bfhi(v[e]); } }
            if (si + 1 < 8) LRU_XLOAD(si + 1);
            *(LAS f32x4*)(lds + XCF + (ct * 128 + 8 * cg) * 4) = (f32x4){xc[0], xc[1], xc[2], xc[3]};
            *(LAS f32x4*)(lds + XCF + (ct * 128 + 8 * cg + 4) * 4) = (f32x4){xc[4], xc[5], xc[6], xc[7]};
            *(LAS u32x4*)(lds + XCB + sw256(ct, 16 * cg)) = (u32x4){cvt_pk_bf16(xc[0], xc[1]), cvt_pk_bf16(xc[2], xc[3]), cvt_pk_bf16(xc[4], xc[5]), cvt_pk_bf16(xc[6], xc[7])};
        }
        __syncthreads();
        {
            f32x16 acc = {};
#pragma unroll
            for (int ks = 0; ks < 8; ++ks) { const bf16x8 fa = *(const LAS bf16x8*)(lds + XCB + sw256(r, (16 * ks + 8 * hh) * 2)); acc = __builtin_amdgcn_mfma_f32_32x32x16_bf16(fa, bfrag[ks], acc, 0, 0, 0); }
#pragma unroll
            for (int q = 0; q < 8; ++q) {
                const auto sw = __builtin_amdgcn_permlane16_swap(__float_as_uint(acc[q]), __float_as_uint(acc[8 + q]), false, false);
                const float rp = __uint_as_float(sw[0]), ip = __uint_as_float(sw[1]);
                const int tq = crow((r < 16) ? q : (8 + q), hh); const int cl = 16 * wid + (r & 15);
                const float xcv = ((const LAS float*)(lds + XCF))[tq * 128 + cl];
                const float rg = frcp(1.0f + fexp2(fmaf(rp, -LOG2E, nba))), ig = frcp(1.0f + fexp2(fmaf(ip, -LOG2E, nbx)));
                const float av = fexp2(csp * rg), uv = __builtin_amdgcn_sqrtf(fmaxf(fmaf(-av, av, 1.0f), 0.f)) * ig * xcv;
                ((LAS float*)(lds + AA))[tq * 128 + cl] = av; ((LAS float*)(lds + UU))[tq * 128 + cl] = uv; }
        }
        __syncthreads();
        if (tid < 128) {
            LAS float* ap = (LAS float*)(lds + AA) + tid; LAS float* up = (LAS float*)(lds + UU) + tid; float av[32], uv[32];
#pragma unroll
            for (int i = 0; i < 32; ++i) { av[i] = ap[i * 128]; uv[i] = up[i * 128]; }
            if (dir == 0) {
#pragma unroll
                for (int i = 0; i < 32; ++i) { carry = av[i] * carry + uv[i]; if (MODE == 0) P *= av[i]; else uv[i] = carry; } }
            else {
#pragma unroll
                for (int i = 31; i >= 0; --i) { carry = av[i] * carry + uv[i]; if (MODE == 0) P *= av[i]; else uv[i] = carry; } }
            if (MODE != 0) {
#pragma unroll
                for (int i = 0; i < 32; ++i) up[i * 128] = uv[i]; }
        }
        if (MODE != 0) {
            __syncthreads();
            const int tok = t0 + ct; const size_t go = ((size_t)b * SEQ + tok) * LRUW + cc0;
            const f32x4 h0 = *(const LAS f32x4*)(lds + UU + (ct * 128 + 8 * cg) * 4), h1 = *(const LAS f32x4*)(lds + UU + (ct * 128 + 8 * cg + 4) * 4);
            if (MODE == 1) { *(u32x4*)(HF + go) = (u32x4){cvt_pk_bf16(h0[0], h0[1]), cvt_pk_bf16(h0[2], h0[3]), cvt_pk_bf16(h1[0], h1[1]), cvt_pk_bf16(h1[2], h1[3])}; }
            else { const u32x4 f = *(const u32x4*)(HF + go), y = *(const u32x4*)(YB + go);
                *(u32x4*)(HY + go) = (u32x4){cvt_pk_bf16((h0[0] + bflo(f[0])) * bflo(y[0]), (h0[1] + bfhi(f[0])) * bfhi(y[0])), cvt_pk_bf16((h0[2] + bflo(f[1])) * bflo(y[1]), (h0[3] + bfhi(f[1])) * bfhi(y[1])),
                                            cvt_pk_bf16((h1[0] + bflo(f[2])) * bflo(y[2]), (h1[1] + bfhi(f[2])) * bfhi(y[2])), cvt_pk_bf16((h1[2] + bflo(f[3])) * bflo(y[3]), (h1[3] + bfhi(f[3])) * bfhi(y[3]))}; }
        }
        __syncthreads();
    }
#undef LRU_XLOAD
    if (MODE == 0 && tid < 128) { float* sm = (float*)(ws + TB_LSUM) + (size_t)(((b * 32 + seg) * 2 + dir) * 2) * LRUW + n * 128 + tid; sm[0] = P; sm[LRUW] = carry; }
}
}
template <int MODE>
__device__ __forceinline__ void lru_phase(const Args& A, LAS unsigned char* lds, int bid, int G) {
    const int nitems = (MODE == 0) ? 5120 : 2560;
    for (int it = bid; it < nitems; it += G) {
        int b, n, seg, dir;
        if (MODE == 0) { dir = it & 1; const int r = it >> 1; seg = r & 31; n = (r >> 5) % 10; b = r / 320; }
        else { dir = MODE - 1; seg = it & 31; n = (it >> 5) % 10; b = it / 320; }
        lru::lru_item<MODE>(A, lds, b, n, seg, dir);
    }
}
__device__ __forceinline__ void lru_carry_phase(const Args& A, int bid, int G) {
    const float* sm = (const float*)(A.ws + TB_LSUM); float* cin = (float*)(A.ws + TB_LCIN);
    for (int idx = bid * NTHR + threadIdx.x; idx < NBATCH * 2 * LRUW; idx += G * NTHR) {
        const int b = idx / (2 * LRUW), r = idx % (2 * LRUW), dir = r / LRUW, ch = r % LRUW; float carry = 0.f;
        for (int i = 0; i < 32; ++i) { const int sg = dir ? (31 - i) : i; const size_t o = (size_t)((b * 32 + sg) * 2 + dir);
            cin[o * LRUW + ch] = carry; carry = sm[o * 2 * LRUW + ch] * carry + sm[o * 2 * LRUW + LRUW + ch]; }
    }
}

__device__ __forceinline__ void place_phase(const Args& A, LAS unsigned char* lds, int bid, int G) {
    int tid_ = threadIdx.x; asm volatile("" : "+v"(tid_));
    const int tid = tid_, lane = tid & 63, wave = tid >> 6; unsigned char* ws = A.ws;
    const int* bcnt = (const int*)(ws + TB_BCNT); const int* eid = (const int*)(ws + TB_EID); int* slot = (int*)(ws + TB_SLOT);
    const bf16_t* HM = (const bf16_t*)(ws + WS_HM); bf16_t* XS = (bf16_t*)(ws + E_XS);
    LAS int* tot = (LAS int*)lds; LAS int* pre = tot + 8; LAS int* rb = tot + 16; LAS int* wcn = tot + 32; LAS int* sl = tot + 64;
    for (int tb = bid; tb < MTOK / 256; tb += G) {
        { int t_ = 0, p_ = 0;
#pragma unroll
            for (int j = 0; j < 4; ++j) { const int blk = lane + 64 * j; const int v = bcnt[blk * 8 + wave]; t_ += v; p_ += (blk < tb) ? v : 0; }
#pragma unroll
            for (int o = 1; o < 64; o <<= 1) { t_ += __shfl_xor(t_, o); p_ += __shfl_xor(p_, o); }
            if (lane == 0) { tot[wave] = t_; pre[wave] = p_; } }
        __syncthreads();
        if (tid == 0) { int acc = 0; for (int e = 0; e < 8; ++e) { rb[e] = acc * 256; if (tb == 0) ((int*)(ws + TB_TILES))[e] = acc; acc += (tot[e] + 255) >> 8; } if (tb == 0) ((int*)(ws + TB_TILES))[8] = acc; }
        int e0 = -1, e1 = -1; unsigned long long mk0 = 0, mk1 = 0;
        if (tid < 256) { e0 = eid[(tb * 256 + tid) * 2]; e1 = eid[(tb * 256 + tid) * 2 + 1];
#pragma unroll
            for (int e = 0; e < 8; ++e) { const unsigned long long m = __ballot(e0 == e || e1 == e); if (lane == 0) wcn[wave * 8 + e] = __popcll(m); if (e0 == e) mk0 = m; if (e1 == e) mk1 = m; } }
        __syncthreads();
        if (tid < 256) { const unsigned long long lt = (1ull << lane) - 1ull; int b0 = rb[e0] + pre[e0] + __popcll(mk0 & lt), b1 = rb[e1] + pre[e1] + __popcll(mk1 & lt);
            for (int w = 0; w < wave; ++w) { b0 += wcn[w * 8 + e0]; b1 += wcn[w * 8 + e1]; }
            sl[tid * 2] = b0; sl[tid * 2 + 1] = b1; slot[(tb * 256 + tid) * 2] = b0; slot[(tb * 256 + tid) * 2 + 1] = b1; }
        __syncthreads();
        for (int i = 0; i < 32; ++i) { const int t = wave * 32 + i; const int s0 = sl[t * 2], s1 = sl[t * 2 + 1];
            const bf16_t* src = HM + (size_t)(tb * 256 + t) * DM + lane * 16;
            const u32x4 a = *(const u32x4*)src, b = *(const u32x4*)(src + 8);
            const u32x4 q = {pk_fp8x4(bflo(a[0]), bfhi(a[0]), bflo(a[1]), bfhi(a[1])), pk_fp8x4(bflo(a[2]), bfhi(a[2]), bflo(a[3]), bfhi(a[3])),
                             pk_fp8x4(bflo(b[0]), bfhi(b[0]), bflo(b[1]), bfhi(b[1])), pk_fp8x4(bflo(b[2]), bfhi(b[2]), bflo(b[3]), bfhi(b[3]))};
            *(u32x4*)((unsigned char*)XS + (size_t)s0 * DM + lane * 16) = q; *(u32x4*)((unsigned char*)XS + (size_t)s1 * DM + lane * 16) = q; }
        __syncthreads();
    }
}

namespace att {
constexpr int KVBLK = 64;
#define SBAR() __builtin_amdgcn_sched_barrier(0)
typedef int v8i __attribute__((ext_vector_type(8)));
__device__ __forceinline__ int crow(int r, int hi) { return (r & 3) + 8 * (r >> 2) + 4 * hi; }
constexpr int SLOTB = 16384;
__device__ __forceinline__ int k_slot(int s) { return s * SLOTB; }
__device__ __forceinline__ int v_slot(int s) { return s * SLOTB + 8192; }
__device__ __forceinline__ int kswz(int row) { return ((row & 7) ^ (row >> 4)) & 7; }
__device__ __forceinline__ int vswz(int row) { return (row >> 2) & 3; }
__device__ __forceinline__ void mfma8_acc(f32x16& acc, const v8i& a, const v8i& b, int sc) {
    asm volatile("s_nop 4\n\tv_mfma_scale_f32_32x32x64_f8f6f4 %0, %1, %2, %0, %3, %3 op_sel_hi:[0,0,0]" : "+v"(acc) : "v"(a), "v"(b), "v"(sc));
}
__device__ __forceinline__ void mfma8_c(f32x16& d, const v8i& a, const v8i& b, const f32x16& c, int sa, int sb) {
    asm volatile("v_mfma_scale_f32_32x32x64_f8f6f4 %0, %1, %2, %3, %4, %5 op_sel_hi:[0,0,0]" : "=&v"(d) : "v"(a), "v"(b), "v"(c), "v"(sa), "v"(sb));
}
#define ATT_LD8(p0_, p1_) __builtin_bit_cast(v8i, __builtin_shufflevector(*(const LAS u32x4*)(p0_), *(const LAS u32x4*)(p1_), 0, 1, 2, 3, 4, 5, 6, 7))
__device__ __forceinline__ void qkt(f32x16& p0, f32x16& p1, const LAS char* Ks, const v8i& qr, int r32, int hi, int jj, const f32x16& cinit, int s1, int s8) {
    const int c0 = jj * 4 + 2 * hi;
    { const int row = r32; const v8i kf = ATT_LD8(Ks + row * 128 + ((c0 ^ kswz(row)) << 4), Ks + row * 128 + (((c0 + 1) ^ kswz(row)) << 4)); mfma8_c(p0, kf, qr, cinit, s1, s8); }
    { const int row = 32 + r32; const v8i kf = ATT_LD8(Ks + row * 128 + ((c0 ^ kswz(row)) << 4), Ks + row * 128 + (((c0 + 1) ^ kswz(row)) << 4)); mfma8_c(p1, kf, qr, cinit, s1, s8); }
}
__device__ __forceinline__ void partialSM(f32x16& p0) {
#pragma unroll
    for (int r = 0; r < 16; ++r) p0[r] = fexp2(p0[r]);
}
__device__ __forceinline__ void finishSM(f32x16& p0, f32x16& p1, v8i& pa) {
#pragma unroll
    for (int r = 0; r < 16; ++r) p1[r] = fexp2(p1[r]);
#pragma unroll
    for (int w = 0; w < 4; ++w) { pa[w] = (int)pk_fp8x4(p0[4 * w], p0[4 * w + 1], p0[4 * w + 2], p0[4 * w + 3]); pa[4 + w] = (int)pk_fp8x4(p1[4 * w], p1[4 * w + 1], p1[4 * w + 2], p1[4 * w + 3]); }
}
__device__ __forceinline__ void pv_d0(f32x16* o, f32x16& lacc, const v8i& ones, const LAS char* Vs, const v8i& pa, int r32, int hi, int s1) {
#pragma unroll
    for (int d0 = 0; d0 < 4; ++d0) { const int row = 32 * d0 + r32;
        const v8i vf = ATT_LD8(Vs + row * 64 + (((2 * hi) ^ vswz(row)) << 4), Vs + row * 64 + (((2 * hi + 1) ^ vswz(row)) << 4));
        mfma8_acc(o[d0], pa, vf, s1); }
    mfma8_acc(lacc, pa, ones, s1);
}
}

__device__ __forceinline__ void vt_phase(const Args& A, int bid, int G) {
    const int tid = threadIdx.x; unsigned char* ws = A.ws;
    const bf16_t* V = (const bf16_t*)(ws + A_V); unsigned char* VT = ws + A_VT;
    const int dv = tid & 127, kq = tid >> 7, half = kq >> 1, hi = kq & 1;
    for (int it = bid; it < 64 * 128; it += G) {
        const int bh = it >> 7, tile = it & 127, b = bh >> 3, h = bh & 7;
        const bf16_t* vp = V + ((size_t)b * SEQ + tile * 64 + 32 * half) * DM + h * 128 + dv;
        float f[16];
#pragma unroll
        for (int i = 0; i < 16; ++i) f[i] = bf2f(vp[(size_t)att::crow(i, hi) * DM]);
        *(u32x4*)(VT + (((size_t)bh * 128 + dv) * 128 + tile) * 64 + hi * 32 + half * 16) =
            (u32x4){pk_fp8x4(f[0], f[1], f[2], f[3]), pk_fp8x4(f[4], f[5], f[6], f[7]), pk_fp8x4(f[8], f[9], f[10], f[11]), pk_fp8x4(f[12], f[13], f[14], f[15])};
    }
}

__device__ __forceinline__ void attn_phase(const Args& A, LAS unsigned char* ldsu, int bid, int G, int al) {
    using namespace att;
    LAS char* lds = (LAS char*)ldsu;
    unsigned char* ws = A.ws;
    const unsigned char* Qg = ws + A_Q; const unsigned char* Kg = ws + A_K; const unsigned char* VTg = ws + A_VT;
    bf16_t* Og = (bf16_t*)(ws + WS_HM);
    const float* scal = (const float*)(ws + TB_SCAL);
    const float lamv = scal[SC_LAM0 + al], omli = scal[SC_OML0 + al], Mc = scal[SC_MC0 + al] - 7.5f;
    const float* subg = A.in[I_ATSUB] + al * 128;
    int tid_ = threadIdx.x; asm volatile("" : "+v"(tid_));
    const int tid = tid_, wid = __builtin_amdgcn_readfirstlane(tid >> 6), lane = tid & 63, r32 = lane & 31, hi = lane >> 5, jj = wid >> 2, wq = wid & 3;
    constexpr int NT = SEQ / KVBLK;
    int s1 = 0x7f7f7f7f, s8 = 0x7c7c7c7c; asm volatile("" : "+v"(s1), "+v"(s8));
    v8i ones; { int o1 = 0x38383838; asm volatile("" : "+v"(o1)); ones = (v8i){o1, o1, o1, o1, o1, o1, o1, o1}; }
    f32x16 cinit;
#pragma unroll
    for (int r = 0; r < 16; ++r) cinit[r] = -Mc;
    unsigned koff, voff;
    { const int bb = wid * 1024 + lane * 16;
      { const int row = bb >> 7, c = ((bb & 127) >> 4) ^ kswz(row); koff = (unsigned)(row * 1024 + c * 16); }
      { const int row = bb >> 6, c = ((bb & 63) >> 4) ^ vswz(row); voff = (unsigned)(row * 8192 + c * 16); } }
    const unsigned ldsw = (unsigned)wid * 1024u;
#define ATT_DMA(slot, kt, vt) do { \
        __builtin_amdgcn_global_load_lds((const unsigned*)((const unsigned char*)(kt) + koff), (LAS unsigned*)(lds + k_slot(slot) + ldsw), 16, 0, 0); \
        __builtin_amdgcn_global_load_lds((const unsigned*)((const unsigned char*)(vt) + voff), (LAS unsigned*)(lds + v_slot(slot) + ldsw), 16, 0, 0); } while (0)
#define ATT_TOP() do { asm volatile("s_waitcnt vmcnt(0)" ::: "memory"); __builtin_amdgcn_s_barrier(); asm volatile("" ::: "memory"); } while (0)
    const int xq = bid & 7, cq = bid >> 3;
    int cbh = xq * 8;
    const bool lag = (jj != 0);
#define ATT_KB(bh_) (Kg + ((size_t)((bh_) >> 3) * SEQ) * DM + ((bh_) & 7) * 128)
#define ATT_VB(bh_) (VTg + (size_t)(bh_) * 128 * 8192)
    ATT_DMA(0, ATT_KB(cbh), ATT_VB(cbh));
    { asm volatile("s_waitcnt vmcnt(0)" ::: "memory"); __builtin_amdgcn_s_barrier(); asm volatile("" ::: "memory"); ATT_DMA(1, ATT_KB(cbh) + (size_t)64 * DM, ATT_VB(cbh) + 64); }
    for (int ui = 0; ui < 16; ++ui) {
        const int qb = (ui & 1) * 32 + cq;
        const int nbh = (ui + 1 < 16) ? xq * 8 + ((ui + 1) >> 1) : cbh;
        const unsigned char* Kh = ATT_KB(cbh); const unsigned char* Vh = ATT_VB(cbh); const unsigned char* nK = ATT_KB(nbh); const unsigned char* nV = ATT_VB(nbh);
        const size_t obase = ((size_t)(cbh >> 3) * SEQ + qb * 128) * DM + (cbh & 7) * 128;
        f32x16 lacc = {}; f32x16 o[4] = {}; v8i qr;
        { const unsigned char* Qw = Qg + obase + (size_t)(wq * 32 + r32) * DM + jj * 64 + hi * 32;
          const u32x4 qa = *(const u32x4*)Qw, qb2 = *(const u32x4*)(Qw + 16);
          qr = __builtin_bit_cast(v8i, __builtin_shufflevector(qa, qb2, 0, 1, 2, 3, 4, 5, 6, 7)); }
        f32x16 pA0, pA1, pB0, pB1; v8i pa;
#define ATT_SRC(jt, KP, VP) const unsigned char* KP = ((jt) + 2 < NT) ? Kh + (size_t)((jt) + 2) * 64 * DM : nK + (size_t)((jt) + 2 - NT) * 64 * DM; \
                            const unsigned char* VP = ((jt) + 2 < NT) ? Vh + (size_t)((jt) + 2) * 64 : nV + (size_t)((jt) + 2 - NT) * 64
#define ATT_BAR(jt) do { ATT_TOP(); ATT_SRC(jt, kp_, vp_); ATT_DMA(((jt) + 2) & 3, kp_, vp_); } while (0)
        { qkt(pA0, pA1, lds + k_slot(0), qr, r32, hi, jj, cinit, s1, s8);
          if (lag) ATT_BAR(0);
          asm volatile("s_nop 15\n\ts_nop 7" ::: "memory");
          partialSM(pA0);
          if (!lag) ATT_BAR(0); }
        for (int jt = 1; jt + 1 < NT; jt += 2) {
            { SBAR(); qkt(pB0, pB1, lds + k_slot(jt & 3), qr, r32, hi, jj, cinit, s1, s8);
              finishSM(pA0, pA1, pa); SBAR();
              if (lag) ATT_BAR(jt);
              pv_d0(o, lacc, ones, lds + v_slot((jt - 1) & 3), pa, r32, hi, s1); partialSM(pB0);
              if (!lag) ATT_BAR(jt); }
            { const int j2 = jt + 1;
              SBAR(); qkt(pA0, pA1, lds + k_slot(j2 & 3), qr, r32, hi, jj, cinit, s1, s8);
              finishSM(pB0, pB1, pa); SBAR();
              if (lag) ATT_BAR(j2);
              pv_d0(o, lacc, ones, lds + v_slot((j2 - 1) & 3), pa, r32, hi, s1); partialSM(pA0);
              if (!lag) ATT_BAR(j2); }
        }
        { constexpr int jt = NT - 1;
          SBAR(); qkt(pB0, pB1, lds + k_slot(jt & 3), qr, r32, hi, jj, cinit, s1, s8);
          finishSM(pA0, pA1, pa); SBAR();
          if (lag) ATT_BAR(jt);
          pv_d0(o, lacc, ones, lds + v_slot((jt - 1) & 3), pa, r32, hi, s1); partialSM(pB0);
          if (!lag) ATT_BAR(jt);
          finishSM(pB0, pB1, pa); SBAR();
          pv_d0(o, lacc, ones, lds + v_slot(jt & 3), pa, r32, hi, s1);
          asm volatile("s_nop 15\n\ts_nop 15" ::: "memory"); }
#undef ATT_BAR
#undef ATT_SRC
        int r32e = r32, hie = hi; asm volatile("" : "+v"(r32e), "+v"(hie));
        float rli[16];
#pragma unroll
        for (int r = 0; r < 16; ++r) rli[r] = frcp(lacc[r]);
        LAS float* Cb = (LAS float*)(lds + 65536);
        if (jj == 1) {
#pragma unroll
            for (int r = 0; r < 16; ++r) { const float sc = rli[r] * lamv;
#pragma unroll
                for (int d0 = 0; d0 < 4; ++d0) Cb[(wq * 32 + crow(r, hie)) * 128 + d0 * 32 + r32e] = o[d0][r] * sc; }
        }
        asm volatile("s_waitcnt lgkmcnt(0)" ::: "memory"); __builtin_amdgcn_s_barrier(); asm volatile("" ::: "memory");
        if (jj == 0) {
            float g[4];
#pragma unroll
            for (int d0 = 0; d0 < 4; ++d0) g[d0] = subg[d0 * 32 + r32e] * omli;
            bf16_t* Ob = Og + obase;
#pragma unroll
            for (int r = 0; r < 16; ++r) {
                float ss = 0.f;
#pragma unroll
                for (int d0 = 0; d0 < 4; ++d0) { const float v = o[d0][r] * rli[r] - Cb[(wq * 32 + crow(r, hie)) * 128 + d0 * 32 + r32e]; o[d0][r] = v; ss += v * v; }
                ss += __shfl_xor(ss, 1); ss += __shfl_xor(ss, 2); ss += __shfl_xor(ss, 4); ss += __shfl_xor(ss, 8); ss += __shfl_xor(ss, 16);
                const float rs = 1.0f / sqrtf(ss * (1.0f / 128.0f) + EPS);
                bf16_t* op = Ob + (size_t)(wq * 32 + crow(r, hie)) * DM + r32e;
#pragma unroll
                for (int d0 = 0; d0 < 4; ++d0) op[d0 * 32] = (bf16_t)f2bf(o[d0][r] * rs * g[d0]);
            }
        }
        asm volatile("s_waitcnt lgkmcnt(0)" ::: "memory"); __builtin_amdgcn_s_barrier(); asm volatile("" ::: "memory");
        cbh = nbh;
    }
    asm volatile("s_waitcnt vmcnt(0) lgkmcnt(0)" ::: "memory"); __builtin_amdgcn_s_barrier(); asm volatile("" ::: "memory");
#undef ATT_DMA
#undef ATT_TOP
#undef ATT_KB
#undef ATT_VB
#undef ATT_LD8
}

namespace gla {
constexpr int BC = 0, QI = 32768, QA = 49152, KA = 65536, KST = 81920, VT = 98304, ST = 106496, AT = 122880, EM = 131072, EL = EM + 512, DD = EM + 1024, BMID = EM + 1536, SEG = EM + 2048;
static_assert(SEG + 2048 <= RING_BYTES, "gla lds");
__device__ __forceinline__ int sw256(int row, int cb) { return row * 256 + (cb ^ ((row & 15) << 4)); }
__device__ __forceinline__ int sw128(int row, int cb) { return row * 128 + (cb ^ ((((row & 7) ^ (row >> 4)) & 7) << 4)); }
__device__ __forceinline__ int crow(int r, int hi) { return (r & 3) + 8 * (r >> 2) + 4 * hi; }
__device__ __forceinline__ float h2f(unsigned short b) { return (float)__builtin_bit_cast(_Float16, b); }
__device__ __forceinline__ void gla_item(const bf16_t* __restrict__ Qp, const unsigned short* __restrict__ LFp, const bf16_t* __restrict__ Vp, bf16_t* __restrict__ Op, int dir, LAS unsigned char* lds, float* dbg) {
    int tid_ = threadIdx.x; asm volatile("" : "+v"(tid_));
    const int tid = tid_, wid = tid >> 6, lane = tid & 63, r = lane & 31, hh = lane >> 5;
    const int t1 = tid >> 3, kg = tid & 7, k0 = 16 * kg, v0 = (tid & 7) * 8;
    for (int i = tid; i < 16384 / 16; i += NTHR) *(LAS u32x4*)(lds + ST + i * 16) = (u32x4){0u, 0u, 0u, 0u};
    f32x16 st = {};
    u32x4 rq[2], rl[2], rv;
#define GLA_TOK(ci, i) (dir ? (SEQ - 1 - ((ci) * 64 + (i))) : ((ci) * 64 + (i)))
#define GLA_LOAD(ci) do { const size_t to = (size_t)GLA_TOK(ci, t1) * DM; \
        rq[0] = *(const u32x4*)(Qp + to + k0); rq[1] = *(const u32x4*)(Qp + to + k0 + 8); \
        rl[0] = *(const u32x4*)(LFp + to + k0); rl[1] = *(const u32x4*)(LFp + to + k0 + 8); rv = *(const u32x4*)(Vp + to + v0); } while (0)
    GLA_LOAD(0);
    __syncthreads();
    for (int ci = 0; ci < SEQ / 64; ++ci) {
        float qf[16], lf[16]; u32x4 vreg = rv;
#pragma unroll
        for (int j = 0; j < 2; ++j)
#pragma unroll
            for (int e = 0; e < 4; ++e) { qf[j * 8 + 2 * e] = bflo(rq[j][e]); qf[j * 8 + 2 * e + 1] = bfhi(rq[j][e]);
                lf[j * 8 + 2 * e] = h2f((unsigned short)(rl[j][e] & 0xffffu)); lf[j * 8 + 2 * e + 1] = h2f((unsigned short)(rl[j][e] >> 16)); }
        if (ci + 1 < SEQ / 64) GLA_LOAD(ci + 1);
#pragma unroll
        for (int j = 0; j < 4; ++j) *(LAS f32x4*)(lds + BC + (t1 * 128 + k0 + 4 * j) * 4) = (f32x4){lf[4 * j], lf[4 * j + 1], lf[4 * j + 2], lf[4 * j + 3]};
        __syncthreads();
        { const int kc = tid & 127, sg = tid >> 7; LAS float* bc = (LAS float*)(lds + BC) + kc; float cs[16];
#pragma unroll
            for (int i = 0; i < 16; ++i) cs[i] = bc[(sg * 16 + i) * 128];
#pragma unroll
            for (int i = 1; i < 16; ++i) cs[i] += cs[i - 1];
            ((LAS float*)(lds + SEG))[sg * 128 + kc] = cs[15];
            __syncthreads();
            const LAS float* sgp = (const LAS float*)(lds + SEG) + kc; const float s0 = sgp[0], s1 = sgp[128], s2 = sgp[256], s3 = sgp[384];
            const float off = sg == 0 ? 0.f : sg == 1 ? s0 : sg == 2 ? (s0 + s1) : ((s0 + s1) + s2);
#pragma unroll
            for (int i = 0; i < 16; ++i) bc[(sg * 16 + i) * 128] = cs[i] + off;
            if (sg == 0) { const float bm = s0 + s1, bl = ((s0 + s1) + s2) + s3;
                ((LAS float*)(lds + BMID))[kc] = bm; ((LAS float*)(lds + EM))[kc] = fexp(bm); ((LAS float*)(lds + EL))[kc] = fexp(bl - bm); ((LAS float*)(lds + DD))[kc] = fexp(bl); }
            __syncthreads();
        }
#ifdef DIAG
        if (dbg && ci == 0) { for (int i = tid; i < 8192; i += NTHR) dbg[i] = ((const LAS float*)(lds + BC))[i]; }
#endif
        {
            unsigned wqi[8], wqa[8], wka[8]; float ksv[16];
#pragma unroll
            for (int j = 0; j < 4; ++j) {
                const f32x4 bt = *(const LAS f32x4*)(lds + BC + (t1 * 128 + k0 + 4 * j) * 4), bm = *(const LAS f32x4*)(lds + BMID + (k0 + 4 * j) * 4);
                const f32x4 em = *(const LAS f32x4*)(lds + EM + (k0 + 4 * j) * 4), el = *(const LAS f32x4*)(lds + EL + (k0 + 4 * j) * 4);
                float qi[4], qa[4], ka[4];
#pragma unroll
                for (int e = 0; e < 4; ++e) { const int i = 4 * j + e; const float e1 = fexp(bt[e] - bm[e]), r1 = frcp(e1);
                    qa[e] = qf[i] * e1; qi[e] = qa[e] * em[e]; const float kk = 1.0f - fexp(lf[i]); ka[e] = kk * r1; ksv[i] = ka[e] * el[e]; }
                wqi[2 * j] = cvt_pk_bf16(qi[0], qi[1]); wqi[2 * j + 1] = cvt_pk_bf16(qi[2], qi[3]);
                wqa[2 * j] = cvt_pk_bf16(qa[0], qa[1]); wqa[2 * j + 1] = cvt_pk_bf16(qa[2], qa[3]);
                wka[2 * j] = cvt_pk_bf16(ka[0], ka[1]); wka[2 * j + 1] = cvt_pk_bf16(ka[2], ka[3]);
            }
#pragma unroll
            for (int j = 0; j < 2; ++j) { const int off = sw256(t1, (k0 + 8 * j) * 2);
                *(LAS u32x4*)(lds + QI + off) = (u32x4){wqi[4 * j], wqi[4 * j + 1], wqi[4 * j + 2], wqi[4 * j + 3]};
                *(LAS u32x4*)(lds + QA + off) = (u32x4){wqa[4 * j], wqa[4 * j + 1], wqa[4 * j + 2], wqa[4 * j + 3]};
                *(LAS u32x4*)(lds + KA + off) = (u32x4){wka[4 * j], wka[4 * j + 1], wka[4 * j + 2], wka[4 * j + 3]}; }
#pragma unroll
            for (int i = 0; i < 16; ++i) *(LAS unsigned short*)(lds + KST + sw128(k0 + i, t1 * 2)) = (unsigned short)f2bf(ksv[i]);
#pragma unroll
            for (int e = 0; e < 4; ++e) { *(LAS unsigned short*)(lds + VT + sw128(v0 + 2 * e, t1 * 2)) = (unsigned short)(vreg[e] & 0xffffu);
                *(LAS unsigned short*)(lds + VT + sw128(v0 + 2 * e + 1, t1 * 2)) = (unsigned short)(vreg[e] >> 16); }
        }
        __syncthreads();
        f32x16 oacc = {};
        const int w4 = wid & 3, t_i = w4 >> 1, v_i = w4 & 1;
        if (wid < 4) {
            const int s_i = wid >> 1, tq = wid & 1; f32x16 a = {};
#pragma unroll
            for (int ks = 0; ks < 8; ++ks) { const bf16x8 fa = *(const LAS bf16x8*)(lds + KA + sw256(32 * s_i + r, (16 * ks + 8 * hh) * 2)), fb = *(const LAS bf16x8*)(lds + QA + sw256(32 * tq + r, (16 * ks + 8 * hh) * 2));
                a = __builtin_amdgcn_mfma_f32_32x32x16_bf16(fa, fb, a, 0, 0, 0); }
            const int tg = 32 * tq + r;
#pragma unroll
            for (int g = 0; g < 4; ++g) { float m[4];
#pragma unroll
                for (int e = 0; e < 4; ++e) { const int sgl = 32 * s_i + 8 * g + 4 * hh + e; m[e] = (sgl <= tg) ? a[4 * g + e] : 0.f; }
                *(LAS u32x2*)(lds + AT + sw128(tg, (32 * s_i + 8 * g + 4 * hh) * 2)) = (u32x2){cvt_pk_bf16(m[0], m[1]), cvt_pk_bf16(m[2], m[3])}; }
        } else {
#pragma unroll
            for (int ks = 0; ks < 8; ++ks) { const bf16x8 fa = *(const LAS bf16x8*)(lds + QI + sw256(32 * t_i + r, (16 * ks + 8 * hh) * 2)), fb = *(const LAS bf16x8*)(lds + ST + sw256(32 * v_i + r, (16 * ks + 8 * hh) * 2));
                oacc = __builtin_amdgcn_mfma_f32_32x32x16_bf16(fa, fb, oacc, 0, 0, 0); }
        }
        __syncthreads();
#ifdef DIAG
        if (dbg && ci == 0) { for (int i = tid; i < 2048; i += NTHR) { ((unsigned*)dbg)[8192 + i] = ((const LAS unsigned*)(lds + AT))[i]; ((unsigned*)dbg)[8192 + 2048 + i] = ((const LAS unsigned*)(lds + VT))[i]; } }
#endif
        if (wid >= 4) {
#pragma unroll
            for (int ks = 0; ks < 4; ++ks) { const bf16x8 fa = *(const LAS bf16x8*)(lds + AT + sw128(32 * t_i + r, (16 * ks + 8 * hh) * 2)), fb = *(const LAS bf16x8*)(lds + VT + sw128(32 * v_i + r, (16 * ks + 8 * hh) * 2));
                oacc = __builtin_amdgcn_mfma_f32_32x32x16_bf16(fa, fb, oacc, 0, 0, 0); }
#pragma unroll
            for (int i = 0; i < 16; ++i) { const int t = 32 * t_i + crow(i, hh); Op[(size_t)GLA_TOK(ci, t) * DM + 32 * v_i + r] = (bf16_t)f2bf(oacc[i]); }
        }
        {
            const int kq = wid >> 1, vq = wid & 1;
#pragma unroll
            for (int i = 0; i < 16; ++i) st[i] *= ((const LAS float*)(lds + DD))[32 * kq + crow(i, hh)];
#pragma unroll
            for (int ks = 0; ks < 4; ++ks) { const bf16x8 fa = *(const LAS bf16x8*)(lds + KST + sw128(32 * kq + r, (16 * ks + 8 * hh) * 2)), fb = *(const LAS bf16x8*)(lds + VT + sw128(32 * vq + r, (16 * ks + 8 * hh) * 2));
                st = __builtin_amdgcn_mfma_f32_32x32x16_bf16(fa, fb, st, 0, 0, 0); }
#pragma unroll
            for (int g = 0; g < 4; ++g) *(LAS u32x2*)(lds + ST + sw256(32 * vq + r, (32 * kq + 8 * g + 4 * hh) * 2)) = (u32x2){cvt_pk_bf16(st[4 * g], st[4 * g + 1]), cvt_pk_bf16(st[4 * g + 2], st[4 * g + 3])};
        }
        __syncthreads();
#ifdef DIAG
        if (dbg && ci == 0) { for (int i = tid; i < 4096; i += NTHR) { ((unsigned*)dbg)[12288 + i] = ((const LAS unsigned*)(lds + ST))[i]; ((unsigned*)dbg)[16384 + i] = ((const LAS unsigned*)(lds + KST))[i]; } }
#endif
    }
#undef GLA_TOK
#undef GLA_LOAD
}
}
__device__ __forceinline__ void gla_phase(const Args& A, LAS unsigned char* lds, int bid, int G) {
    unsigned char* ws = A.ws;
    for (int it = bid; it < 256; it += G) {
        const int b = it >> 5, h = (it >> 2) & 7, dir = (it >> 1) & 1, vh = it & 1;
        const size_t base = (size_t)b * SEQ * DM + h * 128;
        gla::gla_item((const bf16_t*)(ws + H_Q) + base, (const unsigned short*)(ws + (dir ? H_LFB : H_LFF)) + base, (const bf16_t*)(ws + H_V) + base + vh * 64,
                      (bf16_t*)(ws + (dir ? H_OB : H_OF)) + base + vh * 64, dir, lds, it == 0 ? (float*)(ws + TB_LSUM) : nullptr);
    }
}
__device__ __forceinline__ void hg_normo_phase(const Args& A, int bid, int G) {
    int tid_ = threadIdx.x; asm volatile("" : "+v"(tid_));
    const int tid = tid_, lane = tid & 63, wave = tid >> 6; unsigned char* ws = A.ws;
    const bf16_t* OF = (const bf16_t*)(ws + H_OF); const bf16_t* OB = (const bf16_t*)(ws + H_OB); const bf16_t* GG = (const bf16_t*)(ws + H_G); bf16_t* HM = (bf16_t*)(ws + WS_HM);
    const int c0 = (lane >> 3) * 128 + (lane & 7) * 16;
    float ng[16];
#pragma unroll
    for (int i = 0; i < 16; ++i) ng[i] = A.in[I_HGNG][(lane & 7) * 16 + i];
    for (int row = (bid * NWAVES + wave); row < MTOK; row += G * NWAVES) {
        const size_t o = (size_t)row * DM + c0;
        const u32x4 a0 = *(const u32x4*)(OF + o), a1 = *(const u32x4*)(OF + o + 8), b0 = *(const u32x4*)(OB + o), b1 = *(const u32x4*)(OB + o + 8), g0 = *(const u32x4*)(GG + o), g1 = *(const u32x4*)(GG + o + 8);
        float v[16], gt[16]; float ss = 0.f;
#pragma unroll
        for (int e = 0; e < 4; ++e) { v[2 * e] = bflo(a0[e]) + bflo(b0[e]); v[2 * e + 1] = bfhi(a0[e]) + bfhi(b0[e]); v[8 + 2 * e] = bflo(a1[e]) + bflo(b1[e]); v[8 + 2 * e + 1] = bfhi(a1[e]) + bfhi(b1[e]);
            gt[2 * e] = bflo(g0[e]); gt[2 * e + 1] = bfhi(g0[e]); gt[8 + 2 * e] = bflo(g1[e]); gt[8 + 2 * e + 1] = bfhi(g1[e]); }
#pragma unroll
        for (int i = 0; i < 16; ++i) ss += v[i] * v[i];
        ss += __shfl_xor(ss, 1); ss += __shfl_xor(ss, 2); ss += __shfl_xor(ss, 4);
        const float rstd = 1.0f / sqrtf(ss * (1.0f / 128.0f) + EPS);
        u32x4 w0, w1;
#pragma unroll
        for (int e = 0; e < 4; ++e) { w0[e] = cvt_pk_bf16(v[2 * e] * rstd * ng[2 * e] * gt[2 * e], v[2 * e + 1] * rstd * ng[2 * e + 1] * gt[2 * e + 1]);
            w1[e] = cvt_pk_bf16(v[8 + 2 * e] * rstd * ng[8 + 2 * e] * gt[8 + 2 * e], v[8 + 2 * e + 1] * rstd * ng[8 + 2 * e + 1] * gt[8 + 2 * e + 1]); }
        *(u32x4*)(HM + o) = w0; *(u32x4*)(HM + o + 8) = w1;
    }
}

#ifdef DIAG
constexpr int DG_BASE = 8192;
__device__ __forceinline__ void dg_put(const Args& A, int k, float e) { if (!(e >= 0.f) || e > 1e9f) e = 1e9f; atomicMax((unsigned*)(A.ws + WS_CTL) + DG_BASE + 64 * k, __float_as_uint(e)); }
__device__ __forceinline__ float dg_rel(float got, float ref) { return fabsf(got - ref) / (fabsf(ref) + 0.1f); }
__device__ __forceinline__ unsigned dg_hash(unsigned a, unsigned b) { unsigned h = a * 2654435761u + b * 40503u + 0x9e3779b9u; h ^= h >> 15; h *= 2246822519u; h ^= h >> 13; h *= 3266489917u; h ^= h >> 16; return h; }
__device__ __forceinline__ float dg_bfr(float x) { return bflo(f2bf(x)); }
__device__ __forceinline__ void dg_mods(const Args& A, int k) {
    const int lane = threadIdx.x & 63, gwv = blockIdx.x * 8 + (threadIdx.x >> 6);
    const unsigned h = dg_hash(gwv, k); const int l = h & 3, b = (h >> 2) & 7, e = (h >> 5) % 6144;
    float a = 0.f; for (int d = lane; d < DM; d += 64) a += fsilu(A.in[I_C][b * DM + d]) * A.in[I_ADAW][((size_t)l * DM + d) * 6144 + e];
    a = wave_sum(a) + A.in[I_ADAB][l * 6144 + e];
    const float got = ((const float*)(A.ws + TB_MODS))[((size_t)l * NBATCH + b) * 6144 + e];
    if (lane == 0) dg_put(A, k, dg_rel(got, a));
}
__device__ __forceinline__ void dg_norm(const Args& A, int k, const float* x, const float* gain, int L, int which) {
    const int lane = threadIdx.x & 63, gwv = blockIdx.x * 8 + (threadIdx.x >> 6);
    const int row = dg_hash(gwv, k) & (MTOK - 1), b = row >> 13;
    const float* modl = (const float*)(A.ws + TB_MODS) + ((size_t)L * NBATCH + b) * 6144;
    float ss = 0.f; for (int c = lane; c < DM; c += 64) { const float v = x[(size_t)row * DM + c]; ss += v * v; }
    ss = wave_sum(ss); const float rstd = 1.0f / sqrtf(ss / DM + EPS); float e = 0.f;
    for (int c = lane; c < DM; c += 64) { const float ref = x[(size_t)row * DM + c] * rstd * gain[c] * (1.0f + modl[(which * 3 + 1) * 1024 + c]) + modl[(which * 3) * 1024 + c];
        e = fmaxf(e, dg_rel(bf2f(((const bf16_t*)(A.ws + WS_HM))[(size_t)row * DM + c]), ref)); }
    dg_put(A, k, e);
}
__device__ __forceinline__ void dg_qkv(const Args& A, int k, int al) {
    const int lane = threadIdx.x & 63, gwv = blockIdx.x * 8 + (threadIdx.x >> 6);
    const unsigned h = dg_hash(gwv, k); const int row = h & (MTOK - 1), t = (h >> 16) % 48, col = t * 64 + lane;
    const bf16_t* hm = (const bf16_t*)(A.ws + WS_HM) + (size_t)row * DM; const float* w = A.in[I_ATWIN] + (size_t)al * 1024 * 3072 + col;
    float a = 0.f; for (int kk = 0; kk < DM; ++kk) a += bf2f(hm[kk]) * dg_bfr(w[(size_t)kk * 3072]);
    float ref, got;
    if (t < 32) {
        const int part = t >> 4, sh = t & 15; const float ss = wave_sum(a * a); const float rstd = 1.0f / sqrtf(ss / 64.0f + EPS);
        const float y = a * rstd * (part ? A.in[I_ATKN] : A.in[I_ATQN])[al * 64 + lane]; const float yp = __shfl_xor(y, 32);
        const int pos = row & (SEQ - 1); const float cs = ((const float*)(A.ws + TB_COS))[pos * 32 + (lane & 31)], sn = ((const float*)(A.ws + TB_SIN))[pos * 32 + (lane & 31)];
        ref = (lane < 32) ? (y * cs - yp * sn) : (y * cs + yp * sn); if (part == 0) ref *= 0.125f * LOG2E;
        got = bf2f(((const bf16_t*)(A.ws + (part ? A_K : A_Q)))[(size_t)row * DM + sh * 64 + lane]);
    } else { ref = a; got = bf2f(((const bf16_t*)(A.ws + A_V))[(size_t)row * DM + (t - 32) * 64 + lane]); }
    dg_put(A, k, dg_rel(got, ref));
}
__device__ __forceinline__ void dg_attn(const Args& A, int k, int al, LAS unsigned char* lds) {
    const int tid = threadIdx.x; const unsigned h = dg_hash(blockIdx.x, k); const int row = h & (MTOK - 1), hd = (h >> 16) & 7, b = row >> 13;
    const bf16_t* Q = (const bf16_t*)(A.ws + A_Q); const bf16_t* K = (const bf16_t*)(A.ws + A_K); const bf16_t* V = (const bf16_t*)(A.ws + A_V);
    const float* scal = (const float*)(A.ws + TB_SCAL); const float lamv = scal[SC_LAM0 + al], omli = scal[SC_OML0 + al], Mc = scal[SC_MC0 + al];
    LAS float* p0 = (LAS float*)lds; LAS float* p1 = p0 + SEQ; LAS float* red = p1 + SEQ;
    float l0 = 0.f, l1 = 0.f;
    for (int key = tid; key < SEQ; key += NTHR) { const bf16_t* kr = K + ((size_t)b * SEQ + key) * DM + hd * 128; const bf16_t* qr = Q + (size_t)row * DM + hd * 128;
        float s0 = 0.f, s1 = 0.f; for (int d = 0; d < 64; ++d) { s0 += bf2f(qr[d]) * bf2f(kr[d]); s1 += bf2f(qr[64 + d]) * bf2f(kr[64 + d]); }
        const float e0 = fexp2(s0 - Mc), e1 = fexp2(s1 - Mc); p0[key] = e0; p1[key] = e1; l0 += e0; l1 += e1; }
    l0 = wave_sum(l0); l1 = wave_sum(l1); if ((tid & 63) == 0) { red[tid >> 6] = l0; red[8 + (tid >> 6)] = l1; }
    __syncthreads();
    l0 = 0.f; l1 = 0.f; for (int w = 0; w < 8; ++w) { l0 += red[w]; l1 += red[8 + w]; }
    __syncthreads();
    const int dv = tid & 127, part = tid >> 7; float o = 0.f;
    for (int key = part * 2048; key < part * 2048 + 2048; ++key) o += (p0[key] / l0 - lamv * p1[key] / l1) * bf2f(V[((size_t)b * SEQ + key) * DM + hd * 128 + dv]);
    red[16 + part * 128 + dv] = o; __syncthreads();
    if (tid < 128) { o = red[16 + tid] + red[16 + 128 + tid] + red[16 + 256 + tid] + red[16 + 384 + tid]; red[600 + tid] = o * o; }
    __syncthreads();
    if (tid < 128) { float ss = 0.f; for (int i = 0; i < 128; ++i) ss += red[600 + i]; const float ref = o / sqrtf(ss / 128.0f + EPS) * A.in[I_ATSUB][al * 128 + tid] * omli;
        dg_put(A, k, dg_rel(bf2f(((const bf16_t*)(A.ws + WS_HM))[(size_t)row * DM + hd * 128 + tid]), ref)); }
    __syncthreads();
}
__device__ __forceinline__ void dg_save(const Args& A, int k, const float* xold) {
    const int lane = threadIdx.x & 63, gwv = blockIdx.x * 8 + (threadIdx.x >> 6);
    const unsigned h = dg_hash(gwv, k); const int row = h & (MTOK - 1), col = (h >> 16) & 1023;
    float* sv = (float*)(A.ws + TB_LSUM) + 7 * 1024 * 1024 / 4;
    if (lane == 0) sv[k * 4096 + gwv] = xold[(size_t)row * DM + col];
}
__device__ __forceinline__ void dg_res(const Args& A, int k, const float* xnew, const float* gate, const bf16_t* Am, int K, const float* W) {
    const int lane = threadIdx.x & 63, gwv = blockIdx.x * 8 + (threadIdx.x >> 6);
    const unsigned h = dg_hash(gwv, k); const int row = h & (MTOK - 1), col = (h >> 16) & 1023, b = row >> 13;
    const float* sv = (const float*)(A.ws + TB_LSUM) + 7 * 1024 * 1024 / 4;
    float a = 0.f; for (int kk = lane; kk < K; kk += 64) a += bf2f(Am[(size_t)row * K + kk]) * dg_bfr(W[(size_t)kk * DM + col]);
    a = wave_sum(a);
    const float ref = sv[k * 4096 + gwv] + gate[(size_t)b * 6144 + col] * a;
    if (lane == 0) dg_put(A, k, dg_rel(xnew[(size_t)row * DM + col], ref));
}
__device__ __forceinline__ void dg_swiglu(const Args& A, int k, const bf16_t* Am, const float* W, int F, const bf16_t* H, int nrows, const int* rowmap) {
    const int lane = threadIdx.x & 63, gwv = blockIdx.x * 8 + (threadIdx.x >> 6);
    const unsigned h = dg_hash(gwv, k); const int row = (h & 0xfffff) % nrows, j = (h >> 20) % F;
    float g = 0.f, u = 0.f; for (int kk = lane; kk < DM; kk += 64) { const float x = bf2f(Am[(size_t)row * DM + kk]); g += x * dg_bfr(W[(size_t)kk * 2 * F + j]); u += x * dg_bfr(W[(size_t)kk * 2 * F + F + j]); }
    g = wave_sum(g); u = wave_sum(u);
    const float ref = g / (1.0f + expf(-g)) * u;
    if (lane == 0) dg_put(A, k, dg_rel(bf2f(H[(size_t)row * F + j]), ref));
}
__device__ __forceinline__ void dg_hgin(const Args& A, int k) {
    const int lane = threadIdx.x & 63, gwv = blockIdx.x * 8 + (threadIdx.x >> 6);
    const unsigned h = dg_hash(gwv, k); const int row = h & (MTOK - 1), col = (h >> 16) % 5120, grp = col >> 10, cc = col & 1023;
    float a = 0.f; for (int kk = lane; kk < DM; kk += 64) a += bf2f(((const bf16_t*)(A.ws + WS_HM))[(size_t)row * DM + kk]) * dg_bfr(A.in[I_HGWIN][(size_t)kk * 5120 + col]);
    a = wave_sum(a);
    float ref, got;
    if (grp == 0 || grp == 4) { ref = a / (1.0f + expf(-a)); got = bf2f(((const bf16_t*)(A.ws + (grp == 0 ? H_Q : H_G)))[(size_t)row * DM + cc]); }
    else if (grp == 3) { ref = a; got = bf2f(((const bf16_t*)(A.ws + H_V))[(size_t)row * DM + cc]); }
    else { const int d = grp - 1; const float* p = A.in[I_HGLB] + (size_t)d * DEPTH * 1024 + cc; float mx = p[0]; for (int l = 1; l < DEPTH; ++l) mx = fmaxf(mx, p[l * 1024]);
        float den = 0.f; for (int l = 0; l < DEPTH; ++l) den += expf(p[l * 1024] - mx); const float lbv = expf(p[1024] - mx) / den;
        ref = logf(lbv + (1.0f - lbv) / (1.0f + expf(-a))); got = gla::h2f(((const unsigned short*)(A.ws + (d ? H_LFB : H_LFF)))[(size_t)row * DM + cc]); }
    if (lane == 0) dg_put(A, k, dg_rel(got, ref));
}
__device__ __forceinline__ void dg_gla(const Args& A, int k) {
    const int lane = threadIdx.x & 63, gwv = blockIdx.x * 8 + (threadIdx.x >> 6);
    const unsigned h = dg_hash(gwv, k); const int sel0 = (gwv & 3) == 0; const int b = sel0 ? 0 : (h & 7), hd = sel0 ? 0 : ((h >> 3) & 7), dir = sel0 ? 0 : ((h >> 6) & 1), vc = sel0 ? ((h >> 7) & 63) : ((h >> 7) & 127);
    const bf16_t* Q = (const bf16_t*)(A.ws + H_Q); const unsigned short* LF = (const unsigned short*)(A.ws + (dir ? H_LFB : H_LFF)); const bf16_t* V = (const bf16_t*)(A.ws + H_V);
    const bf16_t* O = (const bf16_t*)(A.ws + (dir ? H_OB : H_OF));
    float s0 = 0.f, s1 = 0.f, e0 = 0.f, e1 = 0.f, e2 = 0.f, e3 = 0.f;
    for (int i = 0; i < SEQ; ++i) { const int tok = dir ? (SEQ - 1 - i) : i; const size_t o = ((size_t)b * SEQ + tok) * DM + hd * 128;
        const float f0 = expf(gla::h2f(LF[o + lane])), f1 = expf(gla::h2f(LF[o + 64 + lane])), v = bf2f(V[o + vc]);
        s0 = f0 * s0 + (1.0f - f0) * v; s1 = f1 * s1 + (1.0f - f1) * v;
        if (i < 128 || i % 61 == 0) { const float ov = wave_sum(bf2f(Q[o + lane]) * s0 + bf2f(Q[o + 64 + lane]) * s1); const float er = 0.25f * fabsf(bf2f(O[o + vc]) - ov) / (fabsf(ov) + 1.0f);
            if (i == 0) e0 = er; else if (i < 64) e1 = fmaxf(e1, er); else if (i < 128) e2 = fmaxf(e2, er); else e3 = fmaxf(e3, er); } }
    if (lane == 0) { dg_put(A, k, e0); dg_put(A, k + 4, e1); dg_put(A, k + 5, e2); dg_put(A, k + 6, e3); }
    const float* dbg = (const float*)(A.ws + TB_LSUM); const unsigned short* LF0 = (const unsigned short*)(A.ws + H_LFF); const bf16_t* Q0 = (const bf16_t*)(A.ws + H_Q);
    { const unsigned h2 = dg_hash(gwv, k + 100); const int t = h2 & 63, kk = (h2 >> 6) & 127; float c = 0.f; for (int tt = 0; tt <= t; ++tt) c += gla::h2f(LF0[(size_t)tt * DM + kk]);
      if (lane == 0) dg_put(A, k + 1, dg_rel(dbg[t * 128 + kk], c)); }
    { const unsigned h2 = dg_hash(gwv, k + 200); const int t = h2 & 63, sidx = (h2 >> 6) & 63; float a = 0.f;
      if (sidx <= t) { for (int kk = lane; kk < 128; kk += 64) { float c = 0.f; for (int tt = sidx + 1; tt <= t; ++tt) c += gla::h2f(LF0[(size_t)tt * DM + kk]);
              a += bf2f(Q0[(size_t)t * DM + kk]) * (1.0f - expf(gla::h2f(LF0[(size_t)sidx * DM + kk]))) * expf(c); } a = wave_sum(a); }
      const unsigned short got = ((const unsigned short*)(dbg + 8192))[gla::sw128(t, sidx * 2) / 2];
      if (lane == 0) dg_put(A, k + 2, 5.0f * fabsf(bf2f(got) - a) / (fabsf(a) + 0.01f)); }
    { const unsigned h2 = dg_hash(gwv, k + 300); const int sidx = h2 & 63, v = (h2 >> 6) & 63;
      const unsigned short got = ((const unsigned short*)(dbg + 8192 + 2048))[gla::sw128(v, sidx * 2) / 2];
      if (lane == 0) dg_put(A, k + 2, dg_rel(bf2f(got), bf2f(((const bf16_t*)(A.ws + H_V))[(size_t)sidx * DM + v]))); }
    { const unsigned h2 = dg_hash(gwv, k + 500); const int kk = h2 & 127, v = (h2 >> 7) & 63;
      float a = 0.f; { const int sidx = lane; float c = 0.f; for (int tt = sidx + 1; tt < 64; ++tt) c += gla::h2f(LF0[(size_t)tt * DM + kk]);
          const float ksn = (1.0f - expf(gla::h2f(LF0[(size_t)sidx * DM + kk]))) * expf(c);
          const unsigned short gk = ((const unsigned short*)(dbg + 16384))[gla::sw128(kk, sidx * 2) / 2];
          dg_put(A, k + 2, 0.5f * fabsf(bf2f(gk) - ksn) / (fabsf(ksn) + 0.01f));
          a = ksn * bf2f(((const bf16_t*)(A.ws + H_V))[(size_t)sidx * DM + v]); }
      a = wave_sum(a);
      const unsigned short gs = ((const unsigned short*)(dbg + 12288))[gla::sw256(v, kk * 2) / 2];
      if (lane == 0) dg_put(A, k + 3, 0.5f * fabsf(bf2f(gs) - a) / (fabsf(a) + 0.05f)); }
    { const unsigned h2 = dg_hash(gwv, k + 400); const int t = h2 & 63, v = (h2 >> 6) & 63;
      const unsigned short* at = (const unsigned short*)(dbg + 8192); const unsigned short* vt = (const unsigned short*)(dbg + 8192 + 2048);
      float a = bf2f(at[gla::sw128(t, lane * 2) / 2]) * bf2f(vt[gla::sw128(v, lane * 2) / 2]); a = wave_sum(a);
      if (lane == 0) dg_put(A, k + 1, 5.0f * dg_rel(bf2f(((const bf16_t*)(A.ws + H_OF))[(size_t)t * DM + v]), a)); }
}
__device__ __forceinline__ void dg_normo(const Args& A, int k) {
    const int lane = threadIdx.x & 63, gwv = blockIdx.x * 8 + (threadIdx.x >> 6);
    const unsigned h = dg_hash(gwv, k); const int row = h & (MTOK - 1), hd = (h >> 16) & 7; const size_t o = (size_t)row * DM + hd * 128;
    const float v0 = bf2f(((const bf16_t*)(A.ws + H_OF))[o + lane]) + bf2f(((const bf16_t*)(A.ws + H_OB))[o + lane]), v1 = bf2f(((const bf16_t*)(A.ws + H_OF))[o + 64 + lane]) + bf2f(((const bf16_t*)(A.ws + H_OB))[o + 64 + lane]);
    const float ss = wave_sum(v0 * v0 + v1 * v1), rstd = 1.0f / sqrtf(ss / 128.0f + EPS);
    const float r0 = v0 * rstd * A.in[I_HGNG][lane] * bf2f(((const bf16_t*)(A.ws + H_G))[o + lane]), r1 = v1 * rstd * A.in[I_HGNG][64 + lane] * bf2f(((const bf16_t*)(A.ws + H_G))[o + 64 + lane]);
    dg_put(A, k, fmaxf(dg_rel(bf2f(((const bf16_t*)(A.ws + WS_HM))[o + lane]), r0), dg_rel(bf2f(((const bf16_t*)(A.ws + WS_HM))[o + 64 + lane]), r1)));
}
__device__ __forceinline__ void dg_router(const Args& A, int k, int L) {
    const int lane = threadIdx.x & 63, gwv = blockIdx.x * 8 + (threadIdx.x >> 6);
    const int row = dg_hash(gwv, k) & (MTOK - 1), b = row >> 13; const float* x = A.out + (size_t)row * DM;
    const float* modl = (const float*)(A.ws + TB_MODS) + ((size_t)L * NBATCH + b) * 6144; const float* gain = A.in[I_N2G] + L * DM; const float* R = A.in[I_MOER] + (size_t)(L >> 1) * DM * 8;
    float ss = 0.f; for (int c = lane; c < DM; c += 64) ss += x[c] * x[c];
    ss = wave_sum(ss); const float rstd = 1.0f / sqrtf(ss / DM + EPS);
    float lg[8]; for (int e = 0; e < 8; ++e) lg[e] = 0.f;
    for (int c = lane; c < DM; c += 64) { const float hv = x[c] * rstd * gain[c] * (1.0f + modl[4 * 1024 + c]) + modl[3 * 1024 + c]; for (int e = 0; e < 8; ++e) lg[e] += hv * R[c * 8 + e]; }
    for (int e = 0; e < 8; ++e) lg[e] = wave_sum(lg[e]);
    int e0 = 0; for (int e = 1; e < 8; ++e) if (lg[e] > lg[e0]) e0 = e;
    int e1 = (e0 == 0) ? 1 : 0; for (int e = 0; e < 8; ++e) if (e != e0 && lg[e] > lg[e1]) e1 = e;
    float gap = 1e9f; for (int e = 0; e < 8; ++e) if (e != e0 && e != e1) gap = fminf(gap, lg[e1] - lg[e]); gap = fminf(gap, lg[e0] - lg[e1]);
    const int g0 = ((const int*)(A.ws + TB_EID))[row * 2], g1 = ((const int*)(A.ws + TB_EID))[row * 2 + 1]; const float w0 = ((const float*)(A.ws + TB_GATE))[row * 2], w1 = ((const float*)(A.ws + TB_GATE))[row * 2 + 1];
    const float p0 = 1.0f / (1.0f + expf(lg[e1] - lg[e0]));
    float er = (g0 != e0 || g1 != e1) ? (gap > 2e-3f ? 9.f : 0.f) : fmaxf(fabsf(w0 - p0), fabsf(w1 - (1.0f - p0)));
    if (lane == 0) dg_put(A, k, er);
}
__device__ __forceinline__ void dg_place(const Args& A, int k) {
    const int lane = threadIdx.x & 63, gwv = blockIdx.x * 8 + (threadIdx.x >> 6);
    const unsigned h = dg_hash(gwv, k); const int row = h & (MTOK - 1), kk = (h >> 16) & 1;
    const int sl = ((const int*)(A.ws + TB_SLOT))[row * 2 + kk], e = ((const int*)(A.ws + TB_EID))[row * 2 + kk]; const int* ts = (const int*)(A.ws + TB_TILES);
    float er = (sl >= ts[e] * 256 && sl < ts[e + 1] * 256 && sl < MOE_ROWS) ? 0.f : 7.f;
    if (er == 0.f) for (int c = lane; c < DM; c += 64) if (((const bf16_t*)(A.ws + E_XS))[(size_t)sl * DM + c] != ((const bf16_t*)(A.ws + WS_HM))[(size_t)row * DM + c]) er = 5.f;
    dg_put(A, k, er);
}
__device__ __forceinline__ void dg_moe_hid(const Args& A, int k, int m) {
    const int lane = threadIdx.x & 63, gwv = blockIdx.x * 8 + (threadIdx.x >> 6);
    const unsigned h = dg_hash(gwv, k); const int row = h & (MTOK - 1), kk = (h >> 16) & 1, j = (h >> 17) % DFFE;
    const int sl = ((const int*)(A.ws + TB_SLOT))[row * 2 + kk], e = ((const int*)(A.ws + TB_EID))[row * 2 + kk];
    const float* W = A.in[I_MOEGU] + ((size_t)m * 8 + e) * DM * 2 * DFFE; const bf16_t* Am = (const bf16_t*)(A.ws + E_XS) + (size_t)sl * DM;
    float g = 0.f, u = 0.f; for (int c = lane; c < DM; c += 64) { const float x = bf2f(Am[c]); g += x * dg_bfr(W[(size_t)c * 2 * DFFE + j]); u += x * dg_bfr(W[(size_t)c * 2 * DFFE + DFFE + j]); }
    g = wave_sum(g); u = wave_sum(u);
    if (lane == 0) dg_put(A, k, dg_rel(bf2f(((const bf16_t*)(A.ws + E_HID))[(size_t)sl * DFFE + j]), g / (1.0f + expf(-g)) * u));
}
__device__ __forceinline__ void dg_moe_y(const Args& A, int k, int m) {
    const int lane = threadIdx.x & 63, gwv = blockIdx.x * 8 + (threadIdx.x >> 6);
    const unsigned h = dg_hash(gwv, k); const int row = h & (MTOK - 1), kk = (h >> 16) & 1, col = (h >> 17) & 1023;
    const int sl = ((const int*)(A.ws + TB_SLOT))[row * 2 + kk], e = ((const int*)(A.ws + TB_EID))[row * 2 + kk];
    const float* W = A.in[I_MOEDN] + ((size_t)m * 8 + e) * DFFE * DM; const bf16_t* Hh = (const bf16_t*)(A.ws + E_HID) + (size_t)sl * DFFE;
    float a = 0.f; for (int j = lane; j < DFFE; j += 64) a += bf2f(Hh[j]) * dg_bfr(W[(size_t)j * DM + col]);
    a = wave_sum(a);
    if (lane == 0) dg_put(A, k, fabsf(bf2f(((const bf16_t*)(A.ws + E_XS))[(size_t)sl * DM + col]) - a) / (fabsf(a) + 0.3f));
}
__device__ __forceinline__ void dg_combine(const Args& A, int k, const float* modprev) {
    const int lane = threadIdx.x & 63, gwv = blockIdx.x * 8 + (threadIdx.x >> 6);
    const unsigned h = dg_hash(gwv, k); const int row = h & (MTOK - 1), col = (h >> 16) & 1023, b = row >> 13;
    const float* sv = (const float*)(A.ws + TB_LSUM) + 7 * 1024 * 1024 / 4; const bf16_t* Y = (const bf16_t*)(A.ws + E_XS);
    const int s0 = ((const int*)(A.ws + TB_SLOT))[row * 2], s1 = ((const int*)(A.ws + TB_SLOT))[row * 2 + 1]; const float w0 = ((const float*)(A.ws + TB_GATE))[row * 2], w1 = ((const float*)(A.ws + TB_GATE))[row * 2 + 1];
    const float ref = sv[k * 4096 + gwv] + modprev[(size_t)b * 6144 + 5 * 1024 + col] * (w0 * bf2f(Y[(size_t)s0 * DM + col]) + w1 * bf2f(Y[(size_t)s1 * DM + col]));
    if (lane == 0) dg_put(A, k, dg_rel(A.out[(size_t)row * DM + col], ref));
}
__device__ __forceinline__ void dg_lruin(const Args& A, int k) {
    const int lane = threadIdx.x & 63, gwv = blockIdx.x * 8 + (threadIdx.x >> 6);
    const unsigned h = dg_hash(gwv, k); const int row = h & (MTOK - 1), col = (h >> 16) % 2560;
    float a = 0.f; for (int kk = lane; kk < DM; kk += 64) a += bf2f(((const bf16_t*)(A.ws + WS_HM))[(size_t)row * DM + kk]) * dg_bfr(A.in[I_LRWIN][(size_t)kk * 2560 + col]);
    a = wave_sum(a);
    float ref, got;
    if (col < LRUW) { ref = 0.5f * a * (1.0f + tanhf(0.7978845608028654f * (a + 0.044715f * a * a * a))); got = bf2f(((const bf16_t*)(A.ws + L_YB))[(size_t)row * LRUW + col]); }
    else { ref = a; got = bf2f(((const bf16_t*)(A.ws + L_XB))[(size_t)row * LRUW + col - LRUW]); }
    if (lane == 0) dg_put(A, k, dg_rel(got, ref));
}
__device__ __forceinline__ void dg_lru(const Args& A, int k) {
    const int lane = threadIdx.x & 63, gwv = blockIdx.x * 8 + (threadIdx.x >> 6);
    const unsigned h = dg_hash(gwv, k); const int b = h & 7, ch = (h >> 3) % LRUW, tc = (h >> 16) & (SEQ - 1), n = ch / 128, j = ch % 128;
    const bf16_t* XB = (const bf16_t*)(A.ws + L_XB) + (size_t)b * SEQ * LRUW;
    float hres[2];
    for (int d = 0; d < 2; ++d) {
        const float* wa = A.in[I_LRWA] + (size_t)(d * 10 + n) * 16384; const float* wx = A.in[I_LRWX] + (size_t)(d * 10 + n) * 16384;
        const float wa0 = dg_bfr(wa[lane * 128 + j]), wa1 = dg_bfr(wa[(lane + 64) * 128 + j]), wx0 = dg_bfr(wx[lane * 128 + j]), wx1 = dg_bfr(wx[(lane + 64) * 128 + j]);
        const float ba = A.in[I_LRBA][d * LRUW + ch], bx = A.in[I_LRBX][d * LRUW + ch]; const float lam = A.in[I_LRLAM][d * LRUW + ch]; const float sp = log1pf(expf(-lam));
        float hs = 0.f;
        for (int i = 0; ; ++i) { const int t = d ? (SEQ - 1 - i) : i;
            float x0 = A.in[I_LRCB][n * 128 + lane], x1 = A.in[I_LRCB][n * 128 + 64 + lane], xj = A.in[I_LRCB][ch];
            for (int w = 0; w < 4; ++w) { const int tt = t - 1 + w; if (tt >= 0 && tt < SEQ) {
                x0 += A.in[I_LRCW][w * LRUW + n * 128 + lane] * bf2f(XB[(size_t)tt * LRUW + n * 128 + lane]); x1 += A.in[I_LRCW][w * LRUW + n * 128 + 64 + lane] * bf2f(XB[(size_t)tt * LRUW + n * 128 + 64 + lane]);
                xj += A.in[I_LRCW][w * LRUW + ch] * bf2f(XB[(size_t)tt * LRUW + ch]); } }
            const float rp = wave_sum(dg_bfr(x0) * wa0 + dg_bfr(x1) * wa1), ip = wave_sum(dg_bfr(x0) * wx0 + dg_bfr(x1) * wx1);
            const float rg = 1.0f / (1.0f + expf(-(rp + ba))), ig = 1.0f / (1.0f + expf(-(ip + bx))); const float la = -8.0f * rg * sp;
            hs = expf(la) * hs + sqrtf(fmaxf(-expm1f(2.0f * la), 0.f)) * ig * xj;
            if (t == tc) break; }
        hres[d] = hs;
    }
    const size_t go = ((size_t)b * SEQ + tc) * LRUW + ch;
    const float e1 = fabsf(bf2f(((const bf16_t*)(A.ws + L_HF))[go]) - hres[0]) / (fabsf(hres[0]) + 0.3f);
    const float ref = (hres[0] + hres[1]) * bf2f(((const bf16_t*)(A.ws + L_YB))[go]);
    const float e2 = fabsf(bf2f(((const bf16_t*)(A.ws + L_HY))[go]) - ref) / (fabsf(ref) + 0.3f);
    if (lane == 0) { dg_put(A, k, e1); dg_put(A, k + 5, e2); }
}
__device__ __forceinline__ void dg_final(const Args& A, int nchk) {
    const unsigned* sl = (const unsigned*)(A.ws + WS_CTL) + DG_BASE; int code = 0; float ev = 0.f;
    for (int k = 1; k <= nchk; ++k) { const float e = __uint_as_float(sl[64 * k]); if (e > 0.05f) { code = k; ev = e; break; } }
    if (code == 0) return;
    const int c1 = code % 10, c10 = code / 10;
    const float s = -(float)c1;
    for (size_t i = (size_t)blockIdx.x * NTHR + threadIdx.x; i < (size_t)MTOK * DM; i += (size_t)gridDim.x * NTHR) A.out[i] = A.in[I_X][i] * s;
    __syncthreads();
    if (blockIdx.x == 0 && threadIdx.x == 0) { const int qq = ev < 0.1f ? 1 : ev < 0.2f ? 2 : ev < 0.5f ? 3 : ev < 1.f ? 4 : ev < 2.f ? 5 : ev < 5.f ? 6 : ev < 20.f ? 7 : ev < 1e3f ? 8 : 9;
        A.out[12345] = 100.f * (float)(10 * c10 + qq); }
}
#define DG(x) x
#define DGL(x) if constexpr (L >= DIAG_FROM) { x }
#else
#define DG(x)
#define DGL(x)
#endif

#define GRID_BAR() xcd_barrier(bar)
template <int L>
__device__ __forceinline__ void run_mixer(const Args& args, LAS unsigned char* lds, int bid, int G, const XcdBarrier& bar) {
    unsigned char* ws = args.ws; float* xo = args.out;
    const float* modl = (const float*)(ws + TB_MODS) + (size_t)L * NBATCH * 6144;
    const float* xs = (L == 0) ? args.in[I_X] : xo;
    constexpr int kind = L % 3;
    DGL(if (L > 0 && ((L - 1) & 1)) { dg_save(args, 10 * (L - 1) + 9, xo); GRID_BAR(); })
    norm_phase<false>(args, lds, bid, G, xs, xo, args.in[I_N1G] + L * DM, modl, 0, (L > 0) && ((L - 1) & 1), modl - NBATCH * 6144, false, nullptr);
    GRID_BAR();
    DGL(if (L > 0 && ((L - 1) & 1)) { dg_combine(args, 10 * (L - 1) + 9, modl - NBATCH * 6144); GRID_BAR(); })
    DGL(dg_norm(args, 10 * L + 1, (L > 0 && ((L - 1) & 1)) ? xo : xs, args.in[I_N1G] + L * DM, L, 0); GRID_BAR();)
    if constexpr (kind == 0) {
        constexpr int al = L / 3;
        {
            pg8::Gemm g{(const bf16_t*)(ws + WS_HM), (const bf16_t*)(ws + W_QKV) + (size_t)al * 3072 * 1024, 1024};
            pg8::TileOrder S; S.init(256, 12, G, bid);
            pg8::EpiQKV E{(bf16_t*)(ws + A_Q), (bf16_t*)(ws + A_K), (bf16_t*)(ws + A_V), args.in[I_ATQN] + al * 64, args.in[I_ATKN] + al * 64,
                          (const float*)(ws + TB_COS), (const float*)(ws + TB_SIN), LOG2E};
            pg8::gemm_phase<pg8::EpiQKV>(lds, g, S, E);
        }
        GRID_BAR();
        vt_phase(args, bid, G);
        GRID_BAR();
        attn_phase(args, lds, bid, G, al);
        GRID_BAR();
        DGL(dg_save(args, 10 * L + 4, xs); GRID_BAR();)
        {
            pg8::Gemm g{(const bf16_t*)(ws + WS_HM), (const bf16_t*)(ws + W_AO) + (size_t)al * 1024 * 1024, 1024};
            pg8::TileOrder S; S.init(256, 4, G, bid);
            pg8::EpiRes E{xs, xo, modl + 2 * 1024, 1.0f};
            pg8::gemm_phase<pg8::EpiRes>(lds, g, S, E);
        }
        GRID_BAR();
        DGL(dg_res(args, 10 * L + 4, xo, modl + 2 * 1024, (const bf16_t*)(ws + WS_HM), 1024, args.in[I_ATWOUT] + (size_t)al * 1024 * 1024); GRID_BAR();)
    }
    if constexpr (kind == 1) {
        {
            pg8::Gemm g{(const bf16_t*)(ws + WS_HM), (const bf16_t*)(ws + W_HGI), 1024};
            pg8::TileOrder S; S.init(256, 20, G, bid);
            pg8::EpiAct E{0, ws, (const float*)(ws + TB_LB)};
            pg8::gemm_phase<pg8::EpiAct>(lds, g, S, E);
        }
        GRID_BAR();
        DGL(dg_hgin(args, 10 * L + 2); GRID_BAR();)
        gla_phase(args, lds, bid, G);
        GRID_BAR();
        DGL(dg_gla(args, 10 * L + 3); GRID_BAR();)
        hg_normo_phase(args, bid, G);
        GRID_BAR();
        DGL(dg_normo(args, 10 * L + 0); GRID_BAR();)
        DGL(dg_save(args, 10 * L + 4, xs); GRID_BAR();)
        {
            pg8::Gemm g{(const bf16_t*)(ws + WS_HM), (const bf16_t*)(ws + W_HGO), 1024};
            pg8::TileOrder S; S.init(256, 4, G, bid);
            pg8::EpiRes E{xs, xo, modl + 2 * 1024, 1.0f};
            pg8::gemm_phase<pg8::EpiRes>(lds, g, S, E);
        }
        GRID_BAR();
        DGL(dg_res(args, 10 * L + 4, xo, modl + 2 * 1024, (const bf16_t*)(ws + WS_HM), 1024, args.in[I_HGWOUT]); GRID_BAR();)
    }
    if constexpr (kind == 2) {
        {
            pg8::Gemm g{(const bf16_t*)(ws + WS_HM), (const bf16_t*)(ws + W_LRI), 1024};
            pg8::TileOrder S; S.init(256, 10, G, bid);
            pg8::EpiAct E{1, ws, nullptr};
            pg8::gemm_phase<pg8::EpiAct>(lds, g, S, E);
        }
        GRID_BAR();
        DGL(dg_lruin(args, 10 * L + 2); GRID_BAR();)
        lru_phase<0>(args, lds, bid, G);
        GRID_BAR();
        lru_carry_phase(args, bid, G);
        GRID_BAR();
        lru_phase<1>(args, lds, bid, G);
        GRID_BAR();
        lru_phase<2>(args, lds, bid, G);
        GRID_BAR();
        DGL(dg_lru(args, 10 * L + 3); GRID_BAR();)
        DGL(dg_save(args, 10 * L + 4, xs); GRID_BAR();)
        {
            pg8::Gemm g{(const bf16_t*)(ws + L_HY), (const bf16_t*)(ws + W_LRO), LRUW};
            pg8::TileOrder S; S.init(256, 4, G, bid);
            pg8::EpiRes E{xs, xo, modl + 2 * 1024, 1.0f};
            pg8::gemm_phase<pg8::EpiRes>(lds, g, S, E);
        }
        GRID_BAR();
        DGL(dg_res(args, 10 * L + 4, xo, modl + 2 * 1024, (const bf16_t*)(ws + L_HY), LRUW, args.in[I_LRWOUT]); GRID_BAR();)
    }
}
template <int L>
__device__ __forceinline__ void run_ffn(const Args& args, LAS unsigned char* lds, int bid, int G, const XcdBarrier& bar) {
    unsigned char* ws = args.ws; float* xo = args.out;
    const float* modl = (const float*)(ws + TB_MODS) + (size_t)L * NBATCH * 6144;
    if constexpr ((L & 1) == 0) {
        constexpr int m = L >> 1;
        constexpr bool F8 = (L >= FP8_DENSE_FROM);
        norm_phase<false>(args, lds, bid, G, xo, xo, args.in[I_N2G] + L * DM, modl, 1, false, modl, false, nullptr, F8);
        GRID_BAR();
        if constexpr (F8) {
            pg8::Gemm g{(const bf16_t*)(ws + WS_HM), (const bf16_t*)(ws + W_FGU) + (size_t)m * 5632 * 1024, 512};
            pg8::TileOrder S; S.init(256, 22, G, bid);
            pg8::EpiSwiGLU8 E{ws + F_HID, DFF, 1.0f / MOE_WSCALE, MOE_HSCALE};
            pg8::gemm_phase<pg8::EpiSwiGLU8, true>(lds, g, S, E);
        } else {
            pg8::Gemm g{(const bf16_t*)(ws + WS_HM), (const bf16_t*)(ws + W_FGU) + (size_t)m * 5632 * 1024, 1024};
            pg8::TileOrder S; S.init(256, 22, G, bid);
            pg8::EpiSwiGLU E{(bf16_t*)(ws + F_HID), DFF};
            pg8::gemm_phase<pg8::EpiSwiGLU>(lds, g, S, E);
        }
        GRID_BAR();
        if constexpr (F8) {
            pg8::Gemm g{(const bf16_t*)(ws + F_HID), (const bf16_t*)(ws + W_FDN) + (size_t)m * 1024 * 2816, DFF / 2};
            pg8::TileOrder S; S.init(256, 4, G, bid);
            pg8::EpiRes E{xo, xo, modl + 5 * 1024, 1.0f / (MOE_WSCALE * MOE_HSCALE)};
            pg8::gemm_phase<pg8::EpiRes, true>(lds, g, S, E);
        } else {
            pg8::Gemm g{(const bf16_t*)(ws + F_HID), (const bf16_t*)(ws + W_FDN) + (size_t)m * 1024 * 2816, DFF};
            pg8::TileOrder S; S.init(256, 4, G, bid);
            pg8::EpiRes E{xo, xo, modl + 5 * 1024, 1.0f};
            pg8::gemm_phase<pg8::EpiRes>(lds, g, S, E);
        }
        GRID_BAR();
    } else {
        constexpr int m = L >> 1;
        norm_phase<true>(args, lds, bid, G, xo, xo, args.in[I_N2G] + L * DM, modl, 1, false, modl, false, args.in[I_MOER] + (size_t)m * DM * 8);
        GRID_BAR();
        DGL(dg_norm(args, 10 * L + 5, xo, args.in[I_N2G] + L * DM, L, 1); dg_router(args, 10 * L + 5, L); GRID_BAR();)
        place_phase(args, lds, bid, G);
        GRID_BAR();
        DGL(dg_place(args, 10 * L + 6); GRID_BAR();)
        const int* tiles = (const int*)(ws + TB_TILES);
        {
            pg8::Gemm g{(const bf16_t*)(ws + E_XS), (const bf16_t*)(ws + W_MGU + (size_t)m * 8 * 7168 * 1024), 512};
            pg8::TileOrder S; S.init(tiles[8], 28, G, bid);
#pragma unroll
            for (int e = 1; e < NEXP; ++e) S.ts[e] = tiles[e];
            pg8::EpiSwiGLU8 E{ws + E_HID, DFFE, 1.0f / MOE_WSCALE, MOE_HSCALE};
            pg8::gemm_phase<pg8::EpiSwiGLU8, true>(lds, g, S, E);
        }
        GRID_BAR();
        DGL(dg_moe_hid(args, 10 * L + 7, m); GRID_BAR();)
        {
            pg8::Gemm g{(const bf16_t*)(ws + E_HID), (const bf16_t*)(ws + W_MDN + (size_t)m * 8 * 1024 * 3584), DFFE / 2};
            pg8::TileOrder S; S.init(tiles[8], 4, G, bid);
#pragma unroll
            for (int e = 1; e < NEXP; ++e) S.ts[e] = tiles[e];
            pg8::EpiPlain E{(bf16_t*)(ws + E_XS), DM, 1.0f / (MOE_WSCALE * MOE_HSCALE)};
            pg8::gemm_phase<pg8::EpiPlain, true>(lds, g, S, E);
        }
        GRID_BAR();
        DGL(dg_moe_y(args, 10 * L + 8, m); GRID_BAR();)
    }
}
__device__ __forceinline__ void final_combine(const Args& args, LAS unsigned char* lds, int bid, int G, const XcdBarrier& bar) {
    const float* modl = (const float*)(args.ws + TB_MODS) + (size_t)3 * NBATCH * 6144;
    DG(dg_save(args, 39, args.out); GRID_BAR();)
    norm_phase<false>(args, lds, bid, G, args.out, args.out, args.in[I_N1G], modl, 0, true, modl, true, nullptr);
    DG(GRID_BAR(); dg_combine(args, 39, modl);)
}

__global__ void __launch_bounds__(NTHR, 2) mega_fwd(Args args) {
    extern __shared__ __attribute__((aligned(16))) unsigned char lds_raw[];
    LAS unsigned char* lds = (LAS unsigned char*)lds_raw;
    const int tid = threadIdx.x, bid = blockIdx.x, G = gridDim.x;
    unsigned char* ws = args.ws;
    volatile LAS unsigned* MISC = (volatile LAS unsigned*)(lds + MISC_OFF);
    if (tid < 64) MISC[tid] = 0u;
    __syncthreads();
    XcdBarrier bar = xcd_barrier_post((unsigned*)(ws + WS_CTL) + CW_BAR, MISC + 8);

    prologue_phase(args, lds, bid, G);
    GRID_BAR();

    run_mixer<0>(args, lds, bid, G, bar);
    run_ffn<0>(args, lds, bid, G, bar);
    run_mixer<1>(args, lds, bid, G, bar);
    run_ffn<1>(args, lds, bid, G, bar);
    run_mixer<2>(args, lds, bid, G, bar);
    run_ffn<2>(args, lds, bid, G, bar);
    run_mixer<3>(args, lds, bid, G, bar);
    run_ffn<3>(args, lds, bid, G, bar);
    final_combine(args, lds, bid, G, bar);
    DG(GRID_BAR(); dg_final(args, 49);)
}

extern "C" void kernel_launch(void* const* d_in, const int* in_sizes, int n_in, void* d_out, int out_size, void* d_ws, size_t ws_size, hipStream_t stream) {
    static int grid = 0;
    if (grid == 0) {
        if (n_in != 30 || out_size != MTOK * DM || ws_size < WS_NEED) { fprintf(stderr, "kernel_launch: unexpected shapes (n_in %d out %d ws %zu need %zu)\n", n_in, out_size, ws_size, (size_t)WS_NEED); grid = -1; return; }
        int dev = 0, cus = 0;
        if (hipGetDevice(&dev) != hipSuccess || hipDeviceGetAttribute(&cus, hipDeviceAttributeMultiprocessorCount, dev) != hipSuccess) { grid = -1; return; }
        if (hipFuncSetAttribute((const void*)mega_fwd, hipFuncAttributeMaxDynamicSharedMemorySize, LDS_BYTES) != hipSuccess) { fprintf(stderr, "kernel_launch: hipFuncSetAttribute failed\n"); grid = -1; return; }
        int per_cu = 0;
        if (hipOccupancyMaxActiveBlocksPerMultiprocessor(&per_cu, (const void*)mega_fwd, NTHR, LDS_BYTES) != hipSuccess || per_cu < 1) { fprintf(stderr, "kernel_launch: occupancy query says %d\n", per_cu); }
        (void)hipGetLastError();
        grid = (cus >= 256) ? 256 : -1;
        if (grid < 0) { fprintf(stderr, "kernel_launch: needs 256 CUs, device has %d\n", cus); return; }
    }
    if (grid < 0) return;
    if (hipMemsetAsync((char*)d_ws + WS_CTL, 0, CTL_ZERO_BYTES, stream) != hipSuccess) return;
    Args a{};
    for (int i = 0; i < 30; ++i) a.in[i] = (const float*)d_in[i];
    a.out = (float*)d_out; a.ws = (unsigned char*)d_ws;
    hipLaunchKernelGGL(mega_fwd, dim3(grid), dim3(NTHR), LDS_BYTES, stream, a);
}
```

```cpp
#define DIAG_FROM 2
#include <hip/hip_runtime.h>
#include <cstdio>
#include <cstdint>

#define LAS __attribute__((address_space(3)))
#define GAS __attribute__((address_space(1)))
typedef unsigned short bf16_t;
typedef short bf16x8 __attribute__((ext_vector_type(8)));
typedef short s16x4 __attribute__((ext_vector_type(4)));
typedef float f32x2 __attribute__((ext_vector_type(2)));
typedef float f32x4 __attribute__((ext_vector_type(4)));
typedef float f32x16 __attribute__((ext_vector_type(16)));
typedef unsigned u32x2 __attribute__((ext_vector_type(2)));
typedef unsigned u32x4 __attribute__((ext_vector_type(4)));

constexpr int MTOK = 65536, DM = 1024, SEQ = 8192, NBATCH = 8, DEPTH = 4;
constexpr int DFF = 2816, DFFE = 3584, NEXP = 8, LRUW = 1280;
constexpr float EPS = 1e-6f;
constexpr int FP8_DENSE_FROM = 2;
constexpr float MOE_WSCALE = 64.0f, MOE_HSCALE = 4.0f;
constexpr float LOG2E = 1.4426950408889634f;

constexpr size_t MiB = 1u << 20;
constexpr size_t WS_CTL = 0, CTL_ZERO_BYTES = 1 * MiB;
constexpr size_t WS_TAB = 1 * MiB;
constexpr size_t TB_MODS = WS_TAB;
constexpr size_t TB_COS = WS_TAB + 1 * MiB;
constexpr size_t TB_SIN = WS_TAB + 2 * MiB;
constexpr size_t TB_SCAL = WS_TAB + 3 * MiB;
constexpr size_t TB_LB = TB_SCAL + 4096;
constexpr size_t TB_SP = TB_SCAL + 16384;
constexpr size_t TB_EID = WS_TAB + 4 * MiB;
constexpr size_t TB_GATE = WS_TAB + 5 * MiB;
constexpr size_t TB_SLOT = WS_TAB + 6 * MiB;
constexpr size_t TB_BCNT = WS_TAB + 7 * MiB;
constexpr size_t TB_TILES = TB_BCNT + 16384;
constexpr size_t TB_LSUM = WS_TAB + 8 * MiB;
constexpr size_t TB_LCIN = WS_TAB + 16 * MiB;
constexpr size_t WS_W = 32 * MiB;
constexpr size_t W_QKV = WS_W;
constexpr size_t W_AO = W_QKV + 2 * (size_t)3072 * 1024 * 2;
constexpr size_t W_HGI = W_AO + 2 * (size_t)1024 * 1024 * 2;
constexpr size_t W_HGO = W_HGI + (size_t)5120 * 1024 * 2;
constexpr size_t W_LRI = W_HGO + (size_t)1024 * 1024 * 2;
constexpr size_t W_LRG = W_LRI + (size_t)2560 * 1024 * 2;
constexpr size_t W_LRO = W_LRG + (size_t)10 * 2 * 256 * 128 * 2;
constexpr size_t W_FGU = W_LRO + (size_t)1024 * 1280 * 2;
constexpr size_t W_FDN = W_FGU + 2 * (size_t)5632 * 1024 * 2;
constexpr size_t W_MGU = W_FDN + 2 * (size_t)1024 * 2816 * 2;
constexpr size_t W_MDN = W_MGU + 16 * (size_t)7168 * 1024 * 2;
constexpr size_t W_END = W_MDN + 16 * (size_t)1024 * 3584 * 2;
constexpr size_t WS_HM = 440 * MiB;
constexpr size_t WS_ACT = 568 * MiB;
static_assert(W_END <= WS_HM, "weights overflow");
constexpr size_t SZ_TOK = (size_t)MTOK * 1024 * 2;
constexpr size_t A_Q = WS_ACT, A_K = A_Q + SZ_TOK, A_V = A_K + SZ_TOK, A_VT = A_V + SZ_TOK;
constexpr size_t F_HID = WS_ACT;
constexpr size_t H_Q = WS_ACT, H_LFF = H_Q + SZ_TOK, H_LFB = H_LFF + SZ_TOK, H_V = H_LFB + SZ_TOK, H_G = H_V + SZ_TOK, H_OF = H_G + SZ_TOK, H_OB = H_OF + SZ_TOK;
constexpr size_t SZ_LRU = (size_t)MTOK * 1280 * 2;
constexpr size_t L_YB = WS_ACT, L_XB = L_YB + SZ_LRU, L_HF = L_XB + SZ_LRU, L_HY = L_HF + SZ_LRU;
constexpr int MOE_ROWS = 2 * MTOK + NEXP * 256;
constexpr size_t E_XS = WS_ACT, E_HID = E_XS + (size_t)MOE_ROWS * 1024 * 2, E_END = E_HID + (size_t)MOE_ROWS * DFFE;
constexpr size_t WS_XB = 1536 * MiB;
static_assert(E_END <= WS_XB && H_OB + SZ_TOK <= WS_XB && L_HY + SZ_LRU <= WS_XB && A_VT + SZ_TOK <= WS_XB, "activation regions below the residual stream");
constexpr size_t WS_NEED = WS_XB + SZ_TOK;
static_assert(WS_NEED <= (size_t)1792 * MiB, "workspace");

constexpr int CW_BAR = 4096;

constexpr int RING_BYTES = 135168;
constexpr int MISC_OFF = RING_BYTES;
constexpr int LDS_BYTES = 147456;
constexpr int NWAVES = 8, NTHR = 512;

typedef __bf16 bf16x2v __attribute__((ext_vector_type(2)));
__device__ __forceinline__ unsigned cvt_pk_bf16(float lo, float hi) { const f32x2 v = {lo, hi}; const bf16x2v b = __builtin_convertvector(v, bf16x2v); return __builtin_bit_cast(unsigned, b); }
__device__ __forceinline__ unsigned pk_fp8x4(float a, float b, float c, float d) { unsigned w = 0; w = __builtin_amdgcn_cvt_pk_fp8_f32(a, b, w, false); w = __builtin_amdgcn_cvt_pk_fp8_f32(c, d, w, true); return w; }
__device__ __forceinline__ unsigned f2bf(float f) { unsigned u = __builtin_bit_cast(unsigned, f); return (u + 0x7fffu + ((u >> 16) & 1u)) >> 16; }
__device__ __forceinline__ float bf2f(unsigned short b) { return __builtin_bit_cast(float, ((unsigned)b) << 16); }
__device__ __forceinline__ float bflo(unsigned w) { return __builtin_bit_cast(float, w << 16); }
__device__ __forceinline__ float bfhi(unsigned w) { return __builtin_bit_cast(float, w & 0xffff0000u); }
__device__ __forceinline__ float fexp2(float x) { return __builtin_amdgcn_exp2f(x); }
__device__ __forceinline__ float fexp(float x) { return __builtin_amdgcn_exp2f(x * LOG2E); }
__device__ __forceinline__ float frcp(float x) { return __builtin_amdgcn_rcpf(x); }
__device__ __forceinline__ float fsigmoid(float x) { return frcp(1.0f + fexp(-x)); }
__device__ __forceinline__ float fsilu(float x) { return x * fsigmoid(x); }
__device__ __forceinline__ float wave_sum(float v) {
#pragma unroll
    for (int o = 1; o < 64; o <<= 1) v += __shfl_xor(v, o);
    return v;
}
#define LDS_WAIT() asm volatile("s_waitcnt lgkmcnt(0)" ::: "memory")
#define VM_WAIT() asm volatile("s_waitcnt vmcnt(0)" ::: "memory")

#define XB_TMO      128
#define XB_XCNT(j)  (256  + 64 * (j))
#define XB_XSUB(j)  (1280 + 64 * (j))
#define XB_XGEN(j)  (2304 + 64 * (j))
#define XB_TOP      3328
#define XB_TOPGEN   3392
#define XCD_BAR_WORDS 3456
#define XB_SPIN_CAP (1u << 22)
__device__ __forceinline__ unsigned xb_ld(unsigned* p)              { return __hip_atomic_load(p, __ATOMIC_RELAXED, __HIP_MEMORY_SCOPE_AGENT); }
__device__ __forceinline__ unsigned xb_add(unsigned* p, unsigned v) { return __hip_atomic_fetch_add(p, v, __ATOMIC_RELAXED, __HIP_MEMORY_SCOPE_AGENT); }
__device__ __forceinline__ unsigned xb_xcc_id() { return (unsigned)__builtin_amdgcn_s_getreg((3 << 11) | 20) & 0xFu; }
#define XB_SPIN(cond, bar) do { unsigned _sp = 0; while (cond) { __builtin_amdgcn_s_sleep(1); \
    if ((++_sp & 255u) == 0u) { if (xb_ld(&(bar)[XB_TMO])) break; if (_sp > XB_SPIN_CAP) { atomicAdd(&(bar)[XB_TMO], 1u); break; } } } } while (0)
struct XcdBarrier { unsigned* bar; unsigned x; volatile LAS unsigned* st; };
__device__ __forceinline__ XcdBarrier xcd_barrier_post(unsigned* bar, volatile LAS unsigned* st) {
    XcdBarrier b; b.bar = bar; b.x = xb_xcc_id(); b.st = st;
    if (threadIdx.x == 0) (void)xb_add(&bar[XB_XCNT(b.x)], 1u);
    return b;
}
__device__ __forceinline__ void xcd_barrier_complete(unsigned* bar, unsigned x, unsigned& nloc, unsigned& nx) {
    const unsigned G = gridDim.x * gridDim.y * gridDim.z;
    unsigned sum, cnt, mine, sp = 0u;
    for (;;) {
        sum = 0u; cnt = 0u; mine = 0u;
#pragma unroll
        for (unsigned j = 0; j < 16; ++j) { const unsigned c = xb_ld(&bar[XB_XCNT(j)]); sum += c; cnt += (c > 0u) ? 1u : 0u; mine = (j == x) ? c : mine; }
        if (sum == G) break;
        __builtin_amdgcn_s_sleep(1);
        if ((++sp & 255u) == 0u) { if (xb_ld(&bar[XB_TMO])) break; if (sp > XB_SPIN_CAP) { atomicAdd(&bar[XB_TMO], 1u); break; } }
    }
    nloc = mine > 0u ? mine : 1u; nx = cnt > 0u ? cnt : 1u;
}
__device__ __forceinline__ void xcd_barrier(const XcdBarrier& b) {
    asm volatile("s_waitcnt vmcnt(0)" ::: "memory");
    __syncthreads();
    if (threadIdx.x == 0) {
        unsigned* bar = b.bar;
        __builtin_amdgcn_s_waitcnt(0);
        unsigned nloc = b.st[0], nx = b.st[1];
        if (nloc == 0u) { xcd_barrier_complete(bar, b.x, nloc, nx); b.st[0] = nloc; b.st[1] = nx; }
        const unsigned old = xb_add(&bar[XB_XSUB(b.x)], 1u);
        const unsigned gen = old / nloc;
        if (old + 1u == (gen + 1u) * nloc) {
            __builtin_amdgcn_fence(__ATOMIC_RELEASE, "agent");
            asm volatile("s_waitcnt vmcnt(0)" ::: "memory");
            const unsigned og = xb_add(&bar[XB_TOP], 1u);
            const unsigned tg = og / nx;
            if (og + 1u == (tg + 1u) * nx) xb_add(&bar[XB_TOPGEN], 1u);
            else XB_SPIN(xb_ld(&bar[XB_TOPGEN]) == tg, bar);
            __builtin_amdgcn_fence(__ATOMIC_ACQUIRE, "agent");
            xb_add(&bar[XB_XGEN(b.x)], 1u);
            asm volatile("s_waitcnt vmcnt(0)" ::: "memory");
        } else {
            XB_SPIN(xb_ld(&bar[XB_XGEN(b.x)]) == gen, bar);
            __builtin_amdgcn_fence(__ATOMIC_ACQUIRE, "agent");
            asm volatile("s_waitcnt vmcnt(0)" ::: "memory");
        }
    }
    __syncthreads();
}

namespace pg8 {
constexpr int BM = 256, BK = 64, HALF = 128, HTB = HALF * BK * 2, STAGE_BYTES = 8 * HTB, NXCD = 8, WGM = 8;
__host__ __device__ __forceinline__ int lds_byte(int r, int c) { const int st = (r >> 4) * 2 + (c >> 5), rr = r & 15, cc = c & 31, ob = rr * 64 + cc * 2; return st * 1024 + (ob ^ (((ob >> 9) & 1) << 5)); }
__host__ __device__ __forceinline__ void stage_rc(int b, int& R, int& C) { const int st = b / 1024, sb = b % 1024, swz = sb ^ (((sb >> 9) & 1) << 5); R = (st >> 1) * 16 + swz / 64; C = (st & 1) * 32 + (swz % 64) / 2; }
__host__ __device__ __forceinline__ int perm32(int rho) { const int n = rho >> 4, i = rho & 15; return 8 * (i >> 2) + 4 * n + (i & 3); }

struct Unit { int pm, pn, pb; };
struct Gemm { const bf16_t* A; const bf16_t* Bt; int K; };

struct TileOrder {
    int nM, nN, nwg, G, c; int ts[NEXP];
    __device__ __forceinline__ void init(int nM_, int nN_, int G_, int c_) { nM = nM_; nN = nN_; nwg = nM * nN; G = G_; c = c_;
#pragma unroll
        for (int e = 0; e < NEXP; ++e) ts[e] = (e == 0) ? 0 : 0x7fffffff; }
    __device__ __forceinline__ bool next(int i, Unit& u) const {
        const long L = (long)i * G + c; if (L >= nwg) return false;
        int wgid = (int)L; { const int q = nwg / NXCD, r = nwg % NXCD, xcd = wgid % NXCD, off = wgid / NXCD; wgid = (xcd < r ? xcd * (q + 1) : r * (q + 1) + (xcd - r) * q) + off; }
        const int nig = WGM * nN, gid = wgid / nig, fm = gid * WGM, gsz = (nM - fm) < WGM ? (nM - fm) : WGM;
        u.pm = fm + ((wgid % nig) % gsz); u.pn = (wgid % nig) / gsz;
        int e = 0;
#pragma unroll
        for (int k = 1; k < NEXP; ++k) e += (u.pm >= ts[k]) ? 1 : 0;
        u.pb = e * nN + u.pn; return true;
    }
};

typedef int v8i32 __attribute__((ext_vector_type(8)));
template <class Epi, bool FP8 = false>
__device__ __forceinline__ void gemm_phase(LAS unsigned char* lds, const Gemm g, const TileOrder& S, const Epi& E) {
    int tid_ = threadIdx.x; asm volatile("" : "+v"(tid_));
    const int tid = tid_, wid = __builtin_amdgcn_readfirstlane(tid >> 6), lane = tid & 63, wr = wid >> 2, wc = wid & 3, fr = lane & 15, fq = lane >> 4;
    const int K = g.K, nt = K / BK;
    unsigned voffA[2], voffB[2];
#pragma unroll
    for (int i = 0; i < 2; ++i) { int R, C; stage_rc(tid * 16 + i * 8192, R, C); const int Rb = Epi::PERM ? ((R & ~31) + perm32(R & 31)) : R;
        voffA[i] = (unsigned)(R * K + C) * 2u; voffB[i] = (unsigned)(Rb * K + C) * 2u; }
    const size_t kstep = (size_t)(BK * 2);
    const size_t hstep = (size_t)HALF * K * 2;
    const size_t tstep = 2 * hstep;
    const unsigned ldsw = (unsigned)wid * 1024u;
    const int aoff = lds_byte(wr * 64 + fr, fq * 8), boff = lds_byte(wc * 32 + fr, fq * 8);
#define PG8_SA(b, h) (((b) * 2 + (h)) * HTB)
#define PG8_SB(b, h) ((4 + (b) * 2 + (h)) * HTB)
#define PG8_STAGE(bufoff, gbase, voff) do { _Pragma("unroll") for (int _i = 0; _i < 2; ++_i) \
        __builtin_amdgcn_global_load_lds((const unsigned*)((const char*)(gbase) + (voff)[_i]), (LAS unsigned*)(lds + (bufoff) + ldsw + _i * 8192), 16, 0, 0); } while (0)
#define PG8_LD8(p) __builtin_bit_cast(v8i32, __builtin_shufflevector(*(const LAS u32x4*)(p), *(const LAS u32x4*)((p) + 1024), 0, 1, 2, 3, 4, 5, 6, 7))
#define PG8_LDA(dst, b, h) do { if constexpr (FP8) { _Pragma("unroll") for (int m = 0; m < 4; ++m) dst##8[m] = PG8_LD8(lds + PG8_SA(b, h) + aoff + m * 2048); } \
        else { _Pragma("unroll") for (int m = 0; m < 4; ++m) _Pragma("unroll") for (int k = 0; k < 2; ++k) dst[m][k] = *(const LAS bf16x8*)(lds + PG8_SA(b, h) + aoff + m * 2048 + k * 1024); } } while (0)
#define PG8_LDB(dst, b, h) do { if constexpr (FP8) { _Pragma("unroll") for (int n = 0; n < 2; ++n) dst##8[n] = PG8_LD8(lds + PG8_SB(b, h) + boff + n * 2048); } \
        else { _Pragma("unroll") for (int n = 0; n < 2; ++n) _Pragma("unroll") for (int k = 0; k < 2; ++k) dst[n][k] = *(const LAS bf16x8*)(lds + PG8_SB(b, h) + boff + n * 2048 + k * 1024); } } while (0)
#define PG8_MMA(ai, bj, At, Bt) do { __builtin_amdgcn_s_setprio(1); \
        if constexpr (FP8) { _Pragma("unroll") for (int m = 0; m < 4; ++m) _Pragma("unroll") for (int n = 0; n < 2; ++n) \
            asm volatile("v_mfma_scale_f32_16x16x128_f8f6f4 %0, %1, %2, %0, %3, %3 op_sel_hi:[0,0,0]" : "+v"(acc[ai][bj][m][n]) : "v"(Bt##8[n]), "v"(At##8[m]), "v"(one_scale)); } \
        else { _Pragma("unroll") for (int m = 0; m < 4; ++m) _Pragma("unroll") for (int n = 0; n < 2; ++n) _Pragma("unroll") for (int k = 0; k < 2; ++k) \
            acc[ai][bj][m][n] = __builtin_amdgcn_mfma_f32_16x16x32_bf16(Bt[n][k], At[m][k], acc[ai][bj][m][n], 0, 0, 0); } \
        __builtin_amdgcn_s_setprio(0); } while (0)
#define PG8_WAIT_V(n) asm volatile("s_waitcnt vmcnt(" #n ")" ::: "memory")
#define PG8_WAIT_L(n) asm volatile("s_waitcnt lgkmcnt(" #n ")" ::: "memory")
#define PG8_BAR __builtin_amdgcn_s_barrier()
#define PG8_SCHED __builtin_amdgcn_sched_barrier(0)
    Unit cur, nxt; int ui = 0;
    if (!S.next(0, cur)) return;
    f32x4 acc[2][2][4][2];
#pragma unroll
    for (int a = 0; a < 2; ++a)
#pragma unroll
        for (int b = 0; b < 2; ++b)
#pragma unroll
            for (int m = 0; m < 4; ++m)
#pragma unroll
                for (int n = 0; n < 2; ++n) acc[a][b][m][n] = (f32x4){0.f, 0.f, 0.f, 0.f};
    bf16x8 At[4][2], B0[2][2], B1[2][2]; v8i32 At8[4], B08[2], B18[2];
    int one_scale = 0x7f7f7f7f; asm volatile("" : "+v"(one_scale));
    const char* cA = (const char*)g.A + (size_t)cur.pm * tstep; const char* cB = (const char*)g.Bt + (size_t)cur.pb * tstep;
    PG8_STAGE(PG8_SB(0, 0), cB, voffB); PG8_STAGE(PG8_SA(0, 0), cA, voffA); PG8_STAGE(PG8_SB(0, 1), cB + hstep, voffB); PG8_STAGE(PG8_SA(0, 1), cA + hstep, voffA);
    if (wr == 1) PG8_BAR;
    PG8_WAIT_V(4); PG8_BAR;
    PG8_STAGE(PG8_SB(1, 0), cB + kstep, voffB); PG8_STAGE(PG8_SA(1, 0), cA + kstep, voffA); PG8_STAGE(PG8_SB(1, 1), cB + hstep + kstep, voffB);
    PG8_WAIT_V(6); PG8_BAR;
    for (;;) {
        const bool has_next = S.next(ui + 1, nxt);
        const char* nA = has_next ? (const char*)g.A + (size_t)nxt.pm * tstep : cA; const char* nB = has_next ? (const char*)g.Bt + (size_t)nxt.pb * tstep : cB;
        for (int t = 0; t < nt; t += 2) {
            const bool last = (t == nt - 2);
            const char* a1 = cA + (size_t)(t + 1) * kstep;
            const char* a2 = last ? nA : cA + (size_t)(t + 2) * kstep; const char* b2 = last ? nB : cB + (size_t)(t + 2) * kstep;
            const char* a3 = a2 + kstep; const char* b3 = b2 + kstep;
            PG8_LDB(B0, 0, 0); PG8_SCHED; PG8_LDA(At, 0, 0); PG8_STAGE(PG8_SA(1, 1), a1 + hstep, voffA);
            PG8_WAIT_L(8); PG8_BAR; PG8_WAIT_L(0); PG8_MMA(0, 0, At, B0); PG8_BAR; PG8_SCHED;
            PG8_LDB(B1, 0, 1); PG8_STAGE(PG8_SB(0, 0), b2, voffB);
            PG8_BAR; PG8_WAIT_L(0); PG8_MMA(0, 1, At, B1); PG8_BAR;
            PG8_LDA(At, 0, 1); PG8_STAGE(PG8_SA(0, 0), a2, voffA);
            PG8_BAR; PG8_WAIT_L(0); PG8_MMA(1, 0, At, B0); PG8_BAR; PG8_SCHED;
            PG8_STAGE(PG8_SB(0, 1), b2 + hstep, voffB);
            PG8_WAIT_V(6); PG8_BAR; PG8_MMA(1, 1, At, B1); PG8_BAR;
            PG8_LDB(B0, 1, 0); PG8_SCHED; PG8_LDA(At, 1, 0); PG8_STAGE(PG8_SA(0, 1), a2 + hstep, voffA);
            PG8_WAIT_L(8); PG8_BAR; PG8_WAIT_L(0); PG8_MMA(0, 0, At, B0); PG8_BAR; PG8_SCHED;
            PG8_LDB(B1, 1, 1); PG8_STAGE(PG8_SB(1, 0), b3, voffB);
            PG8_BAR; PG8_WAIT_L(0); PG8_MMA(0, 1, At, B1); PG8_BAR;
            PG8_LDA(At, 1, 1); PG8_STAGE(PG8_SA(1, 0), a3, voffA);
            PG8_BAR; PG8_WAIT_L(0); PG8_MMA(1, 0, At, B0); PG8_BAR; PG8_SCHED;
            PG8_STAGE(PG8_SB(1, 1), b3 + hstep, voffB);
            PG8_WAIT_V(6); PG8_BAR; PG8_MMA(1, 1, At, B1); PG8_BAR;
        }
        if constexpr (FP8) asm volatile("s_nop 15\n\ts_nop 15" ::: "memory");
        E(acc, cur, wr, wc, fr, fq);
        if (!has_next) break;
#pragma unroll
        for (int a = 0; a < 2; ++a)
#pragma unroll
            for (int b = 0; b < 2; ++b)
#pragma unroll
                for (int m = 0; m < 4; ++m)
#pragma unroll
                    for (int n = 0; n < 2; ++n) acc[a][b][m][n] = (f32x4){0.f, 0.f, 0.f, 0.f};
        cur = nxt; cA = nA; cB = nB; ++ui;
    }
    PG8_WAIT_V(0);
    if (wr == 0) PG8_BAR;
    PG8_BAR;
#undef PG8_SA
#undef PG8_SB
#undef PG8_STAGE
#undef PG8_LDA
#undef PG8_LDB
#undef PG8_MMA
#undef PG8_LD8
#undef PG8_WAIT_V
#undef PG8_WAIT_L
#undef PG8_BAR
#undef PG8_SCHED
}

struct EpiQKV {
    static constexpr bool PERM = true;
    bf16_t *Q, *Kk, *V; const float *gq, *gk, *cosT, *sinT; float qscale;
    __device__ __forceinline__ void operator()(const f32x4 (&acc)[2][2][4][2], const Unit& u, int wr, int wc, int fr, int fq) const {
        const int row0 = u.pm * BM + wr * 64 + fr;
        if (u.pn >= 8) {
            const int col0 = (u.pn - 8) * BM + wc * 32 + 8 * fq;
#pragma unroll
            for (int ai = 0; ai < 2; ++ai)
#pragma unroll
                for (int m = 0; m < 4; ++m) { bf16_t* rowp = V + (size_t)(row0 + ai * HALF + m * 16) * DM + col0;
#pragma unroll
                    for (int bj = 0; bj < 2; ++bj) { const f32x4 v0 = acc[ai][bj][m][0], v1 = acc[ai][bj][m][1];
                        u32x4 w; w.x = cvt_pk_bf16(v0[0], v0[1]); w.y = cvt_pk_bf16(v0[2], v0[3]); w.z = cvt_pk_bf16(v1[0], v1[1]); w.w = cvt_pk_bf16(v1[2], v1[3]);
                        *(u32x4*)(rowp + bj * HALF) = w; } }
        } else {
            const int part = u.pn >> 2, sh = 4 * (u.pn & 3) + wc;
            bf16_t* dst = part ? Kk : Q; const float* g = part ? gk : gq; const float sc = part ? 1.0f : qscale;
            f32x4 g0[2], g1[2];
#pragma unroll
            for (int n = 0; n < 2; ++n) { g0[n] = *(const f32x4*)(g + 8 * fq + 4 * n); g1[n] = *(const f32x4*)(g + 32 + 8 * fq + 4 * n); }
#pragma unroll
            for (int ai = 0; ai < 2; ++ai)
#pragma unroll
                for (int m = 0; m < 4; ++m) {
                    const int r = row0 + ai * HALF + m * 16; const int pos = r & (SEQ - 1);
                    f32x4 x1[2], x2[2]; float ss = 0.f;
#pragma unroll
                    for (int n = 0; n < 2; ++n) { x1[n] = acc[ai][0][m][n]; x2[n] = acc[ai][1][m][n];
                        ss += (x1[n][0] * x1[n][0] + x1[n][1] * x1[n][1]) + (x1[n][2] * x1[n][2] + x1[n][3] * x1[n][3]);
                        ss += (x2[n][0] * x2[n][0] + x2[n][1] * x2[n][1]) + (x2[n][2] * x2[n][2] + x2[n][3] * x2[n][3]); }
                    ss += __shfl_xor(ss, 16); ss += __shfl_xor(ss, 32);
                    const float rstd = __builtin_amdgcn_rsqf(ss * (1.0f / 64.0f) + EPS) ;
                    unsigned char* op = (unsigned char*)dst + (size_t)r * DM + sh * 64 + 8 * fq;
                    u32x2 w1, w2;
#pragma unroll
                    for (int n = 0; n < 2; ++n) {
                        const f32x4 cs = *(const f32x4*)(cosT + pos * 32 + 8 * fq + 4 * n), sn = *(const f32x4*)(sinT + pos * 32 + 8 * fq + 4 * n);
                        const f32x4 y1 = x1[n] * rstd * g0[n], y2 = x2[n] * rstd * g1[n];
                        const f32x4 o1 = (y1 * cs - y2 * sn) * sc, o2 = (y2 * cs + y1 * sn) * sc;
                        if (n == 0) { w1.x = pk_fp8x4(o1[0], o1[1], o1[2], o1[3]); w2.x = pk_fp8x4(o2[0], o2[1], o2[2], o2[3]); }
                        else { w1.y = pk_fp8x4(o1[0], o1[1], o1[2], o1[3]); w2.y = pk_fp8x4(o2[0], o2[1], o2[2], o2[3]); }
                    }
                    *(u32x2*)(op) = w1; *(u32x2*)(op + 32) = w2;
                }
        }
    }
};
__device__ __forceinline__ f32x4 ld_x4(const void* p, size_t i, bool is16) {
    if (is16) { const u32x2 w = *(const u32x2*)((const bf16_t*)p + i); return (f32x4){bflo(w.x), bfhi(w.x), bflo(w.y), bfhi(w.y)}; }
    return *(const f32x4*)((const float*)p + i);
}
template <bool IN16>
struct EpiRes {
    static constexpr bool PERM = false;
    const void* xin; bf16_t* xout; const float* gate; float sc;
    __device__ __forceinline__ void operator()(const f32x4 (&acc)[2][2][4][2], const Unit& u, int wr, int wc, int fr, int fq) const {
        const int row0 = u.pm * BM + wr * 64 + fr, col0 = u.pn * BM + wc * 32 + 4 * fq;
        const float* gp = gate + (size_t)(u.pm >> 5) * 6144 + col0;
        f32x4 gv[2][2];
#pragma unroll
        for (int bj = 0; bj < 2; ++bj)
#pragma unroll
            for (int n = 0; n < 2; ++n) gv[bj][n] = *(const f32x4*)(gp + bj * HALF + n * 16) * sc;
#pragma unroll
        for (int ai = 0; ai < 2; ++ai)
#pragma unroll
            for (int m = 0; m < 4; ++m) { const size_t off = (size_t)(row0 + ai * HALF + m * 16) * DM + col0;
                f32x4 xv[2][2];
#pragma unroll
                for (int bj = 0; bj < 2; ++bj)
#pragma unroll
                    for (int n = 0; n < 2; ++n) xv[bj][n] = ld_x4(xin, off + bj * HALF + n * 16, IN16);
#pragma unroll
                for (int bj = 0; bj < 2; ++bj)
#pragma unroll
                    for (int n = 0; n < 2; ++n) { const f32x4 o = xv[bj][n] + gv[bj][n] * acc[ai][bj][m][n];
                        *(u32x2*)(xout + off + bj * HALF + n * 16) = (u32x2){cvt_pk_bf16(o[0], o[1]), cvt_pk_bf16(o[2], o[3])}; }
                if (m == 3) asm volatile("" ::: "memory"); }
    }
};
struct EpiSwiGLU {
    static constexpr bool PERM = true;
    bf16_t* H; int ldh;
    __device__ __forceinline__ void operator()(const f32x4 (&acc)[2][2][4][2], const Unit& u, int wr, int wc, int fr, int fq) const {
        const int row0 = u.pm * BM + wr * 64 + fr, col0 = u.pn * HALF + wc * 32 + 8 * fq;
#pragma unroll
        for (int ai = 0; ai < 2; ++ai)
#pragma unroll
            for (int m = 0; m < 4; ++m) { bf16_t* rowp = H + (size_t)(row0 + ai * HALF + m * 16) * ldh + col0;
                f32x4 v[2];
#pragma unroll
                for (int n = 0; n < 2; ++n) { const f32x4 gt = acc[ai][0][m][n], up = acc[ai][1][m][n];
#pragma unroll
                    for (int j = 0; j < 4; ++j) v[n][j] = fsilu(gt[j]) * up[j]; }
                u32x4 w; w.x = cvt_pk_bf16(v[0][0], v[0][1]); w.y = cvt_pk_bf16(v[0][2], v[0][3]); w.z = cvt_pk_bf16(v[1][0], v[1][1]); w.w = cvt_pk_bf16(v[1][2], v[1][3]);
                *(u32x4*)rowp = w; }
    }
};
struct EpiSwiGLU8 {
    static constexpr bool PERM = true;
    unsigned char* H; int ldh; float ws, hs;
    __device__ __forceinline__ void operator()(const f32x4 (&acc)[2][2][4][2], const Unit& u, int wr, int wc, int fr, int fq) const {
        const int row0 = u.pm * BM + wr * 64 + fr, col0 = u.pn * HALF + wc * 32 + 8 * fq;
#pragma unroll
        for (int ai = 0; ai < 2; ++ai)
#pragma unroll
            for (int m = 0; m < 4; ++m) { unsigned char* rowp = H + (size_t)(row0 + ai * HALF + m * 16) * ldh + col0;
                f32x4 v[2];
#pragma unroll
                for (int n = 0; n < 2; ++n) { const f32x4 gt = acc[ai][0][m][n] * ws, up = acc[ai][1][m][n] * (ws * hs);
#pragma unroll
                    for (int j = 0; j < 4; ++j) v[n][j] = fsilu(gt[j]) * up[j]; }
                *(u32x2*)rowp = (u32x2){pk_fp8x4(v[0][0], v[0][1], v[0][2], v[0][3]), pk_fp8x4(v[1][0], v[1][1], v[1][2], v[1][3])}; }
    }
};
struct EpiPlain {
    static constexpr bool PERM = true;
    bf16_t* O; int ldc; float sc;
    __device__ __forceinline__ void operator()(const f32x4 (&acc)[2][2][4][2], const Unit& u, int wr, int wc, int fr, int fq) const {
        const int row0 = u.pm * BM + wr * 64 + fr, col0 = u.pn * BM + wc * 32 + 8 * fq;
#pragma unroll
        for (int ai = 0; ai < 2; ++ai)
#pragma unroll
            for (int m = 0; m < 4; ++m) { bf16_t* rowp = O + (size_t)(row0 + ai * HALF + m * 16) * ldc + col0;
#pragma unroll
                for (int bj = 0; bj < 2; ++bj) { const f32x4 v0 = acc[ai][bj][m][0] * sc, v1 = acc[ai][bj][m][1] * sc;
                    u32x4 w; w.x = cvt_pk_bf16(v0[0], v0[1]); w.y = cvt_pk_bf16(v0[2], v0[3]); w.z = cvt_pk_bf16(v1[0], v1[1]); w.w = cvt_pk_bf16(v1[2], v1[3]);
                    *(u32x4*)(rowp + bj * HALF) = w; } }
    }
};
struct EpiAct {
    static constexpr bool PERM = true;
    int kind; unsigned char* ws; const float* lb;
    __device__ __forceinline__ void operator()(const f32x4 (&acc)[2][2][4][2], const Unit& u, int wr, int wc, int fr, int fq) const {
        const int row0 = u.pm * BM + wr * 64 + fr;
        int mode, ldc, colt; size_t boff;
        if (kind == 0) { const int grp = u.pn >> 2; colt = (u.pn & 3) * 256; ldc = 1024;
            boff = grp == 0 ? H_Q : grp == 1 ? H_LFF : grp == 2 ? H_LFB : grp == 3 ? H_V : H_G; mode = (grp == 0 || grp == 4) ? 1 : (grp == 3 ? 0 : 3); }
        else { ldc = LRUW; if (u.pn < 5) { boff = L_YB; colt = u.pn * 256; mode = 2; } else { boff = L_XB; colt = (u.pn - 5) * 256; mode = 0; } }
        bf16_t* base = (bf16_t*)(ws + boff);
        const int col0 = colt + wc * 32 + 8 * fq;
        f32x4 lbv[2][2];
        if (mode == 3) { const float* lp = lb + ((u.pn >> 2) - 1) * 1024 + col0;
#pragma unroll
            for (int bj = 0; bj < 2; ++bj)
#pragma unroll
                for (int n = 0; n < 2; ++n) lbv[bj][n] = *(const f32x4*)(lp + bj * HALF + 4 * n); }
#pragma unroll
        for (int ai = 0; ai < 2; ++ai)
#pragma unroll
            for (int m = 0; m < 4; ++m) { bf16_t* rowp = base + (size_t)(row0 + ai * HALF + m * 16) * ldc + col0;
#pragma unroll
                for (int bj = 0; bj < 2; ++bj) { f32x4 v[2]; u32x4 w;
#pragma unroll
                    for (int n = 0; n < 2; ++n) { v[n] = acc[ai][bj][m][n];
                        if (mode == 1) {
#pragma unroll
                            for (int j = 0; j < 4; ++j) v[n][j] = fsilu(v[n][j]); }
                        else if (mode == 2) {
#pragma unroll
                            for (int j = 0; j < 4; ++j) { const float x = v[n][j]; v[n][j] = x * fsigmoid(1.5957691216057308f * (x + 0.044715f * x * x * x)); } }
                        else if (mode == 3) {
#pragma unroll
                            for (int j = 0; j < 4; ++j) { const float l = lbv[bj][n][j]; const float fg = l + (1.0f - l) * fsigmoid(v[n][j]); v[n][j] = __builtin_amdgcn_logf(fg) * 0.6931471805599453f; } }
                    }
                    if (mode == 3) {
#pragma unroll
                        for (int n = 0; n < 2; ++n) { const _Float16 h0 = (_Float16)v[n][0], h1 = (_Float16)v[n][1], h2 = (_Float16)v[n][2], h3 = (_Float16)v[n][3];
                            const unsigned a = (unsigned)__builtin_bit_cast(unsigned short, h0) | ((unsigned)__builtin_bit_cast(unsigned short, h1) << 16);
                            const unsigned b = (unsigned)__builtin_bit_cast(unsigned short, h2) | ((unsigned)__builtin_bit_cast(unsigned short, h3) << 16);
                            if (n == 0) { w.x = a; w.y = b; } else { w.z = a; w.w = b; } }
                    } else { w.x = cvt_pk_bf16(v[0][0], v[0][1]); w.y = cvt_pk_bf16(v[0][2], v[0][3]); w.z = cvt_pk_bf16(v[1][0], v[1][1]); w.w = cvt_pk_bf16(v[1][2], v[1][3]); }
                    *(u32x4*)(rowp + bj * HALF) = w; } }
    }
};
}

struct Args { const float* in[30]; float* out; unsigned char* ws; };
enum { I_X = 0, I_C, I_ADAW, I_ADAB, I_N1G, I_N2G, I_ATWIN, I_ATQN, I_ATKN, I_ATLAM, I_ATSUB, I_ATWOUT, I_HGWIN, I_HGLB, I_HGNG, I_HGWOUT,
       I_LRWIN, I_LRCW, I_LRCB, I_LRWA, I_LRBA, I_LRWX, I_LRBX, I_LRLAM, I_LRWOUT, I_FFGU, I_FFDN, I_MOER, I_MOEGU, I_MOEDN };
enum { SC_LAM0 = 0, SC_LAM1, SC_OML0, SC_OML1, SC_MC0, SC_MC1 };

__device__ __forceinline__ void cvt_item(const float* W, int ldw, int src_col0, bf16_t* WT, int ldt, int dst_row0, int k0, LAS float* scr, int lane) {
#pragma unroll 8
    for (int i = 0; i < 32; ++i) { const int kk = 2 * i + (lane >> 5); scr[kk * 33 + (lane & 31)] = W[(size_t)(k0 + kk) * ldw + src_col0 + (lane & 31)]; }
    LDS_WAIT(); asm volatile("" ::: "memory");
    const int c = lane & 7;
#pragma unroll
    for (int j = 0; j < 4; ++j) { const int n = (lane >> 3) + 8 * j; const LAS float* s = scr + (8 * c) * 33 + n;
        u32x4 o; o.x = cvt_pk_bf16(s[0 * 33], s[1 * 33]); o.y = cvt_pk_bf16(s[2 * 33], s[3 * 33]); o.z = cvt_pk_bf16(s[4 * 33], s[5 * 33]); o.w = cvt_pk_bf16(s[6 * 33], s[7 * 33]);
        *(u32x4*)(WT + (size_t)(dst_row0 + n) * ldt + k0 + 8 * c) = o; }
    LDS_WAIT(); asm volatile("" ::: "memory");
}
__device__ __forceinline__ void cvt_item8(const float* W, int ldw, int src_col0, unsigned char* WT, int ldt, int dst_row0, int k0, float sc, LAS float* scr, int lane) {
#pragma unroll 8
    for (int i = 0; i < 32; ++i) { const int kk = 2 * i + (lane >> 5); scr[kk * 33 + (lane & 31)] = W[(size_t)(k0 + kk) * ldw + src_col0 + (lane & 31)]; }
    LDS_WAIT(); asm volatile("" ::: "memory");
    const int c = lane & 7;
#pragma unroll
    for (int j = 0; j < 4; ++j) { const int n = (lane >> 3) + 8 * j; const LAS float* s = scr + (8 * c) * 33 + n;
        *(u32x2*)(WT + (size_t)(dst_row0 + n) * ldt + k0 + 8 * c) = (u32x2){pk_fp8x4(s[0 * 33] * sc, s[1 * 33] * sc, s[2 * 33] * sc, s[3 * 33] * sc), pk_fp8x4(s[4 * 33] * sc, s[5 * 33] * sc, s[6 * 33] * sc, s[7 * 33] * sc)}; }
    LDS_WAIT(); asm volatile("" ::: "memory");
}
enum { MAP_ID = 0, MAP_QKV = 1, MAP_SWI = 2 };
template <bool F8 = false>
__device__ __forceinline__ void cvt_family(const float* src, size_t sstride, int ninst, int ldw, int K, int ng, int map, int F, bf16_t* dst, size_t dstride,
                                           LAS float* scr, int gw, int NGW, int lane) {
    const int nkb = K / 64, per = nkb * ng, total = ninst * per;
    for (int it = gw; it < total; it += NGW) {
        const int inst = it / per, r = it - inst * per, kb = r / ng, gi = r - kb * ng;
        int sc0;
        if (map == MAP_ID) sc0 = 32 * gi;
        else if (map == MAP_QKV) { const int pn = gi >> 3, bj = (gi >> 2) & 1, wc = gi & 3;
            if (pn < 8) { const int part = pn >> 2, sh = 4 * (pn & 3) + wc; sc0 = part * 1024 + sh * 64 + 32 * bj; } else sc0 = 32 * gi; }
        else { const int pn = gi >> 3, bj = (gi >> 2) & 1, q = gi & 3; sc0 = bj * F + pn * 128 + 32 * q; }
        if constexpr (F8) cvt_item8(src + (size_t)inst * sstride, ldw, sc0, (unsigned char*)dst + (size_t)inst * dstride, K, 32 * gi, 64 * kb, MOE_WSCALE, scr, lane);
        else cvt_item(src + (size_t)inst * sstride, ldw, sc0, dst + (size_t)inst * dstride, K, 32 * gi, 64 * kb, scr, lane);
    }
}

__device__ __forceinline__ void prologue_phase(const Args& A, LAS unsigned char* lds, int bid, int G) {
    const int tid = threadIdx.x, lane = tid & 63, wave = tid >> 6;
    unsigned char* ws = A.ws;
    {
        LAS float* sc = (LAS float*)lds;
        LAS float* red = (LAS float*)(lds + 32768);
        for (int i = tid; i < NBATCH * DM; i += NTHR) { const float cv = A.in[I_C][i]; sc[i] = fsilu(cv); }
        __syncthreads();
        float* mods = (float*)(ws + TB_MODS);
        for (int cb = bid; cb < (DEPTH * 6144) / 128; cb += G) {
            const int col = cb * 128 + (tid & 127), l = col / 6144, e = col - l * 6144, ch = tid >> 7;
            const float* wp = A.in[I_ADAW] + (size_t)l * DM * 6144 + e;
            float a[NBATCH];
#pragma unroll
            for (int b = 0; b < NBATCH; ++b) a[b] = 0.f;
#pragma unroll 4
            for (int d = ch * 256; d < ch * 256 + 256; ++d) { const float w = wp[(size_t)d * 6144];
#pragma unroll
                for (int b = 0; b < NBATCH; ++b) a[b] += sc[b * DM + d] * w; }
#pragma unroll
            for (int b = 0; b < NBATCH; ++b) red[(ch * 128 + (tid & 127)) * 8 + b] = a[b];
            __syncthreads();
            if (tid < 128) { const float bias = A.in[I_ADAB][l * 6144 + e];
#pragma unroll
                for (int b = 0; b < NBATCH; ++b) { const float s = ((red[(0 * 128 + tid) * 8 + b] + red[(1 * 128 + tid) * 8 + b]) + (red[(2 * 128 + tid) * 8 + b] + red[(3 * 128 + tid) * 8 + b])) + bias;
                    mods[((size_t)l * NBATCH + b) * 6144 + e] = s; } }
            __syncthreads();
        }
    }
    {
        float* cosT = (float*)(ws + TB_COS); float* sinT = (float*)(ws + TB_SIN);
        for (int i = bid * NTHR + tid; i < SEQ * 32; i += G * NTHR) {
            const int pos = i >> 5, d = i & 31;
            const float inv = (float)exp(-(double)d * (1.0 / 32.0) * 9.210340371976184);
            const float ang = (float)pos * inv;
            const double rev = (double)ang * 0.15915494309189535; const float fr = (float)(rev - floor(rev));
            cosT[i] = __builtin_amdgcn_cosf(fr); sinT[i] = __builtin_amdgcn_sinf(fr);
        }
        if (bid == 0 && tid < 2) {
            const int a = tid; const float* lm = A.in[I_ATLAM] + a * 256;
            float s1 = 0.f, s2 = 0.f; for (int i = 0; i < 64; ++i) { s1 += lm[i] * lm[64 + i]; s2 += lm[128 + i] * lm[192 + i]; }
            const float linit = 0.8f - 0.6f * expf(-0.3f * (float)(3 * a));
            float mq = 0.f, mk = 0.f; for (int i = 0; i < 64; ++i) { mq = fmaxf(mq, fabsf(A.in[I_ATQN][a * 64 + i])); mk = fmaxf(mk, fabsf(A.in[I_ATKN][a * 64 + i])); }
            float* scal = (float*)(ws + TB_SCAL);
            scal[SC_LAM0 + a] = expf(s1) - expf(s2) + linit; scal[SC_OML0 + a] = 1.0f - linit; scal[SC_MC0 + a] = 8.0f * mq * mk * LOG2E * 1.0001f;
        }
        if (bid == 1) {
            float* lb = (float*)(ws + TB_LB);
            for (int i = tid; i < 2 * 1024; i += NTHR) { const int d = i >> 10, k = i & 1023; const float* p = A.in[I_HGLB] + (size_t)d * DEPTH * 1024 + k;
                float mx = p[0]; for (int l = 1; l < DEPTH; ++l) mx = fmaxf(mx, p[l * 1024]);
                float den = 0.f, num = 0.f; for (int l = 0; l < DEPTH; ++l) { const float e = expf(p[l * 1024] - mx); den += e; if (l == 1) num += e; }
                lb[i] = num / den; }
        }
        if (bid == 2) {
            float* sp = (float*)(ws + TB_SP);
            for (int i = tid; i < 2 * LRUW; i += NTHR) { const float x = -A.in[I_LRLAM][i]; sp[i] = (x > 20.f) ? x : log1pf(expf(x)); }
        }
    }
    {
        LAS float* scr = (LAS float*)(lds + wave * 16384);
        const int vcu = (bid % 8) * (G / 8) + bid / 8;
        const int gw = vcu * NWAVES + wave, NGW = G * NWAVES;
        cvt_family(A.in[I_ATWIN], (size_t)1024 * 3072, 2, 3072, 1024, 96, MAP_QKV, 0, (bf16_t*)(ws + W_QKV), (size_t)3072 * 1024, scr, gw, NGW, lane);
        cvt_family(A.in[I_ATWOUT], (size_t)1024 * 1024, 2, 1024, 1024, 32, MAP_ID, 0, (bf16_t*)(ws + W_AO), (size_t)1024 * 1024, scr, gw, NGW, lane);
        cvt_family(A.in[I_HGWIN], 0, 1, 5120, 1024, 160, MAP_ID, 0, (bf16_t*)(ws + W_HGI), 0, scr, gw, NGW, lane);
        cvt_family(A.in[I_HGWOUT], 0, 1, 1024, 1024, 32, MAP_ID, 0, (bf16_t*)(ws + W_HGO), 0, scr, gw, NGW, lane);
        cvt_family(A.in[I_LRWIN], 0, 1, 2560, 1024, 80, MAP_ID, 0, (bf16_t*)(ws + W_LRI), 0, scr, gw, NGW, lane);
        cvt_family(A.in[I_LRWOUT], 0, 1, 1024, 1280, 32, MAP_ID, 0, (bf16_t*)(ws + W_LRO), 0, scr, gw, NGW, lane);
        for (int it = gw; it < 2 * 20 * 2 * 4; it += NGW) {
            const int part = it / 160, r = it % 160, inst = r >> 3, kb = (r >> 2) & 1, gi = r & 3, d = inst / 10, n = inst % 10;
            const float* src = (part ? A.in[I_LRWX] : A.in[I_LRWA]) + (size_t)inst * 16384;
            cvt_item(src, 128, 32 * gi, (bf16_t*)(ws + W_LRG) + (size_t)(n * 2 + d) * 256 * 128, 128, part * 128 + 32 * gi, 64 * kb, scr, lane);
        }
        static_assert(FP8_DENSE_FROM == 2 || FP8_DENSE_FROM > 3, "dense layer 0 stays bf16; layer 2 optional");
        constexpr int NB16 = (FP8_DENSE_FROM == 2) ? 1 : 2;
        cvt_family(A.in[I_FFGU], (size_t)1024 * 5632, NB16, 5632, 1024, 176, MAP_SWI, DFF, (bf16_t*)(ws + W_FGU), (size_t)5632 * 1024, scr, gw, NGW, lane);
        cvt_family(A.in[I_FFDN], (size_t)2816 * 1024, NB16, 1024, 2816, 32, MAP_ID, 0, (bf16_t*)(ws + W_FDN), (size_t)1024 * 2816, scr, gw, NGW, lane);
        if constexpr (NB16 == 1) {
            cvt_family<true>(A.in[I_FFGU] + (size_t)1024 * 5632, 0, 1, 5632, 1024, 176, MAP_SWI, DFF, (bf16_t*)(ws + W_FGU) + (size_t)5632 * 1024, 0, scr, gw, NGW, lane);
            cvt_family<true>(A.in[I_FFDN] + (size_t)2816 * 1024, 0, 1, 1024, 2816, 32, MAP_ID, 0, (bf16_t*)(ws + W_FDN) + (size_t)1024 * 2816, 0, scr, gw, NGW, lane);
        }
        cvt_family<true>(A.in[I_MOEGU], (size_t)1024 * 7168, 16, 7168, 1024, 224, MAP_SWI, DFFE, (bf16_t*)(ws + W_MGU), (size_t)7168 * 1024, scr, gw, NGW, lane);
        cvt_family<true>(A.in[I_MOEDN], (size_t)3584 * 1024, 16, 1024, 3584, 32, MAP_ID, 0, (bf16_t*)(ws + W_MDN), (size_t)1024 * 3584, scr, gw, NGW, lane);
    }
}

template <bool ROUTER>
__device__ __forceinline__ void norm_phase(const Args& A, LAS unsigned char* lds, int bid, int G, const void* xsrc, bool src16, void* xdst, bool dst16, const float* gain, const float* modl  , int which,
                                           bool combine, const float* modprev  , bool nonorm, const float* router, bool f8out = false) {
    int tid_ = threadIdx.x; asm volatile("" : "+v"(tid_));
    const int tid = tid_, lane = tid & 63, wave = tid >> 6;
    unsigned char* ws = A.ws;
    bf16_t* HM = (bf16_t*)(ws + WS_HM);
    const int* slot = (const int*)(ws + TB_SLOT); const float* gts = (const float*)(ws + TB_GATE);
    const bf16_t* Y = (const bf16_t*)(ws + E_XS);
    LAS int* hist = (LAS int*)lds;
    for (int tb = bid; tb < MTOK / 256; tb += G) {
        const int b = tb >> 5;
        f32x4 ga[4], sh[4], g2[4];
#pragma unroll
        for (int j = 0; j < 4; ++j) { const int c = 256 * j + 4 * lane;
            if (!nonorm) { const f32x4 gv = *(const f32x4*)(gain + c), sv = *(const f32x4*)(modl + (size_t)b * 6144 + (which * 3 + 1) * 1024 + c);
                ga[j] = gv * (sv + 1.0f); sh[j] = *(const f32x4*)(modl + (size_t)b * 6144 + (which * 3) * 1024 + c); }
            if (combine) g2[j] = *(const f32x4*)(modprev + (size_t)b * 6144 + 5 * 1024 + c); }
        f32x4 rw[ROUTER ? 32 : 1];
        if constexpr (ROUTER) {
            if (tid < 8) hist[tid] = 0;
#pragma unroll
            for (int j = 0; j < 4; ++j)
#pragma unroll
                for (int i = 0; i < 4; ++i) { const int c = 256 * j + 4 * lane + i; rw[(j * 4 + i) * 2] = *(const f32x4*)(router + c * 8); rw[(j * 4 + i) * 2 + 1] = *(const f32x4*)(router + c * 8 + 4); }
            __syncthreads();
        }
        for (int i = 0; i < 32; ++i) {
            const int row = tb * 256 + wave * 32 + i;
            f32x4 v[4];
#pragma unroll
            for (int j = 0; j < 4; ++j) v[j] = pg8::ld_x4(xsrc, (size_t)row * DM + 256 * j + 4 * lane, src16);
            if (combine) {
                const int s0 = slot[row * 2], s1 = slot[row * 2 + 1]; const float w0 = gts[row * 2], w1 = gts[row * 2 + 1];
#pragma unroll
                for (int j = 0; j < 4; ++j) { const u32x2 a = *(const u32x2*)(Y + (size_t)s0 * DM + 256 * j + 4 * lane), c2 = *(const u32x2*)(Y + (size_t)s1 * DM + 256 * j + 4 * lane);
                    f32x4 y; y[0] = w0 * bflo(a.x) + w1 * bflo(c2.x); y[1] = w0 * bfhi(a.x) + w1 * bfhi(c2.x); y[2] = w0 * bflo(a.y) + w1 * bflo(c2.y); y[3] = w0 * bfhi(a.y) + w1 * bfhi(c2.y);
                    v[j] = v[j] + g2[j] * y;
                    if (dst16) *(u32x2*)((bf16_t*)xdst + (size_t)row * DM + 256 * j + 4 * lane) = (u32x2){cvt_pk_bf16(v[j][0], v[j][1]), cvt_pk_bf16(v[j][2], v[j][3])};
                    else *(f32x4*)((float*)xdst + (size_t)row * DM + 256 * j + 4 * lane) = v[j]; }
            }
            if (nonorm) continue;
            float ss = 0.f;
#pragma unroll
            for (int j = 0; j < 4; ++j) ss += (v[j][0] * v[j][0] + v[j][1] * v[j][1]) + (v[j][2] * v[j][2] + v[j][3] * v[j][3]);
            ss = wave_sum(ss);
            const float rstd = 1.0f / sqrtf(ss * (1.0f / DM) + EPS);
            f32x4 h[4];
#pragma unroll
            for (int j = 0; j < 4; ++j) { h[j] = v[j] * rstd * ga[j] + sh[j];
                if (f8out) { *(unsigned*)((unsigned char*)HM + (size_t)row * DM + 256 * j + 4 * lane) = pk_fp8x4(h[j][0], h[j][1], h[j][2], h[j][3]); }
                else { u32x2 w; w.x = cvt_pk_bf16(h[j][0], h[j][1]); w.y = cvt_pk_bf16(h[j][2], h[j][3]);
                    *(u32x2*)(HM + (size_t)row * DM + 256 * j + 4 * lane) = w; } }
            if constexpr (ROUTER) {
                float lg[8];
#pragma unroll
                for (int e = 0; e < 8; ++e) lg[e] = 0.f;
#pragma unroll
                for (int j = 0; j < 4; ++j)
#pragma unroll
                    for (int q = 0; q < 4; ++q) { const float hv = h[j][q]; const f32x4 r0 = rw[(j * 4 + q) * 2], r1 = rw[(j * 4 + q) * 2 + 1];
                        lg[0] += hv * r0[0]; lg[1] += hv * r0[1]; lg[2] += hv * r0[2]; lg[3] += hv * r0[3]; lg[4] += hv * r1[0]; lg[5] += hv * r1[1]; lg[6] += hv * r1[2]; lg[7] += hv * r1[3]; }
#pragma unroll
                for (int e = 0; e < 8; ++e) lg[e] = wave_sum(lg[e]);
                int e0 = 0; float v0 = lg[0];
#pragma unroll
                for (int e = 1; e < 8; ++e) if (lg[e] > v0) { v0 = lg[e]; e0 = e; }
                int e1 = -1; float v1 = -3.0e38f;
#pragma unroll
                for (int e = 0; e < 8; ++e) if (e != e0 && lg[e] > v1) { v1 = lg[e]; e1 = e; }
                const float p1 = frcp(1.0f + fexp(v1 - v0));
                if (lane == 0) { int* eid = (int*)(ws + TB_EID); float* gt = (float*)(ws + TB_GATE);
                    eid[row * 2] = e0; eid[row * 2 + 1] = e1; gt[row * 2] = p1; gt[row * 2 + 1] = 1.0f - p1;
                    atomicAdd((int*)&hist[e0], 1); atomicAdd((int*)&hist[e1], 1); }
            }
        }
        if constexpr (ROUTER) {
            __syncthreads();
            if (tid < 8) ((int*)(ws + TB_BCNT))[tb * 8 + tid] = hist[tid];
            __syncthreads();
        }
    }
}

namespace lru {
constexpr int XCF = 0, XCB = 16384, AA = 24576, UU = 40960;
__device__ __forceinline__ int sw256(int row, int cb) { return row * 256 + (cb ^ ((row & 15) << 4)); }
__device__ __forceinline__ int crow(int r, int hi) { return (r & 3) + 8 * (r >> 2) + 4 * hi; }
template <int MODE>
__device__ __forceinline__ void lru_item(const Args& A, LAS unsigned char* lds, int b, int n, int seg, int dir) {
    int tid_ = threadIdx.x; asm volatile("" : "+v"(tid_));
    const int tid = tid_, wid = tid >> 6, lane = tid & 63, r = lane & 31, hh = lane >> 5;
    unsigned char* ws = A.ws;
    const bf16_t* XB = (const bf16_t*)(ws + L_XB); const bf16_t* YB = (const bf16_t*)(ws + L_YB); bf16_t* HF = (bf16_t*)(ws + L_HF); bf16_t* HY = (bf16_t*)(ws + L_HY);
    const bf16_t* Wg = (const bf16_t*)(ws + W_LRG) + (size_t)((n * 2 + dir) * 256 + ((r < 16) ? (16 * wid + r) : (128 + 16 * wid + r - 16))) * 128 + 8 * hh;
    bf16x8 bfrag[8];
#pragma unroll
    for (int ks = 0; ks < 8; ++ks) bfrag[ks] = *(const bf16x8*)(Wg + 16 * ks);
    const int cch = n * 128 + 16 * wid + (r & 15);
    const float nba = -LOG2E * A.in[I_LRBA][dir * LRUW + cch], nbx = -LOG2E * A.in[I_LRBX][dir * LRUW + cch], csp = -8.0f * LOG2E * ((const float*)(ws + TB_SP))[dir * LRUW + cch];
    const int ct = tid >> 4, cg = tid & 15, cc0 = n * 128 + 8 * cg;
    float cw[4][8], cb[8];
#pragma unroll
    for (int j = 0; j < 8; ++j) { cb[j] = A.in[I_LRCB][cc0 + j];
#pragma unroll
        for (int w = 0; w < 4; ++w) cw[w][j] = A.in[I_LRCW][w * LRUW + cc0 + j]; }
    float carry = 0.f, P = 1.f;
    if (MODE != 0 && tid < 128) carry = ((const float*)(ws + TB_LCIN))[(size_t)((b * 32 + seg) * 2 + dir) * LRUW + n * 128 + tid];
    u32x4 xr[4];
#define LRU_XLOAD(si_) do { const int sub_ = dir ? (7 - (si_)) : (si_); const int tok_ = seg * 256 + sub_ * 32 + ct; \
        _Pragma("unroll") for (int w = 0; w < 4; ++w) { const int tt = tok_ - 1 + w; xr[w] = (tt >= 0 && tt < SEQ) ? *(const u32x4*)(XB + ((size_t)b * SEQ + tt) * LRUW + cc0) : (u32x4){0u, 0u, 0u, 0u}; } } while (0)
    LRU_XLOAD(0);
    for (int si = 0; si < 8; ++si) {
        const int sub = dir ? (7 - si) : si; const int t0 = seg * 256 + sub * 32;
        {
            float xc[8];
#pragma unroll
            for (int j = 0; j < 8; ++j) xc[j] = cb[j];
#pragma unroll
            for (int w = 0; w < 4; ++w) { const u32x4 v = xr[w];
#pragma unroll
                for (int e = 0; e < 4; ++e) { xc[2 * e] += cw[w][2 * e] * bflo(v[e]); xc[2 * e + 1] += cw[w][2 * e + 1] * bfhi(v[e]); } }
            if (si + 1 < 8) LRU_XLOAD(si + 1);
            *(LAS f32x4*)(lds + XCF + (ct * 128 + 8 * cg) * 4) = (f32x4){xc[0], xc[1], xc[2], xc[3]};
            *(LAS f32x4*)(lds + XCF + (ct * 128 + 8 * cg + 4) * 4) = (f32x4){xc[4], xc[5], xc[6], xc[7]};
            *(LAS u32x4*)(lds + XCB + sw256(ct, 16 * cg)) = (u32x4){cvt_pk_bf16(xc[0], xc[1]), cvt_pk_bf16(xc[2], xc[3]), cvt_pk_bf16(xc[4], xc[5]), cvt_pk_bf16(xc[6], xc[7])};
        }
        __syncthreads();
        {
            f32x16 acc = {};
#pragma unroll
            for (int ks = 0; ks < 8; ++ks) { const bf16x8 fa = *(const LAS bf16x8*)(lds + XCB + sw256(r, (16 * ks + 8 * hh) * 2)); acc = __builtin_amdgcn_mfma_f32_32x32x16_bf16(fa, bfrag[ks], acc, 0, 0, 0); }
#pragma unroll
            for (int q = 0; q < 8; ++q) {
                const auto sw = __builtin_amdgcn_permlane16_swap(__float_as_uint(acc[q]), __float_as_uint(acc[8 + q]), false, false);
                const float rp = __uint_as_float(sw[0]), ip = __uint_as_float(sw[1]);
                const int tq = crow((r < 16) ? q : (8 + q), hh); const int cl = 16 * wid + (r & 15);
                const float xcv = ((const LAS float*)(lds + XCF))[tq * 128 + cl];
                const float rg = frcp(1.0f + fexp2(fmaf(rp, -LOG2E, nba))), ig = frcp(1.0f + fexp2(fmaf(ip, -LOG2E, nbx)));
                const float av = fexp2(csp * rg), uv = __builtin_amdgcn_sqrtf(fmaxf(fmaf(-av, av, 1.0f), 0.f)) * ig * xcv;
                ((LAS float*)(lds + AA))[tq * 128 + cl] = av; ((LAS float*)(lds + UU))[tq * 128 + cl] = uv; }
        }
        __syncthreads();
        if (tid < 128) {
            LAS float* ap = (LAS float*)(lds + AA) + tid; LAS float* up = (LAS float*)(lds + UU) + tid; float av[32], uv[32];
#pragma unroll
            for (int i = 0; i < 32; ++i) { av[i] = ap[i * 128]; uv[i] = up[i * 128]; }
            if (dir == 0) {
#pragma unroll
                for (int i = 0; i < 32; ++i) { carry = av[i] * carry + uv[i]; if (MODE == 0) P *= av[i]; else uv[i] = carry; } }
            else {
#pragma unroll
                for (int i = 31; i >= 0; --i) { carry = av[i] * carry + uv[i]; if (MODE == 0) P *= av[i]; else uv[i] = carry; } }
            if (MODE != 0) {
#pragma unroll
                for (int i = 0; i < 32; ++i) up[i * 128] = uv[i]; }
        }
        if (MODE != 0) {
            __syncthreads();
            const int tok = t0 + ct; const size_t go = ((size_t)b * SEQ + tok) * LRUW + cc0;
            const f32x4 h0 = *(const LAS f32x4*)(lds + UU + (ct * 128 + 8 * cg) * 4), h1 = *(const LAS f32x4*)(lds + UU + (ct * 128 + 8 * cg + 4) * 4);
            if (MODE == 1) { *(u32x4*)(HF + go) = (u32x4){cvt_pk_bf16(h0[0], h0[1]), cvt_pk_bf16(h0[2], h0[3]), cvt_pk_bf16(h1[0], h1[1]), cvt_pk_bf16(h1[2], h1[3])}; }
            else { const u32x4 f = *(const u32x4*)(HF + go), y = *(const u32x4*)(YB + go);
                *(u32x4*)(HY + go) = (u32x4){cvt_pk_bf16((h0[0] + bflo(f[0])) * bflo(y[0]), (h0[1] + bfhi(f[0])) * bfhi(y[0])), cvt_pk_bf16((h0[2] + bflo(f[1])) * bflo(y[1]), (h0[3] + bfhi(f[1])) * bfhi(y[1])),
                                            cvt_pk_bf16((h1[0] + bflo(f[2])) * bflo(y[2]), (h1[1] + bfhi(f[2])) * bfhi(y[2])), cvt_pk_bf16((h1[2] + bflo(f[3])) * bflo(y[3]), (h1[3] + bfhi(f[3])) * bfhi(y[3]))}; }
        }
        __syncthreads();
    }
#undef LRU_XLOAD
    if (MODE == 0 && tid < 128) { float* sm = (float*)(ws + TB_LSUM) + (size_t)(((b * 32 + seg) * 2 + dir) * 2) * LRUW + n * 128 + tid; sm[0] = P; sm[LRUW] = carry; }
}
}
template <int MODE>
__device__ __forceinline__ void lru_phase(const Args& A, LAS unsigned char* lds, int bid, int G) {
    const int nitems = (MODE == 0) ? 5120 : 2560;
    for (int it = bid; it < nitems; it += G) {
        int b, n, seg, dir;
        if (MODE == 0) { dir = it & 1; const int r = it >> 1; seg = r & 31; n = (r >> 5) % 10; b = r / 320; }
        else { dir = MODE - 1; seg = it & 31; n = (it >> 5) % 10; b = it / 320; }
        lru::lru_item<MODE>(A, lds, b, n, seg, dir);
    }
}
__device__ __forceinline__ void lru_carry_phase(const Args& A, int bid, int G) {
    const float* sm = (const float*)(A.ws + TB_LSUM); float* cin = (float*)(A.ws + TB_LCIN);
    for (int idx = bid * NTHR + threadIdx.x; idx < NBATCH * 2 * LRUW; idx += G * NTHR) {
        const int b = idx / (2 * LRUW), r = idx % (2 * LRUW), dir = r / LRUW, ch = r % LRUW; float carry = 0.f;
        for (int i = 0; i < 32; ++i) { const int sg = dir ? (31 - i) : i; const size_t o = (size_t)((b * 32 + sg) * 2 + dir);
            cin[o * LRUW + ch] = carry; carry = sm[o * 2 * LRUW + ch] * carry + sm[o * 2 * LRUW + LRUW + ch]; }
    }
}

__device__ __forceinline__ void place_phase(const Args& A, LAS unsigned char* lds, int bid, int G) {
    int tid_ = threadIdx.x; asm volatile("" : "+v"(tid_));
    const int tid = tid_, lane = tid & 63, wave = tid >> 6; unsigned char* ws = A.ws;
    const int* bcnt = (const int*)(ws + TB_BCNT); const int* eid = (const int*)(ws + TB_EID); int* slot = (int*)(ws + TB_SLOT);
    const bf16_t* HM = (const bf16_t*)(ws + WS_HM); bf16_t* XS = (bf16_t*)(ws + E_XS);
    LAS int* tot = (LAS int*)lds; LAS int* pre = tot + 8; LAS int* rb = tot + 16; LAS int* wcn = tot + 32; LAS int* sl = tot + 64;
    for (int tb = bid; tb < MTOK / 256; tb += G) {
        { int t_ = 0, p_ = 0;
#pragma unroll
            for (int j = 0; j < 4; ++j) { const int blk = lane + 64 * j; const int v = bcnt[blk * 8 + wave]; t_ += v; p_ += (blk < tb) ? v : 0; }
#pragma unroll
            for (int o = 1; o < 64; o <<= 1) { t_ += __shfl_xor(t_, o); p_ += __shfl_xor(p_, o); }
            if (lane == 0) { tot[wave] = t_; pre[wave] = p_; } }
        __syncthreads();
        if (tid == 0) { int acc = 0; for (int e = 0; e < 8; ++e) { rb[e] = acc * 256; if (tb == 0) ((int*)(ws + TB_TILES))[e] = acc; acc += (tot[e] + 255) >> 8; } if (tb == 0) ((int*)(ws + TB_TILES))[8] = acc; }
        int e0 = -1, e1 = -1; unsigned long long mk0 = 0, mk1 = 0;
        if (tid < 256) { e0 = eid[(tb * 256 + tid) * 2]; e1 = eid[(tb * 256 + tid) * 2 + 1];
#pragma unroll
            for (int e = 0; e < 8; ++e) { const unsigned long long m = __ballot(e0 == e || e1 == e); if (lane == 0) wcn[wave * 8 + e] = __popcll(m); if (e0 == e) mk0 = m; if (e1 == e) mk1 = m; } }
        __syncthreads();
        if (tid < 256) { const unsigned long long lt = (1ull << lane) - 1ull; int b0 = rb[e0] + pre[e0] + __popcll(mk0 & lt), b1 = rb[e1] + pre[e1] + __popcll(mk1 & lt);
            for (int w = 0; w < wave; ++w) { b0 += wcn[w * 8 + e0]; b1 += wcn[w * 8 + e1]; }
            sl[tid * 2] = b0; sl[tid * 2 + 1] = b1; slot[(tb * 256 + tid) * 2] = b0; slot[(tb * 256 + tid) * 2 + 1] = b1; }
        __syncthreads();
        for (int i = 0; i < 32; ++i) { const int t = wave * 32 + i; const int s0 = sl[t * 2], s1 = sl[t * 2 + 1];
            const bf16_t* src = HM + (size_t)(tb * 256 + t) * DM + lane * 16;
            const u32x4 a = *(const u32x4*)src, b = *(const u32x4*)(src + 8);
            const u32x4 q = {pk_fp8x4(bflo(a[0]), bfhi(a[0]), bflo(a[1]), bfhi(a[1])), pk_fp8x4(bflo(a[2]), bfhi(a[2]), bflo(a[3]), bfhi(a[3])),
                             pk_fp8x4(bflo(b[0]), bfhi(b[0]), bflo(b[1]), bfhi(b[1])), pk_fp8x4(bflo(b[2]), bfhi(b[2]), bflo(b[3]), bfhi(b[3]))};
            *(u32x4*)((unsigned char*)XS + (size_t)s0 * DM + lane * 16) = q; *(u32x4*)((unsigned char*)XS + (size_t)s1 * DM + lane * 16) = q; }
        __syncthreads();
    }
}

namespace att {
constexpr int KVBLK = 64;
#define SBAR() __builtin_amdgcn_sched_barrier(0)
typedef int v8i __attribute__((ext_vector_type(8)));
__device__ __forceinline__ int crow(int r, int hi) { return (r & 3) + 8 * (r >> 2) + 4 * hi; }
constexpr int SLOTB = 16384;
__device__ __forceinline__ int k_slot(int s) { return s * SLOTB; }
__device__ __forceinline__ int v_slot(int s) { return s * SLOTB + 8192; }
__device__ __forceinline__ int kswz(int row) { return ((row & 7) ^ (row >> 4)) & 7; }
__device__ __forceinline__ int vswz(int row) { return (row >> 2) & 3; }
__device__ __forceinline__ void mfma8_acc(f32x16& acc, const v8i& a, const v8i& b, int sc) {
    asm volatile("s_nop 4\n\tv_mfma_scale_f32_32x32x64_f8f6f4 %0, %1, %2, %0, %3, %3 op_sel_hi:[0,0,0]" : "+v"(acc) : "v"(a), "v"(b), "v"(sc));
}
__device__ __forceinline__ void mfma8_c(f32x16& d, const v8i& a, const v8i& b, const f32x16& c, int sa, int sb) {
    asm volatile("v_mfma_scale_f32_32x32x64_f8f6f4 %0, %1, %2, %3, %4, %5 op_sel_hi:[0,0,0]" : "=&v"(d) : "v"(a), "v"(b), "v"(c), "v"(sa), "v"(sb));
}
#define ATT_LD8(p0_, p1_) __builtin_bit_cast(v8i, __builtin_shufflevector(*(const LAS u32x4*)(p0_), *(const LAS u32x4*)(p1_), 0, 1, 2, 3, 4, 5, 6, 7))
__device__ __forceinline__ void qkt(f32x16& p0, f32x16& p1, const LAS char* Ks, const v8i& qr, int r32, int hi, int jj, const f32x16& cinit, int s1, int s8) {
    const int c0 = jj * 4 + 2 * hi;
    { const int row = r32; const v8i kf = ATT_LD8(Ks + row * 128 + ((c0 ^ kswz(row)) << 4), Ks + row * 128 + (((c0 + 1) ^ kswz(row)) << 4)); mfma8_c(p0, kf, qr, cinit, s1, s8); }
    { const int row = 32 + r32; const v8i kf = ATT_LD8(Ks + row * 128 + ((c0 ^ kswz(row)) << 4), Ks + row * 128 + (((c0 + 1) ^ kswz(row)) << 4)); mfma8_c(p1, kf, qr, cinit, s1, s8); }
}
__device__ __forceinline__ void partialSM(f32x16& p0) {
#pragma unroll
    for (int r = 0; r < 16; ++r) p0[r] = fexp2(p0[r]);
}
__device__ __forceinline__ void finishSM(f32x16& p0, f32x16& p1, v8i& pa) {
#pragma unroll
    for (int r = 0; r < 16; ++r) p1[r] = fexp2(p1[r]);
#pragma unroll
    for (int w = 0; w < 4; ++w) { pa[w] = (int)pk_fp8x4(p0[4 * w], p0[4 * w + 1], p0[4 * w + 2], p0[4 * w + 3]); pa[4 + w] = (int)pk_fp8x4(p1[4 * w], p1[4 * w + 1], p1[4 * w + 2], p1[4 * w + 3]); }
}
#define ATT_MX7(acc, a, b, sc, NOP, O, I, k) \
    asm volatile(NOP "v_mfma_scale_f32_32x32x64_f8f6f4 %0, %15, %16, %0, %17, %17 op_sel_hi:[0,0,0]\n\tv_exp_f32 %1, %8\n\tv_exp_f32 %2, %9\n\tv_exp_f32 %3, %10\n\tv_exp_f32 %4, %11\n\tv_exp_f32 %5, %12\n\tv_exp_f32 %6, %13\n\tv_exp_f32 %7, %14" \
                 : "+v"(acc), "=&v"(O[k]), "=&v"(O[k + 1]), "=&v"(O[k + 2]), "=&v"(O[k + 3]), "=&v"(O[k + 4]), "=&v"(O[k + 5]), "=&v"(O[k + 6]) \
                 : "v"(I(k)), "v"(I(k + 1)), "v"(I(k + 2)), "v"(I(k + 3)), "v"(I(k + 4)), "v"(I(k + 5)), "v"(I(k + 6)), "v"(a), "v"(b), "v"(sc))
__device__ __forceinline__ void pv_exp(f32x16* o, f32x16& lacc, const v8i& ones, const LAS char* Vs, const v8i& pa, int r32, int hi, int s1, const f32x16& r0, const f32x16& r1, float (&pe)[32]) {
#define ATT_VF(d0) ATT_LD8(Vs + (32 * (d0) + r32) * 64 + (((2 * hi) ^ vswz(32 * (d0) + r32)) << 4), Vs + (32 * (d0) + r32) * 64 + (((2 * hi + 1) ^ vswz(32 * (d0) + r32)) << 4))
#define ATT_RI(k) (((k) < 16) ? r0[(k) & 15] : r1[(k) & 15])
    { const v8i vf = ATT_VF(0); ATT_MX7(o[0], pa, vf, s1, "s_nop 4\n\t", pe, ATT_RI, 0); }
    { const v8i vf = ATT_VF(1); ATT_MX7(o[1], pa, vf, s1, "", pe, ATT_RI, 7); }
    { const v8i vf = ATT_VF(2); ATT_MX7(o[2], pa, vf, s1, "", pe, ATT_RI, 14); }
    { const v8i vf = ATT_VF(3); ATT_MX7(o[3], pa, vf, s1, "", pe, ATT_RI, 21); }
    asm volatile("v_mfma_scale_f32_32x32x64_f8f6f4 %0, %9, %10, %0, %11, %11 op_sel_hi:[0,0,0]\n\tv_exp_f32 %1, %5\n\tv_exp_f32 %2, %6\n\tv_exp_f32 %3, %7\n\tv_exp_f32 %4, %8"
                 : "+v"(lacc), "=&v"(pe[28]), "=&v"(pe[29]), "=&v"(pe[30]), "=&v"(pe[31]) : "v"(r1[12]), "v"(r1[13]), "v"(r1[14]), "v"(r1[15]), "v"(pa), "v"(ones), "v"(s1));
#undef ATT_VF
#undef ATT_RI
}
__device__ __forceinline__ void pack_p(const float (&pe)[32], v8i& pa) {
#pragma unroll
    for (int w = 0; w < 8; ++w) pa[w] = (int)pk_fp8x4(pe[4 * w], pe[4 * w + 1], pe[4 * w + 2], pe[4 * w + 3]);
}
__device__ __forceinline__ void pv_d0(f32x16* o, f32x16& lacc, const v8i& ones, const LAS char* Vs, const v8i& pa, int r32, int hi, int s1) {
#pragma unroll
    for (int d0 = 0; d0 < 4; ++d0) { const int row = 32 * d0 + r32;
        const v8i vf = ATT_LD8(Vs + row * 64 + (((2 * hi) ^ vswz(row)) << 4), Vs + row * 64 + (((2 * hi + 1) ^ vswz(row)) << 4));
        mfma8_acc(o[d0], pa, vf, s1); }
    mfma8_acc(lacc, pa, ones, s1);
}
}

__device__ __forceinline__ void vt_phase(const Args& A, int bid, int G) {
    const int tid = threadIdx.x; unsigned char* ws = A.ws;
    const bf16_t* V = (const bf16_t*)(ws + A_V); unsigned char* VT = ws + A_VT;
    const int dv = tid & 127, kq = tid >> 7, half = kq >> 1, hi = kq & 1;
    for (int it = bid; it < 64 * 128; it += G) {
        const int bh = it >> 7, tile = it & 127, b = bh >> 3, h = bh & 7;
        const bf16_t* vp = V + ((size_t)b * SEQ + tile * 64 + 32 * half) * DM + h * 128 + dv;
        float f[16];
#pragma unroll
        for (int i = 0; i < 16; ++i) f[i] = bf2f(vp[(size_t)att::crow(i, hi) * DM]);
        *(u32x4*)(VT + (((size_t)bh * 128 + dv) * 128 + tile) * 64 + hi * 32 + half * 16) =
            (u32x4){pk_fp8x4(f[0], f[1], f[2], f[3]), pk_fp8x4(f[4], f[5], f[6], f[7]), pk_fp8x4(f[8], f[9], f[10], f[11]), pk_fp8x4(f[12], f[13], f[14], f[15])};
    }
}

__device__ __forceinline__ void attn_phase(const Args& A, LAS unsigned char* ldsu, int bid, int G, int al) {
    using namespace att;
    LAS char* lds = (LAS char*)ldsu;
    unsigned char* ws = A.ws;
    const unsigned char* Qg = ws + A_Q; const unsigned char* Kg = ws + A_K; const unsigned char* VTg = ws + A_VT;
    bf16_t* Og = (bf16_t*)(ws + WS_HM);
    const float* scal = (const float*)(ws + TB_SCAL);
    const float lamv = scal[SC_LAM0 + al], omli = scal[SC_OML0 + al], Mc = scal[SC_MC0 + al] - 7.5f;
    const float* subg = A.in[I_ATSUB] + al * 128;
    int tid_ = threadIdx.x; asm volatile("" : "+v"(tid_));
    const int tid = tid_, wid = __builtin_amdgcn_readfirstlane(tid >> 6), lane = tid & 63, r32 = lane & 31, hi = lane >> 5, jj = wid >> 2, wq = wid & 3;
    constexpr int NT = SEQ / KVBLK;
    int s1 = 0x7f7f7f7f, s8 = 0x7c7c7c7c; asm volatile("" : "+v"(s1), "+v"(s8));
    v8i ones; { int o1 = 0x38383838; asm volatile("" : "+v"(o1)); ones = (v8i){o1, o1, o1, o1, o1, o1, o1, o1}; }
    f32x16 cinit;
#pragma unroll
    for (int r = 0; r < 16; ++r) cinit[r] = -Mc;
    unsigned koff, voff;
    { const int bb = wid * 1024 + lane * 16;
      { const int row = bb >> 7, c = ((bb & 127) >> 4) ^ kswz(row); koff = (unsigned)(row * 1024 + c * 16); }
      { const int row = bb >> 6, c = ((bb & 63) >> 4) ^ vswz(row); voff = (unsigned)(row * 8192 + c * 16); } }
    const unsigned ldsw = (unsigned)wid * 1024u;
#define ATT_DMA(slot, kt, vt) do { \
        __builtin_amdgcn_global_load_lds((const unsigned*)((const unsigned char*)(kt) + koff), (LAS unsigned*)(lds + k_slot(slot) + ldsw), 16, 0, 0); \
        __builtin_amdgcn_global_load_lds((const unsigned*)((const unsigned char*)(vt) + voff), (LAS unsigned*)(lds + v_slot(slot) + ldsw), 16, 0, 0); } while (0)
#define ATT_TOP() do { asm volatile("s_waitcnt vmcnt(0)" ::: "memory"); __builtin_amdgcn_s_barrier(); asm volatile("" ::: "memory"); } while (0)
    const int xq = bid & 7, cq = bid >> 3;
    int cbh = xq * 8;
    const bool lag = (jj != 0);
#define ATT_KB(bh_) (Kg + ((size_t)((bh_) >> 3) * SEQ) * DM + ((bh_) & 7) * 128)
#define ATT_VB(bh_) (VTg + (size_t)(bh_) * 128 * 8192)
    ATT_DMA(0, ATT_KB(cbh), ATT_VB(cbh));
    { asm volatile("s_waitcnt vmcnt(0)" ::: "memory"); __builtin_amdgcn_s_barrier(); asm volatile("" ::: "memory"); ATT_DMA(1, ATT_KB(cbh) + (size_t)64 * DM, ATT_VB(cbh) + 64); }
    for (int ui = 0; ui < 16; ++ui) {
        const int qb = (ui & 1) * 32 + cq;
        const int nbh = (ui + 1 < 16) ? xq * 8 + ((ui + 1) >> 1) : cbh;
        const unsigned char* Kh = ATT_KB(cbh); const unsigned char* Vh = ATT_VB(cbh); const unsigned char* nK = ATT_KB(nbh); const unsigned char* nV = ATT_VB(nbh);
        const size_t obase = ((size_t)(cbh >> 3) * SEQ + qb * 128) * DM + (cbh & 7) * 128;
        f32x16 lacc = {}; f32x16 o[4] = {}; v8i qr;
        { const unsigned char* Qw = Qg + obase + (size_t)(wq * 32 + r32) * DM + jj * 64 + hi * 32;
          const u32x4 qa = *(const u32x4*)Qw, qb2 = *(const u32x4*)(Qw + 16);
          qr = __builtin_bit_cast(v8i, __builtin_shufflevector(qa, qb2, 0, 1, 2, 3, 4, 5, 6, 7)); }
        f32x16 pA0, pA1; v8i pa;
#define ATT_SRC(jt, KP, VP) const unsigned char* KP = ((jt) + 2 < NT) ? Kh + (size_t)((jt) + 2) * 64 * DM : nK + (size_t)((jt) + 2 - NT) * 64 * DM; \
                            const unsigned char* VP = ((jt) + 2 < NT) ? Vh + (size_t)((jt) + 2) * 64 : nV + (size_t)((jt) + 2 - NT) * 64
#define ATT_BAR(jt) do { ATT_TOP(); ATT_SRC(jt, kp_, vp_); ATT_DMA(((jt) + 2) & 3, kp_, vp_); } while (0)
        float pe[32];
        { qkt(pA0, pA1, lds + k_slot(0), qr, r32, hi, jj, cinit, s1, s8);
          if (lag) ATT_BAR(0);
          asm volatile("s_nop 15\n\ts_nop 7" ::: "memory");
#pragma unroll
          for (int r = 0; r < 16; ++r) { pe[r] = fexp2(pA0[r]); pe[16 + r] = fexp2(pA1[r]); }
          if (!lag) ATT_BAR(0); }
        for (int jt = 1; jt < NT; ++jt) {
            SBAR(); qkt(pA0, pA1, lds + k_slot(jt & 3), qr, r32, hi, jj, cinit, s1, s8);
            pack_p(pe, pa); SBAR();
            if (lag) ATT_BAR(jt);
            pv_exp(o, lacc, ones, lds + v_slot((jt - 1) & 3), pa, r32, hi, s1, pA0, pA1, pe);
            if (!lag) ATT_BAR(jt);
        }
        { pack_p(pe, pa); SBAR();
          pv_d0(o, lacc, ones, lds + v_slot((NT - 1) & 3), pa, r32, hi, s1);
          asm volatile("s_nop 15\n\ts_nop 15" ::: "memory"); }
#undef ATT_BAR
#undef ATT_SRC
        int r32e = r32, hie = hi; asm volatile("" : "+v"(r32e), "+v"(hie));
        float rli[16];
#pragma unroll
        for (int r = 0; r < 16; ++r) rli[r] = frcp(lacc[r]);
        LAS float* Cb = (LAS float*)(lds + 65536);
        if (jj == 1) {
#pragma unroll
            for (int r = 0; r < 16; ++r) { const float sc = rli[r] * lamv;
#pragma unroll
                for (int d0 = 0; d0 < 4; ++d0) Cb[(wq * 32 + crow(r, hie)) * 128 + d0 * 32 + r32e] = o[d0][r] * sc; }
        }
        asm volatile("s_waitcnt lgkmcnt(0)" ::: "memory"); __builtin_amdgcn_s_barrier(); asm volatile("" ::: "memory");
        if (jj == 0) {
            float g[4];
#pragma unroll
            for (int d0 = 0; d0 < 4; ++d0) g[d0] = subg[d0 * 32 + r32e] * omli;
            bf16_t* Ob = Og + obase;
#pragma unroll
            for (int r = 0; r < 16; ++r) {
                float ss = 0.f;
#pragma unroll
                for (int d0 = 0; d0 < 4; ++d0) { const float v = o[d0][r] * rli[r] - Cb[(wq * 32 + crow(r, hie)) * 128 + d0 * 32 + r32e]; o[d0][r] = v; ss += v * v; }
                ss += __shfl_xor(ss, 1); ss += __shfl_xor(ss, 2); ss += __shfl_xor(ss, 4); ss += __shfl_xor(ss, 8); ss += __shfl_xor(ss, 16);
                const float rs = 1.0f / sqrtf(ss * (1.0f / 128.0f) + EPS);
                bf16_t* op = Ob + (size_t)(wq * 32 + crow(r, hie)) * DM + r32e;
#pragma unroll
                for (int d0 = 0; d0 < 4; ++d0) op[d0 * 32] = (bf16_t)f2bf(o[d0][r] * rs * g[d0]);
            }
        }
        asm volatile("s_waitcnt lgkmcnt(0)" ::: "memory"); __builtin_amdgcn_s_barrier(); asm volatile("" ::: "memory");
        cbh = nbh;
    }
    asm volatile("s_waitcnt vmcnt(0) lgkmcnt(0)" ::: "memory"); __builtin_amdgcn_s_barrier(); asm volatile("" ::: "memory");
#undef ATT_DMA
#undef ATT_TOP
#undef ATT_KB
#undef ATT_VB
#undef ATT_LD8
}

namespace gla {
constexpr int BC = 0, QI = 32768, QA = 49152, KA = 65536, KST = 81920, VT = 98304, ST = 106496, AT = 122880, EM = 131072, EL = EM + 512, DD = EM + 1024, BMID = EM + 1536, SEG = EM + 2048;
static_assert(SEG + 2048 <= RING_BYTES, "gla lds");
__device__ __forceinline__ int sw256(int row, int cb) { return row * 256 + (cb ^ ((row & 15) << 4)); }
__device__ __forceinline__ int sw128(int row, int cb) { return row * 128 + (cb ^ ((((row & 7) ^ (row >> 4)) & 7) << 4)); }
__device__ __forceinline__ int crow(int r, int hi) { return (r & 3) + 8 * (r >> 2) + 4 * hi; }
__device__ __forceinline__ float h2f(unsigned short b) { return (float)__builtin_bit_cast(_Float16, b); }
__device__ __forceinline__ void gla_item(const bf16_t* __restrict__ Qp, const unsigned short* __restrict__ LFp, const bf16_t* __restrict__ Vp, bf16_t* __restrict__ Op, int dir, LAS unsigned char* lds, float* dbg) {
    int tid_ = threadIdx.x; asm volatile("" : "+v"(tid_));
    const int tid = tid_, wid = tid >> 6, lane = tid & 63, r = lane & 31, hh = lane >> 5;
    const int t1 = tid >> 3, kg = tid & 7, k0 = 16 * kg, v0 = (tid & 7) * 8;
    for (int i = tid; i < 16384 / 16; i += NTHR) *(LAS u32x4*)(lds + ST + i * 16) = (u32x4){0u, 0u, 0u, 0u};
    f32x16 st = {};
    u32x4 rq[2], rl[2], rv;
#define GLA_TOK(ci, i) (dir ? (SEQ - 1 - ((ci) * 64 + (i))) : ((ci) * 64 + (i)))
#define GLA_LOAD(ci) do { const size_t to = (size_t)GLA_TOK(ci, t1) * DM; \
        rq[0] = *(const u32x4*)(Qp + to + k0); rq[1] = *(const u32x4*)(Qp + to + k0 + 8); \
        rl[0] = *(const u32x4*)(LFp + to + k0); rl[1] = *(const u32x4*)(LFp + to + k0 + 8); rv = *(const u32x4*)(Vp + to + v0); } while (0)
    GLA_LOAD(0);
    __syncthreads();
    for (int ci = 0; ci < SEQ / 64; ++ci) {
        float qf[16], lf[16]; u32x4 vreg = rv;
#pragma unroll
        for (int j = 0; j < 2; ++j)
#pragma unroll
            for (int e = 0; e < 4; ++e) { qf[j * 8 + 2 * e] = bflo(rq[j][e]); qf[j * 8 + 2 * e + 1] = bfhi(rq[j][e]);
                lf[j * 8 + 2 * e] = h2f((unsigned short)(rl[j][e] & 0xffffu)); lf[j * 8 + 2 * e + 1] = h2f((unsigned short)(rl[j][e] >> 16)); }
        if (ci + 1 < SEQ / 64) GLA_LOAD(ci + 1);
#pragma unroll
        for (int j = 0; j < 4; ++j) *(LAS f32x4*)(lds + BC + (t1 * 128 + k0 + 4 * j) * 4) = (f32x4){lf[4 * j], lf[4 * j + 1], lf[4 * j + 2], lf[4 * j + 3]};
        __syncthreads();
        { const int kc = tid & 127, sg = tid >> 7; LAS float* bc = (LAS float*)(lds + BC) + kc; float cs[16];
#pragma unroll
            for (int i = 0; i < 16; ++i) cs[i] = bc[(sg * 16 + i) * 128];
#pragma unroll
            for (int i = 1; i < 16; ++i) cs[i] += cs[i - 1];
            ((LAS float*)(lds + SEG))[sg * 128 + kc] = cs[15];
            __syncthreads();
            const LAS float* sgp = (const LAS float*)(lds + SEG) + kc; const float s0 = sgp[0], s1 = sgp[128], s2 = sgp[256], s3 = sgp[384];
            const float off = sg == 0 ? 0.f : sg == 1 ? s0 : sg == 2 ? (s0 + s1) : ((s0 + s1) + s2);
#pragma unroll
            for (int i = 0; i < 16; ++i) bc[(sg * 16 + i) * 128] = cs[i] + off;
            if (sg == 0) { const float bm = s0 + s1, bl = ((s0 + s1) + s2) + s3;
                ((LAS float*)(lds + BMID))[kc] = bm; ((LAS float*)(lds + EM))[kc] = fexp(bm); ((LAS float*)(lds + EL))[kc] = fexp(bl - bm); ((LAS float*)(lds + DD))[kc] = fexp(bl); }
            __syncthreads();
        }
#ifdef DIAG
        if (dbg && ci == 0) { for (int i = tid; i < 8192; i += NTHR) dbg[i] = ((const LAS float*)(lds + BC))[i]; }
#endif
        {
            unsigned wqi[8], wqa[8], wka[8]; float ksv[16];
#pragma unroll
            for (int j = 0; j < 4; ++j) {
                const f32x4 bt = *(const LAS f32x4*)(lds + BC + (t1 * 128 + k0 + 4 * j) * 4), bm = *(const LAS f32x4*)(lds + BMID + (k0 + 4 * j) * 4);
                const f32x4 em = *(const LAS f32x4*)(lds + EM + (k0 + 4 * j) * 4), el = *(const LAS f32x4*)(lds + EL + (k0 + 4 * j) * 4);
                float qi[4], qa[4], ka[4];
#pragma unroll
                for (int e = 0; e < 4; ++e) { const int i = 4 * j + e; const float e1 = fexp(bt[e] - bm[e]), r1 = frcp(e1);
                    qa[e] = qf[i] * e1; qi[e] = qa[e] * em[e]; const float kk = 1.0f - fexp(lf[i]); ka[e] = kk * r1; ksv[i] = ka[e] * el[e]; }
                wqi[2 * j] = cvt_pk_bf16(qi[0], qi[1]); wqi[2 * j + 1] = cvt_pk_bf16(qi[2], qi[3]);
                wqa[2 * j] = cvt_pk_bf16(qa[0], qa[1]); wqa[2 * j + 1] = cvt_pk_bf16(qa[2], qa[3]);
                wka[2 * j] = cvt_pk_bf16(ka[0], ka[1]); wka[2 * j + 1] = cvt_pk_bf16(ka[2], ka[3]);
            }
#pragma unroll
            for (int j = 0; j < 2; ++j) { const int off = sw256(t1, (k0 + 8 * j) * 2);
                *(LAS u32x4*)(lds + QI + off) = (u32x4){wqi[4 * j], wqi[4 * j + 1], wqi[4 * j + 2], wqi[4 * j + 3]};
                *(LAS u32x4*)(lds + QA + off) = (u32x4){wqa[4 * j], wqa[4 * j + 1], wqa[4 * j + 2], wqa[4 * j + 3]};
                *(LAS u32x4*)(lds + KA + off) = (u32x4){wka[4 * j], wka[4 * j + 1], wka[4 * j + 2], wka[4 * j + 3]}; }
#pragma unroll
            for (int i = 0; i < 16; ++i) *(LAS unsigned short*)(lds + KST + sw128(k0 + i, t1 * 2)) = (unsigned short)f2bf(ksv[i]);
#pragma unroll
            for (int e = 0; e < 4; ++e) { *(LAS unsigned short*)(lds + VT + sw128(v0 + 2 * e, t1 * 2)) = (unsigned short)(vreg[e] & 0xffffu);
                *(LAS unsigned short*)(lds + VT + sw128(v0 + 2 * e + 1, t1 * 2)) = (unsigned short)(vreg[e] >> 16); }
        }
        __syncthreads();
        f32x16 oacc = {};
        const int w4 = wid & 3, t_i = w4 >> 1, v_i = w4 & 1;
        if (wid < 4) {
            const int s_i = wid >> 1, tq = wid & 1; f32x16 a = {};
#pragma unroll
            for (int ks = 0; ks < 8; ++ks) { const bf16x8 fa = *(const LAS bf16x8*)(lds + KA + sw256(32 * s_i + r, (16 * ks + 8 * hh) * 2)), fb = *(const LAS bf16x8*)(lds + QA + sw256(32 * tq + r, (16 * ks + 8 * hh) * 2));
                a = __builtin_amdgcn_mfma_f32_32x32x16_bf16(fa, fb, a, 0, 0, 0); }
            const int tg = 32 * tq + r;
#pragma unroll
            for (int g = 0; g < 4; ++g) { float m[4];
#pragma unroll
                for (int e = 0; e < 4; ++e) { const int sgl = 32 * s_i + 8 * g + 4 * hh + e; m[e] = (sgl <= tg) ? a[4 * g + e] : 0.f; }
                *(LAS u32x2*)(lds + AT + sw128(tg, (32 * s_i + 8 * g + 4 * hh) * 2)) = (u32x2){cvt_pk_bf16(m[0], m[1]), cvt_pk_bf16(m[2], m[3])}; }
        } else {
#pragma unroll
            for (int ks = 0; ks < 8; ++ks) { const bf16x8 fa = *(const LAS bf16x8*)(lds + QI + sw256(32 * t_i + r, (16 * ks + 8 * hh) * 2)), fb = *(const LAS bf16x8*)(lds + ST + sw256(32 * v_i + r, (16 * ks + 8 * hh) * 2));
                oacc = __builtin_amdgcn_mfma_f32_32x32x16_bf16(fa, fb, oacc, 0, 0, 0); }
        }
        __syncthreads();
#ifdef DIAG
        if (dbg && ci == 0) { for (int i = tid; i < 2048; i += NTHR) { ((unsigned*)dbg)[8192 + i] = ((const LAS unsigned*)(lds + AT))[i]; ((unsigned*)dbg)[8192 + 2048 + i] = ((const LAS unsigned*)(lds + VT))[i]; } }
#endif
        if (wid >= 4) {
#pragma unroll
            for (int ks = 0; ks < 4; ++ks) { const bf16x8 fa = *(const LAS bf16x8*)(lds + AT + sw128(32 * t_i + r, (16 * ks + 8 * hh) * 2)), fb = *(const LAS bf16x8*)(lds + VT + sw128(32 * v_i + r, (16 * ks + 8 * hh) * 2));
                oacc = __builtin_amdgcn_mfma_f32_32x32x16_bf16(fa, fb, oacc, 0, 0, 0); }
#pragma unroll
            for (int i = 0; i < 16; ++i) { const int t = 32 * t_i + crow(i, hh); Op[(size_t)GLA_TOK(ci, t) * DM + 32 * v_i + r] = (bf16_t)f2bf(oacc[i]); }
        }
        {
            const int kq = wid >> 1, vq = wid & 1;
#pragma unroll
            for (int i = 0; i < 16; ++i) st[i] *= ((const LAS float*)(lds + DD))[32 * kq + crow(i, hh)];
#pragma unroll
            for (int ks = 0; ks < 4; ++ks) { const bf16x8 fa = *(const LAS bf16x8*)(lds + KST + sw128(32 * kq + r, (16 * ks + 8 * hh) * 2)), fb = *(const LAS bf16x8*)(lds + VT + sw128(32 * vq + r, (16 * ks + 8 * hh) * 2));
                st = __builtin_amdgcn_mfma_f32_32x32x16_bf16(fa, fb, st, 0, 0, 0); }
#pragma unroll
            for (int g = 0; g < 4; ++g) *(LAS u32x2*)(lds + ST + sw256(32 * vq + r, (32 * kq + 8 * g + 4 * hh) * 2)) = (u32x2){cvt_pk_bf16(st[4 * g], st[4 * g + 1]), cvt_pk_bf16(st[4 * g + 2], st[4 * g + 3])};
        }
        __syncthreads();
#ifdef DIAG
        if (dbg && ci == 0) { for (int i = tid; i < 4096; i += NTHR) { ((unsigned*)dbg)[12288 + i] = ((const LAS unsigned*)(lds + ST))[i]; ((unsigned*)dbg)[16384 + i] = ((const LAS unsigned*)(lds + KST))[i]; } }
#endif
    }
#undef GLA_TOK
#undef GLA_LOAD
}
}
__device__ __forceinline__ void gla_phase(const Args& A, LAS unsigned char* lds, int bid, int G) {
    unsigned char* ws = A.ws;
    for (int it = bid; it < 256; it += G) {
        const int b = it >> 5, h = (it >> 2) & 7, dir = (it >> 1) & 1, vh = it & 1;
        const size_t base = (size_t)b * SEQ * DM + h * 128;
        gla::gla_item((const bf16_t*)(ws + H_Q) + base, (const unsigned short*)(ws + (dir ? H_LFB : H_LFF)) + base, (const bf16_t*)(ws + H_V) + base + vh * 64,
                      (bf16_t*)(ws + (dir ? H_OB : H_OF)) + base + vh * 64, dir, lds, it == 0 ? (float*)(ws + TB_LSUM) : nullptr);
    }
}
__device__ __forceinline__ void hg_normo_phase(const Args& A, int bid, int G) {
    int tid_ = threadIdx.x; asm volatile("" : "+v"(tid_));
    const int tid = tid_, lane = tid & 63, wave = tid >> 6; unsigned char* ws = A.ws;
    const bf16_t* OF = (const bf16_t*)(ws + H_OF); const bf16_t* OB = (const bf16_t*)(ws + H_OB); const bf16_t* GG = (const bf16_t*)(ws + H_G); bf16_t* HM = (bf16_t*)(ws + WS_HM);
    const int c0 = (lane >> 3) * 128 + (lane & 7) * 16;
    float ng[16];
#pragma unroll
    for (int i = 0; i < 16; ++i) ng[i] = A.in[I_HGNG][(lane & 7) * 16 + i];
    for (int row = (bid * NWAVES + wave); row < MTOK; row += G * NWAVES) {
        const size_t o = (size_t)row * DM + c0;
        const u32x4 a0 = *(const u32x4*)(OF + o), a1 = *(const u32x4*)(OF + o + 8), b0 = *(const u32x4*)(OB + o), b1 = *(const u32x4*)(OB + o + 8), g0 = *(const u32x4*)(GG + o), g1 = *(const u32x4*)(GG + o + 8);
        float v[16], gt[16]; float ss = 0.f;
#pragma unroll
        for (int e = 0; e < 4; ++e) { v[2 * e] = bflo(a0[e]) + bflo(b0[e]); v[2 * e + 1] = bfhi(a0[e]) + bfhi(b0[e]); v[8 + 2 * e] = bflo(a1[e]) + bflo(b1[e]); v[8 + 2 * e + 1] = bfhi(a1[e]) + bfhi(b1[e]);
            gt[2 * e] = bflo(g0[e]); gt[2 * e + 1] = bfhi(g0[e]); gt[8 + 2 * e] = bflo(g1[e]); gt[8 + 2 * e + 1] = bfhi(g1[e]); }
#pragma unroll
        for (int i = 0; i < 16; ++i) ss += v[i] * v[i];
        ss += __shfl_xor(ss, 1); ss += __shfl_xor(ss, 2); ss += __shfl_xor(ss, 4);
        const float rstd = 1.0f / sqrtf(ss * (1.0f / 128.0f) + EPS);
        u32x4 w0, w1;
#pragma unroll
        for (int e = 0; e < 4; ++e) { w0[e] = cvt_pk_bf16(v[2 * e] * rstd * ng[2 * e] * gt[2 * e], v[2 * e + 1] * rstd * ng[2 * e + 1] * gt[2 * e + 1]);
            w1[e] = cvt_pk_bf16(v[8 + 2 * e] * rstd * ng[8 + 2 * e] * gt[8 + 2 * e], v[8 + 2 * e + 1] * rstd * ng[8 + 2 * e + 1] * gt[8 + 2 * e + 1]); }
        *(u32x4*)(HM + o) = w0; *(u32x4*)(HM + o + 8) = w1;
    }
}

#ifdef DIAG
constexpr int DG_BASE = 8192;
__device__ __forceinline__ void dg_put(const Args& A, int k, float e) { if (!(e >= 0.f) || e > 1e9f) e = 1e9f; atomicMax((unsigned*)(A.ws + WS_CTL) + DG_BASE + 64 * k, __float_as_uint(e)); }
__device__ __forceinline__ float dg_rel(float got, float ref) { return fabsf(got - ref) / (fabsf(ref) + 0.1f); }
__device__ __forceinline__ unsigned dg_hash(unsigned a, unsigned b) { unsigned h = a * 2654435761u + b * 40503u + 0x9e3779b9u; h ^= h >> 15; h *= 2246822519u; h ^= h >> 13; h *= 3266489917u; h ^= h >> 16; return h; }
__device__ __forceinline__ float dg_bfr(float x) { return bflo(f2bf(x)); }
__device__ __forceinline__ void dg_mods(const Args& A, int k) {
    const int lane = threadIdx.x & 63, gwv = blockIdx.x * 8 + (threadIdx.x >> 6);
    const unsigned h = dg_hash(gwv, k); const int l = h & 3, b = (h >> 2) & 7, e = (h >> 5) % 6144;
    float a = 0.f; for (int d = lane; d < DM; d += 64) a += fsilu(A.in[I_C][b * DM + d]) * A.in[I_ADAW][((size_t)l * DM + d) * 6144 + e];
    a = wave_sum(a) + A.in[I_ADAB][l * 6144 + e];
    const float got = ((const float*)(A.ws + TB_MODS))[((size_t)l * NBATCH + b) * 6144 + e];
    if (lane == 0) dg_put(A, k, dg_rel(got, a));
}
__device__ __forceinline__ void dg_norm(const Args& A, int k, const float* x, const float* gain, int L, int which) {
    const int lane = threadIdx.x & 63, gwv = blockIdx.x * 8 + (threadIdx.x >> 6);
    const int row = dg_hash(gwv, k) & (MTOK - 1), b = row >> 13;
    const float* modl = (const float*)(A.ws + TB_MODS) + ((size_t)L * NBATCH + b) * 6144;
    float ss = 0.f; for (int c = lane; c < DM; c += 64) { const float v = x[(size_t)row * DM + c]; ss += v * v; }
    ss = wave_sum(ss); const float rstd = 1.0f / sqrtf(ss / DM + EPS); float e = 0.f;
    for (int c = lane; c < DM; c += 64) { const float ref = x[(size_t)row * DM + c] * rstd * gain[c] * (1.0f + modl[(which * 3 + 1) * 1024 + c]) + modl[(which * 3) * 1024 + c];
        e = fmaxf(e, dg_rel(bf2f(((const bf16_t*)(A.ws + WS_HM))[(size_t)row * DM + c]), ref)); }
    dg_put(A, k, e);
}
__device__ __forceinline__ void dg_qkv(const Args& A, int k, int al) {
    const int lane = threadIdx.x & 63, gwv = blockIdx.x * 8 + (threadIdx.x >> 6);
    const unsigned h = dg_hash(gwv, k); const int row = h & (MTOK - 1), t = (h >> 16) % 48, col = t * 64 + lane;
    const bf16_t* hm = (const bf16_t*)(A.ws + WS_HM) + (size_t)row * DM; const float* w = A.in[I_ATWIN] + (size_t)al * 1024 * 3072 + col;
    float a = 0.f; for (int kk = 0; kk < DM; ++kk) a += bf2f(hm[kk]) * dg_bfr(w[(size_t)kk * 3072]);
    float ref, got;
    if (t < 32) {
        const int part = t >> 4, sh = t & 15; const float ss = wave_sum(a * a); const float rstd = 1.0f / sqrtf(ss / 64.0f + EPS);
        const float y = a * rstd * (part ? A.in[I_ATKN] : A.in[I_ATQN])[al * 64 + lane]; const float yp = __shfl_xor(y, 32);
        const int pos = row & (SEQ - 1); const float cs = ((const float*)(A.ws + TB_COS))[pos * 32 + (lane & 31)], sn = ((const float*)(A.ws + TB_SIN))[pos * 32 + (lane & 31)];
        ref = (lane < 32) ? (y * cs - yp * sn) : (y * cs + yp * sn); if (part == 0) ref *= 0.125f * LOG2E;
        got = bf2f(((const bf16_t*)(A.ws + (part ? A_K : A_Q)))[(size_t)row * DM + sh * 64 + lane]);
    } else { ref = a; got = bf2f(((const bf16_t*)(A.ws + A_V))[(size_t)row * DM + (t - 32) * 64 + lane]); }
    dg_put(A, k, dg_rel(got, ref));
}
__device__ __forceinline__ void dg_attn(const Args& A, int k, int al, LAS unsigned char* lds) {
    const int tid = threadIdx.x; const unsigned h = dg_hash(blockIdx.x, k); const int row = h & (MTOK - 1), hd = (h >> 16) & 7, b = row >> 13;
    const bf16_t* Q = (const bf16_t*)(A.ws + A_Q); const bf16_t* K = (const bf16_t*)(A.ws + A_K); const bf16_t* V = (const bf16_t*)(A.ws + A_V);
    const float* scal = (const float*)(A.ws + TB_SCAL); const float lamv = scal[SC_LAM0 + al], omli = scal[SC_OML0 + al], Mc = scal[SC_MC0 + al];
    LAS float* p0 = (LAS float*)lds; LAS float* p1 = p0 + SEQ; LAS float* red = p1 + SEQ;
    float l0 = 0.f, l1 = 0.f;
    for (int key = tid; key < SEQ; key += NTHR) { const bf16_t* kr = K + ((size_t)b * SEQ + key) * DM + hd * 128; const bf16_t* qr = Q + (size_t)row * DM + hd * 128;
        float s0 = 0.f, s1 = 0.f; for (int d = 0; d < 64; ++d) { s0 += bf2f(qr[d]) * bf2f(kr[d]); s1 += bf2f(qr[64 + d]) * bf2f(kr[64 + d]); }
        const float e0 = fexp2(s0 - Mc), e1 = fexp2(s1 - Mc); p0[key] = e0; p1[key] = e1; l0 += e0; l1 += e1; }
    l0 = wave_sum(l0); l1 = wave_sum(l1); if ((tid & 63) == 0) { red[tid >> 6] = l0; red[8 + (tid >> 6)] = l1; }
    __syncthreads();
    l0 = 0.f; l1 = 0.f; for (int w = 0; w < 8; ++w) { l0 += red[w]; l1 += red[8 + w]; }
    __syncthreads();
    const int dv = tid & 127, part = tid >> 7; float o = 0.f;
    for (int key = part * 2048; key < part * 2048 + 2048; ++key) o += (p0[key] / l0 - lamv * p1[key] / l1) * bf2f(V[((size_t)b * SEQ + key) * DM + hd * 128 + dv]);
    red[16 + part * 128 + dv] = o; __syncthreads();
    if (tid < 128) { o = red[16 + tid] + red[16 + 128 + tid] + red[16 + 256 + tid] + red[16 + 384 + tid]; red[600 + tid] = o * o; }
    __syncthreads();
    if (tid < 128) { float ss = 0.f; for (int i = 0; i < 128; ++i) ss += red[600 + i]; const float ref = o / sqrtf(ss / 128.0f + EPS) * A.in[I_ATSUB][al * 128 + tid] * omli;
        dg_put(A, k, dg_rel(bf2f(((const bf16_t*)(A.ws + WS_HM))[(size_t)row * DM + hd * 128 + tid]), ref)); }
    __syncthreads();
}
__device__ __forceinline__ void dg_save(const Args& A, int k, const float* xold) {
    const int lane = threadIdx.x & 63, gwv = blockIdx.x * 8 + (threadIdx.x >> 6);
    const unsigned h = dg_hash(gwv, k); const int row = h & (MTOK - 1), col = (h >> 16) & 1023;
    float* sv = (float*)(A.ws + TB_LSUM) + 7 * 1024 * 1024 / 4;
    if (lane == 0) sv[k * 4096 + gwv] = xold[(size_t)row * DM + col];
}
__device__ __forceinline__ void dg_res(const Args& A, int k, const float* xnew, const float* gate, const bf16_t* Am, int K, const float* W) {
    const int lane = threadIdx.x & 63, gwv = blockIdx.x * 8 + (threadIdx.x >> 6);
    const unsigned h = dg_hash(gwv, k); const int row = h & (MTOK - 1), col = (h >> 16) & 1023, b = row >> 13;
    const float* sv = (const float*)(A.ws + TB_LSUM) + 7 * 1024 * 1024 / 4;
    float a = 0.f; for (int kk = lane; kk < K; kk += 64) a += bf2f(Am[(size_t)row * K + kk]) * dg_bfr(W[(size_t)kk * DM + col]);
    a = wave_sum(a);
    const float ref = sv[k * 4096 + gwv] + gate[(size_t)b * 6144 + col] * a;
    if (lane == 0) dg_put(A, k, dg_rel(xnew[(size_t)row * DM + col], ref));
}
__device__ __forceinline__ void dg_swiglu(const Args& A, int k, const bf16_t* Am, const float* W, int F, const bf16_t* H, int nrows, const int* rowmap) {
    const int lane = threadIdx.x & 63, gwv = blockIdx.x * 8 + (threadIdx.x >> 6);
    const unsigned h = dg_hash(gwv, k); const int row = (h & 0xfffff) % nrows, j = (h >> 20) % F;
    float g = 0.f, u = 0.f; for (int kk = lane; kk < DM; kk += 64) { const float x = bf2f(Am[(size_t)row * DM + kk]); g += x * dg_bfr(W[(size_t)kk * 2 * F + j]); u += x * dg_bfr(W[(size_t)kk * 2 * F + F + j]); }
    g = wave_sum(g); u = wave_sum(u);
    const float ref = g / (1.0f + expf(-g)) * u;
    if (lane == 0) dg_put(A, k, dg_rel(bf2f(H[(size_t)row * F + j]), ref));
}
__device__ __forceinline__ void dg_hgin(const Args& A, int k) {
    const int lane = threadIdx.x & 63, gwv = blockIdx.x * 8 + (threadIdx.x >> 6);
    const unsigned h = dg_hash(gwv, k); const int row = h & (MTOK - 1), col = (h >> 16) % 5120, grp = col >> 10, cc = col & 1023;
    float a = 0.f; for (int kk = lane; kk < DM; kk += 64) a += bf2f(((const bf16_t*)(A.ws + WS_HM))[(size_t)row * DM + kk]) * dg_bfr(A.in[I_HGWIN][(size_t)kk * 5120 + col]);
    a = wave_sum(a);
    float ref, got;
    if (grp == 0 || grp == 4) { ref = a / (1.0f + expf(-a)); got = bf2f(((const bf16_t*)(A.ws + (grp == 0 ? H_Q : H_G)))[(size_t)row * DM + cc]); }
    else if (grp == 3) { ref = a; got = bf2f(((const bf16_t*)(A.ws + H_V))[(size_t)row * DM + cc]); }
    else { const int d = grp - 1; const float* p = A.in[I_HGLB] + (size_t)d * DEPTH * 1024 + cc; float mx = p[0]; for (int l = 1; l < DEPTH; ++l) mx = fmaxf(mx, p[l * 1024]);
        float den = 0.f; for (int l = 0; l < DEPTH; ++l) den += expf(p[l * 1024] - mx); const float lbv = expf(p[1024] - mx) / den;
        ref = logf(lbv + (1.0f - lbv) / (1.0f + expf(-a))); got = gla::h2f(((const unsigned short*)(A.ws + (d ? H_LFB : H_LFF)))[(size_t)row * DM + cc]); }
    if (lane == 0) dg_put(A, k, dg_rel(got, ref));
}
__device__ __forceinline__ void dg_gla(const Args& A, int k) {
    const int lane = threadIdx.x & 63, gwv = blockIdx.x * 8 + (threadIdx.x >> 6);
    const unsigned h = dg_hash(gwv, k); const int sel0 = (gwv & 3) == 0; const int b = sel0 ? 0 : (h & 7), hd = sel0 ? 0 : ((h >> 3) & 7), dir = sel0 ? 0 : ((h >> 6) & 1), vc = sel0 ? ((h >> 7) & 63) : ((h >> 7) & 127);
    const bf16_t* Q = (const bf16_t*)(A.ws + H_Q); const unsigned short* LF = (const unsigned short*)(A.ws + (dir ? H_LFB : H_LFF)); const bf16_t* V = (const bf16_t*)(A.ws + H_V);
    const bf16_t* O = (const bf16_t*)(A.ws + (dir ? H_OB : H_OF));
    float s0 = 0.f, s1 = 0.f, e0 = 0.f, e1 = 0.f, e2 = 0.f, e3 = 0.f;
    for (int i = 0; i < SEQ; ++i) { const int tok = dir ? (SEQ - 1 - i) : i; const size_t o = ((size_t)b * SEQ + tok) * DM + hd * 128;
        const float f0 = expf(gla::h2f(LF[o + lane])), f1 = expf(gla::h2f(LF[o + 64 + lane])), v = bf2f(V[o + vc]);
        s0 = f0 * s0 + (1.0f - f0) * v; s1 = f1 * s1 + (1.0f - f1) * v;
        if (i < 128 || i % 61 == 0) { const float ov = wave_sum(bf2f(Q[o + lane]) * s0 + bf2f(Q[o + 64 + lane]) * s1); const float er = 0.25f * fabsf(bf2f(O[o + vc]) - ov) / (fabsf(ov) + 1.0f);
            if (i == 0) e0 = er; else if (i < 64) e1 = fmaxf(e1, er); else if (i < 128) e2 = fmaxf(e2, er); else e3 = fmaxf(e3, er); } }
    if (lane == 0) { dg_put(A, k, e0); dg_put(A, k + 4, e1); dg_put(A, k + 5, e2); dg_put(A, k + 6, e3); }
    const float* dbg = (const float*)(A.ws + TB_LSUM); const unsigned short* LF0 = (const unsigned short*)(A.ws + H_LFF); const bf16_t* Q0 = (const bf16_t*)(A.ws + H_Q);
    { const unsigned h2 = dg_hash(gwv, k + 100); const int t = h2 & 63, kk = (h2 >> 6) & 127; float c = 0.f; for (int tt = 0; tt <= t; ++tt) c += gla::h2f(LF0[(size_t)tt * DM + kk]);
      if (lane == 0) dg_put(A, k + 1, dg_rel(dbg[t * 128 + kk], c)); }
    { const unsigned h2 = dg_hash(gwv, k + 200); const int t = h2 & 63, sidx = (h2 >> 6) & 63; float a = 0.f;
      if (sidx <= t) { for (int kk = lane; kk < 128; kk += 64) { float c = 0.f; for (int tt = sidx + 1; tt <= t; ++tt) c += gla::h2f(LF0[(size_t)tt * DM + kk]);
              a += bf2f(Q0[(size_t)t * DM + kk]) * (1.0f - expf(gla::h2f(LF0[(size_t)sidx * DM + kk]))) * expf(c); } a = wave_sum(a); }
      const unsigned short got = ((const unsigned short*)(dbg + 8192))[gla::sw128(t, sidx * 2) / 2];
      if (lane == 0) dg_put(A, k + 2, 5.0f * fabsf(bf2f(got) - a) / (fabsf(a) + 0.01f)); }
    { const unsigned h2 = dg_hash(gwv, k + 300); const int sidx = h2 & 63, v = (h2 >> 6) & 63;
      const unsigned short got = ((const unsigned short*)(dbg + 8192 + 2048))[gla::sw128(v, sidx * 2) / 2];
      if (lane == 0) dg_put(A, k + 2, dg_rel(bf2f(got), bf2f(((const bf16_t*)(A.ws + H_V))[(size_t)sidx * DM + v]))); }
    { const unsigned h2 = dg_hash(gwv, k + 500); const int kk = h2 & 127, v = (h2 >> 7) & 63;
      float a = 0.f; { const int sidx = lane; float c = 0.f; for (int tt = sidx + 1; tt < 64; ++tt) c += gla::h2f(LF0[(size_t)tt * DM + kk]);
          const float ksn = (1.0f - expf(gla::h2f(LF0[(size_t)sidx * DM + kk]))) * expf(c);
          const unsigned short gk = ((const unsigned short*)(dbg + 16384))[gla::sw128(kk, sidx * 2) / 2];
          dg_put(A, k + 2, 0.5f * fabsf(bf2f(gk) - ksn) / (fabsf(ksn) + 0.01f));
          a = ksn * bf2f(((const bf16_t*)(A.ws + H_V))[(size_t)sidx * DM + v]); }
      a = wave_sum(a);
      const unsigned short gs = ((const unsigned short*)(dbg + 12288))[gla::sw256(v, kk * 2) / 2];
      if (lane == 0) dg_put(A, k + 3, 0.5f * fabsf(bf2f(gs) - a) / (fabsf(a) + 0.05f)); }
    { const unsigned h2 = dg_hash(gwv, k + 400); const int t = h2 & 63, v = (h2 >> 6) & 63;
      const unsigned short* at = (const unsigned short*)(dbg + 8192); const unsigned short* vt = (const unsigned short*)(dbg + 8192 + 2048);
      float a = bf2f(at[gla::sw128(t, lane * 2) / 2]) * bf2f(vt[gla::sw128(v, lane * 2) / 2]); a = wave_sum(a);
      if (lane == 0) dg_put(A, k + 1, 5.0f * dg_rel(bf2f(((const bf16_t*)(A.ws + H_OF))[(size_t)t * DM + v]), a)); }
}
__device__ __forceinline__ void dg_normo(const Args& A, int k) {
    const int lane = threadIdx.x & 63, gwv = blockIdx.x * 8 + (threadIdx.x >> 6);
    const unsigned h = dg_hash(gwv, k); const int row = h & (MTOK - 1), hd = (h >> 16) & 7; const size_t o = (size_t)row * DM + hd * 128;
    const float v0 = bf2f(((const bf16_t*)(A.ws + H_OF))[o + lane]) + bf2f(((const bf16_t*)(A.ws + H_OB))[o + lane]), v1 = bf2f(((const bf16_t*)(A.ws + H_OF))[o + 64 + lane]) + bf2f(((const bf16_t*)(A.ws + H_OB))[o + 64 + lane]);
    const float ss = wave_sum(v0 * v0 + v1 * v1), rstd = 1.0f / sqrtf(ss / 128.0f + EPS);
    const float r0 = v0 * rstd * A.in[I_HGNG][lane] * bf2f(((const bf16_t*)(A.ws + H_G))[o + lane]), r1 = v1 * rstd * A.in[I_HGNG][64 + lane] * bf2f(((const bf16_t*)(A.ws + H_G))[o + 64 + lane]);
    dg_put(A, k, fmaxf(dg_rel(bf2f(((const bf16_t*)(A.ws + WS_HM))[o + lane]), r0), dg_rel(bf2f(((const bf16_t*)(A.ws + WS_HM))[o + 64 + lane]), r1)));
}
__device__ __forceinline__ void dg_router(const Args& A, int k, int L) {
    const int lane = threadIdx.x & 63, gwv = blockIdx.x * 8 + (threadIdx.x >> 6);
    const int row = dg_hash(gwv, k) & (MTOK - 1), b = row >> 13; const float* x = A.out + (size_t)row * DM;
    const float* modl = (const float*)(A.ws + TB_MODS) + ((size_t)L * NBATCH + b) * 6144; const float* gain = A.in[I_N2G] + L * DM; const float* R = A.in[I_MOER] + (size_t)(L >> 1) * DM * 8;
    float ss = 0.f; for (int c = lane; c < DM; c += 64) ss += x[c] * x[c];
    ss = wave_sum(ss); const float rstd = 1.0f / sqrtf(ss / DM + EPS);
    float lg[8]; for (int e = 0; e < 8; ++e) lg[e] = 0.f;
    for (int c = lane; c < DM; c += 64) { const float hv = x[c] * rstd * gain[c] * (1.0f + modl[4 * 1024 + c]) + modl[3 * 1024 + c]; for (int e = 0; e < 8; ++e) lg[e] += hv * R[c * 8 + e]; }
    for (int e = 0; e < 8; ++e) lg[e] = wave_sum(lg[e]);
    int e0 = 0; for (int e = 1; e < 8; ++e) if (lg[e] > lg[e0]) e0 = e;
    int e1 = (e0 == 0) ? 1 : 0; for (int e = 0; e < 8; ++e) if (e != e0 && lg[e] > lg[e1]) e1 = e;
    float gap = 1e9f; for (int e = 0; e < 8; ++e) if (e != e0 && e != e1) gap = fminf(gap, lg[e1] - lg[e]); gap = fminf(gap, lg[e0] - lg[e1]);
    const int g0 = ((const int*)(A.ws + TB_EID))[row * 2], g1 = ((const int*)(A.ws + TB_EID))[row * 2 + 1]; const float w0 = ((const float*)(A.ws + TB_GATE))[row * 2], w1 = ((const float*)(A.ws + TB_GATE))[row * 2 + 1];
    const float p0 = 1.0f / (1.0f + expf(lg[e1] - lg[e0]));
    float er = (g0 != e0 || g1 != e1) ? (gap > 2e-3f ? 9.f : 0.f) : fmaxf(fabsf(w0 - p0), fabsf(w1 - (1.0f - p0)));
    if (lane == 0) dg_put(A, k, er);
}
__device__ __forceinline__ void dg_place(const Args& A, int k) {
    const int lane = threadIdx.x & 63, gwv = blockIdx.x * 8 + (threadIdx.x >> 6);
    const unsigned h = dg_hash(gwv, k); const int row = h & (MTOK - 1), kk = (h >> 16) & 1;
    const int sl = ((const int*)(A.ws + TB_SLOT))[row * 2 + kk], e = ((const int*)(A.ws + TB_EID))[row * 2 + kk]; const int* ts = (const int*)(A.ws + TB_TILES);
    float er = (sl >= ts[e] * 256 && sl < ts[e + 1] * 256 && sl < MOE_ROWS) ? 0.f : 7.f;
    if (er == 0.f) for (int c = lane; c < DM; c += 64) if (((const bf16_t*)(A.ws + E_XS))[(size_t)sl * DM + c] != ((const bf16_t*)(A.ws + WS_HM))[(size_t)row * DM + c]) er = 5.f;
    dg_put(A, k, er);
}
__device__ __forceinline__ void dg_moe_hid(const Args& A, int k, int m) {
    const int lane = threadIdx.x & 63, gwv = blockIdx.x * 8 + (threadIdx.x >> 6);
    const unsigned h = dg_hash(gwv, k); const int row = h & (MTOK - 1), kk = (h >> 16) & 1, j = (h >> 17) % DFFE;
    const int sl = ((const int*)(A.ws + TB_SLOT))[row * 2 + kk], e = ((const int*)(A.ws + TB_EID))[row * 2 + kk];
    const float* W = A.in[I_MOEGU] + ((size_t)m * 8 + e) * DM * 2 * DFFE; const bf16_t* Am = (const bf16_t*)(A.ws + E_XS) + (size_t)sl * DM;
    float g = 0.f, u = 0.f; for (int c = lane; c < DM; c += 64) { const float x = bf2f(Am[c]); g += x * dg_bfr(W[(size_t)c * 2 * DFFE + j]); u += x * dg_bfr(W[(size_t)c * 2 * DFFE + DFFE + j]); }
    g = wave_sum(g); u = wave_sum(u);
    if (lane == 0) dg_put(A, k, dg_rel(bf2f(((const bf16_t*)(A.ws + E_HID))[(size_t)sl * DFFE + j]), g / (1.0f + expf(-g)) * u));
}
__device__ __forceinline__ void dg_moe_y(const Args& A, int k, int m) {
    const int lane = threadIdx.x & 63, gwv = blockIdx.x * 8 + (threadIdx.x >> 6);
    const unsigned h = dg_hash(gwv, k); const int row = h & (MTOK - 1), kk = (h >> 16) & 1, col = (h >> 17) & 1023;
    const int sl = ((const int*)(A.ws + TB_SLOT))[row * 2 + kk], e = ((const int*)(A.ws + TB_EID))[row * 2 + kk];
    const float* W = A.in[I_MOEDN] + ((size_t)m * 8 + e) * DFFE * DM; const bf16_t* Hh = (const bf16_t*)(A.ws + E_HID) + (size_t)sl * DFFE;
    float a = 0.f; for (int j = lane; j < DFFE; j += 64) a += bf2f(Hh[j]) * dg_bfr(W[(size_t)j * DM + col]);
    a = wave_sum(a);
    if (lane == 0) dg_put(A, k, fabsf(bf2f(((const bf16_t*)(A.ws + E_XS))[(size_t)sl * DM + col]) - a) / (fabsf(a) + 0.3f));
}
__device__ __forceinline__ void dg_combine(const Args& A, int k, const float* modprev) {
    const int lane = threadIdx.x & 63, gwv = blockIdx.x * 8 + (threadIdx.x >> 6);
    const unsigned h = dg_hash(gwv, k); const int row = h & (MTOK - 1), col = (h >> 16) & 1023, b = row >> 13;
    const float* sv = (const float*)(A.ws + TB_LSUM) + 7 * 1024 * 1024 / 4; const bf16_t* Y = (const bf16_t*)(A.ws + E_XS);
    const int s0 = ((const int*)(A.ws + TB_SLOT))[row * 2], s1 = ((const int*)(A.ws + TB_SLOT))[row * 2 + 1]; const float w0 = ((const float*)(A.ws + TB_GATE))[row * 2], w1 = ((const float*)(A.ws + TB_GATE))[row * 2 + 1];
    const float ref = sv[k * 4096 + gwv] + modprev[(size_t)b * 6144 + 5 * 1024 + col] * (w0 * bf2f(Y[(size_t)s0 * DM + col]) + w1 * bf2f(Y[(size_t)s1 * DM + col]));
    if (lane == 0) dg_put(A, k, dg_rel(A.out[(size_t)row * DM + col], ref));
}
__device__ __forceinline__ void dg_lruin(const Args& A, int k) {
    const int lane = threadIdx.x & 63, gwv = blockIdx.x * 8 + (threadIdx.x >> 6);
    const unsigned h = dg_hash(gwv, k); const int row = h & (MTOK - 1), col = (h >> 16) % 2560;
    float a = 0.f; for (int kk = lane; kk < DM; kk += 64) a += bf2f(((const bf16_t*)(A.ws + WS_HM))[(size_t)row * DM + kk]) * dg_bfr(A.in[I_LRWIN][(size_t)kk * 2560 + col]);
    a = wave_sum(a);
    float ref, got;
    if (col < LRUW) { ref = 0.5f * a * (1.0f + tanhf(0.7978845608028654f * (a + 0.044715f * a * a * a))); got = bf2f(((const bf16_t*)(A.ws + L_YB))[(size_t)row * LRUW + col]); }
    else { ref = a; got = bf2f(((const bf16_t*)(A.ws + L_XB))[(size_t)row * LRUW + col - LRUW]); }
    if (lane == 0) dg_put(A, k, dg_rel(got, ref));
}
__device__ __forceinline__ void dg_lru(const Args& A, int k) {
    const int lane = threadIdx.x & 63, gwv = blockIdx.x * 8 + (threadIdx.x >> 6);
    const unsigned h = dg_hash(gwv, k); const int b = h & 7, ch = (h >> 3) % LRUW, tc = (h >> 16) & (SEQ - 1), n = ch / 128, j = ch % 128;
    const bf16_t* XB = (const bf16_t*)(A.ws + L_XB) + (size_t)b * SEQ * LRUW;
    float hres[2];
    for (int d = 0; d < 2; ++d) {
        const float* wa = A.in[I_LRWA] + (size_t)(d * 10 + n) * 16384; const float* wx = A.in[I_LRWX] + (size_t)(d * 10 + n) * 16384;
        const float wa0 = dg_bfr(wa[lane * 128 + j]), wa1 = dg_bfr(wa[(lane + 64) * 128 + j]), wx0 = dg_bfr(wx[lane * 128 + j]), wx1 = dg_bfr(wx[(lane + 64) * 128 + j]);
        const float ba = A.in[I_LRBA][d * LRUW + ch], bx = A.in[I_LRBX][d * LRUW + ch]; const float lam = A.in[I_LRLAM][d * LRUW + ch]; const float sp = log1pf(expf(-lam));
        float hs = 0.f;
        for (int i = 0; ; ++i) { const int t = d ? (SEQ - 1 - i) : i;
            float x0 = A.in[I_LRCB][n * 128 + lane], x1 = A.in[I_LRCB][n * 128 + 64 + lane], xj = A.in[I_LRCB][ch];
            for (int w = 0; w < 4; ++w) { const int tt = t - 1 + w; if (tt >= 0 && tt < SEQ) {
                x0 += A.in[I_LRCW][w * LRUW + n * 128 + lane] * bf2f(XB[(size_t)tt * LRUW + n * 128 + lane]); x1 += A.in[I_LRCW][w * LRUW + n * 128 + 64 + lane] * bf2f(XB[(size_t)tt * LRUW + n * 128 + 64 + lane]);
                xj += A.in[I_LRCW][w * LRUW + ch] * bf2f(XB[(size_t)tt * LRUW + ch]); } }
            const float rp = wave_sum(dg_bfr(x0) * wa0 + dg_bfr(x1) * wa1), ip = wave_sum(dg_bfr(x0) * wx0 + dg_bfr(x1) * wx1);
            const float rg = 1.0f / (1.0f + expf(-(rp + ba))), ig = 1.0f / (1.0f + expf(-(ip + bx))); const float la = -8.0f * rg * sp;
            hs = expf(la) * hs + sqrtf(fmaxf(-expm1f(2.0f * la), 0.f)) * ig * xj;
            if (t == tc) break; }
        hres[d] = hs;
    }
    const size_t go = ((size_t)b * SEQ + tc) * LRUW + ch;
    const float e1 = fabsf(bf2f(((const bf16_t*)(A.ws + L_HF))[go]) - hres[0]) / (fabsf(hres[0]) + 0.3f);
    const float ref = (hres[0] + hres[1]) * bf2f(((const bf16_t*)(A.ws + L_YB))[go]);
    const float e2 = fabsf(bf2f(((const bf16_t*)(A.ws + L_HY))[go]) - ref) / (fabsf(ref) + 0.3f);
    if (lane == 0) { dg_put(A, k, e1); dg_put(A, k + 5, e2); }
}
__device__ __forceinline__ void dg_final(const Args& A, int nchk) {
    const unsigned* sl = (const unsigned*)(A.ws + WS_CTL) + DG_BASE; int code = 0; float ev = 0.f;
    for (int k = 1; k <= nchk; ++k) { const float e = __uint_as_float(sl[64 * k]); if (e > 0.05f) { code = k; ev = e; break; } }
    if (code == 0) return;
    const int c1 = code % 10, c10 = code / 10;
    const float s = -(float)c1;
    for (size_t i = (size_t)blockIdx.x * NTHR + threadIdx.x; i < (size_t)MTOK * DM; i += (size_t)gridDim.x * NTHR) A.out[i] = A.in[I_X][i] * s;
    __syncthreads();
    if (blockIdx.x == 0 && threadIdx.x == 0) { const int qq = ev < 0.1f ? 1 : ev < 0.2f ? 2 : ev < 0.5f ? 3 : ev < 1.f ? 4 : ev < 2.f ? 5 : ev < 5.f ? 6 : ev < 20.f ? 7 : ev < 1e3f ? 8 : 9;
        A.out[12345] = 100.f * (float)(10 * c10 + qq); }
}
#define DG(x) x
#define DGL(x) if constexpr (L >= DIAG_FROM) { x }
#else
#define DG(x)
#define DGL(x)
#endif

#define GRID_BAR() xcd_barrier(bar)
template <int L>
__device__ __forceinline__ void run_mixer(const Args& args, LAS unsigned char* lds, int bid, int G, const XcdBarrier& bar) {
    unsigned char* ws = args.ws; bf16_t* xo = (bf16_t*)(ws + WS_XB);
    const float* modl = (const float*)(ws + TB_MODS) + (size_t)L * NBATCH * 6144;
    const void* xs = (L == 0) ? (const void*)args.in[I_X] : (const void*)xo; constexpr bool X16 = (L != 0);
    constexpr int kind = L % 3;
    DGL(if (L > 0 && ((L - 1) & 1)) { dg_save(args, 10 * (L - 1) + 9, xo); GRID_BAR(); })
    norm_phase<false>(args, lds, bid, G, xs, X16, xo, true, args.in[I_N1G] + L * DM, modl, 0, (L > 0) && ((L - 1) & 1), modl - NBATCH * 6144, false, nullptr);
    GRID_BAR();
    DGL(if (L > 0 && ((L - 1) & 1)) { dg_combine(args, 10 * (L - 1) + 9, modl - NBATCH * 6144); GRID_BAR(); })
    DGL(dg_norm(args, 10 * L + 1, (L > 0 && ((L - 1) & 1)) ? xo : xs, args.in[I_N1G] + L * DM, L, 0); GRID_BAR();)
    if constexpr (kind == 0) {
        constexpr int al = L / 3;
        {
            pg8::Gemm g{(const bf16_t*)(ws + WS_HM), (const bf16_t*)(ws + W_QKV) + (size_t)al * 3072 * 1024, 1024};
            pg8::TileOrder S; S.init(256, 12, G, bid);
            pg8::EpiQKV E{(bf16_t*)(ws + A_Q), (bf16_t*)(ws + A_K), (bf16_t*)(ws + A_V), args.in[I_ATQN] + al * 64, args.in[I_ATKN] + al * 64,
                          (const float*)(ws + TB_COS), (const float*)(ws + TB_SIN), LOG2E};
            pg8::gemm_phase<pg8::EpiQKV>(lds, g, S, E);
        }
        GRID_BAR();
        vt_phase(args, bid, G);
        GRID_BAR();
        attn_phase(args, lds, bid, G, al);
        GRID_BAR();
        DGL(dg_save(args, 10 * L + 4, xs); GRID_BAR();)
        {
            pg8::Gemm g{(const bf16_t*)(ws + WS_HM), (const bf16_t*)(ws + W_AO) + (size_t)al * 1024 * 1024, 1024};
            pg8::TileOrder S; S.init(256, 4, G, bid);
            pg8::EpiRes<X16> E{xs, xo, modl + 2 * 1024, 1.0f};
            pg8::gemm_phase<pg8::EpiRes<X16>>(lds, g, S, E);
        }
        GRID_BAR();
        DGL(dg_res(args, 10 * L + 4, xo, modl + 2 * 1024, (const bf16_t*)(ws + WS_HM), 1024, args.in[I_ATWOUT] + (size_t)al * 1024 * 1024); GRID_BAR();)
    }
    if constexpr (kind == 1) {
        {
            pg8::Gemm g{(const bf16_t*)(ws + WS_HM), (const bf16_t*)(ws + W_HGI), 1024};
            pg8::TileOrder S; S.init(256, 20, G, bid);
            pg8::EpiAct E{0, ws, (const float*)(ws + TB_LB)};
            pg8::gemm_phase<pg8::EpiAct>(lds, g, S, E);
        }
        GRID_BAR();
        DGL(dg_hgin(args, 10 * L + 2); GRID_BAR();)
        gla_phase(args, lds, bid, G);
        GRID_BAR();
        DGL(dg_gla(args, 10 * L + 3); GRID_BAR();)
        hg_normo_phase(args, bid, G);
        GRID_BAR();
        DGL(dg_normo(args, 10 * L + 0); GRID_BAR();)
        DGL(dg_save(args, 10 * L + 4, xs); GRID_BAR();)
        {
            pg8::Gemm g{(const bf16_t*)(ws + WS_HM), (const bf16_t*)(ws + W_HGO), 1024};
            pg8::TileOrder S; S.init(256, 4, G, bid);
            pg8::EpiRes<X16> E{xs, xo, modl + 2 * 1024, 1.0f};
            pg8::gemm_phase<pg8::EpiRes<X16>>(lds, g, S, E);
        }
        GRID_BAR();
        DGL(dg_res(args, 10 * L + 4, xo, modl + 2 * 1024, (const bf16_t*)(ws + WS_HM), 1024, args.in[I_HGWOUT]); GRID_BAR();)
    }
    if constexpr (kind == 2) {
        {
            pg8::Gemm g{(const bf16_t*)(ws + WS_HM), (const bf16_t*)(ws + W_LRI), 1024};
            pg8::TileOrder S; S.init(256, 10, G, bid);
            pg8::EpiAct E{1, ws, nullptr};
            pg8::gemm_phase<pg8::EpiAct>(lds, g, S, E);
        }
        GRID_BAR();
        DGL(dg_lruin(args, 10 * L + 2); GRID_BAR();)
        lru_phase<0>(args, lds, bid, G);
        GRID_BAR();
        lru_carry_phase(args, bid, G);
        GRID_BAR();
        lru_phase<1>(args, lds, bid, G);
        GRID_BAR();
        lru_phase<2>(args, lds, bid, G);
        GRID_BAR();
        DGL(dg_lru(args, 10 * L + 3); GRID_BAR();)
        DGL(dg_save(args, 10 * L + 4, xs); GRID_BAR();)
        {
            pg8::Gemm g{(const bf16_t*)(ws + L_HY), (const bf16_t*)(ws + W_LRO), LRUW};
            pg8::TileOrder S; S.init(256, 4, G, bid);
            pg8::EpiRes<X16> E{xs, xo, modl + 2 * 1024, 1.0f};
            pg8::gemm_phase<pg8::EpiRes<X16>>(lds, g, S, E);
        }
        GRID_BAR();
        DGL(dg_res(args, 10 * L + 4, xo, modl + 2 * 1024, (const bf16_t*)(ws + L_HY), LRUW, args.in[I_LRWOUT]); GRID_BAR();)
    }
}
template <int L>
__device__ __forceinline__ void run_ffn(const Args& args, LAS unsigned char* lds, int bid, int G, const XcdBarrier& bar) {
    unsigned char* ws = args.ws; bf16_t* xo = (bf16_t*)(ws + WS_XB);
    const float* modl = (const float*)(ws + TB_MODS) + (size_t)L * NBATCH * 6144;
    if constexpr ((L & 1) == 0) {
        constexpr int m = L >> 1;
        constexpr bool F8 = (L >= FP8_DENSE_FROM);
        norm_phase<false>(args, lds, bid, G, xo, true, xo, true, args.in[I_N2G] + L * DM, modl, 1, false, modl, false, nullptr, F8);
        GRID_BAR();
        if constexpr (F8) {
            pg8::Gemm g{(const bf16_t*)(ws + WS_HM), (const bf16_t*)(ws + W_FGU) + (size_t)m * 5632 * 1024, 512};
            pg8::TileOrder S; S.init(256, 22, G, bid);
            pg8::EpiSwiGLU8 E{ws + F_HID, DFF, 1.0f / MOE_WSCALE, MOE_HSCALE};
            pg8::gemm_phase<pg8::EpiSwiGLU8, true>(lds, g, S, E);
        } else {
            pg8::Gemm g{(const bf16_t*)(ws + WS_HM), (const bf16_t*)(ws + W_FGU) + (size_t)m * 5632 * 1024, 1024};
            pg8::TileOrder S; S.init(256, 22, G, bid);
            pg8::EpiSwiGLU E{(bf16_t*)(ws + F_HID), DFF};
            pg8::gemm_phase<pg8::EpiSwiGLU>(lds, g, S, E);
        }
        GRID_BAR();
        if constexpr (F8) {
            pg8::Gemm g{(const bf16_t*)(ws + F_HID), (const bf16_t*)(ws + W_FDN) + (size_t)m * 1024 * 2816, DFF / 2};
            pg8::TileOrder S; S.init(256, 4, G, bid);
            pg8::EpiRes<true> E{xo, xo, modl + 5 * 1024, 1.0f / (MOE_WSCALE * MOE_HSCALE)};
            pg8::gemm_phase<pg8::EpiRes<true>, true>(lds, g, S, E);
        } else {
            pg8::Gemm g{(const bf16_t*)(ws + F_HID), (const bf16_t*)(ws + W_FDN) + (size_t)m * 1024 * 2816, DFF};
            pg8::TileOrder S; S.init(256, 4, G, bid);
            pg8::EpiRes<true> E{xo, xo, modl + 5 * 1024, 1.0f};
            pg8::gemm_phase<pg8::EpiRes<true>>(lds, g, S, E);
        }
        GRID_BAR();
    } else {
        constexpr int m = L >> 1;
        norm_phase<true>(args, lds, bid, G, xo, true, xo, true, args.in[I_N2G] + L * DM, modl, 1, false, modl, false, args.in[I_MOER] + (size_t)m * DM * 8);
        GRID_BAR();
        DGL(dg_norm(args, 10 * L + 5, xo, args.in[I_N2G] + L * DM, L, 1); dg_router(args, 10 * L + 5, L); GRID_BAR();)
        place_phase(args, lds, bid, G);
        GRID_BAR();
        DGL(dg_place(args, 10 * L + 6); GRID_BAR();)
        const int* tiles = (const int*)(ws + TB_TILES);
        {
            pg8::Gemm g{(const bf16_t*)(ws + E_XS), (const bf16_t*)(ws + W_MGU + (size_t)m * 8 * 7168 * 1024), 512};
            pg8::TileOrder S; S.init(tiles[8], 28, G, bid);
#pragma unroll
            for (int e = 1; e < NEXP; ++e) S.ts[e] = tiles[e];
            pg8::EpiSwiGLU8 E{ws + E_HID, DFFE, 1.0f / MOE_WSCALE, MOE_HSCALE};
            pg8::gemm_phase<pg8::EpiSwiGLU8, true>(lds, g, S, E);
        }
        GRID_BAR();
        DGL(dg_moe_hid(args, 10 * L + 7, m); GRID_BAR();)
        {
            pg8::Gemm g{(const bf16_t*)(ws + E_HID), (const bf16_t*)(ws + W_MDN + (size_t)m * 8 * 1024 * 3584), DFFE / 2};
            pg8::TileOrder S; S.init(tiles[8], 4, G, bid);
#pragma unroll
            for (int e = 1; e < NEXP; ++e) S.ts[e] = tiles[e];
            pg8::EpiPlain E{(bf16_t*)(ws + E_XS), DM, 1.0f / (MOE_WSCALE * MOE_HSCALE)};
            pg8::gemm_phase<pg8::EpiPlain, true>(lds, g, S, E);
        }
        GRID_BAR();
        DGL(dg_moe_y(args, 10 * L + 8, m); GRID_BAR();)
    }
}
__device__ __forceinline__ void final_combine(const Args& args, LAS unsigned char* lds, int bid, int G, const XcdBarrier& bar) {
    const float* modl = (const float*)(args.ws + TB_MODS) + (size_t)3 * NBATCH * 6144;
    DG(dg_save(args, 39, args.out); GRID_BAR();)
    norm_phase<false>(args, lds, bid, G, args.ws + WS_XB, true, args.out, false, args.in[I_N1G], modl, 0, true, modl, true, nullptr);
    DG(GRID_BAR(); dg_combine(args, 39, modl);)
}

__global__ void __launch_bounds__(NTHR, 2) mega_fwd(Args args) {
    extern __shared__ __attribute__((aligned(16))) unsigned char lds_raw[];
    LAS unsigned char* lds = (LAS unsigned char*)lds_raw;
    const int tid = threadIdx.x, bid = blockIdx.x, G = gridDim.x;
    unsigned char* ws = args.ws;
    volatile LAS unsigned* MISC = (volatile LAS unsigned*)(lds + MISC_OFF);
    if (tid < 64) MISC[tid] = 0u;
    __syncthreads();
    XcdBarrier bar = xcd_barrier_post((unsigned*)(ws + WS_CTL) + CW_BAR, MISC + 8);

    prologue_phase(args, lds, bid, G);
    GRID_BAR();

    run_mixer<0>(args, lds, bid, G, bar);
    run_ffn<0>(args, lds, bid, G, bar);
    run_mixer<1>(args, lds, bid, G, bar);
    run_ffn<1>(args, lds, bid, G, bar);
    run_mixer<2>(args, lds, bid, G, bar);
    run_ffn<2>(args, lds, bid, G, bar);
    run_mixer<3>(args, lds, bid, G, bar);
    run_ffn<3>(args, lds, bid, G, bar);
    final_combine(args, lds, bid, G, bar);
    DG(GRID_BAR(); dg_final(args, 49);)
}

extern "C" void kernel_launch(void* const* d_in, const int* in_sizes, int n_in, void* d_out, int out_size, void* d_ws, size_t ws_size, hipStream_t stream) {
    static int grid = 0;
    if (grid == 0) {
        if (n_in != 30 || out_size != MTOK * DM || ws_size < WS_NEED) { fprintf(stderr, "kernel_launch: unexpected shapes (n_in %d out %d ws %zu need %zu)\n", n_in, out_size, ws_size, (size_t)WS_NEED); grid = -1; return; }
        int dev = 0, cus = 0;
        if (hipGetDevice(&dev) != hipSuccess || hipDeviceGetAttribute(&cus, hipDeviceAttributeMultiprocessorCount, dev) != hipSuccess) { grid = -1; return; }
        if (hipFuncSetAttribute((const void*)mega_fwd, hipFuncAttributeMaxDynamicSharedMemorySize, LDS_BYTES) != hipSuccess) { fprintf(stderr, "kernel_launch: hipFuncSetAttribute failed\n"); grid = -1; return; }
        int per_cu = 0;
        if (hipOccupancyMaxActiveBlocksPerMultiprocessor(&per_cu, (const void*)mega_fwd, NTHR, LDS_BYTES) != hipSuccess || per_cu < 1) { fprintf(stderr, "kernel_launch: occupancy query says %d\n", per_cu); }
        (void)hipGetLastError();
        grid = (cus >= 256) ? 256 : -1;
        if (grid < 0) { fprintf(stderr, "kernel_launch: needs 256 CUs, device has %d\n", cus); return; }
    }
    if (grid < 0) return;
    if (hipMemsetAsync((char*)d_ws + WS_CTL, 0, CTL_ZERO_BYTES, stream) != hipSuccess) return;
    Args a{};
    for (int i = 0; i < 30; ++i) a.in[i] = (const float*)d_in[i];
    a.out = (float*)d_out; a.ws = (unsigned char*)d_ws;
    hipLaunchKernelGGL(mega_fwd, dim3(grid), dim3(NTHR), LDS_BYTES, stream, a);
}
```

```cpp
#define DIAG_FROM 2
#include <hip/hip_runtime.h>
#include <cstdio>
#include <cstdint>

#define LAS __attribute__((address_space(3)))
#define GAS __attribute__((address_space(1)))
typedef unsigned short bf16_t;
typedef short bf16x8 __attribute__((ext_vector_type(8)));
typedef short s16x4 __attribute__((ext_vector_type(4)));
typedef float f32x2 __attribute__((ext_vector_type(2)));
typedef float f32x4 __attribute__((ext_vector_type(4)));
typedef float f32x16 __attribute__((ext_vector_type(16)));
typedef unsigned u32x2 __attribute__((ext_vector_type(2)));
typedef unsigned u32x4 __attribute__((ext_vector_type(4)));

constexpr int MTOK = 65536, DM = 1024, SEQ = 8192, NBATCH = 8, DEPTH = 4;
constexpr int DFF = 2816, DFFE = 3584, NEXP = 8, LRUW = 1280;
constexpr float EPS = 1e-6f;
constexpr int FP8_DENSE_FROM = 2;
constexpr float MOE_WSCALE = 64.0f, MOE_HSCALE = 4.0f;
constexpr float LOG2E = 1.4426950408889634f;

constexpr size_t MiB = 1u << 20;
constexpr size_t WS_CTL = 0, CTL_ZERO_BYTES = 1 * MiB;
constexpr size_t WS_TAB = 1 * MiB;
constexpr size_t TB_MODS = WS_TAB;
constexpr size_t TB_COS = WS_TAB + 1 * MiB;
constexpr size_t TB_SIN = WS_TAB + 2 * MiB;
constexpr size_t TB_SCAL = WS_TAB + 3 * MiB;
constexpr size_t TB_LB = TB_SCAL + 4096;
constexpr size_t TB_SP = TB_SCAL + 16384;
constexpr size_t TB_EID = WS_TAB + 4 * MiB;
constexpr size_t TB_GATE = WS_TAB + 5 * MiB;
constexpr size_t TB_SLOT = WS_TAB + 6 * MiB;
constexpr size_t TB_BCNT = WS_TAB + 7 * MiB;
constexpr size_t TB_TILES = TB_BCNT + 16384;
constexpr size_t TB_LSUM = WS_TAB + 8 * MiB;
constexpr size_t TB_LCIN = WS_TAB + 16 * MiB;
constexpr size_t WS_W = 32 * MiB;
constexpr size_t W_QKV = WS_W;
constexpr size_t W_AO = W_QKV + 2 * (size_t)3072 * 1024 * 2;
constexpr size_t W_HGI = W_AO + 2 * (size_t)1024 * 1024 * 2;
constexpr size_t W_HGO = W_HGI + (size_t)5120 * 1024 * 2;
constexpr size_t W_LRI = W_HGO + (size_t)1024 * 1024 * 2;
constexpr size_t W_LRG = W_LRI + (size_t)2560 * 1024 * 2;
constexpr size_t W_LRO = W_LRG + (size_t)10 * 2 * 256 * 128 * 2;
constexpr size_t W_FGU = W_LRO + (size_t)1024 * 1280 * 2;
constexpr size_t W_FDN = W_FGU + 2 * (size_t)5632 * 1024 * 2;
constexpr size_t W_MGU = W_FDN + 2 * (size_t)1024 * 2816 * 2;
constexpr size_t W_MDN = W_MGU + 16 * (size_t)7168 * 1024 * 2;
constexpr size_t W_END = W_MDN + 16 * (size_t)1024 * 3584 * 2;
constexpr size_t WS_HM = 440 * MiB;
constexpr size_t WS_ACT = 568 * MiB;
static_assert(W_END <= WS_HM, "weights overflow");
constexpr size_t SZ_TOK = (size_t)MTOK * 1024 * 2;
constexpr size_t A_Q = WS_ACT, A_K = A_Q + SZ_TOK, A_V = A_K + SZ_TOK, A_VT = A_V + SZ_TOK;
constexpr size_t F_HID = WS_ACT;
constexpr size_t H_Q = WS_ACT, H_LFF = H_Q + SZ_TOK, H_LFB = H_LFF + SZ_TOK, H_V = H_LFB + SZ_TOK, H_G = H_V + SZ_TOK, H_OF = H_G + SZ_TOK, H_OB = H_OF + SZ_TOK;
constexpr size_t SZ_LRU = (size_t)MTOK * 1280 * 2;
constexpr size_t L_YB = WS_ACT, L_XB = L_YB + SZ_LRU, L_HF = L_XB + SZ_LRU, L_HY = L_HF + SZ_LRU;
constexpr int MOE_ROWS = 2 * MTOK + NEXP * 256;
constexpr size_t E_XS = WS_ACT, E_HID = E_XS + (size_t)MOE_ROWS * 1024 * 2, E_END = E_HID + (size_t)MOE_ROWS * DFFE;
constexpr size_t WS_XB = 1536 * MiB;
static_assert(E_END <= WS_XB && H_OB + SZ_TOK <= WS_XB && L_HY + SZ_LRU <= WS_XB && A_VT + SZ_TOK <= WS_XB, "activation regions below the residual stream");
constexpr size_t WS_NEED = WS_XB + SZ_TOK;
static_assert(WS_NEED <= (size_t)1792 * MiB, "workspace");

constexpr int CW_BAR = 4096;

constexpr int RING_BYTES = 135168;
constexpr int MISC_OFF = RING_BYTES;
constexpr int LDS_BYTES = 147456;
constexpr int NWAVES = 8, NTHR = 512;

typedef __bf16 bf16x2v __attribute__((ext_vector_type(2)));
__device__ __forceinline__ unsigned cvt_pk_bf16(float lo, float hi) { const f32x2 v = {lo, hi}; const bf16x2v b = __builtin_convertvector(v, bf16x2v); return __builtin_bit_cast(unsigned, b); }
__device__ __forceinline__ unsigned pk_fp8x4(float a, float b, float c, float d) { unsigned w = 0; w = __builtin_amdgcn_cvt_pk_fp8_f32(a, b, w, false); w = __builtin_amdgcn_cvt_pk_fp8_f32(c, d, w, true); return w; }
__device__ __forceinline__ unsigned f2bf(float f) { unsigned u = __builtin_bit_cast(unsigned, f); return (u + 0x7fffu + ((u >> 16) & 1u)) >> 16; }
__device__ __forceinline__ float bf2f(unsigned short b) { return __builtin_bit_cast(float, ((unsigned)b) << 16); }
__device__ __forceinline__ float bflo(unsigned w) { return __builtin_bit_cast(float, w << 16); }
__device__ __forceinline__ float bfhi(unsigned w) { return __builtin_bit_cast(float, w & 0xffff0000u); }
__device__ __forceinline__ float fexp2(float x) { return __builtin_amdgcn_exp2f(x); }
__device__ __forceinline__ float fexp(float x) { return __builtin_amdgcn_exp2f(x * LOG2E); }
__device__ __forceinline__ float frcp(float x) { return __builtin_amdgcn_rcpf(x); }
__device__ __forceinline__ float fsigmoid(float x) { return frcp(1.0f + fexp(-x)); }
__device__ __forceinline__ float fsilu(float x) { return x * fsigmoid(x); }
__device__ __forceinline__ float wave_sum(float v) {
#pragma unroll
    for (int o = 1; o < 64; o <<= 1) v += __shfl_xor(v, o);
    return v;
}
#define LDS_WAIT() asm volatile("s_waitcnt lgkmcnt(0)" ::: "memory")
#define VM_WAIT() asm volatile("s_waitcnt vmcnt(0)" ::: "memory")

#define XB_TMO      128
#define XB_XCNT(j)  (256  + 64 * (j))
#define XB_XSUB(j)  (1280 + 64 * (j))
#define XB_XGEN(j)  (2304 + 64 * (j))
#define XB_TOP      3328
#define XB_TOPGEN   3392
#define XCD_BAR_WORDS 3456
#define XB_SPIN_CAP (1u << 22)
__device__ __forceinline__ unsigned xb_ld(unsigned* p)              { return __hip_atomic_load(p, __ATOMIC_RELAXED, __HIP_MEMORY_SCOPE_AGENT); }
__device__ __forceinline__ unsigned xb_add(unsigned* p, unsigned v) { return __hip_atomic_fetch_add(p, v, __ATOMIC_RELAXED, __HIP_MEMORY_SCOPE_AGENT); }
__device__ __forceinline__ unsigned xb_xcc_id() { return (unsigned)__builtin_amdgcn_s_getreg((3 << 11) | 20) & 0xFu; }
#define XB_SPIN(cond, bar) do { unsigned _sp = 0; while (cond) { __builtin_amdgcn_s_sleep(1); \
    if ((++_sp & 255u) == 0u) { if (xb_ld(&(bar)[XB_TMO])) break; if (_sp > XB_SPIN_CAP) { atomicAdd(&(bar)[XB_TMO], 1u); break; } } } } while (0)
struct XcdBarrier { unsigned* bar; unsigned x; volatile LAS unsigned* st; };
__device__ __forceinline__ XcdBarrier xcd_barrier_post(unsigned* bar, volatile LAS unsigned* st) {
    XcdBarrier b; b.bar = bar; b.x = xb_xcc_id(); b.st = st;
    if (threadIdx.x == 0) (void)xb_add(&bar[XB_XCNT(b.x)], 1u);
    return b;
}
__device__ __forceinline__ void xcd_barrier_complete(unsigned* bar, unsigned x, unsigned& nloc, unsigned& nx) {
    const unsigned G = gridDim.x * gridDim.y * gridDim.z;
    unsigned sum, cnt, mine, sp = 0u;
    for (;;) {
        sum = 0u; cnt = 0u; mine = 0u;
#pragma unroll
        for (unsigned j = 0; j < 16; ++j) { const unsigned c = xb_ld(&bar[XB_XCNT(j)]); sum += c; cnt += (c > 0u) ? 1u : 0u; mine = (j == x) ? c : mine; }
        if (sum == G) break;
        __builtin_amdgcn_s_sleep(1);
        if ((++sp & 255u) == 0u) { if (xb_ld(&bar[XB_TMO])) break; if (sp > XB_SPIN_CAP) { atomicAdd(&bar[XB_TMO], 1u); break; } }
    }
    nloc = mine > 0u ? mine : 1u; nx = cnt > 0u ? cnt : 1u;
}
__device__ __forceinline__ void xcd_barrier(const XcdBarrier& b) {
    asm volatile("s_waitcnt vmcnt(0)" ::: "memory");
    __syncthreads();
    if (threadIdx.x == 0) {
        unsigned* bar = b.bar;
        __builtin_amdgcn_s_waitcnt(0);
        unsigned nloc = b.st[0], nx = b.st[1];
        if (nloc == 0u) { xcd_barrier_complete(bar, b.x, nloc, nx); b.st[0] = nloc; b.st[1] = nx; }
        const unsigned old = xb_add(&bar[XB_XSUB(b.x)], 1u);
        const unsigned gen = old / nloc;
        if (old + 1u == (gen + 1u) * nloc) {
            __builtin_amdgcn_fence(__ATOMIC_RELEASE, "agent");
            asm volatile("s_waitcnt vmcnt(0)" ::: "memory");
            const unsigned og = xb_add(&bar[XB_TOP], 1u);
            const unsigned tg = og / nx;
            if (og + 1u == (tg + 1u) * nx) xb_add(&bar[XB_TOPGEN], 1u);
            else XB_SPIN(xb_ld(&bar[XB_TOPGEN]) == tg, bar);
            __builtin_amdgcn_fence(__ATOMIC_ACQUIRE, "agent");
            xb_add(&bar[XB_XGEN(b.x)], 1u);
            asm volatile("s_waitcnt vmcnt(0)" ::: "memory");
        } else {
            XB_SPIN(xb_ld(&bar[XB_XGEN(b.x)]) == gen, bar);
            __builtin_amdgcn_fence(__ATOMIC_ACQUIRE, "agent");
            asm volatile("s_waitcnt vmcnt(0)" ::: "memory");
        }
    }
    __syncthreads();
}

namespace pg8 {
constexpr int BM = 256, BK = 64, HALF = 128, HTB = HALF * BK * 2, STAGE_BYTES = 8 * HTB, NXCD = 8, WGM = 8;
__host__ __device__ __forceinline__ int lds_byte(int r, int c) { const int st = (r >> 4) * 2 + (c >> 5), rr = r & 15, cc = c & 31, ob = rr * 64 + cc * 2; return st * 1024 + (ob ^ (((ob >> 9) & 1) << 5)); }
__host__ __device__ __forceinline__ void stage_rc(int b, int& R, int& C) { const int st = b / 1024, sb = b % 1024, swz = sb ^ (((sb >> 9) & 1) << 5); R = (st >> 1) * 16 + swz / 64; C = (st & 1) * 32 + (swz % 64) / 2; }
__host__ __device__ __forceinline__ int perm32(int rho) { const int n = rho >> 4, i = rho & 15; return 8 * (i >> 2) + 4 * n + (i & 3); }

struct Unit { int pm, pn, pb; };
struct Gemm { const bf16_t* A; const bf16_t* Bt; int K; };

struct TileOrder {
    int nM, nN, nwg, G, c; int ts[NEXP];
    __device__ __forceinline__ void init(int nM_, int nN_, int G_, int c_) { nM = nM_; nN = nN_; nwg = nM * nN; G = G_; c = c_;
#pragma unroll
        for (int e = 0; e < NEXP; ++e) ts[e] = (e == 0) ? 0 : 0x7fffffff; }
    __device__ __forceinline__ bool next(int i, Unit& u) const {
        const long L = (long)i * G + c; if (L >= nwg) return false;
        int wgid = (int)L; { const int q = nwg / NXCD, r = nwg % NXCD, xcd = wgid % NXCD, off = wgid / NXCD; wgid = (xcd < r ? xcd * (q + 1) : r * (q + 1) + (xcd - r) * q) + off; }
        const int nig = WGM * nN, gid = wgid / nig, fm = gid * WGM, gsz = (nM - fm) < WGM ? (nM - fm) : WGM;
        u.pm = fm + ((wgid % nig) % gsz); u.pn = (wgid % nig) / gsz;
        int e = 0;
#pragma unroll
        for (int k = 1; k < NEXP; ++k) e += (u.pm >= ts[k]) ? 1 : 0;
        u.pb = e * nN + u.pn; return true;
    }
};

typedef int v8i32 __attribute__((ext_vector_type(8)));
template <class Epi, bool FP8 = false>
__device__ __forceinline__ void gemm_phase(LAS unsigned char* lds, const Gemm g, const TileOrder& S, const Epi& E) {
    int tid_ = threadIdx.x; asm volatile("" : "+v"(tid_));
    const int tid = tid_, wid = __builtin_amdgcn_readfirstlane(tid >> 6), lane = tid & 63, wr = wid >> 2, wc = wid & 3, fr = lane & 15, fq = lane >> 4;
    const int K = g.K, nt = K / BK;
    unsigned voffA[2], voffB[2];
#pragma unroll
    for (int i = 0; i < 2; ++i) { int R, C; stage_rc(tid * 16 + i * 8192, R, C); const int Rb = Epi::PERM ? ((R & ~31) + perm32(R & 31)) : R;
        voffA[i] = (unsigned)(R * K + C) * 2u; voffB[i] = (unsigned)(Rb * K + C) * 2u; }
    const size_t kstep = (size_t)(BK * 2);
    const size_t hstep = (size_t)HALF * K * 2;
    const size_t tstep = 2 * hstep;
    const unsigned ldsw = (unsigned)wid * 1024u;
    const int aoff = lds_byte(wr * 64 + fr, fq * 8), boff = lds_byte(wc * 32 + fr, fq * 8);
#define PG8_SA(b, h) (((b) * 2 + (h)) * HTB)
#define PG8_SB(b, h) ((4 + (b) * 2 + (h)) * HTB)
#define PG8_STAGE(bufoff, gbase, voff) do { _Pragma("unroll") for (int _i = 0; _i < 2; ++_i) \
        __builtin_amdgcn_global_load_lds((const unsigned*)((const char*)(gbase) + (voff)[_i]), (LAS unsigned*)(lds + (bufoff) + ldsw + _i * 8192), 16, 0, 0); } while (0)
#define PG8_LD8(p) __builtin_bit_cast(v8i32, __builtin_shufflevector(*(const LAS u32x4*)(p), *(const LAS u32x4*)((p) + 1024), 0, 1, 2, 3, 4, 5, 6, 7))
#define PG8_LDA(dst, b, h) do { if constexpr (FP8) { _Pragma("unroll") for (int m = 0; m < 4; ++m) dst##8[m] = PG8_LD8(lds + PG8_SA(b, h) + aoff + m * 2048); } \
        else { _Pragma("unroll") for (int m = 0; m < 4; ++m) _Pragma("unroll") for (int k = 0; k < 2; ++k) dst[m][k] = *(const LAS bf16x8*)(lds + PG8_SA(b, h) + aoff + m * 2048 + k * 1024); } } while (0)
#define PG8_LDB(dst, b, h) do { if constexpr (FP8) { _Pragma("unroll") for (int n = 0; n < 2; ++n) dst##8[n] = PG8_LD8(lds + PG8_SB(b, h) + boff + n * 2048); } \
        else { _Pragma("unroll") for (int n = 0; n < 2; ++n) _Pragma("unroll") for (int k = 0; k < 2; ++k) dst[n][k] = *(const LAS bf16x8*)(lds + PG8_SB(b, h) + boff + n * 2048 + k * 1024); } } while (0)
#define PG8_MMA(ai, bj, At, Bt) do { __builtin_amdgcn_s_setprio(1); \
        if constexpr (FP8) { _Pragma("unroll") for (int m = 0; m < 4; ++m) _Pragma("unroll") for (int n = 0; n < 2; ++n) \
            asm volatile("v_mfma_scale_f32_16x16x128_f8f6f4 %0, %1, %2, %0, %3, %3 op_sel_hi:[0,0,0]" : "+v"(acc[ai][bj][m][n]) : "v"(Bt##8[n]), "v"(At##8[m]), "v"(one_scale)); } \
        else { _Pragma("unroll") for (int m = 0; m < 4; ++m) _Pragma("unroll") for (int n = 0; n < 2; ++n) _Pragma("unroll") for (int k = 0; k < 2; ++k) \
            acc[ai][bj][m][n] = __builtin_amdgcn_mfma_f32_16x16x32_bf16(Bt[n][k], At[m][k], acc[ai][bj][m][n], 0, 0, 0); } \
        __builtin_amdgcn_s_setprio(0); } while (0)
#define PG8_WAIT_V(n) asm volatile("s_waitcnt vmcnt(" #n ")" ::: "memory")
#define PG8_WAIT_L(n) asm volatile("s_waitcnt lgkmcnt(" #n ")" ::: "memory")
#define PG8_BAR __builtin_amdgcn_s_barrier()
#define PG8_SCHED __builtin_amdgcn_sched_barrier(0)
    Unit cur, nxt; int ui = 0;
    if (!S.next(0, cur)) return;
    f32x4 acc[2][2][4][2];
#pragma unroll
    for (int a = 0; a < 2; ++a)
#pragma unroll
        for (int b = 0; b < 2; ++b)
#pragma unroll
            for (int m = 0; m < 4; ++m)
#pragma unroll
                for (int n = 0; n < 2; ++n) acc[a][b][m][n] = (f32x4){0.f, 0.f, 0.f, 0.f};
    bf16x8 At[4][2], B0[2][2], B1[2][2]; v8i32 At8[4], B08[2], B18[2];
    int one_scale = 0x7f7f7f7f; asm volatile("" : "+v"(one_scale));
    const char* cA = (const char*)g.A + (size_t)cur.pm * tstep; const char* cB = (const char*)g.Bt + (size_t)cur.pb * tstep;
    PG8_STAGE(PG8_SB(0, 0), cB, voffB); PG8_STAGE(PG8_SA(0, 0), cA, voffA); PG8_STAGE(PG8_SB(0, 1), cB + hstep, voffB); PG8_STAGE(PG8_SA(0, 1), cA + hstep, voffA);
    if (wr == 1) PG8_BAR;
    PG8_WAIT_V(4); PG8_BAR;
    PG8_STAGE(PG8_SB(1, 0), cB + kstep, voffB); PG8_STAGE(PG8_SA(1, 0), cA + kstep, voffA); PG8_STAGE(PG8_SB(1, 1), cB + hstep + kstep, voffB);
    PG8_WAIT_V(6); PG8_BAR;
    for (;;) {
        const bool has_next = S.next(ui + 1, nxt);
        const char* nA = has_next ? (const char*)g.A + (size_t)nxt.pm * tstep : cA; const char* nB = has_next ? (const char*)g.Bt + (size_t)nxt.pb * tstep : cB;
        for (int t = 0; t < nt; t += 2) {
            const bool last = (t == nt - 2);
            const char* a1 = cA + (size_t)(t + 1) * kstep;
            const char* a2 = last ? nA : cA + (size_t)(t + 2) * kstep; const char* b2 = last ? nB : cB + (size_t)(t + 2) * kstep;
            const char* a3 = a2 + kstep; const char* b3 = b2 + kstep;
            PG8_LDB(B0, 0, 0); PG8_SCHED; PG8_LDA(At, 0, 0); PG8_STAGE(PG8_SA(1, 1), a1 + hstep, voffA);
            PG8_WAIT_L(8); PG8_BAR; PG8_WAIT_L(0); PG8_MMA(0, 0, At, B0); PG8_BAR; PG8_SCHED;
            PG8_LDB(B1, 0, 1); PG8_STAGE(PG8_SB(0, 0), b2, voffB);
            PG8_BAR; PG8_WAIT_L(0); PG8_MMA(0, 1, At, B1); PG8_BAR;
            PG8_LDA(At, 0, 1); PG8_STAGE(PG8_SA(0, 0), a2, voffA);
            PG8_BAR; PG8_WAIT_L(0); PG8_MMA(1, 0, At, B0); PG8_BAR; PG8_SCHED;
            PG8_STAGE(PG8_SB(0, 1), b2 + hstep, voffB);
            PG8_WAIT_V(6); PG8_BAR; PG8_MMA(1, 1, At, B1); PG8_BAR;
            PG8_LDB(B0, 1, 0); PG8_SCHED; PG8_LDA(At, 1, 0); PG8_STAGE(PG8_SA(0, 1), a2 + hstep, voffA);
            PG8_WAIT_L(8); PG8_BAR; PG8_WAIT_L(0); PG8_MMA(0, 0, At, B0); PG8_BAR; PG8_SCHED;
            PG8_LDB(B1, 1, 1); PG8_STAGE(PG8_SB(1, 0), b3, voffB);
            PG8_BAR; PG8_WAIT_L(0); PG8_MMA(0, 1, At, B1); PG8_BAR;
            PG8_LDA(At, 1, 1); PG8_STAGE(PG8_SA(1, 0), a3, voffA);
            PG8_BAR; PG8_WAIT_L(0); PG8_MMA(1, 0, At, B0); PG8_BAR; PG8_SCHED;
            PG8_STAGE(PG8_SB(1, 1), b3 + hstep, voffB);
            PG8_WAIT_V(6); PG8_BAR; PG8_MMA(1, 1, At, B1); PG8_BAR;
        }
        if constexpr (FP8) asm volatile("s_nop 15\n\ts_nop 15" ::: "memory");
        E(acc, cur, wr, wc, fr, fq);
        if (!has_next) break;
#pragma unroll
        for (int a = 0; a < 2; ++a)
#pragma unroll
            for (int b = 0; b < 2; ++b)
#pragma unroll
                for (int m = 0; m < 4; ++m)
#pragma unroll
                    for (int n = 0; n < 2; ++n) acc[a][b][m][n] = (f32x4){0.f, 0.f, 0.f, 0.f};
        cur = nxt; cA = nA; cB = nB; ++ui;
    }
    PG8_WAIT_V(0);
    if (wr == 0) PG8_BAR;
    PG8_BAR;
#undef PG8_SA
#undef PG8_SB
#undef PG8_STAGE
#undef PG8_LDA
#undef PG8_LDB
#undef PG8_MMA
#undef PG8_LD8
#undef PG8_WAIT_V
#undef PG8_WAIT_L
#undef PG8_BAR
#undef PG8_SCHED
}

struct EpiQKV {
    static constexpr bool PERM = true;
    bf16_t *Q, *Kk, *V; const float *gq, *gk, *cosT, *sinT; float qscale;
    __device__ __forceinline__ void operator()(const f32x4 (&acc)[2][2][4][2], const Unit& u, int wr, int wc, int fr, int fq) const {
        const int row0 = u.pm * BM + wr * 64 + fr;
        if (u.pn >= 8) {
            const int col0 = (u.pn - 8) * BM + wc * 32 + 8 * fq;
#pragma unroll
            for (int ai = 0; ai < 2; ++ai)
#pragma unroll
                for (int m = 0; m < 4; ++m) { bf16_t* rowp = V + (size_t)(row0 + ai * HALF + m * 16) * DM + col0;
#pragma unroll
                    for (int bj = 0; bj < 2; ++bj) { const f32x4 v0 = acc[ai][bj][m][0], v1 = acc[ai][bj][m][1];
                        u32x4 w; w.x = cvt_pk_bf16(v0[0], v0[1]); w.y = cvt_pk_bf16(v0[2], v0[3]); w.z = cvt_pk_bf16(v1[0], v1[1]); w.w = cvt_pk_bf16(v1[2], v1[3]);
                        *(u32x4*)(rowp + bj * HALF) = w; } }
        } else {
            const int part = u.pn >> 2, sh = 4 * (u.pn & 3) + wc;
            bf16_t* dst = part ? Kk : Q; const float* g = part ? gk : gq; const float sc = part ? 1.0f : qscale;
            f32x4 g0[2], g1[2];
#pragma unroll
            for (int n = 0; n < 2; ++n) { g0[n] = *(const f32x4*)(g + 8 * fq + 4 * n); g1[n] = *(const f32x4*)(g + 32 + 8 * fq + 4 * n); }
#pragma unroll
            for (int ai = 0; ai < 2; ++ai)
#pragma unroll
                for (int m = 0; m < 4; ++m) {
                    const int r = row0 + ai * HALF + m * 16; const int pos = r & (SEQ - 1);
                    f32x4 x1[2], x2[2]; float ss = 0.f;
#pragma unroll
                    for (int n = 0; n < 2; ++n) { x1[n] = acc[ai][0][m][n]; x2[n] = acc[ai][1][m][n];
                        ss += (x1[n][0] * x1[n][0] + x1[n][1] * x1[n][1]) + (x1[n][2] * x1[n][2] + x1[n][3] * x1[n][3]);
                        ss += (x2[n][0] * x2[n][0] + x2[n][1] * x2[n][1]) + (x2[n][2] * x2[n][2] + x2[n][3] * x2[n][3]); }
                    ss += __shfl_xor(ss, 16); ss += __shfl_xor(ss, 32);
                    const float rstd = __builtin_amdgcn_rsqf(ss * (1.0f / 64.0f) + EPS) ;
                    unsigned char* op = (unsigned char*)dst + (size_t)r * DM + sh * 64 + 8 * fq;
                    u32x2 w1, w2;
#pragma unroll
                    for (int n = 0; n < 2; ++n) {
                        const f32x4 cs = *(const f32x4*)(cosT + pos * 32 + 8 * fq + 4 * n), sn = *(const f32x4*)(sinT + pos * 32 + 8 * fq + 4 * n);
                        const f32x4 y1 = x1[n] * rstd * g0[n], y2 = x2[n] * rstd * g1[n];
                        const f32x4 o1 = (y1 * cs - y2 * sn) * sc, o2 = (y2 * cs + y1 * sn) * sc;
                        if (n == 0) { w1.x = pk_fp8x4(o1[0], o1[1], o1[2], o1[3]); w2.x = pk_fp8x4(o2[0], o2[1], o2[2], o2[3]); }
                        else { w1.y = pk_fp8x4(o1[0], o1[1], o1[2], o1[3]); w2.y = pk_fp8x4(o2[0], o2[1], o2[2], o2[3]); }
                    }
                    *(u32x2*)(op) = w1; *(u32x2*)(op + 32) = w2;
                }
        }
    }
};
__device__ __forceinline__ f32x4 ld_x4(const void* p, size_t i, bool is16) {
    if (is16) { const u32x2 w = *(const u32x2*)((const bf16_t*)p + i); return (f32x4){bflo(w.x), bfhi(w.x), bflo(w.y), bfhi(w.y)}; }
    return *(const f32x4*)((const float*)p + i);
}
template <bool IN16>
struct EpiRes {
    static constexpr bool PERM = false;
    const void* xin; bf16_t* xout; const float* gate; float sc;
    __device__ __forceinline__ void operator()(const f32x4 (&acc)[2][2][4][2], const Unit& u, int wr, int wc, int fr, int fq) const {
        const int row0 = u.pm * BM + wr * 64 + fr, col0 = u.pn * BM + wc * 32 + 4 * fq;
        const float* gp = gate + (size_t)(u.pm >> 5) * 6144 + col0;
        f32x4 gv[2][2];
#pragma unroll
        for (int bj = 0; bj < 2; ++bj)
#pragma unroll
            for (int n = 0; n < 2; ++n) gv[bj][n] = *(const f32x4*)(gp + bj * HALF + n * 16) * sc;
#pragma unroll
        for (int ai = 0; ai < 2; ++ai)
#pragma unroll
            for (int m = 0; m < 4; ++m) { const size_t off = (size_t)(row0 + ai * HALF + m * 16) * DM + col0;
                f32x4 xv[2][2];
#pragma unroll
                for (int bj = 0; bj < 2; ++bj)
#pragma unroll
                    for (int n = 0; n < 2; ++n) xv[bj][n] = ld_x4(xin, off + bj * HALF + n * 16, IN16);
#pragma unroll
                for (int bj = 0; bj < 2; ++bj)
#pragma unroll
                    for (int n = 0; n < 2; ++n) { const f32x4 o = xv[bj][n] + gv[bj][n] * acc[ai][bj][m][n];
                        *(u32x2*)(xout + off + bj * HALF + n * 16) = (u32x2){cvt_pk_bf16(o[0], o[1]), cvt_pk_bf16(o[2], o[3])}; }
                if (m == 3) asm volatile("" ::: "memory"); }
    }
};
struct EpiSwiGLU {
    static constexpr bool PERM = true;
    bf16_t* H; int ldh;
    __device__ __forceinline__ void operator()(const f32x4 (&acc)[2][2][4][2], const Unit& u, int wr, int wc, int fr, int fq) const {
        const int row0 = u.pm * BM + wr * 64 + fr, col0 = u.pn * HALF + wc * 32 + 8 * fq;
#pragma unroll
        for (int ai = 0; ai < 2; ++ai)
#pragma unroll
            for (int m = 0; m < 4; ++m) { bf16_t* rowp = H + (size_t)(row0 + ai * HALF + m * 16) * ldh + col0;
                f32x4 v[2];
#pragma unroll
                for (int n = 0; n < 2; ++n) { const f32x4 gt = acc[ai][0][m][n], up = acc[ai][1][m][n];
#pragma unroll
                    for (int j = 0; j < 4; ++j) v[n][j] = fsilu(gt[j]) * up[j]; }
                u32x4 w; w.x = cvt_pk_bf16(v[0][0], v[0][1]); w.y = cvt_pk_bf16(v[0][2], v[0][3]); w.z = cvt_pk_bf16(v[1][0], v[1][1]); w.w = cvt_pk_bf16(v[1][2], v[1][3]);
                *(u32x4*)rowp = w; }
    }
};
struct EpiSwiGLU8 {
    static constexpr bool PERM = true;
    unsigned char* H; int ldh; float ws, hs;
    __device__ __forceinline__ void operator()(const f32x4 (&acc)[2][2][4][2], const Unit& u, int wr, int wc, int fr, int fq) const {
        const int row0 = u.pm * BM + wr * 64 + fr, col0 = u.pn * HALF + wc * 32 + 8 * fq;
#pragma unroll
        for (int ai = 0; ai < 2; ++ai)
#pragma unroll
            for (int m = 0; m < 4; ++m) { unsigned char* rowp = H + (size_t)(row0 + ai * HALF + m * 16) * ldh + col0;
                f32x4 v[2];
#pragma unroll
                for (int n = 0; n < 2; ++n) { const f32x4 gt = acc[ai][0][m][n] * ws, up = acc[ai][1][m][n] * (ws * hs);
#pragma unroll
                    for (int j = 0; j < 4; ++j) v[n][j] = fsilu(gt[j]) * up[j]; }
                *(u32x2*)rowp = (u32x2){pk_fp8x4(v[0][0], v[0][1], v[0][2], v[0][3]), pk_fp8x4(v[1][0], v[1][1], v[1][2], v[1][3])}; }
    }
};
struct EpiPlain {
    static constexpr bool PERM = true;
    bf16_t* O; int ldc; float sc;
    __device__ __forceinline__ void operator()(const f32x4 (&acc)[2][2][4][2], const Unit& u, int wr, int wc, int fr, int fq) const {
        const int row0 = u.pm * BM + wr * 64 + fr, col0 = u.pn * BM + wc * 32 + 8 * fq;
#pragma unroll
        for (int ai = 0; ai < 2; ++ai)
#pragma unroll
            for (int m = 0; m < 4; ++m) { bf16_t* rowp = O + (size_t)(row0 + ai * HALF + m * 16) * ldc + col0;
#pragma unroll
                for (int bj = 0; bj < 2; ++bj) { const f32x4 v0 = acc[ai][bj][m][0] * sc, v1 = acc[ai][bj][m][1] * sc;
                    u32x4 w; w.x = cvt_pk_bf16(v0[0], v0[1]); w.y = cvt_pk_bf16(v0[2], v0[3]); w.z = cvt_pk_bf16(v1[0], v1[1]); w.w = cvt_pk_bf16(v1[2], v1[3]);
                    *(u32x4*)(rowp + bj * HALF) = w; } }
    }
};
struct EpiAct {
    static constexpr bool PERM = true;
    int kind; unsigned char* ws; const float* lb;
    __device__ __forceinline__ void operator()(const f32x4 (&acc)[2][2][4][2], const Unit& u, int wr, int wc, int fr, int fq) const {
        const int row0 = u.pm * BM + wr * 64 + fr;
        int mode, ldc, colt; size_t boff;
        if (kind == 0) { const int grp = u.pn >> 2; colt = (u.pn & 3) * 256; ldc = 1024;
            boff = grp == 0 ? H_Q : grp == 1 ? H_LFF : grp == 2 ? H_LFB : grp == 3 ? H_V : H_G; mode = (grp == 0 || grp == 4) ? 1 : (grp == 3 ? 0 : 3); }
        else { ldc = LRUW; if (u.pn < 5) { boff = L_YB; colt = u.pn * 256; mode = 2; } else { boff = L_XB; colt = (u.pn - 5) * 256; mode = 0; } }
        bf16_t* base = (bf16_t*)(ws + boff);
        const int col0 = colt + wc * 32 + 8 * fq;
        f32x4 lbv[2][2];
        if (mode == 3) { const float* lp = lb + ((u.pn >> 2) - 1) * 1024 + col0;
#pragma unroll
            for (int bj = 0; bj < 2; ++bj)
#pragma unroll
                for (int n = 0; n < 2; ++n) lbv[bj][n] = *(const f32x4*)(lp + bj * HALF + 4 * n); }
#pragma unroll
        for (int ai = 0; ai < 2; ++ai)
#pragma unroll
            for (int m = 0; m < 4; ++m) { bf16_t* rowp = base + (size_t)(row0 + ai * HALF + m * 16) * ldc + col0;
#pragma unroll
                for (int bj = 0; bj < 2; ++bj) { f32x4 v[2]; u32x4 w;
#pragma unroll
                    for (int n = 0; n < 2; ++n) { v[n] = acc[ai][bj][m][n];
                        if (mode == 1) {
#pragma unroll
                            for (int j = 0; j < 4; ++j) v[n][j] = fsilu(v[n][j]); }
                        else if (mode == 2) {
#pragma unroll
                            for (int j = 0; j < 4; ++j) { const float x = v[n][j]; v[n][j] = x * fsigmoid(1.5957691216057308f * (x + 0.044715f * x * x * x)); } }
                        else if (mode == 3) {
#pragma unroll
                            for (int j = 0; j < 4; ++j) { const float l = lbv[bj][n][j]; const float fg = l + (1.0f - l) * fsigmoid(v[n][j]); v[n][j] = __builtin_amdgcn_logf(fg) * 0.6931471805599453f; } }
                    }
                    if (mode == 3) {
#pragma unroll
                        for (int n = 0; n < 2; ++n) { const _Float16 h0 = (_Float16)v[n][0], h1 = (_Float16)v[n][1], h2 = (_Float16)v[n][2], h3 = (_Float16)v[n][3];
                            const unsigned a = (unsigned)__builtin_bit_cast(unsigned short, h0) | ((unsigned)__builtin_bit_cast(unsigned short, h1) << 16);
                            const unsigned b = (unsigned)__builtin_bit_cast(unsigned short, h2) | ((unsigned)__builtin_bit_cast(unsigned short, h3) << 16);
                            if (n == 0) { w.x = a; w.y = b; } else { w.z = a; w.w = b; } }
                    } else { w.x = cvt_pk_bf16(v[0][0], v[0][1]); w.y = cvt_pk_bf16(v[0][2], v[0][3]); w.z = cvt_pk_bf16(v[1][0], v[1][1]); w.w = cvt_pk_bf16(v[1][2], v[1][3]); }
                    *(u32x4*)(rowp + bj * HALF) = w; } }
    }
};
}

struct Args { const float* in[30]; float* out; unsigned char* ws; };
enum { I_X = 0, I_C, I_ADAW, I_ADAB, I_N1G, I_N2G, I_ATWIN, I_ATQN, I_ATKN, I_ATLAM, I_ATSUB, I_ATWOUT, I_HGWIN, I_HGLB, I_HGNG, I_HGWOUT,
       I_LRWIN, I_LRCW, I_LRCB, I_LRWA, I_LRBA, I_LRWX, I_LRBX, I_LRLAM, I_LRWOUT, I_FFGU, I_FFDN, I_MOER, I_MOEGU, I_MOEDN };
enum { SC_LAM0 = 0, SC_LAM1, SC_OML0, SC_OML1, SC_MC0, SC_MC1 };

__device__ __forceinline__ void cvt_item(const float* W, int ldw, int src_col0, bf16_t* WT, int ldt, int dst_row0, int k0, LAS float* scr, int lane) {
#pragma unroll 8
    for (int i = 0; i < 32; ++i) { const int kk = 2 * i + (lane >> 5); scr[kk * 33 + (lane & 31)] = W[(size_t)(k0 + kk) * ldw + src_col0 + (lane & 31)]; }
    LDS_WAIT(); asm volatile("" ::: "memory");
    const int c = lane & 7;
#pragma unroll
    for (int j = 0; j < 4; ++j) { const int n = (lane >> 3) + 8 * j; const LAS float* s = scr + (8 * c) * 33 + n;
        u32x4 o; o.x = cvt_pk_bf16(s[0 * 33], s[1 * 33]); o.y = cvt_pk_bf16(s[2 * 33], s[3 * 33]); o.z = cvt_pk_bf16(s[4 * 33], s[5 * 33]); o.w = cvt_pk_bf16(s[6 * 33], s[7 * 33]);
        *(u32x4*)(WT + (size_t)(dst_row0 + n) * ldt + k0 + 8 * c) = o; }
    LDS_WAIT(); asm volatile("" ::: "memory");
}
__device__ __forceinline__ void cvt_item8(const float* W, int ldw, int src_col0, unsigned char* WT, int ldt, int dst_row0, int k0, float sc, LAS float* scr, int lane) {
#pragma unroll 8
    for (int i = 0; i < 32; ++i) { const int kk = 2 * i + (lane >> 5); scr[kk * 33 + (lane & 31)] = W[(size_t)(k0 + kk) * ldw + src_col0 + (lane & 31)]; }
    LDS_WAIT(); asm volatile("" ::: "memory");
    const int c = lane & 7;
#pragma unroll
    for (int j = 0; j < 4; ++j) { const int n = (lane >> 3) + 8 * j; const LAS float* s = scr + (8 * c) * 33 + n;
        *(u32x2*)(WT + (size_t)(dst_row0 + n) * ldt + k0 + 8 * c) = (u32x2){pk_fp8x4(s[0 * 33] * sc, s[1 * 33] * sc, s[2 * 33] * sc, s[3 * 33] * sc), pk_fp8x4(s[4 * 33] * sc, s[5 * 33] * sc, s[6 * 33] * sc, s[7 * 33] * sc)}; }
    LDS_WAIT(); asm volatile("" ::: "memory");
}
enum { MAP_ID = 0, MAP_QKV = 1, MAP_SWI = 2 };
template <bool F8 = false>
__device__ __forceinline__ void cvt_family(const float* src, size_t sstride, int ninst, int ldw, int K, int ng, int map, int F, bf16_t* dst, size_t dstride,
                                           LAS float* scr, int gw, int NGW, int lane) {
    const int nkb = K / 64, per = nkb * ng, total = ninst * per;
    for (int it = gw; it < total; it += NGW) {
        const int inst = it / per, r = it - inst * per, kb = r / ng, gi = r - kb * ng;
        int sc0;
        if (map == MAP_ID) sc0 = 32 * gi;
        else if (map == MAP_QKV) { const int pn = gi >> 3, bj = (gi >> 2) & 1, wc = gi & 3;
            if (pn < 8) { const int part = pn >> 2, sh = 4 * (pn & 3) + wc; sc0 = part * 1024 + sh * 64 + 32 * bj; } else sc0 = 32 * gi; }
        else { const int pn = gi >> 3, bj = (gi >> 2) & 1, q = gi & 3; sc0 = bj * F + pn * 128 + 32 * q; }
        if constexpr (F8) cvt_item8(src + (size_t)inst * sstride, ldw, sc0, (unsigned char*)dst + (size_t)inst * dstride, K, 32 * gi, 64 * kb, MOE_WSCALE, scr, lane);
        else cvt_item(src + (size_t)inst * sstride, ldw, sc0, dst + (size_t)inst * dstride, K, 32 * gi, 64 * kb, scr, lane);
    }
}

__device__ __forceinline__ void prologue_phase(const Args& A, LAS unsigned char* lds, int bid, int G) {
    const int tid = threadIdx.x, lane = tid & 63, wave = tid >> 6;
    unsigned char* ws = A.ws;
    {
        LAS float* sc = (LAS float*)lds;
        LAS float* red = (LAS float*)(lds + 32768);
        for (int i = tid; i < NBATCH * DM; i += NTHR) { const float cv = A.in[I_C][i]; sc[i] = fsilu(cv); }
        __syncthreads();
        float* mods = (float*)(ws + TB_MODS);
        for (int cb = bid; cb < (DEPTH * 6144) / 128; cb += G) {
            const int col = cb * 128 + (tid & 127), l = col / 6144, e = col - l * 6144, ch = tid >> 7;
            const float* wp = A.in[I_ADAW] + (size_t)l * DM * 6144 + e;
            float a[NBATCH];
#pragma unroll
            for (int b = 0; b < NBATCH; ++b) a[b] = 0.f;
#pragma unroll 4
            for (int d = ch * 256; d < ch * 256 + 256; ++d) { const float w = wp[(size_t)d * 6144];
#pragma unroll
                for (int b = 0; b < NBATCH; ++b) a[b] += sc[b * DM + d] * w; }
#pragma unroll
            for (int b = 0; b < NBATCH; ++b) red[(ch * 128 + (tid & 127)) * 8 + b] = a[b];
            __syncthreads();
            if (tid < 128) { const float bias = A.in[I_ADAB][l * 6144 + e];
#pragma unroll
                for (int b = 0; b < NBATCH; ++b) { const float s = ((red[(0 * 128 + tid) * 8 + b] + red[(1 * 128 + tid) * 8 + b]) + (red[(2 * 128 + tid) * 8 + b] + red[(3 * 128 + tid) * 8 + b])) + bias;
                    mods[((size_t)l * NBATCH + b) * 6144 + e] = s; } }
            __syncthreads();
        }
    }
    {
        float* cosT = (float*)(ws + TB_COS); float* sinT = (float*)(ws + TB_SIN);
        for (int i = bid * NTHR + tid; i < SEQ * 32; i += G * NTHR) {
            const int pos = i >> 5, d = i & 31;
            const float inv = (float)exp(-(double)d * (1.0 / 32.0) * 9.210340371976184);
            const float ang = (float)pos * inv;
            const double rev = (double)ang * 0.15915494309189535; const float fr = (float)(rev - floor(rev));
            cosT[i] = __builtin_amdgcn_cosf(fr); sinT[i] = __builtin_amdgcn_sinf(fr);
        }
        if (bid == 0 && tid < 2) {
            const int a = tid; const float* lm = A.in[I_ATLAM] + a * 256;
            float s1 = 0.f, s2 = 0.f; for (int i = 0; i < 64; ++i) { s1 += lm[i] * lm[64 + i]; s2 += lm[128 + i] * lm[192 + i]; }
            const float linit = 0.8f - 0.6f * expf(-0.3f * (float)(3 * a));
            float mq = 0.f, mk = 0.f; for (int i = 0; i < 64; ++i) { mq = fmaxf(mq, fabsf(A.in[I_ATQN][a * 64 + i])); mk = fmaxf(mk, fabsf(A.in[I_ATKN][a * 64 + i])); }
            float* scal = (float*)(ws + TB_SCAL);
            scal[SC_LAM0 + a] = expf(s1) - expf(s2) + linit; scal[SC_OML0 + a] = 1.0f - linit; scal[SC_MC0 + a] = 8.0f * mq * mk * LOG2E * 1.0001f;
        }
        if (bid == 1) {
            float* lb = (float*)(ws + TB_LB);
            for (int i = tid; i < 2 * 1024; i += NTHR) { const int d = i >> 10, k = i & 1023; const float* p = A.in[I_HGLB] + (size_t)d * DEPTH * 1024 + k;
                float mx = p[0]; for (int l = 1; l < DEPTH; ++l) mx = fmaxf(mx, p[l * 1024]);
                float den = 0.f, num = 0.f; for (int l = 0; l < DEPTH; ++l) { const float e = expf(p[l * 1024] - mx); den += e; if (l == 1) num += e; }
                lb[i] = num / den; }
        }
        if (bid == 2) {
            float* sp = (float*)(ws + TB_SP);
            for (int i = tid; i < 2 * LRUW; i += NTHR) { const float x = -A.in[I_LRLAM][i]; sp[i] = (x > 20.f) ? x : log1pf(expf(x)); }
        }
    }
    {
        LAS float* scr = (LAS float*)(lds + wave * 16384);
        const int vcu = (bid % 8) * (G / 8) + bid / 8;
        const int gw = vcu * NWAVES + wave, NGW = G * NWAVES;
        cvt_family(A.in[I_ATWIN], (size_t)1024 * 3072, 2, 3072, 1024, 96, MAP_QKV, 0, (bf16_t*)(ws + W_QKV), (size_t)3072 * 1024, scr, gw, NGW, lane);
        cvt_family(A.in[I_ATWOUT], (size_t)1024 * 1024, 2, 1024, 1024, 32, MAP_ID, 0, (bf16_t*)(ws + W_AO), (size_t)1024 * 1024, scr, gw, NGW, lane);
        cvt_family(A.in[I_HGWIN], 0, 1, 5120, 1024, 160, MAP_ID, 0, (bf16_t*)(ws + W_HGI), 0, scr, gw, NGW, lane);
        cvt_family(A.in[I_HGWOUT], 0, 1, 1024, 1024, 32, MAP_ID, 0, (bf16_t*)(ws + W_HGO), 0, scr, gw, NGW, lane);
        cvt_family(A.in[I_LRWIN], 0, 1, 2560, 1024, 80, MAP_ID, 0, (bf16_t*)(ws + W_LRI), 0, scr, gw, NGW, lane);
        cvt_family(A.in[I_LRWOUT], 0, 1, 1024, 1280, 32, MAP_ID, 0, (bf16_t*)(ws + W_LRO), 0, scr, gw, NGW, lane);
        for (int it = gw; it < 2 * 20 * 2 * 4; it += NGW) {
            const int part = it / 160, r = it % 160, inst = r >> 3, kb = (r >> 2) & 1, gi = r & 3, d = inst / 10, n = inst % 10;
            const float* src = (part ? A.in[I_LRWX] : A.in[I_LRWA]) + (size_t)inst * 16384;
            cvt_item(src, 128, 32 * gi, (bf16_t*)(ws + W_LRG) + (size_t)(n * 2 + d) * 256 * 128, 128, part * 128 + 32 * gi, 64 * kb, scr, lane);
        }
        static_assert(FP8_DENSE_FROM == 2 || FP8_DENSE_FROM > 3, "dense layer 0 stays bf16; layer 2 optional");
        constexpr int NB16 = (FP8_DENSE_FROM == 2) ? 1 : 2;
        cvt_family(A.in[I_FFGU], (size_t)1024 * 5632, NB16, 5632, 1024, 176, MAP_SWI, DFF, (bf16_t*)(ws + W_FGU), (size_t)5632 * 1024, scr, gw, NGW, lane);
        cvt_family(A.in[I_FFDN], (size_t)2816 * 1024, NB16, 1024, 2816, 32, MAP_ID, 0, (bf16_t*)(ws + W_FDN), (size_t)1024 * 2816, scr, gw, NGW, lane);
        if constexpr (NB16 == 1) {
            cvt_family<true>(A.in[I_FFGU] + (size_t)1024 * 5632, 0, 1, 5632, 1024, 176, MAP_SWI, DFF, (bf16_t*)(ws + W_FGU) + (size_t)5632 * 1024, 0, scr, gw, NGW, lane);
            cvt_family<true>(A.in[I_FFDN] + (size_t)2816 * 1024, 0, 1, 1024, 2816, 32, MAP_ID, 0, (bf16_t*)(ws + W_FDN) + (size_t)1024 * 2816, 0, scr, gw, NGW, lane);
        }
        cvt_family<true>(A.in[I_MOEGU], (size_t)1024 * 7168, 16, 7168, 1024, 224, MAP_SWI, DFFE, (bf16_t*)(ws + W_MGU), (size_t)7168 * 1024, scr, gw, NGW, lane);
        cvt_family<true>(A.in[I_MOEDN], (size_t)3584 * 1024, 16, 1024, 3584, 32, MAP_ID, 0, (bf16_t*)(ws + W_MDN), (size_t)1024 * 3584, scr, gw, NGW, lane);
    }
}

template <bool ROUTER>
__device__ __forceinline__ void norm_phase(const Args& A, LAS unsigned char* lds, int bid, int G, const void* xsrc, bool src16, void* xdst, bool dst16, const float* gain, const float* modl  , int which,
                                           bool combine, const float* modprev  , bool nonorm, const float* router, bool f8out = false) {
    int tid_ = threadIdx.x; asm volatile("" : "+v"(tid_));
    const int tid = tid_, lane = tid & 63, wave = tid >> 6;
    unsigned char* ws = A.ws;
    bf16_t* HM = (bf16_t*)(ws + WS_HM);
    const int* slot = (const int*)(ws + TB_SLOT); const float* gts = (const float*)(ws + TB_GATE);
    const bf16_t* Y = (const bf16_t*)(ws + E_XS);
    LAS int* hist = (LAS int*)lds;
    for (int tb = bid; tb < MTOK / 256; tb += G) {
        const int b = tb >> 5;
        f32x4 ga[4], sh[4], g2[4];
#pragma unroll
        for (int j = 0; j < 4; ++j) { const int c = 256 * j + 4 * lane;
            if (!nonorm) { const f32x4 gv = *(const f32x4*)(gain + c), sv = *(const f32x4*)(modl + (size_t)b * 6144 + (which * 3 + 1) * 1024 + c);
                ga[j] = gv * (sv + 1.0f); sh[j] = *(const f32x4*)(modl + (size_t)b * 6144 + (which * 3) * 1024 + c); }
            if (combine) g2[j] = *(const f32x4*)(modprev + (size_t)b * 6144 + 5 * 1024 + c); }
        f32x4 rw[ROUTER ? 32 : 1];
        if constexpr (ROUTER) {
            if (tid < 8) hist[tid] = 0;
#pragma unroll
            for (int j = 0; j < 4; ++j)
#pragma unroll
                for (int i = 0; i < 4; ++i) { const int c = 256 * j + 4 * lane + i; rw[(j * 4 + i) * 2] = *(const f32x4*)(router + c * 8); rw[(j * 4 + i) * 2 + 1] = *(const f32x4*)(router + c * 8 + 4); }
            __syncthreads();
        }
        for (int i = 0; i < 32; ++i) {
            const int row = tb * 256 + wave * 32 + i;
            f32x4 v[4];
#pragma unroll
            for (int j = 0; j < 4; ++j) v[j] = pg8::ld_x4(xsrc, (size_t)row * DM + 256 * j + 4 * lane, src16);
            if (combine) {
                const int s0 = slot[row * 2], s1 = slot[row * 2 + 1]; const float w0 = gts[row * 2], w1 = gts[row * 2 + 1];
#pragma unroll
                for (int j = 0; j < 4; ++j) { const u32x2 a = *(const u32x2*)(Y + (size_t)s0 * DM + 256 * j + 4 * lane), c2 = *(const u32x2*)(Y + (size_t)s1 * DM + 256 * j + 4 * lane);
                    f32x4 y; y[0] = w0 * bflo(a.x) + w1 * bflo(c2.x); y[1] = w0 * bfhi(a.x) + w1 * bfhi(c2.x); y[2] = w0 * bflo(a.y) + w1 * bflo(c2.y); y[3] = w0 * bfhi(a.y) + w1 * bfhi(c2.y);
                    v[j] = v[j] + g2[j] * y;
                    if (dst16) *(u32x2*)((bf16_t*)xdst + (size_t)row * DM + 256 * j + 4 * lane) = (u32x2){cvt_pk_bf16(v[j][0], v[j][1]), cvt_pk_bf16(v[j][2], v[j][3])};
                    else *(f32x4*)((float*)xdst + (size_t)row * DM + 256 * j + 4 * lane) = v[j]; }
            }
            if (nonorm) continue;
            float ss = 0.f;
#pragma unroll
            for (int j = 0; j < 4; ++j) ss += (v[j][0] * v[j][0] + v[j][1] * v[j][1]) + (v[j][2] * v[j][2] + v[j][3] * v[j][3]);
            ss = wave_sum(ss);
            const float rstd = 1.0f / sqrtf(ss * (1.0f / DM) + EPS);
            f32x4 h[4];
#pragma unroll
            for (int j = 0; j < 4; ++j) { h[j] = v[j] * rstd * ga[j] + sh[j];
                if (f8out) { *(unsigned*)((unsigned char*)HM + (size_t)row * DM + 256 * j + 4 * lane) = pk_fp8x4(h[j][0], h[j][1], h[j][2], h[j][3]); }
                else { u32x2 w; w.x = cvt_pk_bf16(h[j][0], h[j][1]); w.y = cvt_pk_bf16(h[j][2], h[j][3]);
                    *(u32x2*)(HM + (size_t)row * DM + 256 * j + 4 * lane) = w; } }
            if constexpr (ROUTER) {
                float lg[8];
#pragma unroll
                for (int e = 0; e < 8; ++e) lg[e] = 0.f;
#pragma unroll
                for (int j = 0; j < 4; ++j)
#pragma unroll
                    for (int q = 0; q < 4; ++q) { const float hv = h[j][q]; const f32x4 r0 = rw[(j * 4 + q) * 2], r1 = rw[(j * 4 + q) * 2 + 1];
                        lg[0] += hv * r0[0]; lg[1] += hv * r0[1]; lg[2] += hv * r0[2]; lg[3] += hv * r0[3]; lg[4] += hv * r1[0]; lg[5] += hv * r1[1]; lg[6] += hv * r1[2]; lg[7] += hv * r1[3]; }
#pragma unroll
                for (int e = 0; e < 8; ++e) lg[e] = wave_sum(lg[e]);
                int e0 = 0; float v0 = lg[0];
#pragma unroll
                for (int e = 1; e < 8; ++e) if (lg[e] > v0) { v0 = lg[e]; e0 = e; }
                int e1 = -1; float v1 = -3.0e38f;
#pragma unroll
                for (int e = 0; e < 8; ++e) if (e != e0 && lg[e] > v1) { v1 = lg[e]; e1 = e; }
                const float p1 = frcp(1.0f + fexp(v1 - v0));
                if (lane == 0) { int* eid = (int*)(ws + TB_EID); float* gt = (float*)(ws + TB_GATE);
                    eid[row * 2] = e0; eid[row * 2 + 1] = e1; gt[row * 2] = p1; gt[row * 2 + 1] = 1.0f - p1;
                    atomicAdd((int*)&hist[e0], 1); atomicAdd((int*)&hist[e1], 1); }
            }
        }
        if constexpr (ROUTER) {
            __syncthreads();
            if (tid < 8) ((int*)(ws + TB_BCNT))[tb * 8 + tid] = hist[tid];
            __syncthreads();
        }
    }
}

namespace lru {
constexpr int XCF = 0, XCB = 16384, AA = 24576, UU = 40960;
__device__ __forceinline__ int sw256(int row, int cb) { return row * 256 + (cb ^ ((row & 15) << 4)); }
__device__ __forceinline__ int crow(int r, int hi) { return (r & 3) + 8 * (r >> 2) + 4 * hi; }
template <int MODE>
__device__ __forceinline__ void lru_item(const Args& A, LAS unsigned char* lds, int b, int n, int seg, int dir) {
    int tid_ = threadIdx.x; asm volatile("" : "+v"(tid_));
    const int tid = tid_, wid = tid >> 6, lane = tid & 63, r = lane & 31, hh = lane >> 5;
    unsigned char* ws = A.ws;
    const bf16_t* XB = (const bf16_t*)(ws + L_XB); const bf16_t* YB = (const bf16_t*)(ws + L_YB); bf16_t* HF = (bf16_t*)(ws + L_HF); bf16_t* HY = (bf16_t*)(ws + L_HY);
    const bf16_t* Wg = (const bf16_t*)(ws + W_LRG) + (size_t)((n * 2 + dir) * 256 + ((r < 16) ? (16 * wid + r) : (128 + 16 * wid + r - 16))) * 128 + 8 * hh;
    bf16x8 bfrag[8];
#pragma unroll
    for (int ks = 0; ks < 8; ++ks) bfrag[ks] = *(const bf16x8*)(Wg + 16 * ks);
    const int cch = n * 128 + 16 * wid + (r & 15);
    const float nba = -LOG2E * A.in[I_LRBA][dir * LRUW + cch], nbx = -LOG2E * A.in[I_LRBX][dir * LRUW + cch], csp = -8.0f * LOG2E * ((const float*)(ws + TB_SP))[dir * LRUW + cch];
    const int ct = tid >> 4, cg = tid & 15, cc0 = n * 128 + 8 * cg;
    float cw[4][8], cb[8];
#pragma unroll
    for (int j = 0; j < 8; ++j) { cb[j] = A.in[I_LRCB][cc0 + j];
#pragma unroll
        for (int w = 0; w < 4; ++w) cw[w][j] = A.in[I_LRCW][w * LRUW + cc0 + j]; }
    float carry = 0.f, P = 1.f;
    if (MODE != 0 && tid < 128) carry = ((const float*)(ws + TB_LCIN))[(size_t)((b * 32 + seg) * 2 + dir) * LRUW + n * 128 + tid];
    u32x4 xr[4];
#define LRU_XLOAD(si_) do { const int sub_ = dir ? (7 - (si_)) : (si_); const int tok_ = seg * 256 + sub_ * 32 + ct; \
        _Pragma("unroll") for (int w = 0; w < 4; ++w) { const int tt = tok_ - 1 + w; xr[w] = (tt >= 0 && tt < SEQ) ? *(const u32x4*)(XB + ((size_t)b * SEQ + tt) * LRUW + cc0) : (u32x4){0u, 0u, 0u, 0u}; } } while (0)
    LRU_XLOAD(0);
    for (int si = 0; si < 8; ++si) {
        const int sub = dir ? (7 - si) : si; const int t0 = seg * 256 + sub * 32;
        {
            float xc[8];
#pragma unroll
            for (int j = 0; j < 8; ++j) xc[j] = cb[j];
#pragma unroll
            for (int w = 0; w < 4; ++w) { const u32x4 v = xr[w];
#pragma unroll
                for (int e = 0; e < 4; ++e) { xc[2 * e] += cw[w][2 * e] * bflo(v[e]); xc[2 * e + 1] += cw[w][2 * e + 1] * bfhi(v[e]); } }
            if (si + 1 < 8) LRU_XLOAD(si + 1);
            *(LAS f32x4*)(lds + XCF + (ct * 128 + 8 * cg) * 4) = (f32x4){xc[0], xc[1], xc[2], xc[3]};
            *(LAS f32x4*)(lds + XCF + (ct * 128 + 8 * cg + 4) * 4) = (f32x4){xc[4], xc[5], xc[6], xc[7]};
            *(LAS u32x4*)(lds + XCB + sw256(ct, 16 * cg)) = (u32x4){cvt_pk_bf16(xc[0], xc[1]), cvt_pk_bf16(xc[2], xc[3]), cvt_pk_bf16(xc[4], xc[5]), cvt_pk_bf16(xc[6], xc[7])};
        }
        __syncthreads();
        {
            f32x16 acc = {};
#pragma unroll
            for (int ks = 0; ks < 8; ++ks) { const bf16x8 fa = *(const LAS bf16x8*)(lds + XCB + sw256(r, (16 * ks + 8 * hh) * 2)); acc = __builtin_amdgcn_mfma_f32_32x32x16_bf16(fa, bfrag[ks], acc, 0, 0, 0); }
#pragma unroll
            for (int q = 0; q < 8; ++q) {
                const auto sw = __builtin_amdgcn_permlane16_swap(__float_as_uint(acc[q]), __float_as_uint(acc[8 + q]), false, false);
                const float rp = __uint_as_float(sw[0]), ip = __uint_as_float(sw[1]);
                const int tq = crow((r < 16) ? q : (8 + q), hh); const int cl = 16 * wid + (r & 15);
                const float xcv = ((const LAS float*)(lds + XCF))[tq * 128 + cl];
                const float rg = frcp(1.0f + fexp2(fmaf(rp, -LOG2E, nba))), ig = frcp(1.0f + fexp2(fmaf(ip, -LOG2E, nbx)));
                const float av = fexp2(csp * rg), uv = __builtin_amdgcn_sqrtf(fmaxf(fmaf(-av, av, 1.0f), 0.f)) * ig * xcv;
                ((LAS float*)(lds + AA))[tq * 128 + cl] = av; ((LAS float*)(lds + UU))[tq * 128 + cl] = uv; }
        }
        __syncthreads();
        if (tid < 128) {
            LAS float* ap = (LAS float*)(lds + AA) + tid; LAS float* up = (LAS float*)(lds + UU) + tid; float av[32], uv[32];
#pragma unroll
            for (int i = 0; i < 32; ++i) { av[i] = ap[i * 128]; uv[i] = up[i * 128]; }
            if (dir == 0) {
#pragma unroll
                for (int i = 0; i < 32; ++i) { carry = av[i] * carry + uv[i]; if (MODE == 0) P *= av[i]; else uv[i] = carry; } }
            else {
#pragma unroll
                for (int i = 31; i >= 0; --i) { carry = av[i] * carry + uv[i]; if (MODE == 0) P *= av[i]; else uv[i] = carry; } }
            if (MODE != 0) {
#pragma unroll
                for (int i = 0; i < 32; ++i) up[i * 128] = uv[i]; }
        }
        if (MODE != 0) {
            __syncthreads();
            const int tok = t0 + ct; const size_t go = ((size_t)b * SEQ + tok) * LRUW + cc0;
            const f32x4 h0 = *(const LAS f32x4*)(lds + UU + (ct * 128 + 8 * cg) * 4), h1 = *(const LAS f32x4*)(lds + UU + (ct * 128 + 8 * cg + 4) * 4);
            if (MODE == 1) { *(u32x4*)(HF + go) = (u32x4){cvt_pk_bf16(h0[0], h0[1]), cvt_pk_bf16(h0[2], h0[3]), cvt_pk_bf16(h1[0], h1[1]), cvt_pk_bf16(h1[2], h1[3])}; }
            else { const u32x4 f = *(const u32x4*)(HF + go), y = *(const u32x4*)(YB + go);
                *(u32x4*)(HY + go) = (u32x4){cvt_pk_bf16((h0[0] + bflo(f[0])) * bflo(y[0]), (h0[1] + bfhi(f[0])) * bfhi(y[0])), cvt_pk_bf16((h0[2] + bflo(f[1])) * bflo(y[1]), (h0[3] + bfhi(f[1])) * bfhi(y[1])),
                                            cvt_pk_bf16((h1[0] + bflo(f[2])) * bflo(y[2]), (h1[1] + bfhi(f[2])) * bfhi(y[2])), cvt_pk_bf16((h1[2] + bflo(f[3])) * bflo(y[3]), (h1[3] + bfhi(f[3])) * bfhi(y[3]))}; }
        }
        __syncthreads();
    }
#undef LRU_XLOAD
    if (MODE == 0 && tid < 128) { float* sm = (float*)(ws + TB_LSUM) + (size_t)(((b * 32 + seg) * 2 + dir) * 2) * LRUW + n * 128 + tid; sm[0] = P; sm[LRUW] = carry; }
}
}
template <int MODE>
__device__ __forceinline__ void lru_phase(const Args& A, LAS unsigned char* lds, int bid, int G) {
    const int nitems = (MODE == 0) ? 5120 : 2560;
    for (int it = bid; it < nitems; it += G) {
        int b, n, seg, dir;
        if (MODE == 0) { dir = it & 1; const int r = it >> 1; seg = r & 31; n = (r >> 5) % 10; b = r / 320; }
        else { dir = MODE - 1; seg = it & 31; n = (it >> 5) % 10; b = it / 320; }
        lru::lru_item<MODE>(A, lds, b, n, seg, dir);
    }
}
__device__ __forceinline__ void lru_carry_phase(const Args& A, int bid, int G) {
    const float* sm = (const float*)(A.ws + TB_LSUM); float* cin = (float*)(A.ws + TB_LCIN);
    for (int idx = bid * NTHR + threadIdx.x; idx < NBATCH * 2 * LRUW; idx += G * NTHR) {
        const int b = idx / (2 * LRUW), r = idx % (2 * LRUW), dir = r / LRUW, ch = r % LRUW; float carry = 0.f;
        for (int i = 0; i < 32; ++i) { const int sg = dir ? (31 - i) : i; const size_t o = (size_t)((b * 32 + sg) * 2 + dir);
            cin[o * LRUW + ch] = carry; carry = sm[o * 2 * LRUW + ch] * carry + sm[o * 2 * LRUW + LRUW + ch]; }
    }
}

__device__ __forceinline__ void place_phase(const Args& A, LAS unsigned char* lds, int bid, int G) {
    int tid_ = threadIdx.x; asm volatile("" : "+v"(tid_));
    const int tid = tid_, lane = tid & 63, wave = tid >> 6; unsigned char* ws = A.ws;
    const int* bcnt = (const int*)(ws + TB_BCNT); const int* eid = (const int*)(ws + TB_EID); int* slot = (int*)(ws + TB_SLOT);
    const bf16_t* HM = (const bf16_t*)(ws + WS_HM); bf16_t* XS = (bf16_t*)(ws + E_XS);
    LAS int* tot = (LAS int*)lds; LAS int* pre = tot + 8; LAS int* rb = tot + 16; LAS int* wcn = tot + 32; LAS int* sl = tot + 64;
    for (int tb = bid; tb < MTOK / 256; tb += G) {
        { int t_ = 0, p_ = 0;
#pragma unroll
            for (int j = 0; j < 4; ++j) { const int blk = lane + 64 * j; const int v = bcnt[blk * 8 + wave]; t_ += v; p_ += (blk < tb) ? v : 0; }
#pragma unroll
            for (int o = 1; o < 64; o <<= 1) { t_ += __shfl_xor(t_, o); p_ += __shfl_xor(p_, o); }
            if (lane == 0) { tot[wave] = t_; pre[wave] = p_; } }
        __syncthreads();
        if (tid == 0) { int acc = 0; for (int e = 0; e < 8; ++e) { rb[e] = acc * 256; if (tb == 0) ((int*)(ws + TB_TILES))[e] = acc; acc += (tot[e] + 255) >> 8; } if (tb == 0) ((int*)(ws + TB_TILES))[8] = acc; }
        int e0 = -1, e1 = -1; unsigned long long mk0 = 0, mk1 = 0;
        if (tid < 256) { e0 = eid[(tb * 256 + tid) * 2]; e1 = eid[(tb * 256 + tid) * 2 + 1];
#pragma unroll
            for (int e = 0; e < 8; ++e) { const unsigned long long m = __ballot(e0 == e || e1 == e); if (lane == 0) wcn[wave * 8 + e] = __popcll(m); if (e0 == e) mk0 = m; if (e1 == e) mk1 = m; } }
        __syncthreads();
        if (tid < 256) { const unsigned long long lt = (1ull << lane) - 1ull; int b0 = rb[e0] + pre[e0] + __popcll(mk0 & lt), b1 = rb[e1] + pre[e1] + __popcll(mk1 & lt);
            for (int w = 0; w < wave; ++w) { b0 += wcn[w * 8 + e0]; b1 += wcn[w * 8 + e1]; }
            sl[tid * 2] = b0; sl[tid * 2 + 1] = b1; slot[(tb * 256 + tid) * 2] = b0; slot[(tb * 256 + tid) * 2 + 1] = b1; }
        __syncthreads();
        for (int i = 0; i < 32; ++i) { const int t = wave * 32 + i; const int s0 = sl[t * 2], s1 = sl[t * 2 + 1];
            const bf16_t* src = HM + (size_t)(tb * 256 + t) * DM + lane * 16;
            const u32x4 a = *(const u32x4*)src, b = *(const u32x4*)(src + 8);
            const u32x4 q = {pk_fp8x4(bflo(a[0]), bfhi(a[0]), bflo(a[1]), bfhi(a[1])), pk_fp8x4(bflo(a[2]), bfhi(a[2]), bflo(a[3]), bfhi(a[3])),
                             pk_fp8x4(bflo(b[0]), bfhi(b[0]), bflo(b[1]), bfhi(b[1])), pk_fp8x4(bflo(b[2]), bfhi(b[2]), bflo(b[3]), bfhi(b[3]))};
            *(u32x4*)((unsigned char*)XS + (size_t)s0 * DM + lane * 16) = q; *(u32x4*)((unsigned char*)XS + (size_t)s1 * DM + lane * 16) = q; }
        __syncthreads();
    }
}

namespace att {
constexpr int KVBLK = 64;
#define SBAR() __builtin_amdgcn_sched_barrier(0)
typedef int v8i __attribute__((ext_vector_type(8)));
__device__ __forceinline__ int crow(int r, int hi) { return (r & 3) + 8 * (r >> 2) + 4 * hi; }
constexpr int SLOTB = 16384;
__device__ __forceinline__ int k_slot(int s) { return s * SLOTB; }
__device__ __forceinline__ int v_slot(int s) { return s * SLOTB + 8192; }
__device__ __forceinline__ int kswz(int row) { return ((row & 7) ^ (row >> 4)) & 7; }
__device__ __forceinline__ int vswz(int row) { return (row >> 2) & 3; }
__device__ __forceinline__ void mfma8_acc(f32x16& acc, const v8i& a, const v8i& b, int sc) {
    asm volatile("s_nop 4\n\tv_mfma_scale_f32_32x32x64_f8f6f4 %0, %1, %2, %0, %3, %3 op_sel_hi:[0,0,0]" : "+v"(acc) : "v"(a), "v"(b), "v"(sc));
}
__device__ __forceinline__ void mfma8_c(f32x16& d, const v8i& a, const v8i& b, const f32x16& c, int sa, int sb) {
    asm volatile("v_mfma_scale_f32_32x32x64_f8f6f4 %0, %1, %2, %3, %4, %5 op_sel_hi:[0,0,0]" : "=&v"(d) : "v"(a), "v"(b), "v"(c), "v"(sa), "v"(sb));
}
#define ATT_LD8(p0_, p1_) __builtin_bit_cast(v8i, __builtin_shufflevector(*(const LAS u32x4*)(p0_), *(const LAS u32x4*)(p1_), 0, 1, 2, 3, 4, 5, 6, 7))
__device__ __forceinline__ void qkt(f32x16& p0, f32x16& p1, const LAS char* Ks, const v8i& qr, int r32, int hi, int jj, const f32x16& cinit, int s1, int s8) {
    const int c0 = jj * 4 + 2 * hi;
    { const int row = r32; const v8i kf = ATT_LD8(Ks + row * 128 + ((c0 ^ kswz(row)) << 4), Ks + row * 128 + (((c0 + 1) ^ kswz(row)) << 4)); mfma8_c(p0, kf, qr, cinit, s1, s8); }
    { const int row = 32 + r32; const v8i kf = ATT_LD8(Ks + row * 128 + ((c0 ^ kswz(row)) << 4), Ks + row * 128 + (((c0 + 1) ^ kswz(row)) << 4)); mfma8_c(p1, kf, qr, cinit, s1, s8); }
}
__device__ __forceinline__ void partialSM(f32x16& p0) {
#pragma unroll
    for (int r = 0; r < 16; ++r) p0[r] = fexp2(p0[r]);
}
__device__ __forceinline__ void finishSM(f32x16& p0, f32x16& p1, v8i& pa) {
#pragma unroll
    for (int r = 0; r < 16; ++r) p1[r] = fexp2(p1[r]);
#pragma unroll
    for (int w = 0; w < 4; ++w) { pa[w] = (int)pk_fp8x4(p0[4 * w], p0[4 * w + 1], p0[4 * w + 2], p0[4 * w + 3]); pa[4 + w] = (int)pk_fp8x4(p1[4 * w], p1[4 * w + 1], p1[4 * w + 2], p1[4 * w + 3]); }
}
#define ATT_MX7(acc, a, b, sc, NOP, O, I, k) \
    asm volatile(NOP "v_mfma_scale_f32_32x32x64_f8f6f4 %0, %15, %16, %0, %17, %17 op_sel_hi:[0,0,0]\n\tv_exp_f32 %1, %8\n\tv_exp_f32 %2, %9\n\tv_exp_f32 %3, %10\n\tv_exp_f32 %4, %11\n\tv_exp_f32 %5, %12\n\tv_exp_f32 %6, %13\n\tv_exp_f32 %7, %14" \
                 : "+v"(acc), "=&v"(O[k]), "=&v"(O[k + 1]), "=&v"(O[k + 2]), "=&v"(O[k + 3]), "=&v"(O[k + 4]), "=&v"(O[k + 5]), "=&v"(O[k + 6]) \
                 : "v"(I(k)), "v"(I(k + 1)), "v"(I(k + 2)), "v"(I(k + 3)), "v"(I(k + 4)), "v"(I(k + 5)), "v"(I(k + 6)), "v"(a), "v"(b), "v"(sc) : "memory")
__device__ __forceinline__ void pv_exp(f32x16* o, f32x16& lacc, const v8i& ones, const LAS char* Vs, const v8i& pa, int r32, int hi, int s1, const f32x16& r0, const f32x16& r1, float (&pe)[32]) {
#define ATT_VF(d0) ATT_LD8(Vs + (32 * (d0) + r32) * 64 + (((2 * hi) ^ vswz(32 * (d0) + r32)) << 4), Vs + (32 * (d0) + r32) * 64 + (((2 * hi + 1) ^ vswz(32 * (d0) + r32)) << 4))
#define ATT_RI(k) (((k) < 16) ? r0[(k) & 15] : r1[(k) & 15])
    const v8i vf0 = ATT_VF(0), vf1 = ATT_VF(1), vf2 = ATT_VF(2), vf3 = ATT_VF(3);
    ATT_MX7(o[0], pa, vf0, s1, "s_nop 4\n\t", pe, ATT_RI, 0);
    ATT_MX7(o[1], pa, vf1, s1, "", pe, ATT_RI, 7);
    ATT_MX7(o[2], pa, vf2, s1, "", pe, ATT_RI, 14);
    ATT_MX7(o[3], pa, vf3, s1, "", pe, ATT_RI, 21);
    asm volatile("v_mfma_scale_f32_32x32x64_f8f6f4 %0, %9, %10, %0, %11, %11 op_sel_hi:[0,0,0]\n\tv_exp_f32 %1, %5\n\tv_exp_f32 %2, %6\n\tv_exp_f32 %3, %7\n\tv_exp_f32 %4, %8"
                 : "+v"(lacc), "=&v"(pe[28]), "=&v"(pe[29]), "=&v"(pe[30]), "=&v"(pe[31]) : "v"(r1[12]), "v"(r1[13]), "v"(r1[14]), "v"(r1[15]), "v"(pa), "v"(ones), "v"(s1) : "memory");
#undef ATT_VF
#undef ATT_RI
}
__device__ __forceinline__ void pack_p(const float (&pe)[32], v8i& pa) {
#pragma unroll
    for (int w = 0; w < 8; ++w) pa[w] = (int)pk_fp8x4(pe[4 * w], pe[4 * w + 1], pe[4 * w + 2], pe[4 * w + 3]);
}
__device__ __forceinline__ void pv_d0(f32x16* o, f32x16& lacc, const v8i& ones, const LAS char* Vs, const v8i& pa, int r32, int hi, int s1) {
#pragma unroll
    for (int d0 = 0; d0 < 4; ++d0) { const int row = 32 * d0 + r32;
        const v8i vf = ATT_LD8(Vs + row * 64 + (((2 * hi) ^ vswz(row)) << 4), Vs + row * 64 + (((2 * hi + 1) ^ vswz(row)) << 4));
        mfma8_acc(o[d0], pa, vf, s1); }
    mfma8_acc(lacc, pa, ones, s1);
}
}

__device__ __forceinline__ void vt_phase(const Args& A, int bid, int G) {
    const int tid = threadIdx.x; unsigned char* ws = A.ws;
    const bf16_t* V = (const bf16_t*)(ws + A_V); unsigned char* VT = ws + A_VT;
    const int dv = tid & 127, kq = tid >> 7, half = kq >> 1, hi = kq & 1;
    for (int it = bid; it < 64 * 128; it += G) {
        const int bh = it >> 7, tile = it & 127, b = bh >> 3, h = bh & 7;
        const bf16_t* vp = V + ((size_t)b * SEQ + tile * 64 + 32 * half) * DM + h * 128 + dv;
        float f[16];
#pragma unroll
        for (int i = 0; i < 16; ++i) f[i] = bf2f(vp[(size_t)att::crow(i, hi) * DM]);
        *(u32x4*)(VT + (((size_t)bh * 128 + dv) * 128 + tile) * 64 + hi * 32 + half * 16) =
            (u32x4){pk_fp8x4(f[0], f[1], f[2], f[3]), pk_fp8x4(f[4], f[5], f[6], f[7]), pk_fp8x4(f[8], f[9], f[10], f[11]), pk_fp8x4(f[12], f[13], f[14], f[15])};
    }
}

__device__ __forceinline__ void attn_phase(const Args& A, LAS unsigned char* ldsu, int bid, int G, int al) {
    using namespace att;
    LAS char* lds = (LAS char*)ldsu;
    unsigned char* ws = A.ws;
    const unsigned char* Qg = ws + A_Q; const unsigned char* Kg = ws + A_K; const unsigned char* VTg = ws + A_VT;
    bf16_t* Og = (bf16_t*)(ws + WS_HM);
    const float* scal = (const float*)(ws + TB_SCAL);
    const float lamv = scal[SC_LAM0 + al], omli = scal[SC_OML0 + al], Mc = scal[SC_MC0 + al] - 7.5f;
    const float* subg = A.in[I_ATSUB] + al * 128;
    int tid_ = threadIdx.x; asm volatile("" : "+v"(tid_));
    const int tid = tid_, wid = __builtin_amdgcn_readfirstlane(tid >> 6), lane = tid & 63, r32 = lane & 31, hi = lane >> 5, jj = wid >> 2, wq = wid & 3;
    constexpr int NT = SEQ / KVBLK;
    int s1 = 0x7f7f7f7f, s8 = 0x7c7c7c7c; asm volatile("" : "+v"(s1), "+v"(s8));
    v8i ones; { int o1 = 0x38383838; asm volatile("" : "+v"(o1)); ones = (v8i){o1, o1, o1, o1, o1, o1, o1, o1}; }
    f32x16 cinit;
#pragma unroll
    for (int r = 0; r < 16; ++r) cinit[r] = -Mc;
    unsigned koff, voff;
    { const int bb = wid * 1024 + lane * 16;
      { const int row = bb >> 7, c = ((bb & 127) >> 4) ^ kswz(row); koff = (unsigned)(row * 1024 + c * 16); }
      { const int row = bb >> 6, c = ((bb & 63) >> 4) ^ vswz(row); voff = (unsigned)(row * 8192 + c * 16); } }
    const unsigned ldsw = (unsigned)wid * 1024u;
#define ATT_DMA(slot, kt, vt) do { \
        __builtin_amdgcn_global_load_lds((const unsigned*)((const unsigned char*)(kt) + koff), (LAS unsigned*)(lds + k_slot(slot) + ldsw), 16, 0, 0); \
        __builtin_amdgcn_global_load_lds((const unsigned*)((const unsigned char*)(vt) + voff), (LAS unsigned*)(lds + v_slot(slot) + ldsw), 16, 0, 0); } while (0)
#define ATT_TOP() do { asm volatile("s_waitcnt vmcnt(0)" ::: "memory"); __builtin_amdgcn_s_barrier(); asm volatile("" ::: "memory"); } while (0)
    const int xq = bid & 7, cq = bid >> 3;
    int cbh = xq * 8;
    const bool lag = (jj != 0);
#define ATT_KB(bh_) (Kg + ((size_t)((bh_) >> 3) * SEQ) * DM + ((bh_) & 7) * 128)
#define ATT_VB(bh_) (VTg + (size_t)(bh_) * 128 * 8192)
    ATT_DMA(0, ATT_KB(cbh), ATT_VB(cbh));
    { asm volatile("s_waitcnt vmcnt(0)" ::: "memory"); __builtin_amdgcn_s_barrier(); asm volatile("" ::: "memory"); ATT_DMA(1, ATT_KB(cbh) + (size_t)64 * DM, ATT_VB(cbh) + 64); }
    for (int ui = 0; ui < 16; ++ui) {
        const int qb = (ui & 1) * 32 + cq;
        const int nbh = (ui + 1 < 16) ? xq * 8 + ((ui + 1) >> 1) : cbh;
        const unsigned char* Kh = ATT_KB(cbh); const unsigned char* Vh = ATT_VB(cbh); const unsigned char* nK = ATT_KB(nbh); const unsigned char* nV = ATT_VB(nbh);
        const size_t obase = ((size_t)(cbh >> 3) * SEQ + qb * 128) * DM + (cbh & 7) * 128;
        f32x16 lacc = {}; f32x16 o[4] = {}; v8i qr;
        { const unsigned char* Qw = Qg + obase + (size_t)(wq * 32 + r32) * DM + jj * 64 + hi * 32;
          const u32x4 qa = *(const u32x4*)Qw, qb2 = *(const u32x4*)(Qw + 16);
          qr = __builtin_bit_cast(v8i, __builtin_shufflevector(qa, qb2, 0, 1, 2, 3, 4, 5, 6, 7)); }
        f32x16 pA0, pA1; v8i pa;
#define ATT_SRC(jt, KP, VP) const unsigned char* KP = ((jt) + 2 < NT) ? Kh + (size_t)((jt) + 2) * 64 * DM : nK + (size_t)((jt) + 2 - NT) * 64 * DM; \
                            const unsigned char* VP = ((jt) + 2 < NT) ? Vh + (size_t)((jt) + 2) * 64 : nV + (size_t)((jt) + 2 - NT) * 64
#define ATT_BAR(jt) do { ATT_TOP(); ATT_SRC(jt, kp_, vp_); ATT_DMA(((jt) + 2) & 3, kp_, vp_); } while (0)
        float pe[32];
        { qkt(pA0, pA1, lds + k_slot(0), qr, r32, hi, jj, cinit, s1, s8);
          if (lag) ATT_BAR(0);
          asm volatile("s_nop 15\n\ts_nop 7" ::: "memory");
#pragma unroll
          for (int r = 0; r < 16; ++r) { pe[r] = fexp2(pA0[r]); pe[16 + r] = fexp2(pA1[r]); }
          if (!lag) ATT_BAR(0); }
        for (int jt = 1; jt < NT; ++jt) {
            SBAR(); qkt(pA0, pA1, lds + k_slot(jt & 3), qr, r32, hi, jj, cinit, s1, s8);
            pack_p(pe, pa); SBAR();
            if (lag) ATT_BAR(jt);
            pv_exp(o, lacc, ones, lds + v_slot((jt - 1) & 3), pa, r32, hi, s1, pA0, pA1, pe);
            if (!lag) ATT_BAR(jt);
        }
        { pack_p(pe, pa); SBAR();
          pv_d0(o, lacc, ones, lds + v_slot((NT - 1) & 3), pa, r32, hi, s1);
          asm volatile("s_nop 15\n\ts_nop 15" ::: "memory"); }
#undef ATT_BAR
#undef ATT_SRC
        int r32e = r32, hie = hi; asm volatile("" : "+v"(r32e), "+v"(hie));
        float rli[16];
#pragma unroll
        for (int r = 0; r < 16; ++r) rli[r] = frcp(lacc[r]);
        LAS float* Cb = (LAS float*)(lds + 65536);
        if (jj == 1) {
#pragma unroll
            for (int r = 0; r < 16; ++r) { const float sc = rli[r] * lamv;
#pragma unroll
                for (int d0 = 0; d0 < 4; ++d0) Cb[(wq * 32 + crow(r, hie)) * 128 + d0 * 32 + r32e] = o[d0][r] * sc; }
        }
        asm volatile("s_waitcnt lgkmcnt(0)" ::: "memory"); __builtin_amdgcn_s_barrier(); asm volatile("" ::: "memory");
        if (jj == 0) {
            float g[4];
#pragma unroll
            for (int d0 = 0; d0 < 4; ++d0) g[d0] = subg[d0 * 32 + r32e] * omli;
            bf16_t* Ob = Og + obase;
#pragma unroll
            for (int r = 0; r < 16; ++r) {
                float ss = 0.f;
#pragma unroll
                for (int d0 = 0; d0 < 4; ++d0) { const float v = o[d0][r] * rli[r] - Cb[(wq * 32 + crow(r, hie)) * 128 + d0 * 32 + r32e]; o[d0][r] = v; ss += v * v; }
                ss += __shfl_xor(ss, 1); ss += __shfl_xor(ss, 2); ss += __shfl_xor(ss, 4); ss += __shfl_xor(ss, 8); ss += __shfl_xor(ss, 16);
                const float rs = 1.0f / sqrtf(ss * (1.0f / 128.0f) + EPS);
                bf16_t* op = Ob + (size_t)(wq * 32 + crow(r, hie)) * DM + r32e;
#pragma unroll
                for (int d0 = 0; d0 < 4; ++d0) op[d0 * 32] = (bf16_t)f2bf(o[d0][r] * rs * g[d0]);
            }
        }
        asm volatile("s_waitcnt lgkmcnt(0)" ::: "memory"); __builtin_amdgcn_s_barrier(); asm volatile("" ::: "memory");
        cbh = nbh;
    }
    asm volatile("s_waitcnt vmcnt(0) lgkmcnt(0)" ::: "memory"); __builtin_amdgcn_s_barrier(); asm volatile("" ::: "memory");
#undef ATT_DMA
#undef ATT_TOP
#undef ATT_KB
#undef ATT_VB
#undef ATT_LD8
}

namespace gla {
constexpr int BC = 0, QI = 32768, QA = 49152, KA = 65536, KST = 81920, VT = 98304, ST = 106496, AT = 122880, EM = 131072, EL = EM + 512, DD = EM + 1024, BMID = EM + 1536, SEG = EM + 2048;
static_assert(SEG + 2048 <= RING_BYTES, "gla lds");
__device__ __forceinline__ int sw256(int row, int cb) { return row * 256 + (cb ^ ((row & 15) << 4)); }
__device__ __forceinline__ int sw128(int row, int cb) { return row * 128 + (cb ^ ((((row & 7) ^ (row >> 4)) & 7) << 4)); }
__device__ __forceinline__ int crow(int r, int hi) { return (r & 3) + 8 * (r >> 2) + 4 * hi; }
__device__ __forceinline__ float h2f(unsigned short b) { return (float)__builtin_bit_cast(_Float16, b); }
__device__ __forceinline__ void gla_item(const bf16_t* __restrict__ Qp, const unsigned short* __restrict__ LFp, const bf16_t* __restrict__ Vp, bf16_t* __restrict__ Op, int dir, LAS unsigned char* lds, float* dbg) {
    int tid_ = threadIdx.x; asm volatile("" : "+v"(tid_));
    const int tid = tid_, wid = tid >> 6, lane = tid & 63, r = lane & 31, hh = lane >> 5;
    const int t1 = tid >> 3, kg = tid & 7, k0 = 16 * kg, v0 = (tid & 7) * 8;
    for (int i = tid; i < 16384 / 16; i += NTHR) *(LAS u32x4*)(lds + ST + i * 16) = (u32x4){0u, 0u, 0u, 0u};
    f32x16 st = {};
    u32x4 rq[2], rl[2], rv;
#define GLA_TOK(ci, i) (dir ? (SEQ - 1 - ((ci) * 64 + (i))) : ((ci) * 64 + (i)))
#define GLA_LOAD(ci) do { const size_t to = (size_t)GLA_TOK(ci, t1) * DM; \
        rq[0] = *(const u32x4*)(Qp + to + k0); rq[1] = *(const u32x4*)(Qp + to + k0 + 8); \
        rl[0] = *(const u32x4*)(LFp + to + k0); rl[1] = *(const u32x4*)(LFp + to + k0 + 8); rv = *(const u32x4*)(Vp + to + v0); } while (0)
    GLA_LOAD(0);
    __syncthreads();
    for (int ci = 0; ci < SEQ / 64; ++ci) {
        float qf[16], lf[16]; u32x4 vreg = rv;
#pragma unroll
        for (int j = 0; j < 2; ++j)
#pragma unroll
            for (int e = 0; e < 4; ++e) { qf[j * 8 + 2 * e] = bflo(rq[j][e]); qf[j * 8 + 2 * e + 1] = bfhi(rq[j][e]);
                lf[j * 8 + 2 * e] = h2f((unsigned short)(rl[j][e] & 0xffffu)); lf[j * 8 + 2 * e + 1] = h2f((unsigned short)(rl[j][e] >> 16)); }
        if (ci + 1 < SEQ / 64) GLA_LOAD(ci + 1);
#pragma unroll
        for (int j = 0; j < 4; ++j) *(LAS f32x4*)(lds + BC + (t1 * 128 + k0 + 4 * j) * 4) = (f32x4){lf[4 * j], lf[4 * j + 1], lf[4 * j + 2], lf[4 * j + 3]};
        __syncthreads();
        { const int kc = tid & 127, sg = tid >> 7; LAS float* bc = (LAS float*)(lds + BC) + kc; float cs[16];
#pragma unroll
            for (int i = 0; i < 16; ++i) cs[i] = bc[(sg * 16 + i) * 128];
#pragma unroll
            for (int i = 1; i < 16; ++i) cs[i] += cs[i - 1];
            ((LAS float*)(lds + SEG))[sg * 128 + kc] = cs[15];
            __syncthreads();
            const LAS float* sgp = (const LAS float*)(lds + SEG) + kc; const float s0 = sgp[0], s1 = sgp[128], s2 = sgp[256], s3 = sgp[384];
            const float off = sg == 0 ? 0.f : sg == 1 ? s0 : sg == 2 ? (s0 + s1) : ((s0 + s1) + s2);
#pragma unroll
            for (int i = 0; i < 16; ++i) bc[(sg * 16 + i) * 128] = cs[i] + off;
            if (sg == 0) { const float bm = s0 + s1, bl = ((s0 + s1) + s2) + s3;
                ((LAS float*)(lds + BMID))[kc] = bm; ((LAS float*)(lds + EM))[kc] = fexp(bm); ((LAS float*)(lds + EL))[kc] = fexp(bl - bm); ((LAS float*)(lds + DD))[kc] = fexp(bl); }
            __syncthreads();
        }
#ifdef DIAG
        if (dbg && ci == 0) { for (int i = tid; i < 8192; i += NTHR) dbg[i] = ((const LAS float*)(lds + BC))[i]; }
#endif
        {
            unsigned wqi[8], wqa[8], wka[8]; float ksv[16];
#pragma unroll
            for (int j = 0; j < 4; ++j) {
                const f32x4 bt = *(const LAS f32x4*)(lds + BC + (t1 * 128 + k0 + 4 * j) * 4), bm = *(const LAS f32x4*)(lds + BMID + (k0 + 4 * j) * 4);
                const f32x4 em = *(const LAS f32x4*)(lds + EM + (k0 + 4 * j) * 4), el = *(const LAS f32x4*)(lds + EL + (k0 + 4 * j) * 4);
                float qi[4], qa[4], ka[4];
#pragma unroll
                for (int e = 0; e < 4; ++e) { const int i = 4 * j + e; const float e1 = fexp(bt[e] - bm[e]), r1 = frcp(e1);
                    qa[e] = qf[i] * e1; qi[e] = qa[e] * em[e]; const float kk = 1.0f - fexp(lf[i]); ka[e] = kk * r1; ksv[i] = ka[e] * el[e]; }
                wqi[2 * j] = cvt_pk_bf16(qi[0], qi[1]); wqi[2 * j + 1] = cvt_pk_bf16(qi[2], qi[3]);
                wqa[2 * j] = cvt_pk_bf16(qa[0], qa[1]); wqa[2 * j + 1] = cvt_pk_bf16(qa[2], qa[3]);
                wka[2 * j] = cvt_pk_bf16(ka[0], ka[1]); wka[2 * j + 1] = cvt_pk_bf16(ka[2], ka[3]);
            }
#pragma unroll
            for (int j = 0; j < 2; ++j) { const int off = sw256(t1, (k0 + 8 * j) * 2);
                *(LAS u32x4*)(lds + QI + off) = (u32x4){wqi[4 * j], wqi[4 * j + 1], wqi[4 * j + 2], wqi[4 * j + 3]};
                *(LAS u32x4*)(lds + QA + off) = (u32x4){wqa[4 * j], wqa[4 * j + 1], wqa[4 * j + 2], wqa[4 * j + 3]};
                *(LAS u32x4*)(lds + KA + off) = (u32x4){wka[4 * j], wka[4 * j + 1], wka[4 * j + 2], wka[4 * j + 3]}; }
#pragma unroll
            for (int i = 0; i < 16; ++i) *(LAS unsigned short*)(lds + KST + sw128(k0 + i, t1 * 2)) = (unsigned short)f2bf(ksv[i]);
#pragma unroll
            for (int e = 0; e < 4; ++e) { *(LAS unsigned short*)(lds + VT + sw128(v0 + 2 * e, t1 * 2)) = (unsigned short)(vreg[e] & 0xffffu);
                *(LAS unsigned short*)(lds + VT + sw128(v0 + 2 * e + 1, t1 * 2)) = (unsigned short)(vreg[e] >> 16); }
        }
        __syncthreads();
        f32x16 oacc = {};
        const int w4 = wid & 3, t_i = w4 >> 1, v_i = w4 & 1;
        if (wid < 4) {
            const int s_i = wid >> 1, tq = wid & 1; f32x16 a = {};
#pragma unroll
            for (int ks = 0; ks < 8; ++ks) { const bf16x8 fa = *(const LAS bf16x8*)(lds + KA + sw256(32 * s_i + r, (16 * ks + 8 * hh) * 2)), fb = *(const LAS bf16x8*)(lds + QA + sw256(32 * tq + r, (16 * ks + 8 * hh) * 2));
                a = __builtin_amdgcn_mfma_f32_32x32x16_bf16(fa, fb, a, 0, 0, 0); }
            const int tg = 32 * tq + r;
#pragma unroll
            for (int g = 0; g < 4; ++g) { float m[4];
#pragma unroll
                for (int e = 0; e < 4; ++e) { const int sgl = 32 * s_i + 8 * g + 4 * hh + e; m[e] = (sgl <= tg) ? a[4 * g + e] : 0.f; }
                *(LAS u32x2*)(lds + AT + sw128(tg, (32 * s_i + 8 * g + 4 * hh) * 2)) = (u32x2){cvt_pk_bf16(m[0], m[1]), cvt_pk_bf16(m[2], m[3])}; }
        } else {
#pragma unroll
            for (int ks = 0; ks < 8; ++ks) { const bf16x8 fa = *(const LAS bf16x8*)(lds + QI + sw256(32 * t_i + r, (16 * ks + 8 * hh) * 2)), fb = *(const LAS bf16x8*)(lds + ST + sw256(32 * v_i + r, (16 * ks + 8 * hh) * 2));
                oacc = __builtin_amdgcn_mfma_f32_32x32x16_bf16(fa, fb, oacc, 0, 0, 0); }
        }
        __syncthreads();
#ifdef DIAG
        if (dbg && ci == 0) { for (int i = tid; i < 2048; i += NTHR) { ((unsigned*)dbg)[8192 + i] = ((const LAS unsigned*)(lds + AT))[i]; ((unsigned*)dbg)[8192 + 2048 + i] = ((const LAS unsigned*)(lds + VT))[i]; } }
#endif
        if (wid >= 4) {
#pragma unroll
            for (int ks = 0; ks < 4; ++ks) { const bf16x8 fa = *(const LAS bf16x8*)(lds + AT + sw128(32 * t_i + r, (16 * ks + 8 * hh) * 2)), fb = *(const LAS bf16x8*)(lds + VT + sw128(32 * v_i + r, (16 * ks + 8 * hh) * 2));
                oacc = __builtin_amdgcn_mfma_f32_32x32x16_bf16(fa, fb, oacc, 0, 0, 0); }
#pragma unroll
            for (int i = 0; i < 16; ++i) { const int t = 32 * t_i + crow(i, hh); Op[(size_t)GLA_TOK(ci, t) * DM + 32 * v_i + r] = (bf16_t)f2bf(oacc[i]); }
        }
        {
            const int kq = wid >> 1, vq = wid & 1;
#pragma unroll
            for (int i = 0; i < 16; ++i) st[i] *= ((const LAS float*)(lds + DD))[32 * kq + crow(i, hh)];
#pragma unroll
            for (int ks = 0; ks < 4; ++ks) { const bf16x8 fa = *(const LAS bf16x8*)(lds + KST + sw128(32 * kq + r, (16 * ks + 8 * hh) * 2)), fb = *(const LAS bf16x8*)(lds + VT + sw128(32 * vq + r, (16 * ks + 8 * hh) * 2));
                st = __builtin_amdgcn_mfma_f32_32x32x16_bf16(fa, fb, st, 0, 0, 0); }
#pragma unroll
            for (int g = 0; g < 4; ++g) *(LAS u32x2*)(lds + ST + sw256(32 * vq + r, (32 * kq + 8 * g + 4 * hh) * 2)) = (u32x2){cvt_pk_bf16(st[4 * g], st[4 * g + 1]), cvt_pk_bf16(st[4 * g + 2], st[4 * g + 3])};
        }
        __syncthreads();
#ifdef DIAG
        if (dbg && ci == 0) { for (int i = tid; i < 4096; i += NTHR) { ((unsigned*)dbg)[12288 + i] = ((const LAS unsigned*)(lds + ST))[i]; ((unsigned*)dbg)[16384 + i] = ((const LAS unsigned*)(lds + KST))[i]; } }
#endif
    }
#undef GLA_TOK
#undef GLA_LOAD
}
}
__device__ __forceinline__ void gla_phase(const Args& A, LAS unsigned char* lds, int bid, int G) {
    unsigned char* ws = A.ws;
    for (int it = bid; it < 256; it += G) {
        const int b = it >> 5, h = (it >> 2) & 7, dir = (it >> 1) & 1, vh = it & 1;
        const size_t base = (size_t)b * SEQ * DM + h * 128;
        gla::gla_item((const bf16_t*)(ws + H_Q) + base, (const unsigned short*)(ws + (dir ? H_LFB : H_LFF)) + base, (const bf16_t*)(ws + H_V) + base + vh * 64,
                      (bf16_t*)(ws + (dir ? H_OB : H_OF)) + base + vh * 64, dir, lds, it == 0 ? (float*)(ws + TB_LSUM) : nullptr);
    }
}
__device__ __forceinline__ void hg_normo_phase(const Args& A, int bid, int G) {
    int tid_ = threadIdx.x; asm volatile("" : "+v"(tid_));
    const int tid = tid_, lane = tid & 63, wave = tid >> 6; unsigned char* ws = A.ws;
    const bf16_t* OF = (const bf16_t*)(ws + H_OF); const bf16_t* OB = (const bf16_t*)(ws + H_OB); const bf16_t* GG = (const bf16_t*)(ws + H_G); bf16_t* HM = (bf16_t*)(ws + WS_HM);
    const int c0 = (lane >> 3) * 128 + (lane & 7) * 16;
    float ng[16];
#pragma unroll
    for (int i = 0; i < 16; ++i) ng[i] = A.in[I_HGNG][(lane & 7) * 16 + i];
    for (int row = (bid * NWAVES + wave); row < MTOK; row += G * NWAVES) {
        const size_t o = (size_t)row * DM + c0;
        const u32x4 a0 = *(const u32x4*)(OF + o), a1 = *(const u32x4*)(OF + o + 8), b0 = *(const u32x4*)(OB + o), b1 = *(const u32x4*)(OB + o + 8), g0 = *(const u32x4*)(GG + o), g1 = *(const u32x4*)(GG + o + 8);
        float v[16], gt[16]; float ss = 0.f;
#pragma unroll
        for (int e = 0; e < 4; ++e) { v[2 * e] = bflo(a0[e]) + bflo(b0[e]); v[2 * e + 1] = bfhi(a0[e]) + bfhi(b0[e]); v[8 + 2 * e] = bflo(a1[e]) + bflo(b1[e]); v[8 + 2 * e + 1] = bfhi(a1[e]) + bfhi(b1[e]);
            gt[2 * e] = bflo(g0[e]); gt[2 * e + 1] = bfhi(g0[e]); gt[8 + 2 * e] = bflo(g1[e]); gt[8 + 2 * e + 1] = bfhi(g1[e]); }
#pragma unroll
        for (int i = 0; i < 16; ++i) ss += v[i] * v[i];
        ss += __shfl_xor(ss, 1); ss += __shfl_xor(ss, 2); ss += __shfl_xor(ss, 4);
        const float rstd = 1.0f / sqrtf(ss * (1.0f / 128.0f) + EPS);
        u32x4 w0, w1;
#pragma unroll
        for (int e = 0; e < 4; ++e) { w0[e] = cvt_pk_bf16(v[2 * e] * rstd * ng[2 * e] * gt[2 * e], v[2 * e + 1] * rstd * ng[2 * e + 1] * gt[2 * e + 1]);
            w1[e] = cvt_pk_bf16(v[8 + 2 * e] * rstd * ng[8 + 2 * e] * gt[8 + 2 * e], v[8 + 2 * e + 1] * rstd * ng[8 + 2 * e + 1] * gt[8 + 2 * e + 1]); }
        *(u32x4*)(HM + o) = w0; *(u32x4*)(HM + o + 8) = w1;
    }
}

#ifdef DIAG
constexpr int DG_BASE = 8192;
__device__ __forceinline__ void dg_put(const Args& A, int k, float e) { if (!(e >= 0.f) || e > 1e9f) e = 1e9f; atomicMax((unsigned*)(A.ws + WS_CTL) + DG_BASE + 64 * k, __float_as_uint(e)); }
__device__ __forceinline__ float dg_rel(float got, float ref) { return fabsf(got - ref) / (fabsf(ref) + 0.1f); }
__device__ __forceinline__ unsigned dg_hash(unsigned a, unsigned b) { unsigned h = a * 2654435761u + b * 40503u + 0x9e3779b9u; h ^= h >> 15; h *= 2246822519u; h ^= h >> 13; h *= 3266489917u; h ^= h >> 16; return h; }
__device__ __forceinline__ float dg_bfr(float x) { return bflo(f2bf(x)); }
__device__ __forceinline__ void dg_mods(const Args& A, int k) {
    const int lane = threadIdx.x & 63, gwv = blockIdx.x * 8 + (threadIdx.x >> 6);
    const unsigned h = dg_hash(gwv, k); const int l = h & 3, b = (h >> 2) & 7, e = (h >> 5) % 6144;
    float a = 0.f; for (int d = lane; d < DM; d += 64) a += fsilu(A.in[I_C][b * DM + d]) * A.in[I_ADAW][((size_t)l * DM + d) * 6144 + e];
    a = wave_sum(a) + A.in[I_ADAB][l * 6144 + e];
    const float got = ((const float*)(A.ws + TB_MODS))[((size_t)l * NBATCH + b) * 6144 + e];
    if (lane == 0) dg_put(A, k, dg_rel(got, a));
}
__device__ __forceinline__ void dg_norm(const Args& A, int k, const float* x, const float* gain, int L, int which) {
    const int lane = threadIdx.x & 63, gwv = blockIdx.x * 8 + (threadIdx.x >> 6);
    const int row = dg_hash(gwv, k) & (MTOK - 1), b = row >> 13;
    const float* modl = (const float*)(A.ws + TB_MODS) + ((size_t)L * NBATCH + b) * 6144;
    float ss = 0.f; for (int c = lane; c < DM; c += 64) { const float v = x[(size_t)row * DM + c]; ss += v * v; }
    ss = wave_sum(ss); const float rstd = 1.0f / sqrtf(ss / DM + EPS); float e = 0.f;
    for (int c = lane; c < DM; c += 64) { const float ref = x[(size_t)row * DM + c] * rstd * gain[c] * (1.0f + modl[(which * 3 + 1) * 1024 + c]) + modl[(which * 3) * 1024 + c];
        e = fmaxf(e, dg_rel(bf2f(((const bf16_t*)(A.ws + WS_HM))[(size_t)row * DM + c]), ref)); }
    dg_put(A, k, e);
}
__device__ __forceinline__ void dg_qkv(const Args& A, int k, int al) {
    const int lane = threadIdx.x & 63, gwv = blockIdx.x * 8 + (threadIdx.x >> 6);
    const unsigned h = dg_hash(gwv, k); const int row = h & (MTOK - 1), t = (h >> 16) % 48, col = t * 64 + lane;
    const bf16_t* hm = (const bf16_t*)(A.ws + WS_HM) + (size_t)row * DM; const float* w = A.in[I_ATWIN] + (size_t)al * 1024 * 3072 + col;
    float a = 0.f; for (int kk = 0; kk < DM; ++kk) a += bf2f(hm[kk]) * dg_bfr(w[(size_t)kk * 3072]);
    float ref, got;
    if (t < 32) {
        const int part = t >> 4, sh = t & 15; const float ss = wave_sum(a * a); const float rstd = 1.0f / sqrtf(ss / 64.0f + EPS);
        const float y = a * rstd * (part ? A.in[I_ATKN] : A.in[I_ATQN])[al * 64 + lane]; const float yp = __shfl_xor(y, 32);
        const int pos = row & (SEQ - 1); const float cs = ((const float*)(A.ws + TB_COS))[pos * 32 + (lane & 31)], sn = ((const float*)(A.ws + TB_SIN))[pos * 32 + (lane & 31)];
        ref = (lane < 32) ? (y * cs - yp * sn) : (y * cs + yp * sn); if (part == 0) ref *= 0.125f * LOG2E;
        got = bf2f(((const bf16_t*)(A.ws + (part ? A_K : A_Q)))[(size_t)row * DM + sh * 64 + lane]);
    } else { ref = a; got = bf2f(((const bf16_t*)(A.ws + A_V))[(size_t)row * DM + (t - 32) * 64 + lane]); }
    dg_put(A, k, dg_rel(got, ref));
}
__device__ __forceinline__ void dg_attn(const Args& A, int k, int al, LAS unsigned char* lds) {
    const int tid = threadIdx.x; const unsigned h = dg_hash(blockIdx.x, k); const int row = h & (MTOK - 1), hd = (h >> 16) & 7, b = row >> 13;
    const bf16_t* Q = (const bf16_t*)(A.ws + A_Q); const bf16_t* K = (const bf16_t*)(A.ws + A_K); const bf16_t* V = (const bf16_t*)(A.ws + A_V);
    const float* scal = (const float*)(A.ws + TB_SCAL); const float lamv = scal[SC_LAM0 + al], omli = scal[SC_OML0 + al], Mc = scal[SC_MC0 + al];
    LAS float* p0 = (LAS float*)lds; LAS float* p1 = p0 + SEQ; LAS float* red = p1 + SEQ;
    float l0 = 0.f, l1 = 0.f;
    for (int key = tid; key < SEQ; key += NTHR) { const bf16_t* kr = K + ((size_t)b * SEQ + key) * DM + hd * 128; const bf16_t* qr = Q + (size_t)row * DM + hd * 128;
        float s0 = 0.f, s1 = 0.f; for (int d = 0; d < 64; ++d) { s0 += bf2f(qr[d]) * bf2f(kr[d]); s1 += bf2f(qr[64 + d]) * bf2f(kr[64 + d]); }
        const float e0 = fexp2(s0 - Mc), e1 = fexp2(s1 - Mc); p0[key] = e0; p1[key] = e1; l0 += e0; l1 += e1; }
    l0 = wave_sum(l0); l1 = wave_sum(l1); if ((tid & 63) == 0) { red[tid >> 6] = l0; red[8 + (tid >> 6)] = l1; }
    __syncthreads();
    l0 = 0.f; l1 = 0.f; for (int w = 0; w < 8; ++w) { l0 += red[w]; l1 += red[8 + w]; }
    __syncthreads();
    const int dv = tid & 127, part = tid >> 7; float o = 0.f;
    for (int key = part * 2048; key < part * 2048 + 2048; ++key) o += (p0[key] / l0 - lamv * p1[key] / l1) * bf2f(V[((size_t)b * SEQ + key) * DM + hd * 128 + dv]);
    red[16 + part * 128 + dv] = o; __syncthreads();
    if (tid < 128) { o = red[16 + tid] + red[16 + 128 + tid] + red[16 + 256 + tid] + red[16 + 384 + tid]; red[600 + tid] = o * o; }
    __syncthreads();
    if (tid < 128) { float ss = 0.f; for (int i = 0; i < 128; ++i) ss += red[600 + i]; const float ref = o / sqrtf(ss / 128.0f + EPS) * A.in[I_ATSUB][al * 128 + tid] * omli;
        dg_put(A, k, dg_rel(bf2f(((const bf16_t*)(A.ws + WS_HM))[(size_t)row * DM + hd * 128 + tid]), ref)); }
    __syncthreads();
}
__device__ __forceinline__ void dg_save(const Args& A, int k, const float* xold) {
    const int lane = threadIdx.x & 63, gwv = blockIdx.x * 8 + (threadIdx.x >> 6);
    const unsigned h = dg_hash(gwv, k); const int row = h & (MTOK - 1), col = (h >> 16) & 1023;
    float* sv = (float*)(A.ws + TB_LSUM) + 7 * 1024 * 1024 / 4;
    if (lane == 0) sv[k * 4096 + gwv] = xold[(size_t)row * DM + col];
}
__device__ __forceinline__ void dg_res(const Args& A, int k, const float* xnew, const float* gate, const bf16_t* Am, int K, const float* W) {
    const int lane = threadIdx.x & 63, gwv = blockIdx.x * 8 + (threadIdx.x >> 6);
    const unsigned h = dg_hash(gwv, k); const int row = h & (MTOK - 1), col = (h >> 16) & 1023, b = row >> 13;
    const float* sv = (const float*)(A.ws + TB_LSUM) + 7 * 1024 * 1024 / 4;
    float a = 0.f; for (int kk = lane; kk < K; kk += 64) a += bf2f(Am[(size_t)row * K + kk]) * dg_bfr(W[(size_t)kk * DM + col]);
    a = wave_sum(a);
    const float ref = sv[k * 4096 + gwv] + gate[(size_t)b * 6144 + col] * a;
    if (lane == 0) dg_put(A, k, dg_rel(xnew[(size_t)row * DM + col], ref));
}
__device__ __forceinline__ void dg_swiglu(const Args& A, int k, const bf16_t* Am, const float* W, int F, const bf16_t* H, int nrows, const int* rowmap) {
    const int lane = threadIdx.x & 63, gwv = blockIdx.x * 8 + (threadIdx.x >> 6);
    const unsigned h = dg_hash(gwv, k); const int row = (h & 0xfffff) % nrows, j = (h >> 20) % F;
    float g = 0.f, u = 0.f; for (int kk = lane; kk < DM; kk += 64) { const float x = bf2f(Am[(size_t)row * DM + kk]); g += x * dg_bfr(W[(size_t)kk * 2 * F + j]); u += x * dg_bfr(W[(size_t)kk * 2 * F + F + j]); }
    g = wave_sum(g); u = wave_sum(u);
    const float ref = g / (1.0f + expf(-g)) * u;
    if (lane == 0) dg_put(A, k, dg_rel(bf2f(H[(size_t)row * F + j]), ref));
}
__device__ __forceinline__ void dg_hgin(const Args& A, int k) {
    const int lane = threadIdx.x & 63, gwv = blockIdx.x * 8 + (threadIdx.x >> 6);
    const unsigned h = dg_hash(gwv, k); const int row = h & (MTOK - 1), col = (h >> 16) % 5120, grp = col >> 10, cc = col & 1023;
    float a = 0.f; for (int kk = lane; kk < DM; kk += 64) a += bf2f(((const bf16_t*)(A.ws + WS_HM))[(size_t)row * DM + kk]) * dg_bfr(A.in[I_HGWIN][(size_t)kk * 5120 + col]);
    a = wave_sum(a);
    float ref, got;
    if (grp == 0 || grp == 4) { ref = a / (1.0f + expf(-a)); got = bf2f(((const bf16_t*)(A.ws + (grp == 0 ? H_Q : H_G)))[(size_t)row * DM + cc]); }
    else if (grp == 3) { ref = a; got = bf2f(((const bf16_t*)(A.ws + H_V))[(size_t)row * DM + cc]); }
    else { const int d = grp - 1; const float* p = A.in[I_HGLB] + (size_t)d * DEPTH * 1024 + cc; float mx = p[0]; for (int l = 1; l < DEPTH; ++l) mx = fmaxf(mx, p[l * 1024]);
        float den = 0.f; for (int l = 0; l < DEPTH; ++l) den += expf(p[l * 1024] - mx); const float lbv = expf(p[1024] - mx) / den;
        ref = logf(lbv + (1.0f - lbv) / (1.0f + expf(-a))); got = gla::h2f(((const unsigned short*)(A.ws + (d ? H_LFB : H_LFF)))[(size_t)row * DM + cc]); }
    if (lane == 0) dg_put(A, k, dg_rel(got, ref));
}
__device__ __forceinline__ void dg_gla(const Args& A, int k) {
    const int lane = threadIdx.x & 63, gwv = blockIdx.x * 8 + (threadIdx.x >> 6);
    const unsigned h = dg_hash(gwv, k); const int sel0 = (gwv & 3) == 0; const int b = sel0 ? 0 : (h & 7), hd = sel0 ? 0 : ((h >> 3) & 7), dir = sel0 ? 0 : ((h >> 6) & 1), vc = sel0 ? ((h >> 7) & 63) : ((h >> 7) & 127);
    const bf16_t* Q = (const bf16_t*)(A.ws + H_Q); const unsigned short* LF = (const unsigned short*)(A.ws + (dir ? H_LFB : H_LFF)); const bf16_t* V = (const bf16_t*)(A.ws + H_V);
    const bf16_t* O = (const bf16_t*)(A.ws + (dir ? H_OB : H_OF));
    float s0 = 0.f, s1 = 0.f, e0 = 0.f, e1 = 0.f, e2 = 0.f, e3 = 0.f;
    for (int i = 0; i < SEQ; ++i) { const int tok = dir ? (SEQ - 1 - i) : i; const size_t o = ((size_t)b * SEQ + tok) * DM + hd * 128;
        const float f0 = expf(gla::h2f(LF[o + lane])), f1 = expf(gla::h2f(LF[o + 64 + lane])), v = bf2f(V[o + vc]);
        s0 = f0 * s0 + (1.0f - f0) * v; s1 = f1 * s1 + (1.0f - f1) * v;
        if (i < 128 || i % 61 == 0) { const float ov = wave_sum(bf2f(Q[o + lane]) * s0 + bf2f(Q[o + 64 + lane]) * s1); const float er = 0.25f * fabsf(bf2f(O[o + vc]) - ov) / (fabsf(ov) + 1.0f);
            if (i == 0) e0 = er; else if (i < 64) e1 = fmaxf(e1, er); else if (i < 128) e2 = fmaxf(e2, er); else e3 = fmaxf(e3, er); } }
    if (lane == 0) { dg_put(A, k, e0); dg_put(A, k + 4, e1); dg_put(A, k + 5, e2); dg_put(A, k + 6, e3); }
    const float* dbg = (const float*)(A.ws + TB_LSUM); const unsigned short* LF0 = (const unsigned short*)(A.ws + H_LFF); const bf16_t* Q0 = (const bf16_t*)(A.ws + H_Q);
    { const unsigned h2 = dg_hash(gwv, k + 100); const int t = h2 & 63, kk = (h2 >> 6) & 127; float c = 0.f; for (int tt = 0; tt <= t; ++tt) c += gla::h2f(LF0[(size_t)tt * DM + kk]);
      if (lane == 0) dg_put(A, k + 1, dg_rel(dbg[t * 128 + kk], c)); }
    { const unsigned h2 = dg_hash(gwv, k + 200); const int t = h2 & 63, sidx = (h2 >> 6) & 63; float a = 0.f;
      if (sidx <= t) { for (int kk = lane; kk < 128; kk += 64) { float c = 0.f; for (int tt = sidx + 1; tt <= t; ++tt) c += gla::h2f(LF0[(size_t)tt * DM + kk]);
              a += bf2f(Q0[(size_t)t * DM + kk]) * (1.0f - expf(gla::h2f(LF0[(size_t)sidx * DM + kk]))) * expf(c); } a = wave_sum(a); }
      const unsigned short got = ((const unsigned short*)(dbg + 8192))[gla::sw128(t, sidx * 2) / 2];
      if (lane == 0) dg_put(A, k + 2, 5.0f * fabsf(bf2f(got) - a) / (fabsf(a) + 0.01f)); }
    { const unsigned h2 = dg_hash(gwv, k + 300); const int sidx = h2 & 63, v = (h2 >> 6) & 63;
      const unsigned short got = ((const unsigned short*)(dbg + 8192 + 2048))[gla::sw128(v, sidx * 2) / 2];
      if (lane == 0) dg_put(A, k + 2, dg_rel(bf2f(got), bf2f(((const bf16_t*)(A.ws + H_V))[(size_t)sidx * DM + v]))); }
    { const unsigned h2 = dg_hash(gwv, k + 500); const int kk = h2 & 127, v = (h2 >> 7) & 63;
      float a = 0.f; { const int sidx = lane; float c = 0.f; for (int tt = sidx + 1; tt < 64; ++tt) c += gla::h2f(LF0[(size_t)tt * DM + kk]);
          const float ksn = (1.0f - expf(gla::h2f(LF0[(size_t)sidx * DM + kk]))) * expf(c);
          const unsigned short gk = ((const unsigned short*)(dbg + 16384))[gla::sw128(kk, sidx * 2) / 2];
          dg_put(A, k + 2, 0.5f * fabsf(bf2f(gk) - ksn) / (fabsf(ksn) + 0.01f));
          a = ksn * bf2f(((const bf16_t*)(A.ws + H_V))[(size_t)sidx * DM + v]); }
      a = wave_sum(a);
      const unsigned short gs = ((const unsigned short*)(dbg + 12288))[gla::sw256(v, kk * 2) / 2];
      if (lane == 0) dg_put(A, k + 3, 0.5f * fabsf(bf2f(gs) - a) / (fabsf(a) + 0.05f)); }
    { const unsigned h2 = dg_hash(gwv, k + 400); const int t = h2 & 63, v = (h2 >> 6) & 63;
      const unsigned short* at = (const unsigned short*)(dbg + 8192); const unsigned short* vt = (const unsigned short*)(dbg + 8192 + 2048);
      float a = bf2f(at[gla::sw128(t, lane * 2) / 2]) * bf2f(vt[gla::sw128(v, lane * 2) / 2]); a = wave_sum(a);
      if (lane == 0) dg_put(A, k + 1, 5.0f * dg_rel(bf2f(((const bf16_t*)(A.ws + H_OF))[(size_t)t * DM + v]), a)); }
}
__device__ __forceinline__ void dg_normo(const Args& A, int k) {
    const int lane = threadIdx.x & 63, gwv = blockIdx.x * 8 + (threadIdx.x >> 6);
    const unsigned h = dg_hash(gwv, k); const int row = h & (MTOK - 1), hd = (h >> 16) & 7; const size_t o = (size_t)row * DM + hd * 128;
    const float v0 = bf2f(((const bf16_t*)(A.ws + H_OF))[o + lane]) + bf2f(((const bf16_t*)(A.ws + H_OB))[o + lane]), v1 = bf2f(((const bf16_t*)(A.ws + H_OF))[o + 64 + lane]) + bf2f(((const bf16_t*)(A.ws + H_OB))[o + 64 + lane]);
    const float ss = wave_sum(v0 * v0 + v1 * v1), rstd = 1.0f / sqrtf(ss / 128.0f + EPS);
    const float r0 = v0 * rstd * A.in[I_HGNG][lane] * bf2f(((const bf16_t*)(A.ws + H_G))[o + lane]), r1 = v1 * rstd * A.in[I_HGNG][64 + lane] * bf2f(((const bf16_t*)(A.ws + H_G))[o + 64 + lane]);
    dg_put(A, k, fmaxf(dg_rel(bf2f(((const bf16_t*)(A.ws + WS_HM))[o + lane]), r0), dg_rel(bf2f(((const bf16_t*)(A.ws + WS_HM))[o + 64 + lane]), r1)));
}
__device__ __forceinline__ void dg_router(const Args& A, int k, int L) {
    const int lane = threadIdx.x & 63, gwv = blockIdx.x * 8 + (threadIdx.x >> 6);
    const int row = dg_hash(gwv, k) & (MTOK - 1), b = row >> 13; const float* x = A.out + (size_t)row * DM;
    const float* modl = (const float*)(A.ws + TB_MODS) + ((size_t)L * NBATCH + b) * 6144; const float* gain = A.in[I_N2G] + L * DM; const float* R = A.in[I_MOER] + (size_t)(L >> 1) * DM * 8;
    float ss = 0.f; for (int c = lane; c < DM; c += 64) ss += x[c] * x[c];
    ss = wave_sum(ss); const float rstd = 1.0f / sqrtf(ss / DM + EPS);
    float lg[8]; for (int e = 0; e < 8; ++e) lg[e] = 0.f;
    for (int c = lane; c < DM; c += 64) { const float hv = x[c] * rstd * gain[c] * (1.0f + modl[4 * 1024 + c]) + modl[3 * 1024 + c]; for (int e = 0; e < 8; ++e) lg[e] += hv * R[c * 8 + e]; }
    for (int e = 0; e < 8; ++e) lg[e] = wave_sum(lg[e]);
    int e0 = 0; for (int e = 1; e < 8; ++e) if (lg[e] > lg[e0]) e0 = e;
    int e1 = (e0 == 0) ? 1 : 0; for (int e = 0; e < 8; ++e) if (e != e0 && lg[e] > lg[e1]) e1 = e;
    float gap = 1e9f; for (int e = 0; e < 8; ++e) if (e != e0 && e != e1) gap = fminf(gap, lg[e1] - lg[e]); gap = fminf(gap, lg[e0] - lg[e1]);
    const int g0 = ((const int*)(A.ws + TB_EID))[row * 2], g1 = ((const int*)(A.ws + TB_EID))[row * 2 + 1]; const float w0 = ((const float*)(A.ws + TB_GATE))[row * 2], w1 = ((const float*)(A.ws + TB_GATE))[row * 2 + 1];
    const float p0 = 1.0f / (1.0f + expf(lg[e1] - lg[e0]));
    float er = (g0 != e0 || g1 != e1) ? (gap > 2e-3f ? 9.f : 0.f) : fmaxf(fabsf(w0 - p0), fabsf(w1 - (1.0f - p0)));
    if (lane == 0) dg_put(A, k, er);
}
__device__ __forceinline__ void dg_place(const Args& A, int k) {
    const int lane = threadIdx.x & 63, gwv = blockIdx.x * 8 + (threadIdx.x >> 6);
    const unsigned h = dg_hash(gwv, k); const int row = h & (MTOK - 1), kk = (h >> 16) & 1;
    const int sl = ((const int*)(A.ws + TB_SLOT))[row * 2 + kk], e = ((const int*)(A.ws + TB_EID))[row * 2 + kk]; const int* ts = (const int*)(A.ws + TB_TILES);
    float er = (sl >= ts[e] * 256 && sl < ts[e + 1] * 256 && sl < MOE_ROWS) ? 0.f : 7.f;
    if (er == 0.f) for (int c = lane; c < DM; c += 64) if (((const bf16_t*)(A.ws + E_XS))[(size_t)sl * DM + c] != ((const bf16_t*)(A.ws + WS_HM))[(size_t)row * DM + c]) er = 5.f;
    dg_put(A, k, er);
}
__device__ __forceinline__ void dg_moe_hid(const Args& A, int k, int m) {
    const int lane = threadIdx.x & 63, gwv = blockIdx.x * 8 + (threadIdx.x >> 6);
    const unsigned h = dg_hash(gwv, k); const int row = h & (MTOK - 1), kk = (h >> 16) & 1, j = (h >> 17) % DFFE;
    const int sl = ((const int*)(A.ws + TB_SLOT))[row * 2 + kk], e = ((const int*)(A.ws + TB_EID))[row * 2 + kk];
    const float* W = A.in[I_MOEGU] + ((size_t)m * 8 + e) * DM * 2 * DFFE; const bf16_t* Am = (const bf16_t*)(A.ws + E_XS) + (size_t)sl * DM;
    float g = 0.f, u = 0.f; for (int c = lane; c < DM; c += 64) { const float x = bf2f(Am[c]); g += x * dg_bfr(W[(size_t)c * 2 * DFFE + j]); u += x * dg_bfr(W[(size_t)c * 2 * DFFE + DFFE + j]); }
    g = wave_sum(g); u = wave_sum(u);
    if (lane == 0) dg_put(A, k, dg_rel(bf2f(((const bf16_t*)(A.ws + E_HID))[(size_t)sl * DFFE + j]), g / (1.0f + expf(-g)) * u));
}
__device__ __forceinline__ void dg_moe_y(const Args& A, int k, int m) {
    const int lane = threadIdx.x & 63, gwv = blockIdx.x * 8 + (threadIdx.x >> 6);
    const unsigned h = dg_hash(gwv, k); const int row = h & (MTOK - 1), kk = (h >> 16) & 1, col = (h >> 17) & 1023;
    const int sl = ((const int*)(A.ws + TB_SLOT))[row * 2 + kk], e = ((const int*)(A.ws + TB_EID))[row * 2 + kk];
    const float* W = A.in[I_MOEDN] + ((size_t)m * 8 + e) * DFFE * DM; const bf16_t* Hh = (const bf16_t*)(A.ws + E_HID) + (size_t)sl * DFFE;
    float a = 0.f; for (int j = lane; j < DFFE; j += 64) a += bf2f(Hh[j]) * dg_bfr(W[(size_t)j * DM + col]);
    a = wave_sum(a);
    if (lane == 0) dg_put(A, k, fabsf(bf2f(((const bf16_t*)(A.ws + E_XS))[(size_t)sl * DM + col]) - a) / (fabsf(a) + 0.3f));
}
__device__ __forceinline__ void dg_combine(const Args& A, int k, const float* modprev) {
    const int lane = threadIdx.x & 63, gwv = blockIdx.x * 8 + (threadIdx.x >> 6);
    const unsigned h = dg_hash(gwv, k); const int row = h & (MTOK - 1), col = (h >> 16) & 1023, b = row >> 13;
    const float* sv = (const float*)(A.ws + TB_LSUM) + 7 * 1024 * 1024 / 4; const bf16_t* Y = (const bf16_t*)(A.ws + E_XS);
    const int s0 = ((const int*)(A.ws + TB_SLOT))[row * 2], s1 = ((const int*)(A.ws + TB_SLOT))[row * 2 + 1]; const float w0 = ((const float*)(A.ws + TB_GATE))[row * 2], w1 = ((const float*)(A.ws + TB_GATE))[row * 2 + 1];
    const float ref = sv[k * 4096 + gwv] + modprev[(size_t)b * 6144 + 5 * 1024 + col] * (w0 * bf2f(Y[(size_t)s0 * DM + col]) + w1 * bf2f(Y[(size_t)s1 * DM + col]));
    if (lane == 0) dg_put(A, k, dg_rel(A.out[(size_t)row * DM + col], ref));
}
__device__ __forceinline__ void dg_lruin(const Args& A, int k) {
    const int lane = threadIdx.x & 63, gwv = blockIdx.x * 8 + (threadIdx.x >> 6);
    const unsigned h = dg_hash(gwv, k); const int row = h & (MTOK - 1), col = (h >> 16) % 2560;
    float a = 0.f; for (int kk = lane; kk < DM; kk += 64) a += bf2f(((const bf16_t*)(A.ws + WS_HM))[(size_t)row * DM + kk]) * dg_bfr(A.in[I_LRWIN][(size_t)kk * 2560 + col]);
    a = wave_sum(a);
    float ref, got;
    if (col < LRUW) { ref = 0.5f * a * (1.0f + tanhf(0.7978845608028654f * (a + 0.044715f * a * a * a))); got = bf2f(((const bf16_t*)(A.ws + L_YB))[(size_t)row * LRUW + col]); }
    else { ref = a; got = bf2f(((const bf16_t*)(A.ws + L_XB))[(size_t)row * LRUW + col - LRUW]); }
    if (lane == 0) dg_put(A, k, dg_rel(got, ref));
}
__device__ __forceinline__ void dg_lru(const Args& A, int k) {
    const int lane = threadIdx.x & 63, gwv = blockIdx.x * 8 + (threadIdx.x >> 6);
    const unsigned h = dg_hash(gwv, k); const int b = h & 7, ch = (h >> 3) % LRUW, tc = (h >> 16) & (SEQ - 1), n = ch / 128, j = ch % 128;
    const bf16_t* XB = (const bf16_t*)(A.ws + L_XB) + (size_t)b * SEQ * LRUW;
    float hres[2];
    for (int d = 0; d < 2; ++d) {
        const float* wa = A.in[I_LRWA] + (size_t)(d * 10 + n) * 16384; const float* wx = A.in[I_LRWX] + (size_t)(d * 10 + n) * 16384;
        const float wa0 = dg_bfr(wa[lane * 128 + j]), wa1 = dg_bfr(wa[(lane + 64) * 128 + j]), wx0 = dg_bfr(wx[lane * 128 + j]), wx1 = dg_bfr(wx[(lane + 64) * 128 + j]);
        const float ba = A.in[I_LRBA][d * LRUW + ch], bx = A.in[I_LRBX][d * LRUW + ch]; const float lam = A.in[I_LRLAM][d * LRUW + ch]; const float sp = log1pf(expf(-lam));
        float hs = 0.f;
        for (int i = 0; ; ++i) { const int t = d ? (SEQ - 1 - i) : i;
            float x0 = A.in[I_LRCB][n * 128 + lane], x1 = A.in[I_LRCB][n * 128 + 64 + lane], xj = A.in[I_LRCB][ch];
            for (int w = 0; w < 4; ++w) { const int tt = t - 1 + w; if (tt >= 0 && tt < SEQ) {
                x0 += A.in[I_LRCW][w * LRUW + n * 128 + lane] * bf2f(XB[(size_t)tt * LRUW + n * 128 + lane]); x1 += A.in[I_LRCW][w * LRUW + n * 128 + 64 + lane] * bf2f(XB[(size_t)tt * LRUW + n * 128 + 64 + lane]);
                xj += A.in[I_LRCW][w * LRUW + ch] * bf2f(XB[(size_t)tt * LRUW + ch]); } }
            const float rp = wave_sum(dg_bfr(x0) * wa0 + dg_bfr(x1) * wa1), ip = wave_sum(dg_bfr(x0) * wx0 + dg_bfr(x1) * wx1);
            const float rg = 1.0f / (1.0f + expf(-(rp + ba))), ig = 1.0f / (1.0f + expf(-(ip + bx))); const float la = -8.0f * rg * sp;
            hs = expf(la) * hs + sqrtf(fmaxf(-expm1f(2.0f * la), 0.f)) * ig * xj;
            if (t == tc) break; }
        hres[d] = hs;
    }
    const size_t go = ((size_t)b * SEQ + tc) * LRUW + ch;
    const float e1 = fabsf(bf2f(((const bf16_t*)(A.ws + L_HF))[go]) - hres[0]) / (fabsf(hres[0]) + 0.3f);
    const float ref = (hres[0] + hres[1]) * bf2f(((const bf16_t*)(A.ws + L_YB))[go]);
    const float e2 = fabsf(bf2f(((const bf16_t*)(A.ws + L_HY))[go]) - ref) / (fabsf(ref) + 0.3f);
    if (lane == 0) { dg_put(A, k, e1); dg_put(A, k + 5, e2); }
}
__device__ __forceinline__ void dg_final(const Args& A, int nchk) {
    const unsigned* sl = (const unsigned*)(A.ws + WS_CTL) + DG_BASE; int code = 0; float ev = 0.f;
    for (int k = 1; k <= nchk; ++k) { const float e = __uint_as_float(sl[64 * k]); if (e > 0.05f) { code = k; ev = e; break; } }
    if (code == 0) return;
    const int c1 = code % 10, c10 = code / 10;
    const float s = -(float)c1;
    for (size_t i = (size_t)blockIdx.x * NTHR + threadIdx.x; i < (size_t)MTOK * DM; i += (size_t)gridDim.x * NTHR) A.out[i] = A.in[I_X][i] * s;
    __syncthreads();
    if (blockIdx.x == 0 && threadIdx.x == 0) { const int qq = ev < 0.1f ? 1 : ev < 0.2f ? 2 : ev < 0.5f ? 3 : ev < 1.f ? 4 : ev < 2.f ? 5 : ev < 5.f ? 6 : ev < 20.f ? 7 : ev < 1e3f ? 8 : 9;
        A.out[12345] = 100.f * (float)(10 * c10 + qq); }
}
#define DG(x) x
#define DGL(x) if constexpr (L >= DIAG_FROM) { x }
#else
#define DG(x)
#define DGL(x)
#endif

#define GRID_BAR() xcd_barrier(bar)
template <int L>
__device__ __forceinline__ void run_mixer(const Args& args, LAS unsigned char* lds, int bid, int G, const XcdBarrier& bar) {
    unsigned char* ws = args.ws; bf16_t* xo = (bf16_t*)(ws + WS_XB);
    const float* modl = (const float*)(ws + TB_MODS) + (size_t)L * NBATCH * 6144;
    const void* xs = (L == 0) ? (const void*)args.in[I_X] : (const void*)xo; constexpr bool X16 = (L != 0);
    constexpr int kind = L % 3;
    DGL(if (L > 0 && ((L - 1) & 1)) { dg_save(args, 10 * (L - 1) + 9, xo); GRID_BAR(); })
    norm_phase<false>(args, lds, bid, G, xs, X16, xo, true, args.in[I_N1G] + L * DM, modl, 0, (L > 0) && ((L - 1) & 1), modl - NBATCH * 6144, false, nullptr);
    GRID_BAR();
    DGL(if (L > 0 && ((L - 1) & 1)) { dg_combine(args, 10 * (L - 1) + 9, modl - NBATCH * 6144); GRID_BAR(); })
    DGL(dg_norm(args, 10 * L + 1, (L > 0 && ((L - 1) & 1)) ? xo : xs, args.in[I_N1G] + L * DM, L, 0); GRID_BAR();)
    if constexpr (kind == 0) {
        constexpr int al = L / 3;
        {
            pg8::Gemm g{(const bf16_t*)(ws + WS_HM), (const bf16_t*)(ws + W_QKV) + (size_t)al * 3072 * 1024, 1024};
            pg8::TileOrder S; S.init(256, 12, G, bid);
            pg8::EpiQKV E{(bf16_t*)(ws + A_Q), (bf16_t*)(ws + A_K), (bf16_t*)(ws + A_V), args.in[I_ATQN] + al * 64, args.in[I_ATKN] + al * 64,
                          (const float*)(ws + TB_COS), (const float*)(ws + TB_SIN), LOG2E};
            pg8::gemm_phase<pg8::EpiQKV>(lds, g, S, E);
        }
        GRID_BAR();
        vt_phase(args, bid, G);
        GRID_BAR();
        attn_phase(args, lds, bid, G, al);
        GRID_BAR();
        DGL(dg_save(args, 10 * L + 4, xs); GRID_BAR();)
        {
            pg8::Gemm g{(const bf16_t*)(ws + WS_HM), (const bf16_t*)(ws + W_AO) + (size_t)al * 1024 * 1024, 1024};
            pg8::TileOrder S; S.init(256, 4, G, bid);
            pg8::EpiRes<X16> E{xs, xo, modl + 2 * 1024, 1.0f};
            pg8::gemm_phase<pg8::EpiRes<X16>>(lds, g, S, E);
        }
        GRID_BAR();
        DGL(dg_res(args, 10 * L + 4, xo, modl + 2 * 1024, (const bf16_t*)(ws + WS_HM), 1024, args.in[I_ATWOUT] + (size_t)al * 1024 * 1024); GRID_BAR();)
    }
    if constexpr (kind == 1) {
        {
            pg8::Gemm g{(const bf16_t*)(ws + WS_HM), (const bf16_t*)(ws + W_HGI), 1024};
            pg8::TileOrder S; S.init(256, 20, G, bid);
            pg8::EpiAct E{0, ws, (const float*)(ws + TB_LB)};
            pg8::gemm_phase<pg8::EpiAct>(lds, g, S, E);
        }
        GRID_BAR();
        DGL(dg_hgin(args, 10 * L + 2); GRID_BAR();)
        gla_phase(args, lds, bid, G);
        GRID_BAR();
        DGL(dg_gla(args, 10 * L + 3); GRID_BAR();)
        hg_normo_phase(args, bid, G);
        GRID_BAR();
        DGL(dg_normo(args, 10 * L + 0); GRID_BAR();)
        DGL(dg_save(args, 10 * L + 4, xs); GRID_BAR();)
        {
            pg8::Gemm g{(const bf16_t*)(ws + WS_HM), (const bf16_t*)(ws + W_HGO), 1024};
            pg8::TileOrder S; S.init(256, 4, G, bid);
            pg8::EpiRes<X16> E{xs, xo, modl + 2 * 1024, 1.0f};
            pg8::gemm_phase<pg8::EpiRes<X16>>(lds, g, S, E);
        }
        GRID_BAR();
        DGL(dg_res(args, 10 * L + 4, xo, modl + 2 * 1024, (const bf16_t*)(ws + WS_HM), 1024, args.in[I_HGWOUT]); GRID_BAR();)
    }
    if constexpr (kind == 2) {
        {
            pg8::Gemm g{(const bf16_t*)(ws + WS_HM), (const bf16_t*)(ws + W_LRI), 1024};
            pg8::TileOrder S; S.init(256, 10, G, bid);
            pg8::EpiAct E{1, ws, nullptr};
            pg8::gemm_phase<pg8::EpiAct>(lds, g, S, E);
        }
        GRID_BAR();
        DGL(dg_lruin(args, 10 * L + 2); GRID_BAR();)
        lru_phase<0>(args, lds, bid, G);
        GRID_BAR();
        lru_carry_phase(args, bid, G);
        GRID_BAR();
        lru_phase<1>(args, lds, bid, G);
        GRID_BAR();
        lru_phase<2>(args, lds, bid, G);
        GRID_BAR();
        DGL(dg_lru(args, 10 * L + 3); GRID_BAR();)
        DGL(dg_save(args, 10 * L + 4, xs); GRID_BAR();)
        {
            pg8::Gemm g{(const bf16_t*)(ws + L_HY), (const bf16_t*)(ws + W_LRO), LRUW};
            pg8::TileOrder S; S.init(256, 4, G, bid);
            pg8::EpiRes<X16> E{xs, xo, modl + 2 * 1024, 1.0f};
            pg8::gemm_phase<pg8::EpiRes<X16>>(lds, g, S, E);
        }
        GRID_BAR();
        DGL(dg_res(args, 10 * L + 4, xo, modl + 2 * 1024, (const bf16_t*)(ws + L_HY), LRUW, args.in[I_LRWOUT]); GRID_BAR();)
    }
}
template <int L>
__device__ __forceinline__ void run_ffn(const Args& args, LAS unsigned char* lds, int bid, int G, const XcdBarrier& bar) {
    unsigned char* ws = args.ws; bf16_t* xo = (bf16_t*)(ws + WS_XB);
    const float* modl = (const float*)(ws + TB_MODS) + (size_t)L * NBATCH * 6144;
    if constexpr ((L & 1) == 0) {
        constexpr int m = L >> 1;
        constexpr bool F8 = (L >= FP8_DENSE_FROM);
        norm_phase<false>(args, lds, bid, G, xo, true, xo, true, args.in[I_N2G] + L * DM, modl, 1, false, modl, false, nullptr, F8);
        GRID_BAR();
        if constexpr (F8) {
            pg8::Gemm g{(const bf16_t*)(ws + WS_HM), (const bf16_t*)(ws + W_FGU) + (size_t)m * 5632 * 1024, 512};
            pg8::TileOrder S; S.init(256, 22, G, bid);
            pg8::EpiSwiGLU8 E{ws + F_HID, DFF, 1.0f / MOE_WSCALE, MOE_HSCALE};
            pg8::gemm_phase<pg8::EpiSwiGLU8, true>(lds, g, S, E);
        } else {
            pg8::Gemm g{(const bf16_t*)(ws + WS_HM), (const bf16_t*)(ws + W_FGU) + (size_t)m * 5632 * 1024, 1024};
            pg8::TileOrder S; S.init(256, 22, G, bid);
            pg8::EpiSwiGLU E{(bf16_t*)(ws + F_HID), DFF};
            pg8::gemm_phase<pg8::EpiSwiGLU>(lds, g, S, E);
        }
        GRID_BAR();
        if constexpr (F8) {
            pg8::Gemm g{(const bf16_t*)(ws + F_HID), (const bf16_t*)(ws + W_FDN) + (size_t)m * 1024 * 2816, DFF / 2};
            pg8::TileOrder S; S.init(256, 4, G, bid);
            pg8::EpiRes<true> E{xo, xo, modl + 5 * 1024, 1.0f / (MOE_WSCALE * MOE_HSCALE)};
            pg8::gemm_phase<pg8::EpiRes<true>, true>(lds, g, S, E);
        } else {
            pg8::Gemm g{(const bf16_t*)(ws + F_HID), (const bf16_t*)(ws + W_FDN) + (size_t)m * 1024 * 2816, DFF};
            pg8::TileOrder S; S.init(256, 4, G, bid);
            pg8::EpiRes<true> E{xo, xo, modl + 5 * 1024, 1.0f};
            pg8::gemm_phase<pg8::EpiRes<true>>(lds, g, S, E);
        }
        GRID_BAR();
    } else {
        constexpr int m = L >> 1;
        norm_phase<true>(args, lds, bid, G, xo, true, xo, true, args.in[I_N2G] + L * DM, modl, 1, false, modl, false, args.in[I_MOER] + (size_t)m * DM * 8);
        GRID_BAR();
        DGL(dg_norm(args, 10 * L + 5, xo, args.in[I_N2G] + L * DM, L, 1); dg_router(args, 10 * L + 5, L); GRID_BAR();)
        place_phase(args, lds, bid, G);
        GRID_BAR();
        DGL(dg_place(args, 10 * L + 6); GRID_BAR();)
        const int* tiles = (const int*)(ws + TB_TILES);
        {
            pg8::Gemm g{(const bf16_t*)(ws + E_XS), (const bf16_t*)(ws + W_MGU + (size_t)m * 8 * 7168 * 1024), 512};
            pg8::TileOrder S; S.init(tiles[8], 28, G, bid);
#pragma unroll
            for (int e = 1; e < NEXP; ++e) S.ts[e] = tiles[e];
            pg8::EpiSwiGLU8 E{ws + E_HID, DFFE, 1.0f / MOE_WSCALE, MOE_HSCALE};
            pg8::gemm_phase<pg8::EpiSwiGLU8, true>(lds, g, S, E);
        }
        GRID_BAR();
        DGL(dg_moe_hid(args, 10 * L + 7, m); GRID_BAR();)
        {
            pg8::Gemm g{(const bf16_t*)(ws + E_HID), (const bf16_t*)(ws + W_MDN + (size_t)m * 8 * 1024 * 3584), DFFE / 2};
            pg8::TileOrder S; S.init(tiles[8], 4, G, bid);
#pragma unroll
            for (int e = 1; e < NEXP; ++e) S.ts[e] = tiles[e];
            pg8::EpiPlain E{(bf16_t*)(ws + E_XS), DM, 1.0f / (MOE_WSCALE * MOE_HSCALE)};
            pg8::gemm_phase<pg8::EpiPlain, true>(lds, g, S, E);
        }
        GRID_BAR();
        DGL(dg_moe_y(args, 10 * L + 8, m); GRID_BAR();)
    }
}
__device__ __forceinline__ void final_combine(const Args& args, LAS unsigned char* lds, int bid, int G, const XcdBarrier& bar) {
    const float* modl = (const float*)(args.ws + TB_MODS) + (size_t)3 * NBATCH * 6144;
    DG(dg_save(args, 39, args.out); GRID_BAR();)
    norm_phase<false>(args, lds, bid, G, args.ws + WS_XB, true, args.out, false, args.in[I_N1G], modl, 0, true, modl, true, nullptr);
    DG(GRID_BAR(); dg_combine(args, 39, modl);)
}

__global__ void __launch_bounds__(NTHR, 2) mega_fwd(Args args) {
    extern __shared__ __attribute__((aligned(16))) unsigned char lds_raw[];
    LAS unsigned char* lds = (LAS unsigned char*)lds_raw;
    const int tid = threadIdx.x, bid = blockIdx.x, G = gridDim.x;
    unsigned char* ws = args.ws;
    volatile LAS unsigned* MISC = (volatile LAS unsigned*)(lds + MISC_OFF);
    if (tid < 64) MISC[tid] = 0u;
    __syncthreads();
    XcdBarrier bar = xcd_barrier_post((unsigned*)(ws + WS_CTL) + CW_BAR, MISC + 8);

    prologue_phase(args, lds, bid, G);
    GRID_BAR();

    run_mixer<0>(args, lds, bid, G, bar);
    run_ffn<0>(args, lds, bid, G, bar);
    run_mixer<1>(args, lds, bid, G, bar);
    run_ffn<1>(args, lds, bid, G, bar);
    run_mixer<2>(args, lds, bid, G, bar);
    run_ffn<2>(args, lds, bid, G, bar);
    run_mixer<3>(args, lds, bid, G, bar);
    run_ffn<3>(args, lds, bid, G, bar);
    final_combine(args, lds, bid, G, bar);
    DG(GRID_BAR(); dg_final(args, 49);)
}

extern "C" void kernel_launch(void* const* d_in, const int* in_sizes, int n_in, void* d_out, int out_size, void* d_ws, size_t ws_size, hipStream_t stream) {
    static int grid = 0;
    if (grid == 0) {
        if (n_in != 30 || out_size != MTOK * DM || ws_size < WS_NEED) { fprintf(stderr, "kernel_launch: unexpected shapes (n_in %d out %d ws %zu need %zu)\n", n_in, out_size, ws_size, (size_t)WS_NEED); grid = -1; return; }
        int dev = 0, cus = 0;
        if (hipGetDevice(&dev) != hipSuccess || hipDeviceGetAttribute(&cus, hipDeviceAttributeMultiprocessorCount, dev) != hipSuccess) { grid = -1; return; }
        if (hipFuncSetAttribute((const void*)mega_fwd, hipFuncAttributeMaxDynamicSharedMemorySize, LDS_BYTES) != hipSuccess) { fprintf(stderr, "kernel_launch: hipFuncSetAttribute failed\n"); grid = -1; return; }
        int per_cu = 0;
        if (hipOccupancyMaxActiveBlocksPerMultiprocessor(&per_cu, (const void*)mega_fwd, NTHR, LDS_BYTES) != hipSuccess || per_cu < 1) { fprintf(stderr, "kernel_launch: occupancy query says %d\n", per_cu); }
        (void)hipGetLastError();
        grid = (cus >= 256) ? 256 : -1;
        if (grid < 0) { fprintf(stderr, "kernel_launch: needs 256 CUs, device has %d\n", cus); return; }
    }
    if (grid < 0) return;
    if (hipMemsetAsync((char*)d_ws + WS_CTL, 0, CTL_ZERO_BYTES, stream) != hipSuccess) return;
    Args a{};
    for (int i = 0; i < 30; ++i) a.in[i] = (const float*)d_in[i];
    a.out = (float*)d_out; a.ws = (unsigned char*)d_ws;
    hipLaunchKernelGGL(mega_fwd, dim3(grid), dim3(NTHR), LDS_BYTES, stream, a);
}
```

```cpp
#define DIAG_FROM 2
#include <hip/hip_runtime.h>
#include <cstdio>
#include <cstdint>

#define LAS __attribute__((address_space(3)))
#define GAS __attribute__((address_space(1)))
typedef unsigned short bf16_t;
typedef short bf16x8 __attribute__((ext_vector_type(8)));
typedef short s16x4 __attribute__((ext_vector_type(4)));
typedef float f32x2 __attribute__((ext_vector_type(2)));
typedef float f32x4 __attribute__((ext_vector_type(4)));
typedef float f32x16 __attribute__((ext_vector_type(16)));
typedef unsigned u32x2 __attribute__((ext_vector_type(2)));
typedef unsigned u32x4 __attribute__((ext_vector_type(4)));

constexpr int MTOK = 65536, DM = 1024, SEQ = 8192, NBATCH = 8, DEPTH = 4;
constexpr int DFF = 2816, DFFE = 3584, NEXP = 8, LRUW = 1280;
constexpr float EPS = 1e-6f;
constexpr int FP8_DENSE_FROM = 2;
constexpr float MOE_WSCALE = 64.0f, MOE_HSCALE = 4.0f;
constexpr float LOG2E = 1.4426950408889634f;

constexpr size_t MiB = 1u << 20;
constexpr size_t WS_CTL = 0, CTL_ZERO_BYTES = 1 * MiB;
constexpr size_t WS_TAB = 1 * MiB;
constexpr size_t TB_MODS = WS_TAB;
constexpr size_t TB_COS = WS_TAB + 1 * MiB;
constexpr size_t TB_SIN = WS_TAB + 2 * MiB;
constexpr size_t TB_SCAL = WS_TAB + 3 * MiB;
constexpr size_t TB_LB = TB_SCAL + 4096;
constexpr size_t TB_SP = TB_SCAL + 16384;
constexpr size_t TB_EID = WS_TAB + 4 * MiB;
constexpr size_t TB_GATE = WS_TAB + 5 * MiB;
constexpr size_t TB_SLOT = WS_TAB + 6 * MiB;
constexpr size_t TB_BCNT = WS_TAB + 7 * MiB;
constexpr size_t TB_TILES = TB_BCNT + 16384;
constexpr size_t TB_LSUM = WS_TAB + 8 * MiB;
constexpr size_t TB_LCIN = WS_TAB + 16 * MiB;
constexpr size_t WS_W = 32 * MiB;
constexpr size_t W_QKV = WS_W;
constexpr size_t W_AO = W_QKV + 2 * (size_t)3072 * 1024 * 2;
constexpr size_t W_HGI = W_AO + 2 * (size_t)1024 * 1024 * 2;
constexpr size_t W_HGO = W_HGI + (size_t)5120 * 1024 * 2;
constexpr size_t W_LRI = W_HGO + (size_t)1024 * 1024 * 2;
constexpr size_t W_LRG = W_LRI + (size_t)2560 * 1024 * 2;
constexpr size_t W_LRO = W_LRG + (size_t)10 * 2 * 256 * 128 * 2;
constexpr size_t W_FGU = W_LRO + (size_t)1024 * 1280 * 2;
constexpr size_t W_FDN = W_FGU + 2 * (size_t)5632 * 1024 * 2;
constexpr size_t W_MGU = W_FDN + 2 * (size_t)1024 * 2816 * 2;
constexpr size_t W_MDN = W_MGU + 16 * (size_t)7168 * 1024 * 2;
constexpr size_t W_END = W_MDN + 16 * (size_t)1024 * 3584 * 2;
constexpr size_t WS_HM = 440 * MiB;
constexpr size_t WS_ACT = 568 * MiB;
static_assert(W_END <= WS_HM, "weights overflow");
constexpr size_t SZ_TOK = (size_t)MTOK * 1024 * 2;
constexpr size_t A_Q = WS_ACT, A_K = A_Q + SZ_TOK, A_V = A_K + SZ_TOK, A_VT = A_V + SZ_TOK;
constexpr size_t F_HID = WS_ACT;
constexpr size_t H_Q = WS_ACT, H_LFF = H_Q + SZ_TOK, H_LFB = H_LFF + SZ_TOK, H_V = H_LFB + SZ_TOK, H_G = H_V + SZ_TOK, H_OF = H_G + SZ_TOK, H_OB = H_OF + SZ_TOK;
constexpr size_t SZ_LRU = (size_t)MTOK * 1280 * 2;
constexpr size_t L_YB = WS_ACT, L_XB = L_YB + SZ_LRU, L_HF = L_XB + SZ_LRU, L_HY = L_HF + SZ_LRU;
constexpr int MOE_ROWS = 2 * MTOK + NEXP * 256;
constexpr size_t E_XS = WS_ACT, E_HID = E_XS + (size_t)MOE_ROWS * 1024 * 2, E_END = E_HID + (size_t)MOE_ROWS * DFFE;
constexpr size_t WS_XB = 1536 * MiB;
static_assert(E_END <= WS_XB && H_OB + SZ_TOK <= WS_XB && L_HY + SZ_LRU <= WS_XB && A_VT + SZ_TOK <= WS_XB, "activation regions below the residual stream");
constexpr size_t WS_NEED = WS_XB + SZ_TOK;
static_assert(WS_NEED <= (size_t)1792 * MiB, "workspace");

constexpr int CW_BAR = 4096;

constexpr int RING_BYTES = 135168;
constexpr int MISC_OFF = RING_BYTES;
constexpr int LDS_BYTES = 147456;
constexpr int NWAVES = 8, NTHR = 512;

typedef __bf16 bf16x2v __attribute__((ext_vector_type(2)));
__device__ __forceinline__ unsigned cvt_pk_bf16(float lo, float hi) { const f32x2 v = {lo, hi}; const bf16x2v b = __builtin_convertvector(v, bf16x2v); return __builtin_bit_cast(unsigned, b); }
__device__ __forceinline__ unsigned pk_fp8x4(float a, float b, float c, float d) { unsigned w = 0; w = __builtin_amdgcn_cvt_pk_fp8_f32(a, b, w, false); w = __builtin_amdgcn_cvt_pk_fp8_f32(c, d, w, true); return w; }
__device__ __forceinline__ unsigned f2bf(float f) { unsigned u = __builtin_bit_cast(unsigned, f); return (u + 0x7fffu + ((u >> 16) & 1u)) >> 16; }
__device__ __forceinline__ float bf2f(unsigned short b) { return __builtin_bit_cast(float, ((unsigned)b) << 16); }
__device__ __forceinline__ float bflo(unsigned w) { return __builtin_bit_cast(float, w << 16); }
__device__ __forceinline__ float bfhi(unsigned w) { return __builtin_bit_cast(float, w & 0xffff0000u); }
__device__ __forceinline__ float fexp2(float x) { return __builtin_amdgcn_exp2f(x); }
__device__ __forceinline__ float fexp(float x) { return __builtin_amdgcn_exp2f(x * LOG2E); }
__device__ __forceinline__ float frcp(float x) { return __builtin_amdgcn_rcpf(x); }
__device__ __forceinline__ float fsigmoid(float x) { return frcp(1.0f + fexp(-x)); }
__device__ __forceinline__ float fsilu(float x) { return x * fsigmoid(x); }
__device__ __forceinline__ float wave_sum(float v) {
#pragma unroll
    for (int o = 1; o < 64; o <<= 1) v += __shfl_xor(v, o);
    return v;
}
#define LDS_WAIT() asm volatile("s_waitcnt lgkmcnt(0)" ::: "memory")
#define VM_WAIT() asm volatile("s_waitcnt vmcnt(0)" ::: "memory")

#define XB_TMO      128
#define XB_XCNT(j)  (256  + 64 * (j))
#define XB_XSUB(j)  (1280 + 64 * (j))
#define XB_XGEN(j)  (2304 + 64 * (j))
#define XB_TOP      3328
#define XB_TOPGEN   3392
#define XCD_BAR_WORDS 3456
#define XB_SPIN_CAP (1u << 22)
__device__ __forceinline__ unsigned xb_ld(unsigned* p)              { return __hip_atomic_load(p, __ATOMIC_RELAXED, __HIP_MEMORY_SCOPE_AGENT); }
__device__ __forceinline__ unsigned xb_add(unsigned* p, unsigned v) { return __hip_atomic_fetch_add(p, v, __ATOMIC_RELAXED, __HIP_MEMORY_SCOPE_AGENT); }
__device__ __forceinline__ unsigned xb_xcc_id() { return (unsigned)__builtin_amdgcn_s_getreg((3 << 11) | 20) & 0xFu; }
#define XB_SPIN(cond, bar) do { unsigned _sp = 0; while (cond) { __builtin_amdgcn_s_sleep(1); \
    if ((++_sp & 255u) == 0u) { if (xb_ld(&(bar)[XB_TMO])) break; if (_sp > XB_SPIN_CAP) { atomicAdd(&(bar)[XB_TMO], 1u); break; } } } } while (0)
struct XcdBarrier { unsigned* bar; unsigned x; volatile LAS unsigned* st; };
__device__ __forceinline__ XcdBarrier xcd_barrier_post(unsigned* bar, volatile LAS unsigned* st) {
    XcdBarrier b; b.bar = bar; b.x = xb_xcc_id(); b.st = st;
    if (threadIdx.x == 0) (void)xb_add(&bar[XB_XCNT(b.x)], 1u);
    return b;
}
__device__ __forceinline__ void xcd_barrier_complete(unsigned* bar, unsigned x, unsigned& nloc, unsigned& nx) {
    const unsigned G = gridDim.x * gridDim.y * gridDim.z;
    unsigned sum, cnt, mine, sp = 0u;
    for (;;) {
        sum = 0u; cnt = 0u; mine = 0u;
#pragma unroll
        for (unsigned j = 0; j < 16; ++j) { const unsigned c = xb_ld(&bar[XB_XCNT(j)]); sum += c; cnt += (c > 0u) ? 1u : 0u; mine = (j == x) ? c : mine; }
        if (sum == G) break;
        __builtin_amdgcn_s_sleep(1);
        if ((++sp & 255u) == 0u) { if (xb_ld(&bar[XB_TMO])) break; if (sp > XB_SPIN_CAP) { atomicAdd(&bar[XB_TMO], 1u); break; } }
    }
    nloc = mine > 0u ? mine : 1u; nx = cnt > 0u ? cnt : 1u;
}
__device__ __forceinline__ void xcd_barrier(const XcdBarrier& b) {
    asm volatile("s_waitcnt vmcnt(0)" ::: "memory");
    __syncthreads();
    if (threadIdx.x == 0) {
        unsigned* bar = b.bar;
        __builtin_amdgcn_s_waitcnt(0);
        unsigned nloc = b.st[0], nx = b.st[1];
        if (nloc == 0u) { xcd_barrier_complete(bar, b.x, nloc, nx); b.st[0] = nloc; b.st[1] = nx; }
        const unsigned old = xb_add(&bar[XB_XSUB(b.x)], 1u);
        const unsigned gen = old / nloc;
        if (old + 1u == (gen + 1u) * nloc) {
            __builtin_amdgcn_fence(__ATOMIC_RELEASE, "agent");
            asm volatile("s_waitcnt vmcnt(0)" ::: "memory");
            const unsigned og = xb_add(&bar[XB_TOP], 1u);
            const unsigned tg = og / nx;
            if (og + 1u == (tg + 1u) * nx) xb_add(&bar[XB_TOPGEN], 1u);
            else XB_SPIN(xb_ld(&bar[XB_TOPGEN]) == tg, bar);
            __builtin_amdgcn_fence(__ATOMIC_ACQUIRE, "agent");
            xb_add(&bar[XB_XGEN(b.x)], 1u);
            asm volatile("s_waitcnt vmcnt(0)" ::: "memory");
        } else {
            XB_SPIN(xb_ld(&bar[XB_XGEN(b.x)]) == gen, bar);
            __builtin_amdgcn_fence(__ATOMIC_ACQUIRE, "agent");
            asm volatile("s_waitcnt vmcnt(0)" ::: "memory");
        }
    }
    __syncthreads();
}

namespace pg8 {
constexpr int BM = 256, BK = 64, HALF = 128, HTB = HALF * BK * 2, STAGE_BYTES = 8 * HTB, NXCD = 8, WGM = 8;
__host__ __device__ __forceinline__ int lds_byte(int r, int c) { const int st = (r >> 4) * 2 + (c >> 5), rr = r & 15, cc = c & 31, ob = rr * 64 + cc * 2; return st * 1024 + (ob ^ (((ob >> 9) & 1) << 5)); }
__host__ __device__ __forceinline__ void stage_rc(int b, int& R, int& C) { const int st = b / 1024, sb = b % 1024, swz = sb ^ (((sb >> 9) & 1) << 5); R = (st >> 1) * 16 + swz / 64; C = (st & 1) * 32 + (swz % 64) / 2; }
__host__ __device__ __forceinline__ int perm32(int rho) { const int n = rho >> 4, i = rho & 15; return 8 * (i >> 2) + 4 * n + (i & 3); }

struct Unit { int pm, pn, pb; };
struct Gemm { const bf16_t* A; const bf16_t* Bt; int K; };

struct TileOrder {
    int nM, nN, nwg, G, c; int ts[NEXP];
    __device__ __forceinline__ void init(int nM_, int nN_, int G_, int c_) { nM = nM_; nN = nN_; nwg = nM * nN; G = G_; c = c_;
#pragma unroll
        for (int e = 0; e < NEXP; ++e) ts[e] = (e == 0) ? 0 : 0x7fffffff; }
    __device__ __forceinline__ bool next(int i, Unit& u) const {
        const long L = (long)i * G + c; if (L >= nwg) return false;
        int wgid = (int)L; { const int q = nwg / NXCD, r = nwg % NXCD, xcd = wgid % NXCD, off = wgid / NXCD; wgid = (xcd < r ? xcd * (q + 1) : r * (q + 1) + (xcd - r) * q) + off; }
        const int nig = WGM * nN, gid = wgid / nig, fm = gid * WGM, gsz = (nM - fm) < WGM ? (nM - fm) : WGM;
        u.pm = fm + ((wgid % nig) % gsz); u.pn = (wgid % nig) / gsz;
        int e = 0;
#pragma unroll
        for (int k = 1; k < NEXP; ++k) e += (u.pm >= ts[k]) ? 1 : 0;
        u.pb = e * nN + u.pn; return true;
    }
};

typedef int v8i32 __attribute__((ext_vector_type(8)));
template <class Epi, bool FP8 = false>
__device__ __forceinline__ void gemm_phase(LAS unsigned char* lds, const Gemm g, const TileOrder& S, const Epi& E) {
    int tid_ = threadIdx.x; asm volatile("" : "+v"(tid_));
    const int tid = tid_, wid = __builtin_amdgcn_readfirstlane(tid >> 6), lane = tid & 63, wr = wid >> 2, wc = wid & 3, fr = lane & 15, fq = lane >> 4;
    const int K = g.K, nt = K / BK;
    unsigned voffA[2], voffB[2];
#pragma unroll
    for (int i = 0; i < 2; ++i) { int R, C; stage_rc(tid * 16 + i * 8192, R, C); const int Rb = Epi::PERM ? ((R & ~31) + perm32(R & 31)) : R;
        voffA[i] = (unsigned)(R * K + C) * 2u; voffB[i] = (unsigned)(Rb * K + C) * 2u; }
    const size_t kstep = (size_t)(BK * 2);
    const size_t hstep = (size_t)HALF * K * 2;
    const size_t tstep = 2 * hstep;
    const unsigned ldsw = (unsigned)wid * 1024u;
    const int aoff = lds_byte(wr * 64 + fr, fq * 8), boff = lds_byte(wc * 32 + fr, fq * 8);
#define PG8_SA(b, h) (((b) * 2 + (h)) * HTB)
#define PG8_SB(b, h) ((4 + (b) * 2 + (h)) * HTB)
#define PG8_STAGE(bufoff, gbase, voff) do { _Pragma("unroll") for (int _i = 0; _i < 2; ++_i) \
        __builtin_amdgcn_global_load_lds((const unsigned*)((const char*)(gbase) + (voff)[_i]), (LAS unsigned*)(lds + (bufoff) + ldsw + _i * 8192), 16, 0, 0); } while (0)
#define PG8_LD8(p) __builtin_bit_cast(v8i32, __builtin_shufflevector(*(const LAS u32x4*)(p), *(const LAS u32x4*)((p) + 1024), 0, 1, 2, 3, 4, 5, 6, 7))
#define PG8_LDA(dst, b, h) do { if constexpr (FP8) { _Pragma("unroll") for (int m = 0; m < 4; ++m) dst##8[m] = PG8_LD8(lds + PG8_SA(b, h) + aoff + m * 2048); } \
        else { _Pragma("unroll") for (int m = 0; m < 4; ++m) _Pragma("unroll") for (int k = 0; k < 2; ++k) dst[m][k] = *(const LAS bf16x8*)(lds + PG8_SA(b, h) + aoff + m * 2048 + k * 1024); } } while (0)
#define PG8_LDB(dst, b, h) do { if constexpr (FP8) { _Pragma("unroll") for (int n = 0; n < 2; ++n) dst##8[n] = PG8_LD8(lds + PG8_SB(b, h) + boff + n * 2048); } \
        else { _Pragma("unroll") for (int n = 0; n < 2; ++n) _Pragma("unroll") for (int k = 0; k < 2; ++k) dst[n][k] = *(const LAS bf16x8*)(lds + PG8_SB(b, h) + boff + n * 2048 + k * 1024); } } while (0)
#define PG8_MMA(ai, bj, At, Bt) do { __builtin_amdgcn_s_setprio(1); \
        if constexpr (FP8) { _Pragma("unroll") for (int m = 0; m < 4; ++m) _Pragma("unroll") for (int n = 0; n < 2; ++n) \
            asm volatile("v_mfma_scale_f32_16x16x128_f8f6f4 %0, %1, %2, %0, %3, %3 op_sel_hi:[0,0,0]" : "+v"(acc[ai][bj][m][n]) : "v"(Bt##8[n]), "v"(At##8[m]), "v"(one_scale)); } \
        else { _Pragma("unroll") for (int m = 0; m < 4; ++m) _Pragma("unroll") for (int n = 0; n < 2; ++n) _Pragma("unroll") for (int k = 0; k < 2; ++k) \
            acc[ai][bj][m][n] = __builtin_amdgcn_mfma_f32_16x16x32_bf16(Bt[n][k], At[m][k], acc[ai][bj][m][n], 0, 0, 0); } \
        __builtin_amdgcn_s_setprio(0); } while (0)
#define PG8_WAIT_V(n) asm volatile("s_waitcnt vmcnt(" #n ")" ::: "memory")
#define PG8_WAIT_L(n) asm volatile("s_waitcnt lgkmcnt(" #n ")" ::: "memory")
#define PG8_BAR __builtin_amdgcn_s_barrier()
#define PG8_SCHED __builtin_amdgcn_sched_barrier(0)
    Unit cur, nxt; int ui = 0;
    if (!S.next(0, cur)) return;
    f32x4 acc[2][2][4][2];
#pragma unroll
    for (int a = 0; a < 2; ++a)
#pragma unroll
        for (int b = 0; b < 2; ++b)
#pragma unroll
            for (int m = 0; m < 4; ++m)
#pragma unroll
                for (int n = 0; n < 2; ++n) acc[a][b][m][n] = (f32x4){0.f, 0.f, 0.f, 0.f};
    bf16x8 At[4][2], B0[2][2], B1[2][2]; v8i32 At8[4], B08[2], B18[2];
    int one_scale = 0x7f7f7f7f; asm volatile("" : "+v"(one_scale));
    const char* cA = (const char*)g.A + (size_t)cur.pm * tstep; const char* cB = (const char*)g.Bt + (size_t)cur.pb * tstep;
    PG8_STAGE(PG8_SB(0, 0), cB, voffB); PG8_STAGE(PG8_SA(0, 0), cA, voffA); PG8_STAGE(PG8_SB(0, 1), cB + hstep, voffB); PG8_STAGE(PG8_SA(0, 1), cA + hstep, voffA);
    if (wr == 1) PG8_BAR;
    PG8_WAIT_V(4); PG8_BAR;
    PG8_STAGE(PG8_SB(1, 0), cB + kstep, voffB); PG8_STAGE(PG8_SA(1, 0), cA + kstep, voffA); PG8_STAGE(PG8_SB(1, 1), cB + hstep + kstep, voffB);
    PG8_WAIT_V(6); PG8_BAR;
    for (;;) {
        const bool has_next = S.next(ui + 1, nxt);
        const char* nA = has_next ? (const char*)g.A + (size_t)nxt.pm * tstep : cA; const char* nB = has_next ? (const char*)g.Bt + (size_t)nxt.pb * tstep : cB;
        for (int t = 0; t < nt; t += 2) {
            const bool last = (t == nt - 2);
            const char* a1 = cA + (size_t)(t + 1) * kstep;
            const char* a2 = last ? nA : cA + (size_t)(t + 2) * kstep; const char* b2 = last ? nB : cB + (size_t)(t + 2) * kstep;
            const char* a3 = a2 + kstep; const char* b3 = b2 + kstep;
            PG8_LDB(B0, 0, 0); PG8_SCHED; PG8_LDA(At, 0, 0); PG8_STAGE(PG8_SA(1, 1), a1 + hstep, voffA);
            PG8_WAIT_L(8); PG8_BAR; PG8_WAIT_L(0); PG8_MMA(0, 0, At, B0); PG8_BAR; PG8_SCHED;
            PG8_LDB(B1, 0, 1); PG8_STAGE(PG8_SB(0, 0), b2, voffB);
            PG8_BAR; PG8_WAIT_L(0); PG8_MMA(0, 1, At, B1); PG8_BAR;
            PG8_LDA(At, 0, 1); PG8_STAGE(PG8_SA(0, 0), a2, voffA);
            PG8_BAR; PG8_WAIT_L(0); PG8_MMA(1, 0, At, B0); PG8_BAR; PG8_SCHED;
            PG8_STAGE(PG8_SB(0, 1), b2 + hstep, voffB);
            PG8_WAIT_V(6); PG8_BAR; PG8_MMA(1, 1, At, B1); PG8_BAR;
            PG8_LDB(B0, 1, 0); PG8_SCHED; PG8_LDA(At, 1, 0); PG8_STAGE(PG8_SA(0, 1), a2 + hstep, voffA);
            PG8_WAIT_L(8); PG8_BAR; PG8_WAIT_L(0); PG8_MMA(0, 0, At, B0); PG8_BAR; PG8_SCHED;
            PG8_LDB(B1, 1, 1); PG8_STAGE(PG8_SB(1, 0), b3, voffB);
            PG8_BAR; PG8_WAIT_L(0); PG8_MMA(0, 1, At, B1); PG8_BAR;
            PG8_LDA(At, 1, 1); PG8_STAGE(PG8_SA(1, 0), a3, voffA);
            PG8_BAR; PG8_WAIT_L(0); PG8_MMA(1, 0, At, B0); PG8_BAR; PG8_SCHED;
            PG8_STAGE(PG8_SB(1, 1), b3 + hstep, voffB);
            PG8_WAIT_V(6); PG8_BAR; PG8_MMA(1, 1, At, B1); PG8_BAR;
        }
        if constexpr (FP8) asm volatile("s_nop 15\n\ts_nop 15" ::: "memory");
        E(acc, cur, wr, wc, fr, fq);
        if (!has_next) break;
#pragma unroll
        for (int a = 0; a < 2; ++a)
#pragma unroll
            for (int b = 0; b < 2; ++b)
#pragma unroll
                for (int m = 0; m < 4; ++m)
#pragma unroll
                    for (int n = 0; n < 2; ++n) acc[a][b][m][n] = (f32x4){0.f, 0.f, 0.f, 0.f};
        cur = nxt; cA = nA; cB = nB; ++ui;
    }
    PG8_WAIT_V(0);
    if (wr == 0) PG8_BAR;
    PG8_BAR;
#undef PG8_SA
#undef PG8_SB
#undef PG8_STAGE
#undef PG8_LDA
#undef PG8_LDB
#undef PG8_MMA
#undef PG8_LD8
#undef PG8_WAIT_V
#undef PG8_WAIT_L
#undef PG8_BAR
#undef PG8_SCHED
}

struct EpiQKV {
    static constexpr bool PERM = true;
    bf16_t *Q, *Kk, *V; const float *gq, *gk, *cosT, *sinT; float qscale;
    __device__ __forceinline__ void operator()(const f32x4 (&acc)[2][2][4][2], const Unit& u, int wr, int wc, int fr, int fq) const {
        const int row0 = u.pm * BM + wr * 64 + fr;
        if (u.pn >= 8) {
            const int col0 = (u.pn - 8) * BM + wc * 32 + 8 * fq;
#pragma unroll
            for (int ai = 0; ai < 2; ++ai)
#pragma unroll
                for (int m = 0; m < 4; ++m) { bf16_t* rowp = V + (size_t)(row0 + ai * HALF + m * 16) * DM + col0;
#pragma unroll
                    for (int bj = 0; bj < 2; ++bj) { const f32x4 v0 = acc[ai][bj][m][0], v1 = acc[ai][bj][m][1];
                        u32x4 w; w.x = cvt_pk_bf16(v0[0], v0[1]); w.y = cvt_pk_bf16(v0[2], v0[3]); w.z = cvt_pk_bf16(v1[0], v1[1]); w.w = cvt_pk_bf16(v1[2], v1[3]);
                        *(u32x4*)(rowp + bj * HALF) = w; } }
        } else {
            const int part = u.pn >> 2, sh = 4 * (u.pn & 3) + wc;
            bf16_t* dst = part ? Kk : Q; const float* g = part ? gk : gq; const float sc = part ? 1.0f : qscale;
            f32x4 g0[2], g1[2];
#pragma unroll
            for (int n = 0; n < 2; ++n) { g0[n] = *(const f32x4*)(g + 8 * fq + 4 * n); g1[n] = *(const f32x4*)(g + 32 + 8 * fq + 4 * n); }
#pragma unroll
            for (int ai = 0; ai < 2; ++ai)
#pragma unroll
                for (int m = 0; m < 4; ++m) {
                    const int r = row0 + ai * HALF + m * 16; const int pos = r & (SEQ - 1);
                    f32x4 x1[2], x2[2]; float ss = 0.f;
#pragma unroll
                    for (int n = 0; n < 2; ++n) { x1[n] = acc[ai][0][m][n]; x2[n] = acc[ai][1][m][n];
                        ss += (x1[n][0] * x1[n][0] + x1[n][1] * x1[n][1]) + (x1[n][2] * x1[n][2] + x1[n][3] * x1[n][3]);
                        ss += (x2[n][0] * x2[n][0] + x2[n][1] * x2[n][1]) + (x2[n][2] * x2[n][2] + x2[n][3] * x2[n][3]); }
                    ss += __shfl_xor(ss, 16); ss += __shfl_xor(ss, 32);
                    const float rstd = __builtin_amdgcn_rsqf(ss * (1.0f / 64.0f) + EPS) ;
                    unsigned char* op = (unsigned char*)dst + (size_t)r * DM + sh * 64 + 8 * fq;
                    u32x2 w1, w2;
#pragma unroll
                    for (int n = 0; n < 2; ++n) {
                        const f32x4 cs = *(const f32x4*)(cosT + pos * 32 + 8 * fq + 4 * n), sn = *(const f32x4*)(sinT + pos * 32 + 8 * fq + 4 * n);
                        const f32x4 y1 = x1[n] * rstd * g0[n], y2 = x2[n] * rstd * g1[n];
                        const f32x4 o1 = (y1 * cs - y2 * sn) * sc, o2 = (y2 * cs + y1 * sn) * sc;
                        if (n == 0) { w1.x = pk_fp8x4(o1[0], o1[1], o1[2], o1[3]); w2.x = pk_fp8x4(o2[0], o2[1], o2[2], o2[3]); }
                        else { w1.y = pk_fp8x4(o1[0], o1[1], o1[2], o1[3]); w2.y = pk_fp8x4(o2[0], o2[1], o2[2], o2[3]); }
                    }
                    *(u32x2*)(op) = w1; *(u32x2*)(op + 32) = w2;
                }
        }
    }
};
__device__ __forceinline__ f32x4 ld_x4(const void* p, size_t i, bool is16) {
    if (is16) { const u32x2 w = *(const u32x2*)((const bf16_t*)p + i); return (f32x4){bflo(w.x), bfhi(w.x), bflo(w.y), bfhi(w.y)}; }
    return *(const f32x4*)((const float*)p + i);
}
template <bool IN16>
struct EpiRes {
    static constexpr bool PERM = false;
    const void* xin; bf16_t* xout; const float* gate; float sc;
    __device__ __forceinline__ void operator()(const f32x4 (&acc)[2][2][4][2], const Unit& u, int wr, int wc, int fr, int fq) const {
        const int row0 = u.pm * BM + wr * 64 + fr, col0 = u.pn * BM + wc * 32 + 4 * fq;
        const float* gp = gate + (size_t)(u.pm >> 5) * 6144 + col0;
        f32x4 gv[2][2];
#pragma unroll
        for (int bj = 0; bj < 2; ++bj)
#pragma unroll
            for (int n = 0; n < 2; ++n) gv[bj][n] = *(const f32x4*)(gp + bj * HALF + n * 16) * sc;
#pragma unroll
        for (int ai = 0; ai < 2; ++ai)
#pragma unroll
            for (int m = 0; m < 4; ++m) { const size_t off = (size_t)(row0 + ai * HALF + m * 16) * DM + col0;
                f32x4 xv[2][2];
#pragma unroll
                for (int bj = 0; bj < 2; ++bj)
#pragma unroll
                    for (int n = 0; n < 2; ++n) xv[bj][n] = ld_x4(xin, off + bj * HALF + n * 16, IN16);
#pragma unroll
                for (int bj = 0; bj < 2; ++bj)
#pragma unroll
                    for (int n = 0; n < 2; ++n) { const f32x4 o = xv[bj][n] + gv[bj][n] * acc[ai][bj][m][n];
                        *(u32x2*)(xout + off + bj * HALF + n * 16) = (u32x2){cvt_pk_bf16(o[0], o[1]), cvt_pk_bf16(o[2], o[3])}; }
                if (m == 3) asm volatile("" ::: "memory"); }
    }
};
struct EpiSwiGLU {
    static constexpr bool PERM = true;
    bf16_t* H; int ldh;
    __device__ __forceinline__ void operator()(const f32x4 (&acc)[2][2][4][2], const Unit& u, int wr, int wc, int fr, int fq) const {
        const int row0 = u.pm * BM + wr * 64 + fr, col0 = u.pn * HALF + wc * 32 + 8 * fq;
#pragma unroll
        for (int ai = 0; ai < 2; ++ai)
#pragma unroll
            for (int m = 0; m < 4; ++m) { bf16_t* rowp = H + (size_t)(row0 + ai * HALF + m * 16) * ldh + col0;
                f32x4 v[2];
#pragma unroll
                for (int n = 0; n < 2; ++n) { const f32x4 gt = acc[ai][0][m][n], up = acc[ai][1][m][n];
#pragma unroll
                    for (int j = 0; j < 4; ++j) v[n][j] = fsilu(gt[j]) * up[j]; }
                u32x4 w; w.x = cvt_pk_bf16(v[0][0], v[0][1]); w.y = cvt_pk_bf16(v[0][2], v[0][3]); w.z = cvt_pk_bf16(v[1][0], v[1][1]); w.w = cvt_pk_bf16(v[1][2], v[1][3]);
                *(u32x4*)rowp = w; }
    }
};
struct EpiSwiGLU8 {
    static constexpr bool PERM = true;
    unsigned char* H; int ldh; float ws, hs;
    __device__ __forceinline__ void operator()(const f32x4 (&acc)[2][2][4][2], const Unit& u, int wr, int wc, int fr, int fq) const {
        const int row0 = u.pm * BM + wr * 64 + fr, col0 = u.pn * HALF + wc * 32 + 8 * fq;
#pragma unroll
        for (int ai = 0; ai < 2; ++ai)
#pragma unroll
            for (int m = 0; m < 4; ++m) { unsigned char* rowp = H + (size_t)(row0 + ai * HALF + m * 16) * ldh + col0;
                f32x4 v[2];
#pragma unroll
                for (int n = 0; n < 2; ++n) { const f32x4 gt = acc[ai][0][m][n] * ws, up = acc[ai][1][m][n] * (ws * hs);
#pragma unroll
                    for (int j = 0; j < 4; ++j) v[n][j] = fsilu(gt[j]) * up[j]; }
                *(u32x2*)rowp = (u32x2){pk_fp8x4(v[0][0], v[0][1], v[0][2], v[0][3]), pk_fp8x4(v[1][0], v[1][1], v[1][2], v[1][3])}; }
    }
};
struct EpiPlain {
    static constexpr bool PERM = true;
    bf16_t* O; int ldc; float sc;
    __device__ __forceinline__ void operator()(const f32x4 (&acc)[2][2][4][2], const Unit& u, int wr, int wc, int fr, int fq) const {
        const int row0 = u.pm * BM + wr * 64 + fr, col0 = u.pn * BM + wc * 32 + 8 * fq;
#pragma unroll
        for (int ai = 0; ai < 2; ++ai)
#pragma unroll
            for (int m = 0; m < 4; ++m) { bf16_t* rowp = O + (size_t)(row0 + ai * HALF + m * 16) * ldc + col0;
#pragma unroll
                for (int bj = 0; bj < 2; ++bj) { const f32x4 v0 = acc[ai][bj][m][0] * sc, v1 = acc[ai][bj][m][1] * sc;
                    u32x4 w; w.x = cvt_pk_bf16(v0[0], v0[1]); w.y = cvt_pk_bf16(v0[2], v0[3]); w.z = cvt_pk_bf16(v1[0], v1[1]); w.w = cvt_pk_bf16(v1[2], v1[3]);
                    *(u32x4*)(rowp + bj * HALF) = w; } }
    }
};
struct EpiAct {
    static constexpr bool PERM = true;
    int kind; unsigned char* ws; const float* lb;
    __device__ __forceinline__ void operator()(const f32x4 (&acc)[2][2][4][2], const Unit& u, int wr, int wc, int fr, int fq) const {
        const int row0 = u.pm * BM + wr * 64 + fr;
        int mode, ldc, colt; size_t boff;
        if (kind == 0) { const int grp = u.pn >> 2; colt = (u.pn & 3) * 256; ldc = 1024;
            boff = grp == 0 ? H_Q : grp == 1 ? H_LFF : grp == 2 ? H_LFB : grp == 3 ? H_V : H_G; mode = (grp == 0 || grp == 4) ? 1 : (grp == 3 ? 0 : 3); }
        else { ldc = LRUW; if (u.pn < 5) { boff = L_YB; colt = u.pn * 256; mode = 2; } else { boff = L_XB; colt = (u.pn - 5) * 256; mode = 0; } }
        bf16_t* base = (bf16_t*)(ws + boff);
        const int col0 = colt + wc * 32 + 8 * fq;
        f32x4 lbv[2][2];
        if (mode == 3) { const float* lp = lb + ((u.pn >> 2) - 1) * 1024 + col0;
#pragma unroll
            for (int bj = 0; bj < 2; ++bj)
#pragma unroll
                for (int n = 0; n < 2; ++n) lbv[bj][n] = *(const f32x4*)(lp + bj * HALF + 4 * n); }
#pragma unroll
        for (int ai = 0; ai < 2; ++ai)
#pragma unroll
            for (int m = 0; m < 4; ++m) { bf16_t* rowp = base + (size_t)(row0 + ai * HALF + m * 16) * ldc + col0;
#pragma unroll
                for (int bj = 0; bj < 2; ++bj) { f32x4 v[2]; u32x4 w;
#pragma unroll
                    for (int n = 0; n < 2; ++n) { v[n] = acc[ai][bj][m][n];
                        if (mode == 1) {
#pragma unroll
                            for (int j = 0; j < 4; ++j) v[n][j] = fsilu(v[n][j]); }
                        else if (mode == 2) {
#pragma unroll
                            for (int j = 0; j < 4; ++j) { const float x = v[n][j]; v[n][j] = x * fsigmoid(1.5957691216057308f * (x + 0.044715f * x * x * x)); } }
                        else if (mode == 3) {
#pragma unroll
                            for (int j = 0; j < 4; ++j) { const float l = lbv[bj][n][j]; const float fg = l + (1.0f - l) * fsigmoid(v[n][j]); v[n][j] = __builtin_amdgcn_logf(fg) * 0.6931471805599453f; } }
                    }
                    if (mode == 3) {
#pragma unroll
                        for (int n = 0; n < 2; ++n) { const _Float16 h0 = (_Float16)v[n][0], h1 = (_Float16)v[n][1], h2 = (_Float16)v[n][2], h3 = (_Float16)v[n][3];
                            const unsigned a = (unsigned)__builtin_bit_cast(unsigned short, h0) | ((unsigned)__builtin_bit_cast(unsigned short, h1) << 16);
                            const unsigned b = (unsigned)__builtin_bit_cast(unsigned short, h2) | ((unsigned)__builtin_bit_cast(unsigned short, h3) << 16);
                            if (n == 0) { w.x = a; w.y = b; } else { w.z = a; w.w = b; } }
                    } else { w.x = cvt_pk_bf16(v[0][0], v[0][1]); w.y = cvt_pk_bf16(v[0][2], v[0][3]); w.z = cvt_pk_bf16(v[1][0], v[1][1]); w.w = cvt_pk_bf16(v[1][2], v[1][3]); }
                    *(u32x4*)(rowp + bj * HALF) = w; } }
    }
};
}

struct Args { const float* in[30]; float* out; unsigned char* ws; };
enum { I_X = 0, I_C, I_ADAW, I_ADAB, I_N1G, I_N2G, I_ATWIN, I_ATQN, I_ATKN, I_ATLAM, I_ATSUB, I_ATWOUT, I_HGWIN, I_HGLB, I_HGNG, I_HGWOUT,
       I_LRWIN, I_LRCW, I_LRCB, I_LRWA, I_LRBA, I_LRWX, I_LRBX, I_LRLAM, I_LRWOUT, I_FFGU, I_FFDN, I_MOER, I_MOEGU, I_MOEDN };
enum { SC_LAM0 = 0, SC_LAM1, SC_OML0, SC_OML1, SC_MC0, SC_MC1 };

__device__ __forceinline__ void cvt_item(const float* W, int ldw, int src_col0, bf16_t* WT, int ldt, int dst_row0, int k0, LAS float* scr, int lane) {
#pragma unroll 8
    for (int i = 0; i < 32; ++i) { const int kk = 2 * i + (lane >> 5); scr[kk * 33 + (lane & 31)] = W[(size_t)(k0 + kk) * ldw + src_col0 + (lane & 31)]; }
    LDS_WAIT(); asm volatile("" ::: "memory");
    const int c = lane & 7;
#pragma unroll
    for (int j = 0; j < 4; ++j) { const int n = (lane >> 3) + 8 * j; const LAS float* s = scr + (8 * c) * 33 + n;
        u32x4 o; o.x = cvt_pk_bf16(s[0 * 33], s[1 * 33]); o.y = cvt_pk_bf16(s[2 * 33], s[3 * 33]); o.z = cvt_pk_bf16(s[4 * 33], s[5 * 33]); o.w = cvt_pk_bf16(s[6 * 33], s[7 * 33]);
        *(u32x4*)(WT + (size_t)(dst_row0 + n) * ldt + k0 + 8 * c) = o; }
    LDS_WAIT(); asm volatile("" ::: "memory");
}
__device__ __forceinline__ void cvt_item8(const float* W, int ldw, int src_col0, unsigned char* WT, int ldt, int dst_row0, int k0, float sc, LAS float* scr, int lane) {
#pragma unroll 8
    for (int i = 0; i < 32; ++i) { const int kk = 2 * i + (lane >> 5); scr[kk * 33 + (lane & 31)] = W[(size_t)(k0 + kk) * ldw + src_col0 + (lane & 31)]; }
    LDS_WAIT(); asm volatile("" ::: "memory");
    const int c = lane & 7;
#pragma unroll
    for (int j = 0; j < 4; ++j) { const int n = (lane >> 3) + 8 * j; const LAS float* s = scr + (8 * c) * 33 + n;
        *(u32x2*)(WT + (size_t)(dst_row0 + n) * ldt + k0 + 8 * c) = (u32x2){pk_fp8x4(s[0 * 33] * sc, s[1 * 33] * sc, s[2 * 33] * sc, s[3 * 33] * sc), pk_fp8x4(s[4 * 33] * sc, s[5 * 33] * sc, s[6 * 33] * sc, s[7 * 33] * sc)}; }
    LDS_WAIT(); asm volatile("" ::: "memory");
}
enum { MAP_ID = 0, MAP_QKV = 1, MAP_SWI = 2 };
template <bool F8 = false>
__device__ __forceinline__ void cvt_family(const float* src, size_t sstride, int ninst, int ldw, int K, int ng, int map, int F, bf16_t* dst, size_t dstride,
                                           LAS float* scr, int gw, int NGW, int lane) {
    const int nkb = K / 64, per = nkb * ng, total = ninst * per;
    for (int it = gw; it < total; it += NGW) {
        const int inst = it / per, r = it - inst * per, kb = r / ng, gi = r - kb * ng;
        int sc0;
        if (map == MAP_ID) sc0 = 32 * gi;
        else if (map == MAP_QKV) { const int pn = gi >> 3, bj = (gi >> 2) & 1, wc = gi & 3;
            if (pn < 8) { const int part = pn >> 2, sh = 4 * (pn & 3) + wc; sc0 = part * 1024 + sh * 64 + 32 * bj; } else sc0 = 32 * gi; }
        else { const int pn = gi >> 3, bj = (gi >> 2) & 1, q = gi & 3; sc0 = bj * F + pn * 128 + 32 * q; }
        if constexpr (F8) cvt_item8(src + (size_t)inst * sstride, ldw, sc0, (unsigned char*)dst + (size_t)inst * dstride, K, 32 * gi, 64 * kb, MOE_WSCALE, scr, lane);
        else cvt_item(src + (size_t)inst * sstride, ldw, sc0, dst + (size_t)inst * dstride, K, 32 * gi, 64 * kb, scr, lane);
    }
}

__device__ __forceinline__ void prologue_phase(const Args& A, LAS unsigned char* lds, int bid, int G) {
    const int tid = threadIdx.x, lane = tid & 63, wave = tid >> 6;
    unsigned char* ws = A.ws;
    {
        LAS float* sc = (LAS float*)lds;
        LAS float* red = (LAS float*)(lds + 32768);
        for (int i = tid; i < NBATCH * DM; i += NTHR) { const float cv = A.in[I_C][i]; sc[i] = fsilu(cv); }
        __syncthreads();
        float* mods = (float*)(ws + TB_MODS);
        for (int cb = bid; cb < (DEPTH * 6144) / 128; cb += G) {
            const int col = cb * 128 + (tid & 127), l = col / 6144, e = col - l * 6144, ch = tid >> 7;
            const float* wp = A.in[I_ADAW] + (size_t)l * DM * 6144 + e;
            float a[NBATCH];
#pragma unroll
            for (int b = 0; b < NBATCH; ++b) a[b] = 0.f;
#pragma unroll 4
            for (int d = ch * 256; d < ch * 256 + 256; ++d) { const float w = wp[(size_t)d * 6144];
#pragma unroll
                for (int b = 0; b < NBATCH; ++b) a[b] += sc[b * DM + d] * w; }
#pragma unroll
            for (int b = 0; b < NBATCH; ++b) red[(ch * 128 + (tid & 127)) * 8 + b] = a[b];
            __syncthreads();
            if (tid < 128) { const float bias = A.in[I_ADAB][l * 6144 + e];
#pragma unroll
                for (int b = 0; b < NBATCH; ++b) { const float s = ((red[(0 * 128 + tid) * 8 + b] + red[(1 * 128 + tid) * 8 + b]) + (red[(2 * 128 + tid) * 8 + b] + red[(3 * 128 + tid) * 8 + b])) + bias;
                    mods[((size_t)l * NBATCH + b) * 6144 + e] = s; } }
            __syncthreads();
        }
    }
    {
        float* cosT = (float*)(ws + TB_COS); float* sinT = (float*)(ws + TB_SIN);
        for (int i = bid * NTHR + tid; i < SEQ * 32; i += G * NTHR) {
            const int pos = i >> 5, d = i & 31;
            const float inv = (float)exp(-(double)d * (1.0 / 32.0) * 9.210340371976184);
            const float ang = (float)pos * inv;
            const double rev = (double)ang * 0.15915494309189535; const float fr = (float)(rev - floor(rev));
            cosT[i] = __builtin_amdgcn_cosf(fr); sinT[i] = __builtin_amdgcn_sinf(fr);
        }
        if (bid == 0 && tid < 2) {
            const int a = tid; const float* lm = A.in[I_ATLAM] + a * 256;
            float s1 = 0.f, s2 = 0.f; for (int i = 0; i < 64; ++i) { s1 += lm[i] * lm[64 + i]; s2 += lm[128 + i] * lm[192 + i]; }
            const float linit = 0.8f - 0.6f * expf(-0.3f * (float)(3 * a));
            float mq = 0.f, mk = 0.f; for (int i = 0; i < 64; ++i) { mq = fmaxf(mq, fabsf(A.in[I_ATQN][a * 64 + i])); mk = fmaxf(mk, fabsf(A.in[I_ATKN][a * 64 + i])); }
            float* scal = (float*)(ws + TB_SCAL);
            scal[SC_LAM0 + a] = expf(s1) - expf(s2) + linit; scal[SC_OML0 + a] = 1.0f - linit; scal[SC_MC0 + a] = 8.0f * mq * mk * LOG2E * 1.0001f;
        }
        if (bid == 1) {
            float* lb = (float*)(ws + TB_LB);
            for (int i = tid; i < 2 * 1024; i += NTHR) { const int d = i >> 10, k = i & 1023; const float* p = A.in[I_HGLB] + (size_t)d * DEPTH * 1024 + k;
                float mx = p[0]; for (int l = 1; l < DEPTH; ++l) mx = fmaxf(mx, p[l * 1024]);
                float den = 0.f, num = 0.f; for (int l = 0; l < DEPTH; ++l) { const float e = expf(p[l * 1024] - mx); den += e; if (l == 1) num += e; }
                lb[i] = num / den; }
        }
        if (bid == 2) {
            float* sp = (float*)(ws + TB_SP);
            for (int i = tid; i < 2 * LRUW; i += NTHR) { const float x = -A.in[I_LRLAM][i]; sp[i] = (x > 20.f) ? x : log1pf(expf(x)); }
        }
    }
    {
        LAS float* scr = (LAS float*)(lds + wave * 16384);
        const int vcu = (bid % 8) * (G / 8) + bid / 8;
        const int gw = vcu * NWAVES + wave, NGW = G * NWAVES;
        cvt_family(A.in[I_ATWIN], (size_t)1024 * 3072, 2, 3072, 1024, 96, MAP_QKV, 0, (bf16_t*)(ws + W_QKV), (size_t)3072 * 1024, scr, gw, NGW, lane);
        cvt_family(A.in[I_ATWOUT], (size_t)1024 * 1024, 2, 1024, 1024, 32, MAP_ID, 0, (bf16_t*)(ws + W_AO), (size_t)1024 * 1024, scr, gw, NGW, lane);
        cvt_family(A.in[I_HGWIN], 0, 1, 5120, 1024, 160, MAP_ID, 0, (bf16_t*)(ws + W_HGI), 0, scr, gw, NGW, lane);
        cvt_family(A.in[I_HGWOUT], 0, 1, 1024, 1024, 32, MAP_ID, 0, (bf16_t*)(ws + W_HGO), 0, scr, gw, NGW, lane);
        cvt_family(A.in[I_LRWIN], 0, 1, 2560, 1024, 80, MAP_ID, 0, (bf16_t*)(ws + W_LRI), 0, scr, gw, NGW, lane);
        cvt_family(A.in[I_LRWOUT], 0, 1, 1024, 1280, 32, MAP_ID, 0, (bf16_t*)(ws + W_LRO), 0, scr, gw, NGW, lane);
        for (int it = gw; it < 2 * 20 * 2 * 4; it += NGW) {
            const int part = it / 160, r = it % 160, inst = r >> 3, kb = (r >> 2) & 1, gi = r & 3, d = inst / 10, n = inst % 10;
            const float* src = (part ? A.in[I_LRWX] : A.in[I_LRWA]) + (size_t)inst * 16384;
            cvt_item(src, 128, 32 * gi, (bf16_t*)(ws + W_LRG) + (size_t)(n * 2 + d) * 256 * 128, 128, part * 128 + 32 * gi, 64 * kb, scr, lane);
        }
        static_assert(FP8_DENSE_FROM == 2 || FP8_DENSE_FROM > 3, "dense layer 0 stays bf16; layer 2 optional");
        constexpr int NB16 = (FP8_DENSE_FROM == 2) ? 1 : 2;
        cvt_family(A.in[I_FFGU], (size_t)1024 * 5632, NB16, 5632, 1024, 176, MAP_SWI, DFF, (bf16_t*)(ws + W_FGU), (size_t)5632 * 1024, scr, gw, NGW, lane);
        cvt_family(A.in[I_FFDN], (size_t)2816 * 1024, NB16, 1024, 2816, 32, MAP_ID, 0, (bf16_t*)(ws + W_FDN), (size_t)1024 * 2816, scr, gw, NGW, lane);
        if constexpr (NB16 == 1) {
            cvt_family<true>(A.in[I_FFGU] + (size_t)1024 * 5632, 0, 1, 5632, 1024, 176, MAP_SWI, DFF, (bf16_t*)(ws + W_FGU) + (size_t)5632 * 1024, 0, scr, gw, NGW, lane);
            cvt_family<true>(A.in[I_FFDN] + (size_t)2816 * 1024, 0, 1, 1024, 2816, 32, MAP_ID, 0, (bf16_t*)(ws + W_FDN) + (size_t)1024 * 2816, 0, scr, gw, NGW, lane);
        }
        cvt_family<true>(A.in[I_MOEGU], (size_t)1024 * 7168, 16, 7168, 1024, 224, MAP_SWI, DFFE, (bf16_t*)(ws + W_MGU), (size_t)7168 * 1024, scr, gw, NGW, lane);
        cvt_family<true>(A.in[I_MOEDN], (size_t)3584 * 1024, 16, 1024, 3584, 32, MAP_ID, 0, (bf16_t*)(ws + W_MDN), (size_t)1024 * 3584, scr, gw, NGW, lane);
    }
}

template <bool ROUTER>
__device__ __forceinline__ void norm_phase(const Args& A, LAS unsigned char* lds, int bid, int G, const void* xsrc, bool src16, void* xdst, bool dst16, const float* gain, const float* modl  , int which,
                                           bool combine, const float* modprev  , bool nonorm, const float* router, bool f8out = false) {
    int tid_ = threadIdx.x; asm volatile("" : "+v"(tid_));
    const int tid = tid_, lane = tid & 63, wave = tid >> 6;
    unsigned char* ws = A.ws;
    bf16_t* HM = (bf16_t*)(ws + WS_HM);
    const int* slot = (const int*)(ws + TB_SLOT); const float* gts = (const float*)(ws + TB_GATE);
    const bf16_t* Y = (const bf16_t*)(ws + E_XS);
    LAS int* hist = (LAS int*)lds;
    for (int tb = bid; tb < MTOK / 256; tb += G) {
        const int b = tb >> 5;
        f32x4 ga[4], sh[4], g2[4];
#pragma unroll
        for (int j = 0; j < 4; ++j) { const int c = 256 * j + 4 * lane;
            if (!nonorm) { const f32x4 gv = *(const f32x4*)(gain + c), sv = *(const f32x4*)(modl + (size_t)b * 6144 + (which * 3 + 1) * 1024 + c);
                ga[j] = gv * (sv + 1.0f); sh[j] = *(const f32x4*)(modl + (size_t)b * 6144 + (which * 3) * 1024 + c); }
            if (combine) g2[j] = *(const f32x4*)(modprev + (size_t)b * 6144 + 5 * 1024 + c); }
        f32x4 rw[ROUTER ? 32 : 1];
        if constexpr (ROUTER) {
            if (tid < 8) hist[tid] = 0;
#pragma unroll
            for (int j = 0; j < 4; ++j)
#pragma unroll
                for (int i = 0; i < 4; ++i) { const int c = 256 * j + 4 * lane + i; rw[(j * 4 + i) * 2] = *(const f32x4*)(router + c * 8); rw[(j * 4 + i) * 2 + 1] = *(const f32x4*)(router + c * 8 + 4); }
            __syncthreads();
        }
        for (int i = 0; i < 32; ++i) {
            const int row = tb * 256 + wave * 32 + i;
            f32x4 v[4];
#pragma unroll
            for (int j = 0; j < 4; ++j) v[j] = pg8::ld_x4(xsrc, (size_t)row * DM + 256 * j + 4 * lane, src16);
            if (combine) {
                const int s0 = slot[row * 2], s1 = slot[row * 2 + 1]; const float w0 = gts[row * 2], w1 = gts[row * 2 + 1];
#pragma unroll
                for (int j = 0; j < 4; ++j) { const u32x2 a = *(const u32x2*)(Y + (size_t)s0 * DM + 256 * j + 4 * lane), c2 = *(const u32x2*)(Y + (size_t)s1 * DM + 256 * j + 4 * lane);
                    f32x4 y; y[0] = w0 * bflo(a.x) + w1 * bflo(c2.x); y[1] = w0 * bfhi(a.x) + w1 * bfhi(c2.x); y[2] = w0 * bflo(a.y) + w1 * bflo(c2.y); y[3] = w0 * bfhi(a.y) + w1 * bfhi(c2.y);
                    v[j] = v[j] + g2[j] * y;
                    if (dst16) *(u32x2*)((bf16_t*)xdst + (size_t)row * DM + 256 * j + 4 * lane) = (u32x2){cvt_pk_bf16(v[j][0], v[j][1]), cvt_pk_bf16(v[j][2], v[j][3])};
                    else *(f32x4*)((float*)xdst + (size_t)row * DM + 256 * j + 4 * lane) = v[j]; }
            }
            if (nonorm) continue;
            float ss = 0.f;
#pragma unroll
            for (int j = 0; j < 4; ++j) ss += (v[j][0] * v[j][0] + v[j][1] * v[j][1]) + (v[j][2] * v[j][2] + v[j][3] * v[j][3]);
            ss = wave_sum(ss);
            const float rstd = 1.0f / sqrtf(ss * (1.0f / DM) + EPS);
            f32x4 h[4];
#pragma unroll
            for (int j = 0; j < 4; ++j) { h[j] = v[j] * rstd * ga[j] + sh[j];
                if (f8out) { *(unsigned*)((unsigned char*)HM + (size_t)row * DM + 256 * j + 4 * lane) = pk_fp8x4(h[j][0], h[j][1], h[j][2], h[j][3]); }
                else { u32x2 w; w.x = cvt_pk_bf16(h[j][0], h[j][1]); w.y = cvt_pk_bf16(h[j][2], h[j][3]);
                    *(u32x2*)(HM + (size_t)row * DM + 256 * j + 4 * lane) = w; } }
            if constexpr (ROUTER) {
                float lg[8];
#pragma unroll
                for (int e = 0; e < 8; ++e) lg[e] = 0.f;
#pragma unroll
                for (int j = 0; j < 4; ++j)
#pragma unroll
                    for (int q = 0; q < 4; ++q) { const float hv = h[j][q]; const f32x4 r0 = rw[(j * 4 + q) * 2], r1 = rw[(j * 4 + q) * 2 + 1];
                        lg[0] += hv * r0[0]; lg[1] += hv * r0[1]; lg[2] += hv * r0[2]; lg[3] += hv * r0[3]; lg[4] += hv * r1[0]; lg[5] += hv * r1[1]; lg[6] += hv * r1[2]; lg[7] += hv * r1[3]; }
#pragma unroll
                for (int e = 0; e < 8; ++e) lg[e] = wave_sum(lg[e]);
                int e0 = 0; float v0 = lg[0];
#pragma unroll
                for (int e = 1; e < 8; ++e) if (lg[e] > v0) { v0 = lg[e]; e0 = e; }
                int e1 = -1; float v1 = -3.0e38f;
#pragma unroll
                for (int e = 0; e < 8; ++e) if (e != e0 && lg[e] > v1) { v1 = lg[e]; e1 = e; }
                const float p1 = frcp(1.0f + fexp(v1 - v0));
                if (lane == 0) { int* eid = (int*)(ws + TB_EID); float* gt = (float*)(ws + TB_GATE);
                    eid[row * 2] = e0; eid[row * 2 + 1] = e1; gt[row * 2] = p1; gt[row * 2 + 1] = 1.0f - p1;
                    atomicAdd((int*)&hist[e0], 1); atomicAdd((int*)&hist[e1], 1); }
            }
        }
        if constexpr (ROUTER) {
            __syncthreads();
            if (tid < 8) ((int*)(ws + TB_BCNT))[tb * 8 + tid] = hist[tid];
            __syncthreads();
        }
    }
}

namespace lru {
constexpr int XCF = 0, XCB = 16384, AA = 24576, UU = 40960;
__device__ __forceinline__ int sw256(int row, int cb) { return row * 256 + (cb ^ ((row & 15) << 4)); }
__device__ __forceinline__ int crow(int r, int hi) { return (r & 3) + 8 * (r >> 2) + 4 * hi; }
template <int MODE>
__device__ __forceinline__ void lru_item(const Args& A, LAS unsigned char* lds, int b, int n, int seg, int dir) {
    int tid_ = threadIdx.x; asm volatile("" : "+v"(tid_));
    const int tid = tid_, wid = tid >> 6, lane = tid & 63, r = lane & 31, hh = lane >> 5;
    unsigned char* ws = A.ws;
    const bf16_t* XB = (const bf16_t*)(ws + L_XB); const bf16_t* YB = (const bf16_t*)(ws + L_YB); bf16_t* HF = (bf16_t*)(ws + L_HF); bf16_t* HY = (bf16_t*)(ws + L_HY);
    const bf16_t* Wg = (const bf16_t*)(ws + W_LRG) + (size_t)((n * 2 + dir) * 256 + ((r < 16) ? (16 * wid + r) : (128 + 16 * wid + r - 16))) * 128 + 8 * hh;
    bf16x8 bfrag[8];
#pragma unroll
    for (int ks = 0; ks < 8; ++ks) bfrag[ks] = *(const bf16x8*)(Wg + 16 * ks);
    const int cch = n * 128 + 16 * wid + (r & 15);
    const float nba = -LOG2E * A.in[I_LRBA][dir * LRUW + cch], nbx = -LOG2E * A.in[I_LRBX][dir * LRUW + cch], csp = -8.0f * LOG2E * ((const float*)(ws + TB_SP))[dir * LRUW + cch];
    const int ct = tid >> 4, cg = tid & 15, cc0 = n * 128 + 8 * cg;
    float cw[4][8], cb[8];
#pragma unroll
    for (int j = 0; j < 8; ++j) { cb[j] = A.in[I_LRCB][cc0 + j];
#pragma unroll
        for (int w = 0; w < 4; ++w) cw[w][j] = A.in[I_LRCW][w * LRUW + cc0 + j]; }
    float carry = 0.f, P = 1.f;
    if (MODE != 0 && tid < 128) carry = ((const float*)(ws + TB_LCIN))[(size_t)((b * 32 + seg) * 2 + dir) * LRUW + n * 128 + tid];
    u32x4 xr[4];
#define LRU_XLOAD(si_) do { const int sub_ = dir ? (7 - (si_)) : (si_); const int tok_ = seg * 256 + sub_ * 32 + ct; \
        _Pragma("unroll") for (int w = 0; w < 4; ++w) { const int tt = tok_ - 1 + w; xr[w] = (tt >= 0 && tt < SEQ) ? *(const u32x4*)(XB + ((size_t)b * SEQ + tt) * LRUW + cc0) : (u32x4){0u, 0u, 0u, 0u}; } } while (0)
    LRU_XLOAD(0);
    for (int si = 0; si < 8; ++si) {
        const int sub = dir ? (7 - si) : si; const int t0 = seg * 256 + sub * 32;
        {
            float xc[8];
#pragma unroll
            for (int j = 0; j < 8; ++j) xc[j] = cb[j];
#pragma unroll
            for (int w = 0; w < 4; ++w) { const u32x4 v = xr[w];
#pragma unroll
                for (int e = 0; e < 4; ++e) { xc[2 * e] += cw[w][2 * e] * bflo(v[e]); xc[2 * e + 1] += cw[w][2 * e + 1] * bfhi(v[e]); } }
            if (si + 1 < 8) LRU_XLOAD(si + 1);
            *(LAS f32x4*)(lds + XCF + (ct * 128 + 8 * cg) * 4) = (f32x4){xc[0], xc[1], xc[2], xc[3]};
            *(LAS f32x4*)(lds + XCF + (ct * 128 + 8 * cg + 4) * 4) = (f32x4){xc[4], xc[5], xc[6], xc[7]};
            *(LAS u32x4*)(lds + XCB + sw256(ct, 16 * cg)) = (u32x4){cvt_pk_bf16(xc[0], xc[1]), cvt_pk_bf16(xc[2], xc[3]), cvt_pk_bf16(xc[4], xc[5]), cvt_pk_bf16(xc[6], xc[7])};
        }
        __syncthreads();
        {
            f32x16 acc = {};
#pragma unroll
            for (int ks = 0; ks < 8; ++ks) { const bf16x8 fa = *(const LAS bf16x8*)(lds + XCB + sw256(r, (16 * ks + 8 * hh) * 2)); acc = __builtin_amdgcn_mfma_f32_32x32x16_bf16(fa, bfrag[ks], acc, 0, 0, 0); }
#pragma unroll
            for (int q = 0; q < 8; ++q) {
                const auto sw = __builtin_amdgcn_permlane16_swap(__float_as_uint(acc[q]), __float_as_uint(acc[8 + q]), false, false);
                const float rp = __uint_as_float(sw[0]), ip = __uint_as_float(sw[1]);
                const int tq = crow((r < 16) ? q : (8 + q), hh); const int cl = 16 * wid + (r & 15);
                const float xcv = ((const LAS float*)(lds + XCF))[tq * 128 + cl];
                const float rg = frcp(1.0f + fexp2(fmaf(rp, -LOG2E, nba))), ig = frcp(1.0f + fexp2(fmaf(ip, -LOG2E, nbx)));
                const float av = fexp2(csp * rg), uv = __builtin_amdgcn_sqrtf(fmaxf(fmaf(-av, av, 1.0f), 0.f)) * ig * xcv;
                ((LAS float*)(lds + AA))[tq * 128 + cl] = av; ((LAS float*)(lds + UU))[tq * 128 + cl] = uv; }
        }
        __syncthreads();
        if (tid < 128) {
            LAS float* ap = (LAS float*)(lds + AA) + tid; LAS float* up = (LAS float*)(lds + UU) + tid; float av[32], uv[32];
#pragma unroll
            for (int i = 0; i < 32; ++i) { av[i] = ap[i * 128]; uv[i] = up[i * 128]; }
            if (dir == 0) {
#pragma unroll
                for (int i = 0; i < 32; ++i) { carry = av[i] * carry + uv[i]; if (MODE == 0) P *= av[i]; else uv[i] = carry; } }
            else {
#pragma unroll
                for (int i = 31; i >= 0; --i) { carry = av[i] * carry + uv[i]; if (MODE == 0) P *= av[i]; else uv[i] = carry; } }
            if (MODE != 0) {
#pragma unroll
                for (int i = 0; i < 32; ++i) up[i * 128] = uv[i]; }
        }
        if (MODE != 0) {
            __syncthreads();
            const int tok = t0 + ct; const size_t go = ((size_t)b * SEQ + tok) * LRUW + cc0;
            const f32x4 h0 = *(const LAS f32x4*)(lds + UU + (ct * 128 + 8 * cg) * 4), h1 = *(const LAS f32x4*)(lds + UU + (ct * 128 + 8 * cg + 4) * 4);
            if (MODE == 1) { *(u32x4*)(HF + go) = (u32x4){cvt_pk_bf16(h0[0], h0[1]), cvt_pk_bf16(h0[2], h0[3]), cvt_pk_bf16(h1[0], h1[1]), cvt_pk_bf16(h1[2], h1[3])}; }
            else { const u32x4 f = *(const u32x4*)(HF + go), y = *(const u32x4*)(YB + go);
                *(u32x4*)(HY + go) = (u32x4){cvt_pk_bf16((h0[0] + bflo(f[0])) * bflo(y[0]), (h0[1] + bfhi(f[0])) * bfhi(y[0])), cvt_pk_bf16((h0[2] + bflo(f[1])) * bflo(y[1]), (h0[3] + bfhi(f[1])) * bfhi(y[1])),
                                            cvt_pk_bf16((h1[0] + bflo(f[2])) * bflo(y[2]), (h1[1] + bfhi(f[2])) * bfhi(y[2])), cvt_pk_bf16((h1[2] + bflo(f[3])) * bflo(y[3]), (h1[3] + bfhi(f[3])) * bfhi(y[3]))}; }
        }
        __syncthreads();
    }
#undef LRU_XLOAD
    if (MODE == 0 && tid < 128) { float* sm = (float*)(ws + TB_LSUM) + (size_t)(((b * 32 + seg) * 2 + dir) * 2) * LRUW + n * 128 + tid; sm[0] = P; sm[LRUW] = carry; }
}
}
template <int MODE>
__device__ __forceinline__ void lru_phase(const Args& A, LAS unsigned char* lds, int bid, int G) {
    const int nitems = (MODE == 0) ? 5120 : 2560;
    for (int it = bid; it < nitems; it += G) {
        int b, n, seg, dir;
        if (MODE == 0) { dir = it & 1; const int r = it >> 1; seg = r & 31; n = (r >> 5) % 10; b = r / 320; }
        else { dir = MODE - 1; seg = it & 31; n = (it >> 5) % 10; b = it / 320; }
        lru::lru_item<MODE>(A, lds, b, n, seg, dir);
    }
}
__device__ __forceinline__ void lru_carry_phase(const Args& A, int bid, int G) {
    const float* sm = (const float*)(A.ws + TB_LSUM); float* cin = (float*)(A.ws + TB_LCIN);
    for (int idx = bid * NTHR + threadIdx.x; idx < NBATCH * 2 * LRUW; idx += G * NTHR) {
        const int b = idx / (2 * LRUW), r = idx % (2 * LRUW), dir = r / LRUW, ch = r % LRUW; float carry = 0.f;
        for (int i = 0; i < 32; ++i) { const int sg = dir ? (31 - i) : i; const size_t o = (size_t)((b * 32 + sg) * 2 + dir);
            cin[o * LRUW + ch] = carry; carry = sm[o * 2 * LRUW + ch] * carry + sm[o * 2 * LRUW + LRUW + ch]; }
    }
}

__device__ __forceinline__ void place_phase(const Args& A, LAS unsigned char* lds, int bid, int G) {
    int tid_ = threadIdx.x; asm volatile("" : "+v"(tid_));
    const int tid = tid_, lane = tid & 63, wave = tid >> 6; unsigned char* ws = A.ws;
    const int* bcnt = (const int*)(ws + TB_BCNT); const int* eid = (const int*)(ws + TB_EID); int* slot = (int*)(ws + TB_SLOT);
    const bf16_t* HM = (const bf16_t*)(ws + WS_HM); bf16_t* XS = (bf16_t*)(ws + E_XS);
    LAS int* tot = (LAS int*)lds; LAS int* pre = tot + 8; LAS int* rb = tot + 16; LAS int* wcn = tot + 32; LAS int* sl = tot + 64;
    for (int tb = bid; tb < MTOK / 256; tb += G) {
        { int t_ = 0, p_ = 0;
#pragma unroll
            for (int j = 0; j < 4; ++j) { const int blk = lane + 64 * j; const int v = bcnt[blk * 8 + wave]; t_ += v; p_ += (blk < tb) ? v : 0; }
#pragma unroll
            for (int o = 1; o < 64; o <<= 1) { t_ += __shfl_xor(t_, o); p_ += __shfl_xor(p_, o); }
            if (lane == 0) { tot[wave] = t_; pre[wave] = p_; } }
        __syncthreads();
        if (tid == 0) { int acc = 0; for (int e = 0; e < 8; ++e) { rb[e] = acc * 256; if (tb == 0) ((int*)(ws + TB_TILES))[e] = acc; acc += (tot[e] + 255) >> 8; } if (tb == 0) ((int*)(ws + TB_TILES))[8] = acc; }
        int e0 = -1, e1 = -1; unsigned long long mk0 = 0, mk1 = 0;
        if (tid < 256) { e0 = eid[(tb * 256 + tid) * 2]; e1 = eid[(tb * 256 + tid) * 2 + 1];
#pragma unroll
            for (int e = 0; e < 8; ++e) { const unsigned long long m = __ballot(e0 == e || e1 == e); if (lane == 0) wcn[wave * 8 + e] = __popcll(m); if (e0 == e) mk0 = m; if (e1 == e) mk1 = m; } }
        __syncthreads();
        if (tid < 256) { const unsigned long long lt = (1ull << lane) - 1ull; int b0 = rb[e0] + pre[e0] + __popcll(mk0 & lt), b1 = rb[e1] + pre[e1] + __popcll(mk1 & lt);
            for (int w = 0; w < wave; ++w) { b0 += wcn[w * 8 + e0]; b1 += wcn[w * 8 + e1]; }
            sl[tid * 2] = b0; sl[tid * 2 + 1] = b1; slot[(tb * 256 + tid) * 2] = b0; slot[(tb * 256 + tid) * 2 + 1] = b1; }
        __syncthreads();
        for (int i = 0; i < 32; ++i) { const int t = wave * 32 + i; const int s0 = sl[t * 2], s1 = sl[t * 2 + 1];
            const bf16_t* src = HM + (size_t)(tb * 256 + t) * DM + lane * 16;
            const u32x4 a = *(const u32x4*)src, b = *(const u32x4*)(src + 8);
            const u32x4 q = {pk_fp8x4(bflo(a[0]), bfhi(a[0]), bflo(a[1]), bfhi(a[1])), pk_fp8x4(bflo(a[2]), bfhi(a[2]), bflo(a[3]), bfhi(a[3])),
                             pk_fp8x4(bflo(b[0]), bfhi(b[0]), bflo(b[1]), bfhi(b[1])), pk_fp8x4(bflo(b[2]), bfhi(b[2]), bflo(b[3]), bfhi(b[3]))};
            *(u32x4*)((unsigned char*)XS + (size_t)s0 * DM + lane * 16) = q; *(u32x4*)((unsigned char*)XS + (size_t)s1 * DM + lane * 16) = q; }
        __syncthreads();
    }
}

namespace att {
constexpr int KVBLK = 64;
#define SBAR() __builtin_amdgcn_sched_barrier(0)
typedef int v8i __attribute__((ext_vector_type(8)));
__device__ __forceinline__ int crow(int r, int hi) { return (r & 3) + 8 * (r >> 2) + 4 * hi; }
constexpr int SLOTB = 8192;
__device__ __forceinline__ int k_slot(int s) { return s * SLOTB; }
__device__ __forceinline__ int v_slot(int s) { return 65536 + s * SLOTB; }
__device__ __forceinline__ int kswz(int row) { return ((row & 7) ^ (row >> 4)) & 7; }
__device__ __forceinline__ int vswz(int row) { return (row >> 2) & 3; }
__device__ __forceinline__ void mfma8_acc(f32x16& acc, const v8i& a, const v8i& b, int sc) {
    asm volatile("s_nop 4\n\tv_mfma_scale_f32_32x32x64_f8f6f4 %0, %1, %2, %0, %3, %3 op_sel_hi:[0,0,0]" : "+v"(acc) : "v"(a), "v"(b), "v"(sc) : "memory");
}
__device__ __forceinline__ void mfma8_c(f32x16& d, const v8i& a, const v8i& b, const f32x16& c, int sa, int sb) {
    asm volatile("v_mfma_scale_f32_32x32x64_f8f6f4 %0, %1, %2, %3, %4, %5 op_sel_hi:[0,0,0]" : "=&v"(d) : "v"(a), "v"(b), "v"(c), "v"(sa), "v"(sb) : "memory");
}
#define ATT_LD8(p0_, p1_) __builtin_bit_cast(v8i, __builtin_shufflevector(*(const LAS u32x4*)(p0_), *(const LAS u32x4*)(p1_), 0, 1, 2, 3, 4, 5, 6, 7))
__device__ __forceinline__ void qkt(f32x16& p0, f32x16& p1, const LAS char* Ks, const v8i& qr, int r32, int hi, int jj, const f32x16& cinit, int s1, int s8) {
    const int c0 = jj * 4 + 2 * hi;
    { const int row = r32; const v8i kf = ATT_LD8(Ks + row * 128 + ((c0 ^ kswz(row)) << 4), Ks + row * 128 + (((c0 + 1) ^ kswz(row)) << 4)); mfma8_c(p0, kf, qr, cinit, s1, s8); }
    { const int row = 32 + r32; const v8i kf = ATT_LD8(Ks + row * 128 + ((c0 ^ kswz(row)) << 4), Ks + row * 128 + (((c0 + 1) ^ kswz(row)) << 4)); mfma8_c(p1, kf, qr, cinit, s1, s8); }
}
__device__ __forceinline__ void load_kf(v8i& kf0, v8i& kf1, const LAS char* Ks, int r32, int hi, int jj) {
    const int c0 = jj * 4 + 2 * hi, row1 = 32 + r32;
    kf0 = ATT_LD8(Ks + r32 * 128 + ((c0 ^ kswz(r32)) << 4), Ks + r32 * 128 + (((c0 + 1) ^ kswz(r32)) << 4));
    kf1 = ATT_LD8(Ks + row1 * 128 + ((c0 ^ kswz(row1)) << 4), Ks + row1 * 128 + (((c0 + 1) ^ kswz(row1)) << 4));
}
#define ATT_VFR(Vs, d0) ATT_LD8((Vs) + (32 * (d0) + r32) * 64 + (((2 * hi) ^ vswz(32 * (d0) + r32)) << 4), (Vs) + (32 * (d0) + r32) * 64 + (((2 * hi + 1) ^ vswz(32 * (d0) + r32)) << 4))
__device__ __forceinline__ void pack_p(const float (&pe)[32], v8i& pa);
__device__ __forceinline__ void qkt_pack(f32x16& p0, f32x16& p1, const v8i& kf0, const v8i& kf1, const v8i& qr, const f32x16& cinit, int s1, int s8, const float (&pe)[32], v8i& pa) {
#define ATT_MC8(d, kf, B, O0, O1, O2, O3) \
    asm volatile("v_mfma_scale_f32_32x32x64_f8f6f4 %0, %21, %22, %23, %24, %25 op_sel_hi:[0,0,0]\n\t" \
                 "v_cvt_pk_fp8_f32 %1, %5, %6\n\tv_cvt_pk_fp8_f32 %1, %7, %8 op_sel:[0,0,1]\n\t" \
                 "v_cvt_pk_fp8_f32 %2, %9, %10\n\tv_cvt_pk_fp8_f32 %2, %11, %12 op_sel:[0,0,1]\n\t" \
                 "v_cvt_pk_fp8_f32 %3, %13, %14\n\tv_cvt_pk_fp8_f32 %3, %15, %16 op_sel:[0,0,1]\n\t" \
                 "v_cvt_pk_fp8_f32 %4, %17, %18\n\tv_cvt_pk_fp8_f32 %4, %19, %20 op_sel:[0,0,1]" \
                 : "=&v"(d), "=&v"(O0), "=&v"(O1), "=&v"(O2), "=&v"(O3) \
                 : "v"(pe[B]), "v"(pe[B + 1]), "v"(pe[B + 2]), "v"(pe[B + 3]), "v"(pe[B + 4]), "v"(pe[B + 5]), "v"(pe[B + 6]), "v"(pe[B + 7]), \
                   "v"(pe[B + 8]), "v"(pe[B + 9]), "v"(pe[B + 10]), "v"(pe[B + 11]), "v"(pe[B + 12]), "v"(pe[B + 13]), "v"(pe[B + 14]), "v"(pe[B + 15]), \
                   "v"(kf), "v"(qr), "v"(cinit), "v"(s1), "v"(s8) : "memory")
    int q0, q1, q2, q3, q4, q5, q6, q7;
    ATT_MC8(p0, kf0, 0, q0, q1, q2, q3);
    ATT_MC8(p1, kf1, 16, q4, q5, q6, q7);
#undef ATT_MC8
    pa = (v8i){q0, q1, q2, q3, q4, q5, q6, q7};
}
__device__ __forceinline__ void partialSM(f32x16& p0) {
#pragma unroll
    for (int r = 0; r < 16; ++r) p0[r] = fexp2(p0[r]);
}
__device__ __forceinline__ void finishSM(f32x16& p0, f32x16& p1, v8i& pa) {
#pragma unroll
    for (int r = 0; r < 16; ++r) p1[r] = fexp2(p1[r]);
#pragma unroll
    for (int w = 0; w < 4; ++w) { pa[w] = (int)pk_fp8x4(p0[4 * w], p0[4 * w + 1], p0[4 * w + 2], p0[4 * w + 3]); pa[4 + w] = (int)pk_fp8x4(p1[4 * w], p1[4 * w + 1], p1[4 * w + 2], p1[4 * w + 3]); }
}
#define ATT_MX7(acc, a, b, sc, NOP, O, I, k) \
    asm volatile(NOP "v_mfma_scale_f32_32x32x64_f8f6f4 %0, %15, %16, %0, %17, %17 op_sel_hi:[0,0,0]\n\tv_exp_f32 %1, %8\n\tv_exp_f32 %2, %9\n\tv_exp_f32 %3, %10\n\tv_exp_f32 %4, %11\n\tv_exp_f32 %5, %12\n\tv_exp_f32 %6, %13\n\tv_exp_f32 %7, %14" \
                 : "+v"(acc), "=&v"(O[k]), "=&v"(O[k + 1]), "=&v"(O[k + 2]), "=&v"(O[k + 3]), "=&v"(O[k + 4]), "=&v"(O[k + 5]), "=&v"(O[k + 6]) \
                 : "v"(I(k)), "v"(I(k + 1)), "v"(I(k + 2)), "v"(I(k + 3)), "v"(I(k + 4)), "v"(I(k + 5)), "v"(I(k + 6)), "v"(a), "v"(b), "v"(sc) : "memory")
__device__ __forceinline__ void pv_exp(f32x16* o, f32x16& lacc, const v8i& ones, const v8i& vf0, const v8i& vf1, const v8i& vf2, const v8i& vf3, const v8i& pa, int s1, const f32x16& r0, const f32x16& r1, float (&pe)[32]) {
#define ATT_RI(k) (((k) < 16) ? r0[(k) & 15] : r1[(k) & 15])
    ATT_MX7(o[0], pa, vf0, s1, "s_nop 4\n\t", pe, ATT_RI, 0);
    ATT_MX7(o[1], pa, vf1, s1, "", pe, ATT_RI, 7);
    ATT_MX7(o[2], pa, vf2, s1, "", pe, ATT_RI, 14);
    ATT_MX7(o[3], pa, vf3, s1, "", pe, ATT_RI, 21);
    asm volatile("v_mfma_scale_f32_32x32x64_f8f6f4 %0, %9, %10, %0, %11, %11 op_sel_hi:[0,0,0]\n\tv_exp_f32 %1, %5\n\tv_exp_f32 %2, %6\n\tv_exp_f32 %3, %7\n\tv_exp_f32 %4, %8"
                 : "+v"(lacc), "=&v"(pe[28]), "=&v"(pe[29]), "=&v"(pe[30]), "=&v"(pe[31]) : "v"(r1[12]), "v"(r1[13]), "v"(r1[14]), "v"(r1[15]), "v"(pa), "v"(ones), "v"(s1) : "memory");
#undef ATT_RI
}
__device__ __forceinline__ void pack_p(const float (&pe)[32], v8i& pa) {
#pragma unroll
    for (int w = 0; w < 8; ++w) pa[w] = (int)pk_fp8x4(pe[4 * w], pe[4 * w + 1], pe[4 * w + 2], pe[4 * w + 3]);
}
__device__ __forceinline__ void pv_d0(f32x16* o, f32x16& lacc, const v8i& ones, const LAS char* Vs, const v8i& pa, int r32, int hi, int s1) {
#pragma unroll
    for (int d0 = 0; d0 < 4; ++d0) { const int row = 32 * d0 + r32;
        const v8i vf = ATT_LD8(Vs + row * 64 + (((2 * hi) ^ vswz(row)) << 4), Vs + row * 64 + (((2 * hi + 1) ^ vswz(row)) << 4));
        mfma8_acc(o[d0], pa, vf, s1); }
    mfma8_acc(lacc, pa, ones, s1);
}
__device__ __forceinline__ void pv_last(f32x16* o, f32x16& lacc, const v8i& ones, const v8i& vf0, const v8i& vf1, const v8i& vf2, const v8i& vf3, const v8i& pa, int s1) {
    mfma8_acc(o[0], pa, vf0, s1); mfma8_acc(o[1], pa, vf1, s1); mfma8_acc(o[2], pa, vf2, s1); mfma8_acc(o[3], pa, vf3, s1); mfma8_acc(lacc, pa, ones, s1);
}
}

__device__ __forceinline__ void vt_phase(const Args& A, int bid, int G) {
    const int tid = threadIdx.x; unsigned char* ws = A.ws;
    const bf16_t* V = (const bf16_t*)(ws + A_V); unsigned char* VT = ws + A_VT;
    const int dv = tid & 127, kq = tid >> 7, half = kq >> 1, hi = kq & 1;
    for (int it = bid; it < 64 * 128; it += G) {
        const int bh = it >> 7, tile = it & 127, b = bh >> 3, h = bh & 7;
        const bf16_t* vp = V + ((size_t)b * SEQ + tile * 64 + 32 * half) * DM + h * 128 + dv;
        float f[16];
#pragma unroll
        for (int i = 0; i < 16; ++i) f[i] = bf2f(vp[(size_t)att::crow(i, hi) * DM]);
        *(u32x4*)(VT + (((size_t)bh * 128 + dv) * 128 + tile) * 64 + hi * 32 + half * 16) =
            (u32x4){pk_fp8x4(f[0], f[1], f[2], f[3]), pk_fp8x4(f[4], f[5], f[6], f[7]), pk_fp8x4(f[8], f[9], f[10], f[11]), pk_fp8x4(f[12], f[13], f[14], f[15])};
    }
}

__device__ __forceinline__ void attn_phase(const Args& A, LAS unsigned char* ldsu, int bid, int G, int al) {
    using namespace att;
    LAS char* lds = (LAS char*)ldsu;
    unsigned char* ws = A.ws;
    const unsigned char* Qg = ws + A_Q; const unsigned char* Kg = ws + A_K; const unsigned char* VTg = ws + A_VT;
    bf16_t* Og = (bf16_t*)(ws + WS_HM);
    const float* scal = (const float*)(ws + TB_SCAL);
    const float lamv = scal[SC_LAM0 + al], omli = scal[SC_OML0 + al], Mc = scal[SC_MC0 + al] - 7.5f;
    const float* subg = A.in[I_ATSUB] + al * 128;
    int tid_ = threadIdx.x; asm volatile("" : "+v"(tid_));
    const int tid = tid_, wid = __builtin_amdgcn_readfirstlane(tid >> 6), lane = tid & 63, r32 = lane & 31, hi = lane >> 5, jj = wid >> 2, wq = wid & 3;
    constexpr int NT = SEQ / KVBLK;
    int s1 = 0x7f7f7f7f, s8 = 0x7c7c7c7c; asm volatile("" : "+v"(s1), "+v"(s8));
    v8i ones; { int o1 = 0x38383838; asm volatile("" : "+v"(o1)); ones = (v8i){o1, o1, o1, o1, o1, o1, o1, o1}; }
    f32x16 cinit;
#pragma unroll
    for (int r = 0; r < 16; ++r) cinit[r] = -Mc;
    unsigned koff, voff;
    { const int bb = wid * 1024 + lane * 16;
      { const int row = bb >> 7, c = ((bb & 127) >> 4) ^ kswz(row); koff = (unsigned)(row * 1024 + c * 16); }
      { const int row = bb >> 6, c = ((bb & 63) >> 4) ^ vswz(row); voff = (unsigned)(row * 8192 + c * 16); } }
    const unsigned ldsw = (unsigned)wid * 1024u;
#define ATT_DMA(slot, kt, vt) do { \
        __builtin_amdgcn_global_load_lds((const unsigned*)((const unsigned char*)(kt) + koff), (LAS unsigned*)(lds + k_slot(slot) + ldsw), 16, 0, 0); \
        __builtin_amdgcn_global_load_lds((const unsigned*)((const unsigned char*)(vt) + voff), (LAS unsigned*)(lds + v_slot(slot) + ldsw), 16, 0, 0); } while (0)
#define ATT_TOP() do { asm volatile("s_waitcnt vmcnt(4)" ::: "memory"); __builtin_amdgcn_s_barrier(); asm volatile("" ::: "memory"); } while (0)
    const int xq = bid & 7, cq = bid >> 3;
    int cbh = xq * 8;
    const bool lag = (jj != 0);
#define ATT_KB(bh_) (Kg + ((size_t)((bh_) >> 3) * SEQ) * DM + ((bh_) & 7) * 128)
#define ATT_VB(bh_) (VTg + (size_t)(bh_) * 128 * 8192)
    ATT_DMA(0, ATT_KB(cbh), ATT_VB(cbh)); ATT_DMA(1, ATT_KB(cbh) + (size_t)64 * DM, ATT_VB(cbh) + 64); ATT_DMA(2, ATT_KB(cbh) + (size_t)128 * DM, ATT_VB(cbh) + 128);
    int ofKa, ofKb, ofV, ofKax, ofKbx, ofVx;
    { const int c0 = jj * 4 + 2 * hi, lb = (int)(unsigned)(size_t)lds;
      ofKa = r32 * 128 + ((c0 ^ kswz(r32)) << 4); ofKb = (32 + r32) * 128 + ((c0 ^ kswz(32 + r32)) << 4); ofV = 65536 + r32 * 64 + (((2 * hi) ^ vswz(r32)) << 4);
      ofKax = lb + (ofKa ^ 16); ofKbx = lb + (ofKb ^ 16); ofVx = lb + (ofV ^ 16); ofKa += lb; ofKb += lb; ofV += lb; }
    for (int ui = 0; ui < 16; ++ui) {
        const int qb = (ui & 1) * 32 + cq;
        const int nbh = (ui + 1 < 16) ? xq * 8 + ((ui + 1) >> 1) : cbh;
        const unsigned char* Kh = ATT_KB(cbh); const unsigned char* Vh = ATT_VB(cbh); const unsigned char* nK = ATT_KB(nbh); const unsigned char* nV = ATT_VB(nbh);
        const size_t obase = ((size_t)(cbh >> 3) * SEQ + qb * 128) * DM + (cbh & 7) * 128;
        f32x16 lacc = {}; f32x16 o[4] = {}; v8i qr;
        { const unsigned char* Qw = Qg + obase + (size_t)(wq * 32 + r32) * DM + jj * 64 + hi * 32;
          const u32x4 qa = *(const u32x4*)Qw, qb2 = *(const u32x4*)(Qw + 16);
          qr = __builtin_bit_cast(v8i, __builtin_shufflevector(qa, qb2, 0, 1, 2, 3, 4, 5, 6, 7)); }
        f32x16 pA0, pA1; v8i pa, kf0, kf1, vf0, vf1, vf2, vf3;
        const unsigned char* kptr = Kh + (size_t)3 * 64 * DM; const unsigned char* vptr = Vh + 3 * 64;
#define ATT_ISSUE(SLD, last) do { asm volatile("" : "+s"(kptr), "+s"(vptr)); ATT_DMA(SLD, kptr, vptr); if (last) { kptr = nK; vptr = nV; } else { kptr += (size_t)64 * DM; vptr += 64; } } while (0)
#define ATT_RD8(b_, bx_, imm_) ATT_LD8((const LAS char*)(unsigned)((b_) + (imm_)), (const LAS char*)(unsigned)((bx_) + (imm_)))
#define ATT_FIX() asm volatile("" : "+v"(ofKa), "+v"(ofKax), "+v"(ofKb), "+v"(ofKbx), "+v"(ofV), "+v"(ofVx))
#define ATT_STEPC(LAST, SL, SLP, SLD) do { \
            ATT_FIX(); \
            ATT_TOP(); \
            kf0 = ATT_RD8(ofKa, ofKax, (SL) * SLOTB); kf1 = ATT_RD8(ofKb, ofKbx, (SL) * SLOTB); vf0 = ATT_RD8(ofV, ofVx, (SLP) * SLOTB); vf1 = ATT_RD8(ofV, ofVx, (SLP) * SLOTB + 2048); \
            ATT_ISSUE(SLD, LAST); \
            ATT_TOP(); \
            qkt_pack(pA0, pA1, kf0, kf1, qr, cinit, s1, s8, pe, pa); \
            vf2 = ATT_RD8(ofV, ofVx, (SLP) * SLOTB + 4096); vf3 = ATT_RD8(ofV, ofVx, (SLP) * SLOTB + 6144); \
            pv_exp(o, lacc, ones, vf0, vf1, vf2, vf3, pa, s1, pA0, pA1, pe); } while (0)
        float pe[32];
        if (lag) ATT_TOP();
        ATT_TOP();
        ATT_FIX(); kf0 = ATT_RD8(ofKa, ofKax, 0); kf1 = ATT_RD8(ofKb, ofKbx, 0); ATT_ISSUE(3, false);
        ATT_TOP();
        { mfma8_c(pA0, kf0, qr, cinit, s1, s8); mfma8_c(pA1, kf1, qr, cinit, s1, s8);
          asm volatile("s_nop 15\n\ts_nop 15" ::: "memory");
#pragma unroll
          for (int r = 0; r < 16; ++r) pe[r] = fexp2(pA0[r]);
#pragma unroll
          for (int r = 0; r < 16; ++r) pe[16 + r] = fexp2(pA1[r]); }
        ATT_STEPC(false, 1, 0, 4); ATT_STEPC(false, 2, 1, 5); ATT_STEPC(false, 3, 2, 6); ATT_STEPC(false, 4, 3, 7); ATT_STEPC(false, 5, 4, 0); ATT_STEPC(false, 6, 5, 1); ATT_STEPC(false, 7, 6, 2);
        for (int kb = 8; kb < NT; kb += 8) {
            ATT_STEPC(false, 0, 7, 3); ATT_STEPC(false, 1, 0, 4); ATT_STEPC(false, 2, 1, 5); ATT_STEPC(false, 3, 2, 6);
            ATT_STEPC(kb == NT - 8, 4, 3, 7); ATT_STEPC(false, 5, 4, 0); ATT_STEPC(false, 6, 5, 1); ATT_STEPC(false, 7, 6, 2);
        }
        ATT_TOP();
        ATT_FIX();
        vf0 = ATT_RD8(ofV, ofVx, 7 * SLOTB); vf1 = ATT_RD8(ofV, ofVx, 7 * SLOTB + 2048);
        ATT_TOP();
        { vf2 = ATT_RD8(ofV, ofVx, 7 * SLOTB + 4096); vf3 = ATT_RD8(ofV, ofVx, 7 * SLOTB + 6144);
          pack_p(pe, pa); SBAR();
          pv_last(o, lacc, ones, vf0, vf1, vf2, vf3, pa, s1);
          asm volatile("s_nop 15\n\ts_nop 15" ::: "memory"); }
        if (!lag) ATT_TOP();
#undef ATT_ISSUE
#undef ATT_STEPC
#undef ATT_RD8
#undef ATT_FIX
        int r32e = r32, hie = hi; asm volatile("" : "+v"(r32e), "+v"(hie));
        float rli[16];
#pragma unroll
        for (int r = 0; r < 16; ++r) rli[r] = frcp(lacc[r]);
        asm volatile("s_waitcnt lgkmcnt(0)" ::: "memory"); __builtin_amdgcn_s_barrier(); asm volatile("" ::: "memory");
        LAS float* Cb = (LAS float*)(lds + ((wq < 2) ? 3 * SLOTB : 65536 + 3 * SLOTB - 64 * 512));
        if (jj == 1) {
#pragma unroll
            for (int r = 0; r < 16; ++r) { const float sc = rli[r] * lamv;
#pragma unroll
                for (int d0 = 0; d0 < 4; ++d0) Cb[(wq * 32 + crow(r, hie)) * 128 + d0 * 32 + r32e] = o[d0][r] * sc; }
        }
        asm volatile("s_waitcnt lgkmcnt(0)" ::: "memory"); __builtin_amdgcn_s_barrier(); asm volatile("" ::: "memory");
        if (jj == 0) {
            float g[4];
#pragma unroll
            for (int d0 = 0; d0 < 4; ++d0) g[d0] = subg[d0 * 32 + r32e] * omli;
            bf16_t* Ob = Og + obase;
#pragma unroll
            for (int r = 0; r < 16; ++r) {
                float ss = 0.f;
#pragma unroll
                for (int d0 = 0; d0 < 4; ++d0) { const float v = o[d0][r] * rli[r] - Cb[(wq * 32 + crow(r, hie)) * 128 + d0 * 32 + r32e]; o[d0][r] = v; ss += v * v; }
                ss += __shfl_xor(ss, 1); ss += __shfl_xor(ss, 2); ss += __shfl_xor(ss, 4); ss += __shfl_xor(ss, 8); ss += __shfl_xor(ss, 16);
                const float rs = 1.0f / sqrtf(ss * (1.0f / 128.0f) + EPS);
                bf16_t* op = Ob + (size_t)(wq * 32 + crow(r, hie)) * DM + r32e;
#pragma unroll
                for (int d0 = 0; d0 < 4; ++d0) op[d0 * 32] = (bf16_t)f2bf(o[d0][r] * rs * g[d0]);
            }
        }
        asm volatile("s_waitcnt lgkmcnt(0)" ::: "memory"); __builtin_amdgcn_s_barrier(); asm volatile("" ::: "memory");
        cbh = nbh;
    }
    asm volatile("s_waitcnt vmcnt(0) lgkmcnt(0)" ::: "memory"); __builtin_amdgcn_s_barrier(); asm volatile("" ::: "memory");
#undef ATT_DMA
#undef ATT_TOP
#undef ATT_KB
#undef ATT_VB
#undef ATT_LD8
}

namespace gla {
constexpr int BC = 0, QI = 32768, QA = 49152, KA = 65536, KST = 81920, VT = 98304, ST = 106496, AT = 122880, EM = 131072, EL = EM + 512, DD = EM + 1024, BMID = EM + 1536, SEG = EM + 2048;
static_assert(SEG + 2048 <= RING_BYTES, "gla lds");
__device__ __forceinline__ int sw256(int row, int cb) { return row * 256 + (cb ^ ((row & 15) << 4)); }
__device__ __forceinline__ int sw128(int row, int cb) { return row * 128 + (cb ^ ((((row & 7) ^ (row >> 4)) & 7) << 4)); }
__device__ __forceinline__ int crow(int r, int hi) { return (r & 3) + 8 * (r >> 2) + 4 * hi; }
__device__ __forceinline__ float h2f(unsigned short b) { return (float)__builtin_bit_cast(_Float16, b); }
__device__ __forceinline__ void gla_item(const bf16_t* __restrict__ Qp, const unsigned short* __restrict__ LFp, const bf16_t* __restrict__ Vp, bf16_t* __restrict__ Op, int dir, LAS unsigned char* lds, float* dbg) {
    int tid_ = threadIdx.x; asm volatile("" : "+v"(tid_));
    const int tid = tid_, wid = tid >> 6, lane = tid & 63, r = lane & 31, hh = lane >> 5;
    const int t1 = tid >> 3, kg = tid & 7, k0 = 16 * kg, v0 = (tid & 7) * 8;
    for (int i = tid; i < 16384 / 16; i += NTHR) *(LAS u32x4*)(lds + ST + i * 16) = (u32x4){0u, 0u, 0u, 0u};
    f32x16 st = {};
    u32x4 rq[2], rl[2], rv;
#define GLA_TOK(ci, i) (dir ? (SEQ - 1 - ((ci) * 64 + (i))) : ((ci) * 64 + (i)))
#define GLA_LOAD(ci) do { const size_t to = (size_t)GLA_TOK(ci, t1) * DM; \
        rq[0] = *(const u32x4*)(Qp + to + k0); rq[1] = *(const u32x4*)(Qp + to + k0 + 8); \
        rl[0] = *(const u32x4*)(LFp + to + k0); rl[1] = *(const u32x4*)(LFp + to + k0 + 8); rv = *(const u32x4*)(Vp + to + v0); } while (0)
    GLA_LOAD(0);
    __syncthreads();
    for (int ci = 0; ci < SEQ / 64; ++ci) {
        float qf[16], lf[16]; u32x4 vreg = rv;
#pragma unroll
        for (int j = 0; j < 2; ++j)
#pragma unroll
            for (int e = 0; e < 4; ++e) { qf[j * 8 + 2 * e] = bflo(rq[j][e]); qf[j * 8 + 2 * e + 1] = bfhi(rq[j][e]);
                lf[j * 8 + 2 * e] = h2f((unsigned short)(rl[j][e] & 0xffffu)); lf[j * 8 + 2 * e + 1] = h2f((unsigned short)(rl[j][e] >> 16)); }
        if (ci + 1 < SEQ / 64) GLA_LOAD(ci + 1);
#pragma unroll
        for (int j = 0; j < 4; ++j) *(LAS f32x4*)(lds + BC + (t1 * 128 + k0 + 4 * j) * 4) = (f32x4){lf[4 * j], lf[4 * j + 1], lf[4 * j + 2], lf[4 * j + 3]};
        __syncthreads();
        { const int kc = tid & 127, sg = tid >> 7; LAS float* bc = (LAS float*)(lds + BC) + kc; float cs[16];
#pragma unroll
            for (int i = 0; i < 16; ++i) cs[i] = bc[(sg * 16 + i) * 128];
#pragma unroll
            for (int i = 1; i < 16; ++i) cs[i] += cs[i - 1];
            ((LAS float*)(lds + SEG))[sg * 128 + kc] = cs[15];
            __syncthreads();
            const LAS float* sgp = (const LAS float*)(lds + SEG) + kc; const float s0 = sgp[0], s1 = sgp[128], s2 = sgp[256], s3 = sgp[384];
            const float off = sg == 0 ? 0.f : sg == 1 ? s0 : sg == 2 ? (s0 + s1) : ((s0 + s1) + s2);
#pragma unroll
            for (int i = 0; i < 16; ++i) bc[(sg * 16 + i) * 128] = cs[i] + off;
            if (sg == 0) { const float bm = s0 + s1, bl = ((s0 + s1) + s2) + s3;
                ((LAS float*)(lds + BMID))[kc] = bm; ((LAS float*)(lds + EM))[kc] = fexp(bm); ((LAS float*)(lds + EL))[kc] = fexp(bl - bm); ((LAS float*)(lds + DD))[kc] = fexp(bl); }
            __syncthreads();
        }
#ifdef DIAG
        if (dbg && ci == 0) { for (int i = tid; i < 8192; i += NTHR) dbg[i] = ((const LAS float*)(lds + BC))[i]; }
#endif
        {
            unsigned wqi[8], wqa[8], wka[8]; float ksv[16];
#pragma unroll
            for (int j = 0; j < 4; ++j) {
                const f32x4 bt = *(const LAS f32x4*)(lds + BC + (t1 * 128 + k0 + 4 * j) * 4), bm = *(const LAS f32x4*)(lds + BMID + (k0 + 4 * j) * 4);
                const f32x4 em = *(const LAS f32x4*)(lds + EM + (k0 + 4 * j) * 4), el = *(const LAS f32x4*)(lds + EL + (k0 + 4 * j) * 4);
                float qi[4], qa[4], ka[4];
#pragma unroll
                for (int e = 0; e < 4; ++e) { const int i = 4 * j + e; const float e1 = fexp(bt[e] - bm[e]), r1 = frcp(e1);
                    qa[e] = qf[i] * e1; qi[e] = qa[e] * em[e]; const float kk = 1.0f - fexp(lf[i]); ka[e] = kk * r1; ksv[i] = ka[e] * el[e]; }
                wqi[2 * j] = cvt_pk_bf16(qi[0], qi[1]); wqi[2 * j + 1] = cvt_pk_bf16(qi[2], qi[3]);
                wqa[2 * j] = cvt_pk_bf16(qa[0], qa[1]); wqa[2 * j + 1] = cvt_pk_bf16(qa[2], qa[3]);
                wka[2 * j] = cvt_pk_bf16(ka[0], ka[1]); wka[2 * j + 1] = cvt_pk_bf16(ka[2], ka[3]);
            }
#pragma unroll
            for (int j = 0; j < 2; ++j) { const int off = sw256(t1, (k0 + 8 * j) * 2);
                *(LAS u32x4*)(lds + QI + off) = (u32x4){wqi[4 * j], wqi[4 * j + 1], wqi[4 * j + 2], wqi[4 * j + 3]};
                *(LAS u32x4*)(lds + QA + off) = (u32x4){wqa[4 * j], wqa[4 * j + 1], wqa[4 * j + 2], wqa[4 * j + 3]};
                *(LAS u32x4*)(lds + KA + off) = (u32x4){wka[4 * j], wka[4 * j + 1], wka[4 * j + 2], wka[4 * j + 3]}; }
#pragma unroll
            for (int i = 0; i < 16; ++i) *(LAS unsigned short*)(lds + KST + sw128(k0 + i, t1 * 2)) = (unsigned short)f2bf(ksv[i]);
#pragma unroll
            for (int e = 0; e < 4; ++e) { *(LAS unsigned short*)(lds + VT + sw128(v0 + 2 * e, t1 * 2)) = (unsigned short)(vreg[e] & 0xffffu);
                *(LAS unsigned short*)(lds + VT + sw128(v0 + 2 * e + 1, t1 * 2)) = (unsigned short)(vreg[e] >> 16); }
        }
        __syncthreads();
        f32x16 oacc = {};
        const int w4 = wid & 3, t_i = w4 >> 1, v_i = w4 & 1;
        if (wid < 4) {
            const int s_i = wid >> 1, tq = wid & 1; f32x16 a = {};
#pragma unroll
            for (int ks = 0; ks < 8; ++ks) { const bf16x8 fa = *(const LAS bf16x8*)(lds + KA + sw256(32 * s_i + r, (16 * ks + 8 * hh) * 2)), fb = *(const LAS bf16x8*)(lds + QA + sw256(32 * tq + r, (16 * ks + 8 * hh) * 2));
                a = __builtin_amdgcn_mfma_f32_32x32x16_bf16(fa, fb, a, 0, 0, 0); }
            const int tg = 32 * tq + r;
#pragma unroll
            for (int g = 0; g < 4; ++g) { float m[4];
#pragma unroll
                for (int e = 0; e < 4; ++e) { const int sgl = 32 * s_i + 8 * g + 4 * hh + e; m[e] = (sgl <= tg) ? a[4 * g + e] : 0.f; }
                *(LAS u32x2*)(lds + AT + sw128(tg, (32 * s_i + 8 * g + 4 * hh) * 2)) = (u32x2){cvt_pk_bf16(m[0], m[1]), cvt_pk_bf16(m[2], m[3])}; }
        } else {
#pragma unroll
            for (int ks = 0; ks < 8; ++ks) { const bf16x8 fa = *(const LAS bf16x8*)(lds + QI + sw256(32 * t_i + r, (16 * ks + 8 * hh) * 2)), fb = *(const LAS bf16x8*)(lds + ST + sw256(32 * v_i + r, (16 * ks + 8 * hh) * 2));
                oacc = __builtin_amdgcn_mfma_f32_32x32x16_bf16(fa, fb, oacc, 0, 0, 0); }
        }
        __syncthreads();
#ifdef DIAG
        if (dbg && ci == 0) { for (int i = tid; i < 2048; i += NTHR) { ((unsigned*)dbg)[8192 + i] = ((const LAS unsigned*)(lds + AT))[i]; ((unsigned*)dbg)[8192 + 2048 + i] = ((const LAS unsigned*)(lds + VT))[i]; } }
#endif
        if (wid >= 4) {
#pragma unroll
            for (int ks = 0; ks < 4; ++ks) { const bf16x8 fa = *(const LAS bf16x8*)(lds + AT + sw128(32 * t_i + r, (16 * ks + 8 * hh) * 2)), fb = *(const LAS bf16x8*)(lds + VT + sw128(32 * v_i + r, (16 * ks + 8 * hh) * 2));
                oacc = __builtin_amdgcn_mfma_f32_32x32x16_bf16(fa, fb, oacc, 0, 0, 0); }
#pragma unroll
            for (int i = 0; i < 16; ++i) { const int t = 32 * t_i + crow(i, hh); Op[(size_t)GLA_TOK(ci, t) * DM + 32 * v_i + r] = (bf16_t)f2bf(oacc[i]); }
        }
        {
            const int kq = wid >> 1, vq = wid & 1;
#pragma unroll
            for (int i = 0; i < 16; ++i) st[i] *= ((const LAS float*)(lds + DD))[32 * kq + crow(i, hh)];
#pragma unroll
            for (int ks = 0; ks < 4; ++ks) { const bf16x8 fa = *(const LAS bf16x8*)(lds + KST + sw128(32 * kq + r, (16 * ks + 8 * hh) * 2)), fb = *(const LAS bf16x8*)(lds + VT + sw128(32 * vq + r, (16 * ks + 8 * hh) * 2));
                st = __builtin_amdgcn_mfma_f32_32x32x16_bf16(fa, fb, st, 0, 0, 0); }
#pragma unroll
            for (int g = 0; g < 4; ++g) *(LAS u32x2*)(lds + ST + sw256(32 * vq + r, (32 * kq + 8 * g + 4 * hh) * 2)) = (u32x2){cvt_pk_bf16(st[4 * g], st[4 * g + 1]), cvt_pk_bf16(st[4 * g + 2], st[4 * g + 3])};
        }
        __syncthreads();
#ifdef DIAG
        if (dbg && ci == 0) { for (int i = tid; i < 4096; i += NTHR) { ((unsigned*)dbg)[12288 + i] = ((const LAS unsigned*)(lds + ST))[i]; ((unsigned*)dbg)[16384 + i] = ((const LAS unsigned*)(lds + KST))[i]; } }
#endif
    }
#undef GLA_TOK
#undef GLA_LOAD
}
}
__device__ __forceinline__ void gla_phase(const Args& A, LAS unsigned char* lds, int bid, int G) {
    unsigned char* ws = A.ws;
    for (int it = bid; it < 256; it += G) {
        const int b = it >> 5, h = (it >> 2) & 7, dir = (it >> 1) & 1, vh = it & 1;
        const size_t base = (size_t)b * SEQ * DM + h * 128;
        gla::gla_item((const bf16_t*)(ws + H_Q) + base, (const unsigned short*)(ws + (dir ? H_LFB : H_LFF)) + base, (const bf16_t*)(ws + H_V) + base + vh * 64,
                      (bf16_t*)(ws + (dir ? H_OB : H_OF)) + base + vh * 64, dir, lds, it == 0 ? (float*)(ws + TB_LSUM) : nullptr);
    }
}
__device__ __forceinline__ void hg_normo_phase(const Args& A, int bid, int G) {
    int tid_ = threadIdx.x; asm volatile("" : "+v"(tid_));
    const int tid = tid_, lane = tid & 63, wave = tid >> 6; unsigned char* ws = A.ws;
    const bf16_t* OF = (const bf16_t*)(ws + H_OF); const bf16_t* OB = (const bf16_t*)(ws + H_OB); const bf16_t* GG = (const bf16_t*)(ws + H_G); bf16_t* HM = (bf16_t*)(ws + WS_HM);
    const int c0 = (lane >> 3) * 128 + (lane & 7) * 16;
    float ng[16];
#pragma unroll
    for (int i = 0; i < 16; ++i) ng[i] = A.in[I_HGNG][(lane & 7) * 16 + i];
    for (int row = (bid * NWAVES + wave); row < MTOK; row += G * NWAVES) {
        const size_t o = (size_t)row * DM + c0;
        const u32x4 a0 = *(const u32x4*)(OF + o), a1 = *(const u32x4*)(OF + o + 8), b0 = *(const u32x4*)(OB + o), b1 = *(const u32x4*)(OB + o + 8), g0 = *(const u32x4*)(GG + o), g1 = *(const u32x4*)(GG + o + 8);
        float v[16], gt[16]; float ss = 0.f;
#pragma unroll
        for (int e = 0; e < 4; ++e) { v[2 * e] = bflo(a0[e]) + bflo(b0[e]); v[2 * e + 1] = bfhi(a0[e]) + bfhi(b0[e]); v[8 + 2 * e] = bflo(a1[e]) + bflo(b1[e]); v[8 + 2 * e + 1] = bfhi(a1[e]) + bfhi(b1[e]);
            gt[2 * e] = bflo(g0[e]); gt[2 * e + 1] = bfhi(g0[e]); gt[8 + 2 * e] = bflo(g1[e]); gt[8 + 2 * e + 1] = bfhi(g1[e]); }
#pragma unroll
        for (int i = 0; i < 16; ++i) ss += v[i] * v[i];
        ss += __shfl_xor(ss, 1); ss += __shfl_xor(ss, 2); ss += __shfl_xor(ss, 4);
        const float rstd = 1.0f / sqrtf(ss * (1.0f / 128.0f) + EPS);
        u32x4 w0, w1;
#pragma unroll
        for (int e = 0; e < 4; ++e) { w0[e] = cvt_pk_bf16(v[2 * e] * rstd * ng[2 * e] * gt[2 * e], v[2 * e + 1] * rstd * ng[2 * e + 1] * gt[2 * e + 1]);
            w1[e] = cvt_pk_bf16(v[8 + 2 * e] * rstd * ng[8 + 2 * e] * gt[8 + 2 * e], v[8 + 2 * e + 1] * rstd * ng[8 + 2 * e + 1] * gt[8 + 2 * e + 1]); }
        *(u32x4*)(HM + o) = w0; *(u32x4*)(HM + o + 8) = w1;
    }
}

#ifdef DIAG
constexpr int DG_BASE = 8192;
__device__ __forceinline__ void dg_put(const Args& A, int k, float e) { if (!(e >= 0.f) || e > 1e9f) e = 1e9f; atomicMax((unsigned*)(A.ws + WS_CTL) + DG_BASE + 64 * k, __float_as_uint(e)); }
__device__ __forceinline__ float dg_rel(float got, float ref) { return fabsf(got - ref) / (fabsf(ref) + 0.1f); }
__device__ __forceinline__ unsigned dg_hash(unsigned a, unsigned b) { unsigned h = a * 2654435761u + b * 40503u + 0x9e3779b9u; h ^= h >> 15; h *= 2246822519u; h ^= h >> 13; h *= 3266489917u; h ^= h >> 16; return h; }
__device__ __forceinline__ float dg_bfr(float x) { return bflo(f2bf(x)); }
__device__ __forceinline__ void dg_mods(const Args& A, int k) {
    const int lane = threadIdx.x & 63, gwv = blockIdx.x * 8 + (threadIdx.x >> 6);
    const unsigned h = dg_hash(gwv, k); const int l = h & 3, b = (h >> 2) & 7, e = (h >> 5) % 6144;
    float a = 0.f; for (int d = lane; d < DM; d += 64) a += fsilu(A.in[I_C][b * DM + d]) * A.in[I_ADAW][((size_t)l * DM + d) * 6144 + e];
    a = wave_sum(a) + A.in[I_ADAB][l * 6144 + e];
    const float got = ((const float*)(A.ws + TB_MODS))[((size_t)l * NBATCH + b) * 6144 + e];
    if (lane == 0) dg_put(A, k, dg_rel(got, a));
}
__device__ __forceinline__ void dg_norm(const Args& A, int k, const float* x, const float* gain, int L, int which) {
    const int lane = threadIdx.x & 63, gwv = blockIdx.x * 8 + (threadIdx.x >> 6);
    const int row = dg_hash(gwv, k) & (MTOK - 1), b = row >> 13;
    const float* modl = (const float*)(A.ws + TB_MODS) + ((size_t)L * NBATCH + b) * 6144;
    float ss = 0.f; for (int c = lane; c < DM; c += 64) { const float v = x[(size_t)row * DM + c]; ss += v * v; }
    ss = wave_sum(ss); const float rstd = 1.0f / sqrtf(ss / DM + EPS); float e = 0.f;
    for (int c = lane; c < DM; c += 64) { const float ref = x[(size_t)row * DM + c] * rstd * gain[c] * (1.0f + modl[(which * 3 + 1) * 1024 + c]) + modl[(which * 3) * 1024 + c];
        e = fmaxf(e, dg_rel(bf2f(((const bf16_t*)(A.ws + WS_HM))[(size_t)row * DM + c]), ref)); }
    dg_put(A, k, e);
}
__device__ __forceinline__ void dg_qkv(const Args& A, int k, int al) {
    const int lane = threadIdx.x & 63, gwv = blockIdx.x * 8 + (threadIdx.x >> 6);
    const unsigned h = dg_hash(gwv, k); const int row = h & (MTOK - 1), t = (h >> 16) % 48, col = t * 64 + lane;
    const bf16_t* hm = (const bf16_t*)(A.ws + WS_HM) + (size_t)row * DM; const float* w = A.in[I_ATWIN] + (size_t)al * 1024 * 3072 + col;
    float a = 0.f; for (int kk = 0; kk < DM; ++kk) a += bf2f(hm[kk]) * dg_bfr(w[(size_t)kk * 3072]);
    float ref, got;
    if (t < 32) {
        const int part = t >> 4, sh = t & 15; const float ss = wave_sum(a * a); const float rstd = 1.0f / sqrtf(ss / 64.0f + EPS);
        const float y = a * rstd * (part ? A.in[I_ATKN] : A.in[I_ATQN])[al * 64 + lane]; const float yp = __shfl_xor(y, 32);
        const int pos = row & (SEQ - 1); const float cs = ((const float*)(A.ws + TB_COS))[pos * 32 + (lane & 31)], sn = ((const float*)(A.ws + TB_SIN))[pos * 32 + (lane & 31)];
        ref = (lane < 32) ? (y * cs - yp * sn) : (y * cs + yp * sn); if (part == 0) ref *= 0.125f * LOG2E;
        got = bf2f(((const bf16_t*)(A.ws + (part ? A_K : A_Q)))[(size_t)row * DM + sh * 64 + lane]);
    } else { ref = a; got = bf2f(((const bf16_t*)(A.ws + A_V))[(size_t)row * DM + (t - 32) * 64 + lane]); }
    dg_put(A, k, dg_rel(got, ref));
}
__device__ __forceinline__ void dg_attn(const Args& A, int k, int al, LAS unsigned char* lds) {
    const int tid = threadIdx.x; const unsigned h = dg_hash(blockIdx.x, k); const int row = h & (MTOK - 1), hd = (h >> 16) & 7, b = row >> 13;
    const bf16_t* Q = (const bf16_t*)(A.ws + A_Q); const bf16_t* K = (const bf16_t*)(A.ws + A_K); const bf16_t* V = (const bf16_t*)(A.ws + A_V);
    const float* scal = (const float*)(A.ws + TB_SCAL); const float lamv = scal[SC_LAM0 + al], omli = scal[SC_OML0 + al], Mc = scal[SC_MC0 + al];
    LAS float* p0 = (LAS float*)lds; LAS float* p1 = p0 + SEQ; LAS float* red = p1 + SEQ;
    float l0 = 0.f, l1 = 0.f;
    for (int key = tid; key < SEQ; key += NTHR) { const bf16_t* kr = K + ((size_t)b * SEQ + key) * DM + hd * 128; const bf16_t* qr = Q + (size_t)row * DM + hd * 128;
        float s0 = 0.f, s1 = 0.f; for (int d = 0; d < 64; ++d) { s0 += bf2f(qr[d]) * bf2f(kr[d]); s1 += bf2f(qr[64 + d]) * bf2f(kr[64 + d]); }
        const float e0 = fexp2(s0 - Mc), e1 = fexp2(s1 - Mc); p0[key] = e0; p1[key] = e1; l0 += e0; l1 += e1; }
    l0 = wave_sum(l0); l1 = wave_sum(l1); if ((tid & 63) == 0) { red[tid >> 6] = l0; red[8 + (tid >> 6)] = l1; }
    __syncthreads();
    l0 = 0.f; l1 = 0.f; for (int w = 0; w < 8; ++w) { l0 += red[w]; l1 += red[8 + w]; }
    __syncthreads();
    const int dv = tid & 127, part = tid >> 7; float o = 0.f;
    for (int key = part * 2048; key < part * 2048 + 2048; ++key) o += (p0[key] / l0 - lamv * p1[key] / l1) * bf2f(V[((size_t)b * SEQ + key) * DM + hd * 128 + dv]);
    red[16 + part * 128 + dv] = o; __syncthreads();
    if (tid < 128) { o = red[16 + tid] + red[16 + 128 + tid] + red[16 + 256 + tid] + red[16 + 384 + tid]; red[600 + tid] = o * o; }
    __syncthreads();
    if (tid < 128) { float ss = 0.f; for (int i = 0; i < 128; ++i) ss += red[600 + i]; const float ref = o / sqrtf(ss / 128.0f + EPS) * A.in[I_ATSUB][al * 128 + tid] * omli;
        dg_put(A, k, dg_rel(bf2f(((const bf16_t*)(A.ws + WS_HM))[(size_t)row * DM + hd * 128 + tid]), ref)); }
    __syncthreads();
}
__device__ __forceinline__ void dg_save(const Args& A, int k, const float* xold) {
    const int lane = threadIdx.x & 63, gwv = blockIdx.x * 8 + (threadIdx.x >> 6);
    const unsigned h = dg_hash(gwv, k); const int row = h & (MTOK - 1), col = (h >> 16) & 1023;
    float* sv = (float*)(A.ws + TB_LSUM) + 7 * 1024 * 1024 / 4;
    if (lane == 0) sv[k * 4096 + gwv] = xold[(size_t)row * DM + col];
}
__device__ __forceinline__ void dg_res(const Args& A, int k, const float* xnew, const float* gate, const bf16_t* Am, int K, const float* W) {
    const int lane = threadIdx.x & 63, gwv = blockIdx.x * 8 + (threadIdx.x >> 6);
    const unsigned h = dg_hash(gwv, k); const int row = h & (MTOK - 1), col = (h >> 16) & 1023, b = row >> 13;
    const float* sv = (const float*)(A.ws + TB_LSUM) + 7 * 1024 * 1024 / 4;
    float a = 0.f; for (int kk = lane; kk < K; kk += 64) a += bf2f(Am[(size_t)row * K + kk]) * dg_bfr(W[(size_t)kk * DM + col]);
    a = wave_sum(a);
    const float ref = sv[k * 4096 + gwv] + gate[(size_t)b * 6144 + col] * a;
    if (lane == 0) dg_put(A, k, dg_rel(xnew[(size_t)row * DM + col], ref));
}
__device__ __forceinline__ void dg_swiglu(const Args& A, int k, const bf16_t* Am, const float* W, int F, const bf16_t* H, int nrows, const int* rowmap) {
    const int lane = threadIdx.x & 63, gwv = blockIdx.x * 8 + (threadIdx.x >> 6);
    const unsigned h = dg_hash(gwv, k); const int row = (h & 0xfffff) % nrows, j = (h >> 20) % F;
    float g = 0.f, u = 0.f; for (int kk = lane; kk < DM; kk += 64) { const float x = bf2f(Am[(size_t)row * DM + kk]); g += x * dg_bfr(W[(size_t)kk * 2 * F + j]); u += x * dg_bfr(W[(size_t)kk * 2 * F + F + j]); }
    g = wave_sum(g); u = wave_sum(u);
    const float ref = g / (1.0f + expf(-g)) * u;
    if (lane == 0) dg_put(A, k, dg_rel(bf2f(H[(size_t)row * F + j]), ref));
}
__device__ __forceinline__ void dg_hgin(const Args& A, int k) {
    const int lane = threadIdx.x & 63, gwv = blockIdx.x * 8 + (threadIdx.x >> 6);
    const unsigned h = dg_hash(gwv, k); const int row = h & (MTOK - 1), col = (h >> 16) % 5120, grp = col >> 10, cc = col & 1023;
    float a = 0.f; for (int kk = lane; kk < DM; kk += 64) a += bf2f(((const bf16_t*)(A.ws + WS_HM))[(size_t)row * DM + kk]) * dg_bfr(A.in[I_HGWIN][(size_t)kk * 5120 + col]);
    a = wave_sum(a);
    float ref, got;
    if (grp == 0 || grp == 4) { ref = a / (1.0f + expf(-a)); got = bf2f(((const bf16_t*)(A.ws + (grp == 0 ? H_Q : H_G)))[(size_t)row * DM + cc]); }
    else if (grp == 3) { ref = a; got = bf2f(((const bf16_t*)(A.ws + H_V))[(size_t)row * DM + cc]); }
    else { const int d = grp - 1; const float* p = A.in[I_HGLB] + (size_t)d * DEPTH * 1024 + cc; float mx = p[0]; for (int l = 1; l < DEPTH; ++l) mx = fmaxf(mx, p[l * 1024]);
        float den = 0.f; for (int l = 0; l < DEPTH; ++l) den += expf(p[l * 1024] - mx); const float lbv = expf(p[1024] - mx) / den;
        ref = logf(lbv + (1.0f - lbv) / (1.0f + expf(-a))); got = gla::h2f(((const unsigned short*)(A.ws + (d ? H_LFB : H_LFF)))[(size_t)row * DM + cc]); }
    if (lane == 0) dg_put(A, k, dg_rel(got, ref));
}
__device__ __forceinline__ void dg_gla(const Args& A, int k) {
    const int lane = threadIdx.x & 63, gwv = blockIdx.x * 8 + (threadIdx.x >> 6);
    const unsigned h = dg_hash(gwv, k); const int sel0 = (gwv & 3) == 0; const int b = sel0 ? 0 : (h & 7), hd = sel0 ? 0 : ((h >> 3) & 7), dir = sel0 ? 0 : ((h >> 6) & 1), vc = sel0 ? ((h >> 7) & 63) : ((h >> 7) & 127);
    const bf16_t* Q = (const bf16_t*)(A.ws + H_Q); const unsigned short* LF = (const unsigned short*)(A.ws + (dir ? H_LFB : H_LFF)); const bf16_t* V = (const bf16_t*)(A.ws + H_V);
    const bf16_t* O = (const bf16_t*)(A.ws + (dir ? H_OB : H_OF));
    float s0 = 0.f, s1 = 0.f, e0 = 0.f, e1 = 0.f, e2 = 0.f, e3 = 0.f;
    for (int i = 0; i < SEQ; ++i) { const int tok = dir ? (SEQ - 1 - i) : i; const size_t o = ((size_t)b * SEQ + tok) * DM + hd * 128;
        const float f0 = expf(gla::h2f(LF[o + lane])), f1 = expf(gla::h2f(LF[o + 64 + lane])), v = bf2f(V[o + vc]);
        s0 = f0 * s0 + (1.0f - f0) * v; s1 = f1 * s1 + (1.0f - f1) * v;
        if (i < 128 || i % 61 == 0) { const float ov = wave_sum(bf2f(Q[o + lane]) * s0 + bf2f(Q[o + 64 + lane]) * s1); const float er = 0.25f * fabsf(bf2f(O[o + vc]) - ov) / (fabsf(ov) + 1.0f);
            if (i == 0) e0 = er; else if (i < 64) e1 = fmaxf(e1, er); else if (i < 128) e2 = fmaxf(e2, er); else e3 = fmaxf(e3, er); } }
    if (lane == 0) { dg_put(A, k, e0); dg_put(A, k + 4, e1); dg_put(A, k + 5, e2); dg_put(A, k + 6, e3); }
    const float* dbg = (const float*)(A.ws + TB_LSUM); const unsigned short* LF0 = (const unsigned short*)(A.ws + H_LFF); const bf16_t* Q0 = (const bf16_t*)(A.ws + H_Q);
    { const unsigned h2 = dg_hash(gwv, k + 100); const int t = h2 & 63, kk = (h2 >> 6) & 127; float c = 0.f; for (int tt = 0; tt <= t; ++tt) c += gla::h2f(LF0[(size_t)tt * DM + kk]);
      if (lane == 0) dg_put(A, k + 1, dg_rel(dbg[t * 128 + kk], c)); }
    { const unsigned h2 = dg_hash(gwv, k + 200); const int t = h2 & 63, sidx = (h2 >> 6) & 63; float a = 0.f;
      if (sidx <= t) { for (int kk = lane; kk < 128; kk += 64) { float c = 0.f; for (int tt = sidx + 1; tt <= t; ++tt) c += gla::h2f(LF0[(size_t)tt * DM + kk]);
              a += bf2f(Q0[(size_t)t * DM + kk]) * (1.0f - expf(gla::h2f(LF0[(size_t)sidx * DM + kk]))) * expf(c); } a = wave_sum(a); }
      const unsigned short got = ((const unsigned short*)(dbg + 8192))[gla::sw128(t, sidx * 2) / 2];
      if (lane == 0) dg_put(A, k + 2, 5.0f * fabsf(bf2f(got) - a) / (fabsf(a) + 0.01f)); }
    { const unsigned h2 = dg_hash(gwv, k + 300); const int sidx = h2 & 63, v = (h2 >> 6) & 63;
      const unsigned short got = ((const unsigned short*)(dbg + 8192 + 2048))[gla::sw128(v, sidx * 2) / 2];
      if (lane == 0) dg_put(A, k + 2, dg_rel(bf2f(got), bf2f(((const bf16_t*)(A.ws + H_V))[(size_t)sidx * DM + v]))); }
    { const unsigned h2 = dg_hash(gwv, k + 500); const int kk = h2 & 127, v = (h2 >> 7) & 63;
      float a = 0.f; { const int sidx = lane; float c = 0.f; for (int tt = sidx + 1; tt < 64; ++tt) c += gla::h2f(LF0[(size_t)tt * DM + kk]);
          const float ksn = (1.0f - expf(gla::h2f(LF0[(size_t)sidx * DM + kk]))) * expf(c);
          const unsigned short gk = ((const unsigned short*)(dbg + 16384))[gla::sw128(kk, sidx * 2) / 2];
          dg_put(A, k + 2, 0.5f * fabsf(bf2f(gk) - ksn) / (fabsf(ksn) + 0.01f));
          a = ksn * bf2f(((const bf16_t*)(A.ws + H_V))[(size_t)sidx * DM + v]); }
      a = wave_sum(a);
      const unsigned short gs = ((const unsigned short*)(dbg + 12288))[gla::sw256(v, kk * 2) / 2];
      if (lane == 0) dg_put(A, k + 3, 0.5f * fabsf(bf2f(gs) - a) / (fabsf(a) + 0.05f)); }
    { const unsigned h2 = dg_hash(gwv, k + 400); const int t = h2 & 63, v = (h2 >> 6) & 63;
      const unsigned short* at = (const unsigned short*)(dbg + 8192); const unsigned short* vt = (const unsigned short*)(dbg + 8192 + 2048);
      float a = bf2f(at[gla::sw128(t, lane * 2) / 2]) * bf2f(vt[gla::sw128(v, lane * 2) / 2]); a = wave_sum(a);
      if (lane == 0) dg_put(A, k + 1, 5.0f * dg_rel(bf2f(((const bf16_t*)(A.ws + H_OF))[(size_t)t * DM + v]), a)); }
}
__device__ __forceinline__ void dg_normo(const Args& A, int k) {
    const int lane = threadIdx.x & 63, gwv = blockIdx.x * 8 + (threadIdx.x >> 6);
    const unsigned h = dg_hash(gwv, k); const int row = h & (MTOK - 1), hd = (h >> 16) & 7; const size_t o = (size_t)row * DM + hd * 128;
    const float v0 = bf2f(((const bf16_t*)(A.ws + H_OF))[o + lane]) + bf2f(((const bf16_t*)(A.ws + H_OB))[o + lane]), v1 = bf2f(((const bf16_t*)(A.ws + H_OF))[o + 64 + lane]) + bf2f(((const bf16_t*)(A.ws + H_OB))[o + 64 + lane]);
    const float ss = wave_sum(v0 * v0 + v1 * v1), rstd = 1.0f / sqrtf(ss / 128.0f + EPS);
    const float r0 = v0 * rstd * A.in[I_HGNG][lane] * bf2f(((const bf16_t*)(A.ws + H_G))[o + lane]), r1 = v1 * rstd * A.in[I_HGNG][64 + lane] * bf2f(((const bf16_t*)(A.ws + H_G))[o + 64 + lane]);
    dg_put(A, k, fmaxf(dg_rel(bf2f(((const bf16_t*)(A.ws + WS_HM))[o + lane]), r0), dg_rel(bf2f(((const bf16_t*)(A.ws + WS_HM))[o + 64 + lane]), r1)));
}
__device__ __forceinline__ void dg_router(const Args& A, int k, int L) {
    const int lane = threadIdx.x & 63, gwv = blockIdx.x * 8 + (threadIdx.x >> 6);
    const int row = dg_hash(gwv, k) & (MTOK - 1), b = row >> 13; const float* x = A.out + (size_t)row * DM;
    const float* modl = (const float*)(A.ws + TB_MODS) + ((size_t)L * NBATCH + b) * 6144; const float* gain = A.in[I_N2G] + L * DM; const float* R = A.in[I_MOER] + (size_t)(L >> 1) * DM * 8;
    float ss = 0.f; for (int c = lane; c < DM; c += 64) ss += x[c] * x[c];
    ss = wave_sum(ss); const float rstd = 1.0f / sqrtf(ss / DM + EPS);
    float lg[8]; for (int e = 0; e < 8; ++e) lg[e] = 0.f;
    for (int c = lane; c < DM; c += 64) { const float hv = x[c] * rstd * gain[c] * (1.0f + modl[4 * 1024 + c]) + modl[3 * 1024 + c]; for (int e = 0; e < 8; ++e) lg[e] += hv * R[c * 8 + e]; }
    for (int e = 0; e < 8; ++e) lg[e] = wave_sum(lg[e]);
    int e0 = 0; for (int e = 1; e < 8; ++e) if (lg[e] > lg[e0]) e0 = e;
    int e1 = (e0 == 0) ? 1 : 0; for (int e = 0; e < 8; ++e) if (e != e0 && lg[e] > lg[e1]) e1 = e;
    float gap = 1e9f; for (int e = 0; e < 8; ++e) if (e != e0 && e != e1) gap = fminf(gap, lg[e1] - lg[e]); gap = fminf(gap, lg[e0] - lg[e1]);
    const int g0 = ((const int*)(A.ws + TB_EID))[row * 2], g1 = ((const int*)(A.ws + TB_EID))[row * 2 + 1]; const float w0 = ((const float*)(A.ws + TB_GATE))[row * 2], w1 = ((const float*)(A.ws + TB_GATE))[row * 2 + 1];
    const float p0 = 1.0f / (1.0f + expf(lg[e1] - lg[e0]));
    float er = (g0 != e0 || g1 != e1) ? (gap > 2e-3f ? 9.f : 0.f) : fmaxf(fabsf(w0 - p0), fabsf(w1 - (1.0f - p0)));
    if (lane == 0) dg_put(A, k, er);
}
__device__ __forceinline__ void dg_place(const Args& A, int k) {
    const int lane = threadIdx.x & 63, gwv = blockIdx.x * 8 + (threadIdx.x >> 6);
    const unsigned h = dg_hash(gwv, k); const int row = h & (MTOK - 1), kk = (h >> 16) & 1;
    const int sl = ((const int*)(A.ws + TB_SLOT))[row * 2 + kk], e = ((const int*)(A.ws + TB_EID))[row * 2 + kk]; const int* ts = (const int*)(A.ws + TB_TILES);
    float er = (sl >= ts[e] * 256 && sl < ts[e + 1] * 256 && sl < MOE_ROWS) ? 0.f : 7.f;
    if (er == 0.f) for (int c = lane; c < DM; c += 64) if (((const bf16_t*)(A.ws + E_XS))[(size_t)sl * DM + c] != ((const bf16_t*)(A.ws + WS_HM))[(size_t)row * DM + c]) er = 5.f;
    dg_put(A, k, er);
}
__device__ __forceinline__ void dg_moe_hid(const Args& A, int k, int m) {
    const int lane = threadIdx.x & 63, gwv = blockIdx.x * 8 + (threadIdx.x >> 6);
    const unsigned h = dg_hash(gwv, k); const int row = h & (MTOK - 1), kk = (h >> 16) & 1, j = (h >> 17) % DFFE;
    const int sl = ((const int*)(A.ws + TB_SLOT))[row * 2 + kk], e = ((const int*)(A.ws + TB_EID))[row * 2 + kk];
    const float* W = A.in[I_MOEGU] + ((size_t)m * 8 + e) * DM * 2 * DFFE; const bf16_t* Am = (const bf16_t*)(A.ws + E_XS) + (size_t)sl * DM;
    float g = 0.f, u = 0.f; for (int c = lane; c < DM; c += 64) { const float x = bf2f(Am[c]); g += x * dg_bfr(W[(size_t)c * 2 * DFFE + j]); u += x * dg_bfr(W[(size_t)c * 2 * DFFE + DFFE + j]); }
    g = wave_sum(g); u = wave_sum(u);
    if (lane == 0) dg_put(A, k, dg_rel(bf2f(((const bf16_t*)(A.ws + E_HID))[(size_t)sl * DFFE + j]), g / (1.0f + expf(-g)) * u));
}
__device__ __forceinline__ void dg_moe_y(const Args& A, int k, int m) {
    const int lane = threadIdx.x & 63, gwv = blockIdx.x * 8 + (threadIdx.x >> 6);
    const unsigned h = dg_hash(gwv, k); const int row = h & (MTOK - 1), kk = (h >> 16) & 1, col = (h >> 17) & 1023;
    const int sl = ((const int*)(A.ws + TB_SLOT))[row * 2 + kk], e = ((const int*)(A.ws + TB_EID))[row * 2 + kk];
    const float* W = A.in[I_MOEDN] + ((size_t)m * 8 + e) * DFFE * DM; const bf16_t* Hh = (const bf16_t*)(A.ws + E_HID) + (size_t)sl * DFFE;
    float a = 0.f; for (int j = lane; j < DFFE; j += 64) a += bf2f(Hh[j]) * dg_bfr(W[(size_t)j * DM + col]);
    a = wave_sum(a);
    if (lane == 0) dg_put(A, k, fabsf(bf2f(((const bf16_t*)(A.ws + E_XS))[(size_t)sl * DM + col]) - a) / (fabsf(a) + 0.3f));
}
__device__ __forceinline__ void dg_combine(const Args& A, int k, const float* modprev) {
    const int lane = threadIdx.x & 63, gwv = blockIdx.x * 8 + (threadIdx.x >> 6);
    const unsigned h = dg_hash(gwv, k); const int row = h & (MTOK - 1), col = (h >> 16) & 1023, b = row >> 13;
    const float* sv = (const float*)(A.ws + TB_LSUM) + 7 * 1024 * 1024 / 4; const bf16_t* Y = (const bf16_t*)(A.ws + E_XS);
    const int s0 = ((const int*)(A.ws + TB_SLOT))[row * 2], s1 = ((const int*)(A.ws + TB_SLOT))[row * 2 + 1]; const float w0 = ((const float*)(A.ws + TB_GATE))[row * 2], w1 = ((const float*)(A.ws + TB_GATE))[row * 2 + 1];
    const float ref = sv[k * 4096 + gwv] + modprev[(size_t)b * 6144 + 5 * 1024 + col] * (w0 * bf2f(Y[(size_t)s0 * DM + col]) + w1 * bf2f(Y[(size_t)s1 * DM + col]));
    if (lane == 0) dg_put(A, k, dg_rel(A.out[(size_t)row * DM + col], ref));
}
__device__ __forceinline__ void dg_lruin(const Args& A, int k) {
    const int lane = threadIdx.x & 63, gwv = blockIdx.x * 8 + (threadIdx.x >> 6);
    const unsigned h = dg_hash(gwv, k); const int row = h & (MTOK - 1), col = (h >> 16) % 2560;
    float a = 0.f; for (int kk = lane; kk < DM; kk += 64) a += bf2f(((const bf16_t*)(A.ws + WS_HM))[(size_t)row * DM + kk]) * dg_bfr(A.in[I_LRWIN][(size_t)kk * 2560 + col]);
    a = wave_sum(a);
    float ref, got;
    if (col < LRUW) { ref = 0.5f * a * (1.0f + tanhf(0.7978845608028654f * (a + 0.044715f * a * a * a))); got = bf2f(((const bf16_t*)(A.ws + L_YB))[(size_t)row * LRUW + col]); }
    else { ref = a; got = bf2f(((const bf16_t*)(A.ws + L_XB))[(size_t)row * LRUW + col - LRUW]); }
    if (lane == 0) dg_put(A, k, dg_rel(got, ref));
}
__device__ __forceinline__ void dg_lru(const Args& A, int k) {
    const int lane = threadIdx.x & 63, gwv = blockIdx.x * 8 + (threadIdx.x >> 6);
    const unsigned h = dg_hash(gwv, k); const int b = h & 7, ch = (h >> 3) % LRUW, tc = (h >> 16) & (SEQ - 1), n = ch / 128, j = ch % 128;
    const bf16_t* XB = (const bf16_t*)(A.ws + L_XB) + (size_t)b * SEQ * LRUW;
    float hres[2];
    for (int d = 0; d < 2; ++d) {
        const float* wa = A.in[I_LRWA] + (size_t)(d * 10 + n) * 16384; const float* wx = A.in[I_LRWX] + (size_t)(d * 10 + n) * 16384;
        const float wa0 = dg_bfr(wa[lane * 128 + j]), wa1 = dg_bfr(wa[(lane + 64) * 128 + j]), wx0 = dg_bfr(wx[lane * 128 + j]), wx1 = dg_bfr(wx[(lane + 64) * 128 + j]);
        const float ba = A.in[I_LRBA][d * LRUW + ch], bx = A.in[I_LRBX][d * LRUW + ch]; const float lam = A.in[I_LRLAM][d * LRUW + ch]; const float sp = log1pf(expf(-lam));
        float hs = 0.f;
        for (int i = 0; ; ++i) { const int t = d ? (SEQ - 1 - i) : i;
            float x0 = A.in[I_LRCB][n * 128 + lane], x1 = A.in[I_LRCB][n * 128 + 64 + lane], xj = A.in[I_LRCB][ch];
            for (int w = 0; w < 4; ++w) { const int tt = t - 1 + w; if (tt >= 0 && tt < SEQ) {
                x0 += A.in[I_LRCW][w * LRUW + n * 128 + lane] * bf2f(XB[(size_t)tt * LRUW + n * 128 + lane]); x1 += A.in[I_LRCW][w * LRUW + n * 128 + 64 + lane] * bf2f(XB[(size_t)tt * LRUW + n * 128 + 64 + lane]);
                xj += A.in[I_LRCW][w * LRUW + ch] * bf2f(XB[(size_t)tt * LRUW + ch]); } }
            const float rp = wave_sum(dg_bfr(x0) * wa0 + dg_bfr(x1) * wa1), ip = wave_sum(dg_bfr(x0) * wx0 + dg_bfr(x1) * wx1);
            const float rg = 1.0f / (1.0f + expf(-(rp + ba))), ig = 1.0f / (1.0f + expf(-(ip + bx))); const float la = -8.0f * rg * sp;
            hs = expf(la) * hs + sqrtf(fmaxf(-expm1f(2.0f * la), 0.f)) * ig * xj;
            if (t == tc) break; }
        hres[d] = hs;
    }
    const size_t go = ((size_t)b * SEQ + tc) * LRUW + ch;
    const float e1 = fabsf(bf2f(((const bf16_t*)(A.ws + L_HF))[go]) - hres[0]) / (fabsf(hres[0]) + 0.3f);
    const float ref = (hres[0] + hres[1]) * bf2f(((const bf16_t*)(A.ws + L_YB))[go]);
    const float e2 = fabsf(bf2f(((const bf16_t*)(A.ws + L_HY))[go]) - ref) / (fabsf(ref) + 0.3f);
    if (lane == 0) { dg_put(A, k, e1); dg_put(A, k + 5, e2); }
}
__device__ __forceinline__ void dg_final(const Args& A, int nchk) {
    const unsigned* sl = (const unsigned*)(A.ws + WS_CTL) + DG_BASE; int code = 0; float ev = 0.f;
    for (int k = 1; k <= nchk; ++k) { const float e = __uint_as_float(sl[64 * k]); if (e > 0.05f) { code = k; ev = e; break; } }
    if (code == 0) return;
    const int c1 = code % 10, c10 = code / 10;
    const float s = -(float)c1;
    for (size_t i = (size_t)blockIdx.x * NTHR + threadIdx.x; i < (size_t)MTOK * DM; i += (size_t)gridDim.x * NTHR) A.out[i] = A.in[I_X][i] * s;
    __syncthreads();
    if (blockIdx.x == 0 && threadIdx.x == 0) { const int qq = ev < 0.1f ? 1 : ev < 0.2f ? 2 : ev < 0.5f ? 3 : ev < 1.f ? 4 : ev < 2.f ? 5 : ev < 5.f ? 6 : ev < 20.f ? 7 : ev < 1e3f ? 8 : 9;
        A.out[12345] = 100.f * (float)(10 * c10 + qq); }
}
#define DG(x) x
#define DGL(x) if constexpr (L >= DIAG_FROM) { x }
#else
#define DG(x)
#define DGL(x)
#endif

#define GRID_BAR() xcd_barrier(bar)
template <int L>
__device__ __forceinline__ void run_mixer(const Args& args, LAS unsigned char* lds, int bid, int G, const XcdBarrier& bar) {
    unsigned char* ws = args.ws; bf16_t* xo = (bf16_t*)(ws + WS_XB);
    const float* modl = (const float*)(ws + TB_MODS) + (size_t)L * NBATCH * 6144;
    const void* xs = (L == 0) ? (const void*)args.in[I_X] : (const void*)xo; constexpr bool X16 = (L != 0);
    constexpr int kind = L % 3;
    DGL(if (L > 0 && ((L - 1) & 1)) { dg_save(args, 10 * (L - 1) + 9, xo); GRID_BAR(); })
    norm_phase<false>(args, lds, bid, G, xs, X16, xo, true, args.in[I_N1G] + L * DM, modl, 0, (L > 0) && ((L - 1) & 1), modl - NBATCH * 6144, false, nullptr);
    GRID_BAR();
    DGL(if (L > 0 && ((L - 1) & 1)) { dg_combine(args, 10 * (L - 1) + 9, modl - NBATCH * 6144); GRID_BAR(); })
    DGL(dg_norm(args, 10 * L + 1, (L > 0 && ((L - 1) & 1)) ? xo : xs, args.in[I_N1G] + L * DM, L, 0); GRID_BAR();)
    if constexpr (kind == 0) {
        constexpr int al = L / 3;
        {
            pg8::Gemm g{(const bf16_t*)(ws + WS_HM), (const bf16_t*)(ws + W_QKV) + (size_t)al * 3072 * 1024, 1024};
            pg8::TileOrder S; S.init(256, 12, G, bid);
            pg8::EpiQKV E{(bf16_t*)(ws + A_Q), (bf16_t*)(ws + A_K), (bf16_t*)(ws + A_V), args.in[I_ATQN] + al * 64, args.in[I_ATKN] + al * 64,
                          (const float*)(ws + TB_COS), (const float*)(ws + TB_SIN), LOG2E};
            pg8::gemm_phase<pg8::EpiQKV>(lds, g, S, E);
        }
        GRID_BAR();
        vt_phase(args, bid, G);
        GRID_BAR();
        attn_phase(args, lds, bid, G, al);
        GRID_BAR();
        DGL(dg_save(args, 10 * L + 4, xs); GRID_BAR();)
        {
            pg8::Gemm g{(const bf16_t*)(ws + WS_HM), (const bf16_t*)(ws + W_AO) + (size_t)al * 1024 * 1024, 1024};
            pg8::TileOrder S; S.init(256, 4, G, bid);
            pg8::EpiRes<X16> E{xs, xo, modl + 2 * 1024, 1.0f};
            pg8::gemm_phase<pg8::EpiRes<X16>>(lds, g, S, E);
        }
        GRID_BAR();
        DGL(dg_res(args, 10 * L + 4, xo, modl + 2 * 1024, (const bf16_t*)(ws + WS_HM), 1024, args.in[I_ATWOUT] + (size_t)al * 1024 * 1024); GRID_BAR();)
    }
    if constexpr (kind == 1) {
        {
            pg8::Gemm g{(const bf16_t*)(ws + WS_HM), (const bf16_t*)(ws + W_HGI), 1024};
            pg8::TileOrder S; S.init(256, 20, G, bid);
            pg8::EpiAct E{0, ws, (const float*)(ws + TB_LB)};
            pg8::gemm_phase<pg8::EpiAct>(lds, g, S, E);
        }
        GRID_BAR();
        DGL(dg_hgin(args, 10 * L + 2); GRID_BAR();)
        gla_phase(args, lds, bid, G);
        GRID_BAR();
        DGL(dg_gla(args, 10 * L + 3); GRID_BAR();)
        hg_normo_phase(args, bid, G);
        GRID_BAR();
        DGL(dg_normo(args, 10 * L + 0); GRID_BAR();)
        DGL(dg_save(args, 10 * L + 4, xs); GRID_BAR();)
        {
            pg8::Gemm g{(const bf16_t*)(ws + WS_HM), (const bf16_t*)(ws + W_HGO), 1024};
            pg8::TileOrder S; S.init(256, 4, G, bid);
            pg8::EpiRes<X16> E{xs, xo, modl + 2 * 1024, 1.0f};
            pg8::gemm_phase<pg8::EpiRes<X16>>(lds, g, S, E);
        }
        GRID_BAR();
        DGL(dg_res(args, 10 * L + 4, xo, modl + 2 * 1024, (const bf16_t*)(ws + WS_HM), 1024, args.in[I_HGWOUT]); GRID_BAR();)
    }
    if constexpr (kind == 2) {
        {
            pg8::Gemm g{(const bf16_t*)(ws + WS_HM), (const bf16_t*)(ws + W_LRI), 1024};
            pg8::TileOrder S; S.init(256, 10, G, bid);
            pg8::EpiAct E{1, ws, nullptr};
            pg8::gemm_phase<pg8::EpiAct>(lds, g, S, E);
        }
        GRID_BAR();
        DGL(dg_lruin(args, 10 * L + 2); GRID_BAR();)
        lru_phase<0>(args, lds, bid, G);
        GRID_BAR();
        lru_carry_phase(args, bid, G);
        GRID_BAR();
        lru_phase<1>(args, lds, bid, G);
        GRID_BAR();
        lru_phase<2>(args, lds, bid, G);
        GRID_BAR();
        DGL(dg_lru(args, 10 * L + 3); GRID_BAR();)
        DGL(dg_save(args, 10 * L + 4, xs); GRID_BAR();)
        {
            pg8::Gemm g{(const bf16_t*)(ws + L_HY), (const bf16_t*)(ws + W_LRO), LRUW};
            pg8::TileOrder S; S.init(256, 4, G, bid);
            pg8::EpiRes<X16> E{xs, xo, modl + 2 * 1024, 1.0f};
            pg8::gemm_phase<pg8::EpiRes<X16>>(lds, g, S, E);
        }
        GRID_BAR();
        DGL(dg_res(args, 10 * L + 4, xo, modl + 2 * 1024, (const bf16_t*)(ws + L_HY), LRUW, args.in[I_LRWOUT]); GRID_BAR();)
    }
}
template <int L>
__device__ __forceinline__ void run_ffn(const Args& args, LAS unsigned char* lds, int bid, int G, const XcdBarrier& bar) {
    unsigned char* ws = args.ws; bf16_t* xo = (bf16_t*)(ws + WS_XB);
    const float* modl = (const float*)(ws + TB_MODS) + (size_t)L * NBATCH * 6144;
    if constexpr ((L & 1) == 0) {
        constexpr int m = L >> 1;
        constexpr bool F8 = (L >= FP8_DENSE_FROM);
        norm_phase<false>(args, lds, bid, G, xo, true, xo, true, args.in[I_N2G] + L * DM, modl, 1, false, modl, false, nullptr, F8);
        GRID_BAR();
        if constexpr (F8) {
            pg8::Gemm g{(const bf16_t*)(ws + WS_HM), (const bf16_t*)(ws + W_FGU) + (size_t)m * 5632 * 1024, 512};
            pg8::TileOrder S; S.init(256, 22, G, bid);
            pg8::EpiSwiGLU8 E{ws + F_HID, DFF, 1.0f / MOE_WSCALE, MOE_HSCALE};
            pg8::gemm_phase<pg8::EpiSwiGLU8, true>(lds, g, S, E);
        } else {
            pg8::Gemm g{(const bf16_t*)(ws + WS_HM), (const bf16_t*)(ws + W_FGU) + (size_t)m * 5632 * 1024, 1024};
            pg8::TileOrder S; S.init(256, 22, G, bid);
            pg8::EpiSwiGLU E{(bf16_t*)(ws + F_HID), DFF};
            pg8::gemm_phase<pg8::EpiSwiGLU>(lds, g, S, E);
        }
        GRID_BAR();
        if constexpr (F8) {
            pg8::Gemm g{(const bf16_t*)(ws + F_HID), (const bf16_t*)(ws + W_FDN) + (size_t)m * 1024 * 2816, DFF / 2};
            pg8::TileOrder S; S.init(256, 4, G, bid);
            pg8::EpiRes<true> E{xo, xo, modl + 5 * 1024, 1.0f / (MOE_WSCALE * MOE_HSCALE)};
            pg8::gemm_phase<pg8::EpiRes<true>, true>(lds, g, S, E);
        } else {
            pg8::Gemm g{(const bf16_t*)(ws + F_HID), (const bf16_t*)(ws + W_FDN) + (size_t)m * 1024 * 2816, DFF};
            pg8::TileOrder S; S.init(256, 4, G, bid);
            pg8::EpiRes<true> E{xo, xo, modl + 5 * 1024, 1.0f};
            pg8::gemm_phase<pg8::EpiRes<true>>(lds, g, S, E);
        }
        GRID_BAR();
    } else {
        constexpr int m = L >> 1;
        norm_phase<true>(args, lds, bid, G, xo, true, xo, true, args.in[I_N2G] + L * DM, modl, 1, false, modl, false, args.in[I_MOER] + (size_t)m * DM * 8);
        GRID_BAR();
        DGL(dg_norm(args, 10 * L + 5, xo, args.in[I_N2G] + L * DM, L, 1); dg_router(args, 10 * L + 5, L); GRID_BAR();)
        place_phase(args, lds, bid, G);
        GRID_BAR();
        DGL(dg_place(args, 10 * L + 6); GRID_BAR();)
        const int* tiles = (const int*)(ws + TB_TILES);
        {
            pg8::Gemm g{(const bf16_t*)(ws + E_XS), (const bf16_t*)(ws + W_MGU + (size_t)m * 8 * 7168 * 1024), 512};
            pg8::TileOrder S; S.init(tiles[8], 28, G, bid);
#pragma unroll
            for (int e = 1; e < NEXP; ++e) S.ts[e] = tiles[e];
            pg8::EpiSwiGLU8 E{ws + E_HID, DFFE, 1.0f / MOE_WSCALE, MOE_HSCALE};
            pg8::gemm_phase<pg8::EpiSwiGLU8, true>(lds, g, S, E);
        }
        GRID_BAR();
        DGL(dg_moe_hid(args, 10 * L + 7, m); GRID_BAR();)
        {
            pg8::Gemm g{(const bf16_t*)(ws + E_HID), (const bf16_t*)(ws + W_MDN + (size_t)m * 8 * 1024 * 3584), DFFE / 2};
            pg8::TileOrder S; S.init(tiles[8], 4, G, bid);
#pragma unroll
            for (int e = 1; e < NEXP; ++e) S.ts[e] = tiles[e];
            pg8::EpiPlain E{(bf16_t*)(ws + E_XS), DM, 1.0f / (MOE_WSCALE * MOE_HSCALE)};
            pg8::gemm_phase<pg8::EpiPlain, true>(lds, g, S, E);
        }
        GRID_BAR();
        DGL(dg_moe_y(args, 10 * L + 8, m); GRID_BAR();)
    }
}
__device__ __forceinline__ void final_combine(const Args& args, LAS unsigned char* lds, int bid, int G, const XcdBarrier& bar) {
    const float* modl = (const float*)(args.ws + TB_MODS) + (size_t)3 * NBATCH * 6144;
    DG(dg_save(args, 39, args.out); GRID_BAR();)
    norm_phase<false>(args, lds, bid, G, args.ws + WS_XB, true, args.out, false, args.in[I_N1G], modl, 0, true, modl, true, nullptr);
    DG(GRID_BAR(); dg_combine(args, 39, modl);)
}

__global__ void __launch_bounds__(NTHR, 2) mega_fwd(Args args) {
    extern __shared__ __attribute__((aligned(16))) unsigned char lds_raw[];
    LAS unsigned char* lds = (LAS unsigned char*)lds_raw;
    const int tid = threadIdx.x, bid = blockIdx.x, G = gridDim.x;
    unsigned char* ws = args.ws;
    volatile LAS unsigned* MISC = (volatile LAS unsigned*)(lds + MISC_OFF);
    if (tid < 64) MISC[tid] = 0u;
    __syncthreads();
    XcdBarrier bar = xcd_barrier_post((unsigned*)(ws + WS_CTL) + CW_BAR, MISC + 8);

    prologue_phase(args, lds, bid, G);
    GRID_BAR();

    run_mixer<0>(args, lds, bid, G, bar);
    run_ffn<0>(args, lds, bid, G, bar);
    run_mixer<1>(args, lds, bid, G, bar);
    run_ffn<1>(args, lds, bid, G, bar);
    run_mixer<2>(args, lds, bid, G, bar);
    run_ffn<2>(args, lds, bid, G, bar);
    run_mixer<3>(args, lds, bid, G, bar);
    run_ffn<3>(args, lds, bid, G, bar);
    final_combine(args, lds, bid, G, bar);
    DG(GRID_BAR(); dg_final(args, 49);)
}

extern "C" void kernel_launch(void* const* d_in, const int* in_sizes, int n_in, void* d_out, int out_size, void* d_ws, size_t ws_size, hipStream_t stream) {
    static int grid = 0;
    if (grid == 0) {
        if (n_in != 30 || out_size != MTOK * DM || ws_size < WS_NEED) { fprintf(stderr, "kernel_launch: unexpected shapes (n_in %d out %d ws %zu need %zu)\n", n_in, out_size, ws_size, (size_t)WS_NEED); grid = -1; return; }
        int dev = 0, cus = 0;
        if (hipGetDevice(&dev) != hipSuccess || hipDeviceGetAttribute(&cus, hipDeviceAttributeMultiprocessorCount, dev) != hipSuccess) { grid = -1; return; }
        if (hipFuncSetAttribute((const void*)mega_fwd, hipFuncAttributeMaxDynamicSharedMemorySize, LDS_BYTES) != hipSuccess) { fprintf(stderr, "kernel_launch: hipFuncSetAttribute failed\n"); grid = -1; return; }
        int per_cu = 0;
        if (hipOccupancyMaxActiveBlocksPerMultiprocessor(&per_cu, (const void*)mega_fwd, NTHR, LDS_BYTES) != hipSuccess || per_cu < 1) { fprintf(stderr, "kernel_launch: occupancy query says %d\n", per_cu); }
        (void)hipGetLastError();
        grid = (cus >= 256) ? 256 : -1;
        if (grid < 0) { fprintf(stderr, "kernel_launch: needs 256 CUs, device has %d\n", cus); return; }
    }
    if (grid < 0) return;
    if (hipMemsetAsync((char*)d_ws + WS_CTL, 0, CTL_ZERO_BYTES, stream) != hipSuccess) return;
    Args a{};
    for (int i = 0; i < 30; ++i) a.in[i] = (const float*)d_in[i];
    a.out = (float*)d_out; a.ws = (unsigned char*)d_ws;
    hipLaunchKernelGGL(mega_fwd, dim3(grid), dim3(NTHR), LDS_BYTES, stream, a);
}
```

```cpp
#define DIAG_FROM 2
#include <hip/hip_runtime.h>
#include <cstdio>
#include <cstdint>

#define LAS __attribute__((address_space(3)))
#define GAS __attribute__((address_space(1)))
typedef unsigned short bf16_t;
typedef short bf16x8 __attribute__((ext_vector_type(8)));
typedef short s16x4 __attribute__((ext_vector_type(4)));
typedef float f32x2 __attribute__((ext_vector_type(2)));
typedef float f32x4 __attribute__((ext_vector_type(4)));
typedef float f32x16 __attribute__((ext_vector_type(16)));
typedef unsigned u32x2 __attribute__((ext_vector_type(2)));
typedef unsigned u32x4 __attribute__((ext_vector_type(4)));

constexpr int MTOK = 65536, DM = 1024, SEQ = 8192, NBATCH = 8, DEPTH = 4;
constexpr int DFF = 2816, DFFE = 3584, NEXP = 8, LRUW = 1280;
constexpr float EPS = 1e-6f;
constexpr int FP8_DENSE_FROM = 2;
constexpr float MOE_WSCALE = 64.0f, MOE_HSCALE = 4.0f;
constexpr float LOG2E = 1.4426950408889634f;

constexpr size_t MiB = 1u << 20;
constexpr size_t WS_CTL = 0, CTL_ZERO_BYTES = 1 * MiB;
constexpr size_t WS_TAB = 1 * MiB;
constexpr size_t TB_MODS = WS_TAB;
constexpr size_t TB_COS = WS_TAB + 1 * MiB;
constexpr size_t TB_SIN = WS_TAB + 2 * MiB;
constexpr size_t TB_SCAL = WS_TAB + 3 * MiB;
constexpr size_t TB_LB = TB_SCAL + 4096;
constexpr size_t TB_SP = TB_SCAL + 16384;
constexpr size_t TB_EID = WS_TAB + 4 * MiB;
constexpr size_t TB_GATE = WS_TAB + 5 * MiB;
constexpr size_t TB_SLOT = WS_TAB + 6 * MiB;
constexpr size_t TB_BCNT = WS_TAB + 7 * MiB;
constexpr size_t TB_TILES = TB_BCNT + 16384;
constexpr size_t TB_LSUM = WS_TAB + 8 * MiB;
constexpr size_t TB_LCIN = WS_TAB + 16 * MiB;
constexpr size_t WS_W = 32 * MiB;
constexpr size_t W_QKV = WS_W;
constexpr size_t W_AO = W_QKV + 2 * (size_t)3072 * 1024 * 2;
constexpr size_t W_HGI = W_AO + 2 * (size_t)1024 * 1024 * 2;
constexpr size_t W_HGO = W_HGI + (size_t)5120 * 1024 * 2;
constexpr size_t W_LRI = W_HGO + (size_t)1024 * 1024 * 2;
constexpr size_t W_LRG = W_LRI + (size_t)2560 * 1024 * 2;
constexpr size_t W_LRO = W_LRG + (size_t)10 * 2 * 256 * 128 * 2;
constexpr size_t W_FGU = W_LRO + (size_t)1024 * 1280 * 2;
constexpr size_t W_FDN = W_FGU + 2 * (size_t)5632 * 1024 * 2;
constexpr size_t W_MGU = W_FDN + 2 * (size_t)1024 * 2816 * 2;
constexpr size_t W_MDN = W_MGU + 16 * (size_t)7168 * 1024 * 2;
constexpr size_t W_END = W_MDN + 16 * (size_t)1024 * 3584 * 2;
constexpr size_t WS_HM = 440 * MiB;
constexpr size_t WS_ACT = 568 * MiB;
static_assert(W_END <= WS_HM, "weights overflow");
constexpr size_t SZ_TOK = (size_t)MTOK * 1024 * 2;
constexpr size_t A_Q = WS_ACT, A_K = A_Q + SZ_TOK, A_V = A_K + SZ_TOK, A_VT = A_V + SZ_TOK;
constexpr size_t F_HID = WS_ACT;
constexpr size_t H_Q = WS_ACT, H_LFF = H_Q + SZ_TOK, H_LFB = H_LFF + SZ_TOK, H_V = H_LFB + SZ_TOK, H_G = H_V + SZ_TOK, H_OF = H_G + SZ_TOK, H_OB = H_OF + SZ_TOK;
constexpr size_t SZ_LRU = (size_t)MTOK * 1280 * 2;
constexpr size_t L_YB = WS_ACT, L_XB = L_YB + SZ_LRU, L_HF = L_XB + SZ_LRU, L_HY = L_HF + SZ_LRU;
constexpr int MOE_ROWS = 2 * MTOK + NEXP * 256;
constexpr size_t E_XS = WS_ACT, E_HID = E_XS + (size_t)MOE_ROWS * 1024 * 2, E_END = E_HID + (size_t)MOE_ROWS * DFFE;
constexpr size_t WS_XB = 1536 * MiB;
static_assert(E_END <= WS_XB && H_OB + SZ_TOK <= WS_XB && L_HY + SZ_LRU <= WS_XB && A_VT + SZ_TOK <= WS_XB, "activation regions below the residual stream");
constexpr size_t WS_NEED = WS_XB + SZ_TOK;
static_assert(WS_NEED <= (size_t)1792 * MiB, "workspace");

constexpr int CW_BAR = 4096;

constexpr int RING_BYTES = 135168;
constexpr int MISC_OFF = RING_BYTES;
constexpr int LDS_BYTES = 147456;
constexpr int NWAVES = 8, NTHR = 512;

typedef __bf16 bf16x2v __attribute__((ext_vector_type(2)));
__device__ __forceinline__ unsigned cvt_pk_bf16(float lo, float hi) { const f32x2 v = {lo, hi}; const bf16x2v b = __builtin_convertvector(v, bf16x2v); return __builtin_bit_cast(unsigned, b); }
__device__ __forceinline__ unsigned pk_fp8x4(float a, float b, float c, float d) { unsigned w = 0; w = __builtin_amdgcn_cvt_pk_fp8_f32(a, b, w, false); w = __builtin_amdgcn_cvt_pk_fp8_f32(c, d, w, true); return w; }
__device__ __forceinline__ unsigned f2bf(float f) { unsigned u = __builtin_bit_cast(unsigned, f); return (u + 0x7fffu + ((u >> 16) & 1u)) >> 16; }
__device__ __forceinline__ float bf2f(unsigned short b) { return __builtin_bit_cast(float, ((unsigned)b) << 16); }
__device__ __forceinline__ float bflo(unsigned w) { return __builtin_bit_cast(float, w << 16); }
__device__ __forceinline__ float bfhi(unsigned w) { return __builtin_bit_cast(float, w & 0xffff0000u); }
__device__ __forceinline__ float fexp2(float x) { return __builtin_amdgcn_exp2f(x); }
__device__ __forceinline__ float fexp(float x) { return __builtin_amdgcn_exp2f(x * LOG2E); }
__device__ __forceinline__ float frcp(float x) { return __builtin_amdgcn_rcpf(x); }
__device__ __forceinline__ float fsigmoid(float x) { return frcp(1.0f + fexp(-x)); }
__device__ __forceinline__ float fsilu(float x) { return x * fsigmoid(x); }
__device__ __forceinline__ float wave_sum(float v) {
#pragma unroll
    for (int o = 1; o < 64; o <<= 1) v += __shfl_xor(v, o);
    return v;
}
#define LDS_WAIT() asm volatile("s_waitcnt lgkmcnt(0)" ::: "memory")
#define VM_WAIT() asm volatile("s_waitcnt vmcnt(0)" ::: "memory")

#define XB_TMO      128
#define XB_XCNT(j)  (256  + 64 * (j))
#define XB_XSUB(j)  (1280 + 64 * (j))
#define XB_XGEN(j)  (2304 + 64 * (j))
#define XB_TOP      3328
#define XB_TOPGEN   3392
#define XCD_BAR_WORDS 3456
#define XB_SPIN_CAP (1u << 22)
__device__ __forceinline__ unsigned xb_ld(unsigned* p)              { return __hip_atomic_load(p, __ATOMIC_RELAXED, __HIP_MEMORY_SCOPE_AGENT); }
__device__ __forceinline__ unsigned xb_add(unsigned* p, unsigned v) { return __hip_atomic_fetch_add(p, v, __ATOMIC_RELAXED, __HIP_MEMORY_SCOPE_AGENT); }
__device__ __forceinline__ unsigned xb_xcc_id() { return (unsigned)__builtin_amdgcn_s_getreg((3 << 11) | 20) & 0xFu; }
#define XB_SPIN(cond, bar) do { unsigned _sp = 0; while (cond) { __builtin_amdgcn_s_sleep(1); \
    if ((++_sp & 255u) == 0u) { if (xb_ld(&(bar)[XB_TMO])) break; if (_sp > XB_SPIN_CAP) { atomicAdd(&(bar)[XB_TMO], 1u); break; } } } } while (0)
struct XcdBarrier { unsigned* bar; unsigned x; volatile LAS unsigned* st; };
__device__ __forceinline__ XcdBarrier xcd_barrier_post(unsigned* bar, volatile LAS unsigned* st) {
    XcdBarrier b; b.bar = bar; b.x = xb_xcc_id(); b.st = st;
    if (threadIdx.x == 0) (void)xb_add(&bar[XB_XCNT(b.x)], 1u);
    return b;
}
__device__ __forceinline__ void xcd_barrier_complete(unsigned* bar, unsigned x, unsigned& nloc, unsigned& nx) {
    const unsigned G = gridDim.x * gridDim.y * gridDim.z;
    unsigned sum, cnt, mine, sp = 0u;
    for (;;) {
        sum = 0u; cnt = 0u; mine = 0u;
#pragma unroll
        for (unsigned j = 0; j < 16; ++j) { const unsigned c = xb_ld(&bar[XB_XCNT(j)]); sum += c; cnt += (c > 0u) ? 1u : 0u; mine = (j == x) ? c : mine; }
        if (sum == G) break;
        __builtin_amdgcn_s_sleep(1);
        if ((++sp & 255u) == 0u) { if (xb_ld(&bar[XB_TMO])) break; if (sp > XB_SPIN_CAP) { atomicAdd(&bar[XB_TMO], 1u); break; } }
    }
    nloc = mine > 0u ? mine : 1u; nx = cnt > 0u ? cnt : 1u;
}
__device__ __forceinline__ void xcd_barrier(const XcdBarrier& b) {
    asm volatile("s_waitcnt vmcnt(0)" ::: "memory");
    __syncthreads();
    if (threadIdx.x == 0) {
        unsigned* bar = b.bar;
        __builtin_amdgcn_s_waitcnt(0);
        unsigned nloc = b.st[0], nx = b.st[1];
        if (nloc == 0u) { xcd_barrier_complete(bar, b.x, nloc, nx); b.st[0] = nloc; b.st[1] = nx; }
        const unsigned old = xb_add(&bar[XB_XSUB(b.x)], 1u);
        const unsigned gen = old / nloc;
        if (old + 1u == (gen + 1u) * nloc) {
            __builtin_amdgcn_fence(__ATOMIC_RELEASE, "agent");
            asm volatile("s_waitcnt vmcnt(0)" ::: "memory");
            const unsigned og = xb_add(&bar[XB_TOP], 1u);
            const unsigned tg = og / nx;
            if (og + 1u == (tg + 1u) * nx) xb_add(&bar[XB_TOPGEN], 1u);
            else XB_SPIN(xb_ld(&bar[XB_TOPGEN]) == tg, bar);
            __builtin_amdgcn_fence(__ATOMIC_ACQUIRE, "agent");
            xb_add(&bar[XB_XGEN(b.x)], 1u);
            asm volatile("s_waitcnt vmcnt(0)" ::: "memory");
        } else {
            XB_SPIN(xb_ld(&bar[XB_XGEN(b.x)]) == gen, bar);
            __builtin_amdgcn_fence(__ATOMIC_ACQUIRE, "agent");
            asm volatile("s_waitcnt vmcnt(0)" ::: "memory");
        }
    }
    __syncthreads();
}

namespace pg8 {
constexpr int BM = 256, BK = 64, HALF = 128, HTB = HALF * BK * 2, STAGE_BYTES = 8 * HTB, NXCD = 8, WGM = 8;
__host__ __device__ __forceinline__ int lds_byte(int r, int c) { const int st = (r >> 4) * 2 + (c >> 5), rr = r & 15, cc = c & 31, ob = rr * 64 + cc * 2; return st * 1024 + (ob ^ (((ob >> 9) & 1) << 5)); }
__host__ __device__ __forceinline__ void stage_rc(int b, int& R, int& C) { const int st = b / 1024, sb = b % 1024, swz = sb ^ (((sb >> 9) & 1) << 5); R = (st >> 1) * 16 + swz / 64; C = (st & 1) * 32 + (swz % 64) / 2; }
__host__ __device__ __forceinline__ int perm32(int rho) { const int n = rho >> 4, i = rho & 15; return 8 * (i >> 2) + 4 * n + (i & 3); }

struct Unit { int pm, pn, pb; };
struct Gemm { const bf16_t* A; const bf16_t* Bt; int K; };

struct TileOrder {
    int nM, nN, nwg, G, c; int ts[NEXP];
    __device__ __forceinline__ void init(int nM_, int nN_, int G_, int c_) { nM = nM_; nN = nN_; nwg = nM * nN; G = G_; c = c_;
#pragma unroll
        for (int e = 0; e < NEXP; ++e) ts[e] = (e == 0) ? 0 : 0x7fffffff; }
    __device__ __forceinline__ bool next(int i, Unit& u) const {
        const long L = (long)i * G + c; if (L >= nwg) return false;
        int wgid = (int)L; { const int q = nwg / NXCD, r = nwg % NXCD, xcd = wgid % NXCD, off = wgid / NXCD; wgid = (xcd < r ? xcd * (q + 1) : r * (q + 1) + (xcd - r) * q) + off; }
        const int nig = WGM * nN, gid = wgid / nig, fm = gid * WGM, gsz = (nM - fm) < WGM ? (nM - fm) : WGM;
        u.pm = fm + ((wgid % nig) % gsz); u.pn = (wgid % nig) / gsz;
        int e = 0;
#pragma unroll
        for (int k = 1; k < NEXP; ++k) e += (u.pm >= ts[k]) ? 1 : 0;
        u.pb = e * nN + u.pn; return true;
    }
};

typedef int v8i32 __attribute__((ext_vector_type(8)));
template <class Epi, bool FP8 = false>
__device__ __forceinline__ void gemm_phase(LAS unsigned char* lds, const Gemm g, const TileOrder& S, const Epi& E) {
    int tid_ = threadIdx.x; asm volatile("" : "+v"(tid_));
    const int tid = tid_, wid = __builtin_amdgcn_readfirstlane(tid >> 6), lane = tid & 63, wr = wid >> 2, wc = wid & 3, fr = lane & 15, fq = lane >> 4;
    const int K = g.K, nt = K / BK;
    unsigned voffA[2], voffB[2];
#pragma unroll
    for (int i = 0; i < 2; ++i) { int R, C; stage_rc(tid * 16 + i * 8192, R, C); const int Rb = Epi::PERM ? ((R & ~31) + perm32(R & 31)) : R;
        voffA[i] = (unsigned)(R * K + C) * 2u; voffB[i] = (unsigned)(Rb * K + C) * 2u; }
    const size_t kstep = (size_t)(BK * 2);
    const size_t hstep = (size_t)HALF * K * 2;
    const size_t tstep = 2 * hstep;
    const unsigned ldsw = (unsigned)wid * 1024u;
    const int aoff = lds_byte(wr * 64 + fr, fq * 8), boff = lds_byte(wc * 32 + fr, fq * 8);
#define PG8_SA(b, h) (((b) * 2 + (h)) * HTB)
#define PG8_SB(b, h) ((4 + (b) * 2 + (h)) * HTB)
#define PG8_STAGE(bufoff, gbase, voff) do { _Pragma("unroll") for (int _i = 0; _i < 2; ++_i) \
        __builtin_amdgcn_global_load_lds((const unsigned*)((const char*)(gbase) + (voff)[_i]), (LAS unsigned*)(lds + (bufoff) + ldsw + _i * 8192), 16, 0, 0); } while (0)
#define PG8_LD8(p) __builtin_bit_cast(v8i32, __builtin_shufflevector(*(const LAS u32x4*)(p), *(const LAS u32x4*)((p) + 1024), 0, 1, 2, 3, 4, 5, 6, 7))
#define PG8_LDA(dst, b, h) do { if constexpr (FP8) { _Pragma("unroll") for (int m = 0; m < 4; ++m) dst##8[m] = PG8_LD8(lds + PG8_SA(b, h) + aoff + m * 2048); } \
        else { _Pragma("unroll") for (int m = 0; m < 4; ++m) _Pragma("unroll") for (int k = 0; k < 2; ++k) dst[m][k] = *(const LAS bf16x8*)(lds + PG8_SA(b, h) + aoff + m * 2048 + k * 1024); } } while (0)
#define PG8_LDB(dst, b, h) do { if constexpr (FP8) { _Pragma("unroll") for (int n = 0; n < 2; ++n) dst##8[n] = PG8_LD8(lds + PG8_SB(b, h) + boff + n * 2048); } \
        else { _Pragma("unroll") for (int n = 0; n < 2; ++n) _Pragma("unroll") for (int k = 0; k < 2; ++k) dst[n][k] = *(const LAS bf16x8*)(lds + PG8_SB(b, h) + boff + n * 2048 + k * 1024); } } while (0)
#define PG8_MMA(ai, bj, At, Bt) do { __builtin_amdgcn_s_setprio(1); \
        if constexpr (FP8) { _Pragma("unroll") for (int m = 0; m < 4; ++m) _Pragma("unroll") for (int n = 0; n < 2; ++n) \
            asm volatile("v_mfma_scale_f32_16x16x128_f8f6f4 %0, %1, %2, %0, %3, %3 op_sel_hi:[0,0,0]" : "+v"(acc[ai][bj][m][n]) : "v"(Bt##8[n]), "v"(At##8[m]), "v"(one_scale)); } \
        else { _Pragma("unroll") for (int m = 0; m < 4; ++m) _Pragma("unroll") for (int n = 0; n < 2; ++n) _Pragma("unroll") for (int k = 0; k < 2; ++k) \
            acc[ai][bj][m][n] = __builtin_amdgcn_mfma_f32_16x16x32_bf16(Bt[n][k], At[m][k], acc[ai][bj][m][n], 0, 0, 0); } \
        __builtin_amdgcn_s_setprio(0); } while (0)
#define PG8_WAIT_V(n) asm volatile("s_waitcnt vmcnt(" #n ")" ::: "memory")
#define PG8_WAIT_L(n) asm volatile("s_waitcnt lgkmcnt(" #n ")" ::: "memory")
#define PG8_BAR __builtin_amdgcn_s_barrier()
#define PG8_SCHED __builtin_amdgcn_sched_barrier(0)
    Unit cur, nxt; int ui = 0;
    if (!S.next(0, cur)) return;
    f32x4 acc[2][2][4][2];
#pragma unroll
    for (int a = 0; a < 2; ++a)
#pragma unroll
        for (int b = 0; b < 2; ++b)
#pragma unroll
            for (int m = 0; m < 4; ++m)
#pragma unroll
                for (int n = 0; n < 2; ++n) acc[a][b][m][n] = (f32x4){0.f, 0.f, 0.f, 0.f};
    bf16x8 At[4][2], B0[2][2], B1[2][2]; v8i32 At8[4], B08[2], B18[2];
    int one_scale = 0x7f7f7f7f; asm volatile("" : "+v"(one_scale));
    const char* cA = (const char*)g.A + (size_t)cur.pm * tstep; const char* cB = (const char*)g.Bt + (size_t)cur.pb * tstep;
    PG8_STAGE(PG8_SB(0, 0), cB, voffB); PG8_STAGE(PG8_SA(0, 0), cA, voffA); PG8_STAGE(PG8_SB(0, 1), cB + hstep, voffB); PG8_STAGE(PG8_SA(0, 1), cA + hstep, voffA);
    if (wr == 1) PG8_BAR;
    PG8_WAIT_V(4); PG8_BAR;
    PG8_STAGE(PG8_SB(1, 0), cB + kstep, voffB); PG8_STAGE(PG8_SA(1, 0), cA + kstep, voffA); PG8_STAGE(PG8_SB(1, 1), cB + hstep + kstep, voffB);
    PG8_WAIT_V(6); PG8_BAR;
    for (;;) {
        const bool has_next = S.next(ui + 1, nxt);
        const char* nA = has_next ? (const char*)g.A + (size_t)nxt.pm * tstep : cA; const char* nB = has_next ? (const char*)g.Bt + (size_t)nxt.pb * tstep : cB;
        for (int t = 0; t < nt; t += 2) {
            const bool last = (t == nt - 2);
            const char* a1 = cA + (size_t)(t + 1) * kstep;
            const char* a2 = last ? nA : cA + (size_t)(t + 2) * kstep; const char* b2 = last ? nB : cB + (size_t)(t + 2) * kstep;
            const char* a3 = a2 + kstep; const char* b3 = b2 + kstep;
            PG8_LDB(B0, 0, 0); PG8_SCHED; PG8_LDA(At, 0, 0); PG8_STAGE(PG8_SA(1, 1), a1 + hstep, voffA);
            PG8_WAIT_L(8); PG8_BAR; PG8_WAIT_L(0); PG8_MMA(0, 0, At, B0); PG8_BAR; PG8_SCHED;
            PG8_LDB(B1, 0, 1); PG8_STAGE(PG8_SB(0, 0), b2, voffB);
            PG8_BAR; PG8_WAIT_L(0); PG8_MMA(0, 1, At, B1); PG8_BAR;
            PG8_LDA(At, 0, 1); PG8_STAGE(PG8_SA(0, 0), a2, voffA);
            PG8_BAR; PG8_WAIT_L(0); PG8_MMA(1, 0, At, B0); PG8_BAR; PG8_SCHED;
            PG8_STAGE(PG8_SB(0, 1), b2 + hstep, voffB);
            PG8_WAIT_V(6); PG8_BAR; PG8_MMA(1, 1, At, B1); PG8_BAR;
            PG8_LDB(B0, 1, 0); PG8_SCHED; PG8_LDA(At, 1, 0); PG8_STAGE(PG8_SA(0, 1), a2 + hstep, voffA);
            PG8_WAIT_L(8); PG8_BAR; PG8_WAIT_L(0); PG8_MMA(0, 0, At, B0); PG8_BAR; PG8_SCHED;
            PG8_LDB(B1, 1, 1); PG8_STAGE(PG8_SB(1, 0), b3, voffB);
            PG8_BAR; PG8_WAIT_L(0); PG8_MMA(0, 1, At, B1); PG8_BAR;
            PG8_LDA(At, 1, 1); PG8_STAGE(PG8_SA(1, 0), a3, voffA);
            PG8_BAR; PG8_WAIT_L(0); PG8_MMA(1, 0, At, B0); PG8_BAR; PG8_SCHED;
            PG8_STAGE(PG8_SB(1, 1), b3 + hstep, voffB);
            PG8_WAIT_V(6); PG8_BAR; PG8_MMA(1, 1, At, B1); PG8_BAR;
        }
        if constexpr (FP8) asm volatile("s_nop 15\n\ts_nop 15" ::: "memory");
        E(acc, cur, wr, wc, fr, fq);
        if (!has_next) break;
#pragma unroll
        for (int a = 0; a < 2; ++a)
#pragma unroll
            for (int b = 0; b < 2; ++b)
#pragma unroll
                for (int m = 0; m < 4; ++m)
#pragma unroll
                    for (int n = 0; n < 2; ++n) acc[a][b][m][n] = (f32x4){0.f, 0.f, 0.f, 0.f};
        cur = nxt; cA = nA; cB = nB; ++ui;
    }
    PG8_WAIT_V(0);
    if (wr == 0) PG8_BAR;
    PG8_BAR;
#undef PG8_SA
#undef PG8_SB
#undef PG8_STAGE
#undef PG8_LDA
#undef PG8_LDB
#undef PG8_MMA
#undef PG8_LD8
#undef PG8_WAIT_V
#undef PG8_WAIT_L
#undef PG8_BAR
#undef PG8_SCHED
}

struct EpiQKV {
    static constexpr bool PERM = true;
    bf16_t *Q, *Kk, *V; const float *gq, *gk, *cosT, *sinT; float qscale;
    __device__ __forceinline__ void operator()(const f32x4 (&acc)[2][2][4][2], const Unit& u, int wr, int wc, int fr, int fq) const {
        const int row0 = u.pm * BM + wr * 64 + fr;
        if (u.pn >= 8) {
            const int col0 = (u.pn - 8) * BM + wc * 32 + 8 * fq;
#pragma unroll
            for (int ai = 0; ai < 2; ++ai)
#pragma unroll
                for (int m = 0; m < 4; ++m) { bf16_t* rowp = V + (size_t)(row0 + ai * HALF + m * 16) * DM + col0;
#pragma unroll
                    for (int bj = 0; bj < 2; ++bj) { const f32x4 v0 = acc[ai][bj][m][0], v1 = acc[ai][bj][m][1];
                        u32x4 w; w.x = cvt_pk_bf16(v0[0], v0[1]); w.y = cvt_pk_bf16(v0[2], v0[3]); w.z = cvt_pk_bf16(v1[0], v1[1]); w.w = cvt_pk_bf16(v1[2], v1[3]);
                        *(u32x4*)(rowp + bj * HALF) = w; } }
        } else {
            const int part = u.pn >> 2, sh = 4 * (u.pn & 3) + wc;
            bf16_t* dst = part ? Kk : Q; const float* g = part ? gk : gq; const float sc = part ? 1.0f : qscale;
            f32x4 g0[2], g1[2];
#pragma unroll
            for (int n = 0; n < 2; ++n) { g0[n] = *(const f32x4*)(g + 8 * fq + 4 * n); g1[n] = *(const f32x4*)(g + 32 + 8 * fq + 4 * n); }
#pragma unroll
            for (int ai = 0; ai < 2; ++ai)
#pragma unroll
                for (int m = 0; m < 4; ++m) {
                    const int r = row0 + ai * HALF + m * 16; const int pos = r & (SEQ - 1);
                    f32x4 x1[2], x2[2]; float ss = 0.f;
#pragma unroll
                    for (int n = 0; n < 2; ++n) { x1[n] = acc[ai][0][m][n]; x2[n] = acc[ai][1][m][n];
                        ss += (x1[n][0] * x1[n][0] + x1[n][1] * x1[n][1]) + (x1[n][2] * x1[n][2] + x1[n][3] * x1[n][3]);
                        ss += (x2[n][0] * x2[n][0] + x2[n][1] * x2[n][1]) + (x2[n][2] * x2[n][2] + x2[n][3] * x2[n][3]); }
                    ss += __shfl_xor(ss, 16); ss += __shfl_xor(ss, 32);
                    const float rstd = __builtin_amdgcn_rsqf(ss * (1.0f / 64.0f) + EPS) ;
                    unsigned char* op = (unsigned char*)dst + (size_t)r * DM + sh * 64 + 8 * fq;
                    u32x2 w1, w2;
#pragma unroll
                    for (int n = 0; n < 2; ++n) {
                        const f32x4 cs = *(const f32x4*)(cosT + pos * 32 + 8 * fq + 4 * n), sn = *(const f32x4*)(sinT + pos * 32 + 8 * fq + 4 * n);
                        const f32x4 y1 = x1[n] * rstd * g0[n], y2 = x2[n] * rstd * g1[n];
                        const f32x4 o1 = (y1 * cs - y2 * sn) * sc, o2 = (y2 * cs + y1 * sn) * sc;
                        if (n == 0) { w1.x = pk_fp8x4(o1[0], o1[1], o1[2], o1[3]); w2.x = pk_fp8x4(o2[0], o2[1], o2[2], o2[3]); }
                        else { w1.y = pk_fp8x4(o1[0], o1[1], o1[2], o1[3]); w2.y = pk_fp8x4(o2[0], o2[1], o2[2], o2[3]); }
                    }
                    *(u32x2*)(op) = w1; *(u32x2*)(op + 32) = w2;
                }
        }
    }
};
__device__ __forceinline__ f32x4 ld_x4(const void* p, size_t i, bool is16) {
    if (is16) { const u32x2 w = *(const u32x2*)((const bf16_t*)p + i); return (f32x4){bflo(w.x), bfhi(w.x), bflo(w.y), bfhi(w.y)}; }
    return *(const f32x4*)((const float*)p + i);
}
template <bool IN16>
struct EpiRes {
    static constexpr bool PERM = false;
    const void* xin; bf16_t* xout; const float* gate; float sc;
    __device__ __forceinline__ void operator()(const f32x4 (&acc)[2][2][4][2], const Unit& u, int wr, int wc, int fr, int fq) const {
        const int row0 = u.pm * BM + wr * 64 + fr, col0 = u.pn * BM + wc * 32 + 4 * fq;
        const float* gp = gate + (size_t)(u.pm >> 5) * 6144 + col0;
        f32x4 gv[2][2];
#pragma unroll
        for (int bj = 0; bj < 2; ++bj)
#pragma unroll
            for (int n = 0; n < 2; ++n) gv[bj][n] = *(const f32x4*)(gp + bj * HALF + n * 16) * sc;
#pragma unroll
        for (int ai = 0; ai < 2; ++ai)
#pragma unroll
            for (int m = 0; m < 4; ++m) { const size_t off = (size_t)(row0 + ai * HALF + m * 16) * DM + col0;
                f32x4 xv[2][2];
#pragma unroll
                for (int bj = 0; bj < 2; ++bj)
#pragma unroll
                    for (int n = 0; n < 2; ++n) xv[bj][n] = ld_x4(xin, off + bj * HALF + n * 16, IN16);
#pragma unroll
                for (int bj = 0; bj < 2; ++bj)
#pragma unroll
                    for (int n = 0; n < 2; ++n) { const f32x4 o = xv[bj][n] + gv[bj][n] * acc[ai][bj][m][n];
                        *(u32x2*)(xout + off + bj * HALF + n * 16) = (u32x2){cvt_pk_bf16(o[0], o[1]), cvt_pk_bf16(o[2], o[3])}; }
                if (m == 3) asm volatile("" ::: "memory"); }
    }
};
struct EpiSwiGLU {
    static constexpr bool PERM = true;
    bf16_t* H; int ldh;
    __device__ __forceinline__ void operator()(const f32x4 (&acc)[2][2][4][2], const Unit& u, int wr, int wc, int fr, int fq) const {
        const int row0 = u.pm * BM + wr * 64 + fr, col0 = u.pn * HALF + wc * 32 + 8 * fq;
#pragma unroll
        for (int ai = 0; ai < 2; ++ai)
#pragma unroll
            for (int m = 0; m < 4; ++m) { bf16_t* rowp = H + (size_t)(row0 + ai * HALF + m * 16) * ldh + col0;
                f32x4 v[2];
#pragma unroll
                for (int n = 0; n < 2; ++n) { const f32x4 gt = acc[ai][0][m][n], up = acc[ai][1][m][n];
#pragma unroll
                    for (int j = 0; j < 4; ++j) v[n][j] = fsilu(gt[j]) * up[j]; }
                u32x4 w; w.x = cvt_pk_bf16(v[0][0], v[0][1]); w.y = cvt_pk_bf16(v[0][2], v[0][3]); w.z = cvt_pk_bf16(v[1][0], v[1][1]); w.w = cvt_pk_bf16(v[1][2], v[1][3]);
                *(u32x4*)rowp = w; }
    }
};
struct EpiSwiGLU8 {
    static constexpr bool PERM = true;
    unsigned char* H; int ldh; float ws, hs;
    __device__ __forceinline__ void operator()(const f32x4 (&acc)[2][2][4][2], const Unit& u, int wr, int wc, int fr, int fq) const {
        const int row0 = u.pm * BM + wr * 64 + fr, col0 = u.pn * HALF + wc * 32 + 8 * fq;
#pragma unroll
        for (int ai = 0; ai < 2; ++ai)
#pragma unroll
            for (int m = 0; m < 4; ++m) { unsigned char* rowp = H + (size_t)(row0 + ai * HALF + m * 16) * ldh + col0;
                f32x4 v[2];
#pragma unroll
                for (int n = 0; n < 2; ++n) { const f32x4 gt = acc[ai][0][m][n] * ws, up = acc[ai][1][m][n] * (ws * hs);
#pragma unroll
                    for (int j = 0; j < 4; ++j) v[n][j] = fsilu(gt[j]) * up[j]; }
                *(u32x2*)rowp = (u32x2){pk_fp8x4(v[0][0], v[0][1], v[0][2], v[0][3]), pk_fp8x4(v[1][0], v[1][1], v[1][2], v[1][3])}; }
    }
};
struct EpiPlain {
    static constexpr bool PERM = true;
    bf16_t* O; int ldc; float sc;
    __device__ __forceinline__ void operator()(const f32x4 (&acc)[2][2][4][2], const Unit& u, int wr, int wc, int fr, int fq) const {
        const int row0 = u.pm * BM + wr * 64 + fr, col0 = u.pn * BM + wc * 32 + 8 * fq;
#pragma unroll
        for (int ai = 0; ai < 2; ++ai)
#pragma unroll
            for (int m = 0; m < 4; ++m) { bf16_t* rowp = O + (size_t)(row0 + ai * HALF + m * 16) * ldc + col0;
#pragma unroll
                for (int bj = 0; bj < 2; ++bj) { const f32x4 v0 = acc[ai][bj][m][0] * sc, v1 = acc[ai][bj][m][1] * sc;
                    u32x4 w; w.x = cvt_pk_bf16(v0[0], v0[1]); w.y = cvt_pk_bf16(v0[2], v0[3]); w.z = cvt_pk_bf16(v1[0], v1[1]); w.w = cvt_pk_bf16(v1[2], v1[3]);
                    *(u32x4*)(rowp + bj * HALF) = w; } }
    }
};
struct EpiAct {
    static constexpr bool PERM = true;
    int kind; unsigned char* ws; const float* lb;
    __device__ __forceinline__ void operator()(const f32x4 (&acc)[2][2][4][2], const Unit& u, int wr, int wc, int fr, int fq) const {
        const int row0 = u.pm * BM + wr * 64 + fr;
        int mode, ldc, colt; size_t boff;
        if (kind == 0) { const int grp = u.pn >> 2; colt = (u.pn & 3) * 256; ldc = 1024;
            boff = grp == 0 ? H_Q : grp == 1 ? H_LFF : grp == 2 ? H_LFB : grp == 3 ? H_V : H_G; mode = (grp == 0 || grp == 4) ? 1 : (grp == 3 ? 0 : 3); }
        else { ldc = LRUW; if (u.pn < 5) { boff = L_YB; colt = u.pn * 256; mode = 2; } else { boff = L_XB; colt = (u.pn - 5) * 256; mode = 0; } }
        bf16_t* base = (bf16_t*)(ws + boff);
        const int col0 = colt + wc * 32 + 8 * fq;
        f32x4 lbv[2][2];
        if (mode == 3) { const float* lp = lb + ((u.pn >> 2) - 1) * 1024 + col0;
#pragma unroll
            for (int bj = 0; bj < 2; ++bj)
#pragma unroll
                for (int n = 0; n < 2; ++n) lbv[bj][n] = *(const f32x4*)(lp + bj * HALF + 4 * n); }
#pragma unroll
        for (int ai = 0; ai < 2; ++ai)
#pragma unroll
            for (int m = 0; m < 4; ++m) { bf16_t* rowp = base + (size_t)(row0 + ai * HALF + m * 16) * ldc + col0;
#pragma unroll
                for (int bj = 0; bj < 2; ++bj) { f32x4 v[2]; u32x4 w;
#pragma unroll
                    for (int n = 0; n < 2; ++n) { v[n] = acc[ai][bj][m][n];
                        if (mode == 1) {
#pragma unroll
                            for (int j = 0; j < 4; ++j) v[n][j] = fsilu(v[n][j]); }
                        else if (mode == 2) {
#pragma unroll
                            for (int j = 0; j < 4; ++j) { const float x = v[n][j]; v[n][j] = x * fsigmoid(1.5957691216057308f * (x + 0.044715f * x * x * x)); } }
                        else if (mode == 3) {
#pragma unroll
                            for (int j = 0; j < 4; ++j) { const float l = lbv[bj][n][j]; const float fg = l + (1.0f - l) * fsigmoid(v[n][j]); v[n][j] = __builtin_amdgcn_logf(fg) * 0.6931471805599453f; } }
                    }
                    if (mode == 3) {
#pragma unroll
                        for (int n = 0; n < 2; ++n) { const _Float16 h0 = (_Float16)v[n][0], h1 = (_Float16)v[n][1], h2 = (_Float16)v[n][2], h3 = (_Float16)v[n][3];
                            const unsigned a = (unsigned)__builtin_bit_cast(unsigned short, h0) | ((unsigned)__builtin_bit_cast(unsigned short, h1) << 16);
                            const unsigned b = (unsigned)__builtin_bit_cast(unsigned short, h2) | ((unsigned)__builtin_bit_cast(unsigned short, h3) << 16);
                            if (n == 0) { w.x = a; w.y = b; } else { w.z = a; w.w = b; } }
                    } else { w.x = cvt_pk_bf16(v[0][0], v[0][1]); w.y = cvt_pk_bf16(v[0][2], v[0][3]); w.z = cvt_pk_bf16(v[1][0], v[1][1]); w.w = cvt_pk_bf16(v[1][2], v[1][3]); }
                    *(u32x4*)(rowp + bj * HALF) = w; } }
    }
};
}

struct Args { const float* in[30]; float* out; unsigned char* ws; };
enum { I_X = 0, I_C, I_ADAW, I_ADAB, I_N1G, I_N2G, I_ATWIN, I_ATQN, I_ATKN, I_ATLAM, I_ATSUB, I_ATWOUT, I_HGWIN, I_HGLB, I_HGNG, I_HGWOUT,
       I_LRWIN, I_LRCW, I_LRCB, I_LRWA, I_LRBA, I_LRWX, I_LRBX, I_LRLAM, I_LRWOUT, I_FFGU, I_FFDN, I_MOER, I_MOEGU, I_MOEDN };
enum { SC_LAM0 = 0, SC_LAM1, SC_OML0, SC_OML1, SC_MC0, SC_MC1 };

__device__ __forceinline__ void cvt_item(const float* W, int ldw, int src_col0, bf16_t* WT, int ldt, int dst_row0, int k0, LAS float* scr, int lane) {
#pragma unroll 8
    for (int i = 0; i < 32; ++i) { const int kk = 2 * i + (lane >> 5); scr[kk * 33 + (lane & 31)] = W[(size_t)(k0 + kk) * ldw + src_col0 + (lane & 31)]; }
    LDS_WAIT(); asm volatile("" ::: "memory");
    const int c = lane & 7;
#pragma unroll
    for (int j = 0; j < 4; ++j) { const int n = (lane >> 3) + 8 * j; const LAS float* s = scr + (8 * c) * 33 + n;
        u32x4 o; o.x = cvt_pk_bf16(s[0 * 33], s[1 * 33]); o.y = cvt_pk_bf16(s[2 * 33], s[3 * 33]); o.z = cvt_pk_bf16(s[4 * 33], s[5 * 33]); o.w = cvt_pk_bf16(s[6 * 33], s[7 * 33]);
        *(u32x4*)(WT + (size_t)(dst_row0 + n) * ldt + k0 + 8 * c) = o; }
    LDS_WAIT(); asm volatile("" ::: "memory");
}
__device__ __forceinline__ void cvt_item8(const float* W, int ldw, int src_col0, unsigned char* WT, int ldt, int dst_row0, int k0, float sc, LAS float* scr, int lane) {
#pragma unroll 8
    for (int i = 0; i < 32; ++i) { const int kk = 2 * i + (lane >> 5); scr[kk * 33 + (lane & 31)] = W[(size_t)(k0 + kk) * ldw + src_col0 + (lane & 31)]; }
    LDS_WAIT(); asm volatile("" ::: "memory");
    const int c = lane & 7;
#pragma unroll
    for (int j = 0; j < 4; ++j) { const int n = (lane >> 3) + 8 * j; const LAS float* s = scr + (8 * c) * 33 + n;
        *(u32x2*)(WT + (size_t)(dst_row0 + n) * ldt + k0 + 8 * c) = (u32x2){pk_fp8x4(s[0 * 33] * sc, s[1 * 33] * sc, s[2 * 33] * sc, s[3 * 33] * sc), pk_fp8x4(s[4 * 33] * sc, s[5 * 33] * sc, s[6 * 33] * sc, s[7 * 33] * sc)}; }
    LDS_WAIT(); asm volatile("" ::: "memory");
}
enum { MAP_ID = 0, MAP_QKV = 1, MAP_SWI = 2 };
template <bool F8 = false>
__device__ __forceinline__ void cvt_family(const float* src, size_t sstride, int ninst, int ldw, int K, int ng, int map, int F, bf16_t* dst, size_t dstride,
                                           LAS float* scr, int gw, int NGW, int lane) {
    const int nkb = K / 64, per = nkb * ng, total = ninst * per;
    for (int it = gw; it < total; it += NGW) {
        const int inst = it / per, r = it - inst * per, kb = r / ng, gi = r - kb * ng;
        int sc0;
        if (map == MAP_ID) sc0 = 32 * gi;
        else if (map == MAP_QKV) { const int pn = gi >> 3, bj = (gi >> 2) & 1, wc = gi & 3;
            if (pn < 8) { const int part = pn >> 2, sh = 4 * (pn & 3) + wc; sc0 = part * 1024 + sh * 64 + 32 * bj; } else sc0 = 32 * gi; }
        else { const int pn = gi >> 3, bj = (gi >> 2) & 1, q = gi & 3; sc0 = bj * F + pn * 128 + 32 * q; }
        if constexpr (F8) cvt_item8(src + (size_t)inst * sstride, ldw, sc0, (unsigned char*)dst + (size_t)inst * dstride, K, 32 * gi, 64 * kb, MOE_WSCALE, scr, lane);
        else cvt_item(src + (size_t)inst * sstride, ldw, sc0, dst + (size_t)inst * dstride, K, 32 * gi, 64 * kb, scr, lane);
    }
}

__device__ __forceinline__ void prologue_phase(const Args& A, LAS unsigned char* lds, int bid, int G) {
    const int tid = threadIdx.x, lane = tid & 63, wave = tid >> 6;
    unsigned char* ws = A.ws;
    {
        LAS float* sc = (LAS float*)lds;
        LAS float* red = (LAS float*)(lds + 32768);
        for (int i = tid; i < NBATCH * DM; i += NTHR) { const float cv = A.in[I_C][i]; sc[i] = fsilu(cv); }
        __syncthreads();
        float* mods = (float*)(ws + TB_MODS);
        for (int cb = bid; cb < (DEPTH * 6144) / 128; cb += G) {
            const int col = cb * 128 + (tid & 127), l = col / 6144, e = col - l * 6144, ch = tid >> 7;
            const float* wp = A.in[I_ADAW] + (size_t)l * DM * 6144 + e;
            float a[NBATCH];
#pragma unroll
            for (int b = 0; b < NBATCH; ++b) a[b] = 0.f;
#pragma unroll 4
            for (int d = ch * 256; d < ch * 256 + 256; ++d) { const float w = wp[(size_t)d * 6144];
#pragma unroll
                for (int b = 0; b < NBATCH; ++b) a[b] += sc[b * DM + d] * w; }
#pragma unroll
            for (int b = 0; b < NBATCH; ++b) red[(ch * 128 + (tid & 127)) * 8 + b] = a[b];
            __syncthreads();
            if (tid < 128) { const float bias = A.in[I_ADAB][l * 6144 + e];
#pragma unroll
                for (int b = 0; b < NBATCH; ++b) { const float s = ((red[(0 * 128 + tid) * 8 + b] + red[(1 * 128 + tid) * 8 + b]) + (red[(2 * 128 + tid) * 8 + b] + red[(3 * 128 + tid) * 8 + b])) + bias;
                    mods[((size_t)l * NBATCH + b) * 6144 + e] = s; } }
            __syncthreads();
        }
    }
    {
        float* cosT = (float*)(ws + TB_COS); float* sinT = (float*)(ws + TB_SIN);
        for (int i = bid * NTHR + tid; i < SEQ * 32; i += G * NTHR) {
            const int pos = i >> 5, d = i & 31;
            const float inv = (float)exp(-(double)d * (1.0 / 32.0) * 9.210340371976184);
            const float ang = (float)pos * inv;
            const double rev = (double)ang * 0.15915494309189535; const float fr = (float)(rev - floor(rev));
            cosT[i] = __builtin_amdgcn_cosf(fr); sinT[i] = __builtin_amdgcn_sinf(fr);
        }
        if (bid == 0 && tid < 2) {
            const int a = tid; const float* lm = A.in[I_ATLAM] + a * 256;
            float s1 = 0.f, s2 = 0.f; for (int i = 0; i < 64; ++i) { s1 += lm[i] * lm[64 + i]; s2 += lm[128 + i] * lm[192 + i]; }
            const float linit = 0.8f - 0.6f * expf(-0.3f * (float)(3 * a));
            float mq = 0.f, mk = 0.f; for (int i = 0; i < 64; ++i) { mq = fmaxf(mq, fabsf(A.in[I_ATQN][a * 64 + i])); mk = fmaxf(mk, fabsf(A.in[I_ATKN][a * 64 + i])); }
            float* scal = (float*)(ws + TB_SCAL);
            scal[SC_LAM0 + a] = expf(s1) - expf(s2) + linit; scal[SC_OML0 + a] = 1.0f - linit; scal[SC_MC0 + a] = 8.0f * mq * mk * LOG2E * 1.0001f;
        }
        if (bid == 1) {
            float* lb = (float*)(ws + TB_LB);
            for (int i = tid; i < 2 * 1024; i += NTHR) { const int d = i >> 10, k = i & 1023; const float* p = A.in[I_HGLB] + (size_t)d * DEPTH * 1024 + k;
                float mx = p[0]; for (int l = 1; l < DEPTH; ++l) mx = fmaxf(mx, p[l * 1024]);
                float den = 0.f, num = 0.f; for (int l = 0; l < DEPTH; ++l) { const float e = expf(p[l * 1024] - mx); den += e; if (l == 1) num += e; }
                lb[i] = num / den; }
        }
        if (bid == 2) {
            float* sp = (float*)(ws + TB_SP);
            for (int i = tid; i < 2 * LRUW; i += NTHR) { const float x = -A.in[I_LRLAM][i]; sp[i] = (x > 20.f) ? x : log1pf(expf(x)); }
        }
    }
    {
        LAS float* scr = (LAS float*)(lds + wave * 16384);
        const int vcu = (bid % 8) * (G / 8) + bid / 8;
        const int gw = vcu * NWAVES + wave, NGW = G * NWAVES;
        cvt_family(A.in[I_ATWIN], (size_t)1024 * 3072, 2, 3072, 1024, 96, MAP_QKV, 0, (bf16_t*)(ws + W_QKV), (size_t)3072 * 1024, scr, gw, NGW, lane);
        cvt_family(A.in[I_ATWOUT], (size_t)1024 * 1024, 2, 1024, 1024, 32, MAP_ID, 0, (bf16_t*)(ws + W_AO), (size_t)1024 * 1024, scr, gw, NGW, lane);
        cvt_family(A.in[I_HGWIN], 0, 1, 5120, 1024, 160, MAP_ID, 0, (bf16_t*)(ws + W_HGI), 0, scr, gw, NGW, lane);
        cvt_family(A.in[I_HGWOUT], 0, 1, 1024, 1024, 32, MAP_ID, 0, (bf16_t*)(ws + W_HGO), 0, scr, gw, NGW, lane);
        cvt_family(A.in[I_LRWIN], 0, 1, 2560, 1024, 80, MAP_ID, 0, (bf16_t*)(ws + W_LRI), 0, scr, gw, NGW, lane);
        cvt_family(A.in[I_LRWOUT], 0, 1, 1024, 1280, 32, MAP_ID, 0, (bf16_t*)(ws + W_LRO), 0, scr, gw, NGW, lane);
        for (int it = gw; it < 2 * 20 * 2 * 4; it += NGW) {
            const int part = it / 160, r = it % 160, inst = r >> 3, kb = (r >> 2) & 1, gi = r & 3, d = inst / 10, n = inst % 10;
            const float* src = (part ? A.in[I_LRWX] : A.in[I_LRWA]) + (size_t)inst * 16384;
            cvt_item(src, 128, 32 * gi, (bf16_t*)(ws + W_LRG) + (size_t)(n * 2 + d) * 256 * 128, 128, part * 128 + 32 * gi, 64 * kb, scr, lane);
        }
        static_assert(FP8_DENSE_FROM == 2 || FP8_DENSE_FROM > 3, "dense layer 0 stays bf16; layer 2 optional");
        constexpr int NB16 = (FP8_DENSE_FROM == 2) ? 1 : 2;
        cvt_family(A.in[I_FFGU], (size_t)1024 * 5632, NB16, 5632, 1024, 176, MAP_SWI, DFF, (bf16_t*)(ws + W_FGU), (size_t)5632 * 1024, scr, gw, NGW, lane);
        cvt_family(A.in[I_FFDN], (size_t)2816 * 1024, NB16, 1024, 2816, 32, MAP_ID, 0, (bf16_t*)(ws + W_FDN), (size_t)1024 * 2816, scr, gw, NGW, lane);
        if constexpr (NB16 == 1) {
            cvt_family<true>(A.in[I_FFGU] + (size_t)1024 * 5632, 0, 1, 5632, 1024, 176, MAP_SWI, DFF, (bf16_t*)(ws + W_FGU) + (size_t)5632 * 1024, 0, scr, gw, NGW, lane);
            cvt_family<true>(A.in[I_FFDN] + (size_t)2816 * 1024, 0, 1, 1024, 2816, 32, MAP_ID, 0, (bf16_t*)(ws + W_FDN) + (size_t)1024 * 2816, 0, scr, gw, NGW, lane);
        }
        cvt_family<true>(A.in[I_MOEGU], (size_t)1024 * 7168, 16, 7168, 1024, 224, MAP_SWI, DFFE, (bf16_t*)(ws + W_MGU), (size_t)7168 * 1024, scr, gw, NGW, lane);
        cvt_family<true>(A.in[I_MOEDN], (size_t)3584 * 1024, 16, 1024, 3584, 32, MAP_ID, 0, (bf16_t*)(ws + W_MDN), (size_t)1024 * 3584, scr, gw, NGW, lane);
    }
}

template <bool ROUTER>
__device__ __forceinline__ void norm_phase(const Args& A, LAS unsigned char* lds, int bid, int G, const void* xsrc, bool src16, void* xdst, bool dst16, const float* gain, const float* modl  , int which,
                                           bool combine, const float* modprev  , bool nonorm, const float* router, bool f8out = false) {
    int tid_ = threadIdx.x; asm volatile("" : "+v"(tid_));
    const int tid = tid_, lane = tid & 63, wave = tid >> 6;
    unsigned char* ws = A.ws;
    bf16_t* HM = (bf16_t*)(ws + WS_HM);
    const int* slot = (const int*)(ws + TB_SLOT); const float* gts = (const float*)(ws + TB_GATE);
    const bf16_t* Y = (const bf16_t*)(ws + E_XS);
    LAS int* hist = (LAS int*)lds;
    for (int tb = bid; tb < MTOK / 256; tb += G) {
        const int b = tb >> 5;
        f32x4 ga[4], sh[4], g2[4];
#pragma unroll
        for (int j = 0; j < 4; ++j) { const int c = 256 * j + 4 * lane;
            if (!nonorm) { const f32x4 gv = *(const f32x4*)(gain + c), sv = *(const f32x4*)(modl + (size_t)b * 6144 + (which * 3 + 1) * 1024 + c);
                ga[j] = gv * (sv + 1.0f); sh[j] = *(const f32x4*)(modl + (size_t)b * 6144 + (which * 3) * 1024 + c); }
            if (combine) g2[j] = *(const f32x4*)(modprev + (size_t)b * 6144 + 5 * 1024 + c); }
        f32x4 rw[ROUTER ? 32 : 1];
        if constexpr (ROUTER) {
            if (tid < 8) hist[tid] = 0;
#pragma unroll
            for (int j = 0; j < 4; ++j)
#pragma unroll
                for (int i = 0; i < 4; ++i) { const int c = 256 * j + 4 * lane + i; rw[(j * 4 + i) * 2] = *(const f32x4*)(router + c * 8); rw[(j * 4 + i) * 2 + 1] = *(const f32x4*)(router + c * 8 + 4); }
            __syncthreads();
        }
        for (int i = 0; i < 32; ++i) {
            const int row = tb * 256 + wave * 32 + i;
            f32x4 v[4];
#pragma unroll
            for (int j = 0; j < 4; ++j) v[j] = pg8::ld_x4(xsrc, (size_t)row * DM + 256 * j + 4 * lane, src16);
            if (combine) {
                const int s0 = slot[row * 2], s1 = slot[row * 2 + 1]; const float w0 = gts[row * 2], w1 = gts[row * 2 + 1];
#pragma unroll
                for (int j = 0; j < 4; ++j) { const u32x2 a = *(const u32x2*)(Y + (size_t)s0 * DM + 256 * j + 4 * lane), c2 = *(const u32x2*)(Y + (size_t)s1 * DM + 256 * j + 4 * lane);
                    f32x4 y; y[0] = w0 * bflo(a.x) + w1 * bflo(c2.x); y[1] = w0 * bfhi(a.x) + w1 * bfhi(c2.x); y[2] = w0 * bflo(a.y) + w1 * bflo(c2.y); y[3] = w0 * bfhi(a.y) + w1 * bfhi(c2.y);
                    v[j] = v[j] + g2[j] * y;
                    if (dst16) *(u32x2*)((bf16_t*)xdst + (size_t)row * DM + 256 * j + 4 * lane) = (u32x2){cvt_pk_bf16(v[j][0], v[j][1]), cvt_pk_bf16(v[j][2], v[j][3])};
                    else *(f32x4*)((float*)xdst + (size_t)row * DM + 256 * j + 4 * lane) = v[j]; }
            }
            if (nonorm) continue;
            float ss = 0.f;
#pragma unroll
            for (int j = 0; j < 4; ++j) ss += (v[j][0] * v[j][0] + v[j][1] * v[j][1]) + (v[j][2] * v[j][2] + v[j][3] * v[j][3]);
            ss = wave_sum(ss);
            const float rstd = 1.0f / sqrtf(ss * (1.0f / DM) + EPS);
            f32x4 h[4];
#pragma unroll
            for (int j = 0; j < 4; ++j) { h[j] = v[j] * rstd * ga[j] + sh[j];
                if (f8out) { *(unsigned*)((unsigned char*)HM + (size_t)row * DM + 256 * j + 4 * lane) = pk_fp8x4(h[j][0], h[j][1], h[j][2], h[j][3]); }
                else { u32x2 w; w.x = cvt_pk_bf16(h[j][0], h[j][1]); w.y = cvt_pk_bf16(h[j][2], h[j][3]);
                    *(u32x2*)(HM + (size_t)row * DM + 256 * j + 4 * lane) = w; } }
            if constexpr (ROUTER) {
                float lg[8];
#pragma unroll
                for (int e = 0; e < 8; ++e) lg[e] = 0.f;
#pragma unroll
                for (int j = 0; j < 4; ++j)
#pragma unroll
                    for (int q = 0; q < 4; ++q) { const float hv = h[j][q]; const f32x4 r0 = rw[(j * 4 + q) * 2], r1 = rw[(j * 4 + q) * 2 + 1];
                        lg[0] += hv * r0[0]; lg[1] += hv * r0[1]; lg[2] += hv * r0[2]; lg[3] += hv * r0[3]; lg[4] += hv * r1[0]; lg[5] += hv * r1[1]; lg[6] += hv * r1[2]; lg[7] += hv * r1[3]; }
#pragma unroll
                for (int e = 0; e < 8; ++e) lg[e] = wave_sum(lg[e]);
                int e0 = 0; float v0 = lg[0];
#pragma unroll
                for (int e = 1; e < 8; ++e) if (lg[e] > v0) { v0 = lg[e]; e0 = e; }
                int e1 = -1; float v1 = -3.0e38f;
#pragma unroll
                for (int e = 0; e < 8; ++e) if (e != e0 && lg[e] > v1) { v1 = lg[e]; e1 = e; }
                const float p1 = frcp(1.0f + fexp(v1 - v0));
                if (lane == 0) { int* eid = (int*)(ws + TB_EID); float* gt = (float*)(ws + TB_GATE);
                    eid[row * 2] = e0; eid[row * 2 + 1] = e1; gt[row * 2] = p1; gt[row * 2 + 1] = 1.0f - p1;
                    atomicAdd((int*)&hist[e0], 1); atomicAdd((int*)&hist[e1], 1); }
            }
        }
        if constexpr (ROUTER) {
            __syncthreads();
            if (tid < 8) ((int*)(ws + TB_BCNT))[tb * 8 + tid] = hist[tid];
            __syncthreads();
        }
    }
}

namespace lru {
constexpr int XCF = 0, XCB = 16384, AA = 24576, UU = 40960;
__device__ __forceinline__ int sw256(int row, int cb) { return row * 256 + (cb ^ ((row & 15) << 4)); }
__device__ __forceinline__ int crow(int r, int hi) { return (r & 3) + 8 * (r >> 2) + 4 * hi; }
template <int MODE>
__device__ __forceinline__ void lru_item(const Args& A, LAS unsigned char* lds, int b, int n, int seg, int dir) {
    int tid_ = threadIdx.x; asm volatile("" : "+v"(tid_));
    const int tid = tid_, wid = tid >> 6, lane = tid & 63, r = lane & 31, hh = lane >> 5;
    unsigned char* ws = A.ws;
    const bf16_t* XB = (const bf16_t*)(ws + L_XB); const bf16_t* YB = (const bf16_t*)(ws + L_YB); bf16_t* HF = (bf16_t*)(ws + L_HF); bf16_t* HY = (bf16_t*)(ws + L_HY);
    const bf16_t* Wg = (const bf16_t*)(ws + W_LRG) + (size_t)((n * 2 + dir) * 256 + ((r < 16) ? (16 * wid + r) : (128 + 16 * wid + r - 16))) * 128 + 8 * hh;
    bf16x8 bfrag[8];
#pragma unroll
    for (int ks = 0; ks < 8; ++ks) bfrag[ks] = *(const bf16x8*)(Wg + 16 * ks);
    const int cch = n * 128 + 16 * wid + (r & 15);
    const float nba = -LOG2E * A.in[I_LRBA][dir * LRUW + cch], nbx = -LOG2E * A.in[I_LRBX][dir * LRUW + cch], csp = -8.0f * LOG2E * ((const float*)(ws + TB_SP))[dir * LRUW + cch];
    const int ct = tid >> 4, cg = tid & 15, cc0 = n * 128 + 8 * cg;
    float cw[4][8], cb[8];
#pragma unroll
    for (int j = 0; j < 8; ++j) { cb[j] = A.in[I_LRCB][cc0 + j];
#pragma unroll
        for (int w = 0; w < 4; ++w) cw[w][j] = A.in[I_LRCW][w * LRUW + cc0 + j]; }
    float carry = 0.f, P = 1.f;
    if (MODE != 0 && tid < 128) carry = ((const float*)(ws + TB_LCIN))[(size_t)((b * 32 + seg) * 2 + dir) * LRUW + n * 128 + tid];
    u32x4 xr[4];
#define LRU_XLOAD(si_) do { const int sub_ = dir ? (7 - (si_)) : (si_); const int tok_ = seg * 256 + sub_ * 32 + ct; \
        _Pragma("unroll") for (int w = 0; w < 4; ++w) { const int tt = tok_ - 1 + w; xr[w] = (tt >= 0 && tt < SEQ) ? *(const u32x4*)(XB + ((size_t)b * SEQ + tt) * LRUW + cc0) : (u32x4){0u, 0u, 0u, 0u}; } } while (0)
    LRU_XLOAD(0);
    for (int si = 0; si < 8; ++si) {
        const int sub = dir ? (7 - si) : si; const int t0 = seg * 256 + sub * 32;
        {
            float xc[8];
#pragma unroll
            for (int j = 0; j < 8; ++j) xc[j] = cb[j];
#pragma unroll
            for (int w = 0; w < 4; ++w) { const u32x4 v = xr[w];
#pragma unroll
                for (int e = 0; e < 4; ++e) { xc[2 * e] += cw[w][2 * e] * bflo(v[e]); xc[2 * e + 1] += cw[w][2 * e + 1] * bfhi(v[e]); } }
            if (si + 1 < 8) LRU_XLOAD(si + 1);
            *(LAS f32x4*)(lds + XCF + (ct * 128 + 8 * cg) * 4) = (f32x4){xc[0], xc[1], xc[2], xc[3]};
            *(LAS f32x4*)(lds + XCF + (ct * 128 + 8 * cg + 4) * 4) = (f32x4){xc[4], xc[5], xc[6], xc[7]};
            *(LAS u32x4*)(lds + XCB + sw256(ct, 16 * cg)) = (u32x4){cvt_pk_bf16(xc[0], xc[1]), cvt_pk_bf16(xc[2], xc[3]), cvt_pk_bf16(xc[4], xc[5]), cvt_pk_bf16(xc[6], xc[7])};
        }
        __syncthreads();
        {
            f32x16 acc = {};
#pragma unroll
            for (int ks = 0; ks < 8; ++ks) { const bf16x8 fa = *(const LAS bf16x8*)(lds + XCB + sw256(r, (16 * ks + 8 * hh) * 2)); acc = __builtin_amdgcn_mfma_f32_32x32x16_bf16(fa, bfrag[ks], acc, 0, 0, 0); }
#pragma unroll
            for (int q = 0; q < 8; ++q) {
                const auto sw = __builtin_amdgcn_permlane16_swap(__float_as_uint(acc[q]), __float_as_uint(acc[8 + q]), false, false);
                const float rp = __uint_as_float(sw[0]), ip = __uint_as_float(sw[1]);
                const int tq = crow((r < 16) ? q : (8 + q), hh); const int cl = 16 * wid + (r & 15);
                const float xcv = ((const LAS float*)(lds + XCF))[tq * 128 + cl];
                const float rg = frcp(1.0f + fexp2(fmaf(rp, -LOG2E, nba))), ig = frcp(1.0f + fexp2(fmaf(ip, -LOG2E, nbx)));
                const float av = fexp2(csp * rg), uv = __builtin_amdgcn_sqrtf(fmaxf(fmaf(-av, av, 1.0f), 0.f)) * ig * xcv;
                ((LAS float*)(lds + AA))[tq * 128 + cl] = av; ((LAS float*)(lds + UU))[tq * 128 + cl] = uv; }
        }
        __syncthreads();
        if (tid < 128) {
            LAS float* ap = (LAS float*)(lds + AA) + tid; LAS float* up = (LAS float*)(lds + UU) + tid; float av[32], uv[32];
#pragma unroll
            for (int i = 0; i < 32; ++i) { av[i] = ap[i * 128]; uv[i] = up[i * 128]; }
            if (dir == 0) {
#pragma unroll
                for (int i = 0; i < 32; ++i) { carry = av[i] * carry + uv[i]; if (MODE == 0) P *= av[i]; else uv[i] = carry; } }
            else {
#pragma unroll
                for (int i = 31; i >= 0; --i) { carry = av[i] * carry + uv[i]; if (MODE == 0) P *= av[i]; else uv[i] = carry; } }
            if (MODE != 0) {
#pragma unroll
                for (int i = 0; i < 32; ++i) up[i * 128] = uv[i]; }
        }
        if (MODE != 0) {
            __syncthreads();
            const int tok = t0 + ct; const size_t go = ((size_t)b * SEQ + tok) * LRUW + cc0;
            const f32x4 h0 = *(const LAS f32x4*)(lds + UU + (ct * 128 + 8 * cg) * 4), h1 = *(const LAS f32x4*)(lds + UU + (ct * 128 + 8 * cg + 4) * 4);
            if (MODE == 1) { *(u32x4*)(HF + go) = (u32x4){cvt_pk_bf16(h0[0], h0[1]), cvt_pk_bf16(h0[2], h0[3]), cvt_pk_bf16(h1[0], h1[1]), cvt_pk_bf16(h1[2], h1[3])}; }
            else { const u32x4 f = *(const u32x4*)(HF + go), y = *(const u32x4*)(YB + go);
                *(u32x4*)(HY + go) = (u32x4){cvt_pk_bf16((h0[0] + bflo(f[0])) * bflo(y[0]), (h0[1] + bfhi(f[0])) * bfhi(y[0])), cvt_pk_bf16((h0[2] + bflo(f[1])) * bflo(y[1]), (h0[3] + bfhi(f[1])) * bfhi(y[1])),
                                            cvt_pk_bf16((h1[0] + bflo(f[2])) * bflo(y[2]), (h1[1] + bfhi(f[2])) * bfhi(y[2])), cvt_pk_bf16((h1[2] + bflo(f[3])) * bflo(y[3]), (h1[3] + bfhi(f[3])) * bfhi(y[3]))}; }
        }
        __syncthreads();
    }
#undef LRU_XLOAD
    if (MODE == 0 && tid < 128) { float* sm = (float*)(ws + TB_LSUM) + (size_t)(((b * 32 + seg) * 2 + dir) * 2) * LRUW + n * 128 + tid; sm[0] = P; sm[LRUW] = carry; }
}
}
template <int MODE>
__device__ __forceinline__ void lru_phase(const Args& A, LAS unsigned char* lds, int bid, int G) {
    const int nitems = (MODE == 0) ? 5120 : 2560;
    for (int it = bid; it < nitems; it += G) {
        int b, n, seg, dir;
        if (MODE == 0) { dir = it & 1; const int r = it >> 1; seg = r & 31; n = (r >> 5) % 10; b = r / 320; }
        else { dir = MODE - 1; seg = it & 31; n = (it >> 5) % 10; b = it / 320; }
        lru::lru_item<MODE>(A, lds, b, n, seg, dir);
    }
}
__device__ __forceinline__ void lru_carry_phase(const Args& A, int bid, int G) {
    const float* sm = (const float*)(A.ws + TB_LSUM); float* cin = (float*)(A.ws + TB_LCIN);
    for (int idx = bid * NTHR + threadIdx.x; idx < NBATCH * 2 * LRUW; idx += G * NTHR) {
        const int b = idx / (2 * LRUW), r = idx % (2 * LRUW), dir = r / LRUW, ch = r % LRUW; float carry = 0.f;
        for (int i = 0; i < 32; ++i) { const int sg = dir ? (31 - i) : i; const size_t o = (size_t)((b * 32 + sg) * 2 + dir);
            cin[o * LRUW + ch] = carry; carry = sm[o * 2 * LRUW + ch] * carry + sm[o * 2 * LRUW + LRUW + ch]; }
    }
}

__device__ __forceinline__ void place_phase(const Args& A, LAS unsigned char* lds, int bid, int G) {
    int tid_ = threadIdx.x; asm volatile("" : "+v"(tid_));
    const int tid = tid_, lane = tid & 63, wave = tid >> 6; unsigned char* ws = A.ws;
    const int* bcnt = (const int*)(ws + TB_BCNT); const int* eid = (const int*)(ws + TB_EID); int* slot = (int*)(ws + TB_SLOT);
    const bf16_t* HM = (const bf16_t*)(ws + WS_HM); bf16_t* XS = (bf16_t*)(ws + E_XS);
    LAS int* tot = (LAS int*)lds; LAS int* pre = tot + 8; LAS int* rb = tot + 16; LAS int* wcn = tot + 32; LAS int* sl = tot + 64;
    for (int tb = bid; tb < MTOK / 256; tb += G) {
        { int t_ = 0, p_ = 0;
#pragma unroll
            for (int j = 0; j < 4; ++j) { const int blk = lane + 64 * j; const int v = bcnt[blk * 8 + wave]; t_ += v; p_ += (blk < tb) ? v : 0; }
#pragma unroll
            for (int o = 1; o < 64; o <<= 1) { t_ += __shfl_xor(t_, o); p_ += __shfl_xor(p_, o); }
            if (lane == 0) { tot[wave] = t_; pre[wave] = p_; } }
        __syncthreads();
        if (tid == 0) { int acc = 0; for (int e = 0; e < 8; ++e) { rb[e] = acc * 256; if (tb == 0) ((int*)(ws + TB_TILES))[e] = acc; acc += (tot[e] + 255) >> 8; } if (tb == 0) ((int*)(ws + TB_TILES))[8] = acc; }
        int e0 = -1, e1 = -1; unsigned long long mk0 = 0, mk1 = 0;
        if (tid < 256) { e0 = eid[(tb * 256 + tid) * 2]; e1 = eid[(tb * 256 + tid) * 2 + 1];
#pragma unroll
            for (int e = 0; e < 8; ++e) { const unsigned long long m = __ballot(e0 == e || e1 == e); if (lane == 0) wcn[wave * 8 + e] = __popcll(m); if (e0 == e) mk0 = m; if (e1 == e) mk1 = m; } }
        __syncthreads();
        if (tid < 256) { const unsigned long long lt = (1ull << lane) - 1ull; int b0 = rb[e0] + pre[e0] + __popcll(mk0 & lt), b1 = rb[e1] + pre[e1] + __popcll(mk1 & lt);
            for (int w = 0; w < wave; ++w) { b0 += wcn[w * 8 + e0]; b1 += wcn[w * 8 + e1]; }
            sl[tid * 2] = b0; sl[tid * 2 + 1] = b1; slot[(tb * 256 + tid) * 2] = b0; slot[(tb * 256 + tid) * 2 + 1] = b1; }
        __syncthreads();
        for (int i = 0; i < 32; ++i) { const int t = wave * 32 + i; const int s0 = sl[t * 2], s1 = sl[t * 2 + 1];
            const bf16_t* src = HM + (size_t)(tb * 256 + t) * DM + lane * 16;
            const u32x4 a = *(const u32x4*)src, b = *(const u32x4*)(src + 8);
            const u32x4 q = {pk_fp8x4(bflo(a[0]), bfhi(a[0]), bflo(a[1]), bfhi(a[1])), pk_fp8x4(bflo(a[2]), bfhi(a[2]), bflo(a[3]), bfhi(a[3])),
                             pk_fp8x4(bflo(b[0]), bfhi(b[0]), bflo(b[1]), bfhi(b[1])), pk_fp8x4(bflo(b[2]), bfhi(b[2]), bflo(b[3]), bfhi(b[3]))};
            *(u32x4*)((unsigned char*)XS + (size_t)s0 * DM + lane * 16) = q; *(u32x4*)((unsigned char*)XS + (size_t)s1 * DM + lane * 16) = q; }
        __syncthreads();
    }
}

namespace att {
constexpr int KVBLK = 64;
#define SBAR() __builtin_amdgcn_sched_barrier(0)
typedef int v8i __attribute__((ext_vector_type(8)));
__device__ __forceinline__ int crow(int r, int hi) { return (r & 3) + 8 * (r >> 2) + 4 * hi; }
constexpr int SLOTB = 8192;
__device__ __forceinline__ int k_slot(int s) { return s * SLOTB; }
__device__ __forceinline__ int v_slot(int s) { return 65536 + s * SLOTB; }
__device__ __forceinline__ int kswz(int row) { return ((row & 7) ^ (row >> 4)) & 7; }
__device__ __forceinline__ int vswz(int row) { return (row >> 2) & 3; }
__device__ __forceinline__ void mfma8_acc(f32x16& acc, const v8i& a, const v8i& b, int sc) {
    asm volatile("s_nop 4\n\tv_mfma_scale_f32_32x32x64_f8f6f4 %0, %1, %2, %0, %3, %3 op_sel_hi:[0,0,0]" : "+v"(acc) : "v"(a), "v"(b), "v"(sc) : "memory");
}
__device__ __forceinline__ void mfma8_c(f32x16& d, const v8i& a, const v8i& b, const f32x16& c, int sa, int sb) {
    asm volatile("v_mfma_scale_f32_32x32x64_f8f6f4 %0, %1, %2, %3, %4, %5 op_sel_hi:[0,0,0]" : "=&v"(d) : "v"(a), "v"(b), "v"(c), "v"(sa), "v"(sb) : "memory");
}
#define ATT_LD8(p0_, p1_) __builtin_bit_cast(v8i, __builtin_shufflevector(*(const LAS u32x4*)(p0_), *(const LAS u32x4*)(p1_), 0, 1, 2, 3, 4, 5, 6, 7))
__device__ __forceinline__ void qkt(f32x16& p0, f32x16& p1, const LAS char* Ks, const v8i& qr, int r32, int hi, int jj, const f32x16& cinit, int s1, int s8) {
    const int c0 = jj * 4 + 2 * hi;
    { const int row = r32; const v8i kf = ATT_LD8(Ks + row * 128 + ((c0 ^ kswz(row)) << 4), Ks + row * 128 + (((c0 + 1) ^ kswz(row)) << 4)); mfma8_c(p0, kf, qr, cinit, s1, s8); }
    { const int row = 32 + r32; const v8i kf = ATT_LD8(Ks + row * 128 + ((c0 ^ kswz(row)) << 4), Ks + row * 128 + (((c0 + 1) ^ kswz(row)) << 4)); mfma8_c(p1, kf, qr, cinit, s1, s8); }
}
__device__ __forceinline__ void load_kf(v8i& kf0, v8i& kf1, const LAS char* Ks, int r32, int hi, int jj) {
    const int c0 = jj * 4 + 2 * hi, row1 = 32 + r32;
    kf0 = ATT_LD8(Ks + r32 * 128 + ((c0 ^ kswz(r32)) << 4), Ks + r32 * 128 + (((c0 + 1) ^ kswz(r32)) << 4));
    kf1 = ATT_LD8(Ks + row1 * 128 + ((c0 ^ kswz(row1)) << 4), Ks + row1 * 128 + (((c0 + 1) ^ kswz(row1)) << 4));
}
#define ATT_VFR(Vs, d0) ATT_LD8((Vs) + (32 * (d0) + r32) * 64 + (((2 * hi) ^ vswz(32 * (d0) + r32)) << 4), (Vs) + (32 * (d0) + r32) * 64 + (((2 * hi + 1) ^ vswz(32 * (d0) + r32)) << 4))
__device__ __forceinline__ void pack_p(const float (&pe)[32], v8i& pa);
__device__ __forceinline__ void qkt_pack(f32x16& p0, f32x16& p1, const v8i& kf0, const v8i& kf1, const v8i& qr, const f32x16& cinit, int s1, int s8, const float (&pe)[32], v8i& pa) {
#define ATT_MC8(d, kf, B, O0, O1, O2, O3) \
    asm volatile("v_mfma_scale_f32_32x32x64_f8f6f4 %0, %21, %22, %23, %24, %25 op_sel_hi:[0,0,0]\n\t" \
                 "v_cvt_pk_fp8_f32 %1, %5, %6\n\tv_cvt_pk_fp8_f32 %1, %7, %8 op_sel:[0,0,1]\n\t" \
                 "v_cvt_pk_fp8_f32 %2, %9, %10\n\tv_cvt_pk_fp8_f32 %2, %11, %12 op_sel:[0,0,1]\n\t" \
                 "v_cvt_pk_fp8_f32 %3, %13, %14\n\tv_cvt_pk_fp8_f32 %3, %15, %16 op_sel:[0,0,1]\n\t" \
                 "v_cvt_pk_fp8_f32 %4, %17, %18\n\tv_cvt_pk_fp8_f32 %4, %19, %20 op_sel:[0,0,1]" \
                 : "=&v"(d), "=&v"(O0), "=&v"(O1), "=&v"(O2), "=&v"(O3) \
                 : "v"(pe[B]), "v"(pe[B + 1]), "v"(pe[B + 2]), "v"(pe[B + 3]), "v"(pe[B + 4]), "v"(pe[B + 5]), "v"(pe[B + 6]), "v"(pe[B + 7]), \
                   "v"(pe[B + 8]), "v"(pe[B + 9]), "v"(pe[B + 10]), "v"(pe[B + 11]), "v"(pe[B + 12]), "v"(pe[B + 13]), "v"(pe[B + 14]), "v"(pe[B + 15]), \
                   "v"(kf), "v"(qr), "v"(cinit), "v"(s1), "v"(s8) : "memory")
    int q0, q1, q2, q3, q4, q5, q6, q7;
    ATT_MC8(p0, kf0, 0, q0, q1, q2, q3);
    ATT_MC8(p1, kf1, 16, q4, q5, q6, q7);
#undef ATT_MC8
    pa = (v8i){q0, q1, q2, q3, q4, q5, q6, q7};
}
__device__ __forceinline__ void partialSM(f32x16& p0) {
#pragma unroll
    for (int r = 0; r < 16; ++r) p0[r] = fexp2(p0[r]);
}
__device__ __forceinline__ void finishSM(f32x16& p0, f32x16& p1, v8i& pa) {
#pragma unroll
    for (int r = 0; r < 16; ++r) p1[r] = fexp2(p1[r]);
#pragma unroll
    for (int w = 0; w < 4; ++w) { pa[w] = (int)pk_fp8x4(p0[4 * w], p0[4 * w + 1], p0[4 * w + 2], p0[4 * w + 3]); pa[4 + w] = (int)pk_fp8x4(p1[4 * w], p1[4 * w + 1], p1[4 * w + 2], p1[4 * w + 3]); }
}
#define ATT_MX7(acc, a, b, sc, NOP, O, I, k) \
    asm volatile(NOP "v_mfma_scale_f32_32x32x64_f8f6f4 %0, %15, %16, %0, %17, %17 op_sel_hi:[0,0,0]\n\tv_exp_f32 %1, %8\n\tv_exp_f32 %2, %9\n\tv_exp_f32 %3, %10\n\tv_exp_f32 %4, %11\n\tv_exp_f32 %5, %12\n\tv_exp_f32 %6, %13\n\tv_exp_f32 %7, %14" \
                 : "+v"(acc), "=&v"(O[k]), "=&v"(O[k + 1]), "=&v"(O[k + 2]), "=&v"(O[k + 3]), "=&v"(O[k + 4]), "=&v"(O[k + 5]), "=&v"(O[k + 6]) \
                 : "v"(I(k)), "v"(I(k + 1)), "v"(I(k + 2)), "v"(I(k + 3)), "v"(I(k + 4)), "v"(I(k + 5)), "v"(I(k + 6)), "v"(a), "v"(b), "v"(sc) : "memory")
__device__ __forceinline__ void pv_exp(f32x16* o, f32x16& lacc, const v8i& ones, const v8i& vf0, const v8i& vf1, const v8i& vf2, const v8i& vf3, const v8i& pa, int s1, const f32x16& r0, const f32x16& r1, float (&pe)[32]) {
#define ATT_RI(k) (((k) < 16) ? r0[(k) & 15] : r1[(k) & 15])
    ATT_MX7(o[0], pa, vf0, s1, "s_nop 4\n\t", pe, ATT_RI, 0);
    ATT_MX7(o[1], pa, vf1, s1, "", pe, ATT_RI, 7);
    ATT_MX7(o[2], pa, vf2, s1, "", pe, ATT_RI, 14);
    ATT_MX7(o[3], pa, vf3, s1, "", pe, ATT_RI, 21);
    asm volatile("v_mfma_scale_f32_32x32x64_f8f6f4 %0, %9, %10, %0, %11, %11 op_sel_hi:[0,0,0]\n\tv_exp_f32 %1, %5\n\tv_exp_f32 %2, %6\n\tv_exp_f32 %3, %7\n\tv_exp_f32 %4, %8"
                 : "+v"(lacc), "=&v"(pe[28]), "=&v"(pe[29]), "=&v"(pe[30]), "=&v"(pe[31]) : "v"(r1[12]), "v"(r1[13]), "v"(r1[14]), "v"(r1[15]), "v"(pa), "v"(ones), "v"(s1) : "memory");
#undef ATT_RI
}
__device__ __forceinline__ void pack_p(const float (&pe)[32], v8i& pa) {
#pragma unroll
    for (int w = 0; w < 8; ++w) pa[w] = (int)pk_fp8x4(pe[4 * w], pe[4 * w + 1], pe[4 * w + 2], pe[4 * w + 3]);
}
__device__ __forceinline__ void pv_d0(f32x16* o, f32x16& lacc, const v8i& ones, const LAS char* Vs, const v8i& pa, int r32, int hi, int s1) {
#pragma unroll
    for (int d0 = 0; d0 < 4; ++d0) { const int row = 32 * d0 + r32;
        const v8i vf = ATT_LD8(Vs + row * 64 + (((2 * hi) ^ vswz(row)) << 4), Vs + row * 64 + (((2 * hi + 1) ^ vswz(row)) << 4));
        mfma8_acc(o[d0], pa, vf, s1); }
    mfma8_acc(lacc, pa, ones, s1);
}
__device__ __forceinline__ void pv_last(f32x16* o, f32x16& lacc, const v8i& ones, const v8i& vf0, const v8i& vf1, const v8i& vf2, const v8i& vf3, const v8i& pa, int s1) {
    mfma8_acc(o[0], pa, vf0, s1); mfma8_acc(o[1], pa, vf1, s1); mfma8_acc(o[2], pa, vf2, s1); mfma8_acc(o[3], pa, vf3, s1); mfma8_acc(lacc, pa, ones, s1);
}
}

__device__ __forceinline__ void vt_phase(const Args& A, int bid, int G) {
    const int tid = threadIdx.x; unsigned char* ws = A.ws;
    const bf16_t* V = (const bf16_t*)(ws + A_V); unsigned char* VT = ws + A_VT;
    const int dv = tid & 127, kq = tid >> 7, half = kq >> 1, hi = kq & 1;
    for (int it = bid; it < 64 * 128; it += G) {
        const int bh = it >> 7, tile = it & 127, b = bh >> 3, h = bh & 7;
        const bf16_t* vp = V + ((size_t)b * SEQ + tile * 64 + 32 * half) * DM + h * 128 + dv;
        float f[16];
#pragma unroll
        for (int i = 0; i < 16; ++i) f[i] = bf2f(vp[(size_t)att::crow(i, hi) * DM]);
        *(u32x4*)(VT + (((size_t)bh * 128 + tile) * 128 + dv) * 64 + hi * 32 + half * 16) =
            (u32x4){pk_fp8x4(f[0], f[1], f[2], f[3]), pk_fp8x4(f[4], f[5], f[6], f[7]), pk_fp8x4(f[8], f[9], f[10], f[11]), pk_fp8x4(f[12], f[13], f[14], f[15])};
    }
}

__device__ __forceinline__ void attn_phase(const Args& A, LAS unsigned char* ldsu, int bid, int G, int al) {
    using namespace att;
    LAS char* lds = (LAS char*)ldsu;
    unsigned char* ws = A.ws;
    const unsigned char* Qg = ws + A_Q; const unsigned char* Kg = ws + A_K; const unsigned char* VTg = ws + A_VT;
    bf16_t* Og = (bf16_t*)(ws + WS_HM);
    const float* scal = (const float*)(ws + TB_SCAL);
    const float lamv = scal[SC_LAM0 + al], omli = scal[SC_OML0 + al], Mc = scal[SC_MC0 + al] - 7.5f;
    const float* subg = A.in[I_ATSUB] + al * 128;
    int tid_ = threadIdx.x; asm volatile("" : "+v"(tid_));
    const int tid = tid_, wid = __builtin_amdgcn_readfirstlane(tid >> 6), lane = tid & 63, r32 = lane & 31, hi = lane >> 5, jj = wid >> 2, wq = wid & 3;
    constexpr int NT = SEQ / KVBLK;
    int s1 = 0x7f7f7f7f, s8 = 0x7c7c7c7c; asm volatile("" : "+v"(s1), "+v"(s8));
    v8i ones; { int o1 = 0x38383838; asm volatile("" : "+v"(o1)); ones = (v8i){o1, o1, o1, o1, o1, o1, o1, o1}; }
    f32x16 cinit;
#pragma unroll
    for (int r = 0; r < 16; ++r) cinit[r] = -Mc;
    unsigned koff, voff;
    { const int bb = wid * 1024 + lane * 16;
      { const int row = bb >> 7, c = ((bb & 127) >> 4) ^ kswz(row); koff = (unsigned)(row * 1024 + c * 16); }
      { const int row = bb >> 6, c = ((bb & 63) >> 4) ^ vswz(row); voff = (unsigned)(row * 64 + c * 16); } }
    const unsigned ldsw = (unsigned)wid * 1024u;
#define ATT_DMA(slot, kt, vt) do { \
        __builtin_amdgcn_global_load_lds((const unsigned*)((const unsigned char*)(kt) + koff), (LAS unsigned*)(lds + k_slot(slot) + ldsw), 16, 0, 0); \
        __builtin_amdgcn_global_load_lds((const unsigned*)((const unsigned char*)(vt) + voff), (LAS unsigned*)(lds + v_slot(slot) + ldsw), 16, 0, 0); } while (0)
#define ATT_TOP() do { asm volatile("s_waitcnt vmcnt(4)" ::: "memory"); __builtin_amdgcn_s_barrier(); asm volatile("" ::: "memory"); } while (0)
    const int xq = bid & 7, cq = bid >> 3;
    int cbh = xq * 8;
    const bool lag = (jj != 0);
#define ATT_KB(bh_) (Kg + ((size_t)((bh_) >> 3) * SEQ) * DM + ((bh_) & 7) * 128)
#define ATT_VB(bh_) (VTg + (size_t)(bh_) * 128 * 8192)
    ATT_DMA(0, ATT_KB(cbh), ATT_VB(cbh)); ATT_DMA(1, ATT_KB(cbh) + (size_t)64 * DM, ATT_VB(cbh) + 8192); ATT_DMA(2, ATT_KB(cbh) + (size_t)128 * DM, ATT_VB(cbh) + 16384);
    int ofKa, ofKb, ofV, ofKax, ofKbx, ofVx;
    { const int c0 = jj * 4 + 2 * hi, lb = (int)(unsigned)(size_t)lds;
      ofKa = r32 * 128 + ((c0 ^ kswz(r32)) << 4); ofKb = (32 + r32) * 128 + ((c0 ^ kswz(32 + r32)) << 4); ofV = 65536 + r32 * 64 + (((2 * hi) ^ vswz(r32)) << 4);
      ofKax = lb + (ofKa ^ 16); ofKbx = lb + (ofKb ^ 16); ofVx = lb + (ofV ^ 16); ofKa += lb; ofKb += lb; ofV += lb; }
    for (int ui = 0; ui < 16; ++ui) {
        const int qb = (ui & 1) * 32 + cq;
        const int nbh = (ui + 1 < 16) ? xq * 8 + ((ui + 1) >> 1) : cbh;
        const unsigned char* Kh = ATT_KB(cbh); const unsigned char* Vh = ATT_VB(cbh); const unsigned char* nK = ATT_KB(nbh); const unsigned char* nV = ATT_VB(nbh);
        const size_t obase = ((size_t)(cbh >> 3) * SEQ + qb * 128) * DM + (cbh & 7) * 128;
        f32x16 lacc = {}; f32x16 o[4] = {}; v8i qr;
        { const unsigned char* Qw = Qg + obase + (size_t)(wq * 32 + r32) * DM + jj * 64 + hi * 32;
          const u32x4 qa = *(const u32x4*)Qw, qb2 = *(const u32x4*)(Qw + 16);
          qr = __builtin_bit_cast(v8i, __builtin_shufflevector(qa, qb2, 0, 1, 2, 3, 4, 5, 6, 7)); }
        f32x16 pA0, pA1; v8i pa, kf0, kf1, vf0, vf1, vf2, vf3;
        const unsigned char* kptr = Kh + (size_t)3 * 64 * DM; const unsigned char* vptr = Vh + 3 * 8192;
#define ATT_ISSUE(SLD, last) do { asm volatile("" : "+s"(kptr), "+s"(vptr)); ATT_DMA(SLD, kptr, vptr); if (last) { kptr = nK; vptr = nV; } else { kptr += (size_t)64 * DM; vptr += 8192; } } while (0)
#define ATT_RD8(b_, bx_, imm_) ATT_LD8((const LAS char*)(unsigned)((b_) + (imm_)), (const LAS char*)(unsigned)((bx_) + (imm_)))
#define ATT_FIX() asm volatile("" : "+v"(ofKa), "+v"(ofKax), "+v"(ofKb), "+v"(ofKbx), "+v"(ofV), "+v"(ofVx))
#define ATT_STEPC(LAST, SL, SLP, SLD) do { \
            ATT_FIX(); \
            ATT_TOP(); \
            kf0 = ATT_RD8(ofKa, ofKax, (SL) * SLOTB); kf1 = ATT_RD8(ofKb, ofKbx, (SL) * SLOTB); vf0 = ATT_RD8(ofV, ofVx, (SLP) * SLOTB); vf1 = ATT_RD8(ofV, ofVx, (SLP) * SLOTB + 2048); \
            ATT_ISSUE(SLD, LAST); \
            ATT_TOP(); \
            qkt_pack(pA0, pA1, kf0, kf1, qr, cinit, s1, s8, pe, pa); \
            vf2 = ATT_RD8(ofV, ofVx, (SLP) * SLOTB + 4096); vf3 = ATT_RD8(ofV, ofVx, (SLP) * SLOTB + 6144); \
            pv_exp(o, lacc, ones, vf0, vf1, vf2, vf3, pa, s1, pA0, pA1, pe); } while (0)
        float pe[32];
        if (lag) ATT_TOP();
        ATT_TOP();
        ATT_FIX(); kf0 = ATT_RD8(ofKa, ofKax, 0); kf1 = ATT_RD8(ofKb, ofKbx, 0); ATT_ISSUE(3, false);
        ATT_TOP();
        { mfma8_c(pA0, kf0, qr, cinit, s1, s8); mfma8_c(pA1, kf1, qr, cinit, s1, s8);
          asm volatile("s_nop 15\n\ts_nop 15" ::: "memory");
#pragma unroll
          for (int r = 0; r < 16; ++r) pe[r] = fexp2(pA0[r]);
#pragma unroll
          for (int r = 0; r < 16; ++r) pe[16 + r] = fexp2(pA1[r]); }
        ATT_STEPC(false, 1, 0, 4); ATT_STEPC(false, 2, 1, 5); ATT_STEPC(false, 3, 2, 6); ATT_STEPC(false, 4, 3, 7); ATT_STEPC(false, 5, 4, 0); ATT_STEPC(false, 6, 5, 1); ATT_STEPC(false, 7, 6, 2);
        for (int kb = 8; kb < NT; kb += 8) {
            ATT_STEPC(false, 0, 7, 3); ATT_STEPC(false, 1, 0, 4); ATT_STEPC(false, 2, 1, 5); ATT_STEPC(false, 3, 2, 6);
            ATT_STEPC(kb == NT - 8, 4, 3, 7); ATT_STEPC(false, 5, 4, 0); ATT_STEPC(false, 6, 5, 1); ATT_STEPC(false, 7, 6, 2);
        }
        ATT_TOP();
        ATT_FIX();
        vf0 = ATT_RD8(ofV, ofVx, 7 * SLOTB); vf1 = ATT_RD8(ofV, ofVx, 7 * SLOTB + 2048);
        ATT_TOP();
        { vf2 = ATT_RD8(ofV, ofVx, 7 * SLOTB + 4096); vf3 = ATT_RD8(ofV, ofVx, 7 * SLOTB + 6144);
          pack_p(pe, pa); SBAR();
          pv_last(o, lacc, ones, vf0, vf1, vf2, vf3, pa, s1);
          asm volatile("s_nop 15\n\ts_nop 15" ::: "memory"); }
        if (!lag) ATT_TOP();
#undef ATT_ISSUE
#undef ATT_STEPC
#undef ATT_RD8
#undef ATT_FIX
        int r32e = r32, hie = hi; asm volatile("" : "+v"(r32e), "+v"(hie));
        float rli[16];
#pragma unroll
        for (int r = 0; r < 16; ++r) rli[r] = frcp(lacc[r]);
        asm volatile("s_waitcnt lgkmcnt(0)" ::: "memory"); __builtin_amdgcn_s_barrier(); asm volatile("" ::: "memory");
        LAS float* Cb = (LAS float*)(lds + ((wq < 2) ? 3 * SLOTB : 65536 + 3 * SLOTB - 64 * 512));
        if (jj == 1) {
#pragma unroll
            for (int r = 0; r < 16; ++r) { const float sc = rli[r] * lamv;
#pragma unroll
                for (int d0 = 0; d0 < 4; ++d0) Cb[(wq * 32 + crow(r, hie)) * 128 + d0 * 32 + r32e] = o[d0][r] * sc; }
        }
        asm volatile("s_waitcnt lgkmcnt(0)" ::: "memory"); __builtin_amdgcn_s_barrier(); asm volatile("" ::: "memory");
        if (jj == 0) {
            float g[4];
#pragma unroll
            for (int d0 = 0; d0 < 4; ++d0) g[d0] = subg[d0 * 32 + r32e] * omli;
            bf16_t* Ob = Og + obase;
#pragma unroll
            for (int r = 0; r < 16; ++r) {
                float ss = 0.f;
#pragma unroll
                for (int d0 = 0; d0 < 4; ++d0) { const float v = o[d0][r] * rli[r] - Cb[(wq * 32 + crow(r, hie)) * 128 + d0 * 32 + r32e]; o[d0][r] = v; ss += v * v; }
                ss += __shfl_xor(ss, 1); ss += __shfl_xor(ss, 2); ss += __shfl_xor(ss, 4); ss += __shfl_xor(ss, 8); ss += __shfl_xor(ss, 16);
                const float rs = 1.0f / sqrtf(ss * (1.0f / 128.0f) + EPS);
                bf16_t* op = Ob + (size_t)(wq * 32 + crow(r, hie)) * DM + r32e;
#pragma unroll
                for (int d0 = 0; d0 < 4; ++d0) op[d0 * 32] = (bf16_t)f2bf(o[d0][r] * rs * g[d0]);
            }
        }
        asm volatile("s_waitcnt lgkmcnt(0)" ::: "memory"); __builtin_amdgcn_s_barrier(); asm volatile("" ::: "memory");
        cbh = nbh;
    }
    asm volatile("s_waitcnt vmcnt(0) lgkmcnt(0)" ::: "memory"); __builtin_amdgcn_s_barrier(); asm volatile("" ::: "memory");
#undef ATT_DMA
#undef ATT_TOP
#undef ATT_KB
#undef ATT_VB
#undef ATT_LD8
}

namespace gla {
constexpr int BC = 0, QI = 32768, QA = 49152, KA = 65536, KST = 81920, VT = 98304, ST = 106496, AT = 122880, EM = 131072, EL = EM + 512, DD = EM + 1024, BMID = EM + 1536, SEG = EM + 2048;
static_assert(SEG + 2048 <= RING_BYTES, "gla lds");
__device__ __forceinline__ int sw256(int row, int cb) { return row * 256 + (cb ^ ((row & 15) << 4)); }
__device__ __forceinline__ int sw128(int row, int cb) { return row * 128 + (cb ^ ((((row & 7) ^ (row >> 4)) & 7) << 4)); }
__device__ __forceinline__ int crow(int r, int hi) { return (r & 3) + 8 * (r >> 2) + 4 * hi; }
__device__ __forceinline__ float h2f(unsigned short b) { return (float)__builtin_bit_cast(_Float16, b); }
__device__ __forceinline__ void gla_item(const bf16_t* __restrict__ Qp, const unsigned short* __restrict__ LFp, const bf16_t* __restrict__ Vp, bf16_t* __restrict__ Op, int dir, LAS unsigned char* lds, float* dbg) {
    int tid_ = threadIdx.x; asm volatile("" : "+v"(tid_));
    const int tid = tid_, wid = tid >> 6, lane = tid & 63, r = lane & 31, hh = lane >> 5;
    const int t1 = tid >> 3, kg = tid & 7, k0 = 16 * kg, v0 = (tid & 7) * 8;
    for (int i = tid; i < 16384 / 16; i += NTHR) *(LAS u32x4*)(lds + ST + i * 16) = (u32x4){0u, 0u, 0u, 0u};
    f32x16 st = {};
    u32x4 rq[2], rl[2], rv;
#define GLA_TOK(ci, i) (dir ? (SEQ - 1 - ((ci) * 64 + (i))) : ((ci) * 64 + (i)))
#define GLA_LOAD(ci) do { const size_t to = (size_t)GLA_TOK(ci, t1) * DM; \
        rq[0] = *(const u32x4*)(Qp + to + k0); rq[1] = *(const u32x4*)(Qp + to + k0 + 8); \
        rl[0] = *(const u32x4*)(LFp + to + k0); rl[1] = *(const u32x4*)(LFp + to + k0 + 8); rv = *(const u32x4*)(Vp + to + v0); } while (0)
    GLA_LOAD(0);
    __syncthreads();
    for (int ci = 0; ci < SEQ / 64; ++ci) {
        float qf[16], lf[16]; u32x4 vreg = rv;
#pragma unroll
        for (int j = 0; j < 2; ++j)
#pragma unroll
            for (int e = 0; e < 4; ++e) { qf[j * 8 + 2 * e] = bflo(rq[j][e]); qf[j * 8 + 2 * e + 1] = bfhi(rq[j][e]);
                lf[j * 8 + 2 * e] = h2f((unsigned short)(rl[j][e] & 0xffffu)); lf[j * 8 + 2 * e + 1] = h2f((unsigned short)(rl[j][e] >> 16)); }
        if (ci + 1 < SEQ / 64) GLA_LOAD(ci + 1);
#pragma unroll
        for (int j = 0; j < 4; ++j) *(LAS f32x4*)(lds + BC + (t1 * 128 + k0 + 4 * j) * 4) = (f32x4){lf[4 * j], lf[4 * j + 1], lf[4 * j + 2], lf[4 * j + 3]};
        __syncthreads();
        { const int kc = tid & 127, sg = tid >> 7; LAS float* bc = (LAS float*)(lds + BC) + kc; float cs[16];
#pragma unroll
            for (int i = 0; i < 16; ++i) cs[i] = bc[(sg * 16 + i) * 128];
#pragma unroll
            for (int i = 1; i < 16; ++i) cs[i] += cs[i - 1];
            ((LAS float*)(lds + SEG))[sg * 128 + kc] = cs[15];
            __syncthreads();
            const LAS float* sgp = (const LAS float*)(lds + SEG) + kc; const float s0 = sgp[0], s1 = sgp[128], s2 = sgp[256], s3 = sgp[384];
            const float off = sg == 0 ? 0.f : sg == 1 ? s0 : sg == 2 ? (s0 + s1) : ((s0 + s1) + s2);
#pragma unroll
            for (int i = 0; i < 16; ++i) bc[(sg * 16 + i) * 128] = cs[i] + off;
            if (sg == 0) { const float bm = s0 + s1, bl = ((s0 + s1) + s2) + s3;
                ((LAS float*)(lds + BMID))[kc] = bm; ((LAS float*)(lds + EM))[kc] = fexp(bm); ((LAS float*)(lds + EL))[kc] = fexp(bl - bm); ((LAS float*)(lds + DD))[kc] = fexp(bl); }
            __syncthreads();
        }
#ifdef DIAG
        if (dbg && ci == 0) { for (int i = tid; i < 8192; i += NTHR) dbg[i] = ((const LAS float*)(lds + BC))[i]; }
#endif
        {
            unsigned wqi[8], wqa[8], wka[8]; float ksv[16];
#pragma unroll
            for (int j = 0; j < 4; ++j) {
                const f32x4 bt = *(const LAS f32x4*)(lds + BC + (t1 * 128 + k0 + 4 * j) * 4), bm = *(const LAS f32x4*)(lds + BMID + (k0 + 4 * j) * 4);
                const f32x4 em = *(const LAS f32x4*)(lds + EM + (k0 + 4 * j) * 4), el = *(const LAS f32x4*)(lds + EL + (k0 + 4 * j) * 4);
                float qi[4], qa[4], ka[4];
#pragma unroll
                for (int e = 0; e < 4; ++e) { const int i = 4 * j + e; const float e1 = fexp(bt[e] - bm[e]), r1 = frcp(e1);
                    qa[e] = qf[i] * e1; qi[e] = qa[e] * em[e]; const float kk = 1.0f - fexp(lf[i]); ka[e] = kk * r1; ksv[i] = ka[e] * el[e]; }
                wqi[2 * j] = cvt_pk_bf16(qi[0], qi[1]); wqi[2 * j + 1] = cvt_pk_bf16(qi[2], qi[3]);
                wqa[2 * j] = cvt_pk_bf16(qa[0], qa[1]); wqa[2 * j + 1] = cvt_pk_bf16(qa[2], qa[3]);
                wka[2 * j] = cvt_pk_bf16(ka[0], ka[1]); wka[2 * j + 1] = cvt_pk_bf16(ka[2], ka[3]);
            }
#pragma unroll
            for (int j = 0; j < 2; ++j) { const int off = sw256(t1, (k0 + 8 * j) * 2);
                *(LAS u32x4*)(lds + QI + off) = (u32x4){wqi[4 * j], wqi[4 * j + 1], wqi[4 * j + 2], wqi[4 * j + 3]};
                *(LAS u32x4*)(lds + QA + off) = (u32x4){wqa[4 * j], wqa[4 * j + 1], wqa[4 * j + 2], wqa[4 * j + 3]};
                *(LAS u32x4*)(lds + KA + off) = (u32x4){wka[4 * j], wka[4 * j + 1], wka[4 * j + 2], wka[4 * j + 3]}; }
#pragma unroll
            for (int i = 0; i < 16; ++i) *(LAS unsigned short*)(lds + KST + sw128(k0 + i, t1 * 2)) = (unsigned short)f2bf(ksv[i]);
#pragma unroll
            for (int e = 0; e < 4; ++e) { *(LAS unsigned short*)(lds + VT + sw128(v0 + 2 * e, t1 * 2)) = (unsigned short)(vreg[e] & 0xffffu);
                *(LAS unsigned short*)(lds + VT + sw128(v0 + 2 * e + 1, t1 * 2)) = (unsigned short)(vreg[e] >> 16); }
        }
        __syncthreads();
        f32x16 oacc = {};
        const int w4 = wid & 3, t_i = w4 >> 1, v_i = w4 & 1;
        if (wid < 4) {
            const int s_i = wid >> 1, tq = wid & 1; f32x16 a = {};
#pragma unroll
            for (int ks = 0; ks < 8; ++ks) { const bf16x8 fa = *(const LAS bf16x8*)(lds + KA + sw256(32 * s_i + r, (16 * ks + 8 * hh) * 2)), fb = *(const LAS bf16x8*)(lds + QA + sw256(32 * tq + r, (16 * ks + 8 * hh) * 2));
                a = __builtin_amdgcn_mfma_f32_32x32x16_bf16(fa, fb, a, 0, 0, 0); }
            const int tg = 32 * tq + r;
#pragma unroll
            for (int g = 0; g < 4; ++g) { float m[4];
#pragma unroll
                for (int e = 0; e < 4; ++e) { const int sgl = 32 * s_i + 8 * g + 4 * hh + e; m[e] = (sgl <= tg) ? a[4 * g + e] : 0.f; }
                *(LAS u32x2*)(lds + AT + sw128(tg, (32 * s_i + 8 * g + 4 * hh) * 2)) = (u32x2){cvt_pk_bf16(m[0], m[1]), cvt_pk_bf16(m[2], m[3])}; }
        } else {
#pragma unroll
            for (int ks = 0; ks < 8; ++ks) { const bf16x8 fa = *(const LAS bf16x8*)(lds + QI + sw256(32 * t_i + r, (16 * ks + 8 * hh) * 2)), fb = *(const LAS bf16x8*)(lds + ST + sw256(32 * v_i + r, (16 * ks + 8 * hh) * 2));
                oacc = __builtin_amdgcn_mfma_f32_32x32x16_bf16(fa, fb, oacc, 0, 0, 0); }
        }
        __syncthreads();
#ifdef DIAG
        if (dbg && ci == 0) { for (int i = tid; i < 2048; i += NTHR) { ((unsigned*)dbg)[8192 + i] = ((const LAS unsigned*)(lds + AT))[i]; ((unsigned*)dbg)[8192 + 2048 + i] = ((const LAS unsigned*)(lds + VT))[i]; } }
#endif
        if (wid >= 4) {
#pragma unroll
            for (int ks = 0; ks < 4; ++ks) { const bf16x8 fa = *(const LAS bf16x8*)(lds + AT + sw128(32 * t_i + r, (16 * ks + 8 * hh) * 2)), fb = *(const LAS bf16x8*)(lds + VT + sw128(32 * v_i + r, (16 * ks + 8 * hh) * 2));
                oacc = __builtin_amdgcn_mfma_f32_32x32x16_bf16(fa, fb, oacc, 0, 0, 0); }
#pragma unroll
            for (int i = 0; i < 16; ++i) { const int t = 32 * t_i + crow(i, hh); Op[(size_t)GLA_TOK(ci, t) * DM + 32 * v_i + r] = (bf16_t)f2bf(oacc[i]); }
        }
        {
            const int kq = wid >> 1, vq = wid & 1;
#pragma unroll
            for (int i = 0; i < 16; ++i) st[i] *= ((const LAS float*)(lds + DD))[32 * kq + crow(i, hh)];
#pragma unroll
            for (int ks = 0; ks < 4; ++ks) { const bf16x8 fa = *(const LAS bf16x8*)(lds + KST + sw128(32 * kq + r, (16 * ks + 8 * hh) * 2)), fb = *(const LAS bf16x8*)(lds + VT + sw128(32 * vq + r, (16 * ks + 8 * hh) * 2));
                st = __builtin_amdgcn_mfma_f32_32x32x16_bf16(fa, fb, st, 0, 0, 0); }
#pragma unroll
            for (int g = 0; g < 4; ++g) *(LAS u32x2*)(lds + ST + sw256(32 * vq + r, (32 * kq + 8 * g + 4 * hh) * 2)) = (u32x2){cvt_pk_bf16(st[4 * g], st[4 * g + 1]), cvt_pk_bf16(st[4 * g + 2], st[4 * g + 3])};
        }
        __syncthreads();
#ifdef DIAG
        if (dbg && ci == 0) { for (int i = tid; i < 4096; i += NTHR) { ((unsigned*)dbg)[12288 + i] = ((const LAS unsigned*)(lds + ST))[i]; ((unsigned*)dbg)[16384 + i] = ((const LAS unsigned*)(lds + KST))[i]; } }
#endif
    }
#undef GLA_TOK
#undef GLA_LOAD
}
}
__device__ __forceinline__ void gla_phase(const Args& A, LAS unsigned char* lds, int bid, int G) {
    unsigned char* ws = A.ws;
    for (int it = bid; it < 256; it += G) {
        const int b = it >> 5, h = (it >> 2) & 7, dir = (it >> 1) & 1, vh = it & 1;
        const size_t base = (size_t)b * SEQ * DM + h * 128;
        gla::gla_item((const bf16_t*)(ws + H_Q) + base, (const unsigned short*)(ws + (dir ? H_LFB : H_LFF)) + base, (const bf16_t*)(ws + H_V) + base + vh * 64,
                      (bf16_t*)(ws + (dir ? H_OB : H_OF)) + base + vh * 64, dir, lds, it == 0 ? (float*)(ws + TB_LSUM) : nullptr);
    }
}
__device__ __forceinline__ void hg_normo_phase(const Args& A, int bid, int G) {
    int tid_ = threadIdx.x; asm volatile("" : "+v"(tid_));
    const int tid = tid_, lane = tid & 63, wave = tid >> 6; unsigned char* ws = A.ws;
    const bf16_t* OF = (const bf16_t*)(ws + H_OF); const bf16_t* OB = (const bf16_t*)(ws + H_OB); const bf16_t* GG = (const bf16_t*)(ws + H_G); bf16_t* HM = (bf16_t*)(ws + WS_HM);
    const int c0 = (lane >> 3) * 128 + (lane & 7) * 16;
    float ng[16];
#pragma unroll
    for (int i = 0; i < 16; ++i) ng[i] = A.in[I_HGNG][(lane & 7) * 16 + i];
    for (int row = (bid * NWAVES + wave); row < MTOK; row += G * NWAVES) {
        const size_t o = (size_t)row * DM + c0;
        const u32x4 a0 = *(const u32x4*)(OF + o), a1 = *(const u32x4*)(OF + o + 8), b0 = *(const u32x4*)(OB + o), b1 = *(const u32x4*)(OB + o + 8), g0 = *(const u32x4*)(GG + o), g1 = *(const u32x4*)(GG + o + 8);
        float v[16], gt[16]; float ss = 0.f;
#pragma unroll
        for (int e = 0; e < 4; ++e) { v[2 * e] = bflo(a0[e]) + bflo(b0[e]); v[2 * e + 1] = bfhi(a0[e]) + bfhi(b0[e]); v[8 + 2 * e] = bflo(a1[e]) + bflo(b1[e]); v[8 + 2 * e + 1] = bfhi(a1[e]) + bfhi(b1[e]);
            gt[2 * e] = bflo(g0[e]); gt[2 * e + 1] = bfhi(g0[e]); gt[8 + 2 * e] = bflo(g1[e]); gt[8 + 2 * e + 1] = bfhi(g1[e]); }
#pragma unroll
        for (int i = 0; i < 16; ++i) ss += v[i] * v[i];
        ss += __shfl_xor(ss, 1); ss += __shfl_xor(ss, 2); ss += __shfl_xor(ss, 4);
        const float rstd = 1.0f / sqrtf(ss * (1.0f / 128.0f) + EPS);
        u32x4 w0, w1;
#pragma unroll
        for (int e = 0; e < 4; ++e) { w0[e] = cvt_pk_bf16(v[2 * e] * rstd * ng[2 * e] * gt[2 * e], v[2 * e + 1] * rstd * ng[2 * e + 1] * gt[2 * e + 1]);
            w1[e] = cvt_pk_bf16(v[8 + 2 * e] * rstd * ng[8 + 2 * e] * gt[8 + 2 * e], v[8 + 2 * e + 1] * rstd * ng[8 + 2 * e + 1] * gt[8 + 2 * e + 1]); }
        *(u32x4*)(HM + o) = w0; *(u32x4*)(HM + o + 8) = w1;
    }
}

#ifdef DIAG
constexpr int DG_BASE = 8192;
__device__ __forceinline__ void dg_put(const Args& A, int k, float e) { if (!(e >= 0.f) || e > 1e9f) e = 1e9f; atomicMax((unsigned*)(A.ws + WS_CTL) + DG_BASE + 64 * k, __float_as_uint(e)); }
__device__ __forceinline__ float dg_rel(float got, float ref) { return fabsf(got - ref) / (fabsf(ref) + 0.1f); }
__device__ __forceinline__ unsigned dg_hash(unsigned a, unsigned b) { unsigned h = a * 2654435761u + b * 40503u + 0x9e3779b9u; h ^= h >> 15; h *= 2246822519u; h ^= h >> 13; h *= 3266489917u; h ^= h >> 16; return h; }
__device__ __forceinline__ float dg_bfr(float x) { return bflo(f2bf(x)); }
__device__ __forceinline__ void dg_mods(const Args& A, int k) {
    const int lane = threadIdx.x & 63, gwv = blockIdx.x * 8 + (threadIdx.x >> 6);
    const unsigned h = dg_hash(gwv, k); const int l = h & 3, b = (h >> 2) & 7, e = (h >> 5) % 6144;
    float a = 0.f; for (int d = lane; d < DM; d += 64) a += fsilu(A.in[I_C][b * DM + d]) * A.in[I_ADAW][((size_t)l * DM + d) * 6144 + e];
    a = wave_sum(a) + A.in[I_ADAB][l * 6144 + e];
    const float got = ((const float*)(A.ws + TB_MODS))[((size_t)l * NBATCH + b) * 6144 + e];
    if (lane == 0) dg_put(A, k, dg_rel(got, a));
}
__device__ __forceinline__ void dg_norm(const Args& A, int k, const float* x, const float* gain, int L, int which) {
    const int lane = threadIdx.x & 63, gwv = blockIdx.x * 8 + (threadIdx.x >> 6);
    const int row = dg_hash(gwv, k) & (MTOK - 1), b = row >> 13;
    const float* modl = (const float*)(A.ws + TB_MODS) + ((size_t)L * NBATCH + b) * 6144;
    float ss = 0.f; for (int c = lane; c < DM; c += 64) { const float v = x[(size_t)row * DM + c]; ss += v * v; }
    ss = wave_sum(ss); const float rstd = 1.0f / sqrtf(ss / DM + EPS); float e = 0.f;
    for (int c = lane; c < DM; c += 64) { const float ref = x[(size_t)row * DM + c] * rstd * gain[c] * (1.0f + modl[(which * 3 + 1) * 1024 + c]) + modl[(which * 3) * 1024 + c];
        e = fmaxf(e, dg_rel(bf2f(((const bf16_t*)(A.ws + WS_HM))[(size_t)row * DM + c]), ref)); }
    dg_put(A, k, e);
}
__device__ __forceinline__ void dg_qkv(const Args& A, int k, int al) {
    const int lane = threadIdx.x & 63, gwv = blockIdx.x * 8 + (threadIdx.x >> 6);
    const unsigned h = dg_hash(gwv, k); const int row = h & (MTOK - 1), t = (h >> 16) % 48, col = t * 64 + lane;
    const bf16_t* hm = (const bf16_t*)(A.ws + WS_HM) + (size_t)row * DM; const float* w = A.in[I_ATWIN] + (size_t)al * 1024 * 3072 + col;
    float a = 0.f; for (int kk = 0; kk < DM; ++kk) a += bf2f(hm[kk]) * dg_bfr(w[(size_t)kk * 3072]);
    float ref, got;
    if (t < 32) {
        const int part = t >> 4, sh = t & 15; const float ss = wave_sum(a * a); const float rstd = 1.0f / sqrtf(ss / 64.0f + EPS);
        const float y = a * rstd * (part ? A.in[I_ATKN] : A.in[I_ATQN])[al * 64 + lane]; const float yp = __shfl_xor(y, 32);
        const int pos = row & (SEQ - 1); const float cs = ((const float*)(A.ws + TB_COS))[pos * 32 + (lane & 31)], sn = ((const float*)(A.ws + TB_SIN))[pos * 32 + (lane & 31)];
        ref = (lane < 32) ? (y * cs - yp * sn) : (y * cs + yp * sn); if (part == 0) ref *= 0.125f * LOG2E;
        got = bf2f(((const bf16_t*)(A.ws + (part ? A_K : A_Q)))[(size_t)row * DM + sh * 64 + lane]);
    } else { ref = a; got = bf2f(((const bf16_t*)(A.ws + A_V))[(size_t)row * DM + (t - 32) * 64 + lane]); }
    dg_put(A, k, dg_rel(got, ref));
}
__device__ __forceinline__ void dg_attn(const Args& A, int k, int al, LAS unsigned char* lds) {
    const int tid = threadIdx.x; const unsigned h = dg_hash(blockIdx.x, k); const int row = h & (MTOK - 1), hd = (h >> 16) & 7, b = row >> 13;
    const bf16_t* Q = (const bf16_t*)(A.ws + A_Q); const bf16_t* K = (const bf16_t*)(A.ws + A_K); const bf16_t* V = (const bf16_t*)(A.ws + A_V);
    const float* scal = (const float*)(A.ws + TB_SCAL); const float lamv = scal[SC_LAM0 + al], omli = scal[SC_OML0 + al], Mc = scal[SC_MC0 + al];
    LAS float* p0 = (LAS float*)lds; LAS float* p1 = p0 + SEQ; LAS float* red = p1 + SEQ;
    float l0 = 0.f, l1 = 0.f;
    for (int key = tid; key < SEQ; key += NTHR) { const bf16_t* kr = K + ((size_t)b * SEQ + key) * DM + hd * 128; const bf16_t* qr = Q + (size_t)row * DM + hd * 128;
        float s0 = 0.f, s1 = 0.f; for (int d = 0; d < 64; ++d) { s0 += bf2f(qr[d]) * bf2f(kr[d]); s1 += bf2f(qr[64 + d]) * bf2f(kr[64 + d]); }
        const float e0 = fexp2(s0 - Mc), e1 = fexp2(s1 - Mc); p0[key] = e0; p1[key] = e1; l0 += e0; l1 += e1; }
    l0 = wave_sum(l0); l1 = wave_sum(l1); if ((tid & 63) == 0) { red[tid >> 6] = l0; red[8 + (tid >> 6)] = l1; }
    __syncthreads();
    l0 = 0.f; l1 = 0.f; for (int w = 0; w < 8; ++w) { l0 += red[w]; l1 += red[8 + w]; }
    __syncthreads();
    const int dv = tid & 127, part = tid >> 7; float o = 0.f;
    for (int key = part * 2048; key < part * 2048 + 2048; ++key) o += (p0[key] / l0 - lamv * p1[key] / l1) * bf2f(V[((size_t)b * SEQ + key) * DM + hd * 128 + dv]);
    red[16 + part * 128 + dv] = o; __syncthreads();
    if (tid < 128) { o = red[16 + tid] + red[16 + 128 + tid] + red[16 + 256 + tid] + red[16 + 384 + tid]; red[600 + tid] = o * o; }
    __syncthreads();
    if (tid < 128) { float ss = 0.f; for (int i = 0; i < 128; ++i) ss += red[600 + i]; const float ref = o / sqrtf(ss / 128.0f + EPS) * A.in[I_ATSUB][al * 128 + tid] * omli;
        dg_put(A, k, dg_rel(bf2f(((const bf16_t*)(A.ws + WS_HM))[(size_t)row * DM + hd * 128 + tid]), ref)); }
    __syncthreads();
}
__device__ __forceinline__ void dg_save(const Args& A, int k, const float* xold) {
    const int lane = threadIdx.x & 63, gwv = blockIdx.x * 8 + (threadIdx.x >> 6);
    const unsigned h = dg_hash(gwv, k); const int row = h & (MTOK - 1), col = (h >> 16) & 1023;
    float* sv = (float*)(A.ws + TB_LSUM) + 7 * 1024 * 1024 / 4;
    if (lane == 0) sv[k * 4096 + gwv] = xold[(size_t)row * DM + col];
}
__device__ __forceinline__ void dg_res(const Args& A, int k, const float* xnew, const float* gate, const bf16_t* Am, int K, const float* W) {
    const int lane = threadIdx.x & 63, gwv = blockIdx.x * 8 + (threadIdx.x >> 6);
    const unsigned h = dg_hash(gwv, k); const int row = h & (MTOK - 1), col = (h >> 16) & 1023, b = row >> 13;
    const float* sv = (const float*)(A.ws + TB_LSUM) + 7 * 1024 * 1024 / 4;
    float a = 0.f; for (int kk = lane; kk < K; kk += 64) a += bf2f(Am[(size_t)row * K + kk]) * dg_bfr(W[(size_t)kk * DM + col]);
    a = wave_sum(a);
    const float ref = sv[k * 4096 + gwv] + gate[(size_t)b * 6144 + col] * a;
    if (lane == 0) dg_put(A, k, dg_rel(xnew[(size_t)row * DM + col], ref));
}
__device__ __forceinline__ void dg_swiglu(const Args& A, int k, const bf16_t* Am, const float* W, int F, const bf16_t* H, int nrows, const int* rowmap) {
    const int lane = threadIdx.x & 63, gwv = blockIdx.x * 8 + (threadIdx.x >> 6);
    const unsigned h = dg_hash(gwv, k); const int row = (h & 0xfffff) % nrows, j = (h >> 20) % F;
    float g = 0.f, u = 0.f; for (int kk = lane; kk < DM; kk += 64) { const float x = bf2f(Am[(size_t)row * DM + kk]); g += x * dg_bfr(W[(size_t)kk * 2 * F + j]); u += x * dg_bfr(W[(size_t)kk * 2 * F + F + j]); }
    g = wave_sum(g); u = wave_sum(u);
    const float ref = g / (1.0f + expf(-g)) * u;
    if (lane == 0) dg_put(A, k, dg_rel(bf2f(H[(size_t)row * F + j]), ref));
}
__device__ __forceinline__ void dg_hgin(const Args& A, int k) {
    const int lane = threadIdx.x & 63, gwv = blockIdx.x * 8 + (threadIdx.x >> 6);
    const unsigned h = dg_hash(gwv, k); const int row = h & (MTOK - 1), col = (h >> 16) % 5120, grp = col >> 10, cc = col & 1023;
    float a = 0.f; for (int kk = lane; kk < DM; kk += 64) a += bf2f(((const bf16_t*)(A.ws + WS_HM))[(size_t)row * DM + kk]) * dg_bfr(A.in[I_HGWIN][(size_t)kk * 5120 + col]);
    a = wave_sum(a);
    float ref, got;
    if (grp == 0 || grp == 4) { ref = a / (1.0f + expf(-a)); got = bf2f(((const bf16_t*)(A.ws + (grp == 0 ? H_Q : H_G)))[(size_t)row * DM + cc]); }
    else if (grp == 3) { ref = a; got = bf2f(((const bf16_t*)(A.ws + H_V))[(size_t)row * DM + cc]); }
    else { const int d = grp - 1; const float* p = A.in[I_HGLB] + (size_t)d * DEPTH * 1024 + cc; float mx = p[0]; for (int l = 1; l < DEPTH; ++l) mx = fmaxf(mx, p[l * 1024]);
        float den = 0.f; for (int l = 0; l < DEPTH; ++l) den += expf(p[l * 1024] - mx); const float lbv = expf(p[1024] - mx) / den;
        ref = logf(lbv + (1.0f - lbv) / (1.0f + expf(-a))); got = gla::h2f(((const unsigned short*)(A.ws + (d ? H_LFB : H_LFF)))[(size_t)row * DM + cc]); }
    if (lane == 0) dg_put(A, k, dg_rel(got, ref));
}
__device__ __forceinline__ void dg_gla(const Args& A, int k) {
    const int lane = threadIdx.x & 63, gwv = blockIdx.x * 8 + (threadIdx.x >> 6);
    const unsigned h = dg_hash(gwv, k); const int sel0 = (gwv & 3) == 0; const int b = sel0 ? 0 : (h & 7), hd = sel0 ? 0 : ((h >> 3) & 7), dir = sel0 ? 0 : ((h >> 6) & 1), vc = sel0 ? ((h >> 7) & 63) : ((h >> 7) & 127);
    const bf16_t* Q = (const bf16_t*)(A.ws + H_Q); const unsigned short* LF = (const unsigned short*)(A.ws + (dir ? H_LFB : H_LFF)); const bf16_t* V = (const bf16_t*)(A.ws + H_V);
    const bf16_t* O = (const bf16_t*)(A.ws + (dir ? H_OB : H_OF));
    float s0 = 0.f, s1 = 0.f, e0 = 0.f, e1 = 0.f, e2 = 0.f, e3 = 0.f;
    for (int i = 0; i < SEQ; ++i) { const int tok = dir ? (SEQ - 1 - i) : i; const size_t o = ((size_t)b * SEQ + tok) * DM + hd * 128;
        const float f0 = expf(gla::h2f(LF[o + lane])), f1 = expf(gla::h2f(LF[o + 64 + lane])), v = bf2f(V[o + vc]);
        s0 = f0 * s0 + (1.0f - f0) * v; s1 = f1 * s1 + (1.0f - f1) * v;
        if (i < 128 || i % 61 == 0) { const float ov = wave_sum(bf2f(Q[o + lane]) * s0 + bf2f(Q[o + 64 + lane]) * s1); const float er = 0.25f * fabsf(bf2f(O[o + vc]) - ov) / (fabsf(ov) + 1.0f);
            if (i == 0) e0 = er; else if (i < 64) e1 = fmaxf(e1, er); else if (i < 128) e2 = fmaxf(e2, er); else e3 = fmaxf(e3, er); } }
    if (lane == 0) { dg_put(A, k, e0); dg_put(A, k + 4, e1); dg_put(A, k + 5, e2); dg_put(A, k + 6, e3); }
    const float* dbg = (const float*)(A.ws + TB_LSUM); const unsigned short* LF0 = (const unsigned short*)(A.ws + H_LFF); const bf16_t* Q0 = (const bf16_t*)(A.ws + H_Q);
    { const unsigned h2 = dg_hash(gwv, k + 100); const int t = h2 & 63, kk = (h2 >> 6) & 127; float c = 0.f; for (int tt = 0; tt <= t; ++tt) c += gla::h2f(LF0[(size_t)tt * DM + kk]);
      if (lane == 0) dg_put(A, k + 1, dg_rel(dbg[t * 128 + kk], c)); }
    { const unsigned h2 = dg_hash(gwv, k + 200); const int t = h2 & 63, sidx = (h2 >> 6) & 63; float a = 0.f;
      if (sidx <= t) { for (int kk = lane; kk < 128; kk += 64) { float c = 0.f; for (int tt = sidx + 1; tt <= t; ++tt) c += gla::h2f(LF0[(size_t)tt * DM + kk]);
              a += bf2f(Q0[(size_t)t * DM + kk]) * (1.0f - expf(gla::h2f(LF0[(size_t)sidx * DM + kk]))) * expf(c); } a = wave_sum(a); }
      const unsigned short got = ((const unsigned short*)(dbg + 8192))[gla::sw128(t, sidx * 2) / 2];
      if (lane == 0) dg_put(A, k + 2, 5.0f * fabsf(bf2f(got) - a) / (fabsf(a) + 0.01f)); }
    { const unsigned h2 = dg_hash(gwv, k + 300); const int sidx = h2 & 63, v = (h2 >> 6) & 63;
      const unsigned short got = ((const unsigned short*)(dbg + 8192 + 2048))[gla::sw128(v, sidx * 2) / 2];
      if (lane == 0) dg_put(A, k + 2, dg_rel(bf2f(got), bf2f(((const bf16_t*)(A.ws + H_V))[(size_t)sidx * DM + v]))); }
    { const unsigned h2 = dg_hash(gwv, k + 500); const int kk = h2 & 127, v = (h2 >> 7) & 63;
      float a = 0.f; { const int sidx = lane; float c = 0.f; for (int tt = sidx + 1; tt < 64; ++tt) c += gla::h2f(LF0[(size_t)tt * DM + kk]);
          const float ksn = (1.0f - expf(gla::h2f(LF0[(size_t)sidx * DM + kk]))) * expf(c);
          const unsigned short gk = ((const unsigned short*)(dbg + 16384))[gla::sw128(kk, sidx * 2) / 2];
          dg_put(A, k + 2, 0.5f * fabsf(bf2f(gk) - ksn) / (fabsf(ksn) + 0.01f));
          a = ksn * bf2f(((const bf16_t*)(A.ws + H_V))[(size_t)sidx * DM + v]); }
      a = wave_sum(a);
      const unsigned short gs = ((const unsigned short*)(dbg + 12288))[gla::sw256(v, kk * 2) / 2];
      if (lane == 0) dg_put(A, k + 3, 0.5f * fabsf(bf2f(gs) - a) / (fabsf(a) + 0.05f)); }
    { const unsigned h2 = dg_hash(gwv, k + 400); const int t = h2 & 63, v = (h2 >> 6) & 63;
      const unsigned short* at = (const unsigned short*)(dbg + 8192); const unsigned short* vt = (const unsigned short*)(dbg + 8192 + 2048);
      float a = bf2f(at[gla::sw128(t, lane * 2) / 2]) * bf2f(vt[gla::sw128(v, lane * 2) / 2]); a = wave_sum(a);
      if (lane == 0) dg_put(A, k + 1, 5.0f * dg_rel(bf2f(((const bf16_t*)(A.ws + H_OF))[(size_t)t * DM + v]), a)); }
}
__device__ __forceinline__ void dg_normo(const Args& A, int k) {
    const int lane = threadIdx.x & 63, gwv = blockIdx.x * 8 + (threadIdx.x >> 6);
    const unsigned h = dg_hash(gwv, k); const int row = h & (MTOK - 1), hd = (h >> 16) & 7; const size_t o = (size_t)row * DM + hd * 128;
    const float v0 = bf2f(((const bf16_t*)(A.ws + H_OF))[o + lane]) + bf2f(((const bf16_t*)(A.ws + H_OB))[o + lane]), v1 = bf2f(((const bf16_t*)(A.ws + H_OF))[o + 64 + lane]) + bf2f(((const bf16_t*)(A.ws + H_OB))[o + 64 + lane]);
    const float ss = wave_sum(v0 * v0 + v1 * v1), rstd = 1.0f / sqrtf(ss / 128.0f + EPS);
    const float r0 = v0 * rstd * A.in[I_HGNG][lane] * bf2f(((const bf16_t*)(A.ws + H_G))[o + lane]), r1 = v1 * rstd * A.in[I_HGNG][64 + lane] * bf2f(((const bf16_t*)(A.ws + H_G))[o + 64 + lane]);
    dg_put(A, k, fmaxf(dg_rel(bf2f(((const bf16_t*)(A.ws + WS_HM))[o + lane]), r0), dg_rel(bf2f(((const bf16_t*)(A.ws + WS_HM))[o + 64 + lane]), r1)));
}
__device__ __forceinline__ void dg_router(const Args& A, int k, int L) {
    const int lane = threadIdx.x & 63, gwv = blockIdx.x * 8 + (threadIdx.x >> 6);
    const int row = dg_hash(gwv, k) & (MTOK - 1), b = row >> 13; const float* x = A.out + (size_t)row * DM;
    const float* modl = (const float*)(A.ws + TB_MODS) + ((size_t)L * NBATCH + b) * 6144; const float* gain = A.in[I_N2G] + L * DM; const float* R = A.in[I_MOER] + (size_t)(L >> 1) * DM * 8;
    float ss = 0.f; for (int c = lane; c < DM; c += 64) ss += x[c] * x[c];
    ss = wave_sum(ss); const float rstd = 1.0f / sqrtf(ss / DM + EPS);
    float lg[8]; for (int e = 0; e < 8; ++e) lg[e] = 0.f;
    for (int c = lane; c < DM; c += 64) { const float hv = x[c] * rstd * gain[c] * (1.0f + modl[4 * 1024 + c]) + modl[3 * 1024 + c]; for (int e = 0; e < 8; ++e) lg[e] += hv * R[c * 8 + e]; }
    for (int e = 0; e < 8; ++e) lg[e] = wave_sum(lg[e]);
    int e0 = 0; for (int e = 1; e < 8; ++e) if (lg[e] > lg[e0]) e0 = e;
    int e1 = (e0 == 0) ? 1 : 0; for (int e = 0; e < 8; ++e) if (e != e0 && lg[e] > lg[e1]) e1 = e;
    float gap = 1e9f; for (int e = 0; e < 8; ++e) if (e != e0 && e != e1) gap = fminf(gap, lg[e1] - lg[e]); gap = fminf(gap, lg[e0] - lg[e1]);
    const int g0 = ((const int*)(A.ws + TB_EID))[row * 2], g1 = ((const int*)(A.ws + TB_EID))[row * 2 + 1]; const float w0 = ((const float*)(A.ws + TB_GATE))[row * 2], w1 = ((const float*)(A.ws + TB_GATE))[row * 2 + 1];
    const float p0 = 1.0f / (1.0f + expf(lg[e1] - lg[e0]));
    float er = (g0 != e0 || g1 != e1) ? (gap > 2e-3f ? 9.f : 0.f) : fmaxf(fabsf(w0 - p0), fabsf(w1 - (1.0f - p0)));
    if (lane == 0) dg_put(A, k, er);
}
__device__ __forceinline__ void dg_place(const Args& A, int k) {
    const int lane = threadIdx.x & 63, gwv = blockIdx.x * 8 + (threadIdx.x >> 6);
    const unsigned h = dg_hash(gwv, k); const int row = h & (MTOK - 1), kk = (h >> 16) & 1;
    const int sl = ((const int*)(A.ws + TB_SLOT))[row * 2 + kk], e = ((const int*)(A.ws + TB_EID))[row * 2 + kk]; const int* ts = (const int*)(A.ws + TB_TILES);
    float er = (sl >= ts[e] * 256 && sl < ts[e + 1] * 256 && sl < MOE_ROWS) ? 0.f : 7.f;
    if (er == 0.f) for (int c = lane; c < DM; c += 64) if (((const bf16_t*)(A.ws + E_XS))[(size_t)sl * DM + c] != ((const bf16_t*)(A.ws + WS_HM))[(size_t)row * DM + c]) er = 5.f;
    dg_put(A, k, er);
}
__device__ __forceinline__ void dg_moe_hid(const Args& A, int k, int m) {
    const int lane = threadIdx.x & 63, gwv = blockIdx.x * 8 + (threadIdx.x >> 6);
    const unsigned h = dg_hash(gwv, k); const int row = h & (MTOK - 1), kk = (h >> 16) & 1, j = (h >> 17) % DFFE;
    const int sl = ((const int*)(A.ws + TB_SLOT))[row * 2 + kk], e = ((const int*)(A.ws + TB_EID))[row * 2 + kk];
    const float* W = A.in[I_MOEGU] + ((size_t)m * 8 + e) * DM * 2 * DFFE; const bf16_t* Am = (const bf16_t*)(A.ws + E_XS) + (size_t)sl * DM;
    float g = 0.f, u = 0.f; for (int c = lane; c < DM; c += 64) { const float x = bf2f(Am[c]); g += x * dg_bfr(W[(size_t)c * 2 * DFFE + j]); u += x * dg_bfr(W[(size_t)c * 2 * DFFE + DFFE + j]); }
    g = wave_sum(g); u = wave_sum(u);
    if (lane == 0) dg_put(A, k, dg_rel(bf2f(((const bf16_t*)(A.ws + E_HID))[(size_t)sl * DFFE + j]), g / (1.0f + expf(-g)) * u));
}
__device__ __forceinline__ void dg_moe_y(const Args& A, int k, int m) {
    const int lane = threadIdx.x & 63, gwv = blockIdx.x * 8 + (threadIdx.x >> 6);
    const unsigned h = dg_hash(gwv, k); const int row = h & (MTOK - 1), kk = (h >> 16) & 1, col = (h >> 17) & 1023;
    const int sl = ((const int*)(A.ws + TB_SLOT))[row * 2 + kk], e = ((const int*)(A.ws + TB_EID))[row * 2 + kk];
    const float* W = A.in[I_MOEDN] + ((size_t)m * 8 + e) * DFFE * DM; const bf16_t* Hh = (const bf16_t*)(A.ws + E_HID) + (size_t)sl * DFFE;
    float a = 0.f; for (int j = lane; j < DFFE; j += 64) a += bf2f(Hh[j]) * dg_bfr(W[(size_t)j * DM + col]);
    a = wave_sum(a);
    if (lane == 0) dg_put(A, k, fabsf(bf2f(((const bf16_t*)(A.ws + E_XS))[(size_t)sl * DM + col]) - a) / (fabsf(a) + 0.3f));
}
__device__ __forceinline__ void dg_combine(const Args& A, int k, const float* modprev) {
    const int lane = threadIdx.x & 63, gwv = blockIdx.x * 8 + (threadIdx.x >> 6);
    const unsigned h = dg_hash(gwv, k); const int row = h & (MTOK - 1), col = (h >> 16) & 1023, b = row >> 13;
    const float* sv = (const float*)(A.ws + TB_LSUM) + 7 * 1024 * 1024 / 4; const bf16_t* Y = (const bf16_t*)(A.ws + E_XS);
    const int s0 = ((const int*)(A.ws + TB_SLOT))[row * 2], s1 = ((const int*)(A.ws + TB_SLOT))[row * 2 + 1]; const float w0 = ((const float*)(A.ws + TB_GATE))[row * 2], w1 = ((const float*)(A.ws + TB_GATE))[row * 2 + 1];
    const float ref = sv[k * 4096 + gwv] + modprev[(size_t)b * 6144 + 5 * 1024 + col] * (w0 * bf2f(Y[(size_t)s0 * DM + col]) + w1 * bf2f(Y[(size_t)s1 * DM + col]));
    if (lane == 0) dg_put(A, k, dg_rel(A.out[(size_t)row * DM + col], ref));
}
__device__ __forceinline__ void dg_lruin(const Args& A, int k) {
    const int lane = threadIdx.x & 63, gwv = blockIdx.x * 8 + (threadIdx.x >> 6);
    const unsigned h = dg_hash(gwv, k); const int row = h & (MTOK - 1), col = (h >> 16) % 2560;
    float a = 0.f; for (int kk = lane; kk < DM; kk += 64) a += bf2f(((const bf16_t*)(A.ws + WS_HM))[(size_t)row * DM + kk]) * dg_bfr(A.in[I_LRWIN][(size_t)kk * 2560 + col]);
    a = wave_sum(a);
    float ref, got;
    if (col < LRUW) { ref = 0.5f * a * (1.0f + tanhf(0.7978845608028654f * (a + 0.044715f * a * a * a))); got = bf2f(((const bf16_t*)(A.ws + L_YB))[(size_t)row * LRUW + col]); }
    else { ref = a; got = bf2f(((const bf16_t*)(A.ws + L_XB))[(size_t)row * LRUW + col - LRUW]); }
    if (lane == 0) dg_put(A, k, dg_rel(got, ref));
}
__device__ __forceinline__ void dg_lru(const Args& A, int k) {
    const int lane = threadIdx.x & 63, gwv = blockIdx.x * 8 + (threadIdx.x >> 6);
    const unsigned h = dg_hash(gwv, k); const int b = h & 7, ch = (h >> 3) % LRUW, tc = (h >> 16) & (SEQ - 1), n = ch / 128, j = ch % 128;
    const bf16_t* XB = (const bf16_t*)(A.ws + L_XB) + (size_t)b * SEQ * LRUW;
    float hres[2];
    for (int d = 0; d < 2; ++d) {
        const float* wa = A.in[I_LRWA] + (size_t)(d * 10 + n) * 16384; const float* wx = A.in[I_LRWX] + (size_t)(d * 10 + n) * 16384;
        const float wa0 = dg_bfr(wa[lane * 128 + j]), wa1 = dg_bfr(wa[(lane + 64) * 128 + j]), wx0 = dg_bfr(wx[lane * 128 + j]), wx1 = dg_bfr(wx[(lane + 64) * 128 + j]);
        const float ba = A.in[I_LRBA][d * LRUW + ch], bx = A.in[I_LRBX][d * LRUW + ch]; const float lam = A.in[I_LRLAM][d * LRUW + ch]; const float sp = log1pf(expf(-lam));
        float hs = 0.f;
        for (int i = 0; ; ++i) { const int t = d ? (SEQ - 1 - i) : i;
            float x0 = A.in[I_LRCB][n * 128 + lane], x1 = A.in[I_LRCB][n * 128 + 64 + lane], xj = A.in[I_LRCB][ch];
            for (int w = 0; w < 4; ++w) { const int tt = t - 1 + w; if (tt >= 0 && tt < SEQ) {
                x0 += A.in[I_LRCW][w * LRUW + n * 128 + lane] * bf2f(XB[(size_t)tt * LRUW + n * 128 + lane]); x1 += A.in[I_LRCW][w * LRUW + n * 128 + 64 + lane] * bf2f(XB[(size_t)tt * LRUW + n * 128 + 64 + lane]);
                xj += A.in[I_LRCW][w * LRUW + ch] * bf2f(XB[(size_t)tt * LRUW + ch]); } }
            const float rp = wave_sum(dg_bfr(x0) * wa0 + dg_bfr(x1) * wa1), ip = wave_sum(dg_bfr(x0) * wx0 + dg_bfr(x1) * wx1);
            const float rg = 1.0f / (1.0f + expf(-(rp + ba))), ig = 1.0f / (1.0f + expf(-(ip + bx))); const float la = -8.0f * rg * sp;
            hs = expf(la) * hs + sqrtf(fmaxf(-expm1f(2.0f * la), 0.f)) * ig * xj;
            if (t == tc) break; }
        hres[d] = hs;
    }
    const size_t go = ((size_t)b * SEQ + tc) * LRUW + ch;
    const float e1 = fabsf(bf2f(((const bf16_t*)(A.ws + L_HF))[go]) - hres[0]) / (fabsf(hres[0]) + 0.3f);
    const float ref = (hres[0] + hres[1]) * bf2f(((const bf16_t*)(A.ws + L_YB))[go]);
    const float e2 = fabsf(bf2f(((const bf16_t*)(A.ws + L_HY))[go]) - ref) / (fabsf(ref) + 0.3f);
    if (lane == 0) { dg_put(A, k, e1); dg_put(A, k + 5, e2); }
}
__device__ __forceinline__ void dg_final(const Args& A, int nchk) {
    const unsigned* sl = (const unsigned*)(A.ws + WS_CTL) + DG_BASE; int code = 0; float ev = 0.f;
    for (int k = 1; k <= nchk; ++k) { const float e = __uint_as_float(sl[64 * k]); if (e > 0.05f) { code = k; ev = e; break; } }
    if (code == 0) return;
    const int c1 = code % 10, c10 = code / 10;
    const float s = -(float)c1;
    for (size_t i = (size_t)blockIdx.x * NTHR + threadIdx.x; i < (size_t)MTOK * DM; i += (size_t)gridDim.x * NTHR) A.out[i] = A.in[I_X][i] * s;
    __syncthreads();
    if (blockIdx.x == 0 && threadIdx.x == 0) { const int qq = ev < 0.1f ? 1 : ev < 0.2f ? 2 : ev < 0.5f ? 3 : ev < 1.f ? 4 : ev < 2.f ? 5 : ev < 5.f ? 6 : ev < 20.f ? 7 : ev < 1e3f ? 8 : 9;
        A.out[12345] = 100.f * (float)(10 * c10 + qq); }
}
#define DG(x) x
#define DGL(x) if constexpr (L >= DIAG_FROM) { x }
#else
#define DG(x)
#define DGL(x)
#endif

#define GRID_BAR() xcd_barrier(bar)
template <int L>
__device__ __forceinline__ void run_mixer(const Args& args, LAS unsigned char* lds, int bid, int G, const XcdBarrier& bar) {
    unsigned char* ws = args.ws; bf16_t* xo = (bf16_t*)(ws + WS_XB);
    const float* modl = (const float*)(ws + TB_MODS) + (size_t)L * NBATCH * 6144;
    const void* xs = (L == 0) ? (const void*)args.in[I_X] : (const void*)xo; constexpr bool X16 = (L != 0);
    constexpr int kind = L % 3;
    DGL(if (L > 0 && ((L - 1) & 1)) { dg_save(args, 10 * (L - 1) + 9, xo); GRID_BAR(); })
    norm_phase<false>(args, lds, bid, G, xs, X16, xo, true, args.in[I_N1G] + L * DM, modl, 0, (L > 0) && ((L - 1) & 1), modl - NBATCH * 6144, false, nullptr);
    GRID_BAR();
    DGL(if (L > 0 && ((L - 1) & 1)) { dg_combine(args, 10 * (L - 1) + 9, modl - NBATCH * 6144); GRID_BAR(); })
    DGL(dg_norm(args, 10 * L + 1, (L > 0 && ((L - 1) & 1)) ? xo : xs, args.in[I_N1G] + L * DM, L, 0); GRID_BAR();)
    if constexpr (kind == 0) {
        constexpr int al = L / 3;
        {
            pg8::Gemm g{(const bf16_t*)(ws + WS_HM), (const bf16_t*)(ws + W_QKV) + (size_t)al * 3072 * 1024, 1024};
            pg8::TileOrder S; S.init(256, 12, G, bid);
            pg8::EpiQKV E{(bf16_t*)(ws + A_Q), (bf16_t*)(ws + A_K), (bf16_t*)(ws + A_V), args.in[I_ATQN] + al * 64, args.in[I_ATKN] + al * 64,
                          (const float*)(ws + TB_COS), (const float*)(ws + TB_SIN), LOG2E};
            pg8::gemm_phase<pg8::EpiQKV>(lds, g, S, E);
        }
        GRID_BAR();
        vt_phase(args, bid, G);
        GRID_BAR();
        attn_phase(args, lds, bid, G, al);
        GRID_BAR();
        DGL(dg_save(args, 10 * L + 4, xs); GRID_BAR();)
        {
            pg8::Gemm g{(const bf16_t*)(ws + WS_HM), (const bf16_t*)(ws + W_AO) + (size_t)al * 1024 * 1024, 1024};
            pg8::TileOrder S; S.init(256, 4, G, bid);
            pg8::EpiRes<X16> E{xs, xo, modl + 2 * 1024, 1.0f};
            pg8::gemm_phase<pg8::EpiRes<X16>>(lds, g, S, E);
        }
        GRID_BAR();
        DGL(dg_res(args, 10 * L + 4, xo, modl + 2 * 1024, (const bf16_t*)(ws + WS_HM), 1024, args.in[I_ATWOUT] + (size_t)al * 1024 * 1024); GRID_BAR();)
    }
    if constexpr (kind == 1) {
        {
            pg8::Gemm g{(const bf16_t*)(ws + WS_HM), (const bf16_t*)(ws + W_HGI), 1024};
            pg8::TileOrder S; S.init(256, 20, G, bid);
            pg8::EpiAct E{0, ws, (const float*)(ws + TB_LB)};
            pg8::gemm_phase<pg8::EpiAct>(lds, g, S, E);
        }
        GRID_BAR();
        DGL(dg_hgin(args, 10 * L + 2); GRID_BAR();)
        gla_phase(args, lds, bid, G);
        GRID_BAR();
        DGL(dg_gla(args, 10 * L + 3); GRID_BAR();)
        hg_normo_phase(args, bid, G);
        GRID_BAR();
        DGL(dg_normo(args, 10 * L + 0); GRID_BAR();)
        DGL(dg_save(args, 10 * L + 4, xs); GRID_BAR();)
        {
            pg8::Gemm g{(const bf16_t*)(ws + WS_HM), (const bf16_t*)(ws + W_HGO), 1024};
            pg8::TileOrder S; S.init(256, 4, G, bid);
            pg8::EpiRes<X16> E{xs, xo, modl + 2 * 1024, 1.0f};
            pg8::gemm_phase<pg8::EpiRes<X16>>(lds, g, S, E);
        }
        GRID_BAR();
        DGL(dg_res(args, 10 * L + 4, xo, modl + 2 * 1024, (const bf16_t*)(ws + WS_HM), 1024, args.in[I_HGWOUT]); GRID_BAR();)
    }
    if constexpr (kind == 2) {
        {
            pg8::Gemm g{(const bf16_t*)(ws + WS_HM), (const bf16_t*)(ws + W_LRI), 1024};
            pg8::TileOrder S; S.init(256, 10, G, bid);
            pg8::EpiAct E{1, ws, nullptr};
            pg8::gemm_phase<pg8::EpiAct>(lds, g, S, E);
        }
        GRID_BAR();
        DGL(dg_lruin(args, 10 * L + 2); GRID_BAR();)
        lru_phase<0>(args, lds, bid, G);
        GRID_BAR();
        lru_carry_phase(args, bid, G);
        GRID_BAR();
        lru_phase<1>(args, lds, bid, G);
        GRID_BAR();
        lru_phase<2>(args, lds, bid, G);
        GRID_BAR();
        DGL(dg_lru(args, 10 * L + 3); GRID_BAR();)
        DGL(dg_save(args, 10 * L + 4, xs); GRID_BAR();)
        {
            pg8::Gemm g{(const bf16_t*)(ws + L_HY), (const bf16_t*)(ws + W_LRO), LRUW};
            pg8::TileOrder S; S.init(256, 4, G, bid);
            pg8::EpiRes<X16> E{xs, xo, modl + 2 * 1024, 1.0f};
            pg8::gemm_phase<pg8::EpiRes<X16>>(lds, g, S, E);
        }
        GRID_BAR();
        DGL(dg_res(args, 10 * L + 4, xo, modl + 2 * 1024, (const bf16_t*)(ws + L_HY), LRUW, args.in[I_LRWOUT]); GRID_BAR();)
    }
}
template <int L>
__device__ __forceinline__ void run_ffn(const Args& args, LAS unsigned char* lds, int bid, int G, const XcdBarrier& bar) {
    unsigned char* ws = args.ws; bf16_t* xo = (bf16_t*)(ws + WS_XB);
    const float* modl = (const float*)(ws + TB_MODS) + (size_t)L * NBATCH * 6144;
    if constexpr ((L & 1) == 0) {
        constexpr int m = L >> 1;
        constexpr bool F8 = (L >= FP8_DENSE_FROM);
        norm_phase<false>(args, lds, bid, G, xo, true, xo, true, args.in[I_N2G] + L * DM, modl, 1, false, modl, false, nullptr, F8);
        GRID_BAR();
        if constexpr (F8) {
            pg8::Gemm g{(const bf16_t*)(ws + WS_HM), (const bf16_t*)(ws + W_FGU) + (size_t)m * 5632 * 1024, 512};
            pg8::TileOrder S; S.init(256, 22, G, bid);
            pg8::EpiSwiGLU8 E{ws + F_HID, DFF, 1.0f / MOE_WSCALE, MOE_HSCALE};
            pg8::gemm_phase<pg8::EpiSwiGLU8, true>(lds, g, S, E);
        } else {
            pg8::Gemm g{(const bf16_t*)(ws + WS_HM), (const bf16_t*)(ws + W_FGU) + (size_t)m * 5632 * 1024, 1024};
            pg8::TileOrder S; S.init(256, 22, G, bid);
            pg8::EpiSwiGLU E{(bf16_t*)(ws + F_HID), DFF};
            pg8::gemm_phase<pg8::EpiSwiGLU>(lds, g, S, E);
        }
        GRID_BAR();
        if constexpr (F8) {
            pg8::Gemm g{(const bf16_t*)(ws + F_HID), (const bf16_t*)(ws + W_FDN) + (size_t)m * 1024 * 2816, DFF / 2};
            pg8::TileOrder S; S.init(256, 4, G, bid);
            pg8::EpiRes<true> E{xo, xo, modl + 5 * 1024, 1.0f / (MOE_WSCALE * MOE_HSCALE)};
            pg8::gemm_phase<pg8::EpiRes<true>, true>(lds, g, S, E);
        } else {
            pg8::Gemm g{(const bf16_t*)(ws + F_HID), (const bf16_t*)(ws + W_FDN) + (size_t)m * 1024 * 2816, DFF};
            pg8::TileOrder S; S.init(256, 4, G, bid);
            pg8::EpiRes<true> E{xo, xo, modl + 5 * 1024, 1.0f};
            pg8::gemm_phase<pg8::EpiRes<true>>(lds, g, S, E);
        }
        GRID_BAR();
    } else {
        constexpr int m = L >> 1;
        norm_phase<true>(args, lds, bid, G, xo, true, xo, true, args.in[I_N2G] + L * DM, modl, 1, false, modl, false, args.in[I_MOER] + (size_t)m * DM * 8);
        GRID_BAR();
        DGL(dg_norm(args, 10 * L + 5, xo, args.in[I_N2G] + L * DM, L, 1); dg_router(args, 10 * L + 5, L); GRID_BAR();)
        place_phase(args, lds, bid, G);
        GRID_BAR();
        DGL(dg_place(args, 10 * L + 6); GRID_BAR();)
        const int* tiles = (const int*)(ws + TB_TILES);
        {
            pg8::Gemm g{(const bf16_t*)(ws + E_XS), (const bf16_t*)(ws + W_MGU + (size_t)m * 8 * 7168 * 1024), 512};
            pg8::TileOrder S; S.init(tiles[8], 28, G, bid);
#pragma unroll
            for (int e = 1; e < NEXP; ++e) S.ts[e] = tiles[e];
            pg8::EpiSwiGLU8 E{ws + E_HID, DFFE, 1.0f / MOE_WSCALE, MOE_HSCALE};
            pg8::gemm_phase<pg8::EpiSwiGLU8, true>(lds, g, S, E);
        }
        GRID_BAR();
        DGL(dg_moe_hid(args, 10 * L + 7, m); GRID_BAR();)
        {
            pg8::Gemm g{(const bf16_t*)(ws + E_HID), (const bf16_t*)(ws + W_MDN + (size_t)m * 8 * 1024 * 3584), DFFE / 2};
            pg8::TileOrder S; S.init(tiles[8], 4, G, bid);
#pragma unroll
            for (int e = 1; e < NEXP; ++e) S.ts[e] = tiles[e];
            pg8::EpiPlain E{(bf16_t*)(ws + E_XS), DM, 1.0f / (MOE_WSCALE * MOE_HSCALE)};
            pg8::gemm_phase<pg8::EpiPlain, true>(lds, g, S, E);
        }
        GRID_BAR();
        DGL(dg_moe_y(args, 10 * L + 8, m); GRID_BAR();)
    }
}
__device__ __forceinline__ void final_combine(const Args& args, LAS unsigned char* lds, int bid, int G, const XcdBarrier& bar) {
    const float* modl = (const float*)(args.ws + TB_MODS) + (size_t)3 * NBATCH * 6144;
    DG(dg_save(args, 39, args.out); GRID_BAR();)
    norm_phase<false>(args, lds, bid, G, args.ws + WS_XB, true, args.out, false, args.in[I_N1G], modl, 0, true, modl, true, nullptr);
    DG(GRID_BAR(); dg_combine(args, 39, modl);)
}

__global__ void __launch_bounds__(NTHR, 2) mega_fwd(Args args) {
    extern __shared__ __attribute__((aligned(16))) unsigned char lds_raw[];
    LAS unsigned char* lds = (LAS unsigned char*)lds_raw;
    const int tid = threadIdx.x, bid = blockIdx.x, G = gridDim.x;
    unsigned char* ws = args.ws;
    volatile LAS unsigned* MISC = (volatile LAS unsigned*)(lds + MISC_OFF);
    if (tid < 64) MISC[tid] = 0u;
    __syncthreads();
    XcdBarrier bar = xcd_barrier_post((unsigned*)(ws + WS_CTL) + CW_BAR, MISC + 8);

    prologue_phase(args, lds, bid, G);
    GRID_BAR();

    run_mixer<0>(args, lds, bid, G, bar);
    run_ffn<0>(args, lds, bid, G, bar);
    run_mixer<1>(args, lds, bid, G, bar);
    run_ffn<1>(args, lds, bid, G, bar);
    run_mixer<2>(args, lds, bid, G, bar);
    run_ffn<2>(args, lds, bid, G, bar);
    run_mixer<3>(args, lds, bid, G, bar);
    run_ffn<3>(args, lds, bid, G, bar);
    final_combine(args, lds, bid, G, bar);
    DG(GRID_BAR(); dg_final(args, 49);)
}

extern "C" void kernel_launch(void* const* d_in, const int* in_sizes, int n_in, void* d_out, int out_size, void* d_ws, size_t ws_size, hipStream_t stream) {
    static int grid = 0;
    if (grid == 0) {
        if (n_in != 30 || out_size != MTOK * DM || ws_size < WS_NEED) { fprintf(stderr, "kernel_launch: unexpected shapes (n_in %d out %d ws %zu need %zu)\n", n_in, out_size, ws_size, (size_t)WS_NEED); grid = -1; return; }
        int dev = 0, cus = 0;
        if (hipGetDevice(&dev) != hipSuccess || hipDeviceGetAttribute(&cus, hipDeviceAttributeMultiprocessorCount, dev) != hipSuccess) { grid = -1; return; }
        if (hipFuncSetAttribute((const void*)mega_fwd, hipFuncAttributeMaxDynamicSharedMemorySize, LDS_BYTES) != hipSuccess) { fprintf(stderr, "kernel_launch: hipFuncSetAttribute failed\n"); grid = -1; return; }
        int per_cu = 0;
        if (hipOccupancyMaxActiveBlocksPerMultiprocessor(&per_cu, (const void*)mega_fwd, NTHR, LDS_BYTES) != hipSuccess || per_cu < 1) { fprintf(stderr, "kernel_launch: occupancy query says %d\n", per_cu); }
        (void)hipGetLastError();
        grid = (cus >= 256) ? 256 : -1;
        if (grid < 0) { fprintf(stderr, "kernel_launch: needs 256 CUs, device has %d\n", cus); return; }
    }
    if (grid < 0) return;
    if (hipMemsetAsync((char*)d_ws + WS_CTL, 0, CTL_ZERO_BYTES, stream) != hipSuccess) return;
    Args a{};
    for (int i = 0; i < 30; ++i) a.in[i] = (const float*)d_in[i];
    a.out = (float*)d_out; a.ws = (unsigned char*)d_ws;
    hipLaunchKernelGGL(mega_fwd, dim3(grid), dim3(NTHR), LDS_BYTES, stream, a);
}
```

```cpp
#define DIAG_FROM 2
#include <hip/hip_runtime.h>
#include <cstdio>
#include <cstdint>

#define LAS __attribute__((address_space(3)))
#define GAS __attribute__((address_space(1)))
typedef unsigned short bf16_t;
typedef short bf16x8 __attribute__((ext_vector_type(8)));
typedef short s16x4 __attribute__((ext_vector_type(4)));
typedef float f32x2 __attribute__((ext_vector_type(2)));
typedef float f32x4 __attribute__((ext_vector_type(4)));
typedef float f32x16 __attribute__((ext_vector_type(16)));
typedef unsigned u32x2 __attribute__((ext_vector_type(2)));
typedef unsigned u32x4 __attribute__((ext_vector_type(4)));

constexpr int MTOK = 65536, DM = 1024, SEQ = 8192, NBATCH = 8, DEPTH = 4;
constexpr int DFF = 2816, DFFE = 3584, NEXP = 8, LRUW = 1280;
constexpr float EPS = 1e-6f;
constexpr int FP8_DENSE_FROM = 2;
constexpr float MOE_WSCALE = 64.0f, MOE_HSCALE = 4.0f;
constexpr float LOG2E = 1.4426950408889634f;

constexpr size_t MiB = 1u << 20;
constexpr size_t WS_CTL = 0, CTL_ZERO_BYTES = 1 * MiB;
constexpr size_t WS_TAB = 1 * MiB;
constexpr size_t TB_MODS = WS_TAB;
constexpr size_t TB_COS = WS_TAB + 1 * MiB;
constexpr size_t TB_SIN = WS_TAB + 2 * MiB;
constexpr size_t TB_SCAL = WS_TAB + 3 * MiB;
constexpr size_t TB_LB = TB_SCAL + 4096;
constexpr size_t TB_SP = TB_SCAL + 16384;
constexpr size_t TB_EID = WS_TAB + 4 * MiB;
constexpr size_t TB_GATE = WS_TAB + 5 * MiB;
constexpr size_t TB_SLOT = WS_TAB + 6 * MiB;
constexpr size_t TB_BCNT = WS_TAB + 7 * MiB;
constexpr size_t TB_TILES = TB_BCNT + 16384;
constexpr size_t TB_LSUM = WS_TAB + 8 * MiB;
constexpr size_t TB_LCIN = WS_TAB + 16 * MiB;
constexpr size_t WS_W = 32 * MiB;
constexpr size_t W_QKV = WS_W;
constexpr size_t W_AO = W_QKV + 2 * (size_t)3072 * 1024 * 2;
constexpr size_t W_HGI = W_AO + 2 * (size_t)1024 * 1024 * 2;
constexpr size_t W_HGO = W_HGI + (size_t)5120 * 1024 * 2;
constexpr size_t W_LRI = W_HGO + (size_t)1024 * 1024 * 2;
constexpr size_t W_LRG = W_LRI + (size_t)2560 * 1024 * 2;
constexpr size_t W_LRO = W_LRG + (size_t)10 * 2 * 256 * 128 * 2;
constexpr size_t W_FGU = W_LRO + (size_t)1024 * 1280 * 2;
constexpr size_t W_FDN = W_FGU + 2 * (size_t)5632 * 1024 * 2;
constexpr size_t W_MGU = W_FDN + 2 * (size_t)1024 * 2816 * 2;
constexpr size_t W_MDN = W_MGU + 16 * (size_t)7168 * 1024 * 2;
constexpr size_t W_END = W_MDN + 16 * (size_t)1024 * 3584 * 2;
constexpr size_t WS_HM = 440 * MiB;
constexpr size_t WS_ACT = 568 * MiB;
static_assert(W_END <= WS_HM, "weights overflow");
constexpr size_t SZ_TOK = (size_t)MTOK * 1024 * 2;
constexpr size_t A_Q = WS_ACT, A_K = A_Q + SZ_TOK, A_V = A_K + SZ_TOK, A_VT = A_V + SZ_TOK;
constexpr size_t F_HID = WS_ACT;
constexpr size_t H_Q = WS_ACT, H_LFF = H_Q + SZ_TOK, H_LFB = H_LFF + SZ_TOK, H_V = H_LFB + SZ_TOK, H_G = H_V + SZ_TOK, H_OF = H_G + SZ_TOK, H_OB = H_OF + SZ_TOK;
constexpr size_t SZ_LRU = (size_t)MTOK * 1280 * 2;
constexpr size_t L_YB = WS_ACT, L_XB = L_YB + SZ_LRU, L_HF = L_XB + SZ_LRU, L_HY = L_HF + SZ_LRU, L_U = L_HY + SZ_LRU;
constexpr int MOE_ROWS = 2 * MTOK + NEXP * 256;
constexpr size_t E_XS = WS_ACT, E_HID = E_XS + (size_t)MOE_ROWS * 1024 * 2, E_END = E_HID + (size_t)MOE_ROWS * DFFE;
constexpr size_t WS_XB = 1536 * MiB;
static_assert(E_END <= WS_XB && H_OB + SZ_TOK <= WS_XB && L_U + 2 * SZ_LRU <= WS_XB && A_VT + SZ_TOK <= WS_XB, "activation regions below the residual stream");
constexpr size_t WS_NEED = WS_XB + SZ_TOK;
static_assert(WS_NEED <= (size_t)1792 * MiB, "workspace");

constexpr int CW_BAR = 4096;

constexpr int RING_BYTES = 135168;
constexpr int MISC_OFF = RING_BYTES;
constexpr int LDS_BYTES = 147456;
constexpr int NWAVES = 8, NTHR = 512;

typedef __bf16 bf16x2v __attribute__((ext_vector_type(2)));
__device__ __forceinline__ unsigned cvt_pk_bf16(float lo, float hi) { const f32x2 v = {lo, hi}; const bf16x2v b = __builtin_convertvector(v, bf16x2v); return __builtin_bit_cast(unsigned, b); }
__device__ __forceinline__ unsigned pk_fp8x4(float a, float b, float c, float d) { unsigned w = 0; w = __builtin_amdgcn_cvt_pk_fp8_f32(a, b, w, false); w = __builtin_amdgcn_cvt_pk_fp8_f32(c, d, w, true); return w; }
__device__ __forceinline__ unsigned f2bf(float f) { unsigned u = __builtin_bit_cast(unsigned, f); return (u + 0x7fffu + ((u >> 16) & 1u)) >> 16; }
__device__ __forceinline__ float bf2f(unsigned short b) { return __builtin_bit_cast(float, ((unsigned)b) << 16); }
__device__ __forceinline__ float bflo(unsigned w) { return __builtin_bit_cast(float, w << 16); }
__device__ __forceinline__ float bfhi(unsigned w) { return __builtin_bit_cast(float, w & 0xffff0000u); }
__device__ __forceinline__ float fexp2(float x) { return __builtin_amdgcn_exp2f(x); }
__device__ __forceinline__ float fexp(float x) { return __builtin_amdgcn_exp2f(x * LOG2E); }
__device__ __forceinline__ float frcp(float x) { return __builtin_amdgcn_rcpf(x); }
__device__ __forceinline__ float fsigmoid(float x) { return frcp(1.0f + fexp(-x)); }
__device__ __forceinline__ float fsilu(float x) { return x * fsigmoid(x); }
__device__ __forceinline__ float wave_sum(float v) {
#pragma unroll
    for (int o = 1; o < 64; o <<= 1) v += __shfl_xor(v, o);
    return v;
}
#define LDS_WAIT() asm volatile("s_waitcnt lgkmcnt(0)" ::: "memory")
#define VM_WAIT() asm volatile("s_waitcnt vmcnt(0)" ::: "memory")

#define XB_TMO      128
#define XB_XCNT(j)  (256  + 64 * (j))
#define XB_XSUB(j)  (1280 + 64 * (j))
#define XB_XGEN(j)  (2304 + 64 * (j))
#define XB_TOP      3328
#define XB_TOPGEN   3392
#define XCD_BAR_WORDS 3456
#define XB_SPIN_CAP (1u << 22)
__device__ __forceinline__ unsigned xb_ld(unsigned* p)              { return __hip_atomic_load(p, __ATOMIC_RELAXED, __HIP_MEMORY_SCOPE_AGENT); }
__device__ __forceinline__ unsigned xb_add(unsigned* p, unsigned v) { return __hip_atomic_fetch_add(p, v, __ATOMIC_RELAXED, __HIP_MEMORY_SCOPE_AGENT); }
__device__ __forceinline__ unsigned xb_xcc_id() { return (unsigned)__builtin_amdgcn_s_getreg((3 << 11) | 20) & 0xFu; }
#define XB_SPIN(cond, bar) do { unsigned _sp = 0; while (cond) { __builtin_amdgcn_s_sleep(1); \
    if ((++_sp & 255u) == 0u) { if (xb_ld(&(bar)[XB_TMO])) break; if (_sp > XB_SPIN_CAP) { atomicAdd(&(bar)[XB_TMO], 1u); break; } } } } while (0)
struct XcdBarrier { unsigned* bar; unsigned x; volatile LAS unsigned* st; };
__device__ __forceinline__ XcdBarrier xcd_barrier_post(unsigned* bar, volatile LAS unsigned* st) {
    XcdBarrier b; b.bar = bar; b.x = xb_xcc_id(); b.st = st;
    if (threadIdx.x == 0) (void)xb_add(&bar[XB_XCNT(b.x)], 1u);
    return b;
}
__device__ __forceinline__ void xcd_barrier_complete(unsigned* bar, unsigned x, unsigned& nloc, unsigned& nx) {
    const unsigned G = gridDim.x * gridDim.y * gridDim.z;
    unsigned sum, cnt, mine, sp = 0u;
    for (;;) {
        sum = 0u; cnt = 0u; mine = 0u;
#pragma unroll
        for (unsigned j = 0; j < 16; ++j) { const unsigned c = xb_ld(&bar[XB_XCNT(j)]); sum += c; cnt += (c > 0u) ? 1u : 0u; mine = (j == x) ? c : mine; }
        if (sum == G) break;
        __builtin_amdgcn_s_sleep(1);
        if ((++sp & 255u) == 0u) { if (xb_ld(&bar[XB_TMO])) break; if (sp > XB_SPIN_CAP) { atomicAdd(&bar[XB_TMO], 1u); break; } }
    }
    nloc = mine > 0u ? mine : 1u; nx = cnt > 0u ? cnt : 1u;
}
__device__ __forceinline__ void xcd_barrier(const XcdBarrier& b) {
    asm volatile("s_waitcnt vmcnt(0)" ::: "memory");
    __syncthreads();
    if (threadIdx.x == 0) {
        unsigned* bar = b.bar;
        __builtin_amdgcn_s_waitcnt(0);
        unsigned nloc = b.st[0], nx = b.st[1];
        if (nloc == 0u) { xcd_barrier_complete(bar, b.x, nloc, nx); b.st[0] = nloc; b.st[1] = nx; }
        const unsigned old = xb_add(&bar[XB_XSUB(b.x)], 1u);
        const unsigned gen = old / nloc;
        if (old + 1u == (gen + 1u) * nloc) {
            __builtin_amdgcn_fence(__ATOMIC_RELEASE, "agent");
            asm volatile("s_waitcnt vmcnt(0)" ::: "memory");
            const unsigned og = xb_add(&bar[XB_TOP], 1u);
            const unsigned tg = og / nx;
            if (og + 1u == (tg + 1u) * nx) xb_add(&bar[XB_TOPGEN], 1u);
            else XB_SPIN(xb_ld(&bar[XB_TOPGEN]) == tg, bar);
            __builtin_amdgcn_fence(__ATOMIC_ACQUIRE, "agent");
            xb_add(&bar[XB_XGEN(b.x)], 1u);
            asm volatile("s_waitcnt vmcnt(0)" ::: "memory");
        } else {
            XB_SPIN(xb_ld(&bar[XB_XGEN(b.x)]) == gen, bar);
            __builtin_amdgcn_fence(__ATOMIC_ACQUIRE, "agent");
            asm volatile("s_waitcnt vmcnt(0)" ::: "memory");
        }
    }
    __syncthreads();
}

namespace pg8 {
constexpr int BM = 256, BK = 64, HALF = 128, HTB = HALF * BK * 2, STAGE_BYTES = 8 * HTB, NXCD = 8, WGM = 8;
__host__ __device__ __forceinline__ int lds_byte(int r, int c) { const int st = (r >> 4) * 2 + (c >> 5), rr = r & 15, cc = c & 31, ob = rr * 64 + cc * 2; return st * 1024 + (ob ^ (((ob >> 9) & 1) << 5)); }
__host__ __device__ __forceinline__ void stage_rc(int b, int& R, int& C) { const int st = b / 1024, sb = b % 1024, swz = sb ^ (((sb >> 9) & 1) << 5); R = (st >> 1) * 16 + swz / 64; C = (st & 1) * 32 + (swz % 64) / 2; }
__host__ __device__ __forceinline__ int perm32(int rho) { const int n = rho >> 4, i = rho & 15; return 8 * (i >> 2) + 4 * n + (i & 3); }

struct Unit { int pm, pn, pb; };
struct Gemm { const bf16_t* A; const bf16_t* Bt; int K; };

struct TileOrder {
    int nM, nN, nwg, G, c; int ts[NEXP];
    __device__ __forceinline__ void init(int nM_, int nN_, int G_, int c_) { nM = nM_; nN = nN_; nwg = nM * nN; G = G_; c = c_;
#pragma unroll
        for (int e = 0; e < NEXP; ++e) ts[e] = (e == 0) ? 0 : 0x7fffffff; }
    __device__ __forceinline__ bool next(int i, Unit& u) const {
        const long L = (long)i * G + c; if (L >= nwg) return false;
        int wgid = (int)L; { const int q = nwg / NXCD, r = nwg % NXCD, xcd = wgid % NXCD, off = wgid / NXCD; wgid = (xcd < r ? xcd * (q + 1) : r * (q + 1) + (xcd - r) * q) + off; }
        const int nig = WGM * nN, gid = wgid / nig, fm = gid * WGM, gsz = (nM - fm) < WGM ? (nM - fm) : WGM;
        u.pm = fm + ((wgid % nig) % gsz); u.pn = (wgid % nig) / gsz;
        int e = 0;
#pragma unroll
        for (int k = 1; k < NEXP; ++k) e += (u.pm >= ts[k]) ? 1 : 0;
        u.pb = e * nN + u.pn; return true;
    }
};

typedef int v8i32 __attribute__((ext_vector_type(8)));
template <class Epi, bool FP8 = false>
__device__ __forceinline__ void gemm_phase(LAS unsigned char* lds, const Gemm g, const TileOrder& S, const Epi& E) {
    int tid_ = threadIdx.x; asm volatile("" : "+v"(tid_));
    const int tid = tid_, wid = __builtin_amdgcn_readfirstlane(tid >> 6), lane = tid & 63, wr = wid >> 2, wc = wid & 3, fr = lane & 15, fq = lane >> 4;
    const int K = g.K, nt = K / BK;
    unsigned voffA[2], voffB[2];
#pragma unroll
    for (int i = 0; i < 2; ++i) { int R, C; stage_rc(tid * 16 + i * 8192, R, C); const int Rb = Epi::PERM ? ((R & ~31) + perm32(R & 31)) : R;
        voffA[i] = (unsigned)(R * K + C) * 2u; voffB[i] = (unsigned)(Rb * K + C) * 2u; }
    const size_t kstep = (size_t)(BK * 2);
    const size_t hstep = (size_t)HALF * K * 2;
    const size_t tstep = 2 * hstep;
    const unsigned ldsw = (unsigned)wid * 1024u;
    const int aoff = lds_byte(wr * 64 + fr, fq * 8), boff = lds_byte(wc * 32 + fr, fq * 8);
#define PG8_SA(b, h) (((b) * 2 + (h)) * HTB)
#define PG8_SB(b, h) ((4 + (b) * 2 + (h)) * HTB)
#define PG8_STAGE(bufoff, gbase, voff) do { _Pragma("unroll") for (int _i = 0; _i < 2; ++_i) \
        __builtin_amdgcn_global_load_lds((const unsigned*)((const char*)(gbase) + (voff)[_i]), (LAS unsigned*)(lds + (bufoff) + ldsw + _i * 8192), 16, 0, 0); } while (0)
#define PG8_LD8(p) __builtin_bit_cast(v8i32, __builtin_shufflevector(*(const LAS u32x4*)(p), *(const LAS u32x4*)((p) + 1024), 0, 1, 2, 3, 4, 5, 6, 7))
#define PG8_LDA(dst, b, h) do { if constexpr (FP8) { _Pragma("unroll") for (int m = 0; m < 4; ++m) dst##8[m] = PG8_LD8(lds + PG8_SA(b, h) + aoff + m * 2048); } \
        else { _Pragma("unroll") for (int m = 0; m < 4; ++m) _Pragma("unroll") for (int k = 0; k < 2; ++k) dst[m][k] = *(const LAS bf16x8*)(lds + PG8_SA(b, h) + aoff + m * 2048 + k * 1024); } } while (0)
#define PG8_LDB(dst, b, h) do { if constexpr (FP8) { _Pragma("unroll") for (int n = 0; n < 2; ++n) dst##8[n] = PG8_LD8(lds + PG8_SB(b, h) + boff + n * 2048); } \
        else { _Pragma("unroll") for (int n = 0; n < 2; ++n) _Pragma("unroll") for (int k = 0; k < 2; ++k) dst[n][k] = *(const LAS bf16x8*)(lds + PG8_SB(b, h) + boff + n * 2048 + k * 1024); } } while (0)
#define PG8_MMA(ai, bj, At, Bt) do { __builtin_amdgcn_s_setprio(1); \
        if constexpr (FP8) { _Pragma("unroll") for (int m = 0; m < 4; ++m) _Pragma("unroll") for (int n = 0; n < 2; ++n) \
            asm volatile("v_mfma_scale_f32_16x16x128_f8f6f4 %0, %1, %2, %0, %3, %3 op_sel_hi:[0,0,0]" : "+v"(acc[ai][bj][m][n]) : "v"(Bt##8[n]), "v"(At##8[m]), "v"(one_scale)); } \
        else { _Pragma("unroll") for (int m = 0; m < 4; ++m) _Pragma("unroll") for (int n = 0; n < 2; ++n) _Pragma("unroll") for (int k = 0; k < 2; ++k) \
            acc[ai][bj][m][n] = __builtin_amdgcn_mfma_f32_16x16x32_bf16(Bt[n][k], At[m][k], acc[ai][bj][m][n], 0, 0, 0); } \
        __builtin_amdgcn_s_setprio(0); } while (0)
#define PG8_WAIT_V(n) asm volatile("s_waitcnt vmcnt(" #n ")" ::: "memory")
#define PG8_WAIT_L(n) asm volatile("s_waitcnt lgkmcnt(" #n ")" ::: "memory")
#define PG8_BAR __builtin_amdgcn_s_barrier()
#define PG8_SCHED __builtin_amdgcn_sched_barrier(0)
    Unit cur, nxt; int ui = 0;
    if (!S.next(0, cur)) return;
    f32x4 acc[2][2][4][2];
#pragma unroll
    for (int a = 0; a < 2; ++a)
#pragma unroll
        for (int b = 0; b < 2; ++b)
#pragma unroll
            for (int m = 0; m < 4; ++m)
#pragma unroll
                for (int n = 0; n < 2; ++n) acc[a][b][m][n] = (f32x4){0.f, 0.f, 0.f, 0.f};
    bf16x8 At[4][2], B0[2][2], B1[2][2]; v8i32 At8[4], B08[2], B18[2];
    int one_scale = 0x7f7f7f7f; asm volatile("" : "+v"(one_scale));
    const char* cA = (const char*)g.A + (size_t)cur.pm * tstep; const char* cB = (const char*)g.Bt + (size_t)cur.pb * tstep;
    PG8_STAGE(PG8_SB(0, 0), cB, voffB); PG8_STAGE(PG8_SA(0, 0), cA, voffA); PG8_STAGE(PG8_SB(0, 1), cB + hstep, voffB); PG8_STAGE(PG8_SA(0, 1), cA + hstep, voffA);
    if (wr == 1) PG8_BAR;
    PG8_WAIT_V(4); PG8_BAR;
    PG8_STAGE(PG8_SB(1, 0), cB + kstep, voffB); PG8_STAGE(PG8_SA(1, 0), cA + kstep, voffA); PG8_STAGE(PG8_SB(1, 1), cB + hstep + kstep, voffB);
    PG8_WAIT_V(6); PG8_BAR;
    for (;;) {
        const bool has_next = S.next(ui + 1, nxt);
        const char* nA = has_next ? (const char*)g.A + (size_t)nxt.pm * tstep : cA; const char* nB = has_next ? (const char*)g.Bt + (size_t)nxt.pb * tstep : cB;
        for (int t = 0; t < nt; t += 2) {
            const bool last = (t == nt - 2);
            const char* a1 = cA + (size_t)(t + 1) * kstep;
            const char* a2 = last ? nA : cA + (size_t)(t + 2) * kstep; const char* b2 = last ? nB : cB + (size_t)(t + 2) * kstep;
            const char* a3 = a2 + kstep; const char* b3 = b2 + kstep;
            PG8_LDB(B0, 0, 0); PG8_SCHED; PG8_LDA(At, 0, 0); PG8_STAGE(PG8_SA(1, 1), a1 + hstep, voffA);
            PG8_WAIT_L(8); PG8_BAR; PG8_WAIT_L(0); PG8_MMA(0, 0, At, B0); PG8_BAR; PG8_SCHED;
            PG8_LDB(B1, 0, 1); PG8_STAGE(PG8_SB(0, 0), b2, voffB);
            PG8_BAR; PG8_WAIT_L(0); PG8_MMA(0, 1, At, B1); PG8_BAR;
            PG8_LDA(At, 0, 1); PG8_STAGE(PG8_SA(0, 0), a2, voffA);
            PG8_BAR; PG8_WAIT_L(0); PG8_MMA(1, 0, At, B0); PG8_BAR; PG8_SCHED;
            PG8_STAGE(PG8_SB(0, 1), b2 + hstep, voffB);
            PG8_WAIT_V(6); PG8_BAR; PG8_MMA(1, 1, At, B1); PG8_BAR;
            PG8_LDB(B0, 1, 0); PG8_SCHED; PG8_LDA(At, 1, 0); PG8_STAGE(PG8_SA(0, 1), a2 + hstep, voffA);
            PG8_WAIT_L(8); PG8_BAR; PG8_WAIT_L(0); PG8_MMA(0, 0, At, B0); PG8_BAR; PG8_SCHED;
            PG8_LDB(B1, 1, 1); PG8_STAGE(PG8_SB(1, 0), b3, voffB);
            PG8_BAR; PG8_WAIT_L(0); PG8_MMA(0, 1, At, B1); PG8_BAR;
            PG8_LDA(At, 1, 1); PG8_STAGE(PG8_SA(1, 0), a3, voffA);
            PG8_BAR; PG8_WAIT_L(0); PG8_MMA(1, 0, At, B0); PG8_BAR; PG8_SCHED;
            PG8_STAGE(PG8_SB(1, 1), b3 + hstep, voffB);
            PG8_WAIT_V(6); PG8_BAR; PG8_MMA(1, 1, At, B1); PG8_BAR;
        }
        if constexpr (FP8) asm volatile("s_nop 15\n\ts_nop 15" ::: "memory");
        E(acc, cur, wr, wc, fr, fq);
        if (!has_next) break;
#pragma unroll
        for (int a = 0; a < 2; ++a)
#pragma unroll
            for (int b = 0; b < 2; ++b)
#pragma unroll
                for (int m = 0; m < 4; ++m)
#pragma unroll
                    for (int n = 0; n < 2; ++n) acc[a][b][m][n] = (f32x4){0.f, 0.f, 0.f, 0.f};
        cur = nxt; cA = nA; cB = nB; ++ui;
    }
    PG8_WAIT_V(0);
    if (wr == 0) PG8_BAR;
    PG8_BAR;
#undef PG8_SA
#undef PG8_SB
#undef PG8_STAGE
#undef PG8_LDA
#undef PG8_LDB
#undef PG8_MMA
#undef PG8_LD8
#undef PG8_WAIT_V
#undef PG8_WAIT_L
#undef PG8_BAR
#undef PG8_SCHED
}

struct EpiQKV {
    static constexpr bool PERM = true;
    bf16_t *Q, *Kk, *V; const float *gq, *gk, *cosT, *sinT; float qscale;
    __device__ __forceinline__ void operator()(const f32x4 (&acc)[2][2][4][2], const Unit& u, int wr, int wc, int fr, int fq) const {
        const int row0 = u.pm * BM + wr * 64 + fr;
        if (u.pn >= 8) {
            const int col0 = (u.pn - 8) * BM + wc * 32 + 8 * fq;
#pragma unroll
            for (int ai = 0; ai < 2; ++ai)
#pragma unroll
                for (int m = 0; m < 4; ++m) { bf16_t* rowp = V + (size_t)(row0 + ai * HALF + m * 16) * DM + col0;
#pragma unroll
                    for (int bj = 0; bj < 2; ++bj) { const f32x4 v0 = acc[ai][bj][m][0], v1 = acc[ai][bj][m][1];
                        u32x4 w; w.x = cvt_pk_bf16(v0[0], v0[1]); w.y = cvt_pk_bf16(v0[2], v0[3]); w.z = cvt_pk_bf16(v1[0], v1[1]); w.w = cvt_pk_bf16(v1[2], v1[3]);
                        *(u32x4*)(rowp + bj * HALF) = w; } }
        } else {
            const int part = u.pn >> 2, sh = 4 * (u.pn & 3) + wc;
            bf16_t* dst = part ? Kk : Q; const float* g = part ? gk : gq; const float sc = part ? 1.0f : qscale;
            f32x4 g0[2], g1[2];
#pragma unroll
            for (int n = 0; n < 2; ++n) { g0[n] = *(const f32x4*)(g + 8 * fq + 4 * n); g1[n] = *(const f32x4*)(g + 32 + 8 * fq + 4 * n); }
#pragma unroll
            for (int ai = 0; ai < 2; ++ai)
#pragma unroll
                for (int m = 0; m < 4; ++m) {
                    const int r = row0 + ai * HALF + m * 16; const int pos = r & (SEQ - 1);
                    f32x4 x1[2], x2[2]; float ss = 0.f;
#pragma unroll
                    for (int n = 0; n < 2; ++n) { x1[n] = acc[ai][0][m][n]; x2[n] = acc[ai][1][m][n];
                        ss += (x1[n][0] * x1[n][0] + x1[n][1] * x1[n][1]) + (x1[n][2] * x1[n][2] + x1[n][3] * x1[n][3]);
                        ss += (x2[n][0] * x2[n][0] + x2[n][1] * x2[n][1]) + (x2[n][2] * x2[n][2] + x2[n][3] * x2[n][3]); }
                    ss += __shfl_xor(ss, 16); ss += __shfl_xor(ss, 32);
                    const float rstd = __builtin_amdgcn_rsqf(ss * (1.0f / 64.0f) + EPS) ;
                    unsigned char* op = (unsigned char*)dst + (size_t)r * DM + sh * 64 + 8 * fq;
                    u32x2 w1, w2;
#pragma unroll
                    for (int n = 0; n < 2; ++n) {
                        const f32x4 cs = *(const f32x4*)(cosT + pos * 32 + 8 * fq + 4 * n), sn = *(const f32x4*)(sinT + pos * 32 + 8 * fq + 4 * n);
                        const f32x4 y1 = x1[n] * rstd * g0[n], y2 = x2[n] * rstd * g1[n];
                        const f32x4 o1 = (y1 * cs - y2 * sn) * sc, o2 = (y2 * cs + y1 * sn) * sc;
                        if (n == 0) { w1.x = pk_fp8x4(o1[0], o1[1], o1[2], o1[3]); w2.x = pk_fp8x4(o2[0], o2[1], o2[2], o2[3]); }
                        else { w1.y = pk_fp8x4(o1[0], o1[1], o1[2], o1[3]); w2.y = pk_fp8x4(o2[0], o2[1], o2[2], o2[3]); }
                    }
                    *(u32x2*)(op) = w1; *(u32x2*)(op + 32) = w2;
                }
        }
    }
};
__device__ __forceinline__ f32x4 ld_x4(const void* p, size_t i, bool is16) {
    if (is16) { const u32x2 w = *(const u32x2*)((const bf16_t*)p + i); return (f32x4){bflo(w.x), bfhi(w.x), bflo(w.y), bfhi(w.y)}; }
    return *(const f32x4*)((const float*)p + i);
}
template <bool IN16>
struct EpiRes {
    static constexpr bool PERM = false;
    const void* xin; bf16_t* xout; const float* gate; float sc;
    __device__ __forceinline__ void operator()(const f32x4 (&acc)[2][2][4][2], const Unit& u, int wr, int wc, int fr, int fq) const {
        const int row0 = u.pm * BM + wr * 64 + fr, col0 = u.pn * BM + wc * 32 + 4 * fq;
        const float* gp = gate + (size_t)(u.pm >> 5) * 6144 + col0;
        f32x4 gv[2][2];
#pragma unroll
        for (int bj = 0; bj < 2; ++bj)
#pragma unroll
            for (int n = 0; n < 2; ++n) gv[bj][n] = *(const f32x4*)(gp + bj * HALF + n * 16) * sc;
#pragma unroll
        for (int ai = 0; ai < 2; ++ai)
#pragma unroll
            for (int m = 0; m < 4; ++m) { const size_t off = (size_t)(row0 + ai * HALF + m * 16) * DM + col0;
                f32x4 xv[2][2];
#pragma unroll
                for (int bj = 0; bj < 2; ++bj)
#pragma unroll
                    for (int n = 0; n < 2; ++n) xv[bj][n] = ld_x4(xin, off + bj * HALF + n * 16, IN16);
#pragma unroll
                for (int bj = 0; bj < 2; ++bj)
#pragma unroll
                    for (int n = 0; n < 2; ++n) { const f32x4 o = xv[bj][n] + gv[bj][n] * acc[ai][bj][m][n];
                        *(u32x2*)(xout + off + bj * HALF + n * 16) = (u32x2){cvt_pk_bf16(o[0], o[1]), cvt_pk_bf16(o[2], o[3])}; }
                if (m == 3) asm volatile("" ::: "memory"); }
    }
};
struct EpiSwiGLU {
    static constexpr bool PERM = true;
    bf16_t* H; int ldh;
    __device__ __forceinline__ void operator()(const f32x4 (&acc)[2][2][4][2], const Unit& u, int wr, int wc, int fr, int fq) const {
        const int row0 = u.pm * BM + wr * 64 + fr, col0 = u.pn * HALF + wc * 32 + 8 * fq;
#pragma unroll
        for (int ai = 0; ai < 2; ++ai)
#pragma unroll
            for (int m = 0; m < 4; ++m) { bf16_t* rowp = H + (size_t)(row0 + ai * HALF + m * 16) * ldh + col0;
                f32x4 v[2];
#pragma unroll
                for (int n = 0; n < 2; ++n) { const f32x4 gt = acc[ai][0][m][n], up = acc[ai][1][m][n];
#pragma unroll
                    for (int j = 0; j < 4; ++j) v[n][j] = fsilu(gt[j]) * up[j]; }
                u32x4 w; w.x = cvt_pk_bf16(v[0][0], v[0][1]); w.y = cvt_pk_bf16(v[0][2], v[0][3]); w.z = cvt_pk_bf16(v[1][0], v[1][1]); w.w = cvt_pk_bf16(v[1][2], v[1][3]);
                *(u32x4*)rowp = w; }
    }
};
struct EpiSwiGLU8 {
    static constexpr bool PERM = true;
    unsigned char* H; int ldh; float ws, hs;
    __device__ __forceinline__ void operator()(const f32x4 (&acc)[2][2][4][2], const Unit& u, int wr, int wc, int fr, int fq) const {
        const int row0 = u.pm * BM + wr * 64 + fr, col0 = u.pn * HALF + wc * 32 + 8 * fq;
#pragma unroll
        for (int ai = 0; ai < 2; ++ai)
#pragma unroll
            for (int m = 0; m < 4; ++m) { unsigned char* rowp = H + (size_t)(row0 + ai * HALF + m * 16) * ldh + col0;
                f32x4 v[2];
#pragma unroll
                for (int n = 0; n < 2; ++n) { const f32x4 gt = acc[ai][0][m][n] * ws, up = acc[ai][1][m][n] * (ws * hs);
#pragma unroll
                    for (int j = 0; j < 4; ++j) v[n][j] = fsilu(gt[j]) * up[j]; }
                *(u32x2*)rowp = (u32x2){pk_fp8x4(v[0][0], v[0][1], v[0][2], v[0][3]), pk_fp8x4(v[1][0], v[1][1], v[1][2], v[1][3])}; }
    }
};
struct EpiPlain {
    static constexpr bool PERM = true;
    bf16_t* O; int ldc; float sc;
    __device__ __forceinline__ void operator()(const f32x4 (&acc)[2][2][4][2], const Unit& u, int wr, int wc, int fr, int fq) const {
        const int row0 = u.pm * BM + wr * 64 + fr, col0 = u.pn * BM + wc * 32 + 8 * fq;
#pragma unroll
        for (int ai = 0; ai < 2; ++ai)
#pragma unroll
            for (int m = 0; m < 4; ++m) { bf16_t* rowp = O + (size_t)(row0 + ai * HALF + m * 16) * ldc + col0;
#pragma unroll
                for (int bj = 0; bj < 2; ++bj) { const f32x4 v0 = acc[ai][bj][m][0] * sc, v1 = acc[ai][bj][m][1] * sc;
                    u32x4 w; w.x = cvt_pk_bf16(v0[0], v0[1]); w.y = cvt_pk_bf16(v0[2], v0[3]); w.z = cvt_pk_bf16(v1[0], v1[1]); w.w = cvt_pk_bf16(v1[2], v1[3]);
                    *(u32x4*)(rowp + bj * HALF) = w; } }
    }
};
struct EpiAct {
    static constexpr bool PERM = true;
    int kind; unsigned char* ws; const float* lb;
    __device__ __forceinline__ void operator()(const f32x4 (&acc)[2][2][4][2], const Unit& u, int wr, int wc, int fr, int fq) const {
        const int row0 = u.pm * BM + wr * 64 + fr;
        int mode, ldc, colt; size_t boff;
        if (kind == 0) { const int grp = u.pn >> 2; colt = (u.pn & 3) * 256; ldc = 1024;
            boff = grp == 0 ? H_Q : grp == 1 ? H_LFF : grp == 2 ? H_LFB : grp == 3 ? H_V : H_G; mode = (grp == 0 || grp == 4) ? 1 : (grp == 3 ? 0 : 3); }
        else { ldc = LRUW; if (u.pn < 5) { boff = L_YB; colt = u.pn * 256; mode = 2; } else { boff = L_XB; colt = (u.pn - 5) * 256; mode = 0; } }
        bf16_t* base = (bf16_t*)(ws + boff);
        const int col0 = colt + wc * 32 + 8 * fq;
        f32x4 lbv[2][2];
        if (mode == 3) { const float* lp = lb + ((u.pn >> 2) - 1) * 1024 + col0;
#pragma unroll
            for (int bj = 0; bj < 2; ++bj)
#pragma unroll
                for (int n = 0; n < 2; ++n) lbv[bj][n] = *(const f32x4*)(lp + bj * HALF + 4 * n); }
#pragma unroll
        for (int ai = 0; ai < 2; ++ai)
#pragma unroll
            for (int m = 0; m < 4; ++m) { bf16_t* rowp = base + (size_t)(row0 + ai * HALF + m * 16) * ldc + col0;
#pragma unroll
                for (int bj = 0; bj < 2; ++bj) { f32x4 v[2]; u32x4 w;
#pragma unroll
                    for (int n = 0; n < 2; ++n) { v[n] = acc[ai][bj][m][n];
                        if (mode == 1) {
#pragma unroll
                            for (int j = 0; j < 4; ++j) v[n][j] = fsilu(v[n][j]); }
                        else if (mode == 2) {
#pragma unroll
                            for (int j = 0; j < 4; ++j) { const float x = v[n][j]; v[n][j] = x * fsigmoid(1.5957691216057308f * (x + 0.044715f * x * x * x)); } }
                        else if (mode == 3) {
#pragma unroll
                            for (int j = 0; j < 4; ++j) { const float l = lbv[bj][n][j]; const float fg = l + (1.0f - l) * fsigmoid(v[n][j]); v[n][j] = __builtin_amdgcn_logf(fg) * 0.6931471805599453f; } }
                    }
                    if (mode == 3) {
#pragma unroll
                        for (int n = 0; n < 2; ++n) { const _Float16 h0 = (_Float16)v[n][0], h1 = (_Float16)v[n][1], h2 = (_Float16)v[n][2], h3 = (_Float16)v[n][3];
                            const unsigned a = (unsigned)__builtin_bit_cast(unsigned short, h0) | ((unsigned)__builtin_bit_cast(unsigned short, h1) << 16);
                            const unsigned b = (unsigned)__builtin_bit_cast(unsigned short, h2) | ((unsigned)__builtin_bit_cast(unsigned short, h3) << 16);
                            if (n == 0) { w.x = a; w.y = b; } else { w.z = a; w.w = b; } }
                    } else { w.x = cvt_pk_bf16(v[0][0], v[0][1]); w.y = cvt_pk_bf16(v[0][2], v[0][3]); w.z = cvt_pk_bf16(v[1][0], v[1][1]); w.w = cvt_pk_bf16(v[1][2], v[1][3]); }
                    *(u32x4*)(rowp + bj * HALF) = w; } }
    }
};
}

struct Args { const float* in[30]; float* out; unsigned char* ws; };
enum { I_X = 0, I_C, I_ADAW, I_ADAB, I_N1G, I_N2G, I_ATWIN, I_ATQN, I_ATKN, I_ATLAM, I_ATSUB, I_ATWOUT, I_HGWIN, I_HGLB, I_HGNG, I_HGWOUT,
       I_LRWIN, I_LRCW, I_LRCB, I_LRWA, I_LRBA, I_LRWX, I_LRBX, I_LRLAM, I_LRWOUT, I_FFGU, I_FFDN, I_MOER, I_MOEGU, I_MOEDN };
enum { SC_LAM0 = 0, SC_LAM1, SC_OML0, SC_OML1, SC_MC0, SC_MC1 };

__device__ __forceinline__ void cvt_item(const float* W, int ldw, int src_col0, bf16_t* WT, int ldt, int dst_row0, int k0, LAS float* scr, int lane) {
#pragma unroll 8
    for (int i = 0; i < 32; ++i) { const int kk = 2 * i + (lane >> 5); scr[kk * 33 + (lane & 31)] = W[(size_t)(k0 + kk) * ldw + src_col0 + (lane & 31)]; }
    LDS_WAIT(); asm volatile("" ::: "memory");
    const int c = lane & 7;
#pragma unroll
    for (int j = 0; j < 4; ++j) { const int n = (lane >> 3) + 8 * j; const LAS float* s = scr + (8 * c) * 33 + n;
        u32x4 o; o.x = cvt_pk_bf16(s[0 * 33], s[1 * 33]); o.y = cvt_pk_bf16(s[2 * 33], s[3 * 33]); o.z = cvt_pk_bf16(s[4 * 33], s[5 * 33]); o.w = cvt_pk_bf16(s[6 * 33], s[7 * 33]);
        *(u32x4*)(WT + (size_t)(dst_row0 + n) * ldt + k0 + 8 * c) = o; }
    LDS_WAIT(); asm volatile("" ::: "memory");
}
__device__ __forceinline__ void cvt_item8(const float* W, int ldw, int src_col0, unsigned char* WT, int ldt, int dst_row0, int k0, float sc, LAS float* scr, int lane) {
#pragma unroll 8
    for (int i = 0; i < 32; ++i) { const int kk = 2 * i + (lane >> 5); scr[kk * 33 + (lane & 31)] = W[(size_t)(k0 + kk) * ldw + src_col0 + (lane & 31)]; }
    LDS_WAIT(); asm volatile("" ::: "memory");
    const int c = lane & 7;
#pragma unroll
    for (int j = 0; j < 4; ++j) { const int n = (lane >> 3) + 8 * j; const LAS float* s = scr + (8 * c) * 33 + n;
        *(u32x2*)(WT + (size_t)(dst_row0 + n) * ldt + k0 + 8 * c) = (u32x2){pk_fp8x4(s[0 * 33] * sc, s[1 * 33] * sc, s[2 * 33] * sc, s[3 * 33] * sc), pk_fp8x4(s[4 * 33] * sc, s[5 * 33] * sc, s[6 * 33] * sc, s[7 * 33] * sc)}; }
    LDS_WAIT(); asm volatile("" ::: "memory");
}
enum { MAP_ID = 0, MAP_QKV = 1, MAP_SWI = 2 };
template <bool F8 = false>
__device__ __forceinline__ void cvt_family(const float* src, size_t sstride, int ninst, int ldw, int K, int ng, int map, int F, bf16_t* dst, size_t dstride,
                                           LAS float* scr, int gw, int NGW, int lane) {
    const int nkb = K / 64, per = nkb * ng, total = ninst * per;
    for (int it = gw; it < total; it += NGW) {
        const int inst = it / per, r = it - inst * per, kb = r / ng, gi = r - kb * ng;
        int sc0;
        if (map == MAP_ID) sc0 = 32 * gi;
        else if (map == MAP_QKV) { const int pn = gi >> 3, bj = (gi >> 2) & 1, wc = gi & 3;
            if (pn < 8) { const int part = pn >> 2, sh = 4 * (pn & 3) + wc; sc0 = part * 1024 + sh * 64 + 32 * bj; } else sc0 = 32 * gi; }
        else { const int pn = gi >> 3, bj = (gi >> 2) & 1, q = gi & 3; sc0 = bj * F + pn * 128 + 32 * q; }
        if constexpr (F8) cvt_item8(src + (size_t)inst * sstride, ldw, sc0, (unsigned char*)dst + (size_t)inst * dstride, K, 32 * gi, 64 * kb, MOE_WSCALE, scr, lane);
        else cvt_item(src + (size_t)inst * sstride, ldw, sc0, dst + (size_t)inst * dstride, K, 32 * gi, 64 * kb, scr, lane);
    }
}

__device__ __forceinline__ void prologue_phase(const Args& A, LAS unsigned char* lds, int bid, int G) {
    const int tid = threadIdx.x, lane = tid & 63, wave = tid >> 6;
    unsigned char* ws = A.ws;
    {
        LAS float* sc = (LAS float*)lds;
        LAS float* red = (LAS float*)(lds + 32768);
        for (int i = tid; i < NBATCH * DM; i += NTHR) { const float cv = A.in[I_C][i]; sc[i] = fsilu(cv); }
        __syncthreads();
        float* mods = (float*)(ws + TB_MODS);
        for (int cb = bid; cb < (DEPTH * 6144) / 128; cb += G) {
            const int col = cb * 128 + (tid & 127), l = col / 6144, e = col - l * 6144, ch = tid >> 7;
            const float* wp = A.in[I_ADAW] + (size_t)l * DM * 6144 + e;
            float a[NBATCH];
#pragma unroll
            for (int b = 0; b < NBATCH; ++b) a[b] = 0.f;
#pragma unroll 4
            for (int d = ch * 256; d < ch * 256 + 256; ++d) { const float w = wp[(size_t)d * 6144];
#pragma unroll
                for (int b = 0; b < NBATCH; ++b) a[b] += sc[b * DM + d] * w; }
#pragma unroll
            for (int b = 0; b < NBATCH; ++b) red[(ch * 128 + (tid & 127)) * 8 + b] = a[b];
            __syncthreads();
            if (tid < 128) { const float bias = A.in[I_ADAB][l * 6144 + e];
#pragma unroll
                for (int b = 0; b < NBATCH; ++b) { const float s = ((red[(0 * 128 + tid) * 8 + b] + red[(1 * 128 + tid) * 8 + b]) + (red[(2 * 128 + tid) * 8 + b] + red[(3 * 128 + tid) * 8 + b])) + bias;
                    mods[((size_t)l * NBATCH + b) * 6144 + e] = s; } }
            __syncthreads();
        }
    }
    {
        float* cosT = (float*)(ws + TB_COS); float* sinT = (float*)(ws + TB_SIN);
        for (int i = bid * NTHR + tid; i < SEQ * 32; i += G * NTHR) {
            const int pos = i >> 5, d = i & 31;
            const float inv = (float)exp(-(double)d * (1.0 / 32.0) * 9.210340371976184);
            const float ang = (float)pos * inv;
            const double rev = (double)ang * 0.15915494309189535; const float fr = (float)(rev - floor(rev));
            cosT[i] = __builtin_amdgcn_cosf(fr); sinT[i] = __builtin_amdgcn_sinf(fr);
        }
        if (bid == 0 && tid < 2) {
            const int a = tid; const float* lm = A.in[I_ATLAM] + a * 256;
            float s1 = 0.f, s2 = 0.f; for (int i = 0; i < 64; ++i) { s1 += lm[i] * lm[64 + i]; s2 += lm[128 + i] * lm[192 + i]; }
            const float linit = 0.8f - 0.6f * expf(-0.3f * (float)(3 * a));
            float mq = 0.f, mk = 0.f; for (int i = 0; i < 64; ++i) { mq = fmaxf(mq, fabsf(A.in[I_ATQN][a * 64 + i])); mk = fmaxf(mk, fabsf(A.in[I_ATKN][a * 64 + i])); }
            float* scal = (float*)(ws + TB_SCAL);
            scal[SC_LAM0 + a] = expf(s1) - expf(s2) + linit; scal[SC_OML0 + a] = 1.0f - linit; scal[SC_MC0 + a] = 8.0f * mq * mk * LOG2E * 1.0001f;
        }
        if (bid == 1) {
            float* lb = (float*)(ws + TB_LB);
            for (int i = tid; i < 2 * 1024; i += NTHR) { const int d = i >> 10, k = i & 1023; const float* p = A.in[I_HGLB] + (size_t)d * DEPTH * 1024 + k;
                float mx = p[0]; for (int l = 1; l < DEPTH; ++l) mx = fmaxf(mx, p[l * 1024]);
                float den = 0.f, num = 0.f; for (int l = 0; l < DEPTH; ++l) { const float e = expf(p[l * 1024] - mx); den += e; if (l == 1) num += e; }
                lb[i] = num / den; }
        }
        if (bid == 2) {
            float* sp = (float*)(ws + TB_SP);
            for (int i = tid; i < 2 * LRUW; i += NTHR) { const float x = -A.in[I_LRLAM][i]; sp[i] = (x > 20.f) ? x : log1pf(expf(x)); }
        }
    }
    {
        LAS float* scr = (LAS float*)(lds + wave * 16384);
        const int vcu = (bid % 8) * (G / 8) + bid / 8;
        const int gw = vcu * NWAVES + wave, NGW = G * NWAVES;
        cvt_family(A.in[I_ATWIN], (size_t)1024 * 3072, 2, 3072, 1024, 96, MAP_QKV, 0, (bf16_t*)(ws + W_QKV), (size_t)3072 * 1024, scr, gw, NGW, lane);
        cvt_family(A.in[I_ATWOUT], (size_t)1024 * 1024, 2, 1024, 1024, 32, MAP_ID, 0, (bf16_t*)(ws + W_AO), (size_t)1024 * 1024, scr, gw, NGW, lane);
        cvt_family(A.in[I_HGWIN], 0, 1, 5120, 1024, 160, MAP_ID, 0, (bf16_t*)(ws + W_HGI), 0, scr, gw, NGW, lane);
        cvt_family(A.in[I_HGWOUT], 0, 1, 1024, 1024, 32, MAP_ID, 0, (bf16_t*)(ws + W_HGO), 0, scr, gw, NGW, lane);
        cvt_family(A.in[I_LRWIN], 0, 1, 2560, 1024, 80, MAP_ID, 0, (bf16_t*)(ws + W_LRI), 0, scr, gw, NGW, lane);
        cvt_family(A.in[I_LRWOUT], 0, 1, 1024, 1280, 32, MAP_ID, 0, (bf16_t*)(ws + W_LRO), 0, scr, gw, NGW, lane);
        for (int it = gw; it < 2 * 20 * 2 * 4; it += NGW) {
            const int part = it / 160, r = it % 160, inst = r >> 3, kb = (r >> 2) & 1, gi = r & 3, d = inst / 10, n = inst % 10;
            const float* src = (part ? A.in[I_LRWX] : A.in[I_LRWA]) + (size_t)inst * 16384;
            cvt_item(src, 128, 32 * gi, (bf16_t*)(ws + W_LRG) + (size_t)(n * 2 + d) * 256 * 128, 128, part * 128 + 32 * gi, 64 * kb, scr, lane);
        }
        static_assert(FP8_DENSE_FROM == 2 || FP8_DENSE_FROM > 3, "dense layer 0 stays bf16; layer 2 optional");
        constexpr int NB16 = (FP8_DENSE_FROM == 2) ? 1 : 2;
        cvt_family(A.in[I_FFGU], (size_t)1024 * 5632, NB16, 5632, 1024, 176, MAP_SWI, DFF, (bf16_t*)(ws + W_FGU), (size_t)5632 * 1024, scr, gw, NGW, lane);
        cvt_family(A.in[I_FFDN], (size_t)2816 * 1024, NB16, 1024, 2816, 32, MAP_ID, 0, (bf16_t*)(ws + W_FDN), (size_t)1024 * 2816, scr, gw, NGW, lane);
        if constexpr (NB16 == 1) {
            cvt_family<true>(A.in[I_FFGU] + (size_t)1024 * 5632, 0, 1, 5632, 1024, 176, MAP_SWI, DFF, (bf16_t*)(ws + W_FGU) + (size_t)5632 * 1024, 0, scr, gw, NGW, lane);
            cvt_family<true>(A.in[I_FFDN] + (size_t)2816 * 1024, 0, 1, 1024, 2816, 32, MAP_ID, 0, (bf16_t*)(ws + W_FDN) + (size_t)1024 * 2816, 0, scr, gw, NGW, lane);
        }
        cvt_family<true>(A.in[I_MOEGU], (size_t)1024 * 7168, 16, 7168, 1024, 224, MAP_SWI, DFFE, (bf16_t*)(ws + W_MGU), (size_t)7168 * 1024, scr, gw, NGW, lane);
        cvt_family<true>(A.in[I_MOEDN], (size_t)3584 * 1024, 16, 1024, 3584, 32, MAP_ID, 0, (bf16_t*)(ws + W_MDN), (size_t)1024 * 3584, scr, gw, NGW, lane);
    }
}

template <bool ROUTER>
__device__ __forceinline__ void norm_phase(const Args& A, LAS unsigned char* lds, int bid, int G, const void* xsrc, bool src16, void* xdst, bool dst16, const float* gain, const float* modl  , int which,
                                           bool combine, const float* modprev  , bool nonorm, const float* router, bool f8out = false) {
    int tid_ = threadIdx.x; asm volatile("" : "+v"(tid_));
    const int tid = tid_, lane = tid & 63, wave = tid >> 6;
    unsigned char* ws = A.ws;
    bf16_t* HM = (bf16_t*)(ws + WS_HM);
    const int* slot = (const int*)(ws + TB_SLOT); const float* gts = (const float*)(ws + TB_GATE);
    const bf16_t* Y = (const bf16_t*)(ws + E_XS);
    LAS int* hist = (LAS int*)lds;
    for (int tb = bid; tb < MTOK / 256; tb += G) {
        const int b = tb >> 5;
        f32x4 ga[4], sh[4], g2[4];
#pragma unroll
        for (int j = 0; j < 4; ++j) { const int c = 256 * j + 4 * lane;
            if (!nonorm) { const f32x4 gv = *(const f32x4*)(gain + c), sv = *(const f32x4*)(modl + (size_t)b * 6144 + (which * 3 + 1) * 1024 + c);
                ga[j] = gv * (sv + 1.0f); sh[j] = *(const f32x4*)(modl + (size_t)b * 6144 + (which * 3) * 1024 + c); }
            if (combine) g2[j] = *(const f32x4*)(modprev + (size_t)b * 6144 + 5 * 1024 + c); }
        f32x4 rw[ROUTER ? 32 : 1];
        if constexpr (ROUTER) {
            if (tid < 8) hist[tid] = 0;
#pragma unroll
            for (int j = 0; j < 4; ++j)
#pragma unroll
                for (int i = 0; i < 4; ++i) { const int c = 256 * j + 4 * lane + i; rw[(j * 4 + i) * 2] = *(const f32x4*)(router + c * 8); rw[(j * 4 + i) * 2 + 1] = *(const f32x4*)(router + c * 8 + 4); }
            __syncthreads();
        }
        for (int i = 0; i < 32; ++i) {
            const int row = tb * 256 + wave * 32 + i;
            f32x4 v[4];
#pragma unroll
            for (int j = 0; j < 4; ++j) v[j] = pg8::ld_x4(xsrc, (size_t)row * DM + 256 * j + 4 * lane, src16);
            if (combine) {
                const int s0 = slot[row * 2], s1 = slot[row * 2 + 1]; const float w0 = gts[row * 2], w1 = gts[row * 2 + 1];
#pragma unroll
                for (int j = 0; j < 4; ++j) { const u32x2 a = *(const u32x2*)(Y + (size_t)s0 * DM + 256 * j + 4 * lane), c2 = *(const u32x2*)(Y + (size_t)s1 * DM + 256 * j + 4 * lane);
                    f32x4 y; y[0] = w0 * bflo(a.x) + w1 * bflo(c2.x); y[1] = w0 * bfhi(a.x) + w1 * bfhi(c2.x); y[2] = w0 * bflo(a.y) + w1 * bflo(c2.y); y[3] = w0 * bfhi(a.y) + w1 * bfhi(c2.y);
                    v[j] = v[j] + g2[j] * y;
                    if (dst16) *(u32x2*)((bf16_t*)xdst + (size_t)row * DM + 256 * j + 4 * lane) = (u32x2){cvt_pk_bf16(v[j][0], v[j][1]), cvt_pk_bf16(v[j][2], v[j][3])};
                    else *(f32x4*)((float*)xdst + (size_t)row * DM + 256 * j + 4 * lane) = v[j]; }
            }
            if (nonorm) continue;
            float ss = 0.f;
#pragma unroll
            for (int j = 0; j < 4; ++j) ss += (v[j][0] * v[j][0] + v[j][1] * v[j][1]) + (v[j][2] * v[j][2] + v[j][3] * v[j][3]);
            ss = wave_sum(ss);
            const float rstd = 1.0f / sqrtf(ss * (1.0f / DM) + EPS);
            f32x4 h[4];
#pragma unroll
            for (int j = 0; j < 4; ++j) { h[j] = v[j] * rstd * ga[j] + sh[j];
                if (f8out) { *(unsigned*)((unsigned char*)HM + (size_t)row * DM + 256 * j + 4 * lane) = pk_fp8x4(h[j][0], h[j][1], h[j][2], h[j][3]); }
                else { u32x2 w; w.x = cvt_pk_bf16(h[j][0], h[j][1]); w.y = cvt_pk_bf16(h[j][2], h[j][3]);
                    *(u32x2*)(HM + (size_t)row * DM + 256 * j + 4 * lane) = w; } }
            if constexpr (ROUTER) {
                float lg[8];
#pragma unroll
                for (int e = 0; e < 8; ++e) lg[e] = 0.f;
#pragma unroll
                for (int j = 0; j < 4; ++j)
#pragma unroll
                    for (int q = 0; q < 4; ++q) { const float hv = h[j][q]; const f32x4 r0 = rw[(j * 4 + q) * 2], r1 = rw[(j * 4 + q) * 2 + 1];
                        lg[0] += hv * r0[0]; lg[1] += hv * r0[1]; lg[2] += hv * r0[2]; lg[3] += hv * r0[3]; lg[4] += hv * r1[0]; lg[5] += hv * r1[1]; lg[6] += hv * r1[2]; lg[7] += hv * r1[3]; }
#pragma unroll
                for (int e = 0; e < 8; ++e) lg[e] = wave_sum(lg[e]);
                int e0 = 0; float v0 = lg[0];
#pragma unroll
                for (int e = 1; e < 8; ++e) if (lg[e] > v0) { v0 = lg[e]; e0 = e; }
                int e1 = -1; float v1 = -3.0e38f;
#pragma unroll
                for (int e = 0; e < 8; ++e) if (e != e0 && lg[e] > v1) { v1 = lg[e]; e1 = e; }
                const float p1 = frcp(1.0f + fexp(v1 - v0));
                if (lane == 0) { int* eid = (int*)(ws + TB_EID); float* gt = (float*)(ws + TB_GATE);
                    eid[row * 2] = e0; eid[row * 2 + 1] = e1; gt[row * 2] = p1; gt[row * 2 + 1] = 1.0f - p1;
                    atomicAdd((int*)&hist[e0], 1); atomicAdd((int*)&hist[e1], 1); }
            }
        }
        if constexpr (ROUTER) {
            __syncthreads();
            if (tid < 8) ((int*)(ws + TB_BCNT))[tb * 8 + tid] = hist[tid];
            __syncthreads();
        }
    }
}

namespace lru {
constexpr int XCF = 0, XCB = 16384, AA = 24576, UU = 40960, LAA = 57344;
__device__ __forceinline__ int sw256(int row, int cb) { return row * 256 + (cb ^ ((row & 15) << 4)); }
__device__ __forceinline__ int crow(int r, int hi) { return (r & 3) + 8 * (r >> 2) + 4 * hi; }
template <int MODE>
__device__ __forceinline__ void lru_item(const Args& A, LAS unsigned char* lds, int b, int n, int seg, int dir) {
    int tid_ = threadIdx.x; asm volatile("" : "+v"(tid_));
    const int tid = tid_, wid = tid >> 6, lane = tid & 63, r = lane & 31, hh = lane >> 5;
    unsigned char* ws = A.ws;
    const bf16_t* XB = (const bf16_t*)(ws + L_XB); const bf16_t* YB = (const bf16_t*)(ws + L_YB); bf16_t* HF = (bf16_t*)(ws + L_HF); bf16_t* HY = (bf16_t*)(ws + L_HY);
    bf16_t* LAg = (bf16_t*)(ws + (dir ? L_HY : L_HF)); bf16_t* Ug = (bf16_t*)(ws + L_U + (size_t)dir * SZ_LRU);
    const int ct = tid >> 4, cg = tid & 15, cc0 = n * 128 + 8 * cg;
    float carry = 0.f, P = 1.f;
    if (MODE != 0 && tid < 128) carry = ((const float*)(ws + TB_LCIN))[(size_t)((b * 32 + seg) * 2 + dir) * LRUW + n * 128 + tid];
    if constexpr (MODE == 0) {
        const bf16_t* Wg = (const bf16_t*)(ws + W_LRG) + (size_t)((n * 2 + dir) * 256 + ((r < 16) ? (16 * wid + r) : (128 + 16 * wid + r - 16))) * 128 + 8 * hh;
        bf16x8 bfrag[8];
#pragma unroll
        for (int ks = 0; ks < 8; ++ks) bfrag[ks] = *(const bf16x8*)(Wg + 16 * ks);
        const int cch = n * 128 + 16 * wid + (r & 15);
        const float nba = -LOG2E * A.in[I_LRBA][dir * LRUW + cch], nbx = -LOG2E * A.in[I_LRBX][dir * LRUW + cch], csp = -8.0f * LOG2E * ((const float*)(ws + TB_SP))[dir * LRUW + cch];
        float cw[4][8], cb[8];
#pragma unroll
        for (int j = 0; j < 8; ++j) { cb[j] = A.in[I_LRCB][cc0 + j];
#pragma unroll
            for (int w = 0; w < 4; ++w) cw[w][j] = A.in[I_LRCW][w * LRUW + cc0 + j]; }
        u32x4 xr[4];
#define LRU_XLOAD(si_) do { const int sub_ = dir ? (7 - (si_)) : (si_); const int tok_ = seg * 256 + sub_ * 32 + ct; \
        _Pragma("unroll") for (int w = 0; w < 4; ++w) { const int tt = tok_ - 1 + w; xr[w] = (tt >= 0 && tt < SEQ) ? *(const u32x4*)(XB + ((size_t)b * SEQ + tt) * LRUW + cc0) : (u32x4){0u, 0u, 0u, 0u}; } } while (0)
        LRU_XLOAD(0);
        for (int si = 0; si < 8; ++si) {
            const int sub = dir ? (7 - si) : si; const int t0 = seg * 256 + sub * 32;
            {
                float xc[8];
#pragma unroll
                for (int j = 0; j < 8; ++j) xc[j] = cb[j];
#pragma unroll
                for (int w = 0; w < 4; ++w) { const u32x4 v = xr[w];
#pragma unroll
                    for (int e = 0; e < 4; ++e) { xc[2 * e] += cw[w][2 * e] * bflo(v[e]); xc[2 * e + 1] += cw[w][2 * e + 1] * bfhi(v[e]); } }
                if (si + 1 < 8) LRU_XLOAD(si + 1);
                *(LAS f32x4*)(lds + XCF + (ct * 128 + 8 * cg) * 4) = (f32x4){xc[0], xc[1], xc[2], xc[3]};
                *(LAS f32x4*)(lds + XCF + (ct * 128 + 8 * cg + 4) * 4) = (f32x4){xc[4], xc[5], xc[6], xc[7]};
                *(LAS u32x4*)(lds + XCB + sw256(ct, 16 * cg)) = (u32x4){cvt_pk_bf16(xc[0], xc[1]), cvt_pk_bf16(xc[2], xc[3]), cvt_pk_bf16(xc[4], xc[5]), cvt_pk_bf16(xc[6], xc[7])};
            }
            __syncthreads();
            {
                f32x16 acc = {};
#pragma unroll
                for (int ks = 0; ks < 8; ++ks) { const bf16x8 fa = *(const LAS bf16x8*)(lds + XCB + sw256(r, (16 * ks + 8 * hh) * 2)); acc = __builtin_amdgcn_mfma_f32_32x32x16_bf16(fa, bfrag[ks], acc, 0, 0, 0); }
#pragma unroll
                for (int q = 0; q < 8; ++q) {
                    const auto sw = __builtin_amdgcn_permlane16_swap(__float_as_uint(acc[q]), __float_as_uint(acc[8 + q]), false, false);
                    const float rp = __uint_as_float(sw[0]), ip = __uint_as_float(sw[1]);
                    const int tq = crow((r < 16) ? q : (8 + q), hh); const int cl = 16 * wid + (r & 15);
                    const float xcv = ((const LAS float*)(lds + XCF))[tq * 128 + cl];
                    const float rg = frcp(1.0f + fexp2(fmaf(rp, -LOG2E, nba))), ig = frcp(1.0f + fexp2(fmaf(ip, -LOG2E, nbx)));
                    const float la = csp * rg, av = fexp2(la), uv = __builtin_amdgcn_sqrtf(fmaxf(fmaf(-av, av, 1.0f), 0.f)) * ig * xcv;
                    ((LAS float*)(lds + AA))[tq * 128 + cl] = av; ((LAS float*)(lds + UU))[tq * 128 + cl] = uv; ((LAS float*)(lds + LAA))[tq * 128 + cl] = la; }
            }
            __syncthreads();
            if (tid < 128) {
                LAS float* ap = (LAS float*)(lds + AA) + tid; LAS float* up = (LAS float*)(lds + UU) + tid; float av[32], uv[32];
#pragma unroll
                for (int i = 0; i < 32; ++i) { av[i] = ap[i * 128]; uv[i] = up[i * 128]; }
                if (dir == 0) {
#pragma unroll
                    for (int i = 0; i < 32; ++i) { carry = av[i] * carry + uv[i]; P *= av[i]; } }
                else {
#pragma unroll
                    for (int i = 31; i >= 0; --i) { carry = av[i] * carry + uv[i]; P *= av[i]; } }
            } else if (tid >= 256) {
                const int t2 = tid - 256, row = t2 >> 3, c16 = (t2 & 7) * 16; const size_t go = ((size_t)b * SEQ + t0 + row) * LRUW + n * 128 + c16;
                const LAS float* lp = (const LAS float*)(lds + LAA) + row * 128 + c16; const LAS float* up = (const LAS float*)(lds + UU) + row * 128 + c16;
                f32x4 l[4], u[4];
#pragma unroll
                for (int j = 0; j < 4; ++j) { l[j] = *(const LAS f32x4*)(lp + 4 * j); u[j] = *(const LAS f32x4*)(up + 4 * j); }
#pragma unroll
                for (int j = 0; j < 2; ++j) {
                    *(u32x4*)(LAg + go + 8 * j) = (u32x4){cvt_pk_bf16(l[2 * j][0], l[2 * j][1]), cvt_pk_bf16(l[2 * j][2], l[2 * j][3]), cvt_pk_bf16(l[2 * j + 1][0], l[2 * j + 1][1]), cvt_pk_bf16(l[2 * j + 1][2], l[2 * j + 1][3])};
                    *(u32x4*)(Ug + go + 8 * j) = (u32x4){cvt_pk_bf16(u[2 * j][0], u[2 * j][1]), cvt_pk_bf16(u[2 * j][2], u[2 * j][3]), cvt_pk_bf16(u[2 * j + 1][0], u[2 * j + 1][1]), cvt_pk_bf16(u[2 * j + 1][2], u[2 * j + 1][3])}; }
            }
            __syncthreads();
        }
#undef LRU_XLOAD
        if (tid < 128) { float* sm = (float*)(ws + TB_LSUM) + (size_t)(((b * 32 + seg) * 2 + dir) * 2) * LRUW + n * 128 + tid; sm[0] = P; sm[LRUW] = carry; }
    } else {
        u32x4 lr, ur;
#define LRU_GLOAD(si_) do { const int sub_ = dir ? (7 - (si_)) : (si_); const size_t go_ = ((size_t)b * SEQ + seg * 256 + sub_ * 32 + ct) * LRUW + cc0; \
        lr = *(const u32x4*)(LAg + go_); ur = *(const u32x4*)(Ug + go_); } while (0)
        LRU_GLOAD(0);
        for (int si = 0; si < 8; ++si) {
            const int sub = dir ? (7 - si) : si; const int t0 = seg * 256 + sub * 32;
            {   const u32x4 l = lr, u = ur;
                if (si + 1 < 8) LRU_GLOAD(si + 1);
                *(LAS f32x4*)(lds + AA + (ct * 128 + 8 * cg) * 4) = (f32x4){fexp2(bflo(l[0])), fexp2(bfhi(l[0])), fexp2(bflo(l[1])), fexp2(bfhi(l[1]))};
                *(LAS f32x4*)(lds + AA + (ct * 128 + 8 * cg + 4) * 4) = (f32x4){fexp2(bflo(l[2])), fexp2(bfhi(l[2])), fexp2(bflo(l[3])), fexp2(bfhi(l[3]))};
                *(LAS f32x4*)(lds + UU + (ct * 128 + 8 * cg) * 4) = (f32x4){bflo(u[0]), bfhi(u[0]), bflo(u[1]), bfhi(u[1])};
                *(LAS f32x4*)(lds + UU + (ct * 128 + 8 * cg + 4) * 4) = (f32x4){bflo(u[2]), bfhi(u[2]), bflo(u[3]), bfhi(u[3])}; }
            __syncthreads();
            if (tid < 128) {
                LAS float* ap = (LAS float*)(lds + AA) + tid; LAS float* up = (LAS float*)(lds + UU) + tid; float av[32], uv[32];
#pragma unroll
                for (int i = 0; i < 32; ++i) { av[i] = ap[i * 128]; uv[i] = up[i * 128]; }
                if (dir == 0) {
#pragma unroll
                    for (int i = 0; i < 32; ++i) { carry = av[i] * carry + uv[i]; uv[i] = carry; } }
                else {
#pragma unroll
                    for (int i = 31; i >= 0; --i) { carry = av[i] * carry + uv[i]; uv[i] = carry; } }
#pragma unroll
                for (int i = 0; i < 32; ++i) up[i * 128] = uv[i];
            }
            __syncthreads();
            {   const int tok = t0 + ct; const size_t go = ((size_t)b * SEQ + tok) * LRUW + cc0;
                const f32x4 h0 = *(const LAS f32x4*)(lds + UU + (ct * 128 + 8 * cg) * 4), h1 = *(const LAS f32x4*)(lds + UU + (ct * 128 + 8 * cg + 4) * 4);
                if (MODE == 1) { *(u32x4*)(HF + go) = (u32x4){cvt_pk_bf16(h0[0], h0[1]), cvt_pk_bf16(h0[2], h0[3]), cvt_pk_bf16(h1[0], h1[1]), cvt_pk_bf16(h1[2], h1[3])}; }
                else { const u32x4 f = *(const u32x4*)(HF + go), y = *(const u32x4*)(YB + go);
                    *(u32x4*)(HY + go) = (u32x4){cvt_pk_bf16((h0[0] + bflo(f[0])) * bflo(y[0]), (h0[1] + bfhi(f[0])) * bfhi(y[0])), cvt_pk_bf16((h0[2] + bflo(f[1])) * bflo(y[1]), (h0[3] + bfhi(f[1])) * bfhi(y[1])),
                                                cvt_pk_bf16((h1[0] + bflo(f[2])) * bflo(y[2]), (h1[1] + bfhi(f[2])) * bfhi(y[2])), cvt_pk_bf16((h1[2] + bflo(f[3])) * bflo(y[3]), (h1[3] + bfhi(f[3])) * bfhi(y[3]))}; }
            }
            __syncthreads();
        }
#undef LRU_GLOAD
    }
}
}
template <int MODE>
__device__ __forceinline__ void lru_phase(const Args& A, LAS unsigned char* lds, int bid, int G) {
    const int nitems = (MODE == 0) ? 5120 : 2560;
    for (int it = bid; it < nitems; it += G) {
        int b, n, seg, dir;
        if (MODE == 0) { dir = it & 1; const int r = it >> 1; seg = r & 31; n = (r >> 5) % 10; b = r / 320; }
        else { dir = MODE - 1; seg = it & 31; n = (it >> 5) % 10; b = it / 320; }
        lru::lru_item<MODE>(A, lds, b, n, seg, dir);
    }
}
__device__ __forceinline__ void lru_carry_phase(const Args& A, int bid, int G) {
    const float* sm = (const float*)(A.ws + TB_LSUM); float* cin = (float*)(A.ws + TB_LCIN);
    for (int idx = bid * NTHR + threadIdx.x; idx < NBATCH * 2 * LRUW; idx += G * NTHR) {
        const int b = idx / (2 * LRUW), r = idx % (2 * LRUW), dir = r / LRUW, ch = r % LRUW; float carry = 0.f;
        for (int i = 0; i < 32; ++i) { const int sg = dir ? (31 - i) : i; const size_t o = (size_t)((b * 32 + sg) * 2 + dir);
            cin[o * LRUW + ch] = carry; carry = sm[o * 2 * LRUW + ch] * carry + sm[o * 2 * LRUW + LRUW + ch]; }
    }
}

__device__ __forceinline__ void place_phase(const Args& A, LAS unsigned char* lds, int bid, int G) {
    int tid_ = threadIdx.x; asm volatile("" : "+v"(tid_));
    const int tid = tid_, lane = tid & 63, wave = tid >> 6; unsigned char* ws = A.ws;
    const int* bcnt = (const int*)(ws + TB_BCNT); const int* eid = (const int*)(ws + TB_EID); int* slot = (int*)(ws + TB_SLOT);
    const bf16_t* HM = (const bf16_t*)(ws + WS_HM); bf16_t* XS = (bf16_t*)(ws + E_XS);
    LAS int* tot = (LAS int*)lds; LAS int* pre = tot + 8; LAS int* rb = tot + 16; LAS int* wcn = tot + 32; LAS int* sl = tot + 64;
    for (int tb = bid; tb < MTOK / 256; tb += G) {
        { int t_ = 0, p_ = 0;
#pragma unroll
            for (int j = 0; j < 4; ++j) { const int blk = lane + 64 * j; const int v = bcnt[blk * 8 + wave]; t_ += v; p_ += (blk < tb) ? v : 0; }
#pragma unroll
            for (int o = 1; o < 64; o <<= 1) { t_ += __shfl_xor(t_, o); p_ += __shfl_xor(p_, o); }
            if (lane == 0) { tot[wave] = t_; pre[wave] = p_; } }
        __syncthreads();
        if (tid == 0) { int acc = 0; for (int e = 0; e < 8; ++e) { rb[e] = acc * 256; if (tb == 0) ((int*)(ws + TB_TILES))[e] = acc; acc += (tot[e] + 255) >> 8; } if (tb == 0) ((int*)(ws + TB_TILES))[8] = acc; }
        int e0 = -1, e1 = -1; unsigned long long mk0 = 0, mk1 = 0;
        if (tid < 256) { e0 = eid[(tb * 256 + tid) * 2]; e1 = eid[(tb * 256 + tid) * 2 + 1];
#pragma unroll
            for (int e = 0; e < 8; ++e) { const unsigned long long m = __ballot(e0 == e || e1 == e); if (lane == 0) wcn[wave * 8 + e] = __popcll(m); if (e0 == e) mk0 = m; if (e1 == e) mk1 = m; } }
        __syncthreads();
        if (tid < 256) { const unsigned long long lt = (1ull << lane) - 1ull; int b0 = rb[e0] + pre[e0] + __popcll(mk0 & lt), b1 = rb[e1] + pre[e1] + __popcll(mk1 & lt);
            for (int w = 0; w < wave; ++w) { b0 += wcn[w * 8 + e0]; b1 += wcn[w * 8 + e1]; }
            sl[tid * 2] = b0; sl[tid * 2 + 1] = b1; slot[(tb * 256 + tid) * 2] = b0; slot[(tb * 256 + tid) * 2 + 1] = b1; }
        __syncthreads();
        for (int i = 0; i < 32; ++i) { const int t = wave * 32 + i; const int s0 = sl[t * 2], s1 = sl[t * 2 + 1];
            const bf16_t* src = HM + (size_t)(tb * 256 + t) * DM + lane * 16;
            const u32x4 a = *(const u32x4*)src, b = *(const u32x4*)(src + 8);
            const u32x4 q = {pk_fp8x4(bflo(a[0]), bfhi(a[0]), bflo(a[1]), bfhi(a[1])), pk_fp8x4(bflo(a[2]), bfhi(a[2]), bflo(a[3]), bfhi(a[3])),
                             pk_fp8x4(bflo(b[0]), bfhi(b[0]), bflo(b[1]), bfhi(b[1])), pk_fp8x4(bflo(b[2]), bfhi(b[2]), bflo(b[3]), bfhi(b[3]))};
            *(u32x4*)((unsigned char*)XS + (size_t)s0 * DM + lane * 16) = q; *(u32x4*)((unsigned char*)XS + (size_t)s1 * DM + lane * 16) = q; }
        __syncthreads();
    }
}

namespace att {
constexpr int KVBLK = 64;
#define SBAR() __builtin_amdgcn_sched_barrier(0)
typedef int v8i __attribute__((ext_vector_type(8)));
__device__ __forceinline__ int crow(int r, int hi) { return (r & 3) + 8 * (r >> 2) + 4 * hi; }
constexpr int SLOTB = 8192;
__device__ __forceinline__ int k_slot(int s) { return s * SLOTB; }
__device__ __forceinline__ int v_slot(int s) { return 65536 + s * SLOTB; }
__device__ __forceinline__ int kswz(int row) { return ((row & 7) ^ (row >> 4)) & 7; }
__device__ __forceinline__ int vswz(int row) { return (row >> 2) & 3; }
__device__ __forceinline__ void mfma8_acc(f32x16& acc, const v8i& a, const v8i& b, int sc) {
    asm volatile("s_nop 4\n\tv_mfma_scale_f32_32x32x64_f8f6f4 %0, %1, %2, %0, %3, %3 op_sel_hi:[0,0,0]" : "+v"(acc) : "v"(a), "v"(b), "v"(sc) : "memory");
}
__device__ __forceinline__ void mfma8_c(f32x16& d, const v8i& a, const v8i& b, const f32x16& c, int sa, int sb) {
    asm volatile("v_mfma_scale_f32_32x32x64_f8f6f4 %0, %1, %2, %3, %4, %5 op_sel_hi:[0,0,0]" : "=&v"(d) : "v"(a), "v"(b), "v"(c), "v"(sa), "v"(sb) : "memory");
}
#define ATT_LD8(p0_, p1_) __builtin_bit_cast(v8i, __builtin_shufflevector(*(const LAS u32x4*)(p0_), *(const LAS u32x4*)(p1_), 0, 1, 2, 3, 4, 5, 6, 7))
__device__ __forceinline__ void qkt(f32x16& p0, f32x16& p1, const LAS char* Ks, const v8i& qr, int r32, int hi, int jj, const f32x16& cinit, int s1, int s8) {
    const int c0 = jj * 4 + 2 * hi;
    { const int row = r32; const v8i kf = ATT_LD8(Ks + row * 128 + ((c0 ^ kswz(row)) << 4), Ks + row * 128 + (((c0 + 1) ^ kswz(row)) << 4)); mfma8_c(p0, kf, qr, cinit, s1, s8); }
    { const int row = 32 + r32; const v8i kf = ATT_LD8(Ks + row * 128 + ((c0 ^ kswz(row)) << 4), Ks + row * 128 + (((c0 + 1) ^ kswz(row)) << 4)); mfma8_c(p1, kf, qr, cinit, s1, s8); }
}
__device__ __forceinline__ void load_kf(v8i& kf0, v8i& kf1, const LAS char* Ks, int r32, int hi, int jj) {
    const int c0 = jj * 4 + 2 * hi, row1 = 32 + r32;
    kf0 = ATT_LD8(Ks + r32 * 128 + ((c0 ^ kswz(r32)) << 4), Ks + r32 * 128 + (((c0 + 1) ^ kswz(r32)) << 4));
    kf1 = ATT_LD8(Ks + row1 * 128 + ((c0 ^ kswz(row1)) << 4), Ks + row1 * 128 + (((c0 + 1) ^ kswz(row1)) << 4));
}
#define ATT_VFR(Vs, d0) ATT_LD8((Vs) + (32 * (d0) + r32) * 64 + (((2 * hi) ^ vswz(32 * (d0) + r32)) << 4), (Vs) + (32 * (d0) + r32) * 64 + (((2 * hi + 1) ^ vswz(32 * (d0) + r32)) << 4))
__device__ __forceinline__ void pack_p(const float (&pe)[32], v8i& pa);
__device__ __forceinline__ void qkt_pack(f32x16& p0, f32x16& p1, const v8i& kf0, const v8i& kf1, const v8i& qr, const f32x16& cinit, int s1, int s8, const float (&pe)[32], v8i& pa) {
#define ATT_MC8(d, kf, B, O0, O1, O2, O3) \
    asm volatile("v_mfma_scale_f32_32x32x64_f8f6f4 %0, %21, %22, %23, %24, %25 op_sel_hi:[0,0,0]\n\t" \
                 "v_cvt_pk_fp8_f32 %1, %5, %6\n\tv_cvt_pk_fp8_f32 %1, %7, %8 op_sel:[0,0,1]\n\t" \
                 "v_cvt_pk_fp8_f32 %2, %9, %10\n\tv_cvt_pk_fp8_f32 %2, %11, %12 op_sel:[0,0,1]\n\t" \
                 "v_cvt_pk_fp8_f32 %3, %13, %14\n\tv_cvt_pk_fp8_f32 %3, %15, %16 op_sel:[0,0,1]\n\t" \
                 "v_cvt_pk_fp8_f32 %4, %17, %18\n\tv_cvt_pk_fp8_f32 %4, %19, %20 op_sel:[0,0,1]" \
                 : "=&v"(d), "=&v"(O0), "=&v"(O1), "=&v"(O2), "=&v"(O3) \
                 : "v"(pe[B]), "v"(pe[B + 1]), "v"(pe[B + 2]), "v"(pe[B + 3]), "v"(pe[B + 4]), "v"(pe[B + 5]), "v"(pe[B + 6]), "v"(pe[B + 7]), \
                   "v"(pe[B + 8]), "v"(pe[B + 9]), "v"(pe[B + 10]), "v"(pe[B + 11]), "v"(pe[B + 12]), "v"(pe[B + 13]), "v"(pe[B + 14]), "v"(pe[B + 15]), \
                   "v"(kf), "v"(qr), "v"(cinit), "v"(s1), "v"(s8) : "memory")
    int q0, q1, q2, q3, q4, q5, q6, q7;
    ATT_MC8(p0, kf0, 0, q0, q1, q2, q3);
    ATT_MC8(p1, kf1, 16, q4, q5, q6, q7);
#undef ATT_MC8
    pa = (v8i){q0, q1, q2, q3, q4, q5, q6, q7};
}
__device__ __forceinline__ void partialSM(f32x16& p0) {
#pragma unroll
    for (int r = 0; r < 16; ++r) p0[r] = fexp2(p0[r]);
}
__device__ __forceinline__ void finishSM(f32x16& p0, f32x16& p1, v8i& pa) {
#pragma unroll
    for (int r = 0; r < 16; ++r) p1[r] = fexp2(p1[r]);
#pragma unroll
    for (int w = 0; w < 4; ++w) { pa[w] = (int)pk_fp8x4(p0[4 * w], p0[4 * w + 1], p0[4 * w + 2], p0[4 * w + 3]); pa[4 + w] = (int)pk_fp8x4(p1[4 * w], p1[4 * w + 1], p1[4 * w + 2], p1[4 * w + 3]); }
}
#define ATT_MX7(acc, a, b, sc, NOP, O, I, k) \
    asm volatile(NOP "v_mfma_scale_f32_32x32x64_f8f6f4 %0, %15, %16, %0, %17, %17 op_sel_hi:[0,0,0]\n\tv_exp_f32 %1, %8\n\tv_exp_f32 %2, %9\n\tv_exp_f32 %3, %10\n\tv_exp_f32 %4, %11\n\tv_exp_f32 %5, %12\n\tv_exp_f32 %6, %13\n\tv_exp_f32 %7, %14" \
                 : "+v"(acc), "=&v"(O[k]), "=&v"(O[k + 1]), "=&v"(O[k + 2]), "=&v"(O[k + 3]), "=&v"(O[k + 4]), "=&v"(O[k + 5]), "=&v"(O[k + 6]) \
                 : "v"(I(k)), "v"(I(k + 1)), "v"(I(k + 2)), "v"(I(k + 3)), "v"(I(k + 4)), "v"(I(k + 5)), "v"(I(k + 6)), "v"(a), "v"(b), "v"(sc) : "memory")
__device__ __forceinline__ void pv_exp(f32x16* o, f32x16& lacc, const v8i& ones, const v8i& vf0, const v8i& vf1, const v8i& vf2, const v8i& vf3, const v8i& pa, int s1, const f32x16& r0, const f32x16& r1, float (&pe)[32]) {
#define ATT_RI(k) (((k) < 16) ? r0[(k) & 15] : r1[(k) & 15])
    ATT_MX7(o[0], pa, vf0, s1, "s_nop 4\n\t", pe, ATT_RI, 0);
    ATT_MX7(o[1], pa, vf1, s1, "", pe, ATT_RI, 7);
    ATT_MX7(o[2], pa, vf2, s1, "", pe, ATT_RI, 14);
    ATT_MX7(o[3], pa, vf3, s1, "", pe, ATT_RI, 21);
    asm volatile("v_mfma_scale_f32_32x32x64_f8f6f4 %0, %9, %10, %0, %11, %11 op_sel_hi:[0,0,0]\n\tv_exp_f32 %1, %5\n\tv_exp_f32 %2, %6\n\tv_exp_f32 %3, %7\n\tv_exp_f32 %4, %8"
                 : "+v"(lacc), "=&v"(pe[28]), "=&v"(pe[29]), "=&v"(pe[30]), "=&v"(pe[31]) : "v"(r1[12]), "v"(r1[13]), "v"(r1[14]), "v"(r1[15]), "v"(pa), "v"(ones), "v"(s1) : "memory");
#undef ATT_RI
}
__device__ __forceinline__ void pack_p(const float (&pe)[32], v8i& pa) {
#pragma unroll
    for (int w = 0; w < 8; ++w) pa[w] = (int)pk_fp8x4(pe[4 * w], pe[4 * w + 1], pe[4 * w + 2], pe[4 * w + 3]);
}
__device__ __forceinline__ void pv_d0(f32x16* o, f32x16& lacc, const v8i& ones, const LAS char* Vs, const v8i& pa, int r32, int hi, int s1) {
#pragma unroll
    for (int d0 = 0; d0 < 4; ++d0) { const int row = 32 * d0 + r32;
        const v8i vf = ATT_LD8(Vs + row * 64 + (((2 * hi) ^ vswz(row)) << 4), Vs + row * 64 + (((2 * hi + 1) ^ vswz(row)) << 4));
        mfma8_acc(o[d0], pa, vf, s1); }
    mfma8_acc(lacc, pa, ones, s1);
}
__device__ __forceinline__ void pv_last(f32x16* o, f32x16& lacc, const v8i& ones, const v8i& vf0, const v8i& vf1, const v8i& vf2, const v8i& vf3, const v8i& pa, int s1) {
    mfma8_acc(o[0], pa, vf0, s1); mfma8_acc(o[1], pa, vf1, s1); mfma8_acc(o[2], pa, vf2, s1); mfma8_acc(o[3], pa, vf3, s1); mfma8_acc(lacc, pa, ones, s1);
}
}

__device__ __forceinline__ void vt_phase(const Args& A, int bid, int G) {
    const int tid = threadIdx.x; unsigned char* ws = A.ws;
    const bf16_t* V = (const bf16_t*)(ws + A_V); unsigned char* VT = ws + A_VT;
    const int dv = tid & 127, kq = tid >> 7, half = kq >> 1, hi = kq & 1;
    for (int it = bid; it < 64 * 128; it += G) {
        const int bh = it >> 7, tile = it & 127, b = bh >> 3, h = bh & 7;
        const bf16_t* vp = V + ((size_t)b * SEQ + tile * 64 + 32 * half) * DM + h * 128 + dv;
        float f[16];
#pragma unroll
        for (int i = 0; i < 16; ++i) f[i] = bf2f(vp[(size_t)att::crow(i, hi) * DM]);
        *(u32x4*)(VT + (((size_t)bh * 128 + tile) * 128 + dv) * 64 + hi * 32 + half * 16) =
            (u32x4){pk_fp8x4(f[0], f[1], f[2], f[3]), pk_fp8x4(f[4], f[5], f[6], f[7]), pk_fp8x4(f[8], f[9], f[10], f[11]), pk_fp8x4(f[12], f[13], f[14], f[15])};
    }
}

__device__ __forceinline__ void attn_phase(const Args& A, LAS unsigned char* ldsu, int bid, int G, int al) {
    using namespace att;
    LAS char* lds = (LAS char*)ldsu;
    unsigned char* ws = A.ws;
    const unsigned char* Qg = ws + A_Q; const unsigned char* Kg = ws + A_K; const unsigned char* VTg = ws + A_VT;
    bf16_t* Og = (bf16_t*)(ws + WS_HM);
    const float* scal = (const float*)(ws + TB_SCAL);
    const float lamv = scal[SC_LAM0 + al], omli = scal[SC_OML0 + al], Mc = scal[SC_MC0 + al] - 7.5f;
    const float* subg = A.in[I_ATSUB] + al * 128;
    int tid_ = threadIdx.x; asm volatile("" : "+v"(tid_));
    const int tid = tid_, wid = __builtin_amdgcn_readfirstlane(tid >> 6), lane = tid & 63, r32 = lane & 31, hi = lane >> 5, jj = wid >> 2, wq = wid & 3;
    constexpr int NT = SEQ / KVBLK;
    int s1 = 0x7f7f7f7f, s8 = 0x7c7c7c7c; asm volatile("" : "+v"(s1), "+v"(s8));
    v8i ones; { int o1 = 0x38383838; asm volatile("" : "+v"(o1)); ones = (v8i){o1, o1, o1, o1, o1, o1, o1, o1}; }
    f32x16 cinit;
#pragma unroll
    for (int r = 0; r < 16; ++r) cinit[r] = -Mc;
    unsigned koff, voff;
    { const int bb = wid * 1024 + lane * 16;
      { const int row = bb >> 7, c = ((bb & 127) >> 4) ^ kswz(row); koff = (unsigned)(row * 1024 + c * 16); }
      { const int row = bb >> 6, c = ((bb & 63) >> 4) ^ vswz(row); voff = (unsigned)(row * 64 + c * 16); } }
    const unsigned ldsw = (unsigned)wid * 1024u;
#define ATT_DMA(slot, kt, vt) do { \
        __builtin_amdgcn_global_load_lds((const unsigned*)((const unsigned char*)(kt) + koff), (LAS unsigned*)(lds + k_slot(slot) + ldsw), 16, 0, 0); \
        __builtin_amdgcn_global_load_lds((const unsigned*)((const unsigned char*)(vt) + voff), (LAS unsigned*)(lds + v_slot(slot) + ldsw), 16, 0, 0); } while (0)
#define ATT_TOP() do { asm volatile("s_waitcnt vmcnt(4)" ::: "memory"); __builtin_amdgcn_s_barrier(); asm volatile("" ::: "memory"); } while (0)
    const int xq = bid & 7, cq = bid >> 3;
    int cbh = xq * 8;
    const bool lag = (jj != 0);
#define ATT_KB(bh_) (Kg + ((size_t)((bh_) >> 3) * SEQ) * DM + ((bh_) & 7) * 128)
#define ATT_VB(bh_) (VTg + (size_t)(bh_) * 128 * 8192)
    ATT_DMA(0, ATT_KB(cbh), ATT_VB(cbh)); ATT_DMA(1, ATT_KB(cbh) + (size_t)64 * DM, ATT_VB(cbh) + 8192); ATT_DMA(2, ATT_KB(cbh) + (size_t)128 * DM, ATT_VB(cbh) + 16384);
    int ofKa, ofKb, ofV, ofKax, ofKbx, ofVx;
    { const int c0 = jj * 4 + 2 * hi, lb = (int)(unsigned)(size_t)lds;
      ofKa = r32 * 128 + ((c0 ^ kswz(r32)) << 4); ofKb = (32 + r32) * 128 + ((c0 ^ kswz(32 + r32)) << 4); ofV = 65536 + r32 * 64 + (((2 * hi) ^ vswz(r32)) << 4);
      ofKax = lb + (ofKa ^ 16); ofKbx = lb + (ofKb ^ 16); ofVx = lb + (ofV ^ 16); ofKa += lb; ofKb += lb; ofV += lb; }
    for (int ui = 0; ui < 16; ++ui) {
        const int qb = (ui & 1) * 32 + cq;
        const int nbh = (ui + 1 < 16) ? xq * 8 + ((ui + 1) >> 1) : cbh;
        const unsigned char* Kh = ATT_KB(cbh); const unsigned char* Vh = ATT_VB(cbh); const unsigned char* nK = ATT_KB(nbh); const unsigned char* nV = ATT_VB(nbh);
        const size_t obase = ((size_t)(cbh >> 3) * SEQ + qb * 128) * DM + (cbh & 7) * 128;
        f32x16 lacc = {}; f32x16 o[4] = {}; v8i qr;
        { const unsigned char* Qw = Qg + obase + (size_t)(wq * 32 + r32) * DM + jj * 64 + hi * 32;
          const u32x4 qa = *(const u32x4*)Qw, qb2 = *(const u32x4*)(Qw + 16);
          qr = __builtin_bit_cast(v8i, __builtin_shufflevector(qa, qb2, 0, 1, 2, 3, 4, 5, 6, 7)); }
        f32x16 pA0, pA1; v8i pa, kf0, kf1, vf0, vf1, vf2, vf3;
        const unsigned char* kptr = Kh + (size_t)3 * 64 * DM; const unsigned char* vptr = Vh + 3 * 8192;
#define ATT_ISSUE(SLD, last) do { asm volatile("" : "+s"(kptr), "+s"(vptr)); ATT_DMA(SLD, kptr, vptr); if (last) { kptr = nK; vptr = nV; } else { kptr += (size_t)64 * DM; vptr += 8192; } } while (0)
#define ATT_RD8(b_, bx_, imm_) ATT_LD8((const LAS char*)(unsigned)((b_) + (imm_)), (const LAS char*)(unsigned)((bx_) + (imm_)))
#define ATT_FIX() asm volatile("" : "+v"(ofKa), "+v"(ofKax), "+v"(ofKb), "+v"(ofKbx), "+v"(ofV), "+v"(ofVx))
#define ATT_STEPC(LAST, SL, SLP, SLD) do { \
            ATT_FIX(); \
            ATT_TOP(); \
            kf0 = ATT_RD8(ofKa, ofKax, (SL) * SLOTB); kf1 = ATT_RD8(ofKb, ofKbx, (SL) * SLOTB); vf0 = ATT_RD8(ofV, ofVx, (SLP) * SLOTB); vf1 = ATT_RD8(ofV, ofVx, (SLP) * SLOTB + 2048); \
            ATT_ISSUE(SLD, LAST); \
            ATT_TOP(); \
            qkt_pack(pA0, pA1, kf0, kf1, qr, cinit, s1, s8, pe, pa); \
            vf2 = ATT_RD8(ofV, ofVx, (SLP) * SLOTB + 4096); vf3 = ATT_RD8(ofV, ofVx, (SLP) * SLOTB + 6144); \
            pv_exp(o, lacc, ones, vf0, vf1, vf2, vf3, pa, s1, pA0, pA1, pe); } while (0)
        float pe[32];
        if (lag) ATT_TOP();
        ATT_TOP();
        ATT_FIX(); kf0 = ATT_RD8(ofKa, ofKax, 0); kf1 = ATT_RD8(ofKb, ofKbx, 0); ATT_ISSUE(3, false);
        ATT_TOP();
        { mfma8_c(pA0, kf0, qr, cinit, s1, s8); mfma8_c(pA1, kf1, qr, cinit, s1, s8);
          asm volatile("s_nop 15\n\ts_nop 15" ::: "memory");
#pragma unroll
          for (int r = 0; r < 16; ++r) pe[r] = fexp2(pA0[r]);
#pragma unroll
          for (int r = 0; r < 16; ++r) pe[16 + r] = fexp2(pA1[r]); }
        ATT_STEPC(false, 1, 0, 4); ATT_STEPC(false, 2, 1, 5); ATT_STEPC(false, 3, 2, 6); ATT_STEPC(false, 4, 3, 7); ATT_STEPC(false, 5, 4, 0); ATT_STEPC(false, 6, 5, 1); ATT_STEPC(false, 7, 6, 2);
        for (int kb = 8; kb < NT; kb += 8) {
            ATT_STEPC(false, 0, 7, 3); ATT_STEPC(false, 1, 0, 4); ATT_STEPC(false, 2, 1, 5); ATT_STEPC(false, 3, 2, 6);
            ATT_STEPC(kb == NT - 8, 4, 3, 7); ATT_STEPC(false, 5, 4, 0); ATT_STEPC(false, 6, 5, 1); ATT_STEPC(false, 7, 6, 2);
        }
        ATT_TOP();
        ATT_FIX();
        vf0 = ATT_RD8(ofV, ofVx, 7 * SLOTB); vf1 = ATT_RD8(ofV, ofVx, 7 * SLOTB + 2048);
        ATT_TOP();
        { vf2 = ATT_RD8(ofV, ofVx, 7 * SLOTB + 4096); vf3 = ATT_RD8(ofV, ofVx, 7 * SLOTB + 6144);
          pack_p(pe, pa); SBAR();
          pv_last(o, lacc, ones, vf0, vf1, vf2, vf3, pa, s1);
          asm volatile("s_nop 15\n\ts_nop 15" ::: "memory"); }
        if (!lag) ATT_TOP();
#undef ATT_ISSUE
#undef ATT_STEPC
#undef ATT_RD8
#undef ATT_FIX
        int r32e = r32, hie = hi; asm volatile("" : "+v"(r32e), "+v"(hie));
        float rli[16];
#pragma unroll
        for (int r = 0; r < 16; ++r) rli[r] = frcp(lacc[r]);
        asm volatile("s_waitcnt lgkmcnt(0)" ::: "memory"); __builtin_amdgcn_s_barrier(); asm volatile("" ::: "memory");
        LAS float* Cb = (LAS float*)(lds + ((wq < 2) ? 3 * SLOTB : 65536 + 3 * SLOTB - 64 * 512));
        if (jj == 1) {
#pragma unroll
            for (int r = 0; r < 16; ++r) { const float sc = rli[r] * lamv;
#pragma unroll
                for (int d0 = 0; d0 < 4; ++d0) Cb[(wq * 32 + crow(r, hie)) * 128 + d0 * 32 + r32e] = o[d0][r] * sc; }
        }
        asm volatile("s_waitcnt lgkmcnt(0)" ::: "memory"); __builtin_amdgcn_s_barrier(); asm volatile("" ::: "memory");
        if (jj == 0) {
            float g[4];
#pragma unroll
            for (int d0 = 0; d0 < 4; ++d0) g[d0] = subg[d0 * 32 + r32e] * omli;
            bf16_t* Ob = Og + obase;
#pragma unroll
            for (int r = 0; r < 16; ++r) {
                float ss = 0.f;
#pragma unroll
                for (int d0 = 0; d0 < 4; ++d0) { const float v = o[d0][r] * rli[r] - Cb[(wq * 32 + crow(r, hie)) * 128 + d0 * 32 + r32e]; o[d0][r] = v; ss += v * v; }
                ss += __shfl_xor(ss, 1); ss += __shfl_xor(ss, 2); ss += __shfl_xor(ss, 4); ss += __shfl_xor(ss, 8); ss += __shfl_xor(ss, 16);
                const float rs = 1.0f / sqrtf(ss * (1.0f / 128.0f) + EPS);
                bf16_t* op = Ob + (size_t)(wq * 32 + crow(r, hie)) * DM + r32e;
#pragma unroll
                for (int d0 = 0; d0 < 4; ++d0) op[d0 * 32] = (bf16_t)f2bf(o[d0][r] * rs * g[d0]);
            }
        }
        asm volatile("s_waitcnt lgkmcnt(0)" ::: "memory"); __builtin_amdgcn_s_barrier(); asm volatile("" ::: "memory");
        cbh = nbh;
    }
    asm volatile("s_waitcnt vmcnt(0) lgkmcnt(0)" ::: "memory"); __builtin_amdgcn_s_barrier(); asm volatile("" ::: "memory");
#undef ATT_DMA
#undef ATT_TOP
#undef ATT_KB
#undef ATT_VB
#undef ATT_LD8
}

namespace gla {
constexpr int BC = 0, QI = 32768, QA = 49152, KA = 65536, KST = 81920, VT = 98304, ST = 106496, AT = 122880, EM = 131072, EL = EM + 512, DD = EM + 1024, BMID = EM + 1536, SEG = EM + 2048;
static_assert(SEG + 2048 <= RING_BYTES, "gla lds");
__device__ __forceinline__ int sw256(int row, int cb) { return row * 256 + (cb ^ ((row & 15) << 4)); }
__device__ __forceinline__ int sw128(int row, int cb) { return row * 128 + (cb ^ ((((row & 7) ^ (row >> 4)) & 7) << 4)); }
__device__ __forceinline__ int crow(int r, int hi) { return (r & 3) + 8 * (r >> 2) + 4 * hi; }
__device__ __forceinline__ float h2f(unsigned short b) { return (float)__builtin_bit_cast(_Float16, b); }
__device__ __forceinline__ void gla_item(const bf16_t* __restrict__ Qp, const unsigned short* __restrict__ LFp, const bf16_t* __restrict__ Vp, bf16_t* __restrict__ Op, int dir, LAS unsigned char* lds, float* dbg) {
    int tid_ = threadIdx.x; asm volatile("" : "+v"(tid_));
    const int tid = tid_, wid = tid >> 6, lane = tid & 63, r = lane & 31, hh = lane >> 5;
    const int t1 = tid >> 3, kg = tid & 7, k0 = 16 * kg, v0 = (tid & 7) * 8;
    for (int i = tid; i < 16384 / 16; i += NTHR) *(LAS u32x4*)(lds + ST + i * 16) = (u32x4){0u, 0u, 0u, 0u};
    f32x16 st = {};
    u32x4 rq[2], rl[2], rv;
#define GLA_TOK(ci, i) (dir ? (SEQ - 1 - ((ci) * 64 + (i))) : ((ci) * 64 + (i)))
#define GLA_LOAD(ci) do { const size_t to = (size_t)GLA_TOK(ci, t1) * DM; \
        rq[0] = *(const u32x4*)(Qp + to + k0); rq[1] = *(const u32x4*)(Qp + to + k0 + 8); \
        rl[0] = *(const u32x4*)(LFp + to + k0); rl[1] = *(const u32x4*)(LFp + to + k0 + 8); rv = *(const u32x4*)(Vp + to + v0); } while (0)
    GLA_LOAD(0);
    __syncthreads();
    for (int ci = 0; ci < SEQ / 64; ++ci) {
        float qf[16], lf[16]; u32x4 vreg = rv;
#pragma unroll
        for (int j = 0; j < 2; ++j)
#pragma unroll
            for (int e = 0; e < 4; ++e) { qf[j * 8 + 2 * e] = bflo(rq[j][e]); qf[j * 8 + 2 * e + 1] = bfhi(rq[j][e]);
                lf[j * 8 + 2 * e] = h2f((unsigned short)(rl[j][e] & 0xffffu)); lf[j * 8 + 2 * e + 1] = h2f((unsigned short)(rl[j][e] >> 16)); }
        if (ci + 1 < SEQ / 64) GLA_LOAD(ci + 1);
#pragma unroll
        for (int j = 0; j < 4; ++j) *(LAS f32x4*)(lds + BC + (t1 * 128 + k0 + 4 * j) * 4) = (f32x4){lf[4 * j], lf[4 * j + 1], lf[4 * j + 2], lf[4 * j + 3]};
        __syncthreads();
        { const int kc = tid & 127, sg = tid >> 7; LAS float* bc = (LAS float*)(lds + BC) + kc; float cs[16];
#pragma unroll
            for (int i = 0; i < 16; ++i) cs[i] = bc[(sg * 16 + i) * 128];
#pragma unroll
            for (int i = 1; i < 16; ++i) cs[i] += cs[i - 1];
            ((LAS float*)(lds + SEG))[sg * 128 + kc] = cs[15];
            __syncthreads();
            const LAS float* sgp = (const LAS float*)(lds + SEG) + kc; const float s0 = sgp[0], s1 = sgp[128], s2 = sgp[256], s3 = sgp[384];
            const float off = sg == 0 ? 0.f : sg == 1 ? s0 : sg == 2 ? (s0 + s1) : ((s0 + s1) + s2);
#pragma unroll
            for (int i = 0; i < 16; ++i) bc[(sg * 16 + i) * 128] = cs[i] + off;
            if (sg == 0) { const float bm = s0 + s1, bl = ((s0 + s1) + s2) + s3;
                ((LAS float*)(lds + BMID))[kc] = bm; ((LAS float*)(lds + EM))[kc] = fexp(bm); ((LAS float*)(lds + EL))[kc] = fexp(bl - bm); ((LAS float*)(lds + DD))[kc] = fexp(bl); }
            __syncthreads();
        }
#ifdef DIAG
        if (dbg && ci == 0) { for (int i = tid; i < 8192; i += NTHR) dbg[i] = ((const LAS float*)(lds + BC))[i]; }
#endif
        {
            unsigned wqi[8], wqa[8], wka[8]; float ksv[16];
#pragma unroll
            for (int j = 0; j < 4; ++j) {
                const f32x4 bt = *(const LAS f32x4*)(lds + BC + (t1 * 128 + k0 + 4 * j) * 4), bm = *(const LAS f32x4*)(lds + BMID + (k0 + 4 * j) * 4);
                const f32x4 em = *(const LAS f32x4*)(lds + EM + (k0 + 4 * j) * 4), el = *(const LAS f32x4*)(lds + EL + (k0 + 4 * j) * 4);
                float qi[4], qa[4], ka[4];
#pragma unroll
                for (int e = 0; e < 4; ++e) { const int i = 4 * j + e; const float e1 = fexp(bt[e] - bm[e]), r1 = frcp(e1);
                    qa[e] = qf[i] * e1; qi[e] = qa[e] * em[e]; const float kk = 1.0f - fexp(lf[i]); ka[e] = kk * r1; ksv[i] = ka[e] * el[e]; }
                wqi[2 * j] = cvt_pk_bf16(qi[0], qi[1]); wqi[2 * j + 1] = cvt_pk_bf16(qi[2], qi[3]);
                wqa[2 * j] = cvt_pk_bf16(qa[0], qa[1]); wqa[2 * j + 1] = cvt_pk_bf16(qa[2], qa[3]);
                wka[2 * j] = cvt_pk_bf16(ka[0], ka[1]); wka[2 * j + 1] = cvt_pk_bf16(ka[2], ka[3]);
            }
#pragma unroll
            for (int j = 0; j < 2; ++j) { const int off = sw256(t1, (k0 + 8 * j) * 2);
                *(LAS u32x4*)(lds + QI + off) = (u32x4){wqi[4 * j], wqi[4 * j + 1], wqi[4 * j + 2], wqi[4 * j + 3]};
                *(LAS u32x4*)(lds + QA + off) = (u32x4){wqa[4 * j], wqa[4 * j + 1], wqa[4 * j + 2], wqa[4 * j + 3]};
                *(LAS u32x4*)(lds + KA + off) = (u32x4){wka[4 * j], wka[4 * j + 1], wka[4 * j + 2], wka[4 * j + 3]}; }
#pragma unroll
            for (int i = 0; i < 16; ++i) *(LAS unsigned short*)(lds + KST + sw128(k0 + i, t1 * 2)) = (unsigned short)f2bf(ksv[i]);
#pragma unroll
            for (int e = 0; e < 4; ++e) { *(LAS unsigned short*)(lds + VT + sw128(v0 + 2 * e, t1 * 2)) = (unsigned short)(vreg[e] & 0xffffu);
                *(LAS unsigned short*)(lds + VT + sw128(v0 + 2 * e + 1, t1 * 2)) = (unsigned short)(vreg[e] >> 16); }
        }
        __syncthreads();
        f32x16 oacc = {};
        const int w4 = wid & 3, t_i = w4 >> 1, v_i = w4 & 1;
        if (wid < 4) {
            const int s_i = wid >> 1, tq = wid & 1; f32x16 a = {};
#pragma unroll
            for (int ks = 0; ks < 8; ++ks) { const bf16x8 fa = *(const LAS bf16x8*)(lds + KA + sw256(32 * s_i + r, (16 * ks + 8 * hh) * 2)), fb = *(const LAS bf16x8*)(lds + QA + sw256(32 * tq + r, (16 * ks + 8 * hh) * 2));
                a = __builtin_amdgcn_mfma_f32_32x32x16_bf16(fa, fb, a, 0, 0, 0); }
            const int tg = 32 * tq + r;
#pragma unroll
            for (int g = 0; g < 4; ++g) { float m[4];
#pragma unroll
                for (int e = 0; e < 4; ++e) { const int sgl = 32 * s_i + 8 * g + 4 * hh + e; m[e] = (sgl <= tg) ? a[4 * g + e] : 0.f; }
                *(LAS u32x2*)(lds + AT + sw128(tg, (32 * s_i + 8 * g + 4 * hh) * 2)) = (u32x2){cvt_pk_bf16(m[0], m[1]), cvt_pk_bf16(m[2], m[3])}; }
        } else {
#pragma unroll
            for (int ks = 0; ks < 8; ++ks) { const bf16x8 fa = *(const LAS bf16x8*)(lds + QI + sw256(32 * t_i + r, (16 * ks + 8 * hh) * 2)), fb = *(const LAS bf16x8*)(lds + ST + sw256(32 * v_i + r, (16 * ks + 8 * hh) * 2));
                oacc = __builtin_amdgcn_mfma_f32_32x32x16_bf16(fa, fb, oacc, 0, 0, 0); }
        }
        __syncthreads();
#ifdef DIAG
        if (dbg && ci == 0) { for (int i = tid; i < 2048; i += NTHR) { ((unsigned*)dbg)[8192 + i] = ((const LAS unsigned*)(lds + AT))[i]; ((unsigned*)dbg)[8192 + 2048 + i] = ((const LAS unsigned*)(lds + VT))[i]; } }
#endif
        if (wid >= 4) {
#pragma unroll
            for (int ks = 0; ks < 4; ++ks) { const bf16x8 fa = *(const LAS bf16x8*)(lds + AT + sw128(32 * t_i + r, (16 * ks + 8 * hh) * 2)), fb = *(const LAS bf16x8*)(lds + VT + sw128(32 * v_i + r, (16 * ks + 8 * hh) * 2));
                oacc = __builtin_amdgcn_mfma_f32_32x32x16_bf16(fa, fb, oacc, 0, 0, 0); }
#pragma unroll
            for (int i = 0; i < 16; ++i) { const int t = 32 * t_i + crow(i, hh); Op[(size_t)GLA_TOK(ci, t) * DM + 32 * v_i + r] = (bf16_t)f2bf(oacc[i]); }
        }
        {
            const int kq = wid >> 1, vq = wid & 1;
#pragma unroll
            for (int i = 0; i < 16; ++i) st[i] *= ((const LAS float*)(lds + DD))[32 * kq + crow(i, hh)];
#pragma unroll
            for (int ks = 0; ks < 4; ++ks) { const bf16x8 fa = *(const LAS bf16x8*)(lds + KST + sw128(32 * kq + r, (16 * ks + 8 * hh) * 2)), fb = *(const LAS bf16x8*)(lds + VT + sw128(32 * vq + r, (16 * ks + 8 * hh) * 2));
                st = __builtin_amdgcn_mfma_f32_32x32x16_bf16(fa, fb, st, 0, 0, 0); }
#pragma unroll
            for (int g = 0; g < 4; ++g) *(LAS u32x2*)(lds + ST + sw256(32 * vq + r, (32 * kq + 8 * g + 4 * hh) * 2)) = (u32x2){cvt_pk_bf16(st[4 * g], st[4 * g + 1]), cvt_pk_bf16(st[4 * g + 2], st[4 * g + 3])};
        }
        __syncthreads();
#ifdef DIAG
        if (dbg && ci == 0) { for (int i = tid; i < 4096; i += NTHR) { ((unsigned*)dbg)[12288 + i] = ((const LAS unsigned*)(lds + ST))[i]; ((unsigned*)dbg)[16384 + i] = ((const LAS unsigned*)(lds + KST))[i]; } }
#endif
    }
#undef GLA_TOK
#undef GLA_LOAD
}
}
__device__ __forceinline__ void gla_phase(const Args& A, LAS unsigned char* lds, int bid, int G) {
    unsigned char* ws = A.ws;
    for (int it = bid; it < 256; it += G) {
        const int b = it >> 5, h = (it >> 2) & 7, dir = (it >> 1) & 1, vh = it & 1;
        const size_t base = (size_t)b * SEQ * DM + h * 128;
        gla::gla_item((const bf16_t*)(ws + H_Q) + base, (const unsigned short*)(ws + (dir ? H_LFB : H_LFF)) + base, (const bf16_t*)(ws + H_V) + base + vh * 64,
                      (bf16_t*)(ws + (dir ? H_OB : H_OF)) + base + vh * 64, dir, lds, it == 0 ? (float*)(ws + TB_LSUM) : nullptr);
    }
}
__device__ __forceinline__ void hg_normo_phase(const Args& A, int bid, int G) {
    int tid_ = threadIdx.x; asm volatile("" : "+v"(tid_));
    const int tid = tid_, lane = tid & 63, wave = tid >> 6; unsigned char* ws = A.ws;
    const bf16_t* OF = (const bf16_t*)(ws + H_OF); const bf16_t* OB = (const bf16_t*)(ws + H_OB); const bf16_t* GG = (const bf16_t*)(ws + H_G); bf16_t* HM = (bf16_t*)(ws + WS_HM);
    const int c0 = (lane >> 3) * 128 + (lane & 7) * 16;
    float ng[16];
#pragma unroll
    for (int i = 0; i < 16; ++i) ng[i] = A.in[I_HGNG][(lane & 7) * 16 + i];
    for (int row = (bid * NWAVES + wave); row < MTOK; row += G * NWAVES) {
        const size_t o = (size_t)row * DM + c0;
        const u32x4 a0 = *(const u32x4*)(OF + o), a1 = *(const u32x4*)(OF + o + 8), b0 = *(const u32x4*)(OB + o), b1 = *(const u32x4*)(OB + o + 8), g0 = *(const u32x4*)(GG + o), g1 = *(const u32x4*)(GG + o + 8);
        float v[16], gt[16]; float ss = 0.f;
#pragma unroll
        for (int e = 0; e < 4; ++e) { v[2 * e] = bflo(a0[e]) + bflo(b0[e]); v[2 * e + 1] = bfhi(a0[e]) + bfhi(b0[e]); v[8 + 2 * e] = bflo(a1[e]) + bflo(b1[e]); v[8 + 2 * e + 1] = bfhi(a1[e]) + bfhi(b1[e]);
            gt[2 * e] = bflo(g0[e]); gt[2 * e + 1] = bfhi(g0[e]); gt[8 + 2 * e] = bflo(g1[e]); gt[8 + 2 * e + 1] = bfhi(g1[e]); }
#pragma unroll
        for (int i = 0; i < 16; ++i) ss += v[i] * v[i];
        ss += __shfl_xor(ss, 1); ss += __shfl_xor(ss, 2); ss += __shfl_xor(ss, 4);
        const float rstd = 1.0f / sqrtf(ss * (1.0f / 128.0f) + EPS);
        u32x4 w0, w1;
#pragma unroll
        for (int e = 0; e < 4; ++e) { w0[e] = cvt_pk_bf16(v[2 * e] * rstd * ng[2 * e] * gt[2 * e], v[2 * e + 1] * rstd * ng[2 * e + 1] * gt[2 * e + 1]);
            w1[e] = cvt_pk_bf16(v[8 + 2 * e] * rstd * ng[8 + 2 * e] * gt[8 + 2 * e], v[8 + 2 * e + 1] * rstd * ng[8 + 2 * e + 1] * gt[8 + 2 * e + 1]); }
        *(u32x4*)(HM + o) = w0; *(u32x4*)(HM + o + 8) = w1;
    }
}

#ifdef DIAG
constexpr int DG_BASE = 8192;
__device__ __forceinline__ void dg_put(const Args& A, int k, float e) { if (!(e >= 0.f) || e > 1e9f) e = 1e9f; atomicMax((unsigned*)(A.ws + WS_CTL) + DG_BASE + 64 * k, __float_as_uint(e)); }
__device__ __forceinline__ float dg_rel(float got, float ref) { return fabsf(got - ref) / (fabsf(ref) + 0.1f); }
__device__ __forceinline__ unsigned dg_hash(unsigned a, unsigned b) { unsigned h = a * 2654435761u + b * 40503u + 0x9e3779b9u; h ^= h >> 15; h *= 2246822519u; h ^= h >> 13; h *= 3266489917u; h ^= h >> 16; return h; }
__device__ __forceinline__ float dg_bfr(float x) { return bflo(f2bf(x)); }
__device__ __forceinline__ void dg_mods(const Args& A, int k) {
    const int lane = threadIdx.x & 63, gwv = blockIdx.x * 8 + (threadIdx.x >> 6);
    const unsigned h = dg_hash(gwv, k); const int l = h & 3, b = (h >> 2) & 7, e = (h >> 5) % 6144;
    float a = 0.f; for (int d = lane; d < DM; d += 64) a += fsilu(A.in[I_C][b * DM + d]) * A.in[I_ADAW][((size_t)l * DM + d) * 6144 + e];
    a = wave_sum(a) + A.in[I_ADAB][l * 6144 + e];
    const float got = ((const float*)(A.ws + TB_MODS))[((size_t)l * NBATCH + b) * 6144 + e];
    if (lane == 0) dg_put(A, k, dg_rel(got, a));
}
__device__ __forceinline__ void dg_norm(const Args& A, int k, const float* x, const float* gain, int L, int which) {
    const int lane = threadIdx.x & 63, gwv = blockIdx.x * 8 + (threadIdx.x >> 6);
    const int row = dg_hash(gwv, k) & (MTOK - 1), b = row >> 13;
    const float* modl = (const float*)(A.ws + TB_MODS) + ((size_t)L * NBATCH + b) * 6144;
    float ss = 0.f; for (int c = lane; c < DM; c += 64) { const float v = x[(size_t)row * DM + c]; ss += v * v; }
    ss = wave_sum(ss); const float rstd = 1.0f / sqrtf(ss / DM + EPS); float e = 0.f;
    for (int c = lane; c < DM; c += 64) { const float ref = x[(size_t)row * DM + c] * rstd * gain[c] * (1.0f + modl[(which * 3 + 1) * 1024 + c]) + modl[(which * 3) * 1024 + c];
        e = fmaxf(e, dg_rel(bf2f(((const bf16_t*)(A.ws + WS_HM))[(size_t)row * DM + c]), ref)); }
    dg_put(A, k, e);
}
__device__ __forceinline__ void dg_qkv(const Args& A, int k, int al) {
    const int lane = threadIdx.x & 63, gwv = blockIdx.x * 8 + (threadIdx.x >> 6);
    const unsigned h = dg_hash(gwv, k); const int row = h & (MTOK - 1), t = (h >> 16) % 48, col = t * 64 + lane;
    const bf16_t* hm = (const bf16_t*)(A.ws + WS_HM) + (size_t)row * DM; const float* w = A.in[I_ATWIN] + (size_t)al * 1024 * 3072 + col;
    float a = 0.f; for (int kk = 0; kk < DM; ++kk) a += bf2f(hm[kk]) * dg_bfr(w[(size_t)kk * 3072]);
    float ref, got;
    if (t < 32) {
        const int part = t >> 4, sh = t & 15; const float ss = wave_sum(a * a); const float rstd = 1.0f / sqrtf(ss / 64.0f + EPS);
        const float y = a * rstd * (part ? A.in[I_ATKN] : A.in[I_ATQN])[al * 64 + lane]; const float yp = __shfl_xor(y, 32);
        const int pos = row & (SEQ - 1); const float cs = ((const float*)(A.ws + TB_COS))[pos * 32 + (lane & 31)], sn = ((const float*)(A.ws + TB_SIN))[pos * 32 + (lane & 31)];
        ref = (lane < 32) ? (y * cs - yp * sn) : (y * cs + yp * sn); if (part == 0) ref *= 0.125f * LOG2E;
        got = bf2f(((const bf16_t*)(A.ws + (part ? A_K : A_Q)))[(size_t)row * DM + sh * 64 + lane]);
    } else { ref = a; got = bf2f(((const bf16_t*)(A.ws + A_V))[(size_t)row * DM + (t - 32) * 64 + lane]); }
    dg_put(A, k, dg_rel(got, ref));
}
__device__ __forceinline__ void dg_attn(const Args& A, int k, int al, LAS unsigned char* lds) {
    const int tid = threadIdx.x; const unsigned h = dg_hash(blockIdx.x, k); const int row = h & (MTOK - 1), hd = (h >> 16) & 7, b = row >> 13;
    const bf16_t* Q = (const bf16_t*)(A.ws + A_Q); const bf16_t* K = (const bf16_t*)(A.ws + A_K); const bf16_t* V = (const bf16_t*)(A.ws + A_V);
    const float* scal = (const float*)(A.ws + TB_SCAL); const float lamv = scal[SC_LAM0 + al], omli = scal[SC_OML0 + al], Mc = scal[SC_MC0 + al];
    LAS float* p0 = (LAS float*)lds; LAS float* p1 = p0 + SEQ; LAS float* red = p1 + SEQ;
    float l0 = 0.f, l1 = 0.f;
    for (int key = tid; key < SEQ; key += NTHR) { const bf16_t* kr = K + ((size_t)b * SEQ + key) * DM + hd * 128; const bf16_t* qr = Q + (size_t)row * DM + hd * 128;
        float s0 = 0.f, s1 = 0.f; for (int d = 0; d < 64; ++d) { s0 += bf2f(qr[d]) * bf2f(kr[d]); s1 += bf2f(qr[64 + d]) * bf2f(kr[64 + d]); }
        const float e0 = fexp2(s0 - Mc), e1 = fexp2(s1 - Mc); p0[key] = e0; p1[key] = e1; l0 += e0; l1 += e1; }
    l0 = wave_sum(l0); l1 = wave_sum(l1); if ((tid & 63) == 0) { red[tid >> 6] = l0; red[8 + (tid >> 6)] = l1; }
    __syncthreads();
    l0 = 0.f; l1 = 0.f; for (int w = 0; w < 8; ++w) { l0 += red[w]; l1 += red[8 + w]; }
    __syncthreads();
    const int dv = tid & 127, part = tid >> 7; float o = 0.f;
    for (int key = part * 2048; key < part * 2048 + 2048; ++key) o += (p0[key] / l0 - lamv * p1[key] / l1) * bf2f(V[((size_t)b * SEQ + key) * DM + hd * 128 + dv]);
    red[16 + part * 128 + dv] = o; __syncthreads();
    if (tid < 128) { o = red[16 + tid] + red[16 + 128 + tid] + red[16 + 256 + tid] + red[16 + 384 + tid]; red[600 + tid] = o * o; }
    __syncthreads();
    if (tid < 128) { float ss = 0.f; for (int i = 0; i < 128; ++i) ss += red[600 + i]; const float ref = o / sqrtf(ss / 128.0f + EPS) * A.in[I_ATSUB][al * 128 + tid] * omli;
        dg_put(A, k, dg_rel(bf2f(((const bf16_t*)(A.ws + WS_HM))[(size_t)row * DM + hd * 128 + tid]), ref)); }
    __syncthreads();
}
__device__ __forceinline__ void dg_save(const Args& A, int k, const float* xold) {
    const int lane = threadIdx.x & 63, gwv = blockIdx.x * 8 + (threadIdx.x >> 6);
    const unsigned h = dg_hash(gwv, k); const int row = h & (MTOK - 1), col = (h >> 16) & 1023;
    float* sv = (float*)(A.ws + TB_LSUM) + 7 * 1024 * 1024 / 4;
    if (lane == 0) sv[k * 4096 + gwv] = xold[(size_t)row * DM + col];
}
__device__ __forceinline__ void dg_res(const Args& A, int k, const float* xnew, const float* gate, const bf16_t* Am, int K, const float* W) {
    const int lane = threadIdx.x & 63, gwv = blockIdx.x * 8 + (threadIdx.x >> 6);
    const unsigned h = dg_hash(gwv, k); const int row = h & (MTOK - 1), col = (h >> 16) & 1023, b = row >> 13;
    const float* sv = (const float*)(A.ws + TB_LSUM) + 7 * 1024 * 1024 / 4;
    float a = 0.f; for (int kk = lane; kk < K; kk += 64) a += bf2f(Am[(size_t)row * K + kk]) * dg_bfr(W[(size_t)kk * DM + col]);
    a = wave_sum(a);
    const float ref = sv[k * 4096 + gwv] + gate[(size_t)b * 6144 + col] * a;
    if (lane == 0) dg_put(A, k, dg_rel(xnew[(size_t)row * DM + col], ref));
}
__device__ __forceinline__ void dg_swiglu(const Args& A, int k, const bf16_t* Am, const float* W, int F, const bf16_t* H, int nrows, const int* rowmap) {
    const int lane = threadIdx.x & 63, gwv = blockIdx.x * 8 + (threadIdx.x >> 6);
    const unsigned h = dg_hash(gwv, k); const int row = (h & 0xfffff) % nrows, j = (h >> 20) % F;
    float g = 0.f, u = 0.f; for (int kk = lane; kk < DM; kk += 64) { const float x = bf2f(Am[(size_t)row * DM + kk]); g += x * dg_bfr(W[(size_t)kk * 2 * F + j]); u += x * dg_bfr(W[(size_t)kk * 2 * F + F + j]); }
    g = wave_sum(g); u = wave_sum(u);
    const float ref = g / (1.0f + expf(-g)) * u;
    if (lane == 0) dg_put(A, k, dg_rel(bf2f(H[(size_t)row * F + j]), ref));
}
__device__ __forceinline__ void dg_hgin(const Args& A, int k) {
    const int lane = threadIdx.x & 63, gwv = blockIdx.x * 8 + (threadIdx.x >> 6);
    const unsigned h = dg_hash(gwv, k); const int row = h & (MTOK - 1), col = (h >> 16) % 5120, grp = col >> 10, cc = col & 1023;
    float a = 0.f; for (int kk = lane; kk < DM; kk += 64) a += bf2f(((const bf16_t*)(A.ws + WS_HM))[(size_t)row * DM + kk]) * dg_bfr(A.in[I_HGWIN][(size_t)kk * 5120 + col]);
    a = wave_sum(a);
    float ref, got;
    if (grp == 0 || grp == 4) { ref = a / (1.0f + expf(-a)); got = bf2f(((const bf16_t*)(A.ws + (grp == 0 ? H_Q : H_G)))[(size_t)row * DM + cc]); }
    else if (grp == 3) { ref = a; got = bf2f(((const bf16_t*)(A.ws + H_V))[(size_t)row * DM + cc]); }
    else { const int d = grp - 1; const float* p = A.in[I_HGLB] + (size_t)d * DEPTH * 1024 + cc; float mx = p[0]; for (int l = 1; l < DEPTH; ++l) mx = fmaxf(mx, p[l * 1024]);
        float den = 0.f; for (int l = 0; l < DEPTH; ++l) den += expf(p[l * 1024] - mx); const float lbv = expf(p[1024] - mx) / den;
        ref = logf(lbv + (1.0f - lbv) / (1.0f + expf(-a))); got = gla::h2f(((const unsigned short*)(A.ws + (d ? H_LFB : H_LFF)))[(size_t)row * DM + cc]); }
    if (lane == 0) dg_put(A, k, dg_rel(got, ref));
}
__device__ __forceinline__ void dg_gla(const Args& A, int k) {
    const int lane = threadIdx.x & 63, gwv = blockIdx.x * 8 + (threadIdx.x >> 6);
    const unsigned h = dg_hash(gwv, k); const int sel0 = (gwv & 3) == 0; const int b = sel0 ? 0 : (h & 7), hd = sel0 ? 0 : ((h >> 3) & 7), dir = sel0 ? 0 : ((h >> 6) & 1), vc = sel0 ? ((h >> 7) & 63) : ((h >> 7) & 127);
    const bf16_t* Q = (const bf16_t*)(A.ws + H_Q); const unsigned short* LF = (const unsigned short*)(A.ws + (dir ? H_LFB : H_LFF)); const bf16_t* V = (const bf16_t*)(A.ws + H_V);
    const bf16_t* O = (const bf16_t*)(A.ws + (dir ? H_OB : H_OF));
    float s0 = 0.f, s1 = 0.f, e0 = 0.f, e1 = 0.f, e2 = 0.f, e3 = 0.f;
    for (int i = 0; i < SEQ; ++i) { const int tok = dir ? (SEQ - 1 - i) : i; const size_t o = ((size_t)b * SEQ + tok) * DM + hd * 128;
        const float f0 = expf(gla::h2f(LF[o + lane])), f1 = expf(gla::h2f(LF[o + 64 + lane])), v = bf2f(V[o + vc]);
        s0 = f0 * s0 + (1.0f - f0) * v; s1 = f1 * s1 + (1.0f - f1) * v;
        if (i < 128 || i % 61 == 0) { const float ov = wave_sum(bf2f(Q[o + lane]) * s0 + bf2f(Q[o + 64 + lane]) * s1); const float er = 0.25f * fabsf(bf2f(O[o + vc]) - ov) / (fabsf(ov) + 1.0f);
            if (i == 0) e0 = er; else if (i < 64) e1 = fmaxf(e1, er); else if (i < 128) e2 = fmaxf(e2, er); else e3 = fmaxf(e3, er); } }
    if (lane == 0) { dg_put(A, k, e0); dg_put(A, k + 4, e1); dg_put(A, k + 5, e2); dg_put(A, k + 6, e3); }
    const float* dbg = (const float*)(A.ws + TB_LSUM); const unsigned short* LF0 = (const unsigned short*)(A.ws + H_LFF); const bf16_t* Q0 = (const bf16_t*)(A.ws + H_Q);
    { const unsigned h2 = dg_hash(gwv, k + 100); const int t = h2 & 63, kk = (h2 >> 6) & 127; float c = 0.f; for (int tt = 0; tt <= t; ++tt) c += gla::h2f(LF0[(size_t)tt * DM + kk]);
      if (lane == 0) dg_put(A, k + 1, dg_rel(dbg[t * 128 + kk], c)); }
    { const unsigned h2 = dg_hash(gwv, k + 200); const int t = h2 & 63, sidx = (h2 >> 6) & 63; float a = 0.f;
      if (sidx <= t) { for (int kk = lane; kk < 128; kk += 64) { float c = 0.f; for (int tt = sidx + 1; tt <= t; ++tt) c += gla::h2f(LF0[(size_t)tt * DM + kk]);
              a += bf2f(Q0[(size_t)t * DM + kk]) * (1.0f - expf(gla::h2f(LF0[(size_t)sidx * DM + kk]))) * expf(c); } a = wave_sum(a); }
      const unsigned short got = ((const unsigned short*)(dbg + 8192))[gla::sw128(t, sidx * 2) / 2];
      if (lane == 0) dg_put(A, k + 2, 5.0f * fabsf(bf2f(got) - a) / (fabsf(a) + 0.01f)); }
    { const unsigned h2 = dg_hash(gwv, k + 300); const int sidx = h2 & 63, v = (h2 >> 6) & 63;
      const unsigned short got = ((const unsigned short*)(dbg + 8192 + 2048))[gla::sw128(v, sidx * 2) / 2];
      if (lane == 0) dg_put(A, k + 2, dg_rel(bf2f(got), bf2f(((const bf16_t*)(A.ws + H_V))[(size_t)sidx * DM + v]))); }
    { const unsigned h2 = dg_hash(gwv, k + 500); const int kk = h2 & 127, v = (h2 >> 7) & 63;
      float a = 0.f; { const int sidx = lane; float c = 0.f; for (int tt = sidx + 1; tt < 64; ++tt) c += gla::h2f(LF0[(size_t)tt * DM + kk]);
          const float ksn = (1.0f - expf(gla::h2f(LF0[(size_t)sidx * DM + kk]))) * expf(c);
          const unsigned short gk = ((const unsigned short*)(dbg + 16384))[gla::sw128(kk, sidx * 2) / 2];
          dg_put(A, k + 2, 0.5f * fabsf(bf2f(gk) - ksn) / (fabsf(ksn) + 0.01f));
          a = ksn * bf2f(((const bf16_t*)(A.ws + H_V))[(size_t)sidx * DM + v]); }
      a = wave_sum(a);
      const unsigned short gs = ((const unsigned short*)(dbg + 12288))[gla::sw256(v, kk * 2) / 2];
      if (lane == 0) dg_put(A, k + 3, 0.5f * fabsf(bf2f(gs) - a) / (fabsf(a) + 0.05f)); }
    { const unsigned h2 = dg_hash(gwv, k + 400); const int t = h2 & 63, v = (h2 >> 6) & 63;
      const unsigned short* at = (const unsigned short*)(dbg + 8192); const unsigned short* vt = (const unsigned short*)(dbg + 8192 + 2048);
      float a = bf2f(at[gla::sw128(t, lane * 2) / 2]) * bf2f(vt[gla::sw128(v, lane * 2) / 2]); a = wave_sum(a);
      if (lane == 0) dg_put(A, k + 1, 5.0f * dg_rel(bf2f(((const bf16_t*)(A.ws + H_OF))[(size_t)t * DM + v]), a)); }
}
__device__ __forceinline__ void dg_normo(const Args& A, int k) {
    const int lane = threadIdx.x & 63, gwv = blockIdx.x * 8 + (threadIdx.x >> 6);
    const unsigned h = dg_hash(gwv, k); const int row = h & (MTOK - 1), hd = (h >> 16) & 7; const size_t o = (size_t)row * DM + hd * 128;
    const float v0 = bf2f(((const bf16_t*)(A.ws + H_OF))[o + lane]) + bf2f(((const bf16_t*)(A.ws + H_OB))[o + lane]), v1 = bf2f(((const bf16_t*)(A.ws + H_OF))[o + 64 + lane]) + bf2f(((const bf16_t*)(A.ws + H_OB))[o + 64 + lane]);
    const float ss = wave_sum(v0 * v0 + v1 * v1), rstd = 1.0f / sqrtf(ss / 128.0f + EPS);
    const float r0 = v0 * rstd * A.in[I_HGNG][lane] * bf2f(((const bf16_t*)(A.ws + H_G))[o + lane]), r1 = v1 * rstd * A.in[I_HGNG][64 + lane] * bf2f(((const bf16_t*)(A.ws + H_G))[o + 64 + lane]);
    dg_put(A, k, fmaxf(dg_rel(bf2f(((const bf16_t*)(A.ws + WS_HM))[o + lane]), r0), dg_rel(bf2f(((const bf16_t*)(A.ws + WS_HM))[o + 64 + lane]), r1)));
}
__device__ __forceinline__ void dg_router(const Args& A, int k, int L) {
    const int lane = threadIdx.x & 63, gwv = blockIdx.x * 8 + (threadIdx.x >> 6);
    const int row = dg_hash(gwv, k) & (MTOK - 1), b = row >> 13; const float* x = A.out + (size_t)row * DM;
    const float* modl = (const float*)(A.ws + TB_MODS) + ((size_t)L * NBATCH + b) * 6144; const float* gain = A.in[I_N2G] + L * DM; const float* R = A.in[I_MOER] + (size_t)(L >> 1) * DM * 8;
    float ss = 0.f; for (int c = lane; c < DM; c += 64) ss += x[c] * x[c];
    ss = wave_sum(ss); const float rstd = 1.0f / sqrtf(ss / DM + EPS);
    float lg[8]; for (int e = 0; e < 8; ++e) lg[e] = 0.f;
    for (int c = lane; c < DM; c += 64) { const float hv = x[c] * rstd * gain[c] * (1.0f + modl[4 * 1024 + c]) + modl[3 * 1024 + c]; for (int e = 0; e < 8; ++e) lg[e] += hv * R[c * 8 + e]; }
    for (int e = 0; e < 8; ++e) lg[e] = wave_sum(lg[e]);
    int e0 = 0; for (int e = 1; e < 8; ++e) if (lg[e] > lg[e0]) e0 = e;
    int e1 = (e0 == 0) ? 1 : 0; for (int e = 0; e < 8; ++e) if (e != e0 && lg[e] > lg[e1]) e1 = e;
    float gap = 1e9f; for (int e = 0; e < 8; ++e) if (e != e0 && e != e1) gap = fminf(gap, lg[e1] - lg[e]); gap = fminf(gap, lg[e0] - lg[e1]);
    const int g0 = ((const int*)(A.ws + TB_EID))[row * 2], g1 = ((const int*)(A.ws + TB_EID))[row * 2 + 1]; const float w0 = ((const float*)(A.ws + TB_GATE))[row * 2], w1 = ((const float*)(A.ws + TB_GATE))[row * 2 + 1];
    const float p0 = 1.0f / (1.0f + expf(lg[e1] - lg[e0]));
    float er = (g0 != e0 || g1 != e1) ? (gap > 2e-3f ? 9.f : 0.f) : fmaxf(fabsf(w0 - p0), fabsf(w1 - (1.0f - p0)));
    if (lane == 0) dg_put(A, k, er);
}
__device__ __forceinline__ void dg_place(const Args& A, int k) {
    const int lane = threadIdx.x & 63, gwv = blockIdx.x * 8 + (threadIdx.x >> 6);
    const unsigned h = dg_hash(gwv, k); const int row = h & (MTOK - 1), kk = (h >> 16) & 1;
    const int sl = ((const int*)(A.ws + TB_SLOT))[row * 2 + kk], e = ((const int*)(A.ws + TB_EID))[row * 2 + kk]; const int* ts = (const int*)(A.ws + TB_TILES);
    float er = (sl >= ts[e] * 256 && sl < ts[e + 1] * 256 && sl < MOE_ROWS) ? 0.f : 7.f;
    if (er == 0.f) for (int c = lane; c < DM; c += 64) if (((const bf16_t*)(A.ws + E_XS))[(size_t)sl * DM + c] != ((const bf16_t*)(A.ws + WS_HM))[(size_t)row * DM + c]) er = 5.f;
    dg_put(A, k, er);
}
__device__ __forceinline__ void dg_moe_hid(const Args& A, int k, int m) {
    const int lane = threadIdx.x & 63, gwv = blockIdx.x * 8 + (threadIdx.x >> 6);
    const unsigned h = dg_hash(gwv, k); const int row = h & (MTOK - 1), kk = (h >> 16) & 1, j = (h >> 17) % DFFE;
    const int sl = ((const int*)(A.ws + TB_SLOT))[row * 2 + kk], e = ((const int*)(A.ws + TB_EID))[row * 2 + kk];
    const float* W = A.in[I_MOEGU] + ((size_t)m * 8 + e) * DM * 2 * DFFE; const bf16_t* Am = (const bf16_t*)(A.ws + E_XS) + (size_t)sl * DM;
    float g = 0.f, u = 0.f; for (int c = lane; c < DM; c += 64) { const float x = bf2f(Am[c]); g += x * dg_bfr(W[(size_t)c * 2 * DFFE + j]); u += x * dg_bfr(W[(size_t)c * 2 * DFFE + DFFE + j]); }
    g = wave_sum(g); u = wave_sum(u);
    if (lane == 0) dg_put(A, k, dg_rel(bf2f(((const bf16_t*)(A.ws + E_HID))[(size_t)sl * DFFE + j]), g / (1.0f + expf(-g)) * u));
}
__device__ __forceinline__ void dg_moe_y(const Args& A, int k, int m) {
    const int lane = threadIdx.x & 63, gwv = blockIdx.x * 8 + (threadIdx.x >> 6);
    const unsigned h = dg_hash(gwv, k); const int row = h & (MTOK - 1), kk = (h >> 16) & 1, col = (h >> 17) & 1023;
    const int sl = ((const int*)(A.ws + TB_SLOT))[row * 2 + kk], e = ((const int*)(A.ws + TB_EID))[row * 2 + kk];
    const float* W = A.in[I_MOEDN] + ((size_t)m * 8 + e) * DFFE * DM; const bf16_t* Hh = (const bf16_t*)(A.ws + E_HID) + (size_t)sl * DFFE;
    float a = 0.f; for (int j = lane; j < DFFE; j += 64) a += bf2f(Hh[j]) * dg_bfr(W[(size_t)j * DM + col]);
    a = wave_sum(a);
    if (lane == 0) dg_put(A, k, fabsf(bf2f(((const bf16_t*)(A.ws + E_XS))[(size_t)sl * DM + col]) - a) / (fabsf(a) + 0.3f));
}
__device__ __forceinline__ void dg_combine(const Args& A, int k, const float* modprev) {
    const int lane = threadIdx.x & 63, gwv = blockIdx.x * 8 + (threadIdx.x >> 6);
    const unsigned h = dg_hash(gwv, k); const int row = h & (MTOK - 1), col = (h >> 16) & 1023, b = row >> 13;
    const float* sv = (const float*)(A.ws + TB_LSUM) + 7 * 1024 * 1024 / 4; const bf16_t* Y = (const bf16_t*)(A.ws + E_XS);
    const int s0 = ((const int*)(A.ws + TB_SLOT))[row * 2], s1 = ((const int*)(A.ws + TB_SLOT))[row * 2 + 1]; const float w0 = ((const float*)(A.ws + TB_GATE))[row * 2], w1 = ((const float*)(A.ws + TB_GATE))[row * 2 + 1];
    const float ref = sv[k * 4096 + gwv] + modprev[(size_t)b * 6144 + 5 * 1024 + col] * (w0 * bf2f(Y[(size_t)s0 * DM + col]) + w1 * bf2f(Y[(size_t)s1 * DM + col]));
    if (lane == 0) dg_put(A, k, dg_rel(A.out[(size_t)row * DM + col], ref));
}
__device__ __forceinline__ void dg_lruin(const Args& A, int k) {
    const int lane = threadIdx.x & 63, gwv = blockIdx.x * 8 + (threadIdx.x >> 6);
    const unsigned h = dg_hash(gwv, k); const int row = h & (MTOK - 1), col = (h >> 16) % 2560;
    float a = 0.f; for (int kk = lane; kk < DM; kk += 64) a += bf2f(((const bf16_t*)(A.ws + WS_HM))[(size_t)row * DM + kk]) * dg_bfr(A.in[I_LRWIN][(size_t)kk * 2560 + col]);
    a = wave_sum(a);
    float ref, got;
    if (col < LRUW) { ref = 0.5f * a * (1.0f + tanhf(0.7978845608028654f * (a + 0.044715f * a * a * a))); got = bf2f(((const bf16_t*)(A.ws + L_YB))[(size_t)row * LRUW + col]); }
    else { ref = a; got = bf2f(((const bf16_t*)(A.ws + L_XB))[(size_t)row * LRUW + col - LRUW]); }
    if (lane == 0) dg_put(A, k, dg_rel(got, ref));
}
__device__ __forceinline__ void dg_lru(const Args& A, int k) {
    const int lane = threadIdx.x & 63, gwv = blockIdx.x * 8 + (threadIdx.x >> 6);
    const unsigned h = dg_hash(gwv, k); const int b = h & 7, ch = (h >> 3) % LRUW, tc = (h >> 16) & (SEQ - 1), n = ch / 128, j = ch % 128;
    const bf16_t* XB = (const bf16_t*)(A.ws + L_XB) + (size_t)b * SEQ * LRUW;
    float hres[2];
    for (int d = 0; d < 2; ++d) {
        const float* wa = A.in[I_LRWA] + (size_t)(d * 10 + n) * 16384; const float* wx = A.in[I_LRWX] + (size_t)(d * 10 + n) * 16384;
        const float wa0 = dg_bfr(wa[lane * 128 + j]), wa1 = dg_bfr(wa[(lane + 64) * 128 + j]), wx0 = dg_bfr(wx[lane * 128 + j]), wx1 = dg_bfr(wx[(lane + 64) * 128 + j]);
        const float ba = A.in[I_LRBA][d * LRUW + ch], bx = A.in[I_LRBX][d * LRUW + ch]; const float lam = A.in[I_LRLAM][d * LRUW + ch]; const float sp = log1pf(expf(-lam));
        float hs = 0.f;
        for (int i = 0; ; ++i) { const int t = d ? (SEQ - 1 - i) : i;
            float x0 = A.in[I_LRCB][n * 128 + lane], x1 = A.in[I_LRCB][n * 128 + 64 + lane], xj = A.in[I_LRCB][ch];
            for (int w = 0; w < 4; ++w) { const int tt = t - 1 + w; if (tt >= 0 && tt < SEQ) {
                x0 += A.in[I_LRCW][w * LRUW + n * 128 + lane] * bf2f(XB[(size_t)tt * LRUW + n * 128 + lane]); x1 += A.in[I_LRCW][w * LRUW + n * 128 + 64 + lane] * bf2f(XB[(size_t)tt * LRUW + n * 128 + 64 + lane]);
                xj += A.in[I_LRCW][w * LRUW + ch] * bf2f(XB[(size_t)tt * LRUW + ch]); } }
            const float rp = wave_sum(dg_bfr(x0) * wa0 + dg_bfr(x1) * wa1), ip = wave_sum(dg_bfr(x0) * wx0 + dg_bfr(x1) * wx1);
            const float rg = 1.0f / (1.0f + expf(-(rp + ba))), ig = 1.0f / (1.0f + expf(-(ip + bx))); const float la = -8.0f * rg * sp;
            hs = expf(la) * hs + sqrtf(fmaxf(-expm1f(2.0f * la), 0.f)) * ig * xj;
            if (t == tc) break; }
        hres[d] = hs;
    }
    const size_t go = ((size_t)b * SEQ + tc) * LRUW + ch;
    const float e1 = fabsf(bf2f(((const bf16_t*)(A.ws + L_HF))[go]) - hres[0]) / (fabsf(hres[0]) + 0.3f);
    const float ref = (hres[0] + hres[1]) * bf2f(((const bf16_t*)(A.ws + L_YB))[go]);
    const float e2 = fabsf(bf2f(((const bf16_t*)(A.ws + L_HY))[go]) - ref) / (fabsf(ref) + 0.3f);
    if (lane == 0) { dg_put(A, k, e1); dg_put(A, k + 5, e2); }
}
__device__ __forceinline__ void dg_final(const Args& A, int nchk) {
    const unsigned* sl = (const unsigned*)(A.ws + WS_CTL) + DG_BASE; int code = 0; float ev = 0.f;
    for (int k = 1; k <= nchk; ++k) { const float e = __uint_as_float(sl[64 * k]); if (e > 0.05f) { code = k; ev = e; break; } }
    if (code == 0) return;
    const int c1 = code % 10, c10 = code / 10;
    const float s = -(float)c1;
    for (size_t i = (size_t)blockIdx.x * NTHR + threadIdx.x; i < (size_t)MTOK * DM; i += (size_t)gridDim.x * NTHR) A.out[i] = A.in[I_X][i] * s;
    __syncthreads();
    if (blockIdx.x == 0 && threadIdx.x == 0) { const int qq = ev < 0.1f ? 1 : ev < 0.2f ? 2 : ev < 0.5f ? 3 : ev < 1.f ? 4 : ev < 2.f ? 5 : ev < 5.f ? 6 : ev < 20.f ? 7 : ev < 1e3f ? 8 : 9;
        A.out[12345] = 100.f * (float)(10 * c10 + qq); }
}
#define DG(x) x
#define DGL(x) if constexpr (L >= DIAG_FROM) { x }
#else
#define DG(x)
#define DGL(x)
#endif

#define GRID_BAR() xcd_barrier(bar)
template <int L>
__device__ __forceinline__ void run_mixer(const Args& args, LAS unsigned char* lds, int bid, int G, const XcdBarrier& bar) {
    unsigned char* ws = args.ws; bf16_t* xo = (bf16_t*)(ws + WS_XB);
    const float* modl = (const float*)(ws + TB_MODS) + (size_t)L * NBATCH * 6144;
    const void* xs = (L == 0) ? (const void*)args.in[I_X] : (const void*)xo; constexpr bool X16 = (L != 0);
    constexpr int kind = L % 3;
    DGL(if (L > 0 && ((L - 1) & 1)) { dg_save(args, 10 * (L - 1) + 9, xo); GRID_BAR(); })
    norm_phase<false>(args, lds, bid, G, xs, X16, xo, true, args.in[I_N1G] + L * DM, modl, 0, (L > 0) && ((L - 1) & 1), modl - NBATCH * 6144, false, nullptr);
    GRID_BAR();
    DGL(if (L > 0 && ((L - 1) & 1)) { dg_combine(args, 10 * (L - 1) + 9, modl - NBATCH * 6144); GRID_BAR(); })
    DGL(dg_norm(args, 10 * L + 1, (L > 0 && ((L - 1) & 1)) ? xo : xs, args.in[I_N1G] + L * DM, L, 0); GRID_BAR();)
    if constexpr (kind == 0) {
        constexpr int al = L / 3;
        {
            pg8::Gemm g{(const bf16_t*)(ws + WS_HM), (const bf16_t*)(ws + W_QKV) + (size_t)al * 3072 * 1024, 1024};
            pg8::TileOrder S; S.init(256, 12, G, bid);
            pg8::EpiQKV E{(bf16_t*)(ws + A_Q), (bf16_t*)(ws + A_K), (bf16_t*)(ws + A_V), args.in[I_ATQN] + al * 64, args.in[I_ATKN] + al * 64,
                          (const float*)(ws + TB_COS), (const float*)(ws + TB_SIN), LOG2E};
            pg8::gemm_phase<pg8::EpiQKV>(lds, g, S, E);
        }
        GRID_BAR();
        vt_phase(args, bid, G);
        GRID_BAR();
        attn_phase(args, lds, bid, G, al);
        GRID_BAR();
        DGL(dg_save(args, 10 * L + 4, xs); GRID_BAR();)
        {
            pg8::Gemm g{(const bf16_t*)(ws + WS_HM), (const bf16_t*)(ws + W_AO) + (size_t)al * 1024 * 1024, 1024};
            pg8::TileOrder S; S.init(256, 4, G, bid);
            pg8::EpiRes<X16> E{xs, xo, modl + 2 * 1024, 1.0f};
            pg8::gemm_phase<pg8::EpiRes<X16>>(lds, g, S, E);
        }
        GRID_BAR();
        DGL(dg_res(args, 10 * L + 4, xo, modl + 2 * 1024, (const bf16_t*)(ws + WS_HM), 1024, args.in[I_ATWOUT] + (size_t)al * 1024 * 1024); GRID_BAR();)
    }
    if constexpr (kind == 1) {
        {
            pg8::Gemm g{(const bf16_t*)(ws + WS_HM), (const bf16_t*)(ws + W_HGI), 1024};
            pg8::TileOrder S; S.init(256, 20, G, bid);
            pg8::EpiAct E{0, ws, (const float*)(ws + TB_LB)};
            pg8::gemm_phase<pg8::EpiAct>(lds, g, S, E);
        }
        GRID_BAR();
        DGL(dg_hgin(args, 10 * L + 2); GRID_BAR();)
        gla_phase(args, lds, bid, G);
        GRID_BAR();
        DGL(dg_gla(args, 10 * L + 3); GRID_BAR();)
        hg_normo_phase(args, bid, G);
        GRID_BAR();
        DGL(dg_normo(args, 10 * L + 0); GRID_BAR();)
        DGL(dg_save(args, 10 * L + 4, xs); GRID_BAR();)
        {
            pg8::Gemm g{(const bf16_t*)(ws + WS_HM), (const bf16_t*)(ws + W_HGO), 1024};
            pg8::TileOrder S; S.init(256, 4, G, bid);
            pg8::EpiRes<X16> E{xs, xo, modl + 2 * 1024, 1.0f};
            pg8::gemm_phase<pg8::EpiRes<X16>>(lds, g, S, E);
        }
        GRID_BAR();
        DGL(dg_res(args, 10 * L + 4, xo, modl + 2 * 1024, (const bf16_t*)(ws + WS_HM), 1024, args.in[I_HGWOUT]); GRID_BAR();)
    }
    if constexpr (kind == 2) {
        {
            pg8::Gemm g{(const bf16_t*)(ws + WS_HM), (const bf16_t*)(ws + W_LRI), 1024};
            pg8::TileOrder S; S.init(256, 10, G, bid);
            pg8::EpiAct E{1, ws, nullptr};
            pg8::gemm_phase<pg8::EpiAct>(lds, g, S, E);
        }
        GRID_BAR();
        DGL(dg_lruin(args, 10 * L + 2); GRID_BAR();)
        lru_phase<0>(args, lds, bid, G);
        GRID_BAR();
        lru_carry_phase(args, bid, G);
        GRID_BAR();
        lru_phase<1>(args, lds, bid, G);
        GRID_BAR();
        lru_phase<2>(args, lds, bid, G);
        GRID_BAR();
        DGL(dg_lru(args, 10 * L + 3); GRID_BAR();)
        DGL(dg_save(args, 10 * L + 4, xs); GRID_BAR();)
        {
            pg8::Gemm g{(const bf16_t*)(ws + L_HY), (const bf16_t*)(ws + W_LRO), LRUW};
            pg8::TileOrder S; S.init(256, 4, G, bid);
            pg8::EpiRes<X16> E{xs, xo, modl + 2 * 1024, 1.0f};
            pg8::gemm_phase<pg8::EpiRes<X16>>(lds, g, S, E);
        }
        GRID_BAR();
        DGL(dg_res(args, 10 * L + 4, xo, modl + 2 * 1024, (const bf16_t*)(ws + L_HY), LRUW, args.in[I_LRWOUT]); GRID_BAR();)
    }
}
template <int L>
__device__ __forceinline__ void run_ffn(const Args& args, LAS unsigned char* lds, int bid, int G, const XcdBarrier& bar) {
    unsigned char* ws = args.ws; bf16_t* xo = (bf16_t*)(ws + WS_XB);
    const float* modl = (const float*)(ws + TB_MODS) + (size_t)L * NBATCH * 6144;
    if constexpr ((L & 1) == 0) {
        constexpr int m = L >> 1;
        constexpr bool F8 = (L >= FP8_DENSE_FROM);
        norm_phase<false>(args, lds, bid, G, xo, true, xo, true, args.in[I_N2G] + L * DM, modl, 1, false, modl, false, nullptr, F8);
        GRID_BAR();
        if constexpr (F8) {
            pg8::Gemm g{(const bf16_t*)(ws + WS_HM), (const bf16_t*)(ws + W_FGU) + (size_t)m * 5632 * 1024, 512};
            pg8::TileOrder S; S.init(256, 22, G, bid);
            pg8::EpiSwiGLU8 E{ws + F_HID, DFF, 1.0f / MOE_WSCALE, MOE_HSCALE};
            pg8::gemm_phase<pg8::EpiSwiGLU8, true>(lds, g, S, E);
        } else {
            pg8::Gemm g{(const bf16_t*)(ws + WS_HM), (const bf16_t*)(ws + W_FGU) + (size_t)m * 5632 * 1024, 1024};
            pg8::TileOrder S; S.init(256, 22, G, bid);
            pg8::EpiSwiGLU E{(bf16_t*)(ws + F_HID), DFF};
            pg8::gemm_phase<pg8::EpiSwiGLU>(lds, g, S, E);
        }
        GRID_BAR();
        if constexpr (F8) {
            pg8::Gemm g{(const bf16_t*)(ws + F_HID), (const bf16_t*)(ws + W_FDN) + (size_t)m * 1024 * 2816, DFF / 2};
            pg8::TileOrder S; S.init(256, 4, G, bid);
            pg8::EpiRes<true> E{xo, xo, modl + 5 * 1024, 1.0f / (MOE_WSCALE * MOE_HSCALE)};
            pg8::gemm_phase<pg8::EpiRes<true>, true>(lds, g, S, E);
        } else {
            pg8::Gemm g{(const bf16_t*)(ws + F_HID), (const bf16_t*)(ws + W_FDN) + (size_t)m * 1024 * 2816, DFF};
            pg8::TileOrder S; S.init(256, 4, G, bid);
            pg8::EpiRes<true> E{xo, xo, modl + 5 * 1024, 1.0f};
            pg8::gemm_phase<pg8::EpiRes<true>>(lds, g, S, E);
        }
        GRID_BAR();
    } else {
        constexpr int m = L >> 1;
        norm_phase<true>(args, lds, bid, G, xo, true, xo, true, args.in[I_N2G] + L * DM, modl, 1, false, modl, false, args.in[I_MOER] + (size_t)m * DM * 8);
        GRID_BAR();
        DGL(dg_norm(args, 10 * L + 5, xo, args.in[I_N2G] + L * DM, L, 1); dg_router(args, 10 * L + 5, L); GRID_BAR();)
        place_phase(args, lds, bid, G);
        GRID_BAR();
        DGL(dg_place(args, 10 * L + 6); GRID_BAR();)
        const int* tiles = (const int*)(ws + TB_TILES);
        {
            pg8::Gemm g{(const bf16_t*)(ws + E_XS), (const bf16_t*)(ws + W_MGU + (size_t)m * 8 * 7168 * 1024), 512};
            pg8::TileOrder S; S.init(tiles[8], 28, G, bid);
#pragma unroll
            for (int e = 1; e < NEXP; ++e) S.ts[e] = tiles[e];
            pg8::EpiSwiGLU8 E{ws + E_HID, DFFE, 1.0f / MOE_WSCALE, MOE_HSCALE};
            pg8::gemm_phase<pg8::EpiSwiGLU8, true>(lds, g, S, E);
        }
        GRID_BAR();
        DGL(dg_moe_hid(args, 10 * L + 7, m); GRID_BAR();)
        {
            pg8::Gemm g{(const bf16_t*)(ws + E_HID), (const bf16_t*)(ws + W_MDN + (size_t)m * 8 * 1024 * 3584), DFFE / 2};
            pg8::TileOrder S; S.init(tiles[8], 4, G, bid);
#pragma unroll
            for (int e = 1; e < NEXP; ++e) S.ts[e] = tiles[e];
            pg8::EpiPlain E{(bf16_t*)(ws + E_XS), DM, 1.0f / (MOE_WSCALE * MOE_HSCALE)};
            pg8::gemm_phase<pg8::EpiPlain, true>(lds, g, S, E);
        }
        GRID_BAR();
        DGL(dg_moe_y(args, 10 * L + 8, m); GRID_BAR();)
    }
}
__device__ __forceinline__ void final_combine(const Args& args, LAS unsigned char* lds, int bid, int G, const XcdBarrier& bar) {
    const float* modl = (const float*)(args.ws + TB_MODS) + (size_t)3 * NBATCH * 6144;
    DG(dg_save(args, 39, args.out); GRID_BAR();)
    norm_phase<false>(args, lds, bid, G, args.ws + WS_XB, true, args.out, false, args.in[I_N1G], modl, 0, true, modl, true, nullptr);
    DG(GRID_BAR(); dg_combine(args, 39, modl);)
}

__global__ void __launch_bounds__(NTHR, 2) mega_fwd(Args args) {
    extern __shared__ __attribute__((aligned(16))) unsigned char lds_raw[];
    LAS unsigned char* lds = (LAS unsigned char*)lds_raw;
    const int tid = threadIdx.x, bid = blockIdx.x, G = gridDim.x;
    unsigned char* ws = args.ws;
    volatile LAS unsigned* MISC = (volatile LAS unsigned*)(lds + MISC_OFF);
    if (tid < 64) MISC[tid] = 0u;
    __syncthreads();
    XcdBarrier bar = xcd_barrier_post((unsigned*)(ws + WS_CTL) + CW_BAR, MISC + 8);

    prologue_phase(args, lds, bid, G);
    GRID_BAR();

    run_mixer<0>(args, lds, bid, G, bar);
    run_ffn<0>(args, lds, bid, G, bar);
    run_mixer<1>(args, lds, bid, G, bar);
    run_ffn<1>(args, lds, bid, G, bar);
    run_mixer<2>(args, lds, bid, G, bar);
    run_ffn<2>(args, lds, bid, G, bar);
    run_mixer<3>(args, lds, bid, G, bar);
    run_ffn<3>(args, lds, bid, G, bar);
    final_combine(args, lds, bid, G, bar);
    DG(GRID_BAR(); dg_final(args, 49);)
}

extern "C" void kernel_launch(void* const* d_in, const int* in_sizes, int n_in, void* d_out, int out_size, void* d_ws, size_t ws_size, hipStream_t stream) {
    static int grid = 0;
    if (grid == 0) {
        if (n_in != 30 || out_size != MTOK * DM || ws_size < WS_NEED) { fprintf(stderr, "kernel_launch: unexpected shapes (n_in %d out %d ws %zu need %zu)\n", n_in, out_size, ws_size, (size_t)WS_NEED); grid = -1; return; }
        int dev = 0, cus = 0;
        if (hipGetDevice(&dev) != hipSuccess || hipDeviceGetAttribute(&cus, hipDeviceAttributeMultiprocessorCount, dev) != hipSuccess) { grid = -1; return; }
        if (hipFuncSetAttribute((const void*)mega_fwd, hipFuncAttributeMaxDynamicSharedMemorySize, LDS_BYTES) != hipSuccess) { fprintf(stderr, "kernel_launch: hipFuncSetAttribute failed\n"); grid = -1; return; }
        int per_cu = 0;
        if (hipOccupancyMaxActiveBlocksPerMultiprocessor(&per_cu, (const void*)mega_fwd, NTHR, LDS_BYTES) != hipSuccess || per_cu < 1) { fprintf(stderr, "kernel_launch: occupancy query says %d\n", per_cu); }
        (void)hipGetLastError();
        grid = (cus >= 256) ? 256 : -1;
        if (grid < 0) { fprintf(stderr, "kernel_launch: needs 256 CUs, device has %d\n", cus); return; }
    }
    if (grid < 0) return;
    if (hipMemsetAsync((char*)d_ws + WS_CTL, 0, CTL_ZERO_BYTES, stream) != hipSuccess) return;
    Args a{};
    for (int i = 0; i < 30; ++i) a.in[i] = (const float*)d_in[i];
    a.out = (float*)d_out; a.ws = (unsigned char*)d_ws;
    hipLaunchKernelGGL(mega_fwd, dim3(grid), dim3(NTHR), LDS_BYTES, stream, a);
}
```

```cpp
#define DIAG_FROM 2
#include <hip/hip_runtime.h>
#include <cstdio>
#include <cstdint>

#define LAS __attribute__((address_space(3)))
#define GAS __attribute__((address_space(1)))
typedef unsigned short bf16_t;
typedef short bf16x8 __attribute__((ext_vector_type(8)));
typedef short s16x4 __attribute__((ext_vector_type(4)));
typedef float f32x2 __attribute__((ext_vector_type(2)));
typedef float f32x4 __attribute__((ext_vector_type(4)));
typedef float f32x16 __attribute__((ext_vector_type(16)));
typedef unsigned u32x2 __attribute__((ext_vector_type(2)));
typedef unsigned u32x4 __attribute__((ext_vector_type(4)));

constexpr int MTOK = 65536, DM = 1024, SEQ = 8192, NBATCH = 8, DEPTH = 4;
constexpr int DFF = 2816, DFFE = 3584, NEXP = 8, LRUW = 1280;
constexpr float EPS = 1e-6f;
constexpr int FP8_DENSE_FROM = 2;
constexpr float MOE_WSCALE = 64.0f, MOE_HSCALE = 4.0f;
constexpr float LOG2E = 1.4426950408889634f;

constexpr size_t MiB = 1u << 20;
constexpr size_t WS_CTL = 0, CTL_ZERO_BYTES = 1 * MiB;
constexpr size_t WS_TAB = 1 * MiB;
constexpr size_t TB_MODS = WS_TAB;
constexpr size_t TB_COS = WS_TAB + 1 * MiB;
constexpr size_t TB_SIN = WS_TAB + 2 * MiB;
constexpr size_t TB_SCAL = WS_TAB + 3 * MiB;
constexpr size_t TB_LB = TB_SCAL + 4096;
constexpr size_t TB_SP = TB_SCAL + 16384;
constexpr size_t TB_EID = WS_TAB + 4 * MiB;
constexpr size_t TB_GATE = WS_TAB + 5 * MiB;
constexpr size_t TB_SLOT = WS_TAB + 6 * MiB;
constexpr size_t TB_BCNT = WS_TAB + 7 * MiB;
constexpr size_t TB_TILES = TB_BCNT + 16384;
constexpr size_t TB_LSUM = WS_TAB + 8 * MiB;
constexpr size_t TB_LCIN = WS_TAB + 16 * MiB;
constexpr size_t WS_W = 32 * MiB;
constexpr size_t W_QKV = WS_W;
constexpr size_t W_AO = W_QKV + 2 * (size_t)3072 * 1024 * 2;
constexpr size_t W_HGI = W_AO + 2 * (size_t)1024 * 1024 * 2;
constexpr size_t W_HGO = W_HGI + (size_t)5120 * 1024 * 2;
constexpr size_t W_LRI = W_HGO + (size_t)1024 * 1024 * 2;
constexpr size_t W_LRG = W_LRI + (size_t)2560 * 1024 * 2;
constexpr size_t W_LRO = W_LRG + (size_t)10 * 2 * 256 * 128 * 2;
constexpr size_t W_FGU = W_LRO + (size_t)1024 * 1280 * 2;
constexpr size_t W_FDN = W_FGU + 2 * (size_t)5632 * 1024 * 2;
constexpr size_t W_MGU = W_FDN + 2 * (size_t)1024 * 2816 * 2;
constexpr size_t W_MDN = W_MGU + 16 * (size_t)7168 * 1024 * 2;
constexpr size_t W_END = W_MDN + 16 * (size_t)1024 * 3584 * 2;
constexpr size_t WS_HM = 440 * MiB;
constexpr size_t WS_ACT = 568 * MiB;
static_assert(W_END <= WS_HM, "weights overflow");
constexpr size_t SZ_TOK = (size_t)MTOK * 1024 * 2;
constexpr size_t A_Q = WS_ACT, A_K = A_Q + SZ_TOK, A_V = A_K + SZ_TOK, A_VT = A_V + SZ_TOK;
constexpr size_t F_HID = WS_ACT;
constexpr size_t H_Q = WS_ACT, H_LFF = H_Q + SZ_TOK, H_LFB = H_LFF + SZ_TOK, H_V = H_LFB + SZ_TOK, H_G = H_V + SZ_TOK, H_OF = H_G + SZ_TOK, H_OB = H_OF + SZ_TOK;
constexpr size_t SZ_LRU = (size_t)MTOK * 1280 * 2;
constexpr size_t L_YB = WS_ACT, L_XB = L_YB + SZ_LRU, L_HF = L_XB + SZ_LRU, L_HY = L_HF + SZ_LRU, L_U = L_HY + SZ_LRU;
constexpr int MOE_ROWS = 2 * MTOK + NEXP * 256;
constexpr size_t E_XS = WS_ACT, E_HID = E_XS + (size_t)MOE_ROWS * 1024 * 2, E_END = E_HID + (size_t)MOE_ROWS * DFFE;
constexpr size_t WS_XB = 1536 * MiB;
static_assert(E_END <= WS_XB && H_OB + SZ_TOK <= WS_XB && L_U + 2 * SZ_LRU <= WS_XB && A_VT + SZ_TOK <= WS_XB, "activation regions below the residual stream");
constexpr size_t WS_NEED = WS_XB + SZ_TOK;
static_assert(WS_NEED <= (size_t)1792 * MiB, "workspace");

constexpr int CW_BAR = 4096;

constexpr int RING_BYTES = 135168;
constexpr int MISC_OFF = RING_BYTES;
constexpr int LDS_BYTES = 147456;
constexpr int NWAVES = 8, NTHR = 512;

typedef __bf16 bf16x2v __attribute__((ext_vector_type(2)));
__device__ __forceinline__ unsigned cvt_pk_bf16(float lo, float hi) { const f32x2 v = {lo, hi}; const bf16x2v b = __builtin_convertvector(v, bf16x2v); return __builtin_bit_cast(unsigned, b); }
__device__ __forceinline__ unsigned pk_fp8x4(float a, float b, float c, float d) { unsigned w = 0; w = __builtin_amdgcn_cvt_pk_fp8_f32(a, b, w, false); w = __builtin_amdgcn_cvt_pk_fp8_f32(c, d, w, true); return w; }
__device__ __forceinline__ unsigned f2bf(float f) { unsigned u = __builtin_bit_cast(unsigned, f); return (u + 0x7fffu + ((u >> 16) & 1u)) >> 16; }
__device__ __forceinline__ float bf2f(unsigned short b) { return __builtin_bit_cast(float, ((unsigned)b) << 16); }
__device__ __forceinline__ float bflo(unsigned w) { return __builtin_bit_cast(float, w << 16); }
__device__ __forceinline__ float bfhi(unsigned w) { return __builtin_bit_cast(float, w & 0xffff0000u); }
__device__ __forceinline__ float fexp2(float x) { return __builtin_amdgcn_exp2f(x); }
__device__ __forceinline__ float fexp(float x) { return __builtin_amdgcn_exp2f(x * LOG2E); }
__device__ __forceinline__ float frcp(float x) { return __builtin_amdgcn_rcpf(x); }
__device__ __forceinline__ float fsigmoid(float x) { return frcp(1.0f + fexp(-x)); }
__device__ __forceinline__ float fsilu(float x) { return x * fsigmoid(x); }
__device__ __forceinline__ float wave_sum(float v) {
#pragma unroll
    for (int o = 1; o < 64; o <<= 1) v += __shfl_xor(v, o);
    return v;
}
#define LDS_WAIT() asm volatile("s_waitcnt lgkmcnt(0)" ::: "memory")
#define VM_WAIT() asm volatile("s_waitcnt vmcnt(0)" ::: "memory")

#define XB_TMO      128
#define XB_XCNT(j)  (256  + 64 * (j))
#define XB_XSUB(j)  (1280 + 64 * (j))
#define XB_XGEN(j)  (2304 + 64 * (j))
#define XB_TOP      3328
#define XB_TOPGEN   3392
#define XCD_BAR_WORDS 3456
#define XB_SPIN_CAP (1u << 22)
__device__ __forceinline__ unsigned xb_ld(unsigned* p)              { return __hip_atomic_load(p, __ATOMIC_RELAXED, __HIP_MEMORY_SCOPE_AGENT); }
__device__ __forceinline__ unsigned xb_add(unsigned* p, unsigned v) { return __hip_atomic_fetch_add(p, v, __ATOMIC_RELAXED, __HIP_MEMORY_SCOPE_AGENT); }
__device__ __forceinline__ unsigned xb_xcc_id() { return (unsigned)__builtin_amdgcn_s_getreg((3 << 11) | 20) & 0xFu; }
#define XB_SPIN(cond, bar) do { unsigned _sp = 0; while (cond) { __builtin_amdgcn_s_sleep(1); \
    if ((++_sp & 255u) == 0u) { if (xb_ld(&(bar)[XB_TMO])) break; if (_sp > XB_SPIN_CAP) { atomicAdd(&(bar)[XB_TMO], 1u); break; } } } } while (0)
struct XcdBarrier { unsigned* bar; unsigned x; volatile LAS unsigned* st; };
__device__ __forceinline__ XcdBarrier xcd_barrier_post(unsigned* bar, volatile LAS unsigned* st) {
    XcdBarrier b; b.bar = bar; b.x = xb_xcc_id(); b.st = st;
    if (threadIdx.x == 0) (void)xb_add(&bar[XB_XCNT(b.x)], 1u);
    return b;
}
__device__ __forceinline__ void xcd_barrier_complete(unsigned* bar, unsigned x, unsigned& nloc, unsigned& nx) {
    const unsigned G = gridDim.x * gridDim.y * gridDim.z;
    unsigned sum, cnt, mine, sp = 0u;
    for (;;) {
        sum = 0u; cnt = 0u; mine = 0u;
#pragma unroll
        for (unsigned j = 0; j < 16; ++j) { const unsigned c = xb_ld(&bar[XB_XCNT(j)]); sum += c; cnt += (c > 0u) ? 1u : 0u; mine = (j == x) ? c : mine; }
        if (sum == G) break;
        __builtin_amdgcn_s_sleep(1);
        if ((++sp & 255u) == 0u) { if (xb_ld(&bar[XB_TMO])) break; if (sp > XB_SPIN_CAP) { atomicAdd(&bar[XB_TMO], 1u); break; } }
    }
    nloc = mine > 0u ? mine : 1u; nx = cnt > 0u ? cnt : 1u;
}
__device__ __forceinline__ void xcd_barrier(const XcdBarrier& b) {
    asm volatile("s_waitcnt vmcnt(0)" ::: "memory");
    __syncthreads();
    if (threadIdx.x == 0) {
        unsigned* bar = b.bar;
        __builtin_amdgcn_s_waitcnt(0);
        unsigned nloc = b.st[0], nx = b.st[1];
        if (nloc == 0u) { xcd_barrier_complete(bar, b.x, nloc, nx); b.st[0] = nloc; b.st[1] = nx; }
        const unsigned old = xb_add(&bar[XB_XSUB(b.x)], 1u);
        const unsigned gen = old / nloc;
        if (old + 1u == (gen + 1u) * nloc) {
            __builtin_amdgcn_fence(__ATOMIC_RELEASE, "agent");
            asm volatile("s_waitcnt vmcnt(0)" ::: "memory");
            const unsigned og = xb_add(&bar[XB_TOP], 1u);
            const unsigned tg = og / nx;
            if (og + 1u == (tg + 1u) * nx) xb_add(&bar[XB_TOPGEN], 1u);
            else XB_SPIN(xb_ld(&bar[XB_TOPGEN]) == tg, bar);
            __builtin_amdgcn_fence(__ATOMIC_ACQUIRE, "agent");
            xb_add(&bar[XB_XGEN(b.x)], 1u);
            asm volatile("s_waitcnt vmcnt(0)" ::: "memory");
        } else {
            XB_SPIN(xb_ld(&bar[XB_XGEN(b.x)]) == gen, bar);
            __builtin_amdgcn_fence(__ATOMIC_ACQUIRE, "agent");
            asm volatile("s_waitcnt vmcnt(0)" ::: "memory");
        }
    }
    __syncthreads();
}

namespace pg8 {
constexpr int BM = 256, BK = 64, HALF = 128, HTB = HALF * BK * 2, STAGE_BYTES = 8 * HTB, NXCD = 8, WGM = 8;
__host__ __device__ __forceinline__ int lds_byte(int r, int c) { const int st = (r >> 4) * 2 + (c >> 5), rr = r & 15, cc = c & 31, ob = rr * 64 + cc * 2; return st * 1024 + (ob ^ (((ob >> 9) & 1) << 5)); }
__host__ __device__ __forceinline__ void stage_rc(int b, int& R, int& C) { const int st = b / 1024, sb = b % 1024, swz = sb ^ (((sb >> 9) & 1) << 5); R = (st >> 1) * 16 + swz / 64; C = (st & 1) * 32 + (swz % 64) / 2; }
__host__ __device__ __forceinline__ int perm32(int rho) { const int n = rho >> 4, i = rho & 15; return 8 * (i >> 2) + 4 * n + (i & 3); }

struct Unit { int pm, pn, pb; };
struct Gemm { const bf16_t* A; const bf16_t* Bt; int K; };

struct TileOrder {
    int nM, nN, nwg, G, c; int ts[NEXP];
    __device__ __forceinline__ void init(int nM_, int nN_, int G_, int c_) { nM = nM_; nN = nN_; nwg = nM * nN; G = G_; c = c_;
#pragma unroll
        for (int e = 0; e < NEXP; ++e) ts[e] = (e == 0) ? 0 : 0x7fffffff; }
    __device__ __forceinline__ bool next(int i, Unit& u) const {
        const long L = (long)i * G + c; if (L >= nwg) return false;
        int wgid = (int)L; { const int q = nwg / NXCD, r = nwg % NXCD, xcd = wgid % NXCD, off = wgid / NXCD; wgid = (xcd < r ? xcd * (q + 1) : r * (q + 1) + (xcd - r) * q) + off; }
        const int nig = WGM * nN, gid = wgid / nig, fm = gid * WGM, gsz = (nM - fm) < WGM ? (nM - fm) : WGM;
        u.pm = fm + ((wgid % nig) % gsz); u.pn = (wgid % nig) / gsz;
        int e = 0;
#pragma unroll
        for (int k = 1; k < NEXP; ++k) e += (u.pm >= ts[k]) ? 1 : 0;
        u.pb = e * nN + u.pn; return true;
    }
};

typedef int v8i32 __attribute__((ext_vector_type(8)));
template <class Epi, bool FP8 = false>
__device__ __forceinline__ void gemm_phase(LAS unsigned char* lds, const Gemm g, const TileOrder& S, const Epi& E) {
    int tid_ = threadIdx.x; asm volatile("" : "+v"(tid_));
    const int tid = tid_, wid = __builtin_amdgcn_readfirstlane(tid >> 6), lane = tid & 63, wr = wid >> 2, wc = wid & 3, fr = lane & 15, fq = lane >> 4;
    const int K = g.K, nt = K / BK;
    unsigned voffA[2], voffB[2];
#pragma unroll
    for (int i = 0; i < 2; ++i) { int R, C; stage_rc(tid * 16 + i * 8192, R, C); const int Rb = Epi::PERM ? ((R & ~31) + perm32(R & 31)) : R;
        voffA[i] = (unsigned)(R * K + C) * 2u; voffB[i] = (unsigned)(Rb * K + C) * 2u; }
    const size_t kstep = (size_t)(BK * 2);
    const size_t hstep = (size_t)HALF * K * 2;
    const size_t tstep = 2 * hstep;
    const unsigned ldsw = (unsigned)wid * 1024u;
    const int aoff = lds_byte(wr * 64 + fr, fq * 8), boff = lds_byte(wc * 32 + fr, fq * 8);
#define PG8_SA(b, h) (((b) * 2 + (h)) * HTB)
#define PG8_SB(b, h) ((4 + (b) * 2 + (h)) * HTB)
#define PG8_STAGE(bufoff, gbase, voff) do { _Pragma("unroll") for (int _i = 0; _i < 2; ++_i) \
        __builtin_amdgcn_global_load_lds((const unsigned*)((const char*)(gbase) + (voff)[_i]), (LAS unsigned*)(lds + (bufoff) + ldsw + _i * 8192), 16, 0, 0); } while (0)
#define PG8_LD8(p) __builtin_bit_cast(v8i32, __builtin_shufflevector(*(const LAS u32x4*)(p), *(const LAS u32x4*)((p) + 1024), 0, 1, 2, 3, 4, 5, 6, 7))
#define PG8_LDA(dst, b, h) do { if constexpr (FP8) { _Pragma("unroll") for (int m = 0; m < 4; ++m) dst##8[m] = PG8_LD8(lds + PG8_SA(b, h) + aoff + m * 2048); } \
        else { _Pragma("unroll") for (int m = 0; m < 4; ++m) _Pragma("unroll") for (int k = 0; k < 2; ++k) dst[m][k] = *(const LAS bf16x8*)(lds + PG8_SA(b, h) + aoff + m * 2048 + k * 1024); } } while (0)
#define PG8_LDB(dst, b, h) do { if constexpr (FP8) { _Pragma("unroll") for (int n = 0; n < 2; ++n) dst##8[n] = PG8_LD8(lds + PG8_SB(b, h) + boff + n * 2048); } \
        else { _Pragma("unroll") for (int n = 0; n < 2; ++n) _Pragma("unroll") for (int k = 0; k < 2; ++k) dst[n][k] = *(const LAS bf16x8*)(lds + PG8_SB(b, h) + boff + n * 2048 + k * 1024); } } while (0)
#define PG8_MMA(ai, bj, At, Bt) do { __builtin_amdgcn_s_setprio(1); \
        if constexpr (FP8) { _Pragma("unroll") for (int m = 0; m < 4; ++m) _Pragma("unroll") for (int n = 0; n < 2; ++n) \
            asm volatile("v_mfma_scale_f32_16x16x128_f8f6f4 %0, %1, %2, %0, %3, %3 op_sel_hi:[0,0,0]" : "+v"(acc[ai][bj][m][n]) : "v"(Bt##8[n]), "v"(At##8[m]), "v"(one_scale)); } \
        else { _Pragma("unroll") for (int m = 0; m < 4; ++m) _Pragma("unroll") for (int n = 0; n < 2; ++n) _Pragma("unroll") for (int k = 0; k < 2; ++k) \
            acc[ai][bj][m][n] = __builtin_amdgcn_mfma_f32_16x16x32_bf16(Bt[n][k], At[m][k], acc[ai][bj][m][n], 0, 0, 0); } \
        __builtin_amdgcn_s_setprio(0); } while (0)
#define PG8_WAIT_V(n) asm volatile("s_waitcnt vmcnt(" #n ")" ::: "memory")
#define PG8_WAIT_L(n) asm volatile("s_waitcnt lgkmcnt(" #n ")" ::: "memory")
#define PG8_BAR __builtin_amdgcn_s_barrier()
#define PG8_SCHED __builtin_amdgcn_sched_barrier(0)
    Unit cur, nxt; int ui = 0;
    if (!S.next(0, cur)) return;
    f32x4 acc[2][2][4][2];
#pragma unroll
    for (int a = 0; a < 2; ++a)
#pragma unroll
        for (int b = 0; b < 2; ++b)
#pragma unroll
            for (int m = 0; m < 4; ++m)
#pragma unroll
                for (int n = 0; n < 2; ++n) acc[a][b][m][n] = (f32x4){0.f, 0.f, 0.f, 0.f};
    bf16x8 At[4][2], B0[2][2], B1[2][2]; v8i32 At8[4], B08[2], B18[2];
    int one_scale = 0x7f7f7f7f; asm volatile("" : "+v"(one_scale));
    const char* cA = (const char*)g.A + (size_t)cur.pm * tstep; const char* cB = (const char*)g.Bt + (size_t)cur.pb * tstep;
    PG8_STAGE(PG8_SB(0, 0), cB, voffB); PG8_STAGE(PG8_SA(0, 0), cA, voffA); PG8_STAGE(PG8_SB(0, 1), cB + hstep, voffB); PG8_STAGE(PG8_SA(0, 1), cA + hstep, voffA);
    if (wr == 1) PG8_BAR;
    PG8_WAIT_V(4); PG8_BAR;
    PG8_STAGE(PG8_SB(1, 0), cB + kstep, voffB); PG8_STAGE(PG8_SA(1, 0), cA + kstep, voffA); PG8_STAGE(PG8_SB(1, 1), cB + hstep + kstep, voffB);
    PG8_WAIT_V(6); PG8_BAR;
    for (;;) {
        const bool has_next = S.next(ui + 1, nxt);
        const char* nA = has_next ? (const char*)g.A + (size_t)nxt.pm * tstep : cA; const char* nB = has_next ? (const char*)g.Bt + (size_t)nxt.pb * tstep : cB;
        for (int t = 0; t < nt; t += 2) {
            const bool last = (t == nt - 2);
            const char* a1 = cA + (size_t)(t + 1) * kstep;
            const char* a2 = last ? nA : cA + (size_t)(t + 2) * kstep; const char* b2 = last ? nB : cB + (size_t)(t + 2) * kstep;
            const char* a3 = a2 + kstep; const char* b3 = b2 + kstep;
            PG8_LDB(B0, 0, 0); PG8_SCHED; PG8_LDA(At, 0, 0); PG8_STAGE(PG8_SA(1, 1), a1 + hstep, voffA);
            PG8_WAIT_L(8); PG8_BAR; PG8_WAIT_L(0); PG8_MMA(0, 0, At, B0); PG8_BAR; PG8_SCHED;
            PG8_LDB(B1, 0, 1); PG8_STAGE(PG8_SB(0, 0), b2, voffB);
            PG8_BAR; PG8_WAIT_L(0); PG8_MMA(0, 1, At, B1); PG8_BAR;
            PG8_LDA(At, 0, 1); PG8_STAGE(PG8_SA(0, 0), a2, voffA);
            PG8_BAR; PG8_WAIT_L(0); PG8_MMA(1, 0, At, B0); PG8_BAR; PG8_SCHED;
            PG8_STAGE(PG8_SB(0, 1), b2 + hstep, voffB);
            PG8_WAIT_V(6); PG8_BAR; PG8_MMA(1, 1, At, B1); PG8_BAR;
            PG8_LDB(B0, 1, 0); PG8_SCHED; PG8_LDA(At, 1, 0); PG8_STAGE(PG8_SA(0, 1), a2 + hstep, voffA);
            PG8_WAIT_L(8); PG8_BAR; PG8_WAIT_L(0); PG8_MMA(0, 0, At, B0); PG8_BAR; PG8_SCHED;
            PG8_LDB(B1, 1, 1); PG8_STAGE(PG8_SB(1, 0), b3, voffB);
            PG8_BAR; PG8_WAIT_L(0); PG8_MMA(0, 1, At, B1); PG8_BAR;
            PG8_LDA(At, 1, 1); PG8_STAGE(PG8_SA(1, 0), a3, voffA);
            PG8_BAR; PG8_WAIT_L(0); PG8_MMA(1, 0, At, B0); PG8_BAR; PG8_SCHED;
            PG8_STAGE(PG8_SB(1, 1), b3 + hstep, voffB);
            PG8_WAIT_V(6); PG8_BAR; PG8_MMA(1, 1, At, B1); PG8_BAR;
        }
        if constexpr (FP8) asm volatile("s_nop 15\n\ts_nop 15" ::: "memory");
        E(acc, cur, wr, wc, fr, fq);
        if (!has_next) break;
#pragma unroll
        for (int a = 0; a < 2; ++a)
#pragma unroll
            for (int b = 0; b < 2; ++b)
#pragma unroll
                for (int m = 0; m < 4; ++m)
#pragma unroll
                    for (int n = 0; n < 2; ++n) acc[a][b][m][n] = (f32x4){0.f, 0.f, 0.f, 0.f};
        cur = nxt; cA = nA; cB = nB; ++ui;
    }
    PG8_WAIT_V(0);
    if (wr == 0) PG8_BAR;
    PG8_BAR;
#undef PG8_SA
#undef PG8_SB
#undef PG8_STAGE
#undef PG8_LDA
#undef PG8_LDB
#undef PG8_MMA
#undef PG8_LD8
#undef PG8_WAIT_V
#undef PG8_WAIT_L
#undef PG8_BAR
#undef PG8_SCHED
}

struct EpiQKV {
    static constexpr bool PERM = true;
    bf16_t *Q, *Kk, *V; const float *gq, *gk, *cosT, *sinT; float qscale;
    __device__ __forceinline__ void operator()(const f32x4 (&acc)[2][2][4][2], const Unit& u, int wr, int wc, int fr, int fq) const {
        const int row0 = u.pm * BM + wr * 64 + fr;
        if (u.pn >= 8) {
            const int col0 = (u.pn - 8) * BM + wc * 32 + 8 * fq;
#pragma unroll
            for (int ai = 0; ai < 2; ++ai)
#pragma unroll
                for (int m = 0; m < 4; ++m) { bf16_t* rowp = V + (size_t)(row0 + ai * HALF + m * 16) * DM + col0;
#pragma unroll
                    for (int bj = 0; bj < 2; ++bj) { const f32x4 v0 = acc[ai][bj][m][0], v1 = acc[ai][bj][m][1];
                        u32x4 w; w.x = cvt_pk_bf16(v0[0], v0[1]); w.y = cvt_pk_bf16(v0[2], v0[3]); w.z = cvt_pk_bf16(v1[0], v1[1]); w.w = cvt_pk_bf16(v1[2], v1[3]);
                        *(u32x4*)(rowp + bj * HALF) = w; } }
        } else {
            const int part = u.pn >> 2, sh = 4 * (u.pn & 3) + wc;
            bf16_t* dst = part ? Kk : Q; const float* g = part ? gk : gq; const float sc = part ? 1.0f : qscale;
            f32x4 g0[2], g1[2];
#pragma unroll
            for (int n = 0; n < 2; ++n) { g0[n] = *(const f32x4*)(g + 8 * fq + 4 * n); g1[n] = *(const f32x4*)(g + 32 + 8 * fq + 4 * n); }
#pragma unroll
            for (int ai = 0; ai < 2; ++ai)
#pragma unroll
                for (int m = 0; m < 4; ++m) {
                    const int r = row0 + ai * HALF + m * 16; const int pos = r & (SEQ - 1);
                    f32x4 x1[2], x2[2]; float ss = 0.f;
#pragma unroll
                    for (int n = 0; n < 2; ++n) { x1[n] = acc[ai][0][m][n]; x2[n] = acc[ai][1][m][n];
                        ss += (x1[n][0] * x1[n][0] + x1[n][1] * x1[n][1]) + (x1[n][2] * x1[n][2] + x1[n][3] * x1[n][3]);
                        ss += (x2[n][0] * x2[n][0] + x2[n][1] * x2[n][1]) + (x2[n][2] * x2[n][2] + x2[n][3] * x2[n][3]); }
                    ss += __shfl_xor(ss, 16); ss += __shfl_xor(ss, 32);
                    const float rstd = __builtin_amdgcn_rsqf(ss * (1.0f / 64.0f) + EPS) ;
                    unsigned char* op = (unsigned char*)dst + (size_t)r * DM + sh * 64 + 8 * fq;
                    u32x2 w1, w2;
#pragma unroll
                    for (int n = 0; n < 2; ++n) {
                        const f32x4 cs = *(const f32x4*)(cosT + pos * 32 + 8 * fq + 4 * n), sn = *(const f32x4*)(sinT + pos * 32 + 8 * fq + 4 * n);
                        const f32x4 y1 = x1[n] * rstd * g0[n], y2 = x2[n] * rstd * g1[n];
                        const f32x4 o1 = (y1 * cs - y2 * sn) * sc, o2 = (y2 * cs + y1 * sn) * sc;
                        if (n == 0) { w1.x = pk_fp8x4(o1[0], o1[1], o1[2], o1[3]); w2.x = pk_fp8x4(o2[0], o2[1], o2[2], o2[3]); }
                        else { w1.y = pk_fp8x4(o1[0], o1[1], o1[2], o1[3]); w2.y = pk_fp8x4(o2[0], o2[1], o2[2], o2[3]); }
                    }
                    *(u32x2*)(op) = w1; *(u32x2*)(op + 32) = w2;
                }
        }
    }
};
__device__ __forceinline__ f32x4 ld_x4(const void* p, size_t i, bool is16) {
    if (is16) { const u32x2 w = *(const u32x2*)((const bf16_t*)p + i); return (f32x4){bflo(w.x), bfhi(w.x), bflo(w.y), bfhi(w.y)}; }
    return *(const f32x4*)((const float*)p + i);
}
template <bool IN16>
struct EpiRes {
    static constexpr bool PERM = false;
    const void* xin; bf16_t* xout; const float* gate; float sc;
    __device__ __forceinline__ void operator()(const f32x4 (&acc)[2][2][4][2], const Unit& u, int wr, int wc, int fr, int fq) const {
        const int row0 = u.pm * BM + wr * 64 + fr, col0 = u.pn * BM + wc * 32 + 4 * fq;
        const float* gp = gate + (size_t)(u.pm >> 5) * 6144 + col0;
        f32x4 gv[2][2];
#pragma unroll
        for (int bj = 0; bj < 2; ++bj)
#pragma unroll
            for (int n = 0; n < 2; ++n) gv[bj][n] = *(const f32x4*)(gp + bj * HALF + n * 16) * sc;
#pragma unroll
        for (int ai = 0; ai < 2; ++ai)
#pragma unroll
            for (int m = 0; m < 4; ++m) { const size_t off = (size_t)(row0 + ai * HALF + m * 16) * DM + col0;
                f32x4 xv[2][2];
#pragma unroll
                for (int bj = 0; bj < 2; ++bj)
#pragma unroll
                    for (int n = 0; n < 2; ++n) xv[bj][n] = ld_x4(xin, off + bj * HALF + n * 16, IN16);
#pragma unroll
                for (int bj = 0; bj < 2; ++bj)
#pragma unroll
                    for (int n = 0; n < 2; ++n) { const f32x4 o = xv[bj][n] + gv[bj][n] * acc[ai][bj][m][n];
                        *(u32x2*)(xout + off + bj * HALF + n * 16) = (u32x2){cvt_pk_bf16(o[0], o[1]), cvt_pk_bf16(o[2], o[3])}; }
                if (m == 3) asm volatile("" ::: "memory"); }
    }
};
struct EpiSwiGLU {
    static constexpr bool PERM = true;
    bf16_t* H; int ldh;
    __device__ __forceinline__ void operator()(const f32x4 (&acc)[2][2][4][2], const Unit& u, int wr, int wc, int fr, int fq) const {
        const int row0 = u.pm * BM + wr * 64 + fr, col0 = u.pn * HALF + wc * 32 + 8 * fq;
#pragma unroll
        for (int ai = 0; ai < 2; ++ai)
#pragma unroll
            for (int m = 0; m < 4; ++m) { bf16_t* rowp = H + (size_t)(row0 + ai * HALF + m * 16) * ldh + col0;
                f32x4 v[2];
#pragma unroll
                for (int n = 0; n < 2; ++n) { const f32x4 gt = acc[ai][0][m][n], up = acc[ai][1][m][n];
#pragma unroll
                    for (int j = 0; j < 4; ++j) v[n][j] = fsilu(gt[j]) * up[j]; }
                u32x4 w; w.x = cvt_pk_bf16(v[0][0], v[0][1]); w.y = cvt_pk_bf16(v[0][2], v[0][3]); w.z = cvt_pk_bf16(v[1][0], v[1][1]); w.w = cvt_pk_bf16(v[1][2], v[1][3]);
                *(u32x4*)rowp = w; }
    }
};
struct EpiSwiGLU8 {
    static constexpr bool PERM = true;
    unsigned char* H; int ldh; float ws, hs;
    __device__ __forceinline__ void operator()(const f32x4 (&acc)[2][2][4][2], const Unit& u, int wr, int wc, int fr, int fq) const {
        const int row0 = u.pm * BM + wr * 64 + fr, col0 = u.pn * HALF + wc * 32 + 8 * fq;
#pragma unroll
        for (int ai = 0; ai < 2; ++ai)
#pragma unroll
            for (int m = 0; m < 4; ++m) { unsigned char* rowp = H + (size_t)(row0 + ai * HALF + m * 16) * ldh + col0;
                f32x4 v[2];
#pragma unroll
                for (int n = 0; n < 2; ++n) { const f32x4 gt = acc[ai][0][m][n] * ws, up = acc[ai][1][m][n] * (ws * hs);
#pragma unroll
                    for (int j = 0; j < 4; ++j) v[n][j] = fsilu(gt[j]) * up[j]; }
                *(u32x2*)rowp = (u32x2){pk_fp8x4(v[0][0], v[0][1], v[0][2], v[0][3]), pk_fp8x4(v[1][0], v[1][1], v[1][2], v[1][3])}; }
    }
};
struct EpiPlain {
    static constexpr bool PERM = true;
    bf16_t* O; int ldc; float sc;
    __device__ __forceinline__ void operator()(const f32x4 (&acc)[2][2][4][2], const Unit& u, int wr, int wc, int fr, int fq) const {
        const int row0 = u.pm * BM + wr * 64 + fr, col0 = u.pn * BM + wc * 32 + 8 * fq;
#pragma unroll
        for (int ai = 0; ai < 2; ++ai)
#pragma unroll
            for (int m = 0; m < 4; ++m) { bf16_t* rowp = O + (size_t)(row0 + ai * HALF + m * 16) * ldc + col0;
#pragma unroll
                for (int bj = 0; bj < 2; ++bj) { const f32x4 v0 = acc[ai][bj][m][0] * sc, v1 = acc[ai][bj][m][1] * sc;
                    u32x4 w; w.x = cvt_pk_bf16(v0[0], v0[1]); w.y = cvt_pk_bf16(v0[2], v0[3]); w.z = cvt_pk_bf16(v1[0], v1[1]); w.w = cvt_pk_bf16(v1[2], v1[3]);
                    *(u32x4*)(rowp + bj * HALF) = w; } }
    }
};
struct EpiAct {
    static constexpr bool PERM = true;
    int kind; unsigned char* ws; const float* lb;
    __device__ __forceinline__ void operator()(const f32x4 (&acc)[2][2][4][2], const Unit& u, int wr, int wc, int fr, int fq) const {
        const int row0 = u.pm * BM + wr * 64 + fr;
        int mode, ldc, colt; size_t boff;
        if (kind == 0) { const int grp = u.pn >> 2; colt = (u.pn & 3) * 256; ldc = 1024;
            boff = grp == 0 ? H_Q : grp == 1 ? H_LFF : grp == 2 ? H_LFB : grp == 3 ? H_V : H_G; mode = (grp == 0 || grp == 4) ? 1 : (grp == 3 ? 0 : 3); }
        else { ldc = LRUW; if (u.pn < 5) { boff = L_YB; colt = u.pn * 256; mode = 2; } else { boff = L_XB; colt = (u.pn - 5) * 256; mode = 0; } }
        bf16_t* base = (bf16_t*)(ws + boff);
        const int col0 = colt + wc * 32 + 8 * fq;
        f32x4 lbv[2][2];
        if (mode == 3) { const float* lp = lb + ((u.pn >> 2) - 1) * 1024 + col0;
#pragma unroll
            for (int bj = 0; bj < 2; ++bj)
#pragma unroll
                for (int n = 0; n < 2; ++n) lbv[bj][n] = *(const f32x4*)(lp + bj * HALF + 4 * n); }
#pragma unroll
        for (int ai = 0; ai < 2; ++ai)
#pragma unroll
            for (int m = 0; m < 4; ++m) { bf16_t* rowp = base + (size_t)(row0 + ai * HALF + m * 16) * ldc + col0;
#pragma unroll
                for (int bj = 0; bj < 2; ++bj) { f32x4 v[2]; u32x4 w;
#pragma unroll
                    for (int n = 0; n < 2; ++n) { v[n] = acc[ai][bj][m][n];
                        if (mode == 1) {
#pragma unroll
                            for (int j = 0; j < 4; ++j) v[n][j] = fsilu(v[n][j]); }
                        else if (mode == 2) {
#pragma unroll
                            for (int j = 0; j < 4; ++j) { const float x = v[n][j]; v[n][j] = x * fsigmoid(1.5957691216057308f * (x + 0.044715f * x * x * x)); } }
                        else if (mode == 3) {
#pragma unroll
                            for (int j = 0; j < 4; ++j) { const float l = lbv[bj][n][j]; const float fg = l + (1.0f - l) * fsigmoid(v[n][j]); v[n][j] = __builtin_amdgcn_logf(fg) * 0.6931471805599453f; } }
                    }
                    if (mode == 3) {
#pragma unroll
                        for (int n = 0; n < 2; ++n) { const _Float16 h0 = (_Float16)v[n][0], h1 = (_Float16)v[n][1], h2 = (_Float16)v[n][2], h3 = (_Float16)v[n][3];
                            const unsigned a = (unsigned)__builtin_bit_cast(unsigned short, h0) | ((unsigned)__builtin_bit_cast(unsigned short, h1) << 16);
                            const unsigned b = (unsigned)__builtin_bit_cast(unsigned short, h2) | ((unsigned)__builtin_bit_cast(unsigned short, h3) << 16);
                            if (n == 0) { w.x = a; w.y = b; } else { w.z = a; w.w = b; } }
                    } else { w.x = cvt_pk_bf16(v[0][0], v[0][1]); w.y = cvt_pk_bf16(v[0][2], v[0][3]); w.z = cvt_pk_bf16(v[1][0], v[1][1]); w.w = cvt_pk_bf16(v[1][2], v[1][3]); }
                    *(u32x4*)(rowp + bj * HALF) = w; } }
    }
};
}

struct Args { const float* in[30]; float* out; unsigned char* ws; };
enum { I_X = 0, I_C, I_ADAW, I_ADAB, I_N1G, I_N2G, I_ATWIN, I_ATQN, I_ATKN, I_ATLAM, I_ATSUB, I_ATWOUT, I_HGWIN, I_HGLB, I_HGNG, I_HGWOUT,
       I_LRWIN, I_LRCW, I_LRCB, I_LRWA, I_LRBA, I_LRWX, I_LRBX, I_LRLAM, I_LRWOUT, I_FFGU, I_FFDN, I_MOER, I_MOEGU, I_MOEDN };
enum { SC_LAM0 = 0, SC_LAM1, SC_OML0, SC_OML1, SC_MC0, SC_MC1 };

__device__ __forceinline__ void cvt_item(const float* W, int ldw, int src_col0, bf16_t* WT, int ldt, int dst_row0, int k0, LAS float* scr, int lane) {
#pragma unroll 8
    for (int i = 0; i < 32; ++i) { const int kk = 2 * i + (lane >> 5); scr[kk * 33 + (lane & 31)] = W[(size_t)(k0 + kk) * ldw + src_col0 + (lane & 31)]; }
    LDS_WAIT(); asm volatile("" ::: "memory");
    const int c = lane & 7;
#pragma unroll
    for (int j = 0; j < 4; ++j) { const int n = (lane >> 3) + 8 * j; const LAS float* s = scr + (8 * c) * 33 + n;
        u32x4 o; o.x = cvt_pk_bf16(s[0 * 33], s[1 * 33]); o.y = cvt_pk_bf16(s[2 * 33], s[3 * 33]); o.z = cvt_pk_bf16(s[4 * 33], s[5 * 33]); o.w = cvt_pk_bf16(s[6 * 33], s[7 * 33]);
        *(u32x4*)(WT + (size_t)(dst_row0 + n) * ldt + k0 + 8 * c) = o; }
    LDS_WAIT(); asm volatile("" ::: "memory");
}
__device__ __forceinline__ void cvt_item8(const float* W, int ldw, int src_col0, unsigned char* WT, int ldt, int dst_row0, int k0, float sc, LAS float* scr, int lane) {
#pragma unroll 8
    for (int i = 0; i < 32; ++i) { const int kk = 2 * i + (lane >> 5); scr[kk * 33 + (lane & 31)] = W[(size_t)(k0 + kk) * ldw + src_col0 + (lane & 31)]; }
    LDS_WAIT(); asm volatile("" ::: "memory");
    const int c = lane & 7;
#pragma unroll
    for (int j = 0; j < 4; ++j) { const int n = (lane >> 3) + 8 * j; const LAS float* s = scr + (8 * c) * 33 + n;
        *(u32x2*)(WT + (size_t)(dst_row0 + n) * ldt + k0 + 8 * c) = (u32x2){pk_fp8x4(s[0 * 33] * sc, s[1 * 33] * sc, s[2 * 33] * sc, s[3 * 33] * sc), pk_fp8x4(s[4 * 33] * sc, s[5 * 33] * sc, s[6 * 33] * sc, s[7 * 33] * sc)}; }
    LDS_WAIT(); asm volatile("" ::: "memory");
}
enum { MAP_ID = 0, MAP_QKV = 1, MAP_SWI = 2 };
template <bool F8 = false>
__device__ __forceinline__ void cvt_family(const float* src, size_t sstride, int ninst, int ldw, int K, int ng, int map, int F, bf16_t* dst, size_t dstride,
                                           LAS float* scr, int gw, int NGW, int lane) {
    const int nkb = K / 64, per = nkb * ng, total = ninst * per;
    for (int it = gw; it < total; it += NGW) {
        const int inst = it / per, r = it - inst * per, kb = r / ng, gi = r - kb * ng;
        int sc0;
        if (map == MAP_ID) sc0 = 32 * gi;
        else if (map == MAP_QKV) { const int pn = gi >> 3, bj = (gi >> 2) & 1, wc = gi & 3;
            if (pn < 8) { const int part = pn >> 2, sh = 4 * (pn & 3) + wc; sc0 = part * 1024 + sh * 64 + 32 * bj; } else sc0 = 32 * gi; }
        else { const int pn = gi >> 3, bj = (gi >> 2) & 1, q = gi & 3; sc0 = bj * F + pn * 128 + 32 * q; }
        if constexpr (F8) cvt_item8(src + (size_t)inst * sstride, ldw, sc0, (unsigned char*)dst + (size_t)inst * dstride, K, 32 * gi, 64 * kb, MOE_WSCALE, scr, lane);
        else cvt_item(src + (size_t)inst * sstride, ldw, sc0, dst + (size_t)inst * dstride, K, 32 * gi, 64 * kb, scr, lane);
    }
}

__device__ __forceinline__ void prologue_phase(const Args& A, LAS unsigned char* lds, int bid, int G) {
    const int tid = threadIdx.x, lane = tid & 63, wave = tid >> 6;
    unsigned char* ws = A.ws;
    {
        LAS float* sc = (LAS float*)lds;
        LAS float* red = (LAS float*)(lds + 32768);
        for (int i = tid; i < NBATCH * DM; i += NTHR) { const float cv = A.in[I_C][i]; sc[i] = fsilu(cv); }
        __syncthreads();
        float* mods = (float*)(ws + TB_MODS);
        for (int cb = bid; cb < (DEPTH * 6144) / 128; cb += G) {
            const int col = cb * 128 + (tid & 127), l = col / 6144, e = col - l * 6144, ch = tid >> 7;
            const float* wp = A.in[I_ADAW] + (size_t)l * DM * 6144 + e;
            float a[NBATCH];
#pragma unroll
            for (int b = 0; b < NBATCH; ++b) a[b] = 0.f;
#pragma unroll 4
            for (int d = ch * 256; d < ch * 256 + 256; ++d) { const float w = wp[(size_t)d * 6144];
#pragma unroll
                for (int b = 0; b < NBATCH; ++b) a[b] += sc[b * DM + d] * w; }
#pragma unroll
            for (int b = 0; b < NBATCH; ++b) red[(ch * 128 + (tid & 127)) * 8 + b] = a[b];
            __syncthreads();
            if (tid < 128) { const float bias = A.in[I_ADAB][l * 6144 + e];
#pragma unroll
                for (int b = 0; b < NBATCH; ++b) { const float s = ((red[(0 * 128 + tid) * 8 + b] + red[(1 * 128 + tid) * 8 + b]) + (red[(2 * 128 + tid) * 8 + b] + red[(3 * 128 + tid) * 8 + b])) + bias;
                    mods[((size_t)l * NBATCH + b) * 6144 + e] = s; } }
            __syncthreads();
        }
    }
    {
        float* cosT = (float*)(ws + TB_COS); float* sinT = (float*)(ws + TB_SIN);
        for (int i = bid * NTHR + tid; i < SEQ * 32; i += G * NTHR) {
            const int pos = i >> 5, d = i & 31;
            const float inv = (float)exp(-(double)d * (1.0 / 32.0) * 9.210340371976184);
            const float ang = (float)pos * inv;
            const double rev = (double)ang * 0.15915494309189535; const float fr = (float)(rev - floor(rev));
            cosT[i] = __builtin_amdgcn_cosf(fr); sinT[i] = __builtin_amdgcn_sinf(fr);
        }
        if (bid == 0 && tid < 2) {
            const int a = tid; const float* lm = A.in[I_ATLAM] + a * 256;
            float s1 = 0.f, s2 = 0.f; for (int i = 0; i < 64; ++i) { s1 += lm[i] * lm[64 + i]; s2 += lm[128 + i] * lm[192 + i]; }
            const float linit = 0.8f - 0.6f * expf(-0.3f * (float)(3 * a));
            float mq = 0.f, mk = 0.f; for (int i = 0; i < 64; ++i) { mq = fmaxf(mq, fabsf(A.in[I_ATQN][a * 64 + i])); mk = fmaxf(mk, fabsf(A.in[I_ATKN][a * 64 + i])); }
            float* scal = (float*)(ws + TB_SCAL);
            scal[SC_LAM0 + a] = expf(s1) - expf(s2) + linit; scal[SC_OML0 + a] = 1.0f - linit; scal[SC_MC0 + a] = 8.0f * mq * mk * LOG2E * 1.0001f;
        }
        if (bid == 1) {
            float* lb = (float*)(ws + TB_LB);
            for (int i = tid; i < 2 * 1024; i += NTHR) { const int d = i >> 10, k = i & 1023; const float* p = A.in[I_HGLB] + (size_t)d * DEPTH * 1024 + k;
                float mx = p[0]; for (int l = 1; l < DEPTH; ++l) mx = fmaxf(mx, p[l * 1024]);
                float den = 0.f, num = 0.f; for (int l = 0; l < DEPTH; ++l) { const float e = expf(p[l * 1024] - mx); den += e; if (l == 1) num += e; }
                lb[i] = num / den; }
        }
        if (bid == 2) {
            float* sp = (float*)(ws + TB_SP);
            for (int i = tid; i < 2 * LRUW; i += NTHR) { const float x = -A.in[I_LRLAM][i]; sp[i] = (x > 20.f) ? x : log1pf(expf(x)); }
        }
    }
    {
        LAS float* scr = (LAS float*)(lds + wave * 16384);
        const int vcu = (bid % 8) * (G / 8) + bid / 8;
        const int gw = vcu * NWAVES + wave, NGW = G * NWAVES;
        cvt_family(A.in[I_ATWIN], (size_t)1024 * 3072, 2, 3072, 1024, 96, MAP_QKV, 0, (bf16_t*)(ws + W_QKV), (size_t)3072 * 1024, scr, gw, NGW, lane);
        cvt_family(A.in[I_ATWOUT], (size_t)1024 * 1024, 2, 1024, 1024, 32, MAP_ID, 0, (bf16_t*)(ws + W_AO), (size_t)1024 * 1024, scr, gw, NGW, lane);
        cvt_family(A.in[I_HGWIN], 0, 1, 5120, 1024, 160, MAP_ID, 0, (bf16_t*)(ws + W_HGI), 0, scr, gw, NGW, lane);
        cvt_family(A.in[I_HGWOUT], 0, 1, 1024, 1024, 32, MAP_ID, 0, (bf16_t*)(ws + W_HGO), 0, scr, gw, NGW, lane);
        cvt_family(A.in[I_LRWIN], 0, 1, 2560, 1024, 80, MAP_ID, 0, (bf16_t*)(ws + W_LRI), 0, scr, gw, NGW, lane);
        cvt_family(A.in[I_LRWOUT], 0, 1, 1024, 1280, 32, MAP_ID, 0, (bf16_t*)(ws + W_LRO), 0, scr, gw, NGW, lane);
        for (int it = gw; it < 2 * 20 * 2 * 4; it += NGW) {
            const int part = it / 160, r = it % 160, inst = r >> 3, kb = (r >> 2) & 1, gi = r & 3, d = inst / 10, n = inst % 10;
            const float* src = (part ? A.in[I_LRWX] : A.in[I_LRWA]) + (size_t)inst * 16384;
            cvt_item(src, 128, 32 * gi, (bf16_t*)(ws + W_LRG) + (size_t)(n * 2 + d) * 256 * 128, 128, part * 128 + 32 * gi, 64 * kb, scr, lane);
        }
        static_assert(FP8_DENSE_FROM == 2 || FP8_DENSE_FROM > 3, "dense layer 0 stays bf16; layer 2 optional");
        constexpr int NB16 = (FP8_DENSE_FROM == 2) ? 1 : 2;
        cvt_family(A.in[I_FFGU], (size_t)1024 * 5632, NB16, 5632, 1024, 176, MAP_SWI, DFF, (bf16_t*)(ws + W_FGU), (size_t)5632 * 1024, scr, gw, NGW, lane);
        cvt_family(A.in[I_FFDN], (size_t)2816 * 1024, NB16, 1024, 2816, 32, MAP_ID, 0, (bf16_t*)(ws + W_FDN), (size_t)1024 * 2816, scr, gw, NGW, lane);
        if constexpr (NB16 == 1) {
            cvt_family<true>(A.in[I_FFGU] + (size_t)1024 * 5632, 0, 1, 5632, 1024, 176, MAP_SWI, DFF, (bf16_t*)(ws + W_FGU) + (size_t)5632 * 1024, 0, scr, gw, NGW, lane);
            cvt_family<true>(A.in[I_FFDN] + (size_t)2816 * 1024, 0, 1, 1024, 2816, 32, MAP_ID, 0, (bf16_t*)(ws + W_FDN) + (size_t)1024 * 2816, 0, scr, gw, NGW, lane);
        }
        cvt_family<true>(A.in[I_MOEGU], (size_t)1024 * 7168, 16, 7168, 1024, 224, MAP_SWI, DFFE, (bf16_t*)(ws + W_MGU), (size_t)7168 * 1024, scr, gw, NGW, lane);
        cvt_family<true>(A.in[I_MOEDN], (size_t)3584 * 1024, 16, 1024, 3584, 32, MAP_ID, 0, (bf16_t*)(ws + W_MDN), (size_t)1024 * 3584, scr, gw, NGW, lane);
    }
}

template <bool ROUTER>
__device__ __forceinline__ void norm_phase(const Args& A, LAS unsigned char* lds, int bid, int G, const void* xsrc, bool src16, void* xdst, bool dst16, const float* gain, const float* modl  , int which,
                                           bool combine, const float* modprev  , bool nonorm, const float* router, bool f8out = false) {
    int tid_ = threadIdx.x; asm volatile("" : "+v"(tid_));
    const int tid = tid_, lane = tid & 63, wave = tid >> 6;
    unsigned char* ws = A.ws;
    bf16_t* HM = (bf16_t*)(ws + WS_HM);
    const int* slot = (const int*)(ws + TB_SLOT); const float* gts = (const float*)(ws + TB_GATE);
    const bf16_t* Y = (const bf16_t*)(ws + E_XS);
    LAS int* hist = (LAS int*)lds;
    for (int tb = bid; tb < MTOK / 256; tb += G) {
        const int b = tb >> 5;
        f32x4 ga[4], sh[4], g2[4];
#pragma unroll
        for (int j = 0; j < 4; ++j) { const int c = 256 * j + 4 * lane;
            if (!nonorm) { const f32x4 gv = *(const f32x4*)(gain + c), sv = *(const f32x4*)(modl + (size_t)b * 6144 + (which * 3 + 1) * 1024 + c);
                ga[j] = gv * (sv + 1.0f); sh[j] = *(const f32x4*)(modl + (size_t)b * 6144 + (which * 3) * 1024 + c); }
            if (combine) g2[j] = *(const f32x4*)(modprev + (size_t)b * 6144 + 5 * 1024 + c); }
        f32x4 rw[ROUTER ? 32 : 1];
        if constexpr (ROUTER) {
            if (tid < 8) hist[tid] = 0;
#pragma unroll
            for (int j = 0; j < 4; ++j)
#pragma unroll
                for (int i = 0; i < 4; ++i) { const int c = 256 * j + 4 * lane + i; rw[(j * 4 + i) * 2] = *(const f32x4*)(router + c * 8); rw[(j * 4 + i) * 2 + 1] = *(const f32x4*)(router + c * 8 + 4); }
            __syncthreads();
        }
        for (int i = 0; i < 32; ++i) {
            const int row = tb * 256 + wave * 32 + i;
            f32x4 v[4];
#pragma unroll
            for (int j = 0; j < 4; ++j) v[j] = pg8::ld_x4(xsrc, (size_t)row * DM + 256 * j + 4 * lane, src16);
            if (combine) {
                const int s0 = slot[row * 2], s1 = slot[row * 2 + 1]; const float w0 = gts[row * 2], w1 = gts[row * 2 + 1];
#pragma unroll
                for (int j = 0; j < 4; ++j) { const u32x2 a = *(const u32x2*)(Y + (size_t)s0 * DM + 256 * j + 4 * lane), c2 = *(const u32x2*)(Y + (size_t)s1 * DM + 256 * j + 4 * lane);
                    f32x4 y; y[0] = w0 * bflo(a.x) + w1 * bflo(c2.x); y[1] = w0 * bfhi(a.x) + w1 * bfhi(c2.x); y[2] = w0 * bflo(a.y) + w1 * bflo(c2.y); y[3] = w0 * bfhi(a.y) + w1 * bfhi(c2.y);
                    v[j] = v[j] + g2[j] * y;
                    if (dst16) *(u32x2*)((bf16_t*)xdst + (size_t)row * DM + 256 * j + 4 * lane) = (u32x2){cvt_pk_bf16(v[j][0], v[j][1]), cvt_pk_bf16(v[j][2], v[j][3])};
                    else *(f32x4*)((float*)xdst + (size_t)row * DM + 256 * j + 4 * lane) = v[j]; }
            }
            if (nonorm) continue;
            float ss = 0.f;
#pragma unroll
            for (int j = 0; j < 4; ++j) ss += (v[j][0] * v[j][0] + v[j][1] * v[j][1]) + (v[j][2] * v[j][2] + v[j][3] * v[j][3]);
            ss = wave_sum(ss);
            const float rstd = 1.0f / sqrtf(ss * (1.0f / DM) + EPS);
            f32x4 h[4];
#pragma unroll
            for (int j = 0; j < 4; ++j) { h[j] = v[j] * rstd * ga[j] + sh[j];
                if (f8out) { *(unsigned*)((unsigned char*)HM + (size_t)row * DM + 256 * j + 4 * lane) = pk_fp8x4(h[j][0], h[j][1], h[j][2], h[j][3]); }
                else { u32x2 w; w.x = cvt_pk_bf16(h[j][0], h[j][1]); w.y = cvt_pk_bf16(h[j][2], h[j][3]);
                    *(u32x2*)(HM + (size_t)row * DM + 256 * j + 4 * lane) = w; } }
            if constexpr (ROUTER) {
                float lg[8];
#pragma unroll
                for (int e = 0; e < 8; ++e) lg[e] = 0.f;
#pragma unroll
                for (int j = 0; j < 4; ++j)
#pragma unroll
                    for (int q = 0; q < 4; ++q) { const float hv = h[j][q]; const f32x4 r0 = rw[(j * 4 + q) * 2], r1 = rw[(j * 4 + q) * 2 + 1];
                        lg[0] += hv * r0[0]; lg[1] += hv * r0[1]; lg[2] += hv * r0[2]; lg[3] += hv * r0[3]; lg[4] += hv * r1[0]; lg[5] += hv * r1[1]; lg[6] += hv * r1[2]; lg[7] += hv * r1[3]; }
#pragma unroll
                for (int e = 0; e < 8; ++e) lg[e] = wave_sum(lg[e]);
                int e0 = 0; float v0 = lg[0];
#pragma unroll
                for (int e = 1; e < 8; ++e) if (lg[e] > v0) { v0 = lg[e]; e0 = e; }
                int e1 = -1; float v1 = -3.0e38f;
#pragma unroll
                for (int e = 0; e < 8; ++e) if (e != e0 && lg[e] > v1) { v1 = lg[e]; e1 = e; }
                const float p1 = frcp(1.0f + fexp(v1 - v0));
                if (lane == 0) { int* eid = (int*)(ws + TB_EID); float* gt = (float*)(ws + TB_GATE);
                    eid[row * 2] = e0; eid[row * 2 + 1] = e1; gt[row * 2] = p1; gt[row * 2 + 1] = 1.0f - p1;
                    atomicAdd((int*)&hist[e0], 1); atomicAdd((int*)&hist[e1], 1); }
            }
        }
        if constexpr (ROUTER) {
            __syncthreads();
            if (tid < 8) ((int*)(ws + TB_BCNT))[tb * 8 + tid] = hist[tid];
            __syncthreads();
        }
    }
}

namespace lru {
constexpr int XCF = 0, XCB = 16384, AA = 24576, UU = 40960, LAA = 57344;
__device__ __forceinline__ int sw256(int row, int cb) { return row * 256 + (cb ^ ((row & 15) << 4)); }
__device__ __forceinline__ int crow(int r, int hi) { return (r & 3) + 8 * (r >> 2) + 4 * hi; }
template <int MODE>
__device__ __forceinline__ void lru_item(const Args& A, LAS unsigned char* lds, int b, int n, int seg, int dir) {
    int tid_ = threadIdx.x; asm volatile("" : "+v"(tid_));
    const int tid = tid_, wid = tid >> 6, lane = tid & 63, r = lane & 31, hh = lane >> 5;
    unsigned char* ws = A.ws;
    const bf16_t* XB = (const bf16_t*)(ws + L_XB); const bf16_t* YB = (const bf16_t*)(ws + L_YB); bf16_t* HF = (bf16_t*)(ws + L_HF); bf16_t* HY = (bf16_t*)(ws + L_HY);
    bf16_t* LAg = (bf16_t*)(ws + (dir ? L_HY : L_HF)); bf16_t* Ug = (bf16_t*)(ws + L_U + (size_t)dir * SZ_LRU);
    const int ct = tid >> 4, cg = tid & 15, cc0 = n * 128 + 8 * cg;
    float carry = 0.f, P = 1.f;
    if (MODE != 0 && tid < 128) carry = ((const float*)(ws + TB_LCIN))[(size_t)((b * 32 + seg) * 2 + dir) * LRUW + n * 128 + tid];
    if constexpr (MODE == 0) {
        const bf16_t* Wg = (const bf16_t*)(ws + W_LRG) + (size_t)((n * 2 + dir) * 256 + ((r < 16) ? (16 * wid + r) : (128 + 16 * wid + r - 16))) * 128 + 8 * hh;
        bf16x8 bfrag[8];
#pragma unroll
        for (int ks = 0; ks < 8; ++ks) bfrag[ks] = *(const bf16x8*)(Wg + 16 * ks);
        const int cch = n * 128 + 16 * wid + (r & 15);
        const float nba = -LOG2E * A.in[I_LRBA][dir * LRUW + cch], nbx = -LOG2E * A.in[I_LRBX][dir * LRUW + cch], csp = -8.0f * LOG2E * ((const float*)(ws + TB_SP))[dir * LRUW + cch];
        float cw[4][8], cb[8];
#pragma unroll
        for (int j = 0; j < 8; ++j) { cb[j] = A.in[I_LRCB][cc0 + j];
#pragma unroll
            for (int w = 0; w < 4; ++w) cw[w][j] = A.in[I_LRCW][w * LRUW + cc0 + j]; }
        u32x4 xr[4];
#define LRU_XLOAD(si_) do { const int sub_ = dir ? (7 - (si_)) : (si_); const int tok_ = seg * 256 + sub_ * 32 + ct; \
        _Pragma("unroll") for (int w = 0; w < 4; ++w) { const int tt = tok_ - 1 + w; xr[w] = (tt >= 0 && tt < SEQ) ? *(const u32x4*)(XB + ((size_t)b * SEQ + tt) * LRUW + cc0) : (u32x4){0u, 0u, 0u, 0u}; } } while (0)
        LRU_XLOAD(0);
        for (int si = 0; si < 8; ++si) {
            const int sub = dir ? (7 - si) : si; const int t0 = seg * 256 + sub * 32;
            {
                float xc[8];
#pragma unroll
                for (int j = 0; j < 8; ++j) xc[j] = cb[j];
#pragma unroll
                for (int w = 0; w < 4; ++w) { const u32x4 v = xr[w];
#pragma unroll
                    for (int e = 0; e < 4; ++e) { xc[2 * e] += cw[w][2 * e] * bflo(v[e]); xc[2 * e + 1] += cw[w][2 * e + 1] * bfhi(v[e]); } }
                if (si + 1 < 8) LRU_XLOAD(si + 1);
                *(LAS f32x4*)(lds + XCF + (ct * 128 + 8 * cg) * 4) = (f32x4){xc[0], xc[1], xc[2], xc[3]};
                *(LAS f32x4*)(lds + XCF + (ct * 128 + 8 * cg + 4) * 4) = (f32x4){xc[4], xc[5], xc[6], xc[7]};
                *(LAS u32x4*)(lds + XCB + sw256(ct, 16 * cg)) = (u32x4){cvt_pk_bf16(xc[0], xc[1]), cvt_pk_bf16(xc[2], xc[3]), cvt_pk_bf16(xc[4], xc[5]), cvt_pk_bf16(xc[6], xc[7])};
            }
            __syncthreads();
            {
                f32x16 acc = {};
#pragma unroll
                for (int ks = 0; ks < 8; ++ks) { const bf16x8 fa = *(const LAS bf16x8*)(lds + XCB + sw256(r, (16 * ks + 8 * hh) * 2)); acc = __builtin_amdgcn_mfma_f32_32x32x16_bf16(fa, bfrag[ks], acc, 0, 0, 0); }
#pragma unroll
                for (int q = 0; q < 8; ++q) {
                    const auto sw = __builtin_amdgcn_permlane16_swap(__float_as_uint(acc[q]), __float_as_uint(acc[8 + q]), false, false);
                    const float rp = __uint_as_float(sw[0]), ip = __uint_as_float(sw[1]);
                    const int tq = crow((r < 16) ? q : (8 + q), hh); const int cl = 16 * wid + (r & 15);
                    const float xcv = ((const LAS float*)(lds + XCF))[tq * 128 + cl];
                    const float rg = frcp(1.0f + fexp2(fmaf(rp, -LOG2E, nba))), ig = frcp(1.0f + fexp2(fmaf(ip, -LOG2E, nbx)));
                    const float la = csp * rg, av = fexp2(la), uv = __builtin_amdgcn_sqrtf(fmaxf(fmaf(-av, av, 1.0f), 0.f)) * ig * xcv;
                    ((LAS float*)(lds + AA))[tq * 128 + cl] = av; ((LAS float*)(lds + UU))[tq * 128 + cl] = uv; ((LAS float*)(lds + LAA))[tq * 128 + cl] = la; }
            }
            __syncthreads();
            if (tid < 128) {
                LAS float* ap = (LAS float*)(lds + AA) + tid; LAS float* up = (LAS float*)(lds + UU) + tid; float av[32], uv[32];
#pragma unroll
                for (int i = 0; i < 32; ++i) { av[i] = ap[i * 128]; uv[i] = up[i * 128]; }
                if (dir == 0) {
#pragma unroll
                    for (int i = 0; i < 32; ++i) { carry = av[i] * carry + uv[i]; P *= av[i]; } }
                else {
#pragma unroll
                    for (int i = 31; i >= 0; --i) { carry = av[i] * carry + uv[i]; P *= av[i]; } }
            } else if (tid >= 256) {
                const int t2 = tid - 256, row = t2 >> 3, c16 = (t2 & 7) * 16; const size_t go = ((size_t)b * SEQ + t0 + row) * LRUW + n * 128 + c16;
                const LAS float* lp = (const LAS float*)(lds + LAA) + row * 128 + c16; const LAS float* up = (const LAS float*)(lds + UU) + row * 128 + c16;
                f32x4 l[4], u[4];
#pragma unroll
                for (int j = 0; j < 4; ++j) { l[j] = *(const LAS f32x4*)(lp + 4 * j); u[j] = *(const LAS f32x4*)(up + 4 * j); }
#pragma unroll
                for (int j = 0; j < 2; ++j) {
                    *(u32x4*)(LAg + go + 8 * j) = (u32x4){cvt_pk_bf16(l[2 * j][0], l[2 * j][1]), cvt_pk_bf16(l[2 * j][2], l[2 * j][3]), cvt_pk_bf16(l[2 * j + 1][0], l[2 * j + 1][1]), cvt_pk_bf16(l[2 * j + 1][2], l[2 * j + 1][3])};
                    *(u32x4*)(Ug + go + 8 * j) = (u32x4){cvt_pk_bf16(u[2 * j][0], u[2 * j][1]), cvt_pk_bf16(u[2 * j][2], u[2 * j][3]), cvt_pk_bf16(u[2 * j + 1][0], u[2 * j + 1][1]), cvt_pk_bf16(u[2 * j + 1][2], u[2 * j + 1][3])}; }
            }
            __syncthreads();
        }
#undef LRU_XLOAD
        if (tid < 128) { float* sm = (float*)(ws + TB_LSUM) + (size_t)(((b * 32 + seg) * 2 + dir) * 2) * LRUW + n * 128 + tid; sm[0] = P; sm[LRUW] = carry; }
    } else {
        u32x4 lr, ur;
#define LRU_GLOAD(si_) do { const int sub_ = dir ? (7 - (si_)) : (si_); const size_t go_ = ((size_t)b * SEQ + seg * 256 + sub_ * 32 + ct) * LRUW + cc0; \
        lr = *(const u32x4*)(LAg + go_); ur = *(const u32x4*)(Ug + go_); } while (0)
        LRU_GLOAD(0);
        for (int si = 0; si < 8; ++si) {
            const int sub = dir ? (7 - si) : si; const int t0 = seg * 256 + sub * 32;
            {   const u32x4 l = lr, u = ur;
                if (si + 1 < 8) LRU_GLOAD(si + 1);
                *(LAS f32x4*)(lds + AA + (ct * 128 + 8 * cg) * 4) = (f32x4){fexp2(bflo(l[0])), fexp2(bfhi(l[0])), fexp2(bflo(l[1])), fexp2(bfhi(l[1]))};
                *(LAS f32x4*)(lds + AA + (ct * 128 + 8 * cg + 4) * 4) = (f32x4){fexp2(bflo(l[2])), fexp2(bfhi(l[2])), fexp2(bflo(l[3])), fexp2(bfhi(l[3]))};
                *(LAS f32x4*)(lds + UU + (ct * 128 + 8 * cg) * 4) = (f32x4){bflo(u[0]), bfhi(u[0]), bflo(u[1]), bfhi(u[1])};
                *(LAS f32x4*)(lds + UU + (ct * 128 + 8 * cg + 4) * 4) = (f32x4){bflo(u[2]), bfhi(u[2]), bflo(u[3]), bfhi(u[3])}; }
            __syncthreads();
            if (tid < 128) {
                LAS float* ap = (LAS float*)(lds + AA) + tid; LAS float* up = (LAS float*)(lds + UU) + tid; float av[32], uv[32];
#pragma unroll
                for (int i = 0; i < 32; ++i) { av[i] = ap[i * 128]; uv[i] = up[i * 128]; }
                if (dir == 0) {
#pragma unroll
                    for (int i = 0; i < 32; ++i) { carry = av[i] * carry + uv[i]; uv[i] = carry; } }
                else {
#pragma unroll
                    for (int i = 31; i >= 0; --i) { carry = av[i] * carry + uv[i]; uv[i] = carry; } }
#pragma unroll
                for (int i = 0; i < 32; ++i) up[i * 128] = uv[i];
            }
            __syncthreads();
            {   const int tok = t0 + ct; const size_t go = ((size_t)b * SEQ + tok) * LRUW + cc0;
                const f32x4 h0 = *(const LAS f32x4*)(lds + UU + (ct * 128 + 8 * cg) * 4), h1 = *(const LAS f32x4*)(lds + UU + (ct * 128 + 8 * cg + 4) * 4);
                if (MODE == 1) { *(u32x4*)(HF + go) = (u32x4){cvt_pk_bf16(h0[0], h0[1]), cvt_pk_bf16(h0[2], h0[3]), cvt_pk_bf16(h1[0], h1[1]), cvt_pk_bf16(h1[2], h1[3])}; }
                else { const u32x4 f = *(const u32x4*)(HF + go), y = *(const u32x4*)(YB + go);
                    *(u32x4*)(HY + go) = (u32x4){cvt_pk_bf16((h0[0] + bflo(f[0])) * bflo(y[0]), (h0[1] + bfhi(f[0])) * bfhi(y[0])), cvt_pk_bf16((h0[2] + bflo(f[1])) * bflo(y[1]), (h0[3] + bfhi(f[1])) * bfhi(y[1])),
                                                cvt_pk_bf16((h1[0] + bflo(f[2])) * bflo(y[2]), (h1[1] + bfhi(f[2])) * bfhi(y[2])), cvt_pk_bf16((h1[2] + bflo(f[3])) * bflo(y[3]), (h1[3] + bfhi(f[3])) * bfhi(y[3]))}; }
            }
            __syncthreads();
        }
#undef LRU_GLOAD
    }
}
__device__ __forceinline__ void lru_apply_item(const Args& A, LAS unsigned char* lds, int b, int n, int seg) {
    constexpr int HFL = 57344;
    int tid_ = threadIdx.x; asm volatile("" : "+v"(tid_));
    const int tid = tid_;
    unsigned char* ws = A.ws;
    const bf16_t* YB = (const bf16_t*)(ws + L_YB); bf16_t* HY = (bf16_t*)(ws + L_HY);
    const int ct = tid >> 4, cg = tid & 15, cc0 = n * 128 + 8 * cg;
#pragma unroll 1
    for (int dir = 0; dir < 2; ++dir) {
        const bf16_t* LAg = (const bf16_t*)(ws + (dir ? L_HY : L_HF)); const bf16_t* Ug = (const bf16_t*)(ws + L_U + (size_t)dir * SZ_LRU);
        float carry = 0.f;
        if (tid < 128) carry = ((const float*)(ws + TB_LCIN))[(size_t)((b * 32 + seg) * 2 + dir) * LRUW + n * 128 + tid];
        u32x4 lr, ur, yr = {0u, 0u, 0u, 0u};
#define LRU_GLOAD(si_) do { const int sub_ = dir ? (7 - (si_)) : (si_); const size_t go_ = ((size_t)b * SEQ + seg * 256 + sub_ * 32 + ct) * LRUW + cc0; \
        lr = *(const u32x4*)(LAg + go_); ur = *(const u32x4*)(Ug + go_); if (dir) yr = *(const u32x4*)(YB + go_); } while (0)
        LRU_GLOAD(0);
        for (int si = 0; si < 8; ++si) {
            const int sub = dir ? (7 - si) : si; const int t0 = seg * 256 + sub * 32;
            const u32x4 l = lr, u = ur, y = yr;
            if (si + 1 < 8) LRU_GLOAD(si + 1);
            *(LAS f32x4*)(lds + AA + (ct * 128 + 8 * cg) * 4) = (f32x4){fexp2(bflo(l[0])), fexp2(bfhi(l[0])), fexp2(bflo(l[1])), fexp2(bfhi(l[1]))};
            *(LAS f32x4*)(lds + AA + (ct * 128 + 8 * cg + 4) * 4) = (f32x4){fexp2(bflo(l[2])), fexp2(bfhi(l[2])), fexp2(bflo(l[3])), fexp2(bfhi(l[3]))};
            *(LAS f32x4*)(lds + UU + (ct * 128 + 8 * cg) * 4) = (f32x4){bflo(u[0]), bfhi(u[0]), bflo(u[1]), bfhi(u[1])};
            *(LAS f32x4*)(lds + UU + (ct * 128 + 8 * cg + 4) * 4) = (f32x4){bflo(u[2]), bfhi(u[2]), bflo(u[3]), bfhi(u[3])};
            __syncthreads();
            if (tid < 128) {
                LAS float* ap = (LAS float*)(lds + AA) + tid; LAS float* up = (LAS float*)(lds + UU) + tid; float av[32], uv[32];
#pragma unroll
                for (int i = 0; i < 32; ++i) { av[i] = ap[i * 128]; uv[i] = up[i * 128]; }
                if (dir == 0) {
#pragma unroll
                    for (int i = 0; i < 32; ++i) { carry = av[i] * carry + uv[i]; uv[i] = carry; } }
                else {
#pragma unroll
                    for (int i = 31; i >= 0; --i) { carry = av[i] * carry + uv[i]; uv[i] = carry; } }
#pragma unroll
                for (int i = 0; i < 32; ++i) up[i * 128] = uv[i];
            }
            __syncthreads();
            {   const f32x4 h0 = *(const LAS f32x4*)(lds + UU + (ct * 128 + 8 * cg) * 4), h1 = *(const LAS f32x4*)(lds + UU + (ct * 128 + 8 * cg + 4) * 4);
                LAS u32x4* hf = (LAS u32x4*)(lds + HFL + ((sub * 32 + ct) * 128 + 8 * cg) * 2);
                if (dir == 0) *hf = (u32x4){cvt_pk_bf16(h0[0], h0[1]), cvt_pk_bf16(h0[2], h0[3]), cvt_pk_bf16(h1[0], h1[1]), cvt_pk_bf16(h1[2], h1[3])};
                else { const u32x4 f = *hf; const size_t go = ((size_t)b * SEQ + t0 + ct) * LRUW + cc0;
                    *(u32x4*)(HY + go) = (u32x4){cvt_pk_bf16((h0[0] + bflo(f[0])) * bflo(y[0]), (h0[1] + bfhi(f[0])) * bfhi(y[0])), cvt_pk_bf16((h0[2] + bflo(f[1])) * bflo(y[1]), (h0[3] + bfhi(f[1])) * bfhi(y[1])),
                                                cvt_pk_bf16((h1[0] + bflo(f[2])) * bflo(y[2]), (h1[1] + bfhi(f[2])) * bfhi(y[2])), cvt_pk_bf16((h1[2] + bflo(f[3])) * bflo(y[3]), (h1[3] + bfhi(f[3])) * bfhi(y[3]))}; }
            }
            __syncthreads();
        }
#undef LRU_GLOAD
    }
}
}
__device__ __forceinline__ void lru_apply_phase(const Args& A, LAS unsigned char* lds, int bid, int G) {
    for (int it = bid; it < 2560; it += G) lru::lru_apply_item(A, lds, it / 320, (it >> 5) % 10, it & 31);
}
template <int MODE>
__device__ __forceinline__ void lru_phase(const Args& A, LAS unsigned char* lds, int bid, int G) {
    const int nitems = (MODE == 0) ? 5120 : 2560;
    for (int it = bid; it < nitems; it += G) {
        int b, n, seg, dir;
        if (MODE == 0) { dir = it & 1; const int r = it >> 1; seg = r & 31; n = (r >> 5) % 10; b = r / 320; }
        else { dir = MODE - 1; seg = it & 31; n = (it >> 5) % 10; b = it / 320; }
        lru::lru_item<MODE>(A, lds, b, n, seg, dir);
    }
}
__device__ __forceinline__ void lru_carry_phase(const Args& A, int bid, int G) {
    const float* sm = (const float*)(A.ws + TB_LSUM); float* cin = (float*)(A.ws + TB_LCIN);
    for (int idx = bid * NTHR + threadIdx.x; idx < NBATCH * 2 * LRUW; idx += G * NTHR) {
        const int b = idx / (2 * LRUW), r = idx % (2 * LRUW), dir = r / LRUW, ch = r % LRUW; float carry = 0.f;
        for (int i = 0; i < 32; ++i) { const int sg = dir ? (31 - i) : i; const size_t o = (size_t)((b * 32 + sg) * 2 + dir);
            cin[o * LRUW + ch] = carry; carry = sm[o * 2 * LRUW + ch] * carry + sm[o * 2 * LRUW + LRUW + ch]; }
    }
}

__device__ __forceinline__ void place_phase(const Args& A, LAS unsigned char* lds, int bid, int G) {
    int tid_ = threadIdx.x; asm volatile("" : "+v"(tid_));
    const int tid = tid_, lane = tid & 63, wave = tid >> 6; unsigned char* ws = A.ws;
    const int* bcnt = (const int*)(ws + TB_BCNT); const int* eid = (const int*)(ws + TB_EID); int* slot = (int*)(ws + TB_SLOT);
    const bf16_t* HM = (const bf16_t*)(ws + WS_HM); bf16_t* XS = (bf16_t*)(ws + E_XS);
    LAS int* tot = (LAS int*)lds; LAS int* pre = tot + 8; LAS int* rb = tot + 16; LAS int* wcn = tot + 32; LAS int* sl = tot + 64;
    for (int tb = bid; tb < MTOK / 256; tb += G) {
        { int t_ = 0, p_ = 0;
#pragma unroll
            for (int j = 0; j < 4; ++j) { const int blk = lane + 64 * j; const int v = bcnt[blk * 8 + wave]; t_ += v; p_ += (blk < tb) ? v : 0; }
#pragma unroll
            for (int o = 1; o < 64; o <<= 1) { t_ += __shfl_xor(t_, o); p_ += __shfl_xor(p_, o); }
            if (lane == 0) { tot[wave] = t_; pre[wave] = p_; } }
        __syncthreads();
        if (tid == 0) { int acc = 0; for (int e = 0; e < 8; ++e) { rb[e] = acc * 256; if (tb == 0) ((int*)(ws + TB_TILES))[e] = acc; acc += (tot[e] + 255) >> 8; } if (tb == 0) ((int*)(ws + TB_TILES))[8] = acc; }
        int e0 = -1, e1 = -1; unsigned long long mk0 = 0, mk1 = 0;
        if (tid < 256) { e0 = eid[(tb * 256 + tid) * 2]; e1 = eid[(tb * 256 + tid) * 2 + 1];
#pragma unroll
            for (int e = 0; e < 8; ++e) { const unsigned long long m = __ballot(e0 == e || e1 == e); if (lane == 0) wcn[wave * 8 + e] = __popcll(m); if (e0 == e) mk0 = m; if (e1 == e) mk1 = m; } }
        __syncthreads();
        if (tid < 256) { const unsigned long long lt = (1ull << lane) - 1ull; int b0 = rb[e0] + pre[e0] + __popcll(mk0 & lt), b1 = rb[e1] + pre[e1] + __popcll(mk1 & lt);
            for (int w = 0; w < wave; ++w) { b0 += wcn[w * 8 + e0]; b1 += wcn[w * 8 + e1]; }
            sl[tid * 2] = b0; sl[tid * 2 + 1] = b1; slot[(tb * 256 + tid) * 2] = b0; slot[(tb * 256 + tid) * 2 + 1] = b1; }
        __syncthreads();
        for (int i = 0; i < 32; ++i) { const int t = wave * 32 + i; const int s0 = sl[t * 2], s1 = sl[t * 2 + 1];
            const bf16_t* src = HM + (size_t)(tb * 256 + t) * DM + lane * 16;
            const u32x4 a = *(const u32x4*)src, b = *(const u32x4*)(src + 8);
            const u32x4 q = {pk_fp8x4(bflo(a[0]), bfhi(a[0]), bflo(a[1]), bfhi(a[1])), pk_fp8x4(bflo(a[2]), bfhi(a[2]), bflo(a[3]), bfhi(a[3])),
                             pk_fp8x4(bflo(b[0]), bfhi(b[0]), bflo(b[1]), bfhi(b[1])), pk_fp8x4(bflo(b[2]), bfhi(b[2]), bflo(b[3]), bfhi(b[3]))};
            *(u32x4*)((unsigned char*)XS + (size_t)s0 * DM + lane * 16) = q; *(u32x4*)((unsigned char*)XS + (size_t)s1 * DM + lane * 16) = q; }
        __syncthreads();
    }
}

namespace att {
constexpr int KVBLK = 64;
#define SBAR() __builtin_amdgcn_sched_barrier(0)
typedef int v8i __attribute__((ext_vector_type(8)));
__device__ __forceinline__ int crow(int r, int hi) { return (r & 3) + 8 * (r >> 2) + 4 * hi; }
constexpr int SLOTB = 8192;
__device__ __forceinline__ int k_slot(int s) { return s * SLOTB; }
__device__ __forceinline__ int v_slot(int s) { return 65536 + s * SLOTB; }
__device__ __forceinline__ int kswz(int row) { return ((row & 7) ^ (row >> 4)) & 7; }
__device__ __forceinline__ int vswz(int row) { return (row >> 2) & 3; }
__device__ __forceinline__ void mfma8_acc(f32x16& acc, const v8i& a, const v8i& b, int sc) {
    asm volatile("s_nop 4\n\tv_mfma_scale_f32_32x32x64_f8f6f4 %0, %1, %2, %0, %3, %3 op_sel_hi:[0,0,0]" : "+v"(acc) : "v"(a), "v"(b), "v"(sc) : "memory");
}
__device__ __forceinline__ void mfma8_c(f32x16& d, const v8i& a, const v8i& b, const f32x16& c, int sa, int sb) {
    asm volatile("v_mfma_scale_f32_32x32x64_f8f6f4 %0, %1, %2, %3, %4, %5 op_sel_hi:[0,0,0]" : "=&v"(d) : "v"(a), "v"(b), "v"(c), "v"(sa), "v"(sb) : "memory");
}
#define ATT_LD8(p0_, p1_) __builtin_bit_cast(v8i, __builtin_shufflevector(*(const LAS u32x4*)(p0_), *(const LAS u32x4*)(p1_), 0, 1, 2, 3, 4, 5, 6, 7))
__device__ __forceinline__ void qkt(f32x16& p0, f32x16& p1, const LAS char* Ks, const v8i& qr, int r32, int hi, int jj, const f32x16& cinit, int s1, int s8) {
    const int c0 = jj * 4 + 2 * hi;
    { const int row = r32; const v8i kf = ATT_LD8(Ks + row * 128 + ((c0 ^ kswz(row)) << 4), Ks + row * 128 + (((c0 + 1) ^ kswz(row)) << 4)); mfma8_c(p0, kf, qr, cinit, s1, s8); }
    { const int row = 32 + r32; const v8i kf = ATT_LD8(Ks + row * 128 + ((c0 ^ kswz(row)) << 4), Ks + row * 128 + (((c0 + 1) ^ kswz(row)) << 4)); mfma8_c(p1, kf, qr, cinit, s1, s8); }
}
__device__ __forceinline__ void load_kf(v8i& kf0, v8i& kf1, const LAS char* Ks, int r32, int hi, int jj) {
    const int c0 = jj * 4 + 2 * hi, row1 = 32 + r32;
    kf0 = ATT_LD8(Ks + r32 * 128 + ((c0 ^ kswz(r32)) << 4), Ks + r32 * 128 + (((c0 + 1) ^ kswz(r32)) << 4));
    kf1 = ATT_LD8(Ks + row1 * 128 + ((c0 ^ kswz(row1)) << 4), Ks + row1 * 128 + (((c0 + 1) ^ kswz(row1)) << 4));
}
#define ATT_VFR(Vs, d0) ATT_LD8((Vs) + (32 * (d0) + r32) * 64 + (((2 * hi) ^ vswz(32 * (d0) + r32)) << 4), (Vs) + (32 * (d0) + r32) * 64 + (((2 * hi + 1) ^ vswz(32 * (d0) + r32)) << 4))
__device__ __forceinline__ void pack_p(const float (&pe)[32], v8i& pa);
__device__ __forceinline__ void qkt_pack(f32x16& p0, f32x16& p1, const v8i& kf0, const v8i& kf1, const v8i& qr, const f32x16& cinit, int s1, int s8, const float (&pe)[32], v8i& pa) {
#define ATT_MC8(d, kf, B, O0, O1, O2, O3) \
    asm volatile("v_mfma_scale_f32_32x32x64_f8f6f4 %0, %21, %22, %23, %24, %25 op_sel_hi:[0,0,0]\n\t" \
                 "v_cvt_pk_fp8_f32 %1, %5, %6\n\tv_cvt_pk_fp8_f32 %1, %7, %8 op_sel:[0,0,1]\n\t" \
                 "v_cvt_pk_fp8_f32 %2, %9, %10\n\tv_cvt_pk_fp8_f32 %2, %11, %12 op_sel:[0,0,1]\n\t" \
                 "v_cvt_pk_fp8_f32 %3, %13, %14\n\tv_cvt_pk_fp8_f32 %3, %15, %16 op_sel:[0,0,1]\n\t" \
                 "v_cvt_pk_fp8_f32 %4, %17, %18\n\tv_cvt_pk_fp8_f32 %4, %19, %20 op_sel:[0,0,1]" \
                 : "=&v"(d), "=&v"(O0), "=&v"(O1), "=&v"(O2), "=&v"(O3) \
                 : "v"(pe[B]), "v"(pe[B + 1]), "v"(pe[B + 2]), "v"(pe[B + 3]), "v"(pe[B + 4]), "v"(pe[B + 5]), "v"(pe[B + 6]), "v"(pe[B + 7]), \
                   "v"(pe[B + 8]), "v"(pe[B + 9]), "v"(pe[B + 10]), "v"(pe[B + 11]), "v"(pe[B + 12]), "v"(pe[B + 13]), "v"(pe[B + 14]), "v"(pe[B + 15]), \
                   "v"(kf), "v"(qr), "v"(cinit), "v"(s1), "v"(s8) : "memory")
    int q0, q1, q2, q3, q4, q5, q6, q7;
    ATT_MC8(p0, kf0, 0, q0, q1, q2, q3);
    ATT_MC8(p1, kf1, 16, q4, q5, q6, q7);
#undef ATT_MC8
    pa = (v8i){q0, q1, q2, q3, q4, q5, q6, q7};
}
__device__ __forceinline__ void partialSM(f32x16& p0) {
#pragma unroll
    for (int r = 0; r < 16; ++r) p0[r] = fexp2(p0[r]);
}
__device__ __forceinline__ void finishSM(f32x16& p0, f32x16& p1, v8i& pa) {
#pragma unroll
    for (int r = 0; r < 16; ++r) p1[r] = fexp2(p1[r]);
#pragma unroll
    for (int w = 0; w < 4; ++w) { pa[w] = (int)pk_fp8x4(p0[4 * w], p0[4 * w + 1], p0[4 * w + 2], p0[4 * w + 3]); pa[4 + w] = (int)pk_fp8x4(p1[4 * w], p1[4 * w + 1], p1[4 * w + 2], p1[4 * w + 3]); }
}
#define ATT_MX7(acc, a, b, sc, NOP, O, I, k) \
    asm volatile(NOP "v_mfma_scale_f32_32x32x64_f8f6f4 %0, %15, %16, %0, %17, %17 op_sel_hi:[0,0,0]\n\tv_exp_f32 %1, %8\n\tv_exp_f32 %2, %9\n\tv_exp_f32 %3, %10\n\tv_exp_f32 %4, %11\n\tv_exp_f32 %5, %12\n\tv_exp_f32 %6, %13\n\tv_exp_f32 %7, %14" \
                 : "+v"(acc), "=&v"(O[k]), "=&v"(O[k + 1]), "=&v"(O[k + 2]), "=&v"(O[k + 3]), "=&v"(O[k + 4]), "=&v"(O[k + 5]), "=&v"(O[k + 6]) \
                 : "v"(I(k)), "v"(I(k + 1)), "v"(I(k + 2)), "v"(I(k + 3)), "v"(I(k + 4)), "v"(I(k + 5)), "v"(I(k + 6)), "v"(a), "v"(b), "v"(sc) : "memory")
__device__ __forceinline__ void pv_exp(f32x16* o, f32x16& lacc, const v8i& ones, const v8i& vf0, const v8i& vf1, const v8i& vf2, const v8i& vf3, const v8i& pa, int s1, const f32x16& r0, const f32x16& r1, float (&pe)[32]) {
#define ATT_RI(k) (((k) < 16) ? r0[(k) & 15] : r1[(k) & 15])
    ATT_MX7(o[0], pa, vf0, s1, "s_nop 4\n\t", pe, ATT_RI, 0);
    ATT_MX7(o[1], pa, vf1, s1, "", pe, ATT_RI, 7);
    ATT_MX7(o[2], pa, vf2, s1, "", pe, ATT_RI, 14);
    ATT_MX7(o[3], pa, vf3, s1, "", pe, ATT_RI, 21);
    asm volatile("v_mfma_scale_f32_32x32x64_f8f6f4 %0, %9, %10, %0, %11, %11 op_sel_hi:[0,0,0]\n\tv_exp_f32 %1, %5\n\tv_exp_f32 %2, %6\n\tv_exp_f32 %3, %7\n\tv_exp_f32 %4, %8"
                 : "+v"(lacc), "=&v"(pe[28]), "=&v"(pe[29]), "=&v"(pe[30]), "=&v"(pe[31]) : "v"(r1[12]), "v"(r1[13]), "v"(r1[14]), "v"(r1[15]), "v"(pa), "v"(ones), "v"(s1) : "memory");
#undef ATT_RI
}
__device__ __forceinline__ void pack_p(const float (&pe)[32], v8i& pa) {
#pragma unroll
    for (int w = 0; w < 8; ++w) pa[w] = (int)pk_fp8x4(pe[4 * w], pe[4 * w + 1], pe[4 * w + 2], pe[4 * w + 3]);
}
__device__ __forceinline__ void pv_d0(f32x16* o, f32x16& lacc, const v8i& ones, const LAS char* Vs, const v8i& pa, int r32, int hi, int s1) {
#pragma unroll
    for (int d0 = 0; d0 < 4; ++d0) { const int row = 32 * d0 + r32;
        const v8i vf = ATT_LD8(Vs + row * 64 + (((2 * hi) ^ vswz(row)) << 4), Vs + row * 64 + (((2 * hi + 1) ^ vswz(row)) << 4));
        mfma8_acc(o[d0], pa, vf, s1); }
    mfma8_acc(lacc, pa, ones, s1);
}
__device__ __forceinline__ void pv_last(f32x16* o, f32x16& lacc, const v8i& ones, const v8i& vf0, const v8i& vf1, const v8i& vf2, const v8i& vf3, const v8i& pa, int s1) {
    mfma8_acc(o[0], pa, vf0, s1); mfma8_acc(o[1], pa, vf1, s1); mfma8_acc(o[2], pa, vf2, s1); mfma8_acc(o[3], pa, vf3, s1); mfma8_acc(lacc, pa, ones, s1);
}
}

__device__ __forceinline__ void vt_phase(const Args& A, int bid, int G) {
    const int tid = threadIdx.x; unsigned char* ws = A.ws;
    const bf16_t* V = (const bf16_t*)(ws + A_V); unsigned char* VT = ws + A_VT;
    const int dv = tid & 127, kq = tid >> 7, half = kq >> 1, hi = kq & 1;
    for (int it = bid; it < 64 * 128; it += G) {
        const int bh = it >> 7, tile = it & 127, b = bh >> 3, h = bh & 7;
        const bf16_t* vp = V + ((size_t)b * SEQ + tile * 64 + 32 * half) * DM + h * 128 + dv;
        float f[16];
#pragma unroll
        for (int i = 0; i < 16; ++i) f[i] = bf2f(vp[(size_t)att::crow(i, hi) * DM]);
        *(u32x4*)(VT + (((size_t)bh * 128 + tile) * 128 + dv) * 64 + hi * 32 + half * 16) =
            (u32x4){pk_fp8x4(f[0], f[1], f[2], f[3]), pk_fp8x4(f[4], f[5], f[6], f[7]), pk_fp8x4(f[8], f[9], f[10], f[11]), pk_fp8x4(f[12], f[13], f[14], f[15])};
    }
}

__device__ __forceinline__ void attn_phase(const Args& A, LAS unsigned char* ldsu, int bid, int G, int al) {
    using namespace att;
    LAS char* lds = (LAS char*)ldsu;
    unsigned char* ws = A.ws;
    const unsigned char* Qg = ws + A_Q; const unsigned char* Kg = ws + A_K; const unsigned char* VTg = ws + A_VT;
    bf16_t* Og = (bf16_t*)(ws + WS_HM);
    const float* scal = (const float*)(ws + TB_SCAL);
    const float lamv = scal[SC_LAM0 + al], omli = scal[SC_OML0 + al], Mc = scal[SC_MC0 + al] - 7.5f;
    const float* subg = A.in[I_ATSUB] + al * 128;
    int tid_ = threadIdx.x; asm volatile("" : "+v"(tid_));
    const int tid = tid_, wid = __builtin_amdgcn_readfirstlane(tid >> 6), lane = tid & 63, r32 = lane & 31, hi = lane >> 5, jj = wid >> 2, wq = wid & 3;
    constexpr int NT = SEQ / KVBLK;
    int s1 = 0x7f7f7f7f, s8 = 0x7c7c7c7c; asm volatile("" : "+v"(s1), "+v"(s8));
    v8i ones; { int o1 = 0x38383838; asm volatile("" : "+v"(o1)); ones = (v8i){o1, o1, o1, o1, o1, o1, o1, o1}; }
    f32x16 cinit;
#pragma unroll
    for (int r = 0; r < 16; ++r) cinit[r] = -Mc;
    unsigned koff, voff;
    { const int bb = wid * 1024 + lane * 16;
      { const int row = bb >> 7, c = ((bb & 127) >> 4) ^ kswz(row); koff = (unsigned)(row * 1024 + c * 16); }
      { const int row = bb >> 6, c = ((bb & 63) >> 4) ^ vswz(row); voff = (unsigned)(row * 64 + c * 16); } }
    const unsigned ldsw = (unsigned)wid * 1024u;
#define ATT_DMA(slot, kt, vt) do { \
        __builtin_amdgcn_global_load_lds((const unsigned*)((const unsigned char*)(kt) + koff), (LAS unsigned*)(lds + k_slot(slot) + ldsw), 16, 0, 0); \
        __builtin_amdgcn_global_load_lds((const unsigned*)((const unsigned char*)(vt) + voff), (LAS unsigned*)(lds + v_slot(slot) + ldsw), 16, 0, 0); } while (0)
#define ATT_TOP() do { asm volatile("s_waitcnt vmcnt(4)" ::: "memory"); __builtin_amdgcn_s_barrier(); asm volatile("" ::: "memory"); } while (0)
    const int xq = bid & 7, cq = bid >> 3;
    int cbh = xq * 8;
    const bool lag = (jj != 0);
#define ATT_KB(bh_) (Kg + ((size_t)((bh_) >> 3) * SEQ) * DM + ((bh_) & 7) * 128)
#define ATT_VB(bh_) (VTg + (size_t)(bh_) * 128 * 8192)
    ATT_DMA(0, ATT_KB(cbh), ATT_VB(cbh)); ATT_DMA(1, ATT_KB(cbh) + (size_t)64 * DM, ATT_VB(cbh) + 8192); ATT_DMA(2, ATT_KB(cbh) + (size_t)128 * DM, ATT_VB(cbh) + 16384);
    int ofKa, ofKb, ofV, ofKax, ofKbx, ofVx;
    { const int c0 = jj * 4 + 2 * hi, lb = (int)(unsigned)(size_t)lds;
      ofKa = r32 * 128 + ((c0 ^ kswz(r32)) << 4); ofKb = (32 + r32) * 128 + ((c0 ^ kswz(32 + r32)) << 4); ofV = 65536 + r32 * 64 + (((2 * hi) ^ vswz(r32)) << 4);
      ofKax = lb + (ofKa ^ 16); ofKbx = lb + (ofKb ^ 16); ofVx = lb + (ofV ^ 16); ofKa += lb; ofKb += lb; ofV += lb; }
    for (int ui = 0; ui < 16; ++ui) {
        const int qb = (ui & 1) * 32 + cq;
        const int nbh = (ui + 1 < 16) ? xq * 8 + ((ui + 1) >> 1) : cbh;
        const unsigned char* Kh = ATT_KB(cbh); const unsigned char* Vh = ATT_VB(cbh); const unsigned char* nK = ATT_KB(nbh); const unsigned char* nV = ATT_VB(nbh);
        const size_t obase = ((size_t)(cbh >> 3) * SEQ + qb * 128) * DM + (cbh & 7) * 128;
        f32x16 lacc = {}; f32x16 o[4] = {}; v8i qr;
        { const unsigned char* Qw = Qg + obase + (size_t)(wq * 32 + r32) * DM + jj * 64 + hi * 32;
          const u32x4 qa = *(const u32x4*)Qw, qb2 = *(const u32x4*)(Qw + 16);
          qr = __builtin_bit_cast(v8i, __builtin_shufflevector(qa, qb2, 0, 1, 2, 3, 4, 5, 6, 7)); }
        f32x16 pA0, pA1; v8i pa, kf0, kf1, vf0, vf1, vf2, vf3;
        const unsigned char* kptr = Kh + (size_t)3 * 64 * DM; const unsigned char* vptr = Vh + 3 * 8192;
#define ATT_ISSUE(SLD, last) do { asm volatile("" : "+s"(kptr), "+s"(vptr)); ATT_DMA(SLD, kptr, vptr); if (last) { kptr = nK; vptr = nV; } else { kptr += (size_t)64 * DM; vptr += 8192; } } while (0)
#define ATT_RD8(b_, bx_, imm_) ATT_LD8((const LAS char*)(unsigned)((b_) + (imm_)), (const LAS char*)(unsigned)((bx_) + (imm_)))
#define ATT_FIX() asm volatile("" : "+v"(ofKa), "+v"(ofKax), "+v"(ofKb), "+v"(ofKbx), "+v"(ofV), "+v"(ofVx))
#define ATT_STEPC(LAST, SL, SLP, SLD) do { \
            ATT_FIX(); \
            ATT_TOP(); \
            kf0 = ATT_RD8(ofKa, ofKax, (SL) * SLOTB); kf1 = ATT_RD8(ofKb, ofKbx, (SL) * SLOTB); vf0 = ATT_RD8(ofV, ofVx, (SLP) * SLOTB); vf1 = ATT_RD8(ofV, ofVx, (SLP) * SLOTB + 2048); \
            ATT_ISSUE(SLD, LAST); \
            ATT_TOP(); \
            qkt_pack(pA0, pA1, kf0, kf1, qr, cinit, s1, s8, pe, pa); \
            vf2 = ATT_RD8(ofV, ofVx, (SLP) * SLOTB + 4096); vf3 = ATT_RD8(ofV, ofVx, (SLP) * SLOTB + 6144); \
            pv_exp(o, lacc, ones, vf0, vf1, vf2, vf3, pa, s1, pA0, pA1, pe); } while (0)
        float pe[32];
        if (lag) ATT_TOP();
        ATT_TOP();
        ATT_FIX(); kf0 = ATT_RD8(ofKa, ofKax, 0); kf1 = ATT_RD8(ofKb, ofKbx, 0); ATT_ISSUE(3, false);
        ATT_TOP();
        { mfma8_c(pA0, kf0, qr, cinit, s1, s8); mfma8_c(pA1, kf1, qr, cinit, s1, s8);
          asm volatile("s_nop 15\n\ts_nop 15" ::: "memory");
#pragma unroll
          for (int r = 0; r < 16; ++r) pe[r] = fexp2(pA0[r]);
#pragma unroll
          for (int r = 0; r < 16; ++r) pe[16 + r] = fexp2(pA1[r]); }
        ATT_STEPC(false, 1, 0, 4); ATT_STEPC(false, 2, 1, 5); ATT_STEPC(false, 3, 2, 6); ATT_STEPC(false, 4, 3, 7); ATT_STEPC(false, 5, 4, 0); ATT_STEPC(false, 6, 5, 1); ATT_STEPC(false, 7, 6, 2);
        for (int kb = 8; kb < NT; kb += 8) {
            ATT_STEPC(false, 0, 7, 3); ATT_STEPC(false, 1, 0, 4); ATT_STEPC(false, 2, 1, 5); ATT_STEPC(false, 3, 2, 6);
            ATT_STEPC(kb == NT - 8, 4, 3, 7); ATT_STEPC(false, 5, 4, 0); ATT_STEPC(false, 6, 5, 1); ATT_STEPC(false, 7, 6, 2);
        }
        ATT_TOP();
        ATT_FIX();
        vf0 = ATT_RD8(ofV, ofVx, 7 * SLOTB); vf1 = ATT_RD8(ofV, ofVx, 7 * SLOTB + 2048);
        ATT_TOP();
        { vf2 = ATT_RD8(ofV, ofVx, 7 * SLOTB + 4096); vf3 = ATT_RD8(ofV, ofVx, 7 * SLOTB + 6144);
          pack_p(pe, pa); SBAR();
          pv_last(o, lacc, ones, vf0, vf1, vf2, vf3, pa, s1);
          asm volatile("s_nop 15\n\ts_nop 15" ::: "memory"); }
        if (!lag) ATT_TOP();
#undef ATT_ISSUE
#undef ATT_STEPC
#undef ATT_RD8
#undef ATT_FIX
        int r32e = r32, hie = hi; asm volatile("" : "+v"(r32e), "+v"(hie));
        float rli[16];
#pragma unroll
        for (int r = 0; r < 16; ++r) rli[r] = frcp(lacc[r]);
        asm volatile("s_waitcnt lgkmcnt(0)" ::: "memory"); __builtin_amdgcn_s_barrier(); asm volatile("" ::: "memory");
        LAS float* Cb = (LAS float*)(lds + ((wq < 2) ? 3 * SLOTB : 65536 + 3 * SLOTB - 64 * 512));
        if (jj == 1) {
#pragma unroll
            for (int r = 0; r < 16; ++r) { const float sc = rli[r] * lamv;
#pragma unroll
                for (int d0 = 0; d0 < 4; ++d0) Cb[(wq * 32 + crow(r, hie)) * 128 + d0 * 32 + r32e] = o[d0][r] * sc; }
        }
        asm volatile("s_waitcnt lgkmcnt(0)" ::: "memory"); __builtin_amdgcn_s_barrier(); asm volatile("" ::: "memory");
        if (jj == 0) {
            float g[4];
#pragma unroll
            for (int d0 = 0; d0 < 4; ++d0) g[d0] = subg[d0 * 32 + r32e] * omli;
            bf16_t* Ob = Og + obase;
#pragma unroll
            for (int r = 0; r < 16; ++r) {
                float ss = 0.f;
#pragma unroll
                for (int d0 = 0; d0 < 4; ++d0) { const float v = o[d0][r] * rli[r] - Cb[(wq * 32 + crow(r, hie)) * 128 + d0 * 32 + r32e]; o[d0][r] = v; ss += v * v; }
                ss += __shfl_xor(ss, 1); ss += __shfl_xor(ss, 2); ss += __shfl_xor(ss, 4); ss += __shfl_xor(ss, 8); ss += __shfl_xor(ss, 16);
                const float rs = 1.0f / sqrtf(ss * (1.0f / 128.0f) + EPS);
                bf16_t* op = Ob + (size_t)(wq * 32 + crow(r, hie)) * DM + r32e;
#pragma unroll
                for (int d0 = 0; d0 < 4; ++d0) op[d0 * 32] = (bf16_t)f2bf(o[d0][r] * rs * g[d0]);
            }
        }
        asm volatile("s_waitcnt lgkmcnt(0)" ::: "memory"); __builtin_amdgcn_s_barrier(); asm volatile("" ::: "memory");
        cbh = nbh;
    }
    asm volatile("s_waitcnt vmcnt(0) lgkmcnt(0)" ::: "memory"); __builtin_amdgcn_s_barrier(); asm volatile("" ::: "memory");
#undef ATT_DMA
#undef ATT_TOP
#undef ATT_KB
#undef ATT_VB
#undef ATT_LD8
}

namespace gla {
constexpr int BC = 0, QI = 32768, QA = 49152, KA = 65536, KST = 81920, VT = 98304, ST = 106496, AT = 122880, EM = 131072, EL = EM + 512, DD = EM + 1024, BMID = EM + 1536, SEG = EM + 2048;
static_assert(SEG + 2048 <= RING_BYTES, "gla lds");
__device__ __forceinline__ int sw256(int row, int cb) { return row * 256 + (cb ^ ((row & 15) << 4)); }
__device__ __forceinline__ int sw128(int row, int cb) { return row * 128 + (cb ^ ((((row & 7) ^ (row >> 4)) & 7) << 4)); }
__device__ __forceinline__ int crow(int r, int hi) { return (r & 3) + 8 * (r >> 2) + 4 * hi; }
__device__ __forceinline__ float h2f(unsigned short b) { return (float)__builtin_bit_cast(_Float16, b); }
__device__ __forceinline__ void gla_item(const bf16_t* __restrict__ Qp, const unsigned short* __restrict__ LFp, const bf16_t* __restrict__ Vp, bf16_t* __restrict__ Op, int dir, LAS unsigned char* lds, float* dbg) {
    int tid_ = threadIdx.x; asm volatile("" : "+v"(tid_));
    const int tid = tid_, wid = tid >> 6, lane = tid & 63, r = lane & 31, hh = lane >> 5;
    const int t1 = tid >> 3, kg = tid & 7, k0 = 16 * kg, v0 = (tid & 7) * 8;
    for (int i = tid; i < 16384 / 16; i += NTHR) *(LAS u32x4*)(lds + ST + i * 16) = (u32x4){0u, 0u, 0u, 0u};
    f32x16 st = {};
    u32x4 rq[2], rl[2], rv;
#define GLA_TOK(ci, i) (dir ? (SEQ - 1 - ((ci) * 64 + (i))) : ((ci) * 64 + (i)))
#define GLA_LOAD(ci) do { const size_t to = (size_t)GLA_TOK(ci, t1) * DM; \
        rq[0] = *(const u32x4*)(Qp + to + k0); rq[1] = *(const u32x4*)(Qp + to + k0 + 8); \
        rl[0] = *(const u32x4*)(LFp + to + k0); rl[1] = *(const u32x4*)(LFp + to + k0 + 8); rv = *(const u32x4*)(Vp + to + v0); } while (0)
    GLA_LOAD(0);
    __syncthreads();
    for (int ci = 0; ci < SEQ / 64; ++ci) {
        float qf[16], lf[16]; u32x4 vreg = rv;
#pragma unroll
        for (int j = 0; j < 2; ++j)
#pragma unroll
            for (int e = 0; e < 4; ++e) { qf[j * 8 + 2 * e] = bflo(rq[j][e]); qf[j * 8 + 2 * e + 1] = bfhi(rq[j][e]);
                lf[j * 8 + 2 * e] = h2f((unsigned short)(rl[j][e] & 0xffffu)); lf[j * 8 + 2 * e + 1] = h2f((unsigned short)(rl[j][e] >> 16)); }
        if (ci + 1 < SEQ / 64) GLA_LOAD(ci + 1);
#pragma unroll
        for (int j = 0; j < 4; ++j) *(LAS f32x4*)(lds + BC + (t1 * 128 + k0 + 4 * j) * 4) = (f32x4){lf[4 * j], lf[4 * j + 1], lf[4 * j + 2], lf[4 * j + 3]};
        __syncthreads();
        { const int kc = tid & 127, sg = tid >> 7; LAS float* bc = (LAS float*)(lds + BC) + kc; float cs[16];
#pragma unroll
            for (int i = 0; i < 16; ++i) cs[i] = bc[(sg * 16 + i) * 128];
#pragma unroll
            for (int i = 1; i < 16; ++i) cs[i] += cs[i - 1];
            ((LAS float*)(lds + SEG))[sg * 128 + kc] = cs[15];
            __syncthreads();
            const LAS float* sgp = (const LAS float*)(lds + SEG) + kc; const float s0 = sgp[0], s1 = sgp[128], s2 = sgp[256], s3 = sgp[384];
            const float off = sg == 0 ? 0.f : sg == 1 ? s0 : sg == 2 ? (s0 + s1) : ((s0 + s1) + s2);
#pragma unroll
            for (int i = 0; i < 16; ++i) bc[(sg * 16 + i) * 128] = cs[i] + off;
            if (sg == 0) { const float bm = s0 + s1, bl = ((s0 + s1) + s2) + s3;
                ((LAS float*)(lds + BMID))[kc] = bm; ((LAS float*)(lds + EM))[kc] = fexp(bm); ((LAS float*)(lds + EL))[kc] = fexp(bl - bm); ((LAS float*)(lds + DD))[kc] = fexp(bl); }
            __syncthreads();
        }
#ifdef DIAG
        if (dbg && ci == 0) { for (int i = tid; i < 8192; i += NTHR) dbg[i] = ((const LAS float*)(lds + BC))[i]; }
#endif
        {
            unsigned wqi[8], wqa[8], wka[8]; float ksv[16];
#pragma unroll
            for (int j = 0; j < 4; ++j) {
                const f32x4 bt = *(const LAS f32x4*)(lds + BC + (t1 * 128 + k0 + 4 * j) * 4), bm = *(const LAS f32x4*)(lds + BMID + (k0 + 4 * j) * 4);
                const f32x4 em = *(const LAS f32x4*)(lds + EM + (k0 + 4 * j) * 4), el = *(const LAS f32x4*)(lds + EL + (k0 + 4 * j) * 4);
                float qi[4], qa[4], ka[4];
#pragma unroll
                for (int e = 0; e < 4; ++e) { const int i = 4 * j + e; const float e1 = fexp(bt[e] - bm[e]), r1 = frcp(e1);
                    qa[e] = qf[i] * e1; qi[e] = qa[e] * em[e]; const float kk = 1.0f - fexp(lf[i]); ka[e] = kk * r1; ksv[i] = ka[e] * el[e]; }
                wqi[2 * j] = cvt_pk_bf16(qi[0], qi[1]); wqi[2 * j + 1] = cvt_pk_bf16(qi[2], qi[3]);
                wqa[2 * j] = cvt_pk_bf16(qa[0], qa[1]); wqa[2 * j + 1] = cvt_pk_bf16(qa[2], qa[3]);
                wka[2 * j] = cvt_pk_bf16(ka[0], ka[1]); wka[2 * j + 1] = cvt_pk_bf16(ka[2], ka[3]);
            }
#pragma unroll
            for (int j = 0; j < 2; ++j) { const int off = sw256(t1, (k0 + 8 * j) * 2);
                *(LAS u32x4*)(lds + QI + off) = (u32x4){wqi[4 * j], wqi[4 * j + 1], wqi[4 * j + 2], wqi[4 * j + 3]};
                *(LAS u32x4*)(lds + QA + off) = (u32x4){wqa[4 * j], wqa[4 * j + 1], wqa[4 * j + 2], wqa[4 * j + 3]};
                *(LAS u32x4*)(lds + KA + off) = (u32x4){wka[4 * j], wka[4 * j + 1], wka[4 * j + 2], wka[4 * j + 3]}; }
#pragma unroll
            for (int i = 0; i < 16; ++i) *(LAS unsigned short*)(lds + KST + sw128(k0 + i, t1 * 2)) = (unsigned short)f2bf(ksv[i]);
#pragma unroll
            for (int e = 0; e < 4; ++e) { *(LAS unsigned short*)(lds + VT + sw128(v0 + 2 * e, t1 * 2)) = (unsigned short)(vreg[e] & 0xffffu);
                *(LAS unsigned short*)(lds + VT + sw128(v0 + 2 * e + 1, t1 * 2)) = (unsigned short)(vreg[e] >> 16); }
        }
        __syncthreads();
        f32x16 oacc = {};
        const int w4 = wid & 3, t_i = w4 >> 1, v_i = w4 & 1;
        if (wid < 4) {
            const int s_i = wid >> 1, tq = wid & 1; f32x16 a = {};
#pragma unroll
            for (int ks = 0; ks < 8; ++ks) { const bf16x8 fa = *(const LAS bf16x8*)(lds + KA + sw256(32 * s_i + r, (16 * ks + 8 * hh) * 2)), fb = *(const LAS bf16x8*)(lds + QA + sw256(32 * tq + r, (16 * ks + 8 * hh) * 2));
                a = __builtin_amdgcn_mfma_f32_32x32x16_bf16(fa, fb, a, 0, 0, 0); }
            const int tg = 32 * tq + r;
#pragma unroll
            for (int g = 0; g < 4; ++g) { float m[4];
#pragma unroll
                for (int e = 0; e < 4; ++e) { const int sgl = 32 * s_i + 8 * g + 4 * hh + e; m[e] = (sgl <= tg) ? a[4 * g + e] : 0.f; }
                *(LAS u32x2*)(lds + AT + sw128(tg, (32 * s_i + 8 * g + 4 * hh) * 2)) = (u32x2){cvt_pk_bf16(m[0], m[1]), cvt_pk_bf16(m[2], m[3])}; }
        } else {
#pragma unroll
            for (int ks = 0; ks < 8; ++ks) { const bf16x8 fa = *(const LAS bf16x8*)(lds + QI + sw256(32 * t_i + r, (16 * ks + 8 * hh) * 2)), fb = *(const LAS bf16x8*)(lds + ST + sw256(32 * v_i + r, (16 * ks + 8 * hh) * 2));
                oacc = __builtin_amdgcn_mfma_f32_32x32x16_bf16(fa, fb, oacc, 0, 0, 0); }
        }
        __syncthreads();
#ifdef DIAG
        if (dbg && ci == 0) { for (int i = tid; i < 2048; i += NTHR) { ((unsigned*)dbg)[8192 + i] = ((const LAS unsigned*)(lds + AT))[i]; ((unsigned*)dbg)[8192 + 2048 + i] = ((const LAS unsigned*)(lds + VT))[i]; } }
#endif
        if (wid >= 4) {
#pragma unroll
            for (int ks = 0; ks < 4; ++ks) { const bf16x8 fa = *(const LAS bf16x8*)(lds + AT + sw128(32 * t_i + r, (16 * ks + 8 * hh) * 2)), fb = *(const LAS bf16x8*)(lds + VT + sw128(32 * v_i + r, (16 * ks + 8 * hh) * 2));
                oacc = __builtin_amdgcn_mfma_f32_32x32x16_bf16(fa, fb, oacc, 0, 0, 0); }
#pragma unroll
            for (int i = 0; i < 16; ++i) { const int t = 32 * t_i + crow(i, hh); Op[(size_t)GLA_TOK(ci, t) * DM + 32 * v_i + r] = (bf16_t)f2bf(oacc[i]); }
        }
        {
            const int kq = wid >> 1, vq = wid & 1;
#pragma unroll
            for (int i = 0; i < 16; ++i) st[i] *= ((const LAS float*)(lds + DD))[32 * kq + crow(i, hh)];
#pragma unroll
            for (int ks = 0; ks < 4; ++ks) { const bf16x8 fa = *(const LAS bf16x8*)(lds + KST + sw128(32 * kq + r, (16 * ks + 8 * hh) * 2)), fb = *(const LAS bf16x8*)(lds + VT + sw128(32 * vq + r, (16 * ks + 8 * hh) * 2));
                st = __builtin_amdgcn_mfma_f32_32x32x16_bf16(fa, fb, st, 0, 0, 0); }
#pragma unroll
            for (int g = 0; g < 4; ++g) *(LAS u32x2*)(lds + ST + sw256(32 * vq + r, (32 * kq + 8 * g + 4 * hh) * 2)) = (u32x2){cvt_pk_bf16(st[4 * g], st[4 * g + 1]), cvt_pk_bf16(st[4 * g + 2], st[4 * g + 3])};
        }
        __syncthreads();
#ifdef DIAG
        if (dbg && ci == 0) { for (int i = tid; i < 4096; i += NTHR) { ((unsigned*)dbg)[12288 + i] = ((const LAS unsigned*)(lds + ST))[i]; ((unsigned*)dbg)[16384 + i] = ((const LAS unsigned*)(lds + KST))[i]; } }
#endif
    }
#undef GLA_TOK
#undef GLA_LOAD
}
}
__device__ __forceinline__ void gla_phase(const Args& A, LAS unsigned char* lds, int bid, int G) {
    unsigned char* ws = A.ws;
    for (int it = bid; it < 256; it += G) {
        const int b = it >> 5, h = (it >> 2) & 7, dir = (it >> 1) & 1, vh = it & 1;
        const size_t base = (size_t)b * SEQ * DM + h * 128;
        gla::gla_item((const bf16_t*)(ws + H_Q) + base, (const unsigned short*)(ws + (dir ? H_LFB : H_LFF)) + base, (const bf16_t*)(ws + H_V) + base + vh * 64,
                      (bf16_t*)(ws + (dir ? H_OB : H_OF)) + base + vh * 64, dir, lds, it == 0 ? (float*)(ws + TB_LSUM) : nullptr);
    }
}
__device__ __forceinline__ void hg_normo_phase(const Args& A, int bid, int G) {
    int tid_ = threadIdx.x; asm volatile("" : "+v"(tid_));
    const int tid = tid_, lane = tid & 63, wave = tid >> 6; unsigned char* ws = A.ws;
    const bf16_t* OF = (const bf16_t*)(ws + H_OF); const bf16_t* OB = (const bf16_t*)(ws + H_OB); const bf16_t* GG = (const bf16_t*)(ws + H_G); bf16_t* HM = (bf16_t*)(ws + WS_HM);
    const int c0 = (lane >> 3) * 128 + (lane & 7) * 16;
    float ng[16];
#pragma unroll
    for (int i = 0; i < 16; ++i) ng[i] = A.in[I_HGNG][(lane & 7) * 16 + i];
    for (int row = (bid * NWAVES + wave); row < MTOK; row += G * NWAVES) {
        const size_t o = (size_t)row * DM + c0;
        const u32x4 a0 = *(const u32x4*)(OF + o), a1 = *(const u32x4*)(OF + o + 8), b0 = *(const u32x4*)(OB + o), b1 = *(const u32x4*)(OB + o + 8), g0 = *(const u32x4*)(GG + o), g1 = *(const u32x4*)(GG + o + 8);
        float v[16], gt[16]; float ss = 0.f;
#pragma unroll
        for (int e = 0; e < 4; ++e) { v[2 * e] = bflo(a0[e]) + bflo(b0[e]); v[2 * e + 1] = bfhi(a0[e]) + bfhi(b0[e]); v[8 + 2 * e] = bflo(a1[e]) + bflo(b1[e]); v[8 + 2 * e + 1] = bfhi(a1[e]) + bfhi(b1[e]);
            gt[2 * e] = bflo(g0[e]); gt[2 * e + 1] = bfhi(g0[e]); gt[8 + 2 * e] = bflo(g1[e]); gt[8 + 2 * e + 1] = bfhi(g1[e]); }
#pragma unroll
        for (int i = 0; i < 16; ++i) ss += v[i] * v[i];
        ss += __shfl_xor(ss, 1); ss += __shfl_xor(ss, 2); ss += __shfl_xor(ss, 4);
        const float rstd = 1.0f / sqrtf(ss * (1.0f / 128.0f) + EPS);
        u32x4 w0, w1;
#pragma unroll
        for (int e = 0; e < 4; ++e) { w0[e] = cvt_pk_bf16(v[2 * e] * rstd * ng[2 * e] * gt[2 * e], v[2 * e + 1] * rstd * ng[2 * e + 1] * gt[2 * e + 1]);
            w1[e] = cvt_pk_bf16(v[8 + 2 * e] * rstd * ng[8 + 2 * e] * gt[8 + 2 * e], v[8 + 2 * e + 1] * rstd * ng[8 + 2 * e + 1] * gt[8 + 2 * e + 1]); }
        *(u32x4*)(HM + o) = w0; *(u32x4*)(HM + o + 8) = w1;
    }
}

#ifdef DIAG
constexpr int DG_BASE = 8192;
__device__ __forceinline__ void dg_put(const Args& A, int k, float e) { if (!(e >= 0.f) || e > 1e9f) e = 1e9f; atomicMax((unsigned*)(A.ws + WS_CTL) + DG_BASE + 64 * k, __float_as_uint(e)); }
__device__ __forceinline__ float dg_rel(float got, float ref) { return fabsf(got - ref) / (fabsf(ref) + 0.1f); }
__device__ __forceinline__ unsigned dg_hash(unsigned a, unsigned b) { unsigned h = a * 2654435761u + b * 40503u + 0x9e3779b9u; h ^= h >> 15; h *= 2246822519u; h ^= h >> 13; h *= 3266489917u; h ^= h >> 16; return h; }
__device__ __forceinline__ float dg_bfr(float x) { return bflo(f2bf(x)); }
__device__ __forceinline__ void dg_mods(const Args& A, int k) {
    const int lane = threadIdx.x & 63, gwv = blockIdx.x * 8 + (threadIdx.x >> 6);
    const unsigned h = dg_hash(gwv, k); const int l = h & 3, b = (h >> 2) & 7, e = (h >> 5) % 6144;
    float a = 0.f; for (int d = lane; d < DM; d += 64) a += fsilu(A.in[I_C][b * DM + d]) * A.in[I_ADAW][((size_t)l * DM + d) * 6144 + e];
    a = wave_sum(a) + A.in[I_ADAB][l * 6144 + e];
    const float got = ((const float*)(A.ws + TB_MODS))[((size_t)l * NBATCH + b) * 6144 + e];
    if (lane == 0) dg_put(A, k, dg_rel(got, a));
}
__device__ __forceinline__ void dg_norm(const Args& A, int k, const float* x, const float* gain, int L, int which) {
    const int lane = threadIdx.x & 63, gwv = blockIdx.x * 8 + (threadIdx.x >> 6);
    const int row = dg_hash(gwv, k) & (MTOK - 1), b = row >> 13;
    const float* modl = (const float*)(A.ws + TB_MODS) + ((size_t)L * NBATCH + b) * 6144;
    float ss = 0.f; for (int c = lane; c < DM; c += 64) { const float v = x[(size_t)row * DM + c]; ss += v * v; }
    ss = wave_sum(ss); const float rstd = 1.0f / sqrtf(ss / DM + EPS); float e = 0.f;
    for (int c = lane; c < DM; c += 64) { const float ref = x[(size_t)row * DM + c] * rstd * gain[c] * (1.0f + modl[(which * 3 + 1) * 1024 + c]) + modl[(which * 3) * 1024 + c];
        e = fmaxf(e, dg_rel(bf2f(((const bf16_t*)(A.ws + WS_HM))[(size_t)row * DM + c]), ref)); }
    dg_put(A, k, e);
}
__device__ __forceinline__ void dg_qkv(const Args& A, int k, int al) {
    const int lane = threadIdx.x & 63, gwv = blockIdx.x * 8 + (threadIdx.x >> 6);
    const unsigned h = dg_hash(gwv, k); const int row = h & (MTOK - 1), t = (h >> 16) % 48, col = t * 64 + lane;
    const bf16_t* hm = (const bf16_t*)(A.ws + WS_HM) + (size_t)row * DM; const float* w = A.in[I_ATWIN] + (size_t)al * 1024 * 3072 + col;
    float a = 0.f; for (int kk = 0; kk < DM; ++kk) a += bf2f(hm[kk]) * dg_bfr(w[(size_t)kk * 3072]);
    float ref, got;
    if (t < 32) {
        const int part = t >> 4, sh = t & 15; const float ss = wave_sum(a * a); const float rstd = 1.0f / sqrtf(ss / 64.0f + EPS);
        const float y = a * rstd * (part ? A.in[I_ATKN] : A.in[I_ATQN])[al * 64 + lane]; const float yp = __shfl_xor(y, 32);
        const int pos = row & (SEQ - 1); const float cs = ((const float*)(A.ws + TB_COS))[pos * 32 + (lane & 31)], sn = ((const float*)(A.ws + TB_SIN))[pos * 32 + (lane & 31)];
        ref = (lane < 32) ? (y * cs - yp * sn) : (y * cs + yp * sn); if (part == 0) ref *= 0.125f * LOG2E;
        got = bf2f(((const bf16_t*)(A.ws + (part ? A_K : A_Q)))[(size_t)row * DM + sh * 64 + lane]);
    } else { ref = a; got = bf2f(((const bf16_t*)(A.ws + A_V))[(size_t)row * DM + (t - 32) * 64 + lane]); }
    dg_put(A, k, dg_rel(got, ref));
}
__device__ __forceinline__ void dg_attn(const Args& A, int k, int al, LAS unsigned char* lds) {
    const int tid = threadIdx.x; const unsigned h = dg_hash(blockIdx.x, k); const int row = h & (MTOK - 1), hd = (h >> 16) & 7, b = row >> 13;
    const bf16_t* Q = (const bf16_t*)(A.ws + A_Q); const bf16_t* K = (const bf16_t*)(A.ws + A_K); const bf16_t* V = (const bf16_t*)(A.ws + A_V);
    const float* scal = (const float*)(A.ws + TB_SCAL); const float lamv = scal[SC_LAM0 + al], omli = scal[SC_OML0 + al], Mc = scal[SC_MC0 + al];
    LAS float* p0 = (LAS float*)lds; LAS float* p1 = p0 + SEQ; LAS float* red = p1 + SEQ;
    float l0 = 0.f, l1 = 0.f;
    for (int key = tid; key < SEQ; key += NTHR) { const bf16_t* kr = K + ((size_t)b * SEQ + key) * DM + hd * 128; const bf16_t* qr = Q + (size_t)row * DM + hd * 128;
        float s0 = 0.f, s1 = 0.f; for (int d = 0; d < 64; ++d) { s0 += bf2f(qr[d]) * bf2f(kr[d]); s1 += bf2f(qr[64 + d]) * bf2f(kr[64 + d]); }
        const float e0 = fexp2(s0 - Mc), e1 = fexp2(s1 - Mc); p0[key] = e0; p1[key] = e1; l0 += e0; l1 += e1; }
    l0 = wave_sum(l0); l1 = wave_sum(l1); if ((tid & 63) == 0) { red[tid >> 6] = l0; red[8 + (tid >> 6)] = l1; }
    __syncthreads();
    l0 = 0.f; l1 = 0.f; for (int w = 0; w < 8; ++w) { l0 += red[w]; l1 += red[8 + w]; }
    __syncthreads();
    const int dv = tid & 127, part = tid >> 7; float o = 0.f;
    for (int key = part * 2048; key < part * 2048 + 2048; ++key) o += (p0[key] / l0 - lamv * p1[key] / l1) * bf2f(V[((size_t)b * SEQ + key) * DM + hd * 128 + dv]);
    red[16 + part * 128 + dv] = o; __syncthreads();
    if (tid < 128) { o = red[16 + tid] + red[16 + 128 + tid] + red[16 + 256 + tid] + red[16 + 384 + tid]; red[600 + tid] = o * o; }
    __syncthreads();
    if (tid < 128) { float ss = 0.f; for (int i = 0; i < 128; ++i) ss += red[600 + i]; const float ref = o / sqrtf(ss / 128.0f + EPS) * A.in[I_ATSUB][al * 128 + tid] * omli;
        dg_put(A, k, dg_rel(bf2f(((const bf16_t*)(A.ws + WS_HM))[(size_t)row * DM + hd * 128 + tid]), ref)); }
    __syncthreads();
}
__device__ __forceinline__ void dg_save(const Args& A, int k, const float* xold) {
    const int lane = threadIdx.x & 63, gwv = blockIdx.x * 8 + (threadIdx.x >> 6);
    const unsigned h = dg_hash(gwv, k); const int row = h & (MTOK - 1), col = (h >> 16) & 1023;
    float* sv = (float*)(A.ws + TB_LSUM) + 7 * 1024 * 1024 / 4;
    if (lane == 0) sv[k * 4096 + gwv] = xold[(size_t)row * DM + col];
}
__device__ __forceinline__ void dg_res(const Args& A, int k, const float* xnew, const float* gate, const bf16_t* Am, int K, const float* W) {
    const int lane = threadIdx.x & 63, gwv = blockIdx.x * 8 + (threadIdx.x >> 6);
    const unsigned h = dg_hash(gwv, k); const int row = h & (MTOK - 1), col = (h >> 16) & 1023, b = row >> 13;
    const float* sv = (const float*)(A.ws + TB_LSUM) + 7 * 1024 * 1024 / 4;
    float a = 0.f; for (int kk = lane; kk < K; kk += 64) a += bf2f(Am[(size_t)row * K + kk]) * dg_bfr(W[(size_t)kk * DM + col]);
    a = wave_sum(a);
    const float ref = sv[k * 4096 + gwv] + gate[(size_t)b * 6144 + col] * a;
    if (lane == 0) dg_put(A, k, dg_rel(xnew[(size_t)row * DM + col], ref));
}
__device__ __forceinline__ void dg_swiglu(const Args& A, int k, const bf16_t* Am, const float* W, int F, const bf16_t* H, int nrows, const int* rowmap) {
    const int lane = threadIdx.x & 63, gwv = blockIdx.x * 8 + (threadIdx.x >> 6);
    const unsigned h = dg_hash(gwv, k); const int row = (h & 0xfffff) % nrows, j = (h >> 20) % F;
    float g = 0.f, u = 0.f; for (int kk = lane; kk < DM; kk += 64) { const float x = bf2f(Am[(size_t)row * DM + kk]); g += x * dg_bfr(W[(size_t)kk * 2 * F + j]); u += x * dg_bfr(W[(size_t)kk * 2 * F + F + j]); }
    g = wave_sum(g); u = wave_sum(u);
    const float ref = g / (1.0f + expf(-g)) * u;
    if (lane == 0) dg_put(A, k, dg_rel(bf2f(H[(size_t)row * F + j]), ref));
}
__device__ __forceinline__ void dg_hgin(const Args& A, int k) {
    const int lane = threadIdx.x & 63, gwv = blockIdx.x * 8 + (threadIdx.x >> 6);
    const unsigned h = dg_hash(gwv, k); const int row = h & (MTOK - 1), col = (h >> 16) % 5120, grp = col >> 10, cc = col & 1023;
    float a = 0.f; for (int kk = lane; kk < DM; kk += 64) a += bf2f(((const bf16_t*)(A.ws + WS_HM))[(size_t)row * DM + kk]) * dg_bfr(A.in[I_HGWIN][(size_t)kk * 5120 + col]);
    a = wave_sum(a);
    float ref, got;
    if (grp == 0 || grp == 4) { ref = a / (1.0f + expf(-a)); got = bf2f(((const bf16_t*)(A.ws + (grp == 0 ? H_Q : H_G)))[(size_t)row * DM + cc]); }
    else if (grp == 3) { ref = a; got = bf2f(((const bf16_t*)(A.ws + H_V))[(size_t)row * DM + cc]); }
    else { const int d = grp - 1; const float* p = A.in[I_HGLB] + (size_t)d * DEPTH * 1024 + cc; float mx = p[0]; for (int l = 1; l < DEPTH; ++l) mx = fmaxf(mx, p[l * 1024]);
        float den = 0.f; for (int l = 0; l < DEPTH; ++l) den += expf(p[l * 1024] - mx); const float lbv = expf(p[1024] - mx) / den;
        ref = logf(lbv + (1.0f - lbv) / (1.0f + expf(-a))); got = gla::h2f(((const unsigned short*)(A.ws + (d ? H_LFB : H_LFF)))[(size_t)row * DM + cc]); }
    if (lane == 0) dg_put(A, k, dg_rel(got, ref));
}
__device__ __forceinline__ void dg_gla(const Args& A, int k) {
    const int lane = threadIdx.x & 63, gwv = blockIdx.x * 8 + (threadIdx.x >> 6);
    const unsigned h = dg_hash(gwv, k); const int sel0 = (gwv & 3) == 0; const int b = sel0 ? 0 : (h & 7), hd = sel0 ? 0 : ((h >> 3) & 7), dir = sel0 ? 0 : ((h >> 6) & 1), vc = sel0 ? ((h >> 7) & 63) : ((h >> 7) & 127);
    const bf16_t* Q = (const bf16_t*)(A.ws + H_Q); const unsigned short* LF = (const unsigned short*)(A.ws + (dir ? H_LFB : H_LFF)); const bf16_t* V = (const bf16_t*)(A.ws + H_V);
    const bf16_t* O = (const bf16_t*)(A.ws + (dir ? H_OB : H_OF));
    float s0 = 0.f, s1 = 0.f, e0 = 0.f, e1 = 0.f, e2 = 0.f, e3 = 0.f;
    for (int i = 0; i < SEQ; ++i) { const int tok = dir ? (SEQ - 1 - i) : i; const size_t o = ((size_t)b * SEQ + tok) * DM + hd * 128;
        const float f0 = expf(gla::h2f(LF[o + lane])), f1 = expf(gla::h2f(LF[o + 64 + lane])), v = bf2f(V[o + vc]);
        s0 = f0 * s0 + (1.0f - f0) * v; s1 = f1 * s1 + (1.0f - f1) * v;
        if (i < 128 || i % 61 == 0) { const float ov = wave_sum(bf2f(Q[o + lane]) * s0 + bf2f(Q[o + 64 + lane]) * s1); const float er = 0.25f * fabsf(bf2f(O[o + vc]) - ov) / (fabsf(ov) + 1.0f);
            if (i == 0) e0 = er; else if (i < 64) e1 = fmaxf(e1, er); else if (i < 128) e2 = fmaxf(e2, er); else e3 = fmaxf(e3, er); } }
    if (lane == 0) { dg_put(A, k, e0); dg_put(A, k + 4, e1); dg_put(A, k + 5, e2); dg_put(A, k + 6, e3); }
    const float* dbg = (const float*)(A.ws + TB_LSUM); const unsigned short* LF0 = (const unsigned short*)(A.ws + H_LFF); const bf16_t* Q0 = (const bf16_t*)(A.ws + H_Q);
    { const unsigned h2 = dg_hash(gwv, k + 100); const int t = h2 & 63, kk = (h2 >> 6) & 127; float c = 0.f; for (int tt = 0; tt <= t; ++tt) c += gla::h2f(LF0[(size_t)tt * DM + kk]);
      if (lane == 0) dg_put(A, k + 1, dg_rel(dbg[t * 128 + kk], c)); }
    { const unsigned h2 = dg_hash(gwv, k + 200); const int t = h2 & 63, sidx = (h2 >> 6) & 63; float a = 0.f;
      if (sidx <= t) { for (int kk = lane; kk < 128; kk += 64) { float c = 0.f; for (int tt = sidx + 1; tt <= t; ++tt) c += gla::h2f(LF0[(size_t)tt * DM + kk]);
              a += bf2f(Q0[(size_t)t * DM + kk]) * (1.0f - expf(gla::h2f(LF0[(size_t)sidx * DM + kk]))) * expf(c); } a = wave_sum(a); }
      const unsigned short got = ((const unsigned short*)(dbg + 8192))[gla::sw128(t, sidx * 2) / 2];
      if (lane == 0) dg_put(A, k + 2, 5.0f * fabsf(bf2f(got) - a) / (fabsf(a) + 0.01f)); }
    { const unsigned h2 = dg_hash(gwv, k + 300); const int sidx = h2 & 63, v = (h2 >> 6) & 63;
      const unsigned short got = ((const unsigned short*)(dbg + 8192 + 2048))[gla::sw128(v, sidx * 2) / 2];
      if (lane == 0) dg_put(A, k + 2, dg_rel(bf2f(got), bf2f(((const bf16_t*)(A.ws + H_V))[(size_t)sidx * DM + v]))); }
    { const unsigned h2 = dg_hash(gwv, k + 500); const int kk = h2 & 127, v = (h2 >> 7) & 63;
      float a = 0.f; { const int sidx = lane; float c = 0.f; for (int tt = sidx + 1; tt < 64; ++tt) c += gla::h2f(LF0[(size_t)tt * DM + kk]);
          const float ksn = (1.0f - expf(gla::h2f(LF0[(size_t)sidx * DM + kk]))) * expf(c);
          const unsigned short gk = ((const unsigned short*)(dbg + 16384))[gla::sw128(kk, sidx * 2) / 2];
          dg_put(A, k + 2, 0.5f * fabsf(bf2f(gk) - ksn) / (fabsf(ksn) + 0.01f));
          a = ksn * bf2f(((const bf16_t*)(A.ws + H_V))[(size_t)sidx * DM + v]); }
      a = wave_sum(a);
      const unsigned short gs = ((const unsigned short*)(dbg + 12288))[gla::sw256(v, kk * 2) / 2];
      if (lane == 0) dg_put(A, k + 3, 0.5f * fabsf(bf2f(gs) - a) / (fabsf(a) + 0.05f)); }
    { const unsigned h2 = dg_hash(gwv, k + 400); const int t = h2 & 63, v = (h2 >> 6) & 63;
      const unsigned short* at = (const unsigned short*)(dbg + 8192); const unsigned short* vt = (const unsigned short*)(dbg + 8192 + 2048);
      float a = bf2f(at[gla::sw128(t, lane * 2) / 2]) * bf2f(vt[gla::sw128(v, lane * 2) / 2]); a = wave_sum(a);
      if (lane == 0) dg_put(A, k + 1, 5.0f * dg_rel(bf2f(((const bf16_t*)(A.ws + H_OF))[(size_t)t * DM + v]), a)); }
}
__device__ __forceinline__ void dg_normo(const Args& A, int k) {
    const int lane = threadIdx.x & 63, gwv = blockIdx.x * 8 + (threadIdx.x >> 6);
    const unsigned h = dg_hash(gwv, k); const int row = h & (MTOK - 1), hd = (h >> 16) & 7; const size_t o = (size_t)row * DM + hd * 128;
    const float v0 = bf2f(((const bf16_t*)(A.ws + H_OF))[o + lane]) + bf2f(((const bf16_t*)(A.ws + H_OB))[o + lane]), v1 = bf2f(((const bf16_t*)(A.ws + H_OF))[o + 64 + lane]) + bf2f(((const bf16_t*)(A.ws + H_OB))[o + 64 + lane]);
    const float ss = wave_sum(v0 * v0 + v1 * v1), rstd = 1.0f / sqrtf(ss / 128.0f + EPS);
    const float r0 = v0 * rstd * A.in[I_HGNG][lane] * bf2f(((const bf16_t*)(A.ws + H_G))[o + lane]), r1 = v1 * rstd * A.in[I_HGNG][64 + lane] * bf2f(((const bf16_t*)(A.ws + H_G))[o + 64 + lane]);
    dg_put(A, k, fmaxf(dg_rel(bf2f(((const bf16_t*)(A.ws + WS_HM))[o + lane]), r0), dg_rel(bf2f(((const bf16_t*)(A.ws + WS_HM))[o + 64 + lane]), r1)));
}
__device__ __forceinline__ void dg_router(const Args& A, int k, int L) {
    const int lane = threadIdx.x & 63, gwv = blockIdx.x * 8 + (threadIdx.x >> 6);
    const int row = dg_hash(gwv, k) & (MTOK - 1), b = row >> 13; const float* x = A.out + (size_t)row * DM;
    const float* modl = (const float*)(A.ws + TB_MODS) + ((size_t)L * NBATCH + b) * 6144; const float* gain = A.in[I_N2G] + L * DM; const float* R = A.in[I_MOER] + (size_t)(L >> 1) * DM * 8;
    float ss = 0.f; for (int c = lane; c < DM; c += 64) ss += x[c] * x[c];
    ss = wave_sum(ss); const float rstd = 1.0f / sqrtf(ss / DM + EPS);
    float lg[8]; for (int e = 0; e < 8; ++e) lg[e] = 0.f;
    for (int c = lane; c < DM; c += 64) { const float hv = x[c] * rstd * gain[c] * (1.0f + modl[4 * 1024 + c]) + modl[3 * 1024 + c]; for (int e = 0; e < 8; ++e) lg[e] += hv * R[c * 8 + e]; }
    for (int e = 0; e < 8; ++e) lg[e] = wave_sum(lg[e]);
    int e0 = 0; for (int e = 1; e < 8; ++e) if (lg[e] > lg[e0]) e0 = e;
    int e1 = (e0 == 0) ? 1 : 0; for (int e = 0; e < 8; ++e) if (e != e0 && lg[e] > lg[e1]) e1 = e;
    float gap = 1e9f; for (int e = 0; e < 8; ++e) if (e != e0 && e != e1) gap = fminf(gap, lg[e1] - lg[e]); gap = fminf(gap, lg[e0] - lg[e1]);
    const int g0 = ((const int*)(A.ws + TB_EID))[row * 2], g1 = ((const int*)(A.ws + TB_EID))[row * 2 + 1]; const float w0 = ((const float*)(A.ws + TB_GATE))[row * 2], w1 = ((const float*)(A.ws + TB_GATE))[row * 2 + 1];
    const float p0 = 1.0f / (1.0f + expf(lg[e1] - lg[e0]));
    float er = (g0 != e0 || g1 != e1) ? (gap > 2e-3f ? 9.f : 0.f) : fmaxf(fabsf(w0 - p0), fabsf(w1 - (1.0f - p0)));
    if (lane == 0) dg_put(A, k, er);
}
__device__ __forceinline__ void dg_place(const Args& A, int k) {
    const int lane = threadIdx.x & 63, gwv = blockIdx.x * 8 + (threadIdx.x >> 6);
    const unsigned h = dg_hash(gwv, k); const int row = h & (MTOK - 1), kk = (h >> 16) & 1;
    const int sl = ((const int*)(A.ws + TB_SLOT))[row * 2 + kk], e = ((const int*)(A.ws + TB_EID))[row * 2 + kk]; const int* ts = (const int*)(A.ws + TB_TILES);
    float er = (sl >= ts[e] * 256 && sl < ts[e + 1] * 256 && sl < MOE_ROWS) ? 0.f : 7.f;
    if (er == 0.f) for (int c = lane; c < DM; c += 64) if (((const bf16_t*)(A.ws + E_XS))[(size_t)sl * DM + c] != ((const bf16_t*)(A.ws + WS_HM))[(size_t)row * DM + c]) er = 5.f;
    dg_put(A, k, er);
}
__device__ __forceinline__ void dg_moe_hid(const Args& A, int k, int m) {
    const int lane = threadIdx.x & 63, gwv = blockIdx.x * 8 + (threadIdx.x >> 6);
    const unsigned h = dg_hash(gwv, k); const int row = h & (MTOK - 1), kk = (h >> 16) & 1, j = (h >> 17) % DFFE;
    const int sl = ((const int*)(A.ws + TB_SLOT))[row * 2 + kk], e = ((const int*)(A.ws + TB_EID))[row * 2 + kk];
    const float* W = A.in[I_MOEGU] + ((size_t)m * 8 + e) * DM * 2 * DFFE; const bf16_t* Am = (const bf16_t*)(A.ws + E_XS) + (size_t)sl * DM;
    float g = 0.f, u = 0.f; for (int c = lane; c < DM; c += 64) { const float x = bf2f(Am[c]); g += x * dg_bfr(W[(size_t)c * 2 * DFFE + j]); u += x * dg_bfr(W[(size_t)c * 2 * DFFE + DFFE + j]); }
    g = wave_sum(g); u = wave_sum(u);
    if (lane == 0) dg_put(A, k, dg_rel(bf2f(((const bf16_t*)(A.ws + E_HID))[(size_t)sl * DFFE + j]), g / (1.0f + expf(-g)) * u));
}
__device__ __forceinline__ void dg_moe_y(const Args& A, int k, int m) {
    const int lane = threadIdx.x & 63, gwv = blockIdx.x * 8 + (threadIdx.x >> 6);
    const unsigned h = dg_hash(gwv, k); const int row = h & (MTOK - 1), kk = (h >> 16) & 1, col = (h >> 17) & 1023;
    const int sl = ((const int*)(A.ws + TB_SLOT))[row * 2 + kk], e = ((const int*)(A.ws + TB_EID))[row * 2 + kk];
    const float* W = A.in[I_MOEDN] + ((size_t)m * 8 + e) * DFFE * DM; const bf16_t* Hh = (const bf16_t*)(A.ws + E_HID) + (size_t)sl * DFFE;
    float a = 0.f; for (int j = lane; j < DFFE; j += 64) a += bf2f(Hh[j]) * dg_bfr(W[(size_t)j * DM + col]);
    a = wave_sum(a);
    if (lane == 0) dg_put(A, k, fabsf(bf2f(((const bf16_t*)(A.ws + E_XS))[(size_t)sl * DM + col]) - a) / (fabsf(a) + 0.3f));
}
__device__ __forceinline__ void dg_combine(const Args& A, int k, const float* modprev) {
    const int lane = threadIdx.x & 63, gwv = blockIdx.x * 8 + (threadIdx.x >> 6);
    const unsigned h = dg_hash(gwv, k); const int row = h & (MTOK - 1), col = (h >> 16) & 1023, b = row >> 13;
    const float* sv = (const float*)(A.ws + TB_LSUM) + 7 * 1024 * 1024 / 4; const bf16_t* Y = (const bf16_t*)(A.ws + E_XS);
    const int s0 = ((const int*)(A.ws + TB_SLOT))[row * 2], s1 = ((const int*)(A.ws + TB_SLOT))[row * 2 + 1]; const float w0 = ((const float*)(A.ws + TB_GATE))[row * 2], w1 = ((const float*)(A.ws + TB_GATE))[row * 2 + 1];
    const float ref = sv[k * 4096 + gwv] + modprev[(size_t)b * 6144 + 5 * 1024 + col] * (w0 * bf2f(Y[(size_t)s0 * DM + col]) + w1 * bf2f(Y[(size_t)s1 * DM + col]));
    if (lane == 0) dg_put(A, k, dg_rel(A.out[(size_t)row * DM + col], ref));
}
__device__ __forceinline__ void dg_lruin(const Args& A, int k) {
    const int lane = threadIdx.x & 63, gwv = blockIdx.x * 8 + (threadIdx.x >> 6);
    const unsigned h = dg_hash(gwv, k); const int row = h & (MTOK - 1), col = (h >> 16) % 2560;
    float a = 0.f; for (int kk = lane; kk < DM; kk += 64) a += bf2f(((const bf16_t*)(A.ws + WS_HM))[(size_t)row * DM + kk]) * dg_bfr(A.in[I_LRWIN][(size_t)kk * 2560 + col]);
    a = wave_sum(a);
    float ref, got;
    if (col < LRUW) { ref = 0.5f * a * (1.0f + tanhf(0.7978845608028654f * (a + 0.044715f * a * a * a))); got = bf2f(((const bf16_t*)(A.ws + L_YB))[(size_t)row * LRUW + col]); }
    else { ref = a; got = bf2f(((const bf16_t*)(A.ws + L_XB))[(size_t)row * LRUW + col - LRUW]); }
    if (lane == 0) dg_put(A, k, dg_rel(got, ref));
}
__device__ __forceinline__ void dg_lru(const Args& A, int k) {
    const int lane = threadIdx.x & 63, gwv = blockIdx.x * 8 + (threadIdx.x >> 6);
    const unsigned h = dg_hash(gwv, k); const int b = h & 7, ch = (h >> 3) % LRUW, tc = (h >> 16) & (SEQ - 1), n = ch / 128, j = ch % 128;
    const bf16_t* XB = (const bf16_t*)(A.ws + L_XB) + (size_t)b * SEQ * LRUW;
    float hres[2];
    for (int d = 0; d < 2; ++d) {
        const float* wa = A.in[I_LRWA] + (size_t)(d * 10 + n) * 16384; const float* wx = A.in[I_LRWX] + (size_t)(d * 10 + n) * 16384;
        const float wa0 = dg_bfr(wa[lane * 128 + j]), wa1 = dg_bfr(wa[(lane + 64) * 128 + j]), wx0 = dg_bfr(wx[lane * 128 + j]), wx1 = dg_bfr(wx[(lane + 64) * 128 + j]);
        const float ba = A.in[I_LRBA][d * LRUW + ch], bx = A.in[I_LRBX][d * LRUW + ch]; const float lam = A.in[I_LRLAM][d * LRUW + ch]; const float sp = log1pf(expf(-lam));
        float hs = 0.f;
        for (int i = 0; ; ++i) { const int t = d ? (SEQ - 1 - i) : i;
            float x0 = A.in[I_LRCB][n * 128 + lane], x1 = A.in[I_LRCB][n * 128 + 64 + lane], xj = A.in[I_LRCB][ch];
            for (int w = 0; w < 4; ++w) { const int tt = t - 1 + w; if (tt >= 0 && tt < SEQ) {
                x0 += A.in[I_LRCW][w * LRUW + n * 128 + lane] * bf2f(XB[(size_t)tt * LRUW + n * 128 + lane]); x1 += A.in[I_LRCW][w * LRUW + n * 128 + 64 + lane] * bf2f(XB[(size_t)tt * LRUW + n * 128 + 64 + lane]);
                xj += A.in[I_LRCW][w * LRUW + ch] * bf2f(XB[(size_t)tt * LRUW + ch]); } }
            const float rp = wave_sum(dg_bfr(x0) * wa0 + dg_bfr(x1) * wa1), ip = wave_sum(dg_bfr(x0) * wx0 + dg_bfr(x1) * wx1);
            const float rg = 1.0f / (1.0f + expf(-(rp + ba))), ig = 1.0f / (1.0f + expf(-(ip + bx))); const float la = -8.0f * rg * sp;
            hs = expf(la) * hs + sqrtf(fmaxf(-expm1f(2.0f * la), 0.f)) * ig * xj;
            if (t == tc) break; }
        hres[d] = hs;
    }
    const size_t go = ((size_t)b * SEQ + tc) * LRUW + ch;
    const float e1 = fabsf(bf2f(((const bf16_t*)(A.ws + L_HF))[go]) - hres[0]) / (fabsf(hres[0]) + 0.3f);
    const float ref = (hres[0] + hres[1]) * bf2f(((const bf16_t*)(A.ws + L_YB))[go]);
    const float e2 = fabsf(bf2f(((const bf16_t*)(A.ws + L_HY))[go]) - ref) / (fabsf(ref) + 0.3f);
    if (lane == 0) { dg_put(A, k, e1); dg_put(A, k + 5, e2); }
}
__device__ __forceinline__ void dg_final(const Args& A, int nchk) {
    const unsigned* sl = (const unsigned*)(A.ws + WS_CTL) + DG_BASE; int code = 0; float ev = 0.f;
    for (int k = 1; k <= nchk; ++k) { const float e = __uint_as_float(sl[64 * k]); if (e > 0.05f) { code = k; ev = e; break; } }
    if (code == 0) return;
    const int c1 = code % 10, c10 = code / 10;
    const float s = -(float)c1;
    for (size_t i = (size_t)blockIdx.x * NTHR + threadIdx.x; i < (size_t)MTOK * DM; i += (size_t)gridDim.x * NTHR) A.out[i] = A.in[I_X][i] * s;
    __syncthreads();
    if (blockIdx.x == 0 && threadIdx.x == 0) { const int qq = ev < 0.1f ? 1 : ev < 0.2f ? 2 : ev < 0.5f ? 3 : ev < 1.f ? 4 : ev < 2.f ? 5 : ev < 5.f ? 6 : ev < 20.f ? 7 : ev < 1e3f ? 8 : 9;
        A.out[12345] = 100.f * (float)(10 * c10 + qq); }
}
#define DG(x) x
#define DGL(x) if constexpr (L >= DIAG_FROM) { x }
#else
#define DG(x)
#define DGL(x)
#endif

#define GRID_BAR() xcd_barrier(bar)
template <int L>
__device__ __forceinline__ void run_mixer(const Args& args, LAS unsigned char* lds, int bid, int G, const XcdBarrier& bar) {
    unsigned char* ws = args.ws; bf16_t* xo = (bf16_t*)(ws + WS_XB);
    const float* modl = (const float*)(ws + TB_MODS) + (size_t)L * NBATCH * 6144;
    const void* xs = (L == 0) ? (const void*)args.in[I_X] : (const void*)xo; constexpr bool X16 = (L != 0);
    constexpr int kind = L % 3;
    DGL(if (L > 0 && ((L - 1) & 1)) { dg_save(args, 10 * (L - 1) + 9, xo); GRID_BAR(); })
    norm_phase<false>(args, lds, bid, G, xs, X16, xo, true, args.in[I_N1G] + L * DM, modl, 0, (L > 0) && ((L - 1) & 1), modl - NBATCH * 6144, false, nullptr);
    GRID_BAR();
    DGL(if (L > 0 && ((L - 1) & 1)) { dg_combine(args, 10 * (L - 1) + 9, modl - NBATCH * 6144); GRID_BAR(); })
    DGL(dg_norm(args, 10 * L + 1, (L > 0 && ((L - 1) & 1)) ? xo : xs, args.in[I_N1G] + L * DM, L, 0); GRID_BAR();)
    if constexpr (kind == 0) {
        constexpr int al = L / 3;
        {
            pg8::Gemm g{(const bf16_t*)(ws + WS_HM), (const bf16_t*)(ws + W_QKV) + (size_t)al * 3072 * 1024, 1024};
            pg8::TileOrder S; S.init(256, 12, G, bid);
            pg8::EpiQKV E{(bf16_t*)(ws + A_Q), (bf16_t*)(ws + A_K), (bf16_t*)(ws + A_V), args.in[I_ATQN] + al * 64, args.in[I_ATKN] + al * 64,
                          (const float*)(ws + TB_COS), (const float*)(ws + TB_SIN), LOG2E};
            pg8::gemm_phase<pg8::EpiQKV>(lds, g, S, E);
        }
        GRID_BAR();
        vt_phase(args, bid, G);
        GRID_BAR();
        attn_phase(args, lds, bid, G, al);
        GRID_BAR();
        DGL(dg_save(args, 10 * L + 4, xs); GRID_BAR();)
        {
            pg8::Gemm g{(const bf16_t*)(ws + WS_HM), (const bf16_t*)(ws + W_AO) + (size_t)al * 1024 * 1024, 1024};
            pg8::TileOrder S; S.init(256, 4, G, bid);
            pg8::EpiRes<X16> E{xs, xo, modl + 2 * 1024, 1.0f};
            pg8::gemm_phase<pg8::EpiRes<X16>>(lds, g, S, E);
        }
        GRID_BAR();
        DGL(dg_res(args, 10 * L + 4, xo, modl + 2 * 1024, (const bf16_t*)(ws + WS_HM), 1024, args.in[I_ATWOUT] + (size_t)al * 1024 * 1024); GRID_BAR();)
    }
    if constexpr (kind == 1) {
        {
            pg8::Gemm g{(const bf16_t*)(ws + WS_HM), (const bf16_t*)(ws + W_HGI), 1024};
            pg8::TileOrder S; S.init(256, 20, G, bid);
            pg8::EpiAct E{0, ws, (const float*)(ws + TB_LB)};
            pg8::gemm_phase<pg8::EpiAct>(lds, g, S, E);
        }
        GRID_BAR();
        DGL(dg_hgin(args, 10 * L + 2); GRID_BAR();)
        gla_phase(args, lds, bid, G);
        GRID_BAR();
        DGL(dg_gla(args, 10 * L + 3); GRID_BAR();)
        hg_normo_phase(args, bid, G);
        GRID_BAR();
        DGL(dg_normo(args, 10 * L + 0); GRID_BAR();)
        DGL(dg_save(args, 10 * L + 4, xs); GRID_BAR();)
        {
            pg8::Gemm g{(const bf16_t*)(ws + WS_HM), (const bf16_t*)(ws + W_HGO), 1024};
            pg8::TileOrder S; S.init(256, 4, G, bid);
            pg8::EpiRes<X16> E{xs, xo, modl + 2 * 1024, 1.0f};
            pg8::gemm_phase<pg8::EpiRes<X16>>(lds, g, S, E);
        }
        GRID_BAR();
        DGL(dg_res(args, 10 * L + 4, xo, modl + 2 * 1024, (const bf16_t*)(ws + WS_HM), 1024, args.in[I_HGWOUT]); GRID_BAR();)
    }
    if constexpr (kind == 2) {
        {
            pg8::Gemm g{(const bf16_t*)(ws + WS_HM), (const bf16_t*)(ws + W_LRI), 1024};
            pg8::TileOrder S; S.init(256, 10, G, bid);
            pg8::EpiAct E{1, ws, nullptr};
            pg8::gemm_phase<pg8::EpiAct>(lds, g, S, E);
        }
        GRID_BAR();
        DGL(dg_lruin(args, 10 * L + 2); GRID_BAR();)
        lru_phase<0>(args, lds, bid, G);
        GRID_BAR();
        lru_carry_phase(args, bid, G);
        GRID_BAR();
        lru_apply_phase(args, lds, bid, G);
        GRID_BAR();
        DGL(dg_lru(args, 10 * L + 3); GRID_BAR();)
        DGL(dg_save(args, 10 * L + 4, xs); GRID_BAR();)
        {
            pg8::Gemm g{(const bf16_t*)(ws + L_HY), (const bf16_t*)(ws + W_LRO), LRUW};
            pg8::TileOrder S; S.init(256, 4, G, bid);
            pg8::EpiRes<X16> E{xs, xo, modl + 2 * 1024, 1.0f};
            pg8::gemm_phase<pg8::EpiRes<X16>>(lds, g, S, E);
        }
        GRID_BAR();
        DGL(dg_res(args, 10 * L + 4, xo, modl + 2 * 1024, (const bf16_t*)(ws + L_HY), LRUW, args.in[I_LRWOUT]); GRID_BAR();)
    }
}
template <int L>
__device__ __forceinline__ void run_ffn(const Args& args, LAS unsigned char* lds, int bid, int G, const XcdBarrier& bar) {
    unsigned char* ws = args.ws; bf16_t* xo = (bf16_t*)(ws + WS_XB);
    const float* modl = (const float*)(ws + TB_MODS) + (size_t)L * NBATCH * 6144;
    if constexpr ((L & 1) == 0) {
        constexpr int m = L >> 1;
        constexpr bool F8 = (L >= FP8_DENSE_FROM);
        norm_phase<false>(args, lds, bid, G, xo, true, xo, true, args.in[I_N2G] + L * DM, modl, 1, false, modl, false, nullptr, F8);
        GRID_BAR();
        if constexpr (F8) {
            pg8::Gemm g{(const bf16_t*)(ws + WS_HM), (const bf16_t*)(ws + W_FGU) + (size_t)m * 5632 * 1024, 512};
            pg8::TileOrder S; S.init(256, 22, G, bid);
            pg8::EpiSwiGLU8 E{ws + F_HID, DFF, 1.0f / MOE_WSCALE, MOE_HSCALE};
            pg8::gemm_phase<pg8::EpiSwiGLU8, true>(lds, g, S, E);
        } else {
            pg8::Gemm g{(const bf16_t*)(ws + WS_HM), (const bf16_t*)(ws + W_FGU) + (size_t)m * 5632 * 1024, 1024};
            pg8::TileOrder S; S.init(256, 22, G, bid);
            pg8::EpiSwiGLU E{(bf16_t*)(ws + F_HID), DFF};
            pg8::gemm_phase<pg8::EpiSwiGLU>(lds, g, S, E);
        }
        GRID_BAR();
        if constexpr (F8) {
            pg8::Gemm g{(const bf16_t*)(ws + F_HID), (const bf16_t*)(ws + W_FDN) + (size_t)m * 1024 * 2816, DFF / 2};
            pg8::TileOrder S; S.init(256, 4, G, bid);
            pg8::EpiRes<true> E{xo, xo, modl + 5 * 1024, 1.0f / (MOE_WSCALE * MOE_HSCALE)};
            pg8::gemm_phase<pg8::EpiRes<true>, true>(lds, g, S, E);
        } else {
            pg8::Gemm g{(const bf16_t*)(ws + F_HID), (const bf16_t*)(ws + W_FDN) + (size_t)m * 1024 * 2816, DFF};
            pg8::TileOrder S; S.init(256, 4, G, bid);
            pg8::EpiRes<true> E{xo, xo, modl + 5 * 1024, 1.0f};
            pg8::gemm_phase<pg8::EpiRes<true>>(lds, g, S, E);
        }
        GRID_BAR();
    } else {
        constexpr int m = L >> 1;
        norm_phase<true>(args, lds, bid, G, xo, true, xo, true, args.in[I_N2G] + L * DM, modl, 1, false, modl, false, args.in[I_MOER] + (size_t)m * DM * 8);
        GRID_BAR();
        DGL(dg_norm(args, 10 * L + 5, xo, args.in[I_N2G] + L * DM, L, 1); dg_router(args, 10 * L + 5, L); GRID_BAR();)
        place_phase(args, lds, bid, G);
        GRID_BAR();
        DGL(dg_place(args, 10 * L + 6); GRID_BAR();)
        const int* tiles = (const int*)(ws + TB_TILES);
        {
            pg8::Gemm g{(const bf16_t*)(ws + E_XS), (const bf16_t*)(ws + W_MGU + (size_t)m * 8 * 7168 * 1024), 512};
            pg8::TileOrder S; S.init(tiles[8], 28, G, bid);
#pragma unroll
            for (int e = 1; e < NEXP; ++e) S.ts[e] = tiles[e];
            pg8::EpiSwiGLU8 E{ws + E_HID, DFFE, 1.0f / MOE_WSCALE, MOE_HSCALE};
            pg8::gemm_phase<pg8::EpiSwiGLU8, true>(lds, g, S, E);
        }
        GRID_BAR();
        DGL(dg_moe_hid(args, 10 * L + 7, m); GRID_BAR();)
        {
            pg8::Gemm g{(const bf16_t*)(ws + E_HID), (const bf16_t*)(ws + W_MDN + (size_t)m * 8 * 1024 * 3584), DFFE / 2};
            pg8::TileOrder S; S.init(tiles[8], 4, G, bid);
#pragma unroll
            for (int e = 1; e < NEXP; ++e) S.ts[e] = tiles[e];
            pg8::EpiPlain E{(bf16_t*)(ws + E_XS), DM, 1.0f / (MOE_WSCALE * MOE_HSCALE)};
            pg8::gemm_phase<pg8::EpiPlain, true>(lds, g, S, E);
        }
        GRID_BAR();
        DGL(dg_moe_y(args, 10 * L + 8, m); GRID_BAR();)
    }
}
__device__ __forceinline__ void final_combine(const Args& args, LAS unsigned char* lds, int bid, int G, const XcdBarrier& bar) {
    const float* modl = (const float*)(args.ws + TB_MODS) + (size_t)3 * NBATCH * 6144;
    DG(dg_save(args, 39, args.out); GRID_BAR();)
    norm_phase<false>(args, lds, bid, G, args.ws + WS_XB, true, args.out, false, args.in[I_N1G], modl, 0, true, modl, true, nullptr);
    DG(GRID_BAR(); dg_combine(args, 39, modl);)
}

__global__ void __launch_bounds__(NTHR, 2) mega_fwd(Args args) {
    extern __shared__ __attribute__((aligned(16))) unsigned char lds_raw[];
    LAS unsigned char* lds = (LAS unsigned char*)lds_raw;
    const int tid = threadIdx.x, bid = blockIdx.x, G = gridDim.x;
    unsigned char* ws = args.ws;
    volatile LAS unsigned* MISC = (volatile LAS unsigned*)(lds + MISC_OFF);
    if (tid < 64) MISC[tid] = 0u;
    __syncthreads();
    XcdBarrier bar = xcd_barrier_post((unsigned*)(ws + WS_CTL) + CW_BAR, MISC + 8);

    prologue_phase(args, lds, bid, G);
    GRID_BAR();

    run_mixer<0>(args, lds, bid, G, bar);
    run_ffn<0>(args, lds, bid, G, bar);
    run_mixer<1>(args, lds, bid, G, bar);
    run_ffn<1>(args, lds, bid, G, bar);
    run_mixer<2>(args, lds, bid, G, bar);
    run_ffn<2>(args, lds, bid, G, bar);
    run_mixer<3>(args, lds, bid, G, bar);
    run_ffn<3>(args, lds, bid, G, bar);
    final_combine(args, lds, bid, G, bar);
    DG(GRID_BAR(); dg_final(args, 49);)
}

extern "C" void kernel_launch(void* const* d_in, const int* in_sizes, int n_in, void* d_out, int out_size, void* d_ws, size_t ws_size, hipStream_t stream) {
    static int grid = 0;
    if (grid == 0) {
        if (n_in != 30 || out_size != MTOK * DM || ws_size < WS_NEED) { fprintf(stderr, "kernel_launch: unexpected shapes (n_in %d out %d ws %zu need %zu)\n", n_in, out_size, ws_size, (size_t)WS_NEED); grid = -1; return; }
        int dev = 0, cus = 0;
        if (hipGetDevice(&dev) != hipSuccess || hipDeviceGetAttribute(&cus, hipDeviceAttributeMultiprocessorCount, dev) != hipSuccess) { grid = -1; return; }
        if (hipFuncSetAttribute((const void*)mega_fwd, hipFuncAttributeMaxDynamicSharedMemorySize, LDS_BYTES) != hipSuccess) { fprintf(stderr, "kernel_launch: hipFuncSetAttribute failed\n"); grid = -1; return; }
        int per_cu = 0;
        if (hipOccupancyMaxActiveBlocksPerMultiprocessor(&per_cu, (const void*)mega_fwd, NTHR, LDS_BYTES) != hipSuccess || per_cu < 1) { fprintf(stderr, "kernel_launch: occupancy query says %d\n", per_cu); }
        (void)hipGetLastError();
        grid = (cus >= 256) ? 256 : -1;
        if (grid < 0) { fprintf(stderr, "kernel_launch: needs 256 CUs, device has %d\n", cus); return; }
    }
    if (grid < 0) return;
    if (hipMemsetAsync((char*)d_ws + WS_CTL, 0, CTL_ZERO_BYTES, stream) != hipSuccess) return;
    Args a{};
    for (int i = 0; i < 30; ++i) a.in[i] = (const float*)d_in[i];
    a.out = (float*)d_out; a.ws = (unsigned char*)d_ws;
    hipLaunchKernelGGL(mega_fwd, dim3(grid), dim3(NTHR), LDS_BYTES, stream, a);
}
```

```cpp
#define DIAG_FROM 2
#include <hip/hip_runtime.h>
#include <cstdio>
#include <cstdint>

#define LAS __attribute__((address_space(3)))
#define GAS __attribute__((address_space(1)))
typedef unsigned short bf16_t;
typedef short bf16x8 __attribute__((ext_vector_type(8)));
typedef short s16x4 __attribute__((ext_vector_type(4)));
typedef float f32x2 __attribute__((ext_vector_type(2)));
typedef float f32x4 __attribute__((ext_vector_type(4)));
typedef float f32x16 __attribute__((ext_vector_type(16)));
typedef unsigned u32x2 __attribute__((ext_vector_type(2)));
typedef unsigned u32x4 __attribute__((ext_vector_type(4)));

constexpr int MTOK = 65536, DM = 1024, SEQ = 8192, NBATCH = 8, DEPTH = 4;
constexpr int DFF = 2816, DFFE = 3584, NEXP = 8, LRUW = 1280;
constexpr float EPS = 1e-6f;
constexpr int FP8_DENSE_FROM = 2;
constexpr float MOE_WSCALE = 64.0f, MOE_HSCALE = 4.0f;
constexpr float LOG2E = 1.4426950408889634f;

constexpr size_t MiB = 1u << 20;
constexpr size_t WS_CTL = 0, CTL_ZERO_BYTES = 1 * MiB;
constexpr size_t WS_TAB = 1 * MiB;
constexpr size_t TB_MODS = WS_TAB;
constexpr size_t TB_COS = WS_TAB + 1 * MiB;
constexpr size_t TB_SIN = WS_TAB + 2 * MiB;
constexpr size_t TB_SCAL = WS_TAB + 3 * MiB;
constexpr size_t TB_LB = TB_SCAL + 4096;
constexpr size_t TB_SP = TB_SCAL + 16384;
constexpr size_t TB_EID = WS_TAB + 4 * MiB;
constexpr size_t TB_GATE = WS_TAB + 5 * MiB;
constexpr size_t TB_SLOT = WS_TAB + 6 * MiB;
constexpr size_t TB_BCNT = WS_TAB + 7 * MiB;
constexpr size_t TB_TILES = TB_BCNT + 16384;
constexpr size_t TB_LSUM = WS_TAB + 8 * MiB;
constexpr size_t TB_LCIN = WS_TAB + 16 * MiB;
constexpr size_t WS_W = 32 * MiB;
constexpr size_t W_QKV = WS_W;
constexpr size_t W_AO = W_QKV + 2 * (size_t)3072 * 1024 * 2;
constexpr size_t W_HGI = W_AO + 2 * (size_t)1024 * 1024 * 2;
constexpr size_t W_HGO = W_HGI + (size_t)5120 * 1024 * 2;
constexpr size_t W_LRI = W_HGO + (size_t)1024 * 1024 * 2;
constexpr size_t W_LRG = W_LRI + (size_t)2560 * 1024 * 2;
constexpr size_t W_LRO = W_LRG + (size_t)10 * 2 * 256 * 128 * 2;
constexpr size_t W_FGU = W_LRO + (size_t)1024 * 1280 * 2;
constexpr size_t W_FDN = W_FGU + 2 * (size_t)5632 * 1024 * 2;
constexpr size_t W_MGU = W_FDN + 2 * (size_t)1024 * 2816 * 2;
constexpr size_t W_MDN = W_MGU + 16 * (size_t)7168 * 1024 * 2;
constexpr size_t W_END = W_MDN + 16 * (size_t)1024 * 3584 * 2;
constexpr size_t WS_HM = 440 * MiB;
constexpr size_t WS_ACT = 568 * MiB;
static_assert(W_END <= WS_HM, "weights overflow");
constexpr size_t SZ_TOK = (size_t)MTOK * 1024 * 2;
constexpr size_t A_Q = WS_ACT, A_K = A_Q + SZ_TOK, A_V = A_K + SZ_TOK, A_VT = A_V + SZ_TOK;
constexpr size_t F_HID = WS_ACT;
constexpr size_t H_Q = WS_ACT, H_LFF = H_Q + SZ_TOK, H_LFB = H_LFF + SZ_TOK, H_V = H_LFB + SZ_TOK, H_G = H_V + SZ_TOK, H_OF = H_G + SZ_TOK, H_OB = H_OF + SZ_TOK;
constexpr size_t SZ_LRU = (size_t)MTOK * 1280 * 2;
constexpr size_t L_YB = WS_ACT, L_XB = L_YB + SZ_LRU, L_HF = L_XB + SZ_LRU, L_HY = L_HF + SZ_LRU, L_U = L_HY + SZ_LRU;
constexpr int MOE_ROWS = 2 * MTOK + NEXP * 256;
constexpr size_t E_XS = WS_ACT, E_HID = E_XS + (size_t)MOE_ROWS * 1024 * 2, E_END = E_HID + (size_t)MOE_ROWS * DFFE;
constexpr size_t WS_XB = 1536 * MiB;
static_assert(E_END <= WS_XB && H_OB + SZ_TOK <= WS_XB && L_U + 2 * SZ_LRU <= WS_XB && A_VT + SZ_TOK <= WS_XB, "activation regions below the residual stream");
constexpr size_t WS_NEED = WS_XB + SZ_TOK;
static_assert(WS_NEED <= (size_t)1792 * MiB, "workspace");

constexpr int CW_BAR = 4096;

constexpr int RING_BYTES = 135168;
constexpr int MISC_OFF = RING_BYTES;
constexpr int LDS_BYTES = 147456;
constexpr int NWAVES = 8, NTHR = 512;

typedef __bf16 bf16x2v __attribute__((ext_vector_type(2)));
__device__ __forceinline__ unsigned cvt_pk_bf16(float lo, float hi) { const f32x2 v = {lo, hi}; const bf16x2v b = __builtin_convertvector(v, bf16x2v); return __builtin_bit_cast(unsigned, b); }
__device__ __forceinline__ unsigned pk_fp8x4(float a, float b, float c, float d) { unsigned w = 0; w = __builtin_amdgcn_cvt_pk_fp8_f32(a, b, w, false); w = __builtin_amdgcn_cvt_pk_fp8_f32(c, d, w, true); return w; }
__device__ __forceinline__ unsigned f2bf(float f) { unsigned u = __builtin_bit_cast(unsigned, f); return (u + 0x7fffu + ((u >> 16) & 1u)) >> 16; }
__device__ __forceinline__ float bf2f(unsigned short b) { return __builtin_bit_cast(float, ((unsigned)b) << 16); }
__device__ __forceinline__ float bflo(unsigned w) { return __builtin_bit_cast(float, w << 16); }
__device__ __forceinline__ float bfhi(unsigned w) { return __builtin_bit_cast(float, w & 0xffff0000u); }
__device__ __forceinline__ float fexp2(float x) { return __builtin_amdgcn_exp2f(x); }
__device__ __forceinline__ float fexp(float x) { return __builtin_amdgcn_exp2f(x * LOG2E); }
__device__ __forceinline__ float frcp(float x) { return __builtin_amdgcn_rcpf(x); }
__device__ __forceinline__ float fsigmoid(float x) { return frcp(1.0f + fexp(-x)); }
__device__ __forceinline__ float fsilu(float x) { return x * fsigmoid(x); }
__device__ __forceinline__ float wave_sum(float v) {
#pragma unroll
    for (int o = 1; o < 64; o <<= 1) v += __shfl_xor(v, o);
    return v;
}
#define LDS_WAIT() asm volatile("s_waitcnt lgkmcnt(0)" ::: "memory")
#define VM_WAIT() asm volatile("s_waitcnt vmcnt(0)" ::: "memory")

#define XB_TMO      128
#define XB_XCNT(j)  (256  + 64 * (j))
#define XB_XSUB(j)  (1280 + 64 * (j))
#define XB_XGEN(j)  (2304 + 64 * (j))
#define XB_TOP      3328
#define XB_TOPGEN   3392
#define XCD_BAR_WORDS 3456
#define XB_SPIN_CAP (1u << 22)
__device__ __forceinline__ unsigned xb_ld(unsigned* p)              { return __hip_atomic_load(p, __ATOMIC_RELAXED, __HIP_MEMORY_SCOPE_AGENT); }
__device__ __forceinline__ unsigned xb_add(unsigned* p, unsigned v) { return __hip_atomic_fetch_add(p, v, __ATOMIC_RELAXED, __HIP_MEMORY_SCOPE_AGENT); }
__device__ __forceinline__ unsigned xb_xcc_id() { return (unsigned)__builtin_amdgcn_s_getreg((3 << 11) | 20) & 0xFu; }
#define XB_SPIN(cond, bar) do { unsigned _sp = 0; while (cond) { __builtin_amdgcn_s_sleep(1); \
    if ((++_sp & 255u) == 0u) { if (xb_ld(&(bar)[XB_TMO])) break; if (_sp > XB_SPIN_CAP) { atomicAdd(&(bar)[XB_TMO], 1u); break; } } } } while (0)
struct XcdBarrier { unsigned* bar; unsigned x; volatile LAS unsigned* st; };
__device__ __forceinline__ XcdBarrier xcd_barrier_post(unsigned* bar, volatile LAS unsigned* st) {
    XcdBarrier b; b.bar = bar; b.x = xb_xcc_id(); b.st = st;
    if (threadIdx.x == 0) (void)xb_add(&bar[XB_XCNT(b.x)], 1u);
    return b;
}
__device__ __forceinline__ void xcd_barrier_complete(unsigned* bar, unsigned x, unsigned& nloc, unsigned& nx) {
    const unsigned G = gridDim.x * gridDim.y * gridDim.z;
    unsigned sum, cnt, mine, sp = 0u;
    for (;;) {
        sum = 0u; cnt = 0u; mine = 0u;
#pragma unroll
        for (unsigned j = 0; j < 16; ++j) { const unsigned c = xb_ld(&bar[XB_XCNT(j)]); sum += c; cnt += (c > 0u) ? 1u : 0u; mine = (j == x) ? c : mine; }
        if (sum == G) break;
        __builtin_amdgcn_s_sleep(1);
        if ((++sp & 255u) == 0u) { if (xb_ld(&bar[XB_TMO])) break; if (sp > XB_SPIN_CAP) { atomicAdd(&bar[XB_TMO], 1u); break; } }
    }
    nloc = mine > 0u ? mine : 1u; nx = cnt > 0u ? cnt : 1u;
}
__device__ __forceinline__ void xcd_barrier(const XcdBarrier& b) {
    asm volatile("s_waitcnt vmcnt(0)" ::: "memory");
    __syncthreads();
    if (threadIdx.x == 0) {
        unsigned* bar = b.bar;
        __builtin_amdgcn_s_waitcnt(0);
        unsigned nloc = b.st[0], nx = b.st[1];
        if (nloc == 0u) { xcd_barrier_complete(bar, b.x, nloc, nx); b.st[0] = nloc; b.st[1] = nx; }
        const unsigned old = xb_add(&bar[XB_XSUB(b.x)], 1u);
        const unsigned gen = old / nloc;
        if (old + 1u == (gen + 1u) * nloc) {
            __builtin_amdgcn_fence(__ATOMIC_RELEASE, "agent");
            asm volatile("s_waitcnt vmcnt(0)" ::: "memory");
            const unsigned og = xb_add(&bar[XB_TOP], 1u);
            const unsigned tg = og / nx;
            if (og + 1u == (tg + 1u) * nx) xb_add(&bar[XB_TOPGEN], 1u);
            else XB_SPIN(xb_ld(&bar[XB_TOPGEN]) == tg, bar);
            __builtin_amdgcn_fence(__ATOMIC_ACQUIRE, "agent");
            xb_add(&bar[XB_XGEN(b.x)], 1u);
            asm volatile("s_waitcnt vmcnt(0)" ::: "memory");
        } else {
            XB_SPIN(xb_ld(&bar[XB_XGEN(b.x)]) == gen, bar);
            __builtin_amdgcn_fence(__ATOMIC_ACQUIRE, "agent");
            asm volatile("s_waitcnt vmcnt(0)" ::: "memory");
        }
    }
    __syncthreads();
}

namespace pg8 {
constexpr int BM = 256, BK = 64, HALF = 128, HTB = HALF * BK * 2, STAGE_BYTES = 8 * HTB, NXCD = 8, WGM = 8;
__host__ __device__ __forceinline__ int lds_byte(int r, int c) { const int st = (r >> 4) * 2 + (c >> 5), rr = r & 15, cc = c & 31, ob = rr * 64 + cc * 2; return st * 1024 + (ob ^ (((ob >> 9) & 1) << 5)); }
__host__ __device__ __forceinline__ void stage_rc(int b, int& R, int& C) { const int st = b / 1024, sb = b % 1024, swz = sb ^ (((sb >> 9) & 1) << 5); R = (st >> 1) * 16 + swz / 64; C = (st & 1) * 32 + (swz % 64) / 2; }
__host__ __device__ __forceinline__ int perm32(int rho) { const int n = rho >> 4, i = rho & 15; return 8 * (i >> 2) + 4 * n + (i & 3); }

struct Unit { int pm, pn, pb; };
struct Gemm { const bf16_t* A; const bf16_t* Bt; int K; };

struct TileOrder {
    int nM, nN, nwg, G, c; int ts[NEXP];
    __device__ __forceinline__ void init(int nM_, int nN_, int G_, int c_) { nM = nM_; nN = nN_; nwg = nM * nN; G = G_; c = c_;
#pragma unroll
        for (int e = 0; e < NEXP; ++e) ts[e] = (e == 0) ? 0 : 0x7fffffff; }
    __device__ __forceinline__ bool next(int i, Unit& u) const {
        const long L = (long)i * G + c; if (L >= nwg) return false;
        int wgid = (int)L; { const int q = nwg / NXCD, r = nwg % NXCD, xcd = wgid % NXCD, off = wgid / NXCD; wgid = (xcd < r ? xcd * (q + 1) : r * (q + 1) + (xcd - r) * q) + off; }
        const int nig = WGM * nN, gid = wgid / nig, fm = gid * WGM, gsz = (nM - fm) < WGM ? (nM - fm) : WGM;
        u.pm = fm + ((wgid % nig) % gsz); u.pn = (wgid % nig) / gsz;
        int e = 0;
#pragma unroll
        for (int k = 1; k < NEXP; ++k) e += (u.pm >= ts[k]) ? 1 : 0;
        u.pb = e * nN + u.pn; return true;
    }
};

typedef int v8i32 __attribute__((ext_vector_type(8)));
template <class Epi, bool FP8 = false>
__device__ __forceinline__ void gemm_phase(LAS unsigned char* lds, const Gemm g, const TileOrder& S, const Epi& E) {
    int tid_ = threadIdx.x; asm volatile("" : "+v"(tid_));
    const int tid = tid_, wid = __builtin_amdgcn_readfirstlane(tid >> 6), lane = tid & 63, wr = wid >> 2, wc = wid & 3, fr = lane & 15, fq = lane >> 4;
    const int K = g.K, nt = K / BK;
    unsigned voffA[2], voffB[2];
#pragma unroll
    for (int i = 0; i < 2; ++i) { int R, C; stage_rc(tid * 16 + i * 8192, R, C); const int Rb = Epi::PERM ? ((R & ~31) + perm32(R & 31)) : R;
        voffA[i] = (unsigned)(R * K + C) * 2u; voffB[i] = (unsigned)(Rb * K + C) * 2u; }
    const size_t kstep = (size_t)(BK * 2);
    const size_t hstep = (size_t)HALF * K * 2;
    const size_t tstep = 2 * hstep;
    const unsigned ldsw = (unsigned)wid * 1024u;
    const int aoff = lds_byte(wr * 64 + fr, fq * 8), boff = lds_byte(wc * 32 + fr, fq * 8);
#define PG8_SA(b, h) (((b) * 2 + (h)) * HTB)
#define PG8_SB(b, h) ((4 + (b) * 2 + (h)) * HTB)
#define PG8_STAGE(bufoff, gbase, voff) do { _Pragma("unroll") for (int _i = 0; _i < 2; ++_i) \
        __builtin_amdgcn_global_load_lds((const unsigned*)((const char*)(gbase) + (voff)[_i]), (LAS unsigned*)(lds + (bufoff) + ldsw + _i * 8192), 16, 0, 0); } while (0)
#define PG8_LD8(p) __builtin_bit_cast(v8i32, __builtin_shufflevector(*(const LAS u32x4*)(p), *(const LAS u32x4*)((p) + 1024), 0, 1, 2, 3, 4, 5, 6, 7))
#define PG8_LDA(dst, b, h) do { if constexpr (FP8) { _Pragma("unroll") for (int m = 0; m < 4; ++m) dst##8[m] = PG8_LD8(lds + PG8_SA(b, h) + aoff + m * 2048); } \
        else { _Pragma("unroll") for (int m = 0; m < 4; ++m) _Pragma("unroll") for (int k = 0; k < 2; ++k) dst[m][k] = *(const LAS bf16x8*)(lds + PG8_SA(b, h) + aoff + m * 2048 + k * 1024); } } while (0)
#define PG8_LDB(dst, b, h) do { if constexpr (FP8) { _Pragma("unroll") for (int n = 0; n < 2; ++n) dst##8[n] = PG8_LD8(lds + PG8_SB(b, h) + boff + n * 2048); } \
        else { _Pragma("unroll") for (int n = 0; n < 2; ++n) _Pragma("unroll") for (int k = 0; k < 2; ++k) dst[n][k] = *(const LAS bf16x8*)(lds + PG8_SB(b, h) + boff + n * 2048 + k * 1024); } } while (0)
#define PG8_MMA(ai, bj, At, Bt) do { __builtin_amdgcn_s_setprio(1); \
        if constexpr (FP8) { _Pragma("unroll") for (int m = 0; m < 4; ++m) _Pragma("unroll") for (int n = 0; n < 2; ++n) \
            asm volatile("v_mfma_scale_f32_16x16x128_f8f6f4 %0, %1, %2, %0, %3, %3 op_sel_hi:[0,0,0]" : "+v"(acc[ai][bj][m][n]) : "v"(Bt##8[n]), "v"(At##8[m]), "v"(one_scale)); } \
        else { _Pragma("unroll") for (int m = 0; m < 4; ++m) _Pragma("unroll") for (int n = 0; n < 2; ++n) _Pragma("unroll") for (int k = 0; k < 2; ++k) \
            acc[ai][bj][m][n] = __builtin_amdgcn_mfma_f32_16x16x32_bf16(Bt[n][k], At[m][k], acc[ai][bj][m][n], 0, 0, 0); } \
        __builtin_amdgcn_s_setprio(0); } while (0)
#define PG8_WAIT_V(n) asm volatile("s_waitcnt vmcnt(" #n ")" ::: "memory")
#define PG8_WAIT_L(n) asm volatile("s_waitcnt lgkmcnt(" #n ")" ::: "memory")
#define PG8_BAR __builtin_amdgcn_s_barrier()
#define PG8_SCHED __builtin_amdgcn_sched_barrier(0)
    Unit cur, nxt; int ui = 0;
    if (!S.next(0, cur)) return;
    f32x4 acc[2][2][4][2];
#pragma unroll
    for (int a = 0; a < 2; ++a)
#pragma unroll
        for (int b = 0; b < 2; ++b)
#pragma unroll
            for (int m = 0; m < 4; ++m)
#pragma unroll
                for (int n = 0; n < 2; ++n) acc[a][b][m][n] = (f32x4){0.f, 0.f, 0.f, 0.f};
    bf16x8 At[4][2], B0[2][2], B1[2][2]; v8i32 At8[4], B08[2], B18[2];
    int one_scale = 0x7f7f7f7f; asm volatile("" : "+v"(one_scale));
    const char* cA = (const char*)g.A + (size_t)cur.pm * tstep; const char* cB = (const char*)g.Bt + (size_t)cur.pb * tstep;
    PG8_STAGE(PG8_SB(0, 0), cB, voffB); PG8_STAGE(PG8_SA(0, 0), cA, voffA); PG8_STAGE(PG8_SB(0, 1), cB + hstep, voffB); PG8_STAGE(PG8_SA(0, 1), cA + hstep, voffA);
    if (wr == 1) PG8_BAR;
    PG8_WAIT_V(4); PG8_BAR;
    PG8_STAGE(PG8_SB(1, 0), cB + kstep, voffB); PG8_STAGE(PG8_SA(1, 0), cA + kstep, voffA); PG8_STAGE(PG8_SB(1, 1), cB + hstep + kstep, voffB);
    PG8_WAIT_V(6); PG8_BAR;
    for (;;) {
        const bool has_next = S.next(ui + 1, nxt);
        const char* nA = has_next ? (const char*)g.A + (size_t)nxt.pm * tstep : cA; const char* nB = has_next ? (const char*)g.Bt + (size_t)nxt.pb * tstep : cB;
        for (int t = 0; t < nt; t += 2) {
            const bool last = (t == nt - 2);
            const char* a1 = cA + (size_t)(t + 1) * kstep;
            const char* a2 = last ? nA : cA + (size_t)(t + 2) * kstep; const char* b2 = last ? nB : cB + (size_t)(t + 2) * kstep;
            const char* a3 = a2 + kstep; const char* b3 = b2 + kstep;
            PG8_LDB(B0, 0, 0); PG8_SCHED; PG8_LDA(At, 0, 0); PG8_STAGE(PG8_SA(1, 1), a1 + hstep, voffA);
            PG8_WAIT_L(8); PG8_BAR; PG8_WAIT_L(0); PG8_MMA(0, 0, At, B0); PG8_BAR; PG8_SCHED;
            PG8_LDB(B1, 0, 1); PG8_STAGE(PG8_SB(0, 0), b2, voffB);
            PG8_BAR; PG8_WAIT_L(0); PG8_MMA(0, 1, At, B1); PG8_BAR;
            PG8_LDA(At, 0, 1); PG8_STAGE(PG8_SA(0, 0), a2, voffA);
            PG8_BAR; PG8_WAIT_L(0); PG8_MMA(1, 0, At, B0); PG8_BAR; PG8_SCHED;
            PG8_STAGE(PG8_SB(0, 1), b2 + hstep, voffB);
            PG8_WAIT_V(6); PG8_BAR; PG8_MMA(1, 1, At, B1); PG8_BAR;
            PG8_LDB(B0, 1, 0); PG8_SCHED; PG8_LDA(At, 1, 0); PG8_STAGE(PG8_SA(0, 1), a2 + hstep, voffA);
            PG8_WAIT_L(8); PG8_BAR; PG8_WAIT_L(0); PG8_MMA(0, 0, At, B0); PG8_BAR; PG8_SCHED;
            PG8_LDB(B1, 1, 1); PG8_STAGE(PG8_SB(1, 0), b3, voffB);
            PG8_BAR; PG8_WAIT_L(0); PG8_MMA(0, 1, At, B1); PG8_BAR;
            PG8_LDA(At, 1, 1); PG8_STAGE(PG8_SA(1, 0), a3, voffA);
            PG8_BAR; PG8_WAIT_L(0); PG8_MMA(1, 0, At, B0); PG8_BAR; PG8_SCHED;
            PG8_STAGE(PG8_SB(1, 1), b3 + hstep, voffB);
            PG8_WAIT_V(6); PG8_BAR; PG8_MMA(1, 1, At, B1); PG8_BAR;
        }
        if constexpr (FP8) asm volatile("s_nop 15\n\ts_nop 15" ::: "memory");
        E(acc, cur, wr, wc, fr, fq);
        if (!has_next) break;
#pragma unroll
        for (int a = 0; a < 2; ++a)
#pragma unroll
            for (int b = 0; b < 2; ++b)
#pragma unroll
                for (int m = 0; m < 4; ++m)
#pragma unroll
                    for (int n = 0; n < 2; ++n) acc[a][b][m][n] = (f32x4){0.f, 0.f, 0.f, 0.f};
        cur = nxt; cA = nA; cB = nB; ++ui;
    }
    PG8_WAIT_V(0);
    if (wr == 0) PG8_BAR;
    PG8_BAR;
#undef PG8_SA
#undef PG8_SB
#undef PG8_STAGE
#undef PG8_LDA
#undef PG8_LDB
#undef PG8_MMA
#undef PG8_LD8
#undef PG8_WAIT_V
#undef PG8_WAIT_L
#undef PG8_BAR
#undef PG8_SCHED
}

struct EpiQKV {
    static constexpr bool PERM = true;
    bf16_t *Q, *Kk, *V; const float *gq, *gk, *cosT, *sinT; float qscale;
    __device__ __forceinline__ void operator()(const f32x4 (&acc)[2][2][4][2], const Unit& u, int wr, int wc, int fr, int fq) const {
        const int row0 = u.pm * BM + wr * 64 + fr;
        if (u.pn >= 8) {
            const int col0 = (u.pn - 8) * BM + wc * 32 + 8 * fq;
#pragma unroll
            for (int ai = 0; ai < 2; ++ai)
#pragma unroll
                for (int m = 0; m < 4; ++m) { bf16_t* rowp = V + (size_t)(row0 + ai * HALF + m * 16) * DM + col0;
#pragma unroll
                    for (int bj = 0; bj < 2; ++bj) { const f32x4 v0 = acc[ai][bj][m][0], v1 = acc[ai][bj][m][1];
                        u32x4 w; w.x = cvt_pk_bf16(v0[0], v0[1]); w.y = cvt_pk_bf16(v0[2], v0[3]); w.z = cvt_pk_bf16(v1[0], v1[1]); w.w = cvt_pk_bf16(v1[2], v1[3]);
                        *(u32x4*)(rowp + bj * HALF) = w; } }
        } else {
            const int part = u.pn >> 2, sh = 4 * (u.pn & 3) + wc;
            bf16_t* dst = part ? Kk : Q; const float* g = part ? gk : gq; const float sc = part ? 1.0f : qscale;
            f32x4 g0[2], g1[2];
#pragma unroll
            for (int n = 0; n < 2; ++n) { g0[n] = *(const f32x4*)(g + 8 * fq + 4 * n); g1[n] = *(const f32x4*)(g + 32 + 8 * fq + 4 * n); }
#pragma unroll
            for (int ai = 0; ai < 2; ++ai)
#pragma unroll
                for (int m = 0; m < 4; ++m) {
                    const int r = row0 + ai * HALF + m * 16; const int pos = r & (SEQ - 1);
                    f32x4 x1[2], x2[2]; float ss = 0.f;
#pragma unroll
                    for (int n = 0; n < 2; ++n) { x1[n] = acc[ai][0][m][n]; x2[n] = acc[ai][1][m][n];
                        ss += (x1[n][0] * x1[n][0] + x1[n][1] * x1[n][1]) + (x1[n][2] * x1[n][2] + x1[n][3] * x1[n][3]);
                        ss += (x2[n][0] * x2[n][0] + x2[n][1] * x2[n][1]) + (x2[n][2] * x2[n][2] + x2[n][3] * x2[n][3]); }
                    ss += __shfl_xor(ss, 16); ss += __shfl_xor(ss, 32);
                    const float rstd = __builtin_amdgcn_rsqf(ss * (1.0f / 64.0f) + EPS) ;
                    unsigned char* op = (unsigned char*)dst + (size_t)r * DM + sh * 64 + 8 * fq;
                    u32x2 w1, w2;
#pragma unroll
                    for (int n = 0; n < 2; ++n) {
                        const f32x4 cs = *(const f32x4*)(cosT + pos * 32 + 8 * fq + 4 * n), sn = *(const f32x4*)(sinT + pos * 32 + 8 * fq + 4 * n);
                        const f32x4 y1 = x1[n] * rstd * g0[n], y2 = x2[n] * rstd * g1[n];
                        const f32x4 o1 = (y1 * cs - y2 * sn) * sc, o2 = (y2 * cs + y1 * sn) * sc;
                        if (n == 0) { w1.x = pk_fp8x4(o1[0], o1[1], o1[2], o1[3]); w2.x = pk_fp8x4(o2[0], o2[1], o2[2], o2[3]); }
                        else { w1.y = pk_fp8x4(o1[0], o1[1], o1[2], o1[3]); w2.y = pk_fp8x4(o2[0], o2[1], o2[2], o2[3]); }
                    }
                    *(u32x2*)(op) = w1; *(u32x2*)(op + 32) = w2;
                }
        }
    }
};
__device__ __forceinline__ f32x4 ld_x4(const void* p, size_t i, bool is16) {
    if (is16) { const u32x2 w = *(const u32x2*)((const bf16_t*)p + i); return (f32x4){bflo(w.x), bfhi(w.x), bflo(w.y), bfhi(w.y)}; }
    return *(const f32x4*)((const float*)p + i);
}
template <bool IN16>
struct EpiRes {
    static constexpr bool PERM = false;
    const void* xin; bf16_t* xout; const float* gate; float sc;
    __device__ __forceinline__ void operator()(const f32x4 (&acc)[2][2][4][2], const Unit& u, int wr, int wc, int fr, int fq) const {
        const int row0 = u.pm * BM + wr * 64 + fr, col0 = u.pn * BM + wc * 32 + 4 * fq;
        const float* gp = gate + (size_t)(u.pm >> 5) * 6144 + col0;
        f32x4 gv[2][2];
#pragma unroll
        for (int bj = 0; bj < 2; ++bj)
#pragma unroll
            for (int n = 0; n < 2; ++n) gv[bj][n] = *(const f32x4*)(gp + bj * HALF + n * 16) * sc;
#pragma unroll
        for (int ai = 0; ai < 2; ++ai)
#pragma unroll
            for (int m = 0; m < 4; ++m) { const size_t off = (size_t)(row0 + ai * HALF + m * 16) * DM + col0;
                f32x4 xv[2][2];
#pragma unroll
                for (int bj = 0; bj < 2; ++bj)
#pragma unroll
                    for (int n = 0; n < 2; ++n) xv[bj][n] = ld_x4(xin, off + bj * HALF + n * 16, IN16);
#pragma unroll
                for (int bj = 0; bj < 2; ++bj)
#pragma unroll
                    for (int n = 0; n < 2; ++n) { const f32x4 o = xv[bj][n] + gv[bj][n] * acc[ai][bj][m][n];
                        *(u32x2*)(xout + off + bj * HALF + n * 16) = (u32x2){cvt_pk_bf16(o[0], o[1]), cvt_pk_bf16(o[2], o[3])}; }
                if (m == 3) asm volatile("" ::: "memory"); }
    }
};
struct EpiSwiGLU {
    static constexpr bool PERM = true;
    bf16_t* H; int ldh;
    __device__ __forceinline__ void operator()(const f32x4 (&acc)[2][2][4][2], const Unit& u, int wr, int wc, int fr, int fq) const {
        const int row0 = u.pm * BM + wr * 64 + fr, col0 = u.pn * HALF + wc * 32 + 8 * fq;
#pragma unroll
        for (int ai = 0; ai < 2; ++ai)
#pragma unroll
            for (int m = 0; m < 4; ++m) { bf16_t* rowp = H + (size_t)(row0 + ai * HALF + m * 16) * ldh + col0;
                f32x4 v[2];
#pragma unroll
                for (int n = 0; n < 2; ++n) { const f32x4 gt = acc[ai][0][m][n], up = acc[ai][1][m][n];
#pragma unroll
                    for (int j = 0; j < 4; ++j) v[n][j] = fsilu(gt[j]) * up[j]; }
                u32x4 w; w.x = cvt_pk_bf16(v[0][0], v[0][1]); w.y = cvt_pk_bf16(v[0][2], v[0][3]); w.z = cvt_pk_bf16(v[1][0], v[1][1]); w.w = cvt_pk_bf16(v[1][2], v[1][3]);
                *(u32x4*)rowp = w; }
    }
};
struct EpiSwiGLU8 {
    static constexpr bool PERM = true;
    unsigned char* H; int ldh; float ws, hs;
    __device__ __forceinline__ void operator()(const f32x4 (&acc)[2][2][4][2], const Unit& u, int wr, int wc, int fr, int fq) const {
        const int row0 = u.pm * BM + wr * 64 + fr, col0 = u.pn * HALF + wc * 32 + 8 * fq;
#pragma unroll
        for (int ai = 0; ai < 2; ++ai)
#pragma unroll
            for (int m = 0; m < 4; ++m) { unsigned char* rowp = H + (size_t)(row0 + ai * HALF + m * 16) * ldh + col0;
                f32x4 v[2];
#pragma unroll
                for (int n = 0; n < 2; ++n) { const f32x4 gt = acc[ai][0][m][n] * ws, up = acc[ai][1][m][n] * (ws * hs);
#pragma unroll
                    for (int j = 0; j < 4; ++j) v[n][j] = fsilu(gt[j]) * up[j]; }
                *(u32x2*)rowp = (u32x2){pk_fp8x4(v[0][0], v[0][1], v[0][2], v[0][3]), pk_fp8x4(v[1][0], v[1][1], v[1][2], v[1][3])}; }
    }
};
struct EpiPlain {
    static constexpr bool PERM = true;
    bf16_t* O; int ldc; float sc;
    __device__ __forceinline__ void operator()(const f32x4 (&acc)[2][2][4][2], const Unit& u, int wr, int wc, int fr, int fq) const {
        const int row0 = u.pm * BM + wr * 64 + fr, col0 = u.pn * BM + wc * 32 + 8 * fq;
#pragma unroll
        for (int ai = 0; ai < 2; ++ai)
#pragma unroll
            for (int m = 0; m < 4; ++m) { bf16_t* rowp = O + (size_t)(row0 + ai * HALF + m * 16) * ldc + col0;
#pragma unroll
                for (int bj = 0; bj < 2; ++bj) { const f32x4 v0 = acc[ai][bj][m][0] * sc, v1 = acc[ai][bj][m][1] * sc;
                    u32x4 w; w.x = cvt_pk_bf16(v0[0], v0[1]); w.y = cvt_pk_bf16(v0[2], v0[3]); w.z = cvt_pk_bf16(v1[0], v1[1]); w.w = cvt_pk_bf16(v1[2], v1[3]);
                    *(u32x4*)(rowp + bj * HALF) = w; } }
    }
};
struct EpiAct {
    static constexpr bool PERM = true;
    int kind; unsigned char* ws; const float* lb;
    __device__ __forceinline__ void operator()(const f32x4 (&acc)[2][2][4][2], const Unit& u, int wr, int wc, int fr, int fq) const {
        const int row0 = u.pm * BM + wr * 64 + fr;
        int mode, ldc, colt; size_t boff;
        if (kind == 0) { const int grp = u.pn >> 2; colt = (u.pn & 3) * 256; ldc = 1024;
            boff = grp == 0 ? H_Q : grp == 1 ? H_LFF : grp == 2 ? H_LFB : grp == 3 ? H_V : H_G; mode = (grp == 0 || grp == 4) ? 1 : (grp == 3 ? 0 : 3); }
        else { ldc = LRUW; if (u.pn < 5) { boff = L_YB; colt = u.pn * 256; mode = 2; } else { boff = L_XB; colt = (u.pn - 5) * 256; mode = 0; } }
        bf16_t* base = (bf16_t*)(ws + boff);
        const int col0 = colt + wc * 32 + 8 * fq;
        f32x4 lbv[2][2];
        if (mode == 3) { const float* lp = lb + ((u.pn >> 2) - 1) * 1024 + col0;
#pragma unroll
            for (int bj = 0; bj < 2; ++bj)
#pragma unroll
                for (int n = 0; n < 2; ++n) lbv[bj][n] = *(const f32x4*)(lp + bj * HALF + 4 * n); }
#pragma unroll
        for (int ai = 0; ai < 2; ++ai)
#pragma unroll
            for (int m = 0; m < 4; ++m) { bf16_t* rowp = base + (size_t)(row0 + ai * HALF + m * 16) * ldc + col0;
#pragma unroll
                for (int bj = 0; bj < 2; ++bj) { f32x4 v[2]; u32x4 w;
#pragma unroll
                    for (int n = 0; n < 2; ++n) { v[n] = acc[ai][bj][m][n];
                        if (mode == 1) {
#pragma unroll
                            for (int j = 0; j < 4; ++j) v[n][j] = fsilu(v[n][j]); }
                        else if (mode == 2) {
#pragma unroll
                            for (int j = 0; j < 4; ++j) { const float x = v[n][j]; v[n][j] = x * fsigmoid(1.5957691216057308f * (x + 0.044715f * x * x * x)); } }
                        else if (mode == 3) {
#pragma unroll
                            for (int j = 0; j < 4; ++j) { const float l = lbv[bj][n][j]; const float fg = l + (1.0f - l) * fsigmoid(v[n][j]); v[n][j] = __builtin_amdgcn_logf(fg) * 0.6931471805599453f; } }
                    }
                    if (mode == 3) {
#pragma unroll
                        for (int n = 0; n < 2; ++n) { const _Float16 h0 = (_Float16)v[n][0], h1 = (_Float16)v[n][1], h2 = (_Float16)v[n][2], h3 = (_Float16)v[n][3];
                            const unsigned a = (unsigned)__builtin_bit_cast(unsigned short, h0) | ((unsigned)__builtin_bit_cast(unsigned short, h1) << 16);
                            const unsigned b = (unsigned)__builtin_bit_cast(unsigned short, h2) | ((unsigned)__builtin_bit_cast(unsigned short, h3) << 16);
                            if (n == 0) { w.x = a; w.y = b; } else { w.z = a; w.w = b; } }
                    } else { w.x = cvt_pk_bf16(v[0][0], v[0][1]); w.y = cvt_pk_bf16(v[0][2], v[0][3]); w.z = cvt_pk_bf16(v[1][0], v[1][1]); w.w = cvt_pk_bf16(v[1][2], v[1][3]); }
                    *(u32x4*)(rowp + bj * HALF) = w; } }
    }
};
}

struct Args { const float* in[30]; float* out; unsigned char* ws; };
enum { I_X = 0, I_C, I_ADAW, I_ADAB, I_N1G, I_N2G, I_ATWIN, I_ATQN, I_ATKN, I_ATLAM, I_ATSUB, I_ATWOUT, I_HGWIN, I_HGLB, I_HGNG, I_HGWOUT,
       I_LRWIN, I_LRCW, I_LRCB, I_LRWA, I_LRBA, I_LRWX, I_LRBX, I_LRLAM, I_LRWOUT, I_FFGU, I_FFDN, I_MOER, I_MOEGU, I_MOEDN };
enum { SC_LAM0 = 0, SC_LAM1, SC_OML0, SC_OML1, SC_MC0, SC_MC1 };

__device__ __forceinline__ void cvt_item(const float* W, int ldw, int src_col0, bf16_t* WT, int ldt, int dst_row0, int k0, LAS float* scr, int lane) {
#pragma unroll 8
    for (int i = 0; i < 32; ++i) { const int kk = 2 * i + (lane >> 5); scr[kk * 33 + (lane & 31)] = W[(size_t)(k0 + kk) * ldw + src_col0 + (lane & 31)]; }
    LDS_WAIT(); asm volatile("" ::: "memory");
    const int c = lane & 7;
#pragma unroll
    for (int j = 0; j < 4; ++j) { const int n = (lane >> 3) + 8 * j; const LAS float* s = scr + (8 * c) * 33 + n;
        u32x4 o; o.x = cvt_pk_bf16(s[0 * 33], s[1 * 33]); o.y = cvt_pk_bf16(s[2 * 33], s[3 * 33]); o.z = cvt_pk_bf16(s[4 * 33], s[5 * 33]); o.w = cvt_pk_bf16(s[6 * 33], s[7 * 33]);
        *(u32x4*)(WT + (size_t)(dst_row0 + n) * ldt + k0 + 8 * c) = o; }
    LDS_WAIT(); asm volatile("" ::: "memory");
}
__device__ __forceinline__ void cvt_item8(const float* W, int ldw, int src_col0, unsigned char* WT, int ldt, int dst_row0, int k0, float sc, LAS float* scr, int lane) {
#pragma unroll 8
    for (int i = 0; i < 32; ++i) { const int kk = 2 * i + (lane >> 5); scr[kk * 33 + (lane & 31)] = W[(size_t)(k0 + kk) * ldw + src_col0 + (lane & 31)]; }
    LDS_WAIT(); asm volatile("" ::: "memory");
    const int c = lane & 7;
#pragma unroll
    for (int j = 0; j < 4; ++j) { const int n = (lane >> 3) + 8 * j; const LAS float* s = scr + (8 * c) * 33 + n;
        *(u32x2*)(WT + (size_t)(dst_row0 + n) * ldt + k0 + 8 * c) = (u32x2){pk_fp8x4(s[0 * 33] * sc, s[1 * 33] * sc, s[2 * 33] * sc, s[3 * 33] * sc), pk_fp8x4(s[4 * 33] * sc, s[5 * 33] * sc, s[6 * 33] * sc, s[7 * 33] * sc)}; }
    LDS_WAIT(); asm volatile("" ::: "memory");
}
enum { MAP_ID = 0, MAP_QKV = 1, MAP_SWI = 2 };
template <bool F8 = false>
__device__ __forceinline__ void cvt_family(const float* src, size_t sstride, int ninst, int ldw, int K, int ng, int map, int F, bf16_t* dst, size_t dstride,
                                           LAS float* scr, int gw, int NGW, int lane) {
    const int nkb = K / 64, per = nkb * ng, total = ninst * per;
    for (int it = gw; it < total; it += NGW) {
        const int inst = it / per, r = it - inst * per, kb = r / ng, gi = r - kb * ng;
        int sc0;
        if (map == MAP_ID) sc0 = 32 * gi;
        else if (map == MAP_QKV) { const int pn = gi >> 3, bj = (gi >> 2) & 1, wc = gi & 3;
            if (pn < 8) { const int part = pn >> 2, sh = 4 * (pn & 3) + wc; sc0 = part * 1024 + sh * 64 + 32 * bj; } else sc0 = 32 * gi; }
        else { const int pn = gi >> 3, bj = (gi >> 2) & 1, q = gi & 3; sc0 = bj * F + pn * 128 + 32 * q; }
        if constexpr (F8) cvt_item8(src + (size_t)inst * sstride, ldw, sc0, (unsigned char*)dst + (size_t)inst * dstride, K, 32 * gi, 64 * kb, MOE_WSCALE, scr, lane);
        else cvt_item(src + (size_t)inst * sstride, ldw, sc0, dst + (size_t)inst * dstride, K, 32 * gi, 64 * kb, scr, lane);
    }
}

__device__ __forceinline__ void prologue_phase(const Args& A, LAS unsigned char* lds, int bid, int G) {
    const int tid = threadIdx.x, lane = tid & 63, wave = tid >> 6;
    unsigned char* ws = A.ws;
    {
        LAS float* sc = (LAS float*)lds;
        LAS float* red = (LAS float*)(lds + 32768);
        for (int i = tid; i < NBATCH * DM; i += NTHR) { const float cv = A.in[I_C][i]; sc[i] = fsilu(cv); }
        __syncthreads();
        float* mods = (float*)(ws + TB_MODS);
        for (int cb = bid; cb < (DEPTH * 6144) / 128; cb += G) {
            const int col = cb * 128 + (tid & 127), l = col / 6144, e = col - l * 6144, ch = tid >> 7;
            const float* wp = A.in[I_ADAW] + (size_t)l * DM * 6144 + e;
            float a[NBATCH];
#pragma unroll
            for (int b = 0; b < NBATCH; ++b) a[b] = 0.f;
#pragma unroll 4
            for (int d = ch * 256; d < ch * 256 + 256; ++d) { const float w = wp[(size_t)d * 6144];
#pragma unroll
                for (int b = 0; b < NBATCH; ++b) a[b] += sc[b * DM + d] * w; }
#pragma unroll
            for (int b = 0; b < NBATCH; ++b) red[(ch * 128 + (tid & 127)) * 8 + b] = a[b];
            __syncthreads();
            if (tid < 128) { const float bias = A.in[I_ADAB][l * 6144 + e];
#pragma unroll
                for (int b = 0; b < NBATCH; ++b) { const float s = ((red[(0 * 128 + tid) * 8 + b] + red[(1 * 128 + tid) * 8 + b]) + (red[(2 * 128 + tid) * 8 + b] + red[(3 * 128 + tid) * 8 + b])) + bias;
                    mods[((size_t)l * NBATCH + b) * 6144 + e] = s; } }
            __syncthreads();
        }
    }
    {
        float* cosT = (float*)(ws + TB_COS); float* sinT = (float*)(ws + TB_SIN);
        for (int i = bid * NTHR + tid; i < SEQ * 32; i += G * NTHR) {
            const int pos = i >> 5, d = i & 31;
            const float inv = (float)exp(-(double)d * (1.0 / 32.0) * 9.210340371976184);
            const float ang = (float)pos * inv;
            const double rev = (double)ang * 0.15915494309189535; const float fr = (float)(rev - floor(rev));
            cosT[i] = __builtin_amdgcn_cosf(fr); sinT[i] = __builtin_amdgcn_sinf(fr);
        }
        if (bid == 0 && tid < 2) {
            const int a = tid; const float* lm = A.in[I_ATLAM] + a * 256;
            float s1 = 0.f, s2 = 0.f; for (int i = 0; i < 64; ++i) { s1 += lm[i] * lm[64 + i]; s2 += lm[128 + i] * lm[192 + i]; }
            const float linit = 0.8f - 0.6f * expf(-0.3f * (float)(3 * a));
            float mq = 0.f, mk = 0.f; for (int i = 0; i < 64; ++i) { mq = fmaxf(mq, fabsf(A.in[I_ATQN][a * 64 + i])); mk = fmaxf(mk, fabsf(A.in[I_ATKN][a * 64 + i])); }
            float* scal = (float*)(ws + TB_SCAL);
            scal[SC_LAM0 + a] = expf(s1) - expf(s2) + linit; scal[SC_OML0 + a] = 1.0f - linit; scal[SC_MC0 + a] = 8.0f * mq * mk * LOG2E * 1.0001f;
        }
        if (bid == 1) {
            float* lb = (float*)(ws + TB_LB);
            for (int i = tid; i < 2 * 1024; i += NTHR) { const int d = i >> 10, k = i & 1023; const float* p = A.in[I_HGLB] + (size_t)d * DEPTH * 1024 + k;
                float mx = p[0]; for (int l = 1; l < DEPTH; ++l) mx = fmaxf(mx, p[l * 1024]);
                float den = 0.f, num = 0.f; for (int l = 0; l < DEPTH; ++l) { const float e = expf(p[l * 1024] - mx); den += e; if (l == 1) num += e; }
                lb[i] = num / den; }
        }
        if (bid == 2) {
            float* sp = (float*)(ws + TB_SP);
            for (int i = tid; i < 2 * LRUW; i += NTHR) { const float x = -A.in[I_LRLAM][i]; sp[i] = (x > 20.f) ? x : log1pf(expf(x)); }
        }
    }
    {
        LAS float* scr = (LAS float*)(lds + wave * 16384);
        const int vcu = (bid % 8) * (G / 8) + bid / 8;
        const int gw = vcu * NWAVES + wave, NGW = G * NWAVES;
        cvt_family(A.in[I_ATWIN], (size_t)1024 * 3072, 2, 3072, 1024, 96, MAP_QKV, 0, (bf16_t*)(ws + W_QKV), (size_t)3072 * 1024, scr, gw, NGW, lane);
        cvt_family(A.in[I_ATWOUT], (size_t)1024 * 1024, 2, 1024, 1024, 32, MAP_ID, 0, (bf16_t*)(ws + W_AO), (size_t)1024 * 1024, scr, gw, NGW, lane);
        cvt_family(A.in[I_HGWIN], 0, 1, 5120, 1024, 160, MAP_ID, 0, (bf16_t*)(ws + W_HGI), 0, scr, gw, NGW, lane);
        cvt_family(A.in[I_HGWOUT], 0, 1, 1024, 1024, 32, MAP_ID, 0, (bf16_t*)(ws + W_HGO), 0, scr, gw, NGW, lane);
        cvt_family(A.in[I_LRWIN], 0, 1, 2560, 1024, 80, MAP_ID, 0, (bf16_t*)(ws + W_LRI), 0, scr, gw, NGW, lane);
        cvt_family(A.in[I_LRWOUT], 0, 1, 1024, 1280, 32, MAP_ID, 0, (bf16_t*)(ws + W_LRO), 0, scr, gw, NGW, lane);
        for (int it = gw; it < 2 * 20 * 2 * 4; it += NGW) {
            const int part = it / 160, r = it % 160, inst = r >> 3, kb = (r >> 2) & 1, gi = r & 3, d = inst / 10, n = inst % 10;
            const float* src = (part ? A.in[I_LRWX] : A.in[I_LRWA]) + (size_t)inst * 16384;
            cvt_item(src, 128, 32 * gi, (bf16_t*)(ws + W_LRG) + (size_t)(n * 2 + d) * 256 * 128, 128, part * 128 + 32 * gi, 64 * kb, scr, lane);
        }
        static_assert(FP8_DENSE_FROM == 2 || FP8_DENSE_FROM > 3, "dense layer 0 stays bf16; layer 2 optional");
        constexpr int NB16 = (FP8_DENSE_FROM == 2) ? 1 : 2;
        cvt_family(A.in[I_FFGU], (size_t)1024 * 5632, NB16, 5632, 1024, 176, MAP_SWI, DFF, (bf16_t*)(ws + W_FGU), (size_t)5632 * 1024, scr, gw, NGW, lane);
        cvt_family(A.in[I_FFDN], (size_t)2816 * 1024, NB16, 1024, 2816, 32, MAP_ID, 0, (bf16_t*)(ws + W_FDN), (size_t)1024 * 2816, scr, gw, NGW, lane);
        if constexpr (NB16 == 1) {
            cvt_family<true>(A.in[I_FFGU] + (size_t)1024 * 5632, 0, 1, 5632, 1024, 176, MAP_SWI, DFF, (bf16_t*)(ws + W_FGU) + (size_t)5632 * 1024, 0, scr, gw, NGW, lane);
            cvt_family<true>(A.in[I_FFDN] + (size_t)2816 * 1024, 0, 1, 1024, 2816, 32, MAP_ID, 0, (bf16_t*)(ws + W_FDN) + (size_t)1024 * 2816, 0, scr, gw, NGW, lane);
        }
        cvt_family<true>(A.in[I_MOEGU], (size_t)1024 * 7168, 16, 7168, 1024, 224, MAP_SWI, DFFE, (bf16_t*)(ws + W_MGU), (size_t)7168 * 1024, scr, gw, NGW, lane);
        cvt_family<true>(A.in[I_MOEDN], (size_t)3584 * 1024, 16, 1024, 3584, 32, MAP_ID, 0, (bf16_t*)(ws + W_MDN), (size_t)1024 * 3584, scr, gw, NGW, lane);
    }
}

template <bool ROUTER>
__device__ __forceinline__ void norm_phase(const Args& A, LAS unsigned char* lds, int bid, int G, const void* xsrc, bool src16, void* xdst, bool dst16, const float* gain, const float* modl  , int which,
                                           bool combine, const float* modprev  , bool nonorm, const float* router, bool f8out = false) {
    int tid_ = threadIdx.x; asm volatile("" : "+v"(tid_));
    const int tid = tid_, lane = tid & 63, wave = tid >> 6;
    unsigned char* ws = A.ws;
    bf16_t* HM = (bf16_t*)(ws + WS_HM);
    const int* slot = (const int*)(ws + TB_SLOT); const float* gts = (const float*)(ws + TB_GATE);
    const bf16_t* Y = (const bf16_t*)(ws + E_XS);
    LAS int* hist = (LAS int*)lds;
    for (int tb = bid; tb < MTOK / 256; tb += G) {
        const int b = tb >> 5;
        f32x4 ga[4], sh[4], g2[4];
#pragma unroll
        for (int j = 0; j < 4; ++j) { const int c = 256 * j + 4 * lane;
            if (!nonorm) { const f32x4 gv = *(const f32x4*)(gain + c), sv = *(const f32x4*)(modl + (size_t)b * 6144 + (which * 3 + 1) * 1024 + c);
                ga[j] = gv * (sv + 1.0f); sh[j] = *(const f32x4*)(modl + (size_t)b * 6144 + (which * 3) * 1024 + c); }
            if (combine) g2[j] = *(const f32x4*)(modprev + (size_t)b * 6144 + 5 * 1024 + c); }
        f32x4 rw[ROUTER ? 32 : 1];
        if constexpr (ROUTER) {
            if (tid < 8) hist[tid] = 0;
#pragma unroll
            for (int j = 0; j < 4; ++j)
#pragma unroll
                for (int i = 0; i < 4; ++i) { const int c = 256 * j + 4 * lane + i; rw[(j * 4 + i) * 2] = *(const f32x4*)(router + c * 8); rw[(j * 4 + i) * 2 + 1] = *(const f32x4*)(router + c * 8 + 4); }
            __syncthreads();
        }
        for (int i = 0; i < 32; ++i) {
            const int row = tb * 256 + wave * 32 + i;
            f32x4 v[4];
#pragma unroll
            for (int j = 0; j < 4; ++j) v[j] = pg8::ld_x4(xsrc, (size_t)row * DM + 256 * j + 4 * lane, src16);
            if (combine) {
                const int s0 = slot[row * 2], s1 = slot[row * 2 + 1]; const float w0 = gts[row * 2], w1 = gts[row * 2 + 1];
#pragma unroll
                for (int j = 0; j < 4; ++j) { const u32x2 a = *(const u32x2*)(Y + (size_t)s0 * DM + 256 * j + 4 * lane), c2 = *(const u32x2*)(Y + (size_t)s1 * DM + 256 * j + 4 * lane);
                    f32x4 y; y[0] = w0 * bflo(a.x) + w1 * bflo(c2.x); y[1] = w0 * bfhi(a.x) + w1 * bfhi(c2.x); y[2] = w0 * bflo(a.y) + w1 * bflo(c2.y); y[3] = w0 * bfhi(a.y) + w1 * bfhi(c2.y);
                    v[j] = v[j] + g2[j] * y;
                    if (dst16) *(u32x2*)((bf16_t*)xdst + (size_t)row * DM + 256 * j + 4 * lane) = (u32x2){cvt_pk_bf16(v[j][0], v[j][1]), cvt_pk_bf16(v[j][2], v[j][3])};
                    else *(f32x4*)((float*)xdst + (size_t)row * DM + 256 * j + 4 * lane) = v[j]; }
            }
            if (nonorm) continue;
            float ss = 0.f;
#pragma unroll
            for (int j = 0; j < 4; ++j) ss += (v[j][0] * v[j][0] + v[j][1] * v[j][1]) + (v[j][2] * v[j][2] + v[j][3] * v[j][3]);
            ss = wave_sum(ss);
            const float rstd = 1.0f / sqrtf(ss * (1.0f / DM) + EPS);
            f32x4 h[4];
#pragma unroll
            for (int j = 0; j < 4; ++j) { h[j] = v[j] * rstd * ga[j] + sh[j];
                if (f8out) { *(unsigned*)((unsigned char*)HM + (size_t)row * DM + 256 * j + 4 * lane) = pk_fp8x4(h[j][0], h[j][1], h[j][2], h[j][3]); }
                else { u32x2 w; w.x = cvt_pk_bf16(h[j][0], h[j][1]); w.y = cvt_pk_bf16(h[j][2], h[j][3]);
                    *(u32x2*)(HM + (size_t)row * DM + 256 * j + 4 * lane) = w; } }
            if constexpr (ROUTER) {
                float lg[8];
#pragma unroll
                for (int e = 0; e < 8; ++e) lg[e] = 0.f;
#pragma unroll
                for (int j = 0; j < 4; ++j)
#pragma unroll
                    for (int q = 0; q < 4; ++q) { const float hv = h[j][q]; const f32x4 r0 = rw[(j * 4 + q) * 2], r1 = rw[(j * 4 + q) * 2 + 1];
                        lg[0] += hv * r0[0]; lg[1] += hv * r0[1]; lg[2] += hv * r0[2]; lg[3] += hv * r0[3]; lg[4] += hv * r1[0]; lg[5] += hv * r1[1]; lg[6] += hv * r1[2]; lg[7] += hv * r1[3]; }
#pragma unroll
                for (int e = 0; e < 8; ++e) lg[e] = wave_sum(lg[e]);
                int e0 = 0; float v0 = lg[0];
#pragma unroll
                for (int e = 1; e < 8; ++e) if (lg[e] > v0) { v0 = lg[e]; e0 = e; }
                int e1 = -1; float v1 = -3.0e38f;
#pragma unroll
                for (int e = 0; e < 8; ++e) if (e != e0 && lg[e] > v1) { v1 = lg[e]; e1 = e; }
                const float p1 = frcp(1.0f + fexp(v1 - v0));
                if (lane == 0) { int* eid = (int*)(ws + TB_EID); float* gt = (float*)(ws + TB_GATE);
                    eid[row * 2] = e0; eid[row * 2 + 1] = e1; gt[row * 2] = p1; gt[row * 2 + 1] = 1.0f - p1;
                    atomicAdd((int*)&hist[e0], 1); atomicAdd((int*)&hist[e1], 1); }
            }
        }
        if constexpr (ROUTER) {
            __syncthreads();
            if (tid < 8) ((int*)(ws + TB_BCNT))[tb * 8 + tid] = hist[tid];
            __syncthreads();
        }
    }
}

namespace lru {
constexpr int XCF = 0, XCB = 16384, AA = 24576, UU = 40960, LAA = 57344;
__device__ __forceinline__ int sw256(int row, int cb) { return row * 256 + (cb ^ ((row & 15) << 4)); }
__device__ __forceinline__ int crow(int r, int hi) { return (r & 3) + 8 * (r >> 2) + 4 * hi; }
template <int MODE>
__device__ __forceinline__ void lru_item(const Args& A, LAS unsigned char* lds, int b, int n, int seg, int dir) {
    int tid_ = threadIdx.x; asm volatile("" : "+v"(tid_));
    const int tid = tid_, wid = tid >> 6, lane = tid & 63, r = lane & 31, hh = lane >> 5;
    unsigned char* ws = A.ws;
    const bf16_t* XB = (const bf16_t*)(ws + L_XB); const bf16_t* YB = (const bf16_t*)(ws + L_YB); bf16_t* HF = (bf16_t*)(ws + L_HF); bf16_t* HY = (bf16_t*)(ws + L_HY);
    bf16_t* LAg = (bf16_t*)(ws + (dir ? L_HY : L_HF)); bf16_t* Ug = (bf16_t*)(ws + L_U + (size_t)dir * SZ_LRU);
    const int ct = tid >> 4, cg = tid & 15, cc0 = n * 128 + 8 * cg;
    float carry = 0.f, P = 1.f;
    if (MODE != 0 && tid < 128) carry = ((const float*)(ws + TB_LCIN))[(size_t)((b * 32 + seg) * 2 + dir) * LRUW + n * 128 + tid];
    if constexpr (MODE == 0) {
        const bf16_t* Wg = (const bf16_t*)(ws + W_LRG) + (size_t)((n * 2 + dir) * 256 + ((r < 16) ? (16 * wid + r) : (128 + 16 * wid + r - 16))) * 128 + 8 * hh;
        bf16x8 bfrag[8];
#pragma unroll
        for (int ks = 0; ks < 8; ++ks) bfrag[ks] = *(const bf16x8*)(Wg + 16 * ks);
        const int cch = n * 128 + 16 * wid + (r & 15);
        const float nba = -LOG2E * A.in[I_LRBA][dir * LRUW + cch], nbx = -LOG2E * A.in[I_LRBX][dir * LRUW + cch], csp = -8.0f * LOG2E * ((const float*)(ws + TB_SP))[dir * LRUW + cch];
        float cw[4][8], cb[8];
#pragma unroll
        for (int j = 0; j < 8; ++j) { cb[j] = A.in[I_LRCB][cc0 + j];
#pragma unroll
            for (int w = 0; w < 4; ++w) cw[w][j] = A.in[I_LRCW][w * LRUW + cc0 + j]; }
        u32x4 xr[4];
#define LRU_XLOAD(si_) do { const int sub_ = dir ? (7 - (si_)) : (si_); const int tok_ = seg * 256 + sub_ * 32 + ct; \
        _Pragma("unroll") for (int w = 0; w < 4; ++w) { const int tt = tok_ - 1 + w; xr[w] = (tt >= 0 && tt < SEQ) ? *(const u32x4*)(XB + ((size_t)b * SEQ + tt) * LRUW + cc0) : (u32x4){0u, 0u, 0u, 0u}; } } while (0)
        LRU_XLOAD(0);
        for (int si = 0; si < 8; ++si) {
            const int sub = dir ? (7 - si) : si; const int t0 = seg * 256 + sub * 32;
            {
                float xc[8];
#pragma unroll
                for (int j = 0; j < 8; ++j) xc[j] = cb[j];
#pragma unroll
                for (int w = 0; w < 4; ++w) { const u32x4 v = xr[w];
#pragma unroll
                    for (int e = 0; e < 4; ++e) { xc[2 * e] += cw[w][2 * e] * bflo(v[e]); xc[2 * e + 1] += cw[w][2 * e + 1] * bfhi(v[e]); } }
                if (si + 1 < 8) LRU_XLOAD(si + 1);
                *(LAS f32x4*)(lds + XCF + (ct * 128 + 8 * cg) * 4) = (f32x4){xc[0], xc[1], xc[2], xc[3]};
                *(LAS f32x4*)(lds + XCF + (ct * 128 + 8 * cg + 4) * 4) = (f32x4){xc[4], xc[5], xc[6], xc[7]};
                *(LAS u32x4*)(lds + XCB + sw256(ct, 16 * cg)) = (u32x4){cvt_pk_bf16(xc[0], xc[1]), cvt_pk_bf16(xc[2], xc[3]), cvt_pk_bf16(xc[4], xc[5]), cvt_pk_bf16(xc[6], xc[7])};
            }
            __syncthreads();
            {
                f32x16 acc = {};
#pragma unroll
                for (int ks = 0; ks < 8; ++ks) { const bf16x8 fa = *(const LAS bf16x8*)(lds + XCB + sw256(r, (16 * ks + 8 * hh) * 2)); acc = __builtin_amdgcn_mfma_f32_32x32x16_bf16(fa, bfrag[ks], acc, 0, 0, 0); }
#pragma unroll
                for (int q = 0; q < 8; ++q) {
                    const auto sw = __builtin_amdgcn_permlane16_swap(__float_as_uint(acc[q]), __float_as_uint(acc[8 + q]), false, false);
                    const float rp = __uint_as_float(sw[0]), ip = __uint_as_float(sw[1]);
                    const int tq = crow((r < 16) ? q : (8 + q), hh); const int cl = 16 * wid + (r & 15);
                    const float xcv = ((const LAS float*)(lds + XCF))[tq * 128 + cl];
                    const float rg = frcp(1.0f + fexp2(fmaf(rp, -LOG2E, nba))), ig = frcp(1.0f + fexp2(fmaf(ip, -LOG2E, nbx)));
                    const float la = csp * rg, av = fexp2(la), uv = __builtin_amdgcn_sqrtf(fmaxf(fmaf(-av, av, 1.0f), 0.f)) * ig * xcv;
                    ((LAS float*)(lds + AA))[tq * 128 + cl] = av; ((LAS float*)(lds + UU))[tq * 128 + cl] = uv; ((LAS float*)(lds + LAA))[tq * 128 + cl] = la; }
            }
            __syncthreads();
            if (tid < 128) {
                LAS float* ap = (LAS float*)(lds + AA) + tid; LAS float* up = (LAS float*)(lds + UU) + tid; float av[32], uv[32];
#pragma unroll
                for (int i = 0; i < 32; ++i) { av[i] = ap[i * 128]; uv[i] = up[i * 128]; }
                if (dir == 0) {
#pragma unroll
                    for (int i = 0; i < 32; ++i) { carry = av[i] * carry + uv[i]; P *= av[i]; } }
                else {
#pragma unroll
                    for (int i = 31; i >= 0; --i) { carry = av[i] * carry + uv[i]; P *= av[i]; } }
            } else if (tid >= 256) {
                const int t2 = tid - 256, row = t2 >> 3, c16 = (t2 & 7) * 16; const size_t go = ((size_t)b * SEQ + t0 + row) * LRUW + n * 128 + c16;
                const LAS float* lp = (const LAS float*)(lds + LAA) + row * 128 + c16; const LAS float* up = (const LAS float*)(lds + UU) + row * 128 + c16;
                f32x4 l[4], u[4];
#pragma unroll
                for (int j = 0; j < 4; ++j) { l[j] = *(const LAS f32x4*)(lp + 4 * j); u[j] = *(const LAS f32x4*)(up + 4 * j); }
#pragma unroll
                for (int j = 0; j < 2; ++j) {
                    *(u32x4*)(LAg + go + 8 * j) = (u32x4){cvt_pk_bf16(l[2 * j][0], l[2 * j][1]), cvt_pk_bf16(l[2 * j][2], l[2 * j][3]), cvt_pk_bf16(l[2 * j + 1][0], l[2 * j + 1][1]), cvt_pk_bf16(l[2 * j + 1][2], l[2 * j + 1][3])};
                    *(u32x4*)(Ug + go + 8 * j) = (u32x4){cvt_pk_bf16(u[2 * j][0], u[2 * j][1]), cvt_pk_bf16(u[2 * j][2], u[2 * j][3]), cvt_pk_bf16(u[2 * j + 1][0], u[2 * j + 1][1]), cvt_pk_bf16(u[2 * j + 1][2], u[2 * j + 1][3])}; }
            }
            __syncthreads();
        }
#undef LRU_XLOAD
        if (tid < 128) { float* sm = (float*)(ws + TB_LSUM) + (size_t)(((b * 32 + seg) * 2 + dir) * 2) * LRUW + n * 128 + tid; sm[0] = P; sm[LRUW] = carry; }
    } else {
        u32x4 lr, ur;
#define LRU_GLOAD(si_) do { const int sub_ = dir ? (7 - (si_)) : (si_); const size_t go_ = ((size_t)b * SEQ + seg * 256 + sub_ * 32 + ct) * LRUW + cc0; \
        lr = *(const u32x4*)(LAg + go_); ur = *(const u32x4*)(Ug + go_); } while (0)
        LRU_GLOAD(0);
        for (int si = 0; si < 8; ++si) {
            const int sub = dir ? (7 - si) : si; const int t0 = seg * 256 + sub * 32;
            {   const u32x4 l = lr, u = ur;
                if (si + 1 < 8) LRU_GLOAD(si + 1);
                *(LAS f32x4*)(lds + AA + (ct * 128 + 8 * cg) * 4) = (f32x4){fexp2(bflo(l[0])), fexp2(bfhi(l[0])), fexp2(bflo(l[1])), fexp2(bfhi(l[1]))};
                *(LAS f32x4*)(lds + AA + (ct * 128 + 8 * cg + 4) * 4) = (f32x4){fexp2(bflo(l[2])), fexp2(bfhi(l[2])), fexp2(bflo(l[3])), fexp2(bfhi(l[3]))};
                *(LAS f32x4*)(lds + UU + (ct * 128 + 8 * cg) * 4) = (f32x4){bflo(u[0]), bfhi(u[0]), bflo(u[1]), bfhi(u[1])};
                *(LAS f32x4*)(lds + UU + (ct * 128 + 8 * cg + 4) * 4) = (f32x4){bflo(u[2]), bfhi(u[2]), bflo(u[3]), bfhi(u[3])}; }
            __syncthreads();
            if (tid < 128) {
                LAS float* ap = (LAS float*)(lds + AA) + tid; LAS float* up = (LAS float*)(lds + UU) + tid; float av[32], uv[32];
#pragma unroll
                for (int i = 0; i < 32; ++i) { av[i] = ap[i * 128]; uv[i] = up[i * 128]; }
                if (dir == 0) {
#pragma unroll
                    for (int i = 0; i < 32; ++i) { carry = av[i] * carry + uv[i]; uv[i] = carry; } }
                else {
#pragma unroll
                    for (int i = 31; i >= 0; --i) { carry = av[i] * carry + uv[i]; uv[i] = carry; } }
#pragma unroll
                for (int i = 0; i < 32; ++i) up[i * 128] = uv[i];
            }
            __syncthreads();
            {   const int tok = t0 + ct; const size_t go = ((size_t)b * SEQ + tok) * LRUW + cc0;
                const f32x4 h0 = *(const LAS f32x4*)(lds + UU + (ct * 128 + 8 * cg) * 4), h1 = *(const LAS f32x4*)(lds + UU + (ct * 128 + 8 * cg + 4) * 4);
                if (MODE == 1) { *(u32x4*)(HF + go) = (u32x4){cvt_pk_bf16(h0[0], h0[1]), cvt_pk_bf16(h0[2], h0[3]), cvt_pk_bf16(h1[0], h1[1]), cvt_pk_bf16(h1[2], h1[3])}; }
                else { const u32x4 f = *(const u32x4*)(HF + go), y = *(const u32x4*)(YB + go);
                    *(u32x4*)(HY + go) = (u32x4){cvt_pk_bf16((h0[0] + bflo(f[0])) * bflo(y[0]), (h0[1] + bfhi(f[0])) * bfhi(y[0])), cvt_pk_bf16((h0[2] + bflo(f[1])) * bflo(y[1]), (h0[3] + bfhi(f[1])) * bfhi(y[1])),
                                                cvt_pk_bf16((h1[0] + bflo(f[2])) * bflo(y[2]), (h1[1] + bfhi(f[2])) * bfhi(y[2])), cvt_pk_bf16((h1[2] + bflo(f[3])) * bflo(y[3]), (h1[3] + bfhi(f[3])) * bfhi(y[3]))}; }
            }
            __syncthreads();
        }
#undef LRU_GLOAD
    }
}
__device__ __forceinline__ void lru_apply_item(const Args& A, LAS unsigned char* lds, int b, int n, int seg) {
    constexpr int HFL = 57344;
    int tid_ = threadIdx.x; asm volatile("" : "+v"(tid_));
    const int tid = tid_;
    unsigned char* ws = A.ws;
    const bf16_t* YB = (const bf16_t*)(ws + L_YB); bf16_t* HY = (bf16_t*)(ws + L_HY);
    const int ct = tid >> 4, cg = tid & 15, cc0 = n * 128 + 8 * cg;
#pragma unroll 1
    for (int dir = 0; dir < 2; ++dir) {
        const bf16_t* LAg = (const bf16_t*)(ws + (dir ? L_HY : L_HF)); const bf16_t* Ug = (const bf16_t*)(ws + L_U + (size_t)dir * SZ_LRU);
        float carry = 0.f;
        if (tid < 128) carry = ((const float*)(ws + TB_LCIN))[(size_t)((b * 32 + seg) * 2 + dir) * LRUW + n * 128 + tid];
        u32x4 lr, ur, yr = {0u, 0u, 0u, 0u};
#define LRU_GLOAD(si_) do { const int sub_ = dir ? (7 - (si_)) : (si_); const size_t go_ = ((size_t)b * SEQ + seg * 256 + sub_ * 32 + ct) * LRUW + cc0; \
        lr = *(const u32x4*)(LAg + go_); ur = *(const u32x4*)(Ug + go_); if (dir) yr = *(const u32x4*)(YB + go_); } while (0)
        LRU_GLOAD(0);
        for (int si = 0; si < 8; ++si) {
            const int sub = dir ? (7 - si) : si; const int t0 = seg * 256 + sub * 32;
            const u32x4 l = lr, u = ur, y = yr;
            if (si + 1 < 8) LRU_GLOAD(si + 1);
            *(LAS f32x4*)(lds + AA + (ct * 128 + 8 * cg) * 4) = (f32x4){fexp2(bflo(l[0])), fexp2(bfhi(l[0])), fexp2(bflo(l[1])), fexp2(bfhi(l[1]))};
            *(LAS f32x4*)(lds + AA + (ct * 128 + 8 * cg + 4) * 4) = (f32x4){fexp2(bflo(l[2])), fexp2(bfhi(l[2])), fexp2(bflo(l[3])), fexp2(bfhi(l[3]))};
            *(LAS f32x4*)(lds + UU + (ct * 128 + 8 * cg) * 4) = (f32x4){bflo(u[0]), bfhi(u[0]), bflo(u[1]), bfhi(u[1])};
            *(LAS f32x4*)(lds + UU + (ct * 128 + 8 * cg + 4) * 4) = (f32x4){bflo(u[2]), bfhi(u[2]), bflo(u[3]), bfhi(u[3])};
            __syncthreads();
            if (tid < 128) {
                LAS float* ap = (LAS float*)(lds + AA) + tid; LAS float* up = (LAS float*)(lds + UU) + tid; float av[32], uv[32];
#pragma unroll
                for (int i = 0; i < 32; ++i) { av[i] = ap[i * 128]; uv[i] = up[i * 128]; }
                if (dir == 0) {
#pragma unroll
                    for (int i = 0; i < 32; ++i) { carry = av[i] * carry + uv[i]; uv[i] = carry; } }
                else {
#pragma unroll
                    for (int i = 31; i >= 0; --i) { carry = av[i] * carry + uv[i]; uv[i] = carry; } }
#pragma unroll
                for (int i = 0; i < 32; ++i) up[i * 128] = uv[i];
            }
            __syncthreads();
            {   const f32x4 h0 = *(const LAS f32x4*)(lds + UU + (ct * 128 + 8 * cg) * 4), h1 = *(const LAS f32x4*)(lds + UU + (ct * 128 + 8 * cg + 4) * 4);
                LAS u32x4* hf = (LAS u32x4*)(lds + HFL + ((sub * 32 + ct) * 128 + 8 * cg) * 2);
                if (dir == 0) *hf = (u32x4){cvt_pk_bf16(h0[0], h0[1]), cvt_pk_bf16(h0[2], h0[3]), cvt_pk_bf16(h1[0], h1[1]), cvt_pk_bf16(h1[2], h1[3])};
                else { const u32x4 f = *hf; const size_t go = ((size_t)b * SEQ + t0 + ct) * LRUW + cc0;
                    *(u32x4*)(HY + go) = (u32x4){cvt_pk_bf16((h0[0] + bflo(f[0])) * bflo(y[0]), (h0[1] + bfhi(f[0])) * bfhi(y[0])), cvt_pk_bf16((h0[2] + bflo(f[1])) * bflo(y[1]), (h0[3] + bfhi(f[1])) * bfhi(y[1])),
                                                cvt_pk_bf16((h1[0] + bflo(f[2])) * bflo(y[2]), (h1[1] + bfhi(f[2])) * bfhi(y[2])), cvt_pk_bf16((h1[2] + bflo(f[3])) * bflo(y[3]), (h1[3] + bfhi(f[3])) * bfhi(y[3]))}; }
            }
            __syncthreads();
        }
#undef LRU_GLOAD
    }
}
}
__device__ __forceinline__ void lru_apply_phase(const Args& A, LAS unsigned char* lds, int bid, int G) {
    for (int it = bid; it < 2560; it += G) lru::lru_apply_item(A, lds, it / 320, (it >> 5) % 10, it & 31);
}
template <int MODE>
__device__ __forceinline__ void lru_phase(const Args& A, LAS unsigned char* lds, int bid, int G) {
    const int nitems = (MODE == 0) ? 5120 : 2560;
    for (int it = bid; it < nitems; it += G) {
        int b, n, seg, dir;
        if (MODE == 0) { dir = it & 1; const int r = it >> 1; seg = r & 31; n = (r >> 5) % 10; b = r / 320; }
        else { dir = MODE - 1; seg = it & 31; n = (it >> 5) % 10; b = it / 320; }
        lru::lru_item<MODE>(A, lds, b, n, seg, dir);
    }
}
__device__ __forceinline__ void lru_carry_phase(const Args& A, int bid, int G) {
    const float* sm = (const float*)(A.ws + TB_LSUM); float* cin = (float*)(A.ws + TB_LCIN);
    for (int idx = bid * NTHR + threadIdx.x; idx < NBATCH * 2 * LRUW; idx += G * NTHR) {
        const int b = idx / (2 * LRUW), r = idx % (2 * LRUW), dir = r / LRUW, ch = r % LRUW; float carry = 0.f;
        for (int i = 0; i < 32; ++i) { const int sg = dir ? (31 - i) : i; const size_t o = (size_t)((b * 32 + sg) * 2 + dir);
            cin[o * LRUW + ch] = carry; carry = sm[o * 2 * LRUW + ch] * carry + sm[o * 2 * LRUW + LRUW + ch]; }
    }
}

__device__ __forceinline__ void place_phase(const Args& A, LAS unsigned char* lds, int bid, int G) {
    int tid_ = threadIdx.x; asm volatile("" : "+v"(tid_));
    const int tid = tid_, lane = tid & 63, wave = tid >> 6; unsigned char* ws = A.ws;
    const int* bcnt = (const int*)(ws + TB_BCNT); const int* eid = (const int*)(ws + TB_EID); int* slot = (int*)(ws + TB_SLOT);
    const bf16_t* HM = (const bf16_t*)(ws + WS_HM); bf16_t* XS = (bf16_t*)(ws + E_XS);
    LAS int* tot = (LAS int*)lds; LAS int* pre = tot + 8; LAS int* rb = tot + 16; LAS int* wcn = tot + 32; LAS int* sl = tot + 64;
    for (int tb = bid; tb < MTOK / 256; tb += G) {
        { int t_ = 0, p_ = 0;
#pragma unroll
            for (int j = 0; j < 4; ++j) { const int blk = lane + 64 * j; const int v = bcnt[blk * 8 + wave]; t_ += v; p_ += (blk < tb) ? v : 0; }
#pragma unroll
            for (int o = 1; o < 64; o <<= 1) { t_ += __shfl_xor(t_, o); p_ += __shfl_xor(p_, o); }
            if (lane == 0) { tot[wave] = t_; pre[wave] = p_; } }
        __syncthreads();
        if (tid == 0) { int acc = 0; for (int e = 0; e < 8; ++e) { rb[e] = acc * 256; if (tb == 0) ((int*)(ws + TB_TILES))[e] = acc; acc += (tot[e] + 255) >> 8; } if (tb == 0) ((int*)(ws + TB_TILES))[8] = acc; }
        int e0 = -1, e1 = -1; unsigned long long mk0 = 0, mk1 = 0;
        if (tid < 256) { e0 = eid[(tb * 256 + tid) * 2]; e1 = eid[(tb * 256 + tid) * 2 + 1];
#pragma unroll
            for (int e = 0; e < 8; ++e) { const unsigned long long m = __ballot(e0 == e || e1 == e); if (lane == 0) wcn[wave * 8 + e] = __popcll(m); if (e0 == e) mk0 = m; if (e1 == e) mk1 = m; } }
        __syncthreads();
        if (tid < 256) { const unsigned long long lt = (1ull << lane) - 1ull; int b0 = rb[e0] + pre[e0] + __popcll(mk0 & lt), b1 = rb[e1] + pre[e1] + __popcll(mk1 & lt);
            for (int w = 0; w < wave; ++w) { b0 += wcn[w * 8 + e0]; b1 += wcn[w * 8 + e1]; }
            sl[tid * 2] = b0; sl[tid * 2 + 1] = b1; slot[(tb * 256 + tid) * 2] = b0; slot[(tb * 256 + tid) * 2 + 1] = b1; }
        __syncthreads();
        for (int i = 0; i < 32; ++i) { const int t = wave * 32 + i; const int s0 = sl[t * 2], s1 = sl[t * 2 + 1];
            const bf16_t* src = HM + (size_t)(tb * 256 + t) * DM + lane * 16;
            const u32x4 a = *(const u32x4*)src, b = *(const u32x4*)(src + 8);
            const u32x4 q = {pk_fp8x4(bflo(a[0]), bfhi(a[0]), bflo(a[1]), bfhi(a[1])), pk_fp8x4(bflo(a[2]), bfhi(a[2]), bflo(a[3]), bfhi(a[3])),
                             pk_fp8x4(bflo(b[0]), bfhi(b[0]), bflo(b[1]), bfhi(b[1])), pk_fp8x4(bflo(b[2]), bfhi(b[2]), bflo(b[3]), bfhi(b[3]))};
            *(u32x4*)((unsigned char*)XS + (size_t)s0 * DM + lane * 16) = q; *(u32x4*)((unsigned char*)XS + (size_t)s1 * DM + lane * 16) = q; }
        __syncthreads();
    }
}

namespace att {
constexpr int KVBLK = 64;
#define SBAR() __builtin_amdgcn_sched_barrier(0)
typedef int v8i __attribute__((ext_vector_type(8)));
__device__ __forceinline__ int crow(int r, int hi) { return (r & 3) + 8 * (r >> 2) + 4 * hi; }
constexpr int SLOTB = 8192;
__device__ __forceinline__ int k_slot(int s) { return s * SLOTB; }
__device__ __forceinline__ int v_slot(int s) { return 65536 + s * SLOTB; }
__device__ __forceinline__ int kswz(int row) { return ((row & 7) ^ (row >> 4)) & 7; }
__device__ __forceinline__ int vswz(int row) { return (row >> 2) & 3; }
__device__ __forceinline__ void mfma8_acc(f32x16& acc, const v8i& a, const v8i& b, int sc) {
    asm volatile("s_nop 4\n\tv_mfma_scale_f32_32x32x64_f8f6f4 %0, %1, %2, %0, %3, %3 op_sel_hi:[0,0,0]" : "+v"(acc) : "v"(a), "v"(b), "v"(sc) : "memory");
}
__device__ __forceinline__ void mfma8_c(f32x16& d, const v8i& a, const v8i& b, const f32x16& c, int sa, int sb) {
    asm volatile("v_mfma_scale_f32_32x32x64_f8f6f4 %0, %1, %2, %3, %4, %5 op_sel_hi:[0,0,0]" : "=&v"(d) : "v"(a), "v"(b), "v"(c), "v"(sa), "v"(sb) : "memory");
}
#define ATT_LD8(p0_, p1_) __builtin_bit_cast(v8i, __builtin_shufflevector(*(const LAS u32x4*)(p0_), *(const LAS u32x4*)(p1_), 0, 1, 2, 3, 4, 5, 6, 7))
__device__ __forceinline__ void qkt(f32x16& p0, f32x16& p1, const LAS char* Ks, const v8i& qr, int r32, int hi, int jj, const f32x16& cinit, int s1, int s8) {
    const int c0 = jj * 4 + 2 * hi;
    { const int row = r32; const v8i kf = ATT_LD8(Ks + row * 128 + ((c0 ^ kswz(row)) << 4), Ks + row * 128 + (((c0 + 1) ^ kswz(row)) << 4)); mfma8_c(p0, kf, qr, cinit, s1, s8); }
    { const int row = 32 + r32; const v8i kf = ATT_LD8(Ks + row * 128 + ((c0 ^ kswz(row)) << 4), Ks + row * 128 + (((c0 + 1) ^ kswz(row)) << 4)); mfma8_c(p1, kf, qr, cinit, s1, s8); }
}
__device__ __forceinline__ void load_kf(v8i& kf0, v8i& kf1, const LAS char* Ks, int r32, int hi, int jj) {
    const int c0 = jj * 4 + 2 * hi, row1 = 32 + r32;
    kf0 = ATT_LD8(Ks + r32 * 128 + ((c0 ^ kswz(r32)) << 4), Ks + r32 * 128 + (((c0 + 1) ^ kswz(r32)) << 4));
    kf1 = ATT_LD8(Ks + row1 * 128 + ((c0 ^ kswz(row1)) << 4), Ks + row1 * 128 + (((c0 + 1) ^ kswz(row1)) << 4));
}
#define ATT_VFR(Vs, d0) ATT_LD8((Vs) + (32 * (d0) + r32) * 64 + (((2 * hi) ^ vswz(32 * (d0) + r32)) << 4), (Vs) + (32 * (d0) + r32) * 64 + (((2 * hi + 1) ^ vswz(32 * (d0) + r32)) << 4))
__device__ __forceinline__ void pack_p(const float (&pe)[32], v8i& pa);
__device__ __forceinline__ void qkt_pack(f32x16& p0, f32x16& p1, const v8i& kf0, const v8i& kf1, const v8i& qr, const f32x16& cinit, int s1, int s8, const float (&pe)[32], v8i& pa) {
#define ATT_MC8(d, kf, B, O0, O1, O2, O3) \
    asm volatile("v_mfma_scale_f32_32x32x64_f8f6f4 %0, %21, %22, %23, %24, %25 op_sel_hi:[0,0,0]\n\t" \
                 "v_cvt_pk_fp8_f32 %1, %5, %6\n\tv_cvt_pk_fp8_f32 %1, %7, %8 op_sel:[0,0,1]\n\t" \
                 "v_cvt_pk_fp8_f32 %2, %9, %10\n\tv_cvt_pk_fp8_f32 %2, %11, %12 op_sel:[0,0,1]\n\t" \
                 "v_cvt_pk_fp8_f32 %3, %13, %14\n\tv_cvt_pk_fp8_f32 %3, %15, %16 op_sel:[0,0,1]\n\t" \
                 "v_cvt_pk_fp8_f32 %4, %17, %18\n\tv_cvt_pk_fp8_f32 %4, %19, %20 op_sel:[0,0,1]" \
                 : "=&v"(d), "=&v"(O0), "=&v"(O1), "=&v"(O2), "=&v"(O3) \
                 : "v"(pe[B]), "v"(pe[B + 1]), "v"(pe[B + 2]), "v"(pe[B + 3]), "v"(pe[B + 4]), "v"(pe[B + 5]), "v"(pe[B + 6]), "v"(pe[B + 7]), \
                   "v"(pe[B + 8]), "v"(pe[B + 9]), "v"(pe[B + 10]), "v"(pe[B + 11]), "v"(pe[B + 12]), "v"(pe[B + 13]), "v"(pe[B + 14]), "v"(pe[B + 15]), \
                   "v"(kf), "v"(qr), "v"(cinit), "v"(s1), "v"(s8) : "memory")
    int q0, q1, q2, q3, q4, q5, q6, q7;
    ATT_MC8(p0, kf0, 0, q0, q1, q2, q3);
    ATT_MC8(p1, kf1, 16, q4, q5, q6, q7);
#undef ATT_MC8
    pa = (v8i){q0, q1, q2, q3, q4, q5, q6, q7};
}
__device__ __forceinline__ void partialSM(f32x16& p0) {
#pragma unroll
    for (int r = 0; r < 16; ++r) p0[r] = fexp2(p0[r]);
}
__device__ __forceinline__ void finishSM(f32x16& p0, f32x16& p1, v8i& pa) {
#pragma unroll
    for (int r = 0; r < 16; ++r) p1[r] = fexp2(p1[r]);
#pragma unroll
    for (int w = 0; w < 4; ++w) { pa[w] = (int)pk_fp8x4(p0[4 * w], p0[4 * w + 1], p0[4 * w + 2], p0[4 * w + 3]); pa[4 + w] = (int)pk_fp8x4(p1[4 * w], p1[4 * w + 1], p1[4 * w + 2], p1[4 * w + 3]); }
}
#define ATT_MX7(acc, a, b, sc, NOP, O, I, k) \
    asm volatile(NOP "v_mfma_scale_f32_32x32x64_f8f6f4 %0, %15, %16, %0, %17, %17 op_sel_hi:[0,0,0]\n\tv_exp_f32 %1, %8\n\tv_exp_f32 %2, %9\n\tv_exp_f32 %3, %10\n\tv_exp_f32 %4, %11\n\tv_exp_f32 %5, %12\n\tv_exp_f32 %6, %13\n\tv_exp_f32 %7, %14" \
                 : "+v"(acc), "=&v"(O[k]), "=&v"(O[k + 1]), "=&v"(O[k + 2]), "=&v"(O[k + 3]), "=&v"(O[k + 4]), "=&v"(O[k + 5]), "=&v"(O[k + 6]) \
                 : "v"(I(k)), "v"(I(k + 1)), "v"(I(k + 2)), "v"(I(k + 3)), "v"(I(k + 4)), "v"(I(k + 5)), "v"(I(k + 6)), "v"(a), "v"(b), "v"(sc) : "memory")
__device__ __forceinline__ void pv_exp(f32x16* o, f32x16& lacc, const v8i& ones, const v8i& vf0, const v8i& vf1, const v8i& vf2, const v8i& vf3, const v8i& pa, int s1, const f32x16& r0, const f32x16& r1, float (&pe)[32]) {
#define ATT_RI(k) (((k) < 16) ? r0[(k) & 15] : r1[(k) & 15])
    ATT_MX7(o[0], pa, vf0, s1, "s_nop 4\n\t", pe, ATT_RI, 0);
    ATT_MX7(o[1], pa, vf1, s1, "", pe, ATT_RI, 7);
    ATT_MX7(o[2], pa, vf2, s1, "", pe, ATT_RI, 14);
    ATT_MX7(o[3], pa, vf3, s1, "", pe, ATT_RI, 21);
    asm volatile("v_mfma_scale_f32_32x32x64_f8f6f4 %0, %9, %10, %0, %11, %11 op_sel_hi:[0,0,0]\n\tv_exp_f32 %1, %5\n\tv_exp_f32 %2, %6\n\tv_exp_f32 %3, %7\n\tv_exp_f32 %4, %8"
                 : "+v"(lacc), "=&v"(pe[28]), "=&v"(pe[29]), "=&v"(pe[30]), "=&v"(pe[31]) : "v"(r1[12]), "v"(r1[13]), "v"(r1[14]), "v"(r1[15]), "v"(pa), "v"(ones), "v"(s1) : "memory");
#undef ATT_RI
}
__device__ __forceinline__ void pack_p(const float (&pe)[32], v8i& pa) {
#pragma unroll
    for (int w = 0; w < 8; ++w) pa[w] = (int)pk_fp8x4(pe[4 * w], pe[4 * w + 1], pe[4 * w + 2], pe[4 * w + 3]);
}
__device__ __forceinline__ void pv_d0(f32x16* o, f32x16& lacc, const v8i& ones, const LAS char* Vs, const v8i& pa, int r32, int hi, int s1) {
#pragma unroll
    for (int d0 = 0; d0 < 4; ++d0) { const int row = 32 * d0 + r32;
        const v8i vf = ATT_LD8(Vs + row * 64 + (((2 * hi) ^ vswz(row)) << 4), Vs + row * 64 + (((2 * hi + 1) ^ vswz(row)) << 4));
        mfma8_acc(o[d0], pa, vf, s1); }
    mfma8_acc(lacc, pa, ones, s1);
}
__device__ __forceinline__ void pv_last(f32x16* o, f32x16& lacc, const v8i& ones, const v8i& vf0, const v8i& vf1, const v8i& vf2, const v8i& vf3, const v8i& pa, int s1) {
    mfma8_acc(o[0], pa, vf0, s1); mfma8_acc(o[1], pa, vf1, s1); mfma8_acc(o[2], pa, vf2, s1); mfma8_acc(o[3], pa, vf3, s1); mfma8_acc(lacc, pa, ones, s1);
}
}

__device__ __forceinline__ void vt_phase(const Args& A, int bid, int G) {
    const int tid = threadIdx.x; unsigned char* ws = A.ws;
    const bf16_t* V = (const bf16_t*)(ws + A_V); unsigned char* VT = ws + A_VT;
    const int dv = tid & 127, kq = tid >> 7, half = kq >> 1, hi = kq & 1;
    for (int it = bid; it < 64 * 128; it += G) {
        const int bh = it >> 7, tile = it & 127, b = bh >> 3, h = bh & 7;
        const bf16_t* vp = V + ((size_t)b * SEQ + tile * 64 + 32 * half) * DM + h * 128 + dv;
        float f[16];
#pragma unroll
        for (int i = 0; i < 16; ++i) f[i] = bf2f(vp[(size_t)att::crow(i, hi) * DM]);
        *(u32x4*)(VT + (((size_t)bh * 128 + tile) * 128 + dv) * 64 + hi * 32 + half * 16) =
            (u32x4){pk_fp8x4(f[0], f[1], f[2], f[3]), pk_fp8x4(f[4], f[5], f[6], f[7]), pk_fp8x4(f[8], f[9], f[10], f[11]), pk_fp8x4(f[12], f[13], f[14], f[15])};
    }
}

__device__ __forceinline__ void attn_phase(const Args& A, LAS unsigned char* ldsu, int bid, int G, int al) {
    using namespace att;
    LAS char* lds = (LAS char*)ldsu;
    unsigned char* ws = A.ws;
    const unsigned char* Qg = ws + A_Q; const unsigned char* Kg = ws + A_K; const unsigned char* VTg = ws + A_VT;
    bf16_t* Og = (bf16_t*)(ws + WS_HM);
    const float* scal = (const float*)(ws + TB_SCAL);
    const float lamv = scal[SC_LAM0 + al], omli = scal[SC_OML0 + al], Mc = scal[SC_MC0 + al] - 7.5f;
    const float* subg = A.in[I_ATSUB] + al * 128;
    int tid_ = threadIdx.x; asm volatile("" : "+v"(tid_));
    const int tid = tid_, wid = __builtin_amdgcn_readfirstlane(tid >> 6), lane = tid & 63, r32 = lane & 31, hi = lane >> 5, jj = wid >> 2, wq = wid & 3;
    constexpr int NT = SEQ / KVBLK;
    int s1 = 0x7f7f7f7f, s8 = 0x7c7c7c7c; asm volatile("" : "+v"(s1), "+v"(s8));
    v8i ones; { int o1 = 0x38383838; asm volatile("" : "+v"(o1)); ones = (v8i){o1, o1, o1, o1, o1, o1, o1, o1}; }
    f32x16 cinit;
#pragma unroll
    for (int r = 0; r < 16; ++r) cinit[r] = -Mc;
    unsigned koff, voff;
    { const int bb = wid * 1024 + lane * 16;
      { const int row = bb >> 7, c = ((bb & 127) >> 4) ^ kswz(row); koff = (unsigned)(row * 1024 + c * 16); }
      { const int row = bb >> 6, c = ((bb & 63) >> 4) ^ vswz(row); voff = (unsigned)(row * 64 + c * 16); } }
    const unsigned ldsw = (unsigned)wid * 1024u;
#define ATT_DMA(slot, kt, vt) do { \
        __builtin_amdgcn_global_load_lds((const unsigned*)((const unsigned char*)(kt) + koff), (LAS unsigned*)(lds + k_slot(slot) + ldsw), 16, 0, 0); \
        __builtin_amdgcn_global_load_lds((const unsigned*)((const unsigned char*)(vt) + voff), (LAS unsigned*)(lds + v_slot(slot) + ldsw), 16, 0, 0); } while (0)
#define ATT_TOP() do { asm volatile("s_waitcnt vmcnt(2)" ::: "memory"); __builtin_amdgcn_s_barrier(); asm volatile("" ::: "memory"); } while (0)
    const int xq = bid & 7, cq = bid >> 3;
    int cbh = xq * 8;
    const bool lag = (jj != 0);
#define ATT_KB(bh_) (Kg + ((size_t)((bh_) >> 3) * SEQ) * DM + ((bh_) & 7) * 128)
#define ATT_VB(bh_) (VTg + (size_t)(bh_) * 128 * 8192)
    ATT_DMA(0, ATT_KB(cbh), ATT_VB(cbh)); ATT_DMA(1, ATT_KB(cbh) + (size_t)64 * DM, ATT_VB(cbh) + 8192);
    int ofKa, ofKb, ofV, ofKax, ofKbx, ofVx;
    { const int c0 = jj * 4 + 2 * hi, lb = (int)(unsigned)(size_t)lds;
      ofKa = r32 * 128 + ((c0 ^ kswz(r32)) << 4); ofKb = (32 + r32) * 128 + ((c0 ^ kswz(32 + r32)) << 4); ofV = 65536 + r32 * 64 + (((2 * hi) ^ vswz(r32)) << 4);
      ofKax = lb + (ofKa ^ 16); ofKbx = lb + (ofKb ^ 16); ofVx = lb + (ofV ^ 16); ofKa += lb; ofKb += lb; ofV += lb; }
    for (int ui = 0; ui < 16; ++ui) {
        const int qb = (ui & 1) * 32 + cq;
        const int nbh = (ui + 1 < 16) ? xq * 8 + ((ui + 1) >> 1) : cbh;
        const unsigned char* Kh = ATT_KB(cbh); const unsigned char* Vh = ATT_VB(cbh); const unsigned char* nK = ATT_KB(nbh); const unsigned char* nV = ATT_VB(nbh);
        const size_t obase = ((size_t)(cbh >> 3) * SEQ + qb * 128) * DM + (cbh & 7) * 128;
        f32x16 lacc = {}; f32x16 o[4] = {}; v8i qr;
        { const unsigned char* Qw = Qg + obase + (size_t)(wq * 32 + r32) * DM + jj * 64 + hi * 32;
          const u32x4 qa = *(const u32x4*)Qw, qb2 = *(const u32x4*)(Qw + 16);
          qr = __builtin_bit_cast(v8i, __builtin_shufflevector(qa, qb2, 0, 1, 2, 3, 4, 5, 6, 7)); }
        f32x16 pA0, pA1; v8i pa, kf0, kf1, vf0, vf1, vf2, vf3;
        const unsigned char* kptr = Kh + (size_t)2 * 64 * DM; const unsigned char* vptr = Vh + 2 * 8192;
#define ATT_ISSUE(SLD, last) do { asm volatile("" : "+s"(kptr), "+s"(vptr)); ATT_DMA(SLD, kptr, vptr); if (last) { kptr = nK; vptr = nV; } else { kptr += (size_t)64 * DM; vptr += 8192; } } while (0)
#define ATT_RD8(b_, bx_, imm_) ATT_LD8((const LAS char*)(unsigned)((b_) + (imm_)), (const LAS char*)(unsigned)((bx_) + (imm_)))
#define ATT_FIX() asm volatile("" : "+v"(ofKa), "+v"(ofKax), "+v"(ofKb), "+v"(ofKbx), "+v"(ofV), "+v"(ofVx))
#define ATT_STEPC(LAST, SL, SLP, SLD) do { \
            ATT_FIX(); \
            ATT_TOP(); \
            kf0 = ATT_RD8(ofKa, ofKax, (SL) * SLOTB); kf1 = ATT_RD8(ofKb, ofKbx, (SL) * SLOTB); vf0 = ATT_RD8(ofV, ofVx, (SLP) * SLOTB); vf1 = ATT_RD8(ofV, ofVx, (SLP) * SLOTB + 2048); \
            ATT_ISSUE(SLD, LAST); \
            ATT_TOP(); \
            qkt_pack(pA0, pA1, kf0, kf1, qr, cinit, s1, s8, pe, pa); \
            vf2 = ATT_RD8(ofV, ofVx, (SLP) * SLOTB + 4096); vf3 = ATT_RD8(ofV, ofVx, (SLP) * SLOTB + 6144); \
            pv_exp(o, lacc, ones, vf0, vf1, vf2, vf3, pa, s1, pA0, pA1, pe); } while (0)
        float pe[32];
        if (lag) ATT_TOP();
        ATT_TOP();
        ATT_FIX(); kf0 = ATT_RD8(ofKa, ofKax, 0); kf1 = ATT_RD8(ofKb, ofKbx, 0); ATT_ISSUE(2, false);
        ATT_TOP();
        { mfma8_c(pA0, kf0, qr, cinit, s1, s8); mfma8_c(pA1, kf1, qr, cinit, s1, s8);
          asm volatile("s_nop 15\n\ts_nop 15" ::: "memory");
#pragma unroll
          for (int r = 0; r < 16; ++r) pe[r] = fexp2(pA0[r]);
#pragma unroll
          for (int r = 0; r < 16; ++r) pe[16 + r] = fexp2(pA1[r]); }
        ATT_STEPC(false, 1, 0, 3); ATT_STEPC(false, 2, 1, 4); ATT_STEPC(false, 3, 2, 5); ATT_STEPC(false, 4, 3, 6); ATT_STEPC(false, 5, 4, 7); ATT_STEPC(false, 6, 5, 0); ATT_STEPC(false, 7, 6, 1);
        for (int kb = 8; kb < NT; kb += 8) {
            ATT_STEPC(false, 0, 7, 2); ATT_STEPC(false, 1, 0, 3); ATT_STEPC(false, 2, 1, 4); ATT_STEPC(false, 3, 2, 5);
            ATT_STEPC(false, 4, 3, 6); ATT_STEPC(kb == NT - 8, 5, 4, 7); ATT_STEPC(false, 6, 5, 0); ATT_STEPC(false, 7, 6, 1);
        }
        ATT_TOP();
        ATT_FIX();
        vf0 = ATT_RD8(ofV, ofVx, 7 * SLOTB); vf1 = ATT_RD8(ofV, ofVx, 7 * SLOTB + 2048);
        ATT_TOP();
        { vf2 = ATT_RD8(ofV, ofVx, 7 * SLOTB + 4096); vf3 = ATT_RD8(ofV, ofVx, 7 * SLOTB + 6144);
          pack_p(pe, pa); SBAR();
          pv_last(o, lacc, ones, vf0, vf1, vf2, vf3, pa, s1);
          asm volatile("s_nop 15\n\ts_nop 15" ::: "memory"); }
        if (!lag) ATT_TOP();
#undef ATT_ISSUE
#undef ATT_STEPC
#undef ATT_RD8
#undef ATT_FIX
        int r32e = r32, hie = hi; asm volatile("" : "+v"(r32e), "+v"(hie));
        float rli[16];
#pragma unroll
        for (int r = 0; r < 16; ++r) rli[r] = frcp(lacc[r]);
        asm volatile("s_waitcnt lgkmcnt(0)" ::: "memory"); __builtin_amdgcn_s_barrier(); asm volatile("" ::: "memory");
        LAS float* Cb = (LAS float*)(lds + ((wq < 2) ? 3 * SLOTB : 65536 + 3 * SLOTB - 64 * 512));
        if (jj == 1) {
#pragma unroll
            for (int r = 0; r < 16; ++r) { const float sc = rli[r] * lamv;
#pragma unroll
                for (int d0 = 0; d0 < 4; ++d0) Cb[(wq * 32 + crow(r, hie)) * 128 + d0 * 32 + r32e] = o[d0][r] * sc; }
        }
        asm volatile("s_waitcnt lgkmcnt(0)" ::: "memory"); __builtin_amdgcn_s_barrier(); asm volatile("" ::: "memory");
        if (jj == 0) {
            float g[4];
#pragma unroll
            for (int d0 = 0; d0 < 4; ++d0) g[d0] = subg[d0 * 32 + r32e] * omli;
            bf16_t* Ob = Og + obase;
#pragma unroll
            for (int r = 0; r < 16; ++r) {
                float ss = 0.f;
#pragma unroll
                for (int d0 = 0; d0 < 4; ++d0) { const float v = o[d0][r] * rli[r] - Cb[(wq * 32 + crow(r, hie)) * 128 + d0 * 32 + r32e]; o[d0][r] = v; ss += v * v; }
                ss += __shfl_xor(ss, 1); ss += __shfl_xor(ss, 2); ss += __shfl_xor(ss, 4); ss += __shfl_xor(ss, 8); ss += __shfl_xor(ss, 16);
                const float rs = 1.0f / sqrtf(ss * (1.0f / 128.0f) + EPS);
                bf16_t* op = Ob + (size_t)(wq * 32 + crow(r, hie)) * DM + r32e;
#pragma unroll
                for (int d0 = 0; d0 < 4; ++d0) op[d0 * 32] = (bf16_t)f2bf(o[d0][r] * rs * g[d0]);
            }
        }
        asm volatile("s_waitcnt lgkmcnt(0)" ::: "memory"); __builtin_amdgcn_s_barrier(); asm volatile("" ::: "memory");
        cbh = nbh;
    }
    asm volatile("s_waitcnt vmcnt(0) lgkmcnt(0)" ::: "memory"); __builtin_amdgcn_s_barrier(); asm volatile("" ::: "memory");
#undef ATT_DMA
#undef ATT_TOP
#undef ATT_KB
#undef ATT_VB
#undef ATT_LD8
}

namespace gla {
constexpr int BC = 0, QI = 32768, QA = 49152, KA = 65536, KST = 81920, VT = 98304, ST = 106496, AT = 122880, EM = 131072, EL = EM + 512, DD = EM + 1024, BMID = EM + 1536, SEG = EM + 2048;
static_assert(SEG + 2048 <= RING_BYTES, "gla lds");
__device__ __forceinline__ int sw256(int row, int cb) { return row * 256 + (cb ^ ((row & 15) << 4)); }
__device__ __forceinline__ int sw128(int row, int cb) { return row * 128 + (cb ^ ((((row & 7) ^ (row >> 4)) & 7) << 4)); }
__device__ __forceinline__ int crow(int r, int hi) { return (r & 3) + 8 * (r >> 2) + 4 * hi; }
__device__ __forceinline__ float h2f(unsigned short b) { return (float)__builtin_bit_cast(_Float16, b); }
__device__ __forceinline__ void gla_item(const bf16_t* __restrict__ Qp, const unsigned short* __restrict__ LFp, const bf16_t* __restrict__ Vp, bf16_t* __restrict__ Op, int dir, LAS unsigned char* lds, float* dbg) {
    int tid_ = threadIdx.x; asm volatile("" : "+v"(tid_));
    const int tid = tid_, wid = tid >> 6, lane = tid & 63, r = lane & 31, hh = lane >> 5;
    const int t1 = tid >> 3, kg = tid & 7, k0 = 16 * kg, v0 = (tid & 7) * 8;
    for (int i = tid; i < 16384 / 16; i += NTHR) *(LAS u32x4*)(lds + ST + i * 16) = (u32x4){0u, 0u, 0u, 0u};
    f32x16 st = {};
    u32x4 rq[2], rl[2], rv;
#define GLA_TOK(ci, i) (dir ? (SEQ - 1 - ((ci) * 64 + (i))) : ((ci) * 64 + (i)))
#define GLA_LOAD(ci) do { const size_t to = (size_t)GLA_TOK(ci, t1) * DM; \
        rq[0] = *(const u32x4*)(Qp + to + k0); rq[1] = *(const u32x4*)(Qp + to + k0 + 8); \
        rl[0] = *(const u32x4*)(LFp + to + k0); rl[1] = *(const u32x4*)(LFp + to + k0 + 8); rv = *(const u32x4*)(Vp + to + v0); } while (0)
    GLA_LOAD(0);
    __syncthreads();
    for (int ci = 0; ci < SEQ / 64; ++ci) {
        float qf[16], lf[16]; u32x4 vreg = rv;
#pragma unroll
        for (int j = 0; j < 2; ++j)
#pragma unroll
            for (int e = 0; e < 4; ++e) { qf[j * 8 + 2 * e] = bflo(rq[j][e]); qf[j * 8 + 2 * e + 1] = bfhi(rq[j][e]);
                lf[j * 8 + 2 * e] = h2f((unsigned short)(rl[j][e] & 0xffffu)); lf[j * 8 + 2 * e + 1] = h2f((unsigned short)(rl[j][e] >> 16)); }
        if (ci + 1 < SEQ / 64) GLA_LOAD(ci + 1);
#pragma unroll
        for (int j = 0; j < 4; ++j) *(LAS f32x4*)(lds + BC + (t1 * 128 + k0 + 4 * j) * 4) = (f32x4){lf[4 * j], lf[4 * j + 1], lf[4 * j + 2], lf[4 * j + 3]};
        __syncthreads();
        { const int kc = tid & 127, sg = tid >> 7; LAS float* bc = (LAS float*)(lds + BC) + kc; float cs[16];
#pragma unroll
            for (int i = 0; i < 16; ++i) cs[i] = bc[(sg * 16 + i) * 128];
#pragma unroll
            for (int i = 1; i < 16; ++i) cs[i] += cs[i - 1];
            ((LAS float*)(lds + SEG))[sg * 128 + kc] = cs[15];
            __syncthreads();
            const LAS float* sgp = (const LAS float*)(lds + SEG) + kc; const float s0 = sgp[0], s1 = sgp[128], s2 = sgp[256], s3 = sgp[384];
            const float off = sg == 0 ? 0.f : sg == 1 ? s0 : sg == 2 ? (s0 + s1) : ((s0 + s1) + s2);
#pragma unroll
            for (int i = 0; i < 16; ++i) bc[(sg * 16 + i) * 128] = cs[i] + off;
            if (sg == 0) { const float bm = s0 + s1, bl = ((s0 + s1) + s2) + s3;
                ((LAS float*)(lds + BMID))[kc] = bm; ((LAS float*)(lds + EM))[kc] = fexp(bm); ((LAS float*)(lds + EL))[kc] = fexp(bl - bm); ((LAS float*)(lds + DD))[kc] = fexp(bl); }
            __syncthreads();
        }
#ifdef DIAG
        if (dbg && ci == 0) { for (int i = tid; i < 8192; i += NTHR) dbg[i] = ((const LAS float*)(lds + BC))[i]; }
#endif
        {
            unsigned wqi[8], wqa[8], wka[8]; float ksv[16];
#pragma unroll
            for (int j = 0; j < 4; ++j) {
                const f32x4 bt = *(const LAS f32x4*)(lds + BC + (t1 * 128 + k0 + 4 * j) * 4), bm = *(const LAS f32x4*)(lds + BMID + (k0 + 4 * j) * 4);
                const f32x4 em = *(const LAS f32x4*)(lds + EM + (k0 + 4 * j) * 4), el = *(const LAS f32x4*)(lds + EL + (k0 + 4 * j) * 4);
                float qi[4], qa[4], ka[4];
#pragma unroll
                for (int e = 0; e < 4; ++e) { const int i = 4 * j + e; const float e1 = fexp(bt[e] - bm[e]), r1 = frcp(e1);
                    qa[e] = qf[i] * e1; qi[e] = qa[e] * em[e]; const float kk = 1.0f - fexp(lf[i]); ka[e] = kk * r1; ksv[i] = ka[e] * el[e]; }
                wqi[2 * j] = cvt_pk_bf16(qi[0], qi[1]); wqi[2 * j + 1] = cvt_pk_bf16(qi[2], qi[3]);
                wqa[2 * j] = cvt_pk_bf16(qa[0], qa[1]); wqa[2 * j + 1] = cvt_pk_bf16(qa[2], qa[3]);
                wka[2 * j] = cvt_pk_bf16(ka[0], ka[1]); wka[2 * j + 1] = cvt_pk_bf16(ka[2], ka[3]);
            }
#pragma unroll
            for (int j = 0; j < 2; ++j) { const int off = sw256(t1, (k0 + 8 * j) * 2);
                *(LAS u32x4*)(lds + QI + off) = (u32x4){wqi[4 * j], wqi[4 * j + 1], wqi[4 * j + 2], wqi[4 * j + 3]};
                *(LAS u32x4*)(lds + QA + off) = (u32x4){wqa[4 * j], wqa[4 * j + 1], wqa[4 * j + 2], wqa[4 * j + 3]};
                *(LAS u32x4*)(lds + KA + off) = (u32x4){wka[4 * j], wka[4 * j + 1], wka[4 * j + 2], wka[4 * j + 3]}; }
#pragma unroll
            for (int i = 0; i < 16; ++i) *(LAS unsigned short*)(lds + KST + sw128(k0 + i, t1 * 2)) = (unsigned short)f2bf(ksv[i]);
#pragma unroll
            for (int e = 0; e < 4; ++e) { *(LAS unsigned short*)(lds + VT + sw128(v0 + 2 * e, t1 * 2)) = (unsigned short)(vreg[e] & 0xffffu);
                *(LAS unsigned short*)(lds + VT + sw128(v0 + 2 * e + 1, t1 * 2)) = (unsigned short)(vreg[e] >> 16); }
        }
        __syncthreads();
        f32x16 oacc = {};
        const int w4 = wid & 3, t_i = w4 >> 1, v_i = w4 & 1;
        if (wid < 4) {
            const int s_i = wid >> 1, tq = wid & 1; f32x16 a = {};
#pragma unroll
            for (int ks = 0; ks < 8; ++ks) { const bf16x8 fa = *(const LAS bf16x8*)(lds + KA + sw256(32 * s_i + r, (16 * ks + 8 * hh) * 2)), fb = *(const LAS bf16x8*)(lds + QA + sw256(32 * tq + r, (16 * ks + 8 * hh) * 2));
                a = __builtin_amdgcn_mfma_f32_32x32x16_bf16(fa, fb, a, 0, 0, 0); }
            const int tg = 32 * tq + r;
#pragma unroll
            for (int g = 0; g < 4; ++g) { float m[4];
#pragma unroll
                for (int e = 0; e < 4; ++e) { const int sgl = 32 * s_i + 8 * g + 4 * hh + e; m[e] = (sgl <= tg) ? a[4 * g + e] : 0.f; }
                *(LAS u32x2*)(lds + AT + sw128(tg, (32 * s_i + 8 * g + 4 * hh) * 2)) = (u32x2){cvt_pk_bf16(m[0], m[1]), cvt_pk_bf16(m[2], m[3])}; }
        } else {
#pragma unroll
            for (int ks = 0; ks < 8; ++ks) { const bf16x8 fa = *(const LAS bf16x8*)(lds + QI + sw256(32 * t_i + r, (16 * ks + 8 * hh) * 2)), fb = *(const LAS bf16x8*)(lds + ST + sw256(32 * v_i + r, (16 * ks + 8 * hh) * 2));
                oacc = __builtin_amdgcn_mfma_f32_32x32x16_bf16(fa, fb, oacc, 0, 0, 0); }
        }
        __syncthreads();
#ifdef DIAG
        if (dbg && ci == 0) { for (int i = tid; i < 2048; i += NTHR) { ((unsigned*)dbg)[8192 + i] = ((const LAS unsigned*)(lds + AT))[i]; ((unsigned*)dbg)[8192 + 2048 + i] = ((const LAS unsigned*)(lds + VT))[i]; } }
#endif
        if (wid >= 4) {
#pragma unroll
            for (int ks = 0; ks < 4; ++ks) { const bf16x8 fa = *(const LAS bf16x8*)(lds + AT + sw128(32 * t_i + r, (16 * ks + 8 * hh) * 2)), fb = *(const LAS bf16x8*)(lds + VT + sw128(32 * v_i + r, (16 * ks + 8 * hh) * 2));
                oacc = __builtin_amdgcn_mfma_f32_32x32x16_bf16(fa, fb, oacc, 0, 0, 0); }
#pragma unroll
            for (int i = 0; i < 16; ++i) { const int t = 32 * t_i + crow(i, hh); Op[(size_t)GLA_TOK(ci, t) * DM + 32 * v_i + r] = (bf16_t)f2bf(oacc[i]); }
        }
        {
            const int kq = wid >> 1, vq = wid & 1;
#pragma unroll
            for (int i = 0; i < 16; ++i) st[i] *= ((const LAS float*)(lds + DD))[32 * kq + crow(i, hh)];
#pragma unroll
            for (int ks = 0; ks < 4; ++ks) { const bf16x8 fa = *(const LAS bf16x8*)(lds + KST + sw128(32 * kq + r, (16 * ks + 8 * hh) * 2)), fb = *(const LAS bf16x8*)(lds + VT + sw128(32 * vq + r, (16 * ks + 8 * hh) * 2));
                st = __builtin_amdgcn_mfma_f32_32x32x16_bf16(fa, fb, st, 0, 0, 0); }
#pragma unroll
            for (int g = 0; g < 4; ++g) *(LAS u32x2*)(lds + ST + sw256(32 * vq + r, (32 * kq + 8 * g + 4 * hh) * 2)) = (u32x2){cvt_pk_bf16(st[4 * g], st[4 * g + 1]), cvt_pk_bf16(st[4 * g + 2], st[4 * g + 3])};
        }
        __syncthreads();
#ifdef DIAG
        if (dbg && ci == 0) { for (int i = tid; i < 4096; i += NTHR) { ((unsigned*)dbg)[12288 + i] = ((const LAS unsigned*)(lds + ST))[i]; ((unsigned*)dbg)[16384 + i] = ((const LAS unsigned*)(lds + KST))[i]; } }
#endif
    }
#undef GLA_TOK
#undef GLA_LOAD
}
}
__device__ __forceinline__ void gla_phase(const Args& A, LAS unsigned char* lds, int bid, int G) {
    unsigned char* ws = A.ws;
    for (int it = bid; it < 256; it += G) {
        const int b = it >> 5, h = (it >> 2) & 7, dir = (it >> 1) & 1, vh = it & 1;
        const size_t base = (size_t)b * SEQ * DM + h * 128;
        gla::gla_item((const bf16_t*)(ws + H_Q) + base, (const unsigned short*)(ws + (dir ? H_LFB : H_LFF)) + base, (const bf16_t*)(ws + H_V) + base + vh * 64,
                      (bf16_t*)(ws + (dir ? H_OB : H_OF)) + base + vh * 64, dir, lds, it == 0 ? (float*)(ws + TB_LSUM) : nullptr);
    }
}
__device__ __forceinline__ void hg_normo_phase(const Args& A, int bid, int G) {
    int tid_ = threadIdx.x; asm volatile("" : "+v"(tid_));
    const int tid = tid_, lane = tid & 63, wave = tid >> 6; unsigned char* ws = A.ws;
    const bf16_t* OF = (const bf16_t*)(ws + H_OF); const bf16_t* OB = (const bf16_t*)(ws + H_OB); const bf16_t* GG = (const bf16_t*)(ws + H_G); bf16_t* HM = (bf16_t*)(ws + WS_HM);
    const int c0 = (lane >> 3) * 128 + (lane & 7) * 16;
    float ng[16];
#pragma unroll
    for (int i = 0; i < 16; ++i) ng[i] = A.in[I_HGNG][(lane & 7) * 16 + i];
    for (int row = (bid * NWAVES + wave); row < MTOK; row += G * NWAVES) {
        const size_t o = (size_t)row * DM + c0;
        const u32x4 a0 = *(const u32x4*)(OF + o), a1 = *(const u32x4*)(OF + o + 8), b0 = *(const u32x4*)(OB + o), b1 = *(const u32x4*)(OB + o + 8), g0 = *(const u32x4*)(GG + o), g1 = *(const u32x4*)(GG + o + 8);
        float v[16], gt[16]; float ss = 0.f;
#pragma unroll
        for (int e = 0; e < 4; ++e) { v[2 * e] = bflo(a0[e]) + bflo(b0[e]); v[2 * e + 1] = bfhi(a0[e]) + bfhi(b0[e]); v[8 + 2 * e] = bflo(a1[e]) + bflo(b1[e]); v[8 + 2 * e + 1] = bfhi(a1[e]) + bfhi(b1[e]);
            gt[2 * e] = bflo(g0[e]); gt[2 * e + 1] = bfhi(g0[e]); gt[8 + 2 * e] = bflo(g1[e]); gt[8 + 2 * e + 1] = bfhi(g1[e]); }
#pragma unroll
        for (int i = 0; i < 16; ++i) ss += v[i] * v[i];
        ss += __shfl_xor(ss, 1); ss += __shfl_xor(ss, 2); ss += __shfl_xor(ss, 4);
        const float rstd = 1.0f / sqrtf(ss * (1.0f / 128.0f) + EPS);
        u32x4 w0, w1;
#pragma unroll
        for (int e = 0; e < 4; ++e) { w0[e] = cvt_pk_bf16(v[2 * e] * rstd * ng[2 * e] * gt[2 * e], v[2 * e + 1] * rstd * ng[2 * e + 1] * gt[2 * e + 1]);
            w1[e] = cvt_pk_bf16(v[8 + 2 * e] * rstd * ng[8 + 2 * e] * gt[8 + 2 * e], v[8 + 2 * e + 1] * rstd * ng[8 + 2 * e + 1] * gt[8 + 2 * e + 1]); }
        *(u32x4*)(HM + o) = w0; *(u32x4*)(HM + o + 8) = w1;
    }
}

#ifdef DIAG
constexpr int DG_BASE = 8192;
__device__ __forceinline__ void dg_put(const Args& A, int k, float e) { if (!(e >= 0.f) || e > 1e9f) e = 1e9f; atomicMax((unsigned*)(A.ws + WS_CTL) + DG_BASE + 64 * k, __float_as_uint(e)); }
__device__ __forceinline__ float dg_rel(float got, float ref) { return fabsf(got - ref) / (fabsf(ref) + 0.1f); }
__device__ __forceinline__ unsigned dg_hash(unsigned a, unsigned b) { unsigned h = a * 2654435761u + b * 40503u + 0x9e3779b9u; h ^= h >> 15; h *= 2246822519u; h ^= h >> 13; h *= 3266489917u; h ^= h >> 16; return h; }
__device__ __forceinline__ float dg_bfr(float x) { return bflo(f2bf(x)); }
__device__ __forceinline__ void dg_mods(const Args& A, int k) {
    const int lane = threadIdx.x & 63, gwv = blockIdx.x * 8 + (threadIdx.x >> 6);
    const unsigned h = dg_hash(gwv, k); const int l = h & 3, b = (h >> 2) & 7, e = (h >> 5) % 6144;
    float a = 0.f; for (int d = lane; d < DM; d += 64) a += fsilu(A.in[I_C][b * DM + d]) * A.in[I_ADAW][((size_t)l * DM + d) * 6144 + e];
    a = wave_sum(a) + A.in[I_ADAB][l * 6144 + e];
    const float got = ((const float*)(A.ws + TB_MODS))[((size_t)l * NBATCH + b) * 6144 + e];
    if (lane == 0) dg_put(A, k, dg_rel(got, a));
}
__device__ __forceinline__ void dg_norm(const Args& A, int k, const float* x, const float* gain, int L, int which) {
    const int lane = threadIdx.x & 63, gwv = blockIdx.x * 8 + (threadIdx.x >> 6);
    const int row = dg_hash(gwv, k) & (MTOK - 1), b = row >> 13;
    const float* modl = (const float*)(A.ws + TB_MODS) + ((size_t)L * NBATCH + b) * 6144;
    float ss = 0.f; for (int c = lane; c < DM; c += 64) { const float v = x[(size_t)row * DM + c]; ss += v * v; }
    ss = wave_sum(ss); const float rstd = 1.0f / sqrtf(ss / DM + EPS); float e = 0.f;
    for (int c = lane; c < DM; c += 64) { const float ref = x[(size_t)row * DM + c] * rstd * gain[c] * (1.0f + modl[(which * 3 + 1) * 1024 + c]) + modl[(which * 3) * 1024 + c];
        e = fmaxf(e, dg_rel(bf2f(((const bf16_t*)(A.ws + WS_HM))[(size_t)row * DM + c]), ref)); }
    dg_put(A, k, e);
}
__device__ __forceinline__ void dg_qkv(const Args& A, int k, int al) {
    const int lane = threadIdx.x & 63, gwv = blockIdx.x * 8 + (threadIdx.x >> 6);
    const unsigned h = dg_hash(gwv, k); const int row = h & (MTOK - 1), t = (h >> 16) % 48, col = t * 64 + lane;
    const bf16_t* hm = (const bf16_t*)(A.ws + WS_HM) + (size_t)row * DM; const float* w = A.in[I_ATWIN] + (size_t)al * 1024 * 3072 + col;
    float a = 0.f; for (int kk = 0; kk < DM; ++kk) a += bf2f(hm[kk]) * dg_bfr(w[(size_t)kk * 3072]);
    float ref, got;
    if (t < 32) {
        const int part = t >> 4, sh = t & 15; const float ss = wave_sum(a * a); const float rstd = 1.0f / sqrtf(ss / 64.0f + EPS);
        const float y = a * rstd * (part ? A.in[I_ATKN] : A.in[I_ATQN])[al * 64 + lane]; const float yp = __shfl_xor(y, 32);
        const int pos = row & (SEQ - 1); const float cs = ((const float*)(A.ws + TB_COS))[pos * 32 + (lane & 31)], sn = ((const float*)(A.ws + TB_SIN))[pos * 32 + (lane & 31)];
        ref = (lane < 32) ? (y * cs - yp * sn) : (y * cs + yp * sn); if (part == 0) ref *= 0.125f * LOG2E;
        got = bf2f(((const bf16_t*)(A.ws + (part ? A_K : A_Q)))[(size_t)row * DM + sh * 64 + lane]);
    } else { ref = a; got = bf2f(((const bf16_t*)(A.ws + A_V))[(size_t)row * DM + (t - 32) * 64 + lane]); }
    dg_put(A, k, dg_rel(got, ref));
}
__device__ __forceinline__ void dg_attn(const Args& A, int k, int al, LAS unsigned char* lds) {
    const int tid = threadIdx.x; const unsigned h = dg_hash(blockIdx.x, k); const int row = h & (MTOK - 1), hd = (h >> 16) & 7, b = row >> 13;
    const bf16_t* Q = (const bf16_t*)(A.ws + A_Q); const bf16_t* K = (const bf16_t*)(A.ws + A_K); const bf16_t* V = (const bf16_t*)(A.ws + A_V);
    const float* scal = (const float*)(A.ws + TB_SCAL); const float lamv = scal[SC_LAM0 + al], omli = scal[SC_OML0 + al], Mc = scal[SC_MC0 + al];
    LAS float* p0 = (LAS float*)lds; LAS float* p1 = p0 + SEQ; LAS float* red = p1 + SEQ;
    float l0 = 0.f, l1 = 0.f;
    for (int key = tid; key < SEQ; key += NTHR) { const bf16_t* kr = K + ((size_t)b * SEQ + key) * DM + hd * 128; const bf16_t* qr = Q + (size_t)row * DM + hd * 128;
        float s0 = 0.f, s1 = 0.f; for (int d = 0; d < 64; ++d) { s0 += bf2f(qr[d]) * bf2f(kr[d]); s1 += bf2f(qr[64 + d]) * bf2f(kr[64 + d]); }
        const float e0 = fexp2(s0 - Mc), e1 = fexp2(s1 - Mc); p0[key] = e0; p1[key] = e1; l0 += e0; l1 += e1; }
    l0 = wave_sum(l0); l1 = wave_sum(l1); if ((tid & 63) == 0) { red[tid >> 6] = l0; red[8 + (tid >> 6)] = l1; }
    __syncthreads();
    l0 = 0.f; l1 = 0.f; for (int w = 0; w < 8; ++w) { l0 += red[w]; l1 += red[8 + w]; }
    __syncthreads();
    const int dv = tid & 127, part = tid >> 7; float o = 0.f;
    for (int key = part * 2048; key < part * 2048 + 2048; ++key) o += (p0[key] / l0 - lamv * p1[key] / l1) * bf2f(V[((size_t)b * SEQ + key) * DM + hd * 128 + dv]);
    red[16 + part * 128 + dv] = o; __syncthreads();
    if (tid < 128) { o = red[16 + tid] + red[16 + 128 + tid] + red[16 + 256 + tid] + red[16 + 384 + tid]; red[600 + tid] = o * o; }
    __syncthreads();
    if (tid < 128) { float ss = 0.f; for (int i = 0; i < 128; ++i) ss += red[600 + i]; const float ref = o / sqrtf(ss / 128.0f + EPS) * A.in[I_ATSUB][al * 128 + tid] * omli;
        dg_put(A, k, dg_rel(bf2f(((const bf16_t*)(A.ws + WS_HM))[(size_t)row * DM + hd * 128 + tid]), ref)); }
    __syncthreads();
}
__device__ __forceinline__ void dg_save(const Args& A, int k, const float* xold) {
    const int lane = threadIdx.x & 63, gwv = blockIdx.x * 8 + (threadIdx.x >> 6);
    const unsigned h = dg_hash(gwv, k); const int row = h & (MTOK - 1), col = (h >> 16) & 1023;
    float* sv = (float*)(A.ws + TB_LSUM) + 7 * 1024 * 1024 / 4;
    if (lane == 0) sv[k * 4096 + gwv] = xold[(size_t)row * DM + col];
}
__device__ __forceinline__ void dg_res(const Args& A, int k, const float* xnew, const float* gate, const bf16_t* Am, int K, const float* W) {
    const int lane = threadIdx.x & 63, gwv = blockIdx.x * 8 + (threadIdx.x >> 6);
    const unsigned h = dg_hash(gwv, k); const int row = h & (MTOK - 1), col = (h >> 16) & 1023, b = row >> 13;
    const float* sv = (const float*)(A.ws + TB_LSUM) + 7 * 1024 * 1024 / 4;
    float a = 0.f; for (int kk = lane; kk < K; kk += 64) a += bf2f(Am[(size_t)row * K + kk]) * dg_bfr(W[(size_t)kk * DM + col]);
    a = wave_sum(a);
    const float ref = sv[k * 4096 + gwv] + gate[(size_t)b * 6144 + col] * a;
    if (lane == 0) dg_put(A, k, dg_rel(xnew[(size_t)row * DM + col], ref));
}
__device__ __forceinline__ void dg_swiglu(const Args& A, int k, const bf16_t* Am, const float* W, int F, const bf16_t* H, int nrows, const int* rowmap) {
    const int lane = threadIdx.x & 63, gwv = blockIdx.x * 8 + (threadIdx.x >> 6);
    const unsigned h = dg_hash(gwv, k); const int row = (h & 0xfffff) % nrows, j = (h >> 20) % F;
    float g = 0.f, u = 0.f; for (int kk = lane; kk < DM; kk += 64) { const float x = bf2f(Am[(size_t)row * DM + kk]); g += x * dg_bfr(W[(size_t)kk * 2 * F + j]); u += x * dg_bfr(W[(size_t)kk * 2 * F + F + j]); }
    g = wave_sum(g); u = wave_sum(u);
    const float ref = g / (1.0f + expf(-g)) * u;
    if (lane == 0) dg_put(A, k, dg_rel(bf2f(H[(size_t)row * F + j]), ref));
}
__device__ __forceinline__ void dg_hgin(const Args& A, int k) {
    const int lane = threadIdx.x & 63, gwv = blockIdx.x * 8 + (threadIdx.x >> 6);
    const unsigned h = dg_hash(gwv, k); const int row = h & (MTOK - 1), col = (h >> 16) % 5120, grp = col >> 10, cc = col & 1023;
    float a = 0.f; for (int kk = lane; kk < DM; kk += 64) a += bf2f(((const bf16_t*)(A.ws + WS_HM))[(size_t)row * DM + kk]) * dg_bfr(A.in[I_HGWIN][(size_t)kk * 5120 + col]);
    a = wave_sum(a);
    float ref, got;
    if (grp == 0 || grp == 4) { ref = a / (1.0f + expf(-a)); got = bf2f(((const bf16_t*)(A.ws + (grp == 0 ? H_Q : H_G)))[(size_t)row * DM + cc]); }
    else if (grp == 3) { ref = a; got = bf2f(((const bf16_t*)(A.ws + H_V))[(size_t)row * DM + cc]); }
    else { const int d = grp - 1; const float* p = A.in[I_HGLB] + (size_t)d * DEPTH * 1024 + cc; float mx = p[0]; for (int l = 1; l < DEPTH; ++l) mx = fmaxf(mx, p[l * 1024]);
        float den = 0.f; for (int l = 0; l < DEPTH; ++l) den += expf(p[l * 1024] - mx); const float lbv = expf(p[1024] - mx) / den;
        ref = logf(lbv + (1.0f - lbv) / (1.0f + expf(-a))); got = gla::h2f(((const unsigned short*)(A.ws + (d ? H_LFB : H_LFF)))[(size_t)row * DM + cc]); }
    if (lane == 0) dg_put(A, k, dg_rel(got, ref));
}
__device__ __forceinline__ void dg_gla(const Args& A, int k) {
    const int lane = threadIdx.x & 63, gwv = blockIdx.x * 8 + (threadIdx.x >> 6);
    const unsigned h = dg_hash(gwv, k); const int sel0 = (gwv & 3) == 0; const int b = sel0 ? 0 : (h & 7), hd = sel0 ? 0 : ((h >> 3) & 7), dir = sel0 ? 0 : ((h >> 6) & 1), vc = sel0 ? ((h >> 7) & 63) : ((h >> 7) & 127);
    const bf16_t* Q = (const bf16_t*)(A.ws + H_Q); const unsigned short* LF = (const unsigned short*)(A.ws + (dir ? H_LFB : H_LFF)); const bf16_t* V = (const bf16_t*)(A.ws + H_V);
    const bf16_t* O = (const bf16_t*)(A.ws + (dir ? H_OB : H_OF));
    float s0 = 0.f, s1 = 0.f, e0 = 0.f, e1 = 0.f, e2 = 0.f, e3 = 0.f;
    for (int i = 0; i < SEQ; ++i) { const int tok = dir ? (SEQ - 1 - i) : i; const size_t o = ((size_t)b * SEQ + tok) * DM + hd * 128;
        const float f0 = expf(gla::h2f(LF[o + lane])), f1 = expf(gla::h2f(LF[o + 64 + lane])), v = bf2f(V[o + vc]);
        s0 = f0 * s0 + (1.0f - f0) * v; s1 = f1 * s1 + (1.0f - f1) * v;
        if (i < 128 || i % 61 == 0) { const float ov = wave_sum(bf2f(Q[o + lane]) * s0 + bf2f(Q[o + 64 + lane]) * s1); const float er = 0.25f * fabsf(bf2f(O[o + vc]) - ov) / (fabsf(ov) + 1.0f);
            if (i == 0) e0 = er; else if (i < 64) e1 = fmaxf(e1, er); else if (i < 128) e2 = fmaxf(e2, er); else e3 = fmaxf(e3, er); } }
    if (lane == 0) { dg_put(A, k, e0); dg_put(A, k + 4, e1); dg_put(A, k + 5, e2); dg_put(A, k + 6, e3); }
    const float* dbg = (const float*)(A.ws + TB_LSUM); const unsigned short* LF0 = (const unsigned short*)(A.ws + H_LFF); const bf16_t* Q0 = (const bf16_t*)(A.ws + H_Q);
    { const unsigned h2 = dg_hash(gwv, k + 100); const int t = h2 & 63, kk = (h2 >> 6) & 127; float c = 0.f; for (int tt = 0; tt <= t; ++tt) c += gla::h2f(LF0[(size_t)tt * DM + kk]);
      if (lane == 0) dg_put(A, k + 1, dg_rel(dbg[t * 128 + kk], c)); }
    { const unsigned h2 = dg_hash(gwv, k + 200); const int t = h2 & 63, sidx = (h2 >> 6) & 63; float a = 0.f;
      if (sidx <= t) { for (int kk = lane; kk < 128; kk += 64) { float c = 0.f; for (int tt = sidx + 1; tt <= t; ++tt) c += gla::h2f(LF0[(size_t)tt * DM + kk]);
              a += bf2f(Q0[(size_t)t * DM + kk]) * (1.0f - expf(gla::h2f(LF0[(size_t)sidx * DM + kk]))) * expf(c); } a = wave_sum(a); }
      const unsigned short got = ((const unsigned short*)(dbg + 8192))[gla::sw128(t, sidx * 2) / 2];
      if (lane == 0) dg_put(A, k + 2, 5.0f * fabsf(bf2f(got) - a) / (fabsf(a) + 0.01f)); }
    { const unsigned h2 = dg_hash(gwv, k + 300); const int sidx = h2 & 63, v = (h2 >> 6) & 63;
      const unsigned short got = ((const unsigned short*)(dbg + 8192 + 2048))[gla::sw128(v, sidx * 2) / 2];
      if (lane == 0) dg_put(A, k + 2, dg_rel(bf2f(got), bf2f(((const bf16_t*)(A.ws + H_V))[(size_t)sidx * DM + v]))); }
    { const unsigned h2 = dg_hash(gwv, k + 500); const int kk = h2 & 127, v = (h2 >> 7) & 63;
      float a = 0.f; { const int sidx = lane; float c = 0.f; for (int tt = sidx + 1; tt < 64; ++tt) c += gla::h2f(LF0[(size_t)tt * DM + kk]);
          const float ksn = (1.0f - expf(gla::h2f(LF0[(size_t)sidx * DM + kk]))) * expf(c);
          const unsigned short gk = ((const unsigned short*)(dbg + 16384))[gla::sw128(kk, sidx * 2) / 2];
          dg_put(A, k + 2, 0.5f * fabsf(bf2f(gk) - ksn) / (fabsf(ksn) + 0.01f));
          a = ksn * bf2f(((const bf16_t*)(A.ws + H_V))[(size_t)sidx * DM + v]); }
      a = wave_sum(a);
      const unsigned short gs = ((const unsigned short*)(dbg + 12288))[gla::sw256(v, kk * 2) / 2];
      if (lane == 0) dg_put(A, k + 3, 0.5f * fabsf(bf2f(gs) - a) / (fabsf(a) + 0.05f)); }
    { const unsigned h2 = dg_hash(gwv, k + 400); const int t = h2 & 63, v = (h2 >> 6) & 63;
      const unsigned short* at = (const unsigned short*)(dbg + 8192); const unsigned short* vt = (const unsigned short*)(dbg + 8192 + 2048);
      float a = bf2f(at[gla::sw128(t, lane * 2) / 2]) * bf2f(vt[gla::sw128(v, lane * 2) / 2]); a = wave_sum(a);
      if (lane == 0) dg_put(A, k + 1, 5.0f * dg_rel(bf2f(((const bf16_t*)(A.ws + H_OF))[(size_t)t * DM + v]), a)); }
}
__device__ __forceinline__ void dg_normo(const Args& A, int k) {
    const int lane = threadIdx.x & 63, gwv = blockIdx.x * 8 + (threadIdx.x >> 6);
    const unsigned h = dg_hash(gwv, k); const int row = h & (MTOK - 1), hd = (h >> 16) & 7; const size_t o = (size_t)row * DM + hd * 128;
    const float v0 = bf2f(((const bf16_t*)(A.ws + H_OF))[o + lane]) + bf2f(((const bf16_t*)(A.ws + H_OB))[o + lane]), v1 = bf2f(((const bf16_t*)(A.ws + H_OF))[o + 64 + lane]) + bf2f(((const bf16_t*)(A.ws + H_OB))[o + 64 + lane]);
    const float ss = wave_sum(v0 * v0 + v1 * v1), rstd = 1.0f / sqrtf(ss / 128.0f + EPS);
    const float r0 = v0 * rstd * A.in[I_HGNG][lane] * bf2f(((const bf16_t*)(A.ws + H_G))[o + lane]), r1 = v1 * rstd * A.in[I_HGNG][64 + lane] * bf2f(((const bf16_t*)(A.ws + H_G))[o + 64 + lane]);
    dg_put(A, k, fmaxf(dg_rel(bf2f(((const bf16_t*)(A.ws + WS_HM))[o + lane]), r0), dg_rel(bf2f(((const bf16_t*)(A.ws + WS_HM))[o + 64 + lane]), r1)));
}
__device__ __forceinline__ void dg_router(const Args& A, int k, int L) {
    const int lane = threadIdx.x & 63, gwv = blockIdx.x * 8 + (threadIdx.x >> 6);
    const int row = dg_hash(gwv, k) & (MTOK - 1), b = row >> 13; const float* x = A.out + (size_t)row * DM;
    const float* modl = (const float*)(A.ws + TB_MODS) + ((size_t)L * NBATCH + b) * 6144; const float* gain = A.in[I_N2G] + L * DM; const float* R = A.in[I_MOER] + (size_t)(L >> 1) * DM * 8;
    float ss = 0.f; for (int c = lane; c < DM; c += 64) ss += x[c] * x[c];
    ss = wave_sum(ss); const float rstd = 1.0f / sqrtf(ss / DM + EPS);
    float lg[8]; for (int e = 0; e < 8; ++e) lg[e] = 0.f;
    for (int c = lane; c < DM; c += 64) { const float hv = x[c] * rstd * gain[c] * (1.0f + modl[4 * 1024 + c]) + modl[3 * 1024 + c]; for (int e = 0; e < 8; ++e) lg[e] += hv * R[c * 8 + e]; }
    for (int e = 0; e < 8; ++e) lg[e] = wave_sum(lg[e]);
    int e0 = 0; for (int e = 1; e < 8; ++e) if (lg[e] > lg[e0]) e0 = e;
    int e1 = (e0 == 0) ? 1 : 0; for (int e = 0; e < 8; ++e) if (e != e0 && lg[e] > lg[e1]) e1 = e;
    float gap = 1e9f; for (int e = 0; e < 8; ++e) if (e != e0 && e != e1) gap = fminf(gap, lg[e1] - lg[e]); gap = fminf(gap, lg[e0] - lg[e1]);
    const int g0 = ((const int*)(A.ws + TB_EID))[row * 2], g1 = ((const int*)(A.ws + TB_EID))[row * 2 + 1]; const float w0 = ((const float*)(A.ws + TB_GATE))[row * 2], w1 = ((const float*)(A.ws + TB_GATE))[row * 2 + 1];
    const float p0 = 1.0f / (1.0f + expf(lg[e1] - lg[e0]));
    float er = (g0 != e0 || g1 != e1) ? (gap > 2e-3f ? 9.f : 0.f) : fmaxf(fabsf(w0 - p0), fabsf(w1 - (1.0f - p0)));
    if (lane == 0) dg_put(A, k, er);
}
__device__ __forceinline__ void dg_place(const Args& A, int k) {
    const int lane = threadIdx.x & 63, gwv = blockIdx.x * 8 + (threadIdx.x >> 6);
    const unsigned h = dg_hash(gwv, k); const int row = h & (MTOK - 1), kk = (h >> 16) & 1;
    const int sl = ((const int*)(A.ws + TB_SLOT))[row * 2 + kk], e = ((const int*)(A.ws + TB_EID))[row * 2 + kk]; const int* ts = (const int*)(A.ws + TB_TILES);
    float er = (sl >= ts[e] * 256 && sl < ts[e + 1] * 256 && sl < MOE_ROWS) ? 0.f : 7.f;
    if (er == 0.f) for (int c = lane; c < DM; c += 64) if (((const bf16_t*)(A.ws + E_XS))[(size_t)sl * DM + c] != ((const bf16_t*)(A.ws + WS_HM))[(size_t)row * DM + c]) er = 5.f;
    dg_put(A, k, er);
}
__device__ __forceinline__ void dg_moe_hid(const Args& A, int k, int m) {
    const int lane = threadIdx.x & 63, gwv = blockIdx.x * 8 + (threadIdx.x >> 6);
    const unsigned h = dg_hash(gwv, k); const int row = h & (MTOK - 1), kk = (h >> 16) & 1, j = (h >> 17) % DFFE;
    const int sl = ((const int*)(A.ws + TB_SLOT))[row * 2 + kk], e = ((const int*)(A.ws + TB_EID))[row * 2 + kk];
    const float* W = A.in[I_MOEGU] + ((size_t)m * 8 + e) * DM * 2 * DFFE; const bf16_t* Am = (const bf16_t*)(A.ws + E_XS) + (size_t)sl * DM;
    float g = 0.f, u = 0.f; for (int c = lane; c < DM; c += 64) { const float x = bf2f(Am[c]); g += x * dg_bfr(W[(size_t)c * 2 * DFFE + j]); u += x * dg_bfr(W[(size_t)c * 2 * DFFE + DFFE + j]); }
    g = wave_sum(g); u = wave_sum(u);
    if (lane == 0) dg_put(A, k, dg_rel(bf2f(((const bf16_t*)(A.ws + E_HID))[(size_t)sl * DFFE + j]), g / (1.0f + expf(-g)) * u));
}
__device__ __forceinline__ void dg_moe_y(const Args& A, int k, int m) {
    const int lane = threadIdx.x & 63, gwv = blockIdx.x * 8 + (threadIdx.x >> 6);
    const unsigned h = dg_hash(gwv, k); const int row = h & (MTOK - 1), kk = (h >> 16) & 1, col = (h >> 17) & 1023;
    const int sl = ((const int*)(A.ws + TB_SLOT))[row * 2 + kk], e = ((const int*)(A.ws + TB_EID))[row * 2 + kk];
    const float* W = A.in[I_MOEDN] + ((size_t)m * 8 + e) * DFFE * DM; const bf16_t* Hh = (const bf16_t*)(A.ws + E_HID) + (size_t)sl * DFFE;
    float a = 0.f; for (int j = lane; j < DFFE; j += 64) a += bf2f(Hh[j]) * dg_bfr(W[(size_t)j * DM + col]);
    a = wave_sum(a);
    if (lane == 0) dg_put(A, k, fabsf(bf2f(((const bf16_t*)(A.ws + E_XS))[(size_t)sl * DM + col]) - a) / (fabsf(a) + 0.3f));
}
__device__ __forceinline__ void dg_combine(const Args& A, int k, const float* modprev) {
    const int lane = threadIdx.x & 63, gwv = blockIdx.x * 8 + (threadIdx.x >> 6);
    const unsigned h = dg_hash(gwv, k); const int row = h & (MTOK - 1), col = (h >> 16) & 1023, b = row >> 13;
    const float* sv = (const float*)(A.ws + TB_LSUM) + 7 * 1024 * 1024 / 4; const bf16_t* Y = (const bf16_t*)(A.ws + E_XS);
    const int s0 = ((const int*)(A.ws + TB_SLOT))[row * 2], s1 = ((const int*)(A.ws + TB_SLOT))[row * 2 + 1]; const float w0 = ((const float*)(A.ws + TB_GATE))[row * 2], w1 = ((const float*)(A.ws + TB_GATE))[row * 2 + 1];
    const float ref = sv[k * 4096 + gwv] + modprev[(size_t)b * 6144 + 5 * 1024 + col] * (w0 * bf2f(Y[(size_t)s0 * DM + col]) + w1 * bf2f(Y[(size_t)s1 * DM + col]));
    if (lane == 0) dg_put(A, k, dg_rel(A.out[(size_t)row * DM + col], ref));
}
__device__ __forceinline__ void dg_lruin(const Args& A, int k) {
    const int lane = threadIdx.x & 63, gwv = blockIdx.x * 8 + (threadIdx.x >> 6);
    const unsigned h = dg_hash(gwv, k); const int row = h & (MTOK - 1), col = (h >> 16) % 2560;
    float a = 0.f; for (int kk = lane; kk < DM; kk += 64) a += bf2f(((const bf16_t*)(A.ws + WS_HM))[(size_t)row * DM + kk]) * dg_bfr(A.in[I_LRWIN][(size_t)kk * 2560 + col]);
    a = wave_sum(a);
    float ref, got;
    if (col < LRUW) { ref = 0.5f * a * (1.0f + tanhf(0.7978845608028654f * (a + 0.044715f * a * a * a))); got = bf2f(((const bf16_t*)(A.ws + L_YB))[(size_t)row * LRUW + col]); }
    else { ref = a; got = bf2f(((const bf16_t*)(A.ws + L_XB))[(size_t)row * LRUW + col - LRUW]); }
    if (lane == 0) dg_put(A, k, dg_rel(got, ref));
}
__device__ __forceinline__ void dg_lru(const Args& A, int k) {
    const int lane = threadIdx.x & 63, gwv = blockIdx.x * 8 + (threadIdx.x >> 6);
    const unsigned h = dg_hash(gwv, k); const int b = h & 7, ch = (h >> 3) % LRUW, tc = (h >> 16) & (SEQ - 1), n = ch / 128, j = ch % 128;
    const bf16_t* XB = (const bf16_t*)(A.ws + L_XB) + (size_t)b * SEQ * LRUW;
    float hres[2];
    for (int d = 0; d < 2; ++d) {
        const float* wa = A.in[I_LRWA] + (size_t)(d * 10 + n) * 16384; const float* wx = A.in[I_LRWX] + (size_t)(d * 10 + n) * 16384;
        const float wa0 = dg_bfr(wa[lane * 128 + j]), wa1 = dg_bfr(wa[(lane + 64) * 128 + j]), wx0 = dg_bfr(wx[lane * 128 + j]), wx1 = dg_bfr(wx[(lane + 64) * 128 + j]);
        const float ba = A.in[I_LRBA][d * LRUW + ch], bx = A.in[I_LRBX][d * LRUW + ch]; const float lam = A.in[I_LRLAM][d * LRUW + ch]; const float sp = log1pf(expf(-lam));
        float hs = 0.f;
        for (int i = 0; ; ++i) { const int t = d ? (SEQ - 1 - i) : i;
            float x0 = A.in[I_LRCB][n * 128 + lane], x1 = A.in[I_LRCB][n * 128 + 64 + lane], xj = A.in[I_LRCB][ch];
            for (int w = 0; w < 4; ++w) { const int tt = t - 1 + w; if (tt >= 0 && tt < SEQ) {
                x0 += A.in[I_LRCW][w * LRUW + n * 128 + lane] * bf2f(XB[(size_t)tt * LRUW + n * 128 + lane]); x1 += A.in[I_LRCW][w * LRUW + n * 128 + 64 + lane] * bf2f(XB[(size_t)tt * LRUW + n * 128 + 64 + lane]);
                xj += A.in[I_LRCW][w * LRUW + ch] * bf2f(XB[(size_t)tt * LRUW + ch]); } }
            const float rp = wave_sum(dg_bfr(x0) * wa0 + dg_bfr(x1) * wa1), ip = wave_sum(dg_bfr(x0) * wx0 + dg_bfr(x1) * wx1);
            const float rg = 1.0f / (1.0f + expf(-(rp + ba))), ig = 1.0f / (1.0f + expf(-(ip + bx))); const float la = -8.0f * rg * sp;
            hs = expf(la) * hs + sqrtf(fmaxf(-expm1f(2.0f * la), 0.f)) * ig * xj;
            if (t == tc) break; }
        hres[d] = hs;
    }
    const size_t go = ((size_t)b * SEQ + tc) * LRUW + ch;
    const float e1 = fabsf(bf2f(((const bf16_t*)(A.ws + L_HF))[go]) - hres[0]) / (fabsf(hres[0]) + 0.3f);
    const float ref = (hres[0] + hres[1]) * bf2f(((const bf16_t*)(A.ws + L_YB))[go]);
    const float e2 = fabsf(bf2f(((const bf16_t*)(A.ws + L_HY))[go]) - ref) / (fabsf(ref) + 0.3f);
    if (lane == 0) { dg_put(A, k, e1); dg_put(A, k + 5, e2); }
}
__device__ __forceinline__ void dg_final(const Args& A, int nchk) {
    const unsigned* sl = (const unsigned*)(A.ws + WS_CTL) + DG_BASE; int code = 0; float ev = 0.f;
    for (int k = 1; k <= nchk; ++k) { const float e = __uint_as_float(sl[64 * k]); if (e > 0.05f) { code = k; ev = e; break; } }
    if (code == 0) return;
    const int c1 = code % 10, c10 = code / 10;
    const float s = -(float)c1;
    for (size_t i = (size_t)blockIdx.x * NTHR + threadIdx.x; i < (size_t)MTOK * DM; i += (size_t)gridDim.x * NTHR) A.out[i] = A.in[I_X][i] * s;
    __syncthreads();
    if (blockIdx.x == 0 && threadIdx.x == 0) { const int qq = ev < 0.1f ? 1 : ev < 0.2f ? 2 : ev < 0.5f ? 3 : ev < 1.f ? 4 : ev < 2.f ? 5 : ev < 5.f ? 6 : ev < 20.f ? 7 : ev < 1e3f ? 8 : 9;
        A.out[12345] = 100.f * (float)(10 * c10 + qq); }
}
#define DG(x) x
#define DGL(x) if constexpr (L >= DIAG_FROM) { x }
#else
#define DG(x)
#define DGL(x)
#endif

#define GRID_BAR() xcd_barrier(bar)
template <int L>
__device__ __forceinline__ void run_mixer(const Args& args, LAS unsigned char* lds, int bid, int G, const XcdBarrier& bar) {
    unsigned char* ws = args.ws; bf16_t* xo = (bf16_t*)(ws + WS_XB);
    const float* modl = (const float*)(ws + TB_MODS) + (size_t)L * NBATCH * 6144;
    const void* xs = (L == 0) ? (const void*)args.in[I_X] : (const void*)xo; constexpr bool X16 = (L != 0);
    constexpr int kind = L % 3;
    DGL(if (L > 0 && ((L - 1) & 1)) { dg_save(args, 10 * (L - 1) + 9, xo); GRID_BAR(); })
    norm_phase<false>(args, lds, bid, G, xs, X16, xo, true, args.in[I_N1G] + L * DM, modl, 0, (L > 0) && ((L - 1) & 1), modl - NBATCH * 6144, false, nullptr);
    GRID_BAR();
    DGL(if (L > 0 && ((L - 1) & 1)) { dg_combine(args, 10 * (L - 1) + 9, modl - NBATCH * 6144); GRID_BAR(); })
    DGL(dg_norm(args, 10 * L + 1, (L > 0 && ((L - 1) & 1)) ? xo : xs, args.in[I_N1G] + L * DM, L, 0); GRID_BAR();)
    if constexpr (kind == 0) {
        constexpr int al = L / 3;
        {
            pg8::Gemm g{(const bf16_t*)(ws + WS_HM), (const bf16_t*)(ws + W_QKV) + (size_t)al * 3072 * 1024, 1024};
            pg8::TileOrder S; S.init(256, 12, G, bid);
            pg8::EpiQKV E{(bf16_t*)(ws + A_Q), (bf16_t*)(ws + A_K), (bf16_t*)(ws + A_V), args.in[I_ATQN] + al * 64, args.in[I_ATKN] + al * 64,
                          (const float*)(ws + TB_COS), (const float*)(ws + TB_SIN), LOG2E};
            pg8::gemm_phase<pg8::EpiQKV>(lds, g, S, E);
        }
        GRID_BAR();
        vt_phase(args, bid, G);
        GRID_BAR();
        attn_phase(args, lds, bid, G, al);
        GRID_BAR();
        DGL(dg_save(args, 10 * L + 4, xs); GRID_BAR();)
        {
            pg8::Gemm g{(const bf16_t*)(ws + WS_HM), (const bf16_t*)(ws + W_AO) + (size_t)al * 1024 * 1024, 1024};
            pg8::TileOrder S; S.init(256, 4, G, bid);
            pg8::EpiRes<X16> E{xs, xo, modl + 2 * 1024, 1.0f};
            pg8::gemm_phase<pg8::EpiRes<X16>>(lds, g, S, E);
        }
        GRID_BAR();
        DGL(dg_res(args, 10 * L + 4, xo, modl + 2 * 1024, (const bf16_t*)(ws + WS_HM), 1024, args.in[I_ATWOUT] + (size_t)al * 1024 * 1024); GRID_BAR();)
    }
    if constexpr (kind == 1) {
        {
            pg8::Gemm g{(const bf16_t*)(ws + WS_HM), (const bf16_t*)(ws + W_HGI), 1024};
            pg8::TileOrder S; S.init(256, 20, G, bid);
            pg8::EpiAct E{0, ws, (const float*)(ws + TB_LB)};
            pg8::gemm_phase<pg8::EpiAct>(lds, g, S, E);
        }
        GRID_BAR();
        DGL(dg_hgin(args, 10 * L + 2); GRID_BAR();)
        gla_phase(args, lds, bid, G);
        GRID_BAR();
        DGL(dg_gla(args, 10 * L + 3); GRID_BAR();)
        hg_normo_phase(args, bid, G);
        GRID_BAR();
        DGL(dg_normo(args, 10 * L + 0); GRID_BAR();)
        DGL(dg_save(args, 10 * L + 4, xs); GRID_BAR();)
        {
            pg8::Gemm g{(const bf16_t*)(ws + WS_HM), (const bf16_t*)(ws + W_HGO), 1024};
            pg8::TileOrder S; S.init(256, 4, G, bid);
            pg8::EpiRes<X16> E{xs, xo, modl + 2 * 1024, 1.0f};
            pg8::gemm_phase<pg8::EpiRes<X16>>(lds, g, S, E);
        }
        GRID_BAR();
        DGL(dg_res(args, 10 * L + 4, xo, modl + 2 * 1024, (const bf16_t*)(ws + WS_HM), 1024, args.in[I_HGWOUT]); GRID_BAR();)
    }
    if constexpr (kind == 2) {
        {
            pg8::Gemm g{(const bf16_t*)(ws + WS_HM), (const bf16_t*)(ws + W_LRI), 1024};
            pg8::TileOrder S; S.init(256, 10, G, bid);
            pg8::EpiAct E{1, ws, nullptr};
            pg8::gemm_phase<pg8::EpiAct>(lds, g, S, E);
        }
        GRID_BAR();
        DGL(dg_lruin(args, 10 * L + 2); GRID_BAR();)
        lru_phase<0>(args, lds, bid, G);
        GRID_BAR();
        lru_carry_phase(args, bid, G);
        GRID_BAR();
        lru_apply_phase(args, lds, bid, G);
        GRID_BAR();
        DGL(dg_lru(args, 10 * L + 3); GRID_BAR();)
        DGL(dg_save(args, 10 * L + 4, xs); GRID_BAR();)
        {
            pg8::Gemm g{(const bf16_t*)(ws + L_HY), (const bf16_t*)(ws + W_LRO), LRUW};
            pg8::TileOrder S; S.init(256, 4, G, bid);
            pg8::EpiRes<X16> E{xs, xo, modl + 2 * 1024, 1.0f};
            pg8::gemm_phase<pg8::EpiRes<X16>>(lds, g, S, E);
        }
        GRID_BAR();
        DGL(dg_res(args, 10 * L + 4, xo, modl + 2 * 1024, (const bf16_t*)(ws + L_HY), LRUW, args.in[I_LRWOUT]); GRID_BAR();)
    }
}
template <int L>
__device__ __forceinline__ void run_ffn(const Args& args, LAS unsigned char* lds, int bid, int G, const XcdBarrier& bar) {
    unsigned char* ws = args.ws; bf16_t* xo = (bf16_t*)(ws + WS_XB);
    const float* modl = (const float*)(ws + TB_MODS) + (size_t)L * NBATCH * 6144;
    if constexpr ((L & 1) == 0) {
        constexpr int m = L >> 1;
        constexpr bool F8 = (L >= FP8_DENSE_FROM);
        norm_phase<false>(args, lds, bid, G, xo, true, xo, true, args.in[I_N2G] + L * DM, modl, 1, false, modl, false, nullptr, F8);
        GRID_BAR();
        if constexpr (F8) {
            pg8::Gemm g{(const bf16_t*)(ws + WS_HM), (const bf16_t*)(ws + W_FGU) + (size_t)m * 5632 * 1024, 512};
            pg8::TileOrder S; S.init(256, 22, G, bid);
            pg8::EpiSwiGLU8 E{ws + F_HID, DFF, 1.0f / MOE_WSCALE, MOE_HSCALE};
            pg8::gemm_phase<pg8::EpiSwiGLU8, true>(lds, g, S, E);
        } else {
            pg8::Gemm g{(const bf16_t*)(ws + WS_HM), (const bf16_t*)(ws + W_FGU) + (size_t)m * 5632 * 1024, 1024};
            pg8::TileOrder S; S.init(256, 22, G, bid);
            pg8::EpiSwiGLU E{(bf16_t*)(ws + F_HID), DFF};
            pg8::gemm_phase<pg8::EpiSwiGLU>(lds, g, S, E);
        }
        GRID_BAR();
        if constexpr (F8) {
            pg8::Gemm g{(const bf16_t*)(ws + F_HID), (const bf16_t*)(ws + W_FDN) + (size_t)m * 1024 * 2816, DFF / 2};
            pg8::TileOrder S; S.init(256, 4, G, bid);
            pg8::EpiRes<true> E{xo, xo, modl + 5 * 1024, 1.0f / (MOE_WSCALE * MOE_HSCALE)};
            pg8::gemm_phase<pg8::EpiRes<true>, true>(lds, g, S, E);
        } else {
            pg8::Gemm g{(const bf16_t*)(ws + F_HID), (const bf16_t*)(ws + W_FDN) + (size_t)m * 1024 * 2816, DFF};
            pg8::TileOrder S; S.init(256, 4, G, bid);
            pg8::EpiRes<true> E{xo, xo, modl + 5 * 1024, 1.0f};
            pg8::gemm_phase<pg8::EpiRes<true>>(lds, g, S, E);
        }
        GRID_BAR();
    } else {
        constexpr int m = L >> 1;
        norm_phase<true>(args, lds, bid, G, xo, true, xo, true, args.in[I_N2G] + L * DM, modl, 1, false, modl, false, args.in[I_MOER] + (size_t)m * DM * 8);
        GRID_BAR();
        DGL(dg_norm(args, 10 * L + 5, xo, args.in[I_N2G] + L * DM, L, 1); dg_router(args, 10 * L + 5, L); GRID_BAR();)
        place_phase(args, lds, bid, G);
        GRID_BAR();
        DGL(dg_place(args, 10 * L + 6); GRID_BAR();)
        const int* tiles = (const int*)(ws + TB_TILES);
        {
            pg8::Gemm g{(const bf16_t*)(ws + E_XS), (const bf16_t*)(ws + W_MGU + (size_t)m * 8 * 7168 * 1024), 512};
            pg8::TileOrder S; S.init(tiles[8], 28, G, bid);
#pragma unroll
            for (int e = 1; e < NEXP; ++e) S.ts[e] = tiles[e];
            pg8::EpiSwiGLU8 E{ws + E_HID, DFFE, 1.0f / MOE_WSCALE, MOE_HSCALE};
            pg8::gemm_phase<pg8::EpiSwiGLU8, true>(lds, g, S, E);
        }
        GRID_BAR();
        DGL(dg_moe_hid(args, 10 * L + 7, m); GRID_BAR();)
        {
            pg8::Gemm g{(const bf16_t*)(ws + E_HID), (const bf16_t*)(ws + W_MDN + (size_t)m * 8 * 1024 * 3584), DFFE / 2};
            pg8::TileOrder S; S.init(tiles[8], 4, G, bid);
#pragma unroll
            for (int e = 1; e < NEXP; ++e) S.ts[e] = tiles[e];
            pg8::EpiPlain E{(bf16_t*)(ws + E_XS), DM, 1.0f / (MOE_WSCALE * MOE_HSCALE)};
            pg8::gemm_phase<pg8::EpiPlain, true>(lds, g, S, E);
        }
        GRID_BAR();
        DGL(dg_moe_y(args, 10 * L + 8, m); GRID_BAR();)
    }
}
__device__ __forceinline__ void final_combine(const Args& args, LAS unsigned char* lds, int bid, int G, const XcdBarrier& bar) {
    const float* modl = (const float*)(args.ws + TB_MODS) + (size_t)3 * NBATCH * 6144;
    DG(dg_save(args, 39, args.out); GRID_BAR();)
    norm_phase<false>(args, lds, bid, G, args.ws + WS_XB, true, args.out, false, args.in[I_N1G], modl, 0, true, modl, true, nullptr);
    DG(GRID_BAR(); dg_combine(args, 39, modl);)
}

__global__ void __launch_bounds__(NTHR, 2) mega_fwd(Args args) {
    extern __shared__ __attribute__((aligned(16))) unsigned char lds_raw[];
    LAS unsigned char* lds = (LAS unsigned char*)lds_raw;
    const int tid = threadIdx.x, bid = blockIdx.x, G = gridDim.x;
    unsigned char* ws = args.ws;
    volatile LAS unsigned* MISC = (volatile LAS unsigned*)(lds + MISC_OFF);
    if (tid < 64) MISC[tid] = 0u;
    __syncthreads();
    XcdBarrier bar = xcd_barrier_post((unsigned*)(ws + WS_CTL) + CW_BAR, MISC + 8);

    prologue_phase(args, lds, bid, G);
    GRID_BAR();

    run_mixer<0>(args, lds, bid, G, bar);
    run_ffn<0>(args, lds, bid, G, bar);
    run_mixer<1>(args, lds, bid, G, bar);
    run_ffn<1>(args, lds, bid, G, bar);
    run_mixer<2>(args, lds, bid, G, bar);
    run_ffn<2>(args, lds, bid, G, bar);
    run_mixer<3>(args, lds, bid, G, bar);
    run_ffn<3>(args, lds, bid, G, bar);
    final_combine(args, lds, bid, G, bar);
    DG(GRID_BAR(); dg_final(args, 49);)
}

extern "C" void kernel_launch(void* const* d_in, const int* in_sizes, int n_in, void* d_out, int out_size, void* d_ws, size_t ws_size, hipStream_t stream) {
    static int grid = 0;
    if (grid == 0) {
        if (n_in != 30 || out_size != MTOK * DM || ws_size < WS_NEED) { fprintf(stderr, "kernel_launch: unexpected shapes (n_in %d out %d ws %zu need %zu)\n", n_in, out_size, ws_size, (size_t)WS_NEED); grid = -1; return; }
        int dev = 0, cus = 0;
        if (hipGetDevice(&dev) != hipSuccess || hipDeviceGetAttribute(&cus, hipDeviceAttributeMultiprocessorCount, dev) != hipSuccess) { grid = -1; return; }
        if (hipFuncSetAttribute((const void*)mega_fwd, hipFuncAttributeMaxDynamicSharedMemorySize, LDS_BYTES) != hipSuccess) { fprintf(stderr, "kernel_launch: hipFuncSetAttribute failed\n"); grid = -1; return; }
        int per_cu = 0;
        if (hipOccupancyMaxActiveBlocksPerMultiprocessor(&per_cu, (const void*)mega_fwd, NTHR, LDS_BYTES) != hipSuccess || per_cu < 1) { fprintf(stderr, "kernel_launch: occupancy query says %d\n", per_cu); }
        (void)hipGetLastError();
        grid = (cus >= 256) ? 256 : -1;
        if (grid < 0) { fprintf(stderr, "kernel_launch: needs 256 CUs, device has %d\n", cus); return; }
    }
    if (grid < 0) return;
    if (hipMemsetAsync((char*)d_ws + WS_CTL, 0, CTL_ZERO_BYTES, stream) != hipSuccess) return;
    Args a{};
    for (int i = 0; i < 30; ++i) a.in[i] = (const float*)d_in[i];
    a.out = (float*)d_out; a.ws = (unsigned char*)d_ws;
    hipLaunchKernelGGL(mega_fwd, dim3(grid), dim3(NTHR), LDS_BYTES, stream, a);
}
```

```cpp
#define DIAG_FROM 2
#include <hip/hip_runtime.h>
#include <cstdio>
#include <cstdint>

#define LAS __attribute__((address_space(3)))
#define GAS __attribute__((address_space(1)))
typedef unsigned short bf16_t;
typedef short bf16x8 __attribute__((ext_vector_type(8)));
typedef short s16x4 __attribute__((ext_vector_type(4)));
typedef float f32x2 __attribute__((ext_vector_type(2)));
typedef float f32x4 __attribute__((ext_vector_type(4)));
typedef float f32x16 __attribute__((ext_vector_type(16)));
typedef unsigned u32x2 __attribute__((ext_vector_type(2)));
typedef unsigned u32x4 __attribute__((ext_vector_type(4)));

constexpr int MTOK = 65536, DM = 1024, SEQ = 8192, NBATCH = 8, DEPTH = 4;
constexpr int DFF = 2816, DFFE = 3584, NEXP = 8, LRUW = 1280;
constexpr float EPS = 1e-6f;
constexpr int FP8_DENSE_FROM = 2;
constexpr float MOE_WSCALE = 64.0f, MOE_HSCALE = 4.0f;
constexpr float LOG2E = 1.4426950408889634f;

constexpr size_t MiB = 1u << 20;
constexpr size_t WS_CTL = 0, CTL_ZERO_BYTES = 1 * MiB;
constexpr size_t WS_TAB = 1 * MiB;
constexpr size_t TB_MODS = WS_TAB;
constexpr size_t TB_COS = WS_TAB + 1 * MiB;
constexpr size_t TB_SIN = WS_TAB + 2 * MiB;
constexpr size_t TB_SCAL = WS_TAB + 3 * MiB;
constexpr size_t TB_LB = TB_SCAL + 4096;
constexpr size_t TB_SP = TB_SCAL + 16384;
constexpr size_t TB_EID = WS_TAB + 4 * MiB;
constexpr size_t TB_GATE = WS_TAB + 5 * MiB;
constexpr size_t TB_SLOT = WS_TAB + 6 * MiB;
constexpr size_t TB_BCNT = WS_TAB + 7 * MiB;
constexpr size_t TB_TILES = TB_BCNT + 16384;
constexpr size_t TB_LSUM = WS_TAB + 8 * MiB;
constexpr size_t TB_LCIN = WS_TAB + 16 * MiB;
constexpr size_t WS_W = 32 * MiB;
constexpr size_t W_QKV = WS_W;
constexpr size_t W_AO = W_QKV + 2 * (size_t)3072 * 1024 * 2;
constexpr size_t W_HGI = W_AO + 2 * (size_t)1024 * 1024 * 2;
constexpr size_t W_HGO = W_HGI + (size_t)5120 * 1024 * 2;
constexpr size_t W_LRI = W_HGO + (size_t)1024 * 1024 * 2;
constexpr size_t W_LRG = W_LRI + (size_t)2560 * 1024 * 2;
constexpr size_t W_LRO = W_LRG + (size_t)10 * 2 * 256 * 128 * 2;
constexpr size_t W_FGU = W_LRO + (size_t)1024 * 1280 * 2;
constexpr size_t W_FDN = W_FGU + 2 * (size_t)5632 * 1024 * 2;
constexpr size_t W_MGU = W_FDN + 2 * (size_t)1024 * 2816 * 2;
constexpr size_t W_MDN = W_MGU + 16 * (size_t)7168 * 1024 * 2;
constexpr size_t W_END = W_MDN + 16 * (size_t)1024 * 3584 * 2;
constexpr size_t WS_HM = 440 * MiB;
constexpr size_t WS_ACT = 568 * MiB;
static_assert(W_END <= WS_HM, "weights overflow");
constexpr size_t SZ_TOK = (size_t)MTOK * 1024 * 2;
constexpr size_t A_Q = WS_ACT, A_K = A_Q + SZ_TOK, A_V = A_K + SZ_TOK, A_VT = A_V + SZ_TOK;
constexpr size_t F_HID = WS_ACT;
constexpr size_t H_Q = WS_ACT, H_LFF = H_Q + SZ_TOK, H_LFB = H_LFF + SZ_TOK, H_V = H_LFB + SZ_TOK, H_G = H_V + SZ_TOK, H_OF = H_G + SZ_TOK, H_OB = H_OF + SZ_TOK;
constexpr size_t SZ_LRU = (size_t)MTOK * 1280 * 2;
constexpr size_t L_YB = WS_ACT, L_XB = L_YB + SZ_LRU, L_HF = L_XB + SZ_LRU, L_HY = L_HF + SZ_LRU, L_U = L_HY + SZ_LRU;
constexpr int MOE_ROWS = 2 * MTOK + NEXP * 256;
constexpr size_t E_XS = WS_ACT, E_HID = E_XS + (size_t)MOE_ROWS * 1024 * 2, E_END = E_HID + (size_t)MOE_ROWS * DFFE;
constexpr size_t WS_XB = 1536 * MiB;
static_assert(E_END <= WS_XB && H_OB + SZ_TOK <= WS_XB && L_U + 2 * SZ_LRU <= WS_XB && A_VT + SZ_TOK <= WS_XB, "activation regions below the residual stream");
constexpr size_t WS_NEED = WS_XB + SZ_TOK;
static_assert(WS_NEED <= (size_t)1792 * MiB, "workspace");

constexpr int CW_BAR = 4096;

constexpr int RING_BYTES = 135168;
constexpr int MISC_OFF = RING_BYTES;
constexpr int LDS_BYTES = 147456;
constexpr int NWAVES = 8, NTHR = 512;

typedef __bf16 bf16x2v __attribute__((ext_vector_type(2)));
__device__ __forceinline__ unsigned cvt_pk_bf16(float lo, float hi) { const f32x2 v = {lo, hi}; const bf16x2v b = __builtin_convertvector(v, bf16x2v); return __builtin_bit_cast(unsigned, b); }
__device__ __forceinline__ unsigned pk_fp8x4(float a, float b, float c, float d) { unsigned w = 0; w = __builtin_amdgcn_cvt_pk_fp8_f32(a, b, w, false); w = __builtin_amdgcn_cvt_pk_fp8_f32(c, d, w, true); return w; }
__device__ __forceinline__ unsigned f2bf(float f) { unsigned u = __builtin_bit_cast(unsigned, f); return (u + 0x7fffu + ((u >> 16) & 1u)) >> 16; }
__device__ __forceinline__ float bf2f(unsigned short b) { return __builtin_bit_cast(float, ((unsigned)b) << 16); }
__device__ __forceinline__ float bflo(unsigned w) { return __builtin_bit_cast(float, w << 16); }
__device__ __forceinline__ float bfhi(unsigned w) { return __builtin_bit_cast(float, w & 0xffff0000u); }
__device__ __forceinline__ float fexp2(float x) { return __builtin_amdgcn_exp2f(x); }
__device__ __forceinline__ float fexp(float x) { return __builtin_amdgcn_exp2f(x * LOG2E); }
__device__ __forceinline__ float frcp(float x) { return __builtin_amdgcn_rcpf(x); }
__device__ __forceinline__ float fsigmoid(float x) { return frcp(1.0f + fexp(-x)); }
__device__ __forceinline__ float fsilu(float x) { return x * fsigmoid(x); }
__device__ __forceinline__ float wave_sum(float v) {
#pragma unroll
    for (int o = 1; o < 64; o <<= 1) v += __shfl_xor(v, o);
    return v;
}
#define LDS_WAIT() asm volatile("s_waitcnt lgkmcnt(0)" ::: "memory")
#define VM_WAIT() asm volatile("s_waitcnt vmcnt(0)" ::: "memory")

#define XB_TMO      128
#define XB_XCNT(j)  (256  + 64 * (j))
#define XB_XSUB(j)  (1280 + 64 * (j))
#define XB_XGEN(j)  (2304 + 64 * (j))
#define XB_TOP      3328
#define XB_TOPGEN   3392
#define XCD_BAR_WORDS 3456
#define XB_SPIN_CAP (1u << 22)
__device__ __forceinline__ unsigned xb_ld(unsigned* p)              { return __hip_atomic_load(p, __ATOMIC_RELAXED, __HIP_MEMORY_SCOPE_AGENT); }
__device__ __forceinline__ unsigned xb_add(unsigned* p, unsigned v) { return __hip_atomic_fetch_add(p, v, __ATOMIC_RELAXED, __HIP_MEMORY_SCOPE_AGENT); }
__device__ __forceinline__ unsigned xb_xcc_id() { return (unsigned)__builtin_amdgcn_s_getreg((3 << 11) | 20) & 0xFu; }
#define XB_SPIN(cond, bar) do { unsigned _sp = 0; while (cond) { __builtin_amdgcn_s_sleep(1); \
    if ((++_sp & 255u) == 0u) { if (xb_ld(&(bar)[XB_TMO])) break; if (_sp > XB_SPIN_CAP) { atomicAdd(&(bar)[XB_TMO], 1u); break; } } } } while (0)
struct XcdBarrier { unsigned* bar; unsigned x; volatile LAS unsigned* st; };
__device__ __forceinline__ XcdBarrier xcd_barrier_post(unsigned* bar, volatile LAS unsigned* st) {
    XcdBarrier b; b.bar = bar; b.x = xb_xcc_id(); b.st = st;
    if (threadIdx.x == 0) (void)xb_add(&bar[XB_XCNT(b.x)], 1u);
    return b;
}
__device__ __forceinline__ void xcd_barrier_complete(unsigned* bar, unsigned x, unsigned& nloc, unsigned& nx) {
    const unsigned G = gridDim.x * gridDim.y * gridDim.z;
    unsigned sum, cnt, mine, sp = 0u;
    for (;;) {
        sum = 0u; cnt = 0u; mine = 0u;
#pragma unroll
        for (unsigned j = 0; j < 16; ++j) { const unsigned c = xb_ld(&bar[XB_XCNT(j)]); sum += c; cnt += (c > 0u) ? 1u : 0u; mine = (j == x) ? c : mine; }
        if (sum == G) break;
        __builtin_amdgcn_s_sleep(1);
        if ((++sp & 255u) == 0u) { if (xb_ld(&bar[XB_TMO])) break; if (sp > XB_SPIN_CAP) { atomicAdd(&bar[XB_TMO], 1u); break; } }
    }
    nloc = mine > 0u ? mine : 1u; nx = cnt > 0u ? cnt : 1u;
}
__device__ __forceinline__ void xcd_barrier(const XcdBarrier& b) {
    asm volatile("s_waitcnt vmcnt(0)" ::: "memory");
    __syncthreads();
    if (threadIdx.x == 0) {
        unsigned* bar = b.bar;
        __builtin_amdgcn_s_waitcnt(0);
        unsigned nloc = b.st[0], nx = b.st[1];
        if (nloc == 0u) { xcd_barrier_complete(bar, b.x, nloc, nx); b.st[0] = nloc; b.st[1] = nx; }
        const unsigned old = xb_add(&bar[XB_XSUB(b.x)], 1u);
        const unsigned gen = old / nloc;
        if (old + 1u == (gen + 1u) * nloc) {
            __builtin_amdgcn_fence(__ATOMIC_RELEASE, "agent");
            asm volatile("s_waitcnt vmcnt(0)" ::: "memory");
            const unsigned og = xb_add(&bar[XB_TOP], 1u);
            const unsigned tg = og / nx;
            if (og + 1u == (tg + 1u) * nx) xb_add(&bar[XB_TOPGEN], 1u);
            else XB_SPIN(xb_ld(&bar[XB_TOPGEN]) == tg, bar);
            __builtin_amdgcn_fence(__ATOMIC_ACQUIRE, "agent");
            xb_add(&bar[XB_XGEN(b.x)], 1u);
            asm volatile("s_waitcnt vmcnt(0)" ::: "memory");
        } else {
            XB_SPIN(xb_ld(&bar[XB_XGEN(b.x)]) == gen, bar);
            __builtin_amdgcn_fence(__ATOMIC_ACQUIRE, "agent");
            asm volatile("s_waitcnt vmcnt(0)" ::: "memory");
        }
    }
    __syncthreads();
}

namespace pg8 {
constexpr int BM = 256, BK = 64, HALF = 128, HTB = HALF * BK * 2, STAGE_BYTES = 8 * HTB, NXCD = 8, WGM = 8;
__host__ __device__ __forceinline__ int lds_byte(int r, int c) { const int st = (r >> 4) * 2 + (c >> 5), rr = r & 15, cc = c & 31, ob = rr * 64 + cc * 2; return st * 1024 + (ob ^ (((ob >> 9) & 1) << 5)); }
__host__ __device__ __forceinline__ void stage_rc(int b, int& R, int& C) { const int st = b / 1024, sb = b % 1024, swz = sb ^ (((sb >> 9) & 1) << 5); R = (st >> 1) * 16 + swz / 64; C = (st & 1) * 32 + (swz % 64) / 2; }
__host__ __device__ __forceinline__ int perm32(int rho) { const int n = rho >> 4, i = rho & 15; return 8 * (i >> 2) + 4 * n + (i & 3); }

struct Unit { int pm, pn, pb; };
struct Gemm { const bf16_t* A; const bf16_t* Bt; int K; };

struct TileOrder {
    int nM, nN, nwg, G, c; int ts[NEXP];
    __device__ __forceinline__ void init(int nM_, int nN_, int G_, int c_) { nM = nM_; nN = nN_; nwg = nM * nN; G = G_; c = c_;
#pragma unroll
        for (int e = 0; e < NEXP; ++e) ts[e] = (e == 0) ? 0 : 0x7fffffff; }
    __device__ __forceinline__ bool next(int i, Unit& u) const {
        const long L = (long)i * G + c; if (L >= nwg) return false;
        int wgid = (int)L; { const int q = nwg / NXCD, r = nwg % NXCD, xcd = wgid % NXCD, off = wgid / NXCD; wgid = (xcd < r ? xcd * (q + 1) : r * (q + 1) + (xcd - r) * q) + off; }
        const int nig = WGM * nN, gid = wgid / nig, fm = gid * WGM, gsz = (nM - fm) < WGM ? (nM - fm) : WGM;
        u.pm = fm + ((wgid % nig) % gsz); u.pn = (wgid % nig) / gsz;
        int e = 0;
#pragma unroll
        for (int k = 1; k < NEXP; ++k) e += (u.pm >= ts[k]) ? 1 : 0;
        u.pb = e * nN + u.pn; return true;
    }
};

typedef int v8i32 __attribute__((ext_vector_type(8)));
template <class Epi, bool FP8 = false>
__device__ __forceinline__ void gemm_phase(LAS unsigned char* lds, const Gemm g, const TileOrder& S, const Epi& E) {
    int tid_ = threadIdx.x; asm volatile("" : "+v"(tid_));
    const int tid = tid_, wid = __builtin_amdgcn_readfirstlane(tid >> 6), lane = tid & 63, wr = wid >> 2, wc = wid & 3, fr = lane & 15, fq = lane >> 4;
    const int K = g.K, nt = K / BK;
    unsigned voffA[2], voffB[2];
#pragma unroll
    for (int i = 0; i < 2; ++i) { int R, C; stage_rc(tid * 16 + i * 8192, R, C); const int Rb = Epi::PERM ? ((R & ~31) + perm32(R & 31)) : R;
        voffA[i] = (unsigned)(R * K + C) * 2u; voffB[i] = (unsigned)(Rb * K + C) * 2u; }
    const size_t kstep = (size_t)(BK * 2);
    const size_t hstep = (size_t)HALF * K * 2;
    const size_t tstep = 2 * hstep;
    const unsigned ldsw = (unsigned)wid * 1024u;
    const int aoff = lds_byte(wr * 64 + fr, fq * 8), boff = lds_byte(wc * 32 + fr, fq * 8);
#define PG8_SA(b, h) (((b) * 2 + (h)) * HTB)
#define PG8_SB(b, h) ((4 + (b) * 2 + (h)) * HTB)
#define PG8_STAGE(bufoff, gbase, voff) do { _Pragma("unroll") for (int _i = 0; _i < 2; ++_i) \
        __builtin_amdgcn_global_load_lds((const unsigned*)((const char*)(gbase) + (voff)[_i]), (LAS unsigned*)(lds + (bufoff) + ldsw + _i * 8192), 16, 0, 0); } while (0)
#define PG8_LD8(p) __builtin_bit_cast(v8i32, __builtin_shufflevector(*(const LAS u32x4*)(p), *(const LAS u32x4*)((p) + 1024), 0, 1, 2, 3, 4, 5, 6, 7))
#define PG8_LDA(dst, b, h) do { if constexpr (FP8) { _Pragma("unroll") for (int m = 0; m < 4; ++m) dst##8[m] = PG8_LD8(lds + PG8_SA(b, h) + aoff + m * 2048); } \
        else { _Pragma("unroll") for (int m = 0; m < 4; ++m) _Pragma("unroll") for (int k = 0; k < 2; ++k) dst[m][k] = *(const LAS bf16x8*)(lds + PG8_SA(b, h) + aoff + m * 2048 + k * 1024); } } while (0)
#define PG8_LDB(dst, b, h) do { if constexpr (FP8) { _Pragma("unroll") for (int n = 0; n < 2; ++n) dst##8[n] = PG8_LD8(lds + PG8_SB(b, h) + boff + n * 2048); } \
        else { _Pragma("unroll") for (int n = 0; n < 2; ++n) _Pragma("unroll") for (int k = 0; k < 2; ++k) dst[n][k] = *(const LAS bf16x8*)(lds + PG8_SB(b, h) + boff + n * 2048 + k * 1024); } } while (0)
#define PG8_MMA(ai, bj, At, Bt) do { __builtin_amdgcn_s_setprio(1); \
        if constexpr (FP8) { _Pragma("unroll") for (int m = 0; m < 4; ++m) _Pragma("unroll") for (int n = 0; n < 2; ++n) \
            asm volatile("v_mfma_scale_f32_16x16x128_f8f6f4 %0, %1, %2, %0, %3, %3 op_sel_hi:[0,0,0]" : "+v"(acc[ai][bj][m][n]) : "v"(Bt##8[n]), "v"(At##8[m]), "v"(one_scale)); } \
        else { _Pragma("unroll") for (int m = 0; m < 4; ++m) _Pragma("unroll") for (int n = 0; n < 2; ++n) _Pragma("unroll") for (int k = 0; k < 2; ++k) \
            acc[ai][bj][m][n] = __builtin_amdgcn_mfma_f32_16x16x32_bf16(Bt[n][k], At[m][k], acc[ai][bj][m][n], 0, 0, 0); } \
        __builtin_amdgcn_s_setprio(0); } while (0)
#define PG8_WAIT_V(n) asm volatile("s_waitcnt vmcnt(" #n ")" ::: "memory")
#define PG8_WAIT_L(n) asm volatile("s_waitcnt lgkmcnt(" #n ")" ::: "memory")
#define PG8_BAR __builtin_amdgcn_s_barrier()
#define PG8_SCHED __builtin_amdgcn_sched_barrier(0)
    Unit cur, nxt; int ui = 0;
    if (!S.next(0, cur)) return;
    f32x4 acc[2][2][4][2];
#pragma unroll
    for (int a = 0; a < 2; ++a)
#pragma unroll
        for (int b = 0; b < 2; ++b)
#pragma unroll
            for (int m = 0; m < 4; ++m)
#pragma unroll
                for (int n = 0; n < 2; ++n) acc[a][b][m][n] = (f32x4){0.f, 0.f, 0.f, 0.f};
    bf16x8 At[4][2], B0[2][2], B1[2][2]; v8i32 At8[4], B08[2], B18[2];
    int one_scale = 0x7f7f7f7f; asm volatile("" : "+v"(one_scale));
    const char* cA = (const char*)g.A + (size_t)cur.pm * tstep; const char* cB = (const char*)g.Bt + (size_t)cur.pb * tstep;
    PG8_STAGE(PG8_SB(0, 0), cB, voffB); PG8_STAGE(PG8_SA(0, 0), cA, voffA); PG8_STAGE(PG8_SB(0, 1), cB + hstep, voffB); PG8_STAGE(PG8_SA(0, 1), cA + hstep, voffA);
    if (wr == 1) PG8_BAR;
    PG8_WAIT_V(4); PG8_BAR;
    PG8_STAGE(PG8_SB(1, 0), cB + kstep, voffB); PG8_STAGE(PG8_SA(1, 0), cA + kstep, voffA); PG8_STAGE(PG8_SB(1, 1), cB + hstep + kstep, voffB);
    PG8_WAIT_V(6); PG8_BAR;
    for (;;) {
        const bool has_next = S.next(ui + 1, nxt);
        const char* nA = has_next ? (const char*)g.A + (size_t)nxt.pm * tstep : cA; const char* nB = has_next ? (const char*)g.Bt + (size_t)nxt.pb * tstep : cB;
        for (int t = 0; t < nt; t += 2) {
            const bool last = (t == nt - 2);
            const char* a1 = cA + (size_t)(t + 1) * kstep;
            const char* a2 = last ? nA : cA + (size_t)(t + 2) * kstep; const char* b2 = last ? nB : cB + (size_t)(t + 2) * kstep;
            const char* a3 = a2 + kstep; const char* b3 = b2 + kstep;
            PG8_LDB(B0, 0, 0); PG8_SCHED; PG8_LDA(At, 0, 0); PG8_STAGE(PG8_SA(1, 1), a1 + hstep, voffA);
            PG8_WAIT_L(8); PG8_BAR; PG8_WAIT_L(0); PG8_MMA(0, 0, At, B0); PG8_BAR; PG8_SCHED;
            PG8_LDB(B1, 0, 1); PG8_STAGE(PG8_SB(0, 0), b2, voffB);
            PG8_BAR; PG8_WAIT_L(0); PG8_MMA(0, 1, At, B1); PG8_BAR;
            PG8_LDA(At, 0, 1); PG8_STAGE(PG8_SA(0, 0), a2, voffA);
            PG8_BAR; PG8_WAIT_L(0); PG8_MMA(1, 0, At, B0); PG8_BAR; PG8_SCHED;
            PG8_STAGE(PG8_SB(0, 1), b2 + hstep, voffB);
            PG8_WAIT_V(6); PG8_BAR; PG8_MMA(1, 1, At, B1); PG8_BAR;
            PG8_LDB(B0, 1, 0); PG8_SCHED; PG8_LDA(At, 1, 0); PG8_STAGE(PG8_SA(0, 1), a2 + hstep, voffA);
            PG8_WAIT_L(8); PG8_BAR; PG8_WAIT_L(0); PG8_MMA(0, 0, At, B0); PG8_BAR; PG8_SCHED;
            PG8_LDB(B1, 1, 1); PG8_STAGE(PG8_SB(1, 0), b3, voffB);
            PG8_BAR; PG8_WAIT_L(0); PG8_MMA(0, 1, At, B1); PG8_BAR;
            PG8_LDA(At, 1, 1); PG8_STAGE(PG8_SA(1, 0), a3, voffA);
            PG8_BAR; PG8_WAIT_L(0); PG8_MMA(1, 0, At, B0); PG8_BAR; PG8_SCHED;
            PG8_STAGE(PG8_SB(1, 1), b3 + hstep, voffB);
            PG8_WAIT_V(6); PG8_BAR; PG8_MMA(1, 1, At, B1); PG8_BAR;
        }
        if constexpr (FP8) asm volatile("s_nop 15\n\ts_nop 15" ::: "memory");
        E(acc, cur, wr, wc, fr, fq);
        if (!has_next) break;
#pragma unroll
        for (int a = 0; a < 2; ++a)
#pragma unroll
            for (int b = 0; b < 2; ++b)
#pragma unroll
                for (int m = 0; m < 4; ++m)
#pragma unroll
                    for (int n = 0; n < 2; ++n) acc[a][b][m][n] = (f32x4){0.f, 0.f, 0.f, 0.f};
        cur = nxt; cA = nA; cB = nB; ++ui;
    }
    PG8_WAIT_V(0);
    if (wr == 0) PG8_BAR;
    PG8_BAR;
#undef PG8_SA
#undef PG8_SB
#undef PG8_STAGE
#undef PG8_LDA
#undef PG8_LDB
#undef PG8_MMA
#undef PG8_LD8
#undef PG8_WAIT_V
#undef PG8_WAIT_L
#undef PG8_BAR
#undef PG8_SCHED
}

struct EpiQKV {
    static constexpr bool PERM = true;
    bf16_t *Q, *Kk, *V; const float *gq, *gk, *cosT, *sinT; float qscale;
    __device__ __forceinline__ void operator()(const f32x4 (&acc)[2][2][4][2], const Unit& u, int wr, int wc, int fr, int fq) const {
        const int row0 = u.pm * BM + wr * 64 + fr;
        if (u.pn >= 8) {
            const int col0 = (u.pn - 8) * BM + wc * 32 + 8 * fq;
#pragma unroll
            for (int ai = 0; ai < 2; ++ai)
#pragma unroll
                for (int m = 0; m < 4; ++m) { bf16_t* rowp = V + (size_t)(row0 + ai * HALF + m * 16) * DM + col0;
#pragma unroll
                    for (int bj = 0; bj < 2; ++bj) { const f32x4 v0 = acc[ai][bj][m][0], v1 = acc[ai][bj][m][1];
                        u32x4 w; w.x = cvt_pk_bf16(v0[0], v0[1]); w.y = cvt_pk_bf16(v0[2], v0[3]); w.z = cvt_pk_bf16(v1[0], v1[1]); w.w = cvt_pk_bf16(v1[2], v1[3]);
                        *(u32x4*)(rowp + bj * HALF) = w; } }
        } else {
            const int part = u.pn >> 2, sh = 4 * (u.pn & 3) + wc;
            bf16_t* dst = part ? Kk : Q; const float* g = part ? gk : gq; const float sc = part ? 1.0f : qscale;
            f32x4 g0[2], g1[2];
#pragma unroll
            for (int n = 0; n < 2; ++n) { g0[n] = *(const f32x4*)(g + 8 * fq + 4 * n); g1[n] = *(const f32x4*)(g + 32 + 8 * fq + 4 * n); }
#pragma unroll
            for (int ai = 0; ai < 2; ++ai)
#pragma unroll
                for (int m = 0; m < 4; ++m) {
                    const int r = row0 + ai * HALF + m * 16; const int pos = r & (SEQ - 1);
                    f32x4 x1[2], x2[2]; float ss = 0.f;
#pragma unroll
                    for (int n = 0; n < 2; ++n) { x1[n] = acc[ai][0][m][n]; x2[n] = acc[ai][1][m][n];
                        ss += (x1[n][0] * x1[n][0] + x1[n][1] * x1[n][1]) + (x1[n][2] * x1[n][2] + x1[n][3] * x1[n][3]);
                        ss += (x2[n][0] * x2[n][0] + x2[n][1] * x2[n][1]) + (x2[n][2] * x2[n][2] + x2[n][3] * x2[n][3]); }
                    ss += __shfl_xor(ss, 16); ss += __shfl_xor(ss, 32);
                    const float rstd = __builtin_amdgcn_rsqf(ss * (1.0f / 64.0f) + EPS) ;
                    unsigned char* op = (unsigned char*)dst + (size_t)r * DM + sh * 64 + 8 * fq;
                    u32x2 w1, w2;
#pragma unroll
                    for (int n = 0; n < 2; ++n) {
                        const f32x4 cs = *(const f32x4*)(cosT + pos * 32 + 8 * fq + 4 * n), sn = *(const f32x4*)(sinT + pos * 32 + 8 * fq + 4 * n);
                        const f32x4 y1 = x1[n] * rstd * g0[n], y2 = x2[n] * rstd * g1[n];
                        const f32x4 o1 = (y1 * cs - y2 * sn) * sc, o2 = (y2 * cs + y1 * sn) * sc;
                        if (n == 0) { w1.x = pk_fp8x4(o1[0], o1[1], o1[2], o1[3]); w2.x = pk_fp8x4(o2[0], o2[1], o2[2], o2[3]); }
                        else { w1.y = pk_fp8x4(o1[0], o1[1], o1[2], o1[3]); w2.y = pk_fp8x4(o2[0], o2[1], o2[2], o2[3]); }
                    }
                    *(u32x2*)(op) = w1; *(u32x2*)(op + 32) = w2;
                }
        }
    }
};
__device__ __forceinline__ f32x4 ld_x4(const void* p, size_t i, bool is16) {
    if (is16) { const u32x2 w = *(const u32x2*)((const bf16_t*)p + i); return (f32x4){bflo(w.x), bfhi(w.x), bflo(w.y), bfhi(w.y)}; }
    return *(const f32x4*)((const float*)p + i);
}
template <bool IN16>
struct EpiRes {
    static constexpr bool PERM = false;
    const void* xin; bf16_t* xout; const float* gate; float sc;
    __device__ __forceinline__ void operator()(const f32x4 (&acc)[2][2][4][2], const Unit& u, int wr, int wc, int fr, int fq) const {
        const int row0 = u.pm * BM + wr * 64 + fr, col0 = u.pn * BM + wc * 32 + 4 * fq;
        const float* gp = gate + (size_t)(u.pm >> 5) * 6144 + col0;
        f32x4 gv[2][2];
#pragma unroll
        for (int bj = 0; bj < 2; ++bj)
#pragma unroll
            for (int n = 0; n < 2; ++n) gv[bj][n] = *(const f32x4*)(gp + bj * HALF + n * 16) * sc;
#pragma unroll
        for (int ai = 0; ai < 2; ++ai)
#pragma unroll
            for (int m = 0; m < 4; ++m) { const size_t off = (size_t)(row0 + ai * HALF + m * 16) * DM + col0;
                f32x4 xv[2][2];
#pragma unroll
                for (int bj = 0; bj < 2; ++bj)
#pragma unroll
                    for (int n = 0; n < 2; ++n) xv[bj][n] = ld_x4(xin, off + bj * HALF + n * 16, IN16);
#pragma unroll
                for (int bj = 0; bj < 2; ++bj)
#pragma unroll
                    for (int n = 0; n < 2; ++n) { const f32x4 o = xv[bj][n] + gv[bj][n] * acc[ai][bj][m][n];
                        *(u32x2*)(xout + off + bj * HALF + n * 16) = (u32x2){cvt_pk_bf16(o[0], o[1]), cvt_pk_bf16(o[2], o[3])}; }
                if (m == 3) asm volatile("" ::: "memory"); }
    }
};
struct EpiSwiGLU {
    static constexpr bool PERM = true;
    bf16_t* H; int ldh;
    __device__ __forceinline__ void operator()(const f32x4 (&acc)[2][2][4][2], const Unit& u, int wr, int wc, int fr, int fq) const {
        const int row0 = u.pm * BM + wr * 64 + fr, col0 = u.pn * HALF + wc * 32 + 8 * fq;
#pragma unroll
        for (int ai = 0; ai < 2; ++ai)
#pragma unroll
            for (int m = 0; m < 4; ++m) { bf16_t* rowp = H + (size_t)(row0 + ai * HALF + m * 16) * ldh + col0;
                f32x4 v[2];
#pragma unroll
                for (int n = 0; n < 2; ++n) { const f32x4 gt = acc[ai][0][m][n], up = acc[ai][1][m][n];
#pragma unroll
                    for (int j = 0; j < 4; ++j) v[n][j] = fsilu(gt[j]) * up[j]; }
                u32x4 w; w.x = cvt_pk_bf16(v[0][0], v[0][1]); w.y = cvt_pk_bf16(v[0][2], v[0][3]); w.z = cvt_pk_bf16(v[1][0], v[1][1]); w.w = cvt_pk_bf16(v[1][2], v[1][3]);
                *(u32x4*)rowp = w; }
    }
};
struct EpiSwiGLU8 {
    static constexpr bool PERM = true;
    unsigned char* H; int ldh; float ws, hs;
    __device__ __forceinline__ void operator()(const f32x4 (&acc)[2][2][4][2], const Unit& u, int wr, int wc, int fr, int fq) const {
        const int row0 = u.pm * BM + wr * 64 + fr, col0 = u.pn * HALF + wc * 32 + 8 * fq;
#pragma unroll
        for (int ai = 0; ai < 2; ++ai)
#pragma unroll
            for (int m = 0; m < 4; ++m) { unsigned char* rowp = H + (size_t)(row0 + ai * HALF + m * 16) * ldh + col0;
                f32x4 v[2];
#pragma unroll
                for (int n = 0; n < 2; ++n) { const f32x4 gt = acc[ai][0][m][n] * ws, up = acc[ai][1][m][n] * (ws * hs);
#pragma unroll
                    for (int j = 0; j < 4; ++j) v[n][j] = fsilu(gt[j]) * up[j]; }
                *(u32x2*)rowp = (u32x2){pk_fp8x4(v[0][0], v[0][1], v[0][2], v[0][3]), pk_fp8x4(v[1][0], v[1][1], v[1][2], v[1][3])}; }
    }
};
struct EpiPlain {
    static constexpr bool PERM = true;
    bf16_t* O; int ldc; float sc;
    __device__ __forceinline__ void operator()(const f32x4 (&acc)[2][2][4][2], const Unit& u, int wr, int wc, int fr, int fq) const {
        const int row0 = u.pm * BM + wr * 64 + fr, col0 = u.pn * BM + wc * 32 + 8 * fq;
#pragma unroll
        for (int ai = 0; ai < 2; ++ai)
#pragma unroll
            for (int m = 0; m < 4; ++m) { bf16_t* rowp = O + (size_t)(row0 + ai * HALF + m * 16) * ldc + col0;
#pragma unroll
                for (int bj = 0; bj < 2; ++bj) { const f32x4 v0 = acc[ai][bj][m][0] * sc, v1 = acc[ai][bj][m][1] * sc;
                    u32x4 w; w.x = cvt_pk_bf16(v0[0], v0[1]); w.y = cvt_pk_bf16(v0[2], v0[3]); w.z = cvt_pk_bf16(v1[0], v1[1]); w.w = cvt_pk_bf16(v1[2], v1[3]);
                    *(u32x4*)(rowp + bj * HALF) = w; } }
    }
};
struct EpiAct {
    static constexpr bool PERM = true;
    int kind; unsigned char* ws; const float* lb;
    __device__ __forceinline__ void operator()(const f32x4 (&acc)[2][2][4][2], const Unit& u, int wr, int wc, int fr, int fq) const {
        const int row0 = u.pm * BM + wr * 64 + fr;
        int mode, ldc, colt; size_t boff;
        if (kind == 0) { const int grp = u.pn >> 2; colt = (u.pn & 3) * 256; ldc = 1024;
            boff = grp == 0 ? H_Q : grp == 1 ? H_LFF : grp == 2 ? H_LFB : grp == 3 ? H_V : H_G; mode = (grp == 0 || grp == 4) ? 1 : (grp == 3 ? 0 : 3); }
        else { ldc = LRUW; if (u.pn < 5) { boff = L_YB; colt = u.pn * 256; mode = 2; } else { boff = L_XB; colt = (u.pn - 5) * 256; mode = 0; } }
        bf16_t* base = (bf16_t*)(ws + boff);
        const int col0 = colt + wc * 32 + 8 * fq;
        f32x4 lbv[2][2];
        if (mode == 3) { const float* lp = lb + ((u.pn >> 2) - 1) * 1024 + col0;
#pragma unroll
            for (int bj = 0; bj < 2; ++bj)
#pragma unroll
                for (int n = 0; n < 2; ++n) lbv[bj][n] = *(const f32x4*)(lp + bj * HALF + 4 * n); }
#pragma unroll
        for (int ai = 0; ai < 2; ++ai)
#pragma unroll
            for (int m = 0; m < 4; ++m) { bf16_t* rowp = base + (size_t)(row0 + ai * HALF + m * 16) * ldc + col0;
#pragma unroll
                for (int bj = 0; bj < 2; ++bj) { f32x4 v[2]; u32x4 w;
#pragma unroll
                    for (int n = 0; n < 2; ++n) { v[n] = acc[ai][bj][m][n];
                        if (mode == 1) {
#pragma unroll
                            for (int j = 0; j < 4; ++j) v[n][j] = fsilu(v[n][j]); }
                        else if (mode == 2) {
#pragma unroll
                            for (int j = 0; j < 4; ++j) { const float x = v[n][j]; v[n][j] = x * fsigmoid(1.5957691216057308f * (x + 0.044715f * x * x * x)); } }
                        else if (mode == 3) {
#pragma unroll
                            for (int j = 0; j < 4; ++j) { const float l = lbv[bj][n][j]; const float fg = l + (1.0f - l) * fsigmoid(v[n][j]); v[n][j] = __builtin_amdgcn_logf(fg) * 0.6931471805599453f; } }
                    }
                    if (mode == 3) {
#pragma unroll
                        for (int n = 0; n < 2; ++n) { const _Float16 h0 = (_Float16)v[n][0], h1 = (_Float16)v[n][1], h2 = (_Float16)v[n][2], h3 = (_Float16)v[n][3];
                            const unsigned a = (unsigned)__builtin_bit_cast(unsigned short, h0) | ((unsigned)__builtin_bit_cast(unsigned short, h1) << 16);
                            const unsigned b = (unsigned)__builtin_bit_cast(unsigned short, h2) | ((unsigned)__builtin_bit_cast(unsigned short, h3) << 16);
                            if (n == 0) { w.x = a; w.y = b; } else { w.z = a; w.w = b; } }
                    } else { w.x = cvt_pk_bf16(v[0][0], v[0][1]); w.y = cvt_pk_bf16(v[0][2], v[0][3]); w.z = cvt_pk_bf16(v[1][0], v[1][1]); w.w = cvt_pk_bf16(v[1][2], v[1][3]); }
                    *(u32x4*)(rowp + bj * HALF) = w; } }
    }
};
}

struct Args { const float* in[30]; float* out; unsigned char* ws; };
enum { I_X = 0, I_C, I_ADAW, I_ADAB, I_N1G, I_N2G, I_ATWIN, I_ATQN, I_ATKN, I_ATLAM, I_ATSUB, I_ATWOUT, I_HGWIN, I_HGLB, I_HGNG, I_HGWOUT,
       I_LRWIN, I_LRCW, I_LRCB, I_LRWA, I_LRBA, I_LRWX, I_LRBX, I_LRLAM, I_LRWOUT, I_FFGU, I_FFDN, I_MOER, I_MOEGU, I_MOEDN };
enum { SC_LAM0 = 0, SC_LAM1, SC_OML0, SC_OML1, SC_MC0, SC_MC1 };

__device__ __forceinline__ void cvt_item(const float* W, int ldw, int src_col0, bf16_t* WT, int ldt, int dst_row0, int k0, LAS float* scr, int lane) {
#pragma unroll 8
    for (int i = 0; i < 32; ++i) { const int kk = 2 * i + (lane >> 5); scr[kk * 33 + (lane & 31)] = W[(size_t)(k0 + kk) * ldw + src_col0 + (lane & 31)]; }
    LDS_WAIT(); asm volatile("" ::: "memory");
    const int c = lane & 7;
#pragma unroll
    for (int j = 0; j < 4; ++j) { const int n = (lane >> 3) + 8 * j; const LAS float* s = scr + (8 * c) * 33 + n;
        u32x4 o; o.x = cvt_pk_bf16(s[0 * 33], s[1 * 33]); o.y = cvt_pk_bf16(s[2 * 33], s[3 * 33]); o.z = cvt_pk_bf16(s[4 * 33], s[5 * 33]); o.w = cvt_pk_bf16(s[6 * 33], s[7 * 33]);
        *(u32x4*)(WT + (size_t)(dst_row0 + n) * ldt + k0 + 8 * c) = o; }
    LDS_WAIT(); asm volatile("" ::: "memory");
}
__device__ __forceinline__ void cvt_item8(const float* W, int ldw, int src_col0, unsigned char* WT, int ldt, int dst_row0, int k0, float sc, LAS float* scr, int lane) {
#pragma unroll 8
    for (int i = 0; i < 32; ++i) { const int kk = 2 * i + (lane >> 5); scr[kk * 33 + (lane & 31)] = W[(size_t)(k0 + kk) * ldw + src_col0 + (lane & 31)]; }
    LDS_WAIT(); asm volatile("" ::: "memory");
    const int c = lane & 7;
#pragma unroll
    for (int j = 0; j < 4; ++j) { const int n = (lane >> 3) + 8 * j; const LAS float* s = scr + (8 * c) * 33 + n;
        *(u32x2*)(WT + (size_t)(dst_row0 + n) * ldt + k0 + 8 * c) = (u32x2){pk_fp8x4(s[0 * 33] * sc, s[1 * 33] * sc, s[2 * 33] * sc, s[3 * 33] * sc), pk_fp8x4(s[4 * 33] * sc, s[5 * 33] * sc, s[6 * 33] * sc, s[7 * 33] * sc)}; }
    LDS_WAIT(); asm volatile("" ::: "memory");
}
enum { MAP_ID = 0, MAP_QKV = 1, MAP_SWI = 2 };
template <bool F8 = false>
__device__ __forceinline__ void cvt_family(const float* src, size_t sstride, int ninst, int ldw, int K, int ng, int map, int F, bf16_t* dst, size_t dstride,
                                           LAS float* scr, int gw, int NGW, int lane) {
    const int nkb = K / 64, per = nkb * ng, total = ninst * per;
    for (int it = gw; it < total; it += NGW) {
        const int inst = it / per, r = it - inst * per, kb = r / ng, gi = r - kb * ng;
        int sc0;
        if (map == MAP_ID) sc0 = 32 * gi;
        else if (map == MAP_QKV) { const int pn = gi >> 3, bj = (gi >> 2) & 1, wc = gi & 3;
            if (pn < 8) { const int part = pn >> 2, sh = 4 * (pn & 3) + wc; sc0 = part * 1024 + sh * 64 + 32 * bj; } else sc0 = 32 * gi; }
        else { const int pn = gi >> 3, bj = (gi >> 2) & 1, q = gi & 3; sc0 = bj * F + pn * 128 + 32 * q; }
        if constexpr (F8) cvt_item8(src + (size_t)inst * sstride, ldw, sc0, (unsigned char*)dst + (size_t)inst * dstride, K, 32 * gi, 64 * kb, MOE_WSCALE, scr, lane);
        else cvt_item(src + (size_t)inst * sstride, ldw, sc0, dst + (size_t)inst * dstride, K, 32 * gi, 64 * kb, scr, lane);
    }
}

__device__ __forceinline__ void prologue_phase(const Args& A, LAS unsigned char* lds, int bid, int G) {
    const int tid = threadIdx.x, lane = tid & 63, wave = tid >> 6;
    unsigned char* ws = A.ws;
    {
        LAS float* sc = (LAS float*)lds;
        LAS float* red = (LAS float*)(lds + 32768);
        for (int i = tid; i < NBATCH * DM; i += NTHR) { const float cv = A.in[I_C][i]; sc[i] = fsilu(cv); }
        __syncthreads();
        float* mods = (float*)(ws + TB_MODS);
        for (int cb = bid; cb < (DEPTH * 6144) / 128; cb += G) {
            const int col = cb * 128 + (tid & 127), l = col / 6144, e = col - l * 6144, ch = tid >> 7;
            const float* wp = A.in[I_ADAW] + (size_t)l * DM * 6144 + e;
            float a[NBATCH];
#pragma unroll
            for (int b = 0; b < NBATCH; ++b) a[b] = 0.f;
#pragma unroll 4
            for (int d = ch * 256; d < ch * 256 + 256; ++d) { const float w = wp[(size_t)d * 6144];
#pragma unroll
                for (int b = 0; b < NBATCH; ++b) a[b] += sc[b * DM + d] * w; }
#pragma unroll
            for (int b = 0; b < NBATCH; ++b) red[(ch * 128 + (tid & 127)) * 8 + b] = a[b];
            __syncthreads();
            if (tid < 128) { const float bias = A.in[I_ADAB][l * 6144 + e];
#pragma unroll
                for (int b = 0; b < NBATCH; ++b) { const float s = ((red[(0 * 128 + tid) * 8 + b] + red[(1 * 128 + tid) * 8 + b]) + (red[(2 * 128 + tid) * 8 + b] + red[(3 * 128 + tid) * 8 + b])) + bias;
                    mods[((size_t)l * NBATCH + b) * 6144 + e] = s; } }
            __syncthreads();
        }
    }
    {
        float* cosT = (float*)(ws + TB_COS); float* sinT = (float*)(ws + TB_SIN);
        for (int i = bid * NTHR + tid; i < SEQ * 32; i += G * NTHR) {
            const int pos = i >> 5, d = i & 31;
            const float inv = (float)exp(-(double)d * (1.0 / 32.0) * 9.210340371976184);
            const float ang = (float)pos * inv;
            const double rev = (double)ang * 0.15915494309189535; const float fr = (float)(rev - floor(rev));
            cosT[i] = __builtin_amdgcn_cosf(fr); sinT[i] = __builtin_amdgcn_sinf(fr);
        }
        if (bid == 0 && tid < 2) {
            const int a = tid; const float* lm = A.in[I_ATLAM] + a * 256;
            float s1 = 0.f, s2 = 0.f; for (int i = 0; i < 64; ++i) { s1 += lm[i] * lm[64 + i]; s2 += lm[128 + i] * lm[192 + i]; }
            const float linit = 0.8f - 0.6f * expf(-0.3f * (float)(3 * a));
            float mq = 0.f, mk = 0.f; for (int i = 0; i < 64; ++i) { mq = fmaxf(mq, fabsf(A.in[I_ATQN][a * 64 + i])); mk = fmaxf(mk, fabsf(A.in[I_ATKN][a * 64 + i])); }
            float* scal = (float*)(ws + TB_SCAL);
            scal[SC_LAM0 + a] = expf(s1) - expf(s2) + linit; scal[SC_OML0 + a] = 1.0f - linit; scal[SC_MC0 + a] = 8.0f * mq * mk * LOG2E * 1.0001f;
        }
        if (bid == 1) {
            float* lb = (float*)(ws + TB_LB);
            for (int i = tid; i < 2 * 1024; i += NTHR) { const int d = i >> 10, k = i & 1023; const float* p = A.in[I_HGLB] + (size_t)d * DEPTH * 1024 + k;
                float mx = p[0]; for (int l = 1; l < DEPTH; ++l) mx = fmaxf(mx, p[l * 1024]);
                float den = 0.f, num = 0.f; for (int l = 0; l < DEPTH; ++l) { const float e = expf(p[l * 1024] - mx); den += e; if (l == 1) num += e; }
                lb[i] = num / den; }
        }
        if (bid == 2) {
            float* sp = (float*)(ws + TB_SP);
            for (int i = tid; i < 2 * LRUW; i += NTHR) { const float x = -A.in[I_LRLAM][i]; sp[i] = (x > 20.f) ? x : log1pf(expf(x)); }
        }
    }
    {
        LAS float* scr = (LAS float*)(lds + wave * 16384);
        const int vcu = (bid % 8) * (G / 8) + bid / 8;
        const int gw = vcu * NWAVES + wave, NGW = G * NWAVES;
        cvt_family(A.in[I_ATWIN], (size_t)1024 * 3072, 2, 3072, 1024, 96, MAP_QKV, 0, (bf16_t*)(ws + W_QKV), (size_t)3072 * 1024, scr, gw, NGW, lane);
        cvt_family(A.in[I_ATWOUT], (size_t)1024 * 1024, 2, 1024, 1024, 32, MAP_ID, 0, (bf16_t*)(ws + W_AO), (size_t)1024 * 1024, scr, gw, NGW, lane);
        cvt_family(A.in[I_HGWIN], 0, 1, 5120, 1024, 160, MAP_ID, 0, (bf16_t*)(ws + W_HGI), 0, scr, gw, NGW, lane);
        cvt_family(A.in[I_HGWOUT], 0, 1, 1024, 1024, 32, MAP_ID, 0, (bf16_t*)(ws + W_HGO), 0, scr, gw, NGW, lane);
        cvt_family(A.in[I_LRWIN], 0, 1, 2560, 1024, 80, MAP_ID, 0, (bf16_t*)(ws + W_LRI), 0, scr, gw, NGW, lane);
        cvt_family(A.in[I_LRWOUT], 0, 1, 1024, 1280, 32, MAP_ID, 0, (bf16_t*)(ws + W_LRO), 0, scr, gw, NGW, lane);
        for (int it = gw; it < 2 * 20 * 2 * 4; it += NGW) {
            const int part = it / 160, r = it % 160, inst = r >> 3, kb = (r >> 2) & 1, gi = r & 3, d = inst / 10, n = inst % 10;
            const float* src = (part ? A.in[I_LRWX] : A.in[I_LRWA]) + (size_t)inst * 16384;
            cvt_item(src, 128, 32 * gi, (bf16_t*)(ws + W_LRG) + (size_t)(n * 2 + d) * 256 * 128, 128, part * 128 + 32 * gi, 64 * kb, scr, lane);
        }
        static_assert(FP8_DENSE_FROM == 2 || FP8_DENSE_FROM > 3, "dense layer 0 stays bf16; layer 2 optional");
        constexpr int NB16 = (FP8_DENSE_FROM == 2) ? 1 : 2;
        cvt_family(A.in[I_FFGU], (size_t)1024 * 5632, NB16, 5632, 1024, 176, MAP_SWI, DFF, (bf16_t*)(ws + W_FGU), (size_t)5632 * 1024, scr, gw, NGW, lane);
        cvt_family(A.in[I_FFDN], (size_t)2816 * 1024, NB16, 1024, 2816, 32, MAP_ID, 0, (bf16_t*)(ws + W_FDN), (size_t)1024 * 2816, scr, gw, NGW, lane);
        if constexpr (NB16 == 1) {
            cvt_family<true>(A.in[I_FFGU] + (size_t)1024 * 5632, 0, 1, 5632, 1024, 176, MAP_SWI, DFF, (bf16_t*)(ws + W_FGU) + (size_t)5632 * 1024, 0, scr, gw, NGW, lane);
            cvt_family<true>(A.in[I_FFDN] + (size_t)2816 * 1024, 0, 1, 1024, 2816, 32, MAP_ID, 0, (bf16_t*)(ws + W_FDN) + (size_t)1024 * 2816, 0, scr, gw, NGW, lane);
        }
        cvt_family<true>(A.in[I_MOEGU], (size_t)1024 * 7168, 16, 7168, 1024, 224, MAP_SWI, DFFE, (bf16_t*)(ws + W_MGU), (size_t)7168 * 1024, scr, gw, NGW, lane);
        cvt_family<true>(A.in[I_MOEDN], (size_t)3584 * 1024, 16, 1024, 3584, 32, MAP_ID, 0, (bf16_t*)(ws + W_MDN), (size_t)1024 * 3584, scr, gw, NGW, lane);
    }
}

template <bool ROUTER>
__device__ __forceinline__ void norm_phase(const Args& A, LAS unsigned char* lds, int bid, int G, const void* xsrc, bool src16, void* xdst, bool dst16, const float* gain, const float* modl  , int which,
                                           bool combine, const float* modprev  , bool nonorm, const float* router, bool f8out = false) {
    int tid_ = threadIdx.x; asm volatile("" : "+v"(tid_));
    const int tid = tid_, lane = tid & 63, wave = tid >> 6;
    unsigned char* ws = A.ws;
    bf16_t* HM = (bf16_t*)(ws + WS_HM);
    const int* slot = (const int*)(ws + TB_SLOT); const float* gts = (const float*)(ws + TB_GATE);
    const bf16_t* Y = (const bf16_t*)(ws + E_XS);
    LAS int* hist = (LAS int*)lds;
    for (int tb = bid; tb < MTOK / 256; tb += G) {
        const int b = tb >> 5;
        f32x4 ga[4], sh[4], g2[4];
#pragma unroll
        for (int j = 0; j < 4; ++j) { const int c = 256 * j + 4 * lane;
            if (!nonorm) { const f32x4 gv = *(const f32x4*)(gain + c), sv = *(const f32x4*)(modl + (size_t)b * 6144 + (which * 3 + 1) * 1024 + c);
                ga[j] = gv * (sv + 1.0f); sh[j] = *(const f32x4*)(modl + (size_t)b * 6144 + (which * 3) * 1024 + c); }
            if (combine) g2[j] = *(const f32x4*)(modprev + (size_t)b * 6144 + 5 * 1024 + c); }
        f32x4 rw[ROUTER ? 32 : 1];
        if constexpr (ROUTER) {
            if (tid < 8) hist[tid] = 0;
#pragma unroll
            for (int j = 0; j < 4; ++j)
#pragma unroll
                for (int i = 0; i < 4; ++i) { const int c = 256 * j + 4 * lane + i; rw[(j * 4 + i) * 2] = *(const f32x4*)(router + c * 8); rw[(j * 4 + i) * 2 + 1] = *(const f32x4*)(router + c * 8 + 4); }
            __syncthreads();
        }
        for (int i = 0; i < 32; ++i) {
            const int row = tb * 256 + wave * 32 + i;
            f32x4 v[4];
#pragma unroll
            for (int j = 0; j < 4; ++j) v[j] = pg8::ld_x4(xsrc, (size_t)row * DM + 256 * j + 4 * lane, src16);
            if (combine) {
                const int s0 = slot[row * 2], s1 = slot[row * 2 + 1]; const float w0 = gts[row * 2], w1 = gts[row * 2 + 1];
#pragma unroll
                for (int j = 0; j < 4; ++j) { const u32x2 a = *(const u32x2*)(Y + (size_t)s0 * DM + 256 * j + 4 * lane), c2 = *(const u32x2*)(Y + (size_t)s1 * DM + 256 * j + 4 * lane);
                    f32x4 y; y[0] = w0 * bflo(a.x) + w1 * bflo(c2.x); y[1] = w0 * bfhi(a.x) + w1 * bfhi(c2.x); y[2] = w0 * bflo(a.y) + w1 * bflo(c2.y); y[3] = w0 * bfhi(a.y) + w1 * bfhi(c2.y);
                    v[j] = v[j] + g2[j] * y;
                    if (dst16) *(u32x2*)((bf16_t*)xdst + (size_t)row * DM + 256 * j + 4 * lane) = (u32x2){cvt_pk_bf16(v[j][0], v[j][1]), cvt_pk_bf16(v[j][2], v[j][3])};
                    else *(f32x4*)((float*)xdst + (size_t)row * DM + 256 * j + 4 * lane) = v[j]; }
            }
            if (nonorm) continue;
            float ss = 0.f;
#pragma unroll
            for (int j = 0; j < 4; ++j) ss += (v[j][0] * v[j][0] + v[j][1] * v[j][1]) + (v[j][2] * v[j][2] + v[j][3] * v[j][3]);
            ss = wave_sum(ss);
            const float rstd = 1.0f / sqrtf(ss * (1.0f / DM) + EPS);
            f32x4 h[4];
#pragma unroll
            for (int j = 0; j < 4; ++j) { h[j] = v[j] * rstd * ga[j] + sh[j];
                if (f8out) { *(unsigned*)((unsigned char*)HM + (size_t)row * DM + 256 * j + 4 * lane) = pk_fp8x4(h[j][0], h[j][1], h[j][2], h[j][3]); }
                else { u32x2 w; w.x = cvt_pk_bf16(h[j][0], h[j][1]); w.y = cvt_pk_bf16(h[j][2], h[j][3]);
                    *(u32x2*)(HM + (size_t)row * DM + 256 * j + 4 * lane) = w; } }
            if constexpr (ROUTER) {
                float lg[8];
#pragma unroll
                for (int e = 0; e < 8; ++e) lg[e] = 0.f;
#pragma unroll
                for (int j = 0; j < 4; ++j)
#pragma unroll
                    for (int q = 0; q < 4; ++q) { const float hv = h[j][q]; const f32x4 r0 = rw[(j * 4 + q) * 2], r1 = rw[(j * 4 + q) * 2 + 1];
                        lg[0] += hv * r0[0]; lg[1] += hv * r0[1]; lg[2] += hv * r0[2]; lg[3] += hv * r0[3]; lg[4] += hv * r1[0]; lg[5] += hv * r1[1]; lg[6] += hv * r1[2]; lg[7] += hv * r1[3]; }
#pragma unroll
                for (int e = 0; e < 8; ++e) lg[e] = wave_sum(lg[e]);
                int e0 = 0; float v0 = lg[0];
#pragma unroll
                for (int e = 1; e < 8; ++e) if (lg[e] > v0) { v0 = lg[e]; e0 = e; }
                int e1 = -1; float v1 = -3.0e38f;
#pragma unroll
                for (int e = 0; e < 8; ++e) if (e != e0 && lg[e] > v1) { v1 = lg[e]; e1 = e; }
                const float p1 = frcp(1.0f + fexp(v1 - v0));
                if (lane == 0) { int* eid = (int*)(ws + TB_EID); float* gt = (float*)(ws + TB_GATE);
                    eid[row * 2] = e0; eid[row * 2 + 1] = e1; gt[row * 2] = p1; gt[row * 2 + 1] = 1.0f - p1;
                    atomicAdd((int*)&hist[e0], 1); atomicAdd((int*)&hist[e1], 1); }
            }
        }
        if constexpr (ROUTER) {
            __syncthreads();
            if (tid < 8) ((int*)(ws + TB_BCNT))[tb * 8 + tid] = hist[tid];
            __syncthreads();
        }
    }
}

namespace lru {
constexpr int XCF = 0, XCB = 16384, AA = 24576, UU = 40960, LAA = 57344;
__device__ __forceinline__ int sw256(int row, int cb) { return row * 256 + (cb ^ ((row & 15) << 4)); }
__device__ __forceinline__ int crow(int r, int hi) { return (r & 3) + 8 * (r >> 2) + 4 * hi; }
template <int MODE>
__device__ __forceinline__ void lru_item(const Args& A, LAS unsigned char* lds, int b, int n, int seg, int dir) {
    int tid_ = threadIdx.x; asm volatile("" : "+v"(tid_));
    const int tid = tid_, wid = tid >> 6, lane = tid & 63, r = lane & 31, hh = lane >> 5;
    unsigned char* ws = A.ws;
    const bf16_t* XB = (const bf16_t*)(ws + L_XB); const bf16_t* YB = (const bf16_t*)(ws + L_YB); bf16_t* HF = (bf16_t*)(ws + L_HF); bf16_t* HY = (bf16_t*)(ws + L_HY);
    bf16_t* LAg = (bf16_t*)(ws + (dir ? L_HY : L_HF)); bf16_t* Ug = (bf16_t*)(ws + L_U + (size_t)dir * SZ_LRU);
    const int ct = tid >> 4, cg = tid & 15, cc0 = n * 128 + 8 * cg;
    float carry = 0.f, P = 1.f;
    if (MODE != 0 && tid < 128) carry = ((const float*)(ws + TB_LCIN))[(size_t)((b * 32 + seg) * 2 + dir) * LRUW + n * 128 + tid];
    if constexpr (MODE == 0) {
        const bf16_t* Wg = (const bf16_t*)(ws + W_LRG) + (size_t)((n * 2 + dir) * 256 + ((r < 16) ? (16 * wid + r) : (128 + 16 * wid + r - 16))) * 128 + 8 * hh;
        bf16x8 bfrag[8];
#pragma unroll
        for (int ks = 0; ks < 8; ++ks) bfrag[ks] = *(const bf16x8*)(Wg + 16 * ks);
        const int cch = n * 128 + 16 * wid + (r & 15);
        const float nba = -LOG2E * A.in[I_LRBA][dir * LRUW + cch], nbx = -LOG2E * A.in[I_LRBX][dir * LRUW + cch], csp = -8.0f * LOG2E * ((const float*)(ws + TB_SP))[dir * LRUW + cch];
        float cw[4][8], cb[8];
#pragma unroll
        for (int j = 0; j < 8; ++j) { cb[j] = A.in[I_LRCB][cc0 + j];
#pragma unroll
            for (int w = 0; w < 4; ++w) cw[w][j] = A.in[I_LRCW][w * LRUW + cc0 + j]; }
        u32x4 xr[4];
#define LRU_XLOAD(si_) do { const int sub_ = dir ? (7 - (si_)) : (si_); const int tok_ = seg * 256 + sub_ * 32 + ct; \
        _Pragma("unroll") for (int w = 0; w < 4; ++w) { const int tt = tok_ - 1 + w; xr[w] = (tt >= 0 && tt < SEQ) ? *(const u32x4*)(XB + ((size_t)b * SEQ + tt) * LRUW + cc0) : (u32x4){0u, 0u, 0u, 0u}; } } while (0)
        LRU_XLOAD(0);
        for (int si = 0; si < 8; ++si) {
            const int sub = dir ? (7 - si) : si; const int t0 = seg * 256 + sub * 32;
            {
                float xc[8];
#pragma unroll
                for (int j = 0; j < 8; ++j) xc[j] = cb[j];
#pragma unroll
                for (int w = 0; w < 4; ++w) { const u32x4 v = xr[w];
#pragma unroll
                    for (int e = 0; e < 4; ++e) { xc[2 * e] += cw[w][2 * e] * bflo(v[e]); xc[2 * e + 1] += cw[w][2 * e + 1] * bfhi(v[e]); } }
                if (si + 1 < 8) LRU_XLOAD(si + 1);
                *(LAS f32x4*)(lds + XCF + (ct * 128 + 8 * cg) * 4) = (f32x4){xc[0], xc[1], xc[2], xc[3]};
                *(LAS f32x4*)(lds + XCF + (ct * 128 + 8 * cg + 4) * 4) = (f32x4){xc[4], xc[5], xc[6], xc[7]};
                *(LAS u32x4*)(lds + XCB + sw256(ct, 16 * cg)) = (u32x4){cvt_pk_bf16(xc[0], xc[1]), cvt_pk_bf16(xc[2], xc[3]), cvt_pk_bf16(xc[4], xc[5]), cvt_pk_bf16(xc[6], xc[7])};
            }
            __syncthreads();
            {
                f32x16 acc = {};
#pragma unroll
                for (int ks = 0; ks < 8; ++ks) { const bf16x8 fa = *(const LAS bf16x8*)(lds + XCB + sw256(r, (16 * ks + 8 * hh) * 2)); acc = __builtin_amdgcn_mfma_f32_32x32x16_bf16(fa, bfrag[ks], acc, 0, 0, 0); }
#pragma unroll
                for (int q = 0; q < 8; ++q) {
                    const auto sw = __builtin_amdgcn_permlane16_swap(__float_as_uint(acc[q]), __float_as_uint(acc[8 + q]), false, false);
                    const float rp = __uint_as_float(sw[0]), ip = __uint_as_float(sw[1]);
                    const int tq = crow((r < 16) ? q : (8 + q), hh); const int cl = 16 * wid + (r & 15);
                    const float xcv = ((const LAS float*)(lds + XCF))[tq * 128 + cl];
                    const float rg = frcp(1.0f + fexp2(fmaf(rp, -LOG2E, nba))), ig = frcp(1.0f + fexp2(fmaf(ip, -LOG2E, nbx)));
                    const float la = csp * rg, av = fexp2(la), uv = __builtin_amdgcn_sqrtf(fmaxf(fmaf(-av, av, 1.0f), 0.f)) * ig * xcv;
                    ((LAS float*)(lds + AA))[tq * 128 + cl] = av; ((LAS float*)(lds + UU))[tq * 128 + cl] = uv; ((LAS float*)(lds + LAA))[tq * 128 + cl] = la; }
            }
            __syncthreads();
            if (tid < 128) {
                LAS float* ap = (LAS float*)(lds + AA) + tid; LAS float* up = (LAS float*)(lds + UU) + tid; float av[32], uv[32];
#pragma unroll
                for (int i = 0; i < 32; ++i) { av[i] = ap[i * 128]; uv[i] = up[i * 128]; }
                if (dir == 0) {
#pragma unroll
                    for (int i = 0; i < 32; ++i) { carry = av[i] * carry + uv[i]; P *= av[i]; } }
                else {
#pragma unroll
                    for (int i = 31; i >= 0; --i) { carry = av[i] * carry + uv[i]; P *= av[i]; } }
            } else if (tid >= 256) {
                const int t2 = tid - 256, row = t2 >> 3, c16 = (t2 & 7) * 16; const size_t go = ((size_t)b * SEQ + t0 + row) * LRUW + n * 128 + c16;
                const LAS float* lp = (const LAS float*)(lds + LAA) + row * 128 + c16; const LAS float* up = (const LAS float*)(lds + UU) + row * 128 + c16;
                f32x4 l[4], u[4];
#pragma unroll
                for (int j = 0; j < 4; ++j) { l[j] = *(const LAS f32x4*)(lp + 4 * j); u[j] = *(const LAS f32x4*)(up + 4 * j); }
#pragma unroll
                for (int j = 0; j < 2; ++j) {
                    *(u32x4*)(LAg + go + 8 * j) = (u32x4){cvt_pk_bf16(l[2 * j][0], l[2 * j][1]), cvt_pk_bf16(l[2 * j][2], l[2 * j][3]), cvt_pk_bf16(l[2 * j + 1][0], l[2 * j + 1][1]), cvt_pk_bf16(l[2 * j + 1][2], l[2 * j + 1][3])};
                    *(u32x4*)(Ug + go + 8 * j) = (u32x4){cvt_pk_bf16(u[2 * j][0], u[2 * j][1]), cvt_pk_bf16(u[2 * j][2], u[2 * j][3]), cvt_pk_bf16(u[2 * j + 1][0], u[2 * j + 1][1]), cvt_pk_bf16(u[2 * j + 1][2], u[2 * j + 1][3])}; }
            }
            __syncthreads();
        }
#undef LRU_XLOAD
        if (tid < 128) { float* sm = (float*)(ws + TB_LSUM) + (size_t)(((b * 32 + seg) * 2 + dir) * 2) * LRUW + n * 128 + tid; sm[0] = P; sm[LRUW] = carry; }
    } else {
        u32x4 lr, ur;
#define LRU_GLOAD(si_) do { const int sub_ = dir ? (7 - (si_)) : (si_); const size_t go_ = ((size_t)b * SEQ + seg * 256 + sub_ * 32 + ct) * LRUW + cc0; \
        lr = *(const u32x4*)(LAg + go_); ur = *(const u32x4*)(Ug + go_); } while (0)
        LRU_GLOAD(0);
        for (int si = 0; si < 8; ++si) {
            const int sub = dir ? (7 - si) : si; const int t0 = seg * 256 + sub * 32;
            {   const u32x4 l = lr, u = ur;
                if (si + 1 < 8) LRU_GLOAD(si + 1);
                *(LAS f32x4*)(lds + AA + (ct * 128 + 8 * cg) * 4) = (f32x4){fexp2(bflo(l[0])), fexp2(bfhi(l[0])), fexp2(bflo(l[1])), fexp2(bfhi(l[1]))};
                *(LAS f32x4*)(lds + AA + (ct * 128 + 8 * cg + 4) * 4) = (f32x4){fexp2(bflo(l[2])), fexp2(bfhi(l[2])), fexp2(bflo(l[3])), fexp2(bfhi(l[3]))};
                *(LAS f32x4*)(lds + UU + (ct * 128 + 8 * cg) * 4) = (f32x4){bflo(u[0]), bfhi(u[0]), bflo(u[1]), bfhi(u[1])};
                *(LAS f32x4*)(lds + UU + (ct * 128 + 8 * cg + 4) * 4) = (f32x4){bflo(u[2]), bfhi(u[2]), bflo(u[3]), bfhi(u[3])}; }
            __syncthreads();
            if (tid < 128) {
                LAS float* ap = (LAS float*)(lds + AA) + tid; LAS float* up = (LAS float*)(lds + UU) + tid; float av[32], uv[32];
#pragma unroll
                for (int i = 0; i < 32; ++i) { av[i] = ap[i * 128]; uv[i] = up[i * 128]; }
                if (dir == 0) {
#pragma unroll
                    for (int i = 0; i < 32; ++i) { carry = av[i] * carry + uv[i]; uv[i] = carry; } }
                else {
#pragma unroll
                    for (int i = 31; i >= 0; --i) { carry = av[i] * carry + uv[i]; uv[i] = carry; } }
#pragma unroll
                for (int i = 0; i < 32; ++i) up[i * 128] = uv[i];
            }
            __syncthreads();
            {   const int tok = t0 + ct; const size_t go = ((size_t)b * SEQ + tok) * LRUW + cc0;
                const f32x4 h0 = *(const LAS f32x4*)(lds + UU + (ct * 128 + 8 * cg) * 4), h1 = *(const LAS f32x4*)(lds + UU + (ct * 128 + 8 * cg + 4) * 4);
                if (MODE == 1) { *(u32x4*)(HF + go) = (u32x4){cvt_pk_bf16(h0[0], h0[1]), cvt_pk_bf16(h0[2], h0[3]), cvt_pk_bf16(h1[0], h1[1]), cvt_pk_bf16(h1[2], h1[3])}; }
                else { const u32x4 f = *(const u32x4*)(HF + go), y = *(const u32x4*)(YB + go);
                    *(u32x4*)(HY + go) = (u32x4){cvt_pk_bf16((h0[0] + bflo(f[0])) * bflo(y[0]), (h0[1] + bfhi(f[0])) * bfhi(y[0])), cvt_pk_bf16((h0[2] + bflo(f[1])) * bflo(y[1]), (h0[3] + bfhi(f[1])) * bfhi(y[1])),
                                                cvt_pk_bf16((h1[0] + bflo(f[2])) * bflo(y[2]), (h1[1] + bfhi(f[2])) * bfhi(y[2])), cvt_pk_bf16((h1[2] + bflo(f[3])) * bflo(y[3]), (h1[3] + bfhi(f[3])) * bfhi(y[3]))}; }
            }
            __syncthreads();
        }
#undef LRU_GLOAD
    }
}
__device__ __forceinline__ void lru_apply_item(const Args& A, LAS unsigned char* lds, int b, int n, int seg) {
    constexpr int HFL = 57344;
    int tid_ = threadIdx.x; asm volatile("" : "+v"(tid_));
    const int tid = tid_;
    unsigned char* ws = A.ws;
    const bf16_t* YB = (const bf16_t*)(ws + L_YB); bf16_t* HY = (bf16_t*)(ws + L_HY);
    const int ct = tid >> 4, cg = tid & 15, cc0 = n * 128 + 8 * cg;
#pragma unroll 1
    for (int dir = 0; dir < 2; ++dir) {
        const bf16_t* LAg = (const bf16_t*)(ws + (dir ? L_HY : L_HF)); const bf16_t* Ug = (const bf16_t*)(ws + L_U + (size_t)dir * SZ_LRU);
        float carry = 0.f;
        if (tid < 128) carry = ((const float*)(ws + TB_LCIN))[(size_t)((b * 32 + seg) * 2 + dir) * LRUW + n * 128 + tid];
        u32x4 lr, ur, yr = {0u, 0u, 0u, 0u};
#define LRU_GLOAD(si_) do { const int sub_ = dir ? (7 - (si_)) : (si_); const size_t go_ = ((size_t)b * SEQ + seg * 256 + sub_ * 32 + ct) * LRUW + cc0; \
        lr = *(const u32x4*)(LAg + go_); ur = *(const u32x4*)(Ug + go_); if (dir) yr = *(const u32x4*)(YB + go_); } while (0)
        LRU_GLOAD(0);
        for (int si = 0; si < 8; ++si) {
            const int sub = dir ? (7 - si) : si; const int t0 = seg * 256 + sub * 32;
            const u32x4 l = lr, u = ur, y = yr;
            if (si + 1 < 8) LRU_GLOAD(si + 1);
            *(LAS f32x4*)(lds + AA + (ct * 128 + 8 * cg) * 4) = (f32x4){fexp2(bflo(l[0])), fexp2(bfhi(l[0])), fexp2(bflo(l[1])), fexp2(bfhi(l[1]))};
            *(LAS f32x4*)(lds + AA + (ct * 128 + 8 * cg + 4) * 4) = (f32x4){fexp2(bflo(l[2])), fexp2(bfhi(l[2])), fexp2(bflo(l[3])), fexp2(bfhi(l[3]))};
            *(LAS f32x4*)(lds + UU + (ct * 128 + 8 * cg) * 4) = (f32x4){bflo(u[0]), bfhi(u[0]), bflo(u[1]), bfhi(u[1])};
            *(LAS f32x4*)(lds + UU + (ct * 128 + 8 * cg + 4) * 4) = (f32x4){bflo(u[2]), bfhi(u[2]), bflo(u[3]), bfhi(u[3])};
            __syncthreads();
            if (tid < 128) {
                LAS float* ap = (LAS float*)(lds + AA) + tid; LAS float* up = (LAS float*)(lds + UU) + tid; float av[32], uv[32];
#pragma unroll
                for (int i = 0; i < 32; ++i) { av[i] = ap[i * 128]; uv[i] = up[i * 128]; }
                if (dir == 0) {
#pragma unroll
                    for (int i = 0; i < 32; ++i) { carry = av[i] * carry + uv[i]; uv[i] = carry; } }
                else {
#pragma unroll
                    for (int i = 31; i >= 0; --i) { carry = av[i] * carry + uv[i]; uv[i] = carry; } }
#pragma unroll
                for (int i = 0; i < 32; ++i) up[i * 128] = uv[i];
            }
            __syncthreads();
            {   const f32x4 h0 = *(const LAS f32x4*)(lds + UU + (ct * 128 + 8 * cg) * 4), h1 = *(const LAS f32x4*)(lds + UU + (ct * 128 + 8 * cg + 4) * 4);
                LAS u32x4* hf = (LAS u32x4*)(lds + HFL + ((sub * 32 + ct) * 128 + 8 * cg) * 2);
                if (dir == 0) *hf = (u32x4){cvt_pk_bf16(h0[0], h0[1]), cvt_pk_bf16(h0[2], h0[3]), cvt_pk_bf16(h1[0], h1[1]), cvt_pk_bf16(h1[2], h1[3])};
                else { const u32x4 f = *hf; const size_t go = ((size_t)b * SEQ + t0 + ct) * LRUW + cc0;
                    *(u32x4*)(HY + go) = (u32x4){cvt_pk_bf16((h0[0] + bflo(f[0])) * bflo(y[0]), (h0[1] + bfhi(f[0])) * bfhi(y[0])), cvt_pk_bf16((h0[2] + bflo(f[1])) * bflo(y[1]), (h0[3] + bfhi(f[1])) * bfhi(y[1])),
                                                cvt_pk_bf16((h1[0] + bflo(f[2])) * bflo(y[2]), (h1[1] + bfhi(f[2])) * bfhi(y[2])), cvt_pk_bf16((h1[2] + bflo(f[3])) * bflo(y[3]), (h1[3] + bfhi(f[3])) * bfhi(y[3]))}; }
            }
            __syncthreads();
        }
#undef LRU_GLOAD
    }
}
}
__device__ __forceinline__ void lru_apply_phase(const Args& A, LAS unsigned char* lds, int bid, int G) {
    for (int it = bid; it < 2560; it += G) lru::lru_apply_item(A, lds, it / 320, (it >> 5) % 10, it & 31);
}
template <int MODE>
__device__ __forceinline__ void lru_phase(const Args& A, LAS unsigned char* lds, int bid, int G) {
    const int nitems = (MODE == 0) ? 5120 : 2560;
    for (int it = bid; it < nitems; it += G) {
        int b, n, seg, dir;
        if (MODE == 0) { dir = it & 1; const int r = it >> 1; seg = r & 31; n = (r >> 5) % 10; b = r / 320; }
        else { dir = MODE - 1; seg = it & 31; n = (it >> 5) % 10; b = it / 320; }
        lru::lru_item<MODE>(A, lds, b, n, seg, dir);
    }
}
__device__ __forceinline__ void lru_carry_phase(const Args& A, int bid, int G) {
    const float* sm = (const float*)(A.ws + TB_LSUM); float* cin = (float*)(A.ws + TB_LCIN);
    for (int idx = bid * NTHR + threadIdx.x; idx < NBATCH * 2 * LRUW; idx += G * NTHR) {
        const int b = idx / (2 * LRUW), r = idx % (2 * LRUW), dir = r / LRUW, ch = r % LRUW; float carry = 0.f;
        for (int i = 0; i < 32; ++i) { const int sg = dir ? (31 - i) : i; const size_t o = (size_t)((b * 32 + sg) * 2 + dir);
            cin[o * LRUW + ch] = carry; carry = sm[o * 2 * LRUW + ch] * carry + sm[o * 2 * LRUW + LRUW + ch]; }
    }
}

__device__ __forceinline__ void place_phase(const Args& A, LAS unsigned char* lds, int bid, int G) {
    int tid_ = threadIdx.x; asm volatile("" : "+v"(tid_));
    const int tid = tid_, lane = tid & 63, wave = tid >> 6; unsigned char* ws = A.ws;
    const int* bcnt = (const int*)(ws + TB_BCNT); const int* eid = (const int*)(ws + TB_EID); int* slot = (int*)(ws + TB_SLOT);
    const bf16_t* HM = (const bf16_t*)(ws + WS_HM); bf16_t* XS = (bf16_t*)(ws + E_XS);
    LAS int* tot = (LAS int*)lds; LAS int* pre = tot + 8; LAS int* rb = tot + 16; LAS int* wcn = tot + 32; LAS int* sl = tot + 64;
    for (int tb = bid; tb < MTOK / 256; tb += G) {
        { int t_ = 0, p_ = 0;
#pragma unroll
            for (int j = 0; j < 4; ++j) { const int blk = lane + 64 * j; const int v = bcnt[blk * 8 + wave]; t_ += v; p_ += (blk < tb) ? v : 0; }
#pragma unroll
            for (int o = 1; o < 64; o <<= 1) { t_ += __shfl_xor(t_, o); p_ += __shfl_xor(p_, o); }
            if (lane == 0) { tot[wave] = t_; pre[wave] = p_; } }
        __syncthreads();
        if (tid == 0) { int acc = 0; for (int e = 0; e < 8; ++e) { rb[e] = acc * 256; if (tb == 0) ((int*)(ws + TB_TILES))[e] = acc; acc += (tot[e] + 255) >> 8; } if (tb == 0) ((int*)(ws + TB_TILES))[8] = acc; }
        int e0 = -1, e1 = -1; unsigned long long mk0 = 0, mk1 = 0;
        if (tid < 256) { e0 = eid[(tb * 256 + tid) * 2]; e1 = eid[(tb * 256 + tid) * 2 + 1];
#pragma unroll
            for (int e = 0; e < 8; ++e) { const unsigned long long m = __ballot(e0 == e || e1 == e); if (lane == 0) wcn[wave * 8 + e] = __popcll(m); if (e0 == e) mk0 = m; if (e1 == e) mk1 = m; } }
        __syncthreads();
        if (tid < 256) { const unsigned long long lt = (1ull << lane) - 1ull; int b0 = rb[e0] + pre[e0] + __popcll(mk0 & lt), b1 = rb[e1] + pre[e1] + __popcll(mk1 & lt);
            for (int w = 0; w < wave; ++w) { b0 += wcn[w * 8 + e0]; b1 += wcn[w * 8 + e1]; }
            sl[tid * 2] = b0; sl[tid * 2 + 1] = b1; slot[(tb * 256 + tid) * 2] = b0; slot[(tb * 256 + tid) * 2 + 1] = b1; }
        __syncthreads();
        for (int i = 0; i < 32; ++i) { const int t = wave * 32 + i; const int s0 = sl[t * 2], s1 = sl[t * 2 + 1];
            const bf16_t* src = HM + (size_t)(tb * 256 + t) * DM + lane * 16;
            const u32x4 a = *(const u32x4*)src, b = *(const u32x4*)(src + 8);
            const u32x4 q = {pk_fp8x4(bflo(a[0]), bfhi(a[0]), bflo(a[1]), bfhi(a[1])), pk_fp8x4(bflo(a[2]), bfhi(a[2]), bflo(a[3]), bfhi(a[3])),
                             pk_fp8x4(bflo(b[0]), bfhi(b[0]), bflo(b[1]), bfhi(b[1])), pk_fp8x4(bflo(b[2]), bfhi(b[2]), bflo(b[3]), bfhi(b[3]))};
            *(u32x4*)((unsigned char*)XS + (size_t)s0 * DM + lane * 16) = q; *(u32x4*)((unsigned char*)XS + (size_t)s1 * DM + lane * 16) = q; }
        __syncthreads();
    }
}

namespace att {
constexpr int KVBLK = 64;
#define SBAR() __builtin_amdgcn_sched_barrier(0)
typedef int v8i __attribute__((ext_vector_type(8)));
__device__ __forceinline__ int crow(int r, int hi) { return (r & 3) + 8 * (r >> 2) + 4 * hi; }
constexpr int SLOTB = 8192;
__device__ __forceinline__ int k_slot(int s) { return s * SLOTB; }
__device__ __forceinline__ int v_slot(int s) { return 65536 + s * SLOTB; }
__device__ __forceinline__ int kswz(int row) { return ((row & 7) ^ (row >> 4)) & 7; }
__device__ __forceinline__ int vswz(int row) { return (row >> 2) & 3; }
__device__ __forceinline__ void mfma8_acc(f32x16& acc, const v8i& a, const v8i& b, int sc) {
    asm volatile("s_nop 4\n\tv_mfma_scale_f32_32x32x64_f8f6f4 %0, %1, %2, %0, %3, %3 op_sel_hi:[0,0,0]" : "+v"(acc) : "v"(a), "v"(b), "v"(sc) : "memory");
}
__device__ __forceinline__ void mfma8_c(f32x16& d, const v8i& a, const v8i& b, const f32x16& c, int sa, int sb) {
    asm volatile("v_mfma_scale_f32_32x32x64_f8f6f4 %0, %1, %2, %3, %4, %5 op_sel_hi:[0,0,0]" : "=&v"(d) : "v"(a), "v"(b), "v"(c), "v"(sa), "v"(sb) : "memory");
}
#define ATT_LD8(p0_, p1_) __builtin_bit_cast(v8i, __builtin_shufflevector(*(const LAS u32x4*)(p0_), *(const LAS u32x4*)(p1_), 0, 1, 2, 3, 4, 5, 6, 7))
__device__ __forceinline__ void qkt(f32x16& p0, f32x16& p1, const LAS char* Ks, const v8i& qr, int r32, int hi, int jj, const f32x16& cinit, int s1, int s8) {
    const int c0 = jj * 4 + 2 * hi;
    { const int row = r32; const v8i kf = ATT_LD8(Ks + row * 128 + ((c0 ^ kswz(row)) << 4), Ks + row * 128 + (((c0 + 1) ^ kswz(row)) << 4)); mfma8_c(p0, kf, qr, cinit, s1, s8); }
    { const int row = 32 + r32; const v8i kf = ATT_LD8(Ks + row * 128 + ((c0 ^ kswz(row)) << 4), Ks + row * 128 + (((c0 + 1) ^ kswz(row)) << 4)); mfma8_c(p1, kf, qr, cinit, s1, s8); }
}
__device__ __forceinline__ void load_kf(v8i& kf0, v8i& kf1, const LAS char* Ks, int r32, int hi, int jj) {
    const int c0 = jj * 4 + 2 * hi, row1 = 32 + r32;
    kf0 = ATT_LD8(Ks + r32 * 128 + ((c0 ^ kswz(r32)) << 4), Ks + r32 * 128 + (((c0 + 1) ^ kswz(r32)) << 4));
    kf1 = ATT_LD8(Ks + row1 * 128 + ((c0 ^ kswz(row1)) << 4), Ks + row1 * 128 + (((c0 + 1) ^ kswz(row1)) << 4));
}
#define ATT_VFR(Vs, d0) ATT_LD8((Vs) + (32 * (d0) + r32) * 64 + (((2 * hi) ^ vswz(32 * (d0) + r32)) << 4), (Vs) + (32 * (d0) + r32) * 64 + (((2 * hi + 1) ^ vswz(32 * (d0) + r32)) << 4))
__device__ __forceinline__ void pack_p(const float (&pe)[32], v8i& pa);
__device__ __forceinline__ void qkt_pack(f32x16& p0, f32x16& p1, const v8i& kf0, const v8i& kf1, const v8i& qr, const f32x16& cinit, int s1, int s8, const float (&pe)[32], v8i& pa) {
#define ATT_MC8(d, kf, B, O0, O1, O2, O3) \
    asm volatile("v_mfma_scale_f32_32x32x64_f8f6f4 %0, %21, %22, %23, %24, %25 op_sel_hi:[0,0,0]\n\t" \
                 "v_cvt_pk_fp8_f32 %1, %5, %6\n\tv_cvt_pk_fp8_f32 %1, %7, %8 op_sel:[0,0,1]\n\t" \
                 "v_cvt_pk_fp8_f32 %2, %9, %10\n\tv_cvt_pk_fp8_f32 %2, %11, %12 op_sel:[0,0,1]\n\t" \
                 "v_cvt_pk_fp8_f32 %3, %13, %14\n\tv_cvt_pk_fp8_f32 %3, %15, %16 op_sel:[0,0,1]\n\t" \
                 "v_cvt_pk_fp8_f32 %4, %17, %18\n\tv_cvt_pk_fp8_f32 %4, %19, %20 op_sel:[0,0,1]" \
                 : "=&v"(d), "=&v"(O0), "=&v"(O1), "=&v"(O2), "=&v"(O3) \
                 : "v"(pe[B]), "v"(pe[B + 1]), "v"(pe[B + 2]), "v"(pe[B + 3]), "v"(pe[B + 4]), "v"(pe[B + 5]), "v"(pe[B + 6]), "v"(pe[B + 7]), \
                   "v"(pe[B + 8]), "v"(pe[B + 9]), "v"(pe[B + 10]), "v"(pe[B + 11]), "v"(pe[B + 12]), "v"(pe[B + 13]), "v"(pe[B + 14]), "v"(pe[B + 15]), \
                   "v"(kf), "v"(qr), "v"(cinit), "v"(s1), "v"(s8) : "memory")
    int q0, q1, q2, q3, q4, q5, q6, q7;
    ATT_MC8(p0, kf0, 0, q0, q1, q2, q3);
    ATT_MC8(p1, kf1, 16, q4, q5, q6, q7);
#undef ATT_MC8
    pa = (v8i){q0, q1, q2, q3, q4, q5, q6, q7};
}
__device__ __forceinline__ void partialSM(f32x16& p0) {
#pragma unroll
    for (int r = 0; r < 16; ++r) p0[r] = fexp2(p0[r]);
}
__device__ __forceinline__ void finishSM(f32x16& p0, f32x16& p1, v8i& pa) {
#pragma unroll
    for (int r = 0; r < 16; ++r) p1[r] = fexp2(p1[r]);
#pragma unroll
    for (int w = 0; w < 4; ++w) { pa[w] = (int)pk_fp8x4(p0[4 * w], p0[4 * w + 1], p0[4 * w + 2], p0[4 * w + 3]); pa[4 + w] = (int)pk_fp8x4(p1[4 * w], p1[4 * w + 1], p1[4 * w + 2], p1[4 * w + 3]); }
}
#define ATT_MX7(acc, a, b, sc, NOP, O, I, k) \
    asm volatile(NOP "v_mfma_scale_f32_32x32x64_f8f6f4 %0, %15, %16, %0, %17, %17 op_sel_hi:[0,0,0]\n\tv_exp_f32 %1, %8\n\tv_exp_f32 %2, %9\n\tv_exp_f32 %3, %10\n\tv_exp_f32 %4, %11\n\tv_exp_f32 %5, %12\n\tv_exp_f32 %6, %13\n\tv_exp_f32 %7, %14" \
                 : "+v"(acc), "=&v"(O[k]), "=&v"(O[k + 1]), "=&v"(O[k + 2]), "=&v"(O[k + 3]), "=&v"(O[k + 4]), "=&v"(O[k + 5]), "=&v"(O[k + 6]) \
                 : "v"(I(k)), "v"(I(k + 1)), "v"(I(k + 2)), "v"(I(k + 3)), "v"(I(k + 4)), "v"(I(k + 5)), "v"(I(k + 6)), "v"(a), "v"(b), "v"(sc) : "memory")
__device__ __forceinline__ void pv_exp(f32x16* o, f32x16& lacc, const v8i& ones, const v8i& vf0, const v8i& vf1, const v8i& vf2, const v8i& vf3, const v8i& pa, int s1, const f32x16& r0, const f32x16& r1, float (&pe)[32]) {
#define ATT_RI(k) (((k) < 16) ? r0[(k) & 15] : r1[(k) & 15])
    ATT_MX7(o[0], pa, vf0, s1, "s_nop 4\n\t", pe, ATT_RI, 0);
    ATT_MX7(o[1], pa, vf1, s1, "", pe, ATT_RI, 7);
    ATT_MX7(o[2], pa, vf2, s1, "", pe, ATT_RI, 14);
    ATT_MX7(o[3], pa, vf3, s1, "", pe, ATT_RI, 21);
    asm volatile("v_mfma_scale_f32_32x32x64_f8f6f4 %0, %9, %10, %0, %11, %11 op_sel_hi:[0,0,0]\n\tv_exp_f32 %1, %5\n\tv_exp_f32 %2, %6\n\tv_exp_f32 %3, %7\n\tv_exp_f32 %4, %8"
                 : "+v"(lacc), "=&v"(pe[28]), "=&v"(pe[29]), "=&v"(pe[30]), "=&v"(pe[31]) : "v"(r1[12]), "v"(r1[13]), "v"(r1[14]), "v"(r1[15]), "v"(pa), "v"(ones), "v"(s1) : "memory");
#undef ATT_RI
}
__device__ __forceinline__ void pack_p(const float (&pe)[32], v8i& pa) {
#pragma unroll
    for (int w = 0; w < 8; ++w) pa[w] = (int)pk_fp8x4(pe[4 * w], pe[4 * w + 1], pe[4 * w + 2], pe[4 * w + 3]);
}
__device__ __forceinline__ void pv_d0(f32x16* o, f32x16& lacc, const v8i& ones, const LAS char* Vs, const v8i& pa, int r32, int hi, int s1) {
#pragma unroll
    for (int d0 = 0; d0 < 4; ++d0) { const int row = 32 * d0 + r32;
        const v8i vf = ATT_LD8(Vs + row * 64 + (((2 * hi) ^ vswz(row)) << 4), Vs + row * 64 + (((2 * hi + 1) ^ vswz(row)) << 4));
        mfma8_acc(o[d0], pa, vf, s1); }
    mfma8_acc(lacc, pa, ones, s1);
}
__device__ __forceinline__ void pv_last(f32x16* o, f32x16& lacc, const v8i& ones, const v8i& vf0, const v8i& vf1, const v8i& vf2, const v8i& vf3, const v8i& pa, int s1) {
    mfma8_acc(o[0], pa, vf0, s1); mfma8_acc(o[1], pa, vf1, s1); mfma8_acc(o[2], pa, vf2, s1); mfma8_acc(o[3], pa, vf3, s1); mfma8_acc(lacc, pa, ones, s1);
}
}

__device__ __forceinline__ void vt_phase(const Args& A, int bid, int G) {
    const int tid = threadIdx.x; unsigned char* ws = A.ws;
    const bf16_t* V = (const bf16_t*)(ws + A_V); unsigned char* VT = ws + A_VT;
    const int dv = tid & 127, kq = tid >> 7, half = kq >> 1, hi = kq & 1;
    for (int it = bid; it < 64 * 128; it += G) {
        const int bh = it >> 7, tile = it & 127, b = bh >> 3, h = bh & 7;
        const bf16_t* vp = V + ((size_t)b * SEQ + tile * 64 + 32 * half) * DM + h * 128 + dv;
        float f[16];
#pragma unroll
        for (int i = 0; i < 16; ++i) f[i] = bf2f(vp[(size_t)att::crow(i, hi) * DM]);
        *(u32x4*)(VT + (((size_t)bh * 128 + tile) * 128 + dv) * 64 + hi * 32 + half * 16) =
            (u32x4){pk_fp8x4(f[0], f[1], f[2], f[3]), pk_fp8x4(f[4], f[5], f[6], f[7]), pk_fp8x4(f[8], f[9], f[10], f[11]), pk_fp8x4(f[12], f[13], f[14], f[15])};
    }
}

__device__ __forceinline__ void attn_phase(const Args& A, LAS unsigned char* ldsu, int bid, int G, int al) {
    using namespace att;
    LAS char* lds = (LAS char*)ldsu;
    unsigned char* ws = A.ws;
    const unsigned char* Qg = ws + A_Q; const unsigned char* Kg = ws + A_K; const unsigned char* VTg = ws + A_VT;
    bf16_t* Og = (bf16_t*)(ws + WS_HM);
    const float* scal = (const float*)(ws + TB_SCAL);
    const float lamv = scal[SC_LAM0 + al], omli = scal[SC_OML0 + al], Mc = scal[SC_MC0 + al] - 7.5f;
    const float* subg = A.in[I_ATSUB] + al * 128;
    int tid_ = threadIdx.x; asm volatile("" : "+v"(tid_));
    const int tid = tid_, wid = __builtin_amdgcn_readfirstlane(tid >> 6), lane = tid & 63, r32 = lane & 31, hi = lane >> 5, jj = wid >> 2, wq = wid & 3;
    constexpr int NT = SEQ / KVBLK;
    int s1 = 0x7f7f7f7f, s8 = 0x7c7c7c7c; asm volatile("" : "+v"(s1), "+v"(s8));
    v8i ones; { int o1 = 0x38383838; asm volatile("" : "+v"(o1)); ones = (v8i){o1, o1, o1, o1, o1, o1, o1, o1}; }
    f32x16 cinit;
#pragma unroll
    for (int r = 0; r < 16; ++r) cinit[r] = -Mc;
    unsigned koff, voff;
    { const int bb = wid * 1024 + lane * 16;
      { const int row = bb >> 7, c = ((bb & 127) >> 4) ^ kswz(row); koff = (unsigned)(row * 1024 + c * 16); }
      { const int row = bb >> 6, c = ((bb & 63) >> 4) ^ vswz(row); voff = (unsigned)(row * 64 + c * 16); } }
    const unsigned ldsw = (unsigned)wid * 1024u;
    const __amdgpu_buffer_rsrc_t rK = __builtin_amdgcn_make_buffer_rsrc((void*)Kg, (short)0, 0x7fffffff, 0x00020000);
    const __amdgpu_buffer_rsrc_t rV = __builtin_amdgcn_make_buffer_rsrc((void*)VTg, (short)0, 0x7fffffff, 0x00020000);
#define ATT_DMA(slot, kt, vt) do { \
        __builtin_amdgcn_raw_ptr_buffer_load_lds(rK, (LAS void*)(lds + k_slot(slot) + ldsw), 16, (int)koff, (int)(kt), 0, 0); \
        __builtin_amdgcn_raw_ptr_buffer_load_lds(rV, (LAS void*)(lds + v_slot(slot) + ldsw), 16, (int)voff, (int)(vt), 0, 0); } while (0)
#define ATT_TOP() do { asm volatile("s_waitcnt vmcnt(2)" ::: "memory"); __builtin_amdgcn_s_barrier(); asm volatile("" ::: "memory"); } while (0)
    const int xq = bid & 7, cq = bid >> 3;
    int cbh = xq * 8;
    const bool lag = (jj != 0);
#define ATT_KB(bh_) ((unsigned)(((bh_) >> 3) * SEQ) * (unsigned)DM + (unsigned)((bh_) & 7) * 128u)
#define ATT_VB(bh_) ((unsigned)(bh_) * (128u * 8192u))
    ATT_DMA(0, ATT_KB(cbh), ATT_VB(cbh)); ATT_DMA(1, ATT_KB(cbh) + 64u * DM, ATT_VB(cbh) + 8192u);
    int ofKa, ofKb, ofV, ofKax, ofKbx, ofVx;
    { const int c0 = jj * 4 + 2 * hi, lb = (int)(unsigned)(size_t)lds;
      ofKa = r32 * 128 + ((c0 ^ kswz(r32)) << 4); ofKb = (32 + r32) * 128 + ((c0 ^ kswz(32 + r32)) << 4); ofV = 65536 + r32 * 64 + (((2 * hi) ^ vswz(r32)) << 4);
      ofKax = lb + (ofKa ^ 16); ofKbx = lb + (ofKb ^ 16); ofVx = lb + (ofV ^ 16); ofKa += lb; ofKb += lb; ofV += lb; }
    for (int ui = 0; ui < 16; ++ui) {
        const int qb = (ui & 1) * 32 + cq;
        const int nbh = (ui + 1 < 16) ? xq * 8 + ((ui + 1) >> 1) : cbh;
        const unsigned Kh = ATT_KB(cbh), Vh = ATT_VB(cbh), nK = ATT_KB(nbh), nV = ATT_VB(nbh);
        const size_t obase = ((size_t)(cbh >> 3) * SEQ + qb * 128) * DM + (cbh & 7) * 128;
        f32x16 lacc = {}; f32x16 o[4] = {}; v8i qr;
        { const unsigned char* Qw = Qg + obase + (size_t)(wq * 32 + r32) * DM + jj * 64 + hi * 32;
          const u32x4 qa = *(const u32x4*)Qw, qb2 = *(const u32x4*)(Qw + 16);
          qr = __builtin_bit_cast(v8i, __builtin_shufflevector(qa, qb2, 0, 1, 2, 3, 4, 5, 6, 7)); }
        f32x16 pA0, pA1; v8i pa, kf0, kf1, vf0, vf1, vf2, vf3;
        unsigned kptr = Kh + 2u * 64u * DM, vptr = Vh + 2u * 8192u;
#define ATT_ISSUE(SLD, last) do { asm volatile("" : "+s"(kptr), "+s"(vptr)); ATT_DMA(SLD, kptr, vptr); if (last) { kptr = nK; vptr = nV; } else { kptr += 64u * DM; vptr += 8192u; } } while (0)
#define ATT_RD8(b_, bx_, imm_) ATT_LD8((const LAS char*)(unsigned)((b_) + (imm_)), (const LAS char*)(unsigned)((bx_) + (imm_)))
#define ATT_FIX() asm volatile("" : "+v"(ofKa), "+v"(ofKax), "+v"(ofKb), "+v"(ofKbx), "+v"(ofV), "+v"(ofVx))
#define ATT_STEPC(LAST, SL, SLP, SLD) do { \
            ATT_FIX(); \
            ATT_TOP(); \
            kf0 = ATT_RD8(ofKa, ofKax, (SL) * SLOTB); kf1 = ATT_RD8(ofKb, ofKbx, (SL) * SLOTB); vf0 = ATT_RD8(ofV, ofVx, (SLP) * SLOTB); vf1 = ATT_RD8(ofV, ofVx, (SLP) * SLOTB + 2048); \
            ATT_ISSUE(SLD, LAST); \
            ATT_TOP(); \
            qkt_pack(pA0, pA1, kf0, kf1, qr, cinit, s1, s8, pe, pa); \
            vf2 = ATT_RD8(ofV, ofVx, (SLP) * SLOTB + 4096); vf3 = ATT_RD8(ofV, ofVx, (SLP) * SLOTB + 6144); \
            pv_exp(o, lacc, ones, vf0, vf1, vf2, vf3, pa, s1, pA0, pA1, pe); } while (0)
        float pe[32];
        if (lag) ATT_TOP();
        ATT_TOP();
        ATT_FIX(); kf0 = ATT_RD8(ofKa, ofKax, 0); kf1 = ATT_RD8(ofKb, ofKbx, 0); ATT_ISSUE(2, false);
        ATT_TOP();
        { mfma8_c(pA0, kf0, qr, cinit, s1, s8); mfma8_c(pA1, kf1, qr, cinit, s1, s8);
          asm volatile("s_nop 15\n\ts_nop 15" ::: "memory");
#pragma unroll
          for (int r = 0; r < 16; ++r) pe[r] = fexp2(pA0[r]);
#pragma unroll
          for (int r = 0; r < 16; ++r) pe[16 + r] = fexp2(pA1[r]); }
        ATT_STEPC(false, 1, 0, 3); ATT_STEPC(false, 2, 1, 4); ATT_STEPC(false, 3, 2, 5); ATT_STEPC(false, 4, 3, 6); ATT_STEPC(false, 5, 4, 7); ATT_STEPC(false, 6, 5, 0); ATT_STEPC(false, 7, 6, 1);
        for (int kb = 8; kb < NT; kb += 8) {
            ATT_STEPC(false, 0, 7, 2); ATT_STEPC(false, 1, 0, 3); ATT_STEPC(false, 2, 1, 4); ATT_STEPC(false, 3, 2, 5);
            ATT_STEPC(false, 4, 3, 6); ATT_STEPC(kb == NT - 8, 5, 4, 7); ATT_STEPC(false, 6, 5, 0); ATT_STEPC(false, 7, 6, 1);
        }
        ATT_TOP();
        ATT_FIX();
        vf0 = ATT_RD8(ofV, ofVx, 7 * SLOTB); vf1 = ATT_RD8(ofV, ofVx, 7 * SLOTB + 2048);
        ATT_TOP();
        { vf2 = ATT_RD8(ofV, ofVx, 7 * SLOTB + 4096); vf3 = ATT_RD8(ofV, ofVx, 7 * SLOTB + 6144);
          pack_p(pe, pa); SBAR();
          pv_last(o, lacc, ones, vf0, vf1, vf2, vf3, pa, s1);
          asm volatile("s_nop 15\n\ts_nop 15" ::: "memory"); }
        if (!lag) ATT_TOP();
#undef ATT_ISSUE
#undef ATT_STEPC
#undef ATT_RD8
#undef ATT_FIX
        int r32e = r32, hie = hi; asm volatile("" : "+v"(r32e), "+v"(hie));
        float rli[16];
#pragma unroll
        for (int r = 0; r < 16; ++r) rli[r] = frcp(lacc[r]);
        asm volatile("s_waitcnt lgkmcnt(0)" ::: "memory"); __builtin_amdgcn_s_barrier(); asm volatile("" ::: "memory");
        LAS float* Cb = (LAS float*)(lds + ((wq < 2) ? 3 * SLOTB : 65536 + 3 * SLOTB - 64 * 512));
        if (jj == 1) {
#pragma unroll
            for (int r = 0; r < 16; ++r) { const float sc = rli[r] * lamv;
#pragma unroll
                for (int d0 = 0; d0 < 4; ++d0) Cb[(wq * 32 + crow(r, hie)) * 128 + d0 * 32 + r32e] = o[d0][r] * sc; }
        }
        asm volatile("s_waitcnt lgkmcnt(0)" ::: "memory"); __builtin_amdgcn_s_barrier(); asm volatile("" ::: "memory");
        if (jj == 0) {
            float g[4];
#pragma unroll
            for (int d0 = 0; d0 < 4; ++d0) g[d0] = subg[d0 * 32 + r32e] * omli;
            bf16_t* Ob = Og + obase;
#pragma unroll
            for (int r = 0; r < 16; ++r) {
                float ss = 0.f;
#pragma unroll
                for (int d0 = 0; d0 < 4; ++d0) { const float v = o[d0][r] * rli[r] - Cb[(wq * 32 + crow(r, hie)) * 128 + d0 * 32 + r32e]; o[d0][r] = v; ss += v * v; }
                ss += __shfl_xor(ss, 1); ss += __shfl_xor(ss, 2); ss += __shfl_xor(ss, 4); ss += __shfl_xor(ss, 8); ss += __shfl_xor(ss, 16);
                const float rs = 1.0f / sqrtf(ss * (1.0f / 128.0f) + EPS);
                bf16_t* op = Ob + (size_t)(wq * 32 + crow(r, hie)) * DM + r32e;
#pragma unroll
                for (int d0 = 0; d0 < 4; ++d0) op[d0 * 32] = (bf16_t)f2bf(o[d0][r] * rs * g[d0]);
            }
        }
        asm volatile("s_waitcnt lgkmcnt(0)" ::: "memory"); __builtin_amdgcn_s_barrier(); asm volatile("" ::: "memory");
        cbh = nbh;
    }
    asm volatile("s_waitcnt vmcnt(0) lgkmcnt(0)" ::: "memory"); __builtin_amdgcn_s_barrier(); asm volatile("" ::: "memory");
#undef ATT_DMA
#undef ATT_TOP
#undef ATT_KB
#undef ATT_VB
#undef ATT_LD8
}

namespace gla {
constexpr int BC = 0, QI = 32768, QA = 49152, KA = 65536, KST = 81920, VT = 98304, ST = 106496, AT = 122880, EM = 131072, EL = EM + 512, DD = EM + 1024, BMID = EM + 1536, SEG = EM + 2048;
static_assert(SEG + 2048 <= RING_BYTES, "gla lds");
__device__ __forceinline__ int sw256(int row, int cb) { return row * 256 + (cb ^ ((row & 15) << 4)); }
__device__ __forceinline__ int sw128(int row, int cb) { return row * 128 + (cb ^ ((((row & 7) ^ (row >> 4)) & 7) << 4)); }
__device__ __forceinline__ int crow(int r, int hi) { return (r & 3) + 8 * (r >> 2) + 4 * hi; }
__device__ __forceinline__ float h2f(unsigned short b) { return (float)__builtin_bit_cast(_Float16, b); }
__device__ __forceinline__ void gla_item(const bf16_t* __restrict__ Qp, const unsigned short* __restrict__ LFp, const bf16_t* __restrict__ Vp, bf16_t* __restrict__ Op, int dir, LAS unsigned char* lds, float* dbg) {
    int tid_ = threadIdx.x; asm volatile("" : "+v"(tid_));
    const int tid = tid_, wid = tid >> 6, lane = tid & 63, r = lane & 31, hh = lane >> 5;
    const int t1 = tid >> 3, kg = tid & 7, k0 = 16 * kg, v0 = (tid & 7) * 8;
    for (int i = tid; i < 16384 / 16; i += NTHR) *(LAS u32x4*)(lds + ST + i * 16) = (u32x4){0u, 0u, 0u, 0u};
    f32x16 st = {};
    u32x4 rq[2], rl[2], rv;
#define GLA_TOK(ci, i) (dir ? (SEQ - 1 - ((ci) * 64 + (i))) : ((ci) * 64 + (i)))
#define GLA_LOAD(ci) do { const size_t to = (size_t)GLA_TOK(ci, t1) * DM; \
        rq[0] = *(const u32x4*)(Qp + to + k0); rq[1] = *(const u32x4*)(Qp + to + k0 + 8); \
        rl[0] = *(const u32x4*)(LFp + to + k0); rl[1] = *(const u32x4*)(LFp + to + k0 + 8); rv = *(const u32x4*)(Vp + to + v0); } while (0)
    GLA_LOAD(0);
    __syncthreads();
    for (int ci = 0; ci < SEQ / 64; ++ci) {
        float qf[16], lf[16]; u32x4 vreg = rv;
#pragma unroll
        for (int j = 0; j < 2; ++j)
#pragma unroll
            for (int e = 0; e < 4; ++e) { qf[j * 8 + 2 * e] = bflo(rq[j][e]); qf[j * 8 + 2 * e + 1] = bfhi(rq[j][e]);
                lf[j * 8 + 2 * e] = h2f((unsigned short)(rl[j][e] & 0xffffu)); lf[j * 8 + 2 * e + 1] = h2f((unsigned short)(rl[j][e] >> 16)); }
        if (ci + 1 < SEQ / 64) GLA_LOAD(ci + 1);
#pragma unroll
        for (int j = 0; j < 4; ++j) *(LAS f32x4*)(lds + BC + (t1 * 128 + k0 + 4 * j) * 4) = (f32x4){lf[4 * j], lf[4 * j + 1], lf[4 * j + 2], lf[4 * j + 3]};
        __syncthreads();
        { const int kc = tid & 127, sg = tid >> 7; LAS float* bc = (LAS float*)(lds + BC) + kc; float cs[16];
#pragma unroll
            for (int i = 0; i < 16; ++i) cs[i] = bc[(sg * 16 + i) * 128];
#pragma unroll
            for (int i = 1; i < 16; ++i) cs[i] += cs[i - 1];
            ((LAS float*)(lds + SEG))[sg * 128 + kc] = cs[15];
            __syncthreads();
            const LAS float* sgp = (const LAS float*)(lds + SEG) + kc; const float s0 = sgp[0], s1 = sgp[128], s2 = sgp[256], s3 = sgp[384];
            const float off = sg == 0 ? 0.f : sg == 1 ? s0 : sg == 2 ? (s0 + s1) : ((s0 + s1) + s2);
#pragma unroll
            for (int i = 0; i < 16; ++i) bc[(sg * 16 + i) * 128] = cs[i] + off;
            if (sg == 0) { const float bm = s0 + s1, bl = ((s0 + s1) + s2) + s3;
                ((LAS float*)(lds + BMID))[kc] = bm; ((LAS float*)(lds + EM))[kc] = fexp(bm); ((LAS float*)(lds + EL))[kc] = fexp(bl - bm); ((LAS float*)(lds + DD))[kc] = fexp(bl); }
            __syncthreads();
        }
#ifdef DIAG
        if (dbg && ci == 0) { for (int i = tid; i < 8192; i += NTHR) dbg[i] = ((const LAS float*)(lds + BC))[i]; }
#endif
        {
            unsigned wqi[8], wqa[8], wka[8]; float ksv[16];
#pragma unroll
            for (int j = 0; j < 4; ++j) {
                const f32x4 bt = *(const LAS f32x4*)(lds + BC + (t1 * 128 + k0 + 4 * j) * 4), bm = *(const LAS f32x4*)(lds + BMID + (k0 + 4 * j) * 4);
                const f32x4 em = *(const LAS f32x4*)(lds + EM + (k0 + 4 * j) * 4), el = *(const LAS f32x4*)(lds + EL + (k0 + 4 * j) * 4);
                float qi[4], qa[4], ka[4];
#pragma unroll
                for (int e = 0; e < 4; ++e) { const int i = 4 * j + e; const float e1 = fexp(bt[e] - bm[e]), r1 = frcp(e1);
                    qa[e] = qf[i] * e1; qi[e] = qa[e] * em[e]; const float kk = 1.0f - fexp(lf[i]); ka[e] = kk * r1; ksv[i] = ka[e] * el[e]; }
                wqi[2 * j] = cvt_pk_bf16(qi[0], qi[1]); wqi[2 * j + 1] = cvt_pk_bf16(qi[2], qi[3]);
                wqa[2 * j] = cvt_pk_bf16(qa[0], qa[1]); wqa[2 * j + 1] = cvt_pk_bf16(qa[2], qa[3]);
                wka[2 * j] = cvt_pk_bf16(ka[0], ka[1]); wka[2 * j + 1] = cvt_pk_bf16(ka[2], ka[3]);
            }
#pragma unroll
            for (int j = 0; j < 2; ++j) { const int off = sw256(t1, (k0 + 8 * j) * 2);
                *(LAS u32x4*)(lds + QI + off) = (u32x4){wqi[4 * j], wqi[4 * j + 1], wqi[4 * j + 2], wqi[4 * j + 3]};
                *(LAS u32x4*)(lds + QA + off) = (u32x4){wqa[4 * j], wqa[4 * j + 1], wqa[4 * j + 2], wqa[4 * j + 3]};
                *(LAS u32x4*)(lds + KA + off) = (u32x4){wka[4 * j], wka[4 * j + 1], wka[4 * j + 2], wka[4 * j + 3]}; }
#pragma unroll
            for (int i = 0; i < 16; ++i) *(LAS unsigned short*)(lds + KST + sw128(k0 + i, t1 * 2)) = (unsigned short)f2bf(ksv[i]);
#pragma unroll
            for (int e = 0; e < 4; ++e) { *(LAS unsigned short*)(lds + VT + sw128(v0 + 2 * e, t1 * 2)) = (unsigned short)(vreg[e] & 0xffffu);
                *(LAS unsigned short*)(lds + VT + sw128(v0 + 2 * e + 1, t1 * 2)) = (unsigned short)(vreg[e] >> 16); }
        }
        __syncthreads();
        f32x16 oacc = {};
        const int w4 = wid & 3, t_i = w4 >> 1, v_i = w4 & 1;
        if (wid < 4) {
            const int s_i = wid >> 1, tq = wid & 1; f32x16 a = {};
#pragma unroll
            for (int ks = 0; ks < 8; ++ks) { const bf16x8 fa = *(const LAS bf16x8*)(lds + KA + sw256(32 * s_i + r, (16 * ks + 8 * hh) * 2)), fb = *(const LAS bf16x8*)(lds + QA + sw256(32 * tq + r, (16 * ks + 8 * hh) * 2));
                a = __builtin_amdgcn_mfma_f32_32x32x16_bf16(fa, fb, a, 0, 0, 0); }
            const int tg = 32 * tq + r;
#pragma unroll
            for (int g = 0; g < 4; ++g) { float m[4];
#pragma unroll
                for (int e = 0; e < 4; ++e) { const int sgl = 32 * s_i + 8 * g + 4 * hh + e; m[e] = (sgl <= tg) ? a[4 * g + e] : 0.f; }
                *(LAS u32x2*)(lds + AT + sw128(tg, (32 * s_i + 8 * g + 4 * hh) * 2)) = (u32x2){cvt_pk_bf16(m[0], m[1]), cvt_pk_bf16(m[2], m[3])}; }
        } else {
#pragma unroll
            for (int ks = 0; ks < 8; ++ks) { const bf16x8 fa = *(const LAS bf16x8*)(lds + QI + sw256(32 * t_i + r, (16 * ks + 8 * hh) * 2)), fb = *(const LAS bf16x8*)(lds + ST + sw256(32 * v_i + r, (16 * ks + 8 * hh) * 2));
                oacc = __builtin_amdgcn_mfma_f32_32x32x16_bf16(fa, fb, oacc, 0, 0, 0); }
        }
        __syncthreads();
#ifdef DIAG
        if (dbg && ci == 0) { for (int i = tid; i < 2048; i += NTHR) { ((unsigned*)dbg)[8192 + i] = ((const LAS unsigned*)(lds + AT))[i]; ((unsigned*)dbg)[8192 + 2048 + i] = ((const LAS unsigned*)(lds + VT))[i]; } }
#endif
        if (wid >= 4) {
#pragma unroll
            for (int ks = 0; ks < 4; ++ks) { const bf16x8 fa = *(const LAS bf16x8*)(lds + AT + sw128(32 * t_i + r, (16 * ks + 8 * hh) * 2)), fb = *(const LAS bf16x8*)(lds + VT + sw128(32 * v_i + r, (16 * ks + 8 * hh) * 2));
                oacc = __builtin_amdgcn_mfma_f32_32x32x16_bf16(fa, fb, oacc, 0, 0, 0); }
#pragma unroll
            for (int i = 0; i < 16; ++i) { const int t = 32 * t_i + crow(i, hh); Op[(size_t)GLA_TOK(ci, t) * DM + 32 * v_i + r] = (bf16_t)f2bf(oacc[i]); }
        }
        {
            const int kq = wid >> 1, vq = wid & 1;
#pragma unroll
            for (int i = 0; i < 16; ++i) st[i] *= ((const LAS float*)(lds + DD))[32 * kq + crow(i, hh)];
#pragma unroll
            for (int ks = 0; ks < 4; ++ks) { const bf16x8 fa = *(const LAS bf16x8*)(lds + KST + sw128(32 * kq + r, (16 * ks + 8 * hh) * 2)), fb = *(const LAS bf16x8*)(lds + VT + sw128(32 * vq + r, (16 * ks + 8 * hh) * 2));
                st = __builtin_amdgcn_mfma_f32_32x32x16_bf16(fa, fb, st, 0, 0, 0); }
#pragma unroll
            for (int g = 0; g < 4; ++g) *(LAS u32x2*)(lds + ST + sw256(32 * vq + r, (32 * kq + 8 * g + 4 * hh) * 2)) = (u32x2){cvt_pk_bf16(st[4 * g], st[4 * g + 1]), cvt_pk_bf16(st[4 * g + 2], st[4 * g + 3])};
        }
        __syncthreads();
#ifdef DIAG
        if (dbg && ci == 0) { for (int i = tid; i < 4096; i += NTHR) { ((unsigned*)dbg)[12288 + i] = ((const LAS unsigned*)(lds + ST))[i]; ((unsigned*)dbg)[16384 + i] = ((const LAS unsigned*)(lds + KST))[i]; } }
#endif
    }
#undef GLA_TOK
#undef GLA_LOAD
}
}
__device__ __forceinline__ void gla_phase(const Args& A, LAS unsigned char* lds, int bid, int G) {
    unsigned char* ws = A.ws;
    for (int it = bid; it < 256; it += G) {
        const int b = it >> 5, h = (it >> 2) & 7, dir = (it >> 1) & 1, vh = it & 1;
        const size_t base = (size_t)b * SEQ * DM + h * 128;
        gla::gla_item((const bf16_t*)(ws + H_Q) + base, (const unsigned short*)(ws + (dir ? H_LFB : H_LFF)) + base, (const bf16_t*)(ws + H_V) + base + vh * 64,
                      (bf16_t*)(ws + (dir ? H_OB : H_OF)) + base + vh * 64, dir, lds, it == 0 ? (float*)(ws + TB_LSUM) : nullptr);
    }
}
__device__ __forceinline__ void hg_normo_phase(const Args& A, int bid, int G) {
    int tid_ = threadIdx.x; asm volatile("" : "+v"(tid_));
    const int tid = tid_, lane = tid & 63, wave = tid >> 6; unsigned char* ws = A.ws;
    const bf16_t* OF = (const bf16_t*)(ws + H_OF); const bf16_t* OB = (const bf16_t*)(ws + H_OB); const bf16_t* GG = (const bf16_t*)(ws + H_G); bf16_t* HM = (bf16_t*)(ws + WS_HM);
    const int c0 = (lane >> 3) * 128 + (lane & 7) * 16;
    float ng[16];
#pragma unroll
    for (int i = 0; i < 16; ++i) ng[i] = A.in[I_HGNG][(lane & 7) * 16 + i];
    for (int row = (bid * NWAVES + wave); row < MTOK; row += G * NWAVES) {
        const size_t o = (size_t)row * DM + c0;
        const u32x4 a0 = *(const u32x4*)(OF + o), a1 = *(const u32x4*)(OF + o + 8), b0 = *(const u32x4*)(OB + o), b1 = *(const u32x4*)(OB + o + 8), g0 = *(const u32x4*)(GG + o), g1 = *(const u32x4*)(GG + o + 8);
        float v[16], gt[16]; float ss = 0.f;
#pragma unroll
        for (int e = 0; e < 4; ++e) { v[2 * e] = bflo(a0[e]) + bflo(b0[e]); v[2 * e + 1] = bfhi(a0[e]) + bfhi(b0[e]); v[8 + 2 * e] = bflo(a1[e]) + bflo(b1[e]); v[8 + 2 * e + 1] = bfhi(a1[e]) + bfhi(b1[e]);
            gt[2 * e] = bflo(g0[e]); gt[2 * e + 1] = bfhi(g0[e]); gt[8 + 2 * e] = bflo(g1[e]); gt[8 + 2 * e + 1] = bfhi(g1[e]); }
#pragma unroll
        for (int i = 0; i < 16; ++i) ss += v[i] * v[i];
        ss += __shfl_xor(ss, 1); ss += __shfl_xor(ss, 2); ss += __shfl_xor(ss, 4);
        const float rstd = 1.0f / sqrtf(ss * (1.0f / 128.0f) + EPS);
        u32x4 w0, w1;
#pragma unroll
        for (int e = 0; e < 4; ++e) { w0[e] = cvt_pk_bf16(v[2 * e] * rstd * ng[2 * e] * gt[2 * e], v[2 * e + 1] * rstd * ng[2 * e + 1] * gt[2 * e + 1]);
            w1[e] = cvt_pk_bf16(v[8 + 2 * e] * rstd * ng[8 + 2 * e] * gt[8 + 2 * e], v[8 + 2 * e + 1] * rstd * ng[8 + 2 * e + 1] * gt[8 + 2 * e + 1]); }
        *(u32x4*)(HM + o) = w0; *(u32x4*)(HM + o + 8) = w1;
    }
}

#ifdef DIAG
constexpr int DG_BASE = 8192;
__device__ __forceinline__ void dg_put(const Args& A, int k, float e) { if (!(e >= 0.f) || e > 1e9f) e = 1e9f; atomicMax((unsigned*)(A.ws + WS_CTL) + DG_BASE + 64 * k, __float_as_uint(e)); }
__device__ __forceinline__ float dg_rel(float got, float ref) { return fabsf(got - ref) / (fabsf(ref) + 0.1f); }
__device__ __forceinline__ unsigned dg_hash(unsigned a, unsigned b) { unsigned h = a * 2654435761u + b * 40503u + 0x9e3779b9u; h ^= h >> 15; h *= 2246822519u; h ^= h >> 13; h *= 3266489917u; h ^= h >> 16; return h; }
__device__ __forceinline__ float dg_bfr(float x) { return bflo(f2bf(x)); }
__device__ __forceinline__ void dg_mods(const Args& A, int k) {
    const int lane = threadIdx.x & 63, gwv = blockIdx.x * 8 + (threadIdx.x >> 6);
    const unsigned h = dg_hash(gwv, k); const int l = h & 3, b = (h >> 2) & 7, e = (h >> 5) % 6144;
    float a = 0.f; for (int d = lane; d < DM; d += 64) a += fsilu(A.in[I_C][b * DM + d]) * A.in[I_ADAW][((size_t)l * DM + d) * 6144 + e];
    a = wave_sum(a) + A.in[I_ADAB][l * 6144 + e];
    const float got = ((const float*)(A.ws + TB_MODS))[((size_t)l * NBATCH + b) * 6144 + e];
    if (lane == 0) dg_put(A, k, dg_rel(got, a));
}
__device__ __forceinline__ void dg_norm(const Args& A, int k, const float* x, const float* gain, int L, int which) {
    const int lane = threadIdx.x & 63, gwv = blockIdx.x * 8 + (threadIdx.x >> 6);
    const int row = dg_hash(gwv, k) & (MTOK - 1), b = row >> 13;
    const float* modl = (const float*)(A.ws + TB_MODS) + ((size_t)L * NBATCH + b) * 6144;
    float ss = 0.f; for (int c = lane; c < DM; c += 64) { const float v = x[(size_t)row * DM + c]; ss += v * v; }
    ss = wave_sum(ss); const float rstd = 1.0f / sqrtf(ss / DM + EPS); float e = 0.f;
    for (int c = lane; c < DM; c += 64) { const float ref = x[(size_t)row * DM + c] * rstd * gain[c] * (1.0f + modl[(which * 3 + 1) * 1024 + c]) + modl[(which * 3) * 1024 + c];
        e = fmaxf(e, dg_rel(bf2f(((const bf16_t*)(A.ws + WS_HM))[(size_t)row * DM + c]), ref)); }
    dg_put(A, k, e);
}
__device__ __forceinline__ void dg_qkv(const Args& A, int k, int al) {
    const int lane = threadIdx.x & 63, gwv = blockIdx.x * 8 + (threadIdx.x >> 6);
    const unsigned h = dg_hash(gwv, k); const int row = h & (MTOK - 1), t = (h >> 16) % 48, col = t * 64 + lane;
    const bf16_t* hm = (const bf16_t*)(A.ws + WS_HM) + (size_t)row * DM; const float* w = A.in[I_ATWIN] + (size_t)al * 1024 * 3072 + col;
    float a = 0.f; for (int kk = 0; kk < DM; ++kk) a += bf2f(hm[kk]) * dg_bfr(w[(size_t)kk * 3072]);
    float ref, got;
    if (t < 32) {
        const int part = t >> 4, sh = t & 15; const float ss = wave_sum(a * a); const float rstd = 1.0f / sqrtf(ss / 64.0f + EPS);
        const float y = a * rstd * (part ? A.in[I_ATKN] : A.in[I_ATQN])[al * 64 + lane]; const float yp = __shfl_xor(y, 32);
        const int pos = row & (SEQ - 1); const float cs = ((const float*)(A.ws + TB_COS))[pos * 32 + (lane & 31)], sn = ((const float*)(A.ws + TB_SIN))[pos * 32 + (lane & 31)];
        ref = (lane < 32) ? (y * cs - yp * sn) : (y * cs + yp * sn); if (part == 0) ref *= 0.125f * LOG2E;
        got = bf2f(((const bf16_t*)(A.ws + (part ? A_K : A_Q)))[(size_t)row * DM + sh * 64 + lane]);
    } else { ref = a; got = bf2f(((const bf16_t*)(A.ws + A_V))[(size_t)row * DM + (t - 32) * 64 + lane]); }
    dg_put(A, k, dg_rel(got, ref));
}
__device__ __forceinline__ void dg_attn(const Args& A, int k, int al, LAS unsigned char* lds) {
    const int tid = threadIdx.x; const unsigned h = dg_hash(blockIdx.x, k); const int row = h & (MTOK - 1), hd = (h >> 16) & 7, b = row >> 13;
    const bf16_t* Q = (const bf16_t*)(A.ws + A_Q); const bf16_t* K = (const bf16_t*)(A.ws + A_K); const bf16_t* V = (const bf16_t*)(A.ws + A_V);
    const float* scal = (const float*)(A.ws + TB_SCAL); const float lamv = scal[SC_LAM0 + al], omli = scal[SC_OML0 + al], Mc = scal[SC_MC0 + al];
    LAS float* p0 = (LAS float*)lds; LAS float* p1 = p0 + SEQ; LAS float* red = p1 + SEQ;
    float l0 = 0.f, l1 = 0.f;
    for (int key = tid; key < SEQ; key += NTHR) { const bf16_t* kr = K + ((size_t)b * SEQ + key) * DM + hd * 128; const bf16_t* qr = Q + (size_t)row * DM + hd * 128;
        float s0 = 0.f, s1 = 0.f; for (int d = 0; d < 64; ++d) { s0 += bf2f(qr[d]) * bf2f(kr[d]); s1 += bf2f(qr[64 + d]) * bf2f(kr[64 + d]); }
        const float e0 = fexp2(s0 - Mc), e1 = fexp2(s1 - Mc); p0[key] = e0; p1[key] = e1; l0 += e0; l1 += e1; }
    l0 = wave_sum(l0); l1 = wave_sum(l1); if ((tid & 63) == 0) { red[tid >> 6] = l0; red[8 + (tid >> 6)] = l1; }
    __syncthreads();
    l0 = 0.f; l1 = 0.f; for (int w = 0; w < 8; ++w) { l0 += red[w]; l1 += red[8 + w]; }
    __syncthreads();
    const int dv = tid & 127, part = tid >> 7; float o = 0.f;
    for (int key = part * 2048; key < part * 2048 + 2048; ++key) o += (p0[key] / l0 - lamv * p1[key] / l1) * bf2f(V[((size_t)b * SEQ + key) * DM + hd * 128 + dv]);
    red[16 + part * 128 + dv] = o; __syncthreads();
    if (tid < 128) { o = red[16 + tid] + red[16 + 128 + tid] + red[16 + 256 + tid] + red[16 + 384 + tid]; red[600 + tid] = o * o; }
    __syncthreads();
    if (tid < 128) { float ss = 0.f; for (int i = 0; i < 128; ++i) ss += red[600 + i]; const float ref = o / sqrtf(ss / 128.0f + EPS) * A.in[I_ATSUB][al * 128 + tid] * omli;
        dg_put(A, k, dg_rel(bf2f(((const bf16_t*)(A.ws + WS_HM))[(size_t)row * DM + hd * 128 + tid]), ref)); }
    __syncthreads();
}
__device__ __forceinline__ void dg_save(const Args& A, int k, const float* xold) {
    const int lane = threadIdx.x & 63, gwv = blockIdx.x * 8 + (threadIdx.x >> 6);
    const unsigned h = dg_hash(gwv, k); const int row = h & (MTOK - 1), col = (h >> 16) & 1023;
    float* sv = (float*)(A.ws + TB_LSUM) + 7 * 1024 * 1024 / 4;
    if (lane == 0) sv[k * 4096 + gwv] = xold[(size_t)row * DM + col];
}
__device__ __forceinline__ void dg_res(const Args& A, int k, const float* xnew, const float* gate, const bf16_t* Am, int K, const float* W) {
    const int lane = threadIdx.x & 63, gwv = blockIdx.x * 8 + (threadIdx.x >> 6);
    const unsigned h = dg_hash(gwv, k); const int row = h & (MTOK - 1), col = (h >> 16) & 1023, b = row >> 13;
    const float* sv = (const float*)(A.ws + TB_LSUM) + 7 * 1024 * 1024 / 4;
    float a = 0.f; for (int kk = lane; kk < K; kk += 64) a += bf2f(Am[(size_t)row * K + kk]) * dg_bfr(W[(size_t)kk * DM + col]);
    a = wave_sum(a);
    const float ref = sv[k * 4096 + gwv] + gate[(size_t)b * 6144 + col] * a;
    if (lane == 0) dg_put(A, k, dg_rel(xnew[(size_t)row * DM + col], ref));
}
__device__ __forceinline__ void dg_swiglu(const Args& A, int k, const bf16_t* Am, const float* W, int F, const bf16_t* H, int nrows, const int* rowmap) {
    const int lane = threadIdx.x & 63, gwv = blockIdx.x * 8 + (threadIdx.x >> 6);
    const unsigned h = dg_hash(gwv, k); const int row = (h & 0xfffff) % nrows, j = (h >> 20) % F;
    float g = 0.f, u = 0.f; for (int kk = lane; kk < DM; kk += 64) { const float x = bf2f(Am[(size_t)row * DM + kk]); g += x * dg_bfr(W[(size_t)kk * 2 * F + j]); u += x * dg_bfr(W[(size_t)kk * 2 * F + F + j]); }
    g = wave_sum(g); u = wave_sum(u);
    const float ref = g / (1.0f + expf(-g)) * u;
    if (lane == 0) dg_put(A, k, dg_rel(bf2f(H[(size_t)row * F + j]), ref));
}
__device__ __forceinline__ void dg_hgin(const Args& A, int k) {
    const int lane = threadIdx.x & 63, gwv = blockIdx.x * 8 + (threadIdx.x >> 6);
    const unsigned h = dg_hash(gwv, k); const int row = h & (MTOK - 1), col = (h >> 16) % 5120, grp = col >> 10, cc = col & 1023;
    float a = 0.f; for (int kk = lane; kk < DM; kk += 64) a += bf2f(((const bf16_t*)(A.ws + WS_HM))[(size_t)row * DM + kk]) * dg_bfr(A.in[I_HGWIN][(size_t)kk * 5120 + col]);
    a = wave_sum(a);
    float ref, got;
    if (grp == 0 || grp == 4) { ref = a / (1.0f + expf(-a)); got = bf2f(((const bf16_t*)(A.ws + (grp == 0 ? H_Q : H_G)))[(size_t)row * DM + cc]); }
    else if (grp == 3) { ref = a; got = bf2f(((const bf16_t*)(A.ws + H_V))[(size_t)row * DM + cc]); }
    else { const int d = grp - 1; const float* p = A.in[I_HGLB] + (size_t)d * DEPTH * 1024 + cc; float mx = p[0]; for (int l = 1; l < DEPTH; ++l) mx = fmaxf(mx, p[l * 1024]);
        float den = 0.f; for (int l = 0; l < DEPTH; ++l) den += expf(p[l * 1024] - mx); const float lbv = expf(p[1024] - mx) / den;
        ref = logf(lbv + (1.0f - lbv) / (1.0f + expf(-a))); got = gla::h2f(((const unsigned short*)(A.ws + (d ? H_LFB : H_LFF)))[(size_t)row * DM + cc]); }
    if (lane == 0) dg_put(A, k, dg_rel(got, ref));
}
__device__ __forceinline__ void dg_gla(const Args& A, int k) {
    const int lane = threadIdx.x & 63, gwv = blockIdx.x * 8 + (threadIdx.x >> 6);
    const unsigned h = dg_hash(gwv, k); const int sel0 = (gwv & 3) == 0; const int b = sel0 ? 0 : (h & 7), hd = sel0 ? 0 : ((h >> 3) & 7), dir = sel0 ? 0 : ((h >> 6) & 1), vc = sel0 ? ((h >> 7) & 63) : ((h >> 7) & 127);
    const bf16_t* Q = (const bf16_t*)(A.ws + H_Q); const unsigned short* LF = (const unsigned short*)(A.ws + (dir ? H_LFB : H_LFF)); const bf16_t* V = (const bf16_t*)(A.ws + H_V);
    const bf16_t* O = (const bf16_t*)(A.ws + (dir ? H_OB : H_OF));
    float s0 = 0.f, s1 = 0.f, e0 = 0.f, e1 = 0.f, e2 = 0.f, e3 = 0.f;
    for (int i = 0; i < SEQ; ++i) { const int tok = dir ? (SEQ - 1 - i) : i; const size_t o = ((size_t)b * SEQ + tok) * DM + hd * 128;
        const float f0 = expf(gla::h2f(LF[o + lane])), f1 = expf(gla::h2f(LF[o + 64 + lane])), v = bf2f(V[o + vc]);
        s0 = f0 * s0 + (1.0f - f0) * v; s1 = f1 * s1 + (1.0f - f1) * v;
        if (i < 128 || i % 61 == 0) { const float ov = wave_sum(bf2f(Q[o + lane]) * s0 + bf2f(Q[o + 64 + lane]) * s1); const float er = 0.25f * fabsf(bf2f(O[o + vc]) - ov) / (fabsf(ov) + 1.0f);
            if (i == 0) e0 = er; else if (i < 64) e1 = fmaxf(e1, er); else if (i < 128) e2 = fmaxf(e2, er); else e3 = fmaxf(e3, er); } }
    if (lane == 0) { dg_put(A, k, e0); dg_put(A, k + 4, e1); dg_put(A, k + 5, e2); dg_put(A, k + 6, e3); }
    const float* dbg = (const float*)(A.ws + TB_LSUM); const unsigned short* LF0 = (const unsigned short*)(A.ws + H_LFF); const bf16_t* Q0 = (const bf16_t*)(A.ws + H_Q);
    { const unsigned h2 = dg_hash(gwv, k + 100); const int t = h2 & 63, kk = (h2 >> 6) & 127; float c = 0.f; for (int tt = 0; tt <= t; ++tt) c += gla::h2f(LF0[(size_t)tt * DM + kk]);
      if (lane == 0) dg_put(A, k + 1, dg_rel(dbg[t * 128 + kk], c)); }
    { const unsigned h2 = dg_hash(gwv, k + 200); const int t = h2 & 63, sidx = (h2 >> 6) & 63; float a = 0.f;
      if (sidx <= t) { for (int kk = lane; kk < 128; kk += 64) { float c = 0.f; for (int tt = sidx + 1; tt <= t; ++tt) c += gla::h2f(LF0[(size_t)tt * DM + kk]);
              a += bf2f(Q0[(size_t)t * DM + kk]) * (1.0f - expf(gla::h2f(LF0[(size_t)sidx * DM + kk]))) * expf(c); } a = wave_sum(a); }
      const unsigned short got = ((const unsigned short*)(dbg + 8192))[gla::sw128(t, sidx * 2) / 2];
      if (lane == 0) dg_put(A, k + 2, 5.0f * fabsf(bf2f(got) - a) / (fabsf(a) + 0.01f)); }
    { const unsigned h2 = dg_hash(gwv, k + 300); const int sidx = h2 & 63, v = (h2 >> 6) & 63;
      const unsigned short got = ((const unsigned short*)(dbg + 8192 + 2048))[gla::sw128(v, sidx * 2) / 2];
      if (lane == 0) dg_put(A, k + 2, dg_rel(bf2f(got), bf2f(((const bf16_t*)(A.ws + H_V))[(size_t)sidx * DM + v]))); }
    { const unsigned h2 = dg_hash(gwv, k + 500); const int kk = h2 & 127, v = (h2 >> 7) & 63;
      float a = 0.f; { const int sidx = lane; float c = 0.f; for (int tt = sidx + 1; tt < 64; ++tt) c += gla::h2f(LF0[(size_t)tt * DM + kk]);
          const float ksn = (1.0f - expf(gla::h2f(LF0[(size_t)sidx * DM + kk]))) * expf(c);
          const unsigned short gk = ((const unsigned short*)(dbg + 16384))[gla::sw128(kk, sidx * 2) / 2];
          dg_put(A, k + 2, 0.5f * fabsf(bf2f(gk) - ksn) / (fabsf(ksn) + 0.01f));
          a = ksn * bf2f(((const bf16_t*)(A.ws + H_V))[(size_t)sidx * DM + v]); }
      a = wave_sum(a);
      const unsigned short gs = ((const unsigned short*)(dbg + 12288))[gla::sw256(v, kk * 2) / 2];
      if (lane == 0) dg_put(A, k + 3, 0.5f * fabsf(bf2f(gs) - a) / (fabsf(a) + 0.05f)); }
    { const unsigned h2 = dg_hash(gwv, k + 400); const int t = h2 & 63, v = (h2 >> 6) & 63;
      const unsigned short* at = (const unsigned short*)(dbg + 8192); const unsigned short* vt = (const unsigned short*)(dbg + 8192 + 2048);
      float a = bf2f(at[gla::sw128(t, lane * 2) / 2]) * bf2f(vt[gla::sw128(v, lane * 2) / 2]); a = wave_sum(a);
      if (lane == 0) dg_put(A, k + 1, 5.0f * dg_rel(bf2f(((const bf16_t*)(A.ws + H_OF))[(size_t)t * DM + v]), a)); }
}
__device__ __forceinline__ void dg_normo(const Args& A, int k) {
    const int lane = threadIdx.x & 63, gwv = blockIdx.x * 8 + (threadIdx.x >> 6);
    const unsigned h = dg_hash(gwv, k); const int row = h & (MTOK - 1), hd = (h >> 16) & 7; const size_t o = (size_t)row * DM + hd * 128;
    const float v0 = bf2f(((const bf16_t*)(A.ws + H_OF))[o + lane]) + bf2f(((const bf16_t*)(A.ws + H_OB))[o + lane]), v1 = bf2f(((const bf16_t*)(A.ws + H_OF))[o + 64 + lane]) + bf2f(((const bf16_t*)(A.ws + H_OB))[o + 64 + lane]);
    const float ss = wave_sum(v0 * v0 + v1 * v1), rstd = 1.0f / sqrtf(ss / 128.0f + EPS);
    const float r0 = v0 * rstd * A.in[I_HGNG][lane] * bf2f(((const bf16_t*)(A.ws + H_G))[o + lane]), r1 = v1 * rstd * A.in[I_HGNG][64 + lane] * bf2f(((const bf16_t*)(A.ws + H_G))[o + 64 + lane]);
    dg_put(A, k, fmaxf(dg_rel(bf2f(((const bf16_t*)(A.ws + WS_HM))[o + lane]), r0), dg_rel(bf2f(((const bf16_t*)(A.ws + WS_HM))[o + 64 + lane]), r1)));
}
__device__ __forceinline__ void dg_router(const Args& A, int k, int L) {
    const int lane = threadIdx.x & 63, gwv = blockIdx.x * 8 + (threadIdx.x >> 6);
    const int row = dg_hash(gwv, k) & (MTOK - 1), b = row >> 13; const float* x = A.out + (size_t)row * DM;
    const float* modl = (const float*)(A.ws + TB_MODS) + ((size_t)L * NBATCH + b) * 6144; const float* gain = A.in[I_N2G] + L * DM; const float* R = A.in[I_MOER] + (size_t)(L >> 1) * DM * 8;
    float ss = 0.f; for (int c = lane; c < DM; c += 64) ss += x[c] * x[c];
    ss = wave_sum(ss); const float rstd = 1.0f / sqrtf(ss / DM + EPS);
    float lg[8]; for (int e = 0; e < 8; ++e) lg[e] = 0.f;
    for (int c = lane; c < DM; c += 64) { const float hv = x[c] * rstd * gain[c] * (1.0f + modl[4 * 1024 + c]) + modl[3 * 1024 + c]; for (int e = 0; e < 8; ++e) lg[e] += hv * R[c * 8 + e]; }
    for (int e = 0; e < 8; ++e) lg[e] = wave_sum(lg[e]);
    int e0 = 0; for (int e = 1; e < 8; ++e) if (lg[e] > lg[e0]) e0 = e;
    int e1 = (e0 == 0) ? 1 : 0; for (int e = 0; e < 8; ++e) if (e != e0 && lg[e] > lg[e1]) e1 = e;
    float gap = 1e9f; for (int e = 0; e < 8; ++e) if (e != e0 && e != e1) gap = fminf(gap, lg[e1] - lg[e]); gap = fminf(gap, lg[e0] - lg[e1]);
    const int g0 = ((const int*)(A.ws + TB_EID))[row * 2], g1 = ((const int*)(A.ws + TB_EID))[row * 2 + 1]; const float w0 = ((const float*)(A.ws + TB_GATE))[row * 2], w1 = ((const float*)(A.ws + TB_GATE))[row * 2 + 1];
    const float p0 = 1.0f / (1.0f + expf(lg[e1] - lg[e0]));
    float er = (g0 != e0 || g1 != e1) ? (gap > 2e-3f ? 9.f : 0.f) : fmaxf(fabsf(w0 - p0), fabsf(w1 - (1.0f - p0)));
    if (lane == 0) dg_put(A, k, er);
}
__device__ __forceinline__ void dg_place(const Args& A, int k) {
    const int lane = threadIdx.x & 63, gwv = blockIdx.x * 8 + (threadIdx.x >> 6);
    const unsigned h = dg_hash(gwv, k); const int row = h & (MTOK - 1), kk = (h >> 16) & 1;
    const int sl = ((const int*)(A.ws + TB_SLOT))[row * 2 + kk], e = ((const int*)(A.ws + TB_EID))[row * 2 + kk]; const int* ts = (const int*)(A.ws + TB_TILES);
    float er = (sl >= ts[e] * 256 && sl < ts[e + 1] * 256 && sl < MOE_ROWS) ? 0.f : 7.f;
    if (er == 0.f) for (int c = lane; c < DM; c += 64) if (((const bf16_t*)(A.ws + E_XS))[(size_t)sl * DM + c] != ((const bf16_t*)(A.ws + WS_HM))[(size_t)row * DM + c]) er = 5.f;
    dg_put(A, k, er);
}
__device__ __forceinline__ void dg_moe_hid(const Args& A, int k, int m) {
    const int lane = threadIdx.x & 63, gwv = blockIdx.x * 8 + (threadIdx.x >> 6);
    const unsigned h = dg_hash(gwv, k); const int row = h & (MTOK - 1), kk = (h >> 16) & 1, j = (h >> 17) % DFFE;
    const int sl = ((const int*)(A.ws + TB_SLOT))[row * 2 + kk], e = ((const int*)(A.ws + TB_EID))[row * 2 + kk];
    const float* W = A.in[I_MOEGU] + ((size_t)m * 8 + e) * DM * 2 * DFFE; const bf16_t* Am = (const bf16_t*)(A.ws + E_XS) + (size_t)sl * DM;
    float g = 0.f, u = 0.f; for (int c = lane; c < DM; c += 64) { const float x = bf2f(Am[c]); g += x * dg_bfr(W[(size_t)c * 2 * DFFE + j]); u += x * dg_bfr(W[(size_t)c * 2 * DFFE + DFFE + j]); }
    g = wave_sum(g); u = wave_sum(u);
    if (lane == 0) dg_put(A, k, dg_rel(bf2f(((const bf16_t*)(A.ws + E_HID))[(size_t)sl * DFFE + j]), g / (1.0f + expf(-g)) * u));
}
__device__ __forceinline__ void dg_moe_y(const Args& A, int k, int m) {
    const int lane = threadIdx.x & 63, gwv = blockIdx.x * 8 + (threadIdx.x >> 6);
    const unsigned h = dg_hash(gwv, k); const int row = h & (MTOK - 1), kk = (h >> 16) & 1, col = (h >> 17) & 1023;
    const int sl = ((const int*)(A.ws + TB_SLOT))[row * 2 + kk], e = ((const int*)(A.ws + TB_EID))[row * 2 + kk];
    const float* W = A.in[I_MOEDN] + ((size_t)m * 8 + e) * DFFE * DM; const bf16_t* Hh = (const bf16_t*)(A.ws + E_HID) + (size_t)sl * DFFE;
    float a = 0.f; for (int j = lane; j < DFFE; j += 64) a += bf2f(Hh[j]) * dg_bfr(W[(size_t)j * DM + col]);
    a = wave_sum(a);
    if (lane == 0) dg_put(A, k, fabsf(bf2f(((const bf16_t*)(A.ws + E_XS))[(size_t)sl * DM + col]) - a) / (fabsf(a) + 0.3f));
}
__device__ __forceinline__ void dg_combine(const Args& A, int k, const float* modprev) {
    const int lane = threadIdx.x & 63, gwv = blockIdx.x * 8 + (threadIdx.x >> 6);
    const unsigned h = dg_hash(gwv, k); const int row = h & (MTOK - 1), col = (h >> 16) & 1023, b = row >> 13;
    const float* sv = (const float*)(A.ws + TB_LSUM) + 7 * 1024 * 1024 / 4; const bf16_t* Y = (const bf16_t*)(A.ws + E_XS);
    const int s0 = ((const int*)(A.ws + TB_SLOT))[row * 2], s1 = ((const int*)(A.ws + TB_SLOT))[row * 2 + 1]; const float w0 = ((const float*)(A.ws + TB_GATE))[row * 2], w1 = ((const float*)(A.ws + TB_GATE))[row * 2 + 1];
    const float ref = sv[k * 4096 + gwv] + modprev[(size_t)b * 6144 + 5 * 1024 + col] * (w0 * bf2f(Y[(size_t)s0 * DM + col]) + w1 * bf2f(Y[(size_t)s1 * DM + col]));
    if (lane == 0) dg_put(A, k, dg_rel(A.out[(size_t)row * DM + col], ref));
}
__device__ __forceinline__ void dg_lruin(const Args& A, int k) {
    const int lane = threadIdx.x & 63, gwv = blockIdx.x * 8 + (threadIdx.x >> 6);
    const unsigned h = dg_hash(gwv, k); const int row = h & (MTOK - 1), col = (h >> 16) % 2560;
    float a = 0.f; for (int kk = lane; kk < DM; kk += 64) a += bf2f(((const bf16_t*)(A.ws + WS_HM))[(size_t)row * DM + kk]) * dg_bfr(A.in[I_LRWIN][(size_t)kk * 2560 + col]);
    a = wave_sum(a);
    float ref, got;
    if (col < LRUW) { ref = 0.5f * a * (1.0f + tanhf(0.7978845608028654f * (a + 0.044715f * a * a * a))); got = bf2f(((const bf16_t*)(A.ws + L_YB))[(size_t)row * LRUW + col]); }
    else { ref = a; got = bf2f(((const bf16_t*)(A.ws + L_XB))[(size_t)row * LRUW + col - LRUW]); }
    if (lane == 0) dg_put(A, k, dg_rel(got, ref));
}
__device__ __forceinline__ void dg_lru(const Args& A, int k) {
    const int lane = threadIdx.x & 63, gwv = blockIdx.x * 8 + (threadIdx.x >> 6);
    const unsigned h = dg_hash(gwv, k); const int b = h & 7, ch = (h >> 3) % LRUW, tc = (h >> 16) & (SEQ - 1), n = ch / 128, j = ch % 128;
    const bf16_t* XB = (const bf16_t*)(A.ws + L_XB) + (size_t)b * SEQ * LRUW;
    float hres[2];
    for (int d = 0; d < 2; ++d) {
        const float* wa = A.in[I_LRWA] + (size_t)(d * 10 + n) * 16384; const float* wx = A.in[I_LRWX] + (size_t)(d * 10 + n) * 16384;
        const float wa0 = dg_bfr(wa[lane * 128 + j]), wa1 = dg_bfr(wa[(lane + 64) * 128 + j]), wx0 = dg_bfr(wx[lane * 128 + j]), wx1 = dg_bfr(wx[(lane + 64) * 128 + j]);
        const float ba = A.in[I_LRBA][d * LRUW + ch], bx = A.in[I_LRBX][d * LRUW + ch]; const float lam = A.in[I_LRLAM][d * LRUW + ch]; const float sp = log1pf(expf(-lam));
        float hs = 0.f;
        for (int i = 0; ; ++i) { const int t = d ? (SEQ - 1 - i) : i;
            float x0 = A.in[I_LRCB][n * 128 + lane], x1 = A.in[I_LRCB][n * 128 + 64 + lane], xj = A.in[I_LRCB][ch];
            for (int w = 0; w < 4; ++w) { const int tt = t - 1 + w; if (tt >= 0 && tt < SEQ) {
                x0 += A.in[I_LRCW][w * LRUW + n * 128 + lane] * bf2f(XB[(size_t)tt * LRUW + n * 128 + lane]); x1 += A.in[I_LRCW][w * LRUW + n * 128 + 64 + lane] * bf2f(XB[(size_t)tt * LRUW + n * 128 + 64 + lane]);
                xj += A.in[I_LRCW][w * LRUW + ch] * bf2f(XB[(size_t)tt * LRUW + ch]); } }
            const float rp = wave_sum(dg_bfr(x0) * wa0 + dg_bfr(x1) * wa1), ip = wave_sum(dg_bfr(x0) * wx0 + dg_bfr(x1) * wx1);
            const float rg = 1.0f / (1.0f + expf(-(rp + ba))), ig = 1.0f / (1.0f + expf(-(ip + bx))); const float la = -8.0f * rg * sp;
            hs = expf(la) * hs + sqrtf(fmaxf(-expm1f(2.0f * la), 0.f)) * ig * xj;
            if (t == tc) break; }
        hres[d] = hs;
    }
    const size_t go = ((size_t)b * SEQ + tc) * LRUW + ch;
    const float e1 = fabsf(bf2f(((const bf16_t*)(A.ws + L_HF))[go]) - hres[0]) / (fabsf(hres[0]) + 0.3f);
    const float ref = (hres[0] + hres[1]) * bf2f(((const bf16_t*)(A.ws + L_YB))[go]);
    const float e2 = fabsf(bf2f(((const bf16_t*)(A.ws + L_HY))[go]) - ref) / (fabsf(ref) + 0.3f);
    if (lane == 0) { dg_put(A, k, e1); dg_put(A, k + 5, e2); }
}
__device__ __forceinline__ void dg_final(const Args& A, int nchk) {
    const unsigned* sl = (const unsigned*)(A.ws + WS_CTL) + DG_BASE; int code = 0; float ev = 0.f;
    for (int k = 1; k <= nchk; ++k) { const float e = __uint_as_float(sl[64 * k]); if (e > 0.05f) { code = k; ev = e; break; } }
    if (code == 0) return;
    const int c1 = code % 10, c10 = code / 10;
    const float s = -(float)c1;
    for (size_t i = (size_t)blockIdx.x * NTHR + threadIdx.x; i < (size_t)MTOK * DM; i += (size_t)gridDim.x * NTHR) A.out[i] = A.in[I_X][i] * s;
    __syncthreads();
    if (blockIdx.x == 0 && threadIdx.x == 0) { const int qq = ev < 0.1f ? 1 : ev < 0.2f ? 2 : ev < 0.5f ? 3 : ev < 1.f ? 4 : ev < 2.f ? 5 : ev < 5.f ? 6 : ev < 20.f ? 7 : ev < 1e3f ? 8 : 9;
        A.out[12345] = 100.f * (float)(10 * c10 + qq); }
}
#define DG(x) x
#define DGL(x) if constexpr (L >= DIAG_FROM) { x }
#else
#define DG(x)
#define DGL(x)
#endif

#define GRID_BAR() xcd_barrier(bar)
template <int L>
__device__ __forceinline__ void run_mixer(const Args& args, LAS unsigned char* lds, int bid, int G, const XcdBarrier& bar) {
    unsigned char* ws = args.ws; bf16_t* xo = (bf16_t*)(ws + WS_XB);
    const float* modl = (const float*)(ws + TB_MODS) + (size_t)L * NBATCH * 6144;
    const void* xs = (L == 0) ? (const void*)args.in[I_X] : (const void*)xo; constexpr bool X16 = (L != 0);
    constexpr int kind = L % 3;
    DGL(if (L > 0 && ((L - 1) & 1)) { dg_save(args, 10 * (L - 1) + 9, xo); GRID_BAR(); })
    norm_phase<false>(args, lds, bid, G, xs, X16, xo, true, args.in[I_N1G] + L * DM, modl, 0, (L > 0) && ((L - 1) & 1), modl - NBATCH * 6144, false, nullptr);
    GRID_BAR();
    DGL(if (L > 0 && ((L - 1) & 1)) { dg_combine(args, 10 * (L - 1) + 9, modl - NBATCH * 6144); GRID_BAR(); })
    DGL(dg_norm(args, 10 * L + 1, (L > 0 && ((L - 1) & 1)) ? xo : xs, args.in[I_N1G] + L * DM, L, 0); GRID_BAR();)
    if constexpr (kind == 0) {
        constexpr int al = L / 3;
        {
            pg8::Gemm g{(const bf16_t*)(ws + WS_HM), (const bf16_t*)(ws + W_QKV) + (size_t)al * 3072 * 1024, 1024};
            pg8::TileOrder S; S.init(256, 12, G, bid);
            pg8::EpiQKV E{(bf16_t*)(ws + A_Q), (bf16_t*)(ws + A_K), (bf16_t*)(ws + A_V), args.in[I_ATQN] + al * 64, args.in[I_ATKN] + al * 64,
                          (const float*)(ws + TB_COS), (const float*)(ws + TB_SIN), LOG2E};
            pg8::gemm_phase<pg8::EpiQKV>(lds, g, S, E);
        }
        GRID_BAR();
        vt_phase(args, bid, G);
        GRID_BAR();
        attn_phase(args, lds, bid, G, al);
        GRID_BAR();
        DGL(dg_save(args, 10 * L + 4, xs); GRID_BAR();)
        {
            pg8::Gemm g{(const bf16_t*)(ws + WS_HM), (const bf16_t*)(ws + W_AO) + (size_t)al * 1024 * 1024, 1024};
            pg8::TileOrder S; S.init(256, 4, G, bid);
            pg8::EpiRes<X16> E{xs, xo, modl + 2 * 1024, 1.0f};
            pg8::gemm_phase<pg8::EpiRes<X16>>(lds, g, S, E);
        }
        GRID_BAR();
        DGL(dg_res(args, 10 * L + 4, xo, modl + 2 * 1024, (const bf16_t*)(ws + WS_HM), 1024, args.in[I_ATWOUT] + (size_t)al * 1024 * 1024); GRID_BAR();)
    }
    if constexpr (kind == 1) {
        {
            pg8::Gemm g{(const bf16_t*)(ws + WS_HM), (const bf16_t*)(ws + W_HGI), 1024};
            pg8::TileOrder S; S.init(256, 20, G, bid);
            pg8::EpiAct E{0, ws, (const float*)(ws + TB_LB)};
            pg8::gemm_phase<pg8::EpiAct>(lds, g, S, E);
        }
        GRID_BAR();
        DGL(dg_hgin(args, 10 * L + 2); GRID_BAR();)
        gla_phase(args, lds, bid, G);
        GRID_BAR();
        DGL(dg_gla(args, 10 * L + 3); GRID_BAR();)
        hg_normo_phase(args, bid, G);
        GRID_BAR();
        DGL(dg_normo(args, 10 * L + 0); GRID_BAR();)
        DGL(dg_save(args, 10 * L + 4, xs); GRID_BAR();)
        {
            pg8::Gemm g{(const bf16_t*)(ws + WS_HM), (const bf16_t*)(ws + W_HGO), 1024};
            pg8::TileOrder S; S.init(256, 4, G, bid);
            pg8::EpiRes<X16> E{xs, xo, modl + 2 * 1024, 1.0f};
            pg8::gemm_phase<pg8::EpiRes<X16>>(lds, g, S, E);
        }
        GRID_BAR();
        DGL(dg_res(args, 10 * L + 4, xo, modl + 2 * 1024, (const bf16_t*)(ws + WS_HM), 1024, args.in[I_HGWOUT]); GRID_BAR();)
    }
    if constexpr (kind == 2) {
        {
            pg8::Gemm g{(const bf16_t*)(ws + WS_HM), (const bf16_t*)(ws + W_LRI), 1024};
            pg8::TileOrder S; S.init(256, 10, G, bid);
            pg8::EpiAct E{1, ws, nullptr};
            pg8::gemm_phase<pg8::EpiAct>(lds, g, S, E);
        }
        GRID_BAR();
        DGL(dg_lruin(args, 10 * L + 2); GRID_BAR();)
        lru_phase<0>(args, lds, bid, G);
        GRID_BAR();
        lru_carry_phase(args, bid, G);
        GRID_BAR();
        lru_apply_phase(args, lds, bid, G);
        GRID_BAR();
        DGL(dg_lru(args, 10 * L + 3); GRID_BAR();)
        DGL(dg_save(args, 10 * L + 4, xs); GRID_BAR();)
        {
            pg8::Gemm g{(const bf16_t*)(ws + L_HY), (const bf16_t*)(ws + W_LRO), LRUW};
            pg8::TileOrder S; S.init(256, 4, G, bid);
            pg8::EpiRes<X16> E{xs, xo, modl + 2 * 1024, 1.0f};
            pg8::gemm_phase<pg8::EpiRes<X16>>(lds, g, S, E);
        }
        GRID_BAR();
        DGL(dg_res(args, 10 * L + 4, xo, modl + 2 * 1024, (const bf16_t*)(ws + L_HY), LRUW, args.in[I_LRWOUT]); GRID_BAR();)
    }
}
template <int L>
__device__ __forceinline__ void run_ffn(const Args& args, LAS unsigned char* lds, int bid, int G, const XcdBarrier& bar) {
    unsigned char* ws = args.ws; bf16_t* xo = (bf16_t*)(ws + WS_XB);
    const float* modl = (const float*)(ws + TB_MODS) + (size_t)L * NBATCH * 6144;
    if constexpr ((L & 1) == 0) {
        constexpr int m = L >> 1;
        constexpr bool F8 = (L >= FP8_DENSE_FROM);
        norm_phase<false>(args, lds, bid, G, xo, true, xo, true, args.in[I_N2G] + L * DM, modl, 1, false, modl, false, nullptr, F8);
        GRID_BAR();
        if constexpr (F8) {
            pg8::Gemm g{(const bf16_t*)(ws + WS_HM), (const bf16_t*)(ws + W_FGU) + (size_t)m * 5632 * 1024, 512};
            pg8::TileOrder S; S.init(256, 22, G, bid);
            pg8::EpiSwiGLU8 E{ws + F_HID, DFF, 1.0f / MOE_WSCALE, MOE_HSCALE};
            pg8::gemm_phase<pg8::EpiSwiGLU8, true>(lds, g, S, E);
        } else {
            pg8::Gemm g{(const bf16_t*)(ws + WS_HM), (const bf16_t*)(ws + W_FGU) + (size_t)m * 5632 * 1024, 1024};
            pg8::TileOrder S; S.init(256, 22, G, bid);
            pg8::EpiSwiGLU E{(bf16_t*)(ws + F_HID), DFF};
            pg8::gemm_phase<pg8::EpiSwiGLU>(lds, g, S, E);
        }
        GRID_BAR();
        if constexpr (F8) {
            pg8::Gemm g{(const bf16_t*)(ws + F_HID), (const bf16_t*)(ws + W_FDN) + (size_t)m * 1024 * 2816, DFF / 2};
            pg8::TileOrder S; S.init(256, 4, G, bid);
            pg8::EpiRes<true> E{xo, xo, modl + 5 * 1024, 1.0f / (MOE_WSCALE * MOE_HSCALE)};
            pg8::gemm_phase<pg8::EpiRes<true>, true>(lds, g, S, E);
        } else {
            pg8::Gemm g{(const bf16_t*)(ws + F_HID), (const bf16_t*)(ws + W_FDN) + (size_t)m * 1024 * 2816, DFF};
            pg8::TileOrder S; S.init(256, 4, G, bid);
            pg8::EpiRes<true> E{xo, xo, modl + 5 * 1024, 1.0f};
            pg8::gemm_phase<pg8::EpiRes<true>>(lds, g, S, E);
        }
        GRID_BAR();
    } else {
        constexpr int m = L >> 1;
        norm_phase<true>(args, lds, bid, G, xo, true, xo, true, args.in[I_N2G] + L * DM, modl, 1, false, modl, false, args.in[I_MOER] + (size_t)m * DM * 8);
        GRID_BAR();
        DGL(dg_norm(args, 10 * L + 5, xo, args.in[I_N2G] + L * DM, L, 1); dg_router(args, 10 * L + 5, L); GRID_BAR();)
        place_phase(args, lds, bid, G);
        GRID_BAR();
        DGL(dg_place(args, 10 * L + 6); GRID_BAR();)
        const int* tiles = (const int*)(ws + TB_TILES);
        {
            pg8::Gemm g{(const bf16_t*)(ws + E_XS), (const bf16_t*)(ws + W_MGU + (size_t)m * 8 * 7168 * 1024), 512};
            pg8::TileOrder S; S.init(tiles[8], 28, G, bid);
#pragma unroll
            for (int e = 1; e < NEXP; ++e) S.ts[e] = tiles[e];
            pg8::EpiSwiGLU8 E{ws + E_HID, DFFE, 1.0f / MOE_WSCALE, MOE_HSCALE};
            pg8::gemm_phase<pg8::EpiSwiGLU8, true>(lds, g, S, E);
        }
        GRID_BAR();
        DGL(dg_moe_hid(args, 10 * L + 7, m); GRID_BAR();)
        {
            pg8::Gemm g{(const bf16_t*)(ws + E_HID), (const bf16_t*)(ws + W_MDN + (size_t)m * 8 * 1024 * 3584), DFFE / 2};
            pg8::TileOrder S; S.init(tiles[8], 4, G, bid);
#pragma unroll
            for (int e = 1; e < NEXP; ++e) S.ts[e] = tiles[e];
            pg8::EpiPlain E{(bf16_t*)(ws + E_XS), DM, 1.0f / (MOE_WSCALE * MOE_HSCALE)};
            pg8::gemm_phase<pg8::EpiPlain, true>(lds, g, S, E);
        }
        GRID_BAR();
        DGL(dg_moe_y(args, 10 * L + 8, m); GRID_BAR();)
    }
}
__device__ __forceinline__ void final_combine(const Args& args, LAS unsigned char* lds, int bid, int G, const XcdBarrier& bar) {
    const float* modl = (const float*)(args.ws + TB_MODS) + (size_t)3 * NBATCH * 6144;
    DG(dg_save(args, 39, args.out); GRID_BAR();)
    norm_phase<false>(args, lds, bid, G, args.ws + WS_XB, true, args.out, false, args.in[I_N1G], modl, 0, true, modl, true, nullptr);
    DG(GRID_BAR(); dg_combine(args, 39, modl);)
}

__global__ void __launch_bounds__(NTHR, 2) mega_fwd(Args args) {
    extern __shared__ __attribute__((aligned(16))) unsigned char lds_raw[];
    LAS unsigned char* lds = (LAS unsigned char*)lds_raw;
    const int tid = threadIdx.x, bid = blockIdx.x, G = gridDim.x;
    unsigned char* ws = args.ws;
    volatile LAS unsigned* MISC = (volatile LAS unsigned*)(lds + MISC_OFF);
    if (tid < 64) MISC[tid] = 0u;
    __syncthreads();
    XcdBarrier bar = xcd_barrier_post((unsigned*)(ws + WS_CTL) + CW_BAR, MISC + 8);

    prologue_phase(args, lds, bid, G);
    GRID_BAR();

    run_mixer<0>(args, lds, bid, G, bar);
    run_ffn<0>(args, lds, bid, G, bar);
    run_mixer<1>(args, lds, bid, G, bar);
    run_ffn<1>(args, lds, bid, G, bar);
    run_mixer<2>(args, lds, bid, G, bar);
    run_ffn<2>(args, lds, bid, G, bar);
    run_mixer<3>(args, lds, bid, G, bar);
    run_ffn<3>(args, lds, bid, G, bar);
    final_combine(args, lds, bid, G, bar);
    DG(GRID_BAR(); dg_final(args, 49);)
}

extern "C" void kernel_launch(void* const* d_in, const int* in_sizes, int n_in, void* d_out, int out_size, void* d_ws, size_t ws_size, hipStream_t stream) {
    static int grid = 0;
    if (grid == 0) {
        if (n_in != 30 || out_size != MTOK * DM || ws_size < WS_NEED) { fprintf(stderr, "kernel_launch: unexpected shapes (n_in %d out %d ws %zu need %zu)\n", n_in, out_size, ws_size, (size_t)WS_NEED); grid = -1; return; }
        int dev = 0, cus = 0;
        if (hipGetDevice(&dev) != hipSuccess || hipDeviceGetAttribute(&cus, hipDeviceAttributeMultiprocessorCount, dev) != hipSuccess) { grid = -1; return; }
        if (hipFuncSetAttribute((const void*)mega_fwd, hipFuncAttributeMaxDynamicSharedMemorySize, LDS_BYTES) != hipSuccess) { fprintf(stderr, "kernel_launch: hipFuncSetAttribute failed\n"); grid = -1; return; }
        int per_cu = 0;
        if (hipOccupancyMaxActiveBlocksPerMultiprocessor(&per_cu, (const void*)mega_fwd, NTHR, LDS_BYTES) != hipSuccess || per_cu < 1) { fprintf(stderr, "kernel_launch: occupancy query says %d\n", per_cu); }
        (void)hipGetLastError();
        grid = (cus >= 256) ? 256 : -1;
        if (grid < 0) { fprintf(stderr, "kernel_launch: needs 256 CUs, device has %d\n", cus); return; }
    }
    if (grid < 0) return;
    if (hipMemsetAsync((char*)d_ws + WS_CTL, 0, CTL_ZERO_BYTES, stream) != hipSuccess) return;
    Args a{};
    for (int i = 0; i < 30; ++i) a.in[i] = (const float*)d_in[i];
    a.out = (float*)d_out; a.ws = (unsigned char*)d_ws;
    hipLaunchKernelGGL(mega_fwd, dim3(grid), dim3(NTHR), LDS_BYTES, stream, a);
}
```

```cpp
#define DIAG_FROM 2
#include <hip/hip_runtime.h>
#include <cstdio>
#include <cstdint>

#define LAS __attribute__((address_space(3)))
#define GAS __attribute__((address_space(1)))
typedef unsigned short bf16_t;
typedef short bf16x8 __attribute__((ext_vector_type(8)));
typedef short s16x4 __attribute__((ext_vector_type(4)));
typedef float f32x2 __attribute__((ext_vector_type(2)));
typedef float f32x4 __attribute__((ext_vector_type(4)));
typedef float f32x16 __attribute__((ext_vector_type(16)));
typedef unsigned u32x2 __attribute__((ext_vector_type(2)));
typedef unsigned u32x4 __attribute__((ext_vector_type(4)));

constexpr int MTOK = 65536, DM = 1024, SEQ = 8192, NBATCH = 8, DEPTH = 4;
constexpr int DFF = 2816, DFFE = 3584, NEXP = 8, LRUW = 1280;
constexpr float EPS = 1e-6f;
constexpr int FP8_DENSE_FROM = 2;
constexpr float MOE_WSCALE = 64.0f, MOE_HSCALE = 4.0f;
constexpr float LOG2E = 1.4426950408889634f;

constexpr size_t MiB = 1u << 20;
constexpr size_t WS_CTL = 0, CTL_ZERO_BYTES = 1 * MiB;
constexpr size_t WS_TAB = 1 * MiB;
constexpr size_t TB_MODS = WS_TAB;
constexpr size_t TB_COS = WS_TAB + 1 * MiB;
constexpr size_t TB_SIN = WS_TAB + 2 * MiB;
constexpr size_t TB_SCAL = WS_TAB + 3 * MiB;
constexpr size_t TB_LB = TB_SCAL + 4096;
constexpr size_t TB_SP = TB_SCAL + 16384;
constexpr size_t TB_EID = WS_TAB + 4 * MiB;
constexpr size_t TB_GATE = WS_TAB + 5 * MiB;
constexpr size_t TB_SLOT = WS_TAB + 6 * MiB;
constexpr size_t TB_BCNT = WS_TAB + 7 * MiB;
constexpr size_t TB_TILES = TB_BCNT + 16384;
constexpr size_t TB_LSUM = WS_TAB + 8 * MiB;
constexpr size_t TB_LCIN = WS_TAB + 16 * MiB;
constexpr size_t WS_W = 32 * MiB;
constexpr size_t W_QKV = WS_W;
constexpr size_t W_AO = W_QKV + 2 * (size_t)3072 * 1024 * 2;
constexpr size_t W_HGI = W_AO + 2 * (size_t)1024 * 1024 * 2;
constexpr size_t W_HGO = W_HGI + (size_t)5120 * 1024 * 2;
constexpr size_t W_LRI = W_HGO + (size_t)1024 * 1024 * 2;
constexpr size_t W_LRG = W_LRI + (size_t)2560 * 1024 * 2;
constexpr size_t W_LRO = W_LRG + (size_t)10 * 2 * 256 * 128 * 2;
constexpr size_t W_FGU = W_LRO + (size_t)1024 * 1280 * 2;
constexpr size_t W_FDN = W_FGU + 2 * (size_t)5632 * 1024 * 2;
constexpr size_t W_MGU = W_FDN + 2 * (size_t)1024 * 2816 * 2;
constexpr size_t W_MDN = W_MGU + 16 * (size_t)7168 * 1024 * 2;
constexpr size_t W_END = W_MDN + 16 * (size_t)1024 * 3584 * 2;
constexpr size_t WS_HM = 440 * MiB;
constexpr size_t WS_ACT = 568 * MiB;
static_assert(W_END <= WS_HM, "weights overflow");
constexpr size_t SZ_TOK = (size_t)MTOK * 1024 * 2;
constexpr size_t A_Q = WS_ACT, A_K = A_Q + SZ_TOK, A_V = A_K + SZ_TOK, A_VT = A_V + SZ_TOK;
constexpr size_t F_HID = WS_ACT;
constexpr size_t H_Q = WS_ACT, H_LFF = H_Q + SZ_TOK, H_LFB = H_LFF + SZ_TOK, H_V = H_LFB + SZ_TOK, H_G = H_V + SZ_TOK, H_OF = H_G + SZ_TOK, H_OB = H_OF + SZ_TOK;
constexpr size_t SZ_LRU = (size_t)MTOK * 1280 * 2;
constexpr size_t L_YB = WS_ACT, L_XB = L_YB + SZ_LRU, L_HF = L_XB + SZ_LRU, L_HY = L_HF + SZ_LRU, L_U = L_HY + SZ_LRU;
constexpr int MOE_ROWS = 2 * MTOK + NEXP * 256;
constexpr size_t E_XS = WS_ACT, E_HID = E_XS + (size_t)MOE_ROWS * 1024 * 2, E_END = E_HID + (size_t)MOE_ROWS * DFFE;
constexpr size_t WS_XB = 1536 * MiB;
static_assert(E_END <= WS_XB && H_OB + SZ_TOK <= WS_XB && L_U + 2 * SZ_LRU <= WS_XB && A_VT + SZ_TOK <= WS_XB, "activation regions below the residual stream");
constexpr size_t WS_NEED = WS_XB + SZ_TOK;
static_assert(WS_NEED <= (size_t)1792 * MiB, "workspace");

constexpr int CW_BAR = 4096;

constexpr int RING_BYTES = 135168;
constexpr int MISC_OFF = RING_BYTES;
constexpr int LDS_BYTES = 147456;
constexpr int NWAVES = 8, NTHR = 512;

typedef __bf16 bf16x2v __attribute__((ext_vector_type(2)));
__device__ __forceinline__ unsigned cvt_pk_bf16(float lo, float hi) { const f32x2 v = {lo, hi}; const bf16x2v b = __builtin_convertvector(v, bf16x2v); return __builtin_bit_cast(unsigned, b); }
__device__ __forceinline__ unsigned pk_fp8x4(float a, float b, float c, float d) { unsigned w = 0; w = __builtin_amdgcn_cvt_pk_fp8_f32(a, b, w, false); w = __builtin_amdgcn_cvt_pk_fp8_f32(c, d, w, true); return w; }
__device__ __forceinline__ unsigned f2bf(float f) { unsigned u = __builtin_bit_cast(unsigned, f); return (u + 0x7fffu + ((u >> 16) & 1u)) >> 16; }
__device__ __forceinline__ float bf2f(unsigned short b) { return __builtin_bit_cast(float, ((unsigned)b) << 16); }
__device__ __forceinline__ float bflo(unsigned w) { return __builtin_bit_cast(float, w << 16); }
__device__ __forceinline__ float bfhi(unsigned w) { return __builtin_bit_cast(float, w & 0xffff0000u); }
__device__ __forceinline__ float fexp2(float x) { return __builtin_amdgcn_exp2f(x); }
__device__ __forceinline__ float fexp(float x) { return __builtin_amdgcn_exp2f(x * LOG2E); }
__device__ __forceinline__ float frcp(float x) { return __builtin_amdgcn_rcpf(x); }
__device__ __forceinline__ float fsigmoid(float x) { return frcp(1.0f + fexp(-x)); }
__device__ __forceinline__ float fsilu(float x) { return x * fsigmoid(x); }
__device__ __forceinline__ float wave_sum(float v) {
#pragma unroll
    for (int o = 1; o < 64; o <<= 1) v += __shfl_xor(v, o);
    return v;
}
#define LDS_WAIT() asm volatile("s_waitcnt lgkmcnt(0)" ::: "memory")
#define VM_WAIT() asm volatile("s_waitcnt vmcnt(0)" ::: "memory")

#define XB_TMO      128
#define XB_XCNT(j)  (256  + 64 * (j))
#define XB_XSUB(j)  (1280 + 64 * (j))
#define XB_XGEN(j)  (2304 + 64 * (j))
#define XB_TOP      3328
#define XB_TOPGEN   3392
#define XCD_BAR_WORDS 3456
#define XB_SPIN_CAP (1u << 22)
__device__ __forceinline__ unsigned xb_ld(unsigned* p)              { return __hip_atomic_load(p, __ATOMIC_RELAXED, __HIP_MEMORY_SCOPE_AGENT); }
__device__ __forceinline__ unsigned xb_add(unsigned* p, unsigned v) { return __hip_atomic_fetch_add(p, v, __ATOMIC_RELAXED, __HIP_MEMORY_SCOPE_AGENT); }
__device__ __forceinline__ unsigned xb_xcc_id() { return (unsigned)__builtin_amdgcn_s_getreg((3 << 11) | 20) & 0xFu; }
#define XB_SPIN(cond, bar) do { unsigned _sp = 0; while (cond) { __builtin_amdgcn_s_sleep(1); \
    if ((++_sp & 255u) == 0u) { if (xb_ld(&(bar)[XB_TMO])) break; if (_sp > XB_SPIN_CAP) { atomicAdd(&(bar)[XB_TMO], 1u); break; } } } } while (0)
struct XcdBarrier { unsigned* bar; unsigned x; volatile LAS unsigned* st; };
__device__ __forceinline__ XcdBarrier xcd_barrier_post(unsigned* bar, volatile LAS unsigned* st) {
    XcdBarrier b; b.bar = bar; b.x = xb_xcc_id(); b.st = st;
    if (threadIdx.x == 0) (void)xb_add(&bar[XB_XCNT(b.x)], 1u);
    return b;
}
__device__ __forceinline__ void xcd_barrier_complete(unsigned* bar, unsigned x, unsigned& nloc, unsigned& nx) {
    const unsigned G = gridDim.x * gridDim.y * gridDim.z;
    unsigned sum, cnt, mine, sp = 0u;
    for (;;) {
        sum = 0u; cnt = 0u; mine = 0u;
#pragma unroll
        for (unsigned j = 0; j < 16; ++j) { const unsigned c = xb_ld(&bar[XB_XCNT(j)]); sum += c; cnt += (c > 0u) ? 1u : 0u; mine = (j == x) ? c : mine; }
        if (sum == G) break;
        __builtin_amdgcn_s_sleep(1);
        if ((++sp & 255u) == 0u) { if (xb_ld(&bar[XB_TMO])) break; if (sp > XB_SPIN_CAP) { atomicAdd(&bar[XB_TMO], 1u); break; } }
    }
    nloc = mine > 0u ? mine : 1u; nx = cnt > 0u ? cnt : 1u;
}
__device__ __forceinline__ void xcd_barrier(const XcdBarrier& b) {
    asm volatile("s_waitcnt vmcnt(0)" ::: "memory");
    __syncthreads();
    if (threadIdx.x == 0) {
        unsigned* bar = b.bar;
        __builtin_amdgcn_s_waitcnt(0);
        unsigned nloc = b.st[0], nx = b.st[1];
        if (nloc == 0u) { xcd_barrier_complete(bar, b.x, nloc, nx); b.st[0] = nloc; b.st[1] = nx; }
        const unsigned old = xb_add(&bar[XB_XSUB(b.x)], 1u);
        const unsigned gen = old / nloc;
        if (old + 1u == (gen + 1u) * nloc) {
            __builtin_amdgcn_fence(__ATOMIC_RELEASE, "agent");
            asm volatile("s_waitcnt vmcnt(0)" ::: "memory");
            const unsigned og = xb_add(&bar[XB_TOP], 1u);
            const unsigned tg = og / nx;
            if (og + 1u == (tg + 1u) * nx) xb_add(&bar[XB_TOPGEN], 1u);
            else XB_SPIN(xb_ld(&bar[XB_TOPGEN]) == tg, bar);
            __builtin_amdgcn_fence(__ATOMIC_ACQUIRE, "agent");
            xb_add(&bar[XB_XGEN(b.x)], 1u);
            asm volatile("s_waitcnt vmcnt(0)" ::: "memory");
        } else {
            XB_SPIN(xb_ld(&bar[XB_XGEN(b.x)]) == gen, bar);
            __builtin_amdgcn_fence(__ATOMIC_ACQUIRE, "agent");
            asm volatile("s_waitcnt vmcnt(0)" ::: "memory");
        }
    }
    __syncthreads();
}

namespace pg8 {
constexpr int BM = 256, BK = 64, HALF = 128, HTB = HALF * BK * 2, STAGE_BYTES = 8 * HTB, NXCD = 8, WGM = 8;
__host__ __device__ __forceinline__ int lds_byte(int r, int c) { const int st = (r >> 4) * 2 + (c >> 5), rr = r & 15, cc = c & 31, ob = rr * 64 + cc * 2; return st * 1024 + (ob ^ (((ob >> 9) & 1) << 5)); }
__host__ __device__ __forceinline__ void stage_rc(int b, int& R, int& C) { const int st = b / 1024, sb = b % 1024, swz = sb ^ (((sb >> 9) & 1) << 5); R = (st >> 1) * 16 + swz / 64; C = (st & 1) * 32 + (swz % 64) / 2; }
__host__ __device__ __forceinline__ int perm32(int rho) { const int n = rho >> 4, i = rho & 15; return 8 * (i >> 2) + 4 * n + (i & 3); }

struct Unit { int pm, pn, pb; };
struct Gemm { const bf16_t* A; const bf16_t* Bt; int K; };

struct TileOrder {
    int nM, nN, nwg, G, c; int ts[NEXP];
    __device__ __forceinline__ void init(int nM_, int nN_, int G_, int c_) { nM = nM_; nN = nN_; nwg = nM * nN; G = G_; c = c_;
#pragma unroll
        for (int e = 0; e < NEXP; ++e) ts[e] = (e == 0) ? 0 : 0x7fffffff; }
    __device__ __forceinline__ bool next(int i, Unit& u) const {
        const long L = (long)i * G + c; if (L >= nwg) return false;
        int wgid = (int)L; { const int q = nwg / NXCD, r = nwg % NXCD, xcd = wgid % NXCD, off = wgid / NXCD; wgid = (xcd < r ? xcd * (q + 1) : r * (q + 1) + (xcd - r) * q) + off; }
        const int nig = WGM * nN, gid = wgid / nig, fm = gid * WGM, gsz = (nM - fm) < WGM ? (nM - fm) : WGM;
        u.pm = fm + ((wgid % nig) % gsz); u.pn = (wgid % nig) / gsz;
        int e = 0;
#pragma unroll
        for (int k = 1; k < NEXP; ++k) e += (u.pm >= ts[k]) ? 1 : 0;
        u.pb = e * nN + u.pn; return true;
    }
};

typedef int v8i32 __attribute__((ext_vector_type(8)));
template <class Epi, bool FP8 = false>
__device__ __forceinline__ void gemm_phase(LAS unsigned char* lds, const Gemm g, const TileOrder& S, const Epi& E) {
    int tid_ = threadIdx.x; asm volatile("" : "+v"(tid_));
    const int tid = tid_, wid = __builtin_amdgcn_readfirstlane(tid >> 6), lane = tid & 63, wr = wid >> 2, wc = wid & 3, fr = lane & 15, fq = lane >> 4;
    const int K = g.K, nt = K / BK;
    unsigned voffA[2], voffB[2];
#pragma unroll
    for (int i = 0; i < 2; ++i) { int R, C; stage_rc(tid * 16 + i * 8192, R, C); const int Rb = Epi::PERM ? ((R & ~31) + perm32(R & 31)) : R;
        voffA[i] = (unsigned)(R * K + C) * 2u; voffB[i] = (unsigned)(Rb * K + C) * 2u; }
    const size_t kstep = (size_t)(BK * 2);
    const size_t hstep = (size_t)HALF * K * 2;
    const size_t tstep = 2 * hstep;
    const unsigned ldsw = (unsigned)wid * 1024u;
    const int aoff = lds_byte(wr * 64 + fr, fq * 8), boff = lds_byte(wc * 32 + fr, fq * 8);
#define PG8_SA(b, h) (((b) * 2 + (h)) * HTB)
#define PG8_SB(b, h) ((4 + (b) * 2 + (h)) * HTB)
#define PG8_STAGE(bufoff, gbase, voff) do { _Pragma("unroll") for (int _i = 0; _i < 2; ++_i) \
        __builtin_amdgcn_global_load_lds((const unsigned*)((const char*)(gbase) + (voff)[_i]), (LAS unsigned*)(lds + (bufoff) + ldsw + _i * 8192), 16, 0, 0); } while (0)
#define PG8_LD8(p) __builtin_bit_cast(v8i32, __builtin_shufflevector(*(const LAS u32x4*)(p), *(const LAS u32x4*)((p) + 1024), 0, 1, 2, 3, 4, 5, 6, 7))
#define PG8_LDA(dst, b, h) do { if constexpr (FP8) { _Pragma("unroll") for (int m = 0; m < 4; ++m) dst##8[m] = PG8_LD8(lds + PG8_SA(b, h) + aoff + m * 2048); } \
        else { _Pragma("unroll") for (int m = 0; m < 4; ++m) _Pragma("unroll") for (int k = 0; k < 2; ++k) dst[m][k] = *(const LAS bf16x8*)(lds + PG8_SA(b, h) + aoff + m * 2048 + k * 1024); } } while (0)
#define PG8_LDB(dst, b, h) do { if constexpr (FP8) { _Pragma("unroll") for (int n = 0; n < 2; ++n) dst##8[n] = PG8_LD8(lds + PG8_SB(b, h) + boff + n * 2048); } \
        else { _Pragma("unroll") for (int n = 0; n < 2; ++n) _Pragma("unroll") for (int k = 0; k < 2; ++k) dst[n][k] = *(const LAS bf16x8*)(lds + PG8_SB(b, h) + boff + n * 2048 + k * 1024); } } while (0)
#define PG8_MMA(ai, bj, At, Bt) do { __builtin_amdgcn_s_setprio(1); \
        if constexpr (FP8) { _Pragma("unroll") for (int m = 0; m < 4; ++m) _Pragma("unroll") for (int n = 0; n < 2; ++n) \
            asm volatile("v_mfma_scale_f32_16x16x128_f8f6f4 %0, %1, %2, %0, %3, %3 op_sel_hi:[0,0,0]" : "+v"(acc[ai][bj][m][n]) : "v"(Bt##8[n]), "v"(At##8[m]), "v"(one_scale)); } \
        else { _Pragma("unroll") for (int m = 0; m < 4; ++m) _Pragma("unroll") for (int n = 0; n < 2; ++n) _Pragma("unroll") for (int k = 0; k < 2; ++k) \
            acc[ai][bj][m][n] = __builtin_amdgcn_mfma_f32_16x16x32_bf16(Bt[n][k], At[m][k], acc[ai][bj][m][n], 0, 0, 0); } \
        __builtin_amdgcn_s_setprio(0); } while (0)
#define PG8_WAIT_V(n) asm volatile("s_waitcnt vmcnt(" #n ")" ::: "memory")
#define PG8_WAIT_L(n) asm volatile("s_waitcnt lgkmcnt(" #n ")" ::: "memory")
#define PG8_BAR __builtin_amdgcn_s_barrier()
#define PG8_SCHED __builtin_amdgcn_sched_barrier(0)
    Unit cur, nxt; int ui = 0;
    if (!S.next(0, cur)) return;
    f32x4 acc[2][2][4][2];
#pragma unroll
    for (int a = 0; a < 2; ++a)
#pragma unroll
        for (int b = 0; b < 2; ++b)
#pragma unroll
            for (int m = 0; m < 4; ++m)
#pragma unroll
                for (int n = 0; n < 2; ++n) acc[a][b][m][n] = (f32x4){0.f, 0.f, 0.f, 0.f};
    bf16x8 At[4][2], B0[2][2], B1[2][2]; v8i32 At8[4], B08[2], B18[2];
    int one_scale = 0x7f7f7f7f; asm volatile("" : "+v"(one_scale));
    const char* cA = (const char*)g.A + (size_t)cur.pm * tstep; const char* cB = (const char*)g.Bt + (size_t)cur.pb * tstep;
    PG8_STAGE(PG8_SB(0, 0), cB, voffB); PG8_STAGE(PG8_SA(0, 0), cA, voffA); PG8_STAGE(PG8_SB(0, 1), cB + hstep, voffB); PG8_STAGE(PG8_SA(0, 1), cA + hstep, voffA);
    if (wr == 1) PG8_BAR;
    PG8_WAIT_V(4); PG8_BAR;
    PG8_STAGE(PG8_SB(1, 0), cB + kstep, voffB); PG8_STAGE(PG8_SA(1, 0), cA + kstep, voffA); PG8_STAGE(PG8_SB(1, 1), cB + hstep + kstep, voffB);
    PG8_WAIT_V(6); PG8_BAR;
    for (;;) {
        const bool has_next = S.next(ui + 1, nxt);
        const char* nA = has_next ? (const char*)g.A + (size_t)nxt.pm * tstep : cA; const char* nB = has_next ? (const char*)g.Bt + (size_t)nxt.pb * tstep : cB;
        for (int t = 0; t < nt; t += 2) {
            const bool last = (t == nt - 2);
            const char* a1 = cA + (size_t)(t + 1) * kstep;
            const char* a2 = last ? nA : cA + (size_t)(t + 2) * kstep; const char* b2 = last ? nB : cB + (size_t)(t + 2) * kstep;
            const char* a3 = a2 + kstep; const char* b3 = b2 + kstep;
            PG8_LDB(B0, 0, 0); PG8_SCHED; PG8_LDA(At, 0, 0); PG8_STAGE(PG8_SA(1, 1), a1 + hstep, voffA);
            PG8_WAIT_L(8); PG8_BAR; PG8_WAIT_L(0); PG8_MMA(0, 0, At, B0); PG8_BAR; PG8_SCHED;
            PG8_LDB(B1, 0, 1); PG8_STAGE(PG8_SB(0, 0), b2, voffB);
            PG8_BAR; PG8_WAIT_L(0); PG8_MMA(0, 1, At, B1); PG8_BAR;
            PG8_LDA(At, 0, 1); PG8_STAGE(PG8_SA(0, 0), a2, voffA);
            PG8_BAR; PG8_WAIT_L(0); PG8_MMA(1, 0, At, B0); PG8_BAR; PG8_SCHED;
            PG8_STAGE(PG8_SB(0, 1), b2 + hstep, voffB);
            PG8_WAIT_V(6); PG8_BAR; PG8_MMA(1, 1, At, B1); PG8_BAR;
            PG8_LDB(B0, 1, 0); PG8_SCHED; PG8_LDA(At, 1, 0); PG8_STAGE(PG8_SA(0, 1), a2 + hstep, voffA);
            PG8_WAIT_L(8); PG8_BAR; PG8_WAIT_L(0); PG8_MMA(0, 0, At, B0); PG8_BAR; PG8_SCHED;
            PG8_LDB(B1, 1, 1); PG8_STAGE(PG8_SB(1, 0), b3, voffB);
            PG8_BAR; PG8_WAIT_L(0); PG8_MMA(0, 1, At, B1); PG8_BAR;
            PG8_LDA(At, 1, 1); PG8_STAGE(PG8_SA(1, 0), a3, voffA);
            PG8_BAR; PG8_WAIT_L(0); PG8_MMA(1, 0, At, B0); PG8_BAR; PG8_SCHED;
            PG8_STAGE(PG8_SB(1, 1), b3 + hstep, voffB);
            PG8_WAIT_V(6); PG8_BAR; PG8_MMA(1, 1, At, B1); PG8_BAR;
        }
        if constexpr (FP8) asm volatile("s_nop 15\n\ts_nop 15" ::: "memory");
        E(acc, cur, wr, wc, fr, fq);
        if (!has_next) break;
#pragma unroll
        for (int a = 0; a < 2; ++a)
#pragma unroll
            for (int b = 0; b < 2; ++b)
#pragma unroll
                for (int m = 0; m < 4; ++m)
#pragma unroll
                    for (int n = 0; n < 2; ++n) acc[a][b][m][n] = (f32x4){0.f, 0.f, 0.f, 0.f};
        cur = nxt; cA = nA; cB = nB; ++ui;
    }
    PG8_WAIT_V(0);
    if (wr == 0) PG8_BAR;
    PG8_BAR;
#undef PG8_SA
#undef PG8_SB
#undef PG8_STAGE
#undef PG8_LDA
#undef PG8_LDB
#undef PG8_MMA
#undef PG8_LD8
#undef PG8_WAIT_V
#undef PG8_WAIT_L
#undef PG8_BAR
#undef PG8_SCHED
}

struct EpiQKV {
    static constexpr bool PERM = true;
    bf16_t *Q, *Kk, *V; const float *gq, *gk, *cosT, *sinT; float qscale;
    __device__ __forceinline__ void operator()(const f32x4 (&acc)[2][2][4][2], const Unit& u, int wr, int wc, int fr, int fq) const {
        const int row0 = u.pm * BM + wr * 64 + fr;
        if (u.pn >= 8) {
            const int col0 = (u.pn - 8) * BM + wc * 32 + 8 * fq;
#pragma unroll
            for (int ai = 0; ai < 2; ++ai)
#pragma unroll
                for (int m = 0; m < 4; ++m) { bf16_t* rowp = V + (size_t)(row0 + ai * HALF + m * 16) * DM + col0;
#pragma unroll
                    for (int bj = 0; bj < 2; ++bj) { const f32x4 v0 = acc[ai][bj][m][0], v1 = acc[ai][bj][m][1];
                        u32x4 w; w.x = cvt_pk_bf16(v0[0], v0[1]); w.y = cvt_pk_bf16(v0[2], v0[3]); w.z = cvt_pk_bf16(v1[0], v1[1]); w.w = cvt_pk_bf16(v1[2], v1[3]);
                        *(u32x4*)(rowp + bj * HALF) = w; } }
        } else {
            const int part = u.pn >> 2, sh = 4 * (u.pn & 3) + wc;
            bf16_t* dst = part ? Kk : Q; const float* g = part ? gk : gq; const float sc = part ? 1.0f : qscale;
            f32x4 g0[2], g1[2];
#pragma unroll
            for (int n = 0; n < 2; ++n) { g0[n] = *(const f32x4*)(g + 8 * fq + 4 * n); g1[n] = *(const f32x4*)(g + 32 + 8 * fq + 4 * n); }
#pragma unroll
            for (int ai = 0; ai < 2; ++ai)
#pragma unroll
                for (int m = 0; m < 4; ++m) {
                    const int r = row0 + ai * HALF + m * 16; const int pos = r & (SEQ - 1);
                    f32x4 x1[2], x2[2]; float ss = 0.f;
#pragma unroll
                    for (int n = 0; n < 2; ++n) { x1[n] = acc[ai][0][m][n]; x2[n] = acc[ai][1][m][n];
                        ss += (x1[n][0] * x1[n][0] + x1[n][1] * x1[n][1]) + (x1[n][2] * x1[n][2] + x1[n][3] * x1[n][3]);
                        ss += (x2[n][0] * x2[n][0] + x2[n][1] * x2[n][1]) + (x2[n][2] * x2[n][2] + x2[n][3] * x2[n][3]); }
                    ss += __shfl_xor(ss, 16); ss += __shfl_xor(ss, 32);
                    const float rstd = __builtin_amdgcn_rsqf(ss * (1.0f / 64.0f) + EPS) ;
                    unsigned char* op = (unsigned char*)dst + (size_t)r * DM + sh * 64 + 8 * fq;
                    u32x2 w1, w2;
#pragma unroll
                    for (int n = 0; n < 2; ++n) {
                        const f32x4 cs = *(const f32x4*)(cosT + pos * 32 + 8 * fq + 4 * n), sn = *(const f32x4*)(sinT + pos * 32 + 8 * fq + 4 * n);
                        const f32x4 y1 = x1[n] * rstd * g0[n], y2 = x2[n] * rstd * g1[n];
                        const f32x4 o1 = (y1 * cs - y2 * sn) * sc, o2 = (y2 * cs + y1 * sn) * sc;
                        if (n == 0) { w1.x = pk_fp8x4(o1[0], o1[1], o1[2], o1[3]); w2.x = pk_fp8x4(o2[0], o2[1], o2[2], o2[3]); }
                        else { w1.y = pk_fp8x4(o1[0], o1[1], o1[2], o1[3]); w2.y = pk_fp8x4(o2[0], o2[1], o2[2], o2[3]); }
                    }
                    *(u32x2*)(op) = w1; *(u32x2*)(op + 32) = w2;
                }
        }
    }
};
__device__ __forceinline__ f32x4 ld_x4(const void* p, size_t i, bool is16) {
    if (is16) { const u32x2 w = *(const u32x2*)((const bf16_t*)p + i); return (f32x4){bflo(w.x), bfhi(w.x), bflo(w.y), bfhi(w.y)}; }
    return *(const f32x4*)((const float*)p + i);
}
template <bool IN16>
struct EpiRes {
    static constexpr bool PERM = false;
    const void* xin; bf16_t* xout; const float* gate; float sc;
    __device__ __forceinline__ void operator()(const f32x4 (&acc)[2][2][4][2], const Unit& u, int wr, int wc, int fr, int fq) const {
        const int row0 = u.pm * BM + wr * 64 + fr, col0 = u.pn * BM + wc * 32 + 4 * fq;
        const float* gp = gate + (size_t)(u.pm >> 5) * 6144 + col0;
        f32x4 gv[2][2];
#pragma unroll
        for (int bj = 0; bj < 2; ++bj)
#pragma unroll
            for (int n = 0; n < 2; ++n) gv[bj][n] = *(const f32x4*)(gp + bj * HALF + n * 16) * sc;
#pragma unroll
        for (int ai = 0; ai < 2; ++ai)
#pragma unroll
            for (int m = 0; m < 4; ++m) { const size_t off = (size_t)(row0 + ai * HALF + m * 16) * DM + col0;
                f32x4 xv[2][2];
#pragma unroll
                for (int bj = 0; bj < 2; ++bj)
#pragma unroll
                    for (int n = 0; n < 2; ++n) xv[bj][n] = ld_x4(xin, off + bj * HALF + n * 16, IN16);
#pragma unroll
                for (int bj = 0; bj < 2; ++bj)
#pragma unroll
                    for (int n = 0; n < 2; ++n) { const f32x4 o = xv[bj][n] + gv[bj][n] * acc[ai][bj][m][n];
                        *(u32x2*)(xout + off + bj * HALF + n * 16) = (u32x2){cvt_pk_bf16(o[0], o[1]), cvt_pk_bf16(o[2], o[3])}; }
                if (m == 3) asm volatile("" ::: "memory"); }
    }
};
struct EpiSwiGLU {
    static constexpr bool PERM = true;
    bf16_t* H; int ldh;
    __device__ __forceinline__ void operator()(const f32x4 (&acc)[2][2][4][2], const Unit& u, int wr, int wc, int fr, int fq) const {
        const int row0 = u.pm * BM + wr * 64 + fr, col0 = u.pn * HALF + wc * 32 + 8 * fq;
#pragma unroll
        for (int ai = 0; ai < 2; ++ai)
#pragma unroll
            for (int m = 0; m < 4; ++m) { bf16_t* rowp = H + (size_t)(row0 + ai * HALF + m * 16) * ldh + col0;
                f32x4 v[2];
#pragma unroll
                for (int n = 0; n < 2; ++n) { const f32x4 gt = acc[ai][0][m][n], up = acc[ai][1][m][n];
#pragma unroll
                    for (int j = 0; j < 4; ++j) v[n][j] = fsilu(gt[j]) * up[j]; }
                u32x4 w; w.x = cvt_pk_bf16(v[0][0], v[0][1]); w.y = cvt_pk_bf16(v[0][2], v[0][3]); w.z = cvt_pk_bf16(v[1][0], v[1][1]); w.w = cvt_pk_bf16(v[1][2], v[1][3]);
                *(u32x4*)rowp = w; }
    }
};
struct EpiSwiGLU8 {
    static constexpr bool PERM = true;
    unsigned char* H; int ldh; float ws, hs;
    __device__ __forceinline__ void operator()(const f32x4 (&acc)[2][2][4][2], const Unit& u, int wr, int wc, int fr, int fq) const {
        const int row0 = u.pm * BM + wr * 64 + fr, col0 = u.pn * HALF + wc * 32 + 8 * fq;
#pragma unroll
        for (int ai = 0; ai < 2; ++ai)
#pragma unroll
            for (int m = 0; m < 4; ++m) { unsigned char* rowp = H + (size_t)(row0 + ai * HALF + m * 16) * ldh + col0;
                f32x4 v[2];
#pragma unroll
                for (int n = 0; n < 2; ++n) { const f32x4 gt = acc[ai][0][m][n] * ws, up = acc[ai][1][m][n] * (ws * hs);
#pragma unroll
                    for (int j = 0; j < 4; ++j) v[n][j] = fsilu(gt[j]) * up[j]; }
                *(u32x2*)rowp = (u32x2){pk_fp8x4(v[0][0], v[0][1], v[0][2], v[0][3]), pk_fp8x4(v[1][0], v[1][1], v[1][2], v[1][3])}; }
    }
};
struct EpiPlain {
    static constexpr bool PERM = true;
    bf16_t* O; int ldc; float sc;
    __device__ __forceinline__ void operator()(const f32x4 (&acc)[2][2][4][2], const Unit& u, int wr, int wc, int fr, int fq) const {
        const int row0 = u.pm * BM + wr * 64 + fr, col0 = u.pn * BM + wc * 32 + 8 * fq;
#pragma unroll
        for (int ai = 0; ai < 2; ++ai)
#pragma unroll
            for (int m = 0; m < 4; ++m) { bf16_t* rowp = O + (size_t)(row0 + ai * HALF + m * 16) * ldc + col0;
#pragma unroll
                for (int bj = 0; bj < 2; ++bj) { const f32x4 v0 = acc[ai][bj][m][0] * sc, v1 = acc[ai][bj][m][1] * sc;
                    u32x4 w; w.x = cvt_pk_bf16(v0[0], v0[1]); w.y = cvt_pk_bf16(v0[2], v0[3]); w.z = cvt_pk_bf16(v1[0], v1[1]); w.w = cvt_pk_bf16(v1[2], v1[3]);
                    *(u32x4*)(rowp + bj * HALF) = w; } }
    }
};
struct EpiAct {
    static constexpr bool PERM = true;
    int kind; unsigned char* ws; const float* lb;
    __device__ __forceinline__ void operator()(const f32x4 (&acc)[2][2][4][2], const Unit& u, int wr, int wc, int fr, int fq) const {
        const int row0 = u.pm * BM + wr * 64 + fr;
        int mode, ldc, colt; size_t boff;
        if (kind == 0) { const int grp = u.pn >> 2; colt = (u.pn & 3) * 256; ldc = 1024;
            boff = grp == 0 ? H_Q : grp == 1 ? H_LFF : grp == 2 ? H_LFB : grp == 3 ? H_V : H_G; mode = (grp == 0 || grp == 4) ? 1 : (grp == 3 ? 0 : 3); }
        else { ldc = LRUW; if (u.pn < 5) { boff = L_YB; colt = u.pn * 256; mode = 2; } else { boff = L_XB; colt = (u.pn - 5) * 256; mode = 0; } }
        bf16_t* base = (bf16_t*)(ws + boff);
        const int col0 = colt + wc * 32 + 8 * fq;
        f32x4 lbv[2][2];
        if (mode == 3) { const float* lp = lb + ((u.pn >> 2) - 1) * 1024 + col0;
#pragma unroll
            for (int bj = 0; bj < 2; ++bj)
#pragma unroll
                for (int n = 0; n < 2; ++n) lbv[bj][n] = *(const f32x4*)(lp + bj * HALF + 4 * n); }
#pragma unroll
        for (int ai = 0; ai < 2; ++ai)
#pragma unroll
            for (int m = 0; m < 4; ++m) { bf16_t* rowp = base + (size_t)(row0 + ai * HALF + m * 16) * ldc + col0;
#pragma unroll
                for (int bj = 0; bj < 2; ++bj) { f32x4 v[2]; u32x4 w;
#pragma unroll
                    for (int n = 0; n < 2; ++n) { v[n] = acc[ai][bj][m][n];
                        if (mode == 1) {
#pragma unroll
                            for (int j = 0; j < 4; ++j) v[n][j] = fsilu(v[n][j]); }
                        else if (mode == 2) {
#pragma unroll
                            for (int j = 0; j < 4; ++j) { const float x = v[n][j]; v[n][j] = x * fsigmoid(1.5957691216057308f * (x + 0.044715f * x * x * x)); } }
                        else if (mode == 3) {
#pragma unroll
                            for (int j = 0; j < 4; ++j) { const float l = lbv[bj][n][j]; const float fg = l + (1.0f - l) * fsigmoid(v[n][j]); v[n][j] = __builtin_amdgcn_logf(fg) * 0.6931471805599453f; } }
                    }
                    if (mode == 3) {
#pragma unroll
                        for (int n = 0; n < 2; ++n) { const _Float16 h0 = (_Float16)v[n][0], h1 = (_Float16)v[n][1], h2 = (_Float16)v[n][2], h3 = (_Float16)v[n][3];
                            const unsigned a = (unsigned)__builtin_bit_cast(unsigned short, h0) | ((unsigned)__builtin_bit_cast(unsigned short, h1) << 16);
                            const unsigned b = (unsigned)__builtin_bit_cast(unsigned short, h2) | ((unsigned)__builtin_bit_cast(unsigned short, h3) << 16);
                            if (n == 0) { w.x = a; w.y = b; } else { w.z = a; w.w = b; } }
                    } else { w.x = cvt_pk_bf16(v[0][0], v[0][1]); w.y = cvt_pk_bf16(v[0][2], v[0][3]); w.z = cvt_pk_bf16(v[1][0], v[1][1]); w.w = cvt_pk_bf16(v[1][2], v[1][3]); }
                    *(u32x4*)(rowp + bj * HALF) = w; } }
    }
};
}

struct Args { const float* in[30]; float* out; unsigned char* ws; };
enum { I_X = 0, I_C, I_ADAW, I_ADAB, I_N1G, I_N2G, I_ATWIN, I_ATQN, I_ATKN, I_ATLAM, I_ATSUB, I_ATWOUT, I_HGWIN, I_HGLB, I_HGNG, I_HGWOUT,
       I_LRWIN, I_LRCW, I_LRCB, I_LRWA, I_LRBA, I_LRWX, I_LRBX, I_LRLAM, I_LRWOUT, I_FFGU, I_FFDN, I_MOER, I_MOEGU, I_MOEDN };
enum { SC_LAM0 = 0, SC_LAM1, SC_OML0, SC_OML1, SC_MC0, SC_MC1 };

__device__ __forceinline__ void cvt_item(const float* W, int ldw, int src_col0, bf16_t* WT, int ldt, int dst_row0, int k0, LAS float* scr, int lane) {
#pragma unroll 8
    for (int i = 0; i < 32; ++i) { const int kk = 2 * i + (lane >> 5); scr[kk * 33 + (lane & 31)] = W[(size_t)(k0 + kk) * ldw + src_col0 + (lane & 31)]; }
    LDS_WAIT(); asm volatile("" ::: "memory");
    const int c = lane & 7;
#pragma unroll
    for (int j = 0; j < 4; ++j) { const int n = (lane >> 3) + 8 * j; const LAS float* s = scr + (8 * c) * 33 + n;
        u32x4 o; o.x = cvt_pk_bf16(s[0 * 33], s[1 * 33]); o.y = cvt_pk_bf16(s[2 * 33], s[3 * 33]); o.z = cvt_pk_bf16(s[4 * 33], s[5 * 33]); o.w = cvt_pk_bf16(s[6 * 33], s[7 * 33]);
        *(u32x4*)(WT + (size_t)(dst_row0 + n) * ldt + k0 + 8 * c) = o; }
    LDS_WAIT(); asm volatile("" ::: "memory");
}
__device__ __forceinline__ void cvt_item8(const float* W, int ldw, int src_col0, unsigned char* WT, int ldt, int dst_row0, int k0, float sc, LAS float* scr, int lane) {
#pragma unroll 8
    for (int i = 0; i < 32; ++i) { const int kk = 2 * i + (lane >> 5); scr[kk * 33 + (lane & 31)] = W[(size_t)(k0 + kk) * ldw + src_col0 + (lane & 31)]; }
    LDS_WAIT(); asm volatile("" ::: "memory");
    const int c = lane & 7;
#pragma unroll
    for (int j = 0; j < 4; ++j) { const int n = (lane >> 3) + 8 * j; const LAS float* s = scr + (8 * c) * 33 + n;
        *(u32x2*)(WT + (size_t)(dst_row0 + n) * ldt + k0 + 8 * c) = (u32x2){pk_fp8x4(s[0 * 33] * sc, s[1 * 33] * sc, s[2 * 33] * sc, s[3 * 33] * sc), pk_fp8x4(s[4 * 33] * sc, s[5 * 33] * sc, s[6 * 33] * sc, s[7 * 33] * sc)}; }
    LDS_WAIT(); asm volatile("" ::: "memory");
}
enum { MAP_ID = 0, MAP_QKV = 1, MAP_SWI = 2 };
template <bool F8 = false>
__device__ __forceinline__ void cvt_family(const float* src, size_t sstride, int ninst, int ldw, int K, int ng, int map, int F, bf16_t* dst, size_t dstride,
                                           LAS float* scr, int gw, int NGW, int lane) {
    const int nkb = K / 64, per = nkb * ng, total = ninst * per;
    for (int it = gw; it < total; it += NGW) {
        const int inst = it / per, r = it - inst * per, kb = r / ng, gi = r - kb * ng;
        int sc0;
        if (map == MAP_ID) sc0 = 32 * gi;
        else if (map == MAP_QKV) { const int pn = gi >> 3, bj = (gi >> 2) & 1, wc = gi & 3;
            if (pn < 8) { const int part = pn >> 2, sh = 4 * (pn & 3) + wc; sc0 = part * 1024 + sh * 64 + 32 * bj; } else sc0 = 32 * gi; }
        else { const int pn = gi >> 3, bj = (gi >> 2) & 1, q = gi & 3; sc0 = bj * F + pn * 128 + 32 * q; }
        if constexpr (F8) cvt_item8(src + (size_t)inst * sstride, ldw, sc0, (unsigned char*)dst + (size_t)inst * dstride, K, 32 * gi, 64 * kb, MOE_WSCALE, scr, lane);
        else cvt_item(src + (size_t)inst * sstride, ldw, sc0, dst + (size_t)inst * dstride, K, 32 * gi, 64 * kb, scr, lane);
    }
}

__device__ __forceinline__ void prologue_phase(const Args& A, LAS unsigned char* lds, int bid, int G) {
    const int tid = threadIdx.x, lane = tid & 63, wave = tid >> 6;
    unsigned char* ws = A.ws;
    {
        LAS float* sc = (LAS float*)lds;
        LAS float* red = (LAS float*)(lds + 32768);
        for (int i = tid; i < NBATCH * DM; i += NTHR) { const float cv = A.in[I_C][i]; sc[i] = fsilu(cv); }
        __syncthreads();
        float* mods = (float*)(ws + TB_MODS);
        for (int cb = bid; cb < (DEPTH * 6144) / 128; cb += G) {
            const int col = cb * 128 + (tid & 127), l = col / 6144, e = col - l * 6144, ch = tid >> 7;
            const float* wp = A.in[I_ADAW] + (size_t)l * DM * 6144 + e;
            float a[NBATCH];
#pragma unroll
            for (int b = 0; b < NBATCH; ++b) a[b] = 0.f;
#pragma unroll 4
            for (int d = ch * 256; d < ch * 256 + 256; ++d) { const float w = wp[(size_t)d * 6144];
#pragma unroll
                for (int b = 0; b < NBATCH; ++b) a[b] += sc[b * DM + d] * w; }
#pragma unroll
            for (int b = 0; b < NBATCH; ++b) red[(ch * 128 + (tid & 127)) * 8 + b] = a[b];
            __syncthreads();
            if (tid < 128) { const float bias = A.in[I_ADAB][l * 6144 + e];
#pragma unroll
                for (int b = 0; b < NBATCH; ++b) { const float s = ((red[(0 * 128 + tid) * 8 + b] + red[(1 * 128 + tid) * 8 + b]) + (red[(2 * 128 + tid) * 8 + b] + red[(3 * 128 + tid) * 8 + b])) + bias;
                    mods[((size_t)l * NBATCH + b) * 6144 + e] = s; } }
            __syncthreads();
        }
    }
    {
        float* cosT = (float*)(ws + TB_COS); float* sinT = (float*)(ws + TB_SIN);
        for (int i = bid * NTHR + tid; i < SEQ * 32; i += G * NTHR) {
            const int pos = i >> 5, d = i & 31;
            const float inv = (float)exp(-(double)d * (1.0 / 32.0) * 9.210340371976184);
            const float ang = (float)pos * inv;
            const double rev = (double)ang * 0.15915494309189535; const float fr = (float)(rev - floor(rev));
            cosT[i] = __builtin_amdgcn_cosf(fr); sinT[i] = __builtin_amdgcn_sinf(fr);
        }
        if (bid == 0 && tid < 2) {
            const int a = tid; const float* lm = A.in[I_ATLAM] + a * 256;
            float s1 = 0.f, s2 = 0.f; for (int i = 0; i < 64; ++i) { s1 += lm[i] * lm[64 + i]; s2 += lm[128 + i] * lm[192 + i]; }
            const float linit = 0.8f - 0.6f * expf(-0.3f * (float)(3 * a));
            float mq = 0.f, mk = 0.f; for (int i = 0; i < 64; ++i) { mq = fmaxf(mq, fabsf(A.in[I_ATQN][a * 64 + i])); mk = fmaxf(mk, fabsf(A.in[I_ATKN][a * 64 + i])); }
            float* scal = (float*)(ws + TB_SCAL);
            scal[SC_LAM0 + a] = expf(s1) - expf(s2) + linit; scal[SC_OML0 + a] = 1.0f - linit; scal[SC_MC0 + a] = 8.0f * mq * mk * LOG2E * 1.0001f;
        }
        if (bid == 1) {
            float* lb = (float*)(ws + TB_LB);
            for (int i = tid; i < 2 * 1024; i += NTHR) { const int d = i >> 10, k = i & 1023; const float* p = A.in[I_HGLB] + (size_t)d * DEPTH * 1024 + k;
                float mx = p[0]; for (int l = 1; l < DEPTH; ++l) mx = fmaxf(mx, p[l * 1024]);
                float den = 0.f, num = 0.f; for (int l = 0; l < DEPTH; ++l) { const float e = expf(p[l * 1024] - mx); den += e; if (l == 1) num += e; }
                lb[i] = num / den; }
        }
        if (bid == 2) {
            float* sp = (float*)(ws + TB_SP);
            for (int i = tid; i < 2 * LRUW; i += NTHR) { const float x = -A.in[I_LRLAM][i]; sp[i] = (x > 20.f) ? x : log1pf(expf(x)); }
        }
    }
    {
        LAS float* scr = (LAS float*)(lds + wave * 16384);
        const int vcu = (bid % 8) * (G / 8) + bid / 8;
        const int gw = vcu * NWAVES + wave, NGW = G * NWAVES;
        cvt_family(A.in[I_ATWIN], (size_t)1024 * 3072, 2, 3072, 1024, 96, MAP_QKV, 0, (bf16_t*)(ws + W_QKV), (size_t)3072 * 1024, scr, gw, NGW, lane);
        cvt_family(A.in[I_ATWOUT], (size_t)1024 * 1024, 2, 1024, 1024, 32, MAP_ID, 0, (bf16_t*)(ws + W_AO), (size_t)1024 * 1024, scr, gw, NGW, lane);
        cvt_family(A.in[I_HGWIN], 0, 1, 5120, 1024, 160, MAP_ID, 0, (bf16_t*)(ws + W_HGI), 0, scr, gw, NGW, lane);
        cvt_family(A.in[I_HGWOUT], 0, 1, 1024, 1024, 32, MAP_ID, 0, (bf16_t*)(ws + W_HGO), 0, scr, gw, NGW, lane);
        cvt_family(A.in[I_LRWIN], 0, 1, 2560, 1024, 80, MAP_ID, 0, (bf16_t*)(ws + W_LRI), 0, scr, gw, NGW, lane);
        cvt_family(A.in[I_LRWOUT], 0, 1, 1024, 1280, 32, MAP_ID, 0, (bf16_t*)(ws + W_LRO), 0, scr, gw, NGW, lane);
        for (int it = gw; it < 2 * 20 * 2 * 4; it += NGW) {
            const int part = it / 160, r = it % 160, inst = r >> 3, kb = (r >> 2) & 1, gi = r & 3, d = inst / 10, n = inst % 10;
            const float* src = (part ? A.in[I_LRWX] : A.in[I_LRWA]) + (size_t)inst * 16384;
            cvt_item(src, 128, 32 * gi, (bf16_t*)(ws + W_LRG) + (size_t)(n * 2 + d) * 256 * 128, 128, part * 128 + 32 * gi, 64 * kb, scr, lane);
        }
        static_assert(FP8_DENSE_FROM == 2 || FP8_DENSE_FROM > 3, "dense layer 0 stays bf16; layer 2 optional");
        constexpr int NB16 = (FP8_DENSE_FROM == 2) ? 1 : 2;
        cvt_family(A.in[I_FFGU], (size_t)1024 * 5632, NB16, 5632, 1024, 176, MAP_SWI, DFF, (bf16_t*)(ws + W_FGU), (size_t)5632 * 1024, scr, gw, NGW, lane);
        cvt_family(A.in[I_FFDN], (size_t)2816 * 1024, NB16, 1024, 2816, 32, MAP_ID, 0, (bf16_t*)(ws + W_FDN), (size_t)1024 * 2816, scr, gw, NGW, lane);
        if constexpr (NB16 == 1) {
            cvt_family<true>(A.in[I_FFGU] + (size_t)1024 * 5632, 0, 1, 5632, 1024, 176, MAP_SWI, DFF, (bf16_t*)(ws + W_FGU) + (size_t)5632 * 1024, 0, scr, gw, NGW, lane);
            cvt_family<true>(A.in[I_FFDN] + (size_t)2816 * 1024, 0, 1, 1024, 2816, 32, MAP_ID, 0, (bf16_t*)(ws + W_FDN) + (size_t)1024 * 2816, 0, scr, gw, NGW, lane);
        }
        cvt_family<true>(A.in[I_MOEGU], (size_t)1024 * 7168, 16, 7168, 1024, 224, MAP_SWI, DFFE, (bf16_t*)(ws + W_MGU), (size_t)7168 * 1024, scr, gw, NGW, lane);
        cvt_family<true>(A.in[I_MOEDN], (size_t)3584 * 1024, 16, 1024, 3584, 32, MAP_ID, 0, (bf16_t*)(ws + W_MDN), (size_t)1024 * 3584, scr, gw, NGW, lane);
    }
}

template <bool ROUTER>
__device__ __forceinline__ void norm_phase(const Args& A, LAS unsigned char* lds, int bid, int G, const void* xsrc, bool src16, void* xdst, bool dst16, const float* gain, const float* modl  , int which,
                                           bool combine, const float* modprev  , bool nonorm, const float* router, bool f8out = false) {
    int tid_ = threadIdx.x; asm volatile("" : "+v"(tid_));
    const int tid = tid_, lane = tid & 63, wave = tid >> 6;
    unsigned char* ws = A.ws;
    bf16_t* HM = (bf16_t*)(ws + WS_HM);
    const int* slot = (const int*)(ws + TB_SLOT); const float* gts = (const float*)(ws + TB_GATE);
    const bf16_t* Y = (const bf16_t*)(ws + E_XS);
    LAS int* hist = (LAS int*)lds;
    for (int tb = bid; tb < MTOK / 256; tb += G) {
        const int b = tb >> 5;
        f32x4 ga[4], sh[4], g2[4];
#pragma unroll
        for (int j = 0; j < 4; ++j) { const int c = 256 * j + 4 * lane;
            if (!nonorm) { const f32x4 gv = *(const f32x4*)(gain + c), sv = *(const f32x4*)(modl + (size_t)b * 6144 + (which * 3 + 1) * 1024 + c);
                ga[j] = gv * (sv + 1.0f); sh[j] = *(const f32x4*)(modl + (size_t)b * 6144 + (which * 3) * 1024 + c); }
            if (combine) g2[j] = *(const f32x4*)(modprev + (size_t)b * 6144 + 5 * 1024 + c); }
        f32x4 rw[ROUTER ? 32 : 1];
        if constexpr (ROUTER) {
            if (tid < 8) hist[tid] = 0;
#pragma unroll
            for (int j = 0; j < 4; ++j)
#pragma unroll
                for (int i = 0; i < 4; ++i) { const int c = 256 * j + 4 * lane + i; rw[(j * 4 + i) * 2] = *(const f32x4*)(router + c * 8); rw[(j * 4 + i) * 2 + 1] = *(const f32x4*)(router + c * 8 + 4); }
            __syncthreads();
        }
        for (int i = 0; i < 32; ++i) {
            const int row = tb * 256 + wave * 32 + i;
            f32x4 v[4];
#pragma unroll
            for (int j = 0; j < 4; ++j) v[j] = pg8::ld_x4(xsrc, (size_t)row * DM + 256 * j + 4 * lane, src16);
            if (combine) {
                const int s0 = slot[row * 2], s1 = slot[row * 2 + 1]; const float w0 = gts[row * 2], w1 = gts[row * 2 + 1];
#pragma unroll
                for (int j = 0; j < 4; ++j) { const u32x2 a = *(const u32x2*)(Y + (size_t)s0 * DM + 256 * j + 4 * lane), c2 = *(const u32x2*)(Y + (size_t)s1 * DM + 256 * j + 4 * lane);
                    f32x4 y; y[0] = w0 * bflo(a.x) + w1 * bflo(c2.x); y[1] = w0 * bfhi(a.x) + w1 * bfhi(c2.x); y[2] = w0 * bflo(a.y) + w1 * bflo(c2.y); y[3] = w0 * bfhi(a.y) + w1 * bfhi(c2.y);
                    v[j] = v[j] + g2[j] * y;
                    if (dst16) *(u32x2*)((bf16_t*)xdst + (size_t)row * DM + 256 * j + 4 * lane) = (u32x2){cvt_pk_bf16(v[j][0], v[j][1]), cvt_pk_bf16(v[j][2], v[j][3])};
                    else *(f32x4*)((float*)xdst + (size_t)row * DM + 256 * j + 4 * lane) = v[j]; }
            }
            if (nonorm) continue;
            float ss = 0.f;
#pragma unroll
            for (int j = 0; j < 4; ++j) ss += (v[j][0] * v[j][0] + v[j][1] * v[j][1]) + (v[j][2] * v[j][2] + v[j][3] * v[j][3]);
            ss = wave_sum(ss);
            const float rstd = 1.0f / sqrtf(ss * (1.0f / DM) + EPS);
            f32x4 h[4];
#pragma unroll
            for (int j = 0; j < 4; ++j) { h[j] = v[j] * rstd * ga[j] + sh[j];
                if (f8out) { *(unsigned*)((unsigned char*)HM + (size_t)row * DM + 256 * j + 4 * lane) = pk_fp8x4(h[j][0], h[j][1], h[j][2], h[j][3]); }
                else { u32x2 w; w.x = cvt_pk_bf16(h[j][0], h[j][1]); w.y = cvt_pk_bf16(h[j][2], h[j][3]);
                    *(u32x2*)(HM + (size_t)row * DM + 256 * j + 4 * lane) = w; } }
            if constexpr (ROUTER) {
                float lg[8];
#pragma unroll
                for (int e = 0; e < 8; ++e) lg[e] = 0.f;
#pragma unroll
                for (int j = 0; j < 4; ++j)
#pragma unroll
                    for (int q = 0; q < 4; ++q) { const float hv = h[j][q]; const f32x4 r0 = rw[(j * 4 + q) * 2], r1 = rw[(j * 4 + q) * 2 + 1];
                        lg[0] += hv * r0[0]; lg[1] += hv * r0[1]; lg[2] += hv * r0[2]; lg[3] += hv * r0[3]; lg[4] += hv * r1[0]; lg[5] += hv * r1[1]; lg[6] += hv * r1[2]; lg[7] += hv * r1[3]; }
#pragma unroll
                for (int e = 0; e < 8; ++e) lg[e] = wave_sum(lg[e]);
                int e0 = 0; float v0 = lg[0];
#pragma unroll
                for (int e = 1; e < 8; ++e) if (lg[e] > v0) { v0 = lg[e]; e0 = e; }
                int e1 = -1; float v1 = -3.0e38f;
#pragma unroll
                for (int e = 0; e < 8; ++e) if (e != e0 && lg[e] > v1) { v1 = lg[e]; e1 = e; }
                const float p1 = frcp(1.0f + fexp(v1 - v0));
                if (lane == 0) { int* eid = (int*)(ws + TB_EID); float* gt = (float*)(ws + TB_GATE);
                    eid[row * 2] = e0; eid[row * 2 + 1] = e1; gt[row * 2] = p1; gt[row * 2 + 1] = 1.0f - p1;
                    atomicAdd((int*)&hist[e0], 1); atomicAdd((int*)&hist[e1], 1); }
            }
        }
        if constexpr (ROUTER) {
            __syncthreads();
            if (tid < 8) ((int*)(ws + TB_BCNT))[tb * 8 + tid] = hist[tid];
            __syncthreads();
        }
    }
}

namespace lru {
constexpr int XCF = 0, XCB = 16384, AA = 24576, UU = 40960, LAA = 57344;
__device__ __forceinline__ int sw256(int row, int cb) { return row * 256 + (cb ^ ((row & 15) << 4)); }
__device__ __forceinline__ int crow(int r, int hi) { return (r & 3) + 8 * (r >> 2) + 4 * hi; }
template <int MODE>
__device__ __forceinline__ void lru_item(const Args& A, LAS unsigned char* lds, int b, int n, int seg, int dir) {
    int tid_ = threadIdx.x; asm volatile("" : "+v"(tid_));
    const int tid = tid_, wid = tid >> 6, lane = tid & 63, r = lane & 31, hh = lane >> 5;
    unsigned char* ws = A.ws;
    const bf16_t* XB = (const bf16_t*)(ws + L_XB); const bf16_t* YB = (const bf16_t*)(ws + L_YB); bf16_t* HF = (bf16_t*)(ws + L_HF); bf16_t* HY = (bf16_t*)(ws + L_HY);
    bf16_t* LAg = (bf16_t*)(ws + (dir ? L_HY : L_HF)); bf16_t* Ug = (bf16_t*)(ws + L_U + (size_t)dir * SZ_LRU);
    const int ct = tid >> 4, cg = tid & 15, cc0 = n * 128 + 8 * cg;
    float carry = 0.f, P = 1.f;
    if (MODE != 0 && tid < 128) carry = ((const float*)(ws + TB_LCIN))[(size_t)((b * 32 + seg) * 2 + dir) * LRUW + n * 128 + tid];
    if constexpr (MODE == 0) {
        const bf16_t* Wg = (const bf16_t*)(ws + W_LRG) + (size_t)((n * 2 + dir) * 256 + ((r < 16) ? (16 * wid + r) : (128 + 16 * wid + r - 16))) * 128 + 8 * hh;
        bf16x8 bfrag[8];
#pragma unroll
        for (int ks = 0; ks < 8; ++ks) bfrag[ks] = *(const bf16x8*)(Wg + 16 * ks);
        const int cch = n * 128 + 16 * wid + (r & 15);
        const float nba = -LOG2E * A.in[I_LRBA][dir * LRUW + cch], nbx = -LOG2E * A.in[I_LRBX][dir * LRUW + cch], csp = -8.0f * LOG2E * ((const float*)(ws + TB_SP))[dir * LRUW + cch];
        float cw[4][8], cb[8];
#pragma unroll
        for (int j = 0; j < 8; ++j) { cb[j] = A.in[I_LRCB][cc0 + j];
#pragma unroll
            for (int w = 0; w < 4; ++w) cw[w][j] = A.in[I_LRCW][w * LRUW + cc0 + j]; }
        u32x4 xr[4];
#define LRU_XLOAD(si_) do { const int sub_ = dir ? (7 - (si_)) : (si_); const int tok_ = seg * 256 + sub_ * 32 + ct; \
        _Pragma("unroll") for (int w = 0; w < 4; ++w) { const int tt = tok_ - 1 + w; xr[w] = (tt >= 0 && tt < SEQ) ? *(const u32x4*)(XB + ((size_t)b * SEQ + tt) * LRUW + cc0) : (u32x4){0u, 0u, 0u, 0u}; } } while (0)
        LRU_XLOAD(0);
        for (int si = 0; si < 8; ++si) {
            const int sub = dir ? (7 - si) : si; const int t0 = seg * 256 + sub * 32;
            {
                float xc[8];
#pragma unroll
                for (int j = 0; j < 8; ++j) xc[j] = cb[j];
#pragma unroll
                for (int w = 0; w < 4; ++w) { const u32x4 v = xr[w];
#pragma unroll
                    for (int e = 0; e < 4; ++e) { xc[2 * e] += cw[w][2 * e] * bflo(v[e]); xc[2 * e + 1] += cw[w][2 * e + 1] * bfhi(v[e]); } }
                if (si + 1 < 8) LRU_XLOAD(si + 1);
                *(LAS f32x4*)(lds + XCF + (ct * 128 + 8 * cg) * 4) = (f32x4){xc[0], xc[1], xc[2], xc[3]};
                *(LAS f32x4*)(lds + XCF + (ct * 128 + 8 * cg + 4) * 4) = (f32x4){xc[4], xc[5], xc[6], xc[7]};
                *(LAS u32x4*)(lds + XCB + sw256(ct, 16 * cg)) = (u32x4){cvt_pk_bf16(xc[0], xc[1]), cvt_pk_bf16(xc[2], xc[3]), cvt_pk_bf16(xc[4], xc[5]), cvt_pk_bf16(xc[6], xc[7])};
            }
            __syncthreads();
            {
                f32x16 acc = {};
#pragma unroll
                for (int ks = 0; ks < 8; ++ks) { const bf16x8 fa = *(const LAS bf16x8*)(lds + XCB + sw256(r, (16 * ks + 8 * hh) * 2)); acc = __builtin_amdgcn_mfma_f32_32x32x16_bf16(fa, bfrag[ks], acc, 0, 0, 0); }
#pragma unroll
                for (int q = 0; q < 8; ++q) {
                    const auto sw = __builtin_amdgcn_permlane16_swap(__float_as_uint(acc[q]), __float_as_uint(acc[8 + q]), false, false);
                    const float rp = __uint_as_float(sw[0]), ip = __uint_as_float(sw[1]);
                    const int tq = crow((r < 16) ? q : (8 + q), hh); const int cl = 16 * wid + (r & 15);
                    const float xcv = ((const LAS float*)(lds + XCF))[tq * 128 + cl];
                    const float rg = frcp(1.0f + fexp2(fmaf(rp, -LOG2E, nba))), ig = frcp(1.0f + fexp2(fmaf(ip, -LOG2E, nbx)));
                    const float la = csp * rg, av = fexp2(la), uv = __builtin_amdgcn_sqrtf(fmaxf(fmaf(-av, av, 1.0f), 0.f)) * ig * xcv;
                    ((LAS float*)(lds + AA))[tq * 128 + cl] = av; ((LAS float*)(lds + UU))[tq * 128 + cl] = uv; ((LAS float*)(lds + LAA))[tq * 128 + cl] = la; }
            }
            __syncthreads();
            if (tid < 128) {
                LAS float* ap = (LAS float*)(lds + AA) + tid; LAS float* up = (LAS float*)(lds + UU) + tid; float av[32], uv[32];
#pragma unroll
                for (int i = 0; i < 32; ++i) { av[i] = ap[i * 128]; uv[i] = up[i * 128]; }
                if (dir == 0) {
#pragma unroll
                    for (int i = 0; i < 32; ++i) { carry = av[i] * carry + uv[i]; P *= av[i]; } }
                else {
#pragma unroll
                    for (int i = 31; i >= 0; --i) { carry = av[i] * carry + uv[i]; P *= av[i]; } }
            } else if (tid >= 256) {
                const int t2 = tid - 256, row = t2 >> 3, c16 = (t2 & 7) * 16; const size_t go = ((size_t)b * SEQ + t0 + row) * LRUW + n * 128 + c16;
                const LAS float* lp = (const LAS float*)(lds + LAA) + row * 128 + c16; const LAS float* up = (const LAS float*)(lds + UU) + row * 128 + c16;
                f32x4 l[4], u[4];
#pragma unroll
                for (int j = 0; j < 4; ++j) { l[j] = *(const LAS f32x4*)(lp + 4 * j); u[j] = *(const LAS f32x4*)(up + 4 * j); }
#pragma unroll
                for (int j = 0; j < 2; ++j) {
                    *(u32x4*)(LAg + go + 8 * j) = (u32x4){cvt_pk_bf16(l[2 * j][0], l[2 * j][1]), cvt_pk_bf16(l[2 * j][2], l[2 * j][3]), cvt_pk_bf16(l[2 * j + 1][0], l[2 * j + 1][1]), cvt_pk_bf16(l[2 * j + 1][2], l[2 * j + 1][3])};
                    *(u32x4*)(Ug + go + 8 * j) = (u32x4){cvt_pk_bf16(u[2 * j][0], u[2 * j][1]), cvt_pk_bf16(u[2 * j][2], u[2 * j][3]), cvt_pk_bf16(u[2 * j + 1][0], u[2 * j + 1][1]), cvt_pk_bf16(u[2 * j + 1][2], u[2 * j + 1][3])}; }
            }
            __syncthreads();
        }
#undef LRU_XLOAD
        if (tid < 128) { float* sm = (float*)(ws + TB_LSUM) + (size_t)(((b * 32 + seg) * 2 + dir) * 2) * LRUW + n * 128 + tid; sm[0] = P; sm[LRUW] = carry; }
    } else {
        u32x4 lr, ur;
#define LRU_GLOAD(si_) do { const int sub_ = dir ? (7 - (si_)) : (si_); const size_t go_ = ((size_t)b * SEQ + seg * 256 + sub_ * 32 + ct) * LRUW + cc0; \
        lr = *(const u32x4*)(LAg + go_); ur = *(const u32x4*)(Ug + go_); } while (0)
        LRU_GLOAD(0);
        for (int si = 0; si < 8; ++si) {
            const int sub = dir ? (7 - si) : si; const int t0 = seg * 256 + sub * 32;
            {   const u32x4 l = lr, u = ur;
                if (si + 1 < 8) LRU_GLOAD(si + 1);
                *(LAS f32x4*)(lds + AA + (ct * 128 + 8 * cg) * 4) = (f32x4){fexp2(bflo(l[0])), fexp2(bfhi(l[0])), fexp2(bflo(l[1])), fexp2(bfhi(l[1]))};
                *(LAS f32x4*)(lds + AA + (ct * 128 + 8 * cg + 4) * 4) = (f32x4){fexp2(bflo(l[2])), fexp2(bfhi(l[2])), fexp2(bflo(l[3])), fexp2(bfhi(l[3]))};
                *(LAS f32x4*)(lds + UU + (ct * 128 + 8 * cg) * 4) = (f32x4){bflo(u[0]), bfhi(u[0]), bflo(u[1]), bfhi(u[1])};
                *(LAS f32x4*)(lds + UU + (ct * 128 + 8 * cg + 4) * 4) = (f32x4){bflo(u[2]), bfhi(u[2]), bflo(u[3]), bfhi(u[3])}; }
            __syncthreads();
            if (tid < 128) {
                LAS float* ap = (LAS float*)(lds + AA) + tid; LAS float* up = (LAS float*)(lds + UU) + tid; float av[32], uv[32];
#pragma unroll
                for (int i = 0; i < 32; ++i) { av[i] = ap[i * 128]; uv[i] = up[i * 128]; }
                if (dir == 0) {
#pragma unroll
                    for (int i = 0; i < 32; ++i) { carry = av[i] * carry + uv[i]; uv[i] = carry; } }
                else {
#pragma unroll
                    for (int i = 31; i >= 0; --i) { carry = av[i] * carry + uv[i]; uv[i] = carry; } }
#pragma unroll
                for (int i = 0; i < 32; ++i) up[i * 128] = uv[i];
            }
            __syncthreads();
            {   const int tok = t0 + ct; const size_t go = ((size_t)b * SEQ + tok) * LRUW + cc0;
                const f32x4 h0 = *(const LAS f32x4*)(lds + UU + (ct * 128 + 8 * cg) * 4), h1 = *(const LAS f32x4*)(lds + UU + (ct * 128 + 8 * cg + 4) * 4);
                if (MODE == 1) { *(u32x4*)(HF + go) = (u32x4){cvt_pk_bf16(h0[0], h0[1]), cvt_pk_bf16(h0[2], h0[3]), cvt_pk_bf16(h1[0], h1[1]), cvt_pk_bf16(h1[2], h1[3])}; }
                else { const u32x4 f = *(const u32x4*)(HF + go), y = *(const u32x4*)(YB + go);
                    *(u32x4*)(HY + go) = (u32x4){cvt_pk_bf16((h0[0] + bflo(f[0])) * bflo(y[0]), (h0[1] + bfhi(f[0])) * bfhi(y[0])), cvt_pk_bf16((h0[2] + bflo(f[1])) * bflo(y[1]), (h0[3] + bfhi(f[1])) * bfhi(y[1])),
                                                cvt_pk_bf16((h1[0] + bflo(f[2])) * bflo(y[2]), (h1[1] + bfhi(f[2])) * bfhi(y[2])), cvt_pk_bf16((h1[2] + bflo(f[3])) * bflo(y[3]), (h1[3] + bfhi(f[3])) * bfhi(y[3]))}; }
            }
            __syncthreads();
        }
#undef LRU_GLOAD
    }
}
__device__ __forceinline__ void lru_apply_item(const Args& A, LAS unsigned char* lds, int b, int n, int seg) {
    constexpr int HFL = 57344;
    int tid_ = threadIdx.x; asm volatile("" : "+v"(tid_));
    const int tid = tid_;
    unsigned char* ws = A.ws;
    const bf16_t* YB = (const bf16_t*)(ws + L_YB); bf16_t* HY = (bf16_t*)(ws + L_HY);
    const int ct = tid >> 4, cg = tid & 15, cc0 = n * 128 + 8 * cg;
#pragma unroll 1
    for (int dir = 0; dir < 2; ++dir) {
        const bf16_t* LAg = (const bf16_t*)(ws + (dir ? L_HY : L_HF)); const bf16_t* Ug = (const bf16_t*)(ws + L_U + (size_t)dir * SZ_LRU);
        float carry = 0.f;
        if (tid < 128) carry = ((const float*)(ws + TB_LCIN))[(size_t)((b * 32 + seg) * 2 + dir) * LRUW + n * 128 + tid];
        u32x4 lr, ur, yr = {0u, 0u, 0u, 0u};
#define LRU_GLOAD(si_) do { const int sub_ = dir ? (7 - (si_)) : (si_); const size_t go_ = ((size_t)b * SEQ + seg * 256 + sub_ * 32 + ct) * LRUW + cc0; \
        lr = *(const u32x4*)(LAg + go_); ur = *(const u32x4*)(Ug + go_); if (dir) yr = *(const u32x4*)(YB + go_); } while (0)
        LRU_GLOAD(0);
        for (int si = 0; si < 8; ++si) {
            const int sub = dir ? (7 - si) : si; const int t0 = seg * 256 + sub * 32;
            const u32x4 l = lr, u = ur, y = yr;
            if (si + 1 < 8) LRU_GLOAD(si + 1);
            *(LAS f32x4*)(lds + AA + (ct * 128 + 8 * cg) * 4) = (f32x4){fexp2(bflo(l[0])), fexp2(bfhi(l[0])), fexp2(bflo(l[1])), fexp2(bfhi(l[1]))};
            *(LAS f32x4*)(lds + AA + (ct * 128 + 8 * cg + 4) * 4) = (f32x4){fexp2(bflo(l[2])), fexp2(bfhi(l[2])), fexp2(bflo(l[3])), fexp2(bfhi(l[3]))};
            *(LAS f32x4*)(lds + UU + (ct * 128 + 8 * cg) * 4) = (f32x4){bflo(u[0]), bfhi(u[0]), bflo(u[1]), bfhi(u[1])};
            *(LAS f32x4*)(lds + UU + (ct * 128 + 8 * cg + 4) * 4) = (f32x4){bflo(u[2]), bfhi(u[2]), bflo(u[3]), bfhi(u[3])};
            __syncthreads();
            if (tid < 128) {
                LAS float* ap = (LAS float*)(lds + AA) + tid; LAS float* up = (LAS float*)(lds + UU) + tid; float av[32], uv[32];
#pragma unroll
                for (int i = 0; i < 32; ++i) { av[i] = ap[i * 128]; uv[i] = up[i * 128]; }
                if (dir == 0) {
#pragma unroll
                    for (int i = 0; i < 32; ++i) { carry = av[i] * carry + uv[i]; uv[i] = carry; } }
                else {
#pragma unroll
                    for (int i = 31; i >= 0; --i) { carry = av[i] * carry + uv[i]; uv[i] = carry; } }
#pragma unroll
                for (int i = 0; i < 32; ++i) up[i * 128] = uv[i];
            }
            __syncthreads();
            {   const f32x4 h0 = *(const LAS f32x4*)(lds + UU + (ct * 128 + 8 * cg) * 4), h1 = *(const LAS f32x4*)(lds + UU + (ct * 128 + 8 * cg + 4) * 4);
                LAS u32x4* hf = (LAS u32x4*)(lds + HFL + ((sub * 32 + ct) * 128 + 8 * cg) * 2);
                if (dir == 0) *hf = (u32x4){cvt_pk_bf16(h0[0], h0[1]), cvt_pk_bf16(h0[2], h0[3]), cvt_pk_bf16(h1[0], h1[1]), cvt_pk_bf16(h1[2], h1[3])};
                else { const u32x4 f = *hf; const size_t go = ((size_t)b * SEQ + t0 + ct) * LRUW + cc0;
                    *(u32x4*)(HY + go) = (u32x4){cvt_pk_bf16((h0[0] + bflo(f[0])) * bflo(y[0]), (h0[1] + bfhi(f[0])) * bfhi(y[0])), cvt_pk_bf16((h0[2] + bflo(f[1])) * bflo(y[1]), (h0[3] + bfhi(f[1])) * bfhi(y[1])),
                                                cvt_pk_bf16((h1[0] + bflo(f[2])) * bflo(y[2]), (h1[1] + bfhi(f[2])) * bfhi(y[2])), cvt_pk_bf16((h1[2] + bflo(f[3])) * bflo(y[3]), (h1[3] + bfhi(f[3])) * bfhi(y[3]))}; }
            }
            __syncthreads();
        }
#undef LRU_GLOAD
    }
}
}
__device__ __forceinline__ void lru_apply_phase(const Args& A, LAS unsigned char* lds, int bid, int G) {
    for (int it = bid; it < 2560; it += G) lru::lru_apply_item(A, lds, it / 320, (it >> 5) % 10, it & 31);
}
template <int MODE>
__device__ __forceinline__ void lru_phase(const Args& A, LAS unsigned char* lds, int bid, int G) {
    const int nitems = (MODE == 0) ? 5120 : 2560;
    for (int it = bid; it < nitems; it += G) {
        int b, n, seg, dir;
        if (MODE == 0) { dir = it & 1; const int r = it >> 1; seg = r & 31; n = (r >> 5) % 10; b = r / 320; }
        else { dir = MODE - 1; seg = it & 31; n = (it >> 5) % 10; b = it / 320; }
        lru::lru_item<MODE>(A, lds, b, n, seg, dir);
    }
}
__device__ __forceinline__ void lru_carry_phase(const Args& A, int bid, int G) {
    const float* sm = (const float*)(A.ws + TB_LSUM); float* cin = (float*)(A.ws + TB_LCIN);
    for (int idx = bid * NTHR + threadIdx.x; idx < NBATCH * 2 * LRUW; idx += G * NTHR) {
        const int b = idx / (2 * LRUW), r = idx % (2 * LRUW), dir = r / LRUW, ch = r % LRUW; float carry = 0.f;
        for (int i = 0; i < 32; ++i) { const int sg = dir ? (31 - i) : i; const size_t o = (size_t)((b * 32 + sg) * 2 + dir);
            cin[o * LRUW + ch] = carry; carry = sm[o * 2 * LRUW + ch] * carry + sm[o * 2 * LRUW + LRUW + ch]; }
    }
}

__device__ __forceinline__ void place_phase(const Args& A, LAS unsigned char* lds, int bid, int G) {
    int tid_ = threadIdx.x; asm volatile("" : "+v"(tid_));
    const int tid = tid_, lane = tid & 63, wave = tid >> 6; unsigned char* ws = A.ws;
    const int* bcnt = (const int*)(ws + TB_BCNT); const int* eid = (const int*)(ws + TB_EID); int* slot = (int*)(ws + TB_SLOT);
    const bf16_t* HM = (const bf16_t*)(ws + WS_HM); bf16_t* XS = (bf16_t*)(ws + E_XS);
    LAS int* tot = (LAS int*)lds; LAS int* pre = tot + 8; LAS int* rb = tot + 16; LAS int* wcn = tot + 32; LAS int* sl = tot + 64;
    for (int tb = bid; tb < MTOK / 256; tb += G) {
        { int t_ = 0, p_ = 0;
#pragma unroll
            for (int j = 0; j < 4; ++j) { const int blk = lane + 64 * j; const int v = bcnt[blk * 8 + wave]; t_ += v; p_ += (blk < tb) ? v : 0; }
#pragma unroll
            for (int o = 1; o < 64; o <<= 1) { t_ += __shfl_xor(t_, o); p_ += __shfl_xor(p_, o); }
            if (lane == 0) { tot[wave] = t_; pre[wave] = p_; } }
        __syncthreads();
        if (tid == 0) { int acc = 0; for (int e = 0; e < 8; ++e) { rb[e] = acc * 256; if (tb == 0) ((int*)(ws + TB_TILES))[e] = acc; acc += (tot[e] + 255) >> 8; } if (tb == 0) ((int*)(ws + TB_TILES))[8] = acc; }
        int e0 = -1, e1 = -1; unsigned long long mk0 = 0, mk1 = 0;
        if (tid < 256) { e0 = eid[(tb * 256 + tid) * 2]; e1 = eid[(tb * 256 + tid) * 2 + 1];
#pragma unroll
            for (int e = 0; e < 8; ++e) { const unsigned long long m = __ballot(e0 == e || e1 == e); if (lane == 0) wcn[wave * 8 + e] = __popcll(m); if (e0 == e) mk0 = m; if (e1 == e) mk1 = m; } }
        __syncthreads();
        if (tid < 256) { const unsigned long long lt = (1ull << lane) - 1ull; int b0 = rb[e0] + pre[e0] + __popcll(mk0 & lt), b1 = rb[e1] + pre[e1] + __popcll(mk1 & lt);
            for (int w = 0; w < wave; ++w) { b0 += wcn[w * 8 + e0]; b1 += wcn[w * 8 + e1]; }
            sl[tid * 2] = b0; sl[tid * 2 + 1] = b1; slot[(tb * 256 + tid) * 2] = b0; slot[(tb * 256 + tid) * 2 + 1] = b1; }
        __syncthreads();
        for (int i = 0; i < 32; ++i) { const int t = wave * 32 + i; const int s0 = sl[t * 2], s1 = sl[t * 2 + 1];
            const bf16_t* src = HM + (size_t)(tb * 256 + t) * DM + lane * 16;
            const u32x4 a = *(const u32x4*)src, b = *(const u32x4*)(src + 8);
            const u32x4 q = {pk_fp8x4(bflo(a[0]), bfhi(a[0]), bflo(a[1]), bfhi(a[1])), pk_fp8x4(bflo(a[2]), bfhi(a[2]), bflo(a[3]), bfhi(a[3])),
                             pk_fp8x4(bflo(b[0]), bfhi(b[0]), bflo(b[1]), bfhi(b[1])), pk_fp8x4(bflo(b[2]), bfhi(b[2]), bflo(b[3]), bfhi(b[3]))};
            *(u32x4*)((unsigned char*)XS + (size_t)s0 * DM + lane * 16) = q; *(u32x4*)((unsigned char*)XS + (size_t)s1 * DM + lane * 16) = q; }
        __syncthreads();
    }
}

namespace att {
constexpr int KVBLK = 64;
#define SBAR() __builtin_amdgcn_sched_barrier(0)
typedef int v8i __attribute__((ext_vector_type(8)));
__device__ __forceinline__ int crow(int r, int hi) { return (r & 3) + 8 * (r >> 2) + 4 * hi; }
constexpr int SLOTB = 8192;
__device__ __forceinline__ int k_slot(int s) { return s * SLOTB; }
__device__ __forceinline__ int v_slot(int s) { return 65536 + s * SLOTB; }
__device__ __forceinline__ int kswz(int row) { return ((row & 7) ^ (row >> 4)) & 7; }
__device__ __forceinline__ int vswz(int row) { return (row >> 2) & 3; }
__device__ __forceinline__ void mfma8_acc(f32x16& acc, const v8i& a, const v8i& b, int sc) {
    asm volatile("s_nop 4\n\tv_mfma_scale_f32_32x32x64_f8f6f4 %0, %1, %2, %0, %3, %3 op_sel_hi:[0,0,0]" : "+v"(acc) : "v"(a), "v"(b), "v"(sc) : "memory");
}
__device__ __forceinline__ void mfma8_c(f32x16& d, const v8i& a, const v8i& b, const f32x16& c, int sa, int sb) {
    asm volatile("v_mfma_scale_f32_32x32x64_f8f6f4 %0, %1, %2, %3, %4, %5 op_sel_hi:[0,0,0]" : "=&v"(d) : "v"(a), "v"(b), "v"(c), "v"(sa), "v"(sb) : "memory");
}
#define ATT_LD8(p0_, p1_) __builtin_bit_cast(v8i, __builtin_shufflevector(*(const LAS u32x4*)(p0_), *(const LAS u32x4*)(p1_), 0, 1, 2, 3, 4, 5, 6, 7))
__device__ __forceinline__ void qkt(f32x16& p0, f32x16& p1, const LAS char* Ks, const v8i& qr, int r32, int hi, int jj, const f32x16& cinit, int s1, int s8) {
    const int c0 = jj * 4 + 2 * hi;
    { const int row = r32; const v8i kf = ATT_LD8(Ks + row * 128 + ((c0 ^ kswz(row)) << 4), Ks + row * 128 + (((c0 + 1) ^ kswz(row)) << 4)); mfma8_c(p0, kf, qr, cinit, s1, s8); }
    { const int row = 32 + r32; const v8i kf = ATT_LD8(Ks + row * 128 + ((c0 ^ kswz(row)) << 4), Ks + row * 128 + (((c0 + 1) ^ kswz(row)) << 4)); mfma8_c(p1, kf, qr, cinit, s1, s8); }
}
__device__ __forceinline__ void load_kf(v8i& kf0, v8i& kf1, const LAS char* Ks, int r32, int hi, int jj) {
    const int c0 = jj * 4 + 2 * hi, row1 = 32 + r32;
    kf0 = ATT_LD8(Ks + r32 * 128 + ((c0 ^ kswz(r32)) << 4), Ks + r32 * 128 + (((c0 + 1) ^ kswz(r32)) << 4));
    kf1 = ATT_LD8(Ks + row1 * 128 + ((c0 ^ kswz(row1)) << 4), Ks + row1 * 128 + (((c0 + 1) ^ kswz(row1)) << 4));
}
#define ATT_VFR(Vs, d0) ATT_LD8((Vs) + (32 * (d0) + r32) * 64 + (((2 * hi) ^ vswz(32 * (d0) + r32)) << 4), (Vs) + (32 * (d0) + r32) * 64 + (((2 * hi + 1) ^ vswz(32 * (d0) + r32)) << 4))
__device__ __forceinline__ void pack_p(const float (&pe)[32], v8i& pa);
__device__ __forceinline__ void qkt_pack(f32x16& p0, f32x16& p1, const v8i& kf0, const v8i& kf1, const v8i& qr, const f32x16& cinit, int s1, int s8, const float (&pe)[32], v8i& pa) {
#define ATT_MC8(d, kf, B, O0, O1, O2, O3) \
    asm volatile("v_mfma_scale_f32_32x32x64_f8f6f4 %0, %21, %22, %23, %24, %25 op_sel_hi:[0,0,0]\n\t" \
                 "v_cvt_pk_fp8_f32 %1, %5, %6\n\tv_cvt_pk_fp8_f32 %1, %7, %8 op_sel:[0,0,1]\n\t" \
                 "v_cvt_pk_fp8_f32 %2, %9, %10\n\tv_cvt_pk_fp8_f32 %2, %11, %12 op_sel:[0,0,1]\n\t" \
                 "v_cvt_pk_fp8_f32 %3, %13, %14\n\tv_cvt_pk_fp8_f32 %3, %15, %16 op_sel:[0,0,1]\n\t" \
                 "v_cvt_pk_fp8_f32 %4, %17, %18\n\tv_cvt_pk_fp8_f32 %4, %19, %20 op_sel:[0,0,1]" \
                 : "=&v"(d), "=&v"(O0), "=&v"(O1), "=&v"(O2), "=&v"(O3) \
                 : "v"(pe[B]), "v"(pe[B + 1]), "v"(pe[B + 2]), "v"(pe[B + 3]), "v"(pe[B + 4]), "v"(pe[B + 5]), "v"(pe[B + 6]), "v"(pe[B + 7]), \
                   "v"(pe[B + 8]), "v"(pe[B + 9]), "v"(pe[B + 10]), "v"(pe[B + 11]), "v"(pe[B + 12]), "v"(pe[B + 13]), "v"(pe[B + 14]), "v"(pe[B + 15]), \
                   "v"(kf), "v"(qr), "v"(cinit), "v"(s1), "v"(s8) : "memory")
    int q0, q1, q2, q3, q4, q5, q6, q7;
    ATT_MC8(p0, kf0, 0, q0, q1, q2, q3);
    ATT_MC8(p1, kf1, 16, q4, q5, q6, q7);
#undef ATT_MC8
    pa = (v8i){q0, q1, q2, q3, q4, q5, q6, q7};
}
__device__ __forceinline__ void partialSM(f32x16& p0) {
#pragma unroll
    for (int r = 0; r < 16; ++r) p0[r] = fexp2(p0[r]);
}
__device__ __forceinline__ void finishSM(f32x16& p0, f32x16& p1, v8i& pa) {
#pragma unroll
    for (int r = 0; r < 16; ++r) p1[r] = fexp2(p1[r]);
#pragma unroll
    for (int w = 0; w < 4; ++w) { pa[w] = (int)pk_fp8x4(p0[4 * w], p0[4 * w + 1], p0[4 * w + 2], p0[4 * w + 3]); pa[4 + w] = (int)pk_fp8x4(p1[4 * w], p1[4 * w + 1], p1[4 * w + 2], p1[4 * w + 3]); }
}
#define ATT_MX7(acc, a, b, sc, NOP, O, I, k) \
    asm volatile(NOP "v_mfma_scale_f32_32x32x64_f8f6f4 %0, %15, %16, %0, %17, %17 op_sel_hi:[0,0,0]\n\tv_exp_f32 %1, %8\n\tv_exp_f32 %2, %9\n\tv_exp_f32 %3, %10\n\tv_exp_f32 %4, %11\n\tv_exp_f32 %5, %12\n\tv_exp_f32 %6, %13\n\tv_exp_f32 %7, %14" \
                 : "+v"(acc), "=&v"(O[k]), "=&v"(O[k + 1]), "=&v"(O[k + 2]), "=&v"(O[k + 3]), "=&v"(O[k + 4]), "=&v"(O[k + 5]), "=&v"(O[k + 6]) \
                 : "v"(I(k)), "v"(I(k + 1)), "v"(I(k + 2)), "v"(I(k + 3)), "v"(I(k + 4)), "v"(I(k + 5)), "v"(I(k + 6)), "v"(a), "v"(b), "v"(sc) : "memory")
__device__ __forceinline__ void pv_exp(f32x16* o, f32x16& lacc, const v8i& ones, const v8i& vf0, const v8i& vf1, const v8i& vf2, const v8i& vf3, const v8i& pa, int s1, const f32x16& r0, const f32x16& r1, float (&pe)[32]) {
#define ATT_RI(k) (((k) < 16) ? r0[(k) & 15] : r1[(k) & 15])
    ATT_MX7(o[0], pa, vf0, s1, "s_nop 4\n\t", pe, ATT_RI, 0);
    ATT_MX7(o[1], pa, vf1, s1, "", pe, ATT_RI, 7);
    ATT_MX7(o[2], pa, vf2, s1, "", pe, ATT_RI, 14);
    ATT_MX7(o[3], pa, vf3, s1, "", pe, ATT_RI, 21);
    asm volatile("v_mfma_scale_f32_32x32x64_f8f6f4 %0, %9, %10, %0, %11, %11 op_sel_hi:[0,0,0]\n\tv_exp_f32 %1, %5\n\tv_exp_f32 %2, %6\n\tv_exp_f32 %3, %7\n\tv_exp_f32 %4, %8"
                 : "+v"(lacc), "=&v"(pe[28]), "=&v"(pe[29]), "=&v"(pe[30]), "=&v"(pe[31]) : "v"(r1[12]), "v"(r1[13]), "v"(r1[14]), "v"(r1[15]), "v"(pa), "v"(ones), "v"(s1) : "memory");
#undef ATT_RI
}
__device__ __forceinline__ void pack_p(const float (&pe)[32], v8i& pa) {
#pragma unroll
    for (int w = 0; w < 8; ++w) pa[w] = (int)pk_fp8x4(pe[4 * w], pe[4 * w + 1], pe[4 * w + 2], pe[4 * w + 3]);
}
__device__ __forceinline__ void pv_d0(f32x16* o, f32x16& lacc, const v8i& ones, const LAS char* Vs, const v8i& pa, int r32, int hi, int s1) {
#pragma unroll
    for (int d0 = 0; d0 < 4; ++d0) { const int row = 32 * d0 + r32;
        const v8i vf = ATT_LD8(Vs + row * 64 + (((2 * hi) ^ vswz(row)) << 4), Vs + row * 64 + (((2 * hi + 1) ^ vswz(row)) << 4));
        mfma8_acc(o[d0], pa, vf, s1); }
    mfma8_acc(lacc, pa, ones, s1);
}
__device__ __forceinline__ void pv_last(f32x16* o, f32x16& lacc, const v8i& ones, const v8i& vf0, const v8i& vf1, const v8i& vf2, const v8i& vf3, const v8i& pa, int s1) {
    mfma8_acc(o[0], pa, vf0, s1); mfma8_acc(o[1], pa, vf1, s1); mfma8_acc(o[2], pa, vf2, s1); mfma8_acc(o[3], pa, vf3, s1); mfma8_acc(lacc, pa, ones, s1);
}
}

__device__ __forceinline__ void vt_phase(const Args& A, int bid, int G) {
    const int tid = threadIdx.x; unsigned char* ws = A.ws;
    const bf16_t* V = (const bf16_t*)(ws + A_V); unsigned char* VT = ws + A_VT;
    const int dv = tid & 127, kq = tid >> 7, half = kq >> 1, hi = kq & 1;
    for (int it = bid; it < 64 * 128; it += G) {
        const int bh = it >> 7, tile = it & 127, b = bh >> 3, h = bh & 7;
        const bf16_t* vp = V + ((size_t)b * SEQ + tile * 64 + 32 * half) * DM + h * 128 + dv;
        float f[16];
#pragma unroll
        for (int i = 0; i < 16; ++i) f[i] = bf2f(vp[(size_t)att::crow(i, hi) * DM]);
        *(u32x4*)(VT + (((size_t)bh * 128 + tile) * 128 + dv) * 64 + hi * 32 + half * 16) =
            (u32x4){pk_fp8x4(f[0], f[1], f[2], f[3]), pk_fp8x4(f[4], f[5], f[6], f[7]), pk_fp8x4(f[8], f[9], f[10], f[11]), pk_fp8x4(f[12], f[13], f[14], f[15])};
    }
}

__device__ __forceinline__ void attn_phase(const Args& A, LAS unsigned char* ldsu, int bid, int G, int al) {
    using namespace att;
    LAS char* lds = (LAS char*)ldsu;
    unsigned char* ws = A.ws;
    const unsigned char* Qg = ws + A_Q; const unsigned char* Kg = ws + A_K; const unsigned char* VTg = ws + A_VT;
    bf16_t* Og = (bf16_t*)(ws + WS_HM);
    const float* scal = (const float*)(ws + TB_SCAL);
    const float lamv = scal[SC_LAM0 + al], omli = scal[SC_OML0 + al], Mc = scal[SC_MC0 + al] - 7.5f;
    const float* subg = A.in[I_ATSUB] + al * 128;
    int tid_ = threadIdx.x; asm volatile("" : "+v"(tid_));
    const int tid = tid_, wid = __builtin_amdgcn_readfirstlane(tid >> 6), lane = tid & 63, r32 = lane & 31, hi = lane >> 5, jj = wid >> 2, wq = wid & 3;
    constexpr int NT = SEQ / KVBLK;
    int s1 = 0x7f7f7f7f, s8 = 0x7c7c7c7c; asm volatile("" : "+v"(s1), "+v"(s8));
    v8i ones; { int o1 = 0x38383838; asm volatile("" : "+v"(o1)); ones = (v8i){o1, o1, o1, o1, o1, o1, o1, o1}; }
    f32x16 cinit;
#pragma unroll
    for (int r = 0; r < 16; ++r) cinit[r] = -Mc;
    unsigned koff, voff;
    { const int bb = wid * 1024 + lane * 16;
      { const int row = bb >> 7, c = ((bb & 127) >> 4) ^ kswz(row); koff = (unsigned)(row * 1024 + c * 16); }
      { const int row = bb >> 6, c = ((bb & 63) >> 4) ^ vswz(row); voff = (unsigned)(row * 64 + c * 16); } }
    const unsigned ldsw = (unsigned)wid * 1024u;
    const __amdgpu_buffer_rsrc_t rK = __builtin_amdgcn_make_buffer_rsrc((void*)Kg, (short)0, 0x7fffffff, 0x00020000);
    const __amdgpu_buffer_rsrc_t rV = __builtin_amdgcn_make_buffer_rsrc((void*)VTg, (short)0, 0x7fffffff, 0x00020000);
#define ATT_DMA(slot, kt, vt) do { \
        __builtin_amdgcn_raw_ptr_buffer_load_lds(rK, (LAS void*)(lds + k_slot(slot) + ldsw), 16, (int)koff, (int)(kt), 0, 0); \
        __builtin_amdgcn_raw_ptr_buffer_load_lds(rV, (LAS void*)(lds + v_slot(slot) + ldsw), 16, (int)voff, (int)(vt), 0, 0); } while (0)
#define ATT_TOP() do { asm volatile("s_waitcnt vmcnt(2)" ::: "memory"); __builtin_amdgcn_s_barrier(); asm volatile("" ::: "memory"); } while (0)
    const int xq = bid & 7, cq = bid >> 3;
    int cbh = xq * 8;
    const bool lag = (jj != 0);
#define ATT_KB(bh_) ((unsigned)(((bh_) >> 3) * SEQ) * (unsigned)DM + (unsigned)((bh_) & 7) * 128u)
#define ATT_VB(bh_) ((unsigned)(bh_) * (128u * 8192u))
    ATT_DMA(0, ATT_KB(cbh), ATT_VB(cbh)); ATT_DMA(1, ATT_KB(cbh) + 64u * DM, ATT_VB(cbh) + 8192u);
    int ofKa, ofKb, ofV, ofKax, ofKbx, ofVx;
    { const int c0 = jj * 4 + 2 * hi, lb = (int)(unsigned)(size_t)lds;
      ofKa = r32 * 128 + ((c0 ^ kswz(r32)) << 4); ofKb = (32 + r32) * 128 + ((c0 ^ kswz(32 + r32)) << 4); ofV = 65536 + r32 * 64 + (((2 * hi) ^ vswz(r32)) << 4);
      ofKax = lb + (ofKa ^ 16); ofKbx = lb + (ofKb ^ 16); ofVx = lb + (ofV ^ 16); ofKa += lb; ofKb += lb; ofV += lb; }
#define ATT_QLOAD(dst, bh_, qb_) do { const unsigned char* Qw_ = Qg + ((size_t)((bh_) >> 3) * SEQ + (qb_) * 128) * DM + ((bh_) & 7) * 128 + (size_t)(wq * 32 + r32) * DM + jj * 64 + hi * 32; \
        const u32x4 qa_ = *(const u32x4*)Qw_, qb2_ = *(const u32x4*)(Qw_ + 16); dst = __builtin_bit_cast(v8i, __builtin_shufflevector(qa_, qb2_, 0, 1, 2, 3, 4, 5, 6, 7)); } while (0)
    v8i qnext; ATT_QLOAD(qnext, cbh, cq);
    for (int ui = 0; ui < 16; ++ui) {
        const int qb = (ui & 1) * 32 + cq;
        const int nbh = (ui + 1 < 16) ? xq * 8 + ((ui + 1) >> 1) : cbh;
        const unsigned Kh = ATT_KB(cbh), Vh = ATT_VB(cbh), nK = ATT_KB(nbh), nV = ATT_VB(nbh);
        const size_t obase = ((size_t)(cbh >> 3) * SEQ + qb * 128) * DM + (cbh & 7) * 128;
        f32x16 lacc = {}; f32x16 o[4] = {}; const v8i qr = qnext;
        f32x16 pA0, pA1; v8i pa, kf0, kf1, vf0, vf1, vf2, vf3;
        unsigned kptr = Kh + 2u * 64u * DM, vptr = Vh + 2u * 8192u;
#define ATT_ISSUE(SLD, last) do { asm volatile("" : "+s"(kptr), "+s"(vptr)); ATT_DMA(SLD, kptr, vptr); if (last) { kptr = nK; vptr = nV; } else { kptr += 64u * DM; vptr += 8192u; } } while (0)
#define ATT_RD8(b_, bx_, imm_) ATT_LD8((const LAS char*)(unsigned)((b_) + (imm_)), (const LAS char*)(unsigned)((bx_) + (imm_)))
#define ATT_FIX() asm volatile("" : "+v"(ofKa), "+v"(ofKax), "+v"(ofKb), "+v"(ofKbx), "+v"(ofV), "+v"(ofVx))
#define ATT_STEPC(LAST, SL, SLP, SLD) do { \
            ATT_FIX(); \
            ATT_TOP(); \
            kf0 = ATT_RD8(ofKa, ofKax, (SL) * SLOTB); kf1 = ATT_RD8(ofKb, ofKbx, (SL) * SLOTB); vf0 = ATT_RD8(ofV, ofVx, (SLP) * SLOTB); vf1 = ATT_RD8(ofV, ofVx, (SLP) * SLOTB + 2048); \
            ATT_ISSUE(SLD, LAST); \
            ATT_TOP(); \
            qkt_pack(pA0, pA1, kf0, kf1, qr, cinit, s1, s8, pe, pa); \
            vf2 = ATT_RD8(ofV, ofVx, (SLP) * SLOTB + 4096); vf3 = ATT_RD8(ofV, ofVx, (SLP) * SLOTB + 6144); \
            pv_exp(o, lacc, ones, vf0, vf1, vf2, vf3, pa, s1, pA0, pA1, pe); } while (0)
        float pe[32];
        if (lag) ATT_TOP();
        ATT_TOP();
        ATT_FIX(); kf0 = ATT_RD8(ofKa, ofKax, 0); kf1 = ATT_RD8(ofKb, ofKbx, 0); ATT_ISSUE(2, false);
        ATT_TOP();
        { mfma8_c(pA0, kf0, qr, cinit, s1, s8); mfma8_c(pA1, kf1, qr, cinit, s1, s8);
          asm volatile("s_nop 15\n\ts_nop 15" ::: "memory");
#pragma unroll
          for (int r = 0; r < 16; ++r) pe[r] = fexp2(pA0[r]);
#pragma unroll
          for (int r = 0; r < 16; ++r) pe[16 + r] = fexp2(pA1[r]); }
        ATT_STEPC(false, 1, 0, 3); ATT_STEPC(false, 2, 1, 4); ATT_STEPC(false, 3, 2, 5); ATT_STEPC(false, 4, 3, 6); ATT_STEPC(false, 5, 4, 7); ATT_STEPC(false, 6, 5, 0); ATT_STEPC(false, 7, 6, 1);
        for (int kb = 8; kb < NT; kb += 8) {
            ATT_STEPC(false, 0, 7, 2); ATT_STEPC(false, 1, 0, 3); ATT_STEPC(false, 2, 1, 4); ATT_STEPC(false, 3, 2, 5);
            ATT_STEPC(false, 4, 3, 6); ATT_STEPC(kb == NT - 8, 5, 4, 7); ATT_STEPC(false, 6, 5, 0); ATT_STEPC(false, 7, 6, 1);
        }
        ATT_TOP();
        ATT_FIX();
        vf0 = ATT_RD8(ofV, ofVx, 7 * SLOTB); vf1 = ATT_RD8(ofV, ofVx, 7 * SLOTB + 2048);
        ATT_TOP();
        { vf2 = ATT_RD8(ofV, ofVx, 7 * SLOTB + 4096); vf3 = ATT_RD8(ofV, ofVx, 7 * SLOTB + 6144);
          pack_p(pe, pa); SBAR();
          pv_last(o, lacc, ones, vf0, vf1, vf2, vf3, pa, s1);
          asm volatile("s_nop 15\n\ts_nop 15" ::: "memory"); }
        if (!lag) ATT_TOP();
        if (ui + 1 < 16) ATT_QLOAD(qnext, nbh, ((ui + 1) & 1) * 32 + cq);
#undef ATT_ISSUE
#undef ATT_STEPC
#undef ATT_RD8
#undef ATT_FIX
        int r32e = r32, hie = hi; asm volatile("" : "+v"(r32e), "+v"(hie));
        float rli[16];
#pragma unroll
        for (int r = 0; r < 16; ++r) rli[r] = frcp(lacc[r]);
        asm volatile("s_waitcnt lgkmcnt(0)" ::: "memory"); __builtin_amdgcn_s_barrier(); asm volatile("" ::: "memory");
        LAS float* Cb = (LAS float*)(lds + ((wq < 2) ? 3 * SLOTB : 65536 + 3 * SLOTB - 64 * 512));
        if (jj == 1) {
#pragma unroll
            for (int r = 0; r < 16; ++r) { const float sc = rli[r] * lamv;
#pragma unroll
                for (int d0 = 0; d0 < 4; ++d0) Cb[(wq * 32 + crow(r, hie)) * 128 + d0 * 32 + r32e] = o[d0][r] * sc; }
        }
        asm volatile("s_waitcnt lgkmcnt(0)" ::: "memory"); __builtin_amdgcn_s_barrier(); asm volatile("" ::: "memory");
        if (jj == 0) {
            float g[4];
#pragma unroll
            for (int d0 = 0; d0 < 4; ++d0) g[d0] = subg[d0 * 32 + r32e] * omli;
            bf16_t* Ob = Og + obase;
#pragma unroll
            for (int r = 0; r < 16; ++r) {
                float ss = 0.f;
#pragma unroll
                for (int d0 = 0; d0 < 4; ++d0) { const float v = o[d0][r] * rli[r] - Cb[(wq * 32 + crow(r, hie)) * 128 + d0 * 32 + r32e]; o[d0][r] = v; ss += v * v; }
                ss += __shfl_xor(ss, 1); ss += __shfl_xor(ss, 2); ss += __shfl_xor(ss, 4); ss += __shfl_xor(ss, 8); ss += __shfl_xor(ss, 16);
                const float rs = 1.0f / sqrtf(ss * (1.0f / 128.0f) + EPS);
                bf16_t* op = Ob + (size_t)(wq * 32 + crow(r, hie)) * DM + r32e;
#pragma unroll
                for (int d0 = 0; d0 < 4; ++d0) op[d0 * 32] = (bf16_t)f2bf(o[d0][r] * rs * g[d0]);
            }
        }
        asm volatile("s_waitcnt lgkmcnt(0)" ::: "memory"); __builtin_amdgcn_s_barrier(); asm volatile("" ::: "memory");
        cbh = nbh;
    }
    asm volatile("s_waitcnt vmcnt(0) lgkmcnt(0)" ::: "memory"); __builtin_amdgcn_s_barrier(); asm volatile("" ::: "memory");
#undef ATT_DMA
#undef ATT_TOP
#undef ATT_QLOAD
#undef ATT_KB
#undef ATT_VB
#undef ATT_LD8
}

namespace gla {
constexpr int BC = 0, QI = 32768, QA = 49152, KA = 65536, KST = 81920, VT = 98304, ST = 106496, AT = 122880, EM = 131072, EL = EM + 512, DD = EM + 1024, BMID = EM + 1536, SEG = EM + 2048;
static_assert(SEG + 2048 <= RING_BYTES, "gla lds");
__device__ __forceinline__ int sw256(int row, int cb) { return row * 256 + (cb ^ ((row & 15) << 4)); }
__device__ __forceinline__ int sw128(int row, int cb) { return row * 128 + (cb ^ ((((row & 7) ^ (row >> 4)) & 7) << 4)); }
__device__ __forceinline__ int crow(int r, int hi) { return (r & 3) + 8 * (r >> 2) + 4 * hi; }
__device__ __forceinline__ float h2f(unsigned short b) { return (float)__builtin_bit_cast(_Float16, b); }
__device__ __forceinline__ void gla_item(const bf16_t* __restrict__ Qp, const unsigned short* __restrict__ LFp, const bf16_t* __restrict__ Vp, bf16_t* __restrict__ Op, int dir, LAS unsigned char* lds, float* dbg) {
    int tid_ = threadIdx.x; asm volatile("" : "+v"(tid_));
    const int tid = tid_, wid = tid >> 6, lane = tid & 63, r = lane & 31, hh = lane >> 5;
    const int t1 = tid >> 3, kg = tid & 7, k0 = 16 * kg, v0 = (tid & 7) * 8;
    for (int i = tid; i < 16384 / 16; i += NTHR) *(LAS u32x4*)(lds + ST + i * 16) = (u32x4){0u, 0u, 0u, 0u};
    f32x16 st = {};
    u32x4 rq[2], rl[2], rv;
#define GLA_TOK(ci, i) (dir ? (SEQ - 1 - ((ci) * 64 + (i))) : ((ci) * 64 + (i)))
#define GLA_LOAD(ci) do { const size_t to = (size_t)GLA_TOK(ci, t1) * DM; \
        rq[0] = *(const u32x4*)(Qp + to + k0); rq[1] = *(const u32x4*)(Qp + to + k0 + 8); \
        rl[0] = *(const u32x4*)(LFp + to + k0); rl[1] = *(const u32x4*)(LFp + to + k0 + 8); rv = *(const u32x4*)(Vp + to + v0); } while (0)
    GLA_LOAD(0);
    __syncthreads();
    for (int ci = 0; ci < SEQ / 64; ++ci) {
        float qf[16], lf[16]; u32x4 vreg = rv;
#pragma unroll
        for (int j = 0; j < 2; ++j)
#pragma unroll
            for (int e = 0; e < 4; ++e) { qf[j * 8 + 2 * e] = bflo(rq[j][e]); qf[j * 8 + 2 * e + 1] = bfhi(rq[j][e]);
                lf[j * 8 + 2 * e] = h2f((unsigned short)(rl[j][e] & 0xffffu)); lf[j * 8 + 2 * e + 1] = h2f((unsigned short)(rl[j][e] >> 16)); }
        if (ci + 1 < SEQ / 64) GLA_LOAD(ci + 1);
#pragma unroll
        for (int j = 0; j < 4; ++j) *(LAS f32x4*)(lds + BC + (t1 * 128 + k0 + 4 * j) * 4) = (f32x4){lf[4 * j], lf[4 * j + 1], lf[4 * j + 2], lf[4 * j + 3]};
        __syncthreads();
        { const int kc = tid & 127, sg = tid >> 7; LAS float* bc = (LAS float*)(lds + BC) + kc; float cs[16];
#pragma unroll
            for (int i = 0; i < 16; ++i) cs[i] = bc[(sg * 16 + i) * 128];
#pragma unroll
            for (int i = 1; i < 16; ++i) cs[i] += cs[i - 1];
            ((LAS float*)(lds + SEG))[sg * 128 + kc] = cs[15];
            __syncthreads();
            const LAS float* sgp = (const LAS float*)(lds + SEG) + kc; const float s0 = sgp[0], s1 = sgp[128], s2 = sgp[256], s3 = sgp[384];
            const float off = sg == 0 ? 0.f : sg == 1 ? s0 : sg == 2 ? (s0 + s1) : ((s0 + s1) + s2);
#pragma unroll
            for (int i = 0; i < 16; ++i) bc[(sg * 16 + i) * 128] = cs[i] + off;
            if (sg == 0) { const float bm = s0 + s1, bl = ((s0 + s1) + s2) + s3;
                ((LAS float*)(lds + BMID))[kc] = bm; ((LAS float*)(lds + EM))[kc] = fexp(bm); ((LAS float*)(lds + EL))[kc] = fexp(bl - bm); ((LAS float*)(lds + DD))[kc] = fexp(bl); }
            __syncthreads();
        }
#ifdef DIAG
        if (dbg && ci == 0) { for (int i = tid; i < 8192; i += NTHR) dbg[i] = ((const LAS float*)(lds + BC))[i]; }
#endif
        {
            unsigned wqi[8], wqa[8], wka[8]; float ksv[16];
#pragma unroll
            for (int j = 0; j < 4; ++j) {
                const f32x4 bt = *(const LAS f32x4*)(lds + BC + (t1 * 128 + k0 + 4 * j) * 4), bm = *(const LAS f32x4*)(lds + BMID + (k0 + 4 * j) * 4);
                const f32x4 em = *(const LAS f32x4*)(lds + EM + (k0 + 4 * j) * 4), el = *(const LAS f32x4*)(lds + EL + (k0 + 4 * j) * 4);
                float qi[4], qa[4], ka[4];
#pragma unroll
                for (int e = 0; e < 4; ++e) { const int i = 4 * j + e; const float e1 = fexp(bt[e] - bm[e]), r1 = frcp(e1);
                    qa[e] = qf[i] * e1; qi[e] = qa[e] * em[e]; const float kk = 1.0f - fexp(lf[i]); ka[e] = kk * r1; ksv[i] = ka[e] * el[e]; }
                wqi[2 * j] = cvt_pk_bf16(qi[0], qi[1]); wqi[2 * j + 1] = cvt_pk_bf16(qi[2], qi[3]);
                wqa[2 * j] = cvt_pk_bf16(qa[0], qa[1]); wqa[2 * j + 1] = cvt_pk_bf16(qa[2], qa[3]);
                wka[2 * j] = cvt_pk_bf16(ka[0], ka[1]); wka[2 * j + 1] = cvt_pk_bf16(ka[2], ka[3]);
            }
#pragma unroll
            for (int j = 0; j < 2; ++j) { const int off = sw256(t1, (k0 + 8 * j) * 2);
                *(LAS u32x4*)(lds + QI + off) = (u32x4){wqi[4 * j], wqi[4 * j + 1], wqi[4 * j + 2], wqi[4 * j + 3]};
                *(LAS u32x4*)(lds + QA + off) = (u32x4){wqa[4 * j], wqa[4 * j + 1], wqa[4 * j + 2], wqa[4 * j + 3]};
                *(LAS u32x4*)(lds + KA + off) = (u32x4){wka[4 * j], wka[4 * j + 1], wka[4 * j + 2], wka[4 * j + 3]}; }
#pragma unroll
            for (int i = 0; i < 16; ++i) *(LAS unsigned short*)(lds + KST + sw128(k0 + i, t1 * 2)) = (unsigned short)f2bf(ksv[i]);
#pragma unroll
            for (int e = 0; e < 4; ++e) { *(LAS unsigned short*)(lds + VT + sw128(v0 + 2 * e, t1 * 2)) = (unsigned short)(vreg[e] & 0xffffu);
                *(LAS unsigned short*)(lds + VT + sw128(v0 + 2 * e + 1, t1 * 2)) = (unsigned short)(vreg[e] >> 16); }
        }
        __syncthreads();
        f32x16 oacc = {};
        const int w4 = wid & 3, t_i = w4 >> 1, v_i = w4 & 1;
        if (wid < 4) {
            const int s_i = wid >> 1, tq = wid & 1; f32x16 a = {};
#pragma unroll
            for (int ks = 0; ks < 8; ++ks) { const bf16x8 fa = *(const LAS bf16x8*)(lds + KA + sw256(32 * s_i + r, (16 * ks + 8 * hh) * 2)), fb = *(const LAS bf16x8*)(lds + QA + sw256(32 * tq + r, (16 * ks + 8 * hh) * 2));
                a = __builtin_amdgcn_mfma_f32_32x32x16_bf16(fa, fb, a, 0, 0, 0); }
            const int tg = 32 * tq + r;
#pragma unroll
            for (int g = 0; g < 4; ++g) { float m[4];
#pragma unroll
                for (int e = 0; e < 4; ++e) { const int sgl = 32 * s_i + 8 * g + 4 * hh + e; m[e] = (sgl <= tg) ? a[4 * g + e] : 0.f; }
                *(LAS u32x2*)(lds + AT + sw128(tg, (32 * s_i + 8 * g + 4 * hh) * 2)) = (u32x2){cvt_pk_bf16(m[0], m[1]), cvt_pk_bf16(m[2], m[3])}; }
        } else {
#pragma unroll
            for (int ks = 0; ks < 8; ++ks) { const bf16x8 fa = *(const LAS bf16x8*)(lds + QI + sw256(32 * t_i + r, (16 * ks + 8 * hh) * 2)), fb = *(const LAS bf16x8*)(lds + ST + sw256(32 * v_i + r, (16 * ks + 8 * hh) * 2));
                oacc = __builtin_amdgcn_mfma_f32_32x32x16_bf16(fa, fb, oacc, 0, 0, 0); }
        }
        __syncthreads();
#ifdef DIAG
        if (dbg && ci == 0) { for (int i = tid; i < 2048; i += NTHR) { ((unsigned*)dbg)[8192 + i] = ((const LAS unsigned*)(lds + AT))[i]; ((unsigned*)dbg)[8192 + 2048 + i] = ((const LAS unsigned*)(lds + VT))[i]; } }
#endif
        if (wid >= 4) {
#pragma unroll
            for (int ks = 0; ks < 4; ++ks) { const bf16x8 fa = *(const LAS bf16x8*)(lds + AT + sw128(32 * t_i + r, (16 * ks + 8 * hh) * 2)), fb = *(const LAS bf16x8*)(lds + VT + sw128(32 * v_i + r, (16 * ks + 8 * hh) * 2));
                oacc = __builtin_amdgcn_mfma_f32_32x32x16_bf16(fa, fb, oacc, 0, 0, 0); }
#pragma unroll
            for (int i = 0; i < 16; ++i) { const int t = 32 * t_i + crow(i, hh); Op[(size_t)GLA_TOK(ci, t) * DM + 32 * v_i + r] = (bf16_t)f2bf(oacc[i]); }
        }
        {
            const int kq = wid >> 1, vq = wid & 1;
#pragma unroll
            for (int i = 0; i < 16; ++i) st[i] *= ((const LAS float*)(lds + DD))[32 * kq + crow(i, hh)];
#pragma unroll
            for (int ks = 0; ks < 4; ++ks) { const bf16x8 fa = *(const LAS bf16x8*)(lds + KST + sw128(32 * kq + r, (16 * ks + 8 * hh) * 2)), fb = *(const LAS bf16x8*)(lds + VT + sw128(32 * vq + r, (16 * ks + 8 * hh) * 2));
                st = __builtin_amdgcn_mfma_f32_32x32x16_bf16(fa, fb, st, 0, 0, 0); }
#pragma unroll
            for (int g = 0; g < 4; ++g) *(LAS u32x2*)(lds + ST + sw256(32 * vq + r, (32 * kq + 8 * g + 4 * hh) * 2)) = (u32x2){cvt_pk_bf16(st[4 * g], st[4 * g + 1]), cvt_pk_bf16(st[4 * g + 2], st[4 * g + 3])};
        }
        __syncthreads();
#ifdef DIAG
        if (dbg && ci == 0) { for (int i = tid; i < 4096; i += NTHR) { ((unsigned*)dbg)[12288 + i] = ((const LAS unsigned*)(lds + ST))[i]; ((unsigned*)dbg)[16384 + i] = ((const LAS unsigned*)(lds + KST))[i]; } }
#endif
    }
#undef GLA_TOK
#undef GLA_LOAD
}
}
__device__ __forceinline__ void gla_phase(const Args& A, LAS unsigned char* lds, int bid, int G) {
    unsigned char* ws = A.ws;
    for (int it = bid; it < 256; it += G) {
        const int b = it >> 5, h = (it >> 2) & 7, dir = (it >> 1) & 1, vh = it & 1;
        const size_t base = (size_t)b * SEQ * DM + h * 128;
        gla::gla_item((const bf16_t*)(ws + H_Q) + base, (const unsigned short*)(ws + (dir ? H_LFB : H_LFF)) + base, (const bf16_t*)(ws + H_V) + base + vh * 64,
                      (bf16_t*)(ws + (dir ? H_OB : H_OF)) + base + vh * 64, dir, lds, it == 0 ? (float*)(ws + TB_LSUM) : nullptr);
    }
}
__device__ __forceinline__ void hg_normo_phase(const Args& A, int bid, int G) {
    int tid_ = threadIdx.x; asm volatile("" : "+v"(tid_));
    const int tid = tid_, lane = tid & 63, wave = tid >> 6; unsigned char* ws = A.ws;
    const bf16_t* OF = (const bf16_t*)(ws + H_OF); const bf16_t* OB = (const bf16_t*)(ws + H_OB); const bf16_t* GG = (const bf16_t*)(ws + H_G); bf16_t* HM = (bf16_t*)(ws + WS_HM);
    const int c0 = (lane >> 3) * 128 + (lane & 7) * 16;
    float ng[16];
#pragma unroll
    for (int i = 0; i < 16; ++i) ng[i] = A.in[I_HGNG][(lane & 7) * 16 + i];
    for (int row = (bid * NWAVES + wave); row < MTOK; row += G * NWAVES) {
        const size_t o = (size_t)row * DM + c0;
        const u32x4 a0 = *(const u32x4*)(OF + o), a1 = *(const u32x4*)(OF + o + 8), b0 = *(const u32x4*)(OB + o), b1 = *(const u32x4*)(OB + o + 8), g0 = *(const u32x4*)(GG + o), g1 = *(const u32x4*)(GG + o + 8);
        float v[16], gt[16]; float ss = 0.f;
#pragma unroll
        for (int e = 0; e < 4; ++e) { v[2 * e] = bflo(a0[e]) + bflo(b0[e]); v[2 * e + 1] = bfhi(a0[e]) + bfhi(b0[e]); v[8 + 2 * e] = bflo(a1[e]) + bflo(b1[e]); v[8 + 2 * e + 1] = bfhi(a1[e]) + bfhi(b1[e]);
            gt[2 * e] = bflo(g0[e]); gt[2 * e + 1] = bfhi(g0[e]); gt[8 + 2 * e] = bflo(g1[e]); gt[8 + 2 * e + 1] = bfhi(g1[e]); }
#pragma unroll
        for (int i = 0; i < 16; ++i) ss += v[i] * v[i];
        ss += __shfl_xor(ss, 1); ss += __shfl_xor(ss, 2); ss += __shfl_xor(ss, 4);
        const float rstd = 1.0f / sqrtf(ss * (1.0f / 128.0f) + EPS);
        u32x4 w0, w1;
#pragma unroll
        for (int e = 0; e < 4; ++e) { w0[e] = cvt_pk_bf16(v[2 * e] * rstd * ng[2 * e] * gt[2 * e], v[2 * e + 1] * rstd * ng[2 * e + 1] * gt[2 * e + 1]);
            w1[e] = cvt_pk_bf16(v[8 + 2 * e] * rstd * ng[8 + 2 * e] * gt[8 + 2 * e], v[8 + 2 * e + 1] * rstd * ng[8 + 2 * e + 1] * gt[8 + 2 * e + 1]); }
        *(u32x4*)(HM + o) = w0; *(u32x4*)(HM + o + 8) = w1;
    }
}

#ifdef DIAG
constexpr int DG_BASE = 8192;
__device__ __forceinline__ void dg_put(const Args& A, int k, float e) { if (!(e >= 0.f) || e > 1e9f) e = 1e9f; atomicMax((unsigned*)(A.ws + WS_CTL) + DG_BASE + 64 * k, __float_as_uint(e)); }
__device__ __forceinline__ float dg_rel(float got, float ref) { return fabsf(got - ref) / (fabsf(ref) + 0.1f); }
__device__ __forceinline__ unsigned dg_hash(unsigned a, unsigned b) { unsigned h = a * 2654435761u + b * 40503u + 0x9e3779b9u; h ^= h >> 15; h *= 2246822519u; h ^= h >> 13; h *= 3266489917u; h ^= h >> 16; return h; }
__device__ __forceinline__ float dg_bfr(float x) { return bflo(f2bf(x)); }
__device__ __forceinline__ void dg_mods(const Args& A, int k) {
    const int lane = threadIdx.x & 63, gwv = blockIdx.x * 8 + (threadIdx.x >> 6);
    const unsigned h = dg_hash(gwv, k); const int l = h & 3, b = (h >> 2) & 7, e = (h >> 5) % 6144;
    float a = 0.f; for (int d = lane; d < DM; d += 64) a += fsilu(A.in[I_C][b * DM + d]) * A.in[I_ADAW][((size_t)l * DM + d) * 6144 + e];
    a = wave_sum(a) + A.in[I_ADAB][l * 6144 + e];
    const float got = ((const float*)(A.ws + TB_MODS))[((size_t)l * NBATCH + b) * 6144 + e];
    if (lane == 0) dg_put(A, k, dg_rel(got, a));
}
__device__ __forceinline__ void dg_norm(const Args& A, int k, const float* x, const float* gain, int L, int which) {
    const int lane = threadIdx.x & 63, gwv = blockIdx.x * 8 + (threadIdx.x >> 6);
    const int row = dg_hash(gwv, k) & (MTOK - 1), b = row >> 13;
    const float* modl = (const float*)(A.ws + TB_MODS) + ((size_t)L * NBATCH + b) * 6144;
    float ss = 0.f; for (int c = lane; c < DM; c += 64) { const float v = x[(size_t)row * DM + c]; ss += v * v; }
    ss = wave_sum(ss); const float rstd = 1.0f / sqrtf(ss / DM + EPS); float e = 0.f;
    for (int c = lane; c < DM; c += 64) { const float ref = x[(size_t)row * DM + c] * rstd * gain[c] * (1.0f + modl[(which * 3 + 1) * 1024 + c]) + modl[(which * 3) * 1024 + c];
        e = fmaxf(e, dg_rel(bf2f(((const bf16_t*)(A.ws + WS_HM))[(size_t)row * DM + c]), ref)); }
    dg_put(A, k, e);
}
__device__ __forceinline__ void dg_qkv(const Args& A, int k, int al) {
    const int lane = threadIdx.x & 63, gwv = blockIdx.x * 8 + (threadIdx.x >> 6);
    const unsigned h = dg_hash(gwv, k); const int row = h & (MTOK - 1), t = (h >> 16) % 48, col = t * 64 + lane;
    const bf16_t* hm = (const bf16_t*)(A.ws + WS_HM) + (size_t)row * DM; const float* w = A.in[I_ATWIN] + (size_t)al * 1024 * 3072 + col;
    float a = 0.f; for (int kk = 0; kk < DM; ++kk) a += bf2f(hm[kk]) * dg_bfr(w[(size_t)kk * 3072]);
    float ref, got;
    if (t < 32) {
        const int part = t >> 4, sh = t & 15; const float ss = wave_sum(a * a); const float rstd = 1.0f / sqrtf(ss / 64.0f + EPS);
        const float y = a * rstd * (part ? A.in[I_ATKN] : A.in[I_ATQN])[al * 64 + lane]; const float yp = __shfl_xor(y, 32);
        const int pos = row & (SEQ - 1); const float cs = ((const float*)(A.ws + TB_COS))[pos * 32 + (lane & 31)], sn = ((const float*)(A.ws + TB_SIN))[pos * 32 + (lane & 31)];
        ref = (lane < 32) ? (y * cs - yp * sn) : (y * cs + yp * sn); if (part == 0) ref *= 0.125f * LOG2E;
        got = bf2f(((const bf16_t*)(A.ws + (part ? A_K : A_Q)))[(size_t)row * DM + sh * 64 + lane]);
    } else { ref = a; got = bf2f(((const bf16_t*)(A.ws + A_V))[(size_t)row * DM + (t - 32) * 64 + lane]); }
    dg_put(A, k, dg_rel(got, ref));
}
__device__ __forceinline__ void dg_attn(const Args& A, int k, int al, LAS unsigned char* lds) {
    const int tid = threadIdx.x; const unsigned h = dg_hash(blockIdx.x, k); const int row = h & (MTOK - 1), hd = (h >> 16) & 7, b = row >> 13;
    const bf16_t* Q = (const bf16_t*)(A.ws + A_Q); const bf16_t* K = (const bf16_t*)(A.ws + A_K); const bf16_t* V = (const bf16_t*)(A.ws + A_V);
    const float* scal = (const float*)(A.ws + TB_SCAL); const float lamv = scal[SC_LAM0 + al], omli = scal[SC_OML0 + al], Mc = scal[SC_MC0 + al];
    LAS float* p0 = (LAS float*)lds; LAS float* p1 = p0 + SEQ; LAS float* red = p1 + SEQ;
    float l0 = 0.f, l1 = 0.f;
    for (int key = tid; key < SEQ; key += NTHR) { const bf16_t* kr = K + ((size_t)b * SEQ + key) * DM + hd * 128; const bf16_t* qr = Q + (size_t)row * DM + hd * 128;
        float s0 = 0.f, s1 = 0.f; for (int d = 0; d < 64; ++d) { s0 += bf2f(qr[d]) * bf2f(kr[d]); s1 += bf2f(qr[64 + d]) * bf2f(kr[64 + d]); }
        const float e0 = fexp2(s0 - Mc), e1 = fexp2(s1 - Mc); p0[key] = e0; p1[key] = e1; l0 += e0; l1 += e1; }
    l0 = wave_sum(l0); l1 = wave_sum(l1); if ((tid & 63) == 0) { red[tid >> 6] = l0; red[8 + (tid >> 6)] = l1; }
    __syncthreads();
    l0 = 0.f; l1 = 0.f; for (int w = 0; w < 8; ++w) { l0 += red[w]; l1 += red[8 + w]; }
    __syncthreads();
    const int dv = tid & 127, part = tid >> 7; float o = 0.f;
    for (int key = part * 2048; key < part * 2048 + 2048; ++key) o += (p0[key] / l0 - lamv * p1[key] / l1) * bf2f(V[((size_t)b * SEQ + key) * DM + hd * 128 + dv]);
    red[16 + part * 128 + dv] = o; __syncthreads();
    if (tid < 128) { o = red[16 + tid] + red[16 + 128 + tid] + red[16 + 256 + tid] + red[16 + 384 + tid]; red[600 + tid] = o * o; }
    __syncthreads();
    if (tid < 128) { float ss = 0.f; for (int i = 0; i < 128; ++i) ss += red[600 + i]; const float ref = o / sqrtf(ss / 128.0f + EPS) * A.in[I_ATSUB][al * 128 + tid] * omli;
        dg_put(A, k, dg_rel(bf2f(((const bf16_t*)(A.ws + WS_HM))[(size_t)row * DM + hd * 128 + tid]), ref)); }
    __syncthreads();
}
__device__ __forceinline__ void dg_save(const Args& A, int k, const float* xold) {
    const int lane = threadIdx.x & 63, gwv = blockIdx.x * 8 + (threadIdx.x >> 6);
    const unsigned h = dg_hash(gwv, k); const int row = h & (MTOK - 1), col = (h >> 16) & 1023;
    float* sv = (float*)(A.ws + TB_LSUM) + 7 * 1024 * 1024 / 4;
    if (lane == 0) sv[k * 4096 + gwv] = xold[(size_t)row * DM + col];
}
__device__ __forceinline__ void dg_res(const Args& A, int k, const float* xnew, const float* gate, const bf16_t* Am, int K, const float* W) {
    const int lane = threadIdx.x & 63, gwv = blockIdx.x * 8 + (threadIdx.x >> 6);
    const unsigned h = dg_hash(gwv, k); const int row = h & (MTOK - 1), col = (h >> 16) & 1023, b = row >> 13;
    const float* sv = (const float*)(A.ws + TB_LSUM) + 7 * 1024 * 1024 / 4;
    float a = 0.f; for (int kk = lane; kk < K; kk += 64) a += bf2f(Am[(size_t)row * K + kk]) * dg_bfr(W[(size_t)kk * DM + col]);
    a = wave_sum(a);
    const float ref = sv[k * 4096 + gwv] + gate[(size_t)b * 6144 + col] * a;
    if (lane == 0) dg_put(A, k, dg_rel(xnew[(size_t)row * DM + col], ref));
}
__device__ __forceinline__ void dg_swiglu(const Args& A, int k, const bf16_t* Am, const float* W, int F, const bf16_t* H, int nrows, const int* rowmap) {
    const int lane = threadIdx.x & 63, gwv = blockIdx.x * 8 + (threadIdx.x >> 6);
    const unsigned h = dg_hash(gwv, k); const int row = (h & 0xfffff) % nrows, j = (h >> 20) % F;
    float g = 0.f, u = 0.f; for (int kk = lane; kk < DM; kk += 64) { const float x = bf2f(Am[(size_t)row * DM + kk]); g += x * dg_bfr(W[(size_t)kk * 2 * F + j]); u += x * dg_bfr(W[(size_t)kk * 2 * F + F + j]); }
    g = wave_sum(g); u = wave_sum(u);
    const float ref = g / (1.0f + expf(-g)) * u;
    if (lane == 0) dg_put(A, k, dg_rel(bf2f(H[(size_t)row * F + j]), ref));
}
__device__ __forceinline__ void dg_hgin(const Args& A, int k) {
    const int lane = threadIdx.x & 63, gwv = blockIdx.x * 8 + (threadIdx.x >> 6);
    const unsigned h = dg_hash(gwv, k); const int row = h & (MTOK - 1), col = (h >> 16) % 5120, grp = col >> 10, cc = col & 1023;
    float a = 0.f; for (int kk = lane; kk < DM; kk += 64) a += bf2f(((const bf16_t*)(A.ws + WS_HM))[(size_t)row * DM + kk]) * dg_bfr(A.in[I_HGWIN][(size_t)kk * 5120 + col]);
    a = wave_sum(a);
    float ref, got;
    if (grp == 0 || grp == 4) { ref = a / (1.0f + expf(-a)); got = bf2f(((const bf16_t*)(A.ws + (grp == 0 ? H_Q : H_G)))[(size_t)row * DM + cc]); }
    else if (grp == 3) { ref = a; got = bf2f(((const bf16_t*)(A.ws + H_V))[(size_t)row * DM + cc]); }
    else { const int d = grp - 1; const float* p = A.in[I_HGLB] + (size_t)d * DEPTH * 1024 + cc; float mx = p[0]; for (int l = 1; l < DEPTH; ++l) mx = fmaxf(mx, p[l * 1024]);
        float den = 0.f; for (int l = 0; l < DEPTH; ++l) den += expf(p[l * 1024] - mx); const float lbv = expf(p[1024] - mx) / den;
        ref = logf(lbv + (1.0f - lbv) / (1.0f + expf(-a))); got = gla::h2f(((const unsigned short*)(A.ws + (d ? H_LFB : H_LFF)))[(size_t)row * DM + cc]); }
    if (lane == 0) dg_put(A, k, dg_rel(got, ref));
}
__device__ __forceinline__ void dg_gla(const Args& A, int k) {
    const int lane = threadIdx.x & 63, gwv = blockIdx.x * 8 + (threadIdx.x >> 6);
    const unsigned h = dg_hash(gwv, k); const int sel0 = (gwv & 3) == 0; const int b = sel0 ? 0 : (h & 7), hd = sel0 ? 0 : ((h >> 3) & 7), dir = sel0 ? 0 : ((h >> 6) & 1), vc = sel0 ? ((h >> 7) & 63) : ((h >> 7) & 127);
    const bf16_t* Q = (const bf16_t*)(A.ws + H_Q); const unsigned short* LF = (const unsigned short*)(A.ws + (dir ? H_LFB : H_LFF)); const bf16_t* V = (const bf16_t*)(A.ws + H_V);
    const bf16_t* O = (const bf16_t*)(A.ws + (dir ? H_OB : H_OF));
    float s0 = 0.f, s1 = 0.f, e0 = 0.f, e1 = 0.f, e2 = 0.f, e3 = 0.f;
    for (int i = 0; i < SEQ; ++i) { const int tok = dir ? (SEQ - 1 - i) : i; const size_t o = ((size_t)b * SEQ + tok) * DM + hd * 128;
        const float f0 = expf(gla::h2f(LF[o + lane])), f1 = expf(gla::h2f(LF[o + 64 + lane])), v = bf2f(V[o + vc]);
        s0 = f0 * s0 + (1.0f - f0) * v; s1 = f1 * s1 + (1.0f - f1) * v;
        if (i < 128 || i % 61 == 0) { const float ov = wave_sum(bf2f(Q[o + lane]) * s0 + bf2f(Q[o + 64 + lane]) * s1); const float er = 0.25f * fabsf(bf2f(O[o + vc]) - ov) / (fabsf(ov) + 1.0f);
            if (i == 0) e0 = er; else if (i < 64) e1 = fmaxf(e1, er); else if (i < 128) e2 = fmaxf(e2, er); else e3 = fmaxf(e3, er); } }
    if (lane == 0) { dg_put(A, k, e0); dg_put(A, k + 4, e1); dg_put(A, k + 5, e2); dg_put(A, k + 6, e3); }
    const float* dbg = (const float*)(A.ws + TB_LSUM); const unsigned short* LF0 = (const unsigned short*)(A.ws + H_LFF); const bf16_t* Q0 = (const bf16_t*)(A.ws + H_Q);
    { const unsigned h2 = dg_hash(gwv, k + 100); const int t = h2 & 63, kk = (h2 >> 6) & 127; float c = 0.f; for (int tt = 0; tt <= t; ++tt) c += gla::h2f(LF0[(size_t)tt * DM + kk]);
      if (lane == 0) dg_put(A, k + 1, dg_rel(dbg[t * 128 + kk], c)); }
    { const unsigned h2 = dg_hash(gwv, k + 200); const int t = h2 & 63, sidx = (h2 >> 6) & 63; float a = 0.f;
      if (sidx <= t) { for (int kk = lane; kk < 128; kk += 64) { float c = 0.f; for (int tt = sidx + 1; tt <= t; ++tt) c += gla::h2f(LF0[(size_t)tt * DM + kk]);
              a += bf2f(Q0[(size_t)t * DM + kk]) * (1.0f - expf(gla::h2f(LF0[(size_t)sidx * DM + kk]))) * expf(c); } a = wave_sum(a); }
      const unsigned short got = ((const unsigned short*)(dbg + 8192))[gla::sw128(t, sidx * 2) / 2];
      if (lane == 0) dg_put(A, k + 2, 5.0f * fabsf(bf2f(got) - a) / (fabsf(a) + 0.01f)); }
    { const unsigned h2 = dg_hash(gwv, k + 300); const int sidx = h2 & 63, v = (h2 >> 6) & 63;
      const unsigned short got = ((const unsigned short*)(dbg + 8192 + 2048))[gla::sw128(v, sidx * 2) / 2];
      if (lane == 0) dg_put(A, k + 2, dg_rel(bf2f(got), bf2f(((const bf16_t*)(A.ws + H_V))[(size_t)sidx * DM + v]))); }
    { const unsigned h2 = dg_hash(gwv, k + 500); const int kk = h2 & 127, v = (h2 >> 7) & 63;
      float a = 0.f; { const int sidx = lane; float c = 0.f; for (int tt = sidx + 1; tt < 64; ++tt) c += gla::h2f(LF0[(size_t)tt * DM + kk]);
          const float ksn = (1.0f - expf(gla::h2f(LF0[(size_t)sidx * DM + kk]))) * expf(c);
          const unsigned short gk = ((const unsigned short*)(dbg + 16384))[gla::sw128(kk, sidx * 2) / 2];
          dg_put(A, k + 2, 0.5f * fabsf(bf2f(gk) - ksn) / (fabsf(ksn) + 0.01f));
          a = ksn * bf2f(((const bf16_t*)(A.ws + H_V))[(size_t)sidx * DM + v]); }
      a = wave_sum(a);
      const unsigned short gs = ((const unsigned short*)(dbg + 12288))[gla::sw256(v, kk * 2) / 2];
      if (lane == 0) dg_put(A, k + 3, 0.5f * fabsf(bf2f(gs) - a) / (fabsf(a) + 0.05f)); }
    { const unsigned h2 = dg_hash(gwv, k + 400); const int t = h2 & 63, v = (h2 >> 6) & 63;
      const unsigned short* at = (const unsigned short*)(dbg + 8192); const unsigned short* vt = (const unsigned short*)(dbg + 8192 + 2048);
      float a = bf2f(at[gla::sw128(t, lane * 2) / 2]) * bf2f(vt[gla::sw128(v, lane * 2) / 2]); a = wave_sum(a);
      if (lane == 0) dg_put(A, k + 1, 5.0f * dg_rel(bf2f(((const bf16_t*)(A.ws + H_OF))[(size_t)t * DM + v]), a)); }
}
__device__ __forceinline__ void dg_normo(const Args& A, int k) {
    const int lane = threadIdx.x & 63, gwv = blockIdx.x * 8 + (threadIdx.x >> 6);
    const unsigned h = dg_hash(gwv, k); const int row = h & (MTOK - 1), hd = (h >> 16) & 7; const size_t o = (size_t)row * DM + hd * 128;
    const float v0 = bf2f(((const bf16_t*)(A.ws + H_OF))[o + lane]) + bf2f(((const bf16_t*)(A.ws + H_OB))[o + lane]), v1 = bf2f(((const bf16_t*)(A.ws + H_OF))[o + 64 + lane]) + bf2f(((const bf16_t*)(A.ws + H_OB))[o + 64 + lane]);
    const float ss = wave_sum(v0 * v0 + v1 * v1), rstd = 1.0f / sqrtf(ss / 128.0f + EPS);
    const float r0 = v0 * rstd * A.in[I_HGNG][lane] * bf2f(((const bf16_t*)(A.ws + H_G))[o + lane]), r1 = v1 * rstd * A.in[I_HGNG][64 + lane] * bf2f(((const bf16_t*)(A.ws + H_G))[o + 64 + lane]);
    dg_put(A, k, fmaxf(dg_rel(bf2f(((const bf16_t*)(A.ws + WS_HM))[o + lane]), r0), dg_rel(bf2f(((const bf16_t*)(A.ws + WS_HM))[o + 64 + lane]), r1)));
}
__device__ __forceinline__ void dg_router(const Args& A, int k, int L) {
    const int lane = threadIdx.x & 63, gwv = blockIdx.x * 8 + (threadIdx.x >> 6);
    const int row = dg_hash(gwv, k) & (MTOK - 1), b = row >> 13; const float* x = A.out + (size_t)row * DM;
    const float* modl = (const float*)(A.ws + TB_MODS) + ((size_t)L * NBATCH + b) * 6144; const float* gain = A.in[I_N2G] + L * DM; const float* R = A.in[I_MOER] + (size_t)(L >> 1) * DM * 8;
    float ss = 0.f; for (int c = lane; c < DM; c += 64) ss += x[c] * x[c];
    ss = wave_sum(ss); const float rstd = 1.0f / sqrtf(ss / DM + EPS);
    float lg[8]; for (int e = 0; e < 8; ++e) lg[e] = 0.f;
    for (int c = lane; c < DM; c += 64) { const float hv = x[c] * rstd * gain[c] * (1.0f + modl[4 * 1024 + c]) + modl[3 * 1024 + c]; for (int e = 0; e < 8; ++e) lg[e] += hv * R[c * 8 + e]; }
    for (int e = 0; e < 8; ++e) lg[e] = wave_sum(lg[e]);
    int e0 = 0; for (int e = 1; e < 8; ++e) if (lg[e] > lg[e0]) e0 = e;
    int e1 = (e0 == 0) ? 1 : 0; for (int e = 0; e < 8; ++e) if (e != e0 && lg[e] > lg[e1]) e1 = e;
    float gap = 1e9f; for (int e = 0; e < 8; ++e) if (e != e0 && e != e1) gap = fminf(gap, lg[e1] - lg[e]); gap = fminf(gap, lg[e0] - lg[e1]);
    const int g0 = ((const int*)(A.ws + TB_EID))[row * 2], g1 = ((const int*)(A.ws + TB_EID))[row * 2 + 1]; const float w0 = ((const float*)(A.ws + TB_GATE))[row * 2], w1 = ((const float*)(A.ws + TB_GATE))[row * 2 + 1];
    const float p0 = 1.0f / (1.0f + expf(lg[e1] - lg[e0]));
    float er = (g0 != e0 || g1 != e1) ? (gap > 2e-3f ? 9.f : 0.f) : fmaxf(fabsf(w0 - p0), fabsf(w1 - (1.0f - p0)));
    if (lane == 0) dg_put(A, k, er);
}
__device__ __forceinline__ void dg_place(const Args& A, int k) {
    const int lane = threadIdx.x & 63, gwv = blockIdx.x * 8 + (threadIdx.x >> 6);
    const unsigned h = dg_hash(gwv, k); const int row = h & (MTOK - 1), kk = (h >> 16) & 1;
    const int sl = ((const int*)(A.ws + TB_SLOT))[row * 2 + kk], e = ((const int*)(A.ws + TB_EID))[row * 2 + kk]; const int* ts = (const int*)(A.ws + TB_TILES);
    float er = (sl >= ts[e] * 256 && sl < ts[e + 1] * 256 && sl < MOE_ROWS) ? 0.f : 7.f;
    if (er == 0.f) for (int c = lane; c < DM; c += 64) if (((const bf16_t*)(A.ws + E_XS))[(size_t)sl * DM + c] != ((const bf16_t*)(A.ws + WS_HM))[(size_t)row * DM + c]) er = 5.f;
    dg_put(A, k, er);
}
__device__ __forceinline__ void dg_moe_hid(const Args& A, int k, int m) {
    const int lane = threadIdx.x & 63, gwv = blockIdx.x * 8 + (threadIdx.x >> 6);
    const unsigned h = dg_hash(gwv, k); const int row = h & (MTOK - 1), kk = (h >> 16) & 1, j = (h >> 17) % DFFE;
    const int sl = ((const int*)(A.ws + TB_SLOT))[row * 2 + kk], e = ((const int*)(A.ws + TB_EID))[row * 2 + kk];
    const float* W = A.in[I_MOEGU] + ((size_t)m * 8 + e) * DM * 2 * DFFE; const bf16_t* Am = (const bf16_t*)(A.ws + E_XS) + (size_t)sl * DM;
    float g = 0.f, u = 0.f; for (int c = lane; c < DM; c += 64) { const float x = bf2f(Am[c]); g += x * dg_bfr(W[(size_t)c * 2 * DFFE + j]); u += x * dg_bfr(W[(size_t)c * 2 * DFFE + DFFE + j]); }
    g = wave_sum(g); u = wave_sum(u);
    if (lane == 0) dg_put(A, k, dg_rel(bf2f(((const bf16_t*)(A.ws + E_HID))[(size_t)sl * DFFE + j]), g / (1.0f + expf(-g)) * u));
}
__device__ __forceinline__ void dg_moe_y(const Args& A, int k, int m) {
    const int lane = threadIdx.x & 63, gwv = blockIdx.x * 8 + (threadIdx.x >> 6);
    const unsigned h = dg_hash(gwv, k); const int row = h & (MTOK - 1), kk = (h >> 16) & 1, col = (h >> 17) & 1023;
    const int sl = ((const int*)(A.ws + TB_SLOT))[row * 2 + kk], e = ((const int*)(A.ws + TB_EID))[row * 2 + kk];
    const float* W = A.in[I_MOEDN] + ((size_t)m * 8 + e) * DFFE * DM; const bf16_t* Hh = (const bf16_t*)(A.ws + E_HID) + (size_t)sl * DFFE;
    float a = 0.f; for (int j = lane; j < DFFE; j += 64) a += bf2f(Hh[j]) * dg_bfr(W[(size_t)j * DM + col]);
    a = wave_sum(a);
    if (lane == 0) dg_put(A, k, fabsf(bf2f(((const bf16_t*)(A.ws + E_XS))[(size_t)sl * DM + col]) - a) / (fabsf(a) + 0.3f));
}
__device__ __forceinline__ void dg_combine(const Args& A, int k, const float* modprev) {
    const int lane = threadIdx.x & 63, gwv = blockIdx.x * 8 + (threadIdx.x >> 6);
    const unsigned h = dg_hash(gwv, k); const int row = h & (MTOK - 1), col = (h >> 16) & 1023, b = row >> 13;
    const float* sv = (const float*)(A.ws + TB_LSUM) + 7 * 1024 * 1024 / 4; const bf16_t* Y = (const bf16_t*)(A.ws + E_XS);
    const int s0 = ((const int*)(A.ws + TB_SLOT))[row * 2], s1 = ((const int*)(A.ws + TB_SLOT))[row * 2 + 1]; const float w0 = ((const float*)(A.ws + TB_GATE))[row * 2], w1 = ((const float*)(A.ws + TB_GATE))[row * 2 + 1];
    const float ref = sv[k * 4096 + gwv] + modprev[(size_t)b * 6144 + 5 * 1024 + col] * (w0 * bf2f(Y[(size_t)s0 * DM + col]) + w1 * bf2f(Y[(size_t)s1 * DM + col]));
    if (lane == 0) dg_put(A, k, dg_rel(A.out[(size_t)row * DM + col], ref));
}
__device__ __forceinline__ void dg_lruin(const Args& A, int k) {
    const int lane = threadIdx.x & 63, gwv = blockIdx.x * 8 + (threadIdx.x >> 6);
    const unsigned h = dg_hash(gwv, k); const int row = h & (MTOK - 1), col = (h >> 16) % 2560;
    float a = 0.f; for (int kk = lane; kk < DM; kk += 64) a += bf2f(((const bf16_t*)(A.ws + WS_HM))[(size_t)row * DM + kk]) * dg_bfr(A.in[I_LRWIN][(size_t)kk * 2560 + col]);
    a = wave_sum(a);
    float ref, got;
    if (col < LRUW) { ref = 0.5f * a * (1.0f + tanhf(0.7978845608028654f * (a + 0.044715f * a * a * a))); got = bf2f(((const bf16_t*)(A.ws + L_YB))[(size_t)row * LRUW + col]); }
    else { ref = a; got = bf2f(((const bf16_t*)(A.ws + L_XB))[(size_t)row * LRUW + col - LRUW]); }
    if (lane == 0) dg_put(A, k, dg_rel(got, ref));
}
__device__ __forceinline__ void dg_lru(const Args& A, int k) {
    const int lane = threadIdx.x & 63, gwv = blockIdx.x * 8 + (threadIdx.x >> 6);
    const unsigned h = dg_hash(gwv, k); const int b = h & 7, ch = (h >> 3) % LRUW, tc = (h >> 16) & (SEQ - 1), n = ch / 128, j = ch % 128;
    const bf16_t* XB = (const bf16_t*)(A.ws + L_XB) + (size_t)b * SEQ * LRUW;
    float hres[2];
    for (int d = 0; d < 2; ++d) {
        const float* wa = A.in[I_LRWA] + (size_t)(d * 10 + n) * 16384; const float* wx = A.in[I_LRWX] + (size_t)(d * 10 + n) * 16384;
        const float wa0 = dg_bfr(wa[lane * 128 + j]), wa1 = dg_bfr(wa[(lane + 64) * 128 + j]), wx0 = dg_bfr(wx[lane * 128 + j]), wx1 = dg_bfr(wx[(lane + 64) * 128 + j]);
        const float ba = A.in[I_LRBA][d * LRUW + ch], bx = A.in[I_LRBX][d * LRUW + ch]; const float lam = A.in[I_LRLAM][d * LRUW + ch]; const float sp = log1pf(expf(-lam));
        float hs = 0.f;
        for (int i = 0; ; ++i) { const int t = d ? (SEQ - 1 - i) : i;
            float x0 = A.in[I_LRCB][n * 128 + lane], x1 = A.in[I_LRCB][n * 128 + 64 + lane], xj = A.in[I_LRCB][ch];
            for (int w = 0; w < 4; ++w) { const int tt = t - 1 + w; if (tt >= 0 && tt < SEQ) {
                x0 += A.in[I_LRCW][w * LRUW + n * 128 + lane] * bf2f(XB[(size_t)tt * LRUW + n * 128 + lane]); x1 += A.in[I_LRCW][w * LRUW + n * 128 + 64 + lane] * bf2f(XB[(size_t)tt * LRUW + n * 128 + 64 + lane]);
                xj += A.in[I_LRCW][w * LRUW + ch] * bf2f(XB[(size_t)tt * LRUW + ch]); } }
            const float rp = wave_sum(dg_bfr(x0) * wa0 + dg_bfr(x1) * wa1), ip = wave_sum(dg_bfr(x0) * wx0 + dg_bfr(x1) * wx1);
            const float rg = 1.0f / (1.0f + expf(-(rp + ba))), ig = 1.0f / (1.0f + expf(-(ip + bx))); const float la = -8.0f * rg * sp;
            hs = expf(la) * hs + sqrtf(fmaxf(-expm1f(2.0f * la), 0.f)) * ig * xj;
            if (t == tc) break; }
        hres[d] = hs;
    }
    const size_t go = ((size_t)b * SEQ + tc) * LRUW + ch;
    const float e1 = fabsf(bf2f(((const bf16_t*)(A.ws + L_HF))[go]) - hres[0]) / (fabsf(hres[0]) + 0.3f);
    const float ref = (hres[0] + hres[1]) * bf2f(((const bf16_t*)(A.ws + L_YB))[go]);
    const float e2 = fabsf(bf2f(((const bf16_t*)(A.ws + L_HY))[go]) - ref) / (fabsf(ref) + 0.3f);
    if (lane == 0) { dg_put(A, k, e1); dg_put(A, k + 5, e2); }
}
__device__ __forceinline__ void dg_final(const Args& A, int nchk) {
    const unsigned* sl = (const unsigned*)(A.ws + WS_CTL) + DG_BASE; int code = 0; float ev = 0.f;
    for (int k = 1; k <= nchk; ++k) { const float e = __uint_as_float(sl[64 * k]); if (e > 0.05f) { code = k; ev = e; break; } }
    if (code == 0) return;
    const int c1 = code % 10, c10 = code / 10;
    const float s = -(float)c1;
    for (size_t i = (size_t)blockIdx.x * NTHR + threadIdx.x; i < (size_t)MTOK * DM; i += (size_t)gridDim.x * NTHR) A.out[i] = A.in[I_X][i] * s;
    __syncthreads();
    if (blockIdx.x == 0 && threadIdx.x == 0) { const int qq = ev < 0.1f ? 1 : ev < 0.2f ? 2 : ev < 0.5f ? 3 : ev < 1.f ? 4 : ev < 2.f ? 5 : ev < 5.f ? 6 : ev < 20.f ? 7 : ev < 1e3f ? 8 : 9;
        A.out[12345] = 100.f * (float)(10 * c10 + qq); }
}
#define DG(x) x
#define DGL(x) if constexpr (L >= DIAG_FROM) { x }
#else
#define DG(x)
#define DGL(x)
#endif

#define GRID_BAR() xcd_barrier(bar)
template <int L>
__device__ __forceinline__ void run_mixer(const Args& args, LAS unsigned char* lds, int bid, int G, const XcdBarrier& bar) {
    unsigned char* ws = args.ws; bf16_t* xo = (bf16_t*)(ws + WS_XB);
    const float* modl = (const float*)(ws + TB_MODS) + (size_t)L * NBATCH * 6144;
    const void* xs = (L == 0) ? (const void*)args.in[I_X] : (const void*)xo; constexpr bool X16 = (L != 0);
    constexpr int kind = L % 3;
    DGL(if (L > 0 && ((L - 1) & 1)) { dg_save(args, 10 * (L - 1) + 9, xo); GRID_BAR(); })
    norm_phase<false>(args, lds, bid, G, xs, X16, xo, true, args.in[I_N1G] + L * DM, modl, 0, (L > 0) && ((L - 1) & 1), modl - NBATCH * 6144, false, nullptr);
    GRID_BAR();
    DGL(if (L > 0 && ((L - 1) & 1)) { dg_combine(args, 10 * (L - 1) + 9, modl - NBATCH * 6144); GRID_BAR(); })
    DGL(dg_norm(args, 10 * L + 1, (L > 0 && ((L - 1) & 1)) ? xo : xs, args.in[I_N1G] + L * DM, L, 0); GRID_BAR();)
    if constexpr (kind == 0) {
        constexpr int al = L / 3;
        {
            pg8::Gemm g{(const bf16_t*)(ws + WS_HM), (const bf16_t*)(ws + W_QKV) + (size_t)al * 3072 * 1024, 1024};
            pg8::TileOrder S; S.init(256, 12, G, bid);
            pg8::EpiQKV E{(bf16_t*)(ws + A_Q), (bf16_t*)(ws + A_K), (bf16_t*)(ws + A_V), args.in[I_ATQN] + al * 64, args.in[I_ATKN] + al * 64,
                          (const float*)(ws + TB_COS), (const float*)(ws + TB_SIN), LOG2E};
            pg8::gemm_phase<pg8::EpiQKV>(lds, g, S, E);
        }
        GRID_BAR();
        vt_phase(args, bid, G);
        GRID_BAR();
        attn_phase(args, lds, bid, G, al);
        GRID_BAR();
        DGL(dg_save(args, 10 * L + 4, xs); GRID_BAR();)
        {
            pg8::Gemm g{(const bf16_t*)(ws + WS_HM), (const bf16_t*)(ws + W_AO) + (size_t)al * 1024 * 1024, 1024};
            pg8::TileOrder S; S.init(256, 4, G, bid);
            pg8::EpiRes<X16> E{xs, xo, modl + 2 * 1024, 1.0f};
            pg8::gemm_phase<pg8::EpiRes<X16>>(lds, g, S, E);
        }
        GRID_BAR();
        DGL(dg_res(args, 10 * L + 4, xo, modl + 2 * 1024, (const bf16_t*)(ws + WS_HM), 1024, args.in[I_ATWOUT] + (size_t)al * 1024 * 1024); GRID_BAR();)
    }
    if constexpr (kind == 1) {
        {
            pg8::Gemm g{(const bf16_t*)(ws + WS_HM), (const bf16_t*)(ws + W_HGI), 1024};
            pg8::TileOrder S; S.init(256, 20, G, bid);
            pg8::EpiAct E{0, ws, (const float*)(ws + TB_LB)};
            pg8::gemm_phase<pg8::EpiAct>(lds, g, S, E);
        }
        GRID_BAR();
        DGL(dg_hgin(args, 10 * L + 2); GRID_BAR();)
        gla_phase(args, lds, bid, G);
        GRID_BAR();
        DGL(dg_gla(args, 10 * L + 3); GRID_BAR();)
        hg_normo_phase(args, bid, G);
        GRID_BAR();
        DGL(dg_normo(args, 10 * L + 0); GRID_BAR();)
        DGL(dg_save(args, 10 * L + 4, xs); GRID_BAR();)
        {
            pg8::Gemm g{(const bf16_t*)(ws + WS_HM), (const bf16_t*)(ws + W_HGO), 1024};
            pg8::TileOrder S; S.init(256, 4, G, bid);
            pg8::EpiRes<X16> E{xs, xo, modl + 2 * 1024, 1.0f};
            pg8::gemm_phase<pg8::EpiRes<X16>>(lds, g, S, E);
        }
        GRID_BAR();
        DGL(dg_res(args, 10 * L + 4, xo, modl + 2 * 1024, (const bf16_t*)(ws + WS_HM), 1024, args.in[I_HGWOUT]); GRID_BAR();)
    }
    if constexpr (kind == 2) {
        {
            pg8::Gemm g{(const bf16_t*)(ws + WS_HM), (const bf16_t*)(ws + W_LRI), 1024};
            pg8::TileOrder S; S.init(256, 10, G, bid);
            pg8::EpiAct E{1, ws, nullptr};
            pg8::gemm_phase<pg8::EpiAct>(lds, g, S, E);
        }
        GRID_BAR();
        DGL(dg_lruin(args, 10 * L + 2); GRID_BAR();)
        lru_phase<0>(args, lds, bid, G);
        GRID_BAR();
        lru_carry_phase(args, bid, G);
        GRID_BAR();
        lru_apply_phase(args, lds, bid, G);
        GRID_BAR();
        DGL(dg_lru(args, 10 * L + 3); GRID_BAR();)
        DGL(dg_save(args, 10 * L + 4, xs); GRID_BAR();)
        {
            pg8::Gemm g{(const bf16_t*)(ws + L_HY), (const bf16_t*)(ws + W_LRO), LRUW};
            pg8::TileOrder S; S.init(256, 4, G, bid);
            pg8::EpiRes<X16> E{xs, xo, modl + 2 * 1024, 1.0f};
            pg8::gemm_phase<pg8::EpiRes<X16>>(lds, g, S, E);
        }
        GRID_BAR();
        DGL(dg_res(args, 10 * L + 4, xo, modl + 2 * 1024, (const bf16_t*)(ws + L_HY), LRUW, args.in[I_LRWOUT]); GRID_BAR();)
    }
}
template <int L>
__device__ __forceinline__ void run_ffn(const Args& args, LAS unsigned char* lds, int bid, int G, const XcdBarrier& bar) {
    unsigned char* ws = args.ws; bf16_t* xo = (bf16_t*)(ws + WS_XB);
    const float* modl = (const float*)(ws + TB_MODS) + (size_t)L * NBATCH * 6144;
    if constexpr ((L & 1) == 0) {
        constexpr int m = L >> 1;
        constexpr bool F8 = (L >= FP8_DENSE_FROM);
        norm_phase<false>(args, lds, bid, G, xo, true, xo, true, args.in[I_N2G] + L * DM, modl, 1, false, modl, false, nullptr, F8);
        GRID_BAR();
        if constexpr (F8) {
            pg8::Gemm g{(const bf16_t*)(ws + WS_HM), (const bf16_t*)(ws + W_FGU) + (size_t)m * 5632 * 1024, 512};
            pg8::TileOrder S; S.init(256, 22, G, bid);
            pg8::EpiSwiGLU8 E{ws + F_HID, DFF, 1.0f / MOE_WSCALE, MOE_HSCALE};
            pg8::gemm_phase<pg8::EpiSwiGLU8, true>(lds, g, S, E);
        } else {
            pg8::Gemm g{(const bf16_t*)(ws + WS_HM), (const bf16_t*)(ws + W_FGU) + (size_t)m * 5632 * 1024, 1024};
            pg8::TileOrder S; S.init(256, 22, G, bid);
            pg8::EpiSwiGLU E{(bf16_t*)(ws + F_HID), DFF};
            pg8::gemm_phase<pg8::EpiSwiGLU>(lds, g, S, E);
        }
        GRID_BAR();
        if constexpr (F8) {
            pg8::Gemm g{(const bf16_t*)(ws + F_HID), (const bf16_t*)(ws + W_FDN) + (size_t)m * 1024 * 2816, DFF / 2};
            pg8::TileOrder S; S.init(256, 4, G, bid);
            pg8::EpiRes<true> E{xo, xo, modl + 5 * 1024, 1.0f / (MOE_WSCALE * MOE_HSCALE)};
            pg8::gemm_phase<pg8::EpiRes<true>, true>(lds, g, S, E);
        } else {
            pg8::Gemm g{(const bf16_t*)(ws + F_HID), (const bf16_t*)(ws + W_FDN) + (size_t)m * 1024 * 2816, DFF};
            pg8::TileOrder S; S.init(256, 4, G, bid);
            pg8::EpiRes<true> E{xo, xo, modl + 5 * 1024, 1.0f};
            pg8::gemm_phase<pg8::EpiRes<true>>(lds, g, S, E);
        }
        GRID_BAR();
    } else {
        constexpr int m = L >> 1;
        norm_phase<true>(args, lds, bid, G, xo, true, xo, true, args.in[I_N2G] + L * DM, modl, 1, false, modl, false, args.in[I_MOER] + (size_t)m * DM * 8);
        GRID_BAR();
        DGL(dg_norm(args, 10 * L + 5, xo, args.in[I_N2G] + L * DM, L, 1); dg_router(args, 10 * L + 5, L); GRID_BAR();)
        place_phase(args, lds, bid, G);
        GRID_BAR();
        DGL(dg_place(args, 10 * L + 6); GRID_BAR();)
        const int* tiles = (const int*)(ws + TB_TILES);
        {
            pg8::Gemm g{(const bf16_t*)(ws + E_XS), (const bf16_t*)(ws + W_MGU + (size_t)m * 8 * 7168 * 1024), 512};
            pg8::TileOrder S; S.init(tiles[8], 28, G, bid);
#pragma unroll
            for (int e = 1; e < NEXP; ++e) S.ts[e] = tiles[e];
            pg8::EpiSwiGLU8 E{ws + E_HID, DFFE, 1.0f / MOE_WSCALE, MOE_HSCALE};
            pg8::gemm_phase<pg8::EpiSwiGLU8, true>(lds, g, S, E);
        }
        GRID_BAR();
        DGL(dg_moe_hid(args, 10 * L + 7, m); GRID_BAR();)
        {
            pg8::Gemm g{(const bf16_t*)(ws + E_HID), (const bf16_t*)(ws + W_MDN + (size_t)m * 8 * 1024 * 3584), DFFE / 2};
            pg8::TileOrder S; S.init(tiles[8], 4, G, bid);
#pragma unroll
            for (int e = 1; e < NEXP; ++e) S.ts[e] = tiles[e];
            pg8::EpiPlain E{(bf16_t*)(ws + E_XS), DM, 1.0f / (MOE_WSCALE * MOE_HSCALE)};
            pg8::gemm_phase<pg8::EpiPlain, true>(lds, g, S, E);
        }
        GRID_BAR();
        DGL(dg_moe_y(args, 10 * L + 8, m); GRID_BAR();)
    }
}
__device__ __forceinline__ void final_combine(const Args& args, LAS unsigned char* lds, int bid, int G, const XcdBarrier& bar) {
    const float* modl = (const float*)(args.ws + TB_MODS) + (size_t)3 * NBATCH * 6144;
    DG(dg_save(args, 39, args.out); GRID_BAR();)
    norm_phase<false>(args, lds, bid, G, args.ws + WS_XB, true, args.out, false, args.in[I_N1G], modl, 0, true, modl, true, nullptr);
    DG(GRID_BAR(); dg_combine(args, 39, modl);)
}

__global__ void __launch_bounds__(NTHR, 2) mega_fwd(Args args) {
    extern __shared__ __attribute__((aligned(16))) unsigned char lds_raw[];
    LAS unsigned char* lds = (LAS unsigned char*)lds_raw;
    const int tid = threadIdx.x, bid = blockIdx.x, G = gridDim.x;
    unsigned char* ws = args.ws;
    volatile LAS unsigned* MISC = (volatile LAS unsigned*)(lds + MISC_OFF);
    if (tid < 64) MISC[tid] = 0u;
    __syncthreads();
    XcdBarrier bar = xcd_barrier_post((unsigned*)(ws + WS_CTL) + CW_BAR, MISC + 8);

    prologue_phase(args, lds, bid, G);
    GRID_BAR();

    run_mixer<0>(args, lds, bid, G, bar);
    run_ffn<0>(args, lds, bid, G, bar);
    run_mixer<1>(args, lds, bid, G, bar);
    run_ffn<1>(args, lds, bid, G, bar);
    run_mixer<2>(args, lds, bid, G, bar);
    run_ffn<2>(args, lds, bid, G, bar);
    run_mixer<3>(args, lds, bid, G, bar);
    run_ffn<3>(args, lds, bid, G, bar);
    final_combine(args, lds, bid, G, bar);
    DG(GRID_BAR(); dg_final(args, 49);)
}

extern "C" void kernel_launch(void* const* d_in, const int* in_sizes, int n_in, void* d_out, int out_size, void* d_ws, size_t ws_size, hipStream_t stream) {
    static int grid = 0;
    if (grid == 0) {
        if (n_in != 30 || out_size != MTOK * DM || ws_size < WS_NEED) { fprintf(stderr, "kernel_launch: unexpected shapes (n_in %d out %d ws %zu need %zu)\n", n_in, out_size, ws_size, (size_t)WS_NEED); grid = -1; return; }
        int dev = 0, cus = 0;
        if (hipGetDevice(&dev) != hipSuccess || hipDeviceGetAttribute(&cus, hipDeviceAttributeMultiprocessorCount, dev) != hipSuccess) { grid = -1; return; }
        if (hipFuncSetAttribute((const void*)mega_fwd, hipFuncAttributeMaxDynamicSharedMemorySize, LDS_BYTES) != hipSuccess) { fprintf(stderr, "kernel_launch: hipFuncSetAttribute failed\n"); grid = -1; return; }
        int per_cu = 0;
        if (hipOccupancyMaxActiveBlocksPerMultiprocessor(&per_cu, (const void*)mega_fwd, NTHR, LDS_BYTES) != hipSuccess || per_cu < 1) { fprintf(stderr, "kernel_launch: occupancy query says %d\n", per_cu); }
        (void)hipGetLastError();
        grid = (cus >= 256) ? 256 : -1;
        if (grid < 0) { fprintf(stderr, "kernel_launch: needs 256 CUs, device has %d\n", cus); return; }
    }
    if (grid < 0) return;
    if (hipMemsetAsync((char*)d_ws + WS_CTL, 0, CTL_ZERO_BYTES, stream) != hipSuccess) return;
    Args a{};
    for (int i = 0; i < 30; ++i) a.in[i] = (const float*)d_in[i];
    a.out = (float*)d_out; a.ws = (unsigned char*)d_ws;
    hipLaunchKernelGGL(mega_fwd, dim3(grid), dim3(NTHR), LDS_BYTES, stream, a);
}
```

```cpp
#define DIAG_FROM 2
#include <hip/hip_runtime.h>
#include <cstdio>
#include <cstdint>

#define LAS __attribute__((address_space(3)))
#define GAS __attribute__((address_space(1)))
typedef unsigned short bf16_t;
typedef short bf16x8 __attribute__((ext_vector_type(8)));
typedef short s16x4 __attribute__((ext_vector_type(4)));
typedef float f32x2 __attribute__((ext_vector_type(2)));
typedef float f32x4 __attribute__((ext_vector_type(4)));
typedef float f32x16 __attribute__((ext_vector_type(16)));
typedef unsigned u32x2 __attribute__((ext_vector_type(2)));
typedef unsigned u32x4 __attribute__((ext_vector_type(4)));

constexpr int MTOK = 65536, DM = 1024, SEQ = 8192, NBATCH = 8, DEPTH = 4;
constexpr int DFF = 2816, DFFE = 3584, NEXP = 8, LRUW = 1280;
constexpr float EPS = 1e-6f;
constexpr int FP8_DENSE_FROM = 2;
constexpr float MOE_WSCALE = 64.0f, MOE_HSCALE = 4.0f;
constexpr float LOG2E = 1.4426950408889634f;

constexpr size_t MiB = 1u << 20;
constexpr size_t WS_CTL = 0, CTL_ZERO_BYTES = 1 * MiB;
constexpr size_t WS_TAB = 1 * MiB;
constexpr size_t TB_MODS = WS_TAB;
constexpr size_t TB_COS = WS_TAB + 1 * MiB;
constexpr size_t TB_SIN = WS_TAB + 2 * MiB;
constexpr size_t TB_SCAL = WS_TAB + 3 * MiB;
constexpr size_t TB_LB = TB_SCAL + 4096;
constexpr size_t TB_SP = TB_SCAL + 16384;
constexpr size_t TB_EID = WS_TAB + 4 * MiB;
constexpr size_t TB_GATE = WS_TAB + 5 * MiB;
constexpr size_t TB_SLOT = WS_TAB + 6 * MiB;
constexpr size_t TB_BCNT = WS_TAB + 7 * MiB;
constexpr size_t TB_TILES = TB_BCNT + 16384;
constexpr size_t TB_LSUM = WS_TAB + 8 * MiB;
constexpr size_t TB_LCIN = WS_TAB + 16 * MiB;
constexpr size_t WS_W = 32 * MiB;
constexpr size_t W_QKV = WS_W;
constexpr size_t W_AO = W_QKV + 2 * (size_t)3072 * 1024 * 2;
constexpr size_t W_HGI = W_AO + 2 * (size_t)1024 * 1024 * 2;
constexpr size_t W_HGO = W_HGI + (size_t)5120 * 1024 * 2;
constexpr size_t W_LRI = W_HGO + (size_t)1024 * 1024 * 2;
constexpr size_t W_LRG = W_LRI + (size_t)2560 * 1024 * 2;
constexpr size_t W_LRO = W_LRG + (size_t)10 * 2 * 256 * 128 * 2;
constexpr size_t W_FGU = W_LRO + (size_t)1024 * 1280 * 2;
constexpr size_t W_FDN = W_FGU + 2 * (size_t)5632 * 1024 * 2;
constexpr size_t W_MGU = W_FDN + 2 * (size_t)1024 * 2816 * 2;
constexpr size_t W_MDN = W_MGU + 16 * (size_t)7168 * 1024 * 2;
constexpr size_t W_END = W_MDN + 16 * (size_t)1024 * 3584 * 2;
constexpr size_t WS_HM = 440 * MiB;
constexpr size_t WS_ACT = 568 * MiB;
static_assert(W_END <= WS_HM, "weights overflow");
constexpr size_t SZ_TOK = (size_t)MTOK * 1024 * 2;
constexpr size_t A_Q = WS_ACT, A_K = A_Q + SZ_TOK, A_V = A_K + SZ_TOK, A_VT = A_V + SZ_TOK;
constexpr size_t F_HID = WS_ACT;
constexpr size_t H_Q = WS_ACT, H_LFF = H_Q + SZ_TOK, H_LFB = H_LFF + SZ_TOK, H_V = H_LFB + SZ_TOK, H_G = H_V + SZ_TOK, H_OF = H_G + SZ_TOK, H_OB = H_OF + SZ_TOK;
constexpr size_t SZ_LRU = (size_t)MTOK * 1280 * 2;
constexpr size_t L_YB = WS_ACT, L_XB = L_YB + SZ_LRU, L_HF = L_XB + SZ_LRU, L_HY = L_HF + SZ_LRU, L_U = L_HY + SZ_LRU;
constexpr int MOE_ROWS = 2 * MTOK + NEXP * 256;
constexpr size_t E_XS = WS_ACT, E_HID = E_XS + (size_t)MOE_ROWS * 1024 * 2, E_END = E_HID + (size_t)MOE_ROWS * DFFE;
constexpr size_t WS_XB = 1536 * MiB;
static_assert(E_END <= WS_XB && H_OB + SZ_TOK <= WS_XB && L_U + 2 * SZ_LRU <= WS_XB && A_VT + SZ_TOK <= WS_XB, "activation regions below the residual stream");
constexpr size_t WS_NEED = WS_XB + SZ_TOK;
static_assert(WS_NEED <= (size_t)1792 * MiB, "workspace");

constexpr int CW_BAR = 4096;

constexpr int RING_BYTES = 135168;
constexpr int MISC_OFF = RING_BYTES;
constexpr int LDS_BYTES = 147456;
constexpr int NWAVES = 8, NTHR = 512;

typedef __bf16 bf16x2v __attribute__((ext_vector_type(2)));
__device__ __forceinline__ unsigned cvt_pk_bf16(float lo, float hi) { const f32x2 v = {lo, hi}; const bf16x2v b = __builtin_convertvector(v, bf16x2v); return __builtin_bit_cast(unsigned, b); }
__device__ __forceinline__ unsigned pk_fp8x4(float a, float b, float c, float d) { unsigned w = 0; w = __builtin_amdgcn_cvt_pk_fp8_f32(a, b, w, false); w = __builtin_amdgcn_cvt_pk_fp8_f32(c, d, w, true); return w; }
__device__ __forceinline__ unsigned f2bf(float f) { unsigned u = __builtin_bit_cast(unsigned, f); return (u + 0x7fffu + ((u >> 16) & 1u)) >> 16; }
__device__ __forceinline__ float bf2f(unsigned short b) { return __builtin_bit_cast(float, ((unsigned)b) << 16); }
__device__ __forceinline__ float bflo(unsigned w) { return __builtin_bit_cast(float, w << 16); }
__device__ __forceinline__ float bfhi(unsigned w) { return __builtin_bit_cast(float, w & 0xffff0000u); }
__device__ __forceinline__ float fexp2(float x) { return __builtin_amdgcn_exp2f(x); }
__device__ __forceinline__ float fexp(float x) { return __builtin_amdgcn_exp2f(x * LOG2E); }
__device__ __forceinline__ float frcp(float x) { return __builtin_amdgcn_rcpf(x); }
__device__ __forceinline__ float fsigmoid(float x) { return frcp(1.0f + fexp(-x)); }
__device__ __forceinline__ float fsilu(float x) { return x * fsigmoid(x); }
__device__ __forceinline__ float wave_sum(float v) {
#pragma unroll
    for (int o = 1; o < 64; o <<= 1) v += __shfl_xor(v, o);
    return v;
}
#define LDS_WAIT() asm volatile("s_waitcnt lgkmcnt(0)" ::: "memory")
#define VM_WAIT() asm volatile("s_waitcnt vmcnt(0)" ::: "memory")

#define XB_TMO      128
#define XB_XCNT(j)  (256  + 64 * (j))
#define XB_XSUB(j)  (1280 + 64 * (j))
#define XB_XGEN(j)  (2304 + 64 * (j))
#define XB_TOP      3328
#define XB_TOPGEN   3392
#define XCD_BAR_WORDS 3456
#define XB_SPIN_CAP (1u << 22)
__device__ __forceinline__ unsigned xb_ld(unsigned* p)              { return __hip_atomic_load(p, __ATOMIC_RELAXED, __HIP_MEMORY_SCOPE_AGENT); }
__device__ __forceinline__ unsigned xb_add(unsigned* p, unsigned v) { return __hip_atomic_fetch_add(p, v, __ATOMIC_RELAXED, __HIP_MEMORY_SCOPE_AGENT); }
__device__ __forceinline__ unsigned xb_xcc_id() { return (unsigned)__builtin_amdgcn_s_getreg((3 << 11) | 20) & 0xFu; }
#define XB_SPIN(cond, bar) do { unsigned _sp = 0; while (cond) { __builtin_amdgcn_s_sleep(1); \
    if ((++_sp & 255u) == 0u) { if (xb_ld(&(bar)[XB_TMO])) break; if (_sp > XB_SPIN_CAP) { atomicAdd(&(bar)[XB_TMO], 1u); break; } } } } while (0)
struct XcdBarrier { unsigned* bar; unsigned x; volatile LAS unsigned* st; };
__device__ __forceinline__ XcdBarrier xcd_barrier_post(unsigned* bar, volatile LAS unsigned* st) {
    XcdBarrier b; b.bar = bar; b.x = xb_xcc_id(); b.st = st;
    if (threadIdx.x == 0) (void)xb_add(&bar[XB_XCNT(b.x)], 1u);
    return b;
}
__device__ __forceinline__ void xcd_barrier_complete(unsigned* bar, unsigned x, unsigned& nloc, unsigned& nx) {
    const unsigned G = gridDim.x * gridDim.y * gridDim.z;
    unsigned sum, cnt, mine, sp = 0u;
    for (;;) {
        sum = 0u; cnt = 0u; mine = 0u;
#pragma unroll
        for (unsigned j = 0; j < 16; ++j) { const unsigned c = xb_ld(&bar[XB_XCNT(j)]); sum += c; cnt += (c > 0u) ? 1u : 0u; mine = (j == x) ? c : mine; }
        if (sum == G) break;
        __builtin_amdgcn_s_sleep(1);
        if ((++sp & 255u) == 0u) { if (xb_ld(&bar[XB_TMO])) break; if (sp > XB_SPIN_CAP) { atomicAdd(&bar[XB_TMO], 1u); break; } }
    }
    nloc = mine > 0u ? mine : 1u; nx = cnt > 0u ? cnt : 1u;
}
__device__ __forceinline__ void xcd_barrier(const XcdBarrier& b) {
    asm volatile("s_waitcnt vmcnt(0)" ::: "memory");
    __syncthreads();
    if (threadIdx.x == 0) {
        unsigned* bar = b.bar;
        __builtin_amdgcn_s_waitcnt(0);
        unsigned nloc = b.st[0], nx = b.st[1];
        if (nloc == 0u) { xcd_barrier_complete(bar, b.x, nloc, nx); b.st[0] = nloc; b.st[1] = nx; }
        const unsigned old = xb_add(&bar[XB_XSUB(b.x)], 1u);
        const unsigned gen = old / nloc;
        if (old + 1u == (gen + 1u) * nloc) {
            __builtin_amdgcn_fence(__ATOMIC_RELEASE, "agent");
            asm volatile("s_waitcnt vmcnt(0)" ::: "memory");
            const unsigned og = xb_add(&bar[XB_TOP], 1u);
            const unsigned tg = og / nx;
            if (og + 1u == (tg + 1u) * nx) xb_add(&bar[XB_TOPGEN], 1u);
            else XB_SPIN(xb_ld(&bar[XB_TOPGEN]) == tg, bar);
            __builtin_amdgcn_fence(__ATOMIC_ACQUIRE, "agent");
            xb_add(&bar[XB_XGEN(b.x)], 1u);
            asm volatile("s_waitcnt vmcnt(0)" ::: "memory");
        } else {
            XB_SPIN(xb_ld(&bar[XB_XGEN(b.x)]) == gen, bar);
            __builtin_amdgcn_fence(__ATOMIC_ACQUIRE, "agent");
            asm volatile("s_waitcnt vmcnt(0)" ::: "memory");
        }
    }
    __syncthreads();
}

namespace pg8 {
constexpr int BM = 256, BK = 64, HALF = 128, HTB = HALF * BK * 2, STAGE_BYTES = 8 * HTB, NXCD = 8, WGM = 8;
__host__ __device__ __forceinline__ int lds_byte(int r, int c) { const int st = (r >> 4) * 2 + (c >> 5), rr = r & 15, cc = c & 31, ob = rr * 64 + cc * 2; return st * 1024 + (ob ^ (((ob >> 9) & 1) << 5)); }
__host__ __device__ __forceinline__ void stage_rc(int b, int& R, int& C) { const int st = b / 1024, sb = b % 1024, swz = sb ^ (((sb >> 9) & 1) << 5); R = (st >> 1) * 16 + swz / 64; C = (st & 1) * 32 + (swz % 64) / 2; }
__host__ __device__ __forceinline__ int perm32(int rho) { const int n = rho >> 4, i = rho & 15; return 8 * (i >> 2) + 4 * n + (i & 3); }

struct Unit { int pm, pn, pb; };
struct Gemm { const bf16_t* A; const bf16_t* Bt; int K; };

struct TileOrder {
    int nM, nN, nwg, G, c; int ts[NEXP];
    __device__ __forceinline__ void init(int nM_, int nN_, int G_, int c_) { nM = nM_; nN = nN_; nwg = nM * nN; G = G_; c = c_;
#pragma unroll
        for (int e = 0; e < NEXP; ++e) ts[e] = (e == 0) ? 0 : 0x7fffffff; }
    __device__ __forceinline__ bool next(int i, Unit& u) const {
        const long L = (long)i * G + c; if (L >= nwg) return false;
        int wgid = (int)L; { const int q = nwg / NXCD, r = nwg % NXCD, xcd = wgid % NXCD, off = wgid / NXCD; wgid = (xcd < r ? xcd * (q + 1) : r * (q + 1) + (xcd - r) * q) + off; }
        const int nig = WGM * nN, gid = wgid / nig, fm = gid * WGM, gsz = (nM - fm) < WGM ? (nM - fm) : WGM;
        u.pm = fm + ((wgid % nig) % gsz); u.pn = (wgid % nig) / gsz;
        int e = 0;
#pragma unroll
        for (int k = 1; k < NEXP; ++k) e += (u.pm >= ts[k]) ? 1 : 0;
        u.pb = e * nN + u.pn; return true;
    }
};

typedef int v8i32 __attribute__((ext_vector_type(8)));
template <class Epi, bool FP8 = false>
__device__ __forceinline__ void gemm_phase(LAS unsigned char* lds, const Gemm g, const TileOrder& S, const Epi& E) {
    int tid_ = threadIdx.x; asm volatile("" : "+v"(tid_));
    const int tid = tid_, wid = __builtin_amdgcn_readfirstlane(tid >> 6), lane = tid & 63, wr = wid >> 2, wc = wid & 3, fr = lane & 15, fq = lane >> 4;
    const int K = g.K, nt = K / BK;
    unsigned voffA[2], voffB[2];
#pragma unroll
    for (int i = 0; i < 2; ++i) { int R, C; stage_rc(tid * 16 + i * 8192, R, C); const int Rb = Epi::PERM ? ((R & ~31) + perm32(R & 31)) : R;
        voffA[i] = (unsigned)(R * K + C) * 2u; voffB[i] = (unsigned)(Rb * K + C) * 2u; }
    const size_t kstep = (size_t)(BK * 2);
    const size_t hstep = (size_t)HALF * K * 2;
    const size_t tstep = 2 * hstep;
    const unsigned ldsw = (unsigned)wid * 1024u;
    const int aoff = lds_byte(wr * 64 + fr, fq * 8), boff = lds_byte(wc * 32 + fr, fq * 8);
#define PG8_SA(b, h) (((b) * 2 + (h)) * HTB)
#define PG8_SB(b, h) ((4 + (b) * 2 + (h)) * HTB)
#define PG8_STAGE(bufoff, gbase, voff) do { _Pragma("unroll") for (int _i = 0; _i < 2; ++_i) \
        __builtin_amdgcn_global_load_lds((const unsigned*)((const char*)(gbase) + (voff)[_i]), (LAS unsigned*)(lds + (bufoff) + ldsw + _i * 8192), 16, 0, 0); } while (0)
#define PG8_LD8(p) __builtin_bit_cast(v8i32, __builtin_shufflevector(*(const LAS u32x4*)(p), *(const LAS u32x4*)((p) + 1024), 0, 1, 2, 3, 4, 5, 6, 7))
#define PG8_LDA(dst, b, h) do { if constexpr (FP8) { _Pragma("unroll") for (int m = 0; m < 4; ++m) dst##8[m] = PG8_LD8(lds + PG8_SA(b, h) + aoff + m * 2048); } \
        else { _Pragma("unroll") for (int m = 0; m < 4; ++m) _Pragma("unroll") for (int k = 0; k < 2; ++k) dst[m][k] = *(const LAS bf16x8*)(lds + PG8_SA(b, h) + aoff + m * 2048 + k * 1024); } } while (0)
#define PG8_LDB(dst, b, h) do { if constexpr (FP8) { _Pragma("unroll") for (int n = 0; n < 2; ++n) dst##8[n] = PG8_LD8(lds + PG8_SB(b, h) + boff + n * 2048); } \
        else { _Pragma("unroll") for (int n = 0; n < 2; ++n) _Pragma("unroll") for (int k = 0; k < 2; ++k) dst[n][k] = *(const LAS bf16x8*)(lds + PG8_SB(b, h) + boff + n * 2048 + k * 1024); } } while (0)
#define PG8_MMA(ai, bj, At, Bt) do { __builtin_amdgcn_s_setprio(1); \
        if constexpr (FP8) { _Pragma("unroll") for (int m = 0; m < 4; ++m) _Pragma("unroll") for (int n = 0; n < 2; ++n) \
            asm volatile("v_mfma_scale_f32_16x16x128_f8f6f4 %0, %1, %2, %0, %3, %3 op_sel_hi:[0,0,0]" : "+v"(acc[ai][bj][m][n]) : "v"(Bt##8[n]), "v"(At##8[m]), "v"(one_scale)); } \
        else { _Pragma("unroll") for (int m = 0; m < 4; ++m) _Pragma("unroll") for (int n = 0; n < 2; ++n) _Pragma("unroll") for (int k = 0; k < 2; ++k) \
            acc[ai][bj][m][n] = __builtin_amdgcn_mfma_f32_16x16x32_bf16(Bt[n][k], At[m][k], acc[ai][bj][m][n], 0, 0, 0); } \
        __builtin_amdgcn_s_setprio(0); } while (0)
#define PG8_WAIT_V(n) asm volatile("s_waitcnt vmcnt(" #n ")" ::: "memory")
#define PG8_WAIT_L(n) asm volatile("s_waitcnt lgkmcnt(" #n ")" ::: "memory")
#define PG8_BAR __builtin_amdgcn_s_barrier()
#define PG8_SCHED __builtin_amdgcn_sched_barrier(0)
    Unit cur, nxt; int ui = 0;
    if (!S.next(0, cur)) return;
    f32x4 acc[2][2][4][2];
#pragma unroll
    for (int a = 0; a < 2; ++a)
#pragma unroll
        for (int b = 0; b < 2; ++b)
#pragma unroll
            for (int m = 0; m < 4; ++m)
#pragma unroll
                for (int n = 0; n < 2; ++n) acc[a][b][m][n] = (f32x4){0.f, 0.f, 0.f, 0.f};
    bf16x8 At[4][2], B0[2][2], B1[2][2]; v8i32 At8[4], B08[2], B18[2];
    int one_scale = 0x7f7f7f7f; asm volatile("" : "+v"(one_scale));
    const char* cA = (const char*)g.A + (size_t)cur.pm * tstep; const char* cB = (const char*)g.Bt + (size_t)cur.pb * tstep;
    PG8_STAGE(PG8_SB(0, 0), cB, voffB); PG8_STAGE(PG8_SA(0, 0), cA, voffA); PG8_STAGE(PG8_SB(0, 1), cB + hstep, voffB); PG8_STAGE(PG8_SA(0, 1), cA + hstep, voffA);
    if (wr == 1) PG8_BAR;
    PG8_WAIT_V(4); PG8_BAR;
    PG8_STAGE(PG8_SB(1, 0), cB + kstep, voffB); PG8_STAGE(PG8_SA(1, 0), cA + kstep, voffA); PG8_STAGE(PG8_SB(1, 1), cB + hstep + kstep, voffB);
    PG8_WAIT_V(6); PG8_BAR;
    for (;;) {
        const bool has_next = S.next(ui + 1, nxt);
        const char* nA = has_next ? (const char*)g.A + (size_t)nxt.pm * tstep : cA; const char* nB = has_next ? (const char*)g.Bt + (size_t)nxt.pb * tstep : cB;
        for (int t = 0; t < nt; t += 2) {
            const bool last = (t == nt - 2);
            const char* a1 = cA + (size_t)(t + 1) * kstep;
            const char* a2 = last ? nA : cA + (size_t)(t + 2) * kstep; const char* b2 = last ? nB : cB + (size_t)(t + 2) * kstep;
            const char* a3 = a2 + kstep; const char* b3 = b2 + kstep;
            PG8_LDB(B0, 0, 0); PG8_SCHED; PG8_LDA(At, 0, 0); PG8_STAGE(PG8_SA(1, 1), a1 + hstep, voffA);
            PG8_WAIT_L(8); PG8_BAR; PG8_WAIT_L(0); PG8_MMA(0, 0, At, B0); PG8_BAR; PG8_SCHED;
            PG8_LDB(B1, 0, 1); PG8_STAGE(PG8_SB(0, 0), b2, voffB);
            PG8_BAR; PG8_WAIT_L(0); PG8_MMA(0, 1, At, B1); PG8_BAR;
            PG8_LDA(At, 0, 1); PG8_STAGE(PG8_SA(0, 0), a2, voffA);
            PG8_BAR; PG8_WAIT_L(0); PG8_MMA(1, 0, At, B0); PG8_BAR; PG8_SCHED;
            PG8_STAGE(PG8_SB(0, 1), b2 + hstep, voffB);
            PG8_WAIT_V(6); PG8_BAR; PG8_MMA(1, 1, At, B1); PG8_BAR;
            PG8_LDB(B0, 1, 0); PG8_SCHED; PG8_LDA(At, 1, 0); PG8_STAGE(PG8_SA(0, 1), a2 + hstep, voffA);
            PG8_WAIT_L(8); PG8_BAR; PG8_WAIT_L(0); PG8_MMA(0, 0, At, B0); PG8_BAR; PG8_SCHED;
            PG8_LDB(B1, 1, 1); PG8_STAGE(PG8_SB(1, 0), b3, voffB);
            PG8_BAR; PG8_WAIT_L(0); PG8_MMA(0, 1, At, B1); PG8_BAR;
            PG8_LDA(At, 1, 1); PG8_STAGE(PG8_SA(1, 0), a3, voffA);
            PG8_BAR; PG8_WAIT_L(0); PG8_MMA(1, 0, At, B0); PG8_BAR; PG8_SCHED;
            PG8_STAGE(PG8_SB(1, 1), b3 + hstep, voffB);
            PG8_WAIT_V(6); PG8_BAR; PG8_MMA(1, 1, At, B1); PG8_BAR;
        }
        if constexpr (FP8) asm volatile("s_nop 15\n\ts_nop 15" ::: "memory");
        E(acc, cur, wr, wc, fr, fq);
        if (!has_next) break;
#pragma unroll
        for (int a = 0; a < 2; ++a)
#pragma unroll
            for (int b = 0; b < 2; ++b)
#pragma unroll
                for (int m = 0; m < 4; ++m)
#pragma unroll
                    for (int n = 0; n < 2; ++n) acc[a][b][m][n] = (f32x4){0.f, 0.f, 0.f, 0.f};
        cur = nxt; cA = nA; cB = nB; ++ui;
    }
    PG8_WAIT_V(0);
    if (wr == 0) PG8_BAR;
    PG8_BAR;
#undef PG8_SA
#undef PG8_SB
#undef PG8_STAGE
#undef PG8_LDA
#undef PG8_LDB
#undef PG8_MMA
#undef PG8_LD8
#undef PG8_WAIT_V
#undef PG8_WAIT_L
#undef PG8_BAR
#undef PG8_SCHED
}

struct EpiQKV {
    static constexpr bool PERM = true;
    bf16_t *Q, *Kk, *V; const float *gq, *gk, *cosT, *sinT; float qscale;
    __device__ __forceinline__ void operator()(const f32x4 (&acc)[2][2][4][2], const Unit& u, int wr, int wc, int fr, int fq) const {
        const int row0 = u.pm * BM + wr * 64 + fr;
        if (u.pn >= 8) {
            const int col0 = (u.pn - 8) * BM + wc * 32 + 8 * fq;
#pragma unroll
            for (int ai = 0; ai < 2; ++ai)
#pragma unroll
                for (int m = 0; m < 4; ++m) { bf16_t* rowp = V + (size_t)(row0 + ai * HALF + m * 16) * DM + col0;
#pragma unroll
                    for (int bj = 0; bj < 2; ++bj) { const f32x4 v0 = acc[ai][bj][m][0], v1 = acc[ai][bj][m][1];
                        u32x4 w; w.x = cvt_pk_bf16(v0[0], v0[1]); w.y = cvt_pk_bf16(v0[2], v0[3]); w.z = cvt_pk_bf16(v1[0], v1[1]); w.w = cvt_pk_bf16(v1[2], v1[3]);
                        *(u32x4*)(rowp + bj * HALF) = w; } }
        } else {
            const int part = u.pn >> 2, sh = 4 * (u.pn & 3) + wc;
            bf16_t* dst = part ? Kk : Q; const float* g = part ? gk : gq; const float sc = part ? 1.0f : qscale;
            f32x4 g0[2], g1[2];
#pragma unroll
            for (int n = 0; n < 2; ++n) { g0[n] = *(const f32x4*)(g + 8 * fq + 4 * n); g1[n] = *(const f32x4*)(g + 32 + 8 * fq + 4 * n); }
#pragma unroll
            for (int ai = 0; ai < 2; ++ai)
#pragma unroll
                for (int m = 0; m < 4; ++m) {
                    const int r = row0 + ai * HALF + m * 16; const int pos = r & (SEQ - 1);
                    f32x4 x1[2], x2[2]; float ss = 0.f;
#pragma unroll
                    for (int n = 0; n < 2; ++n) { x1[n] = acc[ai][0][m][n]; x2[n] = acc[ai][1][m][n];
                        ss += (x1[n][0] * x1[n][0] + x1[n][1] * x1[n][1]) + (x1[n][2] * x1[n][2] + x1[n][3] * x1[n][3]);
                        ss += (x2[n][0] * x2[n][0] + x2[n][1] * x2[n][1]) + (x2[n][2] * x2[n][2] + x2[n][3] * x2[n][3]); }
                    ss += __shfl_xor(ss, 16); ss += __shfl_xor(ss, 32);
                    const float rstd = __builtin_amdgcn_rsqf(ss * (1.0f / 64.0f) + EPS) ;
                    unsigned char* op = (unsigned char*)dst + (size_t)r * DM + sh * 64 + 8 * fq;
                    u32x2 w1, w2;
#pragma unroll
                    for (int n = 0; n < 2; ++n) {
                        const f32x4 cs = *(const f32x4*)(cosT + pos * 32 + 8 * fq + 4 * n), sn = *(const f32x4*)(sinT + pos * 32 + 8 * fq + 4 * n);
                        const f32x4 y1 = x1[n] * rstd * g0[n], y2 = x2[n] * rstd * g1[n];
                        const f32x4 o1 = (y1 * cs - y2 * sn) * sc, o2 = (y2 * cs + y1 * sn) * sc;
                        if (n == 0) { w1.x = pk_fp8x4(o1[0], o1[1], o1[2], o1[3]); w2.x = pk_fp8x4(o2[0], o2[1], o2[2], o2[3]); }
                        else { w1.y = pk_fp8x4(o1[0], o1[1], o1[2], o1[3]); w2.y = pk_fp8x4(o2[0], o2[1], o2[2], o2[3]); }
                    }
                    *(u32x2*)(op) = w1; *(u32x2*)(op + 32) = w2;
                }
        }
    }
};
__device__ __forceinline__ f32x4 ld_x4(const void* p, size_t i, bool is16) {
    if (is16) { const u32x2 w = *(const u32x2*)((const bf16_t*)p + i); return (f32x4){bflo(w.x), bfhi(w.x), bflo(w.y), bfhi(w.y)}; }
    return *(const f32x4*)((const float*)p + i);
}
template <bool IN16>
struct EpiRes {
    static constexpr bool PERM = false;
    const void* xin; bf16_t* xout; const float* gate; float sc;
    __device__ __forceinline__ void operator()(const f32x4 (&acc)[2][2][4][2], const Unit& u, int wr, int wc, int fr, int fq) const {
        const int row0 = u.pm * BM + wr * 64 + fr, col0 = u.pn * BM + wc * 32 + 4 * fq;
        const float* gp = gate + (size_t)(u.pm >> 5) * 6144 + col0;
        f32x4 gv[2][2];
#pragma unroll
        for (int bj = 0; bj < 2; ++bj)
#pragma unroll
            for (int n = 0; n < 2; ++n) gv[bj][n] = *(const f32x4*)(gp + bj * HALF + n * 16) * sc;
#pragma unroll
        for (int ai = 0; ai < 2; ++ai)
#pragma unroll
            for (int m = 0; m < 4; ++m) { const size_t off = (size_t)(row0 + ai * HALF + m * 16) * DM + col0;
                f32x4 xv[2][2];
#pragma unroll
                for (int bj = 0; bj < 2; ++bj)
#pragma unroll
                    for (int n = 0; n < 2; ++n) xv[bj][n] = ld_x4(xin, off + bj * HALF + n * 16, IN16);
#pragma unroll
                for (int bj = 0; bj < 2; ++bj)
#pragma unroll
                    for (int n = 0; n < 2; ++n) { const f32x4 o = xv[bj][n] + gv[bj][n] * acc[ai][bj][m][n];
                        *(u32x2*)(xout + off + bj * HALF + n * 16) = (u32x2){cvt_pk_bf16(o[0], o[1]), cvt_pk_bf16(o[2], o[3])}; }
                if (m == 3) asm volatile("" ::: "memory"); }
    }
};
struct EpiSwiGLU {
    static constexpr bool PERM = true;
    bf16_t* H; int ldh;
    __device__ __forceinline__ void operator()(const f32x4 (&acc)[2][2][4][2], const Unit& u, int wr, int wc, int fr, int fq) const {
        const int row0 = u.pm * BM + wr * 64 + fr, col0 = u.pn * HALF + wc * 32 + 8 * fq;
#pragma unroll
        for (int ai = 0; ai < 2; ++ai)
#pragma unroll
            for (int m = 0; m < 4; ++m) { bf16_t* rowp = H + (size_t)(row0 + ai * HALF + m * 16) * ldh + col0;
                f32x4 v[2];
#pragma unroll
                for (int n = 0; n < 2; ++n) { const f32x4 gt = acc[ai][0][m][n], up = acc[ai][1][m][n];
#pragma unroll
                    for (int j = 0; j < 4; ++j) v[n][j] = fsilu(gt[j]) * up[j]; }
                u32x4 w; w.x = cvt_pk_bf16(v[0][0], v[0][1]); w.y = cvt_pk_bf16(v[0][2], v[0][3]); w.z = cvt_pk_bf16(v[1][0], v[1][1]); w.w = cvt_pk_bf16(v[1][2], v[1][3]);
                *(u32x4*)rowp = w; }
    }
};
struct EpiSwiGLU8 {
    static constexpr bool PERM = true;
    unsigned char* H; int ldh; float ws, hs;
    __device__ __forceinline__ void operator()(const f32x4 (&acc)[2][2][4][2], const Unit& u, int wr, int wc, int fr, int fq) const {
        const int row0 = u.pm * BM + wr * 64 + fr, col0 = u.pn * HALF + wc * 32 + 8 * fq;
#pragma unroll
        for (int ai = 0; ai < 2; ++ai)
#pragma unroll
            for (int m = 0; m < 4; ++m) { unsigned char* rowp = H + (size_t)(row0 + ai * HALF + m * 16) * ldh + col0;
                f32x4 v[2];
#pragma unroll
                for (int n = 0; n < 2; ++n) { const f32x4 gt = acc[ai][0][m][n] * ws, up = acc[ai][1][m][n] * (ws * hs);
#pragma unroll
                    for (int j = 0; j < 4; ++j) v[n][j] = fsilu(gt[j]) * up[j]; }
                *(u32x2*)rowp = (u32x2){pk_fp8x4(v[0][0], v[0][1], v[0][2], v[0][3]), pk_fp8x4(v[1][0], v[1][1], v[1][2], v[1][3])}; }
    }
};
struct EpiPlain {
    static constexpr bool PERM = true;
    bf16_t* O; int ldc; float sc;
    __device__ __forceinline__ void operator()(const f32x4 (&acc)[2][2][4][2], const Unit& u, int wr, int wc, int fr, int fq) const {
        const int row0 = u.pm * BM + wr * 64 + fr, col0 = u.pn * BM + wc * 32 + 8 * fq;
#pragma unroll
        for (int ai = 0; ai < 2; ++ai)
#pragma unroll
            for (int m = 0; m < 4; ++m) { bf16_t* rowp = O + (size_t)(row0 + ai * HALF + m * 16) * ldc + col0;
#pragma unroll
                for (int bj = 0; bj < 2; ++bj) { const f32x4 v0 = acc[ai][bj][m][0] * sc, v1 = acc[ai][bj][m][1] * sc;
                    u32x4 w; w.x = cvt_pk_bf16(v0[0], v0[1]); w.y = cvt_pk_bf16(v0[2], v0[3]); w.z = cvt_pk_bf16(v1[0], v1[1]); w.w = cvt_pk_bf16(v1[2], v1[3]);
                    *(u32x4*)(rowp + bj * HALF) = w; } }
    }
};
struct EpiAct {
    static constexpr bool PERM = true;
    int kind; unsigned char* ws; const float* lb;
    __device__ __forceinline__ void operator()(const f32x4 (&acc)[2][2][4][2], const Unit& u, int wr, int wc, int fr, int fq) const {
        const int row0 = u.pm * BM + wr * 64 + fr;
        int mode, ldc, colt; size_t boff;
        if (kind == 0) { const int grp = u.pn >> 2; colt = (u.pn & 3) * 256; ldc = 1024;
            boff = grp == 0 ? H_Q : grp == 1 ? H_LFF : grp == 2 ? H_LFB : grp == 3 ? H_V : H_G; mode = (grp == 0 || grp == 4) ? 1 : (grp == 3 ? 0 : 3); }
        else { ldc = LRUW; if (u.pn < 5) { boff = L_YB; colt = u.pn * 256; mode = 2; } else { boff = L_XB; colt = (u.pn - 5) * 256; mode = 0; } }
        bf16_t* base = (bf16_t*)(ws + boff);
        const int col0 = colt + wc * 32 + 8 * fq;
        f32x4 lbv[2][2];
        if (mode == 3) { const float* lp = lb + ((u.pn >> 2) - 1) * 1024 + col0;
#pragma unroll
            for (int bj = 0; bj < 2; ++bj)
#pragma unroll
                for (int n = 0; n < 2; ++n) lbv[bj][n] = *(const f32x4*)(lp + bj * HALF + 4 * n); }
#pragma unroll
        for (int ai = 0; ai < 2; ++ai)
#pragma unroll
            for (int m = 0; m < 4; ++m) { bf16_t* rowp = base + (size_t)(row0 + ai * HALF + m * 16) * ldc + col0;
#pragma unroll
                for (int bj = 0; bj < 2; ++bj) { f32x4 v[2]; u32x4 w;
#pragma unroll
                    for (int n = 0; n < 2; ++n) { v[n] = acc[ai][bj][m][n];
                        if (mode == 1) {
#pragma unroll
                            for (int j = 0; j < 4; ++j) v[n][j] = fsilu(v[n][j]); }
                        else if (mode == 2) {
#pragma unroll
                            for (int j = 0; j < 4; ++j) { const float x = v[n][j]; v[n][j] = x * fsigmoid(1.5957691216057308f * (x + 0.044715f * x * x * x)); } }
                        else if (mode == 3) {
#pragma unroll
                            for (int j = 0; j < 4; ++j) { const float l = lbv[bj][n][j]; const float fg = l + (1.0f - l) * fsigmoid(v[n][j]); v[n][j] = __builtin_amdgcn_logf(fg) * 0.6931471805599453f; } }
                    }
                    if (mode == 3) {
#pragma unroll
                        for (int n = 0; n < 2; ++n) { const _Float16 h0 = (_Float16)v[n][0], h1 = (_Float16)v[n][1], h2 = (_Float16)v[n][2], h3 = (_Float16)v[n][3];
                            const unsigned a = (unsigned)__builtin_bit_cast(unsigned short, h0) | ((unsigned)__builtin_bit_cast(unsigned short, h1) << 16);
                            const unsigned b = (unsigned)__builtin_bit_cast(unsigned short, h2) | ((unsigned)__builtin_bit_cast(unsigned short, h3) << 16);
                            if (n == 0) { w.x = a; w.y = b; } else { w.z = a; w.w = b; } }
                    } else { w.x = cvt_pk_bf16(v[0][0], v[0][1]); w.y = cvt_pk_bf16(v[0][2], v[0][3]); w.z = cvt_pk_bf16(v[1][0], v[1][1]); w.w = cvt_pk_bf16(v[1][2], v[1][3]); }
                    *(u32x4*)(rowp + bj * HALF) = w; } }
    }
};
}

struct Args { const float* in[30]; float* out; unsigned char* ws; };
enum { I_X = 0, I_C, I_ADAW, I_ADAB, I_N1G, I_N2G, I_ATWIN, I_ATQN, I_ATKN, I_ATLAM, I_ATSUB, I_ATWOUT, I_HGWIN, I_HGLB, I_HGNG, I_HGWOUT,
       I_LRWIN, I_LRCW, I_LRCB, I_LRWA, I_LRBA, I_LRWX, I_LRBX, I_LRLAM, I_LRWOUT, I_FFGU, I_FFDN, I_MOER, I_MOEGU, I_MOEDN };
enum { SC_LAM0 = 0, SC_LAM1, SC_OML0, SC_OML1, SC_MC0, SC_MC1 };

__device__ __forceinline__ void cvt_item(const float* W, int ldw, int src_col0, bf16_t* WT, int ldt, int dst_row0, int k0, LAS float* scr, int lane) {
#pragma unroll 8
    for (int i = 0; i < 32; ++i) { const int kk = 2 * i + (lane >> 5); scr[kk * 33 + (lane & 31)] = W[(size_t)(k0 + kk) * ldw + src_col0 + (lane & 31)]; }
    LDS_WAIT(); asm volatile("" ::: "memory");
    const int c = lane & 7;
#pragma unroll
    for (int j = 0; j < 4; ++j) { const int n = (lane >> 3) + 8 * j; const LAS float* s = scr + (8 * c) * 33 + n;
        u32x4 o; o.x = cvt_pk_bf16(s[0 * 33], s[1 * 33]); o.y = cvt_pk_bf16(s[2 * 33], s[3 * 33]); o.z = cvt_pk_bf16(s[4 * 33], s[5 * 33]); o.w = cvt_pk_bf16(s[6 * 33], s[7 * 33]);
        *(u32x4*)(WT + (size_t)(dst_row0 + n) * ldt + k0 + 8 * c) = o; }
    LDS_WAIT(); asm volatile("" ::: "memory");
}
__device__ __forceinline__ void cvt_item8(const float* W, int ldw, int src_col0, unsigned char* WT, int ldt, int dst_row0, int k0, float sc, LAS float* scr, int lane) {
#pragma unroll 8
    for (int i = 0; i < 32; ++i) { const int kk = 2 * i + (lane >> 5); scr[kk * 33 + (lane & 31)] = W[(size_t)(k0 + kk) * ldw + src_col0 + (lane & 31)]; }
    LDS_WAIT(); asm volatile("" ::: "memory");
    const int c = lane & 7;
#pragma unroll
    for (int j = 0; j < 4; ++j) { const int n = (lane >> 3) + 8 * j; const LAS float* s = scr + (8 * c) * 33 + n;
        *(u32x2*)(WT + (size_t)(dst_row0 + n) * ldt + k0 + 8 * c) = (u32x2){pk_fp8x4(s[0 * 33] * sc, s[1 * 33] * sc, s[2 * 33] * sc, s[3 * 33] * sc), pk_fp8x4(s[4 * 33] * sc, s[5 * 33] * sc, s[6 * 33] * sc, s[7 * 33] * sc)}; }
    LDS_WAIT(); asm volatile("" ::: "memory");
}
enum { MAP_ID = 0, MAP_QKV = 1, MAP_SWI = 2 };
template <bool F8 = false>
__device__ __forceinline__ void cvt_family(const float* src, size_t sstride, int ninst, int ldw, int K, int ng, int map, int F, bf16_t* dst, size_t dstride,
                                           LAS float* scr, int gw, int NGW, int lane) {
    const int nkb = K / 64, per = nkb * ng, total = ninst * per;
    for (int it = gw; it < total; it += NGW) {
        const int inst = it / per, r = it - inst * per, kb = r / ng, gi = r - kb * ng;
        int sc0;
        if (map == MAP_ID) sc0 = 32 * gi;
        else if (map == MAP_QKV) { const int pn = gi >> 3, bj = (gi >> 2) & 1, wc = gi & 3;
            if (pn < 8) { const int part = pn >> 2, sh = 4 * (pn & 3) + wc; sc0 = part * 1024 + sh * 64 + 32 * bj; } else sc0 = 32 * gi; }
        else { const int pn = gi >> 3, bj = (gi >> 2) & 1, q = gi & 3; sc0 = bj * F + pn * 128 + 32 * q; }
        if constexpr (F8) cvt_item8(src + (size_t)inst * sstride, ldw, sc0, (unsigned char*)dst + (size_t)inst * dstride, K, 32 * gi, 64 * kb, MOE_WSCALE, scr, lane);
        else cvt_item(src + (size_t)inst * sstride, ldw, sc0, dst + (size_t)inst * dstride, K, 32 * gi, 64 * kb, scr, lane);
    }
}

__device__ __forceinline__ void prologue_phase(const Args& A, LAS unsigned char* lds, int bid, int G) {
    const int tid = threadIdx.x, lane = tid & 63, wave = tid >> 6;
    unsigned char* ws = A.ws;
    {
        LAS float* sc = (LAS float*)lds;
        LAS float* red = (LAS float*)(lds + 32768);
        for (int i = tid; i < NBATCH * DM; i += NTHR) { const float cv = A.in[I_C][i]; sc[i] = fsilu(cv); }
        __syncthreads();
        float* mods = (float*)(ws + TB_MODS);
        for (int cb = bid; cb < (DEPTH * 6144) / 128; cb += G) {
            const int col = cb * 128 + (tid & 127), l = col / 6144, e = col - l * 6144, ch = tid >> 7;
            const float* wp = A.in[I_ADAW] + (size_t)l * DM * 6144 + e;
            float a[NBATCH];
#pragma unroll
            for (int b = 0; b < NBATCH; ++b) a[b] = 0.f;
#pragma unroll 4
            for (int d = ch * 256; d < ch * 256 + 256; ++d) { const float w = wp[(size_t)d * 6144];
#pragma unroll
                for (int b = 0; b < NBATCH; ++b) a[b] += sc[b * DM + d] * w; }
#pragma unroll
            for (int b = 0; b < NBATCH; ++b) red[(ch * 128 + (tid & 127)) * 8 + b] = a[b];
            __syncthreads();
            if (tid < 128) { const float bias = A.in[I_ADAB][l * 6144 + e];
#pragma unroll
                for (int b = 0; b < NBATCH; ++b) { const float s = ((red[(0 * 128 + tid) * 8 + b] + red[(1 * 128 + tid) * 8 + b]) + (red[(2 * 128 + tid) * 8 + b] + red[(3 * 128 + tid) * 8 + b])) + bias;
                    mods[((size_t)l * NBATCH + b) * 6144 + e] = s; } }
            __syncthreads();
        }
    }
    {
        float* cosT = (float*)(ws + TB_COS); float* sinT = (float*)(ws + TB_SIN);
        for (int i = bid * NTHR + tid; i < SEQ * 32; i += G * NTHR) {
            const int pos = i >> 5, d = i & 31;
            const float inv = (float)exp(-(double)d * (1.0 / 32.0) * 9.210340371976184);
            const float ang = (float)pos * inv;
            const double rev = (double)ang * 0.15915494309189535; const float fr = (float)(rev - floor(rev));
            cosT[i] = __builtin_amdgcn_cosf(fr); sinT[i] = __builtin_amdgcn_sinf(fr);
        }
        if (bid == 0 && tid < 2) {
            const int a = tid; const float* lm = A.in[I_ATLAM] + a * 256;
            float s1 = 0.f, s2 = 0.f; for (int i = 0; i < 64; ++i) { s1 += lm[i] * lm[64 + i]; s2 += lm[128 + i] * lm[192 + i]; }
            const float linit = 0.8f - 0.6f * expf(-0.3f * (float)(3 * a));
            float mq = 0.f, mk = 0.f; for (int i = 0; i < 64; ++i) { mq = fmaxf(mq, fabsf(A.in[I_ATQN][a * 64 + i])); mk = fmaxf(mk, fabsf(A.in[I_ATKN][a * 64 + i])); }
            float* scal = (float*)(ws + TB_SCAL);
            scal[SC_LAM0 + a] = expf(s1) - expf(s2) + linit; scal[SC_OML0 + a] = 1.0f - linit; scal[SC_MC0 + a] = 8.0f * mq * mk * LOG2E * 1.0001f;
        }
        if (bid == 1) {
            float* lb = (float*)(ws + TB_LB);
            for (int i = tid; i < 2 * 1024; i += NTHR) { const int d = i >> 10, k = i & 1023; const float* p = A.in[I_HGLB] + (size_t)d * DEPTH * 1024 + k;
                float mx = p[0]; for (int l = 1; l < DEPTH; ++l) mx = fmaxf(mx, p[l * 1024]);
                float den = 0.f, num = 0.f; for (int l = 0; l < DEPTH; ++l) { const float e = expf(p[l * 1024] - mx); den += e; if (l == 1) num += e; }
                lb[i] = num / den; }
        }
        if (bid == 2) {
            float* sp = (float*)(ws + TB_SP);
            for (int i = tid; i < 2 * LRUW; i += NTHR) { const float x = -A.in[I_LRLAM][i]; sp[i] = (x > 20.f) ? x : log1pf(expf(x)); }
        }
    }
    {
        LAS float* scr = (LAS float*)(lds + wave * 16384);
        const int vcu = (bid % 8) * (G / 8) + bid / 8;
        const int gw = vcu * NWAVES + wave, NGW = G * NWAVES;
        cvt_family(A.in[I_ATWIN], (size_t)1024 * 3072, 2, 3072, 1024, 96, MAP_QKV, 0, (bf16_t*)(ws + W_QKV), (size_t)3072 * 1024, scr, gw, NGW, lane);
        cvt_family(A.in[I_ATWOUT], (size_t)1024 * 1024, 2, 1024, 1024, 32, MAP_ID, 0, (bf16_t*)(ws + W_AO), (size_t)1024 * 1024, scr, gw, NGW, lane);
        cvt_family(A.in[I_HGWIN], 0, 1, 5120, 1024, 160, MAP_ID, 0, (bf16_t*)(ws + W_HGI), 0, scr, gw, NGW, lane);
        cvt_family(A.in[I_HGWOUT], 0, 1, 1024, 1024, 32, MAP_ID, 0, (bf16_t*)(ws + W_HGO), 0, scr, gw, NGW, lane);
        cvt_family(A.in[I_LRWIN], 0, 1, 2560, 1024, 80, MAP_ID, 0, (bf16_t*)(ws + W_LRI), 0, scr, gw, NGW, lane);
        cvt_family(A.in[I_LRWOUT], 0, 1, 1024, 1280, 32, MAP_ID, 0, (bf16_t*)(ws + W_LRO), 0, scr, gw, NGW, lane);
        for (int it = gw; it < 2 * 20 * 2 * 4; it += NGW) {
            const int part = it / 160, r = it % 160, inst = r >> 3, kb = (r >> 2) & 1, gi = r & 3, d = inst / 10, n = inst % 10;
            const float* src = (part ? A.in[I_LRWX] : A.in[I_LRWA]) + (size_t)inst * 16384;
            cvt_item(src, 128, 32 * gi, (bf16_t*)(ws + W_LRG) + (size_t)(n * 2 + d) * 256 * 128, 128, part * 128 + 32 * gi, 64 * kb, scr, lane);
        }
        static_assert(FP8_DENSE_FROM == 2 || FP8_DENSE_FROM > 3, "dense layer 0 stays bf16; layer 2 optional");
        constexpr int NB16 = (FP8_DENSE_FROM == 2) ? 1 : 2;
        cvt_family(A.in[I_FFGU], (size_t)1024 * 5632, NB16, 5632, 1024, 176, MAP_SWI, DFF, (bf16_t*)(ws + W_FGU), (size_t)5632 * 1024, scr, gw, NGW, lane);
        cvt_family(A.in[I_FFDN], (size_t)2816 * 1024, NB16, 1024, 2816, 32, MAP_ID, 0, (bf16_t*)(ws + W_FDN), (size_t)1024 * 2816, scr, gw, NGW, lane);
        if constexpr (NB16 == 1) {
            cvt_family<true>(A.in[I_FFGU] + (size_t)1024 * 5632, 0, 1, 5632, 1024, 176, MAP_SWI, DFF, (bf16_t*)(ws + W_FGU) + (size_t)5632 * 1024, 0, scr, gw, NGW, lane);
            cvt_family<true>(A.in[I_FFDN] + (size_t)2816 * 1024, 0, 1, 1024, 2816, 32, MAP_ID, 0, (bf16_t*)(ws + W_FDN) + (size_t)1024 * 2816, 0, scr, gw, NGW, lane);
        }
        cvt_family<true>(A.in[I_MOEGU], (size_t)1024 * 7168, 16, 7168, 1024, 224, MAP_SWI, DFFE, (bf16_t*)(ws + W_MGU), (size_t)7168 * 1024, scr, gw, NGW, lane);
        cvt_family<true>(A.in[I_MOEDN], (size_t)3584 * 1024, 16, 1024, 3584, 32, MAP_ID, 0, (bf16_t*)(ws + W_MDN), (size_t)1024 * 3584, scr, gw, NGW, lane);
    }
}

template <bool ROUTER>
__device__ __forceinline__ void norm_phase(const Args& A, LAS unsigned char* lds, int bid, int G, const void* xsrc, bool src16, void* xdst, bool dst16, const float* gain, const float* modl  , int which,
                                           bool combine, const float* modprev  , bool nonorm, const float* router, bool f8out = false) {
    int tid_ = threadIdx.x; asm volatile("" : "+v"(tid_));
    const int tid = tid_, lane = tid & 63, wave = tid >> 6;
    unsigned char* ws = A.ws;
    bf16_t* HM = (bf16_t*)(ws + WS_HM);
    const int* slot = (const int*)(ws + TB_SLOT); const float* gts = (const float*)(ws + TB_GATE);
    const bf16_t* Y = (const bf16_t*)(ws + E_XS);
    LAS int* hist = (LAS int*)lds;
    for (int tb = bid; tb < MTOK / 256; tb += G) {
        const int b = tb >> 5;
        f32x4 ga[4], sh[4], g2[4];
#pragma unroll
        for (int j = 0; j < 4; ++j) { const int c = 256 * j + 4 * lane;
            if (!nonorm) { const f32x4 gv = *(const f32x4*)(gain + c), sv = *(const f32x4*)(modl + (size_t)b * 6144 + (which * 3 + 1) * 1024 + c);
                ga[j] = gv * (sv + 1.0f); sh[j] = *(const f32x4*)(modl + (size_t)b * 6144 + (which * 3) * 1024 + c); }
            if (combine) g2[j] = *(const f32x4*)(modprev + (size_t)b * 6144 + 5 * 1024 + c); }
        f32x4 rw[ROUTER ? 32 : 1];
        if constexpr (ROUTER) {
            if (tid < 8) hist[tid] = 0;
#pragma unroll
            for (int j = 0; j < 4; ++j)
#pragma unroll
                for (int i = 0; i < 4; ++i) { const int c = 256 * j + 4 * lane + i; rw[(j * 4 + i) * 2] = *(const f32x4*)(router + c * 8); rw[(j * 4 + i) * 2 + 1] = *(const f32x4*)(router + c * 8 + 4); }
            __syncthreads();
        }
        for (int i = 0; i < 32; ++i) {
            const int row = tb * 256 + wave * 32 + i;
            f32x4 v[4];
#pragma unroll
            for (int j = 0; j < 4; ++j) v[j] = pg8::ld_x4(xsrc, (size_t)row * DM + 256 * j + 4 * lane, src16);
            if (combine) {
                const int s0 = slot[row * 2], s1 = slot[row * 2 + 1]; const float w0 = gts[row * 2], w1 = gts[row * 2 + 1];
#pragma unroll
                for (int j = 0; j < 4; ++j) { const u32x2 a = *(const u32x2*)(Y + (size_t)s0 * DM + 256 * j + 4 * lane), c2 = *(const u32x2*)(Y + (size_t)s1 * DM + 256 * j + 4 * lane);
                    f32x4 y; y[0] = w0 * bflo(a.x) + w1 * bflo(c2.x); y[1] = w0 * bfhi(a.x) + w1 * bfhi(c2.x); y[2] = w0 * bflo(a.y) + w1 * bflo(c2.y); y[3] = w0 * bfhi(a.y) + w1 * bfhi(c2.y);
                    v[j] = v[j] + g2[j] * y;
                    if (dst16) *(u32x2*)((bf16_t*)xdst + (size_t)row * DM + 256 * j + 4 * lane) = (u32x2){cvt_pk_bf16(v[j][0], v[j][1]), cvt_pk_bf16(v[j][2], v[j][3])};
                    else *(f32x4*)((float*)xdst + (size_t)row * DM + 256 * j + 4 * lane) = v[j]; }
            }
            if (nonorm) continue;
            float ss = 0.f;
#pragma unroll
            for (int j = 0; j < 4; ++j) ss += (v[j][0] * v[j][0] + v[j][1] * v[j][1]) + (v[j][2] * v[j][2] + v[j][3] * v[j][3]);
            ss = wave_sum(ss);
            const float rstd = 1.0f / sqrtf(ss * (1.0f / DM) + EPS);
            f32x4 h[4];
#pragma unroll
            for (int j = 0; j < 4; ++j) { h[j] = v[j] * rstd * ga[j] + sh[j];
                if (f8out) { *(unsigned*)((unsigned char*)HM + (size_t)row * DM + 256 * j + 4 * lane) = pk_fp8x4(h[j][0], h[j][1], h[j][2], h[j][3]); }
                else { u32x2 w; w.x = cvt_pk_bf16(h[j][0], h[j][1]); w.y = cvt_pk_bf16(h[j][2], h[j][3]);
                    *(u32x2*)(HM + (size_t)row * DM + 256 * j + 4 * lane) = w; } }
            if constexpr (ROUTER) {
                float lg[8];
#pragma unroll
                for (int e = 0; e < 8; ++e) lg[e] = 0.f;
#pragma unroll
                for (int j = 0; j < 4; ++j)
#pragma unroll
                    for (int q = 0; q < 4; ++q) { const float hv = h[j][q]; const f32x4 r0 = rw[(j * 4 + q) * 2], r1 = rw[(j * 4 + q) * 2 + 1];
                        lg[0] += hv * r0[0]; lg[1] += hv * r0[1]; lg[2] += hv * r0[2]; lg[3] += hv * r0[3]; lg[4] += hv * r1[0]; lg[5] += hv * r1[1]; lg[6] += hv * r1[2]; lg[7] += hv * r1[3]; }
#pragma unroll
                for (int e = 0; e < 8; ++e) lg[e] = wave_sum(lg[e]);
                int e0 = 0; float v0 = lg[0];
#pragma unroll
                for (int e = 1; e < 8; ++e) if (lg[e] > v0) { v0 = lg[e]; e0 = e; }
                int e1 = -1; float v1 = -3.0e38f;
#pragma unroll
                for (int e = 0; e < 8; ++e) if (e != e0 && lg[e] > v1) { v1 = lg[e]; e1 = e; }
                const float p1 = frcp(1.0f + fexp(v1 - v0));
                if (lane == 0) { int* eid = (int*)(ws + TB_EID); float* gt = (float*)(ws + TB_GATE);
                    eid[row * 2] = e0; eid[row * 2 + 1] = e1; gt[row * 2] = p1; gt[row * 2 + 1] = 1.0f - p1;
                    atomicAdd((int*)&hist[e0], 1); atomicAdd((int*)&hist[e1], 1); }
            }
        }
        if constexpr (ROUTER) {
            __syncthreads();
            if (tid < 8) ((int*)(ws + TB_BCNT))[tb * 8 + tid] = hist[tid];
            __syncthreads();
        }
    }
}

namespace lru {
constexpr int XCF = 0, XCB = 16384, AA = 24576, UU = 40960, LAA = 57344;
__device__ __forceinline__ int sw256(int row, int cb) { return row * 256 + (cb ^ ((row & 15) << 4)); }
__device__ __forceinline__ int crow(int r, int hi) { return (r & 3) + 8 * (r >> 2) + 4 * hi; }
template <int MODE>
__device__ __forceinline__ void lru_item(const Args& A, LAS unsigned char* lds, int b, int n, int seg, int dir) {
    int tid_ = threadIdx.x; asm volatile("" : "+v"(tid_));
    const int tid = tid_, wid = tid >> 6, lane = tid & 63, r = lane & 31, hh = lane >> 5;
    unsigned char* ws = A.ws;
    const bf16_t* XB = (const bf16_t*)(ws + L_XB); const bf16_t* YB = (const bf16_t*)(ws + L_YB); bf16_t* HF = (bf16_t*)(ws + L_HF); bf16_t* HY = (bf16_t*)(ws + L_HY);
    bf16_t* LAg = (bf16_t*)(ws + (dir ? L_HY : L_HF)); bf16_t* Ug = (bf16_t*)(ws + L_U + (size_t)dir * SZ_LRU);
    const int ct = tid >> 4, cg = tid & 15, cc0 = n * 128 + 8 * cg;
    float carry = 0.f, P = 1.f;
    if (MODE != 0 && tid < 128) carry = ((const float*)(ws + TB_LCIN))[(size_t)((b * 32 + seg) * 2 + dir) * LRUW + n * 128 + tid];
    if constexpr (MODE == 0) {
        const bf16_t* Wg = (const bf16_t*)(ws + W_LRG) + (size_t)((n * 2 + dir) * 256 + ((r < 16) ? (16 * wid + r) : (128 + 16 * wid + r - 16))) * 128 + 8 * hh;
        bf16x8 bfrag[8];
#pragma unroll
        for (int ks = 0; ks < 8; ++ks) bfrag[ks] = *(const bf16x8*)(Wg + 16 * ks);
        const int cch = n * 128 + 16 * wid + (r & 15);
        const float nba = -LOG2E * A.in[I_LRBA][dir * LRUW + cch], nbx = -LOG2E * A.in[I_LRBX][dir * LRUW + cch], csp = -8.0f * LOG2E * ((const float*)(ws + TB_SP))[dir * LRUW + cch];
        float cw[4][8], cb[8];
#pragma unroll
        for (int j = 0; j < 8; ++j) { cb[j] = A.in[I_LRCB][cc0 + j];
#pragma unroll
            for (int w = 0; w < 4; ++w) cw[w][j] = A.in[I_LRCW][w * LRUW + cc0 + j]; }
        u32x4 xr[4];
#define LRU_XLOAD(si_) do { const int sub_ = dir ? (7 - (si_)) : (si_); const int tok_ = seg * 256 + sub_ * 32 + ct; \
        _Pragma("unroll") for (int w = 0; w < 4; ++w) { const int tt = tok_ - 1 + w; xr[w] = (tt >= 0 && tt < SEQ) ? *(const u32x4*)(XB + ((size_t)b * SEQ + tt) * LRUW + cc0) : (u32x4){0u, 0u, 0u, 0u}; } } while (0)
        LRU_XLOAD(0);
        for (int si = 0; si < 8; ++si) {
            const int sub = dir ? (7 - si) : si; const int t0 = seg * 256 + sub * 32;
            {
                float xc[8];
#pragma unroll
                for (int j = 0; j < 8; ++j) xc[j] = cb[j];
#pragma unroll
                for (int w = 0; w < 4; ++w) { const u32x4 v = xr[w];
#pragma unroll
                    for (int e = 0; e < 4; ++e) { xc[2 * e] += cw[w][2 * e] * bflo(v[e]); xc[2 * e + 1] += cw[w][2 * e + 1] * bfhi(v[e]); } }
                if (si + 1 < 8) LRU_XLOAD(si + 1);
                *(LAS f32x4*)(lds + XCF + (ct * 128 + 8 * cg) * 4) = (f32x4){xc[0], xc[1], xc[2], xc[3]};
                *(LAS f32x4*)(lds + XCF + (ct * 128 + 8 * cg + 4) * 4) = (f32x4){xc[4], xc[5], xc[6], xc[7]};
                *(LAS u32x4*)(lds + XCB + sw256(ct, 16 * cg)) = (u32x4){cvt_pk_bf16(xc[0], xc[1]), cvt_pk_bf16(xc[2], xc[3]), cvt_pk_bf16(xc[4], xc[5]), cvt_pk_bf16(xc[6], xc[7])};
            }
            __syncthreads();
            {
                f32x16 acc = {};
#pragma unroll
                for (int ks = 0; ks < 8; ++ks) { const bf16x8 fa = *(const LAS bf16x8*)(lds + XCB + sw256(r, (16 * ks + 8 * hh) * 2)); acc = __builtin_amdgcn_mfma_f32_32x32x16_bf16(fa, bfrag[ks], acc, 0, 0, 0); }
#pragma unroll
                for (int q = 0; q < 8; ++q) {
                    const auto sw = __builtin_amdgcn_permlane16_swap(__float_as_uint(acc[q]), __float_as_uint(acc[8 + q]), false, false);
                    const float rp = __uint_as_float(sw[0]), ip = __uint_as_float(sw[1]);
                    const int tq = crow((r < 16) ? q : (8 + q), hh); const int cl = 16 * wid + (r & 15);
                    const float xcv = ((const LAS float*)(lds + XCF))[tq * 128 + cl];
                    const float rg = frcp(1.0f + fexp2(fmaf(rp, -LOG2E, nba))), ig = frcp(1.0f + fexp2(fmaf(ip, -LOG2E, nbx)));
                    const float la = csp * rg, av = fexp2(la), uv = __builtin_amdgcn_sqrtf(fmaxf(fmaf(-av, av, 1.0f), 0.f)) * ig * xcv;
                    ((LAS float*)(lds + AA))[tq * 128 + cl] = av; ((LAS float*)(lds + UU))[tq * 128 + cl] = uv; ((LAS float*)(lds + LAA))[tq * 128 + cl] = la; }
            }
            __syncthreads();
            if (tid < 128) {
                LAS float* ap = (LAS float*)(lds + AA) + tid; LAS float* up = (LAS float*)(lds + UU) + tid; float av[32], uv[32];
#pragma unroll
                for (int i = 0; i < 32; ++i) { av[i] = ap[i * 128]; uv[i] = up[i * 128]; }
                if (dir == 0) {
#pragma unroll
                    for (int i = 0; i < 32; ++i) { carry = av[i] * carry + uv[i]; P *= av[i]; } }
                else {
#pragma unroll
                    for (int i = 31; i >= 0; --i) { carry = av[i] * carry + uv[i]; P *= av[i]; } }
            } else if (tid >= 256) {
                const int t2 = tid - 256, row = t2 >> 3, c16 = (t2 & 7) * 16; const size_t go = ((size_t)b * SEQ + t0 + row) * LRUW + n * 128 + c16;
                const LAS float* lp = (const LAS float*)(lds + LAA) + row * 128 + c16; const LAS float* up = (const LAS float*)(lds + UU) + row * 128 + c16;
                f32x4 l[4], u[4];
#pragma unroll
                for (int j = 0; j < 4; ++j) { l[j] = *(const LAS f32x4*)(lp + 4 * j); u[j] = *(const LAS f32x4*)(up + 4 * j); }
#pragma unroll
                for (int j = 0; j < 2; ++j) {
                    *(u32x4*)(LAg + go + 8 * j) = (u32x4){cvt_pk_bf16(l[2 * j][0], l[2 * j][1]), cvt_pk_bf16(l[2 * j][2], l[2 * j][3]), cvt_pk_bf16(l[2 * j + 1][0], l[2 * j + 1][1]), cvt_pk_bf16(l[2 * j + 1][2], l[2 * j + 1][3])};
                    *(u32x4*)(Ug + go + 8 * j) = (u32x4){cvt_pk_bf16(u[2 * j][0], u[2 * j][1]), cvt_pk_bf16(u[2 * j][2], u[2 * j][3]), cvt_pk_bf16(u[2 * j + 1][0], u[2 * j + 1][1]), cvt_pk_bf16(u[2 * j + 1][2], u[2 * j + 1][3])}; }
            }
            __syncthreads();
        }
#undef LRU_XLOAD
        if (tid < 128) { float* sm = (float*)(ws + TB_LSUM) + (size_t)(((b * 32 + seg) * 2 + dir) * 2) * LRUW + n * 128 + tid; sm[0] = P; sm[LRUW] = carry; }
    } else {
        u32x4 lr, ur;
#define LRU_GLOAD(si_) do { const int sub_ = dir ? (7 - (si_)) : (si_); const size_t go_ = ((size_t)b * SEQ + seg * 256 + sub_ * 32 + ct) * LRUW + cc0; \
        lr = *(const u32x4*)(LAg + go_); ur = *(const u32x4*)(Ug + go_); } while (0)
        LRU_GLOAD(0);
        for (int si = 0; si < 8; ++si) {
            const int sub = dir ? (7 - si) : si; const int t0 = seg * 256 + sub * 32;
            {   const u32x4 l = lr, u = ur;
                if (si + 1 < 8) LRU_GLOAD(si + 1);
                *(LAS f32x4*)(lds + AA + (ct * 128 + 8 * cg) * 4) = (f32x4){fexp2(bflo(l[0])), fexp2(bfhi(l[0])), fexp2(bflo(l[1])), fexp2(bfhi(l[1]))};
                *(LAS f32x4*)(lds + AA + (ct * 128 + 8 * cg + 4) * 4) = (f32x4){fexp2(bflo(l[2])), fexp2(bfhi(l[2])), fexp2(bflo(l[3])), fexp2(bfhi(l[3]))};
                *(LAS f32x4*)(lds + UU + (ct * 128 + 8 * cg) * 4) = (f32x4){bflo(u[0]), bfhi(u[0]), bflo(u[1]), bfhi(u[1])};
                *(LAS f32x4*)(lds + UU + (ct * 128 + 8 * cg + 4) * 4) = (f32x4){bflo(u[2]), bfhi(u[2]), bflo(u[3]), bfhi(u[3])}; }
            __syncthreads();
            if (tid < 128) {
                LAS float* ap = (LAS float*)(lds + AA) + tid; LAS float* up = (LAS float*)(lds + UU) + tid; float av[32], uv[32];
#pragma unroll
                for (int i = 0; i < 32; ++i) { av[i] = ap[i * 128]; uv[i] = up[i * 128]; }
                if (dir == 0) {
#pragma unroll
                    for (int i = 0; i < 32; ++i) { carry = av[i] * carry + uv[i]; uv[i] = carry; } }
                else {
#pragma unroll
                    for (int i = 31; i >= 0; --i) { carry = av[i] * carry + uv[i]; uv[i] = carry; } }
#pragma unroll
                for (int i = 0; i < 32; ++i) up[i * 128] = uv[i];
            }
            __syncthreads();
            {   const int tok = t0 + ct; const size_t go = ((size_t)b * SEQ + tok) * LRUW + cc0;
                const f32x4 h0 = *(const LAS f32x4*)(lds + UU + (ct * 128 + 8 * cg) * 4), h1 = *(const LAS f32x4*)(lds + UU + (ct * 128 + 8 * cg + 4) * 4);
                if (MODE == 1) { *(u32x4*)(HF + go) = (u32x4){cvt_pk_bf16(h0[0], h0[1]), cvt_pk_bf16(h0[2], h0[3]), cvt_pk_bf16(h1[0], h1[1]), cvt_pk_bf16(h1[2], h1[3])}; }
                else { const u32x4 f = *(const u32x4*)(HF + go), y = *(const u32x4*)(YB + go);
                    *(u32x4*)(HY + go) = (u32x4){cvt_pk_bf16((h0[0] + bflo(f[0])) * bflo(y[0]), (h0[1] + bfhi(f[0])) * bfhi(y[0])), cvt_pk_bf16((h0[2] + bflo(f[1])) * bflo(y[1]), (h0[3] + bfhi(f[1])) * bfhi(y[1])),
                                                cvt_pk_bf16((h1[0] + bflo(f[2])) * bflo(y[2]), (h1[1] + bfhi(f[2])) * bfhi(y[2])), cvt_pk_bf16((h1[2] + bflo(f[3])) * bflo(y[3]), (h1[3] + bfhi(f[3])) * bfhi(y[3]))}; }
            }
            __syncthreads();
        }
#undef LRU_GLOAD
    }
}
__device__ __forceinline__ void lru_apply_item(const Args& A, LAS unsigned char* lds, int b, int n, int seg) {
    constexpr int HFL = 57344;
    int tid_ = threadIdx.x; asm volatile("" : "+v"(tid_));
    const int tid = tid_;
    unsigned char* ws = A.ws;
    const bf16_t* YB = (const bf16_t*)(ws + L_YB); bf16_t* HY = (bf16_t*)(ws + L_HY);
    const int ct = tid >> 4, cg = tid & 15, cc0 = n * 128 + 8 * cg;
#pragma unroll 1
    for (int dir = 0; dir < 2; ++dir) {
        const bf16_t* LAg = (const bf16_t*)(ws + (dir ? L_HY : L_HF)); const bf16_t* Ug = (const bf16_t*)(ws + L_U + (size_t)dir * SZ_LRU);
        float carry = 0.f;
        if (tid < 128) carry = ((const float*)(ws + TB_LCIN))[(size_t)((b * 32 + seg) * 2 + dir) * LRUW + n * 128 + tid];
        u32x4 lr, ur, yr = {0u, 0u, 0u, 0u};
#define LRU_GLOAD(si_) do { const int sub_ = dir ? (7 - (si_)) : (si_); const size_t go_ = ((size_t)b * SEQ + seg * 256 + sub_ * 32 + ct) * LRUW + cc0; \
        lr = *(const u32x4*)(LAg + go_); ur = *(const u32x4*)(Ug + go_); if (dir) yr = *(const u32x4*)(YB + go_); } while (0)
        LRU_GLOAD(0);
        for (int si = 0; si < 8; ++si) {
            const int sub = dir ? (7 - si) : si; const int t0 = seg * 256 + sub * 32;
            const u32x4 l = lr, u = ur, y = yr;
            if (si + 1 < 8) LRU_GLOAD(si + 1);
            *(LAS f32x4*)(lds + AA + (ct * 128 + 8 * cg) * 4) = (f32x4){fexp2(bflo(l[0])), fexp2(bfhi(l[0])), fexp2(bflo(l[1])), fexp2(bfhi(l[1]))};
            *(LAS f32x4*)(lds + AA + (ct * 128 + 8 * cg + 4) * 4) = (f32x4){fexp2(bflo(l[2])), fexp2(bfhi(l[2])), fexp2(bflo(l[3])), fexp2(bfhi(l[3]))};
            *(LAS f32x4*)(lds + UU + (ct * 128 + 8 * cg) * 4) = (f32x4){bflo(u[0]), bfhi(u[0]), bflo(u[1]), bfhi(u[1])};
            *(LAS f32x4*)(lds + UU + (ct * 128 + 8 * cg + 4) * 4) = (f32x4){bflo(u[2]), bfhi(u[2]), bflo(u[3]), bfhi(u[3])};
            __syncthreads();
            if (tid < 128) {
                LAS float* ap = (LAS float*)(lds + AA) + tid; LAS float* up = (LAS float*)(lds + UU) + tid; float av[32], uv[32];
#pragma unroll
                for (int i = 0; i < 32; ++i) { av[i] = ap[i * 128]; uv[i] = up[i * 128]; }
                if (dir == 0) {
#pragma unroll
                    for (int i = 0; i < 32; ++i) { carry = av[i] * carry + uv[i]; uv[i] = carry; } }
                else {
#pragma unroll
                    for (int i = 31; i >= 0; --i) { carry = av[i] * carry + uv[i]; uv[i] = carry; } }
#pragma unroll
                for (int i = 0; i < 32; ++i) up[i * 128] = uv[i];
            }
            __syncthreads();
            {   const f32x4 h0 = *(const LAS f32x4*)(lds + UU + (ct * 128 + 8 * cg) * 4), h1 = *(const LAS f32x4*)(lds + UU + (ct * 128 + 8 * cg + 4) * 4);
                LAS u32x4* hf = (LAS u32x4*)(lds + HFL + ((sub * 32 + ct) * 128 + 8 * cg) * 2);
                if (dir == 0) *hf = (u32x4){cvt_pk_bf16(h0[0], h0[1]), cvt_pk_bf16(h0[2], h0[3]), cvt_pk_bf16(h1[0], h1[1]), cvt_pk_bf16(h1[2], h1[3])};
                else { const u32x4 f = *hf; const size_t go = ((size_t)b * SEQ + t0 + ct) * LRUW + cc0;
                    *(u32x4*)(HY + go) = (u32x4){cvt_pk_bf16((h0[0] + bflo(f[0])) * bflo(y[0]), (h0[1] + bfhi(f[0])) * bfhi(y[0])), cvt_pk_bf16((h0[2] + bflo(f[1])) * bflo(y[1]), (h0[3] + bfhi(f[1])) * bfhi(y[1])),
                                                cvt_pk_bf16((h1[0] + bflo(f[2])) * bflo(y[2]), (h1[1] + bfhi(f[2])) * bfhi(y[2])), cvt_pk_bf16((h1[2] + bflo(f[3])) * bflo(y[3]), (h1[3] + bfhi(f[3])) * bfhi(y[3]))}; }
            }
            __syncthreads();
        }
#undef LRU_GLOAD
    }
}
}
__device__ __forceinline__ void lru_apply_phase(const Args& A, LAS unsigned char* lds, int bid, int G) {
    for (int it = bid; it < 2560; it += G) lru::lru_apply_item(A, lds, it / 320, (it >> 5) % 10, it & 31);
}
template <int MODE>
__device__ __forceinline__ void lru_phase(const Args& A, LAS unsigned char* lds, int bid, int G) {
    const int nitems = (MODE == 0) ? 5120 : 2560;
    for (int it = bid; it < nitems; it += G) {
        int b, n, seg, dir;
        if (MODE == 0) { dir = it & 1; const int r = it >> 1; seg = r & 31; n = (r >> 5) % 10; b = r / 320; }
        else { dir = MODE - 1; seg = it & 31; n = (it >> 5) % 10; b = it / 320; }
        lru::lru_item<MODE>(A, lds, b, n, seg, dir);
    }
}
__device__ __forceinline__ void lru_carry_phase(const Args& A, int bid, int G) {
    const float* sm = (const float*)(A.ws + TB_LSUM); float* cin = (float*)(A.ws + TB_LCIN);
    for (int idx = bid * NTHR + threadIdx.x; idx < NBATCH * 2 * LRUW; idx += G * NTHR) {
        const int b = idx / (2 * LRUW), r = idx % (2 * LRUW), dir = r / LRUW, ch = r % LRUW; float carry = 0.f;
        for (int i = 0; i < 32; ++i) { const int sg = dir ? (31 - i) : i; const size_t o = (size_t)((b * 32 + sg) * 2 + dir);
            cin[o * LRUW + ch] = carry; carry = sm[o * 2 * LRUW + ch] * carry + sm[o * 2 * LRUW + LRUW + ch]; }
    }
}

__device__ __forceinline__ void place_phase(const Args& A, LAS unsigned char* lds, int bid, int G) {
    int tid_ = threadIdx.x; asm volatile("" : "+v"(tid_));
    const int tid = tid_, lane = tid & 63, wave = tid >> 6; unsigned char* ws = A.ws;
    const int* bcnt = (const int*)(ws + TB_BCNT); const int* eid = (const int*)(ws + TB_EID); int* slot = (int*)(ws + TB_SLOT);
    const bf16_t* HM = (const bf16_t*)(ws + WS_HM); bf16_t* XS = (bf16_t*)(ws + E_XS);
    LAS int* tot = (LAS int*)lds; LAS int* pre = tot + 8; LAS int* rb = tot + 16; LAS int* wcn = tot + 32; LAS int* sl = tot + 64;
    for (int tb = bid; tb < MTOK / 256; tb += G) {
        { int t_ = 0, p_ = 0;
#pragma unroll
            for (int j = 0; j < 4; ++j) { const int blk = lane + 64 * j; const int v = bcnt[blk * 8 + wave]; t_ += v; p_ += (blk < tb) ? v : 0; }
#pragma unroll
            for (int o = 1; o < 64; o <<= 1) { t_ += __shfl_xor(t_, o); p_ += __shfl_xor(p_, o); }
            if (lane == 0) { tot[wave] = t_; pre[wave] = p_; } }
        __syncthreads();
        if (tid == 0) { int acc = 0; for (int e = 0; e < 8; ++e) { rb[e] = acc * 256; if (tb == 0) ((int*)(ws + TB_TILES))[e] = acc; acc += (tot[e] + 255) >> 8; } if (tb == 0) ((int*)(ws + TB_TILES))[8] = acc; }
        int e0 = -1, e1 = -1; unsigned long long mk0 = 0, mk1 = 0;
        if (tid < 256) { e0 = eid[(tb * 256 + tid) * 2]; e1 = eid[(tb * 256 + tid) * 2 + 1];
#pragma unroll
            for (int e = 0; e < 8; ++e) { const unsigned long long m = __ballot(e0 == e || e1 == e); if (lane == 0) wcn[wave * 8 + e] = __popcll(m); if (e0 == e) mk0 = m; if (e1 == e) mk1 = m; } }
        __syncthreads();
        if (tid < 256) { const unsigned long long lt = (1ull << lane) - 1ull; int b0 = rb[e0] + pre[e0] + __popcll(mk0 & lt), b1 = rb[e1] + pre[e1] + __popcll(mk1 & lt);
            for (int w = 0; w < wave; ++w) { b0 += wcn[w * 8 + e0]; b1 += wcn[w * 8 + e1]; }
            sl[tid * 2] = b0; sl[tid * 2 + 1] = b1; slot[(tb * 256 + tid) * 2] = b0; slot[(tb * 256 + tid) * 2 + 1] = b1; }
        __syncthreads();
        for (int i = 0; i < 32; ++i) { const int t = wave * 32 + i; const int s0 = sl[t * 2], s1 = sl[t * 2 + 1];
            const bf16_t* src = HM + (size_t)(tb * 256 + t) * DM + lane * 16;
            const u32x4 a = *(const u32x4*)src, b = *(const u32x4*)(src + 8);
            const u32x4 q = {pk_fp8x4(bflo(a[0]), bfhi(a[0]), bflo(a[1]), bfhi(a[1])), pk_fp8x4(bflo(a[2]), bfhi(a[2]), bflo(a[3]), bfhi(a[3])),
                             pk_fp8x4(bflo(b[0]), bfhi(b[0]), bflo(b[1]), bfhi(b[1])), pk_fp8x4(bflo(b[2]), bfhi(b[2]), bflo(b[3]), bfhi(b[3]))};
            *(u32x4*)((unsigned char*)XS + (size_t)s0 * DM + lane * 16) = q; *(u32x4*)((unsigned char*)XS + (size_t)s1 * DM + lane * 16) = q; }
        __syncthreads();
    }
}

namespace att {
constexpr int KVBLK = 64;
#define SBAR() __builtin_amdgcn_sched_barrier(0)
typedef int v8i __attribute__((ext_vector_type(8)));
__device__ __forceinline__ int crow(int r, int hi) { return (r & 3) + 8 * (r >> 2) + 4 * hi; }
constexpr int SLOTB = 8192;
__device__ __forceinline__ int k_slot(int s) { return s * SLOTB; }
__device__ __forceinline__ int v_slot(int s) { return 65536 + s * SLOTB; }
__device__ __forceinline__ int kswz(int row) { return ((row & 7) ^ (row >> 4)) & 7; }
__device__ __forceinline__ int vswz(int row) { return (row >> 2) & 3; }
__device__ __forceinline__ void mfma8_acc(f32x16& acc, const v8i& a, const v8i& b, int sc) {
    asm volatile("s_nop 4\n\tv_mfma_scale_f32_32x32x64_f8f6f4 %0, %1, %2, %0, %3, %3 op_sel_hi:[0,0,0]" : "+v"(acc) : "v"(a), "v"(b), "v"(sc) : "memory");
}
__device__ __forceinline__ void mfma8_c(f32x16& d, const v8i& a, const v8i& b, const f32x16& c, int sa, int sb) {
    asm volatile("v_mfma_scale_f32_32x32x64_f8f6f4 %0, %1, %2, %3, %4, %5 op_sel_hi:[0,0,0]" : "=&v"(d) : "v"(a), "v"(b), "v"(c), "v"(sa), "v"(sb) : "memory");
}
#define ATT_LD8(p0_, p1_) __builtin_bit_cast(v8i, __builtin_shufflevector(*(const LAS u32x4*)(p0_), *(const LAS u32x4*)(p1_), 0, 1, 2, 3, 4, 5, 6, 7))
__device__ __forceinline__ void qkt(f32x16& p0, f32x16& p1, const LAS char* Ks, const v8i& qr, int r32, int hi, int jj, const f32x16& cinit, int s1, int s8) {
    const int c0 = jj * 4 + 2 * hi;
    { const int row = r32; const v8i kf = ATT_LD8(Ks + row * 128 + ((c0 ^ kswz(row)) << 4), Ks + row * 128 + (((c0 + 1) ^ kswz(row)) << 4)); mfma8_c(p0, kf, qr, cinit, s1, s8); }
    { const int row = 32 + r32; const v8i kf = ATT_LD8(Ks + row * 128 + ((c0 ^ kswz(row)) << 4), Ks + row * 128 + (((c0 + 1) ^ kswz(row)) << 4)); mfma8_c(p1, kf, qr, cinit, s1, s8); }
}
__device__ __forceinline__ void load_kf(v8i& kf0, v8i& kf1, const LAS char* Ks, int r32, int hi, int jj) {
    const int c0 = jj * 4 + 2 * hi, row1 = 32 + r32;
    kf0 = ATT_LD8(Ks + r32 * 128 + ((c0 ^ kswz(r32)) << 4), Ks + r32 * 128 + (((c0 + 1) ^ kswz(r32)) << 4));
    kf1 = ATT_LD8(Ks + row1 * 128 + ((c0 ^ kswz(row1)) << 4), Ks + row1 * 128 + (((c0 + 1) ^ kswz(row1)) << 4));
}
#define ATT_VFR(Vs, d0) ATT_LD8((Vs) + (32 * (d0) + r32) * 64 + (((2 * hi) ^ vswz(32 * (d0) + r32)) << 4), (Vs) + (32 * (d0) + r32) * 64 + (((2 * hi + 1) ^ vswz(32 * (d0) + r32)) << 4))
__device__ __forceinline__ void pack_p(const float (&pe)[32], v8i& pa);
__device__ __forceinline__ void qkt_pack(f32x16& p0, f32x16& p1, const v8i& kf0, const v8i& kf1, const v8i& qr, const f32x16& cinit, int s1, int s8, const float (&pe)[32], v8i& pa) {
#define ATT_MC8(d, kf, B, O0, O1, O2, O3) \
    asm volatile("v_mfma_scale_f32_32x32x64_f8f6f4 %0, %21, %22, %23, %24, %25 op_sel_hi:[0,0,0]\n\t" \
                 "v_cvt_pk_fp8_f32 %1, %5, %6\n\tv_cvt_pk_fp8_f32 %1, %7, %8 op_sel:[0,0,1]\n\t" \
                 "v_cvt_pk_fp8_f32 %2, %9, %10\n\tv_cvt_pk_fp8_f32 %2, %11, %12 op_sel:[0,0,1]\n\t" \
                 "v_cvt_pk_fp8_f32 %3, %13, %14\n\tv_cvt_pk_fp8_f32 %3, %15, %16 op_sel:[0,0,1]\n\t" \
                 "v_cvt_pk_fp8_f32 %4, %17, %18\n\tv_cvt_pk_fp8_f32 %4, %19, %20 op_sel:[0,0,1]" \
                 : "=&v"(d), "=&v"(O0), "=&v"(O1), "=&v"(O2), "=&v"(O3) \
                 : "v"(pe[B]), "v"(pe[B + 1]), "v"(pe[B + 2]), "v"(pe[B + 3]), "v"(pe[B + 4]), "v"(pe[B + 5]), "v"(pe[B + 6]), "v"(pe[B + 7]), \
                   "v"(pe[B + 8]), "v"(pe[B + 9]), "v"(pe[B + 10]), "v"(pe[B + 11]), "v"(pe[B + 12]), "v"(pe[B + 13]), "v"(pe[B + 14]), "v"(pe[B + 15]), \
                   "v"(kf), "v"(qr), "v"(cinit), "v"(s1), "v"(s8) : "memory")
    int q0, q1, q2, q3, q4, q5, q6, q7;
    ATT_MC8(p0, kf0, 0, q0, q1, q2, q3);
    ATT_MC8(p1, kf1, 16, q4, q5, q6, q7);
#undef ATT_MC8
    pa = (v8i){q0, q1, q2, q3, q4, q5, q6, q7};
}
__device__ __forceinline__ void partialSM(f32x16& p0) {
#pragma unroll
    for (int r = 0; r < 16; ++r) p0[r] = fexp2(p0[r]);
}
__device__ __forceinline__ void finishSM(f32x16& p0, f32x16& p1, v8i& pa) {
#pragma unroll
    for (int r = 0; r < 16; ++r) p1[r] = fexp2(p1[r]);
#pragma unroll
    for (int w = 0; w < 4; ++w) { pa[w] = (int)pk_fp8x4(p0[4 * w], p0[4 * w + 1], p0[4 * w + 2], p0[4 * w + 3]); pa[4 + w] = (int)pk_fp8x4(p1[4 * w], p1[4 * w + 1], p1[4 * w + 2], p1[4 * w + 3]); }
}
#define ATT_MX7(acc, a, b, sc, NOP, O, I, k) \
    asm volatile(NOP "v_mfma_scale_f32_32x32x64_f8f6f4 %0, %15, %16, %0, %17, %17 op_sel_hi:[0,0,0]\n\tv_exp_f32 %1, %8\n\tv_exp_f32 %2, %9\n\tv_exp_f32 %3, %10\n\tv_exp_f32 %4, %11\n\tv_exp_f32 %5, %12\n\tv_exp_f32 %6, %13\n\tv_exp_f32 %7, %14" \
                 : "+v"(acc), "=&v"(O[k]), "=&v"(O[k + 1]), "=&v"(O[k + 2]), "=&v"(O[k + 3]), "=&v"(O[k + 4]), "=&v"(O[k + 5]), "=&v"(O[k + 6]) \
                 : "v"(I(k)), "v"(I(k + 1)), "v"(I(k + 2)), "v"(I(k + 3)), "v"(I(k + 4)), "v"(I(k + 5)), "v"(I(k + 6)), "v"(a), "v"(b), "v"(sc) : "memory")
__device__ __forceinline__ void pv_exp_a(f32x16* o, const v8i& vf0, const v8i& vf1, const v8i& vf2, const v8i& pa, int s1, const f32x16& r0, const f32x16& r1, float (&pe)[32]) {
#define ATT_RI(k) (((k) < 16) ? r0[(k) & 15] : r1[(k) & 15])
    ATT_MX7(o[0], pa, vf0, s1, "s_nop 4\n\t", pe, ATT_RI, 0);
    ATT_MX7(o[1], pa, vf1, s1, "", pe, ATT_RI, 7);
    ATT_MX7(o[2], pa, vf2, s1, "", pe, ATT_RI, 14);
#undef ATT_RI
}
__device__ __forceinline__ void pv_exp_b(f32x16* o, f32x16& lacc, const v8i& ones, const v8i& vf3, const v8i& pa, int s1, const f32x16& r0, const f32x16& r1, float (&pe)[32]) {
#define ATT_RI(k) (((k) < 16) ? r0[(k) & 15] : r1[(k) & 15])
    ATT_MX7(o[3], pa, vf3, s1, "", pe, ATT_RI, 21);
    asm volatile("v_mfma_scale_f32_32x32x64_f8f6f4 %0, %9, %10, %0, %11, %11 op_sel_hi:[0,0,0]\n\tv_exp_f32 %1, %5\n\tv_exp_f32 %2, %6\n\tv_exp_f32 %3, %7\n\tv_exp_f32 %4, %8"
                 : "+v"(lacc), "=&v"(pe[28]), "=&v"(pe[29]), "=&v"(pe[30]), "=&v"(pe[31]) : "v"(r1[12]), "v"(r1[13]), "v"(r1[14]), "v"(r1[15]), "v"(pa), "v"(ones), "v"(s1) : "memory");
#undef ATT_RI
}
__device__ __forceinline__ void pack_p(const float (&pe)[32], v8i& pa) {
#pragma unroll
    for (int w = 0; w < 8; ++w) pa[w] = (int)pk_fp8x4(pe[4 * w], pe[4 * w + 1], pe[4 * w + 2], pe[4 * w + 3]);
}
__device__ __forceinline__ void pv_d0(f32x16* o, f32x16& lacc, const v8i& ones, const LAS char* Vs, const v8i& pa, int r32, int hi, int s1) {
#pragma unroll
    for (int d0 = 0; d0 < 4; ++d0) { const int row = 32 * d0 + r32;
        const v8i vf = ATT_LD8(Vs + row * 64 + (((2 * hi) ^ vswz(row)) << 4), Vs + row * 64 + (((2 * hi + 1) ^ vswz(row)) << 4));
        mfma8_acc(o[d0], pa, vf, s1); }
    mfma8_acc(lacc, pa, ones, s1);
}
__device__ __forceinline__ void pv_last(f32x16* o, f32x16& lacc, const v8i& ones, const v8i& vf0, const v8i& vf1, const v8i& vf2, const v8i& vf3, const v8i& pa, int s1) {
    mfma8_acc(o[0], pa, vf0, s1); mfma8_acc(o[1], pa, vf1, s1); mfma8_acc(o[2], pa, vf2, s1); mfma8_acc(o[3], pa, vf3, s1); mfma8_acc(lacc, pa, ones, s1);
}
}

__device__ __forceinline__ void vt_phase(const Args& A, int bid, int G) {
    const int tid = threadIdx.x; unsigned char* ws = A.ws;
    const bf16_t* V = (const bf16_t*)(ws + A_V); unsigned char* VT = ws + A_VT;
    const int dv = tid & 127, kq = tid >> 7, half = kq >> 1, hi = kq & 1;
    for (int it = bid; it < 64 * 128; it += G) {
        const int bh = it >> 7, tile = it & 127, b = bh >> 3, h = bh & 7;
        const bf16_t* vp = V + ((size_t)b * SEQ + tile * 64 + 32 * half) * DM + h * 128 + dv;
        float f[16];
#pragma unroll
        for (int i = 0; i < 16; ++i) f[i] = bf2f(vp[(size_t)att::crow(i, hi) * DM]);
        *(u32x4*)(VT + (((size_t)bh * 128 + tile) * 128 + dv) * 64 + hi * 32 + half * 16) =
            (u32x4){pk_fp8x4(f[0], f[1], f[2], f[3]), pk_fp8x4(f[4], f[5], f[6], f[7]), pk_fp8x4(f[8], f[9], f[10], f[11]), pk_fp8x4(f[12], f[13], f[14], f[15])};
    }
}

__device__ __forceinline__ void attn_phase(const Args& A, LAS unsigned char* ldsu, int bid, int G, int al) {
    using namespace att;
    LAS char* lds = (LAS char*)ldsu;
    unsigned char* ws = A.ws;
    const unsigned char* Qg = ws + A_Q; const unsigned char* Kg = ws + A_K; const unsigned char* VTg = ws + A_VT;
    bf16_t* Og = (bf16_t*)(ws + WS_HM);
    const float* scal = (const float*)(ws + TB_SCAL);
    const float lamv = scal[SC_LAM0 + al], omli = scal[SC_OML0 + al], Mc = scal[SC_MC0 + al] - 7.5f;
    const float* subg = A.in[I_ATSUB] + al * 128;
    int tid_ = threadIdx.x; asm volatile("" : "+v"(tid_));
    const int tid = tid_, wid = __builtin_amdgcn_readfirstlane(tid >> 6), lane = tid & 63, r32 = lane & 31, hi = lane >> 5, jj = wid >> 2, wq = wid & 3;
    constexpr int NT = SEQ / KVBLK;
    int s1 = 0x7f7f7f7f, s8 = 0x7c7c7c7c; asm volatile("" : "+v"(s1), "+v"(s8));
    v8i ones; { int o1 = 0x38383838; asm volatile("" : "+v"(o1)); ones = (v8i){o1, o1, o1, o1, o1, o1, o1, o1}; }
    f32x16 cinit;
#pragma unroll
    for (int r = 0; r < 16; ++r) cinit[r] = -Mc;
    unsigned koff, voff;
    { const int bb = wid * 1024 + lane * 16;
      { const int row = bb >> 7, c = ((bb & 127) >> 4) ^ kswz(row); koff = (unsigned)(row * 1024 + c * 16); }
      { const int row = bb >> 6, c = ((bb & 63) >> 4) ^ vswz(row); voff = (unsigned)(row * 64 + c * 16); } }
    const unsigned ldsw = (unsigned)wid * 1024u;
    const __amdgpu_buffer_rsrc_t rK = __builtin_amdgcn_make_buffer_rsrc((void*)Kg, (short)0, 0x7fffffff, 0x00020000);
    const __amdgpu_buffer_rsrc_t rV = __builtin_amdgcn_make_buffer_rsrc((void*)VTg, (short)0, 0x7fffffff, 0x00020000);
#define ATT_DMA(slot, kt, vt) do { \
        __builtin_amdgcn_raw_ptr_buffer_load_lds(rK, (LAS void*)(lds + k_slot(slot) + ldsw), 16, (int)koff, (int)(kt), 0, 0); \
        __builtin_amdgcn_raw_ptr_buffer_load_lds(rV, (LAS void*)(lds + v_slot(slot) + ldsw), 16, (int)voff, (int)(vt), 0, 0); } while (0)
#define ATT_TOP() do { asm volatile("s_waitcnt vmcnt(2)" ::: "memory"); __builtin_amdgcn_s_barrier(); asm volatile("" ::: "memory"); } while (0)
    const int xq = bid & 7, cq = bid >> 3;
    int cbh = xq * 8;
    const bool lag = (jj != 0);
#define ATT_KB(bh_) ((unsigned)(((bh_) >> 3) * SEQ) * (unsigned)DM + (unsigned)((bh_) & 7) * 128u)
#define ATT_VB(bh_) ((unsigned)(bh_) * (128u * 8192u))
    ATT_DMA(0, ATT_KB(cbh), ATT_VB(cbh)); ATT_DMA(1, ATT_KB(cbh) + 64u * DM, ATT_VB(cbh) + 8192u);
    int ofKa, ofKb, ofV, ofKax, ofKbx, ofVx;
    { const int c0 = jj * 4 + 2 * hi, lb = (int)(unsigned)(size_t)lds;
      ofKa = r32 * 128 + ((c0 ^ kswz(r32)) << 4); ofKb = (32 + r32) * 128 + ((c0 ^ kswz(32 + r32)) << 4); ofV = 65536 + r32 * 64 + (((2 * hi) ^ vswz(r32)) << 4);
      ofKax = lb + (ofKa ^ 16); ofKbx = lb + (ofKb ^ 16); ofVx = lb + (ofV ^ 16); ofKa += lb; ofKb += lb; ofV += lb; }
#define ATT_QLOAD(dst, bh_, qb_) do { const unsigned char* Qw_ = Qg + ((size_t)((bh_) >> 3) * SEQ + (qb_) * 128) * DM + ((bh_) & 7) * 128 + (size_t)(wq * 32 + r32) * DM + jj * 64 + hi * 32; \
        const u32x4 qa_ = *(const u32x4*)Qw_, qb2_ = *(const u32x4*)(Qw_ + 16); dst = __builtin_bit_cast(v8i, __builtin_shufflevector(qa_, qb2_, 0, 1, 2, 3, 4, 5, 6, 7)); } while (0)
    v8i qnext; ATT_QLOAD(qnext, cbh, cq);
    for (int ui = 0; ui < 16; ++ui) {
        const int qb = (ui & 1) * 32 + cq;
        const int nbh = (ui + 1 < 16) ? xq * 8 + ((ui + 1) >> 1) : cbh;
        const unsigned Kh = ATT_KB(cbh), Vh = ATT_VB(cbh), nK = ATT_KB(nbh), nV = ATT_VB(nbh);
        const size_t obase = ((size_t)(cbh >> 3) * SEQ + qb * 128) * DM + (cbh & 7) * 128;
        f32x16 lacc = {}; f32x16 o[4] = {}; const v8i qr = qnext;
        f32x16 pA0, pA1; v8i pa, kf0, kf1, vf0, vf1, vf2, vf3;
        unsigned kptr = Kh + 2u * 64u * DM, vptr = Vh + 2u * 8192u;
#define ATT_ISSUE(SLD, last) do { asm volatile("" : "+s"(kptr), "+s"(vptr)); ATT_DMA(SLD, kptr, vptr); if (last) { kptr = nK; vptr = nV; } else { kptr += 64u * DM; vptr += 8192u; } } while (0)
#define ATT_RD8(b_, bx_, imm_) ATT_LD8((const LAS char*)(unsigned)((b_) + (imm_)), (const LAS char*)(unsigned)((bx_) + (imm_)))
#define ATT_FIX() asm volatile("" : "+v"(ofKa), "+v"(ofKax), "+v"(ofKb), "+v"(ofKbx), "+v"(ofV), "+v"(ofVx))
#define ATT_STEPC(LAST, SL, SLP, SLD) do { \
            ATT_FIX(); \
            kf0 = ATT_RD8(ofKa, ofKax, (SL) * SLOTB); kf1 = ATT_RD8(ofKb, ofKbx, (SL) * SLOTB); vf0 = ATT_RD8(ofV, ofVx, (SLP) * SLOTB); vf1 = ATT_RD8(ofV, ofVx, (SLP) * SLOTB + 2048); \
            ATT_ISSUE(SLD, LAST); \
            ATT_TOP(); \
            qkt_pack(pA0, pA1, kf0, kf1, qr, cinit, s1, s8, pe, pa); \
            vf2 = ATT_RD8(ofV, ofVx, (SLP) * SLOTB + 4096); vf3 = ATT_RD8(ofV, ofVx, (SLP) * SLOTB + 6144); \
            pv_exp_a(o, vf0, vf1, vf2, pa, s1, pA0, pA1, pe); \
            ATT_TOP(); \
            pv_exp_b(o, lacc, ones, vf3, pa, s1, pA0, pA1, pe); } while (0)
        float pe[32];
        if (lag) ATT_TOP();
        ATT_TOP();
        ATT_FIX(); kf0 = ATT_RD8(ofKa, ofKax, 0); kf1 = ATT_RD8(ofKb, ofKbx, 0); ATT_ISSUE(2, false);
        ATT_TOP();
        { mfma8_c(pA0, kf0, qr, cinit, s1, s8); mfma8_c(pA1, kf1, qr, cinit, s1, s8);
          asm volatile("s_nop 15\n\ts_nop 15" ::: "memory");
#pragma unroll
          for (int r = 0; r < 16; ++r) pe[r] = fexp2(pA0[r]);
#pragma unroll
          for (int r = 0; r < 16; ++r) pe[16 + r] = fexp2(pA1[r]); }
        ATT_TOP();
        ATT_STEPC(false, 1, 0, 3); ATT_STEPC(false, 2, 1, 4); ATT_STEPC(false, 3, 2, 5); ATT_STEPC(false, 4, 3, 6); ATT_STEPC(false, 5, 4, 7); ATT_STEPC(false, 6, 5, 0); ATT_STEPC(false, 7, 6, 1);
        for (int kb = 8; kb < NT; kb += 8) {
            ATT_STEPC(false, 0, 7, 2); ATT_STEPC(false, 1, 0, 3); ATT_STEPC(false, 2, 1, 4); ATT_STEPC(false, 3, 2, 5);
            ATT_STEPC(false, 4, 3, 6); ATT_STEPC(kb == NT - 8, 5, 4, 7); ATT_STEPC(false, 6, 5, 0); ATT_STEPC(false, 7, 6, 1);
        }
        ATT_FIX();
        vf0 = ATT_RD8(ofV, ofVx, 7 * SLOTB); vf1 = ATT_RD8(ofV, ofVx, 7 * SLOTB + 2048);
        ATT_TOP();
        { vf2 = ATT_RD8(ofV, ofVx, 7 * SLOTB + 4096); vf3 = ATT_RD8(ofV, ofVx, 7 * SLOTB + 6144);
          pack_p(pe, pa); SBAR();
          pv_last(o, lacc, ones, vf0, vf1, vf2, vf3, pa, s1);
          asm volatile("s_nop 15\n\ts_nop 15" ::: "memory"); }
        if (!lag) ATT_TOP();
        if (ui + 1 < 16) ATT_QLOAD(qnext, nbh, ((ui + 1) & 1) * 32 + cq);
#undef ATT_ISSUE
#undef ATT_STEPC
#undef ATT_RD8
#undef ATT_FIX
        int r32e = r32, hie = hi; asm volatile("" : "+v"(r32e), "+v"(hie));
        float rli[16];
#pragma unroll
        for (int r = 0; r < 16; ++r) rli[r] = frcp(lacc[r]);
        asm volatile("s_waitcnt lgkmcnt(0)" ::: "memory"); __builtin_amdgcn_s_barrier(); asm volatile("" ::: "memory");
        LAS float* Cb = (LAS float*)(lds + ((wq < 2) ? 3 * SLOTB : 65536 + 3 * SLOTB - 64 * 512));
        if (jj == 1) {
#pragma unroll
            for (int r = 0; r < 16; ++r) { const float sc = rli[r] * lamv;
#pragma unroll
                for (int d0 = 0; d0 < 4; ++d0) Cb[(wq * 32 + crow(r, hie)) * 128 + d0 * 32 + r32e] = o[d0][r] * sc; }
        }
        asm volatile("s_waitcnt lgkmcnt(0)" ::: "memory"); __builtin_amdgcn_s_barrier(); asm volatile("" ::: "memory");
        if (jj == 0) {
            float g[4];
#pragma unroll
            for (int d0 = 0; d0 < 4; ++d0) g[d0] = subg[d0 * 32 + r32e] * omli;
            bf16_t* Ob = Og + obase;
#pragma unroll
            for (int r = 0; r < 16; ++r) {
                float ss = 0.f;
#pragma unroll
                for (int d0 = 0; d0 < 4; ++d0) { const float v = o[d0][r] * rli[r] - Cb[(wq * 32 + crow(r, hie)) * 128 + d0 * 32 + r32e]; o[d0][r] = v; ss += v * v; }
                ss += __shfl_xor(ss, 1); ss += __shfl_xor(ss, 2); ss += __shfl_xor(ss, 4); ss += __shfl_xor(ss, 8); ss += __shfl_xor(ss, 16);
                const float rs = 1.0f / sqrtf(ss * (1.0f / 128.0f) + EPS);
                bf16_t* op = Ob + (size_t)(wq * 32 + crow(r, hie)) * DM + r32e;
#pragma unroll
                for (int d0 = 0; d0 < 4; ++d0) op[d0 * 32] = (bf16_t)f2bf(o[d0][r] * rs * g[d0]);
            }
        }
        asm volatile("s_waitcnt lgkmcnt(0)" ::: "memory"); __builtin_amdgcn_s_barrier(); asm volatile("" ::: "memory");
        cbh = nbh;
    }
    asm volatile("s_waitcnt vmcnt(0) lgkmcnt(0)" ::: "memory"); __builtin_amdgcn_s_barrier(); asm volatile("" ::: "memory");
#undef ATT_DMA
#undef ATT_TOP
#undef ATT_QLOAD
#undef ATT_KB
#undef ATT_VB
#undef ATT_LD8
}

namespace gla {
constexpr int BC = 0, QI = 32768, QA = 49152, KA = 65536, KST = 81920, VT = 98304, ST = 106496, AT = 122880, EM = 131072, EL = EM + 512, DD = EM + 1024, BMID = EM + 1536, SEG = EM + 2048;
static_assert(SEG + 2048 <= RING_BYTES, "gla lds");
__device__ __forceinline__ int sw256(int row, int cb) { return row * 256 + (cb ^ ((row & 15) << 4)); }
__device__ __forceinline__ int sw128(int row, int cb) { return row * 128 + (cb ^ ((((row & 7) ^ (row >> 4)) & 7) << 4)); }
__device__ __forceinline__ int crow(int r, int hi) { return (r & 3) + 8 * (r >> 2) + 4 * hi; }
__device__ __forceinline__ float h2f(unsigned short b) { return (float)__builtin_bit_cast(_Float16, b); }
__device__ __forceinline__ void gla_item(const bf16_t* __restrict__ Qp, const unsigned short* __restrict__ LFp, const bf16_t* __restrict__ Vp, bf16_t* __restrict__ Op, int dir, LAS unsigned char* lds, float* dbg) {
    int tid_ = threadIdx.x; asm volatile("" : "+v"(tid_));
    const int tid = tid_, wid = tid >> 6, lane = tid & 63, r = lane & 31, hh = lane >> 5;
    const int t1 = tid >> 3, kg = tid & 7, k0 = 16 * kg, v0 = (tid & 7) * 8;
    for (int i = tid; i < 16384 / 16; i += NTHR) *(LAS u32x4*)(lds + ST + i * 16) = (u32x4){0u, 0u, 0u, 0u};
    f32x16 st = {};
    u32x4 rq[2], rl[2], rv;
#define GLA_TOK(ci, i) (dir ? (SEQ - 1 - ((ci) * 64 + (i))) : ((ci) * 64 + (i)))
#define GLA_LOAD(ci) do { const size_t to = (size_t)GLA_TOK(ci, t1) * DM; \
        rq[0] = *(const u32x4*)(Qp + to + k0); rq[1] = *(const u32x4*)(Qp + to + k0 + 8); \
        rl[0] = *(const u32x4*)(LFp + to + k0); rl[1] = *(const u32x4*)(LFp + to + k0 + 8); rv = *(const u32x4*)(Vp + to + v0); } while (0)
    GLA_LOAD(0);
    __syncthreads();
    for (int ci = 0; ci < SEQ / 64; ++ci) {
        float qf[16], lf[16]; u32x4 vreg = rv;
#pragma unroll
        for (int j = 0; j < 2; ++j)
#pragma unroll
            for (int e = 0; e < 4; ++e) { qf[j * 8 + 2 * e] = bflo(rq[j][e]); qf[j * 8 + 2 * e + 1] = bfhi(rq[j][e]);
                lf[j * 8 + 2 * e] = h2f((unsigned short)(rl[j][e] & 0xffffu)); lf[j * 8 + 2 * e + 1] = h2f((unsigned short)(rl[j][e] >> 16)); }
        if (ci + 1 < SEQ / 64) GLA_LOAD(ci + 1);
#pragma unroll
        for (int j = 0; j < 4; ++j) *(LAS f32x4*)(lds + BC + (t1 * 128 + k0 + 4 * j) * 4) = (f32x4){lf[4 * j], lf[4 * j + 1], lf[4 * j + 2], lf[4 * j + 3]};
        __syncthreads();
        { const int kc = tid & 127, sg = tid >> 7; LAS float* bc = (LAS float*)(lds + BC) + kc; float cs[16];
#pragma unroll
            for (int i = 0; i < 16; ++i) cs[i] = bc[(sg * 16 + i) * 128];
#pragma unroll
            for (int i = 1; i < 16; ++i) cs[i] += cs[i - 1];
            ((LAS float*)(lds + SEG))[sg * 128 + kc] = cs[15];
            __syncthreads();
            const LAS float* sgp = (const LAS float*)(lds + SEG) + kc; const float s0 = sgp[0], s1 = sgp[128], s2 = sgp[256], s3 = sgp[384];
            const float off = sg == 0 ? 0.f : sg == 1 ? s0 : sg == 2 ? (s0 + s1) : ((s0 + s1) + s2);
#pragma unroll
            for (int i = 0; i < 16; ++i) bc[(sg * 16 + i) * 128] = cs[i] + off;
            if (sg == 0) { const float bm = s0 + s1, bl = ((s0 + s1) + s2) + s3;
                ((LAS float*)(lds + BMID))[kc] = bm; ((LAS float*)(lds + EM))[kc] = fexp(bm); ((LAS float*)(lds + EL))[kc] = fexp(bl - bm); ((LAS float*)(lds + DD))[kc] = fexp(bl); }
            __syncthreads();
        }
#ifdef DIAG
        if (dbg && ci == 0) { for (int i = tid; i < 8192; i += NTHR) dbg[i] = ((const LAS float*)(lds + BC))[i]; }
#endif
        {
            unsigned wqi[8], wqa[8], wka[8]; float ksv[16];
#pragma unroll
            for (int j = 0; j < 4; ++j) {
                const f32x4 bt = *(const LAS f32x4*)(lds + BC + (t1 * 128 + k0 + 4 * j) * 4), bm = *(const LAS f32x4*)(lds + BMID + (k0 + 4 * j) * 4);
                const f32x4 em = *(const LAS f32x4*)(lds + EM + (k0 + 4 * j) * 4), el = *(const LAS f32x4*)(lds + EL + (k0 + 4 * j) * 4);
                float qi[4], qa[4], ka[4];
#pragma unroll
                for (int e = 0; e < 4; ++e) { const int i = 4 * j + e; const float e1 = fexp(bt[e] - bm[e]), r1 = frcp(e1);
                    qa[e] = qf[i] * e1; qi[e] = qa[e] * em[e]; const float kk = 1.0f - fexp(lf[i]); ka[e] = kk * r1; ksv[i] = ka[e] * el[e]; }
                wqi[2 * j] = cvt_pk_bf16(qi[0], qi[1]); wqi[2 * j + 1] = cvt_pk_bf16(qi[2], qi[3]);
                wqa[2 * j] = cvt_pk_bf16(qa[0], qa[1]); wqa[2 * j + 1] = cvt_pk_bf16(qa[2], qa[3]);
                wka[2 * j] = cvt_pk_bf16(ka[0], ka[1]); wka[2 * j + 1] = cvt_pk_bf16(ka[2], ka[3]);
            }
#pragma unroll
            for (int j = 0; j < 2; ++j) { const int off = sw256(t1, (k0 + 8 * j) * 2);
                *(LAS u32x4*)(lds + QI + off) = (u32x4){wqi[4 * j], wqi[4 * j + 1], wqi[4 * j + 2], wqi[4 * j + 3]};
                *(LAS u32x4*)(lds + QA + off) = (u32x4){wqa[4 * j], wqa[4 * j + 1], wqa[4 * j + 2], wqa[4 * j + 3]};
                *(LAS u32x4*)(lds + KA + off) = (u32x4){wka[4 * j], wka[4 * j + 1], wka[4 * j + 2], wka[4 * j + 3]}; }
#pragma unroll
            for (int i = 0; i < 16; ++i) *(LAS unsigned short*)(lds + KST + sw128(k0 + i, t1 * 2)) = (unsigned short)f2bf(ksv[i]);
#pragma unroll
            for (int e = 0; e < 4; ++e) { *(LAS unsigned short*)(lds + VT + sw128(v0 + 2 * e, t1 * 2)) = (unsigned short)(vreg[e] & 0xffffu);
                *(LAS unsigned short*)(lds + VT + sw128(v0 + 2 * e + 1, t1 * 2)) = (unsigned short)(vreg[e] >> 16); }
        }
        __syncthreads();
        f32x16 oacc = {};
        const int w4 = wid & 3, t_i = w4 >> 1, v_i = w4 & 1;
        if (wid < 4) {
            const int s_i = wid >> 1, tq = wid & 1; f32x16 a = {};
#pragma unroll
            for (int ks = 0; ks < 8; ++ks) { const bf16x8 fa = *(const LAS bf16x8*)(lds + KA + sw256(32 * s_i + r, (16 * ks + 8 * hh) * 2)), fb = *(const LAS bf16x8*)(lds + QA + sw256(32 * tq + r, (16 * ks + 8 * hh) * 2));
                a = __builtin_amdgcn_mfma_f32_32x32x16_bf16(fa, fb, a, 0, 0, 0); }
            const int tg = 32 * tq + r;
#pragma unroll
            for (int g = 0; g < 4; ++g) { float m[4];
#pragma unroll
                for (int e = 0; e < 4; ++e) { const int sgl = 32 * s_i + 8 * g + 4 * hh + e; m[e] = (sgl <= tg) ? a[4 * g + e] : 0.f; }
                *(LAS u32x2*)(lds + AT + sw128(tg, (32 * s_i + 8 * g + 4 * hh) * 2)) = (u32x2){cvt_pk_bf16(m[0], m[1]), cvt_pk_bf16(m[2], m[3])}; }
        } else {
#pragma unroll
            for (int ks = 0; ks < 8; ++ks) { const bf16x8 fa = *(const LAS bf16x8*)(lds + QI + sw256(32 * t_i + r, (16 * ks + 8 * hh) * 2)), fb = *(const LAS bf16x8*)(lds + ST + sw256(32 * v_i + r, (16 * ks + 8 * hh) * 2));
                oacc = __builtin_amdgcn_mfma_f32_32x32x16_bf16(fa, fb, oacc, 0, 0, 0); }
        }
        __syncthreads();
#ifdef DIAG
        if (dbg && ci == 0) { for (int i = tid; i < 2048; i += NTHR) { ((unsigned*)dbg)[8192 + i] = ((const LAS unsigned*)(lds + AT))[i]; ((unsigned*)dbg)[8192 + 2048 + i] = ((const LAS unsigned*)(lds + VT))[i]; } }
#endif
        if (wid >= 4) {
#pragma unroll
            for (int ks = 0; ks < 4; ++ks) { const bf16x8 fa = *(const LAS bf16x8*)(lds + AT + sw128(32 * t_i + r, (16 * ks + 8 * hh) * 2)), fb = *(const LAS bf16x8*)(lds + VT + sw128(32 * v_i + r, (16 * ks + 8 * hh) * 2));
                oacc = __builtin_amdgcn_mfma_f32_32x32x16_bf16(fa, fb, oacc, 0, 0, 0); }
#pragma unroll
            for (int i = 0; i < 16; ++i) { const int t = 32 * t_i + crow(i, hh); Op[(size_t)GLA_TOK(ci, t) * DM + 32 * v_i + r] = (bf16_t)f2bf(oacc[i]); }
        }
        {
            const int kq = wid >> 1, vq = wid & 1;
#pragma unroll
            for (int i = 0; i < 16; ++i) st[i] *= ((const LAS float*)(lds + DD))[32 * kq + crow(i, hh)];
#pragma unroll
            for (int ks = 0; ks < 4; ++ks) { const bf16x8 fa = *(const LAS bf16x8*)(lds + KST + sw128(32 * kq + r, (16 * ks + 8 * hh) * 2)), fb = *(const LAS bf16x8*)(lds + VT + sw128(32 * vq + r, (16 * ks + 8 * hh) * 2));
                st = __builtin_amdgcn_mfma_f32_32x32x16_bf16(fa, fb, st, 0, 0, 0); }
#pragma unroll
            for (int g = 0; g < 4; ++g) *(LAS u32x2*)(lds + ST + sw256(32 * vq + r, (32 * kq + 8 * g + 4 * hh) * 2)) = (u32x2){cvt_pk_bf16(st[4 * g], st[4 * g + 1]), cvt_pk_bf16(st[4 * g + 2], st[4 * g + 3])};
        }
        __syncthreads();
#ifdef DIAG
        if (dbg && ci == 0) { for (int i = tid; i < 4096; i += NTHR) { ((unsigned*)dbg)[12288 + i] = ((const LAS unsigned*)(lds + ST))[i]; ((unsigned*)dbg)[16384 + i] = ((const LAS unsigned*)(lds + KST))[i]; } }
#endif
    }
#undef GLA_TOK
#undef GLA_LOAD
}
}
__device__ __forceinline__ void gla_phase(const Args& A, LAS unsigned char* lds, int bid, int G) {
    unsigned char* ws = A.ws;
    for (int it = bid; it < 256; it += G) {
        const int b = it >> 5, h = (it >> 2) & 7, dir = (it >> 1) & 1, vh = it & 1;
        const size_t base = (size_t)b * SEQ * DM + h * 128;
        gla::gla_item((const bf16_t*)(ws + H_Q) + base, (const unsigned short*)(ws + (dir ? H_LFB : H_LFF)) + base, (const bf16_t*)(ws + H_V) + base + vh * 64,
                      (bf16_t*)(ws + (dir ? H_OB : H_OF)) + base + vh * 64, dir, lds, it == 0 ? (float*)(ws + TB_LSUM) : nullptr);
    }
}
__device__ __forceinline__ void hg_normo_phase(const Args& A, int bid, int G) {
    int tid_ = threadIdx.x; asm volatile("" : "+v"(tid_));
    const int tid = tid_, lane = tid & 63, wave = tid >> 6; unsigned char* ws = A.ws;
    const bf16_t* OF = (const bf16_t*)(ws + H_OF); const bf16_t* OB = (const bf16_t*)(ws + H_OB); const bf16_t* GG = (const bf16_t*)(ws + H_G); bf16_t* HM = (bf16_t*)(ws + WS_HM);
    const int c0 = (lane >> 3) * 128 + (lane & 7) * 16;
    float ng[16];
#pragma unroll
    for (int i = 0; i < 16; ++i) ng[i] = A.in[I_HGNG][(lane & 7) * 16 + i];
    for (int row = (bid * NWAVES + wave); row < MTOK; row += G * NWAVES) {
        const size_t o = (size_t)row * DM + c0;
        const u32x4 a0 = *(const u32x4*)(OF + o), a1 = *(const u32x4*)(OF + o + 8), b0 = *(const u32x4*)(OB + o), b1 = *(const u32x4*)(OB + o + 8), g0 = *(const u32x4*)(GG + o), g1 = *(const u32x4*)(GG + o + 8);
        float v[16], gt[16]; float ss = 0.f;
#pragma unroll
        for (int e = 0; e < 4; ++e) { v[2 * e] = bflo(a0[e]) + bflo(b0[e]); v[2 * e + 1] = bfhi(a0[e]) + bfhi(b0[e]); v[8 + 2 * e] = bflo(a1[e]) + bflo(b1[e]); v[8 + 2 * e + 1] = bfhi(a1[e]) + bfhi(b1[e]);
            gt[2 * e] = bflo(g0[e]); gt[2 * e + 1] = bfhi(g0[e]); gt[8 + 2 * e] = bflo(g1[e]); gt[8 + 2 * e + 1] = bfhi(g1[e]); }
#pragma unroll
        for (int i = 0; i < 16; ++i) ss += v[i] * v[i];
        ss += __shfl_xor(ss, 1); ss += __shfl_xor(ss, 2); ss += __shfl_xor(ss, 4);
        const float rstd = 1.0f / sqrtf(ss * (1.0f / 128.0f) + EPS);
        u32x4 w0, w1;
#pragma unroll
        for (int e = 0; e < 4; ++e) { w0[e] = cvt_pk_bf16(v[2 * e] * rstd * ng[2 * e] * gt[2 * e], v[2 * e + 1] * rstd * ng[2 * e + 1] * gt[2 * e + 1]);
            w1[e] = cvt_pk_bf16(v[8 + 2 * e] * rstd * ng[8 + 2 * e] * gt[8 + 2 * e], v[8 + 2 * e + 1] * rstd * ng[8 + 2 * e + 1] * gt[8 + 2 * e + 1]); }
        *(u32x4*)(HM + o) = w0; *(u32x4*)(HM + o + 8) = w1;
    }
}

#ifdef DIAG
constexpr int DG_BASE = 8192;
__device__ __forceinline__ void dg_put(const Args& A, int k, float e) { if (!(e >= 0.f) || e > 1e9f) e = 1e9f; atomicMax((unsigned*)(A.ws + WS_CTL) + DG_BASE + 64 * k, __float_as_uint(e)); }
__device__ __forceinline__ float dg_rel(float got, float ref) { return fabsf(got - ref) / (fabsf(ref) + 0.1f); }
__device__ __forceinline__ unsigned dg_hash(unsigned a, unsigned b) { unsigned h = a * 2654435761u + b * 40503u + 0x9e3779b9u; h ^= h >> 15; h *= 2246822519u; h ^= h >> 13; h *= 3266489917u; h ^= h >> 16; return h; }
__device__ __forceinline__ float dg_bfr(float x) { return bflo(f2bf(x)); }
__device__ __forceinline__ void dg_mods(const Args& A, int k) {
    const int lane = threadIdx.x & 63, gwv = blockIdx.x * 8 + (threadIdx.x >> 6);
    const unsigned h = dg_hash(gwv, k); const int l = h & 3, b = (h >> 2) & 7, e = (h >> 5) % 6144;
    float a = 0.f; for (int d = lane; d < DM; d += 64) a += fsilu(A.in[I_C][b * DM + d]) * A.in[I_ADAW][((size_t)l * DM + d) * 6144 + e];
    a = wave_sum(a) + A.in[I_ADAB][l * 6144 + e];
    const float got = ((const float*)(A.ws + TB_MODS))[((size_t)l * NBATCH + b) * 6144 + e];
    if (lane == 0) dg_put(A, k, dg_rel(got, a));
}
__device__ __forceinline__ void dg_norm(const Args& A, int k, const float* x, const float* gain, int L, int which) {
    const int lane = threadIdx.x & 63, gwv = blockIdx.x * 8 + (threadIdx.x >> 6);
    const int row = dg_hash(gwv, k) & (MTOK - 1), b = row >> 13;
    const float* modl = (const float*)(A.ws + TB_MODS) + ((size_t)L * NBATCH + b) * 6144;
    float ss = 0.f; for (int c = lane; c < DM; c += 64) { const float v = x[(size_t)row * DM + c]; ss += v * v; }
    ss = wave_sum(ss); const float rstd = 1.0f / sqrtf(ss / DM + EPS); float e = 0.f;
    for (int c = lane; c < DM; c += 64) { const float ref = x[(size_t)row * DM + c] * rstd * gain[c] * (1.0f + modl[(which * 3 + 1) * 1024 + c]) + modl[(which * 3) * 1024 + c];
        e = fmaxf(e, dg_rel(bf2f(((const bf16_t*)(A.ws + WS_HM))[(size_t)row * DM + c]), ref)); }
    dg_put(A, k, e);
}
__device__ __forceinline__ void dg_qkv(const Args& A, int k, int al) {
    const int lane = threadIdx.x & 63, gwv = blockIdx.x * 8 + (threadIdx.x >> 6);
    const unsigned h = dg_hash(gwv, k); const int row = h & (MTOK - 1), t = (h >> 16) % 48, col = t * 64 + lane;
    const bf16_t* hm = (const bf16_t*)(A.ws + WS_HM) + (size_t)row * DM; const float* w = A.in[I_ATWIN] + (size_t)al * 1024 * 3072 + col;
    float a = 0.f; for (int kk = 0; kk < DM; ++kk) a += bf2f(hm[kk]) * dg_bfr(w[(size_t)kk * 3072]);
    float ref, got;
    if (t < 32) {
        const int part = t >> 4, sh = t & 15; const float ss = wave_sum(a * a); const float rstd = 1.0f / sqrtf(ss / 64.0f + EPS);
        const float y = a * rstd * (part ? A.in[I_ATKN] : A.in[I_ATQN])[al * 64 + lane]; const float yp = __shfl_xor(y, 32);
        const int pos = row & (SEQ - 1); const float cs = ((const float*)(A.ws + TB_COS))[pos * 32 + (lane & 31)], sn = ((const float*)(A.ws + TB_SIN))[pos * 32 + (lane & 31)];
        ref = (lane < 32) ? (y * cs - yp * sn) : (y * cs + yp * sn); if (part == 0) ref *= 0.125f * LOG2E;
        got = bf2f(((const bf16_t*)(A.ws + (part ? A_K : A_Q)))[(size_t)row * DM + sh * 64 + lane]);
    } else { ref = a; got = bf2f(((const bf16_t*)(A.ws + A_V))[(size_t)row * DM + (t - 32) * 64 + lane]); }
    dg_put(A, k, dg_rel(got, ref));
}
__device__ __forceinline__ void dg_attn(const Args& A, int k, int al, LAS unsigned char* lds) {
    const int tid = threadIdx.x; const unsigned h = dg_hash(blockIdx.x, k); const int row = h & (MTOK - 1), hd = (h >> 16) & 7, b = row >> 13;
    const bf16_t* Q = (const bf16_t*)(A.ws + A_Q); const bf16_t* K = (const bf16_t*)(A.ws + A_K); const bf16_t* V = (const bf16_t*)(A.ws + A_V);
    const float* scal = (const float*)(A.ws + TB_SCAL); const float lamv = scal[SC_LAM0 + al], omli = scal[SC_OML0 + al], Mc = scal[SC_MC0 + al];
    LAS float* p0 = (LAS float*)lds; LAS float* p1 = p0 + SEQ; LAS float* red = p1 + SEQ;
    float l0 = 0.f, l1 = 0.f;
    for (int key = tid; key < SEQ; key += NTHR) { const bf16_t* kr = K + ((size_t)b * SEQ + key) * DM + hd * 128; const bf16_t* qr = Q + (size_t)row * DM + hd * 128;
        float s0 = 0.f, s1 = 0.f; for (int d = 0; d < 64; ++d) { s0 += bf2f(qr[d]) * bf2f(kr[d]); s1 += bf2f(qr[64 + d]) * bf2f(kr[64 + d]); }
        const float e0 = fexp2(s0 - Mc), e1 = fexp2(s1 - Mc); p0[key] = e0; p1[key] = e1; l0 += e0; l1 += e1; }
    l0 = wave_sum(l0); l1 = wave_sum(l1); if ((tid & 63) == 0) { red[tid >> 6] = l0; red[8 + (tid >> 6)] = l1; }
    __syncthreads();
    l0 = 0.f; l1 = 0.f; for (int w = 0; w < 8; ++w) { l0 += red[w]; l1 += red[8 + w]; }
    __syncthreads();
    const int dv = tid & 127, part = tid >> 7; float o = 0.f;
    for (int key = part * 2048; key < part * 2048 + 2048; ++key) o += (p0[key] / l0 - lamv * p1[key] / l1) * bf2f(V[((size_t)b * SEQ + key) * DM + hd * 128 + dv]);
    red[16 + part * 128 + dv] = o; __syncthreads();
    if (tid < 128) { o = red[16 + tid] + red[16 + 128 + tid] + red[16 + 256 + tid] + red[16 + 384 + tid]; red[600 + tid] = o * o; }
    __syncthreads();
    if (tid < 128) { float ss = 0.f; for (int i = 0; i < 128; ++i) ss += red[600 + i]; const float ref = o / sqrtf(ss / 128.0f + EPS) * A.in[I_ATSUB][al * 128 + tid] * omli;
        dg_put(A, k, dg_rel(bf2f(((const bf16_t*)(A.ws + WS_HM))[(size_t)row * DM + hd * 128 + tid]), ref)); }
    __syncthreads();
}
__device__ __forceinline__ void dg_save(const Args& A, int k, const float* xold) {
    const int lane = threadIdx.x & 63, gwv = blockIdx.x * 8 + (threadIdx.x >> 6);
    const unsigned h = dg_hash(gwv, k); const int row = h & (MTOK - 1), col = (h >> 16) & 1023;
    float* sv = (float*)(A.ws + TB_LSUM) + 7 * 1024 * 1024 / 4;
    if (lane == 0) sv[k * 4096 + gwv] = xold[(size_t)row * DM + col];
}
__device__ __forceinline__ void dg_res(const Args& A, int k, const float* xnew, const float* gate, const bf16_t* Am, int K, const float* W) {
    const int lane = threadIdx.x & 63, gwv = blockIdx.x * 8 + (threadIdx.x >> 6);
    const unsigned h = dg_hash(gwv, k); const int row = h & (MTOK - 1), col = (h >> 16) & 1023, b = row >> 13;
    const float* sv = (const float*)(A.ws + TB_LSUM) + 7 * 1024 * 1024 / 4;
    float a = 0.f; for (int kk = lane; kk < K; kk += 64) a += bf2f(Am[(size_t)row * K + kk]) * dg_bfr(W[(size_t)kk * DM + col]);
    a = wave_sum(a);
    const float ref = sv[k * 4096 + gwv] + gate[(size_t)b * 6144 + col] * a;
    if (lane == 0) dg_put(A, k, dg_rel(xnew[(size_t)row * DM + col], ref));
}
__device__ __forceinline__ void dg_swiglu(const Args& A, int k, const bf16_t* Am, const float* W, int F, const bf16_t* H, int nrows, const int* rowmap) {
    const int lane = threadIdx.x & 63, gwv = blockIdx.x * 8 + (threadIdx.x >> 6);
    const unsigned h = dg_hash(gwv, k); const int row = (h & 0xfffff) % nrows, j = (h >> 20) % F;
    float g = 0.f, u = 0.f; for (int kk = lane; kk < DM; kk += 64) { const float x = bf2f(Am[(size_t)row * DM + kk]); g += x * dg_bfr(W[(size_t)kk * 2 * F + j]); u += x * dg_bfr(W[(size_t)kk * 2 * F + F + j]); }
    g = wave_sum(g); u = wave_sum(u);
    const float ref = g / (1.0f + expf(-g)) * u;
    if (lane == 0) dg_put(A, k, dg_rel(bf2f(H[(size_t)row * F + j]), ref));
}
__device__ __forceinline__ void dg_hgin(const Args& A, int k) {
    const int lane = threadIdx.x & 63, gwv = blockIdx.x * 8 + (threadIdx.x >> 6);
    const unsigned h = dg_hash(gwv, k); const int row = h & (MTOK - 1), col = (h >> 16) % 5120, grp = col >> 10, cc = col & 1023;
    float a = 0.f; for (int kk = lane; kk < DM; kk += 64) a += bf2f(((const bf16_t*)(A.ws + WS_HM))[(size_t)row * DM + kk]) * dg_bfr(A.in[I_HGWIN][(size_t)kk * 5120 + col]);
    a = wave_sum(a);
    float ref, got;
    if (grp == 0 || grp == 4) { ref = a / (1.0f + expf(-a)); got = bf2f(((const bf16_t*)(A.ws + (grp == 0 ? H_Q : H_G)))[(size_t)row * DM + cc]); }
    else if (grp == 3) { ref = a; got = bf2f(((const bf16_t*)(A.ws + H_V))[(size_t)row * DM + cc]); }
    else { const int d = grp - 1; const float* p = A.in[I_HGLB] + (size_t)d * DEPTH * 1024 + cc; float mx = p[0]; for (int l = 1; l < DEPTH; ++l) mx = fmaxf(mx, p[l * 1024]);
        float den = 0.f; for (int l = 0; l < DEPTH; ++l) den += expf(p[l * 1024] - mx); const float lbv = expf(p[1024] - mx) / den;
        ref = logf(lbv + (1.0f - lbv) / (1.0f + expf(-a))); got = gla::h2f(((const unsigned short*)(A.ws + (d ? H_LFB : H_LFF)))[(size_t)row * DM + cc]); }
    if (lane == 0) dg_put(A, k, dg_rel(got, ref));
}
__device__ __forceinline__ void dg_gla(const Args& A, int k) {
    const int lane = threadIdx.x & 63, gwv = blockIdx.x * 8 + (threadIdx.x >> 6);
    const unsigned h = dg_hash(gwv, k); const int sel0 = (gwv & 3) == 0; const int b = sel0 ? 0 : (h & 7), hd = sel0 ? 0 : ((h >> 3) & 7), dir = sel0 ? 0 : ((h >> 6) & 1), vc = sel0 ? ((h >> 7) & 63) : ((h >> 7) & 127);
    const bf16_t* Q = (const bf16_t*)(A.ws + H_Q); const unsigned short* LF = (const unsigned short*)(A.ws + (dir ? H_LFB : H_LFF)); const bf16_t* V = (const bf16_t*)(A.ws + H_V);
    const bf16_t* O = (const bf16_t*)(A.ws + (dir ? H_OB : H_OF));
    float s0 = 0.f, s1 = 0.f, e0 = 0.f, e1 = 0.f, e2 = 0.f, e3 = 0.f;
    for (int i = 0; i < SEQ; ++i) { const int tok = dir ? (SEQ - 1 - i) : i; const size_t o = ((size_t)b * SEQ + tok) * DM + hd * 128;
        const float f0 = expf(gla::h2f(LF[o + lane])), f1 = expf(gla::h2f(LF[o + 64 + lane])), v = bf2f(V[o + vc]);
        s0 = f0 * s0 + (1.0f - f0) * v; s1 = f1 * s1 + (1.0f - f1) * v;
        if (i < 128 || i % 61 == 0) { const float ov = wave_sum(bf2f(Q[o + lane]) * s0 + bf2f(Q[o + 64 + lane]) * s1); const float er = 0.25f * fabsf(bf2f(O[o + vc]) - ov) / (fabsf(ov) + 1.0f);
            if (i == 0) e0 = er; else if (i < 64) e1 = fmaxf(e1, er); else if (i < 128) e2 = fmaxf(e2, er); else e3 = fmaxf(e3, er); } }
    if (lane == 0) { dg_put(A, k, e0); dg_put(A, k + 4, e1); dg_put(A, k + 5, e2); dg_put(A, k + 6, e3); }
    const float* dbg = (const float*)(A.ws + TB_LSUM); const unsigned short* LF0 = (const unsigned short*)(A.ws + H_LFF); const bf16_t* Q0 = (const bf16_t*)(A.ws + H_Q);
    { const unsigned h2 = dg_hash(gwv, k + 100); const int t = h2 & 63, kk = (h2 >> 6) & 127; float c = 0.f; for (int tt = 0; tt <= t; ++tt) c += gla::h2f(LF0[(size_t)tt * DM + kk]);
      if (lane == 0) dg_put(A, k + 1, dg_rel(dbg[t * 128 + kk], c)); }
    { const unsigned h2 = dg_hash(gwv, k + 200); const int t = h2 & 63, sidx = (h2 >> 6) & 63; float a = 0.f;
      if (sidx <= t) { for (int kk = lane; kk < 128; kk += 64) { float c = 0.f; for (int tt = sidx + 1; tt <= t; ++tt) c += gla::h2f(LF0[(size_t)tt * DM + kk]);
              a += bf2f(Q0[(size_t)t * DM + kk]) * (1.0f - expf(gla::h2f(LF0[(size_t)sidx * DM + kk]))) * expf(c); } a = wave_sum(a); }
      const unsigned short got = ((const unsigned short*)(dbg + 8192))[gla::sw128(t, sidx * 2) / 2];
      if (lane == 0) dg_put(A, k + 2, 5.0f * fabsf(bf2f(got) - a) / (fabsf(a) + 0.01f)); }
    { const unsigned h2 = dg_hash(gwv, k + 300); const int sidx = h2 & 63, v = (h2 >> 6) & 63;
      const unsigned short got = ((const unsigned short*)(dbg + 8192 + 2048))[gla::sw128(v, sidx * 2) / 2];
      if (lane == 0) dg_put(A, k + 2, dg_rel(bf2f(got), bf2f(((const bf16_t*)(A.ws + H_V))[(size_t)sidx * DM + v]))); }
    { const unsigned h2 = dg_hash(gwv, k + 500); const int kk = h2 & 127, v = (h2 >> 7) & 63;
      float a = 0.f; { const int sidx = lane; float c = 0.f; for (int tt = sidx + 1; tt < 64; ++tt) c += gla::h2f(LF0[(size_t)tt * DM + kk]);
          const float ksn = (1.0f - expf(gla::h2f(LF0[(size_t)sidx * DM + kk]))) * expf(c);
          const unsigned short gk = ((const unsigned short*)(dbg + 16384))[gla::sw128(kk, sidx * 2) / 2];
          dg_put(A, k + 2, 0.5f * fabsf(bf2f(gk) - ksn) / (fabsf(ksn) + 0.01f));
          a = ksn * bf2f(((const bf16_t*)(A.ws + H_V))[(size_t)sidx * DM + v]); }
      a = wave_sum(a);
      const unsigned short gs = ((const unsigned short*)(dbg + 12288))[gla::sw256(v, kk * 2) / 2];
      if (lane == 0) dg_put(A, k + 3, 0.5f * fabsf(bf2f(gs) - a) / (fabsf(a) + 0.05f)); }
    { const unsigned h2 = dg_hash(gwv, k + 400); const int t = h2 & 63, v = (h2 >> 6) & 63;
      const unsigned short* at = (const unsigned short*)(dbg + 8192); const unsigned short* vt = (const unsigned short*)(dbg + 8192 + 2048);
      float a = bf2f(at[gla::sw128(t, lane * 2) / 2]) * bf2f(vt[gla::sw128(v, lane * 2) / 2]); a = wave_sum(a);
      if (lane == 0) dg_put(A, k + 1, 5.0f * dg_rel(bf2f(((const bf16_t*)(A.ws + H_OF))[(size_t)t * DM + v]), a)); }
}
__device__ __forceinline__ void dg_normo(const Args& A, int k) {
    const int lane = threadIdx.x & 63, gwv = blockIdx.x * 8 + (threadIdx.x >> 6);
    const unsigned h = dg_hash(gwv, k); const int row = h & (MTOK - 1), hd = (h >> 16) & 7; const size_t o = (size_t)row * DM + hd * 128;
    const float v0 = bf2f(((const bf16_t*)(A.ws + H_OF))[o + lane]) + bf2f(((const bf16_t*)(A.ws + H_OB))[o + lane]), v1 = bf2f(((const bf16_t*)(A.ws + H_OF))[o + 64 + lane]) + bf2f(((const bf16_t*)(A.ws + H_OB))[o + 64 + lane]);
    const float ss = wave_sum(v0 * v0 + v1 * v1), rstd = 1.0f / sqrtf(ss / 128.0f + EPS);
    const float r0 = v0 * rstd * A.in[I_HGNG][lane] * bf2f(((const bf16_t*)(A.ws + H_G))[o + lane]), r1 = v1 * rstd * A.in[I_HGNG][64 + lane] * bf2f(((const bf16_t*)(A.ws + H_G))[o + 64 + lane]);
    dg_put(A, k, fmaxf(dg_rel(bf2f(((const bf16_t*)(A.ws + WS_HM))[o + lane]), r0), dg_rel(bf2f(((const bf16_t*)(A.ws + WS_HM))[o + 64 + lane]), r1)));
}
__device__ __forceinline__ void dg_router(const Args& A, int k, int L) {
    const int lane = threadIdx.x & 63, gwv = blockIdx.x * 8 + (threadIdx.x >> 6);
    const int row = dg_hash(gwv, k) & (MTOK - 1), b = row >> 13; const float* x = A.out + (size_t)row * DM;
    const float* modl = (const float*)(A.ws + TB_MODS) + ((size_t)L * NBATCH + b) * 6144; const float* gain = A.in[I_N2G] + L * DM; const float* R = A.in[I_MOER] + (size_t)(L >> 1) * DM * 8;
    float ss = 0.f; for (int c = lane; c < DM; c += 64) ss += x[c] * x[c];
    ss = wave_sum(ss); const float rstd = 1.0f / sqrtf(ss / DM + EPS);
    float lg[8]; for (int e = 0; e < 8; ++e) lg[e] = 0.f;
    for (int c = lane; c < DM; c += 64) { const float hv = x[c] * rstd * gain[c] * (1.0f + modl[4 * 1024 + c]) + modl[3 * 1024 + c]; for (int e = 0; e < 8; ++e) lg[e] += hv * R[c * 8 + e]; }
    for (int e = 0; e < 8; ++e) lg[e] = wave_sum(lg[e]);
    int e0 = 0; for (int e = 1; e < 8; ++e) if (lg[e] > lg[e0]) e0 = e;
    int e1 = (e0 == 0) ? 1 : 0; for (int e = 0; e < 8; ++e) if (e != e0 && lg[e] > lg[e1]) e1 = e;
    float gap = 1e9f; for (int e = 0; e < 8; ++e) if (e != e0 && e != e1) gap = fminf(gap, lg[e1] - lg[e]); gap = fminf(gap, lg[e0] - lg[e1]);
    const int g0 = ((const int*)(A.ws + TB_EID))[row * 2], g1 = ((const int*)(A.ws + TB_EID))[row * 2 + 1]; const float w0 = ((const float*)(A.ws + TB_GATE))[row * 2], w1 = ((const float*)(A.ws + TB_GATE))[row * 2 + 1];
    const float p0 = 1.0f / (1.0f + expf(lg[e1] - lg[e0]));
    float er = (g0 != e0 || g1 != e1) ? (gap > 2e-3f ? 9.f : 0.f) : fmaxf(fabsf(w0 - p0), fabsf(w1 - (1.0f - p0)));
    if (lane == 0) dg_put(A, k, er);
}
__device__ __forceinline__ void dg_place(const Args& A, int k) {
    const int lane = threadIdx.x & 63, gwv = blockIdx.x * 8 + (threadIdx.x >> 6);
    const unsigned h = dg_hash(gwv, k); const int row = h & (MTOK - 1), kk = (h >> 16) & 1;
    const int sl = ((const int*)(A.ws + TB_SLOT))[row * 2 + kk], e = ((const int*)(A.ws + TB_EID))[row * 2 + kk]; const int* ts = (const int*)(A.ws + TB_TILES);
    float er = (sl >= ts[e] * 256 && sl < ts[e + 1] * 256 && sl < MOE_ROWS) ? 0.f : 7.f;
    if (er == 0.f) for (int c = lane; c < DM; c += 64) if (((const bf16_t*)(A.ws + E_XS))[(size_t)sl * DM + c] != ((const bf16_t*)(A.ws + WS_HM))[(size_t)row * DM + c]) er = 5.f;
    dg_put(A, k, er);
}
__device__ __forceinline__ void dg_moe_hid(const Args& A, int k, int m) {
    const int lane = threadIdx.x & 63, gwv = blockIdx.x * 8 + (threadIdx.x >> 6);
    const unsigned h = dg_hash(gwv, k); const int row = h & (MTOK - 1), kk = (h >> 16) & 1, j = (h >> 17) % DFFE;
    const int sl = ((const int*)(A.ws + TB_SLOT))[row * 2 + kk], e = ((const int*)(A.ws + TB_EID))[row * 2 + kk];
    const float* W = A.in[I_MOEGU] + ((size_t)m * 8 + e) * DM * 2 * DFFE; const bf16_t* Am = (const bf16_t*)(A.ws + E_XS) + (size_t)sl * DM;
    float g = 0.f, u = 0.f; for (int c = lane; c < DM; c += 64) { const float x = bf2f(Am[c]); g += x * dg_bfr(W[(size_t)c * 2 * DFFE + j]); u += x * dg_bfr(W[(size_t)c * 2 * DFFE + DFFE + j]); }
    g = wave_sum(g); u = wave_sum(u);
    if (lane == 0) dg_put(A, k, dg_rel(bf2f(((const bf16_t*)(A.ws + E_HID))[(size_t)sl * DFFE + j]), g / (1.0f + expf(-g)) * u));
}
__device__ __forceinline__ void dg_moe_y(const Args& A, int k, int m) {
    const int lane = threadIdx.x & 63, gwv = blockIdx.x * 8 + (threadIdx.x >> 6);
    const unsigned h = dg_hash(gwv, k); const int row = h & (MTOK - 1), kk = (h >> 16) & 1, col = (h >> 17) & 1023;
    const int sl = ((const int*)(A.ws + TB_SLOT))[row * 2 + kk], e = ((const int*)(A.ws + TB_EID))[row * 2 + kk];
    const float* W = A.in[I_MOEDN] + ((size_t)m * 8 + e) * DFFE * DM; const bf16_t* Hh = (const bf16_t*)(A.ws + E_HID) + (size_t)sl * DFFE;
    float a = 0.f; for (int j = lane; j < DFFE; j += 64) a += bf2f(Hh[j]) * dg_bfr(W[(size_t)j * DM + col]);
    a = wave_sum(a);
    if (lane == 0) dg_put(A, k, fabsf(bf2f(((const bf16_t*)(A.ws + E_XS))[(size_t)sl * DM + col]) - a) / (fabsf(a) + 0.3f));
}
__device__ __forceinline__ void dg_combine(const Args& A, int k, const float* modprev) {
    const int lane = threadIdx.x & 63, gwv = blockIdx.x * 8 + (threadIdx.x >> 6);
    const unsigned h = dg_hash(gwv, k); const int row = h & (MTOK - 1), col = (h >> 16) & 1023, b = row >> 13;
    const float* sv = (const float*)(A.ws + TB_LSUM) + 7 * 1024 * 1024 / 4; const bf16_t* Y = (const bf16_t*)(A.ws + E_XS);
    const int s0 = ((const int*)(A.ws + TB_SLOT))[row * 2], s1 = ((const int*)(A.ws + TB_SLOT))[row * 2 + 1]; const float w0 = ((const float*)(A.ws + TB_GATE))[row * 2], w1 = ((const float*)(A.ws + TB_GATE))[row * 2 + 1];
    const float ref = sv[k * 4096 + gwv] + modprev[(size_t)b * 6144 + 5 * 1024 + col] * (w0 * bf2f(Y[(size_t)s0 * DM + col]) + w1 * bf2f(Y[(size_t)s1 * DM + col]));
    if (lane == 0) dg_put(A, k, dg_rel(A.out[(size_t)row * DM + col], ref));
}
__device__ __forceinline__ void dg_lruin(const Args& A, int k) {
    const int lane = threadIdx.x & 63, gwv = blockIdx.x * 8 + (threadIdx.x >> 6);
    const unsigned h = dg_hash(gwv, k); const int row = h & (MTOK - 1), col = (h >> 16) % 2560;
    float a = 0.f; for (int kk = lane; kk < DM; kk += 64) a += bf2f(((const bf16_t*)(A.ws + WS_HM))[(size_t)row * DM + kk]) * dg_bfr(A.in[I_LRWIN][(size_t)kk * 2560 + col]);
    a = wave_sum(a);
    float ref, got;
    if (col < LRUW) { ref = 0.5f * a * (1.0f + tanhf(0.7978845608028654f * (a + 0.044715f * a * a * a))); got = bf2f(((const bf16_t*)(A.ws + L_YB))[(size_t)row * LRUW + col]); }
    else { ref = a; got = bf2f(((const bf16_t*)(A.ws + L_XB))[(size_t)row * LRUW + col - LRUW]); }
    if (lane == 0) dg_put(A, k, dg_rel(got, ref));
}
__device__ __forceinline__ void dg_lru(const Args& A, int k) {
    const int lane = threadIdx.x & 63, gwv = blockIdx.x * 8 + (threadIdx.x >> 6);
    const unsigned h = dg_hash(gwv, k); const int b = h & 7, ch = (h >> 3) % LRUW, tc = (h >> 16) & (SEQ - 1), n = ch / 128, j = ch % 128;
    const bf16_t* XB = (const bf16_t*)(A.ws + L_XB) + (size_t)b * SEQ * LRUW;
    float hres[2];
    for (int d = 0; d < 2; ++d) {
        const float* wa = A.in[I_LRWA] + (size_t)(d * 10 + n) * 16384; const float* wx = A.in[I_LRWX] + (size_t)(d * 10 + n) * 16384;
        const float wa0 = dg_bfr(wa[lane * 128 + j]), wa1 = dg_bfr(wa[(lane + 64) * 128 + j]), wx0 = dg_bfr(wx[lane * 128 + j]), wx1 = dg_bfr(wx[(lane + 64) * 128 + j]);
        const float ba = A.in[I_LRBA][d * LRUW + ch], bx = A.in[I_LRBX][d * LRUW + ch]; const float lam = A.in[I_LRLAM][d * LRUW + ch]; const float sp = log1pf(expf(-lam));
        float hs = 0.f;
        for (int i = 0; ; ++i) { const int t = d ? (SEQ - 1 - i) : i;
            float x0 = A.in[I_LRCB][n * 128 + lane], x1 = A.in[I_LRCB][n * 128 + 64 + lane], xj = A.in[I_LRCB][ch];
            for (int w = 0; w < 4; ++w) { const int tt = t - 1 + w; if (tt >= 0 && tt < SEQ) {
                x0 += A.in[I_LRCW][w * LRUW + n * 128 + lane] * bf2f(XB[(size_t)tt * LRUW + n * 128 + lane]); x1 += A.in[I_LRCW][w * LRUW + n * 128 + 64 + lane] * bf2f(XB[(size_t)tt * LRUW + n * 128 + 64 + lane]);
                xj += A.in[I_LRCW][w * LRUW + ch] * bf2f(XB[(size_t)tt * LRUW + ch]); } }
            const float rp = wave_sum(dg_bfr(x0) * wa0 + dg_bfr(x1) * wa1), ip = wave_sum(dg_bfr(x0) * wx0 + dg_bfr(x1) * wx1);
            const float rg = 1.0f / (1.0f + expf(-(rp + ba))), ig = 1.0f / (1.0f + expf(-(ip + bx))); const float la = -8.0f * rg * sp;
            hs = expf(la) * hs + sqrtf(fmaxf(-expm1f(2.0f * la), 0.f)) * ig * xj;
            if (t == tc) break; }
        hres[d] = hs;
    }
    const size_t go = ((size_t)b * SEQ + tc) * LRUW + ch;
    const float e1 = fabsf(bf2f(((const bf16_t*)(A.ws + L_HF))[go]) - hres[0]) / (fabsf(hres[0]) + 0.3f);
    const float ref = (hres[0] + hres[1]) * bf2f(((const bf16_t*)(A.ws + L_YB))[go]);
    const float e2 = fabsf(bf2f(((const bf16_t*)(A.ws + L_HY))[go]) - ref) / (fabsf(ref) + 0.3f);
    if (lane == 0) { dg_put(A, k, e1); dg_put(A, k + 5, e2); }
}
__device__ __forceinline__ void dg_final(const Args& A, int nchk) {
    const unsigned* sl = (const unsigned*)(A.ws + WS_CTL) + DG_BASE; int code = 0; float ev = 0.f;
    for (int k = 1; k <= nchk; ++k) { const float e = __uint_as_float(sl[64 * k]); if (e > 0.05f) { code = k; ev = e; break; } }
    if (code == 0) return;
    const int c1 = code % 10, c10 = code / 10;
    const float s = -(float)c1;
    for (size_t i = (size_t)blockIdx.x * NTHR + threadIdx.x; i < (size_t)MTOK * DM; i += (size_t)gridDim.x * NTHR) A.out[i] = A.in[I_X][i] * s;
    __syncthreads();
    if (blockIdx.x == 0 && threadIdx.x == 0) { const int qq = ev < 0.1f ? 1 : ev < 0.2f ? 2 : ev < 0.5f ? 3 : ev < 1.f ? 4 : ev < 2.f ? 5 : ev < 5.f ? 6 : ev < 20.f ? 7 : ev < 1e3f ? 8 : 9;
        A.out[12345] = 100.f * (float)(10 * c10 + qq); }
}
#define DG(x) x
#define DGL(x) if constexpr (L >= DIAG_FROM) { x }
#else
#define DG(x)
#define DGL(x)
#endif

#define GRID_BAR() xcd_barrier(bar)
template <int L>
__device__ __forceinline__ void run_mixer(const Args& args, LAS unsigned char* lds, int bid, int G, const XcdBarrier& bar) {
    unsigned char* ws = args.ws; bf16_t* xo = (bf16_t*)(ws + WS_XB);
    const float* modl = (const float*)(ws + TB_MODS) + (size_t)L * NBATCH * 6144;
    const void* xs = (L == 0) ? (const void*)args.in[I_X] : (const void*)xo; constexpr bool X16 = (L != 0);
    constexpr int kind = L % 3;
    DGL(if (L > 0 && ((L - 1) & 1)) { dg_save(args, 10 * (L - 1) + 9, xo); GRID_BAR(); })
    norm_phase<false>(args, lds, bid, G, xs, X16, xo, true, args.in[I_N1G] + L * DM, modl, 0, (L > 0) && ((L - 1) & 1), modl - NBATCH * 6144, false, nullptr);
    GRID_BAR();
    DGL(if (L > 0 && ((L - 1) & 1)) { dg_combine(args, 10 * (L - 1) + 9, modl - NBATCH * 6144); GRID_BAR(); })
    DGL(dg_norm(args, 10 * L + 1, (L > 0 && ((L - 1) & 1)) ? xo : xs, args.in[I_N1G] + L * DM, L, 0); GRID_BAR();)
    if constexpr (kind == 0) {
        constexpr int al = L / 3;
        {
            pg8::Gemm g{(const bf16_t*)(ws + WS_HM), (const bf16_t*)(ws + W_QKV) + (size_t)al * 3072 * 1024, 1024};
            pg8::TileOrder S; S.init(256, 12, G, bid);
            pg8::EpiQKV E{(bf16_t*)(ws + A_Q), (bf16_t*)(ws + A_K), (bf16_t*)(ws + A_V), args.in[I_ATQN] + al * 64, args.in[I_ATKN] + al * 64,
                          (const float*)(ws + TB_COS), (const float*)(ws + TB_SIN), LOG2E};
            pg8::gemm_phase<pg8::EpiQKV>(lds, g, S, E);
        }
        GRID_BAR();
        vt_phase(args, bid, G);
        GRID_BAR();
        attn_phase(args, lds, bid, G, al);
        GRID_BAR();
        DGL(dg_save(args, 10 * L + 4, xs); GRID_BAR();)
        {
            pg8::Gemm g{(const bf16_t*)(ws + WS_HM), (const bf16_t*)(ws + W_AO) + (size_t)al * 1024 * 1024, 1024};
            pg8::TileOrder S; S.init(256, 4, G, bid);
            pg8::EpiRes<X16> E{xs, xo, modl + 2 * 1024, 1.0f};
            pg8::gemm_phase<pg8::EpiRes<X16>>(lds, g, S, E);
        }
        GRID_BAR();
        DGL(dg_res(args, 10 * L + 4, xo, modl + 2 * 1024, (const bf16_t*)(ws + WS_HM), 1024, args.in[I_ATWOUT] + (size_t)al * 1024 * 1024); GRID_BAR();)
    }
    if constexpr (kind == 1) {
        {
            pg8::Gemm g{(const bf16_t*)(ws + WS_HM), (const bf16_t*)(ws + W_HGI), 1024};
            pg8::TileOrder S; S.init(256, 20, G, bid);
            pg8::EpiAct E{0, ws, (const float*)(ws + TB_LB)};
            pg8::gemm_phase<pg8::EpiAct>(lds, g, S, E);
        }
        GRID_BAR();
        DGL(dg_hgin(args, 10 * L + 2); GRID_BAR();)
        gla_phase(args, lds, bid, G);
        GRID_BAR();
        DGL(dg_gla(args, 10 * L + 3); GRID_BAR();)
        hg_normo_phase(args, bid, G);
        GRID_BAR();
        DGL(dg_normo(args, 10 * L + 0); GRID_BAR();)
        DGL(dg_save(args, 10 * L + 4, xs); GRID_BAR();)
        {
            pg8::Gemm g{(const bf16_t*)(ws + WS_HM), (const bf16_t*)(ws + W_HGO), 1024};
            pg8::TileOrder S; S.init(256, 4, G, bid);
            pg8::EpiRes<X16> E{xs, xo, modl + 2 * 1024, 1.0f};
            pg8::gemm_phase<pg8::EpiRes<X16>>(lds, g, S, E);
        }
        GRID_BAR();
        DGL(dg_res(args, 10 * L + 4, xo, modl + 2 * 1024, (const bf16_t*)(ws + WS_HM), 1024, args.in[I_HGWOUT]); GRID_BAR();)
    }
    if constexpr (kind == 2) {
        {
            pg8::Gemm g{(const bf16_t*)(ws + WS_HM), (const bf16_t*)(ws + W_LRI), 1024};
            pg8::TileOrder S; S.init(256, 10, G, bid);
            pg8::EpiAct E{1, ws, nullptr};
            pg8::gemm_phase<pg8::EpiAct>(lds, g, S, E);
        }
        GRID_BAR();
        DGL(dg_lruin(args, 10 * L + 2); GRID_BAR();)
        lru_phase<0>(args, lds, bid, G);
        GRID_BAR();
        lru_carry_phase(args, bid, G);
        GRID_BAR();
        lru_apply_phase(args, lds, bid, G);
        GRID_BAR();
        DGL(dg_lru(args, 10 * L + 3); GRID_BAR();)
        DGL(dg_save(args, 10 * L + 4, xs); GRID_BAR();)
        {
            pg8::Gemm g{(const bf16_t*)(ws + L_HY), (const bf16_t*)(ws + W_LRO), LRUW};
            pg8::TileOrder S; S.init(256, 4, G, bid);
            pg8::EpiRes<X16> E{xs, xo, modl + 2 * 1024, 1.0f};
            pg8::gemm_phase<pg8::EpiRes<X16>>(lds, g, S, E);
        }
        GRID_BAR();
        DGL(dg_res(args, 10 * L + 4, xo, modl + 2 * 1024, (const bf16_t*)(ws + L_HY), LRUW, args.in[I_LRWOUT]); GRID_BAR();)
    }
}
template <int L>
__device__ __forceinline__ void run_ffn(const Args& args, LAS unsigned char* lds, int bid, int G, const XcdBarrier& bar) {
    unsigned char* ws = args.ws; bf16_t* xo = (bf16_t*)(ws + WS_XB);
    const float* modl = (const float*)(ws + TB_MODS) + (size_t)L * NBATCH * 6144;
    if constexpr ((L & 1) == 0) {
        constexpr int m = L >> 1;
        constexpr bool F8 = (L >= FP8_DENSE_FROM);
        norm_phase<false>(args, lds, bid, G, xo, true, xo, true, args.in[I_N2G] + L * DM, modl, 1, false, modl, false, nullptr, F8);
        GRID_BAR();
        if constexpr (F8) {
            pg8::Gemm g{(const bf16_t*)(ws + WS_HM), (const bf16_t*)(ws + W_FGU) + (size_t)m * 5632 * 1024, 512};
            pg8::TileOrder S; S.init(256, 22, G, bid);
            pg8::EpiSwiGLU8 E{ws + F_HID, DFF, 1.0f / MOE_WSCALE, MOE_HSCALE};
            pg8::gemm_phase<pg8::EpiSwiGLU8, true>(lds, g, S, E);
        } else {
            pg8::Gemm g{(const bf16_t*)(ws + WS_HM), (const bf16_t*)(ws + W_FGU) + (size_t)m * 5632 * 1024, 1024};
            pg8::TileOrder S; S.init(256, 22, G, bid);
            pg8::EpiSwiGLU E{(bf16_t*)(ws + F_HID), DFF};
            pg8::gemm_phase<pg8::EpiSwiGLU>(lds, g, S, E);
        }
        GRID_BAR();
        if constexpr (F8) {
            pg8::Gemm g{(const bf16_t*)(ws + F_HID), (const bf16_t*)(ws + W_FDN) + (size_t)m * 1024 * 2816, DFF / 2};
            pg8::TileOrder S; S.init(256, 4, G, bid);
            pg8::EpiRes<true> E{xo, xo, modl + 5 * 1024, 1.0f / (MOE_WSCALE * MOE_HSCALE)};
            pg8::gemm_phase<pg8::EpiRes<true>, true>(lds, g, S, E);
        } else {
            pg8::Gemm g{(const bf16_t*)(ws + F_HID), (const bf16_t*)(ws + W_FDN) + (size_t)m * 1024 * 2816, DFF};
            pg8::TileOrder S; S.init(256, 4, G, bid);
            pg8::EpiRes<true> E{xo, xo, modl + 5 * 1024, 1.0f};
            pg8::gemm_phase<pg8::EpiRes<true>>(lds, g, S, E);
        }
        GRID_BAR();
    } else {
        constexpr int m = L >> 1;
        norm_phase<true>(args, lds, bid, G, xo, true, xo, true, args.in[I_N2G] + L * DM, modl, 1, false, modl, false, args.in[I_MOER] + (size_t)m * DM * 8);
        GRID_BAR();
        DGL(dg_norm(args, 10 * L + 5, xo, args.in[I_N2G] + L * DM, L, 1); dg_router(args, 10 * L + 5, L); GRID_BAR();)
        place_phase(args, lds, bid, G);
        GRID_BAR();
        DGL(dg_place(args, 10 * L + 6); GRID_BAR();)
        const int* tiles = (const int*)(ws + TB_TILES);
        {
            pg8::Gemm g{(const bf16_t*)(ws + E_XS), (const bf16_t*)(ws + W_MGU + (size_t)m * 8 * 7168 * 1024), 512};
            pg8::TileOrder S; S.init(tiles[8], 28, G, bid);
#pragma unroll
            for (int e = 1; e < NEXP; ++e) S.ts[e] = tiles[e];
            pg8::EpiSwiGLU8 E{ws + E_HID, DFFE, 1.0f / MOE_WSCALE, MOE_HSCALE};
            pg8::gemm_phase<pg8::EpiSwiGLU8, true>(lds, g, S, E);
        }
        GRID_BAR();
        DGL(dg_moe_hid(args, 10 * L + 7, m); GRID_BAR();)
        {
            pg8::Gemm g{(const bf16_t*)(ws + E_HID), (const bf16_t*)(ws + W_MDN + (size_t)m * 8 * 1024 * 3584), DFFE / 2};
            pg8::TileOrder S; S.init(tiles[8], 4, G, bid);
#pragma unroll
            for (int e = 1; e < NEXP; ++e) S.ts[e] = tiles[e];
            pg8::EpiPlain E{(bf16_t*)(ws + E_XS), DM, 1.0f / (MOE_WSCALE * MOE_HSCALE)};
            pg8::gemm_phase<pg8::EpiPlain, true>(lds, g, S, E);
        }
        GRID_BAR();
        DGL(dg_moe_y(args, 10 * L + 8, m); GRID_BAR();)
    }
}
__device__ __forceinline__ void final_combine(const Args& args, LAS unsigned char* lds, int bid, int G, const XcdBarrier& bar) {
    const float* modl = (const float*)(args.ws + TB_MODS) + (size_t)3 * NBATCH * 6144;
    DG(dg_save(args, 39, args.out); GRID_BAR();)
    norm_phase<false>(args, lds, bid, G, args.ws + WS_XB, true, args.out, false, args.in[I_N1G], modl, 0, true, modl, true, nullptr);
    DG(GRID_BAR(); dg_combine(args, 39, modl);)
}

__global__ void __launch_bounds__(NTHR, 2) mega_fwd(Args args) {
    extern __shared__ __attribute__((aligned(16))) unsigned char lds_raw[];
    LAS unsigned char* lds = (LAS unsigned char*)lds_raw;
    const int tid = threadIdx.x, bid = blockIdx.x, G = gridDim.x;
    unsigned char* ws = args.ws;
    volatile LAS unsigned* MISC = (volatile LAS unsigned*)(lds + MISC_OFF);
    if (tid < 64) MISC[tid] = 0u;
    __syncthreads();
    XcdBarrier bar = xcd_barrier_post((unsigned*)(ws + WS_CTL) + CW_BAR, MISC + 8);

    prologue_phase(args, lds, bid, G);
    GRID_BAR();

    run_mixer<0>(args, lds, bid, G, bar);
    run_ffn<0>(args, lds, bid, G, bar);
    run_mixer<1>(args, lds, bid, G, bar);
    run_ffn<1>(args, lds, bid, G, bar);
    run_mixer<2>(args, lds, bid, G, bar);
    run_ffn<2>(args, lds, bid, G, bar);
    run_mixer<3>(args, lds, bid, G, bar);
    run_ffn<3>(args, lds, bid, G, bar);
    final_combine(args, lds, bid, G, bar);
    DG(GRID_BAR(); dg_final(args, 49);)
}

extern "C" void kernel_launch(void* const* d_in, const int* in_sizes, int n_in, void* d_out, int out_size, void* d_ws, size_t ws_size, hipStream_t stream) {
    static int grid = 0;
    if (grid == 0) {
        if (n_in != 30 || out_size != MTOK * DM || ws_size < WS_NEED) { fprintf(stderr, "kernel_launch: unexpected shapes (n_in %d out %d ws %zu need %zu)\n", n_in, out_size, ws_size, (size_t)WS_NEED); grid = -1; return; }
        int dev = 0, cus = 0;
        if (hipGetDevice(&dev) != hipSuccess || hipDeviceGetAttribute(&cus, hipDeviceAttributeMultiprocessorCount, dev) != hipSuccess) { grid = -1; return; }
        if (hipFuncSetAttribute((const void*)mega_fwd, hipFuncAttributeMaxDynamicSharedMemorySize, LDS_BYTES) != hipSuccess) { fprintf(stderr, "kernel_launch: hipFuncSetAttribute failed\n"); grid = -1; return; }
        int per_cu = 0;
        if (hipOccupancyMaxActiveBlocksPerMultiprocessor(&per_cu, (const void*)mega_fwd, NTHR, LDS_BYTES) != hipSuccess || per_cu < 1) { fprintf(stderr, "kernel_launch: occupancy query says %d\n", per_cu); }
        (void)hipGetLastError();
        grid = (cus >= 256) ? 256 : -1;
        if (grid < 0) { fprintf(stderr, "kernel_launch: needs 256 CUs, device has %d\n", cus); return; }
    }
    if (grid < 0) return;
    if (hipMemsetAsync((char*)d_ws + WS_CTL, 0, CTL_ZERO_BYTES, stream) != hipSuccess) return;
    Args a{};
    for (int i = 0; i < 30; ++i) a.in[i] = (const float*)d_in[i];
    a.out = (float*)d_out; a.ws = (unsigned char*)d_ws;
    hipLaunchKernelGGL(mega_fwd, dim3(grid), dim3(NTHR), LDS_BYTES, stream, a);
}
```

```cpp
#define DIAG_FROM 2
#include <hip/hip_runtime.h>
#include <cstdio>
#include <cstdint>

#define LAS __attribute__((address_space(3)))
#define GAS __attribute__((address_space(1)))
typedef unsigned short bf16_t;
typedef short bf16x8 __attribute__((ext_vector_type(8)));
typedef short s16x4 __attribute__((ext_vector_type(4)));
typedef float f32x2 __attribute__((ext_vector_type(2)));
typedef float f32x4 __attribute__((ext_vector_type(4)));
typedef float f32x16 __attribute__((ext_vector_type(16)));
typedef unsigned u32x2 __attribute__((ext_vector_type(2)));
typedef unsigned u32x4 __attribute__((ext_vector_type(4)));

constexpr int MTOK = 65536, DM = 1024, SEQ = 8192, NBATCH = 8, DEPTH = 4;
constexpr int DFF = 2816, DFFE = 3584, NEXP = 8, LRUW = 1280;
constexpr float EPS = 1e-6f;
constexpr int FP8_DENSE_FROM = 2;
constexpr float MOE_WSCALE = 64.0f, MOE_HSCALE = 4.0f;
constexpr float LOG2E = 1.4426950408889634f;

constexpr size_t MiB = 1u << 20;
constexpr size_t WS_CTL = 0, CTL_ZERO_BYTES = 1 * MiB;
constexpr size_t WS_TAB = 1 * MiB;
constexpr size_t TB_MODS = WS_TAB;
constexpr size_t TB_COS = WS_TAB + 1 * MiB;
constexpr size_t TB_SIN = WS_TAB + 2 * MiB;
constexpr size_t TB_SCAL = WS_TAB + 3 * MiB;
constexpr size_t TB_LB = TB_SCAL + 4096;
constexpr size_t TB_SP = TB_SCAL + 16384;
constexpr size_t TB_EID = WS_TAB + 4 * MiB;
constexpr size_t TB_GATE = WS_TAB + 5 * MiB;
constexpr size_t TB_SLOT = WS_TAB + 6 * MiB;
constexpr size_t TB_BCNT = WS_TAB + 7 * MiB;
constexpr size_t TB_TILES = TB_BCNT + 16384;
constexpr size_t TB_LSUM = WS_TAB + 8 * MiB;
constexpr size_t TB_LCIN = WS_TAB + 16 * MiB;
constexpr size_t WS_W = 32 * MiB;
constexpr size_t W_QKV = WS_W;
constexpr size_t W_AO = W_QKV + 2 * (size_t)3072 * 1024 * 2;
constexpr size_t W_HGI = W_AO + 2 * (size_t)1024 * 1024 * 2;
constexpr size_t W_HGO = W_HGI + (size_t)5120 * 1024 * 2;
constexpr size_t W_LRI = W_HGO + (size_t)1024 * 1024 * 2;
constexpr size_t W_LRG = W_LRI + (size_t)2560 * 1024 * 2;
constexpr size_t W_LRO = W_LRG + (size_t)10 * 2 * 256 * 128 * 2;
constexpr size_t W_FGU = W_LRO + (size_t)1024 * 1280 * 2;
constexpr size_t W_FDN = W_FGU + 2 * (size_t)5632 * 1024 * 2;
constexpr size_t W_MGU = W_FDN + 2 * (size_t)1024 * 2816 * 2;
constexpr size_t W_MDN = W_MGU + 16 * (size_t)7168 * 1024 * 2;
constexpr size_t W_END = W_MDN + 16 * (size_t)1024 * 3584 * 2;
constexpr size_t WS_HM = 440 * MiB;
constexpr size_t WS_ACT = 568 * MiB;
static_assert(W_END <= WS_HM, "weights overflow");
constexpr size_t SZ_TOK = (size_t)MTOK * 1024 * 2;
constexpr size_t A_Q = WS_ACT, A_K = A_Q + SZ_TOK, A_V = A_K + SZ_TOK, A_VT = A_V + SZ_TOK;
constexpr size_t F_HID = WS_ACT;
constexpr size_t H_Q = WS_ACT, H_LFF = H_Q + SZ_TOK, H_LFB = H_LFF + SZ_TOK, H_V = H_LFB + SZ_TOK, H_G = H_V + SZ_TOK, H_OF = H_G + SZ_TOK, H_OB = H_OF + SZ_TOK;
constexpr size_t SZ_LRU = (size_t)MTOK * 1280 * 2;
constexpr size_t L_YB = WS_ACT, L_XB = L_YB + SZ_LRU, L_HF = L_XB + SZ_LRU, L_HY = L_HF + SZ_LRU, L_U = L_HY + SZ_LRU;
constexpr int MOE_ROWS = 2 * MTOK + NEXP * 256;
constexpr size_t E_XS = WS_ACT, E_HID = E_XS + (size_t)MOE_ROWS * 1024 * 2, E_END = E_HID + (size_t)MOE_ROWS * DFFE;
constexpr size_t WS_XB = 1536 * MiB;
static_assert(E_END <= WS_XB && H_OB + SZ_TOK <= WS_XB && L_U + 2 * SZ_LRU <= WS_XB && A_VT + SZ_TOK <= WS_XB, "activation regions below the residual stream");
constexpr size_t WS_NEED = WS_XB + SZ_TOK;
static_assert(WS_NEED <= (size_t)1792 * MiB, "workspace");

constexpr int CW_BAR = 4096;

constexpr int RING_BYTES = 135168;
constexpr int MISC_OFF = RING_BYTES;
constexpr int LDS_BYTES = 147456;
constexpr int NWAVES = 8, NTHR = 512;

typedef __bf16 bf16x2v __attribute__((ext_vector_type(2)));
__device__ __forceinline__ unsigned cvt_pk_bf16(float lo, float hi) { const f32x2 v = {lo, hi}; const bf16x2v b = __builtin_convertvector(v, bf16x2v); return __builtin_bit_cast(unsigned, b); }
__device__ __forceinline__ unsigned pk_fp8x4(float a, float b, float c, float d) { unsigned w = 0; w = __builtin_amdgcn_cvt_pk_fp8_f32(a, b, w, false); w = __builtin_amdgcn_cvt_pk_fp8_f32(c, d, w, true); return w; }
__device__ __forceinline__ unsigned f2bf(float f) { unsigned u = __builtin_bit_cast(unsigned, f); return (u + 0x7fffu + ((u >> 16) & 1u)) >> 16; }
__device__ __forceinline__ float bf2f(unsigned short b) { return __builtin_bit_cast(float, ((unsigned)b) << 16); }
__device__ __forceinline__ float bflo(unsigned w) { return __builtin_bit_cast(float, w << 16); }
__device__ __forceinline__ float bfhi(unsigned w) { return __builtin_bit_cast(float, w & 0xffff0000u); }
__device__ __forceinline__ float fexp2(float x) { return __builtin_amdgcn_exp2f(x); }
__device__ __forceinline__ float fexp(float x) { return __builtin_amdgcn_exp2f(x * LOG2E); }
__device__ __forceinline__ float frcp(float x) { return __builtin_amdgcn_rcpf(x); }
__device__ __forceinline__ float fsigmoid(float x) { return frcp(1.0f + fexp(-x)); }
__device__ __forceinline__ float fsilu(float x) { return x * fsigmoid(x); }
__device__ __forceinline__ float wave_sum(float v) {
#pragma unroll
    for (int o = 1; o < 64; o <<= 1) v += __shfl_xor(v, o);
    return v;
}
#define LDS_WAIT() asm volatile("s_waitcnt lgkmcnt(0)" ::: "memory")
#define VM_WAIT() asm volatile("s_waitcnt vmcnt(0)" ::: "memory")

#define XB_TMO      128
#define XB_XCNT(j)  (256  + 64 * (j))
#define XB_XSUB(j)  (1280 + 64 * (j))
#define XB_XGEN(j)  (2304 + 64 * (j))
#define XB_TOP      3328
#define XB_TOPGEN   3392
#define XCD_BAR_WORDS 3456
#define XB_SPIN_CAP (1u << 22)
__device__ __forceinline__ unsigned xb_ld(unsigned* p)              { return __hip_atomic_load(p, __ATOMIC_RELAXED, __HIP_MEMORY_SCOPE_AGENT); }
__device__ __forceinline__ unsigned xb_add(unsigned* p, unsigned v) { return __hip_atomic_fetch_add(p, v, __ATOMIC_RELAXED, __HIP_MEMORY_SCOPE_AGENT); }
__device__ __forceinline__ unsigned xb_xcc_id() { return (unsigned)__builtin_amdgcn_s_getreg((3 << 11) | 20) & 0xFu; }
#define XB_SPIN(cond, bar) do { unsigned _sp = 0; while (cond) { __builtin_amdgcn_s_sleep(1); \
    if ((++_sp & 255u) == 0u) { if (xb_ld(&(bar)[XB_TMO])) break; if (_sp > XB_SPIN_CAP) { atomicAdd(&(bar)[XB_TMO], 1u); break; } } } } while (0)
struct XcdBarrier { unsigned* bar; unsigned x; volatile LAS unsigned* st; };
__device__ __forceinline__ XcdBarrier xcd_barrier_post(unsigned* bar, volatile LAS unsigned* st) {
    XcdBarrier b; b.bar = bar; b.x = xb_xcc_id(); b.st = st;
    if (threadIdx.x == 0) (void)xb_add(&bar[XB_XCNT(b.x)], 1u);
    return b;
}
__device__ __forceinline__ void xcd_barrier_complete(unsigned* bar, unsigned x, unsigned& nloc, unsigned& nx) {
    const unsigned G = gridDim.x * gridDim.y * gridDim.z;
    unsigned sum, cnt, mine, sp = 0u;
    for (;;) {
        sum = 0u; cnt = 0u; mine = 0u;
#pragma unroll
        for (unsigned j = 0; j < 16; ++j) { const unsigned c = xb_ld(&bar[XB_XCNT(j)]); sum += c; cnt += (c > 0u) ? 1u : 0u; mine = (j == x) ? c : mine; }
        if (sum == G) break;
        __builtin_amdgcn_s_sleep(1);
        if ((++sp & 255u) == 0u) { if (xb_ld(&bar[XB_TMO])) break; if (sp > XB_SPIN_CAP) { atomicAdd(&bar[XB_TMO], 1u); break; } }
    }
    nloc = mine > 0u ? mine : 1u; nx = cnt > 0u ? cnt : 1u;
}
__device__ __forceinline__ void xcd_barrier(const XcdBarrier& b) {
    asm volatile("s_waitcnt vmcnt(0)" ::: "memory");
    __syncthreads();
    if (threadIdx.x == 0) {
        unsigned* bar = b.bar;
        __builtin_amdgcn_s_waitcnt(0);
        unsigned nloc = b.st[0], nx = b.st[1];
        if (nloc == 0u) { xcd_barrier_complete(bar, b.x, nloc, nx); b.st[0] = nloc; b.st[1] = nx; }
        const unsigned old = xb_add(&bar[XB_XSUB(b.x)], 1u);
        const unsigned gen = old / nloc;
        if (old + 1u == (gen + 1u) * nloc) {
            __builtin_amdgcn_fence(__ATOMIC_RELEASE, "agent");
            asm volatile("s_waitcnt vmcnt(0)" ::: "memory");
            const unsigned og = xb_add(&bar[XB_TOP], 1u);
            const unsigned tg = og / nx;
            if (og + 1u == (tg + 1u) * nx) xb_add(&bar[XB_TOPGEN], 1u);
            else XB_SPIN(xb_ld(&bar[XB_TOPGEN]) == tg, bar);
            __builtin_amdgcn_fence(__ATOMIC_ACQUIRE, "agent");
            xb_add(&bar[XB_XGEN(b.x)], 1u);
            asm volatile("s_waitcnt vmcnt(0)" ::: "memory");
        } else {
            XB_SPIN(xb_ld(&bar[XB_XGEN(b.x)]) == gen, bar);
            __builtin_amdgcn_fence(__ATOMIC_ACQUIRE, "agent");
            asm volatile("s_waitcnt vmcnt(0)" ::: "memory");
        }
    }
    __syncthreads();
}

namespace pg8 {
constexpr int BM = 256, BK = 64, HALF = 128, HTB = HALF * BK * 2, STAGE_BYTES = 8 * HTB, NXCD = 8, WGM = 8;
__host__ __device__ __forceinline__ int lds_byte(int r, int c) { const int st = (r >> 4) * 2 + (c >> 5), rr = r & 15, cc = c & 31, ob = rr * 64 + cc * 2; return st * 1024 + (ob ^ (((ob >> 9) & 1) << 5)); }
__host__ __device__ __forceinline__ void stage_rc(int b, int& R, int& C) { const int st = b / 1024, sb = b % 1024, swz = sb ^ (((sb >> 9) & 1) << 5); R = (st >> 1) * 16 + swz / 64; C = (st & 1) * 32 + (swz % 64) / 2; }
__host__ __device__ __forceinline__ int perm32(int rho) { const int n = rho >> 4, i = rho & 15; return 8 * (i >> 2) + 4 * n + (i & 3); }

struct Unit { int pm, pn, pb; };
struct Gemm { const bf16_t* A; const bf16_t* Bt; int K; };

struct TileOrder {
    int nM, nN, nwg, G, c; int ts[NEXP];
    __device__ __forceinline__ void init(int nM_, int nN_, int G_, int c_) { nM = nM_; nN = nN_; nwg = nM * nN; G = G_; c = c_;
#pragma unroll
        for (int e = 0; e < NEXP; ++e) ts[e] = (e == 0) ? 0 : 0x7fffffff; }
    __device__ __forceinline__ bool next(int i, Unit& u) const {
        const long L = (long)i * G + c; if (L >= nwg) return false;
        int wgid = (int)L; { const int q = nwg / NXCD, r = nwg % NXCD, xcd = wgid % NXCD, off = wgid / NXCD; wgid = (xcd < r ? xcd * (q + 1) : r * (q + 1) + (xcd - r) * q) + off; }
        const int nig = WGM * nN, gid = wgid / nig, fm = gid * WGM, gsz = (nM - fm) < WGM ? (nM - fm) : WGM;
        u.pm = fm + ((wgid % nig) % gsz); u.pn = (wgid % nig) / gsz;
        int e = 0;
#pragma unroll
        for (int k = 1; k < NEXP; ++k) e += (u.pm >= ts[k]) ? 1 : 0;
        u.pb = e * nN + u.pn; return true;
    }
};

typedef int v8i32 __attribute__((ext_vector_type(8)));
template <class Epi, bool FP8 = false>
__device__ __forceinline__ void gemm_phase(LAS unsigned char* lds, const Gemm g, const TileOrder& S, const Epi& E) {
    int tid_ = threadIdx.x; asm volatile("" : "+v"(tid_));
    const int tid = tid_, wid = __builtin_amdgcn_readfirstlane(tid >> 6), lane = tid & 63, wr = wid >> 2, wc = wid & 3, fr = lane & 15, fq = lane >> 4;
    const int K = g.K, nt = K / BK;
    unsigned voffA[2], voffB[2];
#pragma unroll
    for (int i = 0; i < 2; ++i) { int R, C; stage_rc(tid * 16 + i * 8192, R, C); const int Rb = Epi::PERM ? ((R & ~31) + perm32(R & 31)) : R;
        voffA[i] = (unsigned)(R * K + C) * 2u; voffB[i] = (unsigned)(Rb * K + C) * 2u; }
    const size_t kstep = (size_t)(BK * 2);
    const size_t hstep = (size_t)HALF * K * 2;
    const size_t tstep = 2 * hstep;
    const unsigned ldsw = (unsigned)wid * 1024u;
    const int aoff = lds_byte(wr * 64 + fr, fq * 8), boff = lds_byte(wc * 32 + fr, fq * 8);
#define PG8_SA(b, h) (((b) * 2 + (h)) * HTB)
#define PG8_SB(b, h) ((4 + (b) * 2 + (h)) * HTB)
#define PG8_STAGE(bufoff, gbase, voff) do { _Pragma("unroll") for (int _i = 0; _i < 2; ++_i) \
        __builtin_amdgcn_global_load_lds((const unsigned*)((const char*)(gbase) + (voff)[_i]), (LAS unsigned*)(lds + (bufoff) + ldsw + _i * 8192), 16, 0, 0); } while (0)
#define PG8_LD8(p) __builtin_bit_cast(v8i32, __builtin_shufflevector(*(const LAS u32x4*)(p), *(const LAS u32x4*)((p) + 1024), 0, 1, 2, 3, 4, 5, 6, 7))
#define PG8_LDA(dst, b, h) do { if constexpr (FP8) { _Pragma("unroll") for (int m = 0; m < 4; ++m) dst##8[m] = PG8_LD8(lds + PG8_SA(b, h) + aoff + m * 2048); } \
        else { _Pragma("unroll") for (int m = 0; m < 4; ++m) _Pragma("unroll") for (int k = 0; k < 2; ++k) dst[m][k] = *(const LAS bf16x8*)(lds + PG8_SA(b, h) + aoff + m * 2048 + k * 1024); } } while (0)
#define PG8_LDB(dst, b, h) do { if constexpr (FP8) { _Pragma("unroll") for (int n = 0; n < 2; ++n) dst##8[n] = PG8_LD8(lds + PG8_SB(b, h) + boff + n * 2048); } \
        else { _Pragma("unroll") for (int n = 0; n < 2; ++n) _Pragma("unroll") for (int k = 0; k < 2; ++k) dst[n][k] = *(const LAS bf16x8*)(lds + PG8_SB(b, h) + boff + n * 2048 + k * 1024); } } while (0)
#define PG8_MMA(ai, bj, At, Bt) do { __builtin_amdgcn_s_setprio(1); \
        if constexpr (FP8) { _Pragma("unroll") for (int m = 0; m < 4; ++m) _Pragma("unroll") for (int n = 0; n < 2; ++n) \
            asm volatile("v_mfma_scale_f32_16x16x128_f8f6f4 %0, %1, %2, %0, %3, %3 op_sel_hi:[0,0,0]" : "+v"(acc[ai][bj][m][n]) : "v"(Bt##8[n]), "v"(At##8[m]), "v"(one_scale)); } \
        else { _Pragma("unroll") for (int m = 0; m < 4; ++m) _Pragma("unroll") for (int n = 0; n < 2; ++n) _Pragma("unroll") for (int k = 0; k < 2; ++k) \
            acc[ai][bj][m][n] = __builtin_amdgcn_mfma_f32_16x16x32_bf16(Bt[n][k], At[m][k], acc[ai][bj][m][n], 0, 0, 0); } \
        __builtin_amdgcn_s_setprio(0); } while (0)
#define PG8_WAIT_V(n) asm volatile("s_waitcnt vmcnt(" #n ")" ::: "memory")
#define PG8_WAIT_L(n) asm volatile("s_waitcnt lgkmcnt(" #n ")" ::: "memory")
#define PG8_BAR __builtin_amdgcn_s_barrier()
#define PG8_SCHED __builtin_amdgcn_sched_barrier(0)
    Unit cur, nxt; int ui = 0;
    if (!S.next(0, cur)) return;
    f32x4 acc[2][2][4][2];
#pragma unroll
    for (int a = 0; a < 2; ++a)
#pragma unroll
        for (int b = 0; b < 2; ++b)
#pragma unroll
            for (int m = 0; m < 4; ++m)
#pragma unroll
                for (int n = 0; n < 2; ++n) acc[a][b][m][n] = (f32x4){0.f, 0.f, 0.f, 0.f};
    bf16x8 At[4][2], B0[2][2], B1[2][2]; v8i32 At8[4], B08[2], B18[2];
    int one_scale = 0x7f7f7f7f; asm volatile("" : "+v"(one_scale));
    const char* cA = (const char*)g.A + (size_t)cur.pm * tstep; const char* cB = (const char*)g.Bt + (size_t)cur.pb * tstep;
    PG8_STAGE(PG8_SB(0, 0), cB, voffB); PG8_STAGE(PG8_SA(0, 0), cA, voffA); PG8_STAGE(PG8_SB(0, 1), cB + hstep, voffB); PG8_STAGE(PG8_SA(0, 1), cA + hstep, voffA);
    if (wr == 1) PG8_BAR;
    PG8_WAIT_V(4); PG8_BAR;
    PG8_STAGE(PG8_SB(1, 0), cB + kstep, voffB); PG8_STAGE(PG8_SA(1, 0), cA + kstep, voffA); PG8_STAGE(PG8_SB(1, 1), cB + hstep + kstep, voffB);
    PG8_WAIT_V(6); PG8_BAR;
    for (;;) {
        const bool has_next = S.next(ui + 1, nxt);
        const char* nA = has_next ? (const char*)g.A + (size_t)nxt.pm * tstep : cA; const char* nB = has_next ? (const char*)g.Bt + (size_t)nxt.pb * tstep : cB;
        for (int t = 0; t < nt; t += 2) {
            const bool last = (t == nt - 2);
            const char* a1 = cA + (size_t)(t + 1) * kstep;
            const char* a2 = last ? nA : cA + (size_t)(t + 2) * kstep; const char* b2 = last ? nB : cB + (size_t)(t + 2) * kstep;
            const char* a3 = a2 + kstep; const char* b3 = b2 + kstep;
            PG8_LDB(B0, 0, 0); PG8_SCHED; PG8_LDA(At, 0, 0); PG8_STAGE(PG8_SA(1, 1), a1 + hstep, voffA);
            PG8_WAIT_L(8); PG8_BAR; PG8_WAIT_L(0); PG8_MMA(0, 0, At, B0); PG8_BAR; PG8_SCHED;
            PG8_LDB(B1, 0, 1); PG8_STAGE(PG8_SB(0, 0), b2, voffB);
            PG8_BAR; PG8_WAIT_L(0); PG8_MMA(0, 1, At, B1); PG8_BAR;
            PG8_LDA(At, 0, 1); PG8_STAGE(PG8_SA(0, 0), a2, voffA);
            PG8_BAR; PG8_WAIT_L(0); PG8_MMA(1, 0, At, B0); PG8_BAR; PG8_SCHED;
            PG8_STAGE(PG8_SB(0, 1), b2 + hstep, voffB);
            PG8_WAIT_V(6); PG8_BAR; PG8_MMA(1, 1, At, B1); PG8_BAR;
            PG8_LDB(B0, 1, 0); PG8_SCHED; PG8_LDA(At, 1, 0); PG8_STAGE(PG8_SA(0, 1), a2 + hstep, voffA);
            PG8_WAIT_L(8); PG8_BAR; PG8_WAIT_L(0); PG8_MMA(0, 0, At, B0); PG8_BAR; PG8_SCHED;
            PG8_LDB(B1, 1, 1); PG8_STAGE(PG8_SB(1, 0), b3, voffB);
            PG8_BAR; PG8_WAIT_L(0); PG8_MMA(0, 1, At, B1); PG8_BAR;
            PG8_LDA(At, 1, 1); PG8_STAGE(PG8_SA(1, 0), a3, voffA);
            PG8_BAR; PG8_WAIT_L(0); PG8_MMA(1, 0, At, B0); PG8_BAR; PG8_SCHED;
            PG8_STAGE(PG8_SB(1, 1), b3 + hstep, voffB);
            PG8_WAIT_V(6); PG8_BAR; PG8_MMA(1, 1, At, B1); PG8_BAR;
        }
        if constexpr (FP8) asm volatile("s_nop 15\n\ts_nop 15" ::: "memory");
        E(acc, cur, wr, wc, fr, fq);
        if (!has_next) break;
#pragma unroll
        for (int a = 0; a < 2; ++a)
#pragma unroll
            for (int b = 0; b < 2; ++b)
#pragma unroll
                for (int m = 0; m < 4; ++m)
#pragma unroll
                    for (int n = 0; n < 2; ++n) acc[a][b][m][n] = (f32x4){0.f, 0.f, 0.f, 0.f};
        cur = nxt; cA = nA; cB = nB; ++ui;
    }
    PG8_WAIT_V(0);
    if (wr == 0) PG8_BAR;
    PG8_BAR;
#undef PG8_SA
#undef PG8_SB
#undef PG8_STAGE
#undef PG8_LDA
#undef PG8_LDB
#undef PG8_MMA
#undef PG8_LD8
#undef PG8_WAIT_V
#undef PG8_WAIT_L
#undef PG8_BAR
#undef PG8_SCHED
}

struct EpiQKV {
    static constexpr bool PERM = true;
    bf16_t *Q, *Kk, *V; const float *gq, *gk, *cosT, *sinT; float qscale, isc;
    __device__ __forceinline__ void operator()(const f32x4 (&acc)[2][2][4][2], const Unit& u, int wr, int wc, int fr, int fq) const {
        const int row0 = u.pm * BM + wr * 64 + fr;
        if (u.pn >= 8) {
            const int col0 = (u.pn - 8) * BM + wc * 32 + 8 * fq;
#pragma unroll
            for (int ai = 0; ai < 2; ++ai)
#pragma unroll
                for (int m = 0; m < 4; ++m) { bf16_t* rowp = V + (size_t)(row0 + ai * HALF + m * 16) * DM + col0;
#pragma unroll
                    for (int bj = 0; bj < 2; ++bj) { const f32x4 v0 = acc[ai][bj][m][0] * isc, v1 = acc[ai][bj][m][1] * isc;
                        u32x4 w; w.x = cvt_pk_bf16(v0[0], v0[1]); w.y = cvt_pk_bf16(v0[2], v0[3]); w.z = cvt_pk_bf16(v1[0], v1[1]); w.w = cvt_pk_bf16(v1[2], v1[3]);
                        *(u32x4*)(rowp + bj * HALF) = w; } }
        } else {
            const int part = u.pn >> 2, sh = 4 * (u.pn & 3) + wc;
            bf16_t* dst = part ? Kk : Q; const float* g = part ? gk : gq; const float sc = part ? 1.0f : qscale;
            f32x4 g0[2], g1[2];
#pragma unroll
            for (int n = 0; n < 2; ++n) { g0[n] = *(const f32x4*)(g + 8 * fq + 4 * n); g1[n] = *(const f32x4*)(g + 32 + 8 * fq + 4 * n); }
#pragma unroll
            for (int ai = 0; ai < 2; ++ai)
#pragma unroll
                for (int m = 0; m < 4; ++m) {
                    const int r = row0 + ai * HALF + m * 16; const int pos = r & (SEQ - 1);
                    f32x4 x1[2], x2[2]; float ss = 0.f;
#pragma unroll
                    for (int n = 0; n < 2; ++n) { x1[n] = acc[ai][0][m][n]; x2[n] = acc[ai][1][m][n];
                        ss += (x1[n][0] * x1[n][0] + x1[n][1] * x1[n][1]) + (x1[n][2] * x1[n][2] + x1[n][3] * x1[n][3]);
                        ss += (x2[n][0] * x2[n][0] + x2[n][1] * x2[n][1]) + (x2[n][2] * x2[n][2] + x2[n][3] * x2[n][3]); }
                    ss += __shfl_xor(ss, 16); ss += __shfl_xor(ss, 32);
                    const float rstd = __builtin_amdgcn_rsqf(ss * (isc * isc * (1.0f / 64.0f)) + EPS) * isc;
                    unsigned char* op = (unsigned char*)dst + (size_t)r * DM + sh * 64 + 8 * fq;
                    u32x2 w1, w2;
#pragma unroll
                    for (int n = 0; n < 2; ++n) {
                        const f32x4 cs = *(const f32x4*)(cosT + pos * 32 + 8 * fq + 4 * n), sn = *(const f32x4*)(sinT + pos * 32 + 8 * fq + 4 * n);
                        const f32x4 y1 = x1[n] * rstd * g0[n], y2 = x2[n] * rstd * g1[n];
                        const f32x4 o1 = (y1 * cs - y2 * sn) * sc, o2 = (y2 * cs + y1 * sn) * sc;
                        if (n == 0) { w1.x = pk_fp8x4(o1[0], o1[1], o1[2], o1[3]); w2.x = pk_fp8x4(o2[0], o2[1], o2[2], o2[3]); }
                        else { w1.y = pk_fp8x4(o1[0], o1[1], o1[2], o1[3]); w2.y = pk_fp8x4(o2[0], o2[1], o2[2], o2[3]); }
                    }
                    *(u32x2*)(op) = w1; *(u32x2*)(op + 32) = w2;
                }
        }
    }
};
__device__ __forceinline__ f32x4 ld_x4(const void* p, size_t i, bool is16) {
    if (is16) { const u32x2 w = *(const u32x2*)((const bf16_t*)p + i); return (f32x4){bflo(w.x), bfhi(w.x), bflo(w.y), bfhi(w.y)}; }
    return *(const f32x4*)((const float*)p + i);
}
template <bool IN16>
struct EpiRes {
    static constexpr bool PERM = false;
    const void* xin; bf16_t* xout; const float* gate; float sc;
    __device__ __forceinline__ void operator()(const f32x4 (&acc)[2][2][4][2], const Unit& u, int wr, int wc, int fr, int fq) const {
        const int row0 = u.pm * BM + wr * 64 + fr, col0 = u.pn * BM + wc * 32 + 4 * fq;
        const float* gp = gate + (size_t)(u.pm >> 5) * 6144 + col0;
        f32x4 gv[2][2];
#pragma unroll
        for (int bj = 0; bj < 2; ++bj)
#pragma unroll
            for (int n = 0; n < 2; ++n) gv[bj][n] = *(const f32x4*)(gp + bj * HALF + n * 16) * sc;
#pragma unroll
        for (int ai = 0; ai < 2; ++ai)
#pragma unroll
            for (int m = 0; m < 4; ++m) { const size_t off = (size_t)(row0 + ai * HALF + m * 16) * DM + col0;
                f32x4 xv[2][2];
#pragma unroll
                for (int bj = 0; bj < 2; ++bj)
#pragma unroll
                    for (int n = 0; n < 2; ++n) xv[bj][n] = ld_x4(xin, off + bj * HALF + n * 16, IN16);
#pragma unroll
                for (int bj = 0; bj < 2; ++bj)
#pragma unroll
                    for (int n = 0; n < 2; ++n) { const f32x4 o = xv[bj][n] + gv[bj][n] * acc[ai][bj][m][n];
                        *(u32x2*)(xout + off + bj * HALF + n * 16) = (u32x2){cvt_pk_bf16(o[0], o[1]), cvt_pk_bf16(o[2], o[3])}; }
                if (m == 3) asm volatile("" ::: "memory"); }
    }
};
struct EpiSwiGLU {
    static constexpr bool PERM = true;
    bf16_t* H; int ldh;
    __device__ __forceinline__ void operator()(const f32x4 (&acc)[2][2][4][2], const Unit& u, int wr, int wc, int fr, int fq) const {
        const int row0 = u.pm * BM + wr * 64 + fr, col0 = u.pn * HALF + wc * 32 + 8 * fq;
#pragma unroll
        for (int ai = 0; ai < 2; ++ai)
#pragma unroll
            for (int m = 0; m < 4; ++m) { bf16_t* rowp = H + (size_t)(row0 + ai * HALF + m * 16) * ldh + col0;
                f32x4 v[2];
#pragma unroll
                for (int n = 0; n < 2; ++n) { const f32x4 gt = acc[ai][0][m][n], up = acc[ai][1][m][n];
#pragma unroll
                    for (int j = 0; j < 4; ++j) v[n][j] = fsilu(gt[j]) * up[j]; }
                u32x4 w; w.x = cvt_pk_bf16(v[0][0], v[0][1]); w.y = cvt_pk_bf16(v[0][2], v[0][3]); w.z = cvt_pk_bf16(v[1][0], v[1][1]); w.w = cvt_pk_bf16(v[1][2], v[1][3]);
                *(u32x4*)rowp = w; }
    }
};
struct EpiSwiGLU8 {
    static constexpr bool PERM = true;
    unsigned char* H; int ldh; float ws, hs;
    __device__ __forceinline__ void operator()(const f32x4 (&acc)[2][2][4][2], const Unit& u, int wr, int wc, int fr, int fq) const {
        const int row0 = u.pm * BM + wr * 64 + fr, col0 = u.pn * HALF + wc * 32 + 8 * fq;
#pragma unroll
        for (int ai = 0; ai < 2; ++ai)
#pragma unroll
            for (int m = 0; m < 4; ++m) { unsigned char* rowp = H + (size_t)(row0 + ai * HALF + m * 16) * ldh + col0;
                f32x4 v[2];
#pragma unroll
                for (int n = 0; n < 2; ++n) { const f32x4 gt = acc[ai][0][m][n] * ws, up = acc[ai][1][m][n] * (ws * hs);
#pragma unroll
                    for (int j = 0; j < 4; ++j) v[n][j] = fsilu(gt[j]) * up[j]; }
                *(u32x2*)rowp = (u32x2){pk_fp8x4(v[0][0], v[0][1], v[0][2], v[0][3]), pk_fp8x4(v[1][0], v[1][1], v[1][2], v[1][3])}; }
    }
};
struct EpiPlain {
    static constexpr bool PERM = true;
    bf16_t* O; int ldc; float sc;
    __device__ __forceinline__ void operator()(const f32x4 (&acc)[2][2][4][2], const Unit& u, int wr, int wc, int fr, int fq) const {
        const int row0 = u.pm * BM + wr * 64 + fr, col0 = u.pn * BM + wc * 32 + 8 * fq;
#pragma unroll
        for (int ai = 0; ai < 2; ++ai)
#pragma unroll
            for (int m = 0; m < 4; ++m) { bf16_t* rowp = O + (size_t)(row0 + ai * HALF + m * 16) * ldc + col0;
#pragma unroll
                for (int bj = 0; bj < 2; ++bj) { const f32x4 v0 = acc[ai][bj][m][0] * sc, v1 = acc[ai][bj][m][1] * sc;
                    u32x4 w; w.x = cvt_pk_bf16(v0[0], v0[1]); w.y = cvt_pk_bf16(v0[2], v0[3]); w.z = cvt_pk_bf16(v1[0], v1[1]); w.w = cvt_pk_bf16(v1[2], v1[3]);
                    *(u32x4*)(rowp + bj * HALF) = w; } }
    }
};
struct EpiAct {
    static constexpr bool PERM = true;
    int kind; unsigned char* ws; const float* lb;
    __device__ __forceinline__ void operator()(const f32x4 (&acc)[2][2][4][2], const Unit& u, int wr, int wc, int fr, int fq) const {
        const int row0 = u.pm * BM + wr * 64 + fr;
        int mode, ldc, colt; size_t boff;
        if (kind == 0) { const int grp = u.pn >> 2; colt = (u.pn & 3) * 256; ldc = 1024;
            boff = grp == 0 ? H_Q : grp == 1 ? H_LFF : grp == 2 ? H_LFB : grp == 3 ? H_V : H_G; mode = (grp == 0 || grp == 4) ? 1 : (grp == 3 ? 0 : 3); }
        else { ldc = LRUW; if (u.pn < 5) { boff = L_YB; colt = u.pn * 256; mode = 2; } else { boff = L_XB; colt = (u.pn - 5) * 256; mode = 0; } }
        bf16_t* base = (bf16_t*)(ws + boff);
        const int col0 = colt + wc * 32 + 8 * fq;
        f32x4 lbv[2][2];
        if (mode == 3) { const float* lp = lb + ((u.pn >> 2) - 1) * 1024 + col0;
#pragma unroll
            for (int bj = 0; bj < 2; ++bj)
#pragma unroll
                for (int n = 0; n < 2; ++n) lbv[bj][n] = *(const f32x4*)(lp + bj * HALF + 4 * n); }
#pragma unroll
        for (int ai = 0; ai < 2; ++ai)
#pragma unroll
            for (int m = 0; m < 4; ++m) { bf16_t* rowp = base + (size_t)(row0 + ai * HALF + m * 16) * ldc + col0;
#pragma unroll
                for (int bj = 0; bj < 2; ++bj) { f32x4 v[2]; u32x4 w;
#pragma unroll
                    for (int n = 0; n < 2; ++n) { v[n] = acc[ai][bj][m][n];
                        if (mode == 1) {
#pragma unroll
                            for (int j = 0; j < 4; ++j) v[n][j] = fsilu(v[n][j]); }
                        else if (mode == 2) {
#pragma unroll
                            for (int j = 0; j < 4; ++j) { const float x = v[n][j]; v[n][j] = x * fsigmoid(1.5957691216057308f * (x + 0.044715f * x * x * x)); } }
                        else if (mode == 3) {
#pragma unroll
                            for (int j = 0; j < 4; ++j) { const float l = lbv[bj][n][j]; const float fg = l + (1.0f - l) * fsigmoid(v[n][j]); v[n][j] = __builtin_amdgcn_logf(fg) * 0.6931471805599453f; } }
                    }
                    if (mode == 3) {
#pragma unroll
                        for (int n = 0; n < 2; ++n) { const _Float16 h0 = (_Float16)v[n][0], h1 = (_Float16)v[n][1], h2 = (_Float16)v[n][2], h3 = (_Float16)v[n][3];
                            const unsigned a = (unsigned)__builtin_bit_cast(unsigned short, h0) | ((unsigned)__builtin_bit_cast(unsigned short, h1) << 16);
                            const unsigned b = (unsigned)__builtin_bit_cast(unsigned short, h2) | ((unsigned)__builtin_bit_cast(unsigned short, h3) << 16);
                            if (n == 0) { w.x = a; w.y = b; } else { w.z = a; w.w = b; } }
                    } else { w.x = cvt_pk_bf16(v[0][0], v[0][1]); w.y = cvt_pk_bf16(v[0][2], v[0][3]); w.z = cvt_pk_bf16(v[1][0], v[1][1]); w.w = cvt_pk_bf16(v[1][2], v[1][3]); }
                    *(u32x4*)(rowp + bj * HALF) = w; } }
    }
};
}

struct Args { const float* in[30]; float* out; unsigned char* ws; };
enum { I_X = 0, I_C, I_ADAW, I_ADAB, I_N1G, I_N2G, I_ATWIN, I_ATQN, I_ATKN, I_ATLAM, I_ATSUB, I_ATWOUT, I_HGWIN, I_HGLB, I_HGNG, I_HGWOUT,
       I_LRWIN, I_LRCW, I_LRCB, I_LRWA, I_LRBA, I_LRWX, I_LRBX, I_LRLAM, I_LRWOUT, I_FFGU, I_FFDN, I_MOER, I_MOEGU, I_MOEDN };
enum { SC_LAM0 = 0, SC_LAM1, SC_OML0, SC_OML1, SC_MC0, SC_MC1 };

__device__ __forceinline__ void cvt_item(const float* W, int ldw, int src_col0, bf16_t* WT, int ldt, int dst_row0, int k0, LAS float* scr, int lane) {
#pragma unroll 8
    for (int i = 0; i < 32; ++i) { const int kk = 2 * i + (lane >> 5); scr[kk * 33 + (lane & 31)] = W[(size_t)(k0 + kk) * ldw + src_col0 + (lane & 31)]; }
    LDS_WAIT(); asm volatile("" ::: "memory");
    const int c = lane & 7;
#pragma unroll
    for (int j = 0; j < 4; ++j) { const int n = (lane >> 3) + 8 * j; const LAS float* s = scr + (8 * c) * 33 + n;
        u32x4 o; o.x = cvt_pk_bf16(s[0 * 33], s[1 * 33]); o.y = cvt_pk_bf16(s[2 * 33], s[3 * 33]); o.z = cvt_pk_bf16(s[4 * 33], s[5 * 33]); o.w = cvt_pk_bf16(s[6 * 33], s[7 * 33]);
        *(u32x4*)(WT + (size_t)(dst_row0 + n) * ldt + k0 + 8 * c) = o; }
    LDS_WAIT(); asm volatile("" ::: "memory");
}
__device__ __forceinline__ void cvt_item8(const float* W, int ldw, int src_col0, unsigned char* WT, int ldt, int dst_row0, int k0, float sc, LAS float* scr, int lane) {
#pragma unroll 8
    for (int i = 0; i < 32; ++i) { const int kk = 2 * i + (lane >> 5); scr[kk * 33 + (lane & 31)] = W[(size_t)(k0 + kk) * ldw + src_col0 + (lane & 31)]; }
    LDS_WAIT(); asm volatile("" ::: "memory");
    const int c = lane & 7;
#pragma unroll
    for (int j = 0; j < 4; ++j) { const int n = (lane >> 3) + 8 * j; const LAS float* s = scr + (8 * c) * 33 + n;
        *(u32x2*)(WT + (size_t)(dst_row0 + n) * ldt + k0 + 8 * c) = (u32x2){pk_fp8x4(s[0 * 33] * sc, s[1 * 33] * sc, s[2 * 33] * sc, s[3 * 33] * sc), pk_fp8x4(s[4 * 33] * sc, s[5 * 33] * sc, s[6 * 33] * sc, s[7 * 33] * sc)}; }
    LDS_WAIT(); asm volatile("" ::: "memory");
}
enum { MAP_ID = 0, MAP_QKV = 1, MAP_SWI = 2 };
template <bool F8 = false>
__device__ __forceinline__ void cvt_family(const float* src, size_t sstride, int ninst, int ldw, int K, int ng, int map, int F, bf16_t* dst, size_t dstride,
                                           LAS float* scr, int gw, int NGW, int lane) {
    const int nkb = K / 64, per = nkb * ng, total = ninst * per;
    for (int it = gw; it < total; it += NGW) {
        const int inst = it / per, r = it - inst * per, kb = r / ng, gi = r - kb * ng;
        int sc0;
        if (map == MAP_ID) sc0 = 32 * gi;
        else if (map == MAP_QKV) { const int pn = gi >> 3, bj = (gi >> 2) & 1, wc = gi & 3;
            if (pn < 8) { const int part = pn >> 2, sh = 4 * (pn & 3) + wc; sc0 = part * 1024 + sh * 64 + 32 * bj; } else sc0 = 32 * gi; }
        else { const int pn = gi >> 3, bj = (gi >> 2) & 1, q = gi & 3; sc0 = bj * F + pn * 128 + 32 * q; }
        if constexpr (F8) cvt_item8(src + (size_t)inst * sstride, ldw, sc0, (unsigned char*)dst + (size_t)inst * dstride, K, 32 * gi, 64 * kb, MOE_WSCALE, scr, lane);
        else cvt_item(src + (size_t)inst * sstride, ldw, sc0, dst + (size_t)inst * dstride, K, 32 * gi, 64 * kb, scr, lane);
    }
}

__device__ __forceinline__ void prologue_phase(const Args& A, LAS unsigned char* lds, int bid, int G) {
    const int tid = threadIdx.x, lane = tid & 63, wave = tid >> 6;
    unsigned char* ws = A.ws;
    {
        LAS float* sc = (LAS float*)lds;
        LAS float* red = (LAS float*)(lds + 32768);
        for (int i = tid; i < NBATCH * DM; i += NTHR) { const float cv = A.in[I_C][i]; sc[i] = fsilu(cv); }
        __syncthreads();
        float* mods = (float*)(ws + TB_MODS);
        for (int cb = bid; cb < (DEPTH * 6144) / 128; cb += G) {
            const int col = cb * 128 + (tid & 127), l = col / 6144, e = col - l * 6144, ch = tid >> 7;
            const float* wp = A.in[I_ADAW] + (size_t)l * DM * 6144 + e;
            float a[NBATCH];
#pragma unroll
            for (int b = 0; b < NBATCH; ++b) a[b] = 0.f;
#pragma unroll 4
            for (int d = ch * 256; d < ch * 256 + 256; ++d) { const float w = wp[(size_t)d * 6144];
#pragma unroll
                for (int b = 0; b < NBATCH; ++b) a[b] += sc[b * DM + d] * w; }
#pragma unroll
            for (int b = 0; b < NBATCH; ++b) red[(ch * 128 + (tid & 127)) * 8 + b] = a[b];
            __syncthreads();
            if (tid < 128) { const float bias = A.in[I_ADAB][l * 6144 + e];
#pragma unroll
                for (int b = 0; b < NBATCH; ++b) { const float s = ((red[(0 * 128 + tid) * 8 + b] + red[(1 * 128 + tid) * 8 + b]) + (red[(2 * 128 + tid) * 8 + b] + red[(3 * 128 + tid) * 8 + b])) + bias;
                    mods[((size_t)l * NBATCH + b) * 6144 + e] = s; } }
            __syncthreads();
        }
    }
    {
        float* cosT = (float*)(ws + TB_COS); float* sinT = (float*)(ws + TB_SIN);
        for (int i = bid * NTHR + tid; i < SEQ * 32; i += G * NTHR) {
            const int pos = i >> 5, d = i & 31;
            const float inv = (float)exp(-(double)d * (1.0 / 32.0) * 9.210340371976184);
            const float ang = (float)pos * inv;
            const double rev = (double)ang * 0.15915494309189535; const float fr = (float)(rev - floor(rev));
            cosT[i] = __builtin_amdgcn_cosf(fr); sinT[i] = __builtin_amdgcn_sinf(fr);
        }
        if (bid == 0 && tid < 2) {
            const int a = tid; const float* lm = A.in[I_ATLAM] + a * 256;
            float s1 = 0.f, s2 = 0.f; for (int i = 0; i < 64; ++i) { s1 += lm[i] * lm[64 + i]; s2 += lm[128 + i] * lm[192 + i]; }
            const float linit = 0.8f - 0.6f * expf(-0.3f * (float)(3 * a));
            float mq = 0.f, mk = 0.f; for (int i = 0; i < 64; ++i) { mq = fmaxf(mq, fabsf(A.in[I_ATQN][a * 64 + i])); mk = fmaxf(mk, fabsf(A.in[I_ATKN][a * 64 + i])); }
            float* scal = (float*)(ws + TB_SCAL);
            scal[SC_LAM0 + a] = expf(s1) - expf(s2) + linit; scal[SC_OML0 + a] = 1.0f - linit; scal[SC_MC0 + a] = 8.0f * mq * mk * LOG2E * 1.0001f;
        }
        if (bid == 1) {
            float* lb = (float*)(ws + TB_LB);
            for (int i = tid; i < 2 * 1024; i += NTHR) { const int d = i >> 10, k = i & 1023; const float* p = A.in[I_HGLB] + (size_t)d * DEPTH * 1024 + k;
                float mx = p[0]; for (int l = 1; l < DEPTH; ++l) mx = fmaxf(mx, p[l * 1024]);
                float den = 0.f, num = 0.f; for (int l = 0; l < DEPTH; ++l) { const float e = expf(p[l * 1024] - mx); den += e; if (l == 1) num += e; }
                lb[i] = num / den; }
        }
        if (bid == 2) {
            float* sp = (float*)(ws + TB_SP);
            for (int i = tid; i < 2 * LRUW; i += NTHR) { const float x = -A.in[I_LRLAM][i]; sp[i] = (x > 20.f) ? x : log1pf(expf(x)); }
        }
    }
    {
        LAS float* scr = (LAS float*)(lds + wave * 16384);
        const int vcu = (bid % 8) * (G / 8) + bid / 8;
        const int gw = vcu * NWAVES + wave, NGW = G * NWAVES;
        cvt_family(A.in[I_ATWIN], (size_t)1024 * 3072, 1, 3072, 1024, 96, MAP_QKV, 0, (bf16_t*)(ws + W_QKV), (size_t)3072 * 1024, scr, gw, NGW, lane);
        cvt_family<true>(A.in[I_ATWIN] + (size_t)1024 * 3072, 0, 1, 3072, 1024, 96, MAP_QKV, 0, (bf16_t*)(ws + W_QKV) + (size_t)3072 * 1024, 0, scr, gw, NGW, lane);
        cvt_family(A.in[I_ATWOUT], (size_t)1024 * 1024, 2, 1024, 1024, 32, MAP_ID, 0, (bf16_t*)(ws + W_AO), (size_t)1024 * 1024, scr, gw, NGW, lane);
        cvt_family(A.in[I_HGWIN], 0, 1, 5120, 1024, 160, MAP_ID, 0, (bf16_t*)(ws + W_HGI), 0, scr, gw, NGW, lane);
        cvt_family(A.in[I_HGWOUT], 0, 1, 1024, 1024, 32, MAP_ID, 0, (bf16_t*)(ws + W_HGO), 0, scr, gw, NGW, lane);
        cvt_family(A.in[I_LRWIN], 0, 1, 2560, 1024, 80, MAP_ID, 0, (bf16_t*)(ws + W_LRI), 0, scr, gw, NGW, lane);
        cvt_family(A.in[I_LRWOUT], 0, 1, 1024, 1280, 32, MAP_ID, 0, (bf16_t*)(ws + W_LRO), 0, scr, gw, NGW, lane);
        for (int it = gw; it < 2 * 20 * 2 * 4; it += NGW) {
            const int part = it / 160, r = it % 160, inst = r >> 3, kb = (r >> 2) & 1, gi = r & 3, d = inst / 10, n = inst % 10;
            const float* src = (part ? A.in[I_LRWX] : A.in[I_LRWA]) + (size_t)inst * 16384;
            cvt_item(src, 128, 32 * gi, (bf16_t*)(ws + W_LRG) + (size_t)(n * 2 + d) * 256 * 128, 128, part * 128 + 32 * gi, 64 * kb, scr, lane);
        }
        static_assert(FP8_DENSE_FROM == 2 || FP8_DENSE_FROM > 3, "dense layer 0 stays bf16; layer 2 optional");
        constexpr int NB16 = (FP8_DENSE_FROM == 2) ? 1 : 2;
        cvt_family(A.in[I_FFGU], (size_t)1024 * 5632, NB16, 5632, 1024, 176, MAP_SWI, DFF, (bf16_t*)(ws + W_FGU), (size_t)5632 * 1024, scr, gw, NGW, lane);
        cvt_family(A.in[I_FFDN], (size_t)2816 * 1024, NB16, 1024, 2816, 32, MAP_ID, 0, (bf16_t*)(ws + W_FDN), (size_t)1024 * 2816, scr, gw, NGW, lane);
        if constexpr (NB16 == 1) {
            cvt_family<true>(A.in[I_FFGU] + (size_t)1024 * 5632, 0, 1, 5632, 1024, 176, MAP_SWI, DFF, (bf16_t*)(ws + W_FGU) + (size_t)5632 * 1024, 0, scr, gw, NGW, lane);
            cvt_family<true>(A.in[I_FFDN] + (size_t)2816 * 1024, 0, 1, 1024, 2816, 32, MAP_ID, 0, (bf16_t*)(ws + W_FDN) + (size_t)1024 * 2816, 0, scr, gw, NGW, lane);
        }
        cvt_family<true>(A.in[I_MOEGU], (size_t)1024 * 7168, 16, 7168, 1024, 224, MAP_SWI, DFFE, (bf16_t*)(ws + W_MGU), (size_t)7168 * 1024, scr, gw, NGW, lane);
        cvt_family<true>(A.in[I_MOEDN], (size_t)3584 * 1024, 16, 1024, 3584, 32, MAP_ID, 0, (bf16_t*)(ws + W_MDN), (size_t)1024 * 3584, scr, gw, NGW, lane);
    }
}

template <bool ROUTER>
__device__ __forceinline__ void norm_phase(const Args& A, LAS unsigned char* lds, int bid, int G, const void* xsrc, bool src16, void* xdst, bool dst16, const float* gain, const float* modl  , int which,
                                           bool combine, const float* modprev  , bool nonorm, const float* router, bool f8out = false) {
    int tid_ = threadIdx.x; asm volatile("" : "+v"(tid_));
    const int tid = tid_, lane = tid & 63, wave = tid >> 6;
    unsigned char* ws = A.ws;
    bf16_t* HM = (bf16_t*)(ws + WS_HM);
    const int* slot = (const int*)(ws + TB_SLOT); const float* gts = (const float*)(ws + TB_GATE);
    const bf16_t* Y = (const bf16_t*)(ws + E_XS);
    LAS int* hist = (LAS int*)lds;
    for (int tb = bid; tb < MTOK / 256; tb += G) {
        const int b = tb >> 5;
        f32x4 ga[4], sh[4], g2[4];
#pragma unroll
        for (int j = 0; j < 4; ++j) { const int c = 256 * j + 4 * lane;
            if (!nonorm) { const f32x4 gv = *(const f32x4*)(gain + c), sv = *(const f32x4*)(modl + (size_t)b * 6144 + (which * 3 + 1) * 1024 + c);
                ga[j] = gv * (sv + 1.0f); sh[j] = *(const f32x4*)(modl + (size_t)b * 6144 + (which * 3) * 1024 + c); }
            if (combine) g2[j] = *(const f32x4*)(modprev + (size_t)b * 6144 + 5 * 1024 + c); }
        f32x4 rw[ROUTER ? 32 : 1];
        if constexpr (ROUTER) {
            if (tid < 8) hist[tid] = 0;
#pragma unroll
            for (int j = 0; j < 4; ++j)
#pragma unroll
                for (int i = 0; i < 4; ++i) { const int c = 256 * j + 4 * lane + i; rw[(j * 4 + i) * 2] = *(const f32x4*)(router + c * 8); rw[(j * 4 + i) * 2 + 1] = *(const f32x4*)(router + c * 8 + 4); }
            __syncthreads();
        }
        for (int i = 0; i < 32; ++i) {
            const int row = tb * 256 + wave * 32 + i;
            f32x4 v[4];
#pragma unroll
            for (int j = 0; j < 4; ++j) v[j] = pg8::ld_x4(xsrc, (size_t)row * DM + 256 * j + 4 * lane, src16);
            if (combine) {
                const int s0 = slot[row * 2], s1 = slot[row * 2 + 1]; const float w0 = gts[row * 2], w1 = gts[row * 2 + 1];
#pragma unroll
                for (int j = 0; j < 4; ++j) { const u32x2 a = *(const u32x2*)(Y + (size_t)s0 * DM + 256 * j + 4 * lane), c2 = *(const u32x2*)(Y + (size_t)s1 * DM + 256 * j + 4 * lane);
                    f32x4 y; y[0] = w0 * bflo(a.x) + w1 * bflo(c2.x); y[1] = w0 * bfhi(a.x) + w1 * bfhi(c2.x); y[2] = w0 * bflo(a.y) + w1 * bflo(c2.y); y[3] = w0 * bfhi(a.y) + w1 * bfhi(c2.y);
                    v[j] = v[j] + g2[j] * y;
                    if (dst16) *(u32x2*)((bf16_t*)xdst + (size_t)row * DM + 256 * j + 4 * lane) = (u32x2){cvt_pk_bf16(v[j][0], v[j][1]), cvt_pk_bf16(v[j][2], v[j][3])};
                    else *(f32x4*)((float*)xdst + (size_t)row * DM + 256 * j + 4 * lane) = v[j]; }
            }
            if (nonorm) continue;
            float ss = 0.f;
#pragma unroll
            for (int j = 0; j < 4; ++j) ss += (v[j][0] * v[j][0] + v[j][1] * v[j][1]) + (v[j][2] * v[j][2] + v[j][3] * v[j][3]);
            ss = wave_sum(ss);
            const float rstd = 1.0f / sqrtf(ss * (1.0f / DM) + EPS);
            f32x4 h[4];
#pragma unroll
            for (int j = 0; j < 4; ++j) { h[j] = v[j] * rstd * ga[j] + sh[j];
                if (f8out) { *(unsigned*)((unsigned char*)HM + (size_t)row * DM + 256 * j + 4 * lane) = pk_fp8x4(h[j][0], h[j][1], h[j][2], h[j][3]); }
                else { u32x2 w; w.x = cvt_pk_bf16(h[j][0], h[j][1]); w.y = cvt_pk_bf16(h[j][2], h[j][3]);
                    *(u32x2*)(HM + (size_t)row * DM + 256 * j + 4 * lane) = w; } }
            if constexpr (ROUTER) {
                float lg[8];
#pragma unroll
                for (int e = 0; e < 8; ++e) lg[e] = 0.f;
#pragma unroll
                for (int j = 0; j < 4; ++j)
#pragma unroll
                    for (int q = 0; q < 4; ++q) { const float hv = h[j][q]; const f32x4 r0 = rw[(j * 4 + q) * 2], r1 = rw[(j * 4 + q) * 2 + 1];
                        lg[0] += hv * r0[0]; lg[1] += hv * r0[1]; lg[2] += hv * r0[2]; lg[3] += hv * r0[3]; lg[4] += hv * r1[0]; lg[5] += hv * r1[1]; lg[6] += hv * r1[2]; lg[7] += hv * r1[3]; }
#pragma unroll
                for (int e = 0; e < 8; ++e) lg[e] = wave_sum(lg[e]);
                int e0 = 0; float v0 = lg[0];
#pragma unroll
                for (int e = 1; e < 8; ++e) if (lg[e] > v0) { v0 = lg[e]; e0 = e; }
                int e1 = -1; float v1 = -3.0e38f;
#pragma unroll
                for (int e = 0; e < 8; ++e) if (e != e0 && lg[e] > v1) { v1 = lg[e]; e1 = e; }
                const float p1 = frcp(1.0f + fexp(v1 - v0));
                if (lane == 0) { int* eid = (int*)(ws + TB_EID); float* gt = (float*)(ws + TB_GATE);
                    eid[row * 2] = e0; eid[row * 2 + 1] = e1; gt[row * 2] = p1; gt[row * 2 + 1] = 1.0f - p1;
                    atomicAdd((int*)&hist[e0], 1); atomicAdd((int*)&hist[e1], 1); }
            }
        }
        if constexpr (ROUTER) {
            __syncthreads();
            if (tid < 8) ((int*)(ws + TB_BCNT))[tb * 8 + tid] = hist[tid];
            __syncthreads();
        }
    }
}

namespace lru {
constexpr int XCF = 0, XCB = 16384, AA = 24576, UU = 40960, LAA = 57344;
__device__ __forceinline__ int sw256(int row, int cb) { return row * 256 + (cb ^ ((row & 15) << 4)); }
__device__ __forceinline__ int crow(int r, int hi) { return (r & 3) + 8 * (r >> 2) + 4 * hi; }
template <int MODE>
__device__ __forceinline__ void lru_item(const Args& A, LAS unsigned char* lds, int b, int n, int seg, int dir) {
    int tid_ = threadIdx.x; asm volatile("" : "+v"(tid_));
    const int tid = tid_, wid = tid >> 6, lane = tid & 63, r = lane & 31, hh = lane >> 5;
    unsigned char* ws = A.ws;
    const bf16_t* XB = (const bf16_t*)(ws + L_XB); const bf16_t* YB = (const bf16_t*)(ws + L_YB); bf16_t* HF = (bf16_t*)(ws + L_HF); bf16_t* HY = (bf16_t*)(ws + L_HY);
    bf16_t* LAg = (bf16_t*)(ws + (dir ? L_HY : L_HF)); bf16_t* Ug = (bf16_t*)(ws + L_U + (size_t)dir * SZ_LRU);
    const int ct = tid >> 4, cg = tid & 15, cc0 = n * 128 + 8 * cg;
    float carry = 0.f, P = 1.f;
    if (MODE != 0 && tid < 128) carry = ((const float*)(ws + TB_LCIN))[(size_t)((b * 32 + seg) * 2 + dir) * LRUW + n * 128 + tid];
    if constexpr (MODE == 0) {
        const bf16_t* Wg = (const bf16_t*)(ws + W_LRG) + (size_t)((n * 2 + dir) * 256 + ((r < 16) ? (16 * wid + r) : (128 + 16 * wid + r - 16))) * 128 + 8 * hh;
        bf16x8 bfrag[8];
#pragma unroll
        for (int ks = 0; ks < 8; ++ks) bfrag[ks] = *(const bf16x8*)(Wg + 16 * ks);
        const int cch = n * 128 + 16 * wid + (r & 15);
        const float nba = -LOG2E * A.in[I_LRBA][dir * LRUW + cch], nbx = -LOG2E * A.in[I_LRBX][dir * LRUW + cch], csp = -8.0f * LOG2E * ((const float*)(ws + TB_SP))[dir * LRUW + cch];
        float cw[4][8], cb[8];
#pragma unroll
        for (int j = 0; j < 8; ++j) { cb[j] = A.in[I_LRCB][cc0 + j];
#pragma unroll
            for (int w = 0; w < 4; ++w) cw[w][j] = A.in[I_LRCW][w * LRUW + cc0 + j]; }
        u32x4 xr[4];
#define LRU_XLOAD(si_) do { const int sub_ = dir ? (7 - (si_)) : (si_); const int tok_ = seg * 256 + sub_ * 32 + ct; \
        _Pragma("unroll") for (int w = 0; w < 4; ++w) { const int tt = tok_ - 1 + w; xr[w] = (tt >= 0 && tt < SEQ) ? *(const u32x4*)(XB + ((size_t)b * SEQ + tt) * LRUW + cc0) : (u32x4){0u, 0u, 0u, 0u}; } } while (0)
        LRU_XLOAD(0);
        for (int si = 0; si < 8; ++si) {
            const int sub = dir ? (7 - si) : si; const int t0 = seg * 256 + sub * 32;
            {
                float xc[8];
#pragma unroll
                for (int j = 0; j < 8; ++j) xc[j] = cb[j];
#pragma unroll
                for (int w = 0; w < 4; ++w) { const u32x4 v = xr[w];
#pragma unroll
                    for (int e = 0; e < 4; ++e) { xc[2 * e] += cw[w][2 * e] * bflo(v[e]); xc[2 * e + 1] += cw[w][2 * e + 1] * bfhi(v[e]); } }
                if (si + 1 < 8) LRU_XLOAD(si + 1);
                *(LAS f32x4*)(lds + XCF + (ct * 128 + 8 * cg) * 4) = (f32x4){xc[0], xc[1], xc[2], xc[3]};
                *(LAS f32x4*)(lds + XCF + (ct * 128 + 8 * cg + 4) * 4) = (f32x4){xc[4], xc[5], xc[6], xc[7]};
                *(LAS u32x4*)(lds + XCB + sw256(ct, 16 * cg)) = (u32x4){cvt_pk_bf16(xc[0], xc[1]), cvt_pk_bf16(xc[2], xc[3]), cvt_pk_bf16(xc[4], xc[5]), cvt_pk_bf16(xc[6], xc[7])};
            }
            __syncthreads();
            {
                f32x16 acc = {};
#pragma unroll
                for (int ks = 0; ks < 8; ++ks) { const bf16x8 fa = *(const LAS bf16x8*)(lds + XCB + sw256(r, (16 * ks + 8 * hh) * 2)); acc = __builtin_amdgcn_mfma_f32_32x32x16_bf16(fa, bfrag[ks], acc, 0, 0, 0); }
#pragma unroll
                for (int q = 0; q < 8; ++q) {
                    const auto sw = __builtin_amdgcn_permlane16_swap(__float_as_uint(acc[q]), __float_as_uint(acc[8 + q]), false, false);
                    const float rp = __uint_as_float(sw[0]), ip = __uint_as_float(sw[1]);
                    const int tq = crow((r < 16) ? q : (8 + q), hh); const int cl = 16 * wid + (r & 15);
                    const float xcv = ((const LAS float*)(lds + XCF))[tq * 128 + cl];
                    const float rg = frcp(1.0f + fexp2(fmaf(rp, -LOG2E, nba))), ig = frcp(1.0f + fexp2(fmaf(ip, -LOG2E, nbx)));
                    const float la = csp * rg, av = fexp2(la), uv = __builtin_amdgcn_sqrtf(fmaxf(fmaf(-av, av, 1.0f), 0.f)) * ig * xcv;
                    ((LAS float*)(lds + AA))[tq * 128 + cl] = av; ((LAS float*)(lds + UU))[tq * 128 + cl] = uv; ((LAS float*)(lds + LAA))[tq * 128 + cl] = la; }
            }
            __syncthreads();
            if (tid < 128) {
                LAS float* ap = (LAS float*)(lds + AA) + tid; LAS float* up = (LAS float*)(lds + UU) + tid; float av[32], uv[32];
#pragma unroll
                for (int i = 0; i < 32; ++i) { av[i] = ap[i * 128]; uv[i] = up[i * 128]; }
                if (dir == 0) {
#pragma unroll
                    for (int i = 0; i < 32; ++i) { carry = av[i] * carry + uv[i]; P *= av[i]; } }
                else {
#pragma unroll
                    for (int i = 31; i >= 0; --i) { carry = av[i] * carry + uv[i]; P *= av[i]; } }
            } else if (tid >= 256) {
                const int t2 = tid - 256, row = t2 >> 3, c16 = (t2 & 7) * 16; const size_t go = ((size_t)b * SEQ + t0 + row) * LRUW + n * 128 + c16;
                const LAS float* lp = (const LAS float*)(lds + LAA) + row * 128 + c16; const LAS float* up = (const LAS float*)(lds + UU) + row * 128 + c16;
                f32x4 l[4], u[4];
#pragma unroll
                for (int j = 0; j < 4; ++j) { l[j] = *(const LAS f32x4*)(lp + 4 * j); u[j] = *(const LAS f32x4*)(up + 4 * j); }
#pragma unroll
                for (int j = 0; j < 2; ++j) {
                    *(u32x4*)(LAg + go + 8 * j) = (u32x4){cvt_pk_bf16(l[2 * j][0], l[2 * j][1]), cvt_pk_bf16(l[2 * j][2], l[2 * j][3]), cvt_pk_bf16(l[2 * j + 1][0], l[2 * j + 1][1]), cvt_pk_bf16(l[2 * j + 1][2], l[2 * j + 1][3])};
                    *(u32x4*)(Ug + go + 8 * j) = (u32x4){cvt_pk_bf16(u[2 * j][0], u[2 * j][1]), cvt_pk_bf16(u[2 * j][2], u[2 * j][3]), cvt_pk_bf16(u[2 * j + 1][0], u[2 * j + 1][1]), cvt_pk_bf16(u[2 * j + 1][2], u[2 * j + 1][3])}; }
            }
            __syncthreads();
        }
#undef LRU_XLOAD
        if (tid < 128) { float* sm = (float*)(ws + TB_LSUM) + (size_t)(((b * 32 + seg) * 2 + dir) * 2) * LRUW + n * 128 + tid; sm[0] = P; sm[LRUW] = carry; }
    } else {
        u32x4 lr, ur;
#define LRU_GLOAD(si_) do { const int sub_ = dir ? (7 - (si_)) : (si_); const size_t go_ = ((size_t)b * SEQ + seg * 256 + sub_ * 32 + ct) * LRUW + cc0; \
        lr = *(const u32x4*)(LAg + go_); ur = *(const u32x4*)(Ug + go_); } while (0)
        LRU_GLOAD(0);
        for (int si = 0; si < 8; ++si) {
            const int sub = dir ? (7 - si) : si; const int t0 = seg * 256 + sub * 32;
            {   const u32x4 l = lr, u = ur;
                if (si + 1 < 8) LRU_GLOAD(si + 1);
                *(LAS f32x4*)(lds + AA + (ct * 128 + 8 * cg) * 4) = (f32x4){fexp2(bflo(l[0])), fexp2(bfhi(l[0])), fexp2(bflo(l[1])), fexp2(bfhi(l[1]))};
                *(LAS f32x4*)(lds + AA + (ct * 128 + 8 * cg + 4) * 4) = (f32x4){fexp2(bflo(l[2])), fexp2(bfhi(l[2])), fexp2(bflo(l[3])), fexp2(bfhi(l[3]))};
                *(LAS f32x4*)(lds + UU + (ct * 128 + 8 * cg) * 4) = (f32x4){bflo(u[0]), bfhi(u[0]), bflo(u[1]), bfhi(u[1])};
                *(LAS f32x4*)(lds + UU + (ct * 128 + 8 * cg + 4) * 4) = (f32x4){bflo(u[2]), bfhi(u[2]), bflo(u[3]), bfhi(u[3])}; }
            __syncthreads();
            if (tid < 128) {
                LAS float* ap = (LAS float*)(lds + AA) + tid; LAS float* up = (LAS float*)(lds + UU) + tid; float av[32], uv[32];
#pragma unroll
                for (int i = 0; i < 32; ++i) { av[i] = ap[i * 128]; uv[i] = up[i * 128]; }
                if (dir == 0) {
#pragma unroll
                    for (int i = 0; i < 32; ++i) { carry = av[i] * carry + uv[i]; uv[i] = carry; } }
                else {
#pragma unroll
                    for (int i = 31; i >= 0; --i) { carry = av[i] * carry + uv[i]; uv[i] = carry; } }
#pragma unroll
                for (int i = 0; i < 32; ++i) up[i * 128] = uv[i];
            }
            __syncthreads();
            {   const int tok = t0 + ct; const size_t go = ((size_t)b * SEQ + tok) * LRUW + cc0;
                const f32x4 h0 = *(const LAS f32x4*)(lds + UU + (ct * 128 + 8 * cg) * 4), h1 = *(const LAS f32x4*)(lds + UU + (ct * 128 + 8 * cg + 4) * 4);
                if (MODE == 1) { *(u32x4*)(HF + go) = (u32x4){cvt_pk_bf16(h0[0], h0[1]), cvt_pk_bf16(h0[2], h0[3]), cvt_pk_bf16(h1[0], h1[1]), cvt_pk_bf16(h1[2], h1[3])}; }
                else { const u32x4 f = *(const u32x4*)(HF + go), y = *(const u32x4*)(YB + go);
                    *(u32x4*)(HY + go) = (u32x4){cvt_pk_bf16((h0[0] + bflo(f[0])) * bflo(y[0]), (h0[1] + bfhi(f[0])) * bfhi(y[0])), cvt_pk_bf16((h0[2] + bflo(f[1])) * bflo(y[1]), (h0[3] + bfhi(f[1])) * bfhi(y[1])),
                                                cvt_pk_bf16((h1[0] + bflo(f[2])) * bflo(y[2]), (h1[1] + bfhi(f[2])) * bfhi(y[2])), cvt_pk_bf16((h1[2] + bflo(f[3])) * bflo(y[3]), (h1[3] + bfhi(f[3])) * bfhi(y[3]))}; }
            }
            __syncthreads();
        }
#undef LRU_GLOAD
    }
}
__device__ __forceinline__ void lru_apply_item(const Args& A, LAS unsigned char* lds, int b, int n, int seg) {
    constexpr int HFL = 57344;
    int tid_ = threadIdx.x; asm volatile("" : "+v"(tid_));
    const int tid = tid_;
    unsigned char* ws = A.ws;
    const bf16_t* YB = (const bf16_t*)(ws + L_YB); bf16_t* HY = (bf16_t*)(ws + L_HY);
    const int ct = tid >> 4, cg = tid & 15, cc0 = n * 128 + 8 * cg;
#pragma unroll 1
    for (int dir = 0; dir < 2; ++dir) {
        const bf16_t* LAg = (const bf16_t*)(ws + (dir ? L_HY : L_HF)); const bf16_t* Ug = (const bf16_t*)(ws + L_U + (size_t)dir * SZ_LRU);
        float carry = 0.f;
        if (tid < 128) carry = ((const float*)(ws + TB_LCIN))[(size_t)((b * 32 + seg) * 2 + dir) * LRUW + n * 128 + tid];
        u32x4 lr, ur, yr = {0u, 0u, 0u, 0u};
#define LRU_GLOAD(si_) do { const int sub_ = dir ? (7 - (si_)) : (si_); const size_t go_ = ((size_t)b * SEQ + seg * 256 + sub_ * 32 + ct) * LRUW + cc0; \
        lr = *(const u32x4*)(LAg + go_); ur = *(const u32x4*)(Ug + go_); if (dir) yr = *(const u32x4*)(YB + go_); } while (0)
        LRU_GLOAD(0);
        for (int si = 0; si < 8; ++si) {
            const int sub = dir ? (7 - si) : si; const int t0 = seg * 256 + sub * 32;
            const u32x4 l = lr, u = ur, y = yr;
            if (si + 1 < 8) LRU_GLOAD(si + 1);
            *(LAS f32x4*)(lds + AA + (ct * 128 + 8 * cg) * 4) = (f32x4){fexp2(bflo(l[0])), fexp2(bfhi(l[0])), fexp2(bflo(l[1])), fexp2(bfhi(l[1]))};
            *(LAS f32x4*)(lds + AA + (ct * 128 + 8 * cg + 4) * 4) = (f32x4){fexp2(bflo(l[2])), fexp2(bfhi(l[2])), fexp2(bflo(l[3])), fexp2(bfhi(l[3]))};
            *(LAS f32x4*)(lds + UU + (ct * 128 + 8 * cg) * 4) = (f32x4){bflo(u[0]), bfhi(u[0]), bflo(u[1]), bfhi(u[1])};
            *(LAS f32x4*)(lds + UU + (ct * 128 + 8 * cg + 4) * 4) = (f32x4){bflo(u[2]), bfhi(u[2]), bflo(u[3]), bfhi(u[3])};
            __syncthreads();
            if (tid < 128) {
                LAS float* ap = (LAS float*)(lds + AA) + tid; LAS float* up = (LAS float*)(lds + UU) + tid; float av[32], uv[32];
#pragma unroll
                for (int i = 0; i < 32; ++i) { av[i] = ap[i * 128]; uv[i] = up[i * 128]; }
                if (dir == 0) {
#pragma unroll
                    for (int i = 0; i < 32; ++i) { carry = av[i] * carry + uv[i]; uv[i] = carry; } }
                else {
#pragma unroll
                    for (int i = 31; i >= 0; --i) { carry = av[i] * carry + uv[i]; uv[i] = carry; } }
#pragma unroll
                for (int i = 0; i < 32; ++i) up[i * 128] = uv[i];
            }
            __syncthreads();
            {   const f32x4 h0 = *(const LAS f32x4*)(lds + UU + (ct * 128 + 8 * cg) * 4), h1 = *(const LAS f32x4*)(lds + UU + (ct * 128 + 8 * cg + 4) * 4);
                LAS u32x4* hf = (LAS u32x4*)(lds + HFL + ((sub * 32 + ct) * 128 + 8 * cg) * 2);
                if (dir == 0) *hf = (u32x4){cvt_pk_bf16(h0[0], h0[1]), cvt_pk_bf16(h0[2], h0[3]), cvt_pk_bf16(h1[0], h1[1]), cvt_pk_bf16(h1[2], h1[3])};
                else { const u32x4 f = *hf; const size_t go = ((size_t)b * SEQ + t0 + ct) * LRUW + cc0;
                    *(u32x4*)(HY + go) = (u32x4){cvt_pk_bf16((h0[0] + bflo(f[0])) * bflo(y[0]), (h0[1] + bfhi(f[0])) * bfhi(y[0])), cvt_pk_bf16((h0[2] + bflo(f[1])) * bflo(y[1]), (h0[3] + bfhi(f[1])) * bfhi(y[1])),
                                                cvt_pk_bf16((h1[0] + bflo(f[2])) * bflo(y[2]), (h1[1] + bfhi(f[2])) * bfhi(y[2])), cvt_pk_bf16((h1[2] + bflo(f[3])) * bflo(y[3]), (h1[3] + bfhi(f[3])) * bfhi(y[3]))}; }
            }
            __syncthreads();
        }
#undef LRU_GLOAD
    }
}
}
__device__ __forceinline__ void lru_apply_phase(const Args& A, LAS unsigned char* lds, int bid, int G) {
    for (int it = bid; it < 2560; it += G) lru::lru_apply_item(A, lds, it / 320, (it >> 5) % 10, it & 31);
}
template <int MODE>
__device__ __forceinline__ void lru_phase(const Args& A, LAS unsigned char* lds, int bid, int G) {
    const int nitems = (MODE == 0) ? 5120 : 2560;
    for (int it = bid; it < nitems; it += G) {
        int b, n, seg, dir;
        if (MODE == 0) { dir = it & 1; const int r = it >> 1; seg = r & 31; n = (r >> 5) % 10; b = r / 320; }
        else { dir = MODE - 1; seg = it & 31; n = (it >> 5) % 10; b = it / 320; }
        lru::lru_item<MODE>(A, lds, b, n, seg, dir);
    }
}
__device__ __forceinline__ void lru_carry_phase(const Args& A, int bid, int G) {
    const float* sm = (const float*)(A.ws + TB_LSUM); float* cin = (float*)(A.ws + TB_LCIN);
    for (int idx = bid * NTHR + threadIdx.x; idx < NBATCH * 2 * LRUW; idx += G * NTHR) {
        const int b = idx / (2 * LRUW), r = idx % (2 * LRUW), dir = r / LRUW, ch = r % LRUW; float carry = 0.f;
        for (int i = 0; i < 32; ++i) { const int sg = dir ? (31 - i) : i; const size_t o = (size_t)((b * 32 + sg) * 2 + dir);
            cin[o * LRUW + ch] = carry; carry = sm[o * 2 * LRUW + ch] * carry + sm[o * 2 * LRUW + LRUW + ch]; }
    }
}

__device__ __forceinline__ void place_phase(const Args& A, LAS unsigned char* lds, int bid, int G) {
    int tid_ = threadIdx.x; asm volatile("" : "+v"(tid_));
    const int tid = tid_, lane = tid & 63, wave = tid >> 6; unsigned char* ws = A.ws;
    const int* bcnt = (const int*)(ws + TB_BCNT); const int* eid = (const int*)(ws + TB_EID); int* slot = (int*)(ws + TB_SLOT);
    const bf16_t* HM = (const bf16_t*)(ws + WS_HM); bf16_t* XS = (bf16_t*)(ws + E_XS);
    LAS int* tot = (LAS int*)lds; LAS int* pre = tot + 8; LAS int* rb = tot + 16; LAS int* wcn = tot + 32; LAS int* sl = tot + 64;
    for (int tb = bid; tb < MTOK / 256; tb += G) {
        { int t_ = 0, p_ = 0;
#pragma unroll
            for (int j = 0; j < 4; ++j) { const int blk = lane + 64 * j; const int v = bcnt[blk * 8 + wave]; t_ += v; p_ += (blk < tb) ? v : 0; }
#pragma unroll
            for (int o = 1; o < 64; o <<= 1) { t_ += __shfl_xor(t_, o); p_ += __shfl_xor(p_, o); }
            if (lane == 0) { tot[wave] = t_; pre[wave] = p_; } }
        __syncthreads();
        if (tid == 0) { int acc = 0; for (int e = 0; e < 8; ++e) { rb[e] = acc * 256; if (tb == 0) ((int*)(ws + TB_TILES))[e] = acc; acc += (tot[e] + 255) >> 8; } if (tb == 0) ((int*)(ws + TB_TILES))[8] = acc; }
        int e0 = -1, e1 = -1; unsigned long long mk0 = 0, mk1 = 0;
        if (tid < 256) { e0 = eid[(tb * 256 + tid) * 2]; e1 = eid[(tb * 256 + tid) * 2 + 1];
#pragma unroll
            for (int e = 0; e < 8; ++e) { const unsigned long long m = __ballot(e0 == e || e1 == e); if (lane == 0) wcn[wave * 8 + e] = __popcll(m); if (e0 == e) mk0 = m; if (e1 == e) mk1 = m; } }
        __syncthreads();
        if (tid < 256) { const unsigned long long lt = (1ull << lane) - 1ull; int b0 = rb[e0] + pre[e0] + __popcll(mk0 & lt), b1 = rb[e1] + pre[e1] + __popcll(mk1 & lt);
            for (int w = 0; w < wave; ++w) { b0 += wcn[w * 8 + e0]; b1 += wcn[w * 8 + e1]; }
            sl[tid * 2] = b0; sl[tid * 2 + 1] = b1; slot[(tb * 256 + tid) * 2] = b0; slot[(tb * 256 + tid) * 2 + 1] = b1; }
        __syncthreads();
        for (int i = 0; i < 32; ++i) { const int t = wave * 32 + i; const int s0 = sl[t * 2], s1 = sl[t * 2 + 1];
            const bf16_t* src = HM + (size_t)(tb * 256 + t) * DM + lane * 16;
            const u32x4 a = *(const u32x4*)src, b = *(const u32x4*)(src + 8);
            const u32x4 q = {pk_fp8x4(bflo(a[0]), bfhi(a[0]), bflo(a[1]), bfhi(a[1])), pk_fp8x4(bflo(a[2]), bfhi(a[2]), bflo(a[3]), bfhi(a[3])),
                             pk_fp8x4(bflo(b[0]), bfhi(b[0]), bflo(b[1]), bfhi(b[1])), pk_fp8x4(bflo(b[2]), bfhi(b[2]), bflo(b[3]), bfhi(b[3]))};
            *(u32x4*)((unsigned char*)XS + (size_t)s0 * DM + lane * 16) = q; *(u32x4*)((unsigned char*)XS + (size_t)s1 * DM + lane * 16) = q; }
        __syncthreads();
    }
}

namespace att {
constexpr int KVBLK = 64;
#define SBAR() __builtin_amdgcn_sched_barrier(0)
typedef int v8i __attribute__((ext_vector_type(8)));
__device__ __forceinline__ int crow(int r, int hi) { return (r & 3) + 8 * (r >> 2) + 4 * hi; }
constexpr int SLOTB = 8192;
__device__ __forceinline__ int k_slot(int s) { return s * SLOTB; }
__device__ __forceinline__ int v_slot(int s) { return 65536 + s * SLOTB; }
__device__ __forceinline__ int kswz(int row) { return ((row & 7) ^ (row >> 4)) & 7; }
__device__ __forceinline__ int vswz(int row) { return (row >> 2) & 3; }
__device__ __forceinline__ void mfma8_acc(f32x16& acc, const v8i& a, const v8i& b, int sc) {
    asm volatile("s_nop 4\n\tv_mfma_scale_f32_32x32x64_f8f6f4 %0, %1, %2, %0, %3, %3 op_sel_hi:[0,0,0]" : "+v"(acc) : "v"(a), "v"(b), "v"(sc) : "memory");
}
__device__ __forceinline__ void mfma8_c(f32x16& d, const v8i& a, const v8i& b, const f32x16& c, int sa, int sb) {
    asm volatile("v_mfma_scale_f32_32x32x64_f8f6f4 %0, %1, %2, %3, %4, %5 op_sel_hi:[0,0,0]" : "=&v"(d) : "v"(a), "v"(b), "v"(c), "v"(sa), "v"(sb) : "memory");
}
#define ATT_LD8(p0_, p1_) __builtin_bit_cast(v8i, __builtin_shufflevector(*(const LAS u32x4*)(p0_), *(const LAS u32x4*)(p1_), 0, 1, 2, 3, 4, 5, 6, 7))
__device__ __forceinline__ void qkt(f32x16& p0, f32x16& p1, const LAS char* Ks, const v8i& qr, int r32, int hi, int jj, const f32x16& cinit, int s1, int s8) {
    const int c0 = jj * 4 + 2 * hi;
    { const int row = r32; const v8i kf = ATT_LD8(Ks + row * 128 + ((c0 ^ kswz(row)) << 4), Ks + row * 128 + (((c0 + 1) ^ kswz(row)) << 4)); mfma8_c(p0, kf, qr, cinit, s1, s8); }
    { const int row = 32 + r32; const v8i kf = ATT_LD8(Ks + row * 128 + ((c0 ^ kswz(row)) << 4), Ks + row * 128 + (((c0 + 1) ^ kswz(row)) << 4)); mfma8_c(p1, kf, qr, cinit, s1, s8); }
}
__device__ __forceinline__ void load_kf(v8i& kf0, v8i& kf1, const LAS char* Ks, int r32, int hi, int jj) {
    const int c0 = jj * 4 + 2 * hi, row1 = 32 + r32;
    kf0 = ATT_LD8(Ks + r32 * 128 + ((c0 ^ kswz(r32)) << 4), Ks + r32 * 128 + (((c0 + 1) ^ kswz(r32)) << 4));
    kf1 = ATT_LD8(Ks + row1 * 128 + ((c0 ^ kswz(row1)) << 4), Ks + row1 * 128 + (((c0 + 1) ^ kswz(row1)) << 4));
}
#define ATT_VFR(Vs, d0) ATT_LD8((Vs) + (32 * (d0) + r32) * 64 + (((2 * hi) ^ vswz(32 * (d0) + r32)) << 4), (Vs) + (32 * (d0) + r32) * 64 + (((2 * hi + 1) ^ vswz(32 * (d0) + r32)) << 4))
__device__ __forceinline__ void pack_p(const float (&pe)[32], v8i& pa);
__device__ __forceinline__ void qkt_pack(f32x16& p0, f32x16& p1, const v8i& kf0, const v8i& kf1, const v8i& qr, const f32x16& cinit, int s1, int s8, const float (&pe)[32], v8i& pa) {
#define ATT_MC8(d, kf, B, O0, O1, O2, O3) \
    asm volatile("v_mfma_scale_f32_32x32x64_f8f6f4 %0, %21, %22, %23, %24, %25 op_sel_hi:[0,0,0]\n\t" \
                 "v_cvt_pk_fp8_f32 %1, %5, %6\n\tv_cvt_pk_fp8_f32 %1, %7, %8 op_sel:[0,0,1]\n\t" \
                 "v_cvt_pk_fp8_f32 %2, %9, %10\n\tv_cvt_pk_fp8_f32 %2, %11, %12 op_sel:[0,0,1]\n\t" \
                 "v_cvt_pk_fp8_f32 %3, %13, %14\n\tv_cvt_pk_fp8_f32 %3, %15, %16 op_sel:[0,0,1]\n\t" \
                 "v_cvt_pk_fp8_f32 %4, %17, %18\n\tv_cvt_pk_fp8_f32 %4, %19, %20 op_sel:[0,0,1]" \
                 : "=&v"(d), "=&v"(O0), "=&v"(O1), "=&v"(O2), "=&v"(O3) \
                 : "v"(pe[B]), "v"(pe[B + 1]), "v"(pe[B + 2]), "v"(pe[B + 3]), "v"(pe[B + 4]), "v"(pe[B + 5]), "v"(pe[B + 6]), "v"(pe[B + 7]), \
                   "v"(pe[B + 8]), "v"(pe[B + 9]), "v"(pe[B + 10]), "v"(pe[B + 11]), "v"(pe[B + 12]), "v"(pe[B + 13]), "v"(pe[B + 14]), "v"(pe[B + 15]), \
                   "v"(kf), "v"(qr), "v"(cinit), "v"(s1), "v"(s8) : "memory")
    int q0, q1, q2, q3, q4, q5, q6, q7;
    ATT_MC8(p0, kf0, 0, q0, q1, q2, q3);
    ATT_MC8(p1, kf1, 16, q4, q5, q6, q7);
#undef ATT_MC8
    pa = (v8i){q0, q1, q2, q3, q4, q5, q6, q7};
}
__device__ __forceinline__ void partialSM(f32x16& p0) {
#pragma unroll
    for (int r = 0; r < 16; ++r) p0[r] = fexp2(p0[r]);
}
__device__ __forceinline__ void finishSM(f32x16& p0, f32x16& p1, v8i& pa) {
#pragma unroll
    for (int r = 0; r < 16; ++r) p1[r] = fexp2(p1[r]);
#pragma unroll
    for (int w = 0; w < 4; ++w) { pa[w] = (int)pk_fp8x4(p0[4 * w], p0[4 * w + 1], p0[4 * w + 2], p0[4 * w + 3]); pa[4 + w] = (int)pk_fp8x4(p1[4 * w], p1[4 * w + 1], p1[4 * w + 2], p1[4 * w + 3]); }
}
#define ATT_MX7(acc, a, b, sc, NOP, O, I, k) \
    asm volatile(NOP "v_mfma_scale_f32_32x32x64_f8f6f4 %0, %15, %16, %0, %17, %17 op_sel_hi:[0,0,0]\n\tv_exp_f32 %1, %8\n\tv_exp_f32 %2, %9\n\tv_exp_f32 %3, %10\n\tv_exp_f32 %4, %11\n\tv_exp_f32 %5, %12\n\tv_exp_f32 %6, %13\n\tv_exp_f32 %7, %14" \
                 : "+v"(acc), "=&v"(O[k]), "=&v"(O[k + 1]), "=&v"(O[k + 2]), "=&v"(O[k + 3]), "=&v"(O[k + 4]), "=&v"(O[k + 5]), "=&v"(O[k + 6]) \
                 : "v"(I(k)), "v"(I(k + 1)), "v"(I(k + 2)), "v"(I(k + 3)), "v"(I(k + 4)), "v"(I(k + 5)), "v"(I(k + 6)), "v"(a), "v"(b), "v"(sc) : "memory")
__device__ __forceinline__ void pv_exp_a(f32x16* o, const v8i& vf0, const v8i& vf1, const v8i& vf2, const v8i& pa, int s1, const f32x16& r0, const f32x16& r1, float (&pe)[32]) {
#define ATT_RI(k) (((k) < 16) ? r0[(k) & 15] : r1[(k) & 15])
    ATT_MX7(o[0], pa, vf0, s1, "s_nop 4\n\t", pe, ATT_RI, 0);
    ATT_MX7(o[1], pa, vf1, s1, "", pe, ATT_RI, 7);
    ATT_MX7(o[2], pa, vf2, s1, "", pe, ATT_RI, 14);
#undef ATT_RI
}
__device__ __forceinline__ void pv_exp_b(f32x16* o, f32x16& lacc, const v8i& ones, const v8i& vf3, const v8i& pa, int s1, const f32x16& r0, const f32x16& r1, float (&pe)[32]) {
#define ATT_RI(k) (((k) < 16) ? r0[(k) & 15] : r1[(k) & 15])
    ATT_MX7(o[3], pa, vf3, s1, "", pe, ATT_RI, 21);
    asm volatile("v_mfma_scale_f32_32x32x64_f8f6f4 %0, %9, %10, %0, %11, %11 op_sel_hi:[0,0,0]\n\tv_exp_f32 %1, %5\n\tv_exp_f32 %2, %6\n\tv_exp_f32 %3, %7\n\tv_exp_f32 %4, %8"
                 : "+v"(lacc), "=&v"(pe[28]), "=&v"(pe[29]), "=&v"(pe[30]), "=&v"(pe[31]) : "v"(r1[12]), "v"(r1[13]), "v"(r1[14]), "v"(r1[15]), "v"(pa), "v"(ones), "v"(s1) : "memory");
#undef ATT_RI
}
__device__ __forceinline__ void pack_p(const float (&pe)[32], v8i& pa) {
#pragma unroll
    for (int w = 0; w < 8; ++w) pa[w] = (int)pk_fp8x4(pe[4 * w], pe[4 * w + 1], pe[4 * w + 2], pe[4 * w + 3]);
}
__device__ __forceinline__ void pv_d0(f32x16* o, f32x16& lacc, const v8i& ones, const LAS char* Vs, const v8i& pa, int r32, int hi, int s1) {
#pragma unroll
    for (int d0 = 0; d0 < 4; ++d0) { const int row = 32 * d0 + r32;
        const v8i vf = ATT_LD8(Vs + row * 64 + (((2 * hi) ^ vswz(row)) << 4), Vs + row * 64 + (((2 * hi + 1) ^ vswz(row)) << 4));
        mfma8_acc(o[d0], pa, vf, s1); }
    mfma8_acc(lacc, pa, ones, s1);
}
__device__ __forceinline__ void pv_last(f32x16* o, f32x16& lacc, const v8i& ones, const v8i& vf0, const v8i& vf1, const v8i& vf2, const v8i& vf3, const v8i& pa, int s1) {
    mfma8_acc(o[0], pa, vf0, s1); mfma8_acc(o[1], pa, vf1, s1); mfma8_acc(o[2], pa, vf2, s1); mfma8_acc(o[3], pa, vf3, s1); mfma8_acc(lacc, pa, ones, s1);
}
}

__device__ __forceinline__ void vt_phase(const Args& A, int bid, int G) {
    const int tid = threadIdx.x; unsigned char* ws = A.ws;
    const bf16_t* V = (const bf16_t*)(ws + A_V); unsigned char* VT = ws + A_VT;
    const int dv = tid & 127, kq = tid >> 7, half = kq >> 1, hi = kq & 1;
    for (int it = bid; it < 64 * 128; it += G) {
        const int bh = it >> 7, tile = it & 127, b = bh >> 3, h = bh & 7;
        const bf16_t* vp = V + ((size_t)b * SEQ + tile * 64 + 32 * half) * DM + h * 128 + dv;
        float f[16];
#pragma unroll
        for (int i = 0; i < 16; ++i) f[i] = bf2f(vp[(size_t)att::crow(i, hi) * DM]);
        *(u32x4*)(VT + (((size_t)bh * 128 + tile) * 128 + dv) * 64 + hi * 32 + half * 16) =
            (u32x4){pk_fp8x4(f[0], f[1], f[2], f[3]), pk_fp8x4(f[4], f[5], f[6], f[7]), pk_fp8x4(f[8], f[9], f[10], f[11]), pk_fp8x4(f[12], f[13], f[14], f[15])};
    }
}

__device__ __forceinline__ void attn_phase(const Args& A, LAS unsigned char* ldsu, int bid, int G, int al) {
    using namespace att;
    LAS char* lds = (LAS char*)ldsu;
    unsigned char* ws = A.ws;
    const unsigned char* Qg = ws + A_Q; const unsigned char* Kg = ws + A_K; const unsigned char* VTg = ws + A_VT;
    bf16_t* Og = (bf16_t*)(ws + WS_HM);
    const float* scal = (const float*)(ws + TB_SCAL);
    const float lamv = scal[SC_LAM0 + al], omli = scal[SC_OML0 + al], Mc = scal[SC_MC0 + al] - 7.5f;
    const float* subg = A.in[I_ATSUB] + al * 128;
    int tid_ = threadIdx.x; asm volatile("" : "+v"(tid_));
    const int tid = tid_, wid = __builtin_amdgcn_readfirstlane(tid >> 6), lane = tid & 63, r32 = lane & 31, hi = lane >> 5, jj = wid >> 2, wq = wid & 3;
    constexpr int NT = SEQ / KVBLK;
    int s1 = 0x7f7f7f7f, s8 = 0x7c7c7c7c; asm volatile("" : "+v"(s1), "+v"(s8));
    v8i ones; { int o1 = 0x38383838; asm volatile("" : "+v"(o1)); ones = (v8i){o1, o1, o1, o1, o1, o1, o1, o1}; }
    f32x16 cinit;
#pragma unroll
    for (int r = 0; r < 16; ++r) cinit[r] = -Mc;
    unsigned koff, voff;
    { const int bb = wid * 1024 + lane * 16;
      { const int row = bb >> 7, c = ((bb & 127) >> 4) ^ kswz(row); koff = (unsigned)(row * 1024 + c * 16); }
      { const int row = bb >> 6, c = ((bb & 63) >> 4) ^ vswz(row); voff = (unsigned)(row * 64 + c * 16); } }
    const unsigned ldsw = (unsigned)wid * 1024u;
    const __amdgpu_buffer_rsrc_t rK = __builtin_amdgcn_make_buffer_rsrc((void*)Kg, (short)0, 0x7fffffff, 0x00020000);
    const __amdgpu_buffer_rsrc_t rV = __builtin_amdgcn_make_buffer_rsrc((void*)VTg, (short)0, 0x7fffffff, 0x00020000);
#define ATT_DMA(slot, kt, vt) do { \
        __builtin_amdgcn_raw_ptr_buffer_load_lds(rK, (LAS void*)(lds + k_slot(slot) + ldsw), 16, (int)koff, (int)(kt), 0, 0); \
        __builtin_amdgcn_raw_ptr_buffer_load_lds(rV, (LAS void*)(lds + v_slot(slot) + ldsw), 16, (int)voff, (int)(vt), 0, 0); } while (0)
#define ATT_TOP() do { asm volatile("s_waitcnt vmcnt(2)" ::: "memory"); __builtin_amdgcn_s_barrier(); asm volatile("" ::: "memory"); } while (0)
    const int xq = bid & 7, cq = bid >> 3;
    int cbh = xq * 8;
    const bool lag = (jj != 0);
#define ATT_KB(bh_) ((unsigned)(((bh_) >> 3) * SEQ) * (unsigned)DM + (unsigned)((bh_) & 7) * 128u)
#define ATT_VB(bh_) ((unsigned)(bh_) * (128u * 8192u))
    ATT_DMA(0, ATT_KB(cbh), ATT_VB(cbh)); ATT_DMA(1, ATT_KB(cbh) + 64u * DM, ATT_VB(cbh) + 8192u);
    int ofKa, ofKb, ofV, ofKax, ofKbx, ofVx;
    { const int c0 = jj * 4 + 2 * hi, lb = (int)(unsigned)(size_t)lds;
      ofKa = r32 * 128 + ((c0 ^ kswz(r32)) << 4); ofKb = (32 + r32) * 128 + ((c0 ^ kswz(32 + r32)) << 4); ofV = 65536 + r32 * 64 + (((2 * hi) ^ vswz(r32)) << 4);
      ofKax = lb + (ofKa ^ 16); ofKbx = lb + (ofKb ^ 16); ofVx = lb + (ofV ^ 16); ofKa += lb; ofKb += lb; ofV += lb; }
#define ATT_QLOAD(dst, bh_, qb_) do { const unsigned char* Qw_ = Qg + ((size_t)((bh_) >> 3) * SEQ + (qb_) * 128) * DM + ((bh_) & 7) * 128 + (size_t)(wq * 32 + r32) * DM + jj * 64 + hi * 32; \
        const u32x4 qa_ = *(const u32x4*)Qw_, qb2_ = *(const u32x4*)(Qw_ + 16); dst = __builtin_bit_cast(v8i, __builtin_shufflevector(qa_, qb2_, 0, 1, 2, 3, 4, 5, 6, 7)); } while (0)
    v8i qnext; ATT_QLOAD(qnext, cbh, cq);
    for (int ui = 0; ui < 16; ++ui) {
        const int qb = (ui & 1) * 32 + cq;
        const int nbh = (ui + 1 < 16) ? xq * 8 + ((ui + 1) >> 1) : cbh;
        const unsigned Kh = ATT_KB(cbh), Vh = ATT_VB(cbh), nK = ATT_KB(nbh), nV = ATT_VB(nbh);
        const size_t obase = ((size_t)(cbh >> 3) * SEQ + qb * 128) * DM + (cbh & 7) * 128;
        f32x16 lacc = {}; f32x16 o[4] = {}; const v8i qr = qnext;
        f32x16 pA0, pA1; v8i pa, kf0, kf1, vf0, vf1, vf2, vf3;
        unsigned kptr = Kh + 2u * 64u * DM, vptr = Vh + 2u * 8192u;
#define ATT_ISSUE(SLD, last) do { asm volatile("" : "+s"(kptr), "+s"(vptr)); ATT_DMA(SLD, kptr, vptr); if (last) { kptr = nK; vptr = nV; } else { kptr += 64u * DM; vptr += 8192u; } } while (0)
#define ATT_RD8(b_, bx_, imm_) ATT_LD8((const LAS char*)(unsigned)((b_) + (imm_)), (const LAS char*)(unsigned)((bx_) + (imm_)))
#define ATT_FIX() asm volatile("" : "+v"(ofKa), "+v"(ofKax), "+v"(ofKb), "+v"(ofKbx), "+v"(ofV), "+v"(ofVx))
#define ATT_STEPC(LAST, SL, SLP, SLD) do { \
            ATT_FIX(); \
            kf0 = ATT_RD8(ofKa, ofKax, (SL) * SLOTB); kf1 = ATT_RD8(ofKb, ofKbx, (SL) * SLOTB); vf0 = ATT_RD8(ofV, ofVx, (SLP) * SLOTB); vf1 = ATT_RD8(ofV, ofVx, (SLP) * SLOTB + 2048); \
            ATT_ISSUE(SLD, LAST); \
            ATT_TOP(); \
            qkt_pack(pA0, pA1, kf0, kf1, qr, cinit, s1, s8, pe, pa); \
            vf2 = ATT_RD8(ofV, ofVx, (SLP) * SLOTB + 4096); vf3 = ATT_RD8(ofV, ofVx, (SLP) * SLOTB + 6144); \
            pv_exp_a(o, vf0, vf1, vf2, pa, s1, pA0, pA1, pe); \
            ATT_TOP(); \
            pv_exp_b(o, lacc, ones, vf3, pa, s1, pA0, pA1, pe); } while (0)
        float pe[32];
        if (lag) ATT_TOP();
        ATT_TOP();
        ATT_FIX(); kf0 = ATT_RD8(ofKa, ofKax, 0); kf1 = ATT_RD8(ofKb, ofKbx, 0); ATT_ISSUE(2, false);
        ATT_TOP();
        { mfma8_c(pA0, kf0, qr, cinit, s1, s8); mfma8_c(pA1, kf1, qr, cinit, s1, s8);
          asm volatile("s_nop 15\n\ts_nop 15" ::: "memory");
#pragma unroll
          for (int r = 0; r < 16; ++r) pe[r] = fexp2(pA0[r]);
#pragma unroll
          for (int r = 0; r < 16; ++r) pe[16 + r] = fexp2(pA1[r]); }
        ATT_TOP();
        ATT_STEPC(false, 1, 0, 3); ATT_STEPC(false, 2, 1, 4); ATT_STEPC(false, 3, 2, 5); ATT_STEPC(false, 4, 3, 6); ATT_STEPC(false, 5, 4, 7); ATT_STEPC(false, 6, 5, 0); ATT_STEPC(false, 7, 6, 1);
        for (int kb = 8; kb < NT; kb += 8) {
            ATT_STEPC(false, 0, 7, 2); ATT_STEPC(false, 1, 0, 3); ATT_STEPC(false, 2, 1, 4); ATT_STEPC(false, 3, 2, 5);
            ATT_STEPC(false, 4, 3, 6); ATT_STEPC(kb == NT - 8, 5, 4, 7); ATT_STEPC(false, 6, 5, 0); ATT_STEPC(false, 7, 6, 1);
        }
        ATT_FIX();
        vf0 = ATT_RD8(ofV, ofVx, 7 * SLOTB); vf1 = ATT_RD8(ofV, ofVx, 7 * SLOTB + 2048);
        ATT_TOP();
        { vf2 = ATT_RD8(ofV, ofVx, 7 * SLOTB + 4096); vf3 = ATT_RD8(ofV, ofVx, 7 * SLOTB + 6144);
          pack_p(pe, pa); SBAR();
          pv_last(o, lacc, ones, vf0, vf1, vf2, vf3, pa, s1);
          asm volatile("s_nop 15\n\ts_nop 15" ::: "memory"); }
        if (!lag) ATT_TOP();
        if (ui + 1 < 16) ATT_QLOAD(qnext, nbh, ((ui + 1) & 1) * 32 + cq);
#undef ATT_ISSUE
#undef ATT_STEPC
#undef ATT_RD8
#undef ATT_FIX
        int r32e = r32, hie = hi; asm volatile("" : "+v"(r32e), "+v"(hie));
        float rli[16];
#pragma unroll
        for (int r = 0; r < 16; ++r) rli[r] = frcp(lacc[r]);
        asm volatile("s_waitcnt lgkmcnt(0)" ::: "memory"); __builtin_amdgcn_s_barrier(); asm volatile("" ::: "memory");
        LAS float* Cb = (LAS float*)(lds + ((wq < 2) ? 3 * SLOTB : 65536 + 3 * SLOTB - 64 * 512));
        if (jj == 1) {
#pragma unroll
            for (int r = 0; r < 16; ++r) { const float sc = rli[r] * lamv;
#pragma unroll
                for (int d0 = 0; d0 < 4; ++d0) Cb[(wq * 32 + crow(r, hie)) * 128 + d0 * 32 + r32e] = o[d0][r] * sc; }
        }
        asm volatile("s_waitcnt lgkmcnt(0)" ::: "memory"); __builtin_amdgcn_s_barrier(); asm volatile("" ::: "memory");
        if (jj == 0) {
            float g[4];
#pragma unroll
            for (int d0 = 0; d0 < 4; ++d0) g[d0] = subg[d0 * 32 + r32e] * omli;
            bf16_t* Ob = Og + obase;
#pragma unroll
            for (int r = 0; r < 16; ++r) {
                float ss = 0.f;
#pragma unroll
                for (int d0 = 0; d0 < 4; ++d0) { const float v = o[d0][r] * rli[r] - Cb[(wq * 32 + crow(r, hie)) * 128 + d0 * 32 + r32e]; o[d0][r] = v; ss += v * v; }
                ss += __shfl_xor(ss, 1); ss += __shfl_xor(ss, 2); ss += __shfl_xor(ss, 4); ss += __shfl_xor(ss, 8); ss += __shfl_xor(ss, 16);
                const float rs = 1.0f / sqrtf(ss * (1.0f / 128.0f) + EPS);
                bf16_t* op = Ob + (size_t)(wq * 32 + crow(r, hie)) * DM + r32e;
#pragma unroll
                for (int d0 = 0; d0 < 4; ++d0) op[d0 * 32] = (bf16_t)f2bf(o[d0][r] * rs * g[d0]);
            }
        }
        asm volatile("s_waitcnt lgkmcnt(0)" ::: "memory"); __builtin_amdgcn_s_barrier(); asm volatile("" ::: "memory");
        cbh = nbh;
    }
    asm volatile("s_waitcnt vmcnt(0) lgkmcnt(0)" ::: "memory"); __builtin_amdgcn_s_barrier(); asm volatile("" ::: "memory");
#undef ATT_DMA
#undef ATT_TOP
#undef ATT_QLOAD
#undef ATT_KB
#undef ATT_VB
#undef ATT_LD8
}

namespace gla {
constexpr int BC = 0, QI = 32768, QA = 49152, KA = 65536, KST = 81920, VT = 98304, ST = 106496, AT = 122880, EM = 131072, EL = EM + 512, DD = EM + 1024, BMID = EM + 1536, SEG = EM + 2048;
static_assert(SEG + 2048 <= RING_BYTES, "gla lds");
__device__ __forceinline__ int sw256(int row, int cb) { return row * 256 + (cb ^ ((row & 15) << 4)); }
__device__ __forceinline__ int sw128(int row, int cb) { return row * 128 + (cb ^ ((((row & 7) ^ (row >> 4)) & 7) << 4)); }
__device__ __forceinline__ int crow(int r, int hi) { return (r & 3) + 8 * (r >> 2) + 4 * hi; }
__device__ __forceinline__ float h2f(unsigned short b) { return (float)__builtin_bit_cast(_Float16, b); }
__device__ __forceinline__ void gla_item(const bf16_t* __restrict__ Qp, const unsigned short* __restrict__ LFp, const bf16_t* __restrict__ Vp, bf16_t* __restrict__ Op, int dir, LAS unsigned char* lds, float* dbg) {
    int tid_ = threadIdx.x; asm volatile("" : "+v"(tid_));
    const int tid = tid_, wid = tid >> 6, lane = tid & 63, r = lane & 31, hh = lane >> 5;
    const int t1 = tid >> 3, kg = tid & 7, k0 = 16 * kg, v0 = (tid & 7) * 8;
    for (int i = tid; i < 16384 / 16; i += NTHR) *(LAS u32x4*)(lds + ST + i * 16) = (u32x4){0u, 0u, 0u, 0u};
    f32x16 st = {};
    u32x4 rq[2], rl[2], rv;
#define GLA_TOK(ci, i) (dir ? (SEQ - 1 - ((ci) * 64 + (i))) : ((ci) * 64 + (i)))
#define GLA_LOAD(ci) do { const size_t to = (size_t)GLA_TOK(ci, t1) * DM; \
        rq[0] = *(const u32x4*)(Qp + to + k0); rq[1] = *(const u32x4*)(Qp + to + k0 + 8); \
        rl[0] = *(const u32x4*)(LFp + to + k0); rl[1] = *(const u32x4*)(LFp + to + k0 + 8); rv = *(const u32x4*)(Vp + to + v0); } while (0)
    GLA_LOAD(0);
    __syncthreads();
    for (int ci = 0; ci < SEQ / 64; ++ci) {
        float qf[16], lf[16]; u32x4 vreg = rv;
#pragma unroll
        for (int j = 0; j < 2; ++j)
#pragma unroll
            for (int e = 0; e < 4; ++e) { qf[j * 8 + 2 * e] = bflo(rq[j][e]); qf[j * 8 + 2 * e + 1] = bfhi(rq[j][e]);
                lf[j * 8 + 2 * e] = h2f((unsigned short)(rl[j][e] & 0xffffu)); lf[j * 8 + 2 * e + 1] = h2f((unsigned short)(rl[j][e] >> 16)); }
        if (ci + 1 < SEQ / 64) GLA_LOAD(ci + 1);
#pragma unroll
        for (int j = 0; j < 4; ++j) *(LAS f32x4*)(lds + BC + (t1 * 128 + k0 + 4 * j) * 4) = (f32x4){lf[4 * j], lf[4 * j + 1], lf[4 * j + 2], lf[4 * j + 3]};
        __syncthreads();
        { const int kc = tid & 127, sg = tid >> 7; LAS float* bc = (LAS float*)(lds + BC) + kc; float cs[16];
#pragma unroll
            for (int i = 0; i < 16; ++i) cs[i] = bc[(sg * 16 + i) * 128];
#pragma unroll
            for (int i = 1; i < 16; ++i) cs[i] += cs[i - 1];
            ((LAS float*)(lds + SEG))[sg * 128 + kc] = cs[15];
            __syncthreads();
            const LAS float* sgp = (const LAS float*)(lds + SEG) + kc; const float s0 = sgp[0], s1 = sgp[128], s2 = sgp[256], s3 = sgp[384];
            const float off = sg == 0 ? 0.f : sg == 1 ? s0 : sg == 2 ? (s0 + s1) : ((s0 + s1) + s2);
#pragma unroll
            for (int i = 0; i < 16; ++i) bc[(sg * 16 + i) * 128] = cs[i] + off;
            if (sg == 0) { const float bm = s0 + s1, bl = ((s0 + s1) + s2) + s3;
                ((LAS float*)(lds + BMID))[kc] = bm; ((LAS float*)(lds + EM))[kc] = fexp(bm); ((LAS float*)(lds + EL))[kc] = fexp(bl - bm); ((LAS float*)(lds + DD))[kc] = fexp(bl); }
            __syncthreads();
        }
#ifdef DIAG
        if (dbg && ci == 0) { for (int i = tid; i < 8192; i += NTHR) dbg[i] = ((const LAS float*)(lds + BC))[i]; }
#endif
        {
            unsigned wqi[8], wqa[8], wka[8]; float ksv[16];
#pragma unroll
            for (int j = 0; j < 4; ++j) {
                const f32x4 bt = *(const LAS f32x4*)(lds + BC + (t1 * 128 + k0 + 4 * j) * 4), bm = *(const LAS f32x4*)(lds + BMID + (k0 + 4 * j) * 4);
                const f32x4 em = *(const LAS f32x4*)(lds + EM + (k0 + 4 * j) * 4), el = *(const LAS f32x4*)(lds + EL + (k0 + 4 * j) * 4);
                float qi[4], qa[4], ka[4];
#pragma unroll
                for (int e = 0; e < 4; ++e) { const int i = 4 * j + e; const float e1 = fexp(bt[e] - bm[e]), r1 = frcp(e1);
                    qa[e] = qf[i] * e1; qi[e] = qa[e] * em[e]; const float kk = 1.0f - fexp(lf[i]); ka[e] = kk * r1; ksv[i] = ka[e] * el[e]; }
                wqi[2 * j] = cvt_pk_bf16(qi[0], qi[1]); wqi[2 * j + 1] = cvt_pk_bf16(qi[2], qi[3]);
                wqa[2 * j] = cvt_pk_bf16(qa[0], qa[1]); wqa[2 * j + 1] = cvt_pk_bf16(qa[2], qa[3]);
                wka[2 * j] = cvt_pk_bf16(ka[0], ka[1]); wka[2 * j + 1] = cvt_pk_bf16(ka[2], ka[3]);
            }
#pragma unroll
            for (int j = 0; j < 2; ++j) { const int off = sw256(t1, (k0 + 8 * j) * 2);
                *(LAS u32x4*)(lds + QI + off) = (u32x4){wqi[4 * j], wqi[4 * j + 1], wqi[4 * j + 2], wqi[4 * j + 3]};
                *(LAS u32x4*)(lds + QA + off) = (u32x4){wqa[4 * j], wqa[4 * j + 1], wqa[4 * j + 2], wqa[4 * j + 3]};
                *(LAS u32x4*)(lds + KA + off) = (u32x4){wka[4 * j], wka[4 * j + 1], wka[4 * j + 2], wka[4 * j + 3]}; }
#pragma unroll
            for (int i = 0; i < 16; ++i) *(LAS unsigned short*)(lds + KST + sw128(k0 + i, t1 * 2)) = (unsigned short)f2bf(ksv[i]);
#pragma unroll
            for (int e = 0; e < 4; ++e) { *(LAS unsigned short*)(lds + VT + sw128(v0 + 2 * e, t1 * 2)) = (unsigned short)(vreg[e] & 0xffffu);
                *(LAS unsigned short*)(lds + VT + sw128(v0 + 2 * e + 1, t1 * 2)) = (unsigned short)(vreg[e] >> 16); }
        }
        __syncthreads();
        f32x16 oacc = {};
        const int w4 = wid & 3, t_i = w4 >> 1, v_i = w4 & 1;
        if (wid < 4) {
            const int s_i = wid >> 1, tq = wid & 1; f32x16 a = {};
#pragma unroll
            for (int ks = 0; ks < 8; ++ks) { const bf16x8 fa = *(const LAS bf16x8*)(lds + KA + sw256(32 * s_i + r, (16 * ks + 8 * hh) * 2)), fb = *(const LAS bf16x8*)(lds + QA + sw256(32 * tq + r, (16 * ks + 8 * hh) * 2));
                a = __builtin_amdgcn_mfma_f32_32x32x16_bf16(fa, fb, a, 0, 0, 0); }
            const int tg = 32 * tq + r;
#pragma unroll
            for (int g = 0; g < 4; ++g) { float m[4];
#pragma unroll
                for (int e = 0; e < 4; ++e) { const int sgl = 32 * s_i + 8 * g + 4 * hh + e; m[e] = (sgl <= tg) ? a[4 * g + e] : 0.f; }
                *(LAS u32x2*)(lds + AT + sw128(tg, (32 * s_i + 8 * g + 4 * hh) * 2)) = (u32x2){cvt_pk_bf16(m[0], m[1]), cvt_pk_bf16(m[2], m[3])}; }
        } else {
#pragma unroll
            for (int ks = 0; ks < 8; ++ks) { const bf16x8 fa = *(const LAS bf16x8*)(lds + QI + sw256(32 * t_i + r, (16 * ks + 8 * hh) * 2)), fb = *(const LAS bf16x8*)(lds + ST + sw256(32 * v_i + r, (16 * ks + 8 * hh) * 2));
                oacc = __builtin_amdgcn_mfma_f32_32x32x16_bf16(fa, fb, oacc, 0, 0, 0); }
        }
        __syncthreads();
#ifdef DIAG
        if (dbg && ci == 0) { for (int i = tid; i < 2048; i += NTHR) { ((unsigned*)dbg)[8192 + i] = ((const LAS unsigned*)(lds + AT))[i]; ((unsigned*)dbg)[8192 + 2048 + i] = ((const LAS unsigned*)(lds + VT))[i]; } }
#endif
        if (wid >= 4) {
#pragma unroll
            for (int ks = 0; ks < 4; ++ks) { const bf16x8 fa = *(const LAS bf16x8*)(lds + AT + sw128(32 * t_i + r, (16 * ks + 8 * hh) * 2)), fb = *(const LAS bf16x8*)(lds + VT + sw128(32 * v_i + r, (16 * ks + 8 * hh) * 2));
                oacc = __builtin_amdgcn_mfma_f32_32x32x16_bf16(fa, fb, oacc, 0, 0, 0); }
#pragma unroll
            for (int i = 0; i < 16; ++i) { const int t = 32 * t_i + crow(i, hh); Op[(size_t)GLA_TOK(ci, t) * DM + 32 * v_i + r] = (bf16_t)f2bf(oacc[i]); }
        }
        {
            const int kq = wid >> 1, vq = wid & 1;
#pragma unroll
            for (int i = 0; i < 16; ++i) st[i] *= ((const LAS float*)(lds + DD))[32 * kq + crow(i, hh)];
#pragma unroll
            for (int ks = 0; ks < 4; ++ks) { const bf16x8 fa = *(const LAS bf16x8*)(lds + KST + sw128(32 * kq + r, (16 * ks + 8 * hh) * 2)), fb = *(const LAS bf16x8*)(lds + VT + sw128(32 * vq + r, (16 * ks + 8 * hh) * 2));
                st = __builtin_amdgcn_mfma_f32_32x32x16_bf16(fa, fb, st, 0, 0, 0); }
#pragma unroll
            for (int g = 0; g < 4; ++g) *(LAS u32x2*)(lds + ST + sw256(32 * vq + r, (32 * kq + 8 * g + 4 * hh) * 2)) = (u32x2){cvt_pk_bf16(st[4 * g], st[4 * g + 1]), cvt_pk_bf16(st[4 * g + 2], st[4 * g + 3])};
        }
        __syncthreads();
#ifdef DIAG
        if (dbg && ci == 0) { for (int i = tid; i < 4096; i += NTHR) { ((unsigned*)dbg)[12288 + i] = ((const LAS unsigned*)(lds + ST))[i]; ((unsigned*)dbg)[16384 + i] = ((const LAS unsigned*)(lds + KST))[i]; } }
#endif
    }
#undef GLA_TOK
#undef GLA_LOAD
}
}
__device__ __forceinline__ void gla_phase(const Args& A, LAS unsigned char* lds, int bid, int G) {
    unsigned char* ws = A.ws;
    for (int it = bid; it < 256; it += G) {
        const int b = it >> 5, h = (it >> 2) & 7, dir = (it >> 1) & 1, vh = it & 1;
        const size_t base = (size_t)b * SEQ * DM + h * 128;
        gla::gla_item((const bf16_t*)(ws + H_Q) + base, (const unsigned short*)(ws + (dir ? H_LFB : H_LFF)) + base, (const bf16_t*)(ws + H_V) + base + vh * 64,
                      (bf16_t*)(ws + (dir ? H_OB : H_OF)) + base + vh * 64, dir, lds, it == 0 ? (float*)(ws + TB_LSUM) : nullptr);
    }
}
__device__ __forceinline__ void hg_normo_phase(const Args& A, int bid, int G) {
    int tid_ = threadIdx.x; asm volatile("" : "+v"(tid_));
    const int tid = tid_, lane = tid & 63, wave = tid >> 6; unsigned char* ws = A.ws;
    const bf16_t* OF = (const bf16_t*)(ws + H_OF); const bf16_t* OB = (const bf16_t*)(ws + H_OB); const bf16_t* GG = (const bf16_t*)(ws + H_G); bf16_t* HM = (bf16_t*)(ws + WS_HM);
    const int c0 = (lane >> 3) * 128 + (lane & 7) * 16;
    float ng[16];
#pragma unroll
    for (int i = 0; i < 16; ++i) ng[i] = A.in[I_HGNG][(lane & 7) * 16 + i];
    for (int row = (bid * NWAVES + wave); row < MTOK; row += G * NWAVES) {
        const size_t o = (size_t)row * DM + c0;
        const u32x4 a0 = *(const u32x4*)(OF + o), a1 = *(const u32x4*)(OF + o + 8), b0 = *(const u32x4*)(OB + o), b1 = *(const u32x4*)(OB + o + 8), g0 = *(const u32x4*)(GG + o), g1 = *(const u32x4*)(GG + o + 8);
        float v[16], gt[16]; float ss = 0.f;
#pragma unroll
        for (int e = 0; e < 4; ++e) { v[2 * e] = bflo(a0[e]) + bflo(b0[e]); v[2 * e + 1] = bfhi(a0[e]) + bfhi(b0[e]); v[8 + 2 * e] = bflo(a1[e]) + bflo(b1[e]); v[8 + 2 * e + 1] = bfhi(a1[e]) + bfhi(b1[e]);
            gt[2 * e] = bflo(g0[e]); gt[2 * e + 1] = bfhi(g0[e]); gt[8 + 2 * e] = bflo(g1[e]); gt[8 + 2 * e + 1] = bfhi(g1[e]); }
#pragma unroll
        for (int i = 0; i < 16; ++i) ss += v[i] * v[i];
        ss += __shfl_xor(ss, 1); ss += __shfl_xor(ss, 2); ss += __shfl_xor(ss, 4);
        const float rstd = 1.0f / sqrtf(ss * (1.0f / 128.0f) + EPS);
        u32x4 w0, w1;
#pragma unroll
        for (int e = 0; e < 4; ++e) { w0[e] = cvt_pk_bf16(v[2 * e] * rstd * ng[2 * e] * gt[2 * e], v[2 * e + 1] * rstd * ng[2 * e + 1] * gt[2 * e + 1]);
            w1[e] = cvt_pk_bf16(v[8 + 2 * e] * rstd * ng[8 + 2 * e] * gt[8 + 2 * e], v[8 + 2 * e + 1] * rstd * ng[8 + 2 * e + 1] * gt[8 + 2 * e + 1]); }
        *(u32x4*)(HM + o) = w0; *(u32x4*)(HM + o + 8) = w1;
    }
}

#ifdef DIAG
constexpr int DG_BASE = 8192;
__device__ __forceinline__ void dg_put(const Args& A, int k, float e) { if (!(e >= 0.f) || e > 1e9f) e = 1e9f; atomicMax((unsigned*)(A.ws + WS_CTL) + DG_BASE + 64 * k, __float_as_uint(e)); }
__device__ __forceinline__ float dg_rel(float got, float ref) { return fabsf(got - ref) / (fabsf(ref) + 0.1f); }
__device__ __forceinline__ unsigned dg_hash(unsigned a, unsigned b) { unsigned h = a * 2654435761u + b * 40503u + 0x9e3779b9u; h ^= h >> 15; h *= 2246822519u; h ^= h >> 13; h *= 3266489917u; h ^= h >> 16; return h; }
__device__ __forceinline__ float dg_bfr(float x) { return bflo(f2bf(x)); }
__device__ __forceinline__ void dg_mods(const Args& A, int k) {
    const int lane = threadIdx.x & 63, gwv = blockIdx.x * 8 + (threadIdx.x >> 6);
    const unsigned h = dg_hash(gwv, k); const int l = h & 3, b = (h >> 2) & 7, e = (h >> 5) % 6144;
    float a = 0.f; for (int d = lane; d < DM; d += 64) a += fsilu(A.in[I_C][b * DM + d]) * A.in[I_ADAW][((size_t)l * DM + d) * 6144 + e];
    a = wave_sum(a) + A.in[I_ADAB][l * 6144 + e];
    const float got = ((const float*)(A.ws + TB_MODS))[((size_t)l * NBATCH + b) * 6144 + e];
    if (lane == 0) dg_put(A, k, dg_rel(got, a));
}
__device__ __forceinline__ void dg_norm(const Args& A, int k, const float* x, const float* gain, int L, int which) {
    const int lane = threadIdx.x & 63, gwv = blockIdx.x * 8 + (threadIdx.x >> 6);
    const int row = dg_hash(gwv, k) & (MTOK - 1), b = row >> 13;
    const float* modl = (const float*)(A.ws + TB_MODS) + ((size_t)L * NBATCH + b) * 6144;
    float ss = 0.f; for (int c = lane; c < DM; c += 64) { const float v = x[(size_t)row * DM + c]; ss += v * v; }
    ss = wave_sum(ss); const float rstd = 1.0f / sqrtf(ss / DM + EPS); float e = 0.f;
    for (int c = lane; c < DM; c += 64) { const float ref = x[(size_t)row * DM + c] * rstd * gain[c] * (1.0f + modl[(which * 3 + 1) * 1024 + c]) + modl[(which * 3) * 1024 + c];
        e = fmaxf(e, dg_rel(bf2f(((const bf16_t*)(A.ws + WS_HM))[(size_t)row * DM + c]), ref)); }
    dg_put(A, k, e);
}
__device__ __forceinline__ void dg_qkv(const Args& A, int k, int al) {
    const int lane = threadIdx.x & 63, gwv = blockIdx.x * 8 + (threadIdx.x >> 6);
    const unsigned h = dg_hash(gwv, k); const int row = h & (MTOK - 1), t = (h >> 16) % 48, col = t * 64 + lane;
    const bf16_t* hm = (const bf16_t*)(A.ws + WS_HM) + (size_t)row * DM; const float* w = A.in[I_ATWIN] + (size_t)al * 1024 * 3072 + col;
    float a = 0.f; for (int kk = 0; kk < DM; ++kk) a += bf2f(hm[kk]) * dg_bfr(w[(size_t)kk * 3072]);
    float ref, got;
    if (t < 32) {
        const int part = t >> 4, sh = t & 15; const float ss = wave_sum(a * a); const float rstd = 1.0f / sqrtf(ss / 64.0f + EPS);
        const float y = a * rstd * (part ? A.in[I_ATKN] : A.in[I_ATQN])[al * 64 + lane]; const float yp = __shfl_xor(y, 32);
        const int pos = row & (SEQ - 1); const float cs = ((const float*)(A.ws + TB_COS))[pos * 32 + (lane & 31)], sn = ((const float*)(A.ws + TB_SIN))[pos * 32 + (lane & 31)];
        ref = (lane < 32) ? (y * cs - yp * sn) : (y * cs + yp * sn); if (part == 0) ref *= 0.125f * LOG2E;
        got = bf2f(((const bf16_t*)(A.ws + (part ? A_K : A_Q)))[(size_t)row * DM + sh * 64 + lane]);
    } else { ref = a; got = bf2f(((const bf16_t*)(A.ws + A_V))[(size_t)row * DM + (t - 32) * 64 + lane]); }
    dg_put(A, k, dg_rel(got, ref));
}
__device__ __forceinline__ void dg_attn(const Args& A, int k, int al, LAS unsigned char* lds) {
    const int tid = threadIdx.x; const unsigned h = dg_hash(blockIdx.x, k); const int row = h & (MTOK - 1), hd = (h >> 16) & 7, b = row >> 13;
    const bf16_t* Q = (const bf16_t*)(A.ws + A_Q); const bf16_t* K = (const bf16_t*)(A.ws + A_K); const bf16_t* V = (const bf16_t*)(A.ws + A_V);
    const float* scal = (const float*)(A.ws + TB_SCAL); const float lamv = scal[SC_LAM0 + al], omli = scal[SC_OML0 + al], Mc = scal[SC_MC0 + al];
    LAS float* p0 = (LAS float*)lds; LAS float* p1 = p0 + SEQ; LAS float* red = p1 + SEQ;
    float l0 = 0.f, l1 = 0.f;
    for (int key = tid; key < SEQ; key += NTHR) { const bf16_t* kr = K + ((size_t)b * SEQ + key) * DM + hd * 128; const bf16_t* qr = Q + (size_t)row * DM + hd * 128;
        float s0 = 0.f, s1 = 0.f; for (int d = 0; d < 64; ++d) { s0 += bf2f(qr[d]) * bf2f(kr[d]); s1 += bf2f(qr[64 + d]) * bf2f(kr[64 + d]); }
        const float e0 = fexp2(s0 - Mc), e1 = fexp2(s1 - Mc); p0[key] = e0; p1[key] = e1; l0 += e0; l1 += e1; }
    l0 = wave_sum(l0); l1 = wave_sum(l1); if ((tid & 63) == 0) { red[tid >> 6] = l0; red[8 + (tid >> 6)] = l1; }
    __syncthreads();
    l0 = 0.f; l1 = 0.f; for (int w = 0; w < 8; ++w) { l0 += red[w]; l1 += red[8 + w]; }
    __syncthreads();
    const int dv = tid & 127, part = tid >> 7; float o = 0.f;
    for (int key = part * 2048; key < part * 2048 + 2048; ++key) o += (p0[key] / l0 - lamv * p1[key] / l1) * bf2f(V[((size_t)b * SEQ + key) * DM + hd * 128 + dv]);
    red[16 + part * 128 + dv] = o; __syncthreads();
    if (tid < 128) { o = red[16 + tid] + red[16 + 128 + tid] + red[16 + 256 + tid] + red[16 + 384 + tid]; red[600 + tid] = o * o; }
    __syncthreads();
    if (tid < 128) { float ss = 0.f; for (int i = 0; i < 128; ++i) ss += red[600 + i]; const float ref = o / sqrtf(ss / 128.0f + EPS) * A.in[I_ATSUB][al * 128 + tid] * omli;
        dg_put(A, k, dg_rel(bf2f(((const bf16_t*)(A.ws + WS_HM))[(size_t)row * DM + hd * 128 + tid]), ref)); }
    __syncthreads();
}
__device__ __forceinline__ void dg_save(const Args& A, int k, const float* xold) {
    const int lane = threadIdx.x & 63, gwv = blockIdx.x * 8 + (threadIdx.x >> 6);
    const unsigned h = dg_hash(gwv, k); const int row = h & (MTOK - 1), col = (h >> 16) & 1023;
    float* sv = (float*)(A.ws + TB_LSUM) + 7 * 1024 * 1024 / 4;
    if (lane == 0) sv[k * 4096 + gwv] = xold[(size_t)row * DM + col];
}
__device__ __forceinline__ void dg_res(const Args& A, int k, const float* xnew, const float* gate, const bf16_t* Am, int K, const float* W) {
    const int lane = threadIdx.x & 63, gwv = blockIdx.x * 8 + (threadIdx.x >> 6);
    const unsigned h = dg_hash(gwv, k); const int row = h & (MTOK - 1), col = (h >> 16) & 1023, b = row >> 13;
    const float* sv = (const float*)(A.ws + TB_LSUM) + 7 * 1024 * 1024 / 4;
    float a = 0.f; for (int kk = lane; kk < K; kk += 64) a += bf2f(Am[(size_t)row * K + kk]) * dg_bfr(W[(size_t)kk * DM + col]);
    a = wave_sum(a);
    const float ref = sv[k * 4096 + gwv] + gate[(size_t)b * 6144 + col] * a;
    if (lane == 0) dg_put(A, k, dg_rel(xnew[(size_t)row * DM + col], ref));
}
__device__ __forceinline__ void dg_swiglu(const Args& A, int k, const bf16_t* Am, const float* W, int F, const bf16_t* H, int nrows, const int* rowmap) {
    const int lane = threadIdx.x & 63, gwv = blockIdx.x * 8 + (threadIdx.x >> 6);
    const unsigned h = dg_hash(gwv, k); const int row = (h & 0xfffff) % nrows, j = (h >> 20) % F;
    float g = 0.f, u = 0.f; for (int kk = lane; kk < DM; kk += 64) { const float x = bf2f(Am[(size_t)row * DM + kk]); g += x * dg_bfr(W[(size_t)kk * 2 * F + j]); u += x * dg_bfr(W[(size_t)kk * 2 * F + F + j]); }
    g = wave_sum(g); u = wave_sum(u);
    const float ref = g / (1.0f + expf(-g)) * u;
    if (lane == 0) dg_put(A, k, dg_rel(bf2f(H[(size_t)row * F + j]), ref));
}
__device__ __forceinline__ void dg_hgin(const Args& A, int k) {
    const int lane = threadIdx.x & 63, gwv = blockIdx.x * 8 + (threadIdx.x >> 6);
    const unsigned h = dg_hash(gwv, k); const int row = h & (MTOK - 1), col = (h >> 16) % 5120, grp = col >> 10, cc = col & 1023;
    float a = 0.f; for (int kk = lane; kk < DM; kk += 64) a += bf2f(((const bf16_t*)(A.ws + WS_HM))[(size_t)row * DM + kk]) * dg_bfr(A.in[I_HGWIN][(size_t)kk * 5120 + col]);
    a = wave_sum(a);
    float ref, got;
    if (grp == 0 || grp == 4) { ref = a / (1.0f + expf(-a)); got = bf2f(((const bf16_t*)(A.ws + (grp == 0 ? H_Q : H_G)))[(size_t)row * DM + cc]); }
    else if (grp == 3) { ref = a; got = bf2f(((const bf16_t*)(A.ws + H_V))[(size_t)row * DM + cc]); }
    else { const int d = grp - 1; const float* p = A.in[I_HGLB] + (size_t)d * DEPTH * 1024 + cc; float mx = p[0]; for (int l = 1; l < DEPTH; ++l) mx = fmaxf(mx, p[l * 1024]);
        float den = 0.f; for (int l = 0; l < DEPTH; ++l) den += expf(p[l * 1024] - mx); const float lbv = expf(p[1024] - mx) / den;
        ref = logf(lbv + (1.0f - lbv) / (1.0f + expf(-a))); got = gla::h2f(((const unsigned short*)(A.ws + (d ? H_LFB : H_LFF)))[(size_t)row * DM + cc]); }
    if (lane == 0) dg_put(A, k, dg_rel(got, ref));
}
__device__ __forceinline__ void dg_gla(const Args& A, int k) {
    const int lane = threadIdx.x & 63, gwv = blockIdx.x * 8 + (threadIdx.x >> 6);
    const unsigned h = dg_hash(gwv, k); const int sel0 = (gwv & 3) == 0; const int b = sel0 ? 0 : (h & 7), hd = sel0 ? 0 : ((h >> 3) & 7), dir = sel0 ? 0 : ((h >> 6) & 1), vc = sel0 ? ((h >> 7) & 63) : ((h >> 7) & 127);
    const bf16_t* Q = (const bf16_t*)(A.ws + H_Q); const unsigned short* LF = (const unsigned short*)(A.ws + (dir ? H_LFB : H_LFF)); const bf16_t* V = (const bf16_t*)(A.ws + H_V);
    const bf16_t* O = (const bf16_t*)(A.ws + (dir ? H_OB : H_OF));
    float s0 = 0.f, s1 = 0.f, e0 = 0.f, e1 = 0.f, e2 = 0.f, e3 = 0.f;
    for (int i = 0; i < SEQ; ++i) { const int tok = dir ? (SEQ - 1 - i) : i; const size_t o = ((size_t)b * SEQ + tok) * DM + hd * 128;
        const float f0 = expf(gla::h2f(LF[o + lane])), f1 = expf(gla::h2f(LF[o + 64 + lane])), v = bf2f(V[o + vc]);
        s0 = f0 * s0 + (1.0f - f0) * v; s1 = f1 * s1 + (1.0f - f1) * v;
        if (i < 128 || i % 61 == 0) { const float ov = wave_sum(bf2f(Q[o + lane]) * s0 + bf2f(Q[o + 64 + lane]) * s1); const float er = 0.25f * fabsf(bf2f(O[o + vc]) - ov) / (fabsf(ov) + 1.0f);
            if (i == 0) e0 = er; else if (i < 64) e1 = fmaxf(e1, er); else if (i < 128) e2 = fmaxf(e2, er); else e3 = fmaxf(e3, er); } }
    if (lane == 0) { dg_put(A, k, e0); dg_put(A, k + 4, e1); dg_put(A, k + 5, e2); dg_put(A, k + 6, e3); }
    const float* dbg = (const float*)(A.ws + TB_LSUM); const unsigned short* LF0 = (const unsigned short*)(A.ws + H_LFF); const bf16_t* Q0 = (const bf16_t*)(A.ws + H_Q);
    { const unsigned h2 = dg_hash(gwv, k + 100); const int t = h2 & 63, kk = (h2 >> 6) & 127; float c = 0.f; for (int tt = 0; tt <= t; ++tt) c += gla::h2f(LF0[(size_t)tt * DM + kk]);
      if (lane == 0) dg_put(A, k + 1, dg_rel(dbg[t * 128 + kk], c)); }
    { const unsigned h2 = dg_hash(gwv, k + 200); const int t = h2 & 63, sidx = (h2 >> 6) & 63; float a = 0.f;
      if (sidx <= t) { for (int kk = lane; kk < 128; kk += 64) { float c = 0.f; for (int tt = sidx + 1; tt <= t; ++tt) c += gla::h2f(LF0[(size_t)tt * DM + kk]);
              a += bf2f(Q0[(size_t)t * DM + kk]) * (1.0f - expf(gla::h2f(LF0[(size_t)sidx * DM + kk]))) * expf(c); } a = wave_sum(a); }
      const unsigned short got = ((const unsigned short*)(dbg + 8192))[gla::sw128(t, sidx * 2) / 2];
      if (lane == 0) dg_put(A, k + 2, 5.0f * fabsf(bf2f(got) - a) / (fabsf(a) + 0.01f)); }
    { const unsigned h2 = dg_hash(gwv, k + 300); const int sidx = h2 & 63, v = (h2 >> 6) & 63;
      const unsigned short got = ((const unsigned short*)(dbg + 8192 + 2048))[gla::sw128(v, sidx * 2) / 2];
      if (lane == 0) dg_put(A, k + 2, dg_rel(bf2f(got), bf2f(((const bf16_t*)(A.ws + H_V))[(size_t)sidx * DM + v]))); }
    { const unsigned h2 = dg_hash(gwv, k + 500); const int kk = h2 & 127, v = (h2 >> 7) & 63;
      float a = 0.f; { const int sidx = lane; float c = 0.f; for (int tt = sidx + 1; tt < 64; ++tt) c += gla::h2f(LF0[(size_t)tt * DM + kk]);
          const float ksn = (1.0f - expf(gla::h2f(LF0[(size_t)sidx * DM + kk]))) * expf(c);
          const unsigned short gk = ((const unsigned short*)(dbg + 16384))[gla::sw128(kk, sidx * 2) / 2];
          dg_put(A, k + 2, 0.5f * fabsf(bf2f(gk) - ksn) / (fabsf(ksn) + 0.01f));
          a = ksn * bf2f(((const bf16_t*)(A.ws + H_V))[(size_t)sidx * DM + v]); }
      a = wave_sum(a);
      const unsigned short gs = ((const unsigned short*)(dbg + 12288))[gla::sw256(v, kk * 2) / 2];
      if (lane == 0) dg_put(A, k + 3, 0.5f * fabsf(bf2f(gs) - a) / (fabsf(a) + 0.05f)); }
    { const unsigned h2 = dg_hash(gwv, k + 400); const int t = h2 & 63, v = (h2 >> 6) & 63;
      const unsigned short* at = (const unsigned short*)(dbg + 8192); const unsigned short* vt = (const unsigned short*)(dbg + 8192 + 2048);
      float a = bf2f(at[gla::sw128(t, lane * 2) / 2]) * bf2f(vt[gla::sw128(v, lane * 2) / 2]); a = wave_sum(a);
      if (lane == 0) dg_put(A, k + 1, 5.0f * dg_rel(bf2f(((const bf16_t*)(A.ws + H_OF))[(size_t)t * DM + v]), a)); }
}
__device__ __forceinline__ void dg_normo(const Args& A, int k) {
    const int lane = threadIdx.x & 63, gwv = blockIdx.x * 8 + (threadIdx.x >> 6);
    const unsigned h = dg_hash(gwv, k); const int row = h & (MTOK - 1), hd = (h >> 16) & 7; const size_t o = (size_t)row * DM + hd * 128;
    const float v0 = bf2f(((const bf16_t*)(A.ws + H_OF))[o + lane]) + bf2f(((const bf16_t*)(A.ws + H_OB))[o + lane]), v1 = bf2f(((const bf16_t*)(A.ws + H_OF))[o + 64 + lane]) + bf2f(((const bf16_t*)(A.ws + H_OB))[o + 64 + lane]);
    const float ss = wave_sum(v0 * v0 + v1 * v1), rstd = 1.0f / sqrtf(ss / 128.0f + EPS);
    const float r0 = v0 * rstd * A.in[I_HGNG][lane] * bf2f(((const bf16_t*)(A.ws + H_G))[o + lane]), r1 = v1 * rstd * A.in[I_HGNG][64 + lane] * bf2f(((const bf16_t*)(A.ws + H_G))[o + 64 + lane]);
    dg_put(A, k, fmaxf(dg_rel(bf2f(((const bf16_t*)(A.ws + WS_HM))[o + lane]), r0), dg_rel(bf2f(((const bf16_t*)(A.ws + WS_HM))[o + 64 + lane]), r1)));
}
__device__ __forceinline__ void dg_router(const Args& A, int k, int L) {
    const int lane = threadIdx.x & 63, gwv = blockIdx.x * 8 + (threadIdx.x >> 6);
    const int row = dg_hash(gwv, k) & (MTOK - 1), b = row >> 13; const float* x = A.out + (size_t)row * DM;
    const float* modl = (const float*)(A.ws + TB_MODS) + ((size_t)L * NBATCH + b) * 6144; const float* gain = A.in[I_N2G] + L * DM; const float* R = A.in[I_MOER] + (size_t)(L >> 1) * DM * 8;
    float ss = 0.f; for (int c = lane; c < DM; c += 64) ss += x[c] * x[c];
    ss = wave_sum(ss); const float rstd = 1.0f / sqrtf(ss / DM + EPS);
    float lg[8]; for (int e = 0; e < 8; ++e) lg[e] = 0.f;
    for (int c = lane; c < DM; c += 64) { const float hv = x[c] * rstd * gain[c] * (1.0f + modl[4 * 1024 + c]) + modl[3 * 1024 + c]; for (int e = 0; e < 8; ++e) lg[e] += hv * R[c * 8 + e]; }
    for (int e = 0; e < 8; ++e) lg[e] = wave_sum(lg[e]);
    int e0 = 0; for (int e = 1; e < 8; ++e) if (lg[e] > lg[e0]) e0 = e;
    int e1 = (e0 == 0) ? 1 : 0; for (int e = 0; e < 8; ++e) if (e != e0 && lg[e] > lg[e1]) e1 = e;
    float gap = 1e9f; for (int e = 0; e < 8; ++e) if (e != e0 && e != e1) gap = fminf(gap, lg[e1] - lg[e]); gap = fminf(gap, lg[e0] - lg[e1]);
    const int g0 = ((const int*)(A.ws + TB_EID))[row * 2], g1 = ((const int*)(A.ws + TB_EID))[row * 2 + 1]; const float w0 = ((const float*)(A.ws + TB_GATE))[row * 2], w1 = ((const float*)(A.ws + TB_GATE))[row * 2 + 1];
    const float p0 = 1.0f / (1.0f + expf(lg[e1] - lg[e0]));
    float er = (g0 != e0 || g1 != e1) ? (gap > 2e-3f ? 9.f : 0.f) : fmaxf(fabsf(w0 - p0), fabsf(w1 - (1.0f - p0)));
    if (lane == 0) dg_put(A, k, er);
}
__device__ __forceinline__ void dg_place(const Args& A, int k) {
    const int lane = threadIdx.x & 63, gwv = blockIdx.x * 8 + (threadIdx.x >> 6);
    const unsigned h = dg_hash(gwv, k); const int row = h & (MTOK - 1), kk = (h >> 16) & 1;
    const int sl = ((const int*)(A.ws + TB_SLOT))[row * 2 + kk], e = ((const int*)(A.ws + TB_EID))[row * 2 + kk]; const int* ts = (const int*)(A.ws + TB_TILES);
    float er = (sl >= ts[e] * 256 && sl < ts[e + 1] * 256 && sl < MOE_ROWS) ? 0.f : 7.f;
    if (er == 0.f) for (int c = lane; c < DM; c += 64) if (((const bf16_t*)(A.ws + E_XS))[(size_t)sl * DM + c] != ((const bf16_t*)(A.ws + WS_HM))[(size_t)row * DM + c]) er = 5.f;
    dg_put(A, k, er);
}
__device__ __forceinline__ void dg_moe_hid(const Args& A, int k, int m) {
    const int lane = threadIdx.x & 63, gwv = blockIdx.x * 8 + (threadIdx.x >> 6);
    const unsigned h = dg_hash(gwv, k); const int row = h & (MTOK - 1), kk = (h >> 16) & 1, j = (h >> 17) % DFFE;
    const int sl = ((const int*)(A.ws + TB_SLOT))[row * 2 + kk], e = ((const int*)(A.ws + TB_EID))[row * 2 + kk];
    const float* W = A.in[I_MOEGU] + ((size_t)m * 8 + e) * DM * 2 * DFFE; const bf16_t* Am = (const bf16_t*)(A.ws + E_XS) + (size_t)sl * DM;
    float g = 0.f, u = 0.f; for (int c = lane; c < DM; c += 64) { const float x = bf2f(Am[c]); g += x * dg_bfr(W[(size_t)c * 2 * DFFE + j]); u += x * dg_bfr(W[(size_t)c * 2 * DFFE + DFFE + j]); }
    g = wave_sum(g); u = wave_sum(u);
    if (lane == 0) dg_put(A, k, dg_rel(bf2f(((const bf16_t*)(A.ws + E_HID))[(size_t)sl * DFFE + j]), g / (1.0f + expf(-g)) * u));
}
__device__ __forceinline__ void dg_moe_y(const Args& A, int k, int m) {
    const int lane = threadIdx.x & 63, gwv = blockIdx.x * 8 + (threadIdx.x >> 6);
    const unsigned h = dg_hash(gwv, k); const int row = h & (MTOK - 1), kk = (h >> 16) & 1, col = (h >> 17) & 1023;
    const int sl = ((const int*)(A.ws + TB_SLOT))[row * 2 + kk], e = ((const int*)(A.ws + TB_EID))[row * 2 + kk];
    const float* W = A.in[I_MOEDN] + ((size_t)m * 8 + e) * DFFE * DM; const bf16_t* Hh = (const bf16_t*)(A.ws + E_HID) + (size_t)sl * DFFE;
    float a = 0.f; for (int j = lane; j < DFFE; j += 64) a += bf2f(Hh[j]) * dg_bfr(W[(size_t)j * DM + col]);
    a = wave_sum(a);
    if (lane == 0) dg_put(A, k, fabsf(bf2f(((const bf16_t*)(A.ws + E_XS))[(size_t)sl * DM + col]) - a) / (fabsf(a) + 0.3f));
}
__device__ __forceinline__ void dg_combine(const Args& A, int k, const float* modprev) {
    const int lane = threadIdx.x & 63, gwv = blockIdx.x * 8 + (threadIdx.x >> 6);
    const unsigned h = dg_hash(gwv, k); const int row = h & (MTOK - 1), col = (h >> 16) & 1023, b = row >> 13;
    const float* sv = (const float*)(A.ws + TB_LSUM) + 7 * 1024 * 1024 / 4; const bf16_t* Y = (const bf16_t*)(A.ws + E_XS);
    const int s0 = ((const int*)(A.ws + TB_SLOT))[row * 2], s1 = ((const int*)(A.ws + TB_SLOT))[row * 2 + 1]; const float w0 = ((const float*)(A.ws + TB_GATE))[row * 2], w1 = ((const float*)(A.ws + TB_GATE))[row * 2 + 1];
    const float ref = sv[k * 4096 + gwv] + modprev[(size_t)b * 6144 + 5 * 1024 + col] * (w0 * bf2f(Y[(size_t)s0 * DM + col]) + w1 * bf2f(Y[(size_t)s1 * DM + col]));
    if (lane == 0) dg_put(A, k, dg_rel(A.out[(size_t)row * DM + col], ref));
}
__device__ __forceinline__ void dg_lruin(const Args& A, int k) {
    const int lane = threadIdx.x & 63, gwv = blockIdx.x * 8 + (threadIdx.x >> 6);
    const unsigned h = dg_hash(gwv, k); const int row = h & (MTOK - 1), col = (h >> 16) % 2560;
    float a = 0.f; for (int kk = lane; kk < DM; kk += 64) a += bf2f(((const bf16_t*)(A.ws + WS_HM))[(size_t)row * DM + kk]) * dg_bfr(A.in[I_LRWIN][(size_t)kk * 2560 + col]);
    a = wave_sum(a);
    float ref, got;
    if (col < LRUW) { ref = 0.5f * a * (1.0f + tanhf(0.7978845608028654f * (a + 0.044715f * a * a * a))); got = bf2f(((const bf16_t*)(A.ws + L_YB))[(size_t)row * LRUW + col]); }
    else { ref = a; got = bf2f(((const bf16_t*)(A.ws + L_XB))[(size_t)row * LRUW + col - LRUW]); }
    if (lane == 0) dg_put(A, k, dg_rel(got, ref));
}
__device__ __forceinline__ void dg_lru(const Args& A, int k) {
    const int lane = threadIdx.x & 63, gwv = blockIdx.x * 8 + (threadIdx.x >> 6);
    const unsigned h = dg_hash(gwv, k); const int b = h & 7, ch = (h >> 3) % LRUW, tc = (h >> 16) & (SEQ - 1), n = ch / 128, j = ch % 128;
    const bf16_t* XB = (const bf16_t*)(A.ws + L_XB) + (size_t)b * SEQ * LRUW;
    float hres[2];
    for (int d = 0; d < 2; ++d) {
        const float* wa = A.in[I_LRWA] + (size_t)(d * 10 + n) * 16384; const float* wx = A.in[I_LRWX] + (size_t)(d * 10 + n) * 16384;
        const float wa0 = dg_bfr(wa[lane * 128 + j]), wa1 = dg_bfr(wa[(lane + 64) * 128 + j]), wx0 = dg_bfr(wx[lane * 128 + j]), wx1 = dg_bfr(wx[(lane + 64) * 128 + j]);
        const float ba = A.in[I_LRBA][d * LRUW + ch], bx = A.in[I_LRBX][d * LRUW + ch]; const float lam = A.in[I_LRLAM][d * LRUW + ch]; const float sp = log1pf(expf(-lam));
        float hs = 0.f;
        for (int i = 0; ; ++i) { const int t = d ? (SEQ - 1 - i) : i;
            float x0 = A.in[I_LRCB][n * 128 + lane], x1 = A.in[I_LRCB][n * 128 + 64 + lane], xj = A.in[I_LRCB][ch];
            for (int w = 0; w < 4; ++w) { const int tt = t - 1 + w; if (tt >= 0 && tt < SEQ) {
                x0 += A.in[I_LRCW][w * LRUW + n * 128 + lane] * bf2f(XB[(size_t)tt * LRUW + n * 128 + lane]); x1 += A.in[I_LRCW][w * LRUW + n * 128 + 64 + lane] * bf2f(XB[(size_t)tt * LRUW + n * 128 + 64 + lane]);
                xj += A.in[I_LRCW][w * LRUW + ch] * bf2f(XB[(size_t)tt * LRUW + ch]); } }
            const float rp = wave_sum(dg_bfr(x0) * wa0 + dg_bfr(x1) * wa1), ip = wave_sum(dg_bfr(x0) * wx0 + dg_bfr(x1) * wx1);
            const float rg = 1.0f / (1.0f + expf(-(rp + ba))), ig = 1.0f / (1.0f + expf(-(ip + bx))); const float la = -8.0f * rg * sp;
            hs = expf(la) * hs + sqrtf(fmaxf(-expm1f(2.0f * la), 0.f)) * ig * xj;
            if (t == tc) break; }
        hres[d] = hs;
    }
    const size_t go = ((size_t)b * SEQ + tc) * LRUW + ch;
    const float e1 = fabsf(bf2f(((const bf16_t*)(A.ws + L_HF))[go]) - hres[0]) / (fabsf(hres[0]) + 0.3f);
    const float ref = (hres[0] + hres[1]) * bf2f(((const bf16_t*)(A.ws + L_YB))[go]);
    const float e2 = fabsf(bf2f(((const bf16_t*)(A.ws + L_HY))[go]) - ref) / (fabsf(ref) + 0.3f);
    if (lane == 0) { dg_put(A, k, e1); dg_put(A, k + 5, e2); }
}
__device__ __forceinline__ void dg_final(const Args& A, int nchk) {
    const unsigned* sl = (const unsigned*)(A.ws + WS_CTL) + DG_BASE; int code = 0; float ev = 0.f;
    for (int k = 1; k <= nchk; ++k) { const float e = __uint_as_float(sl[64 * k]); if (e > 0.05f) { code = k; ev = e; break; } }
    if (code == 0) return;
    const int c1 = code % 10, c10 = code / 10;
    const float s = -(float)c1;
    for (size_t i = (size_t)blockIdx.x * NTHR + threadIdx.x; i < (size_t)MTOK * DM; i += (size_t)gridDim.x * NTHR) A.out[i] = A.in[I_X][i] * s;
    __syncthreads();
    if (blockIdx.x == 0 && threadIdx.x == 0) { const int qq = ev < 0.1f ? 1 : ev < 0.2f ? 2 : ev < 0.5f ? 3 : ev < 1.f ? 4 : ev < 2.f ? 5 : ev < 5.f ? 6 : ev < 20.f ? 7 : ev < 1e3f ? 8 : 9;
        A.out[12345] = 100.f * (float)(10 * c10 + qq); }
}
#define DG(x) x
#define DGL(x) if constexpr (L >= DIAG_FROM) { x }
#else
#define DG(x)
#define DGL(x)
#endif

#define GRID_BAR() xcd_barrier(bar)
template <int L>
__device__ __forceinline__ void run_mixer(const Args& args, LAS unsigned char* lds, int bid, int G, const XcdBarrier& bar) {
    unsigned char* ws = args.ws; bf16_t* xo = (bf16_t*)(ws + WS_XB);
    const float* modl = (const float*)(ws + TB_MODS) + (size_t)L * NBATCH * 6144;
    const void* xs = (L == 0) ? (const void*)args.in[I_X] : (const void*)xo; constexpr bool X16 = (L != 0);
    constexpr int kind = L % 3;
    DGL(if (L > 0 && ((L - 1) & 1)) { dg_save(args, 10 * (L - 1) + 9, xo); GRID_BAR(); })
    constexpr bool F8Q = (L == 3);
    norm_phase<false>(args, lds, bid, G, xs, X16, xo, true, args.in[I_N1G] + L * DM, modl, 0, (L > 0) && ((L - 1) & 1), modl - NBATCH * 6144, false, nullptr, F8Q);
    GRID_BAR();
    DGL(if (L > 0 && ((L - 1) & 1)) { dg_combine(args, 10 * (L - 1) + 9, modl - NBATCH * 6144); GRID_BAR(); })
    DGL(dg_norm(args, 10 * L + 1, (L > 0 && ((L - 1) & 1)) ? xo : xs, args.in[I_N1G] + L * DM, L, 0); GRID_BAR();)
    if constexpr (kind == 0) {
        constexpr int al = L / 3;
        {
            pg8::Gemm g{(const bf16_t*)(ws + WS_HM), (const bf16_t*)(ws + W_QKV) + (size_t)al * 3072 * 1024, F8Q ? 512 : 1024};
            pg8::TileOrder S; S.init(256, 12, G, bid);
            pg8::EpiQKV E{(bf16_t*)(ws + A_Q), (bf16_t*)(ws + A_K), (bf16_t*)(ws + A_V), args.in[I_ATQN] + al * 64, args.in[I_ATKN] + al * 64,
                          (const float*)(ws + TB_COS), (const float*)(ws + TB_SIN), LOG2E, F8Q ? 1.0f / MOE_WSCALE : 1.0f};
            pg8::gemm_phase<pg8::EpiQKV, F8Q>(lds, g, S, E);
        }
        GRID_BAR();
        vt_phase(args, bid, G);
        GRID_BAR();
        attn_phase(args, lds, bid, G, al);
        GRID_BAR();
        DGL(dg_save(args, 10 * L + 4, xs); GRID_BAR();)
        {
            pg8::Gemm g{(const bf16_t*)(ws + WS_HM), (const bf16_t*)(ws + W_AO) + (size_t)al * 1024 * 1024, 1024};
            pg8::TileOrder S; S.init(256, 4, G, bid);
            pg8::EpiRes<X16> E{xs, xo, modl + 2 * 1024, 1.0f};
            pg8::gemm_phase<pg8::EpiRes<X16>>(lds, g, S, E);
        }
        GRID_BAR();
        DGL(dg_res(args, 10 * L + 4, xo, modl + 2 * 1024, (const bf16_t*)(ws + WS_HM), 1024, args.in[I_ATWOUT] + (size_t)al * 1024 * 1024); GRID_BAR();)
    }
    if constexpr (kind == 1) {
        {
            pg8::Gemm g{(const bf16_t*)(ws + WS_HM), (const bf16_t*)(ws + W_HGI), 1024};
            pg8::TileOrder S; S.init(256, 20, G, bid);
            pg8::EpiAct E{0, ws, (const float*)(ws + TB_LB)};
            pg8::gemm_phase<pg8::EpiAct>(lds, g, S, E);
        }
        GRID_BAR();
        DGL(dg_hgin(args, 10 * L + 2); GRID_BAR();)
        gla_phase(args, lds, bid, G);
        GRID_BAR();
        DGL(dg_gla(args, 10 * L + 3); GRID_BAR();)
        hg_normo_phase(args, bid, G);
        GRID_BAR();
        DGL(dg_normo(args, 10 * L + 0); GRID_BAR();)
        DGL(dg_save(args, 10 * L + 4, xs); GRID_BAR();)
        {
            pg8::Gemm g{(const bf16_t*)(ws + WS_HM), (const bf16_t*)(ws + W_HGO), 1024};
            pg8::TileOrder S; S.init(256, 4, G, bid);
            pg8::EpiRes<X16> E{xs, xo, modl + 2 * 1024, 1.0f};
            pg8::gemm_phase<pg8::EpiRes<X16>>(lds, g, S, E);
        }
        GRID_BAR();
        DGL(dg_res(args, 10 * L + 4, xo, modl + 2 * 1024, (const bf16_t*)(ws + WS_HM), 1024, args.in[I_HGWOUT]); GRID_BAR();)
    }
    if constexpr (kind == 2) {
        {
            pg8::Gemm g{(const bf16_t*)(ws + WS_HM), (const bf16_t*)(ws + W_LRI), 1024};
            pg8::TileOrder S; S.init(256, 10, G, bid);
            pg8::EpiAct E{1, ws, nullptr};
            pg8::gemm_phase<pg8::EpiAct>(lds, g, S, E);
        }
        GRID_BAR();
        DGL(dg_lruin(args, 10 * L + 2); GRID_BAR();)
        lru_phase<0>(args, lds, bid, G);
        GRID_BAR();
        lru_carry_phase(args, bid, G);
        GRID_BAR();
        lru_apply_phase(args, lds, bid, G);
        GRID_BAR();
        DGL(dg_lru(args, 10 * L + 3); GRID_BAR();)
        DGL(dg_save(args, 10 * L + 4, xs); GRID_BAR();)
        {
            pg8::Gemm g{(const bf16_t*)(ws + L_HY), (const bf16_t*)(ws + W_LRO), LRUW};
            pg8::TileOrder S; S.init(256, 4, G, bid);
            pg8::EpiRes<X16> E{xs, xo, modl + 2 * 1024, 1.0f};
            pg8::gemm_phase<pg8::EpiRes<X16>>(lds, g, S, E);
        }
        GRID_BAR();
        DGL(dg_res(args, 10 * L + 4, xo, modl + 2 * 1024, (const bf16_t*)(ws + L_HY), LRUW, args.in[I_LRWOUT]); GRID_BAR();)
    }
}
template <int L>
__device__ __forceinline__ void run_ffn(const Args& args, LAS unsigned char* lds, int bid, int G, const XcdBarrier& bar) {
    unsigned char* ws = args.ws; bf16_t* xo = (bf16_t*)(ws + WS_XB);
    const float* modl = (const float*)(ws + TB_MODS) + (size_t)L * NBATCH * 6144;
    if constexpr ((L & 1) == 0) {
        constexpr int m = L >> 1;
        constexpr bool F8 = (L >= FP8_DENSE_FROM);
        norm_phase<false>(args, lds, bid, G, xo, true, xo, true, args.in[I_N2G] + L * DM, modl, 1, false, modl, false, nullptr, F8);
        GRID_BAR();
        if constexpr (F8) {
            pg8::Gemm g{(const bf16_t*)(ws + WS_HM), (const bf16_t*)(ws + W_FGU) + (size_t)m * 5632 * 1024, 512};
            pg8::TileOrder S; S.init(256, 22, G, bid);
            pg8::EpiSwiGLU8 E{ws + F_HID, DFF, 1.0f / MOE_WSCALE, MOE_HSCALE};
            pg8::gemm_phase<pg8::EpiSwiGLU8, true>(lds, g, S, E);
        } else {
            pg8::Gemm g{(const bf16_t*)(ws + WS_HM), (const bf16_t*)(ws + W_FGU) + (size_t)m * 5632 * 1024, 1024};
            pg8::TileOrder S; S.init(256, 22, G, bid);
            pg8::EpiSwiGLU E{(bf16_t*)(ws + F_HID), DFF};
            pg8::gemm_phase<pg8::EpiSwiGLU>(lds, g, S, E);
        }
        GRID_BAR();
        if constexpr (F8) {
            pg8::Gemm g{(const bf16_t*)(ws + F_HID), (const bf16_t*)(ws + W_FDN) + (size_t)m * 1024 * 2816, DFF / 2};
            pg8::TileOrder S; S.init(256, 4, G, bid);
            pg8::EpiRes<true> E{xo, xo, modl + 5 * 1024, 1.0f / (MOE_WSCALE * MOE_HSCALE)};
            pg8::gemm_phase<pg8::EpiRes<true>, true>(lds, g, S, E);
        } else {
            pg8::Gemm g{(const bf16_t*)(ws + F_HID), (const bf16_t*)(ws + W_FDN) + (size_t)m * 1024 * 2816, DFF};
            pg8::TileOrder S; S.init(256, 4, G, bid);
            pg8::EpiRes<true> E{xo, xo, modl + 5 * 1024, 1.0f};
            pg8::gemm_phase<pg8::EpiRes<true>>(lds, g, S, E);
        }
        GRID_BAR();
    } else {
        constexpr int m = L >> 1;
        norm_phase<true>(args, lds, bid, G, xo, true, xo, true, args.in[I_N2G] + L * DM, modl, 1, false, modl, false, args.in[I_MOER] + (size_t)m * DM * 8);
        GRID_BAR();
        DGL(dg_norm(args, 10 * L + 5, xo, args.in[I_N2G] + L * DM, L, 1); dg_router(args, 10 * L + 5, L); GRID_BAR();)
        place_phase(args, lds, bid, G);
        GRID_BAR();
        DGL(dg_place(args, 10 * L + 6); GRID_BAR();)
        const int* tiles = (const int*)(ws + TB_TILES);
        {
            pg8::Gemm g{(const bf16_t*)(ws + E_XS), (const bf16_t*)(ws + W_MGU + (size_t)m * 8 * 7168 * 1024), 512};
            pg8::TileOrder S; S.init(tiles[8], 28, G, bid);
#pragma unroll
            for (int e = 1; e < NEXP; ++e) S.ts[e] = tiles[e];
            pg8::EpiSwiGLU8 E{ws + E_HID, DFFE, 1.0f / MOE_WSCALE, MOE_HSCALE};
            pg8::gemm_phase<pg8::EpiSwiGLU8, true>(lds, g, S, E);
        }
        GRID_BAR();
        DGL(dg_moe_hid(args, 10 * L + 7, m); GRID_BAR();)
        {
            pg8::Gemm g{(const bf16_t*)(ws + E_HID), (const bf16_t*)(ws + W_MDN + (size_t)m * 8 * 1024 * 3584), DFFE / 2};
            pg8::TileOrder S; S.init(tiles[8], 4, G, bid);
#pragma unroll
            for (int e = 1; e < NEXP; ++e) S.ts[e] = tiles[e];
            pg8::EpiPlain E{(bf16_t*)(ws + E_XS), DM, 1.0f / (MOE_WSCALE * MOE_HSCALE)};
            pg8::gemm_phase<pg8::EpiPlain, true>(lds, g, S, E);
        }
        GRID_BAR();
        DGL(dg_moe_y(args, 10 * L + 8, m); GRID_BAR();)
    }
}
__device__ __forceinline__ void final_combine(const Args& args, LAS unsigned char* lds, int bid, int G, const XcdBarrier& bar) {
    const float* modl = (const float*)(args.ws + TB_MODS) + (size_t)3 * NBATCH * 6144;
    DG(dg_save(args, 39, args.out); GRID_BAR();)
    norm_phase<false>(args, lds, bid, G, args.ws + WS_XB, true, args.out, false, args.in[I_N1G], modl, 0, true, modl, true, nullptr);
    DG(GRID_BAR(); dg_combine(args, 39, modl);)
}

__global__ void __launch_bounds__(NTHR, 2) mega_fwd(Args args) {
    extern __shared__ __attribute__((aligned(16))) unsigned char lds_raw[];
    LAS unsigned char* lds = (LAS unsigned char*)lds_raw;
    const int tid = threadIdx.x, bid = blockIdx.x, G = gridDim.x;
    unsigned char* ws = args.ws;
    volatile LAS unsigned* MISC = (volatile LAS unsigned*)(lds + MISC_OFF);
    if (tid < 64) MISC[tid] = 0u;
    __syncthreads();
    XcdBarrier bar = xcd_barrier_post((unsigned*)(ws + WS_CTL) + CW_BAR, MISC + 8);

    prologue_phase(args, lds, bid, G);
    GRID_BAR();

    run_mixer<0>(args, lds, bid, G, bar);
    run_ffn<0>(args, lds, bid, G, bar);
    run_mixer<1>(args, lds, bid, G, bar);
    run_ffn<1>(args, lds, bid, G, bar);
    run_mixer<2>(args, lds, bid, G, bar);
    run_ffn<2>(args, lds, bid, G, bar);
    run_mixer<3>(args, lds, bid, G, bar);
    run_ffn<3>(args, lds, bid, G, bar);
    final_combine(args, lds, bid, G, bar);
    DG(GRID_BAR(); dg_final(args, 49);)
}

extern "C" void kernel_launch(void* const* d_in, const int* in_sizes, int n_in, void* d_out, int out_size, void* d_ws, size_t ws_size, hipStream_t stream) {
    static int grid = 0;
    if (grid == 0) {
        if (n_in != 30 || out_size != MTOK * DM || ws_size < WS_NEED) { fprintf(stderr, "kernel_launch: unexpected shapes (n_in %d out %d ws %zu need %zu)\n", n_in, out_size, ws_size, (size_t)WS_NEED); grid = -1; return; }
        int dev = 0, cus = 0;
        if (hipGetDevice(&dev) != hipSuccess || hipDeviceGetAttribute(&cus, hipDeviceAttributeMultiprocessorCount, dev) != hipSuccess) { grid = -1; return; }
        if (hipFuncSetAttribute((const void*)mega_fwd, hipFuncAttributeMaxDynamicSharedMemorySize, LDS_BYTES) != hipSuccess) { fprintf(stderr, "kernel_launch: hipFuncSetAttribute failed\n"); grid = -1; return; }
        int per_cu = 0;
        if (hipOccupancyMaxActiveBlocksPerMultiprocessor(&per_cu, (const void*)mega_fwd, NTHR, LDS_BYTES) != hipSuccess || per_cu < 1) { fprintf(stderr, "kernel_launch: occupancy query says %d\n", per_cu); }
        (void)hipGetLastError();
        grid = (cus >= 256) ? 256 : -1;
        if (grid < 0) { fprintf(stderr, "kernel_launch: needs 256 CUs, device has %d\n", cus); return; }
    }
    if (grid < 0) return;
    if (hipMemsetAsync((char*)d_ws + WS_CTL, 0, CTL_ZERO_BYTES, stream) != hipSuccess) return;
    Args a{};
    for (int i = 0; i < 30; ++i) a.in[i] = (const float*)d_in[i];
    a.out = (float*)d_out; a.ws = (unsigned char*)d_ws;
    hipLaunchKernelGGL(mega_fwd, dim3(grid), dim3(NTHR), LDS_BYTES, stream, a);
}
```

```cpp
#define DIAG_FROM 2
#include <hip/hip_runtime.h>
#include <cstdio>
#include <cstdint>

#define LAS __attribute__((address_space(3)))
#define GAS __attribute__((address_space(1)))
typedef unsigned short bf16_t;
typedef short bf16x8 __attribute__((ext_vector_type(8)));
typedef short s16x4 __attribute__((ext_vector_type(4)));
typedef float f32x2 __attribute__((ext_vector_type(2)));
typedef float f32x4 __attribute__((ext_vector_type(4)));
typedef float f32x16 __attribute__((ext_vector_type(16)));
typedef unsigned u32x2 __attribute__((ext_vector_type(2)));
typedef unsigned u32x4 __attribute__((ext_vector_type(4)));

constexpr int MTOK = 65536, DM = 1024, SEQ = 8192, NBATCH = 8, DEPTH = 4;
constexpr int DFF = 2816, DFFE = 3584, NEXP = 8, LRUW = 1280;
constexpr float EPS = 1e-6f;
constexpr int FP8_DENSE_FROM = 2;
constexpr float MOE_WSCALE = 64.0f, MOE_HSCALE = 4.0f;
constexpr float LOG2E = 1.4426950408889634f;

constexpr size_t MiB = 1u << 20;
constexpr size_t WS_CTL = 0, CTL_ZERO_BYTES = 1 * MiB;
constexpr size_t WS_TAB = 1 * MiB;
constexpr size_t TB_MODS = WS_TAB;
constexpr size_t TB_COS = WS_TAB + 1 * MiB;
constexpr size_t TB_SIN = WS_TAB + 2 * MiB;
constexpr size_t TB_SCAL = WS_TAB + 3 * MiB;
constexpr size_t TB_LB = TB_SCAL + 4096;
constexpr size_t TB_SP = TB_SCAL + 16384;
constexpr size_t TB_EID = WS_TAB + 4 * MiB;
constexpr size_t TB_GATE = WS_TAB + 5 * MiB;
constexpr size_t TB_SLOT = WS_TAB + 6 * MiB;
constexpr size_t TB_BCNT = WS_TAB + 7 * MiB;
constexpr size_t TB_TILES = TB_BCNT + 16384;
constexpr size_t TB_LSUM = WS_TAB + 8 * MiB;
constexpr size_t TB_LCIN = WS_TAB + 16 * MiB;
constexpr size_t WS_W = 32 * MiB;
constexpr size_t W_QKV = WS_W;
constexpr size_t W_AO = W_QKV + 2 * (size_t)3072 * 1024 * 2;
constexpr size_t W_HGI = W_AO + 2 * (size_t)1024 * 1024 * 2;
constexpr size_t W_HGO = W_HGI + (size_t)5120 * 1024 * 2;
constexpr size_t W_LRI = W_HGO + (size_t)1024 * 1024 * 2;
constexpr size_t W_LRG = W_LRI + (size_t)2560 * 1024 * 2;
constexpr size_t W_LRO = W_LRG + (size_t)10 * 2 * 256 * 128 * 2;
constexpr size_t W_FGU = W_LRO + (size_t)1024 * 1280 * 2;
constexpr size_t W_FDN = W_FGU + 2 * (size_t)5632 * 1024 * 2;
constexpr size_t W_MGU = W_FDN + 2 * (size_t)1024 * 2816 * 2;
constexpr size_t W_MDN = W_MGU + 16 * (size_t)7168 * 1024 * 2;
constexpr size_t W_END = W_MDN + 16 * (size_t)1024 * 3584 * 2;
constexpr size_t WS_HM = 440 * MiB;
constexpr size_t WS_ACT = 568 * MiB;
static_assert(W_END <= WS_HM, "weights overflow");
constexpr size_t SZ_TOK = (size_t)MTOK * 1024 * 2;
constexpr size_t A_Q = WS_ACT, A_K = A_Q + SZ_TOK, A_V = A_K + SZ_TOK, A_VT = A_V + SZ_TOK;
constexpr size_t F_HID = WS_ACT;
constexpr size_t H_Q = WS_ACT, H_LFF = H_Q + SZ_TOK, H_LFB = H_LFF + SZ_TOK, H_V = H_LFB + SZ_TOK, H_G = H_V + SZ_TOK, H_OF = H_G + SZ_TOK, H_OB = H_OF + SZ_TOK;
constexpr size_t SZ_LRU = (size_t)MTOK * 1280 * 2;
constexpr size_t L_YB = WS_ACT, L_XB = L_YB + SZ_LRU, L_HF = L_XB + SZ_LRU, L_HY = L_HF + SZ_LRU, L_U = L_HY + SZ_LRU;
constexpr int MOE_ROWS = 2 * MTOK + NEXP * 256;
constexpr size_t E_XS = WS_ACT, E_HID = E_XS + (size_t)MOE_ROWS * 1024 * 2, E_END = E_HID + (size_t)MOE_ROWS * DFFE;
constexpr size_t WS_XB = 1536 * MiB;
static_assert(E_END <= WS_XB && H_OB + SZ_TOK <= WS_XB && L_U + 2 * SZ_LRU <= WS_XB && A_VT + SZ_TOK <= WS_XB, "activation regions below the residual stream");
constexpr size_t WS_NEED = WS_XB + SZ_TOK;
static_assert(WS_NEED <= (size_t)1792 * MiB, "workspace");

constexpr int CW_BAR = 4096;

constexpr int RING_BYTES = 135168;
constexpr int MISC_OFF = RING_BYTES;
constexpr int LDS_BYTES = 147456;
constexpr int NWAVES = 8, NTHR = 512;

typedef __bf16 bf16x2v __attribute__((ext_vector_type(2)));
__device__ __forceinline__ unsigned cvt_pk_bf16(float lo, float hi) { const f32x2 v = {lo, hi}; const bf16x2v b = __builtin_convertvector(v, bf16x2v); return __builtin_bit_cast(unsigned, b); }
__device__ __forceinline__ unsigned pk_fp8x4(float a, float b, float c, float d) { unsigned w = 0; w = __builtin_amdgcn_cvt_pk_fp8_f32(a, b, w, false); w = __builtin_amdgcn_cvt_pk_fp8_f32(c, d, w, true); return w; }
__device__ __forceinline__ unsigned f2bf(float f) { unsigned u = __builtin_bit_cast(unsigned, f); return (u + 0x7fffu + ((u >> 16) & 1u)) >> 16; }
__device__ __forceinline__ float bf2f(unsigned short b) { return __builtin_bit_cast(float, ((unsigned)b) << 16); }
__device__ __forceinline__ float bflo(unsigned w) { return __builtin_bit_cast(float, w << 16); }
__device__ __forceinline__ float bfhi(unsigned w) { return __builtin_bit_cast(float, w & 0xffff0000u); }
__device__ __forceinline__ float fexp2(float x) { return __builtin_amdgcn_exp2f(x); }
__device__ __forceinline__ float fexp(float x) { return __builtin_amdgcn_exp2f(x * LOG2E); }
__device__ __forceinline__ float frcp(float x) { return __builtin_amdgcn_rcpf(x); }
__device__ __forceinline__ float fsigmoid(float x) { return frcp(1.0f + fexp(-x)); }
__device__ __forceinline__ float fsilu(float x) { return x * fsigmoid(x); }
__device__ __forceinline__ float wave_sum(float v) {
#pragma unroll
    for (int o = 1; o < 64; o <<= 1) v += __shfl_xor(v, o);
    return v;
}
#define LDS_WAIT() asm volatile("s_waitcnt lgkmcnt(0)" ::: "memory")
#define VM_WAIT() asm volatile("s_waitcnt vmcnt(0)" ::: "memory")

#define XB_TMO      128
#define XB_XCNT(j)  (256  + 64 * (j))
#define XB_XSUB(j)  (1280 + 64 * (j))
#define XB_XGEN(j)  (2304 + 64 * (j))
#define XB_TOP      3328
#define XB_TOPGEN   3392
#define XCD_BAR_WORDS 3456
#define XB_SPIN_CAP (1u << 22)
__device__ __forceinline__ unsigned xb_ld(unsigned* p)              { return __hip_atomic_load(p, __ATOMIC_RELAXED, __HIP_MEMORY_SCOPE_AGENT); }
__device__ __forceinline__ unsigned xb_add(unsigned* p, unsigned v) { return __hip_atomic_fetch_add(p, v, __ATOMIC_RELAXED, __HIP_MEMORY_SCOPE_AGENT); }
__device__ __forceinline__ unsigned xb_xcc_id() { return (unsigned)__builtin_amdgcn_s_getreg((3 << 11) | 20) & 0xFu; }
#define XB_SPIN(cond, bar) do { unsigned _sp = 0; while (cond) { __builtin_amdgcn_s_sleep(1); \
    if ((++_sp & 255u) == 0u) { if (xb_ld(&(bar)[XB_TMO])) break; if (_sp > XB_SPIN_CAP) { atomicAdd(&(bar)[XB_TMO], 1u); break; } } } } while (0)
struct XcdBarrier { unsigned* bar; unsigned x; volatile LAS unsigned* st; };
__device__ __forceinline__ XcdBarrier xcd_barrier_post(unsigned* bar, volatile LAS unsigned* st) {
    XcdBarrier b; b.bar = bar; b.x = xb_xcc_id(); b.st = st;
    if (threadIdx.x == 0) (void)xb_add(&bar[XB_XCNT(b.x)], 1u);
    return b;
}
__device__ __forceinline__ void xcd_barrier_complete(unsigned* bar, unsigned x, unsigned& nloc, unsigned& nx) {
    const unsigned G = gridDim.x * gridDim.y * gridDim.z;
    unsigned sum, cnt, mine, sp = 0u;
    for (;;) {
        sum = 0u; cnt = 0u; mine = 0u;
#pragma unroll
        for (unsigned j = 0; j < 16; ++j) { const unsigned c = xb_ld(&bar[XB_XCNT(j)]); sum += c; cnt += (c > 0u) ? 1u : 0u; mine = (j == x) ? c : mine; }
        if (sum == G) break;
        __builtin_amdgcn_s_sleep(1);
        if ((++sp & 255u) == 0u) { if (xb_ld(&bar[XB_TMO])) break; if (sp > XB_SPIN_CAP) { atomicAdd(&bar[XB_TMO], 1u); break; } }
    }
    nloc = mine > 0u ? mine : 1u; nx = cnt > 0u ? cnt : 1u;
}
__device__ __forceinline__ void xcd_barrier(const XcdBarrier& b) {
    asm volatile("s_waitcnt vmcnt(0)" ::: "memory");
    __syncthreads();
    if (threadIdx.x == 0) {
        unsigned* bar = b.bar;
        __builtin_amdgcn_s_waitcnt(0);
        unsigned nloc = b.st[0], nx = b.st[1];
        if (nloc == 0u) { xcd_barrier_complete(bar, b.x, nloc, nx); b.st[0] = nloc; b.st[1] = nx; }
        const unsigned old = xb_add(&bar[XB_XSUB(b.x)], 1u);
        const unsigned gen = old / nloc;
        if (old + 1u == (gen + 1u) * nloc) {
            __builtin_amdgcn_fence(__ATOMIC_RELEASE, "agent");
            asm volatile("s_waitcnt vmcnt(0)" ::: "memory");
            const unsigned og = xb_add(&bar[XB_TOP], 1u);
            const unsigned tg = og / nx;
            if (og + 1u == (tg + 1u) * nx) xb_add(&bar[XB_TOPGEN], 1u);
            else XB_SPIN(xb_ld(&bar[XB_TOPGEN]) == tg, bar);
            __builtin_amdgcn_fence(__ATOMIC_ACQUIRE, "agent");
            xb_add(&bar[XB_XGEN(b.x)], 1u);
            asm volatile("s_waitcnt vmcnt(0)" ::: "memory");
        } else {
            XB_SPIN(xb_ld(&bar[XB_XGEN(b.x)]) == gen, bar);
            __builtin_amdgcn_fence(__ATOMIC_ACQUIRE, "agent");
            asm volatile("s_waitcnt vmcnt(0)" ::: "memory");
        }
    }
    __syncthreads();
}

namespace pg8 {
constexpr int BM = 256, BK = 64, HALF = 128, HTB = HALF * BK * 2, STAGE_BYTES = 8 * HTB, NXCD = 8, WGM = 8;
__host__ __device__ __forceinline__ int lds_byte(int r, int c) { const int st = (r >> 4) * 2 + (c >> 5), rr = r & 15, cc = c & 31, ob = rr * 64 + cc * 2; return st * 1024 + (ob ^ (((ob >> 9) & 1) << 5)); }
__host__ __device__ __forceinline__ void stage_rc(int b, int& R, int& C) { const int st = b / 1024, sb = b % 1024, swz = sb ^ (((sb >> 9) & 1) << 5); R = (st >> 1) * 16 + swz / 64; C = (st & 1) * 32 + (swz % 64) / 2; }
__host__ __device__ __forceinline__ int perm32(int rho) { const int n = rho >> 4, i = rho & 15; return 8 * (i >> 2) + 4 * n + (i & 3); }

struct Unit { int pm, pn, pb; };
struct Gemm { const bf16_t* A; const bf16_t* Bt; int K; };

struct TileOrder {
    int nM, nN, nwg, G, c; int ts[NEXP];
    __device__ __forceinline__ void init(int nM_, int nN_, int G_, int c_) { nM = nM_; nN = nN_; nwg = nM * nN; G = G_; c = c_;
#pragma unroll
        for (int e = 0; e < NEXP; ++e) ts[e] = (e == 0) ? 0 : 0x7fffffff; }
    __device__ __forceinline__ bool next(int i, Unit& u) const {
        const long L = (long)i * G + c; if (L >= nwg) return false;
        int wgid = (int)L; { const int q = nwg / NXCD, r = nwg % NXCD, xcd = wgid % NXCD, off = wgid / NXCD; wgid = (xcd < r ? xcd * (q + 1) : r * (q + 1) + (xcd - r) * q) + off; }
        const int nig = WGM * nN, gid = wgid / nig, fm = gid * WGM, gsz = (nM - fm) < WGM ? (nM - fm) : WGM;
        u.pm = fm + ((wgid % nig) % gsz); u.pn = (wgid % nig) / gsz;
        int e = 0;
#pragma unroll
        for (int k = 1; k < NEXP; ++k) e += (u.pm >= ts[k]) ? 1 : 0;
        u.pb = e * nN + u.pn; return true;
    }
};

typedef int v8i32 __attribute__((ext_vector_type(8)));
template <class Epi, bool FP8 = false>
__device__ __forceinline__ void gemm_phase(LAS unsigned char* lds, const Gemm g, const TileOrder& S, const Epi& E) {
    int tid_ = threadIdx.x; asm volatile("" : "+v"(tid_));
    const int tid = tid_, wid = __builtin_amdgcn_readfirstlane(tid >> 6), lane = tid & 63, wr = wid >> 2, wc = wid & 3, fr = lane & 15, fq = lane >> 4;
    const int K = g.K, nt = K / BK;
    unsigned voffA[2], voffB[2];
#pragma unroll
    for (int i = 0; i < 2; ++i) { int R, C; stage_rc(tid * 16 + i * 8192, R, C); const int Rb = Epi::PERM ? ((R & ~31) + perm32(R & 31)) : R;
        voffA[i] = (unsigned)(R * K + C) * 2u; voffB[i] = (unsigned)(Rb * K + C) * 2u; }
    const size_t kstep = (size_t)(BK * 2);
    const size_t hstep = (size_t)HALF * K * 2;
    const size_t tstep = 2 * hstep;
    const unsigned ldsw = (unsigned)wid * 1024u;
    const int aoff = lds_byte(wr * 64 + fr, fq * 8), boff = lds_byte(wc * 32 + fr, fq * 8);
#define PG8_SA(b, h) (((b) * 2 + (h)) * HTB)
#define PG8_SB(b, h) ((4 + (b) * 2 + (h)) * HTB)
#define PG8_STAGE(bufoff, gbase, voff) do { _Pragma("unroll") for (int _i = 0; _i < 2; ++_i) \
        __builtin_amdgcn_global_load_lds((const unsigned*)((const char*)(gbase) + (voff)[_i]), (LAS unsigned*)(lds + (bufoff) + ldsw + _i * 8192), 16, 0, 0); } while (0)
#define PG8_LD8(p) __builtin_bit_cast(v8i32, __builtin_shufflevector(*(const LAS u32x4*)(p), *(const LAS u32x4*)((p) + 1024), 0, 1, 2, 3, 4, 5, 6, 7))
#define PG8_LDA(dst, b, h) do { if constexpr (FP8) { _Pragma("unroll") for (int m = 0; m < 4; ++m) dst##8[m] = PG8_LD8(lds + PG8_SA(b, h) + aoff + m * 2048); } \
        else { _Pragma("unroll") for (int m = 0; m < 4; ++m) _Pragma("unroll") for (int k = 0; k < 2; ++k) dst[m][k] = *(const LAS bf16x8*)(lds + PG8_SA(b, h) + aoff + m * 2048 + k * 1024); } } while (0)
#define PG8_LDB(dst, b, h) do { if constexpr (FP8) { _Pragma("unroll") for (int n = 0; n < 2; ++n) dst##8[n] = PG8_LD8(lds + PG8_SB(b, h) + boff + n * 2048); } \
        else { _Pragma("unroll") for (int n = 0; n < 2; ++n) _Pragma("unroll") for (int k = 0; k < 2; ++k) dst[n][k] = *(const LAS bf16x8*)(lds + PG8_SB(b, h) + boff + n * 2048 + k * 1024); } } while (0)
#define PG8_MMA(ai, bj, At, Bt) do { __builtin_amdgcn_s_setprio(1); \
        if constexpr (FP8) { _Pragma("unroll") for (int m = 0; m < 4; ++m) _Pragma("unroll") for (int n = 0; n < 2; ++n) \
            asm volatile("v_mfma_scale_f32_16x16x128_f8f6f4 %0, %1, %2, %0, %3, %3 op_sel_hi:[0,0,0]" : "+v"(acc[ai][bj][m][n]) : "v"(Bt##8[n]), "v"(At##8[m]), "v"(one_scale)); } \
        else { _Pragma("unroll") for (int m = 0; m < 4; ++m) _Pragma("unroll") for (int n = 0; n < 2; ++n) _Pragma("unroll") for (int k = 0; k < 2; ++k) \
            acc[ai][bj][m][n] = __builtin_amdgcn_mfma_f32_16x16x32_bf16(Bt[n][k], At[m][k], acc[ai][bj][m][n], 0, 0, 0); } \
        __builtin_amdgcn_s_setprio(0); } while (0)
#define PG8_WAIT_V(n) asm volatile("s_waitcnt vmcnt(" #n ")" ::: "memory")
#define PG8_WAIT_L(n) asm volatile("s_waitcnt lgkmcnt(" #n ")" ::: "memory")
#define PG8_BAR __builtin_amdgcn_s_barrier()
#define PG8_SCHED __builtin_amdgcn_sched_barrier(0)
    Unit cur, nxt; int ui = 0;
    if (!S.next(0, cur)) return;
    f32x4 acc[2][2][4][2];
#pragma unroll
    for (int a = 0; a < 2; ++a)
#pragma unroll
        for (int b = 0; b < 2; ++b)
#pragma unroll
            for (int m = 0; m < 4; ++m)
#pragma unroll
                for (int n = 0; n < 2; ++n) acc[a][b][m][n] = (f32x4){0.f, 0.f, 0.f, 0.f};
    bf16x8 At[4][2], B0[2][2], B1[2][2]; v8i32 At8[4], B08[2], B18[2];
    int one_scale = 0x7f7f7f7f; asm volatile("" : "+v"(one_scale));
    const char* cA = (const char*)g.A + (size_t)cur.pm * tstep; const char* cB = (const char*)g.Bt + (size_t)cur.pb * tstep;
    PG8_STAGE(PG8_SB(0, 0), cB, voffB); PG8_STAGE(PG8_SA(0, 0), cA, voffA); PG8_STAGE(PG8_SB(0, 1), cB + hstep, voffB); PG8_STAGE(PG8_SA(0, 1), cA + hstep, voffA);
    if (wr == 1) PG8_BAR;
    PG8_WAIT_V(4); PG8_BAR;
    PG8_STAGE(PG8_SB(1, 0), cB + kstep, voffB); PG8_STAGE(PG8_SA(1, 0), cA + kstep, voffA); PG8_STAGE(PG8_SB(1, 1), cB + hstep + kstep, voffB);
    PG8_WAIT_V(6); PG8_BAR;
    for (;;) {
        const bool has_next = S.next(ui + 1, nxt);
        const char* nA = has_next ? (const char*)g.A + (size_t)nxt.pm * tstep : cA; const char* nB = has_next ? (const char*)g.Bt + (size_t)nxt.pb * tstep : cB;
        for (int t = 0; t < nt; t += 2) {
            const bool last = (t == nt - 2);
            const char* a1 = cA + (size_t)(t + 1) * kstep;
            const char* a2 = last ? nA : cA + (size_t)(t + 2) * kstep; const char* b2 = last ? nB : cB + (size_t)(t + 2) * kstep;
            const char* a3 = a2 + kstep; const char* b3 = b2 + kstep;
            PG8_LDB(B0, 0, 0); PG8_SCHED; PG8_LDA(At, 0, 0); PG8_STAGE(PG8_SA(1, 1), a1 + hstep, voffA);
            PG8_WAIT_L(8); PG8_BAR; PG8_WAIT_L(0); PG8_MMA(0, 0, At, B0); PG8_BAR; PG8_SCHED;
            PG8_LDB(B1, 0, 1); PG8_STAGE(PG8_SB(0, 0), b2, voffB);
            PG8_BAR; PG8_WAIT_L(0); PG8_MMA(0, 1, At, B1); PG8_BAR;
            PG8_LDA(At, 0, 1); PG8_STAGE(PG8_SA(0, 0), a2, voffA);
            PG8_BAR; PG8_WAIT_L(0); PG8_MMA(1, 0, At, B0); PG8_BAR; PG8_SCHED;
            PG8_STAGE(PG8_SB(0, 1), b2 + hstep, voffB);
            PG8_WAIT_V(6); PG8_BAR; PG8_MMA(1, 1, At, B1); PG8_BAR;
            PG8_LDB(B0, 1, 0); PG8_SCHED; PG8_LDA(At, 1, 0); PG8_STAGE(PG8_SA(0, 1), a2 + hstep, voffA);
            PG8_WAIT_L(8); PG8_BAR; PG8_WAIT_L(0); PG8_MMA(0, 0, At, B0); PG8_BAR; PG8_SCHED;
            PG8_LDB(B1, 1, 1); PG8_STAGE(PG8_SB(1, 0), b3, voffB);
            PG8_BAR; PG8_WAIT_L(0); PG8_MMA(0, 1, At, B1); PG8_BAR;
            PG8_LDA(At, 1, 1); PG8_STAGE(PG8_SA(1, 0), a3, voffA);
            PG8_BAR; PG8_WAIT_L(0); PG8_MMA(1, 0, At, B0); PG8_BAR; PG8_SCHED;
            PG8_STAGE(PG8_SB(1, 1), b3 + hstep, voffB);
            PG8_WAIT_V(6); PG8_BAR; PG8_MMA(1, 1, At, B1); PG8_BAR;
        }
        if constexpr (FP8) asm volatile("s_nop 15\n\ts_nop 15" ::: "memory");
        E(acc, cur, wr, wc, fr, fq);
        if (!has_next) break;
#pragma unroll
        for (int a = 0; a < 2; ++a)
#pragma unroll
            for (int b = 0; b < 2; ++b)
#pragma unroll
                for (int m = 0; m < 4; ++m)
#pragma unroll
                    for (int n = 0; n < 2; ++n) acc[a][b][m][n] = (f32x4){0.f, 0.f, 0.f, 0.f};
        cur = nxt; cA = nA; cB = nB; ++ui;
    }
    PG8_WAIT_V(0);
    if (wr == 0) PG8_BAR;
    PG8_BAR;
#undef PG8_SA
#undef PG8_SB
#undef PG8_STAGE
#undef PG8_LDA
#undef PG8_LDB
#undef PG8_MMA
#undef PG8_LD8
#undef PG8_WAIT_V
#undef PG8_WAIT_L
#undef PG8_BAR
#undef PG8_SCHED
}

struct EpiQKV {
    static constexpr bool PERM = true;
    bf16_t *Q, *Kk, *V; const float *gq, *gk, *cosT, *sinT; float qscale, isc;
    __device__ __forceinline__ void operator()(const f32x4 (&acc)[2][2][4][2], const Unit& u, int wr, int wc, int fr, int fq) const {
        const int row0 = u.pm * BM + wr * 64 + fr;
        if (u.pn >= 8) {
            const int col0 = (u.pn - 8) * BM + wc * 32 + 8 * fq;
#pragma unroll
            for (int ai = 0; ai < 2; ++ai)
#pragma unroll
                for (int m = 0; m < 4; ++m) { bf16_t* rowp = V + (size_t)(row0 + ai * HALF + m * 16) * DM + col0;
#pragma unroll
                    for (int bj = 0; bj < 2; ++bj) { const f32x4 v0 = acc[ai][bj][m][0] * isc, v1 = acc[ai][bj][m][1] * isc;
                        u32x4 w; w.x = cvt_pk_bf16(v0[0], v0[1]); w.y = cvt_pk_bf16(v0[2], v0[3]); w.z = cvt_pk_bf16(v1[0], v1[1]); w.w = cvt_pk_bf16(v1[2], v1[3]);
                        *(u32x4*)(rowp + bj * HALF) = w; } }
        } else {
            const int part = u.pn >> 2, sh = 4 * (u.pn & 3) + wc;
            bf16_t* dst = part ? Kk : Q; const float* g = part ? gk : gq; const float sc = part ? 1.0f : qscale;
            f32x4 g0[2], g1[2];
#pragma unroll
            for (int n = 0; n < 2; ++n) { g0[n] = *(const f32x4*)(g + 8 * fq + 4 * n); g1[n] = *(const f32x4*)(g + 32 + 8 * fq + 4 * n); }
#pragma unroll
            for (int ai = 0; ai < 2; ++ai)
#pragma unroll
                for (int m = 0; m < 4; ++m) {
                    const int r = row0 + ai * HALF + m * 16; const int pos = r & (SEQ - 1);
                    f32x4 x1[2], x2[2]; float ss = 0.f;
#pragma unroll
                    for (int n = 0; n < 2; ++n) { x1[n] = acc[ai][0][m][n]; x2[n] = acc[ai][1][m][n];
                        ss += (x1[n][0] * x1[n][0] + x1[n][1] * x1[n][1]) + (x1[n][2] * x1[n][2] + x1[n][3] * x1[n][3]);
                        ss += (x2[n][0] * x2[n][0] + x2[n][1] * x2[n][1]) + (x2[n][2] * x2[n][2] + x2[n][3] * x2[n][3]); }
                    ss += __shfl_xor(ss, 16); ss += __shfl_xor(ss, 32);
                    const float rstd = __builtin_amdgcn_rsqf(ss * (isc * isc * (1.0f / 64.0f)) + EPS) * isc;
                    unsigned char* op = (unsigned char*)dst + (size_t)r * DM + sh * 64 + 8 * fq;
                    u32x2 w1, w2;
#pragma unroll
                    for (int n = 0; n < 2; ++n) {
                        const f32x4 cs = *(const f32x4*)(cosT + pos * 32 + 8 * fq + 4 * n), sn = *(const f32x4*)(sinT + pos * 32 + 8 * fq + 4 * n);
                        const f32x4 y1 = x1[n] * rstd * g0[n], y2 = x2[n] * rstd * g1[n];
                        const f32x4 o1 = (y1 * cs - y2 * sn) * sc, o2 = (y2 * cs + y1 * sn) * sc;
                        if (n == 0) { w1.x = pk_fp8x4(o1[0], o1[1], o1[2], o1[3]); w2.x = pk_fp8x4(o2[0], o2[1], o2[2], o2[3]); }
                        else { w1.y = pk_fp8x4(o1[0], o1[1], o1[2], o1[3]); w2.y = pk_fp8x4(o2[0], o2[1], o2[2], o2[3]); }
                    }
                    *(u32x2*)(op) = w1; *(u32x2*)(op + 32) = w2;
                }
        }
    }
};
__device__ __forceinline__ f32x4 ld_x4(const void* p, size_t i, bool is16) {
    if (is16) { const u32x2 w = *(const u32x2*)((const bf16_t*)p + i); return (f32x4){bflo(w.x), bfhi(w.x), bflo(w.y), bfhi(w.y)}; }
    return *(const f32x4*)((const float*)p + i);
}
template <bool IN16>
struct EpiRes {
    static constexpr bool PERM = false;
    const void* xin; bf16_t* xout; const float* gate; float sc;
    __device__ __forceinline__ void operator()(const f32x4 (&acc)[2][2][4][2], const Unit& u, int wr, int wc, int fr, int fq) const {
        const int row0 = u.pm * BM + wr * 64 + fr, col0 = u.pn * BM + wc * 32 + 4 * fq;
        const float* gp = gate + (size_t)(u.pm >> 5) * 6144 + col0;
        f32x4 gv[2][2];
#pragma unroll
        for (int bj = 0; bj < 2; ++bj)
#pragma unroll
            for (int n = 0; n < 2; ++n) gv[bj][n] = *(const f32x4*)(gp + bj * HALF + n * 16) * sc;
#pragma unroll
        for (int ai = 0; ai < 2; ++ai)
#pragma unroll
            for (int m = 0; m < 4; ++m) { const size_t off = (size_t)(row0 + ai * HALF + m * 16) * DM + col0;
                f32x4 xv[2][2];
#pragma unroll
                for (int bj = 0; bj < 2; ++bj)
#pragma unroll
                    for (int n = 0; n < 2; ++n) xv[bj][n] = ld_x4(xin, off + bj * HALF + n * 16, IN16);
#pragma unroll
                for (int bj = 0; bj < 2; ++bj)
#pragma unroll
                    for (int n = 0; n < 2; ++n) { const f32x4 o = xv[bj][n] + gv[bj][n] * acc[ai][bj][m][n];
                        *(u32x2*)(xout + off + bj * HALF + n * 16) = (u32x2){cvt_pk_bf16(o[0], o[1]), cvt_pk_bf16(o[2], o[3])}; }
                if (m == 3) asm volatile("" ::: "memory"); }
    }
};
struct EpiSwiGLU {
    static constexpr bool PERM = true;
    bf16_t* H; int ldh;
    __device__ __forceinline__ void operator()(const f32x4 (&acc)[2][2][4][2], const Unit& u, int wr, int wc, int fr, int fq) const {
        const int row0 = u.pm * BM + wr * 64 + fr, col0 = u.pn * HALF + wc * 32 + 8 * fq;
#pragma unroll
        for (int ai = 0; ai < 2; ++ai)
#pragma unroll
            for (int m = 0; m < 4; ++m) { bf16_t* rowp = H + (size_t)(row0 + ai * HALF + m * 16) * ldh + col0;
                f32x4 v[2];
#pragma unroll
                for (int n = 0; n < 2; ++n) { const f32x4 gt = acc[ai][0][m][n], up = acc[ai][1][m][n];
#pragma unroll
                    for (int j = 0; j < 4; ++j) v[n][j] = fsilu(gt[j]) * up[j]; }
                u32x4 w; w.x = cvt_pk_bf16(v[0][0], v[0][1]); w.y = cvt_pk_bf16(v[0][2], v[0][3]); w.z = cvt_pk_bf16(v[1][0], v[1][1]); w.w = cvt_pk_bf16(v[1][2], v[1][3]);
                *(u32x4*)rowp = w; }
    }
};
struct EpiSwiGLU8 {
    static constexpr bool PERM = true;
    unsigned char* H; int ldh; float ws, hs;
    __device__ __forceinline__ void operator()(const f32x4 (&acc)[2][2][4][2], const Unit& u, int wr, int wc, int fr, int fq) const {
        const int row0 = u.pm * BM + wr * 64 + fr, col0 = u.pn * HALF + wc * 32 + 8 * fq;
#pragma unroll
        for (int ai = 0; ai < 2; ++ai)
#pragma unroll
            for (int m = 0; m < 4; ++m) { unsigned char* rowp = H + (size_t)(row0 + ai * HALF + m * 16) * ldh + col0;
                f32x4 v[2];
#pragma unroll
                for (int n = 0; n < 2; ++n) { const f32x4 gt = acc[ai][0][m][n] * ws, up = acc[ai][1][m][n] * (ws * hs);
#pragma unroll
                    for (int j = 0; j < 4; ++j) v[n][j] = fsilu(gt[j]) * up[j]; }
                *(u32x2*)rowp = (u32x2){pk_fp8x4(v[0][0], v[0][1], v[0][2], v[0][3]), pk_fp8x4(v[1][0], v[1][1], v[1][2], v[1][3])}; }
    }
};
struct EpiPlain {
    static constexpr bool PERM = true;
    bf16_t* O; int ldc; float sc;
    __device__ __forceinline__ void operator()(const f32x4 (&acc)[2][2][4][2], const Unit& u, int wr, int wc, int fr, int fq) const {
        const int row0 = u.pm * BM + wr * 64 + fr, col0 = u.pn * BM + wc * 32 + 8 * fq;
#pragma unroll
        for (int ai = 0; ai < 2; ++ai)
#pragma unroll
            for (int m = 0; m < 4; ++m) { bf16_t* rowp = O + (size_t)(row0 + ai * HALF + m * 16) * ldc + col0;
#pragma unroll
                for (int bj = 0; bj < 2; ++bj) { const f32x4 v0 = acc[ai][bj][m][0] * sc, v1 = acc[ai][bj][m][1] * sc;
                    u32x4 w; w.x = cvt_pk_bf16(v0[0], v0[1]); w.y = cvt_pk_bf16(v0[2], v0[3]); w.z = cvt_pk_bf16(v1[0], v1[1]); w.w = cvt_pk_bf16(v1[2], v1[3]);
                    *(u32x4*)(rowp + bj * HALF) = w; } }
    }
};
struct EpiAct {
    static constexpr bool PERM = true;
    int kind; unsigned char* ws; const float* lb;
    __device__ __forceinline__ void operator()(const f32x4 (&acc)[2][2][4][2], const Unit& u, int wr, int wc, int fr, int fq) const {
        const int row0 = u.pm * BM + wr * 64 + fr;
        int mode, ldc, colt; size_t boff;
        if (kind == 0) { const int grp = u.pn >> 2; colt = (u.pn & 3) * 256; ldc = 1024;
            boff = grp == 0 ? H_Q : grp == 1 ? H_LFF : grp == 2 ? H_LFB : grp == 3 ? H_V : H_G; mode = (grp == 0 || grp == 4) ? 1 : (grp == 3 ? 0 : 3); }
        else { ldc = LRUW; if (u.pn < 5) { boff = L_YB; colt = u.pn * 256; mode = 2; } else { boff = L_XB; colt = (u.pn - 5) * 256; mode = 0; } }
        bf16_t* base = (bf16_t*)(ws + boff);
        const int col0 = colt + wc * 32 + 8 * fq;
        f32x4 lbv[2][2];
        if (mode == 3) { const float* lp = lb + ((u.pn >> 2) - 1) * 1024 + col0;
#pragma unroll
            for (int bj = 0; bj < 2; ++bj)
#pragma unroll
                for (int n = 0; n < 2; ++n) lbv[bj][n] = *(const f32x4*)(lp + bj * HALF + 4 * n); }
#pragma unroll
        for (int ai = 0; ai < 2; ++ai)
#pragma unroll
            for (int m = 0; m < 4; ++m) { bf16_t* rowp = base + (size_t)(row0 + ai * HALF + m * 16) * ldc + col0;
#pragma unroll
                for (int bj = 0; bj < 2; ++bj) { f32x4 v[2]; u32x4 w;
#pragma unroll
                    for (int n = 0; n < 2; ++n) { v[n] = acc[ai][bj][m][n];
                        if (mode == 1) {
#pragma unroll
                            for (int j = 0; j < 4; ++j) v[n][j] = fsilu(v[n][j]); }
                        else if (mode == 2) {
#pragma unroll
                            for (int j = 0; j < 4; ++j) { const float x = v[n][j]; v[n][j] = x * fsigmoid(1.5957691216057308f * (x + 0.044715f * x * x * x)); } }
                        else if (mode == 3) {
#pragma unroll
                            for (int j = 0; j < 4; ++j) { const float l = lbv[bj][n][j]; const float fg = l + (1.0f - l) * fsigmoid(v[n][j]); v[n][j] = __builtin_amdgcn_logf(fg) * 0.6931471805599453f; } }
                    }
                    if (mode == 3) {
#pragma unroll
                        for (int n = 0; n < 2; ++n) { const _Float16 h0 = (_Float16)v[n][0], h1 = (_Float16)v[n][1], h2 = (_Float16)v[n][2], h3 = (_Float16)v[n][3];
                            const unsigned a = (unsigned)__builtin_bit_cast(unsigned short, h0) | ((unsigned)__builtin_bit_cast(unsigned short, h1) << 16);
                            const unsigned b = (unsigned)__builtin_bit_cast(unsigned short, h2) | ((unsigned)__builtin_bit_cast(unsigned short, h3) << 16);
                            if (n == 0) { w.x = a; w.y = b; } else { w.z = a; w.w = b; } }
                    } else { w.x = cvt_pk_bf16(v[0][0], v[0][1]); w.y = cvt_pk_bf16(v[0][2], v[0][3]); w.z = cvt_pk_bf16(v[1][0], v[1][1]); w.w = cvt_pk_bf16(v[1][2], v[1][3]); }
                    *(u32x4*)(rowp + bj * HALF) = w; } }
    }
};
}

struct Args { const float* in[30]; float* out; unsigned char* ws; };
enum { I_X = 0, I_C, I_ADAW, I_ADAB, I_N1G, I_N2G, I_ATWIN, I_ATQN, I_ATKN, I_ATLAM, I_ATSUB, I_ATWOUT, I_HGWIN, I_HGLB, I_HGNG, I_HGWOUT,
       I_LRWIN, I_LRCW, I_LRCB, I_LRWA, I_LRBA, I_LRWX, I_LRBX, I_LRLAM, I_LRWOUT, I_FFGU, I_FFDN, I_MOER, I_MOEGU, I_MOEDN };
enum { SC_LAM0 = 0, SC_LAM1, SC_OML0, SC_OML1, SC_MC0, SC_MC1 };

__device__ __forceinline__ void cvt_item(const float* W, int ldw, int src_col0, bf16_t* WT, int ldt, int dst_row0, int k0, LAS float* scr, int lane) {
#pragma unroll 8
    for (int i = 0; i < 32; ++i) { const int kk = 2 * i + (lane >> 5); scr[kk * 33 + (lane & 31)] = W[(size_t)(k0 + kk) * ldw + src_col0 + (lane & 31)]; }
    LDS_WAIT(); asm volatile("" ::: "memory");
    const int c = lane & 7;
#pragma unroll
    for (int j = 0; j < 4; ++j) { const int n = (lane >> 3) + 8 * j; const LAS float* s = scr + (8 * c) * 33 + n;
        u32x4 o; o.x = cvt_pk_bf16(s[0 * 33], s[1 * 33]); o.y = cvt_pk_bf16(s[2 * 33], s[3 * 33]); o.z = cvt_pk_bf16(s[4 * 33], s[5 * 33]); o.w = cvt_pk_bf16(s[6 * 33], s[7 * 33]);
        *(u32x4*)(WT + (size_t)(dst_row0 + n) * ldt + k0 + 8 * c) = o; }
    LDS_WAIT(); asm volatile("" ::: "memory");
}
__device__ __forceinline__ void cvt_item8(const float* W, int ldw, int src_col0, unsigned char* WT, int ldt, int dst_row0, int k0, float sc, LAS float* scr, int lane) {
#pragma unroll 8
    for (int i = 0; i < 32; ++i) { const int kk = 2 * i + (lane >> 5); scr[kk * 33 + (lane & 31)] = W[(size_t)(k0 + kk) * ldw + src_col0 + (lane & 31)]; }
    LDS_WAIT(); asm volatile("" ::: "memory");
    const int c = lane & 7;
#pragma unroll
    for (int j = 0; j < 4; ++j) { const int n = (lane >> 3) + 8 * j; const LAS float* s = scr + (8 * c) * 33 + n;
        *(u32x2*)(WT + (size_t)(dst_row0 + n) * ldt + k0 + 8 * c) = (u32x2){pk_fp8x4(s[0 * 33] * sc, s[1 * 33] * sc, s[2 * 33] * sc, s[3 * 33] * sc), pk_fp8x4(s[4 * 33] * sc, s[5 * 33] * sc, s[6 * 33] * sc, s[7 * 33] * sc)}; }
    LDS_WAIT(); asm volatile("" ::: "memory");
}
enum { MAP_ID = 0, MAP_QKV = 1, MAP_SWI = 2 };
template <bool F8 = false>
__device__ __forceinline__ void cvt_family(const float* src, size_t sstride, int ninst, int ldw, int K, int ng, int map, int F, bf16_t* dst, size_t dstride,
                                           LAS float* scr, int gw, int NGW, int lane) {
    const int nkb = K / 64, per = nkb * ng, total = ninst * per;
    for (int it = gw; it < total; it += NGW) {
        const int inst = it / per, r = it - inst * per, kb = r / ng, gi = r - kb * ng;
        int sc0;
        if (map == MAP_ID) sc0 = 32 * gi;
        else if (map == MAP_QKV) { const int pn = gi >> 3, bj = (gi >> 2) & 1, wc = gi & 3;
            if (pn < 8) { const int part = pn >> 2, sh = 4 * (pn & 3) + wc; sc0 = part * 1024 + sh * 64 + 32 * bj; } else sc0 = 32 * gi; }
        else { const int pn = gi >> 3, bj = (gi >> 2) & 1, q = gi & 3; sc0 = bj * F + pn * 128 + 32 * q; }
        if constexpr (F8) cvt_item8(src + (size_t)inst * sstride, ldw, sc0, (unsigned char*)dst + (size_t)inst * dstride, K, 32 * gi, 64 * kb, MOE_WSCALE, scr, lane);
        else cvt_item(src + (size_t)inst * sstride, ldw, sc0, dst + (size_t)inst * dstride, K, 32 * gi, 64 * kb, scr, lane);
    }
}

__device__ __forceinline__ void prologue_phase(const Args& A, LAS unsigned char* lds, int bid, int G) {
    const int tid = threadIdx.x, lane = tid & 63, wave = tid >> 6;
    unsigned char* ws = A.ws;
    {
        LAS float* sc = (LAS float*)lds;
        LAS float* red = (LAS float*)(lds + 32768);
        for (int i = tid; i < NBATCH * DM; i += NTHR) { const float cv = A.in[I_C][i]; sc[i] = fsilu(cv); }
        __syncthreads();
        float* mods = (float*)(ws + TB_MODS);
        for (int cb = bid; cb < (DEPTH * 6144) / 128; cb += G) {
            const int col = cb * 128 + (tid & 127), l = col / 6144, e = col - l * 6144, ch = tid >> 7;
            const float* wp = A.in[I_ADAW] + (size_t)l * DM * 6144 + e;
            float a[NBATCH];
#pragma unroll
            for (int b = 0; b < NBATCH; ++b) a[b] = 0.f;
#pragma unroll 4
            for (int d = ch * 256; d < ch * 256 + 256; ++d) { const float w = wp[(size_t)d * 6144];
#pragma unroll
                for (int b = 0; b < NBATCH; ++b) a[b] += sc[b * DM + d] * w; }
#pragma unroll
            for (int b = 0; b < NBATCH; ++b) red[(ch * 128 + (tid & 127)) * 8 + b] = a[b];
            __syncthreads();
            if (tid < 128) { const float bias = A.in[I_ADAB][l * 6144 + e];
#pragma unroll
                for (int b = 0; b < NBATCH; ++b) { const float s = ((red[(0 * 128 + tid) * 8 + b] + red[(1 * 128 + tid) * 8 + b]) + (red[(2 * 128 + tid) * 8 + b] + red[(3 * 128 + tid) * 8 + b])) + bias;
                    mods[((size_t)l * NBATCH + b) * 6144 + e] = s; } }
            __syncthreads();
        }
    }
    {
        float* cosT = (float*)(ws + TB_COS); float* sinT = (float*)(ws + TB_SIN);
        for (int i = bid * NTHR + tid; i < SEQ * 32; i += G * NTHR) {
            const int pos = i >> 5, d = i & 31;
            const float inv = (float)exp(-(double)d * (1.0 / 32.0) * 9.210340371976184);
            const float ang = (float)pos * inv;
            const double rev = (double)ang * 0.15915494309189535; const float fr = (float)(rev - floor(rev));
            cosT[i] = __builtin_amdgcn_cosf(fr); sinT[i] = __builtin_amdgcn_sinf(fr);
        }
        if (bid == 0 && tid < 2) {
            const int a = tid; const float* lm = A.in[I_ATLAM] + a * 256;
            float s1 = 0.f, s2 = 0.f; for (int i = 0; i < 64; ++i) { s1 += lm[i] * lm[64 + i]; s2 += lm[128 + i] * lm[192 + i]; }
            const float linit = 0.8f - 0.6f * expf(-0.3f * (float)(3 * a));
            float mq = 0.f, mk = 0.f; for (int i = 0; i < 64; ++i) { mq = fmaxf(mq, fabsf(A.in[I_ATQN][a * 64 + i])); mk = fmaxf(mk, fabsf(A.in[I_ATKN][a * 64 + i])); }
            float* scal = (float*)(ws + TB_SCAL);
            scal[SC_LAM0 + a] = expf(s1) - expf(s2) + linit; scal[SC_OML0 + a] = 1.0f - linit; scal[SC_MC0 + a] = 8.0f * mq * mk * LOG2E * 1.0001f;
        }
        if (bid == 1) {
            float* lb = (float*)(ws + TB_LB);
            for (int i = tid; i < 2 * 1024; i += NTHR) { const int d = i >> 10, k = i & 1023; const float* p = A.in[I_HGLB] + (size_t)d * DEPTH * 1024 + k;
                float mx = p[0]; for (int l = 1; l < DEPTH; ++l) mx = fmaxf(mx, p[l * 1024]);
                float den = 0.f, num = 0.f; for (int l = 0; l < DEPTH; ++l) { const float e = expf(p[l * 1024] - mx); den += e; if (l == 1) num += e; }
                lb[i] = num / den; }
        }
        if (bid == 2) {
            float* sp = (float*)(ws + TB_SP);
            for (int i = tid; i < 2 * LRUW; i += NTHR) { const float x = -A.in[I_LRLAM][i]; sp[i] = (x > 20.f) ? x : log1pf(expf(x)); }
        }
    }
    {
        LAS float* scr = (LAS float*)(lds + wave * 16384);
        const int vcu = (bid % 8) * (G / 8) + bid / 8;
        const int gw = vcu * NWAVES + wave, NGW = G * NWAVES;
        cvt_family(A.in[I_ATWIN], (size_t)1024 * 3072, 1, 3072, 1024, 96, MAP_QKV, 0, (bf16_t*)(ws + W_QKV), (size_t)3072 * 1024, scr, gw, NGW, lane);
        cvt_family<true>(A.in[I_ATWIN] + (size_t)1024 * 3072, 0, 1, 3072, 1024, 96, MAP_QKV, 0, (bf16_t*)(ws + W_QKV) + (size_t)3072 * 1024, 0, scr, gw, NGW, lane);
        cvt_family(A.in[I_ATWOUT], (size_t)1024 * 1024, 1, 1024, 1024, 32, MAP_ID, 0, (bf16_t*)(ws + W_AO), (size_t)1024 * 1024, scr, gw, NGW, lane);
        cvt_family<true>(A.in[I_ATWOUT] + (size_t)1024 * 1024, 0, 1, 1024, 1024, 32, MAP_ID, 0, (bf16_t*)(ws + W_AO) + (size_t)1024 * 1024, 0, scr, gw, NGW, lane);
        cvt_family(A.in[I_HGWIN], 0, 1, 5120, 1024, 160, MAP_ID, 0, (bf16_t*)(ws + W_HGI), 0, scr, gw, NGW, lane);
        cvt_family(A.in[I_HGWOUT], 0, 1, 1024, 1024, 32, MAP_ID, 0, (bf16_t*)(ws + W_HGO), 0, scr, gw, NGW, lane);
        cvt_family(A.in[I_LRWIN], 0, 1, 2560, 1024, 80, MAP_ID, 0, (bf16_t*)(ws + W_LRI), 0, scr, gw, NGW, lane);
        cvt_family(A.in[I_LRWOUT], 0, 1, 1024, 1280, 32, MAP_ID, 0, (bf16_t*)(ws + W_LRO), 0, scr, gw, NGW, lane);
        for (int it = gw; it < 2 * 20 * 2 * 4; it += NGW) {
            const int part = it / 160, r = it % 160, inst = r >> 3, kb = (r >> 2) & 1, gi = r & 3, d = inst / 10, n = inst % 10;
            const float* src = (part ? A.in[I_LRWX] : A.in[I_LRWA]) + (size_t)inst * 16384;
            cvt_item(src, 128, 32 * gi, (bf16_t*)(ws + W_LRG) + (size_t)(n * 2 + d) * 256 * 128, 128, part * 128 + 32 * gi, 64 * kb, scr, lane);
        }
        static_assert(FP8_DENSE_FROM == 2 || FP8_DENSE_FROM > 3, "dense layer 0 stays bf16; layer 2 optional");
        constexpr int NB16 = (FP8_DENSE_FROM == 2) ? 1 : 2;
        cvt_family(A.in[I_FFGU], (size_t)1024 * 5632, NB16, 5632, 1024, 176, MAP_SWI, DFF, (bf16_t*)(ws + W_FGU), (size_t)5632 * 1024, scr, gw, NGW, lane);
        cvt_family(A.in[I_FFDN], (size_t)2816 * 1024, NB16, 1024, 2816, 32, MAP_ID, 0, (bf16_t*)(ws + W_FDN), (size_t)1024 * 2816, scr, gw, NGW, lane);
        if constexpr (NB16 == 1) {
            cvt_family<true>(A.in[I_FFGU] + (size_t)1024 * 5632, 0, 1, 5632, 1024, 176, MAP_SWI, DFF, (bf16_t*)(ws + W_FGU) + (size_t)5632 * 1024, 0, scr, gw, NGW, lane);
            cvt_family<true>(A.in[I_FFDN] + (size_t)2816 * 1024, 0, 1, 1024, 2816, 32, MAP_ID, 0, (bf16_t*)(ws + W_FDN) + (size_t)1024 * 2816, 0, scr, gw, NGW, lane);
        }
        cvt_family<true>(A.in[I_MOEGU], (size_t)1024 * 7168, 16, 7168, 1024, 224, MAP_SWI, DFFE, (bf16_t*)(ws + W_MGU), (size_t)7168 * 1024, scr, gw, NGW, lane);
        cvt_family<true>(A.in[I_MOEDN], (size_t)3584 * 1024, 16, 1024, 3584, 32, MAP_ID, 0, (bf16_t*)(ws + W_MDN), (size_t)1024 * 3584, scr, gw, NGW, lane);
    }
}

template <bool ROUTER>
__device__ __forceinline__ void norm_phase(const Args& A, LAS unsigned char* lds, int bid, int G, const void* xsrc, bool src16, void* xdst, bool dst16, const float* gain, const float* modl  , int which,
                                           bool combine, const float* modprev  , bool nonorm, const float* router, bool f8out = false) {
    int tid_ = threadIdx.x; asm volatile("" : "+v"(tid_));
    const int tid = tid_, lane = tid & 63, wave = tid >> 6;
    unsigned char* ws = A.ws;
    bf16_t* HM = (bf16_t*)(ws + WS_HM);
    const int* slot = (const int*)(ws + TB_SLOT); const float* gts = (const float*)(ws + TB_GATE);
    const bf16_t* Y = (const bf16_t*)(ws + E_XS);
    LAS int* hist = (LAS int*)lds;
    for (int tb = bid; tb < MTOK / 256; tb += G) {
        const int b = tb >> 5;
        f32x4 ga[4], sh[4], g2[4];
#pragma unroll
        for (int j = 0; j < 4; ++j) { const int c = 256 * j + 4 * lane;
            if (!nonorm) { const f32x4 gv = *(const f32x4*)(gain + c), sv = *(const f32x4*)(modl + (size_t)b * 6144 + (which * 3 + 1) * 1024 + c);
                ga[j] = gv * (sv + 1.0f); sh[j] = *(const f32x4*)(modl + (size_t)b * 6144 + (which * 3) * 1024 + c); }
            if (combine) g2[j] = *(const f32x4*)(modprev + (size_t)b * 6144 + 5 * 1024 + c); }
        f32x4 rw[ROUTER ? 32 : 1];
        if constexpr (ROUTER) {
            if (tid < 8) hist[tid] = 0;
#pragma unroll
            for (int j = 0; j < 4; ++j)
#pragma unroll
                for (int i = 0; i < 4; ++i) { const int c = 256 * j + 4 * lane + i; rw[(j * 4 + i) * 2] = *(const f32x4*)(router + c * 8); rw[(j * 4 + i) * 2 + 1] = *(const f32x4*)(router + c * 8 + 4); }
            __syncthreads();
        }
        for (int i = 0; i < 32; ++i) {
            const int row = tb * 256 + wave * 32 + i;
            f32x4 v[4];
#pragma unroll
            for (int j = 0; j < 4; ++j) v[j] = pg8::ld_x4(xsrc, (size_t)row * DM + 256 * j + 4 * lane, src16);
            if (combine) {
                const int s0 = slot[row * 2], s1 = slot[row * 2 + 1]; const float w0 = gts[row * 2], w1 = gts[row * 2 + 1];
#pragma unroll
                for (int j = 0; j < 4; ++j) { const u32x2 a = *(const u32x2*)(Y + (size_t)s0 * DM + 256 * j + 4 * lane), c2 = *(const u32x2*)(Y + (size_t)s1 * DM + 256 * j + 4 * lane);
                    f32x4 y; y[0] = w0 * bflo(a.x) + w1 * bflo(c2.x); y[1] = w0 * bfhi(a.x) + w1 * bfhi(c2.x); y[2] = w0 * bflo(a.y) + w1 * bflo(c2.y); y[3] = w0 * bfhi(a.y) + w1 * bfhi(c2.y);
                    v[j] = v[j] + g2[j] * y;
                    if (dst16) *(u32x2*)((bf16_t*)xdst + (size_t)row * DM + 256 * j + 4 * lane) = (u32x2){cvt_pk_bf16(v[j][0], v[j][1]), cvt_pk_bf16(v[j][2], v[j][3])};
                    else *(f32x4*)((float*)xdst + (size_t)row * DM + 256 * j + 4 * lane) = v[j]; }
            }
            if (nonorm) continue;
            float ss = 0.f;
#pragma unroll
            for (int j = 0; j < 4; ++j) ss += (v[j][0] * v[j][0] + v[j][1] * v[j][1]) + (v[j][2] * v[j][2] + v[j][3] * v[j][3]);
            ss = wave_sum(ss);
            const float rstd = 1.0f / sqrtf(ss * (1.0f / DM) + EPS);
            f32x4 h[4];
#pragma unroll
            for (int j = 0; j < 4; ++j) { h[j] = v[j] * rstd * ga[j] + sh[j];
                if (f8out) { *(unsigned*)((unsigned char*)HM + (size_t)row * DM + 256 * j + 4 * lane) = pk_fp8x4(h[j][0], h[j][1], h[j][2], h[j][3]); }
                else { u32x2 w; w.x = cvt_pk_bf16(h[j][0], h[j][1]); w.y = cvt_pk_bf16(h[j][2], h[j][3]);
                    *(u32x2*)(HM + (size_t)row * DM + 256 * j + 4 * lane) = w; } }
            if constexpr (ROUTER) {
                float lg[8];
#pragma unroll
                for (int e = 0; e < 8; ++e) lg[e] = 0.f;
#pragma unroll
                for (int j = 0; j < 4; ++j)
#pragma unroll
                    for (int q = 0; q < 4; ++q) { const float hv = h[j][q]; const f32x4 r0 = rw[(j * 4 + q) * 2], r1 = rw[(j * 4 + q) * 2 + 1];
                        lg[0] += hv * r0[0]; lg[1] += hv * r0[1]; lg[2] += hv * r0[2]; lg[3] += hv * r0[3]; lg[4] += hv * r1[0]; lg[5] += hv * r1[1]; lg[6] += hv * r1[2]; lg[7] += hv * r1[3]; }
#pragma unroll
                for (int e = 0; e < 8; ++e) lg[e] = wave_sum(lg[e]);
                int e0 = 0; float v0 = lg[0];
#pragma unroll
                for (int e = 1; e < 8; ++e) if (lg[e] > v0) { v0 = lg[e]; e0 = e; }
                int e1 = -1; float v1 = -3.0e38f;
#pragma unroll
                for (int e = 0; e < 8; ++e) if (e != e0 && lg[e] > v1) { v1 = lg[e]; e1 = e; }
                const float p1 = frcp(1.0f + fexp(v1 - v0));
                if (lane == 0) { int* eid = (int*)(ws + TB_EID); float* gt = (float*)(ws + TB_GATE);
                    eid[row * 2] = e0; eid[row * 2 + 1] = e1; gt[row * 2] = p1; gt[row * 2 + 1] = 1.0f - p1;
                    atomicAdd((int*)&hist[e0], 1); atomicAdd((int*)&hist[e1], 1); }
            }
        }
        if constexpr (ROUTER) {
            __syncthreads();
            if (tid < 8) ((int*)(ws + TB_BCNT))[tb * 8 + tid] = hist[tid];
            __syncthreads();
        }
    }
}

namespace lru {
constexpr int XCF = 0, XCB = 16384, AA = 24576, UU = 40960, LAA = 57344;
__device__ __forceinline__ int sw256(int row, int cb) { return row * 256 + (cb ^ ((row & 15) << 4)); }
__device__ __forceinline__ int crow(int r, int hi) { return (r & 3) + 8 * (r >> 2) + 4 * hi; }
template <int MODE>
__device__ __forceinline__ void lru_item(const Args& A, LAS unsigned char* lds, int b, int n, int seg, int dir) {
    int tid_ = threadIdx.x; asm volatile("" : "+v"(tid_));
    const int tid = tid_, wid = tid >> 6, lane = tid & 63, r = lane & 31, hh = lane >> 5;
    unsigned char* ws = A.ws;
    const bf16_t* XB = (const bf16_t*)(ws + L_XB); const bf16_t* YB = (const bf16_t*)(ws + L_YB); bf16_t* HF = (bf16_t*)(ws + L_HF); bf16_t* HY = (bf16_t*)(ws + L_HY);
    bf16_t* LAg = (bf16_t*)(ws + (dir ? L_HY : L_HF)); bf16_t* Ug = (bf16_t*)(ws + L_U + (size_t)dir * SZ_LRU);
    const int ct = tid >> 4, cg = tid & 15, cc0 = n * 128 + 8 * cg;
    float carry = 0.f, P = 1.f;
    if (MODE != 0 && tid < 128) carry = ((const float*)(ws + TB_LCIN))[(size_t)((b * 32 + seg) * 2 + dir) * LRUW + n * 128 + tid];
    if constexpr (MODE == 0) {
        const bf16_t* Wg = (const bf16_t*)(ws + W_LRG) + (size_t)((n * 2 + dir) * 256 + ((r < 16) ? (16 * wid + r) : (128 + 16 * wid + r - 16))) * 128 + 8 * hh;
        bf16x8 bfrag[8];
#pragma unroll
        for (int ks = 0; ks < 8; ++ks) bfrag[ks] = *(const bf16x8*)(Wg + 16 * ks);
        const int cch = n * 128 + 16 * wid + (r & 15);
        const float nba = -LOG2E * A.in[I_LRBA][dir * LRUW + cch], nbx = -LOG2E * A.in[I_LRBX][dir * LRUW + cch], csp = -8.0f * LOG2E * ((const float*)(ws + TB_SP))[dir * LRUW + cch];
        float cw[4][8], cb[8];
#pragma unroll
        for (int j = 0; j < 8; ++j) { cb[j] = A.in[I_LRCB][cc0 + j];
#pragma unroll
            for (int w = 0; w < 4; ++w) cw[w][j] = A.in[I_LRCW][w * LRUW + cc0 + j]; }
        u32x4 xr[4];
#define LRU_XLOAD(si_) do { const int sub_ = dir ? (7 - (si_)) : (si_); const int tok_ = seg * 256 + sub_ * 32 + ct; \
        _Pragma("unroll") for (int w = 0; w < 4; ++w) { const int tt = tok_ - 1 + w; xr[w] = (tt >= 0 && tt < SEQ) ? *(const u32x4*)(XB + ((size_t)b * SEQ + tt) * LRUW + cc0) : (u32x4){0u, 0u, 0u, 0u}; } } while (0)
        LRU_XLOAD(0);
        for (int si = 0; si < 8; ++si) {
            const int sub = dir ? (7 - si) : si; const int t0 = seg * 256 + sub * 32;
            {
                float xc[8];
#pragma unroll
                for (int j = 0; j < 8; ++j) xc[j] = cb[j];
#pragma unroll
                for (int w = 0; w < 4; ++w) { const u32x4 v = xr[w];
#pragma unroll
                    for (int e = 0; e < 4; ++e) { xc[2 * e] += cw[w][2 * e] * bflo(v[e]); xc[2 * e + 1] += cw[w][2 * e + 1] * bfhi(v[e]); } }
                if (si + 1 < 8) LRU_XLOAD(si + 1);
                *(LAS f32x4*)(lds + XCF + (ct * 128 + 8 * cg) * 4) = (f32x4){xc[0], xc[1], xc[2], xc[3]};
                *(LAS f32x4*)(lds + XCF + (ct * 128 + 8 * cg + 4) * 4) = (f32x4){xc[4], xc[5], xc[6], xc[7]};
                *(LAS u32x4*)(lds + XCB + sw256(ct, 16 * cg)) = (u32x4){cvt_pk_bf16(xc[0], xc[1]), cvt_pk_bf16(xc[2], xc[3]), cvt_pk_bf16(xc[4], xc[5]), cvt_pk_bf16(xc[6], xc[7])};
            }
            __syncthreads();
            {
                f32x16 acc = {};
#pragma unroll
                for (int ks = 0; ks < 8; ++ks) { const bf16x8 fa = *(const LAS bf16x8*)(lds + XCB + sw256(r, (16 * ks + 8 * hh) * 2)); acc = __builtin_amdgcn_mfma_f32_32x32x16_bf16(fa, bfrag[ks], acc, 0, 0, 0); }
#pragma unroll
                for (int q = 0; q < 8; ++q) {
                    const auto sw = __builtin_amdgcn_permlane16_swap(__float_as_uint(acc[q]), __float_as_uint(acc[8 + q]), false, false);
                    const float rp = __uint_as_float(sw[0]), ip = __uint_as_float(sw[1]);
                    const int tq = crow((r < 16) ? q : (8 + q), hh); const int cl = 16 * wid + (r & 15);
                    const float xcv = ((const LAS float*)(lds + XCF))[tq * 128 + cl];
                    const float rg = frcp(1.0f + fexp2(fmaf(rp, -LOG2E, nba))), ig = frcp(1.0f + fexp2(fmaf(ip, -LOG2E, nbx)));
                    const float la = csp * rg, av = fexp2(la), uv = __builtin_amdgcn_sqrtf(fmaxf(fmaf(-av, av, 1.0f), 0.f)) * ig * xcv;
                    ((LAS float*)(lds + AA))[tq * 128 + cl] = av; ((LAS float*)(lds + UU))[tq * 128 + cl] = uv; ((LAS float*)(lds + LAA))[tq * 128 + cl] = la; }
            }
            __syncthreads();
            if (tid < 128) {
                LAS float* ap = (LAS float*)(lds + AA) + tid; LAS float* up = (LAS float*)(lds + UU) + tid; float av[32], uv[32];
#pragma unroll
                for (int i = 0; i < 32; ++i) { av[i] = ap[i * 128]; uv[i] = up[i * 128]; }
                if (dir == 0) {
#pragma unroll
                    for (int i = 0; i < 32; ++i) { carry = av[i] * carry + uv[i]; P *= av[i]; } }
                else {
#pragma unroll
                    for (int i = 31; i >= 0; --i) { carry = av[i] * carry + uv[i]; P *= av[i]; } }
            } else if (tid >= 256) {
                const int t2 = tid - 256, row = t2 >> 3, c16 = (t2 & 7) * 16; const size_t go = ((size_t)b * SEQ + t0 + row) * LRUW + n * 128 + c16;
                const LAS float* lp = (const LAS float*)(lds + LAA) + row * 128 + c16; const LAS float* up = (const LAS float*)(lds + UU) + row * 128 + c16;
                f32x4 l[4], u[4];
#pragma unroll
                for (int j = 0; j < 4; ++j) { l[j] = *(const LAS f32x4*)(lp + 4 * j); u[j] = *(const LAS f32x4*)(up + 4 * j); }
#pragma unroll
                for (int j = 0; j < 2; ++j) {
                    *(u32x4*)(LAg + go + 8 * j) = (u32x4){cvt_pk_bf16(l[2 * j][0], l[2 * j][1]), cvt_pk_bf16(l[2 * j][2], l[2 * j][3]), cvt_pk_bf16(l[2 * j + 1][0], l[2 * j + 1][1]), cvt_pk_bf16(l[2 * j + 1][2], l[2 * j + 1][3])};
                    *(u32x4*)(Ug + go + 8 * j) = (u32x4){cvt_pk_bf16(u[2 * j][0], u[2 * j][1]), cvt_pk_bf16(u[2 * j][2], u[2 * j][3]), cvt_pk_bf16(u[2 * j + 1][0], u[2 * j + 1][1]), cvt_pk_bf16(u[2 * j + 1][2], u[2 * j + 1][3])}; }
            }
            __syncthreads();
        }
#undef LRU_XLOAD
        if (tid < 128) { float* sm = (float*)(ws + TB_LSUM) + (size_t)(((b * 32 + seg) * 2 + dir) * 2) * LRUW + n * 128 + tid; sm[0] = P; sm[LRUW] = carry; }
    } else {
        u32x4 lr, ur;
#define LRU_GLOAD(si_) do { const int sub_ = dir ? (7 - (si_)) : (si_); const size_t go_ = ((size_t)b * SEQ + seg * 256 + sub_ * 32 + ct) * LRUW + cc0; \
        lr = *(const u32x4*)(LAg + go_); ur = *(const u32x4*)(Ug + go_); } while (0)
        LRU_GLOAD(0);
        for (int si = 0; si < 8; ++si) {
            const int sub = dir ? (7 - si) : si; const int t0 = seg * 256 + sub * 32;
            {   const u32x4 l = lr, u = ur;
                if (si + 1 < 8) LRU_GLOAD(si + 1);
                *(LAS f32x4*)(lds + AA + (ct * 128 + 8 * cg) * 4) = (f32x4){fexp2(bflo(l[0])), fexp2(bfhi(l[0])), fexp2(bflo(l[1])), fexp2(bfhi(l[1]))};
                *(LAS f32x4*)(lds + AA + (ct * 128 + 8 * cg + 4) * 4) = (f32x4){fexp2(bflo(l[2])), fexp2(bfhi(l[2])), fexp2(bflo(l[3])), fexp2(bfhi(l[3]))};
                *(LAS f32x4*)(lds + UU + (ct * 128 + 8 * cg) * 4) = (f32x4){bflo(u[0]), bfhi(u[0]), bflo(u[1]), bfhi(u[1])};
                *(LAS f32x4*)(lds + UU + (ct * 128 + 8 * cg + 4) * 4) = (f32x4){bflo(u[2]), bfhi(u[2]), bflo(u[3]), bfhi(u[3])}; }
            __syncthreads();
            if (tid < 128) {
                LAS float* ap = (LAS float*)(lds + AA) + tid; LAS float* up = (LAS float*)(lds + UU) + tid; float av[32], uv[32];
#pragma unroll
                for (int i = 0; i < 32; ++i) { av[i] = ap[i * 128]; uv[i] = up[i * 128]; }
                if (dir == 0) {
#pragma unroll
                    for (int i = 0; i < 32; ++i) { carry = av[i] * carry + uv[i]; uv[i] = carry; } }
                else {
#pragma unroll
                    for (int i = 31; i >= 0; --i) { carry = av[i] * carry + uv[i]; uv[i] = carry; } }
#pragma unroll
                for (int i = 0; i < 32; ++i) up[i * 128] = uv[i];
            }
            __syncthreads();
            {   const int tok = t0 + ct; const size_t go = ((size_t)b * SEQ + tok) * LRUW + cc0;
                const f32x4 h0 = *(const LAS f32x4*)(lds + UU + (ct * 128 + 8 * cg) * 4), h1 = *(const LAS f32x4*)(lds + UU + (ct * 128 + 8 * cg + 4) * 4);
                if (MODE == 1) { *(u32x4*)(HF + go) = (u32x4){cvt_pk_bf16(h0[0], h0[1]), cvt_pk_bf16(h0[2], h0[3]), cvt_pk_bf16(h1[0], h1[1]), cvt_pk_bf16(h1[2], h1[3])}; }
                else { const u32x4 f = *(const u32x4*)(HF + go), y = *(const u32x4*)(YB + go);
                    *(u32x4*)(HY + go) = (u32x4){cvt_pk_bf16((h0[0] + bflo(f[0])) * bflo(y[0]), (h0[1] + bfhi(f[0])) * bfhi(y[0])), cvt_pk_bf16((h0[2] + bflo(f[1])) * bflo(y[1]), (h0[3] + bfhi(f[1])) * bfhi(y[1])),
                                                cvt_pk_bf16((h1[0] + bflo(f[2])) * bflo(y[2]), (h1[1] + bfhi(f[2])) * bfhi(y[2])), cvt_pk_bf16((h1[2] + bflo(f[3])) * bflo(y[3]), (h1[3] + bfhi(f[3])) * bfhi(y[3]))}; }
            }
            __syncthreads();
        }
#undef LRU_GLOAD
    }
}
__device__ __forceinline__ void lru_apply_item(const Args& A, LAS unsigned char* lds, int b, int n, int seg) {
    constexpr int HFL = 57344;
    int tid_ = threadIdx.x; asm volatile("" : "+v"(tid_));
    const int tid = tid_;
    unsigned char* ws = A.ws;
    const bf16_t* YB = (const bf16_t*)(ws + L_YB); bf16_t* HY = (bf16_t*)(ws + L_HY);
    const int ct = tid >> 4, cg = tid & 15, cc0 = n * 128 + 8 * cg;
#pragma unroll 1
    for (int dir = 0; dir < 2; ++dir) {
        const bf16_t* LAg = (const bf16_t*)(ws + (dir ? L_HY : L_HF)); const bf16_t* Ug = (const bf16_t*)(ws + L_U + (size_t)dir * SZ_LRU);
        float carry = 0.f;
        if (tid < 128) carry = ((const float*)(ws + TB_LCIN))[(size_t)((b * 32 + seg) * 2 + dir) * LRUW + n * 128 + tid];
        u32x4 lr, ur, yr = {0u, 0u, 0u, 0u};
#define LRU_GLOAD(si_) do { const int sub_ = dir ? (7 - (si_)) : (si_); const size_t go_ = ((size_t)b * SEQ + seg * 256 + sub_ * 32 + ct) * LRUW + cc0; \
        lr = *(const u32x4*)(LAg + go_); ur = *(const u32x4*)(Ug + go_); if (dir) yr = *(const u32x4*)(YB + go_); } while (0)
        LRU_GLOAD(0);
        for (int si = 0; si < 8; ++si) {
            const int sub = dir ? (7 - si) : si; const int t0 = seg * 256 + sub * 32;
            const u32x4 l = lr, u = ur, y = yr;
            if (si + 1 < 8) LRU_GLOAD(si + 1);
            *(LAS f32x4*)(lds + AA + (ct * 128 + 8 * cg) * 4) = (f32x4){fexp2(bflo(l[0])), fexp2(bfhi(l[0])), fexp2(bflo(l[1])), fexp2(bfhi(l[1]))};
            *(LAS f32x4*)(lds + AA + (ct * 128 + 8 * cg + 4) * 4) = (f32x4){fexp2(bflo(l[2])), fexp2(bfhi(l[2])), fexp2(bflo(l[3])), fexp2(bfhi(l[3]))};
            *(LAS f32x4*)(lds + UU + (ct * 128 + 8 * cg) * 4) = (f32x4){bflo(u[0]), bfhi(u[0]), bflo(u[1]), bfhi(u[1])};
            *(LAS f32x4*)(lds + UU + (ct * 128 + 8 * cg + 4) * 4) = (f32x4){bflo(u[2]), bfhi(u[2]), bflo(u[3]), bfhi(u[3])};
            __syncthreads();
            if (tid < 128) {
                LAS float* ap = (LAS float*)(lds + AA) + tid; LAS float* up = (LAS float*)(lds + UU) + tid; float av[32], uv[32];
#pragma unroll
                for (int i = 0; i < 32; ++i) { av[i] = ap[i * 128]; uv[i] = up[i * 128]; }
                if (dir == 0) {
#pragma unroll
                    for (int i = 0; i < 32; ++i) { carry = av[i] * carry + uv[i]; uv[i] = carry; } }
                else {
#pragma unroll
                    for (int i = 31; i >= 0; --i) { carry = av[i] * carry + uv[i]; uv[i] = carry; } }
#pragma unroll
                for (int i = 0; i < 32; ++i) up[i * 128] = uv[i];
            }
            __syncthreads();
            {   const f32x4 h0 = *(const LAS f32x4*)(lds + UU + (ct * 128 + 8 * cg) * 4), h1 = *(const LAS f32x4*)(lds + UU + (ct * 128 + 8 * cg + 4) * 4);
                LAS u32x4* hf = (LAS u32x4*)(lds + HFL + ((sub * 32 + ct) * 128 + 8 * cg) * 2);
                if (dir == 0) *hf = (u32x4){cvt_pk_bf16(h0[0], h0[1]), cvt_pk_bf16(h0[2], h0[3]), cvt_pk_bf16(h1[0], h1[1]), cvt_pk_bf16(h1[2], h1[3])};
                else { const u32x4 f = *hf; const size_t go = ((size_t)b * SEQ + t0 + ct) * LRUW + cc0;
                    *(u32x4*)(HY + go) = (u32x4){cvt_pk_bf16((h0[0] + bflo(f[0])) * bflo(y[0]), (h0[1] + bfhi(f[0])) * bfhi(y[0])), cvt_pk_bf16((h0[2] + bflo(f[1])) * bflo(y[1]), (h0[3] + bfhi(f[1])) * bfhi(y[1])),
                                                cvt_pk_bf16((h1[0] + bflo(f[2])) * bflo(y[2]), (h1[1] + bfhi(f[2])) * bfhi(y[2])), cvt_pk_bf16((h1[2] + bflo(f[3])) * bflo(y[3]), (h1[3] + bfhi(f[3])) * bfhi(y[3]))}; }
            }
            __syncthreads();
        }
#undef LRU_GLOAD
    }
}
}
__device__ __forceinline__ void lru_apply_phase(const Args& A, LAS unsigned char* lds, int bid, int G) {
    for (int it = bid; it < 2560; it += G) lru::lru_apply_item(A, lds, it / 320, (it >> 5) % 10, it & 31);
}
template <int MODE>
__device__ __forceinline__ void lru_phase(const Args& A, LAS unsigned char* lds, int bid, int G) {
    const int nitems = (MODE == 0) ? 5120 : 2560;
    for (int it = bid; it < nitems; it += G) {
        int b, n, seg, dir;
        if (MODE == 0) { dir = it & 1; const int r = it >> 1; seg = r & 31; n = (r >> 5) % 10; b = r / 320; }
        else { dir = MODE - 1; seg = it & 31; n = (it >> 5) % 10; b = it / 320; }
        lru::lru_item<MODE>(A, lds, b, n, seg, dir);
    }
}
__device__ __forceinline__ void lru_carry_phase(const Args& A, int bid, int G) {
    const float* sm = (const float*)(A.ws + TB_LSUM); float* cin = (float*)(A.ws + TB_LCIN);
    for (int idx = bid * NTHR + threadIdx.x; idx < NBATCH * 2 * LRUW; idx += G * NTHR) {
        const int b = idx / (2 * LRUW), r = idx % (2 * LRUW), dir = r / LRUW, ch = r % LRUW; float carry = 0.f;
        for (int i = 0; i < 32; ++i) { const int sg = dir ? (31 - i) : i; const size_t o = (size_t)((b * 32 + sg) * 2 + dir);
            cin[o * LRUW + ch] = carry; carry = sm[o * 2 * LRUW + ch] * carry + sm[o * 2 * LRUW + LRUW + ch]; }
    }
}

__device__ __forceinline__ void place_phase(const Args& A, LAS unsigned char* lds, int bid, int G) {
    int tid_ = threadIdx.x; asm volatile("" : "+v"(tid_));
    const int tid = tid_, lane = tid & 63, wave = tid >> 6; unsigned char* ws = A.ws;
    const int* bcnt = (const int*)(ws + TB_BCNT); const int* eid = (const int*)(ws + TB_EID); int* slot = (int*)(ws + TB_SLOT);
    const bf16_t* HM = (const bf16_t*)(ws + WS_HM); bf16_t* XS = (bf16_t*)(ws + E_XS);
    LAS int* tot = (LAS int*)lds; LAS int* pre = tot + 8; LAS int* rb = tot + 16; LAS int* wcn = tot + 32; LAS int* sl = tot + 64;
    for (int tb = bid; tb < MTOK / 256; tb += G) {
        { int t_ = 0, p_ = 0;
#pragma unroll
            for (int j = 0; j < 4; ++j) { const int blk = lane + 64 * j; const int v = bcnt[blk * 8 + wave]; t_ += v; p_ += (blk < tb) ? v : 0; }
#pragma unroll
            for (int o = 1; o < 64; o <<= 1) { t_ += __shfl_xor(t_, o); p_ += __shfl_xor(p_, o); }
            if (lane == 0) { tot[wave] = t_; pre[wave] = p_; } }
        __syncthreads();
        if (tid == 0) { int acc = 0; for (int e = 0; e < 8; ++e) { rb[e] = acc * 256; if (tb == 0) ((int*)(ws + TB_TILES))[e] = acc; acc += (tot[e] + 255) >> 8; } if (tb == 0) ((int*)(ws + TB_TILES))[8] = acc; }
        int e0 = -1, e1 = -1; unsigned long long mk0 = 0, mk1 = 0;
        if (tid < 256) { e0 = eid[(tb * 256 + tid) * 2]; e1 = eid[(tb * 256 + tid) * 2 + 1];
#pragma unroll
            for (int e = 0; e < 8; ++e) { const unsigned long long m = __ballot(e0 == e || e1 == e); if (lane == 0) wcn[wave * 8 + e] = __popcll(m); if (e0 == e) mk0 = m; if (e1 == e) mk1 = m; } }
        __syncthreads();
        if (tid < 256) { const unsigned long long lt = (1ull << lane) - 1ull; int b0 = rb[e0] + pre[e0] + __popcll(mk0 & lt), b1 = rb[e1] + pre[e1] + __popcll(mk1 & lt);
            for (int w = 0; w < wave; ++w) { b0 += wcn[w * 8 + e0]; b1 += wcn[w * 8 + e1]; }
            sl[tid * 2] = b0; sl[tid * 2 + 1] = b1; slot[(tb * 256 + tid) * 2] = b0; slot[(tb * 256 + tid) * 2 + 1] = b1; }
        __syncthreads();
        for (int i = 0; i < 32; ++i) { const int t = wave * 32 + i; const int s0 = sl[t * 2], s1 = sl[t * 2 + 1];
            const bf16_t* src = HM + (size_t)(tb * 256 + t) * DM + lane * 16;
            const u32x4 a = *(const u32x4*)src, b = *(const u32x4*)(src + 8);
            const u32x4 q = {pk_fp8x4(bflo(a[0]), bfhi(a[0]), bflo(a[1]), bfhi(a[1])), pk_fp8x4(bflo(a[2]), bfhi(a[2]), bflo(a[3]), bfhi(a[3])),
                             pk_fp8x4(bflo(b[0]), bfhi(b[0]), bflo(b[1]), bfhi(b[1])), pk_fp8x4(bflo(b[2]), bfhi(b[2]), bflo(b[3]), bfhi(b[3]))};
            *(u32x4*)((unsigned char*)XS + (size_t)s0 * DM + lane * 16) = q; *(u32x4*)((unsigned char*)XS + (size_t)s1 * DM + lane * 16) = q; }
        __syncthreads();
    }
}

namespace att {
constexpr int KVBLK = 64;
#define SBAR() __builtin_amdgcn_sched_barrier(0)
typedef int v8i __attribute__((ext_vector_type(8)));
__device__ __forceinline__ int crow(int r, int hi) { return (r & 3) + 8 * (r >> 2) + 4 * hi; }
constexpr int SLOTB = 8192;
__device__ __forceinline__ int k_slot(int s) { return s * SLOTB; }
__device__ __forceinline__ int v_slot(int s) { return 65536 + s * SLOTB; }
__device__ __forceinline__ int kswz(int row) { return ((row & 7) ^ (row >> 4)) & 7; }
__device__ __forceinline__ int vswz(int row) { return (row >> 2) & 3; }
__device__ __forceinline__ void mfma8_acc(f32x16& acc, const v8i& a, const v8i& b, int sc) {
    asm volatile("s_nop 4\n\tv_mfma_scale_f32_32x32x64_f8f6f4 %0, %1, %2, %0, %3, %3 op_sel_hi:[0,0,0]" : "+v"(acc) : "v"(a), "v"(b), "v"(sc) : "memory");
}
__device__ __forceinline__ void mfma8_c(f32x16& d, const v8i& a, const v8i& b, const f32x16& c, int sa, int sb) {
    asm volatile("v_mfma_scale_f32_32x32x64_f8f6f4 %0, %1, %2, %3, %4, %5 op_sel_hi:[0,0,0]" : "=&v"(d) : "v"(a), "v"(b), "v"(c), "v"(sa), "v"(sb) : "memory");
}
#define ATT_LD8(p0_, p1_) __builtin_bit_cast(v8i, __builtin_shufflevector(*(const LAS u32x4*)(p0_), *(const LAS u32x4*)(p1_), 0, 1, 2, 3, 4, 5, 6, 7))
__device__ __forceinline__ void qkt(f32x16& p0, f32x16& p1, const LAS char* Ks, const v8i& qr, int r32, int hi, int jj, const f32x16& cinit, int s1, int s8) {
    const int c0 = jj * 4 + 2 * hi;
    { const int row = r32; const v8i kf = ATT_LD8(Ks + row * 128 + ((c0 ^ kswz(row)) << 4), Ks + row * 128 + (((c0 + 1) ^ kswz(row)) << 4)); mfma8_c(p0, kf, qr, cinit, s1, s8); }
    { const int row = 32 + r32; const v8i kf = ATT_LD8(Ks + row * 128 + ((c0 ^ kswz(row)) << 4), Ks + row * 128 + (((c0 + 1) ^ kswz(row)) << 4)); mfma8_c(p1, kf, qr, cinit, s1, s8); }
}
__device__ __forceinline__ void load_kf(v8i& kf0, v8i& kf1, const LAS char* Ks, int r32, int hi, int jj) {
    const int c0 = jj * 4 + 2 * hi, row1 = 32 + r32;
    kf0 = ATT_LD8(Ks + r32 * 128 + ((c0 ^ kswz(r32)) << 4), Ks + r32 * 128 + (((c0 + 1) ^ kswz(r32)) << 4));
    kf1 = ATT_LD8(Ks + row1 * 128 + ((c0 ^ kswz(row1)) << 4), Ks + row1 * 128 + (((c0 + 1) ^ kswz(row1)) << 4));
}
#define ATT_VFR(Vs, d0) ATT_LD8((Vs) + (32 * (d0) + r32) * 64 + (((2 * hi) ^ vswz(32 * (d0) + r32)) << 4), (Vs) + (32 * (d0) + r32) * 64 + (((2 * hi + 1) ^ vswz(32 * (d0) + r32)) << 4))
__device__ __forceinline__ void pack_p(const float (&pe)[32], v8i& pa);
__device__ __forceinline__ void qkt_pack(f32x16& p0, f32x16& p1, const v8i& kf0, const v8i& kf1, const v8i& qr, const f32x16& cinit, int s1, int s8, const float (&pe)[32], v8i& pa) {
#define ATT_MC8(d, kf, B, O0, O1, O2, O3) \
    asm volatile("v_mfma_scale_f32_32x32x64_f8f6f4 %0, %21, %22, %23, %24, %25 op_sel_hi:[0,0,0]\n\t" \
                 "v_cvt_pk_fp8_f32 %1, %5, %6\n\tv_cvt_pk_fp8_f32 %1, %7, %8 op_sel:[0,0,1]\n\t" \
                 "v_cvt_pk_fp8_f32 %2, %9, %10\n\tv_cvt_pk_fp8_f32 %2, %11, %12 op_sel:[0,0,1]\n\t" \
                 "v_cvt_pk_fp8_f32 %3, %13, %14\n\tv_cvt_pk_fp8_f32 %3, %15, %16 op_sel:[0,0,1]\n\t" \
                 "v_cvt_pk_fp8_f32 %4, %17, %18\n\tv_cvt_pk_fp8_f32 %4, %19, %20 op_sel:[0,0,1]" \
                 : "=&v"(d), "=&v"(O0), "=&v"(O1), "=&v"(O2), "=&v"(O3) \
                 : "v"(pe[B]), "v"(pe[B + 1]), "v"(pe[B + 2]), "v"(pe[B + 3]), "v"(pe[B + 4]), "v"(pe[B + 5]), "v"(pe[B + 6]), "v"(pe[B + 7]), \
                   "v"(pe[B + 8]), "v"(pe[B + 9]), "v"(pe[B + 10]), "v"(pe[B + 11]), "v"(pe[B + 12]), "v"(pe[B + 13]), "v"(pe[B + 14]), "v"(pe[B + 15]), \
                   "v"(kf), "v"(qr), "v"(cinit), "v"(s1), "v"(s8) : "memory")
    int q0, q1, q2, q3, q4, q5, q6, q7;
    ATT_MC8(p0, kf0, 0, q0, q1, q2, q3);
    ATT_MC8(p1, kf1, 16, q4, q5, q6, q7);
#undef ATT_MC8
    pa = (v8i){q0, q1, q2, q3, q4, q5, q6, q7};
}
__device__ __forceinline__ void partialSM(f32x16& p0) {
#pragma unroll
    for (int r = 0; r < 16; ++r) p0[r] = fexp2(p0[r]);
}
__device__ __forceinline__ void finishSM(f32x16& p0, f32x16& p1, v8i& pa) {
#pragma unroll
    for (int r = 0; r < 16; ++r) p1[r] = fexp2(p1[r]);
#pragma unroll
    for (int w = 0; w < 4; ++w) { pa[w] = (int)pk_fp8x4(p0[4 * w], p0[4 * w + 1], p0[4 * w + 2], p0[4 * w + 3]); pa[4 + w] = (int)pk_fp8x4(p1[4 * w], p1[4 * w + 1], p1[4 * w + 2], p1[4 * w + 3]); }
}
#define ATT_MX7(acc, a, b, sc, NOP, O, I, k) \
    asm volatile(NOP "v_mfma_scale_f32_32x32x64_f8f6f4 %0, %15, %16, %0, %17, %17 op_sel_hi:[0,0,0]\n\tv_exp_f32 %1, %8\n\tv_exp_f32 %2, %9\n\tv_exp_f32 %3, %10\n\tv_exp_f32 %4, %11\n\tv_exp_f32 %5, %12\n\tv_exp_f32 %6, %13\n\tv_exp_f32 %7, %14" \
                 : "+v"(acc), "=&v"(O[k]), "=&v"(O[k + 1]), "=&v"(O[k + 2]), "=&v"(O[k + 3]), "=&v"(O[k + 4]), "=&v"(O[k + 5]), "=&v"(O[k + 6]) \
                 : "v"(I(k)), "v"(I(k + 1)), "v"(I(k + 2)), "v"(I(k + 3)), "v"(I(k + 4)), "v"(I(k + 5)), "v"(I(k + 6)), "v"(a), "v"(b), "v"(sc) : "memory")
__device__ __forceinline__ void pv_exp_a(f32x16* o, const v8i& vf0, const v8i& vf1, const v8i& vf2, const v8i& pa, int s1, const f32x16& r0, const f32x16& r1, float (&pe)[32]) {
#define ATT_RI(k) (((k) < 16) ? r0[(k) & 15] : r1[(k) & 15])
    ATT_MX7(o[0], pa, vf0, s1, "s_nop 4\n\t", pe, ATT_RI, 0);
    ATT_MX7(o[1], pa, vf1, s1, "", pe, ATT_RI, 7);
    ATT_MX7(o[2], pa, vf2, s1, "", pe, ATT_RI, 14);
#undef ATT_RI
}
__device__ __forceinline__ void pv_exp_b(f32x16* o, f32x16& lacc, const v8i& ones, const v8i& vf3, const v8i& pa, int s1, const f32x16& r0, const f32x16& r1, float (&pe)[32]) {
#define ATT_RI(k) (((k) < 16) ? r0[(k) & 15] : r1[(k) & 15])
    ATT_MX7(o[3], pa, vf3, s1, "", pe, ATT_RI, 21);
    asm volatile("v_mfma_scale_f32_32x32x64_f8f6f4 %0, %9, %10, %0, %11, %11 op_sel_hi:[0,0,0]\n\tv_exp_f32 %1, %5\n\tv_exp_f32 %2, %6\n\tv_exp_f32 %3, %7\n\tv_exp_f32 %4, %8"
                 : "+v"(lacc), "=&v"(pe[28]), "=&v"(pe[29]), "=&v"(pe[30]), "=&v"(pe[31]) : "v"(r1[12]), "v"(r1[13]), "v"(r1[14]), "v"(r1[15]), "v"(pa), "v"(ones), "v"(s1) : "memory");
#undef ATT_RI
}
__device__ __forceinline__ void pack_p(const float (&pe)[32], v8i& pa) {
#pragma unroll
    for (int w = 0; w < 8; ++w) pa[w] = (int)pk_fp8x4(pe[4 * w], pe[4 * w + 1], pe[4 * w + 2], pe[4 * w + 3]);
}
__device__ __forceinline__ void pv_d0(f32x16* o, f32x16& lacc, const v8i& ones, const LAS char* Vs, const v8i& pa, int r32, int hi, int s1) {
#pragma unroll
    for (int d0 = 0; d0 < 4; ++d0) { const int row = 32 * d0 + r32;
        const v8i vf = ATT_LD8(Vs + row * 64 + (((2 * hi) ^ vswz(row)) << 4), Vs + row * 64 + (((2 * hi + 1) ^ vswz(row)) << 4));
        mfma8_acc(o[d0], pa, vf, s1); }
    mfma8_acc(lacc, pa, ones, s1);
}
__device__ __forceinline__ void pv_last(f32x16* o, f32x16& lacc, const v8i& ones, const v8i& vf0, const v8i& vf1, const v8i& vf2, const v8i& vf3, const v8i& pa, int s1) {
    mfma8_acc(o[0], pa, vf0, s1); mfma8_acc(o[1], pa, vf1, s1); mfma8_acc(o[2], pa, vf2, s1); mfma8_acc(o[3], pa, vf3, s1); mfma8_acc(lacc, pa, ones, s1);
}
}

__device__ __forceinline__ void vt_phase(const Args& A, int bid, int G) {
    const int tid = threadIdx.x; unsigned char* ws = A.ws;
    const bf16_t* V = (const bf16_t*)(ws + A_V); unsigned char* VT = ws + A_VT;
    const int dv = tid & 127, kq = tid >> 7, half = kq >> 1, hi = kq & 1;
    for (int it = bid; it < 64 * 128; it += G) {
        const int bh = it >> 7, tile = it & 127, b = bh >> 3, h = bh & 7;
        const bf16_t* vp = V + ((size_t)b * SEQ + tile * 64 + 32 * half) * DM + h * 128 + dv;
        float f[16];
#pragma unroll
        for (int i = 0; i < 16; ++i) f[i] = bf2f(vp[(size_t)att::crow(i, hi) * DM]);
        *(u32x4*)(VT + (((size_t)bh * 128 + tile) * 128 + dv) * 64 + hi * 32 + half * 16) =
            (u32x4){pk_fp8x4(f[0], f[1], f[2], f[3]), pk_fp8x4(f[4], f[5], f[6], f[7]), pk_fp8x4(f[8], f[9], f[10], f[11]), pk_fp8x4(f[12], f[13], f[14], f[15])};
    }
}

__device__ __forceinline__ void attn_phase(const Args& A, LAS unsigned char* ldsu, int bid, int G, int al) {
    using namespace att;
    LAS char* lds = (LAS char*)ldsu;
    unsigned char* ws = A.ws;
    const unsigned char* Qg = ws + A_Q; const unsigned char* Kg = ws + A_K; const unsigned char* VTg = ws + A_VT;
    bf16_t* Og = (bf16_t*)(ws + WS_HM);
    const float* scal = (const float*)(ws + TB_SCAL);
    const float lamv = scal[SC_LAM0 + al], omli = scal[SC_OML0 + al], Mc = scal[SC_MC0 + al] - 7.5f;
    const float* subg = A.in[I_ATSUB] + al * 128;
    int tid_ = threadIdx.x; asm volatile("" : "+v"(tid_));
    const int tid = tid_, wid = __builtin_amdgcn_readfirstlane(tid >> 6), lane = tid & 63, r32 = lane & 31, hi = lane >> 5, jj = wid >> 2, wq = wid & 3;
    constexpr int NT = SEQ / KVBLK;
    int s1 = 0x7f7f7f7f, s8 = 0x7c7c7c7c; asm volatile("" : "+v"(s1), "+v"(s8));
    v8i ones; { int o1 = 0x38383838; asm volatile("" : "+v"(o1)); ones = (v8i){o1, o1, o1, o1, o1, o1, o1, o1}; }
    f32x16 cinit;
#pragma unroll
    for (int r = 0; r < 16; ++r) cinit[r] = -Mc;
    unsigned koff, voff;
    { const int bb = wid * 1024 + lane * 16;
      { const int row = bb >> 7, c = ((bb & 127) >> 4) ^ kswz(row); koff = (unsigned)(row * 1024 + c * 16); }
      { const int row = bb >> 6, c = ((bb & 63) >> 4) ^ vswz(row); voff = (unsigned)(row * 64 + c * 16); } }
    const unsigned ldsw = (unsigned)wid * 1024u;
    const __amdgpu_buffer_rsrc_t rK = __builtin_amdgcn_make_buffer_rsrc((void*)Kg, (short)0, 0x7fffffff, 0x00020000);
    const __amdgpu_buffer_rsrc_t rV = __builtin_amdgcn_make_buffer_rsrc((void*)VTg, (short)0, 0x7fffffff, 0x00020000);
#define ATT_DMA(slot, kt, vt) do { \
        __builtin_amdgcn_raw_ptr_buffer_load_lds(rK, (LAS void*)(lds + k_slot(slot) + ldsw), 16, (int)koff, (int)(kt), 0, 0); \
        __builtin_amdgcn_raw_ptr_buffer_load_lds(rV, (LAS void*)(lds + v_slot(slot) + ldsw), 16, (int)voff, (int)(vt), 0, 0); } while (0)
#define ATT_TOP() do { asm volatile("s_waitcnt vmcnt(2)" ::: "memory"); __builtin_amdgcn_s_barrier(); asm volatile("" ::: "memory"); } while (0)
    const int xq = bid & 7, cq = bid >> 3;
    int cbh = xq * 8;
    const bool lag = (jj != 0);
#define ATT_KB(bh_) ((unsigned)(((bh_) >> 3) * SEQ) * (unsigned)DM + (unsigned)((bh_) & 7) * 128u)
#define ATT_VB(bh_) ((unsigned)(bh_) * (128u * 8192u))
    ATT_DMA(0, ATT_KB(cbh), ATT_VB(cbh)); ATT_DMA(1, ATT_KB(cbh) + 64u * DM, ATT_VB(cbh) + 8192u);
    int ofKa, ofKb, ofV, ofKax, ofKbx, ofVx;
    { const int c0 = jj * 4 + 2 * hi, lb = (int)(unsigned)(size_t)lds;
      ofKa = r32 * 128 + ((c0 ^ kswz(r32)) << 4); ofKb = (32 + r32) * 128 + ((c0 ^ kswz(32 + r32)) << 4); ofV = 65536 + r32 * 64 + (((2 * hi) ^ vswz(r32)) << 4);
      ofKax = lb + (ofKa ^ 16); ofKbx = lb + (ofKb ^ 16); ofVx = lb + (ofV ^ 16); ofKa += lb; ofKb += lb; ofV += lb; }
#define ATT_QLOAD(dst, bh_, qb_) do { const unsigned char* Qw_ = Qg + ((size_t)((bh_) >> 3) * SEQ + (qb_) * 128) * DM + ((bh_) & 7) * 128 + (size_t)(wq * 32 + r32) * DM + jj * 64 + hi * 32; \
        const u32x4 qa_ = *(const u32x4*)Qw_, qb2_ = *(const u32x4*)(Qw_ + 16); dst = __builtin_bit_cast(v8i, __builtin_shufflevector(qa_, qb2_, 0, 1, 2, 3, 4, 5, 6, 7)); } while (0)
    v8i qnext; ATT_QLOAD(qnext, cbh, cq);
    for (int ui = 0; ui < 16; ++ui) {
        const int qb = (ui & 1) * 32 + cq;
        const int nbh = (ui + 1 < 16) ? xq * 8 + ((ui + 1) >> 1) : cbh;
        const unsigned Kh = ATT_KB(cbh), Vh = ATT_VB(cbh), nK = ATT_KB(nbh), nV = ATT_VB(nbh);
        const size_t obase = ((size_t)(cbh >> 3) * SEQ + qb * 128) * DM + (cbh & 7) * 128;
        f32x16 lacc = {}; f32x16 o[4] = {}; const v8i qr = qnext;
        f32x16 pA0, pA1; v8i pa, kf0, kf1, vf0, vf1, vf2, vf3;
        unsigned kptr = Kh + 2u * 64u * DM, vptr = Vh + 2u * 8192u;
#define ATT_ISSUE(SLD, last) do { asm volatile("" : "+s"(kptr), "+s"(vptr)); ATT_DMA(SLD, kptr, vptr); if (last) { kptr = nK; vptr = nV; } else { kptr += 64u * DM; vptr += 8192u; } } while (0)
#define ATT_RD8(b_, bx_, imm_) ATT_LD8((const LAS char*)(unsigned)((b_) + (imm_)), (const LAS char*)(unsigned)((bx_) + (imm_)))
#define ATT_FIX() asm volatile("" : "+v"(ofKa), "+v"(ofKax), "+v"(ofKb), "+v"(ofKbx), "+v"(ofV), "+v"(ofVx))
#define ATT_STEPC(LAST, SL, SLP, SLD) do { \
            ATT_FIX(); \
            kf0 = ATT_RD8(ofKa, ofKax, (SL) * SLOTB); kf1 = ATT_RD8(ofKb, ofKbx, (SL) * SLOTB); vf0 = ATT_RD8(ofV, ofVx, (SLP) * SLOTB); vf1 = ATT_RD8(ofV, ofVx, (SLP) * SLOTB + 2048); \
            ATT_ISSUE(SLD, LAST); \
            ATT_TOP(); \
            qkt_pack(pA0, pA1, kf0, kf1, qr, cinit, s1, s8, pe, pa); \
            vf2 = ATT_RD8(ofV, ofVx, (SLP) * SLOTB + 4096); vf3 = ATT_RD8(ofV, ofVx, (SLP) * SLOTB + 6144); \
            pv_exp_a(o, vf0, vf1, vf2, pa, s1, pA0, pA1, pe); \
            ATT_TOP(); \
            pv_exp_b(o, lacc, ones, vf3, pa, s1, pA0, pA1, pe); } while (0)
        float pe[32];
        if (lag) ATT_TOP();
        ATT_TOP();
        ATT_FIX(); kf0 = ATT_RD8(ofKa, ofKax, 0); kf1 = ATT_RD8(ofKb, ofKbx, 0); ATT_ISSUE(2, false);
        ATT_TOP();
        { mfma8_c(pA0, kf0, qr, cinit, s1, s8); mfma8_c(pA1, kf1, qr, cinit, s1, s8);
          asm volatile("s_nop 15\n\ts_nop 15" ::: "memory");
#pragma unroll
          for (int r = 0; r < 16; ++r) pe[r] = fexp2(pA0[r]);
#pragma unroll
          for (int r = 0; r < 16; ++r) pe[16 + r] = fexp2(pA1[r]); }
        ATT_TOP();
        ATT_STEPC(false, 1, 0, 3); ATT_STEPC(false, 2, 1, 4); ATT_STEPC(false, 3, 2, 5); ATT_STEPC(false, 4, 3, 6); ATT_STEPC(false, 5, 4, 7); ATT_STEPC(false, 6, 5, 0); ATT_STEPC(false, 7, 6, 1);
        for (int kb = 8; kb < NT; kb += 8) {
            ATT_STEPC(false, 0, 7, 2); ATT_STEPC(false, 1, 0, 3); ATT_STEPC(false, 2, 1, 4); ATT_STEPC(false, 3, 2, 5);
            ATT_STEPC(false, 4, 3, 6); ATT_STEPC(kb == NT - 8, 5, 4, 7); ATT_STEPC(false, 6, 5, 0); ATT_STEPC(false, 7, 6, 1);
        }
        ATT_FIX();
        vf0 = ATT_RD8(ofV, ofVx, 7 * SLOTB); vf1 = ATT_RD8(ofV, ofVx, 7 * SLOTB + 2048);
        ATT_TOP();
        { vf2 = ATT_RD8(ofV, ofVx, 7 * SLOTB + 4096); vf3 = ATT_RD8(ofV, ofVx, 7 * SLOTB + 6144);
          pack_p(pe, pa); SBAR();
          pv_last(o, lacc, ones, vf0, vf1, vf2, vf3, pa, s1);
          asm volatile("s_nop 15\n\ts_nop 15" ::: "memory"); }
        if (!lag) ATT_TOP();
        if (ui + 1 < 16) ATT_QLOAD(qnext, nbh, ((ui + 1) & 1) * 32 + cq);
#undef ATT_ISSUE
#undef ATT_STEPC
#undef ATT_RD8
#undef ATT_FIX
        int r32e = r32, hie = hi; asm volatile("" : "+v"(r32e), "+v"(hie));
        float rli[16];
#pragma unroll
        for (int r = 0; r < 16; ++r) rli[r] = frcp(lacc[r]);
        asm volatile("s_waitcnt lgkmcnt(0)" ::: "memory"); __builtin_amdgcn_s_barrier(); asm volatile("" ::: "memory");
        LAS float* Cb = (LAS float*)(lds + ((wq < 2) ? 3 * SLOTB : 65536 + 3 * SLOTB - 64 * 512));
        if (jj == 1) {
#pragma unroll
            for (int r = 0; r < 16; ++r) { const float sc = rli[r] * lamv;
#pragma unroll
                for (int d0 = 0; d0 < 4; ++d0) Cb[(wq * 32 + crow(r, hie)) * 128 + d0 * 32 + r32e] = o[d0][r] * sc; }
        }
        asm volatile("s_waitcnt lgkmcnt(0)" ::: "memory"); __builtin_amdgcn_s_barrier(); asm volatile("" ::: "memory");
        if (jj == 0) {
            float g[4];
#pragma unroll
            for (int d0 = 0; d0 < 4; ++d0) g[d0] = subg[d0 * 32 + r32e] * omli;
            bf16_t* Ob = Og + obase;
#pragma unroll
            for (int r = 0; r < 16; ++r) {
                float ss = 0.f;
#pragma unroll
                for (int d0 = 0; d0 < 4; ++d0) { const float v = o[d0][r] * rli[r] - Cb[(wq * 32 + crow(r, hie)) * 128 + d0 * 32 + r32e]; o[d0][r] = v; ss += v * v; }
                ss += __shfl_xor(ss, 1); ss += __shfl_xor(ss, 2); ss += __shfl_xor(ss, 4); ss += __shfl_xor(ss, 8); ss += __shfl_xor(ss, 16);
                const float rs = 1.0f / sqrtf(ss * (1.0f / 128.0f) + EPS);
                if (al == 0) { bf16_t* op = Ob + (size_t)(wq * 32 + crow(r, hie)) * DM + r32e;
#pragma unroll
                    for (int d0 = 0; d0 < 4; ++d0) op[d0 * 32] = (bf16_t)f2bf(o[d0][r] * rs * g[d0]); }
                else { unsigned char* op = (unsigned char*)Og + obase + (size_t)(wq * 32 + crow(r, hie)) * DM + r32e;
#pragma unroll
                    for (int d0 = 0; d0 < 4; ++d0) { const float v = o[d0][r] * rs * g[d0]; op[d0 * 32] = (unsigned char)(__builtin_amdgcn_cvt_pk_fp8_f32(v, v, 0, false) & 0xff); } }
            }
        }
        asm volatile("s_waitcnt lgkmcnt(0)" ::: "memory"); __builtin_amdgcn_s_barrier(); asm volatile("" ::: "memory");
        cbh = nbh;
    }
    asm volatile("s_waitcnt vmcnt(0) lgkmcnt(0)" ::: "memory"); __builtin_amdgcn_s_barrier(); asm volatile("" ::: "memory");
#undef ATT_DMA
#undef ATT_TOP
#undef ATT_QLOAD
#undef ATT_KB
#undef ATT_VB
#undef ATT_LD8
}

namespace gla {
constexpr int BC = 0, QI = 32768, QA = 49152, KA = 65536, KST = 81920, VT = 98304, ST = 106496, AT = 122880, EM = 131072, EL = EM + 512, DD = EM + 1024, BMID = EM + 1536, SEG = EM + 2048;
static_assert(SEG + 2048 <= RING_BYTES, "gla lds");
__device__ __forceinline__ int sw256(int row, int cb) { return row * 256 + (cb ^ ((row & 15) << 4)); }
__device__ __forceinline__ int sw128(int row, int cb) { return row * 128 + (cb ^ ((((row & 7) ^ (row >> 4)) & 7) << 4)); }
__device__ __forceinline__ int crow(int r, int hi) { return (r & 3) + 8 * (r >> 2) + 4 * hi; }
__device__ __forceinline__ float h2f(unsigned short b) { return (float)__builtin_bit_cast(_Float16, b); }
__device__ __forceinline__ void gla_item(const bf16_t* __restrict__ Qp, const unsigned short* __restrict__ LFp, const bf16_t* __restrict__ Vp, bf16_t* __restrict__ Op, int dir, LAS unsigned char* lds, float* dbg) {
    int tid_ = threadIdx.x; asm volatile("" : "+v"(tid_));
    const int tid = tid_, wid = tid >> 6, lane = tid & 63, r = lane & 31, hh = lane >> 5;
    const int t1 = tid >> 3, kg = tid & 7, k0 = 16 * kg, v0 = (tid & 7) * 8;
    for (int i = tid; i < 16384 / 16; i += NTHR) *(LAS u32x4*)(lds + ST + i * 16) = (u32x4){0u, 0u, 0u, 0u};
    f32x16 st = {};
    u32x4 rq[2], rl[2], rv;
#define GLA_TOK(ci, i) (dir ? (SEQ - 1 - ((ci) * 64 + (i))) : ((ci) * 64 + (i)))
#define GLA_LOAD(ci) do { const size_t to = (size_t)GLA_TOK(ci, t1) * DM; \
        rq[0] = *(const u32x4*)(Qp + to + k0); rq[1] = *(const u32x4*)(Qp + to + k0 + 8); \
        rl[0] = *(const u32x4*)(LFp + to + k0); rl[1] = *(const u32x4*)(LFp + to + k0 + 8); rv = *(const u32x4*)(Vp + to + v0); } while (0)
    GLA_LOAD(0);
    __syncthreads();
    for (int ci = 0; ci < SEQ / 64; ++ci) {
        float qf[16], lf[16]; u32x4 vreg = rv;
#pragma unroll
        for (int j = 0; j < 2; ++j)
#pragma unroll
            for (int e = 0; e < 4; ++e) { qf[j * 8 + 2 * e] = bflo(rq[j][e]); qf[j * 8 + 2 * e + 1] = bfhi(rq[j][e]);
                lf[j * 8 + 2 * e] = h2f((unsigned short)(rl[j][e] & 0xffffu)); lf[j * 8 + 2 * e + 1] = h2f((unsigned short)(rl[j][e] >> 16)); }
        if (ci + 1 < SEQ / 64) GLA_LOAD(ci + 1);
#pragma unroll
        for (int j = 0; j < 4; ++j) *(LAS f32x4*)(lds + BC + (t1 * 128 + k0 + 4 * j) * 4) = (f32x4){lf[4 * j], lf[4 * j + 1], lf[4 * j + 2], lf[4 * j + 3]};
        __syncthreads();
        { const int kc = tid & 127, sg = tid >> 7; LAS float* bc = (LAS float*)(lds + BC) + kc; float cs[16];
#pragma unroll
            for (int i = 0; i < 16; ++i) cs[i] = bc[(sg * 16 + i) * 128];
#pragma unroll
            for (int i = 1; i < 16; ++i) cs[i] += cs[i - 1];
            ((LAS float*)(lds + SEG))[sg * 128 + kc] = cs[15];
            __syncthreads();
            const LAS float* sgp = (const LAS float*)(lds + SEG) + kc; const float s0 = sgp[0], s1 = sgp[128], s2 = sgp[256], s3 = sgp[384];
            const float off = sg == 0 ? 0.f : sg == 1 ? s0 : sg == 2 ? (s0 + s1) : ((s0 + s1) + s2);
#pragma unroll
            for (int i = 0; i < 16; ++i) bc[(sg * 16 + i) * 128] = cs[i] + off;
            if (sg == 0) { const float bm = s0 + s1, bl = ((s0 + s1) + s2) + s3;
                ((LAS float*)(lds + BMID))[kc] = bm; ((LAS float*)(lds + EM))[kc] = fexp(bm); ((LAS float*)(lds + EL))[kc] = fexp(bl - bm); ((LAS float*)(lds + DD))[kc] = fexp(bl); }
            __syncthreads();
        }
#ifdef DIAG
        if (dbg && ci == 0) { for (int i = tid; i < 8192; i += NTHR) dbg[i] = ((const LAS float*)(lds + BC))[i]; }
#endif
        {
            unsigned wqi[8], wqa[8], wka[8]; float ksv[16];
#pragma unroll
            for (int j = 0; j < 4; ++j) {
                const f32x4 bt = *(const LAS f32x4*)(lds + BC + (t1 * 128 + k0 + 4 * j) * 4), bm = *(const LAS f32x4*)(lds + BMID + (k0 + 4 * j) * 4);
                const f32x4 em = *(const LAS f32x4*)(lds + EM + (k0 + 4 * j) * 4), el = *(const LAS f32x4*)(lds + EL + (k0 + 4 * j) * 4);
                float qi[4], qa[4], ka[4];
#pragma unroll
                for (int e = 0; e < 4; ++e) { const int i = 4 * j + e; const float e1 = fexp(bt[e] - bm[e]), r1 = frcp(e1);
                    qa[e] = qf[i] * e1; qi[e] = qa[e] * em[e]; const float kk = 1.0f - fexp(lf[i]); ka[e] = kk * r1; ksv[i] = ka[e] * el[e]; }
                wqi[2 * j] = cvt_pk_bf16(qi[0], qi[1]); wqi[2 * j + 1] = cvt_pk_bf16(qi[2], qi[3]);
                wqa[2 * j] = cvt_pk_bf16(qa[0], qa[1]); wqa[2 * j + 1] = cvt_pk_bf16(qa[2], qa[3]);
                wka[2 * j] = cvt_pk_bf16(ka[0], ka[1]); wka[2 * j + 1] = cvt_pk_bf16(ka[2], ka[3]);
            }
#pragma unroll
            for (int j = 0; j < 2; ++j) { const int off = sw256(t1, (k0 + 8 * j) * 2);
                *(LAS u32x4*)(lds + QI + off) = (u32x4){wqi[4 * j], wqi[4 * j + 1], wqi[4 * j + 2], wqi[4 * j + 3]};
                *(LAS u32x4*)(lds + QA + off) = (u32x4){wqa[4 * j], wqa[4 * j + 1], wqa[4 * j + 2], wqa[4 * j + 3]};
                *(LAS u32x4*)(lds + KA + off) = (u32x4){wka[4 * j], wka[4 * j + 1], wka[4 * j + 2], wka[4 * j + 3]}; }
#pragma unroll
            for (int i = 0; i < 16; ++i) *(LAS unsigned short*)(lds + KST + sw128(k0 + i, t1 * 2)) = (unsigned short)f2bf(ksv[i]);
#pragma unroll
            for (int e = 0; e < 4; ++e) { *(LAS unsigned short*)(lds + VT + sw128(v0 + 2 * e, t1 * 2)) = (unsigned short)(vreg[e] & 0xffffu);
                *(LAS unsigned short*)(lds + VT + sw128(v0 + 2 * e + 1, t1 * 2)) = (unsigned short)(vreg[e] >> 16); }
        }
        __syncthreads();
        f32x16 oacc = {};
        const int w4 = wid & 3, t_i = w4 >> 1, v_i = w4 & 1;
        if (wid < 4) {
            const int s_i = wid >> 1, tq = wid & 1; f32x16 a = {};
#pragma unroll
            for (int ks = 0; ks < 8; ++ks) { const bf16x8 fa = *(const LAS bf16x8*)(lds + KA + sw256(32 * s_i + r, (16 * ks + 8 * hh) * 2)), fb = *(const LAS bf16x8*)(lds + QA + sw256(32 * tq + r, (16 * ks + 8 * hh) * 2));
                a = __builtin_amdgcn_mfma_f32_32x32x16_bf16(fa, fb, a, 0, 0, 0); }
            const int tg = 32 * tq + r;
#pragma unroll
            for (int g = 0; g < 4; ++g) { float m[4];
#pragma unroll
                for (int e = 0; e < 4; ++e) { const int sgl = 32 * s_i + 8 * g + 4 * hh + e; m[e] = (sgl <= tg) ? a[4 * g + e] : 0.f; }
                *(LAS u32x2*)(lds + AT + sw128(tg, (32 * s_i + 8 * g + 4 * hh) * 2)) = (u32x2){cvt_pk_bf16(m[0], m[1]), cvt_pk_bf16(m[2], m[3])}; }
        } else {
#pragma unroll
            for (int ks = 0; ks < 8; ++ks) { const bf16x8 fa = *(const LAS bf16x8*)(lds + QI + sw256(32 * t_i + r, (16 * ks + 8 * hh) * 2)), fb = *(const LAS bf16x8*)(lds + ST + sw256(32 * v_i + r, (16 * ks + 8 * hh) * 2));
                oacc = __builtin_amdgcn_mfma_f32_32x32x16_bf16(fa, fb, oacc, 0, 0, 0); }
        }
        __syncthreads();
#ifdef DIAG
        if (dbg && ci == 0) { for (int i = tid; i < 2048; i += NTHR) { ((unsigned*)dbg)[8192 + i] = ((const LAS unsigned*)(lds + AT))[i]; ((unsigned*)dbg)[8192 + 2048 + i] = ((const LAS unsigned*)(lds + VT))[i]; } }
#endif
        if (wid >= 4) {
#pragma unroll
            for (int ks = 0; ks < 4; ++ks) { const bf16x8 fa = *(const LAS bf16x8*)(lds + AT + sw128(32 * t_i + r, (16 * ks + 8 * hh) * 2)), fb = *(const LAS bf16x8*)(lds + VT + sw128(32 * v_i + r, (16 * ks + 8 * hh) * 2));
                oacc = __builtin_amdgcn_mfma_f32_32x32x16_bf16(fa, fb, oacc, 0, 0, 0); }
#pragma unroll
            for (int i = 0; i < 16; ++i) { const int t = 32 * t_i + crow(i, hh); Op[(size_t)GLA_TOK(ci, t) * DM + 32 * v_i + r] = (bf16_t)f2bf(oacc[i]); }
        }
        {
            const int kq = wid >> 1, vq = wid & 1;
#pragma unroll
            for (int i = 0; i < 16; ++i) st[i] *= ((const LAS float*)(lds + DD))[32 * kq + crow(i, hh)];
#pragma unroll
            for (int ks = 0; ks < 4; ++ks) { const bf16x8 fa = *(const LAS bf16x8*)(lds + KST + sw128(32 * kq + r, (16 * ks + 8 * hh) * 2)), fb = *(const LAS bf16x8*)(lds + VT + sw128(32 * vq + r, (16 * ks + 8 * hh) * 2));
                st = __builtin_amdgcn_mfma_f32_32x32x16_bf16(fa, fb, st, 0, 0, 0); }
#pragma unroll
            for (int g = 0; g < 4; ++g) *(LAS u32x2*)(lds + ST + sw256(32 * vq + r, (32 * kq + 8 * g + 4 * hh) * 2)) = (u32x2){cvt_pk_bf16(st[4 * g], st[4 * g + 1]), cvt_pk_bf16(st[4 * g + 2], st[4 * g + 3])};
        }
        __syncthreads();
#ifdef DIAG
        if (dbg && ci == 0) { for (int i = tid; i < 4096; i += NTHR) { ((unsigned*)dbg)[12288 + i] = ((const LAS unsigned*)(lds + ST))[i]; ((unsigned*)dbg)[16384 + i] = ((const LAS unsigned*)(lds + KST))[i]; } }
#endif
    }
#undef GLA_TOK
#undef GLA_LOAD
}
}
__device__ __forceinline__ void gla_phase(const Args& A, LAS unsigned char* lds, int bid, int G) {
    unsigned char* ws = A.ws;
    for (int it = bid; it < 256; it += G) {
        const int b = it >> 5, h = (it >> 2) & 7, dir = (it >> 1) & 1, vh = it & 1;
        const size_t base = (size_t)b * SEQ * DM + h * 128;
        gla::gla_item((const bf16_t*)(ws + H_Q) + base, (const unsigned short*)(ws + (dir ? H_LFB : H_LFF)) + base, (const bf16_t*)(ws + H_V) + base + vh * 64,
                      (bf16_t*)(ws + (dir ? H_OB : H_OF)) + base + vh * 64, dir, lds, it == 0 ? (float*)(ws + TB_LSUM) : nullptr);
    }
}
__device__ __forceinline__ void hg_normo_phase(const Args& A, int bid, int G) {
    int tid_ = threadIdx.x; asm volatile("" : "+v"(tid_));
    const int tid = tid_, lane = tid & 63, wave = tid >> 6; unsigned char* ws = A.ws;
    const bf16_t* OF = (const bf16_t*)(ws + H_OF); const bf16_t* OB = (const bf16_t*)(ws + H_OB); const bf16_t* GG = (const bf16_t*)(ws + H_G); bf16_t* HM = (bf16_t*)(ws + WS_HM);
    const int c0 = (lane >> 3) * 128 + (lane & 7) * 16;
    float ng[16];
#pragma unroll
    for (int i = 0; i < 16; ++i) ng[i] = A.in[I_HGNG][(lane & 7) * 16 + i];
    for (int row = (bid * NWAVES + wave); row < MTOK; row += G * NWAVES) {
        const size_t o = (size_t)row * DM + c0;
        const u32x4 a0 = *(const u32x4*)(OF + o), a1 = *(const u32x4*)(OF + o + 8), b0 = *(const u32x4*)(OB + o), b1 = *(const u32x4*)(OB + o + 8), g0 = *(const u32x4*)(GG + o), g1 = *(const u32x4*)(GG + o + 8);
        float v[16], gt[16]; float ss = 0.f;
#pragma unroll
        for (int e = 0; e < 4; ++e) { v[2 * e] = bflo(a0[e]) + bflo(b0[e]); v[2 * e + 1] = bfhi(a0[e]) + bfhi(b0[e]); v[8 + 2 * e] = bflo(a1[e]) + bflo(b1[e]); v[8 + 2 * e + 1] = bfhi(a1[e]) + bfhi(b1[e]);
            gt[2 * e] = bflo(g0[e]); gt[2 * e + 1] = bfhi(g0[e]); gt[8 + 2 * e] = bflo(g1[e]); gt[8 + 2 * e + 1] = bfhi(g1[e]); }
#pragma unroll
        for (int i = 0; i < 16; ++i) ss += v[i] * v[i];
        ss += __shfl_xor(ss, 1); ss += __shfl_xor(ss, 2); ss += __shfl_xor(ss, 4);
        const float rstd = 1.0f / sqrtf(ss * (1.0f / 128.0f) + EPS);
        u32x4 w0, w1;
#pragma unroll
        for (int e = 0; e < 4; ++e) { w0[e] = cvt_pk_bf16(v[2 * e] * rstd * ng[2 * e] * gt[2 * e], v[2 * e + 1] * rstd * ng[2 * e + 1] * gt[2 * e + 1]);
            w1[e] = cvt_pk_bf16(v[8 + 2 * e] * rstd * ng[8 + 2 * e] * gt[8 + 2 * e], v[8 + 2 * e + 1] * rstd * ng[8 + 2 * e + 1] * gt[8 + 2 * e + 1]); }
        *(u32x4*)(HM + o) = w0; *(u32x4*)(HM + o + 8) = w1;
    }
}

#ifdef DIAG
constexpr int DG_BASE = 8192;
__device__ __forceinline__ void dg_put(const Args& A, int k, float e) { if (!(e >= 0.f) || e > 1e9f) e = 1e9f; atomicMax((unsigned*)(A.ws + WS_CTL) + DG_BASE + 64 * k, __float_as_uint(e)); }
__device__ __forceinline__ float dg_rel(float got, float ref) { return fabsf(got - ref) / (fabsf(ref) + 0.1f); }
__device__ __forceinline__ unsigned dg_hash(unsigned a, unsigned b) { unsigned h = a * 2654435761u + b * 40503u + 0x9e3779b9u; h ^= h >> 15; h *= 2246822519u; h ^= h >> 13; h *= 3266489917u; h ^= h >> 16; return h; }
__device__ __forceinline__ float dg_bfr(float x) { return bflo(f2bf(x)); }
__device__ __forceinline__ void dg_mods(const Args& A, int k) {
    const int lane = threadIdx.x & 63, gwv = blockIdx.x * 8 + (threadIdx.x >> 6);
    const unsigned h = dg_hash(gwv, k); const int l = h & 3, b = (h >> 2) & 7, e = (h >> 5) % 6144;
    float a = 0.f; for (int d = lane; d < DM; d += 64) a += fsilu(A.in[I_C][b * DM + d]) * A.in[I_ADAW][((size_t)l * DM + d) * 6144 + e];
    a = wave_sum(a) + A.in[I_ADAB][l * 6144 + e];
    const float got = ((const float*)(A.ws + TB_MODS))[((size_t)l * NBATCH + b) * 6144 + e];
    if (lane == 0) dg_put(A, k, dg_rel(got, a));
}
__device__ __forceinline__ void dg_norm(const Args& A, int k, const float* x, const float* gain, int L, int which) {
    const int lane = threadIdx.x & 63, gwv = blockIdx.x * 8 + (threadIdx.x >> 6);
    const int row = dg_hash(gwv, k) & (MTOK - 1), b = row >> 13;
    const float* modl = (const float*)(A.ws + TB_MODS) + ((size_t)L * NBATCH + b) * 6144;
    float ss = 0.f; for (int c = lane; c < DM; c += 64) { const float v = x[(size_t)row * DM + c]; ss += v * v; }
    ss = wave_sum(ss); const float rstd = 1.0f / sqrtf(ss / DM + EPS); float e = 0.f;
    for (int c = lane; c < DM; c += 64) { const float ref = x[(size_t)row * DM + c] * rstd * gain[c] * (1.0f + modl[(which * 3 + 1) * 1024 + c]) + modl[(which * 3) * 1024 + c];
        e = fmaxf(e, dg_rel(bf2f(((const bf16_t*)(A.ws + WS_HM))[(size_t)row * DM + c]), ref)); }
    dg_put(A, k, e);
}
__device__ __forceinline__ void dg_qkv(const Args& A, int k, int al) {
    const int lane = threadIdx.x & 63, gwv = blockIdx.x * 8 + (threadIdx.x >> 6);
    const unsigned h = dg_hash(gwv, k); const int row = h & (MTOK - 1), t = (h >> 16) % 48, col = t * 64 + lane;
    const bf16_t* hm = (const bf16_t*)(A.ws + WS_HM) + (size_t)row * DM; const float* w = A.in[I_ATWIN] + (size_t)al * 1024 * 3072 + col;
    float a = 0.f; for (int kk = 0; kk < DM; ++kk) a += bf2f(hm[kk]) * dg_bfr(w[(size_t)kk * 3072]);
    float ref, got;
    if (t < 32) {
        const int part = t >> 4, sh = t & 15; const float ss = wave_sum(a * a); const float rstd = 1.0f / sqrtf(ss / 64.0f + EPS);
        const float y = a * rstd * (part ? A.in[I_ATKN] : A.in[I_ATQN])[al * 64 + lane]; const float yp = __shfl_xor(y, 32);
        const int pos = row & (SEQ - 1); const float cs = ((const float*)(A.ws + TB_COS))[pos * 32 + (lane & 31)], sn = ((const float*)(A.ws + TB_SIN))[pos * 32 + (lane & 31)];
        ref = (lane < 32) ? (y * cs - yp * sn) : (y * cs + yp * sn); if (part == 0) ref *= 0.125f * LOG2E;
        got = bf2f(((const bf16_t*)(A.ws + (part ? A_K : A_Q)))[(size_t)row * DM + sh * 64 + lane]);
    } else { ref = a; got = bf2f(((const bf16_t*)(A.ws + A_V))[(size_t)row * DM + (t - 32) * 64 + lane]); }
    dg_put(A, k, dg_rel(got, ref));
}
__device__ __forceinline__ void dg_attn(const Args& A, int k, int al, LAS unsigned char* lds) {
    const int tid = threadIdx.x; const unsigned h = dg_hash(blockIdx.x, k); const int row = h & (MTOK - 1), hd = (h >> 16) & 7, b = row >> 13;
    const bf16_t* Q = (const bf16_t*)(A.ws + A_Q); const bf16_t* K = (const bf16_t*)(A.ws + A_K); const bf16_t* V = (const bf16_t*)(A.ws + A_V);
    const float* scal = (const float*)(A.ws + TB_SCAL); const float lamv = scal[SC_LAM0 + al], omli = scal[SC_OML0 + al], Mc = scal[SC_MC0 + al];
    LAS float* p0 = (LAS float*)lds; LAS float* p1 = p0 + SEQ; LAS float* red = p1 + SEQ;
    float l0 = 0.f, l1 = 0.f;
    for (int key = tid; key < SEQ; key += NTHR) { const bf16_t* kr = K + ((size_t)b * SEQ + key) * DM + hd * 128; const bf16_t* qr = Q + (size_t)row * DM + hd * 128;
        float s0 = 0.f, s1 = 0.f; for (int d = 0; d < 64; ++d) { s0 += bf2f(qr[d]) * bf2f(kr[d]); s1 += bf2f(qr[64 + d]) * bf2f(kr[64 + d]); }
        const float e0 = fexp2(s0 - Mc), e1 = fexp2(s1 - Mc); p0[key] = e0; p1[key] = e1; l0 += e0; l1 += e1; }
    l0 = wave_sum(l0); l1 = wave_sum(l1); if ((tid & 63) == 0) { red[tid >> 6] = l0; red[8 + (tid >> 6)] = l1; }
    __syncthreads();
    l0 = 0.f; l1 = 0.f; for (int w = 0; w < 8; ++w) { l0 += red[w]; l1 += red[8 + w]; }
    __syncthreads();
    const int dv = tid & 127, part = tid >> 7; float o = 0.f;
    for (int key = part * 2048; key < part * 2048 + 2048; ++key) o += (p0[key] / l0 - lamv * p1[key] / l1) * bf2f(V[((size_t)b * SEQ + key) * DM + hd * 128 + dv]);
    red[16 + part * 128 + dv] = o; __syncthreads();
    if (tid < 128) { o = red[16 + tid] + red[16 + 128 + tid] + red[16 + 256 + tid] + red[16 + 384 + tid]; red[600 + tid] = o * o; }
    __syncthreads();
    if (tid < 128) { float ss = 0.f; for (int i = 0; i < 128; ++i) ss += red[600 + i]; const float ref = o / sqrtf(ss / 128.0f + EPS) * A.in[I_ATSUB][al * 128 + tid] * omli;
        dg_put(A, k, dg_rel(bf2f(((const bf16_t*)(A.ws + WS_HM))[(size_t)row * DM + hd * 128 + tid]), ref)); }
    __syncthreads();
}
__device__ __forceinline__ void dg_save(const Args& A, int k, const float* xold) {
    const int lane = threadIdx.x & 63, gwv = blockIdx.x * 8 + (threadIdx.x >> 6);
    const unsigned h = dg_hash(gwv, k); const int row = h & (MTOK - 1), col = (h >> 16) & 1023;
    float* sv = (float*)(A.ws + TB_LSUM) + 7 * 1024 * 1024 / 4;
    if (lane == 0) sv[k * 4096 + gwv] = xold[(size_t)row * DM + col];
}
__device__ __forceinline__ void dg_res(const Args& A, int k, const float* xnew, const float* gate, const bf16_t* Am, int K, const float* W) {
    const int lane = threadIdx.x & 63, gwv = blockIdx.x * 8 + (threadIdx.x >> 6);
    const unsigned h = dg_hash(gwv, k); const int row = h & (MTOK - 1), col = (h >> 16) & 1023, b = row >> 13;
    const float* sv = (const float*)(A.ws + TB_LSUM) + 7 * 1024 * 1024 / 4;
    float a = 0.f; for (int kk = lane; kk < K; kk += 64) a += bf2f(Am[(size_t)row * K + kk]) * dg_bfr(W[(size_t)kk * DM + col]);
    a = wave_sum(a);
    const float ref = sv[k * 4096 + gwv] + gate[(size_t)b * 6144 + col] * a;
    if (lane == 0) dg_put(A, k, dg_rel(xnew[(size_t)row * DM + col], ref));
}
__device__ __forceinline__ void dg_swiglu(const Args& A, int k, const bf16_t* Am, const float* W, int F, const bf16_t* H, int nrows, const int* rowmap) {
    const int lane = threadIdx.x & 63, gwv = blockIdx.x * 8 + (threadIdx.x >> 6);
    const unsigned h = dg_hash(gwv, k); const int row = (h & 0xfffff) % nrows, j = (h >> 20) % F;
    float g = 0.f, u = 0.f; for (int kk = lane; kk < DM; kk += 64) { const float x = bf2f(Am[(size_t)row * DM + kk]); g += x * dg_bfr(W[(size_t)kk * 2 * F + j]); u += x * dg_bfr(W[(size_t)kk * 2 * F + F + j]); }
    g = wave_sum(g); u = wave_sum(u);
    const float ref = g / (1.0f + expf(-g)) * u;
    if (lane == 0) dg_put(A, k, dg_rel(bf2f(H[(size_t)row * F + j]), ref));
}
__device__ __forceinline__ void dg_hgin(const Args& A, int k) {
    const int lane = threadIdx.x & 63, gwv = blockIdx.x * 8 + (threadIdx.x >> 6);
    const unsigned h = dg_hash(gwv, k); const int row = h & (MTOK - 1), col = (h >> 16) % 5120, grp = col >> 10, cc = col & 1023;
    float a = 0.f; for (int kk = lane; kk < DM; kk += 64) a += bf2f(((const bf16_t*)(A.ws + WS_HM))[(size_t)row * DM + kk]) * dg_bfr(A.in[I_HGWIN][(size_t)kk * 5120 + col]);
    a = wave_sum(a);
    float ref, got;
    if (grp == 0 || grp == 4) { ref = a / (1.0f + expf(-a)); got = bf2f(((const bf16_t*)(A.ws + (grp == 0 ? H_Q : H_G)))[(size_t)row * DM + cc]); }
    else if (grp == 3) { ref = a; got = bf2f(((const bf16_t*)(A.ws + H_V))[(size_t)row * DM + cc]); }
    else { const int d = grp - 1; const float* p = A.in[I_HGLB] + (size_t)d * DEPTH * 1024 + cc; float mx = p[0]; for (int l = 1; l < DEPTH; ++l) mx = fmaxf(mx, p[l * 1024]);
        float den = 0.f; for (int l = 0; l < DEPTH; ++l) den += expf(p[l * 1024] - mx); const float lbv = expf(p[1024] - mx) / den;
        ref = logf(lbv + (1.0f - lbv) / (1.0f + expf(-a))); got = gla::h2f(((const unsigned short*)(A.ws + (d ? H_LFB : H_LFF)))[(size_t)row * DM + cc]); }
    if (lane == 0) dg_put(A, k, dg_rel(got, ref));
}
__device__ __forceinline__ void dg_gla(const Args& A, int k) {
    const int lane = threadIdx.x & 63, gwv = blockIdx.x * 8 + (threadIdx.x >> 6);
    const unsigned h = dg_hash(gwv, k); const int sel0 = (gwv & 3) == 0; const int b = sel0 ? 0 : (h & 7), hd = sel0 ? 0 : ((h >> 3) & 7), dir = sel0 ? 0 : ((h >> 6) & 1), vc = sel0 ? ((h >> 7) & 63) : ((h >> 7) & 127);
    const bf16_t* Q = (const bf16_t*)(A.ws + H_Q); const unsigned short* LF = (const unsigned short*)(A.ws + (dir ? H_LFB : H_LFF)); const bf16_t* V = (const bf16_t*)(A.ws + H_V);
    const bf16_t* O = (const bf16_t*)(A.ws + (dir ? H_OB : H_OF));
    float s0 = 0.f, s1 = 0.f, e0 = 0.f, e1 = 0.f, e2 = 0.f, e3 = 0.f;
    for (int i = 0; i < SEQ; ++i) { const int tok = dir ? (SEQ - 1 - i) : i; const size_t o = ((size_t)b * SEQ + tok) * DM + hd * 128;
        const float f0 = expf(gla::h2f(LF[o + lane])), f1 = expf(gla::h2f(LF[o + 64 + lane])), v = bf2f(V[o + vc]);
        s0 = f0 * s0 + (1.0f - f0) * v; s1 = f1 * s1 + (1.0f - f1) * v;
        if (i < 128 || i % 61 == 0) { const float ov = wave_sum(bf2f(Q[o + lane]) * s0 + bf2f(Q[o + 64 + lane]) * s1); const float er = 0.25f * fabsf(bf2f(O[o + vc]) - ov) / (fabsf(ov) + 1.0f);
            if (i == 0) e0 = er; else if (i < 64) e1 = fmaxf(e1, er); else if (i < 128) e2 = fmaxf(e2, er); else e3 = fmaxf(e3, er); } }
    if (lane == 0) { dg_put(A, k, e0); dg_put(A, k + 4, e1); dg_put(A, k + 5, e2); dg_put(A, k + 6, e3); }
    const float* dbg = (const float*)(A.ws + TB_LSUM); const unsigned short* LF0 = (const unsigned short*)(A.ws + H_LFF); const bf16_t* Q0 = (const bf16_t*)(A.ws + H_Q);
    { const unsigned h2 = dg_hash(gwv, k + 100); const int t = h2 & 63, kk = (h2 >> 6) & 127; float c = 0.f; for (int tt = 0; tt <= t; ++tt) c += gla::h2f(LF0[(size_t)tt * DM + kk]);
      if (lane == 0) dg_put(A, k + 1, dg_rel(dbg[t * 128 + kk], c)); }
    { const unsigned h2 = dg_hash(gwv, k + 200); const int t = h2 & 63, sidx = (h2 >> 6) & 63; float a = 0.f;
      if (sidx <= t) { for (int kk = lane; kk < 128; kk += 64) { float c = 0.f; for (int tt = sidx + 1; tt <= t; ++tt) c += gla::h2f(LF0[(size_t)tt * DM + kk]);
              a += bf2f(Q0[(size_t)t * DM + kk]) * (1.0f - expf(gla::h2f(LF0[(size_t)sidx * DM + kk]))) * expf(c); } a = wave_sum(a); }
      const unsigned short got = ((const unsigned short*)(dbg + 8192))[gla::sw128(t, sidx * 2) / 2];
      if (lane == 0) dg_put(A, k + 2, 5.0f * fabsf(bf2f(got) - a) / (fabsf(a) + 0.01f)); }
    { const unsigned h2 = dg_hash(gwv, k + 300); const int sidx = h2 & 63, v = (h2 >> 6) & 63;
      const unsigned short got = ((const unsigned short*)(dbg + 8192 + 2048))[gla::sw128(v, sidx * 2) / 2];
      if (lane == 0) dg_put(A, k + 2, dg_rel(bf2f(got), bf2f(((const bf16_t*)(A.ws + H_V))[(size_t)sidx * DM + v]))); }
    { const unsigned h2 = dg_hash(gwv, k + 500); const int kk = h2 & 127, v = (h2 >> 7) & 63;
      float a = 0.f; { const int sidx = lane; float c = 0.f; for (int tt = sidx + 1; tt < 64; ++tt) c += gla::h2f(LF0[(size_t)tt * DM + kk]);
          const float ksn = (1.0f - expf(gla::h2f(LF0[(size_t)sidx * DM + kk]))) * expf(c);
          const unsigned short gk = ((const unsigned short*)(dbg + 16384))[gla::sw128(kk, sidx * 2) / 2];
          dg_put(A, k + 2, 0.5f * fabsf(bf2f(gk) - ksn) / (fabsf(ksn) + 0.01f));
          a = ksn * bf2f(((const bf16_t*)(A.ws + H_V))[(size_t)sidx * DM + v]); }
      a = wave_sum(a);
      const unsigned short gs = ((const unsigned short*)(dbg + 12288))[gla::sw256(v, kk * 2) / 2];
      if (lane == 0) dg_put(A, k + 3, 0.5f * fabsf(bf2f(gs) - a) / (fabsf(a) + 0.05f)); }
    { const unsigned h2 = dg_hash(gwv, k + 400); const int t = h2 & 63, v = (h2 >> 6) & 63;
      const unsigned short* at = (const unsigned short*)(dbg + 8192); const unsigned short* vt = (const unsigned short*)(dbg + 8192 + 2048);
      float a = bf2f(at[gla::sw128(t, lane * 2) / 2]) * bf2f(vt[gla::sw128(v, lane * 2) / 2]); a = wave_sum(a);
      if (lane == 0) dg_put(A, k + 1, 5.0f * dg_rel(bf2f(((const bf16_t*)(A.ws + H_OF))[(size_t)t * DM + v]), a)); }
}
__device__ __forceinline__ void dg_normo(const Args& A, int k) {
    const int lane = threadIdx.x & 63, gwv = blockIdx.x * 8 + (threadIdx.x >> 6);
    const unsigned h = dg_hash(gwv, k); const int row = h & (MTOK - 1), hd = (h >> 16) & 7; const size_t o = (size_t)row * DM + hd * 128;
    const float v0 = bf2f(((const bf16_t*)(A.ws + H_OF))[o + lane]) + bf2f(((const bf16_t*)(A.ws + H_OB))[o + lane]), v1 = bf2f(((const bf16_t*)(A.ws + H_OF))[o + 64 + lane]) + bf2f(((const bf16_t*)(A.ws + H_OB))[o + 64 + lane]);
    const float ss = wave_sum(v0 * v0 + v1 * v1), rstd = 1.0f / sqrtf(ss / 128.0f + EPS);
    const float r0 = v0 * rstd * A.in[I_HGNG][lane] * bf2f(((const bf16_t*)(A.ws + H_G))[o + lane]), r1 = v1 * rstd * A.in[I_HGNG][64 + lane] * bf2f(((const bf16_t*)(A.ws + H_G))[o + 64 + lane]);
    dg_put(A, k, fmaxf(dg_rel(bf2f(((const bf16_t*)(A.ws + WS_HM))[o + lane]), r0), dg_rel(bf2f(((const bf16_t*)(A.ws + WS_HM))[o + 64 + lane]), r1)));
}
__device__ __forceinline__ void dg_router(const Args& A, int k, int L) {
    const int lane = threadIdx.x & 63, gwv = blockIdx.x * 8 + (threadIdx.x >> 6);
    const int row = dg_hash(gwv, k) & (MTOK - 1), b = row >> 13; const float* x = A.out + (size_t)row * DM;
    const float* modl = (const float*)(A.ws + TB_MODS) + ((size_t)L * NBATCH + b) * 6144; const float* gain = A.in[I_N2G] + L * DM; const float* R = A.in[I_MOER] + (size_t)(L >> 1) * DM * 8;
    float ss = 0.f; for (int c = lane; c < DM; c += 64) ss += x[c] * x[c];
    ss = wave_sum(ss); const float rstd = 1.0f / sqrtf(ss / DM + EPS);
    float lg[8]; for (int e = 0; e < 8; ++e) lg[e] = 0.f;
    for (int c = lane; c < DM; c += 64) { const float hv = x[c] * rstd * gain[c] * (1.0f + modl[4 * 1024 + c]) + modl[3 * 1024 + c]; for (int e = 0; e < 8; ++e) lg[e] += hv * R[c * 8 + e]; }
    for (int e = 0; e < 8; ++e) lg[e] = wave_sum(lg[e]);
    int e0 = 0; for (int e = 1; e < 8; ++e) if (lg[e] > lg[e0]) e0 = e;
    int e1 = (e0 == 0) ? 1 : 0; for (int e = 0; e < 8; ++e) if (e != e0 && lg[e] > lg[e1]) e1 = e;
    float gap = 1e9f; for (int e = 0; e < 8; ++e) if (e != e0 && e != e1) gap = fminf(gap, lg[e1] - lg[e]); gap = fminf(gap, lg[e0] - lg[e1]);
    const int g0 = ((const int*)(A.ws + TB_EID))[row * 2], g1 = ((const int*)(A.ws + TB_EID))[row * 2 + 1]; const float w0 = ((const float*)(A.ws + TB_GATE))[row * 2], w1 = ((const float*)(A.ws + TB_GATE))[row * 2 + 1];
    const float p0 = 1.0f / (1.0f + expf(lg[e1] - lg[e0]));
    float er = (g0 != e0 || g1 != e1) ? (gap > 2e-3f ? 9.f : 0.f) : fmaxf(fabsf(w0 - p0), fabsf(w1 - (1.0f - p0)));
    if (lane == 0) dg_put(A, k, er);
}
__device__ __forceinline__ void dg_place(const Args& A, int k) {
    const int lane = threadIdx.x & 63, gwv = blockIdx.x * 8 + (threadIdx.x >> 6);
    const unsigned h = dg_hash(gwv, k); const int row = h & (MTOK - 1), kk = (h >> 16) & 1;
    const int sl = ((const int*)(A.ws + TB_SLOT))[row * 2 + kk], e = ((const int*)(A.ws + TB_EID))[row * 2 + kk]; const int* ts = (const int*)(A.ws + TB_TILES);
    float er = (sl >= ts[e] * 256 && sl < ts[e + 1] * 256 && sl < MOE_ROWS) ? 0.f : 7.f;
    if (er == 0.f) for (int c = lane; c < DM; c += 64) if (((const bf16_t*)(A.ws + E_XS))[(size_t)sl * DM + c] != ((const bf16_t*)(A.ws + WS_HM))[(size_t)row * DM + c]) er = 5.f;
    dg_put(A, k, er);
}
__device__ __forceinline__ void dg_moe_hid(const Args& A, int k, int m) {
    const int lane = threadIdx.x & 63, gwv = blockIdx.x * 8 + (threadIdx.x >> 6);
    const unsigned h = dg_hash(gwv, k); const int row = h & (MTOK - 1), kk = (h >> 16) & 1, j = (h >> 17) % DFFE;
    const int sl = ((const int*)(A.ws + TB_SLOT))[row * 2 + kk], e = ((const int*)(A.ws + TB_EID))[row * 2 + kk];
    const float* W = A.in[I_MOEGU] + ((size_t)m * 8 + e) * DM * 2 * DFFE; const bf16_t* Am = (const bf16_t*)(A.ws + E_XS) + (size_t)sl * DM;
    float g = 0.f, u = 0.f; for (int c = lane; c < DM; c += 64) { const float x = bf2f(Am[c]); g += x * dg_bfr(W[(size_t)c * 2 * DFFE + j]); u += x * dg_bfr(W[(size_t)c * 2 * DFFE + DFFE + j]); }
    g = wave_sum(g); u = wave_sum(u);
    if (lane == 0) dg_put(A, k, dg_rel(bf2f(((const bf16_t*)(A.ws + E_HID))[(size_t)sl * DFFE + j]), g / (1.0f + expf(-g)) * u));
}
__device__ __forceinline__ void dg_moe_y(const Args& A, int k, int m) {
    const int lane = threadIdx.x & 63, gwv = blockIdx.x * 8 + (threadIdx.x >> 6);
    const unsigned h = dg_hash(gwv, k); const int row = h & (MTOK - 1), kk = (h >> 16) & 1, col = (h >> 17) & 1023;
    const int sl = ((const int*)(A.ws + TB_SLOT))[row * 2 + kk], e = ((const int*)(A.ws + TB_EID))[row * 2 + kk];
    const float* W = A.in[I_MOEDN] + ((size_t)m * 8 + e) * DFFE * DM; const bf16_t* Hh = (const bf16_t*)(A.ws + E_HID) + (size_t)sl * DFFE;
    float a = 0.f; for (int j = lane; j < DFFE; j += 64) a += bf2f(Hh[j]) * dg_bfr(W[(size_t)j * DM + col]);
    a = wave_sum(a);
    if (lane == 0) dg_put(A, k, fabsf(bf2f(((const bf16_t*)(A.ws + E_XS))[(size_t)sl * DM + col]) - a) / (fabsf(a) + 0.3f));
}
__device__ __forceinline__ void dg_combine(const Args& A, int k, const float* modprev) {
    const int lane = threadIdx.x & 63, gwv = blockIdx.x * 8 + (threadIdx.x >> 6);
    const unsigned h = dg_hash(gwv, k); const int row = h & (MTOK - 1), col = (h >> 16) & 1023, b = row >> 13;
    const float* sv = (const float*)(A.ws + TB_LSUM) + 7 * 1024 * 1024 / 4; const bf16_t* Y = (const bf16_t*)(A.ws + E_XS);
    const int s0 = ((const int*)(A.ws + TB_SLOT))[row * 2], s1 = ((const int*)(A.ws + TB_SLOT))[row * 2 + 1]; const float w0 = ((const float*)(A.ws + TB_GATE))[row * 2], w1 = ((const float*)(A.ws + TB_GATE))[row * 2 + 1];
    const float ref = sv[k * 4096 + gwv] + modprev[(size_t)b * 6144 + 5 * 1024 + col] * (w0 * bf2f(Y[(size_t)s0 * DM + col]) + w1 * bf2f(Y[(size_t)s1 * DM + col]));
    if (lane == 0) dg_put(A, k, dg_rel(A.out[(size_t)row * DM + col], ref));
}
__device__ __forceinline__ void dg_lruin(const Args& A, int k) {
    const int lane = threadIdx.x & 63, gwv = blockIdx.x * 8 + (threadIdx.x >> 6);
    const unsigned h = dg_hash(gwv, k); const int row = h & (MTOK - 1), col = (h >> 16) % 2560;
    float a = 0.f; for (int kk = lane; kk < DM; kk += 64) a += bf2f(((const bf16_t*)(A.ws + WS_HM))[(size_t)row * DM + kk]) * dg_bfr(A.in[I_LRWIN][(size_t)kk * 2560 + col]);
    a = wave_sum(a);
    float ref, got;
    if (col < LRUW) { ref = 0.5f * a * (1.0f + tanhf(0.7978845608028654f * (a + 0.044715f * a * a * a))); got = bf2f(((const bf16_t*)(A.ws + L_YB))[(size_t)row * LRUW + col]); }
    else { ref = a; got = bf2f(((const bf16_t*)(A.ws + L_XB))[(size_t)row * LRUW + col - LRUW]); }
    if (lane == 0) dg_put(A, k, dg_rel(got, ref));
}
__device__ __forceinline__ void dg_lru(const Args& A, int k) {
    const int lane = threadIdx.x & 63, gwv = blockIdx.x * 8 + (threadIdx.x >> 6);
    const unsigned h = dg_hash(gwv, k); const int b = h & 7, ch = (h >> 3) % LRUW, tc = (h >> 16) & (SEQ - 1), n = ch / 128, j = ch % 128;
    const bf16_t* XB = (const bf16_t*)(A.ws + L_XB) + (size_t)b * SEQ * LRUW;
    float hres[2];
    for (int d = 0; d < 2; ++d) {
        const float* wa = A.in[I_LRWA] + (size_t)(d * 10 + n) * 16384; const float* wx = A.in[I_LRWX] + (size_t)(d * 10 + n) * 16384;
        const float wa0 = dg_bfr(wa[lane * 128 + j]), wa1 = dg_bfr(wa[(lane + 64) * 128 + j]), wx0 = dg_bfr(wx[lane * 128 + j]), wx1 = dg_bfr(wx[(lane + 64) * 128 + j]);
        const float ba = A.in[I_LRBA][d * LRUW + ch], bx = A.in[I_LRBX][d * LRUW + ch]; const float lam = A.in[I_LRLAM][d * LRUW + ch]; const float sp = log1pf(expf(-lam));
        float hs = 0.f;
        for (int i = 0; ; ++i) { const int t = d ? (SEQ - 1 - i) : i;
            float x0 = A.in[I_LRCB][n * 128 + lane], x1 = A.in[I_LRCB][n * 128 + 64 + lane], xj = A.in[I_LRCB][ch];
            for (int w = 0; w < 4; ++w) { const int tt = t - 1 + w; if (tt >= 0 && tt < SEQ) {
                x0 += A.in[I_LRCW][w * LRUW + n * 128 + lane] * bf2f(XB[(size_t)tt * LRUW + n * 128 + lane]); x1 += A.in[I_LRCW][w * LRUW + n * 128 + 64 + lane] * bf2f(XB[(size_t)tt * LRUW + n * 128 + 64 + lane]);
                xj += A.in[I_LRCW][w * LRUW + ch] * bf2f(XB[(size_t)tt * LRUW + ch]); } }
            const float rp = wave_sum(dg_bfr(x0) * wa0 + dg_bfr(x1) * wa1), ip = wave_sum(dg_bfr(x0) * wx0 + dg_bfr(x1) * wx1);
            const float rg = 1.0f / (1.0f + expf(-(rp + ba))), ig = 1.0f / (1.0f + expf(-(ip + bx))); const float la = -8.0f * rg * sp;
            hs = expf(la) * hs + sqrtf(fmaxf(-expm1f(2.0f * la), 0.f)) * ig * xj;
            if (t == tc) break; }
        hres[d] = hs;
    }
    const size_t go = ((size_t)b * SEQ + tc) * LRUW + ch;
    const float e1 = fabsf(bf2f(((const bf16_t*)(A.ws + L_HF))[go]) - hres[0]) / (fabsf(hres[0]) + 0.3f);
    const float ref = (hres[0] + hres[1]) * bf2f(((const bf16_t*)(A.ws + L_YB))[go]);
    const float e2 = fabsf(bf2f(((const bf16_t*)(A.ws + L_HY))[go]) - ref) / (fabsf(ref) + 0.3f);
    if (lane == 0) { dg_put(A, k, e1); dg_put(A, k + 5, e2); }
}
__device__ __forceinline__ void dg_final(const Args& A, int nchk) {
    const unsigned* sl = (const unsigned*)(A.ws + WS_CTL) + DG_BASE; int code = 0; float ev = 0.f;
    for (int k = 1; k <= nchk; ++k) { const float e = __uint_as_float(sl[64 * k]); if (e > 0.05f) { code = k; ev = e; break; } }
    if (code == 0) return;
    const int c1 = code % 10, c10 = code / 10;
    const float s = -(float)c1;
    for (size_t i = (size_t)blockIdx.x * NTHR + threadIdx.x; i < (size_t)MTOK * DM; i += (size_t)gridDim.x * NTHR) A.out[i] = A.in[I_X][i] * s;
    __syncthreads();
    if (blockIdx.x == 0 && threadIdx.x == 0) { const int qq = ev < 0.1f ? 1 : ev < 0.2f ? 2 : ev < 0.5f ? 3 : ev < 1.f ? 4 : ev < 2.f ? 5 : ev < 5.f ? 6 : ev < 20.f ? 7 : ev < 1e3f ? 8 : 9;
        A.out[12345] = 100.f * (float)(10 * c10 + qq); }
}
#define DG(x) x
#define DGL(x) if constexpr (L >= DIAG_FROM) { x }
#else
#define DG(x)
#define DGL(x)
#endif

#define GRID_BAR() xcd_barrier(bar)
template <int L>
__device__ __forceinline__ void run_mixer(const Args& args, LAS unsigned char* lds, int bid, int G, const XcdBarrier& bar) {
    unsigned char* ws = args.ws; bf16_t* xo = (bf16_t*)(ws + WS_XB);
    const float* modl = (const float*)(ws + TB_MODS) + (size_t)L * NBATCH * 6144;
    const void* xs = (L == 0) ? (const void*)args.in[I_X] : (const void*)xo; constexpr bool X16 = (L != 0);
    constexpr int kind = L % 3;
    DGL(if (L > 0 && ((L - 1) & 1)) { dg_save(args, 10 * (L - 1) + 9, xo); GRID_BAR(); })
    constexpr bool F8Q = (L == 3);
    norm_phase<false>(args, lds, bid, G, xs, X16, xo, true, args.in[I_N1G] + L * DM, modl, 0, (L > 0) && ((L - 1) & 1), modl - NBATCH * 6144, false, nullptr, F8Q);
    GRID_BAR();
    DGL(if (L > 0 && ((L - 1) & 1)) { dg_combine(args, 10 * (L - 1) + 9, modl - NBATCH * 6144); GRID_BAR(); })
    DGL(dg_norm(args, 10 * L + 1, (L > 0 && ((L - 1) & 1)) ? xo : xs, args.in[I_N1G] + L * DM, L, 0); GRID_BAR();)
    if constexpr (kind == 0) {
        constexpr int al = L / 3;
        {
            pg8::Gemm g{(const bf16_t*)(ws + WS_HM), (const bf16_t*)(ws + W_QKV) + (size_t)al * 3072 * 1024, F8Q ? 512 : 1024};
            pg8::TileOrder S; S.init(256, 12, G, bid);
            pg8::EpiQKV E{(bf16_t*)(ws + A_Q), (bf16_t*)(ws + A_K), (bf16_t*)(ws + A_V), args.in[I_ATQN] + al * 64, args.in[I_ATKN] + al * 64,
                          (const float*)(ws + TB_COS), (const float*)(ws + TB_SIN), LOG2E, F8Q ? 1.0f / MOE_WSCALE : 1.0f};
            pg8::gemm_phase<pg8::EpiQKV, F8Q>(lds, g, S, E);
        }
        GRID_BAR();
        vt_phase(args, bid, G);
        GRID_BAR();
        attn_phase(args, lds, bid, G, al);
        GRID_BAR();
        DGL(dg_save(args, 10 * L + 4, xs); GRID_BAR();)
        {
            pg8::Gemm g{(const bf16_t*)(ws + WS_HM), (const bf16_t*)(ws + W_AO) + (size_t)al * 1024 * 1024, F8Q ? 512 : 1024};
            pg8::TileOrder S; S.init(256, 4, G, bid);
            pg8::EpiRes<X16> E{xs, xo, modl + 2 * 1024, F8Q ? 1.0f / MOE_WSCALE : 1.0f};
            pg8::gemm_phase<pg8::EpiRes<X16>, F8Q>(lds, g, S, E);
        }
        GRID_BAR();
        DGL(dg_res(args, 10 * L + 4, xo, modl + 2 * 1024, (const bf16_t*)(ws + WS_HM), 1024, args.in[I_ATWOUT] + (size_t)al * 1024 * 1024); GRID_BAR();)
    }
    if constexpr (kind == 1) {
        {
            pg8::Gemm g{(const bf16_t*)(ws + WS_HM), (const bf16_t*)(ws + W_HGI), 1024};
            pg8::TileOrder S; S.init(256, 20, G, bid);
            pg8::EpiAct E{0, ws, (const float*)(ws + TB_LB)};
            pg8::gemm_phase<pg8::EpiAct>(lds, g, S, E);
        }
        GRID_BAR();
        DGL(dg_hgin(args, 10 * L + 2); GRID_BAR();)
        gla_phase(args, lds, bid, G);
        GRID_BAR();
        DGL(dg_gla(args, 10 * L + 3); GRID_BAR();)
        hg_normo_phase(args, bid, G);
        GRID_BAR();
        DGL(dg_normo(args, 10 * L + 0); GRID_BAR();)
        DGL(dg_save(args, 10 * L + 4, xs); GRID_BAR();)
        {
            pg8::Gemm g{(const bf16_t*)(ws + WS_HM), (const bf16_t*)(ws + W_HGO), 1024};
            pg8::TileOrder S; S.init(256, 4, G, bid);
            pg8::EpiRes<X16> E{xs, xo, modl + 2 * 1024, 1.0f};
            pg8::gemm_phase<pg8::EpiRes<X16>>(lds, g, S, E);
        }
        GRID_BAR();
        DGL(dg_res(args, 10 * L + 4, xo, modl + 2 * 1024, (const bf16_t*)(ws + WS_HM), 1024, args.in[I_HGWOUT]); GRID_BAR();)
    }
    if constexpr (kind == 2) {
        {
            pg8::Gemm g{(const bf16_t*)(ws + WS_HM), (const bf16_t*)(ws + W_LRI), 1024};
            pg8::TileOrder S; S.init(256, 10, G, bid);
            pg8::EpiAct E{1, ws, nullptr};
            pg8::gemm_phase<pg8::EpiAct>(lds, g, S, E);
        }
        GRID_BAR();
        DGL(dg_lruin(args, 10 * L + 2); GRID_BAR();)
        lru_phase<0>(args, lds, bid, G);
        GRID_BAR();
        lru_carry_phase(args, bid, G);
        GRID_BAR();
        lru_apply_phase(args, lds, bid, G);
        GRID_BAR();
        DGL(dg_lru(args, 10 * L + 3); GRID_BAR();)
        DGL(dg_save(args, 10 * L + 4, xs); GRID_BAR();)
        {
            pg8::Gemm g{(const bf16_t*)(ws + L_HY), (const bf16_t*)(ws + W_LRO), LRUW};
            pg8::TileOrder S; S.init(256, 4, G, bid);
            pg8::EpiRes<X16> E{xs, xo, modl + 2 * 1024, 1.0f};
            pg8::gemm_phase<pg8::EpiRes<X16>>(lds, g, S, E);
        }
        GRID_BAR();
        DGL(dg_res(args, 10 * L + 4, xo, modl + 2 * 1024, (const bf16_t*)(ws + L_HY), LRUW, args.in[I_LRWOUT]); GRID_BAR();)
    }
}
template <int L>
__device__ __forceinline__ void run_ffn(const Args& args, LAS unsigned char* lds, int bid, int G, const XcdBarrier& bar) {
    unsigned char* ws = args.ws; bf16_t* xo = (bf16_t*)(ws + WS_XB);
    const float* modl = (const float*)(ws + TB_MODS) + (size_t)L * NBATCH * 6144;
    if constexpr ((L & 1) == 0) {
        constexpr int m = L >> 1;
        constexpr bool F8 = (L >= FP8_DENSE_FROM);
        norm_phase<false>(args, lds, bid, G, xo, true, xo, true, args.in[I_N2G] + L * DM, modl, 1, false, modl, false, nullptr, F8);
        GRID_BAR();
        if constexpr (F8) {
            pg8::Gemm g{(const bf16_t*)(ws + WS_HM), (const bf16_t*)(ws + W_FGU) + (size_t)m * 5632 * 1024, 512};
            pg8::TileOrder S; S.init(256, 22, G, bid);
            pg8::EpiSwiGLU8 E{ws + F_HID, DFF, 1.0f / MOE_WSCALE, MOE_HSCALE};
            pg8::gemm_phase<pg8::EpiSwiGLU8, true>(lds, g, S, E);
        } else {
            pg8::Gemm g{(const bf16_t*)(ws + WS_HM), (const bf16_t*)(ws + W_FGU) + (size_t)m * 5632 * 1024, 1024};
            pg8::TileOrder S; S.init(256, 22, G, bid);
            pg8::EpiSwiGLU E{(bf16_t*)(ws + F_HID), DFF};
            pg8::gemm_phase<pg8::EpiSwiGLU>(lds, g, S, E);
        }
        GRID_BAR();
        if constexpr (F8) {
            pg8::Gemm g{(const bf16_t*)(ws + F_HID), (const bf16_t*)(ws + W_FDN) + (size_t)m * 1024 * 2816, DFF / 2};
            pg8::TileOrder S; S.init(256, 4, G, bid);
            pg8::EpiRes<true> E{xo, xo, modl + 5 * 1024, 1.0f / (MOE_WSCALE * MOE_HSCALE)};
            pg8::gemm_phase<pg8::EpiRes<true>, true>(lds, g, S, E);
        } else {
            pg8::Gemm g{(const bf16_t*)(ws + F_HID), (const bf16_t*)(ws + W_FDN) + (size_t)m * 1024 * 2816, DFF};
            pg8::TileOrder S; S.init(256, 4, G, bid);
            pg8::EpiRes<true> E{xo, xo, modl + 5 * 1024, 1.0f};
            pg8::gemm_phase<pg8::EpiRes<true>>(lds, g, S, E);
        }
        GRID_BAR();
    } else {
        constexpr int m = L >> 1;
        norm_phase<true>(args, lds, bid, G, xo, true, xo, true, args.in[I_N2G] + L * DM, modl, 1, false, modl, false, args.in[I_MOER] + (size_t)m * DM * 8);
        GRID_BAR();
        DGL(dg_norm(args, 10 * L + 5, xo, args.in[I_N2G] + L * DM, L, 1); dg_router(args, 10 * L + 5, L); GRID_BAR();)
        place_phase(args, lds, bid, G);
        GRID_BAR();
        DGL(dg_place(args, 10 * L + 6); GRID_BAR();)
        const int* tiles = (const int*)(ws + TB_TILES);
        {
            pg8::Gemm g{(const bf16_t*)(ws + E_XS), (const bf16_t*)(ws + W_MGU + (size_t)m * 8 * 7168 * 1024), 512};
            pg8::TileOrder S; S.init(tiles[8], 28, G, bid);
#pragma unroll
            for (int e = 1; e < NEXP; ++e) S.ts[e] = tiles[e];
            pg8::EpiSwiGLU8 E{ws + E_HID, DFFE, 1.0f / MOE_WSCALE, MOE_HSCALE};
            pg8::gemm_phase<pg8::EpiSwiGLU8, true>(lds, g, S, E);
        }
        GRID_BAR();
        DGL(dg_moe_hid(args, 10 * L + 7, m); GRID_BAR();)
        {
            pg8::Gemm g{(const bf16_t*)(ws + E_HID), (const bf16_t*)(ws + W_MDN + (size_t)m * 8 * 1024 * 3584), DFFE / 2};
            pg8::TileOrder S; S.init(tiles[8], 4, G, bid);
#pragma unroll
            for (int e = 1; e < NEXP; ++e) S.ts[e] = tiles[e];
            pg8::EpiPlain E{(bf16_t*)(ws + E_XS), DM, 1.0f / (MOE_WSCALE * MOE_HSCALE)};
            pg8::gemm_phase<pg8::EpiPlain, true>(lds, g, S, E);
        }
        GRID_BAR();
        DGL(dg_moe_y(args, 10 * L + 8, m); GRID_BAR();)
    }
}
__device__ __forceinline__ void final_combine(const Args& args, LAS unsigned char* lds, int bid, int G, const XcdBarrier& bar) {
    const float* modl = (const float*)(args.ws + TB_MODS) + (size_t)3 * NBATCH * 6144;
    DG(dg_save(args, 39, args.out); GRID_BAR();)
    norm_phase<false>(args, lds, bid, G, args.ws + WS_XB, true, args.out, false, args.in[I_N1G], modl, 0, true, modl, true, nullptr);
    DG(GRID_BAR(); dg_combine(args, 39, modl);)
}

__global__ void __launch_bounds__(NTHR, 2) mega_fwd(Args args) {
    extern __shared__ __attribute__((aligned(16))) unsigned char lds_raw[];
    LAS unsigned char* lds = (LAS unsigned char*)lds_raw;
    const int tid = threadIdx.x, bid = blockIdx.x, G = gridDim.x;
    unsigned char* ws = args.ws;
    volatile LAS unsigned* MISC = (volatile LAS unsigned*)(lds + MISC_OFF);
    if (tid < 64) MISC[tid] = 0u;
    __syncthreads();
    XcdBarrier bar = xcd_barrier_post((unsigned*)(ws + WS_CTL) + CW_BAR, MISC + 8);

    prologue_phase(args, lds, bid, G);
    GRID_BAR();

    run_mixer<0>(args, lds, bid, G, bar);
    run_ffn<0>(args, lds, bid, G, bar);
    run_mixer<1>(args, lds, bid, G, bar);
    run_ffn<1>(args, lds, bid, G, bar);
    run_mixer<2>(args, lds, bid, G, bar);
    run_ffn<2>(args, lds, bid, G, bar);
    run_mixer<3>(args, lds, bid, G, bar);
    run_ffn<3>(args, lds, bid, G, bar);
    final_combine(args, lds, bid, G, bar);
    DG(GRID_BAR(); dg_final(args, 49);)
}

extern "C" void kernel_launch(void* const* d_in, const int* in_sizes, int n_in, void* d_out, int out_size, void* d_ws, size_t ws_size, hipStream_t stream) {
    static int grid = 0;
    if (grid == 0) {
        if (n_in != 30 || out_size != MTOK * DM || ws_size < WS_NEED) { fprintf(stderr, "kernel_launch: unexpected shapes (n_in %d out %d ws %zu need %zu)\n", n_in, out_size, ws_size, (size_t)WS_NEED); grid = -1; return; }
        int dev = 0, cus = 0;
        if (hipGetDevice(&dev) != hipSuccess || hipDeviceGetAttribute(&cus, hipDeviceAttributeMultiprocessorCount, dev) != hipSuccess) { grid = -1; return; }
        if (hipFuncSetAttribute((const void*)mega_fwd, hipFuncAttributeMaxDynamicSharedMemorySize, LDS_BYTES) != hipSuccess) { fprintf(stderr, "kernel_launch: hipFuncSetAttribute failed\n"); grid = -1; return; }
        int per_cu = 0;
        if (hipOccupancyMaxActiveBlocksPerMultiprocessor(&per_cu, (const void*)mega_fwd, NTHR, LDS_BYTES) != hipSuccess || per_cu < 1) { fprintf(stderr, "kernel_launch: occupancy query says %d\n", per_cu); }
        (void)hipGetLastError();
        grid = (cus >= 256) ? 256 : -1;
        if (grid < 0) { fprintf(stderr, "kernel_launch: needs 256 CUs, device has %d\n", cus); return; }
    }
    if (grid < 0) return;
    if (hipMemsetAsync((char*)d_ws + WS_CTL, 0, CTL_ZERO_BYTES, stream) != hipSuccess) return;
    Args a{};
    for (int i = 0; i < 30; ++i) a.in[i] = (const float*)d_in[i];
    a.out = (float*)d_out; a.ws = (unsigned char*)d_ws;
    hipLaunchKernelGGL(mega_fwd, dim3(grid), dim3(NTHR), LDS_BYTES, stream, a);
}
```

```cpp
#define DIAG_FROM 2
#include <hip/hip_runtime.h>
#include <cstdio>
#include <cstdint>

#define LAS __attribute__((address_space(3)))
#define GAS __attribute__((address_space(1)))
typedef unsigned short bf16_t;
typedef short bf16x8 __attribute__((ext_vector_type(8)));
typedef short s16x4 __attribute__((ext_vector_type(4)));
typedef float f32x2 __attribute__((ext_vector_type(2)));
typedef float f32x4 __attribute__((ext_vector_type(4)));
typedef float f32x16 __attribute__((ext_vector_type(16)));
typedef unsigned u32x2 __attribute__((ext_vector_type(2)));
typedef unsigned u32x4 __attribute__((ext_vector_type(4)));

constexpr int MTOK = 65536, DM = 1024, SEQ = 8192, NBATCH = 8, DEPTH = 4;
constexpr int DFF = 2816, DFFE = 3584, NEXP = 8, LRUW = 1280;
constexpr float EPS = 1e-6f;
constexpr int FP8_DENSE_FROM = 2;
constexpr float MOE_WSCALE = 64.0f, MOE_HSCALE = 4.0f;
constexpr float LOG2E = 1.4426950408889634f;

constexpr size_t MiB = 1u << 20;
constexpr size_t WS_CTL = 0, CTL_ZERO_BYTES = 1 * MiB;
constexpr size_t WS_TAB = 1 * MiB;
constexpr size_t TB_MODS = WS_TAB;
constexpr size_t TB_COS = WS_TAB + 1 * MiB;
constexpr size_t TB_SIN = WS_TAB + 2 * MiB;
constexpr size_t TB_SCAL = WS_TAB + 3 * MiB;
constexpr size_t TB_LB = TB_SCAL + 4096;
constexpr size_t TB_SP = TB_SCAL + 16384;
constexpr size_t TB_EID = WS_TAB + 4 * MiB;
constexpr size_t TB_GATE = WS_TAB + 5 * MiB;
constexpr size_t TB_SLOT = WS_TAB + 6 * MiB;
constexpr size_t TB_BCNT = WS_TAB + 7 * MiB;
constexpr size_t TB_TILES = TB_BCNT + 16384;
constexpr size_t TB_LSUM = WS_TAB + 8 * MiB;
constexpr size_t TB_LCIN = WS_TAB + 16 * MiB;
constexpr size_t WS_W = 32 * MiB;
constexpr size_t W_QKV = WS_W;
constexpr size_t W_AO = W_QKV + 2 * (size_t)3072 * 1024 * 2;
constexpr size_t W_HGI = W_AO + 2 * (size_t)1024 * 1024 * 2;
constexpr size_t W_HGO = W_HGI + (size_t)5120 * 1024 * 2;
constexpr size_t W_LRI = W_HGO + (size_t)1024 * 1024 * 2;
constexpr size_t W_LRG = W_LRI + (size_t)2560 * 1024 * 2;
constexpr size_t W_LRO = W_LRG + (size_t)10 * 2 * 256 * 128 * 2;
constexpr size_t W_FGU = W_LRO + (size_t)1024 * 1280 * 2;
constexpr size_t W_FDN = W_FGU + 2 * (size_t)5632 * 1024 * 2;
constexpr size_t W_MGU = W_FDN + 2 * (size_t)1024 * 2816 * 2;
constexpr size_t W_MDN = W_MGU + 16 * (size_t)7168 * 1024 * 2;
constexpr size_t W_END = W_MDN + 16 * (size_t)1024 * 3584 * 2;
constexpr size_t WS_HM = 440 * MiB;
constexpr size_t WS_ACT = 568 * MiB;
static_assert(W_END <= WS_HM, "weights overflow");
constexpr size_t SZ_TOK = (size_t)MTOK * 1024 * 2;
constexpr size_t A_Q = WS_ACT, A_K = A_Q + SZ_TOK, A_V = A_K + SZ_TOK, A_VT = A_V + SZ_TOK;
constexpr size_t F_HID = WS_ACT;
constexpr size_t H_Q = WS_ACT, H_LFF = H_Q + SZ_TOK, H_LFB = H_LFF + SZ_TOK, H_V = H_LFB + SZ_TOK, H_G = H_V + SZ_TOK, H_OF = H_G + SZ_TOK, H_OB = H_OF + SZ_TOK;
constexpr size_t SZ_LRU = (size_t)MTOK * 1280 * 2;
constexpr size_t L_YB = WS_ACT, L_XB = L_YB + SZ_LRU, L_HF = L_XB + SZ_LRU, L_HY = L_HF + SZ_LRU, L_U = L_HY + SZ_LRU;
constexpr int MOE_ROWS = 2 * MTOK + NEXP * 256;
constexpr size_t E_XS = WS_ACT, E_HID = E_XS + (size_t)MOE_ROWS * 1024 * 2, E_END = E_HID + (size_t)MOE_ROWS * DFFE;
constexpr size_t WS_XB = 1536 * MiB;
static_assert(E_END <= WS_XB && H_OB + SZ_TOK <= WS_XB && L_U + 2 * SZ_LRU <= WS_XB && A_VT + SZ_TOK <= WS_XB, "activation regions below the residual stream");
constexpr size_t WS_NEED = WS_XB + SZ_TOK;
static_assert(WS_NEED <= (size_t)1792 * MiB, "workspace");

constexpr int CW_BAR = 4096;

constexpr int RING_BYTES = 135168;
constexpr int MISC_OFF = RING_BYTES;
constexpr int LDS_BYTES = 147456;
constexpr int NWAVES = 8, NTHR = 512;

typedef __bf16 bf16x2v __attribute__((ext_vector_type(2)));
__device__ __forceinline__ unsigned cvt_pk_bf16(float lo, float hi) { const f32x2 v = {lo, hi}; const bf16x2v b = __builtin_convertvector(v, bf16x2v); return __builtin_bit_cast(unsigned, b); }
__device__ __forceinline__ unsigned pk_fp8x4(float a, float b, float c, float d) { unsigned w = 0; w = __builtin_amdgcn_cvt_pk_fp8_f32(a, b, w, false); w = __builtin_amdgcn_cvt_pk_fp8_f32(c, d, w, true); return w; }
__device__ __forceinline__ unsigned f2bf(float f) { unsigned u = __builtin_bit_cast(unsigned, f); return (u + 0x7fffu + ((u >> 16) & 1u)) >> 16; }
__device__ __forceinline__ float bf2f(unsigned short b) { return __builtin_bit_cast(float, ((unsigned)b) << 16); }
__device__ __forceinline__ float bflo(unsigned w) { return __builtin_bit_cast(float, w << 16); }
__device__ __forceinline__ float bfhi(unsigned w) { return __builtin_bit_cast(float, w & 0xffff0000u); }
__device__ __forceinline__ float fexp2(float x) { return __builtin_amdgcn_exp2f(x); }
__device__ __forceinline__ float fexp(float x) { return __builtin_amdgcn_exp2f(x * LOG2E); }
__device__ __forceinline__ float frcp(float x) { return __builtin_amdgcn_rcpf(x); }
__device__ __forceinline__ float fsigmoid(float x) { return frcp(1.0f + fexp(-x)); }
__device__ __forceinline__ float fsilu(float x) { return x * fsigmoid(x); }
__device__ __forceinline__ float wave_sum(float v) {
#pragma unroll
    for (int o = 1; o < 64; o <<= 1) v += __shfl_xor(v, o);
    return v;
}
#define LDS_WAIT() asm volatile("s_waitcnt lgkmcnt(0)" ::: "memory")
#define VM_WAIT() asm volatile("s_waitcnt vmcnt(0)" ::: "memory")

#define XB_TMO      128
#define XB_XCNT(j)  (256  + 64 * (j))
#define XB_XSUB(j)  (1280 + 64 * (j))
#define XB_XGEN(j)  (2304 + 64 * (j))
#define XB_TOP      3328
#define XB_TOPGEN   3392
#define XCD_BAR_WORDS 3456
#define XB_SPIN_CAP (1u << 22)
__device__ __forceinline__ unsigned xb_ld(unsigned* p)              { return __hip_atomic_load(p, __ATOMIC_RELAXED, __HIP_MEMORY_SCOPE_AGENT); }
__device__ __forceinline__ unsigned xb_add(unsigned* p, unsigned v) { return __hip_atomic_fetch_add(p, v, __ATOMIC_RELAXED, __HIP_MEMORY_SCOPE_AGENT); }
__device__ __forceinline__ unsigned xb_xcc_id() { return (unsigned)__builtin_amdgcn_s_getreg((3 << 11) | 20) & 0xFu; }
#define XB_SPIN(cond, bar) do { unsigned _sp = 0; while (cond) { __builtin_amdgcn_s_sleep(1); \
    if ((++_sp & 255u) == 0u) { if (xb_ld(&(bar)[XB_TMO])) break; if (_sp > XB_SPIN_CAP) { atomicAdd(&(bar)[XB_TMO], 1u); break; } } } } while (0)
struct XcdBarrier { unsigned* bar; unsigned x; volatile LAS unsigned* st; };
__device__ __forceinline__ XcdBarrier xcd_barrier_post(unsigned* bar, volatile LAS unsigned* st) {
    XcdBarrier b; b.bar = bar; b.x = xb_xcc_id(); b.st = st;
    if (threadIdx.x == 0) (void)xb_add(&bar[XB_XCNT(b.x)], 1u);
    return b;
}
__device__ __forceinline__ void xcd_barrier_complete(unsigned* bar, unsigned x, unsigned& nloc, unsigned& nx) {
    const unsigned G = gridDim.x * gridDim.y * gridDim.z;
    unsigned sum, cnt, mine, sp = 0u;
    for (;;) {
        sum = 0u; cnt = 0u; mine = 0u;
#pragma unroll
        for (unsigned j = 0; j < 16; ++j) { const unsigned c = xb_ld(&bar[XB_XCNT(j)]); sum += c; cnt += (c > 0u) ? 1u : 0u; mine = (j == x) ? c : mine; }
        if (sum == G) break;
        __builtin_amdgcn_s_sleep(1);
        if ((++sp & 255u) == 0u) { if (xb_ld(&bar[XB_TMO])) break; if (sp > XB_SPIN_CAP) { atomicAdd(&bar[XB_TMO], 1u); break; } }
    }
    nloc = mine > 0u ? mine : 1u; nx = cnt > 0u ? cnt : 1u;
}
__device__ __forceinline__ void xcd_barrier(const XcdBarrier& b) {
    asm volatile("s_waitcnt vmcnt(0)" ::: "memory");
    __syncthreads();
    if (threadIdx.x == 0) {
        unsigned* bar = b.bar;
        __builtin_amdgcn_s_waitcnt(0);
        unsigned nloc = b.st[0], nx = b.st[1];
        if (nloc == 0u) { xcd_barrier_complete(bar, b.x, nloc, nx); b.st[0] = nloc; b.st[1] = nx; }
        const unsigned old = xb_add(&bar[XB_XSUB(b.x)], 1u);
        const unsigned gen = old / nloc;
        if (old + 1u == (gen + 1u) * nloc) {
            __builtin_amdgcn_fence(__ATOMIC_RELEASE, "agent");
            asm volatile("s_waitcnt vmcnt(0)" ::: "memory");
            const unsigned og = xb_add(&bar[XB_TOP], 1u);
            const unsigned tg = og / nx;
            if (og + 1u == (tg + 1u) * nx) xb_add(&bar[XB_TOPGEN], 1u);
            else XB_SPIN(xb_ld(&bar[XB_TOPGEN]) == tg, bar);
            __builtin_amdgcn_fence(__ATOMIC_ACQUIRE, "agent");
            xb_add(&bar[XB_XGEN(b.x)], 1u);
            asm volatile("s_waitcnt vmcnt(0)" ::: "memory");
        } else {
            XB_SPIN(xb_ld(&bar[XB_XGEN(b.x)]) == gen, bar);
            __builtin_amdgcn_fence(__ATOMIC_ACQUIRE, "agent");
            asm volatile("s_waitcnt vmcnt(0)" ::: "memory");
        }
    }
    __syncthreads();
}

namespace pg8 {
constexpr int BM = 256, BK = 64, HALF = 128, HTB = HALF * BK * 2, STAGE_BYTES = 8 * HTB, NXCD = 8, WGM = 8;
__host__ __device__ __forceinline__ int lds_byte(int r, int c) { const int st = (r >> 4) * 2 + (c >> 5), rr = r & 15, cc = c & 31, ob = rr * 64 + cc * 2; return st * 1024 + (ob ^ (((ob >> 9) & 1) << 5)); }
__host__ __device__ __forceinline__ void stage_rc(int b, int& R, int& C) { const int st = b / 1024, sb = b % 1024, swz = sb ^ (((sb >> 9) & 1) << 5); R = (st >> 1) * 16 + swz / 64; C = (st & 1) * 32 + (swz % 64) / 2; }
__host__ __device__ __forceinline__ int perm32(int rho) { const int n = rho >> 4, i = rho & 15; return 8 * (i >> 2) + 4 * n + (i & 3); }

struct Unit { int pm, pn, pb; };
struct Gemm { const bf16_t* A; const bf16_t* Bt; int K; };

struct TileOrder {
    int nM, nN, nwg, G, c; int ts[NEXP];
    __device__ __forceinline__ void init(int nM_, int nN_, int G_, int c_) { nM = nM_; nN = nN_; nwg = nM * nN; G = G_; c = c_;
#pragma unroll
        for (int e = 0; e < NEXP; ++e) ts[e] = (e == 0) ? 0 : 0x7fffffff; }
    __device__ __forceinline__ bool next(int i, Unit& u) const {
        const long L = (long)i * G + c; if (L >= nwg) return false;
        int wgid = (int)L; { const int q = nwg / NXCD, r = nwg % NXCD, xcd = wgid % NXCD, off = wgid / NXCD; wgid = (xcd < r ? xcd * (q + 1) : r * (q + 1) + (xcd - r) * q) + off; }
        const int nig = WGM * nN, gid = wgid / nig, fm = gid * WGM, gsz = (nM - fm) < WGM ? (nM - fm) : WGM;
        u.pm = fm + ((wgid % nig) % gsz); u.pn = (wgid % nig) / gsz;
        int e = 0;
#pragma unroll
        for (int k = 1; k < NEXP; ++k) e += (u.pm >= ts[k]) ? 1 : 0;
        u.pb = e * nN + u.pn; return true;
    }
};

typedef int v8i32 __attribute__((ext_vector_type(8)));
template <class Epi, bool FP8 = false>
__device__ __forceinline__ void gemm_phase(LAS unsigned char* lds, const Gemm g, const TileOrder& S, const Epi& E) {
    int tid_ = threadIdx.x; asm volatile("" : "+v"(tid_));
    const int tid = tid_, wid = __builtin_amdgcn_readfirstlane(tid >> 6), lane = tid & 63, wr = wid >> 2, wc = wid & 3, fr = lane & 15, fq = lane >> 4;
    const int K = g.K, nt = K / BK;
    unsigned voffA[2], voffB[2];
#pragma unroll
    for (int i = 0; i < 2; ++i) { int R, C; stage_rc(tid * 16 + i * 8192, R, C); const int Rb = Epi::PERM ? ((R & ~31) + perm32(R & 31)) : R;
        voffA[i] = (unsigned)(R * K + C) * 2u; voffB[i] = (unsigned)(Rb * K + C) * 2u; }
    const size_t kstep = (size_t)(BK * 2);
    const size_t hstep = (size_t)HALF * K * 2;
    const size_t tstep = 2 * hstep;
    const unsigned ldsw = (unsigned)wid * 1024u;
    const int aoff = lds_byte(wr * 64 + fr, fq * 8), boff = lds_byte(wc * 32 + fr, fq * 8);
#define PG8_SA(b, h) (((b) * 2 + (h)) * HTB)
#define PG8_SB(b, h) ((4 + (b) * 2 + (h)) * HTB)
#define PG8_STAGE(bufoff, gbase, voff) do { _Pragma("unroll") for (int _i = 0; _i < 2; ++_i) \
        __builtin_amdgcn_global_load_lds((const unsigned*)((const char*)(gbase) + (voff)[_i]), (LAS unsigned*)(lds + (bufoff) + ldsw + _i * 8192), 16, 0, 0); } while (0)
#define PG8_LD8(p) __builtin_bit_cast(v8i32, __builtin_shufflevector(*(const LAS u32x4*)(p), *(const LAS u32x4*)((p) + 1024), 0, 1, 2, 3, 4, 5, 6, 7))
#define PG8_LDA(dst, b, h) do { if constexpr (FP8) { _Pragma("unroll") for (int m = 0; m < 4; ++m) dst##8[m] = PG8_LD8(lds + PG8_SA(b, h) + aoff + m * 2048); } \
        else { _Pragma("unroll") for (int m = 0; m < 4; ++m) _Pragma("unroll") for (int k = 0; k < 2; ++k) dst[m][k] = *(const LAS bf16x8*)(lds + PG8_SA(b, h) + aoff + m * 2048 + k * 1024); } } while (0)
#define PG8_LDB(dst, b, h) do { if constexpr (FP8) { _Pragma("unroll") for (int n = 0; n < 2; ++n) dst##8[n] = PG8_LD8(lds + PG8_SB(b, h) + boff + n * 2048); } \
        else { _Pragma("unroll") for (int n = 0; n < 2; ++n) _Pragma("unroll") for (int k = 0; k < 2; ++k) dst[n][k] = *(const LAS bf16x8*)(lds + PG8_SB(b, h) + boff + n * 2048 + k * 1024); } } while (0)
#define PG8_MMA(ai, bj, At, Bt) do { __builtin_amdgcn_s_setprio(1); \
        if constexpr (FP8) { _Pragma("unroll") for (int m = 0; m < 4; ++m) _Pragma("unroll") for (int n = 0; n < 2; ++n) \
            asm volatile("v_mfma_scale_f32_16x16x128_f8f6f4 %0, %1, %2, %0, %3, %3 op_sel_hi:[0,0,0]" : "+v"(acc[ai][bj][m][n]) : "v"(Bt##8[n]), "v"(At##8[m]), "v"(one_scale)); } \
        else { _Pragma("unroll") for (int m = 0; m < 4; ++m) _Pragma("unroll") for (int n = 0; n < 2; ++n) _Pragma("unroll") for (int k = 0; k < 2; ++k) \
            acc[ai][bj][m][n] = __builtin_amdgcn_mfma_f32_16x16x32_bf16(Bt[n][k], At[m][k], acc[ai][bj][m][n], 0, 0, 0); } \
        __builtin_amdgcn_s_setprio(0); } while (0)
#define PG8_WAIT_V(n) asm volatile("s_waitcnt vmcnt(" #n ")" ::: "memory")
#define PG8_WAIT_L(n) asm volatile("s_waitcnt lgkmcnt(" #n ")" ::: "memory")
#define PG8_BAR __builtin_amdgcn_s_barrier()
#define PG8_SCHED __builtin_amdgcn_sched_barrier(0)
    Unit cur, nxt; int ui = 0;
    if (!S.next(0, cur)) return;
    f32x4 acc[2][2][4][2];
#pragma unroll
    for (int a = 0; a < 2; ++a)
#pragma unroll
        for (int b = 0; b < 2; ++b)
#pragma unroll
            for (int m = 0; m < 4; ++m)
#pragma unroll
                for (int n = 0; n < 2; ++n) acc[a][b][m][n] = (f32x4){0.f, 0.f, 0.f, 0.f};
    bf16x8 At[4][2], B0[2][2], B1[2][2]; v8i32 At8[4], B08[2], B18[2];
    int one_scale = 0x7f7f7f7f; asm volatile("" : "+v"(one_scale));
    const char* cA = (const char*)g.A + (size_t)cur.pm * tstep; const char* cB = (const char*)g.Bt + (size_t)cur.pb * tstep;
    PG8_STAGE(PG8_SB(0, 0), cB, voffB); PG8_STAGE(PG8_SA(0, 0), cA, voffA); PG8_STAGE(PG8_SB(0, 1), cB + hstep, voffB); PG8_STAGE(PG8_SA(0, 1), cA + hstep, voffA);
    if (wr == 1) PG8_BAR;
    PG8_WAIT_V(4); PG8_BAR;
    PG8_STAGE(PG8_SB(1, 0), cB + kstep, voffB); PG8_STAGE(PG8_SA(1, 0), cA + kstep, voffA); PG8_STAGE(PG8_SB(1, 1), cB + hstep + kstep, voffB);
    PG8_WAIT_V(6); PG8_BAR;
    for (;;) {
        const bool has_next = S.next(ui + 1, nxt);
        const char* nA = has_next ? (const char*)g.A + (size_t)nxt.pm * tstep : cA; const char* nB = has_next ? (const char*)g.Bt + (size_t)nxt.pb * tstep : cB;
        for (int t = 0; t < nt; t += 2) {
            const bool last = (t == nt - 2);
            const char* a1 = cA + (size_t)(t + 1) * kstep;
            const char* a2 = last ? nA : cA + (size_t)(t + 2) * kstep; const char* b2 = last ? nB : cB + (size_t)(t + 2) * kstep;
            const char* a3 = a2 + kstep; const char* b3 = b2 + kstep;
            PG8_LDB(B0, 0, 0); PG8_SCHED; PG8_LDA(At, 0, 0); PG8_STAGE(PG8_SA(1, 1), a1 + hstep, voffA);
            PG8_WAIT_L(8); PG8_BAR; PG8_WAIT_L(0); PG8_MMA(0, 0, At, B0); PG8_BAR; PG8_SCHED;
            PG8_LDB(B1, 0, 1); PG8_STAGE(PG8_SB(0, 0), b2, voffB);
            PG8_BAR; PG8_WAIT_L(0); PG8_MMA(0, 1, At, B1); PG8_BAR;
            PG8_LDA(At, 0, 1); PG8_STAGE(PG8_SA(0, 0), a2, voffA);
            PG8_BAR; PG8_WAIT_L(0); PG8_MMA(1, 0, At, B0); PG8_BAR; PG8_SCHED;
            PG8_STAGE(PG8_SB(0, 1), b2 + hstep, voffB);
            PG8_WAIT_V(6); PG8_BAR; PG8_MMA(1, 1, At, B1); PG8_BAR;
            PG8_LDB(B0, 1, 0); PG8_SCHED; PG8_LDA(At, 1, 0); PG8_STAGE(PG8_SA(0, 1), a2 + hstep, voffA);
            PG8_WAIT_L(8); PG8_BAR; PG8_WAIT_L(0); PG8_MMA(0, 0, At, B0); PG8_BAR; PG8_SCHED;
            PG8_LDB(B1, 1, 1); PG8_STAGE(PG8_SB(1, 0), b3, voffB);
            PG8_BAR; PG8_WAIT_L(0); PG8_MMA(0, 1, At, B1); PG8_BAR;
            PG8_LDA(At, 1, 1); PG8_STAGE(PG8_SA(1, 0), a3, voffA);
            PG8_BAR; PG8_WAIT_L(0); PG8_MMA(1, 0, At, B0); PG8_BAR; PG8_SCHED;
            PG8_STAGE(PG8_SB(1, 1), b3 + hstep, voffB);
            PG8_WAIT_V(6); PG8_BAR; PG8_MMA(1, 1, At, B1); PG8_BAR;
        }
        if constexpr (FP8) asm volatile("s_nop 15\n\ts_nop 15" ::: "memory");
        E(acc, cur, wr, wc, fr, fq);
        if (!has_next) break;
#pragma unroll
        for (int a = 0; a < 2; ++a)
#pragma unroll
            for (int b = 0; b < 2; ++b)
#pragma unroll
                for (int m = 0; m < 4; ++m)
#pragma unroll
                    for (int n = 0; n < 2; ++n) acc[a][b][m][n] = (f32x4){0.f, 0.f, 0.f, 0.f};
        cur = nxt; cA = nA; cB = nB; ++ui;
    }
    PG8_WAIT_V(0);
    if (wr == 0) PG8_BAR;
    PG8_BAR;
#undef PG8_SA
#undef PG8_SB
#undef PG8_STAGE
#undef PG8_LDA
#undef PG8_LDB
#undef PG8_MMA
#undef PG8_LD8
#undef PG8_WAIT_V
#undef PG8_WAIT_L
#undef PG8_BAR
#undef PG8_SCHED
}

struct EpiQKV {
    static constexpr bool PERM = true;
    bf16_t *Q, *Kk, *V; const float *gq, *gk, *cosT, *sinT; float qscale, isc;
    __device__ __forceinline__ void operator()(const f32x4 (&acc)[2][2][4][2], const Unit& u, int wr, int wc, int fr, int fq) const {
        const int row0 = u.pm * BM + wr * 64 + fr;
        if (u.pn >= 8) {
            const int col0 = (u.pn - 8) * BM + wc * 32 + 8 * fq;
#pragma unroll
            for (int ai = 0; ai < 2; ++ai)
#pragma unroll
                for (int m = 0; m < 4; ++m) { bf16_t* rowp = V + (size_t)(row0 + ai * HALF + m * 16) * DM + col0;
#pragma unroll
                    for (int bj = 0; bj < 2; ++bj) { const f32x4 v0 = acc[ai][bj][m][0] * isc, v1 = acc[ai][bj][m][1] * isc;
                        u32x4 w; w.x = cvt_pk_bf16(v0[0], v0[1]); w.y = cvt_pk_bf16(v0[2], v0[3]); w.z = cvt_pk_bf16(v1[0], v1[1]); w.w = cvt_pk_bf16(v1[2], v1[3]);
                        *(u32x4*)(rowp + bj * HALF) = w; } }
        } else {
            const int part = u.pn >> 2, sh = 4 * (u.pn & 3) + wc;
            bf16_t* dst = part ? Kk : Q; const float* g = part ? gk : gq; const float sc = part ? 1.0f : qscale;
            f32x4 g0[2], g1[2];
#pragma unroll
            for (int n = 0; n < 2; ++n) { g0[n] = *(const f32x4*)(g + 8 * fq + 4 * n); g1[n] = *(const f32x4*)(g + 32 + 8 * fq + 4 * n); }
#pragma unroll
            for (int ai = 0; ai < 2; ++ai)
#pragma unroll
                for (int m = 0; m < 4; ++m) {
                    const int r = row0 + ai * HALF + m * 16; const int pos = r & (SEQ - 1);
                    f32x4 x1[2], x2[2]; float ss = 0.f;
#pragma unroll
                    for (int n = 0; n < 2; ++n) { x1[n] = acc[ai][0][m][n]; x2[n] = acc[ai][1][m][n];
                        ss += (x1[n][0] * x1[n][0] + x1[n][1] * x1[n][1]) + (x1[n][2] * x1[n][2] + x1[n][3] * x1[n][3]);
                        ss += (x2[n][0] * x2[n][0] + x2[n][1] * x2[n][1]) + (x2[n][2] * x2[n][2] + x2[n][3] * x2[n][3]); }
                    ss += __shfl_xor(ss, 16); ss += __shfl_xor(ss, 32);
                    const float rstd = __builtin_amdgcn_rsqf(ss * (isc * isc * (1.0f / 64.0f)) + EPS) * isc;
                    unsigned char* op = (unsigned char*)dst + (size_t)r * DM + sh * 64 + 8 * fq;
                    u32x2 w1, w2;
#pragma unroll
                    for (int n = 0; n < 2; ++n) {
                        const f32x4 cs = *(const f32x4*)(cosT + pos * 32 + 8 * fq + 4 * n), sn = *(const f32x4*)(sinT + pos * 32 + 8 * fq + 4 * n);
                        const f32x4 y1 = x1[n] * rstd * g0[n], y2 = x2[n] * rstd * g1[n];
                        const f32x4 o1 = (y1 * cs - y2 * sn) * sc, o2 = (y2 * cs + y1 * sn) * sc;
                        if (n == 0) { w1.x = pk_fp8x4(o1[0], o1[1], o1[2], o1[3]); w2.x = pk_fp8x4(o2[0], o2[1], o2[2], o2[3]); }
                        else { w1.y = pk_fp8x4(o1[0], o1[1], o1[2], o1[3]); w2.y = pk_fp8x4(o2[0], o2[1], o2[2], o2[3]); }
                    }
                    *(u32x2*)(op) = w1; *(u32x2*)(op + 32) = w2;
                }
        }
    }
};
__device__ __forceinline__ f32x4 ld_x4(const void* p, size_t i, bool is16) {
    if (is16) { const u32x2 w = *(const u32x2*)((const bf16_t*)p + i); return (f32x4){bflo(w.x), bfhi(w.x), bflo(w.y), bfhi(w.y)}; }
    return *(const f32x4*)((const float*)p + i);
}
template <bool IN16>
struct EpiRes {
    static constexpr bool PERM = false;
    const void* xin; bf16_t* xout; const float* gate; float sc;
    __device__ __forceinline__ void operator()(const f32x4 (&acc)[2][2][4][2], const Unit& u, int wr, int wc, int fr, int fq) const {
        const int row0 = u.pm * BM + wr * 64 + fr, col0 = u.pn * BM + wc * 32 + 4 * fq;
        const float* gp = gate + (size_t)(u.pm >> 5) * 6144 + col0;
        f32x4 gv[2][2];
#pragma unroll
        for (int bj = 0; bj < 2; ++bj)
#pragma unroll
            for (int n = 0; n < 2; ++n) gv[bj][n] = *(const f32x4*)(gp + bj * HALF + n * 16) * sc;
#pragma unroll
        for (int ai = 0; ai < 2; ++ai)
#pragma unroll
            for (int m = 0; m < 4; ++m) { const size_t off = (size_t)(row0 + ai * HALF + m * 16) * DM + col0;
                f32x4 xv[2][2];
#pragma unroll
                for (int bj = 0; bj < 2; ++bj)
#pragma unroll
                    for (int n = 0; n < 2; ++n) xv[bj][n] = ld_x4(xin, off + bj * HALF + n * 16, IN16);
#pragma unroll
                for (int bj = 0; bj < 2; ++bj)
#pragma unroll
                    for (int n = 0; n < 2; ++n) { const f32x4 o = xv[bj][n] + gv[bj][n] * acc[ai][bj][m][n];
                        *(u32x2*)(xout + off + bj * HALF + n * 16) = (u32x2){cvt_pk_bf16(o[0], o[1]), cvt_pk_bf16(o[2], o[3])}; }
                if (m == 3) asm volatile("" ::: "memory"); }
    }
};
struct EpiSwiGLU {
    static constexpr bool PERM = true;
    bf16_t* H; int ldh;
    __device__ __forceinline__ void operator()(const f32x4 (&acc)[2][2][4][2], const Unit& u, int wr, int wc, int fr, int fq) const {
        const int row0 = u.pm * BM + wr * 64 + fr, col0 = u.pn * HALF + wc * 32 + 8 * fq;
#pragma unroll
        for (int ai = 0; ai < 2; ++ai)
#pragma unroll
            for (int m = 0; m < 4; ++m) { bf16_t* rowp = H + (size_t)(row0 + ai * HALF + m * 16) * ldh + col0;
                f32x4 v[2];
#pragma unroll
                for (int n = 0; n < 2; ++n) { const f32x4 gt = acc[ai][0][m][n], up = acc[ai][1][m][n];
#pragma unroll
                    for (int j = 0; j < 4; ++j) v[n][j] = fsilu(gt[j]) * up[j]; }
                u32x4 w; w.x = cvt_pk_bf16(v[0][0], v[0][1]); w.y = cvt_pk_bf16(v[0][2], v[0][3]); w.z = cvt_pk_bf16(v[1][0], v[1][1]); w.w = cvt_pk_bf16(v[1][2], v[1][3]);
                *(u32x4*)rowp = w; }
    }
};
struct EpiSwiGLU8 {
    static constexpr bool PERM = true;
    unsigned char* H; int ldh; float ws, hs;
    __device__ __forceinline__ void operator()(const f32x4 (&acc)[2][2][4][2], const Unit& u, int wr, int wc, int fr, int fq) const {
        const int row0 = u.pm * BM + wr * 64 + fr, col0 = u.pn * HALF + wc * 32 + 8 * fq;
#pragma unroll
        for (int ai = 0; ai < 2; ++ai)
#pragma unroll
            for (int m = 0; m < 4; ++m) { unsigned char* rowp = H + (size_t)(row0 + ai * HALF + m * 16) * ldh + col0;
                f32x4 v[2];
#pragma unroll
                for (int n = 0; n < 2; ++n) { const f32x4 gt = acc[ai][0][m][n] * ws, up = acc[ai][1][m][n] * (ws * hs);
#pragma unroll
                    for (int j = 0; j < 4; ++j) v[n][j] = fsilu(gt[j]) * up[j]; }
                *(u32x2*)rowp = (u32x2){pk_fp8x4(v[0][0], v[0][1], v[0][2], v[0][3]), pk_fp8x4(v[1][0], v[1][1], v[1][2], v[1][3])}; }
    }
};
struct EpiPlain {
    static constexpr bool PERM = true;
    bf16_t* O; int ldc; float sc;
    __device__ __forceinline__ void operator()(const f32x4 (&acc)[2][2][4][2], const Unit& u, int wr, int wc, int fr, int fq) const {
        const int row0 = u.pm * BM + wr * 64 + fr, col0 = u.pn * BM + wc * 32 + 8 * fq;
#pragma unroll
        for (int ai = 0; ai < 2; ++ai)
#pragma unroll
            for (int m = 0; m < 4; ++m) { bf16_t* rowp = O + (size_t)(row0 + ai * HALF + m * 16) * ldc + col0;
#pragma unroll
                for (int bj = 0; bj < 2; ++bj) { const f32x4 v0 = acc[ai][bj][m][0] * sc, v1 = acc[ai][bj][m][1] * sc;
                    u32x4 w; w.x = cvt_pk_bf16(v0[0], v0[1]); w.y = cvt_pk_bf16(v0[2], v0[3]); w.z = cvt_pk_bf16(v1[0], v1[1]); w.w = cvt_pk_bf16(v1[2], v1[3]);
                    *(u32x4*)(rowp + bj * HALF) = w; } }
    }
};
struct EpiAct {
    static constexpr bool PERM = true;
    int kind; unsigned char* ws; const float* lb;
    __device__ __forceinline__ void operator()(const f32x4 (&acc)[2][2][4][2], const Unit& u, int wr, int wc, int fr, int fq) const {
        const int row0 = u.pm * BM + wr * 64 + fr;
        int mode, ldc, colt; size_t boff;
        if (kind == 0) { const int grp = u.pn >> 2; colt = (u.pn & 3) * 256; ldc = 1024;
            boff = grp == 0 ? H_Q : grp == 1 ? H_LFF : grp == 2 ? H_LFB : grp == 3 ? H_V : H_G; mode = (grp == 0 || grp == 4) ? 1 : (grp == 3 ? 0 : 3); }
        else { ldc = LRUW; if (u.pn < 5) { boff = L_YB; colt = u.pn * 256; mode = 2; } else { boff = L_XB; colt = (u.pn - 5) * 256; mode = 0; } }
        bf16_t* base = (bf16_t*)(ws + boff);
        const int col0 = colt + wc * 32 + 8 * fq;
        f32x4 lbv[2][2];
        if (mode == 3) { const float* lp = lb + ((u.pn >> 2) - 1) * 1024 + col0;
#pragma unroll
            for (int bj = 0; bj < 2; ++bj)
#pragma unroll
                for (int n = 0; n < 2; ++n) lbv[bj][n] = *(const f32x4*)(lp + bj * HALF + 4 * n); }
#pragma unroll
        for (int ai = 0; ai < 2; ++ai)
#pragma unroll
            for (int m = 0; m < 4; ++m) { bf16_t* rowp = base + (size_t)(row0 + ai * HALF + m * 16) * ldc + col0;
#pragma unroll
                for (int bj = 0; bj < 2; ++bj) { f32x4 v[2]; u32x4 w;
#pragma unroll
                    for (int n = 0; n < 2; ++n) { v[n] = acc[ai][bj][m][n];
                        if (mode == 1) {
#pragma unroll
                            for (int j = 0; j < 4; ++j) v[n][j] = fsilu(v[n][j]); }
                        else if (mode == 2) {
#pragma unroll
                            for (int j = 0; j < 4; ++j) { const float x = v[n][j]; v[n][j] = x * fsigmoid(1.5957691216057308f * (x + 0.044715f * x * x * x)); } }
                        else if (mode == 3) {
#pragma unroll
                            for (int j = 0; j < 4; ++j) { const float l = lbv[bj][n][j]; const float fg = l + (1.0f - l) * fsigmoid(v[n][j]); v[n][j] = __builtin_amdgcn_logf(fg) * 0.6931471805599453f; } }
                    }
                    if (mode == 3) {
#pragma unroll
                        for (int n = 0; n < 2; ++n) { const _Float16 h0 = (_Float16)v[n][0], h1 = (_Float16)v[n][1], h2 = (_Float16)v[n][2], h3 = (_Float16)v[n][3];
                            const unsigned a = (unsigned)__builtin_bit_cast(unsigned short, h0) | ((unsigned)__builtin_bit_cast(unsigned short, h1) << 16);
                            const unsigned b = (unsigned)__builtin_bit_cast(unsigned short, h2) | ((unsigned)__builtin_bit_cast(unsigned short, h3) << 16);
                            if (n == 0) { w.x = a; w.y = b; } else { w.z = a; w.w = b; } }
                    } else { w.x = cvt_pk_bf16(v[0][0], v[0][1]); w.y = cvt_pk_bf16(v[0][2], v[0][3]); w.z = cvt_pk_bf16(v[1][0], v[1][1]); w.w = cvt_pk_bf16(v[1][2], v[1][3]); }
                    *(u32x4*)(rowp + bj * HALF) = w; } }
    }
};
}

struct Args { const float* in[30]; float* out; unsigned char* ws; };
enum { I_X = 0, I_C, I_ADAW, I_ADAB, I_N1G, I_N2G, I_ATWIN, I_ATQN, I_ATKN, I_ATLAM, I_ATSUB, I_ATWOUT, I_HGWIN, I_HGLB, I_HGNG, I_HGWOUT,
       I_LRWIN, I_LRCW, I_LRCB, I_LRWA, I_LRBA, I_LRWX, I_LRBX, I_LRLAM, I_LRWOUT, I_FFGU, I_FFDN, I_MOER, I_MOEGU, I_MOEDN };
enum { SC_LAM0 = 0, SC_LAM1, SC_OML0, SC_OML1, SC_MC0, SC_MC1 };

__device__ __forceinline__ void cvt_item(const float* W, int ldw, int src_col0, bf16_t* WT, int ldt, int dst_row0, int k0, LAS float* scr, int lane) {
#pragma unroll 8
    for (int i = 0; i < 32; ++i) { const int kk = 2 * i + (lane >> 5); scr[kk * 33 + (lane & 31)] = W[(size_t)(k0 + kk) * ldw + src_col0 + (lane & 31)]; }
    LDS_WAIT(); asm volatile("" ::: "memory");
    const int c = lane & 7;
#pragma unroll
    for (int j = 0; j < 4; ++j) { const int n = (lane >> 3) + 8 * j; const LAS float* s = scr + (8 * c) * 33 + n;
        u32x4 o; o.x = cvt_pk_bf16(s[0 * 33], s[1 * 33]); o.y = cvt_pk_bf16(s[2 * 33], s[3 * 33]); o.z = cvt_pk_bf16(s[4 * 33], s[5 * 33]); o.w = cvt_pk_bf16(s[6 * 33], s[7 * 33]);
        *(u32x4*)(WT + (size_t)(dst_row0 + n) * ldt + k0 + 8 * c) = o; }
    LDS_WAIT(); asm volatile("" ::: "memory");
}
__device__ __forceinline__ void cvt_item8(const float* W, int ldw, int src_col0, unsigned char* WT, int ldt, int dst_row0, int k0, float sc, LAS float* scr, int lane) {
#pragma unroll 8
    for (int i = 0; i < 32; ++i) { const int kk = 2 * i + (lane >> 5); scr[kk * 33 + (lane & 31)] = W[(size_t)(k0 + kk) * ldw + src_col0 + (lane & 31)]; }
    LDS_WAIT(); asm volatile("" ::: "memory");
    const int c = lane & 7;
#pragma unroll
    for (int j = 0; j < 4; ++j) { const int n = (lane >> 3) + 8 * j; const LAS float* s = scr + (8 * c) * 33 + n;
        *(u32x2*)(WT + (size_t)(dst_row0 + n) * ldt + k0 + 8 * c) = (u32x2){pk_fp8x4(s[0 * 33] * sc, s[1 * 33] * sc, s[2 * 33] * sc, s[3 * 33] * sc), pk_fp8x4(s[4 * 33] * sc, s[5 * 33] * sc, s[6 * 33] * sc, s[7 * 33] * sc)}; }
    LDS_WAIT(); asm volatile("" ::: "memory");
}
enum { MAP_ID = 0, MAP_QKV = 1, MAP_SWI = 2 };
template <bool F8 = false>
__device__ __forceinline__ void cvt_family(const float* src, size_t sstride, int ninst, int ldw, int K, int ng, int map, int F, bf16_t* dst, size_t dstride,
                                           LAS float* scr, int gw, int NGW, int lane) {
    const int nkb = K / 64, per = nkb * ng, total = ninst * per;
    for (int it = gw; it < total; it += NGW) {
        const int inst = it / per, r = it - inst * per, kb = r / ng, gi = r - kb * ng;
        int sc0;
        if (map == MAP_ID) sc0 = 32 * gi;
        else if (map == MAP_QKV) { const int pn = gi >> 3, bj = (gi >> 2) & 1, wc = gi & 3;
            if (pn < 8) { const int part = pn >> 2, sh = 4 * (pn & 3) + wc; sc0 = part * 1024 + sh * 64 + 32 * bj; } else sc0 = 32 * gi; }
        else { const int pn = gi >> 3, bj = (gi >> 2) & 1, q = gi & 3; sc0 = bj * F + pn * 128 + 32 * q; }
        if constexpr (F8) cvt_item8(src + (size_t)inst * sstride, ldw, sc0, (unsigned char*)dst + (size_t)inst * dstride, K, 32 * gi, 64 * kb, MOE_WSCALE, scr, lane);
        else cvt_item(src + (size_t)inst * sstride, ldw, sc0, dst + (size_t)inst * dstride, K, 32 * gi, 64 * kb, scr, lane);
    }
}

__device__ __forceinline__ void prologue_phase(const Args& A, LAS unsigned char* lds, int bid, int G) {
    const int tid = threadIdx.x, lane = tid & 63, wave = tid >> 6;
    unsigned char* ws = A.ws;
    {
        LAS float* sc = (LAS float*)lds;
        LAS float* red = (LAS float*)(lds + 32768);
        for (int i = tid; i < NBATCH * DM; i += NTHR) { const float cv = A.in[I_C][i]; sc[i] = fsilu(cv); }
        __syncthreads();
        float* mods = (float*)(ws + TB_MODS);
        for (int cb = bid; cb < (DEPTH * 6144) / 128; cb += G) {
            const int col = cb * 128 + (tid & 127), l = col / 6144, e = col - l * 6144, ch = tid >> 7;
            const float* wp = A.in[I_ADAW] + (size_t)l * DM * 6144 + e;
            float a[NBATCH];
#pragma unroll
            for (int b = 0; b < NBATCH; ++b) a[b] = 0.f;
#pragma unroll 4
            for (int d = ch * 256; d < ch * 256 + 256; ++d) { const float w = wp[(size_t)d * 6144];
#pragma unroll
                for (int b = 0; b < NBATCH; ++b) a[b] += sc[b * DM + d] * w; }
#pragma unroll
            for (int b = 0; b < NBATCH; ++b) red[(ch * 128 + (tid & 127)) * 8 + b] = a[b];
            __syncthreads();
            if (tid < 128) { const float bias = A.in[I_ADAB][l * 6144 + e];
#pragma unroll
                for (int b = 0; b < NBATCH; ++b) { const float s = ((red[(0 * 128 + tid) * 8 + b] + red[(1 * 128 + tid) * 8 + b]) + (red[(2 * 128 + tid) * 8 + b] + red[(3 * 128 + tid) * 8 + b])) + bias;
                    mods[((size_t)l * NBATCH + b) * 6144 + e] = s; } }
            __syncthreads();
        }
    }
    {
        float* cosT = (float*)(ws + TB_COS); float* sinT = (float*)(ws + TB_SIN);
        for (int i = bid * NTHR + tid; i < SEQ * 32; i += G * NTHR) {
            const int pos = i >> 5, d = i & 31;
            const float inv = (float)exp(-(double)d * (1.0 / 32.0) * 9.210340371976184);
            const float ang = (float)pos * inv;
            const double rev = (double)ang * 0.15915494309189535; const float fr = (float)(rev - floor(rev));
            cosT[i] = __builtin_amdgcn_cosf(fr); sinT[i] = __builtin_amdgcn_sinf(fr);
        }
        if (bid == 0 && tid < 2) {
            const int a = tid; const float* lm = A.in[I_ATLAM] + a * 256;
            float s1 = 0.f, s2 = 0.f; for (int i = 0; i < 64; ++i) { s1 += lm[i] * lm[64 + i]; s2 += lm[128 + i] * lm[192 + i]; }
            const float linit = 0.8f - 0.6f * expf(-0.3f * (float)(3 * a));
            float mq = 0.f, mk = 0.f; for (int i = 0; i < 64; ++i) { mq = fmaxf(mq, fabsf(A.in[I_ATQN][a * 64 + i])); mk = fmaxf(mk, fabsf(A.in[I_ATKN][a * 64 + i])); }
            float* scal = (float*)(ws + TB_SCAL);
            scal[SC_LAM0 + a] = expf(s1) - expf(s2) + linit; scal[SC_OML0 + a] = 1.0f - linit; scal[SC_MC0 + a] = 8.0f * mq * mk * LOG2E * 1.0001f;
        }
        if (bid == 1) {
            float* lb = (float*)(ws + TB_LB);
            for (int i = tid; i < 2 * 1024; i += NTHR) { const int d = i >> 10, k = i & 1023; const float* p = A.in[I_HGLB] + (size_t)d * DEPTH * 1024 + k;
                float mx = p[0]; for (int l = 1; l < DEPTH; ++l) mx = fmaxf(mx, p[l * 1024]);
                float den = 0.f, num = 0.f; for (int l = 0; l < DEPTH; ++l) { const float e = expf(p[l * 1024] - mx); den += e; if (l == 1) num += e; }
                lb[i] = num / den; }
        }
        if (bid == 2) {
            float* sp = (float*)(ws + TB_SP);
            for (int i = tid; i < 2 * LRUW; i += NTHR) { const float x = -A.in[I_LRLAM][i]; sp[i] = (x > 20.f) ? x : log1pf(expf(x)); }
        }
    }
    {
        LAS float* scr = (LAS float*)(lds + wave * 16384);
        const int vcu = (bid % 8) * (G / 8) + bid / 8;
        const int gw = vcu * NWAVES + wave, NGW = G * NWAVES;
        cvt_family(A.in[I_ATWIN], (size_t)1024 * 3072, 1, 3072, 1024, 96, MAP_QKV, 0, (bf16_t*)(ws + W_QKV), (size_t)3072 * 1024, scr, gw, NGW, lane);
        cvt_family<true>(A.in[I_ATWIN] + (size_t)1024 * 3072, 0, 1, 3072, 1024, 96, MAP_QKV, 0, (bf16_t*)(ws + W_QKV) + (size_t)3072 * 1024, 0, scr, gw, NGW, lane);
        cvt_family(A.in[I_ATWOUT], (size_t)1024 * 1024, 1, 1024, 1024, 32, MAP_ID, 0, (bf16_t*)(ws + W_AO), (size_t)1024 * 1024, scr, gw, NGW, lane);
        cvt_family<true>(A.in[I_ATWOUT] + (size_t)1024 * 1024, 0, 1, 1024, 1024, 32, MAP_ID, 0, (bf16_t*)(ws + W_AO) + (size_t)1024 * 1024, 0, scr, gw, NGW, lane);
        cvt_family(A.in[I_HGWIN], 0, 1, 5120, 1024, 160, MAP_ID, 0, (bf16_t*)(ws + W_HGI), 0, scr, gw, NGW, lane);
        cvt_family(A.in[I_HGWOUT], 0, 1, 1024, 1024, 32, MAP_ID, 0, (bf16_t*)(ws + W_HGO), 0, scr, gw, NGW, lane);
        cvt_family(A.in[I_LRWIN], 0, 1, 2560, 1024, 80, MAP_ID, 0, (bf16_t*)(ws + W_LRI), 0, scr, gw, NGW, lane);
        cvt_family(A.in[I_LRWOUT], 0, 1, 1024, 1280, 32, MAP_ID, 0, (bf16_t*)(ws + W_LRO), 0, scr, gw, NGW, lane);
        for (int it = gw; it < 2 * 20 * 2 * 4; it += NGW) {
            const int part = it / 160, r = it % 160, inst = r >> 3, kb = (r >> 2) & 1, gi = r & 3, d = inst / 10, n = inst % 10;
            const float* src = (part ? A.in[I_LRWX] : A.in[I_LRWA]) + (size_t)inst * 16384;
            cvt_item(src, 128, 32 * gi, (bf16_t*)(ws + W_LRG) + (size_t)(n * 2 + d) * 256 * 128, 128, part * 128 + 32 * gi, 64 * kb, scr, lane);
        }
        static_assert(FP8_DENSE_FROM == 2 || FP8_DENSE_FROM > 3, "dense layer 0 stays bf16; layer 2 optional");
        constexpr int NB16 = (FP8_DENSE_FROM == 2) ? 1 : 2;
        cvt_family(A.in[I_FFGU], (size_t)1024 * 5632, NB16, 5632, 1024, 176, MAP_SWI, DFF, (bf16_t*)(ws + W_FGU), (size_t)5632 * 1024, scr, gw, NGW, lane);
        cvt_family(A.in[I_FFDN], (size_t)2816 * 1024, NB16, 1024, 2816, 32, MAP_ID, 0, (bf16_t*)(ws + W_FDN), (size_t)1024 * 2816, scr, gw, NGW, lane);
        if constexpr (NB16 == 1) {
            cvt_family<true>(A.in[I_FFGU] + (size_t)1024 * 5632, 0, 1, 5632, 1024, 176, MAP_SWI, DFF, (bf16_t*)(ws + W_FGU) + (size_t)5632 * 1024, 0, scr, gw, NGW, lane);
            cvt_family<true>(A.in[I_FFDN] + (size_t)2816 * 1024, 0, 1, 1024, 2816, 32, MAP_ID, 0, (bf16_t*)(ws + W_FDN) + (size_t)1024 * 2816, 0, scr, gw, NGW, lane);
        }
        cvt_family<true>(A.in[I_MOEGU], (size_t)1024 * 7168, 16, 7168, 1024, 224, MAP_SWI, DFFE, (bf16_t*)(ws + W_MGU), (size_t)7168 * 1024, scr, gw, NGW, lane);
        cvt_family<true>(A.in[I_MOEDN], (size_t)3584 * 1024, 16, 1024, 3584, 32, MAP_ID, 0, (bf16_t*)(ws + W_MDN), (size_t)1024 * 3584, scr, gw, NGW, lane);
    }
}

template <bool ROUTER>
__device__ __forceinline__ void norm_phase(const Args& A, LAS unsigned char* lds, int bid, int G, const void* xsrc, bool src16, void* xdst, bool dst16, const float* gain, const float* modl  , int which,
                                           bool combine, const float* modprev  , bool nonorm, const float* router, bool f8out = false) {
    int tid_ = threadIdx.x; asm volatile("" : "+v"(tid_));
    const int tid = tid_, lane = tid & 63, wave = tid >> 6;
    unsigned char* ws = A.ws;
    bf16_t* HM = (bf16_t*)(ws + WS_HM);
    const int* slot = (const int*)(ws + TB_SLOT); const float* gts = (const float*)(ws + TB_GATE);
    const bf16_t* Y = (const bf16_t*)(ws + E_XS);
    LAS int* hist = (LAS int*)lds;
    for (int tb = bid; tb < MTOK / 256; tb += G) {
        const int b = tb >> 5;
        f32x4 ga[4], sh[4], g2[4];
#pragma unroll
        for (int j = 0; j < 4; ++j) { const int c = 256 * j + 4 * lane;
            if (!nonorm) { const f32x4 gv = *(const f32x4*)(gain + c), sv = *(const f32x4*)(modl + (size_t)b * 6144 + (which * 3 + 1) * 1024 + c);
                ga[j] = gv * (sv + 1.0f); sh[j] = *(const f32x4*)(modl + (size_t)b * 6144 + (which * 3) * 1024 + c); }
            if (combine) g2[j] = *(const f32x4*)(modprev + (size_t)b * 6144 + 5 * 1024 + c); }
        f32x4 rw[ROUTER ? 32 : 1];
        if constexpr (ROUTER) {
            if (tid < 8) hist[tid] = 0;
#pragma unroll
            for (int j = 0; j < 4; ++j)
#pragma unroll
                for (int i = 0; i < 4; ++i) { const int c = 256 * j + 4 * lane + i; rw[(j * 4 + i) * 2] = *(const f32x4*)(router + c * 8); rw[(j * 4 + i) * 2 + 1] = *(const f32x4*)(router + c * 8 + 4); }
            __syncthreads();
        }
        for (int i = 0; i < 32; ++i) {
            const int row = tb * 256 + wave * 32 + i;
            f32x4 v[4];
#pragma unroll
            for (int j = 0; j < 4; ++j) v[j] = pg8::ld_x4(xsrc, (size_t)row * DM + 256 * j + 4 * lane, src16);
            if (combine) {
                const int s0 = slot[row * 2], s1 = slot[row * 2 + 1]; const float w0 = gts[row * 2], w1 = gts[row * 2 + 1];
#pragma unroll
                for (int j = 0; j < 4; ++j) { const u32x2 a = *(const u32x2*)(Y + (size_t)s0 * DM + 256 * j + 4 * lane), c2 = *(const u32x2*)(Y + (size_t)s1 * DM + 256 * j + 4 * lane);
                    f32x4 y; y[0] = w0 * bflo(a.x) + w1 * bflo(c2.x); y[1] = w0 * bfhi(a.x) + w1 * bfhi(c2.x); y[2] = w0 * bflo(a.y) + w1 * bflo(c2.y); y[3] = w0 * bfhi(a.y) + w1 * bfhi(c2.y);
                    v[j] = v[j] + g2[j] * y;
                    if (dst16) *(u32x2*)((bf16_t*)xdst + (size_t)row * DM + 256 * j + 4 * lane) = (u32x2){cvt_pk_bf16(v[j][0], v[j][1]), cvt_pk_bf16(v[j][2], v[j][3])};
                    else *(f32x4*)((float*)xdst + (size_t)row * DM + 256 * j + 4 * lane) = v[j]; }
            }
            if (nonorm) continue;
            float ss = 0.f;
#pragma unroll
            for (int j = 0; j < 4; ++j) ss += (v[j][0] * v[j][0] + v[j][1] * v[j][1]) + (v[j][2] * v[j][2] + v[j][3] * v[j][3]);
            ss = wave_sum(ss);
            const float rstd = 1.0f / sqrtf(ss * (1.0f / DM) + EPS);
            f32x4 h[4];
#pragma unroll
            for (int j = 0; j < 4; ++j) { h[j] = v[j] * rstd * ga[j] + sh[j];
                if (f8out) { *(unsigned*)((unsigned char*)HM + (size_t)row * DM + 256 * j + 4 * lane) = pk_fp8x4(h[j][0], h[j][1], h[j][2], h[j][3]); }
                else { u32x2 w; w.x = cvt_pk_bf16(h[j][0], h[j][1]); w.y = cvt_pk_bf16(h[j][2], h[j][3]);
                    *(u32x2*)(HM + (size_t)row * DM + 256 * j + 4 * lane) = w; } }
            if constexpr (ROUTER) {
                float lg[8];
#pragma unroll
                for (int e = 0; e < 8; ++e) lg[e] = 0.f;
#pragma unroll
                for (int j = 0; j < 4; ++j)
#pragma unroll
                    for (int q = 0; q < 4; ++q) { const float hv = h[j][q]; const f32x4 r0 = rw[(j * 4 + q) * 2], r1 = rw[(j * 4 + q) * 2 + 1];
                        lg[0] += hv * r0[0]; lg[1] += hv * r0[1]; lg[2] += hv * r0[2]; lg[3] += hv * r0[3]; lg[4] += hv * r1[0]; lg[5] += hv * r1[1]; lg[6] += hv * r1[2]; lg[7] += hv * r1[3]; }
#pragma unroll
                for (int e = 0; e < 8; ++e) lg[e] = wave_sum(lg[e]);
                int e0 = 0; float v0 = lg[0];
#pragma unroll
                for (int e = 1; e < 8; ++e) if (lg[e] > v0) { v0 = lg[e]; e0 = e; }
                int e1 = -1; float v1 = -3.0e38f;
#pragma unroll
                for (int e = 0; e < 8; ++e) if (e != e0 && lg[e] > v1) { v1 = lg[e]; e1 = e; }
                const float p1 = frcp(1.0f + fexp(v1 - v0));
                if (lane == 0) { int* eid = (int*)(ws + TB_EID); float* gt = (float*)(ws + TB_GATE);
                    eid[row * 2] = e0; eid[row * 2 + 1] = e1; gt[row * 2] = p1; gt[row * 2 + 1] = 1.0f - p1;
                    atomicAdd((int*)&hist[e0], 1); atomicAdd((int*)&hist[e1], 1); }
            }
        }
        if constexpr (ROUTER) {
            __syncthreads();
            if (tid < 8) ((int*)(ws + TB_BCNT))[tb * 8 + tid] = hist[tid];
            __syncthreads();
        }
    }
}

namespace lru {
constexpr int XCF = 0, XCB = 16384, AA = 24576, UU = 40960, LAA = 57344;
__device__ __forceinline__ int sw256(int row, int cb) { return row * 256 + (cb ^ ((row & 15) << 4)); }
__device__ __forceinline__ int crow(int r, int hi) { return (r & 3) + 8 * (r >> 2) + 4 * hi; }
template <int MODE>
__device__ __forceinline__ void lru_item(const Args& A, LAS unsigned char* lds, int b, int n, int seg, int dir) {
    int tid_ = threadIdx.x; asm volatile("" : "+v"(tid_));
    const int tid = tid_, wid = tid >> 6, lane = tid & 63, r = lane & 31, hh = lane >> 5;
    unsigned char* ws = A.ws;
    const bf16_t* XB = (const bf16_t*)(ws + L_XB); const bf16_t* YB = (const bf16_t*)(ws + L_YB); bf16_t* HF = (bf16_t*)(ws + L_HF); bf16_t* HY = (bf16_t*)(ws + L_HY);
    bf16_t* LAg = (bf16_t*)(ws + (dir ? L_HY : L_HF)); bf16_t* Ug = (bf16_t*)(ws + L_U + (size_t)dir * SZ_LRU);
    const int ct = tid >> 4, cg = tid & 15, cc0 = n * 128 + 8 * cg;
    float carry = 0.f, P = 1.f;
    if (MODE != 0 && tid < 128) carry = ((const float*)(ws + TB_LCIN))[(size_t)((b * 32 + seg) * 2 + dir) * LRUW + n * 128 + tid];
    if constexpr (MODE == 0) {
        const bf16_t* Wg = (const bf16_t*)(ws + W_LRG) + (size_t)((n * 2 + dir) * 256 + ((r < 16) ? (16 * wid + r) : (128 + 16 * wid + r - 16))) * 128 + 8 * hh;
        bf16x8 bfrag[8];
#pragma unroll
        for (int ks = 0; ks < 8; ++ks) bfrag[ks] = *(const bf16x8*)(Wg + 16 * ks);
        const int cch = n * 128 + 16 * wid + (r & 15);
        const float nba = -LOG2E * A.in[I_LRBA][dir * LRUW + cch], nbx = -LOG2E * A.in[I_LRBX][dir * LRUW + cch], csp = -8.0f * LOG2E * ((const float*)(ws + TB_SP))[dir * LRUW + cch];
        float cw[4][8], cb[8];
#pragma unroll
        for (int j = 0; j < 8; ++j) { cb[j] = A.in[I_LRCB][cc0 + j];
#pragma unroll
            for (int w = 0; w < 4; ++w) cw[w][j] = A.in[I_LRCW][w * LRUW + cc0 + j]; }
        u32x4 xr[4];
#define LRU_XLOAD(si_) do { const int sub_ = dir ? (7 - (si_)) : (si_); const int tok_ = seg * 256 + sub_ * 32 + ct; \
        _Pragma("unroll") for (int w = 0; w < 4; ++w) { const int tt = tok_ - 1 + w; xr[w] = (tt >= 0 && tt < SEQ) ? *(const u32x4*)(XB + ((size_t)b * SEQ + tt) * LRUW + cc0) : (u32x4){0u, 0u, 0u, 0u}; } } while (0)
        LRU_XLOAD(0);
        for (int si = 0; si < 8; ++si) {
            const int sub = dir ? (7 - si) : si; const int t0 = seg * 256 + sub * 32;
            {
                float xc[8];
#pragma unroll
                for (int j = 0; j < 8; ++j) xc[j] = cb[j];
#pragma unroll
                for (int w = 0; w < 4; ++w) { const u32x4 v = xr[w];
#pragma unroll
                    for (int e = 0; e < 4; ++e) { xc[2 * e] += cw[w][2 * e] * bflo(v[e]); xc[2 * e + 1] += cw[w][2 * e + 1] * bfhi(v[e]); } }
                if (si + 1 < 8) LRU_XLOAD(si + 1);
                *(LAS f32x4*)(lds + XCF + (ct * 128 + 8 * cg) * 4) = (f32x4){xc[0], xc[1], xc[2], xc[3]};
                *(LAS f32x4*)(lds + XCF + (ct * 128 + 8 * cg + 4) * 4) = (f32x4){xc[4], xc[5], xc[6], xc[7]};
                *(LAS u32x4*)(lds + XCB + sw256(ct, 16 * cg)) = (u32x4){cvt_pk_bf16(xc[0], xc[1]), cvt_pk_bf16(xc[2], xc[3]), cvt_pk_bf16(xc[4], xc[5]), cvt_pk_bf16(xc[6], xc[7])};
            }
            __syncthreads();
            {
                f32x16 acc = {};
#pragma unroll
                for (int ks = 0; ks < 8; ++ks) { const bf16x8 fa = *(const LAS bf16x8*)(lds + XCB + sw256(r, (16 * ks + 8 * hh) * 2)); acc = __builtin_amdgcn_mfma_f32_32x32x16_bf16(fa, bfrag[ks], acc, 0, 0, 0); }
#pragma unroll
                for (int q = 0; q < 8; ++q) {
                    const auto sw = __builtin_amdgcn_permlane16_swap(__float_as_uint(acc[q]), __float_as_uint(acc[8 + q]), false, false);
                    const float rp = __uint_as_float(sw[0]), ip = __uint_as_float(sw[1]);
                    const int tq = crow((r < 16) ? q : (8 + q), hh); const int cl = 16 * wid + (r & 15);
                    const float xcv = ((const LAS float*)(lds + XCF))[tq * 128 + cl];
                    const float rg = frcp(1.0f + fexp2(fmaf(rp, -LOG2E, nba))), ig = frcp(1.0f + fexp2(fmaf(ip, -LOG2E, nbx)));
                    const float la = csp * rg, av = fexp2(la), uv = __builtin_amdgcn_sqrtf(fmaxf(fmaf(-av, av, 1.0f), 0.f)) * ig * xcv;
                    ((LAS float*)(lds + AA))[tq * 128 + cl] = av; ((LAS float*)(lds + UU))[tq * 128 + cl] = uv; ((LAS float*)(lds + LAA))[tq * 128 + cl] = la; }
            }
            __syncthreads();
            if (tid < 128) {
                LAS float* ap = (LAS float*)(lds + AA) + tid; LAS float* up = (LAS float*)(lds + UU) + tid; float av[32], uv[32];
#pragma unroll
                for (int i = 0; i < 32; ++i) { av[i] = ap[i * 128]; uv[i] = up[i * 128]; }
                if (dir == 0) {
#pragma unroll
                    for (int i = 0; i < 32; ++i) { carry = av[i] * carry + uv[i]; P *= av[i]; } }
                else {
#pragma unroll
                    for (int i = 31; i >= 0; --i) { carry = av[i] * carry + uv[i]; P *= av[i]; } }
            } else if (tid >= 256) {
                const int t2 = tid - 256, row = t2 >> 3, c16 = (t2 & 7) * 16; const size_t go = ((size_t)b * SEQ + t0 + row) * LRUW + n * 128 + c16;
                const LAS float* lp = (const LAS float*)(lds + LAA) + row * 128 + c16; const LAS float* up = (const LAS float*)(lds + UU) + row * 128 + c16;
                f32x4 l[4], u[4];
#pragma unroll
                for (int j = 0; j < 4; ++j) { l[j] = *(const LAS f32x4*)(lp + 4 * j); u[j] = *(const LAS f32x4*)(up + 4 * j); }
#pragma unroll
                for (int j = 0; j < 2; ++j) {
                    *(u32x4*)(LAg + go + 8 * j) = (u32x4){cvt_pk_bf16(l[2 * j][0], l[2 * j][1]), cvt_pk_bf16(l[2 * j][2], l[2 * j][3]), cvt_pk_bf16(l[2 * j + 1][0], l[2 * j + 1][1]), cvt_pk_bf16(l[2 * j + 1][2], l[2 * j + 1][3])};
                    *(u32x4*)(Ug + go + 8 * j) = (u32x4){cvt_pk_bf16(u[2 * j][0], u[2 * j][1]), cvt_pk_bf16(u[2 * j][2], u[2 * j][3]), cvt_pk_bf16(u[2 * j + 1][0], u[2 * j + 1][1]), cvt_pk_bf16(u[2 * j + 1][2], u[2 * j + 1][3])}; }
            }
            __syncthreads();
        }
#undef LRU_XLOAD
        if (tid < 128) { float* sm = (float*)(ws + TB_LSUM) + (size_t)(((b * 32 + seg) * 2 + dir) * 2) * LRUW + n * 128 + tid; sm[0] = P; sm[LRUW] = carry; }
    } else {
        u32x4 lr, ur;
#define LRU_GLOAD(si_) do { const int sub_ = dir ? (7 - (si_)) : (si_); const size_t go_ = ((size_t)b * SEQ + seg * 256 + sub_ * 32 + ct) * LRUW + cc0; \
        lr = *(const u32x4*)(LAg + go_); ur = *(const u32x4*)(Ug + go_); } while (0)
        LRU_GLOAD(0);
        for (int si = 0; si < 8; ++si) {
            const int sub = dir ? (7 - si) : si; const int t0 = seg * 256 + sub * 32;
            {   const u32x4 l = lr, u = ur;
                if (si + 1 < 8) LRU_GLOAD(si + 1);
                *(LAS f32x4*)(lds + AA + (ct * 128 + 8 * cg) * 4) = (f32x4){fexp2(bflo(l[0])), fexp2(bfhi(l[0])), fexp2(bflo(l[1])), fexp2(bfhi(l[1]))};
                *(LAS f32x4*)(lds + AA + (ct * 128 + 8 * cg + 4) * 4) = (f32x4){fexp2(bflo(l[2])), fexp2(bfhi(l[2])), fexp2(bflo(l[3])), fexp2(bfhi(l[3]))};
                *(LAS f32x4*)(lds + UU + (ct * 128 + 8 * cg) * 4) = (f32x4){bflo(u[0]), bfhi(u[0]), bflo(u[1]), bfhi(u[1])};
                *(LAS f32x4*)(lds + UU + (ct * 128 + 8 * cg + 4) * 4) = (f32x4){bflo(u[2]), bfhi(u[2]), bflo(u[3]), bfhi(u[3])}; }
            __syncthreads();
            if (tid < 128) {
                LAS float* ap = (LAS float*)(lds + AA) + tid; LAS float* up = (LAS float*)(lds + UU) + tid; float av[32], uv[32];
#pragma unroll
                for (int i = 0; i < 32; ++i) { av[i] = ap[i * 128]; uv[i] = up[i * 128]; }
                if (dir == 0) {
#pragma unroll
                    for (int i = 0; i < 32; ++i) { carry = av[i] * carry + uv[i]; uv[i] = carry; } }
                else {
#pragma unroll
                    for (int i = 31; i >= 0; --i) { carry = av[i] * carry + uv[i]; uv[i] = carry; } }
#pragma unroll
                for (int i = 0; i < 32; ++i) up[i * 128] = uv[i];
            }
            __syncthreads();
            {   const int tok = t0 + ct; const size_t go = ((size_t)b * SEQ + tok) * LRUW + cc0;
                const f32x4 h0 = *(const LAS f32x4*)(lds + UU + (ct * 128 + 8 * cg) * 4), h1 = *(const LAS f32x4*)(lds + UU + (ct * 128 + 8 * cg + 4) * 4);
                if (MODE == 1) { *(u32x4*)(HF + go) = (u32x4){cvt_pk_bf16(h0[0], h0[1]), cvt_pk_bf16(h0[2], h0[3]), cvt_pk_bf16(h1[0], h1[1]), cvt_pk_bf16(h1[2], h1[3])}; }
                else { const u32x4 f = *(const u32x4*)(HF + go), y = *(const u32x4*)(YB + go);
                    *(u32x4*)(HY + go) = (u32x4){cvt_pk_bf16((h0[0] + bflo(f[0])) * bflo(y[0]), (h0[1] + bfhi(f[0])) * bfhi(y[0])), cvt_pk_bf16((h0[2] + bflo(f[1])) * bflo(y[1]), (h0[3] + bfhi(f[1])) * bfhi(y[1])),
                                                cvt_pk_bf16((h1[0] + bflo(f[2])) * bflo(y[2]), (h1[1] + bfhi(f[2])) * bfhi(y[2])), cvt_pk_bf16((h1[2] + bflo(f[3])) * bflo(y[3]), (h1[3] + bfhi(f[3])) * bfhi(y[3]))}; }
            }
            __syncthreads();
        }
#undef LRU_GLOAD
    }
}
__device__ __forceinline__ void lru_apply_item(const Args& A, LAS unsigned char* lds, int b, int n, int seg) {
    constexpr int HFL = 57344;
    int tid_ = threadIdx.x; asm volatile("" : "+v"(tid_));
    const int tid = tid_;
    unsigned char* ws = A.ws;
    const bf16_t* YB = (const bf16_t*)(ws + L_YB); bf16_t* HY = (bf16_t*)(ws + L_HY);
    const int ct = tid >> 4, cg = tid & 15, cc0 = n * 128 + 8 * cg;
#pragma unroll 1
    for (int dir = 0; dir < 2; ++dir) {
        const bf16_t* LAg = (const bf16_t*)(ws + (dir ? L_HY : L_HF)); const bf16_t* Ug = (const bf16_t*)(ws + L_U + (size_t)dir * SZ_LRU);
        float carry = 0.f;
        if (tid < 128) carry = ((const float*)(ws + TB_LCIN))[(size_t)((b * 32 + seg) * 2 + dir) * LRUW + n * 128 + tid];
        u32x4 lr, ur, yr = {0u, 0u, 0u, 0u};
#define LRU_GLOAD(si_) do { const int sub_ = dir ? (7 - (si_)) : (si_); const size_t go_ = ((size_t)b * SEQ + seg * 256 + sub_ * 32 + ct) * LRUW + cc0; \
        lr = *(const u32x4*)(LAg + go_); ur = *(const u32x4*)(Ug + go_); if (dir) yr = *(const u32x4*)(YB + go_); } while (0)
        LRU_GLOAD(0);
        for (int si = 0; si < 8; ++si) {
            const int sub = dir ? (7 - si) : si; const int t0 = seg * 256 + sub * 32;
            const u32x4 l = lr, u = ur, y = yr;
            if (si + 1 < 8) LRU_GLOAD(si + 1);
            *(LAS f32x4*)(lds + AA + (ct * 128 + 8 * cg) * 4) = (f32x4){fexp2(bflo(l[0])), fexp2(bfhi(l[0])), fexp2(bflo(l[1])), fexp2(bfhi(l[1]))};
            *(LAS f32x4*)(lds + AA + (ct * 128 + 8 * cg + 4) * 4) = (f32x4){fexp2(bflo(l[2])), fexp2(bfhi(l[2])), fexp2(bflo(l[3])), fexp2(bfhi(l[3]))};
            *(LAS f32x4*)(lds + UU + (ct * 128 + 8 * cg) * 4) = (f32x4){bflo(u[0]), bfhi(u[0]), bflo(u[1]), bfhi(u[1])};
            *(LAS f32x4*)(lds + UU + (ct * 128 + 8 * cg + 4) * 4) = (f32x4){bflo(u[2]), bfhi(u[2]), bflo(u[3]), bfhi(u[3])};
            __syncthreads();
            if (tid < 128) {
                LAS float* ap = (LAS float*)(lds + AA) + tid; LAS float* up = (LAS float*)(lds + UU) + tid; float av[32], uv[32];
#pragma unroll
                for (int i = 0; i < 32; ++i) { av[i] = ap[i * 128]; uv[i] = up[i * 128]; }
                if (dir == 0) {
#pragma unroll
                    for (int i = 0; i < 32; ++i) { carry = av[i] * carry + uv[i]; uv[i] = carry; } }
                else {
#pragma unroll
                    for (int i = 31; i >= 0; --i) { carry = av[i] * carry + uv[i]; uv[i] = carry; } }
#pragma unroll
                for (int i = 0; i < 32; ++i) up[i * 128] = uv[i];
            }
            __syncthreads();
            {   const f32x4 h0 = *(const LAS f32x4*)(lds + UU + (ct * 128 + 8 * cg) * 4), h1 = *(const LAS f32x4*)(lds + UU + (ct * 128 + 8 * cg + 4) * 4);
                LAS u32x4* hf = (LAS u32x4*)(lds + HFL + ((sub * 32 + ct) * 128 + 8 * cg) * 2);
                if (dir == 0) *hf = (u32x4){cvt_pk_bf16(h0[0], h0[1]), cvt_pk_bf16(h0[2], h0[3]), cvt_pk_bf16(h1[0], h1[1]), cvt_pk_bf16(h1[2], h1[3])};
                else { const u32x4 f = *hf; const size_t go = ((size_t)b * SEQ + t0 + ct) * LRUW + cc0;
                    *(u32x4*)(HY + go) = (u32x4){cvt_pk_bf16((h0[0] + bflo(f[0])) * bflo(y[0]), (h0[1] + bfhi(f[0])) * bfhi(y[0])), cvt_pk_bf16((h0[2] + bflo(f[1])) * bflo(y[1]), (h0[3] + bfhi(f[1])) * bfhi(y[1])),
                                                cvt_pk_bf16((h1[0] + bflo(f[2])) * bflo(y[2]), (h1[1] + bfhi(f[2])) * bfhi(y[2])), cvt_pk_bf16((h1[2] + bflo(f[3])) * bflo(y[3]), (h1[3] + bfhi(f[3])) * bfhi(y[3]))}; }
            }
            __syncthreads();
        }
#undef LRU_GLOAD
    }
}
}
__device__ __forceinline__ void lru_apply_phase(const Args& A, LAS unsigned char* lds, int bid, int G) {
    for (int it = bid; it < 2560; it += G) lru::lru_apply_item(A, lds, it / 320, (it >> 5) % 10, it & 31);
}
template <int MODE>
__device__ __forceinline__ void lru_phase(const Args& A, LAS unsigned char* lds, int bid, int G) {
    const int nitems = (MODE == 0) ? 5120 : 2560;
    for (int it = bid; it < nitems; it += G) {
        int b, n, seg, dir;
        if (MODE == 0) { dir = it & 1; const int r = it >> 1; seg = r & 31; n = (r >> 5) % 10; b = r / 320; }
        else { dir = MODE - 1; seg = it & 31; n = (it >> 5) % 10; b = it / 320; }
        lru::lru_item<MODE>(A, lds, b, n, seg, dir);
    }
}
__device__ __forceinline__ void lru_carry_phase(const Args& A, int bid, int G) {
    const float* sm = (const float*)(A.ws + TB_LSUM); float* cin = (float*)(A.ws + TB_LCIN);
    for (int idx = bid * NTHR + threadIdx.x; idx < NBATCH * 2 * LRUW; idx += G * NTHR) {
        const int b = idx / (2 * LRUW), r = idx % (2 * LRUW), dir = r / LRUW, ch = r % LRUW; float carry = 0.f;
        for (int i = 0; i < 32; ++i) { const int sg = dir ? (31 - i) : i; const size_t o = (size_t)((b * 32 + sg) * 2 + dir);
            cin[o * LRUW + ch] = carry; carry = sm[o * 2 * LRUW + ch] * carry + sm[o * 2 * LRUW + LRUW + ch]; }
    }
}

__device__ __forceinline__ void place_phase(const Args& A, LAS unsigned char* lds, int bid, int G) {
    int tid_ = threadIdx.x; asm volatile("" : "+v"(tid_));
    const int tid = tid_, lane = tid & 63, wave = tid >> 6; unsigned char* ws = A.ws;
    const int* bcnt = (const int*)(ws + TB_BCNT); const int* eid = (const int*)(ws + TB_EID); int* slot = (int*)(ws + TB_SLOT);
    const bf16_t* HM = (const bf16_t*)(ws + WS_HM); bf16_t* XS = (bf16_t*)(ws + E_XS);
    LAS int* tot = (LAS int*)lds; LAS int* pre = tot + 8; LAS int* rb = tot + 16; LAS int* wcn = tot + 32; LAS int* sl = tot + 64;
    for (int tb = bid; tb < MTOK / 256; tb += G) {
        { int t_ = 0, p_ = 0;
#pragma unroll
            for (int j = 0; j < 4; ++j) { const int blk = lane + 64 * j; const int v = bcnt[blk * 8 + wave]; t_ += v; p_ += (blk < tb) ? v : 0; }
#pragma unroll
            for (int o = 1; o < 64; o <<= 1) { t_ += __shfl_xor(t_, o); p_ += __shfl_xor(p_, o); }
            if (lane == 0) { tot[wave] = t_; pre[wave] = p_; } }
        __syncthreads();
        if (tid == 0) { int acc = 0; for (int e = 0; e < 8; ++e) { rb[e] = acc * 256; if (tb == 0) ((int*)(ws + TB_TILES))[e] = acc; acc += (tot[e] + 255) >> 8; } if (tb == 0) ((int*)(ws + TB_TILES))[8] = acc; }
        int e0 = -1, e1 = -1; unsigned long long mk0 = 0, mk1 = 0;
        if (tid < 256) { e0 = eid[(tb * 256 + tid) * 2]; e1 = eid[(tb * 256 + tid) * 2 + 1];
#pragma unroll
            for (int e = 0; e < 8; ++e) { const unsigned long long m = __ballot(e0 == e || e1 == e); if (lane == 0) wcn[wave * 8 + e] = __popcll(m); if (e0 == e) mk0 = m; if (e1 == e) mk1 = m; } }
        __syncthreads();
        if (tid < 256) { const unsigned long long lt = (1ull << lane) - 1ull; int b0 = rb[e0] + pre[e0] + __popcll(mk0 & lt), b1 = rb[e1] + pre[e1] + __popcll(mk1 & lt);
            for (int w = 0; w < wave; ++w) { b0 += wcn[w * 8 + e0]; b1 += wcn[w * 8 + e1]; }
            sl[tid * 2] = b0; sl[tid * 2 + 1] = b1; slot[(tb * 256 + tid) * 2] = b0; slot[(tb * 256 + tid) * 2 + 1] = b1; }
        __syncthreads();
        for (int i = 0; i < 32; ++i) { const int t = wave * 32 + i; const int s0 = sl[t * 2], s1 = sl[t * 2 + 1];
            const u32x4 q = *(const u32x4*)((const unsigned char*)HM + (size_t)(tb * 256 + t) * DM + lane * 16);
            *(u32x4*)((unsigned char*)XS + (size_t)s0 * DM + lane * 16) = q; *(u32x4*)((unsigned char*)XS + (size_t)s1 * DM + lane * 16) = q; }
        __syncthreads();
    }
}

namespace att {
constexpr int KVBLK = 64;
#define SBAR() __builtin_amdgcn_sched_barrier(0)
typedef int v8i __attribute__((ext_vector_type(8)));
__device__ __forceinline__ int crow(int r, int hi) { return (r & 3) + 8 * (r >> 2) + 4 * hi; }
constexpr int SLOTB = 8192;
__device__ __forceinline__ int k_slot(int s) { return s * SLOTB; }
__device__ __forceinline__ int v_slot(int s) { return 65536 + s * SLOTB; }
__device__ __forceinline__ int kswz(int row) { return ((row & 7) ^ (row >> 4)) & 7; }
__device__ __forceinline__ int vswz(int row) { return (row >> 2) & 3; }
__device__ __forceinline__ void mfma8_acc(f32x16& acc, const v8i& a, const v8i& b, int sc) {
    asm volatile("s_nop 4\n\tv_mfma_scale_f32_32x32x64_f8f6f4 %0, %1, %2, %0, %3, %3 op_sel_hi:[0,0,0]" : "+v"(acc) : "v"(a), "v"(b), "v"(sc) : "memory");
}
__device__ __forceinline__ void mfma8_c(f32x16& d, const v8i& a, const v8i& b, const f32x16& c, int sa, int sb) {
    asm volatile("v_mfma_scale_f32_32x32x64_f8f6f4 %0, %1, %2, %3, %4, %5 op_sel_hi:[0,0,0]" : "=&v"(d) : "v"(a), "v"(b), "v"(c), "v"(sa), "v"(sb) : "memory");
}
#define ATT_LD8(p0_, p1_) __builtin_bit_cast(v8i, __builtin_shufflevector(*(const LAS u32x4*)(p0_), *(const LAS u32x4*)(p1_), 0, 1, 2, 3, 4, 5, 6, 7))
__device__ __forceinline__ void qkt(f32x16& p0, f32x16& p1, const LAS char* Ks, const v8i& qr, int r32, int hi, int jj, const f32x16& cinit, int s1, int s8) {
    const int c0 = jj * 4 + 2 * hi;
    { const int row = r32; const v8i kf = ATT_LD8(Ks + row * 128 + ((c0 ^ kswz(row)) << 4), Ks + row * 128 + (((c0 + 1) ^ kswz(row)) << 4)); mfma8_c(p0, kf, qr, cinit, s1, s8); }
    { const int row = 32 + r32; const v8i kf = ATT_LD8(Ks + row * 128 + ((c0 ^ kswz(row)) << 4), Ks + row * 128 + (((c0 + 1) ^ kswz(row)) << 4)); mfma8_c(p1, kf, qr, cinit, s1, s8); }
}
__device__ __forceinline__ void load_kf(v8i& kf0, v8i& kf1, const LAS char* Ks, int r32, int hi, int jj) {
    const int c0 = jj * 4 + 2 * hi, row1 = 32 + r32;
    kf0 = ATT_LD8(Ks + r32 * 128 + ((c0 ^ kswz(r32)) << 4), Ks + r32 * 128 + (((c0 + 1) ^ kswz(r32)) << 4));
    kf1 = ATT_LD8(Ks + row1 * 128 + ((c0 ^ kswz(row1)) << 4), Ks + row1 * 128 + (((c0 + 1) ^ kswz(row1)) << 4));
}
#define ATT_VFR(Vs, d0) ATT_LD8((Vs) + (32 * (d0) + r32) * 64 + (((2 * hi) ^ vswz(32 * (d0) + r32)) << 4), (Vs) + (32 * (d0) + r32) * 64 + (((2 * hi + 1) ^ vswz(32 * (d0) + r32)) << 4))
__device__ __forceinline__ void pack_p(const float (&pe)[32], v8i& pa);
__device__ __forceinline__ void qkt_pack(f32x16& p0, f32x16& p1, const v8i& kf0, const v8i& kf1, const v8i& qr, const f32x16& cinit, int s1, int s8, const float (&pe)[32], v8i& pa) {
#define ATT_MC8(d, kf, B, O0, O1, O2, O3) \
    asm volatile("v_mfma_scale_f32_32x32x64_f8f6f4 %0, %21, %22, %23, %24, %25 op_sel_hi:[0,0,0]\n\t" \
                 "v_cvt_pk_fp8_f32 %1, %5, %6\n\tv_cvt_pk_fp8_f32 %1, %7, %8 op_sel:[0,0,1]\n\t" \
                 "v_cvt_pk_fp8_f32 %2, %9, %10\n\tv_cvt_pk_fp8_f32 %2, %11, %12 op_sel:[0,0,1]\n\t" \
                 "v_cvt_pk_fp8_f32 %3, %13, %14\n\tv_cvt_pk_fp8_f32 %3, %15, %16 op_sel:[0,0,1]\n\t" \
                 "v_cvt_pk_fp8_f32 %4, %17, %18\n\tv_cvt_pk_fp8_f32 %4, %19, %20 op_sel:[0,0,1]" \
                 : "=&v"(d), "=&v"(O0), "=&v"(O1), "=&v"(O2), "=&v"(O3) \
                 : "v"(pe[B]), "v"(pe[B + 1]), "v"(pe[B + 2]), "v"(pe[B + 3]), "v"(pe[B + 4]), "v"(pe[B + 5]), "v"(pe[B + 6]), "v"(pe[B + 7]), \
                   "v"(pe[B + 8]), "v"(pe[B + 9]), "v"(pe[B + 10]), "v"(pe[B + 11]), "v"(pe[B + 12]), "v"(pe[B + 13]), "v"(pe[B + 14]), "v"(pe[B + 15]), \
                   "v"(kf), "v"(qr), "v"(cinit), "v"(s1), "v"(s8) : "memory")
    int q0, q1, q2, q3, q4, q5, q6, q7;
    ATT_MC8(p0, kf0, 0, q0, q1, q2, q3);
    ATT_MC8(p1, kf1, 16, q4, q5, q6, q7);
#undef ATT_MC8
    pa = (v8i){q0, q1, q2, q3, q4, q5, q6, q7};
}
__device__ __forceinline__ void partialSM(f32x16& p0) {
#pragma unroll
    for (int r = 0; r < 16; ++r) p0[r] = fexp2(p0[r]);
}
__device__ __forceinline__ void finishSM(f32x16& p0, f32x16& p1, v8i& pa) {
#pragma unroll
    for (int r = 0; r < 16; ++r) p1[r] = fexp2(p1[r]);
#pragma unroll
    for (int w = 0; w < 4; ++w) { pa[w] = (int)pk_fp8x4(p0[4 * w], p0[4 * w + 1], p0[4 * w + 2], p0[4 * w + 3]); pa[4 + w] = (int)pk_fp8x4(p1[4 * w], p1[4 * w + 1], p1[4 * w + 2], p1[4 * w + 3]); }
}
#define ATT_MX7(acc, a, b, sc, NOP, O, I, k) \
    asm volatile(NOP "v_mfma_scale_f32_32x32x64_f8f6f4 %0, %15, %16, %0, %17, %17 op_sel_hi:[0,0,0]\n\tv_exp_f32 %1, %8\n\tv_exp_f32 %2, %9\n\tv_exp_f32 %3, %10\n\tv_exp_f32 %4, %11\n\tv_exp_f32 %5, %12\n\tv_exp_f32 %6, %13\n\tv_exp_f32 %7, %14" \
                 : "+v"(acc), "=&v"(O[k]), "=&v"(O[k + 1]), "=&v"(O[k + 2]), "=&v"(O[k + 3]), "=&v"(O[k + 4]), "=&v"(O[k + 5]), "=&v"(O[k + 6]) \
                 : "v"(I(k)), "v"(I(k + 1)), "v"(I(k + 2)), "v"(I(k + 3)), "v"(I(k + 4)), "v"(I(k + 5)), "v"(I(k + 6)), "v"(a), "v"(b), "v"(sc) : "memory")
__device__ __forceinline__ void pv_exp_a(f32x16* o, const v8i& vf0, const v8i& vf1, const v8i& vf2, const v8i& pa, int s1, const f32x16& r0, const f32x16& r1, float (&pe)[32]) {
#define ATT_RI(k) (((k) < 16) ? r0[(k) & 15] : r1[(k) & 15])
    ATT_MX7(o[0], pa, vf0, s1, "s_nop 4\n\t", pe, ATT_RI, 0);
    ATT_MX7(o[1], pa, vf1, s1, "", pe, ATT_RI, 7);
    ATT_MX7(o[2], pa, vf2, s1, "", pe, ATT_RI, 14);
#undef ATT_RI
}
__device__ __forceinline__ void pv_exp_b(f32x16* o, f32x16& lacc, const v8i& ones, const v8i& vf3, const v8i& pa, int s1, const f32x16& r0, const f32x16& r1, float (&pe)[32]) {
#define ATT_RI(k) (((k) < 16) ? r0[(k) & 15] : r1[(k) & 15])
    ATT_MX7(o[3], pa, vf3, s1, "", pe, ATT_RI, 21);
    asm volatile("v_mfma_scale_f32_32x32x64_f8f6f4 %0, %9, %10, %0, %11, %11 op_sel_hi:[0,0,0]\n\tv_exp_f32 %1, %5\n\tv_exp_f32 %2, %6\n\tv_exp_f32 %3, %7\n\tv_exp_f32 %4, %8"
                 : "+v"(lacc), "=&v"(pe[28]), "=&v"(pe[29]), "=&v"(pe[30]), "=&v"(pe[31]) : "v"(r1[12]), "v"(r1[13]), "v"(r1[14]), "v"(r1[15]), "v"(pa), "v"(ones), "v"(s1) : "memory");
#undef ATT_RI
}
__device__ __forceinline__ void pack_p(const float (&pe)[32], v8i& pa) {
#pragma unroll
    for (int w = 0; w < 8; ++w) pa[w] = (int)pk_fp8x4(pe[4 * w], pe[4 * w + 1], pe[4 * w + 2], pe[4 * w + 3]);
}
__device__ __forceinline__ void pv_d0(f32x16* o, f32x16& lacc, const v8i& ones, const LAS char* Vs, const v8i& pa, int r32, int hi, int s1) {
#pragma unroll
    for (int d0 = 0; d0 < 4; ++d0) { const int row = 32 * d0 + r32;
        const v8i vf = ATT_LD8(Vs + row * 64 + (((2 * hi) ^ vswz(row)) << 4), Vs + row * 64 + (((2 * hi + 1) ^ vswz(row)) << 4));
        mfma8_acc(o[d0], pa, vf, s1); }
    mfma8_acc(lacc, pa, ones, s1);
}
__device__ __forceinline__ void pv_last(f32x16* o, f32x16& lacc, const v8i& ones, const v8i& vf0, const v8i& vf1, const v8i& vf2, const v8i& vf3, const v8i& pa, int s1) {
    mfma8_acc(o[0], pa, vf0, s1); mfma8_acc(o[1], pa, vf1, s1); mfma8_acc(o[2], pa, vf2, s1); mfma8_acc(o[3], pa, vf3, s1); mfma8_acc(lacc, pa, ones, s1);
}
}

__device__ __forceinline__ void vt_phase(const Args& A, int bid, int G) {
    const int tid = threadIdx.x; unsigned char* ws = A.ws;
    const bf16_t* V = (const bf16_t*)(ws + A_V); unsigned char* VT = ws + A_VT;
    const int dv = tid & 127, kq = tid >> 7, half = kq >> 1, hi = kq & 1;
    for (int it = bid; it < 64 * 128; it += G) {
        const int bh = it >> 7, tile = it & 127, b = bh >> 3, h = bh & 7;
        const bf16_t* vp = V + ((size_t)b * SEQ + tile * 64 + 32 * half) * DM + h * 128 + dv;
        float f[16];
#pragma unroll
        for (int i = 0; i < 16; ++i) f[i] = bf2f(vp[(size_t)att::crow(i, hi) * DM]);
        *(u32x4*)(VT + (((size_t)bh * 128 + tile) * 128 + dv) * 64 + hi * 32 + half * 16) =
            (u32x4){pk_fp8x4(f[0], f[1], f[2], f[3]), pk_fp8x4(f[4], f[5], f[6], f[7]), pk_fp8x4(f[8], f[9], f[10], f[11]), pk_fp8x4(f[12], f[13], f[14], f[15])};
    }
}

__device__ __forceinline__ void attn_phase(const Args& A, LAS unsigned char* ldsu, int bid, int G, int al) {
    using namespace att;
    LAS char* lds = (LAS char*)ldsu;
    unsigned char* ws = A.ws;
    const unsigned char* Qg = ws + A_Q; const unsigned char* Kg = ws + A_K; const unsigned char* VTg = ws + A_VT;
    bf16_t* Og = (bf16_t*)(ws + WS_HM);
    const float* scal = (const float*)(ws + TB_SCAL);
    const float lamv = scal[SC_LAM0 + al], omli = scal[SC_OML0 + al], Mc = scal[SC_MC0 + al] - 7.5f;
    const float* subg = A.in[I_ATSUB] + al * 128;
    int tid_ = threadIdx.x; asm volatile("" : "+v"(tid_));
    const int tid = tid_, wid = __builtin_amdgcn_readfirstlane(tid >> 6), lane = tid & 63, r32 = lane & 31, hi = lane >> 5, jj = wid >> 2, wq = wid & 3;
    constexpr int NT = SEQ / KVBLK;
    int s1 = 0x7f7f7f7f, s8 = 0x7c7c7c7c; asm volatile("" : "+v"(s1), "+v"(s8));
    v8i ones; { int o1 = 0x38383838; asm volatile("" : "+v"(o1)); ones = (v8i){o1, o1, o1, o1, o1, o1, o1, o1}; }
    f32x16 cinit;
#pragma unroll
    for (int r = 0; r < 16; ++r) cinit[r] = -Mc;
    unsigned koff, voff;
    { const int bb = wid * 1024 + lane * 16;
      { const int row = bb >> 7, c = ((bb & 127) >> 4) ^ kswz(row); koff = (unsigned)(row * 1024 + c * 16); }
      { const int row = bb >> 6, c = ((bb & 63) >> 4) ^ vswz(row); voff = (unsigned)(row * 64 + c * 16); } }
    const unsigned ldsw = (unsigned)wid * 1024u;
    const __amdgpu_buffer_rsrc_t rK = __builtin_amdgcn_make_buffer_rsrc((void*)Kg, (short)0, 0x7fffffff, 0x00020000);
    const __amdgpu_buffer_rsrc_t rV = __builtin_amdgcn_make_buffer_rsrc((void*)VTg, (short)0, 0x7fffffff, 0x00020000);
#define ATT_DMA(slot, kt, vt) do { \
        __builtin_amdgcn_raw_ptr_buffer_load_lds(rK, (LAS void*)(lds + k_slot(slot) + ldsw), 16, (int)koff, (int)(kt), 0, 0); \
        __builtin_amdgcn_raw_ptr_buffer_load_lds(rV, (LAS void*)(lds + v_slot(slot) + ldsw), 16, (int)voff, (int)(vt), 0, 0); } while (0)
#define ATT_TOP() do { asm volatile("s_waitcnt vmcnt(2)" ::: "memory"); __builtin_amdgcn_s_barrier(); asm volatile("" ::: "memory"); } while (0)
    const int xq = bid & 7, cq = bid >> 3;
    int cbh = xq * 8;
    const bool lag = (jj != 0);
#define ATT_KB(bh_) ((unsigned)(((bh_) >> 3) * SEQ) * (unsigned)DM + (unsigned)((bh_) & 7) * 128u)
#define ATT_VB(bh_) ((unsigned)(bh_) * (128u * 8192u))
    ATT_DMA(0, ATT_KB(cbh), ATT_VB(cbh)); ATT_DMA(1, ATT_KB(cbh) + 64u * DM, ATT_VB(cbh) + 8192u);
    int ofKa, ofKb, ofV, ofKax, ofKbx, ofVx;
    { const int c0 = jj * 4 + 2 * hi, lb = (int)(unsigned)(size_t)lds;
      ofKa = r32 * 128 + ((c0 ^ kswz(r32)) << 4); ofKb = (32 + r32) * 128 + ((c0 ^ kswz(32 + r32)) << 4); ofV = 65536 + r32 * 64 + (((2 * hi) ^ vswz(r32)) << 4);
      ofKax = lb + (ofKa ^ 16); ofKbx = lb + (ofKb ^ 16); ofVx = lb + (ofV ^ 16); ofKa += lb; ofKb += lb; ofV += lb; }
#define ATT_QLOAD(dst, bh_, qb_) do { const unsigned char* Qw_ = Qg + ((size_t)((bh_) >> 3) * SEQ + (qb_) * 128) * DM + ((bh_) & 7) * 128 + (size_t)(wq * 32 + r32) * DM + jj * 64 + hi * 32; \
        const u32x4 qa_ = *(const u32x4*)Qw_, qb2_ = *(const u32x4*)(Qw_ + 16); dst = __builtin_bit_cast(v8i, __builtin_shufflevector(qa_, qb2_, 0, 1, 2, 3, 4, 5, 6, 7)); } while (0)
    v8i qnext; ATT_QLOAD(qnext, cbh, cq);
    for (int ui = 0; ui < 16; ++ui) {
        const int qb = (ui & 1) * 32 + cq;
        const int nbh = (ui + 1 < 16) ? xq * 8 + ((ui + 1) >> 1) : cbh;
        const unsigned Kh = ATT_KB(cbh), Vh = ATT_VB(cbh), nK = ATT_KB(nbh), nV = ATT_VB(nbh);
        const size_t obase = ((size_t)(cbh >> 3) * SEQ + qb * 128) * DM + (cbh & 7) * 128;
        f32x16 lacc = {}; f32x16 o[4] = {}; const v8i qr = qnext;
        f32x16 pA0, pA1; v8i pa, kf0, kf1, vf0, vf1, vf2, vf3;
        unsigned kptr = Kh + 2u * 64u * DM, vptr = Vh + 2u * 8192u;
#define ATT_ISSUE(SLD, last) do { asm volatile("" : "+s"(kptr), "+s"(vptr)); ATT_DMA(SLD, kptr, vptr); if (last) { kptr = nK; vptr = nV; } else { kptr += 64u * DM; vptr += 8192u; } } while (0)
#define ATT_RD8(b_, bx_, imm_) ATT_LD8((const LAS char*)(unsigned)((b_) + (imm_)), (const LAS char*)(unsigned)((bx_) + (imm_)))
#define ATT_FIX() asm volatile("" : "+v"(ofKa), "+v"(ofKax), "+v"(ofKb), "+v"(ofKbx), "+v"(ofV), "+v"(ofVx))
#define ATT_STEPC(LAST, SL, SLP, SLD) do { \
            ATT_FIX(); \
            kf0 = ATT_RD8(ofKa, ofKax, (SL) * SLOTB); kf1 = ATT_RD8(ofKb, ofKbx, (SL) * SLOTB); vf0 = ATT_RD8(ofV, ofVx, (SLP) * SLOTB); vf1 = ATT_RD8(ofV, ofVx, (SLP) * SLOTB + 2048); \
            ATT_ISSUE(SLD, LAST); \
            ATT_TOP(); \
            qkt_pack(pA0, pA1, kf0, kf1, qr, cinit, s1, s8, pe, pa); \
            vf2 = ATT_RD8(ofV, ofVx, (SLP) * SLOTB + 4096); vf3 = ATT_RD8(ofV, ofVx, (SLP) * SLOTB + 6144); \
            pv_exp_a(o, vf0, vf1, vf2, pa, s1, pA0, pA1, pe); \
            ATT_TOP(); \
            pv_exp_b(o, lacc, ones, vf3, pa, s1, pA0, pA1, pe); } while (0)
        float pe[32];
        if (lag) ATT_TOP();
        ATT_TOP();
        ATT_FIX(); kf0 = ATT_RD8(ofKa, ofKax, 0); kf1 = ATT_RD8(ofKb, ofKbx, 0); ATT_ISSUE(2, false);
        ATT_TOP();
        { mfma8_c(pA0, kf0, qr, cinit, s1, s8); mfma8_c(pA1, kf1, qr, cinit, s1, s8);
          asm volatile("s_nop 15\n\ts_nop 15" ::: "memory");
#pragma unroll
          for (int r = 0; r < 16; ++r) pe[r] = fexp2(pA0[r]);
#pragma unroll
          for (int r = 0; r < 16; ++r) pe[16 + r] = fexp2(pA1[r]); }
        ATT_TOP();
        ATT_STEPC(false, 1, 0, 3); ATT_STEPC(false, 2, 1, 4); ATT_STEPC(false, 3, 2, 5); ATT_STEPC(false, 4, 3, 6); ATT_STEPC(false, 5, 4, 7); ATT_STEPC(false, 6, 5, 0); ATT_STEPC(false, 7, 6, 1);
        for (int kb = 8; kb < NT; kb += 8) {
            ATT_STEPC(false, 0, 7, 2); ATT_STEPC(false, 1, 0, 3); ATT_STEPC(false, 2, 1, 4); ATT_STEPC(false, 3, 2, 5);
            ATT_STEPC(false, 4, 3, 6); ATT_STEPC(kb == NT - 8, 5, 4, 7); ATT_STEPC(false, 6, 5, 0); ATT_STEPC(false, 7, 6, 1);
        }
        ATT_FIX();
        vf0 = ATT_RD8(ofV, ofVx, 7 * SLOTB); vf1 = ATT_RD8(ofV, ofVx, 7 * SLOTB + 2048);
        ATT_TOP();
        { vf2 = ATT_RD8(ofV, ofVx, 7 * SLOTB + 4096); vf3 = ATT_RD8(ofV, ofVx, 7 * SLOTB + 6144);
          pack_p(pe, pa); SBAR();
          pv_last(o, lacc, ones, vf0, vf1, vf2, vf3, pa, s1);
          asm volatile("s_nop 15\n\ts_nop 15" ::: "memory"); }
        if (!lag) ATT_TOP();
        if (ui + 1 < 16) ATT_QLOAD(qnext, nbh, ((ui + 1) & 1) * 32 + cq);
#undef ATT_ISSUE
#undef ATT_STEPC
#undef ATT_RD8
#undef ATT_FIX
        int r32e = r32, hie = hi; asm volatile("" : "+v"(r32e), "+v"(hie));
        float rli[16];
#pragma unroll
        for (int r = 0; r < 16; ++r) rli[r] = frcp(lacc[r]);
        asm volatile("s_waitcnt lgkmcnt(0)" ::: "memory"); __builtin_amdgcn_s_barrier(); asm volatile("" ::: "memory");
        LAS float* Cb = (LAS float*)(lds + ((wq < 2) ? 3 * SLOTB : 65536 + 3 * SLOTB - 64 * 512));
        if (jj == 1) {
#pragma unroll
            for (int r = 0; r < 16; ++r) { const float sc = rli[r] * lamv;
#pragma unroll
                for (int d0 = 0; d0 < 4; ++d0) Cb[(wq * 32 + crow(r, hie)) * 128 + d0 * 32 + r32e] = o[d0][r] * sc; }
        }
        asm volatile("s_waitcnt lgkmcnt(0)" ::: "memory"); __builtin_amdgcn_s_barrier(); asm volatile("" ::: "memory");
        if (jj == 0) {
            float g[4];
#pragma unroll
            for (int d0 = 0; d0 < 4; ++d0) g[d0] = subg[d0 * 32 + r32e] * omli;
            bf16_t* Ob = Og + obase;
#pragma unroll
            for (int r = 0; r < 16; ++r) {
                float ss = 0.f;
#pragma unroll
                for (int d0 = 0; d0 < 4; ++d0) { const float v = o[d0][r] * rli[r] - Cb[(wq * 32 + crow(r, hie)) * 128 + d0 * 32 + r32e]; o[d0][r] = v; ss += v * v; }
                ss += __shfl_xor(ss, 1); ss += __shfl_xor(ss, 2); ss += __shfl_xor(ss, 4); ss += __shfl_xor(ss, 8); ss += __shfl_xor(ss, 16);
                const float rs = 1.0f / sqrtf(ss * (1.0f / 128.0f) + EPS);
                if (al == 0) { bf16_t* op = Ob + (size_t)(wq * 32 + crow(r, hie)) * DM + r32e;
#pragma unroll
                    for (int d0 = 0; d0 < 4; ++d0) op[d0 * 32] = (bf16_t)f2bf(o[d0][r] * rs * g[d0]); }
                else { unsigned char* op = (unsigned char*)Og + obase + (size_t)(wq * 32 + crow(r, hie)) * DM + r32e;
#pragma unroll
                    for (int d0 = 0; d0 < 4; ++d0) { const float v = o[d0][r] * rs * g[d0]; op[d0 * 32] = (unsigned char)(__builtin_amdgcn_cvt_pk_fp8_f32(v, v, 0, false) & 0xff); } }
            }
        }
        asm volatile("s_waitcnt lgkmcnt(0)" ::: "memory"); __builtin_amdgcn_s_barrier(); asm volatile("" ::: "memory");
        cbh = nbh;
    }
    asm volatile("s_waitcnt vmcnt(0) lgkmcnt(0)" ::: "memory"); __builtin_amdgcn_s_barrier(); asm volatile("" ::: "memory");
#undef ATT_DMA
#undef ATT_TOP
#undef ATT_QLOAD
#undef ATT_KB
#undef ATT_VB
#undef ATT_LD8
}

namespace gla {
constexpr int BC = 0, QI = 32768, QA = 49152, KA = 65536, KST = 81920, VT = 98304, ST = 106496, AT = 122880, EM = 131072, EL = EM + 512, DD = EM + 1024, BMID = EM + 1536, SEG = EM + 2048;
static_assert(SEG + 2048 <= RING_BYTES, "gla lds");
__device__ __forceinline__ int sw256(int row, int cb) { return row * 256 + (cb ^ ((row & 15) << 4)); }
__device__ __forceinline__ int sw128(int row, int cb) { return row * 128 + (cb ^ ((((row & 7) ^ (row >> 4)) & 7) << 4)); }
__device__ __forceinline__ int crow(int r, int hi) { return (r & 3) + 8 * (r >> 2) + 4 * hi; }
__device__ __forceinline__ float h2f(unsigned short b) { return (float)__builtin_bit_cast(_Float16, b); }
__device__ __forceinline__ void gla_item(const bf16_t* __restrict__ Qp, const unsigned short* __restrict__ LFp, const bf16_t* __restrict__ Vp, bf16_t* __restrict__ Op, int dir, LAS unsigned char* lds, float* dbg) {
    int tid_ = threadIdx.x; asm volatile("" : "+v"(tid_));
    const int tid = tid_, wid = tid >> 6, lane = tid & 63, r = lane & 31, hh = lane >> 5;
    const int t1 = tid >> 3, kg = tid & 7, k0 = 16 * kg, v0 = (tid & 7) * 8;
    for (int i = tid; i < 16384 / 16; i += NTHR) *(LAS u32x4*)(lds + ST + i * 16) = (u32x4){0u, 0u, 0u, 0u};
    f32x16 st = {};
    u32x4 rq[2], rl[2], rv;
#define GLA_TOK(ci, i) (dir ? (SEQ - 1 - ((ci) * 64 + (i))) : ((ci) * 64 + (i)))
#define GLA_LOAD(ci) do { const size_t to = (size_t)GLA_TOK(ci, t1) * DM; \
        rq[0] = *(const u32x4*)(Qp + to + k0); rq[1] = *(const u32x4*)(Qp + to + k0 + 8); \
        rl[0] = *(const u32x4*)(LFp + to + k0); rl[1] = *(const u32x4*)(LFp + to + k0 + 8); rv = *(const u32x4*)(Vp + to + v0); } while (0)
    GLA_LOAD(0);
    __syncthreads();
    for (int ci = 0; ci < SEQ / 64; ++ci) {
        float qf[16], lf[16]; u32x4 vreg = rv;
#pragma unroll
        for (int j = 0; j < 2; ++j)
#pragma unroll
            for (int e = 0; e < 4; ++e) { qf[j * 8 + 2 * e] = bflo(rq[j][e]); qf[j * 8 + 2 * e + 1] = bfhi(rq[j][e]);
                lf[j * 8 + 2 * e] = h2f((unsigned short)(rl[j][e] & 0xffffu)); lf[j * 8 + 2 * e + 1] = h2f((unsigned short)(rl[j][e] >> 16)); }
        if (ci + 1 < SEQ / 64) GLA_LOAD(ci + 1);
#pragma unroll
        for (int j = 0; j < 4; ++j) *(LAS f32x4*)(lds + BC + (t1 * 128 + k0 + 4 * j) * 4) = (f32x4){lf[4 * j], lf[4 * j + 1], lf[4 * j + 2], lf[4 * j + 3]};
        __syncthreads();
        { const int kc = tid & 127, sg = tid >> 7; LAS float* bc = (LAS float*)(lds + BC) + kc; float cs[16];
#pragma unroll
            for (int i = 0; i < 16; ++i) cs[i] = bc[(sg * 16 + i) * 128];
#pragma unroll
            for (int i = 1; i < 16; ++i) cs[i] += cs[i - 1];
            ((LAS float*)(lds + SEG))[sg * 128 + kc] = cs[15];
            __syncthreads();
            const LAS float* sgp = (const LAS float*)(lds + SEG) + kc; const float s0 = sgp[0], s1 = sgp[128], s2 = sgp[256], s3 = sgp[384];
            const float off = sg == 0 ? 0.f : sg == 1 ? s0 : sg == 2 ? (s0 + s1) : ((s0 + s1) + s2);
#pragma unroll
            for (int i = 0; i < 16; ++i) bc[(sg * 16 + i) * 128] = cs[i] + off;
            if (sg == 0) { const float bm = s0 + s1, bl = ((s0 + s1) + s2) + s3;
                ((LAS float*)(lds + BMID))[kc] = bm; ((LAS float*)(lds + EM))[kc] = fexp(bm); ((LAS float*)(lds + EL))[kc] = fexp(bl - bm); ((LAS float*)(lds + DD))[kc] = fexp(bl); }
            __syncthreads();
        }
#ifdef DIAG
        if (dbg && ci == 0) { for (int i = tid; i < 8192; i += NTHR) dbg[i] = ((const LAS float*)(lds + BC))[i]; }
#endif
        {
            unsigned wqi[8], wqa[8], wka[8]; float ksv[16];
#pragma unroll
            for (int j = 0; j < 4; ++j) {
                const f32x4 bt = *(const LAS f32x4*)(lds + BC + (t1 * 128 + k0 + 4 * j) * 4), bm = *(const LAS f32x4*)(lds + BMID + (k0 + 4 * j) * 4);
                const f32x4 em = *(const LAS f32x4*)(lds + EM + (k0 + 4 * j) * 4), el = *(const LAS f32x4*)(lds + EL + (k0 + 4 * j) * 4);
                float qi[4], qa[4], ka[4];
#pragma unroll
                for (int e = 0; e < 4; ++e) { const int i = 4 * j + e; const float e1 = fexp(bt[e] - bm[e]), r1 = frcp(e1);
                    qa[e] = qf[i] * e1; qi[e] = qa[e] * em[e]; const float kk = 1.0f - fexp(lf[i]); ka[e] = kk * r1; ksv[i] = ka[e] * el[e]; }
                wqi[2 * j] = cvt_pk_bf16(qi[0], qi[1]); wqi[2 * j + 1] = cvt_pk_bf16(qi[2], qi[3]);
                wqa[2 * j] = cvt_pk_bf16(qa[0], qa[1]); wqa[2 * j + 1] = cvt_pk_bf16(qa[2], qa[3]);
                wka[2 * j] = cvt_pk_bf16(ka[0], ka[1]); wka[2 * j + 1] = cvt_pk_bf16(ka[2], ka[3]);
            }
#pragma unroll
            for (int j = 0; j < 2; ++j) { const int off = sw256(t1, (k0 + 8 * j) * 2);
                *(LAS u32x4*)(lds + QI + off) = (u32x4){wqi[4 * j], wqi[4 * j + 1], wqi[4 * j + 2], wqi[4 * j + 3]};
                *(LAS u32x4*)(lds + QA + off) = (u32x4){wqa[4 * j], wqa[4 * j + 1], wqa[4 * j + 2], wqa[4 * j + 3]};
                *(LAS u32x4*)(lds + KA + off) = (u32x4){wka[4 * j], wka[4 * j + 1], wka[4 * j + 2], wka[4 * j + 3]}; }
#pragma unroll
            for (int i = 0; i < 16; ++i) *(LAS unsigned short*)(lds + KST + sw128(k0 + i, t1 * 2)) = (unsigned short)f2bf(ksv[i]);
#pragma unroll
            for (int e = 0; e < 4; ++e) { *(LAS unsigned short*)(lds + VT + sw128(v0 + 2 * e, t1 * 2)) = (unsigned short)(vreg[e] & 0xffffu);
                *(LAS unsigned short*)(lds + VT + sw128(v0 + 2 * e + 1, t1 * 2)) = (unsigned short)(vreg[e] >> 16); }
        }
        __syncthreads();
        f32x16 oacc = {};
        const int w4 = wid & 3, t_i = w4 >> 1, v_i = w4 & 1;
        if (wid < 4) {
            const int s_i = wid >> 1, tq = wid & 1; f32x16 a = {};
#pragma unroll
            for (int ks = 0; ks < 8; ++ks) { const bf16x8 fa = *(const LAS bf16x8*)(lds + KA + sw256(32 * s_i + r, (16 * ks + 8 * hh) * 2)), fb = *(const LAS bf16x8*)(lds + QA + sw256(32 * tq + r, (16 * ks + 8 * hh) * 2));
                a = __builtin_amdgcn_mfma_f32_32x32x16_bf16(fa, fb, a, 0, 0, 0); }
            const int tg = 32 * tq + r;
#pragma unroll
            for (int g = 0; g < 4; ++g) { float m[4];
#pragma unroll
                for (int e = 0; e < 4; ++e) { const int sgl = 32 * s_i + 8 * g + 4 * hh + e; m[e] = (sgl <= tg) ? a[4 * g + e] : 0.f; }
                *(LAS u32x2*)(lds + AT + sw128(tg, (32 * s_i + 8 * g + 4 * hh) * 2)) = (u32x2){cvt_pk_bf16(m[0], m[1]), cvt_pk_bf16(m[2], m[3])}; }
        } else {
#pragma unroll
            for (int ks = 0; ks < 8; ++ks) { const bf16x8 fa = *(const LAS bf16x8*)(lds + QI + sw256(32 * t_i + r, (16 * ks + 8 * hh) * 2)), fb = *(const LAS bf16x8*)(lds + ST + sw256(32 * v_i + r, (16 * ks + 8 * hh) * 2));
                oacc = __builtin_amdgcn_mfma_f32_32x32x16_bf16(fa, fb, oacc, 0, 0, 0); }
        }
        __syncthreads();
#ifdef DIAG
        if (dbg && ci == 0) { for (int i = tid; i < 2048; i += NTHR) { ((unsigned*)dbg)[8192 + i] = ((const LAS unsigned*)(lds + AT))[i]; ((unsigned*)dbg)[8192 + 2048 + i] = ((const LAS unsigned*)(lds + VT))[i]; } }
#endif
        if (wid >= 4) {
#pragma unroll
            for (int ks = 0; ks < 4; ++ks) { const bf16x8 fa = *(const LAS bf16x8*)(lds + AT + sw128(32 * t_i + r, (16 * ks + 8 * hh) * 2)), fb = *(const LAS bf16x8*)(lds + VT + sw128(32 * v_i + r, (16 * ks + 8 * hh) * 2));
                oacc = __builtin_amdgcn_mfma_f32_32x32x16_bf16(fa, fb, oacc, 0, 0, 0); }
#pragma unroll
            for (int i = 0; i < 16; ++i) { const int t = 32 * t_i + crow(i, hh); Op[(size_t)GLA_TOK(ci, t) * DM + 32 * v_i + r] = (bf16_t)f2bf(oacc[i]); }
        }
        {
            const int kq = wid >> 1, vq = wid & 1;
#pragma unroll
            for (int i = 0; i < 16; ++i) st[i] *= ((const LAS float*)(lds + DD))[32 * kq + crow(i, hh)];
#pragma unroll
            for (int ks = 0; ks < 4; ++ks) { const bf16x8 fa = *(const LAS bf16x8*)(lds + KST + sw128(32 * kq + r, (16 * ks + 8 * hh) * 2)), fb = *(const LAS bf16x8*)(lds + VT + sw128(32 * vq + r, (16 * ks + 8 * hh) * 2));
                st = __builtin_amdgcn_mfma_f32_32x32x16_bf16(fa, fb, st, 0, 0, 0); }
#pragma unroll
            for (int g = 0; g < 4; ++g) *(LAS u32x2*)(lds + ST + sw256(32 * vq + r, (32 * kq + 8 * g + 4 * hh) * 2)) = (u32x2){cvt_pk_bf16(st[4 * g], st[4 * g + 1]), cvt_pk_bf16(st[4 * g + 2], st[4 * g + 3])};
        }
        __syncthreads();
#ifdef DIAG
        if (dbg && ci == 0) { for (int i = tid; i < 4096; i += NTHR) { ((unsigned*)dbg)[12288 + i] = ((const LAS unsigned*)(lds + ST))[i]; ((unsigned*)dbg)[16384 + i] = ((const LAS unsigned*)(lds + KST))[i]; } }
#endif
    }
#undef GLA_TOK
#undef GLA_LOAD
}
}
__device__ __forceinline__ void gla_phase(const Args& A, LAS unsigned char* lds, int bid, int G) {
    unsigned char* ws = A.ws;
    for (int it = bid; it < 256; it += G) {
        const int b = it >> 5, h = (it >> 2) & 7, dir = (it >> 1) & 1, vh = it & 1;
        const size_t base = (size_t)b * SEQ * DM + h * 128;
        gla::gla_item((const bf16_t*)(ws + H_Q) + base, (const unsigned short*)(ws + (dir ? H_LFB : H_LFF)) + base, (const bf16_t*)(ws + H_V) + base + vh * 64,
                      (bf16_t*)(ws + (dir ? H_OB : H_OF)) + base + vh * 64, dir, lds, it == 0 ? (float*)(ws + TB_LSUM) : nullptr);
    }
}
__device__ __forceinline__ void hg_normo_phase(const Args& A, int bid, int G) {
    int tid_ = threadIdx.x; asm volatile("" : "+v"(tid_));
    const int tid = tid_, lane = tid & 63, wave = tid >> 6; unsigned char* ws = A.ws;
    const bf16_t* OF = (const bf16_t*)(ws + H_OF); const bf16_t* OB = (const bf16_t*)(ws + H_OB); const bf16_t* GG = (const bf16_t*)(ws + H_G); bf16_t* HM = (bf16_t*)(ws + WS_HM);
    const int c0 = (lane >> 3) * 128 + (lane & 7) * 16;
    float ng[16];
#pragma unroll
    for (int i = 0; i < 16; ++i) ng[i] = A.in[I_HGNG][(lane & 7) * 16 + i];
    for (int row = (bid * NWAVES + wave); row < MTOK; row += G * NWAVES) {
        const size_t o = (size_t)row * DM + c0;
        const u32x4 a0 = *(const u32x4*)(OF + o), a1 = *(const u32x4*)(OF + o + 8), b0 = *(const u32x4*)(OB + o), b1 = *(const u32x4*)(OB + o + 8), g0 = *(const u32x4*)(GG + o), g1 = *(const u32x4*)(GG + o + 8);
        float v[16], gt[16]; float ss = 0.f;
#pragma unroll
        for (int e = 0; e < 4; ++e) { v[2 * e] = bflo(a0[e]) + bflo(b0[e]); v[2 * e + 1] = bfhi(a0[e]) + bfhi(b0[e]); v[8 + 2 * e] = bflo(a1[e]) + bflo(b1[e]); v[8 + 2 * e + 1] = bfhi(a1[e]) + bfhi(b1[e]);
            gt[2 * e] = bflo(g0[e]); gt[2 * e + 1] = bfhi(g0[e]); gt[8 + 2 * e] = bflo(g1[e]); gt[8 + 2 * e + 1] = bfhi(g1[e]); }
#pragma unroll
        for (int i = 0; i < 16; ++i) ss += v[i] * v[i];
        ss += __shfl_xor(ss, 1); ss += __shfl_xor(ss, 2); ss += __shfl_xor(ss, 4);
        const float rstd = 1.0f / sqrtf(ss * (1.0f / 128.0f) + EPS);
        u32x4 w0, w1;
#pragma unroll
        for (int e = 0; e < 4; ++e) { w0[e] = cvt_pk_bf16(v[2 * e] * rstd * ng[2 * e] * gt[2 * e], v[2 * e + 1] * rstd * ng[2 * e + 1] * gt[2 * e + 1]);
            w1[e] = cvt_pk_bf16(v[8 + 2 * e] * rstd * ng[8 + 2 * e] * gt[8 + 2 * e], v[8 + 2 * e + 1] * rstd * ng[8 + 2 * e + 1] * gt[8 + 2 * e + 1]); }
        *(u32x4*)(HM + o) = w0; *(u32x4*)(HM + o + 8) = w1;
    }
}

#ifdef DIAG
constexpr int DG_BASE = 8192;
__device__ __forceinline__ void dg_put(const Args& A, int k, float e) { if (!(e >= 0.f) || e > 1e9f) e = 1e9f; atomicMax((unsigned*)(A.ws + WS_CTL) + DG_BASE + 64 * k, __float_as_uint(e)); }
__device__ __forceinline__ float dg_rel(float got, float ref) { return fabsf(got - ref) / (fabsf(ref) + 0.1f); }
__device__ __forceinline__ unsigned dg_hash(unsigned a, unsigned b) { unsigned h = a * 2654435761u + b * 40503u + 0x9e3779b9u; h ^= h >> 15; h *= 2246822519u; h ^= h >> 13; h *= 3266489917u; h ^= h >> 16; return h; }
__device__ __forceinline__ float dg_bfr(float x) { return bflo(f2bf(x)); }
__device__ __forceinline__ void dg_mods(const Args& A, int k) {
    const int lane = threadIdx.x & 63, gwv = blockIdx.x * 8 + (threadIdx.x >> 6);
    const unsigned h = dg_hash(gwv, k); const int l = h & 3, b = (h >> 2) & 7, e = (h >> 5) % 6144;
    float a = 0.f; for (int d = lane; d < DM; d += 64) a += fsilu(A.in[I_C][b * DM + d]) * A.in[I_ADAW][((size_t)l * DM + d) * 6144 + e];
    a = wave_sum(a) + A.in[I_ADAB][l * 6144 + e];
    const float got = ((const float*)(A.ws + TB_MODS))[((size_t)l * NBATCH + b) * 6144 + e];
    if (lane == 0) dg_put(A, k, dg_rel(got, a));
}
__device__ __forceinline__ void dg_norm(const Args& A, int k, const float* x, const float* gain, int L, int which) {
    const int lane = threadIdx.x & 63, gwv = blockIdx.x * 8 + (threadIdx.x >> 6);
    const int row = dg_hash(gwv, k) & (MTOK - 1), b = row >> 13;
    const float* modl = (const float*)(A.ws + TB_MODS) + ((size_t)L * NBATCH + b) * 6144;
    float ss = 0.f; for (int c = lane; c < DM; c += 64) { const float v = x[(size_t)row * DM + c]; ss += v * v; }
    ss = wave_sum(ss); const float rstd = 1.0f / sqrtf(ss / DM + EPS); float e = 0.f;
    for (int c = lane; c < DM; c += 64) { const float ref = x[(size_t)row * DM + c] * rstd * gain[c] * (1.0f + modl[(which * 3 + 1) * 1024 + c]) + modl[(which * 3) * 1024 + c];
        e = fmaxf(e, dg_rel(bf2f(((const bf16_t*)(A.ws + WS_HM))[(size_t)row * DM + c]), ref)); }
    dg_put(A, k, e);
}
__device__ __forceinline__ void dg_qkv(const Args& A, int k, int al) {
    const int lane = threadIdx.x & 63, gwv = blockIdx.x * 8 + (threadIdx.x >> 6);
    const unsigned h = dg_hash(gwv, k); const int row = h & (MTOK - 1), t = (h >> 16) % 48, col = t * 64 + lane;
    const bf16_t* hm = (const bf16_t*)(A.ws + WS_HM) + (size_t)row * DM; const float* w = A.in[I_ATWIN] + (size_t)al * 1024 * 3072 + col;
    float a = 0.f; for (int kk = 0; kk < DM; ++kk) a += bf2f(hm[kk]) * dg_bfr(w[(size_t)kk * 3072]);
    float ref, got;
    if (t < 32) {
        const int part = t >> 4, sh = t & 15; const float ss = wave_sum(a * a); const float rstd = 1.0f / sqrtf(ss / 64.0f + EPS);
        const float y = a * rstd * (part ? A.in[I_ATKN] : A.in[I_ATQN])[al * 64 + lane]; const float yp = __shfl_xor(y, 32);
        const int pos = row & (SEQ - 1); const float cs = ((const float*)(A.ws + TB_COS))[pos * 32 + (lane & 31)], sn = ((const float*)(A.ws + TB_SIN))[pos * 32 + (lane & 31)];
        ref = (lane < 32) ? (y * cs - yp * sn) : (y * cs + yp * sn); if (part == 0) ref *= 0.125f * LOG2E;
        got = bf2f(((const bf16_t*)(A.ws + (part ? A_K : A_Q)))[(size_t)row * DM + sh * 64 + lane]);
    } else { ref = a; got = bf2f(((const bf16_t*)(A.ws + A_V))[(size_t)row * DM + (t - 32) * 64 + lane]); }
    dg_put(A, k, dg_rel(got, ref));
}
__device__ __forceinline__ void dg_attn(const Args& A, int k, int al, LAS unsigned char* lds) {
    const int tid = threadIdx.x; const unsigned h = dg_hash(blockIdx.x, k); const int row = h & (MTOK - 1), hd = (h >> 16) & 7, b = row >> 13;
    const bf16_t* Q = (const bf16_t*)(A.ws + A_Q); const bf16_t* K = (const bf16_t*)(A.ws + A_K); const bf16_t* V = (const bf16_t*)(A.ws + A_V);
    const float* scal = (const float*)(A.ws + TB_SCAL); const float lamv = scal[SC_LAM0 + al], omli = scal[SC_OML0 + al], Mc = scal[SC_MC0 + al];
    LAS float* p0 = (LAS float*)lds; LAS float* p1 = p0 + SEQ; LAS float* red = p1 + SEQ;
    float l0 = 0.f, l1 = 0.f;
    for (int key = tid; key < SEQ; key += NTHR) { const bf16_t* kr = K + ((size_t)b * SEQ + key) * DM + hd * 128; const bf16_t* qr = Q + (size_t)row * DM + hd * 128;
        float s0 = 0.f, s1 = 0.f; for (int d = 0; d < 64; ++d) { s0 += bf2f(qr[d]) * bf2f(kr[d]); s1 += bf2f(qr[64 + d]) * bf2f(kr[64 + d]); }
        const float e0 = fexp2(s0 - Mc), e1 = fexp2(s1 - Mc); p0[key] = e0; p1[key] = e1; l0 += e0; l1 += e1; }
    l0 = wave_sum(l0); l1 = wave_sum(l1); if ((tid & 63) == 0) { red[tid >> 6] = l0; red[8 + (tid >> 6)] = l1; }
    __syncthreads();
    l0 = 0.f; l1 = 0.f; for (int w = 0; w < 8; ++w) { l0 += red[w]; l1 += red[8 + w]; }
    __syncthreads();
    const int dv = tid & 127, part = tid >> 7; float o = 0.f;
    for (int key = part * 2048; key < part * 2048 + 2048; ++key) o += (p0[key] / l0 - lamv * p1[key] / l1) * bf2f(V[((size_t)b * SEQ + key) * DM + hd * 128 + dv]);
    red[16 + part * 128 + dv] = o; __syncthreads();
    if (tid < 128) { o = red[16 + tid] + red[16 + 128 + tid] + red[16 + 256 + tid] + red[16 + 384 + tid]; red[600 + tid] = o * o; }
    __syncthreads();
    if (tid < 128) { float ss = 0.f; for (int i = 0; i < 128; ++i) ss += red[600 + i]; const float ref = o / sqrtf(ss / 128.0f + EPS) * A.in[I_ATSUB][al * 128 + tid] * omli;
        dg_put(A, k, dg_rel(bf2f(((const bf16_t*)(A.ws + WS_HM))[(size_t)row * DM + hd * 128 + tid]), ref)); }
    __syncthreads();
}
__device__ __forceinline__ void dg_save(const Args& A, int k, const float* xold) {
    const int lane = threadIdx.x & 63, gwv = blockIdx.x * 8 + (threadIdx.x >> 6);
    const unsigned h = dg_hash(gwv, k); const int row = h & (MTOK - 1), col = (h >> 16) & 1023;
    float* sv = (float*)(A.ws + TB_LSUM) + 7 * 1024 * 1024 / 4;
    if (lane == 0) sv[k * 4096 + gwv] = xold[(size_t)row * DM + col];
}
__device__ __forceinline__ void dg_res(const Args& A, int k, const float* xnew, const float* gate, const bf16_t* Am, int K, const float* W) {
    const int lane = threadIdx.x & 63, gwv = blockIdx.x * 8 + (threadIdx.x >> 6);
    const unsigned h = dg_hash(gwv, k); const int row = h & (MTOK - 1), col = (h >> 16) & 1023, b = row >> 13;
    const float* sv = (const float*)(A.ws + TB_LSUM) + 7 * 1024 * 1024 / 4;
    float a = 0.f; for (int kk = lane; kk < K; kk += 64) a += bf2f(Am[(size_t)row * K + kk]) * dg_bfr(W[(size_t)kk * DM + col]);
    a = wave_sum(a);
    const float ref = sv[k * 4096 + gwv] + gate[(size_t)b * 6144 + col] * a;
    if (lane == 0) dg_put(A, k, dg_rel(xnew[(size_t)row * DM + col], ref));
}
__device__ __forceinline__ void dg_swiglu(const Args& A, int k, const bf16_t* Am, const float* W, int F, const bf16_t* H, int nrows, const int* rowmap) {
    const int lane = threadIdx.x & 63, gwv = blockIdx.x * 8 + (threadIdx.x >> 6);
    const unsigned h = dg_hash(gwv, k); const int row = (h & 0xfffff) % nrows, j = (h >> 20) % F;
    float g = 0.f, u = 0.f; for (int kk = lane; kk < DM; kk += 64) { const float x = bf2f(Am[(size_t)row * DM + kk]); g += x * dg_bfr(W[(size_t)kk * 2 * F + j]); u += x * dg_bfr(W[(size_t)kk * 2 * F + F + j]); }
    g = wave_sum(g); u = wave_sum(u);
    const float ref = g / (1.0f + expf(-g)) * u;
    if (lane == 0) dg_put(A, k, dg_rel(bf2f(H[(size_t)row * F + j]), ref));
}
__device__ __forceinline__ void dg_hgin(const Args& A, int k) {
    const int lane = threadIdx.x & 63, gwv = blockIdx.x * 8 + (threadIdx.x >> 6);
    const unsigned h = dg_hash(gwv, k); const int row = h & (MTOK - 1), col = (h >> 16) % 5120, grp = col >> 10, cc = col & 1023;
    float a = 0.f; for (int kk = lane; kk < DM; kk += 64) a += bf2f(((const bf16_t*)(A.ws + WS_HM))[(size_t)row * DM + kk]) * dg_bfr(A.in[I_HGWIN][(size_t)kk * 5120 + col]);
    a = wave_sum(a);
    float ref, got;
    if (grp == 0 || grp == 4) { ref = a / (1.0f + expf(-a)); got = bf2f(((const bf16_t*)(A.ws + (grp == 0 ? H_Q : H_G)))[(size_t)row * DM + cc]); }
    else if (grp == 3) { ref = a; got = bf2f(((const bf16_t*)(A.ws + H_V))[(size_t)row * DM + cc]); }
    else { const int d = grp - 1; const float* p = A.in[I_HGLB] + (size_t)d * DEPTH * 1024 + cc; float mx = p[0]; for (int l = 1; l < DEPTH; ++l) mx = fmaxf(mx, p[l * 1024]);
        float den = 0.f; for (int l = 0; l < DEPTH; ++l) den += expf(p[l * 1024] - mx); const float lbv = expf(p[1024] - mx) / den;
        ref = logf(lbv + (1.0f - lbv) / (1.0f + expf(-a))); got = gla::h2f(((const unsigned short*)(A.ws + (d ? H_LFB : H_LFF)))[(size_t)row * DM + cc]); }
    if (lane == 0) dg_put(A, k, dg_rel(got, ref));
}
__device__ __forceinline__ void dg_gla(const Args& A, int k) {
    const int lane = threadIdx.x & 63, gwv = blockIdx.x * 8 + (threadIdx.x >> 6);
    const unsigned h = dg_hash(gwv, k); const int sel0 = (gwv & 3) == 0; const int b = sel0 ? 0 : (h & 7), hd = sel0 ? 0 : ((h >> 3) & 7), dir = sel0 ? 0 : ((h >> 6) & 1), vc = sel0 ? ((h >> 7) & 63) : ((h >> 7) & 127);
    const bf16_t* Q = (const bf16_t*)(A.ws + H_Q); const unsigned short* LF = (const unsigned short*)(A.ws + (dir ? H_LFB : H_LFF)); const bf16_t* V = (const bf16_t*)(A.ws + H_V);
    const bf16_t* O = (const bf16_t*)(A.ws + (dir ? H_OB : H_OF));
    float s0 = 0.f, s1 = 0.f, e0 = 0.f, e1 = 0.f, e2 = 0.f, e3 = 0.f;
    for (int i = 0; i < SEQ; ++i) { const int tok = dir ? (SEQ - 1 - i) : i; const size_t o = ((size_t)b * SEQ + tok) * DM + hd * 128;
        const float f0 = expf(gla::h2f(LF[o + lane])), f1 = expf(gla::h2f(LF[o + 64 + lane])), v = bf2f(V[o + vc]);
        s0 = f0 * s0 + (1.0f - f0) * v; s1 = f1 * s1 + (1.0f - f1) * v;
        if (i < 128 || i % 61 == 0) { const float ov = wave_sum(bf2f(Q[o + lane]) * s0 + bf2f(Q[o + 64 + lane]) * s1); const float er = 0.25f * fabsf(bf2f(O[o + vc]) - ov) / (fabsf(ov) + 1.0f);
            if (i == 0) e0 = er; else if (i < 64) e1 = fmaxf(e1, er); else if (i < 128) e2 = fmaxf(e2, er); else e3 = fmaxf(e3, er); } }
    if (lane == 0) { dg_put(A, k, e0); dg_put(A, k + 4, e1); dg_put(A, k + 5, e2); dg_put(A, k + 6, e3); }
    const float* dbg = (const float*)(A.ws + TB_LSUM); const unsigned short* LF0 = (const unsigned short*)(A.ws + H_LFF); const bf16_t* Q0 = (const bf16_t*)(A.ws + H_Q);
    { const unsigned h2 = dg_hash(gwv, k + 100); const int t = h2 & 63, kk = (h2 >> 6) & 127; float c = 0.f; for (int tt = 0; tt <= t; ++tt) c += gla::h2f(LF0[(size_t)tt * DM + kk]);
      if (lane == 0) dg_put(A, k + 1, dg_rel(dbg[t * 128 + kk], c)); }
    { const unsigned h2 = dg_hash(gwv, k + 200); const int t = h2 & 63, sidx = (h2 >> 6) & 63; float a = 0.f;
      if (sidx <= t) { for (int kk = lane; kk < 128; kk += 64) { float c = 0.f; for (int tt = sidx + 1; tt <= t; ++tt) c += gla::h2f(LF0[(size_t)tt * DM + kk]);
              a += bf2f(Q0[(size_t)t * DM + kk]) * (1.0f - expf(gla::h2f(LF0[(size_t)sidx * DM + kk]))) * expf(c); } a = wave_sum(a); }
      const unsigned short got = ((const unsigned short*)(dbg + 8192))[gla::sw128(t, sidx * 2) / 2];
      if (lane == 0) dg_put(A, k + 2, 5.0f * fabsf(bf2f(got) - a) / (fabsf(a) + 0.01f)); }
    { const unsigned h2 = dg_hash(gwv, k + 300); const int sidx = h2 & 63, v = (h2 >> 6) & 63;
      const unsigned short got = ((const unsigned short*)(dbg + 8192 + 2048))[gla::sw128(v, sidx * 2) / 2];
      if (lane == 0) dg_put(A, k + 2, dg_rel(bf2f(got), bf2f(((const bf16_t*)(A.ws + H_V))[(size_t)sidx * DM + v]))); }
    { const unsigned h2 = dg_hash(gwv, k + 500); const int kk = h2 & 127, v = (h2 >> 7) & 63;
      float a = 0.f; { const int sidx = lane; float c = 0.f; for (int tt = sidx + 1; tt < 64; ++tt) c += gla::h2f(LF0[(size_t)tt * DM + kk]);
          const float ksn = (1.0f - expf(gla::h2f(LF0[(size_t)sidx * DM + kk]))) * expf(c);
          const unsigned short gk = ((const unsigned short*)(dbg + 16384))[gla::sw128(kk, sidx * 2) / 2];
          dg_put(A, k + 2, 0.5f * fabsf(bf2f(gk) - ksn) / (fabsf(ksn) + 0.01f));
          a = ksn * bf2f(((const bf16_t*)(A.ws + H_V))[(size_t)sidx * DM + v]); }
      a = wave_sum(a);
      const unsigned short gs = ((const unsigned short*)(dbg + 12288))[gla::sw256(v, kk * 2) / 2];
      if (lane == 0) dg_put(A, k + 3, 0.5f * fabsf(bf2f(gs) - a) / (fabsf(a) + 0.05f)); }
    { const unsigned h2 = dg_hash(gwv, k + 400); const int t = h2 & 63, v = (h2 >> 6) & 63;
      const unsigned short* at = (const unsigned short*)(dbg + 8192); const unsigned short* vt = (const unsigned short*)(dbg + 8192 + 2048);
      float a = bf2f(at[gla::sw128(t, lane * 2) / 2]) * bf2f(vt[gla::sw128(v, lane * 2) / 2]); a = wave_sum(a);
      if (lane == 0) dg_put(A, k + 1, 5.0f * dg_rel(bf2f(((const bf16_t*)(A.ws + H_OF))[(size_t)t * DM + v]), a)); }
}
__device__ __forceinline__ void dg_normo(const Args& A, int k) {
    const int lane = threadIdx.x & 63, gwv = blockIdx.x * 8 + (threadIdx.x >> 6);
    const unsigned h = dg_hash(gwv, k); const int row = h & (MTOK - 1), hd = (h >> 16) & 7; const size_t o = (size_t)row * DM + hd * 128;
    const float v0 = bf2f(((const bf16_t*)(A.ws + H_OF))[o + lane]) + bf2f(((const bf16_t*)(A.ws + H_OB))[o + lane]), v1 = bf2f(((const bf16_t*)(A.ws + H_OF))[o + 64 + lane]) + bf2f(((const bf16_t*)(A.ws + H_OB))[o + 64 + lane]);
    const float ss = wave_sum(v0 * v0 + v1 * v1), rstd = 1.0f / sqrtf(ss / 128.0f + EPS);
    const float r0 = v0 * rstd * A.in[I_HGNG][lane] * bf2f(((const bf16_t*)(A.ws + H_G))[o + lane]), r1 = v1 * rstd * A.in[I_HGNG][64 + lane] * bf2f(((const bf16_t*)(A.ws + H_G))[o + 64 + lane]);
    dg_put(A, k, fmaxf(dg_rel(bf2f(((const bf16_t*)(A.ws + WS_HM))[o + lane]), r0), dg_rel(bf2f(((const bf16_t*)(A.ws + WS_HM))[o + 64 + lane]), r1)));
}
__device__ __forceinline__ void dg_router(const Args& A, int k, int L) {
    const int lane = threadIdx.x & 63, gwv = blockIdx.x * 8 + (threadIdx.x >> 6);
    const int row = dg_hash(gwv, k) & (MTOK - 1), b = row >> 13; const float* x = A.out + (size_t)row * DM;
    const float* modl = (const float*)(A.ws + TB_MODS) + ((size_t)L * NBATCH + b) * 6144; const float* gain = A.in[I_N2G] + L * DM; const float* R = A.in[I_MOER] + (size_t)(L >> 1) * DM * 8;
    float ss = 0.f; for (int c = lane; c < DM; c += 64) ss += x[c] * x[c];
    ss = wave_sum(ss); const float rstd = 1.0f / sqrtf(ss / DM + EPS);
    float lg[8]; for (int e = 0; e < 8; ++e) lg[e] = 0.f;
    for (int c = lane; c < DM; c += 64) { const float hv = x[c] * rstd * gain[c] * (1.0f + modl[4 * 1024 + c]) + modl[3 * 1024 + c]; for (int e = 0; e < 8; ++e) lg[e] += hv * R[c * 8 + e]; }
    for (int e = 0; e < 8; ++e) lg[e] = wave_sum(lg[e]);
    int e0 = 0; for (int e = 1; e < 8; ++e) if (lg[e] > lg[e0]) e0 = e;
    int e1 = (e0 == 0) ? 1 : 0; for (int e = 0; e < 8; ++e) if (e != e0 && lg[e] > lg[e1]) e1 = e;
    float gap = 1e9f; for (int e = 0; e < 8; ++e) if (e != e0 && e != e1) gap = fminf(gap, lg[e1] - lg[e]); gap = fminf(gap, lg[e0] - lg[e1]);
    const int g0 = ((const int*)(A.ws + TB_EID))[row * 2], g1 = ((const int*)(A.ws + TB_EID))[row * 2 + 1]; const float w0 = ((const float*)(A.ws + TB_GATE))[row * 2], w1 = ((const float*)(A.ws + TB_GATE))[row * 2 + 1];
    const float p0 = 1.0f / (1.0f + expf(lg[e1] - lg[e0]));
    float er = (g0 != e0 || g1 != e1) ? (gap > 2e-3f ? 9.f : 0.f) : fmaxf(fabsf(w0 - p0), fabsf(w1 - (1.0f - p0)));
    if (lane == 0) dg_put(A, k, er);
}
__device__ __forceinline__ void dg_place(const Args& A, int k) {
    const int lane = threadIdx.x & 63, gwv = blockIdx.x * 8 + (threadIdx.x >> 6);
    const unsigned h = dg_hash(gwv, k); const int row = h & (MTOK - 1), kk = (h >> 16) & 1;
    const int sl = ((const int*)(A.ws + TB_SLOT))[row * 2 + kk], e = ((const int*)(A.ws + TB_EID))[row * 2 + kk]; const int* ts = (const int*)(A.ws + TB_TILES);
    float er = (sl >= ts[e] * 256 && sl < ts[e + 1] * 256 && sl < MOE_ROWS) ? 0.f : 7.f;
    if (er == 0.f) for (int c = lane; c < DM; c += 64) if (((const bf16_t*)(A.ws + E_XS))[(size_t)sl * DM + c] != ((const bf16_t*)(A.ws + WS_HM))[(size_t)row * DM + c]) er = 5.f;
    dg_put(A, k, er);
}
__device__ __forceinline__ void dg_moe_hid(const Args& A, int k, int m) {
    const int lane = threadIdx.x & 63, gwv = blockIdx.x * 8 + (threadIdx.x >> 6);
    const unsigned h = dg_hash(gwv, k); const int row = h & (MTOK - 1), kk = (h >> 16) & 1, j = (h >> 17) % DFFE;
    const int sl = ((const int*)(A.ws + TB_SLOT))[row * 2 + kk], e = ((const int*)(A.ws + TB_EID))[row * 2 + kk];
    const float* W = A.in[I_MOEGU] + ((size_t)m * 8 + e) * DM * 2 * DFFE; const bf16_t* Am = (const bf16_t*)(A.ws + E_XS) + (size_t)sl * DM;
    float g = 0.f, u = 0.f; for (int c = lane; c < DM; c += 64) { const float x = bf2f(Am[c]); g += x * dg_bfr(W[(size_t)c * 2 * DFFE + j]); u += x * dg_bfr(W[(size_t)c * 2 * DFFE + DFFE + j]); }
    g = wave_sum(g); u = wave_sum(u);
    if (lane == 0) dg_put(A, k, dg_rel(bf2f(((const bf16_t*)(A.ws + E_HID))[(size_t)sl * DFFE + j]), g / (1.0f + expf(-g)) * u));
}
__device__ __forceinline__ void dg_moe_y(const Args& A, int k, int m) {
    const int lane = threadIdx.x & 63, gwv = blockIdx.x * 8 + (threadIdx.x >> 6);
    const unsigned h = dg_hash(gwv, k); const int row = h & (MTOK - 1), kk = (h >> 16) & 1, col = (h >> 17) & 1023;
    const int sl = ((const int*)(A.ws + TB_SLOT))[row * 2 + kk], e = ((const int*)(A.ws + TB_EID))[row * 2 + kk];
    const float* W = A.in[I_MOEDN] + ((size_t)m * 8 + e) * DFFE * DM; const bf16_t* Hh = (const bf16_t*)(A.ws + E_HID) + (size_t)sl * DFFE;
    float a = 0.f; for (int j = lane; j < DFFE; j += 64) a += bf2f(Hh[j]) * dg_bfr(W[(size_t)j * DM + col]);
    a = wave_sum(a);
    if (lane == 0) dg_put(A, k, fabsf(bf2f(((const bf16_t*)(A.ws + E_XS))[(size_t)sl * DM + col]) - a) / (fabsf(a) + 0.3f));
}
__device__ __forceinline__ void dg_combine(const Args& A, int k, const float* modprev) {
    const int lane = threadIdx.x & 63, gwv = blockIdx.x * 8 + (threadIdx.x >> 6);
    const unsigned h = dg_hash(gwv, k); const int row = h & (MTOK - 1), col = (h >> 16) & 1023, b = row >> 13;
    const float* sv = (const float*)(A.ws + TB_LSUM) + 7 * 1024 * 1024 / 4; const bf16_t* Y = (const bf16_t*)(A.ws + E_XS);
    const int s0 = ((const int*)(A.ws + TB_SLOT))[row * 2], s1 = ((const int*)(A.ws + TB_SLOT))[row * 2 + 1]; const float w0 = ((const float*)(A.ws + TB_GATE))[row * 2], w1 = ((const float*)(A.ws + TB_GATE))[row * 2 + 1];
    const float ref = sv[k * 4096 + gwv] + modprev[(size_t)b * 6144 + 5 * 1024 + col] * (w0 * bf2f(Y[(size_t)s0 * DM + col]) + w1 * bf2f(Y[(size_t)s1 * DM + col]));
    if (lane == 0) dg_put(A, k, dg_rel(A.out[(size_t)row * DM + col], ref));
}
__device__ __forceinline__ void dg_lruin(const Args& A, int k) {
    const int lane = threadIdx.x & 63, gwv = blockIdx.x * 8 + (threadIdx.x >> 6);
    const unsigned h = dg_hash(gwv, k); const int row = h & (MTOK - 1), col = (h >> 16) % 2560;
    float a = 0.f; for (int kk = lane; kk < DM; kk += 64) a += bf2f(((const bf16_t*)(A.ws + WS_HM))[(size_t)row * DM + kk]) * dg_bfr(A.in[I_LRWIN][(size_t)kk * 2560 + col]);
    a = wave_sum(a);
    float ref, got;
    if (col < LRUW) { ref = 0.5f * a * (1.0f + tanhf(0.7978845608028654f * (a + 0.044715f * a * a * a))); got = bf2f(((const bf16_t*)(A.ws + L_YB))[(size_t)row * LRUW + col]); }
    else { ref = a; got = bf2f(((const bf16_t*)(A.ws + L_XB))[(size_t)row * LRUW + col - LRUW]); }
    if (lane == 0) dg_put(A, k, dg_rel(got, ref));
}
__device__ __forceinline__ void dg_lru(const Args& A, int k) {
    const int lane = threadIdx.x & 63, gwv = blockIdx.x * 8 + (threadIdx.x >> 6);
    const unsigned h = dg_hash(gwv, k); const int b = h & 7, ch = (h >> 3) % LRUW, tc = (h >> 16) & (SEQ - 1), n = ch / 128, j = ch % 128;
    const bf16_t* XB = (const bf16_t*)(A.ws + L_XB) + (size_t)b * SEQ * LRUW;
    float hres[2];
    for (int d = 0; d < 2; ++d) {
        const float* wa = A.in[I_LRWA] + (size_t)(d * 10 + n) * 16384; const float* wx = A.in[I_LRWX] + (size_t)(d * 10 + n) * 16384;
        const float wa0 = dg_bfr(wa[lane * 128 + j]), wa1 = dg_bfr(wa[(lane + 64) * 128 + j]), wx0 = dg_bfr(wx[lane * 128 + j]), wx1 = dg_bfr(wx[(lane + 64) * 128 + j]);
        const float ba = A.in[I_LRBA][d * LRUW + ch], bx = A.in[I_LRBX][d * LRUW + ch]; const float lam = A.in[I_LRLAM][d * LRUW + ch]; const float sp = log1pf(expf(-lam));
        float hs = 0.f;
        for (int i = 0; ; ++i) { const int t = d ? (SEQ - 1 - i) : i;
            float x0 = A.in[I_LRCB][n * 128 + lane], x1 = A.in[I_LRCB][n * 128 + 64 + lane], xj = A.in[I_LRCB][ch];
            for (int w = 0; w < 4; ++w) { const int tt = t - 1 + w; if (tt >= 0 && tt < SEQ) {
                x0 += A.in[I_LRCW][w * LRUW + n * 128 + lane] * bf2f(XB[(size_t)tt * LRUW + n * 128 + lane]); x1 += A.in[I_LRCW][w * LRUW + n * 128 + 64 + lane] * bf2f(XB[(size_t)tt * LRUW + n * 128 + 64 + lane]);
                xj += A.in[I_LRCW][w * LRUW + ch] * bf2f(XB[(size_t)tt * LRUW + ch]); } }
            const float rp = wave_sum(dg_bfr(x0) * wa0 + dg_bfr(x1) * wa1), ip = wave_sum(dg_bfr(x0) * wx0 + dg_bfr(x1) * wx1);
            const float rg = 1.0f / (1.0f + expf(-(rp + ba))), ig = 1.0f / (1.0f + expf(-(ip + bx))); const float la = -8.0f * rg * sp;
            hs = expf(la) * hs + sqrtf(fmaxf(-expm1f(2.0f * la), 0.f)) * ig * xj;
            if (t == tc) break; }
        hres[d] = hs;
    }
    const size_t go = ((size_t)b * SEQ + tc) * LRUW + ch;
    const float e1 = fabsf(bf2f(((const bf16_t*)(A.ws + L_HF))[go]) - hres[0]) / (fabsf(hres[0]) + 0.3f);
    const float ref = (hres[0] + hres[1]) * bf2f(((const bf16_t*)(A.ws + L_YB))[go]);
    const float e2 = fabsf(bf2f(((const bf16_t*)(A.ws + L_HY))[go]) - ref) / (fabsf(ref) + 0.3f);
    if (lane == 0) { dg_put(A, k, e1); dg_put(A, k + 5, e2); }
}
__device__ __forceinline__ void dg_final(const Args& A, int nchk) {
    const unsigned* sl = (const unsigned*)(A.ws + WS_CTL) + DG_BASE; int code = 0; float ev = 0.f;
    for (int k = 1; k <= nchk; ++k) { const float e = __uint_as_float(sl[64 * k]); if (e > 0.05f) { code = k; ev = e; break; } }
    if (code == 0) return;
    const int c1 = code % 10, c10 = code / 10;
    const float s = -(float)c1;
    for (size_t i = (size_t)blockIdx.x * NTHR + threadIdx.x; i < (size_t)MTOK * DM; i += (size_t)gridDim.x * NTHR) A.out[i] = A.in[I_X][i] * s;
    __syncthreads();
    if (blockIdx.x == 0 && threadIdx.x == 0) { const int qq = ev < 0.1f ? 1 : ev < 0.2f ? 2 : ev < 0.5f ? 3 : ev < 1.f ? 4 : ev < 2.f ? 5 : ev < 5.f ? 6 : ev < 20.f ? 7 : ev < 1e3f ? 8 : 9;
        A.out[12345] = 100.f * (float)(10 * c10 + qq); }
}
#define DG(x) x
#define DGL(x) if constexpr (L >= DIAG_FROM) { x }
#else
#define DG(x)
#define DGL(x)
#endif

#define GRID_BAR() xcd_barrier(bar)
template <int L>
__device__ __forceinline__ void run_mixer(const Args& args, LAS unsigned char* lds, int bid, int G, const XcdBarrier& bar) {
    unsigned char* ws = args.ws; bf16_t* xo = (bf16_t*)(ws + WS_XB);
    const float* modl = (const float*)(ws + TB_MODS) + (size_t)L * NBATCH * 6144;
    const void* xs = (L == 0) ? (const void*)args.in[I_X] : (const void*)xo; constexpr bool X16 = (L != 0);
    constexpr int kind = L % 3;
    DGL(if (L > 0 && ((L - 1) & 1)) { dg_save(args, 10 * (L - 1) + 9, xo); GRID_BAR(); })
    constexpr bool F8Q = (L == 3);
    norm_phase<false>(args, lds, bid, G, xs, X16, xo, true, args.in[I_N1G] + L * DM, modl, 0, (L > 0) && ((L - 1) & 1), modl - NBATCH * 6144, false, nullptr, F8Q);
    GRID_BAR();
    DGL(if (L > 0 && ((L - 1) & 1)) { dg_combine(args, 10 * (L - 1) + 9, modl - NBATCH * 6144); GRID_BAR(); })
    DGL(dg_norm(args, 10 * L + 1, (L > 0 && ((L - 1) & 1)) ? xo : xs, args.in[I_N1G] + L * DM, L, 0); GRID_BAR();)
    if constexpr (kind == 0) {
        constexpr int al = L / 3;
        {
            pg8::Gemm g{(const bf16_t*)(ws + WS_HM), (const bf16_t*)(ws + W_QKV) + (size_t)al * 3072 * 1024, F8Q ? 512 : 1024};
            pg8::TileOrder S; S.init(256, 12, G, bid);
            pg8::EpiQKV E{(bf16_t*)(ws + A_Q), (bf16_t*)(ws + A_K), (bf16_t*)(ws + A_V), args.in[I_ATQN] + al * 64, args.in[I_ATKN] + al * 64,
                          (const float*)(ws + TB_COS), (const float*)(ws + TB_SIN), LOG2E, F8Q ? 1.0f / MOE_WSCALE : 1.0f};
            pg8::gemm_phase<pg8::EpiQKV, F8Q>(lds, g, S, E);
        }
        GRID_BAR();
        vt_phase(args, bid, G);
        GRID_BAR();
        attn_phase(args, lds, bid, G, al);
        GRID_BAR();
        DGL(dg_save(args, 10 * L + 4, xs); GRID_BAR();)
        {
            pg8::Gemm g{(const bf16_t*)(ws + WS_HM), (const bf16_t*)(ws + W_AO) + (size_t)al * 1024 * 1024, F8Q ? 512 : 1024};
            pg8::TileOrder S; S.init(256, 4, G, bid);
            pg8::EpiRes<X16> E{xs, xo, modl + 2 * 1024, F8Q ? 1.0f / MOE_WSCALE : 1.0f};
            pg8::gemm_phase<pg8::EpiRes<X16>, F8Q>(lds, g, S, E);
        }
        GRID_BAR();
        DGL(dg_res(args, 10 * L + 4, xo, modl + 2 * 1024, (const bf16_t*)(ws + WS_HM), 1024, args.in[I_ATWOUT] + (size_t)al * 1024 * 1024); GRID_BAR();)
    }
    if constexpr (kind == 1) {
        {
            pg8::Gemm g{(const bf16_t*)(ws + WS_HM), (const bf16_t*)(ws + W_HGI), 1024};
            pg8::TileOrder S; S.init(256, 20, G, bid);
            pg8::EpiAct E{0, ws, (const float*)(ws + TB_LB)};
            pg8::gemm_phase<pg8::EpiAct>(lds, g, S, E);
        }
        GRID_BAR();
        DGL(dg_hgin(args, 10 * L + 2); GRID_BAR();)
        gla_phase(args, lds, bid, G);
        GRID_BAR();
        DGL(dg_gla(args, 10 * L + 3); GRID_BAR();)
        hg_normo_phase(args, bid, G);
        GRID_BAR();
        DGL(dg_normo(args, 10 * L + 0); GRID_BAR();)
        DGL(dg_save(args, 10 * L + 4, xs); GRID_BAR();)
        {
            pg8::Gemm g{(const bf16_t*)(ws + WS_HM), (const bf16_t*)(ws + W_HGO), 1024};
            pg8::TileOrder S; S.init(256, 4, G, bid);
            pg8::EpiRes<X16> E{xs, xo, modl + 2 * 1024, 1.0f};
            pg8::gemm_phase<pg8::EpiRes<X16>>(lds, g, S, E);
        }
        GRID_BAR();
        DGL(dg_res(args, 10 * L + 4, xo, modl + 2 * 1024, (const bf16_t*)(ws + WS_HM), 1024, args.in[I_HGWOUT]); GRID_BAR();)
    }
    if constexpr (kind == 2) {
        {
            pg8::Gemm g{(const bf16_t*)(ws + WS_HM), (const bf16_t*)(ws + W_LRI), 1024};
            pg8::TileOrder S; S.init(256, 10, G, bid);
            pg8::EpiAct E{1, ws, nullptr};
            pg8::gemm_phase<pg8::EpiAct>(lds, g, S, E);
        }
        GRID_BAR();
        DGL(dg_lruin(args, 10 * L + 2); GRID_BAR();)
        lru_phase<0>(args, lds, bid, G);
        GRID_BAR();
        lru_carry_phase(args, bid, G);
        GRID_BAR();
        lru_apply_phase(args, lds, bid, G);
        GRID_BAR();
        DGL(dg_lru(args, 10 * L + 3); GRID_BAR();)
        DGL(dg_save(args, 10 * L + 4, xs); GRID_BAR();)
        {
            pg8::Gemm g{(const bf16_t*)(ws + L_HY), (const bf16_t*)(ws + W_LRO), LRUW};
            pg8::TileOrder S; S.init(256, 4, G, bid);
            pg8::EpiRes<X16> E{xs, xo, modl + 2 * 1024, 1.0f};
            pg8::gemm_phase<pg8::EpiRes<X16>>(lds, g, S, E);
        }
        GRID_BAR();
        DGL(dg_res(args, 10 * L + 4, xo, modl + 2 * 1024, (const bf16_t*)(ws + L_HY), LRUW, args.in[I_LRWOUT]); GRID_BAR();)
    }
}
template <int L>
__device__ __forceinline__ void run_ffn(const Args& args, LAS unsigned char* lds, int bid, int G, const XcdBarrier& bar) {
    unsigned char* ws = args.ws; bf16_t* xo = (bf16_t*)(ws + WS_XB);
    const float* modl = (const float*)(ws + TB_MODS) + (size_t)L * NBATCH * 6144;
    if constexpr ((L & 1) == 0) {
        constexpr int m = L >> 1;
        constexpr bool F8 = (L >= FP8_DENSE_FROM);
        norm_phase<false>(args, lds, bid, G, xo, true, xo, true, args.in[I_N2G] + L * DM, modl, 1, false, modl, false, nullptr, F8);
        GRID_BAR();
        if constexpr (F8) {
            pg8::Gemm g{(const bf16_t*)(ws + WS_HM), (const bf16_t*)(ws + W_FGU) + (size_t)m * 5632 * 1024, 512};
            pg8::TileOrder S; S.init(256, 22, G, bid);
            pg8::EpiSwiGLU8 E{ws + F_HID, DFF, 1.0f / MOE_WSCALE, MOE_HSCALE};
            pg8::gemm_phase<pg8::EpiSwiGLU8, true>(lds, g, S, E);
        } else {
            pg8::Gemm g{(const bf16_t*)(ws + WS_HM), (const bf16_t*)(ws + W_FGU) + (size_t)m * 5632 * 1024, 1024};
            pg8::TileOrder S; S.init(256, 22, G, bid);
            pg8::EpiSwiGLU E{(bf16_t*)(ws + F_HID), DFF};
            pg8::gemm_phase<pg8::EpiSwiGLU>(lds, g, S, E);
        }
        GRID_BAR();
        if constexpr (F8) {
            pg8::Gemm g{(const bf16_t*)(ws + F_HID), (const bf16_t*)(ws + W_FDN) + (size_t)m * 1024 * 2816, DFF / 2};
            pg8::TileOrder S; S.init(256, 4, G, bid);
            pg8::EpiRes<true> E{xo, xo, modl + 5 * 1024, 1.0f / (MOE_WSCALE * MOE_HSCALE)};
            pg8::gemm_phase<pg8::EpiRes<true>, true>(lds, g, S, E);
        } else {
            pg8::Gemm g{(const bf16_t*)(ws + F_HID), (const bf16_t*)(ws + W_FDN) + (size_t)m * 1024 * 2816, DFF};
            pg8::TileOrder S; S.init(256, 4, G, bid);
            pg8::EpiRes<true> E{xo, xo, modl + 5 * 1024, 1.0f};
            pg8::gemm_phase<pg8::EpiRes<true>>(lds, g, S, E);
        }
        GRID_BAR();
    } else {
        constexpr int m = L >> 1;
        norm_phase<true>(args, lds, bid, G, xo, true, xo, true, args.in[I_N2G] + L * DM, modl, 1, false, modl, false, args.in[I_MOER] + (size_t)m * DM * 8, true);
        GRID_BAR();
        DGL(dg_norm(args, 10 * L + 5, xo, args.in[I_N2G] + L * DM, L, 1); dg_router(args, 10 * L + 5, L); GRID_BAR();)
        place_phase(args, lds, bid, G);
        GRID_BAR();
        DGL(dg_place(args, 10 * L + 6); GRID_BAR();)
        const int* tiles = (const int*)(ws + TB_TILES);
        {
            pg8::Gemm g{(const bf16_t*)(ws + E_XS), (const bf16_t*)(ws + W_MGU + (size_t)m * 8 * 7168 * 1024), 512};
            pg8::TileOrder S; S.init(tiles[8], 28, G, bid);
#pragma unroll
            for (int e = 1; e < NEXP; ++e) S.ts[e] = tiles[e];
            pg8::EpiSwiGLU8 E{ws + E_HID, DFFE, 1.0f / MOE_WSCALE, MOE_HSCALE};
            pg8::gemm_phase<pg8::EpiSwiGLU8, true>(lds, g, S, E);
        }
        GRID_BAR();
        DGL(dg_moe_hid(args, 10 * L + 7, m); GRID_BAR();)
        {
            pg8::Gemm g{(const bf16_t*)(ws + E_HID), (const bf16_t*)(ws + W_MDN + (size_t)m * 8 * 1024 * 3584), DFFE / 2};
            pg8::TileOrder S; S.init(tiles[8], 4, G, bid);
#pragma unroll
            for (int e = 1; e < NEXP; ++e) S.ts[e] = tiles[e];
            pg8::EpiPlain E{(bf16_t*)(ws + E_XS), DM, 1.0f / (MOE_WSCALE * MOE_HSCALE)};
            pg8::gemm_phase<pg8::EpiPlain, true>(lds, g, S, E);
        }
        GRID_BAR();
        DGL(dg_moe_y(args, 10 * L + 8, m); GRID_BAR();)
    }
}
__device__ __forceinline__ void final_combine(const Args& args, LAS unsigned char* lds, int bid, int G, const XcdBarrier& bar) {
    const float* modl = (const float*)(args.ws + TB_MODS) + (size_t)3 * NBATCH * 6144;
    DG(dg_save(args, 39, args.out); GRID_BAR();)
    norm_phase<false>(args, lds, bid, G, args.ws + WS_XB, true, args.out, false, args.in[I_N1G], modl, 0, true, modl, true, nullptr);
    DG(GRID_BAR(); dg_combine(args, 39, modl);)
}

__global__ void __launch_bounds__(NTHR, 2) mega_fwd(Args args) {
    extern __shared__ __attribute__((aligned(16))) unsigned char lds_raw[];
    LAS unsigned char* lds = (LAS unsigned char*)lds_raw;
    const int tid = threadIdx.x, bid = blockIdx.x, G = gridDim.x;
    unsigned char* ws = args.ws;
    volatile LAS unsigned* MISC = (volatile LAS unsigned*)(lds + MISC_OFF);
    if (tid < 64) MISC[tid] = 0u;
    __syncthreads();
    XcdBarrier bar = xcd_barrier_post((unsigned*)(ws + WS_CTL) + CW_BAR, MISC + 8);

    prologue_phase(args, lds, bid, G);
    GRID_BAR();

    run_mixer<0>(args, lds, bid, G, bar);
    run_ffn<0>(args, lds, bid, G, bar);
    run_mixer<1>(args, lds, bid, G, bar);
    run_ffn<1>(args, lds, bid, G, bar);
    run_mixer<2>(args, lds, bid, G, bar);
    run_ffn<2>(args, lds, bid, G, bar);
    run_mixer<3>(args, lds, bid, G, bar);
    run_ffn<3>(args, lds, bid, G, bar);
    final_combine(args, lds, bid, G, bar);
    DG(GRID_BAR(); dg_final(args, 49);)
}

extern "C" void kernel_launch(void* const* d_in, const int* in_sizes, int n_in, void* d_out, int out_size, void* d_ws, size_t ws_size, hipStream_t stream) {
    static int grid = 0;
    if (grid == 0) {
        if (n_in != 30 || out_size != MTOK * DM || ws_size < WS_NEED) { fprintf(stderr, "kernel_launch: unexpected shapes (n_in %d out %d ws %zu need %zu)\n", n_in, out_size, ws_size, (size_t)WS_NEED); grid = -1; return; }
        int dev = 0, cus = 0;
        if (hipGetDevice(&dev) != hipSuccess || hipDeviceGetAttribute(&cus, hipDeviceAttributeMultiprocessorCount, dev) != hipSuccess) { grid = -1; return; }
        if (hipFuncSetAttribute((const void*)mega_fwd, hipFuncAttributeMaxDynamicSharedMemorySize, LDS_BYTES) != hipSuccess) { fprintf(stderr, "kernel_launch: hipFuncSetAttribute failed\n"); grid = -1; return; }
        int per_cu = 0;
        if (hipOccupancyMaxActiveBlocksPerMultiprocessor(&per_cu, (const void*)mega_fwd, NTHR, LDS_BYTES) != hipSuccess || per_cu < 1) { fprintf(stderr, "kernel_launch: occupancy query says %d\n", per_cu); }
        (void)hipGetLastError();
        grid = (cus >= 256) ? 256 : -1;
        if (grid < 0) { fprintf(stderr, "kernel_launch: needs 256 CUs, device has %d\n", cus); return; }
    }
    if (grid < 0) return;
    if (hipMemsetAsync((char*)d_ws + WS_CTL, 0, CTL_ZERO_BYTES, stream) != hipSuccess) return;
    Args a{};
    for (int i = 0; i < 30; ++i) a.in[i] = (const float*)d_in[i];
    a.out = (float*)d_out; a.ws = (unsigned char*)d_ws;
    hipLaunchKernelGGL(mega_fwd, dim3(grid), dim3(NTHR), LDS_BYTES, stream, a);
}
```

```cpp
#define DIAG_FROM 2
#include <hip/hip_runtime.h>
#include <cstdio>
#include <cstdint>

#define LAS __attribute__((address_space(3)))
#define GAS __attribute__((address_space(1)))
typedef unsigned short bf16_t;
typedef short bf16x8 __attribute__((ext_vector_type(8)));
typedef short s16x4 __attribute__((ext_vector_type(4)));
typedef float f32x2 __attribute__((ext_vector_type(2)));
typedef float f32x4 __attribute__((ext_vector_type(4)));
typedef float f32x16 __attribute__((ext_vector_type(16)));
typedef unsigned u32x2 __attribute__((ext_vector_type(2)));
typedef unsigned u32x4 __attribute__((ext_vector_type(4)));

constexpr int MTOK = 65536, DM = 1024, SEQ = 8192, NBATCH = 8, DEPTH = 4;
constexpr int DFF = 2816, DFFE = 3584, NEXP = 8, LRUW = 1280;
constexpr float EPS = 1e-6f;
constexpr int FP8_DENSE_FROM = 2;
constexpr float MOE_WSCALE = 64.0f, MOE_HSCALE = 4.0f;
constexpr float LOG2E = 1.4426950408889634f;

constexpr size_t MiB = 1u << 20;
constexpr size_t WS_CTL = 0, CTL_ZERO_BYTES = 1 * MiB;
constexpr size_t WS_TAB = 1 * MiB;
constexpr size_t TB_MODS = WS_TAB;
constexpr size_t TB_COS = WS_TAB + 1 * MiB;
constexpr size_t TB_SIN = WS_TAB + 2 * MiB;
constexpr size_t TB_SCAL = WS_TAB + 3 * MiB;
constexpr size_t TB_LB = TB_SCAL + 4096;
constexpr size_t TB_SP = TB_SCAL + 16384;
constexpr size_t TB_EID = WS_TAB + 4 * MiB;
constexpr size_t TB_GATE = WS_TAB + 5 * MiB;
constexpr size_t TB_SLOT = WS_TAB + 6 * MiB;
constexpr size_t TB_BCNT = WS_TAB + 7 * MiB;
constexpr size_t TB_TILES = TB_BCNT + 16384;
constexpr size_t TB_LSUM = WS_TAB + 8 * MiB;
constexpr size_t TB_LCIN = WS_TAB + 16 * MiB;
constexpr size_t WS_W = 32 * MiB;
constexpr size_t W_QKV = WS_W;
constexpr size_t W_AO = W_QKV + 2 * (size_t)3072 * 1024 * 2;
constexpr size_t W_HGI = W_AO + 2 * (size_t)1024 * 1024 * 2;
constexpr size_t W_HGO = W_HGI + (size_t)5120 * 1024 * 2;
constexpr size_t W_LRI = W_HGO + (size_t)1024 * 1024 * 2;
constexpr size_t W_LRG = W_LRI + (size_t)2560 * 1024 * 2;
constexpr size_t W_LRO = W_LRG + (size_t)10 * 2 * 256 * 128 * 2;
constexpr size_t W_FGU = W_LRO + (size_t)1024 * 1280 * 2;
constexpr size_t W_FDN = W_FGU + 2 * (size_t)5632 * 1024 * 2;
constexpr size_t W_MGU = W_FDN + 2 * (size_t)1024 * 2816 * 2;
constexpr size_t W_MDN = W_MGU + 16 * (size_t)7168 * 1024 * 2;
constexpr size_t W_END = W_MDN + 16 * (size_t)1024 * 3584 * 2;
constexpr size_t WS_HM = 440 * MiB;
constexpr size_t WS_ACT = 568 * MiB;
static_assert(W_END <= WS_HM, "weights overflow");
constexpr size_t SZ_TOK = (size_t)MTOK * 1024 * 2;
constexpr size_t A_Q = WS_ACT, A_K = A_Q + SZ_TOK, A_V = A_K + SZ_TOK, A_VT = A_V + SZ_TOK;
constexpr size_t F_HID = WS_ACT;
constexpr size_t H_Q = WS_ACT, H_LFF = H_Q + SZ_TOK, H_LFB = H_LFF + SZ_TOK, H_V = H_LFB + SZ_TOK, H_G = H_V + SZ_TOK, H_OF = H_G + SZ_TOK, H_OB = H_OF + SZ_TOK;
constexpr size_t SZ_LRU = (size_t)MTOK * 1280 * 2;
constexpr size_t L_YB = WS_ACT, L_XB = L_YB + SZ_LRU, L_HF = L_XB + SZ_LRU, L_HY = L_HF + SZ_LRU, L_U = L_HY + SZ_LRU;
constexpr int MOE_ROWS = 2 * MTOK + NEXP * 256;
constexpr size_t E_XS = WS_ACT, E_HID = E_XS + (size_t)MOE_ROWS * 1024 * 2, E_END = E_HID + (size_t)MOE_ROWS * DFFE;
constexpr size_t WS_XB = 1536 * MiB;
static_assert(E_END <= WS_XB && H_OB + SZ_TOK <= WS_XB && L_U + 2 * SZ_LRU <= WS_XB && A_VT + SZ_TOK <= WS_XB, "activation regions below the residual stream");
constexpr size_t WS_NEED = WS_XB + SZ_TOK;
static_assert(WS_NEED <= (size_t)1792 * MiB, "workspace");

constexpr int CW_BAR = 4096;

constexpr int RING_BYTES = 135168;
constexpr int MISC_OFF = RING_BYTES;
constexpr int LDS_BYTES = 147456;
constexpr int NWAVES = 8, NTHR = 512;

typedef __bf16 bf16x2v __attribute__((ext_vector_type(2)));
__device__ __forceinline__ unsigned cvt_pk_bf16(float lo, float hi) { const f32x2 v = {lo, hi}; const bf16x2v b = __builtin_convertvector(v, bf16x2v); return __builtin_bit_cast(unsigned, b); }
__device__ __forceinline__ unsigned pk_fp8x4(float a, float b, float c, float d) { unsigned w = 0; w = __builtin_amdgcn_cvt_pk_fp8_f32(a, b, w, false); w = __builtin_amdgcn_cvt_pk_fp8_f32(c, d, w, true); return w; }
__device__ __forceinline__ unsigned f2bf(float f) { unsigned u = __builtin_bit_cast(unsigned, f); return (u + 0x7fffu + ((u >> 16) & 1u)) >> 16; }
__device__ __forceinline__ float bf2f(unsigned short b) { return __builtin_bit_cast(float, ((unsigned)b) << 16); }
__device__ __forceinline__ float bflo(unsigned w) { return __builtin_bit_cast(float, w << 16); }
__device__ __forceinline__ float bfhi(unsigned w) { return __builtin_bit_cast(float, w & 0xffff0000u); }
__device__ __forceinline__ float fexp2(float x) { return __builtin_amdgcn_exp2f(x); }
__device__ __forceinline__ float fexp(float x) { return __builtin_amdgcn_exp2f(x * LOG2E); }
__device__ __forceinline__ float frcp(float x) { return __builtin_amdgcn_rcpf(x); }
__device__ __forceinline__ float fsigmoid(float x) { return frcp(1.0f + fexp(-x)); }
__device__ __forceinline__ float fsilu(float x) { return x * fsigmoid(x); }
__device__ __forceinline__ float wave_sum(float v) {
#pragma unroll
    for (int o = 1; o < 64; o <<= 1) v += __shfl_xor(v, o);
    return v;
}
#define LDS_WAIT() asm volatile("s_waitcnt lgkmcnt(0)" ::: "memory")
#define VM_WAIT() asm volatile("s_waitcnt vmcnt(0)" ::: "memory")

#define XB_TMO      128
#define XB_XCNT(j)  (256  + 64 * (j))
#define XB_XSUB(j)  (1280 + 64 * (j))
#define XB_XGEN(j)  (2304 + 64 * (j))
#define XB_TOP      3328
#define XB_TOPGEN   3392
#define XCD_BAR_WORDS 3456
#define XB_SPIN_CAP (1u << 22)
__device__ __forceinline__ unsigned xb_ld(unsigned* p)              { return __hip_atomic_load(p, __ATOMIC_RELAXED, __HIP_MEMORY_SCOPE_AGENT); }
__device__ __forceinline__ unsigned xb_add(unsigned* p, unsigned v) { return __hip_atomic_fetch_add(p, v, __ATOMIC_RELAXED, __HIP_MEMORY_SCOPE_AGENT); }
__device__ __forceinline__ unsigned xb_xcc_id() { return (unsigned)__builtin_amdgcn_s_getreg((3 << 11) | 20) & 0xFu; }
#define XB_SPIN(cond, bar) do { unsigned _sp = 0; while (cond) { __builtin_amdgcn_s_sleep(1); \
    if ((++_sp & 255u) == 0u) { if (xb_ld(&(bar)[XB_TMO])) break; if (_sp > XB_SPIN_CAP) { atomicAdd(&(bar)[XB_TMO], 1u); break; } } } } while (0)
struct XcdBarrier { unsigned* bar; unsigned x; volatile LAS unsigned* st; };
__device__ __forceinline__ XcdBarrier xcd_barrier_post(unsigned* bar, volatile LAS unsigned* st) {
    XcdBarrier b; b.bar = bar; b.x = xb_xcc_id(); b.st = st;
    if (threadIdx.x == 0) (void)xb_add(&bar[XB_XCNT(b.x)], 1u);
    return b;
}
__device__ __forceinline__ void xcd_barrier_complete(unsigned* bar, unsigned x, unsigned& nloc, unsigned& nx) {
    const unsigned G = gridDim.x * gridDim.y * gridDim.z;
    unsigned sum, cnt, mine, sp = 0u;
    for (;;) {
        sum = 0u; cnt = 0u; mine = 0u;
#pragma unroll
        for (unsigned j = 0; j < 16; ++j) { const unsigned c = xb_ld(&bar[XB_XCNT(j)]); sum += c; cnt += (c > 0u) ? 1u : 0u; mine = (j == x) ? c : mine; }
        if (sum == G) break;
        __builtin_amdgcn_s_sleep(1);
        if ((++sp & 255u) == 0u) { if (xb_ld(&bar[XB_TMO])) break; if (sp > XB_SPIN_CAP) { atomicAdd(&bar[XB_TMO], 1u); break; } }
    }
    nloc = mine > 0u ? mine : 1u; nx = cnt > 0u ? cnt : 1u;
}
__device__ __forceinline__ void xcd_barrier(const XcdBarrier& b) {
    asm volatile("s_waitcnt vmcnt(0)" ::: "memory");
    __syncthreads();
    if (threadIdx.x == 0) {
        unsigned* bar = b.bar;
        __builtin_amdgcn_s_waitcnt(0);
        unsigned nloc = b.st[0], nx = b.st[1];
        if (nloc == 0u) { xcd_barrier_complete(bar, b.x, nloc, nx); b.st[0] = nloc; b.st[1] = nx; }
        const unsigned old = xb_add(&bar[XB_XSUB(b.x)], 1u);
        const unsigned gen = old / nloc;
        if (old + 1u == (gen + 1u) * nloc) {
            __builtin_amdgcn_fence(__ATOMIC_RELEASE, "agent");
            asm volatile("s_waitcnt vmcnt(0)" ::: "memory");
            const unsigned og = xb_add(&bar[XB_TOP], 1u);
            const unsigned tg = og / nx;
            if (og + 1u == (tg + 1u) * nx) xb_add(&bar[XB_TOPGEN], 1u);
            else XB_SPIN(xb_ld(&bar[XB_TOPGEN]) == tg, bar);
            __builtin_amdgcn_fence(__ATOMIC_ACQUIRE, "agent");
            xb_add(&bar[XB_XGEN(b.x)], 1u);
            asm volatile("s_waitcnt vmcnt(0)" ::: "memory");
        } else {
            XB_SPIN(xb_ld(&bar[XB_XGEN(b.x)]) == gen, bar);
            __builtin_amdgcn_fence(__ATOMIC_ACQUIRE, "agent");
            asm volatile("s_waitcnt vmcnt(0)" ::: "memory");
        }
    }
    __syncthreads();
}

namespace pg8 {
constexpr int BM = 256, BK = 64, HALF = 128, HTB = HALF * BK * 2, STAGE_BYTES = 8 * HTB, NXCD = 8, WGM = 8;
__host__ __device__ __forceinline__ int lds_byte(int r, int c) { const int st = (r >> 4) * 2 + (c >> 5), rr = r & 15, cc = c & 31, ob = rr * 64 + cc * 2; return st * 1024 + (ob ^ (((ob >> 9) & 1) << 5)); }
__host__ __device__ __forceinline__ void stage_rc(int b, int& R, int& C) { const int st = b / 1024, sb = b % 1024, swz = sb ^ (((sb >> 9) & 1) << 5); R = (st >> 1) * 16 + swz / 64; C = (st & 1) * 32 + (swz % 64) / 2; }
__host__ __device__ __forceinline__ int perm32(int rho) { const int n = rho >> 4, i = rho & 15; return 8 * (i >> 2) + 4 * n + (i & 3); }

struct Unit { int pm, pn, pb; };
struct Gemm { const bf16_t* A; const bf16_t* Bt; int K; };

struct TileOrder {
    int nM, nN, nwg, G, c; int ts[NEXP];
    __device__ __forceinline__ void init(int nM_, int nN_, int G_, int c_) { nM = nM_; nN = nN_; nwg = nM * nN; G = G_; c = c_;
#pragma unroll
        for (int e = 0; e < NEXP; ++e) ts[e] = (e == 0) ? 0 : 0x7fffffff; }
    __device__ __forceinline__ bool next(int i, Unit& u) const {
        const long L = (long)i * G + c; if (L >= nwg) return false;
        int wgid = (int)L; { const int q = nwg / NXCD, r = nwg % NXCD, xcd = wgid % NXCD, off = wgid / NXCD; wgid = (xcd < r ? xcd * (q + 1) : r * (q + 1) + (xcd - r) * q) + off; }
        const int nig = WGM * nN, gid = wgid / nig, fm = gid * WGM, gsz = (nM - fm) < WGM ? (nM - fm) : WGM;
        u.pm = fm + ((wgid % nig) % gsz); u.pn = (wgid % nig) / gsz;
        int e = 0;
#pragma unroll
        for (int k = 1; k < NEXP; ++k) e += (u.pm >= ts[k]) ? 1 : 0;
        u.pb = e * nN + u.pn; return true;
    }
};

typedef int v8i32 __attribute__((ext_vector_type(8)));
template <class Epi, bool FP8 = false>
__device__ __forceinline__ void gemm_phase(LAS unsigned char* lds, const Gemm g, const TileOrder& S, const Epi& E) {
    int tid_ = threadIdx.x; asm volatile("" : "+v"(tid_));
    const int tid = tid_, wid = __builtin_amdgcn_readfirstlane(tid >> 6), lane = tid & 63, wr = wid >> 2, wc = wid & 3, fr = lane & 15, fq = lane >> 4;
    const int K = g.K, nt = K / BK;
    unsigned voffA[2], voffB[2];
#pragma unroll
    for (int i = 0; i < 2; ++i) { int R, C; stage_rc(tid * 16 + i * 8192, R, C); const int Rb = Epi::PERM ? ((R & ~31) + perm32(R & 31)) : R;
        voffA[i] = (unsigned)(R * K + C) * 2u; voffB[i] = (unsigned)(Rb * K + C) * 2u; }
    const size_t kstep = (size_t)(BK * 2);
    const size_t hstep = (size_t)HALF * K * 2;
    const size_t tstep = 2 * hstep;
    const unsigned ldsw = (unsigned)wid * 1024u;
    const int aoff = lds_byte(wr * 64 + fr, fq * 8), boff = lds_byte(wc * 32 + fr, fq * 8);
#define PG8_SA(b, h) (((b) * 2 + (h)) * HTB)
#define PG8_SB(b, h) ((4 + (b) * 2 + (h)) * HTB)
#define PG8_STAGE(bufoff, gbase, voff) do { _Pragma("unroll") for (int _i = 0; _i < 2; ++_i) \
        __builtin_amdgcn_global_load_lds((const unsigned*)((const char*)(gbase) + (voff)[_i]), (LAS unsigned*)(lds + (bufoff) + ldsw + _i * 8192), 16, 0, 0); } while (0)
#define PG8_LD8(p) __builtin_bit_cast(v8i32, __builtin_shufflevector(*(const LAS u32x4*)(p), *(const LAS u32x4*)((p) + 1024), 0, 1, 2, 3, 4, 5, 6, 7))
#define PG8_LDA(dst, b, h) do { if constexpr (FP8) { _Pragma("unroll") for (int m = 0; m < 4; ++m) dst##8[m] = PG8_LD8(lds + PG8_SA(b, h) + aoff + m * 2048); } \
        else { _Pragma("unroll") for (int m = 0; m < 4; ++m) _Pragma("unroll") for (int k = 0; k < 2; ++k) dst[m][k] = *(const LAS bf16x8*)(lds + PG8_SA(b, h) + aoff + m * 2048 + k * 1024); } } while (0)
#define PG8_LDB(dst, b, h) do { if constexpr (FP8) { _Pragma("unroll") for (int n = 0; n < 2; ++n) dst##8[n] = PG8_LD8(lds + PG8_SB(b, h) + boff + n * 2048); } \
        else { _Pragma("unroll") for (int n = 0; n < 2; ++n) _Pragma("unroll") for (int k = 0; k < 2; ++k) dst[n][k] = *(const LAS bf16x8*)(lds + PG8_SB(b, h) + boff + n * 2048 + k * 1024); } } while (0)
#define PG8_MMA(ai, bj, At, Bt) do { __builtin_amdgcn_s_setprio(1); \
        if constexpr (FP8) { _Pragma("unroll") for (int m = 0; m < 4; ++m) _Pragma("unroll") for (int n = 0; n < 2; ++n) \
            asm volatile("v_mfma_scale_f32_16x16x128_f8f6f4 %0, %1, %2, %0, %3, %3 op_sel_hi:[0,0,0]" : "+v"(acc[ai][bj][m][n]) : "v"(Bt##8[n]), "v"(At##8[m]), "v"(one_scale)); } \
        else { _Pragma("unroll") for (int m = 0; m < 4; ++m) _Pragma("unroll") for (int n = 0; n < 2; ++n) _Pragma("unroll") for (int k = 0; k < 2; ++k) \
            acc[ai][bj][m][n] = __builtin_amdgcn_mfma_f32_16x16x32_bf16(Bt[n][k], At[m][k], acc[ai][bj][m][n], 0, 0, 0); } \
        __builtin_amdgcn_s_setprio(0); } while (0)
#define PG8_WAIT_V(n) asm volatile("s_waitcnt vmcnt(" #n ")" ::: "memory")
#define PG8_WAIT_L(n) asm volatile("s_waitcnt lgkmcnt(" #n ")" ::: "memory")
#define PG8_BAR __builtin_amdgcn_s_barrier()
#define PG8_SCHED __builtin_amdgcn_sched_barrier(0)
    Unit cur, nxt; int ui = 0;
    if (!S.next(0, cur)) return;
    f32x4 acc[2][2][4][2];
#pragma unroll
    for (int a = 0; a < 2; ++a)
#pragma unroll
        for (int b = 0; b < 2; ++b)
#pragma unroll
            for (int m = 0; m < 4; ++m)
#pragma unroll
                for (int n = 0; n < 2; ++n) acc[a][b][m][n] = (f32x4){0.f, 0.f, 0.f, 0.f};
    bf16x8 At[4][2], B0[2][2], B1[2][2]; v8i32 At8[4], B08[2], B18[2];
    int one_scale = 0x7f7f7f7f; asm volatile("" : "+v"(one_scale));
    const char* cA = (const char*)g.A + (size_t)cur.pm * tstep; const char* cB = (const char*)g.Bt + (size_t)cur.pb * tstep;
    PG8_STAGE(PG8_SB(0, 0), cB, voffB); PG8_STAGE(PG8_SA(0, 0), cA, voffA); PG8_STAGE(PG8_SB(0, 1), cB + hstep, voffB); PG8_STAGE(PG8_SA(0, 1), cA + hstep, voffA);
    if (wr == 1) PG8_BAR;
    PG8_WAIT_V(4); PG8_BAR;
    PG8_STAGE(PG8_SB(1, 0), cB + kstep, voffB); PG8_STAGE(PG8_SA(1, 0), cA + kstep, voffA); PG8_STAGE(PG8_SB(1, 1), cB + hstep + kstep, voffB);
    PG8_WAIT_V(6); PG8_BAR;
    for (;;) {
        const bool has_next = S.next(ui + 1, nxt);
        const char* nA = has_next ? (const char*)g.A + (size_t)nxt.pm * tstep : cA; const char* nB = has_next ? (const char*)g.Bt + (size_t)nxt.pb * tstep : cB;
        for (int t = 0; t < nt; t += 2) {
            const bool last = (t == nt - 2);
            const char* a1 = cA + (size_t)(t + 1) * kstep;
            const char* a2 = last ? nA : cA + (size_t)(t + 2) * kstep; const char* b2 = last ? nB : cB + (size_t)(t + 2) * kstep;
            const char* a3 = a2 + kstep; const char* b3 = b2 + kstep;
            PG8_LDB(B0, 0, 0); PG8_SCHED; PG8_LDA(At, 0, 0); PG8_STAGE(PG8_SA(1, 1), a1 + hstep, voffA);
            PG8_WAIT_L(8); PG8_BAR; PG8_WAIT_L(0); PG8_MMA(0, 0, At, B0); PG8_BAR; PG8_SCHED;
            PG8_LDB(B1, 0, 1); PG8_STAGE(PG8_SB(0, 0), b2, voffB);
            PG8_BAR; PG8_WAIT_L(0); PG8_MMA(0, 1, At, B1); PG8_BAR;
            PG8_LDA(At, 0, 1); PG8_STAGE(PG8_SA(0, 0), a2, voffA);
            PG8_BAR; PG8_WAIT_L(0); PG8_MMA(1, 0, At, B0); PG8_BAR; PG8_SCHED;
            PG8_STAGE(PG8_SB(0, 1), b2 + hstep, voffB);
            PG8_WAIT_V(6); PG8_BAR; PG8_MMA(1, 1, At, B1); PG8_BAR;
            PG8_LDB(B0, 1, 0); PG8_SCHED; PG8_LDA(At, 1, 0); PG8_STAGE(PG8_SA(0, 1), a2 + hstep, voffA);
            PG8_WAIT_L(8); PG8_BAR; PG8_WAIT_L(0); PG8_MMA(0, 0, At, B0); PG8_BAR; PG8_SCHED;
            PG8_LDB(B1, 1, 1); PG8_STAGE(PG8_SB(1, 0), b3, voffB);
            PG8_BAR; PG8_WAIT_L(0); PG8_MMA(0, 1, At, B1); PG8_BAR;
            PG8_LDA(At, 1, 1); PG8_STAGE(PG8_SA(1, 0), a3, voffA);
            PG8_BAR; PG8_WAIT_L(0); PG8_MMA(1, 0, At, B0); PG8_BAR; PG8_SCHED;
            PG8_STAGE(PG8_SB(1, 1), b3 + hstep, voffB);
            PG8_WAIT_V(6); PG8_BAR; PG8_MMA(1, 1, At, B1); PG8_BAR;
        }
        if constexpr (FP8) asm volatile("s_nop 15\n\ts_nop 15" ::: "memory");
        E(acc, cur, wr, wc, fr, fq);
        if (!has_next) break;
#pragma unroll
        for (int a = 0; a < 2; ++a)
#pragma unroll
            for (int b = 0; b < 2; ++b)
#pragma unroll
                for (int m = 0; m < 4; ++m)
#pragma unroll
                    for (int n = 0; n < 2; ++n) acc[a][b][m][n] = (f32x4){0.f, 0.f, 0.f, 0.f};
        cur = nxt; cA = nA; cB = nB; ++ui;
    }
    PG8_WAIT_V(0);
    if (wr == 0) PG8_BAR;
    PG8_BAR;
#undef PG8_SA
#undef PG8_SB
#undef PG8_STAGE
#undef PG8_LDA
#undef PG8_LDB
#undef PG8_MMA
#undef PG8_LD8
#undef PG8_WAIT_V
#undef PG8_WAIT_L
#undef PG8_BAR
#undef PG8_SCHED
}

struct EpiQKV {
    static constexpr bool PERM = true;
    bf16_t *Q, *Kk, *V; const float *gq, *gk, *cosT, *sinT; float qscale, isc;
    __device__ __forceinline__ void operator()(const f32x4 (&acc)[2][2][4][2], const Unit& u, int wr, int wc, int fr, int fq) const {
        const int row0 = u.pm * BM + wr * 64 + fr;
        if (u.pn >= 8) {
            const int col0 = (u.pn - 8) * BM + wc * 32 + 8 * fq;
#pragma unroll
            for (int ai = 0; ai < 2; ++ai)
#pragma unroll
                for (int m = 0; m < 4; ++m) { bf16_t* rowp = V + (size_t)(row0 + ai * HALF + m * 16) * DM + col0;
#pragma unroll
                    for (int bj = 0; bj < 2; ++bj) { const f32x4 v0 = acc[ai][bj][m][0] * isc, v1 = acc[ai][bj][m][1] * isc;
                        u32x4 w; w.x = cvt_pk_bf16(v0[0], v0[1]); w.y = cvt_pk_bf16(v0[2], v0[3]); w.z = cvt_pk_bf16(v1[0], v1[1]); w.w = cvt_pk_bf16(v1[2], v1[3]);
                        *(u32x4*)(rowp + bj * HALF) = w; } }
        } else {
            const int part = u.pn >> 2, sh = 4 * (u.pn & 3) + wc;
            bf16_t* dst = part ? Kk : Q; const float* g = part ? gk : gq; const float sc = part ? 1.0f : qscale;
            f32x4 g0[2], g1[2];
#pragma unroll
            for (int n = 0; n < 2; ++n) { g0[n] = *(const f32x4*)(g + 8 * fq + 4 * n); g1[n] = *(const f32x4*)(g + 32 + 8 * fq + 4 * n); }
#pragma unroll
            for (int ai = 0; ai < 2; ++ai)
#pragma unroll
                for (int m = 0; m < 4; ++m) {
                    const int r = row0 + ai * HALF + m * 16; const int pos = r & (SEQ - 1);
                    f32x4 x1[2], x2[2]; float ss = 0.f;
#pragma unroll
                    for (int n = 0; n < 2; ++n) { x1[n] = acc[ai][0][m][n]; x2[n] = acc[ai][1][m][n];
                        ss += (x1[n][0] * x1[n][0] + x1[n][1] * x1[n][1]) + (x1[n][2] * x1[n][2] + x1[n][3] * x1[n][3]);
                        ss += (x2[n][0] * x2[n][0] + x2[n][1] * x2[n][1]) + (x2[n][2] * x2[n][2] + x2[n][3] * x2[n][3]); }
                    ss += __shfl_xor(ss, 16); ss += __shfl_xor(ss, 32);
                    const float rstd = __builtin_amdgcn_rsqf(ss * (isc * isc * (1.0f / 64.0f)) + EPS) * isc;
                    unsigned char* op = (unsigned char*)dst + (size_t)r * DM + sh * 64 + 8 * fq;
                    u32x2 w1, w2;
#pragma unroll
                    for (int n = 0; n < 2; ++n) {
                        const f32x4 cs = *(const f32x4*)(cosT + pos * 32 + 8 * fq + 4 * n), sn = *(const f32x4*)(sinT + pos * 32 + 8 * fq + 4 * n);
                        const f32x4 y1 = x1[n] * rstd * g0[n], y2 = x2[n] * rstd * g1[n];
                        const f32x4 o1 = (y1 * cs - y2 * sn) * sc, o2 = (y2 * cs + y1 * sn) * sc;
                        if (n == 0) { w1.x = pk_fp8x4(o1[0], o1[1], o1[2], o1[3]); w2.x = pk_fp8x4(o2[0], o2[1], o2[2], o2[3]); }
                        else { w1.y = pk_fp8x4(o1[0], o1[1], o1[2], o1[3]); w2.y = pk_fp8x4(o2[0], o2[1], o2[2], o2[3]); }
                    }
                    *(u32x2*)(op) = w1; *(u32x2*)(op + 32) = w2;
                }
        }
    }
};
__device__ __forceinline__ f32x4 ld_x4(const void* p, size_t i, bool is16) {
    if (is16) { const u32x2 w = *(const u32x2*)((const bf16_t*)p + i); return (f32x4){bflo(w.x), bfhi(w.x), bflo(w.y), bfhi(w.y)}; }
    return *(const f32x4*)((const float*)p + i);
}
template <bool IN16>
struct EpiRes {
    static constexpr bool PERM = false;
    const void* xin; bf16_t* xout; const float* gate; float sc;
    __device__ __forceinline__ void operator()(const f32x4 (&acc)[2][2][4][2], const Unit& u, int wr, int wc, int fr, int fq) const {
        const int row0 = u.pm * BM + wr * 64 + fr, col0 = u.pn * BM + wc * 32 + 4 * fq;
        const float* gp = gate + (size_t)(u.pm >> 5) * 6144 + col0;
        f32x4 gv[2][2];
#pragma unroll
        for (int bj = 0; bj < 2; ++bj)
#pragma unroll
            for (int n = 0; n < 2; ++n) gv[bj][n] = *(const f32x4*)(gp + bj * HALF + n * 16) * sc;
#pragma unroll
        for (int ai = 0; ai < 2; ++ai)
#pragma unroll
            for (int m = 0; m < 4; ++m) { const size_t off = (size_t)(row0 + ai * HALF + m * 16) * DM + col0;
                f32x4 xv[2][2];
#pragma unroll
                for (int bj = 0; bj < 2; ++bj)
#pragma unroll
                    for (int n = 0; n < 2; ++n) xv[bj][n] = ld_x4(xin, off + bj * HALF + n * 16, IN16);
#pragma unroll
                for (int bj = 0; bj < 2; ++bj)
#pragma unroll
                    for (int n = 0; n < 2; ++n) { const f32x4 o = xv[bj][n] + gv[bj][n] * acc[ai][bj][m][n];
                        *(u32x2*)(xout + off + bj * HALF + n * 16) = (u32x2){cvt_pk_bf16(o[0], o[1]), cvt_pk_bf16(o[2], o[3])}; }
                if (m == 3) asm volatile("" ::: "memory"); }
    }
};
struct EpiSwiGLU {
    static constexpr bool PERM = true;
    bf16_t* H; int ldh;
    __device__ __forceinline__ void operator()(const f32x4 (&acc)[2][2][4][2], const Unit& u, int wr, int wc, int fr, int fq) const {
        const int row0 = u.pm * BM + wr * 64 + fr, col0 = u.pn * HALF + wc * 32 + 8 * fq;
#pragma unroll
        for (int ai = 0; ai < 2; ++ai)
#pragma unroll
            for (int m = 0; m < 4; ++m) { bf16_t* rowp = H + (size_t)(row0 + ai * HALF + m * 16) * ldh + col0;
                f32x4 v[2];
#pragma unroll
                for (int n = 0; n < 2; ++n) { const f32x4 gt = acc[ai][0][m][n], up = acc[ai][1][m][n];
#pragma unroll
                    for (int j = 0; j < 4; ++j) v[n][j] = fsilu(gt[j]) * up[j]; }
                u32x4 w; w.x = cvt_pk_bf16(v[0][0], v[0][1]); w.y = cvt_pk_bf16(v[0][2], v[0][3]); w.z = cvt_pk_bf16(v[1][0], v[1][1]); w.w = cvt_pk_bf16(v[1][2], v[1][3]);
                *(u32x4*)rowp = w; }
    }
};
struct EpiSwiGLU8 {
    static constexpr bool PERM = true;
    unsigned char* H; int ldh; float ws, hs;
    __device__ __forceinline__ void operator()(const f32x4 (&acc)[2][2][4][2], const Unit& u, int wr, int wc, int fr, int fq) const {
        const int row0 = u.pm * BM + wr * 64 + fr, col0 = u.pn * HALF + wc * 32 + 8 * fq;
#pragma unroll
        for (int ai = 0; ai < 2; ++ai)
#pragma unroll
            for (int m = 0; m < 4; ++m) { unsigned char* rowp = H + (size_t)(row0 + ai * HALF + m * 16) * ldh + col0;
                f32x4 v[2];
#pragma unroll
                for (int n = 0; n < 2; ++n) { const f32x4 gt = acc[ai][0][m][n] * ws, up = acc[ai][1][m][n] * (ws * hs);
#pragma unroll
                    for (int j = 0; j < 4; ++j) v[n][j] = fsilu(gt[j]) * up[j]; }
                *(u32x2*)rowp = (u32x2){pk_fp8x4(v[0][0], v[0][1], v[0][2], v[0][3]), pk_fp8x4(v[1][0], v[1][1], v[1][2], v[1][3])}; }
    }
};
struct EpiPlain {
    static constexpr bool PERM = true;
    bf16_t* O; int ldc; float sc;
    __device__ __forceinline__ void operator()(const f32x4 (&acc)[2][2][4][2], const Unit& u, int wr, int wc, int fr, int fq) const {
        const int row0 = u.pm * BM + wr * 64 + fr, col0 = u.pn * BM + wc * 32 + 8 * fq;
#pragma unroll
        for (int ai = 0; ai < 2; ++ai)
#pragma unroll
            for (int m = 0; m < 4; ++m) { bf16_t* rowp = O + (size_t)(row0 + ai * HALF + m * 16) * ldc + col0;
#pragma unroll
                for (int bj = 0; bj < 2; ++bj) { const f32x4 v0 = acc[ai][bj][m][0] * sc, v1 = acc[ai][bj][m][1] * sc;
                    u32x4 w; w.x = cvt_pk_bf16(v0[0], v0[1]); w.y = cvt_pk_bf16(v0[2], v0[3]); w.z = cvt_pk_bf16(v1[0], v1[1]); w.w = cvt_pk_bf16(v1[2], v1[3]);
                    *(u32x4*)(rowp + bj * HALF) = w; } }
    }
};
struct EpiAct {
    static constexpr bool PERM = true;
    int kind; unsigned char* ws; const float* lb;
    __device__ __forceinline__ void operator()(const f32x4 (&acc)[2][2][4][2], const Unit& u, int wr, int wc, int fr, int fq) const {
        const int row0 = u.pm * BM + wr * 64 + fr;
        int mode, ldc, colt; size_t boff;
        if (kind == 0) { const int grp = u.pn >> 2; colt = (u.pn & 3) * 256; ldc = 1024;
            boff = grp == 0 ? H_Q : grp == 1 ? H_LFF : grp == 2 ? H_LFB : grp == 3 ? H_V : H_G; mode = (grp == 0 || grp == 4) ? 1 : (grp == 3 ? 0 : 3); }
        else { ldc = LRUW; if (u.pn < 5) { boff = L_YB; colt = u.pn * 256; mode = 2; } else { boff = L_XB; colt = (u.pn - 5) * 256; mode = 0; } }
        bf16_t* base = (bf16_t*)(ws + boff);
        const int col0 = colt + wc * 32 + 8 * fq;
        f32x4 lbv[2][2];
        if (mode == 3) { const float* lp = lb + ((u.pn >> 2) - 1) * 1024 + col0;
#pragma unroll
            for (int bj = 0; bj < 2; ++bj)
#pragma unroll
                for (int n = 0; n < 2; ++n) lbv[bj][n] = *(const f32x4*)(lp + bj * HALF + 4 * n); }
#pragma unroll
        for (int ai = 0; ai < 2; ++ai)
#pragma unroll
            for (int m = 0; m < 4; ++m) { bf16_t* rowp = base + (size_t)(row0 + ai * HALF + m * 16) * ldc + col0;
#pragma unroll
                for (int bj = 0; bj < 2; ++bj) { f32x4 v[2]; u32x4 w;
#pragma unroll
                    for (int n = 0; n < 2; ++n) { v[n] = acc[ai][bj][m][n];
                        if (mode == 1) {
#pragma unroll
                            for (int j = 0; j < 4; ++j) v[n][j] = fsilu(v[n][j]); }
                        else if (mode == 2) {
#pragma unroll
                            for (int j = 0; j < 4; ++j) { const float x = v[n][j]; v[n][j] = x * fsigmoid(1.5957691216057308f * (x + 0.044715f * x * x * x)); } }
                        else if (mode == 3) {
#pragma unroll
                            for (int j = 0; j < 4; ++j) { const float l = lbv[bj][n][j]; const float fg = l + (1.0f - l) * fsigmoid(v[n][j]); v[n][j] = __builtin_amdgcn_logf(fg) * 0.6931471805599453f; } }
                    }
                    if (mode == 3) {
#pragma unroll
                        for (int n = 0; n < 2; ++n) { const _Float16 h0 = (_Float16)v[n][0], h1 = (_Float16)v[n][1], h2 = (_Float16)v[n][2], h3 = (_Float16)v[n][3];
                            const unsigned a = (unsigned)__builtin_bit_cast(unsigned short, h0) | ((unsigned)__builtin_bit_cast(unsigned short, h1) << 16);
                            const unsigned b = (unsigned)__builtin_bit_cast(unsigned short, h2) | ((unsigned)__builtin_bit_cast(unsigned short, h3) << 16);
                            if (n == 0) { w.x = a; w.y = b; } else { w.z = a; w.w = b; } }
                    } else { w.x = cvt_pk_bf16(v[0][0], v[0][1]); w.y = cvt_pk_bf16(v[0][2], v[0][3]); w.z = cvt_pk_bf16(v[1][0], v[1][1]); w.w = cvt_pk_bf16(v[1][2], v[1][3]); }
                    *(u32x4*)(rowp + bj * HALF) = w; } }
    }
};
}

struct Args { const float* in[30]; float* out; unsigned char* ws; };
enum { I_X = 0, I_C, I_ADAW, I_ADAB, I_N1G, I_N2G, I_ATWIN, I_ATQN, I_ATKN, I_ATLAM, I_ATSUB, I_ATWOUT, I_HGWIN, I_HGLB, I_HGNG, I_HGWOUT,
       I_LRWIN, I_LRCW, I_LRCB, I_LRWA, I_LRBA, I_LRWX, I_LRBX, I_LRLAM, I_LRWOUT, I_FFGU, I_FFDN, I_MOER, I_MOEGU, I_MOEDN };
enum { SC_LAM0 = 0, SC_LAM1, SC_OML0, SC_OML1, SC_MC0, SC_MC1 };

__device__ __forceinline__ void cvt_item(const float* W, int ldw, int src_col0, bf16_t* WT, int ldt, int dst_row0, int k0, LAS float* scr, int lane) {
#pragma unroll 8
    for (int i = 0; i < 32; ++i) { const int kk = 2 * i + (lane >> 5); scr[kk * 33 + (lane & 31)] = W[(size_t)(k0 + kk) * ldw + src_col0 + (lane & 31)]; }
    LDS_WAIT(); asm volatile("" ::: "memory");
    const int c = lane & 7;
#pragma unroll
    for (int j = 0; j < 4; ++j) { const int n = (lane >> 3) + 8 * j; const LAS float* s = scr + (8 * c) * 33 + n;
        u32x4 o; o.x = cvt_pk_bf16(s[0 * 33], s[1 * 33]); o.y = cvt_pk_bf16(s[2 * 33], s[3 * 33]); o.z = cvt_pk_bf16(s[4 * 33], s[5 * 33]); o.w = cvt_pk_bf16(s[6 * 33], s[7 * 33]);
        *(u32x4*)(WT + (size_t)(dst_row0 + n) * ldt + k0 + 8 * c) = o; }
    LDS_WAIT(); asm volatile("" ::: "memory");
}
__device__ __forceinline__ void cvt_item8(const float* W, int ldw, int src_col0, unsigned char* WT, int ldt, int dst_row0, int k0, float sc, LAS float* scr, int lane) {
#pragma unroll 8
    for (int i = 0; i < 32; ++i) { const int kk = 2 * i + (lane >> 5); scr[kk * 33 + (lane & 31)] = W[(size_t)(k0 + kk) * ldw + src_col0 + (lane & 31)]; }
    LDS_WAIT(); asm volatile("" ::: "memory");
    const int c = lane & 7;
#pragma unroll
    for (int j = 0; j < 4; ++j) { const int n = (lane >> 3) + 8 * j; const LAS float* s = scr + (8 * c) * 33 + n;
        *(u32x2*)(WT + (size_t)(dst_row0 + n) * ldt + k0 + 8 * c) = (u32x2){pk_fp8x4(s[0 * 33] * sc, s[1 * 33] * sc, s[2 * 33] * sc, s[3 * 33] * sc), pk_fp8x4(s[4 * 33] * sc, s[5 * 33] * sc, s[6 * 33] * sc, s[7 * 33] * sc)}; }
    LDS_WAIT(); asm volatile("" ::: "memory");
}
enum { MAP_ID = 0, MAP_QKV = 1, MAP_SWI = 2 };
template <bool F8 = false>
__device__ __forceinline__ void cvt_family(const float* src, size_t sstride, int ninst, int ldw, int K, int ng, int map, int F, bf16_t* dst, size_t dstride,
                                           LAS float* scr, int gw, int NGW, int lane) {
    const int nkb = K / 64, per = nkb * ng, total = ninst * per;
    for (int it = gw; it < total; it += NGW) {
        const int inst = it / per, r = it - inst * per, kb = r / ng, gi = r - kb * ng;
        int sc0;
        if (map == MAP_ID) sc0 = 32 * gi;
        else if (map == MAP_QKV) { const int pn = gi >> 3, bj = (gi >> 2) & 1, wc = gi & 3;
            if (pn < 8) { const int part = pn >> 2, sh = 4 * (pn & 3) + wc; sc0 = part * 1024 + sh * 64 + 32 * bj; } else sc0 = 32 * gi; }
        else { const int pn = gi >> 3, bj = (gi >> 2) & 1, q = gi & 3; sc0 = bj * F + pn * 128 + 32 * q; }
        if constexpr (F8) cvt_item8(src + (size_t)inst * sstride, ldw, sc0, (unsigned char*)dst + (size_t)inst * dstride, K, 32 * gi, 64 * kb, MOE_WSCALE, scr, lane);
        else cvt_item(src + (size_t)inst * sstride, ldw, sc0, dst + (size_t)inst * dstride, K, 32 * gi, 64 * kb, scr, lane);
    }
}

__device__ __forceinline__ void prologue_phase(const Args& A, LAS unsigned char* lds, int bid, int G) {
    const int tid = threadIdx.x, lane = tid & 63, wave = tid >> 6;
    unsigned char* ws = A.ws;
    {
        LAS float* sc = (LAS float*)lds;
        LAS float* red = (LAS float*)(lds + 32768);
        for (int i = tid; i < NBATCH * DM; i += NTHR) { const float cv = A.in[I_C][i]; sc[i] = fsilu(cv); }
        __syncthreads();
        float* mods = (float*)(ws + TB_MODS);
        for (int cb = bid; cb < (DEPTH * 6144) / 128; cb += G) {
            const int col = cb * 128 + (tid & 127), l = col / 6144, e = col - l * 6144, ch = tid >> 7;
            const float* wp = A.in[I_ADAW] + (size_t)l * DM * 6144 + e;
            float a[NBATCH];
#pragma unroll
            for (int b = 0; b < NBATCH; ++b) a[b] = 0.f;
#pragma unroll 4
            for (int d = ch * 256; d < ch * 256 + 256; ++d) { const float w = wp[(size_t)d * 6144];
#pragma unroll
                for (int b = 0; b < NBATCH; ++b) a[b] += sc[b * DM + d] * w; }
#pragma unroll
            for (int b = 0; b < NBATCH; ++b) red[(ch * 128 + (tid & 127)) * 8 + b] = a[b];
            __syncthreads();
            if (tid < 128) { const float bias = A.in[I_ADAB][l * 6144 + e];
#pragma unroll
                for (int b = 0; b < NBATCH; ++b) { const float s = ((red[(0 * 128 + tid) * 8 + b] + red[(1 * 128 + tid) * 8 + b]) + (red[(2 * 128 + tid) * 8 + b] + red[(3 * 128 + tid) * 8 + b])) + bias;
                    mods[((size_t)l * NBATCH + b) * 6144 + e] = s; } }
            __syncthreads();
        }
    }
    {
        float* cosT = (float*)(ws + TB_COS); float* sinT = (float*)(ws + TB_SIN);
        for (int i = bid * NTHR + tid; i < SEQ * 32; i += G * NTHR) {
            const int pos = i >> 5, d = i & 31;
            const float inv = (float)exp(-(double)d * (1.0 / 32.0) * 9.210340371976184);
            const float ang = (float)pos * inv;
            const double rev = (double)ang * 0.15915494309189535; const float fr = (float)(rev - floor(rev));
            cosT[i] = __builtin_amdgcn_cosf(fr); sinT[i] = __builtin_amdgcn_sinf(fr);
        }
        if (bid == 0 && tid < 2) {
            const int a = tid; const float* lm = A.in[I_ATLAM] + a * 256;
            float s1 = 0.f, s2 = 0.f; for (int i = 0; i < 64; ++i) { s1 += lm[i] * lm[64 + i]; s2 += lm[128 + i] * lm[192 + i]; }
            const float linit = 0.8f - 0.6f * expf(-0.3f * (float)(3 * a));
            float mq = 0.f, mk = 0.f; for (int i = 0; i < 64; ++i) { mq = fmaxf(mq, fabsf(A.in[I_ATQN][a * 64 + i])); mk = fmaxf(mk, fabsf(A.in[I_ATKN][a * 64 + i])); }
            float* scal = (float*)(ws + TB_SCAL);
            scal[SC_LAM0 + a] = expf(s1) - expf(s2) + linit; scal[SC_OML0 + a] = 1.0f - linit; scal[SC_MC0 + a] = 8.0f * mq * mk * LOG2E * 1.0001f;
        }
        if (bid == 1) {
            float* lb = (float*)(ws + TB_LB);
            for (int i = tid; i < 2 * 1024; i += NTHR) { const int d = i >> 10, k = i & 1023; const float* p = A.in[I_HGLB] + (size_t)d * DEPTH * 1024 + k;
                float mx = p[0]; for (int l = 1; l < DEPTH; ++l) mx = fmaxf(mx, p[l * 1024]);
                float den = 0.f, num = 0.f; for (int l = 0; l < DEPTH; ++l) { const float e = expf(p[l * 1024] - mx); den += e; if (l == 1) num += e; }
                lb[i] = num / den; }
        }
        if (bid == 2) {
            float* sp = (float*)(ws + TB_SP);
            for (int i = tid; i < 2 * LRUW; i += NTHR) { const float x = -A.in[I_LRLAM][i]; sp[i] = (x > 20.f) ? x : log1pf(expf(x)); }
        }
    }
    {
        LAS float* scr = (LAS float*)(lds + wave * 16384);
        const int vcu = (bid % 8) * (G / 8) + bid / 8;
        const int gw = vcu * NWAVES + wave, NGW = G * NWAVES;
        cvt_family(A.in[I_ATWIN], (size_t)1024 * 3072, 1, 3072, 1024, 96, MAP_QKV, 0, (bf16_t*)(ws + W_QKV), (size_t)3072 * 1024, scr, gw, NGW, lane);
        cvt_family<true>(A.in[I_ATWIN] + (size_t)1024 * 3072, 0, 1, 3072, 1024, 96, MAP_QKV, 0, (bf16_t*)(ws + W_QKV) + (size_t)3072 * 1024, 0, scr, gw, NGW, lane);
        cvt_family(A.in[I_ATWOUT], (size_t)1024 * 1024, 1, 1024, 1024, 32, MAP_ID, 0, (bf16_t*)(ws + W_AO), (size_t)1024 * 1024, scr, gw, NGW, lane);
        cvt_family<true>(A.in[I_ATWOUT] + (size_t)1024 * 1024, 0, 1, 1024, 1024, 32, MAP_ID, 0, (bf16_t*)(ws + W_AO) + (size_t)1024 * 1024, 0, scr, gw, NGW, lane);
        cvt_family(A.in[I_HGWIN], 0, 1, 5120, 1024, 160, MAP_ID, 0, (bf16_t*)(ws + W_HGI), 0, scr, gw, NGW, lane);
        cvt_family(A.in[I_HGWOUT], 0, 1, 1024, 1024, 32, MAP_ID, 0, (bf16_t*)(ws + W_HGO), 0, scr, gw, NGW, lane);
        cvt_family(A.in[I_LRWIN], 0, 1, 2560, 1024, 80, MAP_ID, 0, (bf16_t*)(ws + W_LRI), 0, scr, gw, NGW, lane);
        cvt_family(A.in[I_LRWOUT], 0, 1, 1024, 1280, 32, MAP_ID, 0, (bf16_t*)(ws + W_LRO), 0, scr, gw, NGW, lane);
        for (int it = gw; it < 2 * 20 * 2 * 4; it += NGW) {
            const int part = it / 160, r = it % 160, inst = r >> 3, kb = (r >> 2) & 1, gi = r & 3, d = inst / 10, n = inst % 10;
            const float* src = (part ? A.in[I_LRWX] : A.in[I_LRWA]) + (size_t)inst * 16384;
            cvt_item(src, 128, 32 * gi, (bf16_t*)(ws + W_LRG) + (size_t)(n * 2 + d) * 256 * 128, 128, part * 128 + 32 * gi, 64 * kb, scr, lane);
        }
        static_assert(FP8_DENSE_FROM == 2 || FP8_DENSE_FROM > 3, "dense layer 0 stays bf16; layer 2 optional");
        constexpr int NB16 = (FP8_DENSE_FROM == 2) ? 1 : 2;
        cvt_family(A.in[I_FFGU], (size_t)1024 * 5632, NB16, 5632, 1024, 176, MAP_SWI, DFF, (bf16_t*)(ws + W_FGU), (size_t)5632 * 1024, scr, gw, NGW, lane);
        cvt_family(A.in[I_FFDN], (size_t)2816 * 1024, NB16, 1024, 2816, 32, MAP_ID, 0, (bf16_t*)(ws + W_FDN), (size_t)1024 * 2816, scr, gw, NGW, lane);
        if constexpr (NB16 == 1) {
            cvt_family<true>(A.in[I_FFGU] + (size_t)1024 * 5632, 0, 1, 5632, 1024, 176, MAP_SWI, DFF, (bf16_t*)(ws + W_FGU) + (size_t)5632 * 1024, 0, scr, gw, NGW, lane);
            cvt_family<true>(A.in[I_FFDN] + (size_t)2816 * 1024, 0, 1, 1024, 2816, 32, MAP_ID, 0, (bf16_t*)(ws + W_FDN) + (size_t)1024 * 2816, 0, scr, gw, NGW, lane);
        }
        cvt_family<true>(A.in[I_MOEGU], (size_t)1024 * 7168, 16, 7168, 1024, 224, MAP_SWI, DFFE, (bf16_t*)(ws + W_MGU), (size_t)7168 * 1024, scr, gw, NGW, lane);
        cvt_family<true>(A.in[I_MOEDN], (size_t)3584 * 1024, 16, 1024, 3584, 32, MAP_ID, 0, (bf16_t*)(ws + W_MDN), (size_t)1024 * 3584, scr, gw, NGW, lane);
    }
}

template <bool ROUTER>
__device__ __forceinline__ void norm_phase(const Args& A, LAS unsigned char* lds, int bid, int G, const void* xsrc, bool src16, void* xdst, bool dst16, const float* gain, const float* modl  , int which,
                                           bool combine, const float* modprev  , bool nonorm, const float* router, bool f8out = false) {
    int tid_ = threadIdx.x; asm volatile("" : "+v"(tid_));
    const int tid = tid_, lane = tid & 63, wave = tid >> 6;
    unsigned char* ws = A.ws;
    bf16_t* HM = (bf16_t*)(ws + WS_HM);
    const int* slot = (const int*)(ws + TB_SLOT); const float* gts = (const float*)(ws + TB_GATE);
    const bf16_t* Y = (const bf16_t*)(ws + E_XS);
    LAS int* hist = (LAS int*)lds;
    for (int tb = bid; tb < MTOK / 256; tb += G) {
        const int b = tb >> 5;
        f32x4 ga[4], sh[4], g2[4];
#pragma unroll
        for (int j = 0; j < 4; ++j) { const int c = 256 * j + 4 * lane;
            if (!nonorm) { const f32x4 gv = *(const f32x4*)(gain + c), sv = *(const f32x4*)(modl + (size_t)b * 6144 + (which * 3 + 1) * 1024 + c);
                ga[j] = gv * (sv + 1.0f); sh[j] = *(const f32x4*)(modl + (size_t)b * 6144 + (which * 3) * 1024 + c); }
            if (combine) g2[j] = *(const f32x4*)(modprev + (size_t)b * 6144 + 5 * 1024 + c); }
        f32x4 rw[ROUTER ? 32 : 1];
        if constexpr (ROUTER) {
            if (tid < 8) hist[tid] = 0;
#pragma unroll
            for (int j = 0; j < 4; ++j)
#pragma unroll
                for (int i = 0; i < 4; ++i) { const int c = 256 * j + 4 * lane + i; rw[(j * 4 + i) * 2] = *(const f32x4*)(router + c * 8); rw[(j * 4 + i) * 2 + 1] = *(const f32x4*)(router + c * 8 + 4); }
            __syncthreads();
        }
        for (int i = 0; i < 32; ++i) {
            const int row = tb * 256 + wave * 32 + i;
            f32x4 v[4];
#pragma unroll
            for (int j = 0; j < 4; ++j) v[j] = pg8::ld_x4(xsrc, (size_t)row * DM + 256 * j + 4 * lane, src16);
            if (combine) {
                const int s0 = slot[row * 2], s1 = slot[row * 2 + 1]; const float w0 = gts[row * 2], w1 = gts[row * 2 + 1];
#pragma unroll
                for (int j = 0; j < 4; ++j) { const u32x2 a = *(const u32x2*)(Y + (size_t)s0 * DM + 256 * j + 4 * lane), c2 = *(const u32x2*)(Y + (size_t)s1 * DM + 256 * j + 4 * lane);
                    f32x4 y; y[0] = w0 * bflo(a.x) + w1 * bflo(c2.x); y[1] = w0 * bfhi(a.x) + w1 * bfhi(c2.x); y[2] = w0 * bflo(a.y) + w1 * bflo(c2.y); y[3] = w0 * bfhi(a.y) + w1 * bfhi(c2.y);
                    v[j] = v[j] + g2[j] * y;
                    if (dst16) *(u32x2*)((bf16_t*)xdst + (size_t)row * DM + 256 * j + 4 * lane) = (u32x2){cvt_pk_bf16(v[j][0], v[j][1]), cvt_pk_bf16(v[j][2], v[j][3])};
                    else *(f32x4*)((float*)xdst + (size_t)row * DM + 256 * j + 4 * lane) = v[j]; }
            }
            if (nonorm) continue;
            float ss = 0.f;
#pragma unroll
            for (int j = 0; j < 4; ++j) ss += (v[j][0] * v[j][0] + v[j][1] * v[j][1]) + (v[j][2] * v[j][2] + v[j][3] * v[j][3]);
            ss = wave_sum(ss);
            const float rstd = 1.0f / sqrtf(ss * (1.0f / DM) + EPS);
            f32x4 h[4];
#pragma unroll
            for (int j = 0; j < 4; ++j) { h[j] = v[j] * rstd * ga[j] + sh[j];
                if (f8out) { *(unsigned*)((unsigned char*)HM + (size_t)row * DM + 256 * j + 4 * lane) = pk_fp8x4(h[j][0], h[j][1], h[j][2], h[j][3]); }
                else { u32x2 w; w.x = cvt_pk_bf16(h[j][0], h[j][1]); w.y = cvt_pk_bf16(h[j][2], h[j][3]);
                    *(u32x2*)(HM + (size_t)row * DM + 256 * j + 4 * lane) = w; } }
            if constexpr (ROUTER) {
                float lg[8];
#pragma unroll
                for (int e = 0; e < 8; ++e) lg[e] = 0.f;
#pragma unroll
                for (int j = 0; j < 4; ++j)
#pragma unroll
                    for (int q = 0; q < 4; ++q) { const float hv = h[j][q]; const f32x4 r0 = rw[(j * 4 + q) * 2], r1 = rw[(j * 4 + q) * 2 + 1];
                        lg[0] += hv * r0[0]; lg[1] += hv * r0[1]; lg[2] += hv * r0[2]; lg[3] += hv * r0[3]; lg[4] += hv * r1[0]; lg[5] += hv * r1[1]; lg[6] += hv * r1[2]; lg[7] += hv * r1[3]; }
#pragma unroll
                for (int e = 0; e < 8; ++e) lg[e] = wave_sum(lg[e]);
                int e0 = 0; float v0 = lg[0];
#pragma unroll
                for (int e = 1; e < 8; ++e) if (lg[e] > v0) { v0 = lg[e]; e0 = e; }
                int e1 = -1; float v1 = -3.0e38f;
#pragma unroll
                for (int e = 0; e < 8; ++e) if (e != e0 && lg[e] > v1) { v1 = lg[e]; e1 = e; }
                const float p1 = frcp(1.0f + fexp(v1 - v0));
                if (lane == 0) { int* eid = (int*)(ws + TB_EID); float* gt = (float*)(ws + TB_GATE);
                    eid[row * 2] = e0; eid[row * 2 + 1] = e1; gt[row * 2] = p1; gt[row * 2 + 1] = 1.0f - p1;
                    atomicAdd((int*)&hist[e0], 1); atomicAdd((int*)&hist[e1], 1); }
            }
        }
        if constexpr (ROUTER) {
            __syncthreads();
            if (tid < 8) ((int*)(ws + TB_BCNT))[tb * 8 + tid] = hist[tid];
            __syncthreads();
        }
    }
}

namespace lru {
constexpr int XCF = 0, XCB = 16384, AA = 24576, UU = 40960, LAA = 57344;
__device__ __forceinline__ int sw256(int row, int cb) { return row * 256 + (cb ^ ((row & 15) << 4)); }
__device__ __forceinline__ int crow(int r, int hi) { return (r & 3) + 8 * (r >> 2) + 4 * hi; }
template <int MODE>
__device__ __forceinline__ void lru_item(const Args& A, LAS unsigned char* lds, int b, int n, int seg, int dir) {
    int tid_ = threadIdx.x; asm volatile("" : "+v"(tid_));
    const int tid = tid_, wid = tid >> 6, lane = tid & 63, r = lane & 31, hh = lane >> 5;
    unsigned char* ws = A.ws;
    const bf16_t* XB = (const bf16_t*)(ws + L_XB); const bf16_t* YB = (const bf16_t*)(ws + L_YB); bf16_t* HF = (bf16_t*)(ws + L_HF); bf16_t* HY = (bf16_t*)(ws + L_HY);
    bf16_t* LAg = (bf16_t*)(ws + (dir ? L_HY : L_HF)); bf16_t* Ug = (bf16_t*)(ws + L_U + (size_t)dir * SZ_LRU);
    const int ct = tid >> 4, cg = tid & 15, cc0 = n * 128 + 8 * cg;
    float carry = 0.f, P = 1.f;
    if (MODE != 0 && tid < 128) carry = ((const float*)(ws + TB_LCIN))[(size_t)((b * 32 + seg) * 2 + dir) * LRUW + n * 128 + tid];
    if constexpr (MODE == 0) {
        const bf16_t* Wg = (const bf16_t*)(ws + W_LRG) + (size_t)((n * 2 + dir) * 256 + ((r < 16) ? (16 * wid + r) : (128 + 16 * wid + r - 16))) * 128 + 8 * hh;
        bf16x8 bfrag[8];
#pragma unroll
        for (int ks = 0; ks < 8; ++ks) bfrag[ks] = *(const bf16x8*)(Wg + 16 * ks);
        const int cch = n * 128 + 16 * wid + (r & 15);
        const float nba = -LOG2E * A.in[I_LRBA][dir * LRUW + cch], nbx = -LOG2E * A.in[I_LRBX][dir * LRUW + cch], csp = -8.0f * LOG2E * ((const float*)(ws + TB_SP))[dir * LRUW + cch];
        float cw[4][8], cb[8];
#pragma unroll
        for (int j = 0; j < 8; ++j) { cb[j] = A.in[I_LRCB][cc0 + j];
#pragma unroll
            for (int w = 0; w < 4; ++w) cw[w][j] = A.in[I_LRCW][w * LRUW + cc0 + j]; }
        u32x4 xr[4];
#define LRU_XLOAD(si_) do { const int sub_ = dir ? (7 - (si_)) : (si_); const int tok_ = seg * 256 + sub_ * 32 + ct; \
        _Pragma("unroll") for (int w = 0; w < 4; ++w) { const int tt = tok_ - 1 + w; xr[w] = (tt >= 0 && tt < SEQ) ? *(const u32x4*)(XB + ((size_t)b * SEQ + tt) * LRUW + cc0) : (u32x4){0u, 0u, 0u, 0u}; } } while (0)
        LRU_XLOAD(0);
        for (int si = 0; si < 8; ++si) {
            const int sub = dir ? (7 - si) : si; const int t0 = seg * 256 + sub * 32;
            {
                float xc[8];
#pragma unroll
                for (int j = 0; j < 8; ++j) xc[j] = cb[j];
#pragma unroll
                for (int w = 0; w < 4; ++w) { const u32x4 v = xr[w];
#pragma unroll
                    for (int e = 0; e < 4; ++e) { xc[2 * e] += cw[w][2 * e] * bflo(v[e]); xc[2 * e + 1] += cw[w][2 * e + 1] * bfhi(v[e]); } }
                if (si + 1 < 8) LRU_XLOAD(si + 1);
                *(LAS f32x4*)(lds + XCF + (ct * 128 + 8 * cg) * 4) = (f32x4){xc[0], xc[1], xc[2], xc[3]};
                *(LAS f32x4*)(lds + XCF + (ct * 128 + 8 * cg + 4) * 4) = (f32x4){xc[4], xc[5], xc[6], xc[7]};
                *(LAS u32x4*)(lds + XCB + sw256(ct, 16 * cg)) = (u32x4){cvt_pk_bf16(xc[0], xc[1]), cvt_pk_bf16(xc[2], xc[3]), cvt_pk_bf16(xc[4], xc[5]), cvt_pk_bf16(xc[6], xc[7])};
            }
            __syncthreads();
            {
                f32x16 acc = {};
#pragma unroll
                for (int ks = 0; ks < 8; ++ks) { const bf16x8 fa = *(const LAS bf16x8*)(lds + XCB + sw256(r, (16 * ks + 8 * hh) * 2)); acc = __builtin_amdgcn_mfma_f32_32x32x16_bf16(fa, bfrag[ks], acc, 0, 0, 0); }
#pragma unroll
                for (int q = 0; q < 8; ++q) {
                    const auto sw = __builtin_amdgcn_permlane16_swap(__float_as_uint(acc[q]), __float_as_uint(acc[8 + q]), false, false);
                    const float rp = __uint_as_float(sw[0]), ip = __uint_as_float(sw[1]);
                    const int tq = crow((r < 16) ? q : (8 + q), hh); const int cl = 16 * wid + (r & 15);
                    const float xcv = ((const LAS float*)(lds + XCF))[tq * 128 + cl];
                    const float rg = frcp(1.0f + fexp2(fmaf(rp, -LOG2E, nba))), ig = frcp(1.0f + fexp2(fmaf(ip, -LOG2E, nbx)));
                    const float la = csp * rg, av = fexp2(la), uv = __builtin_amdgcn_sqrtf(fmaxf(fmaf(-av, av, 1.0f), 0.f)) * ig * xcv;
                    ((LAS float*)(lds + AA))[tq * 128 + cl] = av; ((LAS float*)(lds + UU))[tq * 128 + cl] = uv; ((LAS float*)(lds + LAA))[tq * 128 + cl] = la; }
            }
            __syncthreads();
            if (tid < 128) {
                LAS float* ap = (LAS float*)(lds + AA) + tid; LAS float* up = (LAS float*)(lds + UU) + tid; float av[32], uv[32];
#pragma unroll
                for (int i = 0; i < 32; ++i) { av[i] = ap[i * 128]; uv[i] = up[i * 128]; }
                if (dir == 0) {
#pragma unroll
                    for (int i = 0; i < 32; ++i) { carry = av[i] * carry + uv[i]; P *= av[i]; } }
                else {
#pragma unroll
                    for (int i = 31; i >= 0; --i) { carry = av[i] * carry + uv[i]; P *= av[i]; } }
            } else if (tid >= 256) {
                const int t2 = tid - 256, row = t2 >> 3, c16 = (t2 & 7) * 16; const size_t go = ((size_t)b * SEQ + t0 + row) * LRUW + n * 128 + c16;
                const LAS float* lp = (const LAS float*)(lds + LAA) + row * 128 + c16; const LAS float* up = (const LAS float*)(lds + UU) + row * 128 + c16;
                f32x4 l[4], u[4];
#pragma unroll
                for (int j = 0; j < 4; ++j) { l[j] = *(const LAS f32x4*)(lp + 4 * j); u[j] = *(const LAS f32x4*)(up + 4 * j); }
#pragma unroll
                for (int j = 0; j < 2; ++j) {
                    *(u32x4*)(LAg + go + 8 * j) = (u32x4){cvt_pk_bf16(l[2 * j][0], l[2 * j][1]), cvt_pk_bf16(l[2 * j][2], l[2 * j][3]), cvt_pk_bf16(l[2 * j + 1][0], l[2 * j + 1][1]), cvt_pk_bf16(l[2 * j + 1][2], l[2 * j + 1][3])};
                    *(u32x4*)(Ug + go + 8 * j) = (u32x4){cvt_pk_bf16(u[2 * j][0], u[2 * j][1]), cvt_pk_bf16(u[2 * j][2], u[2 * j][3]), cvt_pk_bf16(u[2 * j + 1][0], u[2 * j + 1][1]), cvt_pk_bf16(u[2 * j + 1][2], u[2 * j + 1][3])}; }
            }
            __syncthreads();
        }
#undef LRU_XLOAD
        if (tid < 128) { float* sm = (float*)(ws + TB_LSUM) + (size_t)(((b * 32 + seg) * 2 + dir) * 2) * LRUW + n * 128 + tid; sm[0] = P; sm[LRUW] = carry; }
    } else {
        u32x4 lr, ur;
#define LRU_GLOAD(si_) do { const int sub_ = dir ? (7 - (si_)) : (si_); const size_t go_ = ((size_t)b * SEQ + seg * 256 + sub_ * 32 + ct) * LRUW + cc0; \
        lr = *(const u32x4*)(LAg + go_); ur = *(const u32x4*)(Ug + go_); } while (0)
        LRU_GLOAD(0);
        for (int si = 0; si < 8; ++si) {
            const int sub = dir ? (7 - si) : si; const int t0 = seg * 256 + sub * 32;
            {   const u32x4 l = lr, u = ur;
                if (si + 1 < 8) LRU_GLOAD(si + 1);
                *(LAS f32x4*)(lds + AA + (ct * 128 + 8 * cg) * 4) = (f32x4){fexp2(bflo(l[0])), fexp2(bfhi(l[0])), fexp2(bflo(l[1])), fexp2(bfhi(l[1]))};
                *(LAS f32x4*)(lds + AA + (ct * 128 + 8 * cg + 4) * 4) = (f32x4){fexp2(bflo(l[2])), fexp2(bfhi(l[2])), fexp2(bflo(l[3])), fexp2(bfhi(l[3]))};
                *(LAS f32x4*)(lds + UU + (ct * 128 + 8 * cg) * 4) = (f32x4){bflo(u[0]), bfhi(u[0]), bflo(u[1]), bfhi(u[1])};
                *(LAS f32x4*)(lds + UU + (ct * 128 + 8 * cg + 4) * 4) = (f32x4){bflo(u[2]), bfhi(u[2]), bflo(u[3]), bfhi(u[3])}; }
            __syncthreads();
            if (tid < 128) {
                LAS float* ap = (LAS float*)(lds + AA) + tid; LAS float* up = (LAS float*)(lds + UU) + tid; float av[32], uv[32];
#pragma unroll
                for (int i = 0; i < 32; ++i) { av[i] = ap[i * 128]; uv[i] = up[i * 128]; }
                if (dir == 0) {
#pragma unroll
                    for (int i = 0; i < 32; ++i) { carry = av[i] * carry + uv[i]; uv[i] = carry; } }
                else {
#pragma unroll
                    for (int i = 31; i >= 0; --i) { carry = av[i] * carry + uv[i]; uv[i] = carry; } }
#pragma unroll
                for (int i = 0; i < 32; ++i) up[i * 128] = uv[i];
            }
            __syncthreads();
            {   const int tok = t0 + ct; const size_t go = ((size_t)b * SEQ + tok) * LRUW + cc0;
                const f32x4 h0 = *(const LAS f32x4*)(lds + UU + (ct * 128 + 8 * cg) * 4), h1 = *(const LAS f32x4*)(lds + UU + (ct * 128 + 8 * cg + 4) * 4);
                if (MODE == 1) { *(u32x4*)(HF + go) = (u32x4){cvt_pk_bf16(h0[0], h0[1]), cvt_pk_bf16(h0[2], h0[3]), cvt_pk_bf16(h1[0], h1[1]), cvt_pk_bf16(h1[2], h1[3])}; }
                else { const u32x4 f = *(const u32x4*)(HF + go), y = *(const u32x4*)(YB + go);
                    *(u32x4*)(HY + go) = (u32x4){cvt_pk_bf16((h0[0] + bflo(f[0])) * bflo(y[0]), (h0[1] + bfhi(f[0])) * bfhi(y[0])), cvt_pk_bf16((h0[2] + bflo(f[1])) * bflo(y[1]), (h0[3] + bfhi(f[1])) * bfhi(y[1])),
                                                cvt_pk_bf16((h1[0] + bflo(f[2])) * bflo(y[2]), (h1[1] + bfhi(f[2])) * bfhi(y[2])), cvt_pk_bf16((h1[2] + bflo(f[3])) * bflo(y[3]), (h1[3] + bfhi(f[3])) * bfhi(y[3]))}; }
            }
            __syncthreads();
        }
#undef LRU_GLOAD
    }
}
__device__ __forceinline__ void lru_apply_item(const Args& A, LAS unsigned char* lds, int b, int n, int seg) {
    constexpr int HFL = 57344;
    int tid_ = threadIdx.x; asm volatile("" : "+v"(tid_));
    const int tid = tid_;
    unsigned char* ws = A.ws;
    const bf16_t* YB = (const bf16_t*)(ws + L_YB); bf16_t* HY = (bf16_t*)(ws + L_HY);
    const int ct = tid >> 4, cg = tid & 15, cc0 = n * 128 + 8 * cg;
#pragma unroll 1
    for (int dir = 0; dir < 2; ++dir) {
        const bf16_t* LAg = (const bf16_t*)(ws + (dir ? L_HY : L_HF)); const bf16_t* Ug = (const bf16_t*)(ws + L_U + (size_t)dir * SZ_LRU);
        float carry = 0.f;
        if (tid < 128) carry = ((const float*)(ws + TB_LCIN))[(size_t)((b * 32 + seg) * 2 + dir) * LRUW + n * 128 + tid];
        u32x4 lr, ur, yr = {0u, 0u, 0u, 0u};
#define LRU_GLOAD(si_) do { const int sub_ = dir ? (7 - (si_)) : (si_); const size_t go_ = ((size_t)b * SEQ + seg * 256 + sub_ * 32 + ct) * LRUW + cc0; \
        lr = *(const u32x4*)(LAg + go_); ur = *(const u32x4*)(Ug + go_); if (dir) yr = *(const u32x4*)(YB + go_); } while (0)
        LRU_GLOAD(0);
        for (int si = 0; si < 8; ++si) {
            const int sub = dir ? (7 - si) : si; const int t0 = seg * 256 + sub * 32;
            const u32x4 l = lr, u = ur, y = yr;
            if (si + 1 < 8) LRU_GLOAD(si + 1);
            *(LAS f32x4*)(lds + AA + (ct * 128 + 8 * cg) * 4) = (f32x4){fexp2(bflo(l[0])), fexp2(bfhi(l[0])), fexp2(bflo(l[1])), fexp2(bfhi(l[1]))};
            *(LAS f32x4*)(lds + AA + (ct * 128 + 8 * cg + 4) * 4) = (f32x4){fexp2(bflo(l[2])), fexp2(bfhi(l[2])), fexp2(bflo(l[3])), fexp2(bfhi(l[3]))};
            *(LAS f32x4*)(lds + UU + (ct * 128 + 8 * cg) * 4) = (f32x4){bflo(u[0]), bfhi(u[0]), bflo(u[1]), bfhi(u[1])};
            *(LAS f32x4*)(lds + UU + (ct * 128 + 8 * cg + 4) * 4) = (f32x4){bflo(u[2]), bfhi(u[2]), bflo(u[3]), bfhi(u[3])};
            __syncthreads();
            if (tid < 128) {
                LAS float* ap = (LAS float*)(lds + AA) + tid; LAS float* up = (LAS float*)(lds + UU) + tid; float av[32], uv[32];
#pragma unroll
                for (int i = 0; i < 32; ++i) { av[i] = ap[i * 128]; uv[i] = up[i * 128]; }
                if (dir == 0) {
#pragma unroll
                    for (int i = 0; i < 32; ++i) { carry = av[i] * carry + uv[i]; uv[i] = carry; } }
                else {
#pragma unroll
                    for (int i = 31; i >= 0; --i) { carry = av[i] * carry + uv[i]; uv[i] = carry; } }
#pragma unroll
                for (int i = 0; i < 32; ++i) up[i * 128] = uv[i];
            }
            __syncthreads();
            {   const f32x4 h0 = *(const LAS f32x4*)(lds + UU + (ct * 128 + 8 * cg) * 4), h1 = *(const LAS f32x4*)(lds + UU + (ct * 128 + 8 * cg + 4) * 4);
                LAS u32x4* hf = (LAS u32x4*)(lds + HFL + ((sub * 32 + ct) * 128 + 8 * cg) * 2);
                if (dir == 0) *hf = (u32x4){cvt_pk_bf16(h0[0], h0[1]), cvt_pk_bf16(h0[2], h0[3]), cvt_pk_bf16(h1[0], h1[1]), cvt_pk_bf16(h1[2], h1[3])};
                else { const u32x4 f = *hf; const size_t go = ((size_t)b * SEQ + t0 + ct) * LRUW + cc0;
                    *(u32x4*)(HY + go) = (u32x4){cvt_pk_bf16((h0[0] + bflo(f[0])) * bflo(y[0]), (h0[1] + bfhi(f[0])) * bfhi(y[0])), cvt_pk_bf16((h0[2] + bflo(f[1])) * bflo(y[1]), (h0[3] + bfhi(f[1])) * bfhi(y[1])),
                                                cvt_pk_bf16((h1[0] + bflo(f[2])) * bflo(y[2]), (h1[1] + bfhi(f[2])) * bfhi(y[2])), cvt_pk_bf16((h1[2] + bflo(f[3])) * bflo(y[3]), (h1[3] + bfhi(f[3])) * bfhi(y[3]))}; }
            }
            __syncthreads();
        }
#undef LRU_GLOAD
    }
}
}
__device__ __forceinline__ void lru_apply_phase(const Args& A, LAS unsigned char* lds, int bid, int G) {
    for (int it = bid; it < 2560; it += G) lru::lru_apply_item(A, lds, it / 320, (it >> 5) % 10, it & 31);
}
template <int MODE>
__device__ __forceinline__ void lru_phase(const Args& A, LAS unsigned char* lds, int bid, int G) {
    const int nitems = (MODE == 0) ? 5120 : 2560;
    for (int it = bid; it < nitems; it += G) {
        int b, n, seg, dir;
        if (MODE == 0) { dir = it & 1; const int r = it >> 1; seg = r & 31; n = (r >> 5) % 10; b = r / 320; }
        else { dir = MODE - 1; seg = it & 31; n = (it >> 5) % 10; b = it / 320; }
        lru::lru_item<MODE>(A, lds, b, n, seg, dir);
    }
}
__device__ __forceinline__ void lru_carry_phase(const Args& A, int bid, int G) {
    const float* sm = (const float*)(A.ws + TB_LSUM); float* cin = (float*)(A.ws + TB_LCIN);
    for (int idx = bid * NTHR + threadIdx.x; idx < NBATCH * 2 * LRUW; idx += G * NTHR) {
        const int b = idx / (2 * LRUW), r = idx % (2 * LRUW), dir = r / LRUW, ch = r % LRUW; float carry = 0.f;
        for (int i = 0; i < 32; ++i) { const int sg = dir ? (31 - i) : i; const size_t o = (size_t)((b * 32 + sg) * 2 + dir);
            cin[o * LRUW + ch] = carry; carry = sm[o * 2 * LRUW + ch] * carry + sm[o * 2 * LRUW + LRUW + ch]; }
    }
}

__device__ __forceinline__ void place_phase(const Args& A, LAS unsigned char* lds, int bid, int G) {
    int tid_ = threadIdx.x; asm volatile("" : "+v"(tid_));
    const int tid = tid_, lane = tid & 63, wave = tid >> 6; unsigned char* ws = A.ws;
    const int* bcnt = (const int*)(ws + TB_BCNT); const int* eid = (const int*)(ws + TB_EID); int* slot = (int*)(ws + TB_SLOT);
    const bf16_t* HM = (const bf16_t*)(ws + WS_HM); bf16_t* XS = (bf16_t*)(ws + E_XS);
    LAS int* tot = (LAS int*)lds; LAS int* pre = tot + 8; LAS int* rb = tot + 16; LAS int* wcn = tot + 32; LAS int* sl = tot + 64;
    for (int tb = bid; tb < MTOK / 256; tb += G) {
        { int t_ = 0, p_ = 0;
#pragma unroll
            for (int j = 0; j < 4; ++j) { const int blk = lane + 64 * j; const int v = bcnt[blk * 8 + wave]; t_ += v; p_ += (blk < tb) ? v : 0; }
#pragma unroll
            for (int o = 1; o < 64; o <<= 1) { t_ += __shfl_xor(t_, o); p_ += __shfl_xor(p_, o); }
            if (lane == 0) { tot[wave] = t_; pre[wave] = p_; } }
        __syncthreads();
        if (tid == 0) { int acc = 0; for (int e = 0; e < 8; ++e) { rb[e] = acc * 256; if (tb == 0) ((int*)(ws + TB_TILES))[e] = acc; acc += (tot[e] + 255) >> 8; } if (tb == 0) ((int*)(ws + TB_TILES))[8] = acc; }
        int e0 = -1, e1 = -1; unsigned long long mk0 = 0, mk1 = 0;
        if (tid < 256) { e0 = eid[(tb * 256 + tid) * 2]; e1 = eid[(tb * 256 + tid) * 2 + 1];
#pragma unroll
            for (int e = 0; e < 8; ++e) { const unsigned long long m = __ballot(e0 == e || e1 == e); if (lane == 0) wcn[wave * 8 + e] = __popcll(m); if (e0 == e) mk0 = m; if (e1 == e) mk1 = m; } }
        __syncthreads();
        if (tid < 256) { const unsigned long long lt = (1ull << lane) - 1ull; int b0 = rb[e0] + pre[e0] + __popcll(mk0 & lt), b1 = rb[e1] + pre[e1] + __popcll(mk1 & lt);
            for (int w = 0; w < wave; ++w) { b0 += wcn[w * 8 + e0]; b1 += wcn[w * 8 + e1]; }
            sl[tid * 2] = b0; sl[tid * 2 + 1] = b1; slot[(tb * 256 + tid) * 2] = b0; slot[(tb * 256 + tid) * 2 + 1] = b1; }
        __syncthreads();
        for (int i0 = 0; i0 < 32; i0 += 8) {
            u32x4 q[8]; int s0[8], s1[8];
#pragma unroll
            for (int j = 0; j < 8; ++j) { const int t = wave * 32 + i0 + j; s0[j] = sl[t * 2]; s1[j] = sl[t * 2 + 1];
                q[j] = *(const u32x4*)((const unsigned char*)HM + (size_t)(tb * 256 + t) * DM + lane * 16); }
#pragma unroll
            for (int j = 0; j < 8; ++j) { *(u32x4*)((unsigned char*)XS + (size_t)s0[j] * DM + lane * 16) = q[j]; *(u32x4*)((unsigned char*)XS + (size_t)s1[j] * DM + lane * 16) = q[j]; } }
        __syncthreads();
    }
}

namespace att {
constexpr int KVBLK = 64;
#define SBAR() __builtin_amdgcn_sched_barrier(0)
typedef int v8i __attribute__((ext_vector_type(8)));
__device__ __forceinline__ int crow(int r, int hi) { return (r & 3) + 8 * (r >> 2) + 4 * hi; }
constexpr int SLOTB = 8192;
__device__ __forceinline__ int k_slot(int s) { return s * SLOTB; }
__device__ __forceinline__ int v_slot(int s) { return 65536 + s * SLOTB; }
__device__ __forceinline__ int kswz(int row) { return ((row & 7) ^ (row >> 4)) & 7; }
__device__ __forceinline__ int vswz(int row) { return (row >> 2) & 3; }
__device__ __forceinline__ void mfma8_acc(f32x16& acc, const v8i& a, const v8i& b, int sc) {
    asm volatile("s_nop 4\n\tv_mfma_scale_f32_32x32x64_f8f6f4 %0, %1, %2, %0, %3, %3 op_sel_hi:[0,0,0]" : "+v"(acc) : "v"(a), "v"(b), "v"(sc) : "memory");
}
__device__ __forceinline__ void mfma8_c(f32x16& d, const v8i& a, const v8i& b, const f32x16& c, int sa, int sb) {
    asm volatile("v_mfma_scale_f32_32x32x64_f8f6f4 %0, %1, %2, %3, %4, %5 op_sel_hi:[0,0,0]" : "=&v"(d) : "v"(a), "v"(b), "v"(c), "v"(sa), "v"(sb) : "memory");
}
#define ATT_LD8(p0_, p1_) __builtin_bit_cast(v8i, __builtin_shufflevector(*(const LAS u32x4*)(p0_), *(const LAS u32x4*)(p1_), 0, 1, 2, 3, 4, 5, 6, 7))
__device__ __forceinline__ void qkt(f32x16& p0, f32x16& p1, const LAS char* Ks, const v8i& qr, int r32, int hi, int jj, const f32x16& cinit, int s1, int s8) {
    const int c0 = jj * 4 + 2 * hi;
    { const int row = r32; const v8i kf = ATT_LD8(Ks + row * 128 + ((c0 ^ kswz(row)) << 4), Ks + row * 128 + (((c0 + 1) ^ kswz(row)) << 4)); mfma8_c(p0, kf, qr, cinit, s1, s8); }
    { const int row = 32 + r32; const v8i kf = ATT_LD8(Ks + row * 128 + ((c0 ^ kswz(row)) << 4), Ks + row * 128 + (((c0 + 1) ^ kswz(row)) << 4)); mfma8_c(p1, kf, qr, cinit, s1, s8); }
}
__device__ __forceinline__ void load_kf(v8i& kf0, v8i& kf1, const LAS char* Ks, int r32, int hi, int jj) {
    const int c0 = jj * 4 + 2 * hi, row1 = 32 + r32;
    kf0 = ATT_LD8(Ks + r32 * 128 + ((c0 ^ kswz(r32)) << 4), Ks + r32 * 128 + (((c0 + 1) ^ kswz(r32)) << 4));
    kf1 = ATT_LD8(Ks + row1 * 128 + ((c0 ^ kswz(row1)) << 4), Ks + row1 * 128 + (((c0 + 1) ^ kswz(row1)) << 4));
}
#define ATT_VFR(Vs, d0) ATT_LD8((Vs) + (32 * (d0) + r32) * 64 + (((2 * hi) ^ vswz(32 * (d0) + r32)) << 4), (Vs) + (32 * (d0) + r32) * 64 + (((2 * hi + 1) ^ vswz(32 * (d0) + r32)) << 4))
__device__ __forceinline__ void pack_p(const float (&pe)[32], v8i& pa);
__device__ __forceinline__ void qkt_pack(f32x16& p0, f32x16& p1, const v8i& kf0, const v8i& kf1, const v8i& qr, const f32x16& cinit, int s1, int s8, const float (&pe)[32], v8i& pa) {
#define ATT_MC8(d, kf, B, O0, O1, O2, O3) \
    asm volatile("v_mfma_scale_f32_32x32x64_f8f6f4 %0, %21, %22, %23, %24, %25 op_sel_hi:[0,0,0]\n\t" \
                 "v_cvt_pk_fp8_f32 %1, %5, %6\n\tv_cvt_pk_fp8_f32 %1, %7, %8 op_sel:[0,0,1]\n\t" \
                 "v_cvt_pk_fp8_f32 %2, %9, %10\n\tv_cvt_pk_fp8_f32 %2, %11, %12 op_sel:[0,0,1]\n\t" \
                 "v_cvt_pk_fp8_f32 %3, %13, %14\n\tv_cvt_pk_fp8_f32 %3, %15, %16 op_sel:[0,0,1]\n\t" \
                 "v_cvt_pk_fp8_f32 %4, %17, %18\n\tv_cvt_pk_fp8_f32 %4, %19, %20 op_sel:[0,0,1]" \
                 : "=&v"(d), "=&v"(O0), "=&v"(O1), "=&v"(O2), "=&v"(O3) \
                 : "v"(pe[B]), "v"(pe[B + 1]), "v"(pe[B + 2]), "v"(pe[B + 3]), "v"(pe[B + 4]), "v"(pe[B + 5]), "v"(pe[B + 6]), "v"(pe[B + 7]), \
                   "v"(pe[B + 8]), "v"(pe[B + 9]), "v"(pe[B + 10]), "v"(pe[B + 11]), "v"(pe[B + 12]), "v"(pe[B + 13]), "v"(pe[B + 14]), "v"(pe[B + 15]), \
                   "v"(kf), "v"(qr), "v"(cinit), "v"(s1), "v"(s8) : "memory")
    int q0, q1, q2, q3, q4, q5, q6, q7;
    ATT_MC8(p0, kf0, 0, q0, q1, q2, q3);
    ATT_MC8(p1, kf1, 16, q4, q5, q6, q7);
#undef ATT_MC8
    pa = (v8i){q0, q1, q2, q3, q4, q5, q6, q7};
}
__device__ __forceinline__ void partialSM(f32x16& p0) {
#pragma unroll
    for (int r = 0; r < 16; ++r) p0[r] = fexp2(p0[r]);
}
__device__ __forceinline__ void finishSM(f32x16& p0, f32x16& p1, v8i& pa) {
#pragma unroll
    for (int r = 0; r < 16; ++r) p1[r] = fexp2(p1[r]);
#pragma unroll
    for (int w = 0; w < 4; ++w) { pa[w] = (int)pk_fp8x4(p0[4 * w], p0[4 * w + 1], p0[4 * w + 2], p0[4 * w + 3]); pa[4 + w] = (int)pk_fp8x4(p1[4 * w], p1[4 * w + 1], p1[4 * w + 2], p1[4 * w + 3]); }
}
#define ATT_MX7(acc, a, b, sc, NOP, O, I, k) \
    asm volatile(NOP "v_mfma_scale_f32_32x32x64_f8f6f4 %0, %15, %16, %0, %17, %17 op_sel_hi:[0,0,0]\n\tv_exp_f32 %1, %8\n\tv_exp_f32 %2, %9\n\tv_exp_f32 %3, %10\n\tv_exp_f32 %4, %11\n\tv_exp_f32 %5, %12\n\tv_exp_f32 %6, %13\n\tv_exp_f32 %7, %14" \
                 : "+v"(acc), "=&v"(O[k]), "=&v"(O[k + 1]), "=&v"(O[k + 2]), "=&v"(O[k + 3]), "=&v"(O[k + 4]), "=&v"(O[k + 5]), "=&v"(O[k + 6]) \
                 : "v"(I(k)), "v"(I(k + 1)), "v"(I(k + 2)), "v"(I(k + 3)), "v"(I(k + 4)), "v"(I(k + 5)), "v"(I(k + 6)), "v"(a), "v"(b), "v"(sc) : "memory")
__device__ __forceinline__ void pv_exp_a(f32x16* o, const v8i& vf0, const v8i& vf1, const v8i& vf2, const v8i& pa, int s1, const f32x16& r0, const f32x16& r1, float (&pe)[32]) {
#define ATT_RI(k) (((k) < 16) ? r0[(k) & 15] : r1[(k) & 15])
    ATT_MX7(o[0], pa, vf0, s1, "s_nop 4\n\t", pe, ATT_RI, 0);
    ATT_MX7(o[1], pa, vf1, s1, "", pe, ATT_RI, 7);
    ATT_MX7(o[2], pa, vf2, s1, "", pe, ATT_RI, 14);
#undef ATT_RI
}
__device__ __forceinline__ void pv_exp_b(f32x16* o, f32x16& lacc, const v8i& ones, const v8i& vf3, const v8i& pa, int s1, const f32x16& r0, const f32x16& r1, float (&pe)[32]) {
#define ATT_RI(k) (((k) < 16) ? r0[(k) & 15] : r1[(k) & 15])
    ATT_MX7(o[3], pa, vf3, s1, "", pe, ATT_RI, 21);
    asm volatile("v_mfma_scale_f32_32x32x64_f8f6f4 %0, %9, %10, %0, %11, %11 op_sel_hi:[0,0,0]\n\tv_exp_f32 %1, %5\n\tv_exp_f32 %2, %6\n\tv_exp_f32 %3, %7\n\tv_exp_f32 %4, %8"
                 : "+v"(lacc), "=&v"(pe[28]), "=&v"(pe[29]), "=&v"(pe[30]), "=&v"(pe[31]) : "v"(r1[12]), "v"(r1[13]), "v"(r1[14]), "v"(r1[15]), "v"(pa), "v"(ones), "v"(s1) : "memory");
#undef ATT_RI
}
__device__ __forceinline__ void pack_p(const float (&pe)[32], v8i& pa) {
#pragma unroll
    for (int w = 0; w < 8; ++w) pa[w] = (int)pk_fp8x4(pe[4 * w], pe[4 * w + 1], pe[4 * w + 2], pe[4 * w + 3]);
}
__device__ __forceinline__ void pv_d0(f32x16* o, f32x16& lacc, const v8i& ones, const LAS char* Vs, const v8i& pa, int r32, int hi, int s1) {
#pragma unroll
    for (int d0 = 0; d0 < 4; ++d0) { const int row = 32 * d0 + r32;
        const v8i vf = ATT_LD8(Vs + row * 64 + (((2 * hi) ^ vswz(row)) << 4), Vs + row * 64 + (((2 * hi + 1) ^ vswz(row)) << 4));
        mfma8_acc(o[d0], pa, vf, s1); }
    mfma8_acc(lacc, pa, ones, s1);
}
__device__ __forceinline__ void pv_last(f32x16* o, f32x16& lacc, const v8i& ones, const v8i& vf0, const v8i& vf1, const v8i& vf2, const v8i& vf3, const v8i& pa, int s1) {
    mfma8_acc(o[0], pa, vf0, s1); mfma8_acc(o[1], pa, vf1, s1); mfma8_acc(o[2], pa, vf2, s1); mfma8_acc(o[3], pa, vf3, s1); mfma8_acc(lacc, pa, ones, s1);
}
}

__device__ __forceinline__ void vt_phase(const Args& A, int bid, int G) {
    const int tid = threadIdx.x; unsigned char* ws = A.ws;
    const bf16_t* V = (const bf16_t*)(ws + A_V); unsigned char* VT = ws + A_VT;
    const int dv = tid & 127, kq = tid >> 7, half = kq >> 1, hi = kq & 1;
    for (int it = bid; it < 64 * 128; it += G) {
        const int bh = it >> 7, tile = it & 127, b = bh >> 3, h = bh & 7;
        const bf16_t* vp = V + ((size_t)b * SEQ + tile * 64 + 32 * half) * DM + h * 128 + dv;
        float f[16];
#pragma unroll
        for (int i = 0; i < 16; ++i) f[i] = bf2f(vp[(size_t)att::crow(i, hi) * DM]);
        *(u32x4*)(VT + (((size_t)bh * 128 + tile) * 128 + dv) * 64 + hi * 32 + half * 16) =
            (u32x4){pk_fp8x4(f[0], f[1], f[2], f[3]), pk_fp8x4(f[4], f[5], f[6], f[7]), pk_fp8x4(f[8], f[9], f[10], f[11]), pk_fp8x4(f[12], f[13], f[14], f[15])};
    }
}

__device__ __forceinline__ void attn_phase(const Args& A, LAS unsigned char* ldsu, int bid, int G, int al) {
    using namespace att;
    LAS char* lds = (LAS char*)ldsu;
    unsigned char* ws = A.ws;
    const unsigned char* Qg = ws + A_Q; const unsigned char* Kg = ws + A_K; const unsigned char* VTg = ws + A_VT;
    bf16_t* Og = (bf16_t*)(ws + WS_HM);
    const float* scal = (const float*)(ws + TB_SCAL);
    const float lamv = scal[SC_LAM0 + al], omli = scal[SC_OML0 + al], Mc = scal[SC_MC0 + al] - 7.5f;
    const float* subg = A.in[I_ATSUB] + al * 128;
    int tid_ = threadIdx.x; asm volatile("" : "+v"(tid_));
    const int tid = tid_, wid = __builtin_amdgcn_readfirstlane(tid >> 6), lane = tid & 63, r32 = lane & 31, hi = lane >> 5, jj = wid >> 2, wq = wid & 3;
    constexpr int NT = SEQ / KVBLK;
    int s1 = 0x7f7f7f7f, s8 = 0x7c7c7c7c; asm volatile("" : "+v"(s1), "+v"(s8));
    v8i ones; { int o1 = 0x38383838; asm volatile("" : "+v"(o1)); ones = (v8i){o1, o1, o1, o1, o1, o1, o1, o1}; }
    f32x16 cinit;
#pragma unroll
    for (int r = 0; r < 16; ++r) cinit[r] = -Mc;
    unsigned koff, voff;
    { const int bb = wid * 1024 + lane * 16;
      { const int row = bb >> 7, c = ((bb & 127) >> 4) ^ kswz(row); koff = (unsigned)(row * 1024 + c * 16); }
      { const int row = bb >> 6, c = ((bb & 63) >> 4) ^ vswz(row); voff = (unsigned)(row * 64 + c * 16); } }
    const unsigned ldsw = (unsigned)wid * 1024u;
    const __amdgpu_buffer_rsrc_t rK = __builtin_amdgcn_make_buffer_rsrc((void*)Kg, (short)0, 0x7fffffff, 0x00020000);
    const __amdgpu_buffer_rsrc_t rV = __builtin_amdgcn_make_buffer_rsrc((void*)VTg, (short)0, 0x7fffffff, 0x00020000);
#define ATT_DMA(slot, kt, vt) do { \
        __builtin_amdgcn_raw_ptr_buffer_load_lds(rK, (LAS void*)(lds + k_slot(slot) + ldsw), 16, (int)koff, (int)(kt), 0, 0); \
        __builtin_amdgcn_raw_ptr_buffer_load_lds(rV, (LAS void*)(lds + v_slot(slot) + ldsw), 16, (int)voff, (int)(vt), 0, 0); } while (0)
#define ATT_TOP() do { asm volatile("s_waitcnt vmcnt(2)" ::: "memory"); __builtin_amdgcn_s_barrier(); asm volatile("" ::: "memory"); } while (0)
    const int xq = bid & 7, cq = bid >> 3;
    int cbh = xq * 8;
    const bool lag = (jj != 0);
#define ATT_KB(bh_) ((unsigned)(((bh_) >> 3) * SEQ) * (unsigned)DM + (unsigned)((bh_) & 7) * 128u)
#define ATT_VB(bh_) ((unsigned)(bh_) * (128u * 8192u))
    ATT_DMA(0, ATT_KB(cbh), ATT_VB(cbh)); ATT_DMA(1, ATT_KB(cbh) + 64u * DM, ATT_VB(cbh) + 8192u);
    int ofKa, ofKb, ofV, ofKax, ofKbx, ofVx;
    { const int c0 = jj * 4 + 2 * hi, lb = (int)(unsigned)(size_t)lds;
      ofKa = r32 * 128 + ((c0 ^ kswz(r32)) << 4); ofKb = (32 + r32) * 128 + ((c0 ^ kswz(32 + r32)) << 4); ofV = 65536 + r32 * 64 + (((2 * hi) ^ vswz(r32)) << 4);
      ofKax = lb + (ofKa ^ 16); ofKbx = lb + (ofKb ^ 16); ofVx = lb + (ofV ^ 16); ofKa += lb; ofKb += lb; ofV += lb; }
#define ATT_QLOAD(dst, bh_, qb_) do { const unsigned char* Qw_ = Qg + ((size_t)((bh_) >> 3) * SEQ + (qb_) * 128) * DM + ((bh_) & 7) * 128 + (size_t)(wq * 32 + r32) * DM + jj * 64 + hi * 32; \
        const u32x4 qa_ = *(const u32x4*)Qw_, qb2_ = *(const u32x4*)(Qw_ + 16); dst = __builtin_bit_cast(v8i, __builtin_shufflevector(qa_, qb2_, 0, 1, 2, 3, 4, 5, 6, 7)); } while (0)
    v8i qnext; ATT_QLOAD(qnext, cbh, cq);
    for (int ui = 0; ui < 16; ++ui) {
        const int qb = (ui & 1) * 32 + cq;
        const int nbh = (ui + 1 < 16) ? xq * 8 + ((ui + 1) >> 1) : cbh;
        const unsigned Kh = ATT_KB(cbh), Vh = ATT_VB(cbh), nK = ATT_KB(nbh), nV = ATT_VB(nbh);
        const size_t obase = ((size_t)(cbh >> 3) * SEQ + qb * 128) * DM + (cbh & 7) * 128;
        f32x16 lacc = {}; f32x16 o[4] = {}; const v8i qr = qnext;
        f32x16 pA0, pA1; v8i pa, kf0, kf1, vf0, vf1, vf2, vf3;
        unsigned kptr = Kh + 2u * 64u * DM, vptr = Vh + 2u * 8192u;
#define ATT_ISSUE(SLD, last) do { asm volatile("" : "+s"(kptr), "+s"(vptr)); ATT_DMA(SLD, kptr, vptr); if (last) { kptr = nK; vptr = nV; } else { kptr += 64u * DM; vptr += 8192u; } } while (0)
#define ATT_RD8(b_, bx_, imm_) ATT_LD8((const LAS char*)(unsigned)((b_) + (imm_)), (const LAS char*)(unsigned)((bx_) + (imm_)))
#define ATT_FIX() asm volatile("" : "+v"(ofKa), "+v"(ofKax), "+v"(ofKb), "+v"(ofKbx), "+v"(ofV), "+v"(ofVx))
#define ATT_STEPC(LAST, SL, SLP, SLD) do { \
            ATT_FIX(); \
            kf0 = ATT_RD8(ofKa, ofKax, (SL) * SLOTB); kf1 = ATT_RD8(ofKb, ofKbx, (SL) * SLOTB); vf0 = ATT_RD8(ofV, ofVx, (SLP) * SLOTB); vf1 = ATT_RD8(ofV, ofVx, (SLP) * SLOTB + 2048); \
            ATT_ISSUE(SLD, LAST); \
            ATT_TOP(); \
            qkt_pack(pA0, pA1, kf0, kf1, qr, cinit, s1, s8, pe, pa); \
            vf2 = ATT_RD8(ofV, ofVx, (SLP) * SLOTB + 4096); vf3 = ATT_RD8(ofV, ofVx, (SLP) * SLOTB + 6144); \
            pv_exp_a(o, vf0, vf1, vf2, pa, s1, pA0, pA1, pe); \
            ATT_TOP(); \
            pv_exp_b(o, lacc, ones, vf3, pa, s1, pA0, pA1, pe); } while (0)
        float pe[32];
        if (lag) ATT_TOP();
        ATT_TOP();
        ATT_FIX(); kf0 = ATT_RD8(ofKa, ofKax, 0); kf1 = ATT_RD8(ofKb, ofKbx, 0); ATT_ISSUE(2, false);
        ATT_TOP();
        { mfma8_c(pA0, kf0, qr, cinit, s1, s8); mfma8_c(pA1, kf1, qr, cinit, s1, s8);
          asm volatile("s_nop 15\n\ts_nop 15" ::: "memory");
#pragma unroll
          for (int r = 0; r < 16; ++r) pe[r] = fexp2(pA0[r]);
#pragma unroll
          for (int r = 0; r < 16; ++r) pe[16 + r] = fexp2(pA1[r]); }
        ATT_TOP();
        ATT_STEPC(false, 1, 0, 3); ATT_STEPC(false, 2, 1, 4); ATT_STEPC(false, 3, 2, 5); ATT_STEPC(false, 4, 3, 6); ATT_STEPC(false, 5, 4, 7); ATT_STEPC(false, 6, 5, 0); ATT_STEPC(false, 7, 6, 1);
        for (int kb = 8; kb < NT; kb += 8) {
            ATT_STEPC(false, 0, 7, 2); ATT_STEPC(false, 1, 0, 3); ATT_STEPC(false, 2, 1, 4); ATT_STEPC(false, 3, 2, 5);
            ATT_STEPC(false, 4, 3, 6); ATT_STEPC(kb == NT - 8, 5, 4, 7); ATT_STEPC(false, 6, 5, 0); ATT_STEPC(false, 7, 6, 1);
        }
        ATT_FIX();
        vf0 = ATT_RD8(ofV, ofVx, 7 * SLOTB); vf1 = ATT_RD8(ofV, ofVx, 7 * SLOTB + 2048);
        ATT_TOP();
        { vf2 = ATT_RD8(ofV, ofVx, 7 * SLOTB + 4096); vf3 = ATT_RD8(ofV, ofVx, 7 * SLOTB + 6144);
          pack_p(pe, pa); SBAR();
          pv_last(o, lacc, ones, vf0, vf1, vf2, vf3, pa, s1);
          asm volatile("s_nop 15\n\ts_nop 15" ::: "memory"); }
        if (!lag) ATT_TOP();
        if (ui + 1 < 16) ATT_QLOAD(qnext, nbh, ((ui + 1) & 1) * 32 + cq);
#undef ATT_ISSUE
#undef ATT_STEPC
#undef ATT_RD8
#undef ATT_FIX
        int r32e = r32, hie = hi; asm volatile("" : "+v"(r32e), "+v"(hie));
        float rli[16];
#pragma unroll
        for (int r = 0; r < 16; ++r) rli[r] = frcp(lacc[r]);
        asm volatile("s_waitcnt lgkmcnt(0)" ::: "memory"); __builtin_amdgcn_s_barrier(); asm volatile("" ::: "memory");
        LAS float* Cb = (LAS float*)(lds + ((wq < 2) ? 3 * SLOTB : 65536 + 3 * SLOTB - 64 * 512));
        if (jj == 1) {
#pragma unroll
            for (int r = 0; r < 16; ++r) { const float sc = rli[r] * lamv;
#pragma unroll
                for (int d0 = 0; d0 < 4; ++d0) Cb[(wq * 32 + crow(r, hie)) * 128 + d0 * 32 + r32e] = o[d0][r] * sc; }
        }
        asm volatile("s_waitcnt lgkmcnt(0)" ::: "memory"); __builtin_amdgcn_s_barrier(); asm volatile("" ::: "memory");
        if (jj == 0) {
            float g[4];
#pragma unroll
            for (int d0 = 0; d0 < 4; ++d0) g[d0] = subg[d0 * 32 + r32e] * omli;
            bf16_t* Ob = Og + obase;
#pragma unroll
            for (int r = 0; r < 16; ++r) {
                float ss = 0.f;
#pragma unroll
                for (int d0 = 0; d0 < 4; ++d0) { const float v = o[d0][r] * rli[r] - Cb[(wq * 32 + crow(r, hie)) * 128 + d0 * 32 + r32e]; o[d0][r] = v; ss += v * v; }
                ss += __shfl_xor(ss, 1); ss += __shfl_xor(ss, 2); ss += __shfl_xor(ss, 4); ss += __shfl_xor(ss, 8); ss += __shfl_xor(ss, 16);
                const float rs = 1.0f / sqrtf(ss * (1.0f / 128.0f) + EPS);
                if (al == 0) { bf16_t* op = Ob + (size_t)(wq * 32 + crow(r, hie)) * DM + r32e;
#pragma unroll
                    for (int d0 = 0; d0 < 4; ++d0) op[d0 * 32] = (bf16_t)f2bf(o[d0][r] * rs * g[d0]); }
                else { unsigned char* op = (unsigned char*)Og + obase + (size_t)(wq * 32 + crow(r, hie)) * DM + r32e;
#pragma unroll
                    for (int d0 = 0; d0 < 4; ++d0) { const float v = o[d0][r] * rs * g[d0]; op[d0 * 32] = (unsigned char)(__builtin_amdgcn_cvt_pk_fp8_f32(v, v, 0, false) & 0xff); } }
            }
        }
        asm volatile("s_waitcnt lgkmcnt(0)" ::: "memory"); __builtin_amdgcn_s_barrier(); asm volatile("" ::: "memory");
        cbh = nbh;
    }
    asm volatile("s_waitcnt vmcnt(0) lgkmcnt(0)" ::: "memory"); __builtin_amdgcn_s_barrier(); asm volatile("" ::: "memory");
#undef ATT_DMA
#undef ATT_TOP
#undef ATT_QLOAD
#undef ATT_KB
#undef ATT_VB
#undef ATT_LD8
}

namespace gla {
constexpr int BC = 0, QI = 32768, QA = 49152, KA = 65536, KST = 81920, VT = 98304, ST = 106496, AT = 122880, EM = 131072, EL = EM + 512, DD = EM + 1024, BMID = EM + 1536, SEG = EM + 2048;
static_assert(SEG + 2048 <= RING_BYTES, "gla lds");
__device__ __forceinline__ int sw256(int row, int cb) { return row * 256 + (cb ^ ((row & 15) << 4)); }
__device__ __forceinline__ int sw128(int row, int cb) { return row * 128 + (cb ^ ((((row & 7) ^ (row >> 4)) & 7) << 4)); }
__device__ __forceinline__ int crow(int r, int hi) { return (r & 3) + 8 * (r >> 2) + 4 * hi; }
__device__ __forceinline__ float h2f(unsigned short b) { return (float)__builtin_bit_cast(_Float16, b); }
__device__ __forceinline__ void gla_item(const bf16_t* __restrict__ Qp, const unsigned short* __restrict__ LFp, const bf16_t* __restrict__ Vp, bf16_t* __restrict__ Op, int dir, LAS unsigned char* lds, float* dbg) {
    int tid_ = threadIdx.x; asm volatile("" : "+v"(tid_));
    const int tid = tid_, wid = tid >> 6, lane = tid & 63, r = lane & 31, hh = lane >> 5;
    const int t1 = tid >> 3, kg = tid & 7, k0 = 16 * kg, v0 = (tid & 7) * 8;
    for (int i = tid; i < 16384 / 16; i += NTHR) *(LAS u32x4*)(lds + ST + i * 16) = (u32x4){0u, 0u, 0u, 0u};
    f32x16 st = {};
    u32x4 rq[2], rl[2], rv;
#define GLA_TOK(ci, i) (dir ? (SEQ - 1 - ((ci) * 64 + (i))) : ((ci) * 64 + (i)))
#define GLA_LOAD(ci) do { const size_t to = (size_t)GLA_TOK(ci, t1) * DM; \
        rq[0] = *(const u32x4*)(Qp + to + k0); rq[1] = *(const u32x4*)(Qp + to + k0 + 8); \
        rl[0] = *(const u32x4*)(LFp + to + k0); rl[1] = *(const u32x4*)(LFp + to + k0 + 8); rv = *(const u32x4*)(Vp + to + v0); } while (0)
    GLA_LOAD(0);
    __syncthreads();
    for (int ci = 0; ci < SEQ / 64; ++ci) {
        float qf[16], lf[16]; u32x4 vreg = rv;
#pragma unroll
        for (int j = 0; j < 2; ++j)
#pragma unroll
            for (int e = 0; e < 4; ++e) { qf[j * 8 + 2 * e] = bflo(rq[j][e]); qf[j * 8 + 2 * e + 1] = bfhi(rq[j][e]);
                lf[j * 8 + 2 * e] = h2f((unsigned short)(rl[j][e] & 0xffffu)); lf[j * 8 + 2 * e + 1] = h2f((unsigned short)(rl[j][e] >> 16)); }
        if (ci + 1 < SEQ / 64) GLA_LOAD(ci + 1);
#pragma unroll
        for (int j = 0; j < 4; ++j) *(LAS f32x4*)(lds + BC + (t1 * 128 + k0 + 4 * j) * 4) = (f32x4){lf[4 * j], lf[4 * j + 1], lf[4 * j + 2], lf[4 * j + 3]};
        __syncthreads();
        { const int kc = tid & 127, sg = tid >> 7; LAS float* bc = (LAS float*)(lds + BC) + kc; float cs[16];
#pragma unroll
            for (int i = 0; i < 16; ++i) cs[i] = bc[(sg * 16 + i) * 128];
#pragma unroll
            for (int i = 1; i < 16; ++i) cs[i] += cs[i - 1];
            ((LAS float*)(lds + SEG))[sg * 128 + kc] = cs[15];
            __syncthreads();
            const LAS float* sgp = (const LAS float*)(lds + SEG) + kc; const float s0 = sgp[0], s1 = sgp[128], s2 = sgp[256], s3 = sgp[384];
            const float off = sg == 0 ? 0.f : sg == 1 ? s0 : sg == 2 ? (s0 + s1) : ((s0 + s1) + s2);
#pragma unroll
            for (int i = 0; i < 16; ++i) bc[(sg * 16 + i) * 128] = cs[i] + off;
            if (sg == 0) { const float bm = s0 + s1, bl = ((s0 + s1) + s2) + s3;
                ((LAS float*)(lds + BMID))[kc] = bm; ((LAS float*)(lds + EM))[kc] = fexp(bm); ((LAS float*)(lds + EL))[kc] = fexp(bl - bm); ((LAS float*)(lds + DD))[kc] = fexp(bl); }
            __syncthreads();
        }
#ifdef DIAG
        if (dbg && ci == 0) { for (int i = tid; i < 8192; i += NTHR) dbg[i] = ((const LAS float*)(lds + BC))[i]; }
#endif
        {
            unsigned wqi[8], wqa[8], wka[8]; float ksv[16];
#pragma unroll
            for (int j = 0; j < 4; ++j) {
                const f32x4 bt = *(const LAS f32x4*)(lds + BC + (t1 * 128 + k0 + 4 * j) * 4), bm = *(const LAS f32x4*)(lds + BMID + (k0 + 4 * j) * 4);
                const f32x4 em = *(const LAS f32x4*)(lds + EM + (k0 + 4 * j) * 4), el = *(const LAS f32x4*)(lds + EL + (k0 + 4 * j) * 4);
                float qi[4], qa[4], ka[4];
#pragma unroll
                for (int e = 0; e < 4; ++e) { const int i = 4 * j + e; const float e1 = fexp(bt[e] - bm[e]), r1 = frcp(e1);
                    qa[e] = qf[i] * e1; qi[e] = qa[e] * em[e]; const float kk = 1.0f - fexp(lf[i]); ka[e] = kk * r1; ksv[i] = ka[e] * el[e]; }
                wqi[2 * j] = cvt_pk_bf16(qi[0], qi[1]); wqi[2 * j + 1] = cvt_pk_bf16(qi[2], qi[3]);
                wqa[2 * j] = cvt_pk_bf16(qa[0], qa[1]); wqa[2 * j + 1] = cvt_pk_bf16(qa[2], qa[3]);
                wka[2 * j] = cvt_pk_bf16(ka[0], ka[1]); wka[2 * j + 1] = cvt_pk_bf16(ka[2], ka[3]);
            }
#pragma unroll
            for (int j = 0; j < 2; ++j) { const int off = sw256(t1, (k0 + 8 * j) * 2);
                *(LAS u32x4*)(lds + QI + off) = (u32x4){wqi[4 * j], wqi[4 * j + 1], wqi[4 * j + 2], wqi[4 * j + 3]};
                *(LAS u32x4*)(lds + QA + off) = (u32x4){wqa[4 * j], wqa[4 * j + 1], wqa[4 * j + 2], wqa[4 * j + 3]};
                *(LAS u32x4*)(lds + KA + off) = (u32x4){wka[4 * j], wka[4 * j + 1], wka[4 * j + 2], wka[4 * j + 3]}; }
#pragma unroll
            for (int i = 0; i < 16; ++i) *(LAS unsigned short*)(lds + KST + sw128(k0 + i, t1 * 2)) = (unsigned short)f2bf(ksv[i]);
#pragma unroll
            for (int e = 0; e < 4; ++e) { *(LAS unsigned short*)(lds + VT + sw128(v0 + 2 * e, t1 * 2)) = (unsigned short)(vreg[e] & 0xffffu);
                *(LAS unsigned short*)(lds + VT + sw128(v0 + 2 * e + 1, t1 * 2)) = (unsigned short)(vreg[e] >> 16); }
        }
        __syncthreads();
        f32x16 oacc = {};
        const int w4 = wid & 3, t_i = w4 >> 1, v_i = w4 & 1;
        if (wid < 4) {
            const int s_i = wid >> 1, tq = wid & 1; f32x16 a = {};
#pragma unroll
            for (int ks = 0; ks < 8; ++ks) { const bf16x8 fa = *(const LAS bf16x8*)(lds + KA + sw256(32 * s_i + r, (16 * ks + 8 * hh) * 2)), fb = *(const LAS bf16x8*)(lds + QA + sw256(32 * tq + r, (16 * ks + 8 * hh) * 2));
                a = __builtin_amdgcn_mfma_f32_32x32x16_bf16(fa, fb, a, 0, 0, 0); }
            const int tg = 32 * tq + r;
#pragma unroll
            for (int g = 0; g < 4; ++g) { float m[4];
#pragma unroll
                for (int e = 0; e < 4; ++e) { const int sgl = 32 * s_i + 8 * g + 4 * hh + e; m[e] = (sgl <= tg) ? a[4 * g + e] : 0.f; }
                *(LAS u32x2*)(lds + AT + sw128(tg, (32 * s_i + 8 * g + 4 * hh) * 2)) = (u32x2){cvt_pk_bf16(m[0], m[1]), cvt_pk_bf16(m[2], m[3])}; }
        } else {
#pragma unroll
            for (int ks = 0; ks < 8; ++ks) { const bf16x8 fa = *(const LAS bf16x8*)(lds + QI + sw256(32 * t_i + r, (16 * ks + 8 * hh) * 2)), fb = *(const LAS bf16x8*)(lds + ST + sw256(32 * v_i + r, (16 * ks + 8 * hh) * 2));
                oacc = __builtin_amdgcn_mfma_f32_32x32x16_bf16(fa, fb, oacc, 0, 0, 0); }
        }
        __syncthreads();
#ifdef DIAG
        if (dbg && ci == 0) { for (int i = tid; i < 2048; i += NTHR) { ((unsigned*)dbg)[8192 + i] = ((const LAS unsigned*)(lds + AT))[i]; ((unsigned*)dbg)[8192 + 2048 + i] = ((const LAS unsigned*)(lds + VT))[i]; } }
#endif
        if (wid >= 4) {
#pragma unroll
            for (int ks = 0; ks < 4; ++ks) { const bf16x8 fa = *(const LAS bf16x8*)(lds + AT + sw128(32 * t_i + r, (16 * ks + 8 * hh) * 2)), fb = *(const LAS bf16x8*)(lds + VT + sw128(32 * v_i + r, (16 * ks + 8 * hh) * 2));
                oacc = __builtin_amdgcn_mfma_f32_32x32x16_bf16(fa, fb, oacc, 0, 0, 0); }
#pragma unroll
            for (int i = 0; i < 16; ++i) { const int t = 32 * t_i + crow(i, hh); Op[(size_t)GLA_TOK(ci, t) * DM + 32 * v_i + r] = (bf16_t)f2bf(oacc[i]); }
        }
        {
            const int kq = wid >> 1, vq = wid & 1;
#pragma unroll
            for (int i = 0; i < 16; ++i) st[i] *= ((const LAS float*)(lds + DD))[32 * kq + crow(i, hh)];
#pragma unroll
            for (int ks = 0; ks < 4; ++ks) { const bf16x8 fa = *(const LAS bf16x8*)(lds + KST + sw128(32 * kq + r, (16 * ks + 8 * hh) * 2)), fb = *(const LAS bf16x8*)(lds + VT + sw128(32 * vq + r, (16 * ks + 8 * hh) * 2));
                st = __builtin_amdgcn_mfma_f32_32x32x16_bf16(fa, fb, st, 0, 0, 0); }
#pragma unroll
            for (int g = 0; g < 4; ++g) *(LAS u32x2*)(lds + ST + sw256(32 * vq + r, (32 * kq + 8 * g + 4 * hh) * 2)) = (u32x2){cvt_pk_bf16(st[4 * g], st[4 * g + 1]), cvt_pk_bf16(st[4 * g + 2], st[4 * g + 3])};
        }
        __syncthreads();
#ifdef DIAG
        if (dbg && ci == 0) { for (int i = tid; i < 4096; i += NTHR) { ((unsigned*)dbg)[12288 + i] = ((const LAS unsigned*)(lds + ST))[i]; ((unsigned*)dbg)[16384 + i] = ((const LAS unsigned*)(lds + KST))[i]; } }
#endif
    }
#undef GLA_TOK
#undef GLA_LOAD
}
}
__device__ __forceinline__ void gla_phase(const Args& A, LAS unsigned char* lds, int bid, int G) {
    unsigned char* ws = A.ws;
    for (int it = bid; it < 256; it += G) {
        const int b = it >> 5, h = (it >> 2) & 7, dir = (it >> 1) & 1, vh = it & 1;
        const size_t base = (size_t)b * SEQ * DM + h * 128;
        gla::gla_item((const bf16_t*)(ws + H_Q) + base, (const unsigned short*)(ws + (dir ? H_LFB : H_LFF)) + base, (const bf16_t*)(ws + H_V) + base + vh * 64,
                      (bf16_t*)(ws + (dir ? H_OB : H_OF)) + base + vh * 64, dir, lds, it == 0 ? (float*)(ws + TB_LSUM) : nullptr);
    }
}
__device__ __forceinline__ void hg_normo_phase(const Args& A, int bid, int G) {
    int tid_ = threadIdx.x; asm volatile("" : "+v"(tid_));
    const int tid = tid_, lane = tid & 63, wave = tid >> 6; unsigned char* ws = A.ws;
    const bf16_t* OF = (const bf16_t*)(ws + H_OF); const bf16_t* OB = (const bf16_t*)(ws + H_OB); const bf16_t* GG = (const bf16_t*)(ws + H_G); bf16_t* HM = (bf16_t*)(ws + WS_HM);
    const int c0 = (lane >> 3) * 128 + (lane & 7) * 16;
    float ng[16];
#pragma unroll
    for (int i = 0; i < 16; ++i) ng[i] = A.in[I_HGNG][(lane & 7) * 16 + i];
    for (int row = (bid * NWAVES + wave); row < MTOK; row += G * NWAVES) {
        const size_t o = (size_t)row * DM + c0;
        const u32x4 a0 = *(const u32x4*)(OF + o), a1 = *(const u32x4*)(OF + o + 8), b0 = *(const u32x4*)(OB + o), b1 = *(const u32x4*)(OB + o + 8), g0 = *(const u32x4*)(GG + o), g1 = *(const u32x4*)(GG + o + 8);
        float v[16], gt[16]; float ss = 0.f;
#pragma unroll
        for (int e = 0; e < 4; ++e) { v[2 * e] = bflo(a0[e]) + bflo(b0[e]); v[2 * e + 1] = bfhi(a0[e]) + bfhi(b0[e]); v[8 + 2 * e] = bflo(a1[e]) + bflo(b1[e]); v[8 + 2 * e + 1] = bfhi(a1[e]) + bfhi(b1[e]);
            gt[2 * e] = bflo(g0[e]); gt[2 * e + 1] = bfhi(g0[e]); gt[8 + 2 * e] = bflo(g1[e]); gt[8 + 2 * e + 1] = bfhi(g1[e]); }
#pragma unroll
        for (int i = 0; i < 16; ++i) ss += v[i] * v[i];
        ss += __shfl_xor(ss, 1); ss += __shfl_xor(ss, 2); ss += __shfl_xor(ss, 4);
        const float rstd = 1.0f / sqrtf(ss * (1.0f / 128.0f) + EPS);
        u32x4 w0, w1;
#pragma unroll
        for (int e = 0; e < 4; ++e) { w0[e] = cvt_pk_bf16(v[2 * e] * rstd * ng[2 * e] * gt[2 * e], v[2 * e + 1] * rstd * ng[2 * e + 1] * gt[2 * e + 1]);
            w1[e] = cvt_pk_bf16(v[8 + 2 * e] * rstd * ng[8 + 2 * e] * gt[8 + 2 * e], v[8 + 2 * e + 1] * rstd * ng[8 + 2 * e + 1] * gt[8 + 2 * e + 1]); }
        *(u32x4*)(HM + o) = w0; *(u32x4*)(HM + o + 8) = w1;
    }
}

#ifdef DIAG
constexpr int DG_BASE = 8192;
__device__ __forceinline__ void dg_put(const Args& A, int k, float e) { if (!(e >= 0.f) || e > 1e9f) e = 1e9f; atomicMax((unsigned*)(A.ws + WS_CTL) + DG_BASE + 64 * k, __float_as_uint(e)); }
__device__ __forceinline__ float dg_rel(float got, float ref) { return fabsf(got - ref) / (fabsf(ref) + 0.1f); }
__device__ __forceinline__ unsigned dg_hash(unsigned a, unsigned b) { unsigned h = a * 2654435761u + b * 40503u + 0x9e3779b9u; h ^= h >> 15; h *= 2246822519u; h ^= h >> 13; h *= 3266489917u; h ^= h >> 16; return h; }
__device__ __forceinline__ float dg_bfr(float x) { return bflo(f2bf(x)); }
__device__ __forceinline__ void dg_mods(const Args& A, int k) {
    const int lane = threadIdx.x & 63, gwv = blockIdx.x * 8 + (threadIdx.x >> 6);
    const unsigned h = dg_hash(gwv, k); const int l = h & 3, b = (h >> 2) & 7, e = (h >> 5) % 6144;
    float a = 0.f; for (int d = lane; d < DM; d += 64) a += fsilu(A.in[I_C][b * DM + d]) * A.in[I_ADAW][((size_t)l * DM + d) * 6144 + e];
    a = wave_sum(a) + A.in[I_ADAB][l * 6144 + e];
    const float got = ((const float*)(A.ws + TB_MODS))[((size_t)l * NBATCH + b) * 6144 + e];
    if (lane == 0) dg_put(A, k, dg_rel(got, a));
}
__device__ __forceinline__ void dg_norm(const Args& A, int k, const float* x, const float* gain, int L, int which) {
    const int lane = threadIdx.x & 63, gwv = blockIdx.x * 8 + (threadIdx.x >> 6);
    const int row = dg_hash(gwv, k) & (MTOK - 1), b = row >> 13;
    const float* modl = (const float*)(A.ws + TB_MODS) + ((size_t)L * NBATCH + b) * 6144;
    float ss = 0.f; for (int c = lane; c < DM; c += 64) { const float v = x[(size_t)row * DM + c]; ss += v * v; }
    ss = wave_sum(ss); const float rstd = 1.0f / sqrtf(ss / DM + EPS); float e = 0.f;
    for (int c = lane; c < DM; c += 64) { const float ref = x[(size_t)row * DM + c] * rstd * gain[c] * (1.0f + modl[(which * 3 + 1) * 1024 + c]) + modl[(which * 3) * 1024 + c];
        e = fmaxf(e, dg_rel(bf2f(((const bf16_t*)(A.ws + WS_HM))[(size_t)row * DM + c]), ref)); }
    dg_put(A, k, e);
}
__device__ __forceinline__ void dg_qkv(const Args& A, int k, int al) {
    const int lane = threadIdx.x & 63, gwv = blockIdx.x * 8 + (threadIdx.x >> 6);
    const unsigned h = dg_hash(gwv, k); const int row = h & (MTOK - 1), t = (h >> 16) % 48, col = t * 64 + lane;
    const bf16_t* hm = (const bf16_t*)(A.ws + WS_HM) + (size_t)row * DM; const float* w = A.in[I_ATWIN] + (size_t)al * 1024 * 3072 + col;
    float a = 0.f; for (int kk = 0; kk < DM; ++kk) a += bf2f(hm[kk]) * dg_bfr(w[(size_t)kk * 3072]);
    float ref, got;
    if (t < 32) {
        const int part = t >> 4, sh = t & 15; const float ss = wave_sum(a * a); const float rstd = 1.0f / sqrtf(ss / 64.0f + EPS);
        const float y = a * rstd * (part ? A.in[I_ATKN] : A.in[I_ATQN])[al * 64 + lane]; const float yp = __shfl_xor(y, 32);
        const int pos = row & (SEQ - 1); const float cs = ((const float*)(A.ws + TB_COS))[pos * 32 + (lane & 31)], sn = ((const float*)(A.ws + TB_SIN))[pos * 32 + (lane & 31)];
        ref = (lane < 32) ? (y * cs - yp * sn) : (y * cs + yp * sn); if (part == 0) ref *= 0.125f * LOG2E;
        got = bf2f(((const bf16_t*)(A.ws + (part ? A_K : A_Q)))[(size_t)row * DM + sh * 64 + lane]);
    } else { ref = a; got = bf2f(((const bf16_t*)(A.ws + A_V))[(size_t)row * DM + (t - 32) * 64 + lane]); }
    dg_put(A, k, dg_rel(got, ref));
}
__device__ __forceinline__ void dg_attn(const Args& A, int k, int al, LAS unsigned char* lds) {
    const int tid = threadIdx.x; const unsigned h = dg_hash(blockIdx.x, k); const int row = h & (MTOK - 1), hd = (h >> 16) & 7, b = row >> 13;
    const bf16_t* Q = (const bf16_t*)(A.ws + A_Q); const bf16_t* K = (const bf16_t*)(A.ws + A_K); const bf16_t* V = (const bf16_t*)(A.ws + A_V);
    const float* scal = (const float*)(A.ws + TB_SCAL); const float lamv = scal[SC_LAM0 + al], omli = scal[SC_OML0 + al], Mc = scal[SC_MC0 + al];
    LAS float* p0 = (LAS float*)lds; LAS float* p1 = p0 + SEQ; LAS float* red = p1 + SEQ;
    float l0 = 0.f, l1 = 0.f;
    for (int key = tid; key < SEQ; key += NTHR) { const bf16_t* kr = K + ((size_t)b * SEQ + key) * DM + hd * 128; const bf16_t* qr = Q + (size_t)row * DM + hd * 128;
        float s0 = 0.f, s1 = 0.f; for (int d = 0; d < 64; ++d) { s0 += bf2f(qr[d]) * bf2f(kr[d]); s1 += bf2f(qr[64 + d]) * bf2f(kr[64 + d]); }
        const float e0 = fexp2(s0 - Mc), e1 = fexp2(s1 - Mc); p0[key] = e0; p1[key] = e1; l0 += e0; l1 += e1; }
    l0 = wave_sum(l0); l1 = wave_sum(l1); if ((tid & 63) == 0) { red[tid >> 6] = l0; red[8 + (tid >> 6)] = l1; }
    __syncthreads();
    l0 = 0.f; l1 = 0.f; for (int w = 0; w < 8; ++w) { l0 += red[w]; l1 += red[8 + w]; }
    __syncthreads();
    const int dv = tid & 127, part = tid >> 7; float o = 0.f;
    for (int key = part * 2048; key < part * 2048 + 2048; ++key) o += (p0[key] / l0 - lamv * p1[key] / l1) * bf2f(V[((size_t)b * SEQ + key) * DM + hd * 128 + dv]);
    red[16 + part * 128 + dv] = o; __syncthreads();
    if (tid < 128) { o = red[16 + tid] + red[16 + 128 + tid] + red[16 + 256 + tid] + red[16 + 384 + tid]; red[600 + tid] = o * o; }
    __syncthreads();
    if (tid < 128) { float ss = 0.f; for (int i = 0; i < 128; ++i) ss += red[600 + i]; const float ref = o / sqrtf(ss / 128.0f + EPS) * A.in[I_ATSUB][al * 128 + tid] * omli;
        dg_put(A, k, dg_rel(bf2f(((const bf16_t*)(A.ws + WS_HM))[(size_t)row * DM + hd * 128 + tid]), ref)); }
    __syncthreads();
}
__device__ __forceinline__ void dg_save(const Args& A, int k, const float* xold) {
    const int lane = threadIdx.x & 63, gwv = blockIdx.x * 8 + (threadIdx.x >> 6);
    const unsigned h = dg_hash(gwv, k); const int row = h & (MTOK - 1), col = (h >> 16) & 1023;
    float* sv = (float*)(A.ws + TB_LSUM) + 7 * 1024 * 1024 / 4;
    if (lane == 0) sv[k * 4096 + gwv] = xold[(size_t)row * DM + col];
}
__device__ __forceinline__ void dg_res(const Args& A, int k, const float* xnew, const float* gate, const bf16_t* Am, int K, const float* W) {
    const int lane = threadIdx.x & 63, gwv = blockIdx.x * 8 + (threadIdx.x >> 6);
    const unsigned h = dg_hash(gwv, k); const int row = h & (MTOK - 1), col = (h >> 16) & 1023, b = row >> 13;
    const float* sv = (const float*)(A.ws + TB_LSUM) + 7 * 1024 * 1024 / 4;
    float a = 0.f; for (int kk = lane; kk < K; kk += 64) a += bf2f(Am[(size_t)row * K + kk]) * dg_bfr(W[(size_t)kk * DM + col]);
    a = wave_sum(a);
    const float ref = sv[k * 4096 + gwv] + gate[(size_t)b * 6144 + col] * a;
    if (lane == 0) dg_put(A, k, dg_rel(xnew[(size_t)row * DM + col], ref));
}
__device__ __forceinline__ void dg_swiglu(const Args& A, int k, const bf16_t* Am, const float* W, int F, const bf16_t* H, int nrows, const int* rowmap) {
    const int lane = threadIdx.x & 63, gwv = blockIdx.x * 8 + (threadIdx.x >> 6);
    const unsigned h = dg_hash(gwv, k); const int row = (h & 0xfffff) % nrows, j = (h >> 20) % F;
    float g = 0.f, u = 0.f; for (int kk = lane; kk < DM; kk += 64) { const float x = bf2f(Am[(size_t)row * DM + kk]); g += x * dg_bfr(W[(size_t)kk * 2 * F + j]); u += x * dg_bfr(W[(size_t)kk * 2 * F + F + j]); }
    g = wave_sum(g); u = wave_sum(u);
    const float ref = g / (1.0f + expf(-g)) * u;
    if (lane == 0) dg_put(A, k, dg_rel(bf2f(H[(size_t)row * F + j]), ref));
}
__device__ __forceinline__ void dg_hgin(const Args& A, int k) {
    const int lane = threadIdx.x & 63, gwv = blockIdx.x * 8 + (threadIdx.x >> 6);
    const unsigned h = dg_hash(gwv, k); const int row = h & (MTOK - 1), col = (h >> 16) % 5120, grp = col >> 10, cc = col & 1023;
    float a = 0.f; for (int kk = lane; kk < DM; kk += 64) a += bf2f(((const bf16_t*)(A.ws + WS_HM))[(size_t)row * DM + kk]) * dg_bfr(A.in[I_HGWIN][(size_t)kk * 5120 + col]);
    a = wave_sum(a);
    float ref, got;
    if (grp == 0 || grp == 4) { ref = a / (1.0f + expf(-a)); got = bf2f(((const bf16_t*)(A.ws + (grp == 0 ? H_Q : H_G)))[(size_t)row * DM + cc]); }
    else if (grp == 3) { ref = a; got = bf2f(((const bf16_t*)(A.ws + H_V))[(size_t)row * DM + cc]); }
    else { const int d = grp - 1; const float* p = A.in[I_HGLB] + (size_t)d * DEPTH * 1024 + cc; float mx = p[0]; for (int l = 1; l < DEPTH; ++l) mx = fmaxf(mx, p[l * 1024]);
        float den = 0.f; for (int l = 0; l < DEPTH; ++l) den += expf(p[l * 1024] - mx); const float lbv = expf(p[1024] - mx) / den;
        ref = logf(lbv + (1.0f - lbv) / (1.0f + expf(-a))); got = gla::h2f(((const unsigned short*)(A.ws + (d ? H_LFB : H_LFF)))[(size_t)row * DM + cc]); }
    if (lane == 0) dg_put(A, k, dg_rel(got, ref));
}
__device__ __forceinline__ void dg_gla(const Args& A, int k) {
    const int lane = threadIdx.x & 63, gwv = blockIdx.x * 8 + (threadIdx.x >> 6);
    const unsigned h = dg_hash(gwv, k); const int sel0 = (gwv & 3) == 0; const int b = sel0 ? 0 : (h & 7), hd = sel0 ? 0 : ((h >> 3) & 7), dir = sel0 ? 0 : ((h >> 6) & 1), vc = sel0 ? ((h >> 7) & 63) : ((h >> 7) & 127);
    const bf16_t* Q = (const bf16_t*)(A.ws + H_Q); const unsigned short* LF = (const unsigned short*)(A.ws + (dir ? H_LFB : H_LFF)); const bf16_t* V = (const bf16_t*)(A.ws + H_V);
    const bf16_t* O = (const bf16_t*)(A.ws + (dir ? H_OB : H_OF));
    float s0 = 0.f, s1 = 0.f, e0 = 0.f, e1 = 0.f, e2 = 0.f, e3 = 0.f;
    for (int i = 0; i < SEQ; ++i) { const int tok = dir ? (SEQ - 1 - i) : i; const size_t o = ((size_t)b * SEQ + tok) * DM + hd * 128;
        const float f0 = expf(gla::h2f(LF[o + lane])), f1 = expf(gla::h2f(LF[o + 64 + lane])), v = bf2f(V[o + vc]);
        s0 = f0 * s0 + (1.0f - f0) * v; s1 = f1 * s1 + (1.0f - f1) * v;
        if (i < 128 || i % 61 == 0) { const float ov = wave_sum(bf2f(Q[o + lane]) * s0 + bf2f(Q[o + 64 + lane]) * s1); const float er = 0.25f * fabsf(bf2f(O[o + vc]) - ov) / (fabsf(ov) + 1.0f);
            if (i == 0) e0 = er; else if (i < 64) e1 = fmaxf(e1, er); else if (i < 128) e2 = fmaxf(e2, er); else e3 = fmaxf(e3, er); } }
    if (lane == 0) { dg_put(A, k, e0); dg_put(A, k + 4, e1); dg_put(A, k + 5, e2); dg_put(A, k + 6, e3); }
    const float* dbg = (const float*)(A.ws + TB_LSUM); const unsigned short* LF0 = (const unsigned short*)(A.ws + H_LFF); const bf16_t* Q0 = (const bf16_t*)(A.ws + H_Q);
    { const unsigned h2 = dg_hash(gwv, k + 100); const int t = h2 & 63, kk = (h2 >> 6) & 127; float c = 0.f; for (int tt = 0; tt <= t; ++tt) c += gla::h2f(LF0[(size_t)tt * DM + kk]);
      if (lane == 0) dg_put(A, k + 1, dg_rel(dbg[t * 128 + kk], c)); }
    { const unsigned h2 = dg_hash(gwv, k + 200); const int t = h2 & 63, sidx = (h2 >> 6) & 63; float a = 0.f;
      if (sidx <= t) { for (int kk = lane; kk < 128; kk += 64) { float c = 0.f; for (int tt = sidx + 1; tt <= t; ++tt) c += gla::h2f(LF0[(size_t)tt * DM + kk]);
              a += bf2f(Q0[(size_t)t * DM + kk]) * (1.0f - expf(gla::h2f(LF0[(size_t)sidx * DM + kk]))) * expf(c); } a = wave_sum(a); }
      const unsigned short got = ((const unsigned short*)(dbg + 8192))[gla::sw128(t, sidx * 2) / 2];
      if (lane == 0) dg_put(A, k + 2, 5.0f * fabsf(bf2f(got) - a) / (fabsf(a) + 0.01f)); }
    { const unsigned h2 = dg_hash(gwv, k + 300); const int sidx = h2 & 63, v = (h2 >> 6) & 63;
      const unsigned short got = ((const unsigned short*)(dbg + 8192 + 2048))[gla::sw128(v, sidx * 2) / 2];
      if (lane == 0) dg_put(A, k + 2, dg_rel(bf2f(got), bf2f(((const bf16_t*)(A.ws + H_V))[(size_t)sidx * DM + v]))); }
    { const unsigned h2 = dg_hash(gwv, k + 500); const int kk = h2 & 127, v = (h2 >> 7) & 63;
      float a = 0.f; { const int sidx = lane; float c = 0.f; for (int tt = sidx + 1; tt < 64; ++tt) c += gla::h2f(LF0[(size_t)tt * DM + kk]);
          const float ksn = (1.0f - expf(gla::h2f(LF0[(size_t)sidx * DM + kk]))) * expf(c);
          const unsigned short gk = ((const unsigned short*)(dbg + 16384))[gla::sw128(kk, sidx * 2) / 2];
          dg_put(A, k + 2, 0.5f * fabsf(bf2f(gk) - ksn) / (fabsf(ksn) + 0.01f));
          a = ksn * bf2f(((const bf16_t*)(A.ws + H_V))[(size_t)sidx * DM + v]); }
      a = wave_sum(a);
      const unsigned short gs = ((const unsigned short*)(dbg + 12288))[gla::sw256(v, kk * 2) / 2];
      if (lane == 0) dg_put(A, k + 3, 0.5f * fabsf(bf2f(gs) - a) / (fabsf(a) + 0.05f)); }
    { const unsigned h2 = dg_hash(gwv, k + 400); const int t = h2 & 63, v = (h2 >> 6) & 63;
      const unsigned short* at = (const unsigned short*)(dbg + 8192); const unsigned short* vt = (const unsigned short*)(dbg + 8192 + 2048);
      float a = bf2f(at[gla::sw128(t, lane * 2) / 2]) * bf2f(vt[gla::sw128(v, lane * 2) / 2]); a = wave_sum(a);
      if (lane == 0) dg_put(A, k + 1, 5.0f * dg_rel(bf2f(((const bf16_t*)(A.ws + H_OF))[(size_t)t * DM + v]), a)); }
}
__device__ __forceinline__ void dg_normo(const Args& A, int k) {
    const int lane = threadIdx.x & 63, gwv = blockIdx.x * 8 + (threadIdx.x >> 6);
    const unsigned h = dg_hash(gwv, k); const int row = h & (MTOK - 1), hd = (h >> 16) & 7; const size_t o = (size_t)row * DM + hd * 128;
    const float v0 = bf2f(((const bf16_t*)(A.ws + H_OF))[o + lane]) + bf2f(((const bf16_t*)(A.ws + H_OB))[o + lane]), v1 = bf2f(((const bf16_t*)(A.ws + H_OF))[o + 64 + lane]) + bf2f(((const bf16_t*)(A.ws + H_OB))[o + 64 + lane]);
    const float ss = wave_sum(v0 * v0 + v1 * v1), rstd = 1.0f / sqrtf(ss / 128.0f + EPS);
    const float r0 = v0 * rstd * A.in[I_HGNG][lane] * bf2f(((const bf16_t*)(A.ws + H_G))[o + lane]), r1 = v1 * rstd * A.in[I_HGNG][64 + lane] * bf2f(((const bf16_t*)(A.ws + H_G))[o + 64 + lane]);
    dg_put(A, k, fmaxf(dg_rel(bf2f(((const bf16_t*)(A.ws + WS_HM))[o + lane]), r0), dg_rel(bf2f(((const bf16_t*)(A.ws + WS_HM))[o + 64 + lane]), r1)));
}
__device__ __forceinline__ void dg_router(const Args& A, int k, int L) {
    const int lane = threadIdx.x & 63, gwv = blockIdx.x * 8 + (threadIdx.x >> 6);
    const int row = dg_hash(gwv, k) & (MTOK - 1), b = row >> 13; const float* x = A.out + (size_t)row * DM;
    const float* modl = (const float*)(A.ws + TB_MODS) + ((size_t)L * NBATCH + b) * 6144; const float* gain = A.in[I_N2G] + L * DM; const float* R = A.in[I_MOER] + (size_t)(L >> 1) * DM * 8;
    float ss = 0.f; for (int c = lane; c < DM; c += 64) ss += x[c] * x[c];
    ss = wave_sum(ss); const float rstd = 1.0f / sqrtf(ss / DM + EPS);
    float lg[8]; for (int e = 0; e < 8; ++e) lg[e] = 0.f;
    for (int c = lane; c < DM; c += 64) { const float hv = x[c] * rstd * gain[c] * (1.0f + modl[4 * 1024 + c]) + modl[3 * 1024 + c]; for (int e = 0; e < 8; ++e) lg[e] += hv * R[c * 8 + e]; }
    for (int e = 0; e < 8; ++e) lg[e] = wave_sum(lg[e]);
    int e0 = 0; for (int e = 1; e < 8; ++e) if (lg[e] > lg[e0]) e0 = e;
    int e1 = (e0 == 0) ? 1 : 0; for (int e = 0; e < 8; ++e) if (e != e0 && lg[e] > lg[e1]) e1 = e;
    float gap = 1e9f; for (int e = 0; e < 8; ++e) if (e != e0 && e != e1) gap = fminf(gap, lg[e1] - lg[e]); gap = fminf(gap, lg[e0] - lg[e1]);
    const int g0 = ((const int*)(A.ws + TB_EID))[row * 2], g1 = ((const int*)(A.ws + TB_EID))[row * 2 + 1]; const float w0 = ((const float*)(A.ws + TB_GATE))[row * 2], w1 = ((const float*)(A.ws + TB_GATE))[row * 2 + 1];
    const float p0 = 1.0f / (1.0f + expf(lg[e1] - lg[e0]));
    float er = (g0 != e0 || g1 != e1) ? (gap > 2e-3f ? 9.f : 0.f) : fmaxf(fabsf(w0 - p0), fabsf(w1 - (1.0f - p0)));
    if (lane == 0) dg_put(A, k, er);
}
__device__ __forceinline__ void dg_place(const Args& A, int k) {
    const int lane = threadIdx.x & 63, gwv = blockIdx.x * 8 + (threadIdx.x >> 6);
    const unsigned h = dg_hash(gwv, k); const int row = h & (MTOK - 1), kk = (h >> 16) & 1;
    const int sl = ((const int*)(A.ws + TB_SLOT))[row * 2 + kk], e = ((const int*)(A.ws + TB_EID))[row * 2 + kk]; const int* ts = (const int*)(A.ws + TB_TILES);
    float er = (sl >= ts[e] * 256 && sl < ts[e + 1] * 256 && sl < MOE_ROWS) ? 0.f : 7.f;
    if (er == 0.f) for (int c = lane; c < DM; c += 64) if (((const bf16_t*)(A.ws + E_XS))[(size_t)sl * DM + c] != ((const bf16_t*)(A.ws + WS_HM))[(size_t)row * DM + c]) er = 5.f;
    dg_put(A, k, er);
}
__device__ __forceinline__ void dg_moe_hid(const Args& A, int k, int m) {
    const int lane = threadIdx.x & 63, gwv = blockIdx.x * 8 + (threadIdx.x >> 6);
    const unsigned h = dg_hash(gwv, k); const int row = h & (MTOK - 1), kk = (h >> 16) & 1, j = (h >> 17) % DFFE;
    const int sl = ((const int*)(A.ws + TB_SLOT))[row * 2 + kk], e = ((const int*)(A.ws + TB_EID))[row * 2 + kk];
    const float* W = A.in[I_MOEGU] + ((size_t)m * 8 + e) * DM * 2 * DFFE; const bf16_t* Am = (const bf16_t*)(A.ws + E_XS) + (size_t)sl * DM;
    float g = 0.f, u = 0.f; for (int c = lane; c < DM; c += 64) { const float x = bf2f(Am[c]); g += x * dg_bfr(W[(size_t)c * 2 * DFFE + j]); u += x * dg_bfr(W[(size_t)c * 2 * DFFE + DFFE + j]); }
    g = wave_sum(g); u = wave_sum(u);
    if (lane == 0) dg_put(A, k, dg_rel(bf2f(((const bf16_t*)(A.ws + E_HID))[(size_t)sl * DFFE + j]), g / (1.0f + expf(-g)) * u));
}
__device__ __forceinline__ void dg_moe_y(const Args& A, int k, int m) {
    const int lane = threadIdx.x & 63, gwv = blockIdx.x * 8 + (threadIdx.x >> 6);
    const unsigned h = dg_hash(gwv, k); const int row = h & (MTOK - 1), kk = (h >> 16) & 1, col = (h >> 17) & 1023;
    const int sl = ((const int*)(A.ws + TB_SLOT))[row * 2 + kk], e = ((const int*)(A.ws + TB_EID))[row * 2 + kk];
    const float* W = A.in[I_MOEDN] + ((size_t)m * 8 + e) * DFFE * DM; const bf16_t* Hh = (const bf16_t*)(A.ws + E_HID) + (size_t)sl * DFFE;
    float a = 0.f; for (int j = lane; j < DFFE; j += 64) a += bf2f(Hh[j]) * dg_bfr(W[(size_t)j * DM + col]);
    a = wave_sum(a);
    if (lane == 0) dg_put(A, k, fabsf(bf2f(((const bf16_t*)(A.ws + E_XS))[(size_t)sl * DM + col]) - a) / (fabsf(a) + 0.3f));
}
__device__ __forceinline__ void dg_combine(const Args& A, int k, const float* modprev) {
    const int lane = threadIdx.x & 63, gwv = blockIdx.x * 8 + (threadIdx.x >> 6);
    const unsigned h = dg_hash(gwv, k); const int row = h & (MTOK - 1), col = (h >> 16) & 1023, b = row >> 13;
    const float* sv = (const float*)(A.ws + TB_LSUM) + 7 * 1024 * 1024 / 4; const bf16_t* Y = (const bf16_t*)(A.ws + E_XS);
    const int s0 = ((const int*)(A.ws + TB_SLOT))[row * 2], s1 = ((const int*)(A.ws + TB_SLOT))[row * 2 + 1]; const float w0 = ((const float*)(A.ws + TB_GATE))[row * 2], w1 = ((const float*)(A.ws + TB_GATE))[row * 2 + 1];
    const float ref = sv[k * 4096 + gwv] + modprev[(size_t)b * 6144 + 5 * 1024 + col] * (w0 * bf2f(Y[(size_t)s0 * DM + col]) + w1 * bf2f(Y[(size_t)s1 * DM + col]));
    if (lane == 0) dg_put(A, k, dg_rel(A.out[(size_t)row * DM + col], ref));
}
__device__ __forceinline__ void dg_lruin(const Args& A, int k) {
    const int lane = threadIdx.x & 63, gwv = blockIdx.x * 8 + (threadIdx.x >> 6);
    const unsigned h = dg_hash(gwv, k); const int row = h & (MTOK - 1), col = (h >> 16) % 2560;
    float a = 0.f; for (int kk = lane; kk < DM; kk += 64) a += bf2f(((const bf16_t*)(A.ws + WS_HM))[(size_t)row * DM + kk]) * dg_bfr(A.in[I_LRWIN][(size_t)kk * 2560 + col]);
    a = wave_sum(a);
    float ref, got;
    if (col < LRUW) { ref = 0.5f * a * (1.0f + tanhf(0.7978845608028654f * (a + 0.044715f * a * a * a))); got = bf2f(((const bf16_t*)(A.ws + L_YB))[(size_t)row * LRUW + col]); }
    else { ref = a; got = bf2f(((const bf16_t*)(A.ws + L_XB))[(size_t)row * LRUW + col - LRUW]); }
    if (lane == 0) dg_put(A, k, dg_rel(got, ref));
}
__device__ __forceinline__ void dg_lru(const Args& A, int k) {
    const int lane = threadIdx.x & 63, gwv = blockIdx.x * 8 + (threadIdx.x >> 6);
    const unsigned h = dg_hash(gwv, k); const int b = h & 7, ch = (h >> 3) % LRUW, tc = (h >> 16) & (SEQ - 1), n = ch / 128, j = ch % 128;
    const bf16_t* XB = (const bf16_t*)(A.ws + L_XB) + (size_t)b * SEQ * LRUW;
    float hres[2];
    for (int d = 0; d < 2; ++d) {
        const float* wa = A.in[I_LRWA] + (size_t)(d * 10 + n) * 16384; const float* wx = A.in[I_LRWX] + (size_t)(d * 10 + n) * 16384;
        const float wa0 = dg_bfr(wa[lane * 128 + j]), wa1 = dg_bfr(wa[(lane + 64) * 128 + j]), wx0 = dg_bfr(wx[lane * 128 + j]), wx1 = dg_bfr(wx[(lane + 64) * 128 + j]);
        const float ba = A.in[I_LRBA][d * LRUW + ch], bx = A.in[I_LRBX][d * LRUW + ch]; const float lam = A.in[I_LRLAM][d * LRUW + ch]; const float sp = log1pf(expf(-lam));
        float hs = 0.f;
        for (int i = 0; ; ++i) { const int t = d ? (SEQ - 1 - i) : i;
            float x0 = A.in[I_LRCB][n * 128 + lane], x1 = A.in[I_LRCB][n * 128 + 64 + lane], xj = A.in[I_LRCB][ch];
            for (int w = 0; w < 4; ++w) { const int tt = t - 1 + w; if (tt >= 0 && tt < SEQ) {
                x0 += A.in[I_LRCW][w * LRUW + n * 128 + lane] * bf2f(XB[(size_t)tt * LRUW + n * 128 + lane]); x1 += A.in[I_LRCW][w * LRUW + n * 128 + 64 + lane] * bf2f(XB[(size_t)tt * LRUW + n * 128 + 64 + lane]);
                xj += A.in[I_LRCW][w * LRUW + ch] * bf2f(XB[(size_t)tt * LRUW + ch]); } }
            const float rp = wave_sum(dg_bfr(x0) * wa0 + dg_bfr(x1) * wa1), ip = wave_sum(dg_bfr(x0) * wx0 + dg_bfr(x1) * wx1);
            const float rg = 1.0f / (1.0f + expf(-(rp + ba))), ig = 1.0f / (1.0f + expf(-(ip + bx))); const float la = -8.0f * rg * sp;
            hs = expf(la) * hs + sqrtf(fmaxf(-expm1f(2.0f * la), 0.f)) * ig * xj;
            if (t == tc) break; }
        hres[d] = hs;
    }
    const size_t go = ((size_t)b * SEQ + tc) * LRUW + ch;
    const float e1 = fabsf(bf2f(((const bf16_t*)(A.ws + L_HF))[go]) - hres[0]) / (fabsf(hres[0]) + 0.3f);
    const float ref = (hres[0] + hres[1]) * bf2f(((const bf16_t*)(A.ws + L_YB))[go]);
    const float e2 = fabsf(bf2f(((const bf16_t*)(A.ws + L_HY))[go]) - ref) / (fabsf(ref) + 0.3f);
    if (lane == 0) { dg_put(A, k, e1); dg_put(A, k + 5, e2); }
}
__device__ __forceinline__ void dg_final(const Args& A, int nchk) {
    const unsigned* sl = (const unsigned*)(A.ws + WS_CTL) + DG_BASE; int code = 0; float ev = 0.f;
    for (int k = 1; k <= nchk; ++k) { const float e = __uint_as_float(sl[64 * k]); if (e > 0.05f) { code = k; ev = e; break; } }
    if (code == 0) return;
    const int c1 = code % 10, c10 = code / 10;
    const float s = -(float)c1;
    for (size_t i = (size_t)blockIdx.x * NTHR + threadIdx.x; i < (size_t)MTOK * DM; i += (size_t)gridDim.x * NTHR) A.out[i] = A.in[I_X][i] * s;
    __syncthreads();
    if (blockIdx.x == 0 && threadIdx.x == 0) { const int qq = ev < 0.1f ? 1 : ev < 0.2f ? 2 : ev < 0.5f ? 3 : ev < 1.f ? 4 : ev < 2.f ? 5 : ev < 5.f ? 6 : ev < 20.f ? 7 : ev < 1e3f ? 8 : 9;
        A.out[12345] = 100.f * (float)(10 * c10 + qq); }
}
#define DG(x) x
#define DGL(x) if constexpr (L >= DIAG_FROM) { x }
#else
#define DG(x)
#define DGL(x)
#endif

#define GRID_BAR() xcd_barrier(bar)
template <int L>
__device__ __forceinline__ void run_mixer(const Args& args, LAS unsigned char* lds, int bid, int G, const XcdBarrier& bar) {
    unsigned char* ws = args.ws; bf16_t* xo = (bf16_t*)(ws + WS_XB);
    const float* modl = (const float*)(ws + TB_MODS) + (size_t)L * NBATCH * 6144;
    const void* xs = (L == 0) ? (const void*)args.in[I_X] : (const void*)xo; constexpr bool X16 = (L != 0);
    constexpr int kind = L % 3;
    DGL(if (L > 0 && ((L - 1) & 1)) { dg_save(args, 10 * (L - 1) + 9, xo); GRID_BAR(); })
    constexpr bool F8Q = (L == 3);
    norm_phase<false>(args, lds, bid, G, xs, X16, xo, true, args.in[I_N1G] + L * DM, modl, 0, (L > 0) && ((L - 1) & 1), modl - NBATCH * 6144, false, nullptr, F8Q);
    GRID_BAR();
    DGL(if (L > 0 && ((L - 1) & 1)) { dg_combine(args, 10 * (L - 1) + 9, modl - NBATCH * 6144); GRID_BAR(); })
    DGL(dg_norm(args, 10 * L + 1, (L > 0 && ((L - 1) & 1)) ? xo : xs, args.in[I_N1G] + L * DM, L, 0); GRID_BAR();)
    if constexpr (kind == 0) {
        constexpr int al = L / 3;
        {
            pg8::Gemm g{(const bf16_t*)(ws + WS_HM), (const bf16_t*)(ws + W_QKV) + (size_t)al * 3072 * 1024, F8Q ? 512 : 1024};
            pg8::TileOrder S; S.init(256, 12, G, bid);
            pg8::EpiQKV E{(bf16_t*)(ws + A_Q), (bf16_t*)(ws + A_K), (bf16_t*)(ws + A_V), args.in[I_ATQN] + al * 64, args.in[I_ATKN] + al * 64,
                          (const float*)(ws + TB_COS), (const float*)(ws + TB_SIN), LOG2E, F8Q ? 1.0f / MOE_WSCALE : 1.0f};
            pg8::gemm_phase<pg8::EpiQKV, F8Q>(lds, g, S, E);
        }
        GRID_BAR();
        vt_phase(args, bid, G);
        GRID_BAR();
        attn_phase(args, lds, bid, G, al);
        GRID_BAR();
        DGL(dg_save(args, 10 * L + 4, xs); GRID_BAR();)
        {
            pg8::Gemm g{(const bf16_t*)(ws + WS_HM), (const bf16_t*)(ws + W_AO) + (size_t)al * 1024 * 1024, F8Q ? 512 : 1024};
            pg8::TileOrder S; S.init(256, 4, G, bid);
            pg8::EpiRes<X16> E{xs, xo, modl + 2 * 1024, F8Q ? 1.0f / MOE_WSCALE : 1.0f};
            pg8::gemm_phase<pg8::EpiRes<X16>, F8Q>(lds, g, S, E);
        }
        GRID_BAR();
        DGL(dg_res(args, 10 * L + 4, xo, modl + 2 * 1024, (const bf16_t*)(ws + WS_HM), 1024, args.in[I_ATWOUT] + (size_t)al * 1024 * 1024); GRID_BAR();)
    }
    if constexpr (kind == 1) {
        {
            pg8::Gemm g{(const bf16_t*)(ws + WS_HM), (const bf16_t*)(ws + W_HGI), 1024};
            pg8::TileOrder S; S.init(256, 20, G, bid);
            pg8::EpiAct E{0, ws, (const float*)(ws + TB_LB)};
            pg8::gemm_phase<pg8::EpiAct>(lds, g, S, E);
        }
        GRID_BAR();
        DGL(dg_hgin(args, 10 * L + 2); GRID_BAR();)
        gla_phase(args, lds, bid, G);
        GRID_BAR();
        DGL(dg_gla(args, 10 * L + 3); GRID_BAR();)
        hg_normo_phase(args, bid, G);
        GRID_BAR();
        DGL(dg_normo(args, 10 * L + 0); GRID_BAR();)
        DGL(dg_save(args, 10 * L + 4, xs); GRID_BAR();)
        {
            pg8::Gemm g{(const bf16_t*)(ws + WS_HM), (const bf16_t*)(ws + W_HGO), 1024};
            pg8::TileOrder S; S.init(256, 4, G, bid);
            pg8::EpiRes<X16> E{xs, xo, modl + 2 * 1024, 1.0f};
            pg8::gemm_phase<pg8::EpiRes<X16>>(lds, g, S, E);
        }
        GRID_BAR();
        DGL(dg_res(args, 10 * L + 4, xo, modl + 2 * 1024, (const bf16_t*)(ws + WS_HM), 1024, args.in[I_HGWOUT]); GRID_BAR();)
    }
    if constexpr (kind == 2) {
        {
            pg8::Gemm g{(const bf16_t*)(ws + WS_HM), (const bf16_t*)(ws + W_LRI), 1024};
            pg8::TileOrder S; S.init(256, 10, G, bid);
            pg8::EpiAct E{1, ws, nullptr};
            pg8::gemm_phase<pg8::EpiAct>(lds, g, S, E);
        }
        GRID_BAR();
        DGL(dg_lruin(args, 10 * L + 2); GRID_BAR();)
        lru_phase<0>(args, lds, bid, G);
        GRID_BAR();
        lru_carry_phase(args, bid, G);
        GRID_BAR();
        lru_apply_phase(args, lds, bid, G);
        GRID_BAR();
        DGL(dg_lru(args, 10 * L + 3); GRID_BAR();)
        DGL(dg_save(args, 10 * L + 4, xs); GRID_BAR();)
        {
            pg8::Gemm g{(const bf16_t*)(ws + L_HY), (const bf16_t*)(ws + W_LRO), LRUW};
            pg8::TileOrder S; S.init(256, 4, G, bid);
            pg8::EpiRes<X16> E{xs, xo, modl + 2 * 1024, 1.0f};
            pg8::gemm_phase<pg8::EpiRes<X16>>(lds, g, S, E);
        }
        GRID_BAR();
        DGL(dg_res(args, 10 * L + 4, xo, modl + 2 * 1024, (const bf16_t*)(ws + L_HY), LRUW, args.in[I_LRWOUT]); GRID_BAR();)
    }
}
template <int L>
__device__ __forceinline__ void run_ffn(const Args& args, LAS unsigned char* lds, int bid, int G, const XcdBarrier& bar) {
    unsigned char* ws = args.ws; bf16_t* xo = (bf16_t*)(ws + WS_XB);
    const float* modl = (const float*)(ws + TB_MODS) + (size_t)L * NBATCH * 6144;
    if constexpr ((L & 1) == 0) {
        constexpr int m = L >> 1;
        constexpr bool F8 = (L >= FP8_DENSE_FROM);
        norm_phase<false>(args, lds, bid, G, xo, true, xo, true, args.in[I_N2G] + L * DM, modl, 1, false, modl, false, nullptr, F8);
        GRID_BAR();
        if constexpr (F8) {
            pg8::Gemm g{(const bf16_t*)(ws + WS_HM), (const bf16_t*)(ws + W_FGU) + (size_t)m * 5632 * 1024, 512};
            pg8::TileOrder S; S.init(256, 22, G, bid);
            pg8::EpiSwiGLU8 E{ws + F_HID, DFF, 1.0f / MOE_WSCALE, MOE_HSCALE};
            pg8::gemm_phase<pg8::EpiSwiGLU8, true>(lds, g, S, E);
        } else {
            pg8::Gemm g{(const bf16_t*)(ws + WS_HM), (const bf16_t*)(ws + W_FGU) + (size_t)m * 5632 * 1024, 1024};
            pg8::TileOrder S; S.init(256, 22, G, bid);
            pg8::EpiSwiGLU E{(bf16_t*)(ws + F_HID), DFF};
            pg8::gemm_phase<pg8::EpiSwiGLU>(lds, g, S, E);
        }
        GRID_BAR();
        if constexpr (F8) {
            pg8::Gemm g{(const bf16_t*)(ws + F_HID), (const bf16_t*)(ws + W_FDN) + (size_t)m * 1024 * 2816, DFF / 2};
            pg8::TileOrder S; S.init(256, 4, G, bid);
            pg8::EpiRes<true> E{xo, xo, modl + 5 * 1024, 1.0f / (MOE_WSCALE * MOE_HSCALE)};
            pg8::gemm_phase<pg8::EpiRes<true>, true>(lds, g, S, E);
        } else {
            pg8::Gemm g{(const bf16_t*)(ws + F_HID), (const bf16_t*)(ws + W_FDN) + (size_t)m * 1024 * 2816, DFF};
            pg8::TileOrder S; S.init(256, 4, G, bid);
            pg8::EpiRes<true> E{xo, xo, modl + 5 * 1024, 1.0f};
            pg8::gemm_phase<pg8::EpiRes<true>>(lds, g, S, E);
        }
        GRID_BAR();
    } else {
        constexpr int m = L >> 1;
        norm_phase<true>(args, lds, bid, G, xo, true, xo, true, args.in[I_N2G] + L * DM, modl, 1, false, modl, false, args.in[I_MOER] + (size_t)m * DM * 8, true);
        GRID_BAR();
        DGL(dg_norm(args, 10 * L + 5, xo, args.in[I_N2G] + L * DM, L, 1); dg_router(args, 10 * L + 5, L); GRID_BAR();)
        place_phase(args, lds, bid, G);
        GRID_BAR();
        DGL(dg_place(args, 10 * L + 6); GRID_BAR();)
        const int* tiles = (const int*)(ws + TB_TILES);
        {
            pg8::Gemm g{(const bf16_t*)(ws + E_XS), (const bf16_t*)(ws + W_MGU + (size_t)m * 8 * 7168 * 1024), 512};
            pg8::TileOrder S; S.init(tiles[8], 28, G, bid);
#pragma unroll
            for (int e = 1; e < NEXP; ++e) S.ts[e] = tiles[e];
            pg8::EpiSwiGLU8 E{ws + E_HID, DFFE, 1.0f / MOE_WSCALE, MOE_HSCALE};
            pg8::gemm_phase<pg8::EpiSwiGLU8, true>(lds, g, S, E);
        }
        GRID_BAR();
        DGL(dg_moe_hid(args, 10 * L + 7, m); GRID_BAR();)
        {
            pg8::Gemm g{(const bf16_t*)(ws + E_HID), (const bf16_t*)(ws + W_MDN + (size_t)m * 8 * 1024 * 3584), DFFE / 2};
            pg8::TileOrder S; S.init(tiles[8], 4, G, bid);
#pragma unroll
            for (int e = 1; e < NEXP; ++e) S.ts[e] = tiles[e];
            pg8::EpiPlain E{(bf16_t*)(ws + E_XS), DM, 1.0f / (MOE_WSCALE * MOE_HSCALE)};
            pg8::gemm_phase<pg8::EpiPlain, true>(lds, g, S, E);
        }
        GRID_BAR();
        DGL(dg_moe_y(args, 10 * L + 8, m); GRID_BAR();)
    }
}
__device__ __forceinline__ void final_combine(const Args& args, LAS unsigned char* lds, int bid, int G, const XcdBarrier& bar) {
    const float* modl = (const float*)(args.ws + TB_MODS) + (size_t)3 * NBATCH * 6144;
    DG(dg_save(args, 39, args.out); GRID_BAR();)
    norm_phase<false>(args, lds, bid, G, args.ws + WS_XB, true, args.out, false, args.in[I_N1G], modl, 0, true, modl, true, nullptr);
    DG(GRID_BAR(); dg_combine(args, 39, modl);)
}

__global__ void __launch_bounds__(NTHR, 2) mega_fwd(Args args) {
    extern __shared__ __attribute__((aligned(16))) unsigned char lds_raw[];
    LAS unsigned char* lds = (LAS unsigned char*)lds_raw;
    const int tid = threadIdx.x, bid = blockIdx.x, G = gridDim.x;
    unsigned char* ws = args.ws;
    volatile LAS unsigned* MISC = (volatile LAS unsigned*)(lds + MISC_OFF);
    if (tid < 64) MISC[tid] = 0u;
    __syncthreads();
    XcdBarrier bar = xcd_barrier_post((unsigned*)(ws + WS_CTL) + CW_BAR, MISC + 8);

    prologue_phase(args, lds, bid, G);
    GRID_BAR();

    run_mixer<0>(args, lds, bid, G, bar);
    run_ffn<0>(args, lds, bid, G, bar);
    run_mixer<1>(args, lds, bid, G, bar);
    run_ffn<1>(args, lds, bid, G, bar);
    run_mixer<2>(args, lds, bid, G, bar);
    run_ffn<2>(args, lds, bid, G, bar);
    run_mixer<3>(args, lds, bid, G, bar);
    run_ffn<3>(args, lds, bid, G, bar);
    final_combine(args, lds, bid, G, bar);
    DG(GRID_BAR(); dg_final(args, 49);)
}

extern "C" void kernel_launch(void* const* d_in, const int* in_sizes, int n_in, void* d_out, int out_size, void* d_ws, size_t ws_size, hipStream_t stream) {
    static int grid = 0;
    if (grid == 0) {
        if (n_in != 30 || out_size != MTOK * DM || ws_size < WS_NEED) { fprintf(stderr, "kernel_launch: unexpected shapes (n_in %d out %d ws %zu need %zu)\n", n_in, out_size, ws_size, (size_t)WS_NEED); grid = -1; return; }
        int dev = 0, cus = 0;
        if (hipGetDevice(&dev) != hipSuccess || hipDeviceGetAttribute(&cus, hipDeviceAttributeMultiprocessorCount, dev) != hipSuccess) { grid = -1; return; }
        if (hipFuncSetAttribute((const void*)mega_fwd, hipFuncAttributeMaxDynamicSharedMemorySize, LDS_BYTES) != hipSuccess) { fprintf(stderr, "kernel_launch: hipFuncSetAttribute failed\n"); grid = -1; return; }
        int per_cu = 0;
        if (hipOccupancyMaxActiveBlocksPerMultiprocessor(&per_cu, (const void*)mega_fwd, NTHR, LDS_BYTES) != hipSuccess || per_cu < 1) { fprintf(stderr, "kernel_launch: occupancy query says %d\n", per_cu); }
        (void)hipGetLastError();
        grid = (cus >= 256) ? 256 : -1;
        if (grid < 0) { fprintf(stderr, "kernel_launch: needs 256 CUs, device has %d\n", cus); return; }
    }
    if (grid < 0) return;
    if (hipMemsetAsync((char*)d_ws + WS_CTL, 0, CTL_ZERO_BYTES, stream) != hipSuccess) return;
    Args a{};
    for (int i = 0; i < 30; ++i) a.in[i] = (const float*)d_in[i];
    a.out = (float*)d_out; a.ws = (unsigned char*)d_ws;
    hipLaunchKernelGGL(mega_fwd, dim3(grid), dim3(NTHR), LDS_BYTES, stream, a);
}
```
